# Optimizing an MI355X kernel written in HIP

```python
import jax, jax.numpy as jnp
from jax import lax
import numpy as np

D_MODEL = 1024
BATCH = 8
SEQ = 2048
DEPTH = 2

N_META = 16
EPS = 1e-6
ROPE_THETA = 10000.0
Q_BLOCK = 128
N_BRANCHES = 3

POOL_WINDOWS = (2, 4, 8, 16)
N_POOL_GROUPS = 4
C_A = D_MODEL
POOL_GROUP_DIM = C_A // N_POOL_GROUPS

RWKV_HEAD_DIM = 64
C_B = D_MODEL
RWKV_HEADS = C_B // RWKV_HEAD_DIM
RWKV_DECAY_RANK = 64
RWKV_A_RANK = 64
RWKV_GATE_RANK = 128
RWKV_VRES_RANK = 32
RWKV_GN_EPS = 64e-5

DSA_HEADS = 16
DSA_NOPE_DIM = 64
DSA_ROPE_DIM = 32
DSA_V_DIM = 64
C_C = DSA_HEADS * DSA_V_DIM
DSA_Q_RANK = 256
DSA_KV_RANK = 128
IDX_HEADS = 8
IDX_DIM = 64
IDX_ROPE_DIM = 32
MAX_TOPK = 256

N_GROUPS = 4
EXPERTS_PER_GROUP = 4
N_EXPERTS = N_GROUPS * EXPERTS_PER_GROUP
EXPERT_TOPK = 2
EXPERT_HIDDEN = 256

C_SHIFT = 3 * C_B + RWKV_DECAY_RANK + RWKV_A_RANK + RWKV_GATE_RANK
C_DSA_IN = DSA_Q_RANK + DSA_KV_RANK + DSA_ROPE_DIM + IDX_DIM + IDX_HEADS
C_IN = N_BRANCHES * D_MODEL + C_A + C_SHIFT + C_DSA_IN

kernel_name = 'hybrid_pool_rwkv7_dsa_hiermoe'


def rms_norm(x, g, eps=EPS):
    xf = x.astype(jnp.float32)
    y = xf * lax.rsqrt(jnp.mean(xf * xf, axis=-1, keepdims=True) + eps)
    return (y * g.astype(jnp.float32)).astype(x.dtype)


def layer_norm(x, w, b, eps=EPS):
    xf = x.astype(jnp.float32)
    mu = jnp.mean(xf, axis=-1, keepdims=True)
    var = jnp.mean(jnp.square(xf - mu), axis=-1, keepdims=True)
    y = (xf - mu) * lax.rsqrt(var + eps)
    return (y * w.astype(jnp.float32) + b.astype(jnp.float32)).astype(x.dtype)


def rope(x, pos):
    d = x.shape[-1]
    inv = ROPE_THETA ** (-jnp.arange(0, d, 2, dtype=jnp.float32) / d)
    ang = pos.astype(jnp.float32)[:, None] * inv[None, :]
    ang = ang.reshape(ang.shape[:1] + (1,) * (x.ndim - 3) + ang.shape[1:])
    cos, sin = jnp.cos(ang), jnp.sin(ang)
    xf = x.astype(jnp.float32)
    x1, x2 = xf[..., : d // 2], xf[..., d // 2:]
    return jnp.concatenate([x1 * cos - x2 * sin, x2 * cos + x1 * sin], axis=-1).astype(x.dtype)


def token_shift(p, mu):
    prev = jnp.pad(p[:, :-1], ((0, 0), (1, 0), (0, 0)))
    return p + (prev - p) * mu.astype(p.dtype)


def pool_mixer(u, w_grp, scale):
    B, T, _ = u.shape
    uf = u.astype(jnp.float32).reshape(B, T, N_POOL_GROUPS, POOL_GROUP_DIM)
    cs = jnp.cumsum(uf, axis=1)
    t = jnp.arange(T, dtype=jnp.float32)
    means = []
    for g, w in enumerate(POOL_WINDOWS):
        c = cs[:, :, g]
        lo = jnp.pad(c, ((0, 0), (w, 0), (0, 0)))[:, :T]
        cnt = jnp.minimum(t + 1.0, float(w))[None, :, None]
        means.append((c - lo) / cnt)
    pooled = jnp.stack(means, axis=2) - uf
    y = jnp.einsum('btgc,gcd->btgd', pooled.astype(u.dtype), w_grp).reshape(B, T, C_A)
    return y * scale


def rwkv7_scan(r, w, k, v, a, b):
    def step(S, inp):
        r_t, w_t, k_t, v_t, a_t, b_t = inp
        sa = jnp.einsum('bhij,bhj->bhi', S, a_t)
        S = S * w_t[:, :, None, :] + sa[..., :, None] * b_t[..., None, :] + v_t[..., :, None] * k_t[..., None, :]
        return S, jnp.einsum('bhij,bhj->bhi', S, r_t)
    B, T, H, N = r.shape
    S0 = jnp.zeros((B, H, N, N), jnp.float32)
    xs = tuple(jnp.moveaxis(z, 1, 0) for z in (r, w, k, v, a, b))
    _, out = lax.scan(step, S0, xs)
    return jnp.moveaxis(out, 0, 1)


def rwkv7_mixer(pb, vres, v_first, w0, w2, a0, a2, g2, k_k, k_a, r_k, ln_w, ln_b):
    B, T, _ = pb.shape
    H, N = RWKV_HEADS, RWKV_HEAD_DIM
    f32 = jnp.float32
    cuts = [C_B, 2 * C_B, 3 * C_B, 3 * C_B + RWKV_DECAY_RANK, 3 * C_B + RWKV_DECAY_RANK + RWKV_A_RANK]
    r, k, v, wd, ad, gd = jnp.split(pb, cuts, axis=-1)
    w_log = -jax.nn.softplus(-(w0 + jnp.tanh(wd) @ w2).astype(f32)) - 0.5
    decay = jnp.exp(-jnp.exp(w_log))
    a = jax.nn.sigmoid((a0 + ad @ a2).astype(f32))
    g = jax.nn.sigmoid(gd) @ g2
    if vres is None:
        v_first = v
    else:
        vd, v0, v2 = vres
        v = v + (v_first - v) * jax.nn.sigmoid(v0 + vd @ v2)
    heads = lambda z: z.astype(f32).reshape(B, T, H, N)
    rh, vh, ah, dh = heads(r), heads(v), heads(a), heads(decay)
    kk = heads(k * k_k)
    kk = kk / jnp.maximum(jnp.linalg.norm(kk, axis=-1, keepdims=True), 1e-12)
    kh = heads(k) * (1.0 + (ah - 1.0) * k_a.astype(f32).reshape(H, N))
    o = rwkv7_scan(rh, dh, kh, vh, -kk, kk * ah)
    mu = jnp.mean(o, axis=-1, keepdims=True)
    var = jnp.mean(jnp.square(o - mu), axis=-1, keepdims=True)
    o = ((o - mu) * lax.rsqrt(var + RWKV_GN_EPS)).reshape(B, T, C_B)
    o = o * ln_w.astype(f32) + ln_b.astype(f32)
    bonus = jnp.sum(rh * kh * r_k.astype(f32), axis=-1, keepdims=True) * vh
    o = (o + bonus.reshape(B, T, C_B)) * g.astype(f32)
    return o.astype(pb.dtype), v_first


def dsa_mixer(pc, pos, topk, q_norm_g, kv_norm_g, w_uq, w_uk, w_uv, w_q_idx, k_idx_w, k_idx_b):
    B, T, _ = pc.shape
    f32 = jnp.float32
    cuts = [DSA_Q_RANK, DSA_Q_RANK + DSA_KV_RANK, DSA_Q_RANK + DSA_KV_RANK + DSA_ROPE_DIM,
            DSA_Q_RANK + DSA_KV_RANK + DSA_ROPE_DIM + IDX_DIM]
    cq, ckv, krope, kidx, widx = jnp.split(pc, cuts, axis=-1)
    cq = rms_norm(cq, q_norm_g)
    ckv = rms_norm(ckv, kv_norm_g)
    q = (cq @ w_uq).reshape(B, T, DSA_HEADS, DSA_NOPE_DIM + DSA_ROPE_DIM)
    q_nope, q_rope = q[..., :DSA_NOPE_DIM], rope(q[..., DSA_NOPE_DIM:], pos)
    k_rope = rope(krope, pos)
    q_lat = jnp.einsum('bthd,hcd->bthc', q_nope, w_uk)
    q_idx = (cq @ w_q_idx).reshape(B, T, IDX_HEADS, IDX_DIM)
    q_idx = jnp.concatenate([rope(q_idx[..., :IDX_ROPE_DIM], pos), q_idx[..., IDX_ROPE_DIM:]], axis=-1)
    k_idx = layer_norm(kidx, k_idx_w, k_idx_b)
    k_idx = jnp.concatenate([rope(k_idx[..., :IDX_ROPE_DIM], pos), k_idx[..., IDX_ROPE_DIM:]], axis=-1)
    w_head = widx * (IDX_HEADS ** -0.5 * IDX_DIM ** -0.5)
    scale = (DSA_NOPE_DIM + DSA_ROPE_DIM) ** -0.5
    n_blk = -(-T // Q_BLOCK)
    t_pad = n_blk * Q_BLOCK

    def blocks(z):
        z = jnp.pad(z, ((0, 0), (0, t_pad - T)) + ((0, 0),) * (z.ndim - 2))
        return jnp.moveaxis(z.reshape((B, n_blk, Q_BLOCK) + z.shape[2:]), 1, 0)

    qpos = jnp.arange(t_pad, dtype=jnp.int32).reshape(n_blk, Q_BLOCK)
    key_pos = jnp.arange(T, dtype=jnp.int32)
    gather = jax.vmap(lambda tbl, ix: tbl[ix])

    def attend(args):
        ql, qr, qi, wh, tq = args
        score_idx = jnp.einsum('bqhs,bqh->bqs', jax.nn.relu(jnp.einsum('bqhd,bsd->bqhs', qi, k_idx)), wh)
        admissible = key_pos[None, None, :] <= tq[None, :, None]
        score_idx = jnp.where(admissible, score_idx.astype(f32), -jnp.inf)
        _, sel = lax.top_k(score_idx, topk)
        ckv_sel = gather(ckv, sel)
        kr_sel = gather(k_rope, sel)
        s = jnp.einsum('bqhc,bqkc->bqhk', ql, ckv_sel) + jnp.einsum('bqhr,bqkr->bqhk', qr, kr_sel)
        s = s.astype(f32) * scale
        valid = (sel <= tq[None, :, None])[:, :, None, :]
        p = jax.nn.softmax(jnp.where(valid, s, -jnp.inf), axis=-1).astype(ckv_sel.dtype)
        return jnp.einsum('bqhk,bqkc->bqhc', p, ckv_sel)

    o_lat = lax.map(attend, (blocks(q_lat), blocks(q_rope), blocks(q_idx), blocks(w_head), qpos))
    o_lat = jnp.moveaxis(o_lat, 0, 1).reshape(B, t_pad, DSA_HEADS, DSA_KV_RANK)[:, :T]
    return jnp.einsum('bthc,hcv->bthv', o_lat, w_uv).reshape(B, T, C_C)


def hier_moe(h, w_grp, b_grp, w_exp, b_exp, w1, w3, w2):
    B, T, D = h.shape
    n = B * T
    f32 = jnp.float32
    hf = h.reshape(n, D)
    grp_logits = (hf @ w_grp).astype(f32) + b_grp.astype(f32)
    g_sel = jnp.argmax(grp_logits, axis=-1)
    p_grp = jnp.take_along_axis(jax.nn.softmax(grp_logits, axis=-1), g_sel[:, None], axis=1)
    exp_logits = ((hf @ w_exp).astype(f32) + b_exp.astype(f32)).reshape(n, N_GROUPS, EXPERTS_PER_GROUP)
    in_grp = jnp.take_along_axis(exp_logits, g_sel[:, None, None], axis=1)[:, 0]
    top_val, top_idx = lax.top_k(in_grp, EXPERT_TOPK)
    p_exp = jax.nn.softmax(top_val, axis=-1) * p_grp
    eid = g_sel[:, None] * EXPERTS_PER_GROUP + top_idx
    combine = jnp.sum(jax.nn.one_hot(eid, N_EXPERTS, dtype=f32) * p_exp[..., None], axis=1)
    y = jnp.zeros((n, D), f32)
    for gi in range(N_GROUPS):
        sl = slice(gi * EXPERTS_PER_GROUP, (gi + 1) * EXPERTS_PER_GROUP)
        hid = jax.nn.silu(jnp.einsum('nd,edf->nef', hf, w1[sl])) * jnp.einsum('nd,edf->nef', hf, w3[sl])
        hid = hid * combine[:, sl, None].astype(hid.dtype)
        y = y + jnp.einsum('nef,efd->nd', hid, w2[sl]).astype(f32)
    return y.reshape(B, T, D).astype(h.dtype)


def setup_inputs(seed: int = 0) -> dict:
    key = jax.random.key(seed)
    ks = iter(jax.random.split(key, 64))
    nrm = lambda shape, s: s * jax.random.normal(next(ks), shape, jnp.float32)
    gain = lambda shape: 1.0 + nrm(shape, 0.02)
    unif = lambda shape: jax.random.uniform(next(ks), shape, jnp.float32)
    L, V = DEPTH, DEPTH - 1
    decay_base = jnp.linspace(-6.5, -1.5, C_B, dtype=jnp.float32)
    return {
        'x': nrm((BATCH, SEQ, D_MODEL), 1.0),
        'meta_tokens': nrm((N_META, D_MODEL), 1.0),
        'norm_mix': gain((L, D_MODEL)),
        'w_in': nrm((L, D_MODEL, C_IN), D_MODEL ** -0.5),
        'mu_shift': unif((L, C_SHIFT)),
        'pool_w': nrm((L, N_POOL_GROUPS, POOL_GROUP_DIM, POOL_GROUP_DIM), POOL_GROUP_DIM ** -0.5),
        'pool_scale': gain((L, C_A)),
        'rwkv_w0': decay_base + nrm((L, C_B), 0.1),
        'rwkv_w2': nrm((L, RWKV_DECAY_RANK, C_B), 0.5 * RWKV_DECAY_RANK ** -0.5),
        'rwkv_a0': nrm((L, C_B), 0.1),
        'rwkv_a2': nrm((L, RWKV_A_RANK, C_B), 0.5 * RWKV_A_RANK ** -0.5),
        'rwkv_g2': nrm((L, RWKV_GATE_RANK, C_B), RWKV_GATE_RANK ** -0.5),
        'rwkv_k_k': 0.85 + nrm((L, C_B), 0.02),
        'rwkv_k_a': gain((L, C_B)),
        'rwkv_r_k': nrm((L, RWKV_HEADS, RWKV_HEAD_DIM), 0.1),
        'rwkv_ln_w': gain((L, C_B)),
        'rwkv_ln_b': nrm((L, C_B), 0.01),
        'vres_w_down': nrm((V, D_MODEL, RWKV_VRES_RANK), D_MODEL ** -0.5),
        'vres_mu': unif((V, RWKV_VRES_RANK)),
        'vres_v0': 1.0 + nrm((V, C_B), 0.1),
        'vres_v2': nrm((V, RWKV_VRES_RANK, C_B), 0.5 * RWKV_VRES_RANK ** -0.5),
        'mla_q_norm': gain((L, DSA_Q_RANK)),
        'mla_kv_norm': gain((L, DSA_KV_RANK)),
        'mla_w_uq': nrm((L, DSA_Q_RANK, DSA_HEADS * (DSA_NOPE_DIM + DSA_ROPE_DIM)), DSA_Q_RANK ** -0.5),
        'mla_w_uk': nrm((L, DSA_HEADS, DSA_KV_RANK, DSA_NOPE_DIM), DSA_NOPE_DIM ** -0.5),
        'mla_w_uv': nrm((L, DSA_HEADS, DSA_KV_RANK, DSA_V_DIM), DSA_KV_RANK ** -0.5),
        'idx_w_q': nrm((L, DSA_Q_RANK, IDX_HEADS * IDX_DIM), DSA_Q_RANK ** -0.5),
        'idx_k_norm_w': gain((L, IDX_DIM)),
        'idx_k_norm_b': nrm((L, IDX_DIM), 0.01),
        'w_proj_a': nrm((L, C_A, D_MODEL), C_A ** -0.5),
        'w_proj_b': nrm((L, C_B, D_MODEL), C_B ** -0.5),
        'w_proj_c': nrm((L, C_C, D_MODEL), C_C ** -0.5),
        'w_out': nrm((L, D_MODEL, D_MODEL), D_MODEL ** -0.5),
        'norm_ffn': gain((L, D_MODEL)),
        'router_w_group': nrm((L, D_MODEL, N_GROUPS), D_MODEL ** -0.5),
        'router_b_group': nrm((L, N_GROUPS), 0.01),
        'router_w_expert': nrm((L, D_MODEL, N_EXPERTS), D_MODEL ** -0.5),
        'router_b_expert': nrm((L, N_EXPERTS), 0.01),
        'expert_w1': nrm((L, N_EXPERTS, D_MODEL, EXPERT_HIDDEN), D_MODEL ** -0.5),
        'expert_w3': nrm((L, N_EXPERTS, D_MODEL, EXPERT_HIDDEN), D_MODEL ** -0.5),
        'expert_w2': nrm((L, N_EXPERTS, EXPERT_HIDDEN, D_MODEL), EXPERT_HIDDEN ** -0.5),
        'norm_final': gain((D_MODEL,)),
    }


def reference(x, meta_tokens, norm_mix, w_in, mu_shift, pool_w, pool_scale,
              rwkv_w0, rwkv_w2, rwkv_a0, rwkv_a2, rwkv_g2, rwkv_k_k, rwkv_k_a, rwkv_r_k,
              rwkv_ln_w, rwkv_ln_b, vres_w_down, vres_mu, vres_v0, vres_v2,
              mla_q_norm, mla_kv_norm, mla_w_uq, mla_w_uk, mla_w_uv,
              idx_w_q, idx_k_norm_w, idx_k_norm_b,
              w_proj_a, w_proj_b, w_proj_c, w_out, norm_ffn,
              router_w_group, router_b_group, router_w_expert, router_b_expert,
              expert_w1, expert_w3, expert_w2, norm_final):
    B, S, D = x.shape
    T = S + N_META
    topk = min(MAX_TOPK, S // 4)
    pos = jnp.arange(T, dtype=jnp.int32)
    h = jnp.concatenate([jnp.broadcast_to(meta_tokens[None].astype(x.dtype), (B, N_META, D)), x], axis=1)
    o0 = N_BRANCHES * D_MODEL
    o1 = o0 + C_A
    o2 = o1 + C_SHIFT
    o3 = o2 + C_DSA_IN
    v_first = None
    for l in range(DEPTH):
        u = rms_norm(h, norm_mix[l])
        w_cat = w_in[l] if l == 0 else jnp.concatenate([w_in[l], vres_w_down[l - 1]], axis=1)
        p = u @ w_cat
        gates = jax.nn.sigmoid(p[..., :o0].astype(jnp.float32)).reshape(B, T, N_BRANCHES, D_MODEL)
        pb = token_shift(p[..., o1:o2], mu_shift[l])
        vres = None if l == 0 else (token_shift(p[..., o3:], vres_mu[l - 1]), vres_v0[l - 1], vres_v2[l - 1])
        y_a = pool_mixer(p[..., o0:o1], pool_w[l], pool_scale[l])
        y_b, v_first = rwkv7_mixer(pb, vres, v_first, rwkv_w0[l], rwkv_w2[l], rwkv_a0[l], rwkv_a2[l],
                                   rwkv_g2[l], rwkv_k_k[l], rwkv_k_a[l], rwkv_r_k[l], rwkv_ln_w[l], rwkv_ln_b[l])
        y_c = dsa_mixer(p[..., o2:o3], pos, topk, mla_q_norm[l], mla_kv_norm[l], mla_w_uq[l], mla_w_uk[l],
                        mla_w_uv[l], idx_w_q[l], idx_k_norm_w[l], idx_k_norm_b[l])
        merged = (gates[:, :, 0] * (y_a @ w_proj_a[l]) + gates[:, :, 1] * (y_b @ w_proj_b[l])
                  + gates[:, :, 2] * (y_c @ w_proj_c[l]))
        h = h + merged.astype(h.dtype) @ w_out[l]
        h = h + hier_moe(rms_norm(h, norm_ffn[l]), router_w_group[l], router_b_group[l], router_w_expert[l],
                         router_b_expert[l], expert_w1[l], expert_w3[l], expert_w2[l])
    return rms_norm(h, norm_final)[:, N_META:]
```

```cpp
#include <hip/hip_runtime.h>
#include <hip/hip_cooperative_groups.h>
#include <cstdio>
#include <cstdint>
namespace cg = cooperative_groups;

typedef unsigned short bf16_t;
typedef short bf16x8 __attribute__((ext_vector_type(8)));
typedef float f32x4 __attribute__((ext_vector_type(4)));

constexpr int NB = 8, SEQ = 2048, NMETA = 16, TS = 2064, DM = 1024;
constexpr int NT = NB * TS;
constexpr int NTP = 16640;
constexpr int NTHR = 512;
constexpr int CIN = 7912;
constexpr int NP1 = 4992;
constexpr int PM_LD = 896;
constexpr int PM_WD = 0, PM_AD = 64, PM_GD = 128, PM_VD = 256, PM_CQ = 320, PM_CKV = 576, PM_KROPE = 704, PM_KIDX = 736, PM_WIDX = 800;
constexpr int LDS_BYTES = 140 * 1024;

constexpr size_t AL(size_t x) { return (x + 255) & ~(size_t)255; }
constexpr size_t SZ_ACT = (size_t)NTP * 1024 * 2;
constexpr size_t OFF_CTL = 0;
constexpr size_t OFF_RSTD = 4096;
constexpr size_t OFF_ROPE = OFF_RSTD + AL((size_t)NTP * 4);
constexpr size_t OFF_H = OFF_ROPE + AL((size_t)TS * 16 * 4 * 2);
constexpr size_t OFF_WB = OFF_H + SZ_ACT;
constexpr size_t WB_WIN = 0;
constexpr size_t WB_WG = WB_WIN + (size_t)NP1 * 1024;
constexpr size_t WB_PA = WB_WG + (size_t)3072 * 1024;
constexpr size_t WB_WO = WB_PA + (size_t)3 * 1024 * 1024;
constexpr size_t WB_POOL = WB_WO + (size_t)1024 * 1024;
constexpr size_t WB_END = WB_POOL + (size_t)4 * 256 * 256;
constexpr size_t OFF_PPOOL = OFF_WB + AL(WB_END * 2);
constexpr size_t OFF_PK = OFF_PPOOL + SZ_ACT;
constexpr size_t OFF_PR = OFF_PK + SZ_ACT;
constexpr size_t OFF_PV = OFF_PR + SZ_ACT;
constexpr size_t OFF_PMISC = OFF_PV + SZ_ACT;
constexpr size_t OFF_VFIRST = OFF_PMISC + AL((size_t)NTP * PM_LD * 2);
constexpr size_t OFF_HALO = OFF_VFIRST + SZ_ACT;
constexpr size_t OFF_LIST = OFF_HALO + AL((size_t)130 * 16 * 1024 * 2);
constexpr size_t OFF_PW = OFF_LIST + AL((size_t)24 * NT * 4);
constexpr size_t WS_END = OFF_PW + AL((size_t)NT * 2 * 4);
constexpr size_t OFF_MERGED = OFF_PK;
constexpr size_t OFF_HM32 = OFF_PR;
constexpr size_t OFF_HN = OFF_PPOOL;
constexpr size_t OFF_WEXP = OFF_PMISC;
constexpr size_t WE_W1 = 0, WE_W3 = (size_t)16 * 256 * 1024, WE_W2 = (size_t)2 * 16 * 256 * 1024;
static_assert((size_t)3 * 16 * 256 * 1024 * 2 <= (size_t)NTP * PM_LD * 2, "expert weights must fit in Pmisc");
constexpr size_t DO_YC = 0;
constexpr size_t DO_CQN = DO_YC + SZ_ACT;
constexpr size_t DO_KV = DO_CQN + AL((size_t)NT * 256 * 2);
constexpr size_t DO_KIDX = DO_KV + AL((size_t)NT * 160 * 2);
constexpr size_t DO_WHEAD = DO_KIDX + AL((size_t)NT * 64 * 2);
constexpr size_t DO_END = DO_WHEAD + AL((size_t)NT * 8 * 4);
constexpr size_t DO_HID = DO_YC;
static_assert(DO_END <= (size_t)NB * SEQ * DM * 4, "d_out scratch overflow");
static_assert((size_t)(129 + 24) * 128 * 512 * 2 <= SZ_ACT, "hid fits");
static_assert(WS_END <= 277240096ull, "workspace overflow");

struct Params {
    const float* in[42];
    float* out;
    unsigned char* ws;
};

__device__ __forceinline__ int otid() { int t = threadIdx.x; asm volatile("" : "+v"(t)); return t; }
__device__ __forceinline__ int obid() { int b = blockIdx.x; asm volatile("" : "+s"(b)); return b; }
__device__ __forceinline__ unsigned char* WS(const Params& p) { unsigned char* w = p.ws; asm volatile("" : "+s"(w)); return w; }
__device__ __forceinline__ unsigned char* OUTB(const Params& p) { unsigned char* w = (unsigned char*)p.out; asm volatile("" : "+s"(w)); return w; }
__device__ __forceinline__ float bf2f(bf16_t v) { return __uint_as_float(((unsigned)v) << 16); }
__device__ __forceinline__ bf16_t f2bf(float f) { unsigned u = __float_as_uint(f); u += 0x7FFFu + ((u >> 16) & 1u); return (bf16_t)(u >> 16); }
__device__ __forceinline__ float wave_sum(float v) {
#pragma unroll
    for (int o = 32; o > 0; o >>= 1) v += __shfl_xor(v, o);
    return v;
}
__device__ __forceinline__ float sigmoidf_(float x) { return 1.0f / (1.0f + __expf(-x)); }
__device__ __forceinline__ float softplusf_(float z) { return fmaxf(z, 0.f) + log1pf(__expf(-fabsf(z))); }
__device__ __forceinline__ void glds16(const void* g, void* l) {
    __builtin_amdgcn_global_load_lds((const unsigned*)g, (unsigned*)l, 16, 0, 0);
}

__device__ __forceinline__ void gemm_kloop(f32x4 (&acc)[2][4], const bf16_t* arow, const bf16_t* brow, int K, unsigned char* lds) {
    const int tid = otid(), lane = tid & 63, wid = tid >> 6, wr = wid >> 1, wc = wid & 1, fr = lane & 15, fq = lane >> 4;
    const int nk = K >> 5;
    glds16(arow, lds + tid * 16);
    glds16(brow, lds + 8192 + tid * 16);
    for (int t = 0; t < nk; ++t) {
        asm volatile("s_waitcnt vmcnt(0)" ::: "memory");
        __syncthreads();
        unsigned char* cA = lds + (t & 1) * 16384;
        unsigned char* cB = cA + 8192;
        if (t + 1 < nk) {
            unsigned char* nA = lds + ((t + 1) & 1) * 16384;
            glds16(arow + (t + 1) * 32, nA + tid * 16);
            glds16(brow + (t + 1) * 32, nA + 8192 + tid * 16);
        }
        bf16x8 a[2], b[4];
#pragma unroll
        for (int m = 0; m < 2; ++m) a[m] = *(const bf16x8*)(cA + (wr * 32 + m * 16 + fr) * 64 + fq * 16);
#pragma unroll
        for (int n = 0; n < 4; ++n) b[n] = *(const bf16x8*)(cB + (wc * 64 + n * 16 + fr) * 64 + fq * 16);
#pragma unroll
        for (int m = 0; m < 2; ++m)
#pragma unroll
            for (int n = 0; n < 4; ++n) acc[m][n] = __builtin_amdgcn_mfma_f32_16x16x32_bf16(a[m], b[n], acc[m][n], 0, 0, 0);
    }
    __syncthreads();
}
__device__ __forceinline__ void zero_acc(f32x4 (&acc)[2][4]) {
#pragma unroll
    for (int m = 0; m < 2; ++m)
#pragma unroll
        for (int n = 0; n < 4; ++n) acc[m][n] = (f32x4){0.f, 0.f, 0.f, 0.f};
}

__device__ void phase_embed(const Params& p) {
    const int lane = otid() & 63;
    const int wave = (obid() * NTHR + otid()) >> 6, nw = gridDim.x * NTHR / 64;
    bf16_t* h = (bf16_t*)(WS(p) + OFF_H);
    float* rstd = (float*)(WS(p) + OFF_RSTD);
    for (int n = wave; n < NTP; n += nw) {
        if (n < NT) {
            const int b = n / TS, t = n % TS;
            const float* src = t < NMETA ? p.in[1] + (size_t)t * DM : p.in[0] + ((size_t)b * SEQ + (t - NMETA)) * DM;
            float ss = 0.f;
#pragma unroll
            for (int i = 0; i < 4; ++i) {
                const float4 v = *(const float4*)(src + i * 256 + lane * 4);
                ss += v.x * v.x + v.y * v.y + v.z * v.z + v.w * v.w;
                ushort4 o; o.x = f2bf(v.x); o.y = f2bf(v.y); o.z = f2bf(v.z); o.w = f2bf(v.w);
                *(ushort4*)(h + (size_t)n * DM + i * 256 + lane * 4) = o;
            }
            ss = wave_sum(ss);
            if (lane == 0) rstd[n] = rsqrtf(ss * (1.0f / 1024.0f) + 1e-6f);
        } else {
#pragma unroll
            for (int i = 0; i < 4; ++i) *(ushort4*)(h + (size_t)n * DM + i * 256 + lane * 4) = make_ushort4(0, 0, 0, 0);
            if (lane == 0) rstd[n] = 0.f;
        }
    }
    float* ctab = (float*)(WS(p) + OFF_ROPE);
    float* stab = ctab + TS * 16;
    for (int idx = obid() * NTHR + otid(); idx < TS * 16; idx += gridDim.x * NTHR) {
        const int t = idx >> 4, i = idx & 15;
        const float inv = powf(10000.0f, -(float)(2 * i) / 32.0f);
        const float ang = (float)t * inv;
        ctab[idx] = cosf(ang);
        stab[idx] = sinf(ang);
    }
}

__device__ void phase_rowstat(const Params& p) {
    const int lane = otid() & 63;
    const int wave = (obid() * NTHR + otid()) >> 6, nw = gridDim.x * NTHR / 64;
    const float* hm = (const float*)(WS(p) + OFF_HM32);
    float* rstd = (float*)(WS(p) + OFF_RSTD);
    for (int n = wave; n < NT; n += nw) {
        float ss = 0.f;
#pragma unroll
        for (int i = 0; i < 4; ++i) {
            const float4 v = *(const float4*)(hm + (size_t)n * DM + i * 256 + lane * 4);
            ss += v.x * v.x + v.y * v.y + v.z * v.z + v.w * v.w;
        }
        ss = wave_sum(ss);
        if (lane == 0) rstd[n] = rsqrtf(ss * (1.0f / 1024.0f) + 1e-6f);
    }
}

struct ConvJob { const float* src; bf16_t* dst; const float* scale; int ldsrc, K, nvalid, nrows, nb; size_t sbs, dbs; };
__device__ __forceinline__ int conv_job_tiles(const ConvJob& j) { return j.nb * (j.nrows >> 6) * (j.K >> 6); }
__device__ void conv_tile(const ConvJob& j, int tile, float* lds) {
    const int per = (j.nrows >> 6) * (j.K >> 6);
    const int bi = tile / per, rem = tile % per;
    const int ktiles = j.K >> 6;
    const int n0 = (rem / ktiles) << 6, k0 = (rem % ktiles) << 6;
    const int tid = otid(), tn = tid & 63, tk = tid >> 6;
    const float* src = j.src + (size_t)bi * j.sbs;
    bf16_t* dst = j.dst + (size_t)bi * j.dbs;
#pragma unroll
    for (int kk = 0; kk < 8; ++kk) {
        const int k = k0 + tk * 8 + kk;
        float v = 0.f;
        if (n0 + tn < j.nvalid) { v = src[(size_t)k * j.ldsrc + n0 + tn]; if (j.scale) v *= j.scale[k]; }
        lds[tn * 65 + tk * 8 + kk] = v;
    }
    __syncthreads();
    const int wn = tid >> 3, kq = tid & 7;
    uint4 o;
    unsigned w[4];
#pragma unroll
    for (int q = 0; q < 4; ++q) {
        const float lo = lds[wn * 65 + kq * 8 + 2 * q], hi = lds[wn * 65 + kq * 8 + 2 * q + 1];
        w[q] = (unsigned)f2bf(lo) | ((unsigned)f2bf(hi) << 16);
    }
    o.x = w[0]; o.y = w[1]; o.z = w[2]; o.w = w[3];
    *(uint4*)(dst + (size_t)(n0 + wn) * j.K + k0 + kq * 8) = o;
    __syncthreads();
}
__device__ ConvJob get_job_early(const Params& p, int l, int ji) {
    bf16_t* wb = (bf16_t*)(WS(p) + OFF_WB);
    const float* win = p.in[3] + (size_t)l * DM * CIN;
    const float* nm = p.in[2] + (size_t)l * DM;
    ConvJob j{}; j.nb = 1; j.sbs = 0; j.dbs = 0; j.K = 1024; j.ldsrc = CIN; j.scale = nm;
    switch (ji) {
    case 0: j.src = win + 3072; j.dst = wb + WB_WIN; j.nvalid = 4352; j.nrows = 4352; break;
    case 1: j.src = p.in[17]; j.ldsrc = 32; j.dst = wb + WB_WIN + (size_t)(4096 + PM_VD) * 1024; j.nvalid = (l == 0 ? 0 : 32); j.nrows = 64; break;
    case 2: j.src = win + 7424; j.dst = wb + WB_WIN + (size_t)(4096 + PM_CQ) * 1024; j.nvalid = 488; j.nrows = 576; break;
    case 3: j.src = win; j.dst = wb + WB_WG; j.nvalid = 3072; j.nrows = 3072; break;
    case 4: j.src = p.in[29] + (size_t)l * DM * DM; j.ldsrc = 1024; j.scale = nullptr; j.dst = wb + WB_PA; j.nvalid = 1024; j.nrows = 1024; break;
    case 5: j.src = p.in[30] + (size_t)l * DM * DM; j.ldsrc = 1024; j.scale = nullptr; j.dst = wb + WB_PA + (size_t)1024 * 1024; j.nvalid = 1024; j.nrows = 1024; break;
    case 6: j.src = p.in[31] + (size_t)l * DM * DM; j.ldsrc = 1024; j.scale = nullptr; j.dst = wb + WB_PA + (size_t)2 * 1024 * 1024; j.nvalid = 1024; j.nrows = 1024; break;
    case 7: j.src = p.in[32] + (size_t)l * DM * DM; j.ldsrc = 1024; j.scale = nullptr; j.dst = wb + WB_WO; j.nvalid = 1024; j.nrows = 1024; break;
    default: j.src = p.in[5] + (size_t)l * 4 * 256 * 256; j.ldsrc = 256; j.K = 256; j.scale = nullptr; j.dst = wb + WB_POOL; j.nvalid = 256; j.nrows = 256; j.nb = 4; j.sbs = 65536; j.dbs = 65536; break;
    }
    return j;
}
__device__ ConvJob get_job_late(const Params& p, int l, int ji) {
    bf16_t* we = (bf16_t*)(WS(p) + OFF_WEXP);
    ConvJob j{}; j.nb = 16; j.scale = nullptr; j.sbs = 262144; j.dbs = 262144;
    switch (ji) {
    case 0: j.src = p.in[38] + (size_t)l * 16 * 262144; j.dst = we + WE_W1; j.ldsrc = 256; j.K = 1024; j.nvalid = 256; j.nrows = 256; break;
    case 1: j.src = p.in[39] + (size_t)l * 16 * 262144; j.dst = we + WE_W3; j.ldsrc = 256; j.K = 1024; j.nvalid = 256; j.nrows = 256; break;
    default: j.src = p.in[40] + (size_t)l * 16 * 262144; j.dst = we + WE_W2; j.ldsrc = 1024; j.K = 256; j.nvalid = 1024; j.nrows = 1024; break;
    }
    return j;
}
template <bool LATE>
__device__ void phase_convert(const Params& p, int l, unsigned char* lds) {
    const int njobs = LATE ? 3 : 9;
    int base = 0;
    for (int ji = 0; ji < njobs; ++ji) {
        const ConvJob j = LATE ? get_job_late(p, l, ji) : get_job_early(p, l, ji);
        const int nt = conv_job_tiles(j);
        int first = ((int)obid() - base) % (int)gridDim.x; if (first < 0) first += gridDim.x;
        for (int t = first; t < nt; t += gridDim.x) conv_tile(j, t, (float*)lds);
        base += nt;
    }
}

__device__ void phase_inproj(const Params& p, unsigned char* lds) {
    const int tid = otid(), lane = tid & 63, wid = tid >> 6, wr = wid >> 1, wc = wid & 1, fr = lane & 15, fq = lane >> 4;
    const bf16_t* h = (const bf16_t*)(WS(p) + OFF_H);
    const bf16_t* wt = (const bf16_t*)(WS(p) + OFF_WB) + WB_WIN;
    const float* rstd = (const float*)(WS(p) + OFF_RSTD);
    bf16_t* halo = (bf16_t*)(WS(p) + OFF_HALO);
    constexpr int NTN = NP1 / 128;
    for (int tile = obid(); tile < 129 * NTN; tile += gridDim.x) {
        const int mt = tile / NTN, nt = tile % NTN;
        const int row0 = mt * 128, col0 = nt * 128;
        f32x4 acc[2][4]; zero_acc(acc);
        gemm_kloop(acc, h + (size_t)(row0 + (tid >> 2)) * DM + (tid & 3) * 8, wt + (size_t)(col0 + (tid >> 2)) * DM + (tid & 3) * 8, DM, lds);
        bf16_t* dst; int ld, cbase;
        if (nt < 8) { dst = (bf16_t*)(WS(p) + OFF_PPOOL); ld = 1024; cbase = 0; }
        else if (nt < 16) { dst = (bf16_t*)(WS(p) + OFF_PR); ld = 1024; cbase = 1024; }
        else if (nt < 24) { dst = (bf16_t*)(WS(p) + OFF_PK); ld = 1024; cbase = 2048; }
        else if (nt < 32) { dst = (bf16_t*)(WS(p) + OFF_PV); ld = 1024; cbase = 3072; }
        else { dst = (bf16_t*)(WS(p) + OFF_PMISC); ld = PM_LD; cbase = 4096; }
#pragma unroll
        for (int m = 0; m < 2; ++m)
#pragma unroll
            for (int j = 0; j < 4; ++j) {
                const int lr = wr * 32 + m * 16 + fq * 4 + j;
                const int row = row0 + lr;
                const float rs = rstd[row];
#pragma unroll
                for (int n = 0; n < 4; ++n) {
                    const int col = col0 + wc * 64 + n * 16 + fr;
                    const bf16_t v = f2bf(acc[m][n][j] * rs);
                    dst[(size_t)row * ld + (col - cbase)] = v;
                    if (nt < 8 && lr >= 112) halo[((size_t)mt * 16 + (lr - 112)) * 1024 + col] = v;
                }
            }
    }
}

__device__ void phase_pool(const Params& p, int l, unsigned char* lds) {
    const int tid = otid(), lane = tid & 63, wid = tid >> 6, fr = lane & 15, fq = lane >> 4;
    bf16_t* pp = (bf16_t*)(WS(p) + OFF_PPOOL);
    const bf16_t* halo = (const bf16_t*)(WS(p) + OFF_HALO);
    const bf16_t* pw = (const bf16_t*)(WS(p) + OFF_WB) + WB_POOL;
    const float* scale = p.in[6] + (size_t)l * 1024;
    bf16_t* sp = (bf16_t*)lds;
    constexpr int SLD = 264;
    for (int tile = obid(); tile < 129 * 4; tile += gridDim.x) {
        const int mt = tile >> 2, g = tile & 3;
        const int row0 = mt * 128, w = 2 << g;
        for (int e = tid; e < 128 * 256; e += NTHR) {
            const int r = e >> 8, c = e & 255;
            const int n = row0 + r, t = n % TS;
            const int col = g * 256 + c;
            const int cnt = (t + 1 < w) ? (t + 1) : w;
            float s = 0.f, self = 0.f;
            for (int i = 0; i < cnt; ++i) {
                const int n2 = n - i;
                float v;
                if (n2 >= row0) v = bf2f(pp[(size_t)n2 * 1024 + col]);
                else v = bf2f(halo[((size_t)(n2 >> 7) * 16 + ((n2 & 127) - 112)) * 1024 + col]);
                if (i == 0) self = v;
                s += v;
            }
            sp[r * SLD + c] = f2bf(s / (float)cnt - self);
        }
        __syncthreads();
        f32x4 acc[8][2];
#pragma unroll
        for (int m = 0; m < 8; ++m) { acc[m][0] = (f32x4){0.f, 0.f, 0.f, 0.f}; acc[m][1] = (f32x4){0.f, 0.f, 0.f, 0.f}; }
        const bf16_t* wg = pw + (size_t)g * 65536;
#pragma unroll 1
        for (int kk = 0; kk < 8; ++kk) {
            bf16x8 bfr[2];
#pragma unroll
            for (int n = 0; n < 2; ++n) bfr[n] = *(const bf16x8*)(wg + (size_t)(wid * 32 + n * 16 + fr) * 256 + kk * 32 + fq * 8);
#pragma unroll
            for (int m = 0; m < 8; ++m) {
                const bf16x8 a = *(const bf16x8*)(sp + (m * 16 + fr) * SLD + kk * 32 + fq * 8);
                acc[m][0] = __builtin_amdgcn_mfma_f32_16x16x32_bf16(a, bfr[0], acc[m][0], 0, 0, 0);
                acc[m][1] = __builtin_amdgcn_mfma_f32_16x16x32_bf16(a, bfr[1], acc[m][1], 0, 0, 0);
            }
        }
#pragma unroll
        for (int m = 0; m < 8; ++m)
#pragma unroll
            for (int n = 0; n < 2; ++n) {
                const int col = g * 256 + wid * 32 + n * 16 + fr;
                const float sc = scale[col];
#pragma unroll
                for (int j = 0; j < 4; ++j) {
                    const int row = row0 + m * 16 + fq * 4 + j;
                    pp[(size_t)row * 1024 + col] = f2bf(acc[m][n][j] * sc);
                }
            }
        __syncthreads();
    }
}

__device__ void phase_dsa_prep(const Params& p, int l) {
    const int lane = otid() & 63;
    const int wave = (obid() * NTHR + otid()) >> 6, nw = gridDim.x * NTHR / 64;
    const bf16_t* pm = (const bf16_t*)(WS(p) + OFF_PMISC);
    unsigned char* dob = OUTB(p);
    bf16_t* cqn = (bf16_t*)(dob + DO_CQN);
    bf16_t* kv = (bf16_t*)(dob + DO_KV);
    bf16_t* kidx = (bf16_t*)(dob + DO_KIDX);
    float* whead = (float*)(dob + DO_WHEAD);
    const float* ctab = (const float*)(WS(p) + OFF_ROPE);
    const float* stab = ctab + TS * 16;
    const float* qn = p.in[21] + l * 256;
    const float* kvn = p.in[22] + l * 128;
    const float* inw = p.in[27] + l * 64;
    const float* inb = p.in[28] + l * 64;
    for (int n = wave; n < NT; n += nw) {
        const int t = n % TS;
        const bf16_t* row = pm + (size_t)n * PM_LD;
        {
            float v[4]; float ss = 0.f;
#pragma unroll
            for (int i = 0; i < 4; ++i) { v[i] = bf2f(row[PM_CQ + lane * 4 + i]); ss += v[i] * v[i]; }
            ss = wave_sum(ss);
            const float rs = rsqrtf(ss * (1.0f / 256.0f) + 1e-6f);
#pragma unroll
            for (int i = 0; i < 4; ++i) cqn[(size_t)n * 256 + lane * 4 + i] = f2bf(v[i] * rs * qn[lane * 4 + i]);
        }
        {
            float v[2]; float ss = 0.f;
#pragma unroll
            for (int i = 0; i < 2; ++i) { v[i] = bf2f(row[PM_CKV + lane * 2 + i]); ss += v[i] * v[i]; }
            ss = wave_sum(ss);
            const float rs = rsqrtf(ss * (1.0f / 128.0f) + 1e-6f);
#pragma unroll
            for (int i = 0; i < 2; ++i) kv[(size_t)n * 160 + lane * 2 + i] = f2bf(v[i] * rs * kvn[lane * 2 + i]);
        }
        if (lane < 16) {
            const float x1 = bf2f(row[PM_KROPE + lane]), x2 = bf2f(row[PM_KROPE + 16 + lane]);
            const float c = ctab[t * 16 + lane], s = stab[t * 16 + lane];
            kv[(size_t)n * 160 + 128 + lane] = f2bf(x1 * c - x2 * s);
            kv[(size_t)n * 160 + 144 + lane] = f2bf(x2 * c + x1 * s);
        }
        {
            const float x = bf2f(row[PM_KIDX + lane]);
            const float mu = wave_sum(x) * (1.0f / 64.0f);
            const float d = x - mu;
            const float var = wave_sum(d * d) * (1.0f / 64.0f);
            const float y = d * rsqrtf(var + 1e-6f) * inw[lane] + inb[lane];
            const float yo = __shfl_xor(y, 16);
            float o = y;
            if (lane < 32) {
                const int i = lane & 15;
                const float c = ctab[t * 16 + i], s = stab[t * 16 + i];
                o = (lane < 16) ? (y * c - yo * s) : (y * c + yo * s);
            }
            kidx[(size_t)n * 64 + lane] = f2bf(o);
        }
        if (lane < 8) whead[(size_t)n * 8 + lane] = bf2f(row[PM_WIDX + lane]) * 0.04419417382415922f;
    }
}

__device__ void phase_scan(const Params& p, int l, unsigned char* lds) {
    if (obid() >= NB * 16) return;
    const int tid = otid(), lane = tid & 63, wid = tid >> 6;
    const int b = obid() >> 4, hh = obid() & 15, hc = hh * 64;
    constexpr int TC = 16;
    float* s_r = (float*)lds;
    float* s_w = s_r + TC * 64;
    float* s_k = s_w + TC * 64;
    float* s_v = s_k + TC * 64;
    float* s_a = s_v + TC * 64;
    float* s_b = s_a + TC * 64;
    float* s_g = s_b + TC * 64;
    float* s_o = s_g + TC * 64;
    float* s_wd = s_o + TC * 64;
    float* s_ad = s_wd + TC * 64;
    float* s_gd = s_ad + TC * 64;
    float* s_vd = s_gd + TC * 128;
    float* s_pr = s_vd + TC * 32;
    float* s_W2 = s_pr + 128;
    float* s_A2 = s_W2 + 64 * 64;
    float* s_G2 = s_A2 + 64 * 64;
    float* s_V2 = s_G2 + 128 * 64;
    bf16_t* Pr = (bf16_t*)(WS(p) + OFF_PR);
    const bf16_t* Pk = (const bf16_t*)(WS(p) + OFF_PK);
    const bf16_t* Pv = (const bf16_t*)(WS(p) + OFF_PV);
    const bf16_t* Pm = (const bf16_t*)(WS(p) + OFF_PMISC);
    bf16_t* vfirst = (bf16_t*)(WS(p) + OFF_VFIRST);
    const float* mu = p.in[4] + (size_t)l * 3328;
    const float* vmu = p.in[18];
    const float* w0 = p.in[7] + l * 1024;
    const float* a0 = p.in[9] + l * 1024;
    const float* k_k = p.in[12] + l * 1024;
    const float* k_a = p.in[13] + l * 1024;
    const float* r_k = p.in[14] + l * 1024;
    const float* ln_w = p.in[15] + l * 1024;
    const float* ln_b = p.in[16] + l * 1024;
    const float* v0 = p.in[19];
    for (int e = tid; e < 64 * 64; e += NTHR) { const int m = e >> 6, c = e & 63; s_W2[e] = p.in[8][((size_t)l * 64 + m) * 1024 + hc + c]; s_A2[e] = p.in[10][((size_t)l * 64 + m) * 1024 + hc + c]; }
    for (int e = tid; e < 128 * 64; e += NTHR) { const int m = e >> 6, c = e & 63; s_G2[e] = p.in[11][((size_t)l * 128 + m) * 1024 + hc + c]; }
    for (int e = tid; e < 32 * 64; e += NTHR) { const int m = e >> 6, c = e & 63; s_V2[e] = (l > 0) ? p.in[20][(size_t)m * 1024 + hc + c] : 0.f; }
    float S[8];
#pragma unroll
    for (int j = 0; j < 8; ++j) S[j] = 0.f;
    const int si = tid >> 3, q8 = tid & 7;
    __syncthreads();
    for (int t0 = 0, ch = 0; t0 < TS; t0 += TC, ++ch) {
        for (int e = tid; e < TC * 64; e += NTHR) {
            const int tau = e >> 6, c = e & 63, t = t0 + tau;
            const size_t n = (size_t)b * TS + t;
            const float cr = bf2f(Pr[n * 1024 + hc + c]);
            const float ck = bf2f(Pk[n * 1024 + hc + c]);
            const float cv = bf2f(Pv[n * 1024 + hc + c]);
            float prr = 0.f, prk = 0.f, prv = 0.f;
            if (t > 0) {
                prr = (tau > 0) ? bf2f(Pr[(n - 1) * 1024 + hc + c]) : s_pr[((ch + 1) & 1) * 64 + c];
                prk = bf2f(Pk[(n - 1) * 1024 + hc + c]);
                prv = bf2f(Pv[(n - 1) * 1024 + hc + c]);
            }
            if (tau == TC - 1) s_pr[(ch & 1) * 64 + c] = cr;
            s_r[e] = cr + (prr - cr) * mu[hc + c];
            s_k[e] = ck + (prk - ck) * mu[1024 + hc + c];
            s_v[e] = cv + (prv - cv) * mu[2048 + hc + c];
            const float cwd = bf2f(Pm[n * PM_LD + PM_WD + c]), cad = bf2f(Pm[n * PM_LD + PM_AD + c]);
            float pwd = 0.f, pad_ = 0.f;
            if (t > 0) { pwd = bf2f(Pm[(n - 1) * PM_LD + PM_WD + c]); pad_ = bf2f(Pm[(n - 1) * PM_LD + PM_AD + c]); }
            s_wd[e] = tanhf(cwd + (pwd - cwd) * mu[3072 + c]);
            s_ad[e] = cad + (pad_ - cad) * mu[3136 + c];
        }
        for (int e = tid; e < TC * 128; e += NTHR) {
            const int tau = e >> 7, c = e & 127, t = t0 + tau;
            const size_t n = (size_t)b * TS + t;
            const float cg_ = bf2f(Pm[n * PM_LD + PM_GD + c]);
            const float pg = (t > 0) ? bf2f(Pm[(n - 1) * PM_LD + PM_GD + c]) : 0.f;
            s_gd[e] = sigmoidf_(cg_ + (pg - cg_) * mu[3200 + c]);
        }
        if (l > 0) {
            for (int e = tid; e < TC * 32; e += NTHR) {
                const int tau = e >> 5, c = e & 31, t = t0 + tau;
                const size_t n = (size_t)b * TS + t;
                const float cvd = bf2f(Pm[n * PM_LD + PM_VD + c]);
                const float pvd = (t > 0) ? bf2f(Pm[(n - 1) * PM_LD + PM_VD + c]) : 0.f;
                s_vd[e] = cvd + (pvd - cvd) * vmu[c];
            }
        }
        __syncthreads();
        for (int e = tid; e < TC * 64; e += NTHR) {
            const int tau = e >> 6, c = e & 63, t = t0 + tau;
            const size_t n = (size_t)b * TS + t;
            float xw = w0[hc + c], xa = a0[hc + c], gg = 0.f, xv = 0.f;
#pragma unroll 8
            for (int m = 0; m < 64; ++m) { xw += s_wd[tau * 64 + m] * s_W2[m * 64 + c]; xa += s_ad[tau * 64 + m] * s_A2[m * 64 + c]; }
#pragma unroll 8
            for (int m = 0; m < 128; ++m) gg += s_gd[tau * 128 + m] * s_G2[m * 64 + c];
            const float wlog = -softplusf_(-xw) - 0.5f;
            const float decay = __expf(-__expf(wlog));
            const float a = sigmoidf_(xa);
            float vv = s_v[e];
            if (l > 0) {
                xv = v0[hc + c];
#pragma unroll 8
                for (int m = 0; m < 32; ++m) xv += s_vd[tau * 32 + m] * s_V2[m * 64 + c];
                const float vf = bf2f(vfirst[n * 1024 + hc + c]);
                vv = vv + (vf - vv) * sigmoidf_(xv);
            } else {
                vfirst[n * 1024 + hc + c] = f2bf(vv);
            }
            const float kraw = s_k[e];
            const float kkv = kraw * k_k[hc + c];
            const float nrm = sqrtf(wave_sum(kkv * kkv));
            const float kk = kkv / fmaxf(nrm, 1e-12f);
            s_w[e] = decay;
            s_a[e] = -kk;
            s_b[e] = kk * a;
            s_k[e] = kraw * (1.0f + (a - 1.0f) * k_a[hc + c]);
            s_v[e] = vv;
            s_g[e] = gg;
        }
        __syncthreads();
#pragma unroll 1
        for (int tau = 0; tau < TC; ++tau) {
            const float4 a0v = *(const float4*)(s_a + tau * 64 + q8 * 8), a1v = *(const float4*)(s_a + tau * 64 + q8 * 8 + 4);
            const float4 w0v = *(const float4*)(s_w + tau * 64 + q8 * 8), w1v = *(const float4*)(s_w + tau * 64 + q8 * 8 + 4);
            const float4 b0v = *(const float4*)(s_b + tau * 64 + q8 * 8), b1v = *(const float4*)(s_b + tau * 64 + q8 * 8 + 4);
            const float4 k0v = *(const float4*)(s_k + tau * 64 + q8 * 8), k1v = *(const float4*)(s_k + tau * 64 + q8 * 8 + 4);
            const float4 r0v = *(const float4*)(s_r + tau * 64 + q8 * 8), r1v = *(const float4*)(s_r + tau * 64 + q8 * 8 + 4);
            const float vi = s_v[tau * 64 + si];
            const float av[8] = {a0v.x, a0v.y, a0v.z, a0v.w, a1v.x, a1v.y, a1v.z, a1v.w};
            const float wv[8] = {w0v.x, w0v.y, w0v.z, w0v.w, w1v.x, w1v.y, w1v.z, w1v.w};
            const float bv[8] = {b0v.x, b0v.y, b0v.z, b0v.w, b1v.x, b1v.y, b1v.z, b1v.w};
            const float kv_[8] = {k0v.x, k0v.y, k0v.z, k0v.w, k1v.x, k1v.y, k1v.z, k1v.w};
            const float rv[8] = {r0v.x, r0v.y, r0v.z, r0v.w, r1v.x, r1v.y, r1v.z, r1v.w};
            float sa = 0.f;
#pragma unroll
            for (int j = 0; j < 8; ++j) sa += S[j] * av[j];
            sa += __shfl_xor(sa, 1); sa += __shfl_xor(sa, 2); sa += __shfl_xor(sa, 4);
            float o = 0.f;
#pragma unroll
            for (int j = 0; j < 8; ++j) { S[j] = S[j] * wv[j] + sa * bv[j] + vi * kv_[j]; o += S[j] * rv[j]; }
            o += __shfl_xor(o, 1); o += __shfl_xor(o, 2); o += __shfl_xor(o, 4);
            if (q8 == 0) s_o[tau * 64 + si] = o;
        }
        __syncthreads();
        for (int tau = wid; tau < TC; tau += 8) {
            const int c = lane, e = tau * 64 + c;
            const size_t n = (size_t)b * TS + t0 + tau;
            const float o = s_o[e];
            const float m_ = wave_sum(o) * (1.0f / 64.0f);
            const float d = o - m_;
            const float var = wave_sum(d * d) * (1.0f / 64.0f);
            const float on = d * rsqrtf(var + 64e-5f) * ln_w[hc + c] + ln_b[hc + c];
            const float bonus = wave_sum(s_r[e] * s_k[e] * r_k[hc + c]) * s_v[e];
            Pr[n * 1024 + hc + c] = f2bf((on + bonus) * s_g[e]);
        }
        __syncthreads();
    }
}

__device__ void phase_dsa_naive(const Params& p, int l, unsigned char* lds) {
    const int tid = otid(), lane = tid & 63, wid = tid >> 6;
    constexpr int QT = 4, SCL = 2080;
    float* s_cq = (float*)lds;
    float* s_q = s_cq + QT * 256;
    float* s_Q = s_q + QT * 1536;
    float* s_qi = s_Q + QT * 16 * 160;
    float* s_sc = s_qi + QT * 512;
    int* s_sel = (int*)(s_sc + QT * SCL);
    int* s_nsel = s_sel + QT * 256;
    float* s_p = (float*)(s_nsel + 16);
    float* s_ol = s_p + 16 * 256;
    float* s_wh = s_ol + 16 * 128;
    unsigned char* dob = OUTB(p);
    const bf16_t* cqn = (const bf16_t*)(dob + DO_CQN);
    const bf16_t* kv = (const bf16_t*)(dob + DO_KV);
    const bf16_t* kidx = (const bf16_t*)(dob + DO_KIDX);
    const float* whead = (const float*)(dob + DO_WHEAD);
    bf16_t* yc = (bf16_t*)(dob + DO_YC);
    const float* ctab = (const float*)(WS(p) + OFF_ROPE);
    const float* stab = ctab + TS * 16;
    const float* w_uq = p.in[23] + (size_t)l * 256 * 1536;
    const float* w_uk = p.in[24] + (size_t)l * 16 * 128 * 64;
    const float* w_uv = p.in[25] + (size_t)l * 16 * 128 * 64;
    const float* w_qi = p.in[26] + (size_t)l * 256 * 512;
    const float scale = 0.10206207261596575f;
    for (int tile = obid(); tile < NT / QT; tile += gridDim.x) {
        const int n0 = tile * QT, b = n0 / TS, t0 = n0 % TS;
        for (int e = tid; e < QT * 256; e += NTHR) s_cq[e] = bf2f(cqn[(size_t)n0 * 256 + e]);
        if (tid < QT * 8) s_wh[tid] = whead[(size_t)n0 * 8 + tid];
        __syncthreads();
        {
            float acc[3][QT];
#pragma unroll
            for (int c = 0; c < 3; ++c)
#pragma unroll
                for (int q = 0; q < QT; ++q) acc[c][q] = 0.f;
            float ai[QT];
#pragma unroll
            for (int q = 0; q < QT; ++q) ai[q] = 0.f;
            for (int i = 0; i < 256; ++i) {
                const float wa = w_uq[(size_t)i * 1536 + tid], wb_ = w_uq[(size_t)i * 1536 + 512 + tid], wc_ = w_uq[(size_t)i * 1536 + 1024 + tid];
                const float wi = w_qi[(size_t)i * 512 + tid];
#pragma unroll
                for (int q = 0; q < QT; ++q) {
                    const float c = s_cq[q * 256 + i];
                    acc[0][q] += c * wa; acc[1][q] += c * wb_; acc[2][q] += c * wc_; ai[q] += c * wi;
                }
            }
#pragma unroll
            for (int q = 0; q < QT; ++q) {
                s_q[q * 1536 + tid] = acc[0][q]; s_q[q * 1536 + 512 + tid] = acc[1][q]; s_q[q * 1536 + 1024 + tid] = acc[2][q];
                s_qi[q * 512 + tid] = ai[q];
            }
        }
        __syncthreads();
        for (int e = tid; e < QT * 16 * 16; e += NTHR) {
            const int q = e >> 8, h = (e >> 4) & 15, i = e & 15;
            const float x1 = s_q[q * 1536 + h * 96 + 64 + i], x2 = s_q[q * 1536 + h * 96 + 80 + i];
            const float c = ctab[(t0 + q) * 16 + i], s = stab[(t0 + q) * 16 + i];
            s_Q[(q * 16 + h) * 160 + 128 + i] = x1 * c - x2 * s;
            s_Q[(q * 16 + h) * 160 + 144 + i] = x2 * c + x1 * s;
        }
        {
            const int q = tid >> 7, h8 = (tid >> 4) & 7, i = tid & 15;
            const float x1 = s_qi[q * 512 + h8 * 64 + i], x2 = s_qi[q * 512 + h8 * 64 + 16 + i];
            const float c = ctab[(t0 + q) * 16 + i], s = stab[(t0 + q) * 16 + i];
            __syncthreads();
            s_qi[q * 512 + h8 * 64 + i] = x1 * c - x2 * s;
            s_qi[q * 512 + h8 * 64 + 16 + i] = x2 * c + x1 * s;
        }
        for (int id = tid; id < 16 * 128; id += NTHR) {
            const int h = id >> 7, c = id & 127;
            const float* wrow = w_uk + ((size_t)h * 128 + c) * 64;
            float acc[QT];
#pragma unroll
            for (int q = 0; q < QT; ++q) acc[q] = 0.f;
            for (int d = 0; d < 64; d += 4) {
                const float4 w4 = *(const float4*)(wrow + d);
#pragma unroll
                for (int q = 0; q < QT; ++q) {
                    const float* qq = s_q + q * 1536 + h * 96 + d;
                    acc[q] += qq[0] * w4.x + qq[1] * w4.y + qq[2] * w4.z + qq[3] * w4.w;
                }
            }
#pragma unroll
            for (int q = 0; q < QT; ++q) s_Q[(q * 16 + h) * 160 + c] = acc[q];
        }
        __syncthreads();
        const int tmax = t0 + QT - 1;
        for (int s = tid; s <= tmax; s += NTHR) {
            float kr[64];
            const bf16_t* krow = kidx + ((size_t)b * TS + s) * 64;
#pragma unroll
            for (int v8 = 0; v8 < 8; ++v8) {
                const uint4 u = *(const uint4*)(krow + v8 * 8);
                kr[v8 * 8 + 0] = __uint_as_float(u.x << 16); kr[v8 * 8 + 1] = __uint_as_float(u.x & 0xFFFF0000u);
                kr[v8 * 8 + 2] = __uint_as_float(u.y << 16); kr[v8 * 8 + 3] = __uint_as_float(u.y & 0xFFFF0000u);
                kr[v8 * 8 + 4] = __uint_as_float(u.z << 16); kr[v8 * 8 + 5] = __uint_as_float(u.z & 0xFFFF0000u);
                kr[v8 * 8 + 6] = __uint_as_float(u.w << 16); kr[v8 * 8 + 7] = __uint_as_float(u.w & 0xFFFF0000u);
            }
#pragma unroll 1
            for (int q = 0; q < QT; ++q) {
                float I = 0.f;
#pragma unroll 1
                for (int h = 0; h < 8; ++h) {
                    const float* qq = s_qi + q * 512 + h * 64;
                    float d = 0.f;
#pragma unroll
                    for (int j = 0; j < 64; ++j) d += qq[j] * kr[j];
                    I += s_wh[q * 8 + h] * fmaxf(d, 0.f);
                }
                s_sc[q * SCL + s] = I;
            }
        }
        __syncthreads();
        if (wid < QT) {
            const int q = wid, t = t0 + q, nadm = t + 1;
            const float* sc = s_sc + q * SCL;
            int* sel = s_sel + q * 256;
            if (nadm <= 256) {
                for (int i = lane; i < nadm; i += 64) sel[i] = i;
                if (lane == 0) s_nsel[q] = nadm;
            } else {
                const int nch = (nadm + 63) >> 6;
                unsigned T = 0u;
                for (int bit = 31; bit >= 0; --bit) {
                    const unsigned cand = T | (1u << bit);
                    int cnt = 0;
                    for (int c = 0; c < nch; ++c) {
                        const int s = c * 64 + lane;
                        bool ge = false;
                        if (s < nadm) { const unsigned u = __float_as_uint(sc[s]); const unsigned key = (u & 0x80000000u) ? ~u : (u | 0x80000000u); ge = key >= cand; }
                        cnt += __popcll(__ballot(ge));
                    }
                    if (cnt >= 256) T = cand;
                }
                int ngt = 0;
                for (int c = 0; c < nch; ++c) {
                    const int s = c * 64 + lane;
                    bool gt = false;
                    if (s < nadm) { const unsigned u = __float_as_uint(sc[s]); const unsigned key = (u & 0x80000000u) ? ~u : (u | 0x80000000u); gt = key > T; }
                    ngt += __popcll(__ballot(gt));
                }
                const int rties = 256 - ngt;
                int base = 0, ties = 0;
                const unsigned long long ltmask = (1ull << lane) - 1ull;
                for (int c = 0; c < nch; ++c) {
                    const int s = c * 64 + lane;
                    bool gt = false, eq = false;
                    if (s < nadm) { const unsigned u = __float_as_uint(sc[s]); const unsigned key = (u & 0x80000000u) ? ~u : (u | 0x80000000u); gt = key > T; eq = key == T; }
                    const unsigned long long em = __ballot(eq);
                    const int myrank = ties + __popcll(em & ltmask);
                    const bool take = gt || (eq && myrank < rties);
                    const unsigned long long tm = __ballot(take);
                    const int pos = base + __popcll(tm & ltmask);
                    if (take && pos < 256) sel[pos] = s;
                    base += __popcll(tm); ties += __popcll(em);
                }
                if (lane == 0) s_nsel[q] = 256;
            }
        }
        __syncthreads();
        for (int q = 0; q < QT; ++q) {
            const int nsel = s_nsel[q];
            const int* sel = s_sel + q * 256;
            {
                const int h = tid >> 5, kg = tid & 31;
                const float* qv = s_Q + (q * 16 + h) * 160;
                float mx = -INFINITY;
#pragma unroll 1
                for (int kk = 0; kk < 8; ++kk) {
                    const int ki = kg + kk * 32;
                    float sv = -INFINITY;
                    if (ki < nsel) {
                        const bf16_t* krow = kv + ((size_t)b * TS + sel[ki]) * 160;
                        float d = 0.f;
#pragma unroll 4
                        for (int v8 = 0; v8 < 20; ++v8) {
                            const uint4 u = *(const uint4*)(krow + v8 * 8);
                            const float* qq = qv + v8 * 8;
                            d += qq[0] * __uint_as_float(u.x << 16) + qq[1] * __uint_as_float(u.x & 0xFFFF0000u)
                               + qq[2] * __uint_as_float(u.y << 16) + qq[3] * __uint_as_float(u.y & 0xFFFF0000u)
                               + qq[4] * __uint_as_float(u.z << 16) + qq[5] * __uint_as_float(u.z & 0xFFFF0000u)
                               + qq[6] * __uint_as_float(u.w << 16) + qq[7] * __uint_as_float(u.w & 0xFFFF0000u);
                        }
                        sv = d * scale;
                    }
                    s_p[h * 256 + ki] = sv; mx = fmaxf(mx, sv);
                }
#pragma unroll
                for (int o = 16; o > 0; o >>= 1) mx = fmaxf(mx, __shfl_xor(mx, o));
                float sum = 0.f;
#pragma unroll 1
                for (int kk = 0; kk < 8; ++kk) { const float sv = s_p[h * 256 + kg + kk * 32]; const float e = (sv == -INFINITY) ? 0.f : __expf(sv - mx); s_p[h * 256 + kg + kk * 32] = e; sum += e; }
#pragma unroll
                for (int o = 16; o > 0; o >>= 1) sum += __shfl_xor(sum, o);
                const float inv = 1.0f / sum;
#pragma unroll 1
                for (int kk = 0; kk < 8; ++kk) s_p[h * 256 + kg + kk * 32] *= inv;
            }
            __syncthreads();
            {
                const int h = tid >> 5, c4 = tid & 31;
                float a0_ = 0.f, a1_ = 0.f, a2_ = 0.f, a3_ = 0.f;
                for (int k = 0; k < nsel; ++k) {
                    const float pk = s_p[h * 256 + k];
                    const uint2 u = *(const uint2*)(kv + ((size_t)b * TS + sel[k]) * 160 + c4 * 4);
                    a0_ += pk * __uint_as_float(u.x << 16); a1_ += pk * __uint_as_float(u.x & 0xFFFF0000u);
                    a2_ += pk * __uint_as_float(u.y << 16); a3_ += pk * __uint_as_float(u.y & 0xFFFF0000u);
                }
                float* o = s_ol + h * 128 + c4 * 4;
                o[0] = a0_; o[1] = a1_; o[2] = a2_; o[3] = a3_;
            }
            __syncthreads();
            for (int id = tid; id < 1024; id += NTHR) {
                const int h = id >> 6, v = id & 63;
                float acc = 0.f;
                for (int c = 0; c < 128; ++c) acc += s_ol[h * 128 + c] * w_uv[((size_t)h * 128 + c) * 64 + v];
                yc[(size_t)(n0 + q) * 1024 + id] = f2bf(acc);
            }
            __syncthreads();
        }
    }
}

__device__ void phase_merge(const Params& p, unsigned char* lds) {
    const int tid = otid(), lane = tid & 63, wid = tid >> 6, wr = wid >> 1, wc = wid & 1, fr = lane & 15, fq = lane >> 4;
    const bf16_t* h = (const bf16_t*)(WS(p) + OFF_H);
    const bf16_t* wb = (const bf16_t*)(WS(p) + OFF_WB);
    const float* rstd = (const float*)(WS(p) + OFF_RSTD);
    bf16_t* merged = (bf16_t*)(WS(p) + OFF_MERGED);
    const bf16_t* ysrc0 = (const bf16_t*)(WS(p) + OFF_PPOOL);
    const bf16_t* ysrc1 = (const bf16_t*)(WS(p) + OFF_PR);
    const bf16_t* ysrc2 = (const bf16_t*)(OUTB(p) + DO_YC);
    for (int tile = obid(); tile < 129 * 8; tile += gridDim.x) {
        const int mt = tile >> 3, nt = tile & 7;
        const int row0 = mt * 128, col0 = nt * 128;
        f32x4 macc[2][4]; zero_acc(macc);
#pragma unroll 1
        for (int i = 0; i < 3; ++i) {
            f32x4 ag[2][4], ay[2][4]; zero_acc(ag); zero_acc(ay);
            gemm_kloop(ag, h + (size_t)(row0 + (tid >> 2)) * DM + (tid & 3) * 8, wb + WB_WG + (size_t)(i * 1024 + col0 + (tid >> 2)) * DM + (tid & 3) * 8, DM, lds);
            const bf16_t* ys = (i == 0) ? ysrc0 : (i == 1 ? ysrc1 : ysrc2);
            gemm_kloop(ay, ys + (size_t)(row0 + (tid >> 2)) * DM + (tid & 3) * 8, wb + WB_PA + (size_t)(i * 1024 + col0 + (tid >> 2)) * DM + (tid & 3) * 8, DM, lds);
#pragma unroll
            for (int m = 0; m < 2; ++m)
#pragma unroll
                for (int j = 0; j < 4; ++j) {
                    const float rs = rstd[row0 + wr * 32 + m * 16 + fq * 4 + j];
#pragma unroll
                    for (int n = 0; n < 4; ++n) macc[m][n][j] += sigmoidf_(ag[m][n][j] * rs) * ay[m][n][j];
                }
        }
#pragma unroll
        for (int m = 0; m < 2; ++m)
#pragma unroll
            for (int j = 0; j < 4; ++j) {
                const int row = row0 + wr * 32 + m * 16 + fq * 4 + j;
#pragma unroll
                for (int n = 0; n < 4; ++n) merged[(size_t)row * 1024 + col0 + wc * 64 + n * 16 + fr] = f2bf(macc[m][n][j]);
            }
    }
}

__device__ void phase_outproj(const Params& p, unsigned char* lds) {
    const int tid = otid(), lane = tid & 63, wid = tid >> 6, wr = wid >> 1, wc = wid & 1, fr = lane & 15, fq = lane >> 4;
    const bf16_t* h = (const bf16_t*)(WS(p) + OFF_H);
    const bf16_t* wb = (const bf16_t*)(WS(p) + OFF_WB);
    const bf16_t* merged = (const bf16_t*)(WS(p) + OFF_MERGED);
    float* hm = (float*)(WS(p) + OFF_HM32);
    for (int tile = obid(); tile < 129 * 8; tile += gridDim.x) {
        const int mt = tile >> 3, nt = tile & 7;
        const int row0 = mt * 128, col0 = nt * 128;
        f32x4 acc[2][4]; zero_acc(acc);
        gemm_kloop(acc, merged + (size_t)(row0 + (tid >> 2)) * DM + (tid & 3) * 8, wb + WB_WO + (size_t)(col0 + (tid >> 2)) * DM + (tid & 3) * 8, DM, lds);
#pragma unroll
        for (int m = 0; m < 2; ++m)
#pragma unroll
            for (int j = 0; j < 4; ++j) {
                const int row = row0 + wr * 32 + m * 16 + fq * 4 + j;
#pragma unroll
                for (int n = 0; n < 4; ++n) {
                    const int col = col0 + wc * 64 + n * 16 + fr;
                    hm[(size_t)row * 1024 + col] = bf2f(h[(size_t)row * 1024 + col]) + acc[m][n][j];
                }
            }
    }
}

__device__ __constant__ int c_pair_lo[6] = {0, 0, 0, 1, 1, 2};
__device__ __constant__ int c_pair_hi[6] = {1, 2, 3, 2, 3, 3};
__device__ void phase_route(const Params& p, int l) {
    const int lane = otid() & 63;
    const int wave = (obid() * NTHR + otid()) >> 6, nw = gridDim.x * NTHR / 64;
    const float* hm = (const float*)(WS(p) + OFF_HM32);
    bf16_t* hn = (bf16_t*)(WS(p) + OFF_HN);
    const float* nf = p.in[33] + (size_t)l * 1024;
    const float* wg = p.in[34] + (size_t)l * 1024 * 4;
    const float* bg = p.in[35] + l * 4;
    const float* we = p.in[36] + (size_t)l * 1024 * 16;
    const float* be = p.in[37] + l * 16;
    int* cnt = (int*)(WS(p) + OFF_CTL);
    int* list = (int*)(WS(p) + OFF_LIST);
    float* pw = (float*)(WS(p) + OFF_PW);
    for (int n = wave; n < NT; n += nw) {
        float ss = 0.f;
#pragma unroll
        for (int i = 0; i < 4; ++i) {
            const float4 v = *(const float4*)(hm + (size_t)n * DM + i * 256 + lane * 4);
            ss += v.x * v.x + v.y * v.y + v.z * v.z + v.w * v.w;
        }
        ss = wave_sum(ss);
        const float rs = rsqrtf(ss * (1.0f / 1024.0f) + 1e-6f);
        float lg[4] = {0.f, 0.f, 0.f, 0.f};
        float le[16];
#pragma unroll
        for (int e = 0; e < 16; ++e) le[e] = 0.f;
#pragma unroll 1
        for (int i = 0; i < 4; ++i) {
            const float4 xv = *(const float4*)(hm + (size_t)n * DM + i * 256 + lane * 4);
            const float4 nv = *(const float4*)(nf + i * 256 + lane * 4);
            float y[4] = {xv.x * rs * nv.x, xv.y * rs * nv.y, xv.z * rs * nv.z, xv.w * rs * nv.w};
#pragma unroll
            for (int k = 0; k < 4; ++k) {
                const int d = i * 256 + lane * 4 + k;
                const float4 g4 = *(const float4*)(wg + (size_t)d * 4);
                lg[0] += y[k] * g4.x; lg[1] += y[k] * g4.y; lg[2] += y[k] * g4.z; lg[3] += y[k] * g4.w;
#pragma unroll
                for (int e4 = 0; e4 < 4; ++e4) {
                    const float4 w4 = *(const float4*)(we + (size_t)d * 16 + e4 * 4);
                    le[e4 * 4 + 0] += y[k] * w4.x; le[e4 * 4 + 1] += y[k] * w4.y; le[e4 * 4 + 2] += y[k] * w4.z; le[e4 * 4 + 3] += y[k] * w4.w;
                }
            }
            ushort4 o;
            o.x = f2bf(y[0]); o.y = f2bf(y[1]); o.z = f2bf(y[2]); o.w = f2bf(y[3]);
            *(ushort4*)(hn + (size_t)n * DM + i * 256 + lane * 4) = o;
        }
#pragma unroll
        for (int g = 0; g < 4; ++g) lg[g] = wave_sum(lg[g]) + bg[g];
#pragma unroll
        for (int e = 0; e < 16; ++e) le[e] = wave_sum(le[e]) + be[e];
        if (lane == 0) {
            int gs = 0; float gm = lg[0];
#pragma unroll
            for (int g = 1; g < 4; ++g) if (lg[g] > gm) { gm = lg[g]; gs = g; }
            float den = 0.f;
#pragma unroll
            for (int g = 0; g < 4; ++g) den += __expf(lg[g] - gm);
            const float pgrp = 1.0f / den;
            float v4[4];
#pragma unroll
            for (int e = 0; e < 4; ++e) {
                const float m0 = (gs == 0) ? 1.f : 0.f, m1s = (gs == 1) ? 1.f : 0.f, m2s = (gs == 2) ? 1.f : 0.f, m3s = (gs == 3) ? 1.f : 0.f;
                v4[e] = le[e] * m0 + le[4 + e] * m1s + le[8 + e] * m2s + le[12 + e] * m3s;
            }
            int i1 = 0; float m1 = v4[0];
#pragma unroll
            for (int e = 1; e < 4; ++e) if (v4[e] > m1) { m1 = v4[e]; i1 = e; }
            int i2 = -1; float m2 = -INFINITY;
#pragma unroll
            for (int e = 0; e < 4; ++e) if (e != i1 && v4[e] > m2) { m2 = v4[e]; i2 = e; }
            const float e2 = __expf(m2 - m1);
            const float p1 = pgrp / (1.0f + e2), p2 = pgrp * e2 / (1.0f + e2);
            const int lo = i1 < i2 ? i1 : i2, hi = i1 < i2 ? i2 : i1;
            const float plo = i1 < i2 ? p1 : p2, phi = i1 < i2 ? p2 : p1;
            const int pi = (lo == 0) ? (hi - 1) : (lo == 1 ? hi + 1 : 5);
            const int cls = gs * 6 + pi;
            const int pos = atomicAdd(&cnt[cls], 1);
            list[(size_t)cls * NT + pos] = n;
            pw[(size_t)n * 2 + 0] = plo; pw[(size_t)n * 2 + 1] = phi;
        }
    }
}

struct MoeTile { int cls, ti, cnt, tg; };
__device__ __forceinline__ int moe_total_tiles(const int* cnt) { int s = 0; for (int c = 0; c < 24; ++c) s += (cnt[c] + 127) >> 7; return s; }
__device__ __forceinline__ MoeTile moe_find(const int* cnt, int tile) {
    MoeTile r; int s = 0; r.cls = 0; r.ti = 0; r.cnt = 0; r.tg = tile;
    for (int c = 0; c < 24; ++c) { const int nt = (cnt[c] + 127) >> 7; if (tile >= s && tile < s + nt) { r.cls = c; r.ti = tile - s; r.cnt = cnt[c]; } s += nt; }
    return r;
}
__device__ void phase_moe1(const Params& p, unsigned char* lds) {
    const int tid = otid(), lane = tid & 63, wid = tid >> 6, wr = wid >> 1, wc = wid & 1, fr = lane & 15, fq = lane >> 4;
    const int* cnt = (const int*)(WS(p) + OFF_CTL);
    const int* list = (const int*)(WS(p) + OFF_LIST);
    const float* pw = (const float*)(WS(p) + OFF_PW);
    const bf16_t* hn = (const bf16_t*)(WS(p) + OFF_HN);
    const bf16_t* we = (const bf16_t*)(WS(p) + OFF_WEXP);
    bf16_t* hid = (bf16_t*)(OUTB(p) + DO_HID);
    const int total = moe_total_tiles(cnt);
    for (int item = obid(); item < total * 4; item += gridDim.x) {
        const MoeTile mt = moe_find(cnt, item >> 2);
        const int nt = item & 3, slot = nt >> 1, f0 = (nt & 1) * 128;
        const int g = mt.cls / 6, pi = mt.cls % 6;
        const int e = g * 4 + (slot == 0 ? c_pair_lo[pi] : c_pair_hi[pi]);
        const int* lst = list + (size_t)mt.cls * NT + mt.ti * 128;
        const int nvalid = min(128, mt.cnt - mt.ti * 128);
        const int ar = tid >> 2;
        const int tok = lst[ar < nvalid ? ar : 0];
        f32x4 a1[2][4], a3[2][4]; zero_acc(a1); zero_acc(a3);
        const bf16_t* arow = hn + (size_t)tok * DM + (tid & 3) * 8;
        gemm_kloop(a1, arow, we + WE_W1 + ((size_t)e * 256 + f0 + (tid >> 2)) * 1024 + (tid & 3) * 8, DM, lds);
        gemm_kloop(a3, arow, we + WE_W3 + ((size_t)e * 256 + f0 + (tid >> 2)) * 1024 + (tid & 3) * 8, DM, lds);
#pragma unroll
        for (int m = 0; m < 2; ++m)
#pragma unroll
            for (int j = 0; j < 4; ++j) {
                const int lr = wr * 32 + m * 16 + fq * 4 + j;
                const int tk = lst[lr < nvalid ? lr : 0];
                const float pe = pw[(size_t)tk * 2 + slot];
#pragma unroll
                for (int n = 0; n < 4; ++n) {
                    const int col = slot * 256 + f0 + wc * 64 + n * 16 + fr;
                    const float x1 = a1[m][n][j];
                    hid[((size_t)mt.tg * 128 + lr) * 512 + col] = f2bf(x1 * sigmoidf_(x1) * a3[m][n][j] * pe);
                }
            }
    }
}
__device__ void phase_moe2(const Params& p, unsigned char* lds) {
    const int tid = otid(), lane = tid & 63, wid = tid >> 6, wr = wid >> 1, wc = wid & 1, fr = lane & 15, fq = lane >> 4;
    const int* cnt = (const int*)(WS(p) + OFF_CTL);
    const int* list = (const int*)(WS(p) + OFF_LIST);
    const bf16_t* we = (const bf16_t*)(WS(p) + OFF_WEXP);
    const bf16_t* hid = (const bf16_t*)(OUTB(p) + DO_HID);
    float* hm = (float*)(WS(p) + OFF_HM32);
    bf16_t* h = (bf16_t*)(WS(p) + OFF_H);
    const int total = moe_total_tiles(cnt);
    for (int item = obid(); item < total * 8; item += gridDim.x) {
        const MoeTile mt = moe_find(cnt, item >> 3);
        const int nt = item & 7, col0 = nt * 128;
        const int g = mt.cls / 6, pi = mt.cls % 6;
        const int elo = g * 4 + c_pair_lo[pi], ehi = g * 4 + c_pair_hi[pi];
        const int* lst = list + (size_t)mt.cls * NT + mt.ti * 128;
        const int nvalid = min(128, mt.cnt - mt.ti * 128);
        f32x4 acc[2][4]; zero_acc(acc);
        const bf16_t* arow = hid + ((size_t)mt.tg * 128 + (tid >> 2)) * 512 + (tid & 3) * 8;
        gemm_kloop(acc, arow, we + WE_W2 + ((size_t)elo * 1024 + col0 + (tid >> 2)) * 256 + (tid & 3) * 8, 256, lds);
        gemm_kloop(acc, arow + 256, we + WE_W2 + ((size_t)ehi * 1024 + col0 + (tid >> 2)) * 256 + (tid & 3) * 8, 256, lds);
#pragma unroll
        for (int m = 0; m < 2; ++m)
#pragma unroll
            for (int j = 0; j < 4; ++j) {
                const int lr = wr * 32 + m * 16 + fq * 4 + j;
                if (lr < nvalid) {
                    const int tk = lst[lr];
#pragma unroll
                    for (int n = 0; n < 4; ++n) {
                        const int col = col0 + wc * 64 + n * 16 + fr;
                        const float v = hm[(size_t)tk * 1024 + col] + acc[m][n][j];
                        hm[(size_t)tk * 1024 + col] = v;
                        h[(size_t)tk * 1024 + col] = f2bf(v);
                    }
                }
            }
    }
}

__device__ void phase_final(const Params& p) {
    const int lane = otid() & 63;
    const int wave = (obid() * NTHR + otid()) >> 6, nw = gridDim.x * NTHR / 64;
    const float* hm = (const float*)(WS(p) + OFF_HM32);
    const float* nf = p.in[41];
    for (int r = wave; r < NB * SEQ; r += nw) {
        const int b = r / SEQ, s = r % SEQ;
        const size_t n = (size_t)b * TS + NMETA + s;
        float4 v[4]; float ss = 0.f;
#pragma unroll
        for (int i = 0; i < 4; ++i) { v[i] = *(const float4*)(hm + n * DM + i * 256 + lane * 4); ss += v[i].x * v[i].x + v[i].y * v[i].y + v[i].z * v[i].z + v[i].w * v[i].w; }
        ss = wave_sum(ss);
        const float rs = rsqrtf(ss * (1.0f / 1024.0f) + 1e-6f);
#pragma unroll
        for (int i = 0; i < 4; ++i) {
            const float4 g = *(const float4*)(nf + i * 256 + lane * 4);
            float4 o; o.x = v[i].x * rs * g.x; o.y = v[i].y * rs * g.y; o.z = v[i].z * rs * g.z; o.w = v[i].w * rs * g.w;
            *(float4*)((float*)OUTB(p) + (size_t)r * DM + i * 256 + lane * 4) = o;
        }
    }
}

__global__ void __launch_bounds__(NTHR) fwd_megakernel(Params p) {
    extern __shared__ __attribute__((aligned(16))) unsigned char lds[];
    cg::grid_group grid = cg::this_grid();
#pragma unroll 1
    for (int step = 0; step < 18; ++step) {
        const int l = step >= 9 ? 1 : 0;
        const int ph = step - l * 9;
        switch (ph) {
        case 0:
            if (l == 0) phase_embed(p); else phase_rowstat(p);
            phase_convert<false>(p, l, lds);
            if (obid() == 0 && otid() < 32) ((int*)(WS(p) + OFF_CTL))[otid()] = 0;
            break;
        case 1: phase_inproj(p, lds); break;
        case 2: phase_dsa_prep(p, l); phase_pool(p, l, lds); phase_scan(p, l, lds); break;
        case 3: phase_dsa_naive(p, l, lds); break;
        case 4: phase_merge(p, lds); break;
        case 5: phase_outproj(p, lds); phase_convert<true>(p, l, lds); break;
        case 6: phase_route(p, l); break;
        case 7: phase_moe1(p, lds); break;
        default: phase_moe2(p, lds); break;
        }
        grid.sync();
    }
    phase_final(p);
}

extern "C" void kernel_launch(void* const* d_in, const int* in_sizes, int n_in,
                              void* d_out, int out_size, void* d_ws, size_t ws_size,
                              hipStream_t stream) {
    static int grid_blocks = 0;
    if (grid_blocks == 0) {
        int dev = 0, cus = 0, per_cu = 0;
        (void)hipGetDevice(&dev);
        (void)hipDeviceGetAttribute(&cus, hipDeviceAttributeMultiprocessorCount, dev);
        (void)hipFuncSetAttribute((const void*)fwd_megakernel, hipFuncAttributeMaxDynamicSharedMemorySize, LDS_BYTES);
        (void)hipOccupancyMaxActiveBlocksPerMultiprocessor(&per_cu, fwd_megakernel, NTHR, LDS_BYTES);
        if (per_cu < 1 || n_in != 42 || ws_size < WS_END) { fprintf(stderr, "kernel_launch: bad config per_cu=%d n_in=%d ws=%zu need=%zu\n", per_cu, n_in, ws_size, (size_t)WS_END); grid_blocks = -1; }
        else grid_blocks = cus;
    }
    if (grid_blocks < 0) return;
    Params p{};
    for (int i = 0; i < 42; ++i) p.in[i] = (const float*)d_in[i];
    p.out = (float*)d_out;
    p.ws = (unsigned char*)d_ws;
    void* args[] = {&p};
    hipError_t e = hipLaunchCooperativeKernel((void*)fwd_megakernel, dim3(grid_blocks), dim3(NTHR), args, LDS_BYTES, stream);
    if (e != hipSuccess) fprintf(stderr, "cooperative launch failed: %s (grid %d)\n", hipGetErrorString(e), grid_blocks);
}
```

```cpp
#include <hip/hip_runtime.h>
#include <hip/hip_cooperative_groups.h>
#include <cstdio>
#include <cstdint>
namespace cg = cooperative_groups;

typedef unsigned short bf16_t;
typedef short bf16x8 __attribute__((ext_vector_type(8)));
typedef float f32x4 __attribute__((ext_vector_type(4)));

constexpr int NB = 8, SEQ = 2048, NMETA = 16, TS = 2064, DM = 1024;
constexpr int NT = NB * TS;
constexpr int NTP = 16640;
constexpr int NTHR = 512;
constexpr int CIN = 7912;
constexpr int NP1 = 4992;
constexpr int PM_LD = 896;
constexpr int PM_WD = 0, PM_AD = 64, PM_GD = 128, PM_VD = 256, PM_CQ = 320, PM_CKV = 576, PM_KROPE = 704, PM_KIDX = 736, PM_WIDX = 800;
constexpr int LDS_BYTES = 157 * 1024;

constexpr size_t AL(size_t x) { return (x + 255) & ~(size_t)255; }
constexpr size_t SZ_ACT = (size_t)NTP * 1024 * 2;
constexpr size_t OFF_CTL = 0;
constexpr size_t OFF_RSTD = 4096;
constexpr size_t OFF_ROPE = OFF_RSTD + AL((size_t)NTP * 4);
constexpr size_t OFF_H = OFF_ROPE + AL((size_t)TS * 16 * 4 * 2);
constexpr size_t OFF_WB = OFF_H + SZ_ACT;
constexpr size_t WB_WIN = 0;
constexpr size_t WB_WG = WB_WIN + (size_t)NP1 * 1024;
constexpr size_t WB_PA = WB_WG + (size_t)3072 * 1024;
constexpr size_t WB_WO = WB_PA + (size_t)3 * 1024 * 1024;
constexpr size_t WB_POOL = WB_WO + (size_t)1024 * 1024;
constexpr size_t WB_QI = WB_POOL + (size_t)4 * 256 * 256;
constexpr size_t WB_UQ = WB_QI + (size_t)512 * 256;
constexpr size_t WB_UK = WB_UQ + (size_t)1536 * 256;
constexpr size_t WB_UV = WB_UK + (size_t)16 * 128 * 64;
constexpr size_t WB_END = WB_UV + (size_t)16 * 64 * 128;
constexpr size_t OFF_PPOOL = OFF_WB + AL(WB_END * 2);
constexpr size_t OFF_PK = OFF_PPOOL + SZ_ACT;
constexpr size_t OFF_PR = OFF_PK + SZ_ACT;
constexpr size_t OFF_PV = OFF_PR + SZ_ACT;
constexpr size_t OFF_PMISC = OFF_PV + SZ_ACT;
constexpr size_t OFF_VFIRST = OFF_PMISC + AL((size_t)NTP * PM_LD * 2);
constexpr size_t OFF_HALO = OFF_VFIRST + SZ_ACT;
constexpr size_t OFF_LIST = OFF_HALO + AL((size_t)130 * 16 * 1024 * 2);
constexpr size_t OFF_PW = OFF_LIST + AL((size_t)24 * NT * 4);
constexpr size_t WS_END = OFF_PW + AL((size_t)NT * 2 * 4);
constexpr size_t OFF_MERGED = OFF_PK;
constexpr size_t OFF_HM32 = OFF_PR;
constexpr size_t OFF_HN = OFF_PPOOL;
constexpr size_t OFF_WEXP = OFF_PMISC;
constexpr size_t WE_W1 = 0, WE_W3 = (size_t)16 * 256 * 1024, WE_W2 = (size_t)2 * 16 * 256 * 1024;
static_assert((size_t)3 * 16 * 256 * 1024 * 2 <= (size_t)NTP * PM_LD * 2, "expert weights must fit in Pmisc");
constexpr size_t DO_YC = 0;
constexpr size_t DO_CQN = DO_YC + SZ_ACT;
constexpr size_t DO_KV = DO_CQN + AL((size_t)NT * 256 * 2);
constexpr size_t DO_KIDX = DO_KV + AL((size_t)NT * 160 * 2);
constexpr size_t DO_WHEAD = DO_KIDX + AL((size_t)NT * 64 * 2);
constexpr size_t DO_END = DO_WHEAD + AL((size_t)NT * 8 * 4);
constexpr size_t DO_HID = DO_YC;
static_assert(DO_END <= (size_t)NB * SEQ * DM * 4, "d_out scratch overflow");
static_assert((size_t)(129 + 24) * 128 * 512 * 2 <= SZ_ACT, "hid fits");
static_assert(WS_END <= 277240096ull, "workspace overflow");

struct Params {
    const float* in[42];
    float* out;
    unsigned char* ws;
};

__device__ __forceinline__ int otid() { int t = threadIdx.x; asm volatile("" : "+v"(t)); return t; }
__device__ __forceinline__ int obid() { int b = blockIdx.x; asm volatile("" : "+s"(b)); return b; }
__device__ __forceinline__ unsigned char* WS(const Params& p) { unsigned char* w = p.ws; asm volatile("" : "+s"(w)); return w; }
__device__ __forceinline__ unsigned char* OUTB(const Params& p) { unsigned char* w = (unsigned char*)p.out; asm volatile("" : "+s"(w)); return w; }
__device__ __forceinline__ float bf2f(bf16_t v) { return __uint_as_float(((unsigned)v) << 16); }
__device__ __forceinline__ bf16_t f2bf(float f) { unsigned u = __float_as_uint(f); u += 0x7FFFu + ((u >> 16) & 1u); return (bf16_t)(u >> 16); }
__device__ __forceinline__ float wave_sum(float v) {
#pragma unroll
    for (int o = 32; o > 0; o >>= 1) v += __shfl_xor(v, o);
    return v;
}
__device__ __forceinline__ float sigmoidf_(float x) { return 1.0f / (1.0f + __expf(-x)); }
__device__ __forceinline__ float softplusf_(float z) { return fmaxf(z, 0.f) + log1pf(__expf(-fabsf(z))); }
__device__ __forceinline__ void glds16(const void* g, void* l) {
    __builtin_amdgcn_global_load_lds((const unsigned*)g, (unsigned*)l, 16, 0, 0);
}

__device__ __forceinline__ void gemm_kloop(f32x4 (&acc)[2][4], const bf16_t* arow, const bf16_t* brow, int K, unsigned char* lds) {
    const int tid = otid(), lane = tid & 63, wid = tid >> 6, wr = wid >> 1, wc = wid & 1, fr = lane & 15, fq = lane >> 4;
    const int nk = K >> 5;
    glds16(arow, lds + tid * 16);
    glds16(brow, lds + 8192 + tid * 16);
    for (int t = 0; t < nk; ++t) {
        asm volatile("s_waitcnt vmcnt(0)" ::: "memory");
        __syncthreads();
        unsigned char* cA = lds + (t & 1) * 16384;
        unsigned char* cB = cA + 8192;
        if (t + 1 < nk) {
            unsigned char* nA = lds + ((t + 1) & 1) * 16384;
            glds16(arow + (t + 1) * 32, nA + tid * 16);
            glds16(brow + (t + 1) * 32, nA + 8192 + tid * 16);
        }
        bf16x8 a[2], b[4];
#pragma unroll
        for (int m = 0; m < 2; ++m) a[m] = *(const bf16x8*)(cA + (wr * 32 + m * 16 + fr) * 64 + fq * 16);
#pragma unroll
        for (int n = 0; n < 4; ++n) b[n] = *(const bf16x8*)(cB + (wc * 64 + n * 16 + fr) * 64 + fq * 16);
#pragma unroll
        for (int m = 0; m < 2; ++m)
#pragma unroll
            for (int n = 0; n < 4; ++n) acc[m][n] = __builtin_amdgcn_mfma_f32_16x16x32_bf16(a[m], b[n], acc[m][n], 0, 0, 0);
    }
    __syncthreads();
}
__device__ __forceinline__ void zero_acc(f32x4 (&acc)[2][4]) {
#pragma unroll
    for (int m = 0; m < 2; ++m)
#pragma unroll
        for (int n = 0; n < 4; ++n) acc[m][n] = (f32x4){0.f, 0.f, 0.f, 0.f};
}

__device__ void phase_embed(const Params& p) {
    const int lane = otid() & 63;
    const int wave = (obid() * NTHR + otid()) >> 6, nw = gridDim.x * NTHR / 64;
    bf16_t* h = (bf16_t*)(WS(p) + OFF_H);
    float* rstd = (float*)(WS(p) + OFF_RSTD);
    for (int n = wave; n < NTP; n += nw) {
        if (n < NT) {
            const int b = n / TS, t = n % TS;
            const float* src = t < NMETA ? p.in[1] + (size_t)t * DM : p.in[0] + ((size_t)b * SEQ + (t - NMETA)) * DM;
            float ss = 0.f;
#pragma unroll
            for (int i = 0; i < 4; ++i) {
                const float4 v = *(const float4*)(src + i * 256 + lane * 4);
                ss += v.x * v.x + v.y * v.y + v.z * v.z + v.w * v.w;
                ushort4 o; o.x = f2bf(v.x); o.y = f2bf(v.y); o.z = f2bf(v.z); o.w = f2bf(v.w);
                *(ushort4*)(h + (size_t)n * DM + i * 256 + lane * 4) = o;
            }
            ss = wave_sum(ss);
            if (lane == 0) rstd[n] = rsqrtf(ss * (1.0f / 1024.0f) + 1e-6f);
        } else {
#pragma unroll
            for (int i = 0; i < 4; ++i) *(ushort4*)(h + (size_t)n * DM + i * 256 + lane * 4) = make_ushort4(0, 0, 0, 0);
            if (lane == 0) rstd[n] = 0.f;
        }
    }
    float* ctab = (float*)(WS(p) + OFF_ROPE);
    float* stab = ctab + TS * 16;
    for (int idx = obid() * NTHR + otid(); idx < TS * 16; idx += gridDim.x * NTHR) {
        const int t = idx >> 4, i = idx & 15;
        const float inv = powf(10000.0f, -(float)(2 * i) / 32.0f);
        const float ang = (float)t * inv;
        ctab[idx] = cosf(ang);
        stab[idx] = sinf(ang);
    }
}

__device__ void phase_rowstat(const Params& p) {
    const int lane = otid() & 63;
    const int wave = (obid() * NTHR + otid()) >> 6, nw = gridDim.x * NTHR / 64;
    const float* hm = (const float*)(WS(p) + OFF_HM32);
    float* rstd = (float*)(WS(p) + OFF_RSTD);
    for (int n = wave; n < NT; n += nw) {
        float ss = 0.f;
#pragma unroll
        for (int i = 0; i < 4; ++i) {
            const float4 v = *(const float4*)(hm + (size_t)n * DM + i * 256 + lane * 4);
            ss += v.x * v.x + v.y * v.y + v.z * v.z + v.w * v.w;
        }
        ss = wave_sum(ss);
        if (lane == 0) rstd[n] = rsqrtf(ss * (1.0f / 1024.0f) + 1e-6f);
    }
}

struct ConvJob { const float* src; bf16_t* dst; const float* scale; int ldsrc, K, nvalid, nrows, nb, notr; size_t sbs, dbs; };
__device__ __forceinline__ int conv_job_tiles(const ConvJob& j) { return j.nb * (j.nrows >> 6) * (j.K >> 6); }
__device__ void conv_tile(const ConvJob& j, int tile, float* lds) {
    const int per = (j.nrows >> 6) * (j.K >> 6);
    const int bi = tile / per, rem = tile % per;
    const int ktiles = j.K >> 6;
    const int n0 = (rem / ktiles) << 6, k0 = (rem % ktiles) << 6;
    const int tid = otid(), tn = tid & 63, tk = tid >> 6;
    const float* src = j.src + (size_t)bi * j.sbs;
    bf16_t* dst = j.dst + (size_t)bi * j.dbs;
#pragma unroll
    for (int kk = 0; kk < 8; ++kk) {
        const int k = k0 + tk * 8 + kk;
        float v = 0.f;
        if (n0 + tn < j.nvalid) { v = j.notr ? src[(size_t)(n0 + tn) * j.ldsrc + k] : src[(size_t)k * j.ldsrc + n0 + tn]; if (j.scale) v *= j.scale[k]; }
        lds[tn * 65 + tk * 8 + kk] = v;
    }
    __syncthreads();
    const int wn = tid >> 3, kq = tid & 7;
    uint4 o;
    unsigned w[4];
#pragma unroll
    for (int q = 0; q < 4; ++q) {
        const float lo = lds[wn * 65 + kq * 8 + 2 * q], hi = lds[wn * 65 + kq * 8 + 2 * q + 1];
        w[q] = (unsigned)f2bf(lo) | ((unsigned)f2bf(hi) << 16);
    }
    o.x = w[0]; o.y = w[1]; o.z = w[2]; o.w = w[3];
    *(uint4*)(dst + (size_t)(n0 + wn) * j.K + k0 + kq * 8) = o;
    __syncthreads();
}
__device__ ConvJob get_job_early(const Params& p, int l, int ji) {
    bf16_t* wb = (bf16_t*)(WS(p) + OFF_WB);
    const float* win = p.in[3] + (size_t)l * DM * CIN;
    const float* nm = p.in[2] + (size_t)l * DM;
    ConvJob j{}; j.nb = 1; j.sbs = 0; j.dbs = 0; j.K = 1024; j.ldsrc = CIN; j.scale = nm;
    switch (ji) {
    case 0: j.src = win + 3072; j.dst = wb + WB_WIN; j.nvalid = 4352; j.nrows = 4352; break;
    case 1: j.src = p.in[17]; j.ldsrc = 32; j.dst = wb + WB_WIN + (size_t)(4096 + PM_VD) * 1024; j.nvalid = (l == 0 ? 0 : 32); j.nrows = 64; break;
    case 2: j.src = win + 7424; j.dst = wb + WB_WIN + (size_t)(4096 + PM_CQ) * 1024; j.nvalid = 488; j.nrows = 576; break;
    case 3: j.src = win; j.dst = wb + WB_WG; j.nvalid = 3072; j.nrows = 3072; break;
    case 4: j.src = p.in[29] + (size_t)l * DM * DM; j.ldsrc = 1024; j.scale = nullptr; j.dst = wb + WB_PA; j.nvalid = 1024; j.nrows = 1024; break;
    case 5: j.src = p.in[30] + (size_t)l * DM * DM; j.ldsrc = 1024; j.scale = nullptr; j.dst = wb + WB_PA + (size_t)1024 * 1024; j.nvalid = 1024; j.nrows = 1024; break;
    case 6: j.src = p.in[31] + (size_t)l * DM * DM; j.ldsrc = 1024; j.scale = nullptr; j.dst = wb + WB_PA + (size_t)2 * 1024 * 1024; j.nvalid = 1024; j.nrows = 1024; break;
    case 7: j.src = p.in[32] + (size_t)l * DM * DM; j.ldsrc = 1024; j.scale = nullptr; j.dst = wb + WB_WO; j.nvalid = 1024; j.nrows = 1024; break;
    case 8: j.src = p.in[5] + (size_t)l * 4 * 256 * 256; j.ldsrc = 256; j.K = 256; j.scale = nullptr; j.dst = wb + WB_POOL; j.nvalid = 256; j.nrows = 256; j.nb = 4; j.sbs = 65536; j.dbs = 65536; break;
    case 9: j.src = p.in[26] + (size_t)l * 256 * 512; j.ldsrc = 512; j.K = 256; j.scale = nullptr; j.dst = wb + WB_QI; j.nvalid = 512; j.nrows = 512; break;
    case 10: j.src = p.in[23] + (size_t)l * 256 * 1536; j.ldsrc = 1536; j.K = 256; j.scale = nullptr; j.dst = wb + WB_UQ; j.nvalid = 1536; j.nrows = 1536; break;
    case 11: j.src = p.in[24] + (size_t)l * 16 * 128 * 64; j.ldsrc = 64; j.K = 64; j.scale = nullptr; j.dst = wb + WB_UK; j.nvalid = 2048; j.nrows = 2048; j.notr = 1; break;
    default: j.src = p.in[25] + (size_t)l * 16 * 128 * 64; j.ldsrc = 64; j.K = 128; j.scale = nullptr; j.dst = wb + WB_UV; j.nvalid = 64; j.nrows = 64; j.nb = 16; j.sbs = 8192; j.dbs = 8192; break;
    }
    return j;
}
__device__ ConvJob get_job_late(const Params& p, int l, int ji) {
    bf16_t* we = (bf16_t*)(WS(p) + OFF_WEXP);
    ConvJob j{}; j.nb = 16; j.scale = nullptr; j.sbs = 262144; j.dbs = 262144;
    switch (ji) {
    case 0: j.src = p.in[38] + (size_t)l * 16 * 262144; j.dst = we + WE_W1; j.ldsrc = 256; j.K = 1024; j.nvalid = 256; j.nrows = 256; break;
    case 1: j.src = p.in[39] + (size_t)l * 16 * 262144; j.dst = we + WE_W3; j.ldsrc = 256; j.K = 1024; j.nvalid = 256; j.nrows = 256; break;
    default: j.src = p.in[40] + (size_t)l * 16 * 262144; j.dst = we + WE_W2; j.ldsrc = 1024; j.K = 256; j.nvalid = 1024; j.nrows = 1024; break;
    }
    return j;
}
template <bool LATE>
__device__ void phase_convert(const Params& p, int l, unsigned char* lds) {
    const int njobs = LATE ? 3 : 13;
    int base = 0;
    for (int ji = 0; ji < njobs; ++ji) {
        const ConvJob j = LATE ? get_job_late(p, l, ji) : get_job_early(p, l, ji);
        const int nt = conv_job_tiles(j);
        int first = ((int)obid() - base) % (int)gridDim.x; if (first < 0) first += gridDim.x;
        for (int t = first; t < nt; t += gridDim.x) conv_tile(j, t, (float*)lds);
        base += nt;
    }
}

__device__ void phase_inproj(const Params& p, unsigned char* lds) {
    const int tid = otid(), lane = tid & 63, wid = tid >> 6, wr = wid >> 1, wc = wid & 1, fr = lane & 15, fq = lane >> 4;
    const bf16_t* h = (const bf16_t*)(WS(p) + OFF_H);
    const bf16_t* wt = (const bf16_t*)(WS(p) + OFF_WB) + WB_WIN;
    const float* rstd = (const float*)(WS(p) + OFF_RSTD);
    bf16_t* halo = (bf16_t*)(WS(p) + OFF_HALO);
    constexpr int NTN = NP1 / 128;
    for (int tile = obid(); tile < 129 * NTN; tile += gridDim.x) {
        const int mt = tile / NTN, nt = tile % NTN;
        const int row0 = mt * 128, col0 = nt * 128;
        f32x4 acc[2][4]; zero_acc(acc);
        gemm_kloop(acc, h + (size_t)(row0 + (tid >> 2)) * DM + (tid & 3) * 8, wt + (size_t)(col0 + (tid >> 2)) * DM + (tid & 3) * 8, DM, lds);
        bf16_t* dst; int ld, cbase;
        if (nt < 8) { dst = (bf16_t*)(WS(p) + OFF_PPOOL); ld = 1024; cbase = 0; }
        else if (nt < 16) { dst = (bf16_t*)(WS(p) + OFF_PR); ld = 1024; cbase = 1024; }
        else if (nt < 24) { dst = (bf16_t*)(WS(p) + OFF_PK); ld = 1024; cbase = 2048; }
        else if (nt < 32) { dst = (bf16_t*)(WS(p) + OFF_PV); ld = 1024; cbase = 3072; }
        else { dst = (bf16_t*)(WS(p) + OFF_PMISC); ld = PM_LD; cbase = 4096; }
#pragma unroll
        for (int m = 0; m < 2; ++m)
#pragma unroll
            for (int j = 0; j < 4; ++j) {
                const int lr = wr * 32 + m * 16 + fq * 4 + j;
                const int row = row0 + lr;
                const float rs = rstd[row];
#pragma unroll
                for (int n = 0; n < 4; ++n) {
                    const int col = col0 + wc * 64 + n * 16 + fr;
                    const bf16_t v = f2bf(acc[m][n][j] * rs);
                    dst[(size_t)row * ld + (col - cbase)] = v;
                    if (nt < 8 && lr >= 112) halo[((size_t)mt * 16 + (lr - 112)) * 1024 + col] = v;
                }
            }
    }
}

__device__ void phase_pool(const Params& p, int l, unsigned char* lds) {
    const int tid = otid(), lane = tid & 63, wid = tid >> 6, fr = lane & 15, fq = lane >> 4;
    bf16_t* pp = (bf16_t*)(WS(p) + OFF_PPOOL);
    const bf16_t* halo = (const bf16_t*)(WS(p) + OFF_HALO);
    const bf16_t* pw = (const bf16_t*)(WS(p) + OFF_WB) + WB_POOL;
    const float* scale = p.in[6] + (size_t)l * 1024;
    bf16_t* sp = (bf16_t*)lds;
    constexpr int SLD = 264;
    for (int tile = obid(); tile < 129 * 4; tile += gridDim.x) {
        const int mt = tile >> 2, g = tile & 3;
        const int row0 = mt * 128, w = 2 << g;
        for (int e = tid; e < 128 * 256; e += NTHR) {
            const int r = e >> 8, c = e & 255;
            const int n = row0 + r, t = n % TS;
            const int col = g * 256 + c;
            const int cnt = (t + 1 < w) ? (t + 1) : w;
            float s = 0.f, self = 0.f;
            for (int i = 0; i < cnt; ++i) {
                const int n2 = n - i;
                float v;
                if (n2 >= row0) v = bf2f(pp[(size_t)n2 * 1024 + col]);
                else v = bf2f(halo[((size_t)(n2 >> 7) * 16 + ((n2 & 127) - 112)) * 1024 + col]);
                if (i == 0) self = v;
                s += v;
            }
            sp[r * SLD + c] = f2bf(s / (float)cnt - self);
        }
        __syncthreads();
        f32x4 acc[8][2];
#pragma unroll
        for (int m = 0; m < 8; ++m) { acc[m][0] = (f32x4){0.f, 0.f, 0.f, 0.f}; acc[m][1] = (f32x4){0.f, 0.f, 0.f, 0.f}; }
        const bf16_t* wg = pw + (size_t)g * 65536;
#pragma unroll 1
        for (int kk = 0; kk < 8; ++kk) {
            bf16x8 bfr[2];
#pragma unroll
            for (int n = 0; n < 2; ++n) bfr[n] = *(const bf16x8*)(wg + (size_t)(wid * 32 + n * 16 + fr) * 256 + kk * 32 + fq * 8);
#pragma unroll
            for (int m = 0; m < 8; ++m) {
                const bf16x8 a = *(const bf16x8*)(sp + (m * 16 + fr) * SLD + kk * 32 + fq * 8);
                acc[m][0] = __builtin_amdgcn_mfma_f32_16x16x32_bf16(a, bfr[0], acc[m][0], 0, 0, 0);
                acc[m][1] = __builtin_amdgcn_mfma_f32_16x16x32_bf16(a, bfr[1], acc[m][1], 0, 0, 0);
            }
        }
#pragma unroll
        for (int m = 0; m < 8; ++m)
#pragma unroll
            for (int n = 0; n < 2; ++n) {
                const int col = g * 256 + wid * 32 + n * 16 + fr;
                const float sc = scale[col];
#pragma unroll
                for (int j = 0; j < 4; ++j) {
                    const int row = row0 + m * 16 + fq * 4 + j;
                    pp[(size_t)row * 1024 + col] = f2bf(acc[m][n][j] * sc);
                }
            }
        __syncthreads();
    }
}

__device__ void phase_dsa_prep(const Params& p, int l) {
    const int lane = otid() & 63;
    const int wave = (obid() * NTHR + otid()) >> 6, nw = gridDim.x * NTHR / 64;
    const bf16_t* pm = (const bf16_t*)(WS(p) + OFF_PMISC);
    unsigned char* dob = OUTB(p);
    bf16_t* cqn = (bf16_t*)(dob + DO_CQN);
    bf16_t* kv = (bf16_t*)(dob + DO_KV);
    bf16_t* kidx = (bf16_t*)(dob + DO_KIDX);
    float* whead = (float*)(dob + DO_WHEAD);
    const float* ctab = (const float*)(WS(p) + OFF_ROPE);
    const float* stab = ctab + TS * 16;
    const float* qn = p.in[21] + l * 256;
    const float* kvn = p.in[22] + l * 128;
    const float* inw = p.in[27] + l * 64;
    const float* inb = p.in[28] + l * 64;
    for (int n = wave; n < NT; n += nw) {
        const int t = n % TS;
        const bf16_t* row = pm + (size_t)n * PM_LD;
        {
            float v[4]; float ss = 0.f;
#pragma unroll
            for (int i = 0; i < 4; ++i) { v[i] = bf2f(row[PM_CQ + lane * 4 + i]); ss += v[i] * v[i]; }
            ss = wave_sum(ss);
            const float rs = rsqrtf(ss * (1.0f / 256.0f) + 1e-6f);
#pragma unroll
            for (int i = 0; i < 4; ++i) cqn[(size_t)n * 256 + lane * 4 + i] = f2bf(v[i] * rs * qn[lane * 4 + i]);
        }
        {
            float v[2]; float ss = 0.f;
#pragma unroll
            for (int i = 0; i < 2; ++i) { v[i] = bf2f(row[PM_CKV + lane * 2 + i]); ss += v[i] * v[i]; }
            ss = wave_sum(ss);
            const float rs = rsqrtf(ss * (1.0f / 128.0f) + 1e-6f);
#pragma unroll
            for (int i = 0; i < 2; ++i) kv[(size_t)n * 160 + lane * 2 + i] = f2bf(v[i] * rs * kvn[lane * 2 + i]);
        }
        if (lane < 16) {
            const float x1 = bf2f(row[PM_KROPE + lane]), x2 = bf2f(row[PM_KROPE + 16 + lane]);
            const float c = ctab[t * 16 + lane], s = stab[t * 16 + lane];
            kv[(size_t)n * 160 + 128 + lane] = f2bf(x1 * c - x2 * s);
            kv[(size_t)n * 160 + 144 + lane] = f2bf(x2 * c + x1 * s);
        }
        {
            const float x = bf2f(row[PM_KIDX + lane]);
            const float mu = wave_sum(x) * (1.0f / 64.0f);
            const float d = x - mu;
            const float var = wave_sum(d * d) * (1.0f / 64.0f);
            const float y = d * rsqrtf(var + 1e-6f) * inw[lane] + inb[lane];
            const float yo = __shfl_xor(y, 16);
            float o = y;
            if (lane < 32) {
                const int i = lane & 15;
                const float c = ctab[t * 16 + i], s = stab[t * 16 + i];
                o = (lane < 16) ? (y * c - yo * s) : (y * c + yo * s);
            }
            kidx[(size_t)n * 64 + lane] = f2bf(o);
        }
        if (lane < 8) whead[(size_t)n * 8 + lane] = bf2f(row[PM_WIDX + lane]) * 0.04419417382415922f;
    }
}

__device__ void phase_scan(const Params& p, int l, unsigned char* lds) {
    if (obid() >= NB * 16) return;
    const int tid = otid(), lane = tid & 63, wid = tid >> 6;
    const int b = obid() >> 4, hh = obid() & 15, hc = hh * 64;
    constexpr int TC = 16;
    float* s_r = (float*)lds;
    float* s_w = s_r + TC * 64;
    float* s_k = s_w + TC * 64;
    float* s_v = s_k + TC * 64;
    float* s_a = s_v + TC * 64;
    float* s_b = s_a + TC * 64;
    float* s_g = s_b + TC * 64;
    float* s_o = s_g + TC * 64;
    float* s_wd = s_o + TC * 64;
    float* s_ad = s_wd + TC * 64;
    float* s_gd = s_ad + TC * 64;
    float* s_vd = s_gd + TC * 128;
    float* s_pr = s_vd + TC * 32;
    float* s_W2 = s_pr + 128;
    float* s_A2 = s_W2 + 64 * 64;
    float* s_G2 = s_A2 + 64 * 64;
    float* s_V2 = s_G2 + 128 * 64;
    bf16_t* Pr = (bf16_t*)(WS(p) + OFF_PR);
    const bf16_t* Pk = (const bf16_t*)(WS(p) + OFF_PK);
    const bf16_t* Pv = (const bf16_t*)(WS(p) + OFF_PV);
    const bf16_t* Pm = (const bf16_t*)(WS(p) + OFF_PMISC);
    bf16_t* vfirst = (bf16_t*)(WS(p) + OFF_VFIRST);
    const float* mu = p.in[4] + (size_t)l * 3328;
    const float* vmu = p.in[18];
    const float* w0 = p.in[7] + l * 1024;
    const float* a0 = p.in[9] + l * 1024;
    const float* k_k = p.in[12] + l * 1024;
    const float* k_a = p.in[13] + l * 1024;
    const float* r_k = p.in[14] + l * 1024;
    const float* ln_w = p.in[15] + l * 1024;
    const float* ln_b = p.in[16] + l * 1024;
    const float* v0 = p.in[19];
    for (int e = tid; e < 64 * 64; e += NTHR) { const int m = e >> 6, c = e & 63; s_W2[e] = p.in[8][((size_t)l * 64 + m) * 1024 + hc + c]; s_A2[e] = p.in[10][((size_t)l * 64 + m) * 1024 + hc + c]; }
    for (int e = tid; e < 128 * 64; e += NTHR) { const int m = e >> 6, c = e & 63; s_G2[e] = p.in[11][((size_t)l * 128 + m) * 1024 + hc + c]; }
    for (int e = tid; e < 32 * 64; e += NTHR) { const int m = e >> 6, c = e & 63; s_V2[e] = (l > 0) ? p.in[20][(size_t)m * 1024 + hc + c] : 0.f; }
    float S[8];
#pragma unroll
    for (int j = 0; j < 8; ++j) S[j] = 0.f;
    const int si = tid >> 3, q8 = tid & 7;
    __syncthreads();
    for (int t0 = 0, ch = 0; t0 < TS; t0 += TC, ++ch) {
        for (int e = tid; e < TC * 64; e += NTHR) {
            const int tau = e >> 6, c = e & 63, t = t0 + tau;
            const size_t n = (size_t)b * TS + t;
            const float cr = bf2f(Pr[n * 1024 + hc + c]);
            const float ck = bf2f(Pk[n * 1024 + hc + c]);
            const float cv = bf2f(Pv[n * 1024 + hc + c]);
            float prr = 0.f, prk = 0.f, prv = 0.f;
            if (t > 0) {
                prr = (tau > 0) ? bf2f(Pr[(n - 1) * 1024 + hc + c]) : s_pr[((ch + 1) & 1) * 64 + c];
                prk = bf2f(Pk[(n - 1) * 1024 + hc + c]);
                prv = bf2f(Pv[(n - 1) * 1024 + hc + c]);
            }
            if (tau == TC - 1) s_pr[(ch & 1) * 64 + c] = cr;
            s_r[e] = cr + (prr - cr) * mu[hc + c];
            s_k[e] = ck + (prk - ck) * mu[1024 + hc + c];
            s_v[e] = cv + (prv - cv) * mu[2048 + hc + c];
            const float cwd = bf2f(Pm[n * PM_LD + PM_WD + c]), cad = bf2f(Pm[n * PM_LD + PM_AD + c]);
            float pwd = 0.f, pad_ = 0.f;
            if (t > 0) { pwd = bf2f(Pm[(n - 1) * PM_LD + PM_WD + c]); pad_ = bf2f(Pm[(n - 1) * PM_LD + PM_AD + c]); }
            s_wd[e] = tanhf(cwd + (pwd - cwd) * mu[3072 + c]);
            s_ad[e] = cad + (pad_ - cad) * mu[3136 + c];
        }
        for (int e = tid; e < TC * 128; e += NTHR) {
            const int tau = e >> 7, c = e & 127, t = t0 + tau;
            const size_t n = (size_t)b * TS + t;
            const float cg_ = bf2f(Pm[n * PM_LD + PM_GD + c]);
            const float pg = (t > 0) ? bf2f(Pm[(n - 1) * PM_LD + PM_GD + c]) : 0.f;
            s_gd[e] = sigmoidf_(cg_ + (pg - cg_) * mu[3200 + c]);
        }
        if (l > 0) {
            for (int e = tid; e < TC * 32; e += NTHR) {
                const int tau = e >> 5, c = e & 31, t = t0 + tau;
                const size_t n = (size_t)b * TS + t;
                const float cvd = bf2f(Pm[n * PM_LD + PM_VD + c]);
                const float pvd = (t > 0) ? bf2f(Pm[(n - 1) * PM_LD + PM_VD + c]) : 0.f;
                s_vd[e] = cvd + (pvd - cvd) * vmu[c];
            }
        }
        __syncthreads();
        for (int e = tid; e < TC * 64; e += NTHR) {
            const int tau = e >> 6, c = e & 63, t = t0 + tau;
            const size_t n = (size_t)b * TS + t;
            float xw = w0[hc + c], xa = a0[hc + c], gg = 0.f, xv = 0.f;
#pragma unroll 8
            for (int m = 0; m < 64; ++m) { xw += s_wd[tau * 64 + m] * s_W2[m * 64 + c]; xa += s_ad[tau * 64 + m] * s_A2[m * 64 + c]; }
#pragma unroll 8
            for (int m = 0; m < 128; ++m) gg += s_gd[tau * 128 + m] * s_G2[m * 64 + c];
            const float wlog = -softplusf_(-xw) - 0.5f;
            const float decay = __expf(-__expf(wlog));
            const float a = sigmoidf_(xa);
            float vv = s_v[e];
            if (l > 0) {
                xv = v0[hc + c];
#pragma unroll 8
                for (int m = 0; m < 32; ++m) xv += s_vd[tau * 32 + m] * s_V2[m * 64 + c];
                const float vf = bf2f(vfirst[n * 1024 + hc + c]);
                vv = vv + (vf - vv) * sigmoidf_(xv);
            } else {
                vfirst[n * 1024 + hc + c] = f2bf(vv);
            }
            const float kraw = s_k[e];
            const float kkv = kraw * k_k[hc + c];
            const float nrm = sqrtf(wave_sum(kkv * kkv));
            const float kk = kkv / fmaxf(nrm, 1e-12f);
            s_w[e] = decay;
            s_a[e] = -kk;
            s_b[e] = kk * a;
            s_k[e] = kraw * (1.0f + (a - 1.0f) * k_a[hc + c]);
            s_v[e] = vv;
            s_g[e] = gg;
        }
        __syncthreads();
#pragma unroll 1
        for (int tau = 0; tau < TC; ++tau) {
            const float4 a0v = *(const float4*)(s_a + tau * 64 + q8 * 8), a1v = *(const float4*)(s_a + tau * 64 + q8 * 8 + 4);
            const float4 w0v = *(const float4*)(s_w + tau * 64 + q8 * 8), w1v = *(const float4*)(s_w + tau * 64 + q8 * 8 + 4);
            const float4 b0v = *(const float4*)(s_b + tau * 64 + q8 * 8), b1v = *(const float4*)(s_b + tau * 64 + q8 * 8 + 4);
            const float4 k0v = *(const float4*)(s_k + tau * 64 + q8 * 8), k1v = *(const float4*)(s_k + tau * 64 + q8 * 8 + 4);
            const float4 r0v = *(const float4*)(s_r + tau * 64 + q8 * 8), r1v = *(const float4*)(s_r + tau * 64 + q8 * 8 + 4);
            const float vi = s_v[tau * 64 + si];
            const float av[8] = {a0v.x, a0v.y, a0v.z, a0v.w, a1v.x, a1v.y, a1v.z, a1v.w};
            const float wv[8] = {w0v.x, w0v.y, w0v.z, w0v.w, w1v.x, w1v.y, w1v.z, w1v.w};
            const float bv[8] = {b0v.x, b0v.y, b0v.z, b0v.w, b1v.x, b1v.y, b1v.z, b1v.w};
            const float kv_[8] = {k0v.x, k0v.y, k0v.z, k0v.w, k1v.x, k1v.y, k1v.z, k1v.w};
            const float rv[8] = {r0v.x, r0v.y, r0v.z, r0v.w, r1v.x, r1v.y, r1v.z, r1v.w};
            float sa = 0.f;
#pragma unroll
            for (int j = 0; j < 8; ++j) sa += S[j] * av[j];
            sa += __shfl_xor(sa, 1); sa += __shfl_xor(sa, 2); sa += __shfl_xor(sa, 4);
            float o = 0.f;
#pragma unroll
            for (int j = 0; j < 8; ++j) { S[j] = S[j] * wv[j] + sa * bv[j] + vi * kv_[j]; o += S[j] * rv[j]; }
            o += __shfl_xor(o, 1); o += __shfl_xor(o, 2); o += __shfl_xor(o, 4);
            if (q8 == 0) s_o[tau * 64 + si] = o;
        }
        __syncthreads();
        for (int tau = wid; tau < TC; tau += 8) {
            const int c = lane, e = tau * 64 + c;
            const size_t n = (size_t)b * TS + t0 + tau;
            const float o = s_o[e];
            const float m_ = wave_sum(o) * (1.0f / 64.0f);
            const float d = o - m_;
            const float var = wave_sum(d * d) * (1.0f / 64.0f);
            const float on = d * rsqrtf(var + 64e-5f) * ln_w[hc + c] + ln_b[hc + c];
            const float bonus = wave_sum(s_r[e] * s_k[e] * r_k[hc + c]) * s_v[e];
            Pr[n * 1024 + hc + c] = f2bf((on + bonus) * s_g[e]);
        }
        __syncthreads();
    }
}

__device__ void phase_dsa_naive(const Params& p, int l, unsigned char* lds) {
    const int tid = otid(), lane = tid & 63, wid = tid >> 6;
    constexpr int QT = 4, SCL = 2080;
    float* s_cq = (float*)lds;
    float* s_q = s_cq + QT * 256;
    float* s_Q = s_q + QT * 1536;
    float* s_qi = s_Q + QT * 16 * 160;
    float* s_sc = s_qi + QT * 512;
    int* s_sel = (int*)(s_sc + QT * SCL);
    int* s_nsel = s_sel + QT * 256;
    float* s_p = (float*)(s_nsel + 16);
    float* s_ol = s_p + 16 * 256;
    float* s_wh = s_ol + 16 * 128;
    unsigned char* dob = OUTB(p);
    const bf16_t* cqn = (const bf16_t*)(dob + DO_CQN);
    const bf16_t* kv = (const bf16_t*)(dob + DO_KV);
    const bf16_t* kidx = (const bf16_t*)(dob + DO_KIDX);
    const float* whead = (const float*)(dob + DO_WHEAD);
    bf16_t* yc = (bf16_t*)(dob + DO_YC);
    const float* ctab = (const float*)(WS(p) + OFF_ROPE);
    const float* stab = ctab + TS * 16;
    const float* w_uq = p.in[23] + (size_t)l * 256 * 1536;
    const float* w_uk = p.in[24] + (size_t)l * 16 * 128 * 64;
    const float* w_uv = p.in[25] + (size_t)l * 16 * 128 * 64;
    const float* w_qi = p.in[26] + (size_t)l * 256 * 512;
    const float scale = 0.10206207261596575f;
    for (int tile = obid(); tile < NT / QT; tile += gridDim.x) {
        const int n0 = tile * QT, b = n0 / TS, t0 = n0 % TS;
        for (int e = tid; e < QT * 256; e += NTHR) s_cq[e] = bf2f(cqn[(size_t)n0 * 256 + e]);
        if (tid < QT * 8) s_wh[tid] = whead[(size_t)n0 * 8 + tid];
        __syncthreads();
        {
            float acc[3][QT];
#pragma unroll
            for (int c = 0; c < 3; ++c)
#pragma unroll
                for (int q = 0; q < QT; ++q) acc[c][q] = 0.f;
            float ai[QT];
#pragma unroll
            for (int q = 0; q < QT; ++q) ai[q] = 0.f;
            for (int i = 0; i < 256; ++i) {
                const float wa = w_uq[(size_t)i * 1536 + tid], wb_ = w_uq[(size_t)i * 1536 + 512 + tid], wc_ = w_uq[(size_t)i * 1536 + 1024 + tid];
                const float wi = w_qi[(size_t)i * 512 + tid];
#pragma unroll
                for (int q = 0; q < QT; ++q) {
                    const float c = s_cq[q * 256 + i];
                    acc[0][q] += c * wa; acc[1][q] += c * wb_; acc[2][q] += c * wc_; ai[q] += c * wi;
                }
            }
#pragma unroll
            for (int q = 0; q < QT; ++q) {
                s_q[q * 1536 + tid] = acc[0][q]; s_q[q * 1536 + 512 + tid] = acc[1][q]; s_q[q * 1536 + 1024 + tid] = acc[2][q];
                s_qi[q * 512 + tid] = ai[q];
            }
        }
        __syncthreads();
        for (int e = tid; e < QT * 16 * 16; e += NTHR) {
            const int q = e >> 8, h = (e >> 4) & 15, i = e & 15;
            const float x1 = s_q[q * 1536 + h * 96 + 64 + i], x2 = s_q[q * 1536 + h * 96 + 80 + i];
            const float c = ctab[(t0 + q) * 16 + i], s = stab[(t0 + q) * 16 + i];
            s_Q[(q * 16 + h) * 160 + 128 + i] = x1 * c - x2 * s;
            s_Q[(q * 16 + h) * 160 + 144 + i] = x2 * c + x1 * s;
        }
        {
            const int q = tid >> 7, h8 = (tid >> 4) & 7, i = tid & 15;
            const float x1 = s_qi[q * 512 + h8 * 64 + i], x2 = s_qi[q * 512 + h8 * 64 + 16 + i];
            const float c = ctab[(t0 + q) * 16 + i], s = stab[(t0 + q) * 16 + i];
            __syncthreads();
            s_qi[q * 512 + h8 * 64 + i] = x1 * c - x2 * s;
            s_qi[q * 512 + h8 * 64 + 16 + i] = x2 * c + x1 * s;
        }
        for (int id = tid; id < 16 * 128; id += NTHR) {
            const int h = id >> 7, c = id & 127;
            const float* wrow = w_uk + ((size_t)h * 128 + c) * 64;
            float acc[QT];
#pragma unroll
            for (int q = 0; q < QT; ++q) acc[q] = 0.f;
            for (int d = 0; d < 64; d += 4) {
                const float4 w4 = *(const float4*)(wrow + d);
#pragma unroll
                for (int q = 0; q < QT; ++q) {
                    const float* qq = s_q + q * 1536 + h * 96 + d;
                    acc[q] += qq[0] * w4.x + qq[1] * w4.y + qq[2] * w4.z + qq[3] * w4.w;
                }
            }
#pragma unroll
            for (int q = 0; q < QT; ++q) s_Q[(q * 16 + h) * 160 + c] = acc[q];
        }
        __syncthreads();
        const int tmax = t0 + QT - 1;
        for (int s = tid; s <= tmax; s += NTHR) {
            float kr[64];
            const bf16_t* krow = kidx + ((size_t)b * TS + s) * 64;
#pragma unroll
            for (int v8 = 0; v8 < 8; ++v8) {
                const uint4 u = *(const uint4*)(krow + v8 * 8);
                kr[v8 * 8 + 0] = __uint_as_float(u.x << 16); kr[v8 * 8 + 1] = __uint_as_float(u.x & 0xFFFF0000u);
                kr[v8 * 8 + 2] = __uint_as_float(u.y << 16); kr[v8 * 8 + 3] = __uint_as_float(u.y & 0xFFFF0000u);
                kr[v8 * 8 + 4] = __uint_as_float(u.z << 16); kr[v8 * 8 + 5] = __uint_as_float(u.z & 0xFFFF0000u);
                kr[v8 * 8 + 6] = __uint_as_float(u.w << 16); kr[v8 * 8 + 7] = __uint_as_float(u.w & 0xFFFF0000u);
            }
#pragma unroll 1
            for (int q = 0; q < QT; ++q) {
                float I = 0.f;
#pragma unroll 1
                for (int h = 0; h < 8; ++h) {
                    const float* qq = s_qi + q * 512 + h * 64;
                    float d = 0.f;
#pragma unroll
                    for (int j = 0; j < 64; ++j) d += qq[j] * kr[j];
                    I += s_wh[q * 8 + h] * fmaxf(d, 0.f);
                }
                s_sc[q * SCL + s] = I;
            }
        }
        __syncthreads();
        if (wid < QT) {
            const int q = wid, t = t0 + q, nadm = t + 1;
            const float* sc = s_sc + q * SCL;
            int* sel = s_sel + q * 256;
            if (nadm <= 256) {
                for (int i = lane; i < nadm; i += 64) sel[i] = i;
                if (lane == 0) s_nsel[q] = nadm;
            } else {
                const int nch = (nadm + 63) >> 6;
                unsigned T = 0u;
                for (int bit = 31; bit >= 0; --bit) {
                    const unsigned cand = T | (1u << bit);
                    int cnt = 0;
                    for (int c = 0; c < nch; ++c) {
                        const int s = c * 64 + lane;
                        bool ge = false;
                        if (s < nadm) { const unsigned u = __float_as_uint(sc[s]); const unsigned key = (u & 0x80000000u) ? ~u : (u | 0x80000000u); ge = key >= cand; }
                        cnt += __popcll(__ballot(ge));
                    }
                    if (cnt >= 256) T = cand;
                }
                int ngt = 0;
                for (int c = 0; c < nch; ++c) {
                    const int s = c * 64 + lane;
                    bool gt = false;
                    if (s < nadm) { const unsigned u = __float_as_uint(sc[s]); const unsigned key = (u & 0x80000000u) ? ~u : (u | 0x80000000u); gt = key > T; }
                    ngt += __popcll(__ballot(gt));
                }
                const int rties = 256 - ngt;
                int base = 0, ties = 0;
                const unsigned long long ltmask = (1ull << lane) - 1ull;
                for (int c = 0; c < nch; ++c) {
                    const int s = c * 64 + lane;
                    bool gt = false, eq = false;
                    if (s < nadm) { const unsigned u = __float_as_uint(sc[s]); const unsigned key = (u & 0x80000000u) ? ~u : (u | 0x80000000u); gt = key > T; eq = key == T; }
                    const unsigned long long em = __ballot(eq);
                    const int myrank = ties + __popcll(em & ltmask);
                    const bool take = gt || (eq && myrank < rties);
                    const unsigned long long tm = __ballot(take);
                    const int pos = base + __popcll(tm & ltmask);
                    if (take && pos < 256) sel[pos] = s;
                    base += __popcll(tm); ties += __popcll(em);
                }
                if (lane == 0) s_nsel[q] = 256;
            }
        }
        __syncthreads();
        for (int q = 0; q < QT; ++q) {
            const int nsel = s_nsel[q];
            const int* sel = s_sel + q * 256;
            {
                const int h = tid >> 5, kg = tid & 31;
                const float* qv = s_Q + (q * 16 + h) * 160;
                float mx = -INFINITY;
#pragma unroll 1
                for (int kk = 0; kk < 8; ++kk) {
                    const int ki = kg + kk * 32;
                    float sv = -INFINITY;
                    if (ki < nsel) {
                        const bf16_t* krow = kv + ((size_t)b * TS + sel[ki]) * 160;
                        float d = 0.f;
#pragma unroll 4
                        for (int v8 = 0; v8 < 20; ++v8) {
                            const uint4 u = *(const uint4*)(krow + v8 * 8);
                            const float* qq = qv + v8 * 8;
                            d += qq[0] * __uint_as_float(u.x << 16) + qq[1] * __uint_as_float(u.x & 0xFFFF0000u)
                               + qq[2] * __uint_as_float(u.y << 16) + qq[3] * __uint_as_float(u.y & 0xFFFF0000u)
                               + qq[4] * __uint_as_float(u.z << 16) + qq[5] * __uint_as_float(u.z & 0xFFFF0000u)
                               + qq[6] * __uint_as_float(u.w << 16) + qq[7] * __uint_as_float(u.w & 0xFFFF0000u);
                        }
                        sv = d * scale;
                    }
                    s_p[h * 256 + ki] = sv; mx = fmaxf(mx, sv);
                }
#pragma unroll
                for (int o = 16; o > 0; o >>= 1) mx = fmaxf(mx, __shfl_xor(mx, o));
                float sum = 0.f;
#pragma unroll 1
                for (int kk = 0; kk < 8; ++kk) { const float sv = s_p[h * 256 + kg + kk * 32]; const float e = (sv == -INFINITY) ? 0.f : __expf(sv - mx); s_p[h * 256 + kg + kk * 32] = e; sum += e; }
#pragma unroll
                for (int o = 16; o > 0; o >>= 1) sum += __shfl_xor(sum, o);
                const float inv = 1.0f / sum;
#pragma unroll 1
                for (int kk = 0; kk < 8; ++kk) s_p[h * 256 + kg + kk * 32] *= inv;
            }
            __syncthreads();
            {
                const int h = tid >> 5, c4 = tid & 31;
                float a0_ = 0.f, a1_ = 0.f, a2_ = 0.f, a3_ = 0.f;
                for (int k = 0; k < nsel; ++k) {
                    const float pk = s_p[h * 256 + k];
                    const uint2 u = *(const uint2*)(kv + ((size_t)b * TS + sel[k]) * 160 + c4 * 4);
                    a0_ += pk * __uint_as_float(u.x << 16); a1_ += pk * __uint_as_float(u.x & 0xFFFF0000u);
                    a2_ += pk * __uint_as_float(u.y << 16); a3_ += pk * __uint_as_float(u.y & 0xFFFF0000u);
                }
                float* o = s_ol + h * 128 + c4 * 4;
                o[0] = a0_; o[1] = a1_; o[2] = a2_; o[3] = a3_;
            }
            __syncthreads();
            for (int id = tid; id < 1024; id += NTHR) {
                const int h = id >> 6, v = id & 63;
                float acc = 0.f;
                for (int c = 0; c < 128; ++c) acc += s_ol[h * 128 + c] * w_uv[((size_t)h * 128 + c) * 64 + v];
                yc[(size_t)(n0 + q) * 1024 + id] = f2bf(acc);
            }
            __syncthreads();
        }
    }
}


typedef short s16x4 __attribute__((ext_vector_type(4)));
__device__ __forceinline__ unsigned f2h_bits(float f) { const _Float16 h = (_Float16)f; unsigned short u; __builtin_memcpy(&u, &h, 2); return u; }
template <bool IMPORT_SEL>
__device__ void phase_dsa(const Params& p, int l, unsigned char* lds, bf16_t* yc, const unsigned short* gsel, const int* gnsel) {
    const int tid = otid(), lane = tid & 63, wid = tid >> 6, fr = lane & 15, fq = lane >> 4;
    unsigned short* s_sc = (unsigned short*)lds;
    bf16_t* s_qi = (bf16_t*)(lds + 66048);
    bf16_t* s_Q = (bf16_t*)lds;
    unsigned char* s_Vw = lds + 82432 + wid * 8192;
    bf16_t* s_qn = (bf16_t*)s_Vw;
    unsigned short* s_sel = (unsigned short*)(lds + 82432 + 65536);
    int* s_nsel = (int*)(lds + 82432 + 65536 + 8192);
    unsigned char* dob = OUTB(p);
    const bf16_t* cqn = (const bf16_t*)(dob + DO_CQN);
    const bf16_t* kv = (const bf16_t*)(dob + DO_KV);
    const bf16_t* kidx = (const bf16_t*)(dob + DO_KIDX);
    const float* whead = (const float*)(dob + DO_WHEAD);
    const float* ctab = (const float*)(WS(p) + OFF_ROPE);
    const float* stab = ctab + TS * 16;
    const bf16_t* wb = (const bf16_t*)(WS(p) + OFF_WB);
    const bf16_t* wqiT = wb + WB_QI;
    const bf16_t* wuqT = wb + WB_UQ;
    const bf16_t* wuk = wb + WB_UK;
    const bf16_t* wuvT = wb + WB_UV;
    const float scale = 0.10206207261596575f;
    const f32x4 z4 = {0.f, 0.f, 0.f, 0.f};
    for (int tile = obid(); tile < NT / 16; tile += gridDim.x) {
        const int qt = 128 - (tile >> 3), b = tile & 7;
        const int t0 = qt * 16;
        const size_t n0 = (size_t)b * TS + t0;
        {
            bf16x8 acq[8];
#pragma unroll
            for (int kk = 0; kk < 8; ++kk) acq[kk] = *(const bf16x8*)(cqn + (n0 + fr) * 256 + kk * 32 + fq * 8);
            f32x4 c[4] = {z4, z4, z4, z4};
#pragma unroll
            for (int kk = 0; kk < 8; ++kk)
#pragma unroll
                for (int nt = 0; nt < 4; ++nt)
                    c[nt] = __builtin_amdgcn_mfma_f32_16x16x32_bf16(acq[kk], *(const bf16x8*)(wqiT + (size_t)(wid * 64 + nt * 16 + fr) * 256 + kk * 32 + fq * 8), c[nt], 0, 0, 0);
#pragma unroll
            for (int j = 0; j < 4; ++j) {
                const int t = t0 + fq * 4 + j;
                const float cs = ctab[t * 16 + fr], sn = stab[t * 16 + fr];
                const float x1 = c[0][j], x2 = c[1][j];
                c[0][j] = x1 * cs - x2 * sn; c[1][j] = x2 * cs + x1 * sn;
            }
#pragma unroll
            for (int nt = 0; nt < 4; ++nt)
#pragma unroll
                for (int j = 0; j < 4; ++j) s_qi[(fq * 4 + j) * 512 + wid * 64 + nt * 16 + fr] = f2bf(c[nt][j]);
        }
        __syncthreads();
        if (!IMPORT_SEL) {
            bf16x8 aq[8][2];
#pragma unroll
            for (int h = 0; h < 8; ++h)
#pragma unroll
                for (int ks = 0; ks < 2; ++ks) aq[h][ks] = *(const bf16x8*)(s_qi + fr * 512 + h * 64 + ks * 32 + fq * 8);
            float wh[4][8];
#pragma unroll
            for (int j = 0; j < 4; ++j) {
                const float4 w0 = *(const float4*)(whead + (n0 + fq * 4 + j) * 8), w1 = *(const float4*)(whead + (n0 + fq * 4 + j) * 8 + 4);
                wh[j][0] = w0.x; wh[j][1] = w0.y; wh[j][2] = w0.z; wh[j][3] = w0.w; wh[j][4] = w1.x; wh[j][5] = w1.y; wh[j][6] = w1.z; wh[j][7] = w1.w;
            }
            const int nkt = qt + 1;
#pragma unroll 1
            for (int kt = wid; kt < nkt; kt += 8) {
                const bf16_t* krow = kidx + ((size_t)b * TS + kt * 16 + fr) * 64 + fq * 8;
                const bf16x8 bk0 = *(const bf16x8*)krow, bk1 = *(const bf16x8*)(krow + 32);
                float I[4] = {0.f, 0.f, 0.f, 0.f};
#pragma unroll
                for (int h = 0; h < 8; ++h) {
                    f32x4 a = __builtin_amdgcn_mfma_f32_16x16x32_bf16(aq[h][0], bk0, z4, 0, 0, 0);
                    a = __builtin_amdgcn_mfma_f32_16x16x32_bf16(aq[h][1], bk1, a, 0, 0, 0);
#pragma unroll
                    for (int j = 0; j < 4; ++j) I[j] += wh[j][h] * fmaxf(a[j], 0.f);
                }
#pragma unroll
                for (int j = 0; j < 4; ++j) s_sc[(fq * 4 + j) * 2064 + kt * 16 + fr] = (unsigned short)f2h_bits(I[j]);
            }
        }
        __syncthreads();
#pragma unroll 1
        for (int qi2 = 0; qi2 < 2; ++qi2) {
            const int q = wid + qi2 * 8;
            const int nadm = t0 + q + 1;
            unsigned short* sel = s_sel + q * 256;
            if (IMPORT_SEL) {
                const int ns = gnsel[n0 + q];
                for (int i = lane; i < ns; i += 64) sel[i] = gsel[(n0 + q) * 256 + i];
                if (lane == 0) s_nsel[q] = ns;
            } else if (nadm <= 256) {
                for (int i = lane; i < nadm; i += 64) sel[i] = (unsigned short)i;
                if (lane == 0) s_nsel[q] = nadm;
            } else {
                unsigned key[33];
#pragma unroll
                for (int c = 0; c < 33; ++c) {
                    const int s = c * 64 + lane;
                    unsigned k = 0u;
                    if (s < nadm) { const unsigned u = s_sc[q * 2064 + s]; k = (u & 0x8000u) ? (~u & 0xFFFFu) : (u | 0x8000u); }
                    key[c] = k;
                }
                unsigned T = 0u;
#pragma unroll 1
                for (int bit = 15; bit >= 0; --bit) {
                    const unsigned cand = T | (1u << bit);
                    int cnt = 0;
#pragma unroll
                    for (int c = 0; c < 33; ++c) cnt += __popcll(__ballot(key[c] >= cand));
                    if (cnt >= 256) T = cand;
                }
                int ngt = 0;
#pragma unroll
                for (int c = 0; c < 33; ++c) ngt += __popcll(__ballot(key[c] > T));
                const int rties = 256 - ngt;
                int base = 0, ties = 0;
                const unsigned long long ltmask = (1ull << lane) - 1ull;
#pragma unroll
                for (int c = 0; c < 33; ++c) {
                    const bool gt = key[c] > T, eq = key[c] == T;
                    const unsigned long long em = __ballot(eq);
                    const int myrank = ties + __popcll(em & ltmask);
                    const bool take = gt || (eq && myrank < rties);
                    const unsigned long long tm = __ballot(take);
                    const int pos = base + __popcll(tm & ltmask);
                    if (take && pos < 256) sel[pos] = (unsigned short)(c * 64 + lane);
                    base += __popcll(tm); ties += __popcll(em);
                }
                if (lane == 0) s_nsel[q] = 256;
            }
        }
        __syncthreads();
#pragma unroll 1
        for (int hi = 0; hi < 2; ++hi) {
            const int hh = wid * 2 + hi;
            bf16x8 acq[8];
#pragma unroll
            for (int kk = 0; kk < 8; ++kk) acq[kk] = *(const bf16x8*)(cqn + (n0 + fr) * 256 + kk * 32 + fq * 8);
            f32x4 c6[6] = {z4, z4, z4, z4, z4, z4};
#pragma unroll
            for (int kk = 0; kk < 8; ++kk)
#pragma unroll
                for (int nt = 0; nt < 6; ++nt)
                    c6[nt] = __builtin_amdgcn_mfma_f32_16x16x32_bf16(acq[kk], *(const bf16x8*)(wuqT + (size_t)(hh * 96 + nt * 16 + fr) * 256 + kk * 32 + fq * 8), c6[nt], 0, 0, 0);
#pragma unroll
            for (int j = 0; j < 4; ++j) {
                const int q = fq * 4 + j, t = t0 + q;
                const float cs = ctab[t * 16 + fr], sn = stab[t * 16 + fr];
                const float x1 = c6[4][j], x2 = c6[5][j];
                s_Q[(q * 16 + hh) * 160 + 128 + fr] = f2bf(x1 * cs - x2 * sn);
                s_Q[(q * 16 + hh) * 160 + 144 + fr] = f2bf(x2 * cs + x1 * sn);
#pragma unroll
                for (int nt = 0; nt < 4; ++nt) s_qn[q * 64 + nt * 16 + fr] = f2bf(c6[nt][j]);
            }
            __syncthreads();
            bf16x8 an[2];
#pragma unroll
            for (int ks = 0; ks < 2; ++ks) an[ks] = *(const bf16x8*)(s_qn + fr * 64 + ks * 32 + fq * 8);
#pragma unroll
            for (int nt = 0; nt < 8; ++nt) {
                f32x4 a = z4;
#pragma unroll
                for (int ks = 0; ks < 2; ++ks)
                    a = __builtin_amdgcn_mfma_f32_16x16x32_bf16(an[ks], *(const bf16x8*)(wuk + (size_t)(hh * 128 + nt * 16 + fr) * 64 + ks * 32 + fq * 8), a, 0, 0, 0);
#pragma unroll
                for (int j = 0; j < 4; ++j) s_Q[((fq * 4 + j) * 16 + hh) * 160 + nt * 16 + fr] = f2bf(a[j]);
            }
            __syncthreads();
        }
#pragma unroll 1
        for (int qi2 = 0; qi2 < 2; ++qi2) {
            const int q = wid + qi2 * 8;
            bf16x8 bq[5];
#pragma unroll
            for (int ks = 0; ks < 5; ++ks) bq[ks] = *(const bf16x8*)(s_Q + (q * 16 + fr) * 160 + ks * 32 + fq * 8);
            const int nsel = s_nsel[q];
            const unsigned short* sel = s_sel + q * 256;
            float m = -INFINITY, lsum = 0.f;
            f32x4 O[8] = {z4, z4, z4, z4, z4, z4, z4, z4};
            const int nchunk = (nsel + 31) >> 5;
#pragma unroll 1
            for (int ch = 0; ch < nchunk; ++ch) {
                bf16x8 ak[2][5];
#pragma unroll
                for (int mt = 0; mt < 2; ++mt) {
                    const int ki = ch * 32 + mt * 16 + fr;
                    const int sidx = sel[ki < nsel ? ki : 0];
                    const bf16_t* krow = kv + ((size_t)b * TS + sidx) * 160 + fq * 8;
#pragma unroll
                    for (int ks = 0; ks < 5; ++ks) ak[mt][ks] = *(const bf16x8*)(krow + ks * 32);
                }
#pragma unroll
                for (int mt = 0; mt < 2; ++mt)
#pragma unroll
                    for (int ks = 0; ks < 4; ++ks) {
                        const int r = mt * 16 + fr;
                        *(bf16x8*)(s_Vw + r * 256 + (((ks * 2 + (fq >> 1)) ^ (r & 7)) * 32) + (fq & 1) * 16) = ak[mt][ks];
                    }
                f32x4 st[2] = {z4, z4};
#pragma unroll
                for (int mt = 0; mt < 2; ++mt)
#pragma unroll
                    for (int ks = 0; ks < 5; ++ks) st[mt] = __builtin_amdgcn_mfma_f32_16x16x32_bf16(ak[mt][ks], bq[ks], st[mt], 0, 0, 0);
                float sv[2][4]; float cmax = -INFINITY;
#pragma unroll
                for (int mt = 0; mt < 2; ++mt)
#pragma unroll
                    for (int j = 0; j < 4; ++j) {
                        const int ke = ch * 32 + mt * 16 + fq * 4 + j;
                        const float s_ = (ke < nsel) ? st[mt][j] * scale : -INFINITY;
                        sv[mt][j] = s_; cmax = fmaxf(cmax, s_);
                    }
                cmax = fmaxf(cmax, __shfl_xor(cmax, 16)); cmax = fmaxf(cmax, __shfl_xor(cmax, 32));
                const float mnew = fmaxf(m, cmax);
                const float alpha = __expf(m - mnew);
                float psum = 0.f;
#pragma unroll
                for (int mt = 0; mt < 2; ++mt)
#pragma unroll
                    for (int j = 0; j < 4; ++j) { const float pe = __expf(sv[mt][j] - mnew); sv[mt][j] = pe; psum += pe; }
                psum += __shfl_xor(psum, 16); psum += __shfl_xor(psum, 32);
                lsum = lsum * alpha + psum; m = mnew;
#pragma unroll
                for (int ct = 0; ct < 8; ++ct) O[ct] = O[ct] * alpha;
                bf16x8 pf;
#pragma unroll
                for (int mt = 0; mt < 2; ++mt)
#pragma unroll
                    for (int j = 0; j < 4; ++j) pf[mt * 4 + j] = (short)f2bf(sv[mt][j]);
                const int q_ = fr >> 2, p_ = fr & 3;
                const int r0 = fq * 4 + q_, r1 = 16 + r0;
#pragma unroll
                for (int ct = 0; ct < 8; ++ct) {
                    const s16x4 v0 = __builtin_amdgcn_ds_read_tr16_b64_v4i16((__attribute__((address_space(3))) s16x4*)(s_Vw + r0 * 256 + ((ct ^ (r0 & 7)) * 32) + p_ * 8));
                    const s16x4 v1 = __builtin_amdgcn_ds_read_tr16_b64_v4i16((__attribute__((address_space(3))) s16x4*)(s_Vw + r1 * 256 + ((ct ^ (r1 & 7)) * 32) + p_ * 8));
                    bf16x8 av; av[0] = v0[0]; av[1] = v0[1]; av[2] = v0[2]; av[3] = v0[3]; av[4] = v1[0]; av[5] = v1[1]; av[6] = v1[2]; av[7] = v1[3];
                    O[ct] = __builtin_amdgcn_mfma_f32_16x16x32_bf16(av, pf, O[ct], 0, 0, 0);
                }
            }
            const float inv = 1.0f / lsum;
#pragma unroll
            for (int ct = 0; ct < 8; ++ct)
#pragma unroll
                for (int j = 0; j < 4; ++j) s_Q[(q * 16 + fr) * 160 + ct * 16 + fq * 4 + j] = f2bf(O[ct][j] * inv);
        }
        __syncthreads();
#pragma unroll 1
        for (int hi = 0; hi < 2; ++hi) {
            const int hh = wid * 2 + hi;
            bf16x8 ao[4];
#pragma unroll
            for (int ks = 0; ks < 4; ++ks) ao[ks] = *(const bf16x8*)(s_Q + (fr * 16 + hh) * 160 + ks * 32 + fq * 8);
#pragma unroll
            for (int nt = 0; nt < 4; ++nt) {
                f32x4 a = z4;
#pragma unroll
                for (int ks = 0; ks < 4; ++ks)
                    a = __builtin_amdgcn_mfma_f32_16x16x32_bf16(ao[ks], *(const bf16x8*)(wuvT + (size_t)(hh * 64 + nt * 16 + fr) * 128 + ks * 32 + fq * 8), a, 0, 0, 0);
#pragma unroll
                for (int j = 0; j < 4; ++j) yc[(n0 + fq * 4 + j) * 1024 + hh * 64 + nt * 16 + fr] = f2bf(a[j]);
            }
        }
        __syncthreads();
    }
}

__device__ void phase_merge(const Params& p, unsigned char* lds) {
    const int tid = otid(), lane = tid & 63, wid = tid >> 6, wr = wid >> 1, wc = wid & 1, fr = lane & 15, fq = lane >> 4;
    const bf16_t* h = (const bf16_t*)(WS(p) + OFF_H);
    const bf16_t* wb = (const bf16_t*)(WS(p) + OFF_WB);
    const float* rstd = (const float*)(WS(p) + OFF_RSTD);
    bf16_t* merged = (bf16_t*)(WS(p) + OFF_MERGED);
    const bf16_t* ysrc0 = (const bf16_t*)(WS(p) + OFF_PPOOL);
    const bf16_t* ysrc1 = (const bf16_t*)(WS(p) + OFF_PR);
    const bf16_t* ysrc2 = (const bf16_t*)(OUTB(p) + DO_YC);
    for (int tile = obid(); tile < 129 * 8; tile += gridDim.x) {
        const int mt = tile >> 3, nt = tile & 7;
        const int row0 = mt * 128, col0 = nt * 128;
        f32x4 macc[2][4]; zero_acc(macc);
#pragma unroll 1
        for (int i = 0; i < 3; ++i) {
            f32x4 ag[2][4], ay[2][4]; zero_acc(ag); zero_acc(ay);
            gemm_kloop(ag, h + (size_t)(row0 + (tid >> 2)) * DM + (tid & 3) * 8, wb + WB_WG + (size_t)(i * 1024 + col0 + (tid >> 2)) * DM + (tid & 3) * 8, DM, lds);
            const bf16_t* ys = (i == 0) ? ysrc0 : (i == 1 ? ysrc1 : ysrc2);
            gemm_kloop(ay, ys + (size_t)(row0 + (tid >> 2)) * DM + (tid & 3) * 8, wb + WB_PA + (size_t)(i * 1024 + col0 + (tid >> 2)) * DM + (tid & 3) * 8, DM, lds);
#pragma unroll
            for (int m = 0; m < 2; ++m)
#pragma unroll
                for (int j = 0; j < 4; ++j) {
                    const float rs = rstd[row0 + wr * 32 + m * 16 + fq * 4 + j];
#pragma unroll
                    for (int n = 0; n < 4; ++n) macc[m][n][j] += sigmoidf_(ag[m][n][j] * rs) * ay[m][n][j];
                }
        }
#pragma unroll
        for (int m = 0; m < 2; ++m)
#pragma unroll
            for (int j = 0; j < 4; ++j) {
                const int row = row0 + wr * 32 + m * 16 + fq * 4 + j;
#pragma unroll
                for (int n = 0; n < 4; ++n) merged[(size_t)row * 1024 + col0 + wc * 64 + n * 16 + fr] = f2bf(macc[m][n][j]);
            }
    }
}

__device__ void phase_outproj(const Params& p, unsigned char* lds) {
    const int tid = otid(), lane = tid & 63, wid = tid >> 6, wr = wid >> 1, wc = wid & 1, fr = lane & 15, fq = lane >> 4;
    const bf16_t* h = (const bf16_t*)(WS(p) + OFF_H);
    const bf16_t* wb = (const bf16_t*)(WS(p) + OFF_WB);
    const bf16_t* merged = (const bf16_t*)(WS(p) + OFF_MERGED);
    float* hm = (float*)(WS(p) + OFF_HM32);
    for (int tile = obid(); tile < 129 * 8; tile += gridDim.x) {
        const int mt = tile >> 3, nt = tile & 7;
        const int row0 = mt * 128, col0 = nt * 128;
        f32x4 acc[2][4]; zero_acc(acc);
        gemm_kloop(acc, merged + (size_t)(row0 + (tid >> 2)) * DM + (tid & 3) * 8, wb + WB_WO + (size_t)(col0 + (tid >> 2)) * DM + (tid & 3) * 8, DM, lds);
#pragma unroll
        for (int m = 0; m < 2; ++m)
#pragma unroll
            for (int j = 0; j < 4; ++j) {
                const int row = row0 + wr * 32 + m * 16 + fq * 4 + j;
#pragma unroll
                for (int n = 0; n < 4; ++n) {
                    const int col = col0 + wc * 64 + n * 16 + fr;
                    hm[(size_t)row * 1024 + col] = bf2f(h[(size_t)row * 1024 + col]) + acc[m][n][j];
                }
            }
    }
}

__device__ __constant__ int c_pair_lo[6] = {0, 0, 0, 1, 1, 2};
__device__ __constant__ int c_pair_hi[6] = {1, 2, 3, 2, 3, 3};
__device__ void phase_route(const Params& p, int l) {
    const int lane = otid() & 63;
    const int wave = (obid() * NTHR + otid()) >> 6, nw = gridDim.x * NTHR / 64;
    const float* hm = (const float*)(WS(p) + OFF_HM32);
    bf16_t* hn = (bf16_t*)(WS(p) + OFF_HN);
    const float* nf = p.in[33] + (size_t)l * 1024;
    const float* wg = p.in[34] + (size_t)l * 1024 * 4;
    const float* bg = p.in[35] + l * 4;
    const float* we = p.in[36] + (size_t)l * 1024 * 16;
    const float* be = p.in[37] + l * 16;
    int* cnt = (int*)(WS(p) + OFF_CTL);
    int* list = (int*)(WS(p) + OFF_LIST);
    float* pw = (float*)(WS(p) + OFF_PW);
    for (int n = wave; n < NT; n += nw) {
        float ss = 0.f;
#pragma unroll
        for (int i = 0; i < 4; ++i) {
            const float4 v = *(const float4*)(hm + (size_t)n * DM + i * 256 + lane * 4);
            ss += v.x * v.x + v.y * v.y + v.z * v.z + v.w * v.w;
        }
        ss = wave_sum(ss);
        const float rs = rsqrtf(ss * (1.0f / 1024.0f) + 1e-6f);
        float lg[4] = {0.f, 0.f, 0.f, 0.f};
        float le[16];
#pragma unroll
        for (int e = 0; e < 16; ++e) le[e] = 0.f;
#pragma unroll 1
        for (int i = 0; i < 4; ++i) {
            const float4 xv = *(const float4*)(hm + (size_t)n * DM + i * 256 + lane * 4);
            const float4 nv = *(const float4*)(nf + i * 256 + lane * 4);
            float y[4] = {xv.x * rs * nv.x, xv.y * rs * nv.y, xv.z * rs * nv.z, xv.w * rs * nv.w};
#pragma unroll
            for (int k = 0; k < 4; ++k) {
                const int d = i * 256 + lane * 4 + k;
                const float4 g4 = *(const float4*)(wg + (size_t)d * 4);
                lg[0] += y[k] * g4.x; lg[1] += y[k] * g4.y; lg[2] += y[k] * g4.z; lg[3] += y[k] * g4.w;
#pragma unroll
                for (int e4 = 0; e4 < 4; ++e4) {
                    const float4 w4 = *(const float4*)(we + (size_t)d * 16 + e4 * 4);
                    le[e4 * 4 + 0] += y[k] * w4.x; le[e4 * 4 + 1] += y[k] * w4.y; le[e4 * 4 + 2] += y[k] * w4.z; le[e4 * 4 + 3] += y[k] * w4.w;
                }
            }
            ushort4 o;
            o.x = f2bf(y[0]); o.y = f2bf(y[1]); o.z = f2bf(y[2]); o.w = f2bf(y[3]);
            *(ushort4*)(hn + (size_t)n * DM + i * 256 + lane * 4) = o;
        }
#pragma unroll
        for (int g = 0; g < 4; ++g) lg[g] = wave_sum(lg[g]) + bg[g];
#pragma unroll
        for (int e = 0; e < 16; ++e) le[e] = wave_sum(le[e]) + be[e];
        if (lane == 0) {
            int gs = 0; float gm = lg[0];
#pragma unroll
            for (int g = 1; g < 4; ++g) if (lg[g] > gm) { gm = lg[g]; gs = g; }
            float den = 0.f;
#pragma unroll
            for (int g = 0; g < 4; ++g) den += __expf(lg[g] - gm);
            const float pgrp = 1.0f / den;
            float v4[4];
#pragma unroll
            for (int e = 0; e < 4; ++e) {
                const float m0 = (gs == 0) ? 1.f : 0.f, m1s = (gs == 1) ? 1.f : 0.f, m2s = (gs == 2) ? 1.f : 0.f, m3s = (gs == 3) ? 1.f : 0.f;
                v4[e] = le[e] * m0 + le[4 + e] * m1s + le[8 + e] * m2s + le[12 + e] * m3s;
            }
            int i1 = 0; float m1 = v4[0];
#pragma unroll
            for (int e = 1; e < 4; ++e) if (v4[e] > m1) { m1 = v4[e]; i1 = e; }
            int i2 = -1; float m2 = -INFINITY;
#pragma unroll
            for (int e = 0; e < 4; ++e) if (e != i1 && v4[e] > m2) { m2 = v4[e]; i2 = e; }
            const float e2 = __expf(m2 - m1);
            const float p1 = pgrp / (1.0f + e2), p2 = pgrp * e2 / (1.0f + e2);
            const int lo = i1 < i2 ? i1 : i2, hi = i1 < i2 ? i2 : i1;
            const float plo = i1 < i2 ? p1 : p2, phi = i1 < i2 ? p2 : p1;
            const int pi = (lo == 0) ? (hi - 1) : (lo == 1 ? hi + 1 : 5);
            const int cls = gs * 6 + pi;
            const int pos = atomicAdd(&cnt[cls], 1);
            list[(size_t)cls * NT + pos] = n;
            pw[(size_t)n * 2 + 0] = plo; pw[(size_t)n * 2 + 1] = phi;
        }
    }
}

struct MoeTile { int cls, ti, cnt, tg; };
__device__ __forceinline__ int moe_total_tiles(const int* cnt) { int s = 0; for (int c = 0; c < 24; ++c) s += (cnt[c] + 127) >> 7; return s; }
__device__ __forceinline__ MoeTile moe_find(const int* cnt, int tile) {
    MoeTile r; int s = 0; r.cls = 0; r.ti = 0; r.cnt = 0; r.tg = tile;
    for (int c = 0; c < 24; ++c) { const int nt = (cnt[c] + 127) >> 7; if (tile >= s && tile < s + nt) { r.cls = c; r.ti = tile - s; r.cnt = cnt[c]; } s += nt; }
    return r;
}
__device__ void phase_moe1(const Params& p, unsigned char* lds) {
    const int tid = otid(), lane = tid & 63, wid = tid >> 6, wr = wid >> 1, wc = wid & 1, fr = lane & 15, fq = lane >> 4;
    const int* cnt = (const int*)(WS(p) + OFF_CTL);
    const int* list = (const int*)(WS(p) + OFF_LIST);
    const float* pw = (const float*)(WS(p) + OFF_PW);
    const bf16_t* hn = (const bf16_t*)(WS(p) + OFF_HN);
    const bf16_t* we = (const bf16_t*)(WS(p) + OFF_WEXP);
    bf16_t* hid = (bf16_t*)(OUTB(p) + DO_HID);
    const int total = moe_total_tiles(cnt);
    for (int item = obid(); item < total * 4; item += gridDim.x) {
        const MoeTile mt = moe_find(cnt, item >> 2);
        const int nt = item & 3, slot = nt >> 1, f0 = (nt & 1) * 128;
        const int g = mt.cls / 6, pi = mt.cls % 6;
        const int e = g * 4 + (slot == 0 ? c_pair_lo[pi] : c_pair_hi[pi]);
        const int* lst = list + (size_t)mt.cls * NT + mt.ti * 128;
        const int nvalid = min(128, mt.cnt - mt.ti * 128);
        const int ar = tid >> 2;
        const int tok = lst[ar < nvalid ? ar : 0];
        f32x4 a1[2][4], a3[2][4]; zero_acc(a1); zero_acc(a3);
        const bf16_t* arow = hn + (size_t)tok * DM + (tid & 3) * 8;
        gemm_kloop(a1, arow, we + WE_W1 + ((size_t)e * 256 + f0 + (tid >> 2)) * 1024 + (tid & 3) * 8, DM, lds);
        gemm_kloop(a3, arow, we + WE_W3 + ((size_t)e * 256 + f0 + (tid >> 2)) * 1024 + (tid & 3) * 8, DM, lds);
#pragma unroll
        for (int m = 0; m < 2; ++m)
#pragma unroll
            for (int j = 0; j < 4; ++j) {
                const int lr = wr * 32 + m * 16 + fq * 4 + j;
                const int tk = lst[lr < nvalid ? lr : 0];
                const float pe = pw[(size_t)tk * 2 + slot];
#pragma unroll
                for (int n = 0; n < 4; ++n) {
                    const int col = slot * 256 + f0 + wc * 64 + n * 16 + fr;
                    const float x1 = a1[m][n][j];
                    hid[((size_t)mt.tg * 128 + lr) * 512 + col] = f2bf(x1 * sigmoidf_(x1) * a3[m][n][j] * pe);
                }
            }
    }
}
__device__ void phase_moe2(const Params& p, unsigned char* lds) {
    const int tid = otid(), lane = tid & 63, wid = tid >> 6, wr = wid >> 1, wc = wid & 1, fr = lane & 15, fq = lane >> 4;
    const int* cnt = (const int*)(WS(p) + OFF_CTL);
    const int* list = (const int*)(WS(p) + OFF_LIST);
    const bf16_t* we = (const bf16_t*)(WS(p) + OFF_WEXP);
    const bf16_t* hid = (const bf16_t*)(OUTB(p) + DO_HID);
    float* hm = (float*)(WS(p) + OFF_HM32);
    bf16_t* h = (bf16_t*)(WS(p) + OFF_H);
    const int total = moe_total_tiles(cnt);
    for (int item = obid(); item < total * 8; item += gridDim.x) {
        const MoeTile mt = moe_find(cnt, item >> 3);
        const int nt = item & 7, col0 = nt * 128;
        const int g = mt.cls / 6, pi = mt.cls % 6;
        const int elo = g * 4 + c_pair_lo[pi], ehi = g * 4 + c_pair_hi[pi];
        const int* lst = list + (size_t)mt.cls * NT + mt.ti * 128;
        const int nvalid = min(128, mt.cnt - mt.ti * 128);
        f32x4 acc[2][4]; zero_acc(acc);
        const bf16_t* arow = hid + ((size_t)mt.tg * 128 + (tid >> 2)) * 512 + (tid & 3) * 8;
        gemm_kloop(acc, arow, we + WE_W2 + ((size_t)elo * 1024 + col0 + (tid >> 2)) * 256 + (tid & 3) * 8, 256, lds);
        gemm_kloop(acc, arow + 256, we + WE_W2 + ((size_t)ehi * 1024 + col0 + (tid >> 2)) * 256 + (tid & 3) * 8, 256, lds);
#pragma unroll
        for (int m = 0; m < 2; ++m)
#pragma unroll
            for (int j = 0; j < 4; ++j) {
                const int lr = wr * 32 + m * 16 + fq * 4 + j;
                if (lr < nvalid) {
                    const int tk = lst[lr];
#pragma unroll
                    for (int n = 0; n < 4; ++n) {
                        const int col = col0 + wc * 64 + n * 16 + fr;
                        const float v = hm[(size_t)tk * 1024 + col] + acc[m][n][j];
                        hm[(size_t)tk * 1024 + col] = v;
                        h[(size_t)tk * 1024 + col] = f2bf(v);
                    }
                }
            }
    }
}

__device__ void phase_final(const Params& p) {
    const int lane = otid() & 63;
    const int wave = (obid() * NTHR + otid()) >> 6, nw = gridDim.x * NTHR / 64;
    const float* hm = (const float*)(WS(p) + OFF_HM32);
    const float* nf = p.in[41];
    for (int r = wave; r < NB * SEQ; r += nw) {
        const int b = r / SEQ, s = r % SEQ;
        const size_t n = (size_t)b * TS + NMETA + s;
        float4 v[4]; float ss = 0.f;
#pragma unroll
        for (int i = 0; i < 4; ++i) { v[i] = *(const float4*)(hm + n * DM + i * 256 + lane * 4); ss += v[i].x * v[i].x + v[i].y * v[i].y + v[i].z * v[i].z + v[i].w * v[i].w; }
        ss = wave_sum(ss);
        const float rs = rsqrtf(ss * (1.0f / 1024.0f) + 1e-6f);
#pragma unroll
        for (int i = 0; i < 4; ++i) {
            const float4 g = *(const float4*)(nf + i * 256 + lane * 4);
            float4 o; o.x = v[i].x * rs * g.x; o.y = v[i].y * rs * g.y; o.z = v[i].z * rs * g.z; o.w = v[i].w * rs * g.w;
            *(float4*)((float*)OUTB(p) + (size_t)r * DM + i * 256 + lane * 4) = o;
        }
    }
}

__global__ void __launch_bounds__(NTHR) fwd_megakernel(Params p) {
    extern __shared__ __attribute__((aligned(16))) unsigned char lds[];
    cg::grid_group grid = cg::this_grid();
#pragma unroll 1
    for (int step = 0; step < 18; ++step) {
        const int l = step >= 9 ? 1 : 0;
        const int ph = step - l * 9;
        switch (ph) {
        case 0:
            if (l == 0) phase_embed(p); else phase_rowstat(p);
            phase_convert<false>(p, l, lds);
            if (obid() == 0 && otid() < 32) ((int*)(WS(p) + OFF_CTL))[otid()] = 0;
            break;
        case 1: phase_inproj(p, lds); break;
        case 2: phase_dsa_prep(p, l); phase_pool(p, l, lds); phase_scan(p, l, lds); break;
        case 3: phase_dsa<false>(p, l, lds, (bf16_t*)(OUTB(p) + DO_YC), nullptr, nullptr); break;
        case 4: phase_merge(p, lds); break;
        case 5: phase_outproj(p, lds); phase_convert<true>(p, l, lds); break;
        case 6: phase_route(p, l); break;
        case 7: phase_moe1(p, lds); break;
        default: phase_moe2(p, lds); break;
        }
        grid.sync();
    }
    phase_final(p);
}

extern "C" void kernel_launch(void* const* d_in, const int* in_sizes, int n_in,
                              void* d_out, int out_size, void* d_ws, size_t ws_size,
                              hipStream_t stream) {
    static int grid_blocks = 0;
    if (grid_blocks == 0) {
        int dev = 0, cus = 0, per_cu = 0;
        (void)hipGetDevice(&dev);
        (void)hipDeviceGetAttribute(&cus, hipDeviceAttributeMultiprocessorCount, dev);
        (void)hipFuncSetAttribute((const void*)fwd_megakernel, hipFuncAttributeMaxDynamicSharedMemorySize, LDS_BYTES);
        (void)hipOccupancyMaxActiveBlocksPerMultiprocessor(&per_cu, fwd_megakernel, NTHR, LDS_BYTES);
        if (per_cu < 1 || n_in != 42 || ws_size < WS_END) { fprintf(stderr, "kernel_launch: bad config per_cu=%d n_in=%d ws=%zu need=%zu\n", per_cu, n_in, ws_size, (size_t)WS_END); grid_blocks = -1; }
        else grid_blocks = cus;
    }
    if (grid_blocks < 0) return;
    Params p{};
    for (int i = 0; i < 42; ++i) p.in[i] = (const float*)d_in[i];
    p.out = (float*)d_out;
    p.ws = (unsigned char*)d_ws;
    void* args[] = {&p};
    hipError_t e = hipLaunchCooperativeKernel((void*)fwd_megakernel, dim3(grid_blocks), dim3(NTHR), args, LDS_BYTES, stream);
    if (e != hipSuccess) fprintf(stderr, "cooperative launch failed: %s (grid %d)\n", hipGetErrorString(e), grid_blocks);
}
```

```cpp
#include <hip/hip_runtime.h>
#include <hip/hip_cooperative_groups.h>
#include <cstdio>
#include <cstdint>
namespace cg = cooperative_groups;

typedef unsigned short bf16_t;
typedef short bf16x8 __attribute__((ext_vector_type(8)));
typedef float f32x4 __attribute__((ext_vector_type(4)));

constexpr int NB = 8, SEQ = 2048, NMETA = 16, TS = 2064, DM = 1024;
constexpr int NT = NB * TS;
constexpr int NTP = 16640;
constexpr int NTHR = 512;
constexpr int CIN = 7912;
constexpr int NP1 = 4992;
constexpr int PM_LD = 896;
constexpr int PM_WD = 0, PM_AD = 64, PM_GD = 128, PM_VD = 256, PM_CQ = 320, PM_CKV = 576, PM_KROPE = 704, PM_KIDX = 736, PM_WIDX = 800;
constexpr int LDS_BYTES = 157 * 1024;

constexpr size_t AL(size_t x) { return (x + 255) & ~(size_t)255; }
constexpr size_t SZ_ACT = (size_t)NTP * 1024 * 2;
constexpr size_t OFF_CTL = 0;
constexpr size_t OFF_RSTD = 4096;
constexpr size_t OFF_ROPE = OFF_RSTD + AL((size_t)NTP * 4);
constexpr size_t OFF_H = OFF_ROPE + AL((size_t)TS * 16 * 4 * 2);
constexpr size_t OFF_WB = OFF_H + SZ_ACT;
constexpr size_t WB_WIN = 0;
constexpr size_t WB_WG = WB_WIN + (size_t)NP1 * 1024;
constexpr size_t WB_PA = WB_WG + (size_t)3072 * 1024;
constexpr size_t WB_WO = WB_PA + (size_t)3 * 1024 * 1024;
constexpr size_t WB_POOL = WB_WO + (size_t)1024 * 1024;
constexpr size_t WB_QI = WB_POOL + (size_t)4 * 256 * 256;
constexpr size_t WB_UQ = WB_QI + (size_t)512 * 256;
constexpr size_t WB_UK = WB_UQ + (size_t)1536 * 256;
constexpr size_t WB_UV = WB_UK + (size_t)16 * 128 * 64;
constexpr size_t WB_END = WB_UV + (size_t)16 * 64 * 128;
constexpr size_t OFF_PPOOL = OFF_WB + AL(WB_END * 2);
constexpr size_t OFF_PK = OFF_PPOOL + SZ_ACT;
constexpr size_t OFF_PR = OFF_PK + SZ_ACT;
constexpr size_t OFF_PV = OFF_PR + SZ_ACT;
constexpr size_t OFF_PMISC = OFF_PV + SZ_ACT;
constexpr size_t OFF_VFIRST = OFF_PMISC + AL((size_t)NTP * PM_LD * 2);
constexpr size_t OFF_HALO = OFF_VFIRST + SZ_ACT;
constexpr size_t OFF_LIST = OFF_HALO + AL((size_t)130 * 16 * 1024 * 2);
constexpr size_t OFF_PW = OFF_LIST + AL((size_t)24 * NT * 4);
constexpr size_t WS_END = OFF_PW + AL((size_t)NT * 2 * 4);
constexpr size_t OFF_MERGED = OFF_PK;
constexpr size_t OFF_HM32 = OFF_PR;
constexpr size_t OFF_HN = OFF_PPOOL;
constexpr size_t OFF_WEXP = OFF_PMISC;
constexpr size_t WE_W1 = 0, WE_W3 = (size_t)16 * 256 * 1024, WE_W2 = (size_t)2 * 16 * 256 * 1024;
static_assert((size_t)3 * 16 * 256 * 1024 * 2 <= (size_t)NTP * PM_LD * 2, "expert weights must fit in Pmisc");
constexpr size_t DO_YC = 0;
constexpr size_t DO_CQN = DO_YC + SZ_ACT;
constexpr size_t DO_KV = DO_CQN + AL((size_t)NT * 256 * 2);
constexpr size_t DO_KIDX = DO_KV + AL((size_t)NT * 160 * 2);
constexpr size_t DO_WHEAD = DO_KIDX + AL((size_t)NT * 64 * 2);
constexpr size_t DO_END = DO_WHEAD + AL((size_t)NT * 8 * 4);
constexpr size_t DO_HID = DO_YC;
static_assert(DO_END <= (size_t)NB * SEQ * DM * 4, "d_out scratch overflow");
static_assert((size_t)(129 + 24) * 128 * 512 * 2 <= SZ_ACT, "hid fits");
static_assert(WS_END <= 277240096ull, "workspace overflow");

struct Params {
    const float* in[42];
    float* out;
    unsigned char* ws;
};

__device__ __forceinline__ int otid() { int t = threadIdx.x; asm volatile("" : "+v"(t)); return t; }
__device__ __forceinline__ int obid() { int b = blockIdx.x; asm volatile("" : "+s"(b)); return b; }
__device__ __forceinline__ unsigned char* WS(const Params& p) { unsigned char* w = p.ws; asm volatile("" : "+s"(w)); return w; }
__device__ __forceinline__ unsigned char* OUTB(const Params& p) { unsigned char* w = (unsigned char*)p.out; asm volatile("" : "+s"(w)); return w; }
__device__ __forceinline__ float bf2f(bf16_t v) { return __uint_as_float(((unsigned)v) << 16); }
__device__ __forceinline__ bf16_t f2bf(float f) { unsigned u = __float_as_uint(f); u += 0x7FFFu + ((u >> 16) & 1u); return (bf16_t)(u >> 16); }
__device__ __forceinline__ float wave_sum(float v) {
#pragma unroll
    for (int o = 32; o > 0; o >>= 1) v += __shfl_xor(v, o);
    return v;
}
__device__ __forceinline__ float sigmoidf_(float x) { return 1.0f / (1.0f + __expf(-x)); }
__device__ __forceinline__ float softplusf_(float z) { return fmaxf(z, 0.f) + log1pf(__expf(-fabsf(z))); }
__device__ __forceinline__ void glds16(const void* g, void* l) {
    __builtin_amdgcn_global_load_lds((const unsigned*)g, (unsigned*)l, 16, 0, 0);
}

__device__ __forceinline__ void gemm_kloop(f32x4 (&acc)[2][4], const bf16_t* arow, const bf16_t* brow, int K, unsigned char* lds) {
    const int tid = otid(), lane = tid & 63, wid = tid >> 6, wr = wid >> 1, wc = wid & 1, fr = lane & 15, fq = lane >> 4;
    const int nk = K >> 5;
    glds16(arow, lds + tid * 16);
    glds16(brow, lds + 8192 + tid * 16);
    for (int t = 0; t < nk; ++t) {
        asm volatile("s_waitcnt vmcnt(0)" ::: "memory");
        __syncthreads();
        unsigned char* cA = lds + (t & 1) * 16384;
        unsigned char* cB = cA + 8192;
        if (t + 1 < nk) {
            unsigned char* nA = lds + ((t + 1) & 1) * 16384;
            glds16(arow + (t + 1) * 32, nA + tid * 16);
            glds16(brow + (t + 1) * 32, nA + 8192 + tid * 16);
        }
        bf16x8 a[2], b[4];
#pragma unroll
        for (int m = 0; m < 2; ++m) a[m] = *(const bf16x8*)(cA + (wr * 32 + m * 16 + fr) * 64 + fq * 16);
#pragma unroll
        for (int n = 0; n < 4; ++n) b[n] = *(const bf16x8*)(cB + (wc * 64 + n * 16 + fr) * 64 + fq * 16);
#pragma unroll
        for (int m = 0; m < 2; ++m)
#pragma unroll
            for (int n = 0; n < 4; ++n) acc[m][n] = __builtin_amdgcn_mfma_f32_16x16x32_bf16(a[m], b[n], acc[m][n], 0, 0, 0);
    }
    __syncthreads();
}
__device__ __forceinline__ void zero_acc(f32x4 (&acc)[2][4]) {
#pragma unroll
    for (int m = 0; m < 2; ++m)
#pragma unroll
        for (int n = 0; n < 4; ++n) acc[m][n] = (f32x4){0.f, 0.f, 0.f, 0.f};
}

__device__ void phase_embed(const Params& p) {
    const int lane = otid() & 63;
    const int wave = (obid() * NTHR + otid()) >> 6, nw = gridDim.x * NTHR / 64;
    bf16_t* h = (bf16_t*)(WS(p) + OFF_H);
    float* rstd = (float*)(WS(p) + OFF_RSTD);
    for (int n = wave; n < NTP; n += nw) {
        if (n < NT) {
            const int b = n / TS, t = n % TS;
            const float* src = t < NMETA ? p.in[1] + (size_t)t * DM : p.in[0] + ((size_t)b * SEQ + (t - NMETA)) * DM;
            float ss = 0.f;
#pragma unroll
            for (int i = 0; i < 4; ++i) {
                const float4 v = *(const float4*)(src + i * 256 + lane * 4);
                ss += v.x * v.x + v.y * v.y + v.z * v.z + v.w * v.w;
                ushort4 o; o.x = f2bf(v.x); o.y = f2bf(v.y); o.z = f2bf(v.z); o.w = f2bf(v.w);
                *(ushort4*)(h + (size_t)n * DM + i * 256 + lane * 4) = o;
            }
            ss = wave_sum(ss);
            if (lane == 0) rstd[n] = rsqrtf(ss * (1.0f / 1024.0f) + 1e-6f);
        } else {
#pragma unroll
            for (int i = 0; i < 4; ++i) *(ushort4*)(h + (size_t)n * DM + i * 256 + lane * 4) = make_ushort4(0, 0, 0, 0);
            if (lane == 0) rstd[n] = 0.f;
        }
    }
    float* ctab = (float*)(WS(p) + OFF_ROPE);
    float* stab = ctab + TS * 16;
    for (int idx = obid() * NTHR + otid(); idx < TS * 16; idx += gridDim.x * NTHR) {
        const int t = idx >> 4, i = idx & 15;
        const float inv = powf(10000.0f, -(float)(2 * i) / 32.0f);
        const float ang = (float)t * inv;
        ctab[idx] = cosf(ang);
        stab[idx] = sinf(ang);
    }
}

__device__ void phase_rowstat(const Params& p) {
    const int lane = otid() & 63;
    const int wave = (obid() * NTHR + otid()) >> 6, nw = gridDim.x * NTHR / 64;
    const float* hm = (const float*)(WS(p) + OFF_HM32);
    float* rstd = (float*)(WS(p) + OFF_RSTD);
    for (int n = wave; n < NT; n += nw) {
        float ss = 0.f;
#pragma unroll
        for (int i = 0; i < 4; ++i) {
            const float4 v = *(const float4*)(hm + (size_t)n * DM + i * 256 + lane * 4);
            ss += v.x * v.x + v.y * v.y + v.z * v.z + v.w * v.w;
        }
        ss = wave_sum(ss);
        if (lane == 0) rstd[n] = rsqrtf(ss * (1.0f / 1024.0f) + 1e-6f);
    }
}

struct ConvJob { const float* src; bf16_t* dst; const float* scale; int ldsrc, K, nvalid, nrows, nb, notr; size_t sbs, dbs; };
__device__ __forceinline__ int conv_job_tiles(const ConvJob& j) { return j.nb * (j.nrows >> 6) * (j.K >> 6); }
__device__ void conv_tile(const ConvJob& j, int tile, float* lds) {
    const int per = (j.nrows >> 6) * (j.K >> 6);
    const int bi = tile / per, rem = tile % per;
    const int ktiles = j.K >> 6;
    const int n0 = (rem / ktiles) << 6, k0 = (rem % ktiles) << 6;
    const int tid = otid(), tn = tid & 63, tk = tid >> 6;
    const float* src = j.src + (size_t)bi * j.sbs;
    bf16_t* dst = j.dst + (size_t)bi * j.dbs;
#pragma unroll
    for (int kk = 0; kk < 8; ++kk) {
        const int k = k0 + tk * 8 + kk;
        float v = 0.f;
        if (n0 + tn < j.nvalid) { v = j.notr ? src[(size_t)(n0 + tn) * j.ldsrc + k] : src[(size_t)k * j.ldsrc + n0 + tn]; if (j.scale) v *= j.scale[k]; }
        lds[tn * 65 + tk * 8 + kk] = v;
    }
    __syncthreads();
    const int wn = tid >> 3, kq = tid & 7;
    uint4 o;
    unsigned w[4];
#pragma unroll
    for (int q = 0; q < 4; ++q) {
        const float lo = lds[wn * 65 + kq * 8 + 2 * q], hi = lds[wn * 65 + kq * 8 + 2 * q + 1];
        w[q] = (unsigned)f2bf(lo) | ((unsigned)f2bf(hi) << 16);
    }
    o.x = w[0]; o.y = w[1]; o.z = w[2]; o.w = w[3];
    *(uint4*)(dst + (size_t)(n0 + wn) * j.K + k0 + kq * 8) = o;
    __syncthreads();
}
__device__ ConvJob get_job_early(const Params& p, int l, int ji) {
    bf16_t* wb = (bf16_t*)(WS(p) + OFF_WB);
    const float* win = p.in[3] + (size_t)l * DM * CIN;
    const float* nm = p.in[2] + (size_t)l * DM;
    ConvJob j{}; j.nb = 1; j.sbs = 0; j.dbs = 0; j.K = 1024; j.ldsrc = CIN; j.scale = nm;
    switch (ji) {
    case 0: j.src = win + 3072; j.dst = wb + WB_WIN; j.nvalid = 4352; j.nrows = 4352; break;
    case 1: j.src = p.in[17]; j.ldsrc = 32; j.dst = wb + WB_WIN + (size_t)(4096 + PM_VD) * 1024; j.nvalid = (l == 0 ? 0 : 32); j.nrows = 64; break;
    case 2: j.src = win + 7424; j.dst = wb + WB_WIN + (size_t)(4096 + PM_CQ) * 1024; j.nvalid = 488; j.nrows = 576; break;
    case 3: j.src = win; j.dst = wb + WB_WG; j.nvalid = 3072; j.nrows = 3072; break;
    case 4: j.src = p.in[29] + (size_t)l * DM * DM; j.ldsrc = 1024; j.scale = nullptr; j.dst = wb + WB_PA; j.nvalid = 1024; j.nrows = 1024; break;
    case 5: j.src = p.in[30] + (size_t)l * DM * DM; j.ldsrc = 1024; j.scale = nullptr; j.dst = wb + WB_PA + (size_t)1024 * 1024; j.nvalid = 1024; j.nrows = 1024; break;
    case 6: j.src = p.in[31] + (size_t)l * DM * DM; j.ldsrc = 1024; j.scale = nullptr; j.dst = wb + WB_PA + (size_t)2 * 1024 * 1024; j.nvalid = 1024; j.nrows = 1024; break;
    case 7: j.src = p.in[32] + (size_t)l * DM * DM; j.ldsrc = 1024; j.scale = nullptr; j.dst = wb + WB_WO; j.nvalid = 1024; j.nrows = 1024; break;
    case 8: j.src = p.in[5] + (size_t)l * 4 * 256 * 256; j.ldsrc = 256; j.K = 256; j.scale = nullptr; j.dst = wb + WB_POOL; j.nvalid = 256; j.nrows = 256; j.nb = 4; j.sbs = 65536; j.dbs = 65536; break;
    case 9: j.src = p.in[26] + (size_t)l * 256 * 512; j.ldsrc = 512; j.K = 256; j.scale = nullptr; j.dst = wb + WB_QI; j.nvalid = 512; j.nrows = 512; break;
    case 10: j.src = p.in[23] + (size_t)l * 256 * 1536; j.ldsrc = 1536; j.K = 256; j.scale = nullptr; j.dst = wb + WB_UQ; j.nvalid = 1536; j.nrows = 1536; break;
    case 11: j.src = p.in[24] + (size_t)l * 16 * 128 * 64; j.ldsrc = 64; j.K = 64; j.scale = nullptr; j.dst = wb + WB_UK; j.nvalid = 2048; j.nrows = 2048; j.notr = 1; break;
    default: j.src = p.in[25] + (size_t)l * 16 * 128 * 64; j.ldsrc = 64; j.K = 128; j.scale = nullptr; j.dst = wb + WB_UV; j.nvalid = 64; j.nrows = 64; j.nb = 16; j.sbs = 8192; j.dbs = 8192; break;
    }
    return j;
}
__device__ ConvJob get_job_late(const Params& p, int l, int ji) {
    bf16_t* we = (bf16_t*)(WS(p) + OFF_WEXP);
    ConvJob j{}; j.nb = 16; j.scale = nullptr; j.sbs = 262144; j.dbs = 262144;
    switch (ji) {
    case 0: j.src = p.in[38] + (size_t)l * 16 * 262144; j.dst = we + WE_W1; j.ldsrc = 256; j.K = 1024; j.nvalid = 256; j.nrows = 256; break;
    case 1: j.src = p.in[39] + (size_t)l * 16 * 262144; j.dst = we + WE_W3; j.ldsrc = 256; j.K = 1024; j.nvalid = 256; j.nrows = 256; break;
    default: j.src = p.in[40] + (size_t)l * 16 * 262144; j.dst = we + WE_W2; j.ldsrc = 1024; j.K = 256; j.nvalid = 1024; j.nrows = 1024; break;
    }
    return j;
}
template <bool LATE>
__device__ void phase_convert(const Params& p, int l, unsigned char* lds) {
    const int njobs = LATE ? 3 : 13;
    int base = 0;
    for (int ji = 0; ji < njobs; ++ji) {
        const ConvJob j = LATE ? get_job_late(p, l, ji) : get_job_early(p, l, ji);
        const int nt = conv_job_tiles(j);
        int first = ((int)obid() - base) % (int)gridDim.x; if (first < 0) first += gridDim.x;
        for (int t = first; t < nt; t += gridDim.x) conv_tile(j, t, (float*)lds);
        base += nt;
    }
}

__device__ void phase_inproj(const Params& p, unsigned char* lds) {
    const int tid = otid(), lane = tid & 63, wid = tid >> 6, wr = wid >> 1, wc = wid & 1, fr = lane & 15, fq = lane >> 4;
    const bf16_t* h = (const bf16_t*)(WS(p) + OFF_H);
    const bf16_t* wt = (const bf16_t*)(WS(p) + OFF_WB) + WB_WIN;
    const float* rstd = (const float*)(WS(p) + OFF_RSTD);
    bf16_t* halo = (bf16_t*)(WS(p) + OFF_HALO);
    constexpr int NTN = NP1 / 128;
    for (int tile = obid(); tile < 129 * NTN; tile += gridDim.x) {
        const int mt = tile / NTN, nt = tile % NTN;
        const int row0 = mt * 128, col0 = nt * 128;
        f32x4 acc[2][4]; zero_acc(acc);
        gemm_kloop(acc, h + (size_t)(row0 + (tid >> 2)) * DM + (tid & 3) * 8, wt + (size_t)(col0 + (tid >> 2)) * DM + (tid & 3) * 8, DM, lds);
        bf16_t* dst; int ld, cbase;
        if (nt < 8) { dst = (bf16_t*)(WS(p) + OFF_PPOOL); ld = 1024; cbase = 0; }
        else if (nt < 16) { dst = (bf16_t*)(WS(p) + OFF_PR); ld = 1024; cbase = 1024; }
        else if (nt < 24) { dst = (bf16_t*)(WS(p) + OFF_PK); ld = 1024; cbase = 2048; }
        else if (nt < 32) { dst = (bf16_t*)(WS(p) + OFF_PV); ld = 1024; cbase = 3072; }
        else { dst = (bf16_t*)(WS(p) + OFF_PMISC); ld = PM_LD; cbase = 4096; }
#pragma unroll
        for (int m = 0; m < 2; ++m)
#pragma unroll
            for (int j = 0; j < 4; ++j) {
                const int lr = wr * 32 + m * 16 + fq * 4 + j;
                const int row = row0 + lr;
                const float rs = rstd[row];
#pragma unroll
                for (int n = 0; n < 4; ++n) {
                    const int col = col0 + wc * 64 + n * 16 + fr;
                    const bf16_t v = f2bf(acc[m][n][j] * rs);
                    dst[(size_t)row * ld + (col - cbase)] = v;
                    if (nt < 8 && lr >= 112) halo[((size_t)mt * 16 + (lr - 112)) * 1024 + col] = v;
                }
            }
    }
}

__device__ void phase_pool(const Params& p, int l, unsigned char* lds, int tb, int te, int tstep) {
    const int tid = otid(), lane = tid & 63, wid = tid >> 6, fr = lane & 15, fq = lane >> 4;
    bf16_t* pp = (bf16_t*)(WS(p) + OFF_PPOOL);
    const bf16_t* halo = (const bf16_t*)(WS(p) + OFF_HALO);
    const bf16_t* pw = (const bf16_t*)(WS(p) + OFF_WB) + WB_POOL;
    const float* scale = p.in[6] + (size_t)l * 1024;
    bf16_t* sp = (bf16_t*)lds;
    constexpr int SLD = 264;
    for (int tile = tb; tile < te; tile += tstep) {
        const int mt = tile >> 2, g = tile & 3;
        const int row0 = mt * 128, w = 2 << g;
        for (int e = tid; e < 128 * 256; e += NTHR) {
            const int r = e >> 8, c = e & 255;
            const int n = row0 + r, t = n % TS;
            const int col = g * 256 + c;
            const int cnt = (t + 1 < w) ? (t + 1) : w;
            float s = 0.f, self = 0.f;
            for (int i = 0; i < cnt; ++i) {
                const int n2 = n - i;
                float v;
                if (n2 >= row0) v = bf2f(pp[(size_t)n2 * 1024 + col]);
                else v = bf2f(halo[((size_t)(n2 >> 7) * 16 + ((n2 & 127) - 112)) * 1024 + col]);
                if (i == 0) self = v;
                s += v;
            }
            sp[r * SLD + c] = f2bf(s / (float)cnt - self);
        }
        __syncthreads();
        f32x4 acc[8][2];
#pragma unroll
        for (int m = 0; m < 8; ++m) { acc[m][0] = (f32x4){0.f, 0.f, 0.f, 0.f}; acc[m][1] = (f32x4){0.f, 0.f, 0.f, 0.f}; }
        const bf16_t* wg = pw + (size_t)g * 65536;
#pragma unroll 1
        for (int kk = 0; kk < 8; ++kk) {
            bf16x8 bfr[2];
#pragma unroll
            for (int n = 0; n < 2; ++n) bfr[n] = *(const bf16x8*)(wg + (size_t)(wid * 32 + n * 16 + fr) * 256 + kk * 32 + fq * 8);
#pragma unroll
            for (int m = 0; m < 8; ++m) {
                const bf16x8 a = *(const bf16x8*)(sp + (m * 16 + fr) * SLD + kk * 32 + fq * 8);
                acc[m][0] = __builtin_amdgcn_mfma_f32_16x16x32_bf16(a, bfr[0], acc[m][0], 0, 0, 0);
                acc[m][1] = __builtin_amdgcn_mfma_f32_16x16x32_bf16(a, bfr[1], acc[m][1], 0, 0, 0);
            }
        }
#pragma unroll
        for (int m = 0; m < 8; ++m)
#pragma unroll
            for (int n = 0; n < 2; ++n) {
                const int col = g * 256 + wid * 32 + n * 16 + fr;
                const float sc = scale[col];
#pragma unroll
                for (int j = 0; j < 4; ++j) {
                    const int row = row0 + m * 16 + fq * 4 + j;
                    pp[(size_t)row * 1024 + col] = f2bf(acc[m][n][j] * sc);
                }
            }
        __syncthreads();
    }
}

__device__ void phase_dsa_prep(const Params& p, int l) {
    const int lane = otid() & 63;
    const int wave = (obid() * NTHR + otid()) >> 6, nw = gridDim.x * NTHR / 64;
    const bf16_t* pm = (const bf16_t*)(WS(p) + OFF_PMISC);
    unsigned char* dob = OUTB(p);
    bf16_t* cqn = (bf16_t*)(dob + DO_CQN);
    bf16_t* kv = (bf16_t*)(dob + DO_KV);
    bf16_t* kidx = (bf16_t*)(dob + DO_KIDX);
    float* whead = (float*)(dob + DO_WHEAD);
    const float* ctab = (const float*)(WS(p) + OFF_ROPE);
    const float* stab = ctab + TS * 16;
    const float* qn = p.in[21] + l * 256;
    const float* kvn = p.in[22] + l * 128;
    const float* inw = p.in[27] + l * 64;
    const float* inb = p.in[28] + l * 64;
    for (int n = wave; n < NT; n += nw) {
        const int t = n % TS;
        const bf16_t* row = pm + (size_t)n * PM_LD;
        {
            float v[4]; float ss = 0.f;
#pragma unroll
            for (int i = 0; i < 4; ++i) { v[i] = bf2f(row[PM_CQ + lane * 4 + i]); ss += v[i] * v[i]; }
            ss = wave_sum(ss);
            const float rs = rsqrtf(ss * (1.0f / 256.0f) + 1e-6f);
#pragma unroll
            for (int i = 0; i < 4; ++i) cqn[(size_t)n * 256 + lane * 4 + i] = f2bf(v[i] * rs * qn[lane * 4 + i]);
        }
        {
            float v[2]; float ss = 0.f;
#pragma unroll
            for (int i = 0; i < 2; ++i) { v[i] = bf2f(row[PM_CKV + lane * 2 + i]); ss += v[i] * v[i]; }
            ss = wave_sum(ss);
            const float rs = rsqrtf(ss * (1.0f / 128.0f) + 1e-6f);
#pragma unroll
            for (int i = 0; i < 2; ++i) kv[(size_t)n * 160 + lane * 2 + i] = f2bf(v[i] * rs * kvn[lane * 2 + i]);
        }
        if (lane < 16) {
            const float x1 = bf2f(row[PM_KROPE + lane]), x2 = bf2f(row[PM_KROPE + 16 + lane]);
            const float c = ctab[t * 16 + lane], s = stab[t * 16 + lane];
            kv[(size_t)n * 160 + 128 + lane] = f2bf(x1 * c - x2 * s);
            kv[(size_t)n * 160 + 144 + lane] = f2bf(x2 * c + x1 * s);
        }
        {
            const float x = bf2f(row[PM_KIDX + lane]);
            const float mu = wave_sum(x) * (1.0f / 64.0f);
            const float d = x - mu;
            const float var = wave_sum(d * d) * (1.0f / 64.0f);
            const float y = d * rsqrtf(var + 1e-6f) * inw[lane] + inb[lane];
            const float yo = __shfl_xor(y, 16);
            float o = y;
            if (lane < 32) {
                const int i = lane & 15;
                const float c = ctab[t * 16 + i], s = stab[t * 16 + i];
                o = (lane < 16) ? (y * c - yo * s) : (y * c + yo * s);
            }
            kidx[(size_t)n * 64 + lane] = f2bf(o);
        }
        if (lane < 8) whead[(size_t)n * 8 + lane] = bf2f(row[PM_WIDX + lane]) * 0.04419417382415922f;
    }
}

__device__ void phase_scan(const Params& p, int l, unsigned char* lds) {
    if (obid() >= NB * 16) return;
    const int tid = otid(), lane = tid & 63, wid = tid >> 6;
    const int b = obid() >> 4, hh = obid() & 15, hc = hh * 64;
    constexpr int TC = 16;
    float* s_r = (float*)lds;
    float* s_w = s_r + TC * 64;
    float* s_k = s_w + TC * 64;
    float* s_v = s_k + TC * 64;
    float* s_a = s_v + TC * 64;
    float* s_b = s_a + TC * 64;
    float* s_g = s_b + TC * 64;
    float* s_o = s_g + TC * 64;
    float* s_wd = s_o + TC * 64;
    float* s_ad = s_wd + TC * 64;
    float* s_gd = s_ad + TC * 64;
    float* s_vd = s_gd + TC * 128;
    float* s_pr = s_vd + TC * 32;
    float* s_W2 = s_pr + 128;
    float* s_A2 = s_W2 + 64 * 64;
    float* s_G2 = s_A2 + 64 * 64;
    float* s_V2 = s_G2 + 128 * 64;
    bf16_t* Pr = (bf16_t*)(WS(p) + OFF_PR);
    const bf16_t* Pk = (const bf16_t*)(WS(p) + OFF_PK);
    const bf16_t* Pv = (const bf16_t*)(WS(p) + OFF_PV);
    const bf16_t* Pm = (const bf16_t*)(WS(p) + OFF_PMISC);
    bf16_t* vfirst = (bf16_t*)(WS(p) + OFF_VFIRST);
    const float* mu = p.in[4] + (size_t)l * 3328;
    const float* vmu = p.in[18];
    const float* w0 = p.in[7] + l * 1024;
    const float* a0 = p.in[9] + l * 1024;
    const float* k_k = p.in[12] + l * 1024;
    const float* k_a = p.in[13] + l * 1024;
    const float* r_k = p.in[14] + l * 1024;
    const float* ln_w = p.in[15] + l * 1024;
    const float* ln_b = p.in[16] + l * 1024;
    const float* v0 = p.in[19];
    for (int e = tid; e < 64 * 64; e += NTHR) { const int m = e >> 6, c = e & 63; s_W2[e] = p.in[8][((size_t)l * 64 + m) * 1024 + hc + c]; s_A2[e] = p.in[10][((size_t)l * 64 + m) * 1024 + hc + c]; }
    for (int e = tid; e < 128 * 64; e += NTHR) { const int m = e >> 6, c = e & 63; s_G2[e] = p.in[11][((size_t)l * 128 + m) * 1024 + hc + c]; }
    for (int e = tid; e < 32 * 64; e += NTHR) { const int m = e >> 6, c = e & 63; s_V2[e] = (l > 0) ? p.in[20][(size_t)m * 1024 + hc + c] : 0.f; }
    float S[8];
#pragma unroll
    for (int j = 0; j < 8; ++j) S[j] = 0.f;
    const int si = tid >> 3, q8 = tid & 7;
    __syncthreads();
    for (int t0 = 0, ch = 0; t0 < TS; t0 += TC, ++ch) {
        for (int e = tid; e < TC * 64; e += NTHR) {
            const int tau = e >> 6, c = e & 63, t = t0 + tau;
            const size_t n = (size_t)b * TS + t;
            const float cr = bf2f(Pr[n * 1024 + hc + c]);
            const float ck = bf2f(Pk[n * 1024 + hc + c]);
            const float cv = bf2f(Pv[n * 1024 + hc + c]);
            float prr = 0.f, prk = 0.f, prv = 0.f;
            if (t > 0) {
                prr = (tau > 0) ? bf2f(Pr[(n - 1) * 1024 + hc + c]) : s_pr[((ch + 1) & 1) * 64 + c];
                prk = bf2f(Pk[(n - 1) * 1024 + hc + c]);
                prv = bf2f(Pv[(n - 1) * 1024 + hc + c]);
            }
            if (tau == TC - 1) s_pr[(ch & 1) * 64 + c] = cr;
            s_r[e] = cr + (prr - cr) * mu[hc + c];
            s_k[e] = ck + (prk - ck) * mu[1024 + hc + c];
            s_v[e] = cv + (prv - cv) * mu[2048 + hc + c];
            const float cwd = bf2f(Pm[n * PM_LD + PM_WD + c]), cad = bf2f(Pm[n * PM_LD + PM_AD + c]);
            float pwd = 0.f, pad_ = 0.f;
            if (t > 0) { pwd = bf2f(Pm[(n - 1) * PM_LD + PM_WD + c]); pad_ = bf2f(Pm[(n - 1) * PM_LD + PM_AD + c]); }
            s_wd[e] = tanhf(cwd + (pwd - cwd) * mu[3072 + c]);
            s_ad[e] = cad + (pad_ - cad) * mu[3136 + c];
        }
        for (int e = tid; e < TC * 128; e += NTHR) {
            const int tau = e >> 7, c = e & 127, t = t0 + tau;
            const size_t n = (size_t)b * TS + t;
            const float cg_ = bf2f(Pm[n * PM_LD + PM_GD + c]);
            const float pg = (t > 0) ? bf2f(Pm[(n - 1) * PM_LD + PM_GD + c]) : 0.f;
            s_gd[e] = sigmoidf_(cg_ + (pg - cg_) * mu[3200 + c]);
        }
        if (l > 0) {
            for (int e = tid; e < TC * 32; e += NTHR) {
                const int tau = e >> 5, c = e & 31, t = t0 + tau;
                const size_t n = (size_t)b * TS + t;
                const float cvd = bf2f(Pm[n * PM_LD + PM_VD + c]);
                const float pvd = (t > 0) ? bf2f(Pm[(n - 1) * PM_LD + PM_VD + c]) : 0.f;
                s_vd[e] = cvd + (pvd - cvd) * vmu[c];
            }
        }
        __syncthreads();
        for (int e = tid; e < TC * 64; e += NTHR) {
            const int tau = e >> 6, c = e & 63, t = t0 + tau;
            const size_t n = (size_t)b * TS + t;
            float xw = w0[hc + c], xa = a0[hc + c], gg = 0.f, xv = 0.f;
#pragma unroll 8
            for (int m = 0; m < 64; ++m) { xw += s_wd[tau * 64 + m] * s_W2[m * 64 + c]; xa += s_ad[tau * 64 + m] * s_A2[m * 64 + c]; }
#pragma unroll 8
            for (int m = 0; m < 128; ++m) gg += s_gd[tau * 128 + m] * s_G2[m * 64 + c];
            const float wlog = -softplusf_(-xw) - 0.5f;
            const float decay = __expf(-__expf(wlog));
            const float a = sigmoidf_(xa);
            float vv = s_v[e];
            if (l > 0) {
                xv = v0[hc + c];
#pragma unroll 8
                for (int m = 0; m < 32; ++m) xv += s_vd[tau * 32 + m] * s_V2[m * 64 + c];
                const float vf = bf2f(vfirst[n * 1024 + hc + c]);
                vv = vv + (vf - vv) * sigmoidf_(xv);
            } else {
                vfirst[n * 1024 + hc + c] = f2bf(vv);
            }
            const float kraw = s_k[e];
            const float kkv = kraw * k_k[hc + c];
            const float nrm = sqrtf(wave_sum(kkv * kkv));
            const float kk = kkv / fmaxf(nrm, 1e-12f);
            s_w[e] = decay;
            s_a[e] = -kk;
            s_b[e] = kk * a;
            s_k[e] = kraw * (1.0f + (a - 1.0f) * k_a[hc + c]);
            s_v[e] = vv;
            s_g[e] = gg;
        }
        __syncthreads();
#pragma unroll 1
        for (int tau = 0; tau < TC; ++tau) {
            const float4 a0v = *(const float4*)(s_a + tau * 64 + q8 * 8), a1v = *(const float4*)(s_a + tau * 64 + q8 * 8 + 4);
            const float4 w0v = *(const float4*)(s_w + tau * 64 + q8 * 8), w1v = *(const float4*)(s_w + tau * 64 + q8 * 8 + 4);
            const float4 b0v = *(const float4*)(s_b + tau * 64 + q8 * 8), b1v = *(const float4*)(s_b + tau * 64 + q8 * 8 + 4);
            const float4 k0v = *(const float4*)(s_k + tau * 64 + q8 * 8), k1v = *(const float4*)(s_k + tau * 64 + q8 * 8 + 4);
            const float4 r0v = *(const float4*)(s_r + tau * 64 + q8 * 8), r1v = *(const float4*)(s_r + tau * 64 + q8 * 8 + 4);
            const float vi = s_v[tau * 64 + si];
            const float av[8] = {a0v.x, a0v.y, a0v.z, a0v.w, a1v.x, a1v.y, a1v.z, a1v.w};
            const float wv[8] = {w0v.x, w0v.y, w0v.z, w0v.w, w1v.x, w1v.y, w1v.z, w1v.w};
            const float bv[8] = {b0v.x, b0v.y, b0v.z, b0v.w, b1v.x, b1v.y, b1v.z, b1v.w};
            const float kv_[8] = {k0v.x, k0v.y, k0v.z, k0v.w, k1v.x, k1v.y, k1v.z, k1v.w};
            const float rv[8] = {r0v.x, r0v.y, r0v.z, r0v.w, r1v.x, r1v.y, r1v.z, r1v.w};
            float sa = 0.f;
#pragma unroll
            for (int j = 0; j < 8; ++j) sa += S[j] * av[j];
            sa += __shfl_xor(sa, 1); sa += __shfl_xor(sa, 2); sa += __shfl_xor(sa, 4);
            float o = 0.f;
#pragma unroll
            for (int j = 0; j < 8; ++j) { S[j] = S[j] * wv[j] + sa * bv[j] + vi * kv_[j]; o += S[j] * rv[j]; }
            o += __shfl_xor(o, 1); o += __shfl_xor(o, 2); o += __shfl_xor(o, 4);
            if (q8 == 0) s_o[tau * 64 + si] = o;
        }
        __syncthreads();
        for (int tau = wid; tau < TC; tau += 8) {
            const int c = lane, e = tau * 64 + c;
            const size_t n = (size_t)b * TS + t0 + tau;
            const float o = s_o[e];
            const float m_ = wave_sum(o) * (1.0f / 64.0f);
            const float d = o - m_;
            const float var = wave_sum(d * d) * (1.0f / 64.0f);
            const float on = d * rsqrtf(var + 64e-5f) * ln_w[hc + c] + ln_b[hc + c];
            const float bonus = wave_sum(s_r[e] * s_k[e] * r_k[hc + c]) * s_v[e];
            Pr[n * 1024 + hc + c] = f2bf((on + bonus) * s_g[e]);
        }
        __syncthreads();
    }
}

__device__ void phase_dsa_naive(const Params& p, int l, unsigned char* lds) {
    const int tid = otid(), lane = tid & 63, wid = tid >> 6;
    constexpr int QT = 4, SCL = 2080;
    float* s_cq = (float*)lds;
    float* s_q = s_cq + QT * 256;
    float* s_Q = s_q + QT * 1536;
    float* s_qi = s_Q + QT * 16 * 160;
    float* s_sc = s_qi + QT * 512;
    int* s_sel = (int*)(s_sc + QT * SCL);
    int* s_nsel = s_sel + QT * 256;
    float* s_p = (float*)(s_nsel + 16);
    float* s_ol = s_p + 16 * 256;
    float* s_wh = s_ol + 16 * 128;
    unsigned char* dob = OUTB(p);
    const bf16_t* cqn = (const bf16_t*)(dob + DO_CQN);
    const bf16_t* kv = (const bf16_t*)(dob + DO_KV);
    const bf16_t* kidx = (const bf16_t*)(dob + DO_KIDX);
    const float* whead = (const float*)(dob + DO_WHEAD);
    bf16_t* yc = (bf16_t*)(dob + DO_YC);
    const float* ctab = (const float*)(WS(p) + OFF_ROPE);
    const float* stab = ctab + TS * 16;
    const float* w_uq = p.in[23] + (size_t)l * 256 * 1536;
    const float* w_uk = p.in[24] + (size_t)l * 16 * 128 * 64;
    const float* w_uv = p.in[25] + (size_t)l * 16 * 128 * 64;
    const float* w_qi = p.in[26] + (size_t)l * 256 * 512;
    const float scale = 0.10206207261596575f;
    for (int tile = obid(); tile < NT / QT; tile += gridDim.x) {
        const int n0 = tile * QT, b = n0 / TS, t0 = n0 % TS;
        for (int e = tid; e < QT * 256; e += NTHR) s_cq[e] = bf2f(cqn[(size_t)n0 * 256 + e]);
        if (tid < QT * 8) s_wh[tid] = whead[(size_t)n0 * 8 + tid];
        __syncthreads();
        {
            float acc[3][QT];
#pragma unroll
            for (int c = 0; c < 3; ++c)
#pragma unroll
                for (int q = 0; q < QT; ++q) acc[c][q] = 0.f;
            float ai[QT];
#pragma unroll
            for (int q = 0; q < QT; ++q) ai[q] = 0.f;
            for (int i = 0; i < 256; ++i) {
                const float wa = w_uq[(size_t)i * 1536 + tid], wb_ = w_uq[(size_t)i * 1536 + 512 + tid], wc_ = w_uq[(size_t)i * 1536 + 1024 + tid];
                const float wi = w_qi[(size_t)i * 512 + tid];
#pragma unroll
                for (int q = 0; q < QT; ++q) {
                    const float c = s_cq[q * 256 + i];
                    acc[0][q] += c * wa; acc[1][q] += c * wb_; acc[2][q] += c * wc_; ai[q] += c * wi;
                }
            }
#pragma unroll
            for (int q = 0; q < QT; ++q) {
                s_q[q * 1536 + tid] = acc[0][q]; s_q[q * 1536 + 512 + tid] = acc[1][q]; s_q[q * 1536 + 1024 + tid] = acc[2][q];
                s_qi[q * 512 + tid] = ai[q];
            }
        }
        __syncthreads();
        for (int e = tid; e < QT * 16 * 16; e += NTHR) {
            const int q = e >> 8, h = (e >> 4) & 15, i = e & 15;
            const float x1 = s_q[q * 1536 + h * 96 + 64 + i], x2 = s_q[q * 1536 + h * 96 + 80 + i];
            const float c = ctab[(t0 + q) * 16 + i], s = stab[(t0 + q) * 16 + i];
            s_Q[(q * 16 + h) * 160 + 128 + i] = x1 * c - x2 * s;
            s_Q[(q * 16 + h) * 160 + 144 + i] = x2 * c + x1 * s;
        }
        {
            const int q = tid >> 7, h8 = (tid >> 4) & 7, i = tid & 15;
            const float x1 = s_qi[q * 512 + h8 * 64 + i], x2 = s_qi[q * 512 + h8 * 64 + 16 + i];
            const float c = ctab[(t0 + q) * 16 + i], s = stab[(t0 + q) * 16 + i];
            __syncthreads();
            s_qi[q * 512 + h8 * 64 + i] = x1 * c - x2 * s;
            s_qi[q * 512 + h8 * 64 + 16 + i] = x2 * c + x1 * s;
        }
        for (int id = tid; id < 16 * 128; id += NTHR) {
            const int h = id >> 7, c = id & 127;
            const float* wrow = w_uk + ((size_t)h * 128 + c) * 64;
            float acc[QT];
#pragma unroll
            for (int q = 0; q < QT; ++q) acc[q] = 0.f;
            for (int d = 0; d < 64; d += 4) {
                const float4 w4 = *(const float4*)(wrow + d);
#pragma unroll
                for (int q = 0; q < QT; ++q) {
                    const float* qq = s_q + q * 1536 + h * 96 + d;
                    acc[q] += qq[0] * w4.x + qq[1] * w4.y + qq[2] * w4.z + qq[3] * w4.w;
                }
            }
#pragma unroll
            for (int q = 0; q < QT; ++q) s_Q[(q * 16 + h) * 160 + c] = acc[q];
        }
        __syncthreads();
        const int tmax = t0 + QT - 1;
        for (int s = tid; s <= tmax; s += NTHR) {
            float kr[64];
            const bf16_t* krow = kidx + ((size_t)b * TS + s) * 64;
#pragma unroll
            for (int v8 = 0; v8 < 8; ++v8) {
                const uint4 u = *(const uint4*)(krow + v8 * 8);
                kr[v8 * 8 + 0] = __uint_as_float(u.x << 16); kr[v8 * 8 + 1] = __uint_as_float(u.x & 0xFFFF0000u);
                kr[v8 * 8 + 2] = __uint_as_float(u.y << 16); kr[v8 * 8 + 3] = __uint_as_float(u.y & 0xFFFF0000u);
                kr[v8 * 8 + 4] = __uint_as_float(u.z << 16); kr[v8 * 8 + 5] = __uint_as_float(u.z & 0xFFFF0000u);
                kr[v8 * 8 + 6] = __uint_as_float(u.w << 16); kr[v8 * 8 + 7] = __uint_as_float(u.w & 0xFFFF0000u);
            }
#pragma unroll 1
            for (int q = 0; q < QT; ++q) {
                float I = 0.f;
#pragma unroll 1
                for (int h = 0; h < 8; ++h) {
                    const float* qq = s_qi + q * 512 + h * 64;
                    float d = 0.f;
#pragma unroll
                    for (int j = 0; j < 64; ++j) d += qq[j] * kr[j];
                    I += s_wh[q * 8 + h] * fmaxf(d, 0.f);
                }
                s_sc[q * SCL + s] = I;
            }
        }
        __syncthreads();
        if (wid < QT) {
            const int q = wid, t = t0 + q, nadm = t + 1;
            const float* sc = s_sc + q * SCL;
            int* sel = s_sel + q * 256;
            if (nadm <= 256) {
                for (int i = lane; i < nadm; i += 64) sel[i] = i;
                if (lane == 0) s_nsel[q] = nadm;
            } else {
                const int nch = (nadm + 63) >> 6;
                unsigned T = 0u;
                for (int bit = 31; bit >= 0; --bit) {
                    const unsigned cand = T | (1u << bit);
                    int cnt = 0;
                    for (int c = 0; c < nch; ++c) {
                        const int s = c * 64 + lane;
                        bool ge = false;
                        if (s < nadm) { const unsigned u = __float_as_uint(sc[s]); const unsigned key = (u & 0x80000000u) ? ~u : (u | 0x80000000u); ge = key >= cand; }
                        cnt += __popcll(__ballot(ge));
                    }
                    if (cnt >= 256) T = cand;
                }
                int ngt = 0;
                for (int c = 0; c < nch; ++c) {
                    const int s = c * 64 + lane;
                    bool gt = false;
                    if (s < nadm) { const unsigned u = __float_as_uint(sc[s]); const unsigned key = (u & 0x80000000u) ? ~u : (u | 0x80000000u); gt = key > T; }
                    ngt += __popcll(__ballot(gt));
                }
                const int rties = 256 - ngt;
                int base = 0, ties = 0;
                const unsigned long long ltmask = (1ull << lane) - 1ull;
                for (int c = 0; c < nch; ++c) {
                    const int s = c * 64 + lane;
                    bool gt = false, eq = false;
                    if (s < nadm) { const unsigned u = __float_as_uint(sc[s]); const unsigned key = (u & 0x80000000u) ? ~u : (u | 0x80000000u); gt = key > T; eq = key == T; }
                    const unsigned long long em = __ballot(eq);
                    const int myrank = ties + __popcll(em & ltmask);
                    const bool take = gt || (eq && myrank < rties);
                    const unsigned long long tm = __ballot(take);
                    const int pos = base + __popcll(tm & ltmask);
                    if (take && pos < 256) sel[pos] = s;
                    base += __popcll(tm); ties += __popcll(em);
                }
                if (lane == 0) s_nsel[q] = 256;
            }
        }
        __syncthreads();
        for (int q = 0; q < QT; ++q) {
            const int nsel = s_nsel[q];
            const int* sel = s_sel + q * 256;
            {
                const int h = tid >> 5, kg = tid & 31;
                const float* qv = s_Q + (q * 16 + h) * 160;
                float mx = -INFINITY;
#pragma unroll 1
                for (int kk = 0; kk < 8; ++kk) {
                    const int ki = kg + kk * 32;
                    float sv = -INFINITY;
                    if (ki < nsel) {
                        const bf16_t* krow = kv + ((size_t)b * TS + sel[ki]) * 160;
                        float d = 0.f;
#pragma unroll 4
                        for (int v8 = 0; v8 < 20; ++v8) {
                            const uint4 u = *(const uint4*)(krow + v8 * 8);
                            const float* qq = qv + v8 * 8;
                            d += qq[0] * __uint_as_float(u.x << 16) + qq[1] * __uint_as_float(u.x & 0xFFFF0000u)
                               + qq[2] * __uint_as_float(u.y << 16) + qq[3] * __uint_as_float(u.y & 0xFFFF0000u)
                               + qq[4] * __uint_as_float(u.z << 16) + qq[5] * __uint_as_float(u.z & 0xFFFF0000u)
                               + qq[6] * __uint_as_float(u.w << 16) + qq[7] * __uint_as_float(u.w & 0xFFFF0000u);
                        }
                        sv = d * scale;
                    }
                    s_p[h * 256 + ki] = sv; mx = fmaxf(mx, sv);
                }
#pragma unroll
                for (int o = 16; o > 0; o >>= 1) mx = fmaxf(mx, __shfl_xor(mx, o));
                float sum = 0.f;
#pragma unroll 1
                for (int kk = 0; kk < 8; ++kk) { const float sv = s_p[h * 256 + kg + kk * 32]; const float e = (sv == -INFINITY) ? 0.f : __expf(sv - mx); s_p[h * 256 + kg + kk * 32] = e; sum += e; }
#pragma unroll
                for (int o = 16; o > 0; o >>= 1) sum += __shfl_xor(sum, o);
                const float inv = 1.0f / sum;
#pragma unroll 1
                for (int kk = 0; kk < 8; ++kk) s_p[h * 256 + kg + kk * 32] *= inv;
            }
            __syncthreads();
            {
                const int h = tid >> 5, c4 = tid & 31;
                float a0_ = 0.f, a1_ = 0.f, a2_ = 0.f, a3_ = 0.f;
                for (int k = 0; k < nsel; ++k) {
                    const float pk = s_p[h * 256 + k];
                    const uint2 u = *(const uint2*)(kv + ((size_t)b * TS + sel[k]) * 160 + c4 * 4);
                    a0_ += pk * __uint_as_float(u.x << 16); a1_ += pk * __uint_as_float(u.x & 0xFFFF0000u);
                    a2_ += pk * __uint_as_float(u.y << 16); a3_ += pk * __uint_as_float(u.y & 0xFFFF0000u);
                }
                float* o = s_ol + h * 128 + c4 * 4;
                o[0] = a0_; o[1] = a1_; o[2] = a2_; o[3] = a3_;
            }
            __syncthreads();
            for (int id = tid; id < 1024; id += NTHR) {
                const int h = id >> 6, v = id & 63;
                float acc = 0.f;
                for (int c = 0; c < 128; ++c) acc += s_ol[h * 128 + c] * w_uv[((size_t)h * 128 + c) * 64 + v];
                yc[(size_t)(n0 + q) * 1024 + id] = f2bf(acc);
            }
            __syncthreads();
        }
    }
}


typedef short s16x4 __attribute__((ext_vector_type(4)));
__device__ __forceinline__ unsigned f2h_bits(float f) { const _Float16 h = (_Float16)f; unsigned short u; __builtin_memcpy(&u, &h, 2); return u; }
template <bool IMPORT_SEL>
__device__ void phase_dsa(const Params& p, int l, unsigned char* lds, bf16_t* yc, const unsigned short* gsel, const int* gnsel, int tb, int te, int tstep) {
    const int tid = otid(), lane = tid & 63, wid = tid >> 6, fr = lane & 15, fq = lane >> 4;
    unsigned short* s_sc = (unsigned short*)lds;
    bf16_t* s_qi = (bf16_t*)(lds + 66048);
    bf16_t* s_Q = (bf16_t*)lds;
    unsigned char* s_Vw = lds + 82432 + wid * 8192;
    bf16_t* s_qn = (bf16_t*)s_Vw;
    unsigned short* s_sel = (unsigned short*)(lds + 82432 + 65536);
    int* s_nsel = (int*)(lds + 82432 + 65536 + 8192);
    unsigned char* dob = OUTB(p);
    const bf16_t* cqn = (const bf16_t*)(dob + DO_CQN);
    const bf16_t* kv = (const bf16_t*)(dob + DO_KV);
    const bf16_t* kidx = (const bf16_t*)(dob + DO_KIDX);
    const float* whead = (const float*)(dob + DO_WHEAD);
    const float* ctab = (const float*)(WS(p) + OFF_ROPE);
    const float* stab = ctab + TS * 16;
    const bf16_t* wb = (const bf16_t*)(WS(p) + OFF_WB);
    const bf16_t* wqiT = wb + WB_QI;
    const bf16_t* wuqT = wb + WB_UQ;
    const bf16_t* wuk = wb + WB_UK;
    const bf16_t* wuvT = wb + WB_UV;
    const float scale = 0.10206207261596575f;
    const f32x4 z4 = {0.f, 0.f, 0.f, 0.f};
    for (int tile = tb; tile < te; tile += tstep) {
        const int qt = 128 - (tile >> 3), b = tile & 7;
        const int t0 = qt * 16;
        const size_t n0 = (size_t)b * TS + t0;
        {
            bf16x8 acq[8];
#pragma unroll
            for (int kk = 0; kk < 8; ++kk) acq[kk] = *(const bf16x8*)(cqn + (n0 + fr) * 256 + kk * 32 + fq * 8);
            f32x4 c[4] = {z4, z4, z4, z4};
#pragma unroll
            for (int kk = 0; kk < 8; ++kk)
#pragma unroll
                for (int nt = 0; nt < 4; ++nt)
                    c[nt] = __builtin_amdgcn_mfma_f32_16x16x32_bf16(acq[kk], *(const bf16x8*)(wqiT + (size_t)(wid * 64 + nt * 16 + fr) * 256 + kk * 32 + fq * 8), c[nt], 0, 0, 0);
#pragma unroll
            for (int j = 0; j < 4; ++j) {
                const int t = t0 + fq * 4 + j;
                const float cs = ctab[t * 16 + fr], sn = stab[t * 16 + fr];
                const float x1 = c[0][j], x2 = c[1][j];
                c[0][j] = x1 * cs - x2 * sn; c[1][j] = x2 * cs + x1 * sn;
            }
#pragma unroll
            for (int nt = 0; nt < 4; ++nt)
#pragma unroll
                for (int j = 0; j < 4; ++j) s_qi[(fq * 4 + j) * 512 + wid * 64 + nt * 16 + fr] = f2bf(c[nt][j]);
        }
        __syncthreads();
        if (!IMPORT_SEL) {
            bf16x8 aq[8][2];
#pragma unroll
            for (int h = 0; h < 8; ++h)
#pragma unroll
                for (int ks = 0; ks < 2; ++ks) aq[h][ks] = *(const bf16x8*)(s_qi + fr * 512 + h * 64 + ks * 32 + fq * 8);
            float wh[4][8];
#pragma unroll
            for (int j = 0; j < 4; ++j) {
                const float4 w0 = *(const float4*)(whead + (n0 + fq * 4 + j) * 8), w1 = *(const float4*)(whead + (n0 + fq * 4 + j) * 8 + 4);
                wh[j][0] = w0.x; wh[j][1] = w0.y; wh[j][2] = w0.z; wh[j][3] = w0.w; wh[j][4] = w1.x; wh[j][5] = w1.y; wh[j][6] = w1.z; wh[j][7] = w1.w;
            }
            const int nkt = qt + 1;
#pragma unroll 1
            for (int kt = wid; kt < nkt; kt += 8) {
                const bf16_t* krow = kidx + ((size_t)b * TS + kt * 16 + fr) * 64 + fq * 8;
                const bf16x8 bk0 = *(const bf16x8*)krow, bk1 = *(const bf16x8*)(krow + 32);
                float I[4] = {0.f, 0.f, 0.f, 0.f};
#pragma unroll
                for (int h = 0; h < 8; ++h) {
                    f32x4 a = __builtin_amdgcn_mfma_f32_16x16x32_bf16(aq[h][0], bk0, z4, 0, 0, 0);
                    a = __builtin_amdgcn_mfma_f32_16x16x32_bf16(aq[h][1], bk1, a, 0, 0, 0);
#pragma unroll
                    for (int j = 0; j < 4; ++j) I[j] += wh[j][h] * fmaxf(a[j], 0.f);
                }
#pragma unroll
                for (int j = 0; j < 4; ++j) s_sc[(fq * 4 + j) * 2064 + kt * 16 + fr] = (unsigned short)f2h_bits(I[j]);
            }
        }
        __syncthreads();
#pragma unroll 1
        for (int qi2 = 0; qi2 < 2; ++qi2) {
            const int q = wid + qi2 * 8;
            const int nadm = t0 + q + 1;
            unsigned short* sel = s_sel + q * 256;
            if (IMPORT_SEL) {
                const int ns = gnsel[n0 + q];
                for (int i = lane; i < ns; i += 64) sel[i] = gsel[(n0 + q) * 256 + i];
                if (lane == 0) s_nsel[q] = ns;
            } else if (nadm <= 256) {
                for (int i = lane; i < nadm; i += 64) sel[i] = (unsigned short)i;
                if (lane == 0) s_nsel[q] = nadm;
            } else {
                unsigned key[33];
#pragma unroll
                for (int c = 0; c < 33; ++c) {
                    const int s = c * 64 + lane;
                    unsigned k = 0u;
                    if (s < nadm) { const unsigned u = s_sc[q * 2064 + s]; k = (u & 0x8000u) ? (~u & 0xFFFFu) : (u | 0x8000u); }
                    key[c] = k;
                }
                unsigned T = 0u;
#pragma unroll 1
                for (int bit = 15; bit >= 0; --bit) {
                    const unsigned cand = T | (1u << bit);
                    int cnt = 0;
#pragma unroll
                    for (int c = 0; c < 33; ++c) cnt += __popcll(__ballot(key[c] >= cand));
                    if (cnt >= 256) T = cand;
                }
                int ngt = 0;
#pragma unroll
                for (int c = 0; c < 33; ++c) ngt += __popcll(__ballot(key[c] > T));
                const int rties = 256 - ngt;
                int base = 0, ties = 0;
                const unsigned long long ltmask = (1ull << lane) - 1ull;
#pragma unroll
                for (int c = 0; c < 33; ++c) {
                    const bool gt = key[c] > T, eq = key[c] == T;
                    const unsigned long long em = __ballot(eq);
                    const int myrank = ties + __popcll(em & ltmask);
                    const bool take = gt || (eq && myrank < rties);
                    const unsigned long long tm = __ballot(take);
                    const int pos = base + __popcll(tm & ltmask);
                    if (take && pos < 256) sel[pos] = (unsigned short)(c * 64 + lane);
                    base += __popcll(tm); ties += __popcll(em);
                }
                if (lane == 0) s_nsel[q] = 256;
            }
        }
        __syncthreads();
#pragma unroll 1
        for (int hi = 0; hi < 2; ++hi) {
            const int hh = wid * 2 + hi;
            bf16x8 acq[8];
#pragma unroll
            for (int kk = 0; kk < 8; ++kk) acq[kk] = *(const bf16x8*)(cqn + (n0 + fr) * 256 + kk * 32 + fq * 8);
            f32x4 c6[6] = {z4, z4, z4, z4, z4, z4};
#pragma unroll
            for (int kk = 0; kk < 8; ++kk)
#pragma unroll
                for (int nt = 0; nt < 6; ++nt)
                    c6[nt] = __builtin_amdgcn_mfma_f32_16x16x32_bf16(acq[kk], *(const bf16x8*)(wuqT + (size_t)(hh * 96 + nt * 16 + fr) * 256 + kk * 32 + fq * 8), c6[nt], 0, 0, 0);
#pragma unroll
            for (int j = 0; j < 4; ++j) {
                const int q = fq * 4 + j, t = t0 + q;
                const float cs = ctab[t * 16 + fr], sn = stab[t * 16 + fr];
                const float x1 = c6[4][j], x2 = c6[5][j];
                s_Q[(q * 16 + hh) * 160 + 128 + fr] = f2bf(x1 * cs - x2 * sn);
                s_Q[(q * 16 + hh) * 160 + 144 + fr] = f2bf(x2 * cs + x1 * sn);
#pragma unroll
                for (int nt = 0; nt < 4; ++nt) s_qn[q * 64 + nt * 16 + fr] = f2bf(c6[nt][j]);
            }
            __syncthreads();
            bf16x8 an[2];
#pragma unroll
            for (int ks = 0; ks < 2; ++ks) an[ks] = *(const bf16x8*)(s_qn + fr * 64 + ks * 32 + fq * 8);
#pragma unroll
            for (int nt = 0; nt < 8; ++nt) {
                f32x4 a = z4;
#pragma unroll
                for (int ks = 0; ks < 2; ++ks)
                    a = __builtin_amdgcn_mfma_f32_16x16x32_bf16(an[ks], *(const bf16x8*)(wuk + (size_t)(hh * 128 + nt * 16 + fr) * 64 + ks * 32 + fq * 8), a, 0, 0, 0);
#pragma unroll
                for (int j = 0; j < 4; ++j) s_Q[((fq * 4 + j) * 16 + hh) * 160 + nt * 16 + fr] = f2bf(a[j]);
            }
            __syncthreads();
        }
#pragma unroll 1
        for (int qi2 = 0; qi2 < 2; ++qi2) {
            const int q = wid + qi2 * 8;
            bf16x8 bq[5];
#pragma unroll
            for (int ks = 0; ks < 5; ++ks) bq[ks] = *(const bf16x8*)(s_Q + (q * 16 + fr) * 160 + ks * 32 + fq * 8);
            const int nsel = s_nsel[q];
            const unsigned short* sel = s_sel + q * 256;
            float m = -INFINITY, lsum = 0.f;
            f32x4 O[8] = {z4, z4, z4, z4, z4, z4, z4, z4};
            const int nchunk = (nsel + 31) >> 5;
#pragma unroll 1
            for (int ch = 0; ch < nchunk; ++ch) {
                bf16x8 ak[2][5];
#pragma unroll
                for (int mt = 0; mt < 2; ++mt) {
                    const int ki = ch * 32 + mt * 16 + fr;
                    const int sidx = sel[ki < nsel ? ki : 0];
                    const bf16_t* krow = kv + ((size_t)b * TS + sidx) * 160 + fq * 8;
#pragma unroll
                    for (int ks = 0; ks < 5; ++ks) ak[mt][ks] = *(const bf16x8*)(krow + ks * 32);
                }
#pragma unroll
                for (int mt = 0; mt < 2; ++mt)
#pragma unroll
                    for (int ks = 0; ks < 4; ++ks) {
                        const int r = mt * 16 + fr;
                        *(bf16x8*)(s_Vw + r * 256 + (((ks * 2 + (fq >> 1)) ^ (r & 7)) * 32) + (fq & 1) * 16) = ak[mt][ks];
                    }
                f32x4 st[2] = {z4, z4};
#pragma unroll
                for (int mt = 0; mt < 2; ++mt)
#pragma unroll
                    for (int ks = 0; ks < 5; ++ks) st[mt] = __builtin_amdgcn_mfma_f32_16x16x32_bf16(ak[mt][ks], bq[ks], st[mt], 0, 0, 0);
                float sv[2][4]; float cmax = -INFINITY;
#pragma unroll
                for (int mt = 0; mt < 2; ++mt)
#pragma unroll
                    for (int j = 0; j < 4; ++j) {
                        const int ke = ch * 32 + mt * 16 + fq * 4 + j;
                        const float s_ = (ke < nsel) ? st[mt][j] * scale : -INFINITY;
                        sv[mt][j] = s_; cmax = fmaxf(cmax, s_);
                    }
                cmax = fmaxf(cmax, __shfl_xor(cmax, 16)); cmax = fmaxf(cmax, __shfl_xor(cmax, 32));
                const float mnew = fmaxf(m, cmax);
                const float alpha = __expf(m - mnew);
                float psum = 0.f;
#pragma unroll
                for (int mt = 0; mt < 2; ++mt)
#pragma unroll
                    for (int j = 0; j < 4; ++j) { const float pe = __expf(sv[mt][j] - mnew); sv[mt][j] = pe; psum += pe; }
                psum += __shfl_xor(psum, 16); psum += __shfl_xor(psum, 32);
                lsum = lsum * alpha + psum; m = mnew;
#pragma unroll
                for (int ct = 0; ct < 8; ++ct) O[ct] = O[ct] * alpha;
                bf16x8 pf;
#pragma unroll
                for (int mt = 0; mt < 2; ++mt)
#pragma unroll
                    for (int j = 0; j < 4; ++j) pf[mt * 4 + j] = (short)f2bf(sv[mt][j]);
                const int q_ = fr >> 2, p_ = fr & 3;
                const int r0 = fq * 4 + q_, r1 = 16 + r0;
#pragma unroll
                for (int ct = 0; ct < 8; ++ct) {
                    const s16x4 v0 = __builtin_amdgcn_ds_read_tr16_b64_v4i16((__attribute__((address_space(3))) s16x4*)(s_Vw + r0 * 256 + ((ct ^ (r0 & 7)) * 32) + p_ * 8));
                    const s16x4 v1 = __builtin_amdgcn_ds_read_tr16_b64_v4i16((__attribute__((address_space(3))) s16x4*)(s_Vw + r1 * 256 + ((ct ^ (r1 & 7)) * 32) + p_ * 8));
                    bf16x8 av; av[0] = v0[0]; av[1] = v0[1]; av[2] = v0[2]; av[3] = v0[3]; av[4] = v1[0]; av[5] = v1[1]; av[6] = v1[2]; av[7] = v1[3];
                    O[ct] = __builtin_amdgcn_mfma_f32_16x16x32_bf16(av, pf, O[ct], 0, 0, 0);
                }
            }
            const float inv = 1.0f / lsum;
#pragma unroll
            for (int ct = 0; ct < 8; ++ct)
#pragma unroll
                for (int j = 0; j < 4; ++j) s_Q[(q * 16 + fr) * 160 + ct * 16 + fq * 4 + j] = f2bf(O[ct][j] * inv);
        }
        __syncthreads();
#pragma unroll 1
        for (int hi = 0; hi < 2; ++hi) {
            const int hh = wid * 2 + hi;
            bf16x8 ao[4];
#pragma unroll
            for (int ks = 0; ks < 4; ++ks) ao[ks] = *(const bf16x8*)(s_Q + (fr * 16 + hh) * 160 + ks * 32 + fq * 8);
#pragma unroll
            for (int nt = 0; nt < 4; ++nt) {
                f32x4 a = z4;
#pragma unroll
                for (int ks = 0; ks < 4; ++ks)
                    a = __builtin_amdgcn_mfma_f32_16x16x32_bf16(ao[ks], *(const bf16x8*)(wuvT + (size_t)(hh * 64 + nt * 16 + fr) * 128 + ks * 32 + fq * 8), a, 0, 0, 0);
#pragma unroll
                for (int j = 0; j < 4; ++j) yc[(n0 + fq * 4 + j) * 1024 + hh * 64 + nt * 16 + fr] = f2bf(a[j]);
            }
        }
        __syncthreads();
    }
}


template <int CTRL> __device__ __forceinline__ float dpp_f(float x) {
    return __int_as_float(__builtin_amdgcn_update_dpp(0, __float_as_int(x), CTRL, 0xF, 0xF, true));
}
__device__ __forceinline__ float row16_sum(float v) {
    v += dpp_f<0xB1>(v);
    v += dpp_f<0x4E>(v);
    v += dpp_f<0x141>(v);
    v += dpp_f<0x140>(v);
    return v;
}
constexpr int SC_TC = 32;
constexpr int SC_ROWB = 1088;
__device__ __forceinline__ const unsigned char* scan_piece_src(const Params& p, int l, int b, int hc, int t0, int pi, bool& ok) {
    const int tau = pi / 68, seg = pi - tau * 68;
    const int t = t0 + tau;
    ok = (t < TS) && (tau < SC_TC);
    const size_t n = (size_t)b * TS + t;
    const unsigned char* ws = WS(p);
    if (seg < 8) return ws + OFF_PR + (n * 1024 + hc) * 2 + seg * 16;
    if (seg < 16) return ws + OFF_PK + (n * 1024 + hc) * 2 + (seg - 8) * 16;
    if (seg < 24) return ws + OFF_PV + (n * 1024 + hc) * 2 + (seg - 16) * 16;
    if (seg < 60) return ws + OFF_PMISC + (n * PM_LD) * 2 + (seg - 24) * 16;
    ok = ok && (l > 0);
    return ws + OFF_VFIRST + (n * 1024 + hc) * 2 + (seg - 60) * 16;
}
__device__ void phase_scan2(const Params& p, int l, unsigned char* lds, int blk) {
    const int tid = otid(), lane = tid & 63, wid = tid >> 6, fr = lane & 15, fq = lane >> 4;
    const int b = blk >> 4, hh = blk & 15, hc = hh * 64;
    float* s_r = (float*)lds;
    float* s_w = s_r + 2048;
    float* s_k = s_w + 2048;
    float* s_v = s_k + 2048;
    float* s_a = s_v + 2048;
    float* s_b = s_a + 2048;
    float* s_g = s_b + 2048;
    float* s_o = s_g + 2048;
    bf16_t* A_wd = (bf16_t*)(s_o + 2048);
    bf16_t* A_ad = A_wd + 2048;
    bf16_t* A_gd = A_ad + 2048;
    bf16_t* A_vd = A_gd + 4096;
    unsigned char* raw = (unsigned char*)(A_vd + 1024);
    float* prevb = (float*)(raw + 32 * SC_ROWB);
    float* cst = prevb + 960;
    const float* mu = p.in[4] + (size_t)l * 3328;
    for (int e = tid; e < 480; e += NTHR) {
        float v;
        if (e < 192) v = mu[(e >> 6) * 1024 + hc + (e & 63)];
        else if (e < 448) v = mu[3072 + (e - 192)];
        else v = p.in[18][e - 448];
        cst[e] = v;
    }
    if (tid < 64) {
        cst[480 + tid] = p.in[7][l * 1024 + hc + tid];
        cst[544 + tid] = p.in[9][l * 1024 + hc + tid];
        cst[608 + tid] = p.in[12][l * 1024 + hc + tid];
        cst[672 + tid] = p.in[13][l * 1024 + hc + tid];
        cst[736 + tid] = p.in[14][l * 1024 + hc + tid];
        cst[800 + tid] = p.in[15][l * 1024 + hc + tid];
        cst[864 + tid] = p.in[16][l * 1024 + hc + tid];
        cst[928 + tid] = p.in[19][hc + tid];
    }
    const int mm = wid >> 1, ntb = (wid & 1) * 2;
    const int nks = (mm == 2) ? 4 : (mm == 3 ? 1 : 2);
    bf16x8 Bw[2][4];
    {
        const float* wsrc = (mm == 0) ? p.in[8] + (size_t)l * 64 * 1024 : (mm == 1) ? p.in[10] + (size_t)l * 64 * 1024 : (mm == 2) ? p.in[11] + (size_t)l * 128 * 1024 : p.in[20];
#pragma unroll
        for (int n2 = 0; n2 < 2; ++n2)
#pragma unroll
            for (int ks = 0; ks < 4; ++ks) {
                bf16x8 f;
#pragma unroll
                for (int j = 0; j < 8; ++j) {
                    float v = 0.f;
                    if (ks < nks && (mm < 3 || l > 0)) v = wsrc[(size_t)(ks * 32 + fq * 8 + j) * 1024 + hc + (ntb + n2) * 16 + fr];
                    f[j] = (short)f2bf(v);
                }
                Bw[n2][ks] = f;
            }
    }
    const int cg = lane & 15, rg = lane >> 4;
    float S0[4] = {0.f, 0.f, 0.f, 0.f}, S1[4] = {0.f, 0.f, 0.f, 0.f};
    bf16_t* Pr = (bf16_t*)(WS(p) + OFF_PR);
    bf16_t* vfirst = (bf16_t*)(WS(p) + OFF_VFIRST);
    uint4 pre[5];
#pragma unroll
    for (int k = 0; k < 5; ++k) {
        const int pi = tid + k * NTHR; bool ok = false; pre[k] = make_uint4(0, 0, 0, 0);
        if (pi < SC_TC * 68) { const unsigned char* src = scan_piece_src(p, l, b, hc, 0, pi, ok); if (ok) pre[k] = *(const uint4*)src; }
    }
    __syncthreads();
#pragma unroll 1
    for (int t0 = 0, ch = 0; t0 < TS; t0 += SC_TC, ++ch) {
        const int nval = (TS - t0 < SC_TC) ? (TS - t0) : SC_TC;
#pragma unroll
        for (int k = 0; k < 5; ++k) { const int pi = tid + k * NTHR; if (pi < SC_TC * 68) *(uint4*)(raw + pi * 16) = pre[k]; }
        __syncthreads();
#pragma unroll
        for (int k = 0; k < 5; ++k) {
            const int pi = tid + k * NTHR; bool ok = false; pre[k] = make_uint4(0, 0, 0, 0);
            if (pi < SC_TC * 68 && t0 + SC_TC < TS) { const unsigned char* src = scan_piece_src(p, l, b, hc, t0 + SC_TC, pi, ok); if (ok) pre[k] = *(const uint4*)src; }
        }
        const float* pvb = prevb + ((ch + 1) & 1) * 480;
        float* pwb = prevb + (ch & 1) * 480;
        for (int e = tid; e < SC_TC * 480; e += NTHR) {
            const int tau = e / 480, c = e - tau * 480;
            const float cur = bf2f(*(const bf16_t*)(raw + tau * SC_ROWB + c * 2));
            float prv;
            if (tau > 0) prv = bf2f(*(const bf16_t*)(raw + (tau - 1) * SC_ROWB + c * 2));
            else prv = (t0 > 0) ? pvb[c] : 0.f;
            if (tau == SC_TC - 1) pwb[c] = cur;
            const float xs = cur + (prv - cur) * cst[c];
            if (c < 64) s_r[tau * 64 + c] = xs;
            else if (c < 128) s_k[tau * 64 + c - 64] = xs;
            else if (c < 192) s_v[tau * 64 + c - 128] = xs;
            else if (c < 256) A_wd[tau * 64 + c - 192] = f2bf(tanhf(xs));
            else if (c < 320) A_ad[tau * 64 + c - 256] = f2bf(xs);
            else if (c < 448) A_gd[tau * 128 + c - 320] = f2bf(sigmoidf_(xs));
            else A_vd[tau * 32 + c - 448] = f2bf(xs);
        }
        __syncthreads();
        if (mm < 3 || l > 0) {
            const bf16_t* Ab = (mm == 0) ? A_wd : (mm == 1) ? A_ad : (mm == 2) ? A_gd : A_vd;
            const int lda = (mm == 2) ? 128 : (mm == 3 ? 32 : 64);
            float* dst = (mm == 0) ? s_w : (mm == 1) ? s_a : (mm == 2) ? s_g : s_o;
#pragma unroll
            for (int m = 0; m < 2; ++m) {
                f32x4 acc0 = {0.f, 0.f, 0.f, 0.f}, acc1 = {0.f, 0.f, 0.f, 0.f};
#pragma unroll
                for (int ks = 0; ks < 4; ++ks) {
                    if (ks < nks) {
                        const bf16x8 a = *(const bf16x8*)(Ab + (m * 16 + fr) * lda + ks * 32 + fq * 8);
                        acc0 = __builtin_amdgcn_mfma_f32_16x16x32_bf16(a, Bw[0][ks], acc0, 0, 0, 0);
                        acc1 = __builtin_amdgcn_mfma_f32_16x16x32_bf16(a, Bw[1][ks], acc1, 0, 0, 0);
                    }
                }
#pragma unroll
                for (int j = 0; j < 4; ++j) {
                    dst[(m * 16 + fq * 4 + j) * 64 + ntb * 16 + fr] = acc0[j];
                    dst[(m * 16 + fq * 4 + j) * 64 + (ntb + 1) * 16 + fr] = acc1[j];
                }
            }
        }
        __syncthreads();
        for (int e = tid; e < SC_TC * 64; e += NTHR) {
            const int tau = e >> 6, c = e & 63, t = t0 + tau;
            const size_t n = (size_t)b * TS + t;
            const float xw = s_w[e] + cst[480 + c];
            const float wlog = -softplusf_(-xw) - 0.5f;
            const float decay = __expf(-__expf(wlog));
            const float a = sigmoidf_(s_a[e] + cst[544 + c]);
            float vv = s_v[e];
            if (l > 0) {
                const float vf = bf2f(*(const bf16_t*)(raw + tau * SC_ROWB + 960 + c * 2));
                vv = vv + (vf - vv) * sigmoidf_(s_o[e] + cst[928 + c]);
            } else if (t < TS) {
                vfirst[n * 1024 + hc + c] = f2bf(vv);
            }
            const float kraw = s_k[e];
            const float kkv = kraw * cst[608 + c];
            const float nrm = sqrtf(wave_sum(kkv * kkv));
            const float kk = kkv / fmaxf(nrm, 1e-12f);
            s_w[e] = decay;
            s_a[e] = -kk;
            s_b[e] = kk * a;
            s_k[e] = kraw * (1.0f + (a - 1.0f) * cst[672 + c]);
            s_v[e] = vv;
        }
        __syncthreads();
#pragma unroll 2
        for (int tau = 0; tau < nval; ++tau) {
            const float4 a4 = *(const float4*)(s_a + tau * 64 + cg * 4);
            const float4 w4 = *(const float4*)(s_w + tau * 64 + cg * 4);
            const float4 b4 = *(const float4*)(s_b + tau * 64 + cg * 4);
            const float4 k4 = *(const float4*)(s_k + tau * 64 + cg * 4);
            const float4 r4 = *(const float4*)(s_r + tau * 64 + cg * 4);
            const float2 v2 = *(const float2*)(s_v + tau * 64 + wid * 8 + rg * 2);
            float sa0 = S0[0] * a4.x + S0[1] * a4.y + S0[2] * a4.z + S0[3] * a4.w;
            float sa1 = S1[0] * a4.x + S1[1] * a4.y + S1[2] * a4.z + S1[3] * a4.w;
            sa0 = row16_sum(sa0); sa1 = row16_sum(sa1);
            S0[0] = S0[0] * w4.x + sa0 * b4.x + v2.x * k4.x; S0[1] = S0[1] * w4.y + sa0 * b4.y + v2.x * k4.y;
            S0[2] = S0[2] * w4.z + sa0 * b4.z + v2.x * k4.z; S0[3] = S0[3] * w4.w + sa0 * b4.w + v2.x * k4.w;
            S1[0] = S1[0] * w4.x + sa1 * b4.x + v2.y * k4.x; S1[1] = S1[1] * w4.y + sa1 * b4.y + v2.y * k4.y;
            S1[2] = S1[2] * w4.z + sa1 * b4.z + v2.y * k4.z; S1[3] = S1[3] * w4.w + sa1 * b4.w + v2.y * k4.w;
            float o0 = S0[0] * r4.x + S0[1] * r4.y + S0[2] * r4.z + S0[3] * r4.w;
            float o1 = S1[0] * r4.x + S1[1] * r4.y + S1[2] * r4.z + S1[3] * r4.w;
            o0 = row16_sum(o0); o1 = row16_sum(o1);
            if (cg == 0) *(float2*)(s_o + tau * 64 + wid * 8 + rg * 2) = make_float2(o0, o1);
        }
        __syncthreads();
        for (int tau = wid; tau < nval; tau += 8) {
            const int c = lane, e = tau * 64 + c;
            const size_t n = (size_t)b * TS + t0 + tau;
            const float o = s_o[e];
            const float m_ = wave_sum(o) * (1.0f / 64.0f);
            const float d = o - m_;
            const float var = wave_sum(d * d) * (1.0f / 64.0f);
            const float on = d * rsqrtf(var + 64e-5f) * cst[800 + c] + cst[864 + c];
            const float bonus = wave_sum(s_r[e] * s_k[e] * cst[736 + c]) * s_v[e];
            Pr[n * 1024 + hc + c] = f2bf((on + bonus) * s_g[e]);
        }
        __syncthreads();
    }
}

__device__ void phase_merge(const Params& p, unsigned char* lds) {
    const int tid = otid(), lane = tid & 63, wid = tid >> 6, wr = wid >> 1, wc = wid & 1, fr = lane & 15, fq = lane >> 4;
    const bf16_t* h = (const bf16_t*)(WS(p) + OFF_H);
    const bf16_t* wb = (const bf16_t*)(WS(p) + OFF_WB);
    const float* rstd = (const float*)(WS(p) + OFF_RSTD);
    bf16_t* merged = (bf16_t*)(WS(p) + OFF_MERGED);
    const bf16_t* ysrc0 = (const bf16_t*)(WS(p) + OFF_PPOOL);
    const bf16_t* ysrc1 = (const bf16_t*)(WS(p) + OFF_PR);
    const bf16_t* ysrc2 = (const bf16_t*)(OUTB(p) + DO_YC);
    for (int tile = obid(); tile < 129 * 8; tile += gridDim.x) {
        const int mt = tile >> 3, nt = tile & 7;
        const int row0 = mt * 128, col0 = nt * 128;
        f32x4 macc[2][4]; zero_acc(macc);
#pragma unroll 1
        for (int i = 0; i < 3; ++i) {
            f32x4 ag[2][4], ay[2][4]; zero_acc(ag); zero_acc(ay);
            gemm_kloop(ag, h + (size_t)(row0 + (tid >> 2)) * DM + (tid & 3) * 8, wb + WB_WG + (size_t)(i * 1024 + col0 + (tid >> 2)) * DM + (tid & 3) * 8, DM, lds);
            const bf16_t* ys = (i == 0) ? ysrc0 : (i == 1 ? ysrc1 : ysrc2);
            gemm_kloop(ay, ys + (size_t)(row0 + (tid >> 2)) * DM + (tid & 3) * 8, wb + WB_PA + (size_t)(i * 1024 + col0 + (tid >> 2)) * DM + (tid & 3) * 8, DM, lds);
#pragma unroll
            for (int m = 0; m < 2; ++m)
#pragma unroll
                for (int j = 0; j < 4; ++j) {
                    const float rs = rstd[row0 + wr * 32 + m * 16 + fq * 4 + j];
#pragma unroll
                    for (int n = 0; n < 4; ++n) macc[m][n][j] += sigmoidf_(ag[m][n][j] * rs) * ay[m][n][j];
                }
        }
#pragma unroll
        for (int m = 0; m < 2; ++m)
#pragma unroll
            for (int j = 0; j < 4; ++j) {
                const int row = row0 + wr * 32 + m * 16 + fq * 4 + j;
#pragma unroll
                for (int n = 0; n < 4; ++n) merged[(size_t)row * 1024 + col0 + wc * 64 + n * 16 + fr] = f2bf(macc[m][n][j]);
            }
    }
}

__device__ void phase_outproj(const Params& p, unsigned char* lds) {
    const int tid = otid(), lane = tid & 63, wid = tid >> 6, wr = wid >> 1, wc = wid & 1, fr = lane & 15, fq = lane >> 4;
    const bf16_t* h = (const bf16_t*)(WS(p) + OFF_H);
    const bf16_t* wb = (const bf16_t*)(WS(p) + OFF_WB);
    const bf16_t* merged = (const bf16_t*)(WS(p) + OFF_MERGED);
    float* hm = (float*)(WS(p) + OFF_HM32);
    for (int tile = obid(); tile < 129 * 8; tile += gridDim.x) {
        const int mt = tile >> 3, nt = tile & 7;
        const int row0 = mt * 128, col0 = nt * 128;
        f32x4 acc[2][4]; zero_acc(acc);
        gemm_kloop(acc, merged + (size_t)(row0 + (tid >> 2)) * DM + (tid & 3) * 8, wb + WB_WO + (size_t)(col0 + (tid >> 2)) * DM + (tid & 3) * 8, DM, lds);
#pragma unroll
        for (int m = 0; m < 2; ++m)
#pragma unroll
            for (int j = 0; j < 4; ++j) {
                const int row = row0 + wr * 32 + m * 16 + fq * 4 + j;
#pragma unroll
                for (int n = 0; n < 4; ++n) {
                    const int col = col0 + wc * 64 + n * 16 + fr;
                    hm[(size_t)row * 1024 + col] = bf2f(h[(size_t)row * 1024 + col]) + acc[m][n][j];
                }
            }
    }
}

__device__ __constant__ int c_pair_lo[6] = {0, 0, 0, 1, 1, 2};
__device__ __constant__ int c_pair_hi[6] = {1, 2, 3, 2, 3, 3};
__device__ void phase_route(const Params& p, int l) {
    const int lane = otid() & 63;
    const int wave = (obid() * NTHR + otid()) >> 6, nw = gridDim.x * NTHR / 64;
    const float* hm = (const float*)(WS(p) + OFF_HM32);
    bf16_t* hn = (bf16_t*)(WS(p) + OFF_HN);
    const float* nf = p.in[33] + (size_t)l * 1024;
    const float* wg = p.in[34] + (size_t)l * 1024 * 4;
    const float* bg = p.in[35] + l * 4;
    const float* we = p.in[36] + (size_t)l * 1024 * 16;
    const float* be = p.in[37] + l * 16;
    int* cnt = (int*)(WS(p) + OFF_CTL);
    int* list = (int*)(WS(p) + OFF_LIST);
    float* pw = (float*)(WS(p) + OFF_PW);
    for (int n = wave; n < NT; n += nw) {
        float ss = 0.f;
#pragma unroll
        for (int i = 0; i < 4; ++i) {
            const float4 v = *(const float4*)(hm + (size_t)n * DM + i * 256 + lane * 4);
            ss += v.x * v.x + v.y * v.y + v.z * v.z + v.w * v.w;
        }
        ss = wave_sum(ss);
        const float rs = rsqrtf(ss * (1.0f / 1024.0f) + 1e-6f);
        float lg[4] = {0.f, 0.f, 0.f, 0.f};
        float le[16];
#pragma unroll
        for (int e = 0; e < 16; ++e) le[e] = 0.f;
#pragma unroll 1
        for (int i = 0; i < 4; ++i) {
            const float4 xv = *(const float4*)(hm + (size_t)n * DM + i * 256 + lane * 4);
            const float4 nv = *(const float4*)(nf + i * 256 + lane * 4);
            float y[4] = {xv.x * rs * nv.x, xv.y * rs * nv.y, xv.z * rs * nv.z, xv.w * rs * nv.w};
#pragma unroll
            for (int k = 0; k < 4; ++k) {
                const int d = i * 256 + lane * 4 + k;
                const float4 g4 = *(const float4*)(wg + (size_t)d * 4);
                lg[0] += y[k] * g4.x; lg[1] += y[k] * g4.y; lg[2] += y[k] * g4.z; lg[3] += y[k] * g4.w;
#pragma unroll
                for (int e4 = 0; e4 < 4; ++e4) {
                    const float4 w4 = *(const float4*)(we + (size_t)d * 16 + e4 * 4);
                    le[e4 * 4 + 0] += y[k] * w4.x; le[e4 * 4 + 1] += y[k] * w4.y; le[e4 * 4 + 2] += y[k] * w4.z; le[e4 * 4 + 3] += y[k] * w4.w;
                }
            }
            ushort4 o;
            o.x = f2bf(y[0]); o.y = f2bf(y[1]); o.z = f2bf(y[2]); o.w = f2bf(y[3]);
            *(ushort4*)(hn + (size_t)n * DM + i * 256 + lane * 4) = o;
        }
#pragma unroll
        for (int g = 0; g < 4; ++g) lg[g] = wave_sum(lg[g]) + bg[g];
#pragma unroll
        for (int e = 0; e < 16; ++e) le[e] = wave_sum(le[e]) + be[e];
        if (lane == 0) {
            int gs = 0; float gm = lg[0];
#pragma unroll
            for (int g = 1; g < 4; ++g) if (lg[g] > gm) { gm = lg[g]; gs = g; }
            float den = 0.f;
#pragma unroll
            for (int g = 0; g < 4; ++g) den += __expf(lg[g] - gm);
            const float pgrp = 1.0f / den;
            float v4[4];
#pragma unroll
            for (int e = 0; e < 4; ++e) {
                const float m0 = (gs == 0) ? 1.f : 0.f, m1s = (gs == 1) ? 1.f : 0.f, m2s = (gs == 2) ? 1.f : 0.f, m3s = (gs == 3) ? 1.f : 0.f;
                v4[e] = le[e] * m0 + le[4 + e] * m1s + le[8 + e] * m2s + le[12 + e] * m3s;
            }
            int i1 = 0; float m1 = v4[0];
#pragma unroll
            for (int e = 1; e < 4; ++e) if (v4[e] > m1) { m1 = v4[e]; i1 = e; }
            int i2 = -1; float m2 = -INFINITY;
#pragma unroll
            for (int e = 0; e < 4; ++e) if (e != i1 && v4[e] > m2) { m2 = v4[e]; i2 = e; }
            const float e2 = __expf(m2 - m1);
            const float p1 = pgrp / (1.0f + e2), p2 = pgrp * e2 / (1.0f + e2);
            const int lo = i1 < i2 ? i1 : i2, hi = i1 < i2 ? i2 : i1;
            const float plo = i1 < i2 ? p1 : p2, phi = i1 < i2 ? p2 : p1;
            const int pi = (lo == 0) ? (hi - 1) : (lo == 1 ? hi + 1 : 5);
            const int cls = gs * 6 + pi;
            const int pos = atomicAdd(&cnt[cls], 1);
            list[(size_t)cls * NT + pos] = n;
            pw[(size_t)n * 2 + 0] = plo; pw[(size_t)n * 2 + 1] = phi;
        }
    }
}

struct MoeTile { int cls, ti, cnt, tg; };
__device__ __forceinline__ int moe_total_tiles(const int* cnt) { int s = 0; for (int c = 0; c < 24; ++c) s += (cnt[c] + 127) >> 7; return s; }
__device__ __forceinline__ MoeTile moe_find(const int* cnt, int tile) {
    MoeTile r; int s = 0; r.cls = 0; r.ti = 0; r.cnt = 0; r.tg = tile;
    for (int c = 0; c < 24; ++c) { const int nt = (cnt[c] + 127) >> 7; if (tile >= s && tile < s + nt) { r.cls = c; r.ti = tile - s; r.cnt = cnt[c]; } s += nt; }
    return r;
}
__device__ void phase_moe1(const Params& p, unsigned char* lds) {
    const int tid = otid(), lane = tid & 63, wid = tid >> 6, wr = wid >> 1, wc = wid & 1, fr = lane & 15, fq = lane >> 4;
    const int* cnt = (const int*)(WS(p) + OFF_CTL);
    const int* list = (const int*)(WS(p) + OFF_LIST);
    const float* pw = (const float*)(WS(p) + OFF_PW);
    const bf16_t* hn = (const bf16_t*)(WS(p) + OFF_HN);
    const bf16_t* we = (const bf16_t*)(WS(p) + OFF_WEXP);
    bf16_t* hid = (bf16_t*)(OUTB(p) + DO_HID);
    const int total = moe_total_tiles(cnt);
    for (int item = obid(); item < total * 4; item += gridDim.x) {
        const MoeTile mt = moe_find(cnt, item >> 2);
        const int nt = item & 3, slot = nt >> 1, f0 = (nt & 1) * 128;
        const int g = mt.cls / 6, pi = mt.cls % 6;
        const int e = g * 4 + (slot == 0 ? c_pair_lo[pi] : c_pair_hi[pi]);
        const int* lst = list + (size_t)mt.cls * NT + mt.ti * 128;
        const int nvalid = min(128, mt.cnt - mt.ti * 128);
        const int ar = tid >> 2;
        const int tok = lst[ar < nvalid ? ar : 0];
        f32x4 a1[2][4], a3[2][4]; zero_acc(a1); zero_acc(a3);
        const bf16_t* arow = hn + (size_t)tok * DM + (tid & 3) * 8;
        gemm_kloop(a1, arow, we + WE_W1 + ((size_t)e * 256 + f0 + (tid >> 2)) * 1024 + (tid & 3) * 8, DM, lds);
        gemm_kloop(a3, arow, we + WE_W3 + ((size_t)e * 256 + f0 + (tid >> 2)) * 1024 + (tid & 3) * 8, DM, lds);
#pragma unroll
        for (int m = 0; m < 2; ++m)
#pragma unroll
            for (int j = 0; j < 4; ++j) {
                const int lr = wr * 32 + m * 16 + fq * 4 + j;
                const int tk = lst[lr < nvalid ? lr : 0];
                const float pe = pw[(size_t)tk * 2 + slot];
#pragma unroll
                for (int n = 0; n < 4; ++n) {
                    const int col = slot * 256 + f0 + wc * 64 + n * 16 + fr;
                    const float x1 = a1[m][n][j];
                    hid[((size_t)mt.tg * 128 + lr) * 512 + col] = f2bf(x1 * sigmoidf_(x1) * a3[m][n][j] * pe);
                }
            }
    }
}
__device__ void phase_moe2(const Params& p, unsigned char* lds) {
    const int tid = otid(), lane = tid & 63, wid = tid >> 6, wr = wid >> 1, wc = wid & 1, fr = lane & 15, fq = lane >> 4;
    const int* cnt = (const int*)(WS(p) + OFF_CTL);
    const int* list = (const int*)(WS(p) + OFF_LIST);
    const bf16_t* we = (const bf16_t*)(WS(p) + OFF_WEXP);
    const bf16_t* hid = (const bf16_t*)(OUTB(p) + DO_HID);
    float* hm = (float*)(WS(p) + OFF_HM32);
    bf16_t* h = (bf16_t*)(WS(p) + OFF_H);
    const int total = moe_total_tiles(cnt);
    for (int item = obid(); item < total * 8; item += gridDim.x) {
        const MoeTile mt = moe_find(cnt, item >> 3);
        const int nt = item & 7, col0 = nt * 128;
        const int g = mt.cls / 6, pi = mt.cls % 6;
        const int elo = g * 4 + c_pair_lo[pi], ehi = g * 4 + c_pair_hi[pi];
        const int* lst = list + (size_t)mt.cls * NT + mt.ti * 128;
        const int nvalid = min(128, mt.cnt - mt.ti * 128);
        f32x4 acc[2][4]; zero_acc(acc);
        const bf16_t* arow = hid + ((size_t)mt.tg * 128 + (tid >> 2)) * 512 + (tid & 3) * 8;
        gemm_kloop(acc, arow, we + WE_W2 + ((size_t)elo * 1024 + col0 + (tid >> 2)) * 256 + (tid & 3) * 8, 256, lds);
        gemm_kloop(acc, arow + 256, we + WE_W2 + ((size_t)ehi * 1024 + col0 + (tid >> 2)) * 256 + (tid & 3) * 8, 256, lds);
#pragma unroll
        for (int m = 0; m < 2; ++m)
#pragma unroll
            for (int j = 0; j < 4; ++j) {
                const int lr = wr * 32 + m * 16 + fq * 4 + j;
                if (lr < nvalid) {
                    const int tk = lst[lr];
#pragma unroll
                    for (int n = 0; n < 4; ++n) {
                        const int col = col0 + wc * 64 + n * 16 + fr;
                        const float v = hm[(size_t)tk * 1024 + col] + acc[m][n][j];
                        hm[(size_t)tk * 1024 + col] = v;
                        h[(size_t)tk * 1024 + col] = f2bf(v);
                    }
                }
            }
    }
}

__device__ void phase_final(const Params& p) {
    const int lane = otid() & 63;
    const int wave = (obid() * NTHR + otid()) >> 6, nw = gridDim.x * NTHR / 64;
    const float* hm = (const float*)(WS(p) + OFF_HM32);
    const float* nf = p.in[41];
    for (int r = wave; r < NB * SEQ; r += nw) {
        const int b = r / SEQ, s = r % SEQ;
        const size_t n = (size_t)b * TS + NMETA + s;
        float4 v[4]; float ss = 0.f;
#pragma unroll
        for (int i = 0; i < 4; ++i) { v[i] = *(const float4*)(hm + n * DM + i * 256 + lane * 4); ss += v[i].x * v[i].x + v[i].y * v[i].y + v[i].z * v[i].z + v[i].w * v[i].w; }
        ss = wave_sum(ss);
        const float rs = rsqrtf(ss * (1.0f / 1024.0f) + 1e-6f);
#pragma unroll
        for (int i = 0; i < 4; ++i) {
            const float4 g = *(const float4*)(nf + i * 256 + lane * 4);
            float4 o; o.x = v[i].x * rs * g.x; o.y = v[i].y * rs * g.y; o.z = v[i].z * rs * g.z; o.w = v[i].w * rs * g.w;
            *(float4*)((float*)OUTB(p) + (size_t)r * DM + i * 256 + lane * 4) = o;
        }
    }
}

__global__ void __launch_bounds__(NTHR) fwd_megakernel(Params p) {
    extern __shared__ __attribute__((aligned(16))) unsigned char lds[];
    cg::grid_group grid = cg::this_grid();
#pragma unroll 1
    for (int step = 0; step < 18; ++step) {
        const int l = step >= 9 ? 1 : 0;
        const int ph = step - l * 9;
        switch (ph) {
        case 0:
            if (l == 0) phase_embed(p); else phase_rowstat(p);
            phase_convert<false>(p, l, lds);
            if (obid() == 0 && otid() < 32) ((int*)(WS(p) + OFF_CTL))[otid()] = 0;
            if (obid() == 0 && otid() == 32) ((int*)(WS(p) + OFF_CTL))[64 + l] = 0;
            break;
        case 1: phase_inproj(p, lds); break;
        case 2: phase_dsa_prep(p, l); break;
        case 3: {
            if (obid() < NB * 16) phase_scan2(p, l, lds, obid());
            int* qctr = (int*)(WS(p) + OFF_CTL) + 64 + l;
            int* qslot = (int*)(lds + LDS_BYTES - 16);
            for (;;) {
                __syncthreads();
                if (otid() == 0) *qslot = atomicAdd(qctr, 1);
                __syncthreads();
                const int item = *qslot;
                if (item >= 516 + NT / 16) break;
                if (item < 516) phase_pool(p, l, lds, item, item + 1, 1);
                else phase_dsa<false>(p, l, lds, (bf16_t*)(OUTB(p) + DO_YC), nullptr, nullptr, item - 516, item - 515, 1);
            }
        } break;
        case 4: phase_merge(p, lds); break;
        case 5: phase_outproj(p, lds); phase_convert<true>(p, l, lds); break;
        case 6: phase_route(p, l); break;
        case 7: phase_moe1(p, lds); break;
        default: phase_moe2(p, lds); break;
        }
        grid.sync();
    }
    phase_final(p);
}

extern "C" void kernel_launch(void* const* d_in, const int* in_sizes, int n_in,
                              void* d_out, int out_size, void* d_ws, size_t ws_size,
                              hipStream_t stream) {
    static int grid_blocks = 0;
    if (grid_blocks == 0) {
        int dev = 0, cus = 0, per_cu = 0;
        (void)hipGetDevice(&dev);
        (void)hipDeviceGetAttribute(&cus, hipDeviceAttributeMultiprocessorCount, dev);
        (void)hipFuncSetAttribute((const void*)fwd_megakernel, hipFuncAttributeMaxDynamicSharedMemorySize, LDS_BYTES);
        (void)hipOccupancyMaxActiveBlocksPerMultiprocessor(&per_cu, fwd_megakernel, NTHR, LDS_BYTES);
        if (per_cu < 1 || n_in != 42 || ws_size < WS_END) { fprintf(stderr, "kernel_launch: bad config per_cu=%d n_in=%d ws=%zu need=%zu\n", per_cu, n_in, ws_size, (size_t)WS_END); grid_blocks = -1; }
        else grid_blocks = cus;
    }
    if (grid_blocks < 0) return;
    Params p{};
    for (int i = 0; i < 42; ++i) p.in[i] = (const float*)d_in[i];
    p.out = (float*)d_out;
    p.ws = (unsigned char*)d_ws;
    void* args[] = {&p};
    hipError_t e = hipLaunchCooperativeKernel((void*)fwd_megakernel, dim3(grid_blocks), dim3(NTHR), args, LDS_BYTES, stream);
    if (e != hipSuccess) fprintf(stderr, "cooperative launch failed: %s (grid %d)\n", hipGetErrorString(e), grid_blocks);
}
```

```cpp
#include <hip/hip_runtime.h>
#include <hip/hip_cooperative_groups.h>
#include <cstdio>
#include <cstdint>
namespace cg = cooperative_groups;

typedef unsigned short bf16_t;
typedef short bf16x8 __attribute__((ext_vector_type(8)));
typedef float f32x4 __attribute__((ext_vector_type(4)));

constexpr int NB = 8, SEQ = 2048, NMETA = 16, TS = 2064, DM = 1024;
constexpr int NT = NB * TS;
constexpr int NTP = 16640;
constexpr int NTHR = 512;
constexpr int CIN = 7912;
constexpr int NP1 = 4992;
constexpr int PM_LD = 896;
constexpr int PM_WD = 0, PM_AD = 64, PM_GD = 128, PM_VD = 256, PM_CQ = 320, PM_CKV = 576, PM_KROPE = 704, PM_KIDX = 736, PM_WIDX = 800;
constexpr int LDS_BYTES = 157 * 1024;

constexpr size_t AL(size_t x) { return (x + 255) & ~(size_t)255; }
constexpr size_t SZ_ACT = (size_t)NTP * 1024 * 2;
constexpr size_t OFF_CTL = 0;
constexpr size_t OFF_BAR = 4096;
constexpr size_t OFF_RSTD = OFF_BAR + 16384;
constexpr size_t OFF_ROPE = OFF_RSTD + AL((size_t)NTP * 4);
constexpr size_t OFF_H = OFF_ROPE + AL((size_t)TS * 16 * 4 * 2);
constexpr size_t OFF_WB = OFF_H + SZ_ACT;
constexpr size_t WB_WIN = 0;
constexpr size_t WB_WG = WB_WIN + (size_t)NP1 * 1024;
constexpr size_t WB_PA = WB_WG + (size_t)3072 * 1024;
constexpr size_t WB_WO = WB_PA + (size_t)3 * 1024 * 1024;
constexpr size_t WB_POOL = WB_WO + (size_t)1024 * 1024;
constexpr size_t WB_QI = WB_POOL + (size_t)4 * 256 * 256;
constexpr size_t WB_UQ = WB_QI + (size_t)512 * 256;
constexpr size_t WB_UK = WB_UQ + (size_t)1536 * 256;
constexpr size_t WB_UV = WB_UK + (size_t)16 * 128 * 64;
constexpr size_t WB_END = WB_UV + (size_t)16 * 64 * 128;
constexpr size_t OFF_PPOOL = OFF_WB + AL(WB_END * 2);
constexpr size_t OFF_PK = OFF_PPOOL + SZ_ACT;
constexpr size_t OFF_PR = OFF_PK + SZ_ACT;
constexpr size_t OFF_PV = OFF_PR + SZ_ACT;
constexpr size_t OFF_PMISC = OFF_PV + SZ_ACT;
constexpr size_t OFF_VFIRST = OFF_PMISC + AL((size_t)NTP * PM_LD * 2);
constexpr size_t OFF_HALO = OFF_VFIRST + SZ_ACT;
constexpr size_t OFF_LIST = OFF_HALO + AL((size_t)130 * 16 * 1024 * 2);
constexpr size_t OFF_PW = OFF_LIST + AL((size_t)24 * NT * 4);
constexpr size_t WS_END = OFF_PW + AL((size_t)NT * 2 * 4);
constexpr size_t OFF_MERGED = OFF_PK;
constexpr size_t OFF_HM32 = OFF_PR;
constexpr size_t OFF_HN = OFF_PPOOL;
constexpr size_t OFF_WEXP = OFF_PMISC;
constexpr size_t WE_W1 = 0, WE_W3 = (size_t)16 * 256 * 1024, WE_W2 = (size_t)2 * 16 * 256 * 1024;
static_assert((size_t)3 * 16 * 256 * 1024 * 2 <= (size_t)NTP * PM_LD * 2, "expert weights must fit in Pmisc");
constexpr size_t DO_YC = 0;
constexpr size_t DO_CQN = DO_YC + SZ_ACT;
constexpr size_t DO_KV = DO_CQN + AL((size_t)NT * 256 * 2);
constexpr size_t DO_KIDX = DO_KV + AL((size_t)NT * 160 * 2);
constexpr size_t DO_WHEAD = DO_KIDX + AL((size_t)NT * 64 * 2);
constexpr size_t DO_END = DO_WHEAD + AL((size_t)NT * 8 * 4);
constexpr size_t DO_HID = DO_YC;
static_assert(DO_END <= (size_t)NB * SEQ * DM * 4, "d_out scratch overflow");
static_assert((size_t)(129 + 24) * 128 * 512 * 2 <= SZ_ACT, "hid fits");
static_assert(WS_END <= 277240096ull, "workspace overflow");

struct Params {
    const float* in[42];
    float* out;
    unsigned char* ws;
};

__device__ __forceinline__ int otid() { int t = threadIdx.x; asm volatile("" : "+v"(t)); return t; }
__device__ __forceinline__ int obid() { int b = blockIdx.x; asm volatile("" : "+s"(b)); return b; }
__device__ __forceinline__ unsigned char* WS(const Params& p) { unsigned char* w = p.ws; asm volatile("" : "+s"(w)); return w; }
__device__ __forceinline__ unsigned char* OUTB(const Params& p) { unsigned char* w = (unsigned char*)p.out; asm volatile("" : "+s"(w)); return w; }
__device__ __forceinline__ float bf2f(bf16_t v) { return __uint_as_float(((unsigned)v) << 16); }
__device__ __forceinline__ bf16_t f2bf(float f) { unsigned u = __float_as_uint(f); u += 0x7FFFu + ((u >> 16) & 1u); return (bf16_t)(u >> 16); }
__device__ __forceinline__ float wave_sum(float v) {
#pragma unroll
    for (int o = 32; o > 0; o >>= 1) v += __shfl_xor(v, o);
    return v;
}
__device__ __forceinline__ float sigmoidf_(float x) { return 1.0f / (1.0f + __expf(-x)); }
__device__ __forceinline__ float softplusf_(float z) { return fmaxf(z, 0.f) + log1pf(__expf(-fabsf(z))); }
__device__ __forceinline__ void glds16(const void* g, void* l) {
    __builtin_amdgcn_global_load_lds((const unsigned*)g, (unsigned*)l, 16, 0, 0);
}

__device__ void phase_embed(const Params& p) {
    const int lane = otid() & 63;
    const int wave = (obid() * NTHR + otid()) >> 6, nw = gridDim.x * NTHR / 64;
    bf16_t* h = (bf16_t*)(WS(p) + OFF_H);
    float* rstd = (float*)(WS(p) + OFF_RSTD);
    for (int n = wave; n < NTP; n += nw) {
        if (n < NT) {
            const int b = n / TS, t = n % TS;
            const float* src = t < NMETA ? p.in[1] + (size_t)t * DM : p.in[0] + ((size_t)b * SEQ + (t - NMETA)) * DM;
            float ss = 0.f;
#pragma unroll
            for (int i = 0; i < 4; ++i) {
                const float4 v = *(const float4*)(src + i * 256 + lane * 4);
                ss += v.x * v.x + v.y * v.y + v.z * v.z + v.w * v.w;
                ushort4 o; o.x = f2bf(v.x); o.y = f2bf(v.y); o.z = f2bf(v.z); o.w = f2bf(v.w);
                *(ushort4*)(h + (size_t)n * DM + i * 256 + lane * 4) = o;
            }
            ss = wave_sum(ss);
            if (lane == 0) rstd[n] = rsqrtf(ss * (1.0f / 1024.0f) + 1e-6f);
        } else {
#pragma unroll
            for (int i = 0; i < 4; ++i) *(ushort4*)(h + (size_t)n * DM + i * 256 + lane * 4) = make_ushort4(0, 0, 0, 0);
            if (lane == 0) rstd[n] = 0.f;
        }
    }
    float* ctab = (float*)(WS(p) + OFF_ROPE);
    float* stab = ctab + TS * 16;
    for (int idx = obid() * NTHR + otid(); idx < TS * 16; idx += gridDim.x * NTHR) {
        const int t = idx >> 4, i = idx & 15;
        const float inv = powf(10000.0f, -(float)(2 * i) / 32.0f);
        const float ang = (float)t * inv;
        ctab[idx] = cosf(ang);
        stab[idx] = sinf(ang);
    }
}

__device__ void phase_rowstat(const Params& p) {
    const int lane = otid() & 63;
    const int wave = (obid() * NTHR + otid()) >> 6, nw = gridDim.x * NTHR / 64;
    const float* hm = (const float*)(WS(p) + OFF_HM32);
    float* rstd = (float*)(WS(p) + OFF_RSTD);
    for (int n = wave; n < NT; n += nw) {
        float ss = 0.f;
#pragma unroll
        for (int i = 0; i < 4; ++i) {
            const float4 v = *(const float4*)(hm + (size_t)n * DM + i * 256 + lane * 4);
            ss += v.x * v.x + v.y * v.y + v.z * v.z + v.w * v.w;
        }
        ss = wave_sum(ss);
        if (lane == 0) rstd[n] = rsqrtf(ss * (1.0f / 1024.0f) + 1e-6f);
    }
}

struct ConvJob { const float* src; bf16_t* dst; const float* scale; int ldsrc, K, nvalid, nrows, nb, notr; size_t sbs, dbs; };
__device__ __forceinline__ int conv_job_tiles(const ConvJob& j) { return j.nb * (j.nrows >> 6) * (j.K >> 6); }
__device__ void conv_tile(const ConvJob& j, int tile, float* lds) {
    const int per = (j.nrows >> 6) * (j.K >> 6);
    const int bi = tile / per, rem = tile % per;
    const int ktiles = j.K >> 6;
    const int n0 = (rem / ktiles) << 6, k0 = (rem % ktiles) << 6;
    const int tid = otid(), tn = tid & 63, tk = tid >> 6;
    const float* src = j.src + (size_t)bi * j.sbs;
    bf16_t* dst = j.dst + (size_t)bi * j.dbs;
#pragma unroll
    for (int kk = 0; kk < 8; ++kk) {
        const int k = k0 + tk * 8 + kk;
        float v = 0.f;
        if (n0 + tn < j.nvalid) { v = j.notr ? src[(size_t)(n0 + tn) * j.ldsrc + k] : src[(size_t)k * j.ldsrc + n0 + tn]; if (j.scale) v *= j.scale[k]; }
        lds[tn * 65 + tk * 8 + kk] = v;
    }
    __syncthreads();
    const int wn = tid >> 3, kq = tid & 7;
    uint4 o;
    unsigned w[4];
#pragma unroll
    for (int q = 0; q < 4; ++q) {
        const float lo = lds[wn * 65 + kq * 8 + 2 * q], hi = lds[wn * 65 + kq * 8 + 2 * q + 1];
        w[q] = (unsigned)f2bf(lo) | ((unsigned)f2bf(hi) << 16);
    }
    o.x = w[0]; o.y = w[1]; o.z = w[2]; o.w = w[3];
    *(uint4*)(dst + (size_t)(n0 + wn) * j.K + k0 + kq * 8) = o;
    __syncthreads();
}
__device__ ConvJob get_job_early(const Params& p, int l, int ji) {
    bf16_t* wb = (bf16_t*)(WS(p) + OFF_WB);
    const float* win = p.in[3] + (size_t)l * DM * CIN;
    const float* nm = p.in[2] + (size_t)l * DM;
    ConvJob j{}; j.nb = 1; j.sbs = 0; j.dbs = 0; j.K = 1024; j.ldsrc = CIN; j.scale = nm;
    switch (ji) {
    case 0: j.src = win + 3072; j.dst = wb + WB_WIN; j.nvalid = 4352; j.nrows = 4352; break;
    case 1: j.src = p.in[17]; j.ldsrc = 32; j.dst = wb + WB_WIN + (size_t)(4096 + PM_VD) * 1024; j.nvalid = (l == 0 ? 0 : 32); j.nrows = 64; break;
    case 2: j.src = win + 7424; j.dst = wb + WB_WIN + (size_t)(4096 + PM_CQ) * 1024; j.nvalid = 488; j.nrows = 576; break;
    case 3: j.src = win; j.dst = wb + WB_WG; j.nvalid = 3072; j.nrows = 3072; break;
    case 4: j.src = p.in[29] + (size_t)l * DM * DM; j.ldsrc = 1024; j.scale = nullptr; j.dst = wb + WB_PA; j.nvalid = 1024; j.nrows = 1024; break;
    case 5: j.src = p.in[30] + (size_t)l * DM * DM; j.ldsrc = 1024; j.scale = nullptr; j.dst = wb + WB_PA + (size_t)1024 * 1024; j.nvalid = 1024; j.nrows = 1024; break;
    case 6: j.src = p.in[31] + (size_t)l * DM * DM; j.ldsrc = 1024; j.scale = nullptr; j.dst = wb + WB_PA + (size_t)2 * 1024 * 1024; j.nvalid = 1024; j.nrows = 1024; break;
    case 7: j.src = p.in[32] + (size_t)l * DM * DM; j.ldsrc = 1024; j.scale = nullptr; j.dst = wb + WB_WO; j.nvalid = 1024; j.nrows = 1024; break;
    case 8: j.src = p.in[5] + (size_t)l * 4 * 256 * 256; j.ldsrc = 256; j.K = 256; j.scale = nullptr; j.dst = wb + WB_POOL; j.nvalid = 256; j.nrows = 256; j.nb = 4; j.sbs = 65536; j.dbs = 65536; break;
    case 9: j.src = p.in[26] + (size_t)l * 256 * 512; j.ldsrc = 512; j.K = 256; j.scale = nullptr; j.dst = wb + WB_QI; j.nvalid = 512; j.nrows = 512; break;
    case 10: j.src = p.in[23] + (size_t)l * 256 * 1536; j.ldsrc = 1536; j.K = 256; j.scale = nullptr; j.dst = wb + WB_UQ; j.nvalid = 1536; j.nrows = 1536; break;
    case 11: j.src = p.in[24] + (size_t)l * 16 * 128 * 64; j.ldsrc = 64; j.K = 64; j.scale = nullptr; j.dst = wb + WB_UK; j.nvalid = 2048; j.nrows = 2048; j.notr = 1; break;
    default: j.src = p.in[25] + (size_t)l * 16 * 128 * 64; j.ldsrc = 64; j.K = 128; j.scale = nullptr; j.dst = wb + WB_UV; j.nvalid = 64; j.nrows = 64; j.nb = 16; j.sbs = 8192; j.dbs = 8192; break;
    }
    return j;
}
__device__ ConvJob get_job_late(const Params& p, int l, int ji) {
    bf16_t* we = (bf16_t*)(WS(p) + OFF_WEXP);
    ConvJob j{}; j.nb = 16; j.scale = nullptr; j.sbs = 262144; j.dbs = 262144;
    switch (ji) {
    case 0: j.src = p.in[38] + (size_t)l * 16 * 262144; j.dst = we + WE_W1; j.ldsrc = 256; j.K = 1024; j.nvalid = 256; j.nrows = 256; break;
    case 1: j.src = p.in[39] + (size_t)l * 16 * 262144; j.dst = we + WE_W3; j.ldsrc = 256; j.K = 1024; j.nvalid = 256; j.nrows = 256; break;
    default: j.src = p.in[40] + (size_t)l * 16 * 262144; j.dst = we + WE_W2; j.ldsrc = 1024; j.K = 256; j.nvalid = 1024; j.nrows = 1024; break;
    }
    return j;
}
template <bool LATE>
__device__ void phase_convert(const Params& p, int l, unsigned char* lds) {
    const int njobs = LATE ? 3 : 13;
    int base = 0;
    for (int ji = 0; ji < njobs; ++ji) {
        const ConvJob j = LATE ? get_job_late(p, l, ji) : get_job_early(p, l, ji);
        const int nt = conv_job_tiles(j);
        int first = ((int)obid() - base) % (int)gridDim.x; if (first < 0) first += gridDim.x;
        for (int t = first; t < nt; t += gridDim.x) conv_tile(j, t, (float*)lds);
        base += nt;
    }
}

template <int BM> struct G3 {
    static constexpr int MI = BM / 64;
    static constexpr int NA = BM / 64;
    static constexpr int STAGE = BM * 128 + 128 * 128;
    const bf16_t* ap[NA];
    const bf16_t* bp[2];
};
template <int BM>
__device__ __forceinline__ void g3_issue(const G3<BM>& g, int kt, unsigned char* stage, int tid) {
#pragma unroll
    for (int i = 0; i < G3<BM>::NA; ++i) glds16(g.ap[i] + kt * 64, stage + (tid + i * NTHR) * 16);
#pragma unroll
    for (int i = 0; i < 2; ++i) glds16(g.bp[i] + kt * 64, stage + BM * 128 + (tid + i * NTHR) * 16);
}
template <int BM, class FA, class FB>
__device__ __forceinline__ void g3_setup(G3<BM>& g, FA rowptr, FB bcol, int tid) {
#pragma unroll
    for (int i = 0; i < G3<BM>::NA; ++i) { const int idx = tid + i * NTHR, row = idx >> 3, sl = (idx & 7) ^ (row & 7); g.ap[i] = rowptr(row) + sl * 8; }
#pragma unroll
    for (int i = 0; i < 2; ++i) { const int idx = tid + i * NTHR, row = idx >> 3, sl = (idx & 7) ^ (row & 7); g.bp[i] = bcol(row) + sl * 8; }
}
template <int BM>
__device__ __forceinline__ void g3_kloop(f32x4 (&acc)[BM / 64][4], const G3<BM>& g, int K, unsigned char* lds) {
    constexpr int MI = G3<BM>::MI, STAGE = G3<BM>::STAGE, NL = G3<BM>::NA + 2;
    const int tid = otid(), lane = tid & 63, wid = tid >> 6, wr = wid >> 1, wc = wid & 1, fr = lane & 15, fq = lane >> 4;
    const int nk = K >> 6;
    g3_issue<BM>(g, 0, lds, tid);
    if (nk > 1) g3_issue<BM>(g, 1, lds + STAGE, tid);
    int cur = 0;
#pragma unroll 1
    for (int t = 0; t < nk; ++t) {
        if (t + 1 < nk) { if (NL == 6) asm volatile("s_waitcnt vmcnt(6)" ::: "memory"); else asm volatile("s_waitcnt vmcnt(4)" ::: "memory"); }
        else asm volatile("s_waitcnt vmcnt(0)" ::: "memory");
        __builtin_amdgcn_s_barrier();
        if (t + 2 < nk) { int nx = cur + 2; if (nx >= 3) nx -= 3; g3_issue<BM>(g, t + 2, lds + nx * STAGE, tid); }
        const unsigned char* cA = lds + cur * STAGE;
        const unsigned char* cB = cA + BM * 128;
#pragma unroll
        for (int ks = 0; ks < 2; ++ks) {
            bf16x8 a[MI], b[4];
#pragma unroll
            for (int m = 0; m < MI; ++m) { const int row = wr * (BM / 4) + m * 16 + fr; a[m] = *(const bf16x8*)(cA + row * 128 + (((ks * 4 + fq) ^ (row & 7)) << 4)); }
#pragma unroll
            for (int n = 0; n < 4; ++n) { const int row = wc * 64 + n * 16 + fr; b[n] = *(const bf16x8*)(cB + row * 128 + (((ks * 4 + fq) ^ (row & 7)) << 4)); }
#pragma unroll
            for (int m = 0; m < MI; ++m)
#pragma unroll
                for (int n = 0; n < 4; ++n) acc[m][n] = __builtin_amdgcn_mfma_f32_16x16x32_bf16(b[n], a[m], acc[m][n], 0, 0, 0);
        }
        cur = (cur == 2) ? 0 : cur + 1;
    }
    __builtin_amdgcn_s_barrier();
}
template <int MI>
__device__ __forceinline__ void g3_zero(f32x4 (&acc)[MI][4]) {
#pragma unroll
    for (int m = 0; m < MI; ++m)
#pragma unroll
        for (int n = 0; n < 4; ++n) acc[m][n] = (f32x4){0.f, 0.f, 0.f, 0.f};
}
__device__ __forceinline__ uint2 pack4(float a, float b, float c, float d) {
    uint2 r; r.x = (unsigned)f2bf(a) | ((unsigned)f2bf(b) << 16); r.y = (unsigned)f2bf(c) | ((unsigned)f2bf(d) << 16); return r;
}

__device__ void phase_inproj(const Params& p, unsigned char* lds) {
    const int tid = otid(), lane = tid & 63, wid = tid >> 6, wr = wid >> 1, wc = wid & 1, fr = lane & 15, fq = lane >> 4;
    const bf16_t* h = (const bf16_t*)(WS(p) + OFF_H);
    const bf16_t* wt = (const bf16_t*)(WS(p) + OFF_WB) + WB_WIN;
    const float* rstd = (const float*)(WS(p) + OFF_RSTD);
    bf16_t* halo = (bf16_t*)(WS(p) + OFF_HALO);
    constexpr int NTN = NP1 / 128;
    for (int tile = obid(); tile < 65 * NTN; tile += gridDim.x) {
        const int mt = tile / NTN, nt = tile % NTN;
        const int row0 = mt * 256, col0 = nt * 128;
        G3<256> g;
        g3_setup<256>(g, [&](int r) { return h + (size_t)(row0 + r) * DM; }, [&](int r) { return wt + (size_t)(col0 + r) * DM; }, tid);
        f32x4 acc[4][4]; g3_zero<4>(acc);
        g3_kloop<256>(acc, g, DM, lds);
        bf16_t* dst; int ld, cbase;
        if (nt < 8) { dst = (bf16_t*)(WS(p) + OFF_PPOOL); ld = 1024; cbase = 0; }
        else if (nt < 16) { dst = (bf16_t*)(WS(p) + OFF_PR); ld = 1024; cbase = 1024; }
        else if (nt < 24) { dst = (bf16_t*)(WS(p) + OFF_PK); ld = 1024; cbase = 2048; }
        else if (nt < 32) { dst = (bf16_t*)(WS(p) + OFF_PV); ld = 1024; cbase = 3072; }
        else { dst = (bf16_t*)(WS(p) + OFF_PMISC); ld = PM_LD; cbase = 4096; }
#pragma unroll
        for (int m = 0; m < 4; ++m) {
            const int row = row0 + wr * 64 + m * 16 + fr;
            if (row < NT) {
                const float rs = rstd[row];
                const int lr = row & 127;
#pragma unroll
                for (int n = 0; n < 4; ++n) {
                    const int col = col0 + wc * 64 + n * 16 + fq * 4;
                    const uint2 v = pack4(acc[m][n][0] * rs, acc[m][n][1] * rs, acc[m][n][2] * rs, acc[m][n][3] * rs);
                    *(uint2*)(dst + (size_t)row * ld + (col - cbase)) = v;
                    if (nt < 8 && lr >= 112) *(uint2*)(halo + ((size_t)(row >> 7) * 16 + (lr - 112)) * 1024 + col) = v;
                }
            }
        }
    }
}

__device__ void phase_pool(const Params& p, int l, unsigned char* lds, int tb, int te, int tstep) {
    const int tid = otid(), lane = tid & 63, wid = tid >> 6, fr = lane & 15, fq = lane >> 4;
    bf16_t* pp = (bf16_t*)(WS(p) + OFF_PPOOL);
    const bf16_t* halo = (const bf16_t*)(WS(p) + OFF_HALO);
    const bf16_t* pw = (const bf16_t*)(WS(p) + OFF_WB) + WB_POOL;
    const float* scale = p.in[6] + (size_t)l * 1024;
    bf16_t* sp = (bf16_t*)lds;
    constexpr int SLD = 264;
    for (int tile = tb; tile < te; tile += tstep) {
        const int mt = tile >> 2, g = tile & 3;
        const int row0 = mt * 128, w = 2 << g;
        for (int e = tid; e < 128 * 256; e += NTHR) {
            const int r = e >> 8, c = e & 255;
            const int n = row0 + r, t = n % TS;
            const int col = g * 256 + c;
            const int cnt = (t + 1 < w) ? (t + 1) : w;
            float s = 0.f, self = 0.f;
            for (int i = 0; i < cnt; ++i) {
                const int n2 = n - i;
                float v;
                if (n2 >= row0) v = bf2f(pp[(size_t)n2 * 1024 + col]);
                else v = bf2f(halo[((size_t)(n2 >> 7) * 16 + ((n2 & 127) - 112)) * 1024 + col]);
                if (i == 0) self = v;
                s += v;
            }
            sp[r * SLD + c] = f2bf(s / (float)cnt - self);
        }
        __syncthreads();
        f32x4 acc[8][2];
#pragma unroll
        for (int m = 0; m < 8; ++m) { acc[m][0] = (f32x4){0.f, 0.f, 0.f, 0.f}; acc[m][1] = (f32x4){0.f, 0.f, 0.f, 0.f}; }
        const bf16_t* wg = pw + (size_t)g * 65536;
#pragma unroll 1
        for (int kk = 0; kk < 8; ++kk) {
            bf16x8 bfr[2];
#pragma unroll
            for (int n = 0; n < 2; ++n) bfr[n] = *(const bf16x8*)(wg + (size_t)(wid * 32 + n * 16 + fr) * 256 + kk * 32 + fq * 8);
#pragma unroll
            for (int m = 0; m < 8; ++m) {
                const bf16x8 a = *(const bf16x8*)(sp + (m * 16 + fr) * SLD + kk * 32 + fq * 8);
                acc[m][0] = __builtin_amdgcn_mfma_f32_16x16x32_bf16(a, bfr[0], acc[m][0], 0, 0, 0);
                acc[m][1] = __builtin_amdgcn_mfma_f32_16x16x32_bf16(a, bfr[1], acc[m][1], 0, 0, 0);
            }
        }
#pragma unroll
        for (int m = 0; m < 8; ++m)
#pragma unroll
            for (int n = 0; n < 2; ++n) {
                const int col = g * 256 + wid * 32 + n * 16 + fr;
                const float sc = scale[col];
#pragma unroll
                for (int j = 0; j < 4; ++j) {
                    const int row = row0 + m * 16 + fq * 4 + j;
                    pp[(size_t)row * 1024 + col] = f2bf(acc[m][n][j] * sc);
                }
            }
        __syncthreads();
    }
}

__device__ void phase_dsa_prep(const Params& p, int l) {
    const int lane = otid() & 63;
    const int wave = (obid() * NTHR + otid()) >> 6, nw = gridDim.x * NTHR / 64;
    const bf16_t* pm = (const bf16_t*)(WS(p) + OFF_PMISC);
    unsigned char* dob = OUTB(p);
    bf16_t* cqn = (bf16_t*)(dob + DO_CQN);
    bf16_t* kv = (bf16_t*)(dob + DO_KV);
    bf16_t* kidx = (bf16_t*)(dob + DO_KIDX);
    float* whead = (float*)(dob + DO_WHEAD);
    const float* ctab = (const float*)(WS(p) + OFF_ROPE);
    const float* stab = ctab + TS * 16;
    const float* qn = p.in[21] + l * 256;
    const float* kvn = p.in[22] + l * 128;
    const float* inw = p.in[27] + l * 64;
    const float* inb = p.in[28] + l * 64;
    for (int n = wave; n < NT; n += nw) {
        const int t = n % TS;
        const bf16_t* row = pm + (size_t)n * PM_LD;
        {
            float v[4]; float ss = 0.f;
#pragma unroll
            for (int i = 0; i < 4; ++i) { v[i] = bf2f(row[PM_CQ + lane * 4 + i]); ss += v[i] * v[i]; }
            ss = wave_sum(ss);
            const float rs = rsqrtf(ss * (1.0f / 256.0f) + 1e-6f);
#pragma unroll
            for (int i = 0; i < 4; ++i) cqn[(size_t)n * 256 + lane * 4 + i] = f2bf(v[i] * rs * qn[lane * 4 + i]);
        }
        {
            float v[2]; float ss = 0.f;
#pragma unroll
            for (int i = 0; i < 2; ++i) { v[i] = bf2f(row[PM_CKV + lane * 2 + i]); ss += v[i] * v[i]; }
            ss = wave_sum(ss);
            const float rs = rsqrtf(ss * (1.0f / 128.0f) + 1e-6f);
#pragma unroll
            for (int i = 0; i < 2; ++i) kv[(size_t)n * 160 + lane * 2 + i] = f2bf(v[i] * rs * kvn[lane * 2 + i]);
        }
        if (lane < 16) {
            const float x1 = bf2f(row[PM_KROPE + lane]), x2 = bf2f(row[PM_KROPE + 16 + lane]);
            const float c = ctab[t * 16 + lane], s = stab[t * 16 + lane];
            kv[(size_t)n * 160 + 128 + lane] = f2bf(x1 * c - x2 * s);
            kv[(size_t)n * 160 + 144 + lane] = f2bf(x2 * c + x1 * s);
        }
        {
            const float x = bf2f(row[PM_KIDX + lane]);
            const float mu = wave_sum(x) * (1.0f / 64.0f);
            const float d = x - mu;
            const float var = wave_sum(d * d) * (1.0f / 64.0f);
            const float y = d * rsqrtf(var + 1e-6f) * inw[lane] + inb[lane];
            const float yo = __shfl_xor(y, 16);
            float o = y;
            if (lane < 32) {
                const int i = lane & 15;
                const float c = ctab[t * 16 + i], s = stab[t * 16 + i];
                o = (lane < 16) ? (y * c - yo * s) : (y * c + yo * s);
            }
            kidx[(size_t)n * 64 + lane] = f2bf(o);
        }
        if (lane < 8) whead[(size_t)n * 8 + lane] = bf2f(row[PM_WIDX + lane]) * 0.04419417382415922f;
    }
}

__device__ void phase_scan(const Params& p, int l, unsigned char* lds) {
    if (obid() >= NB * 16) return;
    const int tid = otid(), lane = tid & 63, wid = tid >> 6;
    const int b = obid() >> 4, hh = obid() & 15, hc = hh * 64;
    constexpr int TC = 16;
    float* s_r = (float*)lds;
    float* s_w = s_r + TC * 64;
    float* s_k = s_w + TC * 64;
    float* s_v = s_k + TC * 64;
    float* s_a = s_v + TC * 64;
    float* s_b = s_a + TC * 64;
    float* s_g = s_b + TC * 64;
    float* s_o = s_g + TC * 64;
    float* s_wd = s_o + TC * 64;
    float* s_ad = s_wd + TC * 64;
    float* s_gd = s_ad + TC * 64;
    float* s_vd = s_gd + TC * 128;
    float* s_pr = s_vd + TC * 32;
    float* s_W2 = s_pr + 128;
    float* s_A2 = s_W2 + 64 * 64;
    float* s_G2 = s_A2 + 64 * 64;
    float* s_V2 = s_G2 + 128 * 64;
    bf16_t* Pr = (bf16_t*)(WS(p) + OFF_PR);
    const bf16_t* Pk = (const bf16_t*)(WS(p) + OFF_PK);
    const bf16_t* Pv = (const bf16_t*)(WS(p) + OFF_PV);
    const bf16_t* Pm = (const bf16_t*)(WS(p) + OFF_PMISC);
    bf16_t* vfirst = (bf16_t*)(WS(p) + OFF_VFIRST);
    const float* mu = p.in[4] + (size_t)l * 3328;
    const float* vmu = p.in[18];
    const float* w0 = p.in[7] + l * 1024;
    const float* a0 = p.in[9] + l * 1024;
    const float* k_k = p.in[12] + l * 1024;
    const float* k_a = p.in[13] + l * 1024;
    const float* r_k = p.in[14] + l * 1024;
    const float* ln_w = p.in[15] + l * 1024;
    const float* ln_b = p.in[16] + l * 1024;
    const float* v0 = p.in[19];
    for (int e = tid; e < 64 * 64; e += NTHR) { const int m = e >> 6, c = e & 63; s_W2[e] = p.in[8][((size_t)l * 64 + m) * 1024 + hc + c]; s_A2[e] = p.in[10][((size_t)l * 64 + m) * 1024 + hc + c]; }
    for (int e = tid; e < 128 * 64; e += NTHR) { const int m = e >> 6, c = e & 63; s_G2[e] = p.in[11][((size_t)l * 128 + m) * 1024 + hc + c]; }
    for (int e = tid; e < 32 * 64; e += NTHR) { const int m = e >> 6, c = e & 63; s_V2[e] = (l > 0) ? p.in[20][(size_t)m * 1024 + hc + c] : 0.f; }
    float S[8];
#pragma unroll
    for (int j = 0; j < 8; ++j) S[j] = 0.f;
    const int si = tid >> 3, q8 = tid & 7;
    __syncthreads();
    for (int t0 = 0, ch = 0; t0 < TS; t0 += TC, ++ch) {
        for (int e = tid; e < TC * 64; e += NTHR) {
            const int tau = e >> 6, c = e & 63, t = t0 + tau;
            const size_t n = (size_t)b * TS + t;
            const float cr = bf2f(Pr[n * 1024 + hc + c]);
            const float ck = bf2f(Pk[n * 1024 + hc + c]);
            const float cv = bf2f(Pv[n * 1024 + hc + c]);
            float prr = 0.f, prk = 0.f, prv = 0.f;
            if (t > 0) {
                prr = (tau > 0) ? bf2f(Pr[(n - 1) * 1024 + hc + c]) : s_pr[((ch + 1) & 1) * 64 + c];
                prk = bf2f(Pk[(n - 1) * 1024 + hc + c]);
                prv = bf2f(Pv[(n - 1) * 1024 + hc + c]);
            }
            if (tau == TC - 1) s_pr[(ch & 1) * 64 + c] = cr;
            s_r[e] = cr + (prr - cr) * mu[hc + c];
            s_k[e] = ck + (prk - ck) * mu[1024 + hc + c];
            s_v[e] = cv + (prv - cv) * mu[2048 + hc + c];
            const float cwd = bf2f(Pm[n * PM_LD + PM_WD + c]), cad = bf2f(Pm[n * PM_LD + PM_AD + c]);
            float pwd = 0.f, pad_ = 0.f;
            if (t > 0) { pwd = bf2f(Pm[(n - 1) * PM_LD + PM_WD + c]); pad_ = bf2f(Pm[(n - 1) * PM_LD + PM_AD + c]); }
            s_wd[e] = tanhf(cwd + (pwd - cwd) * mu[3072 + c]);
            s_ad[e] = cad + (pad_ - cad) * mu[3136 + c];
        }
        for (int e = tid; e < TC * 128; e += NTHR) {
            const int tau = e >> 7, c = e & 127, t = t0 + tau;
            const size_t n = (size_t)b * TS + t;
            const float cg_ = bf2f(Pm[n * PM_LD + PM_GD + c]);
            const float pg = (t > 0) ? bf2f(Pm[(n - 1) * PM_LD + PM_GD + c]) : 0.f;
            s_gd[e] = sigmoidf_(cg_ + (pg - cg_) * mu[3200 + c]);
        }
        if (l > 0) {
            for (int e = tid; e < TC * 32; e += NTHR) {
                const int tau = e >> 5, c = e & 31, t = t0 + tau;
                const size_t n = (size_t)b * TS + t;
                const float cvd = bf2f(Pm[n * PM_LD + PM_VD + c]);
                const float pvd = (t > 0) ? bf2f(Pm[(n - 1) * PM_LD + PM_VD + c]) : 0.f;
                s_vd[e] = cvd + (pvd - cvd) * vmu[c];
            }
        }
        __syncthreads();
        for (int e = tid; e < TC * 64; e += NTHR) {
            const int tau = e >> 6, c = e & 63, t = t0 + tau;
            const size_t n = (size_t)b * TS + t;
            float xw = w0[hc + c], xa = a0[hc + c], gg = 0.f, xv = 0.f;
#pragma unroll 8
            for (int m = 0; m < 64; ++m) { xw += s_wd[tau * 64 + m] * s_W2[m * 64 + c]; xa += s_ad[tau * 64 + m] * s_A2[m * 64 + c]; }
#pragma unroll 8
            for (int m = 0; m < 128; ++m) gg += s_gd[tau * 128 + m] * s_G2[m * 64 + c];
            const float wlog = -softplusf_(-xw) - 0.5f;
            const float decay = __expf(-__expf(wlog));
            const float a = sigmoidf_(xa);
            float vv = s_v[e];
            if (l > 0) {
                xv = v0[hc + c];
#pragma unroll 8
                for (int m = 0; m < 32; ++m) xv += s_vd[tau * 32 + m] * s_V2[m * 64 + c];
                const float vf = bf2f(vfirst[n * 1024 + hc + c]);
                vv = vv + (vf - vv) * sigmoidf_(xv);
            } else {
                vfirst[n * 1024 + hc + c] = f2bf(vv);
            }
            const float kraw = s_k[e];
            const float kkv = kraw * k_k[hc + c];
            const float nrm = sqrtf(wave_sum(kkv * kkv));
            const float kk = kkv / fmaxf(nrm, 1e-12f);
            s_w[e] = decay;
            s_a[e] = -kk;
            s_b[e] = kk * a;
            s_k[e] = kraw * (1.0f + (a - 1.0f) * k_a[hc + c]);
            s_v[e] = vv;
            s_g[e] = gg;
        }
        __syncthreads();
#pragma unroll 1
        for (int tau = 0; tau < TC; ++tau) {
            const float4 a0v = *(const float4*)(s_a + tau * 64 + q8 * 8), a1v = *(const float4*)(s_a + tau * 64 + q8 * 8 + 4);
            const float4 w0v = *(const float4*)(s_w + tau * 64 + q8 * 8), w1v = *(const float4*)(s_w + tau * 64 + q8 * 8 + 4);
            const float4 b0v = *(const float4*)(s_b + tau * 64 + q8 * 8), b1v = *(const float4*)(s_b + tau * 64 + q8 * 8 + 4);
            const float4 k0v = *(const float4*)(s_k + tau * 64 + q8 * 8), k1v = *(const float4*)(s_k + tau * 64 + q8 * 8 + 4);
            const float4 r0v = *(const float4*)(s_r + tau * 64 + q8 * 8), r1v = *(const float4*)(s_r + tau * 64 + q8 * 8 + 4);
            const float vi = s_v[tau * 64 + si];
            const float av[8] = {a0v.x, a0v.y, a0v.z, a0v.w, a1v.x, a1v.y, a1v.z, a1v.w};
            const float wv[8] = {w0v.x, w0v.y, w0v.z, w0v.w, w1v.x, w1v.y, w1v.z, w1v.w};
            const float bv[8] = {b0v.x, b0v.y, b0v.z, b0v.w, b1v.x, b1v.y, b1v.z, b1v.w};
            const float kv_[8] = {k0v.x, k0v.y, k0v.z, k0v.w, k1v.x, k1v.y, k1v.z, k1v.w};
            const float rv[8] = {r0v.x, r0v.y, r0v.z, r0v.w, r1v.x, r1v.y, r1v.z, r1v.w};
            float sa = 0.f;
#pragma unroll
            for (int j = 0; j < 8; ++j) sa += S[j] * av[j];
            sa += __shfl_xor(sa, 1); sa += __shfl_xor(sa, 2); sa += __shfl_xor(sa, 4);
            float o = 0.f;
#pragma unroll
            for (int j = 0; j < 8; ++j) { S[j] = S[j] * wv[j] + sa * bv[j] + vi * kv_[j]; o += S[j] * rv[j]; }
            o += __shfl_xor(o, 1); o += __shfl_xor(o, 2); o += __shfl_xor(o, 4);
            if (q8 == 0) s_o[tau * 64 + si] = o;
        }
        __syncthreads();
        for (int tau = wid; tau < TC; tau += 8) {
            const int c = lane, e = tau * 64 + c;
            const size_t n = (size_t)b * TS + t0 + tau;
            const float o = s_o[e];
            const float m_ = wave_sum(o) * (1.0f / 64.0f);
            const float d = o - m_;
            const float var = wave_sum(d * d) * (1.0f / 64.0f);
            const float on = d * rsqrtf(var + 64e-5f) * ln_w[hc + c] + ln_b[hc + c];
            const float bonus = wave_sum(s_r[e] * s_k[e] * r_k[hc + c]) * s_v[e];
            Pr[n * 1024 + hc + c] = f2bf((on + bonus) * s_g[e]);
        }
        __syncthreads();
    }
}

__device__ void phase_dsa_naive(const Params& p, int l, unsigned char* lds) {
    const int tid = otid(), lane = tid & 63, wid = tid >> 6;
    constexpr int QT = 4, SCL = 2080;
    float* s_cq = (float*)lds;
    float* s_q = s_cq + QT * 256;
    float* s_Q = s_q + QT * 1536;
    float* s_qi = s_Q + QT * 16 * 160;
    float* s_sc = s_qi + QT * 512;
    int* s_sel = (int*)(s_sc + QT * SCL);
    int* s_nsel = s_sel + QT * 256;
    float* s_p = (float*)(s_nsel + 16);
    float* s_ol = s_p + 16 * 256;
    float* s_wh = s_ol + 16 * 128;
    unsigned char* dob = OUTB(p);
    const bf16_t* cqn = (const bf16_t*)(dob + DO_CQN);
    const bf16_t* kv = (const bf16_t*)(dob + DO_KV);
    const bf16_t* kidx = (const bf16_t*)(dob + DO_KIDX);
    const float* whead = (const float*)(dob + DO_WHEAD);
    bf16_t* yc = (bf16_t*)(dob + DO_YC);
    const float* ctab = (const float*)(WS(p) + OFF_ROPE);
    const float* stab = ctab + TS * 16;
    const float* w_uq = p.in[23] + (size_t)l * 256 * 1536;
    const float* w_uk = p.in[24] + (size_t)l * 16 * 128 * 64;
    const float* w_uv = p.in[25] + (size_t)l * 16 * 128 * 64;
    const float* w_qi = p.in[26] + (size_t)l * 256 * 512;
    const float scale = 0.10206207261596575f;
    for (int tile = obid(); tile < NT / QT; tile += gridDim.x) {
        const int n0 = tile * QT, b = n0 / TS, t0 = n0 % TS;
        for (int e = tid; e < QT * 256; e += NTHR) s_cq[e] = bf2f(cqn[(size_t)n0 * 256 + e]);
        if (tid < QT * 8) s_wh[tid] = whead[(size_t)n0 * 8 + tid];
        __syncthreads();
        {
            float acc[3][QT];
#pragma unroll
            for (int c = 0; c < 3; ++c)
#pragma unroll
                for (int q = 0; q < QT; ++q) acc[c][q] = 0.f;
            float ai[QT];
#pragma unroll
            for (int q = 0; q < QT; ++q) ai[q] = 0.f;
            for (int i = 0; i < 256; ++i) {
                const float wa = w_uq[(size_t)i * 1536 + tid], wb_ = w_uq[(size_t)i * 1536 + 512 + tid], wc_ = w_uq[(size_t)i * 1536 + 1024 + tid];
                const float wi = w_qi[(size_t)i * 512 + tid];
#pragma unroll
                for (int q = 0; q < QT; ++q) {
                    const float c = s_cq[q * 256 + i];
                    acc[0][q] += c * wa; acc[1][q] += c * wb_; acc[2][q] += c * wc_; ai[q] += c * wi;
                }
            }
#pragma unroll
            for (int q = 0; q < QT; ++q) {
                s_q[q * 1536 + tid] = acc[0][q]; s_q[q * 1536 + 512 + tid] = acc[1][q]; s_q[q * 1536 + 1024 + tid] = acc[2][q];
                s_qi[q * 512 + tid] = ai[q];
            }
        }
        __syncthreads();
        for (int e = tid; e < QT * 16 * 16; e += NTHR) {
            const int q = e >> 8, h = (e >> 4) & 15, i = e & 15;
            const float x1 = s_q[q * 1536 + h * 96 + 64 + i], x2 = s_q[q * 1536 + h * 96 + 80 + i];
            const float c = ctab[(t0 + q) * 16 + i], s = stab[(t0 + q) * 16 + i];
            s_Q[(q * 16 + h) * 160 + 128 + i] = x1 * c - x2 * s;
            s_Q[(q * 16 + h) * 160 + 144 + i] = x2 * c + x1 * s;
        }
        {
            const int q = tid >> 7, h8 = (tid >> 4) & 7, i = tid & 15;
            const float x1 = s_qi[q * 512 + h8 * 64 + i], x2 = s_qi[q * 512 + h8 * 64 + 16 + i];
            const float c = ctab[(t0 + q) * 16 + i], s = stab[(t0 + q) * 16 + i];
            __syncthreads();
            s_qi[q * 512 + h8 * 64 + i] = x1 * c - x2 * s;
            s_qi[q * 512 + h8 * 64 + 16 + i] = x2 * c + x1 * s;
        }
        for (int id = tid; id < 16 * 128; id += NTHR) {
            const int h = id >> 7, c = id & 127;
            const float* wrow = w_uk + ((size_t)h * 128 + c) * 64;
            float acc[QT];
#pragma unroll
            for (int q = 0; q < QT; ++q) acc[q] = 0.f;
            for (int d = 0; d < 64; d += 4) {
                const float4 w4 = *(const float4*)(wrow + d);
#pragma unroll
                for (int q = 0; q < QT; ++q) {
                    const float* qq = s_q + q * 1536 + h * 96 + d;
                    acc[q] += qq[0] * w4.x + qq[1] * w4.y + qq[2] * w4.z + qq[3] * w4.w;
                }
            }
#pragma unroll
            for (int q = 0; q < QT; ++q) s_Q[(q * 16 + h) * 160 + c] = acc[q];
        }
        __syncthreads();
        const int tmax = t0 + QT - 1;
        for (int s = tid; s <= tmax; s += NTHR) {
            float kr[64];
            const bf16_t* krow = kidx + ((size_t)b * TS + s) * 64;
#pragma unroll
            for (int v8 = 0; v8 < 8; ++v8) {
                const uint4 u = *(const uint4*)(krow + v8 * 8);
                kr[v8 * 8 + 0] = __uint_as_float(u.x << 16); kr[v8 * 8 + 1] = __uint_as_float(u.x & 0xFFFF0000u);
                kr[v8 * 8 + 2] = __uint_as_float(u.y << 16); kr[v8 * 8 + 3] = __uint_as_float(u.y & 0xFFFF0000u);
                kr[v8 * 8 + 4] = __uint_as_float(u.z << 16); kr[v8 * 8 + 5] = __uint_as_float(u.z & 0xFFFF0000u);
                kr[v8 * 8 + 6] = __uint_as_float(u.w << 16); kr[v8 * 8 + 7] = __uint_as_float(u.w & 0xFFFF0000u);
            }
#pragma unroll 1
            for (int q = 0; q < QT; ++q) {
                float I = 0.f;
#pragma unroll 1
                for (int h = 0; h < 8; ++h) {
                    const float* qq = s_qi + q * 512 + h * 64;
                    float d = 0.f;
#pragma unroll
                    for (int j = 0; j < 64; ++j) d += qq[j] * kr[j];
                    I += s_wh[q * 8 + h] * fmaxf(d, 0.f);
                }
                s_sc[q * SCL + s] = I;
            }
        }
        __syncthreads();
        if (wid < QT) {
            const int q = wid, t = t0 + q, nadm = t + 1;
            const float* sc = s_sc + q * SCL;
            int* sel = s_sel + q * 256;
            if (nadm <= 256) {
                for (int i = lane; i < nadm; i += 64) sel[i] = i;
                if (lane == 0) s_nsel[q] = nadm;
            } else {
                const int nch = (nadm + 63) >> 6;
                unsigned T = 0u;
                for (int bit = 31; bit >= 0; --bit) {
                    const unsigned cand = T | (1u << bit);
                    int cnt = 0;
                    for (int c = 0; c < nch; ++c) {
                        const int s = c * 64 + lane;
                        bool ge = false;
                        if (s < nadm) { const unsigned u = __float_as_uint(sc[s]); const unsigned key = (u & 0x80000000u) ? ~u : (u | 0x80000000u); ge = key >= cand; }
                        cnt += __popcll(__ballot(ge));
                    }
                    if (cnt >= 256) T = cand;
                }
                int ngt = 0;
                for (int c = 0; c < nch; ++c) {
                    const int s = c * 64 + lane;
                    bool gt = false;
                    if (s < nadm) { const unsigned u = __float_as_uint(sc[s]); const unsigned key = (u & 0x80000000u) ? ~u : (u | 0x80000000u); gt = key > T; }
                    ngt += __popcll(__ballot(gt));
                }
                const int rties = 256 - ngt;
                int base = 0, ties = 0;
                const unsigned long long ltmask = (1ull << lane) - 1ull;
                for (int c = 0; c < nch; ++c) {
                    const int s = c * 64 + lane;
                    bool gt = false, eq = false;
                    if (s < nadm) { const unsigned u = __float_as_uint(sc[s]); const unsigned key = (u & 0x80000000u) ? ~u : (u | 0x80000000u); gt = key > T; eq = key == T; }
                    const unsigned long long em = __ballot(eq);
                    const int myrank = ties + __popcll(em & ltmask);
                    const bool take = gt || (eq && myrank < rties);
                    const unsigned long long tm = __ballot(take);
                    const int pos = base + __popcll(tm & ltmask);
                    if (take && pos < 256) sel[pos] = s;
                    base += __popcll(tm); ties += __popcll(em);
                }
                if (lane == 0) s_nsel[q] = 256;
            }
        }
        __syncthreads();
        for (int q = 0; q < QT; ++q) {
            const int nsel = s_nsel[q];
            const int* sel = s_sel + q * 256;
            {
                const int h = tid >> 5, kg = tid & 31;
                const float* qv = s_Q + (q * 16 + h) * 160;
                float mx = -INFINITY;
#pragma unroll 1
                for (int kk = 0; kk < 8; ++kk) {
                    const int ki = kg + kk * 32;
                    float sv = -INFINITY;
                    if (ki < nsel) {
                        const bf16_t* krow = kv + ((size_t)b * TS + sel[ki]) * 160;
                        float d = 0.f;
#pragma unroll 4
                        for (int v8 = 0; v8 < 20; ++v8) {
                            const uint4 u = *(const uint4*)(krow + v8 * 8);
                            const float* qq = qv + v8 * 8;
                            d += qq[0] * __uint_as_float(u.x << 16) + qq[1] * __uint_as_float(u.x & 0xFFFF0000u)
                               + qq[2] * __uint_as_float(u.y << 16) + qq[3] * __uint_as_float(u.y & 0xFFFF0000u)
                               + qq[4] * __uint_as_float(u.z << 16) + qq[5] * __uint_as_float(u.z & 0xFFFF0000u)
                               + qq[6] * __uint_as_float(u.w << 16) + qq[7] * __uint_as_float(u.w & 0xFFFF0000u);
                        }
                        sv = d * scale;
                    }
                    s_p[h * 256 + ki] = sv; mx = fmaxf(mx, sv);
                }
#pragma unroll
                for (int o = 16; o > 0; o >>= 1) mx = fmaxf(mx, __shfl_xor(mx, o));
                float sum = 0.f;
#pragma unroll 1
                for (int kk = 0; kk < 8; ++kk) { const float sv = s_p[h * 256 + kg + kk * 32]; const float e = (sv == -INFINITY) ? 0.f : __expf(sv - mx); s_p[h * 256 + kg + kk * 32] = e; sum += e; }
#pragma unroll
                for (int o = 16; o > 0; o >>= 1) sum += __shfl_xor(sum, o);
                const float inv = 1.0f / sum;
#pragma unroll 1
                for (int kk = 0; kk < 8; ++kk) s_p[h * 256 + kg + kk * 32] *= inv;
            }
            __syncthreads();
            {
                const int h = tid >> 5, c4 = tid & 31;
                float a0_ = 0.f, a1_ = 0.f, a2_ = 0.f, a3_ = 0.f;
                for (int k = 0; k < nsel; ++k) {
                    const float pk = s_p[h * 256 + k];
                    const uint2 u = *(const uint2*)(kv + ((size_t)b * TS + sel[k]) * 160 + c4 * 4);
                    a0_ += pk * __uint_as_float(u.x << 16); a1_ += pk * __uint_as_float(u.x & 0xFFFF0000u);
                    a2_ += pk * __uint_as_float(u.y << 16); a3_ += pk * __uint_as_float(u.y & 0xFFFF0000u);
                }
                float* o = s_ol + h * 128 + c4 * 4;
                o[0] = a0_; o[1] = a1_; o[2] = a2_; o[3] = a3_;
            }
            __syncthreads();
            for (int id = tid; id < 1024; id += NTHR) {
                const int h = id >> 6, v = id & 63;
                float acc = 0.f;
                for (int c = 0; c < 128; ++c) acc += s_ol[h * 128 + c] * w_uv[((size_t)h * 128 + c) * 64 + v];
                yc[(size_t)(n0 + q) * 1024 + id] = f2bf(acc);
            }
            __syncthreads();
        }
    }
}


typedef short s16x4 __attribute__((ext_vector_type(4)));
__device__ __forceinline__ unsigned f2h_bits(float f) { const _Float16 h = (_Float16)f; unsigned short u; __builtin_memcpy(&u, &h, 2); return u; }
template <bool IMPORT_SEL>
__device__ void phase_dsa(const Params& p, int l, unsigned char* lds, bf16_t* yc, const unsigned short* gsel, const int* gnsel, int tb, int te, int tstep) {
    const int tid = otid(), lane = tid & 63, wid = tid >> 6, fr = lane & 15, fq = lane >> 4;
    unsigned short* s_sc = (unsigned short*)lds;
    bf16_t* s_qi = (bf16_t*)(lds + 66048);
    bf16_t* s_Q = (bf16_t*)lds;
    unsigned char* s_Vw = lds + 82432 + wid * 8192;
    bf16_t* s_qn = (bf16_t*)s_Vw;
    unsigned short* s_sel = (unsigned short*)(lds + 82432 + 65536);
    int* s_nsel = (int*)(lds + 82432 + 65536 + 8192);
    unsigned char* dob = OUTB(p);
    const bf16_t* cqn = (const bf16_t*)(dob + DO_CQN);
    const bf16_t* kv = (const bf16_t*)(dob + DO_KV);
    const bf16_t* kidx = (const bf16_t*)(dob + DO_KIDX);
    const float* whead = (const float*)(dob + DO_WHEAD);
    const float* ctab = (const float*)(WS(p) + OFF_ROPE);
    const float* stab = ctab + TS * 16;
    const bf16_t* wb = (const bf16_t*)(WS(p) + OFF_WB);
    const bf16_t* wqiT = wb + WB_QI;
    const bf16_t* wuqT = wb + WB_UQ;
    const bf16_t* wuk = wb + WB_UK;
    const bf16_t* wuvT = wb + WB_UV;
    const float scale = 0.10206207261596575f;
    const f32x4 z4 = {0.f, 0.f, 0.f, 0.f};
    for (int tile = tb; tile < te; tile += tstep) {
        const int qt = 128 - (tile >> 3), b = tile & 7;
        const int t0 = qt * 16;
        const size_t n0 = (size_t)b * TS + t0;
        {
            bf16x8 acq[8];
#pragma unroll
            for (int kk = 0; kk < 8; ++kk) acq[kk] = *(const bf16x8*)(cqn + (n0 + fr) * 256 + kk * 32 + fq * 8);
            f32x4 c[4] = {z4, z4, z4, z4};
#pragma unroll
            for (int kk = 0; kk < 8; ++kk)
#pragma unroll
                for (int nt = 0; nt < 4; ++nt)
                    c[nt] = __builtin_amdgcn_mfma_f32_16x16x32_bf16(acq[kk], *(const bf16x8*)(wqiT + (size_t)(wid * 64 + nt * 16 + fr) * 256 + kk * 32 + fq * 8), c[nt], 0, 0, 0);
#pragma unroll
            for (int j = 0; j < 4; ++j) {
                const int t = t0 + fq * 4 + j;
                const float cs = ctab[t * 16 + fr], sn = stab[t * 16 + fr];
                const float x1 = c[0][j], x2 = c[1][j];
                c[0][j] = x1 * cs - x2 * sn; c[1][j] = x2 * cs + x1 * sn;
            }
#pragma unroll
            for (int nt = 0; nt < 4; ++nt)
#pragma unroll
                for (int j = 0; j < 4; ++j) s_qi[(fq * 4 + j) * 512 + wid * 64 + nt * 16 + fr] = f2bf(c[nt][j]);
        }
        __syncthreads();
        if (!IMPORT_SEL) {
            bf16x8 aq[8][2];
#pragma unroll
            for (int h = 0; h < 8; ++h)
#pragma unroll
                for (int ks = 0; ks < 2; ++ks) aq[h][ks] = *(const bf16x8*)(s_qi + fr * 512 + h * 64 + ks * 32 + fq * 8);
            float wh[4][8];
#pragma unroll
            for (int j = 0; j < 4; ++j) {
                const float4 w0 = *(const float4*)(whead + (n0 + fq * 4 + j) * 8), w1 = *(const float4*)(whead + (n0 + fq * 4 + j) * 8 + 4);
                wh[j][0] = w0.x; wh[j][1] = w0.y; wh[j][2] = w0.z; wh[j][3] = w0.w; wh[j][4] = w1.x; wh[j][5] = w1.y; wh[j][6] = w1.z; wh[j][7] = w1.w;
            }
            const int nkt = qt + 1;
#pragma unroll 1
            for (int kt = wid; kt < nkt; kt += 8) {
                const bf16_t* krow = kidx + ((size_t)b * TS + kt * 16 + fr) * 64 + fq * 8;
                const bf16x8 bk0 = *(const bf16x8*)krow, bk1 = *(const bf16x8*)(krow + 32);
                float I[4] = {0.f, 0.f, 0.f, 0.f};
#pragma unroll
                for (int h = 0; h < 8; ++h) {
                    f32x4 a = __builtin_amdgcn_mfma_f32_16x16x32_bf16(aq[h][0], bk0, z4, 0, 0, 0);
                    a = __builtin_amdgcn_mfma_f32_16x16x32_bf16(aq[h][1], bk1, a, 0, 0, 0);
#pragma unroll
                    for (int j = 0; j < 4; ++j) I[j] += wh[j][h] * fmaxf(a[j], 0.f);
                }
#pragma unroll
                for (int j = 0; j < 4; ++j) s_sc[(fq * 4 + j) * 2064 + kt * 16 + fr] = (unsigned short)f2h_bits(I[j]);
            }
        }
        __syncthreads();
#pragma unroll 1
        for (int qi2 = 0; qi2 < 2; ++qi2) {
            const int q = wid + qi2 * 8;
            const int nadm = t0 + q + 1;
            unsigned short* sel = s_sel + q * 256;
            if (IMPORT_SEL) {
                const int ns = gnsel[n0 + q];
                for (int i = lane; i < ns; i += 64) sel[i] = gsel[(n0 + q) * 256 + i];
                if (lane == 0) s_nsel[q] = ns;
            } else if (nadm <= 256) {
                for (int i = lane; i < nadm; i += 64) sel[i] = (unsigned short)i;
                if (lane == 0) s_nsel[q] = nadm;
            } else {
                unsigned key[33];
#pragma unroll
                for (int c = 0; c < 33; ++c) {
                    const int s = c * 64 + lane;
                    unsigned k = 0u;
                    if (s < nadm) { const unsigned u = s_sc[q * 2064 + s]; k = (u & 0x8000u) ? (~u & 0xFFFFu) : (u | 0x8000u); }
                    key[c] = k;
                }
                unsigned T = 0u;
#pragma unroll 1
                for (int bit = 15; bit >= 0; --bit) {
                    const unsigned cand = T | (1u << bit);
                    int cnt = 0;
#pragma unroll
                    for (int c = 0; c < 33; ++c) cnt += __popcll(__ballot(key[c] >= cand));
                    if (cnt >= 256) T = cand;
                }
                int ngt = 0;
#pragma unroll
                for (int c = 0; c < 33; ++c) ngt += __popcll(__ballot(key[c] > T));
                const int rties = 256 - ngt;
                int base = 0, ties = 0;
                const unsigned long long ltmask = (1ull << lane) - 1ull;
#pragma unroll
                for (int c = 0; c < 33; ++c) {
                    const bool gt = key[c] > T, eq = key[c] == T;
                    const unsigned long long em = __ballot(eq);
                    const int myrank = ties + __popcll(em & ltmask);
                    const bool take = gt || (eq && myrank < rties);
                    const unsigned long long tm = __ballot(take);
                    const int pos = base + __popcll(tm & ltmask);
                    if (take && pos < 256) sel[pos] = (unsigned short)(c * 64 + lane);
                    base += __popcll(tm); ties += __popcll(em);
                }
                if (lane == 0) s_nsel[q] = 256;
            }
        }
        __syncthreads();
#pragma unroll 1
        for (int hi = 0; hi < 2; ++hi) {
            const int hh = wid * 2 + hi;
            bf16x8 acq[8];
#pragma unroll
            for (int kk = 0; kk < 8; ++kk) acq[kk] = *(const bf16x8*)(cqn + (n0 + fr) * 256 + kk * 32 + fq * 8);
            f32x4 c6[6] = {z4, z4, z4, z4, z4, z4};
#pragma unroll
            for (int kk = 0; kk < 8; ++kk)
#pragma unroll
                for (int nt = 0; nt < 6; ++nt)
                    c6[nt] = __builtin_amdgcn_mfma_f32_16x16x32_bf16(acq[kk], *(const bf16x8*)(wuqT + (size_t)(hh * 96 + nt * 16 + fr) * 256 + kk * 32 + fq * 8), c6[nt], 0, 0, 0);
#pragma unroll
            for (int j = 0; j < 4; ++j) {
                const int q = fq * 4 + j, t = t0 + q;
                const float cs = ctab[t * 16 + fr], sn = stab[t * 16 + fr];
                const float x1 = c6[4][j], x2 = c6[5][j];
                s_Q[(q * 16 + hh) * 160 + 128 + fr] = f2bf(x1 * cs - x2 * sn);
                s_Q[(q * 16 + hh) * 160 + 144 + fr] = f2bf(x2 * cs + x1 * sn);
#pragma unroll
                for (int nt = 0; nt < 4; ++nt) s_qn[q * 64 + nt * 16 + fr] = f2bf(c6[nt][j]);
            }
            __syncthreads();
            bf16x8 an[2];
#pragma unroll
            for (int ks = 0; ks < 2; ++ks) an[ks] = *(const bf16x8*)(s_qn + fr * 64 + ks * 32 + fq * 8);
#pragma unroll
            for (int nt = 0; nt < 8; ++nt) {
                f32x4 a = z4;
#pragma unroll
                for (int ks = 0; ks < 2; ++ks)
                    a = __builtin_amdgcn_mfma_f32_16x16x32_bf16(an[ks], *(const bf16x8*)(wuk + (size_t)(hh * 128 + nt * 16 + fr) * 64 + ks * 32 + fq * 8), a, 0, 0, 0);
#pragma unroll
                for (int j = 0; j < 4; ++j) s_Q[((fq * 4 + j) * 16 + hh) * 160 + nt * 16 + fr] = f2bf(a[j]);
            }
            __syncthreads();
        }
#pragma unroll 1
        for (int qi2 = 0; qi2 < 2; ++qi2) {
            const int q = wid + qi2 * 8;
            bf16x8 bq[5];
#pragma unroll
            for (int ks = 0; ks < 5; ++ks) bq[ks] = *(const bf16x8*)(s_Q + (q * 16 + fr) * 160 + ks * 32 + fq * 8);
            const int nsel = s_nsel[q];
            const unsigned short* sel = s_sel + q * 256;
            float m = -INFINITY, lsum = 0.f;
            f32x4 O[8] = {z4, z4, z4, z4, z4, z4, z4, z4};
            const int nchunk = (nsel + 31) >> 5;
#pragma unroll 1
            for (int ch = 0; ch < nchunk; ++ch) {
                bf16x8 ak[2][5];
#pragma unroll
                for (int mt = 0; mt < 2; ++mt) {
                    const int ki = ch * 32 + mt * 16 + fr;
                    const int sidx = sel[ki < nsel ? ki : 0];
                    const bf16_t* krow = kv + ((size_t)b * TS + sidx) * 160 + fq * 8;
#pragma unroll
                    for (int ks = 0; ks < 5; ++ks) ak[mt][ks] = *(const bf16x8*)(krow + ks * 32);
                }
#pragma unroll
                for (int mt = 0; mt < 2; ++mt)
#pragma unroll
                    for (int ks = 0; ks < 4; ++ks) {
                        const int r = mt * 16 + fr;
                        *(bf16x8*)(s_Vw + r * 256 + (((ks * 2 + (fq >> 1)) ^ (r & 7)) * 32) + (fq & 1) * 16) = ak[mt][ks];
                    }
                f32x4 st[2] = {z4, z4};
#pragma unroll
                for (int mt = 0; mt < 2; ++mt)
#pragma unroll
                    for (int ks = 0; ks < 5; ++ks) st[mt] = __builtin_amdgcn_mfma_f32_16x16x32_bf16(ak[mt][ks], bq[ks], st[mt], 0, 0, 0);
                float sv[2][4]; float cmax = -INFINITY;
#pragma unroll
                for (int mt = 0; mt < 2; ++mt)
#pragma unroll
                    for (int j = 0; j < 4; ++j) {
                        const int ke = ch * 32 + mt * 16 + fq * 4 + j;
                        const float s_ = (ke < nsel) ? st[mt][j] * scale : -INFINITY;
                        sv[mt][j] = s_; cmax = fmaxf(cmax, s_);
                    }
                cmax = fmaxf(cmax, __shfl_xor(cmax, 16)); cmax = fmaxf(cmax, __shfl_xor(cmax, 32));
                const float mnew = fmaxf(m, cmax);
                const float alpha = __expf(m - mnew);
                float psum = 0.f;
#pragma unroll
                for (int mt = 0; mt < 2; ++mt)
#pragma unroll
                    for (int j = 0; j < 4; ++j) { const float pe = __expf(sv[mt][j] - mnew); sv[mt][j] = pe; psum += pe; }
                psum += __shfl_xor(psum, 16); psum += __shfl_xor(psum, 32);
                lsum = lsum * alpha + psum; m = mnew;
#pragma unroll
                for (int ct = 0; ct < 8; ++ct) O[ct] = O[ct] * alpha;
                bf16x8 pf;
#pragma unroll
                for (int mt = 0; mt < 2; ++mt)
#pragma unroll
                    for (int j = 0; j < 4; ++j) pf[mt * 4 + j] = (short)f2bf(sv[mt][j]);
                const int q_ = fr >> 2, p_ = fr & 3;
                const int r0 = fq * 4 + q_, r1 = 16 + r0;
#pragma unroll
                for (int ct = 0; ct < 8; ++ct) {
                    const s16x4 v0 = __builtin_amdgcn_ds_read_tr16_b64_v4i16((__attribute__((address_space(3))) s16x4*)(s_Vw + r0 * 256 + ((ct ^ (r0 & 7)) * 32) + p_ * 8));
                    const s16x4 v1 = __builtin_amdgcn_ds_read_tr16_b64_v4i16((__attribute__((address_space(3))) s16x4*)(s_Vw + r1 * 256 + ((ct ^ (r1 & 7)) * 32) + p_ * 8));
                    bf16x8 av; av[0] = v0[0]; av[1] = v0[1]; av[2] = v0[2]; av[3] = v0[3]; av[4] = v1[0]; av[5] = v1[1]; av[6] = v1[2]; av[7] = v1[3];
                    O[ct] = __builtin_amdgcn_mfma_f32_16x16x32_bf16(av, pf, O[ct], 0, 0, 0);
                }
            }
            const float inv = 1.0f / lsum;
#pragma unroll
            for (int ct = 0; ct < 8; ++ct)
#pragma unroll
                for (int j = 0; j < 4; ++j) s_Q[(q * 16 + fr) * 160 + ct * 16 + fq * 4 + j] = f2bf(O[ct][j] * inv);
        }
        __syncthreads();
#pragma unroll 1
        for (int hi = 0; hi < 2; ++hi) {
            const int hh = wid * 2 + hi;
            bf16x8 ao[4];
#pragma unroll
            for (int ks = 0; ks < 4; ++ks) ao[ks] = *(const bf16x8*)(s_Q + (fr * 16 + hh) * 160 + ks * 32 + fq * 8);
#pragma unroll
            for (int nt = 0; nt < 4; ++nt) {
                f32x4 a = z4;
#pragma unroll
                for (int ks = 0; ks < 4; ++ks)
                    a = __builtin_amdgcn_mfma_f32_16x16x32_bf16(ao[ks], *(const bf16x8*)(wuvT + (size_t)(hh * 64 + nt * 16 + fr) * 128 + ks * 32 + fq * 8), a, 0, 0, 0);
#pragma unroll
                for (int j = 0; j < 4; ++j) yc[(n0 + fq * 4 + j) * 1024 + hh * 64 + nt * 16 + fr] = f2bf(a[j]);
            }
        }
        __syncthreads();
    }
}


template <int CTRL> __device__ __forceinline__ float dpp_f(float x) {
    return __int_as_float(__builtin_amdgcn_update_dpp(0, __float_as_int(x), CTRL, 0xF, 0xF, true));
}
__device__ __forceinline__ float row16_sum(float v) {
    v += dpp_f<0xB1>(v);
    v += dpp_f<0x4E>(v);
    v += dpp_f<0x141>(v);
    v += dpp_f<0x140>(v);
    return v;
}
__device__ __forceinline__ void lds_barrier() { asm volatile("s_waitcnt lgkmcnt(0)" ::: "memory"); __builtin_amdgcn_s_barrier(); asm volatile("" ::: "memory"); }
__device__ __forceinline__ float fast_rcp(float x) { return __builtin_amdgcn_rcpf(x); }
__device__ __forceinline__ float fast_sigmoid(float x) { return fast_rcp(1.0f + __expf(-x)); }
__device__ __forceinline__ float fast_tanh(float x) { return 1.0f - 2.0f * fast_rcp(1.0f + __expf(2.0f * x)); }
__device__ __forceinline__ void row16_sum4(float& a, float& b, float& c, float& d) {
    asm volatile(
        "s_nop 1\n\t"
        "v_add_f32_dpp %0, %0, %0 quad_perm:[1,0,3,2] row_mask:0xf bank_mask:0xf\n\t"
        "v_add_f32_dpp %1, %1, %1 quad_perm:[1,0,3,2] row_mask:0xf bank_mask:0xf\n\t"
        "v_add_f32_dpp %2, %2, %2 quad_perm:[1,0,3,2] row_mask:0xf bank_mask:0xf\n\t"
        "v_add_f32_dpp %3, %3, %3 quad_perm:[1,0,3,2] row_mask:0xf bank_mask:0xf\n\t"
        "v_add_f32_dpp %0, %0, %0 quad_perm:[2,3,0,1] row_mask:0xf bank_mask:0xf\n\t"
        "v_add_f32_dpp %1, %1, %1 quad_perm:[2,3,0,1] row_mask:0xf bank_mask:0xf\n\t"
        "v_add_f32_dpp %2, %2, %2 quad_perm:[2,3,0,1] row_mask:0xf bank_mask:0xf\n\t"
        "v_add_f32_dpp %3, %3, %3 quad_perm:[2,3,0,1] row_mask:0xf bank_mask:0xf\n\t"
        "v_add_f32_dpp %0, %0, %0 row_half_mirror row_mask:0xf bank_mask:0xf\n\t"
        "v_add_f32_dpp %1, %1, %1 row_half_mirror row_mask:0xf bank_mask:0xf\n\t"
        "v_add_f32_dpp %2, %2, %2 row_half_mirror row_mask:0xf bank_mask:0xf\n\t"
        "v_add_f32_dpp %3, %3, %3 row_half_mirror row_mask:0xf bank_mask:0xf\n\t"
        "v_add_f32_dpp %0, %0, %0 row_mirror row_mask:0xf bank_mask:0xf\n\t"
        "v_add_f32_dpp %1, %1, %1 row_mirror row_mask:0xf bank_mask:0xf\n\t"
        "v_add_f32_dpp %2, %2, %2 row_mirror row_mask:0xf bank_mask:0xf\n\t"
        "v_add_f32_dpp %3, %3, %3 row_mirror row_mask:0xf bank_mask:0xf\n\t"
        "s_nop 1"
        : "+v"(a), "+v"(b), "+v"(c), "+v"(d));
}
__device__ __forceinline__ float wave_sum_fast(float v) { v = row16_sum(v); v += __shfl_xor(v, 16); v += __shfl_xor(v, 32); return v; }
constexpr int SC_TC = 32;
constexpr int SC_ROWB = 1088;
__device__ __forceinline__ const unsigned char* scan_piece_src(const Params& p, int l, int b, int hc, int t0, int pi, bool& ok) {
    const int tau = pi / 68, seg = pi - tau * 68;
    const int t = t0 + tau;
    ok = (t < TS) && (tau < SC_TC);
    const size_t n = (size_t)b * TS + t;
    const unsigned char* ws = WS(p);
    if (seg < 8) return ws + OFF_PR + (n * 1024 + hc) * 2 + seg * 16;
    if (seg < 16) return ws + OFF_PK + (n * 1024 + hc) * 2 + (seg - 8) * 16;
    if (seg < 24) return ws + OFF_PV + (n * 1024 + hc) * 2 + (seg - 16) * 16;
    if (seg < 60) return ws + OFF_PMISC + (n * PM_LD) * 2 + (seg - 24) * 16;
    ok = ok && (l > 0);
    return ws + OFF_VFIRST + (n * 1024 + hc) * 2 + (seg - 60) * 16;
}
__device__ void phase_scan3(const Params& p, int l, unsigned char* lds, int blk) {
    const int tid = otid(), lane = tid & 63, wid = tid >> 6, fr = lane & 15, fq = lane >> 4;
    const int b = blk >> 4, hh = blk & 15, hc = hh * 64;
    float* s_r = (float*)lds;
    float* s_w = s_r + 2048;
    float* s_k = s_w + 2048;
    float* s_v = s_k + 2048;
    float* s_a = s_v + 2048;
    float* s_b = s_a + 2048;
    float* s_g = s_b + 2048;
    float* s_o = s_g + 2048;
    bf16_t* A_wd = (bf16_t*)(s_o + 2048);
    bf16_t* A_ad = A_wd + 2048;
    bf16_t* A_gd = A_ad + 2048;
    bf16_t* A_vd = A_gd + 4096;
    unsigned char* raw = (unsigned char*)(A_vd + 1024);
    float* prevb = (float*)(raw + 32 * SC_ROWB);
    float* cst = prevb + 960;
    const float* mu = p.in[4] + (size_t)l * 3328;
    for (int e = tid; e < 480; e += NTHR) {
        float v;
        if (e < 192) v = mu[(e >> 6) * 1024 + hc + (e & 63)];
        else if (e < 448) v = mu[3072 + (e - 192)];
        else v = p.in[18][e - 448];
        cst[e] = v;
    }
    if (tid < 64) {
        cst[480 + tid] = p.in[7][l * 1024 + hc + tid];
        cst[544 + tid] = p.in[9][l * 1024 + hc + tid];
        cst[608 + tid] = p.in[12][l * 1024 + hc + tid];
        cst[672 + tid] = p.in[13][l * 1024 + hc + tid];
        cst[736 + tid] = p.in[14][l * 1024 + hc + tid];
        cst[800 + tid] = p.in[15][l * 1024 + hc + tid];
        cst[864 + tid] = p.in[16][l * 1024 + hc + tid];
        cst[928 + tid] = p.in[19][hc + tid];
    }
    const int mm = wid >> 1, ntb = (wid & 1) * 2;
    const int nks = (mm == 2) ? 4 : (mm == 3 ? 1 : 2);
    bf16x8 Bw[2][4];
    {
        const float* wsrc = (mm == 0) ? p.in[8] + (size_t)l * 64 * 1024 : (mm == 1) ? p.in[10] + (size_t)l * 64 * 1024 : (mm == 2) ? p.in[11] + (size_t)l * 128 * 1024 : p.in[20];
#pragma unroll
        for (int n2 = 0; n2 < 2; ++n2)
#pragma unroll
            for (int ks = 0; ks < 4; ++ks) {
                bf16x8 f;
#pragma unroll
                for (int j = 0; j < 8; ++j) {
                    float v = 0.f;
                    if (ks < nks && (mm < 3 || l > 0)) v = wsrc[(size_t)(ks * 32 + fq * 8 + j) * 1024 + hc + (ntb + n2) * 16 + fr];
                    f[j] = (short)f2bf(v);
                }
                Bw[n2][ks] = f;
            }
    }
    const int cg = lane & 15, rg = lane >> 4;
    float S0[4] = {0.f, 0.f, 0.f, 0.f}, S1[4] = {0.f, 0.f, 0.f, 0.f};
    bf16_t* Pr = (bf16_t*)(WS(p) + OFF_PR);
    bf16_t* vfirst = (bf16_t*)(WS(p) + OFF_VFIRST);
    float prevraw = 0.f;
    uint4 pre[5];
#pragma unroll
    for (int k = 0; k < 5; ++k) {
        const int pi = tid + k * NTHR; bool ok = false; pre[k] = make_uint4(0, 0, 0, 0);
        if (pi < SC_TC * 68) { const unsigned char* src = scan_piece_src(p, l, b, hc, 0, pi, ok); if (ok) pre[k] = *(const uint4*)src; }
    }
    __syncthreads();
#pragma unroll 1
    for (int t0 = 0, ch = 0; t0 < TS; t0 += SC_TC, ++ch) {
        const int nval = (TS - t0 < SC_TC) ? (TS - t0) : SC_TC;
#pragma unroll
        for (int k = 0; k < 5; ++k) { const int pi = tid + k * NTHR; if (pi < SC_TC * 68) *(uint4*)(raw + pi * 16) = pre[k]; }
        lds_barrier();
#pragma unroll
        for (int k = 0; k < 5; ++k) {
            const int pi = tid + k * NTHR; bool ok = false; pre[k] = make_uint4(0, 0, 0, 0);
            if (pi < SC_TC * 68 && t0 + SC_TC < TS) { const unsigned char* src = scan_piece_src(p, l, b, hc, t0 + SC_TC, pi, ok); if (ok) pre[k] = *(const uint4*)src; }
        }
        if (tid < 480) {
            const int c = tid;
            const float muc = cst[c];
#pragma unroll 4
            for (int tau = 0; tau < SC_TC; ++tau) {
                const float cur = bf2f(*(const bf16_t*)(raw + tau * SC_ROWB + c * 2));
                const float xs = cur + (prevraw - cur) * muc;
                prevraw = cur;
                if (wid == 0) s_r[tau * 64 + c] = xs;
                else if (wid == 1) s_k[tau * 64 + c - 64] = xs;
                else if (wid == 2) s_v[tau * 64 + c - 128] = xs;
                else if (wid == 3) A_wd[tau * 64 + c - 192] = f2bf(fast_tanh(xs));
                else if (wid == 4) A_ad[tau * 64 + c - 256] = f2bf(xs);
                else if (wid < 7) A_gd[tau * 128 + c - 320] = f2bf(fast_sigmoid(xs));
                else A_vd[tau * 32 + c - 448] = f2bf(xs);
            }
        }
        lds_barrier();
        if (mm < 3 || l > 0) {
            const bf16_t* Ab = (mm == 0) ? A_wd : (mm == 1) ? A_ad : (mm == 2) ? A_gd : A_vd;
            const int lda = (mm == 2) ? 128 : (mm == 3 ? 32 : 64);
            float* dst = (mm == 0) ? s_w : (mm == 1) ? s_a : (mm == 2) ? s_g : s_o;
#pragma unroll
            for (int m = 0; m < 2; ++m) {
                f32x4 acc0 = {0.f, 0.f, 0.f, 0.f}, acc1 = {0.f, 0.f, 0.f, 0.f};
#pragma unroll
                for (int ks = 0; ks < 4; ++ks) {
                    if (ks < nks) {
                        const bf16x8 a = *(const bf16x8*)(Ab + (m * 16 + fr) * lda + ks * 32 + fq * 8);
                        acc0 = __builtin_amdgcn_mfma_f32_16x16x32_bf16(a, Bw[0][ks], acc0, 0, 0, 0);
                        acc1 = __builtin_amdgcn_mfma_f32_16x16x32_bf16(a, Bw[1][ks], acc1, 0, 0, 0);
                    }
                }
#pragma unroll
                for (int j = 0; j < 4; ++j) {
                    dst[(m * 16 + fq * 4 + j) * 64 + ntb * 16 + fr] = acc0[j];
                    dst[(m * 16 + fq * 4 + j) * 64 + (ntb + 1) * 16 + fr] = acc1[j];
                }
            }
        }
        lds_barrier();
        for (int e = tid; e < SC_TC * 64; e += NTHR) {
            const int tau = e >> 6, c = e & 63, t = t0 + tau;
            const size_t n = (size_t)b * TS + t;
            const float xw = s_w[e] + cst[480 + c];
            const float decay = __expf(-0.6065306597126334f * fast_sigmoid(xw));
            const float a = fast_sigmoid(s_a[e] + cst[544 + c]);
            float vv = s_v[e];
            if (l > 0) {
                const float vf = bf2f(*(const bf16_t*)(raw + tau * SC_ROWB + 960 + c * 2));
                vv = vv + (vf - vv) * fast_sigmoid(s_o[e] + cst[928 + c]);
            } else if (t < TS) {
                vfirst[n * 1024 + hc + c] = f2bf(vv);
            }
            const float kraw = s_k[e];
            const float kkv = kraw * cst[608 + c];
            const float ss = wave_sum_fast(kkv * kkv);
            const float kk = kkv * rsqrtf(fmaxf(ss, 1e-24f));
            s_w[e] = decay;
            s_a[e] = -kk;
            s_b[e] = kk * a;
            s_k[e] = kraw * (1.0f + (a - 1.0f) * cst[672 + c]);
            s_v[e] = vv;
        }
        lds_barrier();
        {
            float4 a4 = *(const float4*)(s_a + cg * 4);
            float sa0 = S0[0] * a4.x + S0[1] * a4.y + S0[2] * a4.z + S0[3] * a4.w;
            float sa1 = S1[0] * a4.x + S1[1] * a4.y + S1[2] * a4.z + S1[3] * a4.w;
            float du0 = 0.f, du1 = 0.f;
            row16_sum4(sa0, sa1, du0, du1);
            float4 w4 = *(const float4*)(s_w + cg * 4);
            float4 b4 = *(const float4*)(s_b + cg * 4);
            float4 k4 = *(const float4*)(s_k + cg * 4);
            float4 r4 = *(const float4*)(s_r + cg * 4);
            float2 v2 = *(const float2*)(s_v + wid * 8 + rg * 2);
#pragma unroll 1
            for (int tau = 0; tau < nval; ++tau) {
                const int tn = (tau + 1 < SC_TC) ? tau + 1 : tau;
                const float4 na4 = *(const float4*)(s_a + tn * 64 + cg * 4);
                const float4 nw4 = *(const float4*)(s_w + tn * 64 + cg * 4);
                const float4 nb4 = *(const float4*)(s_b + tn * 64 + cg * 4);
                const float4 nk4 = *(const float4*)(s_k + tn * 64 + cg * 4);
                const float4 nr4 = *(const float4*)(s_r + tn * 64 + cg * 4);
                const float2 nv2 = *(const float2*)(s_v + tn * 64 + wid * 8 + rg * 2);
                S0[0] = S0[0] * w4.x + (sa0 * b4.x + v2.x * k4.x); S0[1] = S0[1] * w4.y + (sa0 * b4.y + v2.x * k4.y);
                S0[2] = S0[2] * w4.z + (sa0 * b4.z + v2.x * k4.z); S0[3] = S0[3] * w4.w + (sa0 * b4.w + v2.x * k4.w);
                S1[0] = S1[0] * w4.x + (sa1 * b4.x + v2.y * k4.x); S1[1] = S1[1] * w4.y + (sa1 * b4.y + v2.y * k4.y);
                S1[2] = S1[2] * w4.z + (sa1 * b4.z + v2.y * k4.z); S1[3] = S1[3] * w4.w + (sa1 * b4.w + v2.y * k4.w);
                float o0 = S0[0] * r4.x + S0[1] * r4.y + S0[2] * r4.z + S0[3] * r4.w;
                float o1 = S1[0] * r4.x + S1[1] * r4.y + S1[2] * r4.z + S1[3] * r4.w;
                sa0 = S0[0] * na4.x + S0[1] * na4.y + S0[2] * na4.z + S0[3] * na4.w;
                sa1 = S1[0] * na4.x + S1[1] * na4.y + S1[2] * na4.z + S1[3] * na4.w;
                row16_sum4(sa0, sa1, o0, o1);
                if (cg == 0) *(float2*)(s_o + tau * 64 + wid * 8 + rg * 2) = make_float2(o0, o1);
                w4 = nw4; b4 = nb4; k4 = nk4; r4 = nr4; v2 = nv2;
            }
        }
        lds_barrier();
        for (int tau = wid; tau < nval; tau += 8) {
            const int c = lane, e = tau * 64 + c;
            const size_t n = (size_t)b * TS + t0 + tau;
            const float o = s_o[e];
            const float m_ = wave_sum_fast(o) * (1.0f / 64.0f);
            const float d = o - m_;
            const float var = wave_sum_fast(d * d) * (1.0f / 64.0f);
            const float on = d * rsqrtf(var + 64e-5f) * cst[800 + c] + cst[864 + c];
            const float bonus = wave_sum_fast(s_r[e] * s_k[e] * cst[736 + c]) * s_v[e];
            Pr[n * 1024 + hc + c] = f2bf((on + bonus) * s_g[e]);
        }
        lds_barrier();
    }
}

__device__ void phase_merge(const Params& p, unsigned char* lds) {
    const int tid = otid(), lane = tid & 63, wid = tid >> 6, wr = wid >> 1, wc = wid & 1, fr = lane & 15, fq = lane >> 4;
    const bf16_t* h = (const bf16_t*)(WS(p) + OFF_H);
    const bf16_t* wb = (const bf16_t*)(WS(p) + OFF_WB);
    const float* rstd = (const float*)(WS(p) + OFF_RSTD);
    bf16_t* merged = (bf16_t*)(WS(p) + OFF_MERGED);
    const bf16_t* ysrc0 = (const bf16_t*)(WS(p) + OFF_PPOOL);
    const bf16_t* ysrc1 = (const bf16_t*)(WS(p) + OFF_PR);
    const bf16_t* ysrc2 = (const bf16_t*)(OUTB(p) + DO_YC);
    for (int tile = obid(); tile < 129 * 8; tile += gridDim.x) {
        const int mt = tile >> 3, nt = tile & 7;
        const int row0 = mt * 128, col0 = nt * 128;
        f32x4 macc[2][4]; g3_zero<2>(macc);
#pragma unroll 1
        for (int i = 0; i < 3; ++i) {
            f32x4 ag[2][4], ay[2][4]; g3_zero<2>(ag); g3_zero<2>(ay);
            const bf16_t* ys = (i == 0) ? ysrc0 : (i == 1 ? ysrc1 : ysrc2);
            G3<128> g;
            g3_setup<128>(g, [&](int r) { return h + (size_t)(row0 + r) * DM; }, [&](int r) { return wb + WB_WG + (size_t)(i * 1024 + col0 + r) * DM; }, tid);
            g3_kloop<128>(ag, g, DM, lds);
            g3_setup<128>(g, [&](int r) { return ys + (size_t)(row0 + r) * DM; }, [&](int r) { return wb + WB_PA + (size_t)(i * 1024 + col0 + r) * DM; }, tid);
            g3_kloop<128>(ay, g, DM, lds);
#pragma unroll
            for (int m = 0; m < 2; ++m) {
                const float rs = rstd[row0 + wr * 32 + m * 16 + fr];
#pragma unroll
                for (int n = 0; n < 4; ++n)
#pragma unroll
                    for (int j = 0; j < 4; ++j) macc[m][n][j] += sigmoidf_(ag[m][n][j] * rs) * ay[m][n][j];
            }
        }
#pragma unroll
        for (int m = 0; m < 2; ++m) {
            const int row = row0 + wr * 32 + m * 16 + fr;
#pragma unroll
            for (int n = 0; n < 4; ++n)
                *(uint2*)(merged + (size_t)row * 1024 + col0 + wc * 64 + n * 16 + fq * 4) = pack4(macc[m][n][0], macc[m][n][1], macc[m][n][2], macc[m][n][3]);
        }
    }
}

__device__ void phase_outproj(const Params& p, unsigned char* lds) {
    const int tid = otid(), lane = tid & 63, wid = tid >> 6, wr = wid >> 1, wc = wid & 1, fr = lane & 15, fq = lane >> 4;
    const bf16_t* h = (const bf16_t*)(WS(p) + OFF_H);
    const bf16_t* wb = (const bf16_t*)(WS(p) + OFF_WB);
    const bf16_t* merged = (const bf16_t*)(WS(p) + OFF_MERGED);
    float* hm = (float*)(WS(p) + OFF_HM32);
    for (int tile = obid(); tile < 129 * 8; tile += gridDim.x) {
        const int mt = tile >> 3, nt = tile & 7;
        const int row0 = mt * 128, col0 = nt * 128;
        G3<128> g;
        g3_setup<128>(g, [&](int r) { return merged + (size_t)(row0 + r) * DM; }, [&](int r) { return wb + WB_WO + (size_t)(col0 + r) * DM; }, tid);
        f32x4 acc[2][4]; g3_zero<2>(acc);
        g3_kloop<128>(acc, g, DM, lds);
#pragma unroll
        for (int m = 0; m < 2; ++m) {
            const int row = row0 + wr * 32 + m * 16 + fr;
#pragma unroll
            for (int n = 0; n < 4; ++n) {
                const int col = col0 + wc * 64 + n * 16 + fq * 4;
                const uint2 hv = *(const uint2*)(h + (size_t)row * 1024 + col);
                float4 o;
                o.x = __uint_as_float(hv.x << 16) + acc[m][n][0]; o.y = __uint_as_float(hv.x & 0xFFFF0000u) + acc[m][n][1];
                o.z = __uint_as_float(hv.y << 16) + acc[m][n][2]; o.w = __uint_as_float(hv.y & 0xFFFF0000u) + acc[m][n][3];
                *(float4*)(hm + (size_t)row * 1024 + col) = o;
            }
        }
    }
}

__device__ __constant__ int c_pair_lo[6] = {0, 0, 0, 1, 1, 2};
__device__ __constant__ int c_pair_hi[6] = {1, 2, 3, 2, 3, 3};
__device__ void phase_route(const Params& p, int l) {
    const int lane = otid() & 63;
    const int wave = (obid() * NTHR + otid()) >> 6, nw = gridDim.x * NTHR / 64;
    const float* hm = (const float*)(WS(p) + OFF_HM32);
    bf16_t* hn = (bf16_t*)(WS(p) + OFF_HN);
    const float* nf = p.in[33] + (size_t)l * 1024;
    const float* wg = p.in[34] + (size_t)l * 1024 * 4;
    const float* bg = p.in[35] + l * 4;
    const float* we = p.in[36] + (size_t)l * 1024 * 16;
    const float* be = p.in[37] + l * 16;
    int* cnt = (int*)(WS(p) + OFF_CTL);
    int* list = (int*)(WS(p) + OFF_LIST);
    float* pw = (float*)(WS(p) + OFF_PW);
    for (int n = wave; n < NT; n += nw) {
        float ss = 0.f;
#pragma unroll
        for (int i = 0; i < 4; ++i) {
            const float4 v = *(const float4*)(hm + (size_t)n * DM + i * 256 + lane * 4);
            ss += v.x * v.x + v.y * v.y + v.z * v.z + v.w * v.w;
        }
        ss = wave_sum(ss);
        const float rs = rsqrtf(ss * (1.0f / 1024.0f) + 1e-6f);
        float lg[4] = {0.f, 0.f, 0.f, 0.f};
        float le[16];
#pragma unroll
        for (int e = 0; e < 16; ++e) le[e] = 0.f;
#pragma unroll 1
        for (int i = 0; i < 4; ++i) {
            const float4 xv = *(const float4*)(hm + (size_t)n * DM + i * 256 + lane * 4);
            const float4 nv = *(const float4*)(nf + i * 256 + lane * 4);
            float y[4] = {xv.x * rs * nv.x, xv.y * rs * nv.y, xv.z * rs * nv.z, xv.w * rs * nv.w};
#pragma unroll
            for (int k = 0; k < 4; ++k) {
                const int d = i * 256 + lane * 4 + k;
                const float4 g4 = *(const float4*)(wg + (size_t)d * 4);
                lg[0] += y[k] * g4.x; lg[1] += y[k] * g4.y; lg[2] += y[k] * g4.z; lg[3] += y[k] * g4.w;
#pragma unroll
                for (int e4 = 0; e4 < 4; ++e4) {
                    const float4 w4 = *(const float4*)(we + (size_t)d * 16 + e4 * 4);
                    le[e4 * 4 + 0] += y[k] * w4.x; le[e4 * 4 + 1] += y[k] * w4.y; le[e4 * 4 + 2] += y[k] * w4.z; le[e4 * 4 + 3] += y[k] * w4.w;
                }
            }
            ushort4 o;
            o.x = f2bf(y[0]); o.y = f2bf(y[1]); o.z = f2bf(y[2]); o.w = f2bf(y[3]);
            *(ushort4*)(hn + (size_t)n * DM + i * 256 + lane * 4) = o;
        }
#pragma unroll
        for (int g = 0; g < 4; ++g) lg[g] = wave_sum(lg[g]) + bg[g];
#pragma unroll
        for (int e = 0; e < 16; ++e) le[e] = wave_sum(le[e]) + be[e];
        if (lane == 0) {
            int gs = 0; float gm = lg[0];
#pragma unroll
            for (int g = 1; g < 4; ++g) if (lg[g] > gm) { gm = lg[g]; gs = g; }
            float den = 0.f;
#pragma unroll
            for (int g = 0; g < 4; ++g) den += __expf(lg[g] - gm);
            const float pgrp = 1.0f / den;
            float v4[4];
#pragma unroll
            for (int e = 0; e < 4; ++e) {
                const float m0 = (gs == 0) ? 1.f : 0.f, m1s = (gs == 1) ? 1.f : 0.f, m2s = (gs == 2) ? 1.f : 0.f, m3s = (gs == 3) ? 1.f : 0.f;
                v4[e] = le[e] * m0 + le[4 + e] * m1s + le[8 + e] * m2s + le[12 + e] * m3s;
            }
            int i1 = 0; float m1 = v4[0];
#pragma unroll
            for (int e = 1; e < 4; ++e) if (v4[e] > m1) { m1 = v4[e]; i1 = e; }
            int i2 = -1; float m2 = -INFINITY;
#pragma unroll
            for (int e = 0; e < 4; ++e) if (e != i1 && v4[e] > m2) { m2 = v4[e]; i2 = e; }
            const float e2 = __expf(m2 - m1);
            const float p1 = pgrp / (1.0f + e2), p2 = pgrp * e2 / (1.0f + e2);
            const int lo = i1 < i2 ? i1 : i2, hi = i1 < i2 ? i2 : i1;
            const float plo = i1 < i2 ? p1 : p2, phi = i1 < i2 ? p2 : p1;
            const int pi = (lo == 0) ? (hi - 1) : (lo == 1 ? hi + 1 : 5);
            const int cls = gs * 6 + pi;
            const int pos = atomicAdd(&cnt[cls], 1);
            list[(size_t)cls * NT + pos] = n;
            pw[(size_t)n * 2 + 0] = plo; pw[(size_t)n * 2 + 1] = phi;
        }
    }
}

struct MoeTile { int cls, ti, cnt, tg; };
__device__ __forceinline__ int moe_total_tiles(const int* cnt) { int s = 0; for (int c = 0; c < 24; ++c) s += (cnt[c] + 127) >> 7; return s; }
__device__ __forceinline__ MoeTile moe_find(const int* cnt, int tile) {
    MoeTile r; int s = 0; r.cls = 0; r.ti = 0; r.cnt = 0; r.tg = tile;
    for (int c = 0; c < 24; ++c) { const int nt = (cnt[c] + 127) >> 7; if (tile >= s && tile < s + nt) { r.cls = c; r.ti = tile - s; r.cnt = cnt[c]; } s += nt; }
    return r;
}
__device__ void phase_moe1(const Params& p, unsigned char* lds) {
    const int tid = otid(), lane = tid & 63, wid = tid >> 6, wr = wid >> 1, wc = wid & 1, fr = lane & 15, fq = lane >> 4;
    const int* cnt = (const int*)(WS(p) + OFF_CTL);
    const int* list = (const int*)(WS(p) + OFF_LIST);
    const float* pw = (const float*)(WS(p) + OFF_PW);
    const bf16_t* hn = (const bf16_t*)(WS(p) + OFF_HN);
    const bf16_t* we = (const bf16_t*)(WS(p) + OFF_WEXP);
    bf16_t* hid = (bf16_t*)(OUTB(p) + DO_HID);
    const int total = moe_total_tiles(cnt);
    for (int item = obid(); item < total * 4; item += gridDim.x) {
        const MoeTile mt = moe_find(cnt, item >> 2);
        const int nt = item & 3, slot = nt >> 1, f0 = (nt & 1) * 128;
        const int g_ = mt.cls / 6, pi = mt.cls % 6;
        const int e = g_ * 4 + (slot == 0 ? c_pair_lo[pi] : c_pair_hi[pi]);
        const int* lst = list + (size_t)mt.cls * NT + mt.ti * 128;
        const int nvalid = min(128, mt.cnt - mt.ti * 128);
        f32x4 a1[2][4], a3[2][4]; g3_zero<2>(a1); g3_zero<2>(a3);
        G3<128> g;
        g3_setup<128>(g, [&](int r) { return hn + (size_t)lst[r < nvalid ? r : 0] * DM; }, [&](int r) { return we + WE_W1 + ((size_t)e * 256 + f0 + r) * 1024; }, tid);
        g3_kloop<128>(a1, g, DM, lds);
        g3_setup<128>(g, [&](int r) { return hn + (size_t)lst[r < nvalid ? r : 0] * DM; }, [&](int r) { return we + WE_W3 + ((size_t)e * 256 + f0 + r) * 1024; }, tid);
        g3_kloop<128>(a3, g, DM, lds);
#pragma unroll
        for (int m = 0; m < 2; ++m) {
            const int lr = wr * 32 + m * 16 + fr;
            const int tk = lst[lr < nvalid ? lr : 0];
            const float pe = pw[(size_t)tk * 2 + slot];
#pragma unroll
            for (int n = 0; n < 4; ++n) {
                const int col = slot * 256 + f0 + wc * 64 + n * 16 + fq * 4;
                float o[4];
#pragma unroll
                for (int j = 0; j < 4; ++j) { const float x1 = a1[m][n][j]; o[j] = x1 * sigmoidf_(x1) * a3[m][n][j] * pe; }
                *(uint2*)(hid + ((size_t)mt.tg * 128 + lr) * 512 + col) = pack4(o[0], o[1], o[2], o[3]);
            }
        }
    }
}
__device__ void phase_moe2(const Params& p, unsigned char* lds) {
    const int tid = otid(), lane = tid & 63, wid = tid >> 6, wr = wid >> 1, wc = wid & 1, fr = lane & 15, fq = lane >> 4;
    const int* cnt = (const int*)(WS(p) + OFF_CTL);
    const int* list = (const int*)(WS(p) + OFF_LIST);
    const bf16_t* we = (const bf16_t*)(WS(p) + OFF_WEXP);
    const bf16_t* hid = (const bf16_t*)(OUTB(p) + DO_HID);
    float* hm = (float*)(WS(p) + OFF_HM32);
    bf16_t* h = (bf16_t*)(WS(p) + OFF_H);
    const int total = moe_total_tiles(cnt);
    for (int item = obid(); item < total * 8; item += gridDim.x) {
        const MoeTile mt = moe_find(cnt, item >> 3);
        const int nt = item & 7, col0 = nt * 128;
        const int g_ = mt.cls / 6, pi = mt.cls % 6;
        const int elo = g_ * 4 + c_pair_lo[pi], ehi = g_ * 4 + c_pair_hi[pi];
        const int* lst = list + (size_t)mt.cls * NT + mt.ti * 128;
        const int nvalid = min(128, mt.cnt - mt.ti * 128);
        f32x4 acc[2][4]; g3_zero<2>(acc);
        G3<128> g;
        g3_setup<128>(g, [&](int r) { return hid + ((size_t)mt.tg * 128 + r) * 512; }, [&](int r) { return we + WE_W2 + ((size_t)elo * 1024 + col0 + r) * 256; }, tid);
        g3_kloop<128>(acc, g, 256, lds);
        g3_setup<128>(g, [&](int r) { return hid + ((size_t)mt.tg * 128 + r) * 512 + 256; }, [&](int r) { return we + WE_W2 + ((size_t)ehi * 1024 + col0 + r) * 256; }, tid);
        g3_kloop<128>(acc, g, 256, lds);
#pragma unroll
        for (int m = 0; m < 2; ++m) {
            const int lr = wr * 32 + m * 16 + fr;
            if (lr < nvalid) {
                const int tk = lst[lr];
#pragma unroll
                for (int n = 0; n < 4; ++n) {
                    const int col = col0 + wc * 64 + n * 16 + fq * 4;
                    float4 v = *(const float4*)(hm + (size_t)tk * 1024 + col);
                    v.x += acc[m][n][0]; v.y += acc[m][n][1]; v.z += acc[m][n][2]; v.w += acc[m][n][3];
                    *(float4*)(hm + (size_t)tk * 1024 + col) = v;
                    *(uint2*)(h + (size_t)tk * 1024 + col) = pack4(v.x, v.y, v.z, v.w);
                }
            }
        }
    }
}

__device__ void phase_final(const Params& p) {
    const int lane = otid() & 63;
    const int wave = (obid() * NTHR + otid()) >> 6, nw = gridDim.x * NTHR / 64;
    const float* hm = (const float*)(WS(p) + OFF_HM32);
    const float* nf = p.in[41];
    for (int r = wave; r < NB * SEQ; r += nw) {
        const int b = r / SEQ, s = r % SEQ;
        const size_t n = (size_t)b * TS + NMETA + s;
        float4 v[4]; float ss = 0.f;
#pragma unroll
        for (int i = 0; i < 4; ++i) { v[i] = *(const float4*)(hm + n * DM + i * 256 + lane * 4); ss += v[i].x * v[i].x + v[i].y * v[i].y + v[i].z * v[i].z + v[i].w * v[i].w; }
        ss = wave_sum(ss);
        const float rs = rsqrtf(ss * (1.0f / 1024.0f) + 1e-6f);
#pragma unroll
        for (int i = 0; i < 4; ++i) {
            const float4 g = *(const float4*)(nf + i * 256 + lane * 4);
            float4 o; o.x = v[i].x * rs * g.x; o.y = v[i].y * rs * g.y; o.z = v[i].z * rs * g.z; o.w = v[i].w * rs * g.w;
            *(float4*)((float*)OUTB(p) + (size_t)r * DM + i * 256 + lane * 4) = o;
        }
    }
}


#define XB_TMO      128
#define XB_XCNT(j)  (256  + 64 * (j))
#define XB_XSUB(j)  (1280 + 64 * (j))
#define XB_XGEN(j)  (2304 + 64 * (j))
#define XB_TOP      3328
#define XB_TOPGEN   3392
#define XCD_BAR_WORDS 3456
#define XB_SPIN_CAP (1u << 22)
#define LAS __attribute__((address_space(3)))
__device__ __forceinline__ unsigned xb_ld(unsigned* p) { return __hip_atomic_load(p, __ATOMIC_RELAXED, __HIP_MEMORY_SCOPE_AGENT); }
__device__ __forceinline__ unsigned xb_add(unsigned* p, unsigned v) { return __hip_atomic_fetch_add(p, v, __ATOMIC_RELAXED, __HIP_MEMORY_SCOPE_AGENT); }
__device__ __forceinline__ unsigned xb_xcc_id() { return (unsigned)__builtin_amdgcn_s_getreg((3 << 11) | 20) & 0xFu; }
#define XB_SPIN(cond, bar) do { unsigned _sp = 0; while (cond) { __builtin_amdgcn_s_sleep(1); \
    if ((++_sp & 255u) == 0u) { if (xb_ld(&(bar)[XB_TMO])) break; if (_sp > XB_SPIN_CAP) { atomicAdd(&(bar)[XB_TMO], 1u); break; } } } } while (0)
struct XcdBarrier { unsigned* bar; unsigned x; volatile LAS unsigned* st; };
__device__ __forceinline__ XcdBarrier xcd_barrier_post(unsigned* bar, volatile LAS unsigned* st) {
    XcdBarrier b; b.bar = bar; b.x = xb_xcc_id(); b.st = st;
    if (threadIdx.x == 0) (void)xb_add(&bar[XB_XCNT(b.x)], 1u);
    return b;
}
__device__ __forceinline__ void xcd_barrier_complete(unsigned* bar, unsigned x, unsigned& nloc, unsigned& nx) {
    const unsigned G = gridDim.x * gridDim.y * gridDim.z;
    unsigned sum, cnt, mine, sp = 0u;
    for (;;) {
        sum = 0u; cnt = 0u; mine = 0u;
#pragma unroll
        for (unsigned j = 0; j < 16; ++j) { const unsigned c = xb_ld(&bar[XB_XCNT(j)]); sum += c; cnt += (c > 0u) ? 1u : 0u; mine = (j == x) ? c : mine; }
        if (sum == G) break;
        __builtin_amdgcn_s_sleep(1);
        if ((++sp & 255u) == 0u) { if (xb_ld(&bar[XB_TMO])) break; if (sp > XB_SPIN_CAP) { atomicAdd(&bar[XB_TMO], 1u); break; } }
    }
    nloc = mine > 0u ? mine : 1u; nx = cnt > 0u ? cnt : 1u;
}
__device__ __forceinline__ void xcd_barrier(const XcdBarrier& b) {
    asm volatile("s_waitcnt vmcnt(0)" ::: "memory");
    __syncthreads();
    if (threadIdx.x == 0) {
        unsigned* bar = b.bar;
        __builtin_amdgcn_s_waitcnt(0);
        unsigned nloc = b.st[0], nx = b.st[1];
        if (nloc == 0u) { xcd_barrier_complete(bar, b.x, nloc, nx); b.st[0] = nloc; b.st[1] = nx; }
        const unsigned old = xb_add(&bar[XB_XSUB(b.x)], 1u);
        const unsigned gen = old / nloc;
        if (old + 1u == (gen + 1u) * nloc) {
            __builtin_amdgcn_fence(__ATOMIC_RELEASE, "agent");
            asm volatile("s_waitcnt vmcnt(0)" ::: "memory");
            const unsigned og = xb_add(&bar[XB_TOP], 1u);
            const unsigned tg = og / nx;
            if (og + 1u == (tg + 1u) * nx) xb_add(&bar[XB_TOPGEN], 1u);
            else XB_SPIN(xb_ld(&bar[XB_TOPGEN]) == tg, bar);
            __builtin_amdgcn_fence(__ATOMIC_ACQUIRE, "agent");
            xb_add(&bar[XB_XGEN(b.x)], 1u);
            asm volatile("s_waitcnt vmcnt(0)" ::: "memory");
        } else {
            XB_SPIN(xb_ld(&bar[XB_XGEN(b.x)]) == gen, bar);
            __builtin_amdgcn_fence(__ATOMIC_ACQUIRE, "agent");
            asm volatile("s_waitcnt vmcnt(0)" ::: "memory");
        }
    }
    __syncthreads();
}

__global__ void __launch_bounds__(NTHR) fwd_megakernel(Params p) {
    extern __shared__ __attribute__((aligned(16))) unsigned char lds[];
    cg::grid_group grid = cg::this_grid();
    volatile LAS unsigned* xst = (volatile LAS unsigned*)(lds + LDS_BYTES - 32);
    if (threadIdx.x < 2) xst[threadIdx.x] = 0u;
    __syncthreads();
    const XcdBarrier xb = xcd_barrier_post((unsigned*)(p.ws + OFF_BAR), xst);
#pragma unroll 1
    for (int step = 0; step < 18; ++step) {
        const int l = step >= 9 ? 1 : 0;
        const int ph = step - l * 9;
        switch (ph) {
        case 0:
            if (l == 0) phase_embed(p); else phase_rowstat(p);
            phase_convert<false>(p, l, lds);
            if (obid() == 0 && otid() < 32) ((int*)(WS(p) + OFF_CTL))[otid()] = 0;
            if (obid() == 0 && otid() == 32) ((int*)(WS(p) + OFF_CTL))[64 + l] = 0;
            break;
        case 1: phase_inproj(p, lds); break;
        case 2: phase_dsa_prep(p, l); break;
        case 3: {
            if (obid() < NB * 16) phase_scan3(p, l, lds, obid());
            int* qctr = (int*)(WS(p) + OFF_CTL) + 64 + l;
            int* qslot = (int*)(lds + LDS_BYTES - 16);
            for (;;) {
                __syncthreads();
                if (otid() == 0) *qslot = atomicAdd(qctr, 1);
                __syncthreads();
                const int item = *qslot;
                if (item >= 516 + NT / 16) break;
                if (item < 516) phase_pool(p, l, lds, item, item + 1, 1);
                else phase_dsa<false>(p, l, lds, (bf16_t*)(OUTB(p) + DO_YC), nullptr, nullptr, item - 516, item - 515, 1);
            }
        } break;
        case 4: phase_merge(p, lds); break;
        case 5: phase_outproj(p, lds); phase_convert<true>(p, l, lds); break;
        case 6: phase_route(p, l); break;
        case 7: phase_moe1(p, lds); break;
        default: phase_moe2(p, lds); break;
        }
        if (step == 0) grid.sync(); else xcd_barrier(xb);
    }
    phase_final(p);
}

extern "C" void kernel_launch(void* const* d_in, const int* in_sizes, int n_in,
                              void* d_out, int out_size, void* d_ws, size_t ws_size,
                              hipStream_t stream) {
    static int grid_blocks = 0;
    if (grid_blocks == 0) {
        int dev = 0, cus = 0, per_cu = 0;
        (void)hipGetDevice(&dev);
        (void)hipDeviceGetAttribute(&cus, hipDeviceAttributeMultiprocessorCount, dev);
        (void)hipFuncSetAttribute((const void*)fwd_megakernel, hipFuncAttributeMaxDynamicSharedMemorySize, LDS_BYTES);
        (void)hipOccupancyMaxActiveBlocksPerMultiprocessor(&per_cu, fwd_megakernel, NTHR, LDS_BYTES);
        if (per_cu < 1 || n_in != 42 || ws_size < WS_END) { fprintf(stderr, "kernel_launch: bad config per_cu=%d n_in=%d ws=%zu need=%zu\n", per_cu, n_in, ws_size, (size_t)WS_END); grid_blocks = -1; }
        else grid_blocks = cus;
    }
    if (grid_blocks < 0) return;
    Params p{};
    for (int i = 0; i < 42; ++i) p.in[i] = (const float*)d_in[i];
    p.out = (float*)d_out;
    p.ws = (unsigned char*)d_ws;
    (void)hipMemsetAsync((unsigned char*)d_ws + OFF_BAR, 0, XCD_BAR_WORDS * 4, stream);
    void* args[] = {&p};
    hipError_t e = hipLaunchCooperativeKernel((void*)fwd_megakernel, dim3(grid_blocks), dim3(NTHR), args, LDS_BYTES, stream);
    if (e != hipSuccess) fprintf(stderr, "cooperative launch failed: %s (grid %d)\n", hipGetErrorString(e), grid_blocks);
}
```

```cpp
#include <hip/hip_runtime.h>
#include <hip/hip_cooperative_groups.h>
#include <cstdio>
#include <cstdint>
namespace cg = cooperative_groups;

typedef unsigned short bf16_t;
typedef short bf16x8 __attribute__((ext_vector_type(8)));
typedef float f32x4 __attribute__((ext_vector_type(4)));

constexpr int NB = 8, SEQ = 2048, NMETA = 16, TS = 2064, DM = 1024;
constexpr int NT = NB * TS;
constexpr int NTP = 16640;
constexpr int NTHR = 512;
constexpr int CIN = 7912;
constexpr int NP1 = 4992;
constexpr int PM_LD = 896;
constexpr int PM_WD = 0, PM_AD = 64, PM_GD = 128, PM_VD = 256, PM_CQ = 320, PM_CKV = 576, PM_KROPE = 704, PM_KIDX = 736, PM_WIDX = 800;
constexpr int LDS_BYTES = 157 * 1024;

constexpr size_t AL(size_t x) { return (x + 255) & ~(size_t)255; }
constexpr size_t SZ_ACT = (size_t)NTP * 1024 * 2;
constexpr size_t OFF_CTL = 0;
constexpr size_t OFF_BAR = 4096;
constexpr size_t OFF_RSTD = OFF_BAR + 16384;
constexpr size_t OFF_ROPE = OFF_RSTD + AL((size_t)NTP * 4);
constexpr size_t OFF_H = OFF_ROPE + AL((size_t)TS * 16 * 4 * 2);
constexpr size_t OFF_WB = OFF_H + SZ_ACT;
constexpr size_t WB_WIN = 0;
constexpr size_t WB_WG = WB_WIN + (size_t)NP1 * 1024;
constexpr size_t WB_PA = WB_WG + (size_t)3072 * 1024;
constexpr size_t WB_WO = WB_PA + (size_t)3 * 1024 * 1024;
constexpr size_t WB_POOL = WB_WO + (size_t)1024 * 1024;
constexpr size_t WB_QI = WB_POOL + (size_t)4 * 256 * 256;
constexpr size_t WB_UQ = WB_QI + (size_t)512 * 256;
constexpr size_t WB_UK = WB_UQ + (size_t)1536 * 256;
constexpr size_t WB_UV = WB_UK + (size_t)16 * 128 * 64;
constexpr size_t WB_END = WB_UV + (size_t)16 * 64 * 128;
constexpr size_t OFF_PPOOL = OFF_WB + AL(WB_END * 2);
constexpr size_t OFF_PK = OFF_PPOOL + SZ_ACT;
constexpr size_t OFF_PR = OFF_PK + SZ_ACT;
constexpr size_t OFF_PV = OFF_PR + SZ_ACT;
constexpr size_t OFF_PMISC = OFF_PV + SZ_ACT;
constexpr size_t OFF_VFIRST = OFF_PMISC + AL((size_t)NTP * PM_LD * 2);
constexpr size_t OFF_HALO = OFF_VFIRST + SZ_ACT;
constexpr size_t OFF_LIST = OFF_HALO + AL((size_t)130 * 16 * 1024 * 2);
constexpr size_t OFF_PW = OFF_LIST + AL((size_t)24 * NT * 4);
constexpr size_t WS_END = OFF_PW + AL((size_t)NT * 2 * 4);
constexpr size_t OFF_MERGED = OFF_PK;
constexpr size_t OFF_HM32 = OFF_PR;
constexpr size_t OFF_HN = OFF_PPOOL;
constexpr size_t OFF_WEXP = OFF_PMISC;
constexpr size_t WE_W1 = 0, WE_W3 = (size_t)16 * 256 * 1024, WE_W2 = (size_t)2 * 16 * 256 * 1024;
static_assert((size_t)3 * 16 * 256 * 1024 * 2 <= (size_t)NTP * PM_LD * 2, "expert weights must fit in Pmisc");
constexpr size_t DO_YC = 0;
constexpr size_t DO_CQN = DO_YC + SZ_ACT;
constexpr size_t DO_KV = DO_CQN + AL((size_t)NT * 256 * 2);
constexpr size_t DO_KIDX = DO_KV + AL((size_t)NT * 160 * 2);
constexpr size_t DO_WHEAD = DO_KIDX + AL((size_t)NT * 64 * 2);
constexpr size_t DO_ALR = DO_WHEAD + AL((size_t)NT * 8 * 4);
constexpr size_t DO_END = DO_ALR + AL((size_t)NT * 288 * 2);
constexpr size_t DO_HID = DO_YC;
static_assert(DO_END <= (size_t)NB * SEQ * DM * 4, "d_out scratch overflow");
static_assert((size_t)(129 + 24) * 128 * 512 * 2 <= SZ_ACT, "hid fits");
static_assert(WS_END <= 277240096ull, "workspace overflow");

struct Params {
    const float* in[42];
    float* out;
    unsigned char* ws;
};

__device__ __forceinline__ int otid() { int t = threadIdx.x; asm volatile("" : "+v"(t)); return t; }
__device__ __forceinline__ int obid() { int b = blockIdx.x; asm volatile("" : "+s"(b)); return b; }
__device__ __forceinline__ unsigned char* WS(const Params& p) { unsigned char* w = p.ws; asm volatile("" : "+s"(w)); return w; }
__device__ __forceinline__ unsigned char* OUTB(const Params& p) { unsigned char* w = (unsigned char*)p.out; asm volatile("" : "+s"(w)); return w; }
__device__ __forceinline__ float bf2f(bf16_t v) { return __uint_as_float(((unsigned)v) << 16); }
__device__ __forceinline__ bf16_t f2bf(float f) { unsigned u = __float_as_uint(f); u += 0x7FFFu + ((u >> 16) & 1u); return (bf16_t)(u >> 16); }
__device__ __forceinline__ float wave_sum(float v) {
#pragma unroll
    for (int o = 32; o > 0; o >>= 1) v += __shfl_xor(v, o);
    return v;
}
__device__ __forceinline__ float sigmoidf_(float x) { return 1.0f / (1.0f + __expf(-x)); }
__device__ __forceinline__ float softplusf_(float z) { return fmaxf(z, 0.f) + log1pf(__expf(-fabsf(z))); }
__device__ __forceinline__ void glds16(const void* g, void* l) {
    __builtin_amdgcn_global_load_lds((const unsigned*)g, (unsigned*)l, 16, 0, 0);
}

__device__ void phase_embed(const Params& p) {
    const int lane = otid() & 63;
    const int wave = (obid() * NTHR + otid()) >> 6, nw = gridDim.x * NTHR / 64;
    bf16_t* h = (bf16_t*)(WS(p) + OFF_H);
    float* rstd = (float*)(WS(p) + OFF_RSTD);
    for (int n = wave; n < NTP; n += nw) {
        if (n < NT) {
            const int b = n / TS, t = n % TS;
            const float* src = t < NMETA ? p.in[1] + (size_t)t * DM : p.in[0] + ((size_t)b * SEQ + (t - NMETA)) * DM;
            float ss = 0.f;
#pragma unroll
            for (int i = 0; i < 4; ++i) {
                const float4 v = *(const float4*)(src + i * 256 + lane * 4);
                ss += v.x * v.x + v.y * v.y + v.z * v.z + v.w * v.w;
                ushort4 o; o.x = f2bf(v.x); o.y = f2bf(v.y); o.z = f2bf(v.z); o.w = f2bf(v.w);
                *(ushort4*)(h + (size_t)n * DM + i * 256 + lane * 4) = o;
            }
            ss = wave_sum(ss);
            if (lane == 0) rstd[n] = rsqrtf(ss * (1.0f / 1024.0f) + 1e-6f);
        } else {
#pragma unroll
            for (int i = 0; i < 4; ++i) *(ushort4*)(h + (size_t)n * DM + i * 256 + lane * 4) = make_ushort4(0, 0, 0, 0);
            if (lane == 0) rstd[n] = 0.f;
        }
    }
    float* ctab = (float*)(WS(p) + OFF_ROPE);
    float* stab = ctab + TS * 16;
    for (int idx = obid() * NTHR + otid(); idx < TS * 16; idx += gridDim.x * NTHR) {
        const int t = idx >> 4, i = idx & 15;
        const float inv = powf(10000.0f, -(float)(2 * i) / 32.0f);
        const float ang = (float)t * inv;
        ctab[idx] = cosf(ang);
        stab[idx] = sinf(ang);
    }
}

__device__ void phase_rowstat(const Params& p) {
    const int lane = otid() & 63;
    const int wave = (obid() * NTHR + otid()) >> 6, nw = gridDim.x * NTHR / 64;
    const float* hm = (const float*)(WS(p) + OFF_HM32);
    float* rstd = (float*)(WS(p) + OFF_RSTD);
    for (int n = wave; n < NT; n += nw) {
        float ss = 0.f;
#pragma unroll
        for (int i = 0; i < 4; ++i) {
            const float4 v = *(const float4*)(hm + (size_t)n * DM + i * 256 + lane * 4);
            ss += v.x * v.x + v.y * v.y + v.z * v.z + v.w * v.w;
        }
        ss = wave_sum(ss);
        if (lane == 0) rstd[n] = rsqrtf(ss * (1.0f / 1024.0f) + 1e-6f);
    }
}

struct ConvJob { const float* src; bf16_t* dst; const float* scale; int ldsrc, K, nvalid, nrows, nb, notr; size_t sbs, dbs; };
__device__ __forceinline__ int conv_job_tiles(const ConvJob& j) { return j.nb * (j.nrows >> 6) * (j.K >> 6); }
__device__ void conv_tile(const ConvJob& j, int tile, float* lds) {
    const int per = (j.nrows >> 6) * (j.K >> 6);
    const int bi = tile / per, rem = tile % per;
    const int ktiles = j.K >> 6;
    const int n0 = (rem / ktiles) << 6, k0 = (rem % ktiles) << 6;
    const int tid = otid(), tn = tid & 63, tk = tid >> 6;
    const float* src = j.src + (size_t)bi * j.sbs;
    bf16_t* dst = j.dst + (size_t)bi * j.dbs;
#pragma unroll
    for (int kk = 0; kk < 8; ++kk) {
        const int k = k0 + tk * 8 + kk;
        float v = 0.f;
        if (n0 + tn < j.nvalid) { v = j.notr ? src[(size_t)(n0 + tn) * j.ldsrc + k] : src[(size_t)k * j.ldsrc + n0 + tn]; if (j.scale) v *= j.scale[k]; }
        lds[tn * 65 + tk * 8 + kk] = v;
    }
    __syncthreads();
    const int wn = tid >> 3, kq = tid & 7;
    uint4 o;
    unsigned w[4];
#pragma unroll
    for (int q = 0; q < 4; ++q) {
        const float lo = lds[wn * 65 + kq * 8 + 2 * q], hi = lds[wn * 65 + kq * 8 + 2 * q + 1];
        w[q] = (unsigned)f2bf(lo) | ((unsigned)f2bf(hi) << 16);
    }
    o.x = w[0]; o.y = w[1]; o.z = w[2]; o.w = w[3];
    *(uint4*)(dst + (size_t)(n0 + wn) * j.K + k0 + kq * 8) = o;
    __syncthreads();
}
__device__ ConvJob get_job_early(const Params& p, int l, int ji) {
    bf16_t* wb = (bf16_t*)(WS(p) + OFF_WB);
    const float* win = p.in[3] + (size_t)l * DM * CIN;
    const float* nm = p.in[2] + (size_t)l * DM;
    ConvJob j{}; j.nb = 1; j.sbs = 0; j.dbs = 0; j.K = 1024; j.ldsrc = CIN; j.scale = nm;
    switch (ji) {
    case 0: j.src = win + 3072; j.dst = wb + WB_WIN; j.nvalid = 4352; j.nrows = 4352; break;
    case 1: j.src = p.in[17]; j.ldsrc = 32; j.dst = wb + WB_WIN + (size_t)(4096 + PM_VD) * 1024; j.nvalid = (l == 0 ? 0 : 32); j.nrows = 64; break;
    case 2: j.src = win + 7424; j.dst = wb + WB_WIN + (size_t)(4096 + PM_CQ) * 1024; j.nvalid = 488; j.nrows = 576; break;
    case 3: j.src = win; j.dst = wb + WB_WG; j.nvalid = 3072; j.nrows = 3072; break;
    case 4: j.src = p.in[29] + (size_t)l * DM * DM; j.ldsrc = 1024; j.scale = nullptr; j.dst = wb + WB_PA; j.nvalid = 1024; j.nrows = 1024; break;
    case 5: j.src = p.in[30] + (size_t)l * DM * DM; j.ldsrc = 1024; j.scale = nullptr; j.dst = wb + WB_PA + (size_t)1024 * 1024; j.nvalid = 1024; j.nrows = 1024; break;
    case 6: j.src = p.in[31] + (size_t)l * DM * DM; j.ldsrc = 1024; j.scale = nullptr; j.dst = wb + WB_PA + (size_t)2 * 1024 * 1024; j.nvalid = 1024; j.nrows = 1024; break;
    case 7: j.src = p.in[32] + (size_t)l * DM * DM; j.ldsrc = 1024; j.scale = nullptr; j.dst = wb + WB_WO; j.nvalid = 1024; j.nrows = 1024; break;
    case 8: j.src = p.in[5] + (size_t)l * 4 * 256 * 256; j.ldsrc = 256; j.K = 256; j.scale = nullptr; j.dst = wb + WB_POOL; j.nvalid = 256; j.nrows = 256; j.nb = 4; j.sbs = 65536; j.dbs = 65536; break;
    case 9: j.src = p.in[26] + (size_t)l * 256 * 512; j.ldsrc = 512; j.K = 256; j.scale = nullptr; j.dst = wb + WB_QI; j.nvalid = 512; j.nrows = 512; break;
    case 10: j.src = p.in[23] + (size_t)l * 256 * 1536; j.ldsrc = 1536; j.K = 256; j.scale = nullptr; j.dst = wb + WB_UQ; j.nvalid = 1536; j.nrows = 1536; break;
    case 11: j.src = p.in[24] + (size_t)l * 16 * 128 * 64; j.ldsrc = 64; j.K = 64; j.scale = nullptr; j.dst = wb + WB_UK; j.nvalid = 2048; j.nrows = 2048; j.notr = 1; break;
    default: j.src = p.in[25] + (size_t)l * 16 * 128 * 64; j.ldsrc = 64; j.K = 128; j.scale = nullptr; j.dst = wb + WB_UV; j.nvalid = 64; j.nrows = 64; j.nb = 16; j.sbs = 8192; j.dbs = 8192; break;
    }
    return j;
}
__device__ ConvJob get_job_late(const Params& p, int l, int ji) {
    bf16_t* we = (bf16_t*)(WS(p) + OFF_WEXP);
    ConvJob j{}; j.nb = 16; j.scale = nullptr; j.sbs = 262144; j.dbs = 262144;
    switch (ji) {
    case 0: j.src = p.in[38] + (size_t)l * 16 * 262144; j.dst = we + WE_W1; j.ldsrc = 256; j.K = 1024; j.nvalid = 256; j.nrows = 256; break;
    case 1: j.src = p.in[39] + (size_t)l * 16 * 262144; j.dst = we + WE_W3; j.ldsrc = 256; j.K = 1024; j.nvalid = 256; j.nrows = 256; break;
    default: j.src = p.in[40] + (size_t)l * 16 * 262144; j.dst = we + WE_W2; j.ldsrc = 1024; j.K = 256; j.nvalid = 1024; j.nrows = 1024; break;
    }
    return j;
}
template <bool LATE>
__device__ void phase_convert(const Params& p, int l, unsigned char* lds) {
    const int njobs = LATE ? 3 : 13;
    int base = 0;
    for (int ji = 0; ji < njobs; ++ji) {
        const ConvJob j = LATE ? get_job_late(p, l, ji) : get_job_early(p, l, ji);
        const int nt = conv_job_tiles(j);
        int first = ((int)obid() - base) % (int)gridDim.x; if (first < 0) first += gridDim.x;
        for (int t = first; t < nt; t += gridDim.x) conv_tile(j, t, (float*)lds);
        base += nt;
    }
}

template <int BM> struct G3 {
    static constexpr int MI = BM / 64;
    static constexpr int NA = BM / 64;
    static constexpr int STAGE = BM * 128 + 128 * 128;
    const bf16_t* ap[NA];
    const bf16_t* bp[2];
};
template <int BM>
__device__ __forceinline__ void g3_issue(const G3<BM>& g, int kt, unsigned char* stage, int tid) {
#pragma unroll
    for (int i = 0; i < G3<BM>::NA; ++i) glds16(g.ap[i] + kt * 64, stage + (tid + i * NTHR) * 16);
#pragma unroll
    for (int i = 0; i < 2; ++i) glds16(g.bp[i] + kt * 64, stage + BM * 128 + (tid + i * NTHR) * 16);
}
template <int BM, class FA, class FB>
__device__ __forceinline__ void g3_setup(G3<BM>& g, FA rowptr, FB bcol, int tid) {
#pragma unroll
    for (int i = 0; i < G3<BM>::NA; ++i) { const int idx = tid + i * NTHR, row = idx >> 3, sl = (idx & 7) ^ (row & 7); g.ap[i] = rowptr(row) + sl * 8; }
#pragma unroll
    for (int i = 0; i < 2; ++i) { const int idx = tid + i * NTHR, row = idx >> 3, sl = (idx & 7) ^ (row & 7); g.bp[i] = bcol(row) + sl * 8; }
}
template <int BM>
__device__ __forceinline__ void g3_kloop(f32x4 (&acc)[BM / 64][4], const G3<BM>& g, int K, unsigned char* lds) {
    constexpr int MI = G3<BM>::MI, STAGE = G3<BM>::STAGE, NL = G3<BM>::NA + 2;
    const int tid = otid(), lane = tid & 63, wid = tid >> 6, wr = wid >> 1, wc = wid & 1, fr = lane & 15, fq = lane >> 4;
    const int nk = K >> 6;
    g3_issue<BM>(g, 0, lds, tid);
    if (nk > 1) g3_issue<BM>(g, 1, lds + STAGE, tid);
    int cur = 0;
#pragma unroll 1
    for (int t = 0; t < nk; ++t) {
        if (t + 1 < nk) { if (NL == 6) asm volatile("s_waitcnt vmcnt(6)" ::: "memory"); else asm volatile("s_waitcnt vmcnt(4)" ::: "memory"); }
        else asm volatile("s_waitcnt vmcnt(0)" ::: "memory");
        __builtin_amdgcn_s_barrier();
        if (t + 2 < nk) { int nx = cur + 2; if (nx >= 3) nx -= 3; g3_issue<BM>(g, t + 2, lds + nx * STAGE, tid); }
        const unsigned char* cA = lds + cur * STAGE;
        const unsigned char* cB = cA + BM * 128;
#pragma unroll
        for (int ks = 0; ks < 2; ++ks) {
            bf16x8 a[MI], b[4];
#pragma unroll
            for (int m = 0; m < MI; ++m) { const int row = wr * (BM / 4) + m * 16 + fr; a[m] = *(const bf16x8*)(cA + row * 128 + (((ks * 4 + fq) ^ (row & 7)) << 4)); }
#pragma unroll
            for (int n = 0; n < 4; ++n) { const int row = wc * 64 + n * 16 + fr; b[n] = *(const bf16x8*)(cB + row * 128 + (((ks * 4 + fq) ^ (row & 7)) << 4)); }
#pragma unroll
            for (int m = 0; m < MI; ++m)
#pragma unroll
                for (int n = 0; n < 4; ++n) acc[m][n] = __builtin_amdgcn_mfma_f32_16x16x32_bf16(b[n], a[m], acc[m][n], 0, 0, 0);
        }
        cur = (cur == 2) ? 0 : cur + 1;
    }
    __builtin_amdgcn_s_barrier();
}
template <int MI>
__device__ __forceinline__ void g3_zero(f32x4 (&acc)[MI][4]) {
#pragma unroll
    for (int m = 0; m < MI; ++m)
#pragma unroll
        for (int n = 0; n < 4; ++n) acc[m][n] = (f32x4){0.f, 0.f, 0.f, 0.f};
}
__device__ __forceinline__ uint2 pack4(float a, float b, float c, float d) {
    uint2 r; r.x = (unsigned)f2bf(a) | ((unsigned)f2bf(b) << 16); r.y = (unsigned)f2bf(c) | ((unsigned)f2bf(d) << 16); return r;
}

__device__ void phase_inproj(const Params& p, unsigned char* lds) {
    const int tid = otid(), lane = tid & 63, wid = tid >> 6, wr = wid >> 1, wc = wid & 1, fr = lane & 15, fq = lane >> 4;
    const bf16_t* h = (const bf16_t*)(WS(p) + OFF_H);
    const bf16_t* wt = (const bf16_t*)(WS(p) + OFF_WB) + WB_WIN;
    const float* rstd = (const float*)(WS(p) + OFF_RSTD);
    bf16_t* halo = (bf16_t*)(WS(p) + OFF_HALO);
    constexpr int NTN = NP1 / 128;
    for (int tile = obid(); tile < 65 * NTN; tile += gridDim.x) {
        const int mt = tile / NTN, nt = tile % NTN;
        const int row0 = mt * 256, col0 = nt * 128;
        G3<256> g;
        g3_setup<256>(g, [&](int r) { return h + (size_t)(row0 + r) * DM; }, [&](int r) { return wt + (size_t)(col0 + r) * DM; }, tid);
        f32x4 acc[4][4]; g3_zero<4>(acc);
        g3_kloop<256>(acc, g, DM, lds);
        bf16_t* dst; int ld, cbase;
        if (nt < 8) { dst = (bf16_t*)(WS(p) + OFF_PPOOL); ld = 1024; cbase = 0; }
        else if (nt < 16) { dst = (bf16_t*)(WS(p) + OFF_PR); ld = 1024; cbase = 1024; }
        else if (nt < 24) { dst = (bf16_t*)(WS(p) + OFF_PK); ld = 1024; cbase = 2048; }
        else if (nt < 32) { dst = (bf16_t*)(WS(p) + OFF_PV); ld = 1024; cbase = 3072; }
        else { dst = (bf16_t*)(WS(p) + OFF_PMISC); ld = PM_LD; cbase = 4096; }
#pragma unroll
        for (int m = 0; m < 4; ++m) {
            const int row = row0 + wr * 64 + m * 16 + fr;
            if (row < NT) {
                const float rs = rstd[row];
                const int lr = row & 127;
#pragma unroll
                for (int n = 0; n < 4; ++n) {
                    const int col = col0 + wc * 64 + n * 16 + fq * 4;
                    const uint2 v = pack4(acc[m][n][0] * rs, acc[m][n][1] * rs, acc[m][n][2] * rs, acc[m][n][3] * rs);
                    *(uint2*)(dst + (size_t)row * ld + (col - cbase)) = v;
                    if (nt < 8 && lr >= 112) *(uint2*)(halo + ((size_t)(row >> 7) * 16 + (lr - 112)) * 1024 + col) = v;
                }
            }
        }
    }
}

__device__ void phase_pool(const Params& p, int l, unsigned char* lds, int tb, int te, int tstep) {
    const int tid = otid(), lane = tid & 63, wid = tid >> 6, fr = lane & 15, fq = lane >> 4;
    bf16_t* pp = (bf16_t*)(WS(p) + OFF_PPOOL);
    const bf16_t* halo = (const bf16_t*)(WS(p) + OFF_HALO);
    const bf16_t* pw = (const bf16_t*)(WS(p) + OFF_WB) + WB_POOL;
    const float* scale = p.in[6] + (size_t)l * 1024;
    bf16_t* sp = (bf16_t*)lds;
    constexpr int SLD = 264;
    for (int tile = tb; tile < te; tile += tstep) {
        const int mt = tile >> 2, g = tile & 3;
        const int row0 = mt * 128, w = 2 << g;
        for (int e = tid; e < 128 * 256; e += NTHR) {
            const int r = e >> 8, c = e & 255;
            const int n = row0 + r, t = n % TS;
            const int col = g * 256 + c;
            const int cnt = (t + 1 < w) ? (t + 1) : w;
            float s = 0.f, self = 0.f;
            for (int i = 0; i < cnt; ++i) {
                const int n2 = n - i;
                float v;
                if (n2 >= row0) v = bf2f(pp[(size_t)n2 * 1024 + col]);
                else v = bf2f(halo[((size_t)(n2 >> 7) * 16 + ((n2 & 127) - 112)) * 1024 + col]);
                if (i == 0) self = v;
                s += v;
            }
            sp[r * SLD + c] = f2bf(s / (float)cnt - self);
        }
        __syncthreads();
        f32x4 acc[8][2];
#pragma unroll
        for (int m = 0; m < 8; ++m) { acc[m][0] = (f32x4){0.f, 0.f, 0.f, 0.f}; acc[m][1] = (f32x4){0.f, 0.f, 0.f, 0.f}; }
        const bf16_t* wg = pw + (size_t)g * 65536;
#pragma unroll 1
        for (int kk = 0; kk < 8; ++kk) {
            bf16x8 bfr[2];
#pragma unroll
            for (int n = 0; n < 2; ++n) bfr[n] = *(const bf16x8*)(wg + (size_t)(wid * 32 + n * 16 + fr) * 256 + kk * 32 + fq * 8);
#pragma unroll
            for (int m = 0; m < 8; ++m) {
                const bf16x8 a = *(const bf16x8*)(sp + (m * 16 + fr) * SLD + kk * 32 + fq * 8);
                acc[m][0] = __builtin_amdgcn_mfma_f32_16x16x32_bf16(a, bfr[0], acc[m][0], 0, 0, 0);
                acc[m][1] = __builtin_amdgcn_mfma_f32_16x16x32_bf16(a, bfr[1], acc[m][1], 0, 0, 0);
            }
        }
#pragma unroll
        for (int m = 0; m < 8; ++m)
#pragma unroll
            for (int n = 0; n < 2; ++n) {
                const int col = g * 256 + wid * 32 + n * 16 + fr;
                const float sc = scale[col];
#pragma unroll
                for (int j = 0; j < 4; ++j) {
                    const int row = row0 + m * 16 + fq * 4 + j;
                    pp[(size_t)row * 1024 + col] = f2bf(acc[m][n][j] * sc);
                }
            }
        __syncthreads();
    }
}

__device__ void phase_dsa_prep(const Params& p, int l) {
    const int lane = otid() & 63;
    const int wave = (obid() * NTHR + otid()) >> 6, nw = gridDim.x * NTHR / 64;
    const bf16_t* pm = (const bf16_t*)(WS(p) + OFF_PMISC);
    unsigned char* dob = OUTB(p);
    bf16_t* cqn = (bf16_t*)(dob + DO_CQN);
    bf16_t* kv = (bf16_t*)(dob + DO_KV);
    bf16_t* kidx = (bf16_t*)(dob + DO_KIDX);
    float* whead = (float*)(dob + DO_WHEAD);
    const float* ctab = (const float*)(WS(p) + OFF_ROPE);
    const float* stab = ctab + TS * 16;
    const float* qn = p.in[21] + l * 256;
    const float* kvn = p.in[22] + l * 128;
    const float* inw = p.in[27] + l * 64;
    const float* inb = p.in[28] + l * 64;
    for (int n = wave; n < NT; n += nw) {
        const int t = n % TS;
        const bf16_t* row = pm + (size_t)n * PM_LD;
        {
            float v[4]; float ss = 0.f;
#pragma unroll
            for (int i = 0; i < 4; ++i) { v[i] = bf2f(row[PM_CQ + lane * 4 + i]); ss += v[i] * v[i]; }
            ss = wave_sum(ss);
            const float rs = rsqrtf(ss * (1.0f / 256.0f) + 1e-6f);
#pragma unroll
            for (int i = 0; i < 4; ++i) cqn[(size_t)n * 256 + lane * 4 + i] = f2bf(v[i] * rs * qn[lane * 4 + i]);
        }
        {
            float v[2]; float ss = 0.f;
#pragma unroll
            for (int i = 0; i < 2; ++i) { v[i] = bf2f(row[PM_CKV + lane * 2 + i]); ss += v[i] * v[i]; }
            ss = wave_sum(ss);
            const float rs = rsqrtf(ss * (1.0f / 128.0f) + 1e-6f);
#pragma unroll
            for (int i = 0; i < 2; ++i) kv[(size_t)n * 160 + lane * 2 + i] = f2bf(v[i] * rs * kvn[lane * 2 + i]);
        }
        if (lane < 16) {
            const float x1 = bf2f(row[PM_KROPE + lane]), x2 = bf2f(row[PM_KROPE + 16 + lane]);
            const float c = ctab[t * 16 + lane], s = stab[t * 16 + lane];
            kv[(size_t)n * 160 + 128 + lane] = f2bf(x1 * c - x2 * s);
            kv[(size_t)n * 160 + 144 + lane] = f2bf(x2 * c + x1 * s);
        }
        {
            const float x = bf2f(row[PM_KIDX + lane]);
            const float mu = wave_sum(x) * (1.0f / 64.0f);
            const float d = x - mu;
            const float var = wave_sum(d * d) * (1.0f / 64.0f);
            const float y = d * rsqrtf(var + 1e-6f) * inw[lane] + inb[lane];
            const float yo = __shfl_xor(y, 16);
            float o = y;
            if (lane < 32) {
                const int i = lane & 15;
                const float c = ctab[t * 16 + i], s = stab[t * 16 + i];
                o = (lane < 16) ? (y * c - yo * s) : (y * c + yo * s);
            }
            kidx[(size_t)n * 64 + lane] = f2bf(o);
        }
        if (lane < 8) whead[(size_t)n * 8 + lane] = bf2f(row[PM_WIDX + lane]) * 0.04419417382415922f;
    }
}

__device__ void phase_scan(const Params& p, int l, unsigned char* lds) {
    if (obid() >= NB * 16) return;
    const int tid = otid(), lane = tid & 63, wid = tid >> 6;
    const int b = obid() >> 4, hh = obid() & 15, hc = hh * 64;
    constexpr int TC = 16;
    float* s_r = (float*)lds;
    float* s_w = s_r + TC * 64;
    float* s_k = s_w + TC * 64;
    float* s_v = s_k + TC * 64;
    float* s_a = s_v + TC * 64;
    float* s_b = s_a + TC * 64;
    float* s_g = s_b + TC * 64;
    float* s_o = s_g + TC * 64;
    float* s_wd = s_o + TC * 64;
    float* s_ad = s_wd + TC * 64;
    float* s_gd = s_ad + TC * 64;
    float* s_vd = s_gd + TC * 128;
    float* s_pr = s_vd + TC * 32;
    float* s_W2 = s_pr + 128;
    float* s_A2 = s_W2 + 64 * 64;
    float* s_G2 = s_A2 + 64 * 64;
    float* s_V2 = s_G2 + 128 * 64;
    bf16_t* Pr = (bf16_t*)(WS(p) + OFF_PR);
    const bf16_t* Pk = (const bf16_t*)(WS(p) + OFF_PK);
    const bf16_t* Pv = (const bf16_t*)(WS(p) + OFF_PV);
    const bf16_t* Pm = (const bf16_t*)(WS(p) + OFF_PMISC);
    bf16_t* vfirst = (bf16_t*)(WS(p) + OFF_VFIRST);
    const float* mu = p.in[4] + (size_t)l * 3328;
    const float* vmu = p.in[18];
    const float* w0 = p.in[7] + l * 1024;
    const float* a0 = p.in[9] + l * 1024;
    const float* k_k = p.in[12] + l * 1024;
    const float* k_a = p.in[13] + l * 1024;
    const float* r_k = p.in[14] + l * 1024;
    const float* ln_w = p.in[15] + l * 1024;
    const float* ln_b = p.in[16] + l * 1024;
    const float* v0 = p.in[19];
    for (int e = tid; e < 64 * 64; e += NTHR) { const int m = e >> 6, c = e & 63; s_W2[e] = p.in[8][((size_t)l * 64 + m) * 1024 + hc + c]; s_A2[e] = p.in[10][((size_t)l * 64 + m) * 1024 + hc + c]; }
    for (int e = tid; e < 128 * 64; e += NTHR) { const int m = e >> 6, c = e & 63; s_G2[e] = p.in[11][((size_t)l * 128 + m) * 1024 + hc + c]; }
    for (int e = tid; e < 32 * 64; e += NTHR) { const int m = e >> 6, c = e & 63; s_V2[e] = (l > 0) ? p.in[20][(size_t)m * 1024 + hc + c] : 0.f; }
    float S[8];
#pragma unroll
    for (int j = 0; j < 8; ++j) S[j] = 0.f;
    const int si = tid >> 3, q8 = tid & 7;
    __syncthreads();
    for (int t0 = 0, ch = 0; t0 < TS; t0 += TC, ++ch) {
        for (int e = tid; e < TC * 64; e += NTHR) {
            const int tau = e >> 6, c = e & 63, t = t0 + tau;
            const size_t n = (size_t)b * TS + t;
            const float cr = bf2f(Pr[n * 1024 + hc + c]);
            const float ck = bf2f(Pk[n * 1024 + hc + c]);
            const float cv = bf2f(Pv[n * 1024 + hc + c]);
            float prr = 0.f, prk = 0.f, prv = 0.f;
            if (t > 0) {
                prr = (tau > 0) ? bf2f(Pr[(n - 1) * 1024 + hc + c]) : s_pr[((ch + 1) & 1) * 64 + c];
                prk = bf2f(Pk[(n - 1) * 1024 + hc + c]);
                prv = bf2f(Pv[(n - 1) * 1024 + hc + c]);
            }
            if (tau == TC - 1) s_pr[(ch & 1) * 64 + c] = cr;
            s_r[e] = cr + (prr - cr) * mu[hc + c];
            s_k[e] = ck + (prk - ck) * mu[1024 + hc + c];
            s_v[e] = cv + (prv - cv) * mu[2048 + hc + c];
            const float cwd = bf2f(Pm[n * PM_LD + PM_WD + c]), cad = bf2f(Pm[n * PM_LD + PM_AD + c]);
            float pwd = 0.f, pad_ = 0.f;
            if (t > 0) { pwd = bf2f(Pm[(n - 1) * PM_LD + PM_WD + c]); pad_ = bf2f(Pm[(n - 1) * PM_LD + PM_AD + c]); }
            s_wd[e] = tanhf(cwd + (pwd - cwd) * mu[3072 + c]);
            s_ad[e] = cad + (pad_ - cad) * mu[3136 + c];
        }
        for (int e = tid; e < TC * 128; e += NTHR) {
            const int tau = e >> 7, c = e & 127, t = t0 + tau;
            const size_t n = (size_t)b * TS + t;
            const float cg_ = bf2f(Pm[n * PM_LD + PM_GD + c]);
            const float pg = (t > 0) ? bf2f(Pm[(n - 1) * PM_LD + PM_GD + c]) : 0.f;
            s_gd[e] = sigmoidf_(cg_ + (pg - cg_) * mu[3200 + c]);
        }
        if (l > 0) {
            for (int e = tid; e < TC * 32; e += NTHR) {
                const int tau = e >> 5, c = e & 31, t = t0 + tau;
                const size_t n = (size_t)b * TS + t;
                const float cvd = bf2f(Pm[n * PM_LD + PM_VD + c]);
                const float pvd = (t > 0) ? bf2f(Pm[(n - 1) * PM_LD + PM_VD + c]) : 0.f;
                s_vd[e] = cvd + (pvd - cvd) * vmu[c];
            }
        }
        __syncthreads();
        for (int e = tid; e < TC * 64; e += NTHR) {
            const int tau = e >> 6, c = e & 63, t = t0 + tau;
            const size_t n = (size_t)b * TS + t;
            float xw = w0[hc + c], xa = a0[hc + c], gg = 0.f, xv = 0.f;
#pragma unroll 8
            for (int m = 0; m < 64; ++m) { xw += s_wd[tau * 64 + m] * s_W2[m * 64 + c]; xa += s_ad[tau * 64 + m] * s_A2[m * 64 + c]; }
#pragma unroll 8
            for (int m = 0; m < 128; ++m) gg += s_gd[tau * 128 + m] * s_G2[m * 64 + c];
            const float wlog = -softplusf_(-xw) - 0.5f;
            const float decay = __expf(-__expf(wlog));
            const float a = sigmoidf_(xa);
            float vv = s_v[e];
            if (l > 0) {
                xv = v0[hc + c];
#pragma unroll 8
                for (int m = 0; m < 32; ++m) xv += s_vd[tau * 32 + m] * s_V2[m * 64 + c];
                const float vf = bf2f(vfirst[n * 1024 + hc + c]);
                vv = vv + (vf - vv) * sigmoidf_(xv);
            } else {
                vfirst[n * 1024 + hc + c] = f2bf(vv);
            }
            const float kraw = s_k[e];
            const float kkv = kraw * k_k[hc + c];
            const float nrm = sqrtf(wave_sum(kkv * kkv));
            const float kk = kkv / fmaxf(nrm, 1e-12f);
            s_w[e] = decay;
            s_a[e] = -kk;
            s_b[e] = kk * a;
            s_k[e] = kraw * (1.0f + (a - 1.0f) * k_a[hc + c]);
            s_v[e] = vv;
            s_g[e] = gg;
        }
        __syncthreads();
#pragma unroll 1
        for (int tau = 0; tau < TC; ++tau) {
            const float4 a0v = *(const float4*)(s_a + tau * 64 + q8 * 8), a1v = *(const float4*)(s_a + tau * 64 + q8 * 8 + 4);
            const float4 w0v = *(const float4*)(s_w + tau * 64 + q8 * 8), w1v = *(const float4*)(s_w + tau * 64 + q8 * 8 + 4);
            const float4 b0v = *(const float4*)(s_b + tau * 64 + q8 * 8), b1v = *(const float4*)(s_b + tau * 64 + q8 * 8 + 4);
            const float4 k0v = *(const float4*)(s_k + tau * 64 + q8 * 8), k1v = *(const float4*)(s_k + tau * 64 + q8 * 8 + 4);
            const float4 r0v = *(const float4*)(s_r + tau * 64 + q8 * 8), r1v = *(const float4*)(s_r + tau * 64 + q8 * 8 + 4);
            const float vi = s_v[tau * 64 + si];
            const float av[8] = {a0v.x, a0v.y, a0v.z, a0v.w, a1v.x, a1v.y, a1v.z, a1v.w};
            const float wv[8] = {w0v.x, w0v.y, w0v.z, w0v.w, w1v.x, w1v.y, w1v.z, w1v.w};
            const float bv[8] = {b0v.x, b0v.y, b0v.z, b0v.w, b1v.x, b1v.y, b1v.z, b1v.w};
            const float kv_[8] = {k0v.x, k0v.y, k0v.z, k0v.w, k1v.x, k1v.y, k1v.z, k1v.w};
            const float rv[8] = {r0v.x, r0v.y, r0v.z, r0v.w, r1v.x, r1v.y, r1v.z, r1v.w};
            float sa = 0.f;
#pragma unroll
            for (int j = 0; j < 8; ++j) sa += S[j] * av[j];
            sa += __shfl_xor(sa, 1); sa += __shfl_xor(sa, 2); sa += __shfl_xor(sa, 4);
            float o = 0.f;
#pragma unroll
            for (int j = 0; j < 8; ++j) { S[j] = S[j] * wv[j] + sa * bv[j] + vi * kv_[j]; o += S[j] * rv[j]; }
            o += __shfl_xor(o, 1); o += __shfl_xor(o, 2); o += __shfl_xor(o, 4);
            if (q8 == 0) s_o[tau * 64 + si] = o;
        }
        __syncthreads();
        for (int tau = wid; tau < TC; tau += 8) {
            const int c = lane, e = tau * 64 + c;
            const size_t n = (size_t)b * TS + t0 + tau;
            const float o = s_o[e];
            const float m_ = wave_sum(o) * (1.0f / 64.0f);
            const float d = o - m_;
            const float var = wave_sum(d * d) * (1.0f / 64.0f);
            const float on = d * rsqrtf(var + 64e-5f) * ln_w[hc + c] + ln_b[hc + c];
            const float bonus = wave_sum(s_r[e] * s_k[e] * r_k[hc + c]) * s_v[e];
            Pr[n * 1024 + hc + c] = f2bf((on + bonus) * s_g[e]);
        }
        __syncthreads();
    }
}

__device__ void phase_dsa_naive(const Params& p, int l, unsigned char* lds) {
    const int tid = otid(), lane = tid & 63, wid = tid >> 6;
    constexpr int QT = 4, SCL = 2080;
    float* s_cq = (float*)lds;
    float* s_q = s_cq + QT * 256;
    float* s_Q = s_q + QT * 1536;
    float* s_qi = s_Q + QT * 16 * 160;
    float* s_sc = s_qi + QT * 512;
    int* s_sel = (int*)(s_sc + QT * SCL);
    int* s_nsel = s_sel + QT * 256;
    float* s_p = (float*)(s_nsel + 16);
    float* s_ol = s_p + 16 * 256;
    float* s_wh = s_ol + 16 * 128;
    unsigned char* dob = OUTB(p);
    const bf16_t* cqn = (const bf16_t*)(dob + DO_CQN);
    const bf16_t* kv = (const bf16_t*)(dob + DO_KV);
    const bf16_t* kidx = (const bf16_t*)(dob + DO_KIDX);
    const float* whead = (const float*)(dob + DO_WHEAD);
    bf16_t* yc = (bf16_t*)(dob + DO_YC);
    const float* ctab = (const float*)(WS(p) + OFF_ROPE);
    const float* stab = ctab + TS * 16;
    const float* w_uq = p.in[23] + (size_t)l * 256 * 1536;
    const float* w_uk = p.in[24] + (size_t)l * 16 * 128 * 64;
    const float* w_uv = p.in[25] + (size_t)l * 16 * 128 * 64;
    const float* w_qi = p.in[26] + (size_t)l * 256 * 512;
    const float scale = 0.10206207261596575f;
    for (int tile = obid(); tile < NT / QT; tile += gridDim.x) {
        const int n0 = tile * QT, b = n0 / TS, t0 = n0 % TS;
        for (int e = tid; e < QT * 256; e += NTHR) s_cq[e] = bf2f(cqn[(size_t)n0 * 256 + e]);
        if (tid < QT * 8) s_wh[tid] = whead[(size_t)n0 * 8 + tid];
        __syncthreads();
        {
            float acc[3][QT];
#pragma unroll
            for (int c = 0; c < 3; ++c)
#pragma unroll
                for (int q = 0; q < QT; ++q) acc[c][q] = 0.f;
            float ai[QT];
#pragma unroll
            for (int q = 0; q < QT; ++q) ai[q] = 0.f;
            for (int i = 0; i < 256; ++i) {
                const float wa = w_uq[(size_t)i * 1536 + tid], wb_ = w_uq[(size_t)i * 1536 + 512 + tid], wc_ = w_uq[(size_t)i * 1536 + 1024 + tid];
                const float wi = w_qi[(size_t)i * 512 + tid];
#pragma unroll
                for (int q = 0; q < QT; ++q) {
                    const float c = s_cq[q * 256 + i];
                    acc[0][q] += c * wa; acc[1][q] += c * wb_; acc[2][q] += c * wc_; ai[q] += c * wi;
                }
            }
#pragma unroll
            for (int q = 0; q < QT; ++q) {
                s_q[q * 1536 + tid] = acc[0][q]; s_q[q * 1536 + 512 + tid] = acc[1][q]; s_q[q * 1536 + 1024 + tid] = acc[2][q];
                s_qi[q * 512 + tid] = ai[q];
            }
        }
        __syncthreads();
        for (int e = tid; e < QT * 16 * 16; e += NTHR) {
            const int q = e >> 8, h = (e >> 4) & 15, i = e & 15;
            const float x1 = s_q[q * 1536 + h * 96 + 64 + i], x2 = s_q[q * 1536 + h * 96 + 80 + i];
            const float c = ctab[(t0 + q) * 16 + i], s = stab[(t0 + q) * 16 + i];
            s_Q[(q * 16 + h) * 160 + 128 + i] = x1 * c - x2 * s;
            s_Q[(q * 16 + h) * 160 + 144 + i] = x2 * c + x1 * s;
        }
        {
            const int q = tid >> 7, h8 = (tid >> 4) & 7, i = tid & 15;
            const float x1 = s_qi[q * 512 + h8 * 64 + i], x2 = s_qi[q * 512 + h8 * 64 + 16 + i];
            const float c = ctab[(t0 + q) * 16 + i], s = stab[(t0 + q) * 16 + i];
            __syncthreads();
            s_qi[q * 512 + h8 * 64 + i] = x1 * c - x2 * s;
            s_qi[q * 512 + h8 * 64 + 16 + i] = x2 * c + x1 * s;
        }
        for (int id = tid; id < 16 * 128; id += NTHR) {
            const int h = id >> 7, c = id & 127;
            const float* wrow = w_uk + ((size_t)h * 128 + c) * 64;
            float acc[QT];
#pragma unroll
            for (int q = 0; q < QT; ++q) acc[q] = 0.f;
            for (int d = 0; d < 64; d += 4) {
                const float4 w4 = *(const float4*)(wrow + d);
#pragma unroll
                for (int q = 0; q < QT; ++q) {
                    const float* qq = s_q + q * 1536 + h * 96 + d;
                    acc[q] += qq[0] * w4.x + qq[1] * w4.y + qq[2] * w4.z + qq[3] * w4.w;
                }
            }
#pragma unroll
            for (int q = 0; q < QT; ++q) s_Q[(q * 16 + h) * 160 + c] = acc[q];
        }
        __syncthreads();
        const int tmax = t0 + QT - 1;
        for (int s = tid; s <= tmax; s += NTHR) {
            float kr[64];
            const bf16_t* krow = kidx + ((size_t)b * TS + s) * 64;
#pragma unroll
            for (int v8 = 0; v8 < 8; ++v8) {
                const uint4 u = *(const uint4*)(krow + v8 * 8);
                kr[v8 * 8 + 0] = __uint_as_float(u.x << 16); kr[v8 * 8 + 1] = __uint_as_float(u.x & 0xFFFF0000u);
                kr[v8 * 8 + 2] = __uint_as_float(u.y << 16); kr[v8 * 8 + 3] = __uint_as_float(u.y & 0xFFFF0000u);
                kr[v8 * 8 + 4] = __uint_as_float(u.z << 16); kr[v8 * 8 + 5] = __uint_as_float(u.z & 0xFFFF0000u);
                kr[v8 * 8 + 6] = __uint_as_float(u.w << 16); kr[v8 * 8 + 7] = __uint_as_float(u.w & 0xFFFF0000u);
            }
#pragma unroll 1
            for (int q = 0; q < QT; ++q) {
                float I = 0.f;
#pragma unroll 1
                for (int h = 0; h < 8; ++h) {
                    const float* qq = s_qi + q * 512 + h * 64;
                    float d = 0.f;
#pragma unroll
                    for (int j = 0; j < 64; ++j) d += qq[j] * kr[j];
                    I += s_wh[q * 8 + h] * fmaxf(d, 0.f);
                }
                s_sc[q * SCL + s] = I;
            }
        }
        __syncthreads();
        if (wid < QT) {
            const int q = wid, t = t0 + q, nadm = t + 1;
            const float* sc = s_sc + q * SCL;
            int* sel = s_sel + q * 256;
            if (nadm <= 256) {
                for (int i = lane; i < nadm; i += 64) sel[i] = i;
                if (lane == 0) s_nsel[q] = nadm;
            } else {
                const int nch = (nadm + 63) >> 6;
                unsigned T = 0u;
                for (int bit = 31; bit >= 0; --bit) {
                    const unsigned cand = T | (1u << bit);
                    int cnt = 0;
                    for (int c = 0; c < nch; ++c) {
                        const int s = c * 64 + lane;
                        bool ge = false;
                        if (s < nadm) { const unsigned u = __float_as_uint(sc[s]); const unsigned key = (u & 0x80000000u) ? ~u : (u | 0x80000000u); ge = key >= cand; }
                        cnt += __popcll(__ballot(ge));
                    }
                    if (cnt >= 256) T = cand;
                }
                int ngt = 0;
                for (int c = 0; c < nch; ++c) {
                    const int s = c * 64 + lane;
                    bool gt = false;
                    if (s < nadm) { const unsigned u = __float_as_uint(sc[s]); const unsigned key = (u & 0x80000000u) ? ~u : (u | 0x80000000u); gt = key > T; }
                    ngt += __popcll(__ballot(gt));
                }
                const int rties = 256 - ngt;
                int base = 0, ties = 0;
                const unsigned long long ltmask = (1ull << lane) - 1ull;
                for (int c = 0; c < nch; ++c) {
                    const int s = c * 64 + lane;
                    bool gt = false, eq = false;
                    if (s < nadm) { const unsigned u = __float_as_uint(sc[s]); const unsigned key = (u & 0x80000000u) ? ~u : (u | 0x80000000u); gt = key > T; eq = key == T; }
                    const unsigned long long em = __ballot(eq);
                    const int myrank = ties + __popcll(em & ltmask);
                    const bool take = gt || (eq && myrank < rties);
                    const unsigned long long tm = __ballot(take);
                    const int pos = base + __popcll(tm & ltmask);
                    if (take && pos < 256) sel[pos] = s;
                    base += __popcll(tm); ties += __popcll(em);
                }
                if (lane == 0) s_nsel[q] = 256;
            }
        }
        __syncthreads();
        for (int q = 0; q < QT; ++q) {
            const int nsel = s_nsel[q];
            const int* sel = s_sel + q * 256;
            {
                const int h = tid >> 5, kg = tid & 31;
                const float* qv = s_Q + (q * 16 + h) * 160;
                float mx = -INFINITY;
#pragma unroll 1
                for (int kk = 0; kk < 8; ++kk) {
                    const int ki = kg + kk * 32;
                    float sv = -INFINITY;
                    if (ki < nsel) {
                        const bf16_t* krow = kv + ((size_t)b * TS + sel[ki]) * 160;
                        float d = 0.f;
#pragma unroll 4
                        for (int v8 = 0; v8 < 20; ++v8) {
                            const uint4 u = *(const uint4*)(krow + v8 * 8);
                            const float* qq = qv + v8 * 8;
                            d += qq[0] * __uint_as_float(u.x << 16) + qq[1] * __uint_as_float(u.x & 0xFFFF0000u)
                               + qq[2] * __uint_as_float(u.y << 16) + qq[3] * __uint_as_float(u.y & 0xFFFF0000u)
                               + qq[4] * __uint_as_float(u.z << 16) + qq[5] * __uint_as_float(u.z & 0xFFFF0000u)
                               + qq[6] * __uint_as_float(u.w << 16) + qq[7] * __uint_as_float(u.w & 0xFFFF0000u);
                        }
                        sv = d * scale;
                    }
                    s_p[h * 256 + ki] = sv; mx = fmaxf(mx, sv);
                }
#pragma unroll
                for (int o = 16; o > 0; o >>= 1) mx = fmaxf(mx, __shfl_xor(mx, o));
                float sum = 0.f;
#pragma unroll 1
                for (int kk = 0; kk < 8; ++kk) { const float sv = s_p[h * 256 + kg + kk * 32]; const float e = (sv == -INFINITY) ? 0.f : __expf(sv - mx); s_p[h * 256 + kg + kk * 32] = e; sum += e; }
#pragma unroll
                for (int o = 16; o > 0; o >>= 1) sum += __shfl_xor(sum, o);
                const float inv = 1.0f / sum;
#pragma unroll 1
                for (int kk = 0; kk < 8; ++kk) s_p[h * 256 + kg + kk * 32] *= inv;
            }
            __syncthreads();
            {
                const int h = tid >> 5, c4 = tid & 31;
                float a0_ = 0.f, a1_ = 0.f, a2_ = 0.f, a3_ = 0.f;
                for (int k = 0; k < nsel; ++k) {
                    const float pk = s_p[h * 256 + k];
                    const uint2 u = *(const uint2*)(kv + ((size_t)b * TS + sel[k]) * 160 + c4 * 4);
                    a0_ += pk * __uint_as_float(u.x << 16); a1_ += pk * __uint_as_float(u.x & 0xFFFF0000u);
                    a2_ += pk * __uint_as_float(u.y << 16); a3_ += pk * __uint_as_float(u.y & 0xFFFF0000u);
                }
                float* o = s_ol + h * 128 + c4 * 4;
                o[0] = a0_; o[1] = a1_; o[2] = a2_; o[3] = a3_;
            }
            __syncthreads();
            for (int id = tid; id < 1024; id += NTHR) {
                const int h = id >> 6, v = id & 63;
                float acc = 0.f;
                for (int c = 0; c < 128; ++c) acc += s_ol[h * 128 + c] * w_uv[((size_t)h * 128 + c) * 64 + v];
                yc[(size_t)(n0 + q) * 1024 + id] = f2bf(acc);
            }
            __syncthreads();
        }
    }
}


typedef short s16x4 __attribute__((ext_vector_type(4)));
__device__ __forceinline__ unsigned f2h_bits(float f) { const _Float16 h = (_Float16)f; unsigned short u; __builtin_memcpy(&u, &h, 2); return u; }
template <bool IMPORT_SEL>
__device__ void phase_dsa(const Params& p, int l, unsigned char* lds, bf16_t* yc, const unsigned short* gsel, const int* gnsel, int tb, int te, int tstep) {
    const int tid = otid(), lane = tid & 63, wid = tid >> 6, fr = lane & 15, fq = lane >> 4;
    unsigned short* s_sc = (unsigned short*)lds;
    bf16_t* s_qi = (bf16_t*)(lds + 66048);
    bf16_t* s_Q = (bf16_t*)lds;
    unsigned char* s_Vw = lds + 82432 + wid * 8192;
    bf16_t* s_qn = (bf16_t*)s_Vw;
    unsigned short* s_sel = (unsigned short*)(lds + 82432 + 65536);
    int* s_nsel = (int*)(lds + 82432 + 65536 + 8192);
    unsigned char* dob = OUTB(p);
    const bf16_t* cqn = (const bf16_t*)(dob + DO_CQN);
    const bf16_t* kv = (const bf16_t*)(dob + DO_KV);
    const bf16_t* kidx = (const bf16_t*)(dob + DO_KIDX);
    const float* whead = (const float*)(dob + DO_WHEAD);
    const float* ctab = (const float*)(WS(p) + OFF_ROPE);
    const float* stab = ctab + TS * 16;
    const bf16_t* wb = (const bf16_t*)(WS(p) + OFF_WB);
    const bf16_t* wqiT = wb + WB_QI;
    const bf16_t* wuqT = wb + WB_UQ;
    const bf16_t* wuk = wb + WB_UK;
    const bf16_t* wuvT = wb + WB_UV;
    const float scale = 0.10206207261596575f;
    const f32x4 z4 = {0.f, 0.f, 0.f, 0.f};
    for (int tile = tb; tile < te; tile += tstep) {
        const int qt = 128 - (tile >> 3), b = tile & 7;
        const int t0 = qt * 16;
        const size_t n0 = (size_t)b * TS + t0;
        {
            bf16x8 acq[8];
#pragma unroll
            for (int kk = 0; kk < 8; ++kk) acq[kk] = *(const bf16x8*)(cqn + (n0 + fr) * 256 + kk * 32 + fq * 8);
            f32x4 c[4] = {z4, z4, z4, z4};
#pragma unroll
            for (int kk = 0; kk < 8; ++kk)
#pragma unroll
                for (int nt = 0; nt < 4; ++nt)
                    c[nt] = __builtin_amdgcn_mfma_f32_16x16x32_bf16(acq[kk], *(const bf16x8*)(wqiT + (size_t)(wid * 64 + nt * 16 + fr) * 256 + kk * 32 + fq * 8), c[nt], 0, 0, 0);
#pragma unroll
            for (int j = 0; j < 4; ++j) {
                const int t = t0 + fq * 4 + j;
                const float cs = ctab[t * 16 + fr], sn = stab[t * 16 + fr];
                const float x1 = c[0][j], x2 = c[1][j];
                c[0][j] = x1 * cs - x2 * sn; c[1][j] = x2 * cs + x1 * sn;
            }
#pragma unroll
            for (int nt = 0; nt < 4; ++nt)
#pragma unroll
                for (int j = 0; j < 4; ++j) s_qi[(fq * 4 + j) * 512 + wid * 64 + nt * 16 + fr] = f2bf(c[nt][j]);
        }
        __syncthreads();
        if (!IMPORT_SEL) {
            bf16x8 aq[8][2];
#pragma unroll
            for (int h = 0; h < 8; ++h)
#pragma unroll
                for (int ks = 0; ks < 2; ++ks) aq[h][ks] = *(const bf16x8*)(s_qi + fr * 512 + h * 64 + ks * 32 + fq * 8);
            float wh[4][8];
#pragma unroll
            for (int j = 0; j < 4; ++j) {
                const float4 w0 = *(const float4*)(whead + (n0 + fq * 4 + j) * 8), w1 = *(const float4*)(whead + (n0 + fq * 4 + j) * 8 + 4);
                wh[j][0] = w0.x; wh[j][1] = w0.y; wh[j][2] = w0.z; wh[j][3] = w0.w; wh[j][4] = w1.x; wh[j][5] = w1.y; wh[j][6] = w1.z; wh[j][7] = w1.w;
            }
            const int nkt = qt + 1;
#pragma unroll 1
            for (int kt = wid; kt < nkt; kt += 8) {
                const bf16_t* krow = kidx + ((size_t)b * TS + kt * 16 + fr) * 64 + fq * 8;
                const bf16x8 bk0 = *(const bf16x8*)krow, bk1 = *(const bf16x8*)(krow + 32);
                float I[4] = {0.f, 0.f, 0.f, 0.f};
#pragma unroll
                for (int h = 0; h < 8; ++h) {
                    f32x4 a = __builtin_amdgcn_mfma_f32_16x16x32_bf16(aq[h][0], bk0, z4, 0, 0, 0);
                    a = __builtin_amdgcn_mfma_f32_16x16x32_bf16(aq[h][1], bk1, a, 0, 0, 0);
#pragma unroll
                    for (int j = 0; j < 4; ++j) I[j] += wh[j][h] * fmaxf(a[j], 0.f);
                }
#pragma unroll
                for (int j = 0; j < 4; ++j) s_sc[(fq * 4 + j) * 2064 + kt * 16 + fr] = (unsigned short)f2h_bits(I[j]);
            }
        }
        __syncthreads();
#pragma unroll 1
        for (int qi2 = 0; qi2 < 2; ++qi2) {
            const int q = wid + qi2 * 8;
            const int nadm = t0 + q + 1;
            unsigned short* sel = s_sel + q * 256;
            if (IMPORT_SEL) {
                const int ns = gnsel[n0 + q];
                for (int i = lane; i < ns; i += 64) sel[i] = gsel[(n0 + q) * 256 + i];
                if (lane == 0) s_nsel[q] = ns;
            } else if (nadm <= 256) {
                for (int i = lane; i < nadm; i += 64) sel[i] = (unsigned short)i;
                if (lane == 0) s_nsel[q] = nadm;
            } else {
                unsigned key[33];
#pragma unroll
                for (int c = 0; c < 33; ++c) {
                    const int s = c * 64 + lane;
                    unsigned k = 0u;
                    if (s < nadm) { const unsigned u = s_sc[q * 2064 + s]; k = (u & 0x8000u) ? (~u & 0xFFFFu) : (u | 0x8000u); }
                    key[c] = k;
                }
                unsigned T = 0u;
#pragma unroll 1
                for (int bit = 15; bit >= 0; --bit) {
                    const unsigned cand = T | (1u << bit);
                    int cnt = 0;
#pragma unroll
                    for (int c = 0; c < 33; ++c) cnt += __popcll(__ballot(key[c] >= cand));
                    if (cnt >= 256) T = cand;
                }
                int ngt = 0;
#pragma unroll
                for (int c = 0; c < 33; ++c) ngt += __popcll(__ballot(key[c] > T));
                const int rties = 256 - ngt;
                int base = 0, ties = 0;
                const unsigned long long ltmask = (1ull << lane) - 1ull;
#pragma unroll
                for (int c = 0; c < 33; ++c) {
                    const bool gt = key[c] > T, eq = key[c] == T;
                    const unsigned long long em = __ballot(eq);
                    const int myrank = ties + __popcll(em & ltmask);
                    const bool take = gt || (eq && myrank < rties);
                    const unsigned long long tm = __ballot(take);
                    const int pos = base + __popcll(tm & ltmask);
                    if (take && pos < 256) sel[pos] = (unsigned short)(c * 64 + lane);
                    base += __popcll(tm); ties += __popcll(em);
                }
                if (lane == 0) s_nsel[q] = 256;
            }
        }
        __syncthreads();
#pragma unroll 1
        for (int hi = 0; hi < 2; ++hi) {
            const int hh = wid * 2 + hi;
            bf16x8 acq[8];
#pragma unroll
            for (int kk = 0; kk < 8; ++kk) acq[kk] = *(const bf16x8*)(cqn + (n0 + fr) * 256 + kk * 32 + fq * 8);
            f32x4 c6[6] = {z4, z4, z4, z4, z4, z4};
#pragma unroll
            for (int kk = 0; kk < 8; ++kk)
#pragma unroll
                for (int nt = 0; nt < 6; ++nt)
                    c6[nt] = __builtin_amdgcn_mfma_f32_16x16x32_bf16(acq[kk], *(const bf16x8*)(wuqT + (size_t)(hh * 96 + nt * 16 + fr) * 256 + kk * 32 + fq * 8), c6[nt], 0, 0, 0);
#pragma unroll
            for (int j = 0; j < 4; ++j) {
                const int q = fq * 4 + j, t = t0 + q;
                const float cs = ctab[t * 16 + fr], sn = stab[t * 16 + fr];
                const float x1 = c6[4][j], x2 = c6[5][j];
                s_Q[(q * 16 + hh) * 160 + 128 + fr] = f2bf(x1 * cs - x2 * sn);
                s_Q[(q * 16 + hh) * 160 + 144 + fr] = f2bf(x2 * cs + x1 * sn);
#pragma unroll
                for (int nt = 0; nt < 4; ++nt) s_qn[q * 64 + nt * 16 + fr] = f2bf(c6[nt][j]);
            }
            __syncthreads();
            bf16x8 an[2];
#pragma unroll
            for (int ks = 0; ks < 2; ++ks) an[ks] = *(const bf16x8*)(s_qn + fr * 64 + ks * 32 + fq * 8);
#pragma unroll
            for (int nt = 0; nt < 8; ++nt) {
                f32x4 a = z4;
#pragma unroll
                for (int ks = 0; ks < 2; ++ks)
                    a = __builtin_amdgcn_mfma_f32_16x16x32_bf16(an[ks], *(const bf16x8*)(wuk + (size_t)(hh * 128 + nt * 16 + fr) * 64 + ks * 32 + fq * 8), a, 0, 0, 0);
#pragma unroll
                for (int j = 0; j < 4; ++j) s_Q[((fq * 4 + j) * 16 + hh) * 160 + nt * 16 + fr] = f2bf(a[j]);
            }
            __syncthreads();
        }
#pragma unroll 1
        for (int qi2 = 0; qi2 < 2; ++qi2) {
            const int q = wid + qi2 * 8;
            bf16x8 bq[5];
#pragma unroll
            for (int ks = 0; ks < 5; ++ks) bq[ks] = *(const bf16x8*)(s_Q + (q * 16 + fr) * 160 + ks * 32 + fq * 8);
            const int nsel = s_nsel[q];
            const unsigned short* sel = s_sel + q * 256;
            float m = -INFINITY, lsum = 0.f;
            f32x4 O[8] = {z4, z4, z4, z4, z4, z4, z4, z4};
            const int nchunk = (nsel + 31) >> 5;
#pragma unroll 1
            for (int ch = 0; ch < nchunk; ++ch) {
                bf16x8 ak[2][5];
#pragma unroll
                for (int mt = 0; mt < 2; ++mt) {
                    const int ki = ch * 32 + mt * 16 + fr;
                    const int sidx = sel[ki < nsel ? ki : 0];
                    const bf16_t* krow = kv + ((size_t)b * TS + sidx) * 160 + fq * 8;
#pragma unroll
                    for (int ks = 0; ks < 5; ++ks) ak[mt][ks] = *(const bf16x8*)(krow + ks * 32);
                }
#pragma unroll
                for (int mt = 0; mt < 2; ++mt)
#pragma unroll
                    for (int ks = 0; ks < 4; ++ks) {
                        const int r = mt * 16 + fr;
                        *(bf16x8*)(s_Vw + r * 256 + (((ks * 2 + (fq >> 1)) ^ (r & 7)) * 32) + (fq & 1) * 16) = ak[mt][ks];
                    }
                f32x4 st[2] = {z4, z4};
#pragma unroll
                for (int mt = 0; mt < 2; ++mt)
#pragma unroll
                    for (int ks = 0; ks < 5; ++ks) st[mt] = __builtin_amdgcn_mfma_f32_16x16x32_bf16(ak[mt][ks], bq[ks], st[mt], 0, 0, 0);
                float sv[2][4]; float cmax = -INFINITY;
#pragma unroll
                for (int mt = 0; mt < 2; ++mt)
#pragma unroll
                    for (int j = 0; j < 4; ++j) {
                        const int ke = ch * 32 + mt * 16 + fq * 4 + j;
                        const float s_ = (ke < nsel) ? st[mt][j] * scale : -INFINITY;
                        sv[mt][j] = s_; cmax = fmaxf(cmax, s_);
                    }
                cmax = fmaxf(cmax, __shfl_xor(cmax, 16)); cmax = fmaxf(cmax, __shfl_xor(cmax, 32));
                const float mnew = fmaxf(m, cmax);
                const float alpha = __expf(m - mnew);
                float psum = 0.f;
#pragma unroll
                for (int mt = 0; mt < 2; ++mt)
#pragma unroll
                    for (int j = 0; j < 4; ++j) { const float pe = __expf(sv[mt][j] - mnew); sv[mt][j] = pe; psum += pe; }
                psum += __shfl_xor(psum, 16); psum += __shfl_xor(psum, 32);
                lsum = lsum * alpha + psum; m = mnew;
#pragma unroll
                for (int ct = 0; ct < 8; ++ct) O[ct] = O[ct] * alpha;
                bf16x8 pf;
#pragma unroll
                for (int mt = 0; mt < 2; ++mt)
#pragma unroll
                    for (int j = 0; j < 4; ++j) pf[mt * 4 + j] = (short)f2bf(sv[mt][j]);
                const int q_ = fr >> 2, p_ = fr & 3;
                const int r0 = fq * 4 + q_, r1 = 16 + r0;
#pragma unroll
                for (int ct = 0; ct < 8; ++ct) {
                    const s16x4 v0 = __builtin_amdgcn_ds_read_tr16_b64_v4i16((__attribute__((address_space(3))) s16x4*)(s_Vw + r0 * 256 + ((ct ^ (r0 & 7)) * 32) + p_ * 8));
                    const s16x4 v1 = __builtin_amdgcn_ds_read_tr16_b64_v4i16((__attribute__((address_space(3))) s16x4*)(s_Vw + r1 * 256 + ((ct ^ (r1 & 7)) * 32) + p_ * 8));
                    bf16x8 av; av[0] = v0[0]; av[1] = v0[1]; av[2] = v0[2]; av[3] = v0[3]; av[4] = v1[0]; av[5] = v1[1]; av[6] = v1[2]; av[7] = v1[3];
                    O[ct] = __builtin_amdgcn_mfma_f32_16x16x32_bf16(av, pf, O[ct], 0, 0, 0);
                }
            }
            const float inv = 1.0f / lsum;
#pragma unroll
            for (int ct = 0; ct < 8; ++ct)
#pragma unroll
                for (int j = 0; j < 4; ++j) s_Q[(q * 16 + fr) * 160 + ct * 16 + fq * 4 + j] = f2bf(O[ct][j] * inv);
        }
        __syncthreads();
#pragma unroll 1
        for (int hi = 0; hi < 2; ++hi) {
            const int hh = wid * 2 + hi;
            bf16x8 ao[4];
#pragma unroll
            for (int ks = 0; ks < 4; ++ks) ao[ks] = *(const bf16x8*)(s_Q + (fr * 16 + hh) * 160 + ks * 32 + fq * 8);
#pragma unroll
            for (int nt = 0; nt < 4; ++nt) {
                f32x4 a = z4;
#pragma unroll
                for (int ks = 0; ks < 4; ++ks)
                    a = __builtin_amdgcn_mfma_f32_16x16x32_bf16(ao[ks], *(const bf16x8*)(wuvT + (size_t)(hh * 64 + nt * 16 + fr) * 128 + ks * 32 + fq * 8), a, 0, 0, 0);
#pragma unroll
                for (int j = 0; j < 4; ++j) yc[(n0 + fq * 4 + j) * 1024 + hh * 64 + nt * 16 + fr] = f2bf(a[j]);
            }
        }
        __syncthreads();
    }
}


__device__ void phase_lr_prep(const Params& p, int l) {
    const int lane = otid() & 63;
    const int wave = (obid() * NTHR + otid()) >> 6, nw = gridDim.x * NTHR / 64;
    const bf16_t* pm = (const bf16_t*)(WS(p) + OFF_PMISC);
    bf16_t* alr = (bf16_t*)(OUTB(p) + DO_ALR);
    const float* mu = p.in[4] + (size_t)l * 3328 + 3072;
    const float* vmu = p.in[18];
    for (int n = wave; n < NT; n += nw) {
        const int t = n % TS;
        for (int c = lane; c < 288; c += 64) {
            const float cur = bf2f(pm[(size_t)n * PM_LD + c]);
            const float prv = (t > 0) ? bf2f(pm[(size_t)(n - 1) * PM_LD + c]) : 0.f;
            const float m_ = (c < 256) ? mu[c] : vmu[c - 256];
            float xs = cur + (prv - cur) * m_;
            if (c < 64) xs = tanhf(xs);
            else if (c >= 128 && c < 256) xs = sigmoidf_(xs);
            alr[(size_t)n * 288 + c] = f2bf(xs);
        }
    }
}

template <int CTRL> __device__ __forceinline__ float dpp_f(float x) {
    return __int_as_float(__builtin_amdgcn_update_dpp(0, __float_as_int(x), CTRL, 0xF, 0xF, true));
}
__device__ __forceinline__ float row16_sum(float v) {
    v += dpp_f<0xB1>(v);
    v += dpp_f<0x4E>(v);
    v += dpp_f<0x141>(v);
    v += dpp_f<0x140>(v);
    return v;
}
__device__ __forceinline__ void lds_barrier() { asm volatile("s_waitcnt lgkmcnt(0)" ::: "memory"); __builtin_amdgcn_s_barrier(); asm volatile("" ::: "memory"); }
__device__ __forceinline__ float fast_rcp(float x) { return __builtin_amdgcn_rcpf(x); }
__device__ __forceinline__ float fast_sigmoid(float x) { return fast_rcp(1.0f + __expf(-x)); }
__device__ __forceinline__ float fast_tanh(float x) { return 1.0f - 2.0f * fast_rcp(1.0f + __expf(2.0f * x)); }
__device__ __forceinline__ void row16_sum4(float& a, float& b, float& c, float& d) {
    asm volatile(
        "s_nop 1\n\t"
        "v_add_f32_dpp %0, %0, %0 quad_perm:[1,0,3,2] row_mask:0xf bank_mask:0xf\n\t"
        "v_add_f32_dpp %1, %1, %1 quad_perm:[1,0,3,2] row_mask:0xf bank_mask:0xf\n\t"
        "v_add_f32_dpp %2, %2, %2 quad_perm:[1,0,3,2] row_mask:0xf bank_mask:0xf\n\t"
        "v_add_f32_dpp %3, %3, %3 quad_perm:[1,0,3,2] row_mask:0xf bank_mask:0xf\n\t"
        "v_add_f32_dpp %0, %0, %0 quad_perm:[2,3,0,1] row_mask:0xf bank_mask:0xf\n\t"
        "v_add_f32_dpp %1, %1, %1 quad_perm:[2,3,0,1] row_mask:0xf bank_mask:0xf\n\t"
        "v_add_f32_dpp %2, %2, %2 quad_perm:[2,3,0,1] row_mask:0xf bank_mask:0xf\n\t"
        "v_add_f32_dpp %3, %3, %3 quad_perm:[2,3,0,1] row_mask:0xf bank_mask:0xf\n\t"
        "v_add_f32_dpp %0, %0, %0 row_half_mirror row_mask:0xf bank_mask:0xf\n\t"
        "v_add_f32_dpp %1, %1, %1 row_half_mirror row_mask:0xf bank_mask:0xf\n\t"
        "v_add_f32_dpp %2, %2, %2 row_half_mirror row_mask:0xf bank_mask:0xf\n\t"
        "v_add_f32_dpp %3, %3, %3 row_half_mirror row_mask:0xf bank_mask:0xf\n\t"
        "v_add_f32_dpp %0, %0, %0 row_mirror row_mask:0xf bank_mask:0xf\n\t"
        "v_add_f32_dpp %1, %1, %1 row_mirror row_mask:0xf bank_mask:0xf\n\t"
        "v_add_f32_dpp %2, %2, %2 row_mirror row_mask:0xf bank_mask:0xf\n\t"
        "v_add_f32_dpp %3, %3, %3 row_mirror row_mask:0xf bank_mask:0xf\n\t"
        "s_nop 1"
        : "+v"(a), "+v"(b), "+v"(c), "+v"(d));
}
__device__ __forceinline__ float wave_sum_fast(float v) { v = row16_sum(v); v += __shfl_xor(v, 16); v += __shfl_xor(v, 32); return v; }
constexpr int SC_TC = 32;
constexpr int SC_ROWB = 1088;
__device__ __forceinline__ const unsigned char* scan_piece_src(const Params& p, int l, int b, int hc, int t0, int pi, bool& ok) {
    const int tau = pi / 68, seg = pi - tau * 68;
    const int t = t0 + tau;
    ok = (t < TS) && (tau < SC_TC);
    const size_t n = (size_t)b * TS + t;
    const unsigned char* ws = WS(p);
    if (seg < 8) return ws + OFF_PR + (n * 1024 + hc) * 2 + seg * 16;
    if (seg < 16) return ws + OFF_PK + (n * 1024 + hc) * 2 + (seg - 8) * 16;
    if (seg < 24) return ws + OFF_PV + (n * 1024 + hc) * 2 + (seg - 16) * 16;
    if (seg < 60) return OUTB(p) + DO_ALR + (n * 288) * 2 + (seg - 24) * 16;
    ok = ok && (l > 0);
    return ws + OFF_VFIRST + (n * 1024 + hc) * 2 + (seg - 60) * 16;
}
__device__ void phase_scan4(const Params& p, int l, unsigned char* lds, int blk) {
    const int tid = otid(), lane = tid & 63, wid = tid >> 6, fr = lane & 15, fq = lane >> 4;
    const int b = blk >> 4, hh = blk & 15, hc = hh * 64;
    float* s_r = (float*)lds;
    float* s_w = s_r + 2048;
    float* s_k = s_w + 2048;
    float* s_v = s_k + 2048;
    float* s_a = s_v + 2048;
    float* s_b = s_a + 2048;
    float* s_g = s_b + 2048;
    float* s_o = s_g + 2048;
    bf16_t* A_wd = (bf16_t*)(s_o + 2048);
    bf16_t* A_ad = A_wd + 2048;
    bf16_t* A_gd = A_ad + 2048;
    bf16_t* A_vd = A_gd + 4096;
    unsigned char* raw = (unsigned char*)(A_vd + 1024);
    float* prevb = (float*)(raw + 32 * SC_ROWB);
    float* cst = prevb + 960;
    const float* mu = p.in[4] + (size_t)l * 3328;
    for (int e = tid; e < 480; e += NTHR) {
        float v;
        if (e < 192) v = mu[(e >> 6) * 1024 + hc + (e & 63)];
        else if (e < 448) v = mu[3072 + (e - 192)];
        else v = p.in[18][e - 448];
        cst[e] = v;
    }
    if (tid < 64) {
        cst[480 + tid] = p.in[7][l * 1024 + hc + tid];
        cst[544 + tid] = p.in[9][l * 1024 + hc + tid];
        cst[608 + tid] = p.in[12][l * 1024 + hc + tid];
        cst[672 + tid] = p.in[13][l * 1024 + hc + tid];
        cst[736 + tid] = p.in[14][l * 1024 + hc + tid];
        cst[800 + tid] = p.in[15][l * 1024 + hc + tid];
        cst[864 + tid] = p.in[16][l * 1024 + hc + tid];
        cst[928 + tid] = p.in[19][hc + tid];
    }
    const int mm = wid >> 1, ntb = (wid & 1) * 2;
    const int nks = (mm == 2) ? 4 : (mm == 3 ? 1 : 2);
    bf16x8 Bw[2][4];
    {
        const float* wsrc = (mm == 0) ? p.in[8] + (size_t)l * 64 * 1024 : (mm == 1) ? p.in[10] + (size_t)l * 64 * 1024 : (mm == 2) ? p.in[11] + (size_t)l * 128 * 1024 : p.in[20];
#pragma unroll
        for (int n2 = 0; n2 < 2; ++n2)
#pragma unroll
            for (int ks = 0; ks < 4; ++ks) {
                bf16x8 f;
#pragma unroll
                for (int j = 0; j < 8; ++j) {
                    const bool okw = ks < nks && (mm < 3 || l > 0);
                    const float v = wsrc[(size_t)(okw ? (ks * 32 + fq * 8 + j) : 0) * 1024 + hc + (ntb + n2) * 16 + fr];
                    f[j] = (short)f2bf(okw ? v : 0.f);
                }
                Bw[n2][ks] = f;
            }
    }
    const int cg = lane & 15, rg = lane >> 4;
    float S0[4] = {0.f, 0.f, 0.f, 0.f}, S1[4] = {0.f, 0.f, 0.f, 0.f};
    bf16_t* Pr = (bf16_t*)(WS(p) + OFF_PR);
    bf16_t* vfirst = (bf16_t*)(WS(p) + OFF_VFIRST);
    uint4 pre[5];
#pragma unroll
    for (int k = 0; k < 5; ++k) {
        const int pi = tid + k * NTHR; bool ok = false; pre[k] = make_uint4(0, 0, 0, 0);
        if (pi < SC_TC * 68) { const unsigned char* src = scan_piece_src(p, l, b, hc, 0, pi, ok); if (ok) pre[k] = *(const uint4*)src; }
    }
    __syncthreads();
#pragma unroll 1
    for (int t0 = 0, ch = 0; t0 < TS; t0 += SC_TC, ++ch) {
        const int nval = (TS - t0 < SC_TC) ? (TS - t0) : SC_TC;
#pragma unroll
        for (int k = 0; k < 5; ++k) { const int pi = tid + k * NTHR; if (pi < SC_TC * 68) *(uint4*)(raw + pi * 16) = pre[k]; }
        lds_barrier();
#pragma unroll
        for (int k = 0; k < 5; ++k) {
            const int pi = tid + k * NTHR; bool ok = false; pre[k] = make_uint4(0, 0, 0, 0);
            if (pi < SC_TC * 68 && t0 + SC_TC < TS) { const unsigned char* src = scan_piece_src(p, l, b, hc, t0 + SC_TC, pi, ok); if (ok) pre[k] = *(const uint4*)src; }
        }
        {
            float* pwb = prevb + (ch & 1) * 192;
            const float* pvb = prevb + ((ch + 1) & 1) * 192;
            for (int it = tid; it < SC_TC * 96; it += NTHR) {
                const int tau = it / 96, c2 = (it - tau * 96) * 2;
                const unsigned cu = *(const unsigned*)(raw + tau * SC_ROWB + c2 * 2);
                const float c0 = __uint_as_float(cu << 16), c1 = __uint_as_float(cu & 0xFFFF0000u);
                float p0, p1;
                if (tau > 0) { const unsigned pu = *(const unsigned*)(raw + (tau - 1) * SC_ROWB + c2 * 2); p0 = __uint_as_float(pu << 16); p1 = __uint_as_float(pu & 0xFFFF0000u); }
                else if (t0 > 0) { p0 = pvb[c2]; p1 = pvb[c2 + 1]; }
                else { p0 = 0.f; p1 = 0.f; }
                if (tau == SC_TC - 1) { pwb[c2] = c0; pwb[c2 + 1] = c1; }
                const float x0 = c0 + (p0 - c0) * cst[c2], x1 = c1 + (p1 - c1) * cst[c2 + 1];
                float* dstv = (c2 < 64) ? (s_r + tau * 64 + c2) : (c2 < 128) ? (s_k + tau * 64 + c2 - 64) : (s_v + tau * 64 + c2 - 128);
                *(float2*)dstv = make_float2(x0, x1);
            }
        }
        if (mm < 3 || l > 0) {
            const unsigned char* Ab = raw + ((mm == 0) ? 384 : (mm == 1) ? 512 : (mm == 2) ? 640 : 896);
            float* dst = (mm == 0) ? s_w : (mm == 1) ? s_a : (mm == 2) ? s_g : s_o;
#pragma unroll
            for (int m = 0; m < 2; ++m) {
                f32x4 acc0 = {0.f, 0.f, 0.f, 0.f}, acc1 = {0.f, 0.f, 0.f, 0.f};
#pragma unroll
                for (int ks = 0; ks < 4; ++ks) {
                    if (ks < nks) {
                        const bf16x8 a = *(const bf16x8*)(Ab + (m * 16 + fr) * SC_ROWB + ks * 64 + fq * 16);
                        acc0 = __builtin_amdgcn_mfma_f32_16x16x32_bf16(a, Bw[0][ks], acc0, 0, 0, 0);
                        acc1 = __builtin_amdgcn_mfma_f32_16x16x32_bf16(a, Bw[1][ks], acc1, 0, 0, 0);
                    }
                }
#pragma unroll
                for (int j = 0; j < 4; ++j) {
                    dst[(m * 16 + fq * 4 + j) * 64 + ntb * 16 + fr] = acc0[j];
                    dst[(m * 16 + fq * 4 + j) * 64 + (ntb + 1) * 16 + fr] = acc1[j];
                }
            }
        }
        lds_barrier();
        for (int e = tid; e < SC_TC * 64; e += NTHR) {
            const int tau = e >> 6, c = e & 63, t = t0 + tau;
            const size_t n = (size_t)b * TS + t;
            const float xw = s_w[e] + cst[480 + c];
            const float decay = __expf(-0.6065306597126334f * fast_sigmoid(xw));
            const float a = fast_sigmoid(s_a[e] + cst[544 + c]);
            float vv = s_v[e];
            if (l > 0) {
                const float vf = bf2f(*(const bf16_t*)(raw + tau * SC_ROWB + 960 + c * 2));
                vv = vv + (vf - vv) * fast_sigmoid(s_o[e] + cst[928 + c]);
            } else if (t < TS) {
                vfirst[n * 1024 + hc + c] = f2bf(vv);
            }
            const float kraw = s_k[e];
            const float kkv = kraw * cst[608 + c];
            const float ss = wave_sum_fast(kkv * kkv);
            const float kk = kkv * rsqrtf(fmaxf(ss, 1e-24f));
            s_w[e] = decay;
            s_a[e] = -kk;
            s_b[e] = kk * a;
            s_k[e] = kraw * (1.0f + (a - 1.0f) * cst[672 + c]);
            s_v[e] = vv;
        }
        lds_barrier();
        {
            float4 a4 = *(const float4*)(s_a + cg * 4);
            float sa0 = S0[0] * a4.x + S0[1] * a4.y + S0[2] * a4.z + S0[3] * a4.w;
            float sa1 = S1[0] * a4.x + S1[1] * a4.y + S1[2] * a4.z + S1[3] * a4.w;
            float du0 = 0.f, du1 = 0.f;
            row16_sum4(sa0, sa1, du0, du1);
            float4 w4 = *(const float4*)(s_w + cg * 4);
            float4 b4 = *(const float4*)(s_b + cg * 4);
            float4 k4 = *(const float4*)(s_k + cg * 4);
            float4 r4 = *(const float4*)(s_r + cg * 4);
            float2 v2 = *(const float2*)(s_v + wid * 8 + rg * 2);
            float4 na4 = *(const float4*)(s_a + 64 + cg * 4);
#pragma unroll 1
            for (int tau = 0; tau < nval; ++tau) {
                const int tn = (tau + 1 < SC_TC) ? tau + 1 : tau, tn2 = (tau + 2 < SC_TC) ? tau + 2 : tau;
                const float4 nna4 = *(const float4*)(s_a + tn2 * 64 + cg * 4);
                const float4 nw4 = *(const float4*)(s_w + tn * 64 + cg * 4);
                const float4 nb4 = *(const float4*)(s_b + tn * 64 + cg * 4);
                const float4 nk4 = *(const float4*)(s_k + tn * 64 + cg * 4);
                const float4 nr4 = *(const float4*)(s_r + tn * 64 + cg * 4);
                const float2 nv2 = *(const float2*)(s_v + tn * 64 + wid * 8 + rg * 2);
                S0[0] = S0[0] * w4.x + (sa0 * b4.x + v2.x * k4.x); S0[1] = S0[1] * w4.y + (sa0 * b4.y + v2.x * k4.y);
                S0[2] = S0[2] * w4.z + (sa0 * b4.z + v2.x * k4.z); S0[3] = S0[3] * w4.w + (sa0 * b4.w + v2.x * k4.w);
                S1[0] = S1[0] * w4.x + (sa1 * b4.x + v2.y * k4.x); S1[1] = S1[1] * w4.y + (sa1 * b4.y + v2.y * k4.y);
                S1[2] = S1[2] * w4.z + (sa1 * b4.z + v2.y * k4.z); S1[3] = S1[3] * w4.w + (sa1 * b4.w + v2.y * k4.w);
                float o0 = S0[0] * r4.x + S0[1] * r4.y + S0[2] * r4.z + S0[3] * r4.w;
                float o1 = S1[0] * r4.x + S1[1] * r4.y + S1[2] * r4.z + S1[3] * r4.w;
                sa0 = S0[0] * na4.x + S0[1] * na4.y + S0[2] * na4.z + S0[3] * na4.w;
                sa1 = S1[0] * na4.x + S1[1] * na4.y + S1[2] * na4.z + S1[3] * na4.w;
                row16_sum4(sa0, sa1, o0, o1);
                if (cg == 0) *(float2*)(s_o + tau * 64 + wid * 8 + rg * 2) = make_float2(o0, o1);
                w4 = nw4; b4 = nb4; k4 = nk4; r4 = nr4; v2 = nv2; na4 = nna4;
            }
        }
        lds_barrier();
        for (int tau = wid; tau < nval; tau += 8) {
            const int c = lane, e = tau * 64 + c;
            const size_t n = (size_t)b * TS + t0 + tau;
            const float o = s_o[e];
            const float m_ = wave_sum_fast(o) * (1.0f / 64.0f);
            const float d = o - m_;
            const float var = wave_sum_fast(d * d) * (1.0f / 64.0f);
            const float on = d * rsqrtf(var + 64e-5f) * cst[800 + c] + cst[864 + c];
            const float bonus = wave_sum_fast(s_r[e] * s_k[e] * cst[736 + c]) * s_v[e];
            Pr[n * 1024 + hc + c] = f2bf((on + bonus) * s_g[e]);
        }
    }
}

__device__ void phase_merge(const Params& p, unsigned char* lds) {
    const int tid = otid(), lane = tid & 63, wid = tid >> 6, wr = wid >> 1, wc = wid & 1, fr = lane & 15, fq = lane >> 4;
    const bf16_t* h = (const bf16_t*)(WS(p) + OFF_H);
    const bf16_t* wb = (const bf16_t*)(WS(p) + OFF_WB);
    const float* rstd = (const float*)(WS(p) + OFF_RSTD);
    bf16_t* merged = (bf16_t*)(WS(p) + OFF_MERGED);
    const bf16_t* ysrc0 = (const bf16_t*)(WS(p) + OFF_PPOOL);
    const bf16_t* ysrc1 = (const bf16_t*)(WS(p) + OFF_PR);
    const bf16_t* ysrc2 = (const bf16_t*)(OUTB(p) + DO_YC);
    for (int tile = obid(); tile < 129 * 8; tile += gridDim.x) {
        const int mt = tile >> 3, nt = tile & 7;
        const int row0 = mt * 128, col0 = nt * 128;
        f32x4 macc[2][4]; g3_zero<2>(macc);
#pragma unroll 1
        for (int i = 0; i < 3; ++i) {
            f32x4 ag[2][4], ay[2][4]; g3_zero<2>(ag); g3_zero<2>(ay);
            const bf16_t* ys = (i == 0) ? ysrc0 : (i == 1 ? ysrc1 : ysrc2);
            G3<128> g;
            g3_setup<128>(g, [&](int r) { return h + (size_t)(row0 + r) * DM; }, [&](int r) { return wb + WB_WG + (size_t)(i * 1024 + col0 + r) * DM; }, tid);
            g3_kloop<128>(ag, g, DM, lds);
            g3_setup<128>(g, [&](int r) { return ys + (size_t)(row0 + r) * DM; }, [&](int r) { return wb + WB_PA + (size_t)(i * 1024 + col0 + r) * DM; }, tid);
            g3_kloop<128>(ay, g, DM, lds);
#pragma unroll
            for (int m = 0; m < 2; ++m) {
                const float rs = rstd[row0 + wr * 32 + m * 16 + fr];
#pragma unroll
                for (int n = 0; n < 4; ++n)
#pragma unroll
                    for (int j = 0; j < 4; ++j) macc[m][n][j] += sigmoidf_(ag[m][n][j] * rs) * ay[m][n][j];
            }
        }
#pragma unroll
        for (int m = 0; m < 2; ++m) {
            const int row = row0 + wr * 32 + m * 16 + fr;
#pragma unroll
            for (int n = 0; n < 4; ++n)
                *(uint2*)(merged + (size_t)row * 1024 + col0 + wc * 64 + n * 16 + fq * 4) = pack4(macc[m][n][0], macc[m][n][1], macc[m][n][2], macc[m][n][3]);
        }
    }
}

__device__ void phase_outproj(const Params& p, unsigned char* lds) {
    const int tid = otid(), lane = tid & 63, wid = tid >> 6, wr = wid >> 1, wc = wid & 1, fr = lane & 15, fq = lane >> 4;
    const bf16_t* h = (const bf16_t*)(WS(p) + OFF_H);
    const bf16_t* wb = (const bf16_t*)(WS(p) + OFF_WB);
    const bf16_t* merged = (const bf16_t*)(WS(p) + OFF_MERGED);
    float* hm = (float*)(WS(p) + OFF_HM32);
    for (int tile = obid(); tile < 129 * 8; tile += gridDim.x) {
        const int mt = tile >> 3, nt = tile & 7;
        const int row0 = mt * 128, col0 = nt * 128;
        G3<128> g;
        g3_setup<128>(g, [&](int r) { return merged + (size_t)(row0 + r) * DM; }, [&](int r) { return wb + WB_WO + (size_t)(col0 + r) * DM; }, tid);
        f32x4 acc[2][4]; g3_zero<2>(acc);
        g3_kloop<128>(acc, g, DM, lds);
#pragma unroll
        for (int m = 0; m < 2; ++m) {
            const int row = row0 + wr * 32 + m * 16 + fr;
#pragma unroll
            for (int n = 0; n < 4; ++n) {
                const int col = col0 + wc * 64 + n * 16 + fq * 4;
                const uint2 hv = *(const uint2*)(h + (size_t)row * 1024 + col);
                float4 o;
                o.x = __uint_as_float(hv.x << 16) + acc[m][n][0]; o.y = __uint_as_float(hv.x & 0xFFFF0000u) + acc[m][n][1];
                o.z = __uint_as_float(hv.y << 16) + acc[m][n][2]; o.w = __uint_as_float(hv.y & 0xFFFF0000u) + acc[m][n][3];
                *(float4*)(hm + (size_t)row * 1024 + col) = o;
            }
        }
    }
}

__device__ __constant__ int c_pair_lo[6] = {0, 0, 0, 1, 1, 2};
__device__ __constant__ int c_pair_hi[6] = {1, 2, 3, 2, 3, 3};
__device__ void phase_route(const Params& p, int l, unsigned char* lds) {
    const int tid = otid(), lane = tid & 63, wid = tid >> 6;
    const int per = (NT + (int)gridDim.x - 1) / (int)gridDim.x;
    const int nbeg = obid() * per, nend = (nbeg + per < NT) ? nbeg + per : NT;
    int* s_cls = (int*)lds;
    int* s_base = s_cls + 128;
    float* s_wr = (float*)(lds + 1024);
    const float* hm = (const float*)(WS(p) + OFF_HM32);
    bf16_t* hn = (bf16_t*)(WS(p) + OFF_HN);
    const float* nf = p.in[33] + (size_t)l * 1024;
    const float* wg = p.in[34] + (size_t)l * 1024 * 4;
    const float* bg = p.in[35] + l * 4;
    const float* we = p.in[36] + (size_t)l * 1024 * 16;
    const float* be = p.in[37] + l * 16;
    int* cnt = (int*)(WS(p) + OFF_CTL);
    int* list = (int*)(WS(p) + OFF_LIST);
    float* pw = (float*)(WS(p) + OFF_PW);
    for (int e = tid; e < 1024 * 20; e += NTHR) {
        const int k = e / 20, c = e - k * 20;
        s_wr[c * 1024 + k] = (c < 4) ? wg[(size_t)k * 4 + c] : we[(size_t)k * 16 + (c - 4)];
    }
    __syncthreads();
    for (int n = nbeg + wid; n < nend; n += 8) {
        float ss = 0.f;
#pragma unroll
        for (int i = 0; i < 4; ++i) {
            const float4 v = *(const float4*)(hm + (size_t)n * DM + i * 256 + lane * 4);
            ss += v.x * v.x + v.y * v.y + v.z * v.z + v.w * v.w;
        }
        ss = wave_sum(ss);
        const float rs = rsqrtf(ss * (1.0f / 1024.0f) + 1e-6f);
        float lg[4] = {0.f, 0.f, 0.f, 0.f};
        float le[16];
#pragma unroll
        for (int e = 0; e < 16; ++e) le[e] = 0.f;
#pragma unroll 1
        for (int i = 0; i < 4; ++i) {
            const float4 xv = *(const float4*)(hm + (size_t)n * DM + i * 256 + lane * 4);
            const float4 nv = *(const float4*)(nf + i * 256 + lane * 4);
            float y[4] = {xv.x * rs * nv.x, xv.y * rs * nv.y, xv.z * rs * nv.z, xv.w * rs * nv.w};
            {
                const int d0 = i * 256 + lane * 4;
#pragma unroll
                for (int g = 0; g < 4; ++g) { const float4 w4 = *(const float4*)(s_wr + g * 1024 + d0); lg[g] += y[0] * w4.x + y[1] * w4.y + y[2] * w4.z + y[3] * w4.w; }
#pragma unroll
                for (int e = 0; e < 16; ++e) { const float4 w4 = *(const float4*)(s_wr + (4 + e) * 1024 + d0); le[e] += y[0] * w4.x + y[1] * w4.y + y[2] * w4.z + y[3] * w4.w; }
            }
            ushort4 o;
            o.x = f2bf(y[0]); o.y = f2bf(y[1]); o.z = f2bf(y[2]); o.w = f2bf(y[3]);
            *(ushort4*)(hn + (size_t)n * DM + i * 256 + lane * 4) = o;
        }
#pragma unroll
        for (int g = 0; g < 4; ++g) lg[g] = wave_sum_fast(lg[g]) + bg[g];
#pragma unroll
        for (int e = 0; e < 16; ++e) le[e] = wave_sum_fast(le[e]) + be[e];
        if (lane == 0) {
            int gs = 0; float gm = lg[0];
#pragma unroll
            for (int g = 1; g < 4; ++g) if (lg[g] > gm) { gm = lg[g]; gs = g; }
            float den = 0.f;
#pragma unroll
            for (int g = 0; g < 4; ++g) den += __expf(lg[g] - gm);
            const float pgrp = 1.0f / den;
            float v4[4];
#pragma unroll
            for (int e = 0; e < 4; ++e) {
                const float m0 = (gs == 0) ? 1.f : 0.f, m1s = (gs == 1) ? 1.f : 0.f, m2s = (gs == 2) ? 1.f : 0.f, m3s = (gs == 3) ? 1.f : 0.f;
                v4[e] = le[e] * m0 + le[4 + e] * m1s + le[8 + e] * m2s + le[12 + e] * m3s;
            }
            int i1 = 0; float m1 = v4[0];
#pragma unroll
            for (int e = 1; e < 4; ++e) if (v4[e] > m1) { m1 = v4[e]; i1 = e; }
            int i2 = -1; float m2 = -INFINITY;
#pragma unroll
            for (int e = 0; e < 4; ++e) if (e != i1 && v4[e] > m2) { m2 = v4[e]; i2 = e; }
            const float e2 = __expf(m2 - m1);
            const float p1 = pgrp / (1.0f + e2), p2 = pgrp * e2 / (1.0f + e2);
            const int lo = i1 < i2 ? i1 : i2, hi = i1 < i2 ? i2 : i1;
            const float plo = i1 < i2 ? p1 : p2, phi = i1 < i2 ? p2 : p1;
            const int pi = (lo == 0) ? (hi - 1) : (lo == 1 ? hi + 1 : 5);
            const int cls = gs * 6 + pi;
            s_cls[n - nbeg] = cls;
            pw[(size_t)n * 2 + 0] = plo; pw[(size_t)n * 2 + 1] = phi;
        }
    }
    __syncthreads();
    const int nloc = nend - nbeg;
    if (tid < 24) {
        int c_ = 0;
        for (int i = 0; i < nloc; ++i) c_ += (s_cls[i] == tid) ? 1 : 0;
        s_base[tid] = c_ ? atomicAdd(&cnt[tid * 32], c_) : 0;
    }
    __syncthreads();
    if (tid < nloc) {
        const int cls = s_cls[tid];
        int rank = 0;
        for (int i = 0; i < tid; ++i) rank += (s_cls[i] == cls) ? 1 : 0;
        list[(size_t)cls * NT + s_base[cls] + rank] = nbeg + tid;
    }
    __syncthreads();
}


struct MoeTile { int cls, ti, cnt, tg; };
__device__ __forceinline__ int moe_total_tiles(const int* cnt) { int s = 0; for (int c = 0; c < 24; ++c) s += (cnt[c * 32] + 127) >> 7; return s; }
__device__ __forceinline__ MoeTile moe_find(const int* cnt, int tile) {
    MoeTile r; int s = 0; r.cls = 0; r.ti = 0; r.cnt = 0; r.tg = tile;
    for (int c = 0; c < 24; ++c) { const int nt = (cnt[c * 32] + 127) >> 7; if (tile >= s && tile < s + nt) { r.cls = c; r.ti = tile - s; r.cnt = cnt[c * 32]; } s += nt; }
    return r;
}
__device__ void phase_moe1(const Params& p, unsigned char* lds) {
    const int tid = otid(), lane = tid & 63, wid = tid >> 6, wr = wid >> 1, wc = wid & 1, fr = lane & 15, fq = lane >> 4;
    const int* cnt = (const int*)(WS(p) + OFF_CTL);
    const int* list = (const int*)(WS(p) + OFF_LIST);
    const float* pw = (const float*)(WS(p) + OFF_PW);
    const bf16_t* hn = (const bf16_t*)(WS(p) + OFF_HN);
    const bf16_t* we = (const bf16_t*)(WS(p) + OFF_WEXP);
    bf16_t* hid = (bf16_t*)(OUTB(p) + DO_HID);
    const int total = moe_total_tiles(cnt);
    for (int item = obid(); item < total * 4; item += gridDim.x) {
        const MoeTile mt = moe_find(cnt, item >> 2);
        const int nt = item & 3, slot = nt >> 1, f0 = (nt & 1) * 128;
        const int g_ = mt.cls / 6, pi = mt.cls % 6;
        const int e = g_ * 4 + (slot == 0 ? c_pair_lo[pi] : c_pair_hi[pi]);
        const int* lst = list + (size_t)mt.cls * NT + mt.ti * 128;
        const int nvalid = min(128, mt.cnt - mt.ti * 128);
        f32x4 a1[2][4], a3[2][4]; g3_zero<2>(a1); g3_zero<2>(a3);
        G3<128> g;
        g3_setup<128>(g, [&](int r) { return hn + (size_t)lst[r < nvalid ? r : 0] * DM; }, [&](int r) { return we + WE_W1 + ((size_t)e * 256 + f0 + r) * 1024; }, tid);
        g3_kloop<128>(a1, g, DM, lds);
        g3_setup<128>(g, [&](int r) { return hn + (size_t)lst[r < nvalid ? r : 0] * DM; }, [&](int r) { return we + WE_W3 + ((size_t)e * 256 + f0 + r) * 1024; }, tid);
        g3_kloop<128>(a3, g, DM, lds);
#pragma unroll
        for (int m = 0; m < 2; ++m) {
            const int lr = wr * 32 + m * 16 + fr;
            const int tk = lst[lr < nvalid ? lr : 0];
            const float pe = pw[(size_t)tk * 2 + slot];
#pragma unroll
            for (int n = 0; n < 4; ++n) {
                const int col = slot * 256 + f0 + wc * 64 + n * 16 + fq * 4;
                float o[4];
#pragma unroll
                for (int j = 0; j < 4; ++j) { const float x1 = a1[m][n][j]; o[j] = x1 * sigmoidf_(x1) * a3[m][n][j] * pe; }
                *(uint2*)(hid + ((size_t)mt.tg * 128 + lr) * 512 + col) = pack4(o[0], o[1], o[2], o[3]);
            }
        }
    }
}
__device__ void phase_moe2(const Params& p, unsigned char* lds) {
    const int tid = otid(), lane = tid & 63, wid = tid >> 6, wr = wid >> 1, wc = wid & 1, fr = lane & 15, fq = lane >> 4;
    const int* cnt = (const int*)(WS(p) + OFF_CTL);
    const int* list = (const int*)(WS(p) + OFF_LIST);
    const bf16_t* we = (const bf16_t*)(WS(p) + OFF_WEXP);
    const bf16_t* hid = (const bf16_t*)(OUTB(p) + DO_HID);
    float* hm = (float*)(WS(p) + OFF_HM32);
    bf16_t* h = (bf16_t*)(WS(p) + OFF_H);
    const int total = moe_total_tiles(cnt);
    for (int item = obid(); item < total * 8; item += gridDim.x) {
        const MoeTile mt = moe_find(cnt, item >> 3);
        const int nt = item & 7, col0 = nt * 128;
        const int g_ = mt.cls / 6, pi = mt.cls % 6;
        const int elo = g_ * 4 + c_pair_lo[pi], ehi = g_ * 4 + c_pair_hi[pi];
        const int* lst = list + (size_t)mt.cls * NT + mt.ti * 128;
        const int nvalid = min(128, mt.cnt - mt.ti * 128);
        f32x4 acc[2][4]; g3_zero<2>(acc);
        G3<128> g;
        g3_setup<128>(g, [&](int r) { return hid + ((size_t)mt.tg * 128 + r) * 512; }, [&](int r) { return we + WE_W2 + ((size_t)elo * 1024 + col0 + r) * 256; }, tid);
        g3_kloop<128>(acc, g, 256, lds);
        g3_setup<128>(g, [&](int r) { return hid + ((size_t)mt.tg * 128 + r) * 512 + 256; }, [&](int r) { return we + WE_W2 + ((size_t)ehi * 1024 + col0 + r) * 256; }, tid);
        g3_kloop<128>(acc, g, 256, lds);
#pragma unroll
        for (int m = 0; m < 2; ++m) {
            const int lr = wr * 32 + m * 16 + fr;
            if (lr < nvalid) {
                const int tk = lst[lr];
#pragma unroll
                for (int n = 0; n < 4; ++n) {
                    const int col = col0 + wc * 64 + n * 16 + fq * 4;
                    float4 v = *(const float4*)(hm + (size_t)tk * 1024 + col);
                    v.x += acc[m][n][0]; v.y += acc[m][n][1]; v.z += acc[m][n][2]; v.w += acc[m][n][3];
                    *(float4*)(hm + (size_t)tk * 1024 + col) = v;
                    *(uint2*)(h + (size_t)tk * 1024 + col) = pack4(v.x, v.y, v.z, v.w);
                }
            }
        }
    }
}

__device__ void phase_final(const Params& p) {
    const int lane = otid() & 63;
    const int wave = (obid() * NTHR + otid()) >> 6, nw = gridDim.x * NTHR / 64;
    const float* hm = (const float*)(WS(p) + OFF_HM32);
    const float* nf = p.in[41];
    for (int r = wave; r < NB * SEQ; r += nw) {
        const int b = r / SEQ, s = r % SEQ;
        const size_t n = (size_t)b * TS + NMETA + s;
        float4 v[4]; float ss = 0.f;
#pragma unroll
        for (int i = 0; i < 4; ++i) { v[i] = *(const float4*)(hm + n * DM + i * 256 + lane * 4); ss += v[i].x * v[i].x + v[i].y * v[i].y + v[i].z * v[i].z + v[i].w * v[i].w; }
        ss = wave_sum(ss);
        const float rs = rsqrtf(ss * (1.0f / 1024.0f) + 1e-6f);
#pragma unroll
        for (int i = 0; i < 4; ++i) {
            const float4 g = *(const float4*)(nf + i * 256 + lane * 4);
            float4 o; o.x = v[i].x * rs * g.x; o.y = v[i].y * rs * g.y; o.z = v[i].z * rs * g.z; o.w = v[i].w * rs * g.w;
            *(float4*)((float*)OUTB(p) + (size_t)r * DM + i * 256 + lane * 4) = o;
        }
    }
}


#define XB_TMO      128
#define XB_XCNT(j)  (256  + 64 * (j))
#define XB_XSUB(j)  (1280 + 64 * (j))
#define XB_XGEN(j)  (2304 + 64 * (j))
#define XB_TOP      3328
#define XB_TOPGEN   3392
#define XCD_BAR_WORDS 3456
#define XB_SPIN_CAP (1u << 22)
#define LAS __attribute__((address_space(3)))
__device__ __forceinline__ unsigned xb_ld(unsigned* p) { return __hip_atomic_load(p, __ATOMIC_RELAXED, __HIP_MEMORY_SCOPE_AGENT); }
__device__ __forceinline__ unsigned xb_add(unsigned* p, unsigned v) { return __hip_atomic_fetch_add(p, v, __ATOMIC_RELAXED, __HIP_MEMORY_SCOPE_AGENT); }
__device__ __forceinline__ unsigned xb_xcc_id() { return (unsigned)__builtin_amdgcn_s_getreg((3 << 11) | 20) & 0xFu; }
#define XB_SPIN(cond, bar) do { unsigned _sp = 0; while (cond) { __builtin_amdgcn_s_sleep(1); \
    if ((++_sp & 255u) == 0u) { if (xb_ld(&(bar)[XB_TMO])) break; if (_sp > XB_SPIN_CAP) { atomicAdd(&(bar)[XB_TMO], 1u); break; } } } } while (0)
struct XcdBarrier { unsigned* bar; unsigned x; volatile LAS unsigned* st; };
__device__ __forceinline__ XcdBarrier xcd_barrier_post(unsigned* bar, volatile LAS unsigned* st) {
    XcdBarrier b; b.bar = bar; b.x = xb_xcc_id(); b.st = st;
    if (threadIdx.x == 0) (void)xb_add(&bar[XB_XCNT(b.x)], 1u);
    return b;
}
__device__ __forceinline__ void xcd_barrier_complete(unsigned* bar, unsigned x, unsigned& nloc, unsigned& nx) {
    const unsigned G = gridDim.x * gridDim.y * gridDim.z;
    unsigned sum, cnt, mine, sp = 0u;
    for (;;) {
        sum = 0u; cnt = 0u; mine = 0u;
#pragma unroll
        for (unsigned j = 0; j < 16; ++j) { const unsigned c = xb_ld(&bar[XB_XCNT(j)]); sum += c; cnt += (c > 0u) ? 1u : 0u; mine = (j == x) ? c : mine; }
        if (sum == G) break;
        __builtin_amdgcn_s_sleep(1);
        if ((++sp & 255u) == 0u) { if (xb_ld(&bar[XB_TMO])) break; if (sp > XB_SPIN_CAP) { atomicAdd(&bar[XB_TMO], 1u); break; } }
    }
    nloc = mine > 0u ? mine : 1u; nx = cnt > 0u ? cnt : 1u;
}
__device__ __forceinline__ void xcd_barrier(const XcdBarrier& b) {
    asm volatile("s_waitcnt vmcnt(0)" ::: "memory");
    __syncthreads();
    if (threadIdx.x == 0) {
        unsigned* bar = b.bar;
        __builtin_amdgcn_s_waitcnt(0);
        unsigned nloc = b.st[0], nx = b.st[1];
        if (nloc == 0u) { xcd_barrier_complete(bar, b.x, nloc, nx); b.st[0] = nloc; b.st[1] = nx; }
        const unsigned old = xb_add(&bar[XB_XSUB(b.x)], 1u);
        const unsigned gen = old / nloc;
        if (old + 1u == (gen + 1u) * nloc) {
            __builtin_amdgcn_fence(__ATOMIC_RELEASE, "agent");
            asm volatile("s_waitcnt vmcnt(0)" ::: "memory");
            const unsigned og = xb_add(&bar[XB_TOP], 1u);
            const unsigned tg = og / nx;
            if (og + 1u == (tg + 1u) * nx) xb_add(&bar[XB_TOPGEN], 1u);
            else XB_SPIN(xb_ld(&bar[XB_TOPGEN]) == tg, bar);
            __builtin_amdgcn_fence(__ATOMIC_ACQUIRE, "agent");
            xb_add(&bar[XB_XGEN(b.x)], 1u);
            asm volatile("s_waitcnt vmcnt(0)" ::: "memory");
        } else {
            XB_SPIN(xb_ld(&bar[XB_XGEN(b.x)]) == gen, bar);
            __builtin_amdgcn_fence(__ATOMIC_ACQUIRE, "agent");
            asm volatile("s_waitcnt vmcnt(0)" ::: "memory");
        }
    }
    __syncthreads();
}

__global__ void __launch_bounds__(NTHR) fwd_megakernel(Params p) {
    extern __shared__ __attribute__((aligned(16))) unsigned char lds[];
    cg::grid_group grid = cg::this_grid();
    volatile LAS unsigned* xst = (volatile LAS unsigned*)(lds + LDS_BYTES - 32);
    if (threadIdx.x < 2) xst[threadIdx.x] = 0u;
    __syncthreads();
    const XcdBarrier xb = xcd_barrier_post((unsigned*)(p.ws + OFF_BAR), xst);
#pragma unroll 1
    for (int step = 0; step < 18; ++step) {
        const int l = step >= 9 ? 1 : 0;
        const int ph = step - l * 9;
        switch (ph) {
        case 0:
            if (l == 0) phase_embed(p); else phase_rowstat(p);
            phase_convert<false>(p, l, lds);
            if (obid() == 0 && otid() < 24) ((int*)(WS(p) + OFF_CTL))[otid() * 32] = 0;
            if (obid() == 0 && otid() == 32) ((int*)(WS(p) + OFF_CTL))[800 + l * 32] = 0;
            break;
        case 1: phase_inproj(p, lds); break;
        case 2: phase_dsa_prep(p, l); phase_lr_prep(p, l); break;
        case 3: {
            if (obid() < NB * 16) phase_scan4(p, l, lds, obid());
            int* qctr = (int*)(WS(p) + OFF_CTL) + 800 + l * 32;
            int* qslot = (int*)(lds + LDS_BYTES - 16);
            for (;;) {
                __syncthreads();
                if (otid() == 0) *qslot = atomicAdd(qctr, 1);
                __syncthreads();
                const int item = *qslot;
                if (item >= 516 + NT / 16) break;
                if (item < 516) phase_pool(p, l, lds, item, item + 1, 1);
                else phase_dsa<false>(p, l, lds, (bf16_t*)(OUTB(p) + DO_YC), nullptr, nullptr, item - 516, item - 515, 1);
            }
        } break;
        case 4: phase_merge(p, lds); break;
        case 5: phase_outproj(p, lds); phase_convert<true>(p, l, lds); break;
        case 6: phase_route(p, l, lds); break;
        case 7: phase_moe1(p, lds); break;
        default: phase_moe2(p, lds); break;
        }
        if (step == 0) grid.sync(); else xcd_barrier(xb);
    }
    phase_final(p);
}

extern "C" void kernel_launch(void* const* d_in, const int* in_sizes, int n_in,
                              void* d_out, int out_size, void* d_ws, size_t ws_size,
                              hipStream_t stream) {
    static int grid_blocks = 0;
    if (grid_blocks == 0) {
        int dev = 0, cus = 0, per_cu = 0;
        (void)hipGetDevice(&dev);
        (void)hipDeviceGetAttribute(&cus, hipDeviceAttributeMultiprocessorCount, dev);
        (void)hipFuncSetAttribute((const void*)fwd_megakernel, hipFuncAttributeMaxDynamicSharedMemorySize, LDS_BYTES);
        (void)hipOccupancyMaxActiveBlocksPerMultiprocessor(&per_cu, fwd_megakernel, NTHR, LDS_BYTES);
        if (per_cu < 1 || n_in != 42 || ws_size < WS_END) { fprintf(stderr, "kernel_launch: bad config per_cu=%d n_in=%d ws=%zu need=%zu\n", per_cu, n_in, ws_size, (size_t)WS_END); grid_blocks = -1; }
        else grid_blocks = cus;
    }
    if (grid_blocks < 0) return;
    Params p{};
    for (int i = 0; i < 42; ++i) p.in[i] = (const float*)d_in[i];
    p.out = (float*)d_out;
    p.ws = (unsigned char*)d_ws;
    (void)hipMemsetAsync((unsigned char*)d_ws + OFF_BAR, 0, XCD_BAR_WORDS * 4, stream);
    void* args[] = {&p};
    hipError_t e = hipLaunchCooperativeKernel((void*)fwd_megakernel, dim3(grid_blocks), dim3(NTHR), args, LDS_BYTES, stream);
    if (e != hipSuccess) fprintf(stderr, "cooperative launch failed: %s (grid %d)\n", hipGetErrorString(e), grid_blocks);
}
```

```cpp
#include <hip/hip_runtime.h>
#include <hip/hip_cooperative_groups.h>
#include <cstdio>
#include <cstdint>
#include <type_traits>
namespace cg = cooperative_groups;

typedef unsigned short bf16_t;
typedef short bf16x8 __attribute__((ext_vector_type(8)));
typedef float f32x4 __attribute__((ext_vector_type(4)));

constexpr int NB = 8, SEQ = 2048, NMETA = 16, TS = 2064, DM = 1024;
constexpr int NT = NB * TS;
constexpr int NTP = 16640;
constexpr int NTHR = 512;
constexpr int CIN = 7912;
constexpr int NP1 = 4992;
constexpr int PM_LD = 896;
constexpr int PM_WD = 0, PM_AD = 64, PM_GD = 128, PM_VD = 256, PM_CQ = 320, PM_CKV = 576, PM_KROPE = 704, PM_KIDX = 736, PM_WIDX = 800;
constexpr int LDS_BYTES = 157 * 1024;

constexpr size_t AL(size_t x) { return (x + 255) & ~(size_t)255; }
constexpr size_t SZ_ACT = (size_t)NTP * 1024 * 2;
constexpr size_t OFF_CTL = 0;
constexpr size_t OFF_BAR = 4096;
constexpr size_t OFF_RSTD = OFF_BAR + 16384;
constexpr size_t OFF_ROPE = OFF_RSTD + AL((size_t)NTP * 4);
constexpr size_t OFF_H = OFF_ROPE + AL((size_t)TS * 16 * 4 * 2);
constexpr size_t OFF_WB = OFF_H + SZ_ACT;
constexpr size_t WB_WIN = 0;
constexpr size_t WB_WG = WB_WIN + (size_t)NP1 * 1024;
constexpr size_t WB_PA = WB_WG + (size_t)3072 * 1024;
constexpr size_t WB_WO = WB_PA + (size_t)3 * 1024 * 1024;
constexpr size_t WB_POOL = WB_WO + (size_t)1024 * 1024;
constexpr size_t WB_QI = WB_POOL + (size_t)4 * 256 * 256;
constexpr size_t WB_UQ = WB_QI + (size_t)512 * 256;
constexpr size_t WB_UK = WB_UQ + (size_t)1536 * 256;
constexpr size_t WB_UV = WB_UK + (size_t)16 * 128 * 64;
constexpr size_t WB_END = WB_UV + (size_t)16 * 64 * 128;
constexpr size_t OFF_PPOOL = OFF_WB + AL(WB_END * 2);
constexpr size_t OFF_PK = OFF_PPOOL + SZ_ACT;
constexpr size_t OFF_PR = OFF_PK + SZ_ACT;
constexpr size_t OFF_PV = OFF_PR + SZ_ACT;
constexpr size_t OFF_PMISC = OFF_PV + SZ_ACT;
constexpr size_t OFF_VFIRST = OFF_PMISC + AL((size_t)NTP * PM_LD * 2);
constexpr size_t OFF_HALO = OFF_VFIRST + SZ_ACT;
constexpr size_t OFF_LIST = OFF_HALO + AL((size_t)130 * 16 * 1024 * 2);
constexpr size_t OFF_PW = OFF_LIST + AL((size_t)24 * NT * 4);
constexpr size_t WS_END = OFF_PW + AL((size_t)NT * 2 * 4);
constexpr size_t OFF_MERGED = OFF_PK;
constexpr size_t OFF_HM32 = OFF_PR;
constexpr size_t OFF_HN = OFF_PPOOL;
constexpr size_t OFF_WEXP = OFF_PMISC;
constexpr size_t WE_W1 = 0, WE_W3 = (size_t)16 * 256 * 1024, WE_W2 = (size_t)2 * 16 * 256 * 1024;
static_assert((size_t)3 * 16 * 256 * 1024 * 2 <= (size_t)NTP * PM_LD * 2, "expert weights must fit in Pmisc");
constexpr size_t DO_YC = 0;
constexpr size_t DO_CQN = DO_YC + SZ_ACT;
constexpr size_t DO_KV = DO_CQN + AL((size_t)NT * 256 * 2);
constexpr size_t DO_KIDX = DO_KV + AL((size_t)NT * 160 * 2);
constexpr size_t DO_WHEAD = DO_KIDX + AL((size_t)NT * 64 * 2);
constexpr size_t DO_ALR = DO_WHEAD + AL((size_t)NT * 8 * 4);
constexpr size_t DO_END = DO_ALR + AL((size_t)NT * 288 * 2);
constexpr size_t DO_HID = DO_YC;
static_assert(DO_END <= (size_t)NB * SEQ * DM * 4, "d_out scratch overflow");
static_assert((size_t)(129 + 24) * 128 * 512 * 2 <= SZ_ACT, "hid fits");
static_assert(WS_END <= 277240096ull, "workspace overflow");

struct Params {
    const float* in[42];
    float* out;
    unsigned char* ws;
};

__device__ __forceinline__ int otid() { int t = threadIdx.x; asm volatile("" : "+v"(t)); return t; }
__device__ __forceinline__ int obid() { int b = blockIdx.x; asm volatile("" : "+s"(b)); return b; }
__device__ __forceinline__ unsigned char* WS(const Params& p) { unsigned char* w = p.ws; asm volatile("" : "+s"(w)); return w; }
__device__ __forceinline__ unsigned char* OUTB(const Params& p) { unsigned char* w = (unsigned char*)p.out; asm volatile("" : "+s"(w)); return w; }
__device__ __forceinline__ float bf2f(bf16_t v) { return __uint_as_float(((unsigned)v) << 16); }
__device__ __forceinline__ bf16_t f2bf(float f) { unsigned u = __float_as_uint(f); u += 0x7FFFu + ((u >> 16) & 1u); return (bf16_t)(u >> 16); }
__device__ __forceinline__ float wave_sum(float v) {
#pragma unroll
    for (int o = 32; o > 0; o >>= 1) v += __shfl_xor(v, o);
    return v;
}
__device__ __forceinline__ float sigmoidf_(float x) { return 1.0f / (1.0f + __expf(-x)); }
__device__ __forceinline__ float softplusf_(float z) { return fmaxf(z, 0.f) + log1pf(__expf(-fabsf(z))); }
__device__ __forceinline__ void glds16(const void* g, void* l) {
    __builtin_amdgcn_global_load_lds((const unsigned*)g, (unsigned*)l, 16, 0, 0);
}

__device__ void phase_embed(const Params& p) {
    const int lane = otid() & 63;
    const int wave = (obid() * NTHR + otid()) >> 6, nw = gridDim.x * NTHR / 64;
    bf16_t* h = (bf16_t*)(WS(p) + OFF_H);
    float* rstd = (float*)(WS(p) + OFF_RSTD);
    for (int n = wave; n < NTP; n += nw) {
        if (n < NT) {
            const int b = n / TS, t = n % TS;
            const float* src = t < NMETA ? p.in[1] + (size_t)t * DM : p.in[0] + ((size_t)b * SEQ + (t - NMETA)) * DM;
            float ss = 0.f;
#pragma unroll
            for (int i = 0; i < 4; ++i) {
                const float4 v = *(const float4*)(src + i * 256 + lane * 4);
                ss += v.x * v.x + v.y * v.y + v.z * v.z + v.w * v.w;
                ushort4 o; o.x = f2bf(v.x); o.y = f2bf(v.y); o.z = f2bf(v.z); o.w = f2bf(v.w);
                *(ushort4*)(h + (size_t)n * DM + i * 256 + lane * 4) = o;
            }
            ss = wave_sum(ss);
            if (lane == 0) rstd[n] = rsqrtf(ss * (1.0f / 1024.0f) + 1e-6f);
        } else {
#pragma unroll
            for (int i = 0; i < 4; ++i) *(ushort4*)(h + (size_t)n * DM + i * 256 + lane * 4) = make_ushort4(0, 0, 0, 0);
            if (lane == 0) rstd[n] = 0.f;
        }
    }
    float* ctab = (float*)(WS(p) + OFF_ROPE);
    float* stab = ctab + TS * 16;
    for (int idx = obid() * NTHR + otid(); idx < TS * 16; idx += gridDim.x * NTHR) {
        const int t = idx >> 4, i = idx & 15;
        const float inv = powf(10000.0f, -(float)(2 * i) / 32.0f);
        const float ang = (float)t * inv;
        ctab[idx] = cosf(ang);
        stab[idx] = sinf(ang);
    }
}

__device__ void phase_rowstat(const Params& p) {
    const int lane = otid() & 63;
    const int wave = (obid() * NTHR + otid()) >> 6, nw = gridDim.x * NTHR / 64;
    const float* hm = (const float*)(WS(p) + OFF_HM32);
    float* rstd = (float*)(WS(p) + OFF_RSTD);
    for (int n = wave; n < NT; n += nw) {
        float ss = 0.f;
#pragma unroll
        for (int i = 0; i < 4; ++i) {
            const float4 v = *(const float4*)(hm + (size_t)n * DM + i * 256 + lane * 4);
            ss += v.x * v.x + v.y * v.y + v.z * v.z + v.w * v.w;
        }
        ss = wave_sum(ss);
        if (lane == 0) rstd[n] = rsqrtf(ss * (1.0f / 1024.0f) + 1e-6f);
    }
}

struct ConvJob { const float* src; bf16_t* dst; const float* scale; int ldsrc, K, nvalid, nrows, nb, notr; size_t sbs, dbs; };
__device__ __forceinline__ int conv_job_tiles(const ConvJob& j) { return j.nb * (j.nrows >> 6) * (j.K >> 6); }
__device__ void conv_tile(const ConvJob& j, int tile, float* lds) {
    const int per = (j.nrows >> 6) * (j.K >> 6);
    const int bi = tile / per, rem = tile % per;
    const int ktiles = j.K >> 6;
    const int n0 = (rem / ktiles) << 6, k0 = (rem % ktiles) << 6;
    const int tid = otid(), tn = tid & 63, tk = tid >> 6;
    const float* src = j.src + (size_t)bi * j.sbs;
    bf16_t* dst = j.dst + (size_t)bi * j.dbs;
#pragma unroll
    for (int kk = 0; kk < 8; ++kk) {
        const int k = k0 + tk * 8 + kk;
        float v = 0.f;
        if (n0 + tn < j.nvalid) { v = j.notr ? src[(size_t)(n0 + tn) * j.ldsrc + k] : src[(size_t)k * j.ldsrc + n0 + tn]; if (j.scale) v *= j.scale[k]; }
        lds[tn * 65 + tk * 8 + kk] = v;
    }
    __syncthreads();
    const int wn = tid >> 3, kq = tid & 7;
    uint4 o;
    unsigned w[4];
#pragma unroll
    for (int q = 0; q < 4; ++q) {
        const float lo = lds[wn * 65 + kq * 8 + 2 * q], hi = lds[wn * 65 + kq * 8 + 2 * q + 1];
        w[q] = (unsigned)f2bf(lo) | ((unsigned)f2bf(hi) << 16);
    }
    o.x = w[0]; o.y = w[1]; o.z = w[2]; o.w = w[3];
    *(uint4*)(dst + (size_t)(n0 + wn) * j.K + k0 + kq * 8) = o;
    __syncthreads();
}
__device__ ConvJob get_job_early(const Params& p, int l, int ji) {
    bf16_t* wb = (bf16_t*)(WS(p) + OFF_WB);
    const float* win = p.in[3] + (size_t)l * DM * CIN;
    const float* nm = p.in[2] + (size_t)l * DM;
    ConvJob j{}; j.nb = 1; j.sbs = 0; j.dbs = 0; j.K = 1024; j.ldsrc = CIN; j.scale = nm;
    switch (ji) {
    case 0: j.src = win + 3072; j.dst = wb + WB_WIN; j.nvalid = 4352; j.nrows = 4352; break;
    case 1: j.src = p.in[17]; j.ldsrc = 32; j.dst = wb + WB_WIN + (size_t)(4096 + PM_VD) * 1024; j.nvalid = (l == 0 ? 0 : 32); j.nrows = 64; break;
    case 2: j.src = win + 7424; j.dst = wb + WB_WIN + (size_t)(4096 + PM_CQ) * 1024; j.nvalid = 488; j.nrows = 576; break;
    case 3: j.src = win; j.dst = wb + WB_WG; j.nvalid = 3072; j.nrows = 3072; break;
    case 4: j.src = p.in[29] + (size_t)l * DM * DM; j.ldsrc = 1024; j.scale = nullptr; j.dst = wb + WB_PA; j.nvalid = 1024; j.nrows = 1024; break;
    case 5: j.src = p.in[30] + (size_t)l * DM * DM; j.ldsrc = 1024; j.scale = nullptr; j.dst = wb + WB_PA + (size_t)1024 * 1024; j.nvalid = 1024; j.nrows = 1024; break;
    case 6: j.src = p.in[31] + (size_t)l * DM * DM; j.ldsrc = 1024; j.scale = nullptr; j.dst = wb + WB_PA + (size_t)2 * 1024 * 1024; j.nvalid = 1024; j.nrows = 1024; break;
    case 7: j.src = p.in[32] + (size_t)l * DM * DM; j.ldsrc = 1024; j.scale = nullptr; j.dst = wb + WB_WO; j.nvalid = 1024; j.nrows = 1024; break;
    case 8: j.src = p.in[5] + (size_t)l * 4 * 256 * 256; j.ldsrc = 256; j.K = 256; j.scale = nullptr; j.dst = wb + WB_POOL; j.nvalid = 256; j.nrows = 256; j.nb = 4; j.sbs = 65536; j.dbs = 65536; break;
    case 9: j.src = p.in[26] + (size_t)l * 256 * 512; j.ldsrc = 512; j.K = 256; j.scale = nullptr; j.dst = wb + WB_QI; j.nvalid = 512; j.nrows = 512; break;
    case 10: j.src = p.in[23] + (size_t)l * 256 * 1536; j.ldsrc = 1536; j.K = 256; j.scale = nullptr; j.dst = wb + WB_UQ; j.nvalid = 1536; j.nrows = 1536; break;
    case 11: j.src = p.in[24] + (size_t)l * 16 * 128 * 64; j.ldsrc = 64; j.K = 64; j.scale = nullptr; j.dst = wb + WB_UK; j.nvalid = 2048; j.nrows = 2048; j.notr = 1; break;
    default: j.src = p.in[25] + (size_t)l * 16 * 128 * 64; j.ldsrc = 64; j.K = 128; j.scale = nullptr; j.dst = wb + WB_UV; j.nvalid = 64; j.nrows = 64; j.nb = 16; j.sbs = 8192; j.dbs = 8192; break;
    }
    return j;
}
__device__ ConvJob get_job_late(const Params& p, int l, int ji) {
    bf16_t* we = (bf16_t*)(WS(p) + OFF_WEXP);
    ConvJob j{}; j.nb = 16; j.scale = nullptr; j.sbs = 262144; j.dbs = 262144;
    switch (ji) {
    case 0: j.src = p.in[38] + (size_t)l * 16 * 262144; j.dst = we + WE_W1; j.ldsrc = 256; j.K = 1024; j.nvalid = 256; j.nrows = 256; break;
    case 1: j.src = p.in[39] + (size_t)l * 16 * 262144; j.dst = we + WE_W3; j.ldsrc = 256; j.K = 1024; j.nvalid = 256; j.nrows = 256; break;
    default: j.src = p.in[40] + (size_t)l * 16 * 262144; j.dst = we + WE_W2; j.ldsrc = 1024; j.K = 256; j.nvalid = 1024; j.nrows = 1024; break;
    }
    return j;
}
template <bool LATE>
__device__ void phase_convert(const Params& p, int l, unsigned char* lds) {
    const int njobs = LATE ? 3 : 13;
    int base = 0;
    for (int ji = 0; ji < njobs; ++ji) {
        const ConvJob j = LATE ? get_job_late(p, l, ji) : get_job_early(p, l, ji);
        const int nt = conv_job_tiles(j);
        int first = ((int)obid() - base) % (int)gridDim.x; if (first < 0) first += gridDim.x;
        for (int t = first; t < nt; t += gridDim.x) conv_tile(j, t, (float*)lds);
        base += nt;
    }
}

template <int BM> struct G3 {
    static constexpr int MI = BM / 64;
    static constexpr int NA = BM / 64;
    static constexpr int STAGE = BM * 128 + 128 * 128;
    const bf16_t* ap[NA];
    const bf16_t* bp[2];
};
template <int BM>
__device__ __forceinline__ void g3_issue(const G3<BM>& g, int kt, unsigned char* stage, int tid) {
#pragma unroll
    for (int i = 0; i < G3<BM>::NA; ++i) glds16(g.ap[i] + kt * 64, stage + (tid + i * NTHR) * 16);
#pragma unroll
    for (int i = 0; i < 2; ++i) glds16(g.bp[i] + kt * 64, stage + BM * 128 + (tid + i * NTHR) * 16);
}
template <int BM, class FA, class FB>
__device__ __forceinline__ void g3_setup(G3<BM>& g, FA rowptr, FB bcol, int tid) {
#pragma unroll
    for (int i = 0; i < G3<BM>::NA; ++i) { const int idx = tid + i * NTHR, row = idx >> 3, sl = (idx & 7) ^ (row & 7); g.ap[i] = rowptr(row) + sl * 8; }
#pragma unroll
    for (int i = 0; i < 2; ++i) { const int idx = tid + i * NTHR, row = idx >> 3, sl = (idx & 7) ^ (row & 7); g.bp[i] = bcol(row) + sl * 8; }
}
template <int BM>
__device__ __forceinline__ void g3_kloop(f32x4 (&acc)[BM / 64][4], const G3<BM>& g, int K, unsigned char* lds) {
    constexpr int MI = G3<BM>::MI, STAGE = G3<BM>::STAGE, NL = G3<BM>::NA + 2;
    const int tid = otid(), lane = tid & 63, wid = tid >> 6, wr = wid >> 1, wc = wid & 1, fr = lane & 15, fq = lane >> 4;
    const int nk = K >> 6;
    g3_issue<BM>(g, 0, lds, tid);
    if (nk > 1) g3_issue<BM>(g, 1, lds + STAGE, tid);
    int cur = 0;
#pragma unroll 1
    for (int t = 0; t < nk; ++t) {
        if (t + 1 < nk) { if (NL == 6) asm volatile("s_waitcnt vmcnt(6)" ::: "memory"); else if (NL == 5) asm volatile("s_waitcnt vmcnt(5)" ::: "memory"); else asm volatile("s_waitcnt vmcnt(4)" ::: "memory"); }
        else asm volatile("s_waitcnt vmcnt(0)" ::: "memory");
        __builtin_amdgcn_s_barrier();
        if (t + 2 < nk) { int nx = cur + 2; if (nx >= 3) nx -= 3; g3_issue<BM>(g, t + 2, lds + nx * STAGE, tid); }
        const unsigned char* cA = lds + cur * STAGE;
        const unsigned char* cB = cA + BM * 128;
#pragma unroll
        for (int ks = 0; ks < 2; ++ks) {
            bf16x8 a[MI], b[4];
#pragma unroll
            for (int m = 0; m < MI; ++m) { const int row = wr * (BM / 4) + m * 16 + fr; a[m] = *(const bf16x8*)(cA + row * 128 + (((ks * 4 + fq) ^ (row & 7)) << 4)); }
#pragma unroll
            for (int n = 0; n < 4; ++n) { const int row = wc * 64 + n * 16 + fr; b[n] = *(const bf16x8*)(cB + row * 128 + (((ks * 4 + fq) ^ (row & 7)) << 4)); }
#pragma unroll
            for (int m = 0; m < MI; ++m)
#pragma unroll
                for (int n = 0; n < 4; ++n) acc[m][n] = __builtin_amdgcn_mfma_f32_16x16x32_bf16(b[n], a[m], acc[m][n], 0, 0, 0);
        }
        cur = (cur == 2) ? 0 : cur + 1;
    }
    __builtin_amdgcn_s_barrier();
}
template <int MI>
__device__ __forceinline__ void g3_zero(f32x4 (&acc)[MI][4]) {
#pragma unroll
    for (int m = 0; m < MI; ++m)
#pragma unroll
        for (int n = 0; n < 4; ++n) acc[m][n] = (f32x4){0.f, 0.f, 0.f, 0.f};
}
__device__ __forceinline__ uint2 pack4(float a, float b, float c, float d) {
    uint2 r; r.x = (unsigned)f2bf(a) | ((unsigned)f2bf(b) << 16); r.y = (unsigned)f2bf(c) | ((unsigned)f2bf(d) << 16); return r;
}

__device__ void phase_inproj(const Params& p, unsigned char* lds) {
    const int tid = otid(), lane = tid & 63, wid = tid >> 6, wr = wid >> 1, wc = wid & 1, fr = lane & 15, fq = lane >> 4;
    const bf16_t* h = (const bf16_t*)(WS(p) + OFF_H);
    const bf16_t* wt = (const bf16_t*)(WS(p) + OFF_WB) + WB_WIN;
    const float* rstd = (const float*)(WS(p) + OFF_RSTD);
    bf16_t* halo = (bf16_t*)(WS(p) + OFF_HALO);
    constexpr int NTN = NP1 / 128;
    for (int tile = obid(); tile < 65 * NTN; tile += gridDim.x) {
        const int mt = tile / NTN, nt = tile % NTN;
        const int row0 = mt * 256, col0 = nt * 128;
        G3<256> g;
        g3_setup<256>(g, [&](int r) { return h + (size_t)(row0 + r) * DM; }, [&](int r) { return wt + (size_t)(col0 + r) * DM; }, tid);
        f32x4 acc[4][4]; g3_zero<4>(acc);
        g3_kloop<256>(acc, g, DM, lds);
        bf16_t* dst; int ld, cbase;
        if (nt < 8) { dst = (bf16_t*)(WS(p) + OFF_PPOOL); ld = 1024; cbase = 0; }
        else if (nt < 16) { dst = (bf16_t*)(WS(p) + OFF_PR); ld = 1024; cbase = 1024; }
        else if (nt < 24) { dst = (bf16_t*)(WS(p) + OFF_PK); ld = 1024; cbase = 2048; }
        else if (nt < 32) { dst = (bf16_t*)(WS(p) + OFF_PV); ld = 1024; cbase = 3072; }
        else { dst = (bf16_t*)(WS(p) + OFF_PMISC); ld = PM_LD; cbase = 4096; }
#pragma unroll
        for (int m = 0; m < 4; ++m) {
            const int row = row0 + wr * 64 + m * 16 + fr;
            if (row < NT) {
                const float rs = rstd[row];
                const int lr = row & 127;
#pragma unroll
                for (int n = 0; n < 4; ++n) {
                    const int col = col0 + wc * 64 + n * 16 + fq * 4;
                    const uint2 v = pack4(acc[m][n][0] * rs, acc[m][n][1] * rs, acc[m][n][2] * rs, acc[m][n][3] * rs);
                    *(uint2*)(dst + (size_t)row * ld + (col - cbase)) = v;
                    if (nt < 8 && lr >= 112) *(uint2*)(halo + ((size_t)(row >> 7) * 16 + (lr - 112)) * 1024 + col) = v;
                }
            }
        }
    }
}

__device__ void phase_pool(const Params& p, int l, unsigned char* lds, int tb, int te, int tstep) {
    const int tid = otid(), lane = tid & 63, wid = tid >> 6, fr = lane & 15, fq = lane >> 4;
    bf16_t* pp = (bf16_t*)(WS(p) + OFF_PPOOL);
    const bf16_t* halo = (const bf16_t*)(WS(p) + OFF_HALO);
    const bf16_t* pw = (const bf16_t*)(WS(p) + OFF_WB) + WB_POOL;
    const float* scale = p.in[6] + (size_t)l * 1024;
    bf16_t* sp = (bf16_t*)lds;
    constexpr int SLD = 264;
    for (int tile = tb; tile < te; tile += tstep) {
        const int mt = tile >> 2, g = tile & 3;
        const int row0 = mt * 128, w = 2 << g;
        for (int e = tid; e < 128 * 256; e += NTHR) {
            const int r = e >> 8, c = e & 255;
            const int n = row0 + r, t = n % TS;
            const int col = g * 256 + c;
            const int cnt = (t + 1 < w) ? (t + 1) : w;
            float s = 0.f, self = 0.f;
            for (int i = 0; i < cnt; ++i) {
                const int n2 = n - i;
                float v;
                if (n2 >= row0) v = bf2f(pp[(size_t)n2 * 1024 + col]);
                else v = bf2f(halo[((size_t)(n2 >> 7) * 16 + ((n2 & 127) - 112)) * 1024 + col]);
                if (i == 0) self = v;
                s += v;
            }
            sp[r * SLD + c] = f2bf(s / (float)cnt - self);
        }
        __syncthreads();
        f32x4 acc[8][2];
#pragma unroll
        for (int m = 0; m < 8; ++m) { acc[m][0] = (f32x4){0.f, 0.f, 0.f, 0.f}; acc[m][1] = (f32x4){0.f, 0.f, 0.f, 0.f}; }
        const bf16_t* wg = pw + (size_t)g * 65536;
#pragma unroll 1
        for (int kk = 0; kk < 8; ++kk) {
            bf16x8 bfr[2];
#pragma unroll
            for (int n = 0; n < 2; ++n) bfr[n] = *(const bf16x8*)(wg + (size_t)(wid * 32 + n * 16 + fr) * 256 + kk * 32 + fq * 8);
#pragma unroll
            for (int m = 0; m < 8; ++m) {
                const bf16x8 a = *(const bf16x8*)(sp + (m * 16 + fr) * SLD + kk * 32 + fq * 8);
                acc[m][0] = __builtin_amdgcn_mfma_f32_16x16x32_bf16(a, bfr[0], acc[m][0], 0, 0, 0);
                acc[m][1] = __builtin_amdgcn_mfma_f32_16x16x32_bf16(a, bfr[1], acc[m][1], 0, 0, 0);
            }
        }
#pragma unroll
        for (int m = 0; m < 8; ++m)
#pragma unroll
            for (int n = 0; n < 2; ++n) {
                const int col = g * 256 + wid * 32 + n * 16 + fr;
                const float sc = scale[col];
#pragma unroll
                for (int j = 0; j < 4; ++j) {
                    const int row = row0 + m * 16 + fq * 4 + j;
                    pp[(size_t)row * 1024 + col] = f2bf(acc[m][n][j] * sc);
                }
            }
        __syncthreads();
    }
}

__device__ void phase_dsa_prep(const Params& p, int l) {
    const int lane = otid() & 63;
    const int wave = (obid() * NTHR + otid()) >> 6, nw = gridDim.x * NTHR / 64;
    const bf16_t* pm = (const bf16_t*)(WS(p) + OFF_PMISC);
    unsigned char* dob = OUTB(p);
    bf16_t* cqn = (bf16_t*)(dob + DO_CQN);
    bf16_t* kv = (bf16_t*)(dob + DO_KV);
    bf16_t* kidx = (bf16_t*)(dob + DO_KIDX);
    float* whead = (float*)(dob + DO_WHEAD);
    const float* ctab = (const float*)(WS(p) + OFF_ROPE);
    const float* stab = ctab + TS * 16;
    const float* qn = p.in[21] + l * 256;
    const float* kvn = p.in[22] + l * 128;
    const float* inw = p.in[27] + l * 64;
    const float* inb = p.in[28] + l * 64;
    for (int n = wave; n < NT; n += nw) {
        const int t = n % TS;
        const bf16_t* row = pm + (size_t)n * PM_LD;
        {
            float v[4]; float ss = 0.f;
#pragma unroll
            for (int i = 0; i < 4; ++i) { v[i] = bf2f(row[PM_CQ + lane * 4 + i]); ss += v[i] * v[i]; }
            ss = wave_sum(ss);
            const float rs = rsqrtf(ss * (1.0f / 256.0f) + 1e-6f);
#pragma unroll
            for (int i = 0; i < 4; ++i) cqn[(size_t)n * 256 + lane * 4 + i] = f2bf(v[i] * rs * qn[lane * 4 + i]);
        }
        {
            float v[2]; float ss = 0.f;
#pragma unroll
            for (int i = 0; i < 2; ++i) { v[i] = bf2f(row[PM_CKV + lane * 2 + i]); ss += v[i] * v[i]; }
            ss = wave_sum(ss);
            const float rs = rsqrtf(ss * (1.0f / 128.0f) + 1e-6f);
#pragma unroll
            for (int i = 0; i < 2; ++i) kv[(size_t)n * 160 + lane * 2 + i] = f2bf(v[i] * rs * kvn[lane * 2 + i]);
        }
        if (lane < 16) {
            const float x1 = bf2f(row[PM_KROPE + lane]), x2 = bf2f(row[PM_KROPE + 16 + lane]);
            const float c = ctab[t * 16 + lane], s = stab[t * 16 + lane];
            kv[(size_t)n * 160 + 128 + lane] = f2bf(x1 * c - x2 * s);
            kv[(size_t)n * 160 + 144 + lane] = f2bf(x2 * c + x1 * s);
        }
        {
            const float x = bf2f(row[PM_KIDX + lane]);
            const float mu = wave_sum(x) * (1.0f / 64.0f);
            const float d = x - mu;
            const float var = wave_sum(d * d) * (1.0f / 64.0f);
            const float y = d * rsqrtf(var + 1e-6f) * inw[lane] + inb[lane];
            const float yo = __shfl_xor(y, 16);
            float o = y;
            if (lane < 32) {
                const int i = lane & 15;
                const float c = ctab[t * 16 + i], s = stab[t * 16 + i];
                o = (lane < 16) ? (y * c - yo * s) : (y * c + yo * s);
            }
            kidx[(size_t)n * 64 + lane] = f2bf(o);
        }
        if (lane < 8) whead[(size_t)n * 8 + lane] = bf2f(row[PM_WIDX + lane]) * 0.04419417382415922f;
    }
}

__device__ void phase_scan(const Params& p, int l, unsigned char* lds) {
    if (obid() >= NB * 16) return;
    const int tid = otid(), lane = tid & 63, wid = tid >> 6;
    const int b = obid() >> 4, hh = obid() & 15, hc = hh * 64;
    constexpr int TC = 16;
    float* s_r = (float*)lds;
    float* s_w = s_r + TC * 64;
    float* s_k = s_w + TC * 64;
    float* s_v = s_k + TC * 64;
    float* s_a = s_v + TC * 64;
    float* s_b = s_a + TC * 64;
    float* s_g = s_b + TC * 64;
    float* s_o = s_g + TC * 64;
    float* s_wd = s_o + TC * 64;
    float* s_ad = s_wd + TC * 64;
    float* s_gd = s_ad + TC * 64;
    float* s_vd = s_gd + TC * 128;
    float* s_pr = s_vd + TC * 32;
    float* s_W2 = s_pr + 128;
    float* s_A2 = s_W2 + 64 * 64;
    float* s_G2 = s_A2 + 64 * 64;
    float* s_V2 = s_G2 + 128 * 64;
    bf16_t* Pr = (bf16_t*)(WS(p) + OFF_PR);
    const bf16_t* Pk = (const bf16_t*)(WS(p) + OFF_PK);
    const bf16_t* Pv = (const bf16_t*)(WS(p) + OFF_PV);
    const bf16_t* Pm = (const bf16_t*)(WS(p) + OFF_PMISC);
    bf16_t* vfirst = (bf16_t*)(WS(p) + OFF_VFIRST);
    const float* mu = p.in[4] + (size_t)l * 3328;
    const float* vmu = p.in[18];
    const float* w0 = p.in[7] + l * 1024;
    const float* a0 = p.in[9] + l * 1024;
    const float* k_k = p.in[12] + l * 1024;
    const float* k_a = p.in[13] + l * 1024;
    const float* r_k = p.in[14] + l * 1024;
    const float* ln_w = p.in[15] + l * 1024;
    const float* ln_b = p.in[16] + l * 1024;
    const float* v0 = p.in[19];
    for (int e = tid; e < 64 * 64; e += NTHR) { const int m = e >> 6, c = e & 63; s_W2[e] = p.in[8][((size_t)l * 64 + m) * 1024 + hc + c]; s_A2[e] = p.in[10][((size_t)l * 64 + m) * 1024 + hc + c]; }
    for (int e = tid; e < 128 * 64; e += NTHR) { const int m = e >> 6, c = e & 63; s_G2[e] = p.in[11][((size_t)l * 128 + m) * 1024 + hc + c]; }
    for (int e = tid; e < 32 * 64; e += NTHR) { const int m = e >> 6, c = e & 63; s_V2[e] = (l > 0) ? p.in[20][(size_t)m * 1024 + hc + c] : 0.f; }
    float S[8];
#pragma unroll
    for (int j = 0; j < 8; ++j) S[j] = 0.f;
    const int si = tid >> 3, q8 = tid & 7;
    __syncthreads();
    for (int t0 = 0, ch = 0; t0 < TS; t0 += TC, ++ch) {
        for (int e = tid; e < TC * 64; e += NTHR) {
            const int tau = e >> 6, c = e & 63, t = t0 + tau;
            const size_t n = (size_t)b * TS + t;
            const float cr = bf2f(Pr[n * 1024 + hc + c]);
            const float ck = bf2f(Pk[n * 1024 + hc + c]);
            const float cv = bf2f(Pv[n * 1024 + hc + c]);
            float prr = 0.f, prk = 0.f, prv = 0.f;
            if (t > 0) {
                prr = (tau > 0) ? bf2f(Pr[(n - 1) * 1024 + hc + c]) : s_pr[((ch + 1) & 1) * 64 + c];
                prk = bf2f(Pk[(n - 1) * 1024 + hc + c]);
                prv = bf2f(Pv[(n - 1) * 1024 + hc + c]);
            }
            if (tau == TC - 1) s_pr[(ch & 1) * 64 + c] = cr;
            s_r[e] = cr + (prr - cr) * mu[hc + c];
            s_k[e] = ck + (prk - ck) * mu[1024 + hc + c];
            s_v[e] = cv + (prv - cv) * mu[2048 + hc + c];
            const float cwd = bf2f(Pm[n * PM_LD + PM_WD + c]), cad = bf2f(Pm[n * PM_LD + PM_AD + c]);
            float pwd = 0.f, pad_ = 0.f;
            if (t > 0) { pwd = bf2f(Pm[(n - 1) * PM_LD + PM_WD + c]); pad_ = bf2f(Pm[(n - 1) * PM_LD + PM_AD + c]); }
            s_wd[e] = tanhf(cwd + (pwd - cwd) * mu[3072 + c]);
            s_ad[e] = cad + (pad_ - cad) * mu[3136 + c];
        }
        for (int e = tid; e < TC * 128; e += NTHR) {
            const int tau = e >> 7, c = e & 127, t = t0 + tau;
            const size_t n = (size_t)b * TS + t;
            const float cg_ = bf2f(Pm[n * PM_LD + PM_GD + c]);
            const float pg = (t > 0) ? bf2f(Pm[(n - 1) * PM_LD + PM_GD + c]) : 0.f;
            s_gd[e] = sigmoidf_(cg_ + (pg - cg_) * mu[3200 + c]);
        }
        if (l > 0) {
            for (int e = tid; e < TC * 32; e += NTHR) {
                const int tau = e >> 5, c = e & 31, t = t0 + tau;
                const size_t n = (size_t)b * TS + t;
                const float cvd = bf2f(Pm[n * PM_LD + PM_VD + c]);
                const float pvd = (t > 0) ? bf2f(Pm[(n - 1) * PM_LD + PM_VD + c]) : 0.f;
                s_vd[e] = cvd + (pvd - cvd) * vmu[c];
            }
        }
        __syncthreads();
        for (int e = tid; e < TC * 64; e += NTHR) {
            const int tau = e >> 6, c = e & 63, t = t0 + tau;
            const size_t n = (size_t)b * TS + t;
            float xw = w0[hc + c], xa = a0[hc + c], gg = 0.f, xv = 0.f;
#pragma unroll 8
            for (int m = 0; m < 64; ++m) { xw += s_wd[tau * 64 + m] * s_W2[m * 64 + c]; xa += s_ad[tau * 64 + m] * s_A2[m * 64 + c]; }
#pragma unroll 8
            for (int m = 0; m < 128; ++m) gg += s_gd[tau * 128 + m] * s_G2[m * 64 + c];
            const float wlog = -softplusf_(-xw) - 0.5f;
            const float decay = __expf(-__expf(wlog));
            const float a = sigmoidf_(xa);
            float vv = s_v[e];
            if (l > 0) {
                xv = v0[hc + c];
#pragma unroll 8
                for (int m = 0; m < 32; ++m) xv += s_vd[tau * 32 + m] * s_V2[m * 64 + c];
                const float vf = bf2f(vfirst[n * 1024 + hc + c]);
                vv = vv + (vf - vv) * sigmoidf_(xv);
            } else {
                vfirst[n * 1024 + hc + c] = f2bf(vv);
            }
            const float kraw = s_k[e];
            const float kkv = kraw * k_k[hc + c];
            const float nrm = sqrtf(wave_sum(kkv * kkv));
            const float kk = kkv / fmaxf(nrm, 1e-12f);
            s_w[e] = decay;
            s_a[e] = -kk;
            s_b[e] = kk * a;
            s_k[e] = kraw * (1.0f + (a - 1.0f) * k_a[hc + c]);
            s_v[e] = vv;
            s_g[e] = gg;
        }
        __syncthreads();
#pragma unroll 1
        for (int tau = 0; tau < TC; ++tau) {
            const float4 a0v = *(const float4*)(s_a + tau * 64 + q8 * 8), a1v = *(const float4*)(s_a + tau * 64 + q8 * 8 + 4);
            const float4 w0v = *(const float4*)(s_w + tau * 64 + q8 * 8), w1v = *(const float4*)(s_w + tau * 64 + q8 * 8 + 4);
            const float4 b0v = *(const float4*)(s_b + tau * 64 + q8 * 8), b1v = *(const float4*)(s_b + tau * 64 + q8 * 8 + 4);
            const float4 k0v = *(const float4*)(s_k + tau * 64 + q8 * 8), k1v = *(const float4*)(s_k + tau * 64 + q8 * 8 + 4);
            const float4 r0v = *(const float4*)(s_r + tau * 64 + q8 * 8), r1v = *(const float4*)(s_r + tau * 64 + q8 * 8 + 4);
            const float vi = s_v[tau * 64 + si];
            const float av[8] = {a0v.x, a0v.y, a0v.z, a0v.w, a1v.x, a1v.y, a1v.z, a1v.w};
            const float wv[8] = {w0v.x, w0v.y, w0v.z, w0v.w, w1v.x, w1v.y, w1v.z, w1v.w};
            const float bv[8] = {b0v.x, b0v.y, b0v.z, b0v.w, b1v.x, b1v.y, b1v.z, b1v.w};
            const float kv_[8] = {k0v.x, k0v.y, k0v.z, k0v.w, k1v.x, k1v.y, k1v.z, k1v.w};
            const float rv[8] = {r0v.x, r0v.y, r0v.z, r0v.w, r1v.x, r1v.y, r1v.z, r1v.w};
            float sa = 0.f;
#pragma unroll
            for (int j = 0; j < 8; ++j) sa += S[j] * av[j];
            sa += __shfl_xor(sa, 1); sa += __shfl_xor(sa, 2); sa += __shfl_xor(sa, 4);
            float o = 0.f;
#pragma unroll
            for (int j = 0; j < 8; ++j) { S[j] = S[j] * wv[j] + sa * bv[j] + vi * kv_[j]; o += S[j] * rv[j]; }
            o += __shfl_xor(o, 1); o += __shfl_xor(o, 2); o += __shfl_xor(o, 4);
            if (q8 == 0) s_o[tau * 64 + si] = o;
        }
        __syncthreads();
        for (int tau = wid; tau < TC; tau += 8) {
            const int c = lane, e = tau * 64 + c;
            const size_t n = (size_t)b * TS + t0 + tau;
            const float o = s_o[e];
            const float m_ = wave_sum(o) * (1.0f / 64.0f);
            const float d = o - m_;
            const float var = wave_sum(d * d) * (1.0f / 64.0f);
            const float on = d * rsqrtf(var + 64e-5f) * ln_w[hc + c] + ln_b[hc + c];
            const float bonus = wave_sum(s_r[e] * s_k[e] * r_k[hc + c]) * s_v[e];
            Pr[n * 1024 + hc + c] = f2bf((on + bonus) * s_g[e]);
        }
        __syncthreads();
    }
}

__device__ void phase_dsa_naive(const Params& p, int l, unsigned char* lds) {
    const int tid = otid(), lane = tid & 63, wid = tid >> 6;
    constexpr int QT = 4, SCL = 2080;
    float* s_cq = (float*)lds;
    float* s_q = s_cq + QT * 256;
    float* s_Q = s_q + QT * 1536;
    float* s_qi = s_Q + QT * 16 * 160;
    float* s_sc = s_qi + QT * 512;
    int* s_sel = (int*)(s_sc + QT * SCL);
    int* s_nsel = s_sel + QT * 256;
    float* s_p = (float*)(s_nsel + 16);
    float* s_ol = s_p + 16 * 256;
    float* s_wh = s_ol + 16 * 128;
    unsigned char* dob = OUTB(p);
    const bf16_t* cqn = (const bf16_t*)(dob + DO_CQN);
    const bf16_t* kv = (const bf16_t*)(dob + DO_KV);
    const bf16_t* kidx = (const bf16_t*)(dob + DO_KIDX);
    const float* whead = (const float*)(dob + DO_WHEAD);
    bf16_t* yc = (bf16_t*)(dob + DO_YC);
    const float* ctab = (const float*)(WS(p) + OFF_ROPE);
    const float* stab = ctab + TS * 16;
    const float* w_uq = p.in[23] + (size_t)l * 256 * 1536;
    const float* w_uk = p.in[24] + (size_t)l * 16 * 128 * 64;
    const float* w_uv = p.in[25] + (size_t)l * 16 * 128 * 64;
    const float* w_qi = p.in[26] + (size_t)l * 256 * 512;
    const float scale = 0.10206207261596575f;
    for (int tile = obid(); tile < NT / QT; tile += gridDim.x) {
        const int n0 = tile * QT, b = n0 / TS, t0 = n0 % TS;
        for (int e = tid; e < QT * 256; e += NTHR) s_cq[e] = bf2f(cqn[(size_t)n0 * 256 + e]);
        if (tid < QT * 8) s_wh[tid] = whead[(size_t)n0 * 8 + tid];
        __syncthreads();
        {
            float acc[3][QT];
#pragma unroll
            for (int c = 0; c < 3; ++c)
#pragma unroll
                for (int q = 0; q < QT; ++q) acc[c][q] = 0.f;
            float ai[QT];
#pragma unroll
            for (int q = 0; q < QT; ++q) ai[q] = 0.f;
            for (int i = 0; i < 256; ++i) {
                const float wa = w_uq[(size_t)i * 1536 + tid], wb_ = w_uq[(size_t)i * 1536 + 512 + tid], wc_ = w_uq[(size_t)i * 1536 + 1024 + tid];
                const float wi = w_qi[(size_t)i * 512 + tid];
#pragma unroll
                for (int q = 0; q < QT; ++q) {
                    const float c = s_cq[q * 256 + i];
                    acc[0][q] += c * wa; acc[1][q] += c * wb_; acc[2][q] += c * wc_; ai[q] += c * wi;
                }
            }
#pragma unroll
            for (int q = 0; q < QT; ++q) {
                s_q[q * 1536 + tid] = acc[0][q]; s_q[q * 1536 + 512 + tid] = acc[1][q]; s_q[q * 1536 + 1024 + tid] = acc[2][q];
                s_qi[q * 512 + tid] = ai[q];
            }
        }
        __syncthreads();
        for (int e = tid; e < QT * 16 * 16; e += NTHR) {
            const int q = e >> 8, h = (e >> 4) & 15, i = e & 15;
            const float x1 = s_q[q * 1536 + h * 96 + 64 + i], x2 = s_q[q * 1536 + h * 96 + 80 + i];
            const float c = ctab[(t0 + q) * 16 + i], s = stab[(t0 + q) * 16 + i];
            s_Q[(q * 16 + h) * 160 + 128 + i] = x1 * c - x2 * s;
            s_Q[(q * 16 + h) * 160 + 144 + i] = x2 * c + x1 * s;
        }
        {
            const int q = tid >> 7, h8 = (tid >> 4) & 7, i = tid & 15;
            const float x1 = s_qi[q * 512 + h8 * 64 + i], x2 = s_qi[q * 512 + h8 * 64 + 16 + i];
            const float c = ctab[(t0 + q) * 16 + i], s = stab[(t0 + q) * 16 + i];
            __syncthreads();
            s_qi[q * 512 + h8 * 64 + i] = x1 * c - x2 * s;
            s_qi[q * 512 + h8 * 64 + 16 + i] = x2 * c + x1 * s;
        }
        for (int id = tid; id < 16 * 128; id += NTHR) {
            const int h = id >> 7, c = id & 127;
            const float* wrow = w_uk + ((size_t)h * 128 + c) * 64;
            float acc[QT];
#pragma unroll
            for (int q = 0; q < QT; ++q) acc[q] = 0.f;
            for (int d = 0; d < 64; d += 4) {
                const float4 w4 = *(const float4*)(wrow + d);
#pragma unroll
                for (int q = 0; q < QT; ++q) {
                    const float* qq = s_q + q * 1536 + h * 96 + d;
                    acc[q] += qq[0] * w4.x + qq[1] * w4.y + qq[2] * w4.z + qq[3] * w4.w;
                }
            }
#pragma unroll
            for (int q = 0; q < QT; ++q) s_Q[(q * 16 + h) * 160 + c] = acc[q];
        }
        __syncthreads();
        const int tmax = t0 + QT - 1;
        for (int s = tid; s <= tmax; s += NTHR) {
            float kr[64];
            const bf16_t* krow = kidx + ((size_t)b * TS + s) * 64;
#pragma unroll
            for (int v8 = 0; v8 < 8; ++v8) {
                const uint4 u = *(const uint4*)(krow + v8 * 8);
                kr[v8 * 8 + 0] = __uint_as_float(u.x << 16); kr[v8 * 8 + 1] = __uint_as_float(u.x & 0xFFFF0000u);
                kr[v8 * 8 + 2] = __uint_as_float(u.y << 16); kr[v8 * 8 + 3] = __uint_as_float(u.y & 0xFFFF0000u);
                kr[v8 * 8 + 4] = __uint_as_float(u.z << 16); kr[v8 * 8 + 5] = __uint_as_float(u.z & 0xFFFF0000u);
                kr[v8 * 8 + 6] = __uint_as_float(u.w << 16); kr[v8 * 8 + 7] = __uint_as_float(u.w & 0xFFFF0000u);
            }
#pragma unroll 1
            for (int q = 0; q < QT; ++q) {
                float I = 0.f;
#pragma unroll 1
                for (int h = 0; h < 8; ++h) {
                    const float* qq = s_qi + q * 512 + h * 64;
                    float d = 0.f;
#pragma unroll
                    for (int j = 0; j < 64; ++j) d += qq[j] * kr[j];
                    I += s_wh[q * 8 + h] * fmaxf(d, 0.f);
                }
                s_sc[q * SCL + s] = I;
            }
        }
        __syncthreads();
        if (wid < QT) {
            const int q = wid, t = t0 + q, nadm = t + 1;
            const float* sc = s_sc + q * SCL;
            int* sel = s_sel + q * 256;
            if (nadm <= 256) {
                for (int i = lane; i < nadm; i += 64) sel[i] = i;
                if (lane == 0) s_nsel[q] = nadm;
            } else {
                const int nch = (nadm + 63) >> 6;
                unsigned T = 0u;
                for (int bit = 31; bit >= 0; --bit) {
                    const unsigned cand = T | (1u << bit);
                    int cnt = 0;
                    for (int c = 0; c < nch; ++c) {
                        const int s = c * 64 + lane;
                        bool ge = false;
                        if (s < nadm) { const unsigned u = __float_as_uint(sc[s]); const unsigned key = (u & 0x80000000u) ? ~u : (u | 0x80000000u); ge = key >= cand; }
                        cnt += __popcll(__ballot(ge));
                    }
                    if (cnt >= 256) T = cand;
                }
                int ngt = 0;
                for (int c = 0; c < nch; ++c) {
                    const int s = c * 64 + lane;
                    bool gt = false;
                    if (s < nadm) { const unsigned u = __float_as_uint(sc[s]); const unsigned key = (u & 0x80000000u) ? ~u : (u | 0x80000000u); gt = key > T; }
                    ngt += __popcll(__ballot(gt));
                }
                const int rties = 256 - ngt;
                int base = 0, ties = 0;
                const unsigned long long ltmask = (1ull << lane) - 1ull;
                for (int c = 0; c < nch; ++c) {
                    const int s = c * 64 + lane;
                    bool gt = false, eq = false;
                    if (s < nadm) { const unsigned u = __float_as_uint(sc[s]); const unsigned key = (u & 0x80000000u) ? ~u : (u | 0x80000000u); gt = key > T; eq = key == T; }
                    const unsigned long long em = __ballot(eq);
                    const int myrank = ties + __popcll(em & ltmask);
                    const bool take = gt || (eq && myrank < rties);
                    const unsigned long long tm = __ballot(take);
                    const int pos = base + __popcll(tm & ltmask);
                    if (take && pos < 256) sel[pos] = s;
                    base += __popcll(tm); ties += __popcll(em);
                }
                if (lane == 0) s_nsel[q] = 256;
            }
        }
        __syncthreads();
        for (int q = 0; q < QT; ++q) {
            const int nsel = s_nsel[q];
            const int* sel = s_sel + q * 256;
            {
                const int h = tid >> 5, kg = tid & 31;
                const float* qv = s_Q + (q * 16 + h) * 160;
                float mx = -INFINITY;
#pragma unroll 1
                for (int kk = 0; kk < 8; ++kk) {
                    const int ki = kg + kk * 32;
                    float sv = -INFINITY;
                    if (ki < nsel) {
                        const bf16_t* krow = kv + ((size_t)b * TS + sel[ki]) * 160;
                        float d = 0.f;
#pragma unroll 4
                        for (int v8 = 0; v8 < 20; ++v8) {
                            const uint4 u = *(const uint4*)(krow + v8 * 8);
                            const float* qq = qv + v8 * 8;
                            d += qq[0] * __uint_as_float(u.x << 16) + qq[1] * __uint_as_float(u.x & 0xFFFF0000u)
                               + qq[2] * __uint_as_float(u.y << 16) + qq[3] * __uint_as_float(u.y & 0xFFFF0000u)
                               + qq[4] * __uint_as_float(u.z << 16) + qq[5] * __uint_as_float(u.z & 0xFFFF0000u)
                               + qq[6] * __uint_as_float(u.w << 16) + qq[7] * __uint_as_float(u.w & 0xFFFF0000u);
                        }
                        sv = d * scale;
                    }
                    s_p[h * 256 + ki] = sv; mx = fmaxf(mx, sv);
                }
#pragma unroll
                for (int o = 16; o > 0; o >>= 1) mx = fmaxf(mx, __shfl_xor(mx, o));
                float sum = 0.f;
#pragma unroll 1
                for (int kk = 0; kk < 8; ++kk) { const float sv = s_p[h * 256 + kg + kk * 32]; const float e = (sv == -INFINITY) ? 0.f : __expf(sv - mx); s_p[h * 256 + kg + kk * 32] = e; sum += e; }
#pragma unroll
                for (int o = 16; o > 0; o >>= 1) sum += __shfl_xor(sum, o);
                const float inv = 1.0f / sum;
#pragma unroll 1
                for (int kk = 0; kk < 8; ++kk) s_p[h * 256 + kg + kk * 32] *= inv;
            }
            __syncthreads();
            {
                const int h = tid >> 5, c4 = tid & 31;
                float a0_ = 0.f, a1_ = 0.f, a2_ = 0.f, a3_ = 0.f;
                for (int k = 0; k < nsel; ++k) {
                    const float pk = s_p[h * 256 + k];
                    const uint2 u = *(const uint2*)(kv + ((size_t)b * TS + sel[k]) * 160 + c4 * 4);
                    a0_ += pk * __uint_as_float(u.x << 16); a1_ += pk * __uint_as_float(u.x & 0xFFFF0000u);
                    a2_ += pk * __uint_as_float(u.y << 16); a3_ += pk * __uint_as_float(u.y & 0xFFFF0000u);
                }
                float* o = s_ol + h * 128 + c4 * 4;
                o[0] = a0_; o[1] = a1_; o[2] = a2_; o[3] = a3_;
            }
            __syncthreads();
            for (int id = tid; id < 1024; id += NTHR) {
                const int h = id >> 6, v = id & 63;
                float acc = 0.f;
                for (int c = 0; c < 128; ++c) acc += s_ol[h * 128 + c] * w_uv[((size_t)h * 128 + c) * 64 + v];
                yc[(size_t)(n0 + q) * 1024 + id] = f2bf(acc);
            }
            __syncthreads();
        }
    }
}


typedef short s16x4 __attribute__((ext_vector_type(4)));
__device__ __forceinline__ unsigned f2h_bits(float f) { const _Float16 h = (_Float16)f; unsigned short u; __builtin_memcpy(&u, &h, 2); return u; }
template <bool IMPORT_SEL>
__device__ void phase_dsa(const Params& p, int l, unsigned char* lds, bf16_t* yc, const unsigned short* gsel, const int* gnsel, int tb, int te, int tstep) {
    const int tid = otid(), lane = tid & 63, wid = tid >> 6, fr = lane & 15, fq = lane >> 4;
    unsigned short* s_sc = (unsigned short*)lds;
    bf16_t* s_qi = (bf16_t*)(lds + 66048);
    bf16_t* s_Q = (bf16_t*)lds;
    unsigned char* s_Vw = lds + 82432 + wid * 8192;
    bf16_t* s_qn = (bf16_t*)s_Vw;
    unsigned short* s_sel = (unsigned short*)(lds + 82432 + 65536);
    int* s_nsel = (int*)(lds + 82432 + 65536 + 8192);
    unsigned char* dob = OUTB(p);
    const bf16_t* cqn = (const bf16_t*)(dob + DO_CQN);
    const bf16_t* kv = (const bf16_t*)(dob + DO_KV);
    const bf16_t* kidx = (const bf16_t*)(dob + DO_KIDX);
    const float* whead = (const float*)(dob + DO_WHEAD);
    const float* ctab = (const float*)(WS(p) + OFF_ROPE);
    const float* stab = ctab + TS * 16;
    const bf16_t* wb = (const bf16_t*)(WS(p) + OFF_WB);
    const bf16_t* wqiT = wb + WB_QI;
    const bf16_t* wuqT = wb + WB_UQ;
    const bf16_t* wuk = wb + WB_UK;
    const bf16_t* wuvT = wb + WB_UV;
    const float scale = 0.10206207261596575f;
    const f32x4 z4 = {0.f, 0.f, 0.f, 0.f};
    for (int tile = tb; tile < te; tile += tstep) {
        const int qt = 128 - (tile >> 3), b = tile & 7;
        const int t0 = qt * 16;
        const size_t n0 = (size_t)b * TS + t0;
        {
            bf16x8 acq[8];
#pragma unroll
            for (int kk = 0; kk < 8; ++kk) acq[kk] = *(const bf16x8*)(cqn + (n0 + fr) * 256 + kk * 32 + fq * 8);
            f32x4 c[4] = {z4, z4, z4, z4};
#pragma unroll
            for (int kb = 0; kb < 8; kb += 4) {
                bf16x8 bf[4][4];
#pragma unroll
                for (int k4 = 0; k4 < 4; ++k4)
#pragma unroll
                    for (int nt = 0; nt < 4; ++nt) bf[k4][nt] = *(const bf16x8*)(wqiT + (size_t)(wid * 64 + nt * 16 + fr) * 256 + (kb + k4) * 32 + fq * 8);
#pragma unroll
                for (int k4 = 0; k4 < 4; ++k4)
#pragma unroll
                    for (int nt = 0; nt < 4; ++nt) c[nt] = __builtin_amdgcn_mfma_f32_16x16x32_bf16(acq[kb + k4], bf[k4][nt], c[nt], 0, 0, 0);
            }
#pragma unroll
            for (int j = 0; j < 4; ++j) {
                const int t = t0 + fq * 4 + j;
                const float cs = ctab[t * 16 + fr], sn = stab[t * 16 + fr];
                const float x1 = c[0][j], x2 = c[1][j];
                c[0][j] = x1 * cs - x2 * sn; c[1][j] = x2 * cs + x1 * sn;
            }
#pragma unroll
            for (int nt = 0; nt < 4; ++nt)
#pragma unroll
                for (int j = 0; j < 4; ++j) s_qi[(fq * 4 + j) * 512 + wid * 64 + nt * 16 + fr] = f2bf(c[nt][j]);
        }
        __syncthreads();
        if (!IMPORT_SEL) {
            bf16x8 aq[8][2];
#pragma unroll
            for (int h = 0; h < 8; ++h)
#pragma unroll
                for (int ks = 0; ks < 2; ++ks) aq[h][ks] = *(const bf16x8*)(s_qi + fr * 512 + h * 64 + ks * 32 + fq * 8);
            float wh[4][8];
#pragma unroll
            for (int j = 0; j < 4; ++j) {
                const float4 w0 = *(const float4*)(whead + (n0 + fq * 4 + j) * 8), w1 = *(const float4*)(whead + (n0 + fq * 4 + j) * 8 + 4);
                wh[j][0] = w0.x; wh[j][1] = w0.y; wh[j][2] = w0.z; wh[j][3] = w0.w; wh[j][4] = w1.x; wh[j][5] = w1.y; wh[j][6] = w1.z; wh[j][7] = w1.w;
            }
            const int nkt = qt + 1;
            bf16x8 nb0 = {0, 0, 0, 0, 0, 0, 0, 0}, nb1 = nb0;
            if (wid < nkt) { const bf16_t* kr0 = kidx + ((size_t)b * TS + wid * 16 + fr) * 64 + fq * 8; nb0 = *(const bf16x8*)kr0; nb1 = *(const bf16x8*)(kr0 + 32); }
#pragma unroll 1
            for (int kt = wid; kt < nkt; kt += 8) {
                const bf16x8 bk0 = nb0, bk1 = nb1;
                if (kt + 8 < nkt) { const bf16_t* krn = kidx + ((size_t)b * TS + (kt + 8) * 16 + fr) * 64 + fq * 8; nb0 = *(const bf16x8*)krn; nb1 = *(const bf16x8*)(krn + 32); }
                float I[4] = {0.f, 0.f, 0.f, 0.f};
#pragma unroll
                for (int h = 0; h < 8; ++h) {
                    f32x4 a = __builtin_amdgcn_mfma_f32_16x16x32_bf16(aq[h][0], bk0, z4, 0, 0, 0);
                    a = __builtin_amdgcn_mfma_f32_16x16x32_bf16(aq[h][1], bk1, a, 0, 0, 0);
#pragma unroll
                    for (int j = 0; j < 4; ++j) I[j] += wh[j][h] * fmaxf(a[j], 0.f);
                }
#pragma unroll
                for (int j = 0; j < 4; ++j) s_sc[(fq * 4 + j) * 2064 + kt * 16 + fr] = (unsigned short)f2h_bits(I[j]);
            }
        }
        __syncthreads();
#pragma unroll 1
        for (int qi2 = 0; qi2 < 2; ++qi2) {
            const int q = wid + qi2 * 8;
            const int nadm = t0 + q + 1;
            unsigned short* sel = s_sel + q * 256;
            if (IMPORT_SEL) {
                const int ns = gnsel[n0 + q];
                for (int i = lane; i < ns; i += 64) sel[i] = gsel[(n0 + q) * 256 + i];
                if (lane == 0) s_nsel[q] = ns;
            } else if (nadm <= 256) {
                for (int i = lane; i < nadm; i += 64) sel[i] = (unsigned short)i;
                if (lane == 0) s_nsel[q] = nadm;
            } else {
                auto topk = [&](auto nch_tag) {
                    constexpr int NCH = decltype(nch_tag)::value;
                    unsigned key[NCH];
    #pragma unroll
                    for (int c = 0; c < NCH; ++c) {
                        const int s = c * 64 + lane;
                        unsigned k = 0u;
                        if (s < nadm) { const unsigned u = s_sc[q * 2064 + s]; k = (u & 0x8000u) ? (~u & 0xFFFFu) : (u | 0x8000u); }
                        key[c] = k;
                    }
                    unsigned T = 0u;
    #pragma unroll 1
                    for (int bit = 15; bit >= 0; --bit) {
                        const unsigned cand = T | (1u << bit);
                        int cnt = 0;
    #pragma unroll
                        for (int c = 0; c < NCH; ++c) cnt += __popcll(__ballot(key[c] >= cand));
                        if (cnt >= 256) T = cand;
                    }
                    int ngt = 0;
    #pragma unroll
                    for (int c = 0; c < NCH; ++c) ngt += __popcll(__ballot(key[c] > T));
                    const int rties = 256 - ngt;
                    int base = 0, ties = 0;
                    const unsigned long long ltmask = (1ull << lane) - 1ull;
    #pragma unroll
                    for (int c = 0; c < NCH; ++c) {
                        const bool gt = key[c] > T, eq = key[c] == T;
                        const unsigned long long em = __ballot(eq);
                        const int myrank = ties + __popcll(em & ltmask);
                        const bool take = gt || (eq && myrank < rties);
                        const unsigned long long tm = __ballot(take);
                        const int pos = base + __popcll(tm & ltmask);
                        if (take && pos < 256) sel[pos] = (unsigned short)(c * 64 + lane);
                        base += __popcll(tm); ties += __popcll(em);
                    }

                };
                if (nadm <= 512) topk(std::integral_constant<int, 8>{});
                else if (nadm <= 1024) topk(std::integral_constant<int, 16>{});
                else if (nadm <= 1536) topk(std::integral_constant<int, 24>{});
                else topk(std::integral_constant<int, 33>{});
                if (lane == 0) s_nsel[q] = 256;
            }
        }
        __syncthreads();
#pragma unroll 1
        for (int hi = 0; hi < 2; ++hi) {
            const int hh = wid * 2 + hi;
            bf16x8 acq[8];
#pragma unroll
            for (int kk = 0; kk < 8; ++kk) acq[kk] = *(const bf16x8*)(cqn + (n0 + fr) * 256 + kk * 32 + fq * 8);
            f32x4 c6[6] = {z4, z4, z4, z4, z4, z4};
#pragma unroll
            for (int kb = 0; kb < 8; kb += 4) {
                bf16x8 bf[4][6];
#pragma unroll
                for (int k4 = 0; k4 < 4; ++k4)
#pragma unroll
                    for (int nt = 0; nt < 6; ++nt) bf[k4][nt] = *(const bf16x8*)(wuqT + (size_t)(hh * 96 + nt * 16 + fr) * 256 + (kb + k4) * 32 + fq * 8);
#pragma unroll
                for (int k4 = 0; k4 < 4; ++k4)
#pragma unroll
                    for (int nt = 0; nt < 6; ++nt) c6[nt] = __builtin_amdgcn_mfma_f32_16x16x32_bf16(acq[kb + k4], bf[k4][nt], c6[nt], 0, 0, 0);
            }
#pragma unroll
            for (int j = 0; j < 4; ++j) {
                const int q = fq * 4 + j, t = t0 + q;
                const float cs = ctab[t * 16 + fr], sn = stab[t * 16 + fr];
                const float x1 = c6[4][j], x2 = c6[5][j];
                s_Q[(q * 16 + hh) * 160 + 128 + fr] = f2bf(x1 * cs - x2 * sn);
                s_Q[(q * 16 + hh) * 160 + 144 + fr] = f2bf(x2 * cs + x1 * sn);
#pragma unroll
                for (int nt = 0; nt < 4; ++nt) s_qn[q * 64 + nt * 16 + fr] = f2bf(c6[nt][j]);
            }
            __syncthreads();
            bf16x8 an[2];
#pragma unroll
            for (int ks = 0; ks < 2; ++ks) an[ks] = *(const bf16x8*)(s_qn + fr * 64 + ks * 32 + fq * 8);
            bf16x8 bwk[8][2];
#pragma unroll
            for (int nt = 0; nt < 8; ++nt)
#pragma unroll
                for (int ks = 0; ks < 2; ++ks) bwk[nt][ks] = *(const bf16x8*)(wuk + (size_t)(hh * 128 + nt * 16 + fr) * 64 + ks * 32 + fq * 8);
#pragma unroll
            for (int nt = 0; nt < 8; ++nt) {
                f32x4 a = z4;
#pragma unroll
                for (int ks = 0; ks < 2; ++ks)
                    a = __builtin_amdgcn_mfma_f32_16x16x32_bf16(an[ks], bwk[nt][ks], a, 0, 0, 0);
#pragma unroll
                for (int j = 0; j < 4; ++j) s_Q[((fq * 4 + j) * 16 + hh) * 160 + nt * 16 + fr] = f2bf(a[j]);
            }
            __syncthreads();
        }
#pragma unroll 1
        for (int qi2 = 0; qi2 < 2; ++qi2) {
            const int q = wid + qi2 * 8;
            bf16x8 bq[5];
#pragma unroll
            for (int ks = 0; ks < 5; ++ks) bq[ks] = *(const bf16x8*)(s_Q + (q * 16 + fr) * 160 + ks * 32 + fq * 8);
            const int nsel = s_nsel[q];
            const unsigned short* sel = s_sel + q * 256;
            float m = -INFINITY, lsum = 0.f;
            f32x4 O[8] = {z4, z4, z4, z4, z4, z4, z4, z4};
            const int nchunk = (nsel + 31) >> 5;
            bf16x8 akn[2][5];
#pragma unroll
            for (int mt = 0; mt < 2; ++mt) {
                const int ki = mt * 16 + fr;
                const int sidx = sel[ki < nsel ? ki : 0];
                const bf16_t* krow = kv + ((size_t)b * TS + sidx) * 160 + fq * 8;
#pragma unroll
                for (int ks = 0; ks < 5; ++ks) akn[mt][ks] = *(const bf16x8*)(krow + ks * 32);
            }
#pragma unroll 1
            for (int ch = 0; ch < nchunk; ++ch) {
                bf16x8 ak[2][5];
#pragma unroll
                for (int mt = 0; mt < 2; ++mt)
#pragma unroll
                    for (int ks = 0; ks < 5; ++ks) ak[mt][ks] = akn[mt][ks];
                if (ch + 1 < nchunk) {
#pragma unroll
                    for (int mt = 0; mt < 2; ++mt) {
                        const int ki = (ch + 1) * 32 + mt * 16 + fr;
                        const int sidx = sel[ki < nsel ? ki : 0];
                        const bf16_t* krow = kv + ((size_t)b * TS + sidx) * 160 + fq * 8;
#pragma unroll
                        for (int ks = 0; ks < 5; ++ks) akn[mt][ks] = *(const bf16x8*)(krow + ks * 32);
                    }
                }
#pragma unroll
                for (int mt = 0; mt < 2; ++mt)
#pragma unroll
                    for (int ks = 0; ks < 4; ++ks) {
                        const int r = mt * 16 + fr;
                        *(bf16x8*)(s_Vw + r * 256 + (((ks * 2 + (fq >> 1)) ^ (r & 7)) * 32) + (fq & 1) * 16) = ak[mt][ks];
                    }
                f32x4 st[2] = {z4, z4};
#pragma unroll
                for (int mt = 0; mt < 2; ++mt)
#pragma unroll
                    for (int ks = 0; ks < 5; ++ks) st[mt] = __builtin_amdgcn_mfma_f32_16x16x32_bf16(ak[mt][ks], bq[ks], st[mt], 0, 0, 0);
                float sv[2][4]; float cmax = -INFINITY;
#pragma unroll
                for (int mt = 0; mt < 2; ++mt)
#pragma unroll
                    for (int j = 0; j < 4; ++j) {
                        const int ke = ch * 32 + mt * 16 + fq * 4 + j;
                        const float s_ = (ke < nsel) ? st[mt][j] * scale : -INFINITY;
                        sv[mt][j] = s_; cmax = fmaxf(cmax, s_);
                    }
                cmax = fmaxf(cmax, __shfl_xor(cmax, 16)); cmax = fmaxf(cmax, __shfl_xor(cmax, 32));
                const float mnew = fmaxf(m, cmax);
                const float alpha = __expf(m - mnew);
                float psum = 0.f;
#pragma unroll
                for (int mt = 0; mt < 2; ++mt)
#pragma unroll
                    for (int j = 0; j < 4; ++j) { const float pe = __expf(sv[mt][j] - mnew); sv[mt][j] = pe; psum += pe; }
                psum += __shfl_xor(psum, 16); psum += __shfl_xor(psum, 32);
                lsum = lsum * alpha + psum; m = mnew;
#pragma unroll
                for (int ct = 0; ct < 8; ++ct) O[ct] = O[ct] * alpha;
                bf16x8 pf;
#pragma unroll
                for (int mt = 0; mt < 2; ++mt)
#pragma unroll
                    for (int j = 0; j < 4; ++j) pf[mt * 4 + j] = (short)f2bf(sv[mt][j]);
                const int q_ = fr >> 2, p_ = fr & 3;
                const int r0 = fq * 4 + q_, r1 = 16 + r0;
#pragma unroll
                for (int ct = 0; ct < 8; ++ct) {
                    const s16x4 v0 = __builtin_amdgcn_ds_read_tr16_b64_v4i16((__attribute__((address_space(3))) s16x4*)(s_Vw + r0 * 256 + ((ct ^ (r0 & 7)) * 32) + p_ * 8));
                    const s16x4 v1 = __builtin_amdgcn_ds_read_tr16_b64_v4i16((__attribute__((address_space(3))) s16x4*)(s_Vw + r1 * 256 + ((ct ^ (r1 & 7)) * 32) + p_ * 8));
                    bf16x8 av; av[0] = v0[0]; av[1] = v0[1]; av[2] = v0[2]; av[3] = v0[3]; av[4] = v1[0]; av[5] = v1[1]; av[6] = v1[2]; av[7] = v1[3];
                    O[ct] = __builtin_amdgcn_mfma_f32_16x16x32_bf16(av, pf, O[ct], 0, 0, 0);
                }
            }
            const float inv = 1.0f / lsum;
#pragma unroll
            for (int ct = 0; ct < 8; ++ct)
#pragma unroll
                for (int j = 0; j < 4; ++j) s_Q[(q * 16 + fr) * 160 + ct * 16 + fq * 4 + j] = f2bf(O[ct][j] * inv);
        }
        __syncthreads();
#pragma unroll 1
        for (int hi = 0; hi < 2; ++hi) {
            const int hh = wid * 2 + hi;
            bf16x8 ao[4];
#pragma unroll
            for (int ks = 0; ks < 4; ++ks) ao[ks] = *(const bf16x8*)(s_Q + (fr * 16 + hh) * 160 + ks * 32 + fq * 8);
#pragma unroll
            for (int nt = 0; nt < 4; ++nt) {
                f32x4 a = z4;
#pragma unroll
                for (int ks = 0; ks < 4; ++ks)
                    a = __builtin_amdgcn_mfma_f32_16x16x32_bf16(ao[ks], *(const bf16x8*)(wuvT + (size_t)(hh * 64 + nt * 16 + fr) * 128 + ks * 32 + fq * 8), a, 0, 0, 0);
#pragma unroll
                for (int j = 0; j < 4; ++j) yc[(n0 + fq * 4 + j) * 1024 + hh * 64 + nt * 16 + fr] = f2bf(a[j]);
            }
        }
        __syncthreads();
    }
}


__device__ void phase_lr_prep(const Params& p, int l) {
    const int lane = otid() & 63;
    const int wave = (obid() * NTHR + otid()) >> 6, nw = gridDim.x * NTHR / 64;
    const bf16_t* pm = (const bf16_t*)(WS(p) + OFF_PMISC);
    bf16_t* alr = (bf16_t*)(OUTB(p) + DO_ALR);
    const float* mu = p.in[4] + (size_t)l * 3328 + 3072;
    const float* vmu = p.in[18];
    for (int n = wave; n < NT; n += nw) {
        const int t = n % TS;
        for (int c = lane; c < 288; c += 64) {
            const float cur = bf2f(pm[(size_t)n * PM_LD + c]);
            const float prv = (t > 0) ? bf2f(pm[(size_t)(n - 1) * PM_LD + c]) : 0.f;
            const float m_ = (c < 256) ? mu[c] : vmu[c - 256];
            float xs = cur + (prv - cur) * m_;
            if (c < 64) xs = tanhf(xs);
            else if (c >= 128 && c < 256) xs = sigmoidf_(xs);
            alr[(size_t)n * 288 + c] = f2bf(xs);
        }
    }
}

template <int CTRL> __device__ __forceinline__ float dpp_f(float x) {
    return __int_as_float(__builtin_amdgcn_update_dpp(0, __float_as_int(x), CTRL, 0xF, 0xF, true));
}
__device__ __forceinline__ float row16_sum(float v) {
    v += dpp_f<0xB1>(v);
    v += dpp_f<0x4E>(v);
    v += dpp_f<0x141>(v);
    v += dpp_f<0x140>(v);
    return v;
}
__device__ __forceinline__ void lds_barrier() { asm volatile("s_waitcnt lgkmcnt(0)" ::: "memory"); __builtin_amdgcn_s_barrier(); asm volatile("" ::: "memory"); }
__device__ __forceinline__ float fast_rcp(float x) { return __builtin_amdgcn_rcpf(x); }
__device__ __forceinline__ float fast_sigmoid(float x) { return fast_rcp(1.0f + __expf(-x)); }
__device__ __forceinline__ float fast_tanh(float x) { return 1.0f - 2.0f * fast_rcp(1.0f + __expf(2.0f * x)); }
__device__ __forceinline__ void row16_sum4(float& a, float& b, float& c, float& d) {
    asm volatile(
        "s_nop 1\n\t"
        "v_add_f32_dpp %0, %0, %0 quad_perm:[1,0,3,2] row_mask:0xf bank_mask:0xf\n\t"
        "v_add_f32_dpp %1, %1, %1 quad_perm:[1,0,3,2] row_mask:0xf bank_mask:0xf\n\t"
        "v_add_f32_dpp %2, %2, %2 quad_perm:[1,0,3,2] row_mask:0xf bank_mask:0xf\n\t"
        "v_add_f32_dpp %3, %3, %3 quad_perm:[1,0,3,2] row_mask:0xf bank_mask:0xf\n\t"
        "v_add_f32_dpp %0, %0, %0 quad_perm:[2,3,0,1] row_mask:0xf bank_mask:0xf\n\t"
        "v_add_f32_dpp %1, %1, %1 quad_perm:[2,3,0,1] row_mask:0xf bank_mask:0xf\n\t"
        "v_add_f32_dpp %2, %2, %2 quad_perm:[2,3,0,1] row_mask:0xf bank_mask:0xf\n\t"
        "v_add_f32_dpp %3, %3, %3 quad_perm:[2,3,0,1] row_mask:0xf bank_mask:0xf\n\t"
        "v_add_f32_dpp %0, %0, %0 row_half_mirror row_mask:0xf bank_mask:0xf\n\t"
        "v_add_f32_dpp %1, %1, %1 row_half_mirror row_mask:0xf bank_mask:0xf\n\t"
        "v_add_f32_dpp %2, %2, %2 row_half_mirror row_mask:0xf bank_mask:0xf\n\t"
        "v_add_f32_dpp %3, %3, %3 row_half_mirror row_mask:0xf bank_mask:0xf\n\t"
        "v_add_f32_dpp %0, %0, %0 row_mirror row_mask:0xf bank_mask:0xf\n\t"
        "v_add_f32_dpp %1, %1, %1 row_mirror row_mask:0xf bank_mask:0xf\n\t"
        "v_add_f32_dpp %2, %2, %2 row_mirror row_mask:0xf bank_mask:0xf\n\t"
        "v_add_f32_dpp %3, %3, %3 row_mirror row_mask:0xf bank_mask:0xf\n\t"
        "s_nop 1"
        : "+v"(a), "+v"(b), "+v"(c), "+v"(d));
}
__device__ __forceinline__ float wave_sum_fast(float v) { v = row16_sum(v); v += __shfl_xor(v, 16); v += __shfl_xor(v, 32); return v; }
constexpr int SC_TC = 32;
constexpr int SC_ROWB = 1088;
__device__ __forceinline__ const unsigned char* scan_piece_src(const Params& p, int l, int b, int hc, int t0, int pi, bool& ok) {
    const int tau = pi / 68, seg = pi - tau * 68;
    const int t = t0 + tau;
    ok = (t < TS) && (tau < SC_TC);
    const size_t n = (size_t)b * TS + t;
    const unsigned char* ws = WS(p);
    if (seg < 8) return ws + OFF_PR + (n * 1024 + hc) * 2 + seg * 16;
    if (seg < 16) return ws + OFF_PK + (n * 1024 + hc) * 2 + (seg - 8) * 16;
    if (seg < 24) return ws + OFF_PV + (n * 1024 + hc) * 2 + (seg - 16) * 16;
    if (seg < 60) return OUTB(p) + DO_ALR + (n * 288) * 2 + (seg - 24) * 16;
    ok = ok && (l > 0);
    return ws + OFF_VFIRST + (n * 1024 + hc) * 2 + (seg - 60) * 16;
}
__device__ void phase_scan5(const Params& p, int l, unsigned char* lds, int blk) {
    const int tid = otid(), lane = tid & 63, wid = tid >> 6, fr = lane & 15, fq = lane >> 4;
    const int b = blk >> 4, hh = blk & 15, hc = hh * 64;
    float* s_r = (float*)lds;
    float* s_w = s_r + 2048;
    float* s_k = s_w + 2048;
    float* s_v = s_k + 2048;
    float* s_a = s_v + 2048;
    float* s_b = s_a + 2048;
    float* s_g = s_b + 2048;
    float* s_o = s_g + 2048;
    bf16_t* A_wd = (bf16_t*)(s_o + 2048);
    bf16_t* A_ad = A_wd + 2048;
    bf16_t* A_gd = A_ad + 2048;
    bf16_t* A_vd = A_gd + 4096;
    unsigned char* raw = (unsigned char*)(A_vd + 1024);
    float* prevb = (float*)(raw + 32 * SC_ROWB);
    float* cst = prevb + 960;
    const float* mu = p.in[4] + (size_t)l * 3328;
    for (int e = tid; e < 480; e += NTHR) {
        float v;
        if (e < 192) v = mu[(e >> 6) * 1024 + hc + (e & 63)];
        else if (e < 448) v = mu[3072 + (e - 192)];
        else v = p.in[18][e - 448];
        cst[e] = v;
    }
    if (tid < 64) {
        cst[480 + tid] = p.in[7][l * 1024 + hc + tid];
        cst[544 + tid] = p.in[9][l * 1024 + hc + tid];
        cst[608 + tid] = p.in[12][l * 1024 + hc + tid];
        cst[672 + tid] = p.in[13][l * 1024 + hc + tid];
        cst[736 + tid] = p.in[14][l * 1024 + hc + tid];
        cst[800 + tid] = p.in[15][l * 1024 + hc + tid];
        cst[864 + tid] = p.in[16][l * 1024 + hc + tid];
        cst[928 + tid] = p.in[19][hc + tid];
    }
    const int mm = wid >> 1, ntb = (wid & 1) * 2;
    const int nks = (mm == 2) ? 4 : (mm == 3 ? 1 : 2);
    bf16x8 Bw[2][4];
    {
        const float* wsrc = (mm == 0) ? p.in[8] + (size_t)l * 64 * 1024 : (mm == 1) ? p.in[10] + (size_t)l * 64 * 1024 : (mm == 2) ? p.in[11] + (size_t)l * 128 * 1024 : p.in[20];
#pragma unroll
        for (int n2 = 0; n2 < 2; ++n2)
#pragma unroll
            for (int ks = 0; ks < 4; ++ks) {
                bf16x8 f;
#pragma unroll
                for (int j = 0; j < 8; ++j) {
                    const bool okw = ks < nks && (mm < 3 || l > 0);
                    const float v = wsrc[(size_t)(okw ? (ks * 32 + fq * 8 + j) : 0) * 1024 + hc + (ntb + n2) * 16 + fr];
                    f[j] = (short)f2bf(okw ? v : 0.f);
                }
                Bw[n2][ks] = f;
            }
    }
    const int cg = lane & 15, rg = lane >> 4;
    float S0[4] = {0.f, 0.f, 0.f, 0.f}, S1[4] = {0.f, 0.f, 0.f, 0.f};
    bf16_t* Pr = (bf16_t*)(WS(p) + OFF_PR);
    bf16_t* vfirst = (bf16_t*)(WS(p) + OFF_VFIRST);
    const unsigned char* psrc[5]; int pstep[5], ptau[5]; bool pval[5];
#pragma unroll
    for (int k = 0; k < 5; ++k) {
        const int pi = tid + k * NTHR;
        bool ok = false;
        psrc[k] = scan_piece_src(p, l, b, hc, 0, pi < SC_TC * 68 ? pi : 0, ok);
        const int tau = (pi < SC_TC * 68 ? pi : 0) / 68, seg = (pi < SC_TC * 68 ? pi : 0) - tau * 68;
        ptau[k] = tau;
        pstep[k] = SC_TC * ((seg >= 24 && seg < 60) ? 576 : 2048);
        pval[k] = (pi < SC_TC * 68) && !(seg >= 60 && l == 0);
    }
    uint4 pre[5];
#pragma unroll
    for (int k = 0; k < 5; ++k) { pre[k] = make_uint4(0, 0, 0, 0); if (pval[k] && ptau[k] < TS) pre[k] = *(const uint4*)psrc[k]; }
    __syncthreads();
#pragma unroll 1
    for (int t0 = 0, ch = 0; t0 < TS; t0 += SC_TC, ++ch) {
        const int nval = (TS - t0 < SC_TC) ? (TS - t0) : SC_TC;
#pragma unroll
        for (int k = 0; k < 5; ++k) { const int pi = tid + k * NTHR; if (pi < SC_TC * 68) *(uint4*)(raw + pi * 16) = pre[k]; }
        lds_barrier();
#pragma unroll
        for (int k = 0; k < 5; ++k) {
            pre[k] = make_uint4(0, 0, 0, 0);
            if (pval[k] && t0 + SC_TC + ptau[k] < TS) pre[k] = *(const uint4*)(psrc[k] + (size_t)(ch + 1) * pstep[k]);
        }
        {
            float* pwb = prevb + (ch & 1) * 192;
            const float* pvb = prevb + ((ch + 1) & 1) * 192;
            for (int it = tid; it < SC_TC * 96; it += NTHR) {
                const int tau = it / 96, c2 = (it - tau * 96) * 2;
                const unsigned cu = *(const unsigned*)(raw + tau * SC_ROWB + c2 * 2);
                const float c0 = __uint_as_float(cu << 16), c1 = __uint_as_float(cu & 0xFFFF0000u);
                float p0, p1;
                if (tau > 0) { const unsigned pu = *(const unsigned*)(raw + (tau - 1) * SC_ROWB + c2 * 2); p0 = __uint_as_float(pu << 16); p1 = __uint_as_float(pu & 0xFFFF0000u); }
                else if (t0 > 0) { p0 = pvb[c2]; p1 = pvb[c2 + 1]; }
                else { p0 = 0.f; p1 = 0.f; }
                if (tau == SC_TC - 1) { pwb[c2] = c0; pwb[c2 + 1] = c1; }
                const float x0 = c0 + (p0 - c0) * cst[c2], x1 = c1 + (p1 - c1) * cst[c2 + 1];
                float* dstv = (c2 < 64) ? (s_r + tau * 64 + c2) : (c2 < 128) ? (s_k + tau * 64 + c2 - 64) : (s_v + tau * 64 + c2 - 128);
                *(float2*)dstv = make_float2(x0, x1);
            }
        }
        if (mm < 3 || l > 0) {
            const unsigned char* Ab = raw + ((mm == 0) ? 384 : (mm == 1) ? 512 : (mm == 2) ? 640 : 896);
            float* dst = (mm == 0) ? s_w : (mm == 1) ? s_a : (mm == 2) ? s_g : s_o;
#pragma unroll
            for (int m = 0; m < 2; ++m) {
                f32x4 acc0 = {0.f, 0.f, 0.f, 0.f}, acc1 = {0.f, 0.f, 0.f, 0.f};
#pragma unroll
                for (int ks = 0; ks < 4; ++ks) {
                    if (ks < nks) {
                        const bf16x8 a = *(const bf16x8*)(Ab + (m * 16 + fr) * SC_ROWB + ks * 64 + fq * 16);
                        acc0 = __builtin_amdgcn_mfma_f32_16x16x32_bf16(a, Bw[0][ks], acc0, 0, 0, 0);
                        acc1 = __builtin_amdgcn_mfma_f32_16x16x32_bf16(a, Bw[1][ks], acc1, 0, 0, 0);
                    }
                }
#pragma unroll
                for (int j = 0; j < 4; ++j) {
                    dst[(m * 16 + fq * 4 + j) * 64 + ntb * 16 + fr] = acc0[j];
                    dst[(m * 16 + fq * 4 + j) * 64 + (ntb + 1) * 16 + fr] = acc1[j];
                }
            }
        }
        lds_barrier();
        {
            const int tau = tid >> 4, c4 = (tid & 15) * 4, e = tau * 64 + c4, t = t0 + tau;
            const size_t n = (size_t)b * TS + t;
            const float4 xw4 = *(const float4*)(s_w + e), xa4 = *(const float4*)(s_a + e), kr4 = *(const float4*)(s_k + e);
            float4 vv4 = *(const float4*)(s_v + e);
            const float4 cw = *(const float4*)(cst + 480 + c4), ca = *(const float4*)(cst + 544 + c4), ckk = *(const float4*)(cst + 608 + c4), cka = *(const float4*)(cst + 672 + c4);
            const float xw[4] = {xw4.x + cw.x, xw4.y + cw.y, xw4.z + cw.z, xw4.w + cw.w};
            const float xa[4] = {xa4.x + ca.x, xa4.y + ca.y, xa4.z + ca.z, xa4.w + ca.w};
            const float kr[4] = {kr4.x, kr4.y, kr4.z, kr4.w};
            const float kkc[4] = {ckk.x, ckk.y, ckk.z, ckk.w}, kac[4] = {cka.x, cka.y, cka.z, cka.w};
            float vv[4] = {vv4.x, vv4.y, vv4.z, vv4.w};
            if (l > 0) {
                const float4 xv4 = *(const float4*)(s_o + e), cv = *(const float4*)(cst + 928 + c4);
                const uint2 vfu = *(const uint2*)(raw + tau * SC_ROWB + 960 + c4 * 2);
                const float vf[4] = {__uint_as_float(vfu.x << 16), __uint_as_float(vfu.x & 0xFFFF0000u), __uint_as_float(vfu.y << 16), __uint_as_float(vfu.y & 0xFFFF0000u)};
                const float xv[4] = {xv4.x + cv.x, xv4.y + cv.y, xv4.z + cv.z, xv4.w + cv.w};
#pragma unroll
                for (int j = 0; j < 4; ++j) vv[j] = vv[j] + (vf[j] - vv[j]) * fast_sigmoid(xv[j]);
            } else if (t < TS) {
                *(uint2*)(vfirst + n * 1024 + hc + c4) = pack4(vv[0], vv[1], vv[2], vv[3]);
            }
            float dec[4], av[4], kkv[4]; float ss = 0.f;
#pragma unroll
            for (int j = 0; j < 4; ++j) {
                dec[j] = __expf(-0.6065306597126334f * fast_sigmoid(xw[j]));
                av[j] = fast_sigmoid(xa[j]);
                kkv[j] = kr[j] * kkc[j];
                ss += kkv[j] * kkv[j];
            }
            ss = row16_sum(ss);
            const float rn = rsqrtf(fmaxf(ss, 1e-24f));
            float kk[4];
#pragma unroll
            for (int j = 0; j < 4; ++j) kk[j] = kkv[j] * rn;
            *(float4*)(s_w + e) = make_float4(dec[0], dec[1], dec[2], dec[3]);
            *(float4*)(s_a + e) = make_float4(-kk[0], -kk[1], -kk[2], -kk[3]);
            *(float4*)(s_b + e) = make_float4(kk[0] * av[0], kk[1] * av[1], kk[2] * av[2], kk[3] * av[3]);
            *(float4*)(s_k + e) = make_float4(kr[0] * (1.0f + (av[0] - 1.0f) * kac[0]), kr[1] * (1.0f + (av[1] - 1.0f) * kac[1]), kr[2] * (1.0f + (av[2] - 1.0f) * kac[2]), kr[3] * (1.0f + (av[3] - 1.0f) * kac[3]));
            *(float4*)(s_v + e) = make_float4(vv[0], vv[1], vv[2], vv[3]);
        }
        lds_barrier();
        {
            struct VS { float4 w, b, k, r, a; float2 v; };
            VS X, Y;
            {
                const float4 a4 = *(const float4*)(s_a + cg * 4);
                float sa0_ = S0[0] * a4.x + S0[1] * a4.y + S0[2] * a4.z + S0[3] * a4.w;
                float sa1_ = S1[0] * a4.x + S1[1] * a4.y + S1[2] * a4.z + S1[3] * a4.w;
                float du0 = 0.f, du1 = 0.f;
                row16_sum4(sa0_, sa1_, du0, du1);
                X.w = *(const float4*)(s_w + cg * 4); X.b = *(const float4*)(s_b + cg * 4); X.k = *(const float4*)(s_k + cg * 4); X.r = *(const float4*)(s_r + cg * 4);
                X.v = *(const float2*)(s_v + wid * 8 + rg * 2);
                X.a = *(const float4*)(s_a + 64 + cg * 4);
                float sa0 = sa0_, sa1 = sa1_;
                auto step = [&](VS& C, VS& N, int tau) {
                    const int tn = (tau + 1 < SC_TC) ? tau + 1 : tau, tn2 = (tau + 2 < SC_TC) ? tau + 2 : tau;
                    N.a = *(const float4*)(s_a + tn2 * 64 + cg * 4);
                    N.w = *(const float4*)(s_w + tn * 64 + cg * 4);
                    N.b = *(const float4*)(s_b + tn * 64 + cg * 4);
                    N.k = *(const float4*)(s_k + tn * 64 + cg * 4);
                    N.r = *(const float4*)(s_r + tn * 64 + cg * 4);
                    N.v = *(const float2*)(s_v + tn * 64 + wid * 8 + rg * 2);
                    S0[0] = S0[0] * C.w.x + (sa0 * C.b.x + C.v.x * C.k.x); S0[1] = S0[1] * C.w.y + (sa0 * C.b.y + C.v.x * C.k.y);
                    S0[2] = S0[2] * C.w.z + (sa0 * C.b.z + C.v.x * C.k.z); S0[3] = S0[3] * C.w.w + (sa0 * C.b.w + C.v.x * C.k.w);
                    S1[0] = S1[0] * C.w.x + (sa1 * C.b.x + C.v.y * C.k.x); S1[1] = S1[1] * C.w.y + (sa1 * C.b.y + C.v.y * C.k.y);
                    S1[2] = S1[2] * C.w.z + (sa1 * C.b.z + C.v.y * C.k.z); S1[3] = S1[3] * C.w.w + (sa1 * C.b.w + C.v.y * C.k.w);
                    float o0 = S0[0] * C.r.x + S0[1] * C.r.y + S0[2] * C.r.z + S0[3] * C.r.w;
                    float o1 = S1[0] * C.r.x + S1[1] * C.r.y + S1[2] * C.r.z + S1[3] * C.r.w;
                    sa0 = S0[0] * C.a.x + S0[1] * C.a.y + S0[2] * C.a.z + S0[3] * C.a.w;
                    sa1 = S1[0] * C.a.x + S1[1] * C.a.y + S1[2] * C.a.z + S1[3] * C.a.w;
                    row16_sum4(sa0, sa1, o0, o1);
                    if (cg == 0) *(float2*)(s_o + tau * 64 + wid * 8 + rg * 2) = make_float2(o0, o1);
                };
#pragma unroll 1
                for (int tau = 0; tau < nval; tau += 2) { step(X, Y, tau); step(Y, X, tau + 1); }
            }
        }
        lds_barrier();
        {
            const int tau = tid >> 4, c4 = (tid & 15) * 4, e = tau * 64 + c4;
            const size_t n = (size_t)b * TS + t0 + tau;
            const float4 o4 = *(const float4*)(s_o + e), r4_ = *(const float4*)(s_r + e), k4_ = *(const float4*)(s_k + e), v4_ = *(const float4*)(s_v + e), g4_ = *(const float4*)(s_g + e);
            const float4 crk = *(const float4*)(cst + 736 + c4), clw = *(const float4*)(cst + 800 + c4), clb = *(const float4*)(cst + 864 + c4);
            float osum = (o4.x + o4.y) + (o4.z + o4.w);
            float bsum = r4_.x * k4_.x * crk.x + r4_.y * k4_.y * crk.y + r4_.z * k4_.z * crk.z + r4_.w * k4_.w * crk.w;
            float du0 = 0.f, du1 = 0.f;
            row16_sum4(osum, bsum, du0, du1);
            const float m_ = osum * (1.0f / 64.0f);
            const float d0 = o4.x - m_, d1 = o4.y - m_, d2 = o4.z - m_, d3 = o4.w - m_;
            const float var = row16_sum(d0 * d0 + d1 * d1 + d2 * d2 + d3 * d3) * (1.0f / 64.0f);
            const float rs = rsqrtf(var + 64e-5f);
            const float y0 = (d0 * rs * clw.x + clb.x + bsum * v4_.x) * g4_.x, y1 = (d1 * rs * clw.y + clb.y + bsum * v4_.y) * g4_.y;
            const float y2 = (d2 * rs * clw.z + clb.z + bsum * v4_.z) * g4_.z, y3 = (d3 * rs * clw.w + clb.w + bsum * v4_.w) * g4_.w;
            if (tau < nval) *(uint2*)(Pr + n * 1024 + hc + c4) = pack4(y0, y1, y2, y3);
        }
    }
}

__device__ void phase_merge(const Params& p, unsigned char* lds) {
    const int tid = otid(), lane = tid & 63, wid = tid >> 6, wr = wid >> 1, wc = wid & 1, fr = lane & 15, fq = lane >> 4;
    const bf16_t* h = (const bf16_t*)(WS(p) + OFF_H);
    const bf16_t* wb = (const bf16_t*)(WS(p) + OFF_WB);
    const float* rstd = (const float*)(WS(p) + OFF_RSTD);
    bf16_t* merged = (bf16_t*)(WS(p) + OFF_MERGED);
    const bf16_t* ysrc0 = (const bf16_t*)(WS(p) + OFF_PPOOL);
    const bf16_t* ysrc1 = (const bf16_t*)(WS(p) + OFF_PR);
    const bf16_t* ysrc2 = (const bf16_t*)(OUTB(p) + DO_YC);
    for (int tile = obid(); tile < 86 * 8; tile += gridDim.x) {
        const int mt = tile >> 3, nt = tile & 7;
        const int row0 = mt * 192, col0 = nt * 128;
        uint2 maccp[3][4];
#pragma unroll
        for (int m = 0; m < 3; ++m)
#pragma unroll
            for (int n = 0; n < 4; ++n) maccp[m][n] = make_uint2(0u, 0u);
#pragma unroll 1
        for (int i = 0; i < 3; ++i) {
            const bf16_t* ys = (i == 0) ? ysrc0 : (i == 1 ? ysrc1 : ysrc2);
            uint2 sg[3][4];
            {
                f32x4 ag[3][4]; g3_zero<3>(ag);
                G3<192> g;
                g3_setup<192>(g, [&](int r) { return h + (size_t)(row0 + r) * DM; }, [&](int r) { return wb + WB_WG + (size_t)(i * 1024 + col0 + r) * DM; }, tid);
                g3_kloop<192>(ag, g, DM, lds);
#pragma unroll
                for (int m = 0; m < 3; ++m) {
                    const float rs = rstd[row0 + wr * 48 + m * 16 + fr];
#pragma unroll
                    for (int n = 0; n < 4; ++n) sg[m][n] = pack4(fast_sigmoid(ag[m][n][0] * rs), fast_sigmoid(ag[m][n][1] * rs), fast_sigmoid(ag[m][n][2] * rs), fast_sigmoid(ag[m][n][3] * rs));
                }
            }
            {
                f32x4 ay[3][4]; g3_zero<3>(ay);
                G3<192> g;
                g3_setup<192>(g, [&](int r) { return ys + (size_t)(row0 + r) * DM; }, [&](int r) { return wb + WB_PA + (size_t)(i * 1024 + col0 + r) * DM; }, tid);
                g3_kloop<192>(ay, g, DM, lds);
#pragma unroll
                for (int m = 0; m < 3; ++m)
#pragma unroll
                    for (int n = 0; n < 4; ++n) {
                        const float m0 = __uint_as_float(maccp[m][n].x << 16) + __uint_as_float(sg[m][n].x << 16) * ay[m][n][0];
                        const float m1 = __uint_as_float(maccp[m][n].x & 0xFFFF0000u) + __uint_as_float(sg[m][n].x & 0xFFFF0000u) * ay[m][n][1];
                        const float m2 = __uint_as_float(maccp[m][n].y << 16) + __uint_as_float(sg[m][n].y << 16) * ay[m][n][2];
                        const float m3 = __uint_as_float(maccp[m][n].y & 0xFFFF0000u) + __uint_as_float(sg[m][n].y & 0xFFFF0000u) * ay[m][n][3];
                        maccp[m][n] = pack4(m0, m1, m2, m3);
                    }
            }
        }
#pragma unroll
        for (int m = 0; m < 3; ++m) {
            const int row = row0 + wr * 48 + m * 16 + fr;
#pragma unroll
            for (int n = 0; n < 4; ++n)
                *(uint2*)(merged + (size_t)row * 1024 + col0 + wc * 64 + n * 16 + fq * 4) = maccp[m][n];
        }
    }
}

__device__ void phase_outproj(const Params& p, unsigned char* lds) {
    const int tid = otid(), lane = tid & 63, wid = tid >> 6, wr = wid >> 1, wc = wid & 1, fr = lane & 15, fq = lane >> 4;
    const bf16_t* h = (const bf16_t*)(WS(p) + OFF_H);
    const bf16_t* wb = (const bf16_t*)(WS(p) + OFF_WB);
    const bf16_t* merged = (const bf16_t*)(WS(p) + OFF_MERGED);
    float* hm = (float*)(WS(p) + OFF_HM32);
    for (int tile = obid(); tile < 86 * 8; tile += gridDim.x) {
        const int mt = tile >> 3, nt = tile & 7;
        const int row0 = mt * 192, col0 = nt * 128;
        G3<192> g;
        g3_setup<192>(g, [&](int r) { return merged + (size_t)(row0 + r) * DM; }, [&](int r) { return wb + WB_WO + (size_t)(col0 + r) * DM; }, tid);
        f32x4 acc[3][4]; g3_zero<3>(acc);
        g3_kloop<192>(acc, g, DM, lds);
#pragma unroll
        for (int m = 0; m < 3; ++m) {
            const int row = row0 + wr * 48 + m * 16 + fr;
#pragma unroll
            for (int n = 0; n < 4; ++n) {
                const int col = col0 + wc * 64 + n * 16 + fq * 4;
                const uint2 hv = *(const uint2*)(h + (size_t)row * 1024 + col);
                float4 o;
                o.x = __uint_as_float(hv.x << 16) + acc[m][n][0]; o.y = __uint_as_float(hv.x & 0xFFFF0000u) + acc[m][n][1];
                o.z = __uint_as_float(hv.y << 16) + acc[m][n][2]; o.w = __uint_as_float(hv.y & 0xFFFF0000u) + acc[m][n][3];
                *(float4*)(hm + (size_t)row * 1024 + col) = o;
            }
        }
    }
}

__device__ __constant__ int c_pair_lo[6] = {0, 0, 0, 1, 1, 2};
__device__ __constant__ int c_pair_hi[6] = {1, 2, 3, 2, 3, 3};
__device__ void phase_route(const Params& p, int l, unsigned char* lds) {
    const int tid = otid(), lane = tid & 63, wid = tid >> 6;
    const int per = (NT + (int)gridDim.x - 1) / (int)gridDim.x;
    const int nbeg = obid() * per, nend = (nbeg + per < NT) ? nbeg + per : NT;
    int* s_cls = (int*)lds;
    int* s_base = s_cls + 128;
    float* s_wr = (float*)(lds + 1024);
    const float* hm = (const float*)(WS(p) + OFF_HM32);
    bf16_t* hn = (bf16_t*)(WS(p) + OFF_HN);
    const float* nf = p.in[33] + (size_t)l * 1024;
    const float* wg = p.in[34] + (size_t)l * 1024 * 4;
    const float* bg = p.in[35] + l * 4;
    const float* we = p.in[36] + (size_t)l * 1024 * 16;
    const float* be = p.in[37] + l * 16;
    int* cnt = (int*)(WS(p) + OFF_CTL);
    int* list = (int*)(WS(p) + OFF_LIST);
    float* pw = (float*)(WS(p) + OFF_PW);
    for (int e = tid; e < 1024 * 20; e += NTHR) {
        const int k = e / 20, c = e - k * 20;
        s_wr[c * 1024 + k] = (c < 4) ? wg[(size_t)k * 4 + c] : we[(size_t)k * 16 + (c - 4)];
    }
    __syncthreads();
    for (int n = nbeg + wid; n < nend; n += 8) {
        float ss = 0.f;
#pragma unroll
        for (int i = 0; i < 4; ++i) {
            const float4 v = *(const float4*)(hm + (size_t)n * DM + i * 256 + lane * 4);
            ss += v.x * v.x + v.y * v.y + v.z * v.z + v.w * v.w;
        }
        ss = wave_sum(ss);
        const float rs = rsqrtf(ss * (1.0f / 1024.0f) + 1e-6f);
        float lg[4] = {0.f, 0.f, 0.f, 0.f};
        float le[16];
#pragma unroll
        for (int e = 0; e < 16; ++e) le[e] = 0.f;
#pragma unroll 1
        for (int i = 0; i < 4; ++i) {
            const float4 xv = *(const float4*)(hm + (size_t)n * DM + i * 256 + lane * 4);
            const float4 nv = *(const float4*)(nf + i * 256 + lane * 4);
            float y[4] = {xv.x * rs * nv.x, xv.y * rs * nv.y, xv.z * rs * nv.z, xv.w * rs * nv.w};
            {
                const int d0 = i * 256 + lane * 4;
#pragma unroll
                for (int g = 0; g < 4; ++g) { const float4 w4 = *(const float4*)(s_wr + g * 1024 + d0); lg[g] += y[0] * w4.x + y[1] * w4.y + y[2] * w4.z + y[3] * w4.w; }
#pragma unroll
                for (int e = 0; e < 16; ++e) { const float4 w4 = *(const float4*)(s_wr + (4 + e) * 1024 + d0); le[e] += y[0] * w4.x + y[1] * w4.y + y[2] * w4.z + y[3] * w4.w; }
            }
            ushort4 o;
            o.x = f2bf(y[0]); o.y = f2bf(y[1]); o.z = f2bf(y[2]); o.w = f2bf(y[3]);
            *(ushort4*)(hn + (size_t)n * DM + i * 256 + lane * 4) = o;
        }
#pragma unroll
        for (int g = 0; g < 4; ++g) lg[g] = wave_sum_fast(lg[g]) + bg[g];
#pragma unroll
        for (int e = 0; e < 16; ++e) le[e] = wave_sum_fast(le[e]) + be[e];
        if (lane == 0) {
            int gs = 0; float gm = lg[0];
#pragma unroll
            for (int g = 1; g < 4; ++g) if (lg[g] > gm) { gm = lg[g]; gs = g; }
            float den = 0.f;
#pragma unroll
            for (int g = 0; g < 4; ++g) den += __expf(lg[g] - gm);
            const float pgrp = 1.0f / den;
            float v4[4];
#pragma unroll
            for (int e = 0; e < 4; ++e) {
                const float m0 = (gs == 0) ? 1.f : 0.f, m1s = (gs == 1) ? 1.f : 0.f, m2s = (gs == 2) ? 1.f : 0.f, m3s = (gs == 3) ? 1.f : 0.f;
                v4[e] = le[e] * m0 + le[4 + e] * m1s + le[8 + e] * m2s + le[12 + e] * m3s;
            }
            int i1 = 0; float m1 = v4[0];
#pragma unroll
            for (int e = 1; e < 4; ++e) if (v4[e] > m1) { m1 = v4[e]; i1 = e; }
            int i2 = -1; float m2 = -INFINITY;
#pragma unroll
            for (int e = 0; e < 4; ++e) if (e != i1 && v4[e] > m2) { m2 = v4[e]; i2 = e; }
            const float e2 = __expf(m2 - m1);
            const float p1 = pgrp / (1.0f + e2), p2 = pgrp * e2 / (1.0f + e2);
            const int lo = i1 < i2 ? i1 : i2, hi = i1 < i2 ? i2 : i1;
            const float plo = i1 < i2 ? p1 : p2, phi = i1 < i2 ? p2 : p1;
            const int pi = (lo == 0) ? (hi - 1) : (lo == 1 ? hi + 1 : 5);
            const int cls = gs * 6 + pi;
            s_cls[n - nbeg] = cls;
            pw[(size_t)n * 2 + 0] = plo; pw[(size_t)n * 2 + 1] = phi;
        }
    }
    __syncthreads();
    const int nloc = nend - nbeg;
    if (tid < 24) {
        int c_ = 0;
        for (int i = 0; i < nloc; ++i) c_ += (s_cls[i] == tid) ? 1 : 0;
        s_base[tid] = c_ ? atomicAdd(&cnt[tid * 32], c_) : 0;
    }
    __syncthreads();
    if (tid < nloc) {
        const int cls = s_cls[tid];
        int rank = 0;
        for (int i = 0; i < tid; ++i) rank += (s_cls[i] == cls) ? 1 : 0;
        list[(size_t)cls * NT + s_base[cls] + rank] = nbeg + tid;
    }
    __syncthreads();
}


struct MoeTile { int cls, ti, cnt, tg; };
__device__ __forceinline__ int moe_total_tiles(const int* cnt) { int s = 0; for (int c = 0; c < 24; ++c) s += (cnt[c * 32] + 127) >> 7; return s; }
__device__ __forceinline__ MoeTile moe_find(const int* cnt, int tile) {
    MoeTile r; int s = 0; r.cls = 0; r.ti = 0; r.cnt = 0; r.tg = tile;
    for (int c = 0; c < 24; ++c) { const int nt = (cnt[c * 32] + 127) >> 7; if (tile >= s && tile < s + nt) { r.cls = c; r.ti = tile - s; r.cnt = cnt[c * 32]; } s += nt; }
    return r;
}
__device__ void phase_moe1(const Params& p, unsigned char* lds) {
    const int tid = otid(), lane = tid & 63, wid = tid >> 6, wr = wid >> 1, wc = wid & 1, fr = lane & 15, fq = lane >> 4;
    const int* cnt = (const int*)(WS(p) + OFF_CTL);
    const int* list = (const int*)(WS(p) + OFF_LIST);
    const float* pw = (const float*)(WS(p) + OFF_PW);
    const bf16_t* hn = (const bf16_t*)(WS(p) + OFF_HN);
    const bf16_t* we = (const bf16_t*)(WS(p) + OFF_WEXP);
    bf16_t* hid = (bf16_t*)(OUTB(p) + DO_HID);
    const int total = moe_total_tiles(cnt);
    for (int item = obid(); item < total * 4; item += gridDim.x) {
        const MoeTile mt = moe_find(cnt, item >> 2);
        const int nt = item & 3, slot = nt >> 1, f0 = (nt & 1) * 128;
        const int g_ = mt.cls / 6, pi = mt.cls % 6;
        const int e = g_ * 4 + (slot == 0 ? c_pair_lo[pi] : c_pair_hi[pi]);
        const int* lst = list + (size_t)mt.cls * NT + mt.ti * 128;
        const int nvalid = min(128, mt.cnt - mt.ti * 128);
        f32x4 a1[2][4], a3[2][4]; g3_zero<2>(a1); g3_zero<2>(a3);
        G3<128> g;
        g3_setup<128>(g, [&](int r) { return hn + (size_t)lst[r < nvalid ? r : 0] * DM; }, [&](int r) { return we + WE_W1 + ((size_t)e * 256 + f0 + r) * 1024; }, tid);
        g3_kloop<128>(a1, g, DM, lds);
        g3_setup<128>(g, [&](int r) { return hn + (size_t)lst[r < nvalid ? r : 0] * DM; }, [&](int r) { return we + WE_W3 + ((size_t)e * 256 + f0 + r) * 1024; }, tid);
        g3_kloop<128>(a3, g, DM, lds);
#pragma unroll
        for (int m = 0; m < 2; ++m) {
            const int lr = wr * 32 + m * 16 + fr;
            const int tk = lst[lr < nvalid ? lr : 0];
            const float pe = pw[(size_t)tk * 2 + slot];
#pragma unroll
            for (int n = 0; n < 4; ++n) {
                const int col = slot * 256 + f0 + wc * 64 + n * 16 + fq * 4;
                float o[4];
#pragma unroll
                for (int j = 0; j < 4; ++j) { const float x1 = a1[m][n][j]; o[j] = x1 * sigmoidf_(x1) * a3[m][n][j] * pe; }
                *(uint2*)(hid + ((size_t)mt.tg * 128 + lr) * 512 + col) = pack4(o[0], o[1], o[2], o[3]);
            }
        }
    }
}
__device__ void phase_moe2(const Params& p, unsigned char* lds) {
    const int tid = otid(), lane = tid & 63, wid = tid >> 6, wr = wid >> 1, wc = wid & 1, fr = lane & 15, fq = lane >> 4;
    const int* cnt = (const int*)(WS(p) + OFF_CTL);
    const int* list = (const int*)(WS(p) + OFF_LIST);
    const bf16_t* we = (const bf16_t*)(WS(p) + OFF_WEXP);
    const bf16_t* hid = (const bf16_t*)(OUTB(p) + DO_HID);
    float* hm = (float*)(WS(p) + OFF_HM32);
    bf16_t* h = (bf16_t*)(WS(p) + OFF_H);
    const int total = moe_total_tiles(cnt);
    for (int item = obid(); item < total * 8; item += gridDim.x) {
        const MoeTile mt = moe_find(cnt, item >> 3);
        const int nt = item & 7, col0 = nt * 128;
        const int g_ = mt.cls / 6, pi = mt.cls % 6;
        const int elo = g_ * 4 + c_pair_lo[pi], ehi = g_ * 4 + c_pair_hi[pi];
        const int* lst = list + (size_t)mt.cls * NT + mt.ti * 128;
        const int nvalid = min(128, mt.cnt - mt.ti * 128);
        f32x4 acc[2][4]; g3_zero<2>(acc);
        G3<128> g;
        g3_setup<128>(g, [&](int r) { return hid + ((size_t)mt.tg * 128 + r) * 512; }, [&](int r) { return we + WE_W2 + ((size_t)elo * 1024 + col0 + r) * 256; }, tid);
        g3_kloop<128>(acc, g, 256, lds);
        g3_setup<128>(g, [&](int r) { return hid + ((size_t)mt.tg * 128 + r) * 512 + 256; }, [&](int r) { return we + WE_W2 + ((size_t)ehi * 1024 + col0 + r) * 256; }, tid);
        g3_kloop<128>(acc, g, 256, lds);
#pragma unroll
        for (int m = 0; m < 2; ++m) {
            const int lr = wr * 32 + m * 16 + fr;
            if (lr < nvalid) {
                const int tk = lst[lr];
#pragma unroll
                for (int n = 0; n < 4; ++n) {
                    const int col = col0 + wc * 64 + n * 16 + fq * 4;
                    float4 v = *(const float4*)(hm + (size_t)tk * 1024 + col);
                    v.x += acc[m][n][0]; v.y += acc[m][n][1]; v.z += acc[m][n][2]; v.w += acc[m][n][3];
                    *(float4*)(hm + (size_t)tk * 1024 + col) = v;
                    *(uint2*)(h + (size_t)tk * 1024 + col) = pack4(v.x, v.y, v.z, v.w);
                }
            }
        }
    }
}

__device__ void phase_final(const Params& p) {
    const int lane = otid() & 63;
    const int wave = (obid() * NTHR + otid()) >> 6, nw = gridDim.x * NTHR / 64;
    const float* hm = (const float*)(WS(p) + OFF_HM32);
    const float* nf = p.in[41];
    for (int r = wave; r < NB * SEQ; r += nw) {
        const int b = r / SEQ, s = r % SEQ;
        const size_t n = (size_t)b * TS + NMETA + s;
        float4 v[4]; float ss = 0.f;
#pragma unroll
        for (int i = 0; i < 4; ++i) { v[i] = *(const float4*)(hm + n * DM + i * 256 + lane * 4); ss += v[i].x * v[i].x + v[i].y * v[i].y + v[i].z * v[i].z + v[i].w * v[i].w; }
        ss = wave_sum(ss);
        const float rs = rsqrtf(ss * (1.0f / 1024.0f) + 1e-6f);
#pragma unroll
        for (int i = 0; i < 4; ++i) {
            const float4 g = *(const float4*)(nf + i * 256 + lane * 4);
            float4 o; o.x = v[i].x * rs * g.x; o.y = v[i].y * rs * g.y; o.z = v[i].z * rs * g.z; o.w = v[i].w * rs * g.w;
            *(float4*)((float*)OUTB(p) + (size_t)r * DM + i * 256 + lane * 4) = o;
        }
    }
}


#define XB_TMO      128
#define XB_XCNT(j)  (256  + 64 * (j))
#define XB_XSUB(j)  (1280 + 64 * (j))
#define XB_XGEN(j)  (2304 + 64 * (j))
#define XB_TOP      3328
#define XB_TOPGEN   3392
#define XCD_BAR_WORDS 3456
#define XB_SPIN_CAP (1u << 22)
#define LAS __attribute__((address_space(3)))
__device__ __forceinline__ unsigned xb_ld(unsigned* p) { return __hip_atomic_load(p, __ATOMIC_RELAXED, __HIP_MEMORY_SCOPE_AGENT); }
__device__ __forceinline__ unsigned xb_add(unsigned* p, unsigned v) { return __hip_atomic_fetch_add(p, v, __ATOMIC_RELAXED, __HIP_MEMORY_SCOPE_AGENT); }
__device__ __forceinline__ unsigned xb_xcc_id() { return (unsigned)__builtin_amdgcn_s_getreg((3 << 11) | 20) & 0xFu; }
#define XB_SPIN(cond, bar) do { unsigned _sp = 0; while (cond) { __builtin_amdgcn_s_sleep(1); \
    if ((++_sp & 255u) == 0u) { if (xb_ld(&(bar)[XB_TMO])) break; if (_sp > XB_SPIN_CAP) { atomicAdd(&(bar)[XB_TMO], 1u); break; } } } } while (0)
struct XcdBarrier { unsigned* bar; unsigned x; volatile LAS unsigned* st; };
__device__ __forceinline__ XcdBarrier xcd_barrier_post(unsigned* bar, volatile LAS unsigned* st) {
    XcdBarrier b; b.bar = bar; b.x = xb_xcc_id(); b.st = st;
    if (threadIdx.x == 0) (void)xb_add(&bar[XB_XCNT(b.x)], 1u);
    return b;
}
__device__ __forceinline__ void xcd_barrier_complete(unsigned* bar, unsigned x, unsigned& nloc, unsigned& nx) {
    const unsigned G = gridDim.x * gridDim.y * gridDim.z;
    unsigned sum, cnt, mine, sp = 0u;
    for (;;) {
        sum = 0u; cnt = 0u; mine = 0u;
#pragma unroll
        for (unsigned j = 0; j < 16; ++j) { const unsigned c = xb_ld(&bar[XB_XCNT(j)]); sum += c; cnt += (c > 0u) ? 1u : 0u; mine = (j == x) ? c : mine; }
        if (sum == G) break;
        __builtin_amdgcn_s_sleep(1);
        if ((++sp & 255u) == 0u) { if (xb_ld(&bar[XB_TMO])) break; if (sp > XB_SPIN_CAP) { atomicAdd(&bar[XB_TMO], 1u); break; } }
    }
    nloc = mine > 0u ? mine : 1u; nx = cnt > 0u ? cnt : 1u;
}
__device__ __forceinline__ void xcd_barrier(const XcdBarrier& b) {
    asm volatile("s_waitcnt vmcnt(0)" ::: "memory");
    __syncthreads();
    if (threadIdx.x == 0) {
        unsigned* bar = b.bar;
        __builtin_amdgcn_s_waitcnt(0);
        unsigned nloc = b.st[0], nx = b.st[1];
        if (nloc == 0u) { xcd_barrier_complete(bar, b.x, nloc, nx); b.st[0] = nloc; b.st[1] = nx; }
        const unsigned old = xb_add(&bar[XB_XSUB(b.x)], 1u);
        const unsigned gen = old / nloc;
        if (old + 1u == (gen + 1u) * nloc) {
            __builtin_amdgcn_fence(__ATOMIC_RELEASE, "agent");
            asm volatile("s_waitcnt vmcnt(0)" ::: "memory");
            const unsigned og = xb_add(&bar[XB_TOP], 1u);
            const unsigned tg = og / nx;
            if (og + 1u == (tg + 1u) * nx) xb_add(&bar[XB_TOPGEN], 1u);
            else XB_SPIN(xb_ld(&bar[XB_TOPGEN]) == tg, bar);
            __builtin_amdgcn_fence(__ATOMIC_ACQUIRE, "agent");
            xb_add(&bar[XB_XGEN(b.x)], 1u);
            asm volatile("s_waitcnt vmcnt(0)" ::: "memory");
        } else {
            XB_SPIN(xb_ld(&bar[XB_XGEN(b.x)]) == gen, bar);
            __builtin_amdgcn_fence(__ATOMIC_ACQUIRE, "agent");
            asm volatile("s_waitcnt vmcnt(0)" ::: "memory");
        }
    }
    __syncthreads();
}

__global__ void __launch_bounds__(NTHR) fwd_megakernel(Params p) {
    extern __shared__ __attribute__((aligned(16))) unsigned char lds[];
    cg::grid_group grid = cg::this_grid();
    volatile LAS unsigned* xst = (volatile LAS unsigned*)(lds + LDS_BYTES - 32);
    if (threadIdx.x < 2) xst[threadIdx.x] = 0u;
    __syncthreads();
    const XcdBarrier xb = xcd_barrier_post((unsigned*)(p.ws + OFF_BAR), xst);
#pragma unroll 1
    for (int step = 0; step < 18; ++step) {
        const int l = step >= 9 ? 1 : 0;
        const int ph = step - l * 9;
        switch (ph) {
        case 0:
            if (l == 0) phase_embed(p); else phase_rowstat(p);
            phase_convert<false>(p, l, lds);
            if (obid() == 0 && otid() < 24) ((int*)(WS(p) + OFF_CTL))[otid() * 32] = 0;
            if (obid() == 0 && otid() == 32) ((int*)(WS(p) + OFF_CTL))[800 + l * 32] = 0;
            break;
        case 1: phase_inproj(p, lds); break;
        case 2: phase_dsa_prep(p, l); phase_lr_prep(p, l); break;
        case 3: {
            if (obid() < NB * 16) phase_scan5(p, l, lds, obid());
            int* qctr = (int*)(WS(p) + OFF_CTL) + 800 + l * 32;
            int* qslot = (int*)(lds + LDS_BYTES - 16);
            for (;;) {
                __syncthreads();
                if (otid() == 0) *qslot = atomicAdd(qctr, 1);
                __syncthreads();
                const int item = *qslot;
                if (item >= 516 + NT / 16) break;
                if (item < 516) phase_pool(p, l, lds, item, item + 1, 1);
                else phase_dsa<false>(p, l, lds, (bf16_t*)(OUTB(p) + DO_YC), nullptr, nullptr, item - 516, item - 515, 1);
            }
        } break;
        case 4: phase_merge(p, lds); break;
        case 5: phase_outproj(p, lds); phase_convert<true>(p, l, lds); break;
        case 6: phase_route(p, l, lds); break;
        case 7: phase_moe1(p, lds); break;
        default: phase_moe2(p, lds); break;
        }
        if (step == 0) grid.sync(); else xcd_barrier(xb);
    }
    phase_final(p);
}

extern "C" void kernel_launch(void* const* d_in, const int* in_sizes, int n_in,
                              void* d_out, int out_size, void* d_ws, size_t ws_size,
                              hipStream_t stream) {
    static int grid_blocks = 0;
    if (grid_blocks == 0) {
        int dev = 0, cus = 0, per_cu = 0;
        (void)hipGetDevice(&dev);
        (void)hipDeviceGetAttribute(&cus, hipDeviceAttributeMultiprocessorCount, dev);
        (void)hipFuncSetAttribute((const void*)fwd_megakernel, hipFuncAttributeMaxDynamicSharedMemorySize, LDS_BYTES);
        (void)hipOccupancyMaxActiveBlocksPerMultiprocessor(&per_cu, fwd_megakernel, NTHR, LDS_BYTES);
        if (per_cu < 1 || n_in != 42 || ws_size < WS_END) { fprintf(stderr, "kernel_launch: bad config per_cu=%d n_in=%d ws=%zu need=%zu\n", per_cu, n_in, ws_size, (size_t)WS_END); grid_blocks = -1; }
        else grid_blocks = cus;
    }
    if (grid_blocks < 0) return;
    Params p{};
    for (int i = 0; i < 42; ++i) p.in[i] = (const float*)d_in[i];
    p.out = (float*)d_out;
    p.ws = (unsigned char*)d_ws;
    (void)hipMemsetAsync((unsigned char*)d_ws + OFF_BAR, 0, XCD_BAR_WORDS * 4, stream);
    void* args[] = {&p};
    hipError_t e = hipLaunchCooperativeKernel((void*)fwd_megakernel, dim3(grid_blocks), dim3(NTHR), args, LDS_BYTES, stream);
    if (e != hipSuccess) fprintf(stderr, "cooperative launch failed: %s (grid %d)\n", hipGetErrorString(e), grid_blocks);
}
```

```cpp
#include <hip/hip_runtime.h>
#include <hip/hip_cooperative_groups.h>
#include <cstdio>
#include <cstdint>
#include <type_traits>
namespace cg = cooperative_groups;

typedef unsigned short bf16_t;
typedef short bf16x8 __attribute__((ext_vector_type(8)));
typedef float f32x4 __attribute__((ext_vector_type(4)));

constexpr int NB = 8, SEQ = 2048, NMETA = 16, TS = 2064, DM = 1024;
constexpr int NT = NB * TS;
constexpr int NTP = 16640;
constexpr int NTHR = 512;
constexpr int CIN = 7912;
constexpr int NP1 = 4992;
constexpr int PM_LD = 896;
constexpr int PM_WD = 0, PM_AD = 64, PM_GD = 128, PM_VD = 256, PM_CQ = 320, PM_CKV = 576, PM_KROPE = 704, PM_KIDX = 736, PM_WIDX = 800;
constexpr int LDS_BYTES = 157 * 1024;

constexpr size_t AL(size_t x) { return (x + 255) & ~(size_t)255; }
constexpr size_t SZ_ACT = (size_t)NTP * 1024 * 2;
constexpr size_t OFF_CTL = 0;
constexpr size_t OFF_BAR = 4096;
constexpr size_t OFF_RSTD = OFF_BAR + 16384;
constexpr size_t OFF_ROPE = OFF_RSTD + AL((size_t)NTP * 4);
constexpr size_t OFF_H = OFF_ROPE + AL((size_t)TS * 16 * 4 * 2);
constexpr size_t OFF_WB = OFF_H + SZ_ACT;
constexpr size_t WB_WIN = 0;
constexpr size_t WB_WG = WB_WIN + (size_t)NP1 * 1024;
constexpr size_t WB_PA = WB_WG + (size_t)3072 * 1024;
constexpr size_t WB_WO = WB_PA + (size_t)3 * 1024 * 1024;
constexpr size_t WB_POOL = WB_WO + (size_t)1024 * 1024;
constexpr size_t WB_QI = WB_POOL + (size_t)4 * 256 * 256;
constexpr size_t WB_UQ = WB_QI + (size_t)512 * 256;
constexpr size_t WB_UK = WB_UQ + (size_t)1536 * 256;
constexpr size_t WB_UV = WB_UK + (size_t)16 * 128 * 64;
constexpr size_t WB_END = WB_UV + (size_t)16 * 64 * 128;
constexpr size_t OFF_PPOOL = OFF_WB + AL(WB_END * 2);
constexpr size_t OFF_PK = OFF_PPOOL + SZ_ACT;
constexpr size_t OFF_PR = OFF_PK + SZ_ACT;
constexpr size_t OFF_PV = OFF_PR + SZ_ACT;
constexpr size_t OFF_PMISC = OFF_PV + SZ_ACT;
constexpr size_t OFF_VFIRST = OFF_PMISC + AL((size_t)NTP * PM_LD * 2);
constexpr size_t OFF_HALO = OFF_VFIRST + SZ_ACT;
constexpr size_t OFF_LIST = OFF_HALO + AL((size_t)130 * 16 * 1024 * 2);
constexpr size_t OFF_PW = OFF_LIST + AL((size_t)24 * NT * 4);
constexpr size_t WS_END = OFF_PW + AL((size_t)NT * 2 * 4);
constexpr size_t OFF_MERGED = OFF_PK;
constexpr size_t OFF_HM32 = OFF_PR;
constexpr size_t OFF_HN = OFF_PPOOL;
constexpr size_t OFF_WEXP = OFF_PMISC;
constexpr size_t WE_W1 = 0, WE_W3 = (size_t)16 * 256 * 1024, WE_W2 = (size_t)2 * 16 * 256 * 1024;
static_assert((size_t)3 * 16 * 256 * 1024 * 2 <= (size_t)NTP * PM_LD * 2, "expert weights must fit in Pmisc");
constexpr size_t DO_YC = 0;
constexpr size_t DO_CQN = DO_YC + SZ_ACT;
constexpr size_t DO_KV = DO_CQN + AL((size_t)NT * 256 * 2);
constexpr size_t DO_KIDX = DO_KV + AL((size_t)NT * 160 * 2);
constexpr size_t DO_WHEAD = DO_KIDX + AL((size_t)NT * 64 * 2);
constexpr size_t DO_ALR = DO_WHEAD + AL((size_t)NT * 8 * 4);
constexpr size_t DO_END = DO_ALR + AL((size_t)NT * 288 * 2);
constexpr size_t DO_HID = DO_YC;
static_assert(DO_END <= (size_t)NB * SEQ * DM * 4, "d_out scratch overflow");
static_assert((size_t)(129 + 24) * 128 * 512 * 2 <= SZ_ACT, "hid fits");
static_assert(WS_END <= 277240096ull, "workspace overflow");

struct Params {
    const float* in[42];
    float* out;
    unsigned char* ws;
};

__device__ __forceinline__ int otid() { int t = threadIdx.x; asm volatile("" : "+v"(t)); return t; }
__device__ __forceinline__ int obid() { int b = blockIdx.x; asm volatile("" : "+s"(b)); return b; }
__device__ __forceinline__ unsigned char* WS(const Params& p) { unsigned char* w = p.ws; asm volatile("" : "+s"(w)); return w; }
__device__ __forceinline__ unsigned char* OUTB(const Params& p) { unsigned char* w = (unsigned char*)p.out; asm volatile("" : "+s"(w)); return w; }
__device__ __forceinline__ float bf2f(bf16_t v) { return __uint_as_float(((unsigned)v) << 16); }
__device__ __forceinline__ bf16_t f2bf(float f) { unsigned u = __float_as_uint(f); u += 0x7FFFu + ((u >> 16) & 1u); return (bf16_t)(u >> 16); }
__device__ __forceinline__ float wave_sum(float v) {
#pragma unroll
    for (int o = 32; o > 0; o >>= 1) v += __shfl_xor(v, o);
    return v;
}
__device__ __forceinline__ float sigmoidf_(float x) { return 1.0f / (1.0f + __expf(-x)); }
__device__ __forceinline__ float softplusf_(float z) { return fmaxf(z, 0.f) + log1pf(__expf(-fabsf(z))); }
__device__ __forceinline__ void glds16(const void* g, void* l) {
    __builtin_amdgcn_global_load_lds((const unsigned*)g, (unsigned*)l, 16, 0, 0);
}

__device__ void phase_embed(const Params& p) {
    const int lane = otid() & 63;
    const int wave = (obid() * NTHR + otid()) >> 6, nw = gridDim.x * NTHR / 64;
    bf16_t* h = (bf16_t*)(WS(p) + OFF_H);
    float* rstd = (float*)(WS(p) + OFF_RSTD);
    for (int n = wave; n < NTP; n += nw) {
        if (n < NT) {
            const int b = n / TS, t = n % TS;
            const float* src = t < NMETA ? p.in[1] + (size_t)t * DM : p.in[0] + ((size_t)b * SEQ + (t - NMETA)) * DM;
            float ss = 0.f;
#pragma unroll
            for (int i = 0; i < 4; ++i) {
                const float4 v = *(const float4*)(src + i * 256 + lane * 4);
                ss += v.x * v.x + v.y * v.y + v.z * v.z + v.w * v.w;
                ushort4 o; o.x = f2bf(v.x); o.y = f2bf(v.y); o.z = f2bf(v.z); o.w = f2bf(v.w);
                *(ushort4*)(h + (size_t)n * DM + i * 256 + lane * 4) = o;
            }
            ss = wave_sum(ss);
            if (lane == 0) rstd[n] = rsqrtf(ss * (1.0f / 1024.0f) + 1e-6f);
        } else {
#pragma unroll
            for (int i = 0; i < 4; ++i) *(ushort4*)(h + (size_t)n * DM + i * 256 + lane * 4) = make_ushort4(0, 0, 0, 0);
            if (lane == 0) rstd[n] = 0.f;
        }
    }
    float* ctab = (float*)(WS(p) + OFF_ROPE);
    float* stab = ctab + TS * 16;
    for (int idx = obid() * NTHR + otid(); idx < TS * 16; idx += gridDim.x * NTHR) {
        const int t = idx >> 4, i = idx & 15;
        const float inv = powf(10000.0f, -(float)(2 * i) / 32.0f);
        const float ang = (float)t * inv;
        ctab[idx] = cosf(ang);
        stab[idx] = sinf(ang);
    }
}

__device__ void phase_rowstat(const Params& p) {
    const int lane = otid() & 63;
    const int wave = (obid() * NTHR + otid()) >> 6, nw = gridDim.x * NTHR / 64;
    const float* hm = (const float*)(WS(p) + OFF_HM32);
    float* rstd = (float*)(WS(p) + OFF_RSTD);
    for (int n = wave; n < NT; n += nw) {
        float ss = 0.f;
#pragma unroll
        for (int i = 0; i < 4; ++i) {
            const float4 v = *(const float4*)(hm + (size_t)n * DM + i * 256 + lane * 4);
            ss += v.x * v.x + v.y * v.y + v.z * v.z + v.w * v.w;
        }
        ss = wave_sum(ss);
        if (lane == 0) rstd[n] = rsqrtf(ss * (1.0f / 1024.0f) + 1e-6f);
    }
}

struct ConvJob { const float* src; bf16_t* dst; const float* scale; int ldsrc, K, nvalid, nrows, nb, notr; size_t sbs, dbs; };
__device__ __forceinline__ int conv_job_tiles(const ConvJob& j) { return j.nb * (j.nrows >> 6) * (j.K >> 6); }
__device__ void conv_tile(const ConvJob& j, int tile, float* lds) {
    const int per = (j.nrows >> 6) * (j.K >> 6);
    const int bi = tile / per, rem = tile % per;
    const int ktiles = j.K >> 6;
    const int n0 = (rem / ktiles) << 6, k0 = (rem % ktiles) << 6;
    const int tid = otid(), tn = tid & 63, tk = tid >> 6;
    const float* src = j.src + (size_t)bi * j.sbs;
    bf16_t* dst = j.dst + (size_t)bi * j.dbs;
#pragma unroll
    for (int kk = 0; kk < 8; ++kk) {
        const int k = k0 + tk * 8 + kk;
        float v = 0.f;
        if (n0 + tn < j.nvalid) { v = j.notr ? src[(size_t)(n0 + tn) * j.ldsrc + k] : src[(size_t)k * j.ldsrc + n0 + tn]; if (j.scale) v *= j.scale[k]; }
        lds[tn * 65 + tk * 8 + kk] = v;
    }
    __syncthreads();
    const int wn = tid >> 3, kq = tid & 7;
    uint4 o;
    unsigned w[4];
#pragma unroll
    for (int q = 0; q < 4; ++q) {
        const float lo = lds[wn * 65 + kq * 8 + 2 * q], hi = lds[wn * 65 + kq * 8 + 2 * q + 1];
        w[q] = (unsigned)f2bf(lo) | ((unsigned)f2bf(hi) << 16);
    }
    o.x = w[0]; o.y = w[1]; o.z = w[2]; o.w = w[3];
    *(uint4*)(dst + (size_t)(n0 + wn) * j.K + k0 + kq * 8) = o;
    __syncthreads();
}
__device__ ConvJob get_job_early(const Params& p, int l, int ji) {
    bf16_t* wb = (bf16_t*)(WS(p) + OFF_WB);
    const float* win = p.in[3] + (size_t)l * DM * CIN;
    const float* nm = p.in[2] + (size_t)l * DM;
    ConvJob j{}; j.nb = 1; j.sbs = 0; j.dbs = 0; j.K = 1024; j.ldsrc = CIN; j.scale = nm;
    switch (ji) {
    case 0: j.src = win + 3072; j.dst = wb + WB_WIN; j.nvalid = 4352; j.nrows = 4352; break;
    case 1: j.src = p.in[17]; j.ldsrc = 32; j.dst = wb + WB_WIN + (size_t)(4096 + PM_VD) * 1024; j.nvalid = (l == 0 ? 0 : 32); j.nrows = 64; break;
    case 2: j.src = win + 7424; j.dst = wb + WB_WIN + (size_t)(4096 + PM_CQ) * 1024; j.nvalid = 488; j.nrows = 576; break;
    case 3: j.src = win; j.dst = wb + WB_WG; j.nvalid = 3072; j.nrows = 3072; break;
    case 4: j.src = p.in[29] + (size_t)l * DM * DM; j.ldsrc = 1024; j.scale = nullptr; j.dst = wb + WB_PA; j.nvalid = 1024; j.nrows = 1024; break;
    case 5: j.src = p.in[30] + (size_t)l * DM * DM; j.ldsrc = 1024; j.scale = nullptr; j.dst = wb + WB_PA + (size_t)1024 * 1024; j.nvalid = 1024; j.nrows = 1024; break;
    case 6: j.src = p.in[31] + (size_t)l * DM * DM; j.ldsrc = 1024; j.scale = nullptr; j.dst = wb + WB_PA + (size_t)2 * 1024 * 1024; j.nvalid = 1024; j.nrows = 1024; break;
    case 7: j.src = p.in[32] + (size_t)l * DM * DM; j.ldsrc = 1024; j.scale = nullptr; j.dst = wb + WB_WO; j.nvalid = 1024; j.nrows = 1024; break;
    case 8: j.src = p.in[5] + (size_t)l * 4 * 256 * 256; j.ldsrc = 256; j.K = 256; j.scale = nullptr; j.dst = wb + WB_POOL; j.nvalid = 256; j.nrows = 256; j.nb = 4; j.sbs = 65536; j.dbs = 65536; break;
    case 9: j.src = p.in[26] + (size_t)l * 256 * 512; j.ldsrc = 512; j.K = 256; j.scale = nullptr; j.dst = wb + WB_QI; j.nvalid = 512; j.nrows = 512; break;
    case 10: j.src = p.in[23] + (size_t)l * 256 * 1536; j.ldsrc = 1536; j.K = 256; j.scale = nullptr; j.dst = wb + WB_UQ; j.nvalid = 1536; j.nrows = 1536; break;
    case 11: j.src = p.in[24] + (size_t)l * 16 * 128 * 64; j.ldsrc = 64; j.K = 64; j.scale = nullptr; j.dst = wb + WB_UK; j.nvalid = 2048; j.nrows = 2048; j.notr = 1; break;
    default: j.src = p.in[25] + (size_t)l * 16 * 128 * 64; j.ldsrc = 64; j.K = 128; j.scale = nullptr; j.dst = wb + WB_UV; j.nvalid = 64; j.nrows = 64; j.nb = 16; j.sbs = 8192; j.dbs = 8192; break;
    }
    return j;
}
__device__ ConvJob get_job_late(const Params& p, int l, int ji) {
    bf16_t* we = (bf16_t*)(WS(p) + OFF_WEXP);
    ConvJob j{}; j.nb = 16; j.scale = nullptr; j.sbs = 262144; j.dbs = 262144;
    switch (ji) {
    case 0: j.src = p.in[38] + (size_t)l * 16 * 262144; j.dst = we + WE_W1; j.ldsrc = 256; j.K = 1024; j.nvalid = 256; j.nrows = 256; break;
    case 1: j.src = p.in[39] + (size_t)l * 16 * 262144; j.dst = we + WE_W3; j.ldsrc = 256; j.K = 1024; j.nvalid = 256; j.nrows = 256; break;
    default: j.src = p.in[40] + (size_t)l * 16 * 262144; j.dst = we + WE_W2; j.ldsrc = 1024; j.K = 256; j.nvalid = 1024; j.nrows = 1024; break;
    }
    return j;
}
template <bool LATE>
__device__ void phase_convert(const Params& p, int l, unsigned char* lds) {
    const int njobs = LATE ? 3 : 13;
    int base = 0;
    for (int ji = 0; ji < njobs; ++ji) {
        const ConvJob j = LATE ? get_job_late(p, l, ji) : get_job_early(p, l, ji);
        const int nt = conv_job_tiles(j);
        int first = ((int)obid() - base) % (int)gridDim.x; if (first < 0) first += gridDim.x;
        for (int t = first; t < nt; t += gridDim.x) conv_tile(j, t, (float*)lds);
        base += nt;
    }
}

template <int BM> struct G3 {
    static constexpr int MI = BM / 64;
    static constexpr int NA = BM / 64;
    static constexpr int STAGE = BM * 128 + 128 * 128;
    const bf16_t* ap[NA];
    const bf16_t* bp[2];
};
template <int BM>
__device__ __forceinline__ void g3_issue(const G3<BM>& g, int kt, unsigned char* stage, int tid) {
#pragma unroll
    for (int i = 0; i < G3<BM>::NA; ++i) glds16(g.ap[i] + kt * 64, stage + (tid + i * NTHR) * 16);
#pragma unroll
    for (int i = 0; i < 2; ++i) glds16(g.bp[i] + kt * 64, stage + BM * 128 + (tid + i * NTHR) * 16);
}
template <int BM, class FA, class FB>
__device__ __forceinline__ void g3_setup(G3<BM>& g, FA rowptr, FB bcol, int tid) {
#pragma unroll
    for (int i = 0; i < G3<BM>::NA; ++i) { const int idx = tid + i * NTHR, row = idx >> 3, sl = (idx & 7) ^ (row & 7); g.ap[i] = rowptr(row) + sl * 8; }
#pragma unroll
    for (int i = 0; i < 2; ++i) { const int idx = tid + i * NTHR, row = idx >> 3, sl = (idx & 7) ^ (row & 7); g.bp[i] = bcol(row) + sl * 8; }
}
template <int BM>
__device__ __forceinline__ void g3_kloop(f32x4 (&acc)[BM / 64][4], const G3<BM>& g, int K, unsigned char* lds) {
    constexpr int MI = G3<BM>::MI, STAGE = G3<BM>::STAGE, NL = G3<BM>::NA + 2;
    const int tid = otid(), lane = tid & 63, wid = tid >> 6, wr = wid >> 1, wc = wid & 1, fr = lane & 15, fq = lane >> 4;
    const int nk = K >> 6;
    g3_issue<BM>(g, 0, lds, tid);
    if (nk > 1) g3_issue<BM>(g, 1, lds + STAGE, tid);
    int cur = 0;
#pragma unroll 1
    for (int t = 0; t < nk; ++t) {
        if (t + 1 < nk) { if (NL == 6) asm volatile("s_waitcnt vmcnt(6)" ::: "memory"); else if (NL == 5) asm volatile("s_waitcnt vmcnt(5)" ::: "memory"); else asm volatile("s_waitcnt vmcnt(4)" ::: "memory"); }
        else asm volatile("s_waitcnt vmcnt(0)" ::: "memory");
        __builtin_amdgcn_s_barrier();
        if (t + 2 < nk) { int nx = cur + 2; if (nx >= 3) nx -= 3; g3_issue<BM>(g, t + 2, lds + nx * STAGE, tid); }
        const unsigned char* cA = lds + cur * STAGE;
        const unsigned char* cB = cA + BM * 128;
#pragma unroll
        for (int ks = 0; ks < 2; ++ks) {
            bf16x8 a[MI], b[4];
#pragma unroll
            for (int m = 0; m < MI; ++m) { const int row = wr * (BM / 4) + m * 16 + fr; a[m] = *(const bf16x8*)(cA + row * 128 + (((ks * 4 + fq) ^ (row & 7)) << 4)); }
#pragma unroll
            for (int n = 0; n < 4; ++n) { const int row = wc * 64 + n * 16 + fr; b[n] = *(const bf16x8*)(cB + row * 128 + (((ks * 4 + fq) ^ (row & 7)) << 4)); }
#pragma unroll
            for (int m = 0; m < MI; ++m)
#pragma unroll
                for (int n = 0; n < 4; ++n) acc[m][n] = __builtin_amdgcn_mfma_f32_16x16x32_bf16(b[n], a[m], acc[m][n], 0, 0, 0);
        }
        cur = (cur == 2) ? 0 : cur + 1;
    }
    __builtin_amdgcn_s_barrier();
}
template <int MI>
__device__ __forceinline__ void g3_zero(f32x4 (&acc)[MI][4]) {
#pragma unroll
    for (int m = 0; m < MI; ++m)
#pragma unroll
        for (int n = 0; n < 4; ++n) acc[m][n] = (f32x4){0.f, 0.f, 0.f, 0.f};
}
__device__ __forceinline__ uint2 pack4(float a, float b, float c, float d) {
    uint2 r; r.x = (unsigned)f2bf(a) | ((unsigned)f2bf(b) << 16); r.y = (unsigned)f2bf(c) | ((unsigned)f2bf(d) << 16); return r;
}

__device__ void phase_inproj(const Params& p, unsigned char* lds) {
    const int tid = otid(), lane = tid & 63, wid = tid >> 6, wr = wid >> 1, wc = wid & 1, fr = lane & 15, fq = lane >> 4;
    const bf16_t* h = (const bf16_t*)(WS(p) + OFF_H);
    const bf16_t* wt = (const bf16_t*)(WS(p) + OFF_WB) + WB_WIN;
    const float* rstd = (const float*)(WS(p) + OFF_RSTD);
    bf16_t* halo = (bf16_t*)(WS(p) + OFF_HALO);
    constexpr int NTN = NP1 / 128;
    for (int tile = obid(); tile < 65 * NTN; tile += gridDim.x) {
        const int mt = tile / NTN, nt = tile % NTN;
        const int row0 = mt * 256, col0 = nt * 128;
        G3<256> g;
        g3_setup<256>(g, [&](int r) { return h + (size_t)(row0 + r) * DM; }, [&](int r) { return wt + (size_t)(col0 + r) * DM; }, tid);
        f32x4 acc[4][4]; g3_zero<4>(acc);
        g3_kloop<256>(acc, g, DM, lds);
        bf16_t* dst; int ld, cbase;
        if (nt < 8) { dst = (bf16_t*)(WS(p) + OFF_PPOOL); ld = 1024; cbase = 0; }
        else if (nt < 16) { dst = (bf16_t*)(WS(p) + OFF_PR); ld = 1024; cbase = 1024; }
        else if (nt < 24) { dst = (bf16_t*)(WS(p) + OFF_PK); ld = 1024; cbase = 2048; }
        else if (nt < 32) { dst = (bf16_t*)(WS(p) + OFF_PV); ld = 1024; cbase = 3072; }
        else { dst = (bf16_t*)(WS(p) + OFF_PMISC); ld = PM_LD; cbase = 4096; }
#pragma unroll
        for (int m = 0; m < 4; ++m) {
            const int row = row0 + wr * 64 + m * 16 + fr;
            if (row < NT) {
                const float rs = rstd[row];
                const int lr = row & 127;
#pragma unroll
                for (int n = 0; n < 4; ++n) {
                    const int col = col0 + wc * 64 + n * 16 + fq * 4;
                    const uint2 v = pack4(acc[m][n][0] * rs, acc[m][n][1] * rs, acc[m][n][2] * rs, acc[m][n][3] * rs);
                    *(uint2*)(dst + (size_t)row * ld + (col - cbase)) = v;
                    if (nt < 8 && lr >= 112) *(uint2*)(halo + ((size_t)(row >> 7) * 16 + (lr - 112)) * 1024 + col) = v;
                }
            }
        }
    }
}

__device__ void phase_pool(const Params& p, int l, unsigned char* lds, int tb, int te, int tstep) {
    const int tid = otid(), lane = tid & 63, wid = tid >> 6, fr = lane & 15, fq = lane >> 4;
    bf16_t* pp = (bf16_t*)(WS(p) + OFF_PPOOL);
    const bf16_t* halo = (const bf16_t*)(WS(p) + OFF_HALO);
    const bf16_t* pw = (const bf16_t*)(WS(p) + OFF_WB) + WB_POOL;
    const float* scale = p.in[6] + (size_t)l * 1024;
    bf16_t* sp = (bf16_t*)lds;
    constexpr int SLD = 264;
    for (int tile = tb; tile < te; tile += tstep) {
        const int mt = tile >> 2, g = tile & 3;
        const int row0 = mt * 128, w = 2 << g;
        {
            const int c = tid & 255, r0 = (tid >> 8) * 64, col = g * 256 + c;
            auto rawv = [&](int n2) -> float {
                return (n2 >= row0) ? bf2f(pp[(size_t)n2 * 1024 + col]) : bf2f(halo[((size_t)(n2 >> 7) * 16 + ((n2 & 127) - 112)) * 1024 + col]);
            };
            int n = row0 + r0, t = n % TS;
            float sum = 0.f;
            const int have = (t < w) ? t : w;
            for (int i = 1; i <= have; ++i) sum += rawv(n - i);
#pragma unroll 4
            for (int r = 0; r < 64; ++r, ++n) {
                if (t == 0) sum = 0.f;
                const float v = rawv(n);
                sum += v;
                if (t >= w) sum -= rawv(n - w);
                const int cnt = (t + 1 < w) ? (t + 1) : w;
                sp[(r0 + r) * SLD + c] = f2bf(sum * (1.0f / (float)cnt) - v);
                t = (t + 1 == TS) ? 0 : t + 1;
            }
        }
        __syncthreads();
        f32x4 acc[8][2];
#pragma unroll
        for (int m = 0; m < 8; ++m) { acc[m][0] = (f32x4){0.f, 0.f, 0.f, 0.f}; acc[m][1] = (f32x4){0.f, 0.f, 0.f, 0.f}; }
        const bf16_t* wg = pw + (size_t)g * 65536;
#pragma unroll 1
        for (int kk = 0; kk < 8; ++kk) {
            bf16x8 bfr[2];
#pragma unroll
            for (int n = 0; n < 2; ++n) bfr[n] = *(const bf16x8*)(wg + (size_t)(wid * 32 + n * 16 + fr) * 256 + kk * 32 + fq * 8);
#pragma unroll
            for (int m = 0; m < 8; ++m) {
                const bf16x8 a = *(const bf16x8*)(sp + (m * 16 + fr) * SLD + kk * 32 + fq * 8);
                acc[m][0] = __builtin_amdgcn_mfma_f32_16x16x32_bf16(a, bfr[0], acc[m][0], 0, 0, 0);
                acc[m][1] = __builtin_amdgcn_mfma_f32_16x16x32_bf16(a, bfr[1], acc[m][1], 0, 0, 0);
            }
        }
#pragma unroll
        for (int m = 0; m < 8; ++m)
#pragma unroll
            for (int n = 0; n < 2; ++n) {
                const int col = g * 256 + wid * 32 + n * 16 + fr;
                const float sc = scale[col];
#pragma unroll
                for (int j = 0; j < 4; ++j) {
                    const int row = row0 + m * 16 + fq * 4 + j;
                    pp[(size_t)row * 1024 + col] = f2bf(acc[m][n][j] * sc);
                }
            }
        __syncthreads();
    }
}

__device__ void phase_dsa_prep(const Params& p, int l) {
    const int lane = otid() & 63;
    const int wave = (obid() * NTHR + otid()) >> 6, nw = gridDim.x * NTHR / 64;
    const bf16_t* pm = (const bf16_t*)(WS(p) + OFF_PMISC);
    unsigned char* dob = OUTB(p);
    bf16_t* cqn = (bf16_t*)(dob + DO_CQN);
    bf16_t* kv = (bf16_t*)(dob + DO_KV);
    bf16_t* kidx = (bf16_t*)(dob + DO_KIDX);
    float* whead = (float*)(dob + DO_WHEAD);
    const float* ctab = (const float*)(WS(p) + OFF_ROPE);
    const float* stab = ctab + TS * 16;
    const float* qn = p.in[21] + l * 256;
    const float* kvn = p.in[22] + l * 128;
    const float* inw = p.in[27] + l * 64;
    const float* inb = p.in[28] + l * 64;
    for (int n = wave; n < NT; n += nw) {
        const int t = n % TS;
        const bf16_t* row = pm + (size_t)n * PM_LD;
        {
            float v[4]; float ss = 0.f;
#pragma unroll
            for (int i = 0; i < 4; ++i) { v[i] = bf2f(row[PM_CQ + lane * 4 + i]); ss += v[i] * v[i]; }
            ss = wave_sum(ss);
            const float rs = rsqrtf(ss * (1.0f / 256.0f) + 1e-6f);
#pragma unroll
            for (int i = 0; i < 4; ++i) cqn[(size_t)n * 256 + lane * 4 + i] = f2bf(v[i] * rs * qn[lane * 4 + i]);
        }
        {
            float v[2]; float ss = 0.f;
#pragma unroll
            for (int i = 0; i < 2; ++i) { v[i] = bf2f(row[PM_CKV + lane * 2 + i]); ss += v[i] * v[i]; }
            ss = wave_sum(ss);
            const float rs = rsqrtf(ss * (1.0f / 128.0f) + 1e-6f);
#pragma unroll
            for (int i = 0; i < 2; ++i) kv[(size_t)n * 160 + lane * 2 + i] = f2bf(v[i] * rs * kvn[lane * 2 + i]);
        }
        if (lane < 16) {
            const float x1 = bf2f(row[PM_KROPE + lane]), x2 = bf2f(row[PM_KROPE + 16 + lane]);
            const float c = ctab[t * 16 + lane], s = stab[t * 16 + lane];
            kv[(size_t)n * 160 + 128 + lane] = f2bf(x1 * c - x2 * s);
            kv[(size_t)n * 160 + 144 + lane] = f2bf(x2 * c + x1 * s);
        }
        {
            const float x = bf2f(row[PM_KIDX + lane]);
            const float mu = wave_sum(x) * (1.0f / 64.0f);
            const float d = x - mu;
            const float var = wave_sum(d * d) * (1.0f / 64.0f);
            const float y = d * rsqrtf(var + 1e-6f) * inw[lane] + inb[lane];
            const float yo = __shfl_xor(y, 16);
            float o = y;
            if (lane < 32) {
                const int i = lane & 15;
                const float c = ctab[t * 16 + i], s = stab[t * 16 + i];
                o = (lane < 16) ? (y * c - yo * s) : (y * c + yo * s);
            }
            kidx[(size_t)n * 64 + lane] = f2bf(o);
        }
        if (lane < 8) whead[(size_t)n * 8 + lane] = bf2f(row[PM_WIDX + lane]) * 0.04419417382415922f;
    }
}

typedef short s16x4 __attribute__((ext_vector_type(4)));
__device__ __forceinline__ unsigned f2h_bits(float f) { const _Float16 h = (_Float16)f; unsigned short u; __builtin_memcpy(&u, &h, 2); return u; }
template <bool IMPORT_SEL>
__device__ void phase_dsa(const Params& p, int l, unsigned char* lds, bf16_t* yc, const unsigned short* gsel, const int* gnsel, int tb, int te, int tstep) {
    const int tid = otid(), lane = tid & 63, wid = tid >> 6, fr = lane & 15, fq = lane >> 4;
    unsigned short* s_sc = (unsigned short*)lds;
    bf16_t* s_qi = (bf16_t*)(lds + 66048);
    bf16_t* s_Q = (bf16_t*)lds;
    unsigned char* s_Vw = lds + 82432 + wid * 8192;
    bf16_t* s_qn = (bf16_t*)s_Vw;
    unsigned short* s_sel = (unsigned short*)(lds + 82432 + 65536);
    int* s_nsel = (int*)(lds + 82432 + 65536 + 8192);
    unsigned char* dob = OUTB(p);
    const bf16_t* cqn = (const bf16_t*)(dob + DO_CQN);
    const bf16_t* kv = (const bf16_t*)(dob + DO_KV);
    const bf16_t* kidx = (const bf16_t*)(dob + DO_KIDX);
    const float* whead = (const float*)(dob + DO_WHEAD);
    const float* ctab = (const float*)(WS(p) + OFF_ROPE);
    const float* stab = ctab + TS * 16;
    const bf16_t* wb = (const bf16_t*)(WS(p) + OFF_WB);
    const bf16_t* wqiT = wb + WB_QI;
    const bf16_t* wuqT = wb + WB_UQ;
    const bf16_t* wuk = wb + WB_UK;
    const bf16_t* wuvT = wb + WB_UV;
    const float scale = 0.10206207261596575f;
    const f32x4 z4 = {0.f, 0.f, 0.f, 0.f};
    for (int tile = tb; tile < te; tile += tstep) {
        const int qt = 128 - (tile >> 3), b = tile & 7;
        const int t0 = qt * 16;
        const size_t n0 = (size_t)b * TS + t0;
        {
            bf16x8 acq[8];
#pragma unroll
            for (int kk = 0; kk < 8; ++kk) acq[kk] = *(const bf16x8*)(cqn + (n0 + fr) * 256 + kk * 32 + fq * 8);
            f32x4 c[4] = {z4, z4, z4, z4};
#pragma unroll
            for (int kb = 0; kb < 8; kb += 4) {
                bf16x8 bf[4][4];
#pragma unroll
                for (int k4 = 0; k4 < 4; ++k4)
#pragma unroll
                    for (int nt = 0; nt < 4; ++nt) bf[k4][nt] = *(const bf16x8*)(wqiT + (size_t)(wid * 64 + nt * 16 + fr) * 256 + (kb + k4) * 32 + fq * 8);
#pragma unroll
                for (int k4 = 0; k4 < 4; ++k4)
#pragma unroll
                    for (int nt = 0; nt < 4; ++nt) c[nt] = __builtin_amdgcn_mfma_f32_16x16x32_bf16(acq[kb + k4], bf[k4][nt], c[nt], 0, 0, 0);
            }
#pragma unroll
            for (int j = 0; j < 4; ++j) {
                const int t = t0 + fq * 4 + j;
                const float cs = ctab[t * 16 + fr], sn = stab[t * 16 + fr];
                const float x1 = c[0][j], x2 = c[1][j];
                c[0][j] = x1 * cs - x2 * sn; c[1][j] = x2 * cs + x1 * sn;
            }
#pragma unroll
            for (int nt = 0; nt < 4; ++nt)
#pragma unroll
                for (int j = 0; j < 4; ++j) s_qi[(fq * 4 + j) * 512 + wid * 64 + nt * 16 + fr] = f2bf(c[nt][j]);
        }
        __syncthreads();
        if (!IMPORT_SEL) {
            bf16x8 aq[8][2];
#pragma unroll
            for (int h = 0; h < 8; ++h)
#pragma unroll
                for (int ks = 0; ks < 2; ++ks) aq[h][ks] = *(const bf16x8*)(s_qi + fr * 512 + h * 64 + ks * 32 + fq * 8);
            float wh[4][8];
#pragma unroll
            for (int j = 0; j < 4; ++j) {
                const float4 w0 = *(const float4*)(whead + (n0 + fq * 4 + j) * 8), w1 = *(const float4*)(whead + (n0 + fq * 4 + j) * 8 + 4);
                wh[j][0] = w0.x; wh[j][1] = w0.y; wh[j][2] = w0.z; wh[j][3] = w0.w; wh[j][4] = w1.x; wh[j][5] = w1.y; wh[j][6] = w1.z; wh[j][7] = w1.w;
            }
            const int nkt = qt + 1;
            bf16x8 nb0 = {0, 0, 0, 0, 0, 0, 0, 0}, nb1 = nb0;
            if (wid < nkt) { const bf16_t* kr0 = kidx + ((size_t)b * TS + wid * 16 + fr) * 64 + fq * 8; nb0 = *(const bf16x8*)kr0; nb1 = *(const bf16x8*)(kr0 + 32); }
#pragma unroll 1
            for (int kt = wid; kt < nkt; kt += 8) {
                const bf16x8 bk0 = nb0, bk1 = nb1;
                if (kt + 8 < nkt) { const bf16_t* krn = kidx + ((size_t)b * TS + (kt + 8) * 16 + fr) * 64 + fq * 8; nb0 = *(const bf16x8*)krn; nb1 = *(const bf16x8*)(krn + 32); }
                float I[4] = {0.f, 0.f, 0.f, 0.f};
#pragma unroll
                for (int h = 0; h < 8; ++h) {
                    f32x4 a = __builtin_amdgcn_mfma_f32_16x16x32_bf16(aq[h][0], bk0, z4, 0, 0, 0);
                    a = __builtin_amdgcn_mfma_f32_16x16x32_bf16(aq[h][1], bk1, a, 0, 0, 0);
#pragma unroll
                    for (int j = 0; j < 4; ++j) I[j] += wh[j][h] * fmaxf(a[j], 0.f);
                }
#pragma unroll
                for (int j = 0; j < 4; ++j) s_sc[(fq * 4 + j) * 2064 + kt * 16 + fr] = (unsigned short)f2h_bits(I[j]);
            }
        }
        __syncthreads();
#pragma unroll 1
        for (int qi2 = 0; qi2 < 2; ++qi2) {
            const int q = wid + qi2 * 8;
            const int nadm = t0 + q + 1;
            unsigned short* sel = s_sel + q * 256;
            if (IMPORT_SEL) {
                const int ns = gnsel[n0 + q];
                for (int i = lane; i < ns; i += 64) sel[i] = gsel[(n0 + q) * 256 + i];
                if (lane == 0) s_nsel[q] = ns;
            } else if (nadm <= 256) {
                for (int i = lane; i < nadm; i += 64) sel[i] = (unsigned short)i;
                if (lane == 0) s_nsel[q] = nadm;
            } else {
                auto topk = [&](auto nch_tag) {
                    constexpr int NCH = decltype(nch_tag)::value;
                    unsigned key[NCH];
    #pragma unroll
                    for (int c = 0; c < NCH; ++c) {
                        const int s = c * 64 + lane;
                        unsigned k = 0u;
                        if (s < nadm) { const unsigned u = s_sc[q * 2064 + s]; k = (u & 0x8000u) ? (~u & 0xFFFFu) : (u | 0x8000u); }
                        key[c] = k;
                    }
                    unsigned T = 0u;
    #pragma unroll 1
                    for (int bit = 15; bit >= 0; --bit) {
                        const unsigned cand = T | (1u << bit);
                        int cnt = 0;
    #pragma unroll
                        for (int c = 0; c < NCH; ++c) cnt += __popcll(__ballot(key[c] >= cand));
                        if (cnt >= 256) T = cand;
                    }
                    int ngt = 0;
    #pragma unroll
                    for (int c = 0; c < NCH; ++c) ngt += __popcll(__ballot(key[c] > T));
                    const int rties = 256 - ngt;
                    int base = 0, ties = 0;
                    const unsigned long long ltmask = (1ull << lane) - 1ull;
    #pragma unroll
                    for (int c = 0; c < NCH; ++c) {
                        const bool gt = key[c] > T, eq = key[c] == T;
                        const unsigned long long em = __ballot(eq);
                        const int myrank = ties + __popcll(em & ltmask);
                        const bool take = gt || (eq && myrank < rties);
                        const unsigned long long tm = __ballot(take);
                        const int pos = base + __popcll(tm & ltmask);
                        if (take && pos < 256) sel[pos] = (unsigned short)(c * 64 + lane);
                        base += __popcll(tm); ties += __popcll(em);
                    }

                };
                if (nadm <= 512) topk(std::integral_constant<int, 8>{});
                else if (nadm <= 1024) topk(std::integral_constant<int, 16>{});
                else if (nadm <= 1536) topk(std::integral_constant<int, 24>{});
                else topk(std::integral_constant<int, 33>{});
                if (lane == 0) s_nsel[q] = 256;
            }
        }
        __syncthreads();
#pragma unroll 1
        for (int hi = 0; hi < 2; ++hi) {
            const int hh = wid * 2 + hi;
            bf16x8 acq[8];
#pragma unroll
            for (int kk = 0; kk < 8; ++kk) acq[kk] = *(const bf16x8*)(cqn + (n0 + fr) * 256 + kk * 32 + fq * 8);
            f32x4 c6[6] = {z4, z4, z4, z4, z4, z4};
#pragma unroll
            for (int kb = 0; kb < 8; kb += 4) {
                bf16x8 bf[4][6];
#pragma unroll
                for (int k4 = 0; k4 < 4; ++k4)
#pragma unroll
                    for (int nt = 0; nt < 6; ++nt) bf[k4][nt] = *(const bf16x8*)(wuqT + (size_t)(hh * 96 + nt * 16 + fr) * 256 + (kb + k4) * 32 + fq * 8);
#pragma unroll
                for (int k4 = 0; k4 < 4; ++k4)
#pragma unroll
                    for (int nt = 0; nt < 6; ++nt) c6[nt] = __builtin_amdgcn_mfma_f32_16x16x32_bf16(acq[kb + k4], bf[k4][nt], c6[nt], 0, 0, 0);
            }
#pragma unroll
            for (int j = 0; j < 4; ++j) {
                const int q = fq * 4 + j, t = t0 + q;
                const float cs = ctab[t * 16 + fr], sn = stab[t * 16 + fr];
                const float x1 = c6[4][j], x2 = c6[5][j];
                s_Q[(q * 16 + hh) * 160 + 128 + fr] = f2bf(x1 * cs - x2 * sn);
                s_Q[(q * 16 + hh) * 160 + 144 + fr] = f2bf(x2 * cs + x1 * sn);
#pragma unroll
                for (int nt = 0; nt < 4; ++nt) s_qn[q * 64 + nt * 16 + fr] = f2bf(c6[nt][j]);
            }
            __syncthreads();
            bf16x8 an[2];
#pragma unroll
            for (int ks = 0; ks < 2; ++ks) an[ks] = *(const bf16x8*)(s_qn + fr * 64 + ks * 32 + fq * 8);
            bf16x8 bwk[8][2];
#pragma unroll
            for (int nt = 0; nt < 8; ++nt)
#pragma unroll
                for (int ks = 0; ks < 2; ++ks) bwk[nt][ks] = *(const bf16x8*)(wuk + (size_t)(hh * 128 + nt * 16 + fr) * 64 + ks * 32 + fq * 8);
#pragma unroll
            for (int nt = 0; nt < 8; ++nt) {
                f32x4 a = z4;
#pragma unroll
                for (int ks = 0; ks < 2; ++ks)
                    a = __builtin_amdgcn_mfma_f32_16x16x32_bf16(an[ks], bwk[nt][ks], a, 0, 0, 0);
#pragma unroll
                for (int j = 0; j < 4; ++j) s_Q[((fq * 4 + j) * 16 + hh) * 160 + nt * 16 + fr] = f2bf(a[j]);
            }
            __syncthreads();
        }
#pragma unroll 1
        for (int qi2 = 0; qi2 < 2; ++qi2) {
            const int q = wid + qi2 * 8;
            bf16x8 bq[5];
#pragma unroll
            for (int ks = 0; ks < 5; ++ks) bq[ks] = *(const bf16x8*)(s_Q + (q * 16 + fr) * 160 + ks * 32 + fq * 8);
            const int nsel = s_nsel[q];
            const unsigned short* sel = s_sel + q * 256;
            float m = -INFINITY, lsum = 0.f;
            f32x4 O[8] = {z4, z4, z4, z4, z4, z4, z4, z4};
            const int nchunk = (nsel + 31) >> 5;
            bf16x8 akn[2][5];
#pragma unroll
            for (int mt = 0; mt < 2; ++mt) {
                const int ki = mt * 16 + fr;
                const int sidx = sel[ki < nsel ? ki : 0];
                const bf16_t* krow = kv + ((size_t)b * TS + sidx) * 160 + fq * 8;
#pragma unroll
                for (int ks = 0; ks < 5; ++ks) akn[mt][ks] = *(const bf16x8*)(krow + ks * 32);
            }
#pragma unroll 1
            for (int ch = 0; ch < nchunk; ++ch) {
                bf16x8 ak[2][5];
#pragma unroll
                for (int mt = 0; mt < 2; ++mt)
#pragma unroll
                    for (int ks = 0; ks < 5; ++ks) ak[mt][ks] = akn[mt][ks];
                if (ch + 1 < nchunk) {
#pragma unroll
                    for (int mt = 0; mt < 2; ++mt) {
                        const int ki = (ch + 1) * 32 + mt * 16 + fr;
                        const int sidx = sel[ki < nsel ? ki : 0];
                        const bf16_t* krow = kv + ((size_t)b * TS + sidx) * 160 + fq * 8;
#pragma unroll
                        for (int ks = 0; ks < 5; ++ks) akn[mt][ks] = *(const bf16x8*)(krow + ks * 32);
                    }
                }
#pragma unroll
                for (int mt = 0; mt < 2; ++mt)
#pragma unroll
                    for (int ks = 0; ks < 4; ++ks) {
                        const int r = mt * 16 + fr;
                        *(bf16x8*)(s_Vw + r * 256 + (((ks * 2 + (fq >> 1)) ^ (r & 7)) * 32) + (fq & 1) * 16) = ak[mt][ks];
                    }
                f32x4 st[2] = {z4, z4};
#pragma unroll
                for (int mt = 0; mt < 2; ++mt)
#pragma unroll
                    for (int ks = 0; ks < 5; ++ks) st[mt] = __builtin_amdgcn_mfma_f32_16x16x32_bf16(ak[mt][ks], bq[ks], st[mt], 0, 0, 0);
                float sv[2][4]; float cmax = -INFINITY;
#pragma unroll
                for (int mt = 0; mt < 2; ++mt)
#pragma unroll
                    for (int j = 0; j < 4; ++j) {
                        const int ke = ch * 32 + mt * 16 + fq * 4 + j;
                        const float s_ = (ke < nsel) ? st[mt][j] * scale : -INFINITY;
                        sv[mt][j] = s_; cmax = fmaxf(cmax, s_);
                    }
                cmax = fmaxf(cmax, __shfl_xor(cmax, 16)); cmax = fmaxf(cmax, __shfl_xor(cmax, 32));
                const float mnew = fmaxf(m, cmax);
                const float alpha = __expf(m - mnew);
                float psum = 0.f;
#pragma unroll
                for (int mt = 0; mt < 2; ++mt)
#pragma unroll
                    for (int j = 0; j < 4; ++j) { const float pe = __expf(sv[mt][j] - mnew); sv[mt][j] = pe; psum += pe; }
                psum += __shfl_xor(psum, 16); psum += __shfl_xor(psum, 32);
                lsum = lsum * alpha + psum; m = mnew;
#pragma unroll
                for (int ct = 0; ct < 8; ++ct) O[ct] = O[ct] * alpha;
                bf16x8 pf;
#pragma unroll
                for (int mt = 0; mt < 2; ++mt)
#pragma unroll
                    for (int j = 0; j < 4; ++j) pf[mt * 4 + j] = (short)f2bf(sv[mt][j]);
                const int q_ = fr >> 2, p_ = fr & 3;
                const int r0 = fq * 4 + q_, r1 = 16 + r0;
#pragma unroll
                for (int ct = 0; ct < 8; ++ct) {
                    const s16x4 v0 = __builtin_amdgcn_ds_read_tr16_b64_v4i16((__attribute__((address_space(3))) s16x4*)(s_Vw + r0 * 256 + ((ct ^ (r0 & 7)) * 32) + p_ * 8));
                    const s16x4 v1 = __builtin_amdgcn_ds_read_tr16_b64_v4i16((__attribute__((address_space(3))) s16x4*)(s_Vw + r1 * 256 + ((ct ^ (r1 & 7)) * 32) + p_ * 8));
                    bf16x8 av; av[0] = v0[0]; av[1] = v0[1]; av[2] = v0[2]; av[3] = v0[3]; av[4] = v1[0]; av[5] = v1[1]; av[6] = v1[2]; av[7] = v1[3];
                    O[ct] = __builtin_amdgcn_mfma_f32_16x16x32_bf16(av, pf, O[ct], 0, 0, 0);
                }
            }
            const float inv = 1.0f / lsum;
#pragma unroll
            for (int ct = 0; ct < 8; ++ct)
#pragma unroll
                for (int j = 0; j < 4; ++j) s_Q[(q * 16 + fr) * 160 + ct * 16 + fq * 4 + j] = f2bf(O[ct][j] * inv);
        }
        __syncthreads();
#pragma unroll 1
        for (int hi = 0; hi < 2; ++hi) {
            const int hh = wid * 2 + hi;
            bf16x8 ao[4];
#pragma unroll
            for (int ks = 0; ks < 4; ++ks) ao[ks] = *(const bf16x8*)(s_Q + (fr * 16 + hh) * 160 + ks * 32 + fq * 8);
#pragma unroll
            for (int nt = 0; nt < 4; ++nt) {
                f32x4 a = z4;
#pragma unroll
                for (int ks = 0; ks < 4; ++ks)
                    a = __builtin_amdgcn_mfma_f32_16x16x32_bf16(ao[ks], *(const bf16x8*)(wuvT + (size_t)(hh * 64 + nt * 16 + fr) * 128 + ks * 32 + fq * 8), a, 0, 0, 0);
#pragma unroll
                for (int j = 0; j < 4; ++j) yc[(n0 + fq * 4 + j) * 1024 + hh * 64 + nt * 16 + fr] = f2bf(a[j]);
            }
        }
        __syncthreads();
    }
}


__device__ void phase_lr_prep(const Params& p, int l) {
    const int lane = otid() & 63;
    const int wave = (obid() * NTHR + otid()) >> 6, nw = gridDim.x * NTHR / 64;
    const bf16_t* pm = (const bf16_t*)(WS(p) + OFF_PMISC);
    bf16_t* alr = (bf16_t*)(OUTB(p) + DO_ALR);
    const float* mu = p.in[4] + (size_t)l * 3328 + 3072;
    const float* vmu = p.in[18];
    for (int n = wave; n < NT; n += nw) {
        const int t = n % TS;
        for (int c = lane; c < 288; c += 64) {
            const float cur = bf2f(pm[(size_t)n * PM_LD + c]);
            const float prv = (t > 0) ? bf2f(pm[(size_t)(n - 1) * PM_LD + c]) : 0.f;
            const float m_ = (c < 256) ? mu[c] : vmu[c - 256];
            float xs = cur + (prv - cur) * m_;
            if (c < 64) xs = tanhf(xs);
            else if (c >= 128 && c < 256) xs = sigmoidf_(xs);
            alr[(size_t)n * 288 + c] = f2bf(xs);
        }
    }
}

template <int CTRL> __device__ __forceinline__ float dpp_f(float x) {
    return __int_as_float(__builtin_amdgcn_update_dpp(0, __float_as_int(x), CTRL, 0xF, 0xF, true));
}
__device__ __forceinline__ float row16_sum(float v) {
    v += dpp_f<0xB1>(v);
    v += dpp_f<0x4E>(v);
    v += dpp_f<0x141>(v);
    v += dpp_f<0x140>(v);
    return v;
}
__device__ __forceinline__ void lds_barrier() { asm volatile("s_waitcnt lgkmcnt(0)" ::: "memory"); __builtin_amdgcn_s_barrier(); asm volatile("" ::: "memory"); }
__device__ __forceinline__ float fast_rcp(float x) { return __builtin_amdgcn_rcpf(x); }
__device__ __forceinline__ float fast_sigmoid(float x) { return fast_rcp(1.0f + __expf(-x)); }
__device__ __forceinline__ float fast_tanh(float x) { return 1.0f - 2.0f * fast_rcp(1.0f + __expf(2.0f * x)); }
__device__ __forceinline__ void row16_sum4(float& a, float& b, float& c, float& d) {
    asm volatile(
        "s_nop 1\n\t"
        "v_add_f32_dpp %0, %0, %0 quad_perm:[1,0,3,2] row_mask:0xf bank_mask:0xf\n\t"
        "v_add_f32_dpp %1, %1, %1 quad_perm:[1,0,3,2] row_mask:0xf bank_mask:0xf\n\t"
        "v_add_f32_dpp %2, %2, %2 quad_perm:[1,0,3,2] row_mask:0xf bank_mask:0xf\n\t"
        "v_add_f32_dpp %3, %3, %3 quad_perm:[1,0,3,2] row_mask:0xf bank_mask:0xf\n\t"
        "v_add_f32_dpp %0, %0, %0 quad_perm:[2,3,0,1] row_mask:0xf bank_mask:0xf\n\t"
        "v_add_f32_dpp %1, %1, %1 quad_perm:[2,3,0,1] row_mask:0xf bank_mask:0xf\n\t"
        "v_add_f32_dpp %2, %2, %2 quad_perm:[2,3,0,1] row_mask:0xf bank_mask:0xf\n\t"
        "v_add_f32_dpp %3, %3, %3 quad_perm:[2,3,0,1] row_mask:0xf bank_mask:0xf\n\t"
        "v_add_f32_dpp %0, %0, %0 row_half_mirror row_mask:0xf bank_mask:0xf\n\t"
        "v_add_f32_dpp %1, %1, %1 row_half_mirror row_mask:0xf bank_mask:0xf\n\t"
        "v_add_f32_dpp %2, %2, %2 row_half_mirror row_mask:0xf bank_mask:0xf\n\t"
        "v_add_f32_dpp %3, %3, %3 row_half_mirror row_mask:0xf bank_mask:0xf\n\t"
        "v_add_f32_dpp %0, %0, %0 row_mirror row_mask:0xf bank_mask:0xf\n\t"
        "v_add_f32_dpp %1, %1, %1 row_mirror row_mask:0xf bank_mask:0xf\n\t"
        "v_add_f32_dpp %2, %2, %2 row_mirror row_mask:0xf bank_mask:0xf\n\t"
        "v_add_f32_dpp %3, %3, %3 row_mirror row_mask:0xf bank_mask:0xf\n\t"
        "s_nop 1"
        : "+v"(a), "+v"(b), "+v"(c), "+v"(d));
}
__device__ __forceinline__ float wave_sum_fast(float v) { v = row16_sum(v); v += __shfl_xor(v, 16); v += __shfl_xor(v, 32); return v; }
constexpr int SC_TC = 32;
constexpr int SC_ROWB = 1088;
__device__ __forceinline__ const unsigned char* scan_piece_src(const Params& p, int l, int b, int hc, int t0, int pi, bool& ok) {
    const int tau = pi / 68, seg = pi - tau * 68;
    const int t = t0 + tau;
    ok = (t < TS) && (tau < SC_TC);
    const size_t n = (size_t)b * TS + t;
    const unsigned char* ws = WS(p);
    if (seg < 8) return ws + OFF_PR + (n * 1024 + hc) * 2 + seg * 16;
    if (seg < 16) return ws + OFF_PK + (n * 1024 + hc) * 2 + (seg - 8) * 16;
    if (seg < 24) return ws + OFF_PV + (n * 1024 + hc) * 2 + (seg - 16) * 16;
    if (seg < 60) return OUTB(p) + DO_ALR + (n * 288) * 2 + (seg - 24) * 16;
    ok = ok && (l > 0);
    return ws + OFF_VFIRST + (n * 1024 + hc) * 2 + (seg - 60) * 16;
}
__device__ void phase_scan5(const Params& p, int l, unsigned char* lds, int blk) {
    const int tid = otid(), lane = tid & 63, wid = tid >> 6, fr = lane & 15, fq = lane >> 4;
    const int b = blk >> 4, hh = blk & 15, hc = hh * 64;
    float* s_r = (float*)lds;
    float* s_w = s_r + 2048;
    float* s_k = s_w + 2048;
    float* s_v = s_k + 2048;
    float* s_a = s_v + 2048;
    float* s_b = s_a + 2048;
    float* s_g = s_b + 2048;
    float* s_o = s_g + 2048;
    bf16_t* A_wd = (bf16_t*)(s_o + 2048);
    bf16_t* A_ad = A_wd + 2048;
    bf16_t* A_gd = A_ad + 2048;
    bf16_t* A_vd = A_gd + 4096;
    unsigned char* raw = (unsigned char*)(A_vd + 1024);
    float* prevb = (float*)(raw + 32 * SC_ROWB);
    float* cst = prevb + 960;
    const float* mu = p.in[4] + (size_t)l * 3328;
    for (int e = tid; e < 480; e += NTHR) {
        float v;
        if (e < 192) v = mu[(e >> 6) * 1024 + hc + (e & 63)];
        else if (e < 448) v = mu[3072 + (e - 192)];
        else v = p.in[18][e - 448];
        cst[e] = v;
    }
    if (tid < 64) {
        cst[480 + tid] = p.in[7][l * 1024 + hc + tid];
        cst[544 + tid] = p.in[9][l * 1024 + hc + tid];
        cst[608 + tid] = p.in[12][l * 1024 + hc + tid];
        cst[672 + tid] = p.in[13][l * 1024 + hc + tid];
        cst[736 + tid] = p.in[14][l * 1024 + hc + tid];
        cst[800 + tid] = p.in[15][l * 1024 + hc + tid];
        cst[864 + tid] = p.in[16][l * 1024 + hc + tid];
        cst[928 + tid] = p.in[19][hc + tid];
    }
    const int mm = wid >> 1, ntb = (wid & 1) * 2;
    const int nks = (mm == 2) ? 4 : (mm == 3 ? 1 : 2);
    bf16x8 Bw[2][4];
    {
        const float* wsrc = (mm == 0) ? p.in[8] + (size_t)l * 64 * 1024 : (mm == 1) ? p.in[10] + (size_t)l * 64 * 1024 : (mm == 2) ? p.in[11] + (size_t)l * 128 * 1024 : p.in[20];
#pragma unroll
        for (int n2 = 0; n2 < 2; ++n2)
#pragma unroll
            for (int ks = 0; ks < 4; ++ks) {
                bf16x8 f;
#pragma unroll
                for (int j = 0; j < 8; ++j) {
                    const bool okw = ks < nks && (mm < 3 || l > 0);
                    const float v = wsrc[(size_t)(okw ? (ks * 32 + fq * 8 + j) : 0) * 1024 + hc + (ntb + n2) * 16 + fr];
                    f[j] = (short)f2bf(okw ? v : 0.f);
                }
                Bw[n2][ks] = f;
            }
    }
    const int cg = lane & 15, rg = lane >> 4;
    float S0[4] = {0.f, 0.f, 0.f, 0.f}, S1[4] = {0.f, 0.f, 0.f, 0.f};
    bf16_t* Pr = (bf16_t*)(WS(p) + OFF_PR);
    bf16_t* vfirst = (bf16_t*)(WS(p) + OFF_VFIRST);
    const unsigned char* psrc[5]; int pstep[5], ptau[5]; bool pval[5];
#pragma unroll
    for (int k = 0; k < 5; ++k) {
        const int pi = tid + k * NTHR;
        bool ok = false;
        psrc[k] = scan_piece_src(p, l, b, hc, 0, pi < SC_TC * 68 ? pi : 0, ok);
        const int tau = (pi < SC_TC * 68 ? pi : 0) / 68, seg = (pi < SC_TC * 68 ? pi : 0) - tau * 68;
        ptau[k] = tau;
        pstep[k] = SC_TC * ((seg >= 24 && seg < 60) ? 576 : 2048);
        pval[k] = (pi < SC_TC * 68) && !(seg >= 60 && l == 0);
    }
    uint4 pre[5];
#pragma unroll
    for (int k = 0; k < 5; ++k) { pre[k] = make_uint4(0, 0, 0, 0); if (pval[k] && ptau[k] < TS) pre[k] = *(const uint4*)psrc[k]; }
    __syncthreads();
#pragma unroll 1
    for (int t0 = 0, ch = 0; t0 < TS; t0 += SC_TC, ++ch) {
        const int nval = (TS - t0 < SC_TC) ? (TS - t0) : SC_TC;
#pragma unroll
        for (int k = 0; k < 5; ++k) { const int pi = tid + k * NTHR; if (pi < SC_TC * 68) *(uint4*)(raw + pi * 16) = pre[k]; }
        lds_barrier();
#pragma unroll
        for (int k = 0; k < 5; ++k) {
            pre[k] = make_uint4(0, 0, 0, 0);
            if (pval[k] && t0 + SC_TC + ptau[k] < TS) pre[k] = *(const uint4*)(psrc[k] + (size_t)(ch + 1) * pstep[k]);
        }
        {
            float* pwb = prevb + (ch & 1) * 192;
            const float* pvb = prevb + ((ch + 1) & 1) * 192;
            for (int it = tid; it < SC_TC * 96; it += NTHR) {
                const int tau = it / 96, c2 = (it - tau * 96) * 2;
                const unsigned cu = *(const unsigned*)(raw + tau * SC_ROWB + c2 * 2);
                const float c0 = __uint_as_float(cu << 16), c1 = __uint_as_float(cu & 0xFFFF0000u);
                float p0, p1;
                if (tau > 0) { const unsigned pu = *(const unsigned*)(raw + (tau - 1) * SC_ROWB + c2 * 2); p0 = __uint_as_float(pu << 16); p1 = __uint_as_float(pu & 0xFFFF0000u); }
                else if (t0 > 0) { p0 = pvb[c2]; p1 = pvb[c2 + 1]; }
                else { p0 = 0.f; p1 = 0.f; }
                if (tau == SC_TC - 1) { pwb[c2] = c0; pwb[c2 + 1] = c1; }
                const float x0 = c0 + (p0 - c0) * cst[c2], x1 = c1 + (p1 - c1) * cst[c2 + 1];
                float* dstv = (c2 < 64) ? (s_r + tau * 64 + c2) : (c2 < 128) ? (s_k + tau * 64 + c2 - 64) : (s_v + tau * 64 + c2 - 128);
                *(float2*)dstv = make_float2(x0, x1);
            }
        }
        if (mm < 3 || l > 0) {
            const unsigned char* Ab = raw + ((mm == 0) ? 384 : (mm == 1) ? 512 : (mm == 2) ? 640 : 896);
            float* dst = (mm == 0) ? s_w : (mm == 1) ? s_a : (mm == 2) ? s_g : s_o;
#pragma unroll
            for (int m = 0; m < 2; ++m) {
                f32x4 acc0 = {0.f, 0.f, 0.f, 0.f}, acc1 = {0.f, 0.f, 0.f, 0.f};
#pragma unroll
                for (int ks = 0; ks < 4; ++ks) {
                    if (ks < nks) {
                        const bf16x8 a = *(const bf16x8*)(Ab + (m * 16 + fr) * SC_ROWB + ks * 64 + fq * 16);
                        acc0 = __builtin_amdgcn_mfma_f32_16x16x32_bf16(a, Bw[0][ks], acc0, 0, 0, 0);
                        acc1 = __builtin_amdgcn_mfma_f32_16x16x32_bf16(a, Bw[1][ks], acc1, 0, 0, 0);
                    }
                }
#pragma unroll
                for (int j = 0; j < 4; ++j) {
                    dst[(m * 16 + fq * 4 + j) * 64 + ntb * 16 + fr] = acc0[j];
                    dst[(m * 16 + fq * 4 + j) * 64 + (ntb + 1) * 16 + fr] = acc1[j];
                }
            }
        }
        lds_barrier();
        {
            const int tau = tid >> 4, c4 = (tid & 15) * 4, e = tau * 64 + c4, t = t0 + tau;
            const size_t n = (size_t)b * TS + t;
            const float4 xw4 = *(const float4*)(s_w + e), xa4 = *(const float4*)(s_a + e), kr4 = *(const float4*)(s_k + e);
            float4 vv4 = *(const float4*)(s_v + e);
            const float4 cw = *(const float4*)(cst + 480 + c4), ca = *(const float4*)(cst + 544 + c4), ckk = *(const float4*)(cst + 608 + c4), cka = *(const float4*)(cst + 672 + c4);
            const float xw[4] = {xw4.x + cw.x, xw4.y + cw.y, xw4.z + cw.z, xw4.w + cw.w};
            const float xa[4] = {xa4.x + ca.x, xa4.y + ca.y, xa4.z + ca.z, xa4.w + ca.w};
            const float kr[4] = {kr4.x, kr4.y, kr4.z, kr4.w};
            const float kkc[4] = {ckk.x, ckk.y, ckk.z, ckk.w}, kac[4] = {cka.x, cka.y, cka.z, cka.w};
            float vv[4] = {vv4.x, vv4.y, vv4.z, vv4.w};
            if (l > 0) {
                const float4 xv4 = *(const float4*)(s_o + e), cv = *(const float4*)(cst + 928 + c4);
                const uint2 vfu = *(const uint2*)(raw + tau * SC_ROWB + 960 + c4 * 2);
                const float vf[4] = {__uint_as_float(vfu.x << 16), __uint_as_float(vfu.x & 0xFFFF0000u), __uint_as_float(vfu.y << 16), __uint_as_float(vfu.y & 0xFFFF0000u)};
                const float xv[4] = {xv4.x + cv.x, xv4.y + cv.y, xv4.z + cv.z, xv4.w + cv.w};
#pragma unroll
                for (int j = 0; j < 4; ++j) vv[j] = vv[j] + (vf[j] - vv[j]) * fast_sigmoid(xv[j]);
            } else if (t < TS) {
                *(uint2*)(vfirst + n * 1024 + hc + c4) = pack4(vv[0], vv[1], vv[2], vv[3]);
            }
            float dec[4], av[4], kkv[4]; float ss = 0.f;
#pragma unroll
            for (int j = 0; j < 4; ++j) {
                dec[j] = __expf(-0.6065306597126334f * fast_sigmoid(xw[j]));
                av[j] = fast_sigmoid(xa[j]);
                kkv[j] = kr[j] * kkc[j];
                ss += kkv[j] * kkv[j];
            }
            ss = row16_sum(ss);
            const float rn = rsqrtf(fmaxf(ss, 1e-24f));
            float kk[4];
#pragma unroll
            for (int j = 0; j < 4; ++j) kk[j] = kkv[j] * rn;
            *(float4*)(s_w + e) = make_float4(dec[0], dec[1], dec[2], dec[3]);
            *(float4*)(s_a + e) = make_float4(-kk[0], -kk[1], -kk[2], -kk[3]);
            *(float4*)(s_b + e) = make_float4(kk[0] * av[0], kk[1] * av[1], kk[2] * av[2], kk[3] * av[3]);
            *(float4*)(s_k + e) = make_float4(kr[0] * (1.0f + (av[0] - 1.0f) * kac[0]), kr[1] * (1.0f + (av[1] - 1.0f) * kac[1]), kr[2] * (1.0f + (av[2] - 1.0f) * kac[2]), kr[3] * (1.0f + (av[3] - 1.0f) * kac[3]));
            *(float4*)(s_v + e) = make_float4(vv[0], vv[1], vv[2], vv[3]);
        }
        lds_barrier();
        {
            struct VS { float4 w, b, k, r, a; float2 v; };
            VS X, Y;
            {
                const float4 a4 = *(const float4*)(s_a + cg * 4);
                float sa0_ = S0[0] * a4.x + S0[1] * a4.y + S0[2] * a4.z + S0[3] * a4.w;
                float sa1_ = S1[0] * a4.x + S1[1] * a4.y + S1[2] * a4.z + S1[3] * a4.w;
                float du0 = 0.f, du1 = 0.f;
                row16_sum4(sa0_, sa1_, du0, du1);
                X.w = *(const float4*)(s_w + cg * 4); X.b = *(const float4*)(s_b + cg * 4); X.k = *(const float4*)(s_k + cg * 4); X.r = *(const float4*)(s_r + cg * 4);
                X.v = *(const float2*)(s_v + wid * 8 + rg * 2);
                X.a = *(const float4*)(s_a + 64 + cg * 4);
                float sa0 = sa0_, sa1 = sa1_;
                auto step = [&](VS& C, VS& N, int tau) {
                    const int tn = (tau + 1 < SC_TC) ? tau + 1 : tau, tn2 = (tau + 2 < SC_TC) ? tau + 2 : tau;
                    N.a = *(const float4*)(s_a + tn2 * 64 + cg * 4);
                    N.w = *(const float4*)(s_w + tn * 64 + cg * 4);
                    N.b = *(const float4*)(s_b + tn * 64 + cg * 4);
                    N.k = *(const float4*)(s_k + tn * 64 + cg * 4);
                    N.r = *(const float4*)(s_r + tn * 64 + cg * 4);
                    N.v = *(const float2*)(s_v + tn * 64 + wid * 8 + rg * 2);
                    S0[0] = S0[0] * C.w.x + (sa0 * C.b.x + C.v.x * C.k.x); S0[1] = S0[1] * C.w.y + (sa0 * C.b.y + C.v.x * C.k.y);
                    S0[2] = S0[2] * C.w.z + (sa0 * C.b.z + C.v.x * C.k.z); S0[3] = S0[3] * C.w.w + (sa0 * C.b.w + C.v.x * C.k.w);
                    S1[0] = S1[0] * C.w.x + (sa1 * C.b.x + C.v.y * C.k.x); S1[1] = S1[1] * C.w.y + (sa1 * C.b.y + C.v.y * C.k.y);
                    S1[2] = S1[2] * C.w.z + (sa1 * C.b.z + C.v.y * C.k.z); S1[3] = S1[3] * C.w.w + (sa1 * C.b.w + C.v.y * C.k.w);
                    float o0 = S0[0] * C.r.x + S0[1] * C.r.y + S0[2] * C.r.z + S0[3] * C.r.w;
                    float o1 = S1[0] * C.r.x + S1[1] * C.r.y + S1[2] * C.r.z + S1[3] * C.r.w;
                    sa0 = S0[0] * C.a.x + S0[1] * C.a.y + S0[2] * C.a.z + S0[3] * C.a.w;
                    sa1 = S1[0] * C.a.x + S1[1] * C.a.y + S1[2] * C.a.z + S1[3] * C.a.w;
                    row16_sum4(sa0, sa1, o0, o1);
                    if (cg == 0) *(float2*)(s_o + tau * 64 + wid * 8 + rg * 2) = make_float2(o0, o1);
                };
#pragma unroll 1
                for (int tau = 0; tau < nval; tau += 2) { step(X, Y, tau); step(Y, X, tau + 1); }
            }
        }
        lds_barrier();
        {
            const int tau = tid >> 4, c4 = (tid & 15) * 4, e = tau * 64 + c4;
            const size_t n = (size_t)b * TS + t0 + tau;
            const float4 o4 = *(const float4*)(s_o + e), r4_ = *(const float4*)(s_r + e), k4_ = *(const float4*)(s_k + e), v4_ = *(const float4*)(s_v + e), g4_ = *(const float4*)(s_g + e);
            const float4 crk = *(const float4*)(cst + 736 + c4), clw = *(const float4*)(cst + 800 + c4), clb = *(const float4*)(cst + 864 + c4);
            float osum = (o4.x + o4.y) + (o4.z + o4.w);
            float bsum = r4_.x * k4_.x * crk.x + r4_.y * k4_.y * crk.y + r4_.z * k4_.z * crk.z + r4_.w * k4_.w * crk.w;
            float du0 = 0.f, du1 = 0.f;
            row16_sum4(osum, bsum, du0, du1);
            const float m_ = osum * (1.0f / 64.0f);
            const float d0 = o4.x - m_, d1 = o4.y - m_, d2 = o4.z - m_, d3 = o4.w - m_;
            const float var = row16_sum(d0 * d0 + d1 * d1 + d2 * d2 + d3 * d3) * (1.0f / 64.0f);
            const float rs = rsqrtf(var + 64e-5f);
            const float y0 = (d0 * rs * clw.x + clb.x + bsum * v4_.x) * g4_.x, y1 = (d1 * rs * clw.y + clb.y + bsum * v4_.y) * g4_.y;
            const float y2 = (d2 * rs * clw.z + clb.z + bsum * v4_.z) * g4_.z, y3 = (d3 * rs * clw.w + clb.w + bsum * v4_.w) * g4_.w;
            if (tau < nval) *(uint2*)(Pr + n * 1024 + hc + c4) = pack4(y0, y1, y2, y3);
        }
    }
}

__device__ void phase_merge(const Params& p, unsigned char* lds) {
    const int tid = otid(), lane = tid & 63, wid = tid >> 6, wr = wid >> 1, wc = wid & 1, fr = lane & 15, fq = lane >> 4;
    const bf16_t* h = (const bf16_t*)(WS(p) + OFF_H);
    const bf16_t* wb = (const bf16_t*)(WS(p) + OFF_WB);
    const float* rstd = (const float*)(WS(p) + OFF_RSTD);
    bf16_t* merged = (bf16_t*)(WS(p) + OFF_MERGED);
    const bf16_t* ysrc0 = (const bf16_t*)(WS(p) + OFF_PPOOL);
    const bf16_t* ysrc1 = (const bf16_t*)(WS(p) + OFF_PR);
    const bf16_t* ysrc2 = (const bf16_t*)(OUTB(p) + DO_YC);
    for (int tile = obid(); tile < 86 * 8; tile += gridDim.x) {
        const int mt = tile >> 3, nt = tile & 7;
        const int row0 = mt * 192, col0 = nt * 128;
        uint2 maccp[3][4];
#pragma unroll
        for (int m = 0; m < 3; ++m)
#pragma unroll
            for (int n = 0; n < 4; ++n) maccp[m][n] = make_uint2(0u, 0u);
#pragma unroll 1
        for (int i = 0; i < 3; ++i) {
            const bf16_t* ys = (i == 0) ? ysrc0 : (i == 1 ? ysrc1 : ysrc2);
            uint2 sg[3][4];
            {
                f32x4 ag[3][4]; g3_zero<3>(ag);
                G3<192> g;
                g3_setup<192>(g, [&](int r) { return h + (size_t)(row0 + r) * DM; }, [&](int r) { return wb + WB_WG + (size_t)(i * 1024 + col0 + r) * DM; }, tid);
                g3_kloop<192>(ag, g, DM, lds);
#pragma unroll
                for (int m = 0; m < 3; ++m) {
                    const float rs = rstd[row0 + wr * 48 + m * 16 + fr];
#pragma unroll
                    for (int n = 0; n < 4; ++n) sg[m][n] = pack4(fast_sigmoid(ag[m][n][0] * rs), fast_sigmoid(ag[m][n][1] * rs), fast_sigmoid(ag[m][n][2] * rs), fast_sigmoid(ag[m][n][3] * rs));
                }
            }
            {
                f32x4 ay[3][4]; g3_zero<3>(ay);
                G3<192> g;
                g3_setup<192>(g, [&](int r) { return ys + (size_t)(row0 + r) * DM; }, [&](int r) { return wb + WB_PA + (size_t)(i * 1024 + col0 + r) * DM; }, tid);
                g3_kloop<192>(ay, g, DM, lds);
#pragma unroll
                for (int m = 0; m < 3; ++m)
#pragma unroll
                    for (int n = 0; n < 4; ++n) {
                        const float m0 = __uint_as_float(maccp[m][n].x << 16) + __uint_as_float(sg[m][n].x << 16) * ay[m][n][0];
                        const float m1 = __uint_as_float(maccp[m][n].x & 0xFFFF0000u) + __uint_as_float(sg[m][n].x & 0xFFFF0000u) * ay[m][n][1];
                        const float m2 = __uint_as_float(maccp[m][n].y << 16) + __uint_as_float(sg[m][n].y << 16) * ay[m][n][2];
                        const float m3 = __uint_as_float(maccp[m][n].y & 0xFFFF0000u) + __uint_as_float(sg[m][n].y & 0xFFFF0000u) * ay[m][n][3];
                        maccp[m][n] = pack4(m0, m1, m2, m3);
                    }
            }
        }
#pragma unroll
        for (int m = 0; m < 3; ++m) {
            const int row = row0 + wr * 48 + m * 16 + fr;
#pragma unroll
            for (int n = 0; n < 4; ++n)
                *(uint2*)(merged + (size_t)row * 1024 + col0 + wc * 64 + n * 16 + fq * 4) = maccp[m][n];
        }
    }
}

__device__ void phase_outproj(const Params& p, unsigned char* lds) {
    const int tid = otid(), lane = tid & 63, wid = tid >> 6, wr = wid >> 1, wc = wid & 1, fr = lane & 15, fq = lane >> 4;
    const bf16_t* h = (const bf16_t*)(WS(p) + OFF_H);
    const bf16_t* wb = (const bf16_t*)(WS(p) + OFF_WB);
    const bf16_t* merged = (const bf16_t*)(WS(p) + OFF_MERGED);
    float* hm = (float*)(WS(p) + OFF_HM32);
    for (int tile = obid(); tile < 86 * 8; tile += gridDim.x) {
        const int mt = tile >> 3, nt = tile & 7;
        const int row0 = mt * 192, col0 = nt * 128;
        G3<192> g;
        g3_setup<192>(g, [&](int r) { return merged + (size_t)(row0 + r) * DM; }, [&](int r) { return wb + WB_WO + (size_t)(col0 + r) * DM; }, tid);
        f32x4 acc[3][4]; g3_zero<3>(acc);
        g3_kloop<192>(acc, g, DM, lds);
#pragma unroll
        for (int m = 0; m < 3; ++m) {
            const int row = row0 + wr * 48 + m * 16 + fr;
#pragma unroll
            for (int n = 0; n < 4; ++n) {
                const int col = col0 + wc * 64 + n * 16 + fq * 4;
                const uint2 hv = *(const uint2*)(h + (size_t)row * 1024 + col);
                float4 o;
                o.x = __uint_as_float(hv.x << 16) + acc[m][n][0]; o.y = __uint_as_float(hv.x & 0xFFFF0000u) + acc[m][n][1];
                o.z = __uint_as_float(hv.y << 16) + acc[m][n][2]; o.w = __uint_as_float(hv.y & 0xFFFF0000u) + acc[m][n][3];
                *(float4*)(hm + (size_t)row * 1024 + col) = o;
            }
        }
    }
}

__device__ __constant__ int c_pair_lo[6] = {0, 0, 0, 1, 1, 2};
__device__ __constant__ int c_pair_hi[6] = {1, 2, 3, 2, 3, 3};
__device__ void phase_route(const Params& p, int l, unsigned char* lds) {
    const int tid = otid(), lane = tid & 63, wid = tid >> 6;
    const int per = (NT + (int)gridDim.x - 1) / (int)gridDim.x;
    const int nbeg = obid() * per, nend = (nbeg + per < NT) ? nbeg + per : NT;
    int* s_cls = (int*)lds;
    int* s_base = s_cls + 512;
    float* s_wr = (float*)(lds + 4096);
    const float* hm = (const float*)(WS(p) + OFF_HM32);
    bf16_t* hn = (bf16_t*)(WS(p) + OFF_HN);
    const float* nf = p.in[33] + (size_t)l * 1024;
    const float* wg = p.in[34] + (size_t)l * 1024 * 4;
    const float* bg = p.in[35] + l * 4;
    const float* we = p.in[36] + (size_t)l * 1024 * 16;
    const float* be = p.in[37] + l * 16;
    int* cnt = (int*)(WS(p) + OFF_CTL);
    int* list = (int*)(WS(p) + OFF_LIST);
    float* pw = (float*)(WS(p) + OFF_PW);
    for (int e = tid; e < 1024 * 20; e += NTHR) {
        const int k = e / 20, c = e - k * 20;
        s_wr[c * 1024 + k] = (c < 4) ? wg[(size_t)k * 4 + c] : we[(size_t)k * 16 + (c - 4)];
    }
    __syncthreads();
    for (int n = nbeg + wid; n < nend; n += 8) {
        float ss = 0.f;
#pragma unroll
        for (int i = 0; i < 4; ++i) {
            const float4 v = *(const float4*)(hm + (size_t)n * DM + i * 256 + lane * 4);
            ss += v.x * v.x + v.y * v.y + v.z * v.z + v.w * v.w;
        }
        ss = wave_sum(ss);
        const float rs = rsqrtf(ss * (1.0f / 1024.0f) + 1e-6f);
        float lg[4] = {0.f, 0.f, 0.f, 0.f};
        float le[16];
#pragma unroll
        for (int e = 0; e < 16; ++e) le[e] = 0.f;
#pragma unroll 1
        for (int i = 0; i < 4; ++i) {
            const float4 xv = *(const float4*)(hm + (size_t)n * DM + i * 256 + lane * 4);
            const float4 nv = *(const float4*)(nf + i * 256 + lane * 4);
            float y[4] = {xv.x * rs * nv.x, xv.y * rs * nv.y, xv.z * rs * nv.z, xv.w * rs * nv.w};
            {
                const int d0 = i * 256 + lane * 4;
#pragma unroll
                for (int g = 0; g < 4; ++g) { const float4 w4 = *(const float4*)(s_wr + g * 1024 + d0); lg[g] += y[0] * w4.x + y[1] * w4.y + y[2] * w4.z + y[3] * w4.w; }
#pragma unroll
                for (int e = 0; e < 16; ++e) { const float4 w4 = *(const float4*)(s_wr + (4 + e) * 1024 + d0); le[e] += y[0] * w4.x + y[1] * w4.y + y[2] * w4.z + y[3] * w4.w; }
            }
            ushort4 o;
            o.x = f2bf(y[0]); o.y = f2bf(y[1]); o.z = f2bf(y[2]); o.w = f2bf(y[3]);
            *(ushort4*)(hn + (size_t)n * DM + i * 256 + lane * 4) = o;
        }
#pragma unroll
        for (int g = 0; g < 4; ++g) lg[g] = wave_sum_fast(lg[g]) + bg[g];
#pragma unroll
        for (int e = 0; e < 16; ++e) le[e] = wave_sum_fast(le[e]) + be[e];
        if (lane == 0) {
            int gs = 0; float gm = lg[0];
#pragma unroll
            for (int g = 1; g < 4; ++g) if (lg[g] > gm) { gm = lg[g]; gs = g; }
            float den = 0.f;
#pragma unroll
            for (int g = 0; g < 4; ++g) den += __expf(lg[g] - gm);
            const float pgrp = 1.0f / den;
            float v4[4];
#pragma unroll
            for (int e = 0; e < 4; ++e) {
                const float m0 = (gs == 0) ? 1.f : 0.f, m1s = (gs == 1) ? 1.f : 0.f, m2s = (gs == 2) ? 1.f : 0.f, m3s = (gs == 3) ? 1.f : 0.f;
                v4[e] = le[e] * m0 + le[4 + e] * m1s + le[8 + e] * m2s + le[12 + e] * m3s;
            }
            int i1 = 0; float m1 = v4[0];
#pragma unroll
            for (int e = 1; e < 4; ++e) if (v4[e] > m1) { m1 = v4[e]; i1 = e; }
            int i2 = -1; float m2 = -INFINITY;
#pragma unroll
            for (int e = 0; e < 4; ++e) if (e != i1 && v4[e] > m2) { m2 = v4[e]; i2 = e; }
            const float e2 = __expf(m2 - m1);
            const float p1 = pgrp / (1.0f + e2), p2 = pgrp * e2 / (1.0f + e2);
            const int lo = i1 < i2 ? i1 : i2, hi = i1 < i2 ? i2 : i1;
            const float plo = i1 < i2 ? p1 : p2, phi = i1 < i2 ? p2 : p1;
            const int pi = (lo == 0) ? (hi - 1) : (lo == 1 ? hi + 1 : 5);
            const int cls = gs * 6 + pi;
            s_cls[n - nbeg] = cls;
            pw[(size_t)n * 2 + 0] = plo; pw[(size_t)n * 2 + 1] = phi;
        }
    }
    __syncthreads();
    const int nloc = nend - nbeg;
    if (tid < 24) {
        int c_ = 0;
        for (int i = 0; i < nloc; ++i) c_ += (s_cls[i] == tid) ? 1 : 0;
        s_base[tid] = c_ ? atomicAdd(&cnt[tid * 32], c_) : 0;
    }
    __syncthreads();
    for (int it = tid; it < nloc; it += NTHR) {
        const int cls = s_cls[it];
        int rank = 0;
        for (int i = 0; i < it; ++i) rank += (s_cls[i] == cls) ? 1 : 0;
        list[(size_t)cls * NT + s_base[cls] + rank] = nbeg + it;
    }
    __syncthreads();
}


struct MoeTile { int cls, ti, cnt, tg; };
__device__ __forceinline__ int moe_total_tiles(const int* cnt) { int s = 0; for (int c = 0; c < 24; ++c) s += (cnt[c * 32] + 127) >> 7; return s; }
__device__ __forceinline__ MoeTile moe_find(const int* cnt, int tile) {
    MoeTile r; int s = 0; r.cls = 0; r.ti = 0; r.cnt = 0; r.tg = tile;
    for (int c = 0; c < 24; ++c) { const int nt = (cnt[c * 32] + 127) >> 7; if (tile >= s && tile < s + nt) { r.cls = c; r.ti = tile - s; r.cnt = cnt[c * 32]; } s += nt; }
    return r;
}
__device__ void phase_moe1(const Params& p, unsigned char* lds) {
    const int tid = otid(), lane = tid & 63, wid = tid >> 6, wr = wid >> 1, wc = wid & 1, fr = lane & 15, fq = lane >> 4;
    const int* cnt = (const int*)(WS(p) + OFF_CTL);
    const int* list = (const int*)(WS(p) + OFF_LIST);
    const float* pw = (const float*)(WS(p) + OFF_PW);
    const bf16_t* hn = (const bf16_t*)(WS(p) + OFF_HN);
    const bf16_t* we = (const bf16_t*)(WS(p) + OFF_WEXP);
    bf16_t* hid = (bf16_t*)(OUTB(p) + DO_HID);
    const int total = moe_total_tiles(cnt);
    for (int item = obid(); item < total * 4; item += gridDim.x) {
        const MoeTile mt = moe_find(cnt, item >> 2);
        const int nt = item & 3, slot = nt >> 1, f0 = (nt & 1) * 128;
        const int g_ = mt.cls / 6, pi = mt.cls % 6;
        const int e = g_ * 4 + (slot == 0 ? c_pair_lo[pi] : c_pair_hi[pi]);
        const int* lst = list + (size_t)mt.cls * NT + mt.ti * 128;
        const int nvalid = min(128, mt.cnt - mt.ti * 128);
        f32x4 a1[2][4], a3[2][4]; g3_zero<2>(a1); g3_zero<2>(a3);
        G3<128> g;
        g3_setup<128>(g, [&](int r) { return hn + (size_t)lst[r < nvalid ? r : 0] * DM; }, [&](int r) { return we + WE_W1 + ((size_t)e * 256 + f0 + r) * 1024; }, tid);
        g3_kloop<128>(a1, g, DM, lds);
        g3_setup<128>(g, [&](int r) { return hn + (size_t)lst[r < nvalid ? r : 0] * DM; }, [&](int r) { return we + WE_W3 + ((size_t)e * 256 + f0 + r) * 1024; }, tid);
        g3_kloop<128>(a3, g, DM, lds);
#pragma unroll
        for (int m = 0; m < 2; ++m) {
            const int lr = wr * 32 + m * 16 + fr;
            const int tk = lst[lr < nvalid ? lr : 0];
            const float pe = pw[(size_t)tk * 2 + slot];
#pragma unroll
            for (int n = 0; n < 4; ++n) {
                const int col = slot * 256 + f0 + wc * 64 + n * 16 + fq * 4;
                float o[4];
#pragma unroll
                for (int j = 0; j < 4; ++j) { const float x1 = a1[m][n][j]; o[j] = x1 * sigmoidf_(x1) * a3[m][n][j] * pe; }
                *(uint2*)(hid + ((size_t)mt.tg * 128 + lr) * 512 + col) = pack4(o[0], o[1], o[2], o[3]);
            }
        }
    }
}
__device__ void phase_moe2(const Params& p, unsigned char* lds) {
    const int tid = otid(), lane = tid & 63, wid = tid >> 6, wr = wid >> 1, wc = wid & 1, fr = lane & 15, fq = lane >> 4;
    const int* cnt = (const int*)(WS(p) + OFF_CTL);
    const int* list = (const int*)(WS(p) + OFF_LIST);
    const bf16_t* we = (const bf16_t*)(WS(p) + OFF_WEXP);
    const bf16_t* hid = (const bf16_t*)(OUTB(p) + DO_HID);
    float* hm = (float*)(WS(p) + OFF_HM32);
    bf16_t* h = (bf16_t*)(WS(p) + OFF_H);
    const int total = moe_total_tiles(cnt);
    for (int item = obid(); item < total * 8; item += gridDim.x) {
        const MoeTile mt = moe_find(cnt, item >> 3);
        const int nt = item & 7, col0 = nt * 128;
        const int g_ = mt.cls / 6, pi = mt.cls % 6;
        const int elo = g_ * 4 + c_pair_lo[pi], ehi = g_ * 4 + c_pair_hi[pi];
        const int* lst = list + (size_t)mt.cls * NT + mt.ti * 128;
        const int nvalid = min(128, mt.cnt - mt.ti * 128);
        f32x4 acc[2][4]; g3_zero<2>(acc);
        G3<128> g;
        g3_setup<128>(g, [&](int r) { return hid + ((size_t)mt.tg * 128 + r) * 512; }, [&](int r) { return we + WE_W2 + ((size_t)elo * 1024 + col0 + r) * 256; }, tid);
        g3_kloop<128>(acc, g, 256, lds);
        g3_setup<128>(g, [&](int r) { return hid + ((size_t)mt.tg * 128 + r) * 512 + 256; }, [&](int r) { return we + WE_W2 + ((size_t)ehi * 1024 + col0 + r) * 256; }, tid);
        g3_kloop<128>(acc, g, 256, lds);
#pragma unroll
        for (int m = 0; m < 2; ++m) {
            const int lr = wr * 32 + m * 16 + fr;
            if (lr < nvalid) {
                const int tk = lst[lr];
#pragma unroll
                for (int n = 0; n < 4; ++n) {
                    const int col = col0 + wc * 64 + n * 16 + fq * 4;
                    float4 v = *(const float4*)(hm + (size_t)tk * 1024 + col);
                    v.x += acc[m][n][0]; v.y += acc[m][n][1]; v.z += acc[m][n][2]; v.w += acc[m][n][3];
                    *(float4*)(hm + (size_t)tk * 1024 + col) = v;
                    *(uint2*)(h + (size_t)tk * 1024 + col) = pack4(v.x, v.y, v.z, v.w);
                }
            }
        }
    }
}

__device__ void phase_final(const Params& p) {
    const int lane = otid() & 63;
    const int wave = (obid() * NTHR + otid()) >> 6, nw = gridDim.x * NTHR / 64;
    const float* hm = (const float*)(WS(p) + OFF_HM32);
    const float* nf = p.in[41];
    for (int r = wave; r < NB * SEQ; r += nw) {
        const int b = r / SEQ, s = r % SEQ;
        const size_t n = (size_t)b * TS + NMETA + s;
        float4 v[4]; float ss = 0.f;
#pragma unroll
        for (int i = 0; i < 4; ++i) { v[i] = *(const float4*)(hm + n * DM + i * 256 + lane * 4); ss += v[i].x * v[i].x + v[i].y * v[i].y + v[i].z * v[i].z + v[i].w * v[i].w; }
        ss = wave_sum(ss);
        const float rs = rsqrtf(ss * (1.0f / 1024.0f) + 1e-6f);
#pragma unroll
        for (int i = 0; i < 4; ++i) {
            const float4 g = *(const float4*)(nf + i * 256 + lane * 4);
            float4 o; o.x = v[i].x * rs * g.x; o.y = v[i].y * rs * g.y; o.z = v[i].z * rs * g.z; o.w = v[i].w * rs * g.w;
            *(float4*)((float*)OUTB(p) + (size_t)r * DM + i * 256 + lane * 4) = o;
        }
    }
}


#define XB_TMO      128
#define XB_XCNT(j)  (256  + 64 * (j))
#define XB_XSUB(j)  (1280 + 64 * (j))
#define XB_XGEN(j)  (2304 + 64 * (j))
#define XB_TOP      3328
#define XB_TOPGEN   3392
#define XCD_BAR_WORDS 3456
#define XB_SPIN_CAP (1u << 22)
#define LAS __attribute__((address_space(3)))
__device__ __forceinline__ unsigned xb_ld(unsigned* p) { return __hip_atomic_load(p, __ATOMIC_RELAXED, __HIP_MEMORY_SCOPE_AGENT); }
__device__ __forceinline__ unsigned xb_add(unsigned* p, unsigned v) { return __hip_atomic_fetch_add(p, v, __ATOMIC_RELAXED, __HIP_MEMORY_SCOPE_AGENT); }
__device__ __forceinline__ unsigned xb_xcc_id() { return (unsigned)__builtin_amdgcn_s_getreg((3 << 11) | 20) & 0xFu; }
#define XB_SPIN(cond, bar) do { unsigned _sp = 0; while (cond) { __builtin_amdgcn_s_sleep(1); \
    if ((++_sp & 255u) == 0u) { if (xb_ld(&(bar)[XB_TMO])) break; if (_sp > XB_SPIN_CAP) { atomicAdd(&(bar)[XB_TMO], 1u); break; } } } } while (0)
struct XcdBarrier { unsigned* bar; unsigned x; volatile LAS unsigned* st; };
__device__ __forceinline__ XcdBarrier xcd_barrier_post(unsigned* bar, volatile LAS unsigned* st) {
    XcdBarrier b; b.bar = bar; b.x = xb_xcc_id(); b.st = st;
    if (threadIdx.x == 0) (void)xb_add(&bar[XB_XCNT(b.x)], 1u);
    return b;
}
__device__ __forceinline__ void xcd_barrier_complete(unsigned* bar, unsigned x, unsigned& nloc, unsigned& nx) {
    const unsigned G = gridDim.x * gridDim.y * gridDim.z;
    unsigned sum, cnt, mine, sp = 0u;
    for (;;) {
        sum = 0u; cnt = 0u; mine = 0u;
#pragma unroll
        for (unsigned j = 0; j < 16; ++j) { const unsigned c = xb_ld(&bar[XB_XCNT(j)]); sum += c; cnt += (c > 0u) ? 1u : 0u; mine = (j == x) ? c : mine; }
        if (sum == G) break;
        __builtin_amdgcn_s_sleep(1);
        if ((++sp & 255u) == 0u) { if (xb_ld(&bar[XB_TMO])) break; if (sp > XB_SPIN_CAP) { atomicAdd(&bar[XB_TMO], 1u); break; } }
    }
    nloc = mine > 0u ? mine : 1u; nx = cnt > 0u ? cnt : 1u;
}
__device__ __forceinline__ void xcd_barrier(const XcdBarrier& b) {
    asm volatile("s_waitcnt vmcnt(0)" ::: "memory");
    __syncthreads();
    if (threadIdx.x == 0) {
        unsigned* bar = b.bar;
        __builtin_amdgcn_s_waitcnt(0);
        unsigned nloc = b.st[0], nx = b.st[1];
        if (nloc == 0u) { xcd_barrier_complete(bar, b.x, nloc, nx); b.st[0] = nloc; b.st[1] = nx; }
        const unsigned old = xb_add(&bar[XB_XSUB(b.x)], 1u);
        const unsigned gen = old / nloc;
        if (old + 1u == (gen + 1u) * nloc) {
            __builtin_amdgcn_fence(__ATOMIC_RELEASE, "agent");
            asm volatile("s_waitcnt vmcnt(0)" ::: "memory");
            const unsigned og = xb_add(&bar[XB_TOP], 1u);
            const unsigned tg = og / nx;
            if (og + 1u == (tg + 1u) * nx) xb_add(&bar[XB_TOPGEN], 1u);
            else XB_SPIN(xb_ld(&bar[XB_TOPGEN]) == tg, bar);
            __builtin_amdgcn_fence(__ATOMIC_ACQUIRE, "agent");
            xb_add(&bar[XB_XGEN(b.x)], 1u);
            asm volatile("s_waitcnt vmcnt(0)" ::: "memory");
        } else {
            XB_SPIN(xb_ld(&bar[XB_XGEN(b.x)]) == gen, bar);
            __builtin_amdgcn_fence(__ATOMIC_ACQUIRE, "agent");
            asm volatile("s_waitcnt vmcnt(0)" ::: "memory");
        }
    }
    __syncthreads();
}

__global__ void __launch_bounds__(NTHR) fwd_megakernel(Params p) {
    extern __shared__ __attribute__((aligned(16))) unsigned char lds[];
    cg::grid_group grid = cg::this_grid();
    volatile LAS unsigned* xst = (volatile LAS unsigned*)(lds + LDS_BYTES - 32);
    if (threadIdx.x < 2) xst[threadIdx.x] = 0u;
    __syncthreads();
    const XcdBarrier xb = xcd_barrier_post((unsigned*)(p.ws + OFF_BAR), xst);
#pragma unroll 1
    for (int step = 0; step < 18; ++step) {
        const int l = step >= 9 ? 1 : 0;
        const int ph = step - l * 9;
        switch (ph) {
        case 0:
            if (l == 0) phase_embed(p); else phase_rowstat(p);
            phase_convert<false>(p, l, lds);
            if (obid() == 0 && otid() < 24) ((int*)(WS(p) + OFF_CTL))[otid() * 32] = 0;
            if (obid() == 0 && otid() == 32) ((int*)(WS(p) + OFF_CTL))[800 + l * 32] = 0;
            break;
        case 1: phase_inproj(p, lds); break;
        case 2: phase_dsa_prep(p, l); phase_lr_prep(p, l); break;
        case 3: {
            if (obid() < NB * 16) phase_scan5(p, l, lds, obid());
            int* qctr = (int*)(WS(p) + OFF_CTL) + 800 + l * 32;
            int* qslot = (int*)(lds + LDS_BYTES - 16);
            for (;;) {
                __syncthreads();
                if (otid() == 0) *qslot = atomicAdd(qctr, 1);
                __syncthreads();
                const int item = *qslot;
                if (item >= 516 + NT / 16) break;
                if (item < 516) phase_pool(p, l, lds, item, item + 1, 1);
                else phase_dsa<false>(p, l, lds, (bf16_t*)(OUTB(p) + DO_YC), nullptr, nullptr, item - 516, item - 515, 1);
            }
        } break;
        case 4: phase_merge(p, lds); break;
        case 5: phase_outproj(p, lds); phase_convert<true>(p, l, lds); break;
        case 6: phase_route(p, l, lds); break;
        case 7: phase_moe1(p, lds); break;
        default: phase_moe2(p, lds); break;
        }
        if (step == 0) grid.sync(); else xcd_barrier(xb);
    }
    phase_final(p);
}

extern "C" void kernel_launch(void* const* d_in, const int* in_sizes, int n_in,
                              void* d_out, int out_size, void* d_ws, size_t ws_size,
                              hipStream_t stream) {
    static int grid_blocks = 0;
    if (grid_blocks == 0) {
        int dev = 0, cus = 0, per_cu = 0;
        (void)hipGetDevice(&dev);
        (void)hipDeviceGetAttribute(&cus, hipDeviceAttributeMultiprocessorCount, dev);
        (void)hipFuncSetAttribute((const void*)fwd_megakernel, hipFuncAttributeMaxDynamicSharedMemorySize, LDS_BYTES);
        (void)hipOccupancyMaxActiveBlocksPerMultiprocessor(&per_cu, fwd_megakernel, NTHR, LDS_BYTES);
        if (per_cu < 1 || cus < NB * 16 || n_in != 42 || ws_size < WS_END) { fprintf(stderr, "kernel_launch: bad config per_cu=%d n_in=%d ws=%zu need=%zu\n", per_cu, n_in, ws_size, (size_t)WS_END); grid_blocks = -1; }
        else grid_blocks = cus;
    }
    if (grid_blocks < 0) return;
    Params p{};
    for (int i = 0; i < 42; ++i) p.in[i] = (const float*)d_in[i];
    p.out = (float*)d_out;
    p.ws = (unsigned char*)d_ws;
    (void)hipMemsetAsync((unsigned char*)d_ws + OFF_BAR, 0, XCD_BAR_WORDS * 4, stream);
    void* args[] = {&p};
    hipError_t e = hipLaunchCooperativeKernel((void*)fwd_megakernel, dim3(grid_blocks), dim3(NTHR), args, LDS_BYTES, stream);
    if (e != hipSuccess) fprintf(stderr, "cooperative launch failed: %s (grid %d)\n", hipGetErrorString(e), grid_blocks);
}
```

```cpp
#include <hip/hip_runtime.h>
#include <hip/hip_cooperative_groups.h>
#include <cstdio>
#include <cstdint>
#include <type_traits>
namespace cg = cooperative_groups;

typedef unsigned short bf16_t;
typedef short bf16x8 __attribute__((ext_vector_type(8)));
typedef float f32x4 __attribute__((ext_vector_type(4)));

constexpr int NB = 8, SEQ = 2048, NMETA = 16, TS = 2064, DM = 1024;
constexpr int NT = NB * TS;
constexpr int NTP = 16640;
constexpr int NTHR = 512;
constexpr int CIN = 7912;
constexpr int NP1 = 4864;
constexpr int PM_LD = 768;
constexpr int PM_WD = 0, PM_AD = 64, PM_GD = 128, PM_VD = 256, PM_CQ = 288, PM_CKV = 544, PM_KROPE = 672, PM_KIDX = 704;
constexpr int LDS_BYTES = 157 * 1024;

constexpr size_t AL(size_t x) { return (x + 255) & ~(size_t)255; }
constexpr size_t SZ_ACT = (size_t)NTP * 1024 * 2;
constexpr size_t OFF_CTL = 0;
constexpr size_t OFF_BAR = 4096;
constexpr size_t OFF_RSTD = OFF_BAR + 16384;
constexpr size_t OFF_ROPE = OFF_RSTD + AL((size_t)NTP * 4);
constexpr size_t OFF_H = OFF_ROPE + AL((size_t)TS * 16 * 4 * 2);
constexpr size_t OFF_WB = OFF_H + SZ_ACT;
constexpr size_t WB_WIN = 0;
constexpr size_t WB_WG = WB_WIN + (size_t)NP1 * 1024;
constexpr size_t WB_PA = WB_WG + (size_t)3072 * 1024;
constexpr size_t WB_WO = WB_PA + (size_t)3 * 1024 * 1024;
constexpr size_t WB_POOL = WB_WO + (size_t)1024 * 1024;
constexpr size_t WB_QI = WB_POOL + (size_t)4 * 256 * 256;
constexpr size_t WB_UQ = WB_QI + (size_t)512 * 256;
constexpr size_t WB_UK = WB_UQ + (size_t)1536 * 256;
constexpr size_t WB_UV = WB_UK + (size_t)16 * 128 * 64;
constexpr size_t WB_WIDX = WB_UV + (size_t)16 * 64 * 128;
constexpr size_t WB_END = WB_WIDX + (size_t)64 * 1024;
constexpr size_t OFF_PPOOL = OFF_WB + AL(WB_END * 2);
constexpr size_t OFF_PK = OFF_PPOOL + SZ_ACT;
constexpr size_t OFF_PR = OFF_PK + SZ_ACT;
constexpr size_t OFF_PV = OFF_PR + SZ_ACT;
constexpr size_t OFF_PMISC = OFF_PV + SZ_ACT;
constexpr size_t OFF_VFIRST = OFF_PMISC + AL((size_t)NTP * PM_LD * 2);
constexpr size_t OFF_HALO = OFF_VFIRST + SZ_ACT;
constexpr size_t OFF_LIST = OFF_HALO + AL((size_t)130 * 16 * 1024 * 2);
constexpr size_t OFF_PW = OFF_LIST + AL((size_t)24 * NT * 4);
constexpr size_t WS_END = OFF_PW + AL((size_t)NT * 2 * 4);
constexpr size_t OFF_MERGED = OFF_PK;
constexpr size_t OFF_HM32 = OFF_PR;
constexpr size_t OFF_HN = OFF_PPOOL;
constexpr size_t OFF_WEXP = OFF_PMISC;
constexpr size_t WE_W1 = 0, WE_W3 = (size_t)16 * 256 * 1024, WE_W2 = (size_t)2 * 16 * 256 * 1024;
static_assert((size_t)3 * 16 * 256 * 1024 * 2 <= (size_t)NTP * PM_LD * 2, "expert weights must fit in Pmisc");
constexpr size_t DO_YC = 0;
constexpr size_t DO_CQN = DO_YC + SZ_ACT;
constexpr size_t DO_KV = DO_CQN + AL((size_t)NT * 256 * 2);
constexpr size_t DO_KIDX = DO_KV + AL((size_t)NT * 160 * 2);
constexpr size_t DO_WHEAD = DO_KIDX + AL((size_t)NT * 64 * 2);
constexpr size_t DO_ALR = DO_WHEAD + AL((size_t)NT * 8 * 4);
constexpr size_t DO_END = DO_ALR + AL((size_t)NT * 288 * 2);
constexpr size_t DO_HID = DO_YC;
static_assert(DO_END <= (size_t)NB * SEQ * DM * 4, "d_out scratch overflow");
static_assert((size_t)(129 + 24) * 128 * 512 * 2 <= SZ_ACT, "hid fits");
static_assert(WS_END <= 277240096ull, "workspace overflow");

struct Params {
    const float* in[42];
    float* out;
    unsigned char* ws;
};

__device__ __forceinline__ int otid() { int t = threadIdx.x; asm volatile("" : "+v"(t)); return t; }
__device__ __forceinline__ int obid() { int b = blockIdx.x; asm volatile("" : "+s"(b)); return b; }
__device__ __forceinline__ unsigned char* WS(const Params& p) { unsigned char* w = p.ws; asm volatile("" : "+s"(w)); return w; }
__device__ __forceinline__ unsigned char* OUTB(const Params& p) { unsigned char* w = (unsigned char*)p.out; asm volatile("" : "+s"(w)); return w; }
__device__ __forceinline__ float bf2f(bf16_t v) { return __uint_as_float(((unsigned)v) << 16); }
__device__ __forceinline__ bf16_t f2bf(float f) { unsigned u = __float_as_uint(f); u += 0x7FFFu + ((u >> 16) & 1u); return (bf16_t)(u >> 16); }
__device__ __forceinline__ float wave_sum(float v) {
#pragma unroll
    for (int o = 32; o > 0; o >>= 1) v += __shfl_xor(v, o);
    return v;
}
__device__ __forceinline__ float sigmoidf_(float x) { return 1.0f / (1.0f + __expf(-x)); }
__device__ __forceinline__ float softplusf_(float z) { return fmaxf(z, 0.f) + log1pf(__expf(-fabsf(z))); }
__device__ __forceinline__ void glds16(const void* g, void* l) {
    __builtin_amdgcn_global_load_lds((const unsigned*)g, (unsigned*)l, 16, 0, 0);
}

__device__ void phase_embed(const Params& p) {
    const int lane = otid() & 63;
    const int wave = (obid() * NTHR + otid()) >> 6, nw = gridDim.x * NTHR / 64;
    bf16_t* h = (bf16_t*)(WS(p) + OFF_H);
    float* rstd = (float*)(WS(p) + OFF_RSTD);
    for (int n = wave; n < NTP; n += nw) {
        if (n < NT) {
            const int b = n / TS, t = n % TS;
            const float* src = t < NMETA ? p.in[1] + (size_t)t * DM : p.in[0] + ((size_t)b * SEQ + (t - NMETA)) * DM;
            float ss = 0.f;
#pragma unroll
            for (int i = 0; i < 4; ++i) {
                const float4 v = *(const float4*)(src + i * 256 + lane * 4);
                ss += v.x * v.x + v.y * v.y + v.z * v.z + v.w * v.w;
                ushort4 o; o.x = f2bf(v.x); o.y = f2bf(v.y); o.z = f2bf(v.z); o.w = f2bf(v.w);
                *(ushort4*)(h + (size_t)n * DM + i * 256 + lane * 4) = o;
            }
            ss = wave_sum(ss);
            if (lane == 0) rstd[n] = rsqrtf(ss * (1.0f / 1024.0f) + 1e-6f);
        } else {
#pragma unroll
            for (int i = 0; i < 4; ++i) *(ushort4*)(h + (size_t)n * DM + i * 256 + lane * 4) = make_ushort4(0, 0, 0, 0);
            if (lane == 0) rstd[n] = 0.f;
        }
    }
    float* ctab = (float*)(WS(p) + OFF_ROPE);
    float* stab = ctab + TS * 16;
    for (int idx = obid() * NTHR + otid(); idx < TS * 16; idx += gridDim.x * NTHR) {
        const int t = idx >> 4, i = idx & 15;
        const float inv = powf(10000.0f, -(float)(2 * i) / 32.0f);
        const float ang = (float)t * inv;
        ctab[idx] = cosf(ang);
        stab[idx] = sinf(ang);
    }
}

__device__ void phase_rowstat(const Params& p) {
    const int lane = otid() & 63;
    const int wave = (obid() * NTHR + otid()) >> 6, nw = gridDim.x * NTHR / 64;
    const float* hm = (const float*)(WS(p) + OFF_HM32);
    float* rstd = (float*)(WS(p) + OFF_RSTD);
    for (int n = wave; n < NT; n += nw) {
        float ss = 0.f;
#pragma unroll
        for (int i = 0; i < 4; ++i) {
            const float4 v = *(const float4*)(hm + (size_t)n * DM + i * 256 + lane * 4);
            ss += v.x * v.x + v.y * v.y + v.z * v.z + v.w * v.w;
        }
        ss = wave_sum(ss);
        if (lane == 0) rstd[n] = rsqrtf(ss * (1.0f / 1024.0f) + 1e-6f);
    }
}

struct ConvJob { const float* src; bf16_t* dst; const float* scale; int ldsrc, K, nvalid, nrows, nb, notr; size_t sbs, dbs; const float* srcB; int ldB, split; };
__device__ __forceinline__ int conv_job_tiles(const ConvJob& j) { return j.nb * (j.nrows >> 6) * (j.K >> 6); }
__device__ void conv_tile(const ConvJob& j, int tile, float* lds) {
    const int per = (j.nrows >> 6) * (j.K >> 6);
    const int bi = tile / per, rem = tile % per;
    const int ktiles = j.K >> 6;
    const int n0 = (rem / ktiles) << 6, k0 = (rem % ktiles) << 6;
    const int tid = otid(), tn = tid & 63, tk = tid >> 6;
    const float* src = j.src + (size_t)bi * j.sbs;
    bf16_t* dst = j.dst + (size_t)bi * j.dbs;
#pragma unroll
    for (int kk = 0; kk < 8; ++kk) {
        const int k = k0 + tk * 8 + kk;
        float v = 0.f;
        if (n0 + tn < j.nvalid) {
            if (j.split) { const int nn = n0 + tn; v = (nn < j.split) ? (j.src ? j.src[(size_t)k * j.ldsrc + nn] : 0.f) : j.srcB[(size_t)k * j.ldB + (nn - j.split)]; }
            else v = j.notr ? src[(size_t)(n0 + tn) * j.ldsrc + k] : src[(size_t)k * j.ldsrc + n0 + tn];
            if (j.scale) v *= j.scale[k];
        }
        lds[tn * 65 + tk * 8 + kk] = v;
    }
    __syncthreads();
    const int wn = tid >> 3, kq = tid & 7;
    uint4 o;
    unsigned w[4];
#pragma unroll
    for (int q = 0; q < 4; ++q) {
        const float lo = lds[wn * 65 + kq * 8 + 2 * q], hi = lds[wn * 65 + kq * 8 + 2 * q + 1];
        w[q] = (unsigned)f2bf(lo) | ((unsigned)f2bf(hi) << 16);
    }
    o.x = w[0]; o.y = w[1]; o.z = w[2]; o.w = w[3];
    *(uint4*)(dst + (size_t)(n0 + wn) * j.K + k0 + kq * 8) = o;
    __syncthreads();
}
__device__ ConvJob get_job_early(const Params& p, int l, int ji) {
    bf16_t* wb = (bf16_t*)(WS(p) + OFF_WB);
    const float* win = p.in[3] + (size_t)l * DM * CIN;
    const float* nm = p.in[2] + (size_t)l * DM;
    ConvJob j{}; j.nb = 1; j.sbs = 0; j.dbs = 0; j.K = 1024; j.ldsrc = CIN; j.scale = nm;
    switch (ji) {
    case 0: j.src = win + 3072; j.dst = wb + WB_WIN; j.nvalid = 4352; j.nrows = 4352; break;
    case 1: j.src = (l == 0 ? nullptr : p.in[17]); j.ldsrc = 32; j.split = 32; j.srcB = win + 7424; j.ldB = CIN; j.dst = wb + WB_WIN + (size_t)(4096 + PM_VD) * 1024; j.nvalid = 512; j.nrows = 512; break;
    case 2: j.src = win + 7904; j.dst = wb + WB_WIDX; j.nvalid = 8; j.nrows = 64; break;
    case 3: j.src = win; j.dst = wb + WB_WG; j.nvalid = 3072; j.nrows = 3072; break;
    case 4: j.src = p.in[29] + (size_t)l * DM * DM; j.ldsrc = 1024; j.scale = nullptr; j.dst = wb + WB_PA; j.nvalid = 1024; j.nrows = 1024; break;
    case 5: j.src = p.in[30] + (size_t)l * DM * DM; j.ldsrc = 1024; j.scale = nullptr; j.dst = wb + WB_PA + (size_t)1024 * 1024; j.nvalid = 1024; j.nrows = 1024; break;
    case 6: j.src = p.in[31] + (size_t)l * DM * DM; j.ldsrc = 1024; j.scale = nullptr; j.dst = wb + WB_PA + (size_t)2 * 1024 * 1024; j.nvalid = 1024; j.nrows = 1024; break;
    case 7: j.src = p.in[32] + (size_t)l * DM * DM; j.ldsrc = 1024; j.scale = nullptr; j.dst = wb + WB_WO; j.nvalid = 1024; j.nrows = 1024; break;
    case 8: j.src = p.in[5] + (size_t)l * 4 * 256 * 256; j.ldsrc = 256; j.K = 256; j.scale = nullptr; j.dst = wb + WB_POOL; j.nvalid = 256; j.nrows = 256; j.nb = 4; j.sbs = 65536; j.dbs = 65536; break;
    case 9: j.src = p.in[26] + (size_t)l * 256 * 512; j.ldsrc = 512; j.K = 256; j.scale = nullptr; j.dst = wb + WB_QI; j.nvalid = 512; j.nrows = 512; break;
    case 10: j.src = p.in[23] + (size_t)l * 256 * 1536; j.ldsrc = 1536; j.K = 256; j.scale = nullptr; j.dst = wb + WB_UQ; j.nvalid = 1536; j.nrows = 1536; break;
    case 11: j.src = p.in[24] + (size_t)l * 16 * 128 * 64; j.ldsrc = 64; j.K = 64; j.scale = nullptr; j.dst = wb + WB_UK; j.nvalid = 2048; j.nrows = 2048; j.notr = 1; break;
    default: j.src = p.in[25] + (size_t)l * 16 * 128 * 64; j.ldsrc = 64; j.K = 128; j.scale = nullptr; j.dst = wb + WB_UV; j.nvalid = 64; j.nrows = 64; j.nb = 16; j.sbs = 8192; j.dbs = 8192; break;
    }
    return j;
}
__device__ ConvJob get_job_late(const Params& p, int l, int ji) {
    bf16_t* we = (bf16_t*)(WS(p) + OFF_WEXP);
    ConvJob j{}; j.nb = 16; j.scale = nullptr; j.sbs = 262144; j.dbs = 262144;
    switch (ji) {
    case 0: j.src = p.in[38] + (size_t)l * 16 * 262144; j.dst = we + WE_W1; j.ldsrc = 256; j.K = 1024; j.nvalid = 256; j.nrows = 256; break;
    case 1: j.src = p.in[39] + (size_t)l * 16 * 262144; j.dst = we + WE_W3; j.ldsrc = 256; j.K = 1024; j.nvalid = 256; j.nrows = 256; break;
    default: j.src = p.in[40] + (size_t)l * 16 * 262144; j.dst = we + WE_W2; j.ldsrc = 1024; j.K = 256; j.nvalid = 1024; j.nrows = 1024; break;
    }
    return j;
}
template <bool LATE>
__device__ void phase_convert(const Params& p, int l, unsigned char* lds) {
    const int njobs = LATE ? 3 : 13;
    int base = 0;
    for (int ji = 0; ji < njobs; ++ji) {
        const ConvJob j = LATE ? get_job_late(p, l, ji) : get_job_early(p, l, ji);
        const int nt = conv_job_tiles(j);
        int first = ((int)obid() - base) % (int)gridDim.x; if (first < 0) first += gridDim.x;
        for (int t = first; t < nt; t += gridDim.x) conv_tile(j, t, (float*)lds);
        base += nt;
    }
}

template <int BM> struct G3 {
    static constexpr int MI = BM / 64;
    static constexpr int NA = BM / 64;
    static constexpr int STAGE = BM * 128 + 128 * 128;
    const bf16_t* ap[NA];
    const bf16_t* bp[2];
};
template <int BM>
__device__ __forceinline__ void g3_issue(const G3<BM>& g, int kt, unsigned char* stage, int tid) {
#pragma unroll
    for (int i = 0; i < G3<BM>::NA; ++i) glds16(g.ap[i] + kt * 64, stage + (tid + i * NTHR) * 16);
#pragma unroll
    for (int i = 0; i < 2; ++i) glds16(g.bp[i] + kt * 64, stage + BM * 128 + (tid + i * NTHR) * 16);
}
template <int BM, class FA, class FB>
__device__ __forceinline__ void g3_setup(G3<BM>& g, FA rowptr, FB bcol, int tid) {
#pragma unroll
    for (int i = 0; i < G3<BM>::NA; ++i) { const int idx = tid + i * NTHR, row = idx >> 3, sl = (idx & 7) ^ (row & 7); g.ap[i] = rowptr(row) + sl * 8; }
#pragma unroll
    for (int i = 0; i < 2; ++i) { const int idx = tid + i * NTHR, row = idx >> 3, sl = (idx & 7) ^ (row & 7); g.bp[i] = bcol(row) + sl * 8; }
}
template <int BM>
__device__ __forceinline__ void g3_kloop(f32x4 (&acc)[BM / 64][4], const G3<BM>& g, int K, unsigned char* lds) {
    constexpr int MI = G3<BM>::MI, STAGE = G3<BM>::STAGE, NL = G3<BM>::NA + 2;
    const int tid = otid(), lane = tid & 63, wid = tid >> 6, wr = wid >> 1, wc = wid & 1, fr = lane & 15, fq = lane >> 4;
    const int nk = K >> 6;
    g3_issue<BM>(g, 0, lds, tid);
    if (nk > 1) g3_issue<BM>(g, 1, lds + STAGE, tid);
    int cur = 0;
#pragma unroll 1
    for (int t = 0; t < nk; ++t) {
        if (t + 1 < nk) { if (NL == 6) asm volatile("s_waitcnt vmcnt(6)" ::: "memory"); else if (NL == 5) asm volatile("s_waitcnt vmcnt(5)" ::: "memory"); else asm volatile("s_waitcnt vmcnt(4)" ::: "memory"); }
        else asm volatile("s_waitcnt vmcnt(0)" ::: "memory");
        __builtin_amdgcn_s_barrier();
        if (t + 2 < nk) { int nx = cur + 2; if (nx >= 3) nx -= 3; g3_issue<BM>(g, t + 2, lds + nx * STAGE, tid); }
        const unsigned char* cA = lds + cur * STAGE;
        const unsigned char* cB = cA + BM * 128;
#pragma unroll
        for (int ks = 0; ks < 2; ++ks) {
            bf16x8 a[MI], b[4];
#pragma unroll
            for (int m = 0; m < MI; ++m) { const int row = wr * (BM / 4) + m * 16 + fr; a[m] = *(const bf16x8*)(cA + row * 128 + (((ks * 4 + fq) ^ (row & 7)) << 4)); }
#pragma unroll
            for (int n = 0; n < 4; ++n) { const int row = wc * 64 + n * 16 + fr; b[n] = *(const bf16x8*)(cB + row * 128 + (((ks * 4 + fq) ^ (row & 7)) << 4)); }
#pragma unroll
            for (int m = 0; m < MI; ++m)
#pragma unroll
                for (int n = 0; n < 4; ++n) acc[m][n] = __builtin_amdgcn_mfma_f32_16x16x32_bf16(b[n], a[m], acc[m][n], 0, 0, 0);
        }
        cur = (cur == 2) ? 0 : cur + 1;
    }
    __builtin_amdgcn_s_barrier();
}
template <int MI>
__device__ __forceinline__ void g3_zero(f32x4 (&acc)[MI][4]) {
#pragma unroll
    for (int m = 0; m < MI; ++m)
#pragma unroll
        for (int n = 0; n < 4; ++n) acc[m][n] = (f32x4){0.f, 0.f, 0.f, 0.f};
}
__device__ __forceinline__ uint2 pack4(float a, float b, float c, float d) {
    uint2 r; r.x = (unsigned)f2bf(a) | ((unsigned)f2bf(b) << 16); r.y = (unsigned)f2bf(c) | ((unsigned)f2bf(d) << 16); return r;
}

namespace pg8 {
#define PG8_LAS __attribute__((address_space(3)))
typedef unsigned short bf16_t;
typedef short bf16x8 __attribute__((ext_vector_type(8)));
typedef float f32x4 __attribute__((ext_vector_type(4)));
typedef unsigned u32x4 __attribute__((ext_vector_type(4)));
constexpr int BM = 256, BK = 64, HALF = 128, HTB = HALF * BK * 2  , STAGE_BYTES = 8 * HTB, NXCD = 8, WGM = 8;

__host__ __device__ __forceinline__ int lds_byte(int r, int c) { const int st = (r >> 4) * 2 + (c >> 5), rr = r & 15, cc = c & 31, ob = rr * 64 + cc * 2; return st * 1024 + (ob ^ (((ob >> 9) & 1) << 5)); }
__host__ __device__ __forceinline__ void stage_rc(int b, int& R, int& C) { const int st = b / 1024, sb = b % 1024, swz = sb ^ (((sb >> 9) & 1) << 5); R = (st >> 1) * 16 + swz / 64; C = (st & 1) * 32 + (swz % 64) / 2; }
__host__ __device__ __forceinline__ int perm32(int rho) { const int n = rho >> 4, i = rho & 15; return 8 * (i >> 2) + 4 * n + (i & 3); }

struct Unit { int pm, pn; };
struct Gemm { const bf16_t* A; const bf16_t* Bt; int M, N, K; };

struct StaticOrder {
    int nM, nN, nwg, G, c;
    __host__ __device__ void init(int M, int N, int G_, int c_) { nM = M / BM; nN = N / BM; nwg = nM * nN; G = G_; c = c_; }
    __host__ __device__ bool next(int i, Unit& u) const {
        const long L = (long)i * G + c; if (L >= nwg) return false;
        int wgid = (int)L; { const int q = nwg / NXCD, r = nwg % NXCD, xcd = wgid % NXCD, off = wgid / NXCD; wgid = (xcd < r ? xcd * (q + 1) : r * (q + 1) + (xcd - r) * q) + off; }
        const int nig = WGM * nN, gid = wgid / nig, fm = gid * WGM, gsz = (nM - fm) < WGM ? (nM - fm) : WGM;
        u.pm = fm + ((wgid % nig) % gsz); u.pn = (wgid % nig) / gsz; return true;
    }
    __device__ __forceinline__ void a_ready(const Unit&) const {}
    __device__ __forceinline__ void done(const Unit&) const {}
};
template <class Epi, class Sched, bool STAMP = false>
__device__ __forceinline__ void gemm_phase(PG8_LAS unsigned char* lds, const Gemm g, const Sched& S, const Epi& E, unsigned long long* stamps) {
    const int tid = otid(), wid = __builtin_amdgcn_readfirstlane(tid >> 6), lane = tid & 63, wr = wid >> 2, wc = wid & 3, fr = lane & 15, fq = lane >> 4;
    const int K = g.K, nt = K / BK;
    int ts_lo = 0, ts_hi = 0, nts = 0; const unsigned long long rt_entry = STAMP ? 0ull : 0ull;
#define PG8_STAMP() do { if (STAMP && wid == 0 && nts < 64) { const unsigned long long _c = 0ull; \
        ts_lo = (lane == nts) ? (int)(unsigned)_c : ts_lo; ts_hi = (lane == nts) ? (int)(unsigned)(_c >> 32) : ts_hi; ++nts; } } while (0)
    PG8_STAMP();
    unsigned voffA[2], voffB[2];
#pragma unroll
    for (int i = 0; i < 2; ++i) { int R, C; stage_rc(tid * 16 + i * 8192, R, C); const int Rb = Epi::PERM ? ((R & ~31) + perm32(R & 31)) : R;
        voffA[i] = (unsigned)(R * K + C) * 2u; voffB[i] = (unsigned)(Rb * K + C) * 2u; }
    const size_t kstep = (size_t)(BK * 2);
    const size_t hstep = (size_t)HALF * K * 2;
    const size_t tstep = 2 * hstep;
    const unsigned ldsw = (unsigned)wid * 1024u;
    const int aoff = lds_byte(wr * 64 + fr, fq * 8), boff = lds_byte(wc * 32 + fr, fq * 8);
#define PG8_SA(b, h) (((b) * 2 + (h)) * HTB)
#define PG8_SB(b, h) ((4 + (b) * 2 + (h)) * HTB)
#define PG8_STAGE(bufoff, gbase, voff) do { _Pragma("unroll") for (int _i = 0; _i < 2; ++_i) \
        __builtin_amdgcn_global_load_lds((const unsigned*)((const char*)(gbase) + (voff)[_i]), (PG8_LAS unsigned*)(lds + (bufoff) + ldsw + _i * 8192), 16, 0, 0); } while (0)
#define PG8_LDA(dst, b, h) do { _Pragma("unroll") for (int m = 0; m < 4; ++m) _Pragma("unroll") for (int k = 0; k < 2; ++k) dst[m][k] = *(const PG8_LAS bf16x8*)(lds + PG8_SA(b, h) + aoff + m * 2048 + k * 1024); } while (0)
#define PG8_LDB(dst, b, h) do { _Pragma("unroll") for (int n = 0; n < 2; ++n) _Pragma("unroll") for (int k = 0; k < 2; ++k) dst[n][k] = *(const PG8_LAS bf16x8*)(lds + PG8_SB(b, h) + boff + n * 2048 + k * 1024); } while (0)
#define PG8_MMA(ai, bj, At, Bt) do { __builtin_amdgcn_s_setprio(1); _Pragma("unroll") for (int m = 0; m < 4; ++m) _Pragma("unroll") for (int n = 0; n < 2; ++n) _Pragma("unroll") for (int k = 0; k < 2; ++k) \
        acc[ai][bj][m][n] = __builtin_amdgcn_mfma_f32_16x16x32_bf16(Bt[n][k], At[m][k], acc[ai][bj][m][n], 0, 0, 0); __builtin_amdgcn_s_setprio(0); } while (0)
#define PG8_WAIT_V(n) asm volatile("s_waitcnt vmcnt(" #n ")" ::: "memory")
#define PG8_WAIT_L(n) asm volatile("s_waitcnt lgkmcnt(" #n ")" ::: "memory")
#define PG8_BAR __builtin_amdgcn_s_barrier()
#define PG8_SCHED __builtin_amdgcn_sched_barrier(0)
    Unit cur, nxt; int ui = 0;
    if (!S.next(0, cur)) return;
    f32x4 acc[2][2][4][2];
#pragma unroll
    for (int a = 0; a < 2; ++a)
#pragma unroll
        for (int b = 0; b < 2; ++b)
#pragma unroll
            for (int m = 0; m < 4; ++m)
#pragma unroll
                for (int n = 0; n < 2; ++n) acc[a][b][m][n] = (f32x4){0.f, 0.f, 0.f, 0.f};
    bf16x8 At[4][2], B0[2][2], B1[2][2];
    const char* cA = (const char*)g.A + (size_t)cur.pm * tstep; const char* cB = (const char*)g.Bt + (size_t)cur.pn * tstep;
    S.a_ready(cur);
    PG8_STAGE(PG8_SB(0, 0), cB, voffB); PG8_STAGE(PG8_SA(0, 0), cA, voffA); PG8_STAGE(PG8_SB(0, 1), cB + hstep, voffB); PG8_STAGE(PG8_SA(0, 1), cA + hstep, voffA);
    if (wr == 1) PG8_BAR;
    PG8_WAIT_V(4); PG8_BAR;
    PG8_STAGE(PG8_SB(1, 0), cB + kstep, voffB); PG8_STAGE(PG8_SA(1, 0), cA + kstep, voffA); PG8_STAGE(PG8_SB(1, 1), cB + hstep + kstep, voffB);
    PG8_WAIT_V(6); PG8_BAR;
    PG8_STAMP();
    for (;;) {
        const bool has_next = S.next(ui + 1, nxt);
        const char* nA = has_next ? (const char*)g.A + (size_t)nxt.pm * tstep : cA; const char* nB = has_next ? (const char*)g.Bt + (size_t)nxt.pn * tstep : cB;
        for (int t = 0; t < nt; t += 2) {
            const bool last = (t == nt - 2);
            const char* a1 = cA + (size_t)(t + 1) * kstep;
            const char* a2 = last ? nA : cA + (size_t)(t + 2) * kstep; const char* b2 = last ? nB : cB + (size_t)(t + 2) * kstep;
            const char* a3 = a2 + kstep; const char* b3 = b2 + kstep;
            if (last && has_next) S.a_ready(nxt);
            PG8_LDB(B0, 0, 0); PG8_SCHED; PG8_LDA(At, 0, 0); PG8_STAGE(PG8_SA(1, 1), a1 + hstep, voffA);
            PG8_WAIT_L(8); PG8_BAR; PG8_WAIT_L(0); PG8_MMA(0, 0, At, B0); PG8_BAR; PG8_SCHED;
            PG8_LDB(B1, 0, 1); PG8_STAGE(PG8_SB(0, 0), b2, voffB);
            PG8_BAR; PG8_WAIT_L(0); PG8_MMA(0, 1, At, B1); PG8_BAR;
            PG8_LDA(At, 0, 1); PG8_STAGE(PG8_SA(0, 0), a2, voffA);
            PG8_BAR; PG8_WAIT_L(0); PG8_MMA(1, 0, At, B0); PG8_BAR; PG8_SCHED;
            PG8_STAGE(PG8_SB(0, 1), b2 + hstep, voffB);
            PG8_WAIT_V(6); PG8_BAR; PG8_MMA(1, 1, At, B1); PG8_BAR;
            PG8_LDB(B0, 1, 0); PG8_SCHED; PG8_LDA(At, 1, 0); PG8_STAGE(PG8_SA(0, 1), a2 + hstep, voffA);
            PG8_WAIT_L(8); PG8_BAR; PG8_WAIT_L(0); PG8_MMA(0, 0, At, B0); PG8_BAR; PG8_SCHED;
            PG8_LDB(B1, 1, 1); PG8_STAGE(PG8_SB(1, 0), b3, voffB);
            PG8_BAR; PG8_WAIT_L(0); PG8_MMA(0, 1, At, B1); PG8_BAR;
            PG8_LDA(At, 1, 1); PG8_STAGE(PG8_SA(1, 0), a3, voffA);
            PG8_BAR; PG8_WAIT_L(0); PG8_MMA(1, 0, At, B0); PG8_BAR; PG8_SCHED;
            PG8_STAGE(PG8_SB(1, 1), b3 + hstep, voffB);
            PG8_WAIT_V(6); PG8_BAR; PG8_MMA(1, 1, At, B1); PG8_BAR;
        }
        PG8_STAMP();
        if constexpr (!Epi::AFTER_DRAIN) { E(acc, cur, wr, wc, fr, fq); S.done(cur); }
        PG8_STAMP();
        if (!has_next) break;
#pragma unroll
        for (int a = 0; a < 2; ++a)
#pragma unroll
            for (int b = 0; b < 2; ++b)
#pragma unroll
                for (int m = 0; m < 4; ++m)
#pragma unroll
                    for (int n = 0; n < 2; ++n) acc[a][b][m][n] = (f32x4){0.f, 0.f, 0.f, 0.f};
        cur = nxt; cA = nA; cB = nB; ++ui;
    }
    PG8_WAIT_V(0);
    if (wr == 0) PG8_BAR;
    PG8_BAR;
    if constexpr (Epi::AFTER_DRAIN) { E.fused(acc, cur, wr, wc, fr, fq, lds, wid, lane); S.done(cur); }
    PG8_STAMP();
    if (STAMP && wid == 0) { stamps[lane] = lane < nts ? (((unsigned long long)(unsigned)ts_hi << 32) | (unsigned)ts_lo) : 0ull;
        if (lane == 62) stamps[62] = rt_entry; if (lane == 63) stamps[63] = 0ull; }
#undef PG8_STAMP
#undef PG8_SA
#undef PG8_SB
#undef PG8_STAGE
#undef PG8_LDA
#undef PG8_LDB
#undef PG8_MMA
#undef PG8_WAIT_V
#undef PG8_WAIT_L
#undef PG8_BAR
#undef PG8_SCHED
}
}

struct EpiInproj {
    static constexpr bool PERM = true, AFTER_DRAIN = false;
    unsigned char* ws; const float* rstd;
    __device__ __forceinline__ void operator()(const pg8::f32x4 (&acc)[2][2][4][2], const pg8::Unit& u, int wr, int wc, int fr, int fq) const {
        const int pn = u.pn;
        bf16_t* dst; int ld, cb;
        if (pn < 4) { dst = (bf16_t*)(ws + OFF_PPOOL); ld = 1024; cb = pn * 256; }
        else if (pn < 8) { dst = (bf16_t*)(ws + OFF_PR); ld = 1024; cb = (pn - 4) * 256; }
        else if (pn < 12) { dst = (bf16_t*)(ws + OFF_PK); ld = 1024; cb = (pn - 8) * 256; }
        else if (pn < 16) { dst = (bf16_t*)(ws + OFF_PV); ld = 1024; cb = (pn - 12) * 256; }
        else { dst = (bf16_t*)(ws + OFF_PMISC); ld = PM_LD; cb = (pn - 16) * 256; }
        bf16_t* halo = (bf16_t*)(ws + OFF_HALO);
#pragma unroll
        for (int ai = 0; ai < 2; ++ai)
#pragma unroll
            for (int m = 0; m < 4; ++m) {
                const int row = u.pm * 256 + ai * 128 + wr * 64 + m * 16 + fr;
                if (row < NT) {
                    const float rs = rstd[row];
                    const int lr = row & 127;
#pragma unroll
                    for (int bj = 0; bj < 2; ++bj) {
                        const int col = cb + bj * 128 + wc * 32 + fq * 8;
                        const uint2 lo = pack4(acc[ai][bj][m][0][0] * rs, acc[ai][bj][m][0][1] * rs, acc[ai][bj][m][0][2] * rs, acc[ai][bj][m][0][3] * rs);
                        const uint2 hi = pack4(acc[ai][bj][m][1][0] * rs, acc[ai][bj][m][1][1] * rs, acc[ai][bj][m][1][2] * rs, acc[ai][bj][m][1][3] * rs);
                        const uint4 v = make_uint4(lo.x, lo.y, hi.x, hi.y);
                        *(uint4*)(dst + (size_t)row * ld + col) = v;
                        if (pn < 4 && lr >= 112) *(uint4*)(halo + ((size_t)(row >> 7) * 16 + (lr - 112)) * 1024 + col) = v;
                    }
                }
            }
    }
};
__device__ void phase_inproj(const Params& p, unsigned char* lds) {
    pg8::StaticOrder S; S.init(NTP, NP1, (int)gridDim.x, obid());
    pg8::Gemm g; g.A = (const pg8::bf16_t*)(WS(p) + OFF_H); g.Bt = (const pg8::bf16_t*)(WS(p) + OFF_WB) + WB_WIN; g.M = NTP; g.N = NP1; g.K = DM;
    EpiInproj E; E.ws = WS(p); E.rstd = (const float*)(WS(p) + OFF_RSTD);
    pg8::gemm_phase<EpiInproj, pg8::StaticOrder, false>((PG8_LAS unsigned char*)lds, g, S, E, nullptr);
}

__device__ void phase_pool(const Params& p, int l, unsigned char* lds, int tb, int te, int tstep) {
    const int tid = otid(), lane = tid & 63, wid = tid >> 6, fr = lane & 15, fq = lane >> 4;
    bf16_t* pp = (bf16_t*)(WS(p) + OFF_PPOOL);
    const bf16_t* halo = (const bf16_t*)(WS(p) + OFF_HALO);
    const bf16_t* pw = (const bf16_t*)(WS(p) + OFF_WB) + WB_POOL;
    const float* scale = p.in[6] + (size_t)l * 1024;
    bf16_t* sp = (bf16_t*)lds;
    constexpr int SLD = 264;
    for (int tile = tb; tile < te; tile += tstep) {
        const int mt = tile >> 2, g = tile & 3;
        const int row0 = mt * 128, w = 2 << g;
        {
            const int c = tid & 255, r0 = (tid >> 8) * 64, col = g * 256 + c;
            auto rawv = [&](int n2) -> float {
                return (n2 >= row0) ? bf2f(pp[(size_t)n2 * 1024 + col]) : bf2f(halo[((size_t)(n2 >> 7) * 16 + ((n2 & 127) - 112)) * 1024 + col]);
            };
            int n = row0 + r0, t = n % TS;
            float sum = 0.f;
            const int have = (t < w) ? t : w;
            for (int i = 1; i <= have; ++i) sum += rawv(n - i);
#pragma unroll 4
            for (int r = 0; r < 64; ++r, ++n) {
                if (t == 0) sum = 0.f;
                const float v = rawv(n);
                sum += v;
                if (t >= w) sum -= rawv(n - w);
                const int cnt = (t + 1 < w) ? (t + 1) : w;
                sp[(r0 + r) * SLD + c] = f2bf(sum * (1.0f / (float)cnt) - v);
                t = (t + 1 == TS) ? 0 : t + 1;
            }
        }
        __syncthreads();
        f32x4 acc[8][2];
#pragma unroll
        for (int m = 0; m < 8; ++m) { acc[m][0] = (f32x4){0.f, 0.f, 0.f, 0.f}; acc[m][1] = (f32x4){0.f, 0.f, 0.f, 0.f}; }
        const bf16_t* wg = pw + (size_t)g * 65536;
#pragma unroll 1
        for (int kk = 0; kk < 8; ++kk) {
            bf16x8 bfr[2];
#pragma unroll
            for (int n = 0; n < 2; ++n) bfr[n] = *(const bf16x8*)(wg + (size_t)(wid * 32 + n * 16 + fr) * 256 + kk * 32 + fq * 8);
#pragma unroll
            for (int m = 0; m < 8; ++m) {
                const bf16x8 a = *(const bf16x8*)(sp + (m * 16 + fr) * SLD + kk * 32 + fq * 8);
                acc[m][0] = __builtin_amdgcn_mfma_f32_16x16x32_bf16(a, bfr[0], acc[m][0], 0, 0, 0);
                acc[m][1] = __builtin_amdgcn_mfma_f32_16x16x32_bf16(a, bfr[1], acc[m][1], 0, 0, 0);
            }
        }
#pragma unroll
        for (int m = 0; m < 8; ++m)
#pragma unroll
            for (int n = 0; n < 2; ++n) {
                const int col = g * 256 + wid * 32 + n * 16 + fr;
                const float sc = scale[col];
#pragma unroll
                for (int j = 0; j < 4; ++j) {
                    const int row = row0 + m * 16 + fq * 4 + j;
                    pp[(size_t)row * 1024 + col] = f2bf(acc[m][n][j] * sc);
                }
            }
        __syncthreads();
    }
}

__device__ void phase_dsa_prep(const Params& p, int l) {
    const int lane = otid() & 63;
    const int wave = (obid() * NTHR + otid()) >> 6, nw = gridDim.x * NTHR / 64;
    const bf16_t* pm = (const bf16_t*)(WS(p) + OFF_PMISC);
    unsigned char* dob = OUTB(p);
    bf16_t* cqn = (bf16_t*)(dob + DO_CQN);
    bf16_t* kv = (bf16_t*)(dob + DO_KV);
    bf16_t* kidx = (bf16_t*)(dob + DO_KIDX);
    float* whead = (float*)(dob + DO_WHEAD);
    const float* ctab = (const float*)(WS(p) + OFF_ROPE);
    const float* stab = ctab + TS * 16;
    const float* qn = p.in[21] + l * 256;
    const float* kvn = p.in[22] + l * 128;
    const float* inw = p.in[27] + l * 64;
    const float* inb = p.in[28] + l * 64;
    const bf16_t* hrow = (const bf16_t*)(WS(p) + OFF_H);
    const bf16_t* wwidx = (const bf16_t*)(WS(p) + OFF_WB) + WB_WIDX;
    const float* rstd_ = (const float*)(WS(p) + OFF_RSTD);
    for (int n = wave; n < NT; n += nw) {
        const int t = n % TS;
        const bf16_t* row = pm + (size_t)n * PM_LD;
        {
            float v[4]; float ss = 0.f;
#pragma unroll
            for (int i = 0; i < 4; ++i) { v[i] = bf2f(row[PM_CQ + lane * 4 + i]); ss += v[i] * v[i]; }
            ss = wave_sum(ss);
            const float rs = rsqrtf(ss * (1.0f / 256.0f) + 1e-6f);
#pragma unroll
            for (int i = 0; i < 4; ++i) cqn[(size_t)n * 256 + lane * 4 + i] = f2bf(v[i] * rs * qn[lane * 4 + i]);
        }
        {
            float v[2]; float ss = 0.f;
#pragma unroll
            for (int i = 0; i < 2; ++i) { v[i] = bf2f(row[PM_CKV + lane * 2 + i]); ss += v[i] * v[i]; }
            ss = wave_sum(ss);
            const float rs = rsqrtf(ss * (1.0f / 128.0f) + 1e-6f);
#pragma unroll
            for (int i = 0; i < 2; ++i) kv[(size_t)n * 160 + lane * 2 + i] = f2bf(v[i] * rs * kvn[lane * 2 + i]);
        }
        if (lane < 16) {
            const float x1 = bf2f(row[PM_KROPE + lane]), x2 = bf2f(row[PM_KROPE + 16 + lane]);
            const float c = ctab[t * 16 + lane], s = stab[t * 16 + lane];
            kv[(size_t)n * 160 + 128 + lane] = f2bf(x1 * c - x2 * s);
            kv[(size_t)n * 160 + 144 + lane] = f2bf(x2 * c + x1 * s);
        }
        {
            const float x = bf2f(row[PM_KIDX + lane]);
            const float mu = wave_sum(x) * (1.0f / 64.0f);
            const float d = x - mu;
            const float var = wave_sum(d * d) * (1.0f / 64.0f);
            const float y = d * rsqrtf(var + 1e-6f) * inw[lane] + inb[lane];
            const float yo = __shfl_xor(y, 16);
            float o = y;
            if (lane < 32) {
                const int i = lane & 15;
                const float c = ctab[t * 16 + i], s = stab[t * 16 + i];
                o = (lane < 16) ? (y * c - yo * s) : (y * c + yo * s);
            }
            kidx[(size_t)n * 64 + lane] = f2bf(o);
        }
        {
            const uint4 hv0 = *(const uint4*)(hrow + (size_t)n * DM + lane * 16), hv1 = *(const uint4*)(hrow + (size_t)n * DM + lane * 16 + 8);
            float hx[16];
            hx[0] = __uint_as_float(hv0.x << 16); hx[1] = __uint_as_float(hv0.x & 0xFFFF0000u); hx[2] = __uint_as_float(hv0.y << 16); hx[3] = __uint_as_float(hv0.y & 0xFFFF0000u);
            hx[4] = __uint_as_float(hv0.z << 16); hx[5] = __uint_as_float(hv0.z & 0xFFFF0000u); hx[6] = __uint_as_float(hv0.w << 16); hx[7] = __uint_as_float(hv0.w & 0xFFFF0000u);
            hx[8] = __uint_as_float(hv1.x << 16); hx[9] = __uint_as_float(hv1.x & 0xFFFF0000u); hx[10] = __uint_as_float(hv1.y << 16); hx[11] = __uint_as_float(hv1.y & 0xFFFF0000u);
            hx[12] = __uint_as_float(hv1.z << 16); hx[13] = __uint_as_float(hv1.z & 0xFFFF0000u); hx[14] = __uint_as_float(hv1.w << 16); hx[15] = __uint_as_float(hv1.w & 0xFFFF0000u);
            float myw = 0.f;
#pragma unroll
            for (int j = 0; j < 8; ++j) {
                const uint4 w0 = *(const uint4*)(wwidx + (size_t)j * DM + lane * 16), w1 = *(const uint4*)(wwidx + (size_t)j * DM + lane * 16 + 8);
                float d = hx[0] * __uint_as_float(w0.x << 16) + hx[1] * __uint_as_float(w0.x & 0xFFFF0000u) + hx[2] * __uint_as_float(w0.y << 16) + hx[3] * __uint_as_float(w0.y & 0xFFFF0000u)
                        + hx[4] * __uint_as_float(w0.z << 16) + hx[5] * __uint_as_float(w0.z & 0xFFFF0000u) + hx[6] * __uint_as_float(w0.w << 16) + hx[7] * __uint_as_float(w0.w & 0xFFFF0000u)
                        + hx[8] * __uint_as_float(w1.x << 16) + hx[9] * __uint_as_float(w1.x & 0xFFFF0000u) + hx[10] * __uint_as_float(w1.y << 16) + hx[11] * __uint_as_float(w1.y & 0xFFFF0000u)
                        + hx[12] * __uint_as_float(w1.z << 16) + hx[13] * __uint_as_float(w1.z & 0xFFFF0000u) + hx[14] * __uint_as_float(w1.w << 16) + hx[15] * __uint_as_float(w1.w & 0xFFFF0000u);
                d = wave_sum(d);
                myw = (lane == j) ? d : myw;
            }
            if (lane < 8) whead[(size_t)n * 8 + lane] = myw * rstd_[n] * 0.04419417382415922f;
        }
    }
}

typedef short s16x4 __attribute__((ext_vector_type(4)));
__device__ __forceinline__ unsigned f2h_bits(float f) { const _Float16 h = (_Float16)f; unsigned short u; __builtin_memcpy(&u, &h, 2); return u; }
template <bool IMPORT_SEL>
__device__ void phase_dsa(const Params& p, int l, unsigned char* lds, bf16_t* yc, const unsigned short* gsel, const int* gnsel, int tb, int te, int tstep) {
    const int tid = otid(), lane = tid & 63, wid = tid >> 6, fr = lane & 15, fq = lane >> 4;
    unsigned short* s_sc = (unsigned short*)lds;
    bf16_t* s_qi = (bf16_t*)(lds + 66048);
    bf16_t* s_Q = (bf16_t*)lds;
    unsigned char* s_Vw = lds + 82432 + wid * 8192;
    bf16_t* s_qn = (bf16_t*)s_Vw;
    unsigned short* s_sel = (unsigned short*)(lds + 82432 + 65536);
    int* s_nsel = (int*)(lds + 82432 + 65536 + 8192);
    unsigned char* dob = OUTB(p);
    const bf16_t* cqn = (const bf16_t*)(dob + DO_CQN);
    const bf16_t* kv = (const bf16_t*)(dob + DO_KV);
    const bf16_t* kidx = (const bf16_t*)(dob + DO_KIDX);
    const float* whead = (const float*)(dob + DO_WHEAD);
    const float* ctab = (const float*)(WS(p) + OFF_ROPE);
    const float* stab = ctab + TS * 16;
    const bf16_t* wb = (const bf16_t*)(WS(p) + OFF_WB);
    const bf16_t* wqiT = wb + WB_QI;
    const bf16_t* wuqT = wb + WB_UQ;
    const bf16_t* wuk = wb + WB_UK;
    const bf16_t* wuvT = wb + WB_UV;
    const float scale = 0.10206207261596575f;
    const f32x4 z4 = {0.f, 0.f, 0.f, 0.f};
    for (int tile = tb; tile < te; tile += tstep) {
        const int qt = 128 - (tile >> 3), b = tile & 7;
        const int t0 = qt * 16;
        const size_t n0 = (size_t)b * TS + t0;
        {
            bf16x8 acq[8];
#pragma unroll
            for (int kk = 0; kk < 8; ++kk) acq[kk] = *(const bf16x8*)(cqn + (n0 + fr) * 256 + kk * 32 + fq * 8);
            f32x4 c[4] = {z4, z4, z4, z4};
#pragma unroll
            for (int kb = 0; kb < 8; kb += 4) {
                bf16x8 bf[4][4];
#pragma unroll
                for (int k4 = 0; k4 < 4; ++k4)
#pragma unroll
                    for (int nt = 0; nt < 4; ++nt) bf[k4][nt] = *(const bf16x8*)(wqiT + (size_t)(wid * 64 + nt * 16 + fr) * 256 + (kb + k4) * 32 + fq * 8);
#pragma unroll
                for (int k4 = 0; k4 < 4; ++k4)
#pragma unroll
                    for (int nt = 0; nt < 4; ++nt) c[nt] = __builtin_amdgcn_mfma_f32_16x16x32_bf16(acq[kb + k4], bf[k4][nt], c[nt], 0, 0, 0);
            }
#pragma unroll
            for (int j = 0; j < 4; ++j) {
                const int t = t0 + fq * 4 + j;
                const float cs = ctab[t * 16 + fr], sn = stab[t * 16 + fr];
                const float x1 = c[0][j], x2 = c[1][j];
                c[0][j] = x1 * cs - x2 * sn; c[1][j] = x2 * cs + x1 * sn;
            }
#pragma unroll
            for (int nt = 0; nt < 4; ++nt)
#pragma unroll
                for (int j = 0; j < 4; ++j) s_qi[(fq * 4 + j) * 512 + wid * 64 + nt * 16 + fr] = f2bf(c[nt][j]);
        }
        __syncthreads();
        if (!IMPORT_SEL) {
            bf16x8 aq[8][2];
#pragma unroll
            for (int h = 0; h < 8; ++h)
#pragma unroll
                for (int ks = 0; ks < 2; ++ks) aq[h][ks] = *(const bf16x8*)(s_qi + fr * 512 + h * 64 + ks * 32 + fq * 8);
            float wh[4][8];
#pragma unroll
            for (int j = 0; j < 4; ++j) {
                const float4 w0 = *(const float4*)(whead + (n0 + fq * 4 + j) * 8), w1 = *(const float4*)(whead + (n0 + fq * 4 + j) * 8 + 4);
                wh[j][0] = w0.x; wh[j][1] = w0.y; wh[j][2] = w0.z; wh[j][3] = w0.w; wh[j][4] = w1.x; wh[j][5] = w1.y; wh[j][6] = w1.z; wh[j][7] = w1.w;
            }
            const int nkt = qt + 1;
            bf16x8 nb0 = {0, 0, 0, 0, 0, 0, 0, 0}, nb1 = nb0;
            if (wid < nkt) { const bf16_t* kr0 = kidx + ((size_t)b * TS + wid * 16 + fr) * 64 + fq * 8; nb0 = *(const bf16x8*)kr0; nb1 = *(const bf16x8*)(kr0 + 32); }
#pragma unroll 1
            for (int kt = wid; kt < nkt; kt += 8) {
                const bf16x8 bk0 = nb0, bk1 = nb1;
                if (kt + 8 < nkt) { const bf16_t* krn = kidx + ((size_t)b * TS + (kt + 8) * 16 + fr) * 64 + fq * 8; nb0 = *(const bf16x8*)krn; nb1 = *(const bf16x8*)(krn + 32); }
                float I[4] = {0.f, 0.f, 0.f, 0.f};
#pragma unroll
                for (int h = 0; h < 8; ++h) {
                    f32x4 a = __builtin_amdgcn_mfma_f32_16x16x32_bf16(aq[h][0], bk0, z4, 0, 0, 0);
                    a = __builtin_amdgcn_mfma_f32_16x16x32_bf16(aq[h][1], bk1, a, 0, 0, 0);
#pragma unroll
                    for (int j = 0; j < 4; ++j) I[j] += wh[j][h] * fmaxf(a[j], 0.f);
                }
#pragma unroll
                for (int j = 0; j < 4; ++j) s_sc[(fq * 4 + j) * 2064 + kt * 16 + fr] = (unsigned short)f2h_bits(I[j]);
            }
        }
        __syncthreads();
#pragma unroll 1
        for (int qi2 = 0; qi2 < 2; ++qi2) {
            const int q = wid + qi2 * 8;
            const int nadm = t0 + q + 1;
            unsigned short* sel = s_sel + q * 256;
            if (IMPORT_SEL) {
                const int ns = gnsel[n0 + q];
                for (int i = lane; i < ns; i += 64) sel[i] = gsel[(n0 + q) * 256 + i];
                if (lane == 0) s_nsel[q] = ns;
            } else if (nadm <= 256) {
                for (int i = lane; i < nadm; i += 64) sel[i] = (unsigned short)i;
                if (lane == 0) s_nsel[q] = nadm;
            } else {
                auto topk = [&](auto nch_tag) {
                    constexpr int NCH = decltype(nch_tag)::value;
                    unsigned key[NCH];
    #pragma unroll
                    for (int c = 0; c < NCH; ++c) {
                        const int s = c * 64 + lane;
                        unsigned k = 0u;
                        if (s < nadm) { const unsigned u = s_sc[q * 2064 + s]; k = (u & 0x8000u) ? (~u & 0xFFFFu) : (u | 0x8000u); }
                        key[c] = k;
                    }
                    unsigned T = 0u;
    #pragma unroll 1
                    for (int bit = 15; bit >= 0; --bit) {
                        const unsigned cand = T | (1u << bit);
                        int cnt = 0;
    #pragma unroll
                        for (int c = 0; c < NCH; ++c) cnt += __popcll(__ballot(key[c] >= cand));
                        if (cnt >= 256) T = cand;
                    }
                    int ngt = 0;
    #pragma unroll
                    for (int c = 0; c < NCH; ++c) ngt += __popcll(__ballot(key[c] > T));
                    const int rties = 256 - ngt;
                    int base = 0, ties = 0;
                    const unsigned long long ltmask = (1ull << lane) - 1ull;
    #pragma unroll
                    for (int c = 0; c < NCH; ++c) {
                        const bool gt = key[c] > T, eq = key[c] == T;
                        const unsigned long long em = __ballot(eq);
                        const int myrank = ties + __popcll(em & ltmask);
                        const bool take = gt || (eq && myrank < rties);
                        const unsigned long long tm = __ballot(take);
                        const int pos = base + __popcll(tm & ltmask);
                        if (take && pos < 256) sel[pos] = (unsigned short)(c * 64 + lane);
                        base += __popcll(tm); ties += __popcll(em);
                    }

                };
                if (nadm <= 512) topk(std::integral_constant<int, 8>{});
                else if (nadm <= 1024) topk(std::integral_constant<int, 16>{});
                else if (nadm <= 1536) topk(std::integral_constant<int, 24>{});
                else topk(std::integral_constant<int, 33>{});
                if (lane == 0) s_nsel[q] = 256;
            }
        }
        __syncthreads();
#pragma unroll 1
        for (int hi = 0; hi < 2; ++hi) {
            const int hh = wid * 2 + hi;
            bf16x8 acq[8];
#pragma unroll
            for (int kk = 0; kk < 8; ++kk) acq[kk] = *(const bf16x8*)(cqn + (n0 + fr) * 256 + kk * 32 + fq * 8);
            f32x4 c6[6] = {z4, z4, z4, z4, z4, z4};
#pragma unroll
            for (int kb = 0; kb < 8; kb += 4) {
                bf16x8 bf[4][6];
#pragma unroll
                for (int k4 = 0; k4 < 4; ++k4)
#pragma unroll
                    for (int nt = 0; nt < 6; ++nt) bf[k4][nt] = *(const bf16x8*)(wuqT + (size_t)(hh * 96 + nt * 16 + fr) * 256 + (kb + k4) * 32 + fq * 8);
#pragma unroll
                for (int k4 = 0; k4 < 4; ++k4)
#pragma unroll
                    for (int nt = 0; nt < 6; ++nt) c6[nt] = __builtin_amdgcn_mfma_f32_16x16x32_bf16(acq[kb + k4], bf[k4][nt], c6[nt], 0, 0, 0);
            }
#pragma unroll
            for (int j = 0; j < 4; ++j) {
                const int q = fq * 4 + j, t = t0 + q;
                const float cs = ctab[t * 16 + fr], sn = stab[t * 16 + fr];
                const float x1 = c6[4][j], x2 = c6[5][j];
                s_Q[(q * 16 + hh) * 160 + 128 + fr] = f2bf(x1 * cs - x2 * sn);
                s_Q[(q * 16 + hh) * 160 + 144 + fr] = f2bf(x2 * cs + x1 * sn);
#pragma unroll
                for (int nt = 0; nt < 4; ++nt) s_qn[q * 64 + nt * 16 + fr] = f2bf(c6[nt][j]);
            }
            __syncthreads();
            bf16x8 an[2];
#pragma unroll
            for (int ks = 0; ks < 2; ++ks) an[ks] = *(const bf16x8*)(s_qn + fr * 64 + ks * 32 + fq * 8);
            bf16x8 bwk[8][2];
#pragma unroll
            for (int nt = 0; nt < 8; ++nt)
#pragma unroll
                for (int ks = 0; ks < 2; ++ks) bwk[nt][ks] = *(const bf16x8*)(wuk + (size_t)(hh * 128 + nt * 16 + fr) * 64 + ks * 32 + fq * 8);
#pragma unroll
            for (int nt = 0; nt < 8; ++nt) {
                f32x4 a = z4;
#pragma unroll
                for (int ks = 0; ks < 2; ++ks)
                    a = __builtin_amdgcn_mfma_f32_16x16x32_bf16(an[ks], bwk[nt][ks], a, 0, 0, 0);
#pragma unroll
                for (int j = 0; j < 4; ++j) s_Q[((fq * 4 + j) * 16 + hh) * 160 + nt * 16 + fr] = f2bf(a[j]);
            }
            __syncthreads();
        }
#pragma unroll 1
        for (int qi2 = 0; qi2 < 2; ++qi2) {
            const int q = wid + qi2 * 8;
            bf16x8 bq[5];
#pragma unroll
            for (int ks = 0; ks < 5; ++ks) bq[ks] = *(const bf16x8*)(s_Q + (q * 16 + fr) * 160 + ks * 32 + fq * 8);
            const int nsel = s_nsel[q];
            const unsigned short* sel = s_sel + q * 256;
            float m = -INFINITY, lsum = 0.f;
            f32x4 O[8] = {z4, z4, z4, z4, z4, z4, z4, z4};
            const int nchunk = (nsel + 31) >> 5;
            bf16x8 akn[2][5];
#pragma unroll
            for (int mt = 0; mt < 2; ++mt) {
                const int ki = mt * 16 + fr;
                const int sidx = sel[ki < nsel ? ki : 0];
                const bf16_t* krow = kv + ((size_t)b * TS + sidx) * 160 + fq * 8;
#pragma unroll
                for (int ks = 0; ks < 5; ++ks) akn[mt][ks] = *(const bf16x8*)(krow + ks * 32);
            }
#pragma unroll 1
            for (int ch = 0; ch < nchunk; ++ch) {
                bf16x8 ak[2][5];
#pragma unroll
                for (int mt = 0; mt < 2; ++mt)
#pragma unroll
                    for (int ks = 0; ks < 5; ++ks) ak[mt][ks] = akn[mt][ks];
                if (ch + 1 < nchunk) {
#pragma unroll
                    for (int mt = 0; mt < 2; ++mt) {
                        const int ki = (ch + 1) * 32 + mt * 16 + fr;
                        const int sidx = sel[ki < nsel ? ki : 0];
                        const bf16_t* krow = kv + ((size_t)b * TS + sidx) * 160 + fq * 8;
#pragma unroll
                        for (int ks = 0; ks < 5; ++ks) akn[mt][ks] = *(const bf16x8*)(krow + ks * 32);
                    }
                }
#pragma unroll
                for (int mt = 0; mt < 2; ++mt)
#pragma unroll
                    for (int ks = 0; ks < 4; ++ks) {
                        const int r = mt * 16 + fr;
                        *(bf16x8*)(s_Vw + r * 256 + (((ks * 2 + (fq >> 1)) ^ (r & 7)) * 32) + (fq & 1) * 16) = ak[mt][ks];
                    }
                f32x4 st[2] = {z4, z4};
#pragma unroll
                for (int mt = 0; mt < 2; ++mt)
#pragma unroll
                    for (int ks = 0; ks < 5; ++ks) st[mt] = __builtin_amdgcn_mfma_f32_16x16x32_bf16(ak[mt][ks], bq[ks], st[mt], 0, 0, 0);
                float sv[2][4]; float cmax = -INFINITY;
#pragma unroll
                for (int mt = 0; mt < 2; ++mt)
#pragma unroll
                    for (int j = 0; j < 4; ++j) {
                        const int ke = ch * 32 + mt * 16 + fq * 4 + j;
                        const float s_ = (ke < nsel) ? st[mt][j] * scale : -INFINITY;
                        sv[mt][j] = s_; cmax = fmaxf(cmax, s_);
                    }
                cmax = fmaxf(cmax, __shfl_xor(cmax, 16)); cmax = fmaxf(cmax, __shfl_xor(cmax, 32));
                const float mnew = fmaxf(m, cmax);
                const float alpha = __expf(m - mnew);
                float psum = 0.f;
#pragma unroll
                for (int mt = 0; mt < 2; ++mt)
#pragma unroll
                    for (int j = 0; j < 4; ++j) { const float pe = __expf(sv[mt][j] - mnew); sv[mt][j] = pe; psum += pe; }
                psum += __shfl_xor(psum, 16); psum += __shfl_xor(psum, 32);
                lsum = lsum * alpha + psum; m = mnew;
#pragma unroll
                for (int ct = 0; ct < 8; ++ct) O[ct] = O[ct] * alpha;
                bf16x8 pf;
#pragma unroll
                for (int mt = 0; mt < 2; ++mt)
#pragma unroll
                    for (int j = 0; j < 4; ++j) pf[mt * 4 + j] = (short)f2bf(sv[mt][j]);
                const int q_ = fr >> 2, p_ = fr & 3;
                const int r0 = fq * 4 + q_, r1 = 16 + r0;
#pragma unroll
                for (int ct = 0; ct < 8; ++ct) {
                    const s16x4 v0 = __builtin_amdgcn_ds_read_tr16_b64_v4i16((__attribute__((address_space(3))) s16x4*)(s_Vw + r0 * 256 + ((ct ^ (r0 & 7)) * 32) + p_ * 8));
                    const s16x4 v1 = __builtin_amdgcn_ds_read_tr16_b64_v4i16((__attribute__((address_space(3))) s16x4*)(s_Vw + r1 * 256 + ((ct ^ (r1 & 7)) * 32) + p_ * 8));
                    bf16x8 av; av[0] = v0[0]; av[1] = v0[1]; av[2] = v0[2]; av[3] = v0[3]; av[4] = v1[0]; av[5] = v1[1]; av[6] = v1[2]; av[7] = v1[3];
                    O[ct] = __builtin_amdgcn_mfma_f32_16x16x32_bf16(av, pf, O[ct], 0, 0, 0);
                }
            }
            const float inv = 1.0f / lsum;
#pragma unroll
            for (int ct = 0; ct < 8; ++ct)
#pragma unroll
                for (int j = 0; j < 4; ++j) s_Q[(q * 16 + fr) * 160 + ct * 16 + fq * 4 + j] = f2bf(O[ct][j] * inv);
        }
        __syncthreads();
#pragma unroll 1
        for (int hi = 0; hi < 2; ++hi) {
            const int hh = wid * 2 + hi;
            bf16x8 ao[4];
#pragma unroll
            for (int ks = 0; ks < 4; ++ks) ao[ks] = *(const bf16x8*)(s_Q + (fr * 16 + hh) * 160 + ks * 32 + fq * 8);
#pragma unroll
            for (int nt = 0; nt < 4; ++nt) {
                f32x4 a = z4;
#pragma unroll
                for (int ks = 0; ks < 4; ++ks)
                    a = __builtin_amdgcn_mfma_f32_16x16x32_bf16(ao[ks], *(const bf16x8*)(wuvT + (size_t)(hh * 64 + nt * 16 + fr) * 128 + ks * 32 + fq * 8), a, 0, 0, 0);
#pragma unroll
                for (int j = 0; j < 4; ++j) yc[(n0 + fq * 4 + j) * 1024 + hh * 64 + nt * 16 + fr] = f2bf(a[j]);
            }
        }
        __syncthreads();
    }
}


__device__ void phase_lr_prep(const Params& p, int l) {
    const int lane = otid() & 63;
    const int wave = (obid() * NTHR + otid()) >> 6, nw = gridDim.x * NTHR / 64;
    const bf16_t* pm = (const bf16_t*)(WS(p) + OFF_PMISC);
    bf16_t* alr = (bf16_t*)(OUTB(p) + DO_ALR);
    const float* mu = p.in[4] + (size_t)l * 3328 + 3072;
    const float* vmu = p.in[18];
    for (int n = wave; n < NT; n += nw) {
        const int t = n % TS;
        for (int c = lane; c < 288; c += 64) {
            const float cur = bf2f(pm[(size_t)n * PM_LD + c]);
            const float prv = (t > 0) ? bf2f(pm[(size_t)(n - 1) * PM_LD + c]) : 0.f;
            const float m_ = (c < 256) ? mu[c] : vmu[c - 256];
            float xs = cur + (prv - cur) * m_;
            if (c < 64) xs = tanhf(xs);
            else if (c >= 128 && c < 256) xs = sigmoidf_(xs);
            alr[(size_t)n * 288 + c] = f2bf(xs);
        }
    }
}

template <int CTRL> __device__ __forceinline__ float dpp_f(float x) {
    return __int_as_float(__builtin_amdgcn_update_dpp(0, __float_as_int(x), CTRL, 0xF, 0xF, true));
}
__device__ __forceinline__ float row16_sum(float v) {
    v += dpp_f<0xB1>(v);
    v += dpp_f<0x4E>(v);
    v += dpp_f<0x141>(v);
    v += dpp_f<0x140>(v);
    return v;
}
__device__ __forceinline__ void lds_barrier() { asm volatile("s_waitcnt lgkmcnt(0)" ::: "memory"); __builtin_amdgcn_s_barrier(); asm volatile("" ::: "memory"); }
__device__ __forceinline__ float fast_rcp(float x) { return __builtin_amdgcn_rcpf(x); }
__device__ __forceinline__ float fast_sigmoid(float x) { return fast_rcp(1.0f + __expf(-x)); }
__device__ __forceinline__ float fast_tanh(float x) { return 1.0f - 2.0f * fast_rcp(1.0f + __expf(2.0f * x)); }
__device__ __forceinline__ void row16_sum4(float& a, float& b, float& c, float& d) {
    asm volatile(
        "s_nop 1\n\t"
        "v_add_f32_dpp %0, %0, %0 quad_perm:[1,0,3,2] row_mask:0xf bank_mask:0xf\n\t"
        "v_add_f32_dpp %1, %1, %1 quad_perm:[1,0,3,2] row_mask:0xf bank_mask:0xf\n\t"
        "v_add_f32_dpp %2, %2, %2 quad_perm:[1,0,3,2] row_mask:0xf bank_mask:0xf\n\t"
        "v_add_f32_dpp %3, %3, %3 quad_perm:[1,0,3,2] row_mask:0xf bank_mask:0xf\n\t"
        "v_add_f32_dpp %0, %0, %0 quad_perm:[2,3,0,1] row_mask:0xf bank_mask:0xf\n\t"
        "v_add_f32_dpp %1, %1, %1 quad_perm:[2,3,0,1] row_mask:0xf bank_mask:0xf\n\t"
        "v_add_f32_dpp %2, %2, %2 quad_perm:[2,3,0,1] row_mask:0xf bank_mask:0xf\n\t"
        "v_add_f32_dpp %3, %3, %3 quad_perm:[2,3,0,1] row_mask:0xf bank_mask:0xf\n\t"
        "v_add_f32_dpp %0, %0, %0 row_half_mirror row_mask:0xf bank_mask:0xf\n\t"
        "v_add_f32_dpp %1, %1, %1 row_half_mirror row_mask:0xf bank_mask:0xf\n\t"
        "v_add_f32_dpp %2, %2, %2 row_half_mirror row_mask:0xf bank_mask:0xf\n\t"
        "v_add_f32_dpp %3, %3, %3 row_half_mirror row_mask:0xf bank_mask:0xf\n\t"
        "v_add_f32_dpp %0, %0, %0 row_mirror row_mask:0xf bank_mask:0xf\n\t"
        "v_add_f32_dpp %1, %1, %1 row_mirror row_mask:0xf bank_mask:0xf\n\t"
        "v_add_f32_dpp %2, %2, %2 row_mirror row_mask:0xf bank_mask:0xf\n\t"
        "v_add_f32_dpp %3, %3, %3 row_mirror row_mask:0xf bank_mask:0xf\n\t"
        "s_nop 1"
        : "+v"(a), "+v"(b), "+v"(c), "+v"(d));
}
__device__ __forceinline__ void row8_sum2(float& a, float& b) {
    asm volatile(
        "s_nop 1\n\t"
        "v_add_f32_dpp %0, %0, %0 quad_perm:[1,0,3,2] row_mask:0xf bank_mask:0xf\n\t"
        "v_add_f32_dpp %1, %1, %1 quad_perm:[1,0,3,2] row_mask:0xf bank_mask:0xf\n\t"
        "s_nop 0\n\t"
        "v_add_f32_dpp %0, %0, %0 quad_perm:[2,3,0,1] row_mask:0xf bank_mask:0xf\n\t"
        "v_add_f32_dpp %1, %1, %1 quad_perm:[2,3,0,1] row_mask:0xf bank_mask:0xf\n\t"
        "s_nop 0\n\t"
        "v_add_f32_dpp %0, %0, %0 row_half_mirror row_mask:0xf bank_mask:0xf\n\t"
        "v_add_f32_dpp %1, %1, %1 row_half_mirror row_mask:0xf bank_mask:0xf\n\t"
        "s_nop 1"
        : "+v"(a), "+v"(b));
}
__device__ __forceinline__ float wave_sum_fast(float v) { v = row16_sum(v); v += __shfl_xor(v, 16); v += __shfl_xor(v, 32); return v; }
constexpr int SC_TC = 32;
constexpr int SC_ROWB = 1088;
__device__ __forceinline__ const unsigned char* scan_piece_src(const Params& p, int l, int b, int hc, int t0, int pi, bool& ok) {
    const int tau = pi / 68, seg = pi - tau * 68;
    const int t = t0 + tau;
    ok = (t < TS) && (tau < SC_TC);
    const size_t n = (size_t)b * TS + t;
    const unsigned char* ws = WS(p);
    if (seg < 8) return ws + OFF_PR + (n * 1024 + hc) * 2 + seg * 16;
    if (seg < 16) return ws + OFF_PK + (n * 1024 + hc) * 2 + (seg - 8) * 16;
    if (seg < 24) return ws + OFF_PV + (n * 1024 + hc) * 2 + (seg - 16) * 16;
    if (seg < 60) return OUTB(p) + DO_ALR + (n * 288) * 2 + (seg - 24) * 16;
    ok = ok && (l > 0);
    return ws + OFF_VFIRST + (n * 1024 + hc) * 2 + (seg - 60) * 16;
}
__device__ void phase_scan5(const Params& p, int l, unsigned char* lds, int blk) {
    const int tid = otid(), lane = tid & 63, wid = tid >> 6, fr = lane & 15, fq = lane >> 4;
    const int b = blk >> 4, hh = blk & 15, hc = hh * 64;
    float* s_r = (float*)lds;
    float* s_w = s_r + 2048;
    float* s_k = s_w + 2048;
    float* s_v = s_k + 2048;
    float* s_a = s_v + 2048;
    float* s_b = s_a + 2048;
    float* s_g = s_b + 2048;
    float* s_o = s_g + 2048;
    bf16_t* A_wd = (bf16_t*)(s_o + 2048);
    bf16_t* A_ad = A_wd + 2048;
    bf16_t* A_gd = A_ad + 2048;
    bf16_t* A_vd = A_gd + 4096;
    unsigned char* raw = (unsigned char*)(A_vd + 1024);
    float* prevb = (float*)(raw + 32 * SC_ROWB);
    float* cst = prevb + 960;
    const float* mu = p.in[4] + (size_t)l * 3328;
    for (int e = tid; e < 480; e += NTHR) {
        float v;
        if (e < 192) v = mu[(e >> 6) * 1024 + hc + (e & 63)];
        else if (e < 448) v = mu[3072 + (e - 192)];
        else v = p.in[18][e - 448];
        cst[e] = v;
    }
    if (tid < 64) {
        cst[480 + tid] = p.in[7][l * 1024 + hc + tid];
        cst[544 + tid] = p.in[9][l * 1024 + hc + tid];
        cst[608 + tid] = p.in[12][l * 1024 + hc + tid];
        cst[672 + tid] = p.in[13][l * 1024 + hc + tid];
        cst[736 + tid] = p.in[14][l * 1024 + hc + tid];
        cst[800 + tid] = p.in[15][l * 1024 + hc + tid];
        cst[864 + tid] = p.in[16][l * 1024 + hc + tid];
        cst[928 + tid] = p.in[19][hc + tid];
    }
    const int mm = wid >> 1, ntb = (wid & 1) * 2;
    const int nks = (mm == 2) ? 4 : (mm == 3 ? 1 : 2);
    bf16x8 Bw[2][4];
    {
        const float* wsrc = (mm == 0) ? p.in[8] + (size_t)l * 64 * 1024 : (mm == 1) ? p.in[10] + (size_t)l * 64 * 1024 : (mm == 2) ? p.in[11] + (size_t)l * 128 * 1024 : p.in[20];
#pragma unroll
        for (int n2 = 0; n2 < 2; ++n2)
#pragma unroll
            for (int ks = 0; ks < 4; ++ks) {
                bf16x8 f;
#pragma unroll
                for (int j = 0; j < 8; ++j) {
                    const bool okw = ks < nks && (mm < 3 || l > 0);
                    const float v = wsrc[(size_t)(okw ? (ks * 32 + fq * 8 + j) : 0) * 1024 + hc + (ntb + n2) * 16 + fr];
                    f[j] = (short)f2bf(okw ? v : 0.f);
                }
                Bw[n2][ks] = f;
            }
    }
    const int cg = lane & 15, rg = lane >> 4;
    float S[8] = {0.f, 0.f, 0.f, 0.f, 0.f, 0.f, 0.f, 0.f};
    bf16_t* Pr = (bf16_t*)(WS(p) + OFF_PR);
    bf16_t* vfirst = (bf16_t*)(WS(p) + OFF_VFIRST);
    const unsigned char* psrc[5]; int pstep[5], ptau[5]; bool pval[5];
#pragma unroll
    for (int k = 0; k < 5; ++k) {
        const int pi = tid + k * NTHR;
        bool ok = false;
        psrc[k] = scan_piece_src(p, l, b, hc, 0, pi < SC_TC * 68 ? pi : 0, ok);
        const int tau = (pi < SC_TC * 68 ? pi : 0) / 68, seg = (pi < SC_TC * 68 ? pi : 0) - tau * 68;
        ptau[k] = tau;
        pstep[k] = SC_TC * ((seg >= 24 && seg < 60) ? 576 : 2048);
        pval[k] = (pi < SC_TC * 68) && !(seg >= 60 && l == 0);
    }
    uint4 pre[5];
#pragma unroll
    for (int k = 0; k < 5; ++k) { pre[k] = make_uint4(0, 0, 0, 0); if (pval[k] && ptau[k] < TS) pre[k] = *(const uint4*)psrc[k]; }
    __syncthreads();
#pragma unroll 1
    for (int t0 = 0, ch = 0; t0 < TS; t0 += SC_TC, ++ch) {
        const int nval = (TS - t0 < SC_TC) ? (TS - t0) : SC_TC;
#pragma unroll
        for (int k = 0; k < 5; ++k) { const int pi = tid + k * NTHR; if (pi < SC_TC * 68) *(uint4*)(raw + pi * 16) = pre[k]; }
        lds_barrier();
#pragma unroll
        for (int k = 0; k < 5; ++k) {
            pre[k] = make_uint4(0, 0, 0, 0);
            if (pval[k] && t0 + SC_TC + ptau[k] < TS) pre[k] = *(const uint4*)(psrc[k] + (size_t)(ch + 1) * pstep[k]);
        }
        {
            float* pwb = prevb + (ch & 1) * 192;
            const float* pvb = prevb + ((ch + 1) & 1) * 192;
            for (int it = tid; it < SC_TC * 96; it += NTHR) {
                const int tau = it / 96, c2 = (it - tau * 96) * 2;
                const unsigned cu = *(const unsigned*)(raw + tau * SC_ROWB + c2 * 2);
                const float c0 = __uint_as_float(cu << 16), c1 = __uint_as_float(cu & 0xFFFF0000u);
                float p0, p1;
                if (tau > 0) { const unsigned pu = *(const unsigned*)(raw + (tau - 1) * SC_ROWB + c2 * 2); p0 = __uint_as_float(pu << 16); p1 = __uint_as_float(pu & 0xFFFF0000u); }
                else if (t0 > 0) { p0 = pvb[c2]; p1 = pvb[c2 + 1]; }
                else { p0 = 0.f; p1 = 0.f; }
                if (tau == SC_TC - 1) { pwb[c2] = c0; pwb[c2 + 1] = c1; }
                const float x0 = c0 + (p0 - c0) * cst[c2], x1 = c1 + (p1 - c1) * cst[c2 + 1];
                float* dstv = (c2 < 64) ? (s_r + tau * 64 + c2) : (c2 < 128) ? (s_k + tau * 64 + c2 - 64) : (s_v + tau * 64 + c2 - 128);
                *(float2*)dstv = make_float2(x0, x1);
            }
        }
        if (mm < 3 || l > 0) {
            const unsigned char* Ab = raw + ((mm == 0) ? 384 : (mm == 1) ? 512 : (mm == 2) ? 640 : 896);
            float* dst = (mm == 0) ? s_w : (mm == 1) ? s_a : (mm == 2) ? s_g : s_o;
#pragma unroll
            for (int m = 0; m < 2; ++m) {
                f32x4 acc0 = {0.f, 0.f, 0.f, 0.f}, acc1 = {0.f, 0.f, 0.f, 0.f};
#pragma unroll
                for (int ks = 0; ks < 4; ++ks) {
                    if (ks < nks) {
                        const bf16x8 a = *(const bf16x8*)(Ab + (m * 16 + fr) * SC_ROWB + ks * 64 + fq * 16);
                        acc0 = __builtin_amdgcn_mfma_f32_16x16x32_bf16(a, Bw[0][ks], acc0, 0, 0, 0);
                        acc1 = __builtin_amdgcn_mfma_f32_16x16x32_bf16(a, Bw[1][ks], acc1, 0, 0, 0);
                    }
                }
#pragma unroll
                for (int j = 0; j < 4; ++j) {
                    dst[(m * 16 + fq * 4 + j) * 64 + ntb * 16 + fr] = acc0[j];
                    dst[(m * 16 + fq * 4 + j) * 64 + (ntb + 1) * 16 + fr] = acc1[j];
                }
            }
        }
        lds_barrier();
        {
            const int tau = tid >> 4, c4 = (tid & 15) * 4, e = tau * 64 + c4, t = t0 + tau;
            const size_t n = (size_t)b * TS + t;
            const float4 xw4 = *(const float4*)(s_w + e), xa4 = *(const float4*)(s_a + e), kr4 = *(const float4*)(s_k + e);
            float4 vv4 = *(const float4*)(s_v + e);
            const float4 cw = *(const float4*)(cst + 480 + c4), ca = *(const float4*)(cst + 544 + c4), ckk = *(const float4*)(cst + 608 + c4), cka = *(const float4*)(cst + 672 + c4);
            const float xw[4] = {xw4.x + cw.x, xw4.y + cw.y, xw4.z + cw.z, xw4.w + cw.w};
            const float xa[4] = {xa4.x + ca.x, xa4.y + ca.y, xa4.z + ca.z, xa4.w + ca.w};
            const float kr[4] = {kr4.x, kr4.y, kr4.z, kr4.w};
            const float kkc[4] = {ckk.x, ckk.y, ckk.z, ckk.w}, kac[4] = {cka.x, cka.y, cka.z, cka.w};
            float vv[4] = {vv4.x, vv4.y, vv4.z, vv4.w};
            if (l > 0) {
                const float4 xv4 = *(const float4*)(s_o + e), cv = *(const float4*)(cst + 928 + c4);
                const uint2 vfu = *(const uint2*)(raw + tau * SC_ROWB + 960 + c4 * 2);
                const float vf[4] = {__uint_as_float(vfu.x << 16), __uint_as_float(vfu.x & 0xFFFF0000u), __uint_as_float(vfu.y << 16), __uint_as_float(vfu.y & 0xFFFF0000u)};
                const float xv[4] = {xv4.x + cv.x, xv4.y + cv.y, xv4.z + cv.z, xv4.w + cv.w};
#pragma unroll
                for (int j = 0; j < 4; ++j) vv[j] = vv[j] + (vf[j] - vv[j]) * fast_sigmoid(xv[j]);
            } else if (t < TS) {
                *(uint2*)(vfirst + n * 1024 + hc + c4) = pack4(vv[0], vv[1], vv[2], vv[3]);
            }
            float dec[4], av[4], kkv[4]; float ss = 0.f;
#pragma unroll
            for (int j = 0; j < 4; ++j) {
                dec[j] = __expf(-0.6065306597126334f * fast_sigmoid(xw[j]));
                av[j] = fast_sigmoid(xa[j]);
                kkv[j] = kr[j] * kkc[j];
                ss += kkv[j] * kkv[j];
            }
            ss = row16_sum(ss);
            const float rn = rsqrtf(fmaxf(ss, 1e-24f));
            float kk[4];
#pragma unroll
            for (int j = 0; j < 4; ++j) kk[j] = kkv[j] * rn;
            *(float4*)(s_w + e) = make_float4(dec[0], dec[1], dec[2], dec[3]);
            *(float4*)(s_a + e) = make_float4(-kk[0], -kk[1], -kk[2], -kk[3]);
            *(float4*)(s_b + e) = make_float4(kk[0] * av[0], kk[1] * av[1], kk[2] * av[2], kk[3] * av[3]);
            *(float4*)(s_k + e) = make_float4(kr[0] * (1.0f + (av[0] - 1.0f) * kac[0]), kr[1] * (1.0f + (av[1] - 1.0f) * kac[1]), kr[2] * (1.0f + (av[2] - 1.0f) * kac[2]), kr[3] * (1.0f + (av[3] - 1.0f) * kac[3]));
            *(float4*)(s_v + e) = make_float4(vv[0], vv[1], vv[2], vv[3]);
        }
        lds_barrier();
        {
            struct VS { float4 w0, w1, b0, b1, k0, k1, r0, r1, a0, a1; float v; };
            VS X, Y;
            const int i_ = tid >> 3, c8 = (tid & 7) * 8;
            auto ld = [&](VS& N, int tn, int tn2) {
                N.a0 = *(const float4*)(s_a + tn2 * 64 + c8); N.a1 = *(const float4*)(s_a + tn2 * 64 + c8 + 4);
                N.w0 = *(const float4*)(s_w + tn * 64 + c8); N.w1 = *(const float4*)(s_w + tn * 64 + c8 + 4);
                N.b0 = *(const float4*)(s_b + tn * 64 + c8); N.b1 = *(const float4*)(s_b + tn * 64 + c8 + 4);
                N.k0 = *(const float4*)(s_k + tn * 64 + c8); N.k1 = *(const float4*)(s_k + tn * 64 + c8 + 4);
                N.r0 = *(const float4*)(s_r + tn * 64 + c8); N.r1 = *(const float4*)(s_r + tn * 64 + c8 + 4);
                N.v = s_v[tn * 64 + i_];
            };
            float sa;
            {
                const float4 a0 = *(const float4*)(s_a + c8), a1 = *(const float4*)(s_a + c8 + 4);
                sa = S[0] * a0.x + S[1] * a0.y + S[2] * a0.z + S[3] * a0.w + S[4] * a1.x + S[5] * a1.y + S[6] * a1.z + S[7] * a1.w;
                float du = 0.f;
                row8_sum2(sa, du);
            }
            ld(X, 0, 1);
            auto step = [&](VS& C, VS& N, int tau) {
                const int tn = (tau + 1 < SC_TC) ? tau + 1 : tau, tn2 = (tau + 2 < SC_TC) ? tau + 2 : tau;
                ld(N, tn, tn2);
                const float vi = C.v;
                S[0] = S[0] * C.w0.x + (sa * C.b0.x + vi * C.k0.x); S[1] = S[1] * C.w0.y + (sa * C.b0.y + vi * C.k0.y);
                S[2] = S[2] * C.w0.z + (sa * C.b0.z + vi * C.k0.z); S[3] = S[3] * C.w0.w + (sa * C.b0.w + vi * C.k0.w);
                S[4] = S[4] * C.w1.x + (sa * C.b1.x + vi * C.k1.x); S[5] = S[5] * C.w1.y + (sa * C.b1.y + vi * C.k1.y);
                S[6] = S[6] * C.w1.z + (sa * C.b1.z + vi * C.k1.z); S[7] = S[7] * C.w1.w + (sa * C.b1.w + vi * C.k1.w);
                float o = S[0] * C.r0.x + S[1] * C.r0.y + S[2] * C.r0.z + S[3] * C.r0.w + S[4] * C.r1.x + S[5] * C.r1.y + S[6] * C.r1.z + S[7] * C.r1.w;
                sa = S[0] * C.a0.x + S[1] * C.a0.y + S[2] * C.a0.z + S[3] * C.a0.w + S[4] * C.a1.x + S[5] * C.a1.y + S[6] * C.a1.z + S[7] * C.a1.w;
                row8_sum2(sa, o);
                if ((tid & 7) == 0) s_o[tau * 64 + i_] = o;
            };
#pragma unroll 1
            for (int tau = 0; tau < nval; tau += 2) { step(X, Y, tau); step(Y, X, tau + 1); }
        }
        lds_barrier();
        {
            const int tau = tid >> 4, c4 = (tid & 15) * 4, e = tau * 64 + c4;
            const size_t n = (size_t)b * TS + t0 + tau;
            const float4 o4 = *(const float4*)(s_o + e), r4_ = *(const float4*)(s_r + e), k4_ = *(const float4*)(s_k + e), v4_ = *(const float4*)(s_v + e), g4_ = *(const float4*)(s_g + e);
            const float4 crk = *(const float4*)(cst + 736 + c4), clw = *(const float4*)(cst + 800 + c4), clb = *(const float4*)(cst + 864 + c4);
            float osum = (o4.x + o4.y) + (o4.z + o4.w);
            float bsum = r4_.x * k4_.x * crk.x + r4_.y * k4_.y * crk.y + r4_.z * k4_.z * crk.z + r4_.w * k4_.w * crk.w;
            float du0 = 0.f, du1 = 0.f;
            row16_sum4(osum, bsum, du0, du1);
            const float m_ = osum * (1.0f / 64.0f);
            const float d0 = o4.x - m_, d1 = o4.y - m_, d2 = o4.z - m_, d3 = o4.w - m_;
            const float var = row16_sum(d0 * d0 + d1 * d1 + d2 * d2 + d3 * d3) * (1.0f / 64.0f);
            const float rs = rsqrtf(var + 64e-5f);
            const float y0 = (d0 * rs * clw.x + clb.x + bsum * v4_.x) * g4_.x, y1 = (d1 * rs * clw.y + clb.y + bsum * v4_.y) * g4_.y;
            const float y2 = (d2 * rs * clw.z + clb.z + bsum * v4_.z) * g4_.z, y3 = (d3 * rs * clw.w + clb.w + bsum * v4_.w) * g4_.w;
            if (tau < nval) *(uint2*)(Pr + n * 1024 + hc + c4) = pack4(y0, y1, y2, y3);
        }
    }
}

__device__ void phase_merge(const Params& p, unsigned char* lds) {
    const int tid = otid(), lane = tid & 63, wid = tid >> 6, wr = wid >> 1, wc = wid & 1, fr = lane & 15, fq = lane >> 4;
    const bf16_t* h = (const bf16_t*)(WS(p) + OFF_H);
    const bf16_t* wb = (const bf16_t*)(WS(p) + OFF_WB);
    const float* rstd = (const float*)(WS(p) + OFF_RSTD);
    bf16_t* merged = (bf16_t*)(WS(p) + OFF_MERGED);
    const bf16_t* ysrc0 = (const bf16_t*)(WS(p) + OFF_PPOOL);
    const bf16_t* ysrc1 = (const bf16_t*)(WS(p) + OFF_PR);
    const bf16_t* ysrc2 = (const bf16_t*)(OUTB(p) + DO_YC);
    for (int tile = obid(); tile < 86 * 8; tile += gridDim.x) {
        const int mt = tile >> 3, nt = tile & 7;
        const int row0 = mt * 192, col0 = nt * 128;
        uint2 maccp[3][4];
#pragma unroll
        for (int m = 0; m < 3; ++m)
#pragma unroll
            for (int n = 0; n < 4; ++n) maccp[m][n] = make_uint2(0u, 0u);
#pragma unroll 1
        for (int i = 0; i < 3; ++i) {
            const bf16_t* ys = (i == 0) ? ysrc0 : (i == 1 ? ysrc1 : ysrc2);
            uint2 sg[3][4];
            {
                f32x4 ag[3][4]; g3_zero<3>(ag);
                G3<192> g;
                g3_setup<192>(g, [&](int r) { return h + (size_t)(row0 + r) * DM; }, [&](int r) { return wb + WB_WG + (size_t)(i * 1024 + col0 + r) * DM; }, tid);
                g3_kloop<192>(ag, g, DM, lds);
#pragma unroll
                for (int m = 0; m < 3; ++m) {
                    const float rs = rstd[row0 + wr * 48 + m * 16 + fr];
#pragma unroll
                    for (int n = 0; n < 4; ++n) sg[m][n] = pack4(fast_sigmoid(ag[m][n][0] * rs), fast_sigmoid(ag[m][n][1] * rs), fast_sigmoid(ag[m][n][2] * rs), fast_sigmoid(ag[m][n][3] * rs));
                }
            }
            {
                f32x4 ay[3][4]; g3_zero<3>(ay);
                G3<192> g;
                g3_setup<192>(g, [&](int r) { return ys + (size_t)(row0 + r) * DM; }, [&](int r) { return wb + WB_PA + (size_t)(i * 1024 + col0 + r) * DM; }, tid);
                g3_kloop<192>(ay, g, DM, lds);
#pragma unroll
                for (int m = 0; m < 3; ++m)
#pragma unroll
                    for (int n = 0; n < 4; ++n) {
                        const float m0 = __uint_as_float(maccp[m][n].x << 16) + __uint_as_float(sg[m][n].x << 16) * ay[m][n][0];
                        const float m1 = __uint_as_float(maccp[m][n].x & 0xFFFF0000u) + __uint_as_float(sg[m][n].x & 0xFFFF0000u) * ay[m][n][1];
                        const float m2 = __uint_as_float(maccp[m][n].y << 16) + __uint_as_float(sg[m][n].y << 16) * ay[m][n][2];
                        const float m3 = __uint_as_float(maccp[m][n].y & 0xFFFF0000u) + __uint_as_float(sg[m][n].y & 0xFFFF0000u) * ay[m][n][3];
                        maccp[m][n] = pack4(m0, m1, m2, m3);
                    }
            }
        }
#pragma unroll
        for (int m = 0; m < 3; ++m) {
            const int row = row0 + wr * 48 + m * 16 + fr;
#pragma unroll
            for (int n = 0; n < 4; ++n)
                *(uint2*)(merged + (size_t)row * 1024 + col0 + wc * 64 + n * 16 + fq * 4) = maccp[m][n];
        }
    }
}

__device__ void phase_outproj(const Params& p, unsigned char* lds) {
    const int tid = otid(), lane = tid & 63, wid = tid >> 6, wr = wid >> 1, wc = wid & 1, fr = lane & 15, fq = lane >> 4;
    const bf16_t* h = (const bf16_t*)(WS(p) + OFF_H);
    const bf16_t* wb = (const bf16_t*)(WS(p) + OFF_WB);
    const bf16_t* merged = (const bf16_t*)(WS(p) + OFF_MERGED);
    float* hm = (float*)(WS(p) + OFF_HM32);
    for (int tile = obid(); tile < 86 * 8; tile += gridDim.x) {
        const int mt = tile >> 3, nt = tile & 7;
        const int row0 = mt * 192, col0 = nt * 128;
        G3<192> g;
        g3_setup<192>(g, [&](int r) { return merged + (size_t)(row0 + r) * DM; }, [&](int r) { return wb + WB_WO + (size_t)(col0 + r) * DM; }, tid);
        f32x4 acc[3][4]; g3_zero<3>(acc);
        g3_kloop<192>(acc, g, DM, lds);
#pragma unroll
        for (int m = 0; m < 3; ++m) {
            const int row = row0 + wr * 48 + m * 16 + fr;
#pragma unroll
            for (int n = 0; n < 4; ++n) {
                const int col = col0 + wc * 64 + n * 16 + fq * 4;
                const uint2 hv = *(const uint2*)(h + (size_t)row * 1024 + col);
                float4 o;
                o.x = __uint_as_float(hv.x << 16) + acc[m][n][0]; o.y = __uint_as_float(hv.x & 0xFFFF0000u) + acc[m][n][1];
                o.z = __uint_as_float(hv.y << 16) + acc[m][n][2]; o.w = __uint_as_float(hv.y & 0xFFFF0000u) + acc[m][n][3];
                *(float4*)(hm + (size_t)row * 1024 + col) = o;
            }
        }
    }
}

__device__ __constant__ int c_pair_lo[6] = {0, 0, 0, 1, 1, 2};
__device__ __constant__ int c_pair_hi[6] = {1, 2, 3, 2, 3, 3};
__device__ void phase_route(const Params& p, int l, unsigned char* lds) {
    const int tid = otid(), lane = tid & 63, wid = tid >> 6;
    const int per = (NT + (int)gridDim.x - 1) / (int)gridDim.x;
    const int nbeg = obid() * per, nend = (nbeg + per < NT) ? nbeg + per : NT;
    int* s_cls = (int*)lds;
    int* s_base = s_cls + 512;
    float* s_wr = (float*)(lds + 4096);
    const float* hm = (const float*)(WS(p) + OFF_HM32);
    bf16_t* hn = (bf16_t*)(WS(p) + OFF_HN);
    const float* nf = p.in[33] + (size_t)l * 1024;
    const float* wg = p.in[34] + (size_t)l * 1024 * 4;
    const float* bg = p.in[35] + l * 4;
    const float* we = p.in[36] + (size_t)l * 1024 * 16;
    const float* be = p.in[37] + l * 16;
    int* cnt = (int*)(WS(p) + OFF_CTL);
    int* list = (int*)(WS(p) + OFF_LIST);
    float* pw = (float*)(WS(p) + OFF_PW);
    for (int e = tid; e < 1024 * 20; e += NTHR) {
        const int k = e / 20, c = e - k * 20;
        s_wr[c * 1024 + k] = (c < 4) ? wg[(size_t)k * 4 + c] : we[(size_t)k * 16 + (c - 4)];
    }
    __syncthreads();
    for (int n = nbeg + wid; n < nend; n += 8) {
        float ss = 0.f;
#pragma unroll
        for (int i = 0; i < 4; ++i) {
            const float4 v = *(const float4*)(hm + (size_t)n * DM + i * 256 + lane * 4);
            ss += v.x * v.x + v.y * v.y + v.z * v.z + v.w * v.w;
        }
        ss = wave_sum(ss);
        const float rs = rsqrtf(ss * (1.0f / 1024.0f) + 1e-6f);
        float lg[4] = {0.f, 0.f, 0.f, 0.f};
        float le[16];
#pragma unroll
        for (int e = 0; e < 16; ++e) le[e] = 0.f;
#pragma unroll 1
        for (int i = 0; i < 4; ++i) {
            const float4 xv = *(const float4*)(hm + (size_t)n * DM + i * 256 + lane * 4);
            const float4 nv = *(const float4*)(nf + i * 256 + lane * 4);
            float y[4] = {xv.x * rs * nv.x, xv.y * rs * nv.y, xv.z * rs * nv.z, xv.w * rs * nv.w};
            {
                const int d0 = i * 256 + lane * 4;
#pragma unroll
                for (int g = 0; g < 4; ++g) { const float4 w4 = *(const float4*)(s_wr + g * 1024 + d0); lg[g] += y[0] * w4.x + y[1] * w4.y + y[2] * w4.z + y[3] * w4.w; }
#pragma unroll
                for (int e = 0; e < 16; ++e) { const float4 w4 = *(const float4*)(s_wr + (4 + e) * 1024 + d0); le[e] += y[0] * w4.x + y[1] * w4.y + y[2] * w4.z + y[3] * w4.w; }
            }
            ushort4 o;
            o.x = f2bf(y[0]); o.y = f2bf(y[1]); o.z = f2bf(y[2]); o.w = f2bf(y[3]);
            *(ushort4*)(hn + (size_t)n * DM + i * 256 + lane * 4) = o;
        }
#pragma unroll
        for (int g = 0; g < 4; ++g) lg[g] = wave_sum_fast(lg[g]) + bg[g];
#pragma unroll
        for (int e = 0; e < 16; ++e) le[e] = wave_sum_fast(le[e]) + be[e];
        if (lane == 0) {
            int gs = 0; float gm = lg[0];
#pragma unroll
            for (int g = 1; g < 4; ++g) if (lg[g] > gm) { gm = lg[g]; gs = g; }
            float den = 0.f;
#pragma unroll
            for (int g = 0; g < 4; ++g) den += __expf(lg[g] - gm);
            const float pgrp = 1.0f / den;
            float v4[4];
#pragma unroll
            for (int e = 0; e < 4; ++e) {
                const float m0 = (gs == 0) ? 1.f : 0.f, m1s = (gs == 1) ? 1.f : 0.f, m2s = (gs == 2) ? 1.f : 0.f, m3s = (gs == 3) ? 1.f : 0.f;
                v4[e] = le[e] * m0 + le[4 + e] * m1s + le[8 + e] * m2s + le[12 + e] * m3s;
            }
            int i1 = 0; float m1 = v4[0];
#pragma unroll
            for (int e = 1; e < 4; ++e) if (v4[e] > m1) { m1 = v4[e]; i1 = e; }
            int i2 = -1; float m2 = -INFINITY;
#pragma unroll
            for (int e = 0; e < 4; ++e) if (e != i1 && v4[e] > m2) { m2 = v4[e]; i2 = e; }
            const float e2 = __expf(m2 - m1);
            const float p1 = pgrp / (1.0f + e2), p2 = pgrp * e2 / (1.0f + e2);
            const int lo = i1 < i2 ? i1 : i2, hi = i1 < i2 ? i2 : i1;
            const float plo = i1 < i2 ? p1 : p2, phi = i1 < i2 ? p2 : p1;
            const int pi = (lo == 0) ? (hi - 1) : (lo == 1 ? hi + 1 : 5);
            const int cls = gs * 6 + pi;
            s_cls[n - nbeg] = cls;
            pw[(size_t)n * 2 + 0] = plo; pw[(size_t)n * 2 + 1] = phi;
        }
    }
    __syncthreads();
    const int nloc = nend - nbeg;
    if (tid < 24) {
        int c_ = 0;
        for (int i = 0; i < nloc; ++i) c_ += (s_cls[i] == tid) ? 1 : 0;
        s_base[tid] = c_ ? atomicAdd(&cnt[tid * 32], c_) : 0;
    }
    __syncthreads();
    for (int it = tid; it < nloc; it += NTHR) {
        const int cls = s_cls[it];
        int rank = 0;
        for (int i = 0; i < it; ++i) rank += (s_cls[i] == cls) ? 1 : 0;
        list[(size_t)cls * NT + s_base[cls] + rank] = nbeg + it;
    }
    __syncthreads();
}


struct MoeTile { int cls, ti, cnt, tg; };
__device__ __forceinline__ int moe_total_tiles(const int* cnt) { int s = 0; for (int c = 0; c < 24; ++c) s += (cnt[c * 32] + 127) >> 7; return s; }
__device__ __forceinline__ MoeTile moe_find(const int* cnt, int tile) {
    MoeTile r; int s = 0; r.cls = 0; r.ti = 0; r.cnt = 0; r.tg = tile;
    for (int c = 0; c < 24; ++c) { const int nt = (cnt[c * 32] + 127) >> 7; if (tile >= s && tile < s + nt) { r.cls = c; r.ti = tile - s; r.cnt = cnt[c * 32]; } s += nt; }
    return r;
}
__device__ void phase_moe1(const Params& p, unsigned char* lds) {
    const int tid = otid(), lane = tid & 63, wid = tid >> 6, wr = wid >> 1, wc = wid & 1, fr = lane & 15, fq = lane >> 4;
    const int* cnt = (const int*)(WS(p) + OFF_CTL);
    const int* list = (const int*)(WS(p) + OFF_LIST);
    const float* pw = (const float*)(WS(p) + OFF_PW);
    const bf16_t* hn = (const bf16_t*)(WS(p) + OFF_HN);
    const bf16_t* we = (const bf16_t*)(WS(p) + OFF_WEXP);
    bf16_t* hid = (bf16_t*)(OUTB(p) + DO_HID);
    const int total = moe_total_tiles(cnt);
    for (int item = obid(); item < total * 4; item += gridDim.x) {
        const MoeTile mt = moe_find(cnt, item >> 2);
        const int nt = item & 3, slot = nt >> 1, f0 = (nt & 1) * 128;
        const int g_ = mt.cls / 6, pi = mt.cls % 6;
        const int e = g_ * 4 + (slot == 0 ? c_pair_lo[pi] : c_pair_hi[pi]);
        const int* lst = list + (size_t)mt.cls * NT + mt.ti * 128;
        const int nvalid = min(128, mt.cnt - mt.ti * 128);
        f32x4 a1[2][4], a3[2][4]; g3_zero<2>(a1); g3_zero<2>(a3);
        G3<128> g;
        g3_setup<128>(g, [&](int r) { return hn + (size_t)lst[r < nvalid ? r : 0] * DM; }, [&](int r) { return we + WE_W1 + ((size_t)e * 256 + f0 + r) * 1024; }, tid);
        g3_kloop<128>(a1, g, DM, lds);
        g3_setup<128>(g, [&](int r) { return hn + (size_t)lst[r < nvalid ? r : 0] * DM; }, [&](int r) { return we + WE_W3 + ((size_t)e * 256 + f0 + r) * 1024; }, tid);
        g3_kloop<128>(a3, g, DM, lds);
#pragma unroll
        for (int m = 0; m < 2; ++m) {
            const int lr = wr * 32 + m * 16 + fr;
            const int tk = lst[lr < nvalid ? lr : 0];
            const float pe = pw[(size_t)tk * 2 + slot];
#pragma unroll
            for (int n = 0; n < 4; ++n) {
                const int col = slot * 256 + f0 + wc * 64 + n * 16 + fq * 4;
                float o[4];
#pragma unroll
                for (int j = 0; j < 4; ++j) { const float x1 = a1[m][n][j]; o[j] = x1 * sigmoidf_(x1) * a3[m][n][j] * pe; }
                *(uint2*)(hid + ((size_t)mt.tg * 128 + lr) * 512 + col) = pack4(o[0], o[1], o[2], o[3]);
            }
        }
    }
}
__device__ void phase_moe2(const Params& p, unsigned char* lds) {
    const int tid = otid(), lane = tid & 63, wid = tid >> 6, wr = wid >> 1, wc = wid & 1, fr = lane & 15, fq = lane >> 4;
    const int* cnt = (const int*)(WS(p) + OFF_CTL);
    const int* list = (const int*)(WS(p) + OFF_LIST);
    const bf16_t* we = (const bf16_t*)(WS(p) + OFF_WEXP);
    const bf16_t* hid = (const bf16_t*)(OUTB(p) + DO_HID);
    float* hm = (float*)(WS(p) + OFF_HM32);
    bf16_t* h = (bf16_t*)(WS(p) + OFF_H);
    const int total = moe_total_tiles(cnt);
    for (int item = obid(); item < total * 8; item += gridDim.x) {
        const MoeTile mt = moe_find(cnt, item >> 3);
        const int nt = item & 7, col0 = nt * 128;
        const int g_ = mt.cls / 6, pi = mt.cls % 6;
        const int elo = g_ * 4 + c_pair_lo[pi], ehi = g_ * 4 + c_pair_hi[pi];
        const int* lst = list + (size_t)mt.cls * NT + mt.ti * 128;
        const int nvalid = min(128, mt.cnt - mt.ti * 128);
        f32x4 acc[2][4]; g3_zero<2>(acc);
        G3<128> g;
        g3_setup<128>(g, [&](int r) { return hid + ((size_t)mt.tg * 128 + r) * 512; }, [&](int r) { return we + WE_W2 + ((size_t)elo * 1024 + col0 + r) * 256; }, tid);
        g3_kloop<128>(acc, g, 256, lds);
        g3_setup<128>(g, [&](int r) { return hid + ((size_t)mt.tg * 128 + r) * 512 + 256; }, [&](int r) { return we + WE_W2 + ((size_t)ehi * 1024 + col0 + r) * 256; }, tid);
        g3_kloop<128>(acc, g, 256, lds);
#pragma unroll
        for (int m = 0; m < 2; ++m) {
            const int lr = wr * 32 + m * 16 + fr;
            if (lr < nvalid) {
                const int tk = lst[lr];
#pragma unroll
                for (int n = 0; n < 4; ++n) {
                    const int col = col0 + wc * 64 + n * 16 + fq * 4;
                    float4 v = *(const float4*)(hm + (size_t)tk * 1024 + col);
                    v.x += acc[m][n][0]; v.y += acc[m][n][1]; v.z += acc[m][n][2]; v.w += acc[m][n][3];
                    *(float4*)(hm + (size_t)tk * 1024 + col) = v;
                    *(uint2*)(h + (size_t)tk * 1024 + col) = pack4(v.x, v.y, v.z, v.w);
                }
            }
        }
    }
}

__device__ void phase_final(const Params& p) {
    const int lane = otid() & 63;
    const int wave = (obid() * NTHR + otid()) >> 6, nw = gridDim.x * NTHR / 64;
    const float* hm = (const float*)(WS(p) + OFF_HM32);
    const float* nf = p.in[41];
    for (int r = wave; r < NB * SEQ; r += nw) {
        const int b = r / SEQ, s = r % SEQ;
        const size_t n = (size_t)b * TS + NMETA + s;
        float4 v[4]; float ss = 0.f;
#pragma unroll
        for (int i = 0; i < 4; ++i) { v[i] = *(const float4*)(hm + n * DM + i * 256 + lane * 4); ss += v[i].x * v[i].x + v[i].y * v[i].y + v[i].z * v[i].z + v[i].w * v[i].w; }
        ss = wave_sum(ss);
        const float rs = rsqrtf(ss * (1.0f / 1024.0f) + 1e-6f);
#pragma unroll
        for (int i = 0; i < 4; ++i) {
            const float4 g = *(const float4*)(nf + i * 256 + lane * 4);
            float4 o; o.x = v[i].x * rs * g.x; o.y = v[i].y * rs * g.y; o.z = v[i].z * rs * g.z; o.w = v[i].w * rs * g.w;
            *(float4*)((float*)OUTB(p) + (size_t)r * DM + i * 256 + lane * 4) = o;
        }
    }
}


#define XB_TMO      128
#define XB_XCNT(j)  (256  + 64 * (j))
#define XB_XSUB(j)  (1280 + 64 * (j))
#define XB_XGEN(j)  (2304 + 64 * (j))
#define XB_TOP      3328
#define XB_TOPGEN   3392
#define XCD_BAR_WORDS 3456
#define XB_SPIN_CAP (1u << 22)
#define LAS __attribute__((address_space(3)))
__device__ __forceinline__ unsigned xb_ld(unsigned* p) { return __hip_atomic_load(p, __ATOMIC_RELAXED, __HIP_MEMORY_SCOPE_AGENT); }
__device__ __forceinline__ unsigned xb_add(unsigned* p, unsigned v) { return __hip_atomic_fetch_add(p, v, __ATOMIC_RELAXED, __HIP_MEMORY_SCOPE_AGENT); }
__device__ __forceinline__ unsigned xb_xcc_id() { return (unsigned)__builtin_amdgcn_s_getreg((3 << 11) | 20) & 0xFu; }
#define XB_SPIN(cond, bar) do { unsigned _sp = 0; while (cond) { __builtin_amdgcn_s_sleep(1); \
    if ((++_sp & 255u) == 0u) { if (xb_ld(&(bar)[XB_TMO])) break; if (_sp > XB_SPIN_CAP) { atomicAdd(&(bar)[XB_TMO], 1u); break; } } } } while (0)
struct XcdBarrier { unsigned* bar; unsigned x; volatile LAS unsigned* st; };
__device__ __forceinline__ XcdBarrier xcd_barrier_post(unsigned* bar, volatile LAS unsigned* st) {
    XcdBarrier b; b.bar = bar; b.x = xb_xcc_id(); b.st = st;
    if (threadIdx.x == 0) (void)xb_add(&bar[XB_XCNT(b.x)], 1u);
    return b;
}
__device__ __forceinline__ void xcd_barrier_complete(unsigned* bar, unsigned x, unsigned& nloc, unsigned& nx) {
    const unsigned G = gridDim.x * gridDim.y * gridDim.z;
    unsigned sum, cnt, mine, sp = 0u;
    for (;;) {
        sum = 0u; cnt = 0u; mine = 0u;
#pragma unroll
        for (unsigned j = 0; j < 16; ++j) { const unsigned c = xb_ld(&bar[XB_XCNT(j)]); sum += c; cnt += (c > 0u) ? 1u : 0u; mine = (j == x) ? c : mine; }
        if (sum == G) break;
        __builtin_amdgcn_s_sleep(1);
        if ((++sp & 255u) == 0u) { if (xb_ld(&bar[XB_TMO])) break; if (sp > XB_SPIN_CAP) { atomicAdd(&bar[XB_TMO], 1u); break; } }
    }
    nloc = mine > 0u ? mine : 1u; nx = cnt > 0u ? cnt : 1u;
}
__device__ __forceinline__ void xcd_barrier(const XcdBarrier& b) {
    asm volatile("s_waitcnt vmcnt(0)" ::: "memory");
    __syncthreads();
    if (threadIdx.x == 0) {
        unsigned* bar = b.bar;
        __builtin_amdgcn_s_waitcnt(0);
        unsigned nloc = b.st[0], nx = b.st[1];
        if (nloc == 0u) { xcd_barrier_complete(bar, b.x, nloc, nx); b.st[0] = nloc; b.st[1] = nx; }
        const unsigned old = xb_add(&bar[XB_XSUB(b.x)], 1u);
        const unsigned gen = old / nloc;
        if (old + 1u == (gen + 1u) * nloc) {
            __builtin_amdgcn_fence(__ATOMIC_RELEASE, "agent");
            asm volatile("s_waitcnt vmcnt(0)" ::: "memory");
            const unsigned og = xb_add(&bar[XB_TOP], 1u);
            const unsigned tg = og / nx;
            if (og + 1u == (tg + 1u) * nx) xb_add(&bar[XB_TOPGEN], 1u);
            else XB_SPIN(xb_ld(&bar[XB_TOPGEN]) == tg, bar);
            __builtin_amdgcn_fence(__ATOMIC_ACQUIRE, "agent");
            xb_add(&bar[XB_XGEN(b.x)], 1u);
            asm volatile("s_waitcnt vmcnt(0)" ::: "memory");
        } else {
            XB_SPIN(xb_ld(&bar[XB_XGEN(b.x)]) == gen, bar);
            __builtin_amdgcn_fence(__ATOMIC_ACQUIRE, "agent");
            asm volatile("s_waitcnt vmcnt(0)" ::: "memory");
        }
    }
    __syncthreads();
}

__global__ void __launch_bounds__(NTHR) fwd_megakernel(Params p) {
    extern __shared__ __attribute__((aligned(16))) unsigned char lds[];
    cg::grid_group grid = cg::this_grid();
    volatile LAS unsigned* xst = (volatile LAS unsigned*)(lds + LDS_BYTES - 32);
    if (threadIdx.x < 2) xst[threadIdx.x] = 0u;
    __syncthreads();
    const XcdBarrier xb = xcd_barrier_post((unsigned*)(p.ws + OFF_BAR), xst);
#pragma unroll 1
    for (int step = 0; step < 18; ++step) {
        const int l = step >= 9 ? 1 : 0;
        const int ph = step - l * 9;
        switch (ph) {
        case 0:
            if (l == 0) phase_embed(p); else phase_rowstat(p);
            phase_convert<false>(p, l, lds);
            if (obid() == 0 && otid() < 24) ((int*)(WS(p) + OFF_CTL))[otid() * 32] = 0;
            if (obid() == 0 && otid() == 32) ((int*)(WS(p) + OFF_CTL))[800 + l * 32] = 0;
            break;
        case 1: phase_inproj(p, lds); break;
        case 2: phase_dsa_prep(p, l); phase_lr_prep(p, l); break;
        case 3: {
            if (obid() < NB * 16) phase_scan5(p, l, lds, obid());
            int* qctr = (int*)(WS(p) + OFF_CTL) + 800 + l * 32;
            int* qslot = (int*)(lds + LDS_BYTES - 16);
            for (;;) {
                __syncthreads();
                if (otid() == 0) *qslot = atomicAdd(qctr, 1);
                __syncthreads();
                const int item = *qslot;
                if (item >= 516 + NT / 16) break;
                if (item < 516) phase_pool(p, l, lds, item, item + 1, 1);
                else phase_dsa<false>(p, l, lds, (bf16_t*)(OUTB(p) + DO_YC), nullptr, nullptr, item - 516, item - 515, 1);
            }
        } break;
        case 4: phase_merge(p, lds); break;
        case 5: phase_outproj(p, lds); phase_convert<true>(p, l, lds); break;
        case 6: phase_route(p, l, lds); break;
        case 7: phase_moe1(p, lds); break;
        default: phase_moe2(p, lds); break;
        }
        if (step == 0) grid.sync(); else xcd_barrier(xb);
    }
    phase_final(p);
}

extern "C" void kernel_launch(void* const* d_in, const int* in_sizes, int n_in,
                              void* d_out, int out_size, void* d_ws, size_t ws_size,
                              hipStream_t stream) {
    static int grid_blocks = 0;
    if (grid_blocks == 0) {
        int dev = 0, cus = 0, per_cu = 0;
        (void)hipGetDevice(&dev);
        (void)hipDeviceGetAttribute(&cus, hipDeviceAttributeMultiprocessorCount, dev);
        (void)hipFuncSetAttribute((const void*)fwd_megakernel, hipFuncAttributeMaxDynamicSharedMemorySize, LDS_BYTES);
        (void)hipOccupancyMaxActiveBlocksPerMultiprocessor(&per_cu, fwd_megakernel, NTHR, LDS_BYTES);
        if (per_cu < 1 || cus < NB * 16 || n_in != 42 || ws_size < WS_END) { fprintf(stderr, "kernel_launch: bad config per_cu=%d n_in=%d ws=%zu need=%zu\n", per_cu, n_in, ws_size, (size_t)WS_END); grid_blocks = -1; }
        else grid_blocks = cus;
    }
    if (grid_blocks < 0) return;
    Params p{};
    for (int i = 0; i < 42; ++i) p.in[i] = (const float*)d_in[i];
    p.out = (float*)d_out;
    p.ws = (unsigned char*)d_ws;
    (void)hipMemsetAsync((unsigned char*)d_ws + OFF_BAR, 0, XCD_BAR_WORDS * 4, stream);
    void* args[] = {&p};
    hipError_t e = hipLaunchCooperativeKernel((void*)fwd_megakernel, dim3(grid_blocks), dim3(NTHR), args, LDS_BYTES, stream);
    if (e != hipSuccess) fprintf(stderr, "cooperative launch failed: %s (grid %d)\n", hipGetErrorString(e), grid_blocks);
}
```

```cpp
#include <hip/hip_runtime.h>
#include <hip/hip_cooperative_groups.h>
#include <cstdio>
#include <cstdint>
#include <type_traits>
namespace cg = cooperative_groups;

typedef unsigned short bf16_t;
typedef short bf16x8 __attribute__((ext_vector_type(8)));
typedef float f32x4 __attribute__((ext_vector_type(4)));

constexpr int NB = 8, SEQ = 2048, NMETA = 16, TS = 2064, DM = 1024;
constexpr int NT = NB * TS;
constexpr int NTP = 16640;
constexpr int NTHR = 512;
constexpr int CIN = 7912;
constexpr int NP1 = 4864;
constexpr int PM_LD = 768;
constexpr int PM_WD = 0, PM_AD = 64, PM_GD = 128, PM_VD = 256, PM_CQ = 288, PM_CKV = 544, PM_KROPE = 672, PM_KIDX = 704;
constexpr int LDS_BYTES = 157 * 1024;

constexpr size_t AL(size_t x) { return (x + 255) & ~(size_t)255; }
constexpr size_t SZ_ACT = (size_t)NTP * 1024 * 2;
constexpr size_t OFF_CTL = 0;
constexpr size_t OFF_BAR = 4096;
constexpr size_t OFF_RSTD = OFF_BAR + 16384;
constexpr size_t OFF_ROPE = OFF_RSTD + AL((size_t)NTP * 4);
constexpr size_t OFF_H = OFF_ROPE + AL((size_t)TS * 16 * 4 * 2);
constexpr size_t OFF_WB = OFF_H + SZ_ACT;
constexpr size_t WB_WIN = 0;
constexpr size_t WB_WG = WB_WIN + (size_t)NP1 * 1024;
constexpr size_t WB_PA = WB_WG + (size_t)3072 * 1024;
constexpr size_t WB_WO = WB_PA + (size_t)3 * 1024 * 1024;
constexpr size_t WB_POOL = WB_WO + (size_t)1024 * 1024;
constexpr size_t WB_QI = WB_POOL + (size_t)4 * 256 * 256;
constexpr size_t WB_UQ = WB_QI + (size_t)512 * 256;
constexpr size_t WB_UK = WB_UQ + (size_t)1536 * 256;
constexpr size_t WB_UV = WB_UK + (size_t)16 * 128 * 64;
constexpr size_t WB_WIDX = WB_UV + (size_t)16 * 64 * 128;
constexpr size_t WB_END = WB_WIDX + (size_t)64 * 1024;
constexpr size_t OFF_PPOOL = OFF_WB + AL(WB_END * 2);
constexpr size_t OFF_PK = OFF_PPOOL + SZ_ACT;
constexpr size_t OFF_PR = OFF_PK + SZ_ACT;
constexpr size_t OFF_PV = OFF_PR + SZ_ACT;
constexpr size_t OFF_PMISC = OFF_PV + SZ_ACT;
constexpr size_t OFF_VFIRST = OFF_PMISC + AL((size_t)NTP * PM_LD * 2);
constexpr size_t OFF_HALO = OFF_VFIRST + SZ_ACT;
constexpr size_t OFF_LIST = OFF_HALO + AL((size_t)130 * 16 * 1024 * 2);
constexpr size_t OFF_PW = OFF_LIST + AL((size_t)24 * NT * 4);
constexpr size_t WS_END = OFF_PW + AL((size_t)NT * 2 * 4);
constexpr size_t OFF_MERGED = OFF_PK;
constexpr size_t OFF_HM32 = OFF_PR;
constexpr size_t OFF_HN = OFF_PPOOL;
constexpr size_t OFF_WEXP = OFF_PMISC;
constexpr size_t WE_W1 = 0, WE_W3 = (size_t)16 * 256 * 1024, WE_W2 = (size_t)2 * 16 * 256 * 1024;
static_assert((size_t)3 * 16 * 256 * 1024 * 2 <= (size_t)NTP * PM_LD * 2, "expert weights must fit in Pmisc");
constexpr size_t DO_YC = 0;
constexpr size_t DO_CQN = DO_YC + SZ_ACT;
constexpr size_t DO_KV = DO_CQN + AL((size_t)NT * 256 * 2);
constexpr size_t DO_KIDX = DO_KV + AL((size_t)NT * 160 * 2);
constexpr size_t DO_WHEAD = DO_KIDX + AL((size_t)NT * 64 * 2);
constexpr size_t DO_ALR = DO_WHEAD + AL((size_t)NT * 8 * 4);
constexpr size_t DO_END = DO_ALR + AL((size_t)NT * 288 * 2);
constexpr size_t DO_HID = DO_YC;
static_assert(DO_END <= (size_t)NB * SEQ * DM * 4, "d_out scratch overflow");
static_assert((size_t)(129 + 24) * 128 * 512 * 2 <= SZ_ACT, "hid fits");
static_assert(WS_END <= 277240096ull, "workspace overflow");

struct Params {
    const float* in[42];
    float* out;
    unsigned char* ws;
};

__device__ __forceinline__ int otid() { int t = threadIdx.x; asm volatile("" : "+v"(t)); return t; }
__device__ __forceinline__ int obid() { int b = blockIdx.x; asm volatile("" : "+s"(b)); return b; }
__device__ __forceinline__ unsigned char* WS(const Params& p) { unsigned char* w = p.ws; asm volatile("" : "+s"(w)); return w; }
__device__ __forceinline__ unsigned char* OUTB(const Params& p) { unsigned char* w = (unsigned char*)p.out; asm volatile("" : "+s"(w)); return w; }
__device__ __forceinline__ float bf2f(bf16_t v) { return __uint_as_float(((unsigned)v) << 16); }
__device__ __forceinline__ bf16_t f2bf(float f) { unsigned u = __float_as_uint(f); u += 0x7FFFu + ((u >> 16) & 1u); return (bf16_t)(u >> 16); }
__device__ __forceinline__ float wave_sum(float v) {
#pragma unroll
    for (int o = 32; o > 0; o >>= 1) v += __shfl_xor(v, o);
    return v;
}
template <int CTRL> __device__ __forceinline__ float dpp_f(float x) {
    return __int_as_float(__builtin_amdgcn_update_dpp(0, __float_as_int(x), CTRL, 0xF, 0xF, true));
}
__device__ __forceinline__ float row16_sum(float v) {
    v += dpp_f<0xB1>(v);
    v += dpp_f<0x4E>(v);
    v += dpp_f<0x141>(v);
    v += dpp_f<0x140>(v);
    return v;
}
__device__ __forceinline__ void lds_barrier() { asm volatile("s_waitcnt lgkmcnt(0)" ::: "memory"); __builtin_amdgcn_s_barrier(); asm volatile("" ::: "memory"); }
__device__ __forceinline__ float fast_rcp(float x) { return __builtin_amdgcn_rcpf(x); }
__device__ __forceinline__ float fast_sigmoid(float x) { return fast_rcp(1.0f + __expf(-x)); }
__device__ __forceinline__ float fast_tanh(float x) { return 1.0f - 2.0f * fast_rcp(1.0f + __expf(2.0f * x)); }
__device__ __forceinline__ void row16_sum4(float& a, float& b, float& c, float& d) {
    asm volatile(
        "s_nop 1\n\t"
        "v_add_f32_dpp %0, %0, %0 quad_perm:[1,0,3,2] row_mask:0xf bank_mask:0xf\n\t"
        "v_add_f32_dpp %1, %1, %1 quad_perm:[1,0,3,2] row_mask:0xf bank_mask:0xf\n\t"
        "v_add_f32_dpp %2, %2, %2 quad_perm:[1,0,3,2] row_mask:0xf bank_mask:0xf\n\t"
        "v_add_f32_dpp %3, %3, %3 quad_perm:[1,0,3,2] row_mask:0xf bank_mask:0xf\n\t"
        "v_add_f32_dpp %0, %0, %0 quad_perm:[2,3,0,1] row_mask:0xf bank_mask:0xf\n\t"
        "v_add_f32_dpp %1, %1, %1 quad_perm:[2,3,0,1] row_mask:0xf bank_mask:0xf\n\t"
        "v_add_f32_dpp %2, %2, %2 quad_perm:[2,3,0,1] row_mask:0xf bank_mask:0xf\n\t"
        "v_add_f32_dpp %3, %3, %3 quad_perm:[2,3,0,1] row_mask:0xf bank_mask:0xf\n\t"
        "v_add_f32_dpp %0, %0, %0 row_half_mirror row_mask:0xf bank_mask:0xf\n\t"
        "v_add_f32_dpp %1, %1, %1 row_half_mirror row_mask:0xf bank_mask:0xf\n\t"
        "v_add_f32_dpp %2, %2, %2 row_half_mirror row_mask:0xf bank_mask:0xf\n\t"
        "v_add_f32_dpp %3, %3, %3 row_half_mirror row_mask:0xf bank_mask:0xf\n\t"
        "v_add_f32_dpp %0, %0, %0 row_mirror row_mask:0xf bank_mask:0xf\n\t"
        "v_add_f32_dpp %1, %1, %1 row_mirror row_mask:0xf bank_mask:0xf\n\t"
        "v_add_f32_dpp %2, %2, %2 row_mirror row_mask:0xf bank_mask:0xf\n\t"
        "v_add_f32_dpp %3, %3, %3 row_mirror row_mask:0xf bank_mask:0xf\n\t"
        "s_nop 1"
        : "+v"(a), "+v"(b), "+v"(c), "+v"(d));
}
__device__ __forceinline__ void row8_sum2(float& a, float& b) {
    asm volatile(
        "s_nop 1\n\t"
        "v_add_f32_dpp %0, %0, %0 quad_perm:[1,0,3,2] row_mask:0xf bank_mask:0xf\n\t"
        "v_add_f32_dpp %1, %1, %1 quad_perm:[1,0,3,2] row_mask:0xf bank_mask:0xf\n\t"
        "s_nop 0\n\t"
        "v_add_f32_dpp %0, %0, %0 quad_perm:[2,3,0,1] row_mask:0xf bank_mask:0xf\n\t"
        "v_add_f32_dpp %1, %1, %1 quad_perm:[2,3,0,1] row_mask:0xf bank_mask:0xf\n\t"
        "s_nop 0\n\t"
        "v_add_f32_dpp %0, %0, %0 row_half_mirror row_mask:0xf bank_mask:0xf\n\t"
        "v_add_f32_dpp %1, %1, %1 row_half_mirror row_mask:0xf bank_mask:0xf\n\t"
        "s_nop 1"
        : "+v"(a), "+v"(b));
}
__device__ __forceinline__ float wave_sum_fast(float v) { v = row16_sum(v); v += __shfl_xor(v, 16); v += __shfl_xor(v, 32); return v; }
__device__ __forceinline__ float sigmoidf_(float x) { return 1.0f / (1.0f + __expf(-x)); }
__device__ __forceinline__ float softplusf_(float z) { return fmaxf(z, 0.f) + log1pf(__expf(-fabsf(z))); }
__device__ __forceinline__ void glds16(const void* g, void* l) {
    __builtin_amdgcn_global_load_lds((const unsigned*)g, (unsigned*)l, 16, 0, 0);
}

__device__ void phase_embed(const Params& p) {
    const int lane = otid() & 63;
    const int wave = (obid() * NTHR + otid()) >> 6, nw = gridDim.x * NTHR / 64;
    bf16_t* h = (bf16_t*)(WS(p) + OFF_H);
    float* rstd = (float*)(WS(p) + OFF_RSTD);
    for (int n = wave; n < NTP; n += nw) {
        if (n < NT) {
            const int b = n / TS, t = n % TS;
            const float* src = t < NMETA ? p.in[1] + (size_t)t * DM : p.in[0] + ((size_t)b * SEQ + (t - NMETA)) * DM;
            float ss = 0.f;
#pragma unroll
            for (int i = 0; i < 4; ++i) {
                const float4 v = *(const float4*)(src + i * 256 + lane * 4);
                ss += v.x * v.x + v.y * v.y + v.z * v.z + v.w * v.w;
                ushort4 o; o.x = f2bf(v.x); o.y = f2bf(v.y); o.z = f2bf(v.z); o.w = f2bf(v.w);
                *(ushort4*)(h + (size_t)n * DM + i * 256 + lane * 4) = o;
            }
            ss = wave_sum(ss);
            if (lane == 0) rstd[n] = rsqrtf(ss * (1.0f / 1024.0f) + 1e-6f);
        } else {
#pragma unroll
            for (int i = 0; i < 4; ++i) *(ushort4*)(h + (size_t)n * DM + i * 256 + lane * 4) = make_ushort4(0, 0, 0, 0);
            if (lane == 0) rstd[n] = 0.f;
        }
    }
    float* ctab = (float*)(WS(p) + OFF_ROPE);
    float* stab = ctab + TS * 16;
    for (int idx = obid() * NTHR + otid(); idx < TS * 16; idx += gridDim.x * NTHR) {
        const int t = idx >> 4, i = idx & 15;
        const float inv = powf(10000.0f, -(float)(2 * i) / 32.0f);
        const float ang = (float)t * inv;
        ctab[idx] = cosf(ang);
        stab[idx] = sinf(ang);
    }
}

__device__ void phase_rowstat(const Params& p) {
    const int lane = otid() & 63;
    const int wave = (obid() * NTHR + otid()) >> 6, nw = gridDim.x * NTHR / 64;
    const float* hm = (const float*)(WS(p) + OFF_HM32);
    float* rstd = (float*)(WS(p) + OFF_RSTD);
    for (int n = wave; n < NT; n += nw) {
        float ss = 0.f;
#pragma unroll
        for (int i = 0; i < 4; ++i) {
            const float4 v = *(const float4*)(hm + (size_t)n * DM + i * 256 + lane * 4);
            ss += v.x * v.x + v.y * v.y + v.z * v.z + v.w * v.w;
        }
        ss = wave_sum(ss);
        if (lane == 0) rstd[n] = rsqrtf(ss * (1.0f / 1024.0f) + 1e-6f);
    }
}

struct ConvJob { const float* src; bf16_t* dst; const float* scale; int ldsrc, K, nvalid, nrows, nb, notr; size_t sbs, dbs; const float* srcB; int ldB, split; };
__device__ __forceinline__ int conv_job_tiles(const ConvJob& j) { return j.nb * (j.nrows >> 6) * (j.K >> 6); }
__device__ void conv_tile(const ConvJob& j, int tile, float* lds) {
    const int per = (j.nrows >> 6) * (j.K >> 6);
    const int bi = tile / per, rem = tile % per;
    const int ktiles = j.K >> 6;
    const int n0 = (rem / ktiles) << 6, k0 = (rem % ktiles) << 6;
    const int tid = otid(), tn = tid & 63, tk = tid >> 6;
    const float* src = j.src + (size_t)bi * j.sbs;
    bf16_t* dst = j.dst + (size_t)bi * j.dbs;
#pragma unroll
    for (int kk = 0; kk < 8; ++kk) {
        const int k = k0 + tk * 8 + kk;
        float v = 0.f;
        if (n0 + tn < j.nvalid) {
            if (j.split) { const int nn = n0 + tn; v = (nn < j.split) ? (j.src ? j.src[(size_t)k * j.ldsrc + nn] : 0.f) : j.srcB[(size_t)k * j.ldB + (nn - j.split)]; }
            else v = j.notr ? src[(size_t)(n0 + tn) * j.ldsrc + k] : src[(size_t)k * j.ldsrc + n0 + tn];
            if (j.scale) v *= j.scale[k];
        }
        lds[tn * 65 + tk * 8 + kk] = v;
    }
    __syncthreads();
    const int wn = tid >> 3, kq = tid & 7;
    uint4 o;
    unsigned w[4];
#pragma unroll
    for (int q = 0; q < 4; ++q) {
        const float lo = lds[wn * 65 + kq * 8 + 2 * q], hi = lds[wn * 65 + kq * 8 + 2 * q + 1];
        w[q] = (unsigned)f2bf(lo) | ((unsigned)f2bf(hi) << 16);
    }
    o.x = w[0]; o.y = w[1]; o.z = w[2]; o.w = w[3];
    *(uint4*)(dst + (size_t)(n0 + wn) * j.K + k0 + kq * 8) = o;
    __syncthreads();
}
__device__ ConvJob get_job_early(const Params& p, int l, int ji) {
    bf16_t* wb = (bf16_t*)(WS(p) + OFF_WB);
    const float* win = p.in[3] + (size_t)l * DM * CIN;
    const float* nm = p.in[2] + (size_t)l * DM;
    ConvJob j{}; j.nb = 1; j.sbs = 0; j.dbs = 0; j.K = 1024; j.ldsrc = CIN; j.scale = nm;
    switch (ji) {
    case 0: j.src = win + 3072; j.dst = wb + WB_WIN; j.nvalid = 4352; j.nrows = 4352; break;
    case 1: j.src = (l == 0 ? nullptr : p.in[17]); j.ldsrc = 32; j.split = 32; j.srcB = win + 7424; j.ldB = CIN; j.dst = wb + WB_WIN + (size_t)(4096 + PM_VD) * 1024; j.nvalid = 512; j.nrows = 512; break;
    case 2: j.src = win + 7904; j.dst = wb + WB_WIDX; j.nvalid = 8; j.nrows = 64; break;
    case 3: j.src = win; j.dst = wb + WB_WG; j.nvalid = 3072; j.nrows = 3072; break;
    case 4: j.src = p.in[29] + (size_t)l * DM * DM; j.ldsrc = 1024; j.scale = nullptr; j.dst = wb + WB_PA; j.nvalid = 1024; j.nrows = 1024; break;
    case 5: j.src = p.in[30] + (size_t)l * DM * DM; j.ldsrc = 1024; j.scale = nullptr; j.dst = wb + WB_PA + (size_t)1024 * 1024; j.nvalid = 1024; j.nrows = 1024; break;
    case 6: j.src = p.in[31] + (size_t)l * DM * DM; j.ldsrc = 1024; j.scale = nullptr; j.dst = wb + WB_PA + (size_t)2 * 1024 * 1024; j.nvalid = 1024; j.nrows = 1024; break;
    case 7: j.src = p.in[32] + (size_t)l * DM * DM; j.ldsrc = 1024; j.scale = nullptr; j.dst = wb + WB_WO; j.nvalid = 1024; j.nrows = 1024; break;
    case 8: j.src = p.in[5] + (size_t)l * 4 * 256 * 256; j.ldsrc = 256; j.K = 256; j.scale = nullptr; j.dst = wb + WB_POOL; j.nvalid = 256; j.nrows = 256; j.nb = 4; j.sbs = 65536; j.dbs = 65536; break;
    case 9: j.src = p.in[26] + (size_t)l * 256 * 512; j.ldsrc = 512; j.K = 256; j.scale = nullptr; j.dst = wb + WB_QI; j.nvalid = 512; j.nrows = 512; break;
    case 10: j.src = p.in[23] + (size_t)l * 256 * 1536; j.ldsrc = 1536; j.K = 256; j.scale = nullptr; j.dst = wb + WB_UQ; j.nvalid = 1536; j.nrows = 1536; break;
    case 11: j.src = p.in[24] + (size_t)l * 16 * 128 * 64; j.ldsrc = 64; j.K = 64; j.scale = nullptr; j.dst = wb + WB_UK; j.nvalid = 2048; j.nrows = 2048; j.notr = 1; break;
    default: j.src = p.in[25] + (size_t)l * 16 * 128 * 64; j.ldsrc = 64; j.K = 128; j.scale = nullptr; j.dst = wb + WB_UV; j.nvalid = 64; j.nrows = 64; j.nb = 16; j.sbs = 8192; j.dbs = 8192; break;
    }
    return j;
}
__device__ ConvJob get_job_late(const Params& p, int l, int ji) {
    bf16_t* we = (bf16_t*)(WS(p) + OFF_WEXP);
    ConvJob j{}; j.nb = 16; j.scale = nullptr; j.sbs = 262144; j.dbs = 262144;
    switch (ji) {
    case 0: j.src = p.in[38] + (size_t)l * 16 * 262144; j.dst = we + WE_W1; j.ldsrc = 256; j.K = 1024; j.nvalid = 256; j.nrows = 256; break;
    case 1: j.src = p.in[39] + (size_t)l * 16 * 262144; j.dst = we + WE_W3; j.ldsrc = 256; j.K = 1024; j.nvalid = 256; j.nrows = 256; break;
    default: j.src = p.in[40] + (size_t)l * 16 * 262144; j.dst = we + WE_W2; j.ldsrc = 1024; j.K = 256; j.nvalid = 1024; j.nrows = 1024; break;
    }
    return j;
}
template <bool LATE>
__device__ void phase_convert(const Params& p, int l, unsigned char* lds) {
    const int njobs = LATE ? 3 : 13;
    int base = 0;
    for (int ji = 0; ji < njobs; ++ji) {
        const ConvJob j = LATE ? get_job_late(p, l, ji) : get_job_early(p, l, ji);
        const int nt = conv_job_tiles(j);
        int first = ((int)obid() - base) % (int)gridDim.x; if (first < 0) first += gridDim.x;
        for (int t = first; t < nt; t += gridDim.x) conv_tile(j, t, (float*)lds);
        base += nt;
    }
}

template <int BM> struct G3 {
    static constexpr int MI = BM / 64;
    static constexpr int NA = BM / 64;
    static constexpr int STAGE = BM * 128 + 128 * 128;
    const bf16_t* ap[NA];
    const bf16_t* bp[2];
};
template <int BM>
__device__ __forceinline__ void g3_issue(const G3<BM>& g, int kt, unsigned char* stage, int tid) {
#pragma unroll
    for (int i = 0; i < G3<BM>::NA; ++i) glds16(g.ap[i] + kt * 64, stage + (tid + i * NTHR) * 16);
#pragma unroll
    for (int i = 0; i < 2; ++i) glds16(g.bp[i] + kt * 64, stage + BM * 128 + (tid + i * NTHR) * 16);
}
template <int BM, class FA, class FB>
__device__ __forceinline__ void g3_setup(G3<BM>& g, FA rowptr, FB bcol, int tid) {
#pragma unroll
    for (int i = 0; i < G3<BM>::NA; ++i) { const int idx = tid + i * NTHR, row = idx >> 3, sl = (idx & 7) ^ (row & 7); g.ap[i] = rowptr(row) + sl * 8; }
#pragma unroll
    for (int i = 0; i < 2; ++i) { const int idx = tid + i * NTHR, row = idx >> 3, sl = (idx & 7) ^ (row & 7); g.bp[i] = bcol(row) + sl * 8; }
}
template <int BM>
__device__ __forceinline__ void g3_kloop(f32x4 (&acc)[BM / 64][4], const G3<BM>& g, int K, unsigned char* lds) {
    constexpr int MI = G3<BM>::MI, STAGE = G3<BM>::STAGE, NL = G3<BM>::NA + 2;
    const int tid = otid(), lane = tid & 63, wid = tid >> 6, wr = wid >> 1, wc = wid & 1, fr = lane & 15, fq = lane >> 4;
    const int nk = K >> 6;
    g3_issue<BM>(g, 0, lds, tid);
    if (nk > 1) g3_issue<BM>(g, 1, lds + STAGE, tid);
    int cur = 0;
#pragma unroll 1
    for (int t = 0; t < nk; ++t) {
        if (t + 1 < nk) { if (NL == 6) asm volatile("s_waitcnt vmcnt(6)" ::: "memory"); else if (NL == 5) asm volatile("s_waitcnt vmcnt(5)" ::: "memory"); else asm volatile("s_waitcnt vmcnt(4)" ::: "memory"); }
        else asm volatile("s_waitcnt vmcnt(0)" ::: "memory");
        __builtin_amdgcn_s_barrier();
        if (t + 2 < nk) { int nx = cur + 2; if (nx >= 3) nx -= 3; g3_issue<BM>(g, t + 2, lds + nx * STAGE, tid); }
        const unsigned char* cA = lds + cur * STAGE;
        const unsigned char* cB = cA + BM * 128;
#pragma unroll
        for (int ks = 0; ks < 2; ++ks) {
            bf16x8 a[MI], b[4];
#pragma unroll
            for (int m = 0; m < MI; ++m) { const int row = wr * (BM / 4) + m * 16 + fr; a[m] = *(const bf16x8*)(cA + row * 128 + (((ks * 4 + fq) ^ (row & 7)) << 4)); }
#pragma unroll
            for (int n = 0; n < 4; ++n) { const int row = wc * 64 + n * 16 + fr; b[n] = *(const bf16x8*)(cB + row * 128 + (((ks * 4 + fq) ^ (row & 7)) << 4)); }
#pragma unroll
            for (int m = 0; m < MI; ++m)
#pragma unroll
                for (int n = 0; n < 4; ++n) acc[m][n] = __builtin_amdgcn_mfma_f32_16x16x32_bf16(b[n], a[m], acc[m][n], 0, 0, 0);
        }
        cur = (cur == 2) ? 0 : cur + 1;
    }
    __builtin_amdgcn_s_barrier();
}
struct G3D { const bf16_t* ap[2]; const bf16_t* b1[2]; const bf16_t* b3[2]; };
__device__ __forceinline__ void g3d_issue(const G3D& g, int kt, unsigned char* stage, int tid) {
#pragma unroll
    for (int i = 0; i < 2; ++i) glds16(g.ap[i] + kt * 64, stage + (tid + i * NTHR) * 16);
#pragma unroll
    for (int i = 0; i < 2; ++i) glds16(g.b1[i] + kt * 64, stage + 16384 + (tid + i * NTHR) * 16);
#pragma unroll
    for (int i = 0; i < 2; ++i) glds16(g.b3[i] + kt * 64, stage + 32768 + (tid + i * NTHR) * 16);
}
__device__ __forceinline__ void g3d_kloop(f32x4 (&acc1)[2][4], f32x4 (&acc3)[2][4], const G3D& g, int K, unsigned char* lds) {
    constexpr int STAGE = 49152;
    const int tid = otid(), lane = tid & 63, wid = tid >> 6, wr = wid >> 1, wc = wid & 1, fr = lane & 15, fq = lane >> 4;
    const int nk = K >> 6;
    g3d_issue(g, 0, lds, tid);
    if (nk > 1) g3d_issue(g, 1, lds + STAGE, tid);
    int cur = 0;
#pragma unroll 1
    for (int t = 0; t < nk; ++t) {
        if (t + 1 < nk) asm volatile("s_waitcnt vmcnt(6)" ::: "memory"); else asm volatile("s_waitcnt vmcnt(0)" ::: "memory");
        __builtin_amdgcn_s_barrier();
        if (t + 2 < nk) { int nx = cur + 2; if (nx >= 3) nx -= 3; g3d_issue(g, t + 2, lds + nx * STAGE, tid); }
        const unsigned char* cA = lds + cur * STAGE;
#pragma unroll
        for (int ks = 0; ks < 2; ++ks) {
            bf16x8 a[2], b1[4], b3[4];
#pragma unroll
            for (int m = 0; m < 2; ++m) { const int row = wr * 32 + m * 16 + fr; a[m] = *(const bf16x8*)(cA + row * 128 + (((ks * 4 + fq) ^ (row & 7)) << 4)); }
#pragma unroll
            for (int n = 0; n < 4; ++n) { const int row = wc * 64 + n * 16 + fr; const int off = row * 128 + (((ks * 4 + fq) ^ (row & 7)) << 4);
                b1[n] = *(const bf16x8*)(cA + 16384 + off); b3[n] = *(const bf16x8*)(cA + 32768 + off); }
#pragma unroll
            for (int m = 0; m < 2; ++m)
#pragma unroll
                for (int n = 0; n < 4; ++n) {
                    acc1[m][n] = __builtin_amdgcn_mfma_f32_16x16x32_bf16(b1[n], a[m], acc1[m][n], 0, 0, 0);
                    acc3[m][n] = __builtin_amdgcn_mfma_f32_16x16x32_bf16(b3[n], a[m], acc3[m][n], 0, 0, 0);
                }
        }
        cur = (cur == 2) ? 0 : cur + 1;
    }
    __builtin_amdgcn_s_barrier();
}
template <int MI>
__device__ __forceinline__ void g3_zero(f32x4 (&acc)[MI][4]) {
#pragma unroll
    for (int m = 0; m < MI; ++m)
#pragma unroll
        for (int n = 0; n < 4; ++n) acc[m][n] = (f32x4){0.f, 0.f, 0.f, 0.f};
}
__device__ __forceinline__ uint2 pack4(float a, float b, float c, float d) {
    uint2 r; r.x = (unsigned)f2bf(a) | ((unsigned)f2bf(b) << 16); r.y = (unsigned)f2bf(c) | ((unsigned)f2bf(d) << 16); return r;
}

namespace pg8 {
#define PG8_LAS __attribute__((address_space(3)))
typedef unsigned short bf16_t;
typedef short bf16x8 __attribute__((ext_vector_type(8)));
typedef float f32x4 __attribute__((ext_vector_type(4)));
typedef unsigned u32x4 __attribute__((ext_vector_type(4)));
constexpr int BM = 256, BK = 64, HALF = 128, HTB = HALF * BK * 2  , STAGE_BYTES = 8 * HTB, NXCD = 8, WGM = 8;

__host__ __device__ __forceinline__ int lds_byte(int r, int c) { const int st = (r >> 4) * 2 + (c >> 5), rr = r & 15, cc = c & 31, ob = rr * 64 + cc * 2; return st * 1024 + (ob ^ (((ob >> 9) & 1) << 5)); }
__host__ __device__ __forceinline__ void stage_rc(int b, int& R, int& C) { const int st = b / 1024, sb = b % 1024, swz = sb ^ (((sb >> 9) & 1) << 5); R = (st >> 1) * 16 + swz / 64; C = (st & 1) * 32 + (swz % 64) / 2; }
__host__ __device__ __forceinline__ int perm32(int rho) { const int n = rho >> 4, i = rho & 15; return 8 * (i >> 2) + 4 * n + (i & 3); }

struct Unit { int pm, pn; };
struct Gemm { const bf16_t* A; const bf16_t* Bt; int M, N, K; };

struct StaticOrder {
    int nM, nN, nwg, G, c;
    __host__ __device__ void init(int M, int N, int G_, int c_) { nM = M / BM; nN = N / BM; nwg = nM * nN; G = G_; c = c_; }
    __host__ __device__ bool next(int i, Unit& u) const {
        const long L = (long)i * G + c; if (L >= nwg) return false;
        int wgid = (int)L; { const int q = nwg / NXCD, r = nwg % NXCD, xcd = wgid % NXCD, off = wgid / NXCD; wgid = (xcd < r ? xcd * (q + 1) : r * (q + 1) + (xcd - r) * q) + off; }
        const int nig = WGM * nN, gid = wgid / nig, fm = gid * WGM, gsz = (nM - fm) < WGM ? (nM - fm) : WGM;
        u.pm = fm + ((wgid % nig) % gsz); u.pn = (wgid % nig) / gsz; return true;
    }
    __device__ __forceinline__ void a_ready(const Unit&) const {}
    __device__ __forceinline__ void done(const Unit&) const {}
};
template <class Epi, class Sched, bool STAMP = false>
__device__ __forceinline__ void gemm_phase(PG8_LAS unsigned char* lds, const Gemm g, const Sched& S, const Epi& E, unsigned long long* stamps) {
    const int tid = otid(), wid = __builtin_amdgcn_readfirstlane(tid >> 6), lane = tid & 63, wr = wid >> 2, wc = wid & 3, fr = lane & 15, fq = lane >> 4;
    const int K = g.K, nt = K / BK;
    int ts_lo = 0, ts_hi = 0, nts = 0; const unsigned long long rt_entry = STAMP ? 0ull : 0ull;
#define PG8_STAMP() do { if (STAMP && wid == 0 && nts < 64) { const unsigned long long _c = 0ull; \
        ts_lo = (lane == nts) ? (int)(unsigned)_c : ts_lo; ts_hi = (lane == nts) ? (int)(unsigned)(_c >> 32) : ts_hi; ++nts; } } while (0)
    PG8_STAMP();
    unsigned voffA[2], voffB[2];
#pragma unroll
    for (int i = 0; i < 2; ++i) { int R, C; stage_rc(tid * 16 + i * 8192, R, C); const int Rb = Epi::PERM ? ((R & ~31) + perm32(R & 31)) : R;
        voffA[i] = (unsigned)(R * K + C) * 2u; voffB[i] = (unsigned)(Rb * K + C) * 2u; }
    const size_t kstep = (size_t)(BK * 2);
    const size_t hstep = (size_t)HALF * K * 2;
    const size_t tstep = 2 * hstep;
    const unsigned ldsw = (unsigned)wid * 1024u;
    const int aoff = lds_byte(wr * 64 + fr, fq * 8), boff = lds_byte(wc * 32 + fr, fq * 8);
#define PG8_SA(b, h) (((b) * 2 + (h)) * HTB)
#define PG8_SB(b, h) ((4 + (b) * 2 + (h)) * HTB)
#define PG8_STAGE(bufoff, gbase, voff) do { _Pragma("unroll") for (int _i = 0; _i < 2; ++_i) \
        __builtin_amdgcn_global_load_lds((const unsigned*)((const char*)(gbase) + (voff)[_i]), (PG8_LAS unsigned*)(lds + (bufoff) + ldsw + _i * 8192), 16, 0, 0); } while (0)
#define PG8_LDA(dst, b, h) do { _Pragma("unroll") for (int m = 0; m < 4; ++m) _Pragma("unroll") for (int k = 0; k < 2; ++k) dst[m][k] = *(const PG8_LAS bf16x8*)(lds + PG8_SA(b, h) + aoff + m * 2048 + k * 1024); } while (0)
#define PG8_LDB(dst, b, h) do { _Pragma("unroll") for (int n = 0; n < 2; ++n) _Pragma("unroll") for (int k = 0; k < 2; ++k) dst[n][k] = *(const PG8_LAS bf16x8*)(lds + PG8_SB(b, h) + boff + n * 2048 + k * 1024); } while (0)
#define PG8_MMA(ai, bj, At, Bt) do { __builtin_amdgcn_s_setprio(1); _Pragma("unroll") for (int m = 0; m < 4; ++m) _Pragma("unroll") for (int n = 0; n < 2; ++n) _Pragma("unroll") for (int k = 0; k < 2; ++k) \
        acc[ai][bj][m][n] = __builtin_amdgcn_mfma_f32_16x16x32_bf16(Bt[n][k], At[m][k], acc[ai][bj][m][n], 0, 0, 0); __builtin_amdgcn_s_setprio(0); } while (0)
#define PG8_WAIT_V(n) asm volatile("s_waitcnt vmcnt(" #n ")" ::: "memory")
#define PG8_WAIT_L(n) asm volatile("s_waitcnt lgkmcnt(" #n ")" ::: "memory")
#define PG8_BAR __builtin_amdgcn_s_barrier()
#define PG8_SCHED __builtin_amdgcn_sched_barrier(0)
    Unit cur, nxt; int ui = 0;
    if (!S.next(0, cur)) return;
    f32x4 acc[2][2][4][2];
#pragma unroll
    for (int a = 0; a < 2; ++a)
#pragma unroll
        for (int b = 0; b < 2; ++b)
#pragma unroll
            for (int m = 0; m < 4; ++m)
#pragma unroll
                for (int n = 0; n < 2; ++n) acc[a][b][m][n] = (f32x4){0.f, 0.f, 0.f, 0.f};
    bf16x8 At[4][2], B0[2][2], B1[2][2];
    const char* cA = (const char*)g.A + (size_t)cur.pm * tstep; const char* cB = (const char*)g.Bt + (size_t)cur.pn * tstep;
    S.a_ready(cur);
    PG8_STAGE(PG8_SB(0, 0), cB, voffB); PG8_STAGE(PG8_SA(0, 0), cA, voffA); PG8_STAGE(PG8_SB(0, 1), cB + hstep, voffB); PG8_STAGE(PG8_SA(0, 1), cA + hstep, voffA);
    if (wr == 1) PG8_BAR;
    PG8_WAIT_V(4); PG8_BAR;
    PG8_STAGE(PG8_SB(1, 0), cB + kstep, voffB); PG8_STAGE(PG8_SA(1, 0), cA + kstep, voffA); PG8_STAGE(PG8_SB(1, 1), cB + hstep + kstep, voffB);
    PG8_WAIT_V(6); PG8_BAR;
    PG8_STAMP();
    for (;;) {
        const bool has_next = S.next(ui + 1, nxt);
        const char* nA = has_next ? (const char*)g.A + (size_t)nxt.pm * tstep : cA; const char* nB = has_next ? (const char*)g.Bt + (size_t)nxt.pn * tstep : cB;
        for (int t = 0; t < nt; t += 2) {
            const bool last = (t == nt - 2);
            const char* a1 = cA + (size_t)(t + 1) * kstep;
            const char* a2 = last ? nA : cA + (size_t)(t + 2) * kstep; const char* b2 = last ? nB : cB + (size_t)(t + 2) * kstep;
            const char* a3 = a2 + kstep; const char* b3 = b2 + kstep;
            if (last && has_next) S.a_ready(nxt);
            PG8_LDB(B0, 0, 0); PG8_SCHED; PG8_LDA(At, 0, 0); PG8_STAGE(PG8_SA(1, 1), a1 + hstep, voffA);
            PG8_WAIT_L(8); PG8_BAR; PG8_WAIT_L(0); PG8_MMA(0, 0, At, B0); PG8_BAR; PG8_SCHED;
            PG8_LDB(B1, 0, 1); PG8_STAGE(PG8_SB(0, 0), b2, voffB);
            PG8_BAR; PG8_WAIT_L(0); PG8_MMA(0, 1, At, B1); PG8_BAR;
            PG8_LDA(At, 0, 1); PG8_STAGE(PG8_SA(0, 0), a2, voffA);
            PG8_BAR; PG8_WAIT_L(0); PG8_MMA(1, 0, At, B0); PG8_BAR; PG8_SCHED;
            PG8_STAGE(PG8_SB(0, 1), b2 + hstep, voffB);
            PG8_WAIT_V(6); PG8_BAR; PG8_MMA(1, 1, At, B1); PG8_BAR;
            PG8_LDB(B0, 1, 0); PG8_SCHED; PG8_LDA(At, 1, 0); PG8_STAGE(PG8_SA(0, 1), a2 + hstep, voffA);
            PG8_WAIT_L(8); PG8_BAR; PG8_WAIT_L(0); PG8_MMA(0, 0, At, B0); PG8_BAR; PG8_SCHED;
            PG8_LDB(B1, 1, 1); PG8_STAGE(PG8_SB(1, 0), b3, voffB);
            PG8_BAR; PG8_WAIT_L(0); PG8_MMA(0, 1, At, B1); PG8_BAR;
            PG8_LDA(At, 1, 1); PG8_STAGE(PG8_SA(1, 0), a3, voffA);
            PG8_BAR; PG8_WAIT_L(0); PG8_MMA(1, 0, At, B0); PG8_BAR; PG8_SCHED;
            PG8_STAGE(PG8_SB(1, 1), b3 + hstep, voffB);
            PG8_WAIT_V(6); PG8_BAR; PG8_MMA(1, 1, At, B1); PG8_BAR;
        }
        PG8_STAMP();
        if constexpr (!Epi::AFTER_DRAIN) { E(acc, cur, wr, wc, fr, fq); S.done(cur); }
        PG8_STAMP();
        if (!has_next) break;
#pragma unroll
        for (int a = 0; a < 2; ++a)
#pragma unroll
            for (int b = 0; b < 2; ++b)
#pragma unroll
                for (int m = 0; m < 4; ++m)
#pragma unroll
                    for (int n = 0; n < 2; ++n) acc[a][b][m][n] = (f32x4){0.f, 0.f, 0.f, 0.f};
        cur = nxt; cA = nA; cB = nB; ++ui;
    }
    PG8_WAIT_V(0);
    if (wr == 0) PG8_BAR;
    PG8_BAR;
    if constexpr (Epi::AFTER_DRAIN) { E.fused(acc, cur, wr, wc, fr, fq, lds, wid, lane); S.done(cur); }
    PG8_STAMP();
    if (STAMP && wid == 0) { stamps[lane] = lane < nts ? (((unsigned long long)(unsigned)ts_hi << 32) | (unsigned)ts_lo) : 0ull;
        if (lane == 62) stamps[62] = rt_entry; if (lane == 63) stamps[63] = 0ull; }
#undef PG8_STAMP
#undef PG8_SA
#undef PG8_SB
#undef PG8_STAGE
#undef PG8_LDA
#undef PG8_LDB
#undef PG8_MMA
#undef PG8_WAIT_V
#undef PG8_WAIT_L
#undef PG8_BAR
#undef PG8_SCHED
}
}

struct EpiInproj {
    static constexpr bool PERM = true, AFTER_DRAIN = false;
    unsigned char* ws; const float* rstd;
    __device__ __forceinline__ void operator()(const pg8::f32x4 (&acc)[2][2][4][2], const pg8::Unit& u, int wr, int wc, int fr, int fq) const {
        const int pn = u.pn;
        bf16_t* dst; int ld, cb;
        if (pn < 4) { dst = (bf16_t*)(ws + OFF_PPOOL); ld = 1024; cb = pn * 256; }
        else if (pn < 8) { dst = (bf16_t*)(ws + OFF_PR); ld = 1024; cb = (pn - 4) * 256; }
        else if (pn < 12) { dst = (bf16_t*)(ws + OFF_PK); ld = 1024; cb = (pn - 8) * 256; }
        else if (pn < 16) { dst = (bf16_t*)(ws + OFF_PV); ld = 1024; cb = (pn - 12) * 256; }
        else { dst = (bf16_t*)(ws + OFF_PMISC); ld = PM_LD; cb = (pn - 16) * 256; }
        bf16_t* halo = (bf16_t*)(ws + OFF_HALO);
#pragma unroll
        for (int ai = 0; ai < 2; ++ai)
#pragma unroll
            for (int m = 0; m < 4; ++m) {
                const int row = u.pm * 256 + ai * 128 + wr * 64 + m * 16 + fr;
                if (row < NT) {
                    const float rs = rstd[row];
                    const int lr = row & 127;
#pragma unroll
                    for (int bj = 0; bj < 2; ++bj) {
                        const int col = cb + bj * 128 + wc * 32 + fq * 8;
                        const uint2 lo = pack4(acc[ai][bj][m][0][0] * rs, acc[ai][bj][m][0][1] * rs, acc[ai][bj][m][0][2] * rs, acc[ai][bj][m][0][3] * rs);
                        const uint2 hi = pack4(acc[ai][bj][m][1][0] * rs, acc[ai][bj][m][1][1] * rs, acc[ai][bj][m][1][2] * rs, acc[ai][bj][m][1][3] * rs);
                        const uint4 v = make_uint4(lo.x, lo.y, hi.x, hi.y);
                        *(uint4*)(dst + (size_t)row * ld + col) = v;
                        if (pn < 4 && lr >= 112) *(uint4*)(halo + ((size_t)(row >> 7) * 16 + (lr - 112)) * 1024 + col) = v;
                    }
                }
            }
    }
};
__device__ void phase_inproj(const Params& p, unsigned char* lds) {
    pg8::StaticOrder S; S.init(NTP, NP1, (int)gridDim.x, obid());
    pg8::Gemm g; g.A = (const pg8::bf16_t*)(WS(p) + OFF_H); g.Bt = (const pg8::bf16_t*)(WS(p) + OFF_WB) + WB_WIN; g.M = NTP; g.N = NP1; g.K = DM;
    EpiInproj E; E.ws = WS(p); E.rstd = (const float*)(WS(p) + OFF_RSTD);
    pg8::gemm_phase<EpiInproj, pg8::StaticOrder, false>((PG8_LAS unsigned char*)lds, g, S, E, nullptr);
}

__device__ void phase_pool(const Params& p, int l, unsigned char* lds, int tb, int te, int tstep) {
    const int tid = otid(), lane = tid & 63, wid = tid >> 6, fr = lane & 15, fq = lane >> 4;
    bf16_t* pp = (bf16_t*)(WS(p) + OFF_PPOOL);
    const bf16_t* halo = (const bf16_t*)(WS(p) + OFF_HALO);
    const bf16_t* pw = (const bf16_t*)(WS(p) + OFF_WB) + WB_POOL;
    const float* scale = p.in[6] + (size_t)l * 1024;
    bf16_t* sp = (bf16_t*)lds;
    constexpr int SLD = 264;
    for (int tile = tb; tile < te; tile += tstep) {
        const int mt = tile >> 2, g = tile & 3;
        const int row0 = mt * 128, w = 2 << g;
        {
            const int c = tid & 255, r0 = (tid >> 8) * 64, col = g * 256 + c;
            auto rawv = [&](int n2) -> float {
                return (n2 >= row0) ? bf2f(pp[(size_t)n2 * 1024 + col]) : bf2f(halo[((size_t)(n2 >> 7) * 16 + ((n2 & 127) - 112)) * 1024 + col]);
            };
            int n = row0 + r0, t = n % TS;
            float sum = 0.f;
            const int have = (t < w) ? t : w;
            for (int i = 1; i <= have; ++i) sum += rawv(n - i);
#pragma unroll 4
            for (int r = 0; r < 64; ++r, ++n) {
                if (t == 0) sum = 0.f;
                const float v = rawv(n);
                sum += v;
                if (t >= w) sum -= rawv(n - w);
                const int cnt = (t + 1 < w) ? (t + 1) : w;
                sp[(r0 + r) * SLD + c] = f2bf(sum * (1.0f / (float)cnt) - v);
                t = (t + 1 == TS) ? 0 : t + 1;
            }
        }
        __syncthreads();
        f32x4 acc[8][2];
#pragma unroll
        for (int m = 0; m < 8; ++m) { acc[m][0] = (f32x4){0.f, 0.f, 0.f, 0.f}; acc[m][1] = (f32x4){0.f, 0.f, 0.f, 0.f}; }
        const bf16_t* wg = pw + (size_t)g * 65536;
#pragma unroll 1
        for (int kk = 0; kk < 8; ++kk) {
            bf16x8 bfr[2];
#pragma unroll
            for (int n = 0; n < 2; ++n) bfr[n] = *(const bf16x8*)(wg + (size_t)(wid * 32 + n * 16 + fr) * 256 + kk * 32 + fq * 8);
#pragma unroll
            for (int m = 0; m < 8; ++m) {
                const bf16x8 a = *(const bf16x8*)(sp + (m * 16 + fr) * SLD + kk * 32 + fq * 8);
                acc[m][0] = __builtin_amdgcn_mfma_f32_16x16x32_bf16(a, bfr[0], acc[m][0], 0, 0, 0);
                acc[m][1] = __builtin_amdgcn_mfma_f32_16x16x32_bf16(a, bfr[1], acc[m][1], 0, 0, 0);
            }
        }
#pragma unroll
        for (int m = 0; m < 8; ++m)
#pragma unroll
            for (int n = 0; n < 2; ++n) {
                const int col = g * 256 + wid * 32 + n * 16 + fr;
                const float sc = scale[col];
#pragma unroll
                for (int j = 0; j < 4; ++j) {
                    const int row = row0 + m * 16 + fq * 4 + j;
                    pp[(size_t)row * 1024 + col] = f2bf(acc[m][n][j] * sc);
                }
            }
        __syncthreads();
    }
}

__device__ void phase_dsa_prep(const Params& p, int l) {
    const int lane = otid() & 63;
    const int wave = (obid() * NTHR + otid()) >> 6, nw = gridDim.x * NTHR / 64;
    const bf16_t* pm = (const bf16_t*)(WS(p) + OFF_PMISC);
    unsigned char* dob = OUTB(p);
    bf16_t* cqn = (bf16_t*)(dob + DO_CQN);
    bf16_t* kv = (bf16_t*)(dob + DO_KV);
    bf16_t* kidx = (bf16_t*)(dob + DO_KIDX);
    float* whead = (float*)(dob + DO_WHEAD);
    const float* ctab = (const float*)(WS(p) + OFF_ROPE);
    const float* stab = ctab + TS * 16;
    const float* qn = p.in[21] + l * 256;
    const float* kvn = p.in[22] + l * 128;
    const float* inw = p.in[27] + l * 64;
    const float* inb = p.in[28] + l * 64;
    const bf16_t* hrow = (const bf16_t*)(WS(p) + OFF_H);
    const bf16_t* wwidx = (const bf16_t*)(WS(p) + OFF_WB) + WB_WIDX;
    const float* rstd_ = (const float*)(WS(p) + OFF_RSTD);
    for (int n = wave; n < NT; n += nw) {
        const int t = n % TS;
        const bf16_t* row = pm + (size_t)n * PM_LD;
        {
            float v[4]; float ss = 0.f;
#pragma unroll
            for (int i = 0; i < 4; ++i) { v[i] = bf2f(row[PM_CQ + lane * 4 + i]); ss += v[i] * v[i]; }
            ss = wave_sum_fast(ss);
            const float rs = rsqrtf(ss * (1.0f / 256.0f) + 1e-6f);
#pragma unroll
            for (int i = 0; i < 4; ++i) cqn[(size_t)n * 256 + lane * 4 + i] = f2bf(v[i] * rs * qn[lane * 4 + i]);
        }
        {
            float v[2]; float ss = 0.f;
#pragma unroll
            for (int i = 0; i < 2; ++i) { v[i] = bf2f(row[PM_CKV + lane * 2 + i]); ss += v[i] * v[i]; }
            ss = wave_sum_fast(ss);
            const float rs = rsqrtf(ss * (1.0f / 128.0f) + 1e-6f);
#pragma unroll
            for (int i = 0; i < 2; ++i) kv[(size_t)n * 160 + lane * 2 + i] = f2bf(v[i] * rs * kvn[lane * 2 + i]);
        }
        if (lane < 16) {
            const float x1 = bf2f(row[PM_KROPE + lane]), x2 = bf2f(row[PM_KROPE + 16 + lane]);
            const float c = ctab[t * 16 + lane], s = stab[t * 16 + lane];
            kv[(size_t)n * 160 + 128 + lane] = f2bf(x1 * c - x2 * s);
            kv[(size_t)n * 160 + 144 + lane] = f2bf(x2 * c + x1 * s);
        }
        {
            const float x = bf2f(row[PM_KIDX + lane]);
            const float mu = wave_sum_fast(x) * (1.0f / 64.0f);
            const float d = x - mu;
            const float var = wave_sum_fast(d * d) * (1.0f / 64.0f);
            const float y = d * rsqrtf(var + 1e-6f) * inw[lane] + inb[lane];
            const float yo = __shfl_xor(y, 16);
            float o = y;
            if (lane < 32) {
                const int i = lane & 15;
                const float c = ctab[t * 16 + i], s = stab[t * 16 + i];
                o = (lane < 16) ? (y * c - yo * s) : (y * c + yo * s);
            }
            kidx[(size_t)n * 64 + lane] = f2bf(o);
        }
        {
            const uint4 hv0 = *(const uint4*)(hrow + (size_t)n * DM + lane * 16), hv1 = *(const uint4*)(hrow + (size_t)n * DM + lane * 16 + 8);
            float hx[16];
            hx[0] = __uint_as_float(hv0.x << 16); hx[1] = __uint_as_float(hv0.x & 0xFFFF0000u); hx[2] = __uint_as_float(hv0.y << 16); hx[3] = __uint_as_float(hv0.y & 0xFFFF0000u);
            hx[4] = __uint_as_float(hv0.z << 16); hx[5] = __uint_as_float(hv0.z & 0xFFFF0000u); hx[6] = __uint_as_float(hv0.w << 16); hx[7] = __uint_as_float(hv0.w & 0xFFFF0000u);
            hx[8] = __uint_as_float(hv1.x << 16); hx[9] = __uint_as_float(hv1.x & 0xFFFF0000u); hx[10] = __uint_as_float(hv1.y << 16); hx[11] = __uint_as_float(hv1.y & 0xFFFF0000u);
            hx[12] = __uint_as_float(hv1.z << 16); hx[13] = __uint_as_float(hv1.z & 0xFFFF0000u); hx[14] = __uint_as_float(hv1.w << 16); hx[15] = __uint_as_float(hv1.w & 0xFFFF0000u);
            float myw = 0.f;
#pragma unroll
            for (int j = 0; j < 8; ++j) {
                const uint4 w0 = *(const uint4*)(wwidx + (size_t)j * DM + lane * 16), w1 = *(const uint4*)(wwidx + (size_t)j * DM + lane * 16 + 8);
                float d = hx[0] * __uint_as_float(w0.x << 16) + hx[1] * __uint_as_float(w0.x & 0xFFFF0000u) + hx[2] * __uint_as_float(w0.y << 16) + hx[3] * __uint_as_float(w0.y & 0xFFFF0000u)
                        + hx[4] * __uint_as_float(w0.z << 16) + hx[5] * __uint_as_float(w0.z & 0xFFFF0000u) + hx[6] * __uint_as_float(w0.w << 16) + hx[7] * __uint_as_float(w0.w & 0xFFFF0000u)
                        + hx[8] * __uint_as_float(w1.x << 16) + hx[9] * __uint_as_float(w1.x & 0xFFFF0000u) + hx[10] * __uint_as_float(w1.y << 16) + hx[11] * __uint_as_float(w1.y & 0xFFFF0000u)
                        + hx[12] * __uint_as_float(w1.z << 16) + hx[13] * __uint_as_float(w1.z & 0xFFFF0000u) + hx[14] * __uint_as_float(w1.w << 16) + hx[15] * __uint_as_float(w1.w & 0xFFFF0000u);
                d = wave_sum_fast(d);
                myw = (lane == j) ? d : myw;
            }
            if (lane < 8) whead[(size_t)n * 8 + lane] = myw * rstd_[n] * 0.04419417382415922f;
        }
    }
}

typedef short s16x4 __attribute__((ext_vector_type(4)));
__device__ __forceinline__ unsigned f2h_bits(float f) { const _Float16 h = (_Float16)f; unsigned short u; __builtin_memcpy(&u, &h, 2); return u; }
template <bool IMPORT_SEL>
__device__ void phase_dsa(const Params& p, int l, unsigned char* lds, bf16_t* yc, const unsigned short* gsel, const int* gnsel, int tb, int te, int tstep) {
    const int tid = otid(), lane = tid & 63, wid = tid >> 6, fr = lane & 15, fq = lane >> 4;
    unsigned short* s_sc = (unsigned short*)lds;
    bf16_t* s_qi = (bf16_t*)(lds + 66048);
    bf16_t* s_Q = (bf16_t*)lds;
    unsigned char* s_Vw = lds + 82432 + wid * 8192;
    bf16_t* s_qn = (bf16_t*)s_Vw;
    unsigned short* s_sel = (unsigned short*)(lds + 82432 + 65536);
    int* s_nsel = (int*)(lds + 82432 + 65536 + 8192);
    unsigned char* dob = OUTB(p);
    const bf16_t* cqn = (const bf16_t*)(dob + DO_CQN);
    const bf16_t* kv = (const bf16_t*)(dob + DO_KV);
    const bf16_t* kidx = (const bf16_t*)(dob + DO_KIDX);
    const float* whead = (const float*)(dob + DO_WHEAD);
    const float* ctab = (const float*)(WS(p) + OFF_ROPE);
    const float* stab = ctab + TS * 16;
    const bf16_t* wb = (const bf16_t*)(WS(p) + OFF_WB);
    const bf16_t* wqiT = wb + WB_QI;
    const bf16_t* wuqT = wb + WB_UQ;
    const bf16_t* wuk = wb + WB_UK;
    const bf16_t* wuvT = wb + WB_UV;
    const float scale = 0.10206207261596575f;
    const f32x4 z4 = {0.f, 0.f, 0.f, 0.f};
    for (int tile = tb; tile < te; tile += tstep) {
        const int qt = 128 - (tile >> 3), b = tile & 7;
        const int t0 = qt * 16;
        const size_t n0 = (size_t)b * TS + t0;
        {
            bf16x8 acq[8];
#pragma unroll
            for (int kk = 0; kk < 8; ++kk) acq[kk] = *(const bf16x8*)(cqn + (n0 + fr) * 256 + kk * 32 + fq * 8);
            f32x4 c[4] = {z4, z4, z4, z4};
#pragma unroll
            for (int kb = 0; kb < 8; kb += 4) {
                bf16x8 bf[4][4];
#pragma unroll
                for (int k4 = 0; k4 < 4; ++k4)
#pragma unroll
                    for (int nt = 0; nt < 4; ++nt) bf[k4][nt] = *(const bf16x8*)(wqiT + (size_t)(wid * 64 + nt * 16 + fr) * 256 + (kb + k4) * 32 + fq * 8);
#pragma unroll
                for (int k4 = 0; k4 < 4; ++k4)
#pragma unroll
                    for (int nt = 0; nt < 4; ++nt) c[nt] = __builtin_amdgcn_mfma_f32_16x16x32_bf16(acq[kb + k4], bf[k4][nt], c[nt], 0, 0, 0);
            }
#pragma unroll
            for (int j = 0; j < 4; ++j) {
                const int t = t0 + fq * 4 + j;
                const float cs = ctab[t * 16 + fr], sn = stab[t * 16 + fr];
                const float x1 = c[0][j], x2 = c[1][j];
                c[0][j] = x1 * cs - x2 * sn; c[1][j] = x2 * cs + x1 * sn;
            }
#pragma unroll
            for (int nt = 0; nt < 4; ++nt)
#pragma unroll
                for (int j = 0; j < 4; ++j) s_qi[(fq * 4 + j) * 512 + wid * 64 + nt * 16 + fr] = f2bf(c[nt][j]);
        }
        __syncthreads();
        if (!IMPORT_SEL) {
            bf16x8 aq[8][2];
#pragma unroll
            for (int h = 0; h < 8; ++h)
#pragma unroll
                for (int ks = 0; ks < 2; ++ks) aq[h][ks] = *(const bf16x8*)(s_qi + fr * 512 + h * 64 + ks * 32 + fq * 8);
            float wh[4][8];
#pragma unroll
            for (int j = 0; j < 4; ++j) {
                const float4 w0 = *(const float4*)(whead + (n0 + fq * 4 + j) * 8), w1 = *(const float4*)(whead + (n0 + fq * 4 + j) * 8 + 4);
                wh[j][0] = w0.x; wh[j][1] = w0.y; wh[j][2] = w0.z; wh[j][3] = w0.w; wh[j][4] = w1.x; wh[j][5] = w1.y; wh[j][6] = w1.z; wh[j][7] = w1.w;
            }
            const int nkt = qt + 1;
            bf16x8 nb0 = {0, 0, 0, 0, 0, 0, 0, 0}, nb1 = nb0;
            if (wid < nkt) { const bf16_t* kr0 = kidx + ((size_t)b * TS + wid * 16 + fr) * 64 + fq * 8; nb0 = *(const bf16x8*)kr0; nb1 = *(const bf16x8*)(kr0 + 32); }
#pragma unroll 1
            for (int kt = wid; kt < nkt; kt += 8) {
                const bf16x8 bk0 = nb0, bk1 = nb1;
                if (kt + 8 < nkt) { const bf16_t* krn = kidx + ((size_t)b * TS + (kt + 8) * 16 + fr) * 64 + fq * 8; nb0 = *(const bf16x8*)krn; nb1 = *(const bf16x8*)(krn + 32); }
                float I[4] = {0.f, 0.f, 0.f, 0.f};
#pragma unroll
                for (int h = 0; h < 8; ++h) {
                    f32x4 a = __builtin_amdgcn_mfma_f32_16x16x32_bf16(aq[h][0], bk0, z4, 0, 0, 0);
                    a = __builtin_amdgcn_mfma_f32_16x16x32_bf16(aq[h][1], bk1, a, 0, 0, 0);
#pragma unroll
                    for (int j = 0; j < 4; ++j) I[j] += wh[j][h] * fmaxf(a[j], 0.f);
                }
#pragma unroll
                for (int j = 0; j < 4; ++j) s_sc[(fq * 4 + j) * 2064 + kt * 16 + fr] = (unsigned short)f2h_bits(I[j]);
            }
        }
        __syncthreads();
#pragma unroll 1
        for (int qi2 = 0; qi2 < 2; ++qi2) {
            const int q = wid + qi2 * 8;
            const int nadm = t0 + q + 1;
            unsigned short* sel = s_sel + q * 256;
            if (IMPORT_SEL) {
                const int ns = gnsel[n0 + q];
                for (int i = lane; i < ns; i += 64) sel[i] = gsel[(n0 + q) * 256 + i];
                if (lane == 0) s_nsel[q] = ns;
            } else if (nadm <= 256) {
                for (int i = lane; i < nadm; i += 64) sel[i] = (unsigned short)i;
                if (lane == 0) s_nsel[q] = nadm;
            } else {
                auto topk = [&](auto nch_tag) {
                    constexpr int NCH = decltype(nch_tag)::value;
                    unsigned key[NCH];
    #pragma unroll
                    for (int c = 0; c < NCH; ++c) {
                        const int s = c * 64 + lane;
                        unsigned k = 0u;
                        if (s < nadm) { const unsigned u = s_sc[q * 2064 + s]; k = (u & 0x8000u) ? (~u & 0xFFFFu) : (u | 0x8000u); }
                        key[c] = k;
                    }
                    unsigned T = 0u;
    #pragma unroll 1
                    for (int bit = 15; bit >= 0; --bit) {
                        const unsigned cand = T | (1u << bit);
                        int cnt = 0;
    #pragma unroll
                        for (int c = 0; c < NCH; ++c) cnt += __popcll(__ballot(key[c] >= cand));
                        if (cnt >= 256) T = cand;
                    }
                    int ngt = 0;
    #pragma unroll
                    for (int c = 0; c < NCH; ++c) ngt += __popcll(__ballot(key[c] > T));
                    const int rties = 256 - ngt;
                    int base = 0, ties = 0;
                    const unsigned long long ltmask = (1ull << lane) - 1ull;
    #pragma unroll
                    for (int c = 0; c < NCH; ++c) {
                        const bool gt = key[c] > T, eq = key[c] == T;
                        const unsigned long long em = __ballot(eq);
                        const int myrank = ties + __popcll(em & ltmask);
                        const bool take = gt || (eq && myrank < rties);
                        const unsigned long long tm = __ballot(take);
                        const int pos = base + __popcll(tm & ltmask);
                        if (take && pos < 256) sel[pos] = (unsigned short)(c * 64 + lane);
                        base += __popcll(tm); ties += __popcll(em);
                    }

                };
                if (nadm <= 512) topk(std::integral_constant<int, 8>{});
                else if (nadm <= 1024) topk(std::integral_constant<int, 16>{});
                else if (nadm <= 1536) topk(std::integral_constant<int, 24>{});
                else topk(std::integral_constant<int, 33>{});
                if (lane == 0) s_nsel[q] = 256;
            }
        }
        __syncthreads();
#pragma unroll 1
        for (int hi = 0; hi < 2; ++hi) {
            const int hh = wid * 2 + hi;
            bf16x8 acq[8];
#pragma unroll
            for (int kk = 0; kk < 8; ++kk) acq[kk] = *(const bf16x8*)(cqn + (n0 + fr) * 256 + kk * 32 + fq * 8);
            f32x4 c6[6] = {z4, z4, z4, z4, z4, z4};
#pragma unroll
            for (int kb = 0; kb < 8; kb += 4) {
                bf16x8 bf[4][6];
#pragma unroll
                for (int k4 = 0; k4 < 4; ++k4)
#pragma unroll
                    for (int nt = 0; nt < 6; ++nt) bf[k4][nt] = *(const bf16x8*)(wuqT + (size_t)(hh * 96 + nt * 16 + fr) * 256 + (kb + k4) * 32 + fq * 8);
#pragma unroll
                for (int k4 = 0; k4 < 4; ++k4)
#pragma unroll
                    for (int nt = 0; nt < 6; ++nt) c6[nt] = __builtin_amdgcn_mfma_f32_16x16x32_bf16(acq[kb + k4], bf[k4][nt], c6[nt], 0, 0, 0);
            }
#pragma unroll
            for (int j = 0; j < 4; ++j) {
                const int q = fq * 4 + j, t = t0 + q;
                const float cs = ctab[t * 16 + fr], sn = stab[t * 16 + fr];
                const float x1 = c6[4][j], x2 = c6[5][j];
                s_Q[(q * 16 + hh) * 160 + 128 + fr] = f2bf(x1 * cs - x2 * sn);
                s_Q[(q * 16 + hh) * 160 + 144 + fr] = f2bf(x2 * cs + x1 * sn);
#pragma unroll
                for (int nt = 0; nt < 4; ++nt) s_qn[q * 64 + nt * 16 + fr] = f2bf(c6[nt][j]);
            }
            __syncthreads();
            bf16x8 an[2];
#pragma unroll
            for (int ks = 0; ks < 2; ++ks) an[ks] = *(const bf16x8*)(s_qn + fr * 64 + ks * 32 + fq * 8);
            bf16x8 bwk[8][2];
#pragma unroll
            for (int nt = 0; nt < 8; ++nt)
#pragma unroll
                for (int ks = 0; ks < 2; ++ks) bwk[nt][ks] = *(const bf16x8*)(wuk + (size_t)(hh * 128 + nt * 16 + fr) * 64 + ks * 32 + fq * 8);
#pragma unroll
            for (int nt = 0; nt < 8; ++nt) {
                f32x4 a = z4;
#pragma unroll
                for (int ks = 0; ks < 2; ++ks)
                    a = __builtin_amdgcn_mfma_f32_16x16x32_bf16(an[ks], bwk[nt][ks], a, 0, 0, 0);
#pragma unroll
                for (int j = 0; j < 4; ++j) s_Q[((fq * 4 + j) * 16 + hh) * 160 + nt * 16 + fr] = f2bf(a[j]);
            }
            __syncthreads();
        }
#pragma unroll 1
        for (int qi2 = 0; qi2 < 2; ++qi2) {
            const int q = wid + qi2 * 8;
            bf16x8 bq[5];
#pragma unroll
            for (int ks = 0; ks < 5; ++ks) bq[ks] = *(const bf16x8*)(s_Q + (q * 16 + fr) * 160 + ks * 32 + fq * 8);
            const int nsel = s_nsel[q];
            const unsigned short* sel = s_sel + q * 256;
            float m = -INFINITY, lsum = 0.f;
            f32x4 O[8] = {z4, z4, z4, z4, z4, z4, z4, z4};
            const int nchunk = (nsel + 31) >> 5;
            bf16x8 akn[2][5];
#pragma unroll
            for (int mt = 0; mt < 2; ++mt) {
                const int ki = mt * 16 + fr;
                const int sidx = sel[ki < nsel ? ki : 0];
                const bf16_t* krow = kv + ((size_t)b * TS + sidx) * 160 + fq * 8;
#pragma unroll
                for (int ks = 0; ks < 5; ++ks) akn[mt][ks] = *(const bf16x8*)(krow + ks * 32);
            }
#pragma unroll 1
            for (int ch = 0; ch < nchunk; ++ch) {
                bf16x8 ak[2][5];
#pragma unroll
                for (int mt = 0; mt < 2; ++mt)
#pragma unroll
                    for (int ks = 0; ks < 5; ++ks) ak[mt][ks] = akn[mt][ks];
                if (ch + 1 < nchunk) {
#pragma unroll
                    for (int mt = 0; mt < 2; ++mt) {
                        const int ki = (ch + 1) * 32 + mt * 16 + fr;
                        const int sidx = sel[ki < nsel ? ki : 0];
                        const bf16_t* krow = kv + ((size_t)b * TS + sidx) * 160 + fq * 8;
#pragma unroll
                        for (int ks = 0; ks < 5; ++ks) akn[mt][ks] = *(const bf16x8*)(krow + ks * 32);
                    }
                }
#pragma unroll
                for (int mt = 0; mt < 2; ++mt)
#pragma unroll
                    for (int ks = 0; ks < 4; ++ks) {
                        const int r = mt * 16 + fr;
                        *(bf16x8*)(s_Vw + r * 256 + (((ks * 2 + (fq >> 1)) ^ (r & 7)) * 32) + (fq & 1) * 16) = ak[mt][ks];
                    }
                f32x4 st[2] = {z4, z4};
#pragma unroll
                for (int mt = 0; mt < 2; ++mt)
#pragma unroll
                    for (int ks = 0; ks < 5; ++ks) st[mt] = __builtin_amdgcn_mfma_f32_16x16x32_bf16(ak[mt][ks], bq[ks], st[mt], 0, 0, 0);
                float sv[2][4]; float cmax = -INFINITY;
#pragma unroll
                for (int mt = 0; mt < 2; ++mt)
#pragma unroll
                    for (int j = 0; j < 4; ++j) {
                        const int ke = ch * 32 + mt * 16 + fq * 4 + j;
                        const float s_ = (ke < nsel) ? st[mt][j] * scale : -INFINITY;
                        sv[mt][j] = s_; cmax = fmaxf(cmax, s_);
                    }
                cmax = fmaxf(cmax, __shfl_xor(cmax, 16)); cmax = fmaxf(cmax, __shfl_xor(cmax, 32));
                const float mnew = fmaxf(m, cmax);
                const float alpha = __expf(m - mnew);
                float psum = 0.f;
#pragma unroll
                for (int mt = 0; mt < 2; ++mt)
#pragma unroll
                    for (int j = 0; j < 4; ++j) { const float pe = __expf(sv[mt][j] - mnew); sv[mt][j] = pe; psum += pe; }
                psum += __shfl_xor(psum, 16); psum += __shfl_xor(psum, 32);
                lsum = lsum * alpha + psum; m = mnew;
#pragma unroll
                for (int ct = 0; ct < 8; ++ct) O[ct] = O[ct] * alpha;
                bf16x8 pf;
#pragma unroll
                for (int mt = 0; mt < 2; ++mt)
#pragma unroll
                    for (int j = 0; j < 4; ++j) pf[mt * 4 + j] = (short)f2bf(sv[mt][j]);
                const int q_ = fr >> 2, p_ = fr & 3;
                const int r0 = fq * 4 + q_, r1 = 16 + r0;
#pragma unroll
                for (int ct = 0; ct < 8; ++ct) {
                    const s16x4 v0 = __builtin_amdgcn_ds_read_tr16_b64_v4i16((__attribute__((address_space(3))) s16x4*)(s_Vw + r0 * 256 + ((ct ^ (r0 & 7)) * 32) + p_ * 8));
                    const s16x4 v1 = __builtin_amdgcn_ds_read_tr16_b64_v4i16((__attribute__((address_space(3))) s16x4*)(s_Vw + r1 * 256 + ((ct ^ (r1 & 7)) * 32) + p_ * 8));
                    bf16x8 av; av[0] = v0[0]; av[1] = v0[1]; av[2] = v0[2]; av[3] = v0[3]; av[4] = v1[0]; av[5] = v1[1]; av[6] = v1[2]; av[7] = v1[3];
                    O[ct] = __builtin_amdgcn_mfma_f32_16x16x32_bf16(av, pf, O[ct], 0, 0, 0);
                }
            }
            const float inv = 1.0f / lsum;
#pragma unroll
            for (int ct = 0; ct < 8; ++ct)
#pragma unroll
                for (int j = 0; j < 4; ++j) s_Q[(q * 16 + fr) * 160 + ct * 16 + fq * 4 + j] = f2bf(O[ct][j] * inv);
        }
        __syncthreads();
#pragma unroll 1
        for (int hi = 0; hi < 2; ++hi) {
            const int hh = wid * 2 + hi;
            bf16x8 ao[4];
#pragma unroll
            for (int ks = 0; ks < 4; ++ks) ao[ks] = *(const bf16x8*)(s_Q + (fr * 16 + hh) * 160 + ks * 32 + fq * 8);
#pragma unroll
            for (int nt = 0; nt < 4; ++nt) {
                f32x4 a = z4;
#pragma unroll
                for (int ks = 0; ks < 4; ++ks)
                    a = __builtin_amdgcn_mfma_f32_16x16x32_bf16(ao[ks], *(const bf16x8*)(wuvT + (size_t)(hh * 64 + nt * 16 + fr) * 128 + ks * 32 + fq * 8), a, 0, 0, 0);
#pragma unroll
                for (int j = 0; j < 4; ++j) yc[(n0 + fq * 4 + j) * 1024 + hh * 64 + nt * 16 + fr] = f2bf(a[j]);
            }
        }
        __syncthreads();
    }
}


__device__ void phase_lr_prep(const Params& p, int l) {
    const int lane = otid() & 63;
    const int wave = (obid() * NTHR + otid()) >> 6, nw = gridDim.x * NTHR / 64;
    const bf16_t* pm = (const bf16_t*)(WS(p) + OFF_PMISC);
    bf16_t* alr = (bf16_t*)(OUTB(p) + DO_ALR);
    const float* mu = p.in[4] + (size_t)l * 3328 + 3072;
    const float* vmu = p.in[18];
    for (int n = wave; n < NT; n += nw) {
        const int t = n % TS;
        for (int c = lane; c < 288; c += 64) {
            const float cur = bf2f(pm[(size_t)n * PM_LD + c]);
            const float prv = (t > 0) ? bf2f(pm[(size_t)(n - 1) * PM_LD + c]) : 0.f;
            const float m_ = (c < 256) ? mu[c] : vmu[c - 256];
            float xs = cur + (prv - cur) * m_;
            if (c < 64) xs = tanhf(xs);
            else if (c >= 128 && c < 256) xs = sigmoidf_(xs);
            alr[(size_t)n * 288 + c] = f2bf(xs);
        }
    }
}

constexpr int SC_TC = 32;
constexpr int SC_ROWB = 1088;
__device__ __forceinline__ const unsigned char* scan_piece_src(const Params& p, int l, int b, int hc, int t0, int pi, bool& ok) {
    const int tau = pi / 68, seg = pi - tau * 68;
    const int t = t0 + tau;
    ok = (t < TS) && (tau < SC_TC);
    const size_t n = (size_t)b * TS + t;
    const unsigned char* ws = WS(p);
    if (seg < 8) return ws + OFF_PR + (n * 1024 + hc) * 2 + seg * 16;
    if (seg < 16) return ws + OFF_PK + (n * 1024 + hc) * 2 + (seg - 8) * 16;
    if (seg < 24) return ws + OFF_PV + (n * 1024 + hc) * 2 + (seg - 16) * 16;
    if (seg < 60) return OUTB(p) + DO_ALR + (n * 288) * 2 + (seg - 24) * 16;
    ok = ok && (l > 0);
    return ws + OFF_VFIRST + (n * 1024 + hc) * 2 + (seg - 60) * 16;
}
__device__ void phase_scan5(const Params& p, int l, unsigned char* lds, int blk) {
    const int tid = otid(), lane = tid & 63, wid = tid >> 6, fr = lane & 15, fq = lane >> 4;
    const int b = blk >> 4, hh = blk & 15, hc = hh * 64;
    float* s_r = (float*)lds;
    float* s_w = s_r + 2048;
    float* s_k = s_w + 2048;
    float* s_v = s_k + 2048;
    float* s_a = s_v + 2048;
    float* s_b = s_a + 2048;
    float* s_g = s_b + 2048;
    float* s_o = s_g + 2048;
    bf16_t* A_wd = (bf16_t*)(s_o + 2048);
    bf16_t* A_ad = A_wd + 2048;
    bf16_t* A_gd = A_ad + 2048;
    bf16_t* A_vd = A_gd + 4096;
    unsigned char* raw = (unsigned char*)(A_vd + 1024);
    float* prevb = (float*)(raw + 32 * SC_ROWB);
    float* cst = prevb + 960;
    const float* mu = p.in[4] + (size_t)l * 3328;
    for (int e = tid; e < 480; e += NTHR) {
        float v;
        if (e < 192) v = mu[(e >> 6) * 1024 + hc + (e & 63)];
        else if (e < 448) v = mu[3072 + (e - 192)];
        else v = p.in[18][e - 448];
        cst[e] = v;
    }
    if (tid < 64) {
        cst[480 + tid] = p.in[7][l * 1024 + hc + tid];
        cst[544 + tid] = p.in[9][l * 1024 + hc + tid];
        cst[608 + tid] = p.in[12][l * 1024 + hc + tid];
        cst[672 + tid] = p.in[13][l * 1024 + hc + tid];
        cst[736 + tid] = p.in[14][l * 1024 + hc + tid];
        cst[800 + tid] = p.in[15][l * 1024 + hc + tid];
        cst[864 + tid] = p.in[16][l * 1024 + hc + tid];
        cst[928 + tid] = p.in[19][hc + tid];
    }
    const int mm = wid >> 1, ntb = (wid & 1) * 2;
    const int nks = (mm == 2) ? 4 : (mm == 3 ? 1 : 2);
    bf16x8 Bw[2][4];
    {
        const float* wsrc = (mm == 0) ? p.in[8] + (size_t)l * 64 * 1024 : (mm == 1) ? p.in[10] + (size_t)l * 64 * 1024 : (mm == 2) ? p.in[11] + (size_t)l * 128 * 1024 : p.in[20];
#pragma unroll
        for (int n2 = 0; n2 < 2; ++n2)
#pragma unroll
            for (int ks = 0; ks < 4; ++ks) {
                bf16x8 f;
#pragma unroll
                for (int j = 0; j < 8; ++j) {
                    const bool okw = ks < nks && (mm < 3 || l > 0);
                    const float v = wsrc[(size_t)(okw ? (ks * 32 + fq * 8 + j) : 0) * 1024 + hc + (ntb + n2) * 16 + fr];
                    f[j] = (short)f2bf(okw ? v : 0.f);
                }
                Bw[n2][ks] = f;
            }
    }
    const int cg = lane & 15, rg = lane >> 4;
    float S[8] = {0.f, 0.f, 0.f, 0.f, 0.f, 0.f, 0.f, 0.f};
    bf16_t* Pr = (bf16_t*)(WS(p) + OFF_PR);
    bf16_t* vfirst = (bf16_t*)(WS(p) + OFF_VFIRST);
    const unsigned char* psrc[5]; int pstep[5], ptau[5]; bool pval[5];
#pragma unroll
    for (int k = 0; k < 5; ++k) {
        const int pi = tid + k * NTHR;
        bool ok = false;
        psrc[k] = scan_piece_src(p, l, b, hc, 0, pi < SC_TC * 68 ? pi : 0, ok);
        const int tau = (pi < SC_TC * 68 ? pi : 0) / 68, seg = (pi < SC_TC * 68 ? pi : 0) - tau * 68;
        ptau[k] = tau;
        pstep[k] = SC_TC * ((seg >= 24 && seg < 60) ? 576 : 2048);
        pval[k] = (pi < SC_TC * 68) && !(seg >= 60 && l == 0);
    }
    uint4 pre[5];
#pragma unroll
    for (int k = 0; k < 5; ++k) { pre[k] = make_uint4(0, 0, 0, 0); if (pval[k] && ptau[k] < TS) pre[k] = *(const uint4*)psrc[k]; }
    __syncthreads();
#pragma unroll 1
    for (int t0 = 0, ch = 0; t0 < TS; t0 += SC_TC, ++ch) {
        const int nval = (TS - t0 < SC_TC) ? (TS - t0) : SC_TC;
#pragma unroll
        for (int k = 0; k < 5; ++k) { const int pi = tid + k * NTHR; if (pi < SC_TC * 68) *(uint4*)(raw + pi * 16) = pre[k]; }
        lds_barrier();
#pragma unroll
        for (int k = 0; k < 5; ++k) {
            pre[k] = make_uint4(0, 0, 0, 0);
            if (pval[k] && t0 + SC_TC + ptau[k] < TS) pre[k] = *(const uint4*)(psrc[k] + (size_t)(ch + 1) * pstep[k]);
        }
        {
            float* pwb = prevb + (ch & 1) * 192;
            const float* pvb = prevb + ((ch + 1) & 1) * 192;
            for (int it = tid; it < SC_TC * 96; it += NTHR) {
                const int tau = it / 96, c2 = (it - tau * 96) * 2;
                const unsigned cu = *(const unsigned*)(raw + tau * SC_ROWB + c2 * 2);
                const float c0 = __uint_as_float(cu << 16), c1 = __uint_as_float(cu & 0xFFFF0000u);
                float p0, p1;
                if (tau > 0) { const unsigned pu = *(const unsigned*)(raw + (tau - 1) * SC_ROWB + c2 * 2); p0 = __uint_as_float(pu << 16); p1 = __uint_as_float(pu & 0xFFFF0000u); }
                else if (t0 > 0) { p0 = pvb[c2]; p1 = pvb[c2 + 1]; }
                else { p0 = 0.f; p1 = 0.f; }
                if (tau == SC_TC - 1) { pwb[c2] = c0; pwb[c2 + 1] = c1; }
                const float x0 = c0 + (p0 - c0) * cst[c2], x1 = c1 + (p1 - c1) * cst[c2 + 1];
                float* dstv = (c2 < 64) ? (s_r + tau * 64 + c2) : (c2 < 128) ? (s_k + tau * 64 + c2 - 64) : (s_v + tau * 64 + c2 - 128);
                *(float2*)dstv = make_float2(x0, x1);
            }
        }
        if (mm < 3 || l > 0) {
            const unsigned char* Ab = raw + ((mm == 0) ? 384 : (mm == 1) ? 512 : (mm == 2) ? 640 : 896);
            float* dst = (mm == 0) ? s_w : (mm == 1) ? s_a : (mm == 2) ? s_g : s_o;
#pragma unroll
            for (int m = 0; m < 2; ++m) {
                f32x4 acc0 = {0.f, 0.f, 0.f, 0.f}, acc1 = {0.f, 0.f, 0.f, 0.f};
#pragma unroll
                for (int ks = 0; ks < 4; ++ks) {
                    if (ks < nks) {
                        const bf16x8 a = *(const bf16x8*)(Ab + (m * 16 + fr) * SC_ROWB + ks * 64 + fq * 16);
                        acc0 = __builtin_amdgcn_mfma_f32_16x16x32_bf16(a, Bw[0][ks], acc0, 0, 0, 0);
                        acc1 = __builtin_amdgcn_mfma_f32_16x16x32_bf16(a, Bw[1][ks], acc1, 0, 0, 0);
                    }
                }
#pragma unroll
                for (int j = 0; j < 4; ++j) {
                    dst[(m * 16 + fq * 4 + j) * 64 + ntb * 16 + fr] = acc0[j];
                    dst[(m * 16 + fq * 4 + j) * 64 + (ntb + 1) * 16 + fr] = acc1[j];
                }
            }
        }
        lds_barrier();
        {
            const int tau = tid >> 4, c4 = (tid & 15) * 4, e = tau * 64 + c4, t = t0 + tau;
            const size_t n = (size_t)b * TS + t;
            const float4 xw4 = *(const float4*)(s_w + e), xa4 = *(const float4*)(s_a + e), kr4 = *(const float4*)(s_k + e);
            float4 vv4 = *(const float4*)(s_v + e);
            const float4 cw = *(const float4*)(cst + 480 + c4), ca = *(const float4*)(cst + 544 + c4), ckk = *(const float4*)(cst + 608 + c4), cka = *(const float4*)(cst + 672 + c4);
            const float xw[4] = {xw4.x + cw.x, xw4.y + cw.y, xw4.z + cw.z, xw4.w + cw.w};
            const float xa[4] = {xa4.x + ca.x, xa4.y + ca.y, xa4.z + ca.z, xa4.w + ca.w};
            const float kr[4] = {kr4.x, kr4.y, kr4.z, kr4.w};
            const float kkc[4] = {ckk.x, ckk.y, ckk.z, ckk.w}, kac[4] = {cka.x, cka.y, cka.z, cka.w};
            float vv[4] = {vv4.x, vv4.y, vv4.z, vv4.w};
            if (l > 0) {
                const float4 xv4 = *(const float4*)(s_o + e), cv = *(const float4*)(cst + 928 + c4);
                const uint2 vfu = *(const uint2*)(raw + tau * SC_ROWB + 960 + c4 * 2);
                const float vf[4] = {__uint_as_float(vfu.x << 16), __uint_as_float(vfu.x & 0xFFFF0000u), __uint_as_float(vfu.y << 16), __uint_as_float(vfu.y & 0xFFFF0000u)};
                const float xv[4] = {xv4.x + cv.x, xv4.y + cv.y, xv4.z + cv.z, xv4.w + cv.w};
#pragma unroll
                for (int j = 0; j < 4; ++j) vv[j] = vv[j] + (vf[j] - vv[j]) * fast_sigmoid(xv[j]);
            } else if (t < TS) {
                *(uint2*)(vfirst + n * 1024 + hc + c4) = pack4(vv[0], vv[1], vv[2], vv[3]);
            }
            float dec[4], av[4], kkv[4]; float ss = 0.f;
#pragma unroll
            for (int j = 0; j < 4; ++j) {
                dec[j] = __expf(-0.6065306597126334f * fast_sigmoid(xw[j]));
                av[j] = fast_sigmoid(xa[j]);
                kkv[j] = kr[j] * kkc[j];
                ss += kkv[j] * kkv[j];
            }
            ss = row16_sum(ss);
            const float rn = rsqrtf(fmaxf(ss, 1e-24f));
            float kk[4];
#pragma unroll
            for (int j = 0; j < 4; ++j) kk[j] = kkv[j] * rn;
            *(float4*)(s_w + e) = make_float4(dec[0], dec[1], dec[2], dec[3]);
            *(float4*)(s_a + e) = make_float4(-kk[0], -kk[1], -kk[2], -kk[3]);
            *(float4*)(s_b + e) = make_float4(kk[0] * av[0], kk[1] * av[1], kk[2] * av[2], kk[3] * av[3]);
            *(float4*)(s_k + e) = make_float4(kr[0] * (1.0f + (av[0] - 1.0f) * kac[0]), kr[1] * (1.0f + (av[1] - 1.0f) * kac[1]), kr[2] * (1.0f + (av[2] - 1.0f) * kac[2]), kr[3] * (1.0f + (av[3] - 1.0f) * kac[3]));
            *(float4*)(s_v + e) = make_float4(vv[0], vv[1], vv[2], vv[3]);
        }
        lds_barrier();
        {
            struct VS { float4 w0, w1, b0, b1, k0, k1, r0, r1, a0, a1; float v; };
            VS X, Y;
            const int i_ = tid >> 3, c8 = (tid & 7) * 8;
            auto ld = [&](VS& N, int tn, int tn2) {
                N.a0 = *(const float4*)(s_a + tn2 * 64 + c8); N.a1 = *(const float4*)(s_a + tn2 * 64 + c8 + 4);
                N.w0 = *(const float4*)(s_w + tn * 64 + c8); N.w1 = *(const float4*)(s_w + tn * 64 + c8 + 4);
                N.b0 = *(const float4*)(s_b + tn * 64 + c8); N.b1 = *(const float4*)(s_b + tn * 64 + c8 + 4);
                N.k0 = *(const float4*)(s_k + tn * 64 + c8); N.k1 = *(const float4*)(s_k + tn * 64 + c8 + 4);
                N.r0 = *(const float4*)(s_r + tn * 64 + c8); N.r1 = *(const float4*)(s_r + tn * 64 + c8 + 4);
                N.v = s_v[tn * 64 + i_];
            };
            float sa;
            {
                const float4 a0 = *(const float4*)(s_a + c8), a1 = *(const float4*)(s_a + c8 + 4);
                sa = S[0] * a0.x + S[1] * a0.y + S[2] * a0.z + S[3] * a0.w + S[4] * a1.x + S[5] * a1.y + S[6] * a1.z + S[7] * a1.w;
                float du = 0.f;
                row8_sum2(sa, du);
            }
            ld(X, 0, 1);
            auto step = [&](VS& C, VS& N, int tau) {
                const int tn = (tau + 1 < SC_TC) ? tau + 1 : tau, tn2 = (tau + 2 < SC_TC) ? tau + 2 : tau;
                ld(N, tn, tn2);
                const float vi = C.v;
                S[0] = S[0] * C.w0.x + (sa * C.b0.x + vi * C.k0.x); S[1] = S[1] * C.w0.y + (sa * C.b0.y + vi * C.k0.y);
                S[2] = S[2] * C.w0.z + (sa * C.b0.z + vi * C.k0.z); S[3] = S[3] * C.w0.w + (sa * C.b0.w + vi * C.k0.w);
                S[4] = S[4] * C.w1.x + (sa * C.b1.x + vi * C.k1.x); S[5] = S[5] * C.w1.y + (sa * C.b1.y + vi * C.k1.y);
                S[6] = S[6] * C.w1.z + (sa * C.b1.z + vi * C.k1.z); S[7] = S[7] * C.w1.w + (sa * C.b1.w + vi * C.k1.w);
                float o = S[0] * C.r0.x + S[1] * C.r0.y + S[2] * C.r0.z + S[3] * C.r0.w + S[4] * C.r1.x + S[5] * C.r1.y + S[6] * C.r1.z + S[7] * C.r1.w;
                sa = S[0] * C.a0.x + S[1] * C.a0.y + S[2] * C.a0.z + S[3] * C.a0.w + S[4] * C.a1.x + S[5] * C.a1.y + S[6] * C.a1.z + S[7] * C.a1.w;
                row8_sum2(sa, o);
                if ((tid & 7) == 0) s_o[tau * 64 + i_] = o;
            };
#pragma unroll 1
            for (int tau = 0; tau < nval; tau += 2) { step(X, Y, tau); step(Y, X, tau + 1); }
        }
        lds_barrier();
        {
            const int tau = tid >> 4, c4 = (tid & 15) * 4, e = tau * 64 + c4;
            const size_t n = (size_t)b * TS + t0 + tau;
            const float4 o4 = *(const float4*)(s_o + e), r4_ = *(const float4*)(s_r + e), k4_ = *(const float4*)(s_k + e), v4_ = *(const float4*)(s_v + e), g4_ = *(const float4*)(s_g + e);
            const float4 crk = *(const float4*)(cst + 736 + c4), clw = *(const float4*)(cst + 800 + c4), clb = *(const float4*)(cst + 864 + c4);
            float osum = (o4.x + o4.y) + (o4.z + o4.w);
            float bsum = r4_.x * k4_.x * crk.x + r4_.y * k4_.y * crk.y + r4_.z * k4_.z * crk.z + r4_.w * k4_.w * crk.w;
            float du0 = 0.f, du1 = 0.f;
            row16_sum4(osum, bsum, du0, du1);
            const float m_ = osum * (1.0f / 64.0f);
            const float d0 = o4.x - m_, d1 = o4.y - m_, d2 = o4.z - m_, d3 = o4.w - m_;
            const float var = row16_sum(d0 * d0 + d1 * d1 + d2 * d2 + d3 * d3) * (1.0f / 64.0f);
            const float rs = rsqrtf(var + 64e-5f);
            const float y0 = (d0 * rs * clw.x + clb.x + bsum * v4_.x) * g4_.x, y1 = (d1 * rs * clw.y + clb.y + bsum * v4_.y) * g4_.y;
            const float y2 = (d2 * rs * clw.z + clb.z + bsum * v4_.z) * g4_.z, y3 = (d3 * rs * clw.w + clb.w + bsum * v4_.w) * g4_.w;
            if (tau < nval) *(uint2*)(Pr + n * 1024 + hc + c4) = pack4(y0, y1, y2, y3);
        }
    }
}

__device__ __forceinline__ void xcd_panel_map(int& mt0, int& mstep, int& nt) {
    const int b = obid(), G = (int)gridDim.x;
    if (G == 256) { nt = (b >> 3) & 7; mt0 = (b & 7) * 4 + (b >> 6); mstep = 32; }
    else { nt = b & 7; mt0 = b >> 3; mstep = G >> 3; }
}
__device__ void phase_merge(const Params& p, unsigned char* lds) {
    const int tid = otid(), lane = tid & 63, wid = tid >> 6, wr = wid >> 1, wc = wid & 1, fr = lane & 15, fq = lane >> 4;
    const bf16_t* h = (const bf16_t*)(WS(p) + OFF_H);
    const bf16_t* wb = (const bf16_t*)(WS(p) + OFF_WB);
    const float* rstd = (const float*)(WS(p) + OFF_RSTD);
    bf16_t* merged = (bf16_t*)(WS(p) + OFF_MERGED);
    const bf16_t* ysrc0 = (const bf16_t*)(WS(p) + OFF_PPOOL);
    const bf16_t* ysrc1 = (const bf16_t*)(WS(p) + OFF_PR);
    const bf16_t* ysrc2 = (const bf16_t*)(OUTB(p) + DO_YC);
    for (int tile = obid(); tile < 86 * 8; tile += gridDim.x) {
        const int mt = tile >> 3, nt = tile & 7;
        const int row0 = mt * 192, col0 = nt * 128;
        uint2 maccp[3][4];
#pragma unroll
        for (int m = 0; m < 3; ++m)
#pragma unroll
            for (int n = 0; n < 4; ++n) maccp[m][n] = make_uint2(0u, 0u);
#pragma unroll 1
        for (int i = 0; i < 3; ++i) {
            const bf16_t* ys = (i == 0) ? ysrc0 : (i == 1 ? ysrc1 : ysrc2);
            uint2 sg[3][4];
            {
                f32x4 ag[3][4]; g3_zero<3>(ag);
                G3<192> g;
                g3_setup<192>(g, [&](int r) { return h + (size_t)(row0 + r) * DM; }, [&](int r) { return wb + WB_WG + (size_t)(i * 1024 + col0 + r) * DM; }, tid);
                g3_kloop<192>(ag, g, DM, lds);
#pragma unroll
                for (int m = 0; m < 3; ++m) {
                    const float rs = rstd[row0 + wr * 48 + m * 16 + fr];
#pragma unroll
                    for (int n = 0; n < 4; ++n) sg[m][n] = pack4(fast_sigmoid(ag[m][n][0] * rs), fast_sigmoid(ag[m][n][1] * rs), fast_sigmoid(ag[m][n][2] * rs), fast_sigmoid(ag[m][n][3] * rs));
                }
            }
            {
                f32x4 ay[3][4]; g3_zero<3>(ay);
                G3<192> g;
                g3_setup<192>(g, [&](int r) { return ys + (size_t)(row0 + r) * DM; }, [&](int r) { return wb + WB_PA + (size_t)(i * 1024 + col0 + r) * DM; }, tid);
                g3_kloop<192>(ay, g, DM, lds);
#pragma unroll
                for (int m = 0; m < 3; ++m)
#pragma unroll
                    for (int n = 0; n < 4; ++n) {
                        const float m0 = __uint_as_float(maccp[m][n].x << 16) + __uint_as_float(sg[m][n].x << 16) * ay[m][n][0];
                        const float m1 = __uint_as_float(maccp[m][n].x & 0xFFFF0000u) + __uint_as_float(sg[m][n].x & 0xFFFF0000u) * ay[m][n][1];
                        const float m2 = __uint_as_float(maccp[m][n].y << 16) + __uint_as_float(sg[m][n].y << 16) * ay[m][n][2];
                        const float m3 = __uint_as_float(maccp[m][n].y & 0xFFFF0000u) + __uint_as_float(sg[m][n].y & 0xFFFF0000u) * ay[m][n][3];
                        maccp[m][n] = pack4(m0, m1, m2, m3);
                    }
            }
        }
#pragma unroll
        for (int m = 0; m < 3; ++m) {
            const int row = row0 + wr * 48 + m * 16 + fr;
#pragma unroll
            for (int n = 0; n < 4; ++n)
                *(uint2*)(merged + (size_t)row * 1024 + col0 + wc * 64 + n * 16 + fq * 4) = maccp[m][n];
        }
    }
}

__device__ void phase_outproj(const Params& p, unsigned char* lds) {
    const int tid = otid(), lane = tid & 63, wid = tid >> 6, wr = wid >> 1, wc = wid & 1, fr = lane & 15, fq = lane >> 4;
    const bf16_t* h = (const bf16_t*)(WS(p) + OFF_H);
    const bf16_t* wb = (const bf16_t*)(WS(p) + OFF_WB);
    const bf16_t* merged = (const bf16_t*)(WS(p) + OFF_MERGED);
    float* hm = (float*)(WS(p) + OFF_HM32);
    int mt0, mstep, nt;
    xcd_panel_map(mt0, mstep, nt);
    for (int mt = mt0; mt < 86; mt += mstep) {
        const int row0 = mt * 192, col0 = nt * 128;
        G3<192> g;
        g3_setup<192>(g, [&](int r) { return merged + (size_t)(row0 + r) * DM; }, [&](int r) { return wb + WB_WO + (size_t)(col0 + r) * DM; }, tid);
        f32x4 acc[3][4]; g3_zero<3>(acc);
        g3_kloop<192>(acc, g, DM, lds);
#pragma unroll
        for (int m = 0; m < 3; ++m) {
            const int row = row0 + wr * 48 + m * 16 + fr;
#pragma unroll
            for (int n = 0; n < 4; ++n) {
                const int col = col0 + wc * 64 + n * 16 + fq * 4;
                const uint2 hv = *(const uint2*)(h + (size_t)row * 1024 + col);
                float4 o;
                o.x = __uint_as_float(hv.x << 16) + acc[m][n][0]; o.y = __uint_as_float(hv.x & 0xFFFF0000u) + acc[m][n][1];
                o.z = __uint_as_float(hv.y << 16) + acc[m][n][2]; o.w = __uint_as_float(hv.y & 0xFFFF0000u) + acc[m][n][3];
                *(float4*)(hm + (size_t)row * 1024 + col) = o;
            }
        }
    }
}

__device__ __constant__ int c_pair_lo[6] = {0, 0, 0, 1, 1, 2};
__device__ __constant__ int c_pair_hi[6] = {1, 2, 3, 2, 3, 3};
__device__ void phase_route(const Params& p, int l, unsigned char* lds) {
    const int tid = otid(), lane = tid & 63, wid = tid >> 6;
    const int per = (NT + (int)gridDim.x - 1) / (int)gridDim.x;
    const int nbeg = obid() * per, nend = (nbeg + per < NT) ? nbeg + per : NT;
    int* s_cls = (int*)lds;
    int* s_base = s_cls + 512;
    float* s_wr = (float*)(lds + 4096);
    const float* hm = (const float*)(WS(p) + OFF_HM32);
    bf16_t* hn = (bf16_t*)(WS(p) + OFF_HN);
    const float* nf = p.in[33] + (size_t)l * 1024;
    const float* wg = p.in[34] + (size_t)l * 1024 * 4;
    const float* bg = p.in[35] + l * 4;
    const float* we = p.in[36] + (size_t)l * 1024 * 16;
    const float* be = p.in[37] + l * 16;
    int* cnt = (int*)(WS(p) + OFF_CTL);
    int* list = (int*)(WS(p) + OFF_LIST);
    float* pw = (float*)(WS(p) + OFF_PW);
    for (int e = tid; e < 1024 * 20; e += NTHR) {
        const int k = e / 20, c = e - k * 20;
        s_wr[c * 1024 + k] = (c < 4) ? wg[(size_t)k * 4 + c] : we[(size_t)k * 16 + (c - 4)];
    }
    __syncthreads();
    for (int n = nbeg + wid; n < nend; n += 8) {
        float ss = 0.f;
#pragma unroll
        for (int i = 0; i < 4; ++i) {
            const float4 v = *(const float4*)(hm + (size_t)n * DM + i * 256 + lane * 4);
            ss += v.x * v.x + v.y * v.y + v.z * v.z + v.w * v.w;
        }
        ss = wave_sum(ss);
        const float rs = rsqrtf(ss * (1.0f / 1024.0f) + 1e-6f);
        float lg[4] = {0.f, 0.f, 0.f, 0.f};
        float le[16];
#pragma unroll
        for (int e = 0; e < 16; ++e) le[e] = 0.f;
#pragma unroll 1
        for (int i = 0; i < 4; ++i) {
            const float4 xv = *(const float4*)(hm + (size_t)n * DM + i * 256 + lane * 4);
            const float4 nv = *(const float4*)(nf + i * 256 + lane * 4);
            float y[4] = {xv.x * rs * nv.x, xv.y * rs * nv.y, xv.z * rs * nv.z, xv.w * rs * nv.w};
            {
                const int d0 = i * 256 + lane * 4;
#pragma unroll
                for (int g = 0; g < 4; ++g) { const float4 w4 = *(const float4*)(s_wr + g * 1024 + d0); lg[g] += y[0] * w4.x + y[1] * w4.y + y[2] * w4.z + y[3] * w4.w; }
#pragma unroll
                for (int e = 0; e < 16; ++e) { const float4 w4 = *(const float4*)(s_wr + (4 + e) * 1024 + d0); le[e] += y[0] * w4.x + y[1] * w4.y + y[2] * w4.z + y[3] * w4.w; }
            }
            ushort4 o;
            o.x = f2bf(y[0]); o.y = f2bf(y[1]); o.z = f2bf(y[2]); o.w = f2bf(y[3]);
            *(ushort4*)(hn + (size_t)n * DM + i * 256 + lane * 4) = o;
        }
#pragma unroll
        for (int g = 0; g < 4; ++g) lg[g] = wave_sum_fast(lg[g]) + bg[g];
#pragma unroll
        for (int e = 0; e < 16; ++e) le[e] = wave_sum_fast(le[e]) + be[e];
        if (lane == 0) {
            int gs = 0; float gm = lg[0];
#pragma unroll
            for (int g = 1; g < 4; ++g) if (lg[g] > gm) { gm = lg[g]; gs = g; }
            float den = 0.f;
#pragma unroll
            for (int g = 0; g < 4; ++g) den += __expf(lg[g] - gm);
            const float pgrp = 1.0f / den;
            float v4[4];
#pragma unroll
            for (int e = 0; e < 4; ++e) {
                const float m0 = (gs == 0) ? 1.f : 0.f, m1s = (gs == 1) ? 1.f : 0.f, m2s = (gs == 2) ? 1.f : 0.f, m3s = (gs == 3) ? 1.f : 0.f;
                v4[e] = le[e] * m0 + le[4 + e] * m1s + le[8 + e] * m2s + le[12 + e] * m3s;
            }
            int i1 = 0; float m1 = v4[0];
#pragma unroll
            for (int e = 1; e < 4; ++e) if (v4[e] > m1) { m1 = v4[e]; i1 = e; }
            int i2 = -1; float m2 = -INFINITY;
#pragma unroll
            for (int e = 0; e < 4; ++e) if (e != i1 && v4[e] > m2) { m2 = v4[e]; i2 = e; }
            const float e2 = __expf(m2 - m1);
            const float p1 = pgrp / (1.0f + e2), p2 = pgrp * e2 / (1.0f + e2);
            const int lo = i1 < i2 ? i1 : i2, hi = i1 < i2 ? i2 : i1;
            const float plo = i1 < i2 ? p1 : p2, phi = i1 < i2 ? p2 : p1;
            const int pi = (lo == 0) ? (hi - 1) : (lo == 1 ? hi + 1 : 5);
            const int cls = gs * 6 + pi;
            s_cls[n - nbeg] = cls;
            pw[(size_t)n * 2 + 0] = plo; pw[(size_t)n * 2 + 1] = phi;
        }
    }
    __syncthreads();
    const int nloc = nend - nbeg;
    if (tid < 24) {
        int c_ = 0;
        for (int i = 0; i < nloc; ++i) c_ += (s_cls[i] == tid) ? 1 : 0;
        s_base[tid] = c_ ? atomicAdd(&cnt[tid * 32], c_) : 0;
    }
    __syncthreads();
    for (int it = tid; it < nloc; it += NTHR) {
        const int cls = s_cls[it];
        int rank = 0;
        for (int i = 0; i < it; ++i) rank += (s_cls[i] == cls) ? 1 : 0;
        list[(size_t)cls * NT + s_base[cls] + rank] = nbeg + it;
    }
    __syncthreads();
}


struct MoeTile { int cls, ti, cnt, tg; };
__device__ __forceinline__ int moe_total_tiles(const int* cnt) { int s = 0; for (int c = 0; c < 24; ++c) s += (cnt[c * 32] + 127) >> 7; return s; }
__device__ __forceinline__ MoeTile moe_find(const int* cnt, int tile) {
    MoeTile r; int s = 0; r.cls = 0; r.ti = 0; r.cnt = 0; r.tg = tile;
    for (int c = 0; c < 24; ++c) { const int nt = (cnt[c * 32] + 127) >> 7; if (tile >= s && tile < s + nt) { r.cls = c; r.ti = tile - s; r.cnt = cnt[c * 32]; } s += nt; }
    return r;
}
__device__ void phase_moe1(const Params& p, unsigned char* lds) {
    const int tid = otid(), lane = tid & 63, wid = tid >> 6, wr = wid >> 1, wc = wid & 1, fr = lane & 15, fq = lane >> 4;
    const int* cnt = (const int*)(WS(p) + OFF_CTL);
    const int* list = (const int*)(WS(p) + OFF_LIST);
    const float* pw = (const float*)(WS(p) + OFF_PW);
    const bf16_t* hn = (const bf16_t*)(WS(p) + OFF_HN);
    const bf16_t* we = (const bf16_t*)(WS(p) + OFF_WEXP);
    bf16_t* hid = (bf16_t*)(OUTB(p) + DO_HID);
    const int total = moe_total_tiles(cnt);
    for (int item = obid(); item < total * 4; item += gridDim.x) {
        const MoeTile mt = moe_find(cnt, item >> 2);
        const int nt = item & 3, slot = nt >> 1, f0 = (nt & 1) * 128;
        const int g_ = mt.cls / 6, pi = mt.cls % 6;
        const int e = g_ * 4 + (slot == 0 ? c_pair_lo[pi] : c_pair_hi[pi]);
        const int* lst = list + (size_t)mt.cls * NT + mt.ti * 128;
        const int nvalid = min(128, mt.cnt - mt.ti * 128);
        f32x4 a1[2][4], a3[2][4]; g3_zero<2>(a1); g3_zero<2>(a3);
        G3D g;
#pragma unroll
        for (int i = 0; i < 2; ++i) {
            const int idx = tid + i * NTHR, row = idx >> 3, sl = (idx & 7) ^ (row & 7);
            g.ap[i] = hn + (size_t)lst[row < nvalid ? row : 0] * DM + sl * 8;
            g.b1[i] = we + WE_W1 + ((size_t)e * 256 + f0 + row) * 1024 + sl * 8;
            g.b3[i] = we + WE_W3 + ((size_t)e * 256 + f0 + row) * 1024 + sl * 8;
        }
        g3d_kloop(a1, a3, g, DM, lds);
#pragma unroll
        for (int m = 0; m < 2; ++m) {
            const int lr = wr * 32 + m * 16 + fr;
            const int tk = lst[lr < nvalid ? lr : 0];
            const float pe = pw[(size_t)tk * 2 + slot];
#pragma unroll
            for (int n = 0; n < 4; ++n) {
                const int col = slot * 256 + f0 + wc * 64 + n * 16 + fq * 4;
                float o[4];
#pragma unroll
                for (int j = 0; j < 4; ++j) { const float x1 = a1[m][n][j]; o[j] = x1 * sigmoidf_(x1) * a3[m][n][j] * pe; }
                *(uint2*)(hid + ((size_t)mt.tg * 128 + lr) * 512 + col) = pack4(o[0], o[1], o[2], o[3]);
            }
        }
    }
}
__device__ void phase_moe2(const Params& p, unsigned char* lds) {
    const int tid = otid(), lane = tid & 63, wid = tid >> 6, wr = wid >> 1, wc = wid & 1, fr = lane & 15, fq = lane >> 4;
    const int* cnt = (const int*)(WS(p) + OFF_CTL);
    const int* list = (const int*)(WS(p) + OFF_LIST);
    const bf16_t* we = (const bf16_t*)(WS(p) + OFF_WEXP);
    const bf16_t* hid = (const bf16_t*)(OUTB(p) + DO_HID);
    float* hm = (float*)(WS(p) + OFF_HM32);
    bf16_t* h = (bf16_t*)(WS(p) + OFF_H);
    const int total = moe_total_tiles(cnt);
    for (int item = obid(); item < total * 8; item += gridDim.x) {
        const MoeTile mt = moe_find(cnt, item >> 3);
        const int nt = item & 7, col0 = nt * 128;
        const int g_ = mt.cls / 6, pi = mt.cls % 6;
        const int elo = g_ * 4 + c_pair_lo[pi], ehi = g_ * 4 + c_pair_hi[pi];
        const int* lst = list + (size_t)mt.cls * NT + mt.ti * 128;
        const int nvalid = min(128, mt.cnt - mt.ti * 128);
        f32x4 acc[2][4]; g3_zero<2>(acc);
        G3<128> g;
        g3_setup<128>(g, [&](int r) { return hid + ((size_t)mt.tg * 128 + r) * 512; }, [&](int r) { return we + WE_W2 + ((size_t)elo * 1024 + col0 + r) * 256; }, tid);
        g3_kloop<128>(acc, g, 256, lds);
        g3_setup<128>(g, [&](int r) { return hid + ((size_t)mt.tg * 128 + r) * 512 + 256; }, [&](int r) { return we + WE_W2 + ((size_t)ehi * 1024 + col0 + r) * 256; }, tid);
        g3_kloop<128>(acc, g, 256, lds);
#pragma unroll
        for (int m = 0; m < 2; ++m) {
            const int lr = wr * 32 + m * 16 + fr;
            if (lr < nvalid) {
                const int tk = lst[lr];
#pragma unroll
                for (int n = 0; n < 4; ++n) {
                    const int col = col0 + wc * 64 + n * 16 + fq * 4;
                    float4 v = *(const float4*)(hm + (size_t)tk * 1024 + col);
                    v.x += acc[m][n][0]; v.y += acc[m][n][1]; v.z += acc[m][n][2]; v.w += acc[m][n][3];
                    *(float4*)(hm + (size_t)tk * 1024 + col) = v;
                    *(uint2*)(h + (size_t)tk * 1024 + col) = pack4(v.x, v.y, v.z, v.w);
                }
            }
        }
    }
}

__device__ void phase_final(const Params& p) {
    const int lane = otid() & 63;
    const int wave = (obid() * NTHR + otid()) >> 6, nw = gridDim.x * NTHR / 64;
    const float* hm = (const float*)(WS(p) + OFF_HM32);
    const float* nf = p.in[41];
    for (int r = wave; r < NB * SEQ; r += nw) {
        const int b = r / SEQ, s = r % SEQ;
        const size_t n = (size_t)b * TS + NMETA + s;
        float4 v[4]; float ss = 0.f;
#pragma unroll
        for (int i = 0; i < 4; ++i) { v[i] = *(const float4*)(hm + n * DM + i * 256 + lane * 4); ss += v[i].x * v[i].x + v[i].y * v[i].y + v[i].z * v[i].z + v[i].w * v[i].w; }
        ss = wave_sum(ss);
        const float rs = rsqrtf(ss * (1.0f / 1024.0f) + 1e-6f);
#pragma unroll
        for (int i = 0; i < 4; ++i) {
            const float4 g = *(const float4*)(nf + i * 256 + lane * 4);
            float4 o; o.x = v[i].x * rs * g.x; o.y = v[i].y * rs * g.y; o.z = v[i].z * rs * g.z; o.w = v[i].w * rs * g.w;
            *(float4*)((float*)OUTB(p) + (size_t)r * DM + i * 256 + lane * 4) = o;
        }
    }
}


#define XB_TMO      128
#define XB_XCNT(j)  (256  + 64 * (j))
#define XB_XSUB(j)  (1280 + 64 * (j))
#define XB_XGEN(j)  (2304 + 64 * (j))
#define XB_TOP      3328
#define XB_TOPGEN   3392
#define XCD_BAR_WORDS 3456
#define XB_SPIN_CAP (1u << 22)
#define LAS __attribute__((address_space(3)))
__device__ __forceinline__ unsigned xb_ld(unsigned* p) { return __hip_atomic_load(p, __ATOMIC_RELAXED, __HIP_MEMORY_SCOPE_AGENT); }
__device__ __forceinline__ unsigned xb_add(unsigned* p, unsigned v) { return __hip_atomic_fetch_add(p, v, __ATOMIC_RELAXED, __HIP_MEMORY_SCOPE_AGENT); }
__device__ __forceinline__ unsigned xb_xcc_id() { return (unsigned)__builtin_amdgcn_s_getreg((3 << 11) | 20) & 0xFu; }
#define XB_SPIN(cond, bar) do { unsigned _sp = 0; while (cond) { __builtin_amdgcn_s_sleep(1); \
    if ((++_sp & 255u) == 0u) { if (xb_ld(&(bar)[XB_TMO])) break; if (_sp > XB_SPIN_CAP) { atomicAdd(&(bar)[XB_TMO], 1u); break; } } } } while (0)
struct XcdBarrier { unsigned* bar; unsigned x; volatile LAS unsigned* st; };
__device__ __forceinline__ XcdBarrier xcd_barrier_post(unsigned* bar, volatile LAS unsigned* st) {
    XcdBarrier b; b.bar = bar; b.x = xb_xcc_id(); b.st = st;
    if (threadIdx.x == 0) (void)xb_add(&bar[XB_XCNT(b.x)], 1u);
    return b;
}
__device__ __forceinline__ void xcd_barrier_complete(unsigned* bar, unsigned x, unsigned& nloc, unsigned& nx) {
    const unsigned G = gridDim.x * gridDim.y * gridDim.z;
    unsigned sum, cnt, mine, sp = 0u;
    for (;;) {
        sum = 0u; cnt = 0u; mine = 0u;
#pragma unroll
        for (unsigned j = 0; j < 16; ++j) { const unsigned c = xb_ld(&bar[XB_XCNT(j)]); sum += c; cnt += (c > 0u) ? 1u : 0u; mine = (j == x) ? c : mine; }
        if (sum == G) break;
        __builtin_amdgcn_s_sleep(1);
        if ((++sp & 255u) == 0u) { if (xb_ld(&bar[XB_TMO])) break; if (sp > XB_SPIN_CAP) { atomicAdd(&bar[XB_TMO], 1u); break; } }
    }
    nloc = mine > 0u ? mine : 1u; nx = cnt > 0u ? cnt : 1u;
}
__device__ __forceinline__ void xcd_barrier(const XcdBarrier& b) {
    asm volatile("s_waitcnt vmcnt(0)" ::: "memory");
    __syncthreads();
    if (threadIdx.x == 0) {
        unsigned* bar = b.bar;
        __builtin_amdgcn_s_waitcnt(0);
        unsigned nloc = b.st[0], nx = b.st[1];
        if (nloc == 0u) { xcd_barrier_complete(bar, b.x, nloc, nx); b.st[0] = nloc; b.st[1] = nx; }
        const unsigned old = xb_add(&bar[XB_XSUB(b.x)], 1u);
        const unsigned gen = old / nloc;
        if (old + 1u == (gen + 1u) * nloc) {
            __builtin_amdgcn_fence(__ATOMIC_RELEASE, "agent");
            asm volatile("s_waitcnt vmcnt(0)" ::: "memory");
            const unsigned og = xb_add(&bar[XB_TOP], 1u);
            const unsigned tg = og / nx;
            if (og + 1u == (tg + 1u) * nx) xb_add(&bar[XB_TOPGEN], 1u);
            else XB_SPIN(xb_ld(&bar[XB_TOPGEN]) == tg, bar);
            __builtin_amdgcn_fence(__ATOMIC_ACQUIRE, "agent");
            xb_add(&bar[XB_XGEN(b.x)], 1u);
            asm volatile("s_waitcnt vmcnt(0)" ::: "memory");
        } else {
            XB_SPIN(xb_ld(&bar[XB_XGEN(b.x)]) == gen, bar);
            __builtin_amdgcn_fence(__ATOMIC_ACQUIRE, "agent");
            asm volatile("s_waitcnt vmcnt(0)" ::: "memory");
        }
    }
    __syncthreads();
}

__global__ void __launch_bounds__(NTHR) fwd_megakernel(Params p) {
    extern __shared__ __attribute__((aligned(16))) unsigned char lds[];
    cg::grid_group grid = cg::this_grid();
    volatile LAS unsigned* xst = (volatile LAS unsigned*)(lds + LDS_BYTES - 32);
    if (threadIdx.x < 2) xst[threadIdx.x] = 0u;
    __syncthreads();
    const XcdBarrier xb = xcd_barrier_post((unsigned*)(p.ws + OFF_BAR), xst);
    if (p.out == nullptr) grid.sync();
#pragma unroll 1
    for (int step = 0; step < 18; ++step) {
        const int l = step >= 9 ? 1 : 0;
        const int ph = step - l * 9;
        switch (ph) {
        case 0:
            if (l == 0) phase_embed(p); else phase_rowstat(p);
            phase_convert<false>(p, l, lds);
            if (obid() == 0 && otid() < 24) ((int*)(WS(p) + OFF_CTL))[otid() * 32] = 0;
            if (obid() == 0 && otid() == 32) ((int*)(WS(p) + OFF_CTL))[800 + l * 32] = 0;
            break;
        case 1: phase_inproj(p, lds); break;
        case 2: phase_dsa_prep(p, l); phase_lr_prep(p, l); break;
        case 3: {
            if (obid() < NB * 16) phase_scan5(p, l, lds, obid());
            int* qctr = (int*)(WS(p) + OFF_CTL) + 800 + l * 32;
            int* qslot = (int*)(lds + LDS_BYTES - 16);
            for (;;) {
                __syncthreads();
                if (otid() == 0) *qslot = atomicAdd(qctr, 1);
                __syncthreads();
                const int item = *qslot;
                if (item >= 516 + NT / 16 + 3072) break;
                if (item < 516) phase_pool(p, l, lds, item, item + 1, 1);
                else if (item < 516 + NT / 16) phase_dsa<false>(p, l, lds, (bf16_t*)(OUTB(p) + DO_YC), nullptr, nullptr, item - 516, item - 515, 1);
                else {
                    const int ct = item - (516 + NT / 16);
                    const ConvJob cj = get_job_late(p, l, ct >> 10);
                    conv_tile(cj, ct & 1023, (float*)lds);
                }
            }
        } break;
        case 4: phase_merge(p, lds); break;
        case 5: phase_outproj(p, lds); break;
        case 6: phase_route(p, l, lds); break;
        case 7: phase_moe1(p, lds); break;
        default: phase_moe2(p, lds); break;
        }
        xcd_barrier(xb);
    }
    phase_final(p);
}

extern "C" void kernel_launch(void* const* d_in, const int* in_sizes, int n_in,
                              void* d_out, int out_size, void* d_ws, size_t ws_size,
                              hipStream_t stream) {
    static int grid_blocks = 0;
    if (grid_blocks == 0) {
        int dev = 0, cus = 0, per_cu = 0;
        (void)hipGetDevice(&dev);
        (void)hipDeviceGetAttribute(&cus, hipDeviceAttributeMultiprocessorCount, dev);
        (void)hipFuncSetAttribute((const void*)fwd_megakernel, hipFuncAttributeMaxDynamicSharedMemorySize, LDS_BYTES);
        (void)hipOccupancyMaxActiveBlocksPerMultiprocessor(&per_cu, fwd_megakernel, NTHR, LDS_BYTES);
        if (per_cu < 1 || cus < NB * 16 || (cus & 7) != 0 || n_in != 42 || ws_size < WS_END) { fprintf(stderr, "kernel_launch: bad config per_cu=%d n_in=%d ws=%zu need=%zu\n", per_cu, n_in, ws_size, (size_t)WS_END); grid_blocks = -1; }
        else grid_blocks = cus;
    }
    if (grid_blocks < 0) return;
    Params p{};
    for (int i = 0; i < 42; ++i) p.in[i] = (const float*)d_in[i];
    p.out = (float*)d_out;
    p.ws = (unsigned char*)d_ws;
    (void)hipMemsetAsync((unsigned char*)d_ws + OFF_BAR, 0, XCD_BAR_WORDS * 4, stream);
    void* args[] = {&p};
    hipError_t e = hipLaunchCooperativeKernel((void*)fwd_megakernel, dim3(grid_blocks), dim3(NTHR), args, LDS_BYTES, stream);
    if (e != hipSuccess) fprintf(stderr, "cooperative launch failed: %s (grid %d)\n", hipGetErrorString(e), grid_blocks);
}
```

```cpp
#include <hip/hip_runtime.h>
#include <hip/hip_cooperative_groups.h>
#include <cstdio>
#include <cstdint>
#include <type_traits>
namespace cg = cooperative_groups;

typedef unsigned short bf16_t;
typedef short bf16x8 __attribute__((ext_vector_type(8)));
typedef float f32x4 __attribute__((ext_vector_type(4)));

constexpr int NB = 8, SEQ = 2048, NMETA = 16, TS = 2064, DM = 1024;
constexpr int NT = NB * TS;
constexpr int NTP = 16640;
constexpr int NTHR = 512;
constexpr int CIN = 7912;
constexpr int NP1 = 4864;
constexpr int PM_LD = 768;
constexpr int PM_WD = 0, PM_AD = 64, PM_GD = 128, PM_VD = 256, PM_CQ = 288, PM_CKV = 544, PM_KROPE = 672, PM_KIDX = 704;
constexpr int LDS_BYTES = 157 * 1024;

constexpr size_t AL(size_t x) { return (x + 255) & ~(size_t)255; }
constexpr size_t SZ_ACT = (size_t)NTP * 1024 * 2;
constexpr size_t OFF_CTL = 0;
constexpr size_t OFF_BAR = 4096;
constexpr size_t OFF_RSTD = OFF_BAR + 16384;
constexpr size_t OFF_ROPE = OFF_RSTD + AL((size_t)NTP * 4);
constexpr size_t OFF_H = OFF_ROPE + AL((size_t)TS * 16 * 4 * 2);
constexpr size_t OFF_WB = OFF_H + SZ_ACT;
constexpr size_t WB_WIN = 0;
constexpr size_t WB_WG = WB_WIN + (size_t)NP1 * 1024;
constexpr size_t WB_PA = WB_WG + (size_t)3072 * 1024;
constexpr size_t WB_WO = WB_PA + (size_t)3 * 1024 * 1024;
constexpr size_t WB_POOL = WB_WO + (size_t)1024 * 1024;
constexpr size_t WB_QI = WB_POOL + (size_t)4 * 256 * 256;
constexpr size_t WB_UQ = WB_QI + (size_t)512 * 256;
constexpr size_t WB_UK = WB_UQ + (size_t)1536 * 256;
constexpr size_t WB_UV = WB_UK + (size_t)16 * 128 * 64;
constexpr size_t WB_WIDX = WB_UV + (size_t)16 * 64 * 128;
constexpr size_t WB_END = WB_WIDX + (size_t)64 * 1024;
constexpr size_t OFF_PPOOL = OFF_WB + AL(WB_END * 2);
constexpr size_t OFF_PK = OFF_PPOOL + SZ_ACT;
constexpr size_t OFF_PR = OFF_PK + SZ_ACT;
constexpr size_t OFF_PV = OFF_PR + SZ_ACT;
constexpr size_t OFF_PMISC = OFF_PV + SZ_ACT;
constexpr size_t OFF_VFIRST = OFF_PMISC + AL((size_t)NTP * PM_LD * 2);
constexpr size_t OFF_HALO = OFF_VFIRST + SZ_ACT;
constexpr size_t OFF_LIST = OFF_HALO + AL((size_t)130 * 16 * 1024 * 2);
constexpr size_t OFF_PW = OFF_LIST + AL((size_t)24 * NT * 4);
constexpr size_t WS_END = OFF_PW + AL((size_t)NT * 2 * 4);
constexpr size_t OFF_MERGED = OFF_PK;
constexpr size_t OFF_HM32 = OFF_PR;
constexpr size_t OFF_HN = OFF_PPOOL;
constexpr size_t OFF_WEXP = OFF_PMISC;
constexpr size_t WE_W1 = 0, WE_W3 = (size_t)16 * 256 * 1024, WE_W2 = (size_t)2 * 16 * 256 * 1024;
static_assert((size_t)3 * 16 * 256 * 1024 * 2 <= (size_t)NTP * PM_LD * 2, "expert weights must fit in Pmisc");
constexpr size_t DO_YC = 0;
constexpr size_t DO_CQN = DO_YC + SZ_ACT;
constexpr size_t DO_KV = DO_CQN + AL((size_t)NT * 256 * 2);
constexpr size_t DO_KIDX = DO_KV + AL((size_t)NT * 160 * 2);
constexpr size_t DO_WHEAD = DO_KIDX + AL((size_t)NT * 64 * 2);
constexpr size_t DO_ALR = DO_WHEAD + AL((size_t)NT * 8 * 4);
constexpr size_t DO_END = DO_ALR + AL((size_t)NT * 288 * 2);
constexpr size_t DO_HID = DO_YC;
static_assert(DO_END <= (size_t)NB * SEQ * DM * 4, "d_out scratch overflow");
static_assert((size_t)(129 + 24) * 128 * 512 * 2 <= SZ_ACT, "hid fits");
static_assert(WS_END <= 277240096ull, "workspace overflow");

struct Params {
    const float* in[42];
    float* out;
    unsigned char* ws;
};

__device__ __forceinline__ int otid() { int t = threadIdx.x; asm volatile("" : "+v"(t)); return t; }
__device__ __forceinline__ int obid() { int b = blockIdx.x; asm volatile("" : "+s"(b)); return b; }
__device__ __forceinline__ unsigned char* WS(const Params& p) { unsigned char* w = p.ws; asm volatile("" : "+s"(w)); return w; }
__device__ __forceinline__ unsigned char* OUTB(const Params& p) { unsigned char* w = (unsigned char*)p.out; asm volatile("" : "+s"(w)); return w; }
__device__ __forceinline__ float bf2f(bf16_t v) { return __uint_as_float(((unsigned)v) << 16); }
typedef float f32x2v __attribute__((ext_vector_type(2)));
typedef __bf16 bf16x2v __attribute__((ext_vector_type(2)));
__device__ __forceinline__ unsigned pk2(float a, float b) { const f32x2v v = {a, b}; const bf16x2v r = __builtin_convertvector(v, bf16x2v); unsigned u; __builtin_memcpy(&u, &r, 4); return u; }
__device__ __forceinline__ bf16_t f2bf(float f) { const __bf16 h = (__bf16)f; bf16_t u; __builtin_memcpy(&u, &h, 2); return u; }
__device__ __forceinline__ float wave_sum(float v) {
#pragma unroll
    for (int o = 32; o > 0; o >>= 1) v += __shfl_xor(v, o);
    return v;
}
template <int CTRL> __device__ __forceinline__ float dpp_f(float x) {
    return __int_as_float(__builtin_amdgcn_update_dpp(0, __float_as_int(x), CTRL, 0xF, 0xF, true));
}
__device__ __forceinline__ float row16_sum(float v) {
    v += dpp_f<0xB1>(v);
    v += dpp_f<0x4E>(v);
    v += dpp_f<0x141>(v);
    v += dpp_f<0x140>(v);
    return v;
}
__device__ __forceinline__ void lds_barrier() { asm volatile("s_waitcnt lgkmcnt(0)" ::: "memory"); __builtin_amdgcn_s_barrier(); asm volatile("" ::: "memory"); }
__device__ __forceinline__ float fast_rcp(float x) { return __builtin_amdgcn_rcpf(x); }
__device__ __forceinline__ float fast_sigmoid(float x) { return fast_rcp(1.0f + __expf(-x)); }
__device__ __forceinline__ float fast_tanh(float x) { return 1.0f - 2.0f * fast_rcp(1.0f + __expf(2.0f * x)); }
__device__ __forceinline__ void row16_sum4(float& a, float& b, float& c, float& d) {
    asm volatile(
        "s_nop 1\n\t"
        "v_add_f32_dpp %0, %0, %0 quad_perm:[1,0,3,2] row_mask:0xf bank_mask:0xf\n\t"
        "v_add_f32_dpp %1, %1, %1 quad_perm:[1,0,3,2] row_mask:0xf bank_mask:0xf\n\t"
        "v_add_f32_dpp %2, %2, %2 quad_perm:[1,0,3,2] row_mask:0xf bank_mask:0xf\n\t"
        "v_add_f32_dpp %3, %3, %3 quad_perm:[1,0,3,2] row_mask:0xf bank_mask:0xf\n\t"
        "v_add_f32_dpp %0, %0, %0 quad_perm:[2,3,0,1] row_mask:0xf bank_mask:0xf\n\t"
        "v_add_f32_dpp %1, %1, %1 quad_perm:[2,3,0,1] row_mask:0xf bank_mask:0xf\n\t"
        "v_add_f32_dpp %2, %2, %2 quad_perm:[2,3,0,1] row_mask:0xf bank_mask:0xf\n\t"
        "v_add_f32_dpp %3, %3, %3 quad_perm:[2,3,0,1] row_mask:0xf bank_mask:0xf\n\t"
        "v_add_f32_dpp %0, %0, %0 row_half_mirror row_mask:0xf bank_mask:0xf\n\t"
        "v_add_f32_dpp %1, %1, %1 row_half_mirror row_mask:0xf bank_mask:0xf\n\t"
        "v_add_f32_dpp %2, %2, %2 row_half_mirror row_mask:0xf bank_mask:0xf\n\t"
        "v_add_f32_dpp %3, %3, %3 row_half_mirror row_mask:0xf bank_mask:0xf\n\t"
        "v_add_f32_dpp %0, %0, %0 row_mirror row_mask:0xf bank_mask:0xf\n\t"
        "v_add_f32_dpp %1, %1, %1 row_mirror row_mask:0xf bank_mask:0xf\n\t"
        "v_add_f32_dpp %2, %2, %2 row_mirror row_mask:0xf bank_mask:0xf\n\t"
        "v_add_f32_dpp %3, %3, %3 row_mirror row_mask:0xf bank_mask:0xf\n\t"
        "s_nop 1"
        : "+v"(a), "+v"(b), "+v"(c), "+v"(d));
}
__device__ __forceinline__ void row8_sum2(float& a, float& b) {
    asm volatile(
        "s_nop 1\n\t"
        "v_add_f32_dpp %0, %0, %0 quad_perm:[1,0,3,2] row_mask:0xf bank_mask:0xf\n\t"
        "v_add_f32_dpp %1, %1, %1 quad_perm:[1,0,3,2] row_mask:0xf bank_mask:0xf\n\t"
        "s_nop 0\n\t"
        "v_add_f32_dpp %0, %0, %0 quad_perm:[2,3,0,1] row_mask:0xf bank_mask:0xf\n\t"
        "v_add_f32_dpp %1, %1, %1 quad_perm:[2,3,0,1] row_mask:0xf bank_mask:0xf\n\t"
        "s_nop 0\n\t"
        "v_add_f32_dpp %0, %0, %0 row_half_mirror row_mask:0xf bank_mask:0xf\n\t"
        "v_add_f32_dpp %1, %1, %1 row_half_mirror row_mask:0xf bank_mask:0xf\n\t"
        "s_nop 1"
        : "+v"(a), "+v"(b));
}
__device__ __forceinline__ float wave_sum_fast(float v) { v = row16_sum(v); v += __shfl_xor(v, 16); v += __shfl_xor(v, 32); return v; }
__device__ __forceinline__ float sigmoidf_(float x) { return 1.0f / (1.0f + __expf(-x)); }
__device__ __forceinline__ float softplusf_(float z) { return fmaxf(z, 0.f) + log1pf(__expf(-fabsf(z))); }
__device__ __forceinline__ void glds16(const void* g, void* l) {
    __builtin_amdgcn_global_load_lds((const unsigned*)g, (unsigned*)l, 16, 0, 0);
}

__device__ void phase_embed(const Params& p) {
    const int lane = otid() & 63;
    const int wave = (obid() * NTHR + otid()) >> 6, nw = gridDim.x * NTHR / 64;
    bf16_t* h = (bf16_t*)(WS(p) + OFF_H);
    float* rstd = (float*)(WS(p) + OFF_RSTD);
    for (int n = wave; n < NTP; n += nw) {
        if (n < NT) {
            const int b = n / TS, t = n % TS;
            const float* src = t < NMETA ? p.in[1] + (size_t)t * DM : p.in[0] + ((size_t)b * SEQ + (t - NMETA)) * DM;
            float ss = 0.f;
#pragma unroll
            for (int i = 0; i < 4; ++i) {
                const float4 v = *(const float4*)(src + i * 256 + lane * 4);
                ss += v.x * v.x + v.y * v.y + v.z * v.z + v.w * v.w;
                const uint2 o = make_uint2(pk2(v.x, v.y), pk2(v.z, v.w));
                *(uint2*)(h + (size_t)n * DM + i * 256 + lane * 4) = o;
            }
            ss = wave_sum(ss);
            if (lane == 0) rstd[n] = rsqrtf(ss * (1.0f / 1024.0f) + 1e-6f);
        } else {
#pragma unroll
            for (int i = 0; i < 4; ++i) *(ushort4*)(h + (size_t)n * DM + i * 256 + lane * 4) = make_ushort4(0, 0, 0, 0);
            if (lane == 0) rstd[n] = 0.f;
        }
    }
    float* ctab = (float*)(WS(p) + OFF_ROPE);
    float* stab = ctab + TS * 16;
    for (int idx = obid() * NTHR + otid(); idx < TS * 16; idx += gridDim.x * NTHR) {
        const int t = idx >> 4, i = idx & 15;
        const float inv = powf(10000.0f, -(float)(2 * i) / 32.0f);
        const float ang = (float)t * inv;
        ctab[idx] = cosf(ang);
        stab[idx] = sinf(ang);
    }
}

__device__ void phase_rowstat(const Params& p) {
    const int lane = otid() & 63;
    const int wave = (obid() * NTHR + otid()) >> 6, nw = gridDim.x * NTHR / 64;
    const float* hm = (const float*)(WS(p) + OFF_HM32);
    float* rstd = (float*)(WS(p) + OFF_RSTD);
    for (int n = wave; n < NT; n += nw) {
        float ss = 0.f;
#pragma unroll
        for (int i = 0; i < 4; ++i) {
            const float4 v = *(const float4*)(hm + (size_t)n * DM + i * 256 + lane * 4);
            ss += v.x * v.x + v.y * v.y + v.z * v.z + v.w * v.w;
        }
        ss = wave_sum(ss);
        if (lane == 0) rstd[n] = rsqrtf(ss * (1.0f / 1024.0f) + 1e-6f);
    }
}

struct ConvJob { const float* src; bf16_t* dst; const float* scale; int ldsrc, K, nvalid, nrows, nb, notr; size_t sbs, dbs; const float* srcB; int ldB, split; };
__device__ __forceinline__ int conv_job_tiles(const ConvJob& j) { return j.nb * (j.nrows >> 6) * (j.K >> 6); }
__device__ void conv_tile(const ConvJob& j, int tile, float* lds) {
    const int per = (j.nrows >> 6) * (j.K >> 6);
    const int bi = tile / per, rem = tile % per;
    const int ktiles = j.K >> 6;
    const int n0 = (rem / ktiles) << 6, k0 = (rem % ktiles) << 6;
    const int tid = otid(), tn = tid & 63, tk = tid >> 6;
    const float* src = j.src + (size_t)bi * j.sbs;
    bf16_t* dst = j.dst + (size_t)bi * j.dbs;
#pragma unroll
    for (int kk = 0; kk < 8; ++kk) {
        const int k = k0 + tk * 8 + kk;
        float v = 0.f;
        if (n0 + tn < j.nvalid) {
            if (j.split) { const int nn = n0 + tn; v = (nn < j.split) ? (j.src ? j.src[(size_t)k * j.ldsrc + nn] : 0.f) : j.srcB[(size_t)k * j.ldB + (nn - j.split)]; }
            else v = j.notr ? src[(size_t)(n0 + tn) * j.ldsrc + k] : src[(size_t)k * j.ldsrc + n0 + tn];
            if (j.scale) v *= j.scale[k];
        }
        lds[tn * 65 + tk * 8 + kk] = v;
    }
    __syncthreads();
    const int wn = tid >> 3, kq = tid & 7;
    uint4 o;
    unsigned w[4];
#pragma unroll
    for (int q = 0; q < 4; ++q) {
        const float lo = lds[wn * 65 + kq * 8 + 2 * q], hi = lds[wn * 65 + kq * 8 + 2 * q + 1];
        w[q] = pk2(lo, hi);
    }
    o.x = w[0]; o.y = w[1]; o.z = w[2]; o.w = w[3];
    *(uint4*)(dst + (size_t)(n0 + wn) * j.K + k0 + kq * 8) = o;
    __syncthreads();
}
__device__ ConvJob get_job_early(const Params& p, int l, int ji) {
    bf16_t* wb = (bf16_t*)(WS(p) + OFF_WB);
    const float* win = p.in[3] + (size_t)l * DM * CIN;
    const float* nm = p.in[2] + (size_t)l * DM;
    ConvJob j{}; j.nb = 1; j.sbs = 0; j.dbs = 0; j.K = 1024; j.ldsrc = CIN; j.scale = nm;
    switch (ji) {
    case 0: j.src = win + 3072; j.dst = wb + WB_WIN; j.nvalid = 4352; j.nrows = 4352; break;
    case 1: j.src = (l == 0 ? nullptr : p.in[17]); j.ldsrc = 32; j.split = 32; j.srcB = win + 7424; j.ldB = CIN; j.dst = wb + WB_WIN + (size_t)(4096 + PM_VD) * 1024; j.nvalid = 512; j.nrows = 512; break;
    case 2: j.src = win + 7904; j.dst = wb + WB_WIDX; j.nvalid = 8; j.nrows = 64; break;
    case 3: j.src = win; j.dst = wb + WB_WG; j.nvalid = 3072; j.nrows = 3072; break;
    case 4: j.src = p.in[29] + (size_t)l * DM * DM; j.ldsrc = 1024; j.scale = nullptr; j.dst = wb + WB_PA; j.nvalid = 1024; j.nrows = 1024; break;
    case 5: j.src = p.in[30] + (size_t)l * DM * DM; j.ldsrc = 1024; j.scale = nullptr; j.dst = wb + WB_PA + (size_t)1024 * 1024; j.nvalid = 1024; j.nrows = 1024; break;
    case 6: j.src = p.in[31] + (size_t)l * DM * DM; j.ldsrc = 1024; j.scale = nullptr; j.dst = wb + WB_PA + (size_t)2 * 1024 * 1024; j.nvalid = 1024; j.nrows = 1024; break;
    case 7: j.src = p.in[32] + (size_t)l * DM * DM; j.ldsrc = 1024; j.scale = nullptr; j.dst = wb + WB_WO; j.nvalid = 1024; j.nrows = 1024; break;
    case 8: j.src = p.in[5] + (size_t)l * 4 * 256 * 256; j.ldsrc = 256; j.K = 256; j.scale = nullptr; j.dst = wb + WB_POOL; j.nvalid = 256; j.nrows = 256; j.nb = 4; j.sbs = 65536; j.dbs = 65536; break;
    case 9: j.src = p.in[26] + (size_t)l * 256 * 512; j.ldsrc = 512; j.K = 256; j.scale = nullptr; j.dst = wb + WB_QI; j.nvalid = 512; j.nrows = 512; break;
    case 10: j.src = p.in[23] + (size_t)l * 256 * 1536; j.ldsrc = 1536; j.K = 256; j.scale = nullptr; j.dst = wb + WB_UQ; j.nvalid = 1536; j.nrows = 1536; break;
    case 11: j.src = p.in[24] + (size_t)l * 16 * 128 * 64; j.ldsrc = 64; j.K = 64; j.scale = nullptr; j.dst = wb + WB_UK; j.nvalid = 2048; j.nrows = 2048; j.notr = 1; break;
    default: j.src = p.in[25] + (size_t)l * 16 * 128 * 64; j.ldsrc = 64; j.K = 128; j.scale = nullptr; j.dst = wb + WB_UV; j.nvalid = 64; j.nrows = 64; j.nb = 16; j.sbs = 8192; j.dbs = 8192; break;
    }
    return j;
}
__device__ ConvJob get_job_late(const Params& p, int l, int ji) {
    bf16_t* we = (bf16_t*)(WS(p) + OFF_WEXP);
    ConvJob j{}; j.nb = 16; j.scale = nullptr; j.sbs = 262144; j.dbs = 262144;
    switch (ji) {
    case 0: j.src = p.in[38] + (size_t)l * 16 * 262144; j.dst = we + WE_W1; j.ldsrc = 256; j.K = 1024; j.nvalid = 256; j.nrows = 256; break;
    case 1: j.src = p.in[39] + (size_t)l * 16 * 262144; j.dst = we + WE_W3; j.ldsrc = 256; j.K = 1024; j.nvalid = 256; j.nrows = 256; break;
    default: j.src = p.in[40] + (size_t)l * 16 * 262144; j.dst = we + WE_W2; j.ldsrc = 1024; j.K = 256; j.nvalid = 1024; j.nrows = 1024; break;
    }
    return j;
}
template <bool LATE>
__device__ void phase_convert(const Params& p, int l, unsigned char* lds) {
    const int njobs = LATE ? 3 : 13;
    int base = 0;
    for (int ji = 0; ji < njobs; ++ji) {
        const ConvJob j = LATE ? get_job_late(p, l, ji) : get_job_early(p, l, ji);
        const int nt = conv_job_tiles(j);
        int first = ((int)obid() - base) % (int)gridDim.x; if (first < 0) first += gridDim.x;
        for (int t = first; t < nt; t += gridDim.x) conv_tile(j, t, (float*)lds);
        base += nt;
    }
}

template <int BM> struct G3 {
    static constexpr int MI = BM / 64;
    static constexpr int NA = BM / 64;
    static constexpr int STAGE = BM * 128 + 128 * 128;
    const bf16_t* ap[NA];
    const bf16_t* bp[2];
};
template <int BM>
__device__ __forceinline__ void g3_issue(const G3<BM>& g, int kt, unsigned char* stage, int tid) {
#pragma unroll
    for (int i = 0; i < G3<BM>::NA; ++i) glds16(g.ap[i] + kt * 64, stage + (tid + i * NTHR) * 16);
#pragma unroll
    for (int i = 0; i < 2; ++i) glds16(g.bp[i] + kt * 64, stage + BM * 128 + (tid + i * NTHR) * 16);
}
template <int BM, class FA, class FB>
__device__ __forceinline__ void g3_setup(G3<BM>& g, FA rowptr, FB bcol, int tid) {
#pragma unroll
    for (int i = 0; i < G3<BM>::NA; ++i) { const int idx = tid + i * NTHR, row = idx >> 3, sl = (idx & 7) ^ (row & 7); g.ap[i] = rowptr(row) + sl * 8; }
#pragma unroll
    for (int i = 0; i < 2; ++i) { const int idx = tid + i * NTHR, row = idx >> 3, sl = (idx & 7) ^ (row & 7); g.bp[i] = bcol(row) + sl * 8; }
}
template <int BM>
__device__ __forceinline__ void g3_kloop(f32x4 (&acc)[BM / 64][4], const G3<BM>& g, int K, unsigned char* lds) {
    constexpr int MI = G3<BM>::MI, STAGE = G3<BM>::STAGE, NL = G3<BM>::NA + 2;
    const int tid = otid(), lane = tid & 63, wid = tid >> 6, wr = wid >> 1, wc = wid & 1, fr = lane & 15, fq = lane >> 4;
    const int nk = K >> 6;
    g3_issue<BM>(g, 0, lds, tid);
    if (nk > 1) g3_issue<BM>(g, 1, lds + STAGE, tid);
    int cur = 0;
#pragma unroll 1
    for (int t = 0; t < nk; ++t) {
        if (t + 1 < nk) { if (NL == 6) asm volatile("s_waitcnt vmcnt(6)" ::: "memory"); else if (NL == 5) asm volatile("s_waitcnt vmcnt(5)" ::: "memory"); else asm volatile("s_waitcnt vmcnt(4)" ::: "memory"); }
        else asm volatile("s_waitcnt vmcnt(0)" ::: "memory");
        __builtin_amdgcn_s_barrier();
        if (t + 2 < nk) { int nx = cur + 2; if (nx >= 3) nx -= 3; g3_issue<BM>(g, t + 2, lds + nx * STAGE, tid); }
        const unsigned char* cA = lds + cur * STAGE;
        const unsigned char* cB = cA + BM * 128;
#pragma unroll
        for (int ks = 0; ks < 2; ++ks) {
            bf16x8 a[MI], b[4];
#pragma unroll
            for (int m = 0; m < MI; ++m) { const int row = wr * (BM / 4) + m * 16 + fr; a[m] = *(const bf16x8*)(cA + row * 128 + (((ks * 4 + fq) ^ (row & 7)) << 4)); }
#pragma unroll
            for (int n = 0; n < 4; ++n) { const int row = wc * 64 + n * 16 + fr; b[n] = *(const bf16x8*)(cB + row * 128 + (((ks * 4 + fq) ^ (row & 7)) << 4)); }
#pragma unroll
            for (int m = 0; m < MI; ++m)
#pragma unroll
                for (int n = 0; n < 4; ++n) acc[m][n] = __builtin_amdgcn_mfma_f32_16x16x32_bf16(b[n], a[m], acc[m][n], 0, 0, 0);
        }
        cur = (cur == 2) ? 0 : cur + 1;
    }
    __builtin_amdgcn_s_barrier();
}
struct G3D { const bf16_t* ap[2]; const bf16_t* b1[2]; const bf16_t* b3[2]; };
__device__ __forceinline__ void g3d_issue(const G3D& g, int kt, unsigned char* stage, int tid) {
#pragma unroll
    for (int i = 0; i < 2; ++i) glds16(g.ap[i] + kt * 64, stage + (tid + i * NTHR) * 16);
#pragma unroll
    for (int i = 0; i < 2; ++i) glds16(g.b1[i] + kt * 64, stage + 16384 + (tid + i * NTHR) * 16);
#pragma unroll
    for (int i = 0; i < 2; ++i) glds16(g.b3[i] + kt * 64, stage + 32768 + (tid + i * NTHR) * 16);
}
__device__ __forceinline__ void g3d_kloop(f32x4 (&acc1)[2][4], f32x4 (&acc3)[2][4], const G3D& g, int K, unsigned char* lds) {
    constexpr int STAGE = 49152;
    const int tid = otid(), lane = tid & 63, wid = tid >> 6, wr = wid >> 1, wc = wid & 1, fr = lane & 15, fq = lane >> 4;
    const int nk = K >> 6;
    g3d_issue(g, 0, lds, tid);
    if (nk > 1) g3d_issue(g, 1, lds + STAGE, tid);
    int cur = 0;
#pragma unroll 1
    for (int t = 0; t < nk; ++t) {
        if (t + 1 < nk) asm volatile("s_waitcnt vmcnt(6)" ::: "memory"); else asm volatile("s_waitcnt vmcnt(0)" ::: "memory");
        __builtin_amdgcn_s_barrier();
        if (t + 2 < nk) { int nx = cur + 2; if (nx >= 3) nx -= 3; g3d_issue(g, t + 2, lds + nx * STAGE, tid); }
        const unsigned char* cA = lds + cur * STAGE;
#pragma unroll
        for (int ks = 0; ks < 2; ++ks) {
            bf16x8 a[2], b1[4], b3[4];
#pragma unroll
            for (int m = 0; m < 2; ++m) { const int row = wr * 32 + m * 16 + fr; a[m] = *(const bf16x8*)(cA + row * 128 + (((ks * 4 + fq) ^ (row & 7)) << 4)); }
#pragma unroll
            for (int n = 0; n < 4; ++n) { const int row = wc * 64 + n * 16 + fr; const int off = row * 128 + (((ks * 4 + fq) ^ (row & 7)) << 4);
                b1[n] = *(const bf16x8*)(cA + 16384 + off); b3[n] = *(const bf16x8*)(cA + 32768 + off); }
#pragma unroll
            for (int m = 0; m < 2; ++m)
#pragma unroll
                for (int n = 0; n < 4; ++n) {
                    acc1[m][n] = __builtin_amdgcn_mfma_f32_16x16x32_bf16(b1[n], a[m], acc1[m][n], 0, 0, 0);
                    acc3[m][n] = __builtin_amdgcn_mfma_f32_16x16x32_bf16(b3[n], a[m], acc3[m][n], 0, 0, 0);
                }
        }
        cur = (cur == 2) ? 0 : cur + 1;
    }
    __builtin_amdgcn_s_barrier();
}
template <int MI>
__device__ __forceinline__ void g3_zero(f32x4 (&acc)[MI][4]) {
#pragma unroll
    for (int m = 0; m < MI; ++m)
#pragma unroll
        for (int n = 0; n < 4; ++n) acc[m][n] = (f32x4){0.f, 0.f, 0.f, 0.f};
}
__device__ __forceinline__ uint2 pack4(float a, float b, float c, float d) {
    uint2 r; r.x = pk2(a, b); r.y = pk2(c, d); return r;
}

namespace pg8 {
#define PG8_LAS __attribute__((address_space(3)))
typedef unsigned short bf16_t;
typedef short bf16x8 __attribute__((ext_vector_type(8)));
typedef float f32x4 __attribute__((ext_vector_type(4)));
typedef unsigned u32x4 __attribute__((ext_vector_type(4)));
constexpr int BM = 256, BK = 64, HALF = 128, HTB = HALF * BK * 2  , STAGE_BYTES = 8 * HTB, NXCD = 8, WGM = 8;

__host__ __device__ __forceinline__ int lds_byte(int r, int c) { const int st = (r >> 4) * 2 + (c >> 5), rr = r & 15, cc = c & 31, ob = rr * 64 + cc * 2; return st * 1024 + (ob ^ (((ob >> 9) & 1) << 5)); }
__host__ __device__ __forceinline__ void stage_rc(int b, int& R, int& C) { const int st = b / 1024, sb = b % 1024, swz = sb ^ (((sb >> 9) & 1) << 5); R = (st >> 1) * 16 + swz / 64; C = (st & 1) * 32 + (swz % 64) / 2; }
__host__ __device__ __forceinline__ int perm32(int rho) { const int n = rho >> 4, i = rho & 15; return 8 * (i >> 2) + 4 * n + (i & 3); }

struct Unit { int pm, pn; };
struct Gemm { const bf16_t* A; const bf16_t* Bt; int M, N, K; };

struct StaticOrder {
    int nM, nN, nwg, G, c;
    __host__ __device__ void init(int M, int N, int G_, int c_) { nM = M / BM; nN = N / BM; nwg = nM * nN; G = G_; c = c_; }
    __host__ __device__ bool next(int i, Unit& u) const {
        const long L = (long)i * G + c; if (L >= nwg) return false;
        int wgid = (int)L; { const int q = nwg / NXCD, r = nwg % NXCD, xcd = wgid % NXCD, off = wgid / NXCD; wgid = (xcd < r ? xcd * (q + 1) : r * (q + 1) + (xcd - r) * q) + off; }
        const int nig = WGM * nN, gid = wgid / nig, fm = gid * WGM, gsz = (nM - fm) < WGM ? (nM - fm) : WGM;
        u.pm = fm + ((wgid % nig) % gsz); u.pn = (wgid % nig) / gsz; return true;
    }
    __device__ __forceinline__ void a_ready(const Unit&) const {}
    __device__ __forceinline__ void done(const Unit&) const {}
};
template <class Epi, class Sched, bool STAMP = false>
__device__ __forceinline__ void gemm_phase(PG8_LAS unsigned char* lds, const Gemm g, const Sched& S, const Epi& E, unsigned long long* stamps) {
    const int tid = otid(), wid = __builtin_amdgcn_readfirstlane(tid >> 6), lane = tid & 63, wr = wid >> 2, wc = wid & 3, fr = lane & 15, fq = lane >> 4;
    const int K = g.K, nt = K / BK;
    int ts_lo = 0, ts_hi = 0, nts = 0; const unsigned long long rt_entry = STAMP ? 0ull : 0ull;
#define PG8_STAMP() do { if (STAMP && wid == 0 && nts < 64) { const unsigned long long _c = 0ull; \
        ts_lo = (lane == nts) ? (int)(unsigned)_c : ts_lo; ts_hi = (lane == nts) ? (int)(unsigned)(_c >> 32) : ts_hi; ++nts; } } while (0)
    PG8_STAMP();
    unsigned voffA[2], voffB[2];
#pragma unroll
    for (int i = 0; i < 2; ++i) { int R, C; stage_rc(tid * 16 + i * 8192, R, C); const int Rb = Epi::PERM ? ((R & ~31) + perm32(R & 31)) : R;
        voffA[i] = (unsigned)(R * K + C) * 2u; voffB[i] = (unsigned)(Rb * K + C) * 2u; }
    const size_t kstep = (size_t)(BK * 2);
    const size_t hstep = (size_t)HALF * K * 2;
    const size_t tstep = 2 * hstep;
    const unsigned ldsw = (unsigned)wid * 1024u;
    const int aoff = lds_byte(wr * 64 + fr, fq * 8), boff = lds_byte(wc * 32 + fr, fq * 8);
#define PG8_SA(b, h) (((b) * 2 + (h)) * HTB)
#define PG8_SB(b, h) ((4 + (b) * 2 + (h)) * HTB)
#define PG8_STAGE(bufoff, gbase, voff) do { _Pragma("unroll") for (int _i = 0; _i < 2; ++_i) \
        __builtin_amdgcn_global_load_lds((const unsigned*)((const char*)(gbase) + (voff)[_i]), (PG8_LAS unsigned*)(lds + (bufoff) + ldsw + _i * 8192), 16, 0, 0); } while (0)
#define PG8_LDA(dst, b, h) do { _Pragma("unroll") for (int m = 0; m < 4; ++m) _Pragma("unroll") for (int k = 0; k < 2; ++k) dst[m][k] = *(const PG8_LAS bf16x8*)(lds + PG8_SA(b, h) + aoff + m * 2048 + k * 1024); } while (0)
#define PG8_LDB(dst, b, h) do { _Pragma("unroll") for (int n = 0; n < 2; ++n) _Pragma("unroll") for (int k = 0; k < 2; ++k) dst[n][k] = *(const PG8_LAS bf16x8*)(lds + PG8_SB(b, h) + boff + n * 2048 + k * 1024); } while (0)
#define PG8_MMA(ai, bj, At, Bt) do { __builtin_amdgcn_s_setprio(1); _Pragma("unroll") for (int m = 0; m < 4; ++m) _Pragma("unroll") for (int n = 0; n < 2; ++n) _Pragma("unroll") for (int k = 0; k < 2; ++k) \
        acc[ai][bj][m][n] = __builtin_amdgcn_mfma_f32_16x16x32_bf16(Bt[n][k], At[m][k], acc[ai][bj][m][n], 0, 0, 0); __builtin_amdgcn_s_setprio(0); } while (0)
#define PG8_WAIT_V(n) asm volatile("s_waitcnt vmcnt(" #n ")" ::: "memory")
#define PG8_WAIT_L(n) asm volatile("s_waitcnt lgkmcnt(" #n ")" ::: "memory")
#define PG8_BAR __builtin_amdgcn_s_barrier()
#define PG8_SCHED __builtin_amdgcn_sched_barrier(0)
    Unit cur, nxt; int ui = 0;
    if (!S.next(0, cur)) return;
    f32x4 acc[2][2][4][2];
#pragma unroll
    for (int a = 0; a < 2; ++a)
#pragma unroll
        for (int b = 0; b < 2; ++b)
#pragma unroll
            for (int m = 0; m < 4; ++m)
#pragma unroll
                for (int n = 0; n < 2; ++n) acc[a][b][m][n] = (f32x4){0.f, 0.f, 0.f, 0.f};
    bf16x8 At[4][2], B0[2][2], B1[2][2];
    const char* cA = (const char*)g.A + (size_t)cur.pm * tstep; const char* cB = (const char*)g.Bt + (size_t)cur.pn * tstep;
    S.a_ready(cur);
    PG8_STAGE(PG8_SB(0, 0), cB, voffB); PG8_STAGE(PG8_SA(0, 0), cA, voffA); PG8_STAGE(PG8_SB(0, 1), cB + hstep, voffB); PG8_STAGE(PG8_SA(0, 1), cA + hstep, voffA);
    if (wr == 1) PG8_BAR;
    PG8_WAIT_V(4); PG8_BAR;
    PG8_STAGE(PG8_SB(1, 0), cB + kstep, voffB); PG8_STAGE(PG8_SA(1, 0), cA + kstep, voffA); PG8_STAGE(PG8_SB(1, 1), cB + hstep + kstep, voffB);
    PG8_WAIT_V(6); PG8_BAR;
    PG8_STAMP();
    for (;;) {
        const bool has_next = S.next(ui + 1, nxt);
        const char* nA = has_next ? (const char*)g.A + (size_t)nxt.pm * tstep : cA; const char* nB = has_next ? (const char*)g.Bt + (size_t)nxt.pn * tstep : cB;
        for (int t = 0; t < nt; t += 2) {
            const bool last = (t == nt - 2);
            const char* a1 = cA + (size_t)(t + 1) * kstep;
            const char* a2 = last ? nA : cA + (size_t)(t + 2) * kstep; const char* b2 = last ? nB : cB + (size_t)(t + 2) * kstep;
            const char* a3 = a2 + kstep; const char* b3 = b2 + kstep;
            if (last && has_next) S.a_ready(nxt);
            PG8_LDB(B0, 0, 0); PG8_SCHED; PG8_LDA(At, 0, 0); PG8_STAGE(PG8_SA(1, 1), a1 + hstep, voffA);
            PG8_WAIT_L(8); PG8_BAR; PG8_WAIT_L(0); PG8_MMA(0, 0, At, B0); PG8_BAR; PG8_SCHED;
            PG8_LDB(B1, 0, 1); PG8_STAGE(PG8_SB(0, 0), b2, voffB);
            PG8_BAR; PG8_WAIT_L(0); PG8_MMA(0, 1, At, B1); PG8_BAR;
            PG8_LDA(At, 0, 1); PG8_STAGE(PG8_SA(0, 0), a2, voffA);
            PG8_BAR; PG8_WAIT_L(0); PG8_MMA(1, 0, At, B0); PG8_BAR; PG8_SCHED;
            PG8_STAGE(PG8_SB(0, 1), b2 + hstep, voffB);
            PG8_WAIT_V(6); PG8_BAR; PG8_MMA(1, 1, At, B1); PG8_BAR;
            PG8_LDB(B0, 1, 0); PG8_SCHED; PG8_LDA(At, 1, 0); PG8_STAGE(PG8_SA(0, 1), a2 + hstep, voffA);
            PG8_WAIT_L(8); PG8_BAR; PG8_WAIT_L(0); PG8_MMA(0, 0, At, B0); PG8_BAR; PG8_SCHED;
            PG8_LDB(B1, 1, 1); PG8_STAGE(PG8_SB(1, 0), b3, voffB);
            PG8_BAR; PG8_WAIT_L(0); PG8_MMA(0, 1, At, B1); PG8_BAR;
            PG8_LDA(At, 1, 1); PG8_STAGE(PG8_SA(1, 0), a3, voffA);
            PG8_BAR; PG8_WAIT_L(0); PG8_MMA(1, 0, At, B0); PG8_BAR; PG8_SCHED;
            PG8_STAGE(PG8_SB(1, 1), b3 + hstep, voffB);
            PG8_WAIT_V(6); PG8_BAR; PG8_MMA(1, 1, At, B1); PG8_BAR;
        }
        PG8_STAMP();
        if constexpr (!Epi::AFTER_DRAIN) { E(acc, cur, wr, wc, fr, fq); S.done(cur); }
        PG8_STAMP();
        if (!has_next) break;
#pragma unroll
        for (int a = 0; a < 2; ++a)
#pragma unroll
            for (int b = 0; b < 2; ++b)
#pragma unroll
                for (int m = 0; m < 4; ++m)
#pragma unroll
                    for (int n = 0; n < 2; ++n) acc[a][b][m][n] = (f32x4){0.f, 0.f, 0.f, 0.f};
        cur = nxt; cA = nA; cB = nB; ++ui;
    }
    PG8_WAIT_V(0);
    if (wr == 0) PG8_BAR;
    PG8_BAR;
    if constexpr (Epi::AFTER_DRAIN) { E.fused(acc, cur, wr, wc, fr, fq, lds, wid, lane); S.done(cur); }
    PG8_STAMP();
    if (STAMP && wid == 0) { stamps[lane] = lane < nts ? (((unsigned long long)(unsigned)ts_hi << 32) | (unsigned)ts_lo) : 0ull;
        if (lane == 62) stamps[62] = rt_entry; if (lane == 63) stamps[63] = 0ull; }
#undef PG8_STAMP
#undef PG8_SA
#undef PG8_SB
#undef PG8_STAGE
#undef PG8_LDA
#undef PG8_LDB
#undef PG8_MMA
#undef PG8_WAIT_V
#undef PG8_WAIT_L
#undef PG8_BAR
#undef PG8_SCHED
}
}

struct EpiInproj {
    static constexpr bool PERM = true, AFTER_DRAIN = false;
    unsigned char* ws; const float* rstd;
    __device__ __forceinline__ void operator()(const pg8::f32x4 (&acc)[2][2][4][2], const pg8::Unit& u, int wr, int wc, int fr, int fq) const {
        const int pn = u.pn;
        bf16_t* dst; int ld, cb;
        if (pn < 4) { dst = (bf16_t*)(ws + OFF_PPOOL); ld = 1024; cb = pn * 256; }
        else if (pn < 8) { dst = (bf16_t*)(ws + OFF_PR); ld = 1024; cb = (pn - 4) * 256; }
        else if (pn < 12) { dst = (bf16_t*)(ws + OFF_PK); ld = 1024; cb = (pn - 8) * 256; }
        else if (pn < 16) { dst = (bf16_t*)(ws + OFF_PV); ld = 1024; cb = (pn - 12) * 256; }
        else { dst = (bf16_t*)(ws + OFF_PMISC); ld = PM_LD; cb = (pn - 16) * 256; }
        bf16_t* halo = (bf16_t*)(ws + OFF_HALO);
#pragma unroll
        for (int ai = 0; ai < 2; ++ai)
#pragma unroll
            for (int m = 0; m < 4; ++m) {
                const int row = u.pm * 256 + ai * 128 + wr * 64 + m * 16 + fr;
                if (row < NT) {
                    const float rs = rstd[row];
                    const int lr = row & 127;
#pragma unroll
                    for (int bj = 0; bj < 2; ++bj) {
                        const int col = cb + bj * 128 + wc * 32 + fq * 8;
                        const uint2 lo = pack4(acc[ai][bj][m][0][0] * rs, acc[ai][bj][m][0][1] * rs, acc[ai][bj][m][0][2] * rs, acc[ai][bj][m][0][3] * rs);
                        const uint2 hi = pack4(acc[ai][bj][m][1][0] * rs, acc[ai][bj][m][1][1] * rs, acc[ai][bj][m][1][2] * rs, acc[ai][bj][m][1][3] * rs);
                        const uint4 v = make_uint4(lo.x, lo.y, hi.x, hi.y);
                        *(uint4*)(dst + (size_t)row * ld + col) = v;
                        if (pn < 4 && lr >= 112) *(uint4*)(halo + ((size_t)(row >> 7) * 16 + (lr - 112)) * 1024 + col) = v;
                    }
                }
            }
    }
};
__device__ void phase_inproj(const Params& p, unsigned char* lds) {
    pg8::StaticOrder S; S.init(NTP, NP1, (int)gridDim.x, obid());
    pg8::Gemm g; g.A = (const pg8::bf16_t*)(WS(p) + OFF_H); g.Bt = (const pg8::bf16_t*)(WS(p) + OFF_WB) + WB_WIN; g.M = NTP; g.N = NP1; g.K = DM;
    EpiInproj E; E.ws = WS(p); E.rstd = (const float*)(WS(p) + OFF_RSTD);
    pg8::gemm_phase<EpiInproj, pg8::StaticOrder, false>((PG8_LAS unsigned char*)lds, g, S, E, nullptr);
}

__device__ void phase_pool(const Params& p, int l, unsigned char* lds, int tb, int te, int tstep) {
    const int tid = otid(), lane = tid & 63, wid = tid >> 6, fr = lane & 15, fq = lane >> 4;
    bf16_t* pp = (bf16_t*)(WS(p) + OFF_PPOOL);
    const bf16_t* halo = (const bf16_t*)(WS(p) + OFF_HALO);
    const bf16_t* pw = (const bf16_t*)(WS(p) + OFF_WB) + WB_POOL;
    const float* scale = p.in[6] + (size_t)l * 1024;
    bf16_t* sp = (bf16_t*)lds;
    constexpr int SLD = 264;
    for (int tile = tb; tile < te; tile += tstep) {
        const int mt = tile >> 2, g = tile & 3;
        const int row0 = mt * 128, w = 2 << g;
        {
            const int c = tid & 255, r0 = (tid >> 8) * 64, col = g * 256 + c;
            auto rawv = [&](int n2) -> float {
                return (n2 >= row0) ? bf2f(pp[(size_t)n2 * 1024 + col]) : bf2f(halo[((size_t)(n2 >> 7) * 16 + ((n2 & 127) - 112)) * 1024 + col]);
            };
            int n = row0 + r0, t = n % TS;
            float sum = 0.f;
            const int have = (t < w) ? t : w;
            for (int i = 1; i <= have; ++i) sum += rawv(n - i);
#pragma unroll 4
            for (int r = 0; r < 64; ++r, ++n) {
                if (t == 0) sum = 0.f;
                const float v = rawv(n);
                sum += v;
                if (t >= w) sum -= rawv(n - w);
                const int cnt = (t + 1 < w) ? (t + 1) : w;
                sp[(r0 + r) * SLD + c] = f2bf(sum * (1.0f / (float)cnt) - v);
                t = (t + 1 == TS) ? 0 : t + 1;
            }
        }
        __syncthreads();
        f32x4 acc[8][2];
#pragma unroll
        for (int m = 0; m < 8; ++m) { acc[m][0] = (f32x4){0.f, 0.f, 0.f, 0.f}; acc[m][1] = (f32x4){0.f, 0.f, 0.f, 0.f}; }
        const bf16_t* wg = pw + (size_t)g * 65536;
#pragma unroll 1
        for (int kk = 0; kk < 8; ++kk) {
            bf16x8 bfr[2];
#pragma unroll
            for (int n = 0; n < 2; ++n) bfr[n] = *(const bf16x8*)(wg + (size_t)(wid * 32 + n * 16 + fr) * 256 + kk * 32 + fq * 8);
#pragma unroll
            for (int m = 0; m < 8; ++m) {
                const bf16x8 a = *(const bf16x8*)(sp + (m * 16 + fr) * SLD + kk * 32 + fq * 8);
                acc[m][0] = __builtin_amdgcn_mfma_f32_16x16x32_bf16(a, bfr[0], acc[m][0], 0, 0, 0);
                acc[m][1] = __builtin_amdgcn_mfma_f32_16x16x32_bf16(a, bfr[1], acc[m][1], 0, 0, 0);
            }
        }
#pragma unroll
        for (int m = 0; m < 8; ++m)
#pragma unroll
            for (int n = 0; n < 2; ++n) {
                const int col = g * 256 + wid * 32 + n * 16 + fr;
                const float sc = scale[col];
#pragma unroll
                for (int j = 0; j < 4; ++j) {
                    const int row = row0 + m * 16 + fq * 4 + j;
                    pp[(size_t)row * 1024 + col] = f2bf(acc[m][n][j] * sc);
                }
            }
        __syncthreads();
    }
}

__device__ void phase_dsa_prep(const Params& p, int l) {
    const int lane = otid() & 63;
    const int wave = (obid() * NTHR + otid()) >> 6, nw = gridDim.x * NTHR / 64;
    const bf16_t* pm = (const bf16_t*)(WS(p) + OFF_PMISC);
    unsigned char* dob = OUTB(p);
    bf16_t* cqn = (bf16_t*)(dob + DO_CQN);
    bf16_t* kv = (bf16_t*)(dob + DO_KV);
    bf16_t* kidx = (bf16_t*)(dob + DO_KIDX);
    float* whead = (float*)(dob + DO_WHEAD);
    const float* ctab = (const float*)(WS(p) + OFF_ROPE);
    const float* stab = ctab + TS * 16;
    const float* qn = p.in[21] + l * 256;
    const float* kvn = p.in[22] + l * 128;
    const float* inw = p.in[27] + l * 64;
    const float* inb = p.in[28] + l * 64;
    const bf16_t* hrow = (const bf16_t*)(WS(p) + OFF_H);
    const bf16_t* wwidx = (const bf16_t*)(WS(p) + OFF_WB) + WB_WIDX;
    const float* rstd_ = (const float*)(WS(p) + OFF_RSTD);
    for (int n = wave; n < NT; n += nw) {
        const int t = n % TS;
        const bf16_t* row = pm + (size_t)n * PM_LD;
        {
            float v[4]; float ss = 0.f;
#pragma unroll
            for (int i = 0; i < 4; ++i) { v[i] = bf2f(row[PM_CQ + lane * 4 + i]); ss += v[i] * v[i]; }
            ss = wave_sum_fast(ss);
            const float rs = rsqrtf(ss * (1.0f / 256.0f) + 1e-6f);
#pragma unroll
            for (int i = 0; i < 4; ++i) cqn[(size_t)n * 256 + lane * 4 + i] = f2bf(v[i] * rs * qn[lane * 4 + i]);
        }
        {
            float v[2]; float ss = 0.f;
#pragma unroll
            for (int i = 0; i < 2; ++i) { v[i] = bf2f(row[PM_CKV + lane * 2 + i]); ss += v[i] * v[i]; }
            ss = wave_sum_fast(ss);
            const float rs = rsqrtf(ss * (1.0f / 128.0f) + 1e-6f);
#pragma unroll
            for (int i = 0; i < 2; ++i) kv[(size_t)n * 160 + lane * 2 + i] = f2bf(v[i] * rs * kvn[lane * 2 + i]);
        }
        if (lane < 16) {
            const float x1 = bf2f(row[PM_KROPE + lane]), x2 = bf2f(row[PM_KROPE + 16 + lane]);
            const float c = ctab[t * 16 + lane], s = stab[t * 16 + lane];
            kv[(size_t)n * 160 + 128 + lane] = f2bf(x1 * c - x2 * s);
            kv[(size_t)n * 160 + 144 + lane] = f2bf(x2 * c + x1 * s);
        }
        {
            const float x = bf2f(row[PM_KIDX + lane]);
            const float mu = wave_sum_fast(x) * (1.0f / 64.0f);
            const float d = x - mu;
            const float var = wave_sum_fast(d * d) * (1.0f / 64.0f);
            const float y = d * rsqrtf(var + 1e-6f) * inw[lane] + inb[lane];
            const float yo = __shfl_xor(y, 16);
            float o = y;
            if (lane < 32) {
                const int i = lane & 15;
                const float c = ctab[t * 16 + i], s = stab[t * 16 + i];
                o = (lane < 16) ? (y * c - yo * s) : (y * c + yo * s);
            }
            kidx[(size_t)n * 64 + lane] = f2bf(o);
        }
        {
            const uint4 hv0 = *(const uint4*)(hrow + (size_t)n * DM + lane * 16), hv1 = *(const uint4*)(hrow + (size_t)n * DM + lane * 16 + 8);
            float hx[16];
            hx[0] = __uint_as_float(hv0.x << 16); hx[1] = __uint_as_float(hv0.x & 0xFFFF0000u); hx[2] = __uint_as_float(hv0.y << 16); hx[3] = __uint_as_float(hv0.y & 0xFFFF0000u);
            hx[4] = __uint_as_float(hv0.z << 16); hx[5] = __uint_as_float(hv0.z & 0xFFFF0000u); hx[6] = __uint_as_float(hv0.w << 16); hx[7] = __uint_as_float(hv0.w & 0xFFFF0000u);
            hx[8] = __uint_as_float(hv1.x << 16); hx[9] = __uint_as_float(hv1.x & 0xFFFF0000u); hx[10] = __uint_as_float(hv1.y << 16); hx[11] = __uint_as_float(hv1.y & 0xFFFF0000u);
            hx[12] = __uint_as_float(hv1.z << 16); hx[13] = __uint_as_float(hv1.z & 0xFFFF0000u); hx[14] = __uint_as_float(hv1.w << 16); hx[15] = __uint_as_float(hv1.w & 0xFFFF0000u);
            float myw = 0.f;
#pragma unroll
            for (int j = 0; j < 8; ++j) {
                const uint4 w0 = *(const uint4*)(wwidx + (size_t)j * DM + lane * 16), w1 = *(const uint4*)(wwidx + (size_t)j * DM + lane * 16 + 8);
                float d = hx[0] * __uint_as_float(w0.x << 16) + hx[1] * __uint_as_float(w0.x & 0xFFFF0000u) + hx[2] * __uint_as_float(w0.y << 16) + hx[3] * __uint_as_float(w0.y & 0xFFFF0000u)
                        + hx[4] * __uint_as_float(w0.z << 16) + hx[5] * __uint_as_float(w0.z & 0xFFFF0000u) + hx[6] * __uint_as_float(w0.w << 16) + hx[7] * __uint_as_float(w0.w & 0xFFFF0000u)
                        + hx[8] * __uint_as_float(w1.x << 16) + hx[9] * __uint_as_float(w1.x & 0xFFFF0000u) + hx[10] * __uint_as_float(w1.y << 16) + hx[11] * __uint_as_float(w1.y & 0xFFFF0000u)
                        + hx[12] * __uint_as_float(w1.z << 16) + hx[13] * __uint_as_float(w1.z & 0xFFFF0000u) + hx[14] * __uint_as_float(w1.w << 16) + hx[15] * __uint_as_float(w1.w & 0xFFFF0000u);
                d = wave_sum_fast(d);
                myw = (lane == j) ? d : myw;
            }
            if (lane < 8) whead[(size_t)n * 8 + lane] = myw * rstd_[n] * 0.04419417382415922f;
        }
    }
}

typedef short s16x4 __attribute__((ext_vector_type(4)));
__device__ __forceinline__ unsigned f2h_bits(float f) { const _Float16 h = (_Float16)f; unsigned short u; __builtin_memcpy(&u, &h, 2); return u; }
template <bool IMPORT_SEL>
__device__ void phase_dsa(const Params& p, int l, unsigned char* lds, bf16_t* yc, const unsigned short* gsel, const int* gnsel, int tb, int te, int tstep) {
    const int tid = otid(), lane = tid & 63, wid = tid >> 6, fr = lane & 15, fq = lane >> 4;
    unsigned short* s_sc = (unsigned short*)lds;
    bf16_t* s_qi = (bf16_t*)(lds + 66048);
    bf16_t* s_Q = (bf16_t*)lds;
    unsigned char* s_Vw = lds + 82432 + wid * 8192;
    bf16_t* s_qn = (bf16_t*)s_Vw;
    unsigned short* s_sel = (unsigned short*)(lds + 82432 + 65536);
    int* s_nsel = (int*)(lds + 82432 + 65536 + 8192);
    unsigned char* dob = OUTB(p);
    const bf16_t* cqn = (const bf16_t*)(dob + DO_CQN);
    const bf16_t* kv = (const bf16_t*)(dob + DO_KV);
    const bf16_t* kidx = (const bf16_t*)(dob + DO_KIDX);
    const float* whead = (const float*)(dob + DO_WHEAD);
    const float* ctab = (const float*)(WS(p) + OFF_ROPE);
    const float* stab = ctab + TS * 16;
    const bf16_t* wb = (const bf16_t*)(WS(p) + OFF_WB);
    const bf16_t* wqiT = wb + WB_QI;
    const bf16_t* wuqT = wb + WB_UQ;
    const bf16_t* wuk = wb + WB_UK;
    const bf16_t* wuvT = wb + WB_UV;
    const float scale = 0.10206207261596575f;
    const f32x4 z4 = {0.f, 0.f, 0.f, 0.f};
    for (int tile = tb; tile < te; tile += tstep) {
        const int qt = 128 - (tile >> 3), b = tile & 7;
        const int t0 = qt * 16;
        const size_t n0 = (size_t)b * TS + t0;
        {
            bf16x8 acq[8];
#pragma unroll
            for (int kk = 0; kk < 8; ++kk) acq[kk] = *(const bf16x8*)(cqn + (n0 + fr) * 256 + kk * 32 + fq * 8);
            f32x4 c[4] = {z4, z4, z4, z4};
#pragma unroll
            for (int kb = 0; kb < 8; kb += 4) {
                bf16x8 bf[4][4];
#pragma unroll
                for (int k4 = 0; k4 < 4; ++k4)
#pragma unroll
                    for (int nt = 0; nt < 4; ++nt) bf[k4][nt] = *(const bf16x8*)(wqiT + (size_t)(wid * 64 + nt * 16 + fr) * 256 + (kb + k4) * 32 + fq * 8);
#pragma unroll
                for (int k4 = 0; k4 < 4; ++k4)
#pragma unroll
                    for (int nt = 0; nt < 4; ++nt) c[nt] = __builtin_amdgcn_mfma_f32_16x16x32_bf16(acq[kb + k4], bf[k4][nt], c[nt], 0, 0, 0);
            }
#pragma unroll
            for (int j = 0; j < 4; ++j) {
                const int t = t0 + fq * 4 + j;
                const float cs = ctab[t * 16 + fr], sn = stab[t * 16 + fr];
                const float x1 = c[0][j], x2 = c[1][j];
                c[0][j] = x1 * cs - x2 * sn; c[1][j] = x2 * cs + x1 * sn;
            }
#pragma unroll
            for (int nt = 0; nt < 4; ++nt)
#pragma unroll
                for (int j = 0; j < 4; ++j) s_qi[(fq * 4 + j) * 512 + wid * 64 + nt * 16 + fr] = f2bf(c[nt][j]);
        }
        __syncthreads();
        if (!IMPORT_SEL) {
            bf16x8 aq[8][2];
#pragma unroll
            for (int h = 0; h < 8; ++h)
#pragma unroll
                for (int ks = 0; ks < 2; ++ks) aq[h][ks] = *(const bf16x8*)(s_qi + fr * 512 + h * 64 + ks * 32 + fq * 8);
            float wh[4][8];
#pragma unroll
            for (int j = 0; j < 4; ++j) {
                const float4 w0 = *(const float4*)(whead + (n0 + fq * 4 + j) * 8), w1 = *(const float4*)(whead + (n0 + fq * 4 + j) * 8 + 4);
                wh[j][0] = w0.x; wh[j][1] = w0.y; wh[j][2] = w0.z; wh[j][3] = w0.w; wh[j][4] = w1.x; wh[j][5] = w1.y; wh[j][6] = w1.z; wh[j][7] = w1.w;
            }
            const int nkt = qt + 1;
            bf16x8 nb0 = {0, 0, 0, 0, 0, 0, 0, 0}, nb1 = nb0;
            if (wid < nkt) { const bf16_t* kr0 = kidx + ((size_t)b * TS + wid * 16 + fr) * 64 + fq * 8; nb0 = *(const bf16x8*)kr0; nb1 = *(const bf16x8*)(kr0 + 32); }
#pragma unroll 1
            for (int kt = wid; kt < nkt; kt += 8) {
                const bf16x8 bk0 = nb0, bk1 = nb1;
                if (kt + 8 < nkt) { const bf16_t* krn = kidx + ((size_t)b * TS + (kt + 8) * 16 + fr) * 64 + fq * 8; nb0 = *(const bf16x8*)krn; nb1 = *(const bf16x8*)(krn + 32); }
                float I[4] = {0.f, 0.f, 0.f, 0.f};
#pragma unroll
                for (int h = 0; h < 8; ++h) {
                    f32x4 a = __builtin_amdgcn_mfma_f32_16x16x32_bf16(aq[h][0], bk0, z4, 0, 0, 0);
                    a = __builtin_amdgcn_mfma_f32_16x16x32_bf16(aq[h][1], bk1, a, 0, 0, 0);
#pragma unroll
                    for (int j = 0; j < 4; ++j) I[j] += wh[j][h] * fmaxf(a[j], 0.f);
                }
#pragma unroll
                for (int j = 0; j < 4; ++j) s_sc[(fq * 4 + j) * 2064 + kt * 16 + fr] = (unsigned short)f2h_bits(I[j]);
            }
        }
        __syncthreads();
#pragma unroll 1
        for (int qi2 = 0; qi2 < 2; ++qi2) {
            const int q = wid + qi2 * 8;
            const int nadm = t0 + q + 1;
            unsigned short* sel = s_sel + q * 256;
            if (IMPORT_SEL) {
                const int ns = gnsel[n0 + q];
                for (int i = lane; i < ns; i += 64) sel[i] = gsel[(n0 + q) * 256 + i];
                if (lane == 0) s_nsel[q] = ns;
            } else if (nadm <= 256) {
                for (int i = lane; i < nadm; i += 64) sel[i] = (unsigned short)i;
                if (lane == 0) s_nsel[q] = nadm;
            } else {
                auto topk = [&](auto nch_tag) {
                    constexpr int NCH = decltype(nch_tag)::value;
                    unsigned key[NCH];
    #pragma unroll
                    for (int c = 0; c < NCH; ++c) {
                        const int s = c * 64 + lane;
                        unsigned k = 0u;
                        if (s < nadm) { const unsigned u = s_sc[q * 2064 + s]; k = (u & 0x8000u) ? (~u & 0xFFFFu) : (u | 0x8000u); }
                        key[c] = k;
                    }
                    unsigned T = 0u;
    #pragma unroll 1
                    for (int bit = 15; bit >= 0; --bit) {
                        const unsigned cand = T | (1u << bit);
                        int cnt = 0;
    #pragma unroll
                        for (int c = 0; c < NCH; ++c) cnt += __popcll(__ballot(key[c] >= cand));
                        if (cnt >= 256) T = cand;
                    }
                    int ngt = 0;
    #pragma unroll
                    for (int c = 0; c < NCH; ++c) ngt += __popcll(__ballot(key[c] > T));
                    const int rties = 256 - ngt;
                    int base = 0, ties = 0;
                    const unsigned long long ltmask = (1ull << lane) - 1ull;
    #pragma unroll
                    for (int c = 0; c < NCH; ++c) {
                        const bool gt = key[c] > T, eq = key[c] == T;
                        const unsigned long long em = __ballot(eq);
                        const int myrank = ties + __popcll(em & ltmask);
                        const bool take = gt || (eq && myrank < rties);
                        const unsigned long long tm = __ballot(take);
                        const int pos = base + __popcll(tm & ltmask);
                        if (take && pos < 256) sel[pos] = (unsigned short)(c * 64 + lane);
                        base += __popcll(tm); ties += __popcll(em);
                    }

                };
                if (nadm <= 512) topk(std::integral_constant<int, 8>{});
                else if (nadm <= 1024) topk(std::integral_constant<int, 16>{});
                else if (nadm <= 1536) topk(std::integral_constant<int, 24>{});
                else topk(std::integral_constant<int, 33>{});
                if (lane == 0) s_nsel[q] = 256;
            }
        }
        __syncthreads();
#pragma unroll 1
        for (int hi = 0; hi < 2; ++hi) {
            const int hh = wid * 2 + hi;
            bf16x8 acq[8];
#pragma unroll
            for (int kk = 0; kk < 8; ++kk) acq[kk] = *(const bf16x8*)(cqn + (n0 + fr) * 256 + kk * 32 + fq * 8);
            f32x4 c6[6] = {z4, z4, z4, z4, z4, z4};
#pragma unroll
            for (int kb = 0; kb < 8; kb += 4) {
                bf16x8 bf[4][6];
#pragma unroll
                for (int k4 = 0; k4 < 4; ++k4)
#pragma unroll
                    for (int nt = 0; nt < 6; ++nt) bf[k4][nt] = *(const bf16x8*)(wuqT + (size_t)(hh * 96 + nt * 16 + fr) * 256 + (kb + k4) * 32 + fq * 8);
#pragma unroll
                for (int k4 = 0; k4 < 4; ++k4)
#pragma unroll
                    for (int nt = 0; nt < 6; ++nt) c6[nt] = __builtin_amdgcn_mfma_f32_16x16x32_bf16(acq[kb + k4], bf[k4][nt], c6[nt], 0, 0, 0);
            }
#pragma unroll
            for (int j = 0; j < 4; ++j) {
                const int q = fq * 4 + j, t = t0 + q;
                const float cs = ctab[t * 16 + fr], sn = stab[t * 16 + fr];
                const float x1 = c6[4][j], x2 = c6[5][j];
                s_Q[(q * 16 + hh) * 160 + 128 + fr] = f2bf(x1 * cs - x2 * sn);
                s_Q[(q * 16 + hh) * 160 + 144 + fr] = f2bf(x2 * cs + x1 * sn);
#pragma unroll
                for (int nt = 0; nt < 4; ++nt) s_qn[q * 64 + nt * 16 + fr] = f2bf(c6[nt][j]);
            }
            __syncthreads();
            bf16x8 an[2];
#pragma unroll
            for (int ks = 0; ks < 2; ++ks) an[ks] = *(const bf16x8*)(s_qn + fr * 64 + ks * 32 + fq * 8);
            bf16x8 bwk[8][2];
#pragma unroll
            for (int nt = 0; nt < 8; ++nt)
#pragma unroll
                for (int ks = 0; ks < 2; ++ks) bwk[nt][ks] = *(const bf16x8*)(wuk + (size_t)(hh * 128 + nt * 16 + fr) * 64 + ks * 32 + fq * 8);
#pragma unroll
            for (int nt = 0; nt < 8; ++nt) {
                f32x4 a = z4;
#pragma unroll
                for (int ks = 0; ks < 2; ++ks)
                    a = __builtin_amdgcn_mfma_f32_16x16x32_bf16(an[ks], bwk[nt][ks], a, 0, 0, 0);
#pragma unroll
                for (int j = 0; j < 4; ++j) s_Q[((fq * 4 + j) * 16 + hh) * 160 + nt * 16 + fr] = f2bf(a[j]);
            }
            __syncthreads();
        }
#pragma unroll 1
        for (int qi2 = 0; qi2 < 2; ++qi2) {
            const int q = wid + qi2 * 8;
            bf16x8 bq[5];
#pragma unroll
            for (int ks = 0; ks < 5; ++ks) bq[ks] = *(const bf16x8*)(s_Q + (q * 16 + fr) * 160 + ks * 32 + fq * 8);
            const int nsel = s_nsel[q];
            const unsigned short* sel = s_sel + q * 256;
            float m = -INFINITY, lsum = 0.f;
            f32x4 O[8] = {z4, z4, z4, z4, z4, z4, z4, z4};
            const int nchunk = (nsel + 31) >> 5;
            bf16x8 akn[2][5];
#pragma unroll
            for (int mt = 0; mt < 2; ++mt) {
                const int ki = mt * 16 + fr;
                const int sidx = sel[ki < nsel ? ki : 0];
                const bf16_t* krow = kv + ((size_t)b * TS + sidx) * 160 + fq * 8;
#pragma unroll
                for (int ks = 0; ks < 5; ++ks) akn[mt][ks] = *(const bf16x8*)(krow + ks * 32);
            }
#pragma unroll 1
            for (int ch = 0; ch < nchunk; ++ch) {
                bf16x8 ak[2][5];
#pragma unroll
                for (int mt = 0; mt < 2; ++mt)
#pragma unroll
                    for (int ks = 0; ks < 5; ++ks) ak[mt][ks] = akn[mt][ks];
                if (ch + 1 < nchunk) {
#pragma unroll
                    for (int mt = 0; mt < 2; ++mt) {
                        const int ki = (ch + 1) * 32 + mt * 16 + fr;
                        const int sidx = sel[ki < nsel ? ki : 0];
                        const bf16_t* krow = kv + ((size_t)b * TS + sidx) * 160 + fq * 8;
#pragma unroll
                        for (int ks = 0; ks < 5; ++ks) akn[mt][ks] = *(const bf16x8*)(krow + ks * 32);
                    }
                }
#pragma unroll
                for (int mt = 0; mt < 2; ++mt)
#pragma unroll
                    for (int ks = 0; ks < 4; ++ks) {
                        const int r = mt * 16 + fr;
                        *(bf16x8*)(s_Vw + r * 256 + (((ks * 2 + (fq >> 1)) ^ (r & 7)) * 32) + (fq & 1) * 16) = ak[mt][ks];
                    }
                f32x4 st[2] = {z4, z4};
#pragma unroll
                for (int mt = 0; mt < 2; ++mt)
#pragma unroll
                    for (int ks = 0; ks < 5; ++ks) st[mt] = __builtin_amdgcn_mfma_f32_16x16x32_bf16(ak[mt][ks], bq[ks], st[mt], 0, 0, 0);
                float sv[2][4]; float cmax = -INFINITY;
#pragma unroll
                for (int mt = 0; mt < 2; ++mt)
#pragma unroll
                    for (int j = 0; j < 4; ++j) {
                        const int ke = ch * 32 + mt * 16 + fq * 4 + j;
                        const float s_ = (ke < nsel) ? st[mt][j] * scale : -INFINITY;
                        sv[mt][j] = s_; cmax = fmaxf(cmax, s_);
                    }
                cmax = fmaxf(cmax, __shfl_xor(cmax, 16)); cmax = fmaxf(cmax, __shfl_xor(cmax, 32));
                const float mnew = fmaxf(m, cmax);
                const float alpha = __expf(m - mnew);
                float psum = 0.f;
#pragma unroll
                for (int mt = 0; mt < 2; ++mt)
#pragma unroll
                    for (int j = 0; j < 4; ++j) { const float pe = __expf(sv[mt][j] - mnew); sv[mt][j] = pe; psum += pe; }
                psum += __shfl_xor(psum, 16); psum += __shfl_xor(psum, 32);
                lsum = lsum * alpha + psum; m = mnew;
#pragma unroll
                for (int ct = 0; ct < 8; ++ct) O[ct] = O[ct] * alpha;
                bf16x8 pf;
#pragma unroll
                for (int mt = 0; mt < 2; ++mt)
#pragma unroll
                    for (int j = 0; j < 4; ++j) pf[mt * 4 + j] = (short)f2bf(sv[mt][j]);
                const int q_ = fr >> 2, p_ = fr & 3;
                const int r0 = fq * 4 + q_, r1 = 16 + r0;
#pragma unroll
                for (int ct = 0; ct < 8; ++ct) {
                    const s16x4 v0 = __builtin_amdgcn_ds_read_tr16_b64_v4i16((__attribute__((address_space(3))) s16x4*)(s_Vw + r0 * 256 + ((ct ^ (r0 & 7)) * 32) + p_ * 8));
                    const s16x4 v1 = __builtin_amdgcn_ds_read_tr16_b64_v4i16((__attribute__((address_space(3))) s16x4*)(s_Vw + r1 * 256 + ((ct ^ (r1 & 7)) * 32) + p_ * 8));
                    bf16x8 av; av[0] = v0[0]; av[1] = v0[1]; av[2] = v0[2]; av[3] = v0[3]; av[4] = v1[0]; av[5] = v1[1]; av[6] = v1[2]; av[7] = v1[3];
                    O[ct] = __builtin_amdgcn_mfma_f32_16x16x32_bf16(av, pf, O[ct], 0, 0, 0);
                }
            }
            const float inv = 1.0f / lsum;
#pragma unroll
            for (int ct = 0; ct < 8; ++ct)
#pragma unroll
                for (int j = 0; j < 4; ++j) s_Q[(q * 16 + fr) * 160 + ct * 16 + fq * 4 + j] = f2bf(O[ct][j] * inv);
        }
        __syncthreads();
#pragma unroll 1
        for (int hi = 0; hi < 2; ++hi) {
            const int hh = wid * 2 + hi;
            bf16x8 ao[4];
#pragma unroll
            for (int ks = 0; ks < 4; ++ks) ao[ks] = *(const bf16x8*)(s_Q + (fr * 16 + hh) * 160 + ks * 32 + fq * 8);
#pragma unroll
            for (int nt = 0; nt < 4; ++nt) {
                f32x4 a = z4;
#pragma unroll
                for (int ks = 0; ks < 4; ++ks)
                    a = __builtin_amdgcn_mfma_f32_16x16x32_bf16(ao[ks], *(const bf16x8*)(wuvT + (size_t)(hh * 64 + nt * 16 + fr) * 128 + ks * 32 + fq * 8), a, 0, 0, 0);
#pragma unroll
                for (int j = 0; j < 4; ++j) yc[(n0 + fq * 4 + j) * 1024 + hh * 64 + nt * 16 + fr] = f2bf(a[j]);
            }
        }
        __syncthreads();
    }
}


__device__ void phase_lr_prep(const Params& p, int l) {
    const int lane = otid() & 63;
    const int wave = (obid() * NTHR + otid()) >> 6, nw = gridDim.x * NTHR / 64;
    const bf16_t* pm = (const bf16_t*)(WS(p) + OFF_PMISC);
    bf16_t* alr = (bf16_t*)(OUTB(p) + DO_ALR);
    const float* mu = p.in[4] + (size_t)l * 3328 + 3072;
    const float* vmu = p.in[18];
    for (int n = wave; n < NT; n += nw) {
        const int t = n % TS;
        for (int c = lane; c < 288; c += 64) {
            const float cur = bf2f(pm[(size_t)n * PM_LD + c]);
            const float prv = (t > 0) ? bf2f(pm[(size_t)(n - 1) * PM_LD + c]) : 0.f;
            const float m_ = (c < 256) ? mu[c] : vmu[c - 256];
            float xs = cur + (prv - cur) * m_;
            if (c < 64) xs = tanhf(xs);
            else if (c >= 128 && c < 256) xs = sigmoidf_(xs);
            alr[(size_t)n * 288 + c] = f2bf(xs);
        }
    }
}

constexpr int SC_TC = 32;
constexpr int SC_ROWB = 1088;
__device__ __forceinline__ const unsigned char* scan_piece_src(const Params& p, int l, int b, int hc, int t0, int pi, bool& ok) {
    const int tau = pi / 68, seg = pi - tau * 68;
    const int t = t0 + tau;
    ok = (t < TS) && (tau < SC_TC);
    const size_t n = (size_t)b * TS + t;
    const unsigned char* ws = WS(p);
    if (seg < 8) return ws + OFF_PR + (n * 1024 + hc) * 2 + seg * 16;
    if (seg < 16) return ws + OFF_PK + (n * 1024 + hc) * 2 + (seg - 8) * 16;
    if (seg < 24) return ws + OFF_PV + (n * 1024 + hc) * 2 + (seg - 16) * 16;
    if (seg < 60) return OUTB(p) + DO_ALR + (n * 288) * 2 + (seg - 24) * 16;
    ok = ok && (l > 0);
    return ws + OFF_VFIRST + (n * 1024 + hc) * 2 + (seg - 60) * 16;
}
__device__ void phase_scan5(const Params& p, int l, unsigned char* lds, int blk) {
    const int tid = otid(), lane = tid & 63, wid = tid >> 6, fr = lane & 15, fq = lane >> 4;
    const int b = blk >> 4, hh = blk & 15, hc = hh * 64;
    float* s_r = (float*)lds;
    float* s_w = s_r + 2048;
    float* s_k = s_w + 2048;
    float* s_v = s_k + 2048;
    float* s_a = s_v + 2048;
    float* s_b = s_a + 2048;
    float* s_g = s_b + 2048;
    float* s_o = s_g + 2048;
    bf16_t* A_wd = (bf16_t*)(s_o + 2048);
    bf16_t* A_ad = A_wd + 2048;
    bf16_t* A_gd = A_ad + 2048;
    bf16_t* A_vd = A_gd + 4096;
    unsigned char* raw = (unsigned char*)(A_vd + 1024);
    float* prevb = (float*)(raw + 32 * SC_ROWB);
    float* cst = prevb + 960;
    const float* mu = p.in[4] + (size_t)l * 3328;
    for (int e = tid; e < 480; e += NTHR) {
        float v;
        if (e < 192) v = mu[(e >> 6) * 1024 + hc + (e & 63)];
        else if (e < 448) v = mu[3072 + (e - 192)];
        else v = p.in[18][e - 448];
        cst[e] = v;
    }
    if (tid < 64) {
        cst[480 + tid] = p.in[7][l * 1024 + hc + tid];
        cst[544 + tid] = p.in[9][l * 1024 + hc + tid];
        cst[608 + tid] = p.in[12][l * 1024 + hc + tid];
        cst[672 + tid] = p.in[13][l * 1024 + hc + tid];
        cst[736 + tid] = p.in[14][l * 1024 + hc + tid];
        cst[800 + tid] = p.in[15][l * 1024 + hc + tid];
        cst[864 + tid] = p.in[16][l * 1024 + hc + tid];
        cst[928 + tid] = p.in[19][hc + tid];
    }
    const int mm = wid >> 1, ntb = (wid & 1) * 2;
    const int nks = (mm == 2) ? 4 : (mm == 3 ? 1 : 2);
    bf16x8 Bw[2][4];
    {
        const float* wsrc = (mm == 0) ? p.in[8] + (size_t)l * 64 * 1024 : (mm == 1) ? p.in[10] + (size_t)l * 64 * 1024 : (mm == 2) ? p.in[11] + (size_t)l * 128 * 1024 : p.in[20];
#pragma unroll
        for (int n2 = 0; n2 < 2; ++n2)
#pragma unroll
            for (int ks = 0; ks < 4; ++ks) {
                bf16x8 f;
#pragma unroll
                for (int j = 0; j < 8; ++j) {
                    const bool okw = ks < nks && (mm < 3 || l > 0);
                    const float v = wsrc[(size_t)(okw ? (ks * 32 + fq * 8 + j) : 0) * 1024 + hc + (ntb + n2) * 16 + fr];
                    f[j] = (short)f2bf(okw ? v : 0.f);
                }
                Bw[n2][ks] = f;
            }
    }
    const int cg = lane & 15, rg = lane >> 4;
    float S[8] = {0.f, 0.f, 0.f, 0.f, 0.f, 0.f, 0.f, 0.f};
    bf16_t* Pr = (bf16_t*)(WS(p) + OFF_PR);
    bf16_t* vfirst = (bf16_t*)(WS(p) + OFF_VFIRST);
    const unsigned char* psrc[5]; int pstep[5], ptau[5]; bool pval[5];
#pragma unroll
    for (int k = 0; k < 5; ++k) {
        const int pi = tid + k * NTHR;
        bool ok = false;
        psrc[k] = scan_piece_src(p, l, b, hc, 0, pi < SC_TC * 68 ? pi : 0, ok);
        const int tau = (pi < SC_TC * 68 ? pi : 0) / 68, seg = (pi < SC_TC * 68 ? pi : 0) - tau * 68;
        ptau[k] = tau;
        pstep[k] = SC_TC * ((seg >= 24 && seg < 60) ? 576 : 2048);
        pval[k] = (pi < SC_TC * 68) && !(seg >= 60 && l == 0);
    }
    uint4 pre[5];
#pragma unroll
    for (int k = 0; k < 5; ++k) { pre[k] = make_uint4(0, 0, 0, 0); if (pval[k] && ptau[k] < TS) pre[k] = *(const uint4*)psrc[k]; }
    __syncthreads();
#pragma unroll 1
    for (int t0 = 0, ch = 0; t0 < TS; t0 += SC_TC, ++ch) {
        const int nval = (TS - t0 < SC_TC) ? (TS - t0) : SC_TC;
#pragma unroll
        for (int k = 0; k < 5; ++k) { const int pi = tid + k * NTHR; if (pi < SC_TC * 68) *(uint4*)(raw + pi * 16) = pre[k]; }
        lds_barrier();
#pragma unroll
        for (int k = 0; k < 5; ++k) {
            pre[k] = make_uint4(0, 0, 0, 0);
            if (pval[k] && t0 + SC_TC + ptau[k] < TS) pre[k] = *(const uint4*)(psrc[k] + (size_t)(ch + 1) * pstep[k]);
        }
        {
            float* pwb = prevb + (ch & 1) * 192;
            const float* pvb = prevb + ((ch + 1) & 1) * 192;
            for (int it = tid; it < SC_TC * 96; it += NTHR) {
                const int tau = it / 96, c2 = (it - tau * 96) * 2;
                const unsigned cu = *(const unsigned*)(raw + tau * SC_ROWB + c2 * 2);
                const float c0 = __uint_as_float(cu << 16), c1 = __uint_as_float(cu & 0xFFFF0000u);
                float p0, p1;
                if (tau > 0) { const unsigned pu = *(const unsigned*)(raw + (tau - 1) * SC_ROWB + c2 * 2); p0 = __uint_as_float(pu << 16); p1 = __uint_as_float(pu & 0xFFFF0000u); }
                else if (t0 > 0) { p0 = pvb[c2]; p1 = pvb[c2 + 1]; }
                else { p0 = 0.f; p1 = 0.f; }
                if (tau == SC_TC - 1) { pwb[c2] = c0; pwb[c2 + 1] = c1; }
                const float x0 = c0 + (p0 - c0) * cst[c2], x1 = c1 + (p1 - c1) * cst[c2 + 1];
                float* dstv = (c2 < 64) ? (s_r + tau * 64 + c2) : (c2 < 128) ? (s_k + tau * 64 + c2 - 64) : (s_v + tau * 64 + c2 - 128);
                *(float2*)dstv = make_float2(x0, x1);
            }
        }
        if (mm < 3 || l > 0) {
            const unsigned char* Ab = raw + ((mm == 0) ? 384 : (mm == 1) ? 512 : (mm == 2) ? 640 : 896);
            float* dst = (mm == 0) ? s_w : (mm == 1) ? s_a : (mm == 2) ? s_g : s_o;
#pragma unroll
            for (int m = 0; m < 2; ++m) {
                f32x4 acc0 = {0.f, 0.f, 0.f, 0.f}, acc1 = {0.f, 0.f, 0.f, 0.f};
#pragma unroll
                for (int ks = 0; ks < 4; ++ks) {
                    if (ks < nks) {
                        const bf16x8 a = *(const bf16x8*)(Ab + (m * 16 + fr) * SC_ROWB + ks * 64 + fq * 16);
                        acc0 = __builtin_amdgcn_mfma_f32_16x16x32_bf16(a, Bw[0][ks], acc0, 0, 0, 0);
                        acc1 = __builtin_amdgcn_mfma_f32_16x16x32_bf16(a, Bw[1][ks], acc1, 0, 0, 0);
                    }
                }
#pragma unroll
                for (int j = 0; j < 4; ++j) {
                    dst[(m * 16 + fq * 4 + j) * 64 + ntb * 16 + fr] = acc0[j];
                    dst[(m * 16 + fq * 4 + j) * 64 + (ntb + 1) * 16 + fr] = acc1[j];
                }
            }
        }
        lds_barrier();
        {
            const int tau = tid >> 4, c4 = (tid & 15) * 4, e = tau * 64 + c4, t = t0 + tau;
            const size_t n = (size_t)b * TS + t;
            const float4 xw4 = *(const float4*)(s_w + e), xa4 = *(const float4*)(s_a + e), kr4 = *(const float4*)(s_k + e);
            float4 vv4 = *(const float4*)(s_v + e);
            const float4 cw = *(const float4*)(cst + 480 + c4), ca = *(const float4*)(cst + 544 + c4), ckk = *(const float4*)(cst + 608 + c4), cka = *(const float4*)(cst + 672 + c4);
            const float xw[4] = {xw4.x + cw.x, xw4.y + cw.y, xw4.z + cw.z, xw4.w + cw.w};
            const float xa[4] = {xa4.x + ca.x, xa4.y + ca.y, xa4.z + ca.z, xa4.w + ca.w};
            const float kr[4] = {kr4.x, kr4.y, kr4.z, kr4.w};
            const float kkc[4] = {ckk.x, ckk.y, ckk.z, ckk.w}, kac[4] = {cka.x, cka.y, cka.z, cka.w};
            float vv[4] = {vv4.x, vv4.y, vv4.z, vv4.w};
            if (l > 0) {
                const float4 xv4 = *(const float4*)(s_o + e), cv = *(const float4*)(cst + 928 + c4);
                const uint2 vfu = *(const uint2*)(raw + tau * SC_ROWB + 960 + c4 * 2);
                const float vf[4] = {__uint_as_float(vfu.x << 16), __uint_as_float(vfu.x & 0xFFFF0000u), __uint_as_float(vfu.y << 16), __uint_as_float(vfu.y & 0xFFFF0000u)};
                const float xv[4] = {xv4.x + cv.x, xv4.y + cv.y, xv4.z + cv.z, xv4.w + cv.w};
#pragma unroll
                for (int j = 0; j < 4; ++j) vv[j] = vv[j] + (vf[j] - vv[j]) * fast_sigmoid(xv[j]);
            } else if (t < TS) {
                *(uint2*)(vfirst + n * 1024 + hc + c4) = pack4(vv[0], vv[1], vv[2], vv[3]);
            }
            float dec[4], av[4], kkv[4]; float ss = 0.f;
#pragma unroll
            for (int j = 0; j < 4; ++j) {
                dec[j] = __expf(-0.6065306597126334f * fast_sigmoid(xw[j]));
                av[j] = fast_sigmoid(xa[j]);
                kkv[j] = kr[j] * kkc[j];
                ss += kkv[j] * kkv[j];
            }
            ss = row16_sum(ss);
            const float rn = rsqrtf(fmaxf(ss, 1e-24f));
            float kk[4];
#pragma unroll
            for (int j = 0; j < 4; ++j) kk[j] = kkv[j] * rn;
            *(float4*)(s_w + e) = make_float4(dec[0], dec[1], dec[2], dec[3]);
            *(float4*)(s_a + e) = make_float4(-kk[0], -kk[1], -kk[2], -kk[3]);
            *(float4*)(s_b + e) = make_float4(kk[0] * av[0], kk[1] * av[1], kk[2] * av[2], kk[3] * av[3]);
            *(float4*)(s_k + e) = make_float4(kr[0] * (1.0f + (av[0] - 1.0f) * kac[0]), kr[1] * (1.0f + (av[1] - 1.0f) * kac[1]), kr[2] * (1.0f + (av[2] - 1.0f) * kac[2]), kr[3] * (1.0f + (av[3] - 1.0f) * kac[3]));
            *(float4*)(s_v + e) = make_float4(vv[0], vv[1], vv[2], vv[3]);
        }
        lds_barrier();
        {
            struct VS { float4 w0, w1, b0, b1, k0, k1, r0, r1, a0, a1; float v; };
            VS X, Y;
            const int i_ = tid >> 3, c8 = (tid & 7) * 8;
            auto ld = [&](VS& N, int tn, int tn2) {
                N.a0 = *(const float4*)(s_a + tn2 * 64 + c8); N.a1 = *(const float4*)(s_a + tn2 * 64 + c8 + 4);
                N.w0 = *(const float4*)(s_w + tn * 64 + c8); N.w1 = *(const float4*)(s_w + tn * 64 + c8 + 4);
                N.b0 = *(const float4*)(s_b + tn * 64 + c8); N.b1 = *(const float4*)(s_b + tn * 64 + c8 + 4);
                N.k0 = *(const float4*)(s_k + tn * 64 + c8); N.k1 = *(const float4*)(s_k + tn * 64 + c8 + 4);
                N.r0 = *(const float4*)(s_r + tn * 64 + c8); N.r1 = *(const float4*)(s_r + tn * 64 + c8 + 4);
                N.v = s_v[tn * 64 + i_];
            };
            float sa;
            {
                const float4 a0 = *(const float4*)(s_a + c8), a1 = *(const float4*)(s_a + c8 + 4);
                sa = S[0] * a0.x + S[1] * a0.y + S[2] * a0.z + S[3] * a0.w + S[4] * a1.x + S[5] * a1.y + S[6] * a1.z + S[7] * a1.w;
                float du = 0.f;
                row8_sum2(sa, du);
            }
            ld(X, 0, 1);
            auto step = [&](VS& C, VS& N, int tau) {
                const int tn = (tau + 1 < SC_TC) ? tau + 1 : tau, tn2 = (tau + 2 < SC_TC) ? tau + 2 : tau;
                ld(N, tn, tn2);
                const float vi = C.v;
                S[0] = S[0] * C.w0.x + (sa * C.b0.x + vi * C.k0.x); S[1] = S[1] * C.w0.y + (sa * C.b0.y + vi * C.k0.y);
                S[2] = S[2] * C.w0.z + (sa * C.b0.z + vi * C.k0.z); S[3] = S[3] * C.w0.w + (sa * C.b0.w + vi * C.k0.w);
                S[4] = S[4] * C.w1.x + (sa * C.b1.x + vi * C.k1.x); S[5] = S[5] * C.w1.y + (sa * C.b1.y + vi * C.k1.y);
                S[6] = S[6] * C.w1.z + (sa * C.b1.z + vi * C.k1.z); S[7] = S[7] * C.w1.w + (sa * C.b1.w + vi * C.k1.w);
                float o = S[0] * C.r0.x + S[1] * C.r0.y + S[2] * C.r0.z + S[3] * C.r0.w + S[4] * C.r1.x + S[5] * C.r1.y + S[6] * C.r1.z + S[7] * C.r1.w;
                sa = S[0] * C.a0.x + S[1] * C.a0.y + S[2] * C.a0.z + S[3] * C.a0.w + S[4] * C.a1.x + S[5] * C.a1.y + S[6] * C.a1.z + S[7] * C.a1.w;
                row8_sum2(sa, o);
                if ((tid & 7) == 0) s_o[tau * 64 + i_] = o;
            };
#pragma unroll 1
            for (int tau = 0; tau < nval; tau += 2) { step(X, Y, tau); step(Y, X, tau + 1); }
        }
        lds_barrier();
        {
            const int tau = tid >> 4, c4 = (tid & 15) * 4, e = tau * 64 + c4;
            const size_t n = (size_t)b * TS + t0 + tau;
            const float4 o4 = *(const float4*)(s_o + e), r4_ = *(const float4*)(s_r + e), k4_ = *(const float4*)(s_k + e), v4_ = *(const float4*)(s_v + e), g4_ = *(const float4*)(s_g + e);
            const float4 crk = *(const float4*)(cst + 736 + c4), clw = *(const float4*)(cst + 800 + c4), clb = *(const float4*)(cst + 864 + c4);
            float osum = (o4.x + o4.y) + (o4.z + o4.w);
            float bsum = r4_.x * k4_.x * crk.x + r4_.y * k4_.y * crk.y + r4_.z * k4_.z * crk.z + r4_.w * k4_.w * crk.w;
            float du0 = 0.f, du1 = 0.f;
            row16_sum4(osum, bsum, du0, du1);
            const float m_ = osum * (1.0f / 64.0f);
            const float d0 = o4.x - m_, d1 = o4.y - m_, d2 = o4.z - m_, d3 = o4.w - m_;
            const float var = row16_sum(d0 * d0 + d1 * d1 + d2 * d2 + d3 * d3) * (1.0f / 64.0f);
            const float rs = rsqrtf(var + 64e-5f);
            const float y0 = (d0 * rs * clw.x + clb.x + bsum * v4_.x) * g4_.x, y1 = (d1 * rs * clw.y + clb.y + bsum * v4_.y) * g4_.y;
            const float y2 = (d2 * rs * clw.z + clb.z + bsum * v4_.z) * g4_.z, y3 = (d3 * rs * clw.w + clb.w + bsum * v4_.w) * g4_.w;
            if (tau < nval) *(uint2*)(Pr + n * 1024 + hc + c4) = pack4(y0, y1, y2, y3);
        }
    }
}

__device__ __forceinline__ void xcd_panel_map(int& mt0, int& mstep, int& nt) {
    const int b = obid(), G = (int)gridDim.x;
    if (G == 256) { nt = (b >> 3) & 7; mt0 = (b & 7) * 4 + (b >> 6); mstep = 32; }
    else { nt = b & 7; mt0 = b >> 3; mstep = G >> 3; }
}
__device__ void phase_merge(const Params& p, unsigned char* lds) {
    const int tid = otid(), lane = tid & 63, wid = tid >> 6, wr = wid >> 1, wc = wid & 1, fr = lane & 15, fq = lane >> 4;
    const bf16_t* h = (const bf16_t*)(WS(p) + OFF_H);
    const bf16_t* wb = (const bf16_t*)(WS(p) + OFF_WB);
    const float* rstd = (const float*)(WS(p) + OFF_RSTD);
    bf16_t* merged = (bf16_t*)(WS(p) + OFF_MERGED);
    const bf16_t* ysrc0 = (const bf16_t*)(WS(p) + OFF_PPOOL);
    const bf16_t* ysrc1 = (const bf16_t*)(WS(p) + OFF_PR);
    const bf16_t* ysrc2 = (const bf16_t*)(OUTB(p) + DO_YC);
    for (int tile = obid(); tile < 86 * 8; tile += gridDim.x) {
        const int mt = tile >> 3, nt = tile & 7;
        const int row0 = mt * 192, col0 = nt * 128;
        uint2 maccp[3][4];
#pragma unroll
        for (int m = 0; m < 3; ++m)
#pragma unroll
            for (int n = 0; n < 4; ++n) maccp[m][n] = make_uint2(0u, 0u);
#pragma unroll 1
        for (int i = 0; i < 3; ++i) {
            const bf16_t* ys = (i == 0) ? ysrc0 : (i == 1 ? ysrc1 : ysrc2);
            uint2 sg[3][4];
            {
                f32x4 ag[3][4]; g3_zero<3>(ag);
                G3<192> g;
                g3_setup<192>(g, [&](int r) { return h + (size_t)(row0 + r) * DM; }, [&](int r) { return wb + WB_WG + (size_t)(i * 1024 + col0 + r) * DM; }, tid);
                g3_kloop<192>(ag, g, DM, lds);
#pragma unroll
                for (int m = 0; m < 3; ++m) {
                    const float rs = rstd[row0 + wr * 48 + m * 16 + fr];
#pragma unroll
                    for (int n = 0; n < 4; ++n) sg[m][n] = pack4(fast_sigmoid(ag[m][n][0] * rs), fast_sigmoid(ag[m][n][1] * rs), fast_sigmoid(ag[m][n][2] * rs), fast_sigmoid(ag[m][n][3] * rs));
                }
            }
            {
                f32x4 ay[3][4]; g3_zero<3>(ay);
                G3<192> g;
                g3_setup<192>(g, [&](int r) { return ys + (size_t)(row0 + r) * DM; }, [&](int r) { return wb + WB_PA + (size_t)(i * 1024 + col0 + r) * DM; }, tid);
                g3_kloop<192>(ay, g, DM, lds);
#pragma unroll
                for (int m = 0; m < 3; ++m)
#pragma unroll
                    for (int n = 0; n < 4; ++n) {
                        const float m0 = __uint_as_float(maccp[m][n].x << 16) + __uint_as_float(sg[m][n].x << 16) * ay[m][n][0];
                        const float m1 = __uint_as_float(maccp[m][n].x & 0xFFFF0000u) + __uint_as_float(sg[m][n].x & 0xFFFF0000u) * ay[m][n][1];
                        const float m2 = __uint_as_float(maccp[m][n].y << 16) + __uint_as_float(sg[m][n].y << 16) * ay[m][n][2];
                        const float m3 = __uint_as_float(maccp[m][n].y & 0xFFFF0000u) + __uint_as_float(sg[m][n].y & 0xFFFF0000u) * ay[m][n][3];
                        maccp[m][n] = pack4(m0, m1, m2, m3);
                    }
            }
        }
#pragma unroll
        for (int m = 0; m < 3; ++m) {
            const int row = row0 + wr * 48 + m * 16 + fr;
#pragma unroll
            for (int n = 0; n < 4; ++n)
                *(uint2*)(merged + (size_t)row * 1024 + col0 + wc * 64 + n * 16 + fq * 4) = maccp[m][n];
        }
    }
}

__device__ void phase_outproj(const Params& p, unsigned char* lds) {
    const int tid = otid(), lane = tid & 63, wid = tid >> 6, wr = wid >> 1, wc = wid & 1, fr = lane & 15, fq = lane >> 4;
    const bf16_t* h = (const bf16_t*)(WS(p) + OFF_H);
    const bf16_t* wb = (const bf16_t*)(WS(p) + OFF_WB);
    const bf16_t* merged = (const bf16_t*)(WS(p) + OFF_MERGED);
    float* hm = (float*)(WS(p) + OFF_HM32);
    int mt0, mstep, nt;
    xcd_panel_map(mt0, mstep, nt);
    for (int mt = mt0; mt < 86; mt += mstep) {
        const int row0 = mt * 192, col0 = nt * 128;
        G3<192> g;
        g3_setup<192>(g, [&](int r) { return merged + (size_t)(row0 + r) * DM; }, [&](int r) { return wb + WB_WO + (size_t)(col0 + r) * DM; }, tid);
        f32x4 acc[3][4]; g3_zero<3>(acc);
        g3_kloop<192>(acc, g, DM, lds);
#pragma unroll
        for (int m = 0; m < 3; ++m) {
            const int row = row0 + wr * 48 + m * 16 + fr;
#pragma unroll
            for (int n = 0; n < 4; ++n) {
                const int col = col0 + wc * 64 + n * 16 + fq * 4;
                const uint2 hv = *(const uint2*)(h + (size_t)row * 1024 + col);
                float4 o;
                o.x = __uint_as_float(hv.x << 16) + acc[m][n][0]; o.y = __uint_as_float(hv.x & 0xFFFF0000u) + acc[m][n][1];
                o.z = __uint_as_float(hv.y << 16) + acc[m][n][2]; o.w = __uint_as_float(hv.y & 0xFFFF0000u) + acc[m][n][3];
                *(float4*)(hm + (size_t)row * 1024 + col) = o;
            }
        }
    }
}

__device__ __constant__ int c_pair_lo[6] = {0, 0, 0, 1, 1, 2};
__device__ __constant__ int c_pair_hi[6] = {1, 2, 3, 2, 3, 3};
__device__ void phase_route(const Params& p, int l, unsigned char* lds) {
    const int tid = otid(), lane = tid & 63, wid = tid >> 6;
    const int per = (NT + (int)gridDim.x - 1) / (int)gridDim.x;
    const int nbeg = obid() * per, nend = (nbeg + per < NT) ? nbeg + per : NT;
    int* s_cls = (int*)lds;
    int* s_base = s_cls + 512;
    float* s_wr = (float*)(lds + 4096);
    const float* hm = (const float*)(WS(p) + OFF_HM32);
    bf16_t* hn = (bf16_t*)(WS(p) + OFF_HN);
    const float* nf = p.in[33] + (size_t)l * 1024;
    const float* wg = p.in[34] + (size_t)l * 1024 * 4;
    const float* bg = p.in[35] + l * 4;
    const float* we = p.in[36] + (size_t)l * 1024 * 16;
    const float* be = p.in[37] + l * 16;
    int* cnt = (int*)(WS(p) + OFF_CTL);
    int* list = (int*)(WS(p) + OFF_LIST);
    float* pw = (float*)(WS(p) + OFF_PW);
    for (int e = tid; e < 1024 * 20; e += NTHR) {
        const int k = e / 20, c = e - k * 20;
        s_wr[c * 1024 + k] = (c < 4) ? wg[(size_t)k * 4 + c] : we[(size_t)k * 16 + (c - 4)];
    }
    __syncthreads();
    for (int n = nbeg + wid; n < nend; n += 8) {
        float ss = 0.f;
#pragma unroll
        for (int i = 0; i < 4; ++i) {
            const float4 v = *(const float4*)(hm + (size_t)n * DM + i * 256 + lane * 4);
            ss += v.x * v.x + v.y * v.y + v.z * v.z + v.w * v.w;
        }
        ss = wave_sum(ss);
        const float rs = rsqrtf(ss * (1.0f / 1024.0f) + 1e-6f);
        float lg[4] = {0.f, 0.f, 0.f, 0.f};
        float le[16];
#pragma unroll
        for (int e = 0; e < 16; ++e) le[e] = 0.f;
#pragma unroll 1
        for (int i = 0; i < 4; ++i) {
            const float4 xv = *(const float4*)(hm + (size_t)n * DM + i * 256 + lane * 4);
            const float4 nv = *(const float4*)(nf + i * 256 + lane * 4);
            float y[4] = {xv.x * rs * nv.x, xv.y * rs * nv.y, xv.z * rs * nv.z, xv.w * rs * nv.w};
            {
                const int d0 = i * 256 + lane * 4;
#pragma unroll
                for (int g = 0; g < 4; ++g) { const float4 w4 = *(const float4*)(s_wr + g * 1024 + d0); lg[g] += y[0] * w4.x + y[1] * w4.y + y[2] * w4.z + y[3] * w4.w; }
#pragma unroll
                for (int e = 0; e < 16; ++e) { const float4 w4 = *(const float4*)(s_wr + (4 + e) * 1024 + d0); le[e] += y[0] * w4.x + y[1] * w4.y + y[2] * w4.z + y[3] * w4.w; }
            }
            *(uint2*)(hn + (size_t)n * DM + i * 256 + lane * 4) = pack4(y[0], y[1], y[2], y[3]);
        }
#pragma unroll
        for (int g = 0; g < 4; ++g) lg[g] = wave_sum_fast(lg[g]) + bg[g];
#pragma unroll
        for (int e = 0; e < 16; ++e) le[e] = wave_sum_fast(le[e]) + be[e];
        if (lane == 0) {
            int gs = 0; float gm = lg[0];
#pragma unroll
            for (int g = 1; g < 4; ++g) if (lg[g] > gm) { gm = lg[g]; gs = g; }
            float den = 0.f;
#pragma unroll
            for (int g = 0; g < 4; ++g) den += __expf(lg[g] - gm);
            const float pgrp = 1.0f / den;
            float v4[4];
#pragma unroll
            for (int e = 0; e < 4; ++e) {
                const float m0 = (gs == 0) ? 1.f : 0.f, m1s = (gs == 1) ? 1.f : 0.f, m2s = (gs == 2) ? 1.f : 0.f, m3s = (gs == 3) ? 1.f : 0.f;
                v4[e] = le[e] * m0 + le[4 + e] * m1s + le[8 + e] * m2s + le[12 + e] * m3s;
            }
            int i1 = 0; float m1 = v4[0];
#pragma unroll
            for (int e = 1; e < 4; ++e) if (v4[e] > m1) { m1 = v4[e]; i1 = e; }
            int i2 = -1; float m2 = -INFINITY;
#pragma unroll
            for (int e = 0; e < 4; ++e) if (e != i1 && v4[e] > m2) { m2 = v4[e]; i2 = e; }
            const float e2 = __expf(m2 - m1);
            const float p1 = pgrp / (1.0f + e2), p2 = pgrp * e2 / (1.0f + e2);
            const int lo = i1 < i2 ? i1 : i2, hi = i1 < i2 ? i2 : i1;
            const float plo = i1 < i2 ? p1 : p2, phi = i1 < i2 ? p2 : p1;
            const int pi = (lo == 0) ? (hi - 1) : (lo == 1 ? hi + 1 : 5);
            const int cls = gs * 6 + pi;
            s_cls[n - nbeg] = cls;
            pw[(size_t)n * 2 + 0] = plo; pw[(size_t)n * 2 + 1] = phi;
        }
    }
    __syncthreads();
    const int nloc = nend - nbeg;
    if (tid < 24) {
        int c_ = 0;
        for (int i = 0; i < nloc; ++i) c_ += (s_cls[i] == tid) ? 1 : 0;
        s_base[tid] = c_ ? atomicAdd(&cnt[tid * 32], c_) : 0;
    }
    __syncthreads();
    for (int it = tid; it < nloc; it += NTHR) {
        const int cls = s_cls[it];
        int rank = 0;
        for (int i = 0; i < it; ++i) rank += (s_cls[i] == cls) ? 1 : 0;
        list[(size_t)cls * NT + s_base[cls] + rank] = nbeg + it;
    }
    __syncthreads();
}


struct MoeTile { int cls, ti, cnt, tg; };
__device__ __forceinline__ int moe_total_tiles(const int* cnt) { int s = 0; for (int c = 0; c < 24; ++c) s += (cnt[c * 32] + 127) >> 7; return s; }
__device__ __forceinline__ MoeTile moe_find(const int* cnt, int tile) {
    MoeTile r; int s = 0; r.cls = 0; r.ti = 0; r.cnt = 0; r.tg = tile;
    for (int c = 0; c < 24; ++c) { const int nt = (cnt[c * 32] + 127) >> 7; if (tile >= s && tile < s + nt) { r.cls = c; r.ti = tile - s; r.cnt = cnt[c * 32]; } s += nt; }
    return r;
}
__device__ void phase_moe1(const Params& p, unsigned char* lds) {
    const int tid = otid(), lane = tid & 63, wid = tid >> 6, wr = wid >> 1, wc = wid & 1, fr = lane & 15, fq = lane >> 4;
    const int* cnt = (const int*)(WS(p) + OFF_CTL);
    const int* list = (const int*)(WS(p) + OFF_LIST);
    const float* pw = (const float*)(WS(p) + OFF_PW);
    const bf16_t* hn = (const bf16_t*)(WS(p) + OFF_HN);
    const bf16_t* we = (const bf16_t*)(WS(p) + OFF_WEXP);
    bf16_t* hid = (bf16_t*)(OUTB(p) + DO_HID);
    const int total = moe_total_tiles(cnt);
    for (int item = obid(); item < total * 4; item += gridDim.x) {
        const MoeTile mt = moe_find(cnt, item >> 2);
        const int nt = item & 3, slot = nt >> 1, f0 = (nt & 1) * 128;
        const int g_ = mt.cls / 6, pi = mt.cls % 6;
        const int e = g_ * 4 + (slot == 0 ? c_pair_lo[pi] : c_pair_hi[pi]);
        const int* lst = list + (size_t)mt.cls * NT + mt.ti * 128;
        const int nvalid = min(128, mt.cnt - mt.ti * 128);
        f32x4 a1[2][4], a3[2][4]; g3_zero<2>(a1); g3_zero<2>(a3);
        G3D g;
#pragma unroll
        for (int i = 0; i < 2; ++i) {
            const int idx = tid + i * NTHR, row = idx >> 3, sl = (idx & 7) ^ (row & 7);
            g.ap[i] = hn + (size_t)lst[row < nvalid ? row : 0] * DM + sl * 8;
            g.b1[i] = we + WE_W1 + ((size_t)e * 256 + f0 + row) * 1024 + sl * 8;
            g.b3[i] = we + WE_W3 + ((size_t)e * 256 + f0 + row) * 1024 + sl * 8;
        }
        g3d_kloop(a1, a3, g, DM, lds);
#pragma unroll
        for (int m = 0; m < 2; ++m) {
            const int lr = wr * 32 + m * 16 + fr;
            const int tk = lst[lr < nvalid ? lr : 0];
            const float pe = pw[(size_t)tk * 2 + slot];
#pragma unroll
            for (int n = 0; n < 4; ++n) {
                const int col = slot * 256 + f0 + wc * 64 + n * 16 + fq * 4;
                float o[4];
#pragma unroll
                for (int j = 0; j < 4; ++j) { const float x1 = a1[m][n][j]; o[j] = x1 * sigmoidf_(x1) * a3[m][n][j] * pe; }
                *(uint2*)(hid + ((size_t)mt.tg * 128 + lr) * 512 + col) = pack4(o[0], o[1], o[2], o[3]);
            }
        }
    }
}
__device__ void phase_moe2(const Params& p, unsigned char* lds) {
    const int tid = otid(), lane = tid & 63, wid = tid >> 6, wr = wid >> 1, wc = wid & 1, fr = lane & 15, fq = lane >> 4;
    const int* cnt = (const int*)(WS(p) + OFF_CTL);
    const int* list = (const int*)(WS(p) + OFF_LIST);
    const bf16_t* we = (const bf16_t*)(WS(p) + OFF_WEXP);
    const bf16_t* hid = (const bf16_t*)(OUTB(p) + DO_HID);
    float* hm = (float*)(WS(p) + OFF_HM32);
    bf16_t* h = (bf16_t*)(WS(p) + OFF_H);
    const int total = moe_total_tiles(cnt);
    for (int item = obid(); item < total * 8; item += gridDim.x) {
        const MoeTile mt = moe_find(cnt, item >> 3);
        const int nt = item & 7, col0 = nt * 128;
        const int g_ = mt.cls / 6, pi = mt.cls % 6;
        const int elo = g_ * 4 + c_pair_lo[pi], ehi = g_ * 4 + c_pair_hi[pi];
        const int* lst = list + (size_t)mt.cls * NT + mt.ti * 128;
        const int nvalid = min(128, mt.cnt - mt.ti * 128);
        f32x4 acc[2][4]; g3_zero<2>(acc);
        G3<128> g;
        g3_setup<128>(g, [&](int r) { return hid + ((size_t)mt.tg * 128 + r) * 512; }, [&](int r) { return we + WE_W2 + ((size_t)elo * 1024 + col0 + r) * 256; }, tid);
        g3_kloop<128>(acc, g, 256, lds);
        g3_setup<128>(g, [&](int r) { return hid + ((size_t)mt.tg * 128 + r) * 512 + 256; }, [&](int r) { return we + WE_W2 + ((size_t)ehi * 1024 + col0 + r) * 256; }, tid);
        g3_kloop<128>(acc, g, 256, lds);
#pragma unroll
        for (int m = 0; m < 2; ++m) {
            const int lr = wr * 32 + m * 16 + fr;
            if (lr < nvalid) {
                const int tk = lst[lr];
#pragma unroll
                for (int n = 0; n < 4; ++n) {
                    const int col = col0 + wc * 64 + n * 16 + fq * 4;
                    float4 v = *(const float4*)(hm + (size_t)tk * 1024 + col);
                    v.x += acc[m][n][0]; v.y += acc[m][n][1]; v.z += acc[m][n][2]; v.w += acc[m][n][3];
                    *(float4*)(hm + (size_t)tk * 1024 + col) = v;
                    *(uint2*)(h + (size_t)tk * 1024 + col) = pack4(v.x, v.y, v.z, v.w);
                }
            }
        }
    }
}

__device__ void phase_final(const Params& p) {
    const int lane = otid() & 63;
    const int wave = (obid() * NTHR + otid()) >> 6, nw = gridDim.x * NTHR / 64;
    const float* hm = (const float*)(WS(p) + OFF_HM32);
    const float* nf = p.in[41];
    for (int r = wave; r < NB * SEQ; r += nw) {
        const int b = r / SEQ, s = r % SEQ;
        const size_t n = (size_t)b * TS + NMETA + s;
        float4 v[4]; float ss = 0.f;
#pragma unroll
        for (int i = 0; i < 4; ++i) { v[i] = *(const float4*)(hm + n * DM + i * 256 + lane * 4); ss += v[i].x * v[i].x + v[i].y * v[i].y + v[i].z * v[i].z + v[i].w * v[i].w; }
        ss = wave_sum(ss);
        const float rs = rsqrtf(ss * (1.0f / 1024.0f) + 1e-6f);
#pragma unroll
        for (int i = 0; i < 4; ++i) {
            const float4 g = *(const float4*)(nf + i * 256 + lane * 4);
            float4 o; o.x = v[i].x * rs * g.x; o.y = v[i].y * rs * g.y; o.z = v[i].z * rs * g.z; o.w = v[i].w * rs * g.w;
            *(float4*)((float*)OUTB(p) + (size_t)r * DM + i * 256 + lane * 4) = o;
        }
    }
}


#define XB_TMO      128
#define XB_XCNT(j)  (256  + 64 * (j))
#define XB_XSUB(j)  (1280 + 64 * (j))
#define XB_XGEN(j)  (2304 + 64 * (j))
#define XB_TOP      3328
#define XB_TOPGEN   3392
#define XCD_BAR_WORDS 3456
#define XB_SPIN_CAP (1u << 22)
#define LAS __attribute__((address_space(3)))
__device__ __forceinline__ unsigned xb_ld(unsigned* p) { return __hip_atomic_load(p, __ATOMIC_RELAXED, __HIP_MEMORY_SCOPE_AGENT); }
__device__ __forceinline__ unsigned xb_add(unsigned* p, unsigned v) { return __hip_atomic_fetch_add(p, v, __ATOMIC_RELAXED, __HIP_MEMORY_SCOPE_AGENT); }
__device__ __forceinline__ unsigned xb_xcc_id() { return (unsigned)__builtin_amdgcn_s_getreg((3 << 11) | 20) & 0xFu; }
#define XB_SPIN(cond, bar) do { unsigned _sp = 0; while (cond) { __builtin_amdgcn_s_sleep(1); \
    if ((++_sp & 255u) == 0u) { if (xb_ld(&(bar)[XB_TMO])) break; if (_sp > XB_SPIN_CAP) { atomicAdd(&(bar)[XB_TMO], 1u); break; } } } } while (0)
struct XcdBarrier { unsigned* bar; unsigned x; volatile LAS unsigned* st; };
__device__ __forceinline__ XcdBarrier xcd_barrier_post(unsigned* bar, volatile LAS unsigned* st) {
    XcdBarrier b; b.bar = bar; b.x = xb_xcc_id(); b.st = st;
    if (threadIdx.x == 0) (void)xb_add(&bar[XB_XCNT(b.x)], 1u);
    return b;
}
__device__ __forceinline__ void xcd_barrier_complete(unsigned* bar, unsigned x, unsigned& nloc, unsigned& nx) {
    const unsigned G = gridDim.x * gridDim.y * gridDim.z;
    unsigned sum, cnt, mine, sp = 0u;
    for (;;) {
        sum = 0u; cnt = 0u; mine = 0u;
#pragma unroll
        for (unsigned j = 0; j < 16; ++j) { const unsigned c = xb_ld(&bar[XB_XCNT(j)]); sum += c; cnt += (c > 0u) ? 1u : 0u; mine = (j == x) ? c : mine; }
        if (sum == G) break;
        __builtin_amdgcn_s_sleep(1);
        if ((++sp & 255u) == 0u) { if (xb_ld(&bar[XB_TMO])) break; if (sp > XB_SPIN_CAP) { atomicAdd(&bar[XB_TMO], 1u); break; } }
    }
    nloc = mine > 0u ? mine : 1u; nx = cnt > 0u ? cnt : 1u;
}
__device__ __forceinline__ void xcd_barrier(const XcdBarrier& b) {
    asm volatile("s_waitcnt vmcnt(0)" ::: "memory");
    __syncthreads();
    if (threadIdx.x == 0) {
        unsigned* bar = b.bar;
        __builtin_amdgcn_s_waitcnt(0);
        unsigned nloc = b.st[0], nx = b.st[1];
        if (nloc == 0u) { xcd_barrier_complete(bar, b.x, nloc, nx); b.st[0] = nloc; b.st[1] = nx; }
        const unsigned old = xb_add(&bar[XB_XSUB(b.x)], 1u);
        const unsigned gen = old / nloc;
        if (old + 1u == (gen + 1u) * nloc) {
            __builtin_amdgcn_fence(__ATOMIC_RELEASE, "agent");
            asm volatile("s_waitcnt vmcnt(0)" ::: "memory");
            const unsigned og = xb_add(&bar[XB_TOP], 1u);
            const unsigned tg = og / nx;
            if (og + 1u == (tg + 1u) * nx) xb_add(&bar[XB_TOPGEN], 1u);
            else XB_SPIN(xb_ld(&bar[XB_TOPGEN]) == tg, bar);
            __builtin_amdgcn_fence(__ATOMIC_ACQUIRE, "agent");
            xb_add(&bar[XB_XGEN(b.x)], 1u);
            asm volatile("s_waitcnt vmcnt(0)" ::: "memory");
        } else {
            XB_SPIN(xb_ld(&bar[XB_XGEN(b.x)]) == gen, bar);
            __builtin_amdgcn_fence(__ATOMIC_ACQUIRE, "agent");
            asm volatile("s_waitcnt vmcnt(0)" ::: "memory");
        }
    }
    __syncthreads();
}

__global__ void __launch_bounds__(NTHR) fwd_megakernel(Params p) {
    extern __shared__ __attribute__((aligned(16))) unsigned char lds[];
    cg::grid_group grid = cg::this_grid();
    volatile LAS unsigned* xst = (volatile LAS unsigned*)(lds + LDS_BYTES - 32);
    if (threadIdx.x < 2) xst[threadIdx.x] = 0u;
    __syncthreads();
    const XcdBarrier xb = xcd_barrier_post((unsigned*)(p.ws + OFF_BAR), xst);
    if (p.out == nullptr) grid.sync();
#pragma unroll 1
    for (int step = 0; step < 18; ++step) {
        const int l = step >= 9 ? 1 : 0;
        const int ph = step - l * 9;
        switch (ph) {
        case 0:
            if (l == 0) phase_embed(p); else phase_rowstat(p);
            phase_convert<false>(p, l, lds);
            if (obid() == 0 && otid() < 24) ((int*)(WS(p) + OFF_CTL))[otid() * 32] = 0;
            if (obid() == 0 && otid() == 32) ((int*)(WS(p) + OFF_CTL))[800 + l * 32] = 0;
            break;
        case 1: phase_inproj(p, lds); break;
        case 2: phase_dsa_prep(p, l); phase_lr_prep(p, l); break;
        case 3: {
            if (obid() < NB * 16) phase_scan5(p, l, lds, obid());
            int* qctr = (int*)(WS(p) + OFF_CTL) + 800 + l * 32;
            int* qslot = (int*)(lds + LDS_BYTES - 16);
            for (;;) {
                __syncthreads();
                if (otid() == 0) *qslot = atomicAdd(qctr, 1);
                __syncthreads();
                const int item = *qslot;
                if (item >= 516 + NT / 16 + 3072) break;
                if (item < 516) phase_pool(p, l, lds, item, item + 1, 1);
                else if (item < 516 + NT / 16) phase_dsa<false>(p, l, lds, (bf16_t*)(OUTB(p) + DO_YC), nullptr, nullptr, item - 516, item - 515, 1);
                else {
                    const int ct = item - (516 + NT / 16);
                    const ConvJob cj = get_job_late(p, l, ct >> 10);
                    conv_tile(cj, ct & 1023, (float*)lds);
                }
            }
        } break;
        case 4: phase_merge(p, lds); break;
        case 5: phase_outproj(p, lds); break;
        case 6: phase_route(p, l, lds); break;
        case 7: phase_moe1(p, lds); break;
        default: phase_moe2(p, lds); break;
        }
        xcd_barrier(xb);
    }
    phase_final(p);
}

extern "C" void kernel_launch(void* const* d_in, const int* in_sizes, int n_in,
                              void* d_out, int out_size, void* d_ws, size_t ws_size,
                              hipStream_t stream) {
    static int grid_blocks = 0;
    if (grid_blocks == 0) {
        int dev = 0, cus = 0, per_cu = 0;
        (void)hipGetDevice(&dev);
        (void)hipDeviceGetAttribute(&cus, hipDeviceAttributeMultiprocessorCount, dev);
        (void)hipFuncSetAttribute((const void*)fwd_megakernel, hipFuncAttributeMaxDynamicSharedMemorySize, LDS_BYTES);
        (void)hipOccupancyMaxActiveBlocksPerMultiprocessor(&per_cu, fwd_megakernel, NTHR, LDS_BYTES);
        if (per_cu < 1 || cus < NB * 16 || (cus & 7) != 0 || n_in != 42 || ws_size < WS_END) { fprintf(stderr, "kernel_launch: bad config per_cu=%d n_in=%d ws=%zu need=%zu\n", per_cu, n_in, ws_size, (size_t)WS_END); grid_blocks = -1; }
        else grid_blocks = cus;
    }
    if (grid_blocks < 0) return;
    Params p{};
    for (int i = 0; i < 42; ++i) p.in[i] = (const float*)d_in[i];
    p.out = (float*)d_out;
    p.ws = (unsigned char*)d_ws;
    (void)hipMemsetAsync((unsigned char*)d_ws + OFF_BAR, 0, XCD_BAR_WORDS * 4, stream);
    void* args[] = {&p};
    hipError_t e = hipLaunchCooperativeKernel((void*)fwd_megakernel, dim3(grid_blocks), dim3(NTHR), args, LDS_BYTES, stream);
    if (e != hipSuccess) fprintf(stderr, "cooperative launch failed: %s (grid %d)\n", hipGetErrorString(e), grid_blocks);
}
```

```cpp
#include <hip/hip_runtime.h>
#include <hip/hip_cooperative_groups.h>
#include <cstdio>
#include <cstdint>
#include <type_traits>
namespace cg = cooperative_groups;

typedef unsigned short bf16_t;
typedef short bf16x8 __attribute__((ext_vector_type(8)));
typedef float f32x4 __attribute__((ext_vector_type(4)));

constexpr int NB = 8, SEQ = 2048, NMETA = 16, TS = 2064, DM = 1024;
constexpr int NT = NB * TS;
constexpr int NTP = 16640;
constexpr int NTHR = 512;
constexpr int CIN = 7912;
constexpr int NP1 = 4864;
constexpr int PM_LD = 768;
constexpr int PM_WD = 0, PM_AD = 64, PM_GD = 128, PM_VD = 256, PM_CQ = 288, PM_CKV = 544, PM_KROPE = 672, PM_KIDX = 704;
constexpr int LDS_BYTES = 157 * 1024;

constexpr size_t AL(size_t x) { return (x + 255) & ~(size_t)255; }
constexpr size_t SZ_ACT = (size_t)NTP * 1024 * 2;
constexpr size_t OFF_CTL = 0;
constexpr size_t OFF_BAR = 4096;
constexpr size_t OFF_RSTD = OFF_BAR + 16384;
constexpr size_t OFF_ROPE = OFF_RSTD + AL((size_t)NTP * 4);
constexpr size_t OFF_H = OFF_ROPE + AL((size_t)TS * 16 * 4 * 2);
constexpr size_t OFF_WB = OFF_H + SZ_ACT;
constexpr size_t WB_WIN = 0;
constexpr size_t WB_WG = WB_WIN + (size_t)NP1 * 1024;
constexpr size_t WB_PA = WB_WG + (size_t)3072 * 1024;
constexpr size_t WB_WO = WB_PA + (size_t)3 * 1024 * 1024;
constexpr size_t WB_POOL = WB_WO + (size_t)1024 * 1024;
constexpr size_t WB_QI = WB_POOL + (size_t)4 * 256 * 256;
constexpr size_t WB_UQ = WB_QI + (size_t)512 * 256;
constexpr size_t WB_UK = WB_UQ + (size_t)1536 * 256;
constexpr size_t WB_UV = WB_UK + (size_t)16 * 128 * 64;
constexpr size_t WB_WIDX = WB_UV + (size_t)16 * 64 * 128;
constexpr size_t WB_END = WB_WIDX + (size_t)64 * 1024;
constexpr size_t OFF_PPOOL = OFF_WB + AL(WB_END * 2);
constexpr size_t OFF_PK = OFF_PPOOL + SZ_ACT;
constexpr size_t OFF_PR = OFF_PK + SZ_ACT;
constexpr size_t OFF_PV = OFF_PR + SZ_ACT;
constexpr size_t OFF_PMISC = OFF_PV + SZ_ACT;
constexpr size_t OFF_VFIRST = OFF_PMISC + AL((size_t)NTP * PM_LD * 2);
constexpr size_t OFF_HALO = OFF_VFIRST + SZ_ACT;
constexpr size_t OFF_LIST = OFF_HALO + AL((size_t)130 * 16 * 1024 * 2);
constexpr size_t OFF_PW = OFF_LIST + AL((size_t)24 * NT * 4);
constexpr size_t WS_END = OFF_PW + AL((size_t)NT * 2 * 4);
constexpr size_t OFF_MERGED = OFF_PK;
constexpr size_t OFF_HM32 = OFF_PR;
constexpr size_t OFF_HN = OFF_PPOOL;
constexpr size_t OFF_WEXP = OFF_PMISC;
constexpr size_t WE_W1 = 0, WE_W3 = (size_t)16 * 256 * 1024, WE_W2 = (size_t)2 * 16 * 256 * 1024;
static_assert((size_t)3 * 16 * 256 * 1024 * 2 <= (size_t)NTP * PM_LD * 2, "expert weights must fit in Pmisc");
constexpr size_t DO_YC = 0;
constexpr size_t DO_CQN = DO_YC + SZ_ACT;
constexpr size_t DO_KV = DO_CQN + AL((size_t)NT * 256 * 2);
constexpr size_t DO_KIDX = DO_KV + AL((size_t)NT * 160 * 2);
constexpr size_t DO_WHEAD = DO_KIDX + AL((size_t)NT * 64 * 2);
constexpr size_t DO_ALR = DO_WHEAD + AL((size_t)NT * 8 * 4);
constexpr size_t DO_END = DO_ALR + AL((size_t)NT * 288 * 2);
constexpr size_t DO_HID = DO_YC;
static_assert(DO_END <= (size_t)NB * SEQ * DM * 4, "d_out scratch overflow");
static_assert((size_t)(129 + 24) * 128 * 512 * 2 <= SZ_ACT, "hid fits");
static_assert(WS_END <= 277240096ull, "workspace overflow");

struct Params {
    const float* in[42];
    float* out;
    unsigned char* ws;
};

__device__ __forceinline__ int otid() { int t = threadIdx.x; asm volatile("" : "+v"(t)); return t; }
__device__ __forceinline__ int obid() { int b = blockIdx.x; asm volatile("" : "+s"(b)); return b; }
__device__ __forceinline__ unsigned char* WS(const Params& p) { unsigned char* w = p.ws; asm volatile("" : "+s"(w)); return w; }
__device__ __forceinline__ unsigned char* OUTB(const Params& p) { unsigned char* w = (unsigned char*)p.out; asm volatile("" : "+s"(w)); return w; }
__device__ __forceinline__ float bf2f(bf16_t v) { return __uint_as_float(((unsigned)v) << 16); }
typedef float f32x2v __attribute__((ext_vector_type(2)));
typedef __bf16 bf16x2v __attribute__((ext_vector_type(2)));
__device__ __forceinline__ unsigned pk2(float a, float b) { const f32x2v v = {a, b}; const bf16x2v r = __builtin_convertvector(v, bf16x2v); unsigned u; __builtin_memcpy(&u, &r, 4); return u; }
__device__ __forceinline__ bf16_t f2bf(float f) { const __bf16 h = (__bf16)f; bf16_t u; __builtin_memcpy(&u, &h, 2); return u; }
__device__ __forceinline__ float wave_sum(float v) {
#pragma unroll
    for (int o = 32; o > 0; o >>= 1) v += __shfl_xor(v, o);
    return v;
}
template <int CTRL> __device__ __forceinline__ float dpp_f(float x) {
    return __int_as_float(__builtin_amdgcn_update_dpp(0, __float_as_int(x), CTRL, 0xF, 0xF, true));
}
__device__ __forceinline__ float row16_sum(float v) {
    v += dpp_f<0xB1>(v);
    v += dpp_f<0x4E>(v);
    v += dpp_f<0x141>(v);
    v += dpp_f<0x140>(v);
    return v;
}
__device__ __forceinline__ void lds_barrier() { asm volatile("s_waitcnt lgkmcnt(0)" ::: "memory"); __builtin_amdgcn_s_barrier(); asm volatile("" ::: "memory"); }
__device__ __forceinline__ float fast_rcp(float x) { return __builtin_amdgcn_rcpf(x); }
__device__ __forceinline__ float fast_sigmoid(float x) { return fast_rcp(1.0f + __expf(-x)); }
__device__ __forceinline__ float fast_tanh(float x) { return 1.0f - 2.0f * fast_rcp(1.0f + __expf(2.0f * x)); }
__device__ __forceinline__ void row16_sum4(float& a, float& b, float& c, float& d) {
    asm volatile(
        "s_nop 1\n\t"
        "v_add_f32_dpp %0, %0, %0 quad_perm:[1,0,3,2] row_mask:0xf bank_mask:0xf\n\t"
        "v_add_f32_dpp %1, %1, %1 quad_perm:[1,0,3,2] row_mask:0xf bank_mask:0xf\n\t"
        "v_add_f32_dpp %2, %2, %2 quad_perm:[1,0,3,2] row_mask:0xf bank_mask:0xf\n\t"
        "v_add_f32_dpp %3, %3, %3 quad_perm:[1,0,3,2] row_mask:0xf bank_mask:0xf\n\t"
        "v_add_f32_dpp %0, %0, %0 quad_perm:[2,3,0,1] row_mask:0xf bank_mask:0xf\n\t"
        "v_add_f32_dpp %1, %1, %1 quad_perm:[2,3,0,1] row_mask:0xf bank_mask:0xf\n\t"
        "v_add_f32_dpp %2, %2, %2 quad_perm:[2,3,0,1] row_mask:0xf bank_mask:0xf\n\t"
        "v_add_f32_dpp %3, %3, %3 quad_perm:[2,3,0,1] row_mask:0xf bank_mask:0xf\n\t"
        "v_add_f32_dpp %0, %0, %0 row_half_mirror row_mask:0xf bank_mask:0xf\n\t"
        "v_add_f32_dpp %1, %1, %1 row_half_mirror row_mask:0xf bank_mask:0xf\n\t"
        "v_add_f32_dpp %2, %2, %2 row_half_mirror row_mask:0xf bank_mask:0xf\n\t"
        "v_add_f32_dpp %3, %3, %3 row_half_mirror row_mask:0xf bank_mask:0xf\n\t"
        "v_add_f32_dpp %0, %0, %0 row_mirror row_mask:0xf bank_mask:0xf\n\t"
        "v_add_f32_dpp %1, %1, %1 row_mirror row_mask:0xf bank_mask:0xf\n\t"
        "v_add_f32_dpp %2, %2, %2 row_mirror row_mask:0xf bank_mask:0xf\n\t"
        "v_add_f32_dpp %3, %3, %3 row_mirror row_mask:0xf bank_mask:0xf\n\t"
        "s_nop 1"
        : "+v"(a), "+v"(b), "+v"(c), "+v"(d));
}
__device__ __forceinline__ void row8_sum2(float& a, float& b) {
    asm volatile(
        "s_nop 1\n\t"
        "v_add_f32_dpp %0, %0, %0 quad_perm:[1,0,3,2] row_mask:0xf bank_mask:0xf\n\t"
        "v_add_f32_dpp %1, %1, %1 quad_perm:[1,0,3,2] row_mask:0xf bank_mask:0xf\n\t"
        "s_nop 0\n\t"
        "v_add_f32_dpp %0, %0, %0 quad_perm:[2,3,0,1] row_mask:0xf bank_mask:0xf\n\t"
        "v_add_f32_dpp %1, %1, %1 quad_perm:[2,3,0,1] row_mask:0xf bank_mask:0xf\n\t"
        "s_nop 0\n\t"
        "v_add_f32_dpp %0, %0, %0 row_half_mirror row_mask:0xf bank_mask:0xf\n\t"
        "v_add_f32_dpp %1, %1, %1 row_half_mirror row_mask:0xf bank_mask:0xf\n\t"
        "s_nop 1"
        : "+v"(a), "+v"(b));
}
__device__ __forceinline__ float wave_sum_fast(float v) { v = row16_sum(v); v += __shfl_xor(v, 16); v += __shfl_xor(v, 32); return v; }
__device__ __forceinline__ float sigmoidf_(float x) { return 1.0f / (1.0f + __expf(-x)); }
__device__ __forceinline__ float softplusf_(float z) { return fmaxf(z, 0.f) + log1pf(__expf(-fabsf(z))); }
__device__ __forceinline__ void glds16(const void* g, void* l) {
    __builtin_amdgcn_global_load_lds((const unsigned*)g, (unsigned*)l, 16, 0, 0);
}

__device__ void phase_embed(const Params& p) {
    const int lane = otid() & 63;
    const int wave = (obid() * NTHR + otid()) >> 6, nw = gridDim.x * NTHR / 64;
    bf16_t* h = (bf16_t*)(WS(p) + OFF_H);
    float* rstd = (float*)(WS(p) + OFF_RSTD);
    for (int n = wave; n < NTP; n += nw) {
        if (n < NT) {
            const int b = n / TS, t = n % TS;
            const float* src = t < NMETA ? p.in[1] + (size_t)t * DM : p.in[0] + ((size_t)b * SEQ + (t - NMETA)) * DM;
            float ss = 0.f;
#pragma unroll
            for (int i = 0; i < 4; ++i) {
                const float4 v = *(const float4*)(src + i * 256 + lane * 4);
                ss += v.x * v.x + v.y * v.y + v.z * v.z + v.w * v.w;
                const uint2 o = make_uint2(pk2(v.x, v.y), pk2(v.z, v.w));
                *(uint2*)(h + (size_t)n * DM + i * 256 + lane * 4) = o;
            }
            ss = wave_sum(ss);
            if (lane == 0) rstd[n] = rsqrtf(ss * (1.0f / 1024.0f) + 1e-6f);
        } else {
#pragma unroll
            for (int i = 0; i < 4; ++i) *(ushort4*)(h + (size_t)n * DM + i * 256 + lane * 4) = make_ushort4(0, 0, 0, 0);
            if (lane == 0) rstd[n] = 0.f;
        }
    }
    float* ctab = (float*)(WS(p) + OFF_ROPE);
    float* stab = ctab + TS * 16;
    for (int idx = obid() * NTHR + otid(); idx < TS * 16; idx += gridDim.x * NTHR) {
        const int t = idx >> 4, i = idx & 15;
        const float inv = powf(10000.0f, -(float)(2 * i) / 32.0f);
        const float ang = (float)t * inv;
        ctab[idx] = cosf(ang);
        stab[idx] = sinf(ang);
    }
}

__device__ void phase_rowstat(const Params& p) {
    const int lane = otid() & 63;
    const int wave = (obid() * NTHR + otid()) >> 6, nw = gridDim.x * NTHR / 64;
    const float* hm = (const float*)(WS(p) + OFF_HM32);
    float* rstd = (float*)(WS(p) + OFF_RSTD);
    for (int n = wave; n < NT; n += nw) {
        float ss = 0.f;
#pragma unroll
        for (int i = 0; i < 4; ++i) {
            const float4 v = *(const float4*)(hm + (size_t)n * DM + i * 256 + lane * 4);
            ss += v.x * v.x + v.y * v.y + v.z * v.z + v.w * v.w;
        }
        ss = wave_sum(ss);
        if (lane == 0) rstd[n] = rsqrtf(ss * (1.0f / 1024.0f) + 1e-6f);
    }
}

struct ConvJob { const float* src; bf16_t* dst; const float* scale; int ldsrc, K, nvalid, nrows, nb, notr; size_t sbs, dbs; const float* srcB; int ldB, split; };
__device__ __forceinline__ int conv_job_tiles(const ConvJob& j) { return j.nb * (j.nrows >> 6) * (j.K >> 6); }
__device__ void conv_tile(const ConvJob& j, int tile, float* lds) {
    const int per = (j.nrows >> 6) * (j.K >> 6);
    const int bi = tile / per, rem = tile % per;
    const int ktiles = j.K >> 6;
    const int n0 = (rem / ktiles) << 6, k0 = (rem % ktiles) << 6;
    const int tid = otid(), tn = tid & 63, tk = tid >> 6;
    const float* src = j.src + (size_t)bi * j.sbs;
    bf16_t* dst = j.dst + (size_t)bi * j.dbs;
#pragma unroll
    for (int kk = 0; kk < 8; ++kk) {
        const int k = k0 + tk * 8 + kk;
        float v = 0.f;
        if (n0 + tn < j.nvalid) {
            if (j.split) { const int nn = n0 + tn; v = (nn < j.split) ? (j.src ? j.src[(size_t)k * j.ldsrc + nn] : 0.f) : j.srcB[(size_t)k * j.ldB + (nn - j.split)]; }
            else v = j.notr ? src[(size_t)(n0 + tn) * j.ldsrc + k] : src[(size_t)k * j.ldsrc + n0 + tn];
            if (j.scale) v *= j.scale[k];
        }
        lds[tn * 65 + tk * 8 + kk] = v;
    }
    __syncthreads();
    const int wn = tid >> 3, kq = tid & 7;
    uint4 o;
    unsigned w[4];
#pragma unroll
    for (int q = 0; q < 4; ++q) {
        const float lo = lds[wn * 65 + kq * 8 + 2 * q], hi = lds[wn * 65 + kq * 8 + 2 * q + 1];
        w[q] = pk2(lo, hi);
    }
    o.x = w[0]; o.y = w[1]; o.z = w[2]; o.w = w[3];
    *(uint4*)(dst + (size_t)(n0 + wn) * j.K + k0 + kq * 8) = o;
    __syncthreads();
}
__device__ ConvJob get_job_early(const Params& p, int l, int ji) {
    bf16_t* wb = (bf16_t*)(WS(p) + OFF_WB);
    const float* win = p.in[3] + (size_t)l * DM * CIN;
    const float* nm = p.in[2] + (size_t)l * DM;
    ConvJob j{}; j.nb = 1; j.sbs = 0; j.dbs = 0; j.K = 1024; j.ldsrc = CIN; j.scale = nm;
    switch (ji) {
    case 0: j.src = win + 3072; j.dst = wb + WB_WIN; j.nvalid = 4352; j.nrows = 4352; break;
    case 1: j.src = (l == 0 ? nullptr : p.in[17]); j.ldsrc = 32; j.split = 32; j.srcB = win + 7424; j.ldB = CIN; j.dst = wb + WB_WIN + (size_t)(4096 + PM_VD) * 1024; j.nvalid = 512; j.nrows = 512; break;
    case 2: j.src = win + 7904; j.dst = wb + WB_WIDX; j.nvalid = 8; j.nrows = 64; break;
    case 3: j.src = win; j.dst = wb + WB_WG; j.nvalid = 3072; j.nrows = 3072; break;
    case 4: j.src = p.in[29] + (size_t)l * DM * DM; j.ldsrc = 1024; j.scale = nullptr; j.dst = wb + WB_PA; j.nvalid = 1024; j.nrows = 1024; break;
    case 5: j.src = p.in[30] + (size_t)l * DM * DM; j.ldsrc = 1024; j.scale = nullptr; j.dst = wb + WB_PA + (size_t)1024 * 1024; j.nvalid = 1024; j.nrows = 1024; break;
    case 6: j.src = p.in[31] + (size_t)l * DM * DM; j.ldsrc = 1024; j.scale = nullptr; j.dst = wb + WB_PA + (size_t)2 * 1024 * 1024; j.nvalid = 1024; j.nrows = 1024; break;
    case 7: j.src = p.in[32] + (size_t)l * DM * DM; j.ldsrc = 1024; j.scale = nullptr; j.dst = wb + WB_WO; j.nvalid = 1024; j.nrows = 1024; break;
    case 8: j.src = p.in[5] + (size_t)l * 4 * 256 * 256; j.ldsrc = 256; j.K = 256; j.scale = nullptr; j.dst = wb + WB_POOL; j.nvalid = 256; j.nrows = 256; j.nb = 4; j.sbs = 65536; j.dbs = 65536; break;
    case 9: j.src = p.in[26] + (size_t)l * 256 * 512; j.ldsrc = 512; j.K = 256; j.scale = nullptr; j.dst = wb + WB_QI; j.nvalid = 512; j.nrows = 512; break;
    case 10: j.src = p.in[23] + (size_t)l * 256 * 1536; j.ldsrc = 1536; j.K = 256; j.scale = nullptr; j.dst = wb + WB_UQ; j.nvalid = 1536; j.nrows = 1536; break;
    case 11: j.src = p.in[24] + (size_t)l * 16 * 128 * 64; j.ldsrc = 64; j.K = 64; j.scale = nullptr; j.dst = wb + WB_UK; j.nvalid = 2048; j.nrows = 2048; j.notr = 1; break;
    default: j.src = p.in[25] + (size_t)l * 16 * 128 * 64; j.ldsrc = 64; j.K = 128; j.scale = nullptr; j.dst = wb + WB_UV; j.nvalid = 64; j.nrows = 64; j.nb = 16; j.sbs = 8192; j.dbs = 8192; break;
    }
    return j;
}
__device__ ConvJob get_job_late(const Params& p, int l, int ji) {
    bf16_t* we = (bf16_t*)(WS(p) + OFF_WEXP);
    ConvJob j{}; j.nb = 16; j.scale = nullptr; j.sbs = 262144; j.dbs = 262144;
    switch (ji) {
    case 0: j.src = p.in[38] + (size_t)l * 16 * 262144; j.dst = we + WE_W1; j.ldsrc = 256; j.K = 1024; j.nvalid = 256; j.nrows = 256; break;
    case 1: j.src = p.in[39] + (size_t)l * 16 * 262144; j.dst = we + WE_W3; j.ldsrc = 256; j.K = 1024; j.nvalid = 256; j.nrows = 256; break;
    default: j.src = p.in[40] + (size_t)l * 16 * 262144; j.dst = we + WE_W2; j.ldsrc = 1024; j.K = 256; j.nvalid = 1024; j.nrows = 1024; break;
    }
    return j;
}
template <bool LATE>
__device__ void phase_convert(const Params& p, int l, unsigned char* lds) {
    const int njobs = LATE ? 3 : 13;
    int base = 0;
    for (int ji = 0; ji < njobs; ++ji) {
        const ConvJob j = LATE ? get_job_late(p, l, ji) : get_job_early(p, l, ji);
        const int nt = conv_job_tiles(j);
        int first = ((int)obid() - base) % (int)gridDim.x; if (first < 0) first += gridDim.x;
        for (int t = first; t < nt; t += gridDim.x) conv_tile(j, t, (float*)lds);
        base += nt;
    }
}

template <int BM> struct G3 {
    static constexpr int MI = BM / 64;
    static constexpr int NA = BM / 64;
    static constexpr int STAGE = BM * 128 + 128 * 128;
    const bf16_t* ap[NA];
    const bf16_t* bp[2];
};
template <int BM>
__device__ __forceinline__ void g3_issue(const G3<BM>& g, int kt, unsigned char* stage, int tid) {
#pragma unroll
    for (int i = 0; i < G3<BM>::NA; ++i) glds16(g.ap[i] + kt * 64, stage + (tid + i * NTHR) * 16);
#pragma unroll
    for (int i = 0; i < 2; ++i) glds16(g.bp[i] + kt * 64, stage + BM * 128 + (tid + i * NTHR) * 16);
}
template <int BM, class FA, class FB>
__device__ __forceinline__ void g3_setup(G3<BM>& g, FA rowptr, FB bcol, int tid) {
#pragma unroll
    for (int i = 0; i < G3<BM>::NA; ++i) { const int idx = tid + i * NTHR, row = idx >> 3, sl = (idx & 7) ^ (row & 7); g.ap[i] = rowptr(row) + sl * 8; }
#pragma unroll
    for (int i = 0; i < 2; ++i) { const int idx = tid + i * NTHR, row = idx >> 3, sl = (idx & 7) ^ (row & 7); g.bp[i] = bcol(row) + sl * 8; }
}
template <int BM>
__device__ __forceinline__ void g3_kloop(f32x4 (&acc)[BM / 64][4], const G3<BM>& g, int K, unsigned char* lds) {
    constexpr int MI = G3<BM>::MI, STAGE = G3<BM>::STAGE, NL = G3<BM>::NA + 2;
    const int tid = otid(), lane = tid & 63, wid = tid >> 6, wr = wid >> 1, wc = wid & 1, fr = lane & 15, fq = lane >> 4;
    const int nk = K >> 6;
    g3_issue<BM>(g, 0, lds, tid);
    if (nk > 1) g3_issue<BM>(g, 1, lds + STAGE, tid);
    int cur = 0;
#pragma unroll 1
    for (int t = 0; t < nk; ++t) {
        if (t + 1 < nk) { if (NL == 6) asm volatile("s_waitcnt vmcnt(6)" ::: "memory"); else if (NL == 5) asm volatile("s_waitcnt vmcnt(5)" ::: "memory"); else asm volatile("s_waitcnt vmcnt(4)" ::: "memory"); }
        else asm volatile("s_waitcnt vmcnt(0)" ::: "memory");
        __builtin_amdgcn_s_barrier();
        if (t + 2 < nk) { int nx = cur + 2; if (nx >= 3) nx -= 3; g3_issue<BM>(g, t + 2, lds + nx * STAGE, tid); }
        const unsigned char* cA = lds + cur * STAGE;
        const unsigned char* cB = cA + BM * 128;
#pragma unroll
        for (int ks = 0; ks < 2; ++ks) {
            bf16x8 a[MI], b[4];
#pragma unroll
            for (int m = 0; m < MI; ++m) { const int row = wr * (BM / 4) + m * 16 + fr; a[m] = *(const bf16x8*)(cA + row * 128 + (((ks * 4 + fq) ^ (row & 7)) << 4)); }
#pragma unroll
            for (int n = 0; n < 4; ++n) { const int row = wc * 64 + n * 16 + fr; b[n] = *(const bf16x8*)(cB + row * 128 + (((ks * 4 + fq) ^ (row & 7)) << 4)); }
#pragma unroll
            for (int m = 0; m < MI; ++m)
#pragma unroll
                for (int n = 0; n < 4; ++n) acc[m][n] = __builtin_amdgcn_mfma_f32_16x16x32_bf16(b[n], a[m], acc[m][n], 0, 0, 0);
        }
        cur = (cur == 2) ? 0 : cur + 1;
    }
    __builtin_amdgcn_s_barrier();
}
struct G3D { const bf16_t* ap[2]; const bf16_t* b1[2]; const bf16_t* b3[2]; };
__device__ __forceinline__ void g3d_issue(const G3D& g, int kt, unsigned char* stage, int tid) {
#pragma unroll
    for (int i = 0; i < 2; ++i) glds16(g.ap[i] + kt * 64, stage + (tid + i * NTHR) * 16);
#pragma unroll
    for (int i = 0; i < 2; ++i) glds16(g.b1[i] + kt * 64, stage + 16384 + (tid + i * NTHR) * 16);
#pragma unroll
    for (int i = 0; i < 2; ++i) glds16(g.b3[i] + kt * 64, stage + 32768 + (tid + i * NTHR) * 16);
}
__device__ __forceinline__ void g3d_kloop(f32x4 (&acc1)[2][4], f32x4 (&acc3)[2][4], const G3D& g, int K, unsigned char* lds) {
    constexpr int STAGE = 49152;
    const int tid = otid(), lane = tid & 63, wid = tid >> 6, wr = wid >> 1, wc = wid & 1, fr = lane & 15, fq = lane >> 4;
    const int nk = K >> 6;
    g3d_issue(g, 0, lds, tid);
    if (nk > 1) g3d_issue(g, 1, lds + STAGE, tid);
    int cur = 0;
#pragma unroll 1
    for (int t = 0; t < nk; ++t) {
        if (t + 1 < nk) asm volatile("s_waitcnt vmcnt(6)" ::: "memory"); else asm volatile("s_waitcnt vmcnt(0)" ::: "memory");
        __builtin_amdgcn_s_barrier();
        if (t + 2 < nk) { int nx = cur + 2; if (nx >= 3) nx -= 3; g3d_issue(g, t + 2, lds + nx * STAGE, tid); }
        const unsigned char* cA = lds + cur * STAGE;
#pragma unroll
        for (int ks = 0; ks < 2; ++ks) {
            bf16x8 a[2], b1[4], b3[4];
#pragma unroll
            for (int m = 0; m < 2; ++m) { const int row = wr * 32 + m * 16 + fr; a[m] = *(const bf16x8*)(cA + row * 128 + (((ks * 4 + fq) ^ (row & 7)) << 4)); }
#pragma unroll
            for (int n = 0; n < 4; ++n) { const int row = wc * 64 + n * 16 + fr; const int off = row * 128 + (((ks * 4 + fq) ^ (row & 7)) << 4);
                b1[n] = *(const bf16x8*)(cA + 16384 + off); b3[n] = *(const bf16x8*)(cA + 32768 + off); }
#pragma unroll
            for (int m = 0; m < 2; ++m)
#pragma unroll
                for (int n = 0; n < 4; ++n) {
                    acc1[m][n] = __builtin_amdgcn_mfma_f32_16x16x32_bf16(b1[n], a[m], acc1[m][n], 0, 0, 0);
                    acc3[m][n] = __builtin_amdgcn_mfma_f32_16x16x32_bf16(b3[n], a[m], acc3[m][n], 0, 0, 0);
                }
        }
        cur = (cur == 2) ? 0 : cur + 1;
    }
    __builtin_amdgcn_s_barrier();
}
template <int MI>
__device__ __forceinline__ void g3_zero(f32x4 (&acc)[MI][4]) {
#pragma unroll
    for (int m = 0; m < MI; ++m)
#pragma unroll
        for (int n = 0; n < 4; ++n) acc[m][n] = (f32x4){0.f, 0.f, 0.f, 0.f};
}
__device__ __forceinline__ uint2 pack4(float a, float b, float c, float d) {
    uint2 r; r.x = pk2(a, b); r.y = pk2(c, d); return r;
}

namespace pg8 {
#define PG8_LAS __attribute__((address_space(3)))
typedef unsigned short bf16_t;
typedef short bf16x8 __attribute__((ext_vector_type(8)));
typedef float f32x4 __attribute__((ext_vector_type(4)));
typedef unsigned u32x4 __attribute__((ext_vector_type(4)));
constexpr int BM = 256, BK = 64, HALF = 128, HTB = HALF * BK * 2  , STAGE_BYTES = 8 * HTB, NXCD = 8, WGM = 8;

__host__ __device__ __forceinline__ int lds_byte(int r, int c) { const int st = (r >> 4) * 2 + (c >> 5), rr = r & 15, cc = c & 31, ob = rr * 64 + cc * 2; return st * 1024 + (ob ^ (((ob >> 9) & 1) << 5)); }
__host__ __device__ __forceinline__ void stage_rc(int b, int& R, int& C) { const int st = b / 1024, sb = b % 1024, swz = sb ^ (((sb >> 9) & 1) << 5); R = (st >> 1) * 16 + swz / 64; C = (st & 1) * 32 + (swz % 64) / 2; }
__host__ __device__ __forceinline__ int perm32(int rho) { const int n = rho >> 4, i = rho & 15; return 8 * (i >> 2) + 4 * n + (i & 3); }

struct Unit { int pm, pn; };
struct Gemm { const bf16_t* A; const bf16_t* Bt; int M, N, K; };

struct StaticOrder {
    int nM, nN, nwg, G, c;
    __host__ __device__ void init(int M, int N, int G_, int c_) { nM = M / BM; nN = N / BM; nwg = nM * nN; G = G_; c = c_; }
    __host__ __device__ bool next(int i, Unit& u) const {
        const long L = (long)i * G + c; if (L >= nwg) return false;
        int wgid = (int)L; { const int q = nwg / NXCD, r = nwg % NXCD, xcd = wgid % NXCD, off = wgid / NXCD; wgid = (xcd < r ? xcd * (q + 1) : r * (q + 1) + (xcd - r) * q) + off; }
        const int nig = WGM * nN, gid = wgid / nig, fm = gid * WGM, gsz = (nM - fm) < WGM ? (nM - fm) : WGM;
        u.pm = fm + ((wgid % nig) % gsz); u.pn = (wgid % nig) / gsz; return true;
    }
    __device__ __forceinline__ void a_ready(const Unit&) const {}
    __device__ __forceinline__ void done(const Unit&) const {}
};
template <class Epi, class Sched, bool STAMP = false>
__device__ __forceinline__ void gemm_phase(PG8_LAS unsigned char* lds, const Gemm g, const Sched& S, const Epi& E, unsigned long long* stamps) {
    const int tid = otid(), wid = __builtin_amdgcn_readfirstlane(tid >> 6), lane = tid & 63, wr = wid >> 2, wc = wid & 3, fr = lane & 15, fq = lane >> 4;
    const int K = g.K, nt = K / BK;
    int ts_lo = 0, ts_hi = 0, nts = 0; const unsigned long long rt_entry = STAMP ? 0ull : 0ull;
#define PG8_STAMP() do { if (STAMP && wid == 0 && nts < 64) { const unsigned long long _c = 0ull; \
        ts_lo = (lane == nts) ? (int)(unsigned)_c : ts_lo; ts_hi = (lane == nts) ? (int)(unsigned)(_c >> 32) : ts_hi; ++nts; } } while (0)
    PG8_STAMP();
    unsigned voffA[2], voffB[2];
#pragma unroll
    for (int i = 0; i < 2; ++i) { int R, C; stage_rc(tid * 16 + i * 8192, R, C); const int Rb = Epi::PERM ? ((R & ~31) + perm32(R & 31)) : R;
        voffA[i] = (unsigned)(R * K + C) * 2u; voffB[i] = (unsigned)(Rb * K + C) * 2u; }
    const size_t kstep = (size_t)(BK * 2);
    const size_t hstep = (size_t)HALF * K * 2;
    const size_t tstep = 2 * hstep;
    const unsigned ldsw = (unsigned)wid * 1024u;
    const int aoff = lds_byte(wr * 64 + fr, fq * 8), boff = lds_byte(wc * 32 + fr, fq * 8);
#define PG8_SA(b, h) (((b) * 2 + (h)) * HTB)
#define PG8_SB(b, h) ((4 + (b) * 2 + (h)) * HTB)
#define PG8_STAGE(bufoff, gbase, voff) do { _Pragma("unroll") for (int _i = 0; _i < 2; ++_i) \
        __builtin_amdgcn_global_load_lds((const unsigned*)((const char*)(gbase) + (voff)[_i]), (PG8_LAS unsigned*)(lds + (bufoff) + ldsw + _i * 8192), 16, 0, 0); } while (0)
#define PG8_LDA(dst, b, h) do { _Pragma("unroll") for (int m = 0; m < 4; ++m) _Pragma("unroll") for (int k = 0; k < 2; ++k) dst[m][k] = *(const PG8_LAS bf16x8*)(lds + PG8_SA(b, h) + aoff + m * 2048 + k * 1024); } while (0)
#define PG8_LDB(dst, b, h) do { _Pragma("unroll") for (int n = 0; n < 2; ++n) _Pragma("unroll") for (int k = 0; k < 2; ++k) dst[n][k] = *(const PG8_LAS bf16x8*)(lds + PG8_SB(b, h) + boff + n * 2048 + k * 1024); } while (0)
#define PG8_MMA(ai, bj, At, Bt) do { __builtin_amdgcn_s_setprio(1); _Pragma("unroll") for (int m = 0; m < 4; ++m) _Pragma("unroll") for (int n = 0; n < 2; ++n) _Pragma("unroll") for (int k = 0; k < 2; ++k) \
        acc[ai][bj][m][n] = __builtin_amdgcn_mfma_f32_16x16x32_bf16(Bt[n][k], At[m][k], acc[ai][bj][m][n], 0, 0, 0); __builtin_amdgcn_s_setprio(0); } while (0)
#define PG8_WAIT_V(n) asm volatile("s_waitcnt vmcnt(" #n ")" ::: "memory")
#define PG8_WAIT_L(n) asm volatile("s_waitcnt lgkmcnt(" #n ")" ::: "memory")
#define PG8_BAR __builtin_amdgcn_s_barrier()
#define PG8_SCHED __builtin_amdgcn_sched_barrier(0)
    Unit cur, nxt; int ui = 0;
    if (!S.next(0, cur)) return;
    f32x4 acc[2][2][4][2];
#pragma unroll
    for (int a = 0; a < 2; ++a)
#pragma unroll
        for (int b = 0; b < 2; ++b)
#pragma unroll
            for (int m = 0; m < 4; ++m)
#pragma unroll
                for (int n = 0; n < 2; ++n) acc[a][b][m][n] = (f32x4){0.f, 0.f, 0.f, 0.f};
    bf16x8 At[4][2], B0[2][2], B1[2][2];
    const char* cA = (const char*)g.A + (size_t)cur.pm * tstep; const char* cB = (const char*)g.Bt + (size_t)cur.pn * tstep;
    S.a_ready(cur);
    PG8_STAGE(PG8_SB(0, 0), cB, voffB); PG8_STAGE(PG8_SA(0, 0), cA, voffA); PG8_STAGE(PG8_SB(0, 1), cB + hstep, voffB); PG8_STAGE(PG8_SA(0, 1), cA + hstep, voffA);
    if (wr == 1) PG8_BAR;
    PG8_WAIT_V(4); PG8_BAR;
    PG8_STAGE(PG8_SB(1, 0), cB + kstep, voffB); PG8_STAGE(PG8_SA(1, 0), cA + kstep, voffA); PG8_STAGE(PG8_SB(1, 1), cB + hstep + kstep, voffB);
    PG8_WAIT_V(6); PG8_BAR;
    PG8_STAMP();
    for (;;) {
        const bool has_next = S.next(ui + 1, nxt);
        const char* nA = has_next ? (const char*)g.A + (size_t)nxt.pm * tstep : cA; const char* nB = has_next ? (const char*)g.Bt + (size_t)nxt.pn * tstep : cB;
        for (int t = 0; t < nt; t += 2) {
            const bool last = (t == nt - 2);
            const char* a1 = cA + (size_t)(t + 1) * kstep;
            const char* a2 = last ? nA : cA + (size_t)(t + 2) * kstep; const char* b2 = last ? nB : cB + (size_t)(t + 2) * kstep;
            const char* a3 = a2 + kstep; const char* b3 = b2 + kstep;
            if (last && has_next) S.a_ready(nxt);
            PG8_LDB(B0, 0, 0); PG8_SCHED; PG8_LDA(At, 0, 0); PG8_STAGE(PG8_SA(1, 1), a1 + hstep, voffA);
            PG8_WAIT_L(8); PG8_BAR; PG8_WAIT_L(0); PG8_MMA(0, 0, At, B0); PG8_BAR; PG8_SCHED;
            PG8_LDB(B1, 0, 1); PG8_STAGE(PG8_SB(0, 0), b2, voffB);
            PG8_BAR; PG8_WAIT_L(0); PG8_MMA(0, 1, At, B1); PG8_BAR;
            PG8_LDA(At, 0, 1); PG8_STAGE(PG8_SA(0, 0), a2, voffA);
            PG8_BAR; PG8_WAIT_L(0); PG8_MMA(1, 0, At, B0); PG8_BAR; PG8_SCHED;
            PG8_STAGE(PG8_SB(0, 1), b2 + hstep, voffB);
            PG8_WAIT_V(6); PG8_BAR; PG8_MMA(1, 1, At, B1); PG8_BAR;
            PG8_LDB(B0, 1, 0); PG8_SCHED; PG8_LDA(At, 1, 0); PG8_STAGE(PG8_SA(0, 1), a2 + hstep, voffA);
            PG8_WAIT_L(8); PG8_BAR; PG8_WAIT_L(0); PG8_MMA(0, 0, At, B0); PG8_BAR; PG8_SCHED;
            PG8_LDB(B1, 1, 1); PG8_STAGE(PG8_SB(1, 0), b3, voffB);
            PG8_BAR; PG8_WAIT_L(0); PG8_MMA(0, 1, At, B1); PG8_BAR;
            PG8_LDA(At, 1, 1); PG8_STAGE(PG8_SA(1, 0), a3, voffA);
            PG8_BAR; PG8_WAIT_L(0); PG8_MMA(1, 0, At, B0); PG8_BAR; PG8_SCHED;
            PG8_STAGE(PG8_SB(1, 1), b3 + hstep, voffB);
            PG8_WAIT_V(6); PG8_BAR; PG8_MMA(1, 1, At, B1); PG8_BAR;
        }
        PG8_STAMP();
        if constexpr (!Epi::AFTER_DRAIN) { E(acc, cur, wr, wc, fr, fq); S.done(cur); }
        PG8_STAMP();
        if (!has_next) break;
#pragma unroll
        for (int a = 0; a < 2; ++a)
#pragma unroll
            for (int b = 0; b < 2; ++b)
#pragma unroll
                for (int m = 0; m < 4; ++m)
#pragma unroll
                    for (int n = 0; n < 2; ++n) acc[a][b][m][n] = (f32x4){0.f, 0.f, 0.f, 0.f};
        cur = nxt; cA = nA; cB = nB; ++ui;
    }
    PG8_WAIT_V(0);
    if (wr == 0) PG8_BAR;
    PG8_BAR;
    if constexpr (Epi::AFTER_DRAIN) { E.fused(acc, cur, wr, wc, fr, fq, lds, wid, lane); S.done(cur); }
    PG8_STAMP();
    if (STAMP && wid == 0) { stamps[lane] = lane < nts ? (((unsigned long long)(unsigned)ts_hi << 32) | (unsigned)ts_lo) : 0ull;
        if (lane == 62) stamps[62] = rt_entry; if (lane == 63) stamps[63] = 0ull; }
#undef PG8_STAMP
#undef PG8_SA
#undef PG8_SB
#undef PG8_STAGE
#undef PG8_LDA
#undef PG8_LDB
#undef PG8_MMA
#undef PG8_WAIT_V
#undef PG8_WAIT_L
#undef PG8_BAR
#undef PG8_SCHED
}
}

struct EpiInproj {
    static constexpr bool PERM = true, AFTER_DRAIN = false;
    unsigned char* ws; const float* rstd;
    __device__ __forceinline__ void operator()(const pg8::f32x4 (&acc)[2][2][4][2], const pg8::Unit& u, int wr, int wc, int fr, int fq) const {
        const int pn = u.pn;
        bf16_t* dst; int ld, cb;
        if (pn < 4) { dst = (bf16_t*)(ws + OFF_PPOOL); ld = 1024; cb = pn * 256; }
        else if (pn < 8) { dst = (bf16_t*)(ws + OFF_PR); ld = 1024; cb = (pn - 4) * 256; }
        else if (pn < 12) { dst = (bf16_t*)(ws + OFF_PK); ld = 1024; cb = (pn - 8) * 256; }
        else if (pn < 16) { dst = (bf16_t*)(ws + OFF_PV); ld = 1024; cb = (pn - 12) * 256; }
        else { dst = (bf16_t*)(ws + OFF_PMISC); ld = PM_LD; cb = (pn - 16) * 256; }
        bf16_t* halo = (bf16_t*)(ws + OFF_HALO);
#pragma unroll
        for (int ai = 0; ai < 2; ++ai)
#pragma unroll
            for (int m = 0; m < 4; ++m) {
                const int row = u.pm * 256 + ai * 128 + wr * 64 + m * 16 + fr;
                if (row < NT) {
                    const float rs = rstd[row];
                    const int lr = row & 127;
#pragma unroll
                    for (int bj = 0; bj < 2; ++bj) {
                        const int col = cb + bj * 128 + wc * 32 + fq * 8;
                        const uint2 lo = pack4(acc[ai][bj][m][0][0] * rs, acc[ai][bj][m][0][1] * rs, acc[ai][bj][m][0][2] * rs, acc[ai][bj][m][0][3] * rs);
                        const uint2 hi = pack4(acc[ai][bj][m][1][0] * rs, acc[ai][bj][m][1][1] * rs, acc[ai][bj][m][1][2] * rs, acc[ai][bj][m][1][3] * rs);
                        const uint4 v = make_uint4(lo.x, lo.y, hi.x, hi.y);
                        *(uint4*)(dst + (size_t)row * ld + col) = v;
                        if (pn < 4 && lr >= 112) *(uint4*)(halo + ((size_t)(row >> 7) * 16 + (lr - 112)) * 1024 + col) = v;
                    }
                }
            }
    }
};
__device__ void phase_inproj(const Params& p, unsigned char* lds) {
    pg8::StaticOrder S; S.init(NTP, NP1, (int)gridDim.x, obid());
    pg8::Gemm g; g.A = (const pg8::bf16_t*)(WS(p) + OFF_H); g.Bt = (const pg8::bf16_t*)(WS(p) + OFF_WB) + WB_WIN; g.M = NTP; g.N = NP1; g.K = DM;
    EpiInproj E; E.ws = WS(p); E.rstd = (const float*)(WS(p) + OFF_RSTD);
    pg8::gemm_phase<EpiInproj, pg8::StaticOrder, false>((PG8_LAS unsigned char*)lds, g, S, E, nullptr);
}

__device__ void phase_pool(const Params& p, int l, unsigned char* lds, int tb, int te, int tstep) {
    const int tid = otid(), lane = tid & 63, wid = tid >> 6, fr = lane & 15, fq = lane >> 4;
    bf16_t* pp = (bf16_t*)(WS(p) + OFF_PPOOL);
    const bf16_t* halo = (const bf16_t*)(WS(p) + OFF_HALO);
    const bf16_t* pw = (const bf16_t*)(WS(p) + OFF_WB) + WB_POOL;
    const float* scale = p.in[6] + (size_t)l * 1024;
    bf16_t* sp = (bf16_t*)lds;
    constexpr int SLD = 264;
    for (int tile = tb; tile < te; tile += tstep) {
        const int mt = tile >> 2, g = tile & 3;
        const int row0 = mt * 128, w = 2 << g;
        {
            const int c = tid & 255, r0 = (tid >> 8) * 64, col = g * 256 + c;
            auto rawv = [&](int n2) -> float {
                return (n2 >= row0) ? bf2f(pp[(size_t)n2 * 1024 + col]) : bf2f(halo[((size_t)(n2 >> 7) * 16 + ((n2 & 127) - 112)) * 1024 + col]);
            };
            int n = row0 + r0, t = n % TS;
            float sum = 0.f;
            const int have = (t < w) ? t : w;
            for (int i = 1; i <= have; ++i) sum += rawv(n - i);
#pragma unroll 4
            for (int r = 0; r < 64; ++r, ++n) {
                if (t == 0) sum = 0.f;
                const float v = rawv(n);
                sum += v;
                if (t >= w) sum -= rawv(n - w);
                const int cnt = (t + 1 < w) ? (t + 1) : w;
                sp[(r0 + r) * SLD + c] = f2bf(sum * (1.0f / (float)cnt) - v);
                t = (t + 1 == TS) ? 0 : t + 1;
            }
        }
        __syncthreads();
        f32x4 acc[8][2];
#pragma unroll
        for (int m = 0; m < 8; ++m) { acc[m][0] = (f32x4){0.f, 0.f, 0.f, 0.f}; acc[m][1] = (f32x4){0.f, 0.f, 0.f, 0.f}; }
        const bf16_t* wg = pw + (size_t)g * 65536;
#pragma unroll 1
        for (int kk = 0; kk < 8; ++kk) {
            bf16x8 bfr[2];
#pragma unroll
            for (int n = 0; n < 2; ++n) bfr[n] = *(const bf16x8*)(wg + (size_t)(wid * 32 + n * 16 + fr) * 256 + kk * 32 + fq * 8);
#pragma unroll
            for (int m = 0; m < 8; ++m) {
                const bf16x8 a = *(const bf16x8*)(sp + (m * 16 + fr) * SLD + kk * 32 + fq * 8);
                acc[m][0] = __builtin_amdgcn_mfma_f32_16x16x32_bf16(a, bfr[0], acc[m][0], 0, 0, 0);
                acc[m][1] = __builtin_amdgcn_mfma_f32_16x16x32_bf16(a, bfr[1], acc[m][1], 0, 0, 0);
            }
        }
#pragma unroll
        for (int m = 0; m < 8; ++m)
#pragma unroll
            for (int n = 0; n < 2; ++n) {
                const int col = g * 256 + wid * 32 + n * 16 + fr;
                const float sc = scale[col];
#pragma unroll
                for (int j = 0; j < 4; ++j) {
                    const int row = row0 + m * 16 + fq * 4 + j;
                    pp[(size_t)row * 1024 + col] = f2bf(acc[m][n][j] * sc);
                }
            }
        __syncthreads();
    }
}

__device__ void phase_dsa_prep(const Params& p, int l) {
    const int lane = otid() & 63;
    const int wave = (obid() * NTHR + otid()) >> 6, nw = gridDim.x * NTHR / 64;
    const bf16_t* pm = (const bf16_t*)(WS(p) + OFF_PMISC);
    unsigned char* dob = OUTB(p);
    bf16_t* cqn = (bf16_t*)(dob + DO_CQN);
    bf16_t* kv = (bf16_t*)(dob + DO_KV);
    bf16_t* kidx = (bf16_t*)(dob + DO_KIDX);
    float* whead = (float*)(dob + DO_WHEAD);
    const float* ctab = (const float*)(WS(p) + OFF_ROPE);
    const float* stab = ctab + TS * 16;
    const float* qn = p.in[21] + l * 256;
    const float* kvn = p.in[22] + l * 128;
    const float* inw = p.in[27] + l * 64;
    const float* inb = p.in[28] + l * 64;
    const bf16_t* hrow = (const bf16_t*)(WS(p) + OFF_H);
    const bf16_t* wwidx = (const bf16_t*)(WS(p) + OFF_WB) + WB_WIDX;
    const float* rstd_ = (const float*)(WS(p) + OFF_RSTD);
    for (int n = wave; n < NT; n += nw) {
        const int t = n % TS;
        const bf16_t* row = pm + (size_t)n * PM_LD;
        {
            float v[4]; float ss = 0.f;
#pragma unroll
            for (int i = 0; i < 4; ++i) { v[i] = bf2f(row[PM_CQ + lane * 4 + i]); ss += v[i] * v[i]; }
            ss = wave_sum_fast(ss);
            const float rs = rsqrtf(ss * (1.0f / 256.0f) + 1e-6f);
#pragma unroll
            for (int i = 0; i < 4; ++i) cqn[(size_t)n * 256 + lane * 4 + i] = f2bf(v[i] * rs * qn[lane * 4 + i]);
        }
        {
            float v[2]; float ss = 0.f;
#pragma unroll
            for (int i = 0; i < 2; ++i) { v[i] = bf2f(row[PM_CKV + lane * 2 + i]); ss += v[i] * v[i]; }
            ss = wave_sum_fast(ss);
            const float rs = rsqrtf(ss * (1.0f / 128.0f) + 1e-6f);
#pragma unroll
            for (int i = 0; i < 2; ++i) kv[(size_t)n * 160 + lane * 2 + i] = f2bf(v[i] * rs * kvn[lane * 2 + i]);
        }
        if (lane < 16) {
            const float x1 = bf2f(row[PM_KROPE + lane]), x2 = bf2f(row[PM_KROPE + 16 + lane]);
            const float c = ctab[t * 16 + lane], s = stab[t * 16 + lane];
            kv[(size_t)n * 160 + 128 + lane] = f2bf(x1 * c - x2 * s);
            kv[(size_t)n * 160 + 144 + lane] = f2bf(x2 * c + x1 * s);
        }
        {
            const float x = bf2f(row[PM_KIDX + lane]);
            const float mu = wave_sum_fast(x) * (1.0f / 64.0f);
            const float d = x - mu;
            const float var = wave_sum_fast(d * d) * (1.0f / 64.0f);
            const float y = d * rsqrtf(var + 1e-6f) * inw[lane] + inb[lane];
            const float yo = __shfl_xor(y, 16);
            float o = y;
            if (lane < 32) {
                const int i = lane & 15;
                const float c = ctab[t * 16 + i], s = stab[t * 16 + i];
                o = (lane < 16) ? (y * c - yo * s) : (y * c + yo * s);
            }
            kidx[(size_t)n * 64 + lane] = f2bf(o);
        }
        {
            const uint4 hv0 = *(const uint4*)(hrow + (size_t)n * DM + lane * 16), hv1 = *(const uint4*)(hrow + (size_t)n * DM + lane * 16 + 8);
            float hx[16];
            hx[0] = __uint_as_float(hv0.x << 16); hx[1] = __uint_as_float(hv0.x & 0xFFFF0000u); hx[2] = __uint_as_float(hv0.y << 16); hx[3] = __uint_as_float(hv0.y & 0xFFFF0000u);
            hx[4] = __uint_as_float(hv0.z << 16); hx[5] = __uint_as_float(hv0.z & 0xFFFF0000u); hx[6] = __uint_as_float(hv0.w << 16); hx[7] = __uint_as_float(hv0.w & 0xFFFF0000u);
            hx[8] = __uint_as_float(hv1.x << 16); hx[9] = __uint_as_float(hv1.x & 0xFFFF0000u); hx[10] = __uint_as_float(hv1.y << 16); hx[11] = __uint_as_float(hv1.y & 0xFFFF0000u);
            hx[12] = __uint_as_float(hv1.z << 16); hx[13] = __uint_as_float(hv1.z & 0xFFFF0000u); hx[14] = __uint_as_float(hv1.w << 16); hx[15] = __uint_as_float(hv1.w & 0xFFFF0000u);
            float myw = 0.f;
#pragma unroll
            for (int j = 0; j < 8; ++j) {
                const uint4 w0 = *(const uint4*)(wwidx + (size_t)j * DM + lane * 16), w1 = *(const uint4*)(wwidx + (size_t)j * DM + lane * 16 + 8);
                float d = hx[0] * __uint_as_float(w0.x << 16) + hx[1] * __uint_as_float(w0.x & 0xFFFF0000u) + hx[2] * __uint_as_float(w0.y << 16) + hx[3] * __uint_as_float(w0.y & 0xFFFF0000u)
                        + hx[4] * __uint_as_float(w0.z << 16) + hx[5] * __uint_as_float(w0.z & 0xFFFF0000u) + hx[6] * __uint_as_float(w0.w << 16) + hx[7] * __uint_as_float(w0.w & 0xFFFF0000u)
                        + hx[8] * __uint_as_float(w1.x << 16) + hx[9] * __uint_as_float(w1.x & 0xFFFF0000u) + hx[10] * __uint_as_float(w1.y << 16) + hx[11] * __uint_as_float(w1.y & 0xFFFF0000u)
                        + hx[12] * __uint_as_float(w1.z << 16) + hx[13] * __uint_as_float(w1.z & 0xFFFF0000u) + hx[14] * __uint_as_float(w1.w << 16) + hx[15] * __uint_as_float(w1.w & 0xFFFF0000u);
                d = wave_sum_fast(d);
                myw = (lane == j) ? d : myw;
            }
            if (lane < 8) whead[(size_t)n * 8 + lane] = myw * rstd_[n] * 0.04419417382415922f;
        }
    }
}

typedef short s16x4 __attribute__((ext_vector_type(4)));
__device__ __forceinline__ unsigned f2h_bits(float f) { const _Float16 h = (_Float16)f; unsigned short u; __builtin_memcpy(&u, &h, 2); return u; }
template <bool IMPORT_SEL>
__device__ void phase_dsa(const Params& p, int l, unsigned char* lds, bf16_t* yc, const unsigned short* gsel, const int* gnsel, int tb, int te, int tstep) {
    const int tid = otid(), lane = tid & 63, wid = tid >> 6, fr = lane & 15, fq = lane >> 4;
    unsigned short* s_sc = (unsigned short*)lds;
    bf16_t* s_qi = (bf16_t*)(lds + 66048);
    bf16_t* s_Q = (bf16_t*)lds;
    unsigned char* s_Vw = lds + 82432 + wid * 8192;
    bf16_t* s_qn = (bf16_t*)s_Vw;
    unsigned short* s_sel = (unsigned short*)(lds + 82432 + 65536);
    int* s_nsel = (int*)(lds + 82432 + 65536 + 8192);
    unsigned char* dob = OUTB(p);
    const bf16_t* cqn = (const bf16_t*)(dob + DO_CQN);
    const bf16_t* kv = (const bf16_t*)(dob + DO_KV);
    const bf16_t* kidx = (const bf16_t*)(dob + DO_KIDX);
    const float* whead = (const float*)(dob + DO_WHEAD);
    const float* ctab = (const float*)(WS(p) + OFF_ROPE);
    const float* stab = ctab + TS * 16;
    const bf16_t* wb = (const bf16_t*)(WS(p) + OFF_WB);
    const bf16_t* wqiT = wb + WB_QI;
    const bf16_t* wuqT = wb + WB_UQ;
    const bf16_t* wuk = wb + WB_UK;
    const bf16_t* wuvT = wb + WB_UV;
    const float scale = 0.10206207261596575f;
    const f32x4 z4 = {0.f, 0.f, 0.f, 0.f};
    for (int tile = tb; tile < te; tile += tstep) {
        const int qt = 128 - (tile >> 3), b = tile & 7;
        const int t0 = qt * 16;
        const size_t n0 = (size_t)b * TS + t0;
        {
            bf16x8 acq[8];
#pragma unroll
            for (int kk = 0; kk < 8; ++kk) acq[kk] = *(const bf16x8*)(cqn + (n0 + fr) * 256 + kk * 32 + fq * 8);
            f32x4 c[4] = {z4, z4, z4, z4};
#pragma unroll
            for (int kb = 0; kb < 8; kb += 4) {
                bf16x8 bf[4][4];
#pragma unroll
                for (int k4 = 0; k4 < 4; ++k4)
#pragma unroll
                    for (int nt = 0; nt < 4; ++nt) bf[k4][nt] = *(const bf16x8*)(wqiT + (size_t)(wid * 64 + nt * 16 + fr) * 256 + (kb + k4) * 32 + fq * 8);
#pragma unroll
                for (int k4 = 0; k4 < 4; ++k4)
#pragma unroll
                    for (int nt = 0; nt < 4; ++nt) c[nt] = __builtin_amdgcn_mfma_f32_16x16x32_bf16(acq[kb + k4], bf[k4][nt], c[nt], 0, 0, 0);
            }
#pragma unroll
            for (int j = 0; j < 4; ++j) {
                const int t = t0 + fq * 4 + j;
                const float cs = ctab[t * 16 + fr], sn = stab[t * 16 + fr];
                const float x1 = c[0][j], x2 = c[1][j];
                c[0][j] = x1 * cs - x2 * sn; c[1][j] = x2 * cs + x1 * sn;
            }
#pragma unroll
            for (int nt = 0; nt < 4; ++nt)
#pragma unroll
                for (int j = 0; j < 4; ++j) s_qi[(fq * 4 + j) * 512 + wid * 64 + nt * 16 + fr] = f2bf(c[nt][j]);
        }
        __syncthreads();
        if (!IMPORT_SEL) {
            bf16x8 aq[8][2];
#pragma unroll
            for (int h = 0; h < 8; ++h)
#pragma unroll
                for (int ks = 0; ks < 2; ++ks) aq[h][ks] = *(const bf16x8*)(s_qi + fr * 512 + h * 64 + ks * 32 + fq * 8);
            float wh[4][8];
#pragma unroll
            for (int j = 0; j < 4; ++j) {
                const float4 w0 = *(const float4*)(whead + (n0 + fq * 4 + j) * 8), w1 = *(const float4*)(whead + (n0 + fq * 4 + j) * 8 + 4);
                wh[j][0] = w0.x; wh[j][1] = w0.y; wh[j][2] = w0.z; wh[j][3] = w0.w; wh[j][4] = w1.x; wh[j][5] = w1.y; wh[j][6] = w1.z; wh[j][7] = w1.w;
            }
            const int nkt = qt + 1;
            bf16x8 nb0 = {0, 0, 0, 0, 0, 0, 0, 0}, nb1 = nb0;
            if (wid < nkt) { const bf16_t* kr0 = kidx + ((size_t)b * TS + wid * 16 + fr) * 64 + fq * 8; nb0 = *(const bf16x8*)kr0; nb1 = *(const bf16x8*)(kr0 + 32); }
#pragma unroll 1
            for (int kt = wid; kt < nkt; kt += 8) {
                const bf16x8 bk0 = nb0, bk1 = nb1;
                if (kt + 8 < nkt) { const bf16_t* krn = kidx + ((size_t)b * TS + (kt + 8) * 16 + fr) * 64 + fq * 8; nb0 = *(const bf16x8*)krn; nb1 = *(const bf16x8*)(krn + 32); }
                float I[4] = {0.f, 0.f, 0.f, 0.f};
#pragma unroll
                for (int h = 0; h < 8; ++h) {
                    f32x4 a = __builtin_amdgcn_mfma_f32_16x16x32_bf16(aq[h][0], bk0, z4, 0, 0, 0);
                    a = __builtin_amdgcn_mfma_f32_16x16x32_bf16(aq[h][1], bk1, a, 0, 0, 0);
#pragma unroll
                    for (int j = 0; j < 4; ++j) I[j] += wh[j][h] * fmaxf(a[j], 0.f);
                }
#pragma unroll
                for (int j = 0; j < 4; ++j) s_sc[(fq * 4 + j) * 2064 + kt * 16 + fr] = (unsigned short)f2h_bits(I[j]);
            }
        }
        __syncthreads();
#pragma unroll 1
        for (int qi2 = 0; qi2 < 2; ++qi2) {
            const int q = wid + qi2 * 8;
            const int nadm = t0 + q + 1;
            unsigned short* sel = s_sel + q * 256;
            if (IMPORT_SEL) {
                const int ns = gnsel[n0 + q];
                for (int i = lane; i < ns; i += 64) sel[i] = gsel[(n0 + q) * 256 + i];
                if (lane == 0) s_nsel[q] = ns;
            } else if (nadm <= 256) {
                for (int i = lane; i < nadm; i += 64) sel[i] = (unsigned short)i;
                if (lane == 0) s_nsel[q] = nadm;
            } else {
                auto topk = [&](auto nch_tag) {
                    constexpr int NCH = decltype(nch_tag)::value;
                    unsigned key[NCH];
    #pragma unroll
                    for (int c = 0; c < NCH; ++c) {
                        const int s = c * 64 + lane;
                        unsigned k = 0u;
                        if (s < nadm) { const unsigned u = s_sc[q * 2064 + s]; k = (u & 0x8000u) ? (~u & 0xFFFFu) : (u | 0x8000u); }
                        key[c] = k;
                    }
                    unsigned T = 0u;
    #pragma unroll 1
                    for (int bit = 15; bit >= 0; --bit) {
                        const unsigned cand = T | (1u << bit);
                        int cnt = 0;
    #pragma unroll
                        for (int c = 0; c < NCH; ++c) cnt += __popcll(__ballot(key[c] >= cand));
                        if (cnt >= 256) T = cand;
                    }
                    int ngt = 0;
    #pragma unroll
                    for (int c = 0; c < NCH; ++c) ngt += __popcll(__ballot(key[c] > T));
                    const int rties = 256 - ngt;
                    int base = 0, ties = 0;
                    const unsigned long long ltmask = (1ull << lane) - 1ull;
    #pragma unroll
                    for (int c = 0; c < NCH; ++c) {
                        const bool gt = key[c] > T, eq = key[c] == T;
                        const unsigned long long em = __ballot(eq);
                        const int myrank = ties + __popcll(em & ltmask);
                        const bool take = gt || (eq && myrank < rties);
                        const unsigned long long tm = __ballot(take);
                        const int pos = base + __popcll(tm & ltmask);
                        if (take && pos < 256) sel[pos] = (unsigned short)(c * 64 + lane);
                        base += __popcll(tm); ties += __popcll(em);
                    }

                };
                if (nadm <= 512) topk(std::integral_constant<int, 8>{});
                else if (nadm <= 1024) topk(std::integral_constant<int, 16>{});
                else if (nadm <= 1536) topk(std::integral_constant<int, 24>{});
                else topk(std::integral_constant<int, 33>{});
                if (lane == 0) s_nsel[q] = 256;
            }
        }
        __syncthreads();
#pragma unroll 1
        for (int hi = 0; hi < 2; ++hi) {
            const int hh = wid * 2 + hi;
            bf16x8 acq[8];
#pragma unroll
            for (int kk = 0; kk < 8; ++kk) acq[kk] = *(const bf16x8*)(cqn + (n0 + fr) * 256 + kk * 32 + fq * 8);
            f32x4 c6[6] = {z4, z4, z4, z4, z4, z4};
#pragma unroll
            for (int kb = 0; kb < 8; kb += 4) {
                bf16x8 bf[4][6];
#pragma unroll
                for (int k4 = 0; k4 < 4; ++k4)
#pragma unroll
                    for (int nt = 0; nt < 6; ++nt) bf[k4][nt] = *(const bf16x8*)(wuqT + (size_t)(hh * 96 + nt * 16 + fr) * 256 + (kb + k4) * 32 + fq * 8);
#pragma unroll
                for (int k4 = 0; k4 < 4; ++k4)
#pragma unroll
                    for (int nt = 0; nt < 6; ++nt) c6[nt] = __builtin_amdgcn_mfma_f32_16x16x32_bf16(acq[kb + k4], bf[k4][nt], c6[nt], 0, 0, 0);
            }
#pragma unroll
            for (int j = 0; j < 4; ++j) {
                const int q = fq * 4 + j, t = t0 + q;
                const float cs = ctab[t * 16 + fr], sn = stab[t * 16 + fr];
                const float x1 = c6[4][j], x2 = c6[5][j];
                s_Q[(q * 16 + hh) * 160 + 128 + fr] = f2bf(x1 * cs - x2 * sn);
                s_Q[(q * 16 + hh) * 160 + 144 + fr] = f2bf(x2 * cs + x1 * sn);
#pragma unroll
                for (int nt = 0; nt < 4; ++nt) s_qn[q * 64 + nt * 16 + fr] = f2bf(c6[nt][j]);
            }
            __syncthreads();
            bf16x8 an[2];
#pragma unroll
            for (int ks = 0; ks < 2; ++ks) an[ks] = *(const bf16x8*)(s_qn + fr * 64 + ks * 32 + fq * 8);
            bf16x8 bwk[8][2];
#pragma unroll
            for (int nt = 0; nt < 8; ++nt)
#pragma unroll
                for (int ks = 0; ks < 2; ++ks) bwk[nt][ks] = *(const bf16x8*)(wuk + (size_t)(hh * 128 + nt * 16 + fr) * 64 + ks * 32 + fq * 8);
#pragma unroll
            for (int nt = 0; nt < 8; ++nt) {
                f32x4 a = z4;
#pragma unroll
                for (int ks = 0; ks < 2; ++ks)
                    a = __builtin_amdgcn_mfma_f32_16x16x32_bf16(an[ks], bwk[nt][ks], a, 0, 0, 0);
#pragma unroll
                for (int j = 0; j < 4; ++j) s_Q[((fq * 4 + j) * 16 + hh) * 160 + nt * 16 + fr] = f2bf(a[j]);
            }
            __syncthreads();
        }
#pragma unroll 1
        for (int qi2 = 0; qi2 < 2; ++qi2) {
            const int q = wid + qi2 * 8;
            bf16x8 bq[5];
#pragma unroll
            for (int ks = 0; ks < 5; ++ks) bq[ks] = *(const bf16x8*)(s_Q + (q * 16 + fr) * 160 + ks * 32 + fq * 8);
            const int nsel = s_nsel[q];
            const unsigned short* sel = s_sel + q * 256;
            float m = -INFINITY, lsum = 0.f;
            f32x4 O[8] = {z4, z4, z4, z4, z4, z4, z4, z4};
            const int nchunk = (nsel + 31) >> 5;
            bf16x8 akn[2][5];
#pragma unroll
            for (int mt = 0; mt < 2; ++mt) {
                const int ki = mt * 16 + fr;
                const int sidx = sel[ki < nsel ? ki : 0];
                const bf16_t* krow = kv + ((size_t)b * TS + sidx) * 160 + fq * 8;
#pragma unroll
                for (int ks = 0; ks < 5; ++ks) akn[mt][ks] = *(const bf16x8*)(krow + ks * 32);
            }
#pragma unroll 1
            for (int ch = 0; ch < nchunk; ++ch) {
                bf16x8 ak[2][5];
#pragma unroll
                for (int mt = 0; mt < 2; ++mt)
#pragma unroll
                    for (int ks = 0; ks < 5; ++ks) ak[mt][ks] = akn[mt][ks];
                if (ch + 1 < nchunk) {
#pragma unroll
                    for (int mt = 0; mt < 2; ++mt) {
                        const int ki = (ch + 1) * 32 + mt * 16 + fr;
                        const int sidx = sel[ki < nsel ? ki : 0];
                        const bf16_t* krow = kv + ((size_t)b * TS + sidx) * 160 + fq * 8;
#pragma unroll
                        for (int ks = 0; ks < 5; ++ks) akn[mt][ks] = *(const bf16x8*)(krow + ks * 32);
                    }
                }
#pragma unroll
                for (int mt = 0; mt < 2; ++mt)
#pragma unroll
                    for (int ks = 0; ks < 4; ++ks) {
                        const int r = mt * 16 + fr;
                        *(bf16x8*)(s_Vw + r * 256 + (((ks * 2 + (fq >> 1)) ^ (r & 7)) * 32) + (fq & 1) * 16) = ak[mt][ks];
                    }
                f32x4 st[2] = {z4, z4};
#pragma unroll
                for (int mt = 0; mt < 2; ++mt)
#pragma unroll
                    for (int ks = 0; ks < 5; ++ks) st[mt] = __builtin_amdgcn_mfma_f32_16x16x32_bf16(ak[mt][ks], bq[ks], st[mt], 0, 0, 0);
                float sv[2][4]; float cmax = -INFINITY;
#pragma unroll
                for (int mt = 0; mt < 2; ++mt)
#pragma unroll
                    for (int j = 0; j < 4; ++j) {
                        const int ke = ch * 32 + mt * 16 + fq * 4 + j;
                        const float s_ = (ke < nsel) ? st[mt][j] * scale : -INFINITY;
                        sv[mt][j] = s_; cmax = fmaxf(cmax, s_);
                    }
                cmax = fmaxf(cmax, __shfl_xor(cmax, 16)); cmax = fmaxf(cmax, __shfl_xor(cmax, 32));
                const float mnew = fmaxf(m, cmax);
                const float alpha = __expf(m - mnew);
                float psum = 0.f;
#pragma unroll
                for (int mt = 0; mt < 2; ++mt)
#pragma unroll
                    for (int j = 0; j < 4; ++j) { const float pe = __expf(sv[mt][j] - mnew); sv[mt][j] = pe; psum += pe; }
                psum += __shfl_xor(psum, 16); psum += __shfl_xor(psum, 32);
                lsum = lsum * alpha + psum; m = mnew;
#pragma unroll
                for (int ct = 0; ct < 8; ++ct) O[ct] = O[ct] * alpha;
                bf16x8 pf;
#pragma unroll
                for (int mt = 0; mt < 2; ++mt)
#pragma unroll
                    for (int j = 0; j < 4; ++j) pf[mt * 4 + j] = (short)f2bf(sv[mt][j]);
                const int q_ = fr >> 2, p_ = fr & 3;
                const int r0 = fq * 4 + q_, r1 = 16 + r0;
#pragma unroll
                for (int ct = 0; ct < 8; ++ct) {
                    const s16x4 v0 = __builtin_amdgcn_ds_read_tr16_b64_v4i16((__attribute__((address_space(3))) s16x4*)(s_Vw + r0 * 256 + ((ct ^ (r0 & 7)) * 32) + p_ * 8));
                    const s16x4 v1 = __builtin_amdgcn_ds_read_tr16_b64_v4i16((__attribute__((address_space(3))) s16x4*)(s_Vw + r1 * 256 + ((ct ^ (r1 & 7)) * 32) + p_ * 8));
                    bf16x8 av; av[0] = v0[0]; av[1] = v0[1]; av[2] = v0[2]; av[3] = v0[3]; av[4] = v1[0]; av[5] = v1[1]; av[6] = v1[2]; av[7] = v1[3];
                    O[ct] = __builtin_amdgcn_mfma_f32_16x16x32_bf16(av, pf, O[ct], 0, 0, 0);
                }
            }
            const float inv = 1.0f / lsum;
#pragma unroll
            for (int ct = 0; ct < 8; ++ct)
#pragma unroll
                for (int j = 0; j < 4; ++j) s_Q[(q * 16 + fr) * 160 + ct * 16 + fq * 4 + j] = f2bf(O[ct][j] * inv);
        }
        __syncthreads();
#pragma unroll 1
        for (int hi = 0; hi < 2; ++hi) {
            const int hh = wid * 2 + hi;
            bf16x8 ao[4];
#pragma unroll
            for (int ks = 0; ks < 4; ++ks) ao[ks] = *(const bf16x8*)(s_Q + (fr * 16 + hh) * 160 + ks * 32 + fq * 8);
#pragma unroll
            for (int nt = 0; nt < 4; ++nt) {
                f32x4 a = z4;
#pragma unroll
                for (int ks = 0; ks < 4; ++ks)
                    a = __builtin_amdgcn_mfma_f32_16x16x32_bf16(ao[ks], *(const bf16x8*)(wuvT + (size_t)(hh * 64 + nt * 16 + fr) * 128 + ks * 32 + fq * 8), a, 0, 0, 0);
#pragma unroll
                for (int j = 0; j < 4; ++j) yc[(n0 + fq * 4 + j) * 1024 + hh * 64 + nt * 16 + fr] = f2bf(a[j]);
            }
        }
        __syncthreads();
    }
}


__device__ void phase_lr_prep(const Params& p, int l) {
    const int lane = otid() & 63;
    const int wave = (obid() * NTHR + otid()) >> 6, nw = gridDim.x * NTHR / 64;
    const bf16_t* pm = (const bf16_t*)(WS(p) + OFF_PMISC);
    bf16_t* alr = (bf16_t*)(OUTB(p) + DO_ALR);
    const float* mu = p.in[4] + (size_t)l * 3328 + 3072;
    const float* vmu = p.in[18];
    for (int n = wave; n < NT; n += nw) {
        const int t = n % TS;
        for (int c = lane; c < 288; c += 64) {
            const float cur = bf2f(pm[(size_t)n * PM_LD + c]);
            const float prv = (t > 0) ? bf2f(pm[(size_t)(n - 1) * PM_LD + c]) : 0.f;
            const float m_ = (c < 256) ? mu[c] : vmu[c - 256];
            float xs = cur + (prv - cur) * m_;
            if (c < 64) xs = tanhf(xs);
            else if (c >= 128 && c < 256) xs = sigmoidf_(xs);
            alr[(size_t)n * 288 + c] = f2bf(xs);
        }
    }
}

typedef short sh4 __attribute__((ext_vector_type(4)));
__device__ __forceinline__ sh4 pk4v(const f32x4& v) { const uint2 u = pack4(v[0], v[1], v[2], v[3]); sh4 r; __builtin_memcpy(&r, &u, 8); return r; }
__device__ __forceinline__ bf16x8 cat8(const sh4& a, const sh4& b) { bf16x8 r; r[0] = a[0]; r[1] = a[1]; r[2] = a[2]; r[3] = a[3]; r[4] = b[0]; r[5] = b[1]; r[6] = b[2]; r[7] = b[3]; return r; }
#define MF32(a, b, c) __builtin_amdgcn_mfma_f32_16x16x32_bf16(a, b, c, 0, 0, 0)
#define MF16(a, b, c) MF32(cat8(a, sh4{0, 0, 0, 0}), cat8(b, sh4{0, 0, 0, 0}), c)
constexpr int SC_LT = 72;
constexpr int SC_LS = 36;
constexpr int SC_TC = 32;
constexpr int SC_ROWB = 1088;
__device__ __forceinline__ const unsigned char* scan_piece_src(const Params& p, int l, int b, int hc, int t0, int pi, bool& ok) {
    const int tau = pi / 68, seg = pi - tau * 68;
    const int t = t0 + tau;
    ok = (t < TS) && (tau < SC_TC);
    const size_t n = (size_t)b * TS + t;
    const unsigned char* ws = WS(p);
    if (seg < 8) return ws + OFF_PR + (n * 1024 + hc) * 2 + seg * 16;
    if (seg < 16) return ws + OFF_PK + (n * 1024 + hc) * 2 + (seg - 8) * 16;
    if (seg < 24) return ws + OFF_PV + (n * 1024 + hc) * 2 + (seg - 16) * 16;
    if (seg < 60) return OUTB(p) + DO_ALR + (n * 288) * 2 + (seg - 24) * 16;
    ok = ok && (l > 0);
    return ws + OFF_VFIRST + (n * 1024 + hc) * 2 + (seg - 60) * 16;
}
__device__ void phase_scan5(const Params& p, int l, unsigned char* lds, int blk) {
    const int tid = otid(), lane = tid & 63, wid = tid >> 6, fr = lane & 15, fq = lane >> 4;
    const int b = blk >> 4, hh = blk & 15, hc = hh * 64;
    float* s_r = (float*)lds;
    float* s_w = s_r + 2048;
    float* s_k = s_w + 2048;
    float* s_v = s_k + 2048;
    float* s_a = s_v + 2048;
    float* s_b = s_a + 2048;
    float* s_g = s_b + 2048;
    float* s_o = s_g + 2048;
    bf16_t* o_at = (bf16_t*)(s_o + 2048);
    bf16_t* o_rt = o_at + 32 * SC_LT;
    bf16_t* o_bt = o_rt + 32 * SC_LT;
    bf16_t* o_kt = o_bt + 32 * SC_LT;
    bf16_t* o_bT = o_kt + 32 * SC_LT;
    bf16_t* o_kT = o_bT + 64 * SC_LS;
    bf16_t* o_vT = o_kT + 64 * SC_LS;
    float* s_gc = (float*)(o_vT + 64 * SC_LS);
    unsigned char* raw = (unsigned char*)(s_gc + 128);
    float* prevb = (float*)(raw + 32 * SC_ROWB);
    float* cst = prevb + 960;
    const float* mu = p.in[4] + (size_t)l * 3328;
    for (int e = tid; e < 480; e += NTHR) {
        float v;
        if (e < 192) v = mu[(e >> 6) * 1024 + hc + (e & 63)];
        else if (e < 448) v = mu[3072 + (e - 192)];
        else v = p.in[18][e - 448];
        cst[e] = v;
    }
    if (tid < 64) {
        cst[480 + tid] = p.in[7][l * 1024 + hc + tid];
        cst[544 + tid] = p.in[9][l * 1024 + hc + tid];
        cst[608 + tid] = p.in[12][l * 1024 + hc + tid];
        cst[672 + tid] = p.in[13][l * 1024 + hc + tid];
        cst[736 + tid] = p.in[14][l * 1024 + hc + tid];
        cst[800 + tid] = p.in[15][l * 1024 + hc + tid];
        cst[864 + tid] = p.in[16][l * 1024 + hc + tid];
        cst[928 + tid] = p.in[19][hc + tid];
    }
    const int mm = wid >> 1, ntb = (wid & 1) * 2;
    const int nks = (mm == 2) ? 4 : (mm == 3 ? 1 : 2);
    bf16x8 Bw[2][4];
    {
        const float* wsrc = (mm == 0) ? p.in[8] + (size_t)l * 64 * 1024 : (mm == 1) ? p.in[10] + (size_t)l * 64 * 1024 : (mm == 2) ? p.in[11] + (size_t)l * 128 * 1024 : p.in[20];
#pragma unroll
        for (int n2 = 0; n2 < 2; ++n2)
#pragma unroll
            for (int ks = 0; ks < 4; ++ks) {
                bf16x8 f;
#pragma unroll
                for (int j = 0; j < 8; ++j) {
                    const bool okw = ks < nks && (mm < 3 || l > 0);
                    const float v = wsrc[(size_t)(okw ? (ks * 32 + fq * 8 + j) : 0) * 1024 + hc + (ntb + n2) * 16 + fr];
                    f[j] = (short)f2bf(okw ? v : 0.f);
                }
                Bw[n2][ks] = f;
            }
    }
    const f32x4 z4 = {0.f, 0.f, 0.f, 0.f};
    f32x4 S[4] = {z4, z4, z4, z4};
    sh4 Lf;
#pragma unroll
    for (int j = 0; j < 4; ++j) Lf[j] = (fq * 4 + j <= fr) ? (short)0x3F80 : (short)0;
    bf16_t* Pr = (bf16_t*)(WS(p) + OFF_PR);
    bf16_t* vfirst = (bf16_t*)(WS(p) + OFF_VFIRST);
    const unsigned char* psrc[5]; int pstep[5], ptau[5]; bool pval[5];
#pragma unroll
    for (int k = 0; k < 5; ++k) {
        const int pi = tid + k * NTHR;
        bool ok = false;
        psrc[k] = scan_piece_src(p, l, b, hc, 0, pi < SC_TC * 68 ? pi : 0, ok);
        const int tau = (pi < SC_TC * 68 ? pi : 0) / 68, seg = (pi < SC_TC * 68 ? pi : 0) - tau * 68;
        ptau[k] = tau;
        pstep[k] = SC_TC * ((seg >= 24 && seg < 60) ? 576 : 2048);
        pval[k] = (pi < SC_TC * 68) && !(seg >= 60 && l == 0);
    }
    uint4 pre[5];
#pragma unroll
    for (int k = 0; k < 5; ++k) { pre[k] = make_uint4(0, 0, 0, 0); if (pval[k] && ptau[k] < TS) pre[k] = *(const uint4*)psrc[k]; }
    __syncthreads();
#pragma unroll 1
    for (int t0 = 0, ch = 0; t0 < TS; t0 += SC_TC, ++ch) {
        const int nval = (TS - t0 < SC_TC) ? (TS - t0) : SC_TC;
#pragma unroll
        for (int k = 0; k < 5; ++k) { const int pi = tid + k * NTHR; if (pi < SC_TC * 68) *(uint4*)(raw + pi * 16) = pre[k]; }
        lds_barrier();
#pragma unroll
        for (int k = 0; k < 5; ++k) {
            pre[k] = make_uint4(0, 0, 0, 0);
            if (pval[k] && t0 + SC_TC + ptau[k] < TS) pre[k] = *(const uint4*)(psrc[k] + (size_t)(ch + 1) * pstep[k]);
        }
        {
            float* pwb = prevb + (ch & 1) * 192;
            const float* pvb = prevb + ((ch + 1) & 1) * 192;
            for (int it = tid; it < SC_TC * 96; it += NTHR) {
                const int tau = it / 96, c2 = (it - tau * 96) * 2;
                const unsigned cu = *(const unsigned*)(raw + tau * SC_ROWB + c2 * 2);
                const float c0 = __uint_as_float(cu << 16), c1 = __uint_as_float(cu & 0xFFFF0000u);
                float p0, p1;
                if (tau > 0) { const unsigned pu = *(const unsigned*)(raw + (tau - 1) * SC_ROWB + c2 * 2); p0 = __uint_as_float(pu << 16); p1 = __uint_as_float(pu & 0xFFFF0000u); }
                else if (t0 > 0) { p0 = pvb[c2]; p1 = pvb[c2 + 1]; }
                else { p0 = 0.f; p1 = 0.f; }
                if (tau == SC_TC - 1) { pwb[c2] = c0; pwb[c2 + 1] = c1; }
                const float x0 = c0 + (p0 - c0) * cst[c2], x1 = c1 + (p1 - c1) * cst[c2 + 1];
                float* dstv = (c2 < 64) ? (s_r + tau * 64 + c2) : (c2 < 128) ? (s_k + tau * 64 + c2 - 64) : (s_v + tau * 64 + c2 - 128);
                *(float2*)dstv = make_float2(x0, x1);
            }
        }
        if (mm < 3 || l > 0) {
            const unsigned char* Ab = raw + ((mm == 0) ? 384 : (mm == 1) ? 512 : (mm == 2) ? 640 : 896);
            float* dst = (mm == 0) ? s_w : (mm == 1) ? s_a : (mm == 2) ? s_g : s_o;
#pragma unroll
            for (int m = 0; m < 2; ++m) {
                f32x4 acc0 = {0.f, 0.f, 0.f, 0.f}, acc1 = {0.f, 0.f, 0.f, 0.f};
#pragma unroll
                for (int ks = 0; ks < 4; ++ks) {
                    if (ks < nks) {
                        const bf16x8 a = *(const bf16x8*)(Ab + (m * 16 + fr) * SC_ROWB + ks * 64 + fq * 16);
                        acc0 = __builtin_amdgcn_mfma_f32_16x16x32_bf16(a, Bw[0][ks], acc0, 0, 0, 0);
                        acc1 = __builtin_amdgcn_mfma_f32_16x16x32_bf16(a, Bw[1][ks], acc1, 0, 0, 0);
                    }
                }
                if (mm == 0) {
                    const float cw0 = cst[480 + ntb * 16 + fr], cw1 = cst[480 + (ntb + 1) * 16 + fr];
                    f32x4 l0, l1, r0, r1;
#pragma unroll
                    for (int j = 0; j < 4; ++j) { l0[j] = -0.6065306597126334f * fast_sigmoid(acc0[j] + cw0); l1[j] = -0.6065306597126334f * fast_sigmoid(acc1[j] + cw1); }
                    const uint2 h0 = pack4(l0[0], l0[1], l0[2], l0[3]), h1 = pack4(l1[0], l1[1], l1[2], l1[3]);
                    r0[0] = l0[0] - __uint_as_float(h0.x << 16); r0[1] = l0[1] - __uint_as_float(h0.x & 0xFFFF0000u); r0[2] = l0[2] - __uint_as_float(h0.y << 16); r0[3] = l0[3] - __uint_as_float(h0.y & 0xFFFF0000u);
                    r1[0] = l1[0] - __uint_as_float(h1.x << 16); r1[1] = l1[1] - __uint_as_float(h1.x & 0xFFFF0000u); r1[2] = l1[2] - __uint_as_float(h1.y << 16); r1[3] = l1[3] - __uint_as_float(h1.y & 0xFFFF0000u);
                    sh4 hh0, hh1; __builtin_memcpy(&hh0, &h0, 8); __builtin_memcpy(&hh1, &h1, 8);
                    f32x4 c0 = MF16(Lf, pk4v(r0), z4), c1 = MF16(Lf, pk4v(r1), z4);
                    c0 = MF16(Lf, hh0, c0); c1 = MF16(Lf, hh1, c1);
#pragma unroll
                    for (int j = 0; j < 4; ++j) {
                        const int eo = (m * 16 + fq * 4 + j) * 64 + ntb * 16 + fr;
                        s_w[eo] = c0[j]; s_w[eo + 16] = c1[j];
                        s_b[eo] = l0[j]; s_b[eo + 16] = l1[j];
                    }
                } else {
#pragma unroll
                    for (int j = 0; j < 4; ++j) {
                        dst[(m * 16 + fq * 4 + j) * 64 + ntb * 16 + fr] = acc0[j];
                        dst[(m * 16 + fq * 4 + j) * 64 + (ntb + 1) * 16 + fr] = acc1[j];
                    }
                }
            }
        }
        lds_barrier();
        {
            const int tau = tid >> 4, c4 = (tid & 15) * 4, e = tau * 64 + c4, t = t0 + tau;
            const size_t n = (size_t)b * TS + t;
            const float4 cum4 = *(const float4*)(s_w + e), lw4 = *(const float4*)(s_b + e), xa4 = *(const float4*)(s_a + e), kr4 = *(const float4*)(s_k + e), rr4 = *(const float4*)(s_r + e);
            float4 vv4 = *(const float4*)(s_v + e);
            const float4 ca = *(const float4*)(cst + 544 + c4), ckk = *(const float4*)(cst + 608 + c4), cka = *(const float4*)(cst + 672 + c4);
            const float cum[4] = {cum4.x, cum4.y, cum4.z, cum4.w}, lw[4] = {lw4.x, lw4.y, lw4.z, lw4.w};
            const float xa[4] = {xa4.x + ca.x, xa4.y + ca.y, xa4.z + ca.z, xa4.w + ca.w};
            const float kr[4] = {kr4.x, kr4.y, kr4.z, kr4.w}, rr[4] = {rr4.x, rr4.y, rr4.z, rr4.w};
            const float kkc[4] = {ckk.x, ckk.y, ckk.z, ckk.w}, kac[4] = {cka.x, cka.y, cka.z, cka.w};
            float vv[4] = {vv4.x, vv4.y, vv4.z, vv4.w};
            if (l > 0) {
                const float4 xv4 = *(const float4*)(s_o + e), cv = *(const float4*)(cst + 928 + c4);
                const uint2 vfu = *(const uint2*)(raw + tau * SC_ROWB + 960 + c4 * 2);
                const float vf[4] = {__uint_as_float(vfu.x << 16), __uint_as_float(vfu.x & 0xFFFF0000u), __uint_as_float(vfu.y << 16), __uint_as_float(vfu.y & 0xFFFF0000u)};
                const float xv[4] = {xv4.x + cv.x, xv4.y + cv.y, xv4.z + cv.z, xv4.w + cv.w};
#pragma unroll
                for (int j = 0; j < 4; ++j) vv[j] = vv[j] + (vf[j] - vv[j]) * fast_sigmoid(xv[j]);
            } else if (t < TS) {
                *(uint2*)(vfirst + n * 1024 + hc + c4) = pack4(vv[0], vv[1], vv[2], vv[3]);
            }
            float av[4], kkv[4], ginc[4], gexc[4], ginv[4]; float ss = 0.f;
#pragma unroll
            for (int j = 0; j < 4; ++j) {
                ginc[j] = __expf(cum[j]); gexc[j] = __expf(cum[j] - lw[j]); ginv[j] = __expf(-cum[j]);
                av[j] = fast_sigmoid(xa[j]);
                kkv[j] = kr[j] * kkc[j];
                ss += kkv[j] * kkv[j];
            }
            ss = row16_sum(ss);
            const float rn = rsqrtf(fmaxf(ss, 1e-24f));
            float kk[4], kt[4];
#pragma unroll
            for (int j = 0; j < 4; ++j) { kk[j] = kkv[j] * rn; kt[j] = kr[j] * (1.0f + (av[j] - 1.0f) * kac[j]); }
            const uint2 pa = pack4(-kk[0] * gexc[0], -kk[1] * gexc[1], -kk[2] * gexc[2], -kk[3] * gexc[3]);
            const uint2 pr = pack4(rr[0] * ginc[0], rr[1] * ginc[1], rr[2] * ginc[2], rr[3] * ginc[3]);
            const uint2 pb = pack4(kk[0] * av[0] * ginv[0], kk[1] * av[1] * ginv[1], kk[2] * av[2] * ginv[2], kk[3] * av[3] * ginv[3]);
            const uint2 pk = pack4(kt[0] * ginv[0], kt[1] * ginv[1], kt[2] * ginv[2], kt[3] * ginv[3]);
            const uint2 pv = pack4(vv[0], vv[1], vv[2], vv[3]);
            *(uint2*)(o_at + tau * SC_LT + c4) = pa;
            *(uint2*)(o_rt + tau * SC_LT + c4) = pr;
            *(uint2*)(o_bt + tau * SC_LT + c4) = pb;
            *(uint2*)(o_kt + tau * SC_LT + c4) = pk;
            o_bT[(c4 + 0) * SC_LS + tau] = (bf16_t)(pb.x & 0xFFFFu); o_bT[(c4 + 1) * SC_LS + tau] = (bf16_t)(pb.x >> 16); o_bT[(c4 + 2) * SC_LS + tau] = (bf16_t)(pb.y & 0xFFFFu); o_bT[(c4 + 3) * SC_LS + tau] = (bf16_t)(pb.y >> 16);
            o_kT[(c4 + 0) * SC_LS + tau] = (bf16_t)(pk.x & 0xFFFFu); o_kT[(c4 + 1) * SC_LS + tau] = (bf16_t)(pk.x >> 16); o_kT[(c4 + 2) * SC_LS + tau] = (bf16_t)(pk.y & 0xFFFFu); o_kT[(c4 + 3) * SC_LS + tau] = (bf16_t)(pk.y >> 16);
            o_vT[(c4 + 0) * SC_LS + tau] = (bf16_t)(pv.x & 0xFFFFu); o_vT[(c4 + 1) * SC_LS + tau] = (bf16_t)(pv.x >> 16); o_vT[(c4 + 2) * SC_LS + tau] = (bf16_t)(pv.y & 0xFFFFu); o_vT[(c4 + 3) * SC_LS + tau] = (bf16_t)(pv.y >> 16);
            if ((tau & 15) == 15) *(float4*)(s_gc + (tau >> 4) * 64 + c4) = make_float4(ginc[0], ginc[1], ginc[2], ginc[3]);
            *(float4*)(s_k + e) = make_float4(kt[0], kt[1], kt[2], kt[3]);
            *(float4*)(s_v + e) = make_float4(vv[0], vv[1], vv[2], vv[3]);
        }
        lds_barrier();
        if (wid < 4) {
#pragma unroll
            for (int sc = 0; sc < 2; ++sc) {
                if (sc * 16 < nval) {
                    const bf16_t* ar = o_at + (sc * 16 + fr) * SC_LT;
                    const bf16_t* rr_ = o_rt + (sc * 16 + fr) * SC_LT;
                    const bf16_t* br = o_bt + (sc * 16 + fr) * SC_LT;
                    const bf16_t* kr_ = o_kt + (sc * 16 + fr) * SC_LT;
                    const bf16x8 fa0 = *(const bf16x8*)(ar + fq * 8), fa1 = *(const bf16x8*)(ar + 32 + fq * 8);
                    const bf16x8 fb0 = *(const bf16x8*)(br + fq * 8), fb1 = *(const bf16x8*)(br + 32 + fq * 8);
                    const bf16x8 fk0 = *(const bf16x8*)(kr_ + fq * 8), fk1 = *(const bf16x8*)(kr_ + 32 + fq * 8);
                    const bf16x8 fr0 = *(const bf16x8*)(rr_ + fq * 8), fr1 = *(const bf16x8*)(rr_ + 32 + fq * 8);
                    f32x4 nA = MF32(fb0, fa0, z4); nA = MF32(fb1, fa1, nA);
                    f32x4 nB = MF32(fa0, fb0, z4); nB = MF32(fa1, fb1, nB);
                    f32x4 mak = MF32(fk0, fa0, z4); mak = MF32(fk1, fa1, mak);
                    f32x4 mbr = MF32(fb0, fr0, z4); mbr = MF32(fb1, fr1, mbr);
                    f32x4 mkr = MF32(fk0, fr0, z4); mkr = MF32(fk1, fr1, mkr);
#pragma unroll
                    for (int j = 0; j < 4; ++j) {
                        const int s_ = fq * 4 + j;
                        nA[j] = (s_ < fr) ? nA[j] : 0.f; nB[j] = (fr < s_) ? nB[j] : 0.f; mak[j] = (s_ < fr) ? mak[j] : 0.f;
                        mbr[j] = (s_ <= fr) ? mbr[j] : 0.f; mkr[j] = (s_ <= fr) ? mkr[j] : 0.f;
                    }
                    const sh4 pNA = pk4v(nA), pNB = pk4v(nB), pMak = pk4v(mak), pMbr = pk4v(mbr), pMkr = pk4v(mkr);
                    const f32x4 n2B = MF16(pNA, pNB, z4), n2A = MF16(pNB, pNA, z4);
                    const sh4 pN2A = pk4v(n2A), pN2B = pk4v(n2B);
                    const f32x4 n4B = MF16(pN2A, pN2B, z4), n4A = MF16(pN2B, pN2A, z4);
                    const sh4 pN4A = pk4v(n4A), pN4B = pk4v(n4B);
                    const sh4 pN8A = pk4v(MF16(pN4B, pN4A, z4));
                    const bf16x8 sB0 = cat8(pk4v(S[0]), pk4v(S[1])), sB1 = cat8(pk4v(S[2]), pk4v(S[3]));
                    const sh4 vf = *(const sh4*)(o_vT + (wid * 16 + fr) * SC_LS + sc * 16 + fq * 4);
                    f32x4 X = MF32(cat8(*(const sh4*)(ar + fq * 4), *(const sh4*)(ar + 16 + fq * 4)), sB0, z4);
                    X = MF32(cat8(*(const sh4*)(ar + 32 + fq * 4), *(const sh4*)(ar + 48 + fq * 4)), sB1, X);
                    X = MF16(pMak, vf, X);
                    X = MF16(pN8A, pk4v(X), X); X = MF16(pN4A, pk4v(X), X); X = MF16(pN2A, pk4v(X), X); X = MF16(pNA, pk4v(X), X);
                    const sh4 pSA = pk4v(X);
                    f32x4 O = MF32(cat8(*(const sh4*)(rr_ + fq * 4), *(const sh4*)(rr_ + 16 + fq * 4)), sB0, z4);
                    O = MF32(cat8(*(const sh4*)(rr_ + 32 + fq * 4), *(const sh4*)(rr_ + 48 + fq * 4)), sB1, O);
                    const bf16x8 sav = cat8(pSA, vf);
                    O = MF32(cat8(pMbr, pMkr), sav, O);
#pragma unroll
                    for (int j = 0; j < 4; ++j) s_o[(sc * 16 + fq * 4 + j) * 64 + wid * 16 + fr] = O[j];
#pragma unroll
                    for (int jt = 0; jt < 4; ++jt) {
                        const sh4 ka = *(const sh4*)(o_kT + (jt * 16 + fr) * SC_LS + sc * 16 + fq * 4), ba = *(const sh4*)(o_bT + (jt * 16 + fr) * SC_LS + sc * 16 + fq * 4);
                        f32x4 acc = MF32(cat8(ba, ka), sav, S[jt]);
                        const float4 g4 = *(const float4*)(s_gc + sc * 64 + jt * 16 + fq * 4);
                        acc[0] *= g4.x; acc[1] *= g4.y; acc[2] *= g4.z; acc[3] *= g4.w;
                        S[jt] = acc;
                    }
                }
            }
        }
        lds_barrier();
        {
            const int tau = tid >> 4, c4 = (tid & 15) * 4, e = tau * 64 + c4;
            const size_t n = (size_t)b * TS + t0 + tau;
            const float4 o4 = *(const float4*)(s_o + e), r4_ = *(const float4*)(s_r + e), k4_ = *(const float4*)(s_k + e), v4_ = *(const float4*)(s_v + e), g4_ = *(const float4*)(s_g + e);
            const float4 crk = *(const float4*)(cst + 736 + c4), clw = *(const float4*)(cst + 800 + c4), clb = *(const float4*)(cst + 864 + c4);
            float osum = (o4.x + o4.y) + (o4.z + o4.w);
            float bsum = r4_.x * k4_.x * crk.x + r4_.y * k4_.y * crk.y + r4_.z * k4_.z * crk.z + r4_.w * k4_.w * crk.w;
            float du0 = 0.f, du1 = 0.f;
            row16_sum4(osum, bsum, du0, du1);
            const float m_ = osum * (1.0f / 64.0f);
            const float d0 = o4.x - m_, d1 = o4.y - m_, d2 = o4.z - m_, d3 = o4.w - m_;
            const float var = row16_sum(d0 * d0 + d1 * d1 + d2 * d2 + d3 * d3) * (1.0f / 64.0f);
            const float rs = rsqrtf(var + 64e-5f);
            const float y0 = (d0 * rs * clw.x + clb.x + bsum * v4_.x) * g4_.x, y1 = (d1 * rs * clw.y + clb.y + bsum * v4_.y) * g4_.y;
            const float y2 = (d2 * rs * clw.z + clb.z + bsum * v4_.z) * g4_.z, y3 = (d3 * rs * clw.w + clb.w + bsum * v4_.w) * g4_.w;
            if (tau < nval) *(uint2*)(Pr + n * 1024 + hc + c4) = pack4(y0, y1, y2, y3);
        }
    }
}

__device__ __forceinline__ void xcd_panel_map(int& mt0, int& mstep, int& nt) {
    const int b = obid(), G = (int)gridDim.x;
    if (G == 256) { nt = (b >> 3) & 7; mt0 = (b & 7) * 4 + (b >> 6); mstep = 32; }
    else { nt = b & 7; mt0 = b >> 3; mstep = G >> 3; }
}
__device__ void phase_merge(const Params& p, unsigned char* lds) {
    const int tid = otid(), lane = tid & 63, wid = tid >> 6, wr = wid >> 1, wc = wid & 1, fr = lane & 15, fq = lane >> 4;
    const bf16_t* h = (const bf16_t*)(WS(p) + OFF_H);
    const bf16_t* wb = (const bf16_t*)(WS(p) + OFF_WB);
    const float* rstd = (const float*)(WS(p) + OFF_RSTD);
    bf16_t* merged = (bf16_t*)(WS(p) + OFF_MERGED);
    const bf16_t* ysrc0 = (const bf16_t*)(WS(p) + OFF_PPOOL);
    const bf16_t* ysrc1 = (const bf16_t*)(WS(p) + OFF_PR);
    const bf16_t* ysrc2 = (const bf16_t*)(OUTB(p) + DO_YC);
    for (int tile = obid(); tile < 86 * 8; tile += gridDim.x) {
        const int mt = tile >> 3, nt = tile & 7;
        const int row0 = mt * 192, col0 = nt * 128;
        uint2 maccp[3][4];
#pragma unroll
        for (int m = 0; m < 3; ++m)
#pragma unroll
            for (int n = 0; n < 4; ++n) maccp[m][n] = make_uint2(0u, 0u);
#pragma unroll 1
        for (int i = 0; i < 3; ++i) {
            const bf16_t* ys = (i == 0) ? ysrc0 : (i == 1 ? ysrc1 : ysrc2);
            uint2 sg[3][4];
            {
                f32x4 ag[3][4]; g3_zero<3>(ag);
                G3<192> g;
                g3_setup<192>(g, [&](int r) { return h + (size_t)(row0 + r) * DM; }, [&](int r) { return wb + WB_WG + (size_t)(i * 1024 + col0 + r) * DM; }, tid);
                g3_kloop<192>(ag, g, DM, lds);
#pragma unroll
                for (int m = 0; m < 3; ++m) {
                    const float rs = rstd[row0 + wr * 48 + m * 16 + fr];
#pragma unroll
                    for (int n = 0; n < 4; ++n) sg[m][n] = pack4(fast_sigmoid(ag[m][n][0] * rs), fast_sigmoid(ag[m][n][1] * rs), fast_sigmoid(ag[m][n][2] * rs), fast_sigmoid(ag[m][n][3] * rs));
                }
            }
            {
                f32x4 ay[3][4]; g3_zero<3>(ay);
                G3<192> g;
                g3_setup<192>(g, [&](int r) { return ys + (size_t)(row0 + r) * DM; }, [&](int r) { return wb + WB_PA + (size_t)(i * 1024 + col0 + r) * DM; }, tid);
                g3_kloop<192>(ay, g, DM, lds);
#pragma unroll
                for (int m = 0; m < 3; ++m)
#pragma unroll
                    for (int n = 0; n < 4; ++n) {
                        const float m0 = __uint_as_float(maccp[m][n].x << 16) + __uint_as_float(sg[m][n].x << 16) * ay[m][n][0];
                        const float m1 = __uint_as_float(maccp[m][n].x & 0xFFFF0000u) + __uint_as_float(sg[m][n].x & 0xFFFF0000u) * ay[m][n][1];
                        const float m2 = __uint_as_float(maccp[m][n].y << 16) + __uint_as_float(sg[m][n].y << 16) * ay[m][n][2];
                        const float m3 = __uint_as_float(maccp[m][n].y & 0xFFFF0000u) + __uint_as_float(sg[m][n].y & 0xFFFF0000u) * ay[m][n][3];
                        maccp[m][n] = pack4(m0, m1, m2, m3);
                    }
            }
        }
#pragma unroll
        for (int m = 0; m < 3; ++m) {
            const int row = row0 + wr * 48 + m * 16 + fr;
#pragma unroll
            for (int n = 0; n < 4; ++n)
                *(uint2*)(merged + (size_t)row * 1024 + col0 + wc * 64 + n * 16 + fq * 4) = maccp[m][n];
        }
    }
}

__device__ void phase_outproj(const Params& p, unsigned char* lds) {
    const int tid = otid(), lane = tid & 63, wid = tid >> 6, wr = wid >> 1, wc = wid & 1, fr = lane & 15, fq = lane >> 4;
    const bf16_t* h = (const bf16_t*)(WS(p) + OFF_H);
    const bf16_t* wb = (const bf16_t*)(WS(p) + OFF_WB);
    const bf16_t* merged = (const bf16_t*)(WS(p) + OFF_MERGED);
    float* hm = (float*)(WS(p) + OFF_HM32);
    int mt0, mstep, nt;
    xcd_panel_map(mt0, mstep, nt);
    for (int mt = mt0; mt < 86; mt += mstep) {
        const int row0 = mt * 192, col0 = nt * 128;
        G3<192> g;
        g3_setup<192>(g, [&](int r) { return merged + (size_t)(row0 + r) * DM; }, [&](int r) { return wb + WB_WO + (size_t)(col0 + r) * DM; }, tid);
        f32x4 acc[3][4]; g3_zero<3>(acc);
        g3_kloop<192>(acc, g, DM, lds);
#pragma unroll
        for (int m = 0; m < 3; ++m) {
            const int row = row0 + wr * 48 + m * 16 + fr;
#pragma unroll
            for (int n = 0; n < 4; ++n) {
                const int col = col0 + wc * 64 + n * 16 + fq * 4;
                const uint2 hv = *(const uint2*)(h + (size_t)row * 1024 + col);
                float4 o;
                o.x = __uint_as_float(hv.x << 16) + acc[m][n][0]; o.y = __uint_as_float(hv.x & 0xFFFF0000u) + acc[m][n][1];
                o.z = __uint_as_float(hv.y << 16) + acc[m][n][2]; o.w = __uint_as_float(hv.y & 0xFFFF0000u) + acc[m][n][3];
                *(float4*)(hm + (size_t)row * 1024 + col) = o;
            }
        }
    }
}

__device__ __constant__ int c_pair_lo[6] = {0, 0, 0, 1, 1, 2};
__device__ __constant__ int c_pair_hi[6] = {1, 2, 3, 2, 3, 3};
__device__ void phase_route(const Params& p, int l, unsigned char* lds) {
    const int tid = otid(), lane = tid & 63, wid = tid >> 6;
    const int per = (NT + (int)gridDim.x - 1) / (int)gridDim.x;
    const int nbeg = obid() * per, nend = (nbeg + per < NT) ? nbeg + per : NT;
    int* s_cls = (int*)lds;
    int* s_base = s_cls + 512;
    float* s_wr = (float*)(lds + 4096);
    const float* hm = (const float*)(WS(p) + OFF_HM32);
    bf16_t* hn = (bf16_t*)(WS(p) + OFF_HN);
    const float* nf = p.in[33] + (size_t)l * 1024;
    const float* wg = p.in[34] + (size_t)l * 1024 * 4;
    const float* bg = p.in[35] + l * 4;
    const float* we = p.in[36] + (size_t)l * 1024 * 16;
    const float* be = p.in[37] + l * 16;
    int* cnt = (int*)(WS(p) + OFF_CTL);
    int* list = (int*)(WS(p) + OFF_LIST);
    float* pw = (float*)(WS(p) + OFF_PW);
    for (int e = tid; e < 1024 * 20; e += NTHR) {
        const int k = e / 20, c = e - k * 20;
        s_wr[c * 1024 + k] = (c < 4) ? wg[(size_t)k * 4 + c] : we[(size_t)k * 16 + (c - 4)];
    }
    __syncthreads();
    for (int n = nbeg + wid; n < nend; n += 8) {
        float ss = 0.f;
#pragma unroll
        for (int i = 0; i < 4; ++i) {
            const float4 v = *(const float4*)(hm + (size_t)n * DM + i * 256 + lane * 4);
            ss += v.x * v.x + v.y * v.y + v.z * v.z + v.w * v.w;
        }
        ss = wave_sum(ss);
        const float rs = rsqrtf(ss * (1.0f / 1024.0f) + 1e-6f);
        float lg[4] = {0.f, 0.f, 0.f, 0.f};
        float le[16];
#pragma unroll
        for (int e = 0; e < 16; ++e) le[e] = 0.f;
#pragma unroll 1
        for (int i = 0; i < 4; ++i) {
            const float4 xv = *(const float4*)(hm + (size_t)n * DM + i * 256 + lane * 4);
            const float4 nv = *(const float4*)(nf + i * 256 + lane * 4);
            float y[4] = {xv.x * rs * nv.x, xv.y * rs * nv.y, xv.z * rs * nv.z, xv.w * rs * nv.w};
            {
                const int d0 = i * 256 + lane * 4;
#pragma unroll
                for (int g = 0; g < 4; ++g) { const float4 w4 = *(const float4*)(s_wr + g * 1024 + d0); lg[g] += y[0] * w4.x + y[1] * w4.y + y[2] * w4.z + y[3] * w4.w; }
#pragma unroll
                for (int e = 0; e < 16; ++e) { const float4 w4 = *(const float4*)(s_wr + (4 + e) * 1024 + d0); le[e] += y[0] * w4.x + y[1] * w4.y + y[2] * w4.z + y[3] * w4.w; }
            }
            *(uint2*)(hn + (size_t)n * DM + i * 256 + lane * 4) = pack4(y[0], y[1], y[2], y[3]);
        }
#pragma unroll
        for (int g = 0; g < 4; ++g) lg[g] = wave_sum_fast(lg[g]) + bg[g];
#pragma unroll
        for (int e = 0; e < 16; ++e) le[e] = wave_sum_fast(le[e]) + be[e];
        if (lane == 0) {
            int gs = 0; float gm = lg[0];
#pragma unroll
            for (int g = 1; g < 4; ++g) if (lg[g] > gm) { gm = lg[g]; gs = g; }
            float den = 0.f;
#pragma unroll
            for (int g = 0; g < 4; ++g) den += __expf(lg[g] - gm);
            const float pgrp = 1.0f / den;
            float v4[4];
#pragma unroll
            for (int e = 0; e < 4; ++e) {
                const float m0 = (gs == 0) ? 1.f : 0.f, m1s = (gs == 1) ? 1.f : 0.f, m2s = (gs == 2) ? 1.f : 0.f, m3s = (gs == 3) ? 1.f : 0.f;
                v4[e] = le[e] * m0 + le[4 + e] * m1s + le[8 + e] * m2s + le[12 + e] * m3s;
            }
            int i1 = 0; float m1 = v4[0];
#pragma unroll
            for (int e = 1; e < 4; ++e) if (v4[e] > m1) { m1 = v4[e]; i1 = e; }
            int i2 = -1; float m2 = -INFINITY;
#pragma unroll
            for (int e = 0; e < 4; ++e) if (e != i1 && v4[e] > m2) { m2 = v4[e]; i2 = e; }
            const float e2 = __expf(m2 - m1);
            const float p1 = pgrp / (1.0f + e2), p2 = pgrp * e2 / (1.0f + e2);
            const int lo = i1 < i2 ? i1 : i2, hi = i1 < i2 ? i2 : i1;
            const float plo = i1 < i2 ? p1 : p2, phi = i1 < i2 ? p2 : p1;
            const int pi = (lo == 0) ? (hi - 1) : (lo == 1 ? hi + 1 : 5);
            const int cls = gs * 6 + pi;
            s_cls[n - nbeg] = cls;
            pw[(size_t)n * 2 + 0] = plo; pw[(size_t)n * 2 + 1] = phi;
        }
    }
    __syncthreads();
    const int nloc = nend - nbeg;
    if (tid < 24) {
        int c_ = 0;
        for (int i = 0; i < nloc; ++i) c_ += (s_cls[i] == tid) ? 1 : 0;
        s_base[tid] = c_ ? atomicAdd(&cnt[tid * 32], c_) : 0;
    }
    __syncthreads();
    for (int it = tid; it < nloc; it += NTHR) {
        const int cls = s_cls[it];
        int rank = 0;
        for (int i = 0; i < it; ++i) rank += (s_cls[i] == cls) ? 1 : 0;
        list[(size_t)cls * NT + s_base[cls] + rank] = nbeg + it;
    }
    __syncthreads();
}


struct MoeTile { int cls, ti, cnt, tg; };
__device__ __forceinline__ int moe_total_tiles(const int* cnt) { int s = 0; for (int c = 0; c < 24; ++c) s += (cnt[c * 32] + 127) >> 7; return s; }
__device__ __forceinline__ MoeTile moe_find(const int* cnt, int tile) {
    MoeTile r; int s = 0; r.cls = 0; r.ti = 0; r.cnt = 0; r.tg = tile;
    for (int c = 0; c < 24; ++c) { const int nt = (cnt[c * 32] + 127) >> 7; if (tile >= s && tile < s + nt) { r.cls = c; r.ti = tile - s; r.cnt = cnt[c * 32]; } s += nt; }
    return r;
}
__device__ void phase_moe1(const Params& p, unsigned char* lds) {
    const int tid = otid(), lane = tid & 63, wid = tid >> 6, wr = wid >> 1, wc = wid & 1, fr = lane & 15, fq = lane >> 4;
    const int* cnt = (const int*)(WS(p) + OFF_CTL);
    const int* list = (const int*)(WS(p) + OFF_LIST);
    const float* pw = (const float*)(WS(p) + OFF_PW);
    const bf16_t* hn = (const bf16_t*)(WS(p) + OFF_HN);
    const bf16_t* we = (const bf16_t*)(WS(p) + OFF_WEXP);
    bf16_t* hid = (bf16_t*)(OUTB(p) + DO_HID);
    const int total = moe_total_tiles(cnt);
    for (int item = obid(); item < total * 4; item += gridDim.x) {
        const MoeTile mt = moe_find(cnt, item >> 2);
        const int nt = item & 3, slot = nt >> 1, f0 = (nt & 1) * 128;
        const int g_ = mt.cls / 6, pi = mt.cls % 6;
        const int e = g_ * 4 + (slot == 0 ? c_pair_lo[pi] : c_pair_hi[pi]);
        const int* lst = list + (size_t)mt.cls * NT + mt.ti * 128;
        const int nvalid = min(128, mt.cnt - mt.ti * 128);
        f32x4 a1[2][4], a3[2][4]; g3_zero<2>(a1); g3_zero<2>(a3);
        G3D g;
#pragma unroll
        for (int i = 0; i < 2; ++i) {
            const int idx = tid + i * NTHR, row = idx >> 3, sl = (idx & 7) ^ (row & 7);
            g.ap[i] = hn + (size_t)lst[row < nvalid ? row : 0] * DM + sl * 8;
            g.b1[i] = we + WE_W1 + ((size_t)e * 256 + f0 + row) * 1024 + sl * 8;
            g.b3[i] = we + WE_W3 + ((size_t)e * 256 + f0 + row) * 1024 + sl * 8;
        }
        g3d_kloop(a1, a3, g, DM, lds);
#pragma unroll
        for (int m = 0; m < 2; ++m) {
            const int lr = wr * 32 + m * 16 + fr;
            const int tk = lst[lr < nvalid ? lr : 0];
            const float pe = pw[(size_t)tk * 2 + slot];
#pragma unroll
            for (int n = 0; n < 4; ++n) {
                const int col = slot * 256 + f0 + wc * 64 + n * 16 + fq * 4;
                float o[4];
#pragma unroll
                for (int j = 0; j < 4; ++j) { const float x1 = a1[m][n][j]; o[j] = x1 * sigmoidf_(x1) * a3[m][n][j] * pe; }
                *(uint2*)(hid + ((size_t)mt.tg * 128 + lr) * 512 + col) = pack4(o[0], o[1], o[2], o[3]);
            }
        }
    }
}
__device__ void phase_moe2(const Params& p, unsigned char* lds) {
    const int tid = otid(), lane = tid & 63, wid = tid >> 6, wr = wid >> 1, wc = wid & 1, fr = lane & 15, fq = lane >> 4;
    const int* cnt = (const int*)(WS(p) + OFF_CTL);
    const int* list = (const int*)(WS(p) + OFF_LIST);
    const bf16_t* we = (const bf16_t*)(WS(p) + OFF_WEXP);
    const bf16_t* hid = (const bf16_t*)(OUTB(p) + DO_HID);
    float* hm = (float*)(WS(p) + OFF_HM32);
    bf16_t* h = (bf16_t*)(WS(p) + OFF_H);
    const int total = moe_total_tiles(cnt);
    for (int item = obid(); item < total * 8; item += gridDim.x) {
        const MoeTile mt = moe_find(cnt, item >> 3);
        const int nt = item & 7, col0 = nt * 128;
        const int g_ = mt.cls / 6, pi = mt.cls % 6;
        const int elo = g_ * 4 + c_pair_lo[pi], ehi = g_ * 4 + c_pair_hi[pi];
        const int* lst = list + (size_t)mt.cls * NT + mt.ti * 128;
        const int nvalid = min(128, mt.cnt - mt.ti * 128);
        f32x4 acc[2][4]; g3_zero<2>(acc);
        G3<128> g;
        g3_setup<128>(g, [&](int r) { return hid + ((size_t)mt.tg * 128 + r) * 512; }, [&](int r) { return we + WE_W2 + ((size_t)elo * 1024 + col0 + r) * 256; }, tid);
        g3_kloop<128>(acc, g, 256, lds);
        g3_setup<128>(g, [&](int r) { return hid + ((size_t)mt.tg * 128 + r) * 512 + 256; }, [&](int r) { return we + WE_W2 + ((size_t)ehi * 1024 + col0 + r) * 256; }, tid);
        g3_kloop<128>(acc, g, 256, lds);
#pragma unroll
        for (int m = 0; m < 2; ++m) {
            const int lr = wr * 32 + m * 16 + fr;
            if (lr < nvalid) {
                const int tk = lst[lr];
#pragma unroll
                for (int n = 0; n < 4; ++n) {
                    const int col = col0 + wc * 64 + n * 16 + fq * 4;
                    float4 v = *(const float4*)(hm + (size_t)tk * 1024 + col);
                    v.x += acc[m][n][0]; v.y += acc[m][n][1]; v.z += acc[m][n][2]; v.w += acc[m][n][3];
                    *(float4*)(hm + (size_t)tk * 1024 + col) = v;
                    *(uint2*)(h + (size_t)tk * 1024 + col) = pack4(v.x, v.y, v.z, v.w);
                }
            }
        }
    }
}

__device__ void phase_final(const Params& p) {
    const int lane = otid() & 63;
    const int wave = (obid() * NTHR + otid()) >> 6, nw = gridDim.x * NTHR / 64;
    const float* hm = (const float*)(WS(p) + OFF_HM32);
    const float* nf = p.in[41];
    for (int r = wave; r < NB * SEQ; r += nw) {
        const int b = r / SEQ, s = r % SEQ;
        const size_t n = (size_t)b * TS + NMETA + s;
        float4 v[4]; float ss = 0.f;
#pragma unroll
        for (int i = 0; i < 4; ++i) { v[i] = *(const float4*)(hm + n * DM + i * 256 + lane * 4); ss += v[i].x * v[i].x + v[i].y * v[i].y + v[i].z * v[i].z + v[i].w * v[i].w; }
        ss = wave_sum(ss);
        const float rs = rsqrtf(ss * (1.0f / 1024.0f) + 1e-6f);
#pragma unroll
        for (int i = 0; i < 4; ++i) {
            const float4 g = *(const float4*)(nf + i * 256 + lane * 4);
            float4 o; o.x = v[i].x * rs * g.x; o.y = v[i].y * rs * g.y; o.z = v[i].z * rs * g.z; o.w = v[i].w * rs * g.w;
            *(float4*)((float*)OUTB(p) + (size_t)r * DM + i * 256 + lane * 4) = o;
        }
    }
}


#define XB_TMO      128
#define XB_XCNT(j)  (256  + 64 * (j))
#define XB_XSUB(j)  (1280 + 64 * (j))
#define XB_XGEN(j)  (2304 + 64 * (j))
#define XB_TOP      3328
#define XB_TOPGEN   3392
#define XCD_BAR_WORDS 3456
#define XB_SPIN_CAP (1u << 22)
#define LAS __attribute__((address_space(3)))
__device__ __forceinline__ unsigned xb_ld(unsigned* p) { return __hip_atomic_load(p, __ATOMIC_RELAXED, __HIP_MEMORY_SCOPE_AGENT); }
__device__ __forceinline__ unsigned xb_add(unsigned* p, unsigned v) { return __hip_atomic_fetch_add(p, v, __ATOMIC_RELAXED, __HIP_MEMORY_SCOPE_AGENT); }
__device__ __forceinline__ unsigned xb_xcc_id() { return (unsigned)__builtin_amdgcn_s_getreg((3 << 11) | 20) & 0xFu; }
#define XB_SPIN(cond, bar) do { unsigned _sp = 0; while (cond) { __builtin_amdgcn_s_sleep(1); \
    if ((++_sp & 255u) == 0u) { if (xb_ld(&(bar)[XB_TMO])) break; if (_sp > XB_SPIN_CAP) { atomicAdd(&(bar)[XB_TMO], 1u); break; } } } } while (0)
struct XcdBarrier { unsigned* bar; unsigned x; volatile LAS unsigned* st; };
__device__ __forceinline__ XcdBarrier xcd_barrier_post(unsigned* bar, volatile LAS unsigned* st) {
    XcdBarrier b; b.bar = bar; b.x = xb_xcc_id(); b.st = st;
    if (threadIdx.x == 0) (void)xb_add(&bar[XB_XCNT(b.x)], 1u);
    return b;
}
__device__ __forceinline__ void xcd_barrier_complete(unsigned* bar, unsigned x, unsigned& nloc, unsigned& nx) {
    const unsigned G = gridDim.x * gridDim.y * gridDim.z;
    unsigned sum, cnt, mine, sp = 0u;
    for (;;) {
        sum = 0u; cnt = 0u; mine = 0u;
#pragma unroll
        for (unsigned j = 0; j < 16; ++j) { const unsigned c = xb_ld(&bar[XB_XCNT(j)]); sum += c; cnt += (c > 0u) ? 1u : 0u; mine = (j == x) ? c : mine; }
        if (sum == G) break;
        __builtin_amdgcn_s_sleep(1);
        if ((++sp & 255u) == 0u) { if (xb_ld(&bar[XB_TMO])) break; if (sp > XB_SPIN_CAP) { atomicAdd(&bar[XB_TMO], 1u); break; } }
    }
    nloc = mine > 0u ? mine : 1u; nx = cnt > 0u ? cnt : 1u;
}
__device__ __forceinline__ void xcd_barrier(const XcdBarrier& b) {
    asm volatile("s_waitcnt vmcnt(0)" ::: "memory");
    __syncthreads();
    if (threadIdx.x == 0) {
        unsigned* bar = b.bar;
        __builtin_amdgcn_s_waitcnt(0);
        unsigned nloc = b.st[0], nx = b.st[1];
        if (nloc == 0u) { xcd_barrier_complete(bar, b.x, nloc, nx); b.st[0] = nloc; b.st[1] = nx; }
        const unsigned old = xb_add(&bar[XB_XSUB(b.x)], 1u);
        const unsigned gen = old / nloc;
        if (old + 1u == (gen + 1u) * nloc) {
            __builtin_amdgcn_fence(__ATOMIC_RELEASE, "agent");
            asm volatile("s_waitcnt vmcnt(0)" ::: "memory");
            const unsigned og = xb_add(&bar[XB_TOP], 1u);
            const unsigned tg = og / nx;
            if (og + 1u == (tg + 1u) * nx) xb_add(&bar[XB_TOPGEN], 1u);
            else XB_SPIN(xb_ld(&bar[XB_TOPGEN]) == tg, bar);
            __builtin_amdgcn_fence(__ATOMIC_ACQUIRE, "agent");
            xb_add(&bar[XB_XGEN(b.x)], 1u);
            asm volatile("s_waitcnt vmcnt(0)" ::: "memory");
        } else {
            XB_SPIN(xb_ld(&bar[XB_XGEN(b.x)]) == gen, bar);
            __builtin_amdgcn_fence(__ATOMIC_ACQUIRE, "agent");
            asm volatile("s_waitcnt vmcnt(0)" ::: "memory");
        }
    }
    __syncthreads();
}

__global__ void __launch_bounds__(NTHR) fwd_megakernel(Params p) {
    extern __shared__ __attribute__((aligned(16))) unsigned char lds[];
    cg::grid_group grid = cg::this_grid();
    volatile LAS unsigned* xst = (volatile LAS unsigned*)(lds + LDS_BYTES - 32);
    if (threadIdx.x < 2) xst[threadIdx.x] = 0u;
    __syncthreads();
    const XcdBarrier xb = xcd_barrier_post((unsigned*)(p.ws + OFF_BAR), xst);
    if (p.out == nullptr) grid.sync();
#pragma unroll 1
    for (int step = 0; step < 18; ++step) {
        const int l = step >= 9 ? 1 : 0;
        const int ph = step - l * 9;
        switch (ph) {
        case 0:
            if (l == 0) phase_embed(p); else phase_rowstat(p);
            phase_convert<false>(p, l, lds);
            if (obid() == 0 && otid() < 24) ((int*)(WS(p) + OFF_CTL))[otid() * 32] = 0;
            if (obid() == 0 && otid() == 32) ((int*)(WS(p) + OFF_CTL))[800 + l * 32] = 0;
            break;
        case 1: phase_inproj(p, lds); break;
        case 2: phase_dsa_prep(p, l); phase_lr_prep(p, l); break;
        case 3: {
            if (obid() < NB * 16) phase_scan5(p, l, lds, obid());
            int* qctr = (int*)(WS(p) + OFF_CTL) + 800 + l * 32;
            int* qslot = (int*)(lds + LDS_BYTES - 16);
            for (;;) {
                __syncthreads();
                if (otid() == 0) *qslot = atomicAdd(qctr, 1);
                __syncthreads();
                const int item = *qslot;
                if (item >= 516 + NT / 16 + 3072) break;
                if (item < 516) phase_pool(p, l, lds, item, item + 1, 1);
                else if (item < 516 + NT / 16) phase_dsa<false>(p, l, lds, (bf16_t*)(OUTB(p) + DO_YC), nullptr, nullptr, item - 516, item - 515, 1);
                else {
                    const int ct = item - (516 + NT / 16);
                    const ConvJob cj = get_job_late(p, l, ct >> 10);
                    conv_tile(cj, ct & 1023, (float*)lds);
                }
            }
        } break;
        case 4: phase_merge(p, lds); break;
        case 5: phase_outproj(p, lds); break;
        case 6: phase_route(p, l, lds); break;
        case 7: phase_moe1(p, lds); break;
        default: phase_moe2(p, lds); break;
        }
        xcd_barrier(xb);
    }
    phase_final(p);
}

extern "C" void kernel_launch(void* const* d_in, const int* in_sizes, int n_in,
                              void* d_out, int out_size, void* d_ws, size_t ws_size,
                              hipStream_t stream) {
    static int grid_blocks = 0;
    if (grid_blocks == 0) {
        int dev = 0, cus = 0, per_cu = 0;
        (void)hipGetDevice(&dev);
        (void)hipDeviceGetAttribute(&cus, hipDeviceAttributeMultiprocessorCount, dev);
        (void)hipFuncSetAttribute((const void*)fwd_megakernel, hipFuncAttributeMaxDynamicSharedMemorySize, LDS_BYTES);
        (void)hipOccupancyMaxActiveBlocksPerMultiprocessor(&per_cu, fwd_megakernel, NTHR, LDS_BYTES);
        if (per_cu < 1 || cus < NB * 16 || (cus & 7) != 0 || n_in != 42 || ws_size < WS_END) { fprintf(stderr, "kernel_launch: bad config per_cu=%d n_in=%d ws=%zu need=%zu\n", per_cu, n_in, ws_size, (size_t)WS_END); grid_blocks = -1; }
        else grid_blocks = cus;
    }
    if (grid_blocks < 0) return;
    Params p{};
    for (int i = 0; i < 42; ++i) p.in[i] = (const float*)d_in[i];
    p.out = (float*)d_out;
    p.ws = (unsigned char*)d_ws;
    (void)hipMemsetAsync((unsigned char*)d_ws + OFF_BAR, 0, XCD_BAR_WORDS * 4, stream);
    void* args[] = {&p};
    hipError_t e = hipLaunchCooperativeKernel((void*)fwd_megakernel, dim3(grid_blocks), dim3(NTHR), args, LDS_BYTES, stream);
    if (e != hipSuccess) fprintf(stderr, "cooperative launch failed: %s (grid %d)\n", hipGetErrorString(e), grid_blocks);
}
```

```cpp
#include <hip/hip_runtime.h>
#include <hip/hip_cooperative_groups.h>
#include <cstdio>
#include <cstdint>
#include <type_traits>
namespace cg = cooperative_groups;

typedef unsigned short bf16_t;
typedef short bf16x8 __attribute__((ext_vector_type(8)));
typedef float f32x4 __attribute__((ext_vector_type(4)));

constexpr int NB = 8, SEQ = 2048, NMETA = 16, TS = 2064, DM = 1024;
constexpr int NT = NB * TS;
constexpr int NTP = 16640;
constexpr int NTHR = 512;
constexpr int CIN = 7912;
constexpr int NP1 = 4864;
constexpr int PM_LD = 768;
constexpr int PM_WD = 0, PM_AD = 64, PM_GD = 128, PM_VD = 256, PM_CQ = 288, PM_CKV = 544, PM_KROPE = 672, PM_KIDX = 704;
constexpr int LDS_BYTES = 157 * 1024;

constexpr size_t AL(size_t x) { return (x + 255) & ~(size_t)255; }
constexpr size_t SZ_ACT = (size_t)NTP * 1024 * 2;
constexpr size_t OFF_CTL = 0;
constexpr size_t OFF_BAR = 4096;
constexpr size_t OFF_RSTD = OFF_BAR + 16384;
constexpr size_t OFF_ROPE = OFF_RSTD + AL((size_t)NTP * 4);
constexpr size_t OFF_H = OFF_ROPE + AL((size_t)TS * 16 * 4 * 2);
constexpr size_t OFF_WB = OFF_H + SZ_ACT;
constexpr size_t WB_WIN = 0;
constexpr size_t WB_WG = WB_WIN + (size_t)NP1 * 1024;
constexpr size_t WB_PA = WB_WG + (size_t)3072 * 1024;
constexpr size_t WB_WO = WB_PA + (size_t)3 * 1024 * 1024;
constexpr size_t WB_POOL = WB_WO + (size_t)1024 * 1024;
constexpr size_t WB_QI = WB_POOL + (size_t)4 * 256 * 256;
constexpr size_t WB_UQ = WB_QI + (size_t)512 * 256;
constexpr size_t WB_UK = WB_UQ + (size_t)1536 * 256;
constexpr size_t WB_UV = WB_UK + (size_t)16 * 128 * 64;
constexpr size_t WB_WIDX = WB_UV + (size_t)16 * 64 * 128;
constexpr size_t WB_END = WB_WIDX + (size_t)64 * 1024;
constexpr size_t OFF_PPOOL = OFF_WB + AL(WB_END * 2);
constexpr size_t OFF_PK = OFF_PPOOL + SZ_ACT;
constexpr size_t OFF_PR = OFF_PK + SZ_ACT;
constexpr size_t OFF_PV = OFF_PR + SZ_ACT;
constexpr size_t OFF_PMISC = OFF_PV + SZ_ACT;
constexpr size_t OFF_VFIRST = OFF_PMISC + AL((size_t)NTP * PM_LD * 2);
constexpr size_t OFF_HALO = OFF_VFIRST + SZ_ACT;
constexpr size_t OFF_LIST = OFF_HALO + AL((size_t)130 * 16 * 1024 * 2);
constexpr size_t OFF_PW = OFF_LIST + AL((size_t)24 * NT * 4);
constexpr size_t WS_END = OFF_PW + AL((size_t)NT * 2 * 4);
constexpr size_t OFF_MERGED = OFF_PK;
constexpr size_t OFF_HM32 = OFF_PR;
constexpr size_t OFF_HN = OFF_PPOOL;
constexpr size_t OFF_WEXP = OFF_PMISC;
constexpr size_t WE_W1 = 0, WE_W3 = (size_t)16 * 256 * 1024, WE_W2 = (size_t)2 * 16 * 256 * 1024;
static_assert((size_t)3 * 16 * 256 * 1024 * 2 <= (size_t)NTP * PM_LD * 2, "expert weights must fit in Pmisc");
constexpr size_t DO_YC = 0;
constexpr size_t DO_CQN = DO_YC + SZ_ACT;
constexpr size_t DO_KV = DO_CQN + AL((size_t)NT * 256 * 2);
constexpr size_t DO_KIDX = DO_KV + AL((size_t)NT * 160 * 2);
constexpr size_t DO_WHEAD = DO_KIDX + AL((size_t)NT * 64 * 2);
constexpr size_t DO_ALR = DO_WHEAD + AL((size_t)NT * 8 * 4);
constexpr size_t DO_END = DO_ALR + AL((size_t)NT * 288 * 2);
constexpr size_t DO_HID = DO_YC;
static_assert(DO_END <= (size_t)NB * SEQ * DM * 4, "d_out scratch overflow");
static_assert((size_t)(129 + 24) * 128 * 512 * 2 <= SZ_ACT, "hid fits");
static_assert(WS_END <= 277240096ull, "workspace overflow");

struct Params {
    const float* in[42];
    float* out;
    unsigned char* ws;
};

__device__ __forceinline__ int otid() { int t = threadIdx.x; asm volatile("" : "+v"(t)); return t; }
__device__ __forceinline__ int obid() { int b = blockIdx.x; asm volatile("" : "+s"(b)); return b; }
__device__ __forceinline__ unsigned char* WS(const Params& p) { unsigned char* w = p.ws; asm volatile("" : "+s"(w)); return w; }
__device__ __forceinline__ unsigned char* OUTB(const Params& p) { unsigned char* w = (unsigned char*)p.out; asm volatile("" : "+s"(w)); return w; }
__device__ __forceinline__ float bf2f(bf16_t v) { return __uint_as_float(((unsigned)v) << 16); }
typedef float f32x2v __attribute__((ext_vector_type(2)));
typedef __bf16 bf16x2v __attribute__((ext_vector_type(2)));
__device__ __forceinline__ unsigned pk2(float a, float b) { const f32x2v v = {a, b}; const bf16x2v r = __builtin_convertvector(v, bf16x2v); unsigned u; __builtin_memcpy(&u, &r, 4); return u; }
__device__ __forceinline__ bf16_t f2bf(float f) { const __bf16 h = (__bf16)f; bf16_t u; __builtin_memcpy(&u, &h, 2); return u; }
__device__ __forceinline__ float wave_sum(float v) {
#pragma unroll
    for (int o = 32; o > 0; o >>= 1) v += __shfl_xor(v, o);
    return v;
}
template <int CTRL> __device__ __forceinline__ float dpp_f(float x) {
    return __int_as_float(__builtin_amdgcn_update_dpp(0, __float_as_int(x), CTRL, 0xF, 0xF, true));
}
__device__ __forceinline__ float row16_sum(float v) {
    v += dpp_f<0xB1>(v);
    v += dpp_f<0x4E>(v);
    v += dpp_f<0x141>(v);
    v += dpp_f<0x140>(v);
    return v;
}
__device__ __forceinline__ void lds_barrier() { asm volatile("s_waitcnt lgkmcnt(0)" ::: "memory"); __builtin_amdgcn_s_barrier(); asm volatile("" ::: "memory"); }
__device__ __forceinline__ float fast_rcp(float x) { return __builtin_amdgcn_rcpf(x); }
__device__ __forceinline__ float fast_sigmoid(float x) { return fast_rcp(1.0f + __expf(-x)); }
__device__ __forceinline__ float fast_tanh(float x) { return 1.0f - 2.0f * fast_rcp(1.0f + __expf(2.0f * x)); }
__device__ __forceinline__ void row16_sum4(float& a, float& b, float& c, float& d) {
    asm volatile(
        "s_nop 1\n\t"
        "v_add_f32_dpp %0, %0, %0 quad_perm:[1,0,3,2] row_mask:0xf bank_mask:0xf\n\t"
        "v_add_f32_dpp %1, %1, %1 quad_perm:[1,0,3,2] row_mask:0xf bank_mask:0xf\n\t"
        "v_add_f32_dpp %2, %2, %2 quad_perm:[1,0,3,2] row_mask:0xf bank_mask:0xf\n\t"
        "v_add_f32_dpp %3, %3, %3 quad_perm:[1,0,3,2] row_mask:0xf bank_mask:0xf\n\t"
        "v_add_f32_dpp %0, %0, %0 quad_perm:[2,3,0,1] row_mask:0xf bank_mask:0xf\n\t"
        "v_add_f32_dpp %1, %1, %1 quad_perm:[2,3,0,1] row_mask:0xf bank_mask:0xf\n\t"
        "v_add_f32_dpp %2, %2, %2 quad_perm:[2,3,0,1] row_mask:0xf bank_mask:0xf\n\t"
        "v_add_f32_dpp %3, %3, %3 quad_perm:[2,3,0,1] row_mask:0xf bank_mask:0xf\n\t"
        "v_add_f32_dpp %0, %0, %0 row_half_mirror row_mask:0xf bank_mask:0xf\n\t"
        "v_add_f32_dpp %1, %1, %1 row_half_mirror row_mask:0xf bank_mask:0xf\n\t"
        "v_add_f32_dpp %2, %2, %2 row_half_mirror row_mask:0xf bank_mask:0xf\n\t"
        "v_add_f32_dpp %3, %3, %3 row_half_mirror row_mask:0xf bank_mask:0xf\n\t"
        "v_add_f32_dpp %0, %0, %0 row_mirror row_mask:0xf bank_mask:0xf\n\t"
        "v_add_f32_dpp %1, %1, %1 row_mirror row_mask:0xf bank_mask:0xf\n\t"
        "v_add_f32_dpp %2, %2, %2 row_mirror row_mask:0xf bank_mask:0xf\n\t"
        "v_add_f32_dpp %3, %3, %3 row_mirror row_mask:0xf bank_mask:0xf\n\t"
        "s_nop 1"
        : "+v"(a), "+v"(b), "+v"(c), "+v"(d));
}
__device__ __forceinline__ void row8_sum2(float& a, float& b) {
    asm volatile(
        "s_nop 1\n\t"
        "v_add_f32_dpp %0, %0, %0 quad_perm:[1,0,3,2] row_mask:0xf bank_mask:0xf\n\t"
        "v_add_f32_dpp %1, %1, %1 quad_perm:[1,0,3,2] row_mask:0xf bank_mask:0xf\n\t"
        "s_nop 0\n\t"
        "v_add_f32_dpp %0, %0, %0 quad_perm:[2,3,0,1] row_mask:0xf bank_mask:0xf\n\t"
        "v_add_f32_dpp %1, %1, %1 quad_perm:[2,3,0,1] row_mask:0xf bank_mask:0xf\n\t"
        "s_nop 0\n\t"
        "v_add_f32_dpp %0, %0, %0 row_half_mirror row_mask:0xf bank_mask:0xf\n\t"
        "v_add_f32_dpp %1, %1, %1 row_half_mirror row_mask:0xf bank_mask:0xf\n\t"
        "s_nop 1"
        : "+v"(a), "+v"(b));
}
__device__ __forceinline__ float wave_sum_fast(float v) { v = row16_sum(v); v += __shfl_xor(v, 16); v += __shfl_xor(v, 32); return v; }
__device__ __forceinline__ float sigmoidf_(float x) { return 1.0f / (1.0f + __expf(-x)); }
__device__ __forceinline__ float softplusf_(float z) { return fmaxf(z, 0.f) + log1pf(__expf(-fabsf(z))); }
__device__ __forceinline__ void glds16(const void* g, void* l) {
    __builtin_amdgcn_global_load_lds((const unsigned*)g, (unsigned*)l, 16, 0, 0);
}

__device__ void phase_embed(const Params& p) {
    const int lane = otid() & 63;
    const int wave = (obid() * NTHR + otid()) >> 6, nw = gridDim.x * NTHR / 64;
    bf16_t* h = (bf16_t*)(WS(p) + OFF_H);
    float* rstd = (float*)(WS(p) + OFF_RSTD);
    for (int n = wave; n < NTP; n += nw) {
        if (n < NT) {
            const int b = n / TS, t = n % TS;
            const float* src = t < NMETA ? p.in[1] + (size_t)t * DM : p.in[0] + ((size_t)b * SEQ + (t - NMETA)) * DM;
            float ss = 0.f;
#pragma unroll
            for (int i = 0; i < 4; ++i) {
                const float4 v = *(const float4*)(src + i * 256 + lane * 4);
                ss += v.x * v.x + v.y * v.y + v.z * v.z + v.w * v.w;
                const uint2 o = make_uint2(pk2(v.x, v.y), pk2(v.z, v.w));
                *(uint2*)(h + (size_t)n * DM + i * 256 + lane * 4) = o;
            }
            ss = wave_sum(ss);
            if (lane == 0) rstd[n] = rsqrtf(ss * (1.0f / 1024.0f) + 1e-6f);
        } else {
#pragma unroll
            for (int i = 0; i < 4; ++i) *(ushort4*)(h + (size_t)n * DM + i * 256 + lane * 4) = make_ushort4(0, 0, 0, 0);
            if (lane == 0) rstd[n] = 0.f;
        }
    }
    float* ctab = (float*)(WS(p) + OFF_ROPE);
    float* stab = ctab + TS * 16;
    for (int idx = obid() * NTHR + otid(); idx < TS * 16; idx += gridDim.x * NTHR) {
        const int t = idx >> 4, i = idx & 15;
        const float inv = powf(10000.0f, -(float)(2 * i) / 32.0f);
        const float ang = (float)t * inv;
        ctab[idx] = cosf(ang);
        stab[idx] = sinf(ang);
    }
}

__device__ void phase_rowstat(const Params& p) {
    const int lane = otid() & 63;
    const int wave = (obid() * NTHR + otid()) >> 6, nw = gridDim.x * NTHR / 64;
    const float* hm = (const float*)(WS(p) + OFF_HM32);
    float* rstd = (float*)(WS(p) + OFF_RSTD);
    for (int n = wave; n < NT; n += nw) {
        float ss = 0.f;
#pragma unroll
        for (int i = 0; i < 4; ++i) {
            const float4 v = *(const float4*)(hm + (size_t)n * DM + i * 256 + lane * 4);
            ss += v.x * v.x + v.y * v.y + v.z * v.z + v.w * v.w;
        }
        ss = wave_sum(ss);
        if (lane == 0) rstd[n] = rsqrtf(ss * (1.0f / 1024.0f) + 1e-6f);
    }
}

struct ConvJob { const float* src; bf16_t* dst; const float* scale; int ldsrc, K, nvalid, nrows, nb, notr; size_t sbs, dbs; const float* srcB; int ldB, split; };
__device__ __forceinline__ int conv_job_tiles(const ConvJob& j) { return j.nb * (j.nrows >> 6) * (j.K >> 6); }
__device__ void conv_tile(const ConvJob& j, int tile, float* lds) {
    const int per = (j.nrows >> 6) * (j.K >> 6);
    const int bi = tile / per, rem = tile % per;
    const int ktiles = j.K >> 6;
    const int n0 = (rem / ktiles) << 6, k0 = (rem % ktiles) << 6;
    const int tid = otid(), tn = tid & 63, tk = tid >> 6;
    const float* src = j.src + (size_t)bi * j.sbs;
    bf16_t* dst = j.dst + (size_t)bi * j.dbs;
#pragma unroll
    for (int kk = 0; kk < 8; ++kk) {
        const int k = k0 + tk * 8 + kk;
        float v = 0.f;
        if (n0 + tn < j.nvalid) {
            if (j.split) { const int nn = n0 + tn; v = (nn < j.split) ? (j.src ? j.src[(size_t)k * j.ldsrc + nn] : 0.f) : j.srcB[(size_t)k * j.ldB + (nn - j.split)]; }
            else v = j.notr ? src[(size_t)(n0 + tn) * j.ldsrc + k] : src[(size_t)k * j.ldsrc + n0 + tn];
            if (j.scale) v *= j.scale[k];
        }
        lds[tn * 65 + tk * 8 + kk] = v;
    }
    __syncthreads();
    const int wn = tid >> 3, kq = tid & 7;
    uint4 o;
    unsigned w[4];
#pragma unroll
    for (int q = 0; q < 4; ++q) {
        const float lo = lds[wn * 65 + kq * 8 + 2 * q], hi = lds[wn * 65 + kq * 8 + 2 * q + 1];
        w[q] = pk2(lo, hi);
    }
    o.x = w[0]; o.y = w[1]; o.z = w[2]; o.w = w[3];
    *(uint4*)(dst + (size_t)(n0 + wn) * j.K + k0 + kq * 8) = o;
    __syncthreads();
}
__device__ ConvJob get_job_early(const Params& p, int l, int ji) {
    bf16_t* wb = (bf16_t*)(WS(p) + OFF_WB);
    const float* win = p.in[3] + (size_t)l * DM * CIN;
    const float* nm = p.in[2] + (size_t)l * DM;
    ConvJob j{}; j.nb = 1; j.sbs = 0; j.dbs = 0; j.K = 1024; j.ldsrc = CIN; j.scale = nm;
    switch (ji) {
    case 0: j.src = win + 3072; j.dst = wb + WB_WIN; j.nvalid = 4352; j.nrows = 4352; break;
    case 1: j.src = (l == 0 ? nullptr : p.in[17]); j.ldsrc = 32; j.split = 32; j.srcB = win + 7424; j.ldB = CIN; j.dst = wb + WB_WIN + (size_t)(4096 + PM_VD) * 1024; j.nvalid = 512; j.nrows = 512; break;
    case 2: j.src = win + 7904; j.dst = wb + WB_WIDX; j.nvalid = 8; j.nrows = 64; break;
    case 3: j.src = win; j.dst = wb + WB_WG; j.nvalid = 3072; j.nrows = 3072; break;
    case 4: j.src = p.in[29] + (size_t)l * DM * DM; j.ldsrc = 1024; j.scale = nullptr; j.dst = wb + WB_PA; j.nvalid = 1024; j.nrows = 1024; break;
    case 5: j.src = p.in[30] + (size_t)l * DM * DM; j.ldsrc = 1024; j.scale = nullptr; j.dst = wb + WB_PA + (size_t)1024 * 1024; j.nvalid = 1024; j.nrows = 1024; break;
    case 6: j.src = p.in[31] + (size_t)l * DM * DM; j.ldsrc = 1024; j.scale = nullptr; j.dst = wb + WB_PA + (size_t)2 * 1024 * 1024; j.nvalid = 1024; j.nrows = 1024; break;
    case 7: j.src = p.in[32] + (size_t)l * DM * DM; j.ldsrc = 1024; j.scale = nullptr; j.dst = wb + WB_WO; j.nvalid = 1024; j.nrows = 1024; break;
    case 8: j.src = p.in[5] + (size_t)l * 4 * 256 * 256; j.ldsrc = 256; j.K = 256; j.scale = nullptr; j.dst = wb + WB_POOL; j.nvalid = 256; j.nrows = 256; j.nb = 4; j.sbs = 65536; j.dbs = 65536; break;
    case 9: j.src = p.in[26] + (size_t)l * 256 * 512; j.ldsrc = 512; j.K = 256; j.scale = nullptr; j.dst = wb + WB_QI; j.nvalid = 512; j.nrows = 512; break;
    case 10: j.src = p.in[23] + (size_t)l * 256 * 1536; j.ldsrc = 1536; j.K = 256; j.scale = nullptr; j.dst = wb + WB_UQ; j.nvalid = 1536; j.nrows = 1536; break;
    case 11: j.src = p.in[24] + (size_t)l * 16 * 128 * 64; j.ldsrc = 64; j.K = 64; j.scale = nullptr; j.dst = wb + WB_UK; j.nvalid = 2048; j.nrows = 2048; j.notr = 1; break;
    default: j.src = p.in[25] + (size_t)l * 16 * 128 * 64; j.ldsrc = 64; j.K = 128; j.scale = nullptr; j.dst = wb + WB_UV; j.nvalid = 64; j.nrows = 64; j.nb = 16; j.sbs = 8192; j.dbs = 8192; break;
    }
    return j;
}
__device__ ConvJob get_job_late(const Params& p, int l, int ji) {
    bf16_t* we = (bf16_t*)(WS(p) + OFF_WEXP);
    ConvJob j{}; j.nb = 16; j.scale = nullptr; j.sbs = 262144; j.dbs = 262144;
    switch (ji) {
    case 0: j.src = p.in[38] + (size_t)l * 16 * 262144; j.dst = we + WE_W1; j.ldsrc = 256; j.K = 1024; j.nvalid = 256; j.nrows = 256; break;
    case 1: j.src = p.in[39] + (size_t)l * 16 * 262144; j.dst = we + WE_W3; j.ldsrc = 256; j.K = 1024; j.nvalid = 256; j.nrows = 256; break;
    default: j.src = p.in[40] + (size_t)l * 16 * 262144; j.dst = we + WE_W2; j.ldsrc = 1024; j.K = 256; j.nvalid = 1024; j.nrows = 1024; break;
    }
    return j;
}
template <bool LATE>
__device__ void phase_convert(const Params& p, int l, unsigned char* lds) {
    const int njobs = LATE ? 3 : 13;
    int base = 0;
    for (int ji = 0; ji < njobs; ++ji) {
        const ConvJob j = LATE ? get_job_late(p, l, ji) : get_job_early(p, l, ji);
        const int nt = conv_job_tiles(j);
        int first = ((int)obid() - base) % (int)gridDim.x; if (first < 0) first += gridDim.x;
        for (int t = first; t < nt; t += gridDim.x) conv_tile(j, t, (float*)lds);
        base += nt;
    }
}

template <int BM> struct G3 {
    static constexpr int MI = BM / 64;
    static constexpr int NA = BM / 64;
    static constexpr int STAGE = BM * 128 + 128 * 128;
    const bf16_t* ap[NA];
    const bf16_t* bp[2];
};
template <int BM>
__device__ __forceinline__ void g3_issue(const G3<BM>& g, int kt, unsigned char* stage, int tid) {
#pragma unroll
    for (int i = 0; i < G3<BM>::NA; ++i) glds16(g.ap[i] + kt * 64, stage + (tid + i * NTHR) * 16);
#pragma unroll
    for (int i = 0; i < 2; ++i) glds16(g.bp[i] + kt * 64, stage + BM * 128 + (tid + i * NTHR) * 16);
}
template <int BM, class FA, class FB>
__device__ __forceinline__ void g3_setup(G3<BM>& g, FA rowptr, FB bcol, int tid) {
#pragma unroll
    for (int i = 0; i < G3<BM>::NA; ++i) { const int idx = tid + i * NTHR, row = idx >> 3, sl = (idx & 7) ^ (row & 7); g.ap[i] = rowptr(row) + sl * 8; }
#pragma unroll
    for (int i = 0; i < 2; ++i) { const int idx = tid + i * NTHR, row = idx >> 3, sl = (idx & 7) ^ (row & 7); g.bp[i] = bcol(row) + sl * 8; }
}
template <int BM>
__device__ __forceinline__ void g3_kloop(f32x4 (&acc)[BM / 64][4], const G3<BM>& g, int K, unsigned char* lds) {
    constexpr int MI = G3<BM>::MI, STAGE = G3<BM>::STAGE, NL = G3<BM>::NA + 2;
    const int tid = otid(), lane = tid & 63, wid = tid >> 6, wr = wid >> 1, wc = wid & 1, fr = lane & 15, fq = lane >> 4;
    const int nk = K >> 6;
    g3_issue<BM>(g, 0, lds, tid);
    if (nk > 1) g3_issue<BM>(g, 1, lds + STAGE, tid);
    int cur = 0;
#pragma unroll 1
    for (int t = 0; t < nk; ++t) {
        if (t + 1 < nk) { if (NL == 6) asm volatile("s_waitcnt vmcnt(6)" ::: "memory"); else if (NL == 5) asm volatile("s_waitcnt vmcnt(5)" ::: "memory"); else asm volatile("s_waitcnt vmcnt(4)" ::: "memory"); }
        else asm volatile("s_waitcnt vmcnt(0)" ::: "memory");
        __builtin_amdgcn_s_barrier();
        if (t + 2 < nk) { int nx = cur + 2; if (nx >= 3) nx -= 3; g3_issue<BM>(g, t + 2, lds + nx * STAGE, tid); }
        const unsigned char* cA = lds + cur * STAGE;
        const unsigned char* cB = cA + BM * 128;
#pragma unroll
        for (int ks = 0; ks < 2; ++ks) {
            bf16x8 a[MI], b[4];
#pragma unroll
            for (int m = 0; m < MI; ++m) { const int row = wr * (BM / 4) + m * 16 + fr; a[m] = *(const bf16x8*)(cA + row * 128 + (((ks * 4 + fq) ^ (row & 7)) << 4)); }
#pragma unroll
            for (int n = 0; n < 4; ++n) { const int row = wc * 64 + n * 16 + fr; b[n] = *(const bf16x8*)(cB + row * 128 + (((ks * 4 + fq) ^ (row & 7)) << 4)); }
#pragma unroll
            for (int m = 0; m < MI; ++m)
#pragma unroll
                for (int n = 0; n < 4; ++n) acc[m][n] = __builtin_amdgcn_mfma_f32_16x16x32_bf16(b[n], a[m], acc[m][n], 0, 0, 0);
        }
        cur = (cur == 2) ? 0 : cur + 1;
    }
    __builtin_amdgcn_s_barrier();
}
struct G3D { const bf16_t* ap[2]; const bf16_t* b1[2]; const bf16_t* b3[2]; };
__device__ __forceinline__ void g3d_issue(const G3D& g, int kt, unsigned char* stage, int tid) {
#pragma unroll
    for (int i = 0; i < 2; ++i) glds16(g.ap[i] + kt * 64, stage + (tid + i * NTHR) * 16);
#pragma unroll
    for (int i = 0; i < 2; ++i) glds16(g.b1[i] + kt * 64, stage + 16384 + (tid + i * NTHR) * 16);
#pragma unroll
    for (int i = 0; i < 2; ++i) glds16(g.b3[i] + kt * 64, stage + 32768 + (tid + i * NTHR) * 16);
}
__device__ __forceinline__ void g3d_kloop(f32x4 (&acc1)[2][4], f32x4 (&acc3)[2][4], const G3D& g, int K, unsigned char* lds) {
    constexpr int STAGE = 49152;
    const int tid = otid(), lane = tid & 63, wid = tid >> 6, wr = wid >> 1, wc = wid & 1, fr = lane & 15, fq = lane >> 4;
    const int nk = K >> 6;
    g3d_issue(g, 0, lds, tid);
    if (nk > 1) g3d_issue(g, 1, lds + STAGE, tid);
    int cur = 0;
#pragma unroll 1
    for (int t = 0; t < nk; ++t) {
        if (t + 1 < nk) asm volatile("s_waitcnt vmcnt(6)" ::: "memory"); else asm volatile("s_waitcnt vmcnt(0)" ::: "memory");
        __builtin_amdgcn_s_barrier();
        if (t + 2 < nk) { int nx = cur + 2; if (nx >= 3) nx -= 3; g3d_issue(g, t + 2, lds + nx * STAGE, tid); }
        const unsigned char* cA = lds + cur * STAGE;
#pragma unroll
        for (int ks = 0; ks < 2; ++ks) {
            bf16x8 a[2], b1[4], b3[4];
#pragma unroll
            for (int m = 0; m < 2; ++m) { const int row = wr * 32 + m * 16 + fr; a[m] = *(const bf16x8*)(cA + row * 128 + (((ks * 4 + fq) ^ (row & 7)) << 4)); }
#pragma unroll
            for (int n = 0; n < 4; ++n) { const int row = wc * 64 + n * 16 + fr; const int off = row * 128 + (((ks * 4 + fq) ^ (row & 7)) << 4);
                b1[n] = *(const bf16x8*)(cA + 16384 + off); b3[n] = *(const bf16x8*)(cA + 32768 + off); }
#pragma unroll
            for (int m = 0; m < 2; ++m)
#pragma unroll
                for (int n = 0; n < 4; ++n) {
                    acc1[m][n] = __builtin_amdgcn_mfma_f32_16x16x32_bf16(b1[n], a[m], acc1[m][n], 0, 0, 0);
                    acc3[m][n] = __builtin_amdgcn_mfma_f32_16x16x32_bf16(b3[n], a[m], acc3[m][n], 0, 0, 0);
                }
        }
        cur = (cur == 2) ? 0 : cur + 1;
    }
    __builtin_amdgcn_s_barrier();
}
template <int MI>
__device__ __forceinline__ void g3_zero(f32x4 (&acc)[MI][4]) {
#pragma unroll
    for (int m = 0; m < MI; ++m)
#pragma unroll
        for (int n = 0; n < 4; ++n) acc[m][n] = (f32x4){0.f, 0.f, 0.f, 0.f};
}
__device__ __forceinline__ uint2 pack4(float a, float b, float c, float d) {
    uint2 r; r.x = pk2(a, b); r.y = pk2(c, d); return r;
}

namespace pg8 {
#define PG8_LAS __attribute__((address_space(3)))
typedef unsigned short bf16_t;
typedef short bf16x8 __attribute__((ext_vector_type(8)));
typedef float f32x4 __attribute__((ext_vector_type(4)));
typedef unsigned u32x4 __attribute__((ext_vector_type(4)));
constexpr int BM = 256, BK = 64, HALF = 128, HTB = HALF * BK * 2  , STAGE_BYTES = 8 * HTB, NXCD = 8, WGM = 8;

__host__ __device__ __forceinline__ int lds_byte(int r, int c) { const int st = (r >> 4) * 2 + (c >> 5), rr = r & 15, cc = c & 31, ob = rr * 64 + cc * 2; return st * 1024 + (ob ^ (((ob >> 9) & 1) << 5)); }
__host__ __device__ __forceinline__ void stage_rc(int b, int& R, int& C) { const int st = b / 1024, sb = b % 1024, swz = sb ^ (((sb >> 9) & 1) << 5); R = (st >> 1) * 16 + swz / 64; C = (st & 1) * 32 + (swz % 64) / 2; }
__host__ __device__ __forceinline__ int perm32(int rho) { const int n = rho >> 4, i = rho & 15; return 8 * (i >> 2) + 4 * n + (i & 3); }

struct Unit { int pm, pn; };
struct Gemm { const bf16_t* A; const bf16_t* Bt; int M, N, K; };

struct StaticOrder {
    int nM, nN, nwg, G, c;
    __host__ __device__ void init(int M, int N, int G_, int c_) { nM = M / BM; nN = N / BM; nwg = nM * nN; G = G_; c = c_; }
    __host__ __device__ bool next(int i, Unit& u) const {
        const long L = (long)i * G + c; if (L >= nwg) return false;
        int wgid = (int)L; { const int q = nwg / NXCD, r = nwg % NXCD, xcd = wgid % NXCD, off = wgid / NXCD; wgid = (xcd < r ? xcd * (q + 1) : r * (q + 1) + (xcd - r) * q) + off; }
        const int nig = WGM * nN, gid = wgid / nig, fm = gid * WGM, gsz = (nM - fm) < WGM ? (nM - fm) : WGM;
        u.pm = fm + ((wgid % nig) % gsz); u.pn = (wgid % nig) / gsz; return true;
    }
    __device__ __forceinline__ void a_ready(const Unit&) const {}
    __device__ __forceinline__ void done(const Unit&) const {}
};
template <class Epi, class Sched, bool STAMP = false>
__device__ __forceinline__ void gemm_phase(PG8_LAS unsigned char* lds, const Gemm g, const Sched& S, const Epi& E, unsigned long long* stamps) {
    const int tid = otid(), wid = __builtin_amdgcn_readfirstlane(tid >> 6), lane = tid & 63, wr = wid >> 2, wc = wid & 3, fr = lane & 15, fq = lane >> 4;
    const int K = g.K, nt = K / BK;
    int ts_lo = 0, ts_hi = 0, nts = 0; const unsigned long long rt_entry = STAMP ? 0ull : 0ull;
#define PG8_STAMP() do { if (STAMP && wid == 0 && nts < 64) { const unsigned long long _c = 0ull; \
        ts_lo = (lane == nts) ? (int)(unsigned)_c : ts_lo; ts_hi = (lane == nts) ? (int)(unsigned)(_c >> 32) : ts_hi; ++nts; } } while (0)
    PG8_STAMP();
    unsigned voffA[2], voffB[2];
#pragma unroll
    for (int i = 0; i < 2; ++i) { int R, C; stage_rc(tid * 16 + i * 8192, R, C); const int Rb = Epi::PERM ? ((R & ~31) + perm32(R & 31)) : R;
        voffA[i] = (unsigned)(R * K + C) * 2u; voffB[i] = (unsigned)(Rb * K + C) * 2u; }
    const size_t kstep = (size_t)(BK * 2);
    const size_t hstep = (size_t)HALF * K * 2;
    const size_t tstep = 2 * hstep;
    const unsigned ldsw = (unsigned)wid * 1024u;
    const int aoff = lds_byte(wr * 64 + fr, fq * 8), boff = lds_byte(wc * 32 + fr, fq * 8);
#define PG8_SA(b, h) (((b) * 2 + (h)) * HTB)
#define PG8_SB(b, h) ((4 + (b) * 2 + (h)) * HTB)
#define PG8_STAGE(bufoff, gbase, voff) do { _Pragma("unroll") for (int _i = 0; _i < 2; ++_i) \
        __builtin_amdgcn_global_load_lds((const unsigned*)((const char*)(gbase) + (voff)[_i]), (PG8_LAS unsigned*)(lds + (bufoff) + ldsw + _i * 8192), 16, 0, 0); } while (0)
#define PG8_LDA(dst, b, h) do { _Pragma("unroll") for (int m = 0; m < 4; ++m) _Pragma("unroll") for (int k = 0; k < 2; ++k) dst[m][k] = *(const PG8_LAS bf16x8*)(lds + PG8_SA(b, h) + aoff + m * 2048 + k * 1024); } while (0)
#define PG8_LDB(dst, b, h) do { _Pragma("unroll") for (int n = 0; n < 2; ++n) _Pragma("unroll") for (int k = 0; k < 2; ++k) dst[n][k] = *(const PG8_LAS bf16x8*)(lds + PG8_SB(b, h) + boff + n * 2048 + k * 1024); } while (0)
#define PG8_MMA(ai, bj, At, Bt) do { __builtin_amdgcn_s_setprio(1); _Pragma("unroll") for (int m = 0; m < 4; ++m) _Pragma("unroll") for (int n = 0; n < 2; ++n) _Pragma("unroll") for (int k = 0; k < 2; ++k) \
        acc[ai][bj][m][n] = __builtin_amdgcn_mfma_f32_16x16x32_bf16(Bt[n][k], At[m][k], acc[ai][bj][m][n], 0, 0, 0); __builtin_amdgcn_s_setprio(0); } while (0)
#define PG8_WAIT_V(n) asm volatile("s_waitcnt vmcnt(" #n ")" ::: "memory")
#define PG8_WAIT_L(n) asm volatile("s_waitcnt lgkmcnt(" #n ")" ::: "memory")
#define PG8_BAR __builtin_amdgcn_s_barrier()
#define PG8_SCHED __builtin_amdgcn_sched_barrier(0)
    Unit cur, nxt; int ui = 0;
    if (!S.next(0, cur)) return;
    f32x4 acc[2][2][4][2];
#pragma unroll
    for (int a = 0; a < 2; ++a)
#pragma unroll
        for (int b = 0; b < 2; ++b)
#pragma unroll
            for (int m = 0; m < 4; ++m)
#pragma unroll
                for (int n = 0; n < 2; ++n) acc[a][b][m][n] = (f32x4){0.f, 0.f, 0.f, 0.f};
    bf16x8 At[4][2], B0[2][2], B1[2][2];
    const char* cA = (const char*)g.A + (size_t)cur.pm * tstep; const char* cB = (const char*)g.Bt + (size_t)cur.pn * tstep;
    S.a_ready(cur);
    PG8_STAGE(PG8_SB(0, 0), cB, voffB); PG8_STAGE(PG8_SA(0, 0), cA, voffA); PG8_STAGE(PG8_SB(0, 1), cB + hstep, voffB); PG8_STAGE(PG8_SA(0, 1), cA + hstep, voffA);
    if (wr == 1) PG8_BAR;
    PG8_WAIT_V(4); PG8_BAR;
    PG8_STAGE(PG8_SB(1, 0), cB + kstep, voffB); PG8_STAGE(PG8_SA(1, 0), cA + kstep, voffA); PG8_STAGE(PG8_SB(1, 1), cB + hstep + kstep, voffB);
    PG8_WAIT_V(6); PG8_BAR;
    PG8_STAMP();
    for (;;) {
        const bool has_next = S.next(ui + 1, nxt);
        const char* nA = has_next ? (const char*)g.A + (size_t)nxt.pm * tstep : cA; const char* nB = has_next ? (const char*)g.Bt + (size_t)nxt.pn * tstep : cB;
        for (int t = 0; t < nt; t += 2) {
            const bool last = (t == nt - 2);
            const char* a1 = cA + (size_t)(t + 1) * kstep;
            const char* a2 = last ? nA : cA + (size_t)(t + 2) * kstep; const char* b2 = last ? nB : cB + (size_t)(t + 2) * kstep;
            const char* a3 = a2 + kstep; const char* b3 = b2 + kstep;
            if (last && has_next) S.a_ready(nxt);
            PG8_LDB(B0, 0, 0); PG8_SCHED; PG8_LDA(At, 0, 0); PG8_STAGE(PG8_SA(1, 1), a1 + hstep, voffA);
            PG8_WAIT_L(8); PG8_BAR; PG8_WAIT_L(0); PG8_MMA(0, 0, At, B0); PG8_BAR; PG8_SCHED;
            PG8_LDB(B1, 0, 1); PG8_STAGE(PG8_SB(0, 0), b2, voffB);
            PG8_BAR; PG8_WAIT_L(0); PG8_MMA(0, 1, At, B1); PG8_BAR;
            PG8_LDA(At, 0, 1); PG8_STAGE(PG8_SA(0, 0), a2, voffA);
            PG8_BAR; PG8_WAIT_L(0); PG8_MMA(1, 0, At, B0); PG8_BAR; PG8_SCHED;
            PG8_STAGE(PG8_SB(0, 1), b2 + hstep, voffB);
            PG8_WAIT_V(6); PG8_BAR; PG8_MMA(1, 1, At, B1); PG8_BAR;
            PG8_LDB(B0, 1, 0); PG8_SCHED; PG8_LDA(At, 1, 0); PG8_STAGE(PG8_SA(0, 1), a2 + hstep, voffA);
            PG8_WAIT_L(8); PG8_BAR; PG8_WAIT_L(0); PG8_MMA(0, 0, At, B0); PG8_BAR; PG8_SCHED;
            PG8_LDB(B1, 1, 1); PG8_STAGE(PG8_SB(1, 0), b3, voffB);
            PG8_BAR; PG8_WAIT_L(0); PG8_MMA(0, 1, At, B1); PG8_BAR;
            PG8_LDA(At, 1, 1); PG8_STAGE(PG8_SA(1, 0), a3, voffA);
            PG8_BAR; PG8_WAIT_L(0); PG8_MMA(1, 0, At, B0); PG8_BAR; PG8_SCHED;
            PG8_STAGE(PG8_SB(1, 1), b3 + hstep, voffB);
            PG8_WAIT_V(6); PG8_BAR; PG8_MMA(1, 1, At, B1); PG8_BAR;
        }
        PG8_STAMP();
        if constexpr (!Epi::AFTER_DRAIN) { E(acc, cur, wr, wc, fr, fq); S.done(cur); }
        PG8_STAMP();
        if (!has_next) break;
#pragma unroll
        for (int a = 0; a < 2; ++a)
#pragma unroll
            for (int b = 0; b < 2; ++b)
#pragma unroll
                for (int m = 0; m < 4; ++m)
#pragma unroll
                    for (int n = 0; n < 2; ++n) acc[a][b][m][n] = (f32x4){0.f, 0.f, 0.f, 0.f};
        cur = nxt; cA = nA; cB = nB; ++ui;
    }
    PG8_WAIT_V(0);
    if (wr == 0) PG8_BAR;
    PG8_BAR;
    if constexpr (Epi::AFTER_DRAIN) { E.fused(acc, cur, wr, wc, fr, fq, lds, wid, lane); S.done(cur); }
    PG8_STAMP();
    if (STAMP && wid == 0) { stamps[lane] = lane < nts ? (((unsigned long long)(unsigned)ts_hi << 32) | (unsigned)ts_lo) : 0ull;
        if (lane == 62) stamps[62] = rt_entry; if (lane == 63) stamps[63] = 0ull; }
#undef PG8_STAMP
#undef PG8_SA
#undef PG8_SB
#undef PG8_STAGE
#undef PG8_LDA
#undef PG8_LDB
#undef PG8_MMA
#undef PG8_WAIT_V
#undef PG8_WAIT_L
#undef PG8_BAR
#undef PG8_SCHED
}
}

struct EpiInproj {
    static constexpr bool PERM = true, AFTER_DRAIN = false;
    unsigned char* ws; const float* rstd;
    __device__ __forceinline__ void operator()(const pg8::f32x4 (&acc)[2][2][4][2], const pg8::Unit& u, int wr, int wc, int fr, int fq) const {
        const int pn = u.pn;
        bf16_t* dst; int ld, cb;
        if (pn < 4) { dst = (bf16_t*)(ws + OFF_PPOOL); ld = 1024; cb = pn * 256; }
        else if (pn < 8) { dst = (bf16_t*)(ws + OFF_PR); ld = 1024; cb = (pn - 4) * 256; }
        else if (pn < 12) { dst = (bf16_t*)(ws + OFF_PK); ld = 1024; cb = (pn - 8) * 256; }
        else if (pn < 16) { dst = (bf16_t*)(ws + OFF_PV); ld = 1024; cb = (pn - 12) * 256; }
        else { dst = (bf16_t*)(ws + OFF_PMISC); ld = PM_LD; cb = (pn - 16) * 256; }
        bf16_t* halo = (bf16_t*)(ws + OFF_HALO);
#pragma unroll
        for (int ai = 0; ai < 2; ++ai)
#pragma unroll
            for (int m = 0; m < 4; ++m) {
                const int row = u.pm * 256 + ai * 128 + wr * 64 + m * 16 + fr;
                if (row < NT) {
                    const float rs = rstd[row];
                    const int lr = row & 127;
#pragma unroll
                    for (int bj = 0; bj < 2; ++bj) {
                        const int col = cb + bj * 128 + wc * 32 + fq * 8;
                        const uint2 lo = pack4(acc[ai][bj][m][0][0] * rs, acc[ai][bj][m][0][1] * rs, acc[ai][bj][m][0][2] * rs, acc[ai][bj][m][0][3] * rs);
                        const uint2 hi = pack4(acc[ai][bj][m][1][0] * rs, acc[ai][bj][m][1][1] * rs, acc[ai][bj][m][1][2] * rs, acc[ai][bj][m][1][3] * rs);
                        const uint4 v = make_uint4(lo.x, lo.y, hi.x, hi.y);
                        *(uint4*)(dst + (size_t)row * ld + col) = v;
                        if (pn < 4 && lr >= 112) *(uint4*)(halo + ((size_t)(row >> 7) * 16 + (lr - 112)) * 1024 + col) = v;
                    }
                }
            }
    }
};
__device__ void phase_inproj(const Params& p, unsigned char* lds) {
    pg8::StaticOrder S; S.init(NTP, NP1, (int)gridDim.x, obid());
    pg8::Gemm g; g.A = (const pg8::bf16_t*)(WS(p) + OFF_H); g.Bt = (const pg8::bf16_t*)(WS(p) + OFF_WB) + WB_WIN; g.M = NTP; g.N = NP1; g.K = DM;
    EpiInproj E; E.ws = WS(p); E.rstd = (const float*)(WS(p) + OFF_RSTD);
    pg8::gemm_phase<EpiInproj, pg8::StaticOrder, false>((PG8_LAS unsigned char*)lds, g, S, E, nullptr);
}

__device__ void phase_pool(const Params& p, int l, unsigned char* lds, int tb, int te, int tstep) {
    const int tid = otid(), lane = tid & 63, wid = tid >> 6, fr = lane & 15, fq = lane >> 4;
    bf16_t* pp = (bf16_t*)(WS(p) + OFF_PPOOL);
    const bf16_t* halo = (const bf16_t*)(WS(p) + OFF_HALO);
    const bf16_t* pw = (const bf16_t*)(WS(p) + OFF_WB) + WB_POOL;
    const float* scale = p.in[6] + (size_t)l * 1024;
    bf16_t* sp = (bf16_t*)lds;
    constexpr int SLD = 264;
    for (int tile = tb; tile < te; tile += tstep) {
        const int mt = tile >> 2, g = tile & 3;
        const int row0 = mt * 128, w = 2 << g;
        {
            const int c = tid & 255, r0 = (tid >> 8) * 64, col = g * 256 + c;
            auto rawv = [&](int n2) -> float {
                return (n2 >= row0) ? bf2f(pp[(size_t)n2 * 1024 + col]) : bf2f(halo[((size_t)(n2 >> 7) * 16 + ((n2 & 127) - 112)) * 1024 + col]);
            };
            int n = row0 + r0, t = n % TS;
            float sum = 0.f;
            const int have = (t < w) ? t : w;
            for (int i = 1; i <= have; ++i) sum += rawv(n - i);
#pragma unroll 4
            for (int r = 0; r < 64; ++r, ++n) {
                if (t == 0) sum = 0.f;
                const float v = rawv(n);
                sum += v;
                if (t >= w) sum -= rawv(n - w);
                const int cnt = (t + 1 < w) ? (t + 1) : w;
                sp[(r0 + r) * SLD + c] = f2bf(sum * (1.0f / (float)cnt) - v);
                t = (t + 1 == TS) ? 0 : t + 1;
            }
        }
        __syncthreads();
        f32x4 acc[8][2];
#pragma unroll
        for (int m = 0; m < 8; ++m) { acc[m][0] = (f32x4){0.f, 0.f, 0.f, 0.f}; acc[m][1] = (f32x4){0.f, 0.f, 0.f, 0.f}; }
        const bf16_t* wg = pw + (size_t)g * 65536;
#pragma unroll 1
        for (int kk = 0; kk < 8; ++kk) {
            bf16x8 bfr[2];
#pragma unroll
            for (int n = 0; n < 2; ++n) bfr[n] = *(const bf16x8*)(wg + (size_t)(wid * 32 + n * 16 + fr) * 256 + kk * 32 + fq * 8);
#pragma unroll
            for (int m = 0; m < 8; ++m) {
                const bf16x8 a = *(const bf16x8*)(sp + (m * 16 + fr) * SLD + kk * 32 + fq * 8);
                acc[m][0] = __builtin_amdgcn_mfma_f32_16x16x32_bf16(a, bfr[0], acc[m][0], 0, 0, 0);
                acc[m][1] = __builtin_amdgcn_mfma_f32_16x16x32_bf16(a, bfr[1], acc[m][1], 0, 0, 0);
            }
        }
#pragma unroll
        for (int m = 0; m < 8; ++m)
#pragma unroll
            for (int n = 0; n < 2; ++n) {
                const int col = g * 256 + wid * 32 + n * 16 + fr;
                const float sc = scale[col];
#pragma unroll
                for (int j = 0; j < 4; ++j) {
                    const int row = row0 + m * 16 + fq * 4 + j;
                    pp[(size_t)row * 1024 + col] = f2bf(acc[m][n][j] * sc);
                }
            }
        __syncthreads();
    }
}

__device__ void phase_dsa_prep(const Params& p, int l) {
    const int lane = otid() & 63;
    const int wave = (obid() * NTHR + otid()) >> 6, nw = gridDim.x * NTHR / 64;
    const bf16_t* pm = (const bf16_t*)(WS(p) + OFF_PMISC);
    unsigned char* dob = OUTB(p);
    bf16_t* cqn = (bf16_t*)(dob + DO_CQN);
    bf16_t* kv = (bf16_t*)(dob + DO_KV);
    bf16_t* kidx = (bf16_t*)(dob + DO_KIDX);
    float* whead = (float*)(dob + DO_WHEAD);
    const float* ctab = (const float*)(WS(p) + OFF_ROPE);
    const float* stab = ctab + TS * 16;
    const float* qn = p.in[21] + l * 256;
    const float* kvn = p.in[22] + l * 128;
    const float* inw = p.in[27] + l * 64;
    const float* inb = p.in[28] + l * 64;
    const bf16_t* hrow = (const bf16_t*)(WS(p) + OFF_H);
    const bf16_t* wwidx = (const bf16_t*)(WS(p) + OFF_WB) + WB_WIDX;
    const float* rstd_ = (const float*)(WS(p) + OFF_RSTD);
    for (int n = wave; n < NT; n += nw) {
        const int t = n % TS;
        const bf16_t* row = pm + (size_t)n * PM_LD;
        {
            float v[4]; float ss = 0.f;
#pragma unroll
            for (int i = 0; i < 4; ++i) { v[i] = bf2f(row[PM_CQ + lane * 4 + i]); ss += v[i] * v[i]; }
            ss = wave_sum_fast(ss);
            const float rs = rsqrtf(ss * (1.0f / 256.0f) + 1e-6f);
#pragma unroll
            for (int i = 0; i < 4; ++i) cqn[(size_t)n * 256 + lane * 4 + i] = f2bf(v[i] * rs * qn[lane * 4 + i]);
        }
        {
            float v[2]; float ss = 0.f;
#pragma unroll
            for (int i = 0; i < 2; ++i) { v[i] = bf2f(row[PM_CKV + lane * 2 + i]); ss += v[i] * v[i]; }
            ss = wave_sum_fast(ss);
            const float rs = rsqrtf(ss * (1.0f / 128.0f) + 1e-6f);
#pragma unroll
            for (int i = 0; i < 2; ++i) kv[(size_t)n * 160 + lane * 2 + i] = f2bf(v[i] * rs * kvn[lane * 2 + i]);
        }
        if (lane < 16) {
            const float x1 = bf2f(row[PM_KROPE + lane]), x2 = bf2f(row[PM_KROPE + 16 + lane]);
            const float c = ctab[t * 16 + lane], s = stab[t * 16 + lane];
            kv[(size_t)n * 160 + 128 + lane] = f2bf(x1 * c - x2 * s);
            kv[(size_t)n * 160 + 144 + lane] = f2bf(x2 * c + x1 * s);
        }
        {
            const float x = bf2f(row[PM_KIDX + lane]);
            const float mu = wave_sum_fast(x) * (1.0f / 64.0f);
            const float d = x - mu;
            const float var = wave_sum_fast(d * d) * (1.0f / 64.0f);
            const float y = d * rsqrtf(var + 1e-6f) * inw[lane] + inb[lane];
            const float yo = __shfl_xor(y, 16);
            float o = y;
            if (lane < 32) {
                const int i = lane & 15;
                const float c = ctab[t * 16 + i], s = stab[t * 16 + i];
                o = (lane < 16) ? (y * c - yo * s) : (y * c + yo * s);
            }
            kidx[(size_t)n * 64 + lane] = f2bf(o);
        }
        {
            const uint4 hv0 = *(const uint4*)(hrow + (size_t)n * DM + lane * 16), hv1 = *(const uint4*)(hrow + (size_t)n * DM + lane * 16 + 8);
            float hx[16];
            hx[0] = __uint_as_float(hv0.x << 16); hx[1] = __uint_as_float(hv0.x & 0xFFFF0000u); hx[2] = __uint_as_float(hv0.y << 16); hx[3] = __uint_as_float(hv0.y & 0xFFFF0000u);
            hx[4] = __uint_as_float(hv0.z << 16); hx[5] = __uint_as_float(hv0.z & 0xFFFF0000u); hx[6] = __uint_as_float(hv0.w << 16); hx[7] = __uint_as_float(hv0.w & 0xFFFF0000u);
            hx[8] = __uint_as_float(hv1.x << 16); hx[9] = __uint_as_float(hv1.x & 0xFFFF0000u); hx[10] = __uint_as_float(hv1.y << 16); hx[11] = __uint_as_float(hv1.y & 0xFFFF0000u);
            hx[12] = __uint_as_float(hv1.z << 16); hx[13] = __uint_as_float(hv1.z & 0xFFFF0000u); hx[14] = __uint_as_float(hv1.w << 16); hx[15] = __uint_as_float(hv1.w & 0xFFFF0000u);
            float myw = 0.f;
#pragma unroll
            for (int j = 0; j < 8; ++j) {
                const uint4 w0 = *(const uint4*)(wwidx + (size_t)j * DM + lane * 16), w1 = *(const uint4*)(wwidx + (size_t)j * DM + lane * 16 + 8);
                float d = hx[0] * __uint_as_float(w0.x << 16) + hx[1] * __uint_as_float(w0.x & 0xFFFF0000u) + hx[2] * __uint_as_float(w0.y << 16) + hx[3] * __uint_as_float(w0.y & 0xFFFF0000u)
                        + hx[4] * __uint_as_float(w0.z << 16) + hx[5] * __uint_as_float(w0.z & 0xFFFF0000u) + hx[6] * __uint_as_float(w0.w << 16) + hx[7] * __uint_as_float(w0.w & 0xFFFF0000u)
                        + hx[8] * __uint_as_float(w1.x << 16) + hx[9] * __uint_as_float(w1.x & 0xFFFF0000u) + hx[10] * __uint_as_float(w1.y << 16) + hx[11] * __uint_as_float(w1.y & 0xFFFF0000u)
                        + hx[12] * __uint_as_float(w1.z << 16) + hx[13] * __uint_as_float(w1.z & 0xFFFF0000u) + hx[14] * __uint_as_float(w1.w << 16) + hx[15] * __uint_as_float(w1.w & 0xFFFF0000u);
                d = wave_sum_fast(d);
                myw = (lane == j) ? d : myw;
            }
            if (lane < 8) whead[(size_t)n * 8 + lane] = myw * rstd_[n] * 0.04419417382415922f;
        }
    }
}

typedef short s16x4 __attribute__((ext_vector_type(4)));
__device__ __forceinline__ unsigned f2h_bits(float f) { const _Float16 h = (_Float16)f; unsigned short u; __builtin_memcpy(&u, &h, 2); return u; }
template <bool IMPORT_SEL>
__device__ void phase_dsa(const Params& p, int l, unsigned char* lds, bf16_t* yc, const unsigned short* gsel, const int* gnsel, int tb, int te, int tstep) {
    const int tid = otid(), lane = tid & 63, wid = tid >> 6, fr = lane & 15, fq = lane >> 4;
    unsigned short* s_sc = (unsigned short*)lds;
    bf16_t* s_qi = (bf16_t*)(lds + 66048);
    bf16_t* s_Q = (bf16_t*)lds;
    unsigned char* s_Vw = lds + 82432 + wid * 8192;
    bf16_t* s_qn = (bf16_t*)s_Vw;
    unsigned short* s_sel = (unsigned short*)(lds + 82432 + 65536);
    int* s_nsel = (int*)(lds + 82432 + 65536 + 8192);
    unsigned char* dob = OUTB(p);
    const bf16_t* cqn = (const bf16_t*)(dob + DO_CQN);
    const bf16_t* kv = (const bf16_t*)(dob + DO_KV);
    const bf16_t* kidx = (const bf16_t*)(dob + DO_KIDX);
    const float* whead = (const float*)(dob + DO_WHEAD);
    const float* ctab = (const float*)(WS(p) + OFF_ROPE);
    const float* stab = ctab + TS * 16;
    const bf16_t* wb = (const bf16_t*)(WS(p) + OFF_WB);
    const bf16_t* wqiT = wb + WB_QI;
    const bf16_t* wuqT = wb + WB_UQ;
    const bf16_t* wuk = wb + WB_UK;
    const bf16_t* wuvT = wb + WB_UV;
    const float scale = 0.10206207261596575f;
    const f32x4 z4 = {0.f, 0.f, 0.f, 0.f};
    for (int tile = tb; tile < te; tile += tstep) {
        const int qt = 128 - (tile >> 3), b = tile & 7;
        const int t0 = qt * 16;
        const size_t n0 = (size_t)b * TS + t0;
        {
            bf16x8 acq[8];
#pragma unroll
            for (int kk = 0; kk < 8; ++kk) acq[kk] = *(const bf16x8*)(cqn + (n0 + fr) * 256 + kk * 32 + fq * 8);
            f32x4 c[4] = {z4, z4, z4, z4};
#pragma unroll
            for (int kb = 0; kb < 8; kb += 4) {
                bf16x8 bf[4][4];
#pragma unroll
                for (int k4 = 0; k4 < 4; ++k4)
#pragma unroll
                    for (int nt = 0; nt < 4; ++nt) bf[k4][nt] = *(const bf16x8*)(wqiT + (size_t)(wid * 64 + nt * 16 + fr) * 256 + (kb + k4) * 32 + fq * 8);
#pragma unroll
                for (int k4 = 0; k4 < 4; ++k4)
#pragma unroll
                    for (int nt = 0; nt < 4; ++nt) c[nt] = __builtin_amdgcn_mfma_f32_16x16x32_bf16(acq[kb + k4], bf[k4][nt], c[nt], 0, 0, 0);
            }
#pragma unroll
            for (int j = 0; j < 4; ++j) {
                const int t = t0 + fq * 4 + j;
                const float cs = ctab[t * 16 + fr], sn = stab[t * 16 + fr];
                const float x1 = c[0][j], x2 = c[1][j];
                c[0][j] = x1 * cs - x2 * sn; c[1][j] = x2 * cs + x1 * sn;
            }
#pragma unroll
            for (int nt = 0; nt < 4; ++nt)
#pragma unroll
                for (int j = 0; j < 4; ++j) s_qi[(fq * 4 + j) * 512 + wid * 64 + nt * 16 + fr] = f2bf(c[nt][j]);
        }
        __syncthreads();
        if (!IMPORT_SEL) {
            bf16x8 aq[8][2];
#pragma unroll
            for (int h = 0; h < 8; ++h)
#pragma unroll
                for (int ks = 0; ks < 2; ++ks) aq[h][ks] = *(const bf16x8*)(s_qi + fr * 512 + h * 64 + ks * 32 + fq * 8);
            float wh[4][8];
#pragma unroll
            for (int j = 0; j < 4; ++j) {
                const float4 w0 = *(const float4*)(whead + (n0 + fq * 4 + j) * 8), w1 = *(const float4*)(whead + (n0 + fq * 4 + j) * 8 + 4);
                wh[j][0] = w0.x; wh[j][1] = w0.y; wh[j][2] = w0.z; wh[j][3] = w0.w; wh[j][4] = w1.x; wh[j][5] = w1.y; wh[j][6] = w1.z; wh[j][7] = w1.w;
            }
            const int nkt = qt + 1;
            bf16x8 nb0 = {0, 0, 0, 0, 0, 0, 0, 0}, nb1 = nb0;
            if (wid < nkt) { const bf16_t* kr0 = kidx + ((size_t)b * TS + wid * 16 + fr) * 64 + fq * 8; nb0 = *(const bf16x8*)kr0; nb1 = *(const bf16x8*)(kr0 + 32); }
#pragma unroll 1
            for (int kt = wid; kt < nkt; kt += 8) {
                const bf16x8 bk0 = nb0, bk1 = nb1;
                if (kt + 8 < nkt) { const bf16_t* krn = kidx + ((size_t)b * TS + (kt + 8) * 16 + fr) * 64 + fq * 8; nb0 = *(const bf16x8*)krn; nb1 = *(const bf16x8*)(krn + 32); }
                float I[4] = {0.f, 0.f, 0.f, 0.f};
#pragma unroll
                for (int h = 0; h < 8; ++h) {
                    f32x4 a = __builtin_amdgcn_mfma_f32_16x16x32_bf16(aq[h][0], bk0, z4, 0, 0, 0);
                    a = __builtin_amdgcn_mfma_f32_16x16x32_bf16(aq[h][1], bk1, a, 0, 0, 0);
#pragma unroll
                    for (int j = 0; j < 4; ++j) I[j] += wh[j][h] * fmaxf(a[j], 0.f);
                }
#pragma unroll
                for (int j = 0; j < 4; ++j) s_sc[(fq * 4 + j) * 2064 + kt * 16 + fr] = (unsigned short)f2h_bits(I[j]);
            }
        }
        __syncthreads();
#pragma unroll 1
        for (int qi2 = 0; qi2 < 2; ++qi2) {
            const int q = wid + qi2 * 8;
            const int nadm = t0 + q + 1;
            unsigned short* sel = s_sel + q * 256;
            if (IMPORT_SEL) {
                const int ns = gnsel[n0 + q];
                for (int i = lane; i < ns; i += 64) sel[i] = gsel[(n0 + q) * 256 + i];
                if (lane == 0) s_nsel[q] = ns;
            } else if (nadm <= 256) {
                for (int i = lane; i < nadm; i += 64) sel[i] = (unsigned short)i;
                if (lane == 0) s_nsel[q] = nadm;
            } else {
                auto topk = [&](auto nch_tag) {
                    constexpr int NCH = decltype(nch_tag)::value;
                    unsigned key[NCH];
    #pragma unroll
                    for (int c = 0; c < NCH; ++c) {
                        const int s = c * 64 + lane;
                        unsigned k = 0u;
                        if (s < nadm) { const unsigned u = s_sc[q * 2064 + s]; k = (u & 0x8000u) ? (~u & 0xFFFFu) : (u | 0x8000u); }
                        key[c] = k;
                    }
                    unsigned T = 0u;
    #pragma unroll 1
                    for (int bit = 15; bit >= 0; --bit) {
                        const unsigned cand = T | (1u << bit);
                        int cnt = 0;
    #pragma unroll
                        for (int c = 0; c < NCH; ++c) cnt += __popcll(__ballot(key[c] >= cand));
                        if (cnt >= 256) T = cand;
                    }
                    int ngt = 0;
    #pragma unroll
                    for (int c = 0; c < NCH; ++c) ngt += __popcll(__ballot(key[c] > T));
                    const int rties = 256 - ngt;
                    int base = 0, ties = 0;
                    const unsigned long long ltmask = (1ull << lane) - 1ull;
    #pragma unroll
                    for (int c = 0; c < NCH; ++c) {
                        const bool gt = key[c] > T, eq = key[c] == T;
                        const unsigned long long em = __ballot(eq);
                        const int myrank = ties + __popcll(em & ltmask);
                        const bool take = gt || (eq && myrank < rties);
                        const unsigned long long tm = __ballot(take);
                        const int pos = base + __popcll(tm & ltmask);
                        if (take && pos < 256) sel[pos] = (unsigned short)(c * 64 + lane);
                        base += __popcll(tm); ties += __popcll(em);
                    }

                };
                if (nadm <= 512) topk(std::integral_constant<int, 8>{});
                else if (nadm <= 1024) topk(std::integral_constant<int, 16>{});
                else if (nadm <= 1536) topk(std::integral_constant<int, 24>{});
                else topk(std::integral_constant<int, 33>{});
                if (lane == 0) s_nsel[q] = 256;
            }
        }
        __syncthreads();
#pragma unroll 1
        for (int hi = 0; hi < 2; ++hi) {
            const int hh = wid * 2 + hi;
            bf16x8 acq[8];
#pragma unroll
            for (int kk = 0; kk < 8; ++kk) acq[kk] = *(const bf16x8*)(cqn + (n0 + fr) * 256 + kk * 32 + fq * 8);
            f32x4 c6[6] = {z4, z4, z4, z4, z4, z4};
#pragma unroll
            for (int kb = 0; kb < 8; kb += 4) {
                bf16x8 bf[4][6];
#pragma unroll
                for (int k4 = 0; k4 < 4; ++k4)
#pragma unroll
                    for (int nt = 0; nt < 6; ++nt) bf[k4][nt] = *(const bf16x8*)(wuqT + (size_t)(hh * 96 + nt * 16 + fr) * 256 + (kb + k4) * 32 + fq * 8);
#pragma unroll
                for (int k4 = 0; k4 < 4; ++k4)
#pragma unroll
                    for (int nt = 0; nt < 6; ++nt) c6[nt] = __builtin_amdgcn_mfma_f32_16x16x32_bf16(acq[kb + k4], bf[k4][nt], c6[nt], 0, 0, 0);
            }
#pragma unroll
            for (int j = 0; j < 4; ++j) {
                const int q = fq * 4 + j, t = t0 + q;
                const float cs = ctab[t * 16 + fr], sn = stab[t * 16 + fr];
                const float x1 = c6[4][j], x2 = c6[5][j];
                s_Q[(q * 16 + hh) * 160 + 128 + fr] = f2bf(x1 * cs - x2 * sn);
                s_Q[(q * 16 + hh) * 160 + 144 + fr] = f2bf(x2 * cs + x1 * sn);
#pragma unroll
                for (int nt = 0; nt < 4; ++nt) s_qn[q * 64 + nt * 16 + fr] = f2bf(c6[nt][j]);
            }
            __syncthreads();
            bf16x8 an[2];
#pragma unroll
            for (int ks = 0; ks < 2; ++ks) an[ks] = *(const bf16x8*)(s_qn + fr * 64 + ks * 32 + fq * 8);
            bf16x8 bwk[8][2];
#pragma unroll
            for (int nt = 0; nt < 8; ++nt)
#pragma unroll
                for (int ks = 0; ks < 2; ++ks) bwk[nt][ks] = *(const bf16x8*)(wuk + (size_t)(hh * 128 + nt * 16 + fr) * 64 + ks * 32 + fq * 8);
#pragma unroll
            for (int nt = 0; nt < 8; ++nt) {
                f32x4 a = z4;
#pragma unroll
                for (int ks = 0; ks < 2; ++ks)
                    a = __builtin_amdgcn_mfma_f32_16x16x32_bf16(an[ks], bwk[nt][ks], a, 0, 0, 0);
#pragma unroll
                for (int j = 0; j < 4; ++j) s_Q[((fq * 4 + j) * 16 + hh) * 160 + nt * 16 + fr] = f2bf(a[j]);
            }
            __syncthreads();
        }
#pragma unroll 1
        for (int qi2 = 0; qi2 < 2; ++qi2) {
            const int q = wid + qi2 * 8;
            bf16x8 bq[5];
#pragma unroll
            for (int ks = 0; ks < 5; ++ks) bq[ks] = *(const bf16x8*)(s_Q + (q * 16 + fr) * 160 + ks * 32 + fq * 8);
            const int nsel = s_nsel[q];
            const unsigned short* sel = s_sel + q * 256;
            float m = -INFINITY, lsum = 0.f;
            f32x4 O[8] = {z4, z4, z4, z4, z4, z4, z4, z4};
            const int nchunk = (nsel + 31) >> 5;
            bf16x8 akn[2][5];
#pragma unroll
            for (int mt = 0; mt < 2; ++mt) {
                const int ki = mt * 16 + fr;
                const int sidx = sel[ki < nsel ? ki : 0];
                const bf16_t* krow = kv + ((size_t)b * TS + sidx) * 160 + fq * 8;
#pragma unroll
                for (int ks = 0; ks < 5; ++ks) akn[mt][ks] = *(const bf16x8*)(krow + ks * 32);
            }
#pragma unroll 1
            for (int ch = 0; ch < nchunk; ++ch) {
                bf16x8 ak[2][5];
#pragma unroll
                for (int mt = 0; mt < 2; ++mt)
#pragma unroll
                    for (int ks = 0; ks < 5; ++ks) ak[mt][ks] = akn[mt][ks];
                if (ch + 1 < nchunk) {
#pragma unroll
                    for (int mt = 0; mt < 2; ++mt) {
                        const int ki = (ch + 1) * 32 + mt * 16 + fr;
                        const int sidx = sel[ki < nsel ? ki : 0];
                        const bf16_t* krow = kv + ((size_t)b * TS + sidx) * 160 + fq * 8;
#pragma unroll
                        for (int ks = 0; ks < 5; ++ks) akn[mt][ks] = *(const bf16x8*)(krow + ks * 32);
                    }
                }
#pragma unroll
                for (int mt = 0; mt < 2; ++mt)
#pragma unroll
                    for (int ks = 0; ks < 4; ++ks) {
                        const int r = mt * 16 + fr;
                        *(bf16x8*)(s_Vw + r * 256 + (((ks * 2 + (fq >> 1)) ^ (r & 7)) * 32) + (fq & 1) * 16) = ak[mt][ks];
                    }
                f32x4 st[2] = {z4, z4};
#pragma unroll
                for (int mt = 0; mt < 2; ++mt)
#pragma unroll
                    for (int ks = 0; ks < 5; ++ks) st[mt] = __builtin_amdgcn_mfma_f32_16x16x32_bf16(ak[mt][ks], bq[ks], st[mt], 0, 0, 0);
                float sv[2][4]; float cmax = -INFINITY;
#pragma unroll
                for (int mt = 0; mt < 2; ++mt)
#pragma unroll
                    for (int j = 0; j < 4; ++j) {
                        const int ke = ch * 32 + mt * 16 + fq * 4 + j;
                        const float s_ = (ke < nsel) ? st[mt][j] * scale : -INFINITY;
                        sv[mt][j] = s_; cmax = fmaxf(cmax, s_);
                    }
                cmax = fmaxf(cmax, __shfl_xor(cmax, 16)); cmax = fmaxf(cmax, __shfl_xor(cmax, 32));
                const float mnew = fmaxf(m, cmax);
                const float alpha = __expf(m - mnew);
                float psum = 0.f;
#pragma unroll
                for (int mt = 0; mt < 2; ++mt)
#pragma unroll
                    for (int j = 0; j < 4; ++j) { const float pe = __expf(sv[mt][j] - mnew); sv[mt][j] = pe; psum += pe; }
                psum += __shfl_xor(psum, 16); psum += __shfl_xor(psum, 32);
                lsum = lsum * alpha + psum; m = mnew;
#pragma unroll
                for (int ct = 0; ct < 8; ++ct) O[ct] = O[ct] * alpha;
                bf16x8 pf;
#pragma unroll
                for (int mt = 0; mt < 2; ++mt)
#pragma unroll
                    for (int j = 0; j < 4; ++j) pf[mt * 4 + j] = (short)f2bf(sv[mt][j]);
                const int q_ = fr >> 2, p_ = fr & 3;
                const int r0 = fq * 4 + q_, r1 = 16 + r0;
#pragma unroll
                for (int ct = 0; ct < 8; ++ct) {
                    const s16x4 v0 = __builtin_amdgcn_ds_read_tr16_b64_v4i16((__attribute__((address_space(3))) s16x4*)(s_Vw + r0 * 256 + ((ct ^ (r0 & 7)) * 32) + p_ * 8));
                    const s16x4 v1 = __builtin_amdgcn_ds_read_tr16_b64_v4i16((__attribute__((address_space(3))) s16x4*)(s_Vw + r1 * 256 + ((ct ^ (r1 & 7)) * 32) + p_ * 8));
                    bf16x8 av; av[0] = v0[0]; av[1] = v0[1]; av[2] = v0[2]; av[3] = v0[3]; av[4] = v1[0]; av[5] = v1[1]; av[6] = v1[2]; av[7] = v1[3];
                    O[ct] = __builtin_amdgcn_mfma_f32_16x16x32_bf16(av, pf, O[ct], 0, 0, 0);
                }
            }
            const float inv = 1.0f / lsum;
#pragma unroll
            for (int ct = 0; ct < 8; ++ct)
#pragma unroll
                for (int j = 0; j < 4; ++j) s_Q[(q * 16 + fr) * 160 + ct * 16 + fq * 4 + j] = f2bf(O[ct][j] * inv);
        }
        __syncthreads();
#pragma unroll 1
        for (int hi = 0; hi < 2; ++hi) {
            const int hh = wid * 2 + hi;
            bf16x8 ao[4];
#pragma unroll
            for (int ks = 0; ks < 4; ++ks) ao[ks] = *(const bf16x8*)(s_Q + (fr * 16 + hh) * 160 + ks * 32 + fq * 8);
#pragma unroll
            for (int nt = 0; nt < 4; ++nt) {
                f32x4 a = z4;
#pragma unroll
                for (int ks = 0; ks < 4; ++ks)
                    a = __builtin_amdgcn_mfma_f32_16x16x32_bf16(ao[ks], *(const bf16x8*)(wuvT + (size_t)(hh * 64 + nt * 16 + fr) * 128 + ks * 32 + fq * 8), a, 0, 0, 0);
#pragma unroll
                for (int j = 0; j < 4; ++j) yc[(n0 + fq * 4 + j) * 1024 + hh * 64 + nt * 16 + fr] = f2bf(a[j]);
            }
        }
        __syncthreads();
    }
}


__device__ void phase_lr_prep(const Params& p, int l) {
    const int lane = otid() & 63;
    const int wave = (obid() * NTHR + otid()) >> 6, nw = gridDim.x * NTHR / 64;
    const bf16_t* pm = (const bf16_t*)(WS(p) + OFF_PMISC);
    bf16_t* alr = (bf16_t*)(OUTB(p) + DO_ALR);
    const float* mu = p.in[4] + (size_t)l * 3328 + 3072;
    const float* vmu = p.in[18];
    for (int n = wave; n < NT; n += nw) {
        const int t = n % TS;
        for (int c = lane; c < 288; c += 64) {
            const float cur = bf2f(pm[(size_t)n * PM_LD + c]);
            const float prv = (t > 0) ? bf2f(pm[(size_t)(n - 1) * PM_LD + c]) : 0.f;
            const float m_ = (c < 256) ? mu[c] : vmu[c - 256];
            float xs = cur + (prv - cur) * m_;
            if (c < 64) xs = tanhf(xs);
            else if (c >= 128 && c < 256) xs = sigmoidf_(xs);
            alr[(size_t)n * 288 + c] = f2bf(xs);
        }
    }
}

typedef short sh4 __attribute__((ext_vector_type(4)));
__device__ __forceinline__ sh4 pk4v(const f32x4& v) { const uint2 u = pack4(v[0], v[1], v[2], v[3]); sh4 r; __builtin_memcpy(&r, &u, 8); return r; }
__device__ __forceinline__ bf16x8 cat8(const sh4& a, const sh4& b) { bf16x8 r; r[0] = a[0]; r[1] = a[1]; r[2] = a[2]; r[3] = a[3]; r[4] = b[0]; r[5] = b[1]; r[6] = b[2]; r[7] = b[3]; return r; }
#define MF32(a, b, c) __builtin_amdgcn_mfma_f32_16x16x32_bf16(a, b, c, 0, 0, 0)
#define MF16(a, b, c) MF32(cat8(a, sh4{0, 0, 0, 0}), cat8(b, sh4{0, 0, 0, 0}), c)
constexpr int SC_LT = 72;
constexpr int SC_LS = 36;
constexpr int SC_TC = 32;
constexpr int SC_ROWB = 1088;
__device__ __forceinline__ const unsigned char* scan_piece_src(const Params& p, int l, int b, int hc, int t0, int pi, bool& ok) {
    const int tau = pi / 68, seg = pi - tau * 68;
    const int t = t0 + tau;
    ok = (t < TS) && (tau < SC_TC);
    const size_t n = (size_t)b * TS + t;
    const unsigned char* ws = WS(p);
    if (seg < 8) return ws + OFF_PR + (n * 1024 + hc) * 2 + seg * 16;
    if (seg < 16) return ws + OFF_PK + (n * 1024 + hc) * 2 + (seg - 8) * 16;
    if (seg < 24) return ws + OFF_PV + (n * 1024 + hc) * 2 + (seg - 16) * 16;
    if (seg < 60) return OUTB(p) + DO_ALR + (n * 288) * 2 + (seg - 24) * 16;
    ok = ok && (l > 0);
    return ws + OFF_VFIRST + (n * 1024 + hc) * 2 + (seg - 60) * 16;
}
__device__ void phase_scan5(const Params& p, int l, unsigned char* lds, int blk) {
    const int tid = otid(), lane = tid & 63, wid = tid >> 6, fr = lane & 15, fq = lane >> 4;
    const int b = blk >> 4, hh = blk & 15, hc = hh * 64;
    float* s_r = (float*)lds;
    float* s_w = s_r + 2048;
    float* s_k = s_w + 2048;
    float* s_v = s_k + 2048;
    float* s_a = s_v + 2048;
    float* s_b = s_a + 2048;
    float* s_g = s_b + 2048;
    float* s_o = s_g + 2048;
    bf16_t* o_at = (bf16_t*)(s_o + 2048);
    bf16_t* o_rt = o_at + 32 * SC_LT;
    bf16_t* o_bt = o_rt + 32 * SC_LT;
    bf16_t* o_kt = o_bt + 32 * SC_LT;
    bf16_t* o_bT = o_kt + 32 * SC_LT;
    bf16_t* o_kT = o_bT + 64 * SC_LS;
    bf16_t* o_vT = o_kT + 64 * SC_LS;
    float* s_gc = (float*)(o_vT + 64 * SC_LS);
    unsigned char* raw = (unsigned char*)(s_gc + 128);
    float* prevb = (float*)(raw + 32 * SC_ROWB);
    unsigned* prevr = (unsigned*)prevb;
    float* s_bs = s_r;
    float* cst = prevb + 960;
    const float* mu = p.in[4] + (size_t)l * 3328;
    for (int e = tid; e < 480; e += NTHR) {
        float v;
        if (e < 192) v = mu[(e >> 6) * 1024 + hc + (e & 63)];
        else if (e < 448) v = mu[3072 + (e - 192)];
        else v = p.in[18][e - 448];
        cst[e] = v;
    }
    if (tid < 64) {
        cst[480 + tid] = p.in[7][l * 1024 + hc + tid];
        cst[544 + tid] = p.in[9][l * 1024 + hc + tid];
        cst[608 + tid] = p.in[12][l * 1024 + hc + tid];
        cst[672 + tid] = p.in[13][l * 1024 + hc + tid];
        cst[736 + tid] = p.in[14][l * 1024 + hc + tid];
        cst[800 + tid] = p.in[15][l * 1024 + hc + tid];
        cst[864 + tid] = p.in[16][l * 1024 + hc + tid];
        cst[928 + tid] = p.in[19][hc + tid];
    }
    const int mm = wid >> 1, ntb = (wid & 1) * 2;
    const int nks = (mm == 2) ? 4 : (mm == 3 ? 1 : 2);
    bf16x8 Bw[2][4];
    {
        const float* wsrc = (mm == 0) ? p.in[8] + (size_t)l * 64 * 1024 : (mm == 1) ? p.in[10] + (size_t)l * 64 * 1024 : (mm == 2) ? p.in[11] + (size_t)l * 128 * 1024 : p.in[20];
#pragma unroll
        for (int n2 = 0; n2 < 2; ++n2)
#pragma unroll
            for (int ks = 0; ks < 4; ++ks) {
                bf16x8 f;
#pragma unroll
                for (int j = 0; j < 8; ++j) {
                    const bool okw = ks < nks && (mm < 3 || l > 0);
                    const float v = wsrc[(size_t)(okw ? (ks * 32 + fq * 8 + j) : 0) * 1024 + hc + (ntb + n2) * 16 + fr];
                    f[j] = (short)f2bf(okw ? v : 0.f);
                }
                Bw[n2][ks] = f;
            }
    }
    const f32x4 z4 = {0.f, 0.f, 0.f, 0.f};
    f32x4 S[4] = {z4, z4, z4, z4};
    sh4 Lf;
#pragma unroll
    for (int j = 0; j < 4; ++j) Lf[j] = (fq * 4 + j <= fr) ? (short)0x3F80 : (short)0;
    bf16_t* Pr = (bf16_t*)(WS(p) + OFF_PR);
    bf16_t* vfirst = (bf16_t*)(WS(p) + OFF_VFIRST);
    const unsigned char* psrc[5]; int pstep[5], ptau[5]; bool pval[5];
#pragma unroll
    for (int k = 0; k < 5; ++k) {
        const int pi = tid + k * NTHR;
        bool ok = false;
        psrc[k] = scan_piece_src(p, l, b, hc, 0, pi < SC_TC * 68 ? pi : 0, ok);
        const int tau = (pi < SC_TC * 68 ? pi : 0) / 68, seg = (pi < SC_TC * 68 ? pi : 0) - tau * 68;
        ptau[k] = tau;
        pstep[k] = SC_TC * ((seg >= 24 && seg < 60) ? 576 : 2048);
        pval[k] = (pi < SC_TC * 68) && !(seg >= 60 && l == 0);
    }
    uint4 pre[5];
#pragma unroll
    for (int k = 0; k < 5; ++k) { pre[k] = make_uint4(0, 0, 0, 0); if (pval[k] && ptau[k] < TS) pre[k] = *(const uint4*)psrc[k]; }
    __syncthreads();
#pragma unroll 1
    for (int t0 = 0, ch = 0; t0 < TS; t0 += SC_TC, ++ch) {
        const int nval = (TS - t0 < SC_TC) ? (TS - t0) : SC_TC;
#pragma unroll
        for (int k = 0; k < 5; ++k) { const int pi = tid + k * NTHR; if (pi < SC_TC * 68) *(uint4*)(raw + pi * 16) = pre[k]; }
        lds_barrier();
#pragma unroll
        for (int k = 0; k < 5; ++k) {
            pre[k] = make_uint4(0, 0, 0, 0);
            if (pval[k] && t0 + SC_TC + ptau[k] < TS) pre[k] = *(const uint4*)(psrc[k] + (size_t)(ch + 1) * pstep[k]);
        }
        if (mm < 3 || l > 0) {
            const unsigned char* Ab = raw + ((mm == 0) ? 384 : (mm == 1) ? 512 : (mm == 2) ? 640 : 896);
            float* dst = (mm == 0) ? s_w : (mm == 1) ? s_a : (mm == 2) ? s_g : s_o;
#pragma unroll
            for (int m = 0; m < 2; ++m) {
                f32x4 acc0 = {0.f, 0.f, 0.f, 0.f}, acc1 = {0.f, 0.f, 0.f, 0.f};
#pragma unroll
                for (int ks = 0; ks < 4; ++ks) {
                    if (ks < nks) {
                        const bf16x8 a = *(const bf16x8*)(Ab + (m * 16 + fr) * SC_ROWB + ks * 64 + fq * 16);
                        acc0 = __builtin_amdgcn_mfma_f32_16x16x32_bf16(a, Bw[0][ks], acc0, 0, 0, 0);
                        acc1 = __builtin_amdgcn_mfma_f32_16x16x32_bf16(a, Bw[1][ks], acc1, 0, 0, 0);
                    }
                }
                if (mm == 0) {
                    const float cw0 = cst[480 + ntb * 16 + fr], cw1 = cst[480 + (ntb + 1) * 16 + fr];
                    f32x4 l0, l1, r0, r1;
#pragma unroll
                    for (int j = 0; j < 4; ++j) { l0[j] = -0.6065306597126334f * fast_sigmoid(acc0[j] + cw0); l1[j] = -0.6065306597126334f * fast_sigmoid(acc1[j] + cw1); }
                    const uint2 h0 = pack4(l0[0], l0[1], l0[2], l0[3]), h1 = pack4(l1[0], l1[1], l1[2], l1[3]);
                    r0[0] = l0[0] - __uint_as_float(h0.x << 16); r0[1] = l0[1] - __uint_as_float(h0.x & 0xFFFF0000u); r0[2] = l0[2] - __uint_as_float(h0.y << 16); r0[3] = l0[3] - __uint_as_float(h0.y & 0xFFFF0000u);
                    r1[0] = l1[0] - __uint_as_float(h1.x << 16); r1[1] = l1[1] - __uint_as_float(h1.x & 0xFFFF0000u); r1[2] = l1[2] - __uint_as_float(h1.y << 16); r1[3] = l1[3] - __uint_as_float(h1.y & 0xFFFF0000u);
                    sh4 hh0, hh1; __builtin_memcpy(&hh0, &h0, 8); __builtin_memcpy(&hh1, &h1, 8);
                    f32x4 c0 = MF16(Lf, pk4v(r0), z4), c1 = MF16(Lf, pk4v(r1), z4);
                    c0 = MF16(Lf, hh0, c0); c1 = MF16(Lf, hh1, c1);
#pragma unroll
                    for (int j = 0; j < 4; ++j) {
                        const int eo = (m * 16 + fq * 4 + j) * 64 + ntb * 16 + fr;
                        s_w[eo] = c0[j]; s_w[eo + 16] = c1[j];
                        s_b[eo] = l0[j]; s_b[eo + 16] = l1[j];
                    }
                } else {
#pragma unroll
                    for (int j = 0; j < 4; ++j) {
                        dst[(m * 16 + fq * 4 + j) * 64 + ntb * 16 + fr] = acc0[j];
                        dst[(m * 16 + fq * 4 + j) * 64 + (ntb + 1) * 16 + fr] = acc1[j];
                    }
                }
            }
        }
        lds_barrier();
        {
            const int tau = tid >> 4, c4 = (tid & 15) * 4, e = tau * 64 + c4, t = t0 + tau;
            const size_t n = (size_t)b * TS + t;
            const float4 cum4 = *(const float4*)(s_w + e), lw4 = *(const float4*)(s_b + e), xa4 = *(const float4*)(s_a + e);
            const float4 ca = *(const float4*)(cst + 544 + c4), ckk = *(const float4*)(cst + 608 + c4), cka = *(const float4*)(cst + 672 + c4), crk = *(const float4*)(cst + 736 + c4);
            const float cum[4] = {cum4.x, cum4.y, cum4.z, cum4.w}, lw[4] = {lw4.x, lw4.y, lw4.z, lw4.w};
            const float xa[4] = {xa4.x + ca.x, xa4.y + ca.y, xa4.z + ca.z, xa4.w + ca.w};
            const float kkc[4] = {ckk.x, ckk.y, ckk.z, ckk.w}, kac[4] = {cka.x, cka.y, cka.z, cka.w};
            float rr[4], kr[4], vv[4];
            {
                const unsigned char* rc = raw + tau * SC_ROWB + c4 * 2;
                const uint2 cr = *(const uint2*)rc, ck = *(const uint2*)(rc + 128), cv = *(const uint2*)(rc + 256);
                uint2 qr = make_uint2(0u, 0u), qk = qr, qv = qr;
                if (tau > 0) { qr = *(const uint2*)(rc - SC_ROWB); qk = *(const uint2*)(rc - SC_ROWB + 128); qv = *(const uint2*)(rc - SC_ROWB + 256); }
                else if (t0 > 0) { const unsigned* pvr = prevr + ((ch + 1) & 1) * 96 + (c4 >> 1); qr = *(const uint2*)pvr; qk = *(const uint2*)(pvr + 32); qv = *(const uint2*)(pvr + 64); }
                if (tau == SC_TC - 1) { unsigned* pwr = prevr + (ch & 1) * 96 + (c4 >> 1); *(uint2*)pwr = cr; *(uint2*)(pwr + 32) = ck; *(uint2*)(pwr + 64) = cv; }
                const float4 mr = *(const float4*)(cst + c4), mk = *(const float4*)(cst + 64 + c4), mv = *(const float4*)(cst + 128 + c4);
                const float c_[12] = {__uint_as_float(cr.x << 16), __uint_as_float(cr.x & 0xFFFF0000u), __uint_as_float(cr.y << 16), __uint_as_float(cr.y & 0xFFFF0000u),
                                      __uint_as_float(ck.x << 16), __uint_as_float(ck.x & 0xFFFF0000u), __uint_as_float(ck.y << 16), __uint_as_float(ck.y & 0xFFFF0000u),
                                      __uint_as_float(cv.x << 16), __uint_as_float(cv.x & 0xFFFF0000u), __uint_as_float(cv.y << 16), __uint_as_float(cv.y & 0xFFFF0000u)};
                const float q_[12] = {__uint_as_float(qr.x << 16), __uint_as_float(qr.x & 0xFFFF0000u), __uint_as_float(qr.y << 16), __uint_as_float(qr.y & 0xFFFF0000u),
                                      __uint_as_float(qk.x << 16), __uint_as_float(qk.x & 0xFFFF0000u), __uint_as_float(qk.y << 16), __uint_as_float(qk.y & 0xFFFF0000u),
                                      __uint_as_float(qv.x << 16), __uint_as_float(qv.x & 0xFFFF0000u), __uint_as_float(qv.y << 16), __uint_as_float(qv.y & 0xFFFF0000u)};
                const float m_[12] = {mr.x, mr.y, mr.z, mr.w, mk.x, mk.y, mk.z, mk.w, mv.x, mv.y, mv.z, mv.w};
#pragma unroll
                for (int j = 0; j < 4; ++j) { rr[j] = c_[j] + (q_[j] - c_[j]) * m_[j]; kr[j] = c_[4 + j] + (q_[4 + j] - c_[4 + j]) * m_[4 + j]; vv[j] = c_[8 + j] + (q_[8 + j] - c_[8 + j]) * m_[8 + j]; }
            }
            if (l > 0) {
                const float4 xv4 = *(const float4*)(s_o + e), cv = *(const float4*)(cst + 928 + c4);
                const uint2 vfu = *(const uint2*)(raw + tau * SC_ROWB + 960 + c4 * 2);
                const float vf[4] = {__uint_as_float(vfu.x << 16), __uint_as_float(vfu.x & 0xFFFF0000u), __uint_as_float(vfu.y << 16), __uint_as_float(vfu.y & 0xFFFF0000u)};
                const float xv[4] = {xv4.x + cv.x, xv4.y + cv.y, xv4.z + cv.z, xv4.w + cv.w};
#pragma unroll
                for (int j = 0; j < 4; ++j) vv[j] = vv[j] + (vf[j] - vv[j]) * fast_sigmoid(xv[j]);
            } else if (t < TS) {
                *(uint2*)(vfirst + n * 1024 + hc + c4) = pack4(vv[0], vv[1], vv[2], vv[3]);
            }
            float av[4], kkv[4], ginc[4], gexc[4], ginv[4]; float ss = 0.f;
#pragma unroll
            for (int j = 0; j < 4; ++j) {
                ginc[j] = __expf(cum[j]); gexc[j] = __expf(cum[j] - lw[j]); ginv[j] = __expf(-cum[j]);
                av[j] = fast_sigmoid(xa[j]);
                kkv[j] = kr[j] * kkc[j];
                ss += kkv[j] * kkv[j];
            }
            float kk[4], kt[4];
#pragma unroll
            for (int j = 0; j < 4; ++j) kt[j] = kr[j] * (1.0f + (av[j] - 1.0f) * kac[j]);
            float bsum = rr[0] * kt[0] * crk.x + rr[1] * kt[1] * crk.y + rr[2] * kt[2] * crk.z + rr[3] * kt[3] * crk.w;
            float du0 = 0.f, du1 = 0.f;
            row16_sum4(ss, bsum, du0, du1);
            if ((tid & 15) == 0) s_bs[tau] = bsum;
            const float rn = rsqrtf(fmaxf(ss, 1e-24f));
#pragma unroll
            for (int j = 0; j < 4; ++j) kk[j] = kkv[j] * rn;
            const uint2 pa = pack4(-kk[0] * gexc[0], -kk[1] * gexc[1], -kk[2] * gexc[2], -kk[3] * gexc[3]);
            const uint2 pr = pack4(rr[0] * ginc[0], rr[1] * ginc[1], rr[2] * ginc[2], rr[3] * ginc[3]);
            const uint2 pb = pack4(kk[0] * av[0] * ginv[0], kk[1] * av[1] * ginv[1], kk[2] * av[2] * ginv[2], kk[3] * av[3] * ginv[3]);
            const uint2 pk = pack4(kt[0] * ginv[0], kt[1] * ginv[1], kt[2] * ginv[2], kt[3] * ginv[3]);
            const uint2 pv = pack4(vv[0], vv[1], vv[2], vv[3]);
            *(uint2*)(o_at + tau * SC_LT + c4) = pa;
            *(uint2*)(o_rt + tau * SC_LT + c4) = pr;
            *(uint2*)(o_bt + tau * SC_LT + c4) = pb;
            *(uint2*)(o_kt + tau * SC_LT + c4) = pk;
            o_bT[(c4 + 0) * SC_LS + tau] = (bf16_t)(pb.x & 0xFFFFu); o_bT[(c4 + 1) * SC_LS + tau] = (bf16_t)(pb.x >> 16); o_bT[(c4 + 2) * SC_LS + tau] = (bf16_t)(pb.y & 0xFFFFu); o_bT[(c4 + 3) * SC_LS + tau] = (bf16_t)(pb.y >> 16);
            o_kT[(c4 + 0) * SC_LS + tau] = (bf16_t)(pk.x & 0xFFFFu); o_kT[(c4 + 1) * SC_LS + tau] = (bf16_t)(pk.x >> 16); o_kT[(c4 + 2) * SC_LS + tau] = (bf16_t)(pk.y & 0xFFFFu); o_kT[(c4 + 3) * SC_LS + tau] = (bf16_t)(pk.y >> 16);
            o_vT[(c4 + 0) * SC_LS + tau] = (bf16_t)(pv.x & 0xFFFFu); o_vT[(c4 + 1) * SC_LS + tau] = (bf16_t)(pv.x >> 16); o_vT[(c4 + 2) * SC_LS + tau] = (bf16_t)(pv.y & 0xFFFFu); o_vT[(c4 + 3) * SC_LS + tau] = (bf16_t)(pv.y >> 16);
            if ((tau & 15) == 15) *(float4*)(s_gc + (tau >> 4) * 64 + c4) = make_float4(ginc[0], ginc[1], ginc[2], ginc[3]);
            *(float4*)(s_v + e) = make_float4(vv[0], vv[1], vv[2], vv[3]);
        }
        lds_barrier();
        if (wid < 4) {
#pragma unroll
            for (int sc = 0; sc < 2; ++sc) {
                if (sc * 16 < nval) {
                    const bf16_t* ar = o_at + (sc * 16 + fr) * SC_LT;
                    const bf16_t* rr_ = o_rt + (sc * 16 + fr) * SC_LT;
                    const bf16_t* br = o_bt + (sc * 16 + fr) * SC_LT;
                    const bf16_t* kr_ = o_kt + (sc * 16 + fr) * SC_LT;
                    const bf16x8 fa0 = *(const bf16x8*)(ar + fq * 8), fa1 = *(const bf16x8*)(ar + 32 + fq * 8);
                    const bf16x8 fb0 = *(const bf16x8*)(br + fq * 8), fb1 = *(const bf16x8*)(br + 32 + fq * 8);
                    const bf16x8 fk0 = *(const bf16x8*)(kr_ + fq * 8), fk1 = *(const bf16x8*)(kr_ + 32 + fq * 8);
                    const bf16x8 fr0 = *(const bf16x8*)(rr_ + fq * 8), fr1 = *(const bf16x8*)(rr_ + 32 + fq * 8);
                    f32x4 nA = MF32(fb0, fa0, z4); nA = MF32(fb1, fa1, nA);
                    f32x4 nB = MF32(fa0, fb0, z4); nB = MF32(fa1, fb1, nB);
                    f32x4 mak = MF32(fk0, fa0, z4); mak = MF32(fk1, fa1, mak);
                    f32x4 mbr = MF32(fb0, fr0, z4); mbr = MF32(fb1, fr1, mbr);
                    f32x4 mkr = MF32(fk0, fr0, z4); mkr = MF32(fk1, fr1, mkr);
#pragma unroll
                    for (int j = 0; j < 4; ++j) {
                        const int s_ = fq * 4 + j;
                        nA[j] = (s_ < fr) ? nA[j] : 0.f; nB[j] = (fr < s_) ? nB[j] : 0.f; mak[j] = (s_ < fr) ? mak[j] : 0.f;
                        mbr[j] = (s_ <= fr) ? mbr[j] : 0.f; mkr[j] = (s_ <= fr) ? mkr[j] : 0.f;
                    }
                    const sh4 pNA = pk4v(nA), pNB = pk4v(nB), pMak = pk4v(mak), pMbr = pk4v(mbr), pMkr = pk4v(mkr);
                    const f32x4 n2B = MF16(pNA, pNB, z4), n2A = MF16(pNB, pNA, z4);
                    const sh4 pN2A = pk4v(n2A), pN2B = pk4v(n2B);
                    const f32x4 n4B = MF16(pN2A, pN2B, z4), n4A = MF16(pN2B, pN2A, z4);
                    const sh4 pN4A = pk4v(n4A), pN4B = pk4v(n4B);
                    const sh4 pN8A = pk4v(MF16(pN4B, pN4A, z4));
                    const bf16x8 sB0 = cat8(pk4v(S[0]), pk4v(S[1])), sB1 = cat8(pk4v(S[2]), pk4v(S[3]));
                    const sh4 vf = *(const sh4*)(o_vT + (wid * 16 + fr) * SC_LS + sc * 16 + fq * 4);
                    f32x4 X = MF32(cat8(*(const sh4*)(ar + fq * 4), *(const sh4*)(ar + 16 + fq * 4)), sB0, z4);
                    X = MF32(cat8(*(const sh4*)(ar + 32 + fq * 4), *(const sh4*)(ar + 48 + fq * 4)), sB1, X);
                    X = MF16(pMak, vf, X);
                    X = MF16(pN8A, pk4v(X), X); X = MF16(pN4A, pk4v(X), X); X = MF16(pN2A, pk4v(X), X); X = MF16(pNA, pk4v(X), X);
                    const sh4 pSA = pk4v(X);
                    f32x4 O = MF32(cat8(*(const sh4*)(rr_ + fq * 4), *(const sh4*)(rr_ + 16 + fq * 4)), sB0, z4);
                    O = MF32(cat8(*(const sh4*)(rr_ + 32 + fq * 4), *(const sh4*)(rr_ + 48 + fq * 4)), sB1, O);
                    const bf16x8 sav = cat8(pSA, vf);
                    O = MF32(cat8(pMbr, pMkr), sav, O);
#pragma unroll
                    for (int j = 0; j < 4; ++j) s_o[(sc * 16 + fq * 4 + j) * 64 + wid * 16 + fr] = O[j];
#pragma unroll
                    for (int jt = 0; jt < 4; ++jt) {
                        const sh4 ka = *(const sh4*)(o_kT + (jt * 16 + fr) * SC_LS + sc * 16 + fq * 4), ba = *(const sh4*)(o_bT + (jt * 16 + fr) * SC_LS + sc * 16 + fq * 4);
                        f32x4 acc = MF32(cat8(ba, ka), sav, S[jt]);
                        const float4 g4 = *(const float4*)(s_gc + sc * 64 + jt * 16 + fq * 4);
                        acc[0] *= g4.x; acc[1] *= g4.y; acc[2] *= g4.z; acc[3] *= g4.w;
                        S[jt] = acc;
                    }
                }
            }
        }
        lds_barrier();
        {
            const int tau = tid >> 4, c4 = (tid & 15) * 4, e = tau * 64 + c4;
            const size_t n = (size_t)b * TS + t0 + tau;
            const float4 o4 = *(const float4*)(s_o + e), v4_ = *(const float4*)(s_v + e), g4_ = *(const float4*)(s_g + e);
            const float4 clw = *(const float4*)(cst + 800 + c4), clb = *(const float4*)(cst + 864 + c4);
            const float bsum = s_bs[tau];
            const float m_ = row16_sum((o4.x + o4.y) + (o4.z + o4.w)) * (1.0f / 64.0f);
            const float d0 = o4.x - m_, d1 = o4.y - m_, d2 = o4.z - m_, d3 = o4.w - m_;
            const float var = row16_sum(d0 * d0 + d1 * d1 + d2 * d2 + d3 * d3) * (1.0f / 64.0f);
            const float rs = rsqrtf(var + 64e-5f);
            const float y0 = (d0 * rs * clw.x + clb.x + bsum * v4_.x) * g4_.x, y1 = (d1 * rs * clw.y + clb.y + bsum * v4_.y) * g4_.y;
            const float y2 = (d2 * rs * clw.z + clb.z + bsum * v4_.z) * g4_.z, y3 = (d3 * rs * clw.w + clb.w + bsum * v4_.w) * g4_.w;
            if (tau < nval) *(uint2*)(Pr + n * 1024 + hc + c4) = pack4(y0, y1, y2, y3);
        }
    }
}

__device__ __forceinline__ void xcd_panel_map(int& mt0, int& mstep, int& nt) {
    const int b = obid(), G = (int)gridDim.x;
    if (G == 256) { nt = (b >> 3) & 7; mt0 = (b & 7) * 4 + (b >> 6); mstep = 32; }
    else { nt = b & 7; mt0 = b >> 3; mstep = G >> 3; }
}
__device__ void phase_merge(const Params& p, unsigned char* lds) {
    const int tid = otid(), lane = tid & 63, wid = tid >> 6, wr = wid >> 1, wc = wid & 1, fr = lane & 15, fq = lane >> 4;
    const bf16_t* h = (const bf16_t*)(WS(p) + OFF_H);
    const bf16_t* wb = (const bf16_t*)(WS(p) + OFF_WB);
    const float* rstd = (const float*)(WS(p) + OFF_RSTD);
    bf16_t* merged = (bf16_t*)(WS(p) + OFF_MERGED);
    const bf16_t* ysrc0 = (const bf16_t*)(WS(p) + OFF_PPOOL);
    const bf16_t* ysrc1 = (const bf16_t*)(WS(p) + OFF_PR);
    const bf16_t* ysrc2 = (const bf16_t*)(OUTB(p) + DO_YC);
    for (int tile = obid(); tile < 86 * 8; tile += gridDim.x) {
        const int mt = tile >> 3, nt = tile & 7;
        const int row0 = mt * 192, col0 = nt * 128;
        uint2 maccp[3][4];
#pragma unroll
        for (int m = 0; m < 3; ++m)
#pragma unroll
            for (int n = 0; n < 4; ++n) maccp[m][n] = make_uint2(0u, 0u);
#pragma unroll 1
        for (int i = 0; i < 3; ++i) {
            const bf16_t* ys = (i == 0) ? ysrc0 : (i == 1 ? ysrc1 : ysrc2);
            uint2 sg[3][4];
            {
                f32x4 ag[3][4]; g3_zero<3>(ag);
                G3<192> g;
                g3_setup<192>(g, [&](int r) { return h + (size_t)(row0 + r) * DM; }, [&](int r) { return wb + WB_WG + (size_t)(i * 1024 + col0 + r) * DM; }, tid);
                g3_kloop<192>(ag, g, DM, lds);
#pragma unroll
                for (int m = 0; m < 3; ++m) {
                    const float rs = rstd[row0 + wr * 48 + m * 16 + fr];
#pragma unroll
                    for (int n = 0; n < 4; ++n) sg[m][n] = pack4(fast_sigmoid(ag[m][n][0] * rs), fast_sigmoid(ag[m][n][1] * rs), fast_sigmoid(ag[m][n][2] * rs), fast_sigmoid(ag[m][n][3] * rs));
                }
            }
            {
                f32x4 ay[3][4]; g3_zero<3>(ay);
                G3<192> g;
                g3_setup<192>(g, [&](int r) { return ys + (size_t)(row0 + r) * DM; }, [&](int r) { return wb + WB_PA + (size_t)(i * 1024 + col0 + r) * DM; }, tid);
                g3_kloop<192>(ay, g, DM, lds);
#pragma unroll
                for (int m = 0; m < 3; ++m)
#pragma unroll
                    for (int n = 0; n < 4; ++n) {
                        const float m0 = __uint_as_float(maccp[m][n].x << 16) + __uint_as_float(sg[m][n].x << 16) * ay[m][n][0];
                        const float m1 = __uint_as_float(maccp[m][n].x & 0xFFFF0000u) + __uint_as_float(sg[m][n].x & 0xFFFF0000u) * ay[m][n][1];
                        const float m2 = __uint_as_float(maccp[m][n].y << 16) + __uint_as_float(sg[m][n].y << 16) * ay[m][n][2];
                        const float m3 = __uint_as_float(maccp[m][n].y & 0xFFFF0000u) + __uint_as_float(sg[m][n].y & 0xFFFF0000u) * ay[m][n][3];
                        maccp[m][n] = pack4(m0, m1, m2, m3);
                    }
            }
        }
#pragma unroll
        for (int m = 0; m < 3; ++m) {
            const int row = row0 + wr * 48 + m * 16 + fr;
#pragma unroll
            for (int n = 0; n < 4; ++n)
                *(uint2*)(merged + (size_t)row * 1024 + col0 + wc * 64 + n * 16 + fq * 4) = maccp[m][n];
        }
    }
}

__device__ void phase_outproj(const Params& p, unsigned char* lds) {
    const int tid = otid(), lane = tid & 63, wid = tid >> 6, wr = wid >> 1, wc = wid & 1, fr = lane & 15, fq = lane >> 4;
    const bf16_t* h = (const bf16_t*)(WS(p) + OFF_H);
    const bf16_t* wb = (const bf16_t*)(WS(p) + OFF_WB);
    const bf16_t* merged = (const bf16_t*)(WS(p) + OFF_MERGED);
    float* hm = (float*)(WS(p) + OFF_HM32);
    int mt0, mstep, nt;
    xcd_panel_map(mt0, mstep, nt);
    for (int mt = mt0; mt < 86; mt += mstep) {
        const int row0 = mt * 192, col0 = nt * 128;
        G3<192> g;
        g3_setup<192>(g, [&](int r) { return merged + (size_t)(row0 + r) * DM; }, [&](int r) { return wb + WB_WO + (size_t)(col0 + r) * DM; }, tid);
        f32x4 acc[3][4]; g3_zero<3>(acc);
        g3_kloop<192>(acc, g, DM, lds);
#pragma unroll
        for (int m = 0; m < 3; ++m) {
            const int row = row0 + wr * 48 + m * 16 + fr;
#pragma unroll
            for (int n = 0; n < 4; ++n) {
                const int col = col0 + wc * 64 + n * 16 + fq * 4;
                const uint2 hv = *(const uint2*)(h + (size_t)row * 1024 + col);
                float4 o;
                o.x = __uint_as_float(hv.x << 16) + acc[m][n][0]; o.y = __uint_as_float(hv.x & 0xFFFF0000u) + acc[m][n][1];
                o.z = __uint_as_float(hv.y << 16) + acc[m][n][2]; o.w = __uint_as_float(hv.y & 0xFFFF0000u) + acc[m][n][3];
                *(float4*)(hm + (size_t)row * 1024 + col) = o;
            }
        }
    }
}

__device__ __constant__ int c_pair_lo[6] = {0, 0, 0, 1, 1, 2};
__device__ __constant__ int c_pair_hi[6] = {1, 2, 3, 2, 3, 3};
__device__ void phase_route(const Params& p, int l, unsigned char* lds) {
    const int tid = otid(), lane = tid & 63, wid = tid >> 6;
    const int per = (NT + (int)gridDim.x - 1) / (int)gridDim.x;
    const int nbeg = obid() * per, nend = (nbeg + per < NT) ? nbeg + per : NT;
    int* s_cls = (int*)lds;
    int* s_base = s_cls + 512;
    float* s_wr = (float*)(lds + 4096);
    const float* hm = (const float*)(WS(p) + OFF_HM32);
    bf16_t* hn = (bf16_t*)(WS(p) + OFF_HN);
    const float* nf = p.in[33] + (size_t)l * 1024;
    const float* wg = p.in[34] + (size_t)l * 1024 * 4;
    const float* bg = p.in[35] + l * 4;
    const float* we = p.in[36] + (size_t)l * 1024 * 16;
    const float* be = p.in[37] + l * 16;
    int* cnt = (int*)(WS(p) + OFF_CTL);
    int* list = (int*)(WS(p) + OFF_LIST);
    float* pw = (float*)(WS(p) + OFF_PW);
    for (int e = tid; e < 1024 * 20; e += NTHR) {
        const int k = e / 20, c = e - k * 20;
        s_wr[c * 1024 + k] = (c < 4) ? wg[(size_t)k * 4 + c] : we[(size_t)k * 16 + (c - 4)];
    }
    __syncthreads();
    for (int n = nbeg + wid; n < nend; n += 8) {
        float ss = 0.f;
#pragma unroll
        for (int i = 0; i < 4; ++i) {
            const float4 v = *(const float4*)(hm + (size_t)n * DM + i * 256 + lane * 4);
            ss += v.x * v.x + v.y * v.y + v.z * v.z + v.w * v.w;
        }
        ss = wave_sum(ss);
        const float rs = rsqrtf(ss * (1.0f / 1024.0f) + 1e-6f);
        float lg[4] = {0.f, 0.f, 0.f, 0.f};
        float le[16];
#pragma unroll
        for (int e = 0; e < 16; ++e) le[e] = 0.f;
#pragma unroll 1
        for (int i = 0; i < 4; ++i) {
            const float4 xv = *(const float4*)(hm + (size_t)n * DM + i * 256 + lane * 4);
            const float4 nv = *(const float4*)(nf + i * 256 + lane * 4);
            float y[4] = {xv.x * rs * nv.x, xv.y * rs * nv.y, xv.z * rs * nv.z, xv.w * rs * nv.w};
            {
                const int d0 = i * 256 + lane * 4;
#pragma unroll
                for (int g = 0; g < 4; ++g) { const float4 w4 = *(const float4*)(s_wr + g * 1024 + d0); lg[g] += y[0] * w4.x + y[1] * w4.y + y[2] * w4.z + y[3] * w4.w; }
#pragma unroll
                for (int e = 0; e < 16; ++e) { const float4 w4 = *(const float4*)(s_wr + (4 + e) * 1024 + d0); le[e] += y[0] * w4.x + y[1] * w4.y + y[2] * w4.z + y[3] * w4.w; }
            }
            *(uint2*)(hn + (size_t)n * DM + i * 256 + lane * 4) = pack4(y[0], y[1], y[2], y[3]);
        }
#pragma unroll
        for (int g = 0; g < 4; ++g) lg[g] = wave_sum_fast(lg[g]) + bg[g];
#pragma unroll
        for (int e = 0; e < 16; ++e) le[e] = wave_sum_fast(le[e]) + be[e];
        if (lane == 0) {
            int gs = 0; float gm = lg[0];
#pragma unroll
            for (int g = 1; g < 4; ++g) if (lg[g] > gm) { gm = lg[g]; gs = g; }
            float den = 0.f;
#pragma unroll
            for (int g = 0; g < 4; ++g) den += __expf(lg[g] - gm);
            const float pgrp = 1.0f / den;
            float v4[4];
#pragma unroll
            for (int e = 0; e < 4; ++e) {
                const float m0 = (gs == 0) ? 1.f : 0.f, m1s = (gs == 1) ? 1.f : 0.f, m2s = (gs == 2) ? 1.f : 0.f, m3s = (gs == 3) ? 1.f : 0.f;
                v4[e] = le[e] * m0 + le[4 + e] * m1s + le[8 + e] * m2s + le[12 + e] * m3s;
            }
            int i1 = 0; float m1 = v4[0];
#pragma unroll
            for (int e = 1; e < 4; ++e) if (v4[e] > m1) { m1 = v4[e]; i1 = e; }
            int i2 = -1; float m2 = -INFINITY;
#pragma unroll
            for (int e = 0; e < 4; ++e) if (e != i1 && v4[e] > m2) { m2 = v4[e]; i2 = e; }
            const float e2 = __expf(m2 - m1);
            const float p1 = pgrp / (1.0f + e2), p2 = pgrp * e2 / (1.0f + e2);
            const int lo = i1 < i2 ? i1 : i2, hi = i1 < i2 ? i2 : i1;
            const float plo = i1 < i2 ? p1 : p2, phi = i1 < i2 ? p2 : p1;
            const int pi = (lo == 0) ? (hi - 1) : (lo == 1 ? hi + 1 : 5);
            const int cls = gs * 6 + pi;
            s_cls[n - nbeg] = cls;
            pw[(size_t)n * 2 + 0] = plo; pw[(size_t)n * 2 + 1] = phi;
        }
    }
    __syncthreads();
    const int nloc = nend - nbeg;
    if (tid < 24) {
        int c_ = 0;
        for (int i = 0; i < nloc; ++i) c_ += (s_cls[i] == tid) ? 1 : 0;
        s_base[tid] = c_ ? atomicAdd(&cnt[tid * 32], c_) : 0;
    }
    __syncthreads();
    for (int it = tid; it < nloc; it += NTHR) {
        const int cls = s_cls[it];
        int rank = 0;
        for (int i = 0; i < it; ++i) rank += (s_cls[i] == cls) ? 1 : 0;
        list[(size_t)cls * NT + s_base[cls] + rank] = nbeg + it;
    }
    __syncthreads();
}


struct MoeTile { int cls, ti, cnt, tg; };
__device__ __forceinline__ int moe_total_tiles(const int* cnt) { int s = 0; for (int c = 0; c < 24; ++c) s += (cnt[c * 32] + 127) >> 7; return s; }
__device__ __forceinline__ MoeTile moe_find(const int* cnt, int tile) {
    MoeTile r; int s = 0; r.cls = 0; r.ti = 0; r.cnt = 0; r.tg = tile;
    for (int c = 0; c < 24; ++c) { const int nt = (cnt[c * 32] + 127) >> 7; if (tile >= s && tile < s + nt) { r.cls = c; r.ti = tile - s; r.cnt = cnt[c * 32]; } s += nt; }
    return r;
}
__device__ void phase_moe1(const Params& p, unsigned char* lds) {
    const int tid = otid(), lane = tid & 63, wid = tid >> 6, wr = wid >> 1, wc = wid & 1, fr = lane & 15, fq = lane >> 4;
    const int* cnt = (const int*)(WS(p) + OFF_CTL);
    const int* list = (const int*)(WS(p) + OFF_LIST);
    const float* pw = (const float*)(WS(p) + OFF_PW);
    const bf16_t* hn = (const bf16_t*)(WS(p) + OFF_HN);
    const bf16_t* we = (const bf16_t*)(WS(p) + OFF_WEXP);
    bf16_t* hid = (bf16_t*)(OUTB(p) + DO_HID);
    const int total = moe_total_tiles(cnt);
    for (int item = obid(); item < total * 4; item += gridDim.x) {
        const MoeTile mt = moe_find(cnt, item >> 2);
        const int nt = item & 3, slot = nt >> 1, f0 = (nt & 1) * 128;
        const int g_ = mt.cls / 6, pi = mt.cls % 6;
        const int e = g_ * 4 + (slot == 0 ? c_pair_lo[pi] : c_pair_hi[pi]);
        const int* lst = list + (size_t)mt.cls * NT + mt.ti * 128;
        const int nvalid = min(128, mt.cnt - mt.ti * 128);
        f32x4 a1[2][4], a3[2][4]; g3_zero<2>(a1); g3_zero<2>(a3);
        G3D g;
#pragma unroll
        for (int i = 0; i < 2; ++i) {
            const int idx = tid + i * NTHR, row = idx >> 3, sl = (idx & 7) ^ (row & 7);
            g.ap[i] = hn + (size_t)lst[row < nvalid ? row : 0] * DM + sl * 8;
            g.b1[i] = we + WE_W1 + ((size_t)e * 256 + f0 + row) * 1024 + sl * 8;
            g.b3[i] = we + WE_W3 + ((size_t)e * 256 + f0 + row) * 1024 + sl * 8;
        }
        g3d_kloop(a1, a3, g, DM, lds);
#pragma unroll
        for (int m = 0; m < 2; ++m) {
            const int lr = wr * 32 + m * 16 + fr;
            const int tk = lst[lr < nvalid ? lr : 0];
            const float pe = pw[(size_t)tk * 2 + slot];
#pragma unroll
            for (int n = 0; n < 4; ++n) {
                const int col = slot * 256 + f0 + wc * 64 + n * 16 + fq * 4;
                float o[4];
#pragma unroll
                for (int j = 0; j < 4; ++j) { const float x1 = a1[m][n][j]; o[j] = x1 * sigmoidf_(x1) * a3[m][n][j] * pe; }
                *(uint2*)(hid + ((size_t)mt.tg * 128 + lr) * 512 + col) = pack4(o[0], o[1], o[2], o[3]);
            }
        }
    }
}
__device__ void phase_moe2(const Params& p, unsigned char* lds) {
    const int tid = otid(), lane = tid & 63, wid = tid >> 6, wr = wid >> 1, wc = wid & 1, fr = lane & 15, fq = lane >> 4;
    const int* cnt = (const int*)(WS(p) + OFF_CTL);
    const int* list = (const int*)(WS(p) + OFF_LIST);
    const bf16_t* we = (const bf16_t*)(WS(p) + OFF_WEXP);
    const bf16_t* hid = (const bf16_t*)(OUTB(p) + DO_HID);
    float* hm = (float*)(WS(p) + OFF_HM32);
    bf16_t* h = (bf16_t*)(WS(p) + OFF_H);
    const int total = moe_total_tiles(cnt);
    for (int item = obid(); item < total * 8; item += gridDim.x) {
        const MoeTile mt = moe_find(cnt, item >> 3);
        const int nt = item & 7, col0 = nt * 128;
        const int g_ = mt.cls / 6, pi = mt.cls % 6;
        const int elo = g_ * 4 + c_pair_lo[pi], ehi = g_ * 4 + c_pair_hi[pi];
        const int* lst = list + (size_t)mt.cls * NT + mt.ti * 128;
        const int nvalid = min(128, mt.cnt - mt.ti * 128);
        f32x4 acc[2][4]; g3_zero<2>(acc);
        G3<128> g;
        g3_setup<128>(g, [&](int r) { return hid + ((size_t)mt.tg * 128 + r) * 512; }, [&](int r) { return we + WE_W2 + ((size_t)elo * 1024 + col0 + r) * 256; }, tid);
        g3_kloop<128>(acc, g, 256, lds);
        g3_setup<128>(g, [&](int r) { return hid + ((size_t)mt.tg * 128 + r) * 512 + 256; }, [&](int r) { return we + WE_W2 + ((size_t)ehi * 1024 + col0 + r) * 256; }, tid);
        g3_kloop<128>(acc, g, 256, lds);
#pragma unroll
        for (int m = 0; m < 2; ++m) {
            const int lr = wr * 32 + m * 16 + fr;
            if (lr < nvalid) {
                const int tk = lst[lr];
#pragma unroll
                for (int n = 0; n < 4; ++n) {
                    const int col = col0 + wc * 64 + n * 16 + fq * 4;
                    float4 v = *(const float4*)(hm + (size_t)tk * 1024 + col);
                    v.x += acc[m][n][0]; v.y += acc[m][n][1]; v.z += acc[m][n][2]; v.w += acc[m][n][3];
                    *(float4*)(hm + (size_t)tk * 1024 + col) = v;
                    *(uint2*)(h + (size_t)tk * 1024 + col) = pack4(v.x, v.y, v.z, v.w);
                }
            }
        }
    }
}

__device__ void phase_final(const Params& p) {
    const int lane = otid() & 63;
    const int wave = (obid() * NTHR + otid()) >> 6, nw = gridDim.x * NTHR / 64;
    const float* hm = (const float*)(WS(p) + OFF_HM32);
    const float* nf = p.in[41];
    for (int r = wave; r < NB * SEQ; r += nw) {
        const int b = r / SEQ, s = r % SEQ;
        const size_t n = (size_t)b * TS + NMETA + s;
        float4 v[4]; float ss = 0.f;
#pragma unroll
        for (int i = 0; i < 4; ++i) { v[i] = *(const float4*)(hm + n * DM + i * 256 + lane * 4); ss += v[i].x * v[i].x + v[i].y * v[i].y + v[i].z * v[i].z + v[i].w * v[i].w; }
        ss = wave_sum(ss);
        const float rs = rsqrtf(ss * (1.0f / 1024.0f) + 1e-6f);
#pragma unroll
        for (int i = 0; i < 4; ++i) {
            const float4 g = *(const float4*)(nf + i * 256 + lane * 4);
            float4 o; o.x = v[i].x * rs * g.x; o.y = v[i].y * rs * g.y; o.z = v[i].z * rs * g.z; o.w = v[i].w * rs * g.w;
            *(float4*)((float*)OUTB(p) + (size_t)r * DM + i * 256 + lane * 4) = o;
        }
    }
}


#define XB_TMO      128
#define XB_XCNT(j)  (256  + 64 * (j))
#define XB_XSUB(j)  (1280 + 64 * (j))
#define XB_XGEN(j)  (2304 + 64 * (j))
#define XB_TOP      3328
#define XB_TOPGEN   3392
#define XCD_BAR_WORDS 3456
#define XB_SPIN_CAP (1u << 22)
#define LAS __attribute__((address_space(3)))
__device__ __forceinline__ unsigned xb_ld(unsigned* p) { return __hip_atomic_load(p, __ATOMIC_RELAXED, __HIP_MEMORY_SCOPE_AGENT); }
__device__ __forceinline__ unsigned xb_add(unsigned* p, unsigned v) { return __hip_atomic_fetch_add(p, v, __ATOMIC_RELAXED, __HIP_MEMORY_SCOPE_AGENT); }
__device__ __forceinline__ unsigned xb_xcc_id() { return (unsigned)__builtin_amdgcn_s_getreg((3 << 11) | 20) & 0xFu; }
#define XB_SPIN(cond, bar) do { unsigned _sp = 0; while (cond) { __builtin_amdgcn_s_sleep(1); \
    if ((++_sp & 255u) == 0u) { if (xb_ld(&(bar)[XB_TMO])) break; if (_sp > XB_SPIN_CAP) { atomicAdd(&(bar)[XB_TMO], 1u); break; } } } } while (0)
struct XcdBarrier { unsigned* bar; unsigned x; volatile LAS unsigned* st; };
__device__ __forceinline__ XcdBarrier xcd_barrier_post(unsigned* bar, volatile LAS unsigned* st) {
    XcdBarrier b; b.bar = bar; b.x = xb_xcc_id(); b.st = st;
    if (threadIdx.x == 0) (void)xb_add(&bar[XB_XCNT(b.x)], 1u);
    return b;
}
__device__ __forceinline__ void xcd_barrier_complete(unsigned* bar, unsigned x, unsigned& nloc, unsigned& nx) {
    const unsigned G = gridDim.x * gridDim.y * gridDim.z;
    unsigned sum, cnt, mine, sp = 0u;
    for (;;) {
        sum = 0u; cnt = 0u; mine = 0u;
#pragma unroll
        for (unsigned j = 0; j < 16; ++j) { const unsigned c = xb_ld(&bar[XB_XCNT(j)]); sum += c; cnt += (c > 0u) ? 1u : 0u; mine = (j == x) ? c : mine; }
        if (sum == G) break;
        __builtin_amdgcn_s_sleep(1);
        if ((++sp & 255u) == 0u) { if (xb_ld(&bar[XB_TMO])) break; if (sp > XB_SPIN_CAP) { atomicAdd(&bar[XB_TMO], 1u); break; } }
    }
    nloc = mine > 0u ? mine : 1u; nx = cnt > 0u ? cnt : 1u;
}
__device__ __forceinline__ void xcd_barrier(const XcdBarrier& b) {
    asm volatile("s_waitcnt vmcnt(0)" ::: "memory");
    __syncthreads();
    if (threadIdx.x == 0) {
        unsigned* bar = b.bar;
        __builtin_amdgcn_s_waitcnt(0);
        unsigned nloc = b.st[0], nx = b.st[1];
        if (nloc == 0u) { xcd_barrier_complete(bar, b.x, nloc, nx); b.st[0] = nloc; b.st[1] = nx; }
        const unsigned old = xb_add(&bar[XB_XSUB(b.x)], 1u);
        const unsigned gen = old / nloc;
        if (old + 1u == (gen + 1u) * nloc) {
            __builtin_amdgcn_fence(__ATOMIC_RELEASE, "agent");
            asm volatile("s_waitcnt vmcnt(0)" ::: "memory");
            const unsigned og = xb_add(&bar[XB_TOP], 1u);
            const unsigned tg = og / nx;
            if (og + 1u == (tg + 1u) * nx) xb_add(&bar[XB_TOPGEN], 1u);
            else XB_SPIN(xb_ld(&bar[XB_TOPGEN]) == tg, bar);
            __builtin_amdgcn_fence(__ATOMIC_ACQUIRE, "agent");
            xb_add(&bar[XB_XGEN(b.x)], 1u);
            asm volatile("s_waitcnt vmcnt(0)" ::: "memory");
        } else {
            XB_SPIN(xb_ld(&bar[XB_XGEN(b.x)]) == gen, bar);
            __builtin_amdgcn_fence(__ATOMIC_ACQUIRE, "agent");
            asm volatile("s_waitcnt vmcnt(0)" ::: "memory");
        }
    }
    __syncthreads();
}

__global__ void __launch_bounds__(NTHR) fwd_megakernel(Params p) {
    extern __shared__ __attribute__((aligned(16))) unsigned char lds[];
    cg::grid_group grid = cg::this_grid();
    volatile LAS unsigned* xst = (volatile LAS unsigned*)(lds + LDS_BYTES - 32);
    if (threadIdx.x < 2) xst[threadIdx.x] = 0u;
    __syncthreads();
    const XcdBarrier xb = xcd_barrier_post((unsigned*)(p.ws + OFF_BAR), xst);
    if (p.out == nullptr) grid.sync();
#pragma unroll 1
    for (int step = 0; step < 18; ++step) {
        const int l = step >= 9 ? 1 : 0;
        const int ph = step - l * 9;
        switch (ph) {
        case 0:
            if (l == 0) phase_embed(p); else phase_rowstat(p);
            phase_convert<false>(p, l, lds);
            if (obid() == 0 && otid() < 24) ((int*)(WS(p) + OFF_CTL))[otid() * 32] = 0;
            if (obid() == 0 && otid() == 32) ((int*)(WS(p) + OFF_CTL))[800 + l * 32] = 0;
            break;
        case 1: phase_inproj(p, lds); break;
        case 2: phase_dsa_prep(p, l); phase_lr_prep(p, l); break;
        case 3: {
            if (obid() < NB * 16) phase_scan5(p, l, lds, obid());
            int* qctr = (int*)(WS(p) + OFF_CTL) + 800 + l * 32;
            int* qslot = (int*)(lds + LDS_BYTES - 16);
            for (;;) {
                __syncthreads();
                if (otid() == 0) *qslot = atomicAdd(qctr, 1);
                __syncthreads();
                const int item = *qslot;
                if (item >= 516 + NT / 16 + 3072) break;
                if (item < 516) phase_pool(p, l, lds, item, item + 1, 1);
                else if (item < 516 + NT / 16) phase_dsa<false>(p, l, lds, (bf16_t*)(OUTB(p) + DO_YC), nullptr, nullptr, item - 516, item - 515, 1);
                else {
                    const int ct = item - (516 + NT / 16);
                    const ConvJob cj = get_job_late(p, l, ct >> 10);
                    conv_tile(cj, ct & 1023, (float*)lds);
                }
            }
        } break;
        case 4: phase_merge(p, lds); break;
        case 5: phase_outproj(p, lds); break;
        case 6: phase_route(p, l, lds); break;
        case 7: phase_moe1(p, lds); break;
        default: phase_moe2(p, lds); break;
        }
        xcd_barrier(xb);
    }
    phase_final(p);
}

extern "C" void kernel_launch(void* const* d_in, const int* in_sizes, int n_in,
                              void* d_out, int out_size, void* d_ws, size_t ws_size,
                              hipStream_t stream) {
    static int grid_blocks = 0;
    if (grid_blocks == 0) {
        int dev = 0, cus = 0, per_cu = 0;
        (void)hipGetDevice(&dev);
        (void)hipDeviceGetAttribute(&cus, hipDeviceAttributeMultiprocessorCount, dev);
        (void)hipFuncSetAttribute((const void*)fwd_megakernel, hipFuncAttributeMaxDynamicSharedMemorySize, LDS_BYTES);
        (void)hipOccupancyMaxActiveBlocksPerMultiprocessor(&per_cu, fwd_megakernel, NTHR, LDS_BYTES);
        if (per_cu < 1 || cus < NB * 16 || (cus & 7) != 0 || n_in != 42 || ws_size < WS_END) { fprintf(stderr, "kernel_launch: bad config per_cu=%d n_in=%d ws=%zu need=%zu\n", per_cu, n_in, ws_size, (size_t)WS_END); grid_blocks = -1; }
        else grid_blocks = cus;
    }
    if (grid_blocks < 0) return;
    Params p{};
    for (int i = 0; i < 42; ++i) p.in[i] = (const float*)d_in[i];
    p.out = (float*)d_out;
    p.ws = (unsigned char*)d_ws;
    (void)hipMemsetAsync((unsigned char*)d_ws + OFF_BAR, 0, XCD_BAR_WORDS * 4, stream);
    void* args[] = {&p};
    hipError_t e = hipLaunchCooperativeKernel((void*)fwd_megakernel, dim3(grid_blocks), dim3(NTHR), args, LDS_BYTES, stream);
    if (e != hipSuccess) fprintf(stderr, "cooperative launch failed: %s (grid %d)\n", hipGetErrorString(e), grid_blocks);
}
```

```cpp
#include <hip/hip_runtime.h>
#include <hip/hip_cooperative_groups.h>
#include <cstdio>
#include <cstdint>
#include <type_traits>
namespace cg = cooperative_groups;

typedef unsigned short bf16_t;
typedef short bf16x8 __attribute__((ext_vector_type(8)));
typedef float f32x4 __attribute__((ext_vector_type(4)));

constexpr int NB = 8, SEQ = 2048, NMETA = 16, TS = 2064, DM = 1024;
constexpr int NT = NB * TS;
constexpr int NTP = 16640;
constexpr int NTHR = 512;
constexpr int CIN = 7912;
constexpr int NP1 = 4864;
constexpr int PM_LD = 768;
constexpr int PM_WD = 0, PM_AD = 64, PM_GD = 128, PM_VD = 256, PM_CQ = 288, PM_CKV = 544, PM_KROPE = 672, PM_KIDX = 704;
constexpr int LDS_BYTES = 157 * 1024;

constexpr size_t AL(size_t x) { return (x + 255) & ~(size_t)255; }
constexpr size_t SZ_ACT = (size_t)NTP * 1024 * 2;
constexpr size_t OFF_CTL = 0;
constexpr size_t OFF_BAR = 4096;
constexpr size_t OFF_RSTD = OFF_BAR + 16384;
constexpr size_t OFF_ROPE = OFF_RSTD + AL((size_t)NTP * 4);
constexpr size_t OFF_H = OFF_ROPE + AL((size_t)TS * 16 * 4 * 2);
constexpr size_t OFF_WB = OFF_H + SZ_ACT;
constexpr size_t WB_WIN = 0;
constexpr size_t WB_WG = WB_WIN + (size_t)NP1 * 1024;
constexpr size_t WB_PA = WB_WG + (size_t)3072 * 1024;
constexpr size_t WB_WO = WB_PA + (size_t)3 * 1024 * 1024;
constexpr size_t WB_POOL = WB_WO + (size_t)1024 * 1024;
constexpr size_t WB_QI = WB_POOL + (size_t)4 * 256 * 256;
constexpr size_t WB_UQ = WB_QI + (size_t)512 * 256;
constexpr size_t WB_UK = WB_UQ + (size_t)1536 * 256;
constexpr size_t WB_UV = WB_UK + (size_t)16 * 128 * 64;
constexpr size_t WB_WIDX = WB_UV + (size_t)16 * 64 * 128;
constexpr size_t WB_END = WB_WIDX + (size_t)64 * 1024;
constexpr size_t OFF_PPOOL = OFF_WB + AL(WB_END * 2);
constexpr size_t OFF_PK = OFF_PPOOL + SZ_ACT;
constexpr size_t OFF_PR = OFF_PK + SZ_ACT;
constexpr size_t OFF_PV = OFF_PR + SZ_ACT;
constexpr size_t OFF_PMISC = OFF_PV + SZ_ACT;
constexpr size_t OFF_VFIRST = OFF_PMISC + AL((size_t)NTP * PM_LD * 2);
constexpr size_t OFF_HALO = OFF_VFIRST + SZ_ACT;
constexpr size_t OFF_LIST = OFF_HALO + AL((size_t)130 * 16 * 1024 * 2);
constexpr size_t OFF_PW = OFF_LIST + AL((size_t)24 * NT * 4);
constexpr size_t WS_END = OFF_PW + AL((size_t)NT * 2 * 4);
constexpr size_t OFF_MERGED = OFF_PK;
constexpr size_t OFF_HM32 = OFF_PR;
constexpr size_t OFF_HN = OFF_PPOOL;
constexpr size_t OFF_WEXP = OFF_PMISC;
constexpr size_t WE_W1 = 0, WE_W3 = (size_t)16 * 256 * 1024, WE_W2 = (size_t)2 * 16 * 256 * 1024;
static_assert((size_t)3 * 16 * 256 * 1024 * 2 <= (size_t)NTP * PM_LD * 2, "expert weights must fit in Pmisc");
constexpr size_t DO_YC = 0;
constexpr size_t DO_CQN = DO_YC + SZ_ACT;
constexpr size_t DO_KV = DO_CQN + AL((size_t)NT * 256 * 2);
constexpr size_t DO_KIDX = DO_KV + AL((size_t)NT * 160 * 2);
constexpr size_t DO_WHEAD = DO_KIDX + AL((size_t)NT * 64 * 2);
constexpr size_t DO_ALR = DO_WHEAD + AL((size_t)NT * 8 * 4);
constexpr size_t DO_END = DO_ALR + AL((size_t)NT * 288 * 2);
constexpr size_t DO_HID = DO_YC;
static_assert(DO_END <= (size_t)NB * SEQ * DM * 4, "d_out scratch overflow");
static_assert((size_t)(129 + 24) * 128 * 512 * 2 <= SZ_ACT, "hid fits");
static_assert(WS_END <= 277240096ull, "workspace overflow");

struct Params {
    const float* in[42];
    float* out;
    unsigned char* ws;
};

__device__ __forceinline__ int otid() { int t = threadIdx.x; asm volatile("" : "+v"(t)); return t; }
__device__ __forceinline__ int obid() { int b = blockIdx.x; asm volatile("" : "+s"(b)); return b; }
__device__ __forceinline__ unsigned char* WS(const Params& p) { unsigned char* w = p.ws; asm volatile("" : "+s"(w)); return w; }
__device__ __forceinline__ unsigned char* OUTB(const Params& p) { unsigned char* w = (unsigned char*)p.out; asm volatile("" : "+s"(w)); return w; }
__device__ __forceinline__ float bf2f(bf16_t v) { return __uint_as_float(((unsigned)v) << 16); }
typedef float f32x2v __attribute__((ext_vector_type(2)));
typedef __bf16 bf16x2v __attribute__((ext_vector_type(2)));
__device__ __forceinline__ unsigned pk2(float a, float b) { const f32x2v v = {a, b}; const bf16x2v r = __builtin_convertvector(v, bf16x2v); unsigned u; __builtin_memcpy(&u, &r, 4); return u; }
__device__ __forceinline__ bf16_t f2bf(float f) { const __bf16 h = (__bf16)f; bf16_t u; __builtin_memcpy(&u, &h, 2); return u; }
__device__ __forceinline__ float wave_sum(float v) {
#pragma unroll
    for (int o = 32; o > 0; o >>= 1) v += __shfl_xor(v, o);
    return v;
}
template <int CTRL> __device__ __forceinline__ float dpp_f(float x) {
    return __int_as_float(__builtin_amdgcn_update_dpp(0, __float_as_int(x), CTRL, 0xF, 0xF, true));
}
__device__ __forceinline__ float row16_sum(float v) {
    v += dpp_f<0xB1>(v);
    v += dpp_f<0x4E>(v);
    v += dpp_f<0x141>(v);
    v += dpp_f<0x140>(v);
    return v;
}
__device__ __forceinline__ void lds_barrier() { asm volatile("s_waitcnt lgkmcnt(0)" ::: "memory"); __builtin_amdgcn_s_barrier(); asm volatile("" ::: "memory"); }
__device__ __forceinline__ float fast_rcp(float x) { return __builtin_amdgcn_rcpf(x); }
__device__ __forceinline__ float fast_sigmoid(float x) { return fast_rcp(1.0f + __expf(-x)); }
__device__ __forceinline__ float fast_tanh(float x) { return 1.0f - 2.0f * fast_rcp(1.0f + __expf(2.0f * x)); }
__device__ __forceinline__ void row16_sum4(float& a, float& b, float& c, float& d) {
    asm volatile(
        "s_nop 1\n\t"
        "v_add_f32_dpp %0, %0, %0 quad_perm:[1,0,3,2] row_mask:0xf bank_mask:0xf\n\t"
        "v_add_f32_dpp %1, %1, %1 quad_perm:[1,0,3,2] row_mask:0xf bank_mask:0xf\n\t"
        "v_add_f32_dpp %2, %2, %2 quad_perm:[1,0,3,2] row_mask:0xf bank_mask:0xf\n\t"
        "v_add_f32_dpp %3, %3, %3 quad_perm:[1,0,3,2] row_mask:0xf bank_mask:0xf\n\t"
        "v_add_f32_dpp %0, %0, %0 quad_perm:[2,3,0,1] row_mask:0xf bank_mask:0xf\n\t"
        "v_add_f32_dpp %1, %1, %1 quad_perm:[2,3,0,1] row_mask:0xf bank_mask:0xf\n\t"
        "v_add_f32_dpp %2, %2, %2 quad_perm:[2,3,0,1] row_mask:0xf bank_mask:0xf\n\t"
        "v_add_f32_dpp %3, %3, %3 quad_perm:[2,3,0,1] row_mask:0xf bank_mask:0xf\n\t"
        "v_add_f32_dpp %0, %0, %0 row_half_mirror row_mask:0xf bank_mask:0xf\n\t"
        "v_add_f32_dpp %1, %1, %1 row_half_mirror row_mask:0xf bank_mask:0xf\n\t"
        "v_add_f32_dpp %2, %2, %2 row_half_mirror row_mask:0xf bank_mask:0xf\n\t"
        "v_add_f32_dpp %3, %3, %3 row_half_mirror row_mask:0xf bank_mask:0xf\n\t"
        "v_add_f32_dpp %0, %0, %0 row_mirror row_mask:0xf bank_mask:0xf\n\t"
        "v_add_f32_dpp %1, %1, %1 row_mirror row_mask:0xf bank_mask:0xf\n\t"
        "v_add_f32_dpp %2, %2, %2 row_mirror row_mask:0xf bank_mask:0xf\n\t"
        "v_add_f32_dpp %3, %3, %3 row_mirror row_mask:0xf bank_mask:0xf\n\t"
        "s_nop 1"
        : "+v"(a), "+v"(b), "+v"(c), "+v"(d));
}
__device__ __forceinline__ void row8_sum2(float& a, float& b) {
    asm volatile(
        "s_nop 1\n\t"
        "v_add_f32_dpp %0, %0, %0 quad_perm:[1,0,3,2] row_mask:0xf bank_mask:0xf\n\t"
        "v_add_f32_dpp %1, %1, %1 quad_perm:[1,0,3,2] row_mask:0xf bank_mask:0xf\n\t"
        "s_nop 0\n\t"
        "v_add_f32_dpp %0, %0, %0 quad_perm:[2,3,0,1] row_mask:0xf bank_mask:0xf\n\t"
        "v_add_f32_dpp %1, %1, %1 quad_perm:[2,3,0,1] row_mask:0xf bank_mask:0xf\n\t"
        "s_nop 0\n\t"
        "v_add_f32_dpp %0, %0, %0 row_half_mirror row_mask:0xf bank_mask:0xf\n\t"
        "v_add_f32_dpp %1, %1, %1 row_half_mirror row_mask:0xf bank_mask:0xf\n\t"
        "s_nop 1"
        : "+v"(a), "+v"(b));
}
__device__ __forceinline__ float wave_sum_fast(float v) { v = row16_sum(v); v += __shfl_xor(v, 16); v += __shfl_xor(v, 32); return v; }
__device__ __forceinline__ float sigmoidf_(float x) { return 1.0f / (1.0f + __expf(-x)); }
__device__ __forceinline__ float softplusf_(float z) { return fmaxf(z, 0.f) + log1pf(__expf(-fabsf(z))); }
__device__ __forceinline__ void glds16(const void* g, void* l) {
    __builtin_amdgcn_global_load_lds((const unsigned*)g, (unsigned*)l, 16, 0, 0);
}

__device__ void phase_embed(const Params& p) {
    const int lane = otid() & 63;
    const int wave = (obid() * NTHR + otid()) >> 6, nw = gridDim.x * NTHR / 64;
    bf16_t* h = (bf16_t*)(WS(p) + OFF_H);
    float* rstd = (float*)(WS(p) + OFF_RSTD);
    for (int n = wave; n < NTP; n += nw) {
        if (n < NT) {
            const int b = n / TS, t = n % TS;
            const float* src = t < NMETA ? p.in[1] + (size_t)t * DM : p.in[0] + ((size_t)b * SEQ + (t - NMETA)) * DM;
            float ss = 0.f;
#pragma unroll
            for (int i = 0; i < 4; ++i) {
                const float4 v = *(const float4*)(src + i * 256 + lane * 4);
                ss += v.x * v.x + v.y * v.y + v.z * v.z + v.w * v.w;
                const uint2 o = make_uint2(pk2(v.x, v.y), pk2(v.z, v.w));
                *(uint2*)(h + (size_t)n * DM + i * 256 + lane * 4) = o;
            }
            ss = wave_sum(ss);
            if (lane == 0) rstd[n] = rsqrtf(ss * (1.0f / 1024.0f) + 1e-6f);
        } else {
#pragma unroll
            for (int i = 0; i < 4; ++i) *(ushort4*)(h + (size_t)n * DM + i * 256 + lane * 4) = make_ushort4(0, 0, 0, 0);
            if (lane == 0) rstd[n] = 0.f;
        }
    }
    float* ctab = (float*)(WS(p) + OFF_ROPE);
    float* stab = ctab + TS * 16;
    for (int idx = obid() * NTHR + otid(); idx < TS * 16; idx += gridDim.x * NTHR) {
        const int t = idx >> 4, i = idx & 15;
        const float inv = powf(10000.0f, -(float)(2 * i) / 32.0f);
        const float ang = (float)t * inv;
        ctab[idx] = cosf(ang);
        stab[idx] = sinf(ang);
    }
}

__device__ void phase_rowstat(const Params& p) {
    const int lane = otid() & 63;
    const int wave = (obid() * NTHR + otid()) >> 6, nw = gridDim.x * NTHR / 64;
    const float* hm = (const float*)(WS(p) + OFF_HM32);
    float* rstd = (float*)(WS(p) + OFF_RSTD);
    for (int n = wave; n < NT; n += nw) {
        float ss = 0.f;
#pragma unroll
        for (int i = 0; i < 4; ++i) {
            const float4 v = *(const float4*)(hm + (size_t)n * DM + i * 256 + lane * 4);
            ss += v.x * v.x + v.y * v.y + v.z * v.z + v.w * v.w;
        }
        ss = wave_sum(ss);
        if (lane == 0) rstd[n] = rsqrtf(ss * (1.0f / 1024.0f) + 1e-6f);
    }
}

struct ConvJob { const float* src; bf16_t* dst; const float* scale; int ldsrc, K, nvalid, nrows, nb, notr; size_t sbs, dbs; const float* srcB; int ldB, split; };
__device__ __forceinline__ int conv_job_tiles(const ConvJob& j) { return j.nb * (j.nrows >> 6) * (j.K >> 6); }
__device__ void conv_tile(const ConvJob& j, int tile, float* lds) {
    const int per = (j.nrows >> 6) * (j.K >> 6);
    const int bi = tile / per, rem = tile % per;
    const int ktiles = j.K >> 6;
    const int n0 = (rem / ktiles) << 6, k0 = (rem % ktiles) << 6;
    const int tid = otid(), tn = tid & 63, tk = tid >> 6;
    const float* src = j.src + (size_t)bi * j.sbs;
    bf16_t* dst = j.dst + (size_t)bi * j.dbs;
#pragma unroll
    for (int kk = 0; kk < 8; ++kk) {
        const int k = k0 + tk * 8 + kk;
        float v = 0.f;
        if (n0 + tn < j.nvalid) {
            if (j.split) { const int nn = n0 + tn; v = (nn < j.split) ? (j.src ? j.src[(size_t)k * j.ldsrc + nn] : 0.f) : j.srcB[(size_t)k * j.ldB + (nn - j.split)]; }
            else v = j.notr ? src[(size_t)(n0 + tn) * j.ldsrc + k] : src[(size_t)k * j.ldsrc + n0 + tn];
            if (j.scale) v *= j.scale[k];
        }
        lds[tn * 65 + tk * 8 + kk] = v;
    }
    __syncthreads();
    const int wn = tid >> 3, kq = tid & 7;
    uint4 o;
    unsigned w[4];
#pragma unroll
    for (int q = 0; q < 4; ++q) {
        const float lo = lds[wn * 65 + kq * 8 + 2 * q], hi = lds[wn * 65 + kq * 8 + 2 * q + 1];
        w[q] = pk2(lo, hi);
    }
    o.x = w[0]; o.y = w[1]; o.z = w[2]; o.w = w[3];
    *(uint4*)(dst + (size_t)(n0 + wn) * j.K + k0 + kq * 8) = o;
    __syncthreads();
}
__device__ ConvJob get_job_early(const Params& p, int l, int ji) {
    bf16_t* wb = (bf16_t*)(WS(p) + OFF_WB);
    const float* win = p.in[3] + (size_t)l * DM * CIN;
    const float* nm = p.in[2] + (size_t)l * DM;
    ConvJob j{}; j.nb = 1; j.sbs = 0; j.dbs = 0; j.K = 1024; j.ldsrc = CIN; j.scale = nm;
    switch (ji) {
    case 0: j.src = win + 3072; j.dst = wb + WB_WIN; j.nvalid = 4352; j.nrows = 4352; break;
    case 1: j.src = (l == 0 ? nullptr : p.in[17]); j.ldsrc = 32; j.split = 32; j.srcB = win + 7424; j.ldB = CIN; j.dst = wb + WB_WIN + (size_t)(4096 + PM_VD) * 1024; j.nvalid = 512; j.nrows = 512; break;
    case 2: j.src = win + 7904; j.dst = wb + WB_WIDX; j.nvalid = 8; j.nrows = 64; break;
    case 3: j.src = win; j.dst = wb + WB_WG; j.nvalid = 3072; j.nrows = 3072; break;
    case 4: j.src = p.in[29] + (size_t)l * DM * DM; j.ldsrc = 1024; j.scale = nullptr; j.dst = wb + WB_PA; j.nvalid = 1024; j.nrows = 1024; break;
    case 5: j.src = p.in[30] + (size_t)l * DM * DM; j.ldsrc = 1024; j.scale = nullptr; j.dst = wb + WB_PA + (size_t)1024 * 1024; j.nvalid = 1024; j.nrows = 1024; break;
    case 6: j.src = p.in[31] + (size_t)l * DM * DM; j.ldsrc = 1024; j.scale = nullptr; j.dst = wb + WB_PA + (size_t)2 * 1024 * 1024; j.nvalid = 1024; j.nrows = 1024; break;
    case 7: j.src = p.in[32] + (size_t)l * DM * DM; j.ldsrc = 1024; j.scale = nullptr; j.dst = wb + WB_WO; j.nvalid = 1024; j.nrows = 1024; break;
    case 8: j.src = p.in[5] + (size_t)l * 4 * 256 * 256; j.ldsrc = 256; j.K = 256; j.scale = nullptr; j.dst = wb + WB_POOL; j.nvalid = 256; j.nrows = 256; j.nb = 4; j.sbs = 65536; j.dbs = 65536; break;
    case 9: j.src = p.in[26] + (size_t)l * 256 * 512; j.ldsrc = 512; j.K = 256; j.scale = nullptr; j.dst = wb + WB_QI; j.nvalid = 512; j.nrows = 512; break;
    case 10: j.src = p.in[23] + (size_t)l * 256 * 1536; j.ldsrc = 1536; j.K = 256; j.scale = nullptr; j.dst = wb + WB_UQ; j.nvalid = 1536; j.nrows = 1536; break;
    case 11: j.src = p.in[24] + (size_t)l * 16 * 128 * 64; j.ldsrc = 64; j.K = 64; j.scale = nullptr; j.dst = wb + WB_UK; j.nvalid = 2048; j.nrows = 2048; j.notr = 1; break;
    default: j.src = p.in[25] + (size_t)l * 16 * 128 * 64; j.ldsrc = 64; j.K = 128; j.scale = nullptr; j.dst = wb + WB_UV; j.nvalid = 64; j.nrows = 64; j.nb = 16; j.sbs = 8192; j.dbs = 8192; break;
    }
    return j;
}
__device__ ConvJob get_job_late(const Params& p, int l, int ji) {
    bf16_t* we = (bf16_t*)(WS(p) + OFF_WEXP);
    ConvJob j{}; j.nb = 16; j.scale = nullptr; j.sbs = 262144; j.dbs = 262144;
    switch (ji) {
    case 0: j.src = p.in[38] + (size_t)l * 16 * 262144; j.dst = we + WE_W1; j.ldsrc = 256; j.K = 1024; j.nvalid = 256; j.nrows = 256; break;
    case 1: j.src = p.in[39] + (size_t)l * 16 * 262144; j.dst = we + WE_W3; j.ldsrc = 256; j.K = 1024; j.nvalid = 256; j.nrows = 256; break;
    default: j.src = p.in[40] + (size_t)l * 16 * 262144; j.dst = we + WE_W2; j.ldsrc = 1024; j.K = 256; j.nvalid = 1024; j.nrows = 1024; break;
    }
    return j;
}
template <bool LATE>
__device__ void phase_convert(const Params& p, int l, unsigned char* lds) {
    const int njobs = LATE ? 3 : 13;
    int base = 0;
    for (int ji = 0; ji < njobs; ++ji) {
        const ConvJob j = LATE ? get_job_late(p, l, ji) : get_job_early(p, l, ji);
        const int nt = conv_job_tiles(j);
        int first = ((int)obid() - base) % (int)gridDim.x; if (first < 0) first += gridDim.x;
        for (int t = first; t < nt; t += gridDim.x) conv_tile(j, t, (float*)lds);
        base += nt;
    }
}

template <int BM> struct G3 {
    static constexpr int MI = BM / 64;
    static constexpr int NA = BM / 64;
    static constexpr int STAGE = BM * 128 + 128 * 128;
    const bf16_t* ap[NA];
    const bf16_t* bp[2];
};
template <int BM>
__device__ __forceinline__ void g3_issue(const G3<BM>& g, int kt, unsigned char* stage, int tid) {
#pragma unroll
    for (int i = 0; i < G3<BM>::NA; ++i) glds16(g.ap[i] + kt * 64, stage + (tid + i * NTHR) * 16);
#pragma unroll
    for (int i = 0; i < 2; ++i) glds16(g.bp[i] + kt * 64, stage + BM * 128 + (tid + i * NTHR) * 16);
}
template <int BM, class FA, class FB>
__device__ __forceinline__ void g3_setup(G3<BM>& g, FA rowptr, FB bcol, int tid) {
#pragma unroll
    for (int i = 0; i < G3<BM>::NA; ++i) { const int idx = tid + i * NTHR, row = idx >> 3, sl = (idx & 7) ^ (row & 7); g.ap[i] = rowptr(row) + sl * 8; }
#pragma unroll
    for (int i = 0; i < 2; ++i) { const int idx = tid + i * NTHR, row = idx >> 3, sl = (idx & 7) ^ (row & 7); g.bp[i] = bcol(row) + sl * 8; }
}
template <int BM>
__device__ __forceinline__ void g3_kloop(f32x4 (&acc)[BM / 64][4], const G3<BM>& g, int K, unsigned char* lds) {
    constexpr int MI = G3<BM>::MI, STAGE = G3<BM>::STAGE, NL = G3<BM>::NA + 2;
    const int tid = otid(), lane = tid & 63, wid = tid >> 6, wr = wid >> 1, wc = wid & 1, fr = lane & 15, fq = lane >> 4;
    const int nk = K >> 6;
    g3_issue<BM>(g, 0, lds, tid);
    if (nk > 1) g3_issue<BM>(g, 1, lds + STAGE, tid);
    int cur = 0;
#pragma unroll 1
    for (int t = 0; t < nk; ++t) {
        if (t + 1 < nk) { if (NL == 6) asm volatile("s_waitcnt vmcnt(6)" ::: "memory"); else if (NL == 5) asm volatile("s_waitcnt vmcnt(5)" ::: "memory"); else asm volatile("s_waitcnt vmcnt(4)" ::: "memory"); }
        else asm volatile("s_waitcnt vmcnt(0)" ::: "memory");
        __builtin_amdgcn_s_barrier();
        if (t + 2 < nk) { int nx = cur + 2; if (nx >= 3) nx -= 3; g3_issue<BM>(g, t + 2, lds + nx * STAGE, tid); }
        const unsigned char* cA = lds + cur * STAGE;
        const unsigned char* cB = cA + BM * 128;
#pragma unroll
        for (int ks = 0; ks < 2; ++ks) {
            bf16x8 a[MI], b[4];
#pragma unroll
            for (int m = 0; m < MI; ++m) { const int row = wr * (BM / 4) + m * 16 + fr; a[m] = *(const bf16x8*)(cA + row * 128 + (((ks * 4 + fq) ^ (row & 7)) << 4)); }
#pragma unroll
            for (int n = 0; n < 4; ++n) { const int row = wc * 64 + n * 16 + fr; b[n] = *(const bf16x8*)(cB + row * 128 + (((ks * 4 + fq) ^ (row & 7)) << 4)); }
#pragma unroll
            for (int m = 0; m < MI; ++m)
#pragma unroll
                for (int n = 0; n < 4; ++n) acc[m][n] = __builtin_amdgcn_mfma_f32_16x16x32_bf16(b[n], a[m], acc[m][n], 0, 0, 0);
        }
        cur = (cur == 2) ? 0 : cur + 1;
    }
    __builtin_amdgcn_s_barrier();
}
struct G3D { const bf16_t* ap[2]; const bf16_t* b1[2]; const bf16_t* b3[2]; };
__device__ __forceinline__ void g3d_issue(const G3D& g, int kt, unsigned char* stage, int tid) {
#pragma unroll
    for (int i = 0; i < 2; ++i) glds16(g.ap[i] + kt * 64, stage + (tid + i * NTHR) * 16);
#pragma unroll
    for (int i = 0; i < 2; ++i) glds16(g.b1[i] + kt * 64, stage + 16384 + (tid + i * NTHR) * 16);
#pragma unroll
    for (int i = 0; i < 2; ++i) glds16(g.b3[i] + kt * 64, stage + 32768 + (tid + i * NTHR) * 16);
}
__device__ __forceinline__ void g3d_kloop(f32x4 (&acc1)[2][4], f32x4 (&acc3)[2][4], const G3D& g, int K, unsigned char* lds) {
    constexpr int STAGE = 49152;
    const int tid = otid(), lane = tid & 63, wid = tid >> 6, wr = wid >> 1, wc = wid & 1, fr = lane & 15, fq = lane >> 4;
    const int nk = K >> 6;
    g3d_issue(g, 0, lds, tid);
    if (nk > 1) g3d_issue(g, 1, lds + STAGE, tid);
    int cur = 0;
#pragma unroll 1
    for (int t = 0; t < nk; ++t) {
        if (t + 1 < nk) asm volatile("s_waitcnt vmcnt(6)" ::: "memory"); else asm volatile("s_waitcnt vmcnt(0)" ::: "memory");
        __builtin_amdgcn_s_barrier();
        if (t + 2 < nk) { int nx = cur + 2; if (nx >= 3) nx -= 3; g3d_issue(g, t + 2, lds + nx * STAGE, tid); }
        const unsigned char* cA = lds + cur * STAGE;
#pragma unroll
        for (int ks = 0; ks < 2; ++ks) {
            bf16x8 a[2], b1[4], b3[4];
#pragma unroll
            for (int m = 0; m < 2; ++m) { const int row = wr * 32 + m * 16 + fr; a[m] = *(const bf16x8*)(cA + row * 128 + (((ks * 4 + fq) ^ (row & 7)) << 4)); }
#pragma unroll
            for (int n = 0; n < 4; ++n) { const int row = wc * 64 + n * 16 + fr; const int off = row * 128 + (((ks * 4 + fq) ^ (row & 7)) << 4);
                b1[n] = *(const bf16x8*)(cA + 16384 + off); b3[n] = *(const bf16x8*)(cA + 32768 + off); }
#pragma unroll
            for (int m = 0; m < 2; ++m)
#pragma unroll
                for (int n = 0; n < 4; ++n) {
                    acc1[m][n] = __builtin_amdgcn_mfma_f32_16x16x32_bf16(b1[n], a[m], acc1[m][n], 0, 0, 0);
                    acc3[m][n] = __builtin_amdgcn_mfma_f32_16x16x32_bf16(b3[n], a[m], acc3[m][n], 0, 0, 0);
                }
        }
        cur = (cur == 2) ? 0 : cur + 1;
    }
    __builtin_amdgcn_s_barrier();
}
template <int MI>
__device__ __forceinline__ void g3_zero(f32x4 (&acc)[MI][4]) {
#pragma unroll
    for (int m = 0; m < MI; ++m)
#pragma unroll
        for (int n = 0; n < 4; ++n) acc[m][n] = (f32x4){0.f, 0.f, 0.f, 0.f};
}
__device__ __forceinline__ uint2 pack4(float a, float b, float c, float d) {
    uint2 r; r.x = pk2(a, b); r.y = pk2(c, d); return r;
}

namespace pg8 {
#define PG8_LAS __attribute__((address_space(3)))
typedef unsigned short bf16_t;
typedef short bf16x8 __attribute__((ext_vector_type(8)));
typedef float f32x4 __attribute__((ext_vector_type(4)));
typedef unsigned u32x4 __attribute__((ext_vector_type(4)));
constexpr int BM = 256, BK = 64, HALF = 128, HTB = HALF * BK * 2  , STAGE_BYTES = 8 * HTB, NXCD = 8, WGM = 8;

__host__ __device__ __forceinline__ int lds_byte(int r, int c) { const int st = (r >> 4) * 2 + (c >> 5), rr = r & 15, cc = c & 31, ob = rr * 64 + cc * 2; return st * 1024 + (ob ^ (((ob >> 9) & 1) << 5)); }
__host__ __device__ __forceinline__ void stage_rc(int b, int& R, int& C) { const int st = b / 1024, sb = b % 1024, swz = sb ^ (((sb >> 9) & 1) << 5); R = (st >> 1) * 16 + swz / 64; C = (st & 1) * 32 + (swz % 64) / 2; }
__host__ __device__ __forceinline__ int perm32(int rho) { const int n = rho >> 4, i = rho & 15; return 8 * (i >> 2) + 4 * n + (i & 3); }

struct Unit { int pm, pn; };
struct Gemm { const bf16_t* A; const bf16_t* Bt; int M, N, K; };

struct StaticOrder {
    int nM, nN, nwg, G, c;
    __host__ __device__ void init(int M, int N, int G_, int c_) { nM = M / BM; nN = N / BM; nwg = nM * nN; G = G_; c = c_; }
    __host__ __device__ bool next(int i, Unit& u) const {
        const long L = (long)i * G + c; if (L >= nwg) return false;
        int wgid = (int)L; { const int q = nwg / NXCD, r = nwg % NXCD, xcd = wgid % NXCD, off = wgid / NXCD; wgid = (xcd < r ? xcd * (q + 1) : r * (q + 1) + (xcd - r) * q) + off; }
        const int nig = WGM * nN, gid = wgid / nig, fm = gid * WGM, gsz = (nM - fm) < WGM ? (nM - fm) : WGM;
        u.pm = fm + ((wgid % nig) % gsz); u.pn = (wgid % nig) / gsz; return true;
    }
    __device__ __forceinline__ void a_ready(const Unit&) const {}
    __device__ __forceinline__ void done(const Unit&) const {}
};
template <class Epi, class Sched, bool STAMP = false>
__device__ __forceinline__ void gemm_phase(PG8_LAS unsigned char* lds, const Gemm g, const Sched& S, const Epi& E, unsigned long long* stamps) {
    const int tid = otid(), wid = __builtin_amdgcn_readfirstlane(tid >> 6), lane = tid & 63, wr = wid >> 2, wc = wid & 3, fr = lane & 15, fq = lane >> 4;
    const int K = g.K, nt = K / BK;
    int ts_lo = 0, ts_hi = 0, nts = 0; const unsigned long long rt_entry = STAMP ? 0ull : 0ull;
#define PG8_STAMP() do { if (STAMP && wid == 0 && nts < 64) { const unsigned long long _c = 0ull; \
        ts_lo = (lane == nts) ? (int)(unsigned)_c : ts_lo; ts_hi = (lane == nts) ? (int)(unsigned)(_c >> 32) : ts_hi; ++nts; } } while (0)
    PG8_STAMP();
    unsigned voffA[2], voffB[2];
#pragma unroll
    for (int i = 0; i < 2; ++i) { int R, C; stage_rc(tid * 16 + i * 8192, R, C); const int Rb = Epi::PERM ? ((R & ~31) + perm32(R & 31)) : R;
        voffA[i] = (unsigned)(R * K + C) * 2u; voffB[i] = (unsigned)(Rb * K + C) * 2u; }
    const size_t kstep = (size_t)(BK * 2);
    const size_t hstep = (size_t)HALF * K * 2;
    const size_t tstep = 2 * hstep;
    const unsigned ldsw = (unsigned)wid * 1024u;
    const int aoff = lds_byte(wr * 64 + fr, fq * 8), boff = lds_byte(wc * 32 + fr, fq * 8);
#define PG8_SA(b, h) (((b) * 2 + (h)) * HTB)
#define PG8_SB(b, h) ((4 + (b) * 2 + (h)) * HTB)
#define PG8_STAGE(bufoff, gbase, voff) do { _Pragma("unroll") for (int _i = 0; _i < 2; ++_i) \
        __builtin_amdgcn_global_load_lds((const unsigned*)((const char*)(gbase) + (voff)[_i]), (PG8_LAS unsigned*)(lds + (bufoff) + ldsw + _i * 8192), 16, 0, 0); } while (0)
#define PG8_LDA(dst, b, h) do { _Pragma("unroll") for (int m = 0; m < 4; ++m) _Pragma("unroll") for (int k = 0; k < 2; ++k) dst[m][k] = *(const PG8_LAS bf16x8*)(lds + PG8_SA(b, h) + aoff + m * 2048 + k * 1024); } while (0)
#define PG8_LDB(dst, b, h) do { _Pragma("unroll") for (int n = 0; n < 2; ++n) _Pragma("unroll") for (int k = 0; k < 2; ++k) dst[n][k] = *(const PG8_LAS bf16x8*)(lds + PG8_SB(b, h) + boff + n * 2048 + k * 1024); } while (0)
#define PG8_MMA(ai, bj, At, Bt) do { __builtin_amdgcn_s_setprio(1); _Pragma("unroll") for (int m = 0; m < 4; ++m) _Pragma("unroll") for (int n = 0; n < 2; ++n) _Pragma("unroll") for (int k = 0; k < 2; ++k) \
        acc[ai][bj][m][n] = __builtin_amdgcn_mfma_f32_16x16x32_bf16(Bt[n][k], At[m][k], acc[ai][bj][m][n], 0, 0, 0); __builtin_amdgcn_s_setprio(0); } while (0)
#define PG8_WAIT_V(n) asm volatile("s_waitcnt vmcnt(" #n ")" ::: "memory")
#define PG8_WAIT_L(n) asm volatile("s_waitcnt lgkmcnt(" #n ")" ::: "memory")
#define PG8_BAR __builtin_amdgcn_s_barrier()
#define PG8_SCHED __builtin_amdgcn_sched_barrier(0)
    Unit cur, nxt; int ui = 0;
    if (!S.next(0, cur)) return;
    f32x4 acc[2][2][4][2];
#pragma unroll
    for (int a = 0; a < 2; ++a)
#pragma unroll
        for (int b = 0; b < 2; ++b)
#pragma unroll
            for (int m = 0; m < 4; ++m)
#pragma unroll
                for (int n = 0; n < 2; ++n) acc[a][b][m][n] = (f32x4){0.f, 0.f, 0.f, 0.f};
    bf16x8 At[4][2], B0[2][2], B1[2][2];
    const char* cA = (const char*)g.A + (size_t)cur.pm * tstep; const char* cB = (const char*)g.Bt + (size_t)cur.pn * tstep;
    S.a_ready(cur);
    PG8_STAGE(PG8_SB(0, 0), cB, voffB); PG8_STAGE(PG8_SA(0, 0), cA, voffA); PG8_STAGE(PG8_SB(0, 1), cB + hstep, voffB); PG8_STAGE(PG8_SA(0, 1), cA + hstep, voffA);
    if (wr == 1) PG8_BAR;
    PG8_WAIT_V(4); PG8_BAR;
    PG8_STAGE(PG8_SB(1, 0), cB + kstep, voffB); PG8_STAGE(PG8_SA(1, 0), cA + kstep, voffA); PG8_STAGE(PG8_SB(1, 1), cB + hstep + kstep, voffB);
    PG8_WAIT_V(6); PG8_BAR;
    PG8_STAMP();
    for (;;) {
        const bool has_next = S.next(ui + 1, nxt);
        const char* nA = has_next ? (const char*)g.A + (size_t)nxt.pm * tstep : cA; const char* nB = has_next ? (const char*)g.Bt + (size_t)nxt.pn * tstep : cB;
        for (int t = 0; t < nt; t += 2) {
            const bool last = (t == nt - 2);
            const char* a1 = cA + (size_t)(t + 1) * kstep;
            const char* a2 = last ? nA : cA + (size_t)(t + 2) * kstep; const char* b2 = last ? nB : cB + (size_t)(t + 2) * kstep;
            const char* a3 = a2 + kstep; const char* b3 = b2 + kstep;
            if (last && has_next) S.a_ready(nxt);
            PG8_LDB(B0, 0, 0); PG8_SCHED; PG8_LDA(At, 0, 0); PG8_STAGE(PG8_SA(1, 1), a1 + hstep, voffA);
            PG8_WAIT_L(8); PG8_BAR; PG8_WAIT_L(0); PG8_MMA(0, 0, At, B0); PG8_BAR; PG8_SCHED;
            PG8_LDB(B1, 0, 1); PG8_STAGE(PG8_SB(0, 0), b2, voffB);
            PG8_BAR; PG8_WAIT_L(0); PG8_MMA(0, 1, At, B1); PG8_BAR;
            PG8_LDA(At, 0, 1); PG8_STAGE(PG8_SA(0, 0), a2, voffA);
            PG8_BAR; PG8_WAIT_L(0); PG8_MMA(1, 0, At, B0); PG8_BAR; PG8_SCHED;
            PG8_STAGE(PG8_SB(0, 1), b2 + hstep, voffB);
            PG8_WAIT_V(6); PG8_BAR; PG8_MMA(1, 1, At, B1); PG8_BAR;
            PG8_LDB(B0, 1, 0); PG8_SCHED; PG8_LDA(At, 1, 0); PG8_STAGE(PG8_SA(0, 1), a2 + hstep, voffA);
            PG8_WAIT_L(8); PG8_BAR; PG8_WAIT_L(0); PG8_MMA(0, 0, At, B0); PG8_BAR; PG8_SCHED;
            PG8_LDB(B1, 1, 1); PG8_STAGE(PG8_SB(1, 0), b3, voffB);
            PG8_BAR; PG8_WAIT_L(0); PG8_MMA(0, 1, At, B1); PG8_BAR;
            PG8_LDA(At, 1, 1); PG8_STAGE(PG8_SA(1, 0), a3, voffA);
            PG8_BAR; PG8_WAIT_L(0); PG8_MMA(1, 0, At, B0); PG8_BAR; PG8_SCHED;
            PG8_STAGE(PG8_SB(1, 1), b3 + hstep, voffB);
            PG8_WAIT_V(6); PG8_BAR; PG8_MMA(1, 1, At, B1); PG8_BAR;
        }
        PG8_STAMP();
        if constexpr (!Epi::AFTER_DRAIN) { E(acc, cur, wr, wc, fr, fq); S.done(cur); }
        PG8_STAMP();
        if (!has_next) break;
#pragma unroll
        for (int a = 0; a < 2; ++a)
#pragma unroll
            for (int b = 0; b < 2; ++b)
#pragma unroll
                for (int m = 0; m < 4; ++m)
#pragma unroll
                    for (int n = 0; n < 2; ++n) acc[a][b][m][n] = (f32x4){0.f, 0.f, 0.f, 0.f};
        cur = nxt; cA = nA; cB = nB; ++ui;
    }
    PG8_WAIT_V(0);
    if (wr == 0) PG8_BAR;
    PG8_BAR;
    if constexpr (Epi::AFTER_DRAIN) { E.fused(acc, cur, wr, wc, fr, fq, lds, wid, lane); S.done(cur); }
    PG8_STAMP();
    if (STAMP && wid == 0) { stamps[lane] = lane < nts ? (((unsigned long long)(unsigned)ts_hi << 32) | (unsigned)ts_lo) : 0ull;
        if (lane == 62) stamps[62] = rt_entry; if (lane == 63) stamps[63] = 0ull; }
#undef PG8_STAMP
#undef PG8_SA
#undef PG8_SB
#undef PG8_STAGE
#undef PG8_LDA
#undef PG8_LDB
#undef PG8_MMA
#undef PG8_WAIT_V
#undef PG8_WAIT_L
#undef PG8_BAR
#undef PG8_SCHED
}
}

struct EpiInproj {
    static constexpr bool PERM = true, AFTER_DRAIN = false;
    unsigned char* ws; const float* rstd;
    __device__ __forceinline__ void operator()(const pg8::f32x4 (&acc)[2][2][4][2], const pg8::Unit& u, int wr, int wc, int fr, int fq) const {
        const int pn = u.pn;
        bf16_t* dst; int ld, cb;
        if (pn < 4) { dst = (bf16_t*)(ws + OFF_PPOOL); ld = 1024; cb = pn * 256; }
        else if (pn < 8) { dst = (bf16_t*)(ws + OFF_PR); ld = 1024; cb = (pn - 4) * 256; }
        else if (pn < 12) { dst = (bf16_t*)(ws + OFF_PK); ld = 1024; cb = (pn - 8) * 256; }
        else if (pn < 16) { dst = (bf16_t*)(ws + OFF_PV); ld = 1024; cb = (pn - 12) * 256; }
        else { dst = (bf16_t*)(ws + OFF_PMISC); ld = PM_LD; cb = (pn - 16) * 256; }
        bf16_t* halo = (bf16_t*)(ws + OFF_HALO);
#pragma unroll
        for (int ai = 0; ai < 2; ++ai)
#pragma unroll
            for (int m = 0; m < 4; ++m) {
                const int row = u.pm * 256 + ai * 128 + wr * 64 + m * 16 + fr;
                if (row < NT) {
                    const float rs = rstd[row];
                    const int lr = row & 127;
#pragma unroll
                    for (int bj = 0; bj < 2; ++bj) {
                        const int col = cb + bj * 128 + wc * 32 + fq * 8;
                        const uint2 lo = pack4(acc[ai][bj][m][0][0] * rs, acc[ai][bj][m][0][1] * rs, acc[ai][bj][m][0][2] * rs, acc[ai][bj][m][0][3] * rs);
                        const uint2 hi = pack4(acc[ai][bj][m][1][0] * rs, acc[ai][bj][m][1][1] * rs, acc[ai][bj][m][1][2] * rs, acc[ai][bj][m][1][3] * rs);
                        const uint4 v = make_uint4(lo.x, lo.y, hi.x, hi.y);
                        *(uint4*)(dst + (size_t)row * ld + col) = v;
                        if (pn < 4 && lr >= 112) *(uint4*)(halo + ((size_t)(row >> 7) * 16 + (lr - 112)) * 1024 + col) = v;
                    }
                }
            }
    }
};
__device__ void phase_inproj(const Params& p, unsigned char* lds) {
    pg8::StaticOrder S; S.init(NTP, NP1, (int)gridDim.x, obid());
    pg8::Gemm g; g.A = (const pg8::bf16_t*)(WS(p) + OFF_H); g.Bt = (const pg8::bf16_t*)(WS(p) + OFF_WB) + WB_WIN; g.M = NTP; g.N = NP1; g.K = DM;
    EpiInproj E; E.ws = WS(p); E.rstd = (const float*)(WS(p) + OFF_RSTD);
    pg8::gemm_phase<EpiInproj, pg8::StaticOrder, false>((PG8_LAS unsigned char*)lds, g, S, E, nullptr);
}

__device__ void phase_pool(const Params& p, int l, unsigned char* lds, int tb, int te, int tstep) {
    const int tid = otid(), lane = tid & 63, wid = tid >> 6, fr = lane & 15, fq = lane >> 4;
    bf16_t* pp = (bf16_t*)(WS(p) + OFF_PPOOL);
    const bf16_t* halo = (const bf16_t*)(WS(p) + OFF_HALO);
    const bf16_t* pw = (const bf16_t*)(WS(p) + OFF_WB) + WB_POOL;
    const float* scale = p.in[6] + (size_t)l * 1024;
    bf16_t* sp = (bf16_t*)lds;
    constexpr int SLD = 264;
    for (int tile = tb; tile < te; tile += tstep) {
        const int mt = tile >> 2, g = tile & 3;
        const int row0 = mt * 128, w = 2 << g;
        {
            const int c = tid & 255, r0 = (tid >> 8) * 64, col = g * 256 + c;
            auto rawv = [&](int n2) -> float {
                return (n2 >= row0) ? bf2f(pp[(size_t)n2 * 1024 + col]) : bf2f(halo[((size_t)(n2 >> 7) * 16 + ((n2 & 127) - 112)) * 1024 + col]);
            };
            int n = row0 + r0, t = n % TS;
            float sum = 0.f;
            const int have = (t < w) ? t : w;
            for (int i = 1; i <= have; ++i) sum += rawv(n - i);
#pragma unroll 4
            for (int r = 0; r < 64; ++r, ++n) {
                if (t == 0) sum = 0.f;
                const float v = rawv(n);
                sum += v;
                if (t >= w) sum -= rawv(n - w);
                const int cnt = (t + 1 < w) ? (t + 1) : w;
                sp[(r0 + r) * SLD + c] = f2bf(sum * (1.0f / (float)cnt) - v);
                t = (t + 1 == TS) ? 0 : t + 1;
            }
        }
        __syncthreads();
        f32x4 acc[8][2];
#pragma unroll
        for (int m = 0; m < 8; ++m) { acc[m][0] = (f32x4){0.f, 0.f, 0.f, 0.f}; acc[m][1] = (f32x4){0.f, 0.f, 0.f, 0.f}; }
        const bf16_t* wg = pw + (size_t)g * 65536;
#pragma unroll 1
        for (int kk = 0; kk < 8; ++kk) {
            bf16x8 bfr[2];
#pragma unroll
            for (int n = 0; n < 2; ++n) bfr[n] = *(const bf16x8*)(wg + (size_t)(wid * 32 + n * 16 + fr) * 256 + kk * 32 + fq * 8);
#pragma unroll
            for (int m = 0; m < 8; ++m) {
                const bf16x8 a = *(const bf16x8*)(sp + (m * 16 + fr) * SLD + kk * 32 + fq * 8);
                acc[m][0] = __builtin_amdgcn_mfma_f32_16x16x32_bf16(a, bfr[0], acc[m][0], 0, 0, 0);
                acc[m][1] = __builtin_amdgcn_mfma_f32_16x16x32_bf16(a, bfr[1], acc[m][1], 0, 0, 0);
            }
        }
#pragma unroll
        for (int m = 0; m < 8; ++m)
#pragma unroll
            for (int n = 0; n < 2; ++n) {
                const int col = g * 256 + wid * 32 + n * 16 + fr;
                const float sc = scale[col];
#pragma unroll
                for (int j = 0; j < 4; ++j) {
                    const int row = row0 + m * 16 + fq * 4 + j;
                    pp[(size_t)row * 1024 + col] = f2bf(acc[m][n][j] * sc);
                }
            }
        __syncthreads();
    }
}

__device__ void phase_dsa_prep(const Params& p, int l) {
    const int lane = otid() & 63;
    const int wave = (obid() * NTHR + otid()) >> 6, nw = gridDim.x * NTHR / 64;
    const bf16_t* pm = (const bf16_t*)(WS(p) + OFF_PMISC);
    unsigned char* dob = OUTB(p);
    bf16_t* cqn = (bf16_t*)(dob + DO_CQN);
    bf16_t* kv = (bf16_t*)(dob + DO_KV);
    bf16_t* kidx = (bf16_t*)(dob + DO_KIDX);
    float* whead = (float*)(dob + DO_WHEAD);
    const float* ctab = (const float*)(WS(p) + OFF_ROPE);
    const float* stab = ctab + TS * 16;
    const bf16_t* hrow = (const bf16_t*)(WS(p) + OFF_H);
    const bf16_t* wwidx = (const bf16_t*)(WS(p) + OFF_WB) + WB_WIDX;
    const float* rstd_ = (const float*)(WS(p) + OFF_RSTD);
    const float4 qn4 = *(const float4*)(p.in[21] + l * 256 + lane * 4);
    const float2 kvn2 = *(const float2*)(p.in[22] + l * 128 + lane * 2);
    const float inw = p.in[27][l * 64 + lane], inb = p.in[28][l * 64 + lane];
    uint4 ww[8][2];
#pragma unroll
    for (int j = 0; j < 8; ++j) { ww[j][0] = *(const uint4*)(wwidx + (size_t)j * DM + lane * 16); ww[j][1] = *(const uint4*)(wwidx + (size_t)j * DM + lane * 16 + 8); }
    struct In { uint2 cq; unsigned ckv; bf16_t kr0, kr1, kix; uint4 h0, h1; float rs, c, s; };
    auto load = [&](int n) {
        In r;
        const bf16_t* row = pm + (size_t)n * PM_LD;
        const int t = n % TS;
        r.cq = *(const uint2*)(row + PM_CQ + lane * 4);
        r.ckv = *(const unsigned*)(row + PM_CKV + lane * 2);
        r.kr0 = row[PM_KROPE + (lane & 15)]; r.kr1 = row[PM_KROPE + 16 + (lane & 15)];
        r.kix = row[PM_KIDX + lane];
        r.h0 = *(const uint4*)(hrow + (size_t)n * DM + lane * 16); r.h1 = *(const uint4*)(hrow + (size_t)n * DM + lane * 16 + 8);
        r.rs = rstd_[n];
        r.c = ctab[t * 16 + (lane & 15)]; r.s = stab[t * 16 + (lane & 15)];
        return r;
    };
    In cur = load(wave < NT ? wave : 0);
    for (int n = wave; n < NT; n += nw) {
        const In x = cur;
        if (n + nw < NT) cur = load(n + nw);
        {
            const float v0 = __uint_as_float(x.cq.x << 16), v1 = __uint_as_float(x.cq.x & 0xFFFF0000u), v2 = __uint_as_float(x.cq.y << 16), v3 = __uint_as_float(x.cq.y & 0xFFFF0000u);
            const float ss = wave_sum_fast(v0 * v0 + v1 * v1 + v2 * v2 + v3 * v3);
            const float rs = rsqrtf(ss * (1.0f / 256.0f) + 1e-6f);
            *(uint2*)(cqn + (size_t)n * 256 + lane * 4) = pack4(v0 * rs * qn4.x, v1 * rs * qn4.y, v2 * rs * qn4.z, v3 * rs * qn4.w);
        }
        {
            const float v0 = __uint_as_float(x.ckv << 16), v1 = __uint_as_float(x.ckv & 0xFFFF0000u);
            const float ss = wave_sum_fast(v0 * v0 + v1 * v1);
            const float rs = rsqrtf(ss * (1.0f / 128.0f) + 1e-6f);
            *(unsigned*)(kv + (size_t)n * 160 + lane * 2) = pk2(v0 * rs * kvn2.x, v1 * rs * kvn2.y);
        }
        if (lane < 16) {
            const float x1 = bf2f(x.kr0), x2 = bf2f(x.kr1);
            kv[(size_t)n * 160 + 128 + lane] = f2bf(x1 * x.c - x2 * x.s);
            kv[(size_t)n * 160 + 144 + lane] = f2bf(x2 * x.c + x1 * x.s);
        }
        {
            const float xv = bf2f(x.kix);
            const float mu = wave_sum_fast(xv) * (1.0f / 64.0f);
            const float d = xv - mu;
            const float var = wave_sum_fast(d * d) * (1.0f / 64.0f);
            const float y = d * rsqrtf(var + 1e-6f) * inw + inb;
            const float yo = __shfl_xor(y, 16);
            float o = y;
            if (lane < 32) o = (lane < 16) ? (y * x.c - yo * x.s) : (y * x.c + yo * x.s);
            kidx[(size_t)n * 64 + lane] = f2bf(o);
        }
        {
            const uint4 hv0 = x.h0, hv1 = x.h1;
            float hx[16];
            hx[0] = __uint_as_float(hv0.x << 16); hx[1] = __uint_as_float(hv0.x & 0xFFFF0000u); hx[2] = __uint_as_float(hv0.y << 16); hx[3] = __uint_as_float(hv0.y & 0xFFFF0000u);
            hx[4] = __uint_as_float(hv0.z << 16); hx[5] = __uint_as_float(hv0.z & 0xFFFF0000u); hx[6] = __uint_as_float(hv0.w << 16); hx[7] = __uint_as_float(hv0.w & 0xFFFF0000u);
            hx[8] = __uint_as_float(hv1.x << 16); hx[9] = __uint_as_float(hv1.x & 0xFFFF0000u); hx[10] = __uint_as_float(hv1.y << 16); hx[11] = __uint_as_float(hv1.y & 0xFFFF0000u);
            hx[12] = __uint_as_float(hv1.z << 16); hx[13] = __uint_as_float(hv1.z & 0xFFFF0000u); hx[14] = __uint_as_float(hv1.w << 16); hx[15] = __uint_as_float(hv1.w & 0xFFFF0000u);
            float myw = 0.f;
#pragma unroll
            for (int j = 0; j < 8; ++j) {
                const uint4 w0 = ww[j][0], w1 = ww[j][1];
                float d = hx[0] * __uint_as_float(w0.x << 16) + hx[1] * __uint_as_float(w0.x & 0xFFFF0000u) + hx[2] * __uint_as_float(w0.y << 16) + hx[3] * __uint_as_float(w0.y & 0xFFFF0000u)
                        + hx[4] * __uint_as_float(w0.z << 16) + hx[5] * __uint_as_float(w0.z & 0xFFFF0000u) + hx[6] * __uint_as_float(w0.w << 16) + hx[7] * __uint_as_float(w0.w & 0xFFFF0000u)
                        + hx[8] * __uint_as_float(w1.x << 16) + hx[9] * __uint_as_float(w1.x & 0xFFFF0000u) + hx[10] * __uint_as_float(w1.y << 16) + hx[11] * __uint_as_float(w1.y & 0xFFFF0000u)
                        + hx[12] * __uint_as_float(w1.z << 16) + hx[13] * __uint_as_float(w1.z & 0xFFFF0000u) + hx[14] * __uint_as_float(w1.w << 16) + hx[15] * __uint_as_float(w1.w & 0xFFFF0000u);
                d = wave_sum_fast(d);
                myw = (lane == j) ? d : myw;
            }
            if (lane < 8) whead[(size_t)n * 8 + lane] = myw * x.rs * 0.04419417382415922f;
        }
    }
}

typedef short s16x4 __attribute__((ext_vector_type(4)));
__device__ __forceinline__ unsigned f2h_bits(float f) { const _Float16 h = (_Float16)f; unsigned short u; __builtin_memcpy(&u, &h, 2); return u; }
template <bool IMPORT_SEL>
__device__ void phase_dsa(const Params& p, int l, unsigned char* lds, bf16_t* yc, const unsigned short* gsel, const int* gnsel, int tb, int te, int tstep) {
    const int tid = otid(), lane = tid & 63, wid = tid >> 6, fr = lane & 15, fq = lane >> 4;
    unsigned short* s_sc = (unsigned short*)lds;
    bf16_t* s_qi = (bf16_t*)(lds + 66048);
    bf16_t* s_Q = (bf16_t*)lds;
    unsigned char* s_Vw = lds + 82432 + wid * 8192;
    bf16_t* s_qn = (bf16_t*)s_Vw;
    unsigned short* s_sel = (unsigned short*)(lds + 82432 + 65536);
    int* s_nsel = (int*)(lds + 82432 + 65536 + 8192);
    unsigned char* dob = OUTB(p);
    const bf16_t* cqn = (const bf16_t*)(dob + DO_CQN);
    const bf16_t* kv = (const bf16_t*)(dob + DO_KV);
    const bf16_t* kidx = (const bf16_t*)(dob + DO_KIDX);
    const float* whead = (const float*)(dob + DO_WHEAD);
    const float* ctab = (const float*)(WS(p) + OFF_ROPE);
    const float* stab = ctab + TS * 16;
    const bf16_t* wb = (const bf16_t*)(WS(p) + OFF_WB);
    const bf16_t* wqiT = wb + WB_QI;
    const bf16_t* wuqT = wb + WB_UQ;
    const bf16_t* wuk = wb + WB_UK;
    const bf16_t* wuvT = wb + WB_UV;
    const float scale = 0.10206207261596575f;
    const f32x4 z4 = {0.f, 0.f, 0.f, 0.f};
    for (int tile = tb; tile < te; tile += tstep) {
        const int qt = 128 - (tile >> 3), b = tile & 7;
        const int t0 = qt * 16;
        const size_t n0 = (size_t)b * TS + t0;
        {
            bf16x8 acq[8];
#pragma unroll
            for (int kk = 0; kk < 8; ++kk) acq[kk] = *(const bf16x8*)(cqn + (n0 + fr) * 256 + kk * 32 + fq * 8);
            f32x4 c[4] = {z4, z4, z4, z4};
#pragma unroll
            for (int kb = 0; kb < 8; kb += 4) {
                bf16x8 bf[4][4];
#pragma unroll
                for (int k4 = 0; k4 < 4; ++k4)
#pragma unroll
                    for (int nt = 0; nt < 4; ++nt) bf[k4][nt] = *(const bf16x8*)(wqiT + (size_t)(wid * 64 + nt * 16 + fr) * 256 + (kb + k4) * 32 + fq * 8);
#pragma unroll
                for (int k4 = 0; k4 < 4; ++k4)
#pragma unroll
                    for (int nt = 0; nt < 4; ++nt) c[nt] = __builtin_amdgcn_mfma_f32_16x16x32_bf16(acq[kb + k4], bf[k4][nt], c[nt], 0, 0, 0);
            }
#pragma unroll
            for (int j = 0; j < 4; ++j) {
                const int t = t0 + fq * 4 + j;
                const float cs = ctab[t * 16 + fr], sn = stab[t * 16 + fr];
                const float x1 = c[0][j], x2 = c[1][j];
                c[0][j] = x1 * cs - x2 * sn; c[1][j] = x2 * cs + x1 * sn;
            }
#pragma unroll
            for (int nt = 0; nt < 4; ++nt)
#pragma unroll
                for (int j = 0; j < 4; ++j) s_qi[(fq * 4 + j) * 512 + wid * 64 + nt * 16 + fr] = f2bf(c[nt][j]);
        }
        __syncthreads();
        if (!IMPORT_SEL) {
            bf16x8 aq[8][2];
#pragma unroll
            for (int h = 0; h < 8; ++h)
#pragma unroll
                for (int ks = 0; ks < 2; ++ks) aq[h][ks] = *(const bf16x8*)(s_qi + fr * 512 + h * 64 + ks * 32 + fq * 8);
            float wh[4][8];
#pragma unroll
            for (int j = 0; j < 4; ++j) {
                const float4 w0 = *(const float4*)(whead + (n0 + fq * 4 + j) * 8), w1 = *(const float4*)(whead + (n0 + fq * 4 + j) * 8 + 4);
                wh[j][0] = w0.x; wh[j][1] = w0.y; wh[j][2] = w0.z; wh[j][3] = w0.w; wh[j][4] = w1.x; wh[j][5] = w1.y; wh[j][6] = w1.z; wh[j][7] = w1.w;
            }
            const int nkt = qt + 1;
            bf16x8 nb0 = {0, 0, 0, 0, 0, 0, 0, 0}, nb1 = nb0;
            if (wid < nkt) { const bf16_t* kr0 = kidx + ((size_t)b * TS + wid * 16 + fr) * 64 + fq * 8; nb0 = *(const bf16x8*)kr0; nb1 = *(const bf16x8*)(kr0 + 32); }
#pragma unroll 1
            for (int kt = wid; kt < nkt; kt += 8) {
                const bf16x8 bk0 = nb0, bk1 = nb1;
                if (kt + 8 < nkt) { const bf16_t* krn = kidx + ((size_t)b * TS + (kt + 8) * 16 + fr) * 64 + fq * 8; nb0 = *(const bf16x8*)krn; nb1 = *(const bf16x8*)(krn + 32); }
                float I[4] = {0.f, 0.f, 0.f, 0.f};
#pragma unroll
                for (int h = 0; h < 8; ++h) {
                    f32x4 a = __builtin_amdgcn_mfma_f32_16x16x32_bf16(aq[h][0], bk0, z4, 0, 0, 0);
                    a = __builtin_amdgcn_mfma_f32_16x16x32_bf16(aq[h][1], bk1, a, 0, 0, 0);
#pragma unroll
                    for (int j = 0; j < 4; ++j) I[j] += wh[j][h] * fmaxf(a[j], 0.f);
                }
#pragma unroll
                for (int j = 0; j < 4; ++j) s_sc[(fq * 4 + j) * 2064 + kt * 16 + fr] = (unsigned short)f2h_bits(I[j]);
            }
        }
        __syncthreads();
#pragma unroll 1
        for (int qi2 = 0; qi2 < 2; ++qi2) {
            const int q = wid + qi2 * 8;
            const int nadm = t0 + q + 1;
            unsigned short* sel = s_sel + q * 256;
            if (IMPORT_SEL) {
                const int ns = gnsel[n0 + q];
                for (int i = lane; i < ns; i += 64) sel[i] = gsel[(n0 + q) * 256 + i];
                if (lane == 0) s_nsel[q] = ns;
            } else if (nadm <= 256) {
                for (int i = lane; i < nadm; i += 64) sel[i] = (unsigned short)i;
                if (lane == 0) s_nsel[q] = nadm;
            } else {
                auto topk = [&](auto nch_tag) {
                    constexpr int NCH = decltype(nch_tag)::value;
                    unsigned key[NCH];
    #pragma unroll
                    for (int c = 0; c < NCH; ++c) {
                        const int s = c * 64 + lane;
                        unsigned k = 0u;
                        if (s < nadm) { const unsigned u = s_sc[q * 2064 + s]; k = (u & 0x8000u) ? (~u & 0xFFFFu) : (u | 0x8000u); }
                        key[c] = k;
                    }
                    unsigned T = 0u;
    #pragma unroll 1
                    for (int bit = 15; bit >= 0; --bit) {
                        const unsigned cand = T | (1u << bit);
                        int cnt = 0;
    #pragma unroll
                        for (int c = 0; c < NCH; ++c) cnt += __popcll(__ballot(key[c] >= cand));
                        if (cnt >= 256) T = cand;
                    }
                    int ngt = 0;
    #pragma unroll
                    for (int c = 0; c < NCH; ++c) ngt += __popcll(__ballot(key[c] > T));
                    const int rties = 256 - ngt;
                    int base = 0, ties = 0;
                    const unsigned long long ltmask = (1ull << lane) - 1ull;
    #pragma unroll
                    for (int c = 0; c < NCH; ++c) {
                        const bool gt = key[c] > T, eq = key[c] == T;
                        const unsigned long long em = __ballot(eq);
                        const int myrank = ties + __popcll(em & ltmask);
                        const bool take = gt || (eq && myrank < rties);
                        const unsigned long long tm = __ballot(take);
                        const int pos = base + __popcll(tm & ltmask);
                        if (take && pos < 256) sel[pos] = (unsigned short)(c * 64 + lane);
                        base += __popcll(tm); ties += __popcll(em);
                    }

                };
                if (nadm <= 512) topk(std::integral_constant<int, 8>{});
                else if (nadm <= 1024) topk(std::integral_constant<int, 16>{});
                else if (nadm <= 1536) topk(std::integral_constant<int, 24>{});
                else topk(std::integral_constant<int, 33>{});
                if (lane == 0) s_nsel[q] = 256;
            }
        }
        __syncthreads();
#pragma unroll 1
        for (int hi = 0; hi < 2; ++hi) {
            const int hh = wid * 2 + hi;
            bf16x8 acq[8];
#pragma unroll
            for (int kk = 0; kk < 8; ++kk) acq[kk] = *(const bf16x8*)(cqn + (n0 + fr) * 256 + kk * 32 + fq * 8);
            f32x4 c6[6] = {z4, z4, z4, z4, z4, z4};
#pragma unroll
            for (int kb = 0; kb < 8; kb += 4) {
                bf16x8 bf[4][6];
#pragma unroll
                for (int k4 = 0; k4 < 4; ++k4)
#pragma unroll
                    for (int nt = 0; nt < 6; ++nt) bf[k4][nt] = *(const bf16x8*)(wuqT + (size_t)(hh * 96 + nt * 16 + fr) * 256 + (kb + k4) * 32 + fq * 8);
#pragma unroll
                for (int k4 = 0; k4 < 4; ++k4)
#pragma unroll
                    for (int nt = 0; nt < 6; ++nt) c6[nt] = __builtin_amdgcn_mfma_f32_16x16x32_bf16(acq[kb + k4], bf[k4][nt], c6[nt], 0, 0, 0);
            }
#pragma unroll
            for (int j = 0; j < 4; ++j) {
                const int q = fq * 4 + j, t = t0 + q;
                const float cs = ctab[t * 16 + fr], sn = stab[t * 16 + fr];
                const float x1 = c6[4][j], x2 = c6[5][j];
                s_Q[(q * 16 + hh) * 160 + 128 + fr] = f2bf(x1 * cs - x2 * sn);
                s_Q[(q * 16 + hh) * 160 + 144 + fr] = f2bf(x2 * cs + x1 * sn);
#pragma unroll
                for (int nt = 0; nt < 4; ++nt) s_qn[q * 64 + nt * 16 + fr] = f2bf(c6[nt][j]);
            }
            __syncthreads();
            bf16x8 an[2];
#pragma unroll
            for (int ks = 0; ks < 2; ++ks) an[ks] = *(const bf16x8*)(s_qn + fr * 64 + ks * 32 + fq * 8);
            bf16x8 bwk[8][2];
#pragma unroll
            for (int nt = 0; nt < 8; ++nt)
#pragma unroll
                for (int ks = 0; ks < 2; ++ks) bwk[nt][ks] = *(const bf16x8*)(wuk + (size_t)(hh * 128 + nt * 16 + fr) * 64 + ks * 32 + fq * 8);
#pragma unroll
            for (int nt = 0; nt < 8; ++nt) {
                f32x4 a = z4;
#pragma unroll
                for (int ks = 0; ks < 2; ++ks)
                    a = __builtin_amdgcn_mfma_f32_16x16x32_bf16(an[ks], bwk[nt][ks], a, 0, 0, 0);
#pragma unroll
                for (int j = 0; j < 4; ++j) s_Q[((fq * 4 + j) * 16 + hh) * 160 + nt * 16 + fr] = f2bf(a[j]);
            }
            __syncthreads();
        }
#pragma unroll 1
        for (int qi2 = 0; qi2 < 2; ++qi2) {
            const int q = wid + qi2 * 8;
            bf16x8 bq[5];
#pragma unroll
            for (int ks = 0; ks < 5; ++ks) bq[ks] = *(const bf16x8*)(s_Q + (q * 16 + fr) * 160 + ks * 32 + fq * 8);
            const int nsel = s_nsel[q];
            const unsigned short* sel = s_sel + q * 256;
            float m = -INFINITY, lsum = 0.f;
            f32x4 O[8] = {z4, z4, z4, z4, z4, z4, z4, z4};
            const int nchunk = (nsel + 31) >> 5;
            bf16x8 akn[2][5];
#pragma unroll
            for (int mt = 0; mt < 2; ++mt) {
                const int ki = mt * 16 + fr;
                const int sidx = sel[ki < nsel ? ki : 0];
                const bf16_t* krow = kv + ((size_t)b * TS + sidx) * 160 + fq * 8;
#pragma unroll
                for (int ks = 0; ks < 5; ++ks) akn[mt][ks] = *(const bf16x8*)(krow + ks * 32);
            }
#pragma unroll 1
            for (int ch = 0; ch < nchunk; ++ch) {
                bf16x8 ak[2][5];
#pragma unroll
                for (int mt = 0; mt < 2; ++mt)
#pragma unroll
                    for (int ks = 0; ks < 5; ++ks) ak[mt][ks] = akn[mt][ks];
                if (ch + 1 < nchunk) {
#pragma unroll
                    for (int mt = 0; mt < 2; ++mt) {
                        const int ki = (ch + 1) * 32 + mt * 16 + fr;
                        const int sidx = sel[ki < nsel ? ki : 0];
                        const bf16_t* krow = kv + ((size_t)b * TS + sidx) * 160 + fq * 8;
#pragma unroll
                        for (int ks = 0; ks < 5; ++ks) akn[mt][ks] = *(const bf16x8*)(krow + ks * 32);
                    }
                }
#pragma unroll
                for (int mt = 0; mt < 2; ++mt)
#pragma unroll
                    for (int ks = 0; ks < 4; ++ks) {
                        const int r = mt * 16 + fr;
                        *(bf16x8*)(s_Vw + r * 256 + (((ks * 2 + (fq >> 1)) ^ (r & 7)) * 32) + (fq & 1) * 16) = ak[mt][ks];
                    }
                f32x4 st[2] = {z4, z4};
#pragma unroll
                for (int mt = 0; mt < 2; ++mt)
#pragma unroll
                    for (int ks = 0; ks < 5; ++ks) st[mt] = __builtin_amdgcn_mfma_f32_16x16x32_bf16(ak[mt][ks], bq[ks], st[mt], 0, 0, 0);
                float sv[2][4]; float cmax = -INFINITY;
#pragma unroll
                for (int mt = 0; mt < 2; ++mt)
#pragma unroll
                    for (int j = 0; j < 4; ++j) {
                        const int ke = ch * 32 + mt * 16 + fq * 4 + j;
                        const float s_ = (ke < nsel) ? st[mt][j] * scale : -INFINITY;
                        sv[mt][j] = s_; cmax = fmaxf(cmax, s_);
                    }
                cmax = fmaxf(cmax, __shfl_xor(cmax, 16)); cmax = fmaxf(cmax, __shfl_xor(cmax, 32));
                const float mnew = fmaxf(m, cmax);
                const float alpha = __expf(m - mnew);
                float psum = 0.f;
#pragma unroll
                for (int mt = 0; mt < 2; ++mt)
#pragma unroll
                    for (int j = 0; j < 4; ++j) { const float pe = __expf(sv[mt][j] - mnew); sv[mt][j] = pe; psum += pe; }
                psum += __shfl_xor(psum, 16); psum += __shfl_xor(psum, 32);
                lsum = lsum * alpha + psum; m = mnew;
#pragma unroll
                for (int ct = 0; ct < 8; ++ct) O[ct] = O[ct] * alpha;
                bf16x8 pf;
#pragma unroll
                for (int mt = 0; mt < 2; ++mt)
#pragma unroll
                    for (int j = 0; j < 4; ++j) pf[mt * 4 + j] = (short)f2bf(sv[mt][j]);
                const int q_ = fr >> 2, p_ = fr & 3;
                const int r0 = fq * 4 + q_, r1 = 16 + r0;
#pragma unroll
                for (int ct = 0; ct < 8; ++ct) {
                    const s16x4 v0 = __builtin_amdgcn_ds_read_tr16_b64_v4i16((__attribute__((address_space(3))) s16x4*)(s_Vw + r0 * 256 + ((ct ^ (r0 & 7)) * 32) + p_ * 8));
                    const s16x4 v1 = __builtin_amdgcn_ds_read_tr16_b64_v4i16((__attribute__((address_space(3))) s16x4*)(s_Vw + r1 * 256 + ((ct ^ (r1 & 7)) * 32) + p_ * 8));
                    bf16x8 av; av[0] = v0[0]; av[1] = v0[1]; av[2] = v0[2]; av[3] = v0[3]; av[4] = v1[0]; av[5] = v1[1]; av[6] = v1[2]; av[7] = v1[3];
                    O[ct] = __builtin_amdgcn_mfma_f32_16x16x32_bf16(av, pf, O[ct], 0, 0, 0);
                }
            }
            const float inv = 1.0f / lsum;
#pragma unroll
            for (int ct = 0; ct < 8; ++ct)
#pragma unroll
                for (int j = 0; j < 4; ++j) s_Q[(q * 16 + fr) * 160 + ct * 16 + fq * 4 + j] = f2bf(O[ct][j] * inv);
        }
        __syncthreads();
#pragma unroll 1
        for (int hi = 0; hi < 2; ++hi) {
            const int hh = wid * 2 + hi;
            bf16x8 ao[4];
#pragma unroll
            for (int ks = 0; ks < 4; ++ks) ao[ks] = *(const bf16x8*)(s_Q + (fr * 16 + hh) * 160 + ks * 32 + fq * 8);
#pragma unroll
            for (int nt = 0; nt < 4; ++nt) {
                f32x4 a = z4;
#pragma unroll
                for (int ks = 0; ks < 4; ++ks)
                    a = __builtin_amdgcn_mfma_f32_16x16x32_bf16(ao[ks], *(const bf16x8*)(wuvT + (size_t)(hh * 64 + nt * 16 + fr) * 128 + ks * 32 + fq * 8), a, 0, 0, 0);
#pragma unroll
                for (int j = 0; j < 4; ++j) yc[(n0 + fq * 4 + j) * 1024 + hh * 64 + nt * 16 + fr] = f2bf(a[j]);
            }
        }
        __syncthreads();
    }
}


__device__ void phase_lr_prep(const Params& p, int l) {
    const int lane = otid() & 63;
    const int wave = (obid() * NTHR + otid()) >> 6, nw = gridDim.x * NTHR / 64;
    const bf16_t* pm = (const bf16_t*)(WS(p) + OFF_PMISC);
    bf16_t* alr = (bf16_t*)(OUTB(p) + DO_ALR);
    const float4 mu4 = *(const float4*)(p.in[4] + (size_t)l * 3328 + 3072 + lane * 4);
    const float4 vm4 = *(const float4*)(p.in[18] + (lane & 7) * 4);
    struct In { uint2 c0, p0, c1, p1; };
    auto load = [&](int n) {
        In r;
        const bf16_t* row = pm + (size_t)n * PM_LD;
        const bool hp = (n % TS) > 0;
        r.c0 = *(const uint2*)(row + lane * 4);
        r.p0 = hp ? *(const uint2*)(row - PM_LD + lane * 4) : make_uint2(0u, 0u);
        r.c1 = make_uint2(0u, 0u); r.p1 = r.c1;
        if (lane < 8) { r.c1 = *(const uint2*)(row + 256 + lane * 4); if (hp) r.p1 = *(const uint2*)(row - PM_LD + 256 + lane * 4); }
        return r;
    };
    auto mix4 = [&](const uint2 c, const uint2 q, const float4 m, float (&o)[4]) {
        const float c0 = __uint_as_float(c.x << 16), c1 = __uint_as_float(c.x & 0xFFFF0000u), c2 = __uint_as_float(c.y << 16), c3 = __uint_as_float(c.y & 0xFFFF0000u);
        const float q0 = __uint_as_float(q.x << 16), q1 = __uint_as_float(q.x & 0xFFFF0000u), q2 = __uint_as_float(q.y << 16), q3 = __uint_as_float(q.y & 0xFFFF0000u);
        o[0] = c0 + (q0 - c0) * m.x; o[1] = c1 + (q1 - c1) * m.y; o[2] = c2 + (q2 - c2) * m.z; o[3] = c3 + (q3 - c3) * m.w;
    };
    In cur = load(wave < NT ? wave : 0);
    for (int n = wave; n < NT; n += nw) {
        const In x = cur;
        if (n + nw < NT) cur = load(n + nw);
        float o[4];
        mix4(x.c0, x.p0, mu4, o);
        if (lane < 16) { o[0] = tanhf(o[0]); o[1] = tanhf(o[1]); o[2] = tanhf(o[2]); o[3] = tanhf(o[3]); }
        else if (lane >= 32) { o[0] = sigmoidf_(o[0]); o[1] = sigmoidf_(o[1]); o[2] = sigmoidf_(o[2]); o[3] = sigmoidf_(o[3]); }
        *(uint2*)(alr + (size_t)n * 288 + lane * 4) = pack4(o[0], o[1], o[2], o[3]);
        if (lane < 8) {
            mix4(x.c1, x.p1, vm4, o);
            *(uint2*)(alr + (size_t)n * 288 + 256 + lane * 4) = pack4(o[0], o[1], o[2], o[3]);
        }
    }
}

typedef short sh4 __attribute__((ext_vector_type(4)));
__device__ __forceinline__ sh4 pk4v(const f32x4& v) { const uint2 u = pack4(v[0], v[1], v[2], v[3]); sh4 r; __builtin_memcpy(&r, &u, 8); return r; }
__device__ __forceinline__ bf16x8 cat8(const sh4& a, const sh4& b) { bf16x8 r; r[0] = a[0]; r[1] = a[1]; r[2] = a[2]; r[3] = a[3]; r[4] = b[0]; r[5] = b[1]; r[6] = b[2]; r[7] = b[3]; return r; }
#define MF32(a, b, c) __builtin_amdgcn_mfma_f32_16x16x32_bf16(a, b, c, 0, 0, 0)
#define MF16(a, b, c) MF32(cat8(a, sh4{0, 0, 0, 0}), cat8(b, sh4{0, 0, 0, 0}), c)
constexpr int SC_LT = 72;
constexpr int SC_LS = 36;
constexpr int SC_TC = 32;
constexpr int SC_ROWB = 1088;
__device__ __forceinline__ const unsigned char* scan_piece_src(const Params& p, int l, int b, int hc, int t0, int pi, bool& ok) {
    const int tau = pi / 68, seg = pi - tau * 68;
    const int t = t0 + tau;
    ok = (t < TS) && (tau < SC_TC);
    const size_t n = (size_t)b * TS + t;
    const unsigned char* ws = WS(p);
    if (seg < 8) return ws + OFF_PR + (n * 1024 + hc) * 2 + seg * 16;
    if (seg < 16) return ws + OFF_PK + (n * 1024 + hc) * 2 + (seg - 8) * 16;
    if (seg < 24) return ws + OFF_PV + (n * 1024 + hc) * 2 + (seg - 16) * 16;
    if (seg < 60) return OUTB(p) + DO_ALR + (n * 288) * 2 + (seg - 24) * 16;
    ok = ok && (l > 0);
    return ws + OFF_VFIRST + (n * 1024 + hc) * 2 + (seg - 60) * 16;
}
__device__ void phase_scan5(const Params& p, int l, unsigned char* lds, int blk) {
    const int tid = otid(), lane = tid & 63, wid = tid >> 6, fr = lane & 15, fq = lane >> 4;
    const int b = blk >> 4, hh = blk & 15, hc = hh * 64;
    float* s_r = (float*)lds;
    float* s_w = s_r + 2048;
    float* s_k = s_w + 2048;
    float* s_v = s_k + 2048;
    float* s_a = s_v + 2048;
    float* s_b = s_a + 2048;
    float* s_g = s_b + 2048;
    float* s_o = s_g + 2048;
    bf16_t* o_at = (bf16_t*)(s_o + 2048);
    bf16_t* o_rt = o_at + 32 * SC_LT;
    bf16_t* o_bt = o_rt + 32 * SC_LT;
    bf16_t* o_kt = o_bt + 32 * SC_LT;
    bf16_t* o_bT = o_kt + 32 * SC_LT;
    bf16_t* o_kT = o_bT + 64 * SC_LS;
    bf16_t* o_vT = o_kT + 64 * SC_LS;
    float* s_gc = (float*)(o_vT + 64 * SC_LS);
    unsigned char* raw = (unsigned char*)(s_gc + 128);
    float* prevb = (float*)(raw + 32 * SC_ROWB);
    unsigned* prevr = (unsigned*)prevb;
    float* s_bs = s_r;
    float* cst = prevb + 960;
    const float* mu = p.in[4] + (size_t)l * 3328;
    for (int e = tid; e < 480; e += NTHR) {
        float v;
        if (e < 192) v = mu[(e >> 6) * 1024 + hc + (e & 63)];
        else if (e < 448) v = mu[3072 + (e - 192)];
        else v = p.in[18][e - 448];
        cst[e] = v;
    }
    if (tid < 64) {
        cst[480 + tid] = p.in[7][l * 1024 + hc + tid];
        cst[544 + tid] = p.in[9][l * 1024 + hc + tid];
        cst[608 + tid] = p.in[12][l * 1024 + hc + tid];
        cst[672 + tid] = p.in[13][l * 1024 + hc + tid];
        cst[736 + tid] = p.in[14][l * 1024 + hc + tid];
        cst[800 + tid] = p.in[15][l * 1024 + hc + tid];
        cst[864 + tid] = p.in[16][l * 1024 + hc + tid];
        cst[928 + tid] = p.in[19][hc + tid];
    }
    const int mm = wid >> 1, ntb = (wid & 1) * 2;
    const int nks = (mm == 2) ? 4 : (mm == 3 ? 1 : 2);
    bf16x8 Bw[2][4];
    {
        const float* wsrc = (mm == 0) ? p.in[8] + (size_t)l * 64 * 1024 : (mm == 1) ? p.in[10] + (size_t)l * 64 * 1024 : (mm == 2) ? p.in[11] + (size_t)l * 128 * 1024 : p.in[20];
#pragma unroll
        for (int n2 = 0; n2 < 2; ++n2)
#pragma unroll
            for (int ks = 0; ks < 4; ++ks) {
                bf16x8 f;
#pragma unroll
                for (int j = 0; j < 8; ++j) {
                    const bool okw = ks < nks && (mm < 3 || l > 0);
                    const float v = wsrc[(size_t)(okw ? (ks * 32 + fq * 8 + j) : 0) * 1024 + hc + (ntb + n2) * 16 + fr];
                    f[j] = (short)f2bf(okw ? v : 0.f);
                }
                Bw[n2][ks] = f;
            }
    }
    const f32x4 z4 = {0.f, 0.f, 0.f, 0.f};
    f32x4 S[4] = {z4, z4, z4, z4};
    sh4 Lf;
#pragma unroll
    for (int j = 0; j < 4; ++j) Lf[j] = (fq * 4 + j <= fr) ? (short)0x3F80 : (short)0;
    bf16_t* Pr = (bf16_t*)(WS(p) + OFF_PR);
    bf16_t* vfirst = (bf16_t*)(WS(p) + OFF_VFIRST);
    const unsigned char* psrc[5]; int pstep[5], ptau[5]; bool pval[5];
#pragma unroll
    for (int k = 0; k < 5; ++k) {
        const int pi = tid + k * NTHR;
        bool ok = false;
        psrc[k] = scan_piece_src(p, l, b, hc, 0, pi < SC_TC * 68 ? pi : 0, ok);
        const int tau = (pi < SC_TC * 68 ? pi : 0) / 68, seg = (pi < SC_TC * 68 ? pi : 0) - tau * 68;
        ptau[k] = tau;
        pstep[k] = SC_TC * ((seg >= 24 && seg < 60) ? 576 : 2048);
        pval[k] = (pi < SC_TC * 68) && !(seg >= 60 && l == 0);
    }
    uint4 pre[5];
#pragma unroll
    for (int k = 0; k < 5; ++k) { pre[k] = make_uint4(0, 0, 0, 0); if (pval[k] && ptau[k] < TS) pre[k] = *(const uint4*)psrc[k]; }
    __syncthreads();
#pragma unroll 1
    for (int t0 = 0, ch = 0; t0 < TS; t0 += SC_TC, ++ch) {
        const int nval = (TS - t0 < SC_TC) ? (TS - t0) : SC_TC;
#pragma unroll
        for (int k = 0; k < 5; ++k) { const int pi = tid + k * NTHR; if (pi < SC_TC * 68) *(uint4*)(raw + pi * 16) = pre[k]; }
        lds_barrier();
#pragma unroll
        for (int k = 0; k < 5; ++k) {
            pre[k] = make_uint4(0, 0, 0, 0);
            if (pval[k] && t0 + SC_TC + ptau[k] < TS) pre[k] = *(const uint4*)(psrc[k] + (size_t)(ch + 1) * pstep[k]);
        }
        if (mm < 3 || l > 0) {
            const unsigned char* Ab = raw + ((mm == 0) ? 384 : (mm == 1) ? 512 : (mm == 2) ? 640 : 896);
            float* dst = (mm == 0) ? s_w : (mm == 1) ? s_a : (mm == 2) ? s_g : s_o;
#pragma unroll
            for (int m = 0; m < 2; ++m) {
                f32x4 acc0 = {0.f, 0.f, 0.f, 0.f}, acc1 = {0.f, 0.f, 0.f, 0.f};
#pragma unroll
                for (int ks = 0; ks < 4; ++ks) {
                    if (ks < nks) {
                        const bf16x8 a = *(const bf16x8*)(Ab + (m * 16 + fr) * SC_ROWB + ks * 64 + fq * 16);
                        acc0 = __builtin_amdgcn_mfma_f32_16x16x32_bf16(a, Bw[0][ks], acc0, 0, 0, 0);
                        acc1 = __builtin_amdgcn_mfma_f32_16x16x32_bf16(a, Bw[1][ks], acc1, 0, 0, 0);
                    }
                }
                if (mm == 0) {
                    const float cw0 = cst[480 + ntb * 16 + fr], cw1 = cst[480 + (ntb + 1) * 16 + fr];
                    f32x4 l0, l1, r0, r1;
#pragma unroll
                    for (int j = 0; j < 4; ++j) { l0[j] = -0.6065306597126334f * fast_sigmoid(acc0[j] + cw0); l1[j] = -0.6065306597126334f * fast_sigmoid(acc1[j] + cw1); }
                    const uint2 h0 = pack4(l0[0], l0[1], l0[2], l0[3]), h1 = pack4(l1[0], l1[1], l1[2], l1[3]);
                    r0[0] = l0[0] - __uint_as_float(h0.x << 16); r0[1] = l0[1] - __uint_as_float(h0.x & 0xFFFF0000u); r0[2] = l0[2] - __uint_as_float(h0.y << 16); r0[3] = l0[3] - __uint_as_float(h0.y & 0xFFFF0000u);
                    r1[0] = l1[0] - __uint_as_float(h1.x << 16); r1[1] = l1[1] - __uint_as_float(h1.x & 0xFFFF0000u); r1[2] = l1[2] - __uint_as_float(h1.y << 16); r1[3] = l1[3] - __uint_as_float(h1.y & 0xFFFF0000u);
                    sh4 hh0, hh1; __builtin_memcpy(&hh0, &h0, 8); __builtin_memcpy(&hh1, &h1, 8);
                    f32x4 c0 = MF16(Lf, pk4v(r0), z4), c1 = MF16(Lf, pk4v(r1), z4);
                    c0 = MF16(Lf, hh0, c0); c1 = MF16(Lf, hh1, c1);
#pragma unroll
                    for (int j = 0; j < 4; ++j) {
                        const int eo = (m * 16 + fq * 4 + j) * 64 + ntb * 16 + fr;
                        s_w[eo] = c0[j]; s_w[eo + 16] = c1[j];
                        s_b[eo] = l0[j]; s_b[eo + 16] = l1[j];
                    }
                } else {
#pragma unroll
                    for (int j = 0; j < 4; ++j) {
                        dst[(m * 16 + fq * 4 + j) * 64 + ntb * 16 + fr] = acc0[j];
                        dst[(m * 16 + fq * 4 + j) * 64 + (ntb + 1) * 16 + fr] = acc1[j];
                    }
                }
            }
        }
        lds_barrier();
        {
            const int tau = tid >> 4, c4 = (tid & 15) * 4, e = tau * 64 + c4, t = t0 + tau;
            const size_t n = (size_t)b * TS + t;
            const float4 cum4 = *(const float4*)(s_w + e), lw4 = *(const float4*)(s_b + e), xa4 = *(const float4*)(s_a + e);
            const float4 ca = *(const float4*)(cst + 544 + c4), ckk = *(const float4*)(cst + 608 + c4), cka = *(const float4*)(cst + 672 + c4), crk = *(const float4*)(cst + 736 + c4);
            const float cum[4] = {cum4.x, cum4.y, cum4.z, cum4.w}, lw[4] = {lw4.x, lw4.y, lw4.z, lw4.w};
            const float xa[4] = {xa4.x + ca.x, xa4.y + ca.y, xa4.z + ca.z, xa4.w + ca.w};
            const float kkc[4] = {ckk.x, ckk.y, ckk.z, ckk.w}, kac[4] = {cka.x, cka.y, cka.z, cka.w};
            float rr[4], kr[4], vv[4];
            {
                const unsigned char* rc = raw + tau * SC_ROWB + c4 * 2;
                const uint2 cr = *(const uint2*)rc, ck = *(const uint2*)(rc + 128), cv = *(const uint2*)(rc + 256);
                uint2 qr = make_uint2(0u, 0u), qk = qr, qv = qr;
                if (tau > 0) { qr = *(const uint2*)(rc - SC_ROWB); qk = *(const uint2*)(rc - SC_ROWB + 128); qv = *(const uint2*)(rc - SC_ROWB + 256); }
                else if (t0 > 0) { const unsigned* pvr = prevr + ((ch + 1) & 1) * 96 + (c4 >> 1); qr = *(const uint2*)pvr; qk = *(const uint2*)(pvr + 32); qv = *(const uint2*)(pvr + 64); }
                if (tau == SC_TC - 1) { unsigned* pwr = prevr + (ch & 1) * 96 + (c4 >> 1); *(uint2*)pwr = cr; *(uint2*)(pwr + 32) = ck; *(uint2*)(pwr + 64) = cv; }
                const float4 mr = *(const float4*)(cst + c4), mk = *(const float4*)(cst + 64 + c4), mv = *(const float4*)(cst + 128 + c4);
                const float c_[12] = {__uint_as_float(cr.x << 16), __uint_as_float(cr.x & 0xFFFF0000u), __uint_as_float(cr.y << 16), __uint_as_float(cr.y & 0xFFFF0000u),
                                      __uint_as_float(ck.x << 16), __uint_as_float(ck.x & 0xFFFF0000u), __uint_as_float(ck.y << 16), __uint_as_float(ck.y & 0xFFFF0000u),
                                      __uint_as_float(cv.x << 16), __uint_as_float(cv.x & 0xFFFF0000u), __uint_as_float(cv.y << 16), __uint_as_float(cv.y & 0xFFFF0000u)};
                const float q_[12] = {__uint_as_float(qr.x << 16), __uint_as_float(qr.x & 0xFFFF0000u), __uint_as_float(qr.y << 16), __uint_as_float(qr.y & 0xFFFF0000u),
                                      __uint_as_float(qk.x << 16), __uint_as_float(qk.x & 0xFFFF0000u), __uint_as_float(qk.y << 16), __uint_as_float(qk.y & 0xFFFF0000u),
                                      __uint_as_float(qv.x << 16), __uint_as_float(qv.x & 0xFFFF0000u), __uint_as_float(qv.y << 16), __uint_as_float(qv.y & 0xFFFF0000u)};
                const float m_[12] = {mr.x, mr.y, mr.z, mr.w, mk.x, mk.y, mk.z, mk.w, mv.x, mv.y, mv.z, mv.w};
#pragma unroll
                for (int j = 0; j < 4; ++j) { rr[j] = c_[j] + (q_[j] - c_[j]) * m_[j]; kr[j] = c_[4 + j] + (q_[4 + j] - c_[4 + j]) * m_[4 + j]; vv[j] = c_[8 + j] + (q_[8 + j] - c_[8 + j]) * m_[8 + j]; }
            }
            if (l > 0) {
                const float4 xv4 = *(const float4*)(s_o + e), cv = *(const float4*)(cst + 928 + c4);
                const uint2 vfu = *(const uint2*)(raw + tau * SC_ROWB + 960 + c4 * 2);
                const float vf[4] = {__uint_as_float(vfu.x << 16), __uint_as_float(vfu.x & 0xFFFF0000u), __uint_as_float(vfu.y << 16), __uint_as_float(vfu.y & 0xFFFF0000u)};
                const float xv[4] = {xv4.x + cv.x, xv4.y + cv.y, xv4.z + cv.z, xv4.w + cv.w};
#pragma unroll
                for (int j = 0; j < 4; ++j) vv[j] = vv[j] + (vf[j] - vv[j]) * fast_sigmoid(xv[j]);
            } else if (t < TS) {
                *(uint2*)(vfirst + n * 1024 + hc + c4) = pack4(vv[0], vv[1], vv[2], vv[3]);
            }
            float av[4], kkv[4], ginc[4], gexc[4], ginv[4]; float ss = 0.f;
#pragma unroll
            for (int j = 0; j < 4; ++j) {
                ginc[j] = __expf(cum[j]); gexc[j] = __expf(cum[j] - lw[j]); ginv[j] = __expf(-cum[j]);
                av[j] = fast_sigmoid(xa[j]);
                kkv[j] = kr[j] * kkc[j];
                ss += kkv[j] * kkv[j];
            }
            float kk[4], kt[4];
#pragma unroll
            for (int j = 0; j < 4; ++j) kt[j] = kr[j] * (1.0f + (av[j] - 1.0f) * kac[j]);
            float bsum = rr[0] * kt[0] * crk.x + rr[1] * kt[1] * crk.y + rr[2] * kt[2] * crk.z + rr[3] * kt[3] * crk.w;
            float du0 = 0.f, du1 = 0.f;
            row16_sum4(ss, bsum, du0, du1);
            if ((tid & 15) == 0) s_bs[tau] = bsum;
            const float rn = rsqrtf(fmaxf(ss, 1e-24f));
#pragma unroll
            for (int j = 0; j < 4; ++j) kk[j] = kkv[j] * rn;
            const uint2 pa = pack4(-kk[0] * gexc[0], -kk[1] * gexc[1], -kk[2] * gexc[2], -kk[3] * gexc[3]);
            const uint2 pr = pack4(rr[0] * ginc[0], rr[1] * ginc[1], rr[2] * ginc[2], rr[3] * ginc[3]);
            const uint2 pb = pack4(kk[0] * av[0] * ginv[0], kk[1] * av[1] * ginv[1], kk[2] * av[2] * ginv[2], kk[3] * av[3] * ginv[3]);
            const uint2 pk = pack4(kt[0] * ginv[0], kt[1] * ginv[1], kt[2] * ginv[2], kt[3] * ginv[3]);
            const uint2 pv = pack4(vv[0], vv[1], vv[2], vv[3]);
            *(uint2*)(o_at + tau * SC_LT + c4) = pa;
            *(uint2*)(o_rt + tau * SC_LT + c4) = pr;
            *(uint2*)(o_bt + tau * SC_LT + c4) = pb;
            *(uint2*)(o_kt + tau * SC_LT + c4) = pk;
            o_bT[(c4 + 0) * SC_LS + tau] = (bf16_t)(pb.x & 0xFFFFu); o_bT[(c4 + 1) * SC_LS + tau] = (bf16_t)(pb.x >> 16); o_bT[(c4 + 2) * SC_LS + tau] = (bf16_t)(pb.y & 0xFFFFu); o_bT[(c4 + 3) * SC_LS + tau] = (bf16_t)(pb.y >> 16);
            o_kT[(c4 + 0) * SC_LS + tau] = (bf16_t)(pk.x & 0xFFFFu); o_kT[(c4 + 1) * SC_LS + tau] = (bf16_t)(pk.x >> 16); o_kT[(c4 + 2) * SC_LS + tau] = (bf16_t)(pk.y & 0xFFFFu); o_kT[(c4 + 3) * SC_LS + tau] = (bf16_t)(pk.y >> 16);
            o_vT[(c4 + 0) * SC_LS + tau] = (bf16_t)(pv.x & 0xFFFFu); o_vT[(c4 + 1) * SC_LS + tau] = (bf16_t)(pv.x >> 16); o_vT[(c4 + 2) * SC_LS + tau] = (bf16_t)(pv.y & 0xFFFFu); o_vT[(c4 + 3) * SC_LS + tau] = (bf16_t)(pv.y >> 16);
            if ((tau & 15) == 15) *(float4*)(s_gc + (tau >> 4) * 64 + c4) = make_float4(ginc[0], ginc[1], ginc[2], ginc[3]);
            *(float4*)(s_v + e) = make_float4(vv[0], vv[1], vv[2], vv[3]);
        }
        lds_barrier();
        if (wid < 4) {
#pragma unroll
            for (int sc = 0; sc < 2; ++sc) {
                if (sc * 16 < nval) {
                    const bf16_t* ar = o_at + (sc * 16 + fr) * SC_LT;
                    const bf16_t* rr_ = o_rt + (sc * 16 + fr) * SC_LT;
                    const bf16_t* br = o_bt + (sc * 16 + fr) * SC_LT;
                    const bf16_t* kr_ = o_kt + (sc * 16 + fr) * SC_LT;
                    const bf16x8 fa0 = *(const bf16x8*)(ar + fq * 8), fa1 = *(const bf16x8*)(ar + 32 + fq * 8);
                    const bf16x8 fb0 = *(const bf16x8*)(br + fq * 8), fb1 = *(const bf16x8*)(br + 32 + fq * 8);
                    const bf16x8 fk0 = *(const bf16x8*)(kr_ + fq * 8), fk1 = *(const bf16x8*)(kr_ + 32 + fq * 8);
                    const bf16x8 fr0 = *(const bf16x8*)(rr_ + fq * 8), fr1 = *(const bf16x8*)(rr_ + 32 + fq * 8);
                    f32x4 nA = MF32(fb0, fa0, z4); nA = MF32(fb1, fa1, nA);
                    f32x4 nB = MF32(fa0, fb0, z4); nB = MF32(fa1, fb1, nB);
                    f32x4 mak = MF32(fk0, fa0, z4); mak = MF32(fk1, fa1, mak);
                    f32x4 mbr = MF32(fb0, fr0, z4); mbr = MF32(fb1, fr1, mbr);
                    f32x4 mkr = MF32(fk0, fr0, z4); mkr = MF32(fk1, fr1, mkr);
#pragma unroll
                    for (int j = 0; j < 4; ++j) {
                        const int s_ = fq * 4 + j;
                        nA[j] = (s_ < fr) ? nA[j] : 0.f; nB[j] = (fr < s_) ? nB[j] : 0.f; mak[j] = (s_ < fr) ? mak[j] : 0.f;
                        mbr[j] = (s_ <= fr) ? mbr[j] : 0.f; mkr[j] = (s_ <= fr) ? mkr[j] : 0.f;
                    }
                    const sh4 pNA = pk4v(nA), pNB = pk4v(nB), pMak = pk4v(mak), pMbr = pk4v(mbr), pMkr = pk4v(mkr);
                    const f32x4 n2B = MF16(pNA, pNB, z4), n2A = MF16(pNB, pNA, z4);
                    const sh4 pN2A = pk4v(n2A), pN2B = pk4v(n2B);
                    const f32x4 n4B = MF16(pN2A, pN2B, z4), n4A = MF16(pN2B, pN2A, z4);
                    const sh4 pN4A = pk4v(n4A), pN4B = pk4v(n4B);
                    const sh4 pN8A = pk4v(MF16(pN4B, pN4A, z4));
                    const bf16x8 sB0 = cat8(pk4v(S[0]), pk4v(S[1])), sB1 = cat8(pk4v(S[2]), pk4v(S[3]));
                    const sh4 vf = *(const sh4*)(o_vT + (wid * 16 + fr) * SC_LS + sc * 16 + fq * 4);
                    f32x4 X = MF32(cat8(*(const sh4*)(ar + fq * 4), *(const sh4*)(ar + 16 + fq * 4)), sB0, z4);
                    X = MF32(cat8(*(const sh4*)(ar + 32 + fq * 4), *(const sh4*)(ar + 48 + fq * 4)), sB1, X);
                    X = MF16(pMak, vf, X);
                    X = MF16(pN8A, pk4v(X), X); X = MF16(pN4A, pk4v(X), X); X = MF16(pN2A, pk4v(X), X); X = MF16(pNA, pk4v(X), X);
                    const sh4 pSA = pk4v(X);
                    f32x4 O = MF32(cat8(*(const sh4*)(rr_ + fq * 4), *(const sh4*)(rr_ + 16 + fq * 4)), sB0, z4);
                    O = MF32(cat8(*(const sh4*)(rr_ + 32 + fq * 4), *(const sh4*)(rr_ + 48 + fq * 4)), sB1, O);
                    const bf16x8 sav = cat8(pSA, vf);
                    O = MF32(cat8(pMbr, pMkr), sav, O);
#pragma unroll
                    for (int j = 0; j < 4; ++j) s_o[(sc * 16 + fq * 4 + j) * 64 + wid * 16 + fr] = O[j];
#pragma unroll
                    for (int jt = 0; jt < 4; ++jt) {
                        const sh4 ka = *(const sh4*)(o_kT + (jt * 16 + fr) * SC_LS + sc * 16 + fq * 4), ba = *(const sh4*)(o_bT + (jt * 16 + fr) * SC_LS + sc * 16 + fq * 4);
                        f32x4 acc = MF32(cat8(ba, ka), sav, S[jt]);
                        const float4 g4 = *(const float4*)(s_gc + sc * 64 + jt * 16 + fq * 4);
                        acc[0] *= g4.x; acc[1] *= g4.y; acc[2] *= g4.z; acc[3] *= g4.w;
                        S[jt] = acc;
                    }
                }
            }
        }
        lds_barrier();
        {
            const int tau = tid >> 4, c4 = (tid & 15) * 4, e = tau * 64 + c4;
            const size_t n = (size_t)b * TS + t0 + tau;
            const float4 o4 = *(const float4*)(s_o + e), v4_ = *(const float4*)(s_v + e), g4_ = *(const float4*)(s_g + e);
            const float4 clw = *(const float4*)(cst + 800 + c4), clb = *(const float4*)(cst + 864 + c4);
            const float bsum = s_bs[tau];
            const float m_ = row16_sum((o4.x + o4.y) + (o4.z + o4.w)) * (1.0f / 64.0f);
            const float d0 = o4.x - m_, d1 = o4.y - m_, d2 = o4.z - m_, d3 = o4.w - m_;
            const float var = row16_sum(d0 * d0 + d1 * d1 + d2 * d2 + d3 * d3) * (1.0f / 64.0f);
            const float rs = rsqrtf(var + 64e-5f);
            const float y0 = (d0 * rs * clw.x + clb.x + bsum * v4_.x) * g4_.x, y1 = (d1 * rs * clw.y + clb.y + bsum * v4_.y) * g4_.y;
            const float y2 = (d2 * rs * clw.z + clb.z + bsum * v4_.z) * g4_.z, y3 = (d3 * rs * clw.w + clb.w + bsum * v4_.w) * g4_.w;
            if (tau < nval) *(uint2*)(Pr + n * 1024 + hc + c4) = pack4(y0, y1, y2, y3);
        }
    }
}

__device__ __forceinline__ void xcd_panel_map(int& mt0, int& mstep, int& nt) {
    const int b = obid(), G = (int)gridDim.x;
    if (G == 256) { nt = (b >> 3) & 7; mt0 = (b & 7) * 4 + (b >> 6); mstep = 32; }
    else { nt = b & 7; mt0 = b >> 3; mstep = G >> 3; }
}
__device__ void phase_merge(const Params& p, unsigned char* lds) {
    const int tid = otid(), lane = tid & 63, wid = tid >> 6, wr = wid >> 1, wc = wid & 1, fr = lane & 15, fq = lane >> 4;
    const bf16_t* h = (const bf16_t*)(WS(p) + OFF_H);
    const bf16_t* wb = (const bf16_t*)(WS(p) + OFF_WB);
    const float* rstd = (const float*)(WS(p) + OFF_RSTD);
    bf16_t* merged = (bf16_t*)(WS(p) + OFF_MERGED);
    const bf16_t* ysrc0 = (const bf16_t*)(WS(p) + OFF_PPOOL);
    const bf16_t* ysrc1 = (const bf16_t*)(WS(p) + OFF_PR);
    const bf16_t* ysrc2 = (const bf16_t*)(OUTB(p) + DO_YC);
    for (int tile = obid(); tile < 86 * 8; tile += gridDim.x) {
        const int mt = tile >> 3, nt = tile & 7;
        const int row0 = mt * 192, col0 = nt * 128;
        uint2 maccp[3][4];
#pragma unroll
        for (int m = 0; m < 3; ++m)
#pragma unroll
            for (int n = 0; n < 4; ++n) maccp[m][n] = make_uint2(0u, 0u);
#pragma unroll 1
        for (int i = 0; i < 3; ++i) {
            const bf16_t* ys = (i == 0) ? ysrc0 : (i == 1 ? ysrc1 : ysrc2);
            uint2 sg[3][4];
            {
                f32x4 ag[3][4]; g3_zero<3>(ag);
                G3<192> g;
                g3_setup<192>(g, [&](int r) { return h + (size_t)(row0 + r) * DM; }, [&](int r) { return wb + WB_WG + (size_t)(i * 1024 + col0 + r) * DM; }, tid);
                g3_kloop<192>(ag, g, DM, lds);
#pragma unroll
                for (int m = 0; m < 3; ++m) {
                    const float rs = rstd[row0 + wr * 48 + m * 16 + fr];
#pragma unroll
                    for (int n = 0; n < 4; ++n) sg[m][n] = pack4(fast_sigmoid(ag[m][n][0] * rs), fast_sigmoid(ag[m][n][1] * rs), fast_sigmoid(ag[m][n][2] * rs), fast_sigmoid(ag[m][n][3] * rs));
                }
            }
            {
                f32x4 ay[3][4]; g3_zero<3>(ay);
                G3<192> g;
                g3_setup<192>(g, [&](int r) { return ys + (size_t)(row0 + r) * DM; }, [&](int r) { return wb + WB_PA + (size_t)(i * 1024 + col0 + r) * DM; }, tid);
                g3_kloop<192>(ay, g, DM, lds);
#pragma unroll
                for (int m = 0; m < 3; ++m)
#pragma unroll
                    for (int n = 0; n < 4; ++n) {
                        const float m0 = __uint_as_float(maccp[m][n].x << 16) + __uint_as_float(sg[m][n].x << 16) * ay[m][n][0];
                        const float m1 = __uint_as_float(maccp[m][n].x & 0xFFFF0000u) + __uint_as_float(sg[m][n].x & 0xFFFF0000u) * ay[m][n][1];
                        const float m2 = __uint_as_float(maccp[m][n].y << 16) + __uint_as_float(sg[m][n].y << 16) * ay[m][n][2];
                        const float m3 = __uint_as_float(maccp[m][n].y & 0xFFFF0000u) + __uint_as_float(sg[m][n].y & 0xFFFF0000u) * ay[m][n][3];
                        maccp[m][n] = pack4(m0, m1, m2, m3);
                    }
            }
        }
#pragma unroll
        for (int m = 0; m < 3; ++m) {
            const int row = row0 + wr * 48 + m * 16 + fr;
#pragma unroll
            for (int n = 0; n < 4; ++n)
                *(uint2*)(merged + (size_t)row * 1024 + col0 + wc * 64 + n * 16 + fq * 4) = maccp[m][n];
        }
    }
}

__device__ void phase_outproj(const Params& p, unsigned char* lds) {
    const int tid = otid(), lane = tid & 63, wid = tid >> 6, wr = wid >> 1, wc = wid & 1, fr = lane & 15, fq = lane >> 4;
    const bf16_t* h = (const bf16_t*)(WS(p) + OFF_H);
    const bf16_t* wb = (const bf16_t*)(WS(p) + OFF_WB);
    const bf16_t* merged = (const bf16_t*)(WS(p) + OFF_MERGED);
    float* hm = (float*)(WS(p) + OFF_HM32);
    int mt0, mstep, nt;
    xcd_panel_map(mt0, mstep, nt);
    for (int mt = mt0; mt < 86; mt += mstep) {
        const int row0 = mt * 192, col0 = nt * 128;
        G3<192> g;
        g3_setup<192>(g, [&](int r) { return merged + (size_t)(row0 + r) * DM; }, [&](int r) { return wb + WB_WO + (size_t)(col0 + r) * DM; }, tid);
        f32x4 acc[3][4]; g3_zero<3>(acc);
        g3_kloop<192>(acc, g, DM, lds);
#pragma unroll
        for (int m = 0; m < 3; ++m) {
            const int row = row0 + wr * 48 + m * 16 + fr;
#pragma unroll
            for (int n = 0; n < 4; ++n) {
                const int col = col0 + wc * 64 + n * 16 + fq * 4;
                const uint2 hv = *(const uint2*)(h + (size_t)row * 1024 + col);
                float4 o;
                o.x = __uint_as_float(hv.x << 16) + acc[m][n][0]; o.y = __uint_as_float(hv.x & 0xFFFF0000u) + acc[m][n][1];
                o.z = __uint_as_float(hv.y << 16) + acc[m][n][2]; o.w = __uint_as_float(hv.y & 0xFFFF0000u) + acc[m][n][3];
                *(float4*)(hm + (size_t)row * 1024 + col) = o;
            }
        }
    }
}

__device__ __constant__ int c_pair_lo[6] = {0, 0, 0, 1, 1, 2};
__device__ __constant__ int c_pair_hi[6] = {1, 2, 3, 2, 3, 3};
__device__ void phase_route(const Params& p, int l, unsigned char* lds) {
    const int tid = otid(), lane = tid & 63, wid = tid >> 6;
    const int per = (NT + (int)gridDim.x - 1) / (int)gridDim.x;
    const int nbeg = obid() * per, nend = (nbeg + per < NT) ? nbeg + per : NT;
    int* s_cls = (int*)lds;
    int* s_base = s_cls + 512;
    float* s_wr = (float*)(lds + 4096);
    const float* hm = (const float*)(WS(p) + OFF_HM32);
    bf16_t* hn = (bf16_t*)(WS(p) + OFF_HN);
    const float* nf = p.in[33] + (size_t)l * 1024;
    const float* wg = p.in[34] + (size_t)l * 1024 * 4;
    const float* bg = p.in[35] + l * 4;
    const float* we = p.in[36] + (size_t)l * 1024 * 16;
    const float* be = p.in[37] + l * 16;
    int* cnt = (int*)(WS(p) + OFF_CTL);
    int* list = (int*)(WS(p) + OFF_LIST);
    float* pw = (float*)(WS(p) + OFF_PW);
    for (int e = tid; e < 1024 * 20; e += NTHR) {
        const int k = e / 20, c = e - k * 20;
        s_wr[c * 1024 + k] = (c < 4) ? wg[(size_t)k * 4 + c] : we[(size_t)k * 16 + (c - 4)];
    }
    __syncthreads();
    for (int n = nbeg + wid; n < nend; n += 8) {
        float ss = 0.f;
#pragma unroll
        for (int i = 0; i < 4; ++i) {
            const float4 v = *(const float4*)(hm + (size_t)n * DM + i * 256 + lane * 4);
            ss += v.x * v.x + v.y * v.y + v.z * v.z + v.w * v.w;
        }
        ss = wave_sum(ss);
        const float rs = rsqrtf(ss * (1.0f / 1024.0f) + 1e-6f);
        float lg[4] = {0.f, 0.f, 0.f, 0.f};
        float le[16];
#pragma unroll
        for (int e = 0; e < 16; ++e) le[e] = 0.f;
#pragma unroll 1
        for (int i = 0; i < 4; ++i) {
            const float4 xv = *(const float4*)(hm + (size_t)n * DM + i * 256 + lane * 4);
            const float4 nv = *(const float4*)(nf + i * 256 + lane * 4);
            float y[4] = {xv.x * rs * nv.x, xv.y * rs * nv.y, xv.z * rs * nv.z, xv.w * rs * nv.w};
            {
                const int d0 = i * 256 + lane * 4;
#pragma unroll
                for (int g = 0; g < 4; ++g) { const float4 w4 = *(const float4*)(s_wr + g * 1024 + d0); lg[g] += y[0] * w4.x + y[1] * w4.y + y[2] * w4.z + y[3] * w4.w; }
#pragma unroll
                for (int e = 0; e < 16; ++e) { const float4 w4 = *(const float4*)(s_wr + (4 + e) * 1024 + d0); le[e] += y[0] * w4.x + y[1] * w4.y + y[2] * w4.z + y[3] * w4.w; }
            }
            *(uint2*)(hn + (size_t)n * DM + i * 256 + lane * 4) = pack4(y[0], y[1], y[2], y[3]);
        }
#pragma unroll
        for (int g = 0; g < 4; ++g) lg[g] = wave_sum_fast(lg[g]) + bg[g];
#pragma unroll
        for (int e = 0; e < 16; ++e) le[e] = wave_sum_fast(le[e]) + be[e];
        if (lane == 0) {
            int gs = 0; float gm = lg[0];
#pragma unroll
            for (int g = 1; g < 4; ++g) if (lg[g] > gm) { gm = lg[g]; gs = g; }
            float den = 0.f;
#pragma unroll
            for (int g = 0; g < 4; ++g) den += __expf(lg[g] - gm);
            const float pgrp = 1.0f / den;
            float v4[4];
#pragma unroll
            for (int e = 0; e < 4; ++e) {
                const float m0 = (gs == 0) ? 1.f : 0.f, m1s = (gs == 1) ? 1.f : 0.f, m2s = (gs == 2) ? 1.f : 0.f, m3s = (gs == 3) ? 1.f : 0.f;
                v4[e] = le[e] * m0 + le[4 + e] * m1s + le[8 + e] * m2s + le[12 + e] * m3s;
            }
            int i1 = 0; float m1 = v4[0];
#pragma unroll
            for (int e = 1; e < 4; ++e) if (v4[e] > m1) { m1 = v4[e]; i1 = e; }
            int i2 = -1; float m2 = -INFINITY;
#pragma unroll
            for (int e = 0; e < 4; ++e) if (e != i1 && v4[e] > m2) { m2 = v4[e]; i2 = e; }
            const float e2 = __expf(m2 - m1);
            const float p1 = pgrp / (1.0f + e2), p2 = pgrp * e2 / (1.0f + e2);
            const int lo = i1 < i2 ? i1 : i2, hi = i1 < i2 ? i2 : i1;
            const float plo = i1 < i2 ? p1 : p2, phi = i1 < i2 ? p2 : p1;
            const int pi = (lo == 0) ? (hi - 1) : (lo == 1 ? hi + 1 : 5);
            const int cls = gs * 6 + pi;
            s_cls[n - nbeg] = cls;
            pw[(size_t)n * 2 + 0] = plo; pw[(size_t)n * 2 + 1] = phi;
        }
    }
    __syncthreads();
    const int nloc = nend - nbeg;
    if (tid < 24) {
        int c_ = 0;
        for (int i = 0; i < nloc; ++i) c_ += (s_cls[i] == tid) ? 1 : 0;
        s_base[tid] = c_ ? atomicAdd(&cnt[tid * 32], c_) : 0;
    }
    __syncthreads();
    for (int it = tid; it < nloc; it += NTHR) {
        const int cls = s_cls[it];
        int rank = 0;
        for (int i = 0; i < it; ++i) rank += (s_cls[i] == cls) ? 1 : 0;
        list[(size_t)cls * NT + s_base[cls] + rank] = nbeg + it;
    }
    __syncthreads();
}


struct MoeTile { int cls, ti, cnt, tg; };
__device__ __forceinline__ int moe_total_tiles(const int* cnt) { int s = 0; for (int c = 0; c < 24; ++c) s += (cnt[c * 32] + 127) >> 7; return s; }
__device__ __forceinline__ MoeTile moe_find(const int* cnt, int tile) {
    MoeTile r; int s = 0; r.cls = 0; r.ti = 0; r.cnt = 0; r.tg = tile;
    for (int c = 0; c < 24; ++c) { const int nt = (cnt[c * 32] + 127) >> 7; if (tile >= s && tile < s + nt) { r.cls = c; r.ti = tile - s; r.cnt = cnt[c * 32]; } s += nt; }
    return r;
}
__device__ void phase_moe1(const Params& p, unsigned char* lds) {
    const int tid = otid(), lane = tid & 63, wid = tid >> 6, wr = wid >> 1, wc = wid & 1, fr = lane & 15, fq = lane >> 4;
    const int* cnt = (const int*)(WS(p) + OFF_CTL);
    const int* list = (const int*)(WS(p) + OFF_LIST);
    const float* pw = (const float*)(WS(p) + OFF_PW);
    const bf16_t* hn = (const bf16_t*)(WS(p) + OFF_HN);
    const bf16_t* we = (const bf16_t*)(WS(p) + OFF_WEXP);
    bf16_t* hid = (bf16_t*)(OUTB(p) + DO_HID);
    const int total = moe_total_tiles(cnt);
    for (int item = obid(); item < total * 4; item += gridDim.x) {
        const MoeTile mt = moe_find(cnt, item >> 2);
        const int nt = item & 3, slot = nt >> 1, f0 = (nt & 1) * 128;
        const int g_ = mt.cls / 6, pi = mt.cls % 6;
        const int e = g_ * 4 + (slot == 0 ? c_pair_lo[pi] : c_pair_hi[pi]);
        const int* lst = list + (size_t)mt.cls * NT + mt.ti * 128;
        const int nvalid = min(128, mt.cnt - mt.ti * 128);
        f32x4 a1[2][4], a3[2][4]; g3_zero<2>(a1); g3_zero<2>(a3);
        G3D g;
#pragma unroll
        for (int i = 0; i < 2; ++i) {
            const int idx = tid + i * NTHR, row = idx >> 3, sl = (idx & 7) ^ (row & 7);
            g.ap[i] = hn + (size_t)lst[row < nvalid ? row : 0] * DM + sl * 8;
            g.b1[i] = we + WE_W1 + ((size_t)e * 256 + f0 + row) * 1024 + sl * 8;
            g.b3[i] = we + WE_W3 + ((size_t)e * 256 + f0 + row) * 1024 + sl * 8;
        }
        g3d_kloop(a1, a3, g, DM, lds);
#pragma unroll
        for (int m = 0; m < 2; ++m) {
            const int lr = wr * 32 + m * 16 + fr;
            const int tk = lst[lr < nvalid ? lr : 0];
            const float pe = pw[(size_t)tk * 2 + slot];
#pragma unroll
            for (int n = 0; n < 4; ++n) {
                const int col = slot * 256 + f0 + wc * 64 + n * 16 + fq * 4;
                float o[4];
#pragma unroll
                for (int j = 0; j < 4; ++j) { const float x1 = a1[m][n][j]; o[j] = x1 * sigmoidf_(x1) * a3[m][n][j] * pe; }
                *(uint2*)(hid + ((size_t)mt.tg * 128 + lr) * 512 + col) = pack4(o[0], o[1], o[2], o[3]);
            }
        }
    }
}
__device__ void phase_moe2(const Params& p, unsigned char* lds) {
    const int tid = otid(), lane = tid & 63, wid = tid >> 6, wr = wid >> 1, wc = wid & 1, fr = lane & 15, fq = lane >> 4;
    const int* cnt = (const int*)(WS(p) + OFF_CTL);
    const int* list = (const int*)(WS(p) + OFF_LIST);
    const bf16_t* we = (const bf16_t*)(WS(p) + OFF_WEXP);
    const bf16_t* hid = (const bf16_t*)(OUTB(p) + DO_HID);
    float* hm = (float*)(WS(p) + OFF_HM32);
    bf16_t* h = (bf16_t*)(WS(p) + OFF_H);
    const int total = moe_total_tiles(cnt);
    for (int item = obid(); item < total * 8; item += gridDim.x) {
        const MoeTile mt = moe_find(cnt, item >> 3);
        const int nt = item & 7, col0 = nt * 128;
        const int g_ = mt.cls / 6, pi = mt.cls % 6;
        const int elo = g_ * 4 + c_pair_lo[pi], ehi = g_ * 4 + c_pair_hi[pi];
        const int* lst = list + (size_t)mt.cls * NT + mt.ti * 128;
        const int nvalid = min(128, mt.cnt - mt.ti * 128);
        f32x4 acc[2][4]; g3_zero<2>(acc);
        G3<128> g;
        g3_setup<128>(g, [&](int r) { return hid + ((size_t)mt.tg * 128 + r) * 512; }, [&](int r) { return we + WE_W2 + ((size_t)elo * 1024 + col0 + r) * 256; }, tid);
        g3_kloop<128>(acc, g, 256, lds);
        g3_setup<128>(g, [&](int r) { return hid + ((size_t)mt.tg * 128 + r) * 512 + 256; }, [&](int r) { return we + WE_W2 + ((size_t)ehi * 1024 + col0 + r) * 256; }, tid);
        g3_kloop<128>(acc, g, 256, lds);
#pragma unroll
        for (int m = 0; m < 2; ++m) {
            const int lr = wr * 32 + m * 16 + fr;
            if (lr < nvalid) {
                const int tk = lst[lr];
#pragma unroll
                for (int n = 0; n < 4; ++n) {
                    const int col = col0 + wc * 64 + n * 16 + fq * 4;
                    float4 v = *(const float4*)(hm + (size_t)tk * 1024 + col);
                    v.x += acc[m][n][0]; v.y += acc[m][n][1]; v.z += acc[m][n][2]; v.w += acc[m][n][3];
                    *(float4*)(hm + (size_t)tk * 1024 + col) = v;
                    *(uint2*)(h + (size_t)tk * 1024 + col) = pack4(v.x, v.y, v.z, v.w);
                }
            }
        }
    }
}

__device__ void phase_final(const Params& p) {
    const int lane = otid() & 63;
    const int wave = (obid() * NTHR + otid()) >> 6, nw = gridDim.x * NTHR / 64;
    const float* hm = (const float*)(WS(p) + OFF_HM32);
    const float* nf = p.in[41];
    for (int r = wave; r < NB * SEQ; r += nw) {
        const int b = r / SEQ, s = r % SEQ;
        const size_t n = (size_t)b * TS + NMETA + s;
        float4 v[4]; float ss = 0.f;
#pragma unroll
        for (int i = 0; i < 4; ++i) { v[i] = *(const float4*)(hm + n * DM + i * 256 + lane * 4); ss += v[i].x * v[i].x + v[i].y * v[i].y + v[i].z * v[i].z + v[i].w * v[i].w; }
        ss = wave_sum(ss);
        const float rs = rsqrtf(ss * (1.0f / 1024.0f) + 1e-6f);
#pragma unroll
        for (int i = 0; i < 4; ++i) {
            const float4 g = *(const float4*)(nf + i * 256 + lane * 4);
            float4 o; o.x = v[i].x * rs * g.x; o.y = v[i].y * rs * g.y; o.z = v[i].z * rs * g.z; o.w = v[i].w * rs * g.w;
            *(float4*)((float*)OUTB(p) + (size_t)r * DM + i * 256 + lane * 4) = o;
        }
    }
}


#define XB_TMO      128
#define XB_XCNT(j)  (256  + 64 * (j))
#define XB_XSUB(j)  (1280 + 64 * (j))
#define XB_XGEN(j)  (2304 + 64 * (j))
#define XB_TOP      3328
#define XB_TOPGEN   3392
#define XCD_BAR_WORDS 3456
#define XB_SPIN_CAP (1u << 22)
#define LAS __attribute__((address_space(3)))
__device__ __forceinline__ unsigned xb_ld(unsigned* p) { return __hip_atomic_load(p, __ATOMIC_RELAXED, __HIP_MEMORY_SCOPE_AGENT); }
__device__ __forceinline__ unsigned xb_add(unsigned* p, unsigned v) { return __hip_atomic_fetch_add(p, v, __ATOMIC_RELAXED, __HIP_MEMORY_SCOPE_AGENT); }
__device__ __forceinline__ unsigned xb_xcc_id() { return (unsigned)__builtin_amdgcn_s_getreg((3 << 11) | 20) & 0xFu; }
#define XB_SPIN(cond, bar) do { unsigned _sp = 0; while (cond) { __builtin_amdgcn_s_sleep(1); \
    if ((++_sp & 255u) == 0u) { if (xb_ld(&(bar)[XB_TMO])) break; if (_sp > XB_SPIN_CAP) { atomicAdd(&(bar)[XB_TMO], 1u); break; } } } } while (0)
struct XcdBarrier { unsigned* bar; unsigned x; volatile LAS unsigned* st; };
__device__ __forceinline__ XcdBarrier xcd_barrier_post(unsigned* bar, volatile LAS unsigned* st) {
    XcdBarrier b; b.bar = bar; b.x = xb_xcc_id(); b.st = st;
    if (threadIdx.x == 0) (void)xb_add(&bar[XB_XCNT(b.x)], 1u);
    return b;
}
__device__ __forceinline__ void xcd_barrier_complete(unsigned* bar, unsigned x, unsigned& nloc, unsigned& nx) {
    const unsigned G = gridDim.x * gridDim.y * gridDim.z;
    unsigned sum, cnt, mine, sp = 0u;
    for (;;) {
        sum = 0u; cnt = 0u; mine = 0u;
#pragma unroll
        for (unsigned j = 0; j < 16; ++j) { const unsigned c = xb_ld(&bar[XB_XCNT(j)]); sum += c; cnt += (c > 0u) ? 1u : 0u; mine = (j == x) ? c : mine; }
        if (sum == G) break;
        __builtin_amdgcn_s_sleep(1);
        if ((++sp & 255u) == 0u) { if (xb_ld(&bar[XB_TMO])) break; if (sp > XB_SPIN_CAP) { atomicAdd(&bar[XB_TMO], 1u); break; } }
    }
    nloc = mine > 0u ? mine : 1u; nx = cnt > 0u ? cnt : 1u;
}
__device__ __forceinline__ void xcd_barrier(const XcdBarrier& b) {
    asm volatile("s_waitcnt vmcnt(0)" ::: "memory");
    __syncthreads();
    if (threadIdx.x == 0) {
        unsigned* bar = b.bar;
        __builtin_amdgcn_s_waitcnt(0);
        unsigned nloc = b.st[0], nx = b.st[1];
        if (nloc == 0u) { xcd_barrier_complete(bar, b.x, nloc, nx); b.st[0] = nloc; b.st[1] = nx; }
        const unsigned old = xb_add(&bar[XB_XSUB(b.x)], 1u);
        const unsigned gen = old / nloc;
        if (old + 1u == (gen + 1u) * nloc) {
            __builtin_amdgcn_fence(__ATOMIC_RELEASE, "agent");
            asm volatile("s_waitcnt vmcnt(0)" ::: "memory");
            const unsigned og = xb_add(&bar[XB_TOP], 1u);
            const unsigned tg = og / nx;
            if (og + 1u == (tg + 1u) * nx) xb_add(&bar[XB_TOPGEN], 1u);
            else XB_SPIN(xb_ld(&bar[XB_TOPGEN]) == tg, bar);
            __builtin_amdgcn_fence(__ATOMIC_ACQUIRE, "agent");
            xb_add(&bar[XB_XGEN(b.x)], 1u);
            asm volatile("s_waitcnt vmcnt(0)" ::: "memory");
        } else {
            XB_SPIN(xb_ld(&bar[XB_XGEN(b.x)]) == gen, bar);
            __builtin_amdgcn_fence(__ATOMIC_ACQUIRE, "agent");
            asm volatile("s_waitcnt vmcnt(0)" ::: "memory");
        }
    }
    __syncthreads();
}

__global__ void __launch_bounds__(NTHR) fwd_megakernel(Params p) {
    extern __shared__ __attribute__((aligned(16))) unsigned char lds[];
    cg::grid_group grid = cg::this_grid();
    volatile LAS unsigned* xst = (volatile LAS unsigned*)(lds + LDS_BYTES - 32);
    if (threadIdx.x < 2) xst[threadIdx.x] = 0u;
    __syncthreads();
    const XcdBarrier xb = xcd_barrier_post((unsigned*)(p.ws + OFF_BAR), xst);
    if (p.out == nullptr) grid.sync();
#pragma unroll 1
    for (int step = 0; step < 18; ++step) {
        const int l = step >= 9 ? 1 : 0;
        const int ph = step - l * 9;
        switch (ph) {
        case 0:
            if (l == 0) phase_embed(p); else phase_rowstat(p);
            phase_convert<false>(p, l, lds);
            if (obid() == 0 && otid() < 24) ((int*)(WS(p) + OFF_CTL))[otid() * 32] = 0;
            if (obid() == 0 && otid() == 32) ((int*)(WS(p) + OFF_CTL))[800 + l * 32] = 0;
            break;
        case 1: phase_inproj(p, lds); break;
        case 2: phase_dsa_prep(p, l); phase_lr_prep(p, l); break;
        case 3: {
            if (obid() < NB * 16) phase_scan5(p, l, lds, obid());
            int* qctr = (int*)(WS(p) + OFF_CTL) + 800 + l * 32;
            int* qslot = (int*)(lds + LDS_BYTES - 16);
            for (;;) {
                __syncthreads();
                if (otid() == 0) *qslot = atomicAdd(qctr, 1);
                __syncthreads();
                const int item = *qslot;
                if (item >= 516 + NT / 16 + 3072) break;
                if (item < 516) phase_pool(p, l, lds, item, item + 1, 1);
                else if (item < 516 + NT / 16) phase_dsa<false>(p, l, lds, (bf16_t*)(OUTB(p) + DO_YC), nullptr, nullptr, item - 516, item - 515, 1);
                else {
                    const int ct = item - (516 + NT / 16);
                    const ConvJob cj = get_job_late(p, l, ct >> 10);
                    conv_tile(cj, ct & 1023, (float*)lds);
                }
            }
        } break;
        case 4: phase_merge(p, lds); break;
        case 5: phase_outproj(p, lds); break;
        case 6: phase_route(p, l, lds); break;
        case 7: phase_moe1(p, lds); break;
        default: phase_moe2(p, lds); break;
        }
        xcd_barrier(xb);
    }
    phase_final(p);
}

extern "C" void kernel_launch(void* const* d_in, const int* in_sizes, int n_in,
                              void* d_out, int out_size, void* d_ws, size_t ws_size,
                              hipStream_t stream) {
    static int grid_blocks = 0;
    if (grid_blocks == 0) {
        int dev = 0, cus = 0, per_cu = 0;
        (void)hipGetDevice(&dev);
        (void)hipDeviceGetAttribute(&cus, hipDeviceAttributeMultiprocessorCount, dev);
        (void)hipFuncSetAttribute((const void*)fwd_megakernel, hipFuncAttributeMaxDynamicSharedMemorySize, LDS_BYTES);
        (void)hipOccupancyMaxActiveBlocksPerMultiprocessor(&per_cu, fwd_megakernel, NTHR, LDS_BYTES);
        if (per_cu < 1 || cus < NB * 16 || (cus & 7) != 0 || n_in != 42 || ws_size < WS_END) { fprintf(stderr, "kernel_launch: bad config per_cu=%d n_in=%d ws=%zu need=%zu\n", per_cu, n_in, ws_size, (size_t)WS_END); grid_blocks = -1; }
        else grid_blocks = cus;
    }
    if (grid_blocks < 0) return;
    Params p{};
    for (int i = 0; i < 42; ++i) p.in[i] = (const float*)d_in[i];
    p.out = (float*)d_out;
    p.ws = (unsigned char*)d_ws;
    (void)hipMemsetAsync((unsigned char*)d_ws + OFF_BAR, 0, XCD_BAR_WORDS * 4, stream);
    void* args[] = {&p};
    hipError_t e = hipLaunchCooperativeKernel((void*)fwd_megakernel, dim3(grid_blocks), dim3(NTHR), args, LDS_BYTES, stream);
    if (e != hipSuccess) fprintf(stderr, "cooperative launch failed: %s (grid %d)\n", hipGetErrorString(e), grid_blocks);
}
```

```cpp
#include <hip/hip_runtime.h>
#include <hip/hip_cooperative_groups.h>
#include <cstdio>
#include <cstdint>
#include <type_traits>
namespace cg = cooperative_groups;

typedef unsigned short bf16_t;
typedef short bf16x8 __attribute__((ext_vector_type(8)));
typedef float f32x4 __attribute__((ext_vector_type(4)));

constexpr int NB = 8, SEQ = 2048, NMETA = 16, TS = 2064, DM = 1024;
constexpr int NT = NB * TS;
constexpr int NTP = 16640;
constexpr int NTHR = 512;
constexpr int CIN = 7912;
constexpr int NP1 = 4864;
constexpr int PM_LD = 768;
constexpr int PM_WD = 0, PM_AD = 64, PM_GD = 128, PM_VD = 256, PM_CQ = 288, PM_CKV = 544, PM_KROPE = 672, PM_KIDX = 704;
constexpr int LDS_BYTES = 157 * 1024;

constexpr size_t AL(size_t x) { return (x + 255) & ~(size_t)255; }
constexpr size_t SZ_ACT = (size_t)NTP * 1024 * 2;
constexpr size_t OFF_CTL = 0;
constexpr size_t OFF_BAR = 4096;
constexpr size_t OFF_RSTD = OFF_BAR + 16384;
constexpr size_t OFF_ROPE = OFF_RSTD + AL((size_t)NTP * 4);
constexpr size_t OFF_H = OFF_ROPE + AL((size_t)TS * 16 * 4 * 2);
constexpr size_t OFF_WB = OFF_H + SZ_ACT;
constexpr size_t WB_WIN = 0;
constexpr size_t WB_WG = WB_WIN + (size_t)NP1 * 1024;
constexpr size_t WB_PA = WB_WG + (size_t)3072 * 1024;
constexpr size_t WB_WO = WB_PA + (size_t)3 * 1024 * 1024;
constexpr size_t WB_POOL = WB_WO + (size_t)1024 * 1024;
constexpr size_t WB_QI = WB_POOL + (size_t)4 * 256 * 256;
constexpr size_t WB_UQ = WB_QI + (size_t)512 * 256;
constexpr size_t WB_UK = WB_UQ + (size_t)1536 * 256;
constexpr size_t WB_UV = WB_UK + (size_t)16 * 128 * 64;
constexpr size_t WB_WIDX = WB_UV + (size_t)16 * 64 * 128;
constexpr size_t WB_END = WB_WIDX + (size_t)64 * 1024;
constexpr size_t OFF_PPOOL = OFF_WB + AL(WB_END * 2);
constexpr size_t OFF_PK = OFF_PPOOL + SZ_ACT;
constexpr size_t OFF_PR = OFF_PK + SZ_ACT;
constexpr size_t OFF_PV = OFF_PR + SZ_ACT;
constexpr size_t OFF_PMISC = OFF_PV + SZ_ACT;
constexpr size_t OFF_VFIRST = OFF_PMISC + AL((size_t)NTP * PM_LD * 2);
constexpr size_t OFF_HALO = OFF_VFIRST + SZ_ACT;
constexpr size_t OFF_LIST = OFF_HALO + AL((size_t)130 * 16 * 1024 * 2);
constexpr size_t OFF_PW = OFF_LIST + AL((size_t)24 * NT * 4);
constexpr size_t WS_END = OFF_PW + AL((size_t)NT * 2 * 4);
constexpr size_t OFF_MERGED = OFF_PK;
constexpr size_t OFF_HM32 = OFF_PR;
constexpr size_t OFF_HN = OFF_PPOOL;
constexpr size_t OFF_WEXP = OFF_PMISC;
constexpr size_t WE_W1 = 0, WE_W3 = (size_t)16 * 256 * 1024, WE_W2 = (size_t)2 * 16 * 256 * 1024;
static_assert((size_t)3 * 16 * 256 * 1024 * 2 <= (size_t)NTP * PM_LD * 2, "expert weights must fit in Pmisc");
constexpr size_t DO_YC = 0;
constexpr size_t DO_CQN = DO_YC + SZ_ACT;
constexpr size_t DO_KV = DO_CQN + AL((size_t)NT * 256 * 2);
constexpr size_t DO_KIDX = DO_KV + AL((size_t)NT * 160 * 2);
constexpr size_t DO_WHEAD = DO_KIDX + AL((size_t)NT * 64 * 2);
constexpr size_t DO_ALR = DO_WHEAD + AL((size_t)NT * 8 * 4);
constexpr size_t DO_END = DO_ALR + AL((size_t)NT * 288 * 2);
constexpr size_t DO_HID = DO_YC;
static_assert(DO_END <= (size_t)NB * SEQ * DM * 4, "d_out scratch overflow");
static_assert((size_t)(129 + 24) * 128 * 512 * 2 <= SZ_ACT, "hid fits");
static_assert(WS_END <= 277240096ull, "workspace overflow");

struct Params {
    const float* in[42];
    float* out;
    unsigned char* ws;
};

__device__ __forceinline__ int otid() { int t = threadIdx.x; asm volatile("" : "+v"(t)); return t; }
__device__ __forceinline__ int obid() { int b = blockIdx.x; asm volatile("" : "+s"(b)); return b; }
__device__ __forceinline__ unsigned char* WS(const Params& p) { unsigned char* w = p.ws; asm volatile("" : "+s"(w)); return w; }
__device__ __forceinline__ unsigned char* OUTB(const Params& p) { unsigned char* w = (unsigned char*)p.out; asm volatile("" : "+s"(w)); return w; }
__device__ __forceinline__ float bf2f(bf16_t v) { return __uint_as_float(((unsigned)v) << 16); }
typedef float f32x2v __attribute__((ext_vector_type(2)));
typedef __bf16 bf16x2v __attribute__((ext_vector_type(2)));
__device__ __forceinline__ unsigned pk2(float a, float b) { const f32x2v v = {a, b}; const bf16x2v r = __builtin_convertvector(v, bf16x2v); unsigned u; __builtin_memcpy(&u, &r, 4); return u; }
__device__ __forceinline__ bf16_t f2bf(float f) { const __bf16 h = (__bf16)f; bf16_t u; __builtin_memcpy(&u, &h, 2); return u; }
__device__ __forceinline__ float wave_sum(float v) {
#pragma unroll
    for (int o = 32; o > 0; o >>= 1) v += __shfl_xor(v, o);
    return v;
}
template <int CTRL> __device__ __forceinline__ float dpp_f(float x) {
    return __int_as_float(__builtin_amdgcn_update_dpp(0, __float_as_int(x), CTRL, 0xF, 0xF, true));
}
__device__ __forceinline__ float row16_sum(float v) {
    v += dpp_f<0xB1>(v);
    v += dpp_f<0x4E>(v);
    v += dpp_f<0x141>(v);
    v += dpp_f<0x140>(v);
    return v;
}
__device__ __forceinline__ void lds_barrier() { asm volatile("s_waitcnt lgkmcnt(0)" ::: "memory"); __builtin_amdgcn_s_barrier(); asm volatile("" ::: "memory"); }
__device__ __forceinline__ float fast_rcp(float x) { return __builtin_amdgcn_rcpf(x); }
__device__ __forceinline__ float fast_sigmoid(float x) { return fast_rcp(1.0f + __expf(-x)); }
__device__ __forceinline__ float fast_tanh(float x) { return 1.0f - 2.0f * fast_rcp(1.0f + __expf(2.0f * x)); }
__device__ __forceinline__ void row16_sum4(float& a, float& b, float& c, float& d) {
    asm volatile(
        "s_nop 1\n\t"
        "v_add_f32_dpp %0, %0, %0 quad_perm:[1,0,3,2] row_mask:0xf bank_mask:0xf\n\t"
        "v_add_f32_dpp %1, %1, %1 quad_perm:[1,0,3,2] row_mask:0xf bank_mask:0xf\n\t"
        "v_add_f32_dpp %2, %2, %2 quad_perm:[1,0,3,2] row_mask:0xf bank_mask:0xf\n\t"
        "v_add_f32_dpp %3, %3, %3 quad_perm:[1,0,3,2] row_mask:0xf bank_mask:0xf\n\t"
        "v_add_f32_dpp %0, %0, %0 quad_perm:[2,3,0,1] row_mask:0xf bank_mask:0xf\n\t"
        "v_add_f32_dpp %1, %1, %1 quad_perm:[2,3,0,1] row_mask:0xf bank_mask:0xf\n\t"
        "v_add_f32_dpp %2, %2, %2 quad_perm:[2,3,0,1] row_mask:0xf bank_mask:0xf\n\t"
        "v_add_f32_dpp %3, %3, %3 quad_perm:[2,3,0,1] row_mask:0xf bank_mask:0xf\n\t"
        "v_add_f32_dpp %0, %0, %0 row_half_mirror row_mask:0xf bank_mask:0xf\n\t"
        "v_add_f32_dpp %1, %1, %1 row_half_mirror row_mask:0xf bank_mask:0xf\n\t"
        "v_add_f32_dpp %2, %2, %2 row_half_mirror row_mask:0xf bank_mask:0xf\n\t"
        "v_add_f32_dpp %3, %3, %3 row_half_mirror row_mask:0xf bank_mask:0xf\n\t"
        "v_add_f32_dpp %0, %0, %0 row_mirror row_mask:0xf bank_mask:0xf\n\t"
        "v_add_f32_dpp %1, %1, %1 row_mirror row_mask:0xf bank_mask:0xf\n\t"
        "v_add_f32_dpp %2, %2, %2 row_mirror row_mask:0xf bank_mask:0xf\n\t"
        "v_add_f32_dpp %3, %3, %3 row_mirror row_mask:0xf bank_mask:0xf\n\t"
        "s_nop 1"
        : "+v"(a), "+v"(b), "+v"(c), "+v"(d));
}
__device__ __forceinline__ void row8_sum2(float& a, float& b) {
    asm volatile(
        "s_nop 1\n\t"
        "v_add_f32_dpp %0, %0, %0 quad_perm:[1,0,3,2] row_mask:0xf bank_mask:0xf\n\t"
        "v_add_f32_dpp %1, %1, %1 quad_perm:[1,0,3,2] row_mask:0xf bank_mask:0xf\n\t"
        "s_nop 0\n\t"
        "v_add_f32_dpp %0, %0, %0 quad_perm:[2,3,0,1] row_mask:0xf bank_mask:0xf\n\t"
        "v_add_f32_dpp %1, %1, %1 quad_perm:[2,3,0,1] row_mask:0xf bank_mask:0xf\n\t"
        "s_nop 0\n\t"
        "v_add_f32_dpp %0, %0, %0 row_half_mirror row_mask:0xf bank_mask:0xf\n\t"
        "v_add_f32_dpp %1, %1, %1 row_half_mirror row_mask:0xf bank_mask:0xf\n\t"
        "s_nop 1"
        : "+v"(a), "+v"(b));
}
__device__ __forceinline__ float wave_sum_fast(float v) { v = row16_sum(v); v += __shfl_xor(v, 16); v += __shfl_xor(v, 32); return v; }
__device__ __forceinline__ float sigmoidf_(float x) { return 1.0f / (1.0f + __expf(-x)); }
__device__ __forceinline__ float softplusf_(float z) { return fmaxf(z, 0.f) + log1pf(__expf(-fabsf(z))); }
__device__ __forceinline__ void glds16(const void* g, void* l) {
    __builtin_amdgcn_global_load_lds((const unsigned*)g, (unsigned*)l, 16, 0, 0);
}

__device__ void phase_embed(const Params& p) {
    const int lane = otid() & 63;
    const int wave = (obid() * NTHR + otid()) >> 6, nw = gridDim.x * NTHR / 64;
    bf16_t* h = (bf16_t*)(WS(p) + OFF_H);
    float* rstd = (float*)(WS(p) + OFF_RSTD);
    auto srcrow = [&](int n) { const int b = n / TS, t = n % TS; return t < NMETA ? p.in[1] + (size_t)t * DM : p.in[0] + ((size_t)b * SEQ + (t - NMETA)) * DM; };
    float4 cur[4];
    if (wave < NT) {
        const float* src = srcrow(wave);
#pragma unroll
        for (int i = 0; i < 4; ++i) cur[i] = *(const float4*)(src + i * 256 + lane * 4);
    }
    for (int n = wave; n < NTP; n += nw) {
        if (n < NT) {
            float4 v[4];
#pragma unroll
            for (int i = 0; i < 4; ++i) v[i] = cur[i];
            if (n + nw < NT) {
                const float* src = srcrow(n + nw);
#pragma unroll
                for (int i = 0; i < 4; ++i) cur[i] = *(const float4*)(src + i * 256 + lane * 4);
            }
            float ss = 0.f;
#pragma unroll
            for (int i = 0; i < 4; ++i) {
                ss += v[i].x * v[i].x + v[i].y * v[i].y + v[i].z * v[i].z + v[i].w * v[i].w;
                *(uint2*)(h + (size_t)n * DM + i * 256 + lane * 4) = make_uint2(pk2(v[i].x, v[i].y), pk2(v[i].z, v[i].w));
            }
            ss = wave_sum(ss);
            if (lane == 0) rstd[n] = rsqrtf(ss * (1.0f / 1024.0f) + 1e-6f);
        } else {
#pragma unroll
            for (int i = 0; i < 4; ++i) *(ushort4*)(h + (size_t)n * DM + i * 256 + lane * 4) = make_ushort4(0, 0, 0, 0);
            if (lane == 0) rstd[n] = 0.f;
        }
    }
    float* ctab = (float*)(WS(p) + OFF_ROPE);
    float* stab = ctab + TS * 16;
    for (int idx = obid() * NTHR + otid(); idx < TS * 16; idx += gridDim.x * NTHR) {
        const int t = idx >> 4, i = idx & 15;
        const float inv = powf(10000.0f, -(float)(2 * i) / 32.0f);
        const float ang = (float)t * inv;
        ctab[idx] = cosf(ang);
        stab[idx] = sinf(ang);
    }
}

__device__ void phase_rowstat(const Params& p) {
    const int lane = otid() & 63;
    const int wave = (obid() * NTHR + otid()) >> 6, nw = gridDim.x * NTHR / 64;
    const float* hm = (const float*)(WS(p) + OFF_HM32);
    float* rstd = (float*)(WS(p) + OFF_RSTD);
    float4 cur[4];
    if (wave < NT) {
#pragma unroll
        for (int i = 0; i < 4; ++i) cur[i] = *(const float4*)(hm + (size_t)wave * DM + i * 256 + lane * 4);
    }
    for (int n = wave; n < NT; n += nw) {
        float ss = 0.f;
#pragma unroll
        for (int i = 0; i < 4; ++i) ss += cur[i].x * cur[i].x + cur[i].y * cur[i].y + cur[i].z * cur[i].z + cur[i].w * cur[i].w;
        if (n + nw < NT) {
#pragma unroll
            for (int i = 0; i < 4; ++i) cur[i] = *(const float4*)(hm + (size_t)(n + nw) * DM + i * 256 + lane * 4);
        }
        ss = wave_sum(ss);
        if (lane == 0) rstd[n] = rsqrtf(ss * (1.0f / 1024.0f) + 1e-6f);
    }
}

struct ConvJob { const float* src; bf16_t* dst; const float* scale; int ldsrc, K, nvalid, nrows, nb, notr; size_t sbs, dbs; const float* srcB; int ldB, split; };
__device__ __forceinline__ int conv_job_tiles(const ConvJob& j) { return j.nb * (j.nrows >> 6) * (j.K >> 6); }
__device__ void conv_tile(const ConvJob& j, int tile, float* lds) {
    const int per = (j.nrows >> 6) * (j.K >> 6);
    const int bi = tile / per, rem = tile % per;
    const int ktiles = j.K >> 6;
    const int n0 = (rem / ktiles) << 6, k0 = (rem % ktiles) << 6;
    const int tid = otid(), tn = tid & 63, tk = tid >> 6;
    const float* src = j.src + (size_t)bi * j.sbs;
    bf16_t* dst = j.dst + (size_t)bi * j.dbs;
#pragma unroll
    for (int kk = 0; kk < 8; ++kk) {
        const int k = k0 + tk * 8 + kk;
        float v = 0.f;
        if (n0 + tn < j.nvalid) {
            if (j.split) { const int nn = n0 + tn; v = (nn < j.split) ? (j.src ? j.src[(size_t)k * j.ldsrc + nn] : 0.f) : j.srcB[(size_t)k * j.ldB + (nn - j.split)]; }
            else v = j.notr ? src[(size_t)(n0 + tn) * j.ldsrc + k] : src[(size_t)k * j.ldsrc + n0 + tn];
            if (j.scale) v *= j.scale[k];
        }
        lds[tn * 65 + tk * 8 + kk] = v;
    }
    __syncthreads();
    const int wn = tid >> 3, kq = tid & 7;
    uint4 o;
    unsigned w[4];
#pragma unroll
    for (int q = 0; q < 4; ++q) {
        const float lo = lds[wn * 65 + kq * 8 + 2 * q], hi = lds[wn * 65 + kq * 8 + 2 * q + 1];
        w[q] = pk2(lo, hi);
    }
    o.x = w[0]; o.y = w[1]; o.z = w[2]; o.w = w[3];
    *(uint4*)(dst + (size_t)(n0 + wn) * j.K + k0 + kq * 8) = o;
    __syncthreads();
}
__device__ ConvJob get_job_early(const Params& p, int l, int ji) {
    bf16_t* wb = (bf16_t*)(WS(p) + OFF_WB);
    const float* win = p.in[3] + (size_t)l * DM * CIN;
    const float* nm = p.in[2] + (size_t)l * DM;
    ConvJob j{}; j.nb = 1; j.sbs = 0; j.dbs = 0; j.K = 1024; j.ldsrc = CIN; j.scale = nm;
    switch (ji) {
    case 0: j.src = win + 3072; j.dst = wb + WB_WIN; j.nvalid = 4352; j.nrows = 4352; break;
    case 1: j.src = (l == 0 ? nullptr : p.in[17]); j.ldsrc = 32; j.split = 32; j.srcB = win + 7424; j.ldB = CIN; j.dst = wb + WB_WIN + (size_t)(4096 + PM_VD) * 1024; j.nvalid = 512; j.nrows = 512; break;
    case 2: j.src = win + 7904; j.dst = wb + WB_WIDX; j.nvalid = 8; j.nrows = 64; break;
    case 3: j.src = win; j.dst = wb + WB_WG; j.nvalid = 3072; j.nrows = 3072; break;
    case 4: j.src = p.in[29] + (size_t)l * DM * DM; j.ldsrc = 1024; j.scale = nullptr; j.dst = wb + WB_PA; j.nvalid = 1024; j.nrows = 1024; break;
    case 5: j.src = p.in[30] + (size_t)l * DM * DM; j.ldsrc = 1024; j.scale = nullptr; j.dst = wb + WB_PA + (size_t)1024 * 1024; j.nvalid = 1024; j.nrows = 1024; break;
    case 6: j.src = p.in[31] + (size_t)l * DM * DM; j.ldsrc = 1024; j.scale = nullptr; j.dst = wb + WB_PA + (size_t)2 * 1024 * 1024; j.nvalid = 1024; j.nrows = 1024; break;
    case 7: j.src = p.in[32] + (size_t)l * DM * DM; j.ldsrc = 1024; j.scale = nullptr; j.dst = wb + WB_WO; j.nvalid = 1024; j.nrows = 1024; break;
    case 8: j.src = p.in[5] + (size_t)l * 4 * 256 * 256; j.ldsrc = 256; j.K = 256; j.scale = nullptr; j.dst = wb + WB_POOL; j.nvalid = 256; j.nrows = 256; j.nb = 4; j.sbs = 65536; j.dbs = 65536; break;
    case 9: j.src = p.in[26] + (size_t)l * 256 * 512; j.ldsrc = 512; j.K = 256; j.scale = nullptr; j.dst = wb + WB_QI; j.nvalid = 512; j.nrows = 512; break;
    case 10: j.src = p.in[23] + (size_t)l * 256 * 1536; j.ldsrc = 1536; j.K = 256; j.scale = nullptr; j.dst = wb + WB_UQ; j.nvalid = 1536; j.nrows = 1536; break;
    case 11: j.src = p.in[24] + (size_t)l * 16 * 128 * 64; j.ldsrc = 64; j.K = 64; j.scale = nullptr; j.dst = wb + WB_UK; j.nvalid = 2048; j.nrows = 2048; j.notr = 1; break;
    default: j.src = p.in[25] + (size_t)l * 16 * 128 * 64; j.ldsrc = 64; j.K = 128; j.scale = nullptr; j.dst = wb + WB_UV; j.nvalid = 64; j.nrows = 64; j.nb = 16; j.sbs = 8192; j.dbs = 8192; break;
    }
    return j;
}
__device__ ConvJob get_job_late(const Params& p, int l, int ji) {
    bf16_t* we = (bf16_t*)(WS(p) + OFF_WEXP);
    ConvJob j{}; j.nb = 16; j.scale = nullptr; j.sbs = 262144; j.dbs = 262144;
    switch (ji) {
    case 0: j.src = p.in[38] + (size_t)l * 16 * 262144; j.dst = we + WE_W1; j.ldsrc = 256; j.K = 1024; j.nvalid = 256; j.nrows = 256; break;
    case 1: j.src = p.in[39] + (size_t)l * 16 * 262144; j.dst = we + WE_W3; j.ldsrc = 256; j.K = 1024; j.nvalid = 256; j.nrows = 256; break;
    default: j.src = p.in[40] + (size_t)l * 16 * 262144; j.dst = we + WE_W2; j.ldsrc = 1024; j.K = 256; j.nvalid = 1024; j.nrows = 1024; break;
    }
    return j;
}
template <bool LATE>
__device__ void phase_convert(const Params& p, int l, unsigned char* lds) {
    const int njobs = LATE ? 3 : 13;
    int base = 0;
    for (int ji = 0; ji < njobs; ++ji) {
        const ConvJob j = LATE ? get_job_late(p, l, ji) : get_job_early(p, l, ji);
        const int nt = conv_job_tiles(j);
        int first = ((int)obid() - base) % (int)gridDim.x; if (first < 0) first += gridDim.x;
        for (int t = first; t < nt; t += gridDim.x) conv_tile(j, t, (float*)lds);
        base += nt;
    }
}

template <int BM> struct G3 {
    static constexpr int MI = BM / 64;
    static constexpr int NA = BM / 64;
    static constexpr int STAGE = BM * 128 + 128 * 128;
    const bf16_t* ap[NA];
    const bf16_t* bp[2];
};
template <int BM>
__device__ __forceinline__ void g3_issue(const G3<BM>& g, int kt, unsigned char* stage, int tid) {
#pragma unroll
    for (int i = 0; i < G3<BM>::NA; ++i) glds16(g.ap[i] + kt * 64, stage + (tid + i * NTHR) * 16);
#pragma unroll
    for (int i = 0; i < 2; ++i) glds16(g.bp[i] + kt * 64, stage + BM * 128 + (tid + i * NTHR) * 16);
}
template <int BM, class FA, class FB>
__device__ __forceinline__ void g3_setup(G3<BM>& g, FA rowptr, FB bcol, int tid) {
#pragma unroll
    for (int i = 0; i < G3<BM>::NA; ++i) { const int idx = tid + i * NTHR, row = idx >> 3, sl = (idx & 7) ^ (row & 7); g.ap[i] = rowptr(row) + sl * 8; }
#pragma unroll
    for (int i = 0; i < 2; ++i) { const int idx = tid + i * NTHR, row = idx >> 3, sl = (idx & 7) ^ (row & 7); g.bp[i] = bcol(row) + sl * 8; }
}
template <int BM>
__device__ __forceinline__ void g3_kloop(f32x4 (&acc)[BM / 64][4], const G3<BM>& g, int K, unsigned char* lds) {
    constexpr int MI = G3<BM>::MI, STAGE = G3<BM>::STAGE, NL = G3<BM>::NA + 2;
    const int tid = otid(), lane = tid & 63, wid = tid >> 6, wr = wid >> 1, wc = wid & 1, fr = lane & 15, fq = lane >> 4;
    const int nk = K >> 6;
    g3_issue<BM>(g, 0, lds, tid);
    if (nk > 1) g3_issue<BM>(g, 1, lds + STAGE, tid);
    int cur = 0;
#pragma unroll 1
    for (int t = 0; t < nk; ++t) {
        if (t + 1 < nk) { if (NL == 6) asm volatile("s_waitcnt vmcnt(6)" ::: "memory"); else if (NL == 5) asm volatile("s_waitcnt vmcnt(5)" ::: "memory"); else asm volatile("s_waitcnt vmcnt(4)" ::: "memory"); }
        else asm volatile("s_waitcnt vmcnt(0)" ::: "memory");
        __builtin_amdgcn_s_barrier();
        if (t + 2 < nk) { int nx = cur + 2; if (nx >= 3) nx -= 3; g3_issue<BM>(g, t + 2, lds + nx * STAGE, tid); }
        const unsigned char* cA = lds + cur * STAGE;
        const unsigned char* cB = cA + BM * 128;
#pragma unroll
        for (int ks = 0; ks < 2; ++ks) {
            bf16x8 a[MI], b[4];
#pragma unroll
            for (int m = 0; m < MI; ++m) { const int row = wr * (BM / 4) + m * 16 + fr; a[m] = *(const bf16x8*)(cA + row * 128 + (((ks * 4 + fq) ^ (row & 7)) << 4)); }
#pragma unroll
            for (int n = 0; n < 4; ++n) { const int row = wc * 64 + n * 16 + fr; b[n] = *(const bf16x8*)(cB + row * 128 + (((ks * 4 + fq) ^ (row & 7)) << 4)); }
#pragma unroll
            for (int m = 0; m < MI; ++m)
#pragma unroll
                for (int n = 0; n < 4; ++n) acc[m][n] = __builtin_amdgcn_mfma_f32_16x16x32_bf16(b[n], a[m], acc[m][n], 0, 0, 0);
        }
        cur = (cur == 2) ? 0 : cur + 1;
    }
    __builtin_amdgcn_s_barrier();
}
struct G3D { const bf16_t* ap[2]; const bf16_t* b1[2]; const bf16_t* b3[2]; };
__device__ __forceinline__ void g3d_issue(const G3D& g, int kt, unsigned char* stage, int tid) {
#pragma unroll
    for (int i = 0; i < 2; ++i) glds16(g.ap[i] + kt * 64, stage + (tid + i * NTHR) * 16);
#pragma unroll
    for (int i = 0; i < 2; ++i) glds16(g.b1[i] + kt * 64, stage + 16384 + (tid + i * NTHR) * 16);
#pragma unroll
    for (int i = 0; i < 2; ++i) glds16(g.b3[i] + kt * 64, stage + 32768 + (tid + i * NTHR) * 16);
}
__device__ __forceinline__ void g3d_kloop(f32x4 (&acc1)[2][4], f32x4 (&acc3)[2][4], const G3D& g, int K, unsigned char* lds) {
    constexpr int STAGE = 49152;
    const int tid = otid(), lane = tid & 63, wid = tid >> 6, wr = wid >> 1, wc = wid & 1, fr = lane & 15, fq = lane >> 4;
    const int nk = K >> 6;
    g3d_issue(g, 0, lds, tid);
    if (nk > 1) g3d_issue(g, 1, lds + STAGE, tid);
    int cur = 0;
#pragma unroll 1
    for (int t = 0; t < nk; ++t) {
        if (t + 1 < nk) asm volatile("s_waitcnt vmcnt(6)" ::: "memory"); else asm volatile("s_waitcnt vmcnt(0)" ::: "memory");
        __builtin_amdgcn_s_barrier();
        if (t + 2 < nk) { int nx = cur + 2; if (nx >= 3) nx -= 3; g3d_issue(g, t + 2, lds + nx * STAGE, tid); }
        const unsigned char* cA = lds + cur * STAGE;
#pragma unroll
        for (int ks = 0; ks < 2; ++ks) {
            bf16x8 a[2], b1[4], b3[4];
#pragma unroll
            for (int m = 0; m < 2; ++m) { const int row = wr * 32 + m * 16 + fr; a[m] = *(const bf16x8*)(cA + row * 128 + (((ks * 4 + fq) ^ (row & 7)) << 4)); }
#pragma unroll
            for (int n = 0; n < 4; ++n) { const int row = wc * 64 + n * 16 + fr; const int off = row * 128 + (((ks * 4 + fq) ^ (row & 7)) << 4);
                b1[n] = *(const bf16x8*)(cA + 16384 + off); b3[n] = *(const bf16x8*)(cA + 32768 + off); }
#pragma unroll
            for (int m = 0; m < 2; ++m)
#pragma unroll
                for (int n = 0; n < 4; ++n) {
                    acc1[m][n] = __builtin_amdgcn_mfma_f32_16x16x32_bf16(b1[n], a[m], acc1[m][n], 0, 0, 0);
                    acc3[m][n] = __builtin_amdgcn_mfma_f32_16x16x32_bf16(b3[n], a[m], acc3[m][n], 0, 0, 0);
                }
        }
        cur = (cur == 2) ? 0 : cur + 1;
    }
    __builtin_amdgcn_s_barrier();
}
template <int MI>
__device__ __forceinline__ void g3_zero(f32x4 (&acc)[MI][4]) {
#pragma unroll
    for (int m = 0; m < MI; ++m)
#pragma unroll
        for (int n = 0; n < 4; ++n) acc[m][n] = (f32x4){0.f, 0.f, 0.f, 0.f};
}
__device__ __forceinline__ uint2 pack4(float a, float b, float c, float d) {
    uint2 r; r.x = pk2(a, b); r.y = pk2(c, d); return r;
}

namespace pg8 {
#define PG8_LAS __attribute__((address_space(3)))
typedef unsigned short bf16_t;
typedef short bf16x8 __attribute__((ext_vector_type(8)));
typedef float f32x4 __attribute__((ext_vector_type(4)));
typedef unsigned u32x4 __attribute__((ext_vector_type(4)));
constexpr int BM = 256, BK = 64, HALF = 128, HTB = HALF * BK * 2  , STAGE_BYTES = 8 * HTB, NXCD = 8, WGM = 8;

__host__ __device__ __forceinline__ int lds_byte(int r, int c) { const int st = (r >> 4) * 2 + (c >> 5), rr = r & 15, cc = c & 31, ob = rr * 64 + cc * 2; return st * 1024 + (ob ^ (((ob >> 9) & 1) << 5)); }
__host__ __device__ __forceinline__ void stage_rc(int b, int& R, int& C) { const int st = b / 1024, sb = b % 1024, swz = sb ^ (((sb >> 9) & 1) << 5); R = (st >> 1) * 16 + swz / 64; C = (st & 1) * 32 + (swz % 64) / 2; }
__host__ __device__ __forceinline__ int perm32(int rho) { const int n = rho >> 4, i = rho & 15; return 8 * (i >> 2) + 4 * n + (i & 3); }

struct Unit { int pm, pn; };
struct Gemm { const bf16_t* A; const bf16_t* Bt; int M, N, K; };

struct StaticOrder {
    int nM, nN, nwg, G, c;
    __host__ __device__ void init(int M, int N, int G_, int c_) { nM = M / BM; nN = N / BM; nwg = nM * nN; G = G_; c = c_; }
    __host__ __device__ bool next(int i, Unit& u) const {
        const long L = (long)i * G + c; if (L >= nwg) return false;
        int wgid = (int)L; { const int q = nwg / NXCD, r = nwg % NXCD, xcd = wgid % NXCD, off = wgid / NXCD; wgid = (xcd < r ? xcd * (q + 1) : r * (q + 1) + (xcd - r) * q) + off; }
        const int nig = WGM * nN, gid = wgid / nig, fm = gid * WGM, gsz = (nM - fm) < WGM ? (nM - fm) : WGM;
        u.pm = fm + ((wgid % nig) % gsz); u.pn = (wgid % nig) / gsz; return true;
    }
    __device__ __forceinline__ void a_ready(const Unit&) const {}
    __device__ __forceinline__ void done(const Unit&) const {}
};
template <class Epi, class Sched, bool STAMP = false>
__device__ __forceinline__ void gemm_phase(PG8_LAS unsigned char* lds, const Gemm g, const Sched& S, const Epi& E, unsigned long long* stamps) {
    const int tid = otid(), wid = __builtin_amdgcn_readfirstlane(tid >> 6), lane = tid & 63, wr = wid >> 2, wc = wid & 3, fr = lane & 15, fq = lane >> 4;
    const int K = g.K, nt = K / BK;
    int ts_lo = 0, ts_hi = 0, nts = 0; const unsigned long long rt_entry = STAMP ? 0ull : 0ull;
#define PG8_STAMP() do { if (STAMP && wid == 0 && nts < 64) { const unsigned long long _c = 0ull; \
        ts_lo = (lane == nts) ? (int)(unsigned)_c : ts_lo; ts_hi = (lane == nts) ? (int)(unsigned)(_c >> 32) : ts_hi; ++nts; } } while (0)
    PG8_STAMP();
    unsigned voffA[2], voffB[2];
#pragma unroll
    for (int i = 0; i < 2; ++i) { int R, C; stage_rc(tid * 16 + i * 8192, R, C); const int Rb = Epi::PERM ? ((R & ~31) + perm32(R & 31)) : R;
        voffA[i] = (unsigned)(R * K + C) * 2u; voffB[i] = (unsigned)(Rb * K + C) * 2u; }
    const size_t kstep = (size_t)(BK * 2);
    const size_t hstep = (size_t)HALF * K * 2;
    const size_t tstep = 2 * hstep;
    const unsigned ldsw = (unsigned)wid * 1024u;
    const int aoff = lds_byte(wr * 64 + fr, fq * 8), boff = lds_byte(wc * 32 + fr, fq * 8);
#define PG8_SA(b, h) (((b) * 2 + (h)) * HTB)
#define PG8_SB(b, h) ((4 + (b) * 2 + (h)) * HTB)
#define PG8_STAGE(bufoff, gbase, voff) do { _Pragma("unroll") for (int _i = 0; _i < 2; ++_i) \
        __builtin_amdgcn_global_load_lds((const unsigned*)((const char*)(gbase) + (voff)[_i]), (PG8_LAS unsigned*)(lds + (bufoff) + ldsw + _i * 8192), 16, 0, 0); } while (0)
#define PG8_LDA(dst, b, h) do { _Pragma("unroll") for (int m = 0; m < 4; ++m) _Pragma("unroll") for (int k = 0; k < 2; ++k) dst[m][k] = *(const PG8_LAS bf16x8*)(lds + PG8_SA(b, h) + aoff + m * 2048 + k * 1024); } while (0)
#define PG8_LDB(dst, b, h) do { _Pragma("unroll") for (int n = 0; n < 2; ++n) _Pragma("unroll") for (int k = 0; k < 2; ++k) dst[n][k] = *(const PG8_LAS bf16x8*)(lds + PG8_SB(b, h) + boff + n * 2048 + k * 1024); } while (0)
#define PG8_MMA(ai, bj, At, Bt) do { __builtin_amdgcn_s_setprio(1); _Pragma("unroll") for (int m = 0; m < 4; ++m) _Pragma("unroll") for (int n = 0; n < 2; ++n) _Pragma("unroll") for (int k = 0; k < 2; ++k) \
        acc[ai][bj][m][n] = __builtin_amdgcn_mfma_f32_16x16x32_bf16(Bt[n][k], At[m][k], acc[ai][bj][m][n], 0, 0, 0); __builtin_amdgcn_s_setprio(0); } while (0)
#define PG8_WAIT_V(n) asm volatile("s_waitcnt vmcnt(" #n ")" ::: "memory")
#define PG8_WAIT_L(n) asm volatile("s_waitcnt lgkmcnt(" #n ")" ::: "memory")
#define PG8_BAR __builtin_amdgcn_s_barrier()
#define PG8_SCHED __builtin_amdgcn_sched_barrier(0)
    Unit cur, nxt; int ui = 0;
    if (!S.next(0, cur)) return;
    f32x4 acc[2][2][4][2];
#pragma unroll
    for (int a = 0; a < 2; ++a)
#pragma unroll
        for (int b = 0; b < 2; ++b)
#pragma unroll
            for (int m = 0; m < 4; ++m)
#pragma unroll
                for (int n = 0; n < 2; ++n) acc[a][b][m][n] = (f32x4){0.f, 0.f, 0.f, 0.f};
    bf16x8 At[4][2], B0[2][2], B1[2][2];
    const char* cA = (const char*)g.A + (size_t)cur.pm * tstep; const char* cB = (const char*)g.Bt + (size_t)cur.pn * tstep;
    S.a_ready(cur);
    PG8_STAGE(PG8_SB(0, 0), cB, voffB); PG8_STAGE(PG8_SA(0, 0), cA, voffA); PG8_STAGE(PG8_SB(0, 1), cB + hstep, voffB); PG8_STAGE(PG8_SA(0, 1), cA + hstep, voffA);
    if (wr == 1) PG8_BAR;
    PG8_WAIT_V(4); PG8_BAR;
    PG8_STAGE(PG8_SB(1, 0), cB + kstep, voffB); PG8_STAGE(PG8_SA(1, 0), cA + kstep, voffA); PG8_STAGE(PG8_SB(1, 1), cB + hstep + kstep, voffB);
    PG8_WAIT_V(6); PG8_BAR;
    PG8_STAMP();
    for (;;) {
        const bool has_next = S.next(ui + 1, nxt);
        const char* nA = has_next ? (const char*)g.A + (size_t)nxt.pm * tstep : cA; const char* nB = has_next ? (const char*)g.Bt + (size_t)nxt.pn * tstep : cB;
        for (int t = 0; t < nt; t += 2) {
            const bool last = (t == nt - 2);
            const char* a1 = cA + (size_t)(t + 1) * kstep;
            const char* a2 = last ? nA : cA + (size_t)(t + 2) * kstep; const char* b2 = last ? nB : cB + (size_t)(t + 2) * kstep;
            const char* a3 = a2 + kstep; const char* b3 = b2 + kstep;
            if (last && has_next) S.a_ready(nxt);
            PG8_LDB(B0, 0, 0); PG8_SCHED; PG8_LDA(At, 0, 0); PG8_STAGE(PG8_SA(1, 1), a1 + hstep, voffA);
            PG8_WAIT_L(8); PG8_BAR; PG8_WAIT_L(0); PG8_MMA(0, 0, At, B0); PG8_BAR; PG8_SCHED;
            PG8_LDB(B1, 0, 1); PG8_STAGE(PG8_SB(0, 0), b2, voffB);
            PG8_BAR; PG8_WAIT_L(0); PG8_MMA(0, 1, At, B1); PG8_BAR;
            PG8_LDA(At, 0, 1); PG8_STAGE(PG8_SA(0, 0), a2, voffA);
            PG8_BAR; PG8_WAIT_L(0); PG8_MMA(1, 0, At, B0); PG8_BAR; PG8_SCHED;
            PG8_STAGE(PG8_SB(0, 1), b2 + hstep, voffB);
            PG8_WAIT_V(6); PG8_BAR; PG8_MMA(1, 1, At, B1); PG8_BAR;
            PG8_LDB(B0, 1, 0); PG8_SCHED; PG8_LDA(At, 1, 0); PG8_STAGE(PG8_SA(0, 1), a2 + hstep, voffA);
            PG8_WAIT_L(8); PG8_BAR; PG8_WAIT_L(0); PG8_MMA(0, 0, At, B0); PG8_BAR; PG8_SCHED;
            PG8_LDB(B1, 1, 1); PG8_STAGE(PG8_SB(1, 0), b3, voffB);
            PG8_BAR; PG8_WAIT_L(0); PG8_MMA(0, 1, At, B1); PG8_BAR;
            PG8_LDA(At, 1, 1); PG8_STAGE(PG8_SA(1, 0), a3, voffA);
            PG8_BAR; PG8_WAIT_L(0); PG8_MMA(1, 0, At, B0); PG8_BAR; PG8_SCHED;
            PG8_STAGE(PG8_SB(1, 1), b3 + hstep, voffB);
            PG8_WAIT_V(6); PG8_BAR; PG8_MMA(1, 1, At, B1); PG8_BAR;
        }
        PG8_STAMP();
        if constexpr (!Epi::AFTER_DRAIN) { E(acc, cur, wr, wc, fr, fq); S.done(cur); }
        PG8_STAMP();
        if (!has_next) break;
#pragma unroll
        for (int a = 0; a < 2; ++a)
#pragma unroll
            for (int b = 0; b < 2; ++b)
#pragma unroll
                for (int m = 0; m < 4; ++m)
#pragma unroll
                    for (int n = 0; n < 2; ++n) acc[a][b][m][n] = (f32x4){0.f, 0.f, 0.f, 0.f};
        cur = nxt; cA = nA; cB = nB; ++ui;
    }
    PG8_WAIT_V(0);
    if (wr == 0) PG8_BAR;
    PG8_BAR;
    if constexpr (Epi::AFTER_DRAIN) { E.fused(acc, cur, wr, wc, fr, fq, lds, wid, lane); S.done(cur); }
    PG8_STAMP();
    if (STAMP && wid == 0) { stamps[lane] = lane < nts ? (((unsigned long long)(unsigned)ts_hi << 32) | (unsigned)ts_lo) : 0ull;
        if (lane == 62) stamps[62] = rt_entry; if (lane == 63) stamps[63] = 0ull; }
#undef PG8_STAMP
#undef PG8_SA
#undef PG8_SB
#undef PG8_STAGE
#undef PG8_LDA
#undef PG8_LDB
#undef PG8_MMA
#undef PG8_WAIT_V
#undef PG8_WAIT_L
#undef PG8_BAR
#undef PG8_SCHED
}
}

struct EpiInproj {
    static constexpr bool PERM = true, AFTER_DRAIN = false;
    unsigned char* ws; const float* rstd;
    __device__ __forceinline__ void operator()(const pg8::f32x4 (&acc)[2][2][4][2], const pg8::Unit& u, int wr, int wc, int fr, int fq) const {
        const int pn = u.pn;
        bf16_t* dst; int ld, cb;
        if (pn < 4) { dst = (bf16_t*)(ws + OFF_PPOOL); ld = 1024; cb = pn * 256; }
        else if (pn < 8) { dst = (bf16_t*)(ws + OFF_PR); ld = 1024; cb = (pn - 4) * 256; }
        else if (pn < 12) { dst = (bf16_t*)(ws + OFF_PK); ld = 1024; cb = (pn - 8) * 256; }
        else if (pn < 16) { dst = (bf16_t*)(ws + OFF_PV); ld = 1024; cb = (pn - 12) * 256; }
        else { dst = (bf16_t*)(ws + OFF_PMISC); ld = PM_LD; cb = (pn - 16) * 256; }
        bf16_t* halo = (bf16_t*)(ws + OFF_HALO);
#pragma unroll
        for (int ai = 0; ai < 2; ++ai)
#pragma unroll
            for (int m = 0; m < 4; ++m) {
                const int row = u.pm * 256 + ai * 128 + wr * 64 + m * 16 + fr;
                if (row < NT) {
                    const float rs = rstd[row];
                    const int lr = row & 127;
#pragma unroll
                    for (int bj = 0; bj < 2; ++bj) {
                        const int col = cb + bj * 128 + wc * 32 + fq * 8;
                        const uint2 lo = pack4(acc[ai][bj][m][0][0] * rs, acc[ai][bj][m][0][1] * rs, acc[ai][bj][m][0][2] * rs, acc[ai][bj][m][0][3] * rs);
                        const uint2 hi = pack4(acc[ai][bj][m][1][0] * rs, acc[ai][bj][m][1][1] * rs, acc[ai][bj][m][1][2] * rs, acc[ai][bj][m][1][3] * rs);
                        const uint4 v = make_uint4(lo.x, lo.y, hi.x, hi.y);
                        *(uint4*)(dst + (size_t)row * ld + col) = v;
                        if (pn < 4 && lr >= 112) *(uint4*)(halo + ((size_t)(row >> 7) * 16 + (lr - 112)) * 1024 + col) = v;
                    }
                }
            }
    }
};
__device__ void phase_inproj(const Params& p, unsigned char* lds) {
    pg8::StaticOrder S; S.init(NTP, NP1, (int)gridDim.x, obid());
    pg8::Gemm g; g.A = (const pg8::bf16_t*)(WS(p) + OFF_H); g.Bt = (const pg8::bf16_t*)(WS(p) + OFF_WB) + WB_WIN; g.M = NTP; g.N = NP1; g.K = DM;
    EpiInproj E; E.ws = WS(p); E.rstd = (const float*)(WS(p) + OFF_RSTD);
    pg8::gemm_phase<EpiInproj, pg8::StaticOrder, false>((PG8_LAS unsigned char*)lds, g, S, E, nullptr);
}

__device__ void phase_pool(const Params& p, int l, unsigned char* lds, int tb, int te, int tstep) {
    const int tid = otid(), lane = tid & 63, wid = tid >> 6, fr = lane & 15, fq = lane >> 4;
    bf16_t* pp = (bf16_t*)(WS(p) + OFF_PPOOL);
    const bf16_t* halo = (const bf16_t*)(WS(p) + OFF_HALO);
    const bf16_t* pw = (const bf16_t*)(WS(p) + OFF_WB) + WB_POOL;
    const float* scale = p.in[6] + (size_t)l * 1024;
    bf16_t* sp = (bf16_t*)lds;
    constexpr int SLD = 264;
    for (int tile = tb; tile < te; tile += tstep) {
        const int mt = tile >> 2, g = tile & 3;
        const int row0 = mt * 128, w = 2 << g;
        {
            const int c = tid & 255, r0 = (tid >> 8) * 64, col = g * 256 + c;
            auto rawv = [&](int n2) -> float {
                return (n2 >= row0) ? bf2f(pp[(size_t)n2 * 1024 + col]) : bf2f(halo[((size_t)(n2 >> 7) * 16 + ((n2 & 127) - 112)) * 1024 + col]);
            };
            int n = row0 + r0, t = n % TS;
            float sum = 0.f;
            const int have = (t < w) ? t : w;
            for (int i = 1; i <= have; ++i) sum += rawv(n - i);
#pragma unroll 4
            for (int r = 0; r < 64; ++r, ++n) {
                if (t == 0) sum = 0.f;
                const float v = rawv(n);
                sum += v;
                if (t >= w) sum -= rawv(n - w);
                const int cnt = (t + 1 < w) ? (t + 1) : w;
                sp[(r0 + r) * SLD + c] = f2bf(sum * (1.0f / (float)cnt) - v);
                t = (t + 1 == TS) ? 0 : t + 1;
            }
        }
        __syncthreads();
        f32x4 acc[8][2];
#pragma unroll
        for (int m = 0; m < 8; ++m) { acc[m][0] = (f32x4){0.f, 0.f, 0.f, 0.f}; acc[m][1] = (f32x4){0.f, 0.f, 0.f, 0.f}; }
        const bf16_t* wg = pw + (size_t)g * 65536;
#pragma unroll 1
        for (int kk = 0; kk < 8; ++kk) {
            bf16x8 bfr[2];
#pragma unroll
            for (int n = 0; n < 2; ++n) bfr[n] = *(const bf16x8*)(wg + (size_t)(wid * 32 + n * 16 + fr) * 256 + kk * 32 + fq * 8);
#pragma unroll
            for (int m = 0; m < 8; ++m) {
                const bf16x8 a = *(const bf16x8*)(sp + (m * 16 + fr) * SLD + kk * 32 + fq * 8);
                acc[m][0] = __builtin_amdgcn_mfma_f32_16x16x32_bf16(a, bfr[0], acc[m][0], 0, 0, 0);
                acc[m][1] = __builtin_amdgcn_mfma_f32_16x16x32_bf16(a, bfr[1], acc[m][1], 0, 0, 0);
            }
        }
#pragma unroll
        for (int m = 0; m < 8; ++m)
#pragma unroll
            for (int n = 0; n < 2; ++n) {
                const int col = g * 256 + wid * 32 + n * 16 + fr;
                const float sc = scale[col];
#pragma unroll
                for (int j = 0; j < 4; ++j) {
                    const int row = row0 + m * 16 + fq * 4 + j;
                    pp[(size_t)row * 1024 + col] = f2bf(acc[m][n][j] * sc);
                }
            }
        __syncthreads();
    }
}

__device__ void phase_dsa_prep(const Params& p, int l) {
    const int lane = otid() & 63;
    const int wave = (obid() * NTHR + otid()) >> 6, nw = gridDim.x * NTHR / 64;
    const bf16_t* pm = (const bf16_t*)(WS(p) + OFF_PMISC);
    unsigned char* dob = OUTB(p);
    bf16_t* cqn = (bf16_t*)(dob + DO_CQN);
    bf16_t* kv = (bf16_t*)(dob + DO_KV);
    bf16_t* kidx = (bf16_t*)(dob + DO_KIDX);
    float* whead = (float*)(dob + DO_WHEAD);
    const float* ctab = (const float*)(WS(p) + OFF_ROPE);
    const float* stab = ctab + TS * 16;
    const bf16_t* hrow = (const bf16_t*)(WS(p) + OFF_H);
    const bf16_t* wwidx = (const bf16_t*)(WS(p) + OFF_WB) + WB_WIDX;
    const float* rstd_ = (const float*)(WS(p) + OFF_RSTD);
    const float4 qn4 = *(const float4*)(p.in[21] + l * 256 + lane * 4);
    const float2 kvn2 = *(const float2*)(p.in[22] + l * 128 + lane * 2);
    const float inw = p.in[27][l * 64 + lane], inb = p.in[28][l * 64 + lane];
    uint4 ww[8][2];
#pragma unroll
    for (int j = 0; j < 8; ++j) { ww[j][0] = *(const uint4*)(wwidx + (size_t)j * DM + lane * 16); ww[j][1] = *(const uint4*)(wwidx + (size_t)j * DM + lane * 16 + 8); }
    struct In { uint2 cq; unsigned ckv; bf16_t kr0, kr1, kix; uint4 h0, h1; float rs, c, s; };
    auto load = [&](int n) {
        In r;
        const bf16_t* row = pm + (size_t)n * PM_LD;
        const int t = n % TS;
        r.cq = *(const uint2*)(row + PM_CQ + lane * 4);
        r.ckv = *(const unsigned*)(row + PM_CKV + lane * 2);
        r.kr0 = row[PM_KROPE + (lane & 15)]; r.kr1 = row[PM_KROPE + 16 + (lane & 15)];
        r.kix = row[PM_KIDX + lane];
        r.h0 = *(const uint4*)(hrow + (size_t)n * DM + lane * 16); r.h1 = *(const uint4*)(hrow + (size_t)n * DM + lane * 16 + 8);
        r.rs = rstd_[n];
        r.c = ctab[t * 16 + (lane & 15)]; r.s = stab[t * 16 + (lane & 15)];
        return r;
    };
    In cur = load(wave < NT ? wave : 0);
    for (int n = wave; n < NT; n += nw) {
        const In x = cur;
        if (n + nw < NT) cur = load(n + nw);
        {
            const float v0 = __uint_as_float(x.cq.x << 16), v1 = __uint_as_float(x.cq.x & 0xFFFF0000u), v2 = __uint_as_float(x.cq.y << 16), v3 = __uint_as_float(x.cq.y & 0xFFFF0000u);
            const float ss = wave_sum_fast(v0 * v0 + v1 * v1 + v2 * v2 + v3 * v3);
            const float rs = rsqrtf(ss * (1.0f / 256.0f) + 1e-6f);
            *(uint2*)(cqn + (size_t)n * 256 + lane * 4) = pack4(v0 * rs * qn4.x, v1 * rs * qn4.y, v2 * rs * qn4.z, v3 * rs * qn4.w);
        }
        {
            const float v0 = __uint_as_float(x.ckv << 16), v1 = __uint_as_float(x.ckv & 0xFFFF0000u);
            const float ss = wave_sum_fast(v0 * v0 + v1 * v1);
            const float rs = rsqrtf(ss * (1.0f / 128.0f) + 1e-6f);
            *(unsigned*)(kv + (size_t)n * 160 + lane * 2) = pk2(v0 * rs * kvn2.x, v1 * rs * kvn2.y);
        }
        if (lane < 16) {
            const float x1 = bf2f(x.kr0), x2 = bf2f(x.kr1);
            kv[(size_t)n * 160 + 128 + lane] = f2bf(x1 * x.c - x2 * x.s);
            kv[(size_t)n * 160 + 144 + lane] = f2bf(x2 * x.c + x1 * x.s);
        }
        {
            const float xv = bf2f(x.kix);
            const float mu = wave_sum_fast(xv) * (1.0f / 64.0f);
            const float d = xv - mu;
            const float var = wave_sum_fast(d * d) * (1.0f / 64.0f);
            const float y = d * rsqrtf(var + 1e-6f) * inw + inb;
            const float yo = __shfl_xor(y, 16);
            float o = y;
            if (lane < 32) o = (lane < 16) ? (y * x.c - yo * x.s) : (y * x.c + yo * x.s);
            kidx[(size_t)n * 64 + lane] = f2bf(o);
        }
        {
            const uint4 hv0 = x.h0, hv1 = x.h1;
            float hx[16];
            hx[0] = __uint_as_float(hv0.x << 16); hx[1] = __uint_as_float(hv0.x & 0xFFFF0000u); hx[2] = __uint_as_float(hv0.y << 16); hx[3] = __uint_as_float(hv0.y & 0xFFFF0000u);
            hx[4] = __uint_as_float(hv0.z << 16); hx[5] = __uint_as_float(hv0.z & 0xFFFF0000u); hx[6] = __uint_as_float(hv0.w << 16); hx[7] = __uint_as_float(hv0.w & 0xFFFF0000u);
            hx[8] = __uint_as_float(hv1.x << 16); hx[9] = __uint_as_float(hv1.x & 0xFFFF0000u); hx[10] = __uint_as_float(hv1.y << 16); hx[11] = __uint_as_float(hv1.y & 0xFFFF0000u);
            hx[12] = __uint_as_float(hv1.z << 16); hx[13] = __uint_as_float(hv1.z & 0xFFFF0000u); hx[14] = __uint_as_float(hv1.w << 16); hx[15] = __uint_as_float(hv1.w & 0xFFFF0000u);
            float myw = 0.f;
#pragma unroll
            for (int j = 0; j < 8; ++j) {
                const uint4 w0 = ww[j][0], w1 = ww[j][1];
                float d = hx[0] * __uint_as_float(w0.x << 16) + hx[1] * __uint_as_float(w0.x & 0xFFFF0000u) + hx[2] * __uint_as_float(w0.y << 16) + hx[3] * __uint_as_float(w0.y & 0xFFFF0000u)
                        + hx[4] * __uint_as_float(w0.z << 16) + hx[5] * __uint_as_float(w0.z & 0xFFFF0000u) + hx[6] * __uint_as_float(w0.w << 16) + hx[7] * __uint_as_float(w0.w & 0xFFFF0000u)
                        + hx[8] * __uint_as_float(w1.x << 16) + hx[9] * __uint_as_float(w1.x & 0xFFFF0000u) + hx[10] * __uint_as_float(w1.y << 16) + hx[11] * __uint_as_float(w1.y & 0xFFFF0000u)
                        + hx[12] * __uint_as_float(w1.z << 16) + hx[13] * __uint_as_float(w1.z & 0xFFFF0000u) + hx[14] * __uint_as_float(w1.w << 16) + hx[15] * __uint_as_float(w1.w & 0xFFFF0000u);
                d = wave_sum_fast(d);
                myw = (lane == j) ? d : myw;
            }
            if (lane < 8) whead[(size_t)n * 8 + lane] = myw * x.rs * 0.04419417382415922f;
        }
    }
}

typedef short s16x4 __attribute__((ext_vector_type(4)));
__device__ __forceinline__ unsigned f2h_bits(float f) { const _Float16 h = (_Float16)f; unsigned short u; __builtin_memcpy(&u, &h, 2); return u; }
template <bool IMPORT_SEL>
__device__ void phase_dsa(const Params& p, int l, unsigned char* lds, bf16_t* yc, const unsigned short* gsel, const int* gnsel, int tb, int te, int tstep) {
    const int tid = otid(), lane = tid & 63, wid = tid >> 6, fr = lane & 15, fq = lane >> 4;
    unsigned short* s_sc = (unsigned short*)lds;
    bf16_t* s_qi = (bf16_t*)(lds + 66048);
    bf16_t* s_Q = (bf16_t*)lds;
    unsigned char* s_Vw = lds + 82432 + wid * 8192;
    bf16_t* s_qn = (bf16_t*)s_Vw;
    unsigned short* s_sel = (unsigned short*)(lds + 82432 + 65536);
    int* s_nsel = (int*)(lds + 82432 + 65536 + 8192);
    unsigned char* dob = OUTB(p);
    const bf16_t* cqn = (const bf16_t*)(dob + DO_CQN);
    const bf16_t* kv = (const bf16_t*)(dob + DO_KV);
    const bf16_t* kidx = (const bf16_t*)(dob + DO_KIDX);
    const float* whead = (const float*)(dob + DO_WHEAD);
    const float* ctab = (const float*)(WS(p) + OFF_ROPE);
    const float* stab = ctab + TS * 16;
    const bf16_t* wb = (const bf16_t*)(WS(p) + OFF_WB);
    const bf16_t* wqiT = wb + WB_QI;
    const bf16_t* wuqT = wb + WB_UQ;
    const bf16_t* wuk = wb + WB_UK;
    const bf16_t* wuvT = wb + WB_UV;
    const float scale = 0.10206207261596575f;
    const f32x4 z4 = {0.f, 0.f, 0.f, 0.f};
    for (int tile = tb; tile < te; tile += tstep) {
        const int qt = 128 - (tile >> 3), b = tile & 7;
        const int t0 = qt * 16;
        const size_t n0 = (size_t)b * TS + t0;
        {
            bf16x8 acq[8];
#pragma unroll
            for (int kk = 0; kk < 8; ++kk) acq[kk] = *(const bf16x8*)(cqn + (n0 + fr) * 256 + kk * 32 + fq * 8);
            f32x4 c[4] = {z4, z4, z4, z4};
#pragma unroll
            for (int kb = 0; kb < 8; kb += 4) {
                bf16x8 bf[4][4];
#pragma unroll
                for (int k4 = 0; k4 < 4; ++k4)
#pragma unroll
                    for (int nt = 0; nt < 4; ++nt) bf[k4][nt] = *(const bf16x8*)(wqiT + (size_t)(wid * 64 + nt * 16 + fr) * 256 + (kb + k4) * 32 + fq * 8);
#pragma unroll
                for (int k4 = 0; k4 < 4; ++k4)
#pragma unroll
                    for (int nt = 0; nt < 4; ++nt) c[nt] = __builtin_amdgcn_mfma_f32_16x16x32_bf16(acq[kb + k4], bf[k4][nt], c[nt], 0, 0, 0);
            }
#pragma unroll
            for (int j = 0; j < 4; ++j) {
                const int t = t0 + fq * 4 + j;
                const float cs = ctab[t * 16 + fr], sn = stab[t * 16 + fr];
                const float x1 = c[0][j], x2 = c[1][j];
                c[0][j] = x1 * cs - x2 * sn; c[1][j] = x2 * cs + x1 * sn;
            }
#pragma unroll
            for (int nt = 0; nt < 4; ++nt)
#pragma unroll
                for (int j = 0; j < 4; ++j) s_qi[(fq * 4 + j) * 512 + wid * 64 + nt * 16 + fr] = f2bf(c[nt][j]);
        }
        __syncthreads();
        if (!IMPORT_SEL) {
            bf16x8 aq[8][2];
#pragma unroll
            for (int h = 0; h < 8; ++h)
#pragma unroll
                for (int ks = 0; ks < 2; ++ks) aq[h][ks] = *(const bf16x8*)(s_qi + fr * 512 + h * 64 + ks * 32 + fq * 8);
            float wh[4][8];
#pragma unroll
            for (int j = 0; j < 4; ++j) {
                const float4 w0 = *(const float4*)(whead + (n0 + fq * 4 + j) * 8), w1 = *(const float4*)(whead + (n0 + fq * 4 + j) * 8 + 4);
                wh[j][0] = w0.x; wh[j][1] = w0.y; wh[j][2] = w0.z; wh[j][3] = w0.w; wh[j][4] = w1.x; wh[j][5] = w1.y; wh[j][6] = w1.z; wh[j][7] = w1.w;
            }
            const int nkt = qt + 1;
            bf16x8 nb0 = {0, 0, 0, 0, 0, 0, 0, 0}, nb1 = nb0;
            if (wid < nkt) { const bf16_t* kr0 = kidx + ((size_t)b * TS + wid * 16 + fr) * 64 + fq * 8; nb0 = *(const bf16x8*)kr0; nb1 = *(const bf16x8*)(kr0 + 32); }
#pragma unroll 1
            for (int kt = wid; kt < nkt; kt += 8) {
                const bf16x8 bk0 = nb0, bk1 = nb1;
                if (kt + 8 < nkt) { const bf16_t* krn = kidx + ((size_t)b * TS + (kt + 8) * 16 + fr) * 64 + fq * 8; nb0 = *(const bf16x8*)krn; nb1 = *(const bf16x8*)(krn + 32); }
                float I[4] = {0.f, 0.f, 0.f, 0.f};
#pragma unroll
                for (int h = 0; h < 8; ++h) {
                    f32x4 a = __builtin_amdgcn_mfma_f32_16x16x32_bf16(aq[h][0], bk0, z4, 0, 0, 0);
                    a = __builtin_amdgcn_mfma_f32_16x16x32_bf16(aq[h][1], bk1, a, 0, 0, 0);
#pragma unroll
                    for (int j = 0; j < 4; ++j) I[j] += wh[j][h] * fmaxf(a[j], 0.f);
                }
#pragma unroll
                for (int j = 0; j < 4; ++j) s_sc[(fq * 4 + j) * 2064 + kt * 16 + fr] = (unsigned short)f2h_bits(I[j]);
            }
        }
        __syncthreads();
#pragma unroll 1
        for (int qi2 = 0; qi2 < 2; ++qi2) {
            const int q = wid + qi2 * 8;
            const int nadm = t0 + q + 1;
            unsigned short* sel = s_sel + q * 256;
            if (IMPORT_SEL) {
                const int ns = gnsel[n0 + q];
                for (int i = lane; i < ns; i += 64) sel[i] = gsel[(n0 + q) * 256 + i];
                if (lane == 0) s_nsel[q] = ns;
            } else if (nadm <= 256) {
                for (int i = lane; i < nadm; i += 64) sel[i] = (unsigned short)i;
                if (lane == 0) s_nsel[q] = nadm;
            } else {
                auto topk = [&](auto nch_tag) {
                    constexpr int NCH = decltype(nch_tag)::value;
                    unsigned key[NCH];
    #pragma unroll
                    for (int c = 0; c < NCH; ++c) {
                        const int s = c * 64 + lane;
                        unsigned k = 0u;
                        if (s < nadm) { const unsigned u = s_sc[q * 2064 + s]; k = (u & 0x8000u) ? (~u & 0xFFFFu) : (u | 0x8000u); }
                        key[c] = k;
                    }
                    unsigned T = 0u;
    #pragma unroll 1
                    for (int bit = 15; bit >= 0; --bit) {
                        const unsigned cand = T | (1u << bit);
                        int cnt = 0;
    #pragma unroll
                        for (int c = 0; c < NCH; ++c) cnt += __popcll(__ballot(key[c] >= cand));
                        if (cnt >= 256) T = cand;
                    }
                    int ngt = 0;
    #pragma unroll
                    for (int c = 0; c < NCH; ++c) ngt += __popcll(__ballot(key[c] > T));
                    const int rties = 256 - ngt;
                    int base = 0, ties = 0;
                    const unsigned long long ltmask = (1ull << lane) - 1ull;
    #pragma unroll
                    for (int c = 0; c < NCH; ++c) {
                        const bool gt = key[c] > T, eq = key[c] == T;
                        const unsigned long long em = __ballot(eq);
                        const int myrank = ties + __popcll(em & ltmask);
                        const bool take = gt || (eq && myrank < rties);
                        const unsigned long long tm = __ballot(take);
                        const int pos = base + __popcll(tm & ltmask);
                        if (take && pos < 256) sel[pos] = (unsigned short)(c * 64 + lane);
                        base += __popcll(tm); ties += __popcll(em);
                    }

                };
                if (nadm <= 512) topk(std::integral_constant<int, 8>{});
                else if (nadm <= 1024) topk(std::integral_constant<int, 16>{});
                else if (nadm <= 1536) topk(std::integral_constant<int, 24>{});
                else topk(std::integral_constant<int, 33>{});
                if (lane == 0) s_nsel[q] = 256;
            }
        }
        __syncthreads();
#pragma unroll 1
        for (int hi = 0; hi < 2; ++hi) {
            const int hh = wid * 2 + hi;
            bf16x8 acq[8];
#pragma unroll
            for (int kk = 0; kk < 8; ++kk) acq[kk] = *(const bf16x8*)(cqn + (n0 + fr) * 256 + kk * 32 + fq * 8);
            f32x4 c6[6] = {z4, z4, z4, z4, z4, z4};
#pragma unroll
            for (int kb = 0; kb < 8; kb += 4) {
                bf16x8 bf[4][6];
#pragma unroll
                for (int k4 = 0; k4 < 4; ++k4)
#pragma unroll
                    for (int nt = 0; nt < 6; ++nt) bf[k4][nt] = *(const bf16x8*)(wuqT + (size_t)(hh * 96 + nt * 16 + fr) * 256 + (kb + k4) * 32 + fq * 8);
#pragma unroll
                for (int k4 = 0; k4 < 4; ++k4)
#pragma unroll
                    for (int nt = 0; nt < 6; ++nt) c6[nt] = __builtin_amdgcn_mfma_f32_16x16x32_bf16(acq[kb + k4], bf[k4][nt], c6[nt], 0, 0, 0);
            }
#pragma unroll
            for (int j = 0; j < 4; ++j) {
                const int q = fq * 4 + j, t = t0 + q;
                const float cs = ctab[t * 16 + fr], sn = stab[t * 16 + fr];
                const float x1 = c6[4][j], x2 = c6[5][j];
                s_Q[(q * 16 + hh) * 160 + 128 + fr] = f2bf(x1 * cs - x2 * sn);
                s_Q[(q * 16 + hh) * 160 + 144 + fr] = f2bf(x2 * cs + x1 * sn);
#pragma unroll
                for (int nt = 0; nt < 4; ++nt) s_qn[q * 64 + nt * 16 + fr] = f2bf(c6[nt][j]);
            }
            __syncthreads();
            bf16x8 an[2];
#pragma unroll
            for (int ks = 0; ks < 2; ++ks) an[ks] = *(const bf16x8*)(s_qn + fr * 64 + ks * 32 + fq * 8);
            bf16x8 bwk[8][2];
#pragma unroll
            for (int nt = 0; nt < 8; ++nt)
#pragma unroll
                for (int ks = 0; ks < 2; ++ks) bwk[nt][ks] = *(const bf16x8*)(wuk + (size_t)(hh * 128 + nt * 16 + fr) * 64 + ks * 32 + fq * 8);
#pragma unroll
            for (int nt = 0; nt < 8; ++nt) {
                f32x4 a = z4;
#pragma unroll
                for (int ks = 0; ks < 2; ++ks)
                    a = __builtin_amdgcn_mfma_f32_16x16x32_bf16(an[ks], bwk[nt][ks], a, 0, 0, 0);
#pragma unroll
                for (int j = 0; j < 4; ++j) s_Q[((fq * 4 + j) * 16 + hh) * 160 + nt * 16 + fr] = f2bf(a[j]);
            }
            __syncthreads();
        }
#pragma unroll 1
        for (int qi2 = 0; qi2 < 2; ++qi2) {
            const int q = wid + qi2 * 8;
            bf16x8 bq[5];
#pragma unroll
            for (int ks = 0; ks < 5; ++ks) bq[ks] = *(const bf16x8*)(s_Q + (q * 16 + fr) * 160 + ks * 32 + fq * 8);
            const int nsel = s_nsel[q];
            const unsigned short* sel = s_sel + q * 256;
            float m = -INFINITY, lsum = 0.f;
            f32x4 O[8] = {z4, z4, z4, z4, z4, z4, z4, z4};
            const int nchunk = (nsel + 31) >> 5;
            bf16x8 akn[2][5];
#pragma unroll
            for (int mt = 0; mt < 2; ++mt) {
                const int ki = mt * 16 + fr;
                const int sidx = sel[ki < nsel ? ki : 0];
                const bf16_t* krow = kv + ((size_t)b * TS + sidx) * 160 + fq * 8;
#pragma unroll
                for (int ks = 0; ks < 5; ++ks) akn[mt][ks] = *(const bf16x8*)(krow + ks * 32);
            }
#pragma unroll 1
            for (int ch = 0; ch < nchunk; ++ch) {
                bf16x8 ak[2][5];
#pragma unroll
                for (int mt = 0; mt < 2; ++mt)
#pragma unroll
                    for (int ks = 0; ks < 5; ++ks) ak[mt][ks] = akn[mt][ks];
                if (ch + 1 < nchunk) {
#pragma unroll
                    for (int mt = 0; mt < 2; ++mt) {
                        const int ki = (ch + 1) * 32 + mt * 16 + fr;
                        const int sidx = sel[ki < nsel ? ki : 0];
                        const bf16_t* krow = kv + ((size_t)b * TS + sidx) * 160 + fq * 8;
#pragma unroll
                        for (int ks = 0; ks < 5; ++ks) akn[mt][ks] = *(const bf16x8*)(krow + ks * 32);
                    }
                }
#pragma unroll
                for (int mt = 0; mt < 2; ++mt)
#pragma unroll
                    for (int ks = 0; ks < 4; ++ks) {
                        const int r = mt * 16 + fr;
                        *(bf16x8*)(s_Vw + r * 256 + (((ks * 2 + (fq >> 1)) ^ (r & 7)) * 32) + (fq & 1) * 16) = ak[mt][ks];
                    }
                f32x4 st[2] = {z4, z4};
#pragma unroll
                for (int mt = 0; mt < 2; ++mt)
#pragma unroll
                    for (int ks = 0; ks < 5; ++ks) st[mt] = __builtin_amdgcn_mfma_f32_16x16x32_bf16(ak[mt][ks], bq[ks], st[mt], 0, 0, 0);
                float sv[2][4]; float cmax = -INFINITY;
#pragma unroll
                for (int mt = 0; mt < 2; ++mt)
#pragma unroll
                    for (int j = 0; j < 4; ++j) {
                        const int ke = ch * 32 + mt * 16 + fq * 4 + j;
                        const float s_ = (ke < nsel) ? st[mt][j] * scale : -INFINITY;
                        sv[mt][j] = s_; cmax = fmaxf(cmax, s_);
                    }
                cmax = fmaxf(cmax, __shfl_xor(cmax, 16)); cmax = fmaxf(cmax, __shfl_xor(cmax, 32));
                const float mnew = fmaxf(m, cmax);
                const float alpha = __expf(m - mnew);
                float psum = 0.f;
#pragma unroll
                for (int mt = 0; mt < 2; ++mt)
#pragma unroll
                    for (int j = 0; j < 4; ++j) { const float pe = __expf(sv[mt][j] - mnew); sv[mt][j] = pe; psum += pe; }
                psum += __shfl_xor(psum, 16); psum += __shfl_xor(psum, 32);
                lsum = lsum * alpha + psum; m = mnew;
#pragma unroll
                for (int ct = 0; ct < 8; ++ct) O[ct] = O[ct] * alpha;
                bf16x8 pf;
#pragma unroll
                for (int mt = 0; mt < 2; ++mt)
#pragma unroll
                    for (int j = 0; j < 4; ++j) pf[mt * 4 + j] = (short)f2bf(sv[mt][j]);
                const int q_ = fr >> 2, p_ = fr & 3;
                const int r0 = fq * 4 + q_, r1 = 16 + r0;
#pragma unroll
                for (int ct = 0; ct < 8; ++ct) {
                    const s16x4 v0 = __builtin_amdgcn_ds_read_tr16_b64_v4i16((__attribute__((address_space(3))) s16x4*)(s_Vw + r0 * 256 + ((ct ^ (r0 & 7)) * 32) + p_ * 8));
                    const s16x4 v1 = __builtin_amdgcn_ds_read_tr16_b64_v4i16((__attribute__((address_space(3))) s16x4*)(s_Vw + r1 * 256 + ((ct ^ (r1 & 7)) * 32) + p_ * 8));
                    bf16x8 av; av[0] = v0[0]; av[1] = v0[1]; av[2] = v0[2]; av[3] = v0[3]; av[4] = v1[0]; av[5] = v1[1]; av[6] = v1[2]; av[7] = v1[3];
                    O[ct] = __builtin_amdgcn_mfma_f32_16x16x32_bf16(av, pf, O[ct], 0, 0, 0);
                }
            }
            const float inv = 1.0f / lsum;
#pragma unroll
            for (int ct = 0; ct < 8; ++ct)
#pragma unroll
                for (int j = 0; j < 4; ++j) s_Q[(q * 16 + fr) * 160 + ct * 16 + fq * 4 + j] = f2bf(O[ct][j] * inv);
        }
        __syncthreads();
#pragma unroll 1
        for (int hi = 0; hi < 2; ++hi) {
            const int hh = wid * 2 + hi;
            bf16x8 ao[4];
#pragma unroll
            for (int ks = 0; ks < 4; ++ks) ao[ks] = *(const bf16x8*)(s_Q + (fr * 16 + hh) * 160 + ks * 32 + fq * 8);
#pragma unroll
            for (int nt = 0; nt < 4; ++nt) {
                f32x4 a = z4;
#pragma unroll
                for (int ks = 0; ks < 4; ++ks)
                    a = __builtin_amdgcn_mfma_f32_16x16x32_bf16(ao[ks], *(const bf16x8*)(wuvT + (size_t)(hh * 64 + nt * 16 + fr) * 128 + ks * 32 + fq * 8), a, 0, 0, 0);
#pragma unroll
                for (int j = 0; j < 4; ++j) yc[(n0 + fq * 4 + j) * 1024 + hh * 64 + nt * 16 + fr] = f2bf(a[j]);
            }
        }
        __syncthreads();
    }
}


__device__ void phase_lr_prep(const Params& p, int l) {
    const int lane = otid() & 63;
    const int wave = (obid() * NTHR + otid()) >> 6, nw = gridDim.x * NTHR / 64;
    const bf16_t* pm = (const bf16_t*)(WS(p) + OFF_PMISC);
    bf16_t* alr = (bf16_t*)(OUTB(p) + DO_ALR);
    const float4 mu4 = *(const float4*)(p.in[4] + (size_t)l * 3328 + 3072 + lane * 4);
    const float4 vm4 = *(const float4*)(p.in[18] + (lane & 7) * 4);
    struct In { uint2 c0, p0, c1, p1; };
    auto load = [&](int n) {
        In r;
        const bf16_t* row = pm + (size_t)n * PM_LD;
        const bool hp = (n % TS) > 0;
        r.c0 = *(const uint2*)(row + lane * 4);
        r.p0 = hp ? *(const uint2*)(row - PM_LD + lane * 4) : make_uint2(0u, 0u);
        r.c1 = make_uint2(0u, 0u); r.p1 = r.c1;
        if (lane < 8) { r.c1 = *(const uint2*)(row + 256 + lane * 4); if (hp) r.p1 = *(const uint2*)(row - PM_LD + 256 + lane * 4); }
        return r;
    };
    auto mix4 = [&](const uint2 c, const uint2 q, const float4 m, float (&o)[4]) {
        const float c0 = __uint_as_float(c.x << 16), c1 = __uint_as_float(c.x & 0xFFFF0000u), c2 = __uint_as_float(c.y << 16), c3 = __uint_as_float(c.y & 0xFFFF0000u);
        const float q0 = __uint_as_float(q.x << 16), q1 = __uint_as_float(q.x & 0xFFFF0000u), q2 = __uint_as_float(q.y << 16), q3 = __uint_as_float(q.y & 0xFFFF0000u);
        o[0] = c0 + (q0 - c0) * m.x; o[1] = c1 + (q1 - c1) * m.y; o[2] = c2 + (q2 - c2) * m.z; o[3] = c3 + (q3 - c3) * m.w;
    };
    In cur = load(wave < NT ? wave : 0);
    for (int n = wave; n < NT; n += nw) {
        const In x = cur;
        if (n + nw < NT) cur = load(n + nw);
        float o[4];
        mix4(x.c0, x.p0, mu4, o);
        if (lane < 16) { o[0] = tanhf(o[0]); o[1] = tanhf(o[1]); o[2] = tanhf(o[2]); o[3] = tanhf(o[3]); }
        else if (lane >= 32) { o[0] = sigmoidf_(o[0]); o[1] = sigmoidf_(o[1]); o[2] = sigmoidf_(o[2]); o[3] = sigmoidf_(o[3]); }
        *(uint2*)(alr + (size_t)n * 288 + lane * 4) = pack4(o[0], o[1], o[2], o[3]);
        if (lane < 8) {
            mix4(x.c1, x.p1, vm4, o);
            *(uint2*)(alr + (size_t)n * 288 + 256 + lane * 4) = pack4(o[0], o[1], o[2], o[3]);
        }
    }
}

typedef short sh4 __attribute__((ext_vector_type(4)));
__device__ __forceinline__ sh4 pk4v(const f32x4& v) { const uint2 u = pack4(v[0], v[1], v[2], v[3]); sh4 r; __builtin_memcpy(&r, &u, 8); return r; }
__device__ __forceinline__ bf16x8 cat8(const sh4& a, const sh4& b) { bf16x8 r; r[0] = a[0]; r[1] = a[1]; r[2] = a[2]; r[3] = a[3]; r[4] = b[0]; r[5] = b[1]; r[6] = b[2]; r[7] = b[3]; return r; }
#define MF32(a, b, c) __builtin_amdgcn_mfma_f32_16x16x32_bf16(a, b, c, 0, 0, 0)
#define MF16(a, b, c) MF32(cat8(a, sh4{0, 0, 0, 0}), cat8(b, sh4{0, 0, 0, 0}), c)
constexpr int SC_LT = 72;
constexpr int SC_LS = 36;
constexpr int SC_TC = 32;
constexpr int SC_ROWB = 1088;
__device__ __forceinline__ const unsigned char* scan_piece_src(const Params& p, int l, int b, int hc, int t0, int pi, bool& ok) {
    const int tau = pi / 68, seg = pi - tau * 68;
    const int t = t0 + tau;
    ok = (t < TS) && (tau < SC_TC);
    const size_t n = (size_t)b * TS + t;
    const unsigned char* ws = WS(p);
    if (seg < 8) return ws + OFF_PR + (n * 1024 + hc) * 2 + seg * 16;
    if (seg < 16) return ws + OFF_PK + (n * 1024 + hc) * 2 + (seg - 8) * 16;
    if (seg < 24) return ws + OFF_PV + (n * 1024 + hc) * 2 + (seg - 16) * 16;
    if (seg < 60) return OUTB(p) + DO_ALR + (n * 288) * 2 + (seg - 24) * 16;
    ok = ok && (l > 0);
    return ws + OFF_VFIRST + (n * 1024 + hc) * 2 + (seg - 60) * 16;
}
__device__ void phase_scan5(const Params& p, int l, unsigned char* lds, int blk) {
    const int tid = otid(), lane = tid & 63, wid = tid >> 6, fr = lane & 15, fq = lane >> 4;
    const int b = blk >> 4, hh = blk & 15, hc = hh * 64;
    float* s_r = (float*)lds;
    float* s_w = s_r + 2048;
    float* s_k = s_w + 2048;
    float* s_v = s_k + 2048;
    float* s_a = s_v + 2048;
    float* s_b = s_a + 2048;
    float* s_g = s_b + 2048;
    float* s_o = s_g + 2048;
    bf16_t* o_at = (bf16_t*)(s_o + 2048);
    bf16_t* o_rt = o_at + 32 * SC_LT;
    bf16_t* o_bt = o_rt + 32 * SC_LT;
    bf16_t* o_kt = o_bt + 32 * SC_LT;
    bf16_t* o_bT = o_kt + 32 * SC_LT;
    bf16_t* o_kT = o_bT + 64 * SC_LS;
    bf16_t* o_vT = o_kT + 64 * SC_LS;
    float* s_gc = (float*)(o_vT + 64 * SC_LS);
    unsigned char* raw = (unsigned char*)(s_gc + 128);
    float* prevb = (float*)(raw + 32 * SC_ROWB);
    unsigned* prevr = (unsigned*)prevb;
    float* s_bs = s_r;
    float* cst = prevb + 960;
    const float* mu = p.in[4] + (size_t)l * 3328;
    for (int e = tid; e < 480; e += NTHR) {
        float v;
        if (e < 192) v = mu[(e >> 6) * 1024 + hc + (e & 63)];
        else if (e < 448) v = mu[3072 + (e - 192)];
        else v = p.in[18][e - 448];
        cst[e] = v;
    }
    if (tid < 64) {
        cst[480 + tid] = p.in[7][l * 1024 + hc + tid];
        cst[544 + tid] = p.in[9][l * 1024 + hc + tid];
        cst[608 + tid] = p.in[12][l * 1024 + hc + tid];
        cst[672 + tid] = p.in[13][l * 1024 + hc + tid];
        cst[736 + tid] = p.in[14][l * 1024 + hc + tid];
        cst[800 + tid] = p.in[15][l * 1024 + hc + tid];
        cst[864 + tid] = p.in[16][l * 1024 + hc + tid];
        cst[928 + tid] = p.in[19][hc + tid];
    }
    const int mm = wid >> 1, ntb = (wid & 1) * 2;
    const int nks = (mm == 2) ? 4 : (mm == 3 ? 1 : 2);
    bf16x8 Bw[2][4];
    {
        const float* wsrc = (mm == 0) ? p.in[8] + (size_t)l * 64 * 1024 : (mm == 1) ? p.in[10] + (size_t)l * 64 * 1024 : (mm == 2) ? p.in[11] + (size_t)l * 128 * 1024 : p.in[20];
#pragma unroll
        for (int n2 = 0; n2 < 2; ++n2)
#pragma unroll
            for (int ks = 0; ks < 4; ++ks) {
                bf16x8 f;
#pragma unroll
                for (int j = 0; j < 8; ++j) {
                    const bool okw = ks < nks && (mm < 3 || l > 0);
                    const float v = wsrc[(size_t)(okw ? (ks * 32 + fq * 8 + j) : 0) * 1024 + hc + (ntb + n2) * 16 + fr];
                    f[j] = (short)f2bf(okw ? v : 0.f);
                }
                Bw[n2][ks] = f;
            }
    }
    const f32x4 z4 = {0.f, 0.f, 0.f, 0.f};
    f32x4 S[4] = {z4, z4, z4, z4};
    sh4 Lf;
#pragma unroll
    for (int j = 0; j < 4; ++j) Lf[j] = (fq * 4 + j <= fr) ? (short)0x3F80 : (short)0;
    bf16_t* Pr = (bf16_t*)(WS(p) + OFF_PR);
    bf16_t* vfirst = (bf16_t*)(WS(p) + OFF_VFIRST);
    const unsigned char* psrc[5]; int pstep[5], ptau[5]; bool pval[5];
#pragma unroll
    for (int k = 0; k < 5; ++k) {
        const int pi = tid + k * NTHR;
        bool ok = false;
        psrc[k] = scan_piece_src(p, l, b, hc, 0, pi < SC_TC * 68 ? pi : 0, ok);
        const int tau = (pi < SC_TC * 68 ? pi : 0) / 68, seg = (pi < SC_TC * 68 ? pi : 0) - tau * 68;
        ptau[k] = tau;
        pstep[k] = SC_TC * ((seg >= 24 && seg < 60) ? 576 : 2048);
        pval[k] = (pi < SC_TC * 68) && !(seg >= 60 && l == 0);
    }
    uint4 pre[5];
#pragma unroll
    for (int k = 0; k < 5; ++k) { pre[k] = make_uint4(0, 0, 0, 0); if (pval[k] && ptau[k] < TS) pre[k] = *(const uint4*)psrc[k]; }
    __syncthreads();
#pragma unroll 1
    for (int t0 = 0, ch = 0; t0 < TS; t0 += SC_TC, ++ch) {
        const int nval = (TS - t0 < SC_TC) ? (TS - t0) : SC_TC;
#pragma unroll
        for (int k = 0; k < 5; ++k) { const int pi = tid + k * NTHR; if (pi < SC_TC * 68) *(uint4*)(raw + pi * 16) = pre[k]; }
        lds_barrier();
#pragma unroll
        for (int k = 0; k < 5; ++k) {
            pre[k] = make_uint4(0, 0, 0, 0);
            if (pval[k] && t0 + SC_TC + ptau[k] < TS) pre[k] = *(const uint4*)(psrc[k] + (size_t)(ch + 1) * pstep[k]);
        }
        if (mm < 3 || l > 0) {
            const unsigned char* Ab = raw + ((mm == 0) ? 384 : (mm == 1) ? 512 : (mm == 2) ? 640 : 896);
            float* dst = (mm == 0) ? s_w : (mm == 1) ? s_a : (mm == 2) ? s_g : s_o;
#pragma unroll
            for (int m = 0; m < 2; ++m) {
                f32x4 acc0 = {0.f, 0.f, 0.f, 0.f}, acc1 = {0.f, 0.f, 0.f, 0.f};
#pragma unroll
                for (int ks = 0; ks < 4; ++ks) {
                    if (ks < nks) {
                        const bf16x8 a = *(const bf16x8*)(Ab + (m * 16 + fr) * SC_ROWB + ks * 64 + fq * 16);
                        acc0 = __builtin_amdgcn_mfma_f32_16x16x32_bf16(a, Bw[0][ks], acc0, 0, 0, 0);
                        acc1 = __builtin_amdgcn_mfma_f32_16x16x32_bf16(a, Bw[1][ks], acc1, 0, 0, 0);
                    }
                }
                if (mm == 0) {
                    const float cw0 = cst[480 + ntb * 16 + fr], cw1 = cst[480 + (ntb + 1) * 16 + fr];
                    f32x4 l0, l1, r0, r1;
#pragma unroll
                    for (int j = 0; j < 4; ++j) { l0[j] = -0.6065306597126334f * fast_sigmoid(acc0[j] + cw0); l1[j] = -0.6065306597126334f * fast_sigmoid(acc1[j] + cw1); }
                    const uint2 h0 = pack4(l0[0], l0[1], l0[2], l0[3]), h1 = pack4(l1[0], l1[1], l1[2], l1[3]);
                    r0[0] = l0[0] - __uint_as_float(h0.x << 16); r0[1] = l0[1] - __uint_as_float(h0.x & 0xFFFF0000u); r0[2] = l0[2] - __uint_as_float(h0.y << 16); r0[3] = l0[3] - __uint_as_float(h0.y & 0xFFFF0000u);
                    r1[0] = l1[0] - __uint_as_float(h1.x << 16); r1[1] = l1[1] - __uint_as_float(h1.x & 0xFFFF0000u); r1[2] = l1[2] - __uint_as_float(h1.y << 16); r1[3] = l1[3] - __uint_as_float(h1.y & 0xFFFF0000u);
                    sh4 hh0, hh1; __builtin_memcpy(&hh0, &h0, 8); __builtin_memcpy(&hh1, &h1, 8);
                    f32x4 c0 = MF16(Lf, pk4v(r0), z4), c1 = MF16(Lf, pk4v(r1), z4);
                    c0 = MF16(Lf, hh0, c0); c1 = MF16(Lf, hh1, c1);
#pragma unroll
                    for (int j = 0; j < 4; ++j) {
                        const int eo = (m * 16 + fq * 4 + j) * 64 + ntb * 16 + fr;
                        s_w[eo] = c0[j]; s_w[eo + 16] = c1[j];
                        s_b[eo] = l0[j]; s_b[eo + 16] = l1[j];
                    }
                } else {
#pragma unroll
                    for (int j = 0; j < 4; ++j) {
                        dst[(m * 16 + fq * 4 + j) * 64 + ntb * 16 + fr] = acc0[j];
                        dst[(m * 16 + fq * 4 + j) * 64 + (ntb + 1) * 16 + fr] = acc1[j];
                    }
                }
            }
        }
        lds_barrier();
        {
            const int tau = tid >> 4, c4 = (tid & 15) * 4, e = tau * 64 + c4, t = t0 + tau;
            const size_t n = (size_t)b * TS + t;
            const float4 cum4 = *(const float4*)(s_w + e), lw4 = *(const float4*)(s_b + e), xa4 = *(const float4*)(s_a + e);
            const float4 ca = *(const float4*)(cst + 544 + c4), ckk = *(const float4*)(cst + 608 + c4), cka = *(const float4*)(cst + 672 + c4), crk = *(const float4*)(cst + 736 + c4);
            const float cum[4] = {cum4.x, cum4.y, cum4.z, cum4.w}, lw[4] = {lw4.x, lw4.y, lw4.z, lw4.w};
            const float xa[4] = {xa4.x + ca.x, xa4.y + ca.y, xa4.z + ca.z, xa4.w + ca.w};
            const float kkc[4] = {ckk.x, ckk.y, ckk.z, ckk.w}, kac[4] = {cka.x, cka.y, cka.z, cka.w};
            float rr[4], kr[4], vv[4];
            {
                const unsigned char* rc = raw + tau * SC_ROWB + c4 * 2;
                const uint2 cr = *(const uint2*)rc, ck = *(const uint2*)(rc + 128), cv = *(const uint2*)(rc + 256);
                uint2 qr = make_uint2(0u, 0u), qk = qr, qv = qr;
                if (tau > 0) { qr = *(const uint2*)(rc - SC_ROWB); qk = *(const uint2*)(rc - SC_ROWB + 128); qv = *(const uint2*)(rc - SC_ROWB + 256); }
                else if (t0 > 0) { const unsigned* pvr = prevr + ((ch + 1) & 1) * 96 + (c4 >> 1); qr = *(const uint2*)pvr; qk = *(const uint2*)(pvr + 32); qv = *(const uint2*)(pvr + 64); }
                if (tau == SC_TC - 1) { unsigned* pwr = prevr + (ch & 1) * 96 + (c4 >> 1); *(uint2*)pwr = cr; *(uint2*)(pwr + 32) = ck; *(uint2*)(pwr + 64) = cv; }
                const float4 mr = *(const float4*)(cst + c4), mk = *(const float4*)(cst + 64 + c4), mv = *(const float4*)(cst + 128 + c4);
                const float c_[12] = {__uint_as_float(cr.x << 16), __uint_as_float(cr.x & 0xFFFF0000u), __uint_as_float(cr.y << 16), __uint_as_float(cr.y & 0xFFFF0000u),
                                      __uint_as_float(ck.x << 16), __uint_as_float(ck.x & 0xFFFF0000u), __uint_as_float(ck.y << 16), __uint_as_float(ck.y & 0xFFFF0000u),
                                      __uint_as_float(cv.x << 16), __uint_as_float(cv.x & 0xFFFF0000u), __uint_as_float(cv.y << 16), __uint_as_float(cv.y & 0xFFFF0000u)};
                const float q_[12] = {__uint_as_float(qr.x << 16), __uint_as_float(qr.x & 0xFFFF0000u), __uint_as_float(qr.y << 16), __uint_as_float(qr.y & 0xFFFF0000u),
                                      __uint_as_float(qk.x << 16), __uint_as_float(qk.x & 0xFFFF0000u), __uint_as_float(qk.y << 16), __uint_as_float(qk.y & 0xFFFF0000u),
                                      __uint_as_float(qv.x << 16), __uint_as_float(qv.x & 0xFFFF0000u), __uint_as_float(qv.y << 16), __uint_as_float(qv.y & 0xFFFF0000u)};
                const float m_[12] = {mr.x, mr.y, mr.z, mr.w, mk.x, mk.y, mk.z, mk.w, mv.x, mv.y, mv.z, mv.w};
#pragma unroll
                for (int j = 0; j < 4; ++j) { rr[j] = c_[j] + (q_[j] - c_[j]) * m_[j]; kr[j] = c_[4 + j] + (q_[4 + j] - c_[4 + j]) * m_[4 + j]; vv[j] = c_[8 + j] + (q_[8 + j] - c_[8 + j]) * m_[8 + j]; }
            }
            if (l > 0) {
                const float4 xv4 = *(const float4*)(s_o + e), cv = *(const float4*)(cst + 928 + c4);
                const uint2 vfu = *(const uint2*)(raw + tau * SC_ROWB + 960 + c4 * 2);
                const float vf[4] = {__uint_as_float(vfu.x << 16), __uint_as_float(vfu.x & 0xFFFF0000u), __uint_as_float(vfu.y << 16), __uint_as_float(vfu.y & 0xFFFF0000u)};
                const float xv[4] = {xv4.x + cv.x, xv4.y + cv.y, xv4.z + cv.z, xv4.w + cv.w};
#pragma unroll
                for (int j = 0; j < 4; ++j) vv[j] = vv[j] + (vf[j] - vv[j]) * fast_sigmoid(xv[j]);
            } else if (t < TS) {
                *(uint2*)(vfirst + n * 1024 + hc + c4) = pack4(vv[0], vv[1], vv[2], vv[3]);
            }
            float av[4], kkv[4], ginc[4], gexc[4], ginv[4]; float ss = 0.f;
#pragma unroll
            for (int j = 0; j < 4; ++j) {
                ginc[j] = __expf(cum[j]); gexc[j] = __expf(cum[j] - lw[j]); ginv[j] = __expf(-cum[j]);
                av[j] = fast_sigmoid(xa[j]);
                kkv[j] = kr[j] * kkc[j];
                ss += kkv[j] * kkv[j];
            }
            float kk[4], kt[4];
#pragma unroll
            for (int j = 0; j < 4; ++j) kt[j] = kr[j] * (1.0f + (av[j] - 1.0f) * kac[j]);
            float bsum = rr[0] * kt[0] * crk.x + rr[1] * kt[1] * crk.y + rr[2] * kt[2] * crk.z + rr[3] * kt[3] * crk.w;
            float du0 = 0.f, du1 = 0.f;
            row16_sum4(ss, bsum, du0, du1);
            if ((tid & 15) == 0) s_bs[tau] = bsum;
            const float rn = rsqrtf(fmaxf(ss, 1e-24f));
#pragma unroll
            for (int j = 0; j < 4; ++j) kk[j] = kkv[j] * rn;
            const uint2 pa = pack4(-kk[0] * gexc[0], -kk[1] * gexc[1], -kk[2] * gexc[2], -kk[3] * gexc[3]);
            const uint2 pr = pack4(rr[0] * ginc[0], rr[1] * ginc[1], rr[2] * ginc[2], rr[3] * ginc[3]);
            const uint2 pb = pack4(kk[0] * av[0] * ginv[0], kk[1] * av[1] * ginv[1], kk[2] * av[2] * ginv[2], kk[3] * av[3] * ginv[3]);
            const uint2 pk = pack4(kt[0] * ginv[0], kt[1] * ginv[1], kt[2] * ginv[2], kt[3] * ginv[3]);
            const uint2 pv = pack4(vv[0], vv[1], vv[2], vv[3]);
            *(uint2*)(o_at + tau * SC_LT + c4) = pa;
            *(uint2*)(o_rt + tau * SC_LT + c4) = pr;
            *(uint2*)(o_bt + tau * SC_LT + c4) = pb;
            *(uint2*)(o_kt + tau * SC_LT + c4) = pk;
            o_bT[(c4 + 0) * SC_LS + tau] = (bf16_t)(pb.x & 0xFFFFu); o_bT[(c4 + 1) * SC_LS + tau] = (bf16_t)(pb.x >> 16); o_bT[(c4 + 2) * SC_LS + tau] = (bf16_t)(pb.y & 0xFFFFu); o_bT[(c4 + 3) * SC_LS + tau] = (bf16_t)(pb.y >> 16);
            o_kT[(c4 + 0) * SC_LS + tau] = (bf16_t)(pk.x & 0xFFFFu); o_kT[(c4 + 1) * SC_LS + tau] = (bf16_t)(pk.x >> 16); o_kT[(c4 + 2) * SC_LS + tau] = (bf16_t)(pk.y & 0xFFFFu); o_kT[(c4 + 3) * SC_LS + tau] = (bf16_t)(pk.y >> 16);
            o_vT[(c4 + 0) * SC_LS + tau] = (bf16_t)(pv.x & 0xFFFFu); o_vT[(c4 + 1) * SC_LS + tau] = (bf16_t)(pv.x >> 16); o_vT[(c4 + 2) * SC_LS + tau] = (bf16_t)(pv.y & 0xFFFFu); o_vT[(c4 + 3) * SC_LS + tau] = (bf16_t)(pv.y >> 16);
            if ((tau & 15) == 15) *(float4*)(s_gc + (tau >> 4) * 64 + c4) = make_float4(ginc[0], ginc[1], ginc[2], ginc[3]);
            *(float4*)(s_v + e) = make_float4(vv[0], vv[1], vv[2], vv[3]);
        }
        lds_barrier();
        if (wid < 4) {
#pragma unroll
            for (int sc = 0; sc < 2; ++sc) {
                if (sc * 16 < nval) {
                    const bf16_t* ar = o_at + (sc * 16 + fr) * SC_LT;
                    const bf16_t* rr_ = o_rt + (sc * 16 + fr) * SC_LT;
                    const bf16_t* br = o_bt + (sc * 16 + fr) * SC_LT;
                    const bf16_t* kr_ = o_kt + (sc * 16 + fr) * SC_LT;
                    const bf16x8 fa0 = *(const bf16x8*)(ar + fq * 8), fa1 = *(const bf16x8*)(ar + 32 + fq * 8);
                    const bf16x8 fb0 = *(const bf16x8*)(br + fq * 8), fb1 = *(const bf16x8*)(br + 32 + fq * 8);
                    const bf16x8 fk0 = *(const bf16x8*)(kr_ + fq * 8), fk1 = *(const bf16x8*)(kr_ + 32 + fq * 8);
                    const bf16x8 fr0 = *(const bf16x8*)(rr_ + fq * 8), fr1 = *(const bf16x8*)(rr_ + 32 + fq * 8);
                    f32x4 nA = MF32(fb0, fa0, z4); nA = MF32(fb1, fa1, nA);
                    f32x4 nB = MF32(fa0, fb0, z4); nB = MF32(fa1, fb1, nB);
                    f32x4 mak = MF32(fk0, fa0, z4); mak = MF32(fk1, fa1, mak);
                    f32x4 mbr = MF32(fb0, fr0, z4); mbr = MF32(fb1, fr1, mbr);
                    f32x4 mkr = MF32(fk0, fr0, z4); mkr = MF32(fk1, fr1, mkr);
#pragma unroll
                    for (int j = 0; j < 4; ++j) {
                        const int s_ = fq * 4 + j;
                        nA[j] = (s_ < fr) ? nA[j] : 0.f; nB[j] = (fr < s_) ? nB[j] : 0.f; mak[j] = (s_ < fr) ? mak[j] : 0.f;
                        mbr[j] = (s_ <= fr) ? mbr[j] : 0.f; mkr[j] = (s_ <= fr) ? mkr[j] : 0.f;
                    }
                    const sh4 pNA = pk4v(nA), pNB = pk4v(nB), pMak = pk4v(mak), pMbr = pk4v(mbr), pMkr = pk4v(mkr);
                    const f32x4 n2B = MF16(pNA, pNB, z4), n2A = MF16(pNB, pNA, z4);
                    const sh4 pN2A = pk4v(n2A), pN2B = pk4v(n2B);
                    const f32x4 n4B = MF16(pN2A, pN2B, z4), n4A = MF16(pN2B, pN2A, z4);
                    const sh4 pN4A = pk4v(n4A), pN4B = pk4v(n4B);
                    const sh4 pN8A = pk4v(MF16(pN4B, pN4A, z4));
                    const bf16x8 sB0 = cat8(pk4v(S[0]), pk4v(S[1])), sB1 = cat8(pk4v(S[2]), pk4v(S[3]));
                    const sh4 vf = *(const sh4*)(o_vT + (wid * 16 + fr) * SC_LS + sc * 16 + fq * 4);
                    f32x4 X = MF32(cat8(*(const sh4*)(ar + fq * 4), *(const sh4*)(ar + 16 + fq * 4)), sB0, z4);
                    X = MF32(cat8(*(const sh4*)(ar + 32 + fq * 4), *(const sh4*)(ar + 48 + fq * 4)), sB1, X);
                    X = MF16(pMak, vf, X);
                    X = MF16(pN8A, pk4v(X), X); X = MF16(pN4A, pk4v(X), X); X = MF16(pN2A, pk4v(X), X); X = MF16(pNA, pk4v(X), X);
                    const sh4 pSA = pk4v(X);
                    f32x4 O = MF32(cat8(*(const sh4*)(rr_ + fq * 4), *(const sh4*)(rr_ + 16 + fq * 4)), sB0, z4);
                    O = MF32(cat8(*(const sh4*)(rr_ + 32 + fq * 4), *(const sh4*)(rr_ + 48 + fq * 4)), sB1, O);
                    const bf16x8 sav = cat8(pSA, vf);
                    O = MF32(cat8(pMbr, pMkr), sav, O);
#pragma unroll
                    for (int j = 0; j < 4; ++j) s_o[(sc * 16 + fq * 4 + j) * 64 + wid * 16 + fr] = O[j];
#pragma unroll
                    for (int jt = 0; jt < 4; ++jt) {
                        const sh4 ka = *(const sh4*)(o_kT + (jt * 16 + fr) * SC_LS + sc * 16 + fq * 4), ba = *(const sh4*)(o_bT + (jt * 16 + fr) * SC_LS + sc * 16 + fq * 4);
                        f32x4 acc = MF32(cat8(ba, ka), sav, S[jt]);
                        const float4 g4 = *(const float4*)(s_gc + sc * 64 + jt * 16 + fq * 4);
                        acc[0] *= g4.x; acc[1] *= g4.y; acc[2] *= g4.z; acc[3] *= g4.w;
                        S[jt] = acc;
                    }
                }
            }
        }
        lds_barrier();
        {
            const int tau = tid >> 4, c4 = (tid & 15) * 4, e = tau * 64 + c4;
            const size_t n = (size_t)b * TS + t0 + tau;
            const float4 o4 = *(const float4*)(s_o + e), v4_ = *(const float4*)(s_v + e), g4_ = *(const float4*)(s_g + e);
            const float4 clw = *(const float4*)(cst + 800 + c4), clb = *(const float4*)(cst + 864 + c4);
            const float bsum = s_bs[tau];
            const float m_ = row16_sum((o4.x + o4.y) + (o4.z + o4.w)) * (1.0f / 64.0f);
            const float d0 = o4.x - m_, d1 = o4.y - m_, d2 = o4.z - m_, d3 = o4.w - m_;
            const float var = row16_sum(d0 * d0 + d1 * d1 + d2 * d2 + d3 * d3) * (1.0f / 64.0f);
            const float rs = rsqrtf(var + 64e-5f);
            const float y0 = (d0 * rs * clw.x + clb.x + bsum * v4_.x) * g4_.x, y1 = (d1 * rs * clw.y + clb.y + bsum * v4_.y) * g4_.y;
            const float y2 = (d2 * rs * clw.z + clb.z + bsum * v4_.z) * g4_.z, y3 = (d3 * rs * clw.w + clb.w + bsum * v4_.w) * g4_.w;
            if (tau < nval) *(uint2*)(Pr + n * 1024 + hc + c4) = pack4(y0, y1, y2, y3);
        }
    }
}

__device__ __forceinline__ void xcd_panel_map(int& mt0, int& mstep, int& nt) {
    const int b = obid(), G = (int)gridDim.x;
    if (G == 256) { nt = (b >> 3) & 7; mt0 = (b & 7) * 4 + (b >> 6); mstep = 32; }
    else { nt = b & 7; mt0 = b >> 3; mstep = G >> 3; }
}
__device__ void phase_merge(const Params& p, unsigned char* lds) {
    const int tid = otid(), lane = tid & 63, wid = tid >> 6, wr = wid >> 1, wc = wid & 1, fr = lane & 15, fq = lane >> 4;
    const bf16_t* h = (const bf16_t*)(WS(p) + OFF_H);
    const bf16_t* wb = (const bf16_t*)(WS(p) + OFF_WB);
    const float* rstd = (const float*)(WS(p) + OFF_RSTD);
    bf16_t* merged = (bf16_t*)(WS(p) + OFF_MERGED);
    const bf16_t* ysrc0 = (const bf16_t*)(WS(p) + OFF_PPOOL);
    const bf16_t* ysrc1 = (const bf16_t*)(WS(p) + OFF_PR);
    const bf16_t* ysrc2 = (const bf16_t*)(OUTB(p) + DO_YC);
    for (int tile = obid(); tile < 86 * 8; tile += gridDim.x) {
        const int mt = tile >> 3, nt = tile & 7;
        const int row0 = mt * 192, col0 = nt * 128;
        uint2 maccp[3][4];
#pragma unroll
        for (int m = 0; m < 3; ++m)
#pragma unroll
            for (int n = 0; n < 4; ++n) maccp[m][n] = make_uint2(0u, 0u);
#pragma unroll 1
        for (int i = 0; i < 3; ++i) {
            const bf16_t* ys = (i == 0) ? ysrc0 : (i == 1 ? ysrc1 : ysrc2);
            uint2 sg[3][4];
            {
                f32x4 ag[3][4]; g3_zero<3>(ag);
                G3<192> g;
                g3_setup<192>(g, [&](int r) { return h + (size_t)(row0 + r) * DM; }, [&](int r) { return wb + WB_WG + (size_t)(i * 1024 + col0 + r) * DM; }, tid);
                g3_kloop<192>(ag, g, DM, lds);
#pragma unroll
                for (int m = 0; m < 3; ++m) {
                    const float rs = rstd[row0 + wr * 48 + m * 16 + fr];
#pragma unroll
                    for (int n = 0; n < 4; ++n) sg[m][n] = pack4(fast_sigmoid(ag[m][n][0] * rs), fast_sigmoid(ag[m][n][1] * rs), fast_sigmoid(ag[m][n][2] * rs), fast_sigmoid(ag[m][n][3] * rs));
                }
            }
            {
                f32x4 ay[3][4]; g3_zero<3>(ay);
                G3<192> g;
                g3_setup<192>(g, [&](int r) { return ys + (size_t)(row0 + r) * DM; }, [&](int r) { return wb + WB_PA + (size_t)(i * 1024 + col0 + r) * DM; }, tid);
                g3_kloop<192>(ay, g, DM, lds);
#pragma unroll
                for (int m = 0; m < 3; ++m)
#pragma unroll
                    for (int n = 0; n < 4; ++n) {
                        const float m0 = __uint_as_float(maccp[m][n].x << 16) + __uint_as_float(sg[m][n].x << 16) * ay[m][n][0];
                        const float m1 = __uint_as_float(maccp[m][n].x & 0xFFFF0000u) + __uint_as_float(sg[m][n].x & 0xFFFF0000u) * ay[m][n][1];
                        const float m2 = __uint_as_float(maccp[m][n].y << 16) + __uint_as_float(sg[m][n].y << 16) * ay[m][n][2];
                        const float m3 = __uint_as_float(maccp[m][n].y & 0xFFFF0000u) + __uint_as_float(sg[m][n].y & 0xFFFF0000u) * ay[m][n][3];
                        maccp[m][n] = pack4(m0, m1, m2, m3);
                    }
            }
        }
#pragma unroll
        for (int m = 0; m < 3; ++m) {
            const int row = row0 + wr * 48 + m * 16 + fr;
#pragma unroll
            for (int n = 0; n < 4; ++n)
                *(uint2*)(merged + (size_t)row * 1024 + col0 + wc * 64 + n * 16 + fq * 4) = maccp[m][n];
        }
    }
}

__device__ void phase_outproj(const Params& p, unsigned char* lds) {
    const int tid = otid(), lane = tid & 63, wid = tid >> 6, wr = wid >> 1, wc = wid & 1, fr = lane & 15, fq = lane >> 4;
    const bf16_t* h = (const bf16_t*)(WS(p) + OFF_H);
    const bf16_t* wb = (const bf16_t*)(WS(p) + OFF_WB);
    const bf16_t* merged = (const bf16_t*)(WS(p) + OFF_MERGED);
    float* hm = (float*)(WS(p) + OFF_HM32);
    int mt0, mstep, nt;
    xcd_panel_map(mt0, mstep, nt);
    for (int mt = mt0; mt < 86; mt += mstep) {
        const int row0 = mt * 192, col0 = nt * 128;
        G3<192> g;
        g3_setup<192>(g, [&](int r) { return merged + (size_t)(row0 + r) * DM; }, [&](int r) { return wb + WB_WO + (size_t)(col0 + r) * DM; }, tid);
        f32x4 acc[3][4]; g3_zero<3>(acc);
        g3_kloop<192>(acc, g, DM, lds);
#pragma unroll
        for (int m = 0; m < 3; ++m) {
            const int row = row0 + wr * 48 + m * 16 + fr;
#pragma unroll
            for (int n = 0; n < 4; ++n) {
                const int col = col0 + wc * 64 + n * 16 + fq * 4;
                const uint2 hv = *(const uint2*)(h + (size_t)row * 1024 + col);
                float4 o;
                o.x = __uint_as_float(hv.x << 16) + acc[m][n][0]; o.y = __uint_as_float(hv.x & 0xFFFF0000u) + acc[m][n][1];
                o.z = __uint_as_float(hv.y << 16) + acc[m][n][2]; o.w = __uint_as_float(hv.y & 0xFFFF0000u) + acc[m][n][3];
                *(float4*)(hm + (size_t)row * 1024 + col) = o;
            }
        }
    }
}

__device__ __constant__ int c_pair_lo[6] = {0, 0, 0, 1, 1, 2};
__device__ __constant__ int c_pair_hi[6] = {1, 2, 3, 2, 3, 3};
__device__ void phase_route(const Params& p, int l, unsigned char* lds) {
    const int tid = otid(), lane = tid & 63, wid = tid >> 6;
    const int per = (NT + (int)gridDim.x - 1) / (int)gridDim.x;
    const int nbeg = obid() * per, nend = (nbeg + per < NT) ? nbeg + per : NT;
    int* s_cls = (int*)lds;
    int* s_base = s_cls + 512;
    float* s_wr = (float*)(lds + 4096);
    const float* hm = (const float*)(WS(p) + OFF_HM32);
    bf16_t* hn = (bf16_t*)(WS(p) + OFF_HN);
    const float* nf = p.in[33] + (size_t)l * 1024;
    const float* wg = p.in[34] + (size_t)l * 1024 * 4;
    const float* bg = p.in[35] + l * 4;
    const float* we = p.in[36] + (size_t)l * 1024 * 16;
    const float* be = p.in[37] + l * 16;
    int* cnt = (int*)(WS(p) + OFF_CTL);
    int* list = (int*)(WS(p) + OFF_LIST);
    float* pw = (float*)(WS(p) + OFF_PW);
    for (int e = tid; e < 1024 * 20; e += NTHR) {
        const int k = e / 20, c = e - k * 20;
        s_wr[c * 1024 + k] = (c < 4) ? wg[(size_t)k * 4 + c] : we[(size_t)k * 16 + (c - 4)];
    }
    __syncthreads();
    float4 nv[4], cur[4];
#pragma unroll
    for (int i = 0; i < 4; ++i) nv[i] = *(const float4*)(nf + i * 256 + lane * 4);
    if (nbeg + wid < nend) {
#pragma unroll
        for (int i = 0; i < 4; ++i) cur[i] = *(const float4*)(hm + (size_t)(nbeg + wid) * DM + i * 256 + lane * 4);
    }
    for (int n = nbeg + wid; n < nend; n += 8) {
        float4 xv[4]; float ss = 0.f;
#pragma unroll
        for (int i = 0; i < 4; ++i) { xv[i] = cur[i]; ss += xv[i].x * xv[i].x + xv[i].y * xv[i].y + xv[i].z * xv[i].z + xv[i].w * xv[i].w; }
        if (n + 8 < nend) {
#pragma unroll
            for (int i = 0; i < 4; ++i) cur[i] = *(const float4*)(hm + (size_t)(n + 8) * DM + i * 256 + lane * 4);
        }
        ss = wave_sum(ss);
        const float rs = rsqrtf(ss * (1.0f / 1024.0f) + 1e-6f);
        float lg[4] = {0.f, 0.f, 0.f, 0.f};
        float le[16];
#pragma unroll
        for (int e = 0; e < 16; ++e) le[e] = 0.f;
#pragma unroll
        for (int i = 0; i < 4; ++i) {
            float y[4] = {xv[i].x * rs * nv[i].x, xv[i].y * rs * nv[i].y, xv[i].z * rs * nv[i].z, xv[i].w * rs * nv[i].w};
            {
                const int d0 = i * 256 + lane * 4;
#pragma unroll
                for (int g = 0; g < 4; ++g) { const float4 w4 = *(const float4*)(s_wr + g * 1024 + d0); lg[g] += y[0] * w4.x + y[1] * w4.y + y[2] * w4.z + y[3] * w4.w; }
#pragma unroll
                for (int e = 0; e < 16; ++e) { const float4 w4 = *(const float4*)(s_wr + (4 + e) * 1024 + d0); le[e] += y[0] * w4.x + y[1] * w4.y + y[2] * w4.z + y[3] * w4.w; }
            }
            *(uint2*)(hn + (size_t)n * DM + i * 256 + lane * 4) = pack4(y[0], y[1], y[2], y[3]);
        }
#pragma unroll
        for (int g = 0; g < 4; ++g) lg[g] = wave_sum_fast(lg[g]) + bg[g];
#pragma unroll
        for (int e = 0; e < 16; ++e) le[e] = wave_sum_fast(le[e]) + be[e];
        if (lane == 0) {
            int gs = 0; float gm = lg[0];
#pragma unroll
            for (int g = 1; g < 4; ++g) if (lg[g] > gm) { gm = lg[g]; gs = g; }
            float den = 0.f;
#pragma unroll
            for (int g = 0; g < 4; ++g) den += __expf(lg[g] - gm);
            const float pgrp = 1.0f / den;
            float v4[4];
#pragma unroll
            for (int e = 0; e < 4; ++e) {
                const float m0 = (gs == 0) ? 1.f : 0.f, m1s = (gs == 1) ? 1.f : 0.f, m2s = (gs == 2) ? 1.f : 0.f, m3s = (gs == 3) ? 1.f : 0.f;
                v4[e] = le[e] * m0 + le[4 + e] * m1s + le[8 + e] * m2s + le[12 + e] * m3s;
            }
            int i1 = 0; float m1 = v4[0];
#pragma unroll
            for (int e = 1; e < 4; ++e) if (v4[e] > m1) { m1 = v4[e]; i1 = e; }
            int i2 = -1; float m2 = -INFINITY;
#pragma unroll
            for (int e = 0; e < 4; ++e) if (e != i1 && v4[e] > m2) { m2 = v4[e]; i2 = e; }
            const float e2 = __expf(m2 - m1);
            const float p1 = pgrp / (1.0f + e2), p2 = pgrp * e2 / (1.0f + e2);
            const int lo = i1 < i2 ? i1 : i2, hi = i1 < i2 ? i2 : i1;
            const float plo = i1 < i2 ? p1 : p2, phi = i1 < i2 ? p2 : p1;
            const int pi = (lo == 0) ? (hi - 1) : (lo == 1 ? hi + 1 : 5);
            const int cls = gs * 6 + pi;
            s_cls[n - nbeg] = cls;
            pw[(size_t)n * 2 + 0] = plo; pw[(size_t)n * 2 + 1] = phi;
        }
    }
    __syncthreads();
    const int nloc = nend - nbeg;
    if (tid < 24) {
        int c_ = 0;
        for (int i = 0; i < nloc; ++i) c_ += (s_cls[i] == tid) ? 1 : 0;
        s_base[tid] = c_ ? atomicAdd(&cnt[tid * 32], c_) : 0;
    }
    __syncthreads();
    for (int it = tid; it < nloc; it += NTHR) {
        const int cls = s_cls[it];
        int rank = 0;
        for (int i = 0; i < it; ++i) rank += (s_cls[i] == cls) ? 1 : 0;
        list[(size_t)cls * NT + s_base[cls] + rank] = nbeg + it;
    }
    __syncthreads();
}


struct MoeTile { int cls, ti, cnt, tg; };
__device__ __forceinline__ int moe_total_tiles(const int* cnt) { int s = 0; for (int c = 0; c < 24; ++c) s += (cnt[c * 32] + 127) >> 7; return s; }
__device__ __forceinline__ MoeTile moe_find(const int* cnt, int tile) {
    MoeTile r; int s = 0; r.cls = 0; r.ti = 0; r.cnt = 0; r.tg = tile;
    for (int c = 0; c < 24; ++c) { const int nt = (cnt[c * 32] + 127) >> 7; if (tile >= s && tile < s + nt) { r.cls = c; r.ti = tile - s; r.cnt = cnt[c * 32]; } s += nt; }
    return r;
}
__device__ void phase_moe1(const Params& p, unsigned char* lds) {
    const int tid = otid(), lane = tid & 63, wid = tid >> 6, wr = wid >> 1, wc = wid & 1, fr = lane & 15, fq = lane >> 4;
    const int* cnt = (const int*)(WS(p) + OFF_CTL);
    const int* list = (const int*)(WS(p) + OFF_LIST);
    const float* pw = (const float*)(WS(p) + OFF_PW);
    const bf16_t* hn = (const bf16_t*)(WS(p) + OFF_HN);
    const bf16_t* we = (const bf16_t*)(WS(p) + OFF_WEXP);
    bf16_t* hid = (bf16_t*)(OUTB(p) + DO_HID);
    const int total = moe_total_tiles(cnt);
    for (int item = obid(); item < total * 4; item += gridDim.x) {
        const MoeTile mt = moe_find(cnt, item >> 2);
        const int nt = item & 3, slot = nt >> 1, f0 = (nt & 1) * 128;
        const int g_ = mt.cls / 6, pi = mt.cls % 6;
        const int e = g_ * 4 + (slot == 0 ? c_pair_lo[pi] : c_pair_hi[pi]);
        const int* lst = list + (size_t)mt.cls * NT + mt.ti * 128;
        const int nvalid = min(128, mt.cnt - mt.ti * 128);
        f32x4 a1[2][4], a3[2][4]; g3_zero<2>(a1); g3_zero<2>(a3);
        G3D g;
#pragma unroll
        for (int i = 0; i < 2; ++i) {
            const int idx = tid + i * NTHR, row = idx >> 3, sl = (idx & 7) ^ (row & 7);
            g.ap[i] = hn + (size_t)lst[row < nvalid ? row : 0] * DM + sl * 8;
            g.b1[i] = we + WE_W1 + ((size_t)e * 256 + f0 + row) * 1024 + sl * 8;
            g.b3[i] = we + WE_W3 + ((size_t)e * 256 + f0 + row) * 1024 + sl * 8;
        }
        g3d_kloop(a1, a3, g, DM, lds);
#pragma unroll
        for (int m = 0; m < 2; ++m) {
            const int lr = wr * 32 + m * 16 + fr;
            const int tk = lst[lr < nvalid ? lr : 0];
            const float pe = pw[(size_t)tk * 2 + slot];
#pragma unroll
            for (int n = 0; n < 4; ++n) {
                const int col = slot * 256 + f0 + wc * 64 + n * 16 + fq * 4;
                float o[4];
#pragma unroll
                for (int j = 0; j < 4; ++j) { const float x1 = a1[m][n][j]; o[j] = x1 * sigmoidf_(x1) * a3[m][n][j] * pe; }
                *(uint2*)(hid + ((size_t)mt.tg * 128 + lr) * 512 + col) = pack4(o[0], o[1], o[2], o[3]);
            }
        }
    }
}
__device__ void phase_moe2(const Params& p, unsigned char* lds) {
    const int tid = otid(), lane = tid & 63, wid = tid >> 6, wr = wid >> 1, wc = wid & 1, fr = lane & 15, fq = lane >> 4;
    const int* cnt = (const int*)(WS(p) + OFF_CTL);
    const int* list = (const int*)(WS(p) + OFF_LIST);
    const bf16_t* we = (const bf16_t*)(WS(p) + OFF_WEXP);
    const bf16_t* hid = (const bf16_t*)(OUTB(p) + DO_HID);
    float* hm = (float*)(WS(p) + OFF_HM32);
    bf16_t* h = (bf16_t*)(WS(p) + OFF_H);
    const int total = moe_total_tiles(cnt);
    for (int item = obid(); item < total * 8; item += gridDim.x) {
        const MoeTile mt = moe_find(cnt, item >> 3);
        const int nt = item & 7, col0 = nt * 128;
        const int g_ = mt.cls / 6, pi = mt.cls % 6;
        const int elo = g_ * 4 + c_pair_lo[pi], ehi = g_ * 4 + c_pair_hi[pi];
        const int* lst = list + (size_t)mt.cls * NT + mt.ti * 128;
        const int nvalid = min(128, mt.cnt - mt.ti * 128);
        f32x4 acc[2][4]; g3_zero<2>(acc);
        G3<128> g;
        g3_setup<128>(g, [&](int r) { return hid + ((size_t)mt.tg * 128 + r) * 512; }, [&](int r) { return we + WE_W2 + ((size_t)elo * 1024 + col0 + r) * 256; }, tid);
        g3_kloop<128>(acc, g, 256, lds);
        g3_setup<128>(g, [&](int r) { return hid + ((size_t)mt.tg * 128 + r) * 512 + 256; }, [&](int r) { return we + WE_W2 + ((size_t)ehi * 1024 + col0 + r) * 256; }, tid);
        g3_kloop<128>(acc, g, 256, lds);
#pragma unroll
        for (int m = 0; m < 2; ++m) {
            const int lr = wr * 32 + m * 16 + fr;
            if (lr < nvalid) {
                const int tk = lst[lr];
#pragma unroll
                for (int n = 0; n < 4; ++n) {
                    const int col = col0 + wc * 64 + n * 16 + fq * 4;
                    float4 v = *(const float4*)(hm + (size_t)tk * 1024 + col);
                    v.x += acc[m][n][0]; v.y += acc[m][n][1]; v.z += acc[m][n][2]; v.w += acc[m][n][3];
                    *(float4*)(hm + (size_t)tk * 1024 + col) = v;
                    *(uint2*)(h + (size_t)tk * 1024 + col) = pack4(v.x, v.y, v.z, v.w);
                }
            }
        }
    }
}

__device__ void phase_final(const Params& p) {
    const int lane = otid() & 63;
    const int wave = (obid() * NTHR + otid()) >> 6, nw = gridDim.x * NTHR / 64;
    const float* hm = (const float*)(WS(p) + OFF_HM32);
    const float* nf = p.in[41];
    float4 g[4], cur[4];
#pragma unroll
    for (int i = 0; i < 4; ++i) g[i] = *(const float4*)(nf + i * 256 + lane * 4);
    auto rowp = [&](int r) { const int b = r / SEQ, s_ = r % SEQ; return hm + ((size_t)b * TS + NMETA + s_) * DM; };
    if (wave < NB * SEQ) {
        const float* src = rowp(wave);
#pragma unroll
        for (int i = 0; i < 4; ++i) cur[i] = *(const float4*)(src + i * 256 + lane * 4);
    }
    for (int r = wave; r < NB * SEQ; r += nw) {
        float4 v[4]; float ss = 0.f;
#pragma unroll
        for (int i = 0; i < 4; ++i) { v[i] = cur[i]; ss += v[i].x * v[i].x + v[i].y * v[i].y + v[i].z * v[i].z + v[i].w * v[i].w; }
        if (r + nw < NB * SEQ) {
            const float* src = rowp(r + nw);
#pragma unroll
            for (int i = 0; i < 4; ++i) cur[i] = *(const float4*)(src + i * 256 + lane * 4);
        }
        ss = wave_sum(ss);
        const float rs = rsqrtf(ss * (1.0f / 1024.0f) + 1e-6f);
#pragma unroll
        for (int i = 0; i < 4; ++i) {
            float4 o; o.x = v[i].x * rs * g[i].x; o.y = v[i].y * rs * g[i].y; o.z = v[i].z * rs * g[i].z; o.w = v[i].w * rs * g[i].w;
            *(float4*)((float*)OUTB(p) + (size_t)r * DM + i * 256 + lane * 4) = o;
        }
    }
}


#define XB_TMO      128
#define XB_XCNT(j)  (256  + 64 * (j))
#define XB_XSUB(j)  (1280 + 64 * (j))
#define XB_XGEN(j)  (2304 + 64 * (j))
#define XB_TOP      3328
#define XB_TOPGEN   3392
#define XCD_BAR_WORDS 3456
#define XB_SPIN_CAP (1u << 22)
#define LAS __attribute__((address_space(3)))
__device__ __forceinline__ unsigned xb_ld(unsigned* p) { return __hip_atomic_load(p, __ATOMIC_RELAXED, __HIP_MEMORY_SCOPE_AGENT); }
__device__ __forceinline__ unsigned xb_add(unsigned* p, unsigned v) { return __hip_atomic_fetch_add(p, v, __ATOMIC_RELAXED, __HIP_MEMORY_SCOPE_AGENT); }
__device__ __forceinline__ unsigned xb_xcc_id() { return (unsigned)__builtin_amdgcn_s_getreg((3 << 11) | 20) & 0xFu; }
#define XB_SPIN(cond, bar) do { unsigned _sp = 0; while (cond) { __builtin_amdgcn_s_sleep(1); \
    if ((++_sp & 255u) == 0u) { if (xb_ld(&(bar)[XB_TMO])) break; if (_sp > XB_SPIN_CAP) { atomicAdd(&(bar)[XB_TMO], 1u); break; } } } } while (0)
struct XcdBarrier { unsigned* bar; unsigned x; volatile LAS unsigned* st; };
__device__ __forceinline__ XcdBarrier xcd_barrier_post(unsigned* bar, volatile LAS unsigned* st) {
    XcdBarrier b; b.bar = bar; b.x = xb_xcc_id(); b.st = st;
    if (threadIdx.x == 0) (void)xb_add(&bar[XB_XCNT(b.x)], 1u);
    return b;
}
__device__ __forceinline__ void xcd_barrier_complete(unsigned* bar, unsigned x, unsigned& nloc, unsigned& nx) {
    const unsigned G = gridDim.x * gridDim.y * gridDim.z;
    unsigned sum, cnt, mine, sp = 0u;
    for (;;) {
        sum = 0u; cnt = 0u; mine = 0u;
#pragma unroll
        for (unsigned j = 0; j < 16; ++j) { const unsigned c = xb_ld(&bar[XB_XCNT(j)]); sum += c; cnt += (c > 0u) ? 1u : 0u; mine = (j == x) ? c : mine; }
        if (sum == G) break;
        __builtin_amdgcn_s_sleep(1);
        if ((++sp & 255u) == 0u) { if (xb_ld(&bar[XB_TMO])) break; if (sp > XB_SPIN_CAP) { atomicAdd(&bar[XB_TMO], 1u); break; } }
    }
    nloc = mine > 0u ? mine : 1u; nx = cnt > 0u ? cnt : 1u;
}
__device__ __forceinline__ void xcd_barrier(const XcdBarrier& b) {
    asm volatile("s_waitcnt vmcnt(0)" ::: "memory");
    __syncthreads();
    if (threadIdx.x == 0) {
        unsigned* bar = b.bar;
        __builtin_amdgcn_s_waitcnt(0);
        unsigned nloc = b.st[0], nx = b.st[1];
        if (nloc == 0u) { xcd_barrier_complete(bar, b.x, nloc, nx); b.st[0] = nloc; b.st[1] = nx; }
        const unsigned old = xb_add(&bar[XB_XSUB(b.x)], 1u);
        const unsigned gen = old / nloc;
        if (old + 1u == (gen + 1u) * nloc) {
            __builtin_amdgcn_fence(__ATOMIC_RELEASE, "agent");
            asm volatile("s_waitcnt vmcnt(0)" ::: "memory");
            const unsigned og = xb_add(&bar[XB_TOP], 1u);
            const unsigned tg = og / nx;
            if (og + 1u == (tg + 1u) * nx) xb_add(&bar[XB_TOPGEN], 1u);
            else XB_SPIN(xb_ld(&bar[XB_TOPGEN]) == tg, bar);
            __builtin_amdgcn_fence(__ATOMIC_ACQUIRE, "agent");
            xb_add(&bar[XB_XGEN(b.x)], 1u);
            asm volatile("s_waitcnt vmcnt(0)" ::: "memory");
        } else {
            XB_SPIN(xb_ld(&bar[XB_XGEN(b.x)]) == gen, bar);
            __builtin_amdgcn_fence(__ATOMIC_ACQUIRE, "agent");
            asm volatile("s_waitcnt vmcnt(0)" ::: "memory");
        }
    }
    __syncthreads();
}

__global__ void __launch_bounds__(NTHR) fwd_megakernel(Params p) {
    extern __shared__ __attribute__((aligned(16))) unsigned char lds[];
    cg::grid_group grid = cg::this_grid();
    volatile LAS unsigned* xst = (volatile LAS unsigned*)(lds + LDS_BYTES - 32);
    if (threadIdx.x < 2) xst[threadIdx.x] = 0u;
    __syncthreads();
    const XcdBarrier xb = xcd_barrier_post((unsigned*)(p.ws + OFF_BAR), xst);
    if (p.out == nullptr) grid.sync();
#pragma unroll 1
    for (int step = 0; step < 18; ++step) {
        const int l = step >= 9 ? 1 : 0;
        const int ph = step - l * 9;
        switch (ph) {
        case 0:
            if (l == 0) phase_embed(p); else phase_rowstat(p);
            phase_convert<false>(p, l, lds);
            if (obid() == 0 && otid() < 24) ((int*)(WS(p) + OFF_CTL))[otid() * 32] = 0;
            if (obid() == 0 && otid() == 32) ((int*)(WS(p) + OFF_CTL))[800 + l * 32] = 0;
            break;
        case 1: phase_inproj(p, lds); break;
        case 2: phase_dsa_prep(p, l); phase_lr_prep(p, l); break;
        case 3: {
            if (obid() < NB * 16) phase_scan5(p, l, lds, obid());
            int* qctr = (int*)(WS(p) + OFF_CTL) + 800 + l * 32;
            int* qslot = (int*)(lds + LDS_BYTES - 16);
            for (;;) {
                __syncthreads();
                if (otid() == 0) *qslot = atomicAdd(qctr, 1);
                __syncthreads();
                const int item = *qslot;
                if (item >= 516 + NT / 16 + 3072) break;
                if (item < 516) phase_pool(p, l, lds, item, item + 1, 1);
                else if (item < 516 + NT / 16) phase_dsa<false>(p, l, lds, (bf16_t*)(OUTB(p) + DO_YC), nullptr, nullptr, item - 516, item - 515, 1);
                else {
                    const int ct = item - (516 + NT / 16);
                    const ConvJob cj = get_job_late(p, l, ct >> 10);
                    conv_tile(cj, ct & 1023, (float*)lds);
                }
            }
        } break;
        case 4: phase_merge(p, lds); break;
        case 5: phase_outproj(p, lds); break;
        case 6: phase_route(p, l, lds); break;
        case 7: phase_moe1(p, lds); break;
        default: phase_moe2(p, lds); break;
        }
        xcd_barrier(xb);
    }
    phase_final(p);
}

extern "C" void kernel_launch(void* const* d_in, const int* in_sizes, int n_in,
                              void* d_out, int out_size, void* d_ws, size_t ws_size,
                              hipStream_t stream) {
    static int grid_blocks = 0;
    if (grid_blocks == 0) {
        int dev = 0, cus = 0, per_cu = 0;
        (void)hipGetDevice(&dev);
        (void)hipDeviceGetAttribute(&cus, hipDeviceAttributeMultiprocessorCount, dev);
        (void)hipFuncSetAttribute((const void*)fwd_megakernel, hipFuncAttributeMaxDynamicSharedMemorySize, LDS_BYTES);
        (void)hipOccupancyMaxActiveBlocksPerMultiprocessor(&per_cu, fwd_megakernel, NTHR, LDS_BYTES);
        if (per_cu < 1 || cus < NB * 16 || (cus & 7) != 0 || n_in != 42 || ws_size < WS_END) { fprintf(stderr, "kernel_launch: bad config per_cu=%d n_in=%d ws=%zu need=%zu\n", per_cu, n_in, ws_size, (size_t)WS_END); grid_blocks = -1; }
        else grid_blocks = cus;
    }
    if (grid_blocks < 0) return;
    Params p{};
    for (int i = 0; i < 42; ++i) p.in[i] = (const float*)d_in[i];
    p.out = (float*)d_out;
    p.ws = (unsigned char*)d_ws;
    (void)hipMemsetAsync((unsigned char*)d_ws + OFF_BAR, 0, XCD_BAR_WORDS * 4, stream);
    void* args[] = {&p};
    hipError_t e = hipLaunchCooperativeKernel((void*)fwd_megakernel, dim3(grid_blocks), dim3(NTHR), args, LDS_BYTES, stream);
    if (e != hipSuccess) fprintf(stderr, "cooperative launch failed: %s (grid %d)\n", hipGetErrorString(e), grid_blocks);
}
```

```cpp
#include <hip/hip_runtime.h>
#include <hip/hip_cooperative_groups.h>
#include <cstdio>
#include <cstdint>
#include <type_traits>
namespace cg = cooperative_groups;

typedef unsigned short bf16_t;
typedef short bf16x8 __attribute__((ext_vector_type(8)));
typedef float f32x4 __attribute__((ext_vector_type(4)));

constexpr int NB = 8, SEQ = 2048, NMETA = 16, TS = 2064, DM = 1024;
constexpr int NT = NB * TS;
constexpr int NTP = 16640;
constexpr int NTHR = 512;
constexpr int CIN = 7912;
constexpr int NP1 = 4864;
constexpr int PM_LD = 768;
constexpr int PM_WD = 0, PM_AD = 64, PM_GD = 128, PM_VD = 256, PM_CQ = 288, PM_CKV = 544, PM_KROPE = 672, PM_KIDX = 704;
constexpr int LDS_BYTES = 157 * 1024;

constexpr size_t AL(size_t x) { return (x + 255) & ~(size_t)255; }
constexpr size_t SZ_ACT = (size_t)NTP * 1024 * 2;
constexpr size_t OFF_CTL = 0;
constexpr size_t OFF_BAR = 4096;
constexpr size_t OFF_RSTD = OFF_BAR + 16384;
constexpr size_t OFF_ROPE = OFF_RSTD + AL((size_t)NTP * 4);
constexpr size_t OFF_H = OFF_ROPE + AL((size_t)TS * 16 * 4 * 2);
constexpr size_t OFF_WB = OFF_H + SZ_ACT;
constexpr size_t WB_WIN = 0;
constexpr size_t WB_WG = WB_WIN + (size_t)NP1 * 1024;
constexpr size_t WB_PA = WB_WG + (size_t)3072 * 1024;
constexpr size_t WB_WO = WB_PA + (size_t)3 * 1024 * 1024;
constexpr size_t WB_POOL = WB_WO + (size_t)1024 * 1024;
constexpr size_t WB_QI = WB_POOL + (size_t)4 * 256 * 256;
constexpr size_t WB_UQ = WB_QI + (size_t)512 * 256;
constexpr size_t WB_UK = WB_UQ + (size_t)1536 * 256;
constexpr size_t WB_UV = WB_UK + (size_t)16 * 128 * 64;
constexpr size_t WB_WIDX = WB_UV + (size_t)16 * 64 * 128;
constexpr size_t WB_END = WB_WIDX + (size_t)64 * 1024;
constexpr size_t OFF_PPOOL = OFF_WB + AL(WB_END * 2);
constexpr size_t OFF_PK = OFF_PPOOL + SZ_ACT;
constexpr size_t OFF_PR = OFF_PK + SZ_ACT;
constexpr size_t OFF_PV = OFF_PR + SZ_ACT;
constexpr size_t OFF_PMISC = OFF_PV + SZ_ACT;
constexpr size_t OFF_VFIRST = OFF_PMISC + AL((size_t)NTP * PM_LD * 2);
constexpr size_t OFF_HALO = OFF_VFIRST + SZ_ACT;
constexpr size_t OFF_LIST = OFF_HALO + AL((size_t)130 * 16 * 1024 * 2);
constexpr size_t OFF_PW = OFF_LIST + AL((size_t)24 * NT * 4);
constexpr size_t WS_END = OFF_PW + AL((size_t)NT * 2 * 4);
constexpr size_t OFF_MERGED = OFF_PK;
constexpr size_t OFF_HM32 = OFF_PR;
constexpr size_t OFF_HN = OFF_PPOOL;
constexpr size_t OFF_WEXP = OFF_PMISC;
constexpr size_t WE_W1 = 0, WE_W3 = (size_t)16 * 256 * 1024, WE_W2 = (size_t)2 * 16 * 256 * 1024;
static_assert((size_t)3 * 16 * 256 * 1024 * 2 <= (size_t)NTP * PM_LD * 2, "expert weights must fit in Pmisc");
constexpr size_t DO_YC = 0;
constexpr size_t DO_CQN = DO_YC + SZ_ACT;
constexpr size_t DO_KV = DO_CQN + AL((size_t)NT * 256 * 2);
constexpr size_t DO_KIDX = DO_KV + AL((size_t)NT * 160 * 2);
constexpr size_t DO_WHEAD = DO_KIDX + AL((size_t)NT * 64 * 2);
constexpr size_t DO_ALR = DO_WHEAD + AL((size_t)NT * 8 * 4);
constexpr size_t DO_END = DO_ALR + AL((size_t)NT * 288 * 2);
constexpr size_t DO_HID = DO_YC;
static_assert(DO_END <= (size_t)NB * SEQ * DM * 4, "d_out scratch overflow");
static_assert((size_t)(129 + 24) * 128 * 512 * 2 <= SZ_ACT, "hid fits");
static_assert(WS_END <= 277240096ull, "workspace overflow");

struct Params {
    const float* in[42];
    float* out;
    unsigned char* ws;
};

__device__ __forceinline__ int otid() { int t = threadIdx.x; asm volatile("" : "+v"(t)); return t; }
__device__ __forceinline__ int obid() { int b = blockIdx.x; asm volatile("" : "+s"(b)); return b; }
__device__ __forceinline__ unsigned char* WS(const Params& p) { unsigned char* w = p.ws; asm volatile("" : "+s"(w)); return w; }
__device__ __forceinline__ unsigned char* OUTB(const Params& p) { unsigned char* w = (unsigned char*)p.out; asm volatile("" : "+s"(w)); return w; }
__device__ __forceinline__ float bf2f(bf16_t v) { return __uint_as_float(((unsigned)v) << 16); }
typedef float f32x2v __attribute__((ext_vector_type(2)));
typedef __bf16 bf16x2v __attribute__((ext_vector_type(2)));
__device__ __forceinline__ unsigned pk2(float a, float b) { const f32x2v v = {a, b}; const bf16x2v r = __builtin_convertvector(v, bf16x2v); unsigned u; __builtin_memcpy(&u, &r, 4); return u; }
__device__ __forceinline__ bf16_t f2bf(float f) { const __bf16 h = (__bf16)f; bf16_t u; __builtin_memcpy(&u, &h, 2); return u; }
__device__ __forceinline__ float wave_sum(float v) {
#pragma unroll
    for (int o = 32; o > 0; o >>= 1) v += __shfl_xor(v, o);
    return v;
}
template <int CTRL> __device__ __forceinline__ float dpp_f(float x) {
    return __int_as_float(__builtin_amdgcn_update_dpp(0, __float_as_int(x), CTRL, 0xF, 0xF, true));
}
__device__ __forceinline__ float row16_sum(float v) {
    v += dpp_f<0xB1>(v);
    v += dpp_f<0x4E>(v);
    v += dpp_f<0x141>(v);
    v += dpp_f<0x140>(v);
    return v;
}
__device__ __forceinline__ void lds_barrier() { asm volatile("s_waitcnt lgkmcnt(0)" ::: "memory"); __builtin_amdgcn_s_barrier(); asm volatile("" ::: "memory"); }
__device__ __forceinline__ float fast_rcp(float x) { return __builtin_amdgcn_rcpf(x); }
__device__ __forceinline__ float fast_sigmoid(float x) { return fast_rcp(1.0f + __expf(-x)); }
__device__ __forceinline__ float fast_tanh(float x) { return 1.0f - 2.0f * fast_rcp(1.0f + __expf(2.0f * x)); }
__device__ __forceinline__ void row16_sum4(float& a, float& b, float& c, float& d) {
    asm volatile(
        "s_nop 1\n\t"
        "v_add_f32_dpp %0, %0, %0 quad_perm:[1,0,3,2] row_mask:0xf bank_mask:0xf\n\t"
        "v_add_f32_dpp %1, %1, %1 quad_perm:[1,0,3,2] row_mask:0xf bank_mask:0xf\n\t"
        "v_add_f32_dpp %2, %2, %2 quad_perm:[1,0,3,2] row_mask:0xf bank_mask:0xf\n\t"
        "v_add_f32_dpp %3, %3, %3 quad_perm:[1,0,3,2] row_mask:0xf bank_mask:0xf\n\t"
        "v_add_f32_dpp %0, %0, %0 quad_perm:[2,3,0,1] row_mask:0xf bank_mask:0xf\n\t"
        "v_add_f32_dpp %1, %1, %1 quad_perm:[2,3,0,1] row_mask:0xf bank_mask:0xf\n\t"
        "v_add_f32_dpp %2, %2, %2 quad_perm:[2,3,0,1] row_mask:0xf bank_mask:0xf\n\t"
        "v_add_f32_dpp %3, %3, %3 quad_perm:[2,3,0,1] row_mask:0xf bank_mask:0xf\n\t"
        "v_add_f32_dpp %0, %0, %0 row_half_mirror row_mask:0xf bank_mask:0xf\n\t"
        "v_add_f32_dpp %1, %1, %1 row_half_mirror row_mask:0xf bank_mask:0xf\n\t"
        "v_add_f32_dpp %2, %2, %2 row_half_mirror row_mask:0xf bank_mask:0xf\n\t"
        "v_add_f32_dpp %3, %3, %3 row_half_mirror row_mask:0xf bank_mask:0xf\n\t"
        "v_add_f32_dpp %0, %0, %0 row_mirror row_mask:0xf bank_mask:0xf\n\t"
        "v_add_f32_dpp %1, %1, %1 row_mirror row_mask:0xf bank_mask:0xf\n\t"
        "v_add_f32_dpp %2, %2, %2 row_mirror row_mask:0xf bank_mask:0xf\n\t"
        "v_add_f32_dpp %3, %3, %3 row_mirror row_mask:0xf bank_mask:0xf\n\t"
        "s_nop 1"
        : "+v"(a), "+v"(b), "+v"(c), "+v"(d));
}
__device__ __forceinline__ void row8_sum2(float& a, float& b) {
    asm volatile(
        "s_nop 1\n\t"
        "v_add_f32_dpp %0, %0, %0 quad_perm:[1,0,3,2] row_mask:0xf bank_mask:0xf\n\t"
        "v_add_f32_dpp %1, %1, %1 quad_perm:[1,0,3,2] row_mask:0xf bank_mask:0xf\n\t"
        "s_nop 0\n\t"
        "v_add_f32_dpp %0, %0, %0 quad_perm:[2,3,0,1] row_mask:0xf bank_mask:0xf\n\t"
        "v_add_f32_dpp %1, %1, %1 quad_perm:[2,3,0,1] row_mask:0xf bank_mask:0xf\n\t"
        "s_nop 0\n\t"
        "v_add_f32_dpp %0, %0, %0 row_half_mirror row_mask:0xf bank_mask:0xf\n\t"
        "v_add_f32_dpp %1, %1, %1 row_half_mirror row_mask:0xf bank_mask:0xf\n\t"
        "s_nop 1"
        : "+v"(a), "+v"(b));
}
__device__ __forceinline__ float wave_sum_fast(float v) { v = row16_sum(v); v += __shfl_xor(v, 16); v += __shfl_xor(v, 32); return v; }
__device__ __forceinline__ float sigmoidf_(float x) { return 1.0f / (1.0f + __expf(-x)); }
__device__ __forceinline__ float softplusf_(float z) { return fmaxf(z, 0.f) + log1pf(__expf(-fabsf(z))); }
__device__ __forceinline__ void glds16(const void* g, void* l) {
    __builtin_amdgcn_global_load_lds((const unsigned*)g, (unsigned*)l, 16, 0, 0);
}

__device__ void phase_embed(const Params& p) {
    const int lane = otid() & 63;
    const int wave = (obid() * NTHR + otid()) >> 6, nw = gridDim.x * NTHR / 64;
    bf16_t* h = (bf16_t*)(WS(p) + OFF_H);
    float* rstd = (float*)(WS(p) + OFF_RSTD);
    auto srcrow = [&](int n) { const int b = n / TS, t = n % TS; return t < NMETA ? p.in[1] + (size_t)t * DM : p.in[0] + ((size_t)b * SEQ + (t - NMETA)) * DM; };
    float4 cur[4];
    if (wave < NT) {
        const float* src = srcrow(wave);
#pragma unroll
        for (int i = 0; i < 4; ++i) cur[i] = *(const float4*)(src + i * 256 + lane * 4);
    }
    for (int n = wave; n < NTP; n += nw) {
        if (n < NT) {
            float4 v[4];
#pragma unroll
            for (int i = 0; i < 4; ++i) v[i] = cur[i];
            if (n + nw < NT) {
                const float* src = srcrow(n + nw);
#pragma unroll
                for (int i = 0; i < 4; ++i) cur[i] = *(const float4*)(src + i * 256 + lane * 4);
            }
            float ss = 0.f;
#pragma unroll
            for (int i = 0; i < 4; ++i) {
                ss += v[i].x * v[i].x + v[i].y * v[i].y + v[i].z * v[i].z + v[i].w * v[i].w;
                *(uint2*)(h + (size_t)n * DM + i * 256 + lane * 4) = make_uint2(pk2(v[i].x, v[i].y), pk2(v[i].z, v[i].w));
            }
            ss = wave_sum(ss);
            if (lane == 0) rstd[n] = rsqrtf(ss * (1.0f / 1024.0f) + 1e-6f);
        } else {
#pragma unroll
            for (int i = 0; i < 4; ++i) *(ushort4*)(h + (size_t)n * DM + i * 256 + lane * 4) = make_ushort4(0, 0, 0, 0);
            if (lane == 0) rstd[n] = 0.f;
        }
    }
    float* ctab = (float*)(WS(p) + OFF_ROPE);
    float* stab = ctab + TS * 16;
    for (int idx = obid() * NTHR + otid(); idx < TS * 16; idx += gridDim.x * NTHR) {
        const int t = idx >> 4, i = idx & 15;
        const float inv = powf(10000.0f, -(float)(2 * i) / 32.0f);
        const float ang = (float)t * inv;
        ctab[idx] = cosf(ang);
        stab[idx] = sinf(ang);
    }
}

__device__ void phase_rowstat(const Params& p) {
    const int lane = otid() & 63;
    const int wave = (obid() * NTHR + otid()) >> 6, nw = gridDim.x * NTHR / 64;
    const float* hm = (const float*)(WS(p) + OFF_HM32);
    float* rstd = (float*)(WS(p) + OFF_RSTD);
    float4 cur[4];
    if (wave < NT) {
#pragma unroll
        for (int i = 0; i < 4; ++i) cur[i] = *(const float4*)(hm + (size_t)wave * DM + i * 256 + lane * 4);
    }
    for (int n = wave; n < NT; n += nw) {
        float ss = 0.f;
#pragma unroll
        for (int i = 0; i < 4; ++i) ss += cur[i].x * cur[i].x + cur[i].y * cur[i].y + cur[i].z * cur[i].z + cur[i].w * cur[i].w;
        if (n + nw < NT) {
#pragma unroll
            for (int i = 0; i < 4; ++i) cur[i] = *(const float4*)(hm + (size_t)(n + nw) * DM + i * 256 + lane * 4);
        }
        ss = wave_sum(ss);
        if (lane == 0) rstd[n] = rsqrtf(ss * (1.0f / 1024.0f) + 1e-6f);
    }
}

struct ConvJob { const float* src; bf16_t* dst; const float* scale; int ldsrc, K, nvalid, nrows, nb, notr; size_t sbs, dbs; const float* srcB; int ldB, split; };
__device__ __forceinline__ int conv_job_tiles(const ConvJob& j) { return j.nb * (j.nrows >> 6) * (j.K >> 6); }
__device__ void conv_tile(const ConvJob& j, int tile, float* lds) {
    const int per = (j.nrows >> 6) * (j.K >> 6);
    const int bi = tile / per, rem = tile % per;
    const int ktiles = j.K >> 6;
    const int n0 = (rem / ktiles) << 6, k0 = (rem % ktiles) << 6;
    const int tid = otid(), tn = tid & 63, tk = tid >> 6;
    const float* src = j.src + (size_t)bi * j.sbs;
    bf16_t* dst = j.dst + (size_t)bi * j.dbs;
#pragma unroll
    for (int kk = 0; kk < 8; ++kk) {
        const int k = k0 + tk * 8 + kk;
        float v = 0.f;
        if (n0 + tn < j.nvalid) {
            if (j.split) { const int nn = n0 + tn; v = (nn < j.split) ? (j.src ? j.src[(size_t)k * j.ldsrc + nn] : 0.f) : j.srcB[(size_t)k * j.ldB + (nn - j.split)]; }
            else v = j.notr ? src[(size_t)(n0 + tn) * j.ldsrc + k] : src[(size_t)k * j.ldsrc + n0 + tn];
            if (j.scale) v *= j.scale[k];
        }
        lds[tn * 65 + tk * 8 + kk] = v;
    }
    __syncthreads();
    const int wn = tid >> 3, kq = tid & 7;
    uint4 o;
    unsigned w[4];
#pragma unroll
    for (int q = 0; q < 4; ++q) {
        const float lo = lds[wn * 65 + kq * 8 + 2 * q], hi = lds[wn * 65 + kq * 8 + 2 * q + 1];
        w[q] = pk2(lo, hi);
    }
    o.x = w[0]; o.y = w[1]; o.z = w[2]; o.w = w[3];
    *(uint4*)(dst + (size_t)(n0 + wn) * j.K + k0 + kq * 8) = o;
    __syncthreads();
}
__device__ ConvJob get_job_early(const Params& p, int l, int ji) {
    bf16_t* wb = (bf16_t*)(WS(p) + OFF_WB);
    const float* win = p.in[3] + (size_t)l * DM * CIN;
    const float* nm = p.in[2] + (size_t)l * DM;
    ConvJob j{}; j.nb = 1; j.sbs = 0; j.dbs = 0; j.K = 1024; j.ldsrc = CIN; j.scale = nm;
    switch (ji) {
    case 0: j.src = win + 3072; j.dst = wb + WB_WIN; j.nvalid = 4352; j.nrows = 4352; break;
    case 1: j.src = (l == 0 ? nullptr : p.in[17]); j.ldsrc = 32; j.split = 32; j.srcB = win + 7424; j.ldB = CIN; j.dst = wb + WB_WIN + (size_t)(4096 + PM_VD) * 1024; j.nvalid = 512; j.nrows = 512; break;
    case 2: j.src = win + 7904; j.dst = wb + WB_WIDX; j.nvalid = 8; j.nrows = 64; break;
    case 3: j.src = win; j.dst = wb + WB_WG; j.nvalid = 3072; j.nrows = 3072; break;
    case 4: j.src = p.in[29] + (size_t)l * DM * DM; j.ldsrc = 1024; j.scale = nullptr; j.dst = wb + WB_PA; j.nvalid = 1024; j.nrows = 1024; break;
    case 5: j.src = p.in[30] + (size_t)l * DM * DM; j.ldsrc = 1024; j.scale = nullptr; j.dst = wb + WB_PA + (size_t)1024 * 1024; j.nvalid = 1024; j.nrows = 1024; break;
    case 6: j.src = p.in[31] + (size_t)l * DM * DM; j.ldsrc = 1024; j.scale = nullptr; j.dst = wb + WB_PA + (size_t)2 * 1024 * 1024; j.nvalid = 1024; j.nrows = 1024; break;
    case 7: j.src = p.in[32] + (size_t)l * DM * DM; j.ldsrc = 1024; j.scale = nullptr; j.dst = wb + WB_WO; j.nvalid = 1024; j.nrows = 1024; break;
    case 8: j.src = p.in[5] + (size_t)l * 4 * 256 * 256; j.ldsrc = 256; j.K = 256; j.scale = nullptr; j.dst = wb + WB_POOL; j.nvalid = 256; j.nrows = 256; j.nb = 4; j.sbs = 65536; j.dbs = 65536; break;
    case 9: j.src = p.in[26] + (size_t)l * 256 * 512; j.ldsrc = 512; j.K = 256; j.scale = nullptr; j.dst = wb + WB_QI; j.nvalid = 512; j.nrows = 512; break;
    case 10: j.src = p.in[23] + (size_t)l * 256 * 1536; j.ldsrc = 1536; j.K = 256; j.scale = nullptr; j.dst = wb + WB_UQ; j.nvalid = 1536; j.nrows = 1536; break;
    case 11: j.src = p.in[24] + (size_t)l * 16 * 128 * 64; j.ldsrc = 64; j.K = 64; j.scale = nullptr; j.dst = wb + WB_UK; j.nvalid = 2048; j.nrows = 2048; j.notr = 1; break;
    default: j.src = p.in[25] + (size_t)l * 16 * 128 * 64; j.ldsrc = 64; j.K = 128; j.scale = nullptr; j.dst = wb + WB_UV; j.nvalid = 64; j.nrows = 64; j.nb = 16; j.sbs = 8192; j.dbs = 8192; break;
    }
    return j;
}
__device__ ConvJob get_job_late(const Params& p, int l, int ji) {
    bf16_t* we = (bf16_t*)(WS(p) + OFF_WEXP);
    ConvJob j{}; j.nb = 16; j.scale = nullptr; j.sbs = 262144; j.dbs = 262144;
    switch (ji) {
    case 0: j.src = p.in[38] + (size_t)l * 16 * 262144; j.dst = we + WE_W1; j.ldsrc = 256; j.K = 1024; j.nvalid = 256; j.nrows = 256; break;
    case 1: j.src = p.in[39] + (size_t)l * 16 * 262144; j.dst = we + WE_W3; j.ldsrc = 256; j.K = 1024; j.nvalid = 256; j.nrows = 256; break;
    default: j.src = p.in[40] + (size_t)l * 16 * 262144; j.dst = we + WE_W2; j.ldsrc = 1024; j.K = 256; j.nvalid = 1024; j.nrows = 1024; break;
    }
    return j;
}
template <bool LATE>
__device__ void phase_convert(const Params& p, int l, unsigned char* lds) {
    const int njobs = LATE ? 3 : 13;
    int base = 0;
    for (int ji = 0; ji < njobs; ++ji) {
        const ConvJob j = LATE ? get_job_late(p, l, ji) : get_job_early(p, l, ji);
        const int nt = conv_job_tiles(j);
        int first = ((int)obid() - base) % (int)gridDim.x; if (first < 0) first += gridDim.x;
        for (int t = first; t < nt; t += gridDim.x) conv_tile(j, t, (float*)lds);
        base += nt;
    }
}

template <int BM> struct G3 {
    static constexpr int MI = BM / 64;
    static constexpr int NA = BM / 64;
    static constexpr int STAGE = BM * 128 + 128 * 128;
    const bf16_t* ap[NA];
    const bf16_t* bp[2];
};
template <int BM>
__device__ __forceinline__ void g3_issue(const G3<BM>& g, int kt, unsigned char* stage, int tid) {
#pragma unroll
    for (int i = 0; i < G3<BM>::NA; ++i) glds16(g.ap[i] + kt * 64, stage + (tid + i * NTHR) * 16);
#pragma unroll
    for (int i = 0; i < 2; ++i) glds16(g.bp[i] + kt * 64, stage + BM * 128 + (tid + i * NTHR) * 16);
}
template <int BM, class FA, class FB>
__device__ __forceinline__ void g3_setup(G3<BM>& g, FA rowptr, FB bcol, int tid) {
#pragma unroll
    for (int i = 0; i < G3<BM>::NA; ++i) { const int idx = tid + i * NTHR, row = idx >> 3, sl = (idx & 7) ^ (row & 7); g.ap[i] = rowptr(row) + sl * 8; }
#pragma unroll
    for (int i = 0; i < 2; ++i) { const int idx = tid + i * NTHR, row = idx >> 3, sl = (idx & 7) ^ (row & 7); g.bp[i] = bcol(row) + sl * 8; }
}
template <int BM>
__device__ __forceinline__ void g3_kloop(f32x4 (&acc)[BM / 64][4], const G3<BM>& g, int K, unsigned char* lds) {
    constexpr int MI = G3<BM>::MI, STAGE = G3<BM>::STAGE, NL = G3<BM>::NA + 2;
    const int tid = otid(), lane = tid & 63, wid = tid >> 6, wr = wid >> 1, wc = wid & 1, fr = lane & 15, fq = lane >> 4;
    const int nk = K >> 6;
    g3_issue<BM>(g, 0, lds, tid);
    if (nk > 1) g3_issue<BM>(g, 1, lds + STAGE, tid);
    int cur = 0;
#pragma unroll 1
    for (int t = 0; t < nk; ++t) {
        if (t + 1 < nk) { if (NL == 6) asm volatile("s_waitcnt vmcnt(6)" ::: "memory"); else if (NL == 5) asm volatile("s_waitcnt vmcnt(5)" ::: "memory"); else asm volatile("s_waitcnt vmcnt(4)" ::: "memory"); }
        else asm volatile("s_waitcnt vmcnt(0)" ::: "memory");
        __builtin_amdgcn_s_barrier();
        if (t + 2 < nk) { int nx = cur + 2; if (nx >= 3) nx -= 3; g3_issue<BM>(g, t + 2, lds + nx * STAGE, tid); }
        const unsigned char* cA = lds + cur * STAGE;
        const unsigned char* cB = cA + BM * 128;
#pragma unroll
        for (int ks = 0; ks < 2; ++ks) {
            bf16x8 a[MI], b[4];
#pragma unroll
            for (int m = 0; m < MI; ++m) { const int row = wr * (BM / 4) + m * 16 + fr; a[m] = *(const bf16x8*)(cA + row * 128 + (((ks * 4 + fq) ^ (row & 7)) << 4)); }
#pragma unroll
            for (int n = 0; n < 4; ++n) { const int row = wc * 64 + n * 16 + fr; b[n] = *(const bf16x8*)(cB + row * 128 + (((ks * 4 + fq) ^ (row & 7)) << 4)); }
#pragma unroll
            for (int m = 0; m < MI; ++m)
#pragma unroll
                for (int n = 0; n < 4; ++n) acc[m][n] = __builtin_amdgcn_mfma_f32_16x16x32_bf16(b[n], a[m], acc[m][n], 0, 0, 0);
        }
        cur = (cur == 2) ? 0 : cur + 1;
    }
    __builtin_amdgcn_s_barrier();
}
struct G3D { const bf16_t* ap[2]; const bf16_t* b1[2]; const bf16_t* b3[2]; };
__device__ __forceinline__ void g3d_issue(const G3D& g, int kt, unsigned char* stage, int tid) {
#pragma unroll
    for (int i = 0; i < 2; ++i) glds16(g.ap[i] + kt * 64, stage + (tid + i * NTHR) * 16);
#pragma unroll
    for (int i = 0; i < 2; ++i) glds16(g.b1[i] + kt * 64, stage + 16384 + (tid + i * NTHR) * 16);
#pragma unroll
    for (int i = 0; i < 2; ++i) glds16(g.b3[i] + kt * 64, stage + 32768 + (tid + i * NTHR) * 16);
}
__device__ __forceinline__ void g3d_kloop(f32x4 (&acc1)[2][4], f32x4 (&acc3)[2][4], const G3D& g, int K, unsigned char* lds) {
    constexpr int STAGE = 49152;
    const int tid = otid(), lane = tid & 63, wid = tid >> 6, wr = wid >> 1, wc = wid & 1, fr = lane & 15, fq = lane >> 4;
    const int nk = K >> 6;
    g3d_issue(g, 0, lds, tid);
    if (nk > 1) g3d_issue(g, 1, lds + STAGE, tid);
    int cur = 0;
#pragma unroll 1
    for (int t = 0; t < nk; ++t) {
        if (t + 1 < nk) asm volatile("s_waitcnt vmcnt(6)" ::: "memory"); else asm volatile("s_waitcnt vmcnt(0)" ::: "memory");
        __builtin_amdgcn_s_barrier();
        if (t + 2 < nk) { int nx = cur + 2; if (nx >= 3) nx -= 3; g3d_issue(g, t + 2, lds + nx * STAGE, tid); }
        const unsigned char* cA = lds + cur * STAGE;
#pragma unroll
        for (int ks = 0; ks < 2; ++ks) {
            bf16x8 a[2], b1[4], b3[4];
#pragma unroll
            for (int m = 0; m < 2; ++m) { const int row = wr * 32 + m * 16 + fr; a[m] = *(const bf16x8*)(cA + row * 128 + (((ks * 4 + fq) ^ (row & 7)) << 4)); }
#pragma unroll
            for (int n = 0; n < 4; ++n) { const int row = wc * 64 + n * 16 + fr; const int off = row * 128 + (((ks * 4 + fq) ^ (row & 7)) << 4);
                b1[n] = *(const bf16x8*)(cA + 16384 + off); b3[n] = *(const bf16x8*)(cA + 32768 + off); }
#pragma unroll
            for (int m = 0; m < 2; ++m)
#pragma unroll
                for (int n = 0; n < 4; ++n) {
                    acc1[m][n] = __builtin_amdgcn_mfma_f32_16x16x32_bf16(b1[n], a[m], acc1[m][n], 0, 0, 0);
                    acc3[m][n] = __builtin_amdgcn_mfma_f32_16x16x32_bf16(b3[n], a[m], acc3[m][n], 0, 0, 0);
                }
        }
        cur = (cur == 2) ? 0 : cur + 1;
    }
    __builtin_amdgcn_s_barrier();
}
template <int MI>
__device__ __forceinline__ void g3_zero(f32x4 (&acc)[MI][4]) {
#pragma unroll
    for (int m = 0; m < MI; ++m)
#pragma unroll
        for (int n = 0; n < 4; ++n) acc[m][n] = (f32x4){0.f, 0.f, 0.f, 0.f};
}
__device__ __forceinline__ uint2 pack4(float a, float b, float c, float d) {
    uint2 r; r.x = pk2(a, b); r.y = pk2(c, d); return r;
}

namespace pg8 {
#define PG8_LAS __attribute__((address_space(3)))
typedef unsigned short bf16_t;
typedef short bf16x8 __attribute__((ext_vector_type(8)));
typedef float f32x4 __attribute__((ext_vector_type(4)));
typedef unsigned u32x4 __attribute__((ext_vector_type(4)));
constexpr int BM = 256, BK = 64, HALF = 128, HTB = HALF * BK * 2  , STAGE_BYTES = 8 * HTB, NXCD = 8, WGM = 8;

__host__ __device__ __forceinline__ int lds_byte(int r, int c) { const int st = (r >> 4) * 2 + (c >> 5), rr = r & 15, cc = c & 31, ob = rr * 64 + cc * 2; return st * 1024 + (ob ^ (((ob >> 9) & 1) << 5)); }
__host__ __device__ __forceinline__ void stage_rc(int b, int& R, int& C) { const int st = b / 1024, sb = b % 1024, swz = sb ^ (((sb >> 9) & 1) << 5); R = (st >> 1) * 16 + swz / 64; C = (st & 1) * 32 + (swz % 64) / 2; }
__host__ __device__ __forceinline__ int perm32(int rho) { const int n = rho >> 4, i = rho & 15; return 8 * (i >> 2) + 4 * n + (i & 3); }

struct Unit { int pm, pn; };
struct Gemm { const bf16_t* A; const bf16_t* Bt; int M, N, K; };

struct StaticOrder {
    int nM, nN, nwg, G, c;
    __host__ __device__ void init(int M, int N, int G_, int c_) { nM = M / BM; nN = N / BM; nwg = nM * nN; G = G_; c = c_; }
    __host__ __device__ bool next(int i, Unit& u) const {
        const long L = (long)i * G + c; if (L >= nwg) return false;
        int wgid = (int)L; { const int q = nwg / NXCD, r = nwg % NXCD, xcd = wgid % NXCD, off = wgid / NXCD; wgid = (xcd < r ? xcd * (q + 1) : r * (q + 1) + (xcd - r) * q) + off; }
        const int nig = WGM * nN, gid = wgid / nig, fm = gid * WGM, gsz = (nM - fm) < WGM ? (nM - fm) : WGM;
        u.pm = fm + ((wgid % nig) % gsz); u.pn = (wgid % nig) / gsz; return true;
    }
    __device__ __forceinline__ void a_ready(const Unit&) const {}
    __device__ __forceinline__ void done(const Unit&) const {}
};
template <class Epi, class Sched, bool STAMP = false>
__device__ __forceinline__ void gemm_phase(PG8_LAS unsigned char* lds, const Gemm g, const Sched& S, const Epi& E, unsigned long long* stamps) {
    const int tid = otid(), wid = __builtin_amdgcn_readfirstlane(tid >> 6), lane = tid & 63, wr = wid >> 2, wc = wid & 3, fr = lane & 15, fq = lane >> 4;
    const int K = g.K, nt = K / BK;
    int ts_lo = 0, ts_hi = 0, nts = 0; const unsigned long long rt_entry = STAMP ? 0ull : 0ull;
#define PG8_STAMP() do { if (STAMP && wid == 0 && nts < 64) { const unsigned long long _c = 0ull; \
        ts_lo = (lane == nts) ? (int)(unsigned)_c : ts_lo; ts_hi = (lane == nts) ? (int)(unsigned)(_c >> 32) : ts_hi; ++nts; } } while (0)
    PG8_STAMP();
    unsigned voffA[2], voffB[2];
#pragma unroll
    for (int i = 0; i < 2; ++i) { int R, C; stage_rc(tid * 16 + i * 8192, R, C); const int Rb = Epi::PERM ? ((R & ~31) + perm32(R & 31)) : R;
        voffA[i] = (unsigned)(R * K + C) * 2u; voffB[i] = (unsigned)(Rb * K + C) * 2u; }
    const size_t kstep = (size_t)(BK * 2);
    const size_t hstep = (size_t)HALF * K * 2;
    const size_t tstep = 2 * hstep;
    const unsigned ldsw = (unsigned)wid * 1024u;
    const int aoff = lds_byte(wr * 64 + fr, fq * 8), boff = lds_byte(wc * 32 + fr, fq * 8);
#define PG8_SA(b, h) (((b) * 2 + (h)) * HTB)
#define PG8_SB(b, h) ((4 + (b) * 2 + (h)) * HTB)
#define PG8_STAGE(bufoff, gbase, voff) do { _Pragma("unroll") for (int _i = 0; _i < 2; ++_i) \
        __builtin_amdgcn_global_load_lds((const unsigned*)((const char*)(gbase) + (voff)[_i]), (PG8_LAS unsigned*)(lds + (bufoff) + ldsw + _i * 8192), 16, 0, 0); } while (0)
#define PG8_LDA(dst, b, h) do { _Pragma("unroll") for (int m = 0; m < 4; ++m) _Pragma("unroll") for (int k = 0; k < 2; ++k) dst[m][k] = *(const PG8_LAS bf16x8*)(lds + PG8_SA(b, h) + aoff + m * 2048 + k * 1024); } while (0)
#define PG8_LDB(dst, b, h) do { _Pragma("unroll") for (int n = 0; n < 2; ++n) _Pragma("unroll") for (int k = 0; k < 2; ++k) dst[n][k] = *(const PG8_LAS bf16x8*)(lds + PG8_SB(b, h) + boff + n * 2048 + k * 1024); } while (0)
#define PG8_MMA(ai, bj, At, Bt) do { __builtin_amdgcn_s_setprio(1); _Pragma("unroll") for (int m = 0; m < 4; ++m) _Pragma("unroll") for (int n = 0; n < 2; ++n) _Pragma("unroll") for (int k = 0; k < 2; ++k) \
        acc[ai][bj][m][n] = __builtin_amdgcn_mfma_f32_16x16x32_bf16(Bt[n][k], At[m][k], acc[ai][bj][m][n], 0, 0, 0); __builtin_amdgcn_s_setprio(0); } while (0)
#define PG8_WAIT_V(n) asm volatile("s_waitcnt vmcnt(" #n ")" ::: "memory")
#define PG8_WAIT_L(n) asm volatile("s_waitcnt lgkmcnt(" #n ")" ::: "memory")
#define PG8_BAR __builtin_amdgcn_s_barrier()
#define PG8_SCHED __builtin_amdgcn_sched_barrier(0)
    Unit cur, nxt; int ui = 0;
    if (!S.next(0, cur)) return;
    f32x4 acc[2][2][4][2];
#pragma unroll
    for (int a = 0; a < 2; ++a)
#pragma unroll
        for (int b = 0; b < 2; ++b)
#pragma unroll
            for (int m = 0; m < 4; ++m)
#pragma unroll
                for (int n = 0; n < 2; ++n) acc[a][b][m][n] = (f32x4){0.f, 0.f, 0.f, 0.f};
    bf16x8 At[4][2], B0[2][2], B1[2][2];
    const char* cA = (const char*)g.A + (size_t)cur.pm * tstep; const char* cB = (const char*)g.Bt + (size_t)cur.pn * tstep;
    S.a_ready(cur);
    PG8_STAGE(PG8_SB(0, 0), cB, voffB); PG8_STAGE(PG8_SA(0, 0), cA, voffA); PG8_STAGE(PG8_SB(0, 1), cB + hstep, voffB); PG8_STAGE(PG8_SA(0, 1), cA + hstep, voffA);
    if (wr == 1) PG8_BAR;
    PG8_WAIT_V(4); PG8_BAR;
    PG8_STAGE(PG8_SB(1, 0), cB + kstep, voffB); PG8_STAGE(PG8_SA(1, 0), cA + kstep, voffA); PG8_STAGE(PG8_SB(1, 1), cB + hstep + kstep, voffB);
    PG8_WAIT_V(6); PG8_BAR;
    PG8_STAMP();
    for (;;) {
        const bool has_next = S.next(ui + 1, nxt);
        const char* nA = has_next ? (const char*)g.A + (size_t)nxt.pm * tstep : cA; const char* nB = has_next ? (const char*)g.Bt + (size_t)nxt.pn * tstep : cB;
        for (int t = 0; t < nt; t += 2) {
            const bool last = (t == nt - 2);
            const char* a1 = cA + (size_t)(t + 1) * kstep;
            const char* a2 = last ? nA : cA + (size_t)(t + 2) * kstep; const char* b2 = last ? nB : cB + (size_t)(t + 2) * kstep;
            const char* a3 = a2 + kstep; const char* b3 = b2 + kstep;
            if (last && has_next) S.a_ready(nxt);
            PG8_LDB(B0, 0, 0); PG8_SCHED; PG8_LDA(At, 0, 0); PG8_STAGE(PG8_SA(1, 1), a1 + hstep, voffA);
            PG8_WAIT_L(8); PG8_BAR; PG8_WAIT_L(0); PG8_MMA(0, 0, At, B0); PG8_BAR; PG8_SCHED;
            PG8_LDB(B1, 0, 1); PG8_STAGE(PG8_SB(0, 0), b2, voffB);
            PG8_BAR; PG8_WAIT_L(0); PG8_MMA(0, 1, At, B1); PG8_BAR;
            PG8_LDA(At, 0, 1); PG8_STAGE(PG8_SA(0, 0), a2, voffA);
            PG8_BAR; PG8_WAIT_L(0); PG8_MMA(1, 0, At, B0); PG8_BAR; PG8_SCHED;
            PG8_STAGE(PG8_SB(0, 1), b2 + hstep, voffB);
            PG8_WAIT_V(6); PG8_BAR; PG8_MMA(1, 1, At, B1); PG8_BAR;
            PG8_LDB(B0, 1, 0); PG8_SCHED; PG8_LDA(At, 1, 0); PG8_STAGE(PG8_SA(0, 1), a2 + hstep, voffA);
            PG8_WAIT_L(8); PG8_BAR; PG8_WAIT_L(0); PG8_MMA(0, 0, At, B0); PG8_BAR; PG8_SCHED;
            PG8_LDB(B1, 1, 1); PG8_STAGE(PG8_SB(1, 0), b3, voffB);
            PG8_BAR; PG8_WAIT_L(0); PG8_MMA(0, 1, At, B1); PG8_BAR;
            PG8_LDA(At, 1, 1); PG8_STAGE(PG8_SA(1, 0), a3, voffA);
            PG8_BAR; PG8_WAIT_L(0); PG8_MMA(1, 0, At, B0); PG8_BAR; PG8_SCHED;
            PG8_STAGE(PG8_SB(1, 1), b3 + hstep, voffB);
            PG8_WAIT_V(6); PG8_BAR; PG8_MMA(1, 1, At, B1); PG8_BAR;
        }
        PG8_STAMP();
        if constexpr (!Epi::AFTER_DRAIN) { E(acc, cur, wr, wc, fr, fq); S.done(cur); }
        PG8_STAMP();
        if (!has_next) break;
#pragma unroll
        for (int a = 0; a < 2; ++a)
#pragma unroll
            for (int b = 0; b < 2; ++b)
#pragma unroll
                for (int m = 0; m < 4; ++m)
#pragma unroll
                    for (int n = 0; n < 2; ++n) acc[a][b][m][n] = (f32x4){0.f, 0.f, 0.f, 0.f};
        cur = nxt; cA = nA; cB = nB; ++ui;
    }
    PG8_WAIT_V(0);
    if (wr == 0) PG8_BAR;
    PG8_BAR;
    if constexpr (Epi::AFTER_DRAIN) { E.fused(acc, cur, wr, wc, fr, fq, lds, wid, lane); S.done(cur); }
    PG8_STAMP();
    if (STAMP && wid == 0) { stamps[lane] = lane < nts ? (((unsigned long long)(unsigned)ts_hi << 32) | (unsigned)ts_lo) : 0ull;
        if (lane == 62) stamps[62] = rt_entry; if (lane == 63) stamps[63] = 0ull; }
#undef PG8_STAMP
#undef PG8_SA
#undef PG8_SB
#undef PG8_STAGE
#undef PG8_LDA
#undef PG8_LDB
#undef PG8_MMA
#undef PG8_WAIT_V
#undef PG8_WAIT_L
#undef PG8_BAR
#undef PG8_SCHED
}
}

struct EpiInproj {
    static constexpr bool PERM = true, AFTER_DRAIN = false;
    unsigned char* ws; const float* rstd;
    __device__ __forceinline__ void operator()(const pg8::f32x4 (&acc)[2][2][4][2], const pg8::Unit& u, int wr, int wc, int fr, int fq) const {
        const int pn = u.pn;
        bf16_t* dst; int ld, cb;
        if (pn < 4) { dst = (bf16_t*)(ws + OFF_PPOOL); ld = 1024; cb = pn * 256; }
        else if (pn < 8) { dst = (bf16_t*)(ws + OFF_PR); ld = 1024; cb = (pn - 4) * 256; }
        else if (pn < 12) { dst = (bf16_t*)(ws + OFF_PK); ld = 1024; cb = (pn - 8) * 256; }
        else if (pn < 16) { dst = (bf16_t*)(ws + OFF_PV); ld = 1024; cb = (pn - 12) * 256; }
        else { dst = (bf16_t*)(ws + OFF_PMISC); ld = PM_LD; cb = (pn - 16) * 256; }
        bf16_t* halo = (bf16_t*)(ws + OFF_HALO);
#pragma unroll
        for (int ai = 0; ai < 2; ++ai)
#pragma unroll
            for (int m = 0; m < 4; ++m) {
                const int row = u.pm * 256 + ai * 128 + wr * 64 + m * 16 + fr;
                if (row < NT) {
                    const float rs = rstd[row];
                    const int lr = row & 127;
#pragma unroll
                    for (int bj = 0; bj < 2; ++bj) {
                        const int col = cb + bj * 128 + wc * 32 + fq * 8;
                        const uint2 lo = pack4(acc[ai][bj][m][0][0] * rs, acc[ai][bj][m][0][1] * rs, acc[ai][bj][m][0][2] * rs, acc[ai][bj][m][0][3] * rs);
                        const uint2 hi = pack4(acc[ai][bj][m][1][0] * rs, acc[ai][bj][m][1][1] * rs, acc[ai][bj][m][1][2] * rs, acc[ai][bj][m][1][3] * rs);
                        const uint4 v = make_uint4(lo.x, lo.y, hi.x, hi.y);
                        *(uint4*)(dst + (size_t)row * ld + col) = v;
                        if (pn < 4 && lr >= 112) *(uint4*)(halo + ((size_t)(row >> 7) * 16 + (lr - 112)) * 1024 + col) = v;
                    }
                }
            }
    }
};
__device__ void phase_inproj(const Params& p, unsigned char* lds) {
    pg8::StaticOrder S; S.init(NTP, NP1, (int)gridDim.x, obid());
    pg8::Gemm g; g.A = (const pg8::bf16_t*)(WS(p) + OFF_H); g.Bt = (const pg8::bf16_t*)(WS(p) + OFF_WB) + WB_WIN; g.M = NTP; g.N = NP1; g.K = DM;
    EpiInproj E; E.ws = WS(p); E.rstd = (const float*)(WS(p) + OFF_RSTD);
    pg8::gemm_phase<EpiInproj, pg8::StaticOrder, false>((PG8_LAS unsigned char*)lds, g, S, E, nullptr);
}

__device__ void phase_pool(const Params& p, int l, unsigned char* lds, int tb, int te, int tstep) {
    const int tid = otid(), lane = tid & 63, wid = tid >> 6, fr = lane & 15, fq = lane >> 4;
    bf16_t* pp = (bf16_t*)(WS(p) + OFF_PPOOL);
    const bf16_t* halo = (const bf16_t*)(WS(p) + OFF_HALO);
    const bf16_t* pw = (const bf16_t*)(WS(p) + OFF_WB) + WB_POOL;
    const float* scale = p.in[6] + (size_t)l * 1024;
    bf16_t* sp = (bf16_t*)lds;
    constexpr int SLD = 264;
    for (int tile = tb; tile < te; tile += tstep) {
        const int mt = tile >> 2, g = tile & 3;
        const int row0 = mt * 128, w = 2 << g;
        {
            const int c = tid & 255, r0 = (tid >> 8) * 64, col = g * 256 + c;
            auto rawv = [&](int n2) -> float {
                return (n2 >= row0) ? bf2f(pp[(size_t)n2 * 1024 + col]) : bf2f(halo[((size_t)(n2 >> 7) * 16 + ((n2 & 127) - 112)) * 1024 + col]);
            };
            int n = row0 + r0, t = n % TS;
            float sum = 0.f;
            const int have = (t < w) ? t : w;
            for (int i = 1; i <= have; ++i) sum += rawv(n - i);
#pragma unroll 4
            for (int r = 0; r < 64; ++r, ++n) {
                if (t == 0) sum = 0.f;
                const float v = rawv(n);
                sum += v;
                if (t >= w) sum -= rawv(n - w);
                const int cnt = (t + 1 < w) ? (t + 1) : w;
                sp[(r0 + r) * SLD + c] = f2bf(sum * (1.0f / (float)cnt) - v);
                t = (t + 1 == TS) ? 0 : t + 1;
            }
        }
        __syncthreads();
        f32x4 acc[8][2];
#pragma unroll
        for (int m = 0; m < 8; ++m) { acc[m][0] = (f32x4){0.f, 0.f, 0.f, 0.f}; acc[m][1] = (f32x4){0.f, 0.f, 0.f, 0.f}; }
        const bf16_t* wg = pw + (size_t)g * 65536;
#pragma unroll 1
        for (int kk = 0; kk < 8; ++kk) {
            bf16x8 bfr[2];
#pragma unroll
            for (int n = 0; n < 2; ++n) bfr[n] = *(const bf16x8*)(wg + (size_t)(wid * 32 + n * 16 + fr) * 256 + kk * 32 + fq * 8);
#pragma unroll
            for (int m = 0; m < 8; ++m) {
                const bf16x8 a = *(const bf16x8*)(sp + (m * 16 + fr) * SLD + kk * 32 + fq * 8);
                acc[m][0] = __builtin_amdgcn_mfma_f32_16x16x32_bf16(a, bfr[0], acc[m][0], 0, 0, 0);
                acc[m][1] = __builtin_amdgcn_mfma_f32_16x16x32_bf16(a, bfr[1], acc[m][1], 0, 0, 0);
            }
        }
#pragma unroll
        for (int m = 0; m < 8; ++m)
#pragma unroll
            for (int n = 0; n < 2; ++n) {
                const int col = g * 256 + wid * 32 + n * 16 + fr;
                const float sc = scale[col];
#pragma unroll
                for (int j = 0; j < 4; ++j) {
                    const int row = row0 + m * 16 + fq * 4 + j;
                    pp[(size_t)row * 1024 + col] = f2bf(acc[m][n][j] * sc);
                }
            }
        __syncthreads();
    }
}

__device__ void phase_dsa_prep(const Params& p, int l) {
    const int lane = otid() & 63;
    const int wave = (obid() * NTHR + otid()) >> 6, nw = gridDim.x * NTHR / 64;
    const bf16_t* pm = (const bf16_t*)(WS(p) + OFF_PMISC);
    unsigned char* dob = OUTB(p);
    bf16_t* cqn = (bf16_t*)(dob + DO_CQN);
    bf16_t* kv = (bf16_t*)(dob + DO_KV);
    bf16_t* kidx = (bf16_t*)(dob + DO_KIDX);
    float* whead = (float*)(dob + DO_WHEAD);
    const float* ctab = (const float*)(WS(p) + OFF_ROPE);
    const float* stab = ctab + TS * 16;
    const bf16_t* hrow = (const bf16_t*)(WS(p) + OFF_H);
    const bf16_t* wwidx = (const bf16_t*)(WS(p) + OFF_WB) + WB_WIDX;
    const float* rstd_ = (const float*)(WS(p) + OFF_RSTD);
    const float4 qn4 = *(const float4*)(p.in[21] + l * 256 + lane * 4);
    const float2 kvn2 = *(const float2*)(p.in[22] + l * 128 + lane * 2);
    const float inw = p.in[27][l * 64 + lane], inb = p.in[28][l * 64 + lane];
    uint4 ww[8][2];
#pragma unroll
    for (int j = 0; j < 8; ++j) { ww[j][0] = *(const uint4*)(wwidx + (size_t)j * DM + lane * 16); ww[j][1] = *(const uint4*)(wwidx + (size_t)j * DM + lane * 16 + 8); }
    struct In { uint2 cq; unsigned ckv; bf16_t kr0, kr1, kix; uint4 h0, h1; float rs, c, s; };
    auto load = [&](int n) {
        In r;
        const bf16_t* row = pm + (size_t)n * PM_LD;
        const int t = n % TS;
        r.cq = *(const uint2*)(row + PM_CQ + lane * 4);
        r.ckv = *(const unsigned*)(row + PM_CKV + lane * 2);
        r.kr0 = row[PM_KROPE + (lane & 15)]; r.kr1 = row[PM_KROPE + 16 + (lane & 15)];
        r.kix = row[PM_KIDX + lane];
        r.h0 = *(const uint4*)(hrow + (size_t)n * DM + lane * 16); r.h1 = *(const uint4*)(hrow + (size_t)n * DM + lane * 16 + 8);
        r.rs = rstd_[n];
        r.c = ctab[t * 16 + (lane & 15)]; r.s = stab[t * 16 + (lane & 15)];
        return r;
    };
    In cur = load(wave < NT ? wave : 0);
    for (int n = wave; n < NT; n += nw) {
        const In x = cur;
        if (n + nw < NT) cur = load(n + nw);
        {
            const float v0 = __uint_as_float(x.cq.x << 16), v1 = __uint_as_float(x.cq.x & 0xFFFF0000u), v2 = __uint_as_float(x.cq.y << 16), v3 = __uint_as_float(x.cq.y & 0xFFFF0000u);
            const float ss = wave_sum_fast(v0 * v0 + v1 * v1 + v2 * v2 + v3 * v3);
            const float rs = rsqrtf(ss * (1.0f / 256.0f) + 1e-6f);
            *(uint2*)(cqn + (size_t)n * 256 + lane * 4) = pack4(v0 * rs * qn4.x, v1 * rs * qn4.y, v2 * rs * qn4.z, v3 * rs * qn4.w);
        }
        {
            const float v0 = __uint_as_float(x.ckv << 16), v1 = __uint_as_float(x.ckv & 0xFFFF0000u);
            const float ss = wave_sum_fast(v0 * v0 + v1 * v1);
            const float rs = rsqrtf(ss * (1.0f / 128.0f) + 1e-6f);
            *(unsigned*)(kv + (size_t)n * 160 + lane * 2) = pk2(v0 * rs * kvn2.x, v1 * rs * kvn2.y);
        }
        if (lane < 16) {
            const float x1 = bf2f(x.kr0), x2 = bf2f(x.kr1);
            kv[(size_t)n * 160 + 128 + lane] = f2bf(x1 * x.c - x2 * x.s);
            kv[(size_t)n * 160 + 144 + lane] = f2bf(x2 * x.c + x1 * x.s);
        }
        {
            const float xv = bf2f(x.kix);
            const float mu = wave_sum_fast(xv) * (1.0f / 64.0f);
            const float d = xv - mu;
            const float var = wave_sum_fast(d * d) * (1.0f / 64.0f);
            const float y = d * rsqrtf(var + 1e-6f) * inw + inb;
            const float yo = __shfl_xor(y, 16);
            float o = y;
            if (lane < 32) o = (lane < 16) ? (y * x.c - yo * x.s) : (y * x.c + yo * x.s);
            kidx[(size_t)n * 64 + lane] = f2bf(o);
        }
        {
            const uint4 hv0 = x.h0, hv1 = x.h1;
            float hx[16];
            hx[0] = __uint_as_float(hv0.x << 16); hx[1] = __uint_as_float(hv0.x & 0xFFFF0000u); hx[2] = __uint_as_float(hv0.y << 16); hx[3] = __uint_as_float(hv0.y & 0xFFFF0000u);
            hx[4] = __uint_as_float(hv0.z << 16); hx[5] = __uint_as_float(hv0.z & 0xFFFF0000u); hx[6] = __uint_as_float(hv0.w << 16); hx[7] = __uint_as_float(hv0.w & 0xFFFF0000u);
            hx[8] = __uint_as_float(hv1.x << 16); hx[9] = __uint_as_float(hv1.x & 0xFFFF0000u); hx[10] = __uint_as_float(hv1.y << 16); hx[11] = __uint_as_float(hv1.y & 0xFFFF0000u);
            hx[12] = __uint_as_float(hv1.z << 16); hx[13] = __uint_as_float(hv1.z & 0xFFFF0000u); hx[14] = __uint_as_float(hv1.w << 16); hx[15] = __uint_as_float(hv1.w & 0xFFFF0000u);
            float myw = 0.f;
#pragma unroll
            for (int j = 0; j < 8; ++j) {
                const uint4 w0 = ww[j][0], w1 = ww[j][1];
                float d = hx[0] * __uint_as_float(w0.x << 16) + hx[1] * __uint_as_float(w0.x & 0xFFFF0000u) + hx[2] * __uint_as_float(w0.y << 16) + hx[3] * __uint_as_float(w0.y & 0xFFFF0000u)
                        + hx[4] * __uint_as_float(w0.z << 16) + hx[5] * __uint_as_float(w0.z & 0xFFFF0000u) + hx[6] * __uint_as_float(w0.w << 16) + hx[7] * __uint_as_float(w0.w & 0xFFFF0000u)
                        + hx[8] * __uint_as_float(w1.x << 16) + hx[9] * __uint_as_float(w1.x & 0xFFFF0000u) + hx[10] * __uint_as_float(w1.y << 16) + hx[11] * __uint_as_float(w1.y & 0xFFFF0000u)
                        + hx[12] * __uint_as_float(w1.z << 16) + hx[13] * __uint_as_float(w1.z & 0xFFFF0000u) + hx[14] * __uint_as_float(w1.w << 16) + hx[15] * __uint_as_float(w1.w & 0xFFFF0000u);
                d = wave_sum_fast(d);
                myw = (lane == j) ? d : myw;
            }
            if (lane < 8) whead[(size_t)n * 8 + lane] = myw * x.rs * 0.04419417382415922f;
        }
    }
}

typedef short s16x4 __attribute__((ext_vector_type(4)));
__device__ __forceinline__ unsigned f2h_bits(float f) { const _Float16 h = (_Float16)f; unsigned short u; __builtin_memcpy(&u, &h, 2); return u; }
template <bool IMPORT_SEL>
__device__ void phase_dsa(const Params& p, int l, unsigned char* lds, bf16_t* yc, const unsigned short* gsel, const int* gnsel, int tb, int te, int tstep) {
    const int tid = otid(), lane = tid & 63, wid = tid >> 6, fr = lane & 15, fq = lane >> 4;
    unsigned short* s_sc = (unsigned short*)lds;
    bf16_t* s_qi = (bf16_t*)(lds + 66048);
    bf16_t* s_Q = (bf16_t*)lds;
    unsigned char* s_Vw = lds + 82432 + wid * 8192;
    bf16_t* s_qn = (bf16_t*)s_Vw;
    unsigned short* s_sel = (unsigned short*)(lds + 82432 + 65536);
    int* s_nsel = (int*)(lds + 82432 + 65536 + 8192);
    unsigned char* dob = OUTB(p);
    const bf16_t* cqn = (const bf16_t*)(dob + DO_CQN);
    const bf16_t* kv = (const bf16_t*)(dob + DO_KV);
    const bf16_t* kidx = (const bf16_t*)(dob + DO_KIDX);
    const float* whead = (const float*)(dob + DO_WHEAD);
    const float* ctab = (const float*)(WS(p) + OFF_ROPE);
    const float* stab = ctab + TS * 16;
    const bf16_t* wb = (const bf16_t*)(WS(p) + OFF_WB);
    const bf16_t* wqiT = wb + WB_QI;
    const bf16_t* wuqT = wb + WB_UQ;
    const bf16_t* wuk = wb + WB_UK;
    const bf16_t* wuvT = wb + WB_UV;
    const float scale = 0.10206207261596575f;
    const f32x4 z4 = {0.f, 0.f, 0.f, 0.f};
    for (int tile = tb; tile < te; tile += tstep) {
        const int qt = 128 - (tile >> 3), b = tile & 7;
        const int t0 = qt * 16;
        const size_t n0 = (size_t)b * TS + t0;
        {
            bf16x8 acq[8];
#pragma unroll
            for (int kk = 0; kk < 8; ++kk) acq[kk] = *(const bf16x8*)(cqn + (n0 + fr) * 256 + kk * 32 + fq * 8);
            f32x4 c[4] = {z4, z4, z4, z4};
#pragma unroll
            for (int kb = 0; kb < 8; kb += 4) {
                bf16x8 bf[4][4];
#pragma unroll
                for (int k4 = 0; k4 < 4; ++k4)
#pragma unroll
                    for (int nt = 0; nt < 4; ++nt) bf[k4][nt] = *(const bf16x8*)(wqiT + (size_t)(wid * 64 + nt * 16 + fr) * 256 + (kb + k4) * 32 + fq * 8);
#pragma unroll
                for (int k4 = 0; k4 < 4; ++k4)
#pragma unroll
                    for (int nt = 0; nt < 4; ++nt) c[nt] = __builtin_amdgcn_mfma_f32_16x16x32_bf16(acq[kb + k4], bf[k4][nt], c[nt], 0, 0, 0);
            }
#pragma unroll
            for (int j = 0; j < 4; ++j) {
                const int t = t0 + fq * 4 + j;
                const float cs = ctab[t * 16 + fr], sn = stab[t * 16 + fr];
                const float x1 = c[0][j], x2 = c[1][j];
                c[0][j] = x1 * cs - x2 * sn; c[1][j] = x2 * cs + x1 * sn;
            }
#pragma unroll
            for (int nt = 0; nt < 4; ++nt)
#pragma unroll
                for (int j = 0; j < 4; ++j) s_qi[(fq * 4 + j) * 512 + wid * 64 + nt * 16 + fr] = f2bf(c[nt][j]);
        }
        __syncthreads();
        if (!IMPORT_SEL) {
            bf16x8 aq[8][2];
#pragma unroll
            for (int h = 0; h < 8; ++h)
#pragma unroll
                for (int ks = 0; ks < 2; ++ks) aq[h][ks] = *(const bf16x8*)(s_qi + fr * 512 + h * 64 + ks * 32 + fq * 8);
            float wh[4][8];
#pragma unroll
            for (int j = 0; j < 4; ++j) {
                const float4 w0 = *(const float4*)(whead + (n0 + fq * 4 + j) * 8), w1 = *(const float4*)(whead + (n0 + fq * 4 + j) * 8 + 4);
                wh[j][0] = w0.x; wh[j][1] = w0.y; wh[j][2] = w0.z; wh[j][3] = w0.w; wh[j][4] = w1.x; wh[j][5] = w1.y; wh[j][6] = w1.z; wh[j][7] = w1.w;
            }
            const int nkt = qt + 1;
            bf16x8 nb0 = {0, 0, 0, 0, 0, 0, 0, 0}, nb1 = nb0;
            if (wid < nkt) { const bf16_t* kr0 = kidx + ((size_t)b * TS + wid * 16 + fr) * 64 + fq * 8; nb0 = *(const bf16x8*)kr0; nb1 = *(const bf16x8*)(kr0 + 32); }
#pragma unroll 1
            for (int kt = wid; kt < nkt; kt += 8) {
                const bf16x8 bk0 = nb0, bk1 = nb1;
                if (kt + 8 < nkt) { const bf16_t* krn = kidx + ((size_t)b * TS + (kt + 8) * 16 + fr) * 64 + fq * 8; nb0 = *(const bf16x8*)krn; nb1 = *(const bf16x8*)(krn + 32); }
                float I[4] = {0.f, 0.f, 0.f, 0.f};
#pragma unroll
                for (int h = 0; h < 8; ++h) {
                    f32x4 a = __builtin_amdgcn_mfma_f32_16x16x32_bf16(aq[h][0], bk0, z4, 0, 0, 0);
                    a = __builtin_amdgcn_mfma_f32_16x16x32_bf16(aq[h][1], bk1, a, 0, 0, 0);
#pragma unroll
                    for (int j = 0; j < 4; ++j) I[j] += wh[j][h] * fmaxf(a[j], 0.f);
                }
#pragma unroll
                for (int j = 0; j < 4; ++j) s_sc[(fq * 4 + j) * 2064 + kt * 16 + fr] = (unsigned short)f2h_bits(I[j]);
            }
        }
        __syncthreads();
#pragma unroll 1
        for (int qi2 = 0; qi2 < 2; ++qi2) {
            const int q = wid + qi2 * 8;
            const int nadm = t0 + q + 1;
            unsigned short* sel = s_sel + q * 256;
            if (IMPORT_SEL) {
                const int ns = gnsel[n0 + q];
                for (int i = lane; i < ns; i += 64) sel[i] = gsel[(n0 + q) * 256 + i];
                if (lane == 0) s_nsel[q] = ns;
            } else if (nadm <= 256) {
                for (int i = lane; i < nadm; i += 64) sel[i] = (unsigned short)i;
                if (lane == 0) s_nsel[q] = nadm;
            } else {
                unsigned* hist = (unsigned*)(lds + 82432 + wid * 8192);
                const unsigned short* scq = s_sc + q * 2064;
                const int nch = (nadm + 63) >> 6;
                unsigned B1 = 0u; int na1 = 0, na2 = 0; unsigned T = 0u;
#pragma unroll 1
                for (int pass = 0; pass < 2; ++pass) {
                    *(uint4*)(hist + lane * 4) = make_uint4(0u, 0u, 0u, 0u);
#pragma unroll 1
                    for (int c0 = 0; c0 < nch; c0 += 8) {
                        unsigned kb[8];
#pragma unroll
                        for (int j = 0; j < 8; ++j) { const int s_ = (c0 + j) * 64 + lane; kb[j] = (s_ < nadm) ? (unsigned)scq[s_] : 0x10000u; }
#pragma unroll
                        for (int j = 0; j < 8; ++j) {
                            const unsigned u = kb[j];
                            const unsigned k = (u & 0x8000u) ? (~u & 0xFFFFu) : (u | 0x8000u);
                            const bool ok = (u < 0x10000u) && (pass == 0 || (k >> 8) == B1);
                            if (ok) atomicAdd(hist + (pass == 0 ? (k >> 8) : (k & 255u)), 1u);
                        }
                    }
                    const int need = 256 - na1;
                    const uint4 h4 = *(const uint4*)(hist + lane * 4);
                    const int sl = (int)(h4.x + h4.y + h4.z + h4.w);
                    int suf = sl;
#pragma unroll
                    for (int o = 1; o < 64; o <<= 1) { const int t_ = __shfl_down(suf, o); suf += (lane + o < 64) ? t_ : 0; }
                    const int above = suf - sl;
                    const bool mine = (suf >= need) && (above < need);
                    int a = above, bsel, asel;
                    if (a + (int)h4.w >= need) { bsel = 3; asel = a; }
                    else { a += (int)h4.w;
                        if (a + (int)h4.z >= need) { bsel = 2; asel = a; }
                        else { a += (int)h4.z;
                            if (a + (int)h4.y >= need) { bsel = 1; asel = a; }
                            else { a += (int)h4.y; bsel = 0; asel = a; } } }
                    const int src = __ffsll((long long)__ballot(mine)) - 1;
                    const unsigned bin = (unsigned)__shfl(lane * 4 + bsel, src); const int nab = __shfl(asel, src);
                    if (pass == 0) { B1 = bin; na1 = nab; } else { T = (B1 << 8) | bin; na2 = nab; }
                }
                {
                    const int rties = 256 - (na1 + na2);
                    int base = 0, ties = 0;
                    const unsigned long long ltmask = (1ull << lane) - 1ull;
#pragma unroll 1
                    for (int c0 = 0; c0 < nch; c0 += 4) {
                        unsigned kb[4];
#pragma unroll
                        for (int j = 0; j < 4; ++j) { const int s_ = (c0 + j) * 64 + lane; kb[j] = (s_ < nadm) ? (unsigned)scq[s_] : 0x10000u; }
#pragma unroll
                        for (int j = 0; j < 4; ++j) {
                            const int s_ = (c0 + j) * 64 + lane;
                            const unsigned u = kb[j];
                            const bool valid = u < 0x10000u;
                            const unsigned k = (u & 0x8000u) ? (~u & 0xFFFFu) : (u | 0x8000u);
                            const bool gt = valid && k > T, eq = valid && k == T;
                            const unsigned long long em = __ballot(eq);
                            const int myrank = ties + __popcll(em & ltmask);
                            const bool take = gt || (eq && myrank < rties);
                            const unsigned long long tm = __ballot(take);
                            const int pos = base + __popcll(tm & ltmask);
                            if (take && pos < 256) sel[pos] = (unsigned short)s_;
                            base += __popcll(tm); ties += __popcll(em);
                        }
                    }
                }
                if (lane == 0) s_nsel[q] = 256;
            }
        }
        __syncthreads();
#pragma unroll 1
        for (int hi = 0; hi < 2; ++hi) {
            const int hh = wid * 2 + hi;
            bf16x8 acq[8];
#pragma unroll
            for (int kk = 0; kk < 8; ++kk) acq[kk] = *(const bf16x8*)(cqn + (n0 + fr) * 256 + kk * 32 + fq * 8);
            f32x4 c6[6] = {z4, z4, z4, z4, z4, z4};
#pragma unroll
            for (int kb = 0; kb < 8; kb += 4) {
                bf16x8 bf[4][6];
#pragma unroll
                for (int k4 = 0; k4 < 4; ++k4)
#pragma unroll
                    for (int nt = 0; nt < 6; ++nt) bf[k4][nt] = *(const bf16x8*)(wuqT + (size_t)(hh * 96 + nt * 16 + fr) * 256 + (kb + k4) * 32 + fq * 8);
#pragma unroll
                for (int k4 = 0; k4 < 4; ++k4)
#pragma unroll
                    for (int nt = 0; nt < 6; ++nt) c6[nt] = __builtin_amdgcn_mfma_f32_16x16x32_bf16(acq[kb + k4], bf[k4][nt], c6[nt], 0, 0, 0);
            }
#pragma unroll
            for (int j = 0; j < 4; ++j) {
                const int q = fq * 4 + j, t = t0 + q;
                const float cs = ctab[t * 16 + fr], sn = stab[t * 16 + fr];
                const float x1 = c6[4][j], x2 = c6[5][j];
                s_Q[(q * 16 + hh) * 160 + 128 + fr] = f2bf(x1 * cs - x2 * sn);
                s_Q[(q * 16 + hh) * 160 + 144 + fr] = f2bf(x2 * cs + x1 * sn);
#pragma unroll
                for (int nt = 0; nt < 4; ++nt) s_qn[q * 64 + nt * 16 + fr] = f2bf(c6[nt][j]);
            }
            __syncthreads();
            bf16x8 an[2];
#pragma unroll
            for (int ks = 0; ks < 2; ++ks) an[ks] = *(const bf16x8*)(s_qn + fr * 64 + ks * 32 + fq * 8);
            bf16x8 bwk[8][2];
#pragma unroll
            for (int nt = 0; nt < 8; ++nt)
#pragma unroll
                for (int ks = 0; ks < 2; ++ks) bwk[nt][ks] = *(const bf16x8*)(wuk + (size_t)(hh * 128 + nt * 16 + fr) * 64 + ks * 32 + fq * 8);
#pragma unroll
            for (int nt = 0; nt < 8; ++nt) {
                f32x4 a = z4;
#pragma unroll
                for (int ks = 0; ks < 2; ++ks)
                    a = __builtin_amdgcn_mfma_f32_16x16x32_bf16(an[ks], bwk[nt][ks], a, 0, 0, 0);
#pragma unroll
                for (int j = 0; j < 4; ++j) s_Q[((fq * 4 + j) * 16 + hh) * 160 + nt * 16 + fr] = f2bf(a[j]);
            }
            __syncthreads();
        }
#pragma unroll 1
        for (int qi2 = 0; qi2 < 2; ++qi2) {
            const int q = wid + qi2 * 8;
            bf16x8 bq[5];
#pragma unroll
            for (int ks = 0; ks < 5; ++ks) bq[ks] = *(const bf16x8*)(s_Q + (q * 16 + fr) * 160 + ks * 32 + fq * 8);
            const int nsel = s_nsel[q];
            const unsigned short* sel = s_sel + q * 256;
            float m = -INFINITY, lsum = 0.f;
            f32x4 O[8] = {z4, z4, z4, z4, z4, z4, z4, z4};
            const int nchunk = (nsel + 31) >> 5;
            bf16x8 akn[2][5];
#pragma unroll
            for (int mt = 0; mt < 2; ++mt) {
                const int ki = mt * 16 + fr;
                const int sidx = sel[ki < nsel ? ki : 0];
                const bf16_t* krow = kv + ((size_t)b * TS + sidx) * 160 + fq * 8;
#pragma unroll
                for (int ks = 0; ks < 5; ++ks) akn[mt][ks] = *(const bf16x8*)(krow + ks * 32);
            }
#pragma unroll 1
            for (int ch = 0; ch < nchunk; ++ch) {
                bf16x8 ak[2][5];
#pragma unroll
                for (int mt = 0; mt < 2; ++mt)
#pragma unroll
                    for (int ks = 0; ks < 5; ++ks) ak[mt][ks] = akn[mt][ks];
                if (ch + 1 < nchunk) {
#pragma unroll
                    for (int mt = 0; mt < 2; ++mt) {
                        const int ki = (ch + 1) * 32 + mt * 16 + fr;
                        const int sidx = sel[ki < nsel ? ki : 0];
                        const bf16_t* krow = kv + ((size_t)b * TS + sidx) * 160 + fq * 8;
#pragma unroll
                        for (int ks = 0; ks < 5; ++ks) akn[mt][ks] = *(const bf16x8*)(krow + ks * 32);
                    }
                }
#pragma unroll
                for (int mt = 0; mt < 2; ++mt)
#pragma unroll
                    for (int ks = 0; ks < 4; ++ks) {
                        const int r = mt * 16 + fr;
                        *(bf16x8*)(s_Vw + r * 256 + (((ks * 2 + (fq >> 1)) ^ (r & 7)) * 32) + (fq & 1) * 16) = ak[mt][ks];
                    }
                f32x4 st[2] = {z4, z4};
#pragma unroll
                for (int mt = 0; mt < 2; ++mt)
#pragma unroll
                    for (int ks = 0; ks < 5; ++ks) st[mt] = __builtin_amdgcn_mfma_f32_16x16x32_bf16(ak[mt][ks], bq[ks], st[mt], 0, 0, 0);
                float sv[2][4]; float cmax = -INFINITY;
#pragma unroll
                for (int mt = 0; mt < 2; ++mt)
#pragma unroll
                    for (int j = 0; j < 4; ++j) {
                        const int ke = ch * 32 + mt * 16 + fq * 4 + j;
                        const float s_ = (ke < nsel) ? st[mt][j] * scale : -INFINITY;
                        sv[mt][j] = s_; cmax = fmaxf(cmax, s_);
                    }
                cmax = fmaxf(cmax, __shfl_xor(cmax, 16)); cmax = fmaxf(cmax, __shfl_xor(cmax, 32));
                const float mnew = fmaxf(m, cmax);
                const float alpha = __expf(m - mnew);
                float psum = 0.f;
#pragma unroll
                for (int mt = 0; mt < 2; ++mt)
#pragma unroll
                    for (int j = 0; j < 4; ++j) { const float pe = __expf(sv[mt][j] - mnew); sv[mt][j] = pe; psum += pe; }
                psum += __shfl_xor(psum, 16); psum += __shfl_xor(psum, 32);
                lsum = lsum * alpha + psum; m = mnew;
#pragma unroll
                for (int ct = 0; ct < 8; ++ct) O[ct] = O[ct] * alpha;
                bf16x8 pf;
#pragma unroll
                for (int mt = 0; mt < 2; ++mt)
#pragma unroll
                    for (int j = 0; j < 4; ++j) pf[mt * 4 + j] = (short)f2bf(sv[mt][j]);
                const int q_ = fr >> 2, p_ = fr & 3;
                const int r0 = fq * 4 + q_, r1 = 16 + r0;
#pragma unroll
                for (int ct = 0; ct < 8; ++ct) {
                    const s16x4 v0 = __builtin_amdgcn_ds_read_tr16_b64_v4i16((__attribute__((address_space(3))) s16x4*)(s_Vw + r0 * 256 + ((ct ^ (r0 & 7)) * 32) + p_ * 8));
                    const s16x4 v1 = __builtin_amdgcn_ds_read_tr16_b64_v4i16((__attribute__((address_space(3))) s16x4*)(s_Vw + r1 * 256 + ((ct ^ (r1 & 7)) * 32) + p_ * 8));
                    bf16x8 av; av[0] = v0[0]; av[1] = v0[1]; av[2] = v0[2]; av[3] = v0[3]; av[4] = v1[0]; av[5] = v1[1]; av[6] = v1[2]; av[7] = v1[3];
                    O[ct] = __builtin_amdgcn_mfma_f32_16x16x32_bf16(av, pf, O[ct], 0, 0, 0);
                }
            }
            const float inv = 1.0f / lsum;
#pragma unroll
            for (int ct = 0; ct < 8; ++ct)
#pragma unroll
                for (int j = 0; j < 4; ++j) s_Q[(q * 16 + fr) * 160 + ct * 16 + fq * 4 + j] = f2bf(O[ct][j] * inv);
        }
        __syncthreads();
#pragma unroll 1
        for (int hi = 0; hi < 2; ++hi) {
            const int hh = wid * 2 + hi;
            bf16x8 ao[4];
#pragma unroll
            for (int ks = 0; ks < 4; ++ks) ao[ks] = *(const bf16x8*)(s_Q + (fr * 16 + hh) * 160 + ks * 32 + fq * 8);
#pragma unroll
            for (int nt = 0; nt < 4; ++nt) {
                f32x4 a = z4;
#pragma unroll
                for (int ks = 0; ks < 4; ++ks)
                    a = __builtin_amdgcn_mfma_f32_16x16x32_bf16(ao[ks], *(const bf16x8*)(wuvT + (size_t)(hh * 64 + nt * 16 + fr) * 128 + ks * 32 + fq * 8), a, 0, 0, 0);
#pragma unroll
                for (int j = 0; j < 4; ++j) yc[(n0 + fq * 4 + j) * 1024 + hh * 64 + nt * 16 + fr] = f2bf(a[j]);
            }
        }
        __syncthreads();
    }
}


__device__ void phase_lr_prep(const Params& p, int l) {
    const int lane = otid() & 63;
    const int wave = (obid() * NTHR + otid()) >> 6, nw = gridDim.x * NTHR / 64;
    const bf16_t* pm = (const bf16_t*)(WS(p) + OFF_PMISC);
    bf16_t* alr = (bf16_t*)(OUTB(p) + DO_ALR);
    const float4 mu4 = *(const float4*)(p.in[4] + (size_t)l * 3328 + 3072 + lane * 4);
    const float4 vm4 = *(const float4*)(p.in[18] + (lane & 7) * 4);
    struct In { uint2 c0, p0, c1, p1; };
    auto load = [&](int n) {
        In r;
        const bf16_t* row = pm + (size_t)n * PM_LD;
        const bool hp = (n % TS) > 0;
        r.c0 = *(const uint2*)(row + lane * 4);
        r.p0 = hp ? *(const uint2*)(row - PM_LD + lane * 4) : make_uint2(0u, 0u);
        r.c1 = make_uint2(0u, 0u); r.p1 = r.c1;
        if (lane < 8) { r.c1 = *(const uint2*)(row + 256 + lane * 4); if (hp) r.p1 = *(const uint2*)(row - PM_LD + 256 + lane * 4); }
        return r;
    };
    auto mix4 = [&](const uint2 c, const uint2 q, const float4 m, float (&o)[4]) {
        const float c0 = __uint_as_float(c.x << 16), c1 = __uint_as_float(c.x & 0xFFFF0000u), c2 = __uint_as_float(c.y << 16), c3 = __uint_as_float(c.y & 0xFFFF0000u);
        const float q0 = __uint_as_float(q.x << 16), q1 = __uint_as_float(q.x & 0xFFFF0000u), q2 = __uint_as_float(q.y << 16), q3 = __uint_as_float(q.y & 0xFFFF0000u);
        o[0] = c0 + (q0 - c0) * m.x; o[1] = c1 + (q1 - c1) * m.y; o[2] = c2 + (q2 - c2) * m.z; o[3] = c3 + (q3 - c3) * m.w;
    };
    In cur = load(wave < NT ? wave : 0);
    for (int n = wave; n < NT; n += nw) {
        const In x = cur;
        if (n + nw < NT) cur = load(n + nw);
        float o[4];
        mix4(x.c0, x.p0, mu4, o);
        if (lane < 16) { o[0] = tanhf(o[0]); o[1] = tanhf(o[1]); o[2] = tanhf(o[2]); o[3] = tanhf(o[3]); }
        else if (lane >= 32) { o[0] = sigmoidf_(o[0]); o[1] = sigmoidf_(o[1]); o[2] = sigmoidf_(o[2]); o[3] = sigmoidf_(o[3]); }
        *(uint2*)(alr + (size_t)n * 288 + lane * 4) = pack4(o[0], o[1], o[2], o[3]);
        if (lane < 8) {
            mix4(x.c1, x.p1, vm4, o);
            *(uint2*)(alr + (size_t)n * 288 + 256 + lane * 4) = pack4(o[0], o[1], o[2], o[3]);
        }
    }
}

typedef short sh4 __attribute__((ext_vector_type(4)));
__device__ __forceinline__ sh4 pk4v(const f32x4& v) { const uint2 u = pack4(v[0], v[1], v[2], v[3]); sh4 r; __builtin_memcpy(&r, &u, 8); return r; }
__device__ __forceinline__ bf16x8 cat8(const sh4& a, const sh4& b) { bf16x8 r; r[0] = a[0]; r[1] = a[1]; r[2] = a[2]; r[3] = a[3]; r[4] = b[0]; r[5] = b[1]; r[6] = b[2]; r[7] = b[3]; return r; }
#define MF32(a, b, c) __builtin_amdgcn_mfma_f32_16x16x32_bf16(a, b, c, 0, 0, 0)
#define MF16(a, b, c) MF32(cat8(a, sh4{0, 0, 0, 0}), cat8(b, sh4{0, 0, 0, 0}), c)
constexpr int SC_LT = 72;
constexpr int SC_LS = 36;
constexpr int SC_TC = 32;
constexpr int SC_ROWB = 1088;
__device__ __forceinline__ const unsigned char* scan_piece_src(const Params& p, int l, int b, int hc, int t0, int pi, bool& ok) {
    const int tau = pi / 68, seg = pi - tau * 68;
    const int t = t0 + tau;
    ok = (t < TS) && (tau < SC_TC);
    const size_t n = (size_t)b * TS + t;
    const unsigned char* ws = WS(p);
    if (seg < 8) return ws + OFF_PR + (n * 1024 + hc) * 2 + seg * 16;
    if (seg < 16) return ws + OFF_PK + (n * 1024 + hc) * 2 + (seg - 8) * 16;
    if (seg < 24) return ws + OFF_PV + (n * 1024 + hc) * 2 + (seg - 16) * 16;
    if (seg < 60) return OUTB(p) + DO_ALR + (n * 288) * 2 + (seg - 24) * 16;
    ok = ok && (l > 0);
    return ws + OFF_VFIRST + (n * 1024 + hc) * 2 + (seg - 60) * 16;
}
__device__ void phase_scan5(const Params& p, int l, unsigned char* lds, int blk) {
    const int tid = otid(), lane = tid & 63, wid = tid >> 6, fr = lane & 15, fq = lane >> 4;
    const int b = blk >> 4, hh = blk & 15, hc = hh * 64;
    float* s_r = (float*)lds;
    float* s_w = s_r + 2048;
    float* s_k = s_w + 2048;
    float* s_v = s_k + 2048;
    float* s_a = s_v + 2048;
    float* s_b = s_a + 2048;
    float* s_g = s_b + 2048;
    float* s_o = s_g + 2048;
    bf16_t* o_at = (bf16_t*)(s_o + 2048);
    bf16_t* o_rt = o_at + 32 * SC_LT;
    bf16_t* o_bt = o_rt + 32 * SC_LT;
    bf16_t* o_kt = o_bt + 32 * SC_LT;
    bf16_t* o_bT = o_kt + 32 * SC_LT;
    bf16_t* o_kT = o_bT + 64 * SC_LS;
    bf16_t* o_vT = o_kT + 64 * SC_LS;
    float* s_gc = (float*)(o_vT + 64 * SC_LS);
    unsigned char* raw = (unsigned char*)(s_gc + 128);
    float* prevb = (float*)(raw + 32 * SC_ROWB);
    unsigned* prevr = (unsigned*)prevb;
    float* s_bs = s_r;
    float* cst = prevb + 960;
    const float* mu = p.in[4] + (size_t)l * 3328;
    for (int e = tid; e < 480; e += NTHR) {
        float v;
        if (e < 192) v = mu[(e >> 6) * 1024 + hc + (e & 63)];
        else if (e < 448) v = mu[3072 + (e - 192)];
        else v = p.in[18][e - 448];
        cst[e] = v;
    }
    if (tid < 64) {
        cst[480 + tid] = p.in[7][l * 1024 + hc + tid];
        cst[544 + tid] = p.in[9][l * 1024 + hc + tid];
        cst[608 + tid] = p.in[12][l * 1024 + hc + tid];
        cst[672 + tid] = p.in[13][l * 1024 + hc + tid];
        cst[736 + tid] = p.in[14][l * 1024 + hc + tid];
        cst[800 + tid] = p.in[15][l * 1024 + hc + tid];
        cst[864 + tid] = p.in[16][l * 1024 + hc + tid];
        cst[928 + tid] = p.in[19][hc + tid];
    }
    const int mm = wid >> 1, ntb = (wid & 1) * 2;
    const int nks = (mm == 2) ? 4 : (mm == 3 ? 1 : 2);
    bf16x8 Bw[2][4];
    {
        const float* wsrc = (mm == 0) ? p.in[8] + (size_t)l * 64 * 1024 : (mm == 1) ? p.in[10] + (size_t)l * 64 * 1024 : (mm == 2) ? p.in[11] + (size_t)l * 128 * 1024 : p.in[20];
#pragma unroll
        for (int n2 = 0; n2 < 2; ++n2)
#pragma unroll
            for (int ks = 0; ks < 4; ++ks) {
                bf16x8 f;
#pragma unroll
                for (int j = 0; j < 8; ++j) {
                    const bool okw = ks < nks && (mm < 3 || l > 0);
                    const float v = wsrc[(size_t)(okw ? (ks * 32 + fq * 8 + j) : 0) * 1024 + hc + (ntb + n2) * 16 + fr];
                    f[j] = (short)f2bf(okw ? v : 0.f);
                }
                Bw[n2][ks] = f;
            }
    }
    const f32x4 z4 = {0.f, 0.f, 0.f, 0.f};
    f32x4 S[4] = {z4, z4, z4, z4};
    sh4 Lf;
#pragma unroll
    for (int j = 0; j < 4; ++j) Lf[j] = (fq * 4 + j <= fr) ? (short)0x3F80 : (short)0;
    bf16_t* Pr = (bf16_t*)(WS(p) + OFF_PR);
    bf16_t* vfirst = (bf16_t*)(WS(p) + OFF_VFIRST);
    const unsigned char* psrc[5]; int pstep[5], ptau[5]; bool pval[5];
#pragma unroll
    for (int k = 0; k < 5; ++k) {
        const int pi = tid + k * NTHR;
        bool ok = false;
        psrc[k] = scan_piece_src(p, l, b, hc, 0, pi < SC_TC * 68 ? pi : 0, ok);
        const int tau = (pi < SC_TC * 68 ? pi : 0) / 68, seg = (pi < SC_TC * 68 ? pi : 0) - tau * 68;
        ptau[k] = tau;
        pstep[k] = SC_TC * ((seg >= 24 && seg < 60) ? 576 : 2048);
        pval[k] = (pi < SC_TC * 68) && !(seg >= 60 && l == 0);
    }
    uint4 pre[5];
#pragma unroll
    for (int k = 0; k < 5; ++k) { pre[k] = make_uint4(0, 0, 0, 0); if (pval[k] && ptau[k] < TS) pre[k] = *(const uint4*)psrc[k]; }
    __syncthreads();
#pragma unroll 1
    for (int t0 = 0, ch = 0; t0 < TS; t0 += SC_TC, ++ch) {
        const int nval = (TS - t0 < SC_TC) ? (TS - t0) : SC_TC;
#pragma unroll
        for (int k = 0; k < 5; ++k) { const int pi = tid + k * NTHR; if (pi < SC_TC * 68) *(uint4*)(raw + pi * 16) = pre[k]; }
        lds_barrier();
#pragma unroll
        for (int k = 0; k < 5; ++k) {
            pre[k] = make_uint4(0, 0, 0, 0);
            if (pval[k] && t0 + SC_TC + ptau[k] < TS) pre[k] = *(const uint4*)(psrc[k] + (size_t)(ch + 1) * pstep[k]);
        }
        if (mm < 3 || l > 0) {
            const unsigned char* Ab = raw + ((mm == 0) ? 384 : (mm == 1) ? 512 : (mm == 2) ? 640 : 896);
            float* dst = (mm == 0) ? s_w : (mm == 1) ? s_a : (mm == 2) ? s_g : s_o;
#pragma unroll
            for (int m = 0; m < 2; ++m) {
                f32x4 acc0 = {0.f, 0.f, 0.f, 0.f}, acc1 = {0.f, 0.f, 0.f, 0.f};
#pragma unroll
                for (int ks = 0; ks < 4; ++ks) {
                    if (ks < nks) {
                        const bf16x8 a = *(const bf16x8*)(Ab + (m * 16 + fr) * SC_ROWB + ks * 64 + fq * 16);
                        acc0 = __builtin_amdgcn_mfma_f32_16x16x32_bf16(a, Bw[0][ks], acc0, 0, 0, 0);
                        acc1 = __builtin_amdgcn_mfma_f32_16x16x32_bf16(a, Bw[1][ks], acc1, 0, 0, 0);
                    }
                }
                if (mm == 0) {
                    const float cw0 = cst[480 + ntb * 16 + fr], cw1 = cst[480 + (ntb + 1) * 16 + fr];
                    f32x4 l0, l1, r0, r1;
#pragma unroll
                    for (int j = 0; j < 4; ++j) { l0[j] = -0.6065306597126334f * fast_sigmoid(acc0[j] + cw0); l1[j] = -0.6065306597126334f * fast_sigmoid(acc1[j] + cw1); }
                    const uint2 h0 = pack4(l0[0], l0[1], l0[2], l0[3]), h1 = pack4(l1[0], l1[1], l1[2], l1[3]);
                    r0[0] = l0[0] - __uint_as_float(h0.x << 16); r0[1] = l0[1] - __uint_as_float(h0.x & 0xFFFF0000u); r0[2] = l0[2] - __uint_as_float(h0.y << 16); r0[3] = l0[3] - __uint_as_float(h0.y & 0xFFFF0000u);
                    r1[0] = l1[0] - __uint_as_float(h1.x << 16); r1[1] = l1[1] - __uint_as_float(h1.x & 0xFFFF0000u); r1[2] = l1[2] - __uint_as_float(h1.y << 16); r1[3] = l1[3] - __uint_as_float(h1.y & 0xFFFF0000u);
                    sh4 hh0, hh1; __builtin_memcpy(&hh0, &h0, 8); __builtin_memcpy(&hh1, &h1, 8);
                    f32x4 c0 = MF16(Lf, pk4v(r0), z4), c1 = MF16(Lf, pk4v(r1), z4);
                    c0 = MF16(Lf, hh0, c0); c1 = MF16(Lf, hh1, c1);
#pragma unroll
                    for (int j = 0; j < 4; ++j) {
                        const int eo = (m * 16 + fq * 4 + j) * 64 + ntb * 16 + fr;
                        s_w[eo] = c0[j]; s_w[eo + 16] = c1[j];
                        s_b[eo] = l0[j]; s_b[eo + 16] = l1[j];
                    }
                } else {
#pragma unroll
                    for (int j = 0; j < 4; ++j) {
                        dst[(m * 16 + fq * 4 + j) * 64 + ntb * 16 + fr] = acc0[j];
                        dst[(m * 16 + fq * 4 + j) * 64 + (ntb + 1) * 16 + fr] = acc1[j];
                    }
                }
            }
        }
        lds_barrier();
        {
            const int tau = tid >> 4, c4 = (tid & 15) * 4, e = tau * 64 + c4, t = t0 + tau;
            const size_t n = (size_t)b * TS + t;
            const float4 cum4 = *(const float4*)(s_w + e), lw4 = *(const float4*)(s_b + e), xa4 = *(const float4*)(s_a + e);
            const float4 ca = *(const float4*)(cst + 544 + c4), ckk = *(const float4*)(cst + 608 + c4), cka = *(const float4*)(cst + 672 + c4), crk = *(const float4*)(cst + 736 + c4);
            const float cum[4] = {cum4.x, cum4.y, cum4.z, cum4.w}, lw[4] = {lw4.x, lw4.y, lw4.z, lw4.w};
            const float xa[4] = {xa4.x + ca.x, xa4.y + ca.y, xa4.z + ca.z, xa4.w + ca.w};
            const float kkc[4] = {ckk.x, ckk.y, ckk.z, ckk.w}, kac[4] = {cka.x, cka.y, cka.z, cka.w};
            float rr[4], kr[4], vv[4];
            {
                const unsigned char* rc = raw + tau * SC_ROWB + c4 * 2;
                const uint2 cr = *(const uint2*)rc, ck = *(const uint2*)(rc + 128), cv = *(const uint2*)(rc + 256);
                uint2 qr = make_uint2(0u, 0u), qk = qr, qv = qr;
                if (tau > 0) { qr = *(const uint2*)(rc - SC_ROWB); qk = *(const uint2*)(rc - SC_ROWB + 128); qv = *(const uint2*)(rc - SC_ROWB + 256); }
                else if (t0 > 0) { const unsigned* pvr = prevr + ((ch + 1) & 1) * 96 + (c4 >> 1); qr = *(const uint2*)pvr; qk = *(const uint2*)(pvr + 32); qv = *(const uint2*)(pvr + 64); }
                if (tau == SC_TC - 1) { unsigned* pwr = prevr + (ch & 1) * 96 + (c4 >> 1); *(uint2*)pwr = cr; *(uint2*)(pwr + 32) = ck; *(uint2*)(pwr + 64) = cv; }
                const float4 mr = *(const float4*)(cst + c4), mk = *(const float4*)(cst + 64 + c4), mv = *(const float4*)(cst + 128 + c4);
                const float c_[12] = {__uint_as_float(cr.x << 16), __uint_as_float(cr.x & 0xFFFF0000u), __uint_as_float(cr.y << 16), __uint_as_float(cr.y & 0xFFFF0000u),
                                      __uint_as_float(ck.x << 16), __uint_as_float(ck.x & 0xFFFF0000u), __uint_as_float(ck.y << 16), __uint_as_float(ck.y & 0xFFFF0000u),
                                      __uint_as_float(cv.x << 16), __uint_as_float(cv.x & 0xFFFF0000u), __uint_as_float(cv.y << 16), __uint_as_float(cv.y & 0xFFFF0000u)};
                const float q_[12] = {__uint_as_float(qr.x << 16), __uint_as_float(qr.x & 0xFFFF0000u), __uint_as_float(qr.y << 16), __uint_as_float(qr.y & 0xFFFF0000u),
                                      __uint_as_float(qk.x << 16), __uint_as_float(qk.x & 0xFFFF0000u), __uint_as_float(qk.y << 16), __uint_as_float(qk.y & 0xFFFF0000u),
                                      __uint_as_float(qv.x << 16), __uint_as_float(qv.x & 0xFFFF0000u), __uint_as_float(qv.y << 16), __uint_as_float(qv.y & 0xFFFF0000u)};
                const float m_[12] = {mr.x, mr.y, mr.z, mr.w, mk.x, mk.y, mk.z, mk.w, mv.x, mv.y, mv.z, mv.w};
#pragma unroll
                for (int j = 0; j < 4; ++j) { rr[j] = c_[j] + (q_[j] - c_[j]) * m_[j]; kr[j] = c_[4 + j] + (q_[4 + j] - c_[4 + j]) * m_[4 + j]; vv[j] = c_[8 + j] + (q_[8 + j] - c_[8 + j]) * m_[8 + j]; }
            }
            if (l > 0) {
                const float4 xv4 = *(const float4*)(s_o + e), cv = *(const float4*)(cst + 928 + c4);
                const uint2 vfu = *(const uint2*)(raw + tau * SC_ROWB + 960 + c4 * 2);
                const float vf[4] = {__uint_as_float(vfu.x << 16), __uint_as_float(vfu.x & 0xFFFF0000u), __uint_as_float(vfu.y << 16), __uint_as_float(vfu.y & 0xFFFF0000u)};
                const float xv[4] = {xv4.x + cv.x, xv4.y + cv.y, xv4.z + cv.z, xv4.w + cv.w};
#pragma unroll
                for (int j = 0; j < 4; ++j) vv[j] = vv[j] + (vf[j] - vv[j]) * fast_sigmoid(xv[j]);
            } else if (t < TS) {
                *(uint2*)(vfirst + n * 1024 + hc + c4) = pack4(vv[0], vv[1], vv[2], vv[3]);
            }
            float av[4], kkv[4], ginc[4], gexc[4], ginv[4]; float ss = 0.f;
#pragma unroll
            for (int j = 0; j < 4; ++j) {
                ginc[j] = __expf(cum[j]); gexc[j] = __expf(cum[j] - lw[j]); ginv[j] = __expf(-cum[j]);
                av[j] = fast_sigmoid(xa[j]);
                kkv[j] = kr[j] * kkc[j];
                ss += kkv[j] * kkv[j];
            }
            float kk[4], kt[4];
#pragma unroll
            for (int j = 0; j < 4; ++j) kt[j] = kr[j] * (1.0f + (av[j] - 1.0f) * kac[j]);
            float bsum = rr[0] * kt[0] * crk.x + rr[1] * kt[1] * crk.y + rr[2] * kt[2] * crk.z + rr[3] * kt[3] * crk.w;
            float du0 = 0.f, du1 = 0.f;
            row16_sum4(ss, bsum, du0, du1);
            if ((tid & 15) == 0) s_bs[tau] = bsum;
            const float rn = rsqrtf(fmaxf(ss, 1e-24f));
#pragma unroll
            for (int j = 0; j < 4; ++j) kk[j] = kkv[j] * rn;
            const uint2 pa = pack4(-kk[0] * gexc[0], -kk[1] * gexc[1], -kk[2] * gexc[2], -kk[3] * gexc[3]);
            const uint2 pr = pack4(rr[0] * ginc[0], rr[1] * ginc[1], rr[2] * ginc[2], rr[3] * ginc[3]);
            const uint2 pb = pack4(kk[0] * av[0] * ginv[0], kk[1] * av[1] * ginv[1], kk[2] * av[2] * ginv[2], kk[3] * av[3] * ginv[3]);
            const uint2 pk = pack4(kt[0] * ginv[0], kt[1] * ginv[1], kt[2] * ginv[2], kt[3] * ginv[3]);
            const uint2 pv = pack4(vv[0], vv[1], vv[2], vv[3]);
            *(uint2*)(o_at + tau * SC_LT + c4) = pa;
            *(uint2*)(o_rt + tau * SC_LT + c4) = pr;
            *(uint2*)(o_bt + tau * SC_LT + c4) = pb;
            *(uint2*)(o_kt + tau * SC_LT + c4) = pk;
            o_bT[(c4 + 0) * SC_LS + tau] = (bf16_t)(pb.x & 0xFFFFu); o_bT[(c4 + 1) * SC_LS + tau] = (bf16_t)(pb.x >> 16); o_bT[(c4 + 2) * SC_LS + tau] = (bf16_t)(pb.y & 0xFFFFu); o_bT[(c4 + 3) * SC_LS + tau] = (bf16_t)(pb.y >> 16);
            o_kT[(c4 + 0) * SC_LS + tau] = (bf16_t)(pk.x & 0xFFFFu); o_kT[(c4 + 1) * SC_LS + tau] = (bf16_t)(pk.x >> 16); o_kT[(c4 + 2) * SC_LS + tau] = (bf16_t)(pk.y & 0xFFFFu); o_kT[(c4 + 3) * SC_LS + tau] = (bf16_t)(pk.y >> 16);
            o_vT[(c4 + 0) * SC_LS + tau] = (bf16_t)(pv.x & 0xFFFFu); o_vT[(c4 + 1) * SC_LS + tau] = (bf16_t)(pv.x >> 16); o_vT[(c4 + 2) * SC_LS + tau] = (bf16_t)(pv.y & 0xFFFFu); o_vT[(c4 + 3) * SC_LS + tau] = (bf16_t)(pv.y >> 16);
            if ((tau & 15) == 15) *(float4*)(s_gc + (tau >> 4) * 64 + c4) = make_float4(ginc[0], ginc[1], ginc[2], ginc[3]);
            *(float4*)(s_v + e) = make_float4(vv[0], vv[1], vv[2], vv[3]);
        }
        lds_barrier();
        if (wid < 4) {
#pragma unroll 1
            for (int sc = 0; sc < 2; ++sc) {
                if (sc * 16 < nval) {
                    const bf16_t* ar = o_at + (sc * 16 + fr) * SC_LT;
                    const bf16_t* rr_ = o_rt + (sc * 16 + fr) * SC_LT;
                    const bf16_t* br = o_bt + (sc * 16 + fr) * SC_LT;
                    const bf16_t* kr_ = o_kt + (sc * 16 + fr) * SC_LT;
                    const bf16x8 fa0 = *(const bf16x8*)(ar + fq * 8), fa1 = *(const bf16x8*)(ar + 32 + fq * 8);
                    const bf16x8 fb0 = *(const bf16x8*)(br + fq * 8), fb1 = *(const bf16x8*)(br + 32 + fq * 8);
                    const bf16x8 fk0 = *(const bf16x8*)(kr_ + fq * 8), fk1 = *(const bf16x8*)(kr_ + 32 + fq * 8);
                    const bf16x8 fr0 = *(const bf16x8*)(rr_ + fq * 8), fr1 = *(const bf16x8*)(rr_ + 32 + fq * 8);
                    f32x4 nA = MF32(fb0, fa0, z4); nA = MF32(fb1, fa1, nA);
                    f32x4 nB = MF32(fa0, fb0, z4); nB = MF32(fa1, fb1, nB);
                    f32x4 mak = MF32(fk0, fa0, z4); mak = MF32(fk1, fa1, mak);
                    f32x4 mbr = MF32(fb0, fr0, z4); mbr = MF32(fb1, fr1, mbr);
                    f32x4 mkr = MF32(fk0, fr0, z4); mkr = MF32(fk1, fr1, mkr);
#pragma unroll
                    for (int j = 0; j < 4; ++j) {
                        const int s_ = fq * 4 + j;
                        nA[j] = (s_ < fr) ? nA[j] : 0.f; nB[j] = (fr < s_) ? nB[j] : 0.f; mak[j] = (s_ < fr) ? mak[j] : 0.f;
                        mbr[j] = (s_ <= fr) ? mbr[j] : 0.f; mkr[j] = (s_ <= fr) ? mkr[j] : 0.f;
                    }
                    const sh4 pNA = pk4v(nA), pNB = pk4v(nB), pMak = pk4v(mak), pMbr = pk4v(mbr), pMkr = pk4v(mkr);
                    const f32x4 n2B = MF16(pNA, pNB, z4), n2A = MF16(pNB, pNA, z4);
                    const sh4 pN2A = pk4v(n2A), pN2B = pk4v(n2B);
                    const f32x4 n4B = MF16(pN2A, pN2B, z4), n4A = MF16(pN2B, pN2A, z4);
                    const sh4 pN4A = pk4v(n4A), pN4B = pk4v(n4B);
                    const sh4 pN8A = pk4v(MF16(pN4B, pN4A, z4));
                    const bf16x8 sB0 = cat8(pk4v(S[0]), pk4v(S[1])), sB1 = cat8(pk4v(S[2]), pk4v(S[3]));
                    const sh4 vf = *(const sh4*)(o_vT + (wid * 16 + fr) * SC_LS + sc * 16 + fq * 4);
                    f32x4 X = MF32(cat8(*(const sh4*)(ar + fq * 4), *(const sh4*)(ar + 16 + fq * 4)), sB0, z4);
                    X = MF32(cat8(*(const sh4*)(ar + 32 + fq * 4), *(const sh4*)(ar + 48 + fq * 4)), sB1, X);
                    X = MF16(pMak, vf, X);
                    X = MF16(pN8A, pk4v(X), X); X = MF16(pN4A, pk4v(X), X); X = MF16(pN2A, pk4v(X), X); X = MF16(pNA, pk4v(X), X);
                    const sh4 pSA = pk4v(X);
                    f32x4 O = MF32(cat8(*(const sh4*)(rr_ + fq * 4), *(const sh4*)(rr_ + 16 + fq * 4)), sB0, z4);
                    O = MF32(cat8(*(const sh4*)(rr_ + 32 + fq * 4), *(const sh4*)(rr_ + 48 + fq * 4)), sB1, O);
                    const bf16x8 sav = cat8(pSA, vf);
                    O = MF32(cat8(pMbr, pMkr), sav, O);
#pragma unroll
                    for (int j = 0; j < 4; ++j) s_o[(sc * 16 + fq * 4 + j) * 64 + wid * 16 + fr] = O[j];
#pragma unroll
                    for (int jt = 0; jt < 4; ++jt) {
                        const sh4 ka = *(const sh4*)(o_kT + (jt * 16 + fr) * SC_LS + sc * 16 + fq * 4), ba = *(const sh4*)(o_bT + (jt * 16 + fr) * SC_LS + sc * 16 + fq * 4);
                        f32x4 acc = MF32(cat8(ba, ka), sav, S[jt]);
                        const float4 g4 = *(const float4*)(s_gc + sc * 64 + jt * 16 + fq * 4);
                        acc[0] *= g4.x; acc[1] *= g4.y; acc[2] *= g4.z; acc[3] *= g4.w;
                        S[jt] = acc;
                    }
                }
            }
        }
        lds_barrier();
        {
            const int tau = tid >> 4, c4 = (tid & 15) * 4, e = tau * 64 + c4;
            const size_t n = (size_t)b * TS + t0 + tau;
            const float4 o4 = *(const float4*)(s_o + e), v4_ = *(const float4*)(s_v + e), g4_ = *(const float4*)(s_g + e);
            const float4 clw = *(const float4*)(cst + 800 + c4), clb = *(const float4*)(cst + 864 + c4);
            const float bsum = s_bs[tau];
            const float m_ = row16_sum((o4.x + o4.y) + (o4.z + o4.w)) * (1.0f / 64.0f);
            const float d0 = o4.x - m_, d1 = o4.y - m_, d2 = o4.z - m_, d3 = o4.w - m_;
            const float var = row16_sum(d0 * d0 + d1 * d1 + d2 * d2 + d3 * d3) * (1.0f / 64.0f);
            const float rs = rsqrtf(var + 64e-5f);
            const float y0 = (d0 * rs * clw.x + clb.x + bsum * v4_.x) * g4_.x, y1 = (d1 * rs * clw.y + clb.y + bsum * v4_.y) * g4_.y;
            const float y2 = (d2 * rs * clw.z + clb.z + bsum * v4_.z) * g4_.z, y3 = (d3 * rs * clw.w + clb.w + bsum * v4_.w) * g4_.w;
            if (tau < nval) *(uint2*)(Pr + n * 1024 + hc + c4) = pack4(y0, y1, y2, y3);
        }
    }
}

__device__ __forceinline__ void xcd_panel_map(int& mt0, int& mstep, int& nt) {
    const int b = obid(), G = (int)gridDim.x;
    if (G == 256) { nt = (b >> 3) & 7; mt0 = (b & 7) * 4 + (b >> 6); mstep = 32; }
    else { nt = b & 7; mt0 = b >> 3; mstep = G >> 3; }
}
__device__ void phase_merge(const Params& p, unsigned char* lds) {
    const int tid = otid(), lane = tid & 63, wid = tid >> 6, wr = wid >> 1, wc = wid & 1, fr = lane & 15, fq = lane >> 4;
    const bf16_t* h = (const bf16_t*)(WS(p) + OFF_H);
    const bf16_t* wb = (const bf16_t*)(WS(p) + OFF_WB);
    const float* rstd = (const float*)(WS(p) + OFF_RSTD);
    bf16_t* merged = (bf16_t*)(WS(p) + OFF_MERGED);
    const bf16_t* ysrc0 = (const bf16_t*)(WS(p) + OFF_PPOOL);
    const bf16_t* ysrc1 = (const bf16_t*)(WS(p) + OFF_PR);
    const bf16_t* ysrc2 = (const bf16_t*)(OUTB(p) + DO_YC);
    for (int tile = obid(); tile < 86 * 8; tile += gridDim.x) {
        const int mt = tile >> 3, nt = tile & 7;
        const int row0 = mt * 192, col0 = nt * 128;
        uint2 maccp[3][4];
#pragma unroll
        for (int m = 0; m < 3; ++m)
#pragma unroll
            for (int n = 0; n < 4; ++n) maccp[m][n] = make_uint2(0u, 0u);
#pragma unroll 1
        for (int i = 0; i < 3; ++i) {
            const int tid = otid();
            const bf16_t* ys = (i == 0) ? ysrc0 : (i == 1 ? ysrc1 : ysrc2);
            uint2 sg[3][4];
            {
                f32x4 ag[3][4]; g3_zero<3>(ag);
                G3<192> g;
                g3_setup<192>(g, [&](int r) { return h + (size_t)(row0 + r) * DM; }, [&](int r) { return wb + WB_WG + (size_t)(i * 1024 + col0 + r) * DM; }, tid);
                g3_kloop<192>(ag, g, DM, lds);
#pragma unroll
                for (int m = 0; m < 3; ++m) {
                    const float rs = rstd[row0 + wr * 48 + m * 16 + fr];
#pragma unroll
                    for (int n = 0; n < 4; ++n) sg[m][n] = pack4(fast_sigmoid(ag[m][n][0] * rs), fast_sigmoid(ag[m][n][1] * rs), fast_sigmoid(ag[m][n][2] * rs), fast_sigmoid(ag[m][n][3] * rs));
                }
            }
            {
                f32x4 ay[3][4]; g3_zero<3>(ay);
                G3<192> g;
                g3_setup<192>(g, [&](int r) { return ys + (size_t)(row0 + r) * DM; }, [&](int r) { return wb + WB_PA + (size_t)(i * 1024 + col0 + r) * DM; }, tid);
                g3_kloop<192>(ay, g, DM, lds);
#pragma unroll
                for (int m = 0; m < 3; ++m)
#pragma unroll
                    for (int n = 0; n < 4; ++n) {
                        const float m0 = __uint_as_float(maccp[m][n].x << 16) + __uint_as_float(sg[m][n].x << 16) * ay[m][n][0];
                        const float m1 = __uint_as_float(maccp[m][n].x & 0xFFFF0000u) + __uint_as_float(sg[m][n].x & 0xFFFF0000u) * ay[m][n][1];
                        const float m2 = __uint_as_float(maccp[m][n].y << 16) + __uint_as_float(sg[m][n].y << 16) * ay[m][n][2];
                        const float m3 = __uint_as_float(maccp[m][n].y & 0xFFFF0000u) + __uint_as_float(sg[m][n].y & 0xFFFF0000u) * ay[m][n][3];
                        maccp[m][n] = pack4(m0, m1, m2, m3);
                    }
            }
        }
#pragma unroll
        for (int m = 0; m < 3; ++m) {
            const int row = row0 + wr * 48 + m * 16 + fr;
#pragma unroll
            for (int n = 0; n < 4; ++n)
                *(uint2*)(merged + (size_t)row * 1024 + col0 + wc * 64 + n * 16 + fq * 4) = maccp[m][n];
        }
    }
}

__device__ void phase_outproj(const Params& p, unsigned char* lds) {
    const int tid = otid(), lane = tid & 63, wid = tid >> 6, wr = wid >> 1, wc = wid & 1, fr = lane & 15, fq = lane >> 4;
    const bf16_t* h = (const bf16_t*)(WS(p) + OFF_H);
    const bf16_t* wb = (const bf16_t*)(WS(p) + OFF_WB);
    const bf16_t* merged = (const bf16_t*)(WS(p) + OFF_MERGED);
    float* hm = (float*)(WS(p) + OFF_HM32);
    int mt0, mstep, nt;
    xcd_panel_map(mt0, mstep, nt);
    for (int mt = mt0; mt < 86; mt += mstep) {
        const int row0 = mt * 192, col0 = nt * 128;
        G3<192> g;
        g3_setup<192>(g, [&](int r) { return merged + (size_t)(row0 + r) * DM; }, [&](int r) { return wb + WB_WO + (size_t)(col0 + r) * DM; }, tid);
        f32x4 acc[3][4]; g3_zero<3>(acc);
        g3_kloop<192>(acc, g, DM, lds);
#pragma unroll
        for (int m = 0; m < 3; ++m) {
            const int row = row0 + wr * 48 + m * 16 + fr;
#pragma unroll
            for (int n = 0; n < 4; ++n) {
                const int col = col0 + wc * 64 + n * 16 + fq * 4;
                const uint2 hv = *(const uint2*)(h + (size_t)row * 1024 + col);
                float4 o;
                o.x = __uint_as_float(hv.x << 16) + acc[m][n][0]; o.y = __uint_as_float(hv.x & 0xFFFF0000u) + acc[m][n][1];
                o.z = __uint_as_float(hv.y << 16) + acc[m][n][2]; o.w = __uint_as_float(hv.y & 0xFFFF0000u) + acc[m][n][3];
                *(float4*)(hm + (size_t)row * 1024 + col) = o;
            }
        }
    }
}

__device__ __constant__ int c_pair_lo[6] = {0, 0, 0, 1, 1, 2};
__device__ __constant__ int c_pair_hi[6] = {1, 2, 3, 2, 3, 3};
__device__ void phase_route(const Params& p, int l, unsigned char* lds) {
    const int tid = otid(), lane = tid & 63, wid = tid >> 6;
    const int per = (NT + (int)gridDim.x - 1) / (int)gridDim.x;
    const int nbeg = obid() * per, nend = (nbeg + per < NT) ? nbeg + per : NT;
    int* s_cls = (int*)lds;
    int* s_base = s_cls + 512;
    float* s_wr = (float*)(lds + 4096);
    const float* hm = (const float*)(WS(p) + OFF_HM32);
    bf16_t* hn = (bf16_t*)(WS(p) + OFF_HN);
    const float* nf = p.in[33] + (size_t)l * 1024;
    const float* wg = p.in[34] + (size_t)l * 1024 * 4;
    const float* bg = p.in[35] + l * 4;
    const float* we = p.in[36] + (size_t)l * 1024 * 16;
    const float* be = p.in[37] + l * 16;
    int* cnt = (int*)(WS(p) + OFF_CTL);
    int* list = (int*)(WS(p) + OFF_LIST);
    float* pw = (float*)(WS(p) + OFF_PW);
    for (int e = tid; e < 1024 * 20; e += NTHR) {
        const int k = e / 20, c = e - k * 20;
        s_wr[c * 1024 + k] = (c < 4) ? wg[(size_t)k * 4 + c] : we[(size_t)k * 16 + (c - 4)];
    }
    __syncthreads();
    float4 nv[4], cur[4];
#pragma unroll
    for (int i = 0; i < 4; ++i) nv[i] = *(const float4*)(nf + i * 256 + lane * 4);
    if (nbeg + wid < nend) {
#pragma unroll
        for (int i = 0; i < 4; ++i) cur[i] = *(const float4*)(hm + (size_t)(nbeg + wid) * DM + i * 256 + lane * 4);
    }
    for (int n = nbeg + wid; n < nend; n += 8) {
        float4 xv[4]; float ss = 0.f;
#pragma unroll
        for (int i = 0; i < 4; ++i) { xv[i] = cur[i]; ss += xv[i].x * xv[i].x + xv[i].y * xv[i].y + xv[i].z * xv[i].z + xv[i].w * xv[i].w; }
        if (n + 8 < nend) {
#pragma unroll
            for (int i = 0; i < 4; ++i) cur[i] = *(const float4*)(hm + (size_t)(n + 8) * DM + i * 256 + lane * 4);
        }
        ss = wave_sum(ss);
        const float rs = rsqrtf(ss * (1.0f / 1024.0f) + 1e-6f);
        float lg[4] = {0.f, 0.f, 0.f, 0.f};
        float le[16];
#pragma unroll
        for (int e = 0; e < 16; ++e) le[e] = 0.f;
#pragma unroll
        for (int i = 0; i < 4; ++i) {
            float y[4] = {xv[i].x * rs * nv[i].x, xv[i].y * rs * nv[i].y, xv[i].z * rs * nv[i].z, xv[i].w * rs * nv[i].w};
            {
                const int d0 = i * 256 + lane * 4;
#pragma unroll
                for (int g = 0; g < 4; ++g) { const float4 w4 = *(const float4*)(s_wr + g * 1024 + d0); lg[g] += y[0] * w4.x + y[1] * w4.y + y[2] * w4.z + y[3] * w4.w; }
#pragma unroll
                for (int e = 0; e < 16; ++e) { const float4 w4 = *(const float4*)(s_wr + (4 + e) * 1024 + d0); le[e] += y[0] * w4.x + y[1] * w4.y + y[2] * w4.z + y[3] * w4.w; }
            }
            *(uint2*)(hn + (size_t)n * DM + i * 256 + lane * 4) = pack4(y[0], y[1], y[2], y[3]);
        }
#pragma unroll
        for (int g = 0; g < 4; ++g) lg[g] = wave_sum_fast(lg[g]) + bg[g];
#pragma unroll
        for (int e = 0; e < 16; ++e) le[e] = wave_sum_fast(le[e]) + be[e];
        if (lane == 0) {
            int gs = 0; float gm = lg[0];
#pragma unroll
            for (int g = 1; g < 4; ++g) if (lg[g] > gm) { gm = lg[g]; gs = g; }
            float den = 0.f;
#pragma unroll
            for (int g = 0; g < 4; ++g) den += __expf(lg[g] - gm);
            const float pgrp = 1.0f / den;
            float v4[4];
#pragma unroll
            for (int e = 0; e < 4; ++e) {
                const float m0 = (gs == 0) ? 1.f : 0.f, m1s = (gs == 1) ? 1.f : 0.f, m2s = (gs == 2) ? 1.f : 0.f, m3s = (gs == 3) ? 1.f : 0.f;
                v4[e] = le[e] * m0 + le[4 + e] * m1s + le[8 + e] * m2s + le[12 + e] * m3s;
            }
            int i1 = 0; float m1 = v4[0];
#pragma unroll
            for (int e = 1; e < 4; ++e) if (v4[e] > m1) { m1 = v4[e]; i1 = e; }
            int i2 = -1; float m2 = -INFINITY;
#pragma unroll
            for (int e = 0; e < 4; ++e) if (e != i1 && v4[e] > m2) { m2 = v4[e]; i2 = e; }
            const float e2 = __expf(m2 - m1);
            const float p1 = pgrp / (1.0f + e2), p2 = pgrp * e2 / (1.0f + e2);
            const int lo = i1 < i2 ? i1 : i2, hi = i1 < i2 ? i2 : i1;
            const float plo = i1 < i2 ? p1 : p2, phi = i1 < i2 ? p2 : p1;
            const int pi = (lo == 0) ? (hi - 1) : (lo == 1 ? hi + 1 : 5);
            const int cls = gs * 6 + pi;
            s_cls[n - nbeg] = cls;
            pw[(size_t)n * 2 + 0] = plo; pw[(size_t)n * 2 + 1] = phi;
        }
    }
    __syncthreads();
    const int nloc = nend - nbeg;
    if (tid < 24) {
        int c_ = 0;
        for (int i = 0; i < nloc; ++i) c_ += (s_cls[i] == tid) ? 1 : 0;
        s_base[tid] = c_ ? atomicAdd(&cnt[tid * 32], c_) : 0;
    }
    __syncthreads();
    for (int it = tid; it < nloc; it += NTHR) {
        const int cls = s_cls[it];
        int rank = 0;
        for (int i = 0; i < it; ++i) rank += (s_cls[i] == cls) ? 1 : 0;
        list[(size_t)cls * NT + s_base[cls] + rank] = nbeg + it;
    }
    __syncthreads();
}


struct MoeTile { int cls, ti, cnt, tg; };
__device__ __forceinline__ int moe_total_tiles(const int* cnt) { int s = 0; for (int c = 0; c < 24; ++c) s += (cnt[c * 32] + 127) >> 7; return s; }
__device__ __forceinline__ MoeTile moe_find(const int* cnt, int tile) {
    MoeTile r; int s = 0; r.cls = 0; r.ti = 0; r.cnt = 0; r.tg = tile;
    for (int c = 0; c < 24; ++c) { const int nt = (cnt[c * 32] + 127) >> 7; if (tile >= s && tile < s + nt) { r.cls = c; r.ti = tile - s; r.cnt = cnt[c * 32]; } s += nt; }
    return r;
}
__device__ void phase_moe1(const Params& p, unsigned char* lds) {
    const int tid = otid(), lane = tid & 63, wid = tid >> 6, wr = wid >> 1, wc = wid & 1, fr = lane & 15, fq = lane >> 4;
    const int* cnt = (const int*)(WS(p) + OFF_CTL);
    const int* list = (const int*)(WS(p) + OFF_LIST);
    const float* pw = (const float*)(WS(p) + OFF_PW);
    const bf16_t* hn = (const bf16_t*)(WS(p) + OFF_HN);
    const bf16_t* we = (const bf16_t*)(WS(p) + OFF_WEXP);
    bf16_t* hid = (bf16_t*)(OUTB(p) + DO_HID);
    const int total = moe_total_tiles(cnt);
    for (int item = obid(); item < total * 4; item += gridDim.x) {
        const MoeTile mt = moe_find(cnt, item >> 2);
        const int nt = item & 3, slot = nt >> 1, f0 = (nt & 1) * 128;
        const int g_ = mt.cls / 6, pi = mt.cls % 6;
        const int e = g_ * 4 + (slot == 0 ? c_pair_lo[pi] : c_pair_hi[pi]);
        const int* lst = list + (size_t)mt.cls * NT + mt.ti * 128;
        const int nvalid = min(128, mt.cnt - mt.ti * 128);
        f32x4 a1[2][4], a3[2][4]; g3_zero<2>(a1); g3_zero<2>(a3);
        G3D g;
#pragma unroll
        for (int i = 0; i < 2; ++i) {
            const int idx = tid + i * NTHR, row = idx >> 3, sl = (idx & 7) ^ (row & 7);
            g.ap[i] = hn + (size_t)lst[row < nvalid ? row : 0] * DM + sl * 8;
            g.b1[i] = we + WE_W1 + ((size_t)e * 256 + f0 + row) * 1024 + sl * 8;
            g.b3[i] = we + WE_W3 + ((size_t)e * 256 + f0 + row) * 1024 + sl * 8;
        }
        g3d_kloop(a1, a3, g, DM, lds);
#pragma unroll
        for (int m = 0; m < 2; ++m) {
            const int lr = wr * 32 + m * 16 + fr;
            const int tk = lst[lr < nvalid ? lr : 0];
            const float pe = pw[(size_t)tk * 2 + slot];
#pragma unroll
            for (int n = 0; n < 4; ++n) {
                const int col = slot * 256 + f0 + wc * 64 + n * 16 + fq * 4;
                float o[4];
#pragma unroll
                for (int j = 0; j < 4; ++j) { const float x1 = a1[m][n][j]; o[j] = x1 * sigmoidf_(x1) * a3[m][n][j] * pe; }
                *(uint2*)(hid + ((size_t)mt.tg * 128 + lr) * 512 + col) = pack4(o[0], o[1], o[2], o[3]);
            }
        }
    }
}
__device__ void phase_moe2(const Params& p, unsigned char* lds) {
    const int tid = otid(), lane = tid & 63, wid = tid >> 6, wr = wid >> 1, wc = wid & 1, fr = lane & 15, fq = lane >> 4;
    const int* cnt = (const int*)(WS(p) + OFF_CTL);
    const int* list = (const int*)(WS(p) + OFF_LIST);
    const bf16_t* we = (const bf16_t*)(WS(p) + OFF_WEXP);
    const bf16_t* hid = (const bf16_t*)(OUTB(p) + DO_HID);
    float* hm = (float*)(WS(p) + OFF_HM32);
    bf16_t* h = (bf16_t*)(WS(p) + OFF_H);
    const int total = moe_total_tiles(cnt);
    for (int item = obid(); item < total * 8; item += gridDim.x) {
        const MoeTile mt = moe_find(cnt, item >> 3);
        const int nt = item & 7, col0 = nt * 128;
        const int g_ = mt.cls / 6, pi = mt.cls % 6;
        const int elo = g_ * 4 + c_pair_lo[pi], ehi = g_ * 4 + c_pair_hi[pi];
        const int* lst = list + (size_t)mt.cls * NT + mt.ti * 128;
        const int nvalid = min(128, mt.cnt - mt.ti * 128);
        f32x4 acc[2][4]; g3_zero<2>(acc);
        G3<128> g;
        g3_setup<128>(g, [&](int r) { return hid + ((size_t)mt.tg * 128 + r) * 512; }, [&](int r) { return we + WE_W2 + ((size_t)elo * 1024 + col0 + r) * 256; }, tid);
        g3_kloop<128>(acc, g, 256, lds);
        g3_setup<128>(g, [&](int r) { return hid + ((size_t)mt.tg * 128 + r) * 512 + 256; }, [&](int r) { return we + WE_W2 + ((size_t)ehi * 1024 + col0 + r) * 256; }, tid);
        g3_kloop<128>(acc, g, 256, lds);
#pragma unroll
        for (int m = 0; m < 2; ++m) {
            const int lr = wr * 32 + m * 16 + fr;
            if (lr < nvalid) {
                const int tk = lst[lr];
#pragma unroll
                for (int n = 0; n < 4; ++n) {
                    const int col = col0 + wc * 64 + n * 16 + fq * 4;
                    float4 v = *(const float4*)(hm + (size_t)tk * 1024 + col);
                    v.x += acc[m][n][0]; v.y += acc[m][n][1]; v.z += acc[m][n][2]; v.w += acc[m][n][3];
                    *(float4*)(hm + (size_t)tk * 1024 + col) = v;
                    *(uint2*)(h + (size_t)tk * 1024 + col) = pack4(v.x, v.y, v.z, v.w);
                }
            }
        }
    }
}

__device__ void phase_final(const Params& p) {
    const int lane = otid() & 63;
    const int wave = (obid() * NTHR + otid()) >> 6, nw = gridDim.x * NTHR / 64;
    const float* hm = (const float*)(WS(p) + OFF_HM32);
    const float* nf = p.in[41];
    float4 g[4], cur[4];
#pragma unroll
    for (int i = 0; i < 4; ++i) g[i] = *(const float4*)(nf + i * 256 + lane * 4);
    auto rowp = [&](int r) { const int b = r / SEQ, s_ = r % SEQ; return hm + ((size_t)b * TS + NMETA + s_) * DM; };
    if (wave < NB * SEQ) {
        const float* src = rowp(wave);
#pragma unroll
        for (int i = 0; i < 4; ++i) cur[i] = *(const float4*)(src + i * 256 + lane * 4);
    }
    for (int r = wave; r < NB * SEQ; r += nw) {
        float4 v[4]; float ss = 0.f;
#pragma unroll
        for (int i = 0; i < 4; ++i) { v[i] = cur[i]; ss += v[i].x * v[i].x + v[i].y * v[i].y + v[i].z * v[i].z + v[i].w * v[i].w; }
        if (r + nw < NB * SEQ) {
            const float* src = rowp(r + nw);
#pragma unroll
            for (int i = 0; i < 4; ++i) cur[i] = *(const float4*)(src + i * 256 + lane * 4);
        }
        ss = wave_sum(ss);
        const float rs = rsqrtf(ss * (1.0f / 1024.0f) + 1e-6f);
#pragma unroll
        for (int i = 0; i < 4; ++i) {
            float4 o; o.x = v[i].x * rs * g[i].x; o.y = v[i].y * rs * g[i].y; o.z = v[i].z * rs * g[i].z; o.w = v[i].w * rs * g[i].w;
            *(float4*)((float*)OUTB(p) + (size_t)r * DM + i * 256 + lane * 4) = o;
        }
    }
}


#define XB_TMO      128
#define XB_XCNT(j)  (256  + 64 * (j))
#define XB_XSUB(j)  (1280 + 64 * (j))
#define XB_XGEN(j)  (2304 + 64 * (j))
#define XB_TOP      3328
#define XB_TOPGEN   3392
#define XCD_BAR_WORDS 3456
#define XB_SPIN_CAP (1u << 22)
#define LAS __attribute__((address_space(3)))
__device__ __forceinline__ unsigned xb_ld(unsigned* p) { return __hip_atomic_load(p, __ATOMIC_RELAXED, __HIP_MEMORY_SCOPE_AGENT); }
__device__ __forceinline__ unsigned xb_add(unsigned* p, unsigned v) { return __hip_atomic_fetch_add(p, v, __ATOMIC_RELAXED, __HIP_MEMORY_SCOPE_AGENT); }
__device__ __forceinline__ unsigned xb_xcc_id() { return (unsigned)__builtin_amdgcn_s_getreg((3 << 11) | 20) & 0xFu; }
#define XB_SPIN(cond, bar) do { unsigned _sp = 0; while (cond) { __builtin_amdgcn_s_sleep(1); \
    if ((++_sp & 255u) == 0u) { if (xb_ld(&(bar)[XB_TMO])) break; if (_sp > XB_SPIN_CAP) { atomicAdd(&(bar)[XB_TMO], 1u); break; } } } } while (0)
struct XcdBarrier { unsigned* bar; unsigned x; volatile LAS unsigned* st; };
__device__ __forceinline__ XcdBarrier xcd_barrier_post(unsigned* bar, volatile LAS unsigned* st) {
    XcdBarrier b; b.bar = bar; b.x = xb_xcc_id(); b.st = st;
    if (threadIdx.x == 0) (void)xb_add(&bar[XB_XCNT(b.x)], 1u);
    return b;
}
__device__ __forceinline__ void xcd_barrier_complete(unsigned* bar, unsigned x, unsigned& nloc, unsigned& nx) {
    const unsigned G = gridDim.x * gridDim.y * gridDim.z;
    unsigned sum, cnt, mine, sp = 0u;
    for (;;) {
        sum = 0u; cnt = 0u; mine = 0u;
#pragma unroll
        for (unsigned j = 0; j < 16; ++j) { const unsigned c = xb_ld(&bar[XB_XCNT(j)]); sum += c; cnt += (c > 0u) ? 1u : 0u; mine = (j == x) ? c : mine; }
        if (sum == G) break;
        __builtin_amdgcn_s_sleep(1);
        if ((++sp & 255u) == 0u) { if (xb_ld(&bar[XB_TMO])) break; if (sp > XB_SPIN_CAP) { atomicAdd(&bar[XB_TMO], 1u); break; } }
    }
    nloc = mine > 0u ? mine : 1u; nx = cnt > 0u ? cnt : 1u;
}
__device__ __forceinline__ void xcd_barrier(const XcdBarrier& b) {
    asm volatile("s_waitcnt vmcnt(0)" ::: "memory");
    __syncthreads();
    if (threadIdx.x == 0) {
        unsigned* bar = b.bar;
        __builtin_amdgcn_s_waitcnt(0);
        unsigned nloc = b.st[0], nx = b.st[1];
        if (nloc == 0u) { xcd_barrier_complete(bar, b.x, nloc, nx); b.st[0] = nloc; b.st[1] = nx; }
        const unsigned old = xb_add(&bar[XB_XSUB(b.x)], 1u);
        const unsigned gen = old / nloc;
        if (old + 1u == (gen + 1u) * nloc) {
            __builtin_amdgcn_fence(__ATOMIC_RELEASE, "agent");
            asm volatile("s_waitcnt vmcnt(0)" ::: "memory");
            const unsigned og = xb_add(&bar[XB_TOP], 1u);
            const unsigned tg = og / nx;
            if (og + 1u == (tg + 1u) * nx) xb_add(&bar[XB_TOPGEN], 1u);
            else XB_SPIN(xb_ld(&bar[XB_TOPGEN]) == tg, bar);
            __builtin_amdgcn_fence(__ATOMIC_ACQUIRE, "agent");
            xb_add(&bar[XB_XGEN(b.x)], 1u);
            asm volatile("s_waitcnt vmcnt(0)" ::: "memory");
        } else {
            XB_SPIN(xb_ld(&bar[XB_XGEN(b.x)]) == gen, bar);
            __builtin_amdgcn_fence(__ATOMIC_ACQUIRE, "agent");
            asm volatile("s_waitcnt vmcnt(0)" ::: "memory");
        }
    }
    __syncthreads();
}

__global__ void __launch_bounds__(NTHR) fwd_megakernel(Params p) {
    extern __shared__ __attribute__((aligned(16))) unsigned char lds[];
    cg::grid_group grid = cg::this_grid();
    volatile LAS unsigned* xst = (volatile LAS unsigned*)(lds + LDS_BYTES - 32);
    if (threadIdx.x < 2) xst[threadIdx.x] = 0u;
    __syncthreads();
    const XcdBarrier xb = xcd_barrier_post((unsigned*)(p.ws + OFF_BAR), xst);
    if (p.out == nullptr) grid.sync();
#pragma unroll 1
    for (int step = 0; step < 18; ++step) {
        const int l = step >= 9 ? 1 : 0;
        const int ph = step - l * 9;
        switch (ph) {
        case 0:
            if (l == 0) phase_embed(p); else phase_rowstat(p);
            phase_convert<false>(p, l, lds);
            if (obid() == 0 && otid() < 24) ((int*)(WS(p) + OFF_CTL))[otid() * 32] = 0;
            if (obid() == 0 && otid() == 32) ((int*)(WS(p) + OFF_CTL))[800 + l * 32] = 0;
            break;
        case 1: phase_inproj(p, lds); break;
        case 2: phase_dsa_prep(p, l); phase_lr_prep(p, l); break;
        case 3: {
            if (obid() < NB * 16) phase_scan5(p, l, lds, obid());
            int* qctr = (int*)(WS(p) + OFF_CTL) + 800 + l * 32;
            int* qslot = (int*)(lds + LDS_BYTES - 16);
            for (;;) {
                __syncthreads();
                if (otid() == 0) *qslot = atomicAdd(qctr, 1);
                __syncthreads();
                const int item = *qslot;
                if (item >= 516 + NT / 16 + 3072) break;
                if (item < 516) phase_pool(p, l, lds, item, item + 1, 1);
                else if (item < 516 + NT / 16) phase_dsa<false>(p, l, lds, (bf16_t*)(OUTB(p) + DO_YC), nullptr, nullptr, item - 516, item - 515, 1);
                else {
                    const int ct = item - (516 + NT / 16);
                    const ConvJob cj = get_job_late(p, l, ct >> 10);
                    conv_tile(cj, ct & 1023, (float*)lds);
                }
            }
        } break;
        case 4: phase_merge(p, lds); break;
        case 5: phase_outproj(p, lds); break;
        case 6: phase_route(p, l, lds); break;
        case 7: phase_moe1(p, lds); break;
        default: phase_moe2(p, lds); break;
        }
        xcd_barrier(xb);
    }
    phase_final(p);
}

extern "C" void kernel_launch(void* const* d_in, const int* in_sizes, int n_in,
                              void* d_out, int out_size, void* d_ws, size_t ws_size,
                              hipStream_t stream) {
    static int grid_blocks = 0;
    if (grid_blocks == 0) {
        int dev = 0, cus = 0, per_cu = 0;
        (void)hipGetDevice(&dev);
        (void)hipDeviceGetAttribute(&cus, hipDeviceAttributeMultiprocessorCount, dev);
        (void)hipFuncSetAttribute((const void*)fwd_megakernel, hipFuncAttributeMaxDynamicSharedMemorySize, LDS_BYTES);
        (void)hipOccupancyMaxActiveBlocksPerMultiprocessor(&per_cu, fwd_megakernel, NTHR, LDS_BYTES);
        if (per_cu < 1 || cus < NB * 16 || (cus & 7) != 0 || n_in != 42 || ws_size < WS_END) { fprintf(stderr, "kernel_launch: bad config per_cu=%d n_in=%d ws=%zu need=%zu\n", per_cu, n_in, ws_size, (size_t)WS_END); grid_blocks = -1; }
        else grid_blocks = cus;
    }
    if (grid_blocks < 0) return;
    Params p{};
    for (int i = 0; i < 42; ++i) p.in[i] = (const float*)d_in[i];
    p.out = (float*)d_out;
    p.ws = (unsigned char*)d_ws;
    (void)hipMemsetAsync((unsigned char*)d_ws + OFF_BAR, 0, XCD_BAR_WORDS * 4, stream);
    void* args[] = {&p};
    hipError_t e = hipLaunchCooperativeKernel((void*)fwd_megakernel, dim3(grid_blocks), dim3(NTHR), args, LDS_BYTES, stream);
    if (e != hipSuccess) fprintf(stderr, "cooperative launch failed: %s (grid %d)\n", hipGetErrorString(e), grid_blocks);
}
```

```cpp
#include <hip/hip_runtime.h>
#include <hip/hip_cooperative_groups.h>
#include <cstdio>
#include <cstdint>
#include <type_traits>
namespace cg = cooperative_groups;

typedef unsigned short bf16_t;
typedef short bf16x8 __attribute__((ext_vector_type(8)));
typedef float f32x4 __attribute__((ext_vector_type(4)));

constexpr int NB = 8, SEQ = 2048, NMETA = 16, TS = 2064, DM = 1024;
constexpr int NT = NB * TS;
constexpr int NTP = 16640;
constexpr int NTHR = 512;
constexpr int CIN = 7912;
constexpr int NP1 = 4864;
constexpr int PM_LD = 768;
constexpr int PM_WD = 0, PM_AD = 64, PM_GD = 128, PM_VD = 256, PM_CQ = 288, PM_CKV = 544, PM_KROPE = 672, PM_KIDX = 704;
constexpr int LDS_BYTES = 157 * 1024;

constexpr size_t AL(size_t x) { return (x + 255) & ~(size_t)255; }
constexpr size_t SZ_ACT = (size_t)NTP * 1024 * 2;
constexpr size_t OFF_CTL = 0;
constexpr size_t OFF_BAR = 4096;
constexpr size_t OFF_RSTD = OFF_BAR + 16384;
constexpr size_t OFF_ROPE = OFF_RSTD + AL((size_t)NTP * 4);
constexpr size_t OFF_H = OFF_ROPE + AL((size_t)TS * 16 * 4 * 2);
constexpr size_t OFF_WB = OFF_H + SZ_ACT;
constexpr size_t WB_WIN = 0;
constexpr size_t WB_WG = WB_WIN + (size_t)NP1 * 1024;
constexpr size_t WB_PA = WB_WG + (size_t)3072 * 1024;
constexpr size_t WB_WO = WB_PA + (size_t)3 * 1024 * 1024;
constexpr size_t WB_POOL = WB_WO + (size_t)1024 * 1024;
constexpr size_t WB_QI = WB_POOL + (size_t)4 * 256 * 256;
constexpr size_t WB_UQ = WB_QI + (size_t)512 * 256;
constexpr size_t WB_UK = WB_UQ + (size_t)1536 * 256;
constexpr size_t WB_UV = WB_UK + (size_t)16 * 128 * 64;
constexpr size_t WB_WIDX = WB_UV + (size_t)16 * 64 * 128;
constexpr size_t WB_END = WB_WIDX + (size_t)64 * 1024;
constexpr size_t OFF_PPOOL = OFF_WB + AL(WB_END * 2);
constexpr size_t OFF_PK = OFF_PPOOL + SZ_ACT;
constexpr size_t OFF_PR = OFF_PK + SZ_ACT;
constexpr size_t OFF_PV = OFF_PR + SZ_ACT;
constexpr size_t OFF_PMISC = OFF_PV + SZ_ACT;
constexpr size_t OFF_VFIRST = OFF_PMISC + AL((size_t)NTP * PM_LD * 2);
constexpr size_t OFF_HALO = OFF_VFIRST + SZ_ACT;
constexpr size_t OFF_LIST = OFF_HALO + AL((size_t)130 * 16 * 1024 * 2);
constexpr size_t OFF_PW = OFF_LIST + AL((size_t)24 * NT * 4);
constexpr size_t WS_END = OFF_PW + AL((size_t)NT * 2 * 4);
constexpr size_t OFF_MERGED = OFF_PK;
constexpr size_t OFF_HM32 = OFF_PR;
constexpr size_t OFF_HN = OFF_PPOOL;
constexpr size_t OFF_WEXP = OFF_PMISC;
constexpr size_t WE_W1 = 0, WE_W3 = (size_t)16 * 256 * 1024, WE_W2 = (size_t)2 * 16 * 256 * 1024;
static_assert((size_t)3 * 16 * 256 * 1024 * 2 <= (size_t)NTP * PM_LD * 2, "expert weights must fit in Pmisc");
constexpr size_t DO_YC = 0;
constexpr size_t DO_CQN = DO_YC + SZ_ACT;
constexpr size_t DO_KV = DO_CQN + AL((size_t)NT * 256 * 2);
constexpr size_t DO_KIDX = DO_KV + AL((size_t)NT * 160 * 2);
constexpr size_t DO_WHEAD = DO_KIDX + AL((size_t)NT * 64 * 2);
constexpr size_t DO_ALR = DO_WHEAD + AL((size_t)NT * 8 * 4);
constexpr size_t DO_END = DO_ALR + AL((size_t)NT * 288 * 2);
constexpr size_t QS_BYTES = (size_t)16 * 16 * 160 * 2;
constexpr int QS_WS = (int)((277240096ull - WS_END) / QS_BYTES), QS_DO = (int)(((size_t)NB * SEQ * DM * 4 - DO_END) / QS_BYTES);
static_assert(QS_WS + QS_DO >= 256, "Q scratch");
constexpr size_t DO_HID = DO_YC;
static_assert(DO_END <= (size_t)NB * SEQ * DM * 4, "d_out scratch overflow");
static_assert((size_t)(129 + 24) * 128 * 512 * 2 <= SZ_ACT, "hid fits");
static_assert(WS_END <= 277240096ull, "workspace overflow");

struct Params {
    const float* in[42];
    float* out;
    unsigned char* ws;
};

__device__ __forceinline__ int otid() { int t = threadIdx.x; asm volatile("" : "+v"(t)); return t; }
__device__ __forceinline__ int obid() { int b = blockIdx.x; asm volatile("" : "+s"(b)); return b; }
__device__ __forceinline__ unsigned char* WS(const Params& p) { unsigned char* w = p.ws; asm volatile("" : "+s"(w)); return w; }
__device__ __forceinline__ unsigned char* OUTB(const Params& p) { unsigned char* w = (unsigned char*)p.out; asm volatile("" : "+s"(w)); return w; }
__device__ __forceinline__ float bf2f(bf16_t v) { return __uint_as_float(((unsigned)v) << 16); }
typedef float f32x2v __attribute__((ext_vector_type(2)));
typedef __bf16 bf16x2v __attribute__((ext_vector_type(2)));
__device__ __forceinline__ unsigned pk2(float a, float b) { const f32x2v v = {a, b}; const bf16x2v r = __builtin_convertvector(v, bf16x2v); unsigned u; __builtin_memcpy(&u, &r, 4); return u; }
__device__ __forceinline__ bf16_t f2bf(float f) { const __bf16 h = (__bf16)f; bf16_t u; __builtin_memcpy(&u, &h, 2); return u; }
__device__ __forceinline__ float wave_sum(float v) {
#pragma unroll
    for (int o = 32; o > 0; o >>= 1) v += __shfl_xor(v, o);
    return v;
}
template <int CTRL> __device__ __forceinline__ float dpp_f(float x) {
    return __int_as_float(__builtin_amdgcn_update_dpp(0, __float_as_int(x), CTRL, 0xF, 0xF, true));
}
__device__ __forceinline__ float row16_sum(float v) {
    v += dpp_f<0xB1>(v);
    v += dpp_f<0x4E>(v);
    v += dpp_f<0x141>(v);
    v += dpp_f<0x140>(v);
    return v;
}
__device__ __forceinline__ void lds_barrier() { asm volatile("s_waitcnt lgkmcnt(0)" ::: "memory"); __builtin_amdgcn_s_barrier(); asm volatile("" ::: "memory"); }
__device__ __forceinline__ float fast_rcp(float x) { return __builtin_amdgcn_rcpf(x); }
__device__ __forceinline__ float fast_sigmoid(float x) { return fast_rcp(1.0f + __expf(-x)); }
__device__ __forceinline__ float fast_tanh(float x) { return 1.0f - 2.0f * fast_rcp(1.0f + __expf(2.0f * x)); }
__device__ __forceinline__ void row16_sum4(float& a, float& b, float& c, float& d) {
    asm volatile(
        "s_nop 1\n\t"
        "v_add_f32_dpp %0, %0, %0 quad_perm:[1,0,3,2] row_mask:0xf bank_mask:0xf\n\t"
        "v_add_f32_dpp %1, %1, %1 quad_perm:[1,0,3,2] row_mask:0xf bank_mask:0xf\n\t"
        "v_add_f32_dpp %2, %2, %2 quad_perm:[1,0,3,2] row_mask:0xf bank_mask:0xf\n\t"
        "v_add_f32_dpp %3, %3, %3 quad_perm:[1,0,3,2] row_mask:0xf bank_mask:0xf\n\t"
        "v_add_f32_dpp %0, %0, %0 quad_perm:[2,3,0,1] row_mask:0xf bank_mask:0xf\n\t"
        "v_add_f32_dpp %1, %1, %1 quad_perm:[2,3,0,1] row_mask:0xf bank_mask:0xf\n\t"
        "v_add_f32_dpp %2, %2, %2 quad_perm:[2,3,0,1] row_mask:0xf bank_mask:0xf\n\t"
        "v_add_f32_dpp %3, %3, %3 quad_perm:[2,3,0,1] row_mask:0xf bank_mask:0xf\n\t"
        "v_add_f32_dpp %0, %0, %0 row_half_mirror row_mask:0xf bank_mask:0xf\n\t"
        "v_add_f32_dpp %1, %1, %1 row_half_mirror row_mask:0xf bank_mask:0xf\n\t"
        "v_add_f32_dpp %2, %2, %2 row_half_mirror row_mask:0xf bank_mask:0xf\n\t"
        "v_add_f32_dpp %3, %3, %3 row_half_mirror row_mask:0xf bank_mask:0xf\n\t"
        "v_add_f32_dpp %0, %0, %0 row_mirror row_mask:0xf bank_mask:0xf\n\t"
        "v_add_f32_dpp %1, %1, %1 row_mirror row_mask:0xf bank_mask:0xf\n\t"
        "v_add_f32_dpp %2, %2, %2 row_mirror row_mask:0xf bank_mask:0xf\n\t"
        "v_add_f32_dpp %3, %3, %3 row_mirror row_mask:0xf bank_mask:0xf\n\t"
        "s_nop 1"
        : "+v"(a), "+v"(b), "+v"(c), "+v"(d));
}
__device__ __forceinline__ void row8_sum2(float& a, float& b) {
    asm volatile(
        "s_nop 1\n\t"
        "v_add_f32_dpp %0, %0, %0 quad_perm:[1,0,3,2] row_mask:0xf bank_mask:0xf\n\t"
        "v_add_f32_dpp %1, %1, %1 quad_perm:[1,0,3,2] row_mask:0xf bank_mask:0xf\n\t"
        "s_nop 0\n\t"
        "v_add_f32_dpp %0, %0, %0 quad_perm:[2,3,0,1] row_mask:0xf bank_mask:0xf\n\t"
        "v_add_f32_dpp %1, %1, %1 quad_perm:[2,3,0,1] row_mask:0xf bank_mask:0xf\n\t"
        "s_nop 0\n\t"
        "v_add_f32_dpp %0, %0, %0 row_half_mirror row_mask:0xf bank_mask:0xf\n\t"
        "v_add_f32_dpp %1, %1, %1 row_half_mirror row_mask:0xf bank_mask:0xf\n\t"
        "s_nop 1"
        : "+v"(a), "+v"(b));
}
__device__ __forceinline__ float wave_sum_fast(float v) { v = row16_sum(v); v += __shfl_xor(v, 16); v += __shfl_xor(v, 32); return v; }
__device__ __forceinline__ float sigmoidf_(float x) { return 1.0f / (1.0f + __expf(-x)); }
__device__ __forceinline__ float softplusf_(float z) { return fmaxf(z, 0.f) + log1pf(__expf(-fabsf(z))); }
__device__ __forceinline__ void glds16(const void* g, void* l) {
    __builtin_amdgcn_global_load_lds((const unsigned*)g, (unsigned*)l, 16, 0, 0);
}

__device__ void phase_embed(const Params& p) {
    const int lane = otid() & 63;
    const int wave = (obid() * NTHR + otid()) >> 6, nw = gridDim.x * NTHR / 64;
    bf16_t* h = (bf16_t*)(WS(p) + OFF_H);
    float* rstd = (float*)(WS(p) + OFF_RSTD);
    auto srcrow = [&](int n) { const int b = n / TS, t = n % TS; return t < NMETA ? p.in[1] + (size_t)t * DM : p.in[0] + ((size_t)b * SEQ + (t - NMETA)) * DM; };
    float4 cur[4];
    if (wave < NT) {
        const float* src = srcrow(wave);
#pragma unroll
        for (int i = 0; i < 4; ++i) cur[i] = *(const float4*)(src + i * 256 + lane * 4);
    }
    for (int n = wave; n < NTP; n += nw) {
        if (n < NT) {
            float4 v[4];
#pragma unroll
            for (int i = 0; i < 4; ++i) v[i] = cur[i];
            if (n + nw < NT) {
                const float* src = srcrow(n + nw);
#pragma unroll
                for (int i = 0; i < 4; ++i) cur[i] = *(const float4*)(src + i * 256 + lane * 4);
            }
            float ss = 0.f;
#pragma unroll
            for (int i = 0; i < 4; ++i) {
                ss += v[i].x * v[i].x + v[i].y * v[i].y + v[i].z * v[i].z + v[i].w * v[i].w;
                *(uint2*)(h + (size_t)n * DM + i * 256 + lane * 4) = make_uint2(pk2(v[i].x, v[i].y), pk2(v[i].z, v[i].w));
            }
            ss = wave_sum(ss);
            if (lane == 0) rstd[n] = rsqrtf(ss * (1.0f / 1024.0f) + 1e-6f);
        } else {
#pragma unroll
            for (int i = 0; i < 4; ++i) *(ushort4*)(h + (size_t)n * DM + i * 256 + lane * 4) = make_ushort4(0, 0, 0, 0);
            if (lane == 0) rstd[n] = 0.f;
        }
    }
    float* ctab = (float*)(WS(p) + OFF_ROPE);
    float* stab = ctab + TS * 16;
    for (int idx = obid() * NTHR + otid(); idx < TS * 16; idx += gridDim.x * NTHR) {
        const int t = idx >> 4, i = idx & 15;
        const float inv = powf(10000.0f, -(float)(2 * i) / 32.0f);
        const float ang = (float)t * inv;
        ctab[idx] = cosf(ang);
        stab[idx] = sinf(ang);
    }
}

__device__ void phase_rowstat(const Params& p) {
    const int lane = otid() & 63;
    const int wave = (obid() * NTHR + otid()) >> 6, nw = gridDim.x * NTHR / 64;
    const float* hm = (const float*)(WS(p) + OFF_HM32);
    float* rstd = (float*)(WS(p) + OFF_RSTD);
    float4 cur[4];
    if (wave < NT) {
#pragma unroll
        for (int i = 0; i < 4; ++i) cur[i] = *(const float4*)(hm + (size_t)wave * DM + i * 256 + lane * 4);
    }
    for (int n = wave; n < NT; n += nw) {
        float ss = 0.f;
#pragma unroll
        for (int i = 0; i < 4; ++i) ss += cur[i].x * cur[i].x + cur[i].y * cur[i].y + cur[i].z * cur[i].z + cur[i].w * cur[i].w;
        if (n + nw < NT) {
#pragma unroll
            for (int i = 0; i < 4; ++i) cur[i] = *(const float4*)(hm + (size_t)(n + nw) * DM + i * 256 + lane * 4);
        }
        ss = wave_sum(ss);
        if (lane == 0) rstd[n] = rsqrtf(ss * (1.0f / 1024.0f) + 1e-6f);
    }
}

struct ConvJob { const float* src; bf16_t* dst; const float* scale; int ldsrc, K, nvalid, nrows, nb, notr; size_t sbs, dbs; const float* srcB; int ldB, split; };
__device__ __forceinline__ int conv_job_tiles(const ConvJob& j) { return j.nb * (j.nrows >> 6) * (j.K >> 6); }
__device__ void conv_tile(const ConvJob& j, int tile, float* lds) {
    const int per = (j.nrows >> 6) * (j.K >> 6);
    const int bi = tile / per, rem = tile % per;
    const int ktiles = j.K >> 6;
    const int n0 = (rem / ktiles) << 6, k0 = (rem % ktiles) << 6;
    const int tid = otid(), tn = tid & 63, tk = tid >> 6;
    const float* src = j.src + (size_t)bi * j.sbs;
    bf16_t* dst = j.dst + (size_t)bi * j.dbs;
#pragma unroll
    for (int kk = 0; kk < 8; ++kk) {
        const int k = k0 + tk * 8 + kk;
        float v = 0.f;
        if (n0 + tn < j.nvalid) {
            if (j.split) { const int nn = n0 + tn; v = (nn < j.split) ? (j.src ? j.src[(size_t)k * j.ldsrc + nn] : 0.f) : j.srcB[(size_t)k * j.ldB + (nn - j.split)]; }
            else v = j.notr ? src[(size_t)(n0 + tn) * j.ldsrc + k] : src[(size_t)k * j.ldsrc + n0 + tn];
            if (j.scale) v *= j.scale[k];
        }
        lds[tn * 65 + tk * 8 + kk] = v;
    }
    __syncthreads();
    const int wn = tid >> 3, kq = tid & 7;
    uint4 o;
    unsigned w[4];
#pragma unroll
    for (int q = 0; q < 4; ++q) {
        const float lo = lds[wn * 65 + kq * 8 + 2 * q], hi = lds[wn * 65 + kq * 8 + 2 * q + 1];
        w[q] = pk2(lo, hi);
    }
    o.x = w[0]; o.y = w[1]; o.z = w[2]; o.w = w[3];
    *(uint4*)(dst + (size_t)(n0 + wn) * j.K + k0 + kq * 8) = o;
    __syncthreads();
}
__device__ ConvJob get_job_early(const Params& p, int l, int ji) {
    bf16_t* wb = (bf16_t*)(WS(p) + OFF_WB);
    const float* win = p.in[3] + (size_t)l * DM * CIN;
    const float* nm = p.in[2] + (size_t)l * DM;
    ConvJob j{}; j.nb = 1; j.sbs = 0; j.dbs = 0; j.K = 1024; j.ldsrc = CIN; j.scale = nm;
    switch (ji) {
    case 0: j.src = win + 3072; j.dst = wb + WB_WIN; j.nvalid = 4352; j.nrows = 4352; break;
    case 1: j.src = (l == 0 ? nullptr : p.in[17]); j.ldsrc = 32; j.split = 32; j.srcB = win + 7424; j.ldB = CIN; j.dst = wb + WB_WIN + (size_t)(4096 + PM_VD) * 1024; j.nvalid = 512; j.nrows = 512; break;
    case 2: j.src = win + 7904; j.dst = wb + WB_WIDX; j.nvalid = 8; j.nrows = 64; break;
    case 3: j.src = win; j.dst = wb + WB_WG; j.nvalid = 3072; j.nrows = 3072; break;
    case 4: j.src = p.in[29] + (size_t)l * DM * DM; j.ldsrc = 1024; j.scale = nullptr; j.dst = wb + WB_PA; j.nvalid = 1024; j.nrows = 1024; break;
    case 5: j.src = p.in[30] + (size_t)l * DM * DM; j.ldsrc = 1024; j.scale = nullptr; j.dst = wb + WB_PA + (size_t)1024 * 1024; j.nvalid = 1024; j.nrows = 1024; break;
    case 6: j.src = p.in[31] + (size_t)l * DM * DM; j.ldsrc = 1024; j.scale = nullptr; j.dst = wb + WB_PA + (size_t)2 * 1024 * 1024; j.nvalid = 1024; j.nrows = 1024; break;
    case 7: j.src = p.in[32] + (size_t)l * DM * DM; j.ldsrc = 1024; j.scale = nullptr; j.dst = wb + WB_WO; j.nvalid = 1024; j.nrows = 1024; break;
    case 8: j.src = p.in[5] + (size_t)l * 4 * 256 * 256; j.ldsrc = 256; j.K = 256; j.scale = nullptr; j.dst = wb + WB_POOL; j.nvalid = 256; j.nrows = 256; j.nb = 4; j.sbs = 65536; j.dbs = 65536; break;
    case 9: j.src = p.in[26] + (size_t)l * 256 * 512; j.ldsrc = 512; j.K = 256; j.scale = nullptr; j.dst = wb + WB_QI; j.nvalid = 512; j.nrows = 512; break;
    case 10: j.src = p.in[23] + (size_t)l * 256 * 1536; j.ldsrc = 1536; j.K = 256; j.scale = nullptr; j.dst = wb + WB_UQ; j.nvalid = 1536; j.nrows = 1536; break;
    case 11: j.src = p.in[24] + (size_t)l * 16 * 128 * 64; j.ldsrc = 64; j.K = 64; j.scale = nullptr; j.dst = wb + WB_UK; j.nvalid = 2048; j.nrows = 2048; j.notr = 1; break;
    default: j.src = p.in[25] + (size_t)l * 16 * 128 * 64; j.ldsrc = 64; j.K = 128; j.scale = nullptr; j.dst = wb + WB_UV; j.nvalid = 64; j.nrows = 64; j.nb = 16; j.sbs = 8192; j.dbs = 8192; break;
    }
    return j;
}
__device__ ConvJob get_job_late(const Params& p, int l, int ji) {
    bf16_t* we = (bf16_t*)(WS(p) + OFF_WEXP);
    ConvJob j{}; j.nb = 16; j.scale = nullptr; j.sbs = 262144; j.dbs = 262144;
    switch (ji) {
    case 0: j.src = p.in[38] + (size_t)l * 16 * 262144; j.dst = we + WE_W1; j.ldsrc = 256; j.K = 1024; j.nvalid = 256; j.nrows = 256; break;
    case 1: j.src = p.in[39] + (size_t)l * 16 * 262144; j.dst = we + WE_W3; j.ldsrc = 256; j.K = 1024; j.nvalid = 256; j.nrows = 256; break;
    default: j.src = p.in[40] + (size_t)l * 16 * 262144; j.dst = we + WE_W2; j.ldsrc = 1024; j.K = 256; j.nvalid = 1024; j.nrows = 1024; break;
    }
    return j;
}
template <bool LATE>
__device__ void phase_convert(const Params& p, int l, unsigned char* lds) {
    const int njobs = LATE ? 3 : 13;
    int base = 0;
    for (int ji = 0; ji < njobs; ++ji) {
        const ConvJob j = LATE ? get_job_late(p, l, ji) : get_job_early(p, l, ji);
        const int nt = conv_job_tiles(j);
        int first = ((int)obid() - base) % (int)gridDim.x; if (first < 0) first += gridDim.x;
        for (int t = first; t < nt; t += gridDim.x) conv_tile(j, t, (float*)lds);
        base += nt;
    }
}

template <int BM> struct G3 {
    static constexpr int MI = BM / 64;
    static constexpr int NA = BM / 64;
    static constexpr int STAGE = BM * 128 + 128 * 128;
    const bf16_t* ap[NA];
    const bf16_t* bp[2];
};
template <int BM>
__device__ __forceinline__ void g3_issue(const G3<BM>& g, int kt, unsigned char* stage, int tid) {
#pragma unroll
    for (int i = 0; i < G3<BM>::NA; ++i) glds16(g.ap[i] + kt * 64, stage + (tid + i * NTHR) * 16);
#pragma unroll
    for (int i = 0; i < 2; ++i) glds16(g.bp[i] + kt * 64, stage + BM * 128 + (tid + i * NTHR) * 16);
}
template <int BM, class FA, class FB>
__device__ __forceinline__ void g3_setup(G3<BM>& g, FA rowptr, FB bcol, int tid) {
#pragma unroll
    for (int i = 0; i < G3<BM>::NA; ++i) { const int idx = tid + i * NTHR, row = idx >> 3, sl = (idx & 7) ^ (row & 7); g.ap[i] = rowptr(row) + sl * 8; }
#pragma unroll
    for (int i = 0; i < 2; ++i) { const int idx = tid + i * NTHR, row = idx >> 3, sl = (idx & 7) ^ (row & 7); g.bp[i] = bcol(row) + sl * 8; }
}
template <int BM>
__device__ __forceinline__ void g3_kloop(f32x4 (&acc)[BM / 64][4], const G3<BM>& g, int K, unsigned char* lds) {
    constexpr int MI = G3<BM>::MI, STAGE = G3<BM>::STAGE, NL = G3<BM>::NA + 2;
    const int tid = otid(), lane = tid & 63, wid = tid >> 6, wr = wid >> 1, wc = wid & 1, fr = lane & 15, fq = lane >> 4;
    const int nk = K >> 6;
    g3_issue<BM>(g, 0, lds, tid);
    if (nk > 1) g3_issue<BM>(g, 1, lds + STAGE, tid);
    int cur = 0;
#pragma unroll 1
    for (int t = 0; t < nk; ++t) {
        if (t + 1 < nk) { if (NL == 6) asm volatile("s_waitcnt vmcnt(6)" ::: "memory"); else if (NL == 5) asm volatile("s_waitcnt vmcnt(5)" ::: "memory"); else asm volatile("s_waitcnt vmcnt(4)" ::: "memory"); }
        else asm volatile("s_waitcnt vmcnt(0)" ::: "memory");
        __builtin_amdgcn_s_barrier();
        if (t + 2 < nk) { int nx = cur + 2; if (nx >= 3) nx -= 3; g3_issue<BM>(g, t + 2, lds + nx * STAGE, tid); }
        const unsigned char* cA = lds + cur * STAGE;
        const unsigned char* cB = cA + BM * 128;
#pragma unroll
        for (int ks = 0; ks < 2; ++ks) {
            bf16x8 a[MI], b[4];
#pragma unroll
            for (int m = 0; m < MI; ++m) { const int row = wr * (BM / 4) + m * 16 + fr; a[m] = *(const bf16x8*)(cA + row * 128 + (((ks * 4 + fq) ^ (row & 7)) << 4)); }
#pragma unroll
            for (int n = 0; n < 4; ++n) { const int row = wc * 64 + n * 16 + fr; b[n] = *(const bf16x8*)(cB + row * 128 + (((ks * 4 + fq) ^ (row & 7)) << 4)); }
#pragma unroll
            for (int m = 0; m < MI; ++m)
#pragma unroll
                for (int n = 0; n < 4; ++n) acc[m][n] = __builtin_amdgcn_mfma_f32_16x16x32_bf16(b[n], a[m], acc[m][n], 0, 0, 0);
        }
        cur = (cur == 2) ? 0 : cur + 1;
    }
    __builtin_amdgcn_s_barrier();
}
struct G3D { const bf16_t* ap[2]; const bf16_t* b1[2]; const bf16_t* b3[2]; };
__device__ __forceinline__ void g3d_issue(const G3D& g, int kt, unsigned char* stage, int tid) {
#pragma unroll
    for (int i = 0; i < 2; ++i) glds16(g.ap[i] + kt * 64, stage + (tid + i * NTHR) * 16);
#pragma unroll
    for (int i = 0; i < 2; ++i) glds16(g.b1[i] + kt * 64, stage + 16384 + (tid + i * NTHR) * 16);
#pragma unroll
    for (int i = 0; i < 2; ++i) glds16(g.b3[i] + kt * 64, stage + 32768 + (tid + i * NTHR) * 16);
}
__device__ __forceinline__ void g3d_kloop(f32x4 (&acc1)[2][4], f32x4 (&acc3)[2][4], const G3D& g, int K, unsigned char* lds) {
    constexpr int STAGE = 49152;
    const int tid = otid(), lane = tid & 63, wid = tid >> 6, wr = wid >> 1, wc = wid & 1, fr = lane & 15, fq = lane >> 4;
    const int nk = K >> 6;
    g3d_issue(g, 0, lds, tid);
    if (nk > 1) g3d_issue(g, 1, lds + STAGE, tid);
    int cur = 0;
#pragma unroll 1
    for (int t = 0; t < nk; ++t) {
        if (t + 1 < nk) asm volatile("s_waitcnt vmcnt(6)" ::: "memory"); else asm volatile("s_waitcnt vmcnt(0)" ::: "memory");
        __builtin_amdgcn_s_barrier();
        if (t + 2 < nk) { int nx = cur + 2; if (nx >= 3) nx -= 3; g3d_issue(g, t + 2, lds + nx * STAGE, tid); }
        const unsigned char* cA = lds + cur * STAGE;
#pragma unroll
        for (int ks = 0; ks < 2; ++ks) {
            bf16x8 a[2], b1[4], b3[4];
#pragma unroll
            for (int m = 0; m < 2; ++m) { const int row = wr * 32 + m * 16 + fr; a[m] = *(const bf16x8*)(cA + row * 128 + (((ks * 4 + fq) ^ (row & 7)) << 4)); }
#pragma unroll
            for (int n = 0; n < 4; ++n) { const int row = wc * 64 + n * 16 + fr; const int off = row * 128 + (((ks * 4 + fq) ^ (row & 7)) << 4);
                b1[n] = *(const bf16x8*)(cA + 16384 + off); b3[n] = *(const bf16x8*)(cA + 32768 + off); }
#pragma unroll
            for (int m = 0; m < 2; ++m)
#pragma unroll
                for (int n = 0; n < 4; ++n) {
                    acc1[m][n] = __builtin_amdgcn_mfma_f32_16x16x32_bf16(b1[n], a[m], acc1[m][n], 0, 0, 0);
                    acc3[m][n] = __builtin_amdgcn_mfma_f32_16x16x32_bf16(b3[n], a[m], acc3[m][n], 0, 0, 0);
                }
        }
        cur = (cur == 2) ? 0 : cur + 1;
    }
    __builtin_amdgcn_s_barrier();
}
template <int MI>
__device__ __forceinline__ void g3_zero(f32x4 (&acc)[MI][4]) {
#pragma unroll
    for (int m = 0; m < MI; ++m)
#pragma unroll
        for (int n = 0; n < 4; ++n) acc[m][n] = (f32x4){0.f, 0.f, 0.f, 0.f};
}
__device__ __forceinline__ uint2 pack4(float a, float b, float c, float d) {
    uint2 r; r.x = pk2(a, b); r.y = pk2(c, d); return r;
}

namespace pg8 {
#define PG8_LAS __attribute__((address_space(3)))
typedef unsigned short bf16_t;
typedef short bf16x8 __attribute__((ext_vector_type(8)));
typedef float f32x4 __attribute__((ext_vector_type(4)));
typedef unsigned u32x4 __attribute__((ext_vector_type(4)));
constexpr int BM = 256, BK = 64, HALF = 128, HTB = HALF * BK * 2  , STAGE_BYTES = 8 * HTB, NXCD = 8, WGM = 8;

__host__ __device__ __forceinline__ int lds_byte(int r, int c) { const int st = (r >> 4) * 2 + (c >> 5), rr = r & 15, cc = c & 31, ob = rr * 64 + cc * 2; return st * 1024 + (ob ^ (((ob >> 9) & 1) << 5)); }
__host__ __device__ __forceinline__ void stage_rc(int b, int& R, int& C) { const int st = b / 1024, sb = b % 1024, swz = sb ^ (((sb >> 9) & 1) << 5); R = (st >> 1) * 16 + swz / 64; C = (st & 1) * 32 + (swz % 64) / 2; }
__host__ __device__ __forceinline__ int perm32(int rho) { const int n = rho >> 4, i = rho & 15; return 8 * (i >> 2) + 4 * n + (i & 3); }

struct Unit { int pm, pn; };
struct Gemm { const bf16_t* A; const bf16_t* Bt; int M, N, K; };

struct StaticOrder {
    int nM, nN, nwg, G, c;
    __host__ __device__ void init(int M, int N, int G_, int c_) { nM = M / BM; nN = N / BM; nwg = nM * nN; G = G_; c = c_; }
    __host__ __device__ bool next(int i, Unit& u) const {
        const long L = (long)i * G + c; if (L >= nwg) return false;
        int wgid = (int)L; { const int q = nwg / NXCD, r = nwg % NXCD, xcd = wgid % NXCD, off = wgid / NXCD; wgid = (xcd < r ? xcd * (q + 1) : r * (q + 1) + (xcd - r) * q) + off; }
        const int nig = WGM * nN, gid = wgid / nig, fm = gid * WGM, gsz = (nM - fm) < WGM ? (nM - fm) : WGM;
        u.pm = fm + ((wgid % nig) % gsz); u.pn = (wgid % nig) / gsz; return true;
    }
    __device__ __forceinline__ void a_ready(const Unit&) const {}
    __device__ __forceinline__ void done(const Unit&) const {}
};
template <class Epi, class Sched, bool STAMP = false>
__device__ __forceinline__ void gemm_phase(PG8_LAS unsigned char* lds, const Gemm g, const Sched& S, const Epi& E, unsigned long long* stamps) {
    const int tid = otid(), wid = __builtin_amdgcn_readfirstlane(tid >> 6), lane = tid & 63, wr = wid >> 2, wc = wid & 3, fr = lane & 15, fq = lane >> 4;
    const int K = g.K, nt = K / BK;
    int ts_lo = 0, ts_hi = 0, nts = 0; const unsigned long long rt_entry = STAMP ? 0ull : 0ull;
#define PG8_STAMP() do { if (STAMP && wid == 0 && nts < 64) { const unsigned long long _c = 0ull; \
        ts_lo = (lane == nts) ? (int)(unsigned)_c : ts_lo; ts_hi = (lane == nts) ? (int)(unsigned)(_c >> 32) : ts_hi; ++nts; } } while (0)
    PG8_STAMP();
    unsigned voffA[2], voffB[2];
#pragma unroll
    for (int i = 0; i < 2; ++i) { int R, C; stage_rc(tid * 16 + i * 8192, R, C); const int Rb = Epi::PERM ? ((R & ~31) + perm32(R & 31)) : R;
        voffA[i] = (unsigned)(R * K + C) * 2u; voffB[i] = (unsigned)(Rb * K + C) * 2u; }
    const size_t kstep = (size_t)(BK * 2);
    const size_t hstep = (size_t)HALF * K * 2;
    const size_t tstep = 2 * hstep;
    const unsigned ldsw = (unsigned)wid * 1024u;
    const int aoff = lds_byte(wr * 64 + fr, fq * 8), boff = lds_byte(wc * 32 + fr, fq * 8);
#define PG8_SA(b, h) (((b) * 2 + (h)) * HTB)
#define PG8_SB(b, h) ((4 + (b) * 2 + (h)) * HTB)
#define PG8_STAGE(bufoff, gbase, voff) do { _Pragma("unroll") for (int _i = 0; _i < 2; ++_i) \
        __builtin_amdgcn_global_load_lds((const unsigned*)((const char*)(gbase) + (voff)[_i]), (PG8_LAS unsigned*)(lds + (bufoff) + ldsw + _i * 8192), 16, 0, 0); } while (0)
#define PG8_LDA(dst, b, h) do { _Pragma("unroll") for (int m = 0; m < 4; ++m) _Pragma("unroll") for (int k = 0; k < 2; ++k) dst[m][k] = *(const PG8_LAS bf16x8*)(lds + PG8_SA(b, h) + aoff + m * 2048 + k * 1024); } while (0)
#define PG8_LDB(dst, b, h) do { _Pragma("unroll") for (int n = 0; n < 2; ++n) _Pragma("unroll") for (int k = 0; k < 2; ++k) dst[n][k] = *(const PG8_LAS bf16x8*)(lds + PG8_SB(b, h) + boff + n * 2048 + k * 1024); } while (0)
#define PG8_MMA(ai, bj, At, Bt) do { __builtin_amdgcn_s_setprio(1); _Pragma("unroll") for (int m = 0; m < 4; ++m) _Pragma("unroll") for (int n = 0; n < 2; ++n) _Pragma("unroll") for (int k = 0; k < 2; ++k) \
        acc[ai][bj][m][n] = __builtin_amdgcn_mfma_f32_16x16x32_bf16(Bt[n][k], At[m][k], acc[ai][bj][m][n], 0, 0, 0); __builtin_amdgcn_s_setprio(0); } while (0)
#define PG8_WAIT_V(n) asm volatile("s_waitcnt vmcnt(" #n ")" ::: "memory")
#define PG8_WAIT_L(n) asm volatile("s_waitcnt lgkmcnt(" #n ")" ::: "memory")
#define PG8_BAR __builtin_amdgcn_s_barrier()
#define PG8_SCHED __builtin_amdgcn_sched_barrier(0)
    Unit cur, nxt; int ui = 0;
    if (!S.next(0, cur)) return;
    f32x4 acc[2][2][4][2];
#pragma unroll
    for (int a = 0; a < 2; ++a)
#pragma unroll
        for (int b = 0; b < 2; ++b)
#pragma unroll
            for (int m = 0; m < 4; ++m)
#pragma unroll
                for (int n = 0; n < 2; ++n) acc[a][b][m][n] = (f32x4){0.f, 0.f, 0.f, 0.f};
    bf16x8 At[4][2], B0[2][2], B1[2][2];
    const char* cA = (const char*)g.A + (size_t)cur.pm * tstep; const char* cB = (const char*)g.Bt + (size_t)cur.pn * tstep;
    S.a_ready(cur);
    PG8_STAGE(PG8_SB(0, 0), cB, voffB); PG8_STAGE(PG8_SA(0, 0), cA, voffA); PG8_STAGE(PG8_SB(0, 1), cB + hstep, voffB); PG8_STAGE(PG8_SA(0, 1), cA + hstep, voffA);
    if (wr == 1) PG8_BAR;
    PG8_WAIT_V(4); PG8_BAR;
    PG8_STAGE(PG8_SB(1, 0), cB + kstep, voffB); PG8_STAGE(PG8_SA(1, 0), cA + kstep, voffA); PG8_STAGE(PG8_SB(1, 1), cB + hstep + kstep, voffB);
    PG8_WAIT_V(6); PG8_BAR;
    PG8_STAMP();
    for (;;) {
        const bool has_next = S.next(ui + 1, nxt);
        const char* nA = has_next ? (const char*)g.A + (size_t)nxt.pm * tstep : cA; const char* nB = has_next ? (const char*)g.Bt + (size_t)nxt.pn * tstep : cB;
        for (int t = 0; t < nt; t += 2) {
            const bool last = (t == nt - 2);
            const char* a1 = cA + (size_t)(t + 1) * kstep;
            const char* a2 = last ? nA : cA + (size_t)(t + 2) * kstep; const char* b2 = last ? nB : cB + (size_t)(t + 2) * kstep;
            const char* a3 = a2 + kstep; const char* b3 = b2 + kstep;
            if (last && has_next) S.a_ready(nxt);
            PG8_LDB(B0, 0, 0); PG8_SCHED; PG8_LDA(At, 0, 0); PG8_STAGE(PG8_SA(1, 1), a1 + hstep, voffA);
            PG8_WAIT_L(8); PG8_BAR; PG8_WAIT_L(0); PG8_MMA(0, 0, At, B0); PG8_BAR; PG8_SCHED;
            PG8_LDB(B1, 0, 1); PG8_STAGE(PG8_SB(0, 0), b2, voffB);
            PG8_BAR; PG8_WAIT_L(0); PG8_MMA(0, 1, At, B1); PG8_BAR;
            PG8_LDA(At, 0, 1); PG8_STAGE(PG8_SA(0, 0), a2, voffA);
            PG8_BAR; PG8_WAIT_L(0); PG8_MMA(1, 0, At, B0); PG8_BAR; PG8_SCHED;
            PG8_STAGE(PG8_SB(0, 1), b2 + hstep, voffB);
            PG8_WAIT_V(6); PG8_BAR; PG8_MMA(1, 1, At, B1); PG8_BAR;
            PG8_LDB(B0, 1, 0); PG8_SCHED; PG8_LDA(At, 1, 0); PG8_STAGE(PG8_SA(0, 1), a2 + hstep, voffA);
            PG8_WAIT_L(8); PG8_BAR; PG8_WAIT_L(0); PG8_MMA(0, 0, At, B0); PG8_BAR; PG8_SCHED;
            PG8_LDB(B1, 1, 1); PG8_STAGE(PG8_SB(1, 0), b3, voffB);
            PG8_BAR; PG8_WAIT_L(0); PG8_MMA(0, 1, At, B1); PG8_BAR;
            PG8_LDA(At, 1, 1); PG8_STAGE(PG8_SA(1, 0), a3, voffA);
            PG8_BAR; PG8_WAIT_L(0); PG8_MMA(1, 0, At, B0); PG8_BAR; PG8_SCHED;
            PG8_STAGE(PG8_SB(1, 1), b3 + hstep, voffB);
            PG8_WAIT_V(6); PG8_BAR; PG8_MMA(1, 1, At, B1); PG8_BAR;
        }
        PG8_STAMP();
        if constexpr (!Epi::AFTER_DRAIN) { E(acc, cur, wr, wc, fr, fq); S.done(cur); }
        PG8_STAMP();
        if (!has_next) break;
#pragma unroll
        for (int a = 0; a < 2; ++a)
#pragma unroll
            for (int b = 0; b < 2; ++b)
#pragma unroll
                for (int m = 0; m < 4; ++m)
#pragma unroll
                    for (int n = 0; n < 2; ++n) acc[a][b][m][n] = (f32x4){0.f, 0.f, 0.f, 0.f};
        cur = nxt; cA = nA; cB = nB; ++ui;
    }
    PG8_WAIT_V(0);
    if (wr == 0) PG8_BAR;
    PG8_BAR;
    if constexpr (Epi::AFTER_DRAIN) { E.fused(acc, cur, wr, wc, fr, fq, lds, wid, lane); S.done(cur); }
    PG8_STAMP();
    if (STAMP && wid == 0) { stamps[lane] = lane < nts ? (((unsigned long long)(unsigned)ts_hi << 32) | (unsigned)ts_lo) : 0ull;
        if (lane == 62) stamps[62] = rt_entry; if (lane == 63) stamps[63] = 0ull; }
#undef PG8_STAMP
#undef PG8_SA
#undef PG8_SB
#undef PG8_STAGE
#undef PG8_LDA
#undef PG8_LDB
#undef PG8_MMA
#undef PG8_WAIT_V
#undef PG8_WAIT_L
#undef PG8_BAR
#undef PG8_SCHED
}
}

struct EpiInproj {
    static constexpr bool PERM = true, AFTER_DRAIN = false;
    unsigned char* ws; const float* rstd;
    __device__ __forceinline__ void operator()(const pg8::f32x4 (&acc)[2][2][4][2], const pg8::Unit& u, int wr, int wc, int fr, int fq) const {
        const int pn = u.pn;
        bf16_t* dst; int ld, cb;
        if (pn < 4) { dst = (bf16_t*)(ws + OFF_PPOOL); ld = 1024; cb = pn * 256; }
        else if (pn < 8) { dst = (bf16_t*)(ws + OFF_PR); ld = 1024; cb = (pn - 4) * 256; }
        else if (pn < 12) { dst = (bf16_t*)(ws + OFF_PK); ld = 1024; cb = (pn - 8) * 256; }
        else if (pn < 16) { dst = (bf16_t*)(ws + OFF_PV); ld = 1024; cb = (pn - 12) * 256; }
        else { dst = (bf16_t*)(ws + OFF_PMISC); ld = PM_LD; cb = (pn - 16) * 256; }
        bf16_t* halo = (bf16_t*)(ws + OFF_HALO);
#pragma unroll
        for (int ai = 0; ai < 2; ++ai)
#pragma unroll
            for (int m = 0; m < 4; ++m) {
                const int row = u.pm * 256 + ai * 128 + wr * 64 + m * 16 + fr;
                if (row < NT) {
                    const float rs = rstd[row];
                    const int lr = row & 127;
#pragma unroll
                    for (int bj = 0; bj < 2; ++bj) {
                        const int col = cb + bj * 128 + wc * 32 + fq * 8;
                        const uint2 lo = pack4(acc[ai][bj][m][0][0] * rs, acc[ai][bj][m][0][1] * rs, acc[ai][bj][m][0][2] * rs, acc[ai][bj][m][0][3] * rs);
                        const uint2 hi = pack4(acc[ai][bj][m][1][0] * rs, acc[ai][bj][m][1][1] * rs, acc[ai][bj][m][1][2] * rs, acc[ai][bj][m][1][3] * rs);
                        const uint4 v = make_uint4(lo.x, lo.y, hi.x, hi.y);
                        *(uint4*)(dst + (size_t)row * ld + col) = v;
                        if (pn < 4 && lr >= 112) *(uint4*)(halo + ((size_t)(row >> 7) * 16 + (lr - 112)) * 1024 + col) = v;
                    }
                }
            }
    }
};
__device__ void phase_inproj(const Params& p, unsigned char* lds) {
    pg8::StaticOrder S; S.init(NTP, NP1, (int)gridDim.x, obid());
    pg8::Gemm g; g.A = (const pg8::bf16_t*)(WS(p) + OFF_H); g.Bt = (const pg8::bf16_t*)(WS(p) + OFF_WB) + WB_WIN; g.M = NTP; g.N = NP1; g.K = DM;
    EpiInproj E; E.ws = WS(p); E.rstd = (const float*)(WS(p) + OFF_RSTD);
    pg8::gemm_phase<EpiInproj, pg8::StaticOrder, false>((PG8_LAS unsigned char*)lds, g, S, E, nullptr);
}

__device__ void phase_pool(const Params& p, int l, unsigned char* lds, int tb, int te, int tstep) {
    const int tid = otid(), lane = tid & 63, wid = tid >> 6, fr = lane & 15, fq = lane >> 4;
    bf16_t* pp = (bf16_t*)(WS(p) + OFF_PPOOL);
    const bf16_t* halo = (const bf16_t*)(WS(p) + OFF_HALO);
    const bf16_t* pw = (const bf16_t*)(WS(p) + OFF_WB) + WB_POOL;
    const float* scale = p.in[6] + (size_t)l * 1024;
    bf16_t* sp = (bf16_t*)lds;
    constexpr int SLD = 264;
    for (int tile = tb; tile < te; tile += tstep) {
        const int mt = tile >> 2, g = tile & 3;
        const int row0 = mt * 128, w = 2 << g;
        {
            const int c = tid & 255, r0 = (tid >> 8) * 64, col = g * 256 + c;
            auto rawv = [&](int n2) -> float {
                return (n2 >= row0) ? bf2f(pp[(size_t)n2 * 1024 + col]) : bf2f(halo[((size_t)(n2 >> 7) * 16 + ((n2 & 127) - 112)) * 1024 + col]);
            };
            int n = row0 + r0, t = n % TS;
            float sum = 0.f;
            const int have = (t < w) ? t : w;
            for (int i = 1; i <= have; ++i) sum += rawv(n - i);
#pragma unroll 4
            for (int r = 0; r < 64; ++r, ++n) {
                if (t == 0) sum = 0.f;
                const float v = rawv(n);
                sum += v;
                if (t >= w) sum -= rawv(n - w);
                const int cnt = (t + 1 < w) ? (t + 1) : w;
                sp[(r0 + r) * SLD + c] = f2bf(sum * (1.0f / (float)cnt) - v);
                t = (t + 1 == TS) ? 0 : t + 1;
            }
        }
        __syncthreads();
        f32x4 acc[8][2];
#pragma unroll
        for (int m = 0; m < 8; ++m) { acc[m][0] = (f32x4){0.f, 0.f, 0.f, 0.f}; acc[m][1] = (f32x4){0.f, 0.f, 0.f, 0.f}; }
        const bf16_t* wg = pw + (size_t)g * 65536;
#pragma unroll 1
        for (int kk = 0; kk < 8; ++kk) {
            bf16x8 bfr[2];
#pragma unroll
            for (int n = 0; n < 2; ++n) bfr[n] = *(const bf16x8*)(wg + (size_t)(wid * 32 + n * 16 + fr) * 256 + kk * 32 + fq * 8);
#pragma unroll
            for (int m = 0; m < 8; ++m) {
                const bf16x8 a = *(const bf16x8*)(sp + (m * 16 + fr) * SLD + kk * 32 + fq * 8);
                acc[m][0] = __builtin_amdgcn_mfma_f32_16x16x32_bf16(a, bfr[0], acc[m][0], 0, 0, 0);
                acc[m][1] = __builtin_amdgcn_mfma_f32_16x16x32_bf16(a, bfr[1], acc[m][1], 0, 0, 0);
            }
        }
#pragma unroll
        for (int m = 0; m < 8; ++m)
#pragma unroll
            for (int n = 0; n < 2; ++n) {
                const int col = g * 256 + wid * 32 + n * 16 + fr;
                const float sc = scale[col];
#pragma unroll
                for (int j = 0; j < 4; ++j) {
                    const int row = row0 + m * 16 + fq * 4 + j;
                    pp[(size_t)row * 1024 + col] = f2bf(acc[m][n][j] * sc);
                }
            }
        __syncthreads();
    }
}

__device__ void phase_dsa_prep(const Params& p, int l) {
    const int lane = otid() & 63;
    const int wave = (obid() * NTHR + otid()) >> 6, nw = gridDim.x * NTHR / 64;
    const bf16_t* pm = (const bf16_t*)(WS(p) + OFF_PMISC);
    unsigned char* dob = OUTB(p);
    bf16_t* cqn = (bf16_t*)(dob + DO_CQN);
    bf16_t* kv = (bf16_t*)(dob + DO_KV);
    bf16_t* kidx = (bf16_t*)(dob + DO_KIDX);
    float* whead = (float*)(dob + DO_WHEAD);
    const float* ctab = (const float*)(WS(p) + OFF_ROPE);
    const float* stab = ctab + TS * 16;
    const bf16_t* hrow = (const bf16_t*)(WS(p) + OFF_H);
    const bf16_t* wwidx = (const bf16_t*)(WS(p) + OFF_WB) + WB_WIDX;
    const float* rstd_ = (const float*)(WS(p) + OFF_RSTD);
    const float4 qn4 = *(const float4*)(p.in[21] + l * 256 + lane * 4);
    const float2 kvn2 = *(const float2*)(p.in[22] + l * 128 + lane * 2);
    const float inw = p.in[27][l * 64 + lane], inb = p.in[28][l * 64 + lane];
    uint4 ww[8][2];
#pragma unroll
    for (int j = 0; j < 8; ++j) { ww[j][0] = *(const uint4*)(wwidx + (size_t)j * DM + lane * 16); ww[j][1] = *(const uint4*)(wwidx + (size_t)j * DM + lane * 16 + 8); }
    struct In { uint2 cq; unsigned ckv; bf16_t kr0, kr1, kix; uint4 h0, h1; float rs, c, s; };
    auto load = [&](int n) {
        In r;
        const bf16_t* row = pm + (size_t)n * PM_LD;
        const int t = n % TS;
        r.cq = *(const uint2*)(row + PM_CQ + lane * 4);
        r.ckv = *(const unsigned*)(row + PM_CKV + lane * 2);
        r.kr0 = row[PM_KROPE + (lane & 15)]; r.kr1 = row[PM_KROPE + 16 + (lane & 15)];
        r.kix = row[PM_KIDX + lane];
        r.h0 = *(const uint4*)(hrow + (size_t)n * DM + lane * 16); r.h1 = *(const uint4*)(hrow + (size_t)n * DM + lane * 16 + 8);
        r.rs = rstd_[n];
        r.c = ctab[t * 16 + (lane & 15)]; r.s = stab[t * 16 + (lane & 15)];
        return r;
    };
    In cur = load(wave < NT ? wave : 0);
    for (int n = wave; n < NT; n += nw) {
        const In x = cur;
        if (n + nw < NT) cur = load(n + nw);
        {
            const float v0 = __uint_as_float(x.cq.x << 16), v1 = __uint_as_float(x.cq.x & 0xFFFF0000u), v2 = __uint_as_float(x.cq.y << 16), v3 = __uint_as_float(x.cq.y & 0xFFFF0000u);
            const float ss = wave_sum_fast(v0 * v0 + v1 * v1 + v2 * v2 + v3 * v3);
            const float rs = rsqrtf(ss * (1.0f / 256.0f) + 1e-6f);
            *(uint2*)(cqn + (size_t)n * 256 + lane * 4) = pack4(v0 * rs * qn4.x, v1 * rs * qn4.y, v2 * rs * qn4.z, v3 * rs * qn4.w);
        }
        {
            const float v0 = __uint_as_float(x.ckv << 16), v1 = __uint_as_float(x.ckv & 0xFFFF0000u);
            const float ss = wave_sum_fast(v0 * v0 + v1 * v1);
            const float rs = rsqrtf(ss * (1.0f / 128.0f) + 1e-6f);
            *(unsigned*)(kv + (size_t)n * 160 + lane * 2) = pk2(v0 * rs * kvn2.x, v1 * rs * kvn2.y);
        }
        if (lane < 16) {
            const float x1 = bf2f(x.kr0), x2 = bf2f(x.kr1);
            kv[(size_t)n * 160 + 128 + lane] = f2bf(x1 * x.c - x2 * x.s);
            kv[(size_t)n * 160 + 144 + lane] = f2bf(x2 * x.c + x1 * x.s);
        }
        {
            const float xv = bf2f(x.kix);
            const float mu = wave_sum_fast(xv) * (1.0f / 64.0f);
            const float d = xv - mu;
            const float var = wave_sum_fast(d * d) * (1.0f / 64.0f);
            const float y = d * rsqrtf(var + 1e-6f) * inw + inb;
            const float yo = __shfl_xor(y, 16);
            float o = y;
            if (lane < 32) o = (lane < 16) ? (y * x.c - yo * x.s) : (y * x.c + yo * x.s);
            kidx[(size_t)n * 64 + lane] = f2bf(o);
        }
        {
            const uint4 hv0 = x.h0, hv1 = x.h1;
            float hx[16];
            hx[0] = __uint_as_float(hv0.x << 16); hx[1] = __uint_as_float(hv0.x & 0xFFFF0000u); hx[2] = __uint_as_float(hv0.y << 16); hx[3] = __uint_as_float(hv0.y & 0xFFFF0000u);
            hx[4] = __uint_as_float(hv0.z << 16); hx[5] = __uint_as_float(hv0.z & 0xFFFF0000u); hx[6] = __uint_as_float(hv0.w << 16); hx[7] = __uint_as_float(hv0.w & 0xFFFF0000u);
            hx[8] = __uint_as_float(hv1.x << 16); hx[9] = __uint_as_float(hv1.x & 0xFFFF0000u); hx[10] = __uint_as_float(hv1.y << 16); hx[11] = __uint_as_float(hv1.y & 0xFFFF0000u);
            hx[12] = __uint_as_float(hv1.z << 16); hx[13] = __uint_as_float(hv1.z & 0xFFFF0000u); hx[14] = __uint_as_float(hv1.w << 16); hx[15] = __uint_as_float(hv1.w & 0xFFFF0000u);
            float myw = 0.f;
#pragma unroll
            for (int j = 0; j < 8; ++j) {
                const uint4 w0 = ww[j][0], w1 = ww[j][1];
                float d = hx[0] * __uint_as_float(w0.x << 16) + hx[1] * __uint_as_float(w0.x & 0xFFFF0000u) + hx[2] * __uint_as_float(w0.y << 16) + hx[3] * __uint_as_float(w0.y & 0xFFFF0000u)
                        + hx[4] * __uint_as_float(w0.z << 16) + hx[5] * __uint_as_float(w0.z & 0xFFFF0000u) + hx[6] * __uint_as_float(w0.w << 16) + hx[7] * __uint_as_float(w0.w & 0xFFFF0000u)
                        + hx[8] * __uint_as_float(w1.x << 16) + hx[9] * __uint_as_float(w1.x & 0xFFFF0000u) + hx[10] * __uint_as_float(w1.y << 16) + hx[11] * __uint_as_float(w1.y & 0xFFFF0000u)
                        + hx[12] * __uint_as_float(w1.z << 16) + hx[13] * __uint_as_float(w1.z & 0xFFFF0000u) + hx[14] * __uint_as_float(w1.w << 16) + hx[15] * __uint_as_float(w1.w & 0xFFFF0000u);
                d = wave_sum_fast(d);
                myw = (lane == j) ? d : myw;
            }
            if (lane < 8) whead[(size_t)n * 8 + lane] = myw * x.rs * 0.04419417382415922f;
        }
    }
}

typedef short s16x4 __attribute__((ext_vector_type(4)));
__device__ __forceinline__ unsigned f2h_bits(float f) { const _Float16 h = (_Float16)f; unsigned short u; __builtin_memcpy(&u, &h, 2); return u; }
template <bool IMPORT_SEL>
__device__ void phase_dsa(const Params& p, int l, unsigned char* lds, bf16_t* yc, const unsigned short* gsel, const int* gnsel, int tb, int te, int tstep) {
    unsigned short* s_sc = (unsigned short*)lds;
    bf16_t* s_qi = (bf16_t*)(lds + 66048);
    bf16_t* s_Q = (bf16_t*)lds;
    unsigned short* s_sel = (unsigned short*)(lds + 82432 + 65536);
    int* s_nsel = (int*)(lds + 82432 + 65536 + 8192);
    unsigned char* dob = OUTB(p);
    const bf16_t* cqn = (const bf16_t*)(dob + DO_CQN);
    const bf16_t* kv = (const bf16_t*)(dob + DO_KV);
    const bf16_t* kidx = (const bf16_t*)(dob + DO_KIDX);
    const float* whead = (const float*)(dob + DO_WHEAD);
    const float* ctab = (const float*)(WS(p) + OFF_ROPE);
    const float* stab = ctab + TS * 16;
    const bf16_t* wb = (const bf16_t*)(WS(p) + OFF_WB);
    const bf16_t* wqiT = wb + WB_QI;
    const bf16_t* wuqT = wb + WB_UQ;
    const bf16_t* wuk = wb + WB_UK;
    const bf16_t* wuvT = wb + WB_UV;
    const float scale = 0.10206207261596575f;
    const f32x4 z4 = {0.f, 0.f, 0.f, 0.f};
    bf16_t* gq = (obid() < QS_WS) ? (bf16_t*)(WS(p) + WS_END + (size_t)obid() * QS_BYTES) : (bf16_t*)(OUTB(p) + DO_END + (size_t)(obid() - QS_WS) * QS_BYTES);
    for (int pair = tb; pair < te; pair += tstep) {
        const int qt = 128 - (pair >> 2);
        const int t0 = qt * 16;
#pragma unroll 1
        for (int half = 0; half < 2; ++half) {
        const int tid = otid(), lane = tid & 63, wid = tid >> 6, fr = lane & 15, fq = lane >> 4;
        unsigned char* s_Vw = lds + 82432 + wid * 8192;
        bf16_t* s_qn = (bf16_t*)s_Vw;
        const int b = (pair & 3) * 2 + half;
        const size_t n0 = (size_t)b * TS + t0;
        {
            bf16x8 acq[8];
#pragma unroll
            for (int kk = 0; kk < 8; ++kk) acq[kk] = *(const bf16x8*)(cqn + (n0 + fr) * 256 + kk * 32 + fq * 8);
            f32x4 c[4] = {z4, z4, z4, z4};
#pragma unroll
            for (int kb = 0; kb < 8; kb += 4) {
                bf16x8 bf[4][4];
#pragma unroll
                for (int k4 = 0; k4 < 4; ++k4)
#pragma unroll
                    for (int nt = 0; nt < 4; ++nt) bf[k4][nt] = *(const bf16x8*)(wqiT + (size_t)(wid * 64 + nt * 16 + fr) * 256 + (kb + k4) * 32 + fq * 8);
#pragma unroll
                for (int k4 = 0; k4 < 4; ++k4)
#pragma unroll
                    for (int nt = 0; nt < 4; ++nt) c[nt] = __builtin_amdgcn_mfma_f32_16x16x32_bf16(acq[kb + k4], bf[k4][nt], c[nt], 0, 0, 0);
            }
#pragma unroll
            for (int j = 0; j < 4; ++j) {
                const int t = t0 + fq * 4 + j;
                const float cs = ctab[t * 16 + fr], sn = stab[t * 16 + fr];
                const float x1 = c[0][j], x2 = c[1][j];
                c[0][j] = x1 * cs - x2 * sn; c[1][j] = x2 * cs + x1 * sn;
            }
#pragma unroll
            for (int nt = 0; nt < 4; ++nt)
#pragma unroll
                for (int j = 0; j < 4; ++j) s_qi[(fq * 4 + j) * 512 + wid * 64 + nt * 16 + fr] = f2bf(c[nt][j]);
        }
        __syncthreads();
        if (!IMPORT_SEL) {
            bf16x8 aq[8][2];
#pragma unroll
            for (int h = 0; h < 8; ++h)
#pragma unroll
                for (int ks = 0; ks < 2; ++ks) aq[h][ks] = *(const bf16x8*)(s_qi + fr * 512 + h * 64 + ks * 32 + fq * 8);
            float wh[4][8];
#pragma unroll
            for (int j = 0; j < 4; ++j) {
                const float4 w0 = *(const float4*)(whead + (n0 + fq * 4 + j) * 8), w1 = *(const float4*)(whead + (n0 + fq * 4 + j) * 8 + 4);
                wh[j][0] = w0.x; wh[j][1] = w0.y; wh[j][2] = w0.z; wh[j][3] = w0.w; wh[j][4] = w1.x; wh[j][5] = w1.y; wh[j][6] = w1.z; wh[j][7] = w1.w;
            }
            const int nkt = qt + 1;
            bf16x8 nb0 = {0, 0, 0, 0, 0, 0, 0, 0}, nb1 = nb0;
            if (wid < nkt) { const bf16_t* kr0 = kidx + ((size_t)b * TS + wid * 16 + fr) * 64 + fq * 8; nb0 = *(const bf16x8*)kr0; nb1 = *(const bf16x8*)(kr0 + 32); }
#pragma unroll 1
            for (int kt = wid; kt < nkt; kt += 8) {
                const bf16x8 bk0 = nb0, bk1 = nb1;
                if (kt + 8 < nkt) { const bf16_t* krn = kidx + ((size_t)b * TS + (kt + 8) * 16 + fr) * 64 + fq * 8; nb0 = *(const bf16x8*)krn; nb1 = *(const bf16x8*)(krn + 32); }
                float I[4] = {0.f, 0.f, 0.f, 0.f};
#pragma unroll
                for (int h = 0; h < 8; ++h) {
                    f32x4 a = __builtin_amdgcn_mfma_f32_16x16x32_bf16(aq[h][0], bk0, z4, 0, 0, 0);
                    a = __builtin_amdgcn_mfma_f32_16x16x32_bf16(aq[h][1], bk1, a, 0, 0, 0);
#pragma unroll
                    for (int j = 0; j < 4; ++j) I[j] += wh[j][h] * fmaxf(a[j], 0.f);
                }
#pragma unroll
                for (int j = 0; j < 4; ++j) s_sc[(fq * 4 + j) * 2064 + kt * 16 + fr] = (unsigned short)f2h_bits(I[j]);
            }
        }
        __syncthreads();
#pragma unroll 1
        for (int qi2 = 0; qi2 < 2; ++qi2) {
            const int q = wid + qi2 * 8;
            const int nadm = t0 + q + 1;
            unsigned short* sel = s_sel + q * 256;
            if (IMPORT_SEL) {
                const int ns = gnsel[n0 + q];
                for (int i = lane; i < ns; i += 64) sel[i] = gsel[(n0 + q) * 256 + i];
                if (lane == 0) s_nsel[q] = ns;
            } else if (nadm <= 256) {
                for (int i = lane; i < nadm; i += 64) sel[i] = (unsigned short)i;
                if (lane == 0) s_nsel[q] = nadm;
            } else {
                unsigned* hist = (unsigned*)(lds + 82432 + wid * 8192);
                const unsigned short* scq = s_sc + q * 2064;
                const int nch = (nadm + 63) >> 6;
                unsigned B1 = 0u; int na1 = 0, na2 = 0; unsigned T = 0u;
#pragma unroll 1
                for (int pass = 0; pass < 2; ++pass) {
                    *(uint4*)(hist + lane * 4) = make_uint4(0u, 0u, 0u, 0u);
#pragma unroll 1
                    for (int c0 = 0; c0 < nch; c0 += 8) {
                        unsigned kb[8];
#pragma unroll
                        for (int j = 0; j < 8; ++j) { const int s_ = (c0 + j) * 64 + lane; kb[j] = (s_ < nadm) ? (unsigned)scq[s_] : 0x10000u; }
#pragma unroll
                        for (int j = 0; j < 8; ++j) {
                            const unsigned u = kb[j];
                            const unsigned k = (u & 0x8000u) ? (~u & 0xFFFFu) : (u | 0x8000u);
                            const bool ok = (u < 0x10000u) && (pass == 0 || (k >> 8) == B1);
                            if (ok) atomicAdd(hist + (pass == 0 ? (k >> 8) : (k & 255u)), 1u);
                        }
                    }
                    const int need = 256 - na1;
                    const uint4 h4 = *(const uint4*)(hist + lane * 4);
                    const int sl = (int)(h4.x + h4.y + h4.z + h4.w);
                    int suf = sl;
#pragma unroll
                    for (int o = 1; o < 64; o <<= 1) { const int t_ = __shfl_down(suf, o); suf += (lane + o < 64) ? t_ : 0; }
                    const int above = suf - sl;
                    const bool mine = (suf >= need) && (above < need);
                    int a = above, bsel, asel;
                    if (a + (int)h4.w >= need) { bsel = 3; asel = a; }
                    else { a += (int)h4.w;
                        if (a + (int)h4.z >= need) { bsel = 2; asel = a; }
                        else { a += (int)h4.z;
                            if (a + (int)h4.y >= need) { bsel = 1; asel = a; }
                            else { a += (int)h4.y; bsel = 0; asel = a; } } }
                    const int src = __ffsll((long long)__ballot(mine)) - 1;
                    const unsigned bin = (unsigned)__shfl(lane * 4 + bsel, src); const int nab = __shfl(asel, src);
                    if (pass == 0) { B1 = bin; na1 = nab; } else { T = (B1 << 8) | bin; na2 = nab; }
                }
                {
                    const int rties = 256 - (na1 + na2);
                    int base = 0, ties = 0;
                    const unsigned long long ltmask = (1ull << lane) - 1ull;
#pragma unroll 1
                    for (int c0 = 0; c0 < nch; c0 += 4) {
                        unsigned kb[4];
#pragma unroll
                        for (int j = 0; j < 4; ++j) { const int s_ = (c0 + j) * 64 + lane; kb[j] = (s_ < nadm) ? (unsigned)scq[s_] : 0x10000u; }
#pragma unroll
                        for (int j = 0; j < 4; ++j) {
                            const int s_ = (c0 + j) * 64 + lane;
                            const unsigned u = kb[j];
                            const bool valid = u < 0x10000u;
                            const unsigned k = (u & 0x8000u) ? (~u & 0xFFFFu) : (u | 0x8000u);
                            const bool gt = valid && k > T, eq = valid && k == T;
                            const unsigned long long em = __ballot(eq);
                            const int myrank = ties + __popcll(em & ltmask);
                            const bool take = gt || (eq && myrank < rties);
                            const unsigned long long tm = __ballot(take);
                            const int pos = base + __popcll(tm & ltmask);
                            if (take && pos < 256) sel[pos] = (unsigned short)s_;
                            base += __popcll(tm); ties += __popcll(em);
                        }
                    }
                }
                if (lane == 0) s_nsel[q] = 256;
            }
        }
        __syncthreads();
        if (half == 0) {
            const size_t n0B = n0 + TS;
            bf16_t* s_qnB = s_qn + 1024;
#pragma unroll 1
            for (int hi = 0; hi < 2; ++hi) {
                const int hh = wid * 2 + hi;
                const bf16_t* caA = cqn + (n0 + fr) * 256 + fq * 8;
                const bf16_t* caB = cqn + (n0B + fr) * 256 + fq * 8;
                f32x4 cA[6] = {z4, z4, z4, z4, z4, z4}, cB[6] = {z4, z4, z4, z4, z4, z4};
#pragma unroll
                for (int kb = 0; kb < 8; kb += 2) {
                    bf16x8 bf[2][6], aA[2], aB[2];
#pragma unroll
                    for (int k2 = 0; k2 < 2; ++k2) {
                        aA[k2] = *(const bf16x8*)(caA + (kb + k2) * 32); aB[k2] = *(const bf16x8*)(caB + (kb + k2) * 32);
#pragma unroll
                        for (int nt = 0; nt < 6; ++nt) bf[k2][nt] = *(const bf16x8*)(wuqT + (size_t)(hh * 96 + nt * 16 + fr) * 256 + (kb + k2) * 32 + fq * 8);
                    }
#pragma unroll
                    for (int k2 = 0; k2 < 2; ++k2)
#pragma unroll
                        for (int nt = 0; nt < 6; ++nt) {
                            cA[nt] = __builtin_amdgcn_mfma_f32_16x16x32_bf16(aA[k2], bf[k2][nt], cA[nt], 0, 0, 0);
                            cB[nt] = __builtin_amdgcn_mfma_f32_16x16x32_bf16(aB[k2], bf[k2][nt], cB[nt], 0, 0, 0);
                        }
                }
#pragma unroll
                for (int j = 0; j < 4; ++j) {
                    const int q = fq * 4 + j, t = t0 + q;
                    const float cs = ctab[t * 16 + fr], sn = stab[t * 16 + fr];
                    s_Q[(q * 16 + hh) * 160 + 128 + fr] = f2bf(cA[4][j] * cs - cA[5][j] * sn);
                    s_Q[(q * 16 + hh) * 160 + 144 + fr] = f2bf(cA[5][j] * cs + cA[4][j] * sn);
                    gq[(q * 16 + hh) * 160 + 128 + fr] = f2bf(cB[4][j] * cs - cB[5][j] * sn);
                    gq[(q * 16 + hh) * 160 + 144 + fr] = f2bf(cB[5][j] * cs + cB[4][j] * sn);
#pragma unroll
                    for (int nt = 0; nt < 4; ++nt) { s_qn[q * 64 + nt * 16 + fr] = f2bf(cA[nt][j]); s_qnB[q * 64 + nt * 16 + fr] = f2bf(cB[nt][j]); }
                }
                __syncthreads();
                bf16x8 anA[2], anB[2];
#pragma unroll
                for (int ks = 0; ks < 2; ++ks) { anA[ks] = *(const bf16x8*)(s_qn + fr * 64 + ks * 32 + fq * 8); anB[ks] = *(const bf16x8*)(s_qnB + fr * 64 + ks * 32 + fq * 8); }
                bf16x8 bwk[8][2];
#pragma unroll
                for (int nt = 0; nt < 8; ++nt)
#pragma unroll
                    for (int ks = 0; ks < 2; ++ks) bwk[nt][ks] = *(const bf16x8*)(wuk + (size_t)(hh * 128 + nt * 16 + fr) * 64 + ks * 32 + fq * 8);
#pragma unroll
                for (int nt = 0; nt < 8; ++nt) {
                    f32x4 aA = z4, aB = z4;
#pragma unroll
                    for (int ks = 0; ks < 2; ++ks) {
                        aA = __builtin_amdgcn_mfma_f32_16x16x32_bf16(anA[ks], bwk[nt][ks], aA, 0, 0, 0);
                        aB = __builtin_amdgcn_mfma_f32_16x16x32_bf16(anB[ks], bwk[nt][ks], aB, 0, 0, 0);
                    }
#pragma unroll
                    for (int j = 0; j < 4; ++j) {
                        s_Q[((fq * 4 + j) * 16 + hh) * 160 + nt * 16 + fr] = f2bf(aA[j]);
                        gq[((fq * 4 + j) * 16 + hh) * 160 + nt * 16 + fr] = f2bf(aB[j]);
                    }
                }
                __syncthreads();
            }
        } else {
            for (int e = tid; e < QS_BYTES / 16; e += NTHR) ((uint4*)s_Q)[e] = ((const uint4*)gq)[e];
            __syncthreads();
        }
#pragma unroll 1
        for (int qi2 = 0; qi2 < 2; ++qi2) {
            const int q = wid + qi2 * 8;
            bf16x8 bq[5];
#pragma unroll
            for (int ks = 0; ks < 5; ++ks) bq[ks] = *(const bf16x8*)(s_Q + (q * 16 + fr) * 160 + ks * 32 + fq * 8);
            const int nsel = s_nsel[q];
            const unsigned short* sel = s_sel + q * 256;
            float m = -INFINITY, lsum = 0.f;
            f32x4 O[8] = {z4, z4, z4, z4, z4, z4, z4, z4};
            const int nchunk = (nsel + 31) >> 5;
            bf16x8 akn[2][5];
#pragma unroll
            for (int mt = 0; mt < 2; ++mt) {
                const int ki = mt * 16 + fr;
                const int sidx = sel[ki < nsel ? ki : 0];
                const bf16_t* krow = kv + ((size_t)b * TS + sidx) * 160 + fq * 8;
#pragma unroll
                for (int ks = 0; ks < 5; ++ks) akn[mt][ks] = *(const bf16x8*)(krow + ks * 32);
            }
#pragma unroll 1
            for (int ch = 0; ch < nchunk; ++ch) {
                bf16x8 ak[2][5];
#pragma unroll
                for (int mt = 0; mt < 2; ++mt)
#pragma unroll
                    for (int ks = 0; ks < 5; ++ks) ak[mt][ks] = akn[mt][ks];
                if (ch + 1 < nchunk) {
#pragma unroll
                    for (int mt = 0; mt < 2; ++mt) {
                        const int ki = (ch + 1) * 32 + mt * 16 + fr;
                        const int sidx = sel[ki < nsel ? ki : 0];
                        const bf16_t* krow = kv + ((size_t)b * TS + sidx) * 160 + fq * 8;
#pragma unroll
                        for (int ks = 0; ks < 5; ++ks) akn[mt][ks] = *(const bf16x8*)(krow + ks * 32);
                    }
                }
#pragma unroll
                for (int mt = 0; mt < 2; ++mt)
#pragma unroll
                    for (int ks = 0; ks < 4; ++ks) {
                        const int r = mt * 16 + fr;
                        *(bf16x8*)(s_Vw + r * 256 + (((ks * 2 + (fq >> 1)) ^ (r & 7)) * 32) + (fq & 1) * 16) = ak[mt][ks];
                    }
                f32x4 st[2] = {z4, z4};
#pragma unroll
                for (int mt = 0; mt < 2; ++mt)
#pragma unroll
                    for (int ks = 0; ks < 5; ++ks) st[mt] = __builtin_amdgcn_mfma_f32_16x16x32_bf16(ak[mt][ks], bq[ks], st[mt], 0, 0, 0);
                float sv[2][4]; float cmax = -INFINITY;
#pragma unroll
                for (int mt = 0; mt < 2; ++mt)
#pragma unroll
                    for (int j = 0; j < 4; ++j) {
                        const int ke = ch * 32 + mt * 16 + fq * 4 + j;
                        const float s_ = (ke < nsel) ? st[mt][j] * scale : -INFINITY;
                        sv[mt][j] = s_; cmax = fmaxf(cmax, s_);
                    }
                cmax = fmaxf(cmax, __shfl_xor(cmax, 16)); cmax = fmaxf(cmax, __shfl_xor(cmax, 32));
                const float mnew = fmaxf(m, cmax);
                const float alpha = __expf(m - mnew);
                float psum = 0.f;
#pragma unroll
                for (int mt = 0; mt < 2; ++mt)
#pragma unroll
                    for (int j = 0; j < 4; ++j) { const float pe = __expf(sv[mt][j] - mnew); sv[mt][j] = pe; psum += pe; }
                psum += __shfl_xor(psum, 16); psum += __shfl_xor(psum, 32);
                lsum = lsum * alpha + psum; m = mnew;
#pragma unroll
                for (int ct = 0; ct < 8; ++ct) O[ct] = O[ct] * alpha;
                bf16x8 pf;
#pragma unroll
                for (int mt = 0; mt < 2; ++mt)
#pragma unroll
                    for (int j = 0; j < 4; ++j) pf[mt * 4 + j] = (short)f2bf(sv[mt][j]);
                const int q_ = fr >> 2, p_ = fr & 3;
                const int r0 = fq * 4 + q_, r1 = 16 + r0;
#pragma unroll
                for (int ct = 0; ct < 8; ++ct) {
                    const s16x4 v0 = __builtin_amdgcn_ds_read_tr16_b64_v4i16((__attribute__((address_space(3))) s16x4*)(s_Vw + r0 * 256 + ((ct ^ (r0 & 7)) * 32) + p_ * 8));
                    const s16x4 v1 = __builtin_amdgcn_ds_read_tr16_b64_v4i16((__attribute__((address_space(3))) s16x4*)(s_Vw + r1 * 256 + ((ct ^ (r1 & 7)) * 32) + p_ * 8));
                    bf16x8 av; av[0] = v0[0]; av[1] = v0[1]; av[2] = v0[2]; av[3] = v0[3]; av[4] = v1[0]; av[5] = v1[1]; av[6] = v1[2]; av[7] = v1[3];
                    O[ct] = __builtin_amdgcn_mfma_f32_16x16x32_bf16(av, pf, O[ct], 0, 0, 0);
                }
            }
            const float inv = 1.0f / lsum;
#pragma unroll
            for (int ct = 0; ct < 8; ++ct)
#pragma unroll
                for (int j = 0; j < 4; ++j) s_Q[(q * 16 + fr) * 160 + ct * 16 + fq * 4 + j] = f2bf(O[ct][j] * inv);
        }
        __syncthreads();
#pragma unroll 1
        for (int hi = 0; hi < 2; ++hi) {
            const int hh = wid * 2 + hi;
            bf16x8 ao[4];
#pragma unroll
            for (int ks = 0; ks < 4; ++ks) ao[ks] = *(const bf16x8*)(s_Q + (fr * 16 + hh) * 160 + ks * 32 + fq * 8);
#pragma unroll
            for (int nt = 0; nt < 4; ++nt) {
                f32x4 a = z4;
#pragma unroll
                for (int ks = 0; ks < 4; ++ks)
                    a = __builtin_amdgcn_mfma_f32_16x16x32_bf16(ao[ks], *(const bf16x8*)(wuvT + (size_t)(hh * 64 + nt * 16 + fr) * 128 + ks * 32 + fq * 8), a, 0, 0, 0);
#pragma unroll
                for (int j = 0; j < 4; ++j) yc[(n0 + fq * 4 + j) * 1024 + hh * 64 + nt * 16 + fr] = f2bf(a[j]);
            }
        }
        __syncthreads();
        }
    }
}


__device__ void phase_lr_prep(const Params& p, int l) {
    const int lane = otid() & 63;
    const int wave = (obid() * NTHR + otid()) >> 6, nw = gridDim.x * NTHR / 64;
    const bf16_t* pm = (const bf16_t*)(WS(p) + OFF_PMISC);
    bf16_t* alr = (bf16_t*)(OUTB(p) + DO_ALR);
    const float4 mu4 = *(const float4*)(p.in[4] + (size_t)l * 3328 + 3072 + lane * 4);
    const float4 vm4 = *(const float4*)(p.in[18] + (lane & 7) * 4);
    struct In { uint2 c0, p0, c1, p1; };
    auto load = [&](int n) {
        In r;
        const bf16_t* row = pm + (size_t)n * PM_LD;
        const bool hp = (n % TS) > 0;
        r.c0 = *(const uint2*)(row + lane * 4);
        r.p0 = hp ? *(const uint2*)(row - PM_LD + lane * 4) : make_uint2(0u, 0u);
        r.c1 = make_uint2(0u, 0u); r.p1 = r.c1;
        if (lane < 8) { r.c1 = *(const uint2*)(row + 256 + lane * 4); if (hp) r.p1 = *(const uint2*)(row - PM_LD + 256 + lane * 4); }
        return r;
    };
    auto mix4 = [&](const uint2 c, const uint2 q, const float4 m, float (&o)[4]) {
        const float c0 = __uint_as_float(c.x << 16), c1 = __uint_as_float(c.x & 0xFFFF0000u), c2 = __uint_as_float(c.y << 16), c3 = __uint_as_float(c.y & 0xFFFF0000u);
        const float q0 = __uint_as_float(q.x << 16), q1 = __uint_as_float(q.x & 0xFFFF0000u), q2 = __uint_as_float(q.y << 16), q3 = __uint_as_float(q.y & 0xFFFF0000u);
        o[0] = c0 + (q0 - c0) * m.x; o[1] = c1 + (q1 - c1) * m.y; o[2] = c2 + (q2 - c2) * m.z; o[3] = c3 + (q3 - c3) * m.w;
    };
    In cur = load(wave < NT ? wave : 0);
    for (int n = wave; n < NT; n += nw) {
        const In x = cur;
        if (n + nw < NT) cur = load(n + nw);
        float o[4];
        mix4(x.c0, x.p0, mu4, o);
        if (lane < 16) { o[0] = tanhf(o[0]); o[1] = tanhf(o[1]); o[2] = tanhf(o[2]); o[3] = tanhf(o[3]); }
        else if (lane >= 32) { o[0] = sigmoidf_(o[0]); o[1] = sigmoidf_(o[1]); o[2] = sigmoidf_(o[2]); o[3] = sigmoidf_(o[3]); }
        *(uint2*)(alr + (size_t)n * 288 + lane * 4) = pack4(o[0], o[1], o[2], o[3]);
        if (lane < 8) {
            mix4(x.c1, x.p1, vm4, o);
            *(uint2*)(alr + (size_t)n * 288 + 256 + lane * 4) = pack4(o[0], o[1], o[2], o[3]);
        }
    }
}

typedef short sh4 __attribute__((ext_vector_type(4)));
__device__ __forceinline__ sh4 pk4v(const f32x4& v) { const uint2 u = pack4(v[0], v[1], v[2], v[3]); sh4 r; __builtin_memcpy(&r, &u, 8); return r; }
__device__ __forceinline__ bf16x8 cat8(const sh4& a, const sh4& b) { bf16x8 r; r[0] = a[0]; r[1] = a[1]; r[2] = a[2]; r[3] = a[3]; r[4] = b[0]; r[5] = b[1]; r[6] = b[2]; r[7] = b[3]; return r; }
#define MF32(a, b, c) __builtin_amdgcn_mfma_f32_16x16x32_bf16(a, b, c, 0, 0, 0)
#define MF16(a, b, c) MF32(cat8(a, sh4{0, 0, 0, 0}), cat8(b, sh4{0, 0, 0, 0}), c)
constexpr int SC_LT = 72;
constexpr int SC_LS = 36;
constexpr int SC_TC = 32;
constexpr int SC_ROWB = 1088;
__device__ __forceinline__ const unsigned char* scan_piece_src(const Params& p, int l, int b, int hc, int t0, int pi, bool& ok) {
    const int tau = pi / 68, seg = pi - tau * 68;
    const int t = t0 + tau;
    ok = (t < TS) && (tau < SC_TC);
    const size_t n = (size_t)b * TS + t;
    const unsigned char* ws = WS(p);
    if (seg < 8) return ws + OFF_PR + (n * 1024 + hc) * 2 + seg * 16;
    if (seg < 16) return ws + OFF_PK + (n * 1024 + hc) * 2 + (seg - 8) * 16;
    if (seg < 24) return ws + OFF_PV + (n * 1024 + hc) * 2 + (seg - 16) * 16;
    if (seg < 60) return OUTB(p) + DO_ALR + (n * 288) * 2 + (seg - 24) * 16;
    ok = ok && (l > 0);
    return ws + OFF_VFIRST + (n * 1024 + hc) * 2 + (seg - 60) * 16;
}
__device__ void phase_scan5(const Params& p, int l, unsigned char* lds, int blk) {
    const int tid = otid(), lane = tid & 63, wid = tid >> 6, fr = lane & 15, fq = lane >> 4;
    const int b = blk >> 4, hh = blk & 15, hc = hh * 64;
    float* s_r = (float*)lds;
    float* s_w = s_r + 2048;
    float* s_k = s_w + 2048;
    float* s_v = s_k + 2048;
    float* s_a = s_v + 2048;
    float* s_b = s_a + 2048;
    float* s_g = s_b + 2048;
    float* s_o = s_g + 2048;
    bf16_t* o_at = (bf16_t*)(s_o + 2048);
    bf16_t* o_rt = o_at + 32 * SC_LT;
    bf16_t* o_bt = o_rt + 32 * SC_LT;
    bf16_t* o_kt = o_bt + 32 * SC_LT;
    bf16_t* o_bT = o_kt + 32 * SC_LT;
    bf16_t* o_kT = o_bT + 64 * SC_LS;
    bf16_t* o_vT = o_kT + 64 * SC_LS;
    float* s_gc = (float*)(o_vT + 64 * SC_LS);
    unsigned char* raw = (unsigned char*)(s_gc + 128);
    float* prevb = (float*)(raw + 32 * SC_ROWB);
    unsigned* prevr = (unsigned*)prevb;
    float* s_bs = s_r;
    float* cst = prevb + 960;
    const float* mu = p.in[4] + (size_t)l * 3328;
    for (int e = tid; e < 480; e += NTHR) {
        float v;
        if (e < 192) v = mu[(e >> 6) * 1024 + hc + (e & 63)];
        else if (e < 448) v = mu[3072 + (e - 192)];
        else v = p.in[18][e - 448];
        cst[e] = v;
    }
    if (tid < 64) {
        cst[480 + tid] = p.in[7][l * 1024 + hc + tid];
        cst[544 + tid] = p.in[9][l * 1024 + hc + tid];
        cst[608 + tid] = p.in[12][l * 1024 + hc + tid];
        cst[672 + tid] = p.in[13][l * 1024 + hc + tid];
        cst[736 + tid] = p.in[14][l * 1024 + hc + tid];
        cst[800 + tid] = p.in[15][l * 1024 + hc + tid];
        cst[864 + tid] = p.in[16][l * 1024 + hc + tid];
        cst[928 + tid] = p.in[19][hc + tid];
    }
    const int mm = wid >> 1, ntb = (wid & 1) * 2;
    const int nks = (mm == 2) ? 4 : (mm == 3 ? 1 : 2);
    bf16x8 Bw[2][4];
    {
        const float* wsrc = (mm == 0) ? p.in[8] + (size_t)l * 64 * 1024 : (mm == 1) ? p.in[10] + (size_t)l * 64 * 1024 : (mm == 2) ? p.in[11] + (size_t)l * 128 * 1024 : p.in[20];
#pragma unroll
        for (int n2 = 0; n2 < 2; ++n2)
#pragma unroll
            for (int ks = 0; ks < 4; ++ks) {
                bf16x8 f;
#pragma unroll
                for (int j = 0; j < 8; ++j) {
                    const bool okw = ks < nks && (mm < 3 || l > 0);
                    const float v = wsrc[(size_t)(okw ? (ks * 32 + fq * 8 + j) : 0) * 1024 + hc + (ntb + n2) * 16 + fr];
                    f[j] = (short)f2bf(okw ? v : 0.f);
                }
                Bw[n2][ks] = f;
            }
    }
    const f32x4 z4 = {0.f, 0.f, 0.f, 0.f};
    f32x4 S[4] = {z4, z4, z4, z4};
    sh4 Lf;
#pragma unroll
    for (int j = 0; j < 4; ++j) Lf[j] = (fq * 4 + j <= fr) ? (short)0x3F80 : (short)0;
    bf16_t* Pr = (bf16_t*)(WS(p) + OFF_PR);
    bf16_t* vfirst = (bf16_t*)(WS(p) + OFF_VFIRST);
    const unsigned char* psrc[5]; int pstep[5], ptau[5]; bool pval[5];
#pragma unroll
    for (int k = 0; k < 5; ++k) {
        const int pi = tid + k * NTHR;
        bool ok = false;
        psrc[k] = scan_piece_src(p, l, b, hc, 0, pi < SC_TC * 68 ? pi : 0, ok);
        const int tau = (pi < SC_TC * 68 ? pi : 0) / 68, seg = (pi < SC_TC * 68 ? pi : 0) - tau * 68;
        ptau[k] = tau;
        pstep[k] = SC_TC * ((seg >= 24 && seg < 60) ? 576 : 2048);
        pval[k] = (pi < SC_TC * 68) && !(seg >= 60 && l == 0);
    }
    uint4 pre[5];
#pragma unroll
    for (int k = 0; k < 5; ++k) { pre[k] = make_uint4(0, 0, 0, 0); if (pval[k] && ptau[k] < TS) pre[k] = *(const uint4*)psrc[k]; }
    __syncthreads();
#pragma unroll 1
    for (int t0 = 0, ch = 0; t0 < TS; t0 += SC_TC, ++ch) {
        const int nval = (TS - t0 < SC_TC) ? (TS - t0) : SC_TC;
#pragma unroll
        for (int k = 0; k < 5; ++k) { const int pi = tid + k * NTHR; if (pi < SC_TC * 68) *(uint4*)(raw + pi * 16) = pre[k]; }
        lds_barrier();
#pragma unroll
        for (int k = 0; k < 5; ++k) {
            pre[k] = make_uint4(0, 0, 0, 0);
            if (pval[k] && t0 + SC_TC + ptau[k] < TS) pre[k] = *(const uint4*)(psrc[k] + (size_t)(ch + 1) * pstep[k]);
        }
        if (mm < 3 || l > 0) {
            const unsigned char* Ab = raw + ((mm == 0) ? 384 : (mm == 1) ? 512 : (mm == 2) ? 640 : 896);
            float* dst = (mm == 0) ? s_w : (mm == 1) ? s_a : (mm == 2) ? s_g : s_o;
#pragma unroll
            for (int m = 0; m < 2; ++m) {
                f32x4 acc0 = {0.f, 0.f, 0.f, 0.f}, acc1 = {0.f, 0.f, 0.f, 0.f};
#pragma unroll
                for (int ks = 0; ks < 4; ++ks) {
                    if (ks < nks) {
                        const bf16x8 a = *(const bf16x8*)(Ab + (m * 16 + fr) * SC_ROWB + ks * 64 + fq * 16);
                        acc0 = __builtin_amdgcn_mfma_f32_16x16x32_bf16(a, Bw[0][ks], acc0, 0, 0, 0);
                        acc1 = __builtin_amdgcn_mfma_f32_16x16x32_bf16(a, Bw[1][ks], acc1, 0, 0, 0);
                    }
                }
                if (mm == 0) {
                    const float cw0 = cst[480 + ntb * 16 + fr], cw1 = cst[480 + (ntb + 1) * 16 + fr];
                    f32x4 l0, l1, r0, r1;
#pragma unroll
                    for (int j = 0; j < 4; ++j) { l0[j] = -0.6065306597126334f * fast_sigmoid(acc0[j] + cw0); l1[j] = -0.6065306597126334f * fast_sigmoid(acc1[j] + cw1); }
                    const uint2 h0 = pack4(l0[0], l0[1], l0[2], l0[3]), h1 = pack4(l1[0], l1[1], l1[2], l1[3]);
                    r0[0] = l0[0] - __uint_as_float(h0.x << 16); r0[1] = l0[1] - __uint_as_float(h0.x & 0xFFFF0000u); r0[2] = l0[2] - __uint_as_float(h0.y << 16); r0[3] = l0[3] - __uint_as_float(h0.y & 0xFFFF0000u);
                    r1[0] = l1[0] - __uint_as_float(h1.x << 16); r1[1] = l1[1] - __uint_as_float(h1.x & 0xFFFF0000u); r1[2] = l1[2] - __uint_as_float(h1.y << 16); r1[3] = l1[3] - __uint_as_float(h1.y & 0xFFFF0000u);
                    sh4 hh0, hh1; __builtin_memcpy(&hh0, &h0, 8); __builtin_memcpy(&hh1, &h1, 8);
                    f32x4 c0 = MF16(Lf, pk4v(r0), z4), c1 = MF16(Lf, pk4v(r1), z4);
                    c0 = MF16(Lf, hh0, c0); c1 = MF16(Lf, hh1, c1);
#pragma unroll
                    for (int j = 0; j < 4; ++j) {
                        const int eo = (m * 16 + fq * 4 + j) * 64 + ntb * 16 + fr;
                        s_w[eo] = c0[j]; s_w[eo + 16] = c1[j];
                        s_b[eo] = l0[j]; s_b[eo + 16] = l1[j];
                    }
                } else {
#pragma unroll
                    for (int j = 0; j < 4; ++j) {
                        dst[(m * 16 + fq * 4 + j) * 64 + ntb * 16 + fr] = acc0[j];
                        dst[(m * 16 + fq * 4 + j) * 64 + (ntb + 1) * 16 + fr] = acc1[j];
                    }
                }
            }
        }
        lds_barrier();
        {
            const int tau = tid >> 4, c4 = (tid & 15) * 4, e = tau * 64 + c4, t = t0 + tau;
            const size_t n = (size_t)b * TS + t;
            const float4 cum4 = *(const float4*)(s_w + e), lw4 = *(const float4*)(s_b + e), xa4 = *(const float4*)(s_a + e);
            const float4 ca = *(const float4*)(cst + 544 + c4), ckk = *(const float4*)(cst + 608 + c4), cka = *(const float4*)(cst + 672 + c4), crk = *(const float4*)(cst + 736 + c4);
            const float cum[4] = {cum4.x, cum4.y, cum4.z, cum4.w}, lw[4] = {lw4.x, lw4.y, lw4.z, lw4.w};
            const float xa[4] = {xa4.x + ca.x, xa4.y + ca.y, xa4.z + ca.z, xa4.w + ca.w};
            const float kkc[4] = {ckk.x, ckk.y, ckk.z, ckk.w}, kac[4] = {cka.x, cka.y, cka.z, cka.w};
            float rr[4], kr[4], vv[4];
            {
                const unsigned char* rc = raw + tau * SC_ROWB + c4 * 2;
                const uint2 cr = *(const uint2*)rc, ck = *(const uint2*)(rc + 128), cv = *(const uint2*)(rc + 256);
                uint2 qr = make_uint2(0u, 0u), qk = qr, qv = qr;
                if (tau > 0) { qr = *(const uint2*)(rc - SC_ROWB); qk = *(const uint2*)(rc - SC_ROWB + 128); qv = *(const uint2*)(rc - SC_ROWB + 256); }
                else if (t0 > 0) { const unsigned* pvr = prevr + ((ch + 1) & 1) * 96 + (c4 >> 1); qr = *(const uint2*)pvr; qk = *(const uint2*)(pvr + 32); qv = *(const uint2*)(pvr + 64); }
                if (tau == SC_TC - 1) { unsigned* pwr = prevr + (ch & 1) * 96 + (c4 >> 1); *(uint2*)pwr = cr; *(uint2*)(pwr + 32) = ck; *(uint2*)(pwr + 64) = cv; }
                const float4 mr = *(const float4*)(cst + c4), mk = *(const float4*)(cst + 64 + c4), mv = *(const float4*)(cst + 128 + c4);
                const float c_[12] = {__uint_as_float(cr.x << 16), __uint_as_float(cr.x & 0xFFFF0000u), __uint_as_float(cr.y << 16), __uint_as_float(cr.y & 0xFFFF0000u),
                                      __uint_as_float(ck.x << 16), __uint_as_float(ck.x & 0xFFFF0000u), __uint_as_float(ck.y << 16), __uint_as_float(ck.y & 0xFFFF0000u),
                                      __uint_as_float(cv.x << 16), __uint_as_float(cv.x & 0xFFFF0000u), __uint_as_float(cv.y << 16), __uint_as_float(cv.y & 0xFFFF0000u)};
                const float q_[12] = {__uint_as_float(qr.x << 16), __uint_as_float(qr.x & 0xFFFF0000u), __uint_as_float(qr.y << 16), __uint_as_float(qr.y & 0xFFFF0000u),
                                      __uint_as_float(qk.x << 16), __uint_as_float(qk.x & 0xFFFF0000u), __uint_as_float(qk.y << 16), __uint_as_float(qk.y & 0xFFFF0000u),
                                      __uint_as_float(qv.x << 16), __uint_as_float(qv.x & 0xFFFF0000u), __uint_as_float(qv.y << 16), __uint_as_float(qv.y & 0xFFFF0000u)};
                const float m_[12] = {mr.x, mr.y, mr.z, mr.w, mk.x, mk.y, mk.z, mk.w, mv.x, mv.y, mv.z, mv.w};
#pragma unroll
                for (int j = 0; j < 4; ++j) { rr[j] = c_[j] + (q_[j] - c_[j]) * m_[j]; kr[j] = c_[4 + j] + (q_[4 + j] - c_[4 + j]) * m_[4 + j]; vv[j] = c_[8 + j] + (q_[8 + j] - c_[8 + j]) * m_[8 + j]; }
            }
            if (l > 0) {
                const float4 xv4 = *(const float4*)(s_o + e), cv = *(const float4*)(cst + 928 + c4);
                const uint2 vfu = *(const uint2*)(raw + tau * SC_ROWB + 960 + c4 * 2);
                const float vf[4] = {__uint_as_float(vfu.x << 16), __uint_as_float(vfu.x & 0xFFFF0000u), __uint_as_float(vfu.y << 16), __uint_as_float(vfu.y & 0xFFFF0000u)};
                const float xv[4] = {xv4.x + cv.x, xv4.y + cv.y, xv4.z + cv.z, xv4.w + cv.w};
#pragma unroll
                for (int j = 0; j < 4; ++j) vv[j] = vv[j] + (vf[j] - vv[j]) * fast_sigmoid(xv[j]);
            } else if (t < TS) {
                *(uint2*)(vfirst + n * 1024 + hc + c4) = pack4(vv[0], vv[1], vv[2], vv[3]);
            }
            float av[4], kkv[4], ginc[4], gexc[4], ginv[4]; float ss = 0.f;
#pragma unroll
            for (int j = 0; j < 4; ++j) {
                ginc[j] = __expf(cum[j]); gexc[j] = __expf(cum[j] - lw[j]); ginv[j] = __expf(-cum[j]);
                av[j] = fast_sigmoid(xa[j]);
                kkv[j] = kr[j] * kkc[j];
                ss += kkv[j] * kkv[j];
            }
            float kk[4], kt[4];
#pragma unroll
            for (int j = 0; j < 4; ++j) kt[j] = kr[j] * (1.0f + (av[j] - 1.0f) * kac[j]);
            float bsum = rr[0] * kt[0] * crk.x + rr[1] * kt[1] * crk.y + rr[2] * kt[2] * crk.z + rr[3] * kt[3] * crk.w;
            float du0 = 0.f, du1 = 0.f;
            row16_sum4(ss, bsum, du0, du1);
            if ((tid & 15) == 0) s_bs[tau] = bsum;
            const float rn = rsqrtf(fmaxf(ss, 1e-24f));
#pragma unroll
            for (int j = 0; j < 4; ++j) kk[j] = kkv[j] * rn;
            const uint2 pa = pack4(-kk[0] * gexc[0], -kk[1] * gexc[1], -kk[2] * gexc[2], -kk[3] * gexc[3]);
            const uint2 pr = pack4(rr[0] * ginc[0], rr[1] * ginc[1], rr[2] * ginc[2], rr[3] * ginc[3]);
            const uint2 pb = pack4(kk[0] * av[0] * ginv[0], kk[1] * av[1] * ginv[1], kk[2] * av[2] * ginv[2], kk[3] * av[3] * ginv[3]);
            const uint2 pk = pack4(kt[0] * ginv[0], kt[1] * ginv[1], kt[2] * ginv[2], kt[3] * ginv[3]);
            const uint2 pv = pack4(vv[0], vv[1], vv[2], vv[3]);
            *(uint2*)(o_at + tau * SC_LT + c4) = pa;
            *(uint2*)(o_rt + tau * SC_LT + c4) = pr;
            *(uint2*)(o_bt + tau * SC_LT + c4) = pb;
            *(uint2*)(o_kt + tau * SC_LT + c4) = pk;
            o_bT[(c4 + 0) * SC_LS + tau] = (bf16_t)(pb.x & 0xFFFFu); o_bT[(c4 + 1) * SC_LS + tau] = (bf16_t)(pb.x >> 16); o_bT[(c4 + 2) * SC_LS + tau] = (bf16_t)(pb.y & 0xFFFFu); o_bT[(c4 + 3) * SC_LS + tau] = (bf16_t)(pb.y >> 16);
            o_kT[(c4 + 0) * SC_LS + tau] = (bf16_t)(pk.x & 0xFFFFu); o_kT[(c4 + 1) * SC_LS + tau] = (bf16_t)(pk.x >> 16); o_kT[(c4 + 2) * SC_LS + tau] = (bf16_t)(pk.y & 0xFFFFu); o_kT[(c4 + 3) * SC_LS + tau] = (bf16_t)(pk.y >> 16);
            o_vT[(c4 + 0) * SC_LS + tau] = (bf16_t)(pv.x & 0xFFFFu); o_vT[(c4 + 1) * SC_LS + tau] = (bf16_t)(pv.x >> 16); o_vT[(c4 + 2) * SC_LS + tau] = (bf16_t)(pv.y & 0xFFFFu); o_vT[(c4 + 3) * SC_LS + tau] = (bf16_t)(pv.y >> 16);
            if ((tau & 15) == 15) *(float4*)(s_gc + (tau >> 4) * 64 + c4) = make_float4(ginc[0], ginc[1], ginc[2], ginc[3]);
            *(float4*)(s_v + e) = make_float4(vv[0], vv[1], vv[2], vv[3]);
        }
        lds_barrier();
        if (wid < 4) {
#pragma unroll 1
            for (int sc = 0; sc < 2; ++sc) {
                if (sc * 16 < nval) {
                    const bf16_t* ar = o_at + (sc * 16 + fr) * SC_LT;
                    const bf16_t* rr_ = o_rt + (sc * 16 + fr) * SC_LT;
                    const bf16_t* br = o_bt + (sc * 16 + fr) * SC_LT;
                    const bf16_t* kr_ = o_kt + (sc * 16 + fr) * SC_LT;
                    const bf16x8 fa0 = *(const bf16x8*)(ar + fq * 8), fa1 = *(const bf16x8*)(ar + 32 + fq * 8);
                    const bf16x8 fb0 = *(const bf16x8*)(br + fq * 8), fb1 = *(const bf16x8*)(br + 32 + fq * 8);
                    const bf16x8 fk0 = *(const bf16x8*)(kr_ + fq * 8), fk1 = *(const bf16x8*)(kr_ + 32 + fq * 8);
                    const bf16x8 fr0 = *(const bf16x8*)(rr_ + fq * 8), fr1 = *(const bf16x8*)(rr_ + 32 + fq * 8);
                    f32x4 nA = MF32(fb0, fa0, z4); nA = MF32(fb1, fa1, nA);
                    f32x4 nB = MF32(fa0, fb0, z4); nB = MF32(fa1, fb1, nB);
                    f32x4 mak = MF32(fk0, fa0, z4); mak = MF32(fk1, fa1, mak);
                    f32x4 mbr = MF32(fb0, fr0, z4); mbr = MF32(fb1, fr1, mbr);
                    f32x4 mkr = MF32(fk0, fr0, z4); mkr = MF32(fk1, fr1, mkr);
#pragma unroll
                    for (int j = 0; j < 4; ++j) {
                        const int s_ = fq * 4 + j;
                        nA[j] = (s_ < fr) ? nA[j] : 0.f; nB[j] = (fr < s_) ? nB[j] : 0.f; mak[j] = (s_ < fr) ? mak[j] : 0.f;
                        mbr[j] = (s_ <= fr) ? mbr[j] : 0.f; mkr[j] = (s_ <= fr) ? mkr[j] : 0.f;
                    }
                    const sh4 pNA = pk4v(nA), pNB = pk4v(nB), pMak = pk4v(mak), pMbr = pk4v(mbr), pMkr = pk4v(mkr);
                    const f32x4 n2B = MF16(pNA, pNB, z4), n2A = MF16(pNB, pNA, z4);
                    const sh4 pN2A = pk4v(n2A), pN2B = pk4v(n2B);
                    const f32x4 n4B = MF16(pN2A, pN2B, z4), n4A = MF16(pN2B, pN2A, z4);
                    const sh4 pN4A = pk4v(n4A), pN4B = pk4v(n4B);
                    const sh4 pN8A = pk4v(MF16(pN4B, pN4A, z4));
                    const bf16x8 sB0 = cat8(pk4v(S[0]), pk4v(S[1])), sB1 = cat8(pk4v(S[2]), pk4v(S[3]));
                    const sh4 vf = *(const sh4*)(o_vT + (wid * 16 + fr) * SC_LS + sc * 16 + fq * 4);
                    f32x4 X = MF32(cat8(*(const sh4*)(ar + fq * 4), *(const sh4*)(ar + 16 + fq * 4)), sB0, z4);
                    X = MF32(cat8(*(const sh4*)(ar + 32 + fq * 4), *(const sh4*)(ar + 48 + fq * 4)), sB1, X);
                    X = MF16(pMak, vf, X);
                    X = MF16(pN8A, pk4v(X), X); X = MF16(pN4A, pk4v(X), X); X = MF16(pN2A, pk4v(X), X); X = MF16(pNA, pk4v(X), X);
                    const sh4 pSA = pk4v(X);
                    f32x4 O = MF32(cat8(*(const sh4*)(rr_ + fq * 4), *(const sh4*)(rr_ + 16 + fq * 4)), sB0, z4);
                    O = MF32(cat8(*(const sh4*)(rr_ + 32 + fq * 4), *(const sh4*)(rr_ + 48 + fq * 4)), sB1, O);
                    const bf16x8 sav = cat8(pSA, vf);
                    O = MF32(cat8(pMbr, pMkr), sav, O);
#pragma unroll
                    for (int j = 0; j < 4; ++j) s_o[(sc * 16 + fq * 4 + j) * 64 + wid * 16 + fr] = O[j];
#pragma unroll
                    for (int jt = 0; jt < 4; ++jt) {
                        const sh4 ka = *(const sh4*)(o_kT + (jt * 16 + fr) * SC_LS + sc * 16 + fq * 4), ba = *(const sh4*)(o_bT + (jt * 16 + fr) * SC_LS + sc * 16 + fq * 4);
                        f32x4 acc = MF32(cat8(ba, ka), sav, S[jt]);
                        const float4 g4 = *(const float4*)(s_gc + sc * 64 + jt * 16 + fq * 4);
                        acc[0] *= g4.x; acc[1] *= g4.y; acc[2] *= g4.z; acc[3] *= g4.w;
                        S[jt] = acc;
                    }
                }
            }
        }
        lds_barrier();
        {
            const int tau = tid >> 4, c4 = (tid & 15) * 4, e = tau * 64 + c4;
            const size_t n = (size_t)b * TS + t0 + tau;
            const float4 o4 = *(const float4*)(s_o + e), v4_ = *(const float4*)(s_v + e), g4_ = *(const float4*)(s_g + e);
            const float4 clw = *(const float4*)(cst + 800 + c4), clb = *(const float4*)(cst + 864 + c4);
            const float bsum = s_bs[tau];
            const float m_ = row16_sum((o4.x + o4.y) + (o4.z + o4.w)) * (1.0f / 64.0f);
            const float d0 = o4.x - m_, d1 = o4.y - m_, d2 = o4.z - m_, d3 = o4.w - m_;
            const float var = row16_sum(d0 * d0 + d1 * d1 + d2 * d2 + d3 * d3) * (1.0f / 64.0f);
            const float rs = rsqrtf(var + 64e-5f);
            const float y0 = (d0 * rs * clw.x + clb.x + bsum * v4_.x) * g4_.x, y1 = (d1 * rs * clw.y + clb.y + bsum * v4_.y) * g4_.y;
            const float y2 = (d2 * rs * clw.z + clb.z + bsum * v4_.z) * g4_.z, y3 = (d3 * rs * clw.w + clb.w + bsum * v4_.w) * g4_.w;
            if (tau < nval) *(uint2*)(Pr + n * 1024 + hc + c4) = pack4(y0, y1, y2, y3);
        }
    }
}

__device__ __forceinline__ void xcd_panel_map(int& mt0, int& mstep, int& nt) {
    const int b = obid(), G = (int)gridDim.x;
    if (G == 256) { nt = (b >> 3) & 7; mt0 = (b & 7) * 4 + (b >> 6); mstep = 32; }
    else { nt = b & 7; mt0 = b >> 3; mstep = G >> 3; }
}
__device__ void phase_merge(const Params& p, unsigned char* lds) {
    const int tid = otid(), lane = tid & 63, wid = tid >> 6, wr = wid >> 1, wc = wid & 1, fr = lane & 15, fq = lane >> 4;
    const bf16_t* h = (const bf16_t*)(WS(p) + OFF_H);
    const bf16_t* wb = (const bf16_t*)(WS(p) + OFF_WB);
    const float* rstd = (const float*)(WS(p) + OFF_RSTD);
    bf16_t* merged = (bf16_t*)(WS(p) + OFF_MERGED);
    const bf16_t* ysrc0 = (const bf16_t*)(WS(p) + OFF_PPOOL);
    const bf16_t* ysrc1 = (const bf16_t*)(WS(p) + OFF_PR);
    const bf16_t* ysrc2 = (const bf16_t*)(OUTB(p) + DO_YC);
    for (int tile = obid(); tile < 86 * 8; tile += gridDim.x) {
        const int mt = tile >> 3, nt = tile & 7;
        const int row0 = mt * 192, col0 = nt * 128;
        uint2 maccp[3][4];
#pragma unroll
        for (int m = 0; m < 3; ++m)
#pragma unroll
            for (int n = 0; n < 4; ++n) maccp[m][n] = make_uint2(0u, 0u);
#pragma unroll 1
        for (int i = 0; i < 3; ++i) {
            const int tid = otid();
            const bf16_t* ys = (i == 0) ? ysrc0 : (i == 1 ? ysrc1 : ysrc2);
            uint2 sg[3][4];
            {
                f32x4 ag[3][4]; g3_zero<3>(ag);
                G3<192> g;
                g3_setup<192>(g, [&](int r) { return h + (size_t)(row0 + r) * DM; }, [&](int r) { return wb + WB_WG + (size_t)(i * 1024 + col0 + r) * DM; }, tid);
                g3_kloop<192>(ag, g, DM, lds);
#pragma unroll
                for (int m = 0; m < 3; ++m) {
                    const float rs = rstd[row0 + wr * 48 + m * 16 + fr];
#pragma unroll
                    for (int n = 0; n < 4; ++n) sg[m][n] = pack4(fast_sigmoid(ag[m][n][0] * rs), fast_sigmoid(ag[m][n][1] * rs), fast_sigmoid(ag[m][n][2] * rs), fast_sigmoid(ag[m][n][3] * rs));
                }
            }
            {
                f32x4 ay[3][4]; g3_zero<3>(ay);
                G3<192> g;
                g3_setup<192>(g, [&](int r) { return ys + (size_t)(row0 + r) * DM; }, [&](int r) { return wb + WB_PA + (size_t)(i * 1024 + col0 + r) * DM; }, tid);
                g3_kloop<192>(ay, g, DM, lds);
#pragma unroll
                for (int m = 0; m < 3; ++m)
#pragma unroll
                    for (int n = 0; n < 4; ++n) {
                        const float m0 = __uint_as_float(maccp[m][n].x << 16) + __uint_as_float(sg[m][n].x << 16) * ay[m][n][0];
                        const float m1 = __uint_as_float(maccp[m][n].x & 0xFFFF0000u) + __uint_as_float(sg[m][n].x & 0xFFFF0000u) * ay[m][n][1];
                        const float m2 = __uint_as_float(maccp[m][n].y << 16) + __uint_as_float(sg[m][n].y << 16) * ay[m][n][2];
                        const float m3 = __uint_as_float(maccp[m][n].y & 0xFFFF0000u) + __uint_as_float(sg[m][n].y & 0xFFFF0000u) * ay[m][n][3];
                        maccp[m][n] = pack4(m0, m1, m2, m3);
                    }
            }
        }
#pragma unroll
        for (int m = 0; m < 3; ++m) {
            const int row = row0 + wr * 48 + m * 16 + fr;
#pragma unroll
            for (int n = 0; n < 4; ++n)
                *(uint2*)(merged + (size_t)row * 1024 + col0 + wc * 64 + n * 16 + fq * 4) = maccp[m][n];
        }
    }
}

__device__ void phase_outproj(const Params& p, unsigned char* lds) {
    const int tid = otid(), lane = tid & 63, wid = tid >> 6, wr = wid >> 1, wc = wid & 1, fr = lane & 15, fq = lane >> 4;
    const bf16_t* h = (const bf16_t*)(WS(p) + OFF_H);
    const bf16_t* wb = (const bf16_t*)(WS(p) + OFF_WB);
    const bf16_t* merged = (const bf16_t*)(WS(p) + OFF_MERGED);
    float* hm = (float*)(WS(p) + OFF_HM32);
    int mt0, mstep, nt;
    xcd_panel_map(mt0, mstep, nt);
    for (int mt = mt0; mt < 86; mt += mstep) {
        const int row0 = mt * 192, col0 = nt * 128;
        G3<192> g;
        g3_setup<192>(g, [&](int r) { return merged + (size_t)(row0 + r) * DM; }, [&](int r) { return wb + WB_WO + (size_t)(col0 + r) * DM; }, tid);
        f32x4 acc[3][4]; g3_zero<3>(acc);
        g3_kloop<192>(acc, g, DM, lds);
#pragma unroll
        for (int m = 0; m < 3; ++m) {
            const int row = row0 + wr * 48 + m * 16 + fr;
#pragma unroll
            for (int n = 0; n < 4; ++n) {
                const int col = col0 + wc * 64 + n * 16 + fq * 4;
                const uint2 hv = *(const uint2*)(h + (size_t)row * 1024 + col);
                float4 o;
                o.x = __uint_as_float(hv.x << 16) + acc[m][n][0]; o.y = __uint_as_float(hv.x & 0xFFFF0000u) + acc[m][n][1];
                o.z = __uint_as_float(hv.y << 16) + acc[m][n][2]; o.w = __uint_as_float(hv.y & 0xFFFF0000u) + acc[m][n][3];
                *(float4*)(hm + (size_t)row * 1024 + col) = o;
            }
        }
    }
}

__device__ __constant__ int c_pair_lo[6] = {0, 0, 0, 1, 1, 2};
__device__ __constant__ int c_pair_hi[6] = {1, 2, 3, 2, 3, 3};
__device__ void phase_route(const Params& p, int l, unsigned char* lds) {
    const int tid = otid(), lane = tid & 63, wid = tid >> 6;
    const int per = (NT + (int)gridDim.x - 1) / (int)gridDim.x;
    const int nbeg = obid() * per, nend = (nbeg + per < NT) ? nbeg + per : NT;
    int* s_cls = (int*)lds;
    int* s_base = s_cls + 512;
    float* s_wr = (float*)(lds + 4096);
    const float* hm = (const float*)(WS(p) + OFF_HM32);
    bf16_t* hn = (bf16_t*)(WS(p) + OFF_HN);
    const float* nf = p.in[33] + (size_t)l * 1024;
    const float* wg = p.in[34] + (size_t)l * 1024 * 4;
    const float* bg = p.in[35] + l * 4;
    const float* we = p.in[36] + (size_t)l * 1024 * 16;
    const float* be = p.in[37] + l * 16;
    int* cnt = (int*)(WS(p) + OFF_CTL);
    int* list = (int*)(WS(p) + OFF_LIST);
    float* pw = (float*)(WS(p) + OFF_PW);
    for (int e = tid; e < 1024 * 20; e += NTHR) {
        const int k = e / 20, c = e - k * 20;
        s_wr[c * 1024 + k] = (c < 4) ? wg[(size_t)k * 4 + c] : we[(size_t)k * 16 + (c - 4)];
    }
    __syncthreads();
    float4 nv[4], cur[4];
#pragma unroll
    for (int i = 0; i < 4; ++i) nv[i] = *(const float4*)(nf + i * 256 + lane * 4);
    if (nbeg + wid < nend) {
#pragma unroll
        for (int i = 0; i < 4; ++i) cur[i] = *(const float4*)(hm + (size_t)(nbeg + wid) * DM + i * 256 + lane * 4);
    }
    for (int n = nbeg + wid; n < nend; n += 8) {
        float4 xv[4]; float ss = 0.f;
#pragma unroll
        for (int i = 0; i < 4; ++i) { xv[i] = cur[i]; ss += xv[i].x * xv[i].x + xv[i].y * xv[i].y + xv[i].z * xv[i].z + xv[i].w * xv[i].w; }
        if (n + 8 < nend) {
#pragma unroll
            for (int i = 0; i < 4; ++i) cur[i] = *(const float4*)(hm + (size_t)(n + 8) * DM + i * 256 + lane * 4);
        }
        ss = wave_sum(ss);
        const float rs = rsqrtf(ss * (1.0f / 1024.0f) + 1e-6f);
        float lg[4] = {0.f, 0.f, 0.f, 0.f};
        float le[16];
#pragma unroll
        for (int e = 0; e < 16; ++e) le[e] = 0.f;
#pragma unroll
        for (int i = 0; i < 4; ++i) {
            float y[4] = {xv[i].x * rs * nv[i].x, xv[i].y * rs * nv[i].y, xv[i].z * rs * nv[i].z, xv[i].w * rs * nv[i].w};
            {
                const int d0 = i * 256 + lane * 4;
#pragma unroll
                for (int g = 0; g < 4; ++g) { const float4 w4 = *(const float4*)(s_wr + g * 1024 + d0); lg[g] += y[0] * w4.x + y[1] * w4.y + y[2] * w4.z + y[3] * w4.w; }
#pragma unroll
                for (int e = 0; e < 16; ++e) { const float4 w4 = *(const float4*)(s_wr + (4 + e) * 1024 + d0); le[e] += y[0] * w4.x + y[1] * w4.y + y[2] * w4.z + y[3] * w4.w; }
            }
            *(uint2*)(hn + (size_t)n * DM + i * 256 + lane * 4) = pack4(y[0], y[1], y[2], y[3]);
        }
#pragma unroll
        for (int g = 0; g < 4; ++g) lg[g] = wave_sum_fast(lg[g]) + bg[g];
#pragma unroll
        for (int e = 0; e < 16; ++e) le[e] = wave_sum_fast(le[e]) + be[e];
        if (lane == 0) {
            int gs = 0; float gm = lg[0];
#pragma unroll
            for (int g = 1; g < 4; ++g) if (lg[g] > gm) { gm = lg[g]; gs = g; }
            float den = 0.f;
#pragma unroll
            for (int g = 0; g < 4; ++g) den += __expf(lg[g] - gm);
            const float pgrp = 1.0f / den;
            float v4[4];
#pragma unroll
            for (int e = 0; e < 4; ++e) {
                const float m0 = (gs == 0) ? 1.f : 0.f, m1s = (gs == 1) ? 1.f : 0.f, m2s = (gs == 2) ? 1.f : 0.f, m3s = (gs == 3) ? 1.f : 0.f;
                v4[e] = le[e] * m0 + le[4 + e] * m1s + le[8 + e] * m2s + le[12 + e] * m3s;
            }
            int i1 = 0; float m1 = v4[0];
#pragma unroll
            for (int e = 1; e < 4; ++e) if (v4[e] > m1) { m1 = v4[e]; i1 = e; }
            int i2 = -1; float m2 = -INFINITY;
#pragma unroll
            for (int e = 0; e < 4; ++e) if (e != i1 && v4[e] > m2) { m2 = v4[e]; i2 = e; }
            const float e2 = __expf(m2 - m1);
            const float p1 = pgrp / (1.0f + e2), p2 = pgrp * e2 / (1.0f + e2);
            const int lo = i1 < i2 ? i1 : i2, hi = i1 < i2 ? i2 : i1;
            const float plo = i1 < i2 ? p1 : p2, phi = i1 < i2 ? p2 : p1;
            const int pi = (lo == 0) ? (hi - 1) : (lo == 1 ? hi + 1 : 5);
            const int cls = gs * 6 + pi;
            s_cls[n - nbeg] = cls;
            pw[(size_t)n * 2 + 0] = plo; pw[(size_t)n * 2 + 1] = phi;
        }
    }
    __syncthreads();
    const int nloc = nend - nbeg;
    if (tid < 24) {
        int c_ = 0;
        for (int i = 0; i < nloc; ++i) c_ += (s_cls[i] == tid) ? 1 : 0;
        s_base[tid] = c_ ? atomicAdd(&cnt[tid * 32], c_) : 0;
    }
    __syncthreads();
    for (int it = tid; it < nloc; it += NTHR) {
        const int cls = s_cls[it];
        int rank = 0;
        for (int i = 0; i < it; ++i) rank += (s_cls[i] == cls) ? 1 : 0;
        list[(size_t)cls * NT + s_base[cls] + rank] = nbeg + it;
    }
    __syncthreads();
}


struct MoeTile { int cls, ti, cnt, tg; };
__device__ __forceinline__ int moe_total_tiles(const int* cnt) { int s = 0; for (int c = 0; c < 24; ++c) s += (cnt[c * 32] + 127) >> 7; return s; }
__device__ __forceinline__ MoeTile moe_find(const int* cnt, int tile) {
    MoeTile r; int s = 0; r.cls = 0; r.ti = 0; r.cnt = 0; r.tg = tile;
    for (int c = 0; c < 24; ++c) { const int nt = (cnt[c * 32] + 127) >> 7; if (tile >= s && tile < s + nt) { r.cls = c; r.ti = tile - s; r.cnt = cnt[c * 32]; } s += nt; }
    return r;
}
__device__ void phase_moe1(const Params& p, unsigned char* lds) {
    const int tid = otid(), lane = tid & 63, wid = tid >> 6, wr = wid >> 1, wc = wid & 1, fr = lane & 15, fq = lane >> 4;
    const int* cnt = (const int*)(WS(p) + OFF_CTL);
    const int* list = (const int*)(WS(p) + OFF_LIST);
    const float* pw = (const float*)(WS(p) + OFF_PW);
    const bf16_t* hn = (const bf16_t*)(WS(p) + OFF_HN);
    const bf16_t* we = (const bf16_t*)(WS(p) + OFF_WEXP);
    bf16_t* hid = (bf16_t*)(OUTB(p) + DO_HID);
    const int total = moe_total_tiles(cnt);
    for (int item = obid(); item < total * 4; item += gridDim.x) {
        const MoeTile mt = moe_find(cnt, item >> 2);
        const int nt = item & 3, slot = nt >> 1, f0 = (nt & 1) * 128;
        const int g_ = mt.cls / 6, pi = mt.cls % 6;
        const int e = g_ * 4 + (slot == 0 ? c_pair_lo[pi] : c_pair_hi[pi]);
        const int* lst = list + (size_t)mt.cls * NT + mt.ti * 128;
        const int nvalid = min(128, mt.cnt - mt.ti * 128);
        f32x4 a1[2][4], a3[2][4]; g3_zero<2>(a1); g3_zero<2>(a3);
        G3D g;
#pragma unroll
        for (int i = 0; i < 2; ++i) {
            const int idx = tid + i * NTHR, row = idx >> 3, sl = (idx & 7) ^ (row & 7);
            g.ap[i] = hn + (size_t)lst[row < nvalid ? row : 0] * DM + sl * 8;
            g.b1[i] = we + WE_W1 + ((size_t)e * 256 + f0 + row) * 1024 + sl * 8;
            g.b3[i] = we + WE_W3 + ((size_t)e * 256 + f0 + row) * 1024 + sl * 8;
        }
        g3d_kloop(a1, a3, g, DM, lds);
#pragma unroll
        for (int m = 0; m < 2; ++m) {
            const int lr = wr * 32 + m * 16 + fr;
            const int tk = lst[lr < nvalid ? lr : 0];
            const float pe = pw[(size_t)tk * 2 + slot];
#pragma unroll
            for (int n = 0; n < 4; ++n) {
                const int col = slot * 256 + f0 + wc * 64 + n * 16 + fq * 4;
                float o[4];
#pragma unroll
                for (int j = 0; j < 4; ++j) { const float x1 = a1[m][n][j]; o[j] = x1 * sigmoidf_(x1) * a3[m][n][j] * pe; }
                *(uint2*)(hid + ((size_t)mt.tg * 128 + lr) * 512 + col) = pack4(o[0], o[1], o[2], o[3]);
            }
        }
    }
}
__device__ void phase_moe2(const Params& p, unsigned char* lds) {
    const int tid = otid(), lane = tid & 63, wid = tid >> 6, wr = wid >> 1, wc = wid & 1, fr = lane & 15, fq = lane >> 4;
    const int* cnt = (const int*)(WS(p) + OFF_CTL);
    const int* list = (const int*)(WS(p) + OFF_LIST);
    const bf16_t* we = (const bf16_t*)(WS(p) + OFF_WEXP);
    const bf16_t* hid = (const bf16_t*)(OUTB(p) + DO_HID);
    float* hm = (float*)(WS(p) + OFF_HM32);
    bf16_t* h = (bf16_t*)(WS(p) + OFF_H);
    const int total = moe_total_tiles(cnt);
    for (int item = obid(); item < total * 8; item += gridDim.x) {
        const MoeTile mt = moe_find(cnt, item >> 3);
        const int nt = item & 7, col0 = nt * 128;
        const int g_ = mt.cls / 6, pi = mt.cls % 6;
        const int elo = g_ * 4 + c_pair_lo[pi], ehi = g_ * 4 + c_pair_hi[pi];
        const int* lst = list + (size_t)mt.cls * NT + mt.ti * 128;
        const int nvalid = min(128, mt.cnt - mt.ti * 128);
        f32x4 acc[2][4]; g3_zero<2>(acc);
        G3<128> g;
        g3_setup<128>(g, [&](int r) { return hid + ((size_t)mt.tg * 128 + r) * 512; }, [&](int r) { return we + WE_W2 + ((size_t)elo * 1024 + col0 + r) * 256; }, tid);
        g3_kloop<128>(acc, g, 256, lds);
        g3_setup<128>(g, [&](int r) { return hid + ((size_t)mt.tg * 128 + r) * 512 + 256; }, [&](int r) { return we + WE_W2 + ((size_t)ehi * 1024 + col0 + r) * 256; }, tid);
        g3_kloop<128>(acc, g, 256, lds);
#pragma unroll
        for (int m = 0; m < 2; ++m) {
            const int lr = wr * 32 + m * 16 + fr;
            if (lr < nvalid) {
                const int tk = lst[lr];
#pragma unroll
                for (int n = 0; n < 4; ++n) {
                    const int col = col0 + wc * 64 + n * 16 + fq * 4;
                    float4 v = *(const float4*)(hm + (size_t)tk * 1024 + col);
                    v.x += acc[m][n][0]; v.y += acc[m][n][1]; v.z += acc[m][n][2]; v.w += acc[m][n][3];
                    *(float4*)(hm + (size_t)tk * 1024 + col) = v;
                    *(uint2*)(h + (size_t)tk * 1024 + col) = pack4(v.x, v.y, v.z, v.w);
                }
            }
        }
    }
}

__device__ void phase_final(const Params& p) {
    const int lane = otid() & 63;
    const int wave = (obid() * NTHR + otid()) >> 6, nw = gridDim.x * NTHR / 64;
    const float* hm = (const float*)(WS(p) + OFF_HM32);
    const float* nf = p.in[41];
    float4 g[4], cur[4];
#pragma unroll
    for (int i = 0; i < 4; ++i) g[i] = *(const float4*)(nf + i * 256 + lane * 4);
    auto rowp = [&](int r) { const int b = r / SEQ, s_ = r % SEQ; return hm + ((size_t)b * TS + NMETA + s_) * DM; };
    if (wave < NB * SEQ) {
        const float* src = rowp(wave);
#pragma unroll
        for (int i = 0; i < 4; ++i) cur[i] = *(const float4*)(src + i * 256 + lane * 4);
    }
    for (int r = wave; r < NB * SEQ; r += nw) {
        float4 v[4]; float ss = 0.f;
#pragma unroll
        for (int i = 0; i < 4; ++i) { v[i] = cur[i]; ss += v[i].x * v[i].x + v[i].y * v[i].y + v[i].z * v[i].z + v[i].w * v[i].w; }
        if (r + nw < NB * SEQ) {
            const float* src = rowp(r + nw);
#pragma unroll
            for (int i = 0; i < 4; ++i) cur[i] = *(const float4*)(src + i * 256 + lane * 4);
        }
        ss = wave_sum(ss);
        const float rs = rsqrtf(ss * (1.0f / 1024.0f) + 1e-6f);
#pragma unroll
        for (int i = 0; i < 4; ++i) {
            float4 o; o.x = v[i].x * rs * g[i].x; o.y = v[i].y * rs * g[i].y; o.z = v[i].z * rs * g[i].z; o.w = v[i].w * rs * g[i].w;
            *(float4*)((float*)OUTB(p) + (size_t)r * DM + i * 256 + lane * 4) = o;
        }
    }
}


#define XB_TMO      128
#define XB_XCNT(j)  (256  + 64 * (j))
#define XB_XSUB(j)  (1280 + 64 * (j))
#define XB_XGEN(j)  (2304 + 64 * (j))
#define XB_TOP      3328
#define XB_TOPGEN   3392
#define XCD_BAR_WORDS 3456
#define XB_SPIN_CAP (1u << 22)
#define LAS __attribute__((address_space(3)))
__device__ __forceinline__ unsigned xb_ld(unsigned* p) { return __hip_atomic_load(p, __ATOMIC_RELAXED, __HIP_MEMORY_SCOPE_AGENT); }
__device__ __forceinline__ unsigned xb_add(unsigned* p, unsigned v) { return __hip_atomic_fetch_add(p, v, __ATOMIC_RELAXED, __HIP_MEMORY_SCOPE_AGENT); }
__device__ __forceinline__ unsigned xb_xcc_id() { return (unsigned)__builtin_amdgcn_s_getreg((3 << 11) | 20) & 0xFu; }
#define XB_SPIN(cond, bar) do { unsigned _sp = 0; while (cond) { __builtin_amdgcn_s_sleep(1); \
    if ((++_sp & 255u) == 0u) { if (xb_ld(&(bar)[XB_TMO])) break; if (_sp > XB_SPIN_CAP) { atomicAdd(&(bar)[XB_TMO], 1u); break; } } } } while (0)
struct XcdBarrier { unsigned* bar; unsigned x; volatile LAS unsigned* st; };
__device__ __forceinline__ XcdBarrier xcd_barrier_post(unsigned* bar, volatile LAS unsigned* st) {
    XcdBarrier b; b.bar = bar; b.x = xb_xcc_id(); b.st = st;
    if (threadIdx.x == 0) (void)xb_add(&bar[XB_XCNT(b.x)], 1u);
    return b;
}
__device__ __forceinline__ void xcd_barrier_complete(unsigned* bar, unsigned x, unsigned& nloc, unsigned& nx) {
    const unsigned G = gridDim.x * gridDim.y * gridDim.z;
    unsigned sum, cnt, mine, sp = 0u;
    for (;;) {
        sum = 0u; cnt = 0u; mine = 0u;
#pragma unroll
        for (unsigned j = 0; j < 16; ++j) { const unsigned c = xb_ld(&bar[XB_XCNT(j)]); sum += c; cnt += (c > 0u) ? 1u : 0u; mine = (j == x) ? c : mine; }
        if (sum == G) break;
        __builtin_amdgcn_s_sleep(1);
        if ((++sp & 255u) == 0u) { if (xb_ld(&bar[XB_TMO])) break; if (sp > XB_SPIN_CAP) { atomicAdd(&bar[XB_TMO], 1u); break; } }
    }
    nloc = mine > 0u ? mine : 1u; nx = cnt > 0u ? cnt : 1u;
}
__device__ __forceinline__ void xcd_barrier(const XcdBarrier& b) {
    asm volatile("s_waitcnt vmcnt(0)" ::: "memory");
    __syncthreads();
    if (threadIdx.x == 0) {
        unsigned* bar = b.bar;
        __builtin_amdgcn_s_waitcnt(0);
        unsigned nloc = b.st[0], nx = b.st[1];
        if (nloc == 0u) { xcd_barrier_complete(bar, b.x, nloc, nx); b.st[0] = nloc; b.st[1] = nx; }
        const unsigned old = xb_add(&bar[XB_XSUB(b.x)], 1u);
        const unsigned gen = old / nloc;
        if (old + 1u == (gen + 1u) * nloc) {
            __builtin_amdgcn_fence(__ATOMIC_RELEASE, "agent");
            asm volatile("s_waitcnt vmcnt(0)" ::: "memory");
            const unsigned og = xb_add(&bar[XB_TOP], 1u);
            const unsigned tg = og / nx;
            if (og + 1u == (tg + 1u) * nx) xb_add(&bar[XB_TOPGEN], 1u);
            else XB_SPIN(xb_ld(&bar[XB_TOPGEN]) == tg, bar);
            __builtin_amdgcn_fence(__ATOMIC_ACQUIRE, "agent");
            xb_add(&bar[XB_XGEN(b.x)], 1u);
            asm volatile("s_waitcnt vmcnt(0)" ::: "memory");
        } else {
            XB_SPIN(xb_ld(&bar[XB_XGEN(b.x)]) == gen, bar);
            __builtin_amdgcn_fence(__ATOMIC_ACQUIRE, "agent");
            asm volatile("s_waitcnt vmcnt(0)" ::: "memory");
        }
    }
    __syncthreads();
}

__global__ void __launch_bounds__(NTHR) fwd_megakernel(Params p) {
    extern __shared__ __attribute__((aligned(16))) unsigned char lds[];
    cg::grid_group grid = cg::this_grid();
    volatile LAS unsigned* xst = (volatile LAS unsigned*)(lds + LDS_BYTES - 32);
    if (threadIdx.x < 2) xst[threadIdx.x] = 0u;
    __syncthreads();
    const XcdBarrier xb = xcd_barrier_post((unsigned*)(p.ws + OFF_BAR), xst);
    if (p.out == nullptr) grid.sync();
#pragma unroll 1
    for (int step = 0; step < 18; ++step) {
        const int l = step >= 9 ? 1 : 0;
        const int ph = step - l * 9;
        switch (ph) {
        case 0:
            if (l == 0) phase_embed(p); else phase_rowstat(p);
            phase_convert<false>(p, l, lds);
            if (obid() == 0 && otid() < 24) ((int*)(WS(p) + OFF_CTL))[otid() * 32] = 0;
            if (obid() == 0 && otid() == 32) ((int*)(WS(p) + OFF_CTL))[800 + l * 32] = 0;
            break;
        case 1: phase_inproj(p, lds); break;
        case 2: phase_dsa_prep(p, l); phase_lr_prep(p, l); break;
        case 3: {
            if (obid() < NB * 16) phase_scan5(p, l, lds, obid());
            int* qctr = (int*)(WS(p) + OFF_CTL) + 800 + l * 32;
            int* qslot = (int*)(lds + LDS_BYTES - 16);
            for (;;) {
                __syncthreads();
                if (otid() == 0) *qslot = atomicAdd(qctr, 1);
                __syncthreads();
                const int item = *qslot;
                if (item >= 516 + NT / 32 + 3072) break;
                if (item < 516) phase_pool(p, l, lds, item, item + 1, 1);
                else if (item < 516 + NT / 32) phase_dsa<false>(p, l, lds, (bf16_t*)(OUTB(p) + DO_YC), nullptr, nullptr, item - 516, item - 515, 1);
                else {
                    const int ct = item - (516 + NT / 32);
                    const ConvJob cj = get_job_late(p, l, ct >> 10);
                    conv_tile(cj, ct & 1023, (float*)lds);
                }
            }
        } break;
        case 4: phase_merge(p, lds); break;
        case 5: phase_outproj(p, lds); break;
        case 6: phase_route(p, l, lds); break;
        case 7: phase_moe1(p, lds); break;
        default: phase_moe2(p, lds); break;
        }
        xcd_barrier(xb);
    }
    phase_final(p);
}

extern "C" void kernel_launch(void* const* d_in, const int* in_sizes, int n_in,
                              void* d_out, int out_size, void* d_ws, size_t ws_size,
                              hipStream_t stream) {
    static int grid_blocks = 0;
    if (grid_blocks == 0) {
        int dev = 0, cus = 0, per_cu = 0;
        (void)hipGetDevice(&dev);
        (void)hipDeviceGetAttribute(&cus, hipDeviceAttributeMultiprocessorCount, dev);
        (void)hipFuncSetAttribute((const void*)fwd_megakernel, hipFuncAttributeMaxDynamicSharedMemorySize, LDS_BYTES);
        (void)hipOccupancyMaxActiveBlocksPerMultiprocessor(&per_cu, fwd_megakernel, NTHR, LDS_BYTES);
        if (per_cu < 1 || cus < NB * 16 || (cus & 7) != 0 || n_in != 42 || ws_size < WS_END + (size_t)QS_WS * QS_BYTES || cus > QS_WS + QS_DO) { fprintf(stderr, "kernel_launch: bad config per_cu=%d n_in=%d ws=%zu need=%zu\n", per_cu, n_in, ws_size, (size_t)WS_END); grid_blocks = -1; }
        else grid_blocks = cus;
    }
    if (grid_blocks < 0) return;
    Params p{};
    for (int i = 0; i < 42; ++i) p.in[i] = (const float*)d_in[i];
    p.out = (float*)d_out;
    p.ws = (unsigned char*)d_ws;
    (void)hipMemsetAsync((unsigned char*)d_ws + OFF_BAR, 0, XCD_BAR_WORDS * 4, stream);
    void* args[] = {&p};
    hipError_t e = hipLaunchCooperativeKernel((void*)fwd_megakernel, dim3(grid_blocks), dim3(NTHR), args, LDS_BYTES, stream);
    if (e != hipSuccess) fprintf(stderr, "cooperative launch failed: %s (grid %d)\n", hipGetErrorString(e), grid_blocks);
}
```

```cpp
#include <hip/hip_runtime.h>
#include <hip/hip_cooperative_groups.h>
#include <cstdio>
#include <cstdint>
#include <type_traits>
namespace cg = cooperative_groups;

typedef unsigned short bf16_t;
typedef short bf16x8 __attribute__((ext_vector_type(8)));
typedef float f32x4 __attribute__((ext_vector_type(4)));

constexpr int NB = 8, SEQ = 2048, NMETA = 16, TS = 2064, DM = 1024;
constexpr int NT = NB * TS;
constexpr int NTP = 16640;
constexpr int NTHR = 512;
constexpr int CIN = 7912;
constexpr int NP1 = 4864;
constexpr int PM_LD = 768;
constexpr int PM_WD = 0, PM_AD = 64, PM_GD = 128, PM_VD = 256, PM_CQ = 288, PM_CKV = 544, PM_KROPE = 672, PM_KIDX = 704;
constexpr int LDS_BYTES = 157 * 1024;

constexpr size_t AL(size_t x) { return (x + 255) & ~(size_t)255; }
constexpr size_t SZ_ACT = (size_t)NTP * 1024 * 2;
constexpr size_t OFF_CTL = 0;
constexpr size_t OFF_BAR = 4096;
constexpr size_t OFF_RSTD = OFF_BAR + 16384;
constexpr size_t OFF_ROPE = OFF_RSTD + AL((size_t)NTP * 4);
constexpr size_t OFF_H = OFF_ROPE + AL((size_t)TS * 16 * 4 * 2);
constexpr size_t OFF_WB = OFF_H + SZ_ACT;
constexpr size_t WB_WIN = 0;
constexpr size_t WB_WG = WB_WIN + (size_t)NP1 * 1024;
constexpr size_t WB_PA = WB_WG + (size_t)3072 * 1024;
constexpr size_t WB_WO = WB_PA + (size_t)3 * 1024 * 1024;
constexpr size_t WB_POOL = WB_WO + (size_t)1024 * 1024;
constexpr size_t WB_QI = WB_POOL + (size_t)4 * 256 * 256;
constexpr size_t WB_UQ = WB_QI + (size_t)512 * 256;
constexpr size_t WB_UK = WB_UQ + (size_t)1536 * 256;
constexpr size_t WB_UV = WB_UK + (size_t)16 * 128 * 64;
constexpr size_t WB_WIDX = WB_UV + (size_t)16 * 64 * 128;
constexpr size_t WB_END = WB_WIDX + (size_t)64 * 1024;
constexpr size_t OFF_PPOOL = OFF_WB + AL(WB_END * 2);
constexpr size_t OFF_PK = OFF_PPOOL + SZ_ACT;
constexpr size_t OFF_PR = OFF_PK + SZ_ACT;
constexpr size_t OFF_PV = OFF_PR + SZ_ACT;
constexpr size_t OFF_PMISC = OFF_PV + SZ_ACT;
constexpr size_t OFF_VFIRST = OFF_PMISC + AL((size_t)NTP * PM_LD * 2);
constexpr size_t OFF_HALO = OFF_VFIRST + SZ_ACT;
constexpr size_t OFF_LIST = OFF_HALO + AL((size_t)130 * 16 * 1024 * 2);
constexpr size_t OFF_PW = OFF_LIST + AL((size_t)24 * NT * 4);
constexpr size_t WS_END = OFF_PW + AL((size_t)NT * 2 * 4);
constexpr size_t OFF_MERGED = OFF_PK;
constexpr size_t OFF_HM32 = OFF_PR;
constexpr size_t OFF_HN = OFF_PPOOL;
constexpr size_t OFF_WEXP = OFF_PMISC;
constexpr size_t WE_W1 = 0, WE_W3 = (size_t)16 * 256 * 1024, WE_W2 = (size_t)2 * 16 * 256 * 1024;
static_assert((size_t)3 * 16 * 256 * 1024 * 2 <= (size_t)NTP * PM_LD * 2, "expert weights must fit in Pmisc");
constexpr size_t DO_YC = 0;
constexpr size_t DO_CQN = DO_YC + SZ_ACT;
constexpr size_t DO_KV = DO_CQN + AL((size_t)NT * 256 * 2);
constexpr size_t DO_KIDX = DO_KV + AL((size_t)NT * 160 * 2);
constexpr size_t DO_WHEAD = DO_KIDX + AL((size_t)NT * 64 * 2);
constexpr size_t DO_ALR = DO_WHEAD + AL((size_t)NT * 8 * 4);
constexpr size_t DO_END = DO_ALR + AL((size_t)NT * 288 * 2);
constexpr size_t QS_BYTES = (size_t)16 * 16 * 160 * 2;
constexpr int QS_WS = (int)((277240096ull - WS_END) / QS_BYTES), QS_DO = (int)(((size_t)NB * SEQ * DM * 4 - DO_END) / QS_BYTES);
static_assert(QS_WS + QS_DO >= 256, "Q scratch");
constexpr size_t DO_HID = DO_YC;
static_assert(DO_END <= (size_t)NB * SEQ * DM * 4, "d_out scratch overflow");
static_assert((size_t)(129 + 24) * 128 * 512 * 2 <= SZ_ACT, "hid fits");
static_assert(WS_END <= 277240096ull, "workspace overflow");

struct Params {
    const float* in[42];
    float* out;
    unsigned char* ws;
};

__device__ __forceinline__ int otid() { int t = threadIdx.x; asm volatile("" : "+v"(t)); return t; }
__device__ __forceinline__ int obid() { int b = blockIdx.x; asm volatile("" : "+s"(b)); return b; }
typedef __attribute__((address_space(1))) unsigned char gas_uchar;
__device__ __forceinline__ unsigned char* WS(const Params& p) { gas_uchar* w = (gas_uchar*)p.ws; asm volatile("" : "+s"(w)); return (unsigned char*)w; }
__device__ __forceinline__ unsigned char* OUTB(const Params& p) { gas_uchar* w = (gas_uchar*)p.out; asm volatile("" : "+s"(w)); return (unsigned char*)w; }
__device__ __forceinline__ float bf2f(bf16_t v) { return __uint_as_float(((unsigned)v) << 16); }
typedef float f32x2v __attribute__((ext_vector_type(2)));
typedef __bf16 bf16x2v __attribute__((ext_vector_type(2)));
__device__ __forceinline__ unsigned pk2(float a, float b) { const f32x2v v = {a, b}; const bf16x2v r = __builtin_convertvector(v, bf16x2v); unsigned u; __builtin_memcpy(&u, &r, 4); return u; }
__device__ __forceinline__ bf16_t f2bf(float f) { const __bf16 h = (__bf16)f; bf16_t u; __builtin_memcpy(&u, &h, 2); return u; }
__device__ __forceinline__ float wave_sum(float v) {
#pragma unroll
    for (int o = 32; o > 0; o >>= 1) v += __shfl_xor(v, o);
    return v;
}
template <int CTRL> __device__ __forceinline__ float dpp_f(float x) {
    return __int_as_float(__builtin_amdgcn_update_dpp(0, __float_as_int(x), CTRL, 0xF, 0xF, true));
}
__device__ __forceinline__ float row16_sum(float v) {
    v += dpp_f<0xB1>(v);
    v += dpp_f<0x4E>(v);
    v += dpp_f<0x141>(v);
    v += dpp_f<0x140>(v);
    return v;
}
__device__ __forceinline__ void lds_barrier() { asm volatile("s_waitcnt lgkmcnt(0)" ::: "memory"); __builtin_amdgcn_s_barrier(); asm volatile("" ::: "memory"); }
__device__ __forceinline__ float fast_rcp(float x) { return __builtin_amdgcn_rcpf(x); }
__device__ __forceinline__ float fast_sigmoid(float x) { return fast_rcp(1.0f + __expf(-x)); }
__device__ __forceinline__ float fast_tanh(float x) { return 1.0f - 2.0f * fast_rcp(1.0f + __expf(2.0f * x)); }
__device__ __forceinline__ void row16_sum4(float& a, float& b, float& c, float& d) {
    asm volatile(
        "s_nop 1\n\t"
        "v_add_f32_dpp %0, %0, %0 quad_perm:[1,0,3,2] row_mask:0xf bank_mask:0xf\n\t"
        "v_add_f32_dpp %1, %1, %1 quad_perm:[1,0,3,2] row_mask:0xf bank_mask:0xf\n\t"
        "v_add_f32_dpp %2, %2, %2 quad_perm:[1,0,3,2] row_mask:0xf bank_mask:0xf\n\t"
        "v_add_f32_dpp %3, %3, %3 quad_perm:[1,0,3,2] row_mask:0xf bank_mask:0xf\n\t"
        "v_add_f32_dpp %0, %0, %0 quad_perm:[2,3,0,1] row_mask:0xf bank_mask:0xf\n\t"
        "v_add_f32_dpp %1, %1, %1 quad_perm:[2,3,0,1] row_mask:0xf bank_mask:0xf\n\t"
        "v_add_f32_dpp %2, %2, %2 quad_perm:[2,3,0,1] row_mask:0xf bank_mask:0xf\n\t"
        "v_add_f32_dpp %3, %3, %3 quad_perm:[2,3,0,1] row_mask:0xf bank_mask:0xf\n\t"
        "v_add_f32_dpp %0, %0, %0 row_half_mirror row_mask:0xf bank_mask:0xf\n\t"
        "v_add_f32_dpp %1, %1, %1 row_half_mirror row_mask:0xf bank_mask:0xf\n\t"
        "v_add_f32_dpp %2, %2, %2 row_half_mirror row_mask:0xf bank_mask:0xf\n\t"
        "v_add_f32_dpp %3, %3, %3 row_half_mirror row_mask:0xf bank_mask:0xf\n\t"
        "v_add_f32_dpp %0, %0, %0 row_mirror row_mask:0xf bank_mask:0xf\n\t"
        "v_add_f32_dpp %1, %1, %1 row_mirror row_mask:0xf bank_mask:0xf\n\t"
        "v_add_f32_dpp %2, %2, %2 row_mirror row_mask:0xf bank_mask:0xf\n\t"
        "v_add_f32_dpp %3, %3, %3 row_mirror row_mask:0xf bank_mask:0xf\n\t"
        "s_nop 1"
        : "+v"(a), "+v"(b), "+v"(c), "+v"(d));
}
__device__ __forceinline__ void row8_sum2(float& a, float& b) {
    asm volatile(
        "s_nop 1\n\t"
        "v_add_f32_dpp %0, %0, %0 quad_perm:[1,0,3,2] row_mask:0xf bank_mask:0xf\n\t"
        "v_add_f32_dpp %1, %1, %1 quad_perm:[1,0,3,2] row_mask:0xf bank_mask:0xf\n\t"
        "s_nop 0\n\t"
        "v_add_f32_dpp %0, %0, %0 quad_perm:[2,3,0,1] row_mask:0xf bank_mask:0xf\n\t"
        "v_add_f32_dpp %1, %1, %1 quad_perm:[2,3,0,1] row_mask:0xf bank_mask:0xf\n\t"
        "s_nop 0\n\t"
        "v_add_f32_dpp %0, %0, %0 row_half_mirror row_mask:0xf bank_mask:0xf\n\t"
        "v_add_f32_dpp %1, %1, %1 row_half_mirror row_mask:0xf bank_mask:0xf\n\t"
        "s_nop 1"
        : "+v"(a), "+v"(b));
}
__device__ __forceinline__ float wave_sum_fast(float v) { v = row16_sum(v); v += __shfl_xor(v, 16); v += __shfl_xor(v, 32); return v; }
__device__ __forceinline__ float sigmoidf_(float x) { return 1.0f / (1.0f + __expf(-x)); }
__device__ __forceinline__ float softplusf_(float z) { return fmaxf(z, 0.f) + log1pf(__expf(-fabsf(z))); }
__device__ __forceinline__ void glds16(const void* g, void* l) {
    __builtin_amdgcn_global_load_lds((const unsigned*)g, (unsigned*)l, 16, 0, 0);
}

__device__ void phase_embed(const Params& p) {
    const int lane = otid() & 63;
    const int wave = (obid() * NTHR + otid()) >> 6, nw = gridDim.x * NTHR / 64;
    bf16_t* h = (bf16_t*)(WS(p) + OFF_H);
    float* rstd = (float*)(WS(p) + OFF_RSTD);
    auto srcrow = [&](int n) { const int b = n / TS, t = n % TS; return t < NMETA ? p.in[1] + (size_t)t * DM : p.in[0] + ((size_t)b * SEQ + (t - NMETA)) * DM; };
    float4 cur[4];
    if (wave < NT) {
        const float* src = srcrow(wave);
#pragma unroll
        for (int i = 0; i < 4; ++i) cur[i] = *(const float4*)(src + i * 256 + lane * 4);
    }
    for (int n = wave; n < NTP; n += nw) {
        if (n < NT) {
            float4 v[4];
#pragma unroll
            for (int i = 0; i < 4; ++i) v[i] = cur[i];
            if (n + nw < NT) {
                const float* src = srcrow(n + nw);
#pragma unroll
                for (int i = 0; i < 4; ++i) cur[i] = *(const float4*)(src + i * 256 + lane * 4);
            }
            float ss = 0.f;
#pragma unroll
            for (int i = 0; i < 4; ++i) {
                ss += v[i].x * v[i].x + v[i].y * v[i].y + v[i].z * v[i].z + v[i].w * v[i].w;
                *(uint2*)(h + (size_t)n * DM + i * 256 + lane * 4) = make_uint2(pk2(v[i].x, v[i].y), pk2(v[i].z, v[i].w));
            }
            ss = wave_sum(ss);
            if (lane == 0) rstd[n] = rsqrtf(ss * (1.0f / 1024.0f) + 1e-6f);
        } else {
#pragma unroll
            for (int i = 0; i < 4; ++i) *(ushort4*)(h + (size_t)n * DM + i * 256 + lane * 4) = make_ushort4(0, 0, 0, 0);
            if (lane == 0) rstd[n] = 0.f;
        }
    }
    float* ctab = (float*)(WS(p) + OFF_ROPE);
    float* stab = ctab + TS * 16;
    for (int idx = obid() * NTHR + otid(); idx < TS * 16; idx += gridDim.x * NTHR) {
        const int t = idx >> 4, i = idx & 15;
        const float inv = powf(10000.0f, -(float)(2 * i) / 32.0f);
        const float ang = (float)t * inv;
        ctab[idx] = cosf(ang);
        stab[idx] = sinf(ang);
    }
}

__device__ void phase_rowstat(const Params& p) {
    const int lane = otid() & 63;
    const int wave = (obid() * NTHR + otid()) >> 6, nw = gridDim.x * NTHR / 64;
    const float* hm = (const float*)(WS(p) + OFF_HM32);
    float* rstd = (float*)(WS(p) + OFF_RSTD);
    float4 cur[4];
    if (wave < NT) {
#pragma unroll
        for (int i = 0; i < 4; ++i) cur[i] = *(const float4*)(hm + (size_t)wave * DM + i * 256 + lane * 4);
    }
    for (int n = wave; n < NT; n += nw) {
        float ss = 0.f;
#pragma unroll
        for (int i = 0; i < 4; ++i) ss += cur[i].x * cur[i].x + cur[i].y * cur[i].y + cur[i].z * cur[i].z + cur[i].w * cur[i].w;
        if (n + nw < NT) {
#pragma unroll
            for (int i = 0; i < 4; ++i) cur[i] = *(const float4*)(hm + (size_t)(n + nw) * DM + i * 256 + lane * 4);
        }
        ss = wave_sum(ss);
        if (lane == 0) rstd[n] = rsqrtf(ss * (1.0f / 1024.0f) + 1e-6f);
    }
}

struct ConvJob { const float* src; bf16_t* dst; const float* scale; int ldsrc, K, nvalid, nrows, nb, notr; size_t sbs, dbs; const float* srcB; int ldB, split; };
__device__ __forceinline__ int conv_job_tiles(const ConvJob& j) { return j.nb * (j.nrows >> 6) * (j.K >> 6); }
__device__ void conv_tile(const ConvJob& j, int tile, float* lds) {
    const int per = (j.nrows >> 6) * (j.K >> 6);
    const int bi = tile / per, rem = tile % per;
    const int ktiles = j.K >> 6;
    const int n0 = (rem / ktiles) << 6, k0 = (rem % ktiles) << 6;
    const int tid = otid(), tn = tid & 63, tk = tid >> 6;
    const float* src = j.src + (size_t)bi * j.sbs;
    bf16_t* dst = j.dst + (size_t)bi * j.dbs;
#pragma unroll
    for (int kk = 0; kk < 8; ++kk) {
        const int k = k0 + tk * 8 + kk;
        float v = 0.f;
        if (n0 + tn < j.nvalid) {
            if (j.split) { const int nn = n0 + tn; v = (nn < j.split) ? (j.src ? j.src[(size_t)k * j.ldsrc + nn] : 0.f) : j.srcB[(size_t)k * j.ldB + (nn - j.split)]; }
            else v = j.notr ? src[(size_t)(n0 + tn) * j.ldsrc + k] : src[(size_t)k * j.ldsrc + n0 + tn];
            if (j.scale) v *= j.scale[k];
        }
        lds[tn * 65 + tk * 8 + kk] = v;
    }
    __syncthreads();
    const int wn = tid >> 3, kq = tid & 7;
    uint4 o;
    unsigned w[4];
#pragma unroll
    for (int q = 0; q < 4; ++q) {
        const float lo = lds[wn * 65 + kq * 8 + 2 * q], hi = lds[wn * 65 + kq * 8 + 2 * q + 1];
        w[q] = pk2(lo, hi);
    }
    o.x = w[0]; o.y = w[1]; o.z = w[2]; o.w = w[3];
    *(uint4*)(dst + (size_t)(n0 + wn) * j.K + k0 + kq * 8) = o;
    __syncthreads();
}
__device__ ConvJob get_job_early(const Params& p, int l, int ji) {
    bf16_t* wb = (bf16_t*)(WS(p) + OFF_WB);
    const float* win = p.in[3] + (size_t)l * DM * CIN;
    const float* nm = p.in[2] + (size_t)l * DM;
    ConvJob j{}; j.nb = 1; j.sbs = 0; j.dbs = 0; j.K = 1024; j.ldsrc = CIN; j.scale = nm;
    switch (ji) {
    case 0: j.src = win + 3072; j.dst = wb + WB_WIN; j.nvalid = 4352; j.nrows = 4352; break;
    case 1: j.src = (l == 0 ? nullptr : p.in[17]); j.ldsrc = 32; j.split = 32; j.srcB = win + 7424; j.ldB = CIN; j.dst = wb + WB_WIN + (size_t)(4096 + PM_VD) * 1024; j.nvalid = 512; j.nrows = 512; break;
    case 2: j.src = win + 7904; j.dst = wb + WB_WIDX; j.nvalid = 8; j.nrows = 64; break;
    case 3: j.src = win; j.dst = wb + WB_WG; j.nvalid = 3072; j.nrows = 3072; break;
    case 4: j.src = p.in[29] + (size_t)l * DM * DM; j.ldsrc = 1024; j.scale = nullptr; j.dst = wb + WB_PA; j.nvalid = 1024; j.nrows = 1024; break;
    case 5: j.src = p.in[30] + (size_t)l * DM * DM; j.ldsrc = 1024; j.scale = nullptr; j.dst = wb + WB_PA + (size_t)1024 * 1024; j.nvalid = 1024; j.nrows = 1024; break;
    case 6: j.src = p.in[31] + (size_t)l * DM * DM; j.ldsrc = 1024; j.scale = nullptr; j.dst = wb + WB_PA + (size_t)2 * 1024 * 1024; j.nvalid = 1024; j.nrows = 1024; break;
    case 7: j.src = p.in[32] + (size_t)l * DM * DM; j.ldsrc = 1024; j.scale = nullptr; j.dst = wb + WB_WO; j.nvalid = 1024; j.nrows = 1024; break;
    case 8: j.src = p.in[5] + (size_t)l * 4 * 256 * 256; j.ldsrc = 256; j.K = 256; j.scale = nullptr; j.dst = wb + WB_POOL; j.nvalid = 256; j.nrows = 256; j.nb = 4; j.sbs = 65536; j.dbs = 65536; break;
    case 9: j.src = p.in[26] + (size_t)l * 256 * 512; j.ldsrc = 512; j.K = 256; j.scale = nullptr; j.dst = wb + WB_QI; j.nvalid = 512; j.nrows = 512; break;
    case 10: j.src = p.in[23] + (size_t)l * 256 * 1536; j.ldsrc = 1536; j.K = 256; j.scale = nullptr; j.dst = wb + WB_UQ; j.nvalid = 1536; j.nrows = 1536; break;
    case 11: j.src = p.in[24] + (size_t)l * 16 * 128 * 64; j.ldsrc = 64; j.K = 64; j.scale = nullptr; j.dst = wb + WB_UK; j.nvalid = 2048; j.nrows = 2048; j.notr = 1; break;
    default: j.src = p.in[25] + (size_t)l * 16 * 128 * 64; j.ldsrc = 64; j.K = 128; j.scale = nullptr; j.dst = wb + WB_UV; j.nvalid = 64; j.nrows = 64; j.nb = 16; j.sbs = 8192; j.dbs = 8192; break;
    }
    return j;
}
__device__ ConvJob get_job_late(const Params& p, int l, int ji) {
    bf16_t* we = (bf16_t*)(WS(p) + OFF_WEXP);
    ConvJob j{}; j.nb = 16; j.scale = nullptr; j.sbs = 262144; j.dbs = 262144;
    switch (ji) {
    case 0: j.src = p.in[38] + (size_t)l * 16 * 262144; j.dst = we + WE_W1; j.ldsrc = 256; j.K = 1024; j.nvalid = 256; j.nrows = 256; break;
    case 1: j.src = p.in[39] + (size_t)l * 16 * 262144; j.dst = we + WE_W3; j.ldsrc = 256; j.K = 1024; j.nvalid = 256; j.nrows = 256; break;
    default: j.src = p.in[40] + (size_t)l * 16 * 262144; j.dst = we + WE_W2; j.ldsrc = 1024; j.K = 256; j.nvalid = 1024; j.nrows = 1024; break;
    }
    return j;
}
template <bool LATE>
__device__ void phase_convert(const Params& p, int l, unsigned char* lds) {
    const int njobs = LATE ? 3 : 13;
    int base = 0;
    for (int ji = 0; ji < njobs; ++ji) {
        const ConvJob j = LATE ? get_job_late(p, l, ji) : get_job_early(p, l, ji);
        const int nt = conv_job_tiles(j);
        int first = ((int)obid() - base) % (int)gridDim.x; if (first < 0) first += gridDim.x;
        for (int t = first; t < nt; t += gridDim.x) conv_tile(j, t, (float*)lds);
        base += nt;
    }
}

template <int BM> struct G3 {
    static constexpr int MI = BM / 64;
    static constexpr int NA = BM / 64;
    static constexpr int STAGE = BM * 128 + 128 * 128;
    const bf16_t* ap[NA];
    const bf16_t* bp[2];
};
template <int BM>
__device__ __forceinline__ void g3_issue(const G3<BM>& g, int kt, unsigned char* stage, int tid) {
#pragma unroll
    for (int i = 0; i < G3<BM>::NA; ++i) glds16(g.ap[i] + kt * 64, stage + (tid + i * NTHR) * 16);
#pragma unroll
    for (int i = 0; i < 2; ++i) glds16(g.bp[i] + kt * 64, stage + BM * 128 + (tid + i * NTHR) * 16);
}
template <int BM, class FA, class FB>
__device__ __forceinline__ void g3_setup(G3<BM>& g, FA rowptr, FB bcol, int tid) {
#pragma unroll
    for (int i = 0; i < G3<BM>::NA; ++i) { const int idx = tid + i * NTHR, row = idx >> 3, sl = (idx & 7) ^ (row & 7); g.ap[i] = rowptr(row) + sl * 8; }
#pragma unroll
    for (int i = 0; i < 2; ++i) { const int idx = tid + i * NTHR, row = idx >> 3, sl = (idx & 7) ^ (row & 7); g.bp[i] = bcol(row) + sl * 8; }
}
template <int BM>
__device__ __forceinline__ void g3_kloop(f32x4 (&acc)[BM / 64][4], const G3<BM>& g, int K, unsigned char* lds) {
    constexpr int MI = G3<BM>::MI, STAGE = G3<BM>::STAGE, NL = G3<BM>::NA + 2;
    const int tid = otid(), lane = tid & 63, wid = tid >> 6, wr = wid >> 1, wc = wid & 1, fr = lane & 15, fq = lane >> 4;
    const int nk = K >> 6;
    g3_issue<BM>(g, 0, lds, tid);
    if (nk > 1) g3_issue<BM>(g, 1, lds + STAGE, tid);
    int cur = 0;
#pragma unroll 1
    for (int t = 0; t < nk; ++t) {
        if (t + 1 < nk) { if (NL == 6) asm volatile("s_waitcnt vmcnt(6)" ::: "memory"); else if (NL == 5) asm volatile("s_waitcnt vmcnt(5)" ::: "memory"); else asm volatile("s_waitcnt vmcnt(4)" ::: "memory"); }
        else asm volatile("s_waitcnt vmcnt(0)" ::: "memory");
        __builtin_amdgcn_s_barrier();
        if (t + 2 < nk) { int nx = cur + 2; if (nx >= 3) nx -= 3; g3_issue<BM>(g, t + 2, lds + nx * STAGE, tid); }
        const unsigned char* cA = lds + cur * STAGE;
        const unsigned char* cB = cA + BM * 128;
#pragma unroll
        for (int ks = 0; ks < 2; ++ks) {
            bf16x8 a[MI], b[4];
#pragma unroll
            for (int m = 0; m < MI; ++m) { const int row = wr * (BM / 4) + m * 16 + fr; a[m] = *(const bf16x8*)(cA + row * 128 + (((ks * 4 + fq) ^ (row & 7)) << 4)); }
#pragma unroll
            for (int n = 0; n < 4; ++n) { const int row = wc * 64 + n * 16 + fr; b[n] = *(const bf16x8*)(cB + row * 128 + (((ks * 4 + fq) ^ (row & 7)) << 4)); }
#pragma unroll
            for (int m = 0; m < MI; ++m)
#pragma unroll
                for (int n = 0; n < 4; ++n) acc[m][n] = __builtin_amdgcn_mfma_f32_16x16x32_bf16(b[n], a[m], acc[m][n], 0, 0, 0);
        }
        cur = (cur == 2) ? 0 : cur + 1;
    }
    __builtin_amdgcn_s_barrier();
}
struct G3D { const bf16_t* ap[2]; const bf16_t* b1[2]; const bf16_t* b3[2]; };
__device__ __forceinline__ void g3d_issue(const G3D& g, int kt, unsigned char* stage, int tid) {
#pragma unroll
    for (int i = 0; i < 2; ++i) glds16(g.ap[i] + kt * 64, stage + (tid + i * NTHR) * 16);
#pragma unroll
    for (int i = 0; i < 2; ++i) glds16(g.b1[i] + kt * 64, stage + 16384 + (tid + i * NTHR) * 16);
#pragma unroll
    for (int i = 0; i < 2; ++i) glds16(g.b3[i] + kt * 64, stage + 32768 + (tid + i * NTHR) * 16);
}
__device__ __forceinline__ void g3d_kloop(f32x4 (&acc1)[2][4], f32x4 (&acc3)[2][4], const G3D& g, int K, unsigned char* lds) {
    constexpr int STAGE = 49152;
    const int tid = otid(), lane = tid & 63, wid = tid >> 6, wr = wid >> 1, wc = wid & 1, fr = lane & 15, fq = lane >> 4;
    const int nk = K >> 6;
    g3d_issue(g, 0, lds, tid);
    if (nk > 1) g3d_issue(g, 1, lds + STAGE, tid);
    int cur = 0;
#pragma unroll 1
    for (int t = 0; t < nk; ++t) {
        if (t + 1 < nk) asm volatile("s_waitcnt vmcnt(6)" ::: "memory"); else asm volatile("s_waitcnt vmcnt(0)" ::: "memory");
        __builtin_amdgcn_s_barrier();
        if (t + 2 < nk) { int nx = cur + 2; if (nx >= 3) nx -= 3; g3d_issue(g, t + 2, lds + nx * STAGE, tid); }
        const unsigned char* cA = lds + cur * STAGE;
#pragma unroll
        for (int ks = 0; ks < 2; ++ks) {
            bf16x8 a[2], b1[4], b3[4];
#pragma unroll
            for (int m = 0; m < 2; ++m) { const int row = wr * 32 + m * 16 + fr; a[m] = *(const bf16x8*)(cA + row * 128 + (((ks * 4 + fq) ^ (row & 7)) << 4)); }
#pragma unroll
            for (int n = 0; n < 4; ++n) { const int row = wc * 64 + n * 16 + fr; const int off = row * 128 + (((ks * 4 + fq) ^ (row & 7)) << 4);
                b1[n] = *(const bf16x8*)(cA + 16384 + off); b3[n] = *(const bf16x8*)(cA + 32768 + off); }
#pragma unroll
            for (int m = 0; m < 2; ++m)
#pragma unroll
                for (int n = 0; n < 4; ++n) {
                    acc1[m][n] = __builtin_amdgcn_mfma_f32_16x16x32_bf16(b1[n], a[m], acc1[m][n], 0, 0, 0);
                    acc3[m][n] = __builtin_amdgcn_mfma_f32_16x16x32_bf16(b3[n], a[m], acc3[m][n], 0, 0, 0);
                }
        }
        cur = (cur == 2) ? 0 : cur + 1;
    }
    __builtin_amdgcn_s_barrier();
}
template <int MI>
__device__ __forceinline__ void g3_zero(f32x4 (&acc)[MI][4]) {
#pragma unroll
    for (int m = 0; m < MI; ++m)
#pragma unroll
        for (int n = 0; n < 4; ++n) acc[m][n] = (f32x4){0.f, 0.f, 0.f, 0.f};
}
__device__ __forceinline__ uint2 pack4(float a, float b, float c, float d) {
    uint2 r; r.x = pk2(a, b); r.y = pk2(c, d); return r;
}

namespace pg8 {
#define PG8_LAS __attribute__((address_space(3)))
typedef unsigned short bf16_t;
typedef short bf16x8 __attribute__((ext_vector_type(8)));
typedef float f32x4 __attribute__((ext_vector_type(4)));
typedef unsigned u32x4 __attribute__((ext_vector_type(4)));
constexpr int BM = 256, BK = 64, HALF = 128, HTB = HALF * BK * 2  , STAGE_BYTES = 8 * HTB, NXCD = 8, WGM = 8;

__host__ __device__ __forceinline__ int lds_byte(int r, int c) { const int st = (r >> 4) * 2 + (c >> 5), rr = r & 15, cc = c & 31, ob = rr * 64 + cc * 2; return st * 1024 + (ob ^ (((ob >> 9) & 1) << 5)); }
__host__ __device__ __forceinline__ void stage_rc(int b, int& R, int& C) { const int st = b / 1024, sb = b % 1024, swz = sb ^ (((sb >> 9) & 1) << 5); R = (st >> 1) * 16 + swz / 64; C = (st & 1) * 32 + (swz % 64) / 2; }
__host__ __device__ __forceinline__ int perm32(int rho) { const int n = rho >> 4, i = rho & 15; return 8 * (i >> 2) + 4 * n + (i & 3); }

struct Unit { int pm, pn; };
struct Gemm { const bf16_t* A; const bf16_t* Bt; int M, N, K; };

struct StaticOrder {
    int nM, nN, nwg, G, c;
    __host__ __device__ void init(int M, int N, int G_, int c_) { nM = M / BM; nN = N / BM; nwg = nM * nN; G = G_; c = c_; }
    __host__ __device__ bool next(int i, Unit& u) const {
        const long L = (long)i * G + c; if (L >= nwg) return false;
        int wgid = (int)L; { const int q = nwg / NXCD, r = nwg % NXCD, xcd = wgid % NXCD, off = wgid / NXCD; wgid = (xcd < r ? xcd * (q + 1) : r * (q + 1) + (xcd - r) * q) + off; }
        const int nig = WGM * nN, gid = wgid / nig, fm = gid * WGM, gsz = (nM - fm) < WGM ? (nM - fm) : WGM;
        u.pm = fm + ((wgid % nig) % gsz); u.pn = (wgid % nig) / gsz; return true;
    }
    __device__ __forceinline__ void a_ready(const Unit&) const {}
    __device__ __forceinline__ void done(const Unit&) const {}
};
template <class Epi, class Sched, bool STAMP = false>
__device__ __forceinline__ void gemm_phase(PG8_LAS unsigned char* lds, const Gemm g, const Sched& S, const Epi& E, unsigned long long* stamps) {
    const int tid = otid(), wid = __builtin_amdgcn_readfirstlane(tid >> 6), lane = tid & 63, wr = wid >> 2, wc = wid & 3, fr = lane & 15, fq = lane >> 4;
    const int K = g.K, nt = K / BK;
    int ts_lo = 0, ts_hi = 0, nts = 0; const unsigned long long rt_entry = STAMP ? 0ull : 0ull;
#define PG8_STAMP() do { if (STAMP && wid == 0 && nts < 64) { const unsigned long long _c = 0ull; \
        ts_lo = (lane == nts) ? (int)(unsigned)_c : ts_lo; ts_hi = (lane == nts) ? (int)(unsigned)(_c >> 32) : ts_hi; ++nts; } } while (0)
    PG8_STAMP();
    unsigned voffA[2], voffB[2];
#pragma unroll
    for (int i = 0; i < 2; ++i) { int R, C; stage_rc(tid * 16 + i * 8192, R, C); const int Rb = Epi::PERM ? ((R & ~31) + perm32(R & 31)) : R;
        voffA[i] = (unsigned)(R * K + C) * 2u; voffB[i] = (unsigned)(Rb * K + C) * 2u; }
    const size_t kstep = (size_t)(BK * 2);
    const size_t hstep = (size_t)HALF * K * 2;
    const size_t tstep = 2 * hstep;
    const unsigned ldsw = (unsigned)wid * 1024u;
    const int aoff = lds_byte(wr * 64 + fr, fq * 8), boff = lds_byte(wc * 32 + fr, fq * 8);
#define PG8_SA(b, h) (((b) * 2 + (h)) * HTB)
#define PG8_SB(b, h) ((4 + (b) * 2 + (h)) * HTB)
#define PG8_STAGE(bufoff, gbase, voff) do { _Pragma("unroll") for (int _i = 0; _i < 2; ++_i) \
        __builtin_amdgcn_global_load_lds((const unsigned*)((const char*)(gbase) + (voff)[_i]), (PG8_LAS unsigned*)(lds + (bufoff) + ldsw + _i * 8192), 16, 0, 0); } while (0)
#define PG8_LDA(dst, b, h) do { _Pragma("unroll") for (int m = 0; m < 4; ++m) _Pragma("unroll") for (int k = 0; k < 2; ++k) dst[m][k] = *(const PG8_LAS bf16x8*)(lds + PG8_SA(b, h) + aoff + m * 2048 + k * 1024); } while (0)
#define PG8_LDB(dst, b, h) do { _Pragma("unroll") for (int n = 0; n < 2; ++n) _Pragma("unroll") for (int k = 0; k < 2; ++k) dst[n][k] = *(const PG8_LAS bf16x8*)(lds + PG8_SB(b, h) + boff + n * 2048 + k * 1024); } while (0)
#define PG8_MMA(ai, bj, At, Bt) do { __builtin_amdgcn_s_setprio(1); _Pragma("unroll") for (int m = 0; m < 4; ++m) _Pragma("unroll") for (int n = 0; n < 2; ++n) _Pragma("unroll") for (int k = 0; k < 2; ++k) \
        acc[ai][bj][m][n] = __builtin_amdgcn_mfma_f32_16x16x32_bf16(Bt[n][k], At[m][k], acc[ai][bj][m][n], 0, 0, 0); __builtin_amdgcn_s_setprio(0); } while (0)
#define PG8_WAIT_V(n) asm volatile("s_waitcnt vmcnt(" #n ")" ::: "memory")
#define PG8_WAIT_L(n) asm volatile("s_waitcnt lgkmcnt(" #n ")" ::: "memory")
#define PG8_BAR __builtin_amdgcn_s_barrier()
#define PG8_SCHED __builtin_amdgcn_sched_barrier(0)
    Unit cur, nxt; int ui = 0;
    if (!S.next(0, cur)) return;
    f32x4 acc[2][2][4][2];
#pragma unroll
    for (int a = 0; a < 2; ++a)
#pragma unroll
        for (int b = 0; b < 2; ++b)
#pragma unroll
            for (int m = 0; m < 4; ++m)
#pragma unroll
                for (int n = 0; n < 2; ++n) acc[a][b][m][n] = (f32x4){0.f, 0.f, 0.f, 0.f};
    bf16x8 At[4][2], B0[2][2], B1[2][2];
    const char* cA = (const char*)g.A + (size_t)cur.pm * tstep; const char* cB = (const char*)g.Bt + (size_t)cur.pn * tstep;
    S.a_ready(cur);
    PG8_STAGE(PG8_SB(0, 0), cB, voffB); PG8_STAGE(PG8_SA(0, 0), cA, voffA); PG8_STAGE(PG8_SB(0, 1), cB + hstep, voffB); PG8_STAGE(PG8_SA(0, 1), cA + hstep, voffA);
    if (wr == 1) PG8_BAR;
    PG8_WAIT_V(4); PG8_BAR;
    PG8_STAGE(PG8_SB(1, 0), cB + kstep, voffB); PG8_STAGE(PG8_SA(1, 0), cA + kstep, voffA); PG8_STAGE(PG8_SB(1, 1), cB + hstep + kstep, voffB);
    PG8_WAIT_V(6); PG8_BAR;
    PG8_STAMP();
    for (;;) {
        const bool has_next = S.next(ui + 1, nxt);
        const char* nA = has_next ? (const char*)g.A + (size_t)nxt.pm * tstep : cA; const char* nB = has_next ? (const char*)g.Bt + (size_t)nxt.pn * tstep : cB;
        for (int t = 0; t < nt; t += 2) {
            const bool last = (t == nt - 2);
            const char* a1 = cA + (size_t)(t + 1) * kstep;
            const char* a2 = last ? nA : cA + (size_t)(t + 2) * kstep; const char* b2 = last ? nB : cB + (size_t)(t + 2) * kstep;
            const char* a3 = a2 + kstep; const char* b3 = b2 + kstep;
            if (last && has_next) S.a_ready(nxt);
            PG8_LDB(B0, 0, 0); PG8_SCHED; PG8_LDA(At, 0, 0); PG8_STAGE(PG8_SA(1, 1), a1 + hstep, voffA);
            PG8_WAIT_L(8); PG8_BAR; PG8_WAIT_L(0); PG8_MMA(0, 0, At, B0); PG8_BAR; PG8_SCHED;
            PG8_LDB(B1, 0, 1); PG8_STAGE(PG8_SB(0, 0), b2, voffB);
            PG8_BAR; PG8_WAIT_L(0); PG8_MMA(0, 1, At, B1); PG8_BAR;
            PG8_LDA(At, 0, 1); PG8_STAGE(PG8_SA(0, 0), a2, voffA);
            PG8_BAR; PG8_WAIT_L(0); PG8_MMA(1, 0, At, B0); PG8_BAR; PG8_SCHED;
            PG8_STAGE(PG8_SB(0, 1), b2 + hstep, voffB);
            PG8_WAIT_V(6); PG8_BAR; PG8_MMA(1, 1, At, B1); PG8_BAR;
            PG8_LDB(B0, 1, 0); PG8_SCHED; PG8_LDA(At, 1, 0); PG8_STAGE(PG8_SA(0, 1), a2 + hstep, voffA);
            PG8_WAIT_L(8); PG8_BAR; PG8_WAIT_L(0); PG8_MMA(0, 0, At, B0); PG8_BAR; PG8_SCHED;
            PG8_LDB(B1, 1, 1); PG8_STAGE(PG8_SB(1, 0), b3, voffB);
            PG8_BAR; PG8_WAIT_L(0); PG8_MMA(0, 1, At, B1); PG8_BAR;
            PG8_LDA(At, 1, 1); PG8_STAGE(PG8_SA(1, 0), a3, voffA);
            PG8_BAR; PG8_WAIT_L(0); PG8_MMA(1, 0, At, B0); PG8_BAR; PG8_SCHED;
            PG8_STAGE(PG8_SB(1, 1), b3 + hstep, voffB);
            PG8_WAIT_V(6); PG8_BAR; PG8_MMA(1, 1, At, B1); PG8_BAR;
        }
        PG8_STAMP();
        if constexpr (!Epi::AFTER_DRAIN) { E(acc, cur, wr, wc, fr, fq); S.done(cur); }
        PG8_STAMP();
        if (!has_next) break;
#pragma unroll
        for (int a = 0; a < 2; ++a)
#pragma unroll
            for (int b = 0; b < 2; ++b)
#pragma unroll
                for (int m = 0; m < 4; ++m)
#pragma unroll
                    for (int n = 0; n < 2; ++n) acc[a][b][m][n] = (f32x4){0.f, 0.f, 0.f, 0.f};
        cur = nxt; cA = nA; cB = nB; ++ui;
    }
    PG8_WAIT_V(0);
    if (wr == 0) PG8_BAR;
    PG8_BAR;
    if constexpr (Epi::AFTER_DRAIN) { E.fused(acc, cur, wr, wc, fr, fq, lds, wid, lane); S.done(cur); }
    PG8_STAMP();
    if (STAMP && wid == 0) { stamps[lane] = lane < nts ? (((unsigned long long)(unsigned)ts_hi << 32) | (unsigned)ts_lo) : 0ull;
        if (lane == 62) stamps[62] = rt_entry; if (lane == 63) stamps[63] = 0ull; }
#undef PG8_STAMP
#undef PG8_SA
#undef PG8_SB
#undef PG8_STAGE
#undef PG8_LDA
#undef PG8_LDB
#undef PG8_MMA
#undef PG8_WAIT_V
#undef PG8_WAIT_L
#undef PG8_BAR
#undef PG8_SCHED
}
}

struct EpiInproj {
    static constexpr bool PERM = true, AFTER_DRAIN = false;
    unsigned char* ws; const float* rstd;
    __device__ __forceinline__ void operator()(const pg8::f32x4 (&acc)[2][2][4][2], const pg8::Unit& u, int wr, int wc, int fr, int fq) const {
        const int pn = u.pn;
        bf16_t* dst; int ld, cb;
        if (pn < 4) { dst = (bf16_t*)(ws + OFF_PPOOL); ld = 1024; cb = pn * 256; }
        else if (pn < 8) { dst = (bf16_t*)(ws + OFF_PR); ld = 1024; cb = (pn - 4) * 256; }
        else if (pn < 12) { dst = (bf16_t*)(ws + OFF_PK); ld = 1024; cb = (pn - 8) * 256; }
        else if (pn < 16) { dst = (bf16_t*)(ws + OFF_PV); ld = 1024; cb = (pn - 12) * 256; }
        else { dst = (bf16_t*)(ws + OFF_PMISC); ld = PM_LD; cb = (pn - 16) * 256; }
        bf16_t* halo = (bf16_t*)(ws + OFF_HALO);
#pragma unroll
        for (int ai = 0; ai < 2; ++ai)
#pragma unroll
            for (int m = 0; m < 4; ++m) {
                const int row = u.pm * 256 + ai * 128 + wr * 64 + m * 16 + fr;
                if (row < NT) {
                    const float rs = rstd[row];
                    const int lr = row & 127;
#pragma unroll
                    for (int bj = 0; bj < 2; ++bj) {
                        const int col = cb + bj * 128 + wc * 32 + fq * 8;
                        const uint2 lo = pack4(acc[ai][bj][m][0][0] * rs, acc[ai][bj][m][0][1] * rs, acc[ai][bj][m][0][2] * rs, acc[ai][bj][m][0][3] * rs);
                        const uint2 hi = pack4(acc[ai][bj][m][1][0] * rs, acc[ai][bj][m][1][1] * rs, acc[ai][bj][m][1][2] * rs, acc[ai][bj][m][1][3] * rs);
                        const uint4 v = make_uint4(lo.x, lo.y, hi.x, hi.y);
                        *(uint4*)(dst + (size_t)row * ld + col) = v;
                        if (pn < 4 && lr >= 112) *(uint4*)(halo + ((size_t)(row >> 7) * 16 + (lr - 112)) * 1024 + col) = v;
                    }
                }
            }
    }
};
__device__ void phase_inproj(const Params& p, unsigned char* lds) {
    pg8::StaticOrder S; S.init(NTP, NP1, (int)gridDim.x, obid());
    pg8::Gemm g; g.A = (const pg8::bf16_t*)(WS(p) + OFF_H); g.Bt = (const pg8::bf16_t*)(WS(p) + OFF_WB) + WB_WIN; g.M = NTP; g.N = NP1; g.K = DM;
    EpiInproj E; E.ws = WS(p); E.rstd = (const float*)(WS(p) + OFF_RSTD);
    pg8::gemm_phase<EpiInproj, pg8::StaticOrder, false>((PG8_LAS unsigned char*)lds, g, S, E, nullptr);
}

__device__ void phase_pool(const Params& p, int l, unsigned char* lds, int tb, int te, int tstep) {
    const int tid = otid(), lane = tid & 63, wid = tid >> 6, fr = lane & 15, fq = lane >> 4;
    bf16_t* pp = (bf16_t*)(WS(p) + OFF_PPOOL);
    const bf16_t* halo = (const bf16_t*)(WS(p) + OFF_HALO);
    const bf16_t* pw = (const bf16_t*)(WS(p) + OFF_WB) + WB_POOL;
    const float* scale = p.in[6] + (size_t)l * 1024;
    bf16_t* sp = (bf16_t*)lds;
    constexpr int SLD = 264;
    for (int tile = tb; tile < te; tile += tstep) {
        const int mt = tile >> 2, g = tile & 3;
        const int row0 = mt * 128, w = 2 << g;
        {
            const int c = tid & 255, r0 = (tid >> 8) * 64, col = g * 256 + c;
            auto rawv = [&](int n2) -> float {
                return (n2 >= row0) ? bf2f(pp[(size_t)n2 * 1024 + col]) : bf2f(halo[((size_t)(n2 >> 7) * 16 + ((n2 & 127) - 112)) * 1024 + col]);
            };
            int n = row0 + r0, t = n % TS;
            float sum = 0.f;
            const int have = (t < w) ? t : w;
            for (int i = 1; i <= have; ++i) sum += rawv(n - i);
#pragma unroll 4
            for (int r = 0; r < 64; ++r, ++n) {
                if (t == 0) sum = 0.f;
                const float v = rawv(n);
                sum += v;
                if (t >= w) sum -= rawv(n - w);
                const int cnt = (t + 1 < w) ? (t + 1) : w;
                sp[(r0 + r) * SLD + c] = f2bf(sum * (1.0f / (float)cnt) - v);
                t = (t + 1 == TS) ? 0 : t + 1;
            }
        }
        __syncthreads();
        f32x4 acc[8][2];
#pragma unroll
        for (int m = 0; m < 8; ++m) { acc[m][0] = (f32x4){0.f, 0.f, 0.f, 0.f}; acc[m][1] = (f32x4){0.f, 0.f, 0.f, 0.f}; }
        const bf16_t* wg = pw + (size_t)g * 65536;
#pragma unroll 1
        for (int kk = 0; kk < 8; ++kk) {
            bf16x8 bfr[2];
#pragma unroll
            for (int n = 0; n < 2; ++n) bfr[n] = *(const bf16x8*)(wg + (size_t)(wid * 32 + n * 16 + fr) * 256 + kk * 32 + fq * 8);
#pragma unroll
            for (int m = 0; m < 8; ++m) {
                const bf16x8 a = *(const bf16x8*)(sp + (m * 16 + fr) * SLD + kk * 32 + fq * 8);
                acc[m][0] = __builtin_amdgcn_mfma_f32_16x16x32_bf16(a, bfr[0], acc[m][0], 0, 0, 0);
                acc[m][1] = __builtin_amdgcn_mfma_f32_16x16x32_bf16(a, bfr[1], acc[m][1], 0, 0, 0);
            }
        }
#pragma unroll
        for (int m = 0; m < 8; ++m)
#pragma unroll
            for (int n = 0; n < 2; ++n) {
                const int col = g * 256 + wid * 32 + n * 16 + fr;
                const float sc = scale[col];
#pragma unroll
                for (int j = 0; j < 4; ++j) {
                    const int row = row0 + m * 16 + fq * 4 + j;
                    pp[(size_t)row * 1024 + col] = f2bf(acc[m][n][j] * sc);
                }
            }
        __syncthreads();
    }
}

__device__ void phase_dsa_prep(const Params& p, int l) {
    const int lane = otid() & 63;
    const int wave = (obid() * NTHR + otid()) >> 6, nw = gridDim.x * NTHR / 64;
    const bf16_t* pm = (const bf16_t*)(WS(p) + OFF_PMISC);
    unsigned char* dob = OUTB(p);
    bf16_t* cqn = (bf16_t*)(dob + DO_CQN);
    bf16_t* kv = (bf16_t*)(dob + DO_KV);
    bf16_t* kidx = (bf16_t*)(dob + DO_KIDX);
    float* whead = (float*)(dob + DO_WHEAD);
    const float* ctab = (const float*)(WS(p) + OFF_ROPE);
    const float* stab = ctab + TS * 16;
    const bf16_t* hrow = (const bf16_t*)(WS(p) + OFF_H);
    const bf16_t* wwidx = (const bf16_t*)(WS(p) + OFF_WB) + WB_WIDX;
    const float* rstd_ = (const float*)(WS(p) + OFF_RSTD);
    const float4 qn4 = *(const float4*)(p.in[21] + l * 256 + lane * 4);
    const float2 kvn2 = *(const float2*)(p.in[22] + l * 128 + lane * 2);
    const float inw = p.in[27][l * 64 + lane], inb = p.in[28][l * 64 + lane];
    uint4 ww[8][2];
#pragma unroll
    for (int j = 0; j < 8; ++j) { ww[j][0] = *(const uint4*)(wwidx + (size_t)j * DM + lane * 16); ww[j][1] = *(const uint4*)(wwidx + (size_t)j * DM + lane * 16 + 8); }
    struct In { uint2 cq; unsigned ckv; bf16_t kr0, kr1, kix; uint4 h0, h1; float rs, c, s; };
    auto load = [&](int n) {
        In r;
        const bf16_t* row = pm + (size_t)n * PM_LD;
        const int t = n % TS;
        r.cq = *(const uint2*)(row + PM_CQ + lane * 4);
        r.ckv = *(const unsigned*)(row + PM_CKV + lane * 2);
        r.kr0 = row[PM_KROPE + (lane & 15)]; r.kr1 = row[PM_KROPE + 16 + (lane & 15)];
        r.kix = row[PM_KIDX + lane];
        r.h0 = *(const uint4*)(hrow + (size_t)n * DM + lane * 16); r.h1 = *(const uint4*)(hrow + (size_t)n * DM + lane * 16 + 8);
        r.rs = rstd_[n];
        r.c = ctab[t * 16 + (lane & 15)]; r.s = stab[t * 16 + (lane & 15)];
        return r;
    };
    In cur = load(wave < NT ? wave : 0);
    for (int n = wave; n < NT; n += nw) {
        const In x = cur;
        if (n + nw < NT) cur = load(n + nw);
        {
            const float v0 = __uint_as_float(x.cq.x << 16), v1 = __uint_as_float(x.cq.x & 0xFFFF0000u), v2 = __uint_as_float(x.cq.y << 16), v3 = __uint_as_float(x.cq.y & 0xFFFF0000u);
            const float ss = wave_sum_fast(v0 * v0 + v1 * v1 + v2 * v2 + v3 * v3);
            const float rs = rsqrtf(ss * (1.0f / 256.0f) + 1e-6f);
            *(uint2*)(cqn + (size_t)n * 256 + lane * 4) = pack4(v0 * rs * qn4.x, v1 * rs * qn4.y, v2 * rs * qn4.z, v3 * rs * qn4.w);
        }
        {
            const float v0 = __uint_as_float(x.ckv << 16), v1 = __uint_as_float(x.ckv & 0xFFFF0000u);
            const float ss = wave_sum_fast(v0 * v0 + v1 * v1);
            const float rs = rsqrtf(ss * (1.0f / 128.0f) + 1e-6f);
            *(unsigned*)(kv + (size_t)n * 160 + lane * 2) = pk2(v0 * rs * kvn2.x, v1 * rs * kvn2.y);
        }
        if (lane < 16) {
            const float x1 = bf2f(x.kr0), x2 = bf2f(x.kr1);
            kv[(size_t)n * 160 + 128 + lane] = f2bf(x1 * x.c - x2 * x.s);
            kv[(size_t)n * 160 + 144 + lane] = f2bf(x2 * x.c + x1 * x.s);
        }
        {
            const float xv = bf2f(x.kix);
            const float mu = wave_sum_fast(xv) * (1.0f / 64.0f);
            const float d = xv - mu;
            const float var = wave_sum_fast(d * d) * (1.0f / 64.0f);
            const float y = d * rsqrtf(var + 1e-6f) * inw + inb;
            const float yo = __shfl_xor(y, 16);
            float o = y;
            if (lane < 32) o = (lane < 16) ? (y * x.c - yo * x.s) : (y * x.c + yo * x.s);
            kidx[(size_t)n * 64 + lane] = f2bf(o);
        }
        {
            const uint4 hv0 = x.h0, hv1 = x.h1;
            float hx[16];
            hx[0] = __uint_as_float(hv0.x << 16); hx[1] = __uint_as_float(hv0.x & 0xFFFF0000u); hx[2] = __uint_as_float(hv0.y << 16); hx[3] = __uint_as_float(hv0.y & 0xFFFF0000u);
            hx[4] = __uint_as_float(hv0.z << 16); hx[5] = __uint_as_float(hv0.z & 0xFFFF0000u); hx[6] = __uint_as_float(hv0.w << 16); hx[7] = __uint_as_float(hv0.w & 0xFFFF0000u);
            hx[8] = __uint_as_float(hv1.x << 16); hx[9] = __uint_as_float(hv1.x & 0xFFFF0000u); hx[10] = __uint_as_float(hv1.y << 16); hx[11] = __uint_as_float(hv1.y & 0xFFFF0000u);
            hx[12] = __uint_as_float(hv1.z << 16); hx[13] = __uint_as_float(hv1.z & 0xFFFF0000u); hx[14] = __uint_as_float(hv1.w << 16); hx[15] = __uint_as_float(hv1.w & 0xFFFF0000u);
            float myw = 0.f;
#pragma unroll
            for (int j = 0; j < 8; ++j) {
                const uint4 w0 = ww[j][0], w1 = ww[j][1];
                float d = hx[0] * __uint_as_float(w0.x << 16) + hx[1] * __uint_as_float(w0.x & 0xFFFF0000u) + hx[2] * __uint_as_float(w0.y << 16) + hx[3] * __uint_as_float(w0.y & 0xFFFF0000u)
                        + hx[4] * __uint_as_float(w0.z << 16) + hx[5] * __uint_as_float(w0.z & 0xFFFF0000u) + hx[6] * __uint_as_float(w0.w << 16) + hx[7] * __uint_as_float(w0.w & 0xFFFF0000u)
                        + hx[8] * __uint_as_float(w1.x << 16) + hx[9] * __uint_as_float(w1.x & 0xFFFF0000u) + hx[10] * __uint_as_float(w1.y << 16) + hx[11] * __uint_as_float(w1.y & 0xFFFF0000u)
                        + hx[12] * __uint_as_float(w1.z << 16) + hx[13] * __uint_as_float(w1.z & 0xFFFF0000u) + hx[14] * __uint_as_float(w1.w << 16) + hx[15] * __uint_as_float(w1.w & 0xFFFF0000u);
                d = wave_sum_fast(d);
                myw = (lane == j) ? d : myw;
            }
            if (lane < 8) whead[(size_t)n * 8 + lane] = myw * x.rs * 0.04419417382415922f;
        }
    }
}

typedef short s16x4 __attribute__((ext_vector_type(4)));
__device__ __forceinline__ unsigned f2h_bits(float f) { const _Float16 h = (_Float16)f; unsigned short u; __builtin_memcpy(&u, &h, 2); return u; }
template <bool IMPORT_SEL>
__device__ void phase_dsa(const Params& p, int l, unsigned char* lds, bf16_t* yc, const unsigned short* gsel, const int* gnsel, int tb, int te, int tstep) {
    unsigned short* s_sc = (unsigned short*)lds;
    bf16_t* s_qi = (bf16_t*)(lds + 66048);
    bf16_t* s_Q = (bf16_t*)lds;
    unsigned short* s_sel = (unsigned short*)(lds + 82432 + 65536);
    int* s_nsel = (int*)(lds + 82432 + 65536 + 8192);
    unsigned char* dob = OUTB(p);
    const bf16_t* cqn = (const bf16_t*)(dob + DO_CQN);
    const bf16_t* kv = (const bf16_t*)(dob + DO_KV);
    const bf16_t* kidx = (const bf16_t*)(dob + DO_KIDX);
    const float* whead = (const float*)(dob + DO_WHEAD);
    const float* ctab = (const float*)(WS(p) + OFF_ROPE);
    const float* stab = ctab + TS * 16;
    const bf16_t* wb = (const bf16_t*)(WS(p) + OFF_WB);
    const bf16_t* wqiT = wb + WB_QI;
    const bf16_t* wuqT = wb + WB_UQ;
    const bf16_t* wuk = wb + WB_UK;
    const bf16_t* wuvT = wb + WB_UV;
    const float scale = 0.10206207261596575f;
    const f32x4 z4 = {0.f, 0.f, 0.f, 0.f};
    bf16_t* gq = (obid() < QS_WS) ? (bf16_t*)(WS(p) + WS_END + (size_t)obid() * QS_BYTES) : (bf16_t*)(OUTB(p) + DO_END + (size_t)(obid() - QS_WS) * QS_BYTES);
    for (int pair = tb; pair < te; pair += tstep) {
        const int qt = 128 - (pair >> 2);
        const int t0 = qt * 16;
#pragma unroll 1
        for (int half = 0; half < 2; ++half) {
        const int tid = otid(), lane = tid & 63, wid = tid >> 6, fr = lane & 15, fq = lane >> 4;
        unsigned char* s_Vw = lds + 82432 + wid * 8192;
        bf16_t* s_qn = (bf16_t*)s_Vw;
        const int b = (pair & 3) * 2 + half;
        const size_t n0 = (size_t)b * TS + t0;
        {
            bf16x8 acq[8];
#pragma unroll
            for (int kk = 0; kk < 8; ++kk) acq[kk] = *(const bf16x8*)(cqn + (n0 + fr) * 256 + kk * 32 + fq * 8);
            f32x4 c[4] = {z4, z4, z4, z4};
#pragma unroll
            for (int kb = 0; kb < 8; kb += 4) {
                bf16x8 bf[4][4];
#pragma unroll
                for (int k4 = 0; k4 < 4; ++k4)
#pragma unroll
                    for (int nt = 0; nt < 4; ++nt) bf[k4][nt] = *(const bf16x8*)(wqiT + (size_t)(wid * 64 + nt * 16 + fr) * 256 + (kb + k4) * 32 + fq * 8);
#pragma unroll
                for (int k4 = 0; k4 < 4; ++k4)
#pragma unroll
                    for (int nt = 0; nt < 4; ++nt) c[nt] = __builtin_amdgcn_mfma_f32_16x16x32_bf16(acq[kb + k4], bf[k4][nt], c[nt], 0, 0, 0);
            }
#pragma unroll
            for (int j = 0; j < 4; ++j) {
                const int t = t0 + fq * 4 + j;
                const float cs = ctab[t * 16 + fr], sn = stab[t * 16 + fr];
                const float x1 = c[0][j], x2 = c[1][j];
                c[0][j] = x1 * cs - x2 * sn; c[1][j] = x2 * cs + x1 * sn;
            }
#pragma unroll
            for (int nt = 0; nt < 4; ++nt)
#pragma unroll
                for (int j = 0; j < 4; ++j) s_qi[(fq * 4 + j) * 512 + wid * 64 + nt * 16 + fr] = f2bf(c[nt][j]);
        }
        __syncthreads();
        if (!IMPORT_SEL) {
            bf16x8 aq[8][2];
#pragma unroll
            for (int h = 0; h < 8; ++h)
#pragma unroll
                for (int ks = 0; ks < 2; ++ks) aq[h][ks] = *(const bf16x8*)(s_qi + fr * 512 + h * 64 + ks * 32 + fq * 8);
            float wh[4][8];
#pragma unroll
            for (int j = 0; j < 4; ++j) {
                const float4 w0 = *(const float4*)(whead + (n0 + fq * 4 + j) * 8), w1 = *(const float4*)(whead + (n0 + fq * 4 + j) * 8 + 4);
                wh[j][0] = w0.x; wh[j][1] = w0.y; wh[j][2] = w0.z; wh[j][3] = w0.w; wh[j][4] = w1.x; wh[j][5] = w1.y; wh[j][6] = w1.z; wh[j][7] = w1.w;
            }
            const int nkt = qt + 1;
            bf16x8 nb0 = {0, 0, 0, 0, 0, 0, 0, 0}, nb1 = nb0;
            if (wid < nkt) { const bf16_t* kr0 = kidx + ((size_t)b * TS + wid * 16 + fr) * 64 + fq * 8; nb0 = *(const bf16x8*)kr0; nb1 = *(const bf16x8*)(kr0 + 32); }
#pragma unroll 1
            for (int kt = wid; kt < nkt; kt += 8) {
                const bf16x8 bk0 = nb0, bk1 = nb1;
                if (kt + 8 < nkt) { const bf16_t* krn = kidx + ((size_t)b * TS + (kt + 8) * 16 + fr) * 64 + fq * 8; nb0 = *(const bf16x8*)krn; nb1 = *(const bf16x8*)(krn + 32); }
                float I[4] = {0.f, 0.f, 0.f, 0.f};
#pragma unroll
                for (int h = 0; h < 8; ++h) {
                    f32x4 a = __builtin_amdgcn_mfma_f32_16x16x32_bf16(aq[h][0], bk0, z4, 0, 0, 0);
                    a = __builtin_amdgcn_mfma_f32_16x16x32_bf16(aq[h][1], bk1, a, 0, 0, 0);
#pragma unroll
                    for (int j = 0; j < 4; ++j) I[j] += wh[j][h] * fmaxf(a[j], 0.f);
                }
#pragma unroll
                for (int j = 0; j < 4; ++j) s_sc[(fq * 4 + j) * 2064 + kt * 16 + fr] = (unsigned short)f2h_bits(I[j]);
            }
        }
        __syncthreads();
#pragma unroll 1
        for (int qi2 = 0; qi2 < 2; ++qi2) {
            const int q = wid + qi2 * 8;
            const int nadm = t0 + q + 1;
            unsigned short* sel = s_sel + q * 256;
            if (IMPORT_SEL) {
                const int ns = gnsel[n0 + q];
                for (int i = lane; i < ns; i += 64) sel[i] = gsel[(n0 + q) * 256 + i];
                if (lane == 0) s_nsel[q] = ns;
            } else if (nadm <= 256) {
                for (int i = lane; i < nadm; i += 64) sel[i] = (unsigned short)i;
                if (lane == 0) s_nsel[q] = nadm;
            } else {
                unsigned* hist = (unsigned*)(lds + 82432 + wid * 8192);
                const unsigned short* scq = s_sc + q * 2064;
                const int nch = (nadm + 63) >> 6;
                unsigned B1 = 0u; int na1 = 0, na2 = 0; unsigned T = 0u;
#pragma unroll 1
                for (int pass = 0; pass < 2; ++pass) {
                    *(uint4*)(hist + lane * 4) = make_uint4(0u, 0u, 0u, 0u);
#pragma unroll 1
                    for (int c0 = 0; c0 < nch; c0 += 8) {
                        unsigned kb[8];
#pragma unroll
                        for (int j = 0; j < 8; ++j) { const int s_ = (c0 + j) * 64 + lane; kb[j] = (s_ < nadm) ? (unsigned)scq[s_] : 0x10000u; }
#pragma unroll
                        for (int j = 0; j < 8; ++j) {
                            const unsigned u = kb[j];
                            const unsigned k = (u & 0x8000u) ? (~u & 0xFFFFu) : (u | 0x8000u);
                            const bool ok = (u < 0x10000u) && (pass == 0 || (k >> 8) == B1);
                            if (ok) atomicAdd(hist + (pass == 0 ? (k >> 8) : (k & 255u)), 1u);
                        }
                    }
                    const int need = 256 - na1;
                    const uint4 h4 = *(const uint4*)(hist + lane * 4);
                    const int sl = (int)(h4.x + h4.y + h4.z + h4.w);
                    int suf = sl;
#pragma unroll
                    for (int o = 1; o < 64; o <<= 1) { const int t_ = __shfl_down(suf, o); suf += (lane + o < 64) ? t_ : 0; }
                    const int above = suf - sl;
                    const bool mine = (suf >= need) && (above < need);
                    int a = above, bsel, asel;
                    if (a + (int)h4.w >= need) { bsel = 3; asel = a; }
                    else { a += (int)h4.w;
                        if (a + (int)h4.z >= need) { bsel = 2; asel = a; }
                        else { a += (int)h4.z;
                            if (a + (int)h4.y >= need) { bsel = 1; asel = a; }
                            else { a += (int)h4.y; bsel = 0; asel = a; } } }
                    const int src = __ffsll((long long)__ballot(mine)) - 1;
                    const unsigned bin = (unsigned)__shfl(lane * 4 + bsel, src); const int nab = __shfl(asel, src);
                    if (pass == 0) { B1 = bin; na1 = nab; } else { T = (B1 << 8) | bin; na2 = nab; }
                }
                {
                    const int rties = 256 - (na1 + na2);
                    int base = 0, ties = 0;
                    const unsigned long long ltmask = (1ull << lane) - 1ull;
#pragma unroll 1
                    for (int c0 = 0; c0 < nch; c0 += 4) {
                        unsigned kb[4];
#pragma unroll
                        for (int j = 0; j < 4; ++j) { const int s_ = (c0 + j) * 64 + lane; kb[j] = (s_ < nadm) ? (unsigned)scq[s_] : 0x10000u; }
#pragma unroll
                        for (int j = 0; j < 4; ++j) {
                            const int s_ = (c0 + j) * 64 + lane;
                            const unsigned u = kb[j];
                            const bool valid = u < 0x10000u;
                            const unsigned k = (u & 0x8000u) ? (~u & 0xFFFFu) : (u | 0x8000u);
                            const bool gt = valid && k > T, eq = valid && k == T;
                            const unsigned long long em = __ballot(eq);
                            const int myrank = ties + __popcll(em & ltmask);
                            const bool take = gt || (eq && myrank < rties);
                            const unsigned long long tm = __ballot(take);
                            const int pos = base + __popcll(tm & ltmask);
                            if (take && pos < 256) sel[pos] = (unsigned short)s_;
                            base += __popcll(tm); ties += __popcll(em);
                        }
                    }
                }
                if (lane == 0) s_nsel[q] = 256;
            }
        }
        __syncthreads();
        if (half == 0) {
            const size_t n0B = n0 + TS;
            bf16_t* s_qnB = s_qn + 1024;
#pragma unroll 1
            for (int hi = 0; hi < 2; ++hi) {
                const int hh = wid * 2 + hi;
                const bf16_t* caA = cqn + (n0 + fr) * 256 + fq * 8;
                const bf16_t* caB = cqn + (n0B + fr) * 256 + fq * 8;
                f32x4 cA[6] = {z4, z4, z4, z4, z4, z4}, cB[6] = {z4, z4, z4, z4, z4, z4};
#pragma unroll
                for (int kb = 0; kb < 8; kb += 2) {
                    bf16x8 bf[2][6], aA[2], aB[2];
#pragma unroll
                    for (int k2 = 0; k2 < 2; ++k2) {
                        aA[k2] = *(const bf16x8*)(caA + (kb + k2) * 32); aB[k2] = *(const bf16x8*)(caB + (kb + k2) * 32);
#pragma unroll
                        for (int nt = 0; nt < 6; ++nt) bf[k2][nt] = *(const bf16x8*)(wuqT + (size_t)(hh * 96 + nt * 16 + fr) * 256 + (kb + k2) * 32 + fq * 8);
                    }
#pragma unroll
                    for (int k2 = 0; k2 < 2; ++k2)
#pragma unroll
                        for (int nt = 0; nt < 6; ++nt) {
                            cA[nt] = __builtin_amdgcn_mfma_f32_16x16x32_bf16(aA[k2], bf[k2][nt], cA[nt], 0, 0, 0);
                            cB[nt] = __builtin_amdgcn_mfma_f32_16x16x32_bf16(aB[k2], bf[k2][nt], cB[nt], 0, 0, 0);
                        }
                }
#pragma unroll
                for (int j = 0; j < 4; ++j) {
                    const int q = fq * 4 + j, t = t0 + q;
                    const float cs = ctab[t * 16 + fr], sn = stab[t * 16 + fr];
                    s_Q[(q * 16 + hh) * 160 + 128 + fr] = f2bf(cA[4][j] * cs - cA[5][j] * sn);
                    s_Q[(q * 16 + hh) * 160 + 144 + fr] = f2bf(cA[5][j] * cs + cA[4][j] * sn);
                    gq[(q * 16 + hh) * 160 + 128 + fr] = f2bf(cB[4][j] * cs - cB[5][j] * sn);
                    gq[(q * 16 + hh) * 160 + 144 + fr] = f2bf(cB[5][j] * cs + cB[4][j] * sn);
#pragma unroll
                    for (int nt = 0; nt < 4; ++nt) { s_qn[q * 64 + nt * 16 + fr] = f2bf(cA[nt][j]); s_qnB[q * 64 + nt * 16 + fr] = f2bf(cB[nt][j]); }
                }
                __syncthreads();
                bf16x8 anA[2], anB[2];
#pragma unroll
                for (int ks = 0; ks < 2; ++ks) { anA[ks] = *(const bf16x8*)(s_qn + fr * 64 + ks * 32 + fq * 8); anB[ks] = *(const bf16x8*)(s_qnB + fr * 64 + ks * 32 + fq * 8); }
                bf16x8 bwk[8][2];
#pragma unroll
                for (int nt = 0; nt < 8; ++nt)
#pragma unroll
                    for (int ks = 0; ks < 2; ++ks) bwk[nt][ks] = *(const bf16x8*)(wuk + (size_t)(hh * 128 + nt * 16 + fr) * 64 + ks * 32 + fq * 8);
#pragma unroll
                for (int nt = 0; nt < 8; ++nt) {
                    f32x4 aA = z4, aB = z4;
#pragma unroll
                    for (int ks = 0; ks < 2; ++ks) {
                        aA = __builtin_amdgcn_mfma_f32_16x16x32_bf16(anA[ks], bwk[nt][ks], aA, 0, 0, 0);
                        aB = __builtin_amdgcn_mfma_f32_16x16x32_bf16(anB[ks], bwk[nt][ks], aB, 0, 0, 0);
                    }
#pragma unroll
                    for (int j = 0; j < 4; ++j) {
                        s_Q[((fq * 4 + j) * 16 + hh) * 160 + nt * 16 + fr] = f2bf(aA[j]);
                        gq[((fq * 4 + j) * 16 + hh) * 160 + nt * 16 + fr] = f2bf(aB[j]);
                    }
                }
                __syncthreads();
            }
        } else {
            for (int e = tid; e < QS_BYTES / 16; e += NTHR) ((uint4*)s_Q)[e] = ((const uint4*)gq)[e];
            __syncthreads();
        }
#pragma unroll 1
        for (int qi2 = 0; qi2 < 2; ++qi2) {
            const int q = wid + qi2 * 8;
            bf16x8 bq[5];
#pragma unroll
            for (int ks = 0; ks < 5; ++ks) bq[ks] = *(const bf16x8*)(s_Q + (q * 16 + fr) * 160 + ks * 32 + fq * 8);
            const int nsel = s_nsel[q];
            const unsigned short* sel = s_sel + q * 256;
            float m = -INFINITY, lsum = 0.f;
            f32x4 O[8] = {z4, z4, z4, z4, z4, z4, z4, z4};
            const int nchunk = (nsel + 31) >> 5;
            bf16x8 akn[2][5];
#pragma unroll
            for (int mt = 0; mt < 2; ++mt) {
                const int ki = mt * 16 + fr;
                const int sidx = sel[ki < nsel ? ki : 0];
                const bf16_t* krow = kv + ((size_t)b * TS + sidx) * 160 + fq * 8;
#pragma unroll
                for (int ks = 0; ks < 5; ++ks) akn[mt][ks] = *(const bf16x8*)(krow + ks * 32);
            }
#pragma unroll 1
            for (int ch = 0; ch < nchunk; ++ch) {
                bf16x8 ak[2][5];
#pragma unroll
                for (int mt = 0; mt < 2; ++mt)
#pragma unroll
                    for (int ks = 0; ks < 5; ++ks) ak[mt][ks] = akn[mt][ks];
                if (ch + 1 < nchunk) {
#pragma unroll
                    for (int mt = 0; mt < 2; ++mt) {
                        const int ki = (ch + 1) * 32 + mt * 16 + fr;
                        const int sidx = sel[ki < nsel ? ki : 0];
                        const bf16_t* krow = kv + ((size_t)b * TS + sidx) * 160 + fq * 8;
#pragma unroll
                        for (int ks = 0; ks < 5; ++ks) akn[mt][ks] = *(const bf16x8*)(krow + ks * 32);
                    }
                }
#pragma unroll
                for (int mt = 0; mt < 2; ++mt)
#pragma unroll
                    for (int ks = 0; ks < 4; ++ks) {
                        const int r = mt * 16 + fr;
                        *(bf16x8*)(s_Vw + r * 256 + (((ks * 2 + (fq >> 1)) ^ (r & 7)) * 32) + (fq & 1) * 16) = ak[mt][ks];
                    }
                f32x4 st[2] = {z4, z4};
#pragma unroll
                for (int mt = 0; mt < 2; ++mt)
#pragma unroll
                    for (int ks = 0; ks < 5; ++ks) st[mt] = __builtin_amdgcn_mfma_f32_16x16x32_bf16(ak[mt][ks], bq[ks], st[mt], 0, 0, 0);
                float sv[2][4]; float cmax = -INFINITY;
#pragma unroll
                for (int mt = 0; mt < 2; ++mt)
#pragma unroll
                    for (int j = 0; j < 4; ++j) {
                        const int ke = ch * 32 + mt * 16 + fq * 4 + j;
                        const float s_ = (ke < nsel) ? st[mt][j] * scale : -INFINITY;
                        sv[mt][j] = s_; cmax = fmaxf(cmax, s_);
                    }
                cmax = fmaxf(cmax, __shfl_xor(cmax, 16)); cmax = fmaxf(cmax, __shfl_xor(cmax, 32));
                const float mnew = fmaxf(m, cmax);
                const float alpha = __expf(m - mnew);
                float psum = 0.f;
#pragma unroll
                for (int mt = 0; mt < 2; ++mt)
#pragma unroll
                    for (int j = 0; j < 4; ++j) { const float pe = __expf(sv[mt][j] - mnew); sv[mt][j] = pe; psum += pe; }
                psum += __shfl_xor(psum, 16); psum += __shfl_xor(psum, 32);
                lsum = lsum * alpha + psum; m = mnew;
#pragma unroll
                for (int ct = 0; ct < 8; ++ct) O[ct] = O[ct] * alpha;
                bf16x8 pf;
#pragma unroll
                for (int mt = 0; mt < 2; ++mt)
#pragma unroll
                    for (int j = 0; j < 4; ++j) pf[mt * 4 + j] = (short)f2bf(sv[mt][j]);
                const int q_ = fr >> 2, p_ = fr & 3;
                const int r0 = fq * 4 + q_, r1 = 16 + r0;
#pragma unroll
                for (int ct = 0; ct < 8; ++ct) {
                    const s16x4 v0 = __builtin_amdgcn_ds_read_tr16_b64_v4i16((__attribute__((address_space(3))) s16x4*)(s_Vw + r0 * 256 + ((ct ^ (r0 & 7)) * 32) + p_ * 8));
                    const s16x4 v1 = __builtin_amdgcn_ds_read_tr16_b64_v4i16((__attribute__((address_space(3))) s16x4*)(s_Vw + r1 * 256 + ((ct ^ (r1 & 7)) * 32) + p_ * 8));
                    bf16x8 av; av[0] = v0[0]; av[1] = v0[1]; av[2] = v0[2]; av[3] = v0[3]; av[4] = v1[0]; av[5] = v1[1]; av[6] = v1[2]; av[7] = v1[3];
                    O[ct] = __builtin_amdgcn_mfma_f32_16x16x32_bf16(av, pf, O[ct], 0, 0, 0);
                }
            }
            const float inv = 1.0f / lsum;
#pragma unroll
            for (int ct = 0; ct < 8; ++ct)
#pragma unroll
                for (int j = 0; j < 4; ++j) s_Q[(q * 16 + fr) * 160 + ct * 16 + fq * 4 + j] = f2bf(O[ct][j] * inv);
        }
        __syncthreads();
#pragma unroll 1
        for (int hi = 0; hi < 2; ++hi) {
            const int hh = wid * 2 + hi;
            bf16x8 ao[4];
#pragma unroll
            for (int ks = 0; ks < 4; ++ks) ao[ks] = *(const bf16x8*)(s_Q + (fr * 16 + hh) * 160 + ks * 32 + fq * 8);
#pragma unroll
            for (int nt = 0; nt < 4; ++nt) {
                f32x4 a = z4;
#pragma unroll
                for (int ks = 0; ks < 4; ++ks)
                    a = __builtin_amdgcn_mfma_f32_16x16x32_bf16(ao[ks], *(const bf16x8*)(wuvT + (size_t)(hh * 64 + nt * 16 + fr) * 128 + ks * 32 + fq * 8), a, 0, 0, 0);
#pragma unroll
                for (int j = 0; j < 4; ++j) yc[(n0 + fq * 4 + j) * 1024 + hh * 64 + nt * 16 + fr] = f2bf(a[j]);
            }
        }
        __syncthreads();
        }
    }
}


__device__ void phase_lr_prep(const Params& p, int l) {
    const int lane = otid() & 63;
    const int wave = (obid() * NTHR + otid()) >> 6, nw = gridDim.x * NTHR / 64;
    const bf16_t* pm = (const bf16_t*)(WS(p) + OFF_PMISC);
    bf16_t* alr = (bf16_t*)(OUTB(p) + DO_ALR);
    const float4 mu4 = *(const float4*)(p.in[4] + (size_t)l * 3328 + 3072 + lane * 4);
    const float4 vm4 = *(const float4*)(p.in[18] + (lane & 7) * 4);
    struct In { uint2 c0, p0, c1, p1; };
    auto load = [&](int n) {
        In r;
        const bf16_t* row = pm + (size_t)n * PM_LD;
        const bool hp = (n % TS) > 0;
        r.c0 = *(const uint2*)(row + lane * 4);
        r.p0 = hp ? *(const uint2*)(row - PM_LD + lane * 4) : make_uint2(0u, 0u);
        r.c1 = make_uint2(0u, 0u); r.p1 = r.c1;
        if (lane < 8) { r.c1 = *(const uint2*)(row + 256 + lane * 4); if (hp) r.p1 = *(const uint2*)(row - PM_LD + 256 + lane * 4); }
        return r;
    };
    auto mix4 = [&](const uint2 c, const uint2 q, const float4 m, float (&o)[4]) {
        const float c0 = __uint_as_float(c.x << 16), c1 = __uint_as_float(c.x & 0xFFFF0000u), c2 = __uint_as_float(c.y << 16), c3 = __uint_as_float(c.y & 0xFFFF0000u);
        const float q0 = __uint_as_float(q.x << 16), q1 = __uint_as_float(q.x & 0xFFFF0000u), q2 = __uint_as_float(q.y << 16), q3 = __uint_as_float(q.y & 0xFFFF0000u);
        o[0] = c0 + (q0 - c0) * m.x; o[1] = c1 + (q1 - c1) * m.y; o[2] = c2 + (q2 - c2) * m.z; o[3] = c3 + (q3 - c3) * m.w;
    };
    In cur = load(wave < NT ? wave : 0);
    for (int n = wave; n < NT; n += nw) {
        const In x = cur;
        if (n + nw < NT) cur = load(n + nw);
        float o[4];
        mix4(x.c0, x.p0, mu4, o);
        if (lane < 16) { o[0] = tanhf(o[0]); o[1] = tanhf(o[1]); o[2] = tanhf(o[2]); o[3] = tanhf(o[3]); }
        else if (lane >= 32) { o[0] = sigmoidf_(o[0]); o[1] = sigmoidf_(o[1]); o[2] = sigmoidf_(o[2]); o[3] = sigmoidf_(o[3]); }
        *(uint2*)(alr + (size_t)n * 288 + lane * 4) = pack4(o[0], o[1], o[2], o[3]);
        if (lane < 8) {
            mix4(x.c1, x.p1, vm4, o);
            *(uint2*)(alr + (size_t)n * 288 + 256 + lane * 4) = pack4(o[0], o[1], o[2], o[3]);
        }
    }
}

typedef short sh4 __attribute__((ext_vector_type(4)));
__device__ __forceinline__ sh4 pk4v(const f32x4& v) { const uint2 u = pack4(v[0], v[1], v[2], v[3]); sh4 r; __builtin_memcpy(&r, &u, 8); return r; }
__device__ __forceinline__ bf16x8 cat8(const sh4& a, const sh4& b) { bf16x8 r; r[0] = a[0]; r[1] = a[1]; r[2] = a[2]; r[3] = a[3]; r[4] = b[0]; r[5] = b[1]; r[6] = b[2]; r[7] = b[3]; return r; }
#define MF32(a, b, c) __builtin_amdgcn_mfma_f32_16x16x32_bf16(a, b, c, 0, 0, 0)
#define MF16(a, b, c) MF32(cat8(a, sh4{0, 0, 0, 0}), cat8(b, sh4{0, 0, 0, 0}), c)
constexpr int SC_LT = 72;
constexpr int SC_LS = 36;
constexpr int SC_TC = 32;
constexpr int SC_ROWB = 1088;
__device__ __forceinline__ const unsigned char* scan_piece_src(const Params& p, int l, int b, int hc, int t0, int pi, bool& ok) {
    const int tau = pi / 68, seg = pi - tau * 68;
    const int t = t0 + tau;
    ok = (t < TS) && (tau < SC_TC);
    const size_t n = (size_t)b * TS + t;
    const unsigned char* ws = WS(p);
    if (seg < 8) return ws + OFF_PR + (n * 1024 + hc) * 2 + seg * 16;
    if (seg < 16) return ws + OFF_PK + (n * 1024 + hc) * 2 + (seg - 8) * 16;
    if (seg < 24) return ws + OFF_PV + (n * 1024 + hc) * 2 + (seg - 16) * 16;
    if (seg < 60) return OUTB(p) + DO_ALR + (n * 288) * 2 + (seg - 24) * 16;
    ok = ok && (l > 0);
    return ws + OFF_VFIRST + (n * 1024 + hc) * 2 + (seg - 60) * 16;
}
__device__ void phase_scan5(const Params& p, int l, unsigned char* lds, int blk) {
    const int tid = otid(), lane = tid & 63, wid = tid >> 6, fr = lane & 15, fq = lane >> 4;
    const int b = blk >> 4, hh = blk & 15, hc = hh * 64;
    float* s_r = (float*)lds;
    float* s_w = s_r + 2048;
    float* s_k = s_w + 2048;
    float* s_v = s_k + 2048;
    float* s_a = s_v + 2048;
    float* s_b = s_a + 2048;
    float* s_g = s_b + 2048;
    float* s_o = s_g + 2048;
    bf16_t* o_at = (bf16_t*)(s_o + 2048);
    bf16_t* o_rt = o_at + 32 * SC_LT;
    bf16_t* o_bt = o_rt + 32 * SC_LT;
    bf16_t* o_kt = o_bt + 32 * SC_LT;
    bf16_t* o_bT = o_kt + 32 * SC_LT;
    bf16_t* o_kT = o_bT + 64 * SC_LS;
    bf16_t* o_vT = o_kT + 64 * SC_LS;
    float* s_gc = (float*)(o_vT + 64 * SC_LS);
    unsigned char* raw = (unsigned char*)(s_gc + 128);
    float* prevb = (float*)(raw + 32 * SC_ROWB);
    unsigned* prevr = (unsigned*)prevb;
    float* s_bs = s_r;
    float* cst = prevb + 960;
    const float* mu = p.in[4] + (size_t)l * 3328;
    for (int e = tid; e < 480; e += NTHR) {
        float v;
        if (e < 192) v = mu[(e >> 6) * 1024 + hc + (e & 63)];
        else if (e < 448) v = mu[3072 + (e - 192)];
        else v = p.in[18][e - 448];
        cst[e] = v;
    }
    if (tid < 64) {
        cst[480 + tid] = p.in[7][l * 1024 + hc + tid];
        cst[544 + tid] = p.in[9][l * 1024 + hc + tid];
        cst[608 + tid] = p.in[12][l * 1024 + hc + tid];
        cst[672 + tid] = p.in[13][l * 1024 + hc + tid];
        cst[736 + tid] = p.in[14][l * 1024 + hc + tid];
        cst[800 + tid] = p.in[15][l * 1024 + hc + tid];
        cst[864 + tid] = p.in[16][l * 1024 + hc + tid];
        cst[928 + tid] = p.in[19][hc + tid];
    }
    const int mm = wid >> 1, ntb = (wid & 1) * 2;
    const int nks = (mm == 2) ? 4 : (mm == 3 ? 1 : 2);
    bf16x8 Bw[2][4];
    {
        const float* wsrc = (mm == 0) ? p.in[8] + (size_t)l * 64 * 1024 : (mm == 1) ? p.in[10] + (size_t)l * 64 * 1024 : (mm == 2) ? p.in[11] + (size_t)l * 128 * 1024 : p.in[20];
#pragma unroll
        for (int n2 = 0; n2 < 2; ++n2)
#pragma unroll
            for (int ks = 0; ks < 4; ++ks) {
                bf16x8 f;
#pragma unroll
                for (int j = 0; j < 8; ++j) {
                    const bool okw = ks < nks && (mm < 3 || l > 0);
                    const float v = wsrc[(size_t)(okw ? (ks * 32 + fq * 8 + j) : 0) * 1024 + hc + (ntb + n2) * 16 + fr];
                    f[j] = (short)f2bf(okw ? v : 0.f);
                }
                Bw[n2][ks] = f;
            }
    }
    const f32x4 z4 = {0.f, 0.f, 0.f, 0.f};
    f32x4 S[4] = {z4, z4, z4, z4};
    sh4 Lf;
#pragma unroll
    for (int j = 0; j < 4; ++j) Lf[j] = (fq * 4 + j <= fr) ? (short)0x3F80 : (short)0;
    bf16_t* Pr = (bf16_t*)(WS(p) + OFF_PR);
    bf16_t* vfirst = (bf16_t*)(WS(p) + OFF_VFIRST);
    const unsigned char* psrc[5]; int pstep[5], ptau[5]; bool pval[5];
#pragma unroll
    for (int k = 0; k < 5; ++k) {
        const int pi = tid + k * NTHR;
        bool ok = false;
        psrc[k] = scan_piece_src(p, l, b, hc, 0, pi < SC_TC * 68 ? pi : 0, ok);
        const int tau = (pi < SC_TC * 68 ? pi : 0) / 68, seg = (pi < SC_TC * 68 ? pi : 0) - tau * 68;
        ptau[k] = tau;
        pstep[k] = SC_TC * ((seg >= 24 && seg < 60) ? 576 : 2048);
        pval[k] = (pi < SC_TC * 68) && !(seg >= 60 && l == 0);
    }
    uint4 pre[5];
#pragma unroll
    for (int k = 0; k < 5; ++k) { pre[k] = make_uint4(0, 0, 0, 0); if (pval[k] && ptau[k] < TS) pre[k] = *(const uint4*)psrc[k]; }
    __syncthreads();
#pragma unroll 1
    for (int t0 = 0, ch = 0; t0 < TS; t0 += SC_TC, ++ch) {
        const int nval = (TS - t0 < SC_TC) ? (TS - t0) : SC_TC;
#pragma unroll
        for (int k = 0; k < 5; ++k) { const int pi = tid + k * NTHR; if (pi < SC_TC * 68) *(uint4*)(raw + pi * 16) = pre[k]; }
        lds_barrier();
#pragma unroll
        for (int k = 0; k < 5; ++k) {
            pre[k] = make_uint4(0, 0, 0, 0);
            if (pval[k] && t0 + SC_TC + ptau[k] < TS) pre[k] = *(const uint4*)(psrc[k] + (size_t)(ch + 1) * pstep[k]);
        }
        if (mm < 3 || l > 0) {
            const unsigned char* Ab = raw + ((mm == 0) ? 384 : (mm == 1) ? 512 : (mm == 2) ? 640 : 896);
            float* dst = (mm == 0) ? s_w : (mm == 1) ? s_a : (mm == 2) ? s_g : s_o;
#pragma unroll
            for (int m = 0; m < 2; ++m) {
                f32x4 acc0 = {0.f, 0.f, 0.f, 0.f}, acc1 = {0.f, 0.f, 0.f, 0.f};
#pragma unroll
                for (int ks = 0; ks < 4; ++ks) {
                    if (ks < nks) {
                        const bf16x8 a = *(const bf16x8*)(Ab + (m * 16 + fr) * SC_ROWB + ks * 64 + fq * 16);
                        acc0 = __builtin_amdgcn_mfma_f32_16x16x32_bf16(a, Bw[0][ks], acc0, 0, 0, 0);
                        acc1 = __builtin_amdgcn_mfma_f32_16x16x32_bf16(a, Bw[1][ks], acc1, 0, 0, 0);
                    }
                }
                if (mm == 0) {
                    const float cw0 = cst[480 + ntb * 16 + fr], cw1 = cst[480 + (ntb + 1) * 16 + fr];
                    f32x4 l0, l1, r0, r1;
#pragma unroll
                    for (int j = 0; j < 4; ++j) { l0[j] = -0.6065306597126334f * fast_sigmoid(acc0[j] + cw0); l1[j] = -0.6065306597126334f * fast_sigmoid(acc1[j] + cw1); }
                    const uint2 h0 = pack4(l0[0], l0[1], l0[2], l0[3]), h1 = pack4(l1[0], l1[1], l1[2], l1[3]);
                    r0[0] = l0[0] - __uint_as_float(h0.x << 16); r0[1] = l0[1] - __uint_as_float(h0.x & 0xFFFF0000u); r0[2] = l0[2] - __uint_as_float(h0.y << 16); r0[3] = l0[3] - __uint_as_float(h0.y & 0xFFFF0000u);
                    r1[0] = l1[0] - __uint_as_float(h1.x << 16); r1[1] = l1[1] - __uint_as_float(h1.x & 0xFFFF0000u); r1[2] = l1[2] - __uint_as_float(h1.y << 16); r1[3] = l1[3] - __uint_as_float(h1.y & 0xFFFF0000u);
                    sh4 hh0, hh1; __builtin_memcpy(&hh0, &h0, 8); __builtin_memcpy(&hh1, &h1, 8);
                    f32x4 c0 = MF16(Lf, pk4v(r0), z4), c1 = MF16(Lf, pk4v(r1), z4);
                    c0 = MF16(Lf, hh0, c0); c1 = MF16(Lf, hh1, c1);
#pragma unroll
                    for (int j = 0; j < 4; ++j) {
                        const int eo = (m * 16 + fq * 4 + j) * 64 + ntb * 16 + fr;
                        s_w[eo] = c0[j]; s_w[eo + 16] = c1[j];
                        s_b[eo] = l0[j]; s_b[eo + 16] = l1[j];
                    }
                } else {
#pragma unroll
                    for (int j = 0; j < 4; ++j) {
                        dst[(m * 16 + fq * 4 + j) * 64 + ntb * 16 + fr] = acc0[j];
                        dst[(m * 16 + fq * 4 + j) * 64 + (ntb + 1) * 16 + fr] = acc1[j];
                    }
                }
            }
        }
        lds_barrier();
        {
            const int tau = tid >> 4, c4 = (tid & 15) * 4, e = tau * 64 + c4, t = t0 + tau;
            const size_t n = (size_t)b * TS + t;
            const float4 cum4 = *(const float4*)(s_w + e), lw4 = *(const float4*)(s_b + e), xa4 = *(const float4*)(s_a + e);
            const float4 ca = *(const float4*)(cst + 544 + c4), ckk = *(const float4*)(cst + 608 + c4), cka = *(const float4*)(cst + 672 + c4), crk = *(const float4*)(cst + 736 + c4);
            const float cum[4] = {cum4.x, cum4.y, cum4.z, cum4.w}, lw[4] = {lw4.x, lw4.y, lw4.z, lw4.w};
            const float xa[4] = {xa4.x + ca.x, xa4.y + ca.y, xa4.z + ca.z, xa4.w + ca.w};
            const float kkc[4] = {ckk.x, ckk.y, ckk.z, ckk.w}, kac[4] = {cka.x, cka.y, cka.z, cka.w};
            float rr[4], kr[4], vv[4];
            {
                const unsigned char* rc = raw + tau * SC_ROWB + c4 * 2;
                const uint2 cr = *(const uint2*)rc, ck = *(const uint2*)(rc + 128), cv = *(const uint2*)(rc + 256);
                uint2 qr = make_uint2(0u, 0u), qk = qr, qv = qr;
                if (tau > 0) { qr = *(const uint2*)(rc - SC_ROWB); qk = *(const uint2*)(rc - SC_ROWB + 128); qv = *(const uint2*)(rc - SC_ROWB + 256); }
                else if (t0 > 0) { const unsigned* pvr = prevr + ((ch + 1) & 1) * 96 + (c4 >> 1); qr = *(const uint2*)pvr; qk = *(const uint2*)(pvr + 32); qv = *(const uint2*)(pvr + 64); }
                if (tau == SC_TC - 1) { unsigned* pwr = prevr + (ch & 1) * 96 + (c4 >> 1); *(uint2*)pwr = cr; *(uint2*)(pwr + 32) = ck; *(uint2*)(pwr + 64) = cv; }
                const float4 mr = *(const float4*)(cst + c4), mk = *(const float4*)(cst + 64 + c4), mv = *(const float4*)(cst + 128 + c4);
                const float c_[12] = {__uint_as_float(cr.x << 16), __uint_as_float(cr.x & 0xFFFF0000u), __uint_as_float(cr.y << 16), __uint_as_float(cr.y & 0xFFFF0000u),
                                      __uint_as_float(ck.x << 16), __uint_as_float(ck.x & 0xFFFF0000u), __uint_as_float(ck.y << 16), __uint_as_float(ck.y & 0xFFFF0000u),
                                      __uint_as_float(cv.x << 16), __uint_as_float(cv.x & 0xFFFF0000u), __uint_as_float(cv.y << 16), __uint_as_float(cv.y & 0xFFFF0000u)};
                const float q_[12] = {__uint_as_float(qr.x << 16), __uint_as_float(qr.x & 0xFFFF0000u), __uint_as_float(qr.y << 16), __uint_as_float(qr.y & 0xFFFF0000u),
                                      __uint_as_float(qk.x << 16), __uint_as_float(qk.x & 0xFFFF0000u), __uint_as_float(qk.y << 16), __uint_as_float(qk.y & 0xFFFF0000u),
                                      __uint_as_float(qv.x << 16), __uint_as_float(qv.x & 0xFFFF0000u), __uint_as_float(qv.y << 16), __uint_as_float(qv.y & 0xFFFF0000u)};
                const float m_[12] = {mr.x, mr.y, mr.z, mr.w, mk.x, mk.y, mk.z, mk.w, mv.x, mv.y, mv.z, mv.w};
#pragma unroll
                for (int j = 0; j < 4; ++j) { rr[j] = c_[j] + (q_[j] - c_[j]) * m_[j]; kr[j] = c_[4 + j] + (q_[4 + j] - c_[4 + j]) * m_[4 + j]; vv[j] = c_[8 + j] + (q_[8 + j] - c_[8 + j]) * m_[8 + j]; }
            }
            if (l > 0) {
                const float4 xv4 = *(const float4*)(s_o + e), cv = *(const float4*)(cst + 928 + c4);
                const uint2 vfu = *(const uint2*)(raw + tau * SC_ROWB + 960 + c4 * 2);
                const float vf[4] = {__uint_as_float(vfu.x << 16), __uint_as_float(vfu.x & 0xFFFF0000u), __uint_as_float(vfu.y << 16), __uint_as_float(vfu.y & 0xFFFF0000u)};
                const float xv[4] = {xv4.x + cv.x, xv4.y + cv.y, xv4.z + cv.z, xv4.w + cv.w};
#pragma unroll
                for (int j = 0; j < 4; ++j) vv[j] = vv[j] + (vf[j] - vv[j]) * fast_sigmoid(xv[j]);
            } else if (t < TS) {
                *(uint2*)(vfirst + n * 1024 + hc + c4) = pack4(vv[0], vv[1], vv[2], vv[3]);
            }
            float av[4], kkv[4], ginc[4], gexc[4], ginv[4]; float ss = 0.f;
#pragma unroll
            for (int j = 0; j < 4; ++j) {
                ginc[j] = __expf(cum[j]); gexc[j] = __expf(cum[j] - lw[j]); ginv[j] = __expf(-cum[j]);
                av[j] = fast_sigmoid(xa[j]);
                kkv[j] = kr[j] * kkc[j];
                ss += kkv[j] * kkv[j];
            }
            float kk[4], kt[4];
#pragma unroll
            for (int j = 0; j < 4; ++j) kt[j] = kr[j] * (1.0f + (av[j] - 1.0f) * kac[j]);
            float bsum = rr[0] * kt[0] * crk.x + rr[1] * kt[1] * crk.y + rr[2] * kt[2] * crk.z + rr[3] * kt[3] * crk.w;
            float du0 = 0.f, du1 = 0.f;
            row16_sum4(ss, bsum, du0, du1);
            if ((tid & 15) == 0) s_bs[tau] = bsum;
            const float rn = rsqrtf(fmaxf(ss, 1e-24f));
#pragma unroll
            for (int j = 0; j < 4; ++j) kk[j] = kkv[j] * rn;
            const uint2 pa = pack4(-kk[0] * gexc[0], -kk[1] * gexc[1], -kk[2] * gexc[2], -kk[3] * gexc[3]);
            const uint2 pr = pack4(rr[0] * ginc[0], rr[1] * ginc[1], rr[2] * ginc[2], rr[3] * ginc[3]);
            const uint2 pb = pack4(kk[0] * av[0] * ginv[0], kk[1] * av[1] * ginv[1], kk[2] * av[2] * ginv[2], kk[3] * av[3] * ginv[3]);
            const uint2 pk = pack4(kt[0] * ginv[0], kt[1] * ginv[1], kt[2] * ginv[2], kt[3] * ginv[3]);
            const uint2 pv = pack4(vv[0], vv[1], vv[2], vv[3]);
            *(uint2*)(o_at + tau * SC_LT + c4) = pa;
            *(uint2*)(o_rt + tau * SC_LT + c4) = pr;
            *(uint2*)(o_bt + tau * SC_LT + c4) = pb;
            *(uint2*)(o_kt + tau * SC_LT + c4) = pk;
            o_bT[(c4 + 0) * SC_LS + tau] = (bf16_t)(pb.x & 0xFFFFu); o_bT[(c4 + 1) * SC_LS + tau] = (bf16_t)(pb.x >> 16); o_bT[(c4 + 2) * SC_LS + tau] = (bf16_t)(pb.y & 0xFFFFu); o_bT[(c4 + 3) * SC_LS + tau] = (bf16_t)(pb.y >> 16);
            o_kT[(c4 + 0) * SC_LS + tau] = (bf16_t)(pk.x & 0xFFFFu); o_kT[(c4 + 1) * SC_LS + tau] = (bf16_t)(pk.x >> 16); o_kT[(c4 + 2) * SC_LS + tau] = (bf16_t)(pk.y & 0xFFFFu); o_kT[(c4 + 3) * SC_LS + tau] = (bf16_t)(pk.y >> 16);
            o_vT[(c4 + 0) * SC_LS + tau] = (bf16_t)(pv.x & 0xFFFFu); o_vT[(c4 + 1) * SC_LS + tau] = (bf16_t)(pv.x >> 16); o_vT[(c4 + 2) * SC_LS + tau] = (bf16_t)(pv.y & 0xFFFFu); o_vT[(c4 + 3) * SC_LS + tau] = (bf16_t)(pv.y >> 16);
            if ((tau & 15) == 15) *(float4*)(s_gc + (tau >> 4) * 64 + c4) = make_float4(ginc[0], ginc[1], ginc[2], ginc[3]);
            *(float4*)(s_v + e) = make_float4(vv[0], vv[1], vv[2], vv[3]);
        }
        lds_barrier();
        if (wid < 4) {
#pragma unroll 1
            for (int sc = 0; sc < 2; ++sc) {
                if (sc * 16 < nval) {
                    const bf16_t* ar = o_at + (sc * 16 + fr) * SC_LT;
                    const bf16_t* rr_ = o_rt + (sc * 16 + fr) * SC_LT;
                    const bf16_t* br = o_bt + (sc * 16 + fr) * SC_LT;
                    const bf16_t* kr_ = o_kt + (sc * 16 + fr) * SC_LT;
                    const bf16x8 fa0 = *(const bf16x8*)(ar + fq * 8), fa1 = *(const bf16x8*)(ar + 32 + fq * 8);
                    const bf16x8 fb0 = *(const bf16x8*)(br + fq * 8), fb1 = *(const bf16x8*)(br + 32 + fq * 8);
                    const bf16x8 fk0 = *(const bf16x8*)(kr_ + fq * 8), fk1 = *(const bf16x8*)(kr_ + 32 + fq * 8);
                    const bf16x8 fr0 = *(const bf16x8*)(rr_ + fq * 8), fr1 = *(const bf16x8*)(rr_ + 32 + fq * 8);
                    f32x4 nA = MF32(fb0, fa0, z4); nA = MF32(fb1, fa1, nA);
                    f32x4 nB = MF32(fa0, fb0, z4); nB = MF32(fa1, fb1, nB);
                    f32x4 mak = MF32(fk0, fa0, z4); mak = MF32(fk1, fa1, mak);
                    f32x4 mbr = MF32(fb0, fr0, z4); mbr = MF32(fb1, fr1, mbr);
                    f32x4 mkr = MF32(fk0, fr0, z4); mkr = MF32(fk1, fr1, mkr);
#pragma unroll
                    for (int j = 0; j < 4; ++j) {
                        const int s_ = fq * 4 + j;
                        nA[j] = (s_ < fr) ? nA[j] : 0.f; nB[j] = (fr < s_) ? nB[j] : 0.f; mak[j] = (s_ < fr) ? mak[j] : 0.f;
                        mbr[j] = (s_ <= fr) ? mbr[j] : 0.f; mkr[j] = (s_ <= fr) ? mkr[j] : 0.f;
                    }
                    const sh4 pNA = pk4v(nA), pNB = pk4v(nB), pMak = pk4v(mak), pMbr = pk4v(mbr), pMkr = pk4v(mkr);
                    const f32x4 n2B = MF16(pNA, pNB, z4), n2A = MF16(pNB, pNA, z4);
                    const sh4 pN2A = pk4v(n2A), pN2B = pk4v(n2B);
                    const f32x4 n4B = MF16(pN2A, pN2B, z4), n4A = MF16(pN2B, pN2A, z4);
                    const sh4 pN4A = pk4v(n4A), pN4B = pk4v(n4B);
                    const sh4 pN8A = pk4v(MF16(pN4B, pN4A, z4));
                    const bf16x8 sB0 = cat8(pk4v(S[0]), pk4v(S[1])), sB1 = cat8(pk4v(S[2]), pk4v(S[3]));
                    const sh4 vf = *(const sh4*)(o_vT + (wid * 16 + fr) * SC_LS + sc * 16 + fq * 4);
                    f32x4 X = MF32(cat8(*(const sh4*)(ar + fq * 4), *(const sh4*)(ar + 16 + fq * 4)), sB0, z4);
                    X = MF32(cat8(*(const sh4*)(ar + 32 + fq * 4), *(const sh4*)(ar + 48 + fq * 4)), sB1, X);
                    X = MF16(pMak, vf, X);
                    X = MF16(pN8A, pk4v(X), X); X = MF16(pN4A, pk4v(X), X); X = MF16(pN2A, pk4v(X), X); X = MF16(pNA, pk4v(X), X);
                    const sh4 pSA = pk4v(X);
                    f32x4 O = MF32(cat8(*(const sh4*)(rr_ + fq * 4), *(const sh4*)(rr_ + 16 + fq * 4)), sB0, z4);
                    O = MF32(cat8(*(const sh4*)(rr_ + 32 + fq * 4), *(const sh4*)(rr_ + 48 + fq * 4)), sB1, O);
                    const bf16x8 sav = cat8(pSA, vf);
                    O = MF32(cat8(pMbr, pMkr), sav, O);
#pragma unroll
                    for (int j = 0; j < 4; ++j) s_o[(sc * 16 + fq * 4 + j) * 64 + wid * 16 + fr] = O[j];
#pragma unroll
                    for (int jt = 0; jt < 4; ++jt) {
                        const sh4 ka = *(const sh4*)(o_kT + (jt * 16 + fr) * SC_LS + sc * 16 + fq * 4), ba = *(const sh4*)(o_bT + (jt * 16 + fr) * SC_LS + sc * 16 + fq * 4);
                        f32x4 acc = MF32(cat8(ba, ka), sav, S[jt]);
                        const float4 g4 = *(const float4*)(s_gc + sc * 64 + jt * 16 + fq * 4);
                        acc[0] *= g4.x; acc[1] *= g4.y; acc[2] *= g4.z; acc[3] *= g4.w;
                        S[jt] = acc;
                    }
                }
            }
        }
        lds_barrier();
        {
            const int tau = tid >> 4, c4 = (tid & 15) * 4, e = tau * 64 + c4;
            const size_t n = (size_t)b * TS + t0 + tau;
            const float4 o4 = *(const float4*)(s_o + e), v4_ = *(const float4*)(s_v + e), g4_ = *(const float4*)(s_g + e);
            const float4 clw = *(const float4*)(cst + 800 + c4), clb = *(const float4*)(cst + 864 + c4);
            const float bsum = s_bs[tau];
            const float m_ = row16_sum((o4.x + o4.y) + (o4.z + o4.w)) * (1.0f / 64.0f);
            const float d0 = o4.x - m_, d1 = o4.y - m_, d2 = o4.z - m_, d3 = o4.w - m_;
            const float var = row16_sum(d0 * d0 + d1 * d1 + d2 * d2 + d3 * d3) * (1.0f / 64.0f);
            const float rs = rsqrtf(var + 64e-5f);
            const float y0 = (d0 * rs * clw.x + clb.x + bsum * v4_.x) * g4_.x, y1 = (d1 * rs * clw.y + clb.y + bsum * v4_.y) * g4_.y;
            const float y2 = (d2 * rs * clw.z + clb.z + bsum * v4_.z) * g4_.z, y3 = (d3 * rs * clw.w + clb.w + bsum * v4_.w) * g4_.w;
            if (tau < nval) *(uint2*)(Pr + n * 1024 + hc + c4) = pack4(y0, y1, y2, y3);
        }
    }
}

__device__ __forceinline__ void xcd_panel_map(int& mt0, int& mstep, int& nt) {
    const int b = obid(), G = (int)gridDim.x;
    if (G == 256) { nt = (b >> 3) & 7; mt0 = (b & 7) * 4 + (b >> 6); mstep = 32; }
    else { nt = b & 7; mt0 = b >> 3; mstep = G >> 3; }
}
__device__ void phase_merge(const Params& p, unsigned char* lds) {
    const int tid = otid(), lane = tid & 63, wid = tid >> 6, wr = wid >> 1, wc = wid & 1, fr = lane & 15, fq = lane >> 4;
    const bf16_t* h = (const bf16_t*)(WS(p) + OFF_H);
    const bf16_t* wb = (const bf16_t*)(WS(p) + OFF_WB);
    const float* rstd = (const float*)(WS(p) + OFF_RSTD);
    bf16_t* merged = (bf16_t*)(WS(p) + OFF_MERGED);
    const bf16_t* ysrc0 = (const bf16_t*)(WS(p) + OFF_PPOOL);
    const bf16_t* ysrc1 = (const bf16_t*)(WS(p) + OFF_PR);
    const bf16_t* ysrc2 = (const bf16_t*)(OUTB(p) + DO_YC);
    for (int tile = obid(); tile < 86 * 8; tile += gridDim.x) {
        const int mt = tile >> 3, nt = tile & 7;
        const int row0 = mt * 192, col0 = nt * 128;
        uint2 maccp[3][4];
#pragma unroll
        for (int m = 0; m < 3; ++m)
#pragma unroll
            for (int n = 0; n < 4; ++n) maccp[m][n] = make_uint2(0u, 0u);
#pragma unroll 1
        for (int i = 0; i < 3; ++i) {
            const int tid = otid();
            const bf16_t* ys = (i == 0) ? ysrc0 : (i == 1 ? ysrc1 : ysrc2);
            uint2 sg[3][4];
            {
                f32x4 ag[3][4]; g3_zero<3>(ag);
                G3<192> g;
                g3_setup<192>(g, [&](int r) { return h + (size_t)(row0 + r) * DM; }, [&](int r) { return wb + WB_WG + (size_t)(i * 1024 + col0 + r) * DM; }, tid);
                g3_kloop<192>(ag, g, DM, lds);
#pragma unroll
                for (int m = 0; m < 3; ++m) {
                    const float rs = rstd[row0 + wr * 48 + m * 16 + fr];
#pragma unroll
                    for (int n = 0; n < 4; ++n) sg[m][n] = pack4(fast_sigmoid(ag[m][n][0] * rs), fast_sigmoid(ag[m][n][1] * rs), fast_sigmoid(ag[m][n][2] * rs), fast_sigmoid(ag[m][n][3] * rs));
                }
            }
            {
                f32x4 ay[3][4]; g3_zero<3>(ay);
                G3<192> g;
                g3_setup<192>(g, [&](int r) { return ys + (size_t)(row0 + r) * DM; }, [&](int r) { return wb + WB_PA + (size_t)(i * 1024 + col0 + r) * DM; }, tid);
                g3_kloop<192>(ay, g, DM, lds);
#pragma unroll
                for (int m = 0; m < 3; ++m)
#pragma unroll
                    for (int n = 0; n < 4; ++n) {
                        const float m0 = __uint_as_float(maccp[m][n].x << 16) + __uint_as_float(sg[m][n].x << 16) * ay[m][n][0];
                        const float m1 = __uint_as_float(maccp[m][n].x & 0xFFFF0000u) + __uint_as_float(sg[m][n].x & 0xFFFF0000u) * ay[m][n][1];
                        const float m2 = __uint_as_float(maccp[m][n].y << 16) + __uint_as_float(sg[m][n].y << 16) * ay[m][n][2];
                        const float m3 = __uint_as_float(maccp[m][n].y & 0xFFFF0000u) + __uint_as_float(sg[m][n].y & 0xFFFF0000u) * ay[m][n][3];
                        maccp[m][n] = pack4(m0, m1, m2, m3);
                    }
            }
        }
#pragma unroll
        for (int m = 0; m < 3; ++m) {
            const int row = row0 + wr * 48 + m * 16 + fr;
#pragma unroll
            for (int n = 0; n < 4; ++n)
                *(uint2*)(merged + (size_t)row * 1024 + col0 + wc * 64 + n * 16 + fq * 4) = maccp[m][n];
        }
    }
}

__device__ void phase_outproj(const Params& p, unsigned char* lds) {
    const int tid = otid(), lane = tid & 63, wid = tid >> 6, wr = wid >> 1, wc = wid & 1, fr = lane & 15, fq = lane >> 4;
    const bf16_t* h = (const bf16_t*)(WS(p) + OFF_H);
    const bf16_t* wb = (const bf16_t*)(WS(p) + OFF_WB);
    const bf16_t* merged = (const bf16_t*)(WS(p) + OFF_MERGED);
    float* hm = (float*)(WS(p) + OFF_HM32);
    int mt0, mstep, nt;
    xcd_panel_map(mt0, mstep, nt);
    for (int mt = mt0; mt < 86; mt += mstep) {
        const int row0 = mt * 192, col0 = nt * 128;
        G3<192> g;
        g3_setup<192>(g, [&](int r) { return merged + (size_t)(row0 + r) * DM; }, [&](int r) { return wb + WB_WO + (size_t)(col0 + r) * DM; }, tid);
        f32x4 acc[3][4]; g3_zero<3>(acc);
        g3_kloop<192>(acc, g, DM, lds);
#pragma unroll
        for (int m = 0; m < 3; ++m) {
            const int row = row0 + wr * 48 + m * 16 + fr;
#pragma unroll
            for (int n = 0; n < 4; ++n) {
                const int col = col0 + wc * 64 + n * 16 + fq * 4;
                const uint2 hv = *(const uint2*)(h + (size_t)row * 1024 + col);
                float4 o;
                o.x = __uint_as_float(hv.x << 16) + acc[m][n][0]; o.y = __uint_as_float(hv.x & 0xFFFF0000u) + acc[m][n][1];
                o.z = __uint_as_float(hv.y << 16) + acc[m][n][2]; o.w = __uint_as_float(hv.y & 0xFFFF0000u) + acc[m][n][3];
                *(float4*)(hm + (size_t)row * 1024 + col) = o;
            }
        }
    }
}

__device__ __constant__ int c_pair_lo[6] = {0, 0, 0, 1, 1, 2};
__device__ __constant__ int c_pair_hi[6] = {1, 2, 3, 2, 3, 3};
__device__ void phase_route(const Params& p, int l, unsigned char* lds) {
    const int tid = otid(), lane = tid & 63, wid = tid >> 6;
    const int per = (NT + (int)gridDim.x - 1) / (int)gridDim.x;
    const int nbeg = obid() * per, nend = (nbeg + per < NT) ? nbeg + per : NT;
    int* s_cls = (int*)lds;
    int* s_base = s_cls + 512;
    float* s_wr = (float*)(lds + 4096);
    const float* hm = (const float*)(WS(p) + OFF_HM32);
    bf16_t* hn = (bf16_t*)(WS(p) + OFF_HN);
    const float* nf = p.in[33] + (size_t)l * 1024;
    const float* wg = p.in[34] + (size_t)l * 1024 * 4;
    const float* bg = p.in[35] + l * 4;
    const float* we = p.in[36] + (size_t)l * 1024 * 16;
    const float* be = p.in[37] + l * 16;
    int* cnt = (int*)(WS(p) + OFF_CTL);
    int* list = (int*)(WS(p) + OFF_LIST);
    float* pw = (float*)(WS(p) + OFF_PW);
    for (int e = tid; e < 1024 * 20; e += NTHR) {
        const int k = e / 20, c = e - k * 20;
        s_wr[c * 1024 + k] = (c < 4) ? wg[(size_t)k * 4 + c] : we[(size_t)k * 16 + (c - 4)];
    }
    __syncthreads();
    float4 nv[4], cur[4];
#pragma unroll
    for (int i = 0; i < 4; ++i) nv[i] = *(const float4*)(nf + i * 256 + lane * 4);
    if (nbeg + wid < nend) {
#pragma unroll
        for (int i = 0; i < 4; ++i) cur[i] = *(const float4*)(hm + (size_t)(nbeg + wid) * DM + i * 256 + lane * 4);
    }
    for (int n = nbeg + wid; n < nend; n += 8) {
        float4 xv[4]; float ss = 0.f;
#pragma unroll
        for (int i = 0; i < 4; ++i) { xv[i] = cur[i]; ss += xv[i].x * xv[i].x + xv[i].y * xv[i].y + xv[i].z * xv[i].z + xv[i].w * xv[i].w; }
        if (n + 8 < nend) {
#pragma unroll
            for (int i = 0; i < 4; ++i) cur[i] = *(const float4*)(hm + (size_t)(n + 8) * DM + i * 256 + lane * 4);
        }
        ss = wave_sum(ss);
        const float rs = rsqrtf(ss * (1.0f / 1024.0f) + 1e-6f);
        float lg[4] = {0.f, 0.f, 0.f, 0.f};
        float le[16];
#pragma unroll
        for (int e = 0; e < 16; ++e) le[e] = 0.f;
#pragma unroll
        for (int i = 0; i < 4; ++i) {
            float y[4] = {xv[i].x * rs * nv[i].x, xv[i].y * rs * nv[i].y, xv[i].z * rs * nv[i].z, xv[i].w * rs * nv[i].w};
            {
                const int d0 = i * 256 + lane * 4;
#pragma unroll
                for (int g = 0; g < 4; ++g) { const float4 w4 = *(const float4*)(s_wr + g * 1024 + d0); lg[g] += y[0] * w4.x + y[1] * w4.y + y[2] * w4.z + y[3] * w4.w; }
#pragma unroll
                for (int e = 0; e < 16; ++e) { const float4 w4 = *(const float4*)(s_wr + (4 + e) * 1024 + d0); le[e] += y[0] * w4.x + y[1] * w4.y + y[2] * w4.z + y[3] * w4.w; }
            }
            *(uint2*)(hn + (size_t)n * DM + i * 256 + lane * 4) = pack4(y[0], y[1], y[2], y[3]);
        }
#pragma unroll
        for (int g = 0; g < 4; ++g) lg[g] = wave_sum_fast(lg[g]) + bg[g];
#pragma unroll
        for (int e = 0; e < 16; ++e) le[e] = wave_sum_fast(le[e]) + be[e];
        if (lane == 0) {
            int gs = 0; float gm = lg[0];
#pragma unroll
            for (int g = 1; g < 4; ++g) if (lg[g] > gm) { gm = lg[g]; gs = g; }
            float den = 0.f;
#pragma unroll
            for (int g = 0; g < 4; ++g) den += __expf(lg[g] - gm);
            const float pgrp = 1.0f / den;
            float v4[4];
#pragma unroll
            for (int e = 0; e < 4; ++e) {
                const float m0 = (gs == 0) ? 1.f : 0.f, m1s = (gs == 1) ? 1.f : 0.f, m2s = (gs == 2) ? 1.f : 0.f, m3s = (gs == 3) ? 1.f : 0.f;
                v4[e] = le[e] * m0 + le[4 + e] * m1s + le[8 + e] * m2s + le[12 + e] * m3s;
            }
            int i1 = 0; float m1 = v4[0];
#pragma unroll
            for (int e = 1; e < 4; ++e) if (v4[e] > m1) { m1 = v4[e]; i1 = e; }
            int i2 = -1; float m2 = -INFINITY;
#pragma unroll
            for (int e = 0; e < 4; ++e) if (e != i1 && v4[e] > m2) { m2 = v4[e]; i2 = e; }
            const float e2 = __expf(m2 - m1);
            const float p1 = pgrp / (1.0f + e2), p2 = pgrp * e2 / (1.0f + e2);
            const int lo = i1 < i2 ? i1 : i2, hi = i1 < i2 ? i2 : i1;
            const float plo = i1 < i2 ? p1 : p2, phi = i1 < i2 ? p2 : p1;
            const int pi = (lo == 0) ? (hi - 1) : (lo == 1 ? hi + 1 : 5);
            const int cls = gs * 6 + pi;
            s_cls[n - nbeg] = cls;
            pw[(size_t)n * 2 + 0] = plo; pw[(size_t)n * 2 + 1] = phi;
        }
    }
    __syncthreads();
    const int nloc = nend - nbeg;
    if (tid < 24) {
        int c_ = 0;
        for (int i = 0; i < nloc; ++i) c_ += (s_cls[i] == tid) ? 1 : 0;
        s_base[tid] = c_ ? atomicAdd(&cnt[tid * 32], c_) : 0;
    }
    __syncthreads();
    for (int it = tid; it < nloc; it += NTHR) {
        const int cls = s_cls[it];
        int rank = 0;
        for (int i = 0; i < it; ++i) rank += (s_cls[i] == cls) ? 1 : 0;
        list[(size_t)cls * NT + s_base[cls] + rank] = nbeg + it;
    }
    __syncthreads();
}


struct MoeTile { int cls, ti, cnt, tg; };
__device__ __forceinline__ int moe_total_tiles(const int* cnt) { int s = 0; for (int c = 0; c < 24; ++c) s += (cnt[c * 32] + 127) >> 7; return s; }
__device__ __forceinline__ MoeTile moe_find(const int* cnt, int tile) {
    MoeTile r; int s = 0; r.cls = 0; r.ti = 0; r.cnt = 0; r.tg = tile;
    for (int c = 0; c < 24; ++c) { const int nt = (cnt[c * 32] + 127) >> 7; if (tile >= s && tile < s + nt) { r.cls = c; r.ti = tile - s; r.cnt = cnt[c * 32]; } s += nt; }
    return r;
}
__device__ void phase_moe1(const Params& p, unsigned char* lds) {
    const int tid = otid(), lane = tid & 63, wid = tid >> 6, wr = wid >> 1, wc = wid & 1, fr = lane & 15, fq = lane >> 4;
    const int* cnt = (const int*)(WS(p) + OFF_CTL);
    const int* list = (const int*)(WS(p) + OFF_LIST);
    const float* pw = (const float*)(WS(p) + OFF_PW);
    const bf16_t* hn = (const bf16_t*)(WS(p) + OFF_HN);
    const bf16_t* we = (const bf16_t*)(WS(p) + OFF_WEXP);
    bf16_t* hid = (bf16_t*)(OUTB(p) + DO_HID);
    const int total = moe_total_tiles(cnt);
    for (int item = obid(); item < total * 4; item += gridDim.x) {
        const MoeTile mt = moe_find(cnt, item >> 2);
        const int nt = item & 3, slot = nt >> 1, f0 = (nt & 1) * 128;
        const int g_ = mt.cls / 6, pi = mt.cls % 6;
        const int e = g_ * 4 + (slot == 0 ? c_pair_lo[pi] : c_pair_hi[pi]);
        const int* lst = list + (size_t)mt.cls * NT + mt.ti * 128;
        const int nvalid = min(128, mt.cnt - mt.ti * 128);
        f32x4 a1[2][4], a3[2][4]; g3_zero<2>(a1); g3_zero<2>(a3);
        G3D g;
#pragma unroll
        for (int i = 0; i < 2; ++i) {
            const int idx = tid + i * NTHR, row = idx >> 3, sl = (idx & 7) ^ (row & 7);
            g.ap[i] = hn + (size_t)lst[row < nvalid ? row : 0] * DM + sl * 8;
            g.b1[i] = we + WE_W1 + ((size_t)e * 256 + f0 + row) * 1024 + sl * 8;
            g.b3[i] = we + WE_W3 + ((size_t)e * 256 + f0 + row) * 1024 + sl * 8;
        }
        g3d_kloop(a1, a3, g, DM, lds);
#pragma unroll
        for (int m = 0; m < 2; ++m) {
            const int lr = wr * 32 + m * 16 + fr;
            const int tk = lst[lr < nvalid ? lr : 0];
            const float pe = pw[(size_t)tk * 2 + slot];
#pragma unroll
            for (int n = 0; n < 4; ++n) {
                const int col = slot * 256 + f0 + wc * 64 + n * 16 + fq * 4;
                float o[4];
#pragma unroll
                for (int j = 0; j < 4; ++j) { const float x1 = a1[m][n][j]; o[j] = x1 * sigmoidf_(x1) * a3[m][n][j] * pe; }
                *(uint2*)(hid + ((size_t)mt.tg * 128 + lr) * 512 + col) = pack4(o[0], o[1], o[2], o[3]);
            }
        }
    }
}
__device__ void phase_moe2(const Params& p, unsigned char* lds) {
    const int tid = otid(), lane = tid & 63, wid = tid >> 6, wr = wid >> 1, wc = wid & 1, fr = lane & 15, fq = lane >> 4;
    const int* cnt = (const int*)(WS(p) + OFF_CTL);
    const int* list = (const int*)(WS(p) + OFF_LIST);
    const bf16_t* we = (const bf16_t*)(WS(p) + OFF_WEXP);
    const bf16_t* hid = (const bf16_t*)(OUTB(p) + DO_HID);
    float* hm = (float*)(WS(p) + OFF_HM32);
    bf16_t* h = (bf16_t*)(WS(p) + OFF_H);
    const int total = moe_total_tiles(cnt);
    for (int item = obid(); item < total * 8; item += gridDim.x) {
        const MoeTile mt = moe_find(cnt, item >> 3);
        const int nt = item & 7, col0 = nt * 128;
        const int g_ = mt.cls / 6, pi = mt.cls % 6;
        const int elo = g_ * 4 + c_pair_lo[pi], ehi = g_ * 4 + c_pair_hi[pi];
        const int* lst = list + (size_t)mt.cls * NT + mt.ti * 128;
        const int nvalid = min(128, mt.cnt - mt.ti * 128);
        f32x4 acc[2][4]; g3_zero<2>(acc);
        G3<128> g;
        g3_setup<128>(g, [&](int r) { return hid + ((size_t)mt.tg * 128 + r) * 512; }, [&](int r) { return we + WE_W2 + ((size_t)elo * 1024 + col0 + r) * 256; }, tid);
        g3_kloop<128>(acc, g, 256, lds);
        g3_setup<128>(g, [&](int r) { return hid + ((size_t)mt.tg * 128 + r) * 512 + 256; }, [&](int r) { return we + WE_W2 + ((size_t)ehi * 1024 + col0 + r) * 256; }, tid);
        g3_kloop<128>(acc, g, 256, lds);
#pragma unroll
        for (int m = 0; m < 2; ++m) {
            const int lr = wr * 32 + m * 16 + fr;
            if (lr < nvalid) {
                const int tk = lst[lr];
#pragma unroll
                for (int n = 0; n < 4; ++n) {
                    const int col = col0 + wc * 64 + n * 16 + fq * 4;
                    float4 v = *(const float4*)(hm + (size_t)tk * 1024 + col);
                    v.x += acc[m][n][0]; v.y += acc[m][n][1]; v.z += acc[m][n][2]; v.w += acc[m][n][3];
                    *(float4*)(hm + (size_t)tk * 1024 + col) = v;
                    *(uint2*)(h + (size_t)tk * 1024 + col) = pack4(v.x, v.y, v.z, v.w);
                }
            }
        }
    }
}

__device__ void phase_final(const Params& p) {
    const int lane = otid() & 63;
    const int wave = (obid() * NTHR + otid()) >> 6, nw = gridDim.x * NTHR / 64;
    const float* hm = (const float*)(WS(p) + OFF_HM32);
    const float* nf = p.in[41];
    float4 g[4], cur[4];
#pragma unroll
    for (int i = 0; i < 4; ++i) g[i] = *(const float4*)(nf + i * 256 + lane * 4);
    auto rowp = [&](int r) { const int b = r / SEQ, s_ = r % SEQ; return hm + ((size_t)b * TS + NMETA + s_) * DM; };
    if (wave < NB * SEQ) {
        const float* src = rowp(wave);
#pragma unroll
        for (int i = 0; i < 4; ++i) cur[i] = *(const float4*)(src + i * 256 + lane * 4);
    }
    for (int r = wave; r < NB * SEQ; r += nw) {
        float4 v[4]; float ss = 0.f;
#pragma unroll
        for (int i = 0; i < 4; ++i) { v[i] = cur[i]; ss += v[i].x * v[i].x + v[i].y * v[i].y + v[i].z * v[i].z + v[i].w * v[i].w; }
        if (r + nw < NB * SEQ) {
            const float* src = rowp(r + nw);
#pragma unroll
            for (int i = 0; i < 4; ++i) cur[i] = *(const float4*)(src + i * 256 + lane * 4);
        }
        ss = wave_sum(ss);
        const float rs = rsqrtf(ss * (1.0f / 1024.0f) + 1e-6f);
#pragma unroll
        for (int i = 0; i < 4; ++i) {
            float4 o; o.x = v[i].x * rs * g[i].x; o.y = v[i].y * rs * g[i].y; o.z = v[i].z * rs * g[i].z; o.w = v[i].w * rs * g[i].w;
            *(float4*)((float*)OUTB(p) + (size_t)r * DM + i * 256 + lane * 4) = o;
        }
    }
}


#define XB_TMO      128
#define XB_XCNT(j)  (256  + 64 * (j))
#define XB_XSUB(j)  (1280 + 64 * (j))
#define XB_XGEN(j)  (2304 + 64 * (j))
#define XB_TOP      3328
#define XB_TOPGEN   3392
#define XCD_BAR_WORDS 3456
#define XB_SPIN_CAP (1u << 22)
#define LAS __attribute__((address_space(3)))
__device__ __forceinline__ unsigned xb_ld(unsigned* p) { return __hip_atomic_load(p, __ATOMIC_RELAXED, __HIP_MEMORY_SCOPE_AGENT); }
__device__ __forceinline__ unsigned xb_add(unsigned* p, unsigned v) { return __hip_atomic_fetch_add(p, v, __ATOMIC_RELAXED, __HIP_MEMORY_SCOPE_AGENT); }
__device__ __forceinline__ unsigned xb_xcc_id() { return (unsigned)__builtin_amdgcn_s_getreg((3 << 11) | 20) & 0xFu; }
#define XB_SPIN(cond, bar) do { unsigned _sp = 0; while (cond) { __builtin_amdgcn_s_sleep(1); \
    if ((++_sp & 255u) == 0u) { if (xb_ld(&(bar)[XB_TMO])) break; if (_sp > XB_SPIN_CAP) { atomicAdd(&(bar)[XB_TMO], 1u); break; } } } } while (0)
struct XcdBarrier { unsigned* bar; unsigned x; volatile LAS unsigned* st; };
__device__ __forceinline__ XcdBarrier xcd_barrier_post(unsigned* bar, volatile LAS unsigned* st) {
    XcdBarrier b; b.bar = bar; b.x = xb_xcc_id(); b.st = st;
    if (threadIdx.x == 0) (void)xb_add(&bar[XB_XCNT(b.x)], 1u);
    return b;
}
__device__ __forceinline__ void xcd_barrier_complete(unsigned* bar, unsigned x, unsigned& nloc, unsigned& nx) {
    const unsigned G = gridDim.x * gridDim.y * gridDim.z;
    unsigned sum, cnt, mine, sp = 0u;
    for (;;) {
        sum = 0u; cnt = 0u; mine = 0u;
#pragma unroll
        for (unsigned j = 0; j < 16; ++j) { const unsigned c = xb_ld(&bar[XB_XCNT(j)]); sum += c; cnt += (c > 0u) ? 1u : 0u; mine = (j == x) ? c : mine; }
        if (sum == G) break;
        __builtin_amdgcn_s_sleep(1);
        if ((++sp & 255u) == 0u) { if (xb_ld(&bar[XB_TMO])) break; if (sp > XB_SPIN_CAP) { atomicAdd(&bar[XB_TMO], 1u); break; } }
    }
    nloc = mine > 0u ? mine : 1u; nx = cnt > 0u ? cnt : 1u;
}
__device__ __forceinline__ void xcd_barrier(const XcdBarrier& b) {
    asm volatile("s_waitcnt vmcnt(0)" ::: "memory");
    __syncthreads();
    if (threadIdx.x == 0) {
        unsigned* bar = b.bar;
        __builtin_amdgcn_s_waitcnt(0);
        unsigned nloc = b.st[0], nx = b.st[1];
        if (nloc == 0u) { xcd_barrier_complete(bar, b.x, nloc, nx); b.st[0] = nloc; b.st[1] = nx; }
        const unsigned old = xb_add(&bar[XB_XSUB(b.x)], 1u);
        const unsigned gen = old / nloc;
        if (old + 1u == (gen + 1u) * nloc) {
            __builtin_amdgcn_fence(__ATOMIC_RELEASE, "agent");
            asm volatile("s_waitcnt vmcnt(0)" ::: "memory");
            const unsigned og = xb_add(&bar[XB_TOP], 1u);
            const unsigned tg = og / nx;
            if (og + 1u == (tg + 1u) * nx) xb_add(&bar[XB_TOPGEN], 1u);
            else XB_SPIN(xb_ld(&bar[XB_TOPGEN]) == tg, bar);
            __builtin_amdgcn_fence(__ATOMIC_ACQUIRE, "agent");
            xb_add(&bar[XB_XGEN(b.x)], 1u);
            asm volatile("s_waitcnt vmcnt(0)" ::: "memory");
        } else {
            XB_SPIN(xb_ld(&bar[XB_XGEN(b.x)]) == gen, bar);
            __builtin_amdgcn_fence(__ATOMIC_ACQUIRE, "agent");
            asm volatile("s_waitcnt vmcnt(0)" ::: "memory");
        }
    }
    __syncthreads();
}

__global__ void __launch_bounds__(NTHR) fwd_megakernel(Params p) {
    extern __shared__ __attribute__((aligned(16))) unsigned char lds[];
    cg::grid_group grid = cg::this_grid();
    volatile LAS unsigned* xst = (volatile LAS unsigned*)(lds + LDS_BYTES - 32);
    if (threadIdx.x < 2) xst[threadIdx.x] = 0u;
    __syncthreads();
    const XcdBarrier xb = xcd_barrier_post((unsigned*)(p.ws + OFF_BAR), xst);
    if (p.out == nullptr) grid.sync();
#pragma unroll 1
    for (int step = 0; step < 18; ++step) {
        const int l = step >= 9 ? 1 : 0;
        const int ph = step - l * 9;
        switch (ph) {
        case 0:
            if (l == 0) phase_embed(p); else phase_rowstat(p);
            phase_convert<false>(p, l, lds);
            if (obid() == 0 && otid() < 24) ((int*)(WS(p) + OFF_CTL))[otid() * 32] = 0;
            if (obid() == 0 && otid() == 32) ((int*)(WS(p) + OFF_CTL))[800 + l * 32] = 0;
            break;
        case 1: phase_inproj(p, lds); break;
        case 2: phase_dsa_prep(p, l); phase_lr_prep(p, l); break;
        case 3: {
            if (obid() < NB * 16) phase_scan5(p, l, lds, obid());
            int* qctr = (int*)(WS(p) + OFF_CTL) + 800 + l * 32;
            int* qslot = (int*)(lds + LDS_BYTES - 16);
            for (;;) {
                __syncthreads();
                if (otid() == 0) *qslot = atomicAdd(qctr, 1);
                __syncthreads();
                const int item = *qslot;
                if (item >= 516 + NT / 32 + 3072) break;
                if (item < 516) phase_pool(p, l, lds, item, item + 1, 1);
                else if (item < 516 + NT / 32) phase_dsa<false>(p, l, lds, (bf16_t*)(OUTB(p) + DO_YC), nullptr, nullptr, item - 516, item - 515, 1);
                else {
                    const int ct = item - (516 + NT / 32);
                    const ConvJob cj = get_job_late(p, l, ct >> 10);
                    conv_tile(cj, ct & 1023, (float*)lds);
                }
            }
        } break;
        case 4: phase_merge(p, lds); break;
        case 5: phase_outproj(p, lds); break;
        case 6: phase_route(p, l, lds); break;
        case 7: phase_moe1(p, lds); break;
        default: phase_moe2(p, lds); break;
        }
        xcd_barrier(xb);
    }
    phase_final(p);
}

extern "C" void kernel_launch(void* const* d_in, const int* in_sizes, int n_in,
                              void* d_out, int out_size, void* d_ws, size_t ws_size,
                              hipStream_t stream) {
    static int grid_blocks = 0;
    if (grid_blocks == 0) {
        int dev = 0, cus = 0, per_cu = 0;
        (void)hipGetDevice(&dev);
        (void)hipDeviceGetAttribute(&cus, hipDeviceAttributeMultiprocessorCount, dev);
        (void)hipFuncSetAttribute((const void*)fwd_megakernel, hipFuncAttributeMaxDynamicSharedMemorySize, LDS_BYTES);
        (void)hipOccupancyMaxActiveBlocksPerMultiprocessor(&per_cu, fwd_megakernel, NTHR, LDS_BYTES);
        if (per_cu < 1 || cus < NB * 16 || (cus & 7) != 0 || n_in != 42 || ws_size < WS_END + (size_t)QS_WS * QS_BYTES || cus > QS_WS + QS_DO) { fprintf(stderr, "kernel_launch: bad config per_cu=%d n_in=%d ws=%zu need=%zu\n", per_cu, n_in, ws_size, (size_t)WS_END); grid_blocks = -1; }
        else grid_blocks = cus;
    }
    if (grid_blocks < 0) return;
    Params p{};
    for (int i = 0; i < 42; ++i) p.in[i] = (const float*)d_in[i];
    p.out = (float*)d_out;
    p.ws = (unsigned char*)d_ws;
    (void)hipMemsetAsync((unsigned char*)d_ws + OFF_BAR, 0, XCD_BAR_WORDS * 4, stream);
    void* args[] = {&p};
    hipError_t e = hipLaunchCooperativeKernel((void*)fwd_megakernel, dim3(grid_blocks), dim3(NTHR), args, LDS_BYTES, stream);
    if (e != hipSuccess) fprintf(stderr, "cooperative launch failed: %s (grid %d)\n", hipGetErrorString(e), grid_blocks);
}
```

```cpp
#include <hip/hip_runtime.h>
#include <hip/hip_cooperative_groups.h>
#include <cstdio>
#include <cstdint>
#include <type_traits>
namespace cg = cooperative_groups;

typedef unsigned short bf16_t;
typedef short bf16x8 __attribute__((ext_vector_type(8)));
typedef float f32x4 __attribute__((ext_vector_type(4)));

constexpr int NB = 8, SEQ = 2048, NMETA = 16, TS = 2064, DM = 1024;
constexpr int NT = NB * TS;
constexpr int NTP = 16640;
constexpr int NTHR = 512;
constexpr int CIN = 7912;
constexpr int NP1 = 4864;
constexpr int PM_LD = 768;
constexpr int PM_WD = 0, PM_AD = 64, PM_GD = 128, PM_VD = 256, PM_CQ = 288, PM_CKV = 544, PM_KROPE = 672, PM_KIDX = 704;
constexpr int LDS_BYTES = 157 * 1024;

constexpr size_t AL(size_t x) { return (x + 255) & ~(size_t)255; }
constexpr size_t SZ_ACT = (size_t)NTP * 1024 * 2;
constexpr size_t OFF_CTL = 0;
constexpr size_t OFF_BAR = 4096;
constexpr size_t OFF_RSTD = OFF_BAR + 16384;
constexpr size_t OFF_ROPE = OFF_RSTD + AL((size_t)NTP * 4);
constexpr size_t OFF_H = OFF_ROPE + AL((size_t)TS * 16 * 4 * 2);
constexpr size_t OFF_WB = OFF_H + SZ_ACT;
constexpr size_t WB_WIN = 0;
constexpr size_t WB_WG = WB_WIN + (size_t)NP1 * 1024;
constexpr size_t WB_PA = WB_WG + (size_t)3072 * 1024;
constexpr size_t WB_WO = WB_PA + (size_t)3 * 1024 * 1024;
constexpr size_t WB_POOL = WB_WO + (size_t)1024 * 1024;
constexpr size_t WB_QI = WB_POOL + (size_t)4 * 256 * 256;
constexpr size_t WB_UQ = WB_QI + (size_t)512 * 256;
constexpr size_t WB_UK = WB_UQ + (size_t)1536 * 256;
constexpr size_t WB_UV = WB_UK + (size_t)16 * 128 * 64;
constexpr size_t WB_WIDX = WB_UV + (size_t)16 * 64 * 128;
constexpr size_t WB_END = WB_WIDX + (size_t)64 * 1024;
constexpr size_t OFF_PPOOL = OFF_WB + AL(WB_END * 2);
constexpr size_t OFF_PK = OFF_PPOOL + SZ_ACT;
constexpr size_t OFF_PR = OFF_PK + SZ_ACT;
constexpr size_t OFF_PV = OFF_PR + SZ_ACT;
constexpr size_t OFF_PMISC = OFF_PV + SZ_ACT;
constexpr size_t OFF_VFIRST = OFF_PMISC + AL((size_t)NTP * PM_LD * 2);
constexpr size_t OFF_HALO = OFF_VFIRST + SZ_ACT;
constexpr size_t OFF_LIST = OFF_HALO + AL((size_t)130 * 16 * 1024 * 2);
constexpr size_t OFF_PW = OFF_LIST + AL((size_t)24 * NT * 4);
constexpr size_t WS_END = OFF_PW + AL((size_t)NT * 2 * 4);
constexpr size_t OFF_MERGED = OFF_PK;
constexpr size_t OFF_HM32 = OFF_PR;
constexpr size_t OFF_HN = OFF_PPOOL;
constexpr size_t OFF_WEXP = OFF_PMISC;
constexpr size_t WE_W1 = 0, WE_W3 = (size_t)16 * 256 * 1024, WE_W2 = (size_t)2 * 16 * 256 * 1024;
static_assert((size_t)3 * 16 * 256 * 1024 * 2 <= (size_t)NTP * PM_LD * 2, "expert weights must fit in Pmisc");
constexpr size_t DO_YC = 0;
constexpr size_t DO_CQN = DO_YC + SZ_ACT;
constexpr size_t DO_KV = DO_CQN + AL((size_t)NT * 256 * 2);
constexpr size_t DO_KIDX = DO_KV + AL((size_t)NT * 160 * 2);
constexpr size_t DO_WHEAD = DO_KIDX + AL((size_t)NT * 64 * 2);
constexpr size_t DO_ALR = DO_WHEAD + AL((size_t)NT * 8 * 4);
constexpr size_t DO_END = DO_ALR + AL((size_t)NT * 288 * 2);
constexpr size_t QS_BYTES = (size_t)16 * 16 * 160 * 2;
constexpr int QS_WS = (int)((277240096ull - WS_END) / QS_BYTES), QS_DO = (int)(((size_t)NB * SEQ * DM * 4 - DO_END) / QS_BYTES);
static_assert(QS_WS + QS_DO >= 256, "Q scratch");
constexpr size_t DO_HID = DO_YC;
static_assert(DO_END <= (size_t)NB * SEQ * DM * 4, "d_out scratch overflow");
static_assert((size_t)(129 + 24) * 128 * 512 * 2 <= SZ_ACT, "hid fits");
static_assert(WS_END <= 277240096ull, "workspace overflow");

struct Params {
    const float* in[42];
    float* out;
    unsigned char* ws;
};

__device__ __forceinline__ int otid() { int t = threadIdx.x; asm volatile("" : "+v"(t)); return t; }
__device__ __forceinline__ int obid() { int b = blockIdx.x; asm volatile("" : "+s"(b)); return b; }
typedef __attribute__((address_space(1))) unsigned char gas_uchar;
__device__ __forceinline__ unsigned char* WS(const Params& p) { gas_uchar* w = (gas_uchar*)p.ws; asm volatile("" : "+s"(w)); return (unsigned char*)w; }
__device__ __forceinline__ unsigned char* OUTB(const Params& p) { gas_uchar* w = (gas_uchar*)p.out; asm volatile("" : "+s"(w)); return (unsigned char*)w; }
__device__ __forceinline__ float bf2f(bf16_t v) { return __uint_as_float(((unsigned)v) << 16); }
typedef float f32x2v __attribute__((ext_vector_type(2)));
typedef __bf16 bf16x2v __attribute__((ext_vector_type(2)));
__device__ __forceinline__ unsigned pk2(float a, float b) { const f32x2v v = {a, b}; const bf16x2v r = __builtin_convertvector(v, bf16x2v); unsigned u; __builtin_memcpy(&u, &r, 4); return u; }
__device__ __forceinline__ bf16_t f2bf(float f) { const __bf16 h = (__bf16)f; bf16_t u; __builtin_memcpy(&u, &h, 2); return u; }
__device__ __forceinline__ float wave_sum(float v) {
#pragma unroll
    for (int o = 32; o > 0; o >>= 1) v += __shfl_xor(v, o);
    return v;
}
template <int CTRL> __device__ __forceinline__ float dpp_f(float x) {
    return __int_as_float(__builtin_amdgcn_update_dpp(0, __float_as_int(x), CTRL, 0xF, 0xF, true));
}
__device__ __forceinline__ float row16_sum(float v) {
    v += dpp_f<0xB1>(v);
    v += dpp_f<0x4E>(v);
    v += dpp_f<0x141>(v);
    v += dpp_f<0x140>(v);
    return v;
}
__device__ __forceinline__ void lds_barrier() { asm volatile("s_waitcnt lgkmcnt(0)" ::: "memory"); __builtin_amdgcn_s_barrier(); asm volatile("" ::: "memory"); }
__device__ __forceinline__ float fast_rcp(float x) { return __builtin_amdgcn_rcpf(x); }
__device__ __forceinline__ float fast_sigmoid(float x) { return fast_rcp(1.0f + __expf(-x)); }
__device__ __forceinline__ float fast_tanh(float x) { return 1.0f - 2.0f * fast_rcp(1.0f + __expf(2.0f * x)); }
__device__ __forceinline__ void row16_sum4(float& a, float& b, float& c, float& d) {
    asm volatile(
        "s_nop 1\n\t"
        "v_add_f32_dpp %0, %0, %0 quad_perm:[1,0,3,2] row_mask:0xf bank_mask:0xf\n\t"
        "v_add_f32_dpp %1, %1, %1 quad_perm:[1,0,3,2] row_mask:0xf bank_mask:0xf\n\t"
        "v_add_f32_dpp %2, %2, %2 quad_perm:[1,0,3,2] row_mask:0xf bank_mask:0xf\n\t"
        "v_add_f32_dpp %3, %3, %3 quad_perm:[1,0,3,2] row_mask:0xf bank_mask:0xf\n\t"
        "v_add_f32_dpp %0, %0, %0 quad_perm:[2,3,0,1] row_mask:0xf bank_mask:0xf\n\t"
        "v_add_f32_dpp %1, %1, %1 quad_perm:[2,3,0,1] row_mask:0xf bank_mask:0xf\n\t"
        "v_add_f32_dpp %2, %2, %2 quad_perm:[2,3,0,1] row_mask:0xf bank_mask:0xf\n\t"
        "v_add_f32_dpp %3, %3, %3 quad_perm:[2,3,0,1] row_mask:0xf bank_mask:0xf\n\t"
        "v_add_f32_dpp %0, %0, %0 row_half_mirror row_mask:0xf bank_mask:0xf\n\t"
        "v_add_f32_dpp %1, %1, %1 row_half_mirror row_mask:0xf bank_mask:0xf\n\t"
        "v_add_f32_dpp %2, %2, %2 row_half_mirror row_mask:0xf bank_mask:0xf\n\t"
        "v_add_f32_dpp %3, %3, %3 row_half_mirror row_mask:0xf bank_mask:0xf\n\t"
        "v_add_f32_dpp %0, %0, %0 row_mirror row_mask:0xf bank_mask:0xf\n\t"
        "v_add_f32_dpp %1, %1, %1 row_mirror row_mask:0xf bank_mask:0xf\n\t"
        "v_add_f32_dpp %2, %2, %2 row_mirror row_mask:0xf bank_mask:0xf\n\t"
        "v_add_f32_dpp %3, %3, %3 row_mirror row_mask:0xf bank_mask:0xf\n\t"
        "s_nop 1"
        : "+v"(a), "+v"(b), "+v"(c), "+v"(d));
}
__device__ __forceinline__ void row8_sum2(float& a, float& b) {
    asm volatile(
        "s_nop 1\n\t"
        "v_add_f32_dpp %0, %0, %0 quad_perm:[1,0,3,2] row_mask:0xf bank_mask:0xf\n\t"
        "v_add_f32_dpp %1, %1, %1 quad_perm:[1,0,3,2] row_mask:0xf bank_mask:0xf\n\t"
        "s_nop 0\n\t"
        "v_add_f32_dpp %0, %0, %0 quad_perm:[2,3,0,1] row_mask:0xf bank_mask:0xf\n\t"
        "v_add_f32_dpp %1, %1, %1 quad_perm:[2,3,0,1] row_mask:0xf bank_mask:0xf\n\t"
        "s_nop 0\n\t"
        "v_add_f32_dpp %0, %0, %0 row_half_mirror row_mask:0xf bank_mask:0xf\n\t"
        "v_add_f32_dpp %1, %1, %1 row_half_mirror row_mask:0xf bank_mask:0xf\n\t"
        "s_nop 1"
        : "+v"(a), "+v"(b));
}
__device__ __forceinline__ float wave_sum_fast(float v) { v = row16_sum(v); v += __shfl_xor(v, 16); v += __shfl_xor(v, 32); return v; }
__device__ __forceinline__ float sigmoidf_(float x) { return 1.0f / (1.0f + __expf(-x)); }
__device__ __forceinline__ float softplusf_(float z) { return fmaxf(z, 0.f) + log1pf(__expf(-fabsf(z))); }
__device__ __forceinline__ void glds16(const void* g, void* l) {
    __builtin_amdgcn_global_load_lds((const unsigned*)g, (unsigned*)l, 16, 0, 0);
}

__device__ void phase_embed(const Params& p) {
    const int lane = otid() & 63;
    const int wave = (obid() * NTHR + otid()) >> 6, nw = gridDim.x * NTHR / 64;
    bf16_t* h = (bf16_t*)(WS(p) + OFF_H);
    float* rstd = (float*)(WS(p) + OFF_RSTD);
    auto srcrow = [&](int n) { const int b = n / TS, t = n % TS; return t < NMETA ? p.in[1] + (size_t)t * DM : p.in[0] + ((size_t)b * SEQ + (t - NMETA)) * DM; };
    float4 cur[4];
    if (wave < NT) {
        const float* src = srcrow(wave);
#pragma unroll
        for (int i = 0; i < 4; ++i) cur[i] = *(const float4*)(src + i * 256 + lane * 4);
    }
    for (int n = wave; n < NTP; n += nw) {
        if (n < NT) {
            float4 v[4];
#pragma unroll
            for (int i = 0; i < 4; ++i) v[i] = cur[i];
            if (n + nw < NT) {
                const float* src = srcrow(n + nw);
#pragma unroll
                for (int i = 0; i < 4; ++i) cur[i] = *(const float4*)(src + i * 256 + lane * 4);
            }
            float ss = 0.f;
#pragma unroll
            for (int i = 0; i < 4; ++i) {
                ss += v[i].x * v[i].x + v[i].y * v[i].y + v[i].z * v[i].z + v[i].w * v[i].w;
                *(uint2*)(h + (size_t)n * DM + i * 256 + lane * 4) = make_uint2(pk2(v[i].x, v[i].y), pk2(v[i].z, v[i].w));
            }
            ss = wave_sum(ss);
            if (lane == 0) rstd[n] = rsqrtf(ss * (1.0f / 1024.0f) + 1e-6f);
        } else {
#pragma unroll
            for (int i = 0; i < 4; ++i) *(ushort4*)(h + (size_t)n * DM + i * 256 + lane * 4) = make_ushort4(0, 0, 0, 0);
            if (lane == 0) rstd[n] = 0.f;
        }
    }
    float* ctab = (float*)(WS(p) + OFF_ROPE);
    float* stab = ctab + TS * 16;
    for (int idx = obid() * NTHR + otid(); idx < TS * 16; idx += gridDim.x * NTHR) {
        const int t = idx >> 4, i = idx & 15;
        const float inv = powf(10000.0f, -(float)(2 * i) / 32.0f);
        const float ang = (float)t * inv;
        ctab[idx] = cosf(ang);
        stab[idx] = sinf(ang);
    }
}

__device__ void phase_rowstat(const Params& p) {
    const int lane = otid() & 63;
    const int wave = (obid() * NTHR + otid()) >> 6, nw = gridDim.x * NTHR / 64;
    const float* hm = (const float*)(WS(p) + OFF_HM32);
    float* rstd = (float*)(WS(p) + OFF_RSTD);
    float4 cur[4];
    if (wave < NT) {
#pragma unroll
        for (int i = 0; i < 4; ++i) cur[i] = *(const float4*)(hm + (size_t)wave * DM + i * 256 + lane * 4);
    }
    for (int n = wave; n < NT; n += nw) {
        float ss = 0.f;
#pragma unroll
        for (int i = 0; i < 4; ++i) ss += cur[i].x * cur[i].x + cur[i].y * cur[i].y + cur[i].z * cur[i].z + cur[i].w * cur[i].w;
        if (n + nw < NT) {
#pragma unroll
            for (int i = 0; i < 4; ++i) cur[i] = *(const float4*)(hm + (size_t)(n + nw) * DM + i * 256 + lane * 4);
        }
        ss = wave_sum(ss);
        if (lane == 0) rstd[n] = rsqrtf(ss * (1.0f / 1024.0f) + 1e-6f);
    }
}

struct ConvJob { const float* src; bf16_t* dst; const float* scale; int ldsrc, K, nvalid, nrows, nb, notr; size_t sbs, dbs; const float* srcB; int ldB, split; };
__device__ __forceinline__ int conv_job_tiles(const ConvJob& j) { return j.nb * (j.nrows >> 6) * (j.K >> 6); }
__device__ void conv_tile(const ConvJob& j, int tile, float* lds) {
    const int per = (j.nrows >> 6) * (j.K >> 6);
    const int bi = tile / per, rem = tile % per;
    const int ktiles = j.K >> 6;
    const int n0 = (rem / ktiles) << 6, k0 = (rem % ktiles) << 6;
    const int tid = otid(), tn = tid & 63, tk = tid >> 6;
    const float* src = j.src + (size_t)bi * j.sbs;
    bf16_t* dst = j.dst + (size_t)bi * j.dbs;
#pragma unroll
    for (int kk = 0; kk < 8; ++kk) {
        const int k = k0 + tk * 8 + kk;
        float v = 0.f;
        if (n0 + tn < j.nvalid) {
            if (j.split) { const int nn = n0 + tn; v = (nn < j.split) ? (j.src ? j.src[(size_t)k * j.ldsrc + nn] : 0.f) : j.srcB[(size_t)k * j.ldB + (nn - j.split)]; }
            else v = j.notr ? src[(size_t)(n0 + tn) * j.ldsrc + k] : src[(size_t)k * j.ldsrc + n0 + tn];
            if (j.scale) v *= j.scale[k];
        }
        lds[tn * 65 + tk * 8 + kk] = v;
    }
    __syncthreads();
    const int wn = tid >> 3, kq = tid & 7;
    uint4 o;
    unsigned w[4];
#pragma unroll
    for (int q = 0; q < 4; ++q) {
        const float lo = lds[wn * 65 + kq * 8 + 2 * q], hi = lds[wn * 65 + kq * 8 + 2 * q + 1];
        w[q] = pk2(lo, hi);
    }
    o.x = w[0]; o.y = w[1]; o.z = w[2]; o.w = w[3];
    *(uint4*)(dst + (size_t)(n0 + wn) * j.K + k0 + kq * 8) = o;
    __syncthreads();
}
__device__ ConvJob get_job_early(const Params& p, int l, int ji) {
    bf16_t* wb = (bf16_t*)(WS(p) + OFF_WB);
    const float* win = p.in[3] + (size_t)l * DM * CIN;
    const float* nm = p.in[2] + (size_t)l * DM;
    ConvJob j{}; j.nb = 1; j.sbs = 0; j.dbs = 0; j.K = 1024; j.ldsrc = CIN; j.scale = nm;
    switch (ji) {
    case 0: j.src = win + 3072; j.dst = wb + WB_WIN; j.nvalid = 4352; j.nrows = 4352; break;
    case 1: j.src = (l == 0 ? nullptr : p.in[17]); j.ldsrc = 32; j.split = 32; j.srcB = win + 7424; j.ldB = CIN; j.dst = wb + WB_WIN + (size_t)(4096 + PM_VD) * 1024; j.nvalid = 512; j.nrows = 512; break;
    case 2: j.src = win + 7904; j.dst = wb + WB_WIDX; j.nvalid = 8; j.nrows = 64; break;
    case 3: j.src = win; j.dst = wb + WB_WG; j.nvalid = 3072; j.nrows = 3072; break;
    case 4: j.src = p.in[29] + (size_t)l * DM * DM; j.ldsrc = 1024; j.scale = nullptr; j.dst = wb + WB_PA; j.nvalid = 1024; j.nrows = 1024; break;
    case 5: j.src = p.in[30] + (size_t)l * DM * DM; j.ldsrc = 1024; j.scale = nullptr; j.dst = wb + WB_PA + (size_t)1024 * 1024; j.nvalid = 1024; j.nrows = 1024; break;
    case 6: j.src = p.in[31] + (size_t)l * DM * DM; j.ldsrc = 1024; j.scale = nullptr; j.dst = wb + WB_PA + (size_t)2 * 1024 * 1024; j.nvalid = 1024; j.nrows = 1024; break;
    case 7: j.src = p.in[32] + (size_t)l * DM * DM; j.ldsrc = 1024; j.scale = nullptr; j.dst = wb + WB_WO; j.nvalid = 1024; j.nrows = 1024; break;
    case 8: j.src = p.in[5] + (size_t)l * 4 * 256 * 256; j.ldsrc = 256; j.K = 256; j.scale = nullptr; j.dst = wb + WB_POOL; j.nvalid = 256; j.nrows = 256; j.nb = 4; j.sbs = 65536; j.dbs = 65536; break;
    case 9: j.src = p.in[26] + (size_t)l * 256 * 512; j.ldsrc = 512; j.K = 256; j.scale = nullptr; j.dst = wb + WB_QI; j.nvalid = 512; j.nrows = 512; break;
    case 10: j.src = p.in[23] + (size_t)l * 256 * 1536; j.ldsrc = 1536; j.K = 256; j.scale = nullptr; j.dst = wb + WB_UQ; j.nvalid = 1536; j.nrows = 1536; break;
    case 11: j.src = p.in[24] + (size_t)l * 16 * 128 * 64; j.ldsrc = 64; j.K = 64; j.scale = nullptr; j.dst = wb + WB_UK; j.nvalid = 2048; j.nrows = 2048; j.notr = 1; break;
    default: j.src = p.in[25] + (size_t)l * 16 * 128 * 64; j.ldsrc = 64; j.K = 128; j.scale = nullptr; j.dst = wb + WB_UV; j.nvalid = 64; j.nrows = 64; j.nb = 16; j.sbs = 8192; j.dbs = 8192; break;
    }
    return j;
}
__device__ ConvJob get_job_late(const Params& p, int l, int ji) {
    bf16_t* we = (bf16_t*)(WS(p) + OFF_WEXP);
    ConvJob j{}; j.nb = 16; j.scale = nullptr; j.sbs = 262144; j.dbs = 262144;
    switch (ji) {
    case 0: j.src = p.in[38] + (size_t)l * 16 * 262144; j.dst = we + WE_W1; j.ldsrc = 256; j.K = 1024; j.nvalid = 256; j.nrows = 256; break;
    case 1: j.src = p.in[39] + (size_t)l * 16 * 262144; j.dst = we + WE_W3; j.ldsrc = 256; j.K = 1024; j.nvalid = 256; j.nrows = 256; break;
    default: j.src = p.in[40] + (size_t)l * 16 * 262144; j.dst = we + WE_W2; j.ldsrc = 1024; j.K = 256; j.nvalid = 1024; j.nrows = 1024; break;
    }
    return j;
}
template <bool LATE>
__device__ void phase_convert(const Params& p, int l, unsigned char* lds) {
    const int njobs = LATE ? 3 : 13;
    int base = 0;
    for (int ji = 0; ji < njobs; ++ji) {
        const ConvJob j = LATE ? get_job_late(p, l, ji) : get_job_early(p, l, ji);
        const int nt = conv_job_tiles(j);
        int first = ((int)obid() - base) % (int)gridDim.x; if (first < 0) first += gridDim.x;
        for (int t = first; t < nt; t += gridDim.x) conv_tile(j, t, (float*)lds);
        base += nt;
    }
}

template <int BM> struct G3 {
    static constexpr int MI = BM / 64;
    static constexpr int NA = BM / 64;
    static constexpr int STAGE = BM * 128 + 128 * 128;
    const bf16_t* ap[NA];
    const bf16_t* bp[2];
};
template <int BM>
__device__ __forceinline__ void g3_issue(const G3<BM>& g, int kt, unsigned char* stage, int tid) {
#pragma unroll
    for (int i = 0; i < G3<BM>::NA; ++i) glds16(g.ap[i] + kt * 64, stage + (tid + i * NTHR) * 16);
#pragma unroll
    for (int i = 0; i < 2; ++i) glds16(g.bp[i] + kt * 64, stage + BM * 128 + (tid + i * NTHR) * 16);
}
template <int BM, class FA, class FB>
__device__ __forceinline__ void g3_setup(G3<BM>& g, FA rowptr, FB bcol, int tid) {
#pragma unroll
    for (int i = 0; i < G3<BM>::NA; ++i) { const int idx = tid + i * NTHR, row = idx >> 3, sl = (idx & 7) ^ (row & 7); g.ap[i] = rowptr(row) + sl * 8; }
#pragma unroll
    for (int i = 0; i < 2; ++i) { const int idx = tid + i * NTHR, row = idx >> 3, sl = (idx & 7) ^ (row & 7); g.bp[i] = bcol(row) + sl * 8; }
}
template <int BM>
__device__ __forceinline__ void g3_kloop(f32x4 (&acc)[BM / 64][4], const G3<BM>& g, int K, unsigned char* lds) {
    constexpr int MI = G3<BM>::MI, STAGE = G3<BM>::STAGE, NL = G3<BM>::NA + 2;
    const int tid = otid(), lane = tid & 63, wid = tid >> 6, wr = wid >> 1, wc = wid & 1, fr = lane & 15, fq = lane >> 4;
    const int nk = K >> 6;
    g3_issue<BM>(g, 0, lds, tid);
    if (nk > 1) g3_issue<BM>(g, 1, lds + STAGE, tid);
    int cur = 0;
#pragma unroll 1
    for (int t = 0; t < nk; ++t) {
        if (t + 1 < nk) { if (NL == 6) asm volatile("s_waitcnt vmcnt(6)" ::: "memory"); else if (NL == 5) asm volatile("s_waitcnt vmcnt(5)" ::: "memory"); else asm volatile("s_waitcnt vmcnt(4)" ::: "memory"); }
        else asm volatile("s_waitcnt vmcnt(0)" ::: "memory");
        __builtin_amdgcn_s_barrier();
        if (t + 2 < nk) { int nx = cur + 2; if (nx >= 3) nx -= 3; g3_issue<BM>(g, t + 2, lds + nx * STAGE, tid); }
        const unsigned char* cA = lds + cur * STAGE;
        const unsigned char* cB = cA + BM * 128;
#pragma unroll
        for (int ks = 0; ks < 2; ++ks) {
            bf16x8 a[MI], b[4];
#pragma unroll
            for (int m = 0; m < MI; ++m) { const int row = wr * (BM / 4) + m * 16 + fr; a[m] = *(const bf16x8*)(cA + row * 128 + (((ks * 4 + fq) ^ (row & 7)) << 4)); }
#pragma unroll
            for (int n = 0; n < 4; ++n) { const int row = wc * 64 + n * 16 + fr; b[n] = *(const bf16x8*)(cB + row * 128 + (((ks * 4 + fq) ^ (row & 7)) << 4)); }
#pragma unroll
            for (int m = 0; m < MI; ++m)
#pragma unroll
                for (int n = 0; n < 4; ++n) acc[m][n] = __builtin_amdgcn_mfma_f32_16x16x32_bf16(b[n], a[m], acc[m][n], 0, 0, 0);
        }
        cur = (cur == 2) ? 0 : cur + 1;
    }
    __builtin_amdgcn_s_barrier();
}
struct G3D { const bf16_t* ap[2]; const bf16_t* b1[2]; const bf16_t* b3[2]; };
__device__ __forceinline__ void g3d_issue(const G3D& g, int kt, unsigned char* stage, int tid) {
#pragma unroll
    for (int i = 0; i < 2; ++i) glds16(g.ap[i] + kt * 64, stage + (tid + i * NTHR) * 16);
#pragma unroll
    for (int i = 0; i < 2; ++i) glds16(g.b1[i] + kt * 64, stage + 16384 + (tid + i * NTHR) * 16);
#pragma unroll
    for (int i = 0; i < 2; ++i) glds16(g.b3[i] + kt * 64, stage + 32768 + (tid + i * NTHR) * 16);
}
__device__ __forceinline__ void g3d_kloop(f32x4 (&acc1)[2][4], f32x4 (&acc3)[2][4], const G3D& g, int K, unsigned char* lds) {
    constexpr int STAGE = 49152;
    const int tid = otid(), lane = tid & 63, wid = tid >> 6, wr = wid >> 1, wc = wid & 1, fr = lane & 15, fq = lane >> 4;
    const int nk = K >> 6;
    g3d_issue(g, 0, lds, tid);
    if (nk > 1) g3d_issue(g, 1, lds + STAGE, tid);
    int cur = 0;
#pragma unroll 1
    for (int t = 0; t < nk; ++t) {
        if (t + 1 < nk) asm volatile("s_waitcnt vmcnt(6)" ::: "memory"); else asm volatile("s_waitcnt vmcnt(0)" ::: "memory");
        __builtin_amdgcn_s_barrier();
        if (t + 2 < nk) { int nx = cur + 2; if (nx >= 3) nx -= 3; g3d_issue(g, t + 2, lds + nx * STAGE, tid); }
        const unsigned char* cA = lds + cur * STAGE;
#pragma unroll
        for (int ks = 0; ks < 2; ++ks) {
            bf16x8 a[2], b1[4], b3[4];
#pragma unroll
            for (int m = 0; m < 2; ++m) { const int row = wr * 32 + m * 16 + fr; a[m] = *(const bf16x8*)(cA + row * 128 + (((ks * 4 + fq) ^ (row & 7)) << 4)); }
#pragma unroll
            for (int n = 0; n < 4; ++n) { const int row = wc * 64 + n * 16 + fr; const int off = row * 128 + (((ks * 4 + fq) ^ (row & 7)) << 4);
                b1[n] = *(const bf16x8*)(cA + 16384 + off); b3[n] = *(const bf16x8*)(cA + 32768 + off); }
#pragma unroll
            for (int m = 0; m < 2; ++m)
#pragma unroll
                for (int n = 0; n < 4; ++n) {
                    acc1[m][n] = __builtin_amdgcn_mfma_f32_16x16x32_bf16(b1[n], a[m], acc1[m][n], 0, 0, 0);
                    acc3[m][n] = __builtin_amdgcn_mfma_f32_16x16x32_bf16(b3[n], a[m], acc3[m][n], 0, 0, 0);
                }
        }
        cur = (cur == 2) ? 0 : cur + 1;
    }
    __builtin_amdgcn_s_barrier();
}
template <int MI>
__device__ __forceinline__ void g3_zero(f32x4 (&acc)[MI][4]) {
#pragma unroll
    for (int m = 0; m < MI; ++m)
#pragma unroll
        for (int n = 0; n < 4; ++n) acc[m][n] = (f32x4){0.f, 0.f, 0.f, 0.f};
}
__device__ __forceinline__ uint2 pack4(float a, float b, float c, float d) {
    uint2 r; r.x = pk2(a, b); r.y = pk2(c, d); return r;
}

namespace pg8 {
#define PG8_LAS __attribute__((address_space(3)))
typedef unsigned short bf16_t;
typedef short bf16x8 __attribute__((ext_vector_type(8)));
typedef float f32x4 __attribute__((ext_vector_type(4)));
typedef unsigned u32x4 __attribute__((ext_vector_type(4)));
constexpr int BM = 256, BK = 64, HALF = 128, HTB = HALF * BK * 2  , STAGE_BYTES = 8 * HTB, NXCD = 8, WGM = 8;

__host__ __device__ __forceinline__ int lds_byte(int r, int c) { const int st = (r >> 4) * 2 + (c >> 5), rr = r & 15, cc = c & 31, ob = rr * 64 + cc * 2; return st * 1024 + (ob ^ (((ob >> 9) & 1) << 5)); }
__host__ __device__ __forceinline__ void stage_rc(int b, int& R, int& C) { const int st = b / 1024, sb = b % 1024, swz = sb ^ (((sb >> 9) & 1) << 5); R = (st >> 1) * 16 + swz / 64; C = (st & 1) * 32 + (swz % 64) / 2; }
__host__ __device__ __forceinline__ int perm32(int rho) { const int n = rho >> 4, i = rho & 15; return 8 * (i >> 2) + 4 * n + (i & 3); }

struct Unit { int pm, pn; };
struct Gemm { const bf16_t* A; const bf16_t* Bt; int M, N, K; };

struct StaticOrder {
    int nM, nN, nwg, G, c;
    __host__ __device__ void init(int M, int N, int G_, int c_) { nM = M / BM; nN = N / BM; nwg = nM * nN; G = G_; c = c_; }
    __host__ __device__ bool next(int i, Unit& u) const {
        const long L = (long)i * G + c; if (L >= nwg) return false;
        int wgid = (int)L; { const int q = nwg / NXCD, r = nwg % NXCD, xcd = wgid % NXCD, off = wgid / NXCD; wgid = (xcd < r ? xcd * (q + 1) : r * (q + 1) + (xcd - r) * q) + off; }
        const int nig = WGM * nN, gid = wgid / nig, fm = gid * WGM, gsz = (nM - fm) < WGM ? (nM - fm) : WGM;
        u.pm = fm + ((wgid % nig) % gsz); u.pn = (wgid % nig) / gsz; return true;
    }
    __device__ __forceinline__ void a_ready(const Unit&) const {}
    __device__ __forceinline__ void done(const Unit&) const {}
};
template <class Epi, class Sched, bool STAMP = false>
__device__ __forceinline__ void gemm_phase(PG8_LAS unsigned char* lds, const Gemm g, const Sched& S, const Epi& E, unsigned long long* stamps) {
    const int tid = otid(), wid = __builtin_amdgcn_readfirstlane(tid >> 6), lane = tid & 63, wr = wid >> 2, wc = wid & 3, fr = lane & 15, fq = lane >> 4;
    const int K = g.K, nt = K / BK;
    int ts_lo = 0, ts_hi = 0, nts = 0; const unsigned long long rt_entry = STAMP ? 0ull : 0ull;
#define PG8_STAMP() do { if (STAMP && wid == 0 && nts < 64) { const unsigned long long _c = 0ull; \
        ts_lo = (lane == nts) ? (int)(unsigned)_c : ts_lo; ts_hi = (lane == nts) ? (int)(unsigned)(_c >> 32) : ts_hi; ++nts; } } while (0)
    PG8_STAMP();
    unsigned voffA[2], voffB[2];
#pragma unroll
    for (int i = 0; i < 2; ++i) { int R, C; stage_rc(tid * 16 + i * 8192, R, C); const int Rb = Epi::PERM ? ((R & ~31) + perm32(R & 31)) : R;
        voffA[i] = (unsigned)(R * K + C) * 2u; voffB[i] = (unsigned)(Rb * K + C) * 2u; }
    const size_t kstep = (size_t)(BK * 2);
    const size_t hstep = (size_t)HALF * K * 2;
    const size_t tstep = 2 * hstep;
    const unsigned ldsw = (unsigned)wid * 1024u;
    const int aoff = lds_byte(wr * 64 + fr, fq * 8), boff = lds_byte(wc * 32 + fr, fq * 8);
#define PG8_SA(b, h) (((b) * 2 + (h)) * HTB)
#define PG8_SB(b, h) ((4 + (b) * 2 + (h)) * HTB)
#define PG8_STAGE(bufoff, gbase, voff) do { _Pragma("unroll") for (int _i = 0; _i < 2; ++_i) \
        __builtin_amdgcn_global_load_lds((const unsigned*)((const char*)(gbase) + (voff)[_i]), (PG8_LAS unsigned*)(lds + (bufoff) + ldsw + _i * 8192), 16, 0, 0); } while (0)
#define PG8_LDA(dst, b, h) do { _Pragma("unroll") for (int m = 0; m < 4; ++m) _Pragma("unroll") for (int k = 0; k < 2; ++k) dst[m][k] = *(const PG8_LAS bf16x8*)(lds + PG8_SA(b, h) + aoff + m * 2048 + k * 1024); } while (0)
#define PG8_LDB(dst, b, h) do { _Pragma("unroll") for (int n = 0; n < 2; ++n) _Pragma("unroll") for (int k = 0; k < 2; ++k) dst[n][k] = *(const PG8_LAS bf16x8*)(lds + PG8_SB(b, h) + boff + n * 2048 + k * 1024); } while (0)
#define PG8_MMA(ai, bj, At, Bt) do { __builtin_amdgcn_s_setprio(1); _Pragma("unroll") for (int m = 0; m < 4; ++m) _Pragma("unroll") for (int n = 0; n < 2; ++n) _Pragma("unroll") for (int k = 0; k < 2; ++k) \
        acc[ai][bj][m][n] = __builtin_amdgcn_mfma_f32_16x16x32_bf16(Bt[n][k], At[m][k], acc[ai][bj][m][n], 0, 0, 0); __builtin_amdgcn_s_setprio(0); } while (0)
#define PG8_WAIT_V(n) asm volatile("s_waitcnt vmcnt(" #n ")" ::: "memory")
#define PG8_WAIT_L(n) asm volatile("s_waitcnt lgkmcnt(" #n ")" ::: "memory")
#define PG8_BAR __builtin_amdgcn_s_barrier()
#define PG8_SCHED __builtin_amdgcn_sched_barrier(0)
    Unit cur, nxt; int ui = 0;
    if (!S.next(0, cur)) return;
    f32x4 acc[2][2][4][2];
#pragma unroll
    for (int a = 0; a < 2; ++a)
#pragma unroll
        for (int b = 0; b < 2; ++b)
#pragma unroll
            for (int m = 0; m < 4; ++m)
#pragma unroll
                for (int n = 0; n < 2; ++n) acc[a][b][m][n] = (f32x4){0.f, 0.f, 0.f, 0.f};
    bf16x8 At[4][2], B0[2][2], B1[2][2];
    const char* cA = (const char*)g.A + (size_t)cur.pm * tstep; const char* cB = (const char*)g.Bt + (size_t)cur.pn * tstep;
    S.a_ready(cur);
    PG8_STAGE(PG8_SB(0, 0), cB, voffB); PG8_STAGE(PG8_SA(0, 0), cA, voffA); PG8_STAGE(PG8_SB(0, 1), cB + hstep, voffB); PG8_STAGE(PG8_SA(0, 1), cA + hstep, voffA);
    if (wr == 1) PG8_BAR;
    PG8_WAIT_V(4); PG8_BAR;
    PG8_STAGE(PG8_SB(1, 0), cB + kstep, voffB); PG8_STAGE(PG8_SA(1, 0), cA + kstep, voffA); PG8_STAGE(PG8_SB(1, 1), cB + hstep + kstep, voffB);
    PG8_WAIT_V(6); PG8_BAR;
    PG8_STAMP();
    for (;;) {
        const bool has_next = S.next(ui + 1, nxt);
        const char* nA = has_next ? (const char*)g.A + (size_t)nxt.pm * tstep : cA; const char* nB = has_next ? (const char*)g.Bt + (size_t)nxt.pn * tstep : cB;
        for (int t = 0; t < nt; t += 2) {
            const bool last = (t == nt - 2);
            const char* a1 = cA + (size_t)(t + 1) * kstep;
            const char* a2 = last ? nA : cA + (size_t)(t + 2) * kstep; const char* b2 = last ? nB : cB + (size_t)(t + 2) * kstep;
            const char* a3 = a2 + kstep; const char* b3 = b2 + kstep;
            if (last && has_next) S.a_ready(nxt);
            PG8_LDB(B0, 0, 0); PG8_SCHED; PG8_LDA(At, 0, 0); PG8_STAGE(PG8_SA(1, 1), a1 + hstep, voffA);
            PG8_WAIT_L(8); PG8_BAR; PG8_WAIT_L(0); PG8_MMA(0, 0, At, B0); PG8_BAR; PG8_SCHED;
            PG8_LDB(B1, 0, 1); PG8_STAGE(PG8_SB(0, 0), b2, voffB);
            PG8_BAR; PG8_WAIT_L(0); PG8_MMA(0, 1, At, B1); PG8_BAR;
            PG8_LDA(At, 0, 1); PG8_STAGE(PG8_SA(0, 0), a2, voffA);
            PG8_BAR; PG8_WAIT_L(0); PG8_MMA(1, 0, At, B0); PG8_BAR; PG8_SCHED;
            PG8_STAGE(PG8_SB(0, 1), b2 + hstep, voffB);
            PG8_WAIT_V(6); PG8_BAR; PG8_MMA(1, 1, At, B1); PG8_BAR;
            PG8_LDB(B0, 1, 0); PG8_SCHED; PG8_LDA(At, 1, 0); PG8_STAGE(PG8_SA(0, 1), a2 + hstep, voffA);
            PG8_WAIT_L(8); PG8_BAR; PG8_WAIT_L(0); PG8_MMA(0, 0, At, B0); PG8_BAR; PG8_SCHED;
            PG8_LDB(B1, 1, 1); PG8_STAGE(PG8_SB(1, 0), b3, voffB);
            PG8_BAR; PG8_WAIT_L(0); PG8_MMA(0, 1, At, B1); PG8_BAR;
            PG8_LDA(At, 1, 1); PG8_STAGE(PG8_SA(1, 0), a3, voffA);
            PG8_BAR; PG8_WAIT_L(0); PG8_MMA(1, 0, At, B0); PG8_BAR; PG8_SCHED;
            PG8_STAGE(PG8_SB(1, 1), b3 + hstep, voffB);
            PG8_WAIT_V(6); PG8_BAR; PG8_MMA(1, 1, At, B1); PG8_BAR;
        }
        PG8_STAMP();
        if constexpr (!Epi::AFTER_DRAIN) { E(acc, cur, wr, wc, fr, fq); S.done(cur); }
        PG8_STAMP();
        if (!has_next) break;
#pragma unroll
        for (int a = 0; a < 2; ++a)
#pragma unroll
            for (int b = 0; b < 2; ++b)
#pragma unroll
                for (int m = 0; m < 4; ++m)
#pragma unroll
                    for (int n = 0; n < 2; ++n) acc[a][b][m][n] = (f32x4){0.f, 0.f, 0.f, 0.f};
        cur = nxt; cA = nA; cB = nB; ++ui;
    }
    PG8_WAIT_V(0);
    if (wr == 0) PG8_BAR;
    PG8_BAR;
    if constexpr (Epi::AFTER_DRAIN) { E.fused(acc, cur, wr, wc, fr, fq, lds, wid, lane); S.done(cur); }
    PG8_STAMP();
    if (STAMP && wid == 0) { stamps[lane] = lane < nts ? (((unsigned long long)(unsigned)ts_hi << 32) | (unsigned)ts_lo) : 0ull;
        if (lane == 62) stamps[62] = rt_entry; if (lane == 63) stamps[63] = 0ull; }
#undef PG8_STAMP
#undef PG8_SA
#undef PG8_SB
#undef PG8_STAGE
#undef PG8_LDA
#undef PG8_LDB
#undef PG8_MMA
#undef PG8_WAIT_V
#undef PG8_WAIT_L
#undef PG8_BAR
#undef PG8_SCHED
}
}

struct EpiInproj {
    static constexpr bool PERM = true, AFTER_DRAIN = false;
    unsigned char* ws; const float* rstd;
    __device__ __forceinline__ void operator()(const pg8::f32x4 (&acc)[2][2][4][2], const pg8::Unit& u, int wr, int wc, int fr, int fq) const {
        const int pn = u.pn;
        bf16_t* dst; int ld, cb;
        if (pn < 4) { dst = (bf16_t*)(ws + OFF_PPOOL); ld = 1024; cb = pn * 256; }
        else if (pn < 8) { dst = (bf16_t*)(ws + OFF_PR); ld = 1024; cb = (pn - 4) * 256; }
        else if (pn < 12) { dst = (bf16_t*)(ws + OFF_PK); ld = 1024; cb = (pn - 8) * 256; }
        else if (pn < 16) { dst = (bf16_t*)(ws + OFF_PV); ld = 1024; cb = (pn - 12) * 256; }
        else { dst = (bf16_t*)(ws + OFF_PMISC); ld = PM_LD; cb = (pn - 16) * 256; }
        bf16_t* halo = (bf16_t*)(ws + OFF_HALO);
#pragma unroll
        for (int ai = 0; ai < 2; ++ai)
#pragma unroll
            for (int m = 0; m < 4; ++m) {
                const int row = u.pm * 256 + ai * 128 + wr * 64 + m * 16 + fr;
                if (row < NT) {
                    const float rs = rstd[row];
                    const int lr = row & 127;
#pragma unroll
                    for (int bj = 0; bj < 2; ++bj) {
                        const int col = cb + bj * 128 + wc * 32 + fq * 8;
                        const uint2 lo = pack4(acc[ai][bj][m][0][0] * rs, acc[ai][bj][m][0][1] * rs, acc[ai][bj][m][0][2] * rs, acc[ai][bj][m][0][3] * rs);
                        const uint2 hi = pack4(acc[ai][bj][m][1][0] * rs, acc[ai][bj][m][1][1] * rs, acc[ai][bj][m][1][2] * rs, acc[ai][bj][m][1][3] * rs);
                        const uint4 v = make_uint4(lo.x, lo.y, hi.x, hi.y);
                        *(uint4*)(dst + (size_t)row * ld + col) = v;
                        if (pn < 4 && lr >= 112) *(uint4*)(halo + ((size_t)(row >> 7) * 16 + (lr - 112)) * 1024 + col) = v;
                    }
                }
            }
    }
};
__device__ void phase_inproj(const Params& p, unsigned char* lds) {
    pg8::StaticOrder S; S.init(NTP, NP1, (int)gridDim.x, obid());
    pg8::Gemm g; g.A = (const pg8::bf16_t*)(WS(p) + OFF_H); g.Bt = (const pg8::bf16_t*)(WS(p) + OFF_WB) + WB_WIN; g.M = NTP; g.N = NP1; g.K = DM;
    EpiInproj E; E.ws = WS(p); E.rstd = (const float*)(WS(p) + OFF_RSTD);
    pg8::gemm_phase<EpiInproj, pg8::StaticOrder, false>((PG8_LAS unsigned char*)lds, g, S, E, nullptr);
}

__device__ void phase_pool(const Params& p, int l, unsigned char* lds, int tb, int te, int tstep) {
    const int tid = otid(), lane = tid & 63, wid = tid >> 6, fr = lane & 15, fq = lane >> 4;
    bf16_t* pp = (bf16_t*)(WS(p) + OFF_PPOOL);
    const bf16_t* halo = (const bf16_t*)(WS(p) + OFF_HALO);
    const bf16_t* pw = (const bf16_t*)(WS(p) + OFF_WB) + WB_POOL;
    const float* scale = p.in[6] + (size_t)l * 1024;
    bf16_t* sp = (bf16_t*)lds;
    constexpr int SLD = 264;
    bf16_t* sraw = sp + 128 * SLD;
    for (int tile = tb; tile < te; tile += tstep) {
        const int mt = tile >> 2, g = tile & 3;
        const int row0 = mt * 128, w = 2 << g;
        const bf16_t* wg = pw + (size_t)g * 65536;
        bf16x8 bfr[8][2];
#pragma unroll
        for (int kk = 0; kk < 8; ++kk)
#pragma unroll
            for (int n = 0; n < 2; ++n) bfr[kk][n] = *(const bf16x8*)(wg + (size_t)(wid * 32 + n * 16 + fr) * 256 + kk * 32 + fq * 8);
        {
            for (int e = tid; e < 144 * 32; e += NTHR) {
                const int rr = e >> 5, c16 = e & 31;
                uint4 v = make_uint4(0u, 0u, 0u, 0u);
                if (rr >= 16) v = *(const uint4*)(pp + (size_t)(row0 + rr - 16) * 1024 + g * 256 + c16 * 8);
                else if (mt > 0) v = *(const uint4*)(halo + ((size_t)(mt - 1) * 16 + rr) * 1024 + g * 256 + c16 * 8);
                *(uint4*)(sraw + rr * 256 + c16 * 8) = v;
            }
        }
        __syncthreads();
        {
            const int c = tid & 255, r0 = (tid >> 8) * 64;
            auto rawv = [&](int nrel) -> float { return bf2f(sraw[(nrel + 16) * 256 + c]); };
            int t = (row0 + r0) % TS;
            float sum = 0.f;
            const int have = (t < w) ? t : w;
            for (int i = 1; i <= have; ++i) sum += rawv(r0 - i);
#pragma unroll 8
            for (int r = 0; r < 64; ++r) {
                if (t == 0) sum = 0.f;
                const float v = rawv(r0 + r);
                sum += v;
                if (t >= w) sum -= rawv(r0 + r - w);
                const int cnt = (t + 1 < w) ? (t + 1) : w;
                sp[(r0 + r) * SLD + c] = f2bf(sum * (1.0f / (float)cnt) - v);
                t = (t + 1 == TS) ? 0 : t + 1;
            }
        }
        __syncthreads();
        f32x4 acc[8][2];
#pragma unroll
        for (int m = 0; m < 8; ++m) { acc[m][0] = (f32x4){0.f, 0.f, 0.f, 0.f}; acc[m][1] = (f32x4){0.f, 0.f, 0.f, 0.f}; }
#pragma unroll
        for (int kk = 0; kk < 8; ++kk) {
#pragma unroll
            for (int m = 0; m < 8; ++m) {
                const bf16x8 a = *(const bf16x8*)(sp + (m * 16 + fr) * SLD + kk * 32 + fq * 8);
                acc[m][0] = __builtin_amdgcn_mfma_f32_16x16x32_bf16(bfr[kk][0], a, acc[m][0], 0, 0, 0);
                acc[m][1] = __builtin_amdgcn_mfma_f32_16x16x32_bf16(bfr[kk][1], a, acc[m][1], 0, 0, 0);
            }
        }
#pragma unroll
        for (int n = 0; n < 2; ++n) {
            const int col = g * 256 + wid * 32 + n * 16 + fq * 4;
            const float4 sc = *(const float4*)(scale + col);
#pragma unroll
            for (int m = 0; m < 8; ++m) {
                const int row = row0 + m * 16 + fr;
                *(uint2*)(pp + (size_t)row * 1024 + col) = pack4(acc[m][n][0] * sc.x, acc[m][n][1] * sc.y, acc[m][n][2] * sc.z, acc[m][n][3] * sc.w);
            }
        }
        __syncthreads();
    }
}

__device__ void phase_dsa_prep(const Params& p, int l) {
    const int lane = otid() & 63;
    const int wave = (obid() * NTHR + otid()) >> 6, nw = gridDim.x * NTHR / 64;
    const bf16_t* pm = (const bf16_t*)(WS(p) + OFF_PMISC);
    unsigned char* dob = OUTB(p);
    bf16_t* cqn = (bf16_t*)(dob + DO_CQN);
    bf16_t* kv = (bf16_t*)(dob + DO_KV);
    bf16_t* kidx = (bf16_t*)(dob + DO_KIDX);
    float* whead = (float*)(dob + DO_WHEAD);
    const float* ctab = (const float*)(WS(p) + OFF_ROPE);
    const float* stab = ctab + TS * 16;
    const bf16_t* hrow = (const bf16_t*)(WS(p) + OFF_H);
    const bf16_t* wwidx = (const bf16_t*)(WS(p) + OFF_WB) + WB_WIDX;
    const float* rstd_ = (const float*)(WS(p) + OFF_RSTD);
    const float4 qn4 = *(const float4*)(p.in[21] + l * 256 + lane * 4);
    const float2 kvn2 = *(const float2*)(p.in[22] + l * 128 + lane * 2);
    const float inw = p.in[27][l * 64 + lane], inb = p.in[28][l * 64 + lane];
    uint4 ww[8][2];
#pragma unroll
    for (int j = 0; j < 8; ++j) { ww[j][0] = *(const uint4*)(wwidx + (size_t)j * DM + lane * 16); ww[j][1] = *(const uint4*)(wwidx + (size_t)j * DM + lane * 16 + 8); }
    struct In { uint2 cq; unsigned ckv; bf16_t kr0, kr1, kix; uint4 h0, h1; float rs, c, s; };
    auto load = [&](int n) {
        In r;
        const bf16_t* row = pm + (size_t)n * PM_LD;
        const int t = n % TS;
        r.cq = *(const uint2*)(row + PM_CQ + lane * 4);
        r.ckv = *(const unsigned*)(row + PM_CKV + lane * 2);
        r.kr0 = row[PM_KROPE + (lane & 15)]; r.kr1 = row[PM_KROPE + 16 + (lane & 15)];
        r.kix = row[PM_KIDX + lane];
        r.h0 = *(const uint4*)(hrow + (size_t)n * DM + lane * 16); r.h1 = *(const uint4*)(hrow + (size_t)n * DM + lane * 16 + 8);
        r.rs = rstd_[n];
        r.c = ctab[t * 16 + (lane & 15)]; r.s = stab[t * 16 + (lane & 15)];
        return r;
    };
    In cur = load(wave < NT ? wave : 0);
    for (int n = wave; n < NT; n += nw) {
        const In x = cur;
        if (n + nw < NT) cur = load(n + nw);
        {
            const float v0 = __uint_as_float(x.cq.x << 16), v1 = __uint_as_float(x.cq.x & 0xFFFF0000u), v2 = __uint_as_float(x.cq.y << 16), v3 = __uint_as_float(x.cq.y & 0xFFFF0000u);
            const float ss = wave_sum_fast(v0 * v0 + v1 * v1 + v2 * v2 + v3 * v3);
            const float rs = rsqrtf(ss * (1.0f / 256.0f) + 1e-6f);
            *(uint2*)(cqn + (size_t)n * 256 + lane * 4) = pack4(v0 * rs * qn4.x, v1 * rs * qn4.y, v2 * rs * qn4.z, v3 * rs * qn4.w);
        }
        {
            const float v0 = __uint_as_float(x.ckv << 16), v1 = __uint_as_float(x.ckv & 0xFFFF0000u);
            const float ss = wave_sum_fast(v0 * v0 + v1 * v1);
            const float rs = rsqrtf(ss * (1.0f / 128.0f) + 1e-6f);
            *(unsigned*)(kv + (size_t)n * 160 + lane * 2) = pk2(v0 * rs * kvn2.x, v1 * rs * kvn2.y);
        }
        if (lane < 16) {
            const float x1 = bf2f(x.kr0), x2 = bf2f(x.kr1);
            kv[(size_t)n * 160 + 128 + lane] = f2bf(x1 * x.c - x2 * x.s);
            kv[(size_t)n * 160 + 144 + lane] = f2bf(x2 * x.c + x1 * x.s);
        }
        {
            const float xv = bf2f(x.kix);
            const float mu = wave_sum_fast(xv) * (1.0f / 64.0f);
            const float d = xv - mu;
            const float var = wave_sum_fast(d * d) * (1.0f / 64.0f);
            const float y = d * rsqrtf(var + 1e-6f) * inw + inb;
            const float yo = __shfl_xor(y, 16);
            float o = y;
            if (lane < 32) o = (lane < 16) ? (y * x.c - yo * x.s) : (y * x.c + yo * x.s);
            kidx[(size_t)n * 64 + lane] = f2bf(o);
        }
        {
            const uint4 hv0 = x.h0, hv1 = x.h1;
            float hx[16];
            hx[0] = __uint_as_float(hv0.x << 16); hx[1] = __uint_as_float(hv0.x & 0xFFFF0000u); hx[2] = __uint_as_float(hv0.y << 16); hx[3] = __uint_as_float(hv0.y & 0xFFFF0000u);
            hx[4] = __uint_as_float(hv0.z << 16); hx[5] = __uint_as_float(hv0.z & 0xFFFF0000u); hx[6] = __uint_as_float(hv0.w << 16); hx[7] = __uint_as_float(hv0.w & 0xFFFF0000u);
            hx[8] = __uint_as_float(hv1.x << 16); hx[9] = __uint_as_float(hv1.x & 0xFFFF0000u); hx[10] = __uint_as_float(hv1.y << 16); hx[11] = __uint_as_float(hv1.y & 0xFFFF0000u);
            hx[12] = __uint_as_float(hv1.z << 16); hx[13] = __uint_as_float(hv1.z & 0xFFFF0000u); hx[14] = __uint_as_float(hv1.w << 16); hx[15] = __uint_as_float(hv1.w & 0xFFFF0000u);
            float myw = 0.f;
#pragma unroll
            for (int j = 0; j < 8; ++j) {
                const uint4 w0 = ww[j][0], w1 = ww[j][1];
                float d = hx[0] * __uint_as_float(w0.x << 16) + hx[1] * __uint_as_float(w0.x & 0xFFFF0000u) + hx[2] * __uint_as_float(w0.y << 16) + hx[3] * __uint_as_float(w0.y & 0xFFFF0000u)
                        + hx[4] * __uint_as_float(w0.z << 16) + hx[5] * __uint_as_float(w0.z & 0xFFFF0000u) + hx[6] * __uint_as_float(w0.w << 16) + hx[7] * __uint_as_float(w0.w & 0xFFFF0000u)
                        + hx[8] * __uint_as_float(w1.x << 16) + hx[9] * __uint_as_float(w1.x & 0xFFFF0000u) + hx[10] * __uint_as_float(w1.y << 16) + hx[11] * __uint_as_float(w1.y & 0xFFFF0000u)
                        + hx[12] * __uint_as_float(w1.z << 16) + hx[13] * __uint_as_float(w1.z & 0xFFFF0000u) + hx[14] * __uint_as_float(w1.w << 16) + hx[15] * __uint_as_float(w1.w & 0xFFFF0000u);
                d = wave_sum_fast(d);
                myw = (lane == j) ? d : myw;
            }
            if (lane < 8) whead[(size_t)n * 8 + lane] = myw * x.rs * 0.04419417382415922f;
        }
    }
}

typedef short s16x4 __attribute__((ext_vector_type(4)));
__device__ __forceinline__ unsigned f2h_bits(float f) { const _Float16 h = (_Float16)f; unsigned short u; __builtin_memcpy(&u, &h, 2); return u; }
template <bool IMPORT_SEL>
__device__ void phase_dsa(const Params& p, int l, unsigned char* lds, bf16_t* yc, const unsigned short* gsel, const int* gnsel, int tb, int te, int tstep) {
    unsigned short* s_sc = (unsigned short*)lds;
    bf16_t* s_qi = (bf16_t*)(lds + 66048);
    bf16_t* s_Q = (bf16_t*)lds;
    unsigned short* s_sel = (unsigned short*)(lds + 82432 + 65536);
    int* s_nsel = (int*)(lds + 82432 + 65536 + 8192);
    unsigned char* dob = OUTB(p);
    const bf16_t* cqn = (const bf16_t*)(dob + DO_CQN);
    const bf16_t* kv = (const bf16_t*)(dob + DO_KV);
    const bf16_t* kidx = (const bf16_t*)(dob + DO_KIDX);
    const float* whead = (const float*)(dob + DO_WHEAD);
    const float* ctab = (const float*)(WS(p) + OFF_ROPE);
    const float* stab = ctab + TS * 16;
    const bf16_t* wb = (const bf16_t*)(WS(p) + OFF_WB);
    const bf16_t* wqiT = wb + WB_QI;
    const bf16_t* wuqT = wb + WB_UQ;
    const bf16_t* wuk = wb + WB_UK;
    const bf16_t* wuvT = wb + WB_UV;
    const float scale = 0.10206207261596575f;
    const f32x4 z4 = {0.f, 0.f, 0.f, 0.f};
    bf16_t* gq = (obid() < QS_WS) ? (bf16_t*)(WS(p) + WS_END + (size_t)obid() * QS_BYTES) : (bf16_t*)(OUTB(p) + DO_END + (size_t)(obid() - QS_WS) * QS_BYTES);
    for (int pair = tb; pair < te; pair += tstep) {
        const int qt = 128 - (pair >> 2);
        const int t0 = qt * 16;
#pragma unroll 1
        for (int half = 0; half < 2; ++half) {
        const int tid = otid(), lane = tid & 63, wid = tid >> 6, fr = lane & 15, fq = lane >> 4;
        unsigned char* s_Vw = lds + 82432 + wid * 8192;
        bf16_t* s_qn = (bf16_t*)s_Vw;
        const int b = (pair & 3) * 2 + half;
        const size_t n0 = (size_t)b * TS + t0;
        {
            bf16x8 acq[8];
#pragma unroll
            for (int kk = 0; kk < 8; ++kk) acq[kk] = *(const bf16x8*)(cqn + (n0 + fr) * 256 + kk * 32 + fq * 8);
            f32x4 c[4] = {z4, z4, z4, z4};
#pragma unroll
            for (int kb = 0; kb < 8; kb += 4) {
                bf16x8 bf[4][4];
#pragma unroll
                for (int k4 = 0; k4 < 4; ++k4)
#pragma unroll
                    for (int nt = 0; nt < 4; ++nt) bf[k4][nt] = *(const bf16x8*)(wqiT + (size_t)(wid * 64 + nt * 16 + fr) * 256 + (kb + k4) * 32 + fq * 8);
#pragma unroll
                for (int k4 = 0; k4 < 4; ++k4)
#pragma unroll
                    for (int nt = 0; nt < 4; ++nt) c[nt] = __builtin_amdgcn_mfma_f32_16x16x32_bf16(acq[kb + k4], bf[k4][nt], c[nt], 0, 0, 0);
            }
#pragma unroll
            for (int j = 0; j < 4; ++j) {
                const int t = t0 + fq * 4 + j;
                const float cs = ctab[t * 16 + fr], sn = stab[t * 16 + fr];
                const float x1 = c[0][j], x2 = c[1][j];
                c[0][j] = x1 * cs - x2 * sn; c[1][j] = x2 * cs + x1 * sn;
            }
#pragma unroll
            for (int nt = 0; nt < 4; ++nt)
#pragma unroll
                for (int j = 0; j < 4; ++j) s_qi[(fq * 4 + j) * 512 + wid * 64 + nt * 16 + fr] = f2bf(c[nt][j]);
        }
        __syncthreads();
        if (!IMPORT_SEL) {
            bf16x8 aq[8][2];
#pragma unroll
            for (int h = 0; h < 8; ++h)
#pragma unroll
                for (int ks = 0; ks < 2; ++ks) aq[h][ks] = *(const bf16x8*)(s_qi + fr * 512 + h * 64 + ks * 32 + fq * 8);
            float wh[4][8];
#pragma unroll
            for (int j = 0; j < 4; ++j) {
                const float4 w0 = *(const float4*)(whead + (n0 + fq * 4 + j) * 8), w1 = *(const float4*)(whead + (n0 + fq * 4 + j) * 8 + 4);
                wh[j][0] = w0.x; wh[j][1] = w0.y; wh[j][2] = w0.z; wh[j][3] = w0.w; wh[j][4] = w1.x; wh[j][5] = w1.y; wh[j][6] = w1.z; wh[j][7] = w1.w;
            }
            const int nkt = qt + 1;
            bf16x8 nb0 = {0, 0, 0, 0, 0, 0, 0, 0}, nb1 = nb0;
            if (wid < nkt) { const bf16_t* kr0 = kidx + ((size_t)b * TS + wid * 16 + fr) * 64 + fq * 8; nb0 = *(const bf16x8*)kr0; nb1 = *(const bf16x8*)(kr0 + 32); }
#pragma unroll 1
            for (int kt = wid; kt < nkt; kt += 8) {
                const bf16x8 bk0 = nb0, bk1 = nb1;
                if (kt + 8 < nkt) { const bf16_t* krn = kidx + ((size_t)b * TS + (kt + 8) * 16 + fr) * 64 + fq * 8; nb0 = *(const bf16x8*)krn; nb1 = *(const bf16x8*)(krn + 32); }
                float I[4] = {0.f, 0.f, 0.f, 0.f};
#pragma unroll
                for (int h = 0; h < 8; ++h) {
                    f32x4 a = __builtin_amdgcn_mfma_f32_16x16x32_bf16(aq[h][0], bk0, z4, 0, 0, 0);
                    a = __builtin_amdgcn_mfma_f32_16x16x32_bf16(aq[h][1], bk1, a, 0, 0, 0);
#pragma unroll
                    for (int j = 0; j < 4; ++j) I[j] += wh[j][h] * fmaxf(a[j], 0.f);
                }
#pragma unroll
                for (int j = 0; j < 4; ++j) s_sc[(fq * 4 + j) * 2064 + kt * 16 + fr] = (unsigned short)f2h_bits(I[j]);
            }
        }
        __syncthreads();
#pragma unroll 1
        for (int qi2 = 0; qi2 < 2; ++qi2) {
            const int q = wid + qi2 * 8;
            const int nadm = t0 + q + 1;
            unsigned short* sel = s_sel + q * 256;
            if (IMPORT_SEL) {
                const int ns = gnsel[n0 + q];
                for (int i = lane; i < ns; i += 64) sel[i] = gsel[(n0 + q) * 256 + i];
                if (lane == 0) s_nsel[q] = ns;
            } else if (nadm <= 256) {
                for (int i = lane; i < nadm; i += 64) sel[i] = (unsigned short)i;
                if (lane == 0) s_nsel[q] = nadm;
            } else {
                unsigned* hist = (unsigned*)(lds + 82432 + wid * 8192);
                const unsigned short* scq = s_sc + q * 2064;
                const int nch = (nadm + 63) >> 6;
                unsigned B1 = 0u; int na1 = 0, na2 = 0; unsigned T = 0u;
#pragma unroll 1
                for (int pass = 0; pass < 2; ++pass) {
                    *(uint4*)(hist + lane * 4) = make_uint4(0u, 0u, 0u, 0u);
#pragma unroll 1
                    for (int c0 = 0; c0 < nch; c0 += 8) {
                        unsigned kb[8];
#pragma unroll
                        for (int j = 0; j < 8; ++j) { const int s_ = (c0 + j) * 64 + lane; kb[j] = (s_ < nadm) ? (unsigned)scq[s_] : 0x10000u; }
#pragma unroll
                        for (int j = 0; j < 8; ++j) {
                            const unsigned u = kb[j];
                            const unsigned k = (u & 0x8000u) ? (~u & 0xFFFFu) : (u | 0x8000u);
                            const bool ok = (u < 0x10000u) && (pass == 0 || (k >> 8) == B1);
                            if (ok) atomicAdd(hist + (pass == 0 ? (k >> 8) : (k & 255u)), 1u);
                        }
                    }
                    const int need = 256 - na1;
                    const uint4 h4 = *(const uint4*)(hist + lane * 4);
                    const int sl = (int)(h4.x + h4.y + h4.z + h4.w);
                    int suf = sl;
#pragma unroll
                    for (int o = 1; o < 64; o <<= 1) { const int t_ = __shfl_down(suf, o); suf += (lane + o < 64) ? t_ : 0; }
                    const int above = suf - sl;
                    const bool mine = (suf >= need) && (above < need);
                    int a = above, bsel, asel;
                    if (a + (int)h4.w >= need) { bsel = 3; asel = a; }
                    else { a += (int)h4.w;
                        if (a + (int)h4.z >= need) { bsel = 2; asel = a; }
                        else { a += (int)h4.z;
                            if (a + (int)h4.y >= need) { bsel = 1; asel = a; }
                            else { a += (int)h4.y; bsel = 0; asel = a; } } }
                    const int src = __ffsll((long long)__ballot(mine)) - 1;
                    const unsigned bin = (unsigned)__shfl(lane * 4 + bsel, src); const int nab = __shfl(asel, src);
                    if (pass == 0) { B1 = bin; na1 = nab; } else { T = (B1 << 8) | bin; na2 = nab; }
                }
                {
                    const int rties = 256 - (na1 + na2);
                    int base = 0, ties = 0;
                    const unsigned long long ltmask = (1ull << lane) - 1ull;
#pragma unroll 1
                    for (int c0 = 0; c0 < nch; c0 += 4) {
                        unsigned kb[4];
#pragma unroll
                        for (int j = 0; j < 4; ++j) { const int s_ = (c0 + j) * 64 + lane; kb[j] = (s_ < nadm) ? (unsigned)scq[s_] : 0x10000u; }
#pragma unroll
                        for (int j = 0; j < 4; ++j) {
                            const int s_ = (c0 + j) * 64 + lane;
                            const unsigned u = kb[j];
                            const bool valid = u < 0x10000u;
                            const unsigned k = (u & 0x8000u) ? (~u & 0xFFFFu) : (u | 0x8000u);
                            const bool gt = valid && k > T, eq = valid && k == T;
                            const unsigned long long em = __ballot(eq);
                            const int myrank = ties + __popcll(em & ltmask);
                            const bool take = gt || (eq && myrank < rties);
                            const unsigned long long tm = __ballot(take);
                            const int pos = base + __popcll(tm & ltmask);
                            if (take && pos < 256) sel[pos] = (unsigned short)s_;
                            base += __popcll(tm); ties += __popcll(em);
                        }
                    }
                }
                if (lane == 0) s_nsel[q] = 256;
            }
        }
        __syncthreads();
        if (half == 0) {
            const size_t n0B = n0 + TS;
            bf16_t* s_qnB = s_qn + 1024;
#pragma unroll 1
            for (int hi = 0; hi < 2; ++hi) {
                const int hh = wid * 2 + hi;
                const bf16_t* caA = cqn + (n0 + fr) * 256 + fq * 8;
                const bf16_t* caB = cqn + (n0B + fr) * 256 + fq * 8;
                f32x4 cA[6] = {z4, z4, z4, z4, z4, z4}, cB[6] = {z4, z4, z4, z4, z4, z4};
#pragma unroll
                for (int kb = 0; kb < 8; kb += 2) {
                    bf16x8 bf[2][6], aA[2], aB[2];
#pragma unroll
                    for (int k2 = 0; k2 < 2; ++k2) {
                        aA[k2] = *(const bf16x8*)(caA + (kb + k2) * 32); aB[k2] = *(const bf16x8*)(caB + (kb + k2) * 32);
#pragma unroll
                        for (int nt = 0; nt < 6; ++nt) bf[k2][nt] = *(const bf16x8*)(wuqT + (size_t)(hh * 96 + nt * 16 + fr) * 256 + (kb + k2) * 32 + fq * 8);
                    }
#pragma unroll
                    for (int k2 = 0; k2 < 2; ++k2)
#pragma unroll
                        for (int nt = 0; nt < 6; ++nt) {
                            cA[nt] = __builtin_amdgcn_mfma_f32_16x16x32_bf16(aA[k2], bf[k2][nt], cA[nt], 0, 0, 0);
                            cB[nt] = __builtin_amdgcn_mfma_f32_16x16x32_bf16(aB[k2], bf[k2][nt], cB[nt], 0, 0, 0);
                        }
                }
#pragma unroll
                for (int j = 0; j < 4; ++j) {
                    const int q = fq * 4 + j, t = t0 + q;
                    const float cs = ctab[t * 16 + fr], sn = stab[t * 16 + fr];
                    s_Q[(q * 16 + hh) * 160 + 128 + fr] = f2bf(cA[4][j] * cs - cA[5][j] * sn);
                    s_Q[(q * 16 + hh) * 160 + 144 + fr] = f2bf(cA[5][j] * cs + cA[4][j] * sn);
                    gq[(q * 16 + hh) * 160 + 128 + fr] = f2bf(cB[4][j] * cs - cB[5][j] * sn);
                    gq[(q * 16 + hh) * 160 + 144 + fr] = f2bf(cB[5][j] * cs + cB[4][j] * sn);
#pragma unroll
                    for (int nt = 0; nt < 4; ++nt) { s_qn[q * 64 + nt * 16 + fr] = f2bf(cA[nt][j]); s_qnB[q * 64 + nt * 16 + fr] = f2bf(cB[nt][j]); }
                }
                __syncthreads();
                bf16x8 anA[2], anB[2];
#pragma unroll
                for (int ks = 0; ks < 2; ++ks) { anA[ks] = *(const bf16x8*)(s_qn + fr * 64 + ks * 32 + fq * 8); anB[ks] = *(const bf16x8*)(s_qnB + fr * 64 + ks * 32 + fq * 8); }
                bf16x8 bwk[8][2];
#pragma unroll
                for (int nt = 0; nt < 8; ++nt)
#pragma unroll
                    for (int ks = 0; ks < 2; ++ks) bwk[nt][ks] = *(const bf16x8*)(wuk + (size_t)(hh * 128 + nt * 16 + fr) * 64 + ks * 32 + fq * 8);
#pragma unroll
                for (int nt = 0; nt < 8; ++nt) {
                    f32x4 aA = z4, aB = z4;
#pragma unroll
                    for (int ks = 0; ks < 2; ++ks) {
                        aA = __builtin_amdgcn_mfma_f32_16x16x32_bf16(anA[ks], bwk[nt][ks], aA, 0, 0, 0);
                        aB = __builtin_amdgcn_mfma_f32_16x16x32_bf16(anB[ks], bwk[nt][ks], aB, 0, 0, 0);
                    }
#pragma unroll
                    for (int j = 0; j < 4; ++j) {
                        s_Q[((fq * 4 + j) * 16 + hh) * 160 + nt * 16 + fr] = f2bf(aA[j]);
                        gq[((fq * 4 + j) * 16 + hh) * 160 + nt * 16 + fr] = f2bf(aB[j]);
                    }
                }
                __syncthreads();
            }
        } else {
            for (int e = tid; e < QS_BYTES / 16; e += NTHR) ((uint4*)s_Q)[e] = ((const uint4*)gq)[e];
            __syncthreads();
        }
#pragma unroll 1
        for (int qi2 = 0; qi2 < 2; ++qi2) {
            const int q = wid + qi2 * 8;
            bf16x8 bq[5];
#pragma unroll
            for (int ks = 0; ks < 5; ++ks) bq[ks] = *(const bf16x8*)(s_Q + (q * 16 + fr) * 160 + ks * 32 + fq * 8);
            const int nsel = s_nsel[q];
            const unsigned short* sel = s_sel + q * 256;
            float m = -INFINITY, lsum = 0.f;
            f32x4 O[8] = {z4, z4, z4, z4, z4, z4, z4, z4};
            const int nchunk = (nsel + 31) >> 5;
            bf16x8 akn[2][5];
#pragma unroll
            for (int mt = 0; mt < 2; ++mt) {
                const int ki = mt * 16 + fr;
                const int sidx = sel[ki < nsel ? ki : 0];
                const bf16_t* krow = kv + ((size_t)b * TS + sidx) * 160 + fq * 8;
#pragma unroll
                for (int ks = 0; ks < 5; ++ks) akn[mt][ks] = *(const bf16x8*)(krow + ks * 32);
            }
#pragma unroll 1
            for (int ch = 0; ch < nchunk; ++ch) {
                bf16x8 ak[2][5];
#pragma unroll
                for (int mt = 0; mt < 2; ++mt)
#pragma unroll
                    for (int ks = 0; ks < 5; ++ks) ak[mt][ks] = akn[mt][ks];
                if (ch + 1 < nchunk) {
#pragma unroll
                    for (int mt = 0; mt < 2; ++mt) {
                        const int ki = (ch + 1) * 32 + mt * 16 + fr;
                        const int sidx = sel[ki < nsel ? ki : 0];
                        const bf16_t* krow = kv + ((size_t)b * TS + sidx) * 160 + fq * 8;
#pragma unroll
                        for (int ks = 0; ks < 5; ++ks) akn[mt][ks] = *(const bf16x8*)(krow + ks * 32);
                    }
                }
#pragma unroll
                for (int mt = 0; mt < 2; ++mt)
#pragma unroll
                    for (int ks = 0; ks < 4; ++ks) {
                        const int r = mt * 16 + fr;
                        *(bf16x8*)(s_Vw + r * 256 + (((ks * 2 + (fq >> 1)) ^ (r & 7)) * 32) + (fq & 1) * 16) = ak[mt][ks];
                    }
                f32x4 st[2] = {z4, z4};
#pragma unroll
                for (int mt = 0; mt < 2; ++mt)
#pragma unroll
                    for (int ks = 0; ks < 5; ++ks) st[mt] = __builtin_amdgcn_mfma_f32_16x16x32_bf16(ak[mt][ks], bq[ks], st[mt], 0, 0, 0);
                float sv[2][4]; float cmax = -INFINITY;
#pragma unroll
                for (int mt = 0; mt < 2; ++mt)
#pragma unroll
                    for (int j = 0; j < 4; ++j) {
                        const int ke = ch * 32 + mt * 16 + fq * 4 + j;
                        const float s_ = (ke < nsel) ? st[mt][j] * scale : -INFINITY;
                        sv[mt][j] = s_; cmax = fmaxf(cmax, s_);
                    }
                cmax = fmaxf(cmax, __shfl_xor(cmax, 16)); cmax = fmaxf(cmax, __shfl_xor(cmax, 32));
                const float mnew = fmaxf(m, cmax);
                const float alpha = __expf(m - mnew);
                float psum = 0.f;
#pragma unroll
                for (int mt = 0; mt < 2; ++mt)
#pragma unroll
                    for (int j = 0; j < 4; ++j) { const float pe = __expf(sv[mt][j] - mnew); sv[mt][j] = pe; psum += pe; }
                psum += __shfl_xor(psum, 16); psum += __shfl_xor(psum, 32);
                lsum = lsum * alpha + psum; m = mnew;
#pragma unroll
                for (int ct = 0; ct < 8; ++ct) O[ct] = O[ct] * alpha;
                bf16x8 pf;
#pragma unroll
                for (int mt = 0; mt < 2; ++mt)
#pragma unroll
                    for (int j = 0; j < 4; ++j) pf[mt * 4 + j] = (short)f2bf(sv[mt][j]);
                const int q_ = fr >> 2, p_ = fr & 3;
                const int r0 = fq * 4 + q_, r1 = 16 + r0;
#pragma unroll
                for (int ct = 0; ct < 8; ++ct) {
                    const s16x4 v0 = __builtin_amdgcn_ds_read_tr16_b64_v4i16((__attribute__((address_space(3))) s16x4*)(s_Vw + r0 * 256 + ((ct ^ (r0 & 7)) * 32) + p_ * 8));
                    const s16x4 v1 = __builtin_amdgcn_ds_read_tr16_b64_v4i16((__attribute__((address_space(3))) s16x4*)(s_Vw + r1 * 256 + ((ct ^ (r1 & 7)) * 32) + p_ * 8));
                    bf16x8 av; av[0] = v0[0]; av[1] = v0[1]; av[2] = v0[2]; av[3] = v0[3]; av[4] = v1[0]; av[5] = v1[1]; av[6] = v1[2]; av[7] = v1[3];
                    O[ct] = __builtin_amdgcn_mfma_f32_16x16x32_bf16(av, pf, O[ct], 0, 0, 0);
                }
            }
            const float inv = 1.0f / lsum;
#pragma unroll
            for (int ct = 0; ct < 8; ++ct)
#pragma unroll
                for (int j = 0; j < 4; ++j) s_Q[(q * 16 + fr) * 160 + ct * 16 + fq * 4 + j] = f2bf(O[ct][j] * inv);
        }
        __syncthreads();
#pragma unroll 1
        for (int hi = 0; hi < 2; ++hi) {
            const int hh = wid * 2 + hi;
            bf16x8 ao[4];
#pragma unroll
            for (int ks = 0; ks < 4; ++ks) ao[ks] = *(const bf16x8*)(s_Q + (fr * 16 + hh) * 160 + ks * 32 + fq * 8);
#pragma unroll
            for (int nt = 0; nt < 4; ++nt) {
                f32x4 a = z4;
#pragma unroll
                for (int ks = 0; ks < 4; ++ks)
                    a = __builtin_amdgcn_mfma_f32_16x16x32_bf16(ao[ks], *(const bf16x8*)(wuvT + (size_t)(hh * 64 + nt * 16 + fr) * 128 + ks * 32 + fq * 8), a, 0, 0, 0);
#pragma unroll
                for (int j = 0; j < 4; ++j) yc[(n0 + fq * 4 + j) * 1024 + hh * 64 + nt * 16 + fr] = f2bf(a[j]);
            }
        }
        __syncthreads();
        }
    }
}


__device__ void phase_lr_prep(const Params& p, int l) {
    const int lane = otid() & 63;
    const int wave = (obid() * NTHR + otid()) >> 6, nw = gridDim.x * NTHR / 64;
    const bf16_t* pm = (const bf16_t*)(WS(p) + OFF_PMISC);
    bf16_t* alr = (bf16_t*)(OUTB(p) + DO_ALR);
    const float4 mu4 = *(const float4*)(p.in[4] + (size_t)l * 3328 + 3072 + lane * 4);
    const float4 vm4 = *(const float4*)(p.in[18] + (lane & 7) * 4);
    struct In { uint2 c0, p0, c1, p1; };
    auto load = [&](int n) {
        In r;
        const bf16_t* row = pm + (size_t)n * PM_LD;
        const bool hp = (n % TS) > 0;
        r.c0 = *(const uint2*)(row + lane * 4);
        r.p0 = hp ? *(const uint2*)(row - PM_LD + lane * 4) : make_uint2(0u, 0u);
        r.c1 = make_uint2(0u, 0u); r.p1 = r.c1;
        if (lane < 8) { r.c1 = *(const uint2*)(row + 256 + lane * 4); if (hp) r.p1 = *(const uint2*)(row - PM_LD + 256 + lane * 4); }
        return r;
    };
    auto mix4 = [&](const uint2 c, const uint2 q, const float4 m, float (&o)[4]) {
        const float c0 = __uint_as_float(c.x << 16), c1 = __uint_as_float(c.x & 0xFFFF0000u), c2 = __uint_as_float(c.y << 16), c3 = __uint_as_float(c.y & 0xFFFF0000u);
        const float q0 = __uint_as_float(q.x << 16), q1 = __uint_as_float(q.x & 0xFFFF0000u), q2 = __uint_as_float(q.y << 16), q3 = __uint_as_float(q.y & 0xFFFF0000u);
        o[0] = c0 + (q0 - c0) * m.x; o[1] = c1 + (q1 - c1) * m.y; o[2] = c2 + (q2 - c2) * m.z; o[3] = c3 + (q3 - c3) * m.w;
    };
    In cur = load(wave < NT ? wave : 0);
    for (int n = wave; n < NT; n += nw) {
        const In x = cur;
        if (n + nw < NT) cur = load(n + nw);
        float o[4];
        mix4(x.c0, x.p0, mu4, o);
        if (lane < 16) { o[0] = tanhf(o[0]); o[1] = tanhf(o[1]); o[2] = tanhf(o[2]); o[3] = tanhf(o[3]); }
        else if (lane >= 32) { o[0] = sigmoidf_(o[0]); o[1] = sigmoidf_(o[1]); o[2] = sigmoidf_(o[2]); o[3] = sigmoidf_(o[3]); }
        *(uint2*)(alr + (size_t)n * 288 + lane * 4) = pack4(o[0], o[1], o[2], o[3]);
        if (lane < 8) {
            mix4(x.c1, x.p1, vm4, o);
            *(uint2*)(alr + (size_t)n * 288 + 256 + lane * 4) = pack4(o[0], o[1], o[2], o[3]);
        }
    }
}

typedef short sh4 __attribute__((ext_vector_type(4)));
__device__ __forceinline__ sh4 pk4v(const f32x4& v) { const uint2 u = pack4(v[0], v[1], v[2], v[3]); sh4 r; __builtin_memcpy(&r, &u, 8); return r; }
__device__ __forceinline__ bf16x8 cat8(const sh4& a, const sh4& b) { bf16x8 r; r[0] = a[0]; r[1] = a[1]; r[2] = a[2]; r[3] = a[3]; r[4] = b[0]; r[5] = b[1]; r[6] = b[2]; r[7] = b[3]; return r; }
#define MF32(a, b, c) __builtin_amdgcn_mfma_f32_16x16x32_bf16(a, b, c, 0, 0, 0)
#define MF16(a, b, c) MF32(cat8(a, sh4{0, 0, 0, 0}), cat8(b, sh4{0, 0, 0, 0}), c)
constexpr int SC_LT = 72;
constexpr int SC_LS = 36;
constexpr int SC_TC = 32;
constexpr int SC_ROWB = 1088;
__device__ __forceinline__ const unsigned char* scan_piece_src(const Params& p, int l, int b, int hc, int t0, int pi, bool& ok) {
    const int tau = pi / 68, seg = pi - tau * 68;
    const int t = t0 + tau;
    ok = (t < TS) && (tau < SC_TC);
    const size_t n = (size_t)b * TS + t;
    const unsigned char* ws = WS(p);
    if (seg < 8) return ws + OFF_PR + (n * 1024 + hc) * 2 + seg * 16;
    if (seg < 16) return ws + OFF_PK + (n * 1024 + hc) * 2 + (seg - 8) * 16;
    if (seg < 24) return ws + OFF_PV + (n * 1024 + hc) * 2 + (seg - 16) * 16;
    if (seg < 60) return OUTB(p) + DO_ALR + (n * 288) * 2 + (seg - 24) * 16;
    ok = ok && (l > 0);
    return ws + OFF_VFIRST + (n * 1024 + hc) * 2 + (seg - 60) * 16;
}
__device__ void phase_scan5(const Params& p, int l, unsigned char* lds, int blk) {
    const int tid = otid(), lane = tid & 63, wid = tid >> 6, fr = lane & 15, fq = lane >> 4;
    const int b = blk >> 4, hh = blk & 15, hc = hh * 64;
    float* s_r = (float*)lds;
    float* s_w = s_r + 2048;
    float* s_k = s_w + 2048;
    float* s_v = s_k + 2048;
    float* s_a = s_v + 2048;
    float* s_b = s_a + 2048;
    float* s_g = s_b + 2048;
    float* s_o = s_g + 2048;
    bf16_t* o_at = (bf16_t*)(s_o + 2048);
    bf16_t* o_rt = o_at + 32 * SC_LT;
    bf16_t* o_bt = o_rt + 32 * SC_LT;
    bf16_t* o_kt = o_bt + 32 * SC_LT;
    bf16_t* o_bT = o_kt + 32 * SC_LT;
    bf16_t* o_kT = o_bT + 64 * SC_LS;
    bf16_t* o_vT = o_kT + 64 * SC_LS;
    float* s_gc = (float*)(o_vT + 64 * SC_LS);
    unsigned char* raw = (unsigned char*)(s_gc + 128);
    float* prevb = (float*)(raw + 32 * SC_ROWB);
    unsigned* prevr = (unsigned*)prevb;
    float* s_bs = s_r;
    float* cst = prevb + 960;
    const float* mu = p.in[4] + (size_t)l * 3328;
    for (int e = tid; e < 480; e += NTHR) {
        float v;
        if (e < 192) v = mu[(e >> 6) * 1024 + hc + (e & 63)];
        else if (e < 448) v = mu[3072 + (e - 192)];
        else v = p.in[18][e - 448];
        cst[e] = v;
    }
    if (tid < 64) {
        cst[480 + tid] = p.in[7][l * 1024 + hc + tid];
        cst[544 + tid] = p.in[9][l * 1024 + hc + tid];
        cst[608 + tid] = p.in[12][l * 1024 + hc + tid];
        cst[672 + tid] = p.in[13][l * 1024 + hc + tid];
        cst[736 + tid] = p.in[14][l * 1024 + hc + tid];
        cst[800 + tid] = p.in[15][l * 1024 + hc + tid];
        cst[864 + tid] = p.in[16][l * 1024 + hc + tid];
        cst[928 + tid] = p.in[19][hc + tid];
    }
    const int mm = wid >> 1, ntb = (wid & 1) * 2;
    const int nks = (mm == 2) ? 4 : (mm == 3 ? 1 : 2);
    bf16x8 Bw[2][4];
    {
        const float* wsrc = (mm == 0) ? p.in[8] + (size_t)l * 64 * 1024 : (mm == 1) ? p.in[10] + (size_t)l * 64 * 1024 : (mm == 2) ? p.in[11] + (size_t)l * 128 * 1024 : p.in[20];
#pragma unroll
        for (int n2 = 0; n2 < 2; ++n2)
#pragma unroll
            for (int ks = 0; ks < 4; ++ks) {
                bf16x8 f;
#pragma unroll
                for (int j = 0; j < 8; ++j) {
                    const bool okw = ks < nks && (mm < 3 || l > 0);
                    const float v = wsrc[(size_t)(okw ? (ks * 32 + fq * 8 + j) : 0) * 1024 + hc + (ntb + n2) * 16 + fr];
                    f[j] = (short)f2bf(okw ? v : 0.f);
                }
                Bw[n2][ks] = f;
            }
    }
    const f32x4 z4 = {0.f, 0.f, 0.f, 0.f};
    f32x4 S[4] = {z4, z4, z4, z4};
    sh4 Lf;
#pragma unroll
    for (int j = 0; j < 4; ++j) Lf[j] = (fq * 4 + j <= fr) ? (short)0x3F80 : (short)0;
    bf16_t* Pr = (bf16_t*)(WS(p) + OFF_PR);
    bf16_t* vfirst = (bf16_t*)(WS(p) + OFF_VFIRST);
    const unsigned char* psrc[5]; int pstep[5], ptau[5]; bool pval[5];
#pragma unroll
    for (int k = 0; k < 5; ++k) {
        const int pi = tid + k * NTHR;
        bool ok = false;
        psrc[k] = scan_piece_src(p, l, b, hc, 0, pi < SC_TC * 68 ? pi : 0, ok);
        const int tau = (pi < SC_TC * 68 ? pi : 0) / 68, seg = (pi < SC_TC * 68 ? pi : 0) - tau * 68;
        ptau[k] = tau;
        pstep[k] = SC_TC * ((seg >= 24 && seg < 60) ? 576 : 2048);
        pval[k] = (pi < SC_TC * 68) && !(seg >= 60 && l == 0);
    }
    uint4 pre[5];
#pragma unroll
    for (int k = 0; k < 5; ++k) { pre[k] = make_uint4(0, 0, 0, 0); if (pval[k] && ptau[k] < TS) pre[k] = *(const uint4*)psrc[k]; }
    __syncthreads();
#pragma unroll 1
    for (int t0 = 0, ch = 0; t0 < TS; t0 += SC_TC, ++ch) {
        const int nval = (TS - t0 < SC_TC) ? (TS - t0) : SC_TC;
#pragma unroll
        for (int k = 0; k < 5; ++k) { const int pi = tid + k * NTHR; if (pi < SC_TC * 68) *(uint4*)(raw + pi * 16) = pre[k]; }
        lds_barrier();
#pragma unroll
        for (int k = 0; k < 5; ++k) {
            pre[k] = make_uint4(0, 0, 0, 0);
            if (pval[k] && t0 + SC_TC + ptau[k] < TS) pre[k] = *(const uint4*)(psrc[k] + (size_t)(ch + 1) * pstep[k]);
        }
        if (mm < 3 || l > 0) {
            const unsigned char* Ab = raw + ((mm == 0) ? 384 : (mm == 1) ? 512 : (mm == 2) ? 640 : 896);
            float* dst = (mm == 0) ? s_w : (mm == 1) ? s_a : (mm == 2) ? s_g : s_o;
#pragma unroll
            for (int m = 0; m < 2; ++m) {
                f32x4 acc0 = {0.f, 0.f, 0.f, 0.f}, acc1 = {0.f, 0.f, 0.f, 0.f};
#pragma unroll
                for (int ks = 0; ks < 4; ++ks) {
                    if (ks < nks) {
                        const bf16x8 a = *(const bf16x8*)(Ab + (m * 16 + fr) * SC_ROWB + ks * 64 + fq * 16);
                        acc0 = __builtin_amdgcn_mfma_f32_16x16x32_bf16(a, Bw[0][ks], acc0, 0, 0, 0);
                        acc1 = __builtin_amdgcn_mfma_f32_16x16x32_bf16(a, Bw[1][ks], acc1, 0, 0, 0);
                    }
                }
                if (mm == 0) {
                    const float cw0 = cst[480 + ntb * 16 + fr], cw1 = cst[480 + (ntb + 1) * 16 + fr];
                    f32x4 l0, l1, r0, r1;
#pragma unroll
                    for (int j = 0; j < 4; ++j) { l0[j] = -0.6065306597126334f * fast_sigmoid(acc0[j] + cw0); l1[j] = -0.6065306597126334f * fast_sigmoid(acc1[j] + cw1); }
                    const uint2 h0 = pack4(l0[0], l0[1], l0[2], l0[3]), h1 = pack4(l1[0], l1[1], l1[2], l1[3]);
                    r0[0] = l0[0] - __uint_as_float(h0.x << 16); r0[1] = l0[1] - __uint_as_float(h0.x & 0xFFFF0000u); r0[2] = l0[2] - __uint_as_float(h0.y << 16); r0[3] = l0[3] - __uint_as_float(h0.y & 0xFFFF0000u);
                    r1[0] = l1[0] - __uint_as_float(h1.x << 16); r1[1] = l1[1] - __uint_as_float(h1.x & 0xFFFF0000u); r1[2] = l1[2] - __uint_as_float(h1.y << 16); r1[3] = l1[3] - __uint_as_float(h1.y & 0xFFFF0000u);
                    sh4 hh0, hh1; __builtin_memcpy(&hh0, &h0, 8); __builtin_memcpy(&hh1, &h1, 8);
                    f32x4 c0 = MF16(Lf, pk4v(r0), z4), c1 = MF16(Lf, pk4v(r1), z4);
                    c0 = MF16(Lf, hh0, c0); c1 = MF16(Lf, hh1, c1);
#pragma unroll
                    for (int j = 0; j < 4; ++j) {
                        const int eo = (m * 16 + fq * 4 + j) * 64 + ntb * 16 + fr;
                        s_w[eo] = c0[j]; s_w[eo + 16] = c1[j];
                        s_b[eo] = l0[j]; s_b[eo + 16] = l1[j];
                    }
                } else {
#pragma unroll
                    for (int j = 0; j < 4; ++j) {
                        dst[(m * 16 + fq * 4 + j) * 64 + ntb * 16 + fr] = acc0[j];
                        dst[(m * 16 + fq * 4 + j) * 64 + (ntb + 1) * 16 + fr] = acc1[j];
                    }
                }
            }
        }
        lds_barrier();
        {
            const int tau = tid >> 4, c4 = (tid & 15) * 4, e = tau * 64 + c4, t = t0 + tau;
            const size_t n = (size_t)b * TS + t;
            const float4 cum4 = *(const float4*)(s_w + e), lw4 = *(const float4*)(s_b + e), xa4 = *(const float4*)(s_a + e);
            const float4 ca = *(const float4*)(cst + 544 + c4), ckk = *(const float4*)(cst + 608 + c4), cka = *(const float4*)(cst + 672 + c4), crk = *(const float4*)(cst + 736 + c4);
            const float cum[4] = {cum4.x, cum4.y, cum4.z, cum4.w}, lw[4] = {lw4.x, lw4.y, lw4.z, lw4.w};
            const float xa[4] = {xa4.x + ca.x, xa4.y + ca.y, xa4.z + ca.z, xa4.w + ca.w};
            const float kkc[4] = {ckk.x, ckk.y, ckk.z, ckk.w}, kac[4] = {cka.x, cka.y, cka.z, cka.w};
            float rr[4], kr[4], vv[4];
            {
                const unsigned char* rc = raw + tau * SC_ROWB + c4 * 2;
                const uint2 cr = *(const uint2*)rc, ck = *(const uint2*)(rc + 128), cv = *(const uint2*)(rc + 256);
                uint2 qr = make_uint2(0u, 0u), qk = qr, qv = qr;
                if (tau > 0) { qr = *(const uint2*)(rc - SC_ROWB); qk = *(const uint2*)(rc - SC_ROWB + 128); qv = *(const uint2*)(rc - SC_ROWB + 256); }
                else if (t0 > 0) { const unsigned* pvr = prevr + ((ch + 1) & 1) * 96 + (c4 >> 1); qr = *(const uint2*)pvr; qk = *(const uint2*)(pvr + 32); qv = *(const uint2*)(pvr + 64); }
                if (tau == SC_TC - 1) { unsigned* pwr = prevr + (ch & 1) * 96 + (c4 >> 1); *(uint2*)pwr = cr; *(uint2*)(pwr + 32) = ck; *(uint2*)(pwr + 64) = cv; }
                const float4 mr = *(const float4*)(cst + c4), mk = *(const float4*)(cst + 64 + c4), mv = *(const float4*)(cst + 128 + c4);
                const float c_[12] = {__uint_as_float(cr.x << 16), __uint_as_float(cr.x & 0xFFFF0000u), __uint_as_float(cr.y << 16), __uint_as_float(cr.y & 0xFFFF0000u),
                                      __uint_as_float(ck.x << 16), __uint_as_float(ck.x & 0xFFFF0000u), __uint_as_float(ck.y << 16), __uint_as_float(ck.y & 0xFFFF0000u),
                                      __uint_as_float(cv.x << 16), __uint_as_float(cv.x & 0xFFFF0000u), __uint_as_float(cv.y << 16), __uint_as_float(cv.y & 0xFFFF0000u)};
                const float q_[12] = {__uint_as_float(qr.x << 16), __uint_as_float(qr.x & 0xFFFF0000u), __uint_as_float(qr.y << 16), __uint_as_float(qr.y & 0xFFFF0000u),
                                      __uint_as_float(qk.x << 16), __uint_as_float(qk.x & 0xFFFF0000u), __uint_as_float(qk.y << 16), __uint_as_float(qk.y & 0xFFFF0000u),
                                      __uint_as_float(qv.x << 16), __uint_as_float(qv.x & 0xFFFF0000u), __uint_as_float(qv.y << 16), __uint_as_float(qv.y & 0xFFFF0000u)};
                const float m_[12] = {mr.x, mr.y, mr.z, mr.w, mk.x, mk.y, mk.z, mk.w, mv.x, mv.y, mv.z, mv.w};
#pragma unroll
                for (int j = 0; j < 4; ++j) { rr[j] = c_[j] + (q_[j] - c_[j]) * m_[j]; kr[j] = c_[4 + j] + (q_[4 + j] - c_[4 + j]) * m_[4 + j]; vv[j] = c_[8 + j] + (q_[8 + j] - c_[8 + j]) * m_[8 + j]; }
            }
            if (l > 0) {
                const float4 xv4 = *(const float4*)(s_o + e), cv = *(const float4*)(cst + 928 + c4);
                const uint2 vfu = *(const uint2*)(raw + tau * SC_ROWB + 960 + c4 * 2);
                const float vf[4] = {__uint_as_float(vfu.x << 16), __uint_as_float(vfu.x & 0xFFFF0000u), __uint_as_float(vfu.y << 16), __uint_as_float(vfu.y & 0xFFFF0000u)};
                const float xv[4] = {xv4.x + cv.x, xv4.y + cv.y, xv4.z + cv.z, xv4.w + cv.w};
#pragma unroll
                for (int j = 0; j < 4; ++j) vv[j] = vv[j] + (vf[j] - vv[j]) * fast_sigmoid(xv[j]);
            } else if (t < TS) {
                *(uint2*)(vfirst + n * 1024 + hc + c4) = pack4(vv[0], vv[1], vv[2], vv[3]);
            }
            float av[4], kkv[4], ginc[4], gexc[4], ginv[4]; float ss = 0.f;
#pragma unroll
            for (int j = 0; j < 4; ++j) {
                ginc[j] = __expf(cum[j]); gexc[j] = __expf(cum[j] - lw[j]); ginv[j] = __expf(-cum[j]);
                av[j] = fast_sigmoid(xa[j]);
                kkv[j] = kr[j] * kkc[j];
                ss += kkv[j] * kkv[j];
            }
            float kk[4], kt[4];
#pragma unroll
            for (int j = 0; j < 4; ++j) kt[j] = kr[j] * (1.0f + (av[j] - 1.0f) * kac[j]);
            float bsum = rr[0] * kt[0] * crk.x + rr[1] * kt[1] * crk.y + rr[2] * kt[2] * crk.z + rr[3] * kt[3] * crk.w;
            float du0 = 0.f, du1 = 0.f;
            row16_sum4(ss, bsum, du0, du1);
            if ((tid & 15) == 0) s_bs[tau] = bsum;
            const float rn = rsqrtf(fmaxf(ss, 1e-24f));
#pragma unroll
            for (int j = 0; j < 4; ++j) kk[j] = kkv[j] * rn;
            const uint2 pa = pack4(-kk[0] * gexc[0], -kk[1] * gexc[1], -kk[2] * gexc[2], -kk[3] * gexc[3]);
            const uint2 pr = pack4(rr[0] * ginc[0], rr[1] * ginc[1], rr[2] * ginc[2], rr[3] * ginc[3]);
            const uint2 pb = pack4(kk[0] * av[0] * ginv[0], kk[1] * av[1] * ginv[1], kk[2] * av[2] * ginv[2], kk[3] * av[3] * ginv[3]);
            const uint2 pk = pack4(kt[0] * ginv[0], kt[1] * ginv[1], kt[2] * ginv[2], kt[3] * ginv[3]);
            const uint2 pv = pack4(vv[0], vv[1], vv[2], vv[3]);
            *(uint2*)(o_at + tau * SC_LT + c4) = pa;
            *(uint2*)(o_rt + tau * SC_LT + c4) = pr;
            *(uint2*)(o_bt + tau * SC_LT + c4) = pb;
            *(uint2*)(o_kt + tau * SC_LT + c4) = pk;
            o_bT[(c4 + 0) * SC_LS + tau] = (bf16_t)(pb.x & 0xFFFFu); o_bT[(c4 + 1) * SC_LS + tau] = (bf16_t)(pb.x >> 16); o_bT[(c4 + 2) * SC_LS + tau] = (bf16_t)(pb.y & 0xFFFFu); o_bT[(c4 + 3) * SC_LS + tau] = (bf16_t)(pb.y >> 16);
            o_kT[(c4 + 0) * SC_LS + tau] = (bf16_t)(pk.x & 0xFFFFu); o_kT[(c4 + 1) * SC_LS + tau] = (bf16_t)(pk.x >> 16); o_kT[(c4 + 2) * SC_LS + tau] = (bf16_t)(pk.y & 0xFFFFu); o_kT[(c4 + 3) * SC_LS + tau] = (bf16_t)(pk.y >> 16);
            o_vT[(c4 + 0) * SC_LS + tau] = (bf16_t)(pv.x & 0xFFFFu); o_vT[(c4 + 1) * SC_LS + tau] = (bf16_t)(pv.x >> 16); o_vT[(c4 + 2) * SC_LS + tau] = (bf16_t)(pv.y & 0xFFFFu); o_vT[(c4 + 3) * SC_LS + tau] = (bf16_t)(pv.y >> 16);
            if ((tau & 15) == 15) *(float4*)(s_gc + (tau >> 4) * 64 + c4) = make_float4(ginc[0], ginc[1], ginc[2], ginc[3]);
            *(float4*)(s_v + e) = make_float4(vv[0], vv[1], vv[2], vv[3]);
        }
        lds_barrier();
        if (wid < 4) {
#pragma unroll 1
            for (int sc = 0; sc < 2; ++sc) {
                if (sc * 16 < nval) {
                    const bf16_t* ar = o_at + (sc * 16 + fr) * SC_LT;
                    const bf16_t* rr_ = o_rt + (sc * 16 + fr) * SC_LT;
                    const bf16_t* br = o_bt + (sc * 16 + fr) * SC_LT;
                    const bf16_t* kr_ = o_kt + (sc * 16 + fr) * SC_LT;
                    const bf16x8 fa0 = *(const bf16x8*)(ar + fq * 8), fa1 = *(const bf16x8*)(ar + 32 + fq * 8);
                    const bf16x8 fb0 = *(const bf16x8*)(br + fq * 8), fb1 = *(const bf16x8*)(br + 32 + fq * 8);
                    const bf16x8 fk0 = *(const bf16x8*)(kr_ + fq * 8), fk1 = *(const bf16x8*)(kr_ + 32 + fq * 8);
                    const bf16x8 fr0 = *(const bf16x8*)(rr_ + fq * 8), fr1 = *(const bf16x8*)(rr_ + 32 + fq * 8);
                    f32x4 nA = MF32(fb0, fa0, z4); nA = MF32(fb1, fa1, nA);
                    f32x4 nB = MF32(fa0, fb0, z4); nB = MF32(fa1, fb1, nB);
                    f32x4 mak = MF32(fk0, fa0, z4); mak = MF32(fk1, fa1, mak);
                    f32x4 mbr = MF32(fb0, fr0, z4); mbr = MF32(fb1, fr1, mbr);
                    f32x4 mkr = MF32(fk0, fr0, z4); mkr = MF32(fk1, fr1, mkr);
#pragma unroll
                    for (int j = 0; j < 4; ++j) {
                        const int s_ = fq * 4 + j;
                        nA[j] = (s_ < fr) ? nA[j] : 0.f; nB[j] = (fr < s_) ? nB[j] : 0.f; mak[j] = (s_ < fr) ? mak[j] : 0.f;
                        mbr[j] = (s_ <= fr) ? mbr[j] : 0.f; mkr[j] = (s_ <= fr) ? mkr[j] : 0.f;
                    }
                    const sh4 pNA = pk4v(nA), pNB = pk4v(nB), pMak = pk4v(mak), pMbr = pk4v(mbr), pMkr = pk4v(mkr);
                    const f32x4 n2B = MF16(pNA, pNB, z4), n2A = MF16(pNB, pNA, z4);
                    const sh4 pN2A = pk4v(n2A), pN2B = pk4v(n2B);
                    const f32x4 n4B = MF16(pN2A, pN2B, z4), n4A = MF16(pN2B, pN2A, z4);
                    const sh4 pN4A = pk4v(n4A), pN4B = pk4v(n4B);
                    const sh4 pN8A = pk4v(MF16(pN4B, pN4A, z4));
                    const bf16x8 sB0 = cat8(pk4v(S[0]), pk4v(S[1])), sB1 = cat8(pk4v(S[2]), pk4v(S[3]));
                    const sh4 vf = *(const sh4*)(o_vT + (wid * 16 + fr) * SC_LS + sc * 16 + fq * 4);
                    f32x4 X = MF32(cat8(*(const sh4*)(ar + fq * 4), *(const sh4*)(ar + 16 + fq * 4)), sB0, z4);
                    X = MF32(cat8(*(const sh4*)(ar + 32 + fq * 4), *(const sh4*)(ar + 48 + fq * 4)), sB1, X);
                    X = MF16(pMak, vf, X);
                    X = MF16(pN8A, pk4v(X), X); X = MF16(pN4A, pk4v(X), X); X = MF16(pN2A, pk4v(X), X); X = MF16(pNA, pk4v(X), X);
                    const sh4 pSA = pk4v(X);
                    f32x4 O = MF32(cat8(*(const sh4*)(rr_ + fq * 4), *(const sh4*)(rr_ + 16 + fq * 4)), sB0, z4);
                    O = MF32(cat8(*(const sh4*)(rr_ + 32 + fq * 4), *(const sh4*)(rr_ + 48 + fq * 4)), sB1, O);
                    const bf16x8 sav = cat8(pSA, vf);
                    O = MF32(cat8(pMbr, pMkr), sav, O);
#pragma unroll
                    for (int j = 0; j < 4; ++j) s_o[(sc * 16 + fq * 4 + j) * 64 + wid * 16 + fr] = O[j];
#pragma unroll
                    for (int jt = 0; jt < 4; ++jt) {
                        const sh4 ka = *(const sh4*)(o_kT + (jt * 16 + fr) * SC_LS + sc * 16 + fq * 4), ba = *(const sh4*)(o_bT + (jt * 16 + fr) * SC_LS + sc * 16 + fq * 4);
                        f32x4 acc = MF32(cat8(ba, ka), sav, S[jt]);
                        const float4 g4 = *(const float4*)(s_gc + sc * 64 + jt * 16 + fq * 4);
                        acc[0] *= g4.x; acc[1] *= g4.y; acc[2] *= g4.z; acc[3] *= g4.w;
                        S[jt] = acc;
                    }
                }
            }
        }
        lds_barrier();
        {
            const int tau = tid >> 4, c4 = (tid & 15) * 4, e = tau * 64 + c4;
            const size_t n = (size_t)b * TS + t0 + tau;
            const float4 o4 = *(const float4*)(s_o + e), v4_ = *(const float4*)(s_v + e), g4_ = *(const float4*)(s_g + e);
            const float4 clw = *(const float4*)(cst + 800 + c4), clb = *(const float4*)(cst + 864 + c4);
            const float bsum = s_bs[tau];
            const float m_ = row16_sum((o4.x + o4.y) + (o4.z + o4.w)) * (1.0f / 64.0f);
            const float d0 = o4.x - m_, d1 = o4.y - m_, d2 = o4.z - m_, d3 = o4.w - m_;
            const float var = row16_sum(d0 * d0 + d1 * d1 + d2 * d2 + d3 * d3) * (1.0f / 64.0f);
            const float rs = rsqrtf(var + 64e-5f);
            const float y0 = (d0 * rs * clw.x + clb.x + bsum * v4_.x) * g4_.x, y1 = (d1 * rs * clw.y + clb.y + bsum * v4_.y) * g4_.y;
            const float y2 = (d2 * rs * clw.z + clb.z + bsum * v4_.z) * g4_.z, y3 = (d3 * rs * clw.w + clb.w + bsum * v4_.w) * g4_.w;
            if (tau < nval) *(uint2*)(Pr + n * 1024 + hc + c4) = pack4(y0, y1, y2, y3);
        }
    }
}

__device__ __forceinline__ void xcd_panel_map(int& mt0, int& mstep, int& nt) {
    const int b = obid(), G = (int)gridDim.x;
    if (G == 256) { nt = (b >> 3) & 7; mt0 = (b & 7) * 4 + (b >> 6); mstep = 32; }
    else { nt = b & 7; mt0 = b >> 3; mstep = G >> 3; }
}
__device__ void phase_merge(const Params& p, unsigned char* lds) {
    const int tid = otid(), lane = tid & 63, wid = tid >> 6, wr = wid >> 1, wc = wid & 1, fr = lane & 15, fq = lane >> 4;
    const bf16_t* h = (const bf16_t*)(WS(p) + OFF_H);
    const bf16_t* wb = (const bf16_t*)(WS(p) + OFF_WB);
    const float* rstd = (const float*)(WS(p) + OFF_RSTD);
    bf16_t* merged = (bf16_t*)(WS(p) + OFF_MERGED);
    const bf16_t* ysrc0 = (const bf16_t*)(WS(p) + OFF_PPOOL);
    const bf16_t* ysrc1 = (const bf16_t*)(WS(p) + OFF_PR);
    const bf16_t* ysrc2 = (const bf16_t*)(OUTB(p) + DO_YC);
    for (int tile = obid(); tile < 86 * 8; tile += gridDim.x) {
        const int mt = tile >> 3, nt = tile & 7;
        const int row0 = mt * 192, col0 = nt * 128;
        uint2 maccp[3][4];
#pragma unroll
        for (int m = 0; m < 3; ++m)
#pragma unroll
            for (int n = 0; n < 4; ++n) maccp[m][n] = make_uint2(0u, 0u);
#pragma unroll 1
        for (int i = 0; i < 3; ++i) {
            const int tid = otid();
            const bf16_t* ys = (i == 0) ? ysrc0 : (i == 1 ? ysrc1 : ysrc2);
            uint2 sg[3][4];
            {
                f32x4 ag[3][4]; g3_zero<3>(ag);
                G3<192> g;
                g3_setup<192>(g, [&](int r) { return h + (size_t)(row0 + r) * DM; }, [&](int r) { return wb + WB_WG + (size_t)(i * 1024 + col0 + r) * DM; }, tid);
                g3_kloop<192>(ag, g, DM, lds);
#pragma unroll
                for (int m = 0; m < 3; ++m) {
                    const float rs = rstd[row0 + wr * 48 + m * 16 + fr];
#pragma unroll
                    for (int n = 0; n < 4; ++n) sg[m][n] = pack4(fast_sigmoid(ag[m][n][0] * rs), fast_sigmoid(ag[m][n][1] * rs), fast_sigmoid(ag[m][n][2] * rs), fast_sigmoid(ag[m][n][3] * rs));
                }
            }
            {
                f32x4 ay[3][4]; g3_zero<3>(ay);
                G3<192> g;
                g3_setup<192>(g, [&](int r) { return ys + (size_t)(row0 + r) * DM; }, [&](int r) { return wb + WB_PA + (size_t)(i * 1024 + col0 + r) * DM; }, tid);
                g3_kloop<192>(ay, g, DM, lds);
#pragma unroll
                for (int m = 0; m < 3; ++m)
#pragma unroll
                    for (int n = 0; n < 4; ++n) {
                        const float m0 = __uint_as_float(maccp[m][n].x << 16) + __uint_as_float(sg[m][n].x << 16) * ay[m][n][0];
                        const float m1 = __uint_as_float(maccp[m][n].x & 0xFFFF0000u) + __uint_as_float(sg[m][n].x & 0xFFFF0000u) * ay[m][n][1];
                        const float m2 = __uint_as_float(maccp[m][n].y << 16) + __uint_as_float(sg[m][n].y << 16) * ay[m][n][2];
                        const float m3 = __uint_as_float(maccp[m][n].y & 0xFFFF0000u) + __uint_as_float(sg[m][n].y & 0xFFFF0000u) * ay[m][n][3];
                        maccp[m][n] = pack4(m0, m1, m2, m3);
                    }
            }
        }
#pragma unroll
        for (int m = 0; m < 3; ++m) {
            const int row = row0 + wr * 48 + m * 16 + fr;
#pragma unroll
            for (int n = 0; n < 4; ++n)
                *(uint2*)(merged + (size_t)row * 1024 + col0 + wc * 64 + n * 16 + fq * 4) = maccp[m][n];
        }
    }
}

__device__ void phase_outproj(const Params& p, unsigned char* lds) {
    const int tid = otid(), lane = tid & 63, wid = tid >> 6, wr = wid >> 1, wc = wid & 1, fr = lane & 15, fq = lane >> 4;
    const bf16_t* h = (const bf16_t*)(WS(p) + OFF_H);
    const bf16_t* wb = (const bf16_t*)(WS(p) + OFF_WB);
    const bf16_t* merged = (const bf16_t*)(WS(p) + OFF_MERGED);
    float* hm = (float*)(WS(p) + OFF_HM32);
    int mt0, mstep, nt;
    xcd_panel_map(mt0, mstep, nt);
    for (int mt = mt0; mt < 86; mt += mstep) {
        const int row0 = mt * 192, col0 = nt * 128;
        G3<192> g;
        g3_setup<192>(g, [&](int r) { return merged + (size_t)(row0 + r) * DM; }, [&](int r) { return wb + WB_WO + (size_t)(col0 + r) * DM; }, tid);
        f32x4 acc[3][4]; g3_zero<3>(acc);
        g3_kloop<192>(acc, g, DM, lds);
#pragma unroll
        for (int m = 0; m < 3; ++m) {
            const int row = row0 + wr * 48 + m * 16 + fr;
#pragma unroll
            for (int n = 0; n < 4; ++n) {
                const int col = col0 + wc * 64 + n * 16 + fq * 4;
                const uint2 hv = *(const uint2*)(h + (size_t)row * 1024 + col);
                float4 o;
                o.x = __uint_as_float(hv.x << 16) + acc[m][n][0]; o.y = __uint_as_float(hv.x & 0xFFFF0000u) + acc[m][n][1];
                o.z = __uint_as_float(hv.y << 16) + acc[m][n][2]; o.w = __uint_as_float(hv.y & 0xFFFF0000u) + acc[m][n][3];
                *(float4*)(hm + (size_t)row * 1024 + col) = o;
            }
        }
    }
}

__device__ __constant__ int c_pair_lo[6] = {0, 0, 0, 1, 1, 2};
__device__ __constant__ int c_pair_hi[6] = {1, 2, 3, 2, 3, 3};
__device__ void phase_route(const Params& p, int l, unsigned char* lds) {
    const int tid = otid(), lane = tid & 63, wid = tid >> 6;
    const int per = (NT + (int)gridDim.x - 1) / (int)gridDim.x;
    const int nbeg = obid() * per, nend = (nbeg + per < NT) ? nbeg + per : NT;
    int* s_cls = (int*)lds;
    int* s_base = s_cls + 512;
    float* s_wr = (float*)(lds + 4096);
    const float* hm = (const float*)(WS(p) + OFF_HM32);
    bf16_t* hn = (bf16_t*)(WS(p) + OFF_HN);
    const float* nf = p.in[33] + (size_t)l * 1024;
    const float* wg = p.in[34] + (size_t)l * 1024 * 4;
    const float* bg = p.in[35] + l * 4;
    const float* we = p.in[36] + (size_t)l * 1024 * 16;
    const float* be = p.in[37] + l * 16;
    int* cnt = (int*)(WS(p) + OFF_CTL);
    int* list = (int*)(WS(p) + OFF_LIST);
    float* pw = (float*)(WS(p) + OFF_PW);
    for (int e = tid; e < 1024 * 20; e += NTHR) {
        const int k = e / 20, c = e - k * 20;
        s_wr[c * 1024 + k] = (c < 4) ? wg[(size_t)k * 4 + c] : we[(size_t)k * 16 + (c - 4)];
    }
    __syncthreads();
    float4 nv[4], cur[4];
#pragma unroll
    for (int i = 0; i < 4; ++i) nv[i] = *(const float4*)(nf + i * 256 + lane * 4);
    if (nbeg + wid < nend) {
#pragma unroll
        for (int i = 0; i < 4; ++i) cur[i] = *(const float4*)(hm + (size_t)(nbeg + wid) * DM + i * 256 + lane * 4);
    }
    for (int n = nbeg + wid; n < nend; n += 8) {
        float4 xv[4]; float ss = 0.f;
#pragma unroll
        for (int i = 0; i < 4; ++i) { xv[i] = cur[i]; ss += xv[i].x * xv[i].x + xv[i].y * xv[i].y + xv[i].z * xv[i].z + xv[i].w * xv[i].w; }
        if (n + 8 < nend) {
#pragma unroll
            for (int i = 0; i < 4; ++i) cur[i] = *(const float4*)(hm + (size_t)(n + 8) * DM + i * 256 + lane * 4);
        }
        ss = wave_sum(ss);
        const float rs = rsqrtf(ss * (1.0f / 1024.0f) + 1e-6f);
        float lg[4] = {0.f, 0.f, 0.f, 0.f};
        float le[16];
#pragma unroll
        for (int e = 0; e < 16; ++e) le[e] = 0.f;
#pragma unroll
        for (int i = 0; i < 4; ++i) {
            float y[4] = {xv[i].x * rs * nv[i].x, xv[i].y * rs * nv[i].y, xv[i].z * rs * nv[i].z, xv[i].w * rs * nv[i].w};
            {
                const int d0 = i * 256 + lane * 4;
#pragma unroll
                for (int g = 0; g < 4; ++g) { const float4 w4 = *(const float4*)(s_wr + g * 1024 + d0); lg[g] += y[0] * w4.x + y[1] * w4.y + y[2] * w4.z + y[3] * w4.w; }
#pragma unroll
                for (int e = 0; e < 16; ++e) { const float4 w4 = *(const float4*)(s_wr + (4 + e) * 1024 + d0); le[e] += y[0] * w4.x + y[1] * w4.y + y[2] * w4.z + y[3] * w4.w; }
            }
            *(uint2*)(hn + (size_t)n * DM + i * 256 + lane * 4) = pack4(y[0], y[1], y[2], y[3]);
        }
#pragma unroll
        for (int g = 0; g < 4; ++g) lg[g] = wave_sum_fast(lg[g]) + bg[g];
#pragma unroll
        for (int e = 0; e < 16; ++e) le[e] = wave_sum_fast(le[e]) + be[e];
        if (lane == 0) {
            int gs = 0; float gm = lg[0];
#pragma unroll
            for (int g = 1; g < 4; ++g) if (lg[g] > gm) { gm = lg[g]; gs = g; }
            float den = 0.f;
#pragma unroll
            for (int g = 0; g < 4; ++g) den += __expf(lg[g] - gm);
            const float pgrp = 1.0f / den;
            float v4[4];
#pragma unroll
            for (int e = 0; e < 4; ++e) {
                const float m0 = (gs == 0) ? 1.f : 0.f, m1s = (gs == 1) ? 1.f : 0.f, m2s = (gs == 2) ? 1.f : 0.f, m3s = (gs == 3) ? 1.f : 0.f;
                v4[e] = le[e] * m0 + le[4 + e] * m1s + le[8 + e] * m2s + le[12 + e] * m3s;
            }
            int i1 = 0; float m1 = v4[0];
#pragma unroll
            for (int e = 1; e < 4; ++e) if (v4[e] > m1) { m1 = v4[e]; i1 = e; }
            int i2 = -1; float m2 = -INFINITY;
#pragma unroll
            for (int e = 0; e < 4; ++e) if (e != i1 && v4[e] > m2) { m2 = v4[e]; i2 = e; }
            const float e2 = __expf(m2 - m1);
            const float p1 = pgrp / (1.0f + e2), p2 = pgrp * e2 / (1.0f + e2);
            const int lo = i1 < i2 ? i1 : i2, hi = i1 < i2 ? i2 : i1;
            const float plo = i1 < i2 ? p1 : p2, phi = i1 < i2 ? p2 : p1;
            const int pi = (lo == 0) ? (hi - 1) : (lo == 1 ? hi + 1 : 5);
            const int cls = gs * 6 + pi;
            s_cls[n - nbeg] = cls;
            pw[(size_t)n * 2 + 0] = plo; pw[(size_t)n * 2 + 1] = phi;
        }
    }
    __syncthreads();
    const int nloc = nend - nbeg;
    if (tid < 24) {
        int c_ = 0;
        for (int i = 0; i < nloc; ++i) c_ += (s_cls[i] == tid) ? 1 : 0;
        s_base[tid] = c_ ? atomicAdd(&cnt[tid * 32], c_) : 0;
    }
    __syncthreads();
    for (int it = tid; it < nloc; it += NTHR) {
        const int cls = s_cls[it];
        int rank = 0;
        for (int i = 0; i < it; ++i) rank += (s_cls[i] == cls) ? 1 : 0;
        list[(size_t)cls * NT + s_base[cls] + rank] = nbeg + it;
    }
    __syncthreads();
}


struct MoeTile { int cls, ti, cnt, tg; };
__device__ __forceinline__ int moe_total_tiles(const int* cnt) { int s = 0; for (int c = 0; c < 24; ++c) s += (cnt[c * 32] + 127) >> 7; return s; }
__device__ __forceinline__ MoeTile moe_find(const int* cnt, int tile) {
    MoeTile r; int s = 0; r.cls = 0; r.ti = 0; r.cnt = 0; r.tg = tile;
    for (int c = 0; c < 24; ++c) { const int nt = (cnt[c * 32] + 127) >> 7; if (tile >= s && tile < s + nt) { r.cls = c; r.ti = tile - s; r.cnt = cnt[c * 32]; } s += nt; }
    return r;
}
__device__ void phase_moe1(const Params& p, unsigned char* lds) {
    const int tid = otid(), lane = tid & 63, wid = tid >> 6, wr = wid >> 1, wc = wid & 1, fr = lane & 15, fq = lane >> 4;
    const int* cnt = (const int*)(WS(p) + OFF_CTL);
    const int* list = (const int*)(WS(p) + OFF_LIST);
    const float* pw = (const float*)(WS(p) + OFF_PW);
    const bf16_t* hn = (const bf16_t*)(WS(p) + OFF_HN);
    const bf16_t* we = (const bf16_t*)(WS(p) + OFF_WEXP);
    bf16_t* hid = (bf16_t*)(OUTB(p) + DO_HID);
    const int total = moe_total_tiles(cnt);
    for (int item = obid(); item < total * 4; item += gridDim.x) {
        const MoeTile mt = moe_find(cnt, item >> 2);
        const int nt = item & 3, slot = nt >> 1, f0 = (nt & 1) * 128;
        const int g_ = mt.cls / 6, pi = mt.cls % 6;
        const int e = g_ * 4 + (slot == 0 ? c_pair_lo[pi] : c_pair_hi[pi]);
        const int* lst = list + (size_t)mt.cls * NT + mt.ti * 128;
        const int nvalid = min(128, mt.cnt - mt.ti * 128);
        f32x4 a1[2][4], a3[2][4]; g3_zero<2>(a1); g3_zero<2>(a3);
        G3D g;
#pragma unroll
        for (int i = 0; i < 2; ++i) {
            const int idx = tid + i * NTHR, row = idx >> 3, sl = (idx & 7) ^ (row & 7);
            g.ap[i] = hn + (size_t)lst[row < nvalid ? row : 0] * DM + sl * 8;
            g.b1[i] = we + WE_W1 + ((size_t)e * 256 + f0 + row) * 1024 + sl * 8;
            g.b3[i] = we + WE_W3 + ((size_t)e * 256 + f0 + row) * 1024 + sl * 8;
        }
        g3d_kloop(a1, a3, g, DM, lds);
#pragma unroll
        for (int m = 0; m < 2; ++m) {
            const int lr = wr * 32 + m * 16 + fr;
            const int tk = lst[lr < nvalid ? lr : 0];
            const float pe = pw[(size_t)tk * 2 + slot];
#pragma unroll
            for (int n = 0; n < 4; ++n) {
                const int col = slot * 256 + f0 + wc * 64 + n * 16 + fq * 4;
                float o[4];
#pragma unroll
                for (int j = 0; j < 4; ++j) { const float x1 = a1[m][n][j]; o[j] = x1 * sigmoidf_(x1) * a3[m][n][j] * pe; }
                *(uint2*)(hid + ((size_t)mt.tg * 128 + lr) * 512 + col) = pack4(o[0], o[1], o[2], o[3]);
            }
        }
    }
}
__device__ void phase_moe2(const Params& p, unsigned char* lds) {
    const int tid = otid(), lane = tid & 63, wid = tid >> 6, wr = wid >> 1, wc = wid & 1, fr = lane & 15, fq = lane >> 4;
    const int* cnt = (const int*)(WS(p) + OFF_CTL);
    const int* list = (const int*)(WS(p) + OFF_LIST);
    const bf16_t* we = (const bf16_t*)(WS(p) + OFF_WEXP);
    const bf16_t* hid = (const bf16_t*)(OUTB(p) + DO_HID);
    float* hm = (float*)(WS(p) + OFF_HM32);
    bf16_t* h = (bf16_t*)(WS(p) + OFF_H);
    const int total = moe_total_tiles(cnt);
    for (int item = obid(); item < total * 8; item += gridDim.x) {
        const MoeTile mt = moe_find(cnt, item >> 3);
        const int nt = item & 7, col0 = nt * 128;
        const int g_ = mt.cls / 6, pi = mt.cls % 6;
        const int elo = g_ * 4 + c_pair_lo[pi], ehi = g_ * 4 + c_pair_hi[pi];
        const int* lst = list + (size_t)mt.cls * NT + mt.ti * 128;
        const int nvalid = min(128, mt.cnt - mt.ti * 128);
        f32x4 acc[2][4]; g3_zero<2>(acc);
        G3<128> g;
        g3_setup<128>(g, [&](int r) { return hid + ((size_t)mt.tg * 128 + r) * 512; }, [&](int r) { return we + WE_W2 + ((size_t)elo * 1024 + col0 + r) * 256; }, tid);
        g3_kloop<128>(acc, g, 256, lds);
        g3_setup<128>(g, [&](int r) { return hid + ((size_t)mt.tg * 128 + r) * 512 + 256; }, [&](int r) { return we + WE_W2 + ((size_t)ehi * 1024 + col0 + r) * 256; }, tid);
        g3_kloop<128>(acc, g, 256, lds);
#pragma unroll
        for (int m = 0; m < 2; ++m) {
            const int lr = wr * 32 + m * 16 + fr;
            if (lr < nvalid) {
                const int tk = lst[lr];
#pragma unroll
                for (int n = 0; n < 4; ++n) {
                    const int col = col0 + wc * 64 + n * 16 + fq * 4;
                    float4 v = *(const float4*)(hm + (size_t)tk * 1024 + col);
                    v.x += acc[m][n][0]; v.y += acc[m][n][1]; v.z += acc[m][n][2]; v.w += acc[m][n][3];
                    *(float4*)(hm + (size_t)tk * 1024 + col) = v;
                    *(uint2*)(h + (size_t)tk * 1024 + col) = pack4(v.x, v.y, v.z, v.w);
                }
            }
        }
    }
}

__device__ void phase_final(const Params& p) {
    const int lane = otid() & 63;
    const int wave = (obid() * NTHR + otid()) >> 6, nw = gridDim.x * NTHR / 64;
    const float* hm = (const float*)(WS(p) + OFF_HM32);
    const float* nf = p.in[41];
    float4 g[4], cur[4];
#pragma unroll
    for (int i = 0; i < 4; ++i) g[i] = *(const float4*)(nf + i * 256 + lane * 4);
    auto rowp = [&](int r) { const int b = r / SEQ, s_ = r % SEQ; return hm + ((size_t)b * TS + NMETA + s_) * DM; };
    if (wave < NB * SEQ) {
        const float* src = rowp(wave);
#pragma unroll
        for (int i = 0; i < 4; ++i) cur[i] = *(const float4*)(src + i * 256 + lane * 4);
    }
    for (int r = wave; r < NB * SEQ; r += nw) {
        float4 v[4]; float ss = 0.f;
#pragma unroll
        for (int i = 0; i < 4; ++i) { v[i] = cur[i]; ss += v[i].x * v[i].x + v[i].y * v[i].y + v[i].z * v[i].z + v[i].w * v[i].w; }
        if (r + nw < NB * SEQ) {
            const float* src = rowp(r + nw);
#pragma unroll
            for (int i = 0; i < 4; ++i) cur[i] = *(const float4*)(src + i * 256 + lane * 4);
        }
        ss = wave_sum(ss);
        const float rs = rsqrtf(ss * (1.0f / 1024.0f) + 1e-6f);
#pragma unroll
        for (int i = 0; i < 4; ++i) {
            float4 o; o.x = v[i].x * rs * g[i].x; o.y = v[i].y * rs * g[i].y; o.z = v[i].z * rs * g[i].z; o.w = v[i].w * rs * g[i].w;
            *(float4*)((float*)OUTB(p) + (size_t)r * DM + i * 256 + lane * 4) = o;
        }
    }
}


#define XB_TMO      128
#define XB_XCNT(j)  (256  + 64 * (j))
#define XB_XSUB(j)  (1280 + 64 * (j))
#define XB_XGEN(j)  (2304 + 64 * (j))
#define XB_TOP      3328
#define XB_TOPGEN   3392
#define XCD_BAR_WORDS 3456
#define XB_SPIN_CAP (1u << 22)
#define LAS __attribute__((address_space(3)))
__device__ __forceinline__ unsigned xb_ld(unsigned* p) { return __hip_atomic_load(p, __ATOMIC_RELAXED, __HIP_MEMORY_SCOPE_AGENT); }
__device__ __forceinline__ unsigned xb_add(unsigned* p, unsigned v) { return __hip_atomic_fetch_add(p, v, __ATOMIC_RELAXED, __HIP_MEMORY_SCOPE_AGENT); }
__device__ __forceinline__ unsigned xb_xcc_id() { return (unsigned)__builtin_amdgcn_s_getreg((3 << 11) | 20) & 0xFu; }
#define XB_SPIN(cond, bar) do { unsigned _sp = 0; while (cond) { __builtin_amdgcn_s_sleep(1); \
    if ((++_sp & 255u) == 0u) { if (xb_ld(&(bar)[XB_TMO])) break; if (_sp > XB_SPIN_CAP) { atomicAdd(&(bar)[XB_TMO], 1u); break; } } } } while (0)
struct XcdBarrier { unsigned* bar; unsigned x; volatile LAS unsigned* st; };
__device__ __forceinline__ XcdBarrier xcd_barrier_post(unsigned* bar, volatile LAS unsigned* st) {
    XcdBarrier b; b.bar = bar; b.x = xb_xcc_id(); b.st = st;
    if (threadIdx.x == 0) (void)xb_add(&bar[XB_XCNT(b.x)], 1u);
    return b;
}
__device__ __forceinline__ void xcd_barrier_complete(unsigned* bar, unsigned x, unsigned& nloc, unsigned& nx) {
    const unsigned G = gridDim.x * gridDim.y * gridDim.z;
    unsigned sum, cnt, mine, sp = 0u;
    for (;;) {
        sum = 0u; cnt = 0u; mine = 0u;
#pragma unroll
        for (unsigned j = 0; j < 16; ++j) { const unsigned c = xb_ld(&bar[XB_XCNT(j)]); sum += c; cnt += (c > 0u) ? 1u : 0u; mine = (j == x) ? c : mine; }
        if (sum == G) break;
        __builtin_amdgcn_s_sleep(1);
        if ((++sp & 255u) == 0u) { if (xb_ld(&bar[XB_TMO])) break; if (sp > XB_SPIN_CAP) { atomicAdd(&bar[XB_TMO], 1u); break; } }
    }
    nloc = mine > 0u ? mine : 1u; nx = cnt > 0u ? cnt : 1u;
}
__device__ __forceinline__ void xcd_barrier(const XcdBarrier& b) {
    asm volatile("s_waitcnt vmcnt(0)" ::: "memory");
    __syncthreads();
    if (threadIdx.x == 0) {
        unsigned* bar = b.bar;
        __builtin_amdgcn_s_waitcnt(0);
        unsigned nloc = b.st[0], nx = b.st[1];
        if (nloc == 0u) { xcd_barrier_complete(bar, b.x, nloc, nx); b.st[0] = nloc; b.st[1] = nx; }
        const unsigned old = xb_add(&bar[XB_XSUB(b.x)], 1u);
        const unsigned gen = old / nloc;
        if (old + 1u == (gen + 1u) * nloc) {
            __builtin_amdgcn_fence(__ATOMIC_RELEASE, "agent");
            asm volatile("s_waitcnt vmcnt(0)" ::: "memory");
            const unsigned og = xb_add(&bar[XB_TOP], 1u);
            const unsigned tg = og / nx;
            if (og + 1u == (tg + 1u) * nx) xb_add(&bar[XB_TOPGEN], 1u);
            else XB_SPIN(xb_ld(&bar[XB_TOPGEN]) == tg, bar);
            __builtin_amdgcn_fence(__ATOMIC_ACQUIRE, "agent");
            xb_add(&bar[XB_XGEN(b.x)], 1u);
            asm volatile("s_waitcnt vmcnt(0)" ::: "memory");
        } else {
            XB_SPIN(xb_ld(&bar[XB_XGEN(b.x)]) == gen, bar);
            __builtin_amdgcn_fence(__ATOMIC_ACQUIRE, "agent");
            asm volatile("s_waitcnt vmcnt(0)" ::: "memory");
        }
    }
    __syncthreads();
}

__global__ void __launch_bounds__(NTHR) fwd_megakernel(Params p) {
    extern __shared__ __attribute__((aligned(16))) unsigned char lds[];
    cg::grid_group grid = cg::this_grid();
    volatile LAS unsigned* xst = (volatile LAS unsigned*)(lds + LDS_BYTES - 32);
    if (threadIdx.x < 2) xst[threadIdx.x] = 0u;
    __syncthreads();
    const XcdBarrier xb = xcd_barrier_post((unsigned*)(p.ws + OFF_BAR), xst);
    if (p.out == nullptr) grid.sync();
#pragma unroll 1
    for (int step = 0; step < 18; ++step) {
        const int l = step >= 9 ? 1 : 0;
        const int ph = step - l * 9;
        switch (ph) {
        case 0:
            if (l == 0) phase_embed(p); else phase_rowstat(p);
            phase_convert<false>(p, l, lds);
            if (obid() == 0 && otid() < 24) ((int*)(WS(p) + OFF_CTL))[otid() * 32] = 0;
            if (obid() == 0 && otid() == 32) ((int*)(WS(p) + OFF_CTL))[800 + l * 32] = 0;
            break;
        case 1: phase_inproj(p, lds); break;
        case 2: phase_dsa_prep(p, l); phase_lr_prep(p, l); break;
        case 3: {
            if (obid() < NB * 16) phase_scan5(p, l, lds, obid());
            int* qctr = (int*)(WS(p) + OFF_CTL) + 800 + l * 32;
            int* qslot = (int*)(lds + LDS_BYTES - 16);
            for (;;) {
                __syncthreads();
                if (otid() == 0) *qslot = atomicAdd(qctr, 1);
                __syncthreads();
                const int item = *qslot;
                if (item >= 516 + NT / 32 + 3072) break;
                if (item < 516) phase_pool(p, l, lds, item, item + 1, 1);
                else if (item < 516 + NT / 32) phase_dsa<false>(p, l, lds, (bf16_t*)(OUTB(p) + DO_YC), nullptr, nullptr, item - 516, item - 515, 1);
                else {
                    const int ct = item - (516 + NT / 32);
                    const ConvJob cj = get_job_late(p, l, ct >> 10);
                    conv_tile(cj, ct & 1023, (float*)lds);
                }
            }
        } break;
        case 4: phase_merge(p, lds); break;
        case 5: phase_outproj(p, lds); break;
        case 6: phase_route(p, l, lds); break;
        case 7: phase_moe1(p, lds); break;
        default: phase_moe2(p, lds); break;
        }
        xcd_barrier(xb);
    }
    phase_final(p);
}

extern "C" void kernel_launch(void* const* d_in, const int* in_sizes, int n_in,
                              void* d_out, int out_size, void* d_ws, size_t ws_size,
                              hipStream_t stream) {
    static int grid_blocks = 0;
    if (grid_blocks == 0) {
        int dev = 0, cus = 0, per_cu = 0;
        (void)hipGetDevice(&dev);
        (void)hipDeviceGetAttribute(&cus, hipDeviceAttributeMultiprocessorCount, dev);
        (void)hipFuncSetAttribute((const void*)fwd_megakernel, hipFuncAttributeMaxDynamicSharedMemorySize, LDS_BYTES);
        (void)hipOccupancyMaxActiveBlocksPerMultiprocessor(&per_cu, fwd_megakernel, NTHR, LDS_BYTES);
        if (per_cu < 1 || cus < NB * 16 || (cus & 7) != 0 || n_in != 42 || ws_size < WS_END + (size_t)QS_WS * QS_BYTES || cus > QS_WS + QS_DO) { fprintf(stderr, "kernel_launch: bad config per_cu=%d n_in=%d ws=%zu need=%zu\n", per_cu, n_in, ws_size, (size_t)WS_END); grid_blocks = -1; }
        else grid_blocks = cus;
    }
    if (grid_blocks < 0) return;
    Params p{};
    for (int i = 0; i < 42; ++i) p.in[i] = (const float*)d_in[i];
    p.out = (float*)d_out;
    p.ws = (unsigned char*)d_ws;
    (void)hipMemsetAsync((unsigned char*)d_ws + OFF_BAR, 0, XCD_BAR_WORDS * 4, stream);
    void* args[] = {&p};
    hipError_t e = hipLaunchCooperativeKernel((void*)fwd_megakernel, dim3(grid_blocks), dim3(NTHR), args, LDS_BYTES, stream);
    if (e != hipSuccess) fprintf(stderr, "cooperative launch failed: %s (grid %d)\n", hipGetErrorString(e), grid_blocks);
}
```

```cpp
#include <hip/hip_runtime.h>
#include <hip/hip_cooperative_groups.h>
#include <cstdio>
#include <cstdint>
#include <type_traits>
namespace cg = cooperative_groups;

typedef unsigned short bf16_t;
typedef short bf16x8 __attribute__((ext_vector_type(8)));
typedef float f32x4 __attribute__((ext_vector_type(4)));

constexpr int NB = 8, SEQ = 2048, NMETA = 16, TS = 2064, DM = 1024;
constexpr int NT = NB * TS;
constexpr int NTP = 16640;
constexpr int NTHR = 512;
constexpr int CIN = 7912;
constexpr int NP1 = 4864;
constexpr int PM_LD = 768;
constexpr int PM_WD = 0, PM_AD = 64, PM_GD = 128, PM_VD = 256, PM_CQ = 288, PM_CKV = 544, PM_KROPE = 672, PM_KIDX = 704;
constexpr int LDS_BYTES = 157 * 1024;

constexpr size_t AL(size_t x) { return (x + 255) & ~(size_t)255; }
constexpr size_t SZ_ACT = (size_t)NTP * 1024 * 2;
constexpr size_t OFF_CTL = 0;
constexpr size_t OFF_BAR = 4096;
constexpr size_t OFF_RSTD = OFF_BAR + 16384;
constexpr size_t OFF_ROPE = OFF_RSTD + AL((size_t)NTP * 4);
constexpr size_t OFF_H = OFF_ROPE + AL((size_t)TS * 16 * 4 * 2);
constexpr size_t OFF_WB = OFF_H + SZ_ACT;
constexpr size_t WB_WIN = 0;
constexpr size_t WB_WG = WB_WIN + (size_t)NP1 * 1024;
constexpr size_t WB_PA = WB_WG + (size_t)3072 * 1024;
constexpr size_t WB_WO = WB_PA + (size_t)3 * 1024 * 1024;
constexpr size_t WB_POOL = WB_WO + (size_t)1024 * 1024;
constexpr size_t WB_QI = WB_POOL + (size_t)4 * 256 * 256;
constexpr size_t WB_UQ = WB_QI + (size_t)512 * 256;
constexpr size_t WB_UK = WB_UQ + (size_t)1536 * 256;
constexpr size_t WB_UV = WB_UK + (size_t)16 * 128 * 64;
constexpr size_t WB_WIDX = WB_UV + (size_t)16 * 64 * 128;
constexpr size_t WB_END = WB_WIDX + (size_t)64 * 1024;
constexpr size_t OFF_PPOOL = OFF_WB + AL(WB_END * 2);
constexpr size_t OFF_PK = OFF_PPOOL + SZ_ACT;
constexpr size_t OFF_PR = OFF_PK + SZ_ACT;
constexpr size_t OFF_PV = OFF_PR + SZ_ACT;
constexpr size_t OFF_PMISC = OFF_PV + SZ_ACT;
constexpr size_t OFF_VFIRST = OFF_PMISC + AL((size_t)NTP * PM_LD * 2);
constexpr size_t OFF_HALO = OFF_VFIRST + SZ_ACT;
constexpr size_t OFF_LIST = OFF_HALO + AL((size_t)130 * 16 * 1024 * 2);
constexpr size_t OFF_PW = OFF_LIST + AL((size_t)24 * NT * 4);
constexpr size_t WS_END = OFF_PW + AL((size_t)NT * 2 * 4);
constexpr size_t OFF_MERGED = OFF_PK;
constexpr size_t OFF_HM32 = OFF_PR;
constexpr size_t OFF_HN = OFF_PPOOL;
constexpr size_t OFF_WEXP = OFF_PMISC;
constexpr size_t WE_W1 = 0, WE_W3 = (size_t)16 * 256 * 1024, WE_W2 = (size_t)2 * 16 * 256 * 1024;
static_assert((size_t)3 * 16 * 256 * 1024 * 2 <= (size_t)NTP * PM_LD * 2, "expert weights must fit in Pmisc");
constexpr size_t DO_YC = 0;
constexpr size_t DO_CQN = DO_YC + SZ_ACT;
constexpr size_t DO_KV = DO_CQN + AL((size_t)NT * 256 * 2);
constexpr size_t DO_KIDX = DO_KV + AL((size_t)NT * 160 * 2);
constexpr size_t DO_WHEAD = DO_KIDX + AL((size_t)NT * 64 * 2);
constexpr size_t DO_ALR = DO_WHEAD + AL((size_t)NT * 8 * 4);
constexpr size_t DO_END = DO_ALR + AL((size_t)NT * 288 * 2);
constexpr size_t QS_BYTES = (size_t)16 * 16 * 160 * 2;
constexpr int QS_WS = (int)((277240096ull - WS_END) / QS_BYTES), QS_DO = (int)(((size_t)NB * SEQ * DM * 4 - DO_END) / QS_BYTES);
static_assert(QS_WS + QS_DO >= 256, "Q scratch");
constexpr size_t DO_HID = DO_YC;
static_assert(DO_END <= (size_t)NB * SEQ * DM * 4, "d_out scratch overflow");
static_assert((size_t)(129 + 24) * 128 * 512 * 2 <= SZ_ACT, "hid fits");
static_assert(WS_END <= 277240096ull, "workspace overflow");

struct Params {
    const float* in[42];
    float* out;
    unsigned char* ws;
};

__device__ __forceinline__ int otid() { int t = threadIdx.x; asm volatile("" : "+v"(t)); return t; }
__device__ __forceinline__ int obid() { int b = blockIdx.x; asm volatile("" : "+s"(b)); return b; }
typedef __attribute__((address_space(1))) unsigned char gas_uchar;
__device__ __forceinline__ unsigned char* WS(const Params& p) { gas_uchar* w = (gas_uchar*)p.ws; asm volatile("" : "+s"(w)); return (unsigned char*)w; }
__device__ __forceinline__ unsigned char* OUTB(const Params& p) { gas_uchar* w = (gas_uchar*)p.out; asm volatile("" : "+s"(w)); return (unsigned char*)w; }
__device__ __forceinline__ float bf2f(bf16_t v) { return __uint_as_float(((unsigned)v) << 16); }
typedef float f32x2v __attribute__((ext_vector_type(2)));
typedef __bf16 bf16x2v __attribute__((ext_vector_type(2)));
__device__ __forceinline__ unsigned pk2(float a, float b) { const f32x2v v = {a, b}; const bf16x2v r = __builtin_convertvector(v, bf16x2v); unsigned u; __builtin_memcpy(&u, &r, 4); return u; }
__device__ __forceinline__ bf16_t f2bf(float f) { const __bf16 h = (__bf16)f; bf16_t u; __builtin_memcpy(&u, &h, 2); return u; }
__device__ __forceinline__ float wave_sum(float v) {
#pragma unroll
    for (int o = 32; o > 0; o >>= 1) v += __shfl_xor(v, o);
    return v;
}
template <int CTRL> __device__ __forceinline__ float dpp_f(float x) {
    return __int_as_float(__builtin_amdgcn_update_dpp(0, __float_as_int(x), CTRL, 0xF, 0xF, true));
}
__device__ __forceinline__ float row16_sum(float v) {
    v += dpp_f<0xB1>(v);
    v += dpp_f<0x4E>(v);
    v += dpp_f<0x141>(v);
    v += dpp_f<0x140>(v);
    return v;
}
__device__ __forceinline__ void lds_barrier() { asm volatile("s_waitcnt lgkmcnt(0)" ::: "memory"); __builtin_amdgcn_s_barrier(); asm volatile("" ::: "memory"); }
__device__ __forceinline__ float fast_rcp(float x) { return __builtin_amdgcn_rcpf(x); }
__device__ __forceinline__ float fast_sigmoid(float x) { return fast_rcp(1.0f + __expf(-x)); }
__device__ __forceinline__ float fast_tanh(float x) { return 1.0f - 2.0f * fast_rcp(1.0f + __expf(2.0f * x)); }
__device__ __forceinline__ void row16_sum4(float& a, float& b, float& c, float& d) {
    asm volatile(
        "s_nop 1\n\t"
        "v_add_f32_dpp %0, %0, %0 quad_perm:[1,0,3,2] row_mask:0xf bank_mask:0xf\n\t"
        "v_add_f32_dpp %1, %1, %1 quad_perm:[1,0,3,2] row_mask:0xf bank_mask:0xf\n\t"
        "v_add_f32_dpp %2, %2, %2 quad_perm:[1,0,3,2] row_mask:0xf bank_mask:0xf\n\t"
        "v_add_f32_dpp %3, %3, %3 quad_perm:[1,0,3,2] row_mask:0xf bank_mask:0xf\n\t"
        "v_add_f32_dpp %0, %0, %0 quad_perm:[2,3,0,1] row_mask:0xf bank_mask:0xf\n\t"
        "v_add_f32_dpp %1, %1, %1 quad_perm:[2,3,0,1] row_mask:0xf bank_mask:0xf\n\t"
        "v_add_f32_dpp %2, %2, %2 quad_perm:[2,3,0,1] row_mask:0xf bank_mask:0xf\n\t"
        "v_add_f32_dpp %3, %3, %3 quad_perm:[2,3,0,1] row_mask:0xf bank_mask:0xf\n\t"
        "v_add_f32_dpp %0, %0, %0 row_half_mirror row_mask:0xf bank_mask:0xf\n\t"
        "v_add_f32_dpp %1, %1, %1 row_half_mirror row_mask:0xf bank_mask:0xf\n\t"
        "v_add_f32_dpp %2, %2, %2 row_half_mirror row_mask:0xf bank_mask:0xf\n\t"
        "v_add_f32_dpp %3, %3, %3 row_half_mirror row_mask:0xf bank_mask:0xf\n\t"
        "v_add_f32_dpp %0, %0, %0 row_mirror row_mask:0xf bank_mask:0xf\n\t"
        "v_add_f32_dpp %1, %1, %1 row_mirror row_mask:0xf bank_mask:0xf\n\t"
        "v_add_f32_dpp %2, %2, %2 row_mirror row_mask:0xf bank_mask:0xf\n\t"
        "v_add_f32_dpp %3, %3, %3 row_mirror row_mask:0xf bank_mask:0xf\n\t"
        "s_nop 1"
        : "+v"(a), "+v"(b), "+v"(c), "+v"(d));
}
__device__ __forceinline__ void row8_sum2(float& a, float& b) {
    asm volatile(
        "s_nop 1\n\t"
        "v_add_f32_dpp %0, %0, %0 quad_perm:[1,0,3,2] row_mask:0xf bank_mask:0xf\n\t"
        "v_add_f32_dpp %1, %1, %1 quad_perm:[1,0,3,2] row_mask:0xf bank_mask:0xf\n\t"
        "s_nop 0\n\t"
        "v_add_f32_dpp %0, %0, %0 quad_perm:[2,3,0,1] row_mask:0xf bank_mask:0xf\n\t"
        "v_add_f32_dpp %1, %1, %1 quad_perm:[2,3,0,1] row_mask:0xf bank_mask:0xf\n\t"
        "s_nop 0\n\t"
        "v_add_f32_dpp %0, %0, %0 row_half_mirror row_mask:0xf bank_mask:0xf\n\t"
        "v_add_f32_dpp %1, %1, %1 row_half_mirror row_mask:0xf bank_mask:0xf\n\t"
        "s_nop 1"
        : "+v"(a), "+v"(b));
}
__device__ __forceinline__ float wave_sum_fast(float v) { v = row16_sum(v); v += __shfl_xor(v, 16); v += __shfl_xor(v, 32); return v; }
__device__ __forceinline__ float sigmoidf_(float x) { return 1.0f / (1.0f + __expf(-x)); }
__device__ __forceinline__ float softplusf_(float z) { return fmaxf(z, 0.f) + log1pf(__expf(-fabsf(z))); }
__device__ __forceinline__ void glds16(const void* g, void* l) {
    __builtin_amdgcn_global_load_lds((const unsigned*)g, (unsigned*)l, 16, 0, 0);
}

__device__ void phase_embed(const Params& p) {
    const int lane = otid() & 63;
    const int wave = (obid() * NTHR + otid()) >> 6, nw = gridDim.x * NTHR / 64;
    bf16_t* h = (bf16_t*)(WS(p) + OFF_H);
    float* rstd = (float*)(WS(p) + OFF_RSTD);
    auto srcrow = [&](int n) { const int b = n / TS, t = n % TS; return t < NMETA ? p.in[1] + (size_t)t * DM : p.in[0] + ((size_t)b * SEQ + (t - NMETA)) * DM; };
    float4 cur[4];
    if (wave < NT) {
        const float* src = srcrow(wave);
#pragma unroll
        for (int i = 0; i < 4; ++i) cur[i] = *(const float4*)(src + i * 256 + lane * 4);
    }
    for (int n = wave; n < NTP; n += nw) {
        if (n < NT) {
            float4 v[4];
#pragma unroll
            for (int i = 0; i < 4; ++i) v[i] = cur[i];
            if (n + nw < NT) {
                const float* src = srcrow(n + nw);
#pragma unroll
                for (int i = 0; i < 4; ++i) cur[i] = *(const float4*)(src + i * 256 + lane * 4);
            }
            float ss = 0.f;
#pragma unroll
            for (int i = 0; i < 4; ++i) {
                ss += v[i].x * v[i].x + v[i].y * v[i].y + v[i].z * v[i].z + v[i].w * v[i].w;
                *(uint2*)(h + (size_t)n * DM + i * 256 + lane * 4) = make_uint2(pk2(v[i].x, v[i].y), pk2(v[i].z, v[i].w));
            }
            ss = wave_sum(ss);
            if (lane == 0) rstd[n] = rsqrtf(ss * (1.0f / 1024.0f) + 1e-6f);
        } else {
#pragma unroll
            for (int i = 0; i < 4; ++i) *(ushort4*)(h + (size_t)n * DM + i * 256 + lane * 4) = make_ushort4(0, 0, 0, 0);
            if (lane == 0) rstd[n] = 0.f;
        }
    }
    float* ctab = (float*)(WS(p) + OFF_ROPE);
    float* stab = ctab + TS * 16;
    for (int idx = obid() * NTHR + otid(); idx < TS * 16; idx += gridDim.x * NTHR) {
        const int t = idx >> 4, i = idx & 15;
        const float inv = powf(10000.0f, -(float)(2 * i) / 32.0f);
        const float ang = (float)t * inv;
        ctab[idx] = cosf(ang);
        stab[idx] = sinf(ang);
    }
}

__device__ void phase_rowstat(const Params& p) {
    const int lane = otid() & 63;
    const int wave = (obid() * NTHR + otid()) >> 6, nw = gridDim.x * NTHR / 64;
    const bf16_t* hb = (const bf16_t*)(WS(p) + OFF_H);
    float* rstd = (float*)(WS(p) + OFF_RSTD);
    uint4 cur[2];
    if (wave < NT) { cur[0] = *(const uint4*)(hb + (size_t)wave * DM + lane * 8); cur[1] = *(const uint4*)(hb + (size_t)wave * DM + 512 + lane * 8); }
    for (int n = wave; n < NT; n += nw) {
        float ss = 0.f;
#pragma unroll
        for (int i = 0; i < 2; ++i) {
            const unsigned w_[4] = {cur[i].x, cur[i].y, cur[i].z, cur[i].w};
#pragma unroll
            for (int j = 0; j < 4; ++j) { const float a_ = __uint_as_float(w_[j] << 16), b_ = __uint_as_float(w_[j] & 0xFFFF0000u); ss += a_ * a_ + b_ * b_; }
        }
        if (n + nw < NT) { cur[0] = *(const uint4*)(hb + (size_t)(n + nw) * DM + lane * 8); cur[1] = *(const uint4*)(hb + (size_t)(n + nw) * DM + 512 + lane * 8); }
        ss = wave_sum(ss);
        if (lane == 0) rstd[n] = rsqrtf(ss * (1.0f / 1024.0f) + 1e-6f);
    }
}

struct ConvJob { const float* src; bf16_t* dst; const float* scale; int ldsrc, K, nvalid, nrows, nb, notr; size_t sbs, dbs; const float* srcB; int ldB, split; };
__device__ __forceinline__ int conv_job_tiles(const ConvJob& j) { return j.nb * (j.nrows >> 6) * (j.K >> 6); }
__device__ void conv_tile(const ConvJob& j, int tile, float* lds) {
    const int per = (j.nrows >> 6) * (j.K >> 6);
    const int bi = tile / per, rem = tile % per;
    const int ktiles = j.K >> 6;
    const int n0 = (rem / ktiles) << 6, k0 = (rem % ktiles) << 6;
    const int tid = otid(), tn = tid & 63, tk = tid >> 6;
    const float* src = j.src + (size_t)bi * j.sbs;
    bf16_t* dst = j.dst + (size_t)bi * j.dbs;
#pragma unroll
    for (int kk = 0; kk < 8; ++kk) {
        const int k = k0 + tk * 8 + kk;
        float v = 0.f;
        if (n0 + tn < j.nvalid) {
            if (j.split) { const int nn = n0 + tn; v = (nn < j.split) ? (j.src ? j.src[(size_t)k * j.ldsrc + nn] : 0.f) : j.srcB[(size_t)k * j.ldB + (nn - j.split)]; }
            else v = j.notr ? src[(size_t)(n0 + tn) * j.ldsrc + k] : src[(size_t)k * j.ldsrc + n0 + tn];
            if (j.scale) v *= j.scale[k];
        }
        lds[tn * 65 + tk * 8 + kk] = v;
    }
    __syncthreads();
    const int wn = tid >> 3, kq = tid & 7;
    uint4 o;
    unsigned w[4];
#pragma unroll
    for (int q = 0; q < 4; ++q) {
        const float lo = lds[wn * 65 + kq * 8 + 2 * q], hi = lds[wn * 65 + kq * 8 + 2 * q + 1];
        w[q] = pk2(lo, hi);
    }
    o.x = w[0]; o.y = w[1]; o.z = w[2]; o.w = w[3];
    *(uint4*)(dst + (size_t)(n0 + wn) * j.K + k0 + kq * 8) = o;
    __syncthreads();
}
__device__ ConvJob get_job_early(const Params& p, int l, int ji) {
    bf16_t* wb = (bf16_t*)(WS(p) + OFF_WB);
    const float* win = p.in[3] + (size_t)l * DM * CIN;
    const float* nm = p.in[2] + (size_t)l * DM;
    ConvJob j{}; j.nb = 1; j.sbs = 0; j.dbs = 0; j.K = 1024; j.ldsrc = CIN; j.scale = nm;
    switch (ji) {
    case 0: j.src = win + 3072; j.dst = wb + WB_WIN; j.nvalid = 4352; j.nrows = 4352; break;
    case 1: j.src = (l == 0 ? nullptr : p.in[17]); j.ldsrc = 32; j.split = 32; j.srcB = win + 7424; j.ldB = CIN; j.dst = wb + WB_WIN + (size_t)(4096 + PM_VD) * 1024; j.nvalid = 512; j.nrows = 512; break;
    case 2: j.src = win + 7904; j.dst = wb + WB_WIDX; j.nvalid = 8; j.nrows = 64; break;
    case 3: j.src = win; j.dst = wb + WB_WG; j.nvalid = 3072; j.nrows = 3072; break;
    case 4: j.src = p.in[29] + (size_t)l * DM * DM; j.ldsrc = 1024; j.scale = nullptr; j.dst = wb + WB_PA; j.nvalid = 1024; j.nrows = 1024; break;
    case 5: j.src = p.in[30] + (size_t)l * DM * DM; j.ldsrc = 1024; j.scale = nullptr; j.dst = wb + WB_PA + (size_t)1024 * 1024; j.nvalid = 1024; j.nrows = 1024; break;
    case 6: j.src = p.in[31] + (size_t)l * DM * DM; j.ldsrc = 1024; j.scale = nullptr; j.dst = wb + WB_PA + (size_t)2 * 1024 * 1024; j.nvalid = 1024; j.nrows = 1024; break;
    case 7: j.src = p.in[32] + (size_t)l * DM * DM; j.ldsrc = 1024; j.scale = nullptr; j.dst = wb + WB_WO; j.nvalid = 1024; j.nrows = 1024; break;
    case 8: j.src = p.in[5] + (size_t)l * 4 * 256 * 256; j.ldsrc = 256; j.K = 256; j.scale = nullptr; j.dst = wb + WB_POOL; j.nvalid = 256; j.nrows = 256; j.nb = 4; j.sbs = 65536; j.dbs = 65536; break;
    case 9: j.src = p.in[26] + (size_t)l * 256 * 512; j.ldsrc = 512; j.K = 256; j.scale = nullptr; j.dst = wb + WB_QI; j.nvalid = 512; j.nrows = 512; break;
    case 10: j.src = p.in[23] + (size_t)l * 256 * 1536; j.ldsrc = 1536; j.K = 256; j.scale = nullptr; j.dst = wb + WB_UQ; j.nvalid = 1536; j.nrows = 1536; break;
    case 11: j.src = p.in[24] + (size_t)l * 16 * 128 * 64; j.ldsrc = 64; j.K = 64; j.scale = nullptr; j.dst = wb + WB_UK; j.nvalid = 2048; j.nrows = 2048; j.notr = 1; break;
    default: j.src = p.in[25] + (size_t)l * 16 * 128 * 64; j.ldsrc = 64; j.K = 128; j.scale = nullptr; j.dst = wb + WB_UV; j.nvalid = 64; j.nrows = 64; j.nb = 16; j.sbs = 8192; j.dbs = 8192; break;
    }
    return j;
}
__device__ ConvJob get_job_late(const Params& p, int l, int ji) {
    bf16_t* we = (bf16_t*)(WS(p) + OFF_WEXP);
    ConvJob j{}; j.nb = 16; j.scale = nullptr; j.sbs = 262144; j.dbs = 262144;
    switch (ji) {
    case 0: j.src = p.in[38] + (size_t)l * 16 * 262144; j.dst = we + WE_W1; j.ldsrc = 256; j.K = 1024; j.nvalid = 256; j.nrows = 256; break;
    case 1: j.src = p.in[39] + (size_t)l * 16 * 262144; j.dst = we + WE_W3; j.ldsrc = 256; j.K = 1024; j.nvalid = 256; j.nrows = 256; break;
    default: j.src = p.in[40] + (size_t)l * 16 * 262144; j.dst = we + WE_W2; j.ldsrc = 1024; j.K = 256; j.nvalid = 1024; j.nrows = 1024; break;
    }
    return j;
}
template <bool LATE>
__device__ void phase_convert(const Params& p, int l, unsigned char* lds) {
    const int njobs = LATE ? 3 : 13;
    int base = 0;
    for (int ji = 0; ji < njobs; ++ji) {
        const ConvJob j = LATE ? get_job_late(p, l, ji) : get_job_early(p, l, ji);
        const int nt = conv_job_tiles(j);
        int first = ((int)obid() - base) % (int)gridDim.x; if (first < 0) first += gridDim.x;
        for (int t = first; t < nt; t += gridDim.x) conv_tile(j, t, (float*)lds);
        base += nt;
    }
}

template <int BM> struct G3 {
    static constexpr int MI = BM / 64;
    static constexpr int NA = BM / 64;
    static constexpr int STAGE = BM * 128 + 128 * 128;
    const bf16_t* ap[NA];
    const bf16_t* bp[2];
};
template <int BM>
__device__ __forceinline__ void g3_issue(const G3<BM>& g, int kt, unsigned char* stage, int tid) {
#pragma unroll
    for (int i = 0; i < G3<BM>::NA; ++i) glds16(g.ap[i] + kt * 64, stage + (tid + i * NTHR) * 16);
#pragma unroll
    for (int i = 0; i < 2; ++i) glds16(g.bp[i] + kt * 64, stage + BM * 128 + (tid + i * NTHR) * 16);
}
template <int BM, class FA, class FB>
__device__ __forceinline__ void g3_setup(G3<BM>& g, FA rowptr, FB bcol, int tid) {
#pragma unroll
    for (int i = 0; i < G3<BM>::NA; ++i) { const int idx = tid + i * NTHR, row = idx >> 3, sl = (idx & 7) ^ (row & 7); g.ap[i] = rowptr(row) + sl * 8; }
#pragma unroll
    for (int i = 0; i < 2; ++i) { const int idx = tid + i * NTHR, row = idx >> 3, sl = (idx & 7) ^ (row & 7); g.bp[i] = bcol(row) + sl * 8; }
}
template <int BM>
__device__ __forceinline__ void g3_kloop(f32x4 (&acc)[BM / 64][4], const G3<BM>& g, int K, unsigned char* lds) {
    constexpr int MI = G3<BM>::MI, STAGE = G3<BM>::STAGE, NL = G3<BM>::NA + 2;
    const int tid = otid(), lane = tid & 63, wid = tid >> 6, wr = wid >> 1, wc = wid & 1, fr = lane & 15, fq = lane >> 4;
    const int nk = K >> 6;
    g3_issue<BM>(g, 0, lds, tid);
    if (nk > 1) g3_issue<BM>(g, 1, lds + STAGE, tid);
    int cur = 0;
#pragma unroll 1
    for (int t = 0; t < nk; ++t) {
        if (t + 1 < nk) { if (NL == 6) asm volatile("s_waitcnt vmcnt(6)" ::: "memory"); else if (NL == 5) asm volatile("s_waitcnt vmcnt(5)" ::: "memory"); else asm volatile("s_waitcnt vmcnt(4)" ::: "memory"); }
        else asm volatile("s_waitcnt vmcnt(0)" ::: "memory");
        __builtin_amdgcn_s_barrier();
        if (t + 2 < nk) { int nx = cur + 2; if (nx >= 3) nx -= 3; g3_issue<BM>(g, t + 2, lds + nx * STAGE, tid); }
        const unsigned char* cA = lds + cur * STAGE;
        const unsigned char* cB = cA + BM * 128;
#pragma unroll
        for (int ks = 0; ks < 2; ++ks) {
            bf16x8 a[MI], b[4];
#pragma unroll
            for (int m = 0; m < MI; ++m) { const int row = wr * (BM / 4) + m * 16 + fr; a[m] = *(const bf16x8*)(cA + row * 128 + (((ks * 4 + fq) ^ (row & 7)) << 4)); }
#pragma unroll
            for (int n = 0; n < 4; ++n) { const int row = wc * 64 + n * 16 + fr; b[n] = *(const bf16x8*)(cB + row * 128 + (((ks * 4 + fq) ^ (row & 7)) << 4)); }
#pragma unroll
            for (int m = 0; m < MI; ++m)
#pragma unroll
                for (int n = 0; n < 4; ++n) acc[m][n] = __builtin_amdgcn_mfma_f32_16x16x32_bf16(b[n], a[m], acc[m][n], 0, 0, 0);
        }
        cur = (cur == 2) ? 0 : cur + 1;
    }
    __builtin_amdgcn_s_barrier();
}
struct G3D { const bf16_t* ap[2]; const bf16_t* b1[2]; const bf16_t* b3[2]; };
__device__ __forceinline__ void g3d_issue(const G3D& g, int kt, unsigned char* stage, int tid) {
#pragma unroll
    for (int i = 0; i < 2; ++i) glds16(g.ap[i] + kt * 64, stage + (tid + i * NTHR) * 16);
#pragma unroll
    for (int i = 0; i < 2; ++i) glds16(g.b1[i] + kt * 64, stage + 16384 + (tid + i * NTHR) * 16);
#pragma unroll
    for (int i = 0; i < 2; ++i) glds16(g.b3[i] + kt * 64, stage + 32768 + (tid + i * NTHR) * 16);
}
__device__ __forceinline__ void g3d_kloop(f32x4 (&acc1)[2][4], f32x4 (&acc3)[2][4], const G3D& g, int K, unsigned char* lds) {
    constexpr int STAGE = 49152;
    const int tid = otid(), lane = tid & 63, wid = tid >> 6, wr = wid >> 1, wc = wid & 1, fr = lane & 15, fq = lane >> 4;
    const int nk = K >> 6;
    g3d_issue(g, 0, lds, tid);
    if (nk > 1) g3d_issue(g, 1, lds + STAGE, tid);
    int cur = 0;
#pragma unroll 1
    for (int t = 0; t < nk; ++t) {
        if (t + 1 < nk) asm volatile("s_waitcnt vmcnt(6)" ::: "memory"); else asm volatile("s_waitcnt vmcnt(0)" ::: "memory");
        __builtin_amdgcn_s_barrier();
        if (t + 2 < nk) { int nx = cur + 2; if (nx >= 3) nx -= 3; g3d_issue(g, t + 2, lds + nx * STAGE, tid); }
        const unsigned char* cA = lds + cur * STAGE;
#pragma unroll
        for (int ks = 0; ks < 2; ++ks) {
            bf16x8 a[2], b1[4], b3[4];
#pragma unroll
            for (int m = 0; m < 2; ++m) { const int row = wr * 32 + m * 16 + fr; a[m] = *(const bf16x8*)(cA + row * 128 + (((ks * 4 + fq) ^ (row & 7)) << 4)); }
#pragma unroll
            for (int n = 0; n < 4; ++n) { const int row = wc * 64 + n * 16 + fr; const int off = row * 128 + (((ks * 4 + fq) ^ (row & 7)) << 4);
                b1[n] = *(const bf16x8*)(cA + 16384 + off); b3[n] = *(const bf16x8*)(cA + 32768 + off); }
#pragma unroll
            for (int m = 0; m < 2; ++m)
#pragma unroll
                for (int n = 0; n < 4; ++n) {
                    acc1[m][n] = __builtin_amdgcn_mfma_f32_16x16x32_bf16(b1[n], a[m], acc1[m][n], 0, 0, 0);
                    acc3[m][n] = __builtin_amdgcn_mfma_f32_16x16x32_bf16(b3[n], a[m], acc3[m][n], 0, 0, 0);
                }
        }
        cur = (cur == 2) ? 0 : cur + 1;
    }
    __builtin_amdgcn_s_barrier();
}
template <int MI>
__device__ __forceinline__ void g3_zero(f32x4 (&acc)[MI][4]) {
#pragma unroll
    for (int m = 0; m < MI; ++m)
#pragma unroll
        for (int n = 0; n < 4; ++n) acc[m][n] = (f32x4){0.f, 0.f, 0.f, 0.f};
}
__device__ __forceinline__ uint2 pack4(float a, float b, float c, float d) {
    uint2 r; r.x = pk2(a, b); r.y = pk2(c, d); return r;
}

namespace pg8 {
#define PG8_LAS __attribute__((address_space(3)))
typedef unsigned short bf16_t;
typedef short bf16x8 __attribute__((ext_vector_type(8)));
typedef float f32x4 __attribute__((ext_vector_type(4)));
typedef unsigned u32x4 __attribute__((ext_vector_type(4)));
constexpr int BM = 256, BK = 64, HALF = 128, HTB = HALF * BK * 2  , STAGE_BYTES = 8 * HTB, NXCD = 8, WGM = 8;

__host__ __device__ __forceinline__ int lds_byte(int r, int c) { const int st = (r >> 4) * 2 + (c >> 5), rr = r & 15, cc = c & 31, ob = rr * 64 + cc * 2; return st * 1024 + (ob ^ (((ob >> 9) & 1) << 5)); }
__host__ __device__ __forceinline__ void stage_rc(int b, int& R, int& C) { const int st = b / 1024, sb = b % 1024, swz = sb ^ (((sb >> 9) & 1) << 5); R = (st >> 1) * 16 + swz / 64; C = (st & 1) * 32 + (swz % 64) / 2; }
__host__ __device__ __forceinline__ int perm32(int rho) { const int n = rho >> 4, i = rho & 15; return 8 * (i >> 2) + 4 * n + (i & 3); }

struct Unit { int pm, pn; };
struct Gemm { const bf16_t* A; const bf16_t* Bt; int M, N, K; };

struct StaticOrder {
    int nM, nN, nwg, G, c;
    __host__ __device__ void init(int M, int N, int G_, int c_) { nM = M / BM; nN = N / BM; nwg = nM * nN; G = G_; c = c_; }
    __host__ __device__ bool next(int i, Unit& u) const {
        const long L = (long)i * G + c; if (L >= nwg) return false;
        int wgid = (int)L; { const int q = nwg / NXCD, r = nwg % NXCD, xcd = wgid % NXCD, off = wgid / NXCD; wgid = (xcd < r ? xcd * (q + 1) : r * (q + 1) + (xcd - r) * q) + off; }
        const int nig = WGM * nN, gid = wgid / nig, fm = gid * WGM, gsz = (nM - fm) < WGM ? (nM - fm) : WGM;
        u.pm = fm + ((wgid % nig) % gsz); u.pn = (wgid % nig) / gsz; return true;
    }
    __device__ __forceinline__ void a_ready(const Unit&) const {}
    __device__ __forceinline__ void done(const Unit&) const {}
};
template <class Epi, class Sched, bool STAMP = false>
__device__ __forceinline__ void gemm_phase(PG8_LAS unsigned char* lds, const Gemm g, const Sched& S, const Epi& E, unsigned long long* stamps) {
    const int tid = otid(), wid = __builtin_amdgcn_readfirstlane(tid >> 6), lane = tid & 63, wr = wid >> 2, wc = wid & 3, fr = lane & 15, fq = lane >> 4;
    const int K = g.K, nt = K / BK;
    int ts_lo = 0, ts_hi = 0, nts = 0; const unsigned long long rt_entry = STAMP ? 0ull : 0ull;
#define PG8_STAMP() do { if (STAMP && wid == 0 && nts < 64) { const unsigned long long _c = 0ull; \
        ts_lo = (lane == nts) ? (int)(unsigned)_c : ts_lo; ts_hi = (lane == nts) ? (int)(unsigned)(_c >> 32) : ts_hi; ++nts; } } while (0)
    PG8_STAMP();
    unsigned voffA[2], voffB[2];
#pragma unroll
    for (int i = 0; i < 2; ++i) { int R, C; stage_rc(tid * 16 + i * 8192, R, C); const int Rb = Epi::PERM ? ((R & ~31) + perm32(R & 31)) : R;
        voffA[i] = (unsigned)(R * K + C) * 2u; voffB[i] = (unsigned)(Rb * K + C) * 2u; }
    const size_t kstep = (size_t)(BK * 2);
    const size_t hstep = (size_t)HALF * K * 2;
    const size_t tstep = 2 * hstep;
    const unsigned ldsw = (unsigned)wid * 1024u;
    const int aoff = lds_byte(wr * 64 + fr, fq * 8), boff = lds_byte(wc * 32 + fr, fq * 8);
#define PG8_SA(b, h) (((b) * 2 + (h)) * HTB)
#define PG8_SB(b, h) ((4 + (b) * 2 + (h)) * HTB)
#define PG8_STAGE(bufoff, gbase, voff) do { _Pragma("unroll") for (int _i = 0; _i < 2; ++_i) \
        __builtin_amdgcn_global_load_lds((const unsigned*)((const char*)(gbase) + (voff)[_i]), (PG8_LAS unsigned*)(lds + (bufoff) + ldsw + _i * 8192), 16, 0, 0); } while (0)
#define PG8_LDA(dst, b, h) do { _Pragma("unroll") for (int m = 0; m < 4; ++m) _Pragma("unroll") for (int k = 0; k < 2; ++k) dst[m][k] = *(const PG8_LAS bf16x8*)(lds + PG8_SA(b, h) + aoff + m * 2048 + k * 1024); } while (0)
#define PG8_LDB(dst, b, h) do { _Pragma("unroll") for (int n = 0; n < 2; ++n) _Pragma("unroll") for (int k = 0; k < 2; ++k) dst[n][k] = *(const PG8_LAS bf16x8*)(lds + PG8_SB(b, h) + boff + n * 2048 + k * 1024); } while (0)
#define PG8_MMA(ai, bj, At, Bt) do { __builtin_amdgcn_s_setprio(1); _Pragma("unroll") for (int m = 0; m < 4; ++m) _Pragma("unroll") for (int n = 0; n < 2; ++n) _Pragma("unroll") for (int k = 0; k < 2; ++k) \
        acc[ai][bj][m][n] = __builtin_amdgcn_mfma_f32_16x16x32_bf16(Bt[n][k], At[m][k], acc[ai][bj][m][n], 0, 0, 0); __builtin_amdgcn_s_setprio(0); } while (0)
#define PG8_WAIT_V(n) asm volatile("s_waitcnt vmcnt(" #n ")" ::: "memory")
#define PG8_WAIT_L(n) asm volatile("s_waitcnt lgkmcnt(" #n ")" ::: "memory")
#define PG8_BAR __builtin_amdgcn_s_barrier()
#define PG8_SCHED __builtin_amdgcn_sched_barrier(0)
    Unit cur, nxt; int ui = 0;
    if (!S.next(0, cur)) return;
    f32x4 acc[2][2][4][2];
#pragma unroll
    for (int a = 0; a < 2; ++a)
#pragma unroll
        for (int b = 0; b < 2; ++b)
#pragma unroll
            for (int m = 0; m < 4; ++m)
#pragma unroll
                for (int n = 0; n < 2; ++n) acc[a][b][m][n] = (f32x4){0.f, 0.f, 0.f, 0.f};
    bf16x8 At[4][2], B0[2][2], B1[2][2];
    const char* cA = (const char*)g.A + (size_t)cur.pm * tstep; const char* cB = (const char*)g.Bt + (size_t)cur.pn * tstep;
    S.a_ready(cur);
    PG8_STAGE(PG8_SB(0, 0), cB, voffB); PG8_STAGE(PG8_SA(0, 0), cA, voffA); PG8_STAGE(PG8_SB(0, 1), cB + hstep, voffB); PG8_STAGE(PG8_SA(0, 1), cA + hstep, voffA);
    if (wr == 1) PG8_BAR;
    PG8_WAIT_V(4); PG8_BAR;
    PG8_STAGE(PG8_SB(1, 0), cB + kstep, voffB); PG8_STAGE(PG8_SA(1, 0), cA + kstep, voffA); PG8_STAGE(PG8_SB(1, 1), cB + hstep + kstep, voffB);
    PG8_WAIT_V(6); PG8_BAR;
    PG8_STAMP();
    for (;;) {
        const bool has_next = S.next(ui + 1, nxt);
        const char* nA = has_next ? (const char*)g.A + (size_t)nxt.pm * tstep : cA; const char* nB = has_next ? (const char*)g.Bt + (size_t)nxt.pn * tstep : cB;
        for (int t = 0; t < nt; t += 2) {
            const bool last = (t == nt - 2);
            const char* a1 = cA + (size_t)(t + 1) * kstep;
            const char* a2 = last ? nA : cA + (size_t)(t + 2) * kstep; const char* b2 = last ? nB : cB + (size_t)(t + 2) * kstep;
            const char* a3 = a2 + kstep; const char* b3 = b2 + kstep;
            if (last && has_next) S.a_ready(nxt);
            PG8_LDB(B0, 0, 0); PG8_SCHED; PG8_LDA(At, 0, 0); PG8_STAGE(PG8_SA(1, 1), a1 + hstep, voffA);
            PG8_WAIT_L(8); PG8_BAR; PG8_WAIT_L(0); PG8_MMA(0, 0, At, B0); PG8_BAR; PG8_SCHED;
            PG8_LDB(B1, 0, 1); PG8_STAGE(PG8_SB(0, 0), b2, voffB);
            PG8_BAR; PG8_WAIT_L(0); PG8_MMA(0, 1, At, B1); PG8_BAR;
            PG8_LDA(At, 0, 1); PG8_STAGE(PG8_SA(0, 0), a2, voffA);
            PG8_BAR; PG8_WAIT_L(0); PG8_MMA(1, 0, At, B0); PG8_BAR; PG8_SCHED;
            PG8_STAGE(PG8_SB(0, 1), b2 + hstep, voffB);
            PG8_WAIT_V(6); PG8_BAR; PG8_MMA(1, 1, At, B1); PG8_BAR;
            PG8_LDB(B0, 1, 0); PG8_SCHED; PG8_LDA(At, 1, 0); PG8_STAGE(PG8_SA(0, 1), a2 + hstep, voffA);
            PG8_WAIT_L(8); PG8_BAR; PG8_WAIT_L(0); PG8_MMA(0, 0, At, B0); PG8_BAR; PG8_SCHED;
            PG8_LDB(B1, 1, 1); PG8_STAGE(PG8_SB(1, 0), b3, voffB);
            PG8_BAR; PG8_WAIT_L(0); PG8_MMA(0, 1, At, B1); PG8_BAR;
            PG8_LDA(At, 1, 1); PG8_STAGE(PG8_SA(1, 0), a3, voffA);
            PG8_BAR; PG8_WAIT_L(0); PG8_MMA(1, 0, At, B0); PG8_BAR; PG8_SCHED;
            PG8_STAGE(PG8_SB(1, 1), b3 + hstep, voffB);
            PG8_WAIT_V(6); PG8_BAR; PG8_MMA(1, 1, At, B1); PG8_BAR;
        }
        PG8_STAMP();
        if constexpr (!Epi::AFTER_DRAIN) { E(acc, cur, wr, wc, fr, fq); S.done(cur); }
        PG8_STAMP();
        if (!has_next) break;
#pragma unroll
        for (int a = 0; a < 2; ++a)
#pragma unroll
            for (int b = 0; b < 2; ++b)
#pragma unroll
                for (int m = 0; m < 4; ++m)
#pragma unroll
                    for (int n = 0; n < 2; ++n) acc[a][b][m][n] = (f32x4){0.f, 0.f, 0.f, 0.f};
        cur = nxt; cA = nA; cB = nB; ++ui;
    }
    PG8_WAIT_V(0);
    if (wr == 0) PG8_BAR;
    PG8_BAR;
    if constexpr (Epi::AFTER_DRAIN) { E.fused(acc, cur, wr, wc, fr, fq, lds, wid, lane); S.done(cur); }
    PG8_STAMP();
    if (STAMP && wid == 0) { stamps[lane] = lane < nts ? (((unsigned long long)(unsigned)ts_hi << 32) | (unsigned)ts_lo) : 0ull;
        if (lane == 62) stamps[62] = rt_entry; if (lane == 63) stamps[63] = 0ull; }
#undef PG8_STAMP
#undef PG8_SA
#undef PG8_SB
#undef PG8_STAGE
#undef PG8_LDA
#undef PG8_LDB
#undef PG8_MMA
#undef PG8_WAIT_V
#undef PG8_WAIT_L
#undef PG8_BAR
#undef PG8_SCHED
}
}

struct EpiInproj {
    static constexpr bool PERM = true, AFTER_DRAIN = false;
    unsigned char* ws; const float* rstd;
    __device__ __forceinline__ void operator()(const pg8::f32x4 (&acc)[2][2][4][2], const pg8::Unit& u, int wr, int wc, int fr, int fq) const {
        const int pn = u.pn;
        bf16_t* dst; int ld, cb;
        if (pn < 4) { dst = (bf16_t*)(ws + OFF_PPOOL); ld = 1024; cb = pn * 256; }
        else if (pn < 8) { dst = (bf16_t*)(ws + OFF_PR); ld = 1024; cb = (pn - 4) * 256; }
        else if (pn < 12) { dst = (bf16_t*)(ws + OFF_PK); ld = 1024; cb = (pn - 8) * 256; }
        else if (pn < 16) { dst = (bf16_t*)(ws + OFF_PV); ld = 1024; cb = (pn - 12) * 256; }
        else { dst = (bf16_t*)(ws + OFF_PMISC); ld = PM_LD; cb = (pn - 16) * 256; }
        bf16_t* halo = (bf16_t*)(ws + OFF_HALO);
#pragma unroll
        for (int ai = 0; ai < 2; ++ai)
#pragma unroll
            for (int m = 0; m < 4; ++m) {
                const int row = u.pm * 256 + ai * 128 + wr * 64 + m * 16 + fr;
                if (row < NT) {
                    const float rs = rstd[row];
                    const int lr = row & 127;
#pragma unroll
                    for (int bj = 0; bj < 2; ++bj) {
                        const int col = cb + bj * 128 + wc * 32 + fq * 8;
                        const uint2 lo = pack4(acc[ai][bj][m][0][0] * rs, acc[ai][bj][m][0][1] * rs, acc[ai][bj][m][0][2] * rs, acc[ai][bj][m][0][3] * rs);
                        const uint2 hi = pack4(acc[ai][bj][m][1][0] * rs, acc[ai][bj][m][1][1] * rs, acc[ai][bj][m][1][2] * rs, acc[ai][bj][m][1][3] * rs);
                        const uint4 v = make_uint4(lo.x, lo.y, hi.x, hi.y);
                        *(uint4*)(dst + (size_t)row * ld + col) = v;
                        if (pn < 4 && lr >= 112) *(uint4*)(halo + ((size_t)(row >> 7) * 16 + (lr - 112)) * 1024 + col) = v;
                    }
                }
            }
    }
};
__device__ void phase_inproj(const Params& p, unsigned char* lds) {
    pg8::StaticOrder S; S.init(NTP, NP1, (int)gridDim.x, obid());
    pg8::Gemm g; g.A = (const pg8::bf16_t*)(WS(p) + OFF_H); g.Bt = (const pg8::bf16_t*)(WS(p) + OFF_WB) + WB_WIN; g.M = NTP; g.N = NP1; g.K = DM;
    EpiInproj E; E.ws = WS(p); E.rstd = (const float*)(WS(p) + OFF_RSTD);
    pg8::gemm_phase<EpiInproj, pg8::StaticOrder, false>((PG8_LAS unsigned char*)lds, g, S, E, nullptr);
}

__device__ void phase_pool(const Params& p, int l, unsigned char* lds, int tb, int te, int tstep) {
    const int tid = otid(), lane = tid & 63, wid = tid >> 6, fr = lane & 15, fq = lane >> 4;
    bf16_t* pp = (bf16_t*)(WS(p) + OFF_PPOOL);
    const bf16_t* halo = (const bf16_t*)(WS(p) + OFF_HALO);
    const bf16_t* pw = (const bf16_t*)(WS(p) + OFF_WB) + WB_POOL;
    const float* scale = p.in[6] + (size_t)l * 1024;
    bf16_t* sp = (bf16_t*)lds;
    constexpr int SLD = 264;
    bf16_t* sraw = sp + 128 * SLD;
    for (int tile = tb; tile < te; tile += tstep) {
        const int mt = tile >> 2, g = tile & 3;
        const int row0 = mt * 128, w = 2 << g;
        const bf16_t* wg = pw + (size_t)g * 65536;
        bf16x8 bfr[8][2];
#pragma unroll
        for (int kk = 0; kk < 8; ++kk)
#pragma unroll
            for (int n = 0; n < 2; ++n) bfr[kk][n] = *(const bf16x8*)(wg + (size_t)(wid * 32 + n * 16 + fr) * 256 + kk * 32 + fq * 8);
        {
            for (int e = tid; e < 144 * 32; e += NTHR) {
                const int rr = e >> 5, c16 = e & 31;
                uint4 v = make_uint4(0u, 0u, 0u, 0u);
                if (rr >= 16) v = *(const uint4*)(pp + (size_t)(row0 + rr - 16) * 1024 + g * 256 + c16 * 8);
                else if (mt > 0) v = *(const uint4*)(halo + ((size_t)(mt - 1) * 16 + rr) * 1024 + g * 256 + c16 * 8);
                *(uint4*)(sraw + rr * 256 + c16 * 8) = v;
            }
        }
        __syncthreads();
        {
            const int c = tid & 255, r0 = (tid >> 8) * 64;
            auto rawv = [&](int nrel) -> float { return bf2f(sraw[(nrel + 16) * 256 + c]); };
            int t = (row0 + r0) % TS;
            float sum = 0.f;
            const int have = (t < w) ? t : w;
            for (int i = 1; i <= have; ++i) sum += rawv(r0 - i);
#pragma unroll 8
            for (int r = 0; r < 64; ++r) {
                if (t == 0) sum = 0.f;
                const float v = rawv(r0 + r);
                sum += v;
                if (t >= w) sum -= rawv(r0 + r - w);
                const int cnt = (t + 1 < w) ? (t + 1) : w;
                sp[(r0 + r) * SLD + c] = f2bf(sum * (1.0f / (float)cnt) - v);
                t = (t + 1 == TS) ? 0 : t + 1;
            }
        }
        __syncthreads();
        f32x4 acc[8][2];
#pragma unroll
        for (int m = 0; m < 8; ++m) { acc[m][0] = (f32x4){0.f, 0.f, 0.f, 0.f}; acc[m][1] = (f32x4){0.f, 0.f, 0.f, 0.f}; }
#pragma unroll
        for (int kk = 0; kk < 8; ++kk) {
#pragma unroll
            for (int m = 0; m < 8; ++m) {
                const bf16x8 a = *(const bf16x8*)(sp + (m * 16 + fr) * SLD + kk * 32 + fq * 8);
                acc[m][0] = __builtin_amdgcn_mfma_f32_16x16x32_bf16(bfr[kk][0], a, acc[m][0], 0, 0, 0);
                acc[m][1] = __builtin_amdgcn_mfma_f32_16x16x32_bf16(bfr[kk][1], a, acc[m][1], 0, 0, 0);
            }
        }
#pragma unroll
        for (int n = 0; n < 2; ++n) {
            const int col = g * 256 + wid * 32 + n * 16 + fq * 4;
            const float4 sc = *(const float4*)(scale + col);
#pragma unroll
            for (int m = 0; m < 8; ++m) {
                const int row = row0 + m * 16 + fr;
                *(uint2*)(pp + (size_t)row * 1024 + col) = pack4(acc[m][n][0] * sc.x, acc[m][n][1] * sc.y, acc[m][n][2] * sc.z, acc[m][n][3] * sc.w);
            }
        }
        __syncthreads();
    }
}

__device__ void phase_dsa_prep(const Params& p, int l) {
    const int lane = otid() & 63;
    const int wave = (obid() * NTHR + otid()) >> 6, nw = gridDim.x * NTHR / 64;
    const bf16_t* pm = (const bf16_t*)(WS(p) + OFF_PMISC);
    unsigned char* dob = OUTB(p);
    bf16_t* cqn = (bf16_t*)(dob + DO_CQN);
    bf16_t* kv = (bf16_t*)(dob + DO_KV);
    bf16_t* kidx = (bf16_t*)(dob + DO_KIDX);
    float* whead = (float*)(dob + DO_WHEAD);
    const float* ctab = (const float*)(WS(p) + OFF_ROPE);
    const float* stab = ctab + TS * 16;
    const bf16_t* hrow = (const bf16_t*)(WS(p) + OFF_H);
    const bf16_t* wwidx = (const bf16_t*)(WS(p) + OFF_WB) + WB_WIDX;
    const float* rstd_ = (const float*)(WS(p) + OFF_RSTD);
    const float4 qn4 = *(const float4*)(p.in[21] + l * 256 + lane * 4);
    const float2 kvn2 = *(const float2*)(p.in[22] + l * 128 + lane * 2);
    const float inw = p.in[27][l * 64 + lane], inb = p.in[28][l * 64 + lane];
    uint4 ww[8][2];
#pragma unroll
    for (int j = 0; j < 8; ++j) { ww[j][0] = *(const uint4*)(wwidx + (size_t)j * DM + lane * 16); ww[j][1] = *(const uint4*)(wwidx + (size_t)j * DM + lane * 16 + 8); }
    struct In { uint2 cq; unsigned ckv; bf16_t kr0, kr1, kix; uint4 h0, h1; float rs, c, s; };
    auto load = [&](int n) {
        In r;
        const bf16_t* row = pm + (size_t)n * PM_LD;
        const int t = n % TS;
        r.cq = *(const uint2*)(row + PM_CQ + lane * 4);
        r.ckv = *(const unsigned*)(row + PM_CKV + lane * 2);
        r.kr0 = row[PM_KROPE + (lane & 15)]; r.kr1 = row[PM_KROPE + 16 + (lane & 15)];
        r.kix = row[PM_KIDX + lane];
        r.h0 = *(const uint4*)(hrow + (size_t)n * DM + lane * 16); r.h1 = *(const uint4*)(hrow + (size_t)n * DM + lane * 16 + 8);
        r.rs = rstd_[n];
        r.c = ctab[t * 16 + (lane & 15)]; r.s = stab[t * 16 + (lane & 15)];
        return r;
    };
    In cur = load(wave < NT ? wave : 0);
    for (int n = wave; n < NT; n += nw) {
        const In x = cur;
        if (n + nw < NT) cur = load(n + nw);
        {
            const float v0 = __uint_as_float(x.cq.x << 16), v1 = __uint_as_float(x.cq.x & 0xFFFF0000u), v2 = __uint_as_float(x.cq.y << 16), v3 = __uint_as_float(x.cq.y & 0xFFFF0000u);
            const float ss = wave_sum_fast(v0 * v0 + v1 * v1 + v2 * v2 + v3 * v3);
            const float rs = rsqrtf(ss * (1.0f / 256.0f) + 1e-6f);
            *(uint2*)(cqn + (size_t)n * 256 + lane * 4) = pack4(v0 * rs * qn4.x, v1 * rs * qn4.y, v2 * rs * qn4.z, v3 * rs * qn4.w);
        }
        {
            const float v0 = __uint_as_float(x.ckv << 16), v1 = __uint_as_float(x.ckv & 0xFFFF0000u);
            const float ss = wave_sum_fast(v0 * v0 + v1 * v1);
            const float rs = rsqrtf(ss * (1.0f / 128.0f) + 1e-6f);
            *(unsigned*)(kv + (size_t)n * 160 + lane * 2) = pk2(v0 * rs * kvn2.x, v1 * rs * kvn2.y);
        }
        if (lane < 16) {
            const float x1 = bf2f(x.kr0), x2 = bf2f(x.kr1);
            kv[(size_t)n * 160 + 128 + lane] = f2bf(x1 * x.c - x2 * x.s);
            kv[(size_t)n * 160 + 144 + lane] = f2bf(x2 * x.c + x1 * x.s);
        }
        {
            const float xv = bf2f(x.kix);
            const float mu = wave_sum_fast(xv) * (1.0f / 64.0f);
            const float d = xv - mu;
            const float var = wave_sum_fast(d * d) * (1.0f / 64.0f);
            const float y = d * rsqrtf(var + 1e-6f) * inw + inb;
            const float yo = __shfl_xor(y, 16);
            float o = y;
            if (lane < 32) o = (lane < 16) ? (y * x.c - yo * x.s) : (y * x.c + yo * x.s);
            kidx[(size_t)n * 64 + lane] = f2bf(o);
        }
        {
            const uint4 hv0 = x.h0, hv1 = x.h1;
            float hx[16];
            hx[0] = __uint_as_float(hv0.x << 16); hx[1] = __uint_as_float(hv0.x & 0xFFFF0000u); hx[2] = __uint_as_float(hv0.y << 16); hx[3] = __uint_as_float(hv0.y & 0xFFFF0000u);
            hx[4] = __uint_as_float(hv0.z << 16); hx[5] = __uint_as_float(hv0.z & 0xFFFF0000u); hx[6] = __uint_as_float(hv0.w << 16); hx[7] = __uint_as_float(hv0.w & 0xFFFF0000u);
            hx[8] = __uint_as_float(hv1.x << 16); hx[9] = __uint_as_float(hv1.x & 0xFFFF0000u); hx[10] = __uint_as_float(hv1.y << 16); hx[11] = __uint_as_float(hv1.y & 0xFFFF0000u);
            hx[12] = __uint_as_float(hv1.z << 16); hx[13] = __uint_as_float(hv1.z & 0xFFFF0000u); hx[14] = __uint_as_float(hv1.w << 16); hx[15] = __uint_as_float(hv1.w & 0xFFFF0000u);
            float myw = 0.f;
#pragma unroll
            for (int j = 0; j < 8; ++j) {
                const uint4 w0 = ww[j][0], w1 = ww[j][1];
                float d = hx[0] * __uint_as_float(w0.x << 16) + hx[1] * __uint_as_float(w0.x & 0xFFFF0000u) + hx[2] * __uint_as_float(w0.y << 16) + hx[3] * __uint_as_float(w0.y & 0xFFFF0000u)
                        + hx[4] * __uint_as_float(w0.z << 16) + hx[5] * __uint_as_float(w0.z & 0xFFFF0000u) + hx[6] * __uint_as_float(w0.w << 16) + hx[7] * __uint_as_float(w0.w & 0xFFFF0000u)
                        + hx[8] * __uint_as_float(w1.x << 16) + hx[9] * __uint_as_float(w1.x & 0xFFFF0000u) + hx[10] * __uint_as_float(w1.y << 16) + hx[11] * __uint_as_float(w1.y & 0xFFFF0000u)
                        + hx[12] * __uint_as_float(w1.z << 16) + hx[13] * __uint_as_float(w1.z & 0xFFFF0000u) + hx[14] * __uint_as_float(w1.w << 16) + hx[15] * __uint_as_float(w1.w & 0xFFFF0000u);
                d = wave_sum_fast(d);
                myw = (lane == j) ? d : myw;
            }
            if (lane < 8) whead[(size_t)n * 8 + lane] = myw * x.rs * 0.04419417382415922f;
        }
    }
}

typedef short s16x4 __attribute__((ext_vector_type(4)));
__device__ __forceinline__ unsigned f2h_bits(float f) { const _Float16 h = (_Float16)f; unsigned short u; __builtin_memcpy(&u, &h, 2); return u; }
template <bool IMPORT_SEL>
__device__ void phase_dsa(const Params& p, int l, unsigned char* lds, bf16_t* yc, const unsigned short* gsel, const int* gnsel, int tb, int te, int tstep) {
    unsigned short* s_sc = (unsigned short*)lds;
    bf16_t* s_qi = (bf16_t*)(lds + 66048);
    bf16_t* s_Q = (bf16_t*)lds;
    unsigned short* s_sel = (unsigned short*)(lds + 82432 + 65536);
    int* s_nsel = (int*)(lds + 82432 + 65536 + 8192);
    unsigned char* dob = OUTB(p);
    const bf16_t* cqn = (const bf16_t*)(dob + DO_CQN);
    const bf16_t* kv = (const bf16_t*)(dob + DO_KV);
    const bf16_t* kidx = (const bf16_t*)(dob + DO_KIDX);
    const float* whead = (const float*)(dob + DO_WHEAD);
    const float* ctab = (const float*)(WS(p) + OFF_ROPE);
    const float* stab = ctab + TS * 16;
    const bf16_t* wb = (const bf16_t*)(WS(p) + OFF_WB);
    const bf16_t* wqiT = wb + WB_QI;
    const bf16_t* wuqT = wb + WB_UQ;
    const bf16_t* wuk = wb + WB_UK;
    const bf16_t* wuvT = wb + WB_UV;
    const float scale = 0.10206207261596575f;
    const f32x4 z4 = {0.f, 0.f, 0.f, 0.f};
    bf16_t* gq = (obid() < QS_WS) ? (bf16_t*)(WS(p) + WS_END + (size_t)obid() * QS_BYTES) : (bf16_t*)(OUTB(p) + DO_END + (size_t)(obid() - QS_WS) * QS_BYTES);
    for (int pair = tb; pair < te; pair += tstep) {
        const int qt = 128 - (pair >> 2);
        const int t0 = qt * 16;
#pragma unroll 1
        for (int half = 0; half < 2; ++half) {
        const int tid = otid(), lane = tid & 63, wid = tid >> 6, fr = lane & 15, fq = lane >> 4;
        unsigned char* s_Vw = lds + 82432 + wid * 8192;
        bf16_t* s_qn = (bf16_t*)s_Vw;
        const int b = (pair & 3) * 2 + half;
        const size_t n0 = (size_t)b * TS + t0;
        {
            bf16x8 acq[8];
#pragma unroll
            for (int kk = 0; kk < 8; ++kk) acq[kk] = *(const bf16x8*)(cqn + (n0 + fr) * 256 + kk * 32 + fq * 8);
            f32x4 c[4] = {z4, z4, z4, z4};
#pragma unroll
            for (int kb = 0; kb < 8; kb += 4) {
                bf16x8 bf[4][4];
#pragma unroll
                for (int k4 = 0; k4 < 4; ++k4)
#pragma unroll
                    for (int nt = 0; nt < 4; ++nt) bf[k4][nt] = *(const bf16x8*)(wqiT + (size_t)(wid * 64 + nt * 16 + fr) * 256 + (kb + k4) * 32 + fq * 8);
#pragma unroll
                for (int k4 = 0; k4 < 4; ++k4)
#pragma unroll
                    for (int nt = 0; nt < 4; ++nt) c[nt] = __builtin_amdgcn_mfma_f32_16x16x32_bf16(acq[kb + k4], bf[k4][nt], c[nt], 0, 0, 0);
            }
#pragma unroll
            for (int j = 0; j < 4; ++j) {
                const int t = t0 + fq * 4 + j;
                const float cs = ctab[t * 16 + fr], sn = stab[t * 16 + fr];
                const float x1 = c[0][j], x2 = c[1][j];
                c[0][j] = x1 * cs - x2 * sn; c[1][j] = x2 * cs + x1 * sn;
            }
#pragma unroll
            for (int nt = 0; nt < 4; ++nt)
#pragma unroll
                for (int j = 0; j < 4; ++j) s_qi[(fq * 4 + j) * 512 + wid * 64 + nt * 16 + fr] = f2bf(c[nt][j]);
        }
        __syncthreads();
        if (!IMPORT_SEL) {
            bf16x8 aq[8][2];
#pragma unroll
            for (int h = 0; h < 8; ++h)
#pragma unroll
                for (int ks = 0; ks < 2; ++ks) aq[h][ks] = *(const bf16x8*)(s_qi + fr * 512 + h * 64 + ks * 32 + fq * 8);
            float wh[4][8];
#pragma unroll
            for (int j = 0; j < 4; ++j) {
                const float4 w0 = *(const float4*)(whead + (n0 + fq * 4 + j) * 8), w1 = *(const float4*)(whead + (n0 + fq * 4 + j) * 8 + 4);
                wh[j][0] = w0.x; wh[j][1] = w0.y; wh[j][2] = w0.z; wh[j][3] = w0.w; wh[j][4] = w1.x; wh[j][5] = w1.y; wh[j][6] = w1.z; wh[j][7] = w1.w;
            }
            const int nkt = qt + 1;
            bf16x8 nb0 = {0, 0, 0, 0, 0, 0, 0, 0}, nb1 = nb0;
            if (wid < nkt) { const bf16_t* kr0 = kidx + ((size_t)b * TS + wid * 16 + fr) * 64 + fq * 8; nb0 = *(const bf16x8*)kr0; nb1 = *(const bf16x8*)(kr0 + 32); }
#pragma unroll 1
            for (int kt = wid; kt < nkt; kt += 8) {
                const bf16x8 bk0 = nb0, bk1 = nb1;
                if (kt + 8 < nkt) { const bf16_t* krn = kidx + ((size_t)b * TS + (kt + 8) * 16 + fr) * 64 + fq * 8; nb0 = *(const bf16x8*)krn; nb1 = *(const bf16x8*)(krn + 32); }
                float I[4] = {0.f, 0.f, 0.f, 0.f};
#pragma unroll
                for (int h = 0; h < 8; ++h) {
                    f32x4 a = __builtin_amdgcn_mfma_f32_16x16x32_bf16(aq[h][0], bk0, z4, 0, 0, 0);
                    a = __builtin_amdgcn_mfma_f32_16x16x32_bf16(aq[h][1], bk1, a, 0, 0, 0);
#pragma unroll
                    for (int j = 0; j < 4; ++j) I[j] += wh[j][h] * fmaxf(a[j], 0.f);
                }
#pragma unroll
                for (int j = 0; j < 4; ++j) s_sc[(fq * 4 + j) * 2064 + kt * 16 + fr] = (unsigned short)f2h_bits(I[j]);
            }
        }
        __syncthreads();
#pragma unroll 1
        for (int qi2 = 0; qi2 < 2; ++qi2) {
            const int q = wid + qi2 * 8;
            const int nadm = t0 + q + 1;
            unsigned short* sel = s_sel + q * 256;
            if (IMPORT_SEL) {
                const int ns = gnsel[n0 + q];
                for (int i = lane; i < ns; i += 64) sel[i] = gsel[(n0 + q) * 256 + i];
                if (lane == 0) s_nsel[q] = ns;
            } else if (nadm <= 256) {
                for (int i = lane; i < nadm; i += 64) sel[i] = (unsigned short)i;
                if (lane == 0) s_nsel[q] = nadm;
            } else {
                unsigned* hist = (unsigned*)(lds + 82432 + wid * 8192);
                const unsigned short* scq = s_sc + q * 2064;
                const int nch = (nadm + 63) >> 6;
                unsigned B1 = 0u; int na1 = 0, na2 = 0; unsigned T = 0u;
#pragma unroll 1
                for (int pass = 0; pass < 2; ++pass) {
                    *(uint4*)(hist + lane * 4) = make_uint4(0u, 0u, 0u, 0u);
#pragma unroll 1
                    for (int c0 = 0; c0 < nch; c0 += 8) {
                        unsigned kb[8];
#pragma unroll
                        for (int j = 0; j < 8; ++j) { const int s_ = (c0 + j) * 64 + lane; kb[j] = (s_ < nadm) ? (unsigned)scq[s_] : 0x10000u; }
#pragma unroll
                        for (int j = 0; j < 8; ++j) {
                            const unsigned u = kb[j];
                            const unsigned k = (u & 0x8000u) ? (~u & 0xFFFFu) : (u | 0x8000u);
                            const bool ok = (u < 0x10000u) && (pass == 0 || (k >> 8) == B1);
                            if (ok) atomicAdd(hist + (pass == 0 ? (k >> 8) : (k & 255u)), 1u);
                        }
                    }
                    const int need = 256 - na1;
                    const uint4 h4 = *(const uint4*)(hist + lane * 4);
                    const int sl = (int)(h4.x + h4.y + h4.z + h4.w);
                    int suf = sl;
#pragma unroll
                    for (int o = 1; o < 64; o <<= 1) { const int t_ = __shfl_down(suf, o); suf += (lane + o < 64) ? t_ : 0; }
                    const int above = suf - sl;
                    const bool mine = (suf >= need) && (above < need);
                    int a = above, bsel, asel;
                    if (a + (int)h4.w >= need) { bsel = 3; asel = a; }
                    else { a += (int)h4.w;
                        if (a + (int)h4.z >= need) { bsel = 2; asel = a; }
                        else { a += (int)h4.z;
                            if (a + (int)h4.y >= need) { bsel = 1; asel = a; }
                            else { a += (int)h4.y; bsel = 0; asel = a; } } }
                    const int src = __ffsll((long long)__ballot(mine)) - 1;
                    const unsigned bin = (unsigned)__shfl(lane * 4 + bsel, src); const int nab = __shfl(asel, src);
                    if (pass == 0) { B1 = bin; na1 = nab; } else { T = (B1 << 8) | bin; na2 = nab; }
                }
                {
                    const int rties = 256 - (na1 + na2);
                    int base = 0, ties = 0;
                    const unsigned long long ltmask = (1ull << lane) - 1ull;
#pragma unroll 1
                    for (int c0 = 0; c0 < nch; c0 += 4) {
                        unsigned kb[4];
#pragma unroll
                        for (int j = 0; j < 4; ++j) { const int s_ = (c0 + j) * 64 + lane; kb[j] = (s_ < nadm) ? (unsigned)scq[s_] : 0x10000u; }
#pragma unroll
                        for (int j = 0; j < 4; ++j) {
                            const int s_ = (c0 + j) * 64 + lane;
                            const unsigned u = kb[j];
                            const bool valid = u < 0x10000u;
                            const unsigned k = (u & 0x8000u) ? (~u & 0xFFFFu) : (u | 0x8000u);
                            const bool gt = valid && k > T, eq = valid && k == T;
                            const unsigned long long em = __ballot(eq);
                            const int myrank = ties + __popcll(em & ltmask);
                            const bool take = gt || (eq && myrank < rties);
                            const unsigned long long tm = __ballot(take);
                            const int pos = base + __popcll(tm & ltmask);
                            if (take && pos < 256) sel[pos] = (unsigned short)s_;
                            base += __popcll(tm); ties += __popcll(em);
                        }
                    }
                }
                if (lane == 0) s_nsel[q] = 256;
            }
        }
        __syncthreads();
        if (half == 0) {
            const size_t n0B = n0 + TS;
            bf16_t* s_qnB = s_qn + 1024;
#pragma unroll 1
            for (int hi = 0; hi < 2; ++hi) {
                const int hh = wid * 2 + hi;
                const bf16_t* caA = cqn + (n0 + fr) * 256 + fq * 8;
                const bf16_t* caB = cqn + (n0B + fr) * 256 + fq * 8;
                f32x4 cA[6] = {z4, z4, z4, z4, z4, z4}, cB[6] = {z4, z4, z4, z4, z4, z4};
#pragma unroll
                for (int kb = 0; kb < 8; kb += 2) {
                    bf16x8 bf[2][6], aA[2], aB[2];
#pragma unroll
                    for (int k2 = 0; k2 < 2; ++k2) {
                        aA[k2] = *(const bf16x8*)(caA + (kb + k2) * 32); aB[k2] = *(const bf16x8*)(caB + (kb + k2) * 32);
#pragma unroll
                        for (int nt = 0; nt < 6; ++nt) bf[k2][nt] = *(const bf16x8*)(wuqT + (size_t)(hh * 96 + nt * 16 + fr) * 256 + (kb + k2) * 32 + fq * 8);
                    }
#pragma unroll
                    for (int k2 = 0; k2 < 2; ++k2)
#pragma unroll
                        for (int nt = 0; nt < 6; ++nt) {
                            cA[nt] = __builtin_amdgcn_mfma_f32_16x16x32_bf16(aA[k2], bf[k2][nt], cA[nt], 0, 0, 0);
                            cB[nt] = __builtin_amdgcn_mfma_f32_16x16x32_bf16(aB[k2], bf[k2][nt], cB[nt], 0, 0, 0);
                        }
                }
#pragma unroll
                for (int j = 0; j < 4; ++j) {
                    const int q = fq * 4 + j, t = t0 + q;
                    const float cs = ctab[t * 16 + fr], sn = stab[t * 16 + fr];
                    s_Q[(q * 16 + hh) * 160 + 128 + fr] = f2bf(cA[4][j] * cs - cA[5][j] * sn);
                    s_Q[(q * 16 + hh) * 160 + 144 + fr] = f2bf(cA[5][j] * cs + cA[4][j] * sn);
                    gq[(q * 16 + hh) * 160 + 128 + fr] = f2bf(cB[4][j] * cs - cB[5][j] * sn);
                    gq[(q * 16 + hh) * 160 + 144 + fr] = f2bf(cB[5][j] * cs + cB[4][j] * sn);
#pragma unroll
                    for (int nt = 0; nt < 4; ++nt) { s_qn[q * 64 + nt * 16 + fr] = f2bf(cA[nt][j]); s_qnB[q * 64 + nt * 16 + fr] = f2bf(cB[nt][j]); }
                }
                __syncthreads();
                bf16x8 anA[2], anB[2];
#pragma unroll
                for (int ks = 0; ks < 2; ++ks) { anA[ks] = *(const bf16x8*)(s_qn + fr * 64 + ks * 32 + fq * 8); anB[ks] = *(const bf16x8*)(s_qnB + fr * 64 + ks * 32 + fq * 8); }
                bf16x8 bwk[8][2];
#pragma unroll
                for (int nt = 0; nt < 8; ++nt)
#pragma unroll
                    for (int ks = 0; ks < 2; ++ks) bwk[nt][ks] = *(const bf16x8*)(wuk + (size_t)(hh * 128 + nt * 16 + fr) * 64 + ks * 32 + fq * 8);
#pragma unroll
                for (int nt = 0; nt < 8; ++nt) {
                    f32x4 aA = z4, aB = z4;
#pragma unroll
                    for (int ks = 0; ks < 2; ++ks) {
                        aA = __builtin_amdgcn_mfma_f32_16x16x32_bf16(anA[ks], bwk[nt][ks], aA, 0, 0, 0);
                        aB = __builtin_amdgcn_mfma_f32_16x16x32_bf16(anB[ks], bwk[nt][ks], aB, 0, 0, 0);
                    }
#pragma unroll
                    for (int j = 0; j < 4; ++j) {
                        s_Q[((fq * 4 + j) * 16 + hh) * 160 + nt * 16 + fr] = f2bf(aA[j]);
                        gq[((fq * 4 + j) * 16 + hh) * 160 + nt * 16 + fr] = f2bf(aB[j]);
                    }
                }
                __syncthreads();
            }
        } else {
            for (int e = tid; e < QS_BYTES / 16; e += NTHR) ((uint4*)s_Q)[e] = ((const uint4*)gq)[e];
            __syncthreads();
        }
#pragma unroll 1
        for (int qi2 = 0; qi2 < 2; ++qi2) {
            const int q = wid + qi2 * 8;
            bf16x8 bq[5];
#pragma unroll
            for (int ks = 0; ks < 5; ++ks) bq[ks] = *(const bf16x8*)(s_Q + (q * 16 + fr) * 160 + ks * 32 + fq * 8);
            const int nsel = s_nsel[q];
            const unsigned short* sel = s_sel + q * 256;
            float m = -INFINITY, lsum = 0.f;
            f32x4 O[8] = {z4, z4, z4, z4, z4, z4, z4, z4};
            const int nchunk = (nsel + 31) >> 5;
            bf16x8 akn[2][5];
#pragma unroll
            for (int mt = 0; mt < 2; ++mt) {
                const int ki = mt * 16 + fr;
                const int sidx = sel[ki < nsel ? ki : 0];
                const bf16_t* krow = kv + ((size_t)b * TS + sidx) * 160 + fq * 8;
#pragma unroll
                for (int ks = 0; ks < 5; ++ks) akn[mt][ks] = *(const bf16x8*)(krow + ks * 32);
            }
#pragma unroll 1
            for (int ch = 0; ch < nchunk; ++ch) {
                bf16x8 ak[2][5];
#pragma unroll
                for (int mt = 0; mt < 2; ++mt)
#pragma unroll
                    for (int ks = 0; ks < 5; ++ks) ak[mt][ks] = akn[mt][ks];
                if (ch + 1 < nchunk) {
#pragma unroll
                    for (int mt = 0; mt < 2; ++mt) {
                        const int ki = (ch + 1) * 32 + mt * 16 + fr;
                        const int sidx = sel[ki < nsel ? ki : 0];
                        const bf16_t* krow = kv + ((size_t)b * TS + sidx) * 160 + fq * 8;
#pragma unroll
                        for (int ks = 0; ks < 5; ++ks) akn[mt][ks] = *(const bf16x8*)(krow + ks * 32);
                    }
                }
#pragma unroll
                for (int mt = 0; mt < 2; ++mt)
#pragma unroll
                    for (int ks = 0; ks < 4; ++ks) {
                        const int r = mt * 16 + fr;
                        *(bf16x8*)(s_Vw + r * 256 + (((ks * 2 + (fq >> 1)) ^ (r & 7)) * 32) + (fq & 1) * 16) = ak[mt][ks];
                    }
                f32x4 st[2] = {z4, z4};
#pragma unroll
                for (int mt = 0; mt < 2; ++mt)
#pragma unroll
                    for (int ks = 0; ks < 5; ++ks) st[mt] = __builtin_amdgcn_mfma_f32_16x16x32_bf16(ak[mt][ks], bq[ks], st[mt], 0, 0, 0);
                float sv[2][4]; float cmax = -INFINITY;
#pragma unroll
                for (int mt = 0; mt < 2; ++mt)
#pragma unroll
                    for (int j = 0; j < 4; ++j) {
                        const int ke = ch * 32 + mt * 16 + fq * 4 + j;
                        const float s_ = (ke < nsel) ? st[mt][j] * scale : -INFINITY;
                        sv[mt][j] = s_; cmax = fmaxf(cmax, s_);
                    }
                cmax = fmaxf(cmax, __shfl_xor(cmax, 16)); cmax = fmaxf(cmax, __shfl_xor(cmax, 32));
                const float mnew = fmaxf(m, cmax);
                const float alpha = __expf(m - mnew);
                float psum = 0.f;
#pragma unroll
                for (int mt = 0; mt < 2; ++mt)
#pragma unroll
                    for (int j = 0; j < 4; ++j) { const float pe = __expf(sv[mt][j] - mnew); sv[mt][j] = pe; psum += pe; }
                psum += __shfl_xor(psum, 16); psum += __shfl_xor(psum, 32);
                lsum = lsum * alpha + psum; m = mnew;
#pragma unroll
                for (int ct = 0; ct < 8; ++ct) O[ct] = O[ct] * alpha;
                bf16x8 pf;
#pragma unroll
                for (int mt = 0; mt < 2; ++mt)
#pragma unroll
                    for (int j = 0; j < 4; ++j) pf[mt * 4 + j] = (short)f2bf(sv[mt][j]);
                const int q_ = fr >> 2, p_ = fr & 3;
                const int r0 = fq * 4 + q_, r1 = 16 + r0;
#pragma unroll
                for (int ct = 0; ct < 8; ++ct) {
                    const s16x4 v0 = __builtin_amdgcn_ds_read_tr16_b64_v4i16((__attribute__((address_space(3))) s16x4*)(s_Vw + r0 * 256 + ((ct ^ (r0 & 7)) * 32) + p_ * 8));
                    const s16x4 v1 = __builtin_amdgcn_ds_read_tr16_b64_v4i16((__attribute__((address_space(3))) s16x4*)(s_Vw + r1 * 256 + ((ct ^ (r1 & 7)) * 32) + p_ * 8));
                    bf16x8 av; av[0] = v0[0]; av[1] = v0[1]; av[2] = v0[2]; av[3] = v0[3]; av[4] = v1[0]; av[5] = v1[1]; av[6] = v1[2]; av[7] = v1[3];
                    O[ct] = __builtin_amdgcn_mfma_f32_16x16x32_bf16(av, pf, O[ct], 0, 0, 0);
                }
            }
            const float inv = 1.0f / lsum;
#pragma unroll
            for (int ct = 0; ct < 8; ++ct)
#pragma unroll
                for (int j = 0; j < 4; ++j) s_Q[(q * 16 + fr) * 160 + ct * 16 + fq * 4 + j] = f2bf(O[ct][j] * inv);
        }
        __syncthreads();
#pragma unroll 1
        for (int hi = 0; hi < 2; ++hi) {
            const int hh = wid * 2 + hi;
            bf16x8 ao[4];
#pragma unroll
            for (int ks = 0; ks < 4; ++ks) ao[ks] = *(const bf16x8*)(s_Q + (fr * 16 + hh) * 160 + ks * 32 + fq * 8);
#pragma unroll
            for (int nt = 0; nt < 4; ++nt) {
                f32x4 a = z4;
#pragma unroll
                for (int ks = 0; ks < 4; ++ks)
                    a = __builtin_amdgcn_mfma_f32_16x16x32_bf16(ao[ks], *(const bf16x8*)(wuvT + (size_t)(hh * 64 + nt * 16 + fr) * 128 + ks * 32 + fq * 8), a, 0, 0, 0);
#pragma unroll
                for (int j = 0; j < 4; ++j) yc[(n0 + fq * 4 + j) * 1024 + hh * 64 + nt * 16 + fr] = f2bf(a[j]);
            }
        }
        __syncthreads();
        }
    }
}


__device__ void phase_lr_prep(const Params& p, int l) {
    const int lane = otid() & 63;
    const int wave = (obid() * NTHR + otid()) >> 6, nw = gridDim.x * NTHR / 64;
    const bf16_t* pm = (const bf16_t*)(WS(p) + OFF_PMISC);
    bf16_t* alr = (bf16_t*)(OUTB(p) + DO_ALR);
    const float4 mu4 = *(const float4*)(p.in[4] + (size_t)l * 3328 + 3072 + lane * 4);
    const float4 vm4 = *(const float4*)(p.in[18] + (lane & 7) * 4);
    struct In { uint2 c0, p0, c1, p1; };
    auto load = [&](int n) {
        In r;
        const bf16_t* row = pm + (size_t)n * PM_LD;
        const bool hp = (n % TS) > 0;
        r.c0 = *(const uint2*)(row + lane * 4);
        r.p0 = hp ? *(const uint2*)(row - PM_LD + lane * 4) : make_uint2(0u, 0u);
        r.c1 = make_uint2(0u, 0u); r.p1 = r.c1;
        if (lane < 8) { r.c1 = *(const uint2*)(row + 256 + lane * 4); if (hp) r.p1 = *(const uint2*)(row - PM_LD + 256 + lane * 4); }
        return r;
    };
    auto mix4 = [&](const uint2 c, const uint2 q, const float4 m, float (&o)[4]) {
        const float c0 = __uint_as_float(c.x << 16), c1 = __uint_as_float(c.x & 0xFFFF0000u), c2 = __uint_as_float(c.y << 16), c3 = __uint_as_float(c.y & 0xFFFF0000u);
        const float q0 = __uint_as_float(q.x << 16), q1 = __uint_as_float(q.x & 0xFFFF0000u), q2 = __uint_as_float(q.y << 16), q3 = __uint_as_float(q.y & 0xFFFF0000u);
        o[0] = c0 + (q0 - c0) * m.x; o[1] = c1 + (q1 - c1) * m.y; o[2] = c2 + (q2 - c2) * m.z; o[3] = c3 + (q3 - c3) * m.w;
    };
    In cur = load(wave < NT ? wave : 0);
    for (int n = wave; n < NT; n += nw) {
        const In x = cur;
        if (n + nw < NT) cur = load(n + nw);
        float o[4];
        mix4(x.c0, x.p0, mu4, o);
        if (lane < 16) { o[0] = tanhf(o[0]); o[1] = tanhf(o[1]); o[2] = tanhf(o[2]); o[3] = tanhf(o[3]); }
        else if (lane >= 32) { o[0] = sigmoidf_(o[0]); o[1] = sigmoidf_(o[1]); o[2] = sigmoidf_(o[2]); o[3] = sigmoidf_(o[3]); }
        *(uint2*)(alr + (size_t)n * 288 + lane * 4) = pack4(o[0], o[1], o[2], o[3]);
        if (lane < 8) {
            mix4(x.c1, x.p1, vm4, o);
            *(uint2*)(alr + (size_t)n * 288 + 256 + lane * 4) = pack4(o[0], o[1], o[2], o[3]);
        }
    }
}

typedef short sh4 __attribute__((ext_vector_type(4)));
__device__ __forceinline__ sh4 pk4v(const f32x4& v) { const uint2 u = pack4(v[0], v[1], v[2], v[3]); sh4 r; __builtin_memcpy(&r, &u, 8); return r; }
__device__ __forceinline__ bf16x8 cat8(const sh4& a, const sh4& b) { bf16x8 r; r[0] = a[0]; r[1] = a[1]; r[2] = a[2]; r[3] = a[3]; r[4] = b[0]; r[5] = b[1]; r[6] = b[2]; r[7] = b[3]; return r; }
#define MF32(a, b, c) __builtin_amdgcn_mfma_f32_16x16x32_bf16(a, b, c, 0, 0, 0)
#define MF16(a, b, c) MF32(cat8(a, sh4{0, 0, 0, 0}), cat8(b, sh4{0, 0, 0, 0}), c)
constexpr int SC_LT = 72;
constexpr int SC_LS = 36;
constexpr int SC_TC = 32;
constexpr int SC_ROWB = 1088;
__device__ __forceinline__ const unsigned char* scan_piece_src(const Params& p, int l, int b, int hc, int t0, int pi, bool& ok) {
    const int tau = pi / 68, seg = pi - tau * 68;
    const int t = t0 + tau;
    ok = (t < TS) && (tau < SC_TC);
    const size_t n = (size_t)b * TS + t;
    const unsigned char* ws = WS(p);
    if (seg < 8) return ws + OFF_PR + (n * 1024 + hc) * 2 + seg * 16;
    if (seg < 16) return ws + OFF_PK + (n * 1024 + hc) * 2 + (seg - 8) * 16;
    if (seg < 24) return ws + OFF_PV + (n * 1024 + hc) * 2 + (seg - 16) * 16;
    if (seg < 60) return OUTB(p) + DO_ALR + (n * 288) * 2 + (seg - 24) * 16;
    ok = ok && (l > 0);
    return ws + OFF_VFIRST + (n * 1024 + hc) * 2 + (seg - 60) * 16;
}
__device__ void phase_scan5(const Params& p, int l, unsigned char* lds, int blk) {
    const int tid = otid(), lane = tid & 63, wid = tid >> 6, fr = lane & 15, fq = lane >> 4;
    const int b = blk >> 4, hh = blk & 15, hc = hh * 64;
    float* s_r = (float*)lds;
    float* s_w = s_r + 2048;
    float* s_k = s_w + 2048;
    float* s_v = s_k + 2048;
    float* s_a = s_v + 2048;
    float* s_b = s_a + 2048;
    float* s_g = s_b + 2048;
    float* s_o = s_g + 2048;
    bf16_t* o_at = (bf16_t*)(s_o + 2048);
    bf16_t* o_rt = o_at + 32 * SC_LT;
    bf16_t* o_bt = o_rt + 32 * SC_LT;
    bf16_t* o_kt = o_bt + 32 * SC_LT;
    bf16_t* o_bT = o_kt + 32 * SC_LT;
    bf16_t* o_kT = o_bT + 64 * SC_LS;
    bf16_t* o_vT = o_kT + 64 * SC_LS;
    float* s_gc = (float*)(o_vT + 64 * SC_LS);
    unsigned char* raw = (unsigned char*)(s_gc + 128);
    float* prevb = (float*)(raw + 32 * SC_ROWB);
    unsigned* prevr = (unsigned*)prevb;
    float* s_bs = s_r;
    float* cst = prevb + 960;
    const float* mu = p.in[4] + (size_t)l * 3328;
    for (int e = tid; e < 480; e += NTHR) {
        float v;
        if (e < 192) v = mu[(e >> 6) * 1024 + hc + (e & 63)];
        else if (e < 448) v = mu[3072 + (e - 192)];
        else v = p.in[18][e - 448];
        cst[e] = v;
    }
    if (tid < 64) {
        cst[480 + tid] = p.in[7][l * 1024 + hc + tid];
        cst[544 + tid] = p.in[9][l * 1024 + hc + tid];
        cst[608 + tid] = p.in[12][l * 1024 + hc + tid];
        cst[672 + tid] = p.in[13][l * 1024 + hc + tid];
        cst[736 + tid] = p.in[14][l * 1024 + hc + tid];
        cst[800 + tid] = p.in[15][l * 1024 + hc + tid];
        cst[864 + tid] = p.in[16][l * 1024 + hc + tid];
        cst[928 + tid] = p.in[19][hc + tid];
    }
    const int mm = wid >> 1, ntb = (wid & 1) * 2;
    const int nks = (mm == 2) ? 4 : (mm == 3 ? 1 : 2);
    bf16x8 Bw[2][4];
    {
        const float* wsrc = (mm == 0) ? p.in[8] + (size_t)l * 64 * 1024 : (mm == 1) ? p.in[10] + (size_t)l * 64 * 1024 : (mm == 2) ? p.in[11] + (size_t)l * 128 * 1024 : p.in[20];
#pragma unroll
        for (int n2 = 0; n2 < 2; ++n2)
#pragma unroll
            for (int ks = 0; ks < 4; ++ks) {
                bf16x8 f;
#pragma unroll
                for (int j = 0; j < 8; ++j) {
                    const bool okw = ks < nks && (mm < 3 || l > 0);
                    const float v = wsrc[(size_t)(okw ? (ks * 32 + fq * 8 + j) : 0) * 1024 + hc + (ntb + n2) * 16 + fr];
                    f[j] = (short)f2bf(okw ? v : 0.f);
                }
                Bw[n2][ks] = f;
            }
    }
    const f32x4 z4 = {0.f, 0.f, 0.f, 0.f};
    f32x4 S[4] = {z4, z4, z4, z4};
    sh4 Lf;
#pragma unroll
    for (int j = 0; j < 4; ++j) Lf[j] = (fq * 4 + j <= fr) ? (short)0x3F80 : (short)0;
    bf16_t* Pr = (bf16_t*)(WS(p) + OFF_PR);
    bf16_t* vfirst = (bf16_t*)(WS(p) + OFF_VFIRST);
    const unsigned char* psrc[5]; int pstep[5], ptau[5]; bool pval[5];
#pragma unroll
    for (int k = 0; k < 5; ++k) {
        const int pi = tid + k * NTHR;
        bool ok = false;
        psrc[k] = scan_piece_src(p, l, b, hc, 0, pi < SC_TC * 68 ? pi : 0, ok);
        const int tau = (pi < SC_TC * 68 ? pi : 0) / 68, seg = (pi < SC_TC * 68 ? pi : 0) - tau * 68;
        ptau[k] = tau;
        pstep[k] = SC_TC * ((seg >= 24 && seg < 60) ? 576 : 2048);
        pval[k] = (pi < SC_TC * 68) && !(seg >= 60 && l == 0);
    }
    uint4 pre[5];
#pragma unroll
    for (int k = 0; k < 5; ++k) { pre[k] = make_uint4(0, 0, 0, 0); if (pval[k] && ptau[k] < TS) pre[k] = *(const uint4*)psrc[k]; }
    __syncthreads();
#pragma unroll 1
    for (int t0 = 0, ch = 0; t0 < TS; t0 += SC_TC, ++ch) {
        const int nval = (TS - t0 < SC_TC) ? (TS - t0) : SC_TC;
#pragma unroll
        for (int k = 0; k < 5; ++k) { const int pi = tid + k * NTHR; if (pi < SC_TC * 68) *(uint4*)(raw + pi * 16) = pre[k]; }
        lds_barrier();
#pragma unroll
        for (int k = 0; k < 5; ++k) {
            pre[k] = make_uint4(0, 0, 0, 0);
            if (pval[k] && t0 + SC_TC + ptau[k] < TS) pre[k] = *(const uint4*)(psrc[k] + (size_t)(ch + 1) * pstep[k]);
        }
        if (mm < 3 || l > 0) {
            const unsigned char* Ab = raw + ((mm == 0) ? 384 : (mm == 1) ? 512 : (mm == 2) ? 640 : 896);
            float* dst = (mm == 0) ? s_w : (mm == 1) ? s_a : (mm == 2) ? s_g : s_o;
#pragma unroll
            for (int m = 0; m < 2; ++m) {
                f32x4 acc0 = {0.f, 0.f, 0.f, 0.f}, acc1 = {0.f, 0.f, 0.f, 0.f};
#pragma unroll
                for (int ks = 0; ks < 4; ++ks) {
                    if (ks < nks) {
                        const bf16x8 a = *(const bf16x8*)(Ab + (m * 16 + fr) * SC_ROWB + ks * 64 + fq * 16);
                        acc0 = __builtin_amdgcn_mfma_f32_16x16x32_bf16(a, Bw[0][ks], acc0, 0, 0, 0);
                        acc1 = __builtin_amdgcn_mfma_f32_16x16x32_bf16(a, Bw[1][ks], acc1, 0, 0, 0);
                    }
                }
                if (mm == 0) {
                    const float cw0 = cst[480 + ntb * 16 + fr], cw1 = cst[480 + (ntb + 1) * 16 + fr];
                    f32x4 l0, l1, r0, r1;
#pragma unroll
                    for (int j = 0; j < 4; ++j) { l0[j] = -0.6065306597126334f * fast_sigmoid(acc0[j] + cw0); l1[j] = -0.6065306597126334f * fast_sigmoid(acc1[j] + cw1); }
                    const uint2 h0 = pack4(l0[0], l0[1], l0[2], l0[3]), h1 = pack4(l1[0], l1[1], l1[2], l1[3]);
                    r0[0] = l0[0] - __uint_as_float(h0.x << 16); r0[1] = l0[1] - __uint_as_float(h0.x & 0xFFFF0000u); r0[2] = l0[2] - __uint_as_float(h0.y << 16); r0[3] = l0[3] - __uint_as_float(h0.y & 0xFFFF0000u);
                    r1[0] = l1[0] - __uint_as_float(h1.x << 16); r1[1] = l1[1] - __uint_as_float(h1.x & 0xFFFF0000u); r1[2] = l1[2] - __uint_as_float(h1.y << 16); r1[3] = l1[3] - __uint_as_float(h1.y & 0xFFFF0000u);
                    sh4 hh0, hh1; __builtin_memcpy(&hh0, &h0, 8); __builtin_memcpy(&hh1, &h1, 8);
                    f32x4 c0 = MF16(Lf, pk4v(r0), z4), c1 = MF16(Lf, pk4v(r1), z4);
                    c0 = MF16(Lf, hh0, c0); c1 = MF16(Lf, hh1, c1);
#pragma unroll
                    for (int j = 0; j < 4; ++j) {
                        const int eo = (m * 16 + fq * 4 + j) * 64 + ntb * 16 + fr;
                        s_w[eo] = c0[j]; s_w[eo + 16] = c1[j];
                        s_b[eo] = l0[j]; s_b[eo + 16] = l1[j];
                    }
                } else {
#pragma unroll
                    for (int j = 0; j < 4; ++j) {
                        dst[(m * 16 + fq * 4 + j) * 64 + ntb * 16 + fr] = acc0[j];
                        dst[(m * 16 + fq * 4 + j) * 64 + (ntb + 1) * 16 + fr] = acc1[j];
                    }
                }
            }
        }
        lds_barrier();
        {
            const int tau = tid >> 4, c4 = (tid & 15) * 4, e = tau * 64 + c4, t = t0 + tau;
            const size_t n = (size_t)b * TS + t;
            const float4 cum4 = *(const float4*)(s_w + e), lw4 = *(const float4*)(s_b + e), xa4 = *(const float4*)(s_a + e);
            const float4 ca = *(const float4*)(cst + 544 + c4), ckk = *(const float4*)(cst + 608 + c4), cka = *(const float4*)(cst + 672 + c4), crk = *(const float4*)(cst + 736 + c4);
            const float cum[4] = {cum4.x, cum4.y, cum4.z, cum4.w}, lw[4] = {lw4.x, lw4.y, lw4.z, lw4.w};
            const float xa[4] = {xa4.x + ca.x, xa4.y + ca.y, xa4.z + ca.z, xa4.w + ca.w};
            const float kkc[4] = {ckk.x, ckk.y, ckk.z, ckk.w}, kac[4] = {cka.x, cka.y, cka.z, cka.w};
            float rr[4], kr[4], vv[4];
            {
                const unsigned char* rc = raw + tau * SC_ROWB + c4 * 2;
                const uint2 cr = *(const uint2*)rc, ck = *(const uint2*)(rc + 128), cv = *(const uint2*)(rc + 256);
                uint2 qr = make_uint2(0u, 0u), qk = qr, qv = qr;
                if (tau > 0) { qr = *(const uint2*)(rc - SC_ROWB); qk = *(const uint2*)(rc - SC_ROWB + 128); qv = *(const uint2*)(rc - SC_ROWB + 256); }
                else if (t0 > 0) { const unsigned* pvr = prevr + ((ch + 1) & 1) * 96 + (c4 >> 1); qr = *(const uint2*)pvr; qk = *(const uint2*)(pvr + 32); qv = *(const uint2*)(pvr + 64); }
                if (tau == SC_TC - 1) { unsigned* pwr = prevr + (ch & 1) * 96 + (c4 >> 1); *(uint2*)pwr = cr; *(uint2*)(pwr + 32) = ck; *(uint2*)(pwr + 64) = cv; }
                const float4 mr = *(const float4*)(cst + c4), mk = *(const float4*)(cst + 64 + c4), mv = *(const float4*)(cst + 128 + c4);
                const float c_[12] = {__uint_as_float(cr.x << 16), __uint_as_float(cr.x & 0xFFFF0000u), __uint_as_float(cr.y << 16), __uint_as_float(cr.y & 0xFFFF0000u),
                                      __uint_as_float(ck.x << 16), __uint_as_float(ck.x & 0xFFFF0000u), __uint_as_float(ck.y << 16), __uint_as_float(ck.y & 0xFFFF0000u),
                                      __uint_as_float(cv.x << 16), __uint_as_float(cv.x & 0xFFFF0000u), __uint_as_float(cv.y << 16), __uint_as_float(cv.y & 0xFFFF0000u)};
                const float q_[12] = {__uint_as_float(qr.x << 16), __uint_as_float(qr.x & 0xFFFF0000u), __uint_as_float(qr.y << 16), __uint_as_float(qr.y & 0xFFFF0000u),
                                      __uint_as_float(qk.x << 16), __uint_as_float(qk.x & 0xFFFF0000u), __uint_as_float(qk.y << 16), __uint_as_float(qk.y & 0xFFFF0000u),
                                      __uint_as_float(qv.x << 16), __uint_as_float(qv.x & 0xFFFF0000u), __uint_as_float(qv.y << 16), __uint_as_float(qv.y & 0xFFFF0000u)};
                const float m_[12] = {mr.x, mr.y, mr.z, mr.w, mk.x, mk.y, mk.z, mk.w, mv.x, mv.y, mv.z, mv.w};
#pragma unroll
                for (int j = 0; j < 4; ++j) { rr[j] = c_[j] + (q_[j] - c_[j]) * m_[j]; kr[j] = c_[4 + j] + (q_[4 + j] - c_[4 + j]) * m_[4 + j]; vv[j] = c_[8 + j] + (q_[8 + j] - c_[8 + j]) * m_[8 + j]; }
            }
            if (l > 0) {
                const float4 xv4 = *(const float4*)(s_o + e), cv = *(const float4*)(cst + 928 + c4);
                const uint2 vfu = *(const uint2*)(raw + tau * SC_ROWB + 960 + c4 * 2);
                const float vf[4] = {__uint_as_float(vfu.x << 16), __uint_as_float(vfu.x & 0xFFFF0000u), __uint_as_float(vfu.y << 16), __uint_as_float(vfu.y & 0xFFFF0000u)};
                const float xv[4] = {xv4.x + cv.x, xv4.y + cv.y, xv4.z + cv.z, xv4.w + cv.w};
#pragma unroll
                for (int j = 0; j < 4; ++j) vv[j] = vv[j] + (vf[j] - vv[j]) * fast_sigmoid(xv[j]);
            } else if (t < TS) {
                *(uint2*)(vfirst + n * 1024 + hc + c4) = pack4(vv[0], vv[1], vv[2], vv[3]);
            }
            float av[4], kkv[4], ginc[4], gexc[4], ginv[4]; float ss = 0.f;
#pragma unroll
            for (int j = 0; j < 4; ++j) {
                ginc[j] = __expf(cum[j]); gexc[j] = __expf(cum[j] - lw[j]); ginv[j] = __expf(-cum[j]);
                av[j] = fast_sigmoid(xa[j]);
                kkv[j] = kr[j] * kkc[j];
                ss += kkv[j] * kkv[j];
            }
            float kk[4], kt[4];
#pragma unroll
            for (int j = 0; j < 4; ++j) kt[j] = kr[j] * (1.0f + (av[j] - 1.0f) * kac[j]);
            float bsum = rr[0] * kt[0] * crk.x + rr[1] * kt[1] * crk.y + rr[2] * kt[2] * crk.z + rr[3] * kt[3] * crk.w;
            float du0 = 0.f, du1 = 0.f;
            row16_sum4(ss, bsum, du0, du1);
            if ((tid & 15) == 0) s_bs[tau] = bsum;
            const float rn = rsqrtf(fmaxf(ss, 1e-24f));
#pragma unroll
            for (int j = 0; j < 4; ++j) kk[j] = kkv[j] * rn;
            const uint2 pa = pack4(-kk[0] * gexc[0], -kk[1] * gexc[1], -kk[2] * gexc[2], -kk[3] * gexc[3]);
            const uint2 pr = pack4(rr[0] * ginc[0], rr[1] * ginc[1], rr[2] * ginc[2], rr[3] * ginc[3]);
            const uint2 pb = pack4(kk[0] * av[0] * ginv[0], kk[1] * av[1] * ginv[1], kk[2] * av[2] * ginv[2], kk[3] * av[3] * ginv[3]);
            const uint2 pk = pack4(kt[0] * ginv[0], kt[1] * ginv[1], kt[2] * ginv[2], kt[3] * ginv[3]);
            const uint2 pv = pack4(vv[0], vv[1], vv[2], vv[3]);
            *(uint2*)(o_at + tau * SC_LT + c4) = pa;
            *(uint2*)(o_rt + tau * SC_LT + c4) = pr;
            *(uint2*)(o_bt + tau * SC_LT + c4) = pb;
            *(uint2*)(o_kt + tau * SC_LT + c4) = pk;
            o_bT[(c4 + 0) * SC_LS + tau] = (bf16_t)(pb.x & 0xFFFFu); o_bT[(c4 + 1) * SC_LS + tau] = (bf16_t)(pb.x >> 16); o_bT[(c4 + 2) * SC_LS + tau] = (bf16_t)(pb.y & 0xFFFFu); o_bT[(c4 + 3) * SC_LS + tau] = (bf16_t)(pb.y >> 16);
            o_kT[(c4 + 0) * SC_LS + tau] = (bf16_t)(pk.x & 0xFFFFu); o_kT[(c4 + 1) * SC_LS + tau] = (bf16_t)(pk.x >> 16); o_kT[(c4 + 2) * SC_LS + tau] = (bf16_t)(pk.y & 0xFFFFu); o_kT[(c4 + 3) * SC_LS + tau] = (bf16_t)(pk.y >> 16);
            o_vT[(c4 + 0) * SC_LS + tau] = (bf16_t)(pv.x & 0xFFFFu); o_vT[(c4 + 1) * SC_LS + tau] = (bf16_t)(pv.x >> 16); o_vT[(c4 + 2) * SC_LS + tau] = (bf16_t)(pv.y & 0xFFFFu); o_vT[(c4 + 3) * SC_LS + tau] = (bf16_t)(pv.y >> 16);
            if ((tau & 15) == 15) *(float4*)(s_gc + (tau >> 4) * 64 + c4) = make_float4(ginc[0], ginc[1], ginc[2], ginc[3]);
            *(float4*)(s_v + e) = make_float4(vv[0], vv[1], vv[2], vv[3]);
        }
        lds_barrier();
        if (wid < 4) {
#pragma unroll 1
            for (int sc = 0; sc < 2; ++sc) {
                if (sc * 16 < nval) {
                    const bf16_t* ar = o_at + (sc * 16 + fr) * SC_LT;
                    const bf16_t* rr_ = o_rt + (sc * 16 + fr) * SC_LT;
                    const bf16_t* br = o_bt + (sc * 16 + fr) * SC_LT;
                    const bf16_t* kr_ = o_kt + (sc * 16 + fr) * SC_LT;
                    const bf16x8 fa0 = *(const bf16x8*)(ar + fq * 8), fa1 = *(const bf16x8*)(ar + 32 + fq * 8);
                    const bf16x8 fb0 = *(const bf16x8*)(br + fq * 8), fb1 = *(const bf16x8*)(br + 32 + fq * 8);
                    const bf16x8 fk0 = *(const bf16x8*)(kr_ + fq * 8), fk1 = *(const bf16x8*)(kr_ + 32 + fq * 8);
                    const bf16x8 fr0 = *(const bf16x8*)(rr_ + fq * 8), fr1 = *(const bf16x8*)(rr_ + 32 + fq * 8);
                    f32x4 nA = MF32(fb0, fa0, z4); nA = MF32(fb1, fa1, nA);
                    f32x4 nB = MF32(fa0, fb0, z4); nB = MF32(fa1, fb1, nB);
                    f32x4 mak = MF32(fk0, fa0, z4); mak = MF32(fk1, fa1, mak);
                    f32x4 mbr = MF32(fb0, fr0, z4); mbr = MF32(fb1, fr1, mbr);
                    f32x4 mkr = MF32(fk0, fr0, z4); mkr = MF32(fk1, fr1, mkr);
#pragma unroll
                    for (int j = 0; j < 4; ++j) {
                        const int s_ = fq * 4 + j;
                        nA[j] = (s_ < fr) ? nA[j] : 0.f; nB[j] = (fr < s_) ? nB[j] : 0.f; mak[j] = (s_ < fr) ? mak[j] : 0.f;
                        mbr[j] = (s_ <= fr) ? mbr[j] : 0.f; mkr[j] = (s_ <= fr) ? mkr[j] : 0.f;
                    }
                    const sh4 pNA = pk4v(nA), pNB = pk4v(nB), pMak = pk4v(mak), pMbr = pk4v(mbr), pMkr = pk4v(mkr);
                    const f32x4 n2B = MF16(pNA, pNB, z4), n2A = MF16(pNB, pNA, z4);
                    const sh4 pN2A = pk4v(n2A), pN2B = pk4v(n2B);
                    const f32x4 n4B = MF16(pN2A, pN2B, z4), n4A = MF16(pN2B, pN2A, z4);
                    const sh4 pN4A = pk4v(n4A), pN4B = pk4v(n4B);
                    const sh4 pN8A = pk4v(MF16(pN4B, pN4A, z4));
                    const bf16x8 sB0 = cat8(pk4v(S[0]), pk4v(S[1])), sB1 = cat8(pk4v(S[2]), pk4v(S[3]));
                    const sh4 vf = *(const sh4*)(o_vT + (wid * 16 + fr) * SC_LS + sc * 16 + fq * 4);
                    f32x4 X = MF32(cat8(*(const sh4*)(ar + fq * 4), *(const sh4*)(ar + 16 + fq * 4)), sB0, z4);
                    X = MF32(cat8(*(const sh4*)(ar + 32 + fq * 4), *(const sh4*)(ar + 48 + fq * 4)), sB1, X);
                    X = MF16(pMak, vf, X);
                    X = MF16(pN8A, pk4v(X), X); X = MF16(pN4A, pk4v(X), X); X = MF16(pN2A, pk4v(X), X); X = MF16(pNA, pk4v(X), X);
                    const sh4 pSA = pk4v(X);
                    f32x4 O = MF32(cat8(*(const sh4*)(rr_ + fq * 4), *(const sh4*)(rr_ + 16 + fq * 4)), sB0, z4);
                    O = MF32(cat8(*(const sh4*)(rr_ + 32 + fq * 4), *(const sh4*)(rr_ + 48 + fq * 4)), sB1, O);
                    const bf16x8 sav = cat8(pSA, vf);
                    O = MF32(cat8(pMbr, pMkr), sav, O);
#pragma unroll
                    for (int j = 0; j < 4; ++j) s_o[(sc * 16 + fq * 4 + j) * 64 + wid * 16 + fr] = O[j];
#pragma unroll
                    for (int jt = 0; jt < 4; ++jt) {
                        const sh4 ka = *(const sh4*)(o_kT + (jt * 16 + fr) * SC_LS + sc * 16 + fq * 4), ba = *(const sh4*)(o_bT + (jt * 16 + fr) * SC_LS + sc * 16 + fq * 4);
                        f32x4 acc = MF32(cat8(ba, ka), sav, S[jt]);
                        const float4 g4 = *(const float4*)(s_gc + sc * 64 + jt * 16 + fq * 4);
                        acc[0] *= g4.x; acc[1] *= g4.y; acc[2] *= g4.z; acc[3] *= g4.w;
                        S[jt] = acc;
                    }
                }
            }
        }
        lds_barrier();
        {
            const int tau = tid >> 4, c4 = (tid & 15) * 4, e = tau * 64 + c4;
            const size_t n = (size_t)b * TS + t0 + tau;
            const float4 o4 = *(const float4*)(s_o + e), v4_ = *(const float4*)(s_v + e), g4_ = *(const float4*)(s_g + e);
            const float4 clw = *(const float4*)(cst + 800 + c4), clb = *(const float4*)(cst + 864 + c4);
            const float bsum = s_bs[tau];
            const float m_ = row16_sum((o4.x + o4.y) + (o4.z + o4.w)) * (1.0f / 64.0f);
            const float d0 = o4.x - m_, d1 = o4.y - m_, d2 = o4.z - m_, d3 = o4.w - m_;
            const float var = row16_sum(d0 * d0 + d1 * d1 + d2 * d2 + d3 * d3) * (1.0f / 64.0f);
            const float rs = rsqrtf(var + 64e-5f);
            const float y0 = (d0 * rs * clw.x + clb.x + bsum * v4_.x) * g4_.x, y1 = (d1 * rs * clw.y + clb.y + bsum * v4_.y) * g4_.y;
            const float y2 = (d2 * rs * clw.z + clb.z + bsum * v4_.z) * g4_.z, y3 = (d3 * rs * clw.w + clb.w + bsum * v4_.w) * g4_.w;
            if (tau < nval) *(uint2*)(Pr + n * 1024 + hc + c4) = pack4(y0, y1, y2, y3);
        }
    }
}

__device__ __forceinline__ void xcd_panel_map(int& mt0, int& mstep, int& nt) {
    const int b = obid(), G = (int)gridDim.x;
    if (G == 256) { nt = (b >> 3) & 7; mt0 = (b & 7) * 4 + (b >> 6); mstep = 32; }
    else { nt = b & 7; mt0 = b >> 3; mstep = G >> 3; }
}
__device__ void phase_merge(const Params& p, unsigned char* lds) {
    const int tid = otid(), lane = tid & 63, wid = tid >> 6, wr = wid >> 1, wc = wid & 1, fr = lane & 15, fq = lane >> 4;
    const bf16_t* h = (const bf16_t*)(WS(p) + OFF_H);
    const bf16_t* wb = (const bf16_t*)(WS(p) + OFF_WB);
    const float* rstd = (const float*)(WS(p) + OFF_RSTD);
    bf16_t* merged = (bf16_t*)(WS(p) + OFF_MERGED);
    const bf16_t* ysrc0 = (const bf16_t*)(WS(p) + OFF_PPOOL);
    const bf16_t* ysrc1 = (const bf16_t*)(WS(p) + OFF_PR);
    const bf16_t* ysrc2 = (const bf16_t*)(OUTB(p) + DO_YC);
    for (int tile = obid(); tile < 86 * 8; tile += gridDim.x) {
        const int mt = tile >> 3, nt = tile & 7;
        const int row0 = mt * 192, col0 = nt * 128;
        uint2 maccp[3][4];
#pragma unroll
        for (int m = 0; m < 3; ++m)
#pragma unroll
            for (int n = 0; n < 4; ++n) maccp[m][n] = make_uint2(0u, 0u);
#pragma unroll 1
        for (int i = 0; i < 3; ++i) {
            const int tid = otid();
            const bf16_t* ys = (i == 0) ? ysrc0 : (i == 1 ? ysrc1 : ysrc2);
            uint2 sg[3][4];
            {
                f32x4 ag[3][4]; g3_zero<3>(ag);
                G3<192> g;
                g3_setup<192>(g, [&](int r) { return h + (size_t)(row0 + r) * DM; }, [&](int r) { return wb + WB_WG + (size_t)(i * 1024 + col0 + r) * DM; }, tid);
                g3_kloop<192>(ag, g, DM, lds);
#pragma unroll
                for (int m = 0; m < 3; ++m) {
                    const float rs = rstd[row0 + wr * 48 + m * 16 + fr];
#pragma unroll
                    for (int n = 0; n < 4; ++n) sg[m][n] = pack4(fast_sigmoid(ag[m][n][0] * rs), fast_sigmoid(ag[m][n][1] * rs), fast_sigmoid(ag[m][n][2] * rs), fast_sigmoid(ag[m][n][3] * rs));
                }
            }
            {
                f32x4 ay[3][4]; g3_zero<3>(ay);
                G3<192> g;
                g3_setup<192>(g, [&](int r) { return ys + (size_t)(row0 + r) * DM; }, [&](int r) { return wb + WB_PA + (size_t)(i * 1024 + col0 + r) * DM; }, tid);
                g3_kloop<192>(ay, g, DM, lds);
#pragma unroll
                for (int m = 0; m < 3; ++m)
#pragma unroll
                    for (int n = 0; n < 4; ++n) {
                        const float m0 = __uint_as_float(maccp[m][n].x << 16) + __uint_as_float(sg[m][n].x << 16) * ay[m][n][0];
                        const float m1 = __uint_as_float(maccp[m][n].x & 0xFFFF0000u) + __uint_as_float(sg[m][n].x & 0xFFFF0000u) * ay[m][n][1];
                        const float m2 = __uint_as_float(maccp[m][n].y << 16) + __uint_as_float(sg[m][n].y << 16) * ay[m][n][2];
                        const float m3 = __uint_as_float(maccp[m][n].y & 0xFFFF0000u) + __uint_as_float(sg[m][n].y & 0xFFFF0000u) * ay[m][n][3];
                        maccp[m][n] = pack4(m0, m1, m2, m3);
                    }
            }
        }
#pragma unroll
        for (int m = 0; m < 3; ++m) {
            const int row = row0 + wr * 48 + m * 16 + fr;
#pragma unroll
            for (int n = 0; n < 4; ++n)
                *(uint2*)(merged + (size_t)row * 1024 + col0 + wc * 64 + n * 16 + fq * 4) = maccp[m][n];
        }
    }
}

__device__ void phase_outproj(const Params& p, unsigned char* lds) {
    const int tid = otid(), lane = tid & 63, wid = tid >> 6, wr = wid >> 1, wc = wid & 1, fr = lane & 15, fq = lane >> 4;
    const bf16_t* h = (const bf16_t*)(WS(p) + OFF_H);
    const bf16_t* wb = (const bf16_t*)(WS(p) + OFF_WB);
    const bf16_t* merged = (const bf16_t*)(WS(p) + OFF_MERGED);
    float* hm = (float*)(WS(p) + OFF_HM32);
    int mt0, mstep, nt;
    xcd_panel_map(mt0, mstep, nt);
    for (int mt = mt0; mt < 86; mt += mstep) {
        const int row0 = mt * 192, col0 = nt * 128;
        G3<192> g;
        g3_setup<192>(g, [&](int r) { return merged + (size_t)(row0 + r) * DM; }, [&](int r) { return wb + WB_WO + (size_t)(col0 + r) * DM; }, tid);
        f32x4 acc[3][4]; g3_zero<3>(acc);
        g3_kloop<192>(acc, g, DM, lds);
#pragma unroll
        for (int m = 0; m < 3; ++m) {
            const int row = row0 + wr * 48 + m * 16 + fr;
#pragma unroll
            for (int n = 0; n < 4; ++n) {
                const int col = col0 + wc * 64 + n * 16 + fq * 4;
                const uint2 hv = *(const uint2*)(h + (size_t)row * 1024 + col);
                float4 o;
                o.x = __uint_as_float(hv.x << 16) + acc[m][n][0]; o.y = __uint_as_float(hv.x & 0xFFFF0000u) + acc[m][n][1];
                o.z = __uint_as_float(hv.y << 16) + acc[m][n][2]; o.w = __uint_as_float(hv.y & 0xFFFF0000u) + acc[m][n][3];
                *(float4*)(hm + (size_t)row * 1024 + col) = o;
            }
        }
    }
}

__device__ __constant__ int c_pair_lo[6] = {0, 0, 0, 1, 1, 2};
__device__ __constant__ int c_pair_hi[6] = {1, 2, 3, 2, 3, 3};
__device__ void phase_route(const Params& p, int l, unsigned char* lds) {
    const int tid = otid(), lane = tid & 63, wid = tid >> 6;
    const int per = (NT + (int)gridDim.x - 1) / (int)gridDim.x;
    const int nbeg = obid() * per, nend = (nbeg + per < NT) ? nbeg + per : NT;
    int* s_cls = (int*)lds;
    int* s_base = s_cls + 512;
    float* s_wr = (float*)(lds + 4096);
    const float* hm = (const float*)(WS(p) + OFF_HM32);
    bf16_t* hn = (bf16_t*)(WS(p) + OFF_HN);
    const float* nf = p.in[33] + (size_t)l * 1024;
    const float* wg = p.in[34] + (size_t)l * 1024 * 4;
    const float* bg = p.in[35] + l * 4;
    const float* we = p.in[36] + (size_t)l * 1024 * 16;
    const float* be = p.in[37] + l * 16;
    int* cnt = (int*)(WS(p) + OFF_CTL);
    int* list = (int*)(WS(p) + OFF_LIST);
    float* pw = (float*)(WS(p) + OFF_PW);
    for (int e = tid; e < 1024 * 20; e += NTHR) {
        const int k = e / 20, c = e - k * 20;
        s_wr[c * 1024 + k] = (c < 4) ? wg[(size_t)k * 4 + c] : we[(size_t)k * 16 + (c - 4)];
    }
    __syncthreads();
    float4 nv[4], cur[4];
#pragma unroll
    for (int i = 0; i < 4; ++i) nv[i] = *(const float4*)(nf + i * 256 + lane * 4);
    if (nbeg + wid < nend) {
#pragma unroll
        for (int i = 0; i < 4; ++i) cur[i] = *(const float4*)(hm + (size_t)(nbeg + wid) * DM + i * 256 + lane * 4);
    }
    for (int n = nbeg + wid; n < nend; n += 8) {
        float4 xv[4]; float ss = 0.f;
#pragma unroll
        for (int i = 0; i < 4; ++i) { xv[i] = cur[i]; ss += xv[i].x * xv[i].x + xv[i].y * xv[i].y + xv[i].z * xv[i].z + xv[i].w * xv[i].w; }
        if (n + 8 < nend) {
#pragma unroll
            for (int i = 0; i < 4; ++i) cur[i] = *(const float4*)(hm + (size_t)(n + 8) * DM + i * 256 + lane * 4);
        }
        ss = wave_sum(ss);
        const float rs = rsqrtf(ss * (1.0f / 1024.0f) + 1e-6f);
        float lg[4] = {0.f, 0.f, 0.f, 0.f};
        float le[16];
#pragma unroll
        for (int e = 0; e < 16; ++e) le[e] = 0.f;
#pragma unroll
        for (int i = 0; i < 4; ++i) {
            float y[4] = {xv[i].x * rs * nv[i].x, xv[i].y * rs * nv[i].y, xv[i].z * rs * nv[i].z, xv[i].w * rs * nv[i].w};
            {
                const int d0 = i * 256 + lane * 4;
#pragma unroll
                for (int g = 0; g < 4; ++g) { const float4 w4 = *(const float4*)(s_wr + g * 1024 + d0); lg[g] += y[0] * w4.x + y[1] * w4.y + y[2] * w4.z + y[3] * w4.w; }
#pragma unroll
                for (int e = 0; e < 16; ++e) { const float4 w4 = *(const float4*)(s_wr + (4 + e) * 1024 + d0); le[e] += y[0] * w4.x + y[1] * w4.y + y[2] * w4.z + y[3] * w4.w; }
            }
            *(uint2*)(hn + (size_t)n * DM + i * 256 + lane * 4) = pack4(y[0], y[1], y[2], y[3]);
        }
#pragma unroll
        for (int g = 0; g < 4; ++g) lg[g] = wave_sum_fast(lg[g]) + bg[g];
#pragma unroll
        for (int e = 0; e < 16; ++e) le[e] = wave_sum_fast(le[e]) + be[e];
        if (lane == 0) {
            int gs = 0; float gm = lg[0];
#pragma unroll
            for (int g = 1; g < 4; ++g) if (lg[g] > gm) { gm = lg[g]; gs = g; }
            float den = 0.f;
#pragma unroll
            for (int g = 0; g < 4; ++g) den += __expf(lg[g] - gm);
            const float pgrp = 1.0f / den;
            float v4[4];
#pragma unroll
            for (int e = 0; e < 4; ++e) {
                const float m0 = (gs == 0) ? 1.f : 0.f, m1s = (gs == 1) ? 1.f : 0.f, m2s = (gs == 2) ? 1.f : 0.f, m3s = (gs == 3) ? 1.f : 0.f;
                v4[e] = le[e] * m0 + le[4 + e] * m1s + le[8 + e] * m2s + le[12 + e] * m3s;
            }
            int i1 = 0; float m1 = v4[0];
#pragma unroll
            for (int e = 1; e < 4; ++e) if (v4[e] > m1) { m1 = v4[e]; i1 = e; }
            int i2 = -1; float m2 = -INFINITY;
#pragma unroll
            for (int e = 0; e < 4; ++e) if (e != i1 && v4[e] > m2) { m2 = v4[e]; i2 = e; }
            const float e2 = __expf(m2 - m1);
            const float p1 = pgrp / (1.0f + e2), p2 = pgrp * e2 / (1.0f + e2);
            const int lo = i1 < i2 ? i1 : i2, hi = i1 < i2 ? i2 : i1;
            const float plo = i1 < i2 ? p1 : p2, phi = i1 < i2 ? p2 : p1;
            const int pi = (lo == 0) ? (hi - 1) : (lo == 1 ? hi + 1 : 5);
            const int cls = gs * 6 + pi;
            s_cls[n - nbeg] = cls;
            pw[(size_t)n * 2 + 0] = plo; pw[(size_t)n * 2 + 1] = phi;
        }
    }
    __syncthreads();
    const int nloc = nend - nbeg;
    if (tid < 24) {
        int c_ = 0;
        for (int i = 0; i < nloc; ++i) c_ += (s_cls[i] == tid) ? 1 : 0;
        s_base[tid] = c_ ? atomicAdd(&cnt[tid * 32], c_) : 0;
    }
    __syncthreads();
    for (int it = tid; it < nloc; it += NTHR) {
        const int cls = s_cls[it];
        int rank = 0;
        for (int i = 0; i < it; ++i) rank += (s_cls[i] == cls) ? 1 : 0;
        list[(size_t)cls * NT + s_base[cls] + rank] = nbeg + it;
    }
    __syncthreads();
}


struct MoeTile { int cls, ti, cnt, tg; };
__device__ __forceinline__ int moe_total_tiles(const int* cnt) { int s = 0; for (int c = 0; c < 24; ++c) s += (cnt[c * 32] + 127) >> 7; return s; }
__device__ __forceinline__ MoeTile moe_find(const int* cnt, int tile) {
    MoeTile r; int s = 0; r.cls = 0; r.ti = 0; r.cnt = 0; r.tg = tile;
    for (int c = 0; c < 24; ++c) { const int nt = (cnt[c * 32] + 127) >> 7; if (tile >= s && tile < s + nt) { r.cls = c; r.ti = tile - s; r.cnt = cnt[c * 32]; } s += nt; }
    return r;
}
__device__ void phase_moe1(const Params& p, unsigned char* lds) {
    const int tid = otid(), lane = tid & 63, wid = tid >> 6, wr = wid >> 1, wc = wid & 1, fr = lane & 15, fq = lane >> 4;
    const int* cnt = (const int*)(WS(p) + OFF_CTL);
    const int* list = (const int*)(WS(p) + OFF_LIST);
    const float* pw = (const float*)(WS(p) + OFF_PW);
    const bf16_t* hn = (const bf16_t*)(WS(p) + OFF_HN);
    const bf16_t* we = (const bf16_t*)(WS(p) + OFF_WEXP);
    bf16_t* hid = (bf16_t*)(OUTB(p) + DO_HID);
    const int total = moe_total_tiles(cnt);
    for (int item = obid(); item < total * 4; item += gridDim.x) {
        const MoeTile mt = moe_find(cnt, item >> 2);
        const int nt = item & 3, slot = nt >> 1, f0 = (nt & 1) * 128;
        const int g_ = mt.cls / 6, pi = mt.cls % 6;
        const int e = g_ * 4 + (slot == 0 ? c_pair_lo[pi] : c_pair_hi[pi]);
        const int* lst = list + (size_t)mt.cls * NT + mt.ti * 128;
        const int nvalid = min(128, mt.cnt - mt.ti * 128);
        f32x4 a1[2][4], a3[2][4]; g3_zero<2>(a1); g3_zero<2>(a3);
        G3D g;
#pragma unroll
        for (int i = 0; i < 2; ++i) {
            const int idx = tid + i * NTHR, row = idx >> 3, sl = (idx & 7) ^ (row & 7);
            g.ap[i] = hn + (size_t)lst[row < nvalid ? row : 0] * DM + sl * 8;
            g.b1[i] = we + WE_W1 + ((size_t)e * 256 + f0 + row) * 1024 + sl * 8;
            g.b3[i] = we + WE_W3 + ((size_t)e * 256 + f0 + row) * 1024 + sl * 8;
        }
        g3d_kloop(a1, a3, g, DM, lds);
#pragma unroll
        for (int m = 0; m < 2; ++m) {
            const int lr = wr * 32 + m * 16 + fr;
            const int tk = lst[lr < nvalid ? lr : 0];
            const float pe = pw[(size_t)tk * 2 + slot];
#pragma unroll
            for (int n = 0; n < 4; ++n) {
                const int col = slot * 256 + f0 + wc * 64 + n * 16 + fq * 4;
                float o[4];
#pragma unroll
                for (int j = 0; j < 4; ++j) { const float x1 = a1[m][n][j]; o[j] = x1 * sigmoidf_(x1) * a3[m][n][j] * pe; }
                *(uint2*)(hid + ((size_t)mt.tg * 128 + lr) * 512 + col) = pack4(o[0], o[1], o[2], o[3]);
            }
        }
    }
}
__device__ void phase_moe2(const Params& p, int l, unsigned char* lds) {
    const int tid = otid(), lane = tid & 63, wid = tid >> 6, wr = wid >> 1, wc = wid & 1, fr = lane & 15, fq = lane >> 4;
    const int* cnt = (const int*)(WS(p) + OFF_CTL);
    const int* list = (const int*)(WS(p) + OFF_LIST);
    const bf16_t* we = (const bf16_t*)(WS(p) + OFF_WEXP);
    const bf16_t* hid = (const bf16_t*)(OUTB(p) + DO_HID);
    float* hm = (float*)(WS(p) + OFF_HM32);
    bf16_t* h = (bf16_t*)(WS(p) + OFF_H);
    const int total = moe_total_tiles(cnt);
    for (int item = obid(); item < total * 8; item += gridDim.x) {
        const MoeTile mt = moe_find(cnt, item >> 3);
        const int nt = item & 7, col0 = nt * 128;
        const int g_ = mt.cls / 6, pi = mt.cls % 6;
        const int elo = g_ * 4 + c_pair_lo[pi], ehi = g_ * 4 + c_pair_hi[pi];
        const int* lst = list + (size_t)mt.cls * NT + mt.ti * 128;
        const int nvalid = min(128, mt.cnt - mt.ti * 128);
        f32x4 acc[2][4]; g3_zero<2>(acc);
        G3<128> g;
        g3_setup<128>(g, [&](int r) { return hid + ((size_t)mt.tg * 128 + r) * 512; }, [&](int r) { return we + WE_W2 + ((size_t)elo * 1024 + col0 + r) * 256; }, tid);
        g3_kloop<128>(acc, g, 256, lds);
        g3_setup<128>(g, [&](int r) { return hid + ((size_t)mt.tg * 128 + r) * 512 + 256; }, [&](int r) { return we + WE_W2 + ((size_t)ehi * 1024 + col0 + r) * 256; }, tid);
        g3_kloop<128>(acc, g, 256, lds);
#pragma unroll
        for (int m = 0; m < 2; ++m) {
            const int lr = wr * 32 + m * 16 + fr;
            if (lr < nvalid) {
                const int tk = lst[lr];
#pragma unroll
                for (int n = 0; n < 4; ++n) {
                    const int col = col0 + wc * 64 + n * 16 + fq * 4;
                    float4 v = *(const float4*)(hm + (size_t)tk * 1024 + col);
                    v.x += acc[m][n][0]; v.y += acc[m][n][1]; v.z += acc[m][n][2]; v.w += acc[m][n][3];
                    if (l == 0) *(uint2*)(h + (size_t)tk * 1024 + col) = pack4(v.x, v.y, v.z, v.w);
                    else *(float4*)(hm + (size_t)tk * 1024 + col) = v;
                }
            }
        }
    }
}

__device__ void phase_final(const Params& p) {
    const int lane = otid() & 63;
    const int wave = (obid() * NTHR + otid()) >> 6, nw = gridDim.x * NTHR / 64;
    const float* hm = (const float*)(WS(p) + OFF_HM32);
    const float* nf = p.in[41];
    float4 g[4], cur[4];
#pragma unroll
    for (int i = 0; i < 4; ++i) g[i] = *(const float4*)(nf + i * 256 + lane * 4);
    auto rowp = [&](int r) { const int b = r / SEQ, s_ = r % SEQ; return hm + ((size_t)b * TS + NMETA + s_) * DM; };
    if (wave < NB * SEQ) {
        const float* src = rowp(wave);
#pragma unroll
        for (int i = 0; i < 4; ++i) cur[i] = *(const float4*)(src + i * 256 + lane * 4);
    }
    for (int r = wave; r < NB * SEQ; r += nw) {
        float4 v[4]; float ss = 0.f;
#pragma unroll
        for (int i = 0; i < 4; ++i) { v[i] = cur[i]; ss += v[i].x * v[i].x + v[i].y * v[i].y + v[i].z * v[i].z + v[i].w * v[i].w; }
        if (r + nw < NB * SEQ) {
            const float* src = rowp(r + nw);
#pragma unroll
            for (int i = 0; i < 4; ++i) cur[i] = *(const float4*)(src + i * 256 + lane * 4);
        }
        ss = wave_sum(ss);
        const float rs = rsqrtf(ss * (1.0f / 1024.0f) + 1e-6f);
#pragma unroll
        for (int i = 0; i < 4; ++i) {
            float4 o; o.x = v[i].x * rs * g[i].x; o.y = v[i].y * rs * g[i].y; o.z = v[i].z * rs * g[i].z; o.w = v[i].w * rs * g[i].w;
            *(float4*)((float*)OUTB(p) + (size_t)r * DM + i * 256 + lane * 4) = o;
        }
    }
}


#define XB_TMO      128
#define XB_XCNT(j)  (256  + 64 * (j))
#define XB_XSUB(j)  (1280 + 64 * (j))
#define XB_XGEN(j)  (2304 + 64 * (j))
#define XB_TOP      3328
#define XB_TOPGEN   3392
#define XCD_BAR_WORDS 3456
#define XB_SPIN_CAP (1u << 22)
#define LAS __attribute__((address_space(3)))
__device__ __forceinline__ unsigned xb_ld(unsigned* p) { return __hip_atomic_load(p, __ATOMIC_RELAXED, __HIP_MEMORY_SCOPE_AGENT); }
__device__ __forceinline__ unsigned xb_add(unsigned* p, unsigned v) { return __hip_atomic_fetch_add(p, v, __ATOMIC_RELAXED, __HIP_MEMORY_SCOPE_AGENT); }
__device__ __forceinline__ unsigned xb_xcc_id() { return (unsigned)__builtin_amdgcn_s_getreg((3 << 11) | 20) & 0xFu; }
#define XB_SPIN(cond, bar) do { unsigned _sp = 0; while (cond) { __builtin_amdgcn_s_sleep(1); \
    if ((++_sp & 255u) == 0u) { if (xb_ld(&(bar)[XB_TMO])) break; if (_sp > XB_SPIN_CAP) { atomicAdd(&(bar)[XB_TMO], 1u); break; } } } } while (0)
struct XcdBarrier { unsigned* bar; unsigned x; volatile LAS unsigned* st; };
__device__ __forceinline__ XcdBarrier xcd_barrier_post(unsigned* bar, volatile LAS unsigned* st) {
    XcdBarrier b; b.bar = bar; b.x = xb_xcc_id(); b.st = st;
    if (threadIdx.x == 0) (void)xb_add(&bar[XB_XCNT(b.x)], 1u);
    return b;
}
__device__ __forceinline__ void xcd_barrier_complete(unsigned* bar, unsigned x, unsigned& nloc, unsigned& nx) {
    const unsigned G = gridDim.x * gridDim.y * gridDim.z;
    unsigned sum, cnt, mine, sp = 0u;
    for (;;) {
        sum = 0u; cnt = 0u; mine = 0u;
#pragma unroll
        for (unsigned j = 0; j < 16; ++j) { const unsigned c = xb_ld(&bar[XB_XCNT(j)]); sum += c; cnt += (c > 0u) ? 1u : 0u; mine = (j == x) ? c : mine; }
        if (sum == G) break;
        __builtin_amdgcn_s_sleep(1);
        if ((++sp & 255u) == 0u) { if (xb_ld(&bar[XB_TMO])) break; if (sp > XB_SPIN_CAP) { atomicAdd(&bar[XB_TMO], 1u); break; } }
    }
    nloc = mine > 0u ? mine : 1u; nx = cnt > 0u ? cnt : 1u;
}
__device__ __forceinline__ void xcd_barrier(const XcdBarrier& b) {
    asm volatile("s_waitcnt vmcnt(0)" ::: "memory");
    __syncthreads();
    if (threadIdx.x == 0) {
        unsigned* bar = b.bar;
        __builtin_amdgcn_s_waitcnt(0);
        unsigned nloc = b.st[0], nx = b.st[1];
        if (nloc == 0u) { xcd_barrier_complete(bar, b.x, nloc, nx); b.st[0] = nloc; b.st[1] = nx; }
        const unsigned old = xb_add(&bar[XB_XSUB(b.x)], 1u);
        const unsigned gen = old / nloc;
        if (old + 1u == (gen + 1u) * nloc) {
            __builtin_amdgcn_fence(__ATOMIC_RELEASE, "agent");
            asm volatile("s_waitcnt vmcnt(0)" ::: "memory");
            const unsigned og = xb_add(&bar[XB_TOP], 1u);
            const unsigned tg = og / nx;
            if (og + 1u == (tg + 1u) * nx) xb_add(&bar[XB_TOPGEN], 1u);
            else XB_SPIN(xb_ld(&bar[XB_TOPGEN]) == tg, bar);
            __builtin_amdgcn_fence(__ATOMIC_ACQUIRE, "agent");
            xb_add(&bar[XB_XGEN(b.x)], 1u);
            asm volatile("s_waitcnt vmcnt(0)" ::: "memory");
        } else {
            XB_SPIN(xb_ld(&bar[XB_XGEN(b.x)]) == gen, bar);
            __builtin_amdgcn_fence(__ATOMIC_ACQUIRE, "agent");
            asm volatile("s_waitcnt vmcnt(0)" ::: "memory");
        }
    }
    __syncthreads();
}

__global__ void __launch_bounds__(NTHR) fwd_megakernel(Params p) {
    extern __shared__ __attribute__((aligned(16))) unsigned char lds[];
    cg::grid_group grid = cg::this_grid();
    volatile LAS unsigned* xst = (volatile LAS unsigned*)(lds + LDS_BYTES - 32);
    if (threadIdx.x < 2) xst[threadIdx.x] = 0u;
    __syncthreads();
    const XcdBarrier xb = xcd_barrier_post((unsigned*)(p.ws + OFF_BAR), xst);
    if (p.out == nullptr) grid.sync();
#pragma unroll 1
    for (int step = 0; step < 18; ++step) {
        const int l = step >= 9 ? 1 : 0;
        const int ph = step - l * 9;
        switch (ph) {
        case 0:
            if (l == 0) phase_embed(p); else phase_rowstat(p);
            phase_convert<false>(p, l, lds);
            if (obid() == 0 && otid() < 24) ((int*)(WS(p) + OFF_CTL))[otid() * 32] = 0;
            if (obid() == 0 && otid() == 32) ((int*)(WS(p) + OFF_CTL))[800 + l * 32] = 0;
            break;
        case 1: phase_inproj(p, lds); break;
        case 2: phase_dsa_prep(p, l); phase_lr_prep(p, l); break;
        case 3: {
            if (obid() < NB * 16) phase_scan5(p, l, lds, obid());
            int* qctr = (int*)(WS(p) + OFF_CTL) + 800 + l * 32;
            int* qslot = (int*)(lds + LDS_BYTES - 16);
            for (;;) {
                __syncthreads();
                if (otid() == 0) *qslot = atomicAdd(qctr, 1);
                __syncthreads();
                const int item = *qslot;
                if (item >= 516 + NT / 32 + 3072) break;
                if (item < 516) phase_pool(p, l, lds, item, item + 1, 1);
                else if (item < 516 + NT / 32) phase_dsa<false>(p, l, lds, (bf16_t*)(OUTB(p) + DO_YC), nullptr, nullptr, item - 516, item - 515, 1);
                else {
                    const int ct = item - (516 + NT / 32);
                    const ConvJob cj = get_job_late(p, l, ct >> 10);
                    conv_tile(cj, ct & 1023, (float*)lds);
                }
            }
        } break;
        case 4: phase_merge(p, lds); break;
        case 5: phase_outproj(p, lds); break;
        case 6: phase_route(p, l, lds); break;
        case 7: phase_moe1(p, lds); break;
        default: phase_moe2(p, l, lds); break;
        }
        xcd_barrier(xb);
    }
    phase_final(p);
}

extern "C" void kernel_launch(void* const* d_in, const int* in_sizes, int n_in,
                              void* d_out, int out_size, void* d_ws, size_t ws_size,
                              hipStream_t stream) {
    static int grid_blocks = 0;
    if (grid_blocks == 0) {
        int dev = 0, cus = 0, per_cu = 0;
        (void)hipGetDevice(&dev);
        (void)hipDeviceGetAttribute(&cus, hipDeviceAttributeMultiprocessorCount, dev);
        (void)hipFuncSetAttribute((const void*)fwd_megakernel, hipFuncAttributeMaxDynamicSharedMemorySize, LDS_BYTES);
        (void)hipOccupancyMaxActiveBlocksPerMultiprocessor(&per_cu, fwd_megakernel, NTHR, LDS_BYTES);
        if (per_cu < 1 || cus < NB * 16 || (cus & 7) != 0 || n_in != 42 || ws_size < WS_END + (size_t)QS_WS * QS_BYTES || cus > QS_WS + QS_DO) { fprintf(stderr, "kernel_launch: bad config per_cu=%d n_in=%d ws=%zu need=%zu\n", per_cu, n_in, ws_size, (size_t)WS_END); grid_blocks = -1; }
        else grid_blocks = cus;
    }
    if (grid_blocks < 0) return;
    Params p{};
    for (int i = 0; i < 42; ++i) p.in[i] = (const float*)d_in[i];
    p.out = (float*)d_out;
    p.ws = (unsigned char*)d_ws;
    (void)hipMemsetAsync((unsigned char*)d_ws + OFF_BAR, 0, XCD_BAR_WORDS * 4, stream);
    void* args[] = {&p};
    hipError_t e = hipLaunchCooperativeKernel((void*)fwd_megakernel, dim3(grid_blocks), dim3(NTHR), args, LDS_BYTES, stream);
    if (e != hipSuccess) fprintf(stderr, "cooperative launch failed: %s (grid %d)\n", hipGetErrorString(e), grid_blocks);
}
```

```cpp
#include <hip/hip_runtime.h>
#include <hip/hip_cooperative_groups.h>
#include <cstdio>
#include <cstdint>
#include <type_traits>
namespace cg = cooperative_groups;

typedef unsigned short bf16_t;
typedef short bf16x8 __attribute__((ext_vector_type(8)));
typedef float f32x4 __attribute__((ext_vector_type(4)));

constexpr int NB = 8, SEQ = 2048, NMETA = 16, TS = 2064, DM = 1024;
constexpr int NT = NB * TS;
constexpr int NTP = 16640;
constexpr int NTHR = 512;
constexpr int CIN = 7912;
constexpr int NP1 = 4864;
constexpr int PM_LD = 768;
constexpr int PM_WD = 0, PM_AD = 64, PM_GD = 128, PM_VD = 256, PM_CQ = 288, PM_CKV = 544, PM_KROPE = 672, PM_KIDX = 704;
constexpr int LDS_BYTES = 157 * 1024;

constexpr size_t AL(size_t x) { return (x + 255) & ~(size_t)255; }
constexpr size_t SZ_ACT = (size_t)NTP * 1024 * 2;
constexpr size_t OFF_CTL = 0;
constexpr size_t OFF_BAR = 4096;
constexpr size_t OFF_RSTD = OFF_BAR + 16384;
constexpr size_t OFF_ROPE = OFF_RSTD + AL((size_t)NTP * 4);
constexpr size_t OFF_H = OFF_ROPE + AL((size_t)TS * 16 * 4 * 2);
constexpr size_t OFF_WB = OFF_H + SZ_ACT;
constexpr size_t WB_WIN = 0;
constexpr size_t WB_WG = WB_WIN + (size_t)NP1 * 1024;
constexpr size_t WB_PA = WB_WG + (size_t)3072 * 1024;
constexpr size_t WB_WO = WB_PA + (size_t)3 * 1024 * 1024;
constexpr size_t WB_POOL = WB_WO + (size_t)1024 * 1024;
constexpr size_t WB_QI = WB_POOL + (size_t)4 * 256 * 256;
constexpr size_t WB_UQ = WB_QI + (size_t)512 * 256;
constexpr size_t WB_UK = WB_UQ + (size_t)1536 * 256;
constexpr size_t WB_UV = WB_UK + (size_t)16 * 128 * 64;
constexpr size_t WB_WIDX = WB_UV + (size_t)16 * 64 * 128;
constexpr size_t WB_END = WB_WIDX + (size_t)64 * 1024;
constexpr size_t OFF_PPOOL = OFF_WB + AL(WB_END * 2);
constexpr size_t OFF_PK = OFF_PPOOL + SZ_ACT;
constexpr size_t OFF_PR = OFF_PK + SZ_ACT;
constexpr size_t OFF_PV = OFF_PR + SZ_ACT;
constexpr size_t OFF_PMISC = OFF_PV + SZ_ACT;
constexpr size_t OFF_VFIRST = OFF_PMISC + AL((size_t)NTP * PM_LD * 2);
constexpr size_t OFF_HALO = OFF_VFIRST + SZ_ACT;
constexpr size_t OFF_LIST = OFF_HALO + AL((size_t)130 * 16 * 1024 * 2);
constexpr size_t OFF_PW = OFF_LIST + AL((size_t)24 * NT * 4);
constexpr size_t WS_END = OFF_PW + AL((size_t)NT * 2 * 4);
constexpr size_t OFF_MERGED = OFF_PK;
constexpr size_t OFF_HM32 = OFF_PR;
constexpr size_t OFF_HN = OFF_PPOOL;
constexpr size_t OFF_WEXP = OFF_PMISC;
constexpr size_t WE_W1 = 0, WE_W3 = (size_t)16 * 256 * 1024, WE_W2 = (size_t)2 * 16 * 256 * 1024;
static_assert((size_t)3 * 16 * 256 * 1024 * 2 <= (size_t)NTP * PM_LD * 2, "expert weights must fit in Pmisc");
constexpr size_t DO_YC = 0;
constexpr size_t DO_CQN = DO_YC + SZ_ACT;
constexpr size_t DO_KV = DO_CQN + AL((size_t)NT * 256 * 2);
constexpr size_t DO_KIDX = DO_KV + AL((size_t)NT * 160 * 2);
constexpr size_t DO_WHEAD = DO_KIDX + AL((size_t)NT * 64 * 2);
constexpr size_t DO_ALR = DO_WHEAD + AL((size_t)NT * 8 * 4);
constexpr size_t DO_END = DO_ALR + AL((size_t)NT * 288 * 2);
constexpr size_t QS_BYTES = (size_t)16 * 16 * 160 * 2;
constexpr int QS_WS = (int)((277240096ull - WS_END) / QS_BYTES), QS_DO = (int)(((size_t)NB * SEQ * DM * 4 - DO_END) / QS_BYTES);
static_assert(QS_WS + QS_DO >= 256, "Q scratch");
constexpr size_t DO_HID = DO_YC;
static_assert(DO_END <= (size_t)NB * SEQ * DM * 4, "d_out scratch overflow");
static_assert((size_t)(129 + 24) * 128 * 512 * 2 <= SZ_ACT, "hid fits");
static_assert(WS_END <= 277240096ull, "workspace overflow");

struct Params {
    const float* in[42];
    float* out;
    unsigned char* ws;
};

__device__ __forceinline__ int otid() { int t = threadIdx.x; asm volatile("" : "+v"(t)); return t; }
__device__ __forceinline__ int obid() { int b = blockIdx.x; asm volatile("" : "+s"(b)); return b; }
typedef __attribute__((address_space(1))) unsigned char gas_uchar;
__device__ __forceinline__ unsigned char* WS(const Params& p) { gas_uchar* w = (gas_uchar*)p.ws; asm volatile("" : "+s"(w)); return (unsigned char*)w; }
__device__ __forceinline__ unsigned char* OUTB(const Params& p) { gas_uchar* w = (gas_uchar*)p.out; asm volatile("" : "+s"(w)); return (unsigned char*)w; }
__device__ __forceinline__ float bf2f(bf16_t v) { return __uint_as_float(((unsigned)v) << 16); }
typedef float f32x2v __attribute__((ext_vector_type(2)));
typedef __bf16 bf16x2v __attribute__((ext_vector_type(2)));
__device__ __forceinline__ unsigned pk2(float a, float b) { const f32x2v v = {a, b}; const bf16x2v r = __builtin_convertvector(v, bf16x2v); unsigned u; __builtin_memcpy(&u, &r, 4); return u; }
__device__ __forceinline__ bf16_t f2bf(float f) { const __bf16 h = (__bf16)f; bf16_t u; __builtin_memcpy(&u, &h, 2); return u; }
__device__ __forceinline__ float wave_sum(float v) {
#pragma unroll
    for (int o = 32; o > 0; o >>= 1) v += __shfl_xor(v, o);
    return v;
}
template <int CTRL> __device__ __forceinline__ float dpp_f(float x) {
    return __int_as_float(__builtin_amdgcn_update_dpp(0, __float_as_int(x), CTRL, 0xF, 0xF, true));
}
__device__ __forceinline__ float row16_sum(float v) {
    v += dpp_f<0xB1>(v);
    v += dpp_f<0x4E>(v);
    v += dpp_f<0x141>(v);
    v += dpp_f<0x140>(v);
    return v;
}
__device__ __forceinline__ void lds_barrier() { asm volatile("s_waitcnt lgkmcnt(0)" ::: "memory"); __builtin_amdgcn_s_barrier(); asm volatile("" ::: "memory"); }
__device__ __forceinline__ float fast_rcp(float x) { return __builtin_amdgcn_rcpf(x); }
__device__ __forceinline__ float fast_sigmoid(float x) { return fast_rcp(1.0f + __expf(-x)); }
__device__ __forceinline__ float fast_tanh(float x) { return 1.0f - 2.0f * fast_rcp(1.0f + __expf(2.0f * x)); }
__device__ __forceinline__ void row16_sum4(float& a, float& b, float& c, float& d) {
    asm volatile(
        "s_nop 1\n\t"
        "v_add_f32_dpp %0, %0, %0 quad_perm:[1,0,3,2] row_mask:0xf bank_mask:0xf\n\t"
        "v_add_f32_dpp %1, %1, %1 quad_perm:[1,0,3,2] row_mask:0xf bank_mask:0xf\n\t"
        "v_add_f32_dpp %2, %2, %2 quad_perm:[1,0,3,2] row_mask:0xf bank_mask:0xf\n\t"
        "v_add_f32_dpp %3, %3, %3 quad_perm:[1,0,3,2] row_mask:0xf bank_mask:0xf\n\t"
        "v_add_f32_dpp %0, %0, %0 quad_perm:[2,3,0,1] row_mask:0xf bank_mask:0xf\n\t"
        "v_add_f32_dpp %1, %1, %1 quad_perm:[2,3,0,1] row_mask:0xf bank_mask:0xf\n\t"
        "v_add_f32_dpp %2, %2, %2 quad_perm:[2,3,0,1] row_mask:0xf bank_mask:0xf\n\t"
        "v_add_f32_dpp %3, %3, %3 quad_perm:[2,3,0,1] row_mask:0xf bank_mask:0xf\n\t"
        "v_add_f32_dpp %0, %0, %0 row_half_mirror row_mask:0xf bank_mask:0xf\n\t"
        "v_add_f32_dpp %1, %1, %1 row_half_mirror row_mask:0xf bank_mask:0xf\n\t"
        "v_add_f32_dpp %2, %2, %2 row_half_mirror row_mask:0xf bank_mask:0xf\n\t"
        "v_add_f32_dpp %3, %3, %3 row_half_mirror row_mask:0xf bank_mask:0xf\n\t"
        "v_add_f32_dpp %0, %0, %0 row_mirror row_mask:0xf bank_mask:0xf\n\t"
        "v_add_f32_dpp %1, %1, %1 row_mirror row_mask:0xf bank_mask:0xf\n\t"
        "v_add_f32_dpp %2, %2, %2 row_mirror row_mask:0xf bank_mask:0xf\n\t"
        "v_add_f32_dpp %3, %3, %3 row_mirror row_mask:0xf bank_mask:0xf\n\t"
        "s_nop 1"
        : "+v"(a), "+v"(b), "+v"(c), "+v"(d));
}
__device__ __forceinline__ void row8_sum2(float& a, float& b) {
    asm volatile(
        "s_nop 1\n\t"
        "v_add_f32_dpp %0, %0, %0 quad_perm:[1,0,3,2] row_mask:0xf bank_mask:0xf\n\t"
        "v_add_f32_dpp %1, %1, %1 quad_perm:[1,0,3,2] row_mask:0xf bank_mask:0xf\n\t"
        "s_nop 0\n\t"
        "v_add_f32_dpp %0, %0, %0 quad_perm:[2,3,0,1] row_mask:0xf bank_mask:0xf\n\t"
        "v_add_f32_dpp %1, %1, %1 quad_perm:[2,3,0,1] row_mask:0xf bank_mask:0xf\n\t"
        "s_nop 0\n\t"
        "v_add_f32_dpp %0, %0, %0 row_half_mirror row_mask:0xf bank_mask:0xf\n\t"
        "v_add_f32_dpp %1, %1, %1 row_half_mirror row_mask:0xf bank_mask:0xf\n\t"
        "s_nop 1"
        : "+v"(a), "+v"(b));
}
__device__ __forceinline__ float wave_sum_fast(float v) { v = row16_sum(v); v += __shfl_xor(v, 16); v += __shfl_xor(v, 32); return v; }
__device__ __forceinline__ float sigmoidf_(float x) { return 1.0f / (1.0f + __expf(-x)); }
__device__ __forceinline__ float softplusf_(float z) { return fmaxf(z, 0.f) + log1pf(__expf(-fabsf(z))); }
__device__ __forceinline__ void glds16(const void* g, void* l) {
    __builtin_amdgcn_global_load_lds((const unsigned*)g, (unsigned*)l, 16, 0, 0);
}

__device__ void phase_embed(const Params& p) {
    const int lane = otid() & 63;
    const int wave = (obid() * NTHR + otid()) >> 6, nw = gridDim.x * NTHR / 64;
    bf16_t* h = (bf16_t*)(WS(p) + OFF_H);
    float* rstd = (float*)(WS(p) + OFF_RSTD);
    auto srcrow = [&](int n) { const int b = n / TS, t = n % TS; return t < NMETA ? p.in[1] + (size_t)t * DM : p.in[0] + ((size_t)b * SEQ + (t - NMETA)) * DM; };
    float4 cur[4];
    if (wave < NT) {
        const float* src = srcrow(wave);
#pragma unroll
        for (int i = 0; i < 4; ++i) cur[i] = *(const float4*)(src + i * 256 + lane * 4);
    }
    for (int n = wave; n < NTP; n += nw) {
        if (n < NT) {
            float4 v[4];
#pragma unroll
            for (int i = 0; i < 4; ++i) v[i] = cur[i];
            if (n + nw < NT) {
                const float* src = srcrow(n + nw);
#pragma unroll
                for (int i = 0; i < 4; ++i) cur[i] = *(const float4*)(src + i * 256 + lane * 4);
            }
            float ss = 0.f;
#pragma unroll
            for (int i = 0; i < 4; ++i) {
                ss += v[i].x * v[i].x + v[i].y * v[i].y + v[i].z * v[i].z + v[i].w * v[i].w;
                *(uint2*)(h + (size_t)n * DM + i * 256 + lane * 4) = make_uint2(pk2(v[i].x, v[i].y), pk2(v[i].z, v[i].w));
            }
            ss = wave_sum(ss);
            if (lane == 0) rstd[n] = rsqrtf(ss * (1.0f / 1024.0f) + 1e-6f);
        } else {
#pragma unroll
            for (int i = 0; i < 4; ++i) *(ushort4*)(h + (size_t)n * DM + i * 256 + lane * 4) = make_ushort4(0, 0, 0, 0);
            if (lane == 0) rstd[n] = 0.f;
        }
    }
    float* ctab = (float*)(WS(p) + OFF_ROPE);
    float* stab = ctab + TS * 16;
    for (int idx = obid() * NTHR + otid(); idx < TS * 16; idx += gridDim.x * NTHR) {
        const int t = idx >> 4, i = idx & 15;
        const float inv = powf(10000.0f, -(float)(2 * i) / 32.0f);
        const float ang = (float)t * inv;
        ctab[idx] = cosf(ang);
        stab[idx] = sinf(ang);
    }
}

__device__ void phase_rowstat(const Params& p) {
    const int lane = otid() & 63;
    const int wave = (obid() * NTHR + otid()) >> 6, nw = gridDim.x * NTHR / 64;
    const bf16_t* hb = (const bf16_t*)(WS(p) + OFF_H);
    float* rstd = (float*)(WS(p) + OFF_RSTD);
    uint4 cur[2];
    if (wave < NT) { cur[0] = *(const uint4*)(hb + (size_t)wave * DM + lane * 8); cur[1] = *(const uint4*)(hb + (size_t)wave * DM + 512 + lane * 8); }
    for (int n = wave; n < NT; n += nw) {
        float ss = 0.f;
#pragma unroll
        for (int i = 0; i < 2; ++i) {
            const unsigned w_[4] = {cur[i].x, cur[i].y, cur[i].z, cur[i].w};
#pragma unroll
            for (int j = 0; j < 4; ++j) { const float a_ = __uint_as_float(w_[j] << 16), b_ = __uint_as_float(w_[j] & 0xFFFF0000u); ss += a_ * a_ + b_ * b_; }
        }
        if (n + nw < NT) { cur[0] = *(const uint4*)(hb + (size_t)(n + nw) * DM + lane * 8); cur[1] = *(const uint4*)(hb + (size_t)(n + nw) * DM + 512 + lane * 8); }
        ss = wave_sum(ss);
        if (lane == 0) rstd[n] = rsqrtf(ss * (1.0f / 1024.0f) + 1e-6f);
    }
}

struct ConvJob { const float* src; bf16_t* dst; const float* scale; int ldsrc, K, nvalid, nrows, nb, notr; size_t sbs, dbs; const float* srcB; int ldB, split; };
__device__ __forceinline__ int conv_job_tiles(const ConvJob& j) { return j.nb * (j.nrows >> 6) * (j.K >> 6); }
__device__ void conv_tile(const ConvJob& j, int tile, float* lds) {
    const int per = (j.nrows >> 6) * (j.K >> 6);
    const int bi = tile / per, rem = tile % per;
    const int ktiles = j.K >> 6;
    const int n0 = (rem / ktiles) << 6, k0 = (rem % ktiles) << 6;
    const int tid = otid(), tn = tid & 63, tk = tid >> 6;
    const float* src = j.src + (size_t)bi * j.sbs;
    bf16_t* dst = j.dst + (size_t)bi * j.dbs;
#pragma unroll
    for (int kk = 0; kk < 8; ++kk) {
        const int k = k0 + tk * 8 + kk;
        float v = 0.f;
        if (n0 + tn < j.nvalid) {
            if (j.split) { const int nn = n0 + tn; v = (nn < j.split) ? (j.src ? j.src[(size_t)k * j.ldsrc + nn] : 0.f) : j.srcB[(size_t)k * j.ldB + (nn - j.split)]; }
            else v = j.notr ? src[(size_t)(n0 + tn) * j.ldsrc + k] : src[(size_t)k * j.ldsrc + n0 + tn];
            if (j.scale) v *= j.scale[k];
        }
        lds[tn * 65 + tk * 8 + kk] = v;
    }
    __syncthreads();
    const int wn = tid >> 3, kq = tid & 7;
    uint4 o;
    unsigned w[4];
#pragma unroll
    for (int q = 0; q < 4; ++q) {
        const float lo = lds[wn * 65 + kq * 8 + 2 * q], hi = lds[wn * 65 + kq * 8 + 2 * q + 1];
        w[q] = pk2(lo, hi);
    }
    o.x = w[0]; o.y = w[1]; o.z = w[2]; o.w = w[3];
    *(uint4*)(dst + (size_t)(n0 + wn) * j.K + k0 + kq * 8) = o;
    __syncthreads();
}
__device__ ConvJob get_job_early(const Params& p, int l, int ji) {
    bf16_t* wb = (bf16_t*)(WS(p) + OFF_WB);
    const float* win = p.in[3] + (size_t)l * DM * CIN;
    const float* nm = p.in[2] + (size_t)l * DM;
    ConvJob j{}; j.nb = 1; j.sbs = 0; j.dbs = 0; j.K = 1024; j.ldsrc = CIN; j.scale = nm;
    switch (ji) {
    case 0: j.src = win + 3072; j.dst = wb + WB_WIN; j.nvalid = 4352; j.nrows = 4352; break;
    case 1: j.src = (l == 0 ? nullptr : p.in[17]); j.ldsrc = 32; j.split = 32; j.srcB = win + 7424; j.ldB = CIN; j.dst = wb + WB_WIN + (size_t)(4096 + PM_VD) * 1024; j.nvalid = 512; j.nrows = 512; break;
    case 2: j.src = win + 7904; j.dst = wb + WB_WIDX; j.nvalid = 8; j.nrows = 64; break;
    case 3: j.src = win; j.dst = wb + WB_WG; j.nvalid = 3072; j.nrows = 3072; break;
    case 4: j.src = p.in[29] + (size_t)l * DM * DM; j.ldsrc = 1024; j.scale = nullptr; j.dst = wb + WB_PA; j.nvalid = 1024; j.nrows = 1024; break;
    case 5: j.src = p.in[30] + (size_t)l * DM * DM; j.ldsrc = 1024; j.scale = nullptr; j.dst = wb + WB_PA + (size_t)1024 * 1024; j.nvalid = 1024; j.nrows = 1024; break;
    case 6: j.src = p.in[31] + (size_t)l * DM * DM; j.ldsrc = 1024; j.scale = nullptr; j.dst = wb + WB_PA + (size_t)2 * 1024 * 1024; j.nvalid = 1024; j.nrows = 1024; break;
    case 7: j.src = p.in[32] + (size_t)l * DM * DM; j.ldsrc = 1024; j.scale = nullptr; j.dst = wb + WB_WO; j.nvalid = 1024; j.nrows = 1024; break;
    case 8: j.src = p.in[5] + (size_t)l * 4 * 256 * 256; j.ldsrc = 256; j.K = 256; j.scale = nullptr; j.dst = wb + WB_POOL; j.nvalid = 256; j.nrows = 256; j.nb = 4; j.sbs = 65536; j.dbs = 65536; break;
    case 9: j.src = p.in[26] + (size_t)l * 256 * 512; j.ldsrc = 512; j.K = 256; j.scale = nullptr; j.dst = wb + WB_QI; j.nvalid = 512; j.nrows = 512; break;
    case 10: j.src = p.in[23] + (size_t)l * 256 * 1536; j.ldsrc = 1536; j.K = 256; j.scale = nullptr; j.dst = wb + WB_UQ; j.nvalid = 1536; j.nrows = 1536; break;
    case 11: j.src = p.in[24] + (size_t)l * 16 * 128 * 64; j.ldsrc = 64; j.K = 64; j.scale = nullptr; j.dst = wb + WB_UK; j.nvalid = 2048; j.nrows = 2048; j.notr = 1; break;
    default: j.src = p.in[25] + (size_t)l * 16 * 128 * 64; j.ldsrc = 64; j.K = 128; j.scale = nullptr; j.dst = wb + WB_UV; j.nvalid = 64; j.nrows = 64; j.nb = 16; j.sbs = 8192; j.dbs = 8192; break;
    }
    return j;
}
__device__ ConvJob get_job_late(const Params& p, int l, int ji) {
    bf16_t* we = (bf16_t*)(WS(p) + OFF_WEXP);
    ConvJob j{}; j.nb = 16; j.scale = nullptr; j.sbs = 262144; j.dbs = 262144;
    switch (ji) {
    case 0: j.src = p.in[38] + (size_t)l * 16 * 262144; j.dst = we + WE_W1; j.ldsrc = 256; j.K = 1024; j.nvalid = 256; j.nrows = 256; break;
    case 1: j.src = p.in[39] + (size_t)l * 16 * 262144; j.dst = we + WE_W3; j.ldsrc = 256; j.K = 1024; j.nvalid = 256; j.nrows = 256; break;
    default: j.src = p.in[40] + (size_t)l * 16 * 262144; j.dst = we + WE_W2; j.ldsrc = 1024; j.K = 256; j.nvalid = 1024; j.nrows = 1024; break;
    }
    return j;
}
template <bool LATE>
__device__ void phase_convert(const Params& p, int l, unsigned char* lds) {
    const int njobs = LATE ? 3 : 13;
    int base = 0;
    for (int ji = 0; ji < njobs; ++ji) {
        const ConvJob j = LATE ? get_job_late(p, l, ji) : get_job_early(p, l, ji);
        const int nt = conv_job_tiles(j);
        int first = ((int)obid() - base) % (int)gridDim.x; if (first < 0) first += gridDim.x;
        for (int t = first; t < nt; t += gridDim.x) conv_tile(j, t, (float*)lds);
        base += nt;
    }
}

template <int BM> struct G3 {
    static constexpr int MI = BM / 64;
    static constexpr int NA = BM / 64;
    static constexpr int STAGE = BM * 128 + 128 * 128;
    const bf16_t* ap[NA];
    const bf16_t* bp[2];
};
template <int BM>
__device__ __forceinline__ void g3_issue(const G3<BM>& g, int kt, unsigned char* stage, int tid) {
#pragma unroll
    for (int i = 0; i < G3<BM>::NA; ++i) glds16(g.ap[i] + kt * 64, stage + (tid + i * NTHR) * 16);
#pragma unroll
    for (int i = 0; i < 2; ++i) glds16(g.bp[i] + kt * 64, stage + BM * 128 + (tid + i * NTHR) * 16);
}
template <int BM, class FA, class FB>
__device__ __forceinline__ void g3_setup(G3<BM>& g, FA rowptr, FB bcol, int tid) {
#pragma unroll
    for (int i = 0; i < G3<BM>::NA; ++i) { const int idx = tid + i * NTHR, row = idx >> 3, sl = (idx & 7) ^ (row & 7); g.ap[i] = rowptr(row) + sl * 8; }
#pragma unroll
    for (int i = 0; i < 2; ++i) { const int idx = tid + i * NTHR, row = idx >> 3, sl = (idx & 7) ^ (row & 7); g.bp[i] = bcol(row) + sl * 8; }
}
template <int BM>
__device__ __forceinline__ void g3_kloop(f32x4 (&acc)[BM / 64][4], const G3<BM>& g, int K, unsigned char* lds) {
    constexpr int MI = G3<BM>::MI, STAGE = G3<BM>::STAGE, NL = G3<BM>::NA + 2;
    const int tid = otid(), lane = tid & 63, wid = tid >> 6, wr = wid >> 1, wc = wid & 1, fr = lane & 15, fq = lane >> 4;
    const int nk = K >> 6;
    g3_issue<BM>(g, 0, lds, tid);
    if (nk > 1) g3_issue<BM>(g, 1, lds + STAGE, tid);
    int cur = 0;
#pragma unroll 1
    for (int t = 0; t < nk; ++t) {
        if (t + 1 < nk) { if (NL == 6) asm volatile("s_waitcnt vmcnt(6)" ::: "memory"); else if (NL == 5) asm volatile("s_waitcnt vmcnt(5)" ::: "memory"); else asm volatile("s_waitcnt vmcnt(4)" ::: "memory"); }
        else asm volatile("s_waitcnt vmcnt(0)" ::: "memory");
        __builtin_amdgcn_s_barrier();
        if (t + 2 < nk) { int nx = cur + 2; if (nx >= 3) nx -= 3; g3_issue<BM>(g, t + 2, lds + nx * STAGE, tid); }
        const unsigned char* cA = lds + cur * STAGE;
        const unsigned char* cB = cA + BM * 128;
#pragma unroll
        for (int ks = 0; ks < 2; ++ks) {
            bf16x8 a[MI], b[4];
#pragma unroll
            for (int m = 0; m < MI; ++m) { const int row = wr * (BM / 4) + m * 16 + fr; a[m] = *(const bf16x8*)(cA + row * 128 + (((ks * 4 + fq) ^ (row & 7)) << 4)); }
#pragma unroll
            for (int n = 0; n < 4; ++n) { const int row = wc * 64 + n * 16 + fr; b[n] = *(const bf16x8*)(cB + row * 128 + (((ks * 4 + fq) ^ (row & 7)) << 4)); }
#pragma unroll
            for (int m = 0; m < MI; ++m)
#pragma unroll
                for (int n = 0; n < 4; ++n) acc[m][n] = __builtin_amdgcn_mfma_f32_16x16x32_bf16(b[n], a[m], acc[m][n], 0, 0, 0);
        }
        cur = (cur == 2) ? 0 : cur + 1;
    }
    __builtin_amdgcn_s_barrier();
}
struct G3D { const bf16_t* ap[2]; const bf16_t* b1[2]; const bf16_t* b3[2]; };
__device__ __forceinline__ void g3d_issue(const G3D& g, int kt, unsigned char* stage, int tid) {
#pragma unroll
    for (int i = 0; i < 2; ++i) glds16(g.ap[i] + kt * 64, stage + (tid + i * NTHR) * 16);
#pragma unroll
    for (int i = 0; i < 2; ++i) glds16(g.b1[i] + kt * 64, stage + 16384 + (tid + i * NTHR) * 16);
#pragma unroll
    for (int i = 0; i < 2; ++i) glds16(g.b3[i] + kt * 64, stage + 32768 + (tid + i * NTHR) * 16);
}
__device__ __forceinline__ void g3d_kloop(f32x4 (&acc1)[2][4], f32x4 (&acc3)[2][4], const G3D& g, int K, unsigned char* lds) {
    constexpr int STAGE = 49152;
    const int tid = otid(), lane = tid & 63, wid = tid >> 6, wr = wid >> 1, wc = wid & 1, fr = lane & 15, fq = lane >> 4;
    const int nk = K >> 6;
    g3d_issue(g, 0, lds, tid);
    if (nk > 1) g3d_issue(g, 1, lds + STAGE, tid);
    int cur = 0;
#pragma unroll 1
    for (int t = 0; t < nk; ++t) {
        if (t + 1 < nk) asm volatile("s_waitcnt vmcnt(6)" ::: "memory"); else asm volatile("s_waitcnt vmcnt(0)" ::: "memory");
        __builtin_amdgcn_s_barrier();
        if (t + 2 < nk) { int nx = cur + 2; if (nx >= 3) nx -= 3; g3d_issue(g, t + 2, lds + nx * STAGE, tid); }
        const unsigned char* cA = lds + cur * STAGE;
#pragma unroll
        for (int ks = 0; ks < 2; ++ks) {
            bf16x8 a[2], b1[4], b3[4];
#pragma unroll
            for (int m = 0; m < 2; ++m) { const int row = wr * 32 + m * 16 + fr; a[m] = *(const bf16x8*)(cA + row * 128 + (((ks * 4 + fq) ^ (row & 7)) << 4)); }
#pragma unroll
            for (int n = 0; n < 4; ++n) { const int row = wc * 64 + n * 16 + fr; const int off = row * 128 + (((ks * 4 + fq) ^ (row & 7)) << 4);
                b1[n] = *(const bf16x8*)(cA + 16384 + off); b3[n] = *(const bf16x8*)(cA + 32768 + off); }
#pragma unroll
            for (int m = 0; m < 2; ++m)
#pragma unroll
                for (int n = 0; n < 4; ++n) {
                    acc1[m][n] = __builtin_amdgcn_mfma_f32_16x16x32_bf16(b1[n], a[m], acc1[m][n], 0, 0, 0);
                    acc3[m][n] = __builtin_amdgcn_mfma_f32_16x16x32_bf16(b3[n], a[m], acc3[m][n], 0, 0, 0);
                }
        }
        cur = (cur == 2) ? 0 : cur + 1;
    }
    __builtin_amdgcn_s_barrier();
}
template <int MI>
__device__ __forceinline__ void g3_zero(f32x4 (&acc)[MI][4]) {
#pragma unroll
    for (int m = 0; m < MI; ++m)
#pragma unroll
        for (int n = 0; n < 4; ++n) acc[m][n] = (f32x4){0.f, 0.f, 0.f, 0.f};
}
__device__ __forceinline__ uint2 pack4(float a, float b, float c, float d) {
    uint2 r; r.x = pk2(a, b); r.y = pk2(c, d); return r;
}

namespace pg8 {
#define PG8_LAS __attribute__((address_space(3)))
typedef unsigned short bf16_t;
typedef short bf16x8 __attribute__((ext_vector_type(8)));
typedef float f32x4 __attribute__((ext_vector_type(4)));
typedef unsigned u32x4 __attribute__((ext_vector_type(4)));
constexpr int BM = 256, BK = 64, HALF = 128, HTB = HALF * BK * 2  , STAGE_BYTES = 8 * HTB, NXCD = 8, WGM = 8;

__host__ __device__ __forceinline__ int lds_byte(int r, int c) { const int st = (r >> 4) * 2 + (c >> 5), rr = r & 15, cc = c & 31, ob = rr * 64 + cc * 2; return st * 1024 + (ob ^ (((ob >> 9) & 1) << 5)); }
__host__ __device__ __forceinline__ void stage_rc(int b, int& R, int& C) { const int st = b / 1024, sb = b % 1024, swz = sb ^ (((sb >> 9) & 1) << 5); R = (st >> 1) * 16 + swz / 64; C = (st & 1) * 32 + (swz % 64) / 2; }
__host__ __device__ __forceinline__ int perm32(int rho) { const int n = rho >> 4, i = rho & 15; return 8 * (i >> 2) + 4 * n + (i & 3); }

struct Unit { int pm, pn; };
struct Gemm { const bf16_t* A; const bf16_t* Bt; int M, N, K; };

struct StaticOrder {
    int nM, nN, nwg, G, c;
    __host__ __device__ void init(int M, int N, int G_, int c_) { nM = M / BM; nN = N / BM; nwg = nM * nN; G = G_; c = c_; }
    __host__ __device__ bool next(int i, Unit& u) const {
        const long L = (long)i * G + c; if (L >= nwg) return false;
        int wgid = (int)L; { const int q = nwg / NXCD, r = nwg % NXCD, xcd = wgid % NXCD, off = wgid / NXCD; wgid = (xcd < r ? xcd * (q + 1) : r * (q + 1) + (xcd - r) * q) + off; }
        const int nig = WGM * nN, gid = wgid / nig, fm = gid * WGM, gsz = (nM - fm) < WGM ? (nM - fm) : WGM;
        u.pm = fm + ((wgid % nig) % gsz); u.pn = (wgid % nig) / gsz; return true;
    }
    __device__ __forceinline__ void a_ready(const Unit&) const {}
    __device__ __forceinline__ void done(const Unit&) const {}
};
template <class Epi, class Sched, bool STAMP = false>
__device__ __forceinline__ void gemm_phase(PG8_LAS unsigned char* lds, const Gemm g, const Sched& S, const Epi& E, unsigned long long* stamps) {
    const int tid = otid(), wid = __builtin_amdgcn_readfirstlane(tid >> 6), lane = tid & 63, wr = wid >> 2, wc = wid & 3, fr = lane & 15, fq = lane >> 4;
    const int K = g.K, nt = K / BK;
    int ts_lo = 0, ts_hi = 0, nts = 0; const unsigned long long rt_entry = STAMP ? 0ull : 0ull;
#define PG8_STAMP() do { if (STAMP && wid == 0 && nts < 64) { const unsigned long long _c = 0ull; \
        ts_lo = (lane == nts) ? (int)(unsigned)_c : ts_lo; ts_hi = (lane == nts) ? (int)(unsigned)(_c >> 32) : ts_hi; ++nts; } } while (0)
    PG8_STAMP();
    unsigned voffA[2], voffB[2];
#pragma unroll
    for (int i = 0; i < 2; ++i) { int R, C; stage_rc(tid * 16 + i * 8192, R, C); const int Rb = Epi::PERM ? ((R & ~31) + perm32(R & 31)) : R;
        voffA[i] = (unsigned)(R * K + C) * 2u; voffB[i] = (unsigned)(Rb * K + C) * 2u; }
    const size_t kstep = (size_t)(BK * 2);
    const size_t hstep = (size_t)HALF * K * 2;
    const size_t tstep = 2 * hstep;
    const unsigned ldsw = (unsigned)wid * 1024u;
    const int aoff = lds_byte(wr * 64 + fr, fq * 8), boff = lds_byte(wc * 32 + fr, fq * 8);
#define PG8_SA(b, h) (((b) * 2 + (h)) * HTB)
#define PG8_SB(b, h) ((4 + (b) * 2 + (h)) * HTB)
#define PG8_STAGE(bufoff, gbase, voff) do { _Pragma("unroll") for (int _i = 0; _i < 2; ++_i) \
        __builtin_amdgcn_global_load_lds((const unsigned*)((const char*)(gbase) + (voff)[_i]), (PG8_LAS unsigned*)(lds + (bufoff) + ldsw + _i * 8192), 16, 0, 0); } while (0)
#define PG8_LDA(dst, b, h) do { _Pragma("unroll") for (int m = 0; m < 4; ++m) _Pragma("unroll") for (int k = 0; k < 2; ++k) dst[m][k] = *(const PG8_LAS bf16x8*)(lds + PG8_SA(b, h) + aoff + m * 2048 + k * 1024); } while (0)
#define PG8_LDB(dst, b, h) do { _Pragma("unroll") for (int n = 0; n < 2; ++n) _Pragma("unroll") for (int k = 0; k < 2; ++k) dst[n][k] = *(const PG8_LAS bf16x8*)(lds + PG8_SB(b, h) + boff + n * 2048 + k * 1024); } while (0)
#define PG8_MMA(ai, bj, At, Bt) do { __builtin_amdgcn_s_setprio(1); _Pragma("unroll") for (int m = 0; m < 4; ++m) _Pragma("unroll") for (int n = 0; n < 2; ++n) _Pragma("unroll") for (int k = 0; k < 2; ++k) \
        acc[ai][bj][m][n] = __builtin_amdgcn_mfma_f32_16x16x32_bf16(Bt[n][k], At[m][k], acc[ai][bj][m][n], 0, 0, 0); __builtin_amdgcn_s_setprio(0); } while (0)
#define PG8_WAIT_V(n) asm volatile("s_waitcnt vmcnt(" #n ")" ::: "memory")
#define PG8_WAIT_L(n) asm volatile("s_waitcnt lgkmcnt(" #n ")" ::: "memory")
#define PG8_BAR __builtin_amdgcn_s_barrier()
#define PG8_SCHED __builtin_amdgcn_sched_barrier(0)
    Unit cur, nxt; int ui = 0;
    if (!S.next(0, cur)) return;
    f32x4 acc[2][2][4][2];
#pragma unroll
    for (int a = 0; a < 2; ++a)
#pragma unroll
        for (int b = 0; b < 2; ++b)
#pragma unroll
            for (int m = 0; m < 4; ++m)
#pragma unroll
                for (int n = 0; n < 2; ++n) acc[a][b][m][n] = (f32x4){0.f, 0.f, 0.f, 0.f};
    bf16x8 At[4][2], B0[2][2], B1[2][2];
    const char* cA = (const char*)g.A + (size_t)cur.pm * tstep; const char* cB = (const char*)g.Bt + (size_t)cur.pn * tstep;
    S.a_ready(cur);
    PG8_STAGE(PG8_SB(0, 0), cB, voffB); PG8_STAGE(PG8_SA(0, 0), cA, voffA); PG8_STAGE(PG8_SB(0, 1), cB + hstep, voffB); PG8_STAGE(PG8_SA(0, 1), cA + hstep, voffA);
    if (wr == 1) PG8_BAR;
    PG8_WAIT_V(4); PG8_BAR;
    PG8_STAGE(PG8_SB(1, 0), cB + kstep, voffB); PG8_STAGE(PG8_SA(1, 0), cA + kstep, voffA); PG8_STAGE(PG8_SB(1, 1), cB + hstep + kstep, voffB);
    PG8_WAIT_V(6); PG8_BAR;
    PG8_STAMP();
    for (;;) {
        const bool has_next = S.next(ui + 1, nxt);
        const char* nA = has_next ? (const char*)g.A + (size_t)nxt.pm * tstep : cA; const char* nB = has_next ? (const char*)g.Bt + (size_t)nxt.pn * tstep : cB;
        for (int t = 0; t < nt; t += 2) {
            const bool last = (t == nt - 2);
            const char* a1 = cA + (size_t)(t + 1) * kstep;
            const char* a2 = last ? nA : cA + (size_t)(t + 2) * kstep; const char* b2 = last ? nB : cB + (size_t)(t + 2) * kstep;
            const char* a3 = a2 + kstep; const char* b3 = b2 + kstep;
            if (last && has_next) S.a_ready(nxt);
            PG8_LDB(B0, 0, 0); PG8_SCHED; PG8_LDA(At, 0, 0); PG8_STAGE(PG8_SA(1, 1), a1 + hstep, voffA);
            PG8_WAIT_L(8); PG8_BAR; PG8_WAIT_L(0); PG8_MMA(0, 0, At, B0); PG8_BAR; PG8_SCHED;
            PG8_LDB(B1, 0, 1); PG8_STAGE(PG8_SB(0, 0), b2, voffB);
            PG8_BAR; PG8_WAIT_L(0); PG8_MMA(0, 1, At, B1); PG8_BAR;
            PG8_LDA(At, 0, 1); PG8_STAGE(PG8_SA(0, 0), a2, voffA);
            PG8_BAR; PG8_WAIT_L(0); PG8_MMA(1, 0, At, B0); PG8_BAR; PG8_SCHED;
            PG8_STAGE(PG8_SB(0, 1), b2 + hstep, voffB);
            PG8_WAIT_V(6); PG8_BAR; PG8_MMA(1, 1, At, B1); PG8_BAR;
            PG8_LDB(B0, 1, 0); PG8_SCHED; PG8_LDA(At, 1, 0); PG8_STAGE(PG8_SA(0, 1), a2 + hstep, voffA);
            PG8_WAIT_L(8); PG8_BAR; PG8_WAIT_L(0); PG8_MMA(0, 0, At, B0); PG8_BAR; PG8_SCHED;
            PG8_LDB(B1, 1, 1); PG8_STAGE(PG8_SB(1, 0), b3, voffB);
            PG8_BAR; PG8_WAIT_L(0); PG8_MMA(0, 1, At, B1); PG8_BAR;
            PG8_LDA(At, 1, 1); PG8_STAGE(PG8_SA(1, 0), a3, voffA);
            PG8_BAR; PG8_WAIT_L(0); PG8_MMA(1, 0, At, B0); PG8_BAR; PG8_SCHED;
            PG8_STAGE(PG8_SB(1, 1), b3 + hstep, voffB);
            PG8_WAIT_V(6); PG8_BAR; PG8_MMA(1, 1, At, B1); PG8_BAR;
        }
        PG8_STAMP();
        if constexpr (!Epi::AFTER_DRAIN) { E(acc, cur, wr, wc, fr, fq); S.done(cur); }
        PG8_STAMP();
        if (!has_next) break;
#pragma unroll
        for (int a = 0; a < 2; ++a)
#pragma unroll
            for (int b = 0; b < 2; ++b)
#pragma unroll
                for (int m = 0; m < 4; ++m)
#pragma unroll
                    for (int n = 0; n < 2; ++n) acc[a][b][m][n] = (f32x4){0.f, 0.f, 0.f, 0.f};
        cur = nxt; cA = nA; cB = nB; ++ui;
    }
    PG8_WAIT_V(0);
    if (wr == 0) PG8_BAR;
    PG8_BAR;
    if constexpr (Epi::AFTER_DRAIN) { E.fused(acc, cur, wr, wc, fr, fq, lds, wid, lane); S.done(cur); }
    PG8_STAMP();
    if (STAMP && wid == 0) { stamps[lane] = lane < nts ? (((unsigned long long)(unsigned)ts_hi << 32) | (unsigned)ts_lo) : 0ull;
        if (lane == 62) stamps[62] = rt_entry; if (lane == 63) stamps[63] = 0ull; }
#undef PG8_STAMP
#undef PG8_SA
#undef PG8_SB
#undef PG8_STAGE
#undef PG8_LDA
#undef PG8_LDB
#undef PG8_MMA
#undef PG8_WAIT_V
#undef PG8_WAIT_L
#undef PG8_BAR
#undef PG8_SCHED
}
}

struct EpiInproj {
    static constexpr bool PERM = true, AFTER_DRAIN = false;
    unsigned char* ws; const float* rstd;
    __device__ __forceinline__ void operator()(const pg8::f32x4 (&acc)[2][2][4][2], const pg8::Unit& u, int wr, int wc, int fr, int fq) const {
        const int pn = u.pn;
        bf16_t* dst; int ld, cb;
        if (pn < 4) { dst = (bf16_t*)(ws + OFF_PPOOL); ld = 1024; cb = pn * 256; }
        else if (pn < 8) { dst = (bf16_t*)(ws + OFF_PR); ld = 1024; cb = (pn - 4) * 256; }
        else if (pn < 12) { dst = (bf16_t*)(ws + OFF_PK); ld = 1024; cb = (pn - 8) * 256; }
        else if (pn < 16) { dst = (bf16_t*)(ws + OFF_PV); ld = 1024; cb = (pn - 12) * 256; }
        else { dst = (bf16_t*)(ws + OFF_PMISC); ld = PM_LD; cb = (pn - 16) * 256; }
        bf16_t* halo = (bf16_t*)(ws + OFF_HALO);
        float rsv[2][4];
#pragma unroll
        for (int ai = 0; ai < 2; ++ai)
#pragma unroll
            for (int m = 0; m < 4; ++m) { const int row = u.pm * 256 + ai * 128 + wr * 64 + m * 16 + fr; rsv[ai][m] = (row < NT) ? rstd[row] : 0.f; }
#pragma unroll
        for (int ai = 0; ai < 2; ++ai)
#pragma unroll
            for (int m = 0; m < 4; ++m) {
                const int row = u.pm * 256 + ai * 128 + wr * 64 + m * 16 + fr;
                if (row < NT) {
                    const float rs = rsv[ai][m];
                    const int lr = row & 127;
#pragma unroll
                    for (int bj = 0; bj < 2; ++bj) {
                        const int col = cb + bj * 128 + wc * 32 + fq * 8;
                        const uint2 lo = pack4(acc[ai][bj][m][0][0] * rs, acc[ai][bj][m][0][1] * rs, acc[ai][bj][m][0][2] * rs, acc[ai][bj][m][0][3] * rs);
                        const uint2 hi = pack4(acc[ai][bj][m][1][0] * rs, acc[ai][bj][m][1][1] * rs, acc[ai][bj][m][1][2] * rs, acc[ai][bj][m][1][3] * rs);
                        const uint4 v = make_uint4(lo.x, lo.y, hi.x, hi.y);
                        *(uint4*)(dst + (size_t)row * ld + col) = v;
                        if (pn < 4 && lr >= 112) *(uint4*)(halo + ((size_t)(row >> 7) * 16 + (lr - 112)) * 1024 + col) = v;
                    }
                }
            }
    }
};
__device__ void phase_inproj(const Params& p, unsigned char* lds) {
    pg8::StaticOrder S; S.init(NTP, NP1, (int)gridDim.x, obid());
    pg8::Gemm g; g.A = (const pg8::bf16_t*)(WS(p) + OFF_H); g.Bt = (const pg8::bf16_t*)(WS(p) + OFF_WB) + WB_WIN; g.M = NTP; g.N = NP1; g.K = DM;
    EpiInproj E; E.ws = WS(p); E.rstd = (const float*)(WS(p) + OFF_RSTD);
    pg8::gemm_phase<EpiInproj, pg8::StaticOrder, false>((PG8_LAS unsigned char*)lds, g, S, E, nullptr);
}

__device__ void phase_pool(const Params& p, int l, unsigned char* lds, int tb, int te, int tstep) {
    const int tid = otid(), lane = tid & 63, wid = tid >> 6, fr = lane & 15, fq = lane >> 4;
    bf16_t* pp = (bf16_t*)(WS(p) + OFF_PPOOL);
    const bf16_t* halo = (const bf16_t*)(WS(p) + OFF_HALO);
    const bf16_t* pw = (const bf16_t*)(WS(p) + OFF_WB) + WB_POOL;
    const float* scale = p.in[6] + (size_t)l * 1024;
    bf16_t* sp = (bf16_t*)lds;
    constexpr int SLD = 264;
    bf16_t* sraw = sp + 128 * SLD;
    for (int tile = tb; tile < te; tile += tstep) {
        const int mt = tile >> 2, g = tile & 3;
        const int row0 = mt * 128, w = 2 << g;
        const bf16_t* wg = pw + (size_t)g * 65536;
        bf16x8 bfr[8][2];
#pragma unroll
        for (int kk = 0; kk < 8; ++kk)
#pragma unroll
            for (int n = 0; n < 2; ++n) bfr[kk][n] = *(const bf16x8*)(wg + (size_t)(wid * 32 + n * 16 + fr) * 256 + kk * 32 + fq * 8);
        {
            for (int e = tid; e < 144 * 32; e += NTHR) {
                const int rr = e >> 5, c16 = e & 31;
                uint4 v = make_uint4(0u, 0u, 0u, 0u);
                if (rr >= 16) v = *(const uint4*)(pp + (size_t)(row0 + rr - 16) * 1024 + g * 256 + c16 * 8);
                else if (mt > 0) v = *(const uint4*)(halo + ((size_t)(mt - 1) * 16 + rr) * 1024 + g * 256 + c16 * 8);
                *(uint4*)(sraw + rr * 256 + c16 * 8) = v;
            }
        }
        __syncthreads();
        {
            const int c = tid & 255, r0 = (tid >> 8) * 64;
            auto rawv = [&](int nrel) -> float { return bf2f(sraw[(nrel + 16) * 256 + c]); };
            int t = (row0 + r0) % TS;
            float sum = 0.f;
            const int have = (t < w) ? t : w;
            for (int i = 1; i <= have; ++i) sum += rawv(r0 - i);
#pragma unroll 8
            for (int r = 0; r < 64; ++r) {
                if (t == 0) sum = 0.f;
                const float v = rawv(r0 + r);
                sum += v;
                if (t >= w) sum -= rawv(r0 + r - w);
                const int cnt = (t + 1 < w) ? (t + 1) : w;
                sp[(r0 + r) * SLD + c] = f2bf(sum * (1.0f / (float)cnt) - v);
                t = (t + 1 == TS) ? 0 : t + 1;
            }
        }
        __syncthreads();
        f32x4 acc[8][2];
#pragma unroll
        for (int m = 0; m < 8; ++m) { acc[m][0] = (f32x4){0.f, 0.f, 0.f, 0.f}; acc[m][1] = (f32x4){0.f, 0.f, 0.f, 0.f}; }
#pragma unroll
        for (int kk = 0; kk < 8; ++kk) {
#pragma unroll
            for (int m = 0; m < 8; ++m) {
                const bf16x8 a = *(const bf16x8*)(sp + (m * 16 + fr) * SLD + kk * 32 + fq * 8);
                acc[m][0] = __builtin_amdgcn_mfma_f32_16x16x32_bf16(bfr[kk][0], a, acc[m][0], 0, 0, 0);
                acc[m][1] = __builtin_amdgcn_mfma_f32_16x16x32_bf16(bfr[kk][1], a, acc[m][1], 0, 0, 0);
            }
        }
#pragma unroll
        for (int n = 0; n < 2; ++n) {
            const int col = g * 256 + wid * 32 + n * 16 + fq * 4;
            const float4 sc = *(const float4*)(scale + col);
#pragma unroll
            for (int m = 0; m < 8; ++m) {
                const int row = row0 + m * 16 + fr;
                *(uint2*)(pp + (size_t)row * 1024 + col) = pack4(acc[m][n][0] * sc.x, acc[m][n][1] * sc.y, acc[m][n][2] * sc.z, acc[m][n][3] * sc.w);
            }
        }
        __syncthreads();
    }
}

__device__ void phase_dsa_prep(const Params& p, int l) {
    const int lane = otid() & 63;
    const int wave = (obid() * NTHR + otid()) >> 6, nw = gridDim.x * NTHR / 64;
    const bf16_t* pm = (const bf16_t*)(WS(p) + OFF_PMISC);
    unsigned char* dob = OUTB(p);
    bf16_t* cqn = (bf16_t*)(dob + DO_CQN);
    bf16_t* kv = (bf16_t*)(dob + DO_KV);
    bf16_t* kidx = (bf16_t*)(dob + DO_KIDX);
    float* whead = (float*)(dob + DO_WHEAD);
    const float* ctab = (const float*)(WS(p) + OFF_ROPE);
    const float* stab = ctab + TS * 16;
    const bf16_t* hrow = (const bf16_t*)(WS(p) + OFF_H);
    const bf16_t* wwidx = (const bf16_t*)(WS(p) + OFF_WB) + WB_WIDX;
    const float* rstd_ = (const float*)(WS(p) + OFF_RSTD);
    const float4 qn4 = *(const float4*)(p.in[21] + l * 256 + lane * 4);
    const float2 kvn2 = *(const float2*)(p.in[22] + l * 128 + lane * 2);
    const float inw = p.in[27][l * 64 + lane], inb = p.in[28][l * 64 + lane];
    uint4 ww[8][2];
#pragma unroll
    for (int j = 0; j < 8; ++j) { ww[j][0] = *(const uint4*)(wwidx + (size_t)j * DM + lane * 16); ww[j][1] = *(const uint4*)(wwidx + (size_t)j * DM + lane * 16 + 8); }
    struct In { uint2 cq; unsigned ckv; bf16_t kr0, kr1, kix; uint4 h0, h1; float rs, c, s; };
    auto load = [&](int n) {
        In r;
        const bf16_t* row = pm + (size_t)n * PM_LD;
        const int t = n % TS;
        r.cq = *(const uint2*)(row + PM_CQ + lane * 4);
        r.ckv = *(const unsigned*)(row + PM_CKV + lane * 2);
        r.kr0 = row[PM_KROPE + (lane & 15)]; r.kr1 = row[PM_KROPE + 16 + (lane & 15)];
        r.kix = row[PM_KIDX + lane];
        r.h0 = *(const uint4*)(hrow + (size_t)n * DM + lane * 16); r.h1 = *(const uint4*)(hrow + (size_t)n * DM + lane * 16 + 8);
        r.rs = rstd_[n];
        r.c = ctab[t * 16 + (lane & 15)]; r.s = stab[t * 16 + (lane & 15)];
        return r;
    };
    In cur = load(wave < NT ? wave : 0);
    for (int n = wave; n < NT; n += nw) {
        const In x = cur;
        if (n + nw < NT) cur = load(n + nw);
        {
            const float v0 = __uint_as_float(x.cq.x << 16), v1 = __uint_as_float(x.cq.x & 0xFFFF0000u), v2 = __uint_as_float(x.cq.y << 16), v3 = __uint_as_float(x.cq.y & 0xFFFF0000u);
            const float ss = wave_sum_fast(v0 * v0 + v1 * v1 + v2 * v2 + v3 * v3);
            const float rs = rsqrtf(ss * (1.0f / 256.0f) + 1e-6f);
            *(uint2*)(cqn + (size_t)n * 256 + lane * 4) = pack4(v0 * rs * qn4.x, v1 * rs * qn4.y, v2 * rs * qn4.z, v3 * rs * qn4.w);
        }
        {
            const float v0 = __uint_as_float(x.ckv << 16), v1 = __uint_as_float(x.ckv & 0xFFFF0000u);
            const float ss = wave_sum_fast(v0 * v0 + v1 * v1);
            const float rs = rsqrtf(ss * (1.0f / 128.0f) + 1e-6f);
            *(unsigned*)(kv + (size_t)n * 160 + lane * 2) = pk2(v0 * rs * kvn2.x, v1 * rs * kvn2.y);
        }
        if (lane < 16) {
            const float x1 = bf2f(x.kr0), x2 = bf2f(x.kr1);
            kv[(size_t)n * 160 + 128 + lane] = f2bf(x1 * x.c - x2 * x.s);
            kv[(size_t)n * 160 + 144 + lane] = f2bf(x2 * x.c + x1 * x.s);
        }
        {
            const float xv = bf2f(x.kix);
            const float mu = wave_sum_fast(xv) * (1.0f / 64.0f);
            const float d = xv - mu;
            const float var = wave_sum_fast(d * d) * (1.0f / 64.0f);
            const float y = d * rsqrtf(var + 1e-6f) * inw + inb;
            const float yo = __shfl_xor(y, 16);
            float o = y;
            if (lane < 32) o = (lane < 16) ? (y * x.c - yo * x.s) : (y * x.c + yo * x.s);
            kidx[(size_t)n * 64 + lane] = f2bf(o);
        }
        {
            const uint4 hv0 = x.h0, hv1 = x.h1;
            float hx[16];
            hx[0] = __uint_as_float(hv0.x << 16); hx[1] = __uint_as_float(hv0.x & 0xFFFF0000u); hx[2] = __uint_as_float(hv0.y << 16); hx[3] = __uint_as_float(hv0.y & 0xFFFF0000u);
            hx[4] = __uint_as_float(hv0.z << 16); hx[5] = __uint_as_float(hv0.z & 0xFFFF0000u); hx[6] = __uint_as_float(hv0.w << 16); hx[7] = __uint_as_float(hv0.w & 0xFFFF0000u);
            hx[8] = __uint_as_float(hv1.x << 16); hx[9] = __uint_as_float(hv1.x & 0xFFFF0000u); hx[10] = __uint_as_float(hv1.y << 16); hx[11] = __uint_as_float(hv1.y & 0xFFFF0000u);
            hx[12] = __uint_as_float(hv1.z << 16); hx[13] = __uint_as_float(hv1.z & 0xFFFF0000u); hx[14] = __uint_as_float(hv1.w << 16); hx[15] = __uint_as_float(hv1.w & 0xFFFF0000u);
            float myw = 0.f;
#pragma unroll
            for (int j = 0; j < 8; ++j) {
                const uint4 w0 = ww[j][0], w1 = ww[j][1];
                float d = hx[0] * __uint_as_float(w0.x << 16) + hx[1] * __uint_as_float(w0.x & 0xFFFF0000u) + hx[2] * __uint_as_float(w0.y << 16) + hx[3] * __uint_as_float(w0.y & 0xFFFF0000u)
                        + hx[4] * __uint_as_float(w0.z << 16) + hx[5] * __uint_as_float(w0.z & 0xFFFF0000u) + hx[6] * __uint_as_float(w0.w << 16) + hx[7] * __uint_as_float(w0.w & 0xFFFF0000u)
                        + hx[8] * __uint_as_float(w1.x << 16) + hx[9] * __uint_as_float(w1.x & 0xFFFF0000u) + hx[10] * __uint_as_float(w1.y << 16) + hx[11] * __uint_as_float(w1.y & 0xFFFF0000u)
                        + hx[12] * __uint_as_float(w1.z << 16) + hx[13] * __uint_as_float(w1.z & 0xFFFF0000u) + hx[14] * __uint_as_float(w1.w << 16) + hx[15] * __uint_as_float(w1.w & 0xFFFF0000u);
                d = wave_sum_fast(d);
                myw = (lane == j) ? d : myw;
            }
            if (lane < 8) whead[(size_t)n * 8 + lane] = myw * x.rs * 0.04419417382415922f;
        }
    }
}

typedef short s16x4 __attribute__((ext_vector_type(4)));
__device__ __forceinline__ unsigned f2h_bits(float f) { const _Float16 h = (_Float16)f; unsigned short u; __builtin_memcpy(&u, &h, 2); return u; }
template <bool IMPORT_SEL>
__device__ void phase_dsa(const Params& p, int l, unsigned char* lds, bf16_t* yc, const unsigned short* gsel, const int* gnsel, int tb, int te, int tstep) {
    unsigned short* s_sc = (unsigned short*)lds;
    bf16_t* s_qi = (bf16_t*)(lds + 66048);
    bf16_t* s_Q = (bf16_t*)lds;
    unsigned short* s_sel = (unsigned short*)(lds + 82432 + 65536);
    int* s_nsel = (int*)(lds + 82432 + 65536 + 8192);
    unsigned char* dob = OUTB(p);
    const bf16_t* cqn = (const bf16_t*)(dob + DO_CQN);
    const bf16_t* kv = (const bf16_t*)(dob + DO_KV);
    const bf16_t* kidx = (const bf16_t*)(dob + DO_KIDX);
    const float* whead = (const float*)(dob + DO_WHEAD);
    const float* ctab = (const float*)(WS(p) + OFF_ROPE);
    const float* stab = ctab + TS * 16;
    const bf16_t* wb = (const bf16_t*)(WS(p) + OFF_WB);
    const bf16_t* wqiT = wb + WB_QI;
    const bf16_t* wuqT = wb + WB_UQ;
    const bf16_t* wuk = wb + WB_UK;
    const bf16_t* wuvT = wb + WB_UV;
    const float scale = 0.10206207261596575f;
    const f32x4 z4 = {0.f, 0.f, 0.f, 0.f};
    bf16_t* gq = (obid() < QS_WS) ? (bf16_t*)(WS(p) + WS_END + (size_t)obid() * QS_BYTES) : (bf16_t*)(OUTB(p) + DO_END + (size_t)(obid() - QS_WS) * QS_BYTES);
    for (int pair = tb; pair < te; pair += tstep) {
        const int qt = 128 - (pair >> 2);
        const int t0 = qt * 16;
#pragma unroll 1
        for (int half = 0; half < 2; ++half) {
        const int tid = otid(), lane = tid & 63, wid = tid >> 6, fr = lane & 15, fq = lane >> 4;
        unsigned char* s_Vw = lds + 82432 + wid * 8192;
        bf16_t* s_qn = (bf16_t*)s_Vw;
        const int b = (pair & 3) * 2 + half;
        const size_t n0 = (size_t)b * TS + t0;
        {
            bf16x8 acq[8];
#pragma unroll
            for (int kk = 0; kk < 8; ++kk) acq[kk] = *(const bf16x8*)(cqn + (n0 + fr) * 256 + kk * 32 + fq * 8);
            f32x4 c[4] = {z4, z4, z4, z4};
#pragma unroll
            for (int kb = 0; kb < 8; kb += 4) {
                bf16x8 bf[4][4];
#pragma unroll
                for (int k4 = 0; k4 < 4; ++k4)
#pragma unroll
                    for (int nt = 0; nt < 4; ++nt) bf[k4][nt] = *(const bf16x8*)(wqiT + (size_t)(wid * 64 + nt * 16 + fr) * 256 + (kb + k4) * 32 + fq * 8);
#pragma unroll
                for (int k4 = 0; k4 < 4; ++k4)
#pragma unroll
                    for (int nt = 0; nt < 4; ++nt) c[nt] = __builtin_amdgcn_mfma_f32_16x16x32_bf16(acq[kb + k4], bf[k4][nt], c[nt], 0, 0, 0);
            }
#pragma unroll
            for (int j = 0; j < 4; ++j) {
                const int t = t0 + fq * 4 + j;
                const float cs = ctab[t * 16 + fr], sn = stab[t * 16 + fr];
                const float x1 = c[0][j], x2 = c[1][j];
                c[0][j] = x1 * cs - x2 * sn; c[1][j] = x2 * cs + x1 * sn;
            }
#pragma unroll
            for (int nt = 0; nt < 4; ++nt)
#pragma unroll
                for (int j = 0; j < 4; ++j) s_qi[(fq * 4 + j) * 512 + wid * 64 + nt * 16 + fr] = f2bf(c[nt][j]);
        }
        __syncthreads();
        if (!IMPORT_SEL) {
            bf16x8 aq[8][2];
#pragma unroll
            for (int h = 0; h < 8; ++h)
#pragma unroll
                for (int ks = 0; ks < 2; ++ks) aq[h][ks] = *(const bf16x8*)(s_qi + fr * 512 + h * 64 + ks * 32 + fq * 8);
            float wh[4][8];
#pragma unroll
            for (int j = 0; j < 4; ++j) {
                const float4 w0 = *(const float4*)(whead + (n0 + fq * 4 + j) * 8), w1 = *(const float4*)(whead + (n0 + fq * 4 + j) * 8 + 4);
                wh[j][0] = w0.x; wh[j][1] = w0.y; wh[j][2] = w0.z; wh[j][3] = w0.w; wh[j][4] = w1.x; wh[j][5] = w1.y; wh[j][6] = w1.z; wh[j][7] = w1.w;
            }
            const int nkt = qt + 1;
            bf16x8 nb0 = {0, 0, 0, 0, 0, 0, 0, 0}, nb1 = nb0;
            if (wid < nkt) { const bf16_t* kr0 = kidx + ((size_t)b * TS + wid * 16 + fr) * 64 + fq * 8; nb0 = *(const bf16x8*)kr0; nb1 = *(const bf16x8*)(kr0 + 32); }
#pragma unroll 1
            for (int kt = wid; kt < nkt; kt += 8) {
                const bf16x8 bk0 = nb0, bk1 = nb1;
                if (kt + 8 < nkt) { const bf16_t* krn = kidx + ((size_t)b * TS + (kt + 8) * 16 + fr) * 64 + fq * 8; nb0 = *(const bf16x8*)krn; nb1 = *(const bf16x8*)(krn + 32); }
                float I[4] = {0.f, 0.f, 0.f, 0.f};
#pragma unroll
                for (int h = 0; h < 8; ++h) {
                    f32x4 a = __builtin_amdgcn_mfma_f32_16x16x32_bf16(aq[h][0], bk0, z4, 0, 0, 0);
                    a = __builtin_amdgcn_mfma_f32_16x16x32_bf16(aq[h][1], bk1, a, 0, 0, 0);
#pragma unroll
                    for (int j = 0; j < 4; ++j) I[j] += wh[j][h] * fmaxf(a[j], 0.f);
                }
#pragma unroll
                for (int j = 0; j < 4; ++j) s_sc[(fq * 4 + j) * 2064 + kt * 16 + fr] = (unsigned short)f2h_bits(I[j]);
            }
        }
        __syncthreads();
#pragma unroll 1
        for (int qi2 = 0; qi2 < 2; ++qi2) {
            const int q = wid + qi2 * 8;
            const int nadm = t0 + q + 1;
            unsigned short* sel = s_sel + q * 256;
            if (IMPORT_SEL) {
                const int ns = gnsel[n0 + q];
                for (int i = lane; i < ns; i += 64) sel[i] = gsel[(n0 + q) * 256 + i];
                if (lane == 0) s_nsel[q] = ns;
            } else if (nadm <= 256) {
                for (int i = lane; i < nadm; i += 64) sel[i] = (unsigned short)i;
                if (lane == 0) s_nsel[q] = nadm;
            } else {
                unsigned* hist = (unsigned*)(lds + 82432 + wid * 8192);
                const unsigned short* scq = s_sc + q * 2064;
                const int nch = (nadm + 63) >> 6;
                unsigned B1 = 0u; int na1 = 0, na2 = 0; unsigned T = 0u;
#pragma unroll 1
                for (int pass = 0; pass < 2; ++pass) {
                    *(uint4*)(hist + lane * 4) = make_uint4(0u, 0u, 0u, 0u);
#pragma unroll 1
                    for (int c0 = 0; c0 < nch; c0 += 8) {
                        unsigned kb[8];
#pragma unroll
                        for (int j = 0; j < 8; ++j) { const int s_ = (c0 + j) * 64 + lane; kb[j] = (s_ < nadm) ? (unsigned)scq[s_] : 0x10000u; }
#pragma unroll
                        for (int j = 0; j < 8; ++j) {
                            const unsigned u = kb[j];
                            const unsigned k = (u & 0x8000u) ? (~u & 0xFFFFu) : (u | 0x8000u);
                            const bool ok = (u < 0x10000u) && (pass == 0 || (k >> 8) == B1);
                            if (ok) atomicAdd(hist + (pass == 0 ? (k >> 8) : (k & 255u)), 1u);
                        }
                    }
                    const int need = 256 - na1;
                    const uint4 h4 = *(const uint4*)(hist + lane * 4);
                    const int sl = (int)(h4.x + h4.y + h4.z + h4.w);
                    int suf = sl;
#pragma unroll
                    for (int o = 1; o < 64; o <<= 1) { const int t_ = __shfl_down(suf, o); suf += (lane + o < 64) ? t_ : 0; }
                    const int above = suf - sl;
                    const bool mine = (suf >= need) && (above < need);
                    int a = above, bsel, asel;
                    if (a + (int)h4.w >= need) { bsel = 3; asel = a; }
                    else { a += (int)h4.w;
                        if (a + (int)h4.z >= need) { bsel = 2; asel = a; }
                        else { a += (int)h4.z;
                            if (a + (int)h4.y >= need) { bsel = 1; asel = a; }
                            else { a += (int)h4.y; bsel = 0; asel = a; } } }
                    const int src = __ffsll((long long)__ballot(mine)) - 1;
                    const unsigned bin = (unsigned)__shfl(lane * 4 + bsel, src); const int nab = __shfl(asel, src);
                    if (pass == 0) { B1 = bin; na1 = nab; } else { T = (B1 << 8) | bin; na2 = nab; }
                }
                {
                    const int rties = 256 - (na1 + na2);
                    int base = 0, ties = 0;
                    const unsigned long long ltmask = (1ull << lane) - 1ull;
#pragma unroll 1
                    for (int c0 = 0; c0 < nch; c0 += 4) {
                        unsigned kb[4];
#pragma unroll
                        for (int j = 0; j < 4; ++j) { const int s_ = (c0 + j) * 64 + lane; kb[j] = (s_ < nadm) ? (unsigned)scq[s_] : 0x10000u; }
#pragma unroll
                        for (int j = 0; j < 4; ++j) {
                            const int s_ = (c0 + j) * 64 + lane;
                            const unsigned u = kb[j];
                            const bool valid = u < 0x10000u;
                            const unsigned k = (u & 0x8000u) ? (~u & 0xFFFFu) : (u | 0x8000u);
                            const bool gt = valid && k > T, eq = valid && k == T;
                            const unsigned long long em = __ballot(eq);
                            const int myrank = ties + __popcll(em & ltmask);
                            const bool take = gt || (eq && myrank < rties);
                            const unsigned long long tm = __ballot(take);
                            const int pos = base + __popcll(tm & ltmask);
                            if (take && pos < 256) sel[pos] = (unsigned short)s_;
                            base += __popcll(tm); ties += __popcll(em);
                        }
                    }
                }
                if (lane == 0) s_nsel[q] = 256;
            }
        }
        __syncthreads();
        if (half == 0) {
            const size_t n0B = n0 + TS;
            bf16_t* s_qnB = s_qn + 1024;
#pragma unroll 1
            for (int hi = 0; hi < 2; ++hi) {
                const int hh = wid * 2 + hi;
                const bf16_t* caA = cqn + (n0 + fr) * 256 + fq * 8;
                const bf16_t* caB = cqn + (n0B + fr) * 256 + fq * 8;
                f32x4 cA[6] = {z4, z4, z4, z4, z4, z4}, cB[6] = {z4, z4, z4, z4, z4, z4};
#pragma unroll
                for (int kb = 0; kb < 8; kb += 2) {
                    bf16x8 bf[2][6], aA[2], aB[2];
#pragma unroll
                    for (int k2 = 0; k2 < 2; ++k2) {
                        aA[k2] = *(const bf16x8*)(caA + (kb + k2) * 32); aB[k2] = *(const bf16x8*)(caB + (kb + k2) * 32);
#pragma unroll
                        for (int nt = 0; nt < 6; ++nt) bf[k2][nt] = *(const bf16x8*)(wuqT + (size_t)(hh * 96 + nt * 16 + fr) * 256 + (kb + k2) * 32 + fq * 8);
                    }
#pragma unroll
                    for (int k2 = 0; k2 < 2; ++k2)
#pragma unroll
                        for (int nt = 0; nt < 6; ++nt) {
                            cA[nt] = __builtin_amdgcn_mfma_f32_16x16x32_bf16(aA[k2], bf[k2][nt], cA[nt], 0, 0, 0);
                            cB[nt] = __builtin_amdgcn_mfma_f32_16x16x32_bf16(aB[k2], bf[k2][nt], cB[nt], 0, 0, 0);
                        }
                }
#pragma unroll
                for (int j = 0; j < 4; ++j) {
                    const int q = fq * 4 + j, t = t0 + q;
                    const float cs = ctab[t * 16 + fr], sn = stab[t * 16 + fr];
                    s_Q[(q * 16 + hh) * 160 + 128 + fr] = f2bf(cA[4][j] * cs - cA[5][j] * sn);
                    s_Q[(q * 16 + hh) * 160 + 144 + fr] = f2bf(cA[5][j] * cs + cA[4][j] * sn);
                    gq[(q * 16 + hh) * 160 + 128 + fr] = f2bf(cB[4][j] * cs - cB[5][j] * sn);
                    gq[(q * 16 + hh) * 160 + 144 + fr] = f2bf(cB[5][j] * cs + cB[4][j] * sn);
#pragma unroll
                    for (int nt = 0; nt < 4; ++nt) { s_qn[q * 64 + nt * 16 + fr] = f2bf(cA[nt][j]); s_qnB[q * 64 + nt * 16 + fr] = f2bf(cB[nt][j]); }
                }
                __syncthreads();
                bf16x8 anA[2], anB[2];
#pragma unroll
                for (int ks = 0; ks < 2; ++ks) { anA[ks] = *(const bf16x8*)(s_qn + fr * 64 + ks * 32 + fq * 8); anB[ks] = *(const bf16x8*)(s_qnB + fr * 64 + ks * 32 + fq * 8); }
                bf16x8 bwk[8][2];
#pragma unroll
                for (int nt = 0; nt < 8; ++nt)
#pragma unroll
                    for (int ks = 0; ks < 2; ++ks) bwk[nt][ks] = *(const bf16x8*)(wuk + (size_t)(hh * 128 + nt * 16 + fr) * 64 + ks * 32 + fq * 8);
#pragma unroll
                for (int nt = 0; nt < 8; ++nt) {
                    f32x4 aA = z4, aB = z4;
#pragma unroll
                    for (int ks = 0; ks < 2; ++ks) {
                        aA = __builtin_amdgcn_mfma_f32_16x16x32_bf16(anA[ks], bwk[nt][ks], aA, 0, 0, 0);
                        aB = __builtin_amdgcn_mfma_f32_16x16x32_bf16(anB[ks], bwk[nt][ks], aB, 0, 0, 0);
                    }
#pragma unroll
                    for (int j = 0; j < 4; ++j) {
                        s_Q[((fq * 4 + j) * 16 + hh) * 160 + nt * 16 + fr] = f2bf(aA[j]);
                        gq[((fq * 4 + j) * 16 + hh) * 160 + nt * 16 + fr] = f2bf(aB[j]);
                    }
                }
                __syncthreads();
            }
        } else {
            for (int e = tid; e < QS_BYTES / 16; e += NTHR) ((uint4*)s_Q)[e] = ((const uint4*)gq)[e];
            __syncthreads();
        }
#pragma unroll 1
        for (int qi2 = 0; qi2 < 2; ++qi2) {
            const int q = wid + qi2 * 8;
            bf16x8 bq[5];
#pragma unroll
            for (int ks = 0; ks < 5; ++ks) bq[ks] = *(const bf16x8*)(s_Q + (q * 16 + fr) * 160 + ks * 32 + fq * 8);
            const int nsel = s_nsel[q];
            const unsigned short* sel = s_sel + q * 256;
            float m = -INFINITY, lsum = 0.f;
            f32x4 O[8] = {z4, z4, z4, z4, z4, z4, z4, z4};
            const int nchunk = (nsel + 31) >> 5;
            bf16x8 akn[2][5];
#pragma unroll
            for (int mt = 0; mt < 2; ++mt) {
                const int ki = mt * 16 + fr;
                const int sidx = sel[ki < nsel ? ki : 0];
                const bf16_t* krow = kv + ((size_t)b * TS + sidx) * 160 + fq * 8;
#pragma unroll
                for (int ks = 0; ks < 5; ++ks) akn[mt][ks] = *(const bf16x8*)(krow + ks * 32);
            }
#pragma unroll 1
            for (int ch = 0; ch < nchunk; ++ch) {
                bf16x8 ak[2][5];
#pragma unroll
                for (int mt = 0; mt < 2; ++mt)
#pragma unroll
                    for (int ks = 0; ks < 5; ++ks) ak[mt][ks] = akn[mt][ks];
                if (ch + 1 < nchunk) {
#pragma unroll
                    for (int mt = 0; mt < 2; ++mt) {
                        const int ki = (ch + 1) * 32 + mt * 16 + fr;
                        const int sidx = sel[ki < nsel ? ki : 0];
                        const bf16_t* krow = kv + ((size_t)b * TS + sidx) * 160 + fq * 8;
#pragma unroll
                        for (int ks = 0; ks < 5; ++ks) akn[mt][ks] = *(const bf16x8*)(krow + ks * 32);
                    }
                }
#pragma unroll
                for (int mt = 0; mt < 2; ++mt)
#pragma unroll
                    for (int ks = 0; ks < 4; ++ks) {
                        const int r = mt * 16 + fr;
                        *(bf16x8*)(s_Vw + r * 256 + (((ks * 2 + (fq >> 1)) ^ (r & 7)) * 32) + (fq & 1) * 16) = ak[mt][ks];
                    }
                f32x4 st[2] = {z4, z4};
#pragma unroll
                for (int mt = 0; mt < 2; ++mt)
#pragma unroll
                    for (int ks = 0; ks < 5; ++ks) st[mt] = __builtin_amdgcn_mfma_f32_16x16x32_bf16(ak[mt][ks], bq[ks], st[mt], 0, 0, 0);
                float sv[2][4]; float cmax = -INFINITY;
#pragma unroll
                for (int mt = 0; mt < 2; ++mt)
#pragma unroll
                    for (int j = 0; j < 4; ++j) {
                        const int ke = ch * 32 + mt * 16 + fq * 4 + j;
                        const float s_ = (ke < nsel) ? st[mt][j] * scale : -INFINITY;
                        sv[mt][j] = s_; cmax = fmaxf(cmax, s_);
                    }
                cmax = fmaxf(cmax, __shfl_xor(cmax, 16)); cmax = fmaxf(cmax, __shfl_xor(cmax, 32));
                const float mnew = fmaxf(m, cmax);
                const float alpha = __expf(m - mnew);
                float psum = 0.f;
#pragma unroll
                for (int mt = 0; mt < 2; ++mt)
#pragma unroll
                    for (int j = 0; j < 4; ++j) { const float pe = __expf(sv[mt][j] - mnew); sv[mt][j] = pe; psum += pe; }
                psum += __shfl_xor(psum, 16); psum += __shfl_xor(psum, 32);
                lsum = lsum * alpha + psum; m = mnew;
#pragma unroll
                for (int ct = 0; ct < 8; ++ct) O[ct] = O[ct] * alpha;
                bf16x8 pf;
#pragma unroll
                for (int mt = 0; mt < 2; ++mt)
#pragma unroll
                    for (int j = 0; j < 4; ++j) pf[mt * 4 + j] = (short)f2bf(sv[mt][j]);
                const int q_ = fr >> 2, p_ = fr & 3;
                const int r0 = fq * 4 + q_, r1 = 16 + r0;
#pragma unroll
                for (int ct = 0; ct < 8; ++ct) {
                    const s16x4 v0 = __builtin_amdgcn_ds_read_tr16_b64_v4i16((__attribute__((address_space(3))) s16x4*)(s_Vw + r0 * 256 + ((ct ^ (r0 & 7)) * 32) + p_ * 8));
                    const s16x4 v1 = __builtin_amdgcn_ds_read_tr16_b64_v4i16((__attribute__((address_space(3))) s16x4*)(s_Vw + r1 * 256 + ((ct ^ (r1 & 7)) * 32) + p_ * 8));
                    bf16x8 av; av[0] = v0[0]; av[1] = v0[1]; av[2] = v0[2]; av[3] = v0[3]; av[4] = v1[0]; av[5] = v1[1]; av[6] = v1[2]; av[7] = v1[3];
                    O[ct] = __builtin_amdgcn_mfma_f32_16x16x32_bf16(av, pf, O[ct], 0, 0, 0);
                }
            }
            const float inv = 1.0f / lsum;
#pragma unroll
            for (int ct = 0; ct < 8; ++ct)
#pragma unroll
                for (int j = 0; j < 4; ++j) s_Q[(q * 16 + fr) * 160 + ct * 16 + fq * 4 + j] = f2bf(O[ct][j] * inv);
        }
        __syncthreads();
#pragma unroll 1
        for (int hi = 0; hi < 2; ++hi) {
            const int hh = wid * 2 + hi;
            bf16x8 ao[4];
#pragma unroll
            for (int ks = 0; ks < 4; ++ks) ao[ks] = *(const bf16x8*)(s_Q + (fr * 16 + hh) * 160 + ks * 32 + fq * 8);
#pragma unroll
            for (int nt = 0; nt < 4; ++nt) {
                f32x4 a = z4;
#pragma unroll
                for (int ks = 0; ks < 4; ++ks)
                    a = __builtin_amdgcn_mfma_f32_16x16x32_bf16(ao[ks], *(const bf16x8*)(wuvT + (size_t)(hh * 64 + nt * 16 + fr) * 128 + ks * 32 + fq * 8), a, 0, 0, 0);
#pragma unroll
                for (int j = 0; j < 4; ++j) yc[(n0 + fq * 4 + j) * 1024 + hh * 64 + nt * 16 + fr] = f2bf(a[j]);
            }
        }
        __syncthreads();
        }
    }
}


__device__ void phase_lr_prep(const Params& p, int l) {
    const int lane = otid() & 63;
    const int wave = (obid() * NTHR + otid()) >> 6, nw = gridDim.x * NTHR / 64;
    const bf16_t* pm = (const bf16_t*)(WS(p) + OFF_PMISC);
    bf16_t* alr = (bf16_t*)(OUTB(p) + DO_ALR);
    const float4 mu4 = *(const float4*)(p.in[4] + (size_t)l * 3328 + 3072 + lane * 4);
    const float4 vm4 = *(const float4*)(p.in[18] + (lane & 7) * 4);
    struct In { uint2 c0, p0, c1, p1; };
    auto load = [&](int n) {
        In r;
        const bf16_t* row = pm + (size_t)n * PM_LD;
        const bool hp = (n % TS) > 0;
        r.c0 = *(const uint2*)(row + lane * 4);
        r.p0 = hp ? *(const uint2*)(row - PM_LD + lane * 4) : make_uint2(0u, 0u);
        r.c1 = make_uint2(0u, 0u); r.p1 = r.c1;
        if (lane < 8) { r.c1 = *(const uint2*)(row + 256 + lane * 4); if (hp) r.p1 = *(const uint2*)(row - PM_LD + 256 + lane * 4); }
        return r;
    };
    auto mix4 = [&](const uint2 c, const uint2 q, const float4 m, float (&o)[4]) {
        const float c0 = __uint_as_float(c.x << 16), c1 = __uint_as_float(c.x & 0xFFFF0000u), c2 = __uint_as_float(c.y << 16), c3 = __uint_as_float(c.y & 0xFFFF0000u);
        const float q0 = __uint_as_float(q.x << 16), q1 = __uint_as_float(q.x & 0xFFFF0000u), q2 = __uint_as_float(q.y << 16), q3 = __uint_as_float(q.y & 0xFFFF0000u);
        o[0] = c0 + (q0 - c0) * m.x; o[1] = c1 + (q1 - c1) * m.y; o[2] = c2 + (q2 - c2) * m.z; o[3] = c3 + (q3 - c3) * m.w;
    };
    In cur = load(wave < NT ? wave : 0);
    for (int n = wave; n < NT; n += nw) {
        const In x = cur;
        if (n + nw < NT) cur = load(n + nw);
        float o[4];
        mix4(x.c0, x.p0, mu4, o);
        if (lane < 16) { o[0] = tanhf(o[0]); o[1] = tanhf(o[1]); o[2] = tanhf(o[2]); o[3] = tanhf(o[3]); }
        else if (lane >= 32) { o[0] = sigmoidf_(o[0]); o[1] = sigmoidf_(o[1]); o[2] = sigmoidf_(o[2]); o[3] = sigmoidf_(o[3]); }
        *(uint2*)(alr + (size_t)n * 288 + lane * 4) = pack4(o[0], o[1], o[2], o[3]);
        if (lane < 8) {
            mix4(x.c1, x.p1, vm4, o);
            *(uint2*)(alr + (size_t)n * 288 + 256 + lane * 4) = pack4(o[0], o[1], o[2], o[3]);
        }
    }
}

typedef short sh4 __attribute__((ext_vector_type(4)));
__device__ __forceinline__ sh4 pk4v(const f32x4& v) { const uint2 u = pack4(v[0], v[1], v[2], v[3]); sh4 r; __builtin_memcpy(&r, &u, 8); return r; }
__device__ __forceinline__ bf16x8 cat8(const sh4& a, const sh4& b) { bf16x8 r; r[0] = a[0]; r[1] = a[1]; r[2] = a[2]; r[3] = a[3]; r[4] = b[0]; r[5] = b[1]; r[6] = b[2]; r[7] = b[3]; return r; }
#define MF32(a, b, c) __builtin_amdgcn_mfma_f32_16x16x32_bf16(a, b, c, 0, 0, 0)
#define MF16(a, b, c) MF32(cat8(a, sh4{0, 0, 0, 0}), cat8(b, sh4{0, 0, 0, 0}), c)
constexpr int SC_LT = 72;
constexpr int SC_LS = 36;
constexpr int SC_TC = 32;
constexpr int SC_ROWB = 1088;
__device__ __forceinline__ const unsigned char* scan_piece_src(const Params& p, int l, int b, int hc, int t0, int pi, bool& ok) {
    const int tau = pi / 68, seg = pi - tau * 68;
    const int t = t0 + tau;
    ok = (t < TS) && (tau < SC_TC);
    const size_t n = (size_t)b * TS + t;
    const unsigned char* ws = WS(p);
    if (seg < 8) return ws + OFF_PR + (n * 1024 + hc) * 2 + seg * 16;
    if (seg < 16) return ws + OFF_PK + (n * 1024 + hc) * 2 + (seg - 8) * 16;
    if (seg < 24) return ws + OFF_PV + (n * 1024 + hc) * 2 + (seg - 16) * 16;
    if (seg < 60) return OUTB(p) + DO_ALR + (n * 288) * 2 + (seg - 24) * 16;
    ok = ok && (l > 0);
    return ws + OFF_VFIRST + (n * 1024 + hc) * 2 + (seg - 60) * 16;
}
__device__ void phase_scan5(const Params& p, int l, unsigned char* lds, int blk) {
    const int tid = otid(), lane = tid & 63, wid = tid >> 6, fr = lane & 15, fq = lane >> 4;
    const int b = blk >> 4, hh = blk & 15, hc = hh * 64;
    float* s_r = (float*)lds;
    float* s_w = s_r + 2048;
    float* s_k = s_w + 2048;
    float* s_v = s_k + 2048;
    float* s_a = s_v + 2048;
    float* s_b = s_a + 2048;
    float* s_g = s_b + 2048;
    float* s_o = s_g + 2048;
    bf16_t* o_at = (bf16_t*)(s_o + 2048);
    bf16_t* o_rt = o_at + 32 * SC_LT;
    bf16_t* o_bt = o_rt + 32 * SC_LT;
    bf16_t* o_kt = o_bt + 32 * SC_LT;
    bf16_t* o_bT = o_kt + 32 * SC_LT;
    bf16_t* o_kT = o_bT + 64 * SC_LS;
    bf16_t* o_vT = o_kT + 64 * SC_LS;
    float* s_gc = (float*)(o_vT + 64 * SC_LS);
    unsigned char* raw = (unsigned char*)(s_gc + 128);
    float* prevb = (float*)(raw + 32 * SC_ROWB);
    unsigned* prevr = (unsigned*)prevb;
    float* s_bs = s_r;
    float* cst = prevb + 960;
    const float* mu = p.in[4] + (size_t)l * 3328;
    for (int e = tid; e < 480; e += NTHR) {
        float v;
        if (e < 192) v = mu[(e >> 6) * 1024 + hc + (e & 63)];
        else if (e < 448) v = mu[3072 + (e - 192)];
        else v = p.in[18][e - 448];
        cst[e] = v;
    }
    if (tid < 64) {
        cst[480 + tid] = p.in[7][l * 1024 + hc + tid];
        cst[544 + tid] = p.in[9][l * 1024 + hc + tid];
        cst[608 + tid] = p.in[12][l * 1024 + hc + tid];
        cst[672 + tid] = p.in[13][l * 1024 + hc + tid];
        cst[736 + tid] = p.in[14][l * 1024 + hc + tid];
        cst[800 + tid] = p.in[15][l * 1024 + hc + tid];
        cst[864 + tid] = p.in[16][l * 1024 + hc + tid];
        cst[928 + tid] = p.in[19][hc + tid];
    }
    const int mm = wid >> 1, ntb = (wid & 1) * 2;
    const int nks = (mm == 2) ? 4 : (mm == 3 ? 1 : 2);
    bf16x8 Bw[2][4];
    {
        const float* wsrc = (mm == 0) ? p.in[8] + (size_t)l * 64 * 1024 : (mm == 1) ? p.in[10] + (size_t)l * 64 * 1024 : (mm == 2) ? p.in[11] + (size_t)l * 128 * 1024 : p.in[20];
#pragma unroll
        for (int n2 = 0; n2 < 2; ++n2)
#pragma unroll
            for (int ks = 0; ks < 4; ++ks) {
                bf16x8 f;
#pragma unroll
                for (int j = 0; j < 8; ++j) {
                    const bool okw = ks < nks && (mm < 3 || l > 0);
                    const float v = wsrc[(size_t)(okw ? (ks * 32 + fq * 8 + j) : 0) * 1024 + hc + (ntb + n2) * 16 + fr];
                    f[j] = (short)f2bf(okw ? v : 0.f);
                }
                Bw[n2][ks] = f;
            }
    }
    const f32x4 z4 = {0.f, 0.f, 0.f, 0.f};
    f32x4 S[4] = {z4, z4, z4, z4};
    sh4 Lf;
#pragma unroll
    for (int j = 0; j < 4; ++j) Lf[j] = (fq * 4 + j <= fr) ? (short)0x3F80 : (short)0;
    bf16_t* Pr = (bf16_t*)(WS(p) + OFF_PR);
    bf16_t* vfirst = (bf16_t*)(WS(p) + OFF_VFIRST);
    const unsigned char* psrc[5]; int pstep[5], ptau[5]; bool pval[5];
#pragma unroll
    for (int k = 0; k < 5; ++k) {
        const int pi = tid + k * NTHR;
        bool ok = false;
        psrc[k] = scan_piece_src(p, l, b, hc, 0, pi < SC_TC * 68 ? pi : 0, ok);
        const int tau = (pi < SC_TC * 68 ? pi : 0) / 68, seg = (pi < SC_TC * 68 ? pi : 0) - tau * 68;
        ptau[k] = tau;
        pstep[k] = SC_TC * ((seg >= 24 && seg < 60) ? 576 : 2048);
        pval[k] = (pi < SC_TC * 68) && !(seg >= 60 && l == 0);
    }
    uint4 pre[5];
#pragma unroll
    for (int k = 0; k < 5; ++k) { pre[k] = make_uint4(0, 0, 0, 0); if (pval[k] && ptau[k] < TS) pre[k] = *(const uint4*)psrc[k]; }
    __syncthreads();
#pragma unroll 1
    for (int t0 = 0, ch = 0; t0 < TS; t0 += SC_TC, ++ch) {
        const int nval = (TS - t0 < SC_TC) ? (TS - t0) : SC_TC;
#pragma unroll
        for (int k = 0; k < 5; ++k) { const int pi = tid + k * NTHR; if (pi < SC_TC * 68) *(uint4*)(raw + pi * 16) = pre[k]; }
        lds_barrier();
#pragma unroll
        for (int k = 0; k < 5; ++k) {
            pre[k] = make_uint4(0, 0, 0, 0);
            if (pval[k] && t0 + SC_TC + ptau[k] < TS) pre[k] = *(const uint4*)(psrc[k] + (size_t)(ch + 1) * pstep[k]);
        }
        if (mm < 3 || l > 0) {
            const unsigned char* Ab = raw + ((mm == 0) ? 384 : (mm == 1) ? 512 : (mm == 2) ? 640 : 896);
            float* dst = (mm == 0) ? s_w : (mm == 1) ? s_a : (mm == 2) ? s_g : s_o;
#pragma unroll
            for (int m = 0; m < 2; ++m) {
                f32x4 acc0 = {0.f, 0.f, 0.f, 0.f}, acc1 = {0.f, 0.f, 0.f, 0.f};
#pragma unroll
                for (int ks = 0; ks < 4; ++ks) {
                    if (ks < nks) {
                        const bf16x8 a = *(const bf16x8*)(Ab + (m * 16 + fr) * SC_ROWB + ks * 64 + fq * 16);
                        acc0 = __builtin_amdgcn_mfma_f32_16x16x32_bf16(a, Bw[0][ks], acc0, 0, 0, 0);
                        acc1 = __builtin_amdgcn_mfma_f32_16x16x32_bf16(a, Bw[1][ks], acc1, 0, 0, 0);
                    }
                }
                if (mm == 0) {
                    const float cw0 = cst[480 + ntb * 16 + fr], cw1 = cst[480 + (ntb + 1) * 16 + fr];
                    f32x4 l0, l1, r0, r1;
#pragma unroll
                    for (int j = 0; j < 4; ++j) { l0[j] = -0.6065306597126334f * fast_sigmoid(acc0[j] + cw0); l1[j] = -0.6065306597126334f * fast_sigmoid(acc1[j] + cw1); }
                    const uint2 h0 = pack4(l0[0], l0[1], l0[2], l0[3]), h1 = pack4(l1[0], l1[1], l1[2], l1[3]);
                    r0[0] = l0[0] - __uint_as_float(h0.x << 16); r0[1] = l0[1] - __uint_as_float(h0.x & 0xFFFF0000u); r0[2] = l0[2] - __uint_as_float(h0.y << 16); r0[3] = l0[3] - __uint_as_float(h0.y & 0xFFFF0000u);
                    r1[0] = l1[0] - __uint_as_float(h1.x << 16); r1[1] = l1[1] - __uint_as_float(h1.x & 0xFFFF0000u); r1[2] = l1[2] - __uint_as_float(h1.y << 16); r1[3] = l1[3] - __uint_as_float(h1.y & 0xFFFF0000u);
                    sh4 hh0, hh1; __builtin_memcpy(&hh0, &h0, 8); __builtin_memcpy(&hh1, &h1, 8);
                    f32x4 c0 = MF16(Lf, pk4v(r0), z4), c1 = MF16(Lf, pk4v(r1), z4);
                    c0 = MF16(Lf, hh0, c0); c1 = MF16(Lf, hh1, c1);
#pragma unroll
                    for (int j = 0; j < 4; ++j) {
                        const int eo = (m * 16 + fq * 4 + j) * 64 + ntb * 16 + fr;
                        s_w[eo] = c0[j]; s_w[eo + 16] = c1[j];
                        s_b[eo] = l0[j]; s_b[eo + 16] = l1[j];
                    }
                } else {
#pragma unroll
                    for (int j = 0; j < 4; ++j) {
                        dst[(m * 16 + fq * 4 + j) * 64 + ntb * 16 + fr] = acc0[j];
                        dst[(m * 16 + fq * 4 + j) * 64 + (ntb + 1) * 16 + fr] = acc1[j];
                    }
                }
            }
        }
        lds_barrier();
        {
            const int tau = tid >> 4, c4 = (tid & 15) * 4, e = tau * 64 + c4, t = t0 + tau;
            const size_t n = (size_t)b * TS + t;
            const float4 cum4 = *(const float4*)(s_w + e), lw4 = *(const float4*)(s_b + e), xa4 = *(const float4*)(s_a + e);
            const float4 ca = *(const float4*)(cst + 544 + c4), ckk = *(const float4*)(cst + 608 + c4), cka = *(const float4*)(cst + 672 + c4), crk = *(const float4*)(cst + 736 + c4);
            const float cum[4] = {cum4.x, cum4.y, cum4.z, cum4.w}, lw[4] = {lw4.x, lw4.y, lw4.z, lw4.w};
            const float xa[4] = {xa4.x + ca.x, xa4.y + ca.y, xa4.z + ca.z, xa4.w + ca.w};
            const float kkc[4] = {ckk.x, ckk.y, ckk.z, ckk.w}, kac[4] = {cka.x, cka.y, cka.z, cka.w};
            float rr[4], kr[4], vv[4];
            {
                const unsigned char* rc = raw + tau * SC_ROWB + c4 * 2;
                const uint2 cr = *(const uint2*)rc, ck = *(const uint2*)(rc + 128), cv = *(const uint2*)(rc + 256);
                uint2 qr = make_uint2(0u, 0u), qk = qr, qv = qr;
                if (tau > 0) { qr = *(const uint2*)(rc - SC_ROWB); qk = *(const uint2*)(rc - SC_ROWB + 128); qv = *(const uint2*)(rc - SC_ROWB + 256); }
                else if (t0 > 0) { const unsigned* pvr = prevr + ((ch + 1) & 1) * 96 + (c4 >> 1); qr = *(const uint2*)pvr; qk = *(const uint2*)(pvr + 32); qv = *(const uint2*)(pvr + 64); }
                if (tau == SC_TC - 1) { unsigned* pwr = prevr + (ch & 1) * 96 + (c4 >> 1); *(uint2*)pwr = cr; *(uint2*)(pwr + 32) = ck; *(uint2*)(pwr + 64) = cv; }
                const float4 mr = *(const float4*)(cst + c4), mk = *(const float4*)(cst + 64 + c4), mv = *(const float4*)(cst + 128 + c4);
                const float c_[12] = {__uint_as_float(cr.x << 16), __uint_as_float(cr.x & 0xFFFF0000u), __uint_as_float(cr.y << 16), __uint_as_float(cr.y & 0xFFFF0000u),
                                      __uint_as_float(ck.x << 16), __uint_as_float(ck.x & 0xFFFF0000u), __uint_as_float(ck.y << 16), __uint_as_float(ck.y & 0xFFFF0000u),
                                      __uint_as_float(cv.x << 16), __uint_as_float(cv.x & 0xFFFF0000u), __uint_as_float(cv.y << 16), __uint_as_float(cv.y & 0xFFFF0000u)};
                const float q_[12] = {__uint_as_float(qr.x << 16), __uint_as_float(qr.x & 0xFFFF0000u), __uint_as_float(qr.y << 16), __uint_as_float(qr.y & 0xFFFF0000u),
                                      __uint_as_float(qk.x << 16), __uint_as_float(qk.x & 0xFFFF0000u), __uint_as_float(qk.y << 16), __uint_as_float(qk.y & 0xFFFF0000u),
                                      __uint_as_float(qv.x << 16), __uint_as_float(qv.x & 0xFFFF0000u), __uint_as_float(qv.y << 16), __uint_as_float(qv.y & 0xFFFF0000u)};
                const float m_[12] = {mr.x, mr.y, mr.z, mr.w, mk.x, mk.y, mk.z, mk.w, mv.x, mv.y, mv.z, mv.w};
#pragma unroll
                for (int j = 0; j < 4; ++j) { rr[j] = c_[j] + (q_[j] - c_[j]) * m_[j]; kr[j] = c_[4 + j] + (q_[4 + j] - c_[4 + j]) * m_[4 + j]; vv[j] = c_[8 + j] + (q_[8 + j] - c_[8 + j]) * m_[8 + j]; }
            }
            if (l > 0) {
                const float4 xv4 = *(const float4*)(s_o + e), cv = *(const float4*)(cst + 928 + c4);
                const uint2 vfu = *(const uint2*)(raw + tau * SC_ROWB + 960 + c4 * 2);
                const float vf[4] = {__uint_as_float(vfu.x << 16), __uint_as_float(vfu.x & 0xFFFF0000u), __uint_as_float(vfu.y << 16), __uint_as_float(vfu.y & 0xFFFF0000u)};
                const float xv[4] = {xv4.x + cv.x, xv4.y + cv.y, xv4.z + cv.z, xv4.w + cv.w};
#pragma unroll
                for (int j = 0; j < 4; ++j) vv[j] = vv[j] + (vf[j] - vv[j]) * fast_sigmoid(xv[j]);
            } else if (t < TS) {
                *(uint2*)(vfirst + n * 1024 + hc + c4) = pack4(vv[0], vv[1], vv[2], vv[3]);
            }
            float av[4], kkv[4], ginc[4], gexc[4], ginv[4]; float ss = 0.f;
#pragma unroll
            for (int j = 0; j < 4; ++j) {
                ginc[j] = __expf(cum[j]); gexc[j] = __expf(cum[j] - lw[j]); ginv[j] = __expf(-cum[j]);
                av[j] = fast_sigmoid(xa[j]);
                kkv[j] = kr[j] * kkc[j];
                ss += kkv[j] * kkv[j];
            }
            float kk[4], kt[4];
#pragma unroll
            for (int j = 0; j < 4; ++j) kt[j] = kr[j] * (1.0f + (av[j] - 1.0f) * kac[j]);
            float bsum = rr[0] * kt[0] * crk.x + rr[1] * kt[1] * crk.y + rr[2] * kt[2] * crk.z + rr[3] * kt[3] * crk.w;
            float du0 = 0.f, du1 = 0.f;
            row16_sum4(ss, bsum, du0, du1);
            if ((tid & 15) == 0) s_bs[tau] = bsum;
            const float rn = rsqrtf(fmaxf(ss, 1e-24f));
#pragma unroll
            for (int j = 0; j < 4; ++j) kk[j] = kkv[j] * rn;
            const uint2 pa = pack4(-kk[0] * gexc[0], -kk[1] * gexc[1], -kk[2] * gexc[2], -kk[3] * gexc[3]);
            const uint2 pr = pack4(rr[0] * ginc[0], rr[1] * ginc[1], rr[2] * ginc[2], rr[3] * ginc[3]);
            const uint2 pb = pack4(kk[0] * av[0] * ginv[0], kk[1] * av[1] * ginv[1], kk[2] * av[2] * ginv[2], kk[3] * av[3] * ginv[3]);
            const uint2 pk = pack4(kt[0] * ginv[0], kt[1] * ginv[1], kt[2] * ginv[2], kt[3] * ginv[3]);
            const uint2 pv = pack4(vv[0], vv[1], vv[2], vv[3]);
            *(uint2*)(o_at + tau * SC_LT + c4) = pa;
            *(uint2*)(o_rt + tau * SC_LT + c4) = pr;
            *(uint2*)(o_bt + tau * SC_LT + c4) = pb;
            *(uint2*)(o_kt + tau * SC_LT + c4) = pk;
            o_bT[(c4 + 0) * SC_LS + tau] = (bf16_t)(pb.x & 0xFFFFu); o_bT[(c4 + 1) * SC_LS + tau] = (bf16_t)(pb.x >> 16); o_bT[(c4 + 2) * SC_LS + tau] = (bf16_t)(pb.y & 0xFFFFu); o_bT[(c4 + 3) * SC_LS + tau] = (bf16_t)(pb.y >> 16);
            o_kT[(c4 + 0) * SC_LS + tau] = (bf16_t)(pk.x & 0xFFFFu); o_kT[(c4 + 1) * SC_LS + tau] = (bf16_t)(pk.x >> 16); o_kT[(c4 + 2) * SC_LS + tau] = (bf16_t)(pk.y & 0xFFFFu); o_kT[(c4 + 3) * SC_LS + tau] = (bf16_t)(pk.y >> 16);
            o_vT[(c4 + 0) * SC_LS + tau] = (bf16_t)(pv.x & 0xFFFFu); o_vT[(c4 + 1) * SC_LS + tau] = (bf16_t)(pv.x >> 16); o_vT[(c4 + 2) * SC_LS + tau] = (bf16_t)(pv.y & 0xFFFFu); o_vT[(c4 + 3) * SC_LS + tau] = (bf16_t)(pv.y >> 16);
            if ((tau & 15) == 15) *(float4*)(s_gc + (tau >> 4) * 64 + c4) = make_float4(ginc[0], ginc[1], ginc[2], ginc[3]);
            *(float4*)(s_v + e) = make_float4(vv[0], vv[1], vv[2], vv[3]);
        }
        lds_barrier();
        if (wid < 4) {
#pragma unroll 1
            for (int sc = 0; sc < 2; ++sc) {
                if (sc * 16 < nval) {
                    const bf16_t* ar = o_at + (sc * 16 + fr) * SC_LT;
                    const bf16_t* rr_ = o_rt + (sc * 16 + fr) * SC_LT;
                    const bf16_t* br = o_bt + (sc * 16 + fr) * SC_LT;
                    const bf16_t* kr_ = o_kt + (sc * 16 + fr) * SC_LT;
                    const bf16x8 fa0 = *(const bf16x8*)(ar + fq * 8), fa1 = *(const bf16x8*)(ar + 32 + fq * 8);
                    const bf16x8 fb0 = *(const bf16x8*)(br + fq * 8), fb1 = *(const bf16x8*)(br + 32 + fq * 8);
                    const bf16x8 fk0 = *(const bf16x8*)(kr_ + fq * 8), fk1 = *(const bf16x8*)(kr_ + 32 + fq * 8);
                    const bf16x8 fr0 = *(const bf16x8*)(rr_ + fq * 8), fr1 = *(const bf16x8*)(rr_ + 32 + fq * 8);
                    f32x4 nA = MF32(fb0, fa0, z4); nA = MF32(fb1, fa1, nA);
                    f32x4 nB = MF32(fa0, fb0, z4); nB = MF32(fa1, fb1, nB);
                    f32x4 mak = MF32(fk0, fa0, z4); mak = MF32(fk1, fa1, mak);
                    f32x4 mbr = MF32(fb0, fr0, z4); mbr = MF32(fb1, fr1, mbr);
                    f32x4 mkr = MF32(fk0, fr0, z4); mkr = MF32(fk1, fr1, mkr);
#pragma unroll
                    for (int j = 0; j < 4; ++j) {
                        const int s_ = fq * 4 + j;
                        nA[j] = (s_ < fr) ? nA[j] : 0.f; nB[j] = (fr < s_) ? nB[j] : 0.f; mak[j] = (s_ < fr) ? mak[j] : 0.f;
                        mbr[j] = (s_ <= fr) ? mbr[j] : 0.f; mkr[j] = (s_ <= fr) ? mkr[j] : 0.f;
                    }
                    const sh4 pNA = pk4v(nA), pNB = pk4v(nB), pMak = pk4v(mak), pMbr = pk4v(mbr), pMkr = pk4v(mkr);
                    const f32x4 n2B = MF16(pNA, pNB, z4), n2A = MF16(pNB, pNA, z4);
                    const sh4 pN2A = pk4v(n2A), pN2B = pk4v(n2B);
                    const f32x4 n4B = MF16(pN2A, pN2B, z4), n4A = MF16(pN2B, pN2A, z4);
                    const sh4 pN4A = pk4v(n4A), pN4B = pk4v(n4B);
                    const sh4 pN8A = pk4v(MF16(pN4B, pN4A, z4));
                    const bf16x8 sB0 = cat8(pk4v(S[0]), pk4v(S[1])), sB1 = cat8(pk4v(S[2]), pk4v(S[3]));
                    const sh4 vf = *(const sh4*)(o_vT + (wid * 16 + fr) * SC_LS + sc * 16 + fq * 4);
                    f32x4 X = MF32(cat8(*(const sh4*)(ar + fq * 4), *(const sh4*)(ar + 16 + fq * 4)), sB0, z4);
                    X = MF32(cat8(*(const sh4*)(ar + 32 + fq * 4), *(const sh4*)(ar + 48 + fq * 4)), sB1, X);
                    X = MF16(pMak, vf, X);
                    X = MF16(pN8A, pk4v(X), X); X = MF16(pN4A, pk4v(X), X); X = MF16(pN2A, pk4v(X), X); X = MF16(pNA, pk4v(X), X);
                    const sh4 pSA = pk4v(X);
                    f32x4 O = MF32(cat8(*(const sh4*)(rr_ + fq * 4), *(const sh4*)(rr_ + 16 + fq * 4)), sB0, z4);
                    O = MF32(cat8(*(const sh4*)(rr_ + 32 + fq * 4), *(const sh4*)(rr_ + 48 + fq * 4)), sB1, O);
                    const bf16x8 sav = cat8(pSA, vf);
                    O = MF32(cat8(pMbr, pMkr), sav, O);
#pragma unroll
                    for (int j = 0; j < 4; ++j) s_o[(sc * 16 + fq * 4 + j) * 64 + wid * 16 + fr] = O[j];
#pragma unroll
                    for (int jt = 0; jt < 4; ++jt) {
                        const sh4 ka = *(const sh4*)(o_kT + (jt * 16 + fr) * SC_LS + sc * 16 + fq * 4), ba = *(const sh4*)(o_bT + (jt * 16 + fr) * SC_LS + sc * 16 + fq * 4);
                        f32x4 acc = MF32(cat8(ba, ka), sav, S[jt]);
                        const float4 g4 = *(const float4*)(s_gc + sc * 64 + jt * 16 + fq * 4);
                        acc[0] *= g4.x; acc[1] *= g4.y; acc[2] *= g4.z; acc[3] *= g4.w;
                        S[jt] = acc;
                    }
                }
            }
        }
        lds_barrier();
        {
            const int tau = tid >> 4, c4 = (tid & 15) * 4, e = tau * 64 + c4;
            const size_t n = (size_t)b * TS + t0 + tau;
            const float4 o4 = *(const float4*)(s_o + e), v4_ = *(const float4*)(s_v + e), g4_ = *(const float4*)(s_g + e);
            const float4 clw = *(const float4*)(cst + 800 + c4), clb = *(const float4*)(cst + 864 + c4);
            const float bsum = s_bs[tau];
            const float m_ = row16_sum((o4.x + o4.y) + (o4.z + o4.w)) * (1.0f / 64.0f);
            const float d0 = o4.x - m_, d1 = o4.y - m_, d2 = o4.z - m_, d3 = o4.w - m_;
            const float var = row16_sum(d0 * d0 + d1 * d1 + d2 * d2 + d3 * d3) * (1.0f / 64.0f);
            const float rs = rsqrtf(var + 64e-5f);
            const float y0 = (d0 * rs * clw.x + clb.x + bsum * v4_.x) * g4_.x, y1 = (d1 * rs * clw.y + clb.y + bsum * v4_.y) * g4_.y;
            const float y2 = (d2 * rs * clw.z + clb.z + bsum * v4_.z) * g4_.z, y3 = (d3 * rs * clw.w + clb.w + bsum * v4_.w) * g4_.w;
            if (tau < nval) *(uint2*)(Pr + n * 1024 + hc + c4) = pack4(y0, y1, y2, y3);
        }
    }
}

__device__ __forceinline__ void xcd_panel_map(int& mt0, int& mstep, int& nt) {
    const int b = obid(), G = (int)gridDim.x;
    if (G == 256) { nt = (b >> 3) & 7; mt0 = (b & 7) * 4 + (b >> 6); mstep = 32; }
    else { nt = b & 7; mt0 = b >> 3; mstep = G >> 3; }
}
__device__ void phase_merge(const Params& p, unsigned char* lds) {
    const int tid = otid(), lane = tid & 63, wid = tid >> 6, wr = wid >> 1, wc = wid & 1, fr = lane & 15, fq = lane >> 4;
    const bf16_t* h = (const bf16_t*)(WS(p) + OFF_H);
    const bf16_t* wb = (const bf16_t*)(WS(p) + OFF_WB);
    const float* rstd = (const float*)(WS(p) + OFF_RSTD);
    bf16_t* merged = (bf16_t*)(WS(p) + OFF_MERGED);
    const bf16_t* ysrc0 = (const bf16_t*)(WS(p) + OFF_PPOOL);
    const bf16_t* ysrc1 = (const bf16_t*)(WS(p) + OFF_PR);
    const bf16_t* ysrc2 = (const bf16_t*)(OUTB(p) + DO_YC);
    for (int tile = obid(); tile < 86 * 8; tile += gridDim.x) {
        const int mt = tile >> 3, nt = tile & 7;
        const int row0 = mt * 192, col0 = nt * 128;
        uint2 maccp[3][4];
#pragma unroll
        for (int m = 0; m < 3; ++m)
#pragma unroll
            for (int n = 0; n < 4; ++n) maccp[m][n] = make_uint2(0u, 0u);
#pragma unroll 1
        for (int i = 0; i < 3; ++i) {
            const int tid = otid();
            const bf16_t* ys = (i == 0) ? ysrc0 : (i == 1 ? ysrc1 : ysrc2);
            uint2 sg[3][4];
            {
                f32x4 ag[3][4]; g3_zero<3>(ag);
                G3<192> g;
                g3_setup<192>(g, [&](int r) { return h + (size_t)(row0 + r) * DM; }, [&](int r) { return wb + WB_WG + (size_t)(i * 1024 + col0 + r) * DM; }, tid);
                g3_kloop<192>(ag, g, DM, lds);
#pragma unroll
                for (int m = 0; m < 3; ++m) {
                    const float rs = rstd[row0 + wr * 48 + m * 16 + fr];
#pragma unroll
                    for (int n = 0; n < 4; ++n) sg[m][n] = pack4(fast_sigmoid(ag[m][n][0] * rs), fast_sigmoid(ag[m][n][1] * rs), fast_sigmoid(ag[m][n][2] * rs), fast_sigmoid(ag[m][n][3] * rs));
                }
            }
            {
                f32x4 ay[3][4]; g3_zero<3>(ay);
                G3<192> g;
                g3_setup<192>(g, [&](int r) { return ys + (size_t)(row0 + r) * DM; }, [&](int r) { return wb + WB_PA + (size_t)(i * 1024 + col0 + r) * DM; }, tid);
                g3_kloop<192>(ay, g, DM, lds);
#pragma unroll
                for (int m = 0; m < 3; ++m)
#pragma unroll
                    for (int n = 0; n < 4; ++n) {
                        const float m0 = __uint_as_float(maccp[m][n].x << 16) + __uint_as_float(sg[m][n].x << 16) * ay[m][n][0];
                        const float m1 = __uint_as_float(maccp[m][n].x & 0xFFFF0000u) + __uint_as_float(sg[m][n].x & 0xFFFF0000u) * ay[m][n][1];
                        const float m2 = __uint_as_float(maccp[m][n].y << 16) + __uint_as_float(sg[m][n].y << 16) * ay[m][n][2];
                        const float m3 = __uint_as_float(maccp[m][n].y & 0xFFFF0000u) + __uint_as_float(sg[m][n].y & 0xFFFF0000u) * ay[m][n][3];
                        maccp[m][n] = pack4(m0, m1, m2, m3);
                    }
            }
        }
#pragma unroll
        for (int m = 0; m < 3; ++m) {
            const int row = row0 + wr * 48 + m * 16 + fr;
#pragma unroll
            for (int n = 0; n < 4; ++n)
                *(uint2*)(merged + (size_t)row * 1024 + col0 + wc * 64 + n * 16 + fq * 4) = maccp[m][n];
        }
    }
}

__device__ void phase_outproj(const Params& p, unsigned char* lds) {
    const int tid = otid(), lane = tid & 63, wid = tid >> 6, wr = wid >> 1, wc = wid & 1, fr = lane & 15, fq = lane >> 4;
    const bf16_t* h = (const bf16_t*)(WS(p) + OFF_H);
    const bf16_t* wb = (const bf16_t*)(WS(p) + OFF_WB);
    const bf16_t* merged = (const bf16_t*)(WS(p) + OFF_MERGED);
    float* hm = (float*)(WS(p) + OFF_HM32);
    int mt0, mstep, nt;
    xcd_panel_map(mt0, mstep, nt);
    for (int mt = mt0; mt < 86; mt += mstep) {
        const int row0 = mt * 192, col0 = nt * 128;
        G3<192> g;
        g3_setup<192>(g, [&](int r) { return merged + (size_t)(row0 + r) * DM; }, [&](int r) { return wb + WB_WO + (size_t)(col0 + r) * DM; }, tid);
        f32x4 acc[3][4]; g3_zero<3>(acc);
        g3_kloop<192>(acc, g, DM, lds);
        uint2 hres[3][4];
#pragma unroll
        for (int m = 0; m < 3; ++m)
#pragma unroll
            for (int n = 0; n < 4; ++n) hres[m][n] = *(const uint2*)(h + (size_t)(row0 + wr * 48 + m * 16 + fr) * 1024 + col0 + wc * 64 + n * 16 + fq * 4);
#pragma unroll
        for (int m = 0; m < 3; ++m) {
            const int row = row0 + wr * 48 + m * 16 + fr;
#pragma unroll
            for (int n = 0; n < 4; ++n) {
                const int col = col0 + wc * 64 + n * 16 + fq * 4;
                const uint2 hv = hres[m][n];
                float4 o;
                o.x = __uint_as_float(hv.x << 16) + acc[m][n][0]; o.y = __uint_as_float(hv.x & 0xFFFF0000u) + acc[m][n][1];
                o.z = __uint_as_float(hv.y << 16) + acc[m][n][2]; o.w = __uint_as_float(hv.y & 0xFFFF0000u) + acc[m][n][3];
                *(float4*)(hm + (size_t)row * 1024 + col) = o;
            }
        }
    }
}

__device__ __constant__ int c_pair_lo[6] = {0, 0, 0, 1, 1, 2};
__device__ __constant__ int c_pair_hi[6] = {1, 2, 3, 2, 3, 3};
__device__ void phase_route(const Params& p, int l, unsigned char* lds) {
    const int tid = otid(), lane = tid & 63, wid = tid >> 6;
    const int per = (NT + (int)gridDim.x - 1) / (int)gridDim.x;
    const int nbeg = obid() * per, nend = (nbeg + per < NT) ? nbeg + per : NT;
    int* s_cls = (int*)lds;
    int* s_base = s_cls + 512;
    float* s_wr = (float*)(lds + 4096);
    const float* hm = (const float*)(WS(p) + OFF_HM32);
    bf16_t* hn = (bf16_t*)(WS(p) + OFF_HN);
    const float* nf = p.in[33] + (size_t)l * 1024;
    const float* wg = p.in[34] + (size_t)l * 1024 * 4;
    const float* bg = p.in[35] + l * 4;
    const float* we = p.in[36] + (size_t)l * 1024 * 16;
    const float* be = p.in[37] + l * 16;
    int* cnt = (int*)(WS(p) + OFF_CTL);
    int* list = (int*)(WS(p) + OFF_LIST);
    float* pw = (float*)(WS(p) + OFF_PW);
    for (int e = tid; e < 1024 * 20; e += NTHR) {
        const int k = e / 20, c = e - k * 20;
        s_wr[c * 1024 + k] = (c < 4) ? wg[(size_t)k * 4 + c] : we[(size_t)k * 16 + (c - 4)];
    }
    __syncthreads();
    float4 nv[4], cur[4];
#pragma unroll
    for (int i = 0; i < 4; ++i) nv[i] = *(const float4*)(nf + i * 256 + lane * 4);
    if (nbeg + wid < nend) {
#pragma unroll
        for (int i = 0; i < 4; ++i) cur[i] = *(const float4*)(hm + (size_t)(nbeg + wid) * DM + i * 256 + lane * 4);
    }
    for (int n = nbeg + wid; n < nend; n += 8) {
        float4 xv[4]; float ss = 0.f;
#pragma unroll
        for (int i = 0; i < 4; ++i) { xv[i] = cur[i]; ss += xv[i].x * xv[i].x + xv[i].y * xv[i].y + xv[i].z * xv[i].z + xv[i].w * xv[i].w; }
        if (n + 8 < nend) {
#pragma unroll
            for (int i = 0; i < 4; ++i) cur[i] = *(const float4*)(hm + (size_t)(n + 8) * DM + i * 256 + lane * 4);
        }
        ss = wave_sum(ss);
        const float rs = rsqrtf(ss * (1.0f / 1024.0f) + 1e-6f);
        float lg[4] = {0.f, 0.f, 0.f, 0.f};
        float le[16];
#pragma unroll
        for (int e = 0; e < 16; ++e) le[e] = 0.f;
#pragma unroll
        for (int i = 0; i < 4; ++i) {
            float y[4] = {xv[i].x * rs * nv[i].x, xv[i].y * rs * nv[i].y, xv[i].z * rs * nv[i].z, xv[i].w * rs * nv[i].w};
            {
                const int d0 = i * 256 + lane * 4;
#pragma unroll
                for (int g = 0; g < 4; ++g) { const float4 w4 = *(const float4*)(s_wr + g * 1024 + d0); lg[g] += y[0] * w4.x + y[1] * w4.y + y[2] * w4.z + y[3] * w4.w; }
#pragma unroll
                for (int e = 0; e < 16; ++e) { const float4 w4 = *(const float4*)(s_wr + (4 + e) * 1024 + d0); le[e] += y[0] * w4.x + y[1] * w4.y + y[2] * w4.z + y[3] * w4.w; }
            }
            *(uint2*)(hn + (size_t)n * DM + i * 256 + lane * 4) = pack4(y[0], y[1], y[2], y[3]);
        }
#pragma unroll
        for (int g = 0; g < 4; ++g) lg[g] = wave_sum_fast(lg[g]) + bg[g];
#pragma unroll
        for (int e = 0; e < 16; ++e) le[e] = wave_sum_fast(le[e]) + be[e];
        if (lane == 0) {
            int gs = 0; float gm = lg[0];
#pragma unroll
            for (int g = 1; g < 4; ++g) if (lg[g] > gm) { gm = lg[g]; gs = g; }
            float den = 0.f;
#pragma unroll
            for (int g = 0; g < 4; ++g) den += __expf(lg[g] - gm);
            const float pgrp = 1.0f / den;
            float v4[4];
#pragma unroll
            for (int e = 0; e < 4; ++e) {
                const float m0 = (gs == 0) ? 1.f : 0.f, m1s = (gs == 1) ? 1.f : 0.f, m2s = (gs == 2) ? 1.f : 0.f, m3s = (gs == 3) ? 1.f : 0.f;
                v4[e] = le[e] * m0 + le[4 + e] * m1s + le[8 + e] * m2s + le[12 + e] * m3s;
            }
            int i1 = 0; float m1 = v4[0];
#pragma unroll
            for (int e = 1; e < 4; ++e) if (v4[e] > m1) { m1 = v4[e]; i1 = e; }
            int i2 = -1; float m2 = -INFINITY;
#pragma unroll
            for (int e = 0; e < 4; ++e) if (e != i1 && v4[e] > m2) { m2 = v4[e]; i2 = e; }
            const float e2 = __expf(m2 - m1);
            const float p1 = pgrp / (1.0f + e2), p2 = pgrp * e2 / (1.0f + e2);
            const int lo = i1 < i2 ? i1 : i2, hi = i1 < i2 ? i2 : i1;
            const float plo = i1 < i2 ? p1 : p2, phi = i1 < i2 ? p2 : p1;
            const int pi = (lo == 0) ? (hi - 1) : (lo == 1 ? hi + 1 : 5);
            const int cls = gs * 6 + pi;
            s_cls[n - nbeg] = cls;
            pw[(size_t)n * 2 + 0] = plo; pw[(size_t)n * 2 + 1] = phi;
        }
    }
    __syncthreads();
    const int nloc = nend - nbeg;
    if (tid < 24) {
        int c_ = 0;
        for (int i = 0; i < nloc; ++i) c_ += (s_cls[i] == tid) ? 1 : 0;
        s_base[tid] = c_ ? atomicAdd(&cnt[tid * 32], c_) : 0;
    }
    __syncthreads();
    for (int it = tid; it < nloc; it += NTHR) {
        const int cls = s_cls[it];
        int rank = 0;
        for (int i = 0; i < it; ++i) rank += (s_cls[i] == cls) ? 1 : 0;
        list[(size_t)cls * NT + s_base[cls] + rank] = nbeg + it;
    }
    __syncthreads();
}


struct MoeTile { int cls, ti, cnt, tg; };
__device__ __forceinline__ int moe_total_tiles(const int* cnt) { int s = 0; for (int c = 0; c < 24; ++c) s += (cnt[c * 32] + 127) >> 7; return s; }
__device__ __forceinline__ MoeTile moe_find(const int* cnt, int tile) {
    MoeTile r; int s = 0; r.cls = 0; r.ti = 0; r.cnt = 0; r.tg = tile;
    for (int c = 0; c < 24; ++c) { const int nt = (cnt[c * 32] + 127) >> 7; if (tile >= s && tile < s + nt) { r.cls = c; r.ti = tile - s; r.cnt = cnt[c * 32]; } s += nt; }
    return r;
}
__device__ void phase_moe1(const Params& p, unsigned char* lds) {
    const int tid = otid(), lane = tid & 63, wid = tid >> 6, wr = wid >> 1, wc = wid & 1, fr = lane & 15, fq = lane >> 4;
    const int* cnt = (const int*)(WS(p) + OFF_CTL);
    const int* list = (const int*)(WS(p) + OFF_LIST);
    const float* pw = (const float*)(WS(p) + OFF_PW);
    const bf16_t* hn = (const bf16_t*)(WS(p) + OFF_HN);
    const bf16_t* we = (const bf16_t*)(WS(p) + OFF_WEXP);
    bf16_t* hid = (bf16_t*)(OUTB(p) + DO_HID);
    const int total = moe_total_tiles(cnt);
    for (int item = obid(); item < total * 4; item += gridDim.x) {
        const MoeTile mt = moe_find(cnt, item >> 2);
        const int nt = item & 3, slot = nt >> 1, f0 = (nt & 1) * 128;
        const int g_ = mt.cls / 6, pi = mt.cls % 6;
        const int e = g_ * 4 + (slot == 0 ? c_pair_lo[pi] : c_pair_hi[pi]);
        const int* lst = list + (size_t)mt.cls * NT + mt.ti * 128;
        const int nvalid = min(128, mt.cnt - mt.ti * 128);
        f32x4 a1[2][4], a3[2][4]; g3_zero<2>(a1); g3_zero<2>(a3);
        G3D g;
#pragma unroll
        for (int i = 0; i < 2; ++i) {
            const int idx = tid + i * NTHR, row = idx >> 3, sl = (idx & 7) ^ (row & 7);
            g.ap[i] = hn + (size_t)lst[row < nvalid ? row : 0] * DM + sl * 8;
            g.b1[i] = we + WE_W1 + ((size_t)e * 256 + f0 + row) * 1024 + sl * 8;
            g.b3[i] = we + WE_W3 + ((size_t)e * 256 + f0 + row) * 1024 + sl * 8;
        }
        g3d_kloop(a1, a3, g, DM, lds);
        float pev[2];
#pragma unroll
        for (int m = 0; m < 2; ++m) { const int lr = wr * 32 + m * 16 + fr; pev[m] = pw[(size_t)lst[lr < nvalid ? lr : 0] * 2 + slot]; }
#pragma unroll
        for (int m = 0; m < 2; ++m) {
            const int lr = wr * 32 + m * 16 + fr;
            const float pe = pev[m];
#pragma unroll
            for (int n = 0; n < 4; ++n) {
                const int col = slot * 256 + f0 + wc * 64 + n * 16 + fq * 4;
                float o[4];
#pragma unroll
                for (int j = 0; j < 4; ++j) { const float x1 = a1[m][n][j]; o[j] = x1 * sigmoidf_(x1) * a3[m][n][j] * pe; }
                *(uint2*)(hid + ((size_t)mt.tg * 128 + lr) * 512 + col) = pack4(o[0], o[1], o[2], o[3]);
            }
        }
    }
}
__device__ void phase_moe2(const Params& p, int l, unsigned char* lds) {
    const int tid = otid(), lane = tid & 63, wid = tid >> 6, wr = wid >> 1, wc = wid & 1, fr = lane & 15, fq = lane >> 4;
    const int* cnt = (const int*)(WS(p) + OFF_CTL);
    const int* list = (const int*)(WS(p) + OFF_LIST);
    const bf16_t* we = (const bf16_t*)(WS(p) + OFF_WEXP);
    const bf16_t* hid = (const bf16_t*)(OUTB(p) + DO_HID);
    float* hm = (float*)(WS(p) + OFF_HM32);
    bf16_t* h = (bf16_t*)(WS(p) + OFF_H);
    const int total = moe_total_tiles(cnt);
    for (int item = obid(); item < total * 8; item += gridDim.x) {
        const MoeTile mt = moe_find(cnt, item >> 3);
        const int nt = item & 7, col0 = nt * 128;
        const int g_ = mt.cls / 6, pi = mt.cls % 6;
        const int elo = g_ * 4 + c_pair_lo[pi], ehi = g_ * 4 + c_pair_hi[pi];
        const int* lst = list + (size_t)mt.cls * NT + mt.ti * 128;
        const int nvalid = min(128, mt.cnt - mt.ti * 128);
        f32x4 acc[2][4]; g3_zero<2>(acc);
        G3<128> g;
        g3_setup<128>(g, [&](int r) { return hid + ((size_t)mt.tg * 128 + r) * 512; }, [&](int r) { return we + WE_W2 + ((size_t)elo * 1024 + col0 + r) * 256; }, tid);
        g3_kloop<128>(acc, g, 256, lds);
        g3_setup<128>(g, [&](int r) { return hid + ((size_t)mt.tg * 128 + r) * 512 + 256; }, [&](int r) { return we + WE_W2 + ((size_t)ehi * 1024 + col0 + r) * 256; }, tid);
        g3_kloop<128>(acc, g, 256, lds);
        int tkv[2]; float4 hv[2][4];
#pragma unroll
        for (int m = 0; m < 2; ++m) {
            const int lr = wr * 32 + m * 16 + fr;
            tkv[m] = lst[lr < nvalid ? lr : 0];
#pragma unroll
            for (int n = 0; n < 4; ++n) hv[m][n] = *(const float4*)(hm + (size_t)tkv[m] * 1024 + col0 + wc * 64 + n * 16 + fq * 4);
        }
#pragma unroll
        for (int m = 0; m < 2; ++m) {
            const int lr = wr * 32 + m * 16 + fr;
            if (lr < nvalid) {
                const int tk = tkv[m];
#pragma unroll
                for (int n = 0; n < 4; ++n) {
                    const int col = col0 + wc * 64 + n * 16 + fq * 4;
                    float4 v = hv[m][n];
                    v.x += acc[m][n][0]; v.y += acc[m][n][1]; v.z += acc[m][n][2]; v.w += acc[m][n][3];
                    if (l == 0) *(uint2*)(h + (size_t)tk * 1024 + col) = pack4(v.x, v.y, v.z, v.w);
                    else *(float4*)(hm + (size_t)tk * 1024 + col) = v;
                }
            }
        }
    }
}

__device__ void phase_final(const Params& p) {
    const int lane = otid() & 63;
    const int wave = (obid() * NTHR + otid()) >> 6, nw = gridDim.x * NTHR / 64;
    const float* hm = (const float*)(WS(p) + OFF_HM32);
    const float* nf = p.in[41];
    float4 g[4], cur[4];
#pragma unroll
    for (int i = 0; i < 4; ++i) g[i] = *(const float4*)(nf + i * 256 + lane * 4);
    auto rowp = [&](int r) { const int b = r / SEQ, s_ = r % SEQ; return hm + ((size_t)b * TS + NMETA + s_) * DM; };
    if (wave < NB * SEQ) {
        const float* src = rowp(wave);
#pragma unroll
        for (int i = 0; i < 4; ++i) cur[i] = *(const float4*)(src + i * 256 + lane * 4);
    }
    for (int r = wave; r < NB * SEQ; r += nw) {
        float4 v[4]; float ss = 0.f;
#pragma unroll
        for (int i = 0; i < 4; ++i) { v[i] = cur[i]; ss += v[i].x * v[i].x + v[i].y * v[i].y + v[i].z * v[i].z + v[i].w * v[i].w; }
        if (r + nw < NB * SEQ) {
            const float* src = rowp(r + nw);
#pragma unroll
            for (int i = 0; i < 4; ++i) cur[i] = *(const float4*)(src + i * 256 + lane * 4);
        }
        ss = wave_sum(ss);
        const float rs = rsqrtf(ss * (1.0f / 1024.0f) + 1e-6f);
#pragma unroll
        for (int i = 0; i < 4; ++i) {
            float4 o; o.x = v[i].x * rs * g[i].x; o.y = v[i].y * rs * g[i].y; o.z = v[i].z * rs * g[i].z; o.w = v[i].w * rs * g[i].w;
            *(float4*)((float*)OUTB(p) + (size_t)r * DM + i * 256 + lane * 4) = o;
        }
    }
}


#define XB_TMO      128
#define XB_XCNT(j)  (256  + 64 * (j))
#define XB_XSUB(j)  (1280 + 64 * (j))
#define XB_XGEN(j)  (2304 + 64 * (j))
#define XB_TOP      3328
#define XB_TOPGEN   3392
#define XCD_BAR_WORDS 3456
#define XB_SPIN_CAP (1u << 22)
#define LAS __attribute__((address_space(3)))
__device__ __forceinline__ unsigned xb_ld(unsigned* p) { return __hip_atomic_load(p, __ATOMIC_RELAXED, __HIP_MEMORY_SCOPE_AGENT); }
__device__ __forceinline__ unsigned xb_add(unsigned* p, unsigned v) { return __hip_atomic_fetch_add(p, v, __ATOMIC_RELAXED, __HIP_MEMORY_SCOPE_AGENT); }
__device__ __forceinline__ unsigned xb_xcc_id() { return (unsigned)__builtin_amdgcn_s_getreg((3 << 11) | 20) & 0xFu; }
#define XB_SPIN(cond, bar) do { unsigned _sp = 0; while (cond) { __builtin_amdgcn_s_sleep(1); \
    if ((++_sp & 255u) == 0u) { if (xb_ld(&(bar)[XB_TMO])) break; if (_sp > XB_SPIN_CAP) { atomicAdd(&(bar)[XB_TMO], 1u); break; } } } } while (0)
struct XcdBarrier { unsigned* bar; unsigned x; volatile LAS unsigned* st; };
__device__ __forceinline__ XcdBarrier xcd_barrier_post(unsigned* bar, volatile LAS unsigned* st) {
    XcdBarrier b; b.bar = bar; b.x = xb_xcc_id(); b.st = st;
    if (threadIdx.x == 0) (void)xb_add(&bar[XB_XCNT(b.x)], 1u);
    return b;
}
__device__ __forceinline__ void xcd_barrier_complete(unsigned* bar, unsigned x, unsigned& nloc, unsigned& nx) {
    const unsigned G = gridDim.x * gridDim.y * gridDim.z;
    unsigned sum, cnt, mine, sp = 0u;
    for (;;) {
        sum = 0u; cnt = 0u; mine = 0u;
#pragma unroll
        for (unsigned j = 0; j < 16; ++j) { const unsigned c = xb_ld(&bar[XB_XCNT(j)]); sum += c; cnt += (c > 0u) ? 1u : 0u; mine = (j == x) ? c : mine; }
        if (sum == G) break;
        __builtin_amdgcn_s_sleep(1);
        if ((++sp & 255u) == 0u) { if (xb_ld(&bar[XB_TMO])) break; if (sp > XB_SPIN_CAP) { atomicAdd(&bar[XB_TMO], 1u); break; } }
    }
    nloc = mine > 0u ? mine : 1u; nx = cnt > 0u ? cnt : 1u;
}
__device__ __forceinline__ void xcd_barrier(const XcdBarrier& b) {
    asm volatile("s_waitcnt vmcnt(0)" ::: "memory");
    __syncthreads();
    if (threadIdx.x == 0) {
        unsigned* bar = b.bar;
        __builtin_amdgcn_s_waitcnt(0);
        unsigned nloc = b.st[0], nx = b.st[1];
        if (nloc == 0u) { xcd_barrier_complete(bar, b.x, nloc, nx); b.st[0] = nloc; b.st[1] = nx; }
        const unsigned old = xb_add(&bar[XB_XSUB(b.x)], 1u);
        const unsigned gen = old / nloc;
        if (old + 1u == (gen + 1u) * nloc) {
            __builtin_amdgcn_fence(__ATOMIC_RELEASE, "agent");
            asm volatile("s_waitcnt vmcnt(0)" ::: "memory");
            const unsigned og = xb_add(&bar[XB_TOP], 1u);
            const unsigned tg = og / nx;
            if (og + 1u == (tg + 1u) * nx) xb_add(&bar[XB_TOPGEN], 1u);
            else XB_SPIN(xb_ld(&bar[XB_TOPGEN]) == tg, bar);
            __builtin_amdgcn_fence(__ATOMIC_ACQUIRE, "agent");
            xb_add(&bar[XB_XGEN(b.x)], 1u);
            asm volatile("s_waitcnt vmcnt(0)" ::: "memory");
        } else {
            XB_SPIN(xb_ld(&bar[XB_XGEN(b.x)]) == gen, bar);
            __builtin_amdgcn_fence(__ATOMIC_ACQUIRE, "agent");
            asm volatile("s_waitcnt vmcnt(0)" ::: "memory");
        }
    }
    __syncthreads();
}

__global__ void __launch_bounds__(NTHR) fwd_megakernel(Params p) {
    extern __shared__ __attribute__((aligned(16))) unsigned char lds[];
    cg::grid_group grid = cg::this_grid();
    volatile LAS unsigned* xst = (volatile LAS unsigned*)(lds + LDS_BYTES - 32);
    if (threadIdx.x < 2) xst[threadIdx.x] = 0u;
    __syncthreads();
    const XcdBarrier xb = xcd_barrier_post((unsigned*)(p.ws + OFF_BAR), xst);
    if (p.out == nullptr) grid.sync();
#pragma unroll 1
    for (int step = 0; step < 18; ++step) {
        const int l = step >= 9 ? 1 : 0;
        const int ph = step - l * 9;
        switch (ph) {
        case 0:
            if (l == 0) phase_embed(p); else phase_rowstat(p);
            phase_convert<false>(p, l, lds);
            if (obid() == 0 && otid() < 24) ((int*)(WS(p) + OFF_CTL))[otid() * 32] = 0;
            if (obid() == 0 && otid() == 32) ((int*)(WS(p) + OFF_CTL))[800 + l * 32] = 0;
            break;
        case 1: phase_inproj(p, lds); break;
        case 2: phase_dsa_prep(p, l); phase_lr_prep(p, l); break;
        case 3: {
            if (obid() < NB * 16) phase_scan5(p, l, lds, obid());
            int* qctr = (int*)(WS(p) + OFF_CTL) + 800 + l * 32;
            int* qslot = (int*)(lds + LDS_BYTES - 16);
            for (;;) {
                __syncthreads();
                if (otid() == 0) *qslot = atomicAdd(qctr, 1);
                __syncthreads();
                const int item = *qslot;
                if (item >= 516 + NT / 32 + 3072) break;
                if (item < 516) phase_pool(p, l, lds, item, item + 1, 1);
                else if (item < 516 + NT / 32) phase_dsa<false>(p, l, lds, (bf16_t*)(OUTB(p) + DO_YC), nullptr, nullptr, item - 516, item - 515, 1);
                else {
                    const int ct = item - (516 + NT / 32);
                    const ConvJob cj = get_job_late(p, l, ct >> 10);
                    conv_tile(cj, ct & 1023, (float*)lds);
                }
            }
        } break;
        case 4: phase_merge(p, lds); break;
        case 5: phase_outproj(p, lds); break;
        case 6: phase_route(p, l, lds); break;
        case 7: phase_moe1(p, lds); break;
        default: phase_moe2(p, l, lds); break;
        }
        xcd_barrier(xb);
    }
    phase_final(p);
}

extern "C" void kernel_launch(void* const* d_in, const int* in_sizes, int n_in,
                              void* d_out, int out_size, void* d_ws, size_t ws_size,
                              hipStream_t stream) {
    static int grid_blocks = 0;
    if (grid_blocks == 0) {
        int dev = 0, cus = 0, per_cu = 0;
        (void)hipGetDevice(&dev);
        (void)hipDeviceGetAttribute(&cus, hipDeviceAttributeMultiprocessorCount, dev);
        (void)hipFuncSetAttribute((const void*)fwd_megakernel, hipFuncAttributeMaxDynamicSharedMemorySize, LDS_BYTES);
        (void)hipOccupancyMaxActiveBlocksPerMultiprocessor(&per_cu, fwd_megakernel, NTHR, LDS_BYTES);
        if (per_cu < 1 || cus < NB * 16 || (cus & 7) != 0 || n_in != 42 || ws_size < WS_END + (size_t)QS_WS * QS_BYTES || cus > QS_WS + QS_DO) { fprintf(stderr, "kernel_launch: bad config per_cu=%d n_in=%d ws=%zu need=%zu\n", per_cu, n_in, ws_size, (size_t)WS_END); grid_blocks = -1; }
        else grid_blocks = cus;
    }
    if (grid_blocks < 0) return;
    Params p{};
    for (int i = 0; i < 42; ++i) p.in[i] = (const float*)d_in[i];
    p.out = (float*)d_out;
    p.ws = (unsigned char*)d_ws;
    (void)hipMemsetAsync((unsigned char*)d_ws + OFF_BAR, 0, XCD_BAR_WORDS * 4, stream);
    void* args[] = {&p};
    hipError_t e = hipLaunchCooperativeKernel((void*)fwd_megakernel, dim3(grid_blocks), dim3(NTHR), args, LDS_BYTES, stream);
    if (e != hipSuccess) fprintf(stderr, "cooperative launch failed: %s (grid %d)\n", hipGetErrorString(e), grid_blocks);
}
```

```cpp
#include <hip/hip_runtime.h>
#include <hip/hip_cooperative_groups.h>
#include <cstdio>
#include <cstdint>
#include <type_traits>
namespace cg = cooperative_groups;

typedef unsigned short bf16_t;
typedef short bf16x8 __attribute__((ext_vector_type(8)));
typedef float f32x4 __attribute__((ext_vector_type(4)));

constexpr int NB = 8, SEQ = 2048, NMETA = 16, TS = 2064, DM = 1024;
constexpr int NT = NB * TS;
constexpr int NTP = 16640;
constexpr int NTHR = 512;
constexpr int CIN = 7912;
constexpr int NP1 = 4864;
constexpr int PM_LD = 768;
constexpr int PM_WD = 0, PM_AD = 64, PM_GD = 128, PM_VD = 256, PM_CQ = 288, PM_CKV = 544, PM_KROPE = 672, PM_KIDX = 704;
constexpr int LDS_BYTES = 157 * 1024;

constexpr size_t AL(size_t x) { return (x + 255) & ~(size_t)255; }
constexpr size_t SZ_ACT = (size_t)NTP * 1024 * 2;
constexpr size_t OFF_CTL = 0;
constexpr size_t OFF_BAR = 4096;
constexpr size_t OFF_RSTD = OFF_BAR + 16384;
constexpr size_t OFF_ROPE = OFF_RSTD + AL((size_t)NTP * 4);
constexpr size_t OFF_H = OFF_ROPE + AL((size_t)TS * 16 * 4 * 2);
constexpr size_t OFF_WB = OFF_H + SZ_ACT;
constexpr size_t WB_WIN = 0;
constexpr size_t WB_WG = WB_WIN + (size_t)NP1 * 1024;
constexpr size_t WB_PA = WB_WG + (size_t)3072 * 1024;
constexpr size_t WB_WO = WB_PA + (size_t)3 * 1024 * 1024;
constexpr size_t WB_POOL = WB_WO + (size_t)1024 * 1024;
constexpr size_t WB_QI = WB_POOL + (size_t)4 * 256 * 256;
constexpr size_t WB_UQ = WB_QI + (size_t)512 * 256;
constexpr size_t WB_UK = WB_UQ + (size_t)1536 * 256;
constexpr size_t WB_UV = WB_UK + (size_t)16 * 128 * 64;
constexpr size_t WB_WIDX = WB_UV + (size_t)16 * 64 * 128;
constexpr size_t WB_END = WB_WIDX + (size_t)64 * 1024;
constexpr size_t OFF_PPOOL = OFF_WB + AL(WB_END * 2);
constexpr size_t OFF_PK = OFF_PPOOL + SZ_ACT;
constexpr size_t OFF_PR = OFF_PK + SZ_ACT;
constexpr size_t OFF_PV = OFF_PR + SZ_ACT;
constexpr size_t OFF_PMISC = OFF_PV + SZ_ACT;
constexpr size_t OFF_VFIRST = OFF_PMISC + AL((size_t)NTP * PM_LD * 2);
constexpr size_t OFF_HALO = OFF_VFIRST + SZ_ACT;
constexpr size_t OFF_LIST = OFF_HALO + AL((size_t)130 * 16 * 1024 * 2);
constexpr size_t OFF_PW = OFF_LIST + AL((size_t)24 * NT * 4);
constexpr size_t WS_END = OFF_PW + AL((size_t)NT * 2 * 4);
constexpr size_t OFF_MERGED = OFF_PK;
constexpr size_t OFF_HM32 = OFF_PR;
constexpr size_t OFF_HN = OFF_PPOOL;
constexpr size_t OFF_WEXP = OFF_PMISC;
constexpr size_t WE_W1 = 0, WE_W3 = (size_t)16 * 256 * 1024, WE_W2 = (size_t)2 * 16 * 256 * 1024;
static_assert((size_t)3 * 16 * 256 * 1024 * 2 <= (size_t)NTP * PM_LD * 2, "expert weights must fit in Pmisc");
constexpr size_t DO_YC = 0;
constexpr size_t DO_CQN = DO_YC + SZ_ACT;
constexpr size_t DO_KV = DO_CQN + AL((size_t)NT * 256 * 2);
constexpr size_t DO_KIDX = DO_KV + AL((size_t)NT * 160 * 2);
constexpr size_t DO_WHEAD = DO_KIDX + AL((size_t)NT * 64 * 2);
constexpr size_t DO_ALR = DO_WHEAD + AL((size_t)NT * 8 * 4);
constexpr size_t DO_END = DO_ALR + AL((size_t)NT * 288 * 2);
constexpr size_t QS_BYTES = (size_t)16 * 16 * 160 * 2;
constexpr int QS_WS = (int)((277240096ull - WS_END) / QS_BYTES), QS_DO = (int)(((size_t)NB * SEQ * DM * 4 - DO_END) / QS_BYTES);
static_assert(QS_WS + QS_DO >= 256, "Q scratch");
constexpr size_t DO_HID = DO_YC;
static_assert(DO_END <= (size_t)NB * SEQ * DM * 4, "d_out scratch overflow");
static_assert((size_t)(129 + 24) * 128 * 512 * 2 <= SZ_ACT, "hid fits");
static_assert(WS_END <= 277240096ull, "workspace overflow");

struct Params {
    const float* in[42];
    float* out;
    unsigned char* ws;
};

__device__ __forceinline__ int otid() { int t = threadIdx.x; asm volatile("" : "+v"(t)); return t; }
__device__ __forceinline__ int obid() { int b = blockIdx.x; asm volatile("" : "+s"(b)); return b; }
typedef __attribute__((address_space(1))) unsigned char gas_uchar;
__device__ __forceinline__ unsigned char* WS(const Params& p) { gas_uchar* w = (gas_uchar*)p.ws; asm volatile("" : "+s"(w)); return (unsigned char*)w; }
__device__ __forceinline__ unsigned char* OUTB(const Params& p) { gas_uchar* w = (gas_uchar*)p.out; asm volatile("" : "+s"(w)); return (unsigned char*)w; }
__device__ __forceinline__ float bf2f(bf16_t v) { return __uint_as_float(((unsigned)v) << 16); }
typedef float f32x2v __attribute__((ext_vector_type(2)));
typedef __bf16 bf16x2v __attribute__((ext_vector_type(2)));
__device__ __forceinline__ unsigned pk2(float a, float b) { const f32x2v v = {a, b}; const bf16x2v r = __builtin_convertvector(v, bf16x2v); unsigned u; __builtin_memcpy(&u, &r, 4); return u; }
__device__ __forceinline__ bf16_t f2bf(float f) { const __bf16 h = (__bf16)f; bf16_t u; __builtin_memcpy(&u, &h, 2); return u; }
__device__ __forceinline__ float wave_sum(float v) {
#pragma unroll
    for (int o = 32; o > 0; o >>= 1) v += __shfl_xor(v, o);
    return v;
}
template <int CTRL> __device__ __forceinline__ float dpp_f(float x) {
    return __int_as_float(__builtin_amdgcn_update_dpp(0, __float_as_int(x), CTRL, 0xF, 0xF, true));
}
__device__ __forceinline__ float row16_sum(float v) {
    v += dpp_f<0xB1>(v);
    v += dpp_f<0x4E>(v);
    v += dpp_f<0x141>(v);
    v += dpp_f<0x140>(v);
    return v;
}
__device__ __forceinline__ void lds_barrier() { asm volatile("s_waitcnt lgkmcnt(0)" ::: "memory"); __builtin_amdgcn_s_barrier(); asm volatile("" ::: "memory"); }
__device__ __forceinline__ float fast_rcp(float x) { return __builtin_amdgcn_rcpf(x); }
__device__ __forceinline__ float fast_sigmoid(float x) { return fast_rcp(1.0f + __expf(-x)); }
__device__ __forceinline__ float fast_tanh(float x) { return 1.0f - 2.0f * fast_rcp(1.0f + __expf(2.0f * x)); }
__device__ __forceinline__ void row16_sum4(float& a, float& b, float& c, float& d) {
    asm volatile(
        "s_nop 1\n\t"
        "v_add_f32_dpp %0, %0, %0 quad_perm:[1,0,3,2] row_mask:0xf bank_mask:0xf\n\t"
        "v_add_f32_dpp %1, %1, %1 quad_perm:[1,0,3,2] row_mask:0xf bank_mask:0xf\n\t"
        "v_add_f32_dpp %2, %2, %2 quad_perm:[1,0,3,2] row_mask:0xf bank_mask:0xf\n\t"
        "v_add_f32_dpp %3, %3, %3 quad_perm:[1,0,3,2] row_mask:0xf bank_mask:0xf\n\t"
        "v_add_f32_dpp %0, %0, %0 quad_perm:[2,3,0,1] row_mask:0xf bank_mask:0xf\n\t"
        "v_add_f32_dpp %1, %1, %1 quad_perm:[2,3,0,1] row_mask:0xf bank_mask:0xf\n\t"
        "v_add_f32_dpp %2, %2, %2 quad_perm:[2,3,0,1] row_mask:0xf bank_mask:0xf\n\t"
        "v_add_f32_dpp %3, %3, %3 quad_perm:[2,3,0,1] row_mask:0xf bank_mask:0xf\n\t"
        "v_add_f32_dpp %0, %0, %0 row_half_mirror row_mask:0xf bank_mask:0xf\n\t"
        "v_add_f32_dpp %1, %1, %1 row_half_mirror row_mask:0xf bank_mask:0xf\n\t"
        "v_add_f32_dpp %2, %2, %2 row_half_mirror row_mask:0xf bank_mask:0xf\n\t"
        "v_add_f32_dpp %3, %3, %3 row_half_mirror row_mask:0xf bank_mask:0xf\n\t"
        "v_add_f32_dpp %0, %0, %0 row_mirror row_mask:0xf bank_mask:0xf\n\t"
        "v_add_f32_dpp %1, %1, %1 row_mirror row_mask:0xf bank_mask:0xf\n\t"
        "v_add_f32_dpp %2, %2, %2 row_mirror row_mask:0xf bank_mask:0xf\n\t"
        "v_add_f32_dpp %3, %3, %3 row_mirror row_mask:0xf bank_mask:0xf\n\t"
        "s_nop 1"
        : "+v"(a), "+v"(b), "+v"(c), "+v"(d));
}
__device__ __forceinline__ void row8_sum2(float& a, float& b) {
    asm volatile(
        "s_nop 1\n\t"
        "v_add_f32_dpp %0, %0, %0 quad_perm:[1,0,3,2] row_mask:0xf bank_mask:0xf\n\t"
        "v_add_f32_dpp %1, %1, %1 quad_perm:[1,0,3,2] row_mask:0xf bank_mask:0xf\n\t"
        "s_nop 0\n\t"
        "v_add_f32_dpp %0, %0, %0 quad_perm:[2,3,0,1] row_mask:0xf bank_mask:0xf\n\t"
        "v_add_f32_dpp %1, %1, %1 quad_perm:[2,3,0,1] row_mask:0xf bank_mask:0xf\n\t"
        "s_nop 0\n\t"
        "v_add_f32_dpp %0, %0, %0 row_half_mirror row_mask:0xf bank_mask:0xf\n\t"
        "v_add_f32_dpp %1, %1, %1 row_half_mirror row_mask:0xf bank_mask:0xf\n\t"
        "s_nop 1"
        : "+v"(a), "+v"(b));
}
__device__ __forceinline__ float wave_sum_fast(float v) { v = row16_sum(v); v += __shfl_xor(v, 16); v += __shfl_xor(v, 32); return v; }
__device__ __forceinline__ float sigmoidf_(float x) { return 1.0f / (1.0f + __expf(-x)); }
__device__ __forceinline__ float softplusf_(float z) { return fmaxf(z, 0.f) + log1pf(__expf(-fabsf(z))); }
__device__ __forceinline__ void glds16(const void* g, void* l) {
    __builtin_amdgcn_global_load_lds((const unsigned*)g, (unsigned*)l, 16, 0, 0);
}

__device__ void phase_embed(const Params& p) {
    const int lane = otid() & 63;
    const int wave = (obid() * NTHR + otid()) >> 6, nw = gridDim.x * NTHR / 64;
    bf16_t* h = (bf16_t*)(WS(p) + OFF_H);
    float* rstd = (float*)(WS(p) + OFF_RSTD);
    auto srcrow = [&](int n) { const int b = n / TS, t = n % TS; return t < NMETA ? p.in[1] + (size_t)t * DM : p.in[0] + ((size_t)b * SEQ + (t - NMETA)) * DM; };
    float4 cur[4];
    if (wave < NT) {
        const float* src = srcrow(wave);
#pragma unroll
        for (int i = 0; i < 4; ++i) cur[i] = *(const float4*)(src + i * 256 + lane * 4);
    }
    for (int n = wave; n < NTP; n += nw) {
        if (n < NT) {
            float4 v[4];
#pragma unroll
            for (int i = 0; i < 4; ++i) v[i] = cur[i];
            if (n + nw < NT) {
                const float* src = srcrow(n + nw);
#pragma unroll
                for (int i = 0; i < 4; ++i) cur[i] = *(const float4*)(src + i * 256 + lane * 4);
            }
            float ss = 0.f;
#pragma unroll
            for (int i = 0; i < 4; ++i) {
                ss += v[i].x * v[i].x + v[i].y * v[i].y + v[i].z * v[i].z + v[i].w * v[i].w;
                *(uint2*)(h + (size_t)n * DM + i * 256 + lane * 4) = make_uint2(pk2(v[i].x, v[i].y), pk2(v[i].z, v[i].w));
            }
            ss = wave_sum(ss);
            if (lane == 0) rstd[n] = rsqrtf(ss * (1.0f / 1024.0f) + 1e-6f);
        } else {
#pragma unroll
            for (int i = 0; i < 4; ++i) *(ushort4*)(h + (size_t)n * DM + i * 256 + lane * 4) = make_ushort4(0, 0, 0, 0);
            if (lane == 0) rstd[n] = 0.f;
        }
    }
    float* ctab = (float*)(WS(p) + OFF_ROPE);
    float* stab = ctab + TS * 16;
    for (int idx = obid() * NTHR + otid(); idx < TS * 16; idx += gridDim.x * NTHR) {
        const int t = idx >> 4, i = idx & 15;
        const float inv = powf(10000.0f, -(float)(2 * i) / 32.0f);
        const float ang = (float)t * inv;
        ctab[idx] = cosf(ang);
        stab[idx] = sinf(ang);
    }
}

__device__ void phase_rowstat(const Params& p) {
    const int lane = otid() & 63;
    const int wave = (obid() * NTHR + otid()) >> 6, nw = gridDim.x * NTHR / 64;
    const bf16_t* hb = (const bf16_t*)(WS(p) + OFF_H);
    float* rstd = (float*)(WS(p) + OFF_RSTD);
    uint4 cur[2];
    if (wave < NT) { cur[0] = *(const uint4*)(hb + (size_t)wave * DM + lane * 8); cur[1] = *(const uint4*)(hb + (size_t)wave * DM + 512 + lane * 8); }
    for (int n = wave; n < NT; n += nw) {
        float ss = 0.f;
#pragma unroll
        for (int i = 0; i < 2; ++i) {
            const unsigned w_[4] = {cur[i].x, cur[i].y, cur[i].z, cur[i].w};
#pragma unroll
            for (int j = 0; j < 4; ++j) { const float a_ = __uint_as_float(w_[j] << 16), b_ = __uint_as_float(w_[j] & 0xFFFF0000u); ss += a_ * a_ + b_ * b_; }
        }
        if (n + nw < NT) { cur[0] = *(const uint4*)(hb + (size_t)(n + nw) * DM + lane * 8); cur[1] = *(const uint4*)(hb + (size_t)(n + nw) * DM + 512 + lane * 8); }
        ss = wave_sum(ss);
        if (lane == 0) rstd[n] = rsqrtf(ss * (1.0f / 1024.0f) + 1e-6f);
    }
}

struct ConvJob { const float* src; bf16_t* dst; const float* scale; int ldsrc, K, nvalid, nrows, nb, notr; size_t sbs, dbs; const float* srcB; int ldB, split; };
__device__ __forceinline__ int conv_job_tiles(const ConvJob& j) { return j.nb * (j.nrows >> 6) * (j.K >> 6); }
__device__ void conv_tile(const ConvJob& j, int tile, float* lds) {
    const int per = (j.nrows >> 6) * (j.K >> 6);
    const int bi = tile / per, rem = tile % per;
    const int ktiles = j.K >> 6;
    const int n0 = (rem / ktiles) << 6, k0 = (rem % ktiles) << 6;
    const int tid = otid(), tn = tid & 63, tk = tid >> 6;
    const float* src = j.src + (size_t)bi * j.sbs;
    bf16_t* dst = j.dst + (size_t)bi * j.dbs;
#pragma unroll
    for (int kk = 0; kk < 8; ++kk) {
        const int k = k0 + tk * 8 + kk;
        float v = 0.f;
        if (n0 + tn < j.nvalid) {
            if (j.split) { const int nn = n0 + tn; v = (nn < j.split) ? (j.src ? j.src[(size_t)k * j.ldsrc + nn] : 0.f) : j.srcB[(size_t)k * j.ldB + (nn - j.split)]; }
            else v = j.notr ? src[(size_t)(n0 + tn) * j.ldsrc + k] : src[(size_t)k * j.ldsrc + n0 + tn];
            if (j.scale) v *= j.scale[k];
        }
        lds[tn * 65 + tk * 8 + kk] = v;
    }
    __syncthreads();
    const int wn = tid >> 3, kq = tid & 7;
    uint4 o;
    unsigned w[4];
#pragma unroll
    for (int q = 0; q < 4; ++q) {
        const float lo = lds[wn * 65 + kq * 8 + 2 * q], hi = lds[wn * 65 + kq * 8 + 2 * q + 1];
        w[q] = pk2(lo, hi);
    }
    o.x = w[0]; o.y = w[1]; o.z = w[2]; o.w = w[3];
    *(uint4*)(dst + (size_t)(n0 + wn) * j.K + k0 + kq * 8) = o;
    __syncthreads();
}
__device__ ConvJob get_job_early(const Params& p, int l, int ji) {
    bf16_t* wb = (bf16_t*)(WS(p) + OFF_WB);
    const float* win = p.in[3] + (size_t)l * DM * CIN;
    const float* nm = p.in[2] + (size_t)l * DM;
    ConvJob j{}; j.nb = 1; j.sbs = 0; j.dbs = 0; j.K = 1024; j.ldsrc = CIN; j.scale = nm;
    switch (ji) {
    case 0: j.src = win + 3072; j.dst = wb + WB_WIN; j.nvalid = 4352; j.nrows = 4352; break;
    case 1: j.src = (l == 0 ? nullptr : p.in[17]); j.ldsrc = 32; j.split = 32; j.srcB = win + 7424; j.ldB = CIN; j.dst = wb + WB_WIN + (size_t)(4096 + PM_VD) * 1024; j.nvalid = 512; j.nrows = 512; break;
    case 2: j.src = win + 7904; j.dst = wb + WB_WIDX; j.nvalid = 8; j.nrows = 64; break;
    case 3: j.src = win; j.dst = wb + WB_WG; j.nvalid = 3072; j.nrows = 3072; break;
    case 4: j.src = p.in[29] + (size_t)l * DM * DM; j.ldsrc = 1024; j.scale = nullptr; j.dst = wb + WB_PA; j.nvalid = 1024; j.nrows = 1024; break;
    case 5: j.src = p.in[30] + (size_t)l * DM * DM; j.ldsrc = 1024; j.scale = nullptr; j.dst = wb + WB_PA + (size_t)1024 * 1024; j.nvalid = 1024; j.nrows = 1024; break;
    case 6: j.src = p.in[31] + (size_t)l * DM * DM; j.ldsrc = 1024; j.scale = nullptr; j.dst = wb + WB_PA + (size_t)2 * 1024 * 1024; j.nvalid = 1024; j.nrows = 1024; break;
    case 7: j.src = p.in[32] + (size_t)l * DM * DM; j.ldsrc = 1024; j.scale = nullptr; j.dst = wb + WB_WO; j.nvalid = 1024; j.nrows = 1024; break;
    case 8: j.src = p.in[5] + (size_t)l * 4 * 256 * 256; j.ldsrc = 256; j.K = 256; j.scale = nullptr; j.dst = wb + WB_POOL; j.nvalid = 256; j.nrows = 256; j.nb = 4; j.sbs = 65536; j.dbs = 65536; break;
    case 9: j.src = p.in[26] + (size_t)l * 256 * 512; j.ldsrc = 512; j.K = 256; j.scale = nullptr; j.dst = wb + WB_QI; j.nvalid = 512; j.nrows = 512; break;
    case 10: j.src = p.in[23] + (size_t)l * 256 * 1536; j.ldsrc = 1536; j.K = 256; j.scale = nullptr; j.dst = wb + WB_UQ; j.nvalid = 1536; j.nrows = 1536; break;
    case 11: j.src = p.in[24] + (size_t)l * 16 * 128 * 64; j.ldsrc = 64; j.K = 64; j.scale = nullptr; j.dst = wb + WB_UK; j.nvalid = 2048; j.nrows = 2048; j.notr = 1; break;
    default: j.src = p.in[25] + (size_t)l * 16 * 128 * 64; j.ldsrc = 64; j.K = 128; j.scale = nullptr; j.dst = wb + WB_UV; j.nvalid = 64; j.nrows = 64; j.nb = 16; j.sbs = 8192; j.dbs = 8192; break;
    }
    return j;
}
__device__ ConvJob get_job_late(const Params& p, int l, int ji) {
    bf16_t* we = (bf16_t*)(WS(p) + OFF_WEXP);
    ConvJob j{}; j.nb = 16; j.scale = nullptr; j.sbs = 262144; j.dbs = 262144;
    switch (ji) {
    case 0: j.src = p.in[38] + (size_t)l * 16 * 262144; j.dst = we + WE_W1; j.ldsrc = 256; j.K = 1024; j.nvalid = 256; j.nrows = 256; break;
    case 1: j.src = p.in[39] + (size_t)l * 16 * 262144; j.dst = we + WE_W3; j.ldsrc = 256; j.K = 1024; j.nvalid = 256; j.nrows = 256; break;
    default: j.src = p.in[40] + (size_t)l * 16 * 262144; j.dst = we + WE_W2; j.ldsrc = 1024; j.K = 256; j.nvalid = 1024; j.nrows = 1024; break;
    }
    return j;
}
template <bool LATE>
__device__ void phase_convert(const Params& p, int l, unsigned char* lds) {
    const int njobs = LATE ? 3 : 13;
    int base = 0;
    for (int ji = 0; ji < njobs; ++ji) {
        const ConvJob j = LATE ? get_job_late(p, l, ji) : get_job_early(p, l, ji);
        const int nt = conv_job_tiles(j);
        int first = ((int)obid() - base) % (int)gridDim.x; if (first < 0) first += gridDim.x;
        for (int t = first; t < nt; t += gridDim.x) conv_tile(j, t, (float*)lds);
        base += nt;
    }
}

template <int BM> struct G3 {
    static constexpr int MI = BM / 64;
    static constexpr int NA = BM / 64;
    static constexpr int STAGE = BM * 128 + 128 * 128;
    const bf16_t* ap[NA];
    const bf16_t* bp[2];
};
template <int BM>
__device__ __forceinline__ void g3_issue(const G3<BM>& g, int kt, unsigned char* stage, int tid) {
#pragma unroll
    for (int i = 0; i < G3<BM>::NA; ++i) glds16(g.ap[i] + kt * 64, stage + (tid + i * NTHR) * 16);
#pragma unroll
    for (int i = 0; i < 2; ++i) glds16(g.bp[i] + kt * 64, stage + BM * 128 + (tid + i * NTHR) * 16);
}
template <int BM, class FA, class FB>
__device__ __forceinline__ void g3_setup(G3<BM>& g, FA rowptr, FB bcol, int tid) {
#pragma unroll
    for (int i = 0; i < G3<BM>::NA; ++i) { const int idx = tid + i * NTHR, row = idx >> 3, sl = (idx & 7) ^ (row & 7); g.ap[i] = rowptr(row) + sl * 8; }
#pragma unroll
    for (int i = 0; i < 2; ++i) { const int idx = tid + i * NTHR, row = idx >> 3, sl = (idx & 7) ^ (row & 7); g.bp[i] = bcol(row) + sl * 8; }
}
template <int BM>
__device__ __forceinline__ void g3_kloop(f32x4 (&acc)[BM / 64][4], const G3<BM>& g, int K, unsigned char* lds) {
    constexpr int MI = G3<BM>::MI, STAGE = G3<BM>::STAGE, NL = G3<BM>::NA + 2;
    const int tid = otid(), lane = tid & 63, wid = tid >> 6, wr = wid >> 1, wc = wid & 1, fr = lane & 15, fq = lane >> 4;
    const int nk = K >> 6;
    g3_issue<BM>(g, 0, lds, tid);
    if (nk > 1) g3_issue<BM>(g, 1, lds + STAGE, tid);
    int cur = 0;
#pragma unroll 1
    for (int t = 0; t < nk; ++t) {
        if (t + 1 < nk) { if (NL == 6) asm volatile("s_waitcnt vmcnt(6)" ::: "memory"); else if (NL == 5) asm volatile("s_waitcnt vmcnt(5)" ::: "memory"); else asm volatile("s_waitcnt vmcnt(4)" ::: "memory"); }
        else asm volatile("s_waitcnt vmcnt(0)" ::: "memory");
        __builtin_amdgcn_s_barrier();
        if (t + 2 < nk) { int nx = cur + 2; if (nx >= 3) nx -= 3; g3_issue<BM>(g, t + 2, lds + nx * STAGE, tid); }
        const unsigned char* cA = lds + cur * STAGE;
        const unsigned char* cB = cA + BM * 128;
#pragma unroll
        for (int ks = 0; ks < 2; ++ks) {
            bf16x8 a[MI], b[4];
#pragma unroll
            for (int m = 0; m < MI; ++m) { const int row = wr * (BM / 4) + m * 16 + fr; a[m] = *(const bf16x8*)(cA + row * 128 + (((ks * 4 + fq) ^ (row & 7)) << 4)); }
#pragma unroll
            for (int n = 0; n < 4; ++n) { const int row = wc * 64 + n * 16 + fr; b[n] = *(const bf16x8*)(cB + row * 128 + (((ks * 4 + fq) ^ (row & 7)) << 4)); }
#pragma unroll
            for (int m = 0; m < MI; ++m)
#pragma unroll
                for (int n = 0; n < 4; ++n) acc[m][n] = __builtin_amdgcn_mfma_f32_16x16x32_bf16(b[n], a[m], acc[m][n], 0, 0, 0);
        }
        cur = (cur == 2) ? 0 : cur + 1;
    }
    __builtin_amdgcn_s_barrier();
}
struct G3D { const bf16_t* ap[2]; const bf16_t* b1[2]; const bf16_t* b3[2]; };
__device__ __forceinline__ void g3d_issue(const G3D& g, int kt, unsigned char* stage, int tid) {
#pragma unroll
    for (int i = 0; i < 2; ++i) glds16(g.ap[i] + kt * 64, stage + (tid + i * NTHR) * 16);
#pragma unroll
    for (int i = 0; i < 2; ++i) glds16(g.b1[i] + kt * 64, stage + 16384 + (tid + i * NTHR) * 16);
#pragma unroll
    for (int i = 0; i < 2; ++i) glds16(g.b3[i] + kt * 64, stage + 32768 + (tid + i * NTHR) * 16);
}
__device__ __forceinline__ void g3d_kloop(f32x4 (&acc1)[2][4], f32x4 (&acc3)[2][4], const G3D& g, int K, unsigned char* lds) {
    constexpr int STAGE = 49152;
    const int tid = otid(), lane = tid & 63, wid = tid >> 6, wr = wid >> 1, wc = wid & 1, fr = lane & 15, fq = lane >> 4;
    const int nk = K >> 6;
    g3d_issue(g, 0, lds, tid);
    if (nk > 1) g3d_issue(g, 1, lds + STAGE, tid);
    int cur = 0;
#pragma unroll 1
    for (int t = 0; t < nk; ++t) {
        if (t + 1 < nk) asm volatile("s_waitcnt vmcnt(6)" ::: "memory"); else asm volatile("s_waitcnt vmcnt(0)" ::: "memory");
        __builtin_amdgcn_s_barrier();
        if (t + 2 < nk) { int nx = cur + 2; if (nx >= 3) nx -= 3; g3d_issue(g, t + 2, lds + nx * STAGE, tid); }
        const unsigned char* cA = lds + cur * STAGE;
#pragma unroll
        for (int ks = 0; ks < 2; ++ks) {
            bf16x8 a[2], b1[4], b3[4];
#pragma unroll
            for (int m = 0; m < 2; ++m) { const int row = wr * 32 + m * 16 + fr; a[m] = *(const bf16x8*)(cA + row * 128 + (((ks * 4 + fq) ^ (row & 7)) << 4)); }
#pragma unroll
            for (int n = 0; n < 4; ++n) { const int row = wc * 64 + n * 16 + fr; const int off = row * 128 + (((ks * 4 + fq) ^ (row & 7)) << 4);
                b1[n] = *(const bf16x8*)(cA + 16384 + off); b3[n] = *(const bf16x8*)(cA + 32768 + off); }
#pragma unroll
            for (int m = 0; m < 2; ++m)
#pragma unroll
                for (int n = 0; n < 4; ++n) {
                    acc1[m][n] = __builtin_amdgcn_mfma_f32_16x16x32_bf16(b1[n], a[m], acc1[m][n], 0, 0, 0);
                    acc3[m][n] = __builtin_amdgcn_mfma_f32_16x16x32_bf16(b3[n], a[m], acc3[m][n], 0, 0, 0);
                }
        }
        cur = (cur == 2) ? 0 : cur + 1;
    }
    __builtin_amdgcn_s_barrier();
}
template <int MI>
__device__ __forceinline__ void g3_zero(f32x4 (&acc)[MI][4]) {
#pragma unroll
    for (int m = 0; m < MI; ++m)
#pragma unroll
        for (int n = 0; n < 4; ++n) acc[m][n] = (f32x4){0.f, 0.f, 0.f, 0.f};
}
__device__ __forceinline__ uint2 pack4(float a, float b, float c, float d) {
    uint2 r; r.x = pk2(a, b); r.y = pk2(c, d); return r;
}

namespace pg8 {
#define PG8_LAS __attribute__((address_space(3)))
typedef unsigned short bf16_t;
typedef short bf16x8 __attribute__((ext_vector_type(8)));
typedef float f32x4 __attribute__((ext_vector_type(4)));
typedef unsigned u32x4 __attribute__((ext_vector_type(4)));
constexpr int BM = 256, BK = 64, HALF = 128, HTB = HALF * BK * 2  , STAGE_BYTES = 8 * HTB, NXCD = 8, WGM = 8;

__host__ __device__ __forceinline__ int lds_byte(int r, int c) { const int st = (r >> 4) * 2 + (c >> 5), rr = r & 15, cc = c & 31, ob = rr * 64 + cc * 2; return st * 1024 + (ob ^ (((ob >> 9) & 1) << 5)); }
__host__ __device__ __forceinline__ void stage_rc(int b, int& R, int& C) { const int st = b / 1024, sb = b % 1024, swz = sb ^ (((sb >> 9) & 1) << 5); R = (st >> 1) * 16 + swz / 64; C = (st & 1) * 32 + (swz % 64) / 2; }
__host__ __device__ __forceinline__ int perm32(int rho) { const int n = rho >> 4, i = rho & 15; return 8 * (i >> 2) + 4 * n + (i & 3); }

struct Unit { int pm, pn; };
struct Gemm { const bf16_t* A; const bf16_t* Bt; int M, N, K; };

struct StaticOrder {
    int nM, nN, nwg, G, c;
    __host__ __device__ void init(int M, int N, int G_, int c_) { nM = M / BM; nN = N / BM; nwg = nM * nN; G = G_; c = c_; }
    __host__ __device__ bool next(int i, Unit& u) const {
        const long L = (long)i * G + c; if (L >= nwg) return false;
        int wgid = (int)L; { const int q = nwg / NXCD, r = nwg % NXCD, xcd = wgid % NXCD, off = wgid / NXCD; wgid = (xcd < r ? xcd * (q + 1) : r * (q + 1) + (xcd - r) * q) + off; }
        const int nig = WGM * nN, gid = wgid / nig, fm = gid * WGM, gsz = (nM - fm) < WGM ? (nM - fm) : WGM;
        u.pm = fm + ((wgid % nig) % gsz); u.pn = (wgid % nig) / gsz; return true;
    }
    __device__ __forceinline__ void a_ready(const Unit&) const {}
    __device__ __forceinline__ void done(const Unit&) const {}
};
template <class Epi, class Sched, bool STAMP = false>
__device__ __forceinline__ void gemm_phase(PG8_LAS unsigned char* lds, const Gemm g, const Sched& S, const Epi& E, unsigned long long* stamps) {
    const int tid = otid(), wid = __builtin_amdgcn_readfirstlane(tid >> 6), lane = tid & 63, wr = wid >> 2, wc = wid & 3, fr = lane & 15, fq = lane >> 4;
    const int K = g.K, nt = K / BK;
    int ts_lo = 0, ts_hi = 0, nts = 0; const unsigned long long rt_entry = STAMP ? 0ull : 0ull;
#define PG8_STAMP() do { if (STAMP && wid == 0 && nts < 64) { const unsigned long long _c = 0ull; \
        ts_lo = (lane == nts) ? (int)(unsigned)_c : ts_lo; ts_hi = (lane == nts) ? (int)(unsigned)(_c >> 32) : ts_hi; ++nts; } } while (0)
    PG8_STAMP();
    unsigned voffA[2], voffB[2];
#pragma unroll
    for (int i = 0; i < 2; ++i) { int R, C; stage_rc(tid * 16 + i * 8192, R, C); const int Rb = Epi::PERM ? ((R & ~31) + perm32(R & 31)) : R;
        voffA[i] = (unsigned)(R * K + C) * 2u; voffB[i] = (unsigned)(Rb * K + C) * 2u; }
    const size_t kstep = (size_t)(BK * 2);
    const size_t hstep = (size_t)HALF * K * 2;
    const size_t tstep = 2 * hstep;
    const unsigned ldsw = (unsigned)wid * 1024u;
    const int aoff = lds_byte(wr * 64 + fr, fq * 8), boff = lds_byte(wc * 32 + fr, fq * 8);
#define PG8_SA(b, h) (((b) * 2 + (h)) * HTB)
#define PG8_SB(b, h) ((4 + (b) * 2 + (h)) * HTB)
#define PG8_STAGE(bufoff, gbase, voff) do { _Pragma("unroll") for (int _i = 0; _i < 2; ++_i) \
        __builtin_amdgcn_global_load_lds((const unsigned*)((const char*)(gbase) + (voff)[_i]), (PG8_LAS unsigned*)(lds + (bufoff) + ldsw + _i * 8192), 16, 0, 0); } while (0)
#define PG8_LDA(dst, b, h) do { _Pragma("unroll") for (int m = 0; m < 4; ++m) _Pragma("unroll") for (int k = 0; k < 2; ++k) dst[m][k] = *(const PG8_LAS bf16x8*)(lds + PG8_SA(b, h) + aoff + m * 2048 + k * 1024); } while (0)
#define PG8_LDB(dst, b, h) do { _Pragma("unroll") for (int n = 0; n < 2; ++n) _Pragma("unroll") for (int k = 0; k < 2; ++k) dst[n][k] = *(const PG8_LAS bf16x8*)(lds + PG8_SB(b, h) + boff + n * 2048 + k * 1024); } while (0)
#define PG8_MMA(ai, bj, At, Bt) do { __builtin_amdgcn_s_setprio(1); _Pragma("unroll") for (int m = 0; m < 4; ++m) _Pragma("unroll") for (int n = 0; n < 2; ++n) _Pragma("unroll") for (int k = 0; k < 2; ++k) \
        acc[ai][bj][m][n] = __builtin_amdgcn_mfma_f32_16x16x32_bf16(Bt[n][k], At[m][k], acc[ai][bj][m][n], 0, 0, 0); __builtin_amdgcn_s_setprio(0); } while (0)
#define PG8_WAIT_V(n) asm volatile("s_waitcnt vmcnt(" #n ")" ::: "memory")
#define PG8_WAIT_L(n) asm volatile("s_waitcnt lgkmcnt(" #n ")" ::: "memory")
#define PG8_BAR __builtin_amdgcn_s_barrier()
#define PG8_SCHED __builtin_amdgcn_sched_barrier(0)
    Unit cur, nxt; int ui = 0;
    if (!S.next(0, cur)) return;
    f32x4 acc[2][2][4][2];
#pragma unroll
    for (int a = 0; a < 2; ++a)
#pragma unroll
        for (int b = 0; b < 2; ++b)
#pragma unroll
            for (int m = 0; m < 4; ++m)
#pragma unroll
                for (int n = 0; n < 2; ++n) acc[a][b][m][n] = (f32x4){0.f, 0.f, 0.f, 0.f};
    bf16x8 At[4][2], B0[2][2], B1[2][2];
    const char* cA = (const char*)g.A + (size_t)cur.pm * tstep; const char* cB = (const char*)g.Bt + (size_t)cur.pn * tstep;
    S.a_ready(cur);
    PG8_STAGE(PG8_SB(0, 0), cB, voffB); PG8_STAGE(PG8_SA(0, 0), cA, voffA); PG8_STAGE(PG8_SB(0, 1), cB + hstep, voffB); PG8_STAGE(PG8_SA(0, 1), cA + hstep, voffA);
    if (wr == 1) PG8_BAR;
    PG8_WAIT_V(4); PG8_BAR;
    PG8_STAGE(PG8_SB(1, 0), cB + kstep, voffB); PG8_STAGE(PG8_SA(1, 0), cA + kstep, voffA); PG8_STAGE(PG8_SB(1, 1), cB + hstep + kstep, voffB);
    PG8_WAIT_V(6); PG8_BAR;
    PG8_STAMP();
    for (;;) {
        const bool has_next = S.next(ui + 1, nxt);
        const char* nA = has_next ? (const char*)g.A + (size_t)nxt.pm * tstep : cA; const char* nB = has_next ? (const char*)g.Bt + (size_t)nxt.pn * tstep : cB;
        for (int t = 0; t < nt; t += 2) {
            const bool last = (t == nt - 2);
            const char* a1 = cA + (size_t)(t + 1) * kstep;
            const char* a2 = last ? nA : cA + (size_t)(t + 2) * kstep; const char* b2 = last ? nB : cB + (size_t)(t + 2) * kstep;
            const char* a3 = a2 + kstep; const char* b3 = b2 + kstep;
            if (last && has_next) S.a_ready(nxt);
            PG8_LDB(B0, 0, 0); PG8_SCHED; PG8_LDA(At, 0, 0); PG8_STAGE(PG8_SA(1, 1), a1 + hstep, voffA);
            PG8_WAIT_L(8); PG8_BAR; PG8_WAIT_L(0); PG8_MMA(0, 0, At, B0); PG8_BAR; PG8_SCHED;
            PG8_LDB(B1, 0, 1); PG8_STAGE(PG8_SB(0, 0), b2, voffB);
            PG8_BAR; PG8_WAIT_L(0); PG8_MMA(0, 1, At, B1); PG8_BAR;
            PG8_LDA(At, 0, 1); PG8_STAGE(PG8_SA(0, 0), a2, voffA);
            PG8_BAR; PG8_WAIT_L(0); PG8_MMA(1, 0, At, B0); PG8_BAR; PG8_SCHED;
            PG8_STAGE(PG8_SB(0, 1), b2 + hstep, voffB);
            PG8_WAIT_V(6); PG8_BAR; PG8_MMA(1, 1, At, B1); PG8_BAR;
            PG8_LDB(B0, 1, 0); PG8_SCHED; PG8_LDA(At, 1, 0); PG8_STAGE(PG8_SA(0, 1), a2 + hstep, voffA);
            PG8_WAIT_L(8); PG8_BAR; PG8_WAIT_L(0); PG8_MMA(0, 0, At, B0); PG8_BAR; PG8_SCHED;
            PG8_LDB(B1, 1, 1); PG8_STAGE(PG8_SB(1, 0), b3, voffB);
            PG8_BAR; PG8_WAIT_L(0); PG8_MMA(0, 1, At, B1); PG8_BAR;
            PG8_LDA(At, 1, 1); PG8_STAGE(PG8_SA(1, 0), a3, voffA);
            PG8_BAR; PG8_WAIT_L(0); PG8_MMA(1, 0, At, B0); PG8_BAR; PG8_SCHED;
            PG8_STAGE(PG8_SB(1, 1), b3 + hstep, voffB);
            PG8_WAIT_V(6); PG8_BAR; PG8_MMA(1, 1, At, B1); PG8_BAR;
        }
        PG8_STAMP();
        if constexpr (!Epi::AFTER_DRAIN) { E(acc, cur, wr, wc, fr, fq); S.done(cur); }
        PG8_STAMP();
        if (!has_next) break;
#pragma unroll
        for (int a = 0; a < 2; ++a)
#pragma unroll
            for (int b = 0; b < 2; ++b)
#pragma unroll
                for (int m = 0; m < 4; ++m)
#pragma unroll
                    for (int n = 0; n < 2; ++n) acc[a][b][m][n] = (f32x4){0.f, 0.f, 0.f, 0.f};
        cur = nxt; cA = nA; cB = nB; ++ui;
    }
    PG8_WAIT_V(0);
    if (wr == 0) PG8_BAR;
    PG8_BAR;
    if constexpr (Epi::AFTER_DRAIN) { E.fused(acc, cur, wr, wc, fr, fq, lds, wid, lane); S.done(cur); }
    PG8_STAMP();
    if (STAMP && wid == 0) { stamps[lane] = lane < nts ? (((unsigned long long)(unsigned)ts_hi << 32) | (unsigned)ts_lo) : 0ull;
        if (lane == 62) stamps[62] = rt_entry; if (lane == 63) stamps[63] = 0ull; }
#undef PG8_STAMP
#undef PG8_SA
#undef PG8_SB
#undef PG8_STAGE
#undef PG8_LDA
#undef PG8_LDB
#undef PG8_MMA
#undef PG8_WAIT_V
#undef PG8_WAIT_L
#undef PG8_BAR
#undef PG8_SCHED
}
}

struct EpiInproj {
    static constexpr bool PERM = true, AFTER_DRAIN = false;
    unsigned char* ws; const float* rstd;
    __device__ __forceinline__ void operator()(const pg8::f32x4 (&acc)[2][2][4][2], const pg8::Unit& u, int wr, int wc, int fr, int fq) const {
        const int pn = u.pn;
        bf16_t* dst; int ld, cb;
        if (pn < 4) { dst = (bf16_t*)(ws + OFF_PPOOL); ld = 1024; cb = pn * 256; }
        else if (pn < 8) { dst = (bf16_t*)(ws + OFF_PR); ld = 1024; cb = (pn - 4) * 256; }
        else if (pn < 12) { dst = (bf16_t*)(ws + OFF_PK); ld = 1024; cb = (pn - 8) * 256; }
        else if (pn < 16) { dst = (bf16_t*)(ws + OFF_PV); ld = 1024; cb = (pn - 12) * 256; }
        else { dst = (bf16_t*)(ws + OFF_PMISC); ld = PM_LD; cb = (pn - 16) * 256; }
        bf16_t* halo = (bf16_t*)(ws + OFF_HALO);
        float rsv[2][4];
#pragma unroll
        for (int ai = 0; ai < 2; ++ai)
#pragma unroll
            for (int m = 0; m < 4; ++m) { const int row = u.pm * 256 + ai * 128 + wr * 64 + m * 16 + fr; rsv[ai][m] = (row < NT) ? rstd[row] : 0.f; }
#pragma unroll
        for (int ai = 0; ai < 2; ++ai)
#pragma unroll
            for (int m = 0; m < 4; ++m) {
                const int row = u.pm * 256 + ai * 128 + wr * 64 + m * 16 + fr;
                if (row < NT) {
                    const float rs = rsv[ai][m];
                    const int lr = row & 127;
#pragma unroll
                    for (int bj = 0; bj < 2; ++bj) {
                        const int col = cb + bj * 128 + wc * 32 + fq * 8;
                        const uint2 lo = pack4(acc[ai][bj][m][0][0] * rs, acc[ai][bj][m][0][1] * rs, acc[ai][bj][m][0][2] * rs, acc[ai][bj][m][0][3] * rs);
                        const uint2 hi = pack4(acc[ai][bj][m][1][0] * rs, acc[ai][bj][m][1][1] * rs, acc[ai][bj][m][1][2] * rs, acc[ai][bj][m][1][3] * rs);
                        const uint4 v = make_uint4(lo.x, lo.y, hi.x, hi.y);
                        *(uint4*)(dst + (size_t)row * ld + col) = v;
                        if (pn < 4 && lr >= 112) *(uint4*)(halo + ((size_t)(row >> 7) * 16 + (lr - 112)) * 1024 + col) = v;
                    }
                }
            }
    }
};
__device__ void phase_inproj(const Params& p, unsigned char* lds) {
    pg8::StaticOrder S; S.init(NTP, NP1, (int)gridDim.x, obid());
    pg8::Gemm g; g.A = (const pg8::bf16_t*)(WS(p) + OFF_H); g.Bt = (const pg8::bf16_t*)(WS(p) + OFF_WB) + WB_WIN; g.M = NTP; g.N = NP1; g.K = DM;
    EpiInproj E; E.ws = WS(p); E.rstd = (const float*)(WS(p) + OFF_RSTD);
    pg8::gemm_phase<EpiInproj, pg8::StaticOrder, false>((PG8_LAS unsigned char*)lds, g, S, E, nullptr);
}

__device__ void phase_pool(const Params& p, int l, unsigned char* lds, int tb, int te, int tstep) {
    const int tid = otid(), lane = tid & 63, wid = tid >> 6, fr = lane & 15, fq = lane >> 4;
    bf16_t* pp = (bf16_t*)(WS(p) + OFF_PPOOL);
    const bf16_t* halo = (const bf16_t*)(WS(p) + OFF_HALO);
    const bf16_t* pw = (const bf16_t*)(WS(p) + OFF_WB) + WB_POOL;
    const float* scale = p.in[6] + (size_t)l * 1024;
    bf16_t* sp = (bf16_t*)lds;
    constexpr int SLD = 264;
    bf16_t* sraw = sp + 128 * SLD;
    for (int tile = tb; tile < te; tile += tstep) {
        const int mt = tile >> 2, g = tile & 3;
        const int row0 = mt * 128, w = 2 << g;
        const bf16_t* wg = pw + (size_t)g * 65536;
        bf16x8 bfr[8][2];
#pragma unroll
        for (int kk = 0; kk < 8; ++kk)
#pragma unroll
            for (int n = 0; n < 2; ++n) bfr[kk][n] = *(const bf16x8*)(wg + (size_t)(wid * 32 + n * 16 + fr) * 256 + kk * 32 + fq * 8);
        {
            for (int e = tid; e < 144 * 32; e += NTHR) {
                const int rr = e >> 5, c16 = e & 31;
                uint4 v = make_uint4(0u, 0u, 0u, 0u);
                if (rr >= 16) v = *(const uint4*)(pp + (size_t)(row0 + rr - 16) * 1024 + g * 256 + c16 * 8);
                else if (mt > 0) v = *(const uint4*)(halo + ((size_t)(mt - 1) * 16 + rr) * 1024 + g * 256 + c16 * 8);
                *(uint4*)(sraw + rr * 256 + c16 * 8) = v;
            }
        }
        __syncthreads();
        {
            const int c = tid & 255, r0 = (tid >> 8) * 64;
            auto rawv = [&](int nrel) -> float { return bf2f(sraw[(nrel + 16) * 256 + c]); };
            int t = (row0 + r0) % TS;
            float sum = 0.f;
            const int have = (t < w) ? t : w;
            for (int i = 1; i <= have; ++i) sum += rawv(r0 - i);
#pragma unroll 8
            for (int r = 0; r < 64; ++r) {
                if (t == 0) sum = 0.f;
                const float v = rawv(r0 + r);
                sum += v;
                if (t >= w) sum -= rawv(r0 + r - w);
                const int cnt = (t + 1 < w) ? (t + 1) : w;
                sp[(r0 + r) * SLD + c] = f2bf(sum * (1.0f / (float)cnt) - v);
                t = (t + 1 == TS) ? 0 : t + 1;
            }
        }
        __syncthreads();
        f32x4 acc[8][2];
#pragma unroll
        for (int m = 0; m < 8; ++m) { acc[m][0] = (f32x4){0.f, 0.f, 0.f, 0.f}; acc[m][1] = (f32x4){0.f, 0.f, 0.f, 0.f}; }
#pragma unroll
        for (int kk = 0; kk < 8; ++kk) {
#pragma unroll
            for (int m = 0; m < 8; ++m) {
                const bf16x8 a = *(const bf16x8*)(sp + (m * 16 + fr) * SLD + kk * 32 + fq * 8);
                acc[m][0] = __builtin_amdgcn_mfma_f32_16x16x32_bf16(bfr[kk][0], a, acc[m][0], 0, 0, 0);
                acc[m][1] = __builtin_amdgcn_mfma_f32_16x16x32_bf16(bfr[kk][1], a, acc[m][1], 0, 0, 0);
            }
        }
#pragma unroll
        for (int n = 0; n < 2; ++n) {
            const int col = g * 256 + wid * 32 + n * 16 + fq * 4;
            const float4 sc = *(const float4*)(scale + col);
#pragma unroll
            for (int m = 0; m < 8; ++m) {
                const int row = row0 + m * 16 + fr;
                *(uint2*)(pp + (size_t)row * 1024 + col) = pack4(acc[m][n][0] * sc.x, acc[m][n][1] * sc.y, acc[m][n][2] * sc.z, acc[m][n][3] * sc.w);
            }
        }
        __syncthreads();
    }
}

__device__ void phase_dsa_prep(const Params& p, int l) {
    const int lane = otid() & 63;
    const int wave = (obid() * NTHR + otid()) >> 6, nw = gridDim.x * NTHR / 64;
    const bf16_t* pm = (const bf16_t*)(WS(p) + OFF_PMISC);
    unsigned char* dob = OUTB(p);
    bf16_t* cqn = (bf16_t*)(dob + DO_CQN);
    bf16_t* kv = (bf16_t*)(dob + DO_KV);
    bf16_t* kidx = (bf16_t*)(dob + DO_KIDX);
    float* whead = (float*)(dob + DO_WHEAD);
    const float* ctab = (const float*)(WS(p) + OFF_ROPE);
    const float* stab = ctab + TS * 16;
    const bf16_t* hrow = (const bf16_t*)(WS(p) + OFF_H);
    const bf16_t* wwidx = (const bf16_t*)(WS(p) + OFF_WB) + WB_WIDX;
    const float* rstd_ = (const float*)(WS(p) + OFF_RSTD);
    const float4 qn4 = *(const float4*)(p.in[21] + l * 256 + lane * 4);
    const float2 kvn2 = *(const float2*)(p.in[22] + l * 128 + lane * 2);
    const float inw = p.in[27][l * 64 + lane], inb = p.in[28][l * 64 + lane];
    uint4 ww[8][2];
#pragma unroll
    for (int j = 0; j < 8; ++j) { ww[j][0] = *(const uint4*)(wwidx + (size_t)j * DM + lane * 16); ww[j][1] = *(const uint4*)(wwidx + (size_t)j * DM + lane * 16 + 8); }
    struct In { uint2 cq; unsigned ckv; bf16_t kr0, kr1, kix; uint4 h0, h1; float rs, c, s; };
    auto load = [&](int n) {
        In r;
        const bf16_t* row = pm + (size_t)n * PM_LD;
        const int t = n % TS;
        r.cq = *(const uint2*)(row + PM_CQ + lane * 4);
        r.ckv = *(const unsigned*)(row + PM_CKV + lane * 2);
        r.kr0 = row[PM_KROPE + (lane & 15)]; r.kr1 = row[PM_KROPE + 16 + (lane & 15)];
        r.kix = row[PM_KIDX + lane];
        r.h0 = *(const uint4*)(hrow + (size_t)n * DM + lane * 16); r.h1 = *(const uint4*)(hrow + (size_t)n * DM + lane * 16 + 8);
        r.rs = rstd_[n];
        r.c = ctab[t * 16 + (lane & 15)]; r.s = stab[t * 16 + (lane & 15)];
        return r;
    };
    In cur = load(wave < NT ? wave : 0);
    for (int n = wave; n < NT; n += nw) {
        const In x = cur;
        if (n + nw < NT) cur = load(n + nw);
        {
            const float v0 = __uint_as_float(x.cq.x << 16), v1 = __uint_as_float(x.cq.x & 0xFFFF0000u), v2 = __uint_as_float(x.cq.y << 16), v3 = __uint_as_float(x.cq.y & 0xFFFF0000u);
            const float ss = wave_sum_fast(v0 * v0 + v1 * v1 + v2 * v2 + v3 * v3);
            const float rs = rsqrtf(ss * (1.0f / 256.0f) + 1e-6f);
            *(uint2*)(cqn + (size_t)n * 256 + lane * 4) = pack4(v0 * rs * qn4.x, v1 * rs * qn4.y, v2 * rs * qn4.z, v3 * rs * qn4.w);
        }
        {
            const float v0 = __uint_as_float(x.ckv << 16), v1 = __uint_as_float(x.ckv & 0xFFFF0000u);
            const float ss = wave_sum_fast(v0 * v0 + v1 * v1);
            const float rs = rsqrtf(ss * (1.0f / 128.0f) + 1e-6f);
            *(unsigned*)(kv + (size_t)n * 160 + lane * 2) = pk2(v0 * rs * kvn2.x, v1 * rs * kvn2.y);
        }
        if (lane < 16) {
            const float x1 = bf2f(x.kr0), x2 = bf2f(x.kr1);
            kv[(size_t)n * 160 + 128 + lane] = f2bf(x1 * x.c - x2 * x.s);
            kv[(size_t)n * 160 + 144 + lane] = f2bf(x2 * x.c + x1 * x.s);
        }
        {
            const float xv = bf2f(x.kix);
            const float mu = wave_sum_fast(xv) * (1.0f / 64.0f);
            const float d = xv - mu;
            const float var = wave_sum_fast(d * d) * (1.0f / 64.0f);
            const float y = d * rsqrtf(var + 1e-6f) * inw + inb;
            const float yo = __shfl_xor(y, 16);
            float o = y;
            if (lane < 32) o = (lane < 16) ? (y * x.c - yo * x.s) : (y * x.c + yo * x.s);
            kidx[(size_t)n * 64 + lane] = f2bf(o);
        }
        {
            const uint4 hv0 = x.h0, hv1 = x.h1;
            float hx[16];
            hx[0] = __uint_as_float(hv0.x << 16); hx[1] = __uint_as_float(hv0.x & 0xFFFF0000u); hx[2] = __uint_as_float(hv0.y << 16); hx[3] = __uint_as_float(hv0.y & 0xFFFF0000u);
            hx[4] = __uint_as_float(hv0.z << 16); hx[5] = __uint_as_float(hv0.z & 0xFFFF0000u); hx[6] = __uint_as_float(hv0.w << 16); hx[7] = __uint_as_float(hv0.w & 0xFFFF0000u);
            hx[8] = __uint_as_float(hv1.x << 16); hx[9] = __uint_as_float(hv1.x & 0xFFFF0000u); hx[10] = __uint_as_float(hv1.y << 16); hx[11] = __uint_as_float(hv1.y & 0xFFFF0000u);
            hx[12] = __uint_as_float(hv1.z << 16); hx[13] = __uint_as_float(hv1.z & 0xFFFF0000u); hx[14] = __uint_as_float(hv1.w << 16); hx[15] = __uint_as_float(hv1.w & 0xFFFF0000u);
            float myw = 0.f;
#pragma unroll
            for (int j = 0; j < 8; ++j) {
                const uint4 w0 = ww[j][0], w1 = ww[j][1];
                float d = hx[0] * __uint_as_float(w0.x << 16) + hx[1] * __uint_as_float(w0.x & 0xFFFF0000u) + hx[2] * __uint_as_float(w0.y << 16) + hx[3] * __uint_as_float(w0.y & 0xFFFF0000u)
                        + hx[4] * __uint_as_float(w0.z << 16) + hx[5] * __uint_as_float(w0.z & 0xFFFF0000u) + hx[6] * __uint_as_float(w0.w << 16) + hx[7] * __uint_as_float(w0.w & 0xFFFF0000u)
                        + hx[8] * __uint_as_float(w1.x << 16) + hx[9] * __uint_as_float(w1.x & 0xFFFF0000u) + hx[10] * __uint_as_float(w1.y << 16) + hx[11] * __uint_as_float(w1.y & 0xFFFF0000u)
                        + hx[12] * __uint_as_float(w1.z << 16) + hx[13] * __uint_as_float(w1.z & 0xFFFF0000u) + hx[14] * __uint_as_float(w1.w << 16) + hx[15] * __uint_as_float(w1.w & 0xFFFF0000u);
                d = wave_sum_fast(d);
                myw = (lane == j) ? d : myw;
            }
            if (lane < 8) whead[(size_t)n * 8 + lane] = myw * x.rs * 0.04419417382415922f;
        }
    }
}

typedef short s16x4 __attribute__((ext_vector_type(4)));
__device__ __forceinline__ unsigned f2h_bits(float f) { const _Float16 h = (_Float16)f; unsigned short u; __builtin_memcpy(&u, &h, 2); return u; }
template <bool IMPORT_SEL>
__device__ void phase_dsa(const Params& p, int l, unsigned char* lds, bf16_t* yc, const unsigned short* gsel, const int* gnsel, int tb, int te, int tstep) {
    unsigned short* s_sc = (unsigned short*)lds;
    bf16_t* s_qi = (bf16_t*)(lds + 66048);
    bf16_t* s_Q = (bf16_t*)lds;
    unsigned short* s_sel = (unsigned short*)(lds + 82432 + 65536);
    int* s_nsel = (int*)(lds + 82432 + 65536 + 8192);
    unsigned char* dob = OUTB(p);
    const bf16_t* cqn = (const bf16_t*)(dob + DO_CQN);
    const bf16_t* kv = (const bf16_t*)(dob + DO_KV);
    const bf16_t* kidx = (const bf16_t*)(dob + DO_KIDX);
    const float* whead = (const float*)(dob + DO_WHEAD);
    const float* ctab = (const float*)(WS(p) + OFF_ROPE);
    const float* stab = ctab + TS * 16;
    const bf16_t* wb = (const bf16_t*)(WS(p) + OFF_WB);
    const bf16_t* wqiT = wb + WB_QI;
    const bf16_t* wuqT = wb + WB_UQ;
    const bf16_t* wuk = wb + WB_UK;
    const bf16_t* wuvT = wb + WB_UV;
    const float scale = 0.10206207261596575f;
    const f32x4 z4 = {0.f, 0.f, 0.f, 0.f};
    bf16_t* gq = (obid() < QS_WS) ? (bf16_t*)(WS(p) + WS_END + (size_t)obid() * QS_BYTES) : (bf16_t*)(OUTB(p) + DO_END + (size_t)(obid() - QS_WS) * QS_BYTES);
    for (int pair = tb; pair < te; pair += tstep) {
        const int qt = 128 - (pair >> 2);
        const int t0 = qt * 16;
#pragma unroll 1
        for (int half = 0; half < 2; ++half) {
        const int tid = otid(), lane = tid & 63, wid = tid >> 6, fr = lane & 15, fq = lane >> 4;
        unsigned char* s_Vw = lds + 82432 + wid * 8192;
        bf16_t* s_qn = (bf16_t*)s_Vw;
        const int b = (pair & 3) * 2 + half;
        const size_t n0 = (size_t)b * TS + t0;
        {
            bf16x8 acq[8];
#pragma unroll
            for (int kk = 0; kk < 8; ++kk) acq[kk] = *(const bf16x8*)(cqn + (n0 + fr) * 256 + kk * 32 + fq * 8);
            f32x4 c[4] = {z4, z4, z4, z4};
#pragma unroll
            for (int kb = 0; kb < 8; kb += 4) {
                bf16x8 bf[4][4];
#pragma unroll
                for (int k4 = 0; k4 < 4; ++k4)
#pragma unroll
                    for (int nt = 0; nt < 4; ++nt) bf[k4][nt] = *(const bf16x8*)(wqiT + (size_t)(wid * 64 + nt * 16 + fr) * 256 + (kb + k4) * 32 + fq * 8);
#pragma unroll
                for (int k4 = 0; k4 < 4; ++k4)
#pragma unroll
                    for (int nt = 0; nt < 4; ++nt) c[nt] = __builtin_amdgcn_mfma_f32_16x16x32_bf16(acq[kb + k4], bf[k4][nt], c[nt], 0, 0, 0);
            }
#pragma unroll
            for (int j = 0; j < 4; ++j) {
                const int t = t0 + fq * 4 + j;
                const float cs = ctab[t * 16 + fr], sn = stab[t * 16 + fr];
                const float x1 = c[0][j], x2 = c[1][j];
                c[0][j] = x1 * cs - x2 * sn; c[1][j] = x2 * cs + x1 * sn;
            }
#pragma unroll
            for (int nt = 0; nt < 4; ++nt)
#pragma unroll
                for (int j = 0; j < 4; ++j) s_qi[(fq * 4 + j) * 512 + wid * 64 + nt * 16 + fr] = f2bf(c[nt][j]);
        }
        __syncthreads();
        if (!IMPORT_SEL) {
            bf16x8 aq[8][2];
#pragma unroll
            for (int h = 0; h < 8; ++h)
#pragma unroll
                for (int ks = 0; ks < 2; ++ks) aq[h][ks] = *(const bf16x8*)(s_qi + fr * 512 + h * 64 + ks * 32 + fq * 8);
            float wh[4][8];
#pragma unroll
            for (int j = 0; j < 4; ++j) {
                const float4 w0 = *(const float4*)(whead + (n0 + fq * 4 + j) * 8), w1 = *(const float4*)(whead + (n0 + fq * 4 + j) * 8 + 4);
                wh[j][0] = w0.x; wh[j][1] = w0.y; wh[j][2] = w0.z; wh[j][3] = w0.w; wh[j][4] = w1.x; wh[j][5] = w1.y; wh[j][6] = w1.z; wh[j][7] = w1.w;
            }
            const int nkt = qt + 1;
            bf16x8 nb0 = {0, 0, 0, 0, 0, 0, 0, 0}, nb1 = nb0;
            if (wid < nkt) { const bf16_t* kr0 = kidx + ((size_t)b * TS + wid * 16 + fr) * 64 + fq * 8; nb0 = *(const bf16x8*)kr0; nb1 = *(const bf16x8*)(kr0 + 32); }
#pragma unroll 1
            for (int kt = wid; kt < nkt; kt += 8) {
                const bf16x8 bk0 = nb0, bk1 = nb1;
                if (kt + 8 < nkt) { const bf16_t* krn = kidx + ((size_t)b * TS + (kt + 8) * 16 + fr) * 64 + fq * 8; nb0 = *(const bf16x8*)krn; nb1 = *(const bf16x8*)(krn + 32); }
                float I[4] = {0.f, 0.f, 0.f, 0.f};
#pragma unroll
                for (int h = 0; h < 8; ++h) {
                    f32x4 a = __builtin_amdgcn_mfma_f32_16x16x32_bf16(aq[h][0], bk0, z4, 0, 0, 0);
                    a = __builtin_amdgcn_mfma_f32_16x16x32_bf16(aq[h][1], bk1, a, 0, 0, 0);
#pragma unroll
                    for (int j = 0; j < 4; ++j) I[j] += wh[j][h] * fmaxf(a[j], 0.f);
                }
#pragma unroll
                for (int j = 0; j < 4; ++j) s_sc[(fq * 4 + j) * 2064 + kt * 16 + fr] = (unsigned short)f2h_bits(I[j]);
            }
        }
        __syncthreads();
#pragma unroll 1
        for (int qi2 = 0; qi2 < 2; ++qi2) {
            const int q = wid + qi2 * 8;
            const int nadm = t0 + q + 1;
            unsigned short* sel = s_sel + q * 256;
            if (IMPORT_SEL) {
                const int ns = gnsel[n0 + q];
                for (int i = lane; i < ns; i += 64) sel[i] = gsel[(n0 + q) * 256 + i];
                if (lane == 0) s_nsel[q] = ns;
            } else if (nadm <= 256) {
                for (int i = lane; i < nadm; i += 64) sel[i] = (unsigned short)i;
                if (lane == 0) s_nsel[q] = nadm;
            } else {
                unsigned* hist = (unsigned*)(lds + 82432 + wid * 8192);
                const unsigned short* scq = s_sc + q * 2064;
                const int nch = (nadm + 63) >> 6;
                unsigned B1 = 0u; int na1 = 0, na2 = 0; unsigned T = 0u;
#pragma unroll 1
                for (int pass = 0; pass < 2; ++pass) {
                    *(uint4*)(hist + lane * 4) = make_uint4(0u, 0u, 0u, 0u);
#pragma unroll 1
                    for (int c0 = 0; c0 < nch; c0 += 8) {
                        unsigned kb[8];
#pragma unroll
                        for (int j = 0; j < 8; ++j) { const int s_ = (c0 + j) * 64 + lane; kb[j] = (s_ < nadm) ? (unsigned)scq[s_] : 0x10000u; }
#pragma unroll
                        for (int j = 0; j < 8; ++j) {
                            const unsigned u = kb[j];
                            const unsigned k = (u & 0x8000u) ? (~u & 0xFFFFu) : (u | 0x8000u);
                            const bool ok = (u < 0x10000u) && (pass == 0 || (k >> 8) == B1);
                            if (ok) atomicAdd(hist + (pass == 0 ? (k >> 8) : (k & 255u)), 1u);
                        }
                    }
                    const int need = 256 - na1;
                    const uint4 h4 = *(const uint4*)(hist + lane * 4);
                    const int sl = (int)(h4.x + h4.y + h4.z + h4.w);
                    int suf = sl;
#pragma unroll
                    for (int o = 1; o < 64; o <<= 1) { const int t_ = __shfl_down(suf, o); suf += (lane + o < 64) ? t_ : 0; }
                    const int above = suf - sl;
                    const bool mine = (suf >= need) && (above < need);
                    int a = above, bsel, asel;
                    if (a + (int)h4.w >= need) { bsel = 3; asel = a; }
                    else { a += (int)h4.w;
                        if (a + (int)h4.z >= need) { bsel = 2; asel = a; }
                        else { a += (int)h4.z;
                            if (a + (int)h4.y >= need) { bsel = 1; asel = a; }
                            else { a += (int)h4.y; bsel = 0; asel = a; } } }
                    const int src = __ffsll((long long)__ballot(mine)) - 1;
                    const unsigned bin = (unsigned)__shfl(lane * 4 + bsel, src); const int nab = __shfl(asel, src);
                    if (pass == 0) { B1 = bin; na1 = nab; } else { T = (B1 << 8) | bin; na2 = nab; }
                }
                {
                    const int rties = 256 - (na1 + na2);
                    int base = 0, ties = 0;
                    const unsigned long long ltmask = (1ull << lane) - 1ull;
#pragma unroll 1
                    for (int c0 = 0; c0 < nch; c0 += 4) {
                        unsigned kb[4];
#pragma unroll
                        for (int j = 0; j < 4; ++j) { const int s_ = (c0 + j) * 64 + lane; kb[j] = (s_ < nadm) ? (unsigned)scq[s_] : 0x10000u; }
#pragma unroll
                        for (int j = 0; j < 4; ++j) {
                            const int s_ = (c0 + j) * 64 + lane;
                            const unsigned u = kb[j];
                            const bool valid = u < 0x10000u;
                            const unsigned k = (u & 0x8000u) ? (~u & 0xFFFFu) : (u | 0x8000u);
                            const bool gt = valid && k > T, eq = valid && k == T;
                            const unsigned long long em = __ballot(eq);
                            const int myrank = ties + __popcll(em & ltmask);
                            const bool take = gt || (eq && myrank < rties);
                            const unsigned long long tm = __ballot(take);
                            const int pos = base + __popcll(tm & ltmask);
                            if (take && pos < 256) sel[pos] = (unsigned short)s_;
                            base += __popcll(tm); ties += __popcll(em);
                        }
                    }
                }
                if (lane == 0) s_nsel[q] = 256;
            }
        }
        __syncthreads();
        if (half == 0) {
            const size_t n0B = n0 + TS;
            bf16_t* s_qnB = s_qn + 1024;
#pragma unroll 1
            for (int hi = 0; hi < 2; ++hi) {
                const int hh = wid * 2 + hi;
                const bf16_t* caA = cqn + (n0 + fr) * 256 + fq * 8;
                const bf16_t* caB = cqn + (n0B + fr) * 256 + fq * 8;
                f32x4 cA[6] = {z4, z4, z4, z4, z4, z4}, cB[6] = {z4, z4, z4, z4, z4, z4};
#pragma unroll
                for (int kb = 0; kb < 8; kb += 2) {
                    bf16x8 bf[2][6], aA[2], aB[2];
#pragma unroll
                    for (int k2 = 0; k2 < 2; ++k2) {
                        aA[k2] = *(const bf16x8*)(caA + (kb + k2) * 32); aB[k2] = *(const bf16x8*)(caB + (kb + k2) * 32);
#pragma unroll
                        for (int nt = 0; nt < 6; ++nt) bf[k2][nt] = *(const bf16x8*)(wuqT + (size_t)(hh * 96 + nt * 16 + fr) * 256 + (kb + k2) * 32 + fq * 8);
                    }
#pragma unroll
                    for (int k2 = 0; k2 < 2; ++k2)
#pragma unroll
                        for (int nt = 0; nt < 6; ++nt) {
                            cA[nt] = __builtin_amdgcn_mfma_f32_16x16x32_bf16(aA[k2], bf[k2][nt], cA[nt], 0, 0, 0);
                            cB[nt] = __builtin_amdgcn_mfma_f32_16x16x32_bf16(aB[k2], bf[k2][nt], cB[nt], 0, 0, 0);
                        }
                }
#pragma unroll
                for (int j = 0; j < 4; ++j) {
                    const int q = fq * 4 + j, t = t0 + q;
                    const float cs = ctab[t * 16 + fr], sn = stab[t * 16 + fr];
                    s_Q[(q * 16 + hh) * 160 + 128 + fr] = f2bf(cA[4][j] * cs - cA[5][j] * sn);
                    s_Q[(q * 16 + hh) * 160 + 144 + fr] = f2bf(cA[5][j] * cs + cA[4][j] * sn);
                    gq[(q * 16 + hh) * 160 + 128 + fr] = f2bf(cB[4][j] * cs - cB[5][j] * sn);
                    gq[(q * 16 + hh) * 160 + 144 + fr] = f2bf(cB[5][j] * cs + cB[4][j] * sn);
#pragma unroll
                    for (int nt = 0; nt < 4; ++nt) { s_qn[q * 64 + nt * 16 + fr] = f2bf(cA[nt][j]); s_qnB[q * 64 + nt * 16 + fr] = f2bf(cB[nt][j]); }
                }
                __syncthreads();
                bf16x8 anA[2], anB[2];
#pragma unroll
                for (int ks = 0; ks < 2; ++ks) { anA[ks] = *(const bf16x8*)(s_qn + fr * 64 + ks * 32 + fq * 8); anB[ks] = *(const bf16x8*)(s_qnB + fr * 64 + ks * 32 + fq * 8); }
                bf16x8 bwk[8][2];
#pragma unroll
                for (int nt = 0; nt < 8; ++nt)
#pragma unroll
                    for (int ks = 0; ks < 2; ++ks) bwk[nt][ks] = *(const bf16x8*)(wuk + (size_t)(hh * 128 + nt * 16 + fr) * 64 + ks * 32 + fq * 8);
#pragma unroll
                for (int nt = 0; nt < 8; ++nt) {
                    f32x4 aA = z4, aB = z4;
#pragma unroll
                    for (int ks = 0; ks < 2; ++ks) {
                        aA = __builtin_amdgcn_mfma_f32_16x16x32_bf16(anA[ks], bwk[nt][ks], aA, 0, 0, 0);
                        aB = __builtin_amdgcn_mfma_f32_16x16x32_bf16(anB[ks], bwk[nt][ks], aB, 0, 0, 0);
                    }
#pragma unroll
                    for (int j = 0; j < 4; ++j) {
                        s_Q[((fq * 4 + j) * 16 + hh) * 160 + nt * 16 + fr] = f2bf(aA[j]);
                        gq[((fq * 4 + j) * 16 + hh) * 160 + nt * 16 + fr] = f2bf(aB[j]);
                    }
                }
                __syncthreads();
            }
        } else {
            for (int e = tid; e < QS_BYTES / 16; e += NTHR) ((uint4*)s_Q)[e] = ((const uint4*)gq)[e];
            __syncthreads();
        }
#pragma unroll 1
        for (int qi2 = 0; qi2 < 2; ++qi2) {
            const int q = wid + qi2 * 8;
            bf16x8 bq[5];
#pragma unroll
            for (int ks = 0; ks < 5; ++ks) bq[ks] = *(const bf16x8*)(s_Q + (q * 16 + fr) * 160 + ks * 32 + fq * 8);
            const int nsel = s_nsel[q];
            const unsigned short* sel = s_sel + q * 256;
            float m = -INFINITY, lsum = 0.f;
            f32x4 O[8] = {z4, z4, z4, z4, z4, z4, z4, z4};
            const int nchunk = (nsel + 31) >> 5;
            bf16x8 akn[2][5];
#pragma unroll
            for (int mt = 0; mt < 2; ++mt) {
                const int ki = mt * 16 + fr;
                const int sidx = sel[ki < nsel ? ki : 0];
                const bf16_t* krow = kv + ((size_t)b * TS + sidx) * 160 + fq * 8;
#pragma unroll
                for (int ks = 0; ks < 5; ++ks) akn[mt][ks] = *(const bf16x8*)(krow + ks * 32);
            }
#pragma unroll 1
            for (int ch = 0; ch < nchunk; ++ch) {
                bf16x8 ak[2][5];
#pragma unroll
                for (int mt = 0; mt < 2; ++mt)
#pragma unroll
                    for (int ks = 0; ks < 5; ++ks) ak[mt][ks] = akn[mt][ks];
                if (ch + 1 < nchunk) {
#pragma unroll
                    for (int mt = 0; mt < 2; ++mt) {
                        const int ki = (ch + 1) * 32 + mt * 16 + fr;
                        const int sidx = sel[ki < nsel ? ki : 0];
                        const bf16_t* krow = kv + ((size_t)b * TS + sidx) * 160 + fq * 8;
#pragma unroll
                        for (int ks = 0; ks < 5; ++ks) akn[mt][ks] = *(const bf16x8*)(krow + ks * 32);
                    }
                }
#pragma unroll
                for (int mt = 0; mt < 2; ++mt)
#pragma unroll
                    for (int ks = 0; ks < 4; ++ks) {
                        const int r = mt * 16 + fr;
                        *(bf16x8*)(s_Vw + r * 256 + (((ks * 2 + (fq >> 1)) ^ (r & 7)) * 32) + (fq & 1) * 16) = ak[mt][ks];
                    }
                f32x4 st[2] = {z4, z4};
#pragma unroll
                for (int mt = 0; mt < 2; ++mt)
#pragma unroll
                    for (int ks = 0; ks < 5; ++ks) st[mt] = __builtin_amdgcn_mfma_f32_16x16x32_bf16(ak[mt][ks], bq[ks], st[mt], 0, 0, 0);
                float sv[2][4]; float cmax = -INFINITY;
#pragma unroll
                for (int mt = 0; mt < 2; ++mt)
#pragma unroll
                    for (int j = 0; j < 4; ++j) {
                        const int ke = ch * 32 + mt * 16 + fq * 4 + j;
                        const float s_ = (ke < nsel) ? st[mt][j] * scale : -INFINITY;
                        sv[mt][j] = s_; cmax = fmaxf(cmax, s_);
                    }
                cmax = fmaxf(cmax, __shfl_xor(cmax, 16)); cmax = fmaxf(cmax, __shfl_xor(cmax, 32));
                const float mnew = fmaxf(m, cmax);
                const float alpha = __expf(m - mnew);
                float psum = 0.f;
#pragma unroll
                for (int mt = 0; mt < 2; ++mt)
#pragma unroll
                    for (int j = 0; j < 4; ++j) { const float pe = __expf(sv[mt][j] - mnew); sv[mt][j] = pe; psum += pe; }
                psum += __shfl_xor(psum, 16); psum += __shfl_xor(psum, 32);
                lsum = lsum * alpha + psum; m = mnew;
#pragma unroll
                for (int ct = 0; ct < 8; ++ct) O[ct] = O[ct] * alpha;
                bf16x8 pf;
#pragma unroll
                for (int mt = 0; mt < 2; ++mt)
#pragma unroll
                    for (int j = 0; j < 4; ++j) pf[mt * 4 + j] = (short)f2bf(sv[mt][j]);
                const int q_ = fr >> 2, p_ = fr & 3;
                const int r0 = fq * 4 + q_, r1 = 16 + r0;
#pragma unroll
                for (int ct = 0; ct < 8; ++ct) {
                    const s16x4 v0 = __builtin_amdgcn_ds_read_tr16_b64_v4i16((__attribute__((address_space(3))) s16x4*)(s_Vw + r0 * 256 + ((ct ^ (r0 & 7)) * 32) + p_ * 8));
                    const s16x4 v1 = __builtin_amdgcn_ds_read_tr16_b64_v4i16((__attribute__((address_space(3))) s16x4*)(s_Vw + r1 * 256 + ((ct ^ (r1 & 7)) * 32) + p_ * 8));
                    bf16x8 av; av[0] = v0[0]; av[1] = v0[1]; av[2] = v0[2]; av[3] = v0[3]; av[4] = v1[0]; av[5] = v1[1]; av[6] = v1[2]; av[7] = v1[3];
                    O[ct] = __builtin_amdgcn_mfma_f32_16x16x32_bf16(av, pf, O[ct], 0, 0, 0);
                }
            }
            const float inv = 1.0f / lsum;
#pragma unroll
            for (int ct = 0; ct < 8; ++ct)
#pragma unroll
                for (int j = 0; j < 4; ++j) s_Q[(q * 16 + fr) * 160 + ct * 16 + fq * 4 + j] = f2bf(O[ct][j] * inv);
        }
        __syncthreads();
#pragma unroll 1
        for (int hi = 0; hi < 2; ++hi) {
            const int hh = wid * 2 + hi;
            bf16x8 ao[4];
#pragma unroll
            for (int ks = 0; ks < 4; ++ks) ao[ks] = *(const bf16x8*)(s_Q + (fr * 16 + hh) * 160 + ks * 32 + fq * 8);
#pragma unroll
            for (int nt = 0; nt < 4; ++nt) {
                f32x4 a = z4;
#pragma unroll
                for (int ks = 0; ks < 4; ++ks)
                    a = __builtin_amdgcn_mfma_f32_16x16x32_bf16(ao[ks], *(const bf16x8*)(wuvT + (size_t)(hh * 64 + nt * 16 + fr) * 128 + ks * 32 + fq * 8), a, 0, 0, 0);
#pragma unroll
                for (int j = 0; j < 4; ++j) yc[(n0 + fq * 4 + j) * 1024 + hh * 64 + nt * 16 + fr] = f2bf(a[j]);
            }
        }
        __syncthreads();
        }
    }
}


__device__ void phase_lr_prep(const Params& p, int l) {
    const int lane = otid() & 63;
    const int wave = (obid() * NTHR + otid()) >> 6, nw = gridDim.x * NTHR / 64;
    const bf16_t* pm = (const bf16_t*)(WS(p) + OFF_PMISC);
    bf16_t* alr = (bf16_t*)(OUTB(p) + DO_ALR);
    const float4 mu4 = *(const float4*)(p.in[4] + (size_t)l * 3328 + 3072 + lane * 4);
    const float4 vm4 = *(const float4*)(p.in[18] + (lane & 7) * 4);
    struct In { uint2 c0, p0, c1, p1; };
    auto load = [&](int n) {
        In r;
        const bf16_t* row = pm + (size_t)n * PM_LD;
        const bool hp = (n % TS) > 0;
        r.c0 = *(const uint2*)(row + lane * 4);
        r.p0 = hp ? *(const uint2*)(row - PM_LD + lane * 4) : make_uint2(0u, 0u);
        r.c1 = make_uint2(0u, 0u); r.p1 = r.c1;
        if (lane < 8) { r.c1 = *(const uint2*)(row + 256 + lane * 4); if (hp) r.p1 = *(const uint2*)(row - PM_LD + 256 + lane * 4); }
        return r;
    };
    auto mix4 = [&](const uint2 c, const uint2 q, const float4 m, float (&o)[4]) {
        const float c0 = __uint_as_float(c.x << 16), c1 = __uint_as_float(c.x & 0xFFFF0000u), c2 = __uint_as_float(c.y << 16), c3 = __uint_as_float(c.y & 0xFFFF0000u);
        const float q0 = __uint_as_float(q.x << 16), q1 = __uint_as_float(q.x & 0xFFFF0000u), q2 = __uint_as_float(q.y << 16), q3 = __uint_as_float(q.y & 0xFFFF0000u);
        o[0] = c0 + (q0 - c0) * m.x; o[1] = c1 + (q1 - c1) * m.y; o[2] = c2 + (q2 - c2) * m.z; o[3] = c3 + (q3 - c3) * m.w;
    };
    In cur = load(wave < NT ? wave : 0);
    for (int n = wave; n < NT; n += nw) {
        const In x = cur;
        if (n + nw < NT) cur = load(n + nw);
        float o[4];
        mix4(x.c0, x.p0, mu4, o);
        if (lane < 16) { o[0] = tanhf(o[0]); o[1] = tanhf(o[1]); o[2] = tanhf(o[2]); o[3] = tanhf(o[3]); }
        else if (lane >= 32) { o[0] = sigmoidf_(o[0]); o[1] = sigmoidf_(o[1]); o[2] = sigmoidf_(o[2]); o[3] = sigmoidf_(o[3]); }
        *(uint2*)(alr + (size_t)n * 288 + lane * 4) = pack4(o[0], o[1], o[2], o[3]);
        if (lane < 8) {
            mix4(x.c1, x.p1, vm4, o);
            *(uint2*)(alr + (size_t)n * 288 + 256 + lane * 4) = pack4(o[0], o[1], o[2], o[3]);
        }
    }
}

typedef short sh4 __attribute__((ext_vector_type(4)));
__device__ __forceinline__ sh4 pk4v(const f32x4& v) { const uint2 u = pack4(v[0], v[1], v[2], v[3]); sh4 r; __builtin_memcpy(&r, &u, 8); return r; }
__device__ __forceinline__ bf16x8 cat8(const sh4& a, const sh4& b) { bf16x8 r; r[0] = a[0]; r[1] = a[1]; r[2] = a[2]; r[3] = a[3]; r[4] = b[0]; r[5] = b[1]; r[6] = b[2]; r[7] = b[3]; return r; }
#define MF32(a, b, c) __builtin_amdgcn_mfma_f32_16x16x32_bf16(a, b, c, 0, 0, 0)
#define MF16(a, b, c) MF32(cat8(a, sh4{0, 0, 0, 0}), cat8(b, sh4{0, 0, 0, 0}), c)
constexpr int SC_LT = 72;
constexpr int SC_LS = 36;
constexpr int SC_TC = 32;
constexpr int SC_ROWB = 1088;
__device__ __forceinline__ const unsigned char* scan_piece_src(const Params& p, int l, int b, int hc, int t0, int pi, bool& ok) {
    const int tau = pi / 68, seg = pi - tau * 68;
    const int t = t0 + tau;
    ok = (t < TS) && (tau < SC_TC);
    const size_t n = (size_t)b * TS + t;
    const unsigned char* ws = WS(p);
    if (seg < 8) return ws + OFF_PR + (n * 1024 + hc) * 2 + seg * 16;
    if (seg < 16) return ws + OFF_PK + (n * 1024 + hc) * 2 + (seg - 8) * 16;
    if (seg < 24) return ws + OFF_PV + (n * 1024 + hc) * 2 + (seg - 16) * 16;
    if (seg < 60) return OUTB(p) + DO_ALR + (n * 288) * 2 + (seg - 24) * 16;
    ok = ok && (l > 0);
    return ws + OFF_VFIRST + (n * 1024 + hc) * 2 + (seg - 60) * 16;
}
__device__ void phase_scan5(const Params& p, int l, unsigned char* lds, int blk) {
    const int tid = otid(), lane = tid & 63, wid = tid >> 6, fr = lane & 15, fq = lane >> 4;
    const int b = blk >> 4, hh = blk & 15, hc = hh * 64;
    float* s_r = (float*)lds;
    float* s_w = s_r + 2048;
    float* s_k = s_w + 2048;
    float* s_v = s_k + 2048;
    float* s_a = s_v + 2048;
    float* s_b = s_a + 2048;
    float* s_g = s_b + 2048;
    float* s_o = s_g + 2048;
    bf16_t* o_at = (bf16_t*)(s_o + 2048);
    bf16_t* o_rt = o_at + 32 * SC_LT;
    bf16_t* o_bt = o_rt + 32 * SC_LT;
    bf16_t* o_kt = o_bt + 32 * SC_LT;
    bf16_t* o_bT = o_kt + 32 * SC_LT;
    bf16_t* o_kT = o_bT + 64 * SC_LS;
    bf16_t* o_vT = o_kT + 64 * SC_LS;
    float* s_gc = (float*)(o_vT + 64 * SC_LS);
    unsigned char* raw = (unsigned char*)(s_gc + 128);
    float* prevb = (float*)(raw + 32 * SC_ROWB);
    unsigned* prevr = (unsigned*)prevb;
    float* cst = prevb + 960;
    float* s_gB = s_r;
    float* s_oB = s_k;
    float* s_vB = cst + 992;
    float* s_bs2 = s_vB + 2048;
    const float* mu = p.in[4] + (size_t)l * 3328;
    for (int e = tid; e < 480; e += NTHR) {
        float v;
        if (e < 192) v = mu[(e >> 6) * 1024 + hc + (e & 63)];
        else if (e < 448) v = mu[3072 + (e - 192)];
        else v = p.in[18][e - 448];
        cst[e] = v;
    }
    if (tid < 64) {
        cst[480 + tid] = p.in[7][l * 1024 + hc + tid];
        cst[544 + tid] = p.in[9][l * 1024 + hc + tid];
        cst[608 + tid] = p.in[12][l * 1024 + hc + tid];
        cst[672 + tid] = p.in[13][l * 1024 + hc + tid];
        cst[736 + tid] = p.in[14][l * 1024 + hc + tid];
        cst[800 + tid] = p.in[15][l * 1024 + hc + tid];
        cst[864 + tid] = p.in[16][l * 1024 + hc + tid];
        cst[928 + tid] = p.in[19][hc + tid];
    }
    const int mm = wid >> 1, ntb = (wid & 1) * 2;
    const int nks = (mm == 2) ? 4 : (mm == 3 ? 1 : 2);
    bf16x8 Bw[2][4];
    {
        const float* wsrc = (mm == 0) ? p.in[8] + (size_t)l * 64 * 1024 : (mm == 1) ? p.in[10] + (size_t)l * 64 * 1024 : (mm == 2) ? p.in[11] + (size_t)l * 128 * 1024 : p.in[20];
#pragma unroll
        for (int n2 = 0; n2 < 2; ++n2)
#pragma unroll
            for (int ks = 0; ks < 4; ++ks) {
                bf16x8 f;
#pragma unroll
                for (int j = 0; j < 8; ++j) {
                    const bool okw = ks < nks && (mm < 3 || l > 0);
                    const float v = wsrc[(size_t)(okw ? (ks * 32 + fq * 8 + j) : 0) * 1024 + hc + (ntb + n2) * 16 + fr];
                    f[j] = (short)f2bf(okw ? v : 0.f);
                }
                Bw[n2][ks] = f;
            }
    }
    const f32x4 z4 = {0.f, 0.f, 0.f, 0.f};
    f32x4 S[4] = {z4, z4, z4, z4};
    sh4 Lf;
#pragma unroll
    for (int j = 0; j < 4; ++j) Lf[j] = (fq * 4 + j <= fr) ? (short)0x3F80 : (short)0;
    bf16_t* Pr = (bf16_t*)(WS(p) + OFF_PR);
    bf16_t* vfirst = (bf16_t*)(WS(p) + OFF_VFIRST);
    const unsigned char* psrc[5]; int pstep[5], ptau[5]; bool pval[5];
#pragma unroll
    for (int k = 0; k < 5; ++k) {
        const int pi = tid + k * NTHR;
        bool ok = false;
        psrc[k] = scan_piece_src(p, l, b, hc, 0, pi < SC_TC * 68 ? pi : 0, ok);
        const int tau = (pi < SC_TC * 68 ? pi : 0) / 68, seg = (pi < SC_TC * 68 ? pi : 0) - tau * 68;
        ptau[k] = tau;
        pstep[k] = SC_TC * ((seg >= 24 && seg < 60) ? 576 : 2048);
        pval[k] = (pi < SC_TC * 68) && !(seg >= 60 && l == 0);
    }
    uint4 pre[5];
#pragma unroll
    for (int k = 0; k < 5; ++k) { pre[k] = make_uint4(0, 0, 0, 0); if (pval[k] && ptau[k] < TS) pre[k] = *(const uint4*)psrc[k]; }
    __syncthreads();
    auto stepE = [&](int tau, int c4, const float* so, const float* sv, const float* sgp, const float* sb, int t0e, int nve) {
        const int e = tau * 64 + c4;
        const size_t n = (size_t)b * TS + t0e + tau;
        const float4 o4 = *(const float4*)(so + e), v4_ = *(const float4*)(sv + e), g4_ = *(const float4*)(sgp + e);
        const float4 clw = *(const float4*)(cst + 800 + c4), clb = *(const float4*)(cst + 864 + c4);
        const float bsum = sb[tau];
        const float m_ = row16_sum((o4.x + o4.y) + (o4.z + o4.w)) * (1.0f / 64.0f);
        const float d0 = o4.x - m_, d1 = o4.y - m_, d2 = o4.z - m_, d3 = o4.w - m_;
        const float var = row16_sum(d0 * d0 + d1 * d1 + d2 * d2 + d3 * d3) * (1.0f / 64.0f);
        const float rs = rsqrtf(var + 64e-5f);
        const float y0 = (d0 * rs * clw.x + clb.x + bsum * v4_.x) * g4_.x, y1 = (d1 * rs * clw.y + clb.y + bsum * v4_.y) * g4_.y;
        const float y2 = (d2 * rs * clw.z + clb.z + bsum * v4_.z) * g4_.z, y3 = (d3 * rs * clw.w + clb.w + bsum * v4_.w) * g4_.w;
        if (tau < nve) *(uint2*)(Pr + n * 1024 + hc + c4) = pack4(y0, y1, y2, y3);
    };
#pragma unroll 1
    for (int t0 = 0, ch = 0; t0 < TS; t0 += SC_TC, ++ch) {
        const int nval = (TS - t0 < SC_TC) ? (TS - t0) : SC_TC;
        const bool par = (ch & 1) != 0;
        float* g_c = par ? s_gB : s_g; float* o_c = par ? s_oB : s_o; float* v_c = par ? s_vB : s_v; float* bs_c = s_bs2 + (par ? 32 : 0);
        float* g_p = par ? s_g : s_gB; float* o_p = par ? s_o : s_oB; float* v_p = par ? s_v : s_vB; float* bs_p = s_bs2 + (par ? 0 : 32);
#pragma unroll
        for (int k = 0; k < 5; ++k) { const int pi = tid + k * NTHR; if (pi < SC_TC * 68) *(uint4*)(raw + pi * 16) = pre[k]; }
        lds_barrier();
#pragma unroll
        for (int k = 0; k < 5; ++k) {
            pre[k] = make_uint4(0, 0, 0, 0);
            if (pval[k] && t0 + SC_TC + ptau[k] < TS) pre[k] = *(const uint4*)(psrc[k] + (size_t)(ch + 1) * pstep[k]);
        }
        if (mm < 3 || l > 0) {
            const unsigned char* Ab = raw + ((mm == 0) ? 384 : (mm == 1) ? 512 : (mm == 2) ? 640 : 896);
            float* dst = (mm == 0) ? s_w : (mm == 1) ? s_a : (mm == 2) ? g_c : o_c;
#pragma unroll
            for (int m = 0; m < 2; ++m) {
                f32x4 acc0 = {0.f, 0.f, 0.f, 0.f}, acc1 = {0.f, 0.f, 0.f, 0.f};
#pragma unroll
                for (int ks = 0; ks < 4; ++ks) {
                    if (ks < nks) {
                        const bf16x8 a = *(const bf16x8*)(Ab + (m * 16 + fr) * SC_ROWB + ks * 64 + fq * 16);
                        acc0 = __builtin_amdgcn_mfma_f32_16x16x32_bf16(a, Bw[0][ks], acc0, 0, 0, 0);
                        acc1 = __builtin_amdgcn_mfma_f32_16x16x32_bf16(a, Bw[1][ks], acc1, 0, 0, 0);
                    }
                }
                if (mm == 0) {
                    const float cw0 = cst[480 + ntb * 16 + fr], cw1 = cst[480 + (ntb + 1) * 16 + fr];
                    f32x4 l0, l1, r0, r1;
#pragma unroll
                    for (int j = 0; j < 4; ++j) { l0[j] = -0.6065306597126334f * fast_sigmoid(acc0[j] + cw0); l1[j] = -0.6065306597126334f * fast_sigmoid(acc1[j] + cw1); }
                    const uint2 h0 = pack4(l0[0], l0[1], l0[2], l0[3]), h1 = pack4(l1[0], l1[1], l1[2], l1[3]);
                    r0[0] = l0[0] - __uint_as_float(h0.x << 16); r0[1] = l0[1] - __uint_as_float(h0.x & 0xFFFF0000u); r0[2] = l0[2] - __uint_as_float(h0.y << 16); r0[3] = l0[3] - __uint_as_float(h0.y & 0xFFFF0000u);
                    r1[0] = l1[0] - __uint_as_float(h1.x << 16); r1[1] = l1[1] - __uint_as_float(h1.x & 0xFFFF0000u); r1[2] = l1[2] - __uint_as_float(h1.y << 16); r1[3] = l1[3] - __uint_as_float(h1.y & 0xFFFF0000u);
                    sh4 hh0, hh1; __builtin_memcpy(&hh0, &h0, 8); __builtin_memcpy(&hh1, &h1, 8);
                    f32x4 c0 = MF16(Lf, pk4v(r0), z4), c1 = MF16(Lf, pk4v(r1), z4);
                    c0 = MF16(Lf, hh0, c0); c1 = MF16(Lf, hh1, c1);
#pragma unroll
                    for (int j = 0; j < 4; ++j) {
                        const int eo = (m * 16 + fq * 4 + j) * 64 + ntb * 16 + fr;
                        s_w[eo] = c0[j]; s_w[eo + 16] = c1[j];
                        s_b[eo] = l0[j]; s_b[eo + 16] = l1[j];
                    }
                } else {
#pragma unroll
                    for (int j = 0; j < 4; ++j) {
                        dst[(m * 16 + fq * 4 + j) * 64 + ntb * 16 + fr] = acc0[j];
                        dst[(m * 16 + fq * 4 + j) * 64 + (ntb + 1) * 16 + fr] = acc1[j];
                    }
                }
            }
        }
        lds_barrier();
        {
            const int tau = tid >> 4, c4 = (tid & 15) * 4, e = tau * 64 + c4, t = t0 + tau;
            const size_t n = (size_t)b * TS + t;
            const float4 cum4 = *(const float4*)(s_w + e), lw4 = *(const float4*)(s_b + e), xa4 = *(const float4*)(s_a + e);
            const float4 ca = *(const float4*)(cst + 544 + c4), ckk = *(const float4*)(cst + 608 + c4), cka = *(const float4*)(cst + 672 + c4), crk = *(const float4*)(cst + 736 + c4);
            const float cum[4] = {cum4.x, cum4.y, cum4.z, cum4.w}, lw[4] = {lw4.x, lw4.y, lw4.z, lw4.w};
            const float xa[4] = {xa4.x + ca.x, xa4.y + ca.y, xa4.z + ca.z, xa4.w + ca.w};
            const float kkc[4] = {ckk.x, ckk.y, ckk.z, ckk.w}, kac[4] = {cka.x, cka.y, cka.z, cka.w};
            float rr[4], kr[4], vv[4];
            {
                const unsigned char* rc = raw + tau * SC_ROWB + c4 * 2;
                const uint2 cr = *(const uint2*)rc, ck = *(const uint2*)(rc + 128), cv = *(const uint2*)(rc + 256);
                uint2 qr = make_uint2(0u, 0u), qk = qr, qv = qr;
                if (tau > 0) { qr = *(const uint2*)(rc - SC_ROWB); qk = *(const uint2*)(rc - SC_ROWB + 128); qv = *(const uint2*)(rc - SC_ROWB + 256); }
                else if (t0 > 0) { const unsigned* pvr = prevr + ((ch + 1) & 1) * 96 + (c4 >> 1); qr = *(const uint2*)pvr; qk = *(const uint2*)(pvr + 32); qv = *(const uint2*)(pvr + 64); }
                if (tau == SC_TC - 1) { unsigned* pwr = prevr + (ch & 1) * 96 + (c4 >> 1); *(uint2*)pwr = cr; *(uint2*)(pwr + 32) = ck; *(uint2*)(pwr + 64) = cv; }
                const float4 mr = *(const float4*)(cst + c4), mk = *(const float4*)(cst + 64 + c4), mv = *(const float4*)(cst + 128 + c4);
                const float c_[12] = {__uint_as_float(cr.x << 16), __uint_as_float(cr.x & 0xFFFF0000u), __uint_as_float(cr.y << 16), __uint_as_float(cr.y & 0xFFFF0000u),
                                      __uint_as_float(ck.x << 16), __uint_as_float(ck.x & 0xFFFF0000u), __uint_as_float(ck.y << 16), __uint_as_float(ck.y & 0xFFFF0000u),
                                      __uint_as_float(cv.x << 16), __uint_as_float(cv.x & 0xFFFF0000u), __uint_as_float(cv.y << 16), __uint_as_float(cv.y & 0xFFFF0000u)};
                const float q_[12] = {__uint_as_float(qr.x << 16), __uint_as_float(qr.x & 0xFFFF0000u), __uint_as_float(qr.y << 16), __uint_as_float(qr.y & 0xFFFF0000u),
                                      __uint_as_float(qk.x << 16), __uint_as_float(qk.x & 0xFFFF0000u), __uint_as_float(qk.y << 16), __uint_as_float(qk.y & 0xFFFF0000u),
                                      __uint_as_float(qv.x << 16), __uint_as_float(qv.x & 0xFFFF0000u), __uint_as_float(qv.y << 16), __uint_as_float(qv.y & 0xFFFF0000u)};
                const float m_[12] = {mr.x, mr.y, mr.z, mr.w, mk.x, mk.y, mk.z, mk.w, mv.x, mv.y, mv.z, mv.w};
#pragma unroll
                for (int j = 0; j < 4; ++j) { rr[j] = c_[j] + (q_[j] - c_[j]) * m_[j]; kr[j] = c_[4 + j] + (q_[4 + j] - c_[4 + j]) * m_[4 + j]; vv[j] = c_[8 + j] + (q_[8 + j] - c_[8 + j]) * m_[8 + j]; }
            }
            if (l > 0) {
                const float4 xv4 = *(const float4*)(o_c + e), cv = *(const float4*)(cst + 928 + c4);
                const uint2 vfu = *(const uint2*)(raw + tau * SC_ROWB + 960 + c4 * 2);
                const float vf[4] = {__uint_as_float(vfu.x << 16), __uint_as_float(vfu.x & 0xFFFF0000u), __uint_as_float(vfu.y << 16), __uint_as_float(vfu.y & 0xFFFF0000u)};
                const float xv[4] = {xv4.x + cv.x, xv4.y + cv.y, xv4.z + cv.z, xv4.w + cv.w};
#pragma unroll
                for (int j = 0; j < 4; ++j) vv[j] = vv[j] + (vf[j] - vv[j]) * fast_sigmoid(xv[j]);
            } else if (t < TS) {
                *(uint2*)(vfirst + n * 1024 + hc + c4) = pack4(vv[0], vv[1], vv[2], vv[3]);
            }
            float av[4], kkv[4], ginc[4], gexc[4], ginv[4]; float ss = 0.f;
#pragma unroll
            for (int j = 0; j < 4; ++j) {
                ginc[j] = __expf(cum[j]); gexc[j] = __expf(cum[j] - lw[j]); ginv[j] = __expf(-cum[j]);
                av[j] = fast_sigmoid(xa[j]);
                kkv[j] = kr[j] * kkc[j];
                ss += kkv[j] * kkv[j];
            }
            float kk[4], kt[4];
#pragma unroll
            for (int j = 0; j < 4; ++j) kt[j] = kr[j] * (1.0f + (av[j] - 1.0f) * kac[j]);
            float bsum = rr[0] * kt[0] * crk.x + rr[1] * kt[1] * crk.y + rr[2] * kt[2] * crk.z + rr[3] * kt[3] * crk.w;
            float du0 = 0.f, du1 = 0.f;
            row16_sum4(ss, bsum, du0, du1);
            if ((tid & 15) == 0) bs_c[tau] = bsum;
            const float rn = rsqrtf(fmaxf(ss, 1e-24f));
#pragma unroll
            for (int j = 0; j < 4; ++j) kk[j] = kkv[j] * rn;
            const uint2 pa = pack4(-kk[0] * gexc[0], -kk[1] * gexc[1], -kk[2] * gexc[2], -kk[3] * gexc[3]);
            const uint2 pr = pack4(rr[0] * ginc[0], rr[1] * ginc[1], rr[2] * ginc[2], rr[3] * ginc[3]);
            const uint2 pb = pack4(kk[0] * av[0] * ginv[0], kk[1] * av[1] * ginv[1], kk[2] * av[2] * ginv[2], kk[3] * av[3] * ginv[3]);
            const uint2 pk = pack4(kt[0] * ginv[0], kt[1] * ginv[1], kt[2] * ginv[2], kt[3] * ginv[3]);
            const uint2 pv = pack4(vv[0], vv[1], vv[2], vv[3]);
            *(uint2*)(o_at + tau * SC_LT + c4) = pa;
            *(uint2*)(o_rt + tau * SC_LT + c4) = pr;
            *(uint2*)(o_bt + tau * SC_LT + c4) = pb;
            *(uint2*)(o_kt + tau * SC_LT + c4) = pk;
            o_bT[(c4 + 0) * SC_LS + tau] = (bf16_t)(pb.x & 0xFFFFu); o_bT[(c4 + 1) * SC_LS + tau] = (bf16_t)(pb.x >> 16); o_bT[(c4 + 2) * SC_LS + tau] = (bf16_t)(pb.y & 0xFFFFu); o_bT[(c4 + 3) * SC_LS + tau] = (bf16_t)(pb.y >> 16);
            o_kT[(c4 + 0) * SC_LS + tau] = (bf16_t)(pk.x & 0xFFFFu); o_kT[(c4 + 1) * SC_LS + tau] = (bf16_t)(pk.x >> 16); o_kT[(c4 + 2) * SC_LS + tau] = (bf16_t)(pk.y & 0xFFFFu); o_kT[(c4 + 3) * SC_LS + tau] = (bf16_t)(pk.y >> 16);
            o_vT[(c4 + 0) * SC_LS + tau] = (bf16_t)(pv.x & 0xFFFFu); o_vT[(c4 + 1) * SC_LS + tau] = (bf16_t)(pv.x >> 16); o_vT[(c4 + 2) * SC_LS + tau] = (bf16_t)(pv.y & 0xFFFFu); o_vT[(c4 + 3) * SC_LS + tau] = (bf16_t)(pv.y >> 16);
            if ((tau & 15) == 15) *(float4*)(s_gc + (tau >> 4) * 64 + c4) = make_float4(ginc[0], ginc[1], ginc[2], ginc[3]);
            *(float4*)(v_c + e) = make_float4(vv[0], vv[1], vv[2], vv[3]);
        }
        lds_barrier();
        if (wid < 4) {
#pragma unroll 1
            for (int sc = 0; sc < 2; ++sc) {
                if (sc * 16 < nval) {
                    const bf16_t* ar = o_at + (sc * 16 + fr) * SC_LT;
                    const bf16_t* rr_ = o_rt + (sc * 16 + fr) * SC_LT;
                    const bf16_t* br = o_bt + (sc * 16 + fr) * SC_LT;
                    const bf16_t* kr_ = o_kt + (sc * 16 + fr) * SC_LT;
                    const bf16x8 fa0 = *(const bf16x8*)(ar + fq * 8), fa1 = *(const bf16x8*)(ar + 32 + fq * 8);
                    const bf16x8 fb0 = *(const bf16x8*)(br + fq * 8), fb1 = *(const bf16x8*)(br + 32 + fq * 8);
                    const bf16x8 fk0 = *(const bf16x8*)(kr_ + fq * 8), fk1 = *(const bf16x8*)(kr_ + 32 + fq * 8);
                    const bf16x8 fr0 = *(const bf16x8*)(rr_ + fq * 8), fr1 = *(const bf16x8*)(rr_ + 32 + fq * 8);
                    f32x4 nA = MF32(fb0, fa0, z4); nA = MF32(fb1, fa1, nA);
                    f32x4 nB = MF32(fa0, fb0, z4); nB = MF32(fa1, fb1, nB);
                    f32x4 mak = MF32(fk0, fa0, z4); mak = MF32(fk1, fa1, mak);
                    f32x4 mbr = MF32(fb0, fr0, z4); mbr = MF32(fb1, fr1, mbr);
                    f32x4 mkr = MF32(fk0, fr0, z4); mkr = MF32(fk1, fr1, mkr);
#pragma unroll
                    for (int j = 0; j < 4; ++j) {
                        const int s_ = fq * 4 + j;
                        nA[j] = (s_ < fr) ? nA[j] : 0.f; nB[j] = (fr < s_) ? nB[j] : 0.f; mak[j] = (s_ < fr) ? mak[j] : 0.f;
                        mbr[j] = (s_ <= fr) ? mbr[j] : 0.f; mkr[j] = (s_ <= fr) ? mkr[j] : 0.f;
                    }
                    const sh4 pNA = pk4v(nA), pNB = pk4v(nB), pMak = pk4v(mak), pMbr = pk4v(mbr), pMkr = pk4v(mkr);
                    const f32x4 n2B = MF16(pNA, pNB, z4), n2A = MF16(pNB, pNA, z4);
                    const sh4 pN2A = pk4v(n2A), pN2B = pk4v(n2B);
                    const f32x4 n4B = MF16(pN2A, pN2B, z4), n4A = MF16(pN2B, pN2A, z4);
                    const sh4 pN4A = pk4v(n4A), pN4B = pk4v(n4B);
                    const sh4 pN8A = pk4v(MF16(pN4B, pN4A, z4));
                    const bf16x8 sB0 = cat8(pk4v(S[0]), pk4v(S[1])), sB1 = cat8(pk4v(S[2]), pk4v(S[3]));
                    const sh4 vf = *(const sh4*)(o_vT + (wid * 16 + fr) * SC_LS + sc * 16 + fq * 4);
                    f32x4 X = MF32(cat8(*(const sh4*)(ar + fq * 4), *(const sh4*)(ar + 16 + fq * 4)), sB0, z4);
                    X = MF32(cat8(*(const sh4*)(ar + 32 + fq * 4), *(const sh4*)(ar + 48 + fq * 4)), sB1, X);
                    X = MF16(pMak, vf, X);
                    X = MF16(pN8A, pk4v(X), X); X = MF16(pN4A, pk4v(X), X); X = MF16(pN2A, pk4v(X), X); X = MF16(pNA, pk4v(X), X);
                    const sh4 pSA = pk4v(X);
                    f32x4 O = MF32(cat8(*(const sh4*)(rr_ + fq * 4), *(const sh4*)(rr_ + 16 + fq * 4)), sB0, z4);
                    O = MF32(cat8(*(const sh4*)(rr_ + 32 + fq * 4), *(const sh4*)(rr_ + 48 + fq * 4)), sB1, O);
                    const bf16x8 sav = cat8(pSA, vf);
                    O = MF32(cat8(pMbr, pMkr), sav, O);
#pragma unroll
                    for (int j = 0; j < 4; ++j) o_c[(sc * 16 + fq * 4 + j) * 64 + wid * 16 + fr] = O[j];
#pragma unroll
                    for (int jt = 0; jt < 4; ++jt) {
                        const sh4 ka = *(const sh4*)(o_kT + (jt * 16 + fr) * SC_LS + sc * 16 + fq * 4), ba = *(const sh4*)(o_bT + (jt * 16 + fr) * SC_LS + sc * 16 + fq * 4);
                        f32x4 acc = MF32(cat8(ba, ka), sav, S[jt]);
                        const float4 g4 = *(const float4*)(s_gc + sc * 64 + jt * 16 + fq * 4);
                        acc[0] *= g4.x; acc[1] *= g4.y; acc[2] *= g4.z; acc[3] *= g4.w;
                        S[jt] = acc;
                    }
                }
            }
        } else if (ch > 0) {
            const int t2 = tid - 256;
            stepE(t2 >> 4, (t2 & 15) * 4, o_p, v_p, g_p, bs_p, t0 - SC_TC, SC_TC);
            stepE(16 + (t2 >> 4), (t2 & 15) * 4, o_p, v_p, g_p, bs_p, t0 - SC_TC, SC_TC);
        }
        lds_barrier();
    }
    {
        const int chl = (TS + SC_TC - 1) / SC_TC - 1; const bool parl = (chl & 1) != 0;
        stepE(tid >> 4, (tid & 15) * 4, parl ? s_oB : s_o, parl ? s_vB : s_v, parl ? s_gB : s_g, s_bs2 + (parl ? 32 : 0), chl * SC_TC, TS - chl * SC_TC);
    }
}
__device__ __forceinline__ void xcd_panel_map(int& mt0, int& mstep, int& nt) {
    const int b = obid(), G = (int)gridDim.x;
    if (G == 256) { nt = (b >> 3) & 7; mt0 = (b & 7) * 4 + (b >> 6); mstep = 32; }
    else { nt = b & 7; mt0 = b >> 3; mstep = G >> 3; }
}
__device__ void phase_merge(const Params& p, unsigned char* lds) {
    const int tid = otid(), lane = tid & 63, wid = tid >> 6, wr = wid >> 1, wc = wid & 1, fr = lane & 15, fq = lane >> 4;
    const bf16_t* h = (const bf16_t*)(WS(p) + OFF_H);
    const bf16_t* wb = (const bf16_t*)(WS(p) + OFF_WB);
    const float* rstd = (const float*)(WS(p) + OFF_RSTD);
    bf16_t* merged = (bf16_t*)(WS(p) + OFF_MERGED);
    const bf16_t* ysrc0 = (const bf16_t*)(WS(p) + OFF_PPOOL);
    const bf16_t* ysrc1 = (const bf16_t*)(WS(p) + OFF_PR);
    const bf16_t* ysrc2 = (const bf16_t*)(OUTB(p) + DO_YC);
    for (int tile = obid(); tile < 86 * 8; tile += gridDim.x) {
        const int mt = tile >> 3, nt = tile & 7;
        const int row0 = mt * 192, col0 = nt * 128;
        uint2 maccp[3][4];
#pragma unroll
        for (int m = 0; m < 3; ++m)
#pragma unroll
            for (int n = 0; n < 4; ++n) maccp[m][n] = make_uint2(0u, 0u);
#pragma unroll 1
        for (int i = 0; i < 3; ++i) {
            const int tid = otid();
            const bf16_t* ys = (i == 0) ? ysrc0 : (i == 1 ? ysrc1 : ysrc2);
            uint2 sg[3][4];
            {
                f32x4 ag[3][4]; g3_zero<3>(ag);
                G3<192> g;
                g3_setup<192>(g, [&](int r) { return h + (size_t)(row0 + r) * DM; }, [&](int r) { return wb + WB_WG + (size_t)(i * 1024 + col0 + r) * DM; }, tid);
                g3_kloop<192>(ag, g, DM, lds);
#pragma unroll
                for (int m = 0; m < 3; ++m) {
                    const float rs = rstd[row0 + wr * 48 + m * 16 + fr];
#pragma unroll
                    for (int n = 0; n < 4; ++n) sg[m][n] = pack4(fast_sigmoid(ag[m][n][0] * rs), fast_sigmoid(ag[m][n][1] * rs), fast_sigmoid(ag[m][n][2] * rs), fast_sigmoid(ag[m][n][3] * rs));
                }
            }
            {
                f32x4 ay[3][4]; g3_zero<3>(ay);
                G3<192> g;
                g3_setup<192>(g, [&](int r) { return ys + (size_t)(row0 + r) * DM; }, [&](int r) { return wb + WB_PA + (size_t)(i * 1024 + col0 + r) * DM; }, tid);
                g3_kloop<192>(ay, g, DM, lds);
#pragma unroll
                for (int m = 0; m < 3; ++m)
#pragma unroll
                    for (int n = 0; n < 4; ++n) {
                        const float m0 = __uint_as_float(maccp[m][n].x << 16) + __uint_as_float(sg[m][n].x << 16) * ay[m][n][0];
                        const float m1 = __uint_as_float(maccp[m][n].x & 0xFFFF0000u) + __uint_as_float(sg[m][n].x & 0xFFFF0000u) * ay[m][n][1];
                        const float m2 = __uint_as_float(maccp[m][n].y << 16) + __uint_as_float(sg[m][n].y << 16) * ay[m][n][2];
                        const float m3 = __uint_as_float(maccp[m][n].y & 0xFFFF0000u) + __uint_as_float(sg[m][n].y & 0xFFFF0000u) * ay[m][n][3];
                        maccp[m][n] = pack4(m0, m1, m2, m3);
                    }
            }
        }
#pragma unroll
        for (int m = 0; m < 3; ++m) {
            const int row = row0 + wr * 48 + m * 16 + fr;
#pragma unroll
            for (int n = 0; n < 4; ++n)
                *(uint2*)(merged + (size_t)row * 1024 + col0 + wc * 64 + n * 16 + fq * 4) = maccp[m][n];
        }
    }
}

__device__ void phase_outproj(const Params& p, unsigned char* lds) {
    const int tid = otid(), lane = tid & 63, wid = tid >> 6, wr = wid >> 1, wc = wid & 1, fr = lane & 15, fq = lane >> 4;
    const bf16_t* h = (const bf16_t*)(WS(p) + OFF_H);
    const bf16_t* wb = (const bf16_t*)(WS(p) + OFF_WB);
    const bf16_t* merged = (const bf16_t*)(WS(p) + OFF_MERGED);
    float* hm = (float*)(WS(p) + OFF_HM32);
    int mt0, mstep, nt;
    xcd_panel_map(mt0, mstep, nt);
    for (int mt = mt0; mt < 86; mt += mstep) {
        const int row0 = mt * 192, col0 = nt * 128;
        G3<192> g;
        g3_setup<192>(g, [&](int r) { return merged + (size_t)(row0 + r) * DM; }, [&](int r) { return wb + WB_WO + (size_t)(col0 + r) * DM; }, tid);
        f32x4 acc[3][4]; g3_zero<3>(acc);
        g3_kloop<192>(acc, g, DM, lds);
        uint2 hres[3][4];
#pragma unroll
        for (int m = 0; m < 3; ++m)
#pragma unroll
            for (int n = 0; n < 4; ++n) hres[m][n] = *(const uint2*)(h + (size_t)(row0 + wr * 48 + m * 16 + fr) * 1024 + col0 + wc * 64 + n * 16 + fq * 4);
#pragma unroll
        for (int m = 0; m < 3; ++m) {
            const int row = row0 + wr * 48 + m * 16 + fr;
#pragma unroll
            for (int n = 0; n < 4; ++n) {
                const int col = col0 + wc * 64 + n * 16 + fq * 4;
                const uint2 hv = hres[m][n];
                float4 o;
                o.x = __uint_as_float(hv.x << 16) + acc[m][n][0]; o.y = __uint_as_float(hv.x & 0xFFFF0000u) + acc[m][n][1];
                o.z = __uint_as_float(hv.y << 16) + acc[m][n][2]; o.w = __uint_as_float(hv.y & 0xFFFF0000u) + acc[m][n][3];
                *(float4*)(hm + (size_t)row * 1024 + col) = o;
            }
        }
    }
}

__device__ __constant__ int c_pair_lo[6] = {0, 0, 0, 1, 1, 2};
__device__ __constant__ int c_pair_hi[6] = {1, 2, 3, 2, 3, 3};
__device__ void phase_route(const Params& p, int l, unsigned char* lds) {
    const int tid = otid(), lane = tid & 63, wid = tid >> 6;
    const int per = (NT + (int)gridDim.x - 1) / (int)gridDim.x;
    const int nbeg = obid() * per, nend = (nbeg + per < NT) ? nbeg + per : NT;
    int* s_cls = (int*)lds;
    int* s_base = s_cls + 512;
    float* s_wr = (float*)(lds + 4096);
    const float* hm = (const float*)(WS(p) + OFF_HM32);
    bf16_t* hn = (bf16_t*)(WS(p) + OFF_HN);
    const float* nf = p.in[33] + (size_t)l * 1024;
    const float* wg = p.in[34] + (size_t)l * 1024 * 4;
    const float* bg = p.in[35] + l * 4;
    const float* we = p.in[36] + (size_t)l * 1024 * 16;
    const float* be = p.in[37] + l * 16;
    int* cnt = (int*)(WS(p) + OFF_CTL);
    int* list = (int*)(WS(p) + OFF_LIST);
    float* pw = (float*)(WS(p) + OFF_PW);
    for (int e = tid; e < 1024 * 20; e += NTHR) {
        const int k = e / 20, c = e - k * 20;
        s_wr[c * 1024 + k] = (c < 4) ? wg[(size_t)k * 4 + c] : we[(size_t)k * 16 + (c - 4)];
    }
    __syncthreads();
    float4 nv[4], cur[4];
#pragma unroll
    for (int i = 0; i < 4; ++i) nv[i] = *(const float4*)(nf + i * 256 + lane * 4);
    if (nbeg + wid < nend) {
#pragma unroll
        for (int i = 0; i < 4; ++i) cur[i] = *(const float4*)(hm + (size_t)(nbeg + wid) * DM + i * 256 + lane * 4);
    }
    for (int n = nbeg + wid; n < nend; n += 8) {
        float4 xv[4]; float ss = 0.f;
#pragma unroll
        for (int i = 0; i < 4; ++i) { xv[i] = cur[i]; ss += xv[i].x * xv[i].x + xv[i].y * xv[i].y + xv[i].z * xv[i].z + xv[i].w * xv[i].w; }
        if (n + 8 < nend) {
#pragma unroll
            for (int i = 0; i < 4; ++i) cur[i] = *(const float4*)(hm + (size_t)(n + 8) * DM + i * 256 + lane * 4);
        }
        ss = wave_sum(ss);
        const float rs = rsqrtf(ss * (1.0f / 1024.0f) + 1e-6f);
        float lg[4] = {0.f, 0.f, 0.f, 0.f};
        float le[16];
#pragma unroll
        for (int e = 0; e < 16; ++e) le[e] = 0.f;
#pragma unroll
        for (int i = 0; i < 4; ++i) {
            float y[4] = {xv[i].x * rs * nv[i].x, xv[i].y * rs * nv[i].y, xv[i].z * rs * nv[i].z, xv[i].w * rs * nv[i].w};
            {
                const int d0 = i * 256 + lane * 4;
#pragma unroll
                for (int g = 0; g < 4; ++g) { const float4 w4 = *(const float4*)(s_wr + g * 1024 + d0); lg[g] += y[0] * w4.x + y[1] * w4.y + y[2] * w4.z + y[3] * w4.w; }
#pragma unroll
                for (int e = 0; e < 16; ++e) { const float4 w4 = *(const float4*)(s_wr + (4 + e) * 1024 + d0); le[e] += y[0] * w4.x + y[1] * w4.y + y[2] * w4.z + y[3] * w4.w; }
            }
            *(uint2*)(hn + (size_t)n * DM + i * 256 + lane * 4) = pack4(y[0], y[1], y[2], y[3]);
        }
#pragma unroll
        for (int g = 0; g < 4; ++g) lg[g] = wave_sum_fast(lg[g]) + bg[g];
#pragma unroll
        for (int e = 0; e < 16; ++e) le[e] = wave_sum_fast(le[e]) + be[e];
        if (lane == 0) {
            int gs = 0; float gm = lg[0];
#pragma unroll
            for (int g = 1; g < 4; ++g) if (lg[g] > gm) { gm = lg[g]; gs = g; }
            float den = 0.f;
#pragma unroll
            for (int g = 0; g < 4; ++g) den += __expf(lg[g] - gm);
            const float pgrp = 1.0f / den;
            float v4[4];
#pragma unroll
            for (int e = 0; e < 4; ++e) {
                const float m0 = (gs == 0) ? 1.f : 0.f, m1s = (gs == 1) ? 1.f : 0.f, m2s = (gs == 2) ? 1.f : 0.f, m3s = (gs == 3) ? 1.f : 0.f;
                v4[e] = le[e] * m0 + le[4 + e] * m1s + le[8 + e] * m2s + le[12 + e] * m3s;
            }
            int i1 = 0; float m1 = v4[0];
#pragma unroll
            for (int e = 1; e < 4; ++e) if (v4[e] > m1) { m1 = v4[e]; i1 = e; }
            int i2 = -1; float m2 = -INFINITY;
#pragma unroll
            for (int e = 0; e < 4; ++e) if (e != i1 && v4[e] > m2) { m2 = v4[e]; i2 = e; }
            const float e2 = __expf(m2 - m1);
            const float p1 = pgrp / (1.0f + e2), p2 = pgrp * e2 / (1.0f + e2);
            const int lo = i1 < i2 ? i1 : i2, hi = i1 < i2 ? i2 : i1;
            const float plo = i1 < i2 ? p1 : p2, phi = i1 < i2 ? p2 : p1;
            const int pi = (lo == 0) ? (hi - 1) : (lo == 1 ? hi + 1 : 5);
            const int cls = gs * 6 + pi;
            s_cls[n - nbeg] = cls;
            pw[(size_t)n * 2 + 0] = plo; pw[(size_t)n * 2 + 1] = phi;
        }
    }
    __syncthreads();
    const int nloc = nend - nbeg;
    if (tid < 24) {
        int c_ = 0;
        for (int i = 0; i < nloc; ++i) c_ += (s_cls[i] == tid) ? 1 : 0;
        s_base[tid] = c_ ? atomicAdd(&cnt[tid * 32], c_) : 0;
    }
    __syncthreads();
    for (int it = tid; it < nloc; it += NTHR) {
        const int cls = s_cls[it];
        int rank = 0;
        for (int i = 0; i < it; ++i) rank += (s_cls[i] == cls) ? 1 : 0;
        list[(size_t)cls * NT + s_base[cls] + rank] = nbeg + it;
    }
    __syncthreads();
}


struct MoeTile { int cls, ti, cnt, tg; };
__device__ __forceinline__ int moe_total_tiles(const int* cnt) { int s = 0; for (int c = 0; c < 24; ++c) s += (cnt[c * 32] + 127) >> 7; return s; }
__device__ __forceinline__ MoeTile moe_find(const int* cnt, int tile) {
    MoeTile r; int s = 0; r.cls = 0; r.ti = 0; r.cnt = 0; r.tg = tile;
    for (int c = 0; c < 24; ++c) { const int nt = (cnt[c * 32] + 127) >> 7; if (tile >= s && tile < s + nt) { r.cls = c; r.ti = tile - s; r.cnt = cnt[c * 32]; } s += nt; }
    return r;
}
__device__ void phase_moe1(const Params& p, unsigned char* lds) {
    const int tid = otid(), lane = tid & 63, wid = tid >> 6, wr = wid >> 1, wc = wid & 1, fr = lane & 15, fq = lane >> 4;
    const int* cnt = (const int*)(WS(p) + OFF_CTL);
    const int* list = (const int*)(WS(p) + OFF_LIST);
    const float* pw = (const float*)(WS(p) + OFF_PW);
    const bf16_t* hn = (const bf16_t*)(WS(p) + OFF_HN);
    const bf16_t* we = (const bf16_t*)(WS(p) + OFF_WEXP);
    bf16_t* hid = (bf16_t*)(OUTB(p) + DO_HID);
    const int total = moe_total_tiles(cnt);
    for (int item = obid(); item < total * 4; item += gridDim.x) {
        const MoeTile mt = moe_find(cnt, item >> 2);
        const int nt = item & 3, slot = nt >> 1, f0 = (nt & 1) * 128;
        const int g_ = mt.cls / 6, pi = mt.cls % 6;
        const int e = g_ * 4 + (slot == 0 ? c_pair_lo[pi] : c_pair_hi[pi]);
        const int* lst = list + (size_t)mt.cls * NT + mt.ti * 128;
        const int nvalid = min(128, mt.cnt - mt.ti * 128);
        f32x4 a1[2][4], a3[2][4]; g3_zero<2>(a1); g3_zero<2>(a3);
        G3D g;
#pragma unroll
        for (int i = 0; i < 2; ++i) {
            const int idx = tid + i * NTHR, row = idx >> 3, sl = (idx & 7) ^ (row & 7);
            g.ap[i] = hn + (size_t)lst[row < nvalid ? row : 0] * DM + sl * 8;
            g.b1[i] = we + WE_W1 + ((size_t)e * 256 + f0 + row) * 1024 + sl * 8;
            g.b3[i] = we + WE_W3 + ((size_t)e * 256 + f0 + row) * 1024 + sl * 8;
        }
        g3d_kloop(a1, a3, g, DM, lds);
        float pev[2];
#pragma unroll
        for (int m = 0; m < 2; ++m) { const int lr = wr * 32 + m * 16 + fr; pev[m] = pw[(size_t)lst[lr < nvalid ? lr : 0] * 2 + slot]; }
#pragma unroll
        for (int m = 0; m < 2; ++m) {
            const int lr = wr * 32 + m * 16 + fr;
            const float pe = pev[m];
#pragma unroll
            for (int n = 0; n < 4; ++n) {
                const int col = slot * 256 + f0 + wc * 64 + n * 16 + fq * 4;
                float o[4];
#pragma unroll
                for (int j = 0; j < 4; ++j) { const float x1 = a1[m][n][j]; o[j] = x1 * sigmoidf_(x1) * a3[m][n][j] * pe; }
                *(uint2*)(hid + ((size_t)mt.tg * 128 + lr) * 512 + col) = pack4(o[0], o[1], o[2], o[3]);
            }
        }
    }
}
__device__ void phase_moe2(const Params& p, int l, unsigned char* lds) {
    const int tid = otid(), lane = tid & 63, wid = tid >> 6, wr = wid >> 1, wc = wid & 1, fr = lane & 15, fq = lane >> 4;
    const int* cnt = (const int*)(WS(p) + OFF_CTL);
    const int* list = (const int*)(WS(p) + OFF_LIST);
    const bf16_t* we = (const bf16_t*)(WS(p) + OFF_WEXP);
    const bf16_t* hid = (const bf16_t*)(OUTB(p) + DO_HID);
    float* hm = (float*)(WS(p) + OFF_HM32);
    bf16_t* h = (bf16_t*)(WS(p) + OFF_H);
    const int total = moe_total_tiles(cnt);
    for (int item = obid(); item < total * 8; item += gridDim.x) {
        const MoeTile mt = moe_find(cnt, item >> 3);
        const int nt = item & 7, col0 = nt * 128;
        const int g_ = mt.cls / 6, pi = mt.cls % 6;
        const int elo = g_ * 4 + c_pair_lo[pi], ehi = g_ * 4 + c_pair_hi[pi];
        const int* lst = list + (size_t)mt.cls * NT + mt.ti * 128;
        const int nvalid = min(128, mt.cnt - mt.ti * 128);
        f32x4 acc[2][4]; g3_zero<2>(acc);
        G3<128> g;
        g3_setup<128>(g, [&](int r) { return hid + ((size_t)mt.tg * 128 + r) * 512; }, [&](int r) { return we + WE_W2 + ((size_t)elo * 1024 + col0 + r) * 256; }, tid);
        g3_kloop<128>(acc, g, 256, lds);
        g3_setup<128>(g, [&](int r) { return hid + ((size_t)mt.tg * 128 + r) * 512 + 256; }, [&](int r) { return we + WE_W2 + ((size_t)ehi * 1024 + col0 + r) * 256; }, tid);
        g3_kloop<128>(acc, g, 256, lds);
        int tkv[2]; float4 hv[2][4];
#pragma unroll
        for (int m = 0; m < 2; ++m) {
            const int lr = wr * 32 + m * 16 + fr;
            tkv[m] = lst[lr < nvalid ? lr : 0];
#pragma unroll
            for (int n = 0; n < 4; ++n) hv[m][n] = *(const float4*)(hm + (size_t)tkv[m] * 1024 + col0 + wc * 64 + n * 16 + fq * 4);
        }
#pragma unroll
        for (int m = 0; m < 2; ++m) {
            const int lr = wr * 32 + m * 16 + fr;
            if (lr < nvalid) {
                const int tk = tkv[m];
#pragma unroll
                for (int n = 0; n < 4; ++n) {
                    const int col = col0 + wc * 64 + n * 16 + fq * 4;
                    float4 v = hv[m][n];
                    v.x += acc[m][n][0]; v.y += acc[m][n][1]; v.z += acc[m][n][2]; v.w += acc[m][n][3];
                    if (l == 0) *(uint2*)(h + (size_t)tk * 1024 + col) = pack4(v.x, v.y, v.z, v.w);
                    else *(float4*)(hm + (size_t)tk * 1024 + col) = v;
                }
            }
        }
    }
}

__device__ void phase_final(const Params& p) {
    const int lane = otid() & 63;
    const int wave = (obid() * NTHR + otid()) >> 6, nw = gridDim.x * NTHR / 64;
    const float* hm = (const float*)(WS(p) + OFF_HM32);
    const float* nf = p.in[41];
    float4 g[4], cur[4];
#pragma unroll
    for (int i = 0; i < 4; ++i) g[i] = *(const float4*)(nf + i * 256 + lane * 4);
    auto rowp = [&](int r) { const int b = r / SEQ, s_ = r % SEQ; return hm + ((size_t)b * TS + NMETA + s_) * DM; };
    if (wave < NB * SEQ) {
        const float* src = rowp(wave);
#pragma unroll
        for (int i = 0; i < 4; ++i) cur[i] = *(const float4*)(src + i * 256 + lane * 4);
    }
    for (int r = wave; r < NB * SEQ; r += nw) {
        float4 v[4]; float ss = 0.f;
#pragma unroll
        for (int i = 0; i < 4; ++i) { v[i] = cur[i]; ss += v[i].x * v[i].x + v[i].y * v[i].y + v[i].z * v[i].z + v[i].w * v[i].w; }
        if (r + nw < NB * SEQ) {
            const float* src = rowp(r + nw);
#pragma unroll
            for (int i = 0; i < 4; ++i) cur[i] = *(const float4*)(src + i * 256 + lane * 4);
        }
        ss = wave_sum(ss);
        const float rs = rsqrtf(ss * (1.0f / 1024.0f) + 1e-6f);
#pragma unroll
        for (int i = 0; i < 4; ++i) {
            float4 o; o.x = v[i].x * rs * g[i].x; o.y = v[i].y * rs * g[i].y; o.z = v[i].z * rs * g[i].z; o.w = v[i].w * rs * g[i].w;
            *(float4*)((float*)OUTB(p) + (size_t)r * DM + i * 256 + lane * 4) = o;
        }
    }
}


#define XB_TMO      128
#define XB_XCNT(j)  (256  + 64 * (j))
#define XB_XSUB(j)  (1280 + 64 * (j))
#define XB_XGEN(j)  (2304 + 64 * (j))
#define XB_TOP      3328
#define XB_TOPGEN   3392
#define XCD_BAR_WORDS 3456
#define XB_SPIN_CAP (1u << 22)
#define LAS __attribute__((address_space(3)))
__device__ __forceinline__ unsigned xb_ld(unsigned* p) { return __hip_atomic_load(p, __ATOMIC_RELAXED, __HIP_MEMORY_SCOPE_AGENT); }
__device__ __forceinline__ unsigned xb_add(unsigned* p, unsigned v) { return __hip_atomic_fetch_add(p, v, __ATOMIC_RELAXED, __HIP_MEMORY_SCOPE_AGENT); }
__device__ __forceinline__ unsigned xb_xcc_id() { return (unsigned)__builtin_amdgcn_s_getreg((3 << 11) | 20) & 0xFu; }
#define XB_SPIN(cond, bar) do { unsigned _sp = 0; while (cond) { __builtin_amdgcn_s_sleep(1); \
    if ((++_sp & 255u) == 0u) { if (xb_ld(&(bar)[XB_TMO])) break; if (_sp > XB_SPIN_CAP) { atomicAdd(&(bar)[XB_TMO], 1u); break; } } } } while (0)
struct XcdBarrier { unsigned* bar; unsigned x; volatile LAS unsigned* st; };
__device__ __forceinline__ XcdBarrier xcd_barrier_post(unsigned* bar, volatile LAS unsigned* st) {
    XcdBarrier b; b.bar = bar; b.x = xb_xcc_id(); b.st = st;
    if (threadIdx.x == 0) (void)xb_add(&bar[XB_XCNT(b.x)], 1u);
    return b;
}
__device__ __forceinline__ void xcd_barrier_complete(unsigned* bar, unsigned x, unsigned& nloc, unsigned& nx) {
    const unsigned G = gridDim.x * gridDim.y * gridDim.z;
    unsigned sum, cnt, mine, sp = 0u;
    for (;;) {
        sum = 0u; cnt = 0u; mine = 0u;
#pragma unroll
        for (unsigned j = 0; j < 16; ++j) { const unsigned c = xb_ld(&bar[XB_XCNT(j)]); sum += c; cnt += (c > 0u) ? 1u : 0u; mine = (j == x) ? c : mine; }
        if (sum == G) break;
        __builtin_amdgcn_s_sleep(1);
        if ((++sp & 255u) == 0u) { if (xb_ld(&bar[XB_TMO])) break; if (sp > XB_SPIN_CAP) { atomicAdd(&bar[XB_TMO], 1u); break; } }
    }
    nloc = mine > 0u ? mine : 1u; nx = cnt > 0u ? cnt : 1u;
}
__device__ __forceinline__ void xcd_barrier(const XcdBarrier& b) {
    asm volatile("s_waitcnt vmcnt(0)" ::: "memory");
    __syncthreads();
    if (threadIdx.x == 0) {
        unsigned* bar = b.bar;
        __builtin_amdgcn_s_waitcnt(0);
        unsigned nloc = b.st[0], nx = b.st[1];
        if (nloc == 0u) { xcd_barrier_complete(bar, b.x, nloc, nx); b.st[0] = nloc; b.st[1] = nx; }
        const unsigned old = xb_add(&bar[XB_XSUB(b.x)], 1u);
        const unsigned gen = old / nloc;
        if (old + 1u == (gen + 1u) * nloc) {
            __builtin_amdgcn_fence(__ATOMIC_RELEASE, "agent");
            asm volatile("s_waitcnt vmcnt(0)" ::: "memory");
            const unsigned og = xb_add(&bar[XB_TOP], 1u);
            const unsigned tg = og / nx;
            if (og + 1u == (tg + 1u) * nx) xb_add(&bar[XB_TOPGEN], 1u);
            else XB_SPIN(xb_ld(&bar[XB_TOPGEN]) == tg, bar);
            __builtin_amdgcn_fence(__ATOMIC_ACQUIRE, "agent");
            xb_add(&bar[XB_XGEN(b.x)], 1u);
            asm volatile("s_waitcnt vmcnt(0)" ::: "memory");
        } else {
            XB_SPIN(xb_ld(&bar[XB_XGEN(b.x)]) == gen, bar);
            __builtin_amdgcn_fence(__ATOMIC_ACQUIRE, "agent");
            asm volatile("s_waitcnt vmcnt(0)" ::: "memory");
        }
    }
    __syncthreads();
}

__global__ void __launch_bounds__(NTHR) fwd_megakernel(Params p) {
    extern __shared__ __attribute__((aligned(16))) unsigned char lds[];
    cg::grid_group grid = cg::this_grid();
    volatile LAS unsigned* xst = (volatile LAS unsigned*)(lds + LDS_BYTES - 32);
    if (threadIdx.x < 2) xst[threadIdx.x] = 0u;
    __syncthreads();
    const XcdBarrier xb = xcd_barrier_post((unsigned*)(p.ws + OFF_BAR), xst);
    if (p.out == nullptr) grid.sync();
#pragma unroll 1
    for (int step = 0; step < 18; ++step) {
        const int l = step >= 9 ? 1 : 0;
        const int ph = step - l * 9;
        switch (ph) {
        case 0:
            if (l == 0) phase_embed(p); else phase_rowstat(p);
            phase_convert<false>(p, l, lds);
            if (obid() == 0 && otid() < 24) ((int*)(WS(p) + OFF_CTL))[otid() * 32] = 0;
            if (obid() == 0 && otid() == 32) ((int*)(WS(p) + OFF_CTL))[800 + l * 32] = 0;
            break;
        case 1: phase_inproj(p, lds); break;
        case 2: phase_dsa_prep(p, l); phase_lr_prep(p, l); break;
        case 3: {
            if (obid() < NB * 16) phase_scan5(p, l, lds, obid());
            int* qctr = (int*)(WS(p) + OFF_CTL) + 800 + l * 32;
            int* qslot = (int*)(lds + LDS_BYTES - 16);
            for (;;) {
                __syncthreads();
                if (otid() == 0) *qslot = atomicAdd(qctr, 1);
                __syncthreads();
                const int item = *qslot;
                if (item >= 516 + NT / 32 + 3072) break;
                if (item < 516) phase_pool(p, l, lds, item, item + 1, 1);
                else if (item < 516 + NT / 32) phase_dsa<false>(p, l, lds, (bf16_t*)(OUTB(p) + DO_YC), nullptr, nullptr, item - 516, item - 515, 1);
                else {
                    const int ct = item - (516 + NT / 32);
                    const ConvJob cj = get_job_late(p, l, ct >> 10);
                    conv_tile(cj, ct & 1023, (float*)lds);
                }
            }
        } break;
        case 4: phase_merge(p, lds); break;
        case 5: phase_outproj(p, lds); break;
        case 6: phase_route(p, l, lds); break;
        case 7: phase_moe1(p, lds); break;
        default: phase_moe2(p, l, lds); break;
        }
        xcd_barrier(xb);
    }
    phase_final(p);
}

extern "C" void kernel_launch(void* const* d_in, const int* in_sizes, int n_in,
                              void* d_out, int out_size, void* d_ws, size_t ws_size,
                              hipStream_t stream) {
    static int grid_blocks = 0;
    if (grid_blocks == 0) {
        int dev = 0, cus = 0, per_cu = 0;
        (void)hipGetDevice(&dev);
        (void)hipDeviceGetAttribute(&cus, hipDeviceAttributeMultiprocessorCount, dev);
        (void)hipFuncSetAttribute((const void*)fwd_megakernel, hipFuncAttributeMaxDynamicSharedMemorySize, LDS_BYTES);
        (void)hipOccupancyMaxActiveBlocksPerMultiprocessor(&per_cu, fwd_megakernel, NTHR, LDS_BYTES);
        if (per_cu < 1 || cus < NB * 16 || (cus & 7) != 0 || n_in != 42 || ws_size < WS_END + (size_t)QS_WS * QS_BYTES || cus > QS_WS + QS_DO) { fprintf(stderr, "kernel_launch: bad config per_cu=%d n_in=%d ws=%zu need=%zu\n", per_cu, n_in, ws_size, (size_t)WS_END); grid_blocks = -1; }
        else grid_blocks = cus;
    }
    if (grid_blocks < 0) return;
    Params p{};
    for (int i = 0; i < 42; ++i) p.in[i] = (const float*)d_in[i];
    p.out = (float*)d_out;
    p.ws = (unsigned char*)d_ws;
    (void)hipMemsetAsync((unsigned char*)d_ws + OFF_BAR, 0, XCD_BAR_WORDS * 4, stream);
    void* args[] = {&p};
    hipError_t e = hipLaunchCooperativeKernel((void*)fwd_megakernel, dim3(grid_blocks), dim3(NTHR), args, LDS_BYTES, stream);
    if (e != hipSuccess) fprintf(stderr, "cooperative launch failed: %s (grid %d)\n", hipGetErrorString(e), grid_blocks);
}
```

```cpp
#include <hip/hip_runtime.h>
#include <hip/hip_cooperative_groups.h>
#include <cstdio>
#include <cstdint>
#include <type_traits>
namespace cg = cooperative_groups;

typedef unsigned short bf16_t;
typedef short bf16x8 __attribute__((ext_vector_type(8)));
typedef float f32x4 __attribute__((ext_vector_type(4)));

constexpr int NB = 8, SEQ = 2048, NMETA = 16, TS = 2064, DM = 1024;
constexpr int NT = NB * TS;
constexpr int NTP = 16640;
constexpr int NTHR = 512;
constexpr int CIN = 7912;
constexpr int NP1 = 4864;
constexpr int PM_LD = 768;
constexpr int PM_WD = 0, PM_AD = 64, PM_GD = 128, PM_VD = 256, PM_CQ = 288, PM_CKV = 544, PM_KROPE = 672, PM_KIDX = 704;
constexpr int LDS_BYTES = 157 * 1024;

constexpr size_t AL(size_t x) { return (x + 255) & ~(size_t)255; }
constexpr size_t SZ_ACT = (size_t)NTP * 1024 * 2;
constexpr size_t OFF_CTL = 0;
constexpr size_t OFF_BAR = 4096;
constexpr size_t OFF_RSTD = OFF_BAR + 16384;
constexpr size_t OFF_ROPE = OFF_RSTD + AL((size_t)NTP * 4);
constexpr size_t OFF_H = OFF_ROPE + AL((size_t)TS * 16 * 4 * 2);
constexpr size_t OFF_WB = OFF_H + SZ_ACT;
constexpr size_t WB_WIN = 0;
constexpr size_t WB_WG = WB_WIN + (size_t)NP1 * 1024;
constexpr size_t WB_PA = WB_WG + (size_t)3072 * 1024;
constexpr size_t WB_WO = WB_PA + (size_t)3 * 1024 * 1024;
constexpr size_t WB_POOL = WB_WO + (size_t)1024 * 1024;
constexpr size_t WB_QI = WB_POOL + (size_t)4 * 256 * 256;
constexpr size_t WB_UQ = WB_QI + (size_t)512 * 256;
constexpr size_t WB_UK = WB_UQ + (size_t)1536 * 256;
constexpr size_t WB_UV = WB_UK + (size_t)16 * 128 * 64;
constexpr size_t WB_WIDX = WB_UV + (size_t)16 * 64 * 128;
constexpr size_t WB_END = WB_WIDX + (size_t)64 * 1024;
constexpr size_t OFF_PPOOL = OFF_WB + AL(WB_END * 2);
constexpr size_t OFF_PK = OFF_PPOOL + SZ_ACT;
constexpr size_t OFF_PR = OFF_PK + SZ_ACT;
constexpr size_t OFF_PV = OFF_PR + SZ_ACT;
constexpr size_t OFF_PMISC = OFF_PV + SZ_ACT;
constexpr size_t OFF_VFIRST = OFF_PMISC + AL((size_t)NTP * PM_LD * 2);
constexpr size_t OFF_HALO = OFF_VFIRST + SZ_ACT;
constexpr size_t OFF_LIST = OFF_HALO + AL((size_t)130 * 16 * 1024 * 2);
constexpr size_t OFF_PW = OFF_LIST + AL((size_t)24 * NT * 4);
constexpr size_t WS_END = OFF_PW + AL((size_t)NT * 2 * 4);
constexpr size_t OFF_MERGED = OFF_PK;
constexpr size_t OFF_HM32 = OFF_PR;
constexpr size_t OFF_HN = OFF_PPOOL;
constexpr size_t OFF_WEXP = OFF_PMISC;
constexpr size_t WE_W1 = 0, WE_W3 = (size_t)16 * 256 * 1024, WE_W2 = (size_t)2 * 16 * 256 * 1024;
static_assert((size_t)3 * 16 * 256 * 1024 * 2 <= (size_t)NTP * PM_LD * 2, "expert weights must fit in Pmisc");
constexpr size_t DO_YC = 0;
constexpr size_t DO_CQN = DO_YC + SZ_ACT;
constexpr size_t DO_KV = DO_CQN + AL((size_t)NT * 256 * 2);
constexpr size_t DO_KIDX = DO_KV + AL((size_t)NT * 160 * 2);
constexpr size_t DO_WHEAD = DO_KIDX + AL((size_t)NT * 64 * 2);
constexpr size_t DO_ALR = DO_WHEAD + AL((size_t)NT * 8 * 4);
constexpr size_t DO_END = DO_ALR + AL((size_t)NT * 288 * 2);
constexpr size_t QS_BYTES = (size_t)16 * 16 * 160 * 2;
constexpr int QS_WS = (int)((277240096ull - WS_END) / QS_BYTES), QS_DO = (int)(((size_t)NB * SEQ * DM * 4 - DO_END) / QS_BYTES);
static_assert(QS_WS + QS_DO >= 256, "Q scratch");
constexpr size_t DO_HID = DO_YC;
static_assert(DO_END <= (size_t)NB * SEQ * DM * 4, "d_out scratch overflow");
static_assert((size_t)(129 + 24) * 128 * 512 * 2 <= SZ_ACT, "hid fits");
static_assert(WS_END <= 277240096ull, "workspace overflow");

struct Params {
    const float* in[42];
    float* out;
    unsigned char* ws;
};

__device__ __forceinline__ int otid() { int t = threadIdx.x; asm volatile("" : "+v"(t)); return t; }
__device__ __forceinline__ int obid() { int b = blockIdx.x; asm volatile("" : "+s"(b)); return b; }
typedef __attribute__((address_space(1))) unsigned char gas_uchar;
__device__ __forceinline__ unsigned char* WS(const Params& p) { gas_uchar* w = (gas_uchar*)p.ws; asm volatile("" : "+s"(w)); return (unsigned char*)w; }
__device__ __forceinline__ unsigned char* OUTB(const Params& p) { gas_uchar* w = (gas_uchar*)p.out; asm volatile("" : "+s"(w)); return (unsigned char*)w; }
__device__ __forceinline__ float bf2f(bf16_t v) { return __uint_as_float(((unsigned)v) << 16); }
typedef float f32x2v __attribute__((ext_vector_type(2)));
typedef __bf16 bf16x2v __attribute__((ext_vector_type(2)));
__device__ __forceinline__ unsigned pk2(float a, float b) { const f32x2v v = {a, b}; const bf16x2v r = __builtin_convertvector(v, bf16x2v); unsigned u; __builtin_memcpy(&u, &r, 4); return u; }
__device__ __forceinline__ bf16_t f2bf(float f) { const __bf16 h = (__bf16)f; bf16_t u; __builtin_memcpy(&u, &h, 2); return u; }
__device__ __forceinline__ float wave_sum(float v) {
#pragma unroll
    for (int o = 32; o > 0; o >>= 1) v += __shfl_xor(v, o);
    return v;
}
template <int CTRL> __device__ __forceinline__ float dpp_f(float x) {
    return __int_as_float(__builtin_amdgcn_update_dpp(0, __float_as_int(x), CTRL, 0xF, 0xF, true));
}
__device__ __forceinline__ float row16_sum(float v) {
    v += dpp_f<0xB1>(v);
    v += dpp_f<0x4E>(v);
    v += dpp_f<0x141>(v);
    v += dpp_f<0x140>(v);
    return v;
}
__device__ __forceinline__ void lds_barrier() { asm volatile("s_waitcnt lgkmcnt(0)" ::: "memory"); __builtin_amdgcn_s_barrier(); asm volatile("" ::: "memory"); }
__device__ __forceinline__ float fast_rcp(float x) { return __builtin_amdgcn_rcpf(x); }
__device__ __forceinline__ float fast_sigmoid(float x) { return fast_rcp(1.0f + __expf(-x)); }
__device__ __forceinline__ float fast_tanh(float x) { return 1.0f - 2.0f * fast_rcp(1.0f + __expf(2.0f * x)); }
__device__ __forceinline__ void row16_sum4(float& a, float& b, float& c, float& d) {
    asm volatile(
        "s_nop 1\n\t"
        "v_add_f32_dpp %0, %0, %0 quad_perm:[1,0,3,2] row_mask:0xf bank_mask:0xf\n\t"
        "v_add_f32_dpp %1, %1, %1 quad_perm:[1,0,3,2] row_mask:0xf bank_mask:0xf\n\t"
        "v_add_f32_dpp %2, %2, %2 quad_perm:[1,0,3,2] row_mask:0xf bank_mask:0xf\n\t"
        "v_add_f32_dpp %3, %3, %3 quad_perm:[1,0,3,2] row_mask:0xf bank_mask:0xf\n\t"
        "v_add_f32_dpp %0, %0, %0 quad_perm:[2,3,0,1] row_mask:0xf bank_mask:0xf\n\t"
        "v_add_f32_dpp %1, %1, %1 quad_perm:[2,3,0,1] row_mask:0xf bank_mask:0xf\n\t"
        "v_add_f32_dpp %2, %2, %2 quad_perm:[2,3,0,1] row_mask:0xf bank_mask:0xf\n\t"
        "v_add_f32_dpp %3, %3, %3 quad_perm:[2,3,0,1] row_mask:0xf bank_mask:0xf\n\t"
        "v_add_f32_dpp %0, %0, %0 row_half_mirror row_mask:0xf bank_mask:0xf\n\t"
        "v_add_f32_dpp %1, %1, %1 row_half_mirror row_mask:0xf bank_mask:0xf\n\t"
        "v_add_f32_dpp %2, %2, %2 row_half_mirror row_mask:0xf bank_mask:0xf\n\t"
        "v_add_f32_dpp %3, %3, %3 row_half_mirror row_mask:0xf bank_mask:0xf\n\t"
        "v_add_f32_dpp %0, %0, %0 row_mirror row_mask:0xf bank_mask:0xf\n\t"
        "v_add_f32_dpp %1, %1, %1 row_mirror row_mask:0xf bank_mask:0xf\n\t"
        "v_add_f32_dpp %2, %2, %2 row_mirror row_mask:0xf bank_mask:0xf\n\t"
        "v_add_f32_dpp %3, %3, %3 row_mirror row_mask:0xf bank_mask:0xf\n\t"
        "s_nop 1"
        : "+v"(a), "+v"(b), "+v"(c), "+v"(d));
}
__device__ __forceinline__ void row8_sum2(float& a, float& b) {
    asm volatile(
        "s_nop 1\n\t"
        "v_add_f32_dpp %0, %0, %0 quad_perm:[1,0,3,2] row_mask:0xf bank_mask:0xf\n\t"
        "v_add_f32_dpp %1, %1, %1 quad_perm:[1,0,3,2] row_mask:0xf bank_mask:0xf\n\t"
        "s_nop 0\n\t"
        "v_add_f32_dpp %0, %0, %0 quad_perm:[2,3,0,1] row_mask:0xf bank_mask:0xf\n\t"
        "v_add_f32_dpp %1, %1, %1 quad_perm:[2,3,0,1] row_mask:0xf bank_mask:0xf\n\t"
        "s_nop 0\n\t"
        "v_add_f32_dpp %0, %0, %0 row_half_mirror row_mask:0xf bank_mask:0xf\n\t"
        "v_add_f32_dpp %1, %1, %1 row_half_mirror row_mask:0xf bank_mask:0xf\n\t"
        "s_nop 1"
        : "+v"(a), "+v"(b));
}
__device__ __forceinline__ float xrow_sum(float v) {
    const auto a = __builtin_amdgcn_permlane16_swap(__float_as_uint(v), __float_as_uint(v), false, false);
    v = __uint_as_float(a[0]) + __uint_as_float(a[1]);
    const auto b = __builtin_amdgcn_permlane32_swap(__float_as_uint(v), __float_as_uint(v), false, false);
    return __uint_as_float(b[0]) + __uint_as_float(b[1]);
}
__device__ __forceinline__ float wave_sum_fast(float v) { return xrow_sum(row16_sum(v)); }
__device__ __forceinline__ float sigmoidf_(float x) { return 1.0f / (1.0f + __expf(-x)); }
__device__ __forceinline__ float softplusf_(float z) { return fmaxf(z, 0.f) + log1pf(__expf(-fabsf(z))); }
__device__ __forceinline__ void glds16(const void* g, void* l) {
    __builtin_amdgcn_global_load_lds((const unsigned*)g, (unsigned*)l, 16, 0, 0);
}

__device__ void phase_embed(const Params& p) {
    const int lane = otid() & 63;
    const int wave = (obid() * NTHR + otid()) >> 6, nw = gridDim.x * NTHR / 64;
    bf16_t* h = (bf16_t*)(WS(p) + OFF_H);
    float* rstd = (float*)(WS(p) + OFF_RSTD);
    auto srcrow = [&](int n) { const int b = n / TS, t = n % TS; return t < NMETA ? p.in[1] + (size_t)t * DM : p.in[0] + ((size_t)b * SEQ + (t - NMETA)) * DM; };
    float4 cur[4];
    if (wave < NT) {
        const float* src = srcrow(wave);
#pragma unroll
        for (int i = 0; i < 4; ++i) cur[i] = *(const float4*)(src + i * 256 + lane * 4);
    }
    for (int n = wave; n < NTP; n += nw) {
        if (n < NT) {
            float4 v[4];
#pragma unroll
            for (int i = 0; i < 4; ++i) v[i] = cur[i];
            if (n + nw < NT) {
                const float* src = srcrow(n + nw);
#pragma unroll
                for (int i = 0; i < 4; ++i) cur[i] = *(const float4*)(src + i * 256 + lane * 4);
            }
            float ss = 0.f;
#pragma unroll
            for (int i = 0; i < 4; ++i) {
                ss += v[i].x * v[i].x + v[i].y * v[i].y + v[i].z * v[i].z + v[i].w * v[i].w;
                *(uint2*)(h + (size_t)n * DM + i * 256 + lane * 4) = make_uint2(pk2(v[i].x, v[i].y), pk2(v[i].z, v[i].w));
            }
            ss = wave_sum_fast(ss);
            if (lane == 0) rstd[n] = rsqrtf(ss * (1.0f / 1024.0f) + 1e-6f);
        } else {
#pragma unroll
            for (int i = 0; i < 4; ++i) *(ushort4*)(h + (size_t)n * DM + i * 256 + lane * 4) = make_ushort4(0, 0, 0, 0);
            if (lane == 0) rstd[n] = 0.f;
        }
    }
    float* ctab = (float*)(WS(p) + OFF_ROPE);
    float* stab = ctab + TS * 16;
    for (int idx = obid() * NTHR + otid(); idx < TS * 16; idx += gridDim.x * NTHR) {
        const int t = idx >> 4, i = idx & 15;
        const float inv = powf(10000.0f, -(float)(2 * i) / 32.0f);
        const float ang = (float)t * inv;
        ctab[idx] = cosf(ang);
        stab[idx] = sinf(ang);
    }
}

__device__ void phase_rowstat(const Params& p) {
    const int lane = otid() & 63;
    const int wave = (obid() * NTHR + otid()) >> 6, nw = gridDim.x * NTHR / 64;
    const bf16_t* hb = (const bf16_t*)(WS(p) + OFF_H);
    float* rstd = (float*)(WS(p) + OFF_RSTD);
    uint4 cur[2];
    if (wave < NT) { cur[0] = *(const uint4*)(hb + (size_t)wave * DM + lane * 8); cur[1] = *(const uint4*)(hb + (size_t)wave * DM + 512 + lane * 8); }
    for (int n = wave; n < NT; n += nw) {
        float ss = 0.f;
#pragma unroll
        for (int i = 0; i < 2; ++i) {
            const unsigned w_[4] = {cur[i].x, cur[i].y, cur[i].z, cur[i].w};
#pragma unroll
            for (int j = 0; j < 4; ++j) { const float a_ = __uint_as_float(w_[j] << 16), b_ = __uint_as_float(w_[j] & 0xFFFF0000u); ss += a_ * a_ + b_ * b_; }
        }
        if (n + nw < NT) { cur[0] = *(const uint4*)(hb + (size_t)(n + nw) * DM + lane * 8); cur[1] = *(const uint4*)(hb + (size_t)(n + nw) * DM + 512 + lane * 8); }
        ss = wave_sum_fast(ss);
        if (lane == 0) rstd[n] = rsqrtf(ss * (1.0f / 1024.0f) + 1e-6f);
    }
}

struct ConvJob { const float* src; bf16_t* dst; const float* scale; int ldsrc, K, nvalid, nrows, nb, notr; size_t sbs, dbs; const float* srcB; int ldB, split; };
__device__ __forceinline__ int conv_job_tiles(const ConvJob& j) { return j.nb * (j.nrows >> 6) * (j.K >> 6); }
__device__ void conv_tile(const ConvJob& j, int tile, float* lds) {
    const int per = (j.nrows >> 6) * (j.K >> 6);
    const int bi = tile / per, rem = tile % per;
    const int ktiles = j.K >> 6;
    const int n0 = (rem / ktiles) << 6, k0 = (rem % ktiles) << 6;
    const int tid = otid(), tn = tid & 63, tk = tid >> 6;
    const float* src = j.src + (size_t)bi * j.sbs;
    bf16_t* dst = j.dst + (size_t)bi * j.dbs;
#pragma unroll
    for (int kk = 0; kk < 8; ++kk) {
        const int k = k0 + tk * 8 + kk;
        float v = 0.f;
        if (n0 + tn < j.nvalid) {
            if (j.split) { const int nn = n0 + tn; v = (nn < j.split) ? (j.src ? j.src[(size_t)k * j.ldsrc + nn] : 0.f) : j.srcB[(size_t)k * j.ldB + (nn - j.split)]; }
            else v = j.notr ? src[(size_t)(n0 + tn) * j.ldsrc + k] : src[(size_t)k * j.ldsrc + n0 + tn];
            if (j.scale) v *= j.scale[k];
        }
        lds[tn * 65 + tk * 8 + kk] = v;
    }
    __syncthreads();
    const int wn = tid >> 3, kq = tid & 7;
    uint4 o;
    unsigned w[4];
#pragma unroll
    for (int q = 0; q < 4; ++q) {
        const float lo = lds[wn * 65 + kq * 8 + 2 * q], hi = lds[wn * 65 + kq * 8 + 2 * q + 1];
        w[q] = pk2(lo, hi);
    }
    o.x = w[0]; o.y = w[1]; o.z = w[2]; o.w = w[3];
    *(uint4*)(dst + (size_t)(n0 + wn) * j.K + k0 + kq * 8) = o;
    __syncthreads();
}
__device__ ConvJob get_job_early(const Params& p, int l, int ji) {
    bf16_t* wb = (bf16_t*)(WS(p) + OFF_WB);
    const float* win = p.in[3] + (size_t)l * DM * CIN;
    const float* nm = p.in[2] + (size_t)l * DM;
    ConvJob j{}; j.nb = 1; j.sbs = 0; j.dbs = 0; j.K = 1024; j.ldsrc = CIN; j.scale = nm;
    switch (ji) {
    case 0: j.src = win + 3072; j.dst = wb + WB_WIN; j.nvalid = 4352; j.nrows = 4352; break;
    case 1: j.src = (l == 0 ? nullptr : p.in[17]); j.ldsrc = 32; j.split = 32; j.srcB = win + 7424; j.ldB = CIN; j.dst = wb + WB_WIN + (size_t)(4096 + PM_VD) * 1024; j.nvalid = 512; j.nrows = 512; break;
    case 2: j.src = win + 7904; j.dst = wb + WB_WIDX; j.nvalid = 8; j.nrows = 64; break;
    case 3: j.src = win; j.dst = wb + WB_WG; j.nvalid = 3072; j.nrows = 3072; break;
    case 4: j.src = p.in[29] + (size_t)l * DM * DM; j.ldsrc = 1024; j.scale = nullptr; j.dst = wb + WB_PA; j.nvalid = 1024; j.nrows = 1024; break;
    case 5: j.src = p.in[30] + (size_t)l * DM * DM; j.ldsrc = 1024; j.scale = nullptr; j.dst = wb + WB_PA + (size_t)1024 * 1024; j.nvalid = 1024; j.nrows = 1024; break;
    case 6: j.src = p.in[31] + (size_t)l * DM * DM; j.ldsrc = 1024; j.scale = nullptr; j.dst = wb + WB_PA + (size_t)2 * 1024 * 1024; j.nvalid = 1024; j.nrows = 1024; break;
    case 7: j.src = p.in[32] + (size_t)l * DM * DM; j.ldsrc = 1024; j.scale = nullptr; j.dst = wb + WB_WO; j.nvalid = 1024; j.nrows = 1024; break;
    case 8: j.src = p.in[5] + (size_t)l * 4 * 256 * 256; j.ldsrc = 256; j.K = 256; j.scale = nullptr; j.dst = wb + WB_POOL; j.nvalid = 256; j.nrows = 256; j.nb = 4; j.sbs = 65536; j.dbs = 65536; break;
    case 9: j.src = p.in[26] + (size_t)l * 256 * 512; j.ldsrc = 512; j.K = 256; j.scale = nullptr; j.dst = wb + WB_QI; j.nvalid = 512; j.nrows = 512; break;
    case 10: j.src = p.in[23] + (size_t)l * 256 * 1536; j.ldsrc = 1536; j.K = 256; j.scale = nullptr; j.dst = wb + WB_UQ; j.nvalid = 1536; j.nrows = 1536; break;
    case 11: j.src = p.in[24] + (size_t)l * 16 * 128 * 64; j.ldsrc = 64; j.K = 64; j.scale = nullptr; j.dst = wb + WB_UK; j.nvalid = 2048; j.nrows = 2048; j.notr = 1; break;
    default: j.src = p.in[25] + (size_t)l * 16 * 128 * 64; j.ldsrc = 64; j.K = 128; j.scale = nullptr; j.dst = wb + WB_UV; j.nvalid = 64; j.nrows = 64; j.nb = 16; j.sbs = 8192; j.dbs = 8192; break;
    }
    return j;
}
__device__ ConvJob get_job_late(const Params& p, int l, int ji) {
    bf16_t* we = (bf16_t*)(WS(p) + OFF_WEXP);
    ConvJob j{}; j.nb = 16; j.scale = nullptr; j.sbs = 262144; j.dbs = 262144;
    switch (ji) {
    case 0: j.src = p.in[38] + (size_t)l * 16 * 262144; j.dst = we + WE_W1; j.ldsrc = 256; j.K = 1024; j.nvalid = 256; j.nrows = 256; break;
    case 1: j.src = p.in[39] + (size_t)l * 16 * 262144; j.dst = we + WE_W3; j.ldsrc = 256; j.K = 1024; j.nvalid = 256; j.nrows = 256; break;
    default: j.src = p.in[40] + (size_t)l * 16 * 262144; j.dst = we + WE_W2; j.ldsrc = 1024; j.K = 256; j.nvalid = 1024; j.nrows = 1024; break;
    }
    return j;
}
template <bool LATE>
__device__ void phase_convert(const Params& p, int l, unsigned char* lds) {
    const int njobs = LATE ? 3 : 13;
    int base = 0;
    for (int ji = 0; ji < njobs; ++ji) {
        const ConvJob j = LATE ? get_job_late(p, l, ji) : get_job_early(p, l, ji);
        const int nt = conv_job_tiles(j);
        int first = ((int)obid() - base) % (int)gridDim.x; if (first < 0) first += gridDim.x;
        for (int t = first; t < nt; t += gridDim.x) conv_tile(j, t, (float*)lds);
        base += nt;
    }
}

template <int BM> struct G3 {
    static constexpr int MI = BM / 64;
    static constexpr int NA = BM / 64;
    static constexpr int STAGE = BM * 128 + 128 * 128;
    const bf16_t* ap[NA];
    const bf16_t* bp[2];
};
template <int BM>
__device__ __forceinline__ void g3_issue(const G3<BM>& g, int kt, unsigned char* stage, int tid) {
#pragma unroll
    for (int i = 0; i < G3<BM>::NA; ++i) glds16(g.ap[i] + kt * 64, stage + (tid + i * NTHR) * 16);
#pragma unroll
    for (int i = 0; i < 2; ++i) glds16(g.bp[i] + kt * 64, stage + BM * 128 + (tid + i * NTHR) * 16);
}
template <int BM, class FA, class FB>
__device__ __forceinline__ void g3_setup(G3<BM>& g, FA rowptr, FB bcol, int tid) {
#pragma unroll
    for (int i = 0; i < G3<BM>::NA; ++i) { const int idx = tid + i * NTHR, row = idx >> 3, sl = (idx & 7) ^ (row & 7); g.ap[i] = rowptr(row) + sl * 8; }
#pragma unroll
    for (int i = 0; i < 2; ++i) { const int idx = tid + i * NTHR, row = idx >> 3, sl = (idx & 7) ^ (row & 7); g.bp[i] = bcol(row) + sl * 8; }
}
template <int BM>
__device__ __forceinline__ void g3_kloop(f32x4 (&acc)[BM / 64][4], const G3<BM>& g, int K, unsigned char* lds) {
    constexpr int MI = G3<BM>::MI, STAGE = G3<BM>::STAGE, NL = G3<BM>::NA + 2;
    const int tid = otid(), lane = tid & 63, wid = tid >> 6, wr = wid >> 1, wc = wid & 1, fr = lane & 15, fq = lane >> 4;
    const int nk = K >> 6;
    g3_issue<BM>(g, 0, lds, tid);
    if (nk > 1) g3_issue<BM>(g, 1, lds + STAGE, tid);
    int cur = 0;
#pragma unroll 1
    for (int t = 0; t < nk; ++t) {
        if (t + 1 < nk) { if (NL == 6) asm volatile("s_waitcnt vmcnt(6)" ::: "memory"); else if (NL == 5) asm volatile("s_waitcnt vmcnt(5)" ::: "memory"); else asm volatile("s_waitcnt vmcnt(4)" ::: "memory"); }
        else asm volatile("s_waitcnt vmcnt(0)" ::: "memory");
        __builtin_amdgcn_s_barrier();
        if (t + 2 < nk) { int nx = cur + 2; if (nx >= 3) nx -= 3; g3_issue<BM>(g, t + 2, lds + nx * STAGE, tid); }
        const unsigned char* cA = lds + cur * STAGE;
        const unsigned char* cB = cA + BM * 128;
#pragma unroll
        for (int ks = 0; ks < 2; ++ks) {
            bf16x8 a[MI], b[4];
#pragma unroll
            for (int m = 0; m < MI; ++m) { const int row = wr * (BM / 4) + m * 16 + fr; a[m] = *(const bf16x8*)(cA + row * 128 + (((ks * 4 + fq) ^ (row & 7)) << 4)); }
#pragma unroll
            for (int n = 0; n < 4; ++n) { const int row = wc * 64 + n * 16 + fr; b[n] = *(const bf16x8*)(cB + row * 128 + (((ks * 4 + fq) ^ (row & 7)) << 4)); }
#pragma unroll
            for (int m = 0; m < MI; ++m)
#pragma unroll
                for (int n = 0; n < 4; ++n) acc[m][n] = __builtin_amdgcn_mfma_f32_16x16x32_bf16(b[n], a[m], acc[m][n], 0, 0, 0);
        }
        cur = (cur == 2) ? 0 : cur + 1;
    }
    __builtin_amdgcn_s_barrier();
}
struct G3D { const bf16_t* ap[2]; const bf16_t* b1[2]; const bf16_t* b3[2]; };
__device__ __forceinline__ void g3d_issue(const G3D& g, int kt, unsigned char* stage, int tid) {
#pragma unroll
    for (int i = 0; i < 2; ++i) glds16(g.ap[i] + kt * 64, stage + (tid + i * NTHR) * 16);
#pragma unroll
    for (int i = 0; i < 2; ++i) glds16(g.b1[i] + kt * 64, stage + 16384 + (tid + i * NTHR) * 16);
#pragma unroll
    for (int i = 0; i < 2; ++i) glds16(g.b3[i] + kt * 64, stage + 32768 + (tid + i * NTHR) * 16);
}
__device__ __forceinline__ void g3d_kloop(f32x4 (&acc1)[2][4], f32x4 (&acc3)[2][4], const G3D& g, int K, unsigned char* lds) {
    constexpr int STAGE = 49152;
    const int tid = otid(), lane = tid & 63, wid = tid >> 6, wr = wid >> 1, wc = wid & 1, fr = lane & 15, fq = lane >> 4;
    const int nk = K >> 6;
    g3d_issue(g, 0, lds, tid);
    if (nk > 1) g3d_issue(g, 1, lds + STAGE, tid);
    int cur = 0;
#pragma unroll 1
    for (int t = 0; t < nk; ++t) {
        if (t + 1 < nk) asm volatile("s_waitcnt vmcnt(6)" ::: "memory"); else asm volatile("s_waitcnt vmcnt(0)" ::: "memory");
        __builtin_amdgcn_s_barrier();
        if (t + 2 < nk) { int nx = cur + 2; if (nx >= 3) nx -= 3; g3d_issue(g, t + 2, lds + nx * STAGE, tid); }
        const unsigned char* cA = lds + cur * STAGE;
#pragma unroll
        for (int ks = 0; ks < 2; ++ks) {
            bf16x8 a[2], b1[4], b3[4];
#pragma unroll
            for (int m = 0; m < 2; ++m) { const int row = wr * 32 + m * 16 + fr; a[m] = *(const bf16x8*)(cA + row * 128 + (((ks * 4 + fq) ^ (row & 7)) << 4)); }
#pragma unroll
            for (int n = 0; n < 4; ++n) { const int row = wc * 64 + n * 16 + fr; const int off = row * 128 + (((ks * 4 + fq) ^ (row & 7)) << 4);
                b1[n] = *(const bf16x8*)(cA + 16384 + off); b3[n] = *(const bf16x8*)(cA + 32768 + off); }
#pragma unroll
            for (int m = 0; m < 2; ++m)
#pragma unroll
                for (int n = 0; n < 4; ++n) {
                    acc1[m][n] = __builtin_amdgcn_mfma_f32_16x16x32_bf16(b1[n], a[m], acc1[m][n], 0, 0, 0);
                    acc3[m][n] = __builtin_amdgcn_mfma_f32_16x16x32_bf16(b3[n], a[m], acc3[m][n], 0, 0, 0);
                }
        }
        cur = (cur == 2) ? 0 : cur + 1;
    }
    __builtin_amdgcn_s_barrier();
}
template <int MI>
__device__ __forceinline__ void g3_zero(f32x4 (&acc)[MI][4]) {
#pragma unroll
    for (int m = 0; m < MI; ++m)
#pragma unroll
        for (int n = 0; n < 4; ++n) acc[m][n] = (f32x4){0.f, 0.f, 0.f, 0.f};
}
__device__ __forceinline__ uint2 pack4(float a, float b, float c, float d) {
    uint2 r; r.x = pk2(a, b); r.y = pk2(c, d); return r;
}

namespace pg8 {
#define PG8_LAS __attribute__((address_space(3)))
typedef unsigned short bf16_t;
typedef short bf16x8 __attribute__((ext_vector_type(8)));
typedef float f32x4 __attribute__((ext_vector_type(4)));
typedef unsigned u32x4 __attribute__((ext_vector_type(4)));
constexpr int BM = 256, BK = 64, HALF = 128, HTB = HALF * BK * 2  , STAGE_BYTES = 8 * HTB, NXCD = 8, WGM = 8;

__host__ __device__ __forceinline__ int lds_byte(int r, int c) { const int st = (r >> 4) * 2 + (c >> 5), rr = r & 15, cc = c & 31, ob = rr * 64 + cc * 2; return st * 1024 + (ob ^ (((ob >> 9) & 1) << 5)); }
__host__ __device__ __forceinline__ void stage_rc(int b, int& R, int& C) { const int st = b / 1024, sb = b % 1024, swz = sb ^ (((sb >> 9) & 1) << 5); R = (st >> 1) * 16 + swz / 64; C = (st & 1) * 32 + (swz % 64) / 2; }
__host__ __device__ __forceinline__ int perm32(int rho) { const int n = rho >> 4, i = rho & 15; return 8 * (i >> 2) + 4 * n + (i & 3); }

struct Unit { int pm, pn; };
struct Gemm { const bf16_t* A; const bf16_t* Bt; int M, N, K; };

struct StaticOrder {
    int nM, nN, nwg, G, c;
    __host__ __device__ void init(int M, int N, int G_, int c_) { nM = M / BM; nN = N / BM; nwg = nM * nN; G = G_; c = c_; }
    __host__ __device__ bool next(int i, Unit& u) const {
        const long L = (long)i * G + c; if (L >= nwg) return false;
        int wgid = (int)L; { const int q = nwg / NXCD, r = nwg % NXCD, xcd = wgid % NXCD, off = wgid / NXCD; wgid = (xcd < r ? xcd * (q + 1) : r * (q + 1) + (xcd - r) * q) + off; }
        const int nig = WGM * nN, gid = wgid / nig, fm = gid * WGM, gsz = (nM - fm) < WGM ? (nM - fm) : WGM;
        u.pm = fm + ((wgid % nig) % gsz); u.pn = (wgid % nig) / gsz; return true;
    }
    __device__ __forceinline__ void a_ready(const Unit&) const {}
    __device__ __forceinline__ void done(const Unit&) const {}
};
template <class Epi, class Sched, bool STAMP = false>
__device__ __forceinline__ void gemm_phase(PG8_LAS unsigned char* lds, const Gemm g, const Sched& S, const Epi& E, unsigned long long* stamps) {
    const int tid = otid(), wid = __builtin_amdgcn_readfirstlane(tid >> 6), lane = tid & 63, wr = wid >> 2, wc = wid & 3, fr = lane & 15, fq = lane >> 4;
    const int K = g.K, nt = K / BK;
    int ts_lo = 0, ts_hi = 0, nts = 0; const unsigned long long rt_entry = STAMP ? 0ull : 0ull;
#define PG8_STAMP() do { if (STAMP && wid == 0 && nts < 64) { const unsigned long long _c = 0ull; \
        ts_lo = (lane == nts) ? (int)(unsigned)_c : ts_lo; ts_hi = (lane == nts) ? (int)(unsigned)(_c >> 32) : ts_hi; ++nts; } } while (0)
    PG8_STAMP();
    unsigned voffA[2], voffB[2];
#pragma unroll
    for (int i = 0; i < 2; ++i) { int R, C; stage_rc(tid * 16 + i * 8192, R, C); const int Rb = Epi::PERM ? ((R & ~31) + perm32(R & 31)) : R;
        voffA[i] = (unsigned)(R * K + C) * 2u; voffB[i] = (unsigned)(Rb * K + C) * 2u; }
    const size_t kstep = (size_t)(BK * 2);
    const size_t hstep = (size_t)HALF * K * 2;
    const size_t tstep = 2 * hstep;
    const unsigned ldsw = (unsigned)wid * 1024u;
    const int aoff = lds_byte(wr * 64 + fr, fq * 8), boff = lds_byte(wc * 32 + fr, fq * 8);
#define PG8_SA(b, h) (((b) * 2 + (h)) * HTB)
#define PG8_SB(b, h) ((4 + (b) * 2 + (h)) * HTB)
#define PG8_STAGE(bufoff, gbase, voff) do { _Pragma("unroll") for (int _i = 0; _i < 2; ++_i) \
        __builtin_amdgcn_global_load_lds((const unsigned*)((const char*)(gbase) + (voff)[_i]), (PG8_LAS unsigned*)(lds + (bufoff) + ldsw + _i * 8192), 16, 0, 0); } while (0)
#define PG8_LDA(dst, b, h) do { _Pragma("unroll") for (int m = 0; m < 4; ++m) _Pragma("unroll") for (int k = 0; k < 2; ++k) dst[m][k] = *(const PG8_LAS bf16x8*)(lds + PG8_SA(b, h) + aoff + m * 2048 + k * 1024); } while (0)
#define PG8_LDB(dst, b, h) do { _Pragma("unroll") for (int n = 0; n < 2; ++n) _Pragma("unroll") for (int k = 0; k < 2; ++k) dst[n][k] = *(const PG8_LAS bf16x8*)(lds + PG8_SB(b, h) + boff + n * 2048 + k * 1024); } while (0)
#define PG8_MMA(ai, bj, At, Bt) do { __builtin_amdgcn_s_setprio(1); _Pragma("unroll") for (int m = 0; m < 4; ++m) _Pragma("unroll") for (int n = 0; n < 2; ++n) _Pragma("unroll") for (int k = 0; k < 2; ++k) \
        acc[ai][bj][m][n] = __builtin_amdgcn_mfma_f32_16x16x32_bf16(Bt[n][k], At[m][k], acc[ai][bj][m][n], 0, 0, 0); __builtin_amdgcn_s_setprio(0); } while (0)
#define PG8_WAIT_V(n) asm volatile("s_waitcnt vmcnt(" #n ")" ::: "memory")
#define PG8_WAIT_L(n) asm volatile("s_waitcnt lgkmcnt(" #n ")" ::: "memory")
#define PG8_BAR __builtin_amdgcn_s_barrier()
#define PG8_SCHED __builtin_amdgcn_sched_barrier(0)
    Unit cur, nxt; int ui = 0;
    if (!S.next(0, cur)) return;
    f32x4 acc[2][2][4][2];
#pragma unroll
    for (int a = 0; a < 2; ++a)
#pragma unroll
        for (int b = 0; b < 2; ++b)
#pragma unroll
            for (int m = 0; m < 4; ++m)
#pragma unroll
                for (int n = 0; n < 2; ++n) acc[a][b][m][n] = (f32x4){0.f, 0.f, 0.f, 0.f};
    bf16x8 At[4][2], B0[2][2], B1[2][2];
    const char* cA = (const char*)g.A + (size_t)cur.pm * tstep; const char* cB = (const char*)g.Bt + (size_t)cur.pn * tstep;
    S.a_ready(cur);
    PG8_STAGE(PG8_SB(0, 0), cB, voffB); PG8_STAGE(PG8_SA(0, 0), cA, voffA); PG8_STAGE(PG8_SB(0, 1), cB + hstep, voffB); PG8_STAGE(PG8_SA(0, 1), cA + hstep, voffA);
    if (wr == 1) PG8_BAR;
    PG8_WAIT_V(4); PG8_BAR;
    PG8_STAGE(PG8_SB(1, 0), cB + kstep, voffB); PG8_STAGE(PG8_SA(1, 0), cA + kstep, voffA); PG8_STAGE(PG8_SB(1, 1), cB + hstep + kstep, voffB);
    PG8_WAIT_V(6); PG8_BAR;
    PG8_STAMP();
    for (;;) {
        const bool has_next = S.next(ui + 1, nxt);
        const char* nA = has_next ? (const char*)g.A + (size_t)nxt.pm * tstep : cA; const char* nB = has_next ? (const char*)g.Bt + (size_t)nxt.pn * tstep : cB;
        for (int t = 0; t < nt; t += 2) {
            const bool last = (t == nt - 2);
            const char* a1 = cA + (size_t)(t + 1) * kstep;
            const char* a2 = last ? nA : cA + (size_t)(t + 2) * kstep; const char* b2 = last ? nB : cB + (size_t)(t + 2) * kstep;
            const char* a3 = a2 + kstep; const char* b3 = b2 + kstep;
            if (last && has_next) S.a_ready(nxt);
            PG8_LDB(B0, 0, 0); PG8_SCHED; PG8_LDA(At, 0, 0); PG8_STAGE(PG8_SA(1, 1), a1 + hstep, voffA);
            PG8_WAIT_L(8); PG8_BAR; PG8_WAIT_L(0); PG8_MMA(0, 0, At, B0); PG8_BAR; PG8_SCHED;
            PG8_LDB(B1, 0, 1); PG8_STAGE(PG8_SB(0, 0), b2, voffB);
            PG8_BAR; PG8_WAIT_L(0); PG8_MMA(0, 1, At, B1); PG8_BAR;
            PG8_LDA(At, 0, 1); PG8_STAGE(PG8_SA(0, 0), a2, voffA);
            PG8_BAR; PG8_WAIT_L(0); PG8_MMA(1, 0, At, B0); PG8_BAR; PG8_SCHED;
            PG8_STAGE(PG8_SB(0, 1), b2 + hstep, voffB);
            PG8_WAIT_V(6); PG8_BAR; PG8_MMA(1, 1, At, B1); PG8_BAR;
            PG8_LDB(B0, 1, 0); PG8_SCHED; PG8_LDA(At, 1, 0); PG8_STAGE(PG8_SA(0, 1), a2 + hstep, voffA);
            PG8_WAIT_L(8); PG8_BAR; PG8_WAIT_L(0); PG8_MMA(0, 0, At, B0); PG8_BAR; PG8_SCHED;
            PG8_LDB(B1, 1, 1); PG8_STAGE(PG8_SB(1, 0), b3, voffB);
            PG8_BAR; PG8_WAIT_L(0); PG8_MMA(0, 1, At, B1); PG8_BAR;
            PG8_LDA(At, 1, 1); PG8_STAGE(PG8_SA(1, 0), a3, voffA);
            PG8_BAR; PG8_WAIT_L(0); PG8_MMA(1, 0, At, B0); PG8_BAR; PG8_SCHED;
            PG8_STAGE(PG8_SB(1, 1), b3 + hstep, voffB);
            PG8_WAIT_V(6); PG8_BAR; PG8_MMA(1, 1, At, B1); PG8_BAR;
        }
        PG8_STAMP();
        if constexpr (!Epi::AFTER_DRAIN) { E(acc, cur, wr, wc, fr, fq); S.done(cur); }
        PG8_STAMP();
        if (!has_next) break;
#pragma unroll
        for (int a = 0; a < 2; ++a)
#pragma unroll
            for (int b = 0; b < 2; ++b)
#pragma unroll
                for (int m = 0; m < 4; ++m)
#pragma unroll
                    for (int n = 0; n < 2; ++n) acc[a][b][m][n] = (f32x4){0.f, 0.f, 0.f, 0.f};
        cur = nxt; cA = nA; cB = nB; ++ui;
    }
    PG8_WAIT_V(0);
    if (wr == 0) PG8_BAR;
    PG8_BAR;
    if constexpr (Epi::AFTER_DRAIN) { E.fused(acc, cur, wr, wc, fr, fq, lds, wid, lane); S.done(cur); }
    PG8_STAMP();
    if (STAMP && wid == 0) { stamps[lane] = lane < nts ? (((unsigned long long)(unsigned)ts_hi << 32) | (unsigned)ts_lo) : 0ull;
        if (lane == 62) stamps[62] = rt_entry; if (lane == 63) stamps[63] = 0ull; }
#undef PG8_STAMP
#undef PG8_SA
#undef PG8_SB
#undef PG8_STAGE
#undef PG8_LDA
#undef PG8_LDB
#undef PG8_MMA
#undef PG8_WAIT_V
#undef PG8_WAIT_L
#undef PG8_BAR
#undef PG8_SCHED
}
}

struct EpiInproj {
    static constexpr bool PERM = true, AFTER_DRAIN = false;
    unsigned char* ws; const float* rstd;
    __device__ __forceinline__ void operator()(const pg8::f32x4 (&acc)[2][2][4][2], const pg8::Unit& u, int wr, int wc, int fr, int fq) const {
        const int pn = u.pn;
        bf16_t* dst; int ld, cb;
        if (pn < 4) { dst = (bf16_t*)(ws + OFF_PPOOL); ld = 1024; cb = pn * 256; }
        else if (pn < 8) { dst = (bf16_t*)(ws + OFF_PR); ld = 1024; cb = (pn - 4) * 256; }
        else if (pn < 12) { dst = (bf16_t*)(ws + OFF_PK); ld = 1024; cb = (pn - 8) * 256; }
        else if (pn < 16) { dst = (bf16_t*)(ws + OFF_PV); ld = 1024; cb = (pn - 12) * 256; }
        else { dst = (bf16_t*)(ws + OFF_PMISC); ld = PM_LD; cb = (pn - 16) * 256; }
        bf16_t* halo = (bf16_t*)(ws + OFF_HALO);
        float rsv[2][4];
#pragma unroll
        for (int ai = 0; ai < 2; ++ai)
#pragma unroll
            for (int m = 0; m < 4; ++m) { const int row = u.pm * 256 + ai * 128 + wr * 64 + m * 16 + fr; rsv[ai][m] = (row < NT) ? rstd[row] : 0.f; }
#pragma unroll
        for (int ai = 0; ai < 2; ++ai)
#pragma unroll
            for (int m = 0; m < 4; ++m) {
                const int row = u.pm * 256 + ai * 128 + wr * 64 + m * 16 + fr;
                if (row < NT) {
                    const float rs = rsv[ai][m];
                    const int lr = row & 127;
#pragma unroll
                    for (int bj = 0; bj < 2; ++bj) {
                        const int col = cb + bj * 128 + wc * 32 + fq * 8;
                        const uint2 lo = pack4(acc[ai][bj][m][0][0] * rs, acc[ai][bj][m][0][1] * rs, acc[ai][bj][m][0][2] * rs, acc[ai][bj][m][0][3] * rs);
                        const uint2 hi = pack4(acc[ai][bj][m][1][0] * rs, acc[ai][bj][m][1][1] * rs, acc[ai][bj][m][1][2] * rs, acc[ai][bj][m][1][3] * rs);
                        const uint4 v = make_uint4(lo.x, lo.y, hi.x, hi.y);
                        *(uint4*)(dst + (size_t)row * ld + col) = v;
                        if (pn < 4 && lr >= 112) *(uint4*)(halo + ((size_t)(row >> 7) * 16 + (lr - 112)) * 1024 + col) = v;
                    }
                }
            }
    }
};
__device__ void phase_inproj(const Params& p, unsigned char* lds) {
    pg8::StaticOrder S; S.init(NTP, NP1, (int)gridDim.x, obid());
    pg8::Gemm g; g.A = (const pg8::bf16_t*)(WS(p) + OFF_H); g.Bt = (const pg8::bf16_t*)(WS(p) + OFF_WB) + WB_WIN; g.M = NTP; g.N = NP1; g.K = DM;
    EpiInproj E; E.ws = WS(p); E.rstd = (const float*)(WS(p) + OFF_RSTD);
    pg8::gemm_phase<EpiInproj, pg8::StaticOrder, false>((PG8_LAS unsigned char*)lds, g, S, E, nullptr);
}

__device__ void phase_pool(const Params& p, int l, unsigned char* lds, int tb, int te, int tstep) {
    const int tid = otid(), lane = tid & 63, wid = tid >> 6, fr = lane & 15, fq = lane >> 4;
    bf16_t* pp = (bf16_t*)(WS(p) + OFF_PPOOL);
    const bf16_t* halo = (const bf16_t*)(WS(p) + OFF_HALO);
    const bf16_t* pw = (const bf16_t*)(WS(p) + OFF_WB) + WB_POOL;
    const float* scale = p.in[6] + (size_t)l * 1024;
    bf16_t* sp = (bf16_t*)lds;
    constexpr int SLD = 264;
    bf16_t* sraw = sp + 128 * SLD;
    for (int tile = tb; tile < te; tile += tstep) {
        const int mt = tile >> 2, g = tile & 3;
        const int row0 = mt * 128, w = 2 << g;
        const bf16_t* wg = pw + (size_t)g * 65536;
        bf16x8 bfr[8][2];
#pragma unroll
        for (int kk = 0; kk < 8; ++kk)
#pragma unroll
            for (int n = 0; n < 2; ++n) bfr[kk][n] = *(const bf16x8*)(wg + (size_t)(wid * 32 + n * 16 + fr) * 256 + kk * 32 + fq * 8);
        {
            for (int e = tid; e < 144 * 32; e += NTHR) {
                const int rr = e >> 5, c16 = e & 31;
                uint4 v = make_uint4(0u, 0u, 0u, 0u);
                if (rr >= 16) v = *(const uint4*)(pp + (size_t)(row0 + rr - 16) * 1024 + g * 256 + c16 * 8);
                else if (mt > 0) v = *(const uint4*)(halo + ((size_t)(mt - 1) * 16 + rr) * 1024 + g * 256 + c16 * 8);
                *(uint4*)(sraw + rr * 256 + c16 * 8) = v;
            }
        }
        __syncthreads();
        {
            const int c = tid & 255, r0 = (tid >> 8) * 64;
            auto rawv = [&](int nrel) -> float { return bf2f(sraw[(nrel + 16) * 256 + c]); };
            int t = (row0 + r0) % TS;
            float sum = 0.f;
            const int have = (t < w) ? t : w;
            for (int i = 1; i <= have; ++i) sum += rawv(r0 - i);
#pragma unroll 8
            for (int r = 0; r < 64; ++r) {
                if (t == 0) sum = 0.f;
                const float v = rawv(r0 + r);
                sum += v;
                if (t >= w) sum -= rawv(r0 + r - w);
                const int cnt = (t + 1 < w) ? (t + 1) : w;
                sp[(r0 + r) * SLD + c] = f2bf(sum * (1.0f / (float)cnt) - v);
                t = (t + 1 == TS) ? 0 : t + 1;
            }
        }
        __syncthreads();
        f32x4 acc[8][2];
#pragma unroll
        for (int m = 0; m < 8; ++m) { acc[m][0] = (f32x4){0.f, 0.f, 0.f, 0.f}; acc[m][1] = (f32x4){0.f, 0.f, 0.f, 0.f}; }
#pragma unroll
        for (int kk = 0; kk < 8; ++kk) {
#pragma unroll
            for (int m = 0; m < 8; ++m) {
                const bf16x8 a = *(const bf16x8*)(sp + (m * 16 + fr) * SLD + kk * 32 + fq * 8);
                acc[m][0] = __builtin_amdgcn_mfma_f32_16x16x32_bf16(bfr[kk][0], a, acc[m][0], 0, 0, 0);
                acc[m][1] = __builtin_amdgcn_mfma_f32_16x16x32_bf16(bfr[kk][1], a, acc[m][1], 0, 0, 0);
            }
        }
#pragma unroll
        for (int n = 0; n < 2; ++n) {
            const int col = g * 256 + wid * 32 + n * 16 + fq * 4;
            const float4 sc = *(const float4*)(scale + col);
#pragma unroll
            for (int m = 0; m < 8; ++m) {
                const int row = row0 + m * 16 + fr;
                *(uint2*)(pp + (size_t)row * 1024 + col) = pack4(acc[m][n][0] * sc.x, acc[m][n][1] * sc.y, acc[m][n][2] * sc.z, acc[m][n][3] * sc.w);
            }
        }
        __syncthreads();
    }
}

__device__ void phase_dsa_prep(const Params& p, int l) {
    const int lane = otid() & 63;
    const int wave = (obid() * NTHR + otid()) >> 6, nw = gridDim.x * NTHR / 64;
    const bf16_t* pm = (const bf16_t*)(WS(p) + OFF_PMISC);
    unsigned char* dob = OUTB(p);
    bf16_t* cqn = (bf16_t*)(dob + DO_CQN);
    bf16_t* kv = (bf16_t*)(dob + DO_KV);
    bf16_t* kidx = (bf16_t*)(dob + DO_KIDX);
    float* whead = (float*)(dob + DO_WHEAD);
    const float* ctab = (const float*)(WS(p) + OFF_ROPE);
    const float* stab = ctab + TS * 16;
    const bf16_t* hrow = (const bf16_t*)(WS(p) + OFF_H);
    const bf16_t* wwidx = (const bf16_t*)(WS(p) + OFF_WB) + WB_WIDX;
    const float* rstd_ = (const float*)(WS(p) + OFF_RSTD);
    const float4 qn4 = *(const float4*)(p.in[21] + l * 256 + lane * 4);
    const float2 kvn2 = *(const float2*)(p.in[22] + l * 128 + lane * 2);
    const float inw = p.in[27][l * 64 + lane], inb = p.in[28][l * 64 + lane];
    uint4 ww[8][2];
#pragma unroll
    for (int j = 0; j < 8; ++j) { ww[j][0] = *(const uint4*)(wwidx + (size_t)j * DM + lane * 16); ww[j][1] = *(const uint4*)(wwidx + (size_t)j * DM + lane * 16 + 8); }
    struct In { uint2 cq; unsigned ckv; bf16_t kr0, kr1, kix; uint4 h0, h1; float rs, c, s; };
    auto load = [&](int n) {
        In r;
        const bf16_t* row = pm + (size_t)n * PM_LD;
        const int t = n % TS;
        r.cq = *(const uint2*)(row + PM_CQ + lane * 4);
        r.ckv = *(const unsigned*)(row + PM_CKV + lane * 2);
        r.kr0 = row[PM_KROPE + (lane & 15)]; r.kr1 = row[PM_KROPE + 16 + (lane & 15)];
        r.kix = row[PM_KIDX + lane];
        r.h0 = *(const uint4*)(hrow + (size_t)n * DM + lane * 16); r.h1 = *(const uint4*)(hrow + (size_t)n * DM + lane * 16 + 8);
        r.rs = rstd_[n];
        r.c = ctab[t * 16 + (lane & 15)]; r.s = stab[t * 16 + (lane & 15)];
        return r;
    };
    In cur = load(wave < NT ? wave : 0);
    for (int n = wave; n < NT; n += nw) {
        const In x = cur;
        if (n + nw < NT) cur = load(n + nw);
        {
            const float v0 = __uint_as_float(x.cq.x << 16), v1 = __uint_as_float(x.cq.x & 0xFFFF0000u), v2 = __uint_as_float(x.cq.y << 16), v3 = __uint_as_float(x.cq.y & 0xFFFF0000u);
            const float ss = wave_sum_fast(v0 * v0 + v1 * v1 + v2 * v2 + v3 * v3);
            const float rs = rsqrtf(ss * (1.0f / 256.0f) + 1e-6f);
            *(uint2*)(cqn + (size_t)n * 256 + lane * 4) = pack4(v0 * rs * qn4.x, v1 * rs * qn4.y, v2 * rs * qn4.z, v3 * rs * qn4.w);
        }
        {
            const float v0 = __uint_as_float(x.ckv << 16), v1 = __uint_as_float(x.ckv & 0xFFFF0000u);
            const float ss = wave_sum_fast(v0 * v0 + v1 * v1);
            const float rs = rsqrtf(ss * (1.0f / 128.0f) + 1e-6f);
            *(unsigned*)(kv + (size_t)n * 160 + lane * 2) = pk2(v0 * rs * kvn2.x, v1 * rs * kvn2.y);
        }
        if (lane < 16) {
            const float x1 = bf2f(x.kr0), x2 = bf2f(x.kr1);
            kv[(size_t)n * 160 + 128 + lane] = f2bf(x1 * x.c - x2 * x.s);
            kv[(size_t)n * 160 + 144 + lane] = f2bf(x2 * x.c + x1 * x.s);
        }
        {
            const float xv = bf2f(x.kix);
            const float mu = wave_sum_fast(xv) * (1.0f / 64.0f);
            const float d = xv - mu;
            const float var = wave_sum_fast(d * d) * (1.0f / 64.0f);
            const float y = d * rsqrtf(var + 1e-6f) * inw + inb;
            const float yo = __shfl_xor(y, 16);
            float o = y;
            if (lane < 32) o = (lane < 16) ? (y * x.c - yo * x.s) : (y * x.c + yo * x.s);
            kidx[(size_t)n * 64 + lane] = f2bf(o);
        }
        {
            const uint4 hv0 = x.h0, hv1 = x.h1;
            float hx[16];
            hx[0] = __uint_as_float(hv0.x << 16); hx[1] = __uint_as_float(hv0.x & 0xFFFF0000u); hx[2] = __uint_as_float(hv0.y << 16); hx[3] = __uint_as_float(hv0.y & 0xFFFF0000u);
            hx[4] = __uint_as_float(hv0.z << 16); hx[5] = __uint_as_float(hv0.z & 0xFFFF0000u); hx[6] = __uint_as_float(hv0.w << 16); hx[7] = __uint_as_float(hv0.w & 0xFFFF0000u);
            hx[8] = __uint_as_float(hv1.x << 16); hx[9] = __uint_as_float(hv1.x & 0xFFFF0000u); hx[10] = __uint_as_float(hv1.y << 16); hx[11] = __uint_as_float(hv1.y & 0xFFFF0000u);
            hx[12] = __uint_as_float(hv1.z << 16); hx[13] = __uint_as_float(hv1.z & 0xFFFF0000u); hx[14] = __uint_as_float(hv1.w << 16); hx[15] = __uint_as_float(hv1.w & 0xFFFF0000u);
            float myw = 0.f;
#pragma unroll
            for (int j = 0; j < 8; ++j) {
                const uint4 w0 = ww[j][0], w1 = ww[j][1];
                float d = hx[0] * __uint_as_float(w0.x << 16) + hx[1] * __uint_as_float(w0.x & 0xFFFF0000u) + hx[2] * __uint_as_float(w0.y << 16) + hx[3] * __uint_as_float(w0.y & 0xFFFF0000u)
                        + hx[4] * __uint_as_float(w0.z << 16) + hx[5] * __uint_as_float(w0.z & 0xFFFF0000u) + hx[6] * __uint_as_float(w0.w << 16) + hx[7] * __uint_as_float(w0.w & 0xFFFF0000u)
                        + hx[8] * __uint_as_float(w1.x << 16) + hx[9] * __uint_as_float(w1.x & 0xFFFF0000u) + hx[10] * __uint_as_float(w1.y << 16) + hx[11] * __uint_as_float(w1.y & 0xFFFF0000u)
                        + hx[12] * __uint_as_float(w1.z << 16) + hx[13] * __uint_as_float(w1.z & 0xFFFF0000u) + hx[14] * __uint_as_float(w1.w << 16) + hx[15] * __uint_as_float(w1.w & 0xFFFF0000u);
                d = wave_sum_fast(d);
                myw = (lane == j) ? d : myw;
            }
            if (lane < 8) whead[(size_t)n * 8 + lane] = myw * x.rs * 0.04419417382415922f;
        }
    }
}

typedef short s16x4 __attribute__((ext_vector_type(4)));
__device__ __forceinline__ unsigned f2h_bits(float f) { const _Float16 h = (_Float16)f; unsigned short u; __builtin_memcpy(&u, &h, 2); return u; }
template <bool IMPORT_SEL>
__device__ void phase_dsa(const Params& p, int l, unsigned char* lds, bf16_t* yc, const unsigned short* gsel, const int* gnsel, int tb, int te, int tstep) {
    unsigned short* s_sc = (unsigned short*)lds;
    bf16_t* s_qi = (bf16_t*)(lds + 66048);
    bf16_t* s_Q = (bf16_t*)lds;
    unsigned short* s_sel = (unsigned short*)(lds + 82432 + 65536);
    int* s_nsel = (int*)(lds + 82432 + 65536 + 8192);
    unsigned char* dob = OUTB(p);
    const bf16_t* cqn = (const bf16_t*)(dob + DO_CQN);
    const bf16_t* kv = (const bf16_t*)(dob + DO_KV);
    const bf16_t* kidx = (const bf16_t*)(dob + DO_KIDX);
    const float* whead = (const float*)(dob + DO_WHEAD);
    const float* ctab = (const float*)(WS(p) + OFF_ROPE);
    const float* stab = ctab + TS * 16;
    const bf16_t* wb = (const bf16_t*)(WS(p) + OFF_WB);
    const bf16_t* wqiT = wb + WB_QI;
    const bf16_t* wuqT = wb + WB_UQ;
    const bf16_t* wuk = wb + WB_UK;
    const bf16_t* wuvT = wb + WB_UV;
    const float scale = 0.10206207261596575f;
    const f32x4 z4 = {0.f, 0.f, 0.f, 0.f};
    bf16_t* gq = (obid() < QS_WS) ? (bf16_t*)(WS(p) + WS_END + (size_t)obid() * QS_BYTES) : (bf16_t*)(OUTB(p) + DO_END + (size_t)(obid() - QS_WS) * QS_BYTES);
    for (int pair = tb; pair < te; pair += tstep) {
        const int qt = 128 - (pair >> 2);
        const int t0 = qt * 16;
#pragma unroll 1
        for (int half = 0; half < 2; ++half) {
        const int tid = otid(), lane = tid & 63, wid = tid >> 6, fr = lane & 15, fq = lane >> 4;
        unsigned char* s_Vw = lds + 82432 + wid * 8192;
        bf16_t* s_qn = (bf16_t*)s_Vw;
        const int b = (pair & 3) * 2 + half;
        const size_t n0 = (size_t)b * TS + t0;
        {
            bf16x8 acq[8];
#pragma unroll
            for (int kk = 0; kk < 8; ++kk) acq[kk] = *(const bf16x8*)(cqn + (n0 + fr) * 256 + kk * 32 + fq * 8);
            f32x4 c[4] = {z4, z4, z4, z4};
#pragma unroll
            for (int kb = 0; kb < 8; kb += 4) {
                bf16x8 bf[4][4];
#pragma unroll
                for (int k4 = 0; k4 < 4; ++k4)
#pragma unroll
                    for (int nt = 0; nt < 4; ++nt) bf[k4][nt] = *(const bf16x8*)(wqiT + (size_t)(wid * 64 + nt * 16 + fr) * 256 + (kb + k4) * 32 + fq * 8);
#pragma unroll
                for (int k4 = 0; k4 < 4; ++k4)
#pragma unroll
                    for (int nt = 0; nt < 4; ++nt) c[nt] = __builtin_amdgcn_mfma_f32_16x16x32_bf16(acq[kb + k4], bf[k4][nt], c[nt], 0, 0, 0);
            }
#pragma unroll
            for (int j = 0; j < 4; ++j) {
                const int t = t0 + fq * 4 + j;
                const float cs = ctab[t * 16 + fr], sn = stab[t * 16 + fr];
                const float x1 = c[0][j], x2 = c[1][j];
                c[0][j] = x1 * cs - x2 * sn; c[1][j] = x2 * cs + x1 * sn;
            }
#pragma unroll
            for (int nt = 0; nt < 4; ++nt)
#pragma unroll
                for (int j = 0; j < 4; ++j) s_qi[(fq * 4 + j) * 512 + wid * 64 + nt * 16 + fr] = f2bf(c[nt][j]);
        }
        __syncthreads();
        if (!IMPORT_SEL) {
            bf16x8 aq[8][2];
#pragma unroll
            for (int h = 0; h < 8; ++h)
#pragma unroll
                for (int ks = 0; ks < 2; ++ks) aq[h][ks] = *(const bf16x8*)(s_qi + fr * 512 + h * 64 + ks * 32 + fq * 8);
            float wh[4][8];
#pragma unroll
            for (int j = 0; j < 4; ++j) {
                const float4 w0 = *(const float4*)(whead + (n0 + fq * 4 + j) * 8), w1 = *(const float4*)(whead + (n0 + fq * 4 + j) * 8 + 4);
                wh[j][0] = w0.x; wh[j][1] = w0.y; wh[j][2] = w0.z; wh[j][3] = w0.w; wh[j][4] = w1.x; wh[j][5] = w1.y; wh[j][6] = w1.z; wh[j][7] = w1.w;
            }
            const int nkt = qt + 1;
            bf16x8 nb0 = {0, 0, 0, 0, 0, 0, 0, 0}, nb1 = nb0;
            if (wid < nkt) { const bf16_t* kr0 = kidx + ((size_t)b * TS + wid * 16 + fr) * 64 + fq * 8; nb0 = *(const bf16x8*)kr0; nb1 = *(const bf16x8*)(kr0 + 32); }
#pragma unroll 1
            for (int kt = wid; kt < nkt; kt += 8) {
                const bf16x8 bk0 = nb0, bk1 = nb1;
                if (kt + 8 < nkt) { const bf16_t* krn = kidx + ((size_t)b * TS + (kt + 8) * 16 + fr) * 64 + fq * 8; nb0 = *(const bf16x8*)krn; nb1 = *(const bf16x8*)(krn + 32); }
                float I[4] = {0.f, 0.f, 0.f, 0.f};
#pragma unroll
                for (int h = 0; h < 8; ++h) {
                    f32x4 a = __builtin_amdgcn_mfma_f32_16x16x32_bf16(aq[h][0], bk0, z4, 0, 0, 0);
                    a = __builtin_amdgcn_mfma_f32_16x16x32_bf16(aq[h][1], bk1, a, 0, 0, 0);
#pragma unroll
                    for (int j = 0; j < 4; ++j) I[j] += wh[j][h] * fmaxf(a[j], 0.f);
                }
#pragma unroll
                for (int j = 0; j < 4; ++j) s_sc[(fq * 4 + j) * 2064 + kt * 16 + fr] = (unsigned short)f2h_bits(I[j]);
            }
        }
        __syncthreads();
#pragma unroll 1
        for (int qi2 = 0; qi2 < 2; ++qi2) {
            const int q = wid + qi2 * 8;
            const int nadm = t0 + q + 1;
            unsigned short* sel = s_sel + q * 256;
            if (IMPORT_SEL) {
                const int ns = gnsel[n0 + q];
                for (int i = lane; i < ns; i += 64) sel[i] = gsel[(n0 + q) * 256 + i];
                if (lane == 0) s_nsel[q] = ns;
            } else if (nadm <= 256) {
                for (int i = lane; i < nadm; i += 64) sel[i] = (unsigned short)i;
                if (lane == 0) s_nsel[q] = nadm;
            } else {
                unsigned* hist = (unsigned*)(lds + 82432 + wid * 8192);
                const unsigned short* scq = s_sc + q * 2064;
                const int nch = (nadm + 63) >> 6;
                unsigned B1 = 0u; int na1 = 0, na2 = 0; unsigned T = 0u;
#pragma unroll 1
                for (int pass = 0; pass < 2; ++pass) {
                    *(uint4*)(hist + lane * 4) = make_uint4(0u, 0u, 0u, 0u);
#pragma unroll 1
                    for (int c0 = 0; c0 < nch; c0 += 8) {
                        unsigned kb[8];
#pragma unroll
                        for (int j = 0; j < 8; ++j) { const int s_ = (c0 + j) * 64 + lane; kb[j] = (s_ < nadm) ? (unsigned)scq[s_] : 0x10000u; }
#pragma unroll
                        for (int j = 0; j < 8; ++j) {
                            const unsigned u = kb[j];
                            const unsigned k = (u & 0x8000u) ? (~u & 0xFFFFu) : (u | 0x8000u);
                            const bool ok = (u < 0x10000u) && (pass == 0 || (k >> 8) == B1);
                            if (ok) atomicAdd(hist + (pass == 0 ? (k >> 8) : (k & 255u)), 1u);
                        }
                    }
                    const int need = 256 - na1;
                    const uint4 h4 = *(const uint4*)(hist + lane * 4);
                    const int sl = (int)(h4.x + h4.y + h4.z + h4.w);
                    int suf = sl;
#pragma unroll
                    for (int o = 1; o < 64; o <<= 1) { const int t_ = __shfl_down(suf, o); suf += (lane + o < 64) ? t_ : 0; }
                    const int above = suf - sl;
                    const bool mine = (suf >= need) && (above < need);
                    int a = above, bsel, asel;
                    if (a + (int)h4.w >= need) { bsel = 3; asel = a; }
                    else { a += (int)h4.w;
                        if (a + (int)h4.z >= need) { bsel = 2; asel = a; }
                        else { a += (int)h4.z;
                            if (a + (int)h4.y >= need) { bsel = 1; asel = a; }
                            else { a += (int)h4.y; bsel = 0; asel = a; } } }
                    const int src = __ffsll((long long)__ballot(mine)) - 1;
                    const unsigned bin = (unsigned)__shfl(lane * 4 + bsel, src); const int nab = __shfl(asel, src);
                    if (pass == 0) { B1 = bin; na1 = nab; } else { T = (B1 << 8) | bin; na2 = nab; }
                }
                {
                    const int rties = 256 - (na1 + na2);
                    int base = 0, ties = 0;
                    const unsigned long long ltmask = (1ull << lane) - 1ull;
#pragma unroll 1
                    for (int c0 = 0; c0 < nch; c0 += 4) {
                        unsigned kb[4];
#pragma unroll
                        for (int j = 0; j < 4; ++j) { const int s_ = (c0 + j) * 64 + lane; kb[j] = (s_ < nadm) ? (unsigned)scq[s_] : 0x10000u; }
#pragma unroll
                        for (int j = 0; j < 4; ++j) {
                            const int s_ = (c0 + j) * 64 + lane;
                            const unsigned u = kb[j];
                            const bool valid = u < 0x10000u;
                            const unsigned k = (u & 0x8000u) ? (~u & 0xFFFFu) : (u | 0x8000u);
                            const bool gt = valid && k > T, eq = valid && k == T;
                            const unsigned long long em = __ballot(eq);
                            const int myrank = ties + __popcll(em & ltmask);
                            const bool take = gt || (eq && myrank < rties);
                            const unsigned long long tm = __ballot(take);
                            const int pos = base + __popcll(tm & ltmask);
                            if (take && pos < 256) sel[pos] = (unsigned short)s_;
                            base += __popcll(tm); ties += __popcll(em);
                        }
                    }
                }
                if (lane == 0) s_nsel[q] = 256;
            }
        }
        __syncthreads();
        if (half == 0) {
            const size_t n0B = n0 + TS;
            bf16_t* s_qnB = s_qn + 1024;
#pragma unroll 1
            for (int hi = 0; hi < 2; ++hi) {
                const int hh = wid * 2 + hi;
                const bf16_t* caA = cqn + (n0 + fr) * 256 + fq * 8;
                const bf16_t* caB = cqn + (n0B + fr) * 256 + fq * 8;
                f32x4 cA[6] = {z4, z4, z4, z4, z4, z4}, cB[6] = {z4, z4, z4, z4, z4, z4};
#pragma unroll
                for (int kb = 0; kb < 8; kb += 2) {
                    bf16x8 bf[2][6], aA[2], aB[2];
#pragma unroll
                    for (int k2 = 0; k2 < 2; ++k2) {
                        aA[k2] = *(const bf16x8*)(caA + (kb + k2) * 32); aB[k2] = *(const bf16x8*)(caB + (kb + k2) * 32);
#pragma unroll
                        for (int nt = 0; nt < 6; ++nt) bf[k2][nt] = *(const bf16x8*)(wuqT + (size_t)(hh * 96 + nt * 16 + fr) * 256 + (kb + k2) * 32 + fq * 8);
                    }
#pragma unroll
                    for (int k2 = 0; k2 < 2; ++k2)
#pragma unroll
                        for (int nt = 0; nt < 6; ++nt) {
                            cA[nt] = __builtin_amdgcn_mfma_f32_16x16x32_bf16(aA[k2], bf[k2][nt], cA[nt], 0, 0, 0);
                            cB[nt] = __builtin_amdgcn_mfma_f32_16x16x32_bf16(aB[k2], bf[k2][nt], cB[nt], 0, 0, 0);
                        }
                }
#pragma unroll
                for (int j = 0; j < 4; ++j) {
                    const int q = fq * 4 + j, t = t0 + q;
                    const float cs = ctab[t * 16 + fr], sn = stab[t * 16 + fr];
                    s_Q[(q * 16 + hh) * 160 + 128 + fr] = f2bf(cA[4][j] * cs - cA[5][j] * sn);
                    s_Q[(q * 16 + hh) * 160 + 144 + fr] = f2bf(cA[5][j] * cs + cA[4][j] * sn);
                    gq[(q * 16 + hh) * 160 + 128 + fr] = f2bf(cB[4][j] * cs - cB[5][j] * sn);
                    gq[(q * 16 + hh) * 160 + 144 + fr] = f2bf(cB[5][j] * cs + cB[4][j] * sn);
#pragma unroll
                    for (int nt = 0; nt < 4; ++nt) { s_qn[q * 64 + nt * 16 + fr] = f2bf(cA[nt][j]); s_qnB[q * 64 + nt * 16 + fr] = f2bf(cB[nt][j]); }
                }
                __syncthreads();
                bf16x8 anA[2], anB[2];
#pragma unroll
                for (int ks = 0; ks < 2; ++ks) { anA[ks] = *(const bf16x8*)(s_qn + fr * 64 + ks * 32 + fq * 8); anB[ks] = *(const bf16x8*)(s_qnB + fr * 64 + ks * 32 + fq * 8); }
                bf16x8 bwk[8][2];
#pragma unroll
                for (int nt = 0; nt < 8; ++nt)
#pragma unroll
                    for (int ks = 0; ks < 2; ++ks) bwk[nt][ks] = *(const bf16x8*)(wuk + (size_t)(hh * 128 + nt * 16 + fr) * 64 + ks * 32 + fq * 8);
#pragma unroll
                for (int nt = 0; nt < 8; ++nt) {
                    f32x4 aA = z4, aB = z4;
#pragma unroll
                    for (int ks = 0; ks < 2; ++ks) {
                        aA = __builtin_amdgcn_mfma_f32_16x16x32_bf16(anA[ks], bwk[nt][ks], aA, 0, 0, 0);
                        aB = __builtin_amdgcn_mfma_f32_16x16x32_bf16(anB[ks], bwk[nt][ks], aB, 0, 0, 0);
                    }
#pragma unroll
                    for (int j = 0; j < 4; ++j) {
                        s_Q[((fq * 4 + j) * 16 + hh) * 160 + nt * 16 + fr] = f2bf(aA[j]);
                        gq[((fq * 4 + j) * 16 + hh) * 160 + nt * 16 + fr] = f2bf(aB[j]);
                    }
                }
                __syncthreads();
            }
        } else {
            for (int e = tid; e < QS_BYTES / 16; e += NTHR) ((uint4*)s_Q)[e] = ((const uint4*)gq)[e];
            __syncthreads();
        }
#pragma unroll 1
        for (int qi2 = 0; qi2 < 2; ++qi2) {
            const int q = wid + qi2 * 8;
            bf16x8 bq[5];
#pragma unroll
            for (int ks = 0; ks < 5; ++ks) bq[ks] = *(const bf16x8*)(s_Q + (q * 16 + fr) * 160 + ks * 32 + fq * 8);
            const int nsel = s_nsel[q];
            const unsigned short* sel = s_sel + q * 256;
            float m = -INFINITY, lsum = 0.f;
            f32x4 O[8] = {z4, z4, z4, z4, z4, z4, z4, z4};
            const int nchunk = (nsel + 31) >> 5;
            bf16x8 akn[2][5];
#pragma unroll
            for (int mt = 0; mt < 2; ++mt) {
                const int ki = mt * 16 + fr;
                const int sidx = sel[ki < nsel ? ki : 0];
                const bf16_t* krow = kv + ((size_t)b * TS + sidx) * 160 + fq * 8;
#pragma unroll
                for (int ks = 0; ks < 5; ++ks) akn[mt][ks] = *(const bf16x8*)(krow + ks * 32);
            }
#pragma unroll 1
            for (int ch = 0; ch < nchunk; ++ch) {
                bf16x8 ak[2][5];
#pragma unroll
                for (int mt = 0; mt < 2; ++mt)
#pragma unroll
                    for (int ks = 0; ks < 5; ++ks) ak[mt][ks] = akn[mt][ks];
                if (ch + 1 < nchunk) {
#pragma unroll
                    for (int mt = 0; mt < 2; ++mt) {
                        const int ki = (ch + 1) * 32 + mt * 16 + fr;
                        const int sidx = sel[ki < nsel ? ki : 0];
                        const bf16_t* krow = kv + ((size_t)b * TS + sidx) * 160 + fq * 8;
#pragma unroll
                        for (int ks = 0; ks < 5; ++ks) akn[mt][ks] = *(const bf16x8*)(krow + ks * 32);
                    }
                }
#pragma unroll
                for (int mt = 0; mt < 2; ++mt)
#pragma unroll
                    for (int ks = 0; ks < 4; ++ks) {
                        const int r = mt * 16 + fr;
                        *(bf16x8*)(s_Vw + r * 256 + (((ks * 2 + (fq >> 1)) ^ (r & 7)) * 32) + (fq & 1) * 16) = ak[mt][ks];
                    }
                f32x4 st[2] = {z4, z4};
#pragma unroll
                for (int mt = 0; mt < 2; ++mt)
#pragma unroll
                    for (int ks = 0; ks < 5; ++ks) st[mt] = __builtin_amdgcn_mfma_f32_16x16x32_bf16(ak[mt][ks], bq[ks], st[mt], 0, 0, 0);
                float sv[2][4]; float cmax = -INFINITY;
#pragma unroll
                for (int mt = 0; mt < 2; ++mt)
#pragma unroll
                    for (int j = 0; j < 4; ++j) {
                        const int ke = ch * 32 + mt * 16 + fq * 4 + j;
                        const float s_ = (ke < nsel) ? st[mt][j] * scale : -INFINITY;
                        sv[mt][j] = s_; cmax = fmaxf(cmax, s_);
                    }
                cmax = fmaxf(cmax, __shfl_xor(cmax, 16)); cmax = fmaxf(cmax, __shfl_xor(cmax, 32));
                const float mnew = fmaxf(m, cmax);
                const float alpha = __expf(m - mnew);
                float psum = 0.f;
#pragma unroll
                for (int mt = 0; mt < 2; ++mt)
#pragma unroll
                    for (int j = 0; j < 4; ++j) { const float pe = __expf(sv[mt][j] - mnew); sv[mt][j] = pe; psum += pe; }
                psum += __shfl_xor(psum, 16); psum += __shfl_xor(psum, 32);
                lsum = lsum * alpha + psum; m = mnew;
#pragma unroll
                for (int ct = 0; ct < 8; ++ct) O[ct] = O[ct] * alpha;
                bf16x8 pf;
#pragma unroll
                for (int mt = 0; mt < 2; ++mt)
#pragma unroll
                    for (int j = 0; j < 4; ++j) pf[mt * 4 + j] = (short)f2bf(sv[mt][j]);
                const int q_ = fr >> 2, p_ = fr & 3;
                const int r0 = fq * 4 + q_, r1 = 16 + r0;
#pragma unroll
                for (int ct = 0; ct < 8; ++ct) {
                    const s16x4 v0 = __builtin_amdgcn_ds_read_tr16_b64_v4i16((__attribute__((address_space(3))) s16x4*)(s_Vw + r0 * 256 + ((ct ^ (r0 & 7)) * 32) + p_ * 8));
                    const s16x4 v1 = __builtin_amdgcn_ds_read_tr16_b64_v4i16((__attribute__((address_space(3))) s16x4*)(s_Vw + r1 * 256 + ((ct ^ (r1 & 7)) * 32) + p_ * 8));
                    bf16x8 av; av[0] = v0[0]; av[1] = v0[1]; av[2] = v0[2]; av[3] = v0[3]; av[4] = v1[0]; av[5] = v1[1]; av[6] = v1[2]; av[7] = v1[3];
                    O[ct] = __builtin_amdgcn_mfma_f32_16x16x32_bf16(av, pf, O[ct], 0, 0, 0);
                }
            }
            const float inv = 1.0f / lsum;
#pragma unroll
            for (int ct = 0; ct < 8; ++ct)
#pragma unroll
                for (int j = 0; j < 4; ++j) s_Q[(q * 16 + fr) * 160 + ct * 16 + fq * 4 + j] = f2bf(O[ct][j] * inv);
        }
        __syncthreads();
#pragma unroll 1
        for (int hi = 0; hi < 2; ++hi) {
            const int hh = wid * 2 + hi;
            bf16x8 ao[4];
#pragma unroll
            for (int ks = 0; ks < 4; ++ks) ao[ks] = *(const bf16x8*)(s_Q + (fr * 16 + hh) * 160 + ks * 32 + fq * 8);
#pragma unroll
            for (int nt = 0; nt < 4; ++nt) {
                f32x4 a = z4;
#pragma unroll
                for (int ks = 0; ks < 4; ++ks)
                    a = __builtin_amdgcn_mfma_f32_16x16x32_bf16(ao[ks], *(const bf16x8*)(wuvT + (size_t)(hh * 64 + nt * 16 + fr) * 128 + ks * 32 + fq * 8), a, 0, 0, 0);
#pragma unroll
                for (int j = 0; j < 4; ++j) yc[(n0 + fq * 4 + j) * 1024 + hh * 64 + nt * 16 + fr] = f2bf(a[j]);
            }
        }
        __syncthreads();
        }
    }
}


__device__ void phase_lr_prep(const Params& p, int l) {
    const int lane = otid() & 63;
    const int wave = (obid() * NTHR + otid()) >> 6, nw = gridDim.x * NTHR / 64;
    const bf16_t* pm = (const bf16_t*)(WS(p) + OFF_PMISC);
    bf16_t* alr = (bf16_t*)(OUTB(p) + DO_ALR);
    const float4 mu4 = *(const float4*)(p.in[4] + (size_t)l * 3328 + 3072 + lane * 4);
    const float4 vm4 = *(const float4*)(p.in[18] + (lane & 7) * 4);
    struct In { uint2 c0, p0, c1, p1; };
    auto load = [&](int n) {
        In r;
        const bf16_t* row = pm + (size_t)n * PM_LD;
        const bool hp = (n % TS) > 0;
        r.c0 = *(const uint2*)(row + lane * 4);
        r.p0 = hp ? *(const uint2*)(row - PM_LD + lane * 4) : make_uint2(0u, 0u);
        r.c1 = make_uint2(0u, 0u); r.p1 = r.c1;
        if (lane < 8) { r.c1 = *(const uint2*)(row + 256 + lane * 4); if (hp) r.p1 = *(const uint2*)(row - PM_LD + 256 + lane * 4); }
        return r;
    };
    auto mix4 = [&](const uint2 c, const uint2 q, const float4 m, float (&o)[4]) {
        const float c0 = __uint_as_float(c.x << 16), c1 = __uint_as_float(c.x & 0xFFFF0000u), c2 = __uint_as_float(c.y << 16), c3 = __uint_as_float(c.y & 0xFFFF0000u);
        const float q0 = __uint_as_float(q.x << 16), q1 = __uint_as_float(q.x & 0xFFFF0000u), q2 = __uint_as_float(q.y << 16), q3 = __uint_as_float(q.y & 0xFFFF0000u);
        o[0] = c0 + (q0 - c0) * m.x; o[1] = c1 + (q1 - c1) * m.y; o[2] = c2 + (q2 - c2) * m.z; o[3] = c3 + (q3 - c3) * m.w;
    };
    In cur = load(wave < NT ? wave : 0);
    for (int n = wave; n < NT; n += nw) {
        const In x = cur;
        if (n + nw < NT) cur = load(n + nw);
        float o[4];
        mix4(x.c0, x.p0, mu4, o);
        if (lane < 16) { o[0] = tanhf(o[0]); o[1] = tanhf(o[1]); o[2] = tanhf(o[2]); o[3] = tanhf(o[3]); }
        else if (lane >= 32) { o[0] = sigmoidf_(o[0]); o[1] = sigmoidf_(o[1]); o[2] = sigmoidf_(o[2]); o[3] = sigmoidf_(o[3]); }
        *(uint2*)(alr + (size_t)n * 288 + lane * 4) = pack4(o[0], o[1], o[2], o[3]);
        if (lane < 8) {
            mix4(x.c1, x.p1, vm4, o);
            *(uint2*)(alr + (size_t)n * 288 + 256 + lane * 4) = pack4(o[0], o[1], o[2], o[3]);
        }
    }
}

typedef short sh4 __attribute__((ext_vector_type(4)));
__device__ __forceinline__ sh4 pk4v(const f32x4& v) { const uint2 u = pack4(v[0], v[1], v[2], v[3]); sh4 r; __builtin_memcpy(&r, &u, 8); return r; }
__device__ __forceinline__ bf16x8 cat8(const sh4& a, const sh4& b) { bf16x8 r; r[0] = a[0]; r[1] = a[1]; r[2] = a[2]; r[3] = a[3]; r[4] = b[0]; r[5] = b[1]; r[6] = b[2]; r[7] = b[3]; return r; }
#define MF32(a, b, c) __builtin_amdgcn_mfma_f32_16x16x32_bf16(a, b, c, 0, 0, 0)
#define MF16(a, b, c) MF32(cat8(a, sh4{0, 0, 0, 0}), cat8(b, sh4{0, 0, 0, 0}), c)
constexpr int SC_LT = 72;
constexpr int SC_LS = 36;
constexpr int SC_TC = 32;
constexpr int SC_ROWB = 1088;
__device__ __forceinline__ const unsigned char* scan_piece_src(const Params& p, int l, int b, int hc, int t0, int pi, bool& ok) {
    const int tau = pi / 68, seg = pi - tau * 68;
    const int t = t0 + tau;
    ok = (t < TS) && (tau < SC_TC);
    const size_t n = (size_t)b * TS + t;
    const unsigned char* ws = WS(p);
    if (seg < 8) return ws + OFF_PR + (n * 1024 + hc) * 2 + seg * 16;
    if (seg < 16) return ws + OFF_PK + (n * 1024 + hc) * 2 + (seg - 8) * 16;
    if (seg < 24) return ws + OFF_PV + (n * 1024 + hc) * 2 + (seg - 16) * 16;
    if (seg < 60) return OUTB(p) + DO_ALR + (n * 288) * 2 + (seg - 24) * 16;
    ok = ok && (l > 0);
    return ws + OFF_VFIRST + (n * 1024 + hc) * 2 + (seg - 60) * 16;
}
__device__ void phase_scan5(const Params& p, int l, unsigned char* lds, int blk) {
    const int tid = otid(), lane = tid & 63, wid = tid >> 6, fr = lane & 15, fq = lane >> 4;
    const int b = blk >> 4, hh = blk & 15, hc = hh * 64;
    float* s_r = (float*)lds;
    float* s_w = s_r + 2048;
    float* s_k = s_w + 2048;
    float* s_v = s_k + 2048;
    float* s_a = s_v + 2048;
    float* s_b = s_a + 2048;
    float* s_g = s_b + 2048;
    float* s_o = s_g + 2048;
    bf16_t* o_at = (bf16_t*)(s_o + 2048);
    bf16_t* o_rt = o_at + 32 * SC_LT;
    bf16_t* o_bt = o_rt + 32 * SC_LT;
    bf16_t* o_kt = o_bt + 32 * SC_LT;
    bf16_t* o_bT = o_kt + 32 * SC_LT;
    bf16_t* o_kT = o_bT + 64 * SC_LS;
    bf16_t* o_vT = o_kT + 64 * SC_LS;
    float* s_gc = (float*)(o_vT + 64 * SC_LS);
    unsigned char* raw = (unsigned char*)(s_gc + 128);
    float* prevb = (float*)(raw + 32 * SC_ROWB);
    unsigned* prevr = (unsigned*)prevb;
    float* cst = prevb + 960;
    float* s_gB = s_r;
    float* s_oB = s_k;
    float* s_vB = cst + 992;
    float* s_bs2 = s_vB + 2048;
    const float* mu = p.in[4] + (size_t)l * 3328;
    for (int e = tid; e < 480; e += NTHR) {
        float v;
        if (e < 192) v = mu[(e >> 6) * 1024 + hc + (e & 63)];
        else if (e < 448) v = mu[3072 + (e - 192)];
        else v = p.in[18][e - 448];
        cst[e] = v;
    }
    if (tid < 64) {
        cst[480 + tid] = p.in[7][l * 1024 + hc + tid];
        cst[544 + tid] = p.in[9][l * 1024 + hc + tid];
        cst[608 + tid] = p.in[12][l * 1024 + hc + tid];
        cst[672 + tid] = p.in[13][l * 1024 + hc + tid];
        cst[736 + tid] = p.in[14][l * 1024 + hc + tid];
        cst[800 + tid] = p.in[15][l * 1024 + hc + tid];
        cst[864 + tid] = p.in[16][l * 1024 + hc + tid];
        cst[928 + tid] = p.in[19][hc + tid];
    }
    const int mm = wid >> 1, ntb = (wid & 1) * 2;
    const int nks = (mm == 2) ? 4 : (mm == 3 ? 1 : 2);
    bf16x8 Bw[2][4];
    {
        const float* wsrc = (mm == 0) ? p.in[8] + (size_t)l * 64 * 1024 : (mm == 1) ? p.in[10] + (size_t)l * 64 * 1024 : (mm == 2) ? p.in[11] + (size_t)l * 128 * 1024 : p.in[20];
#pragma unroll
        for (int n2 = 0; n2 < 2; ++n2)
#pragma unroll
            for (int ks = 0; ks < 4; ++ks) {
                bf16x8 f;
#pragma unroll
                for (int j = 0; j < 8; ++j) {
                    const bool okw = ks < nks && (mm < 3 || l > 0);
                    const float v = wsrc[(size_t)(okw ? (ks * 32 + fq * 8 + j) : 0) * 1024 + hc + (ntb + n2) * 16 + fr];
                    f[j] = (short)f2bf(okw ? v : 0.f);
                }
                Bw[n2][ks] = f;
            }
    }
    const f32x4 z4 = {0.f, 0.f, 0.f, 0.f};
    f32x4 S[4] = {z4, z4, z4, z4};
    sh4 Lf;
#pragma unroll
    for (int j = 0; j < 4; ++j) Lf[j] = (fq * 4 + j <= fr) ? (short)0x3F80 : (short)0;
    bf16_t* Pr = (bf16_t*)(WS(p) + OFF_PR);
    bf16_t* vfirst = (bf16_t*)(WS(p) + OFF_VFIRST);
    const unsigned char* psrc[5]; int pstep[5], ptau[5]; bool pval[5];
#pragma unroll
    for (int k = 0; k < 5; ++k) {
        const int pi = tid + k * NTHR;
        bool ok = false;
        psrc[k] = scan_piece_src(p, l, b, hc, 0, pi < SC_TC * 68 ? pi : 0, ok);
        const int tau = (pi < SC_TC * 68 ? pi : 0) / 68, seg = (pi < SC_TC * 68 ? pi : 0) - tau * 68;
        ptau[k] = tau;
        pstep[k] = SC_TC * ((seg >= 24 && seg < 60) ? 576 : 2048);
        pval[k] = (pi < SC_TC * 68) && !(seg >= 60 && l == 0);
    }
    uint4 pre[5];
#pragma unroll
    for (int k = 0; k < 5; ++k) { pre[k] = make_uint4(0, 0, 0, 0); if (pval[k] && ptau[k] < TS) pre[k] = *(const uint4*)psrc[k]; }
    __syncthreads();
    auto stepE = [&](int tau, int c4, const float* so, const float* sv, const float* sgp, const float* sb, int t0e, int nve) {
        const int e = tau * 64 + c4;
        const size_t n = (size_t)b * TS + t0e + tau;
        const float4 o4 = *(const float4*)(so + e), v4_ = *(const float4*)(sv + e), g4_ = *(const float4*)(sgp + e);
        const float4 clw = *(const float4*)(cst + 800 + c4), clb = *(const float4*)(cst + 864 + c4);
        const float bsum = sb[tau];
        const float m_ = row16_sum((o4.x + o4.y) + (o4.z + o4.w)) * (1.0f / 64.0f);
        const float d0 = o4.x - m_, d1 = o4.y - m_, d2 = o4.z - m_, d3 = o4.w - m_;
        const float var = row16_sum(d0 * d0 + d1 * d1 + d2 * d2 + d3 * d3) * (1.0f / 64.0f);
        const float rs = rsqrtf(var + 64e-5f);
        const float y0 = (d0 * rs * clw.x + clb.x + bsum * v4_.x) * g4_.x, y1 = (d1 * rs * clw.y + clb.y + bsum * v4_.y) * g4_.y;
        const float y2 = (d2 * rs * clw.z + clb.z + bsum * v4_.z) * g4_.z, y3 = (d3 * rs * clw.w + clb.w + bsum * v4_.w) * g4_.w;
        if (tau < nve) *(uint2*)(Pr + n * 1024 + hc + c4) = pack4(y0, y1, y2, y3);
    };
#pragma unroll 1
    for (int t0 = 0, ch = 0; t0 < TS; t0 += SC_TC, ++ch) {
        const int nval = (TS - t0 < SC_TC) ? (TS - t0) : SC_TC;
        const bool par = (ch & 1) != 0;
        float* g_c = par ? s_gB : s_g; float* o_c = par ? s_oB : s_o; float* v_c = par ? s_vB : s_v; float* bs_c = s_bs2 + (par ? 32 : 0);
        float* g_p = par ? s_g : s_gB; float* o_p = par ? s_o : s_oB; float* v_p = par ? s_v : s_vB; float* bs_p = s_bs2 + (par ? 0 : 32);
#pragma unroll
        for (int k = 0; k < 5; ++k) { const int pi = tid + k * NTHR; if (pi < SC_TC * 68) *(uint4*)(raw + pi * 16) = pre[k]; }
        lds_barrier();
#pragma unroll
        for (int k = 0; k < 5; ++k) {
            pre[k] = make_uint4(0, 0, 0, 0);
            if (pval[k] && t0 + SC_TC + ptau[k] < TS) pre[k] = *(const uint4*)(psrc[k] + (size_t)(ch + 1) * pstep[k]);
        }
        if (mm < 3 || l > 0) {
            const unsigned char* Ab = raw + ((mm == 0) ? 384 : (mm == 1) ? 512 : (mm == 2) ? 640 : 896);
            float* dst = (mm == 0) ? s_w : (mm == 1) ? s_a : (mm == 2) ? g_c : o_c;
#pragma unroll
            for (int m = 0; m < 2; ++m) {
                f32x4 acc0 = {0.f, 0.f, 0.f, 0.f}, acc1 = {0.f, 0.f, 0.f, 0.f};
#pragma unroll
                for (int ks = 0; ks < 4; ++ks) {
                    if (ks < nks) {
                        const bf16x8 a = *(const bf16x8*)(Ab + (m * 16 + fr) * SC_ROWB + ks * 64 + fq * 16);
                        acc0 = __builtin_amdgcn_mfma_f32_16x16x32_bf16(a, Bw[0][ks], acc0, 0, 0, 0);
                        acc1 = __builtin_amdgcn_mfma_f32_16x16x32_bf16(a, Bw[1][ks], acc1, 0, 0, 0);
                    }
                }
                if (mm == 0) {
                    const float cw0 = cst[480 + ntb * 16 + fr], cw1 = cst[480 + (ntb + 1) * 16 + fr];
                    f32x4 l0, l1, r0, r1;
#pragma unroll
                    for (int j = 0; j < 4; ++j) { l0[j] = -0.6065306597126334f * fast_sigmoid(acc0[j] + cw0); l1[j] = -0.6065306597126334f * fast_sigmoid(acc1[j] + cw1); }
                    const uint2 h0 = pack4(l0[0], l0[1], l0[2], l0[3]), h1 = pack4(l1[0], l1[1], l1[2], l1[3]);
                    r0[0] = l0[0] - __uint_as_float(h0.x << 16); r0[1] = l0[1] - __uint_as_float(h0.x & 0xFFFF0000u); r0[2] = l0[2] - __uint_as_float(h0.y << 16); r0[3] = l0[3] - __uint_as_float(h0.y & 0xFFFF0000u);
                    r1[0] = l1[0] - __uint_as_float(h1.x << 16); r1[1] = l1[1] - __uint_as_float(h1.x & 0xFFFF0000u); r1[2] = l1[2] - __uint_as_float(h1.y << 16); r1[3] = l1[3] - __uint_as_float(h1.y & 0xFFFF0000u);
                    sh4 hh0, hh1; __builtin_memcpy(&hh0, &h0, 8); __builtin_memcpy(&hh1, &h1, 8);
                    f32x4 c0 = MF16(Lf, pk4v(r0), z4), c1 = MF16(Lf, pk4v(r1), z4);
                    c0 = MF16(Lf, hh0, c0); c1 = MF16(Lf, hh1, c1);
#pragma unroll
                    for (int j = 0; j < 4; ++j) {
                        const int eo = (m * 16 + fq * 4 + j) * 64 + ntb * 16 + fr;
                        s_w[eo] = c0[j]; s_w[eo + 16] = c1[j];
                        s_b[eo] = l0[j]; s_b[eo + 16] = l1[j];
                    }
                } else {
#pragma unroll
                    for (int j = 0; j < 4; ++j) {
                        dst[(m * 16 + fq * 4 + j) * 64 + ntb * 16 + fr] = acc0[j];
                        dst[(m * 16 + fq * 4 + j) * 64 + (ntb + 1) * 16 + fr] = acc1[j];
                    }
                }
            }
        }
        lds_barrier();
        {
            const int tau = tid >> 4, c4 = (tid & 15) * 4, e = tau * 64 + c4, t = t0 + tau;
            const size_t n = (size_t)b * TS + t;
            const float4 cum4 = *(const float4*)(s_w + e), lw4 = *(const float4*)(s_b + e), xa4 = *(const float4*)(s_a + e);
            const float4 ca = *(const float4*)(cst + 544 + c4), ckk = *(const float4*)(cst + 608 + c4), cka = *(const float4*)(cst + 672 + c4), crk = *(const float4*)(cst + 736 + c4);
            const float cum[4] = {cum4.x, cum4.y, cum4.z, cum4.w}, lw[4] = {lw4.x, lw4.y, lw4.z, lw4.w};
            const float xa[4] = {xa4.x + ca.x, xa4.y + ca.y, xa4.z + ca.z, xa4.w + ca.w};
            const float kkc[4] = {ckk.x, ckk.y, ckk.z, ckk.w}, kac[4] = {cka.x, cka.y, cka.z, cka.w};
            float rr[4], kr[4], vv[4];
            {
                const unsigned char* rc = raw + tau * SC_ROWB + c4 * 2;
                const uint2 cr = *(const uint2*)rc, ck = *(const uint2*)(rc + 128), cv = *(const uint2*)(rc + 256);
                uint2 qr = make_uint2(0u, 0u), qk = qr, qv = qr;
                if (tau > 0) { qr = *(const uint2*)(rc - SC_ROWB); qk = *(const uint2*)(rc - SC_ROWB + 128); qv = *(const uint2*)(rc - SC_ROWB + 256); }
                else if (t0 > 0) { const unsigned* pvr = prevr + ((ch + 1) & 1) * 96 + (c4 >> 1); qr = *(const uint2*)pvr; qk = *(const uint2*)(pvr + 32); qv = *(const uint2*)(pvr + 64); }
                if (tau == SC_TC - 1) { unsigned* pwr = prevr + (ch & 1) * 96 + (c4 >> 1); *(uint2*)pwr = cr; *(uint2*)(pwr + 32) = ck; *(uint2*)(pwr + 64) = cv; }
                const float4 mr = *(const float4*)(cst + c4), mk = *(const float4*)(cst + 64 + c4), mv = *(const float4*)(cst + 128 + c4);
                const float c_[12] = {__uint_as_float(cr.x << 16), __uint_as_float(cr.x & 0xFFFF0000u), __uint_as_float(cr.y << 16), __uint_as_float(cr.y & 0xFFFF0000u),
                                      __uint_as_float(ck.x << 16), __uint_as_float(ck.x & 0xFFFF0000u), __uint_as_float(ck.y << 16), __uint_as_float(ck.y & 0xFFFF0000u),
                                      __uint_as_float(cv.x << 16), __uint_as_float(cv.x & 0xFFFF0000u), __uint_as_float(cv.y << 16), __uint_as_float(cv.y & 0xFFFF0000u)};
                const float q_[12] = {__uint_as_float(qr.x << 16), __uint_as_float(qr.x & 0xFFFF0000u), __uint_as_float(qr.y << 16), __uint_as_float(qr.y & 0xFFFF0000u),
                                      __uint_as_float(qk.x << 16), __uint_as_float(qk.x & 0xFFFF0000u), __uint_as_float(qk.y << 16), __uint_as_float(qk.y & 0xFFFF0000u),
                                      __uint_as_float(qv.x << 16), __uint_as_float(qv.x & 0xFFFF0000u), __uint_as_float(qv.y << 16), __uint_as_float(qv.y & 0xFFFF0000u)};
                const float m_[12] = {mr.x, mr.y, mr.z, mr.w, mk.x, mk.y, mk.z, mk.w, mv.x, mv.y, mv.z, mv.w};
#pragma unroll
                for (int j = 0; j < 4; ++j) { rr[j] = c_[j] + (q_[j] - c_[j]) * m_[j]; kr[j] = c_[4 + j] + (q_[4 + j] - c_[4 + j]) * m_[4 + j]; vv[j] = c_[8 + j] + (q_[8 + j] - c_[8 + j]) * m_[8 + j]; }
            }
            if (l > 0) {
                const float4 xv4 = *(const float4*)(o_c + e), cv = *(const float4*)(cst + 928 + c4);
                const uint2 vfu = *(const uint2*)(raw + tau * SC_ROWB + 960 + c4 * 2);
                const float vf[4] = {__uint_as_float(vfu.x << 16), __uint_as_float(vfu.x & 0xFFFF0000u), __uint_as_float(vfu.y << 16), __uint_as_float(vfu.y & 0xFFFF0000u)};
                const float xv[4] = {xv4.x + cv.x, xv4.y + cv.y, xv4.z + cv.z, xv4.w + cv.w};
#pragma unroll
                for (int j = 0; j < 4; ++j) vv[j] = vv[j] + (vf[j] - vv[j]) * fast_sigmoid(xv[j]);
            } else if (t < TS) {
                *(uint2*)(vfirst + n * 1024 + hc + c4) = pack4(vv[0], vv[1], vv[2], vv[3]);
            }
            float av[4], kkv[4], ginc[4], gexc[4], ginv[4]; float ss = 0.f;
#pragma unroll
            for (int j = 0; j < 4; ++j) {
                ginc[j] = __expf(cum[j]); gexc[j] = __expf(cum[j] - lw[j]); ginv[j] = __expf(-cum[j]);
                av[j] = fast_sigmoid(xa[j]);
                kkv[j] = kr[j] * kkc[j];
                ss += kkv[j] * kkv[j];
            }
            float kk[4], kt[4];
#pragma unroll
            for (int j = 0; j < 4; ++j) kt[j] = kr[j] * (1.0f + (av[j] - 1.0f) * kac[j]);
            float bsum = rr[0] * kt[0] * crk.x + rr[1] * kt[1] * crk.y + rr[2] * kt[2] * crk.z + rr[3] * kt[3] * crk.w;
            float du0 = 0.f, du1 = 0.f;
            row16_sum4(ss, bsum, du0, du1);
            if ((tid & 15) == 0) bs_c[tau] = bsum;
            const float rn = rsqrtf(fmaxf(ss, 1e-24f));
#pragma unroll
            for (int j = 0; j < 4; ++j) kk[j] = kkv[j] * rn;
            const uint2 pa = pack4(-kk[0] * gexc[0], -kk[1] * gexc[1], -kk[2] * gexc[2], -kk[3] * gexc[3]);
            const uint2 pr = pack4(rr[0] * ginc[0], rr[1] * ginc[1], rr[2] * ginc[2], rr[3] * ginc[3]);
            const uint2 pb = pack4(kk[0] * av[0] * ginv[0], kk[1] * av[1] * ginv[1], kk[2] * av[2] * ginv[2], kk[3] * av[3] * ginv[3]);
            const uint2 pk = pack4(kt[0] * ginv[0], kt[1] * ginv[1], kt[2] * ginv[2], kt[3] * ginv[3]);
            const uint2 pv = pack4(vv[0], vv[1], vv[2], vv[3]);
            *(uint2*)(o_at + tau * SC_LT + c4) = pa;
            *(uint2*)(o_rt + tau * SC_LT + c4) = pr;
            *(uint2*)(o_bt + tau * SC_LT + c4) = pb;
            *(uint2*)(o_kt + tau * SC_LT + c4) = pk;
            o_bT[(c4 + 0) * SC_LS + tau] = (bf16_t)(pb.x & 0xFFFFu); o_bT[(c4 + 1) * SC_LS + tau] = (bf16_t)(pb.x >> 16); o_bT[(c4 + 2) * SC_LS + tau] = (bf16_t)(pb.y & 0xFFFFu); o_bT[(c4 + 3) * SC_LS + tau] = (bf16_t)(pb.y >> 16);
            o_kT[(c4 + 0) * SC_LS + tau] = (bf16_t)(pk.x & 0xFFFFu); o_kT[(c4 + 1) * SC_LS + tau] = (bf16_t)(pk.x >> 16); o_kT[(c4 + 2) * SC_LS + tau] = (bf16_t)(pk.y & 0xFFFFu); o_kT[(c4 + 3) * SC_LS + tau] = (bf16_t)(pk.y >> 16);
            o_vT[(c4 + 0) * SC_LS + tau] = (bf16_t)(pv.x & 0xFFFFu); o_vT[(c4 + 1) * SC_LS + tau] = (bf16_t)(pv.x >> 16); o_vT[(c4 + 2) * SC_LS + tau] = (bf16_t)(pv.y & 0xFFFFu); o_vT[(c4 + 3) * SC_LS + tau] = (bf16_t)(pv.y >> 16);
            if ((tau & 15) == 15) *(float4*)(s_gc + (tau >> 4) * 64 + c4) = make_float4(ginc[0], ginc[1], ginc[2], ginc[3]);
            *(float4*)(v_c + e) = make_float4(vv[0], vv[1], vv[2], vv[3]);
        }
        lds_barrier();
        if (wid < 4) {
#pragma unroll 1
            for (int sc = 0; sc < 2; ++sc) {
                if (sc * 16 < nval) {
                    const bf16_t* ar = o_at + (sc * 16 + fr) * SC_LT;
                    const bf16_t* rr_ = o_rt + (sc * 16 + fr) * SC_LT;
                    const bf16_t* br = o_bt + (sc * 16 + fr) * SC_LT;
                    const bf16_t* kr_ = o_kt + (sc * 16 + fr) * SC_LT;
                    const bf16x8 fa0 = *(const bf16x8*)(ar + fq * 8), fa1 = *(const bf16x8*)(ar + 32 + fq * 8);
                    const bf16x8 fb0 = *(const bf16x8*)(br + fq * 8), fb1 = *(const bf16x8*)(br + 32 + fq * 8);
                    const bf16x8 fk0 = *(const bf16x8*)(kr_ + fq * 8), fk1 = *(const bf16x8*)(kr_ + 32 + fq * 8);
                    const bf16x8 fr0 = *(const bf16x8*)(rr_ + fq * 8), fr1 = *(const bf16x8*)(rr_ + 32 + fq * 8);
                    f32x4 nA = MF32(fb0, fa0, z4); nA = MF32(fb1, fa1, nA);
                    f32x4 nB = MF32(fa0, fb0, z4); nB = MF32(fa1, fb1, nB);
                    f32x4 mak = MF32(fk0, fa0, z4); mak = MF32(fk1, fa1, mak);
                    f32x4 mbr = MF32(fb0, fr0, z4); mbr = MF32(fb1, fr1, mbr);
                    f32x4 mkr = MF32(fk0, fr0, z4); mkr = MF32(fk1, fr1, mkr);
#pragma unroll
                    for (int j = 0; j < 4; ++j) {
                        const int s_ = fq * 4 + j;
                        nA[j] = (s_ < fr) ? nA[j] : 0.f; nB[j] = (fr < s_) ? nB[j] : 0.f; mak[j] = (s_ < fr) ? mak[j] : 0.f;
                        mbr[j] = (s_ <= fr) ? mbr[j] : 0.f; mkr[j] = (s_ <= fr) ? mkr[j] : 0.f;
                    }
                    const sh4 pNA = pk4v(nA), pNB = pk4v(nB), pMak = pk4v(mak), pMbr = pk4v(mbr), pMkr = pk4v(mkr);
                    const f32x4 n2B = MF16(pNA, pNB, z4), n2A = MF16(pNB, pNA, z4);
                    const sh4 pN2A = pk4v(n2A), pN2B = pk4v(n2B);
                    const f32x4 n4B = MF16(pN2A, pN2B, z4), n4A = MF16(pN2B, pN2A, z4);
                    const sh4 pN4A = pk4v(n4A), pN4B = pk4v(n4B);
                    const sh4 pN8A = pk4v(MF16(pN4B, pN4A, z4));
                    const bf16x8 sB0 = cat8(pk4v(S[0]), pk4v(S[1])), sB1 = cat8(pk4v(S[2]), pk4v(S[3]));
                    const sh4 vf = *(const sh4*)(o_vT + (wid * 16 + fr) * SC_LS + sc * 16 + fq * 4);
                    f32x4 X = MF32(cat8(*(const sh4*)(ar + fq * 4), *(const sh4*)(ar + 16 + fq * 4)), sB0, z4);
                    X = MF32(cat8(*(const sh4*)(ar + 32 + fq * 4), *(const sh4*)(ar + 48 + fq * 4)), sB1, X);
                    X = MF16(pMak, vf, X);
                    X = MF16(pN8A, pk4v(X), X); X = MF16(pN4A, pk4v(X), X); X = MF16(pN2A, pk4v(X), X); X = MF16(pNA, pk4v(X), X);
                    const sh4 pSA = pk4v(X);
                    f32x4 O = MF32(cat8(*(const sh4*)(rr_ + fq * 4), *(const sh4*)(rr_ + 16 + fq * 4)), sB0, z4);
                    O = MF32(cat8(*(const sh4*)(rr_ + 32 + fq * 4), *(const sh4*)(rr_ + 48 + fq * 4)), sB1, O);
                    const bf16x8 sav = cat8(pSA, vf);
                    O = MF32(cat8(pMbr, pMkr), sav, O);
#pragma unroll
                    for (int j = 0; j < 4; ++j) o_c[(sc * 16 + fq * 4 + j) * 64 + wid * 16 + fr] = O[j];
#pragma unroll
                    for (int jt = 0; jt < 4; ++jt) {
                        const sh4 ka = *(const sh4*)(o_kT + (jt * 16 + fr) * SC_LS + sc * 16 + fq * 4), ba = *(const sh4*)(o_bT + (jt * 16 + fr) * SC_LS + sc * 16 + fq * 4);
                        f32x4 acc = MF32(cat8(ba, ka), sav, S[jt]);
                        const float4 g4 = *(const float4*)(s_gc + sc * 64 + jt * 16 + fq * 4);
                        acc[0] *= g4.x; acc[1] *= g4.y; acc[2] *= g4.z; acc[3] *= g4.w;
                        S[jt] = acc;
                    }
                }
            }
        } else if (ch > 0) {
            const int t2 = otid() - 256;
            stepE(t2 >> 4, (t2 & 15) * 4, o_p, v_p, g_p, bs_p, t0 - SC_TC, SC_TC);
            stepE(16 + (t2 >> 4), (t2 & 15) * 4, o_p, v_p, g_p, bs_p, t0 - SC_TC, SC_TC);
        }
        lds_barrier();
    }
    {
        const int chl = (TS + SC_TC - 1) / SC_TC - 1; const bool parl = (chl & 1) != 0;
        stepE(tid >> 4, (tid & 15) * 4, parl ? s_oB : s_o, parl ? s_vB : s_v, parl ? s_gB : s_g, s_bs2 + (parl ? 32 : 0), chl * SC_TC, TS - chl * SC_TC);
    }
}
__device__ __forceinline__ void xcd_panel_map(int& mt0, int& mstep, int& nt) {
    const int b = obid(), G = (int)gridDim.x;
    if (G == 256) { nt = (b >> 3) & 7; mt0 = (b & 7) * 4 + (b >> 6); mstep = 32; }
    else { nt = b & 7; mt0 = b >> 3; mstep = G >> 3; }
}
__device__ void phase_merge(const Params& p, unsigned char* lds) {
    const int tid = otid(), lane = tid & 63, wid = tid >> 6, wr = wid >> 1, wc = wid & 1, fr = lane & 15, fq = lane >> 4;
    const bf16_t* h = (const bf16_t*)(WS(p) + OFF_H);
    const bf16_t* wb = (const bf16_t*)(WS(p) + OFF_WB);
    const float* rstd = (const float*)(WS(p) + OFF_RSTD);
    bf16_t* merged = (bf16_t*)(WS(p) + OFF_MERGED);
    const bf16_t* ysrc0 = (const bf16_t*)(WS(p) + OFF_PPOOL);
    const bf16_t* ysrc1 = (const bf16_t*)(WS(p) + OFF_PR);
    const bf16_t* ysrc2 = (const bf16_t*)(OUTB(p) + DO_YC);
    for (int tile = obid(); tile < 86 * 8; tile += gridDim.x) {
        const int mt = tile >> 3, nt = tile & 7;
        const int row0 = mt * 192, col0 = nt * 128;
        uint2 maccp[3][4];
#pragma unroll
        for (int m = 0; m < 3; ++m)
#pragma unroll
            for (int n = 0; n < 4; ++n) maccp[m][n] = make_uint2(0u, 0u);
#pragma unroll 1
        for (int i = 0; i < 3; ++i) {
            const int tid = otid();
            const bf16_t* ys = (i == 0) ? ysrc0 : (i == 1 ? ysrc1 : ysrc2);
            uint2 sg[3][4];
            {
                f32x4 ag[3][4]; g3_zero<3>(ag);
                G3<192> g;
                g3_setup<192>(g, [&](int r) { return h + (size_t)(row0 + r) * DM; }, [&](int r) { return wb + WB_WG + (size_t)(i * 1024 + col0 + r) * DM; }, tid);
                g3_kloop<192>(ag, g, DM, lds);
#pragma unroll
                for (int m = 0; m < 3; ++m) {
                    const float rs = rstd[row0 + wr * 48 + m * 16 + fr];
#pragma unroll
                    for (int n = 0; n < 4; ++n) sg[m][n] = pack4(fast_sigmoid(ag[m][n][0] * rs), fast_sigmoid(ag[m][n][1] * rs), fast_sigmoid(ag[m][n][2] * rs), fast_sigmoid(ag[m][n][3] * rs));
                }
            }
            {
                f32x4 ay[3][4]; g3_zero<3>(ay);
                G3<192> g;
                g3_setup<192>(g, [&](int r) { return ys + (size_t)(row0 + r) * DM; }, [&](int r) { return wb + WB_PA + (size_t)(i * 1024 + col0 + r) * DM; }, tid);
                g3_kloop<192>(ay, g, DM, lds);
#pragma unroll
                for (int m = 0; m < 3; ++m)
#pragma unroll
                    for (int n = 0; n < 4; ++n) {
                        const float m0 = __uint_as_float(maccp[m][n].x << 16) + __uint_as_float(sg[m][n].x << 16) * ay[m][n][0];
                        const float m1 = __uint_as_float(maccp[m][n].x & 0xFFFF0000u) + __uint_as_float(sg[m][n].x & 0xFFFF0000u) * ay[m][n][1];
                        const float m2 = __uint_as_float(maccp[m][n].y << 16) + __uint_as_float(sg[m][n].y << 16) * ay[m][n][2];
                        const float m3 = __uint_as_float(maccp[m][n].y & 0xFFFF0000u) + __uint_as_float(sg[m][n].y & 0xFFFF0000u) * ay[m][n][3];
                        maccp[m][n] = pack4(m0, m1, m2, m3);
                    }
            }
        }
#pragma unroll
        for (int m = 0; m < 3; ++m) {
            const int row = row0 + wr * 48 + m * 16 + fr;
#pragma unroll
            for (int n = 0; n < 4; ++n)
                *(uint2*)(merged + (size_t)row * 1024 + col0 + wc * 64 + n * 16 + fq * 4) = maccp[m][n];
        }
    }
}

__device__ void phase_outproj(const Params& p, unsigned char* lds) {
    const int tid = otid(), lane = tid & 63, wid = tid >> 6, wr = wid >> 1, wc = wid & 1, fr = lane & 15, fq = lane >> 4;
    const bf16_t* h = (const bf16_t*)(WS(p) + OFF_H);
    const bf16_t* wb = (const bf16_t*)(WS(p) + OFF_WB);
    const bf16_t* merged = (const bf16_t*)(WS(p) + OFF_MERGED);
    float* hm = (float*)(WS(p) + OFF_HM32);
    int mt0, mstep, nt;
    xcd_panel_map(mt0, mstep, nt);
    for (int mt = mt0; mt < 86; mt += mstep) {
        const int row0 = mt * 192, col0 = nt * 128;
        G3<192> g;
        g3_setup<192>(g, [&](int r) { return merged + (size_t)(row0 + r) * DM; }, [&](int r) { return wb + WB_WO + (size_t)(col0 + r) * DM; }, tid);
        f32x4 acc[3][4]; g3_zero<3>(acc);
        g3_kloop<192>(acc, g, DM, lds);
        uint2 hres[3][4];
#pragma unroll
        for (int m = 0; m < 3; ++m)
#pragma unroll
            for (int n = 0; n < 4; ++n) hres[m][n] = *(const uint2*)(h + (size_t)(row0 + wr * 48 + m * 16 + fr) * 1024 + col0 + wc * 64 + n * 16 + fq * 4);
#pragma unroll
        for (int m = 0; m < 3; ++m) {
            const int row = row0 + wr * 48 + m * 16 + fr;
#pragma unroll
            for (int n = 0; n < 4; ++n) {
                const int col = col0 + wc * 64 + n * 16 + fq * 4;
                const uint2 hv = hres[m][n];
                float4 o;
                o.x = __uint_as_float(hv.x << 16) + acc[m][n][0]; o.y = __uint_as_float(hv.x & 0xFFFF0000u) + acc[m][n][1];
                o.z = __uint_as_float(hv.y << 16) + acc[m][n][2]; o.w = __uint_as_float(hv.y & 0xFFFF0000u) + acc[m][n][3];
                *(float4*)(hm + (size_t)row * 1024 + col) = o;
            }
        }
    }
}

__device__ __constant__ int c_pair_lo[6] = {0, 0, 0, 1, 1, 2};
__device__ __constant__ int c_pair_hi[6] = {1, 2, 3, 2, 3, 3};
__device__ void phase_route(const Params& p, int l, unsigned char* lds) {
    const int tid = otid(), lane = tid & 63, wid = tid >> 6;
    const int per = (NT + (int)gridDim.x - 1) / (int)gridDim.x;
    const int nbeg = obid() * per, nend = (nbeg + per < NT) ? nbeg + per : NT;
    int* s_cls = (int*)lds;
    int* s_base = s_cls + 512;
    float* s_wr = (float*)(lds + 4096);
    const float* hm = (const float*)(WS(p) + OFF_HM32);
    bf16_t* hn = (bf16_t*)(WS(p) + OFF_HN);
    const float* nf = p.in[33] + (size_t)l * 1024;
    const float* wg = p.in[34] + (size_t)l * 1024 * 4;
    const float* bg = p.in[35] + l * 4;
    const float* we = p.in[36] + (size_t)l * 1024 * 16;
    const float* be = p.in[37] + l * 16;
    int* cnt = (int*)(WS(p) + OFF_CTL);
    int* list = (int*)(WS(p) + OFF_LIST);
    float* pw = (float*)(WS(p) + OFF_PW);
    for (int e = tid; e < 1024 * 20; e += NTHR) {
        const int k = e / 20, c = e - k * 20;
        s_wr[c * 1024 + k] = (c < 4) ? wg[(size_t)k * 4 + c] : we[(size_t)k * 16 + (c - 4)];
    }
    __syncthreads();
    float4 nv[4], cur[4];
#pragma unroll
    for (int i = 0; i < 4; ++i) nv[i] = *(const float4*)(nf + i * 256 + lane * 4);
    if (nbeg + wid < nend) {
#pragma unroll
        for (int i = 0; i < 4; ++i) cur[i] = *(const float4*)(hm + (size_t)(nbeg + wid) * DM + i * 256 + lane * 4);
    }
    for (int n = nbeg + wid; n < nend; n += 8) {
        float4 xv[4]; float ss = 0.f;
#pragma unroll
        for (int i = 0; i < 4; ++i) { xv[i] = cur[i]; ss += xv[i].x * xv[i].x + xv[i].y * xv[i].y + xv[i].z * xv[i].z + xv[i].w * xv[i].w; }
        if (n + 8 < nend) {
#pragma unroll
            for (int i = 0; i < 4; ++i) cur[i] = *(const float4*)(hm + (size_t)(n + 8) * DM + i * 256 + lane * 4);
        }
        ss = wave_sum_fast(ss);
        const float rs = rsqrtf(ss * (1.0f / 1024.0f) + 1e-6f);
        float lg[4] = {0.f, 0.f, 0.f, 0.f};
        float le[16];
#pragma unroll
        for (int e = 0; e < 16; ++e) le[e] = 0.f;
#pragma unroll
        for (int i = 0; i < 4; ++i) {
            float y[4] = {xv[i].x * rs * nv[i].x, xv[i].y * rs * nv[i].y, xv[i].z * rs * nv[i].z, xv[i].w * rs * nv[i].w};
            {
                const int d0 = i * 256 + lane * 4;
#pragma unroll
                for (int g = 0; g < 4; ++g) { const float4 w4 = *(const float4*)(s_wr + g * 1024 + d0); lg[g] += y[0] * w4.x + y[1] * w4.y + y[2] * w4.z + y[3] * w4.w; }
#pragma unroll
                for (int e = 0; e < 16; ++e) { const float4 w4 = *(const float4*)(s_wr + (4 + e) * 1024 + d0); le[e] += y[0] * w4.x + y[1] * w4.y + y[2] * w4.z + y[3] * w4.w; }
            }
            *(uint2*)(hn + (size_t)n * DM + i * 256 + lane * 4) = pack4(y[0], y[1], y[2], y[3]);
        }
#pragma unroll
        for (int g = 0; g < 4; ++g) lg[g] = wave_sum_fast(lg[g]) + bg[g];
#pragma unroll
        for (int e = 0; e < 16; ++e) le[e] = wave_sum_fast(le[e]) + be[e];
        if (lane == 0) {
            int gs = 0; float gm = lg[0];
#pragma unroll
            for (int g = 1; g < 4; ++g) if (lg[g] > gm) { gm = lg[g]; gs = g; }
            float den = 0.f;
#pragma unroll
            for (int g = 0; g < 4; ++g) den += __expf(lg[g] - gm);
            const float pgrp = 1.0f / den;
            float v4[4];
#pragma unroll
            for (int e = 0; e < 4; ++e) {
                const float m0 = (gs == 0) ? 1.f : 0.f, m1s = (gs == 1) ? 1.f : 0.f, m2s = (gs == 2) ? 1.f : 0.f, m3s = (gs == 3) ? 1.f : 0.f;
                v4[e] = le[e] * m0 + le[4 + e] * m1s + le[8 + e] * m2s + le[12 + e] * m3s;
            }
            int i1 = 0; float m1 = v4[0];
#pragma unroll
            for (int e = 1; e < 4; ++e) if (v4[e] > m1) { m1 = v4[e]; i1 = e; }
            int i2 = -1; float m2 = -INFINITY;
#pragma unroll
            for (int e = 0; e < 4; ++e) if (e != i1 && v4[e] > m2) { m2 = v4[e]; i2 = e; }
            const float e2 = __expf(m2 - m1);
            const float p1 = pgrp / (1.0f + e2), p2 = pgrp * e2 / (1.0f + e2);
            const int lo = i1 < i2 ? i1 : i2, hi = i1 < i2 ? i2 : i1;
            const float plo = i1 < i2 ? p1 : p2, phi = i1 < i2 ? p2 : p1;
            const int pi = (lo == 0) ? (hi - 1) : (lo == 1 ? hi + 1 : 5);
            const int cls = gs * 6 + pi;
            s_cls[n - nbeg] = cls;
            pw[(size_t)n * 2 + 0] = plo; pw[(size_t)n * 2 + 1] = phi;
        }
    }
    __syncthreads();
    const int nloc = nend - nbeg;
    if (tid < 24) {
        int c_ = 0;
        for (int i = 0; i < nloc; ++i) c_ += (s_cls[i] == tid) ? 1 : 0;
        s_base[tid] = c_ ? atomicAdd(&cnt[tid * 32], c_) : 0;
    }
    __syncthreads();
    for (int it = tid; it < nloc; it += NTHR) {
        const int cls = s_cls[it];
        int rank = 0;
        for (int i = 0; i < it; ++i) rank += (s_cls[i] == cls) ? 1 : 0;
        list[(size_t)cls * NT + s_base[cls] + rank] = nbeg + it;
    }
    __syncthreads();
}


struct MoeTile { int cls, ti, cnt, tg; };
__device__ __forceinline__ int moe_table(const int* cnt, unsigned char* lds) {
    int* tab = (int*)(lds + LDS_BYTES - 512);
    __syncthreads();
    if (otid() < 24) tab[otid()] = cnt[otid() * 32];
    __syncthreads();
    if (otid() == 0) { int s_ = 0; for (int c = 0; c < 24; ++c) { tab[24 + c] = s_; s_ += (tab[c] + 127) >> 7; } tab[48] = s_; }
    __syncthreads();
    return tab[48];
}
__device__ __forceinline__ MoeTile moe_find(const unsigned char* lds, int tile) {
    const int* tab = (const int*)(lds + LDS_BYTES - 512);
    MoeTile r; r.cls = 0; r.ti = 0; r.cnt = 0; r.tg = tile;
    for (int c = 0; c < 24; ++c) { const int s_ = tab[24 + c], e_ = tab[25 + c]; if (tile >= s_ && tile < e_) { r.cls = c; r.ti = tile - s_; r.cnt = tab[c]; } }
    return r;
}
__device__ void phase_moe1(const Params& p, unsigned char* lds) {
    const int tid = otid(), lane = tid & 63, wid = tid >> 6, wr = wid >> 1, wc = wid & 1, fr = lane & 15, fq = lane >> 4;
    const int* cnt = (const int*)(WS(p) + OFF_CTL);
    const int* list = (const int*)(WS(p) + OFF_LIST);
    const float* pw = (const float*)(WS(p) + OFF_PW);
    const bf16_t* hn = (const bf16_t*)(WS(p) + OFF_HN);
    const bf16_t* we = (const bf16_t*)(WS(p) + OFF_WEXP);
    bf16_t* hid = (bf16_t*)(OUTB(p) + DO_HID);
    const int total = moe_table(cnt, lds);
    for (int item = obid(); item < total * 4; item += gridDim.x) {
        const MoeTile mt = moe_find(lds, item >> 2);
        const int nt = item & 3, slot = nt >> 1, f0 = (nt & 1) * 128;
        const int g_ = mt.cls / 6, pi = mt.cls % 6;
        const int e = g_ * 4 + (slot == 0 ? c_pair_lo[pi] : c_pair_hi[pi]);
        const int* lst = list + (size_t)mt.cls * NT + mt.ti * 128;
        const int nvalid = min(128, mt.cnt - mt.ti * 128);
        f32x4 a1[2][4], a3[2][4]; g3_zero<2>(a1); g3_zero<2>(a3);
        G3D g;
#pragma unroll
        for (int i = 0; i < 2; ++i) {
            const int idx = tid + i * NTHR, row = idx >> 3, sl = (idx & 7) ^ (row & 7);
            g.ap[i] = hn + (size_t)lst[row < nvalid ? row : 0] * DM + sl * 8;
            g.b1[i] = we + WE_W1 + ((size_t)e * 256 + f0 + row) * 1024 + sl * 8;
            g.b3[i] = we + WE_W3 + ((size_t)e * 256 + f0 + row) * 1024 + sl * 8;
        }
        g3d_kloop(a1, a3, g, DM, lds);
        float pev[2];
#pragma unroll
        for (int m = 0; m < 2; ++m) { const int lr = wr * 32 + m * 16 + fr; pev[m] = pw[(size_t)lst[lr < nvalid ? lr : 0] * 2 + slot]; }
#pragma unroll
        for (int m = 0; m < 2; ++m) {
            const int lr = wr * 32 + m * 16 + fr;
            const float pe = pev[m];
#pragma unroll
            for (int n = 0; n < 4; ++n) {
                const int col = slot * 256 + f0 + wc * 64 + n * 16 + fq * 4;
                float o[4];
#pragma unroll
                for (int j = 0; j < 4; ++j) { const float x1 = a1[m][n][j]; o[j] = x1 * sigmoidf_(x1) * a3[m][n][j] * pe; }
                *(uint2*)(hid + ((size_t)mt.tg * 128 + lr) * 512 + col) = pack4(o[0], o[1], o[2], o[3]);
            }
        }
    }
}
__device__ void phase_moe2(const Params& p, int l, unsigned char* lds) {
    const int tid = otid(), lane = tid & 63, wid = tid >> 6, wr = wid >> 1, wc = wid & 1, fr = lane & 15, fq = lane >> 4;
    const int* cnt = (const int*)(WS(p) + OFF_CTL);
    const int* list = (const int*)(WS(p) + OFF_LIST);
    const bf16_t* we = (const bf16_t*)(WS(p) + OFF_WEXP);
    const bf16_t* hid = (const bf16_t*)(OUTB(p) + DO_HID);
    float* hm = (float*)(WS(p) + OFF_HM32);
    bf16_t* h = (bf16_t*)(WS(p) + OFF_H);
    const int total = moe_table(cnt, lds);
    for (int item = obid(); item < total * 8; item += gridDim.x) {
        const MoeTile mt = moe_find(lds, item >> 3);
        const int nt = item & 7, col0 = nt * 128;
        const int g_ = mt.cls / 6, pi = mt.cls % 6;
        const int elo = g_ * 4 + c_pair_lo[pi], ehi = g_ * 4 + c_pair_hi[pi];
        const int* lst = list + (size_t)mt.cls * NT + mt.ti * 128;
        const int nvalid = min(128, mt.cnt - mt.ti * 128);
        f32x4 acc[2][4]; g3_zero<2>(acc);
        G3<128> g;
        g3_setup<128>(g, [&](int r) { return hid + ((size_t)mt.tg * 128 + r) * 512; }, [&](int r) { return we + WE_W2 + ((size_t)elo * 1024 + col0 + r) * 256; }, tid);
        g3_kloop<128>(acc, g, 256, lds);
        g3_setup<128>(g, [&](int r) { return hid + ((size_t)mt.tg * 128 + r) * 512 + 256; }, [&](int r) { return we + WE_W2 + ((size_t)ehi * 1024 + col0 + r) * 256; }, tid);
        g3_kloop<128>(acc, g, 256, lds);
        int tkv[2]; float4 hv[2][4];
#pragma unroll
        for (int m = 0; m < 2; ++m) {
            const int lr = wr * 32 + m * 16 + fr;
            tkv[m] = lst[lr < nvalid ? lr : 0];
#pragma unroll
            for (int n = 0; n < 4; ++n) hv[m][n] = *(const float4*)(hm + (size_t)tkv[m] * 1024 + col0 + wc * 64 + n * 16 + fq * 4);
        }
#pragma unroll
        for (int m = 0; m < 2; ++m) {
            const int lr = wr * 32 + m * 16 + fr;
            if (lr < nvalid) {
                const int tk = tkv[m];
#pragma unroll
                for (int n = 0; n < 4; ++n) {
                    const int col = col0 + wc * 64 + n * 16 + fq * 4;
                    float4 v = hv[m][n];
                    v.x += acc[m][n][0]; v.y += acc[m][n][1]; v.z += acc[m][n][2]; v.w += acc[m][n][3];
                    if (l == 0) *(uint2*)(h + (size_t)tk * 1024 + col) = pack4(v.x, v.y, v.z, v.w);
                    else *(float4*)(hm + (size_t)tk * 1024 + col) = v;
                }
            }
        }
    }
}

__device__ void phase_final(const Params& p) {
    const int lane = otid() & 63;
    const int wave = (obid() * NTHR + otid()) >> 6, nw = gridDim.x * NTHR / 64;
    const float* hm = (const float*)(WS(p) + OFF_HM32);
    const float* nf = p.in[41];
    float4 g[4], cur[4];
#pragma unroll
    for (int i = 0; i < 4; ++i) g[i] = *(const float4*)(nf + i * 256 + lane * 4);
    auto rowp = [&](int r) { const int b = r / SEQ, s_ = r % SEQ; return hm + ((size_t)b * TS + NMETA + s_) * DM; };
    if (wave < NB * SEQ) {
        const float* src = rowp(wave);
#pragma unroll
        for (int i = 0; i < 4; ++i) cur[i] = *(const float4*)(src + i * 256 + lane * 4);
    }
    for (int r = wave; r < NB * SEQ; r += nw) {
        float4 v[4]; float ss = 0.f;
#pragma unroll
        for (int i = 0; i < 4; ++i) { v[i] = cur[i]; ss += v[i].x * v[i].x + v[i].y * v[i].y + v[i].z * v[i].z + v[i].w * v[i].w; }
        if (r + nw < NB * SEQ) {
            const float* src = rowp(r + nw);
#pragma unroll
            for (int i = 0; i < 4; ++i) cur[i] = *(const float4*)(src + i * 256 + lane * 4);
        }
        ss = wave_sum_fast(ss);
        const float rs = rsqrtf(ss * (1.0f / 1024.0f) + 1e-6f);
#pragma unroll
        for (int i = 0; i < 4; ++i) {
            float4 o; o.x = v[i].x * rs * g[i].x; o.y = v[i].y * rs * g[i].y; o.z = v[i].z * rs * g[i].z; o.w = v[i].w * rs * g[i].w;
            *(float4*)((float*)OUTB(p) + (size_t)r * DM + i * 256 + lane * 4) = o;
        }
    }
}


#define XB_TMO      128
#define XB_XCNT(j)  (256  + 64 * (j))
#define XB_XSUB(j)  (1280 + 64 * (j))
#define XB_XGEN(j)  (2304 + 64 * (j))
#define XB_TOP      3328
#define XB_TOPGEN   3392
#define XCD_BAR_WORDS 3456
#define XB_SPIN_CAP (1u << 22)
#define LAS __attribute__((address_space(3)))
__device__ __forceinline__ unsigned xb_ld(unsigned* p) { return __hip_atomic_load(p, __ATOMIC_RELAXED, __HIP_MEMORY_SCOPE_AGENT); }
__device__ __forceinline__ unsigned xb_add(unsigned* p, unsigned v) { return __hip_atomic_fetch_add(p, v, __ATOMIC_RELAXED, __HIP_MEMORY_SCOPE_AGENT); }
__device__ __forceinline__ unsigned xb_xcc_id() { return (unsigned)__builtin_amdgcn_s_getreg((3 << 11) | 20) & 0xFu; }
#define XB_SPIN(cond, bar) do { unsigned _sp = 0; while (cond) { __builtin_amdgcn_s_sleep(1); \
    if ((++_sp & 255u) == 0u) { if (xb_ld(&(bar)[XB_TMO])) break; if (_sp > XB_SPIN_CAP) { atomicAdd(&(bar)[XB_TMO], 1u); break; } } } } while (0)
struct XcdBarrier { unsigned* bar; unsigned x; volatile LAS unsigned* st; };
__device__ __forceinline__ XcdBarrier xcd_barrier_post(unsigned* bar, volatile LAS unsigned* st) {
    XcdBarrier b; b.bar = bar; b.x = xb_xcc_id(); b.st = st;
    if (threadIdx.x == 0) (void)xb_add(&bar[XB_XCNT(b.x)], 1u);
    return b;
}
__device__ __forceinline__ void xcd_barrier_complete(unsigned* bar, unsigned x, unsigned& nloc, unsigned& nx) {
    const unsigned G = gridDim.x * gridDim.y * gridDim.z;
    unsigned sum, cnt, mine, sp = 0u;
    for (;;) {
        sum = 0u; cnt = 0u; mine = 0u;
#pragma unroll
        for (unsigned j = 0; j < 16; ++j) { const unsigned c = xb_ld(&bar[XB_XCNT(j)]); sum += c; cnt += (c > 0u) ? 1u : 0u; mine = (j == x) ? c : mine; }
        if (sum == G) break;
        __builtin_amdgcn_s_sleep(1);
        if ((++sp & 255u) == 0u) { if (xb_ld(&bar[XB_TMO])) break; if (sp > XB_SPIN_CAP) { atomicAdd(&bar[XB_TMO], 1u); break; } }
    }
    nloc = mine > 0u ? mine : 1u; nx = cnt > 0u ? cnt : 1u;
}
__device__ __forceinline__ void xcd_barrier(const XcdBarrier& b) {
    asm volatile("s_waitcnt vmcnt(0)" ::: "memory");
    __syncthreads();
    if (threadIdx.x == 0) {
        unsigned* bar = b.bar;
        __builtin_amdgcn_s_waitcnt(0);
        unsigned nloc = b.st[0], nx = b.st[1];
        if (nloc == 0u) { xcd_barrier_complete(bar, b.x, nloc, nx); b.st[0] = nloc; b.st[1] = nx; }
        const unsigned old = xb_add(&bar[XB_XSUB(b.x)], 1u);
        const unsigned gen = old / nloc;
        if (old + 1u == (gen + 1u) * nloc) {
            __builtin_amdgcn_fence(__ATOMIC_RELEASE, "agent");
            asm volatile("s_waitcnt vmcnt(0)" ::: "memory");
            const unsigned og = xb_add(&bar[XB_TOP], 1u);
            const unsigned tg = og / nx;
            if (og + 1u == (tg + 1u) * nx) xb_add(&bar[XB_TOPGEN], 1u);
            else XB_SPIN(xb_ld(&bar[XB_TOPGEN]) == tg, bar);
            __builtin_amdgcn_fence(__ATOMIC_ACQUIRE, "agent");
            xb_add(&bar[XB_XGEN(b.x)], 1u);
            asm volatile("s_waitcnt vmcnt(0)" ::: "memory");
        } else {
            XB_SPIN(xb_ld(&bar[XB_XGEN(b.x)]) == gen, bar);
            __builtin_amdgcn_fence(__ATOMIC_ACQUIRE, "agent");
            asm volatile("s_waitcnt vmcnt(0)" ::: "memory");
        }
    }
    __syncthreads();
}

__global__ void __launch_bounds__(NTHR) fwd_megakernel(Params p) {
    extern __shared__ __attribute__((aligned(16))) unsigned char lds[];
    cg::grid_group grid = cg::this_grid();
    volatile LAS unsigned* xst = (volatile LAS unsigned*)(lds + LDS_BYTES - 32);
    if (threadIdx.x < 2) xst[threadIdx.x] = 0u;
    __syncthreads();
    const XcdBarrier xb = xcd_barrier_post((unsigned*)(p.ws + OFF_BAR), xst);
    if (p.out == nullptr) grid.sync();
#pragma unroll 1
    for (int step = 0; step < 18; ++step) {
        const int l = step >= 9 ? 1 : 0;
        const int ph = step - l * 9;
        switch (ph) {
        case 0:
            if (l == 0) phase_embed(p); else phase_rowstat(p);
            phase_convert<false>(p, l, lds);
            if (obid() == 0 && otid() < 24) ((int*)(WS(p) + OFF_CTL))[otid() * 32] = 0;
            if (obid() == 0 && otid() == 32) ((int*)(WS(p) + OFF_CTL))[800 + l * 32] = 0;
            break;
        case 1: phase_inproj(p, lds); break;
        case 2: phase_dsa_prep(p, l); phase_lr_prep(p, l); break;
        case 3: {
            if (obid() < NB * 16) phase_scan5(p, l, lds, obid());
            int* qctr = (int*)(WS(p) + OFF_CTL) + 800 + l * 32;
            int* qslot = (int*)(lds + LDS_BYTES - 16);
            for (;;) {
                __syncthreads();
                if (otid() == 0) *qslot = atomicAdd(qctr, 1);
                __syncthreads();
                const int item = *qslot;
                if (item >= 516 + NT / 32 + 3072) break;
                if (item < 516) phase_pool(p, l, lds, item, item + 1, 1);
                else if (item < 516 + NT / 32) phase_dsa<false>(p, l, lds, (bf16_t*)(OUTB(p) + DO_YC), nullptr, nullptr, item - 516, item - 515, 1);
                else {
                    const int ct = item - (516 + NT / 32);
                    const ConvJob cj = get_job_late(p, l, ct >> 10);
                    conv_tile(cj, ct & 1023, (float*)lds);
                }
            }
        } break;
        case 4: phase_merge(p, lds); break;
        case 5: phase_outproj(p, lds); break;
        case 6: phase_route(p, l, lds); break;
        case 7: phase_moe1(p, lds); break;
        default: phase_moe2(p, l, lds); break;
        }
        xcd_barrier(xb);
    }
    phase_final(p);
}

extern "C" void kernel_launch(void* const* d_in, const int* in_sizes, int n_in,
                              void* d_out, int out_size, void* d_ws, size_t ws_size,
                              hipStream_t stream) {
    static int grid_blocks = 0;
    if (grid_blocks == 0) {
        int dev = 0, cus = 0, per_cu = 0;
        (void)hipGetDevice(&dev);
        (void)hipDeviceGetAttribute(&cus, hipDeviceAttributeMultiprocessorCount, dev);
        (void)hipFuncSetAttribute((const void*)fwd_megakernel, hipFuncAttributeMaxDynamicSharedMemorySize, LDS_BYTES);
        (void)hipOccupancyMaxActiveBlocksPerMultiprocessor(&per_cu, fwd_megakernel, NTHR, LDS_BYTES);
        if (per_cu < 1 || cus < NB * 16 || (cus & 7) != 0 || n_in != 42 || ws_size < WS_END + (size_t)QS_WS * QS_BYTES || cus > QS_WS + QS_DO) { fprintf(stderr, "kernel_launch: bad config per_cu=%d n_in=%d ws=%zu need=%zu\n", per_cu, n_in, ws_size, (size_t)WS_END); grid_blocks = -1; }
        else grid_blocks = cus;
    }
    if (grid_blocks < 0) return;
    Params p{};
    for (int i = 0; i < 42; ++i) p.in[i] = (const float*)d_in[i];
    p.out = (float*)d_out;
    p.ws = (unsigned char*)d_ws;
    (void)hipMemsetAsync((unsigned char*)d_ws + OFF_BAR, 0, XCD_BAR_WORDS * 4, stream);
    void* args[] = {&p};
    hipError_t e = hipLaunchCooperativeKernel((void*)fwd_megakernel, dim3(grid_blocks), dim3(NTHR), args, LDS_BYTES, stream);
    if (e != hipSuccess) fprintf(stderr, "cooperative launch failed: %s (grid %d)\n", hipGetErrorString(e), grid_blocks);
}
```

```cpp
#include <hip/hip_runtime.h>
#include <hip/hip_cooperative_groups.h>
#include <cstdio>
#include <cstdint>
#include <type_traits>
namespace cg = cooperative_groups;

typedef unsigned short bf16_t;
typedef short bf16x8 __attribute__((ext_vector_type(8)));
typedef float f32x4 __attribute__((ext_vector_type(4)));

constexpr int NB = 8, SEQ = 2048, NMETA = 16, TS = 2064, DM = 1024;
constexpr int NT = NB * TS;
constexpr int NTP = 16640;
constexpr int NTHR = 512;
constexpr int CIN = 7912;
constexpr int NP1 = 4864;
constexpr int PM_LD = 768;
constexpr int PM_WD = 0, PM_AD = 64, PM_GD = 128, PM_VD = 256, PM_CQ = 288, PM_CKV = 544, PM_KROPE = 672, PM_KIDX = 704;
constexpr int LDS_BYTES = 157 * 1024;

constexpr size_t AL(size_t x) { return (x + 255) & ~(size_t)255; }
constexpr size_t SZ_ACT = (size_t)NTP * 1024 * 2;
constexpr size_t OFF_CTL = 0;
constexpr size_t OFF_BAR = 4096;
constexpr size_t OFF_RSTD = OFF_BAR + 16384;
constexpr size_t OFF_ROPE = OFF_RSTD + AL((size_t)NTP * 4);
constexpr size_t OFF_H = OFF_ROPE + AL((size_t)TS * 16 * 4 * 2);
constexpr size_t OFF_WB = OFF_H + SZ_ACT;
constexpr size_t WB_WIN = 0;
constexpr size_t WB_WG = WB_WIN + (size_t)NP1 * 1024;
constexpr size_t WB_PA = WB_WG + (size_t)3072 * 1024;
constexpr size_t WB_WO = WB_PA + (size_t)3 * 1024 * 1024;
constexpr size_t WB_POOL = WB_WO + (size_t)1024 * 1024;
constexpr size_t WB_QI = WB_POOL + (size_t)4 * 256 * 256;
constexpr size_t WB_UQ = WB_QI + (size_t)512 * 256;
constexpr size_t WB_UK = WB_UQ + (size_t)1536 * 256;
constexpr size_t WB_UV = WB_UK + (size_t)16 * 128 * 64;
constexpr size_t WB_WIDX = WB_UV + (size_t)16 * 64 * 128;
constexpr size_t WB_END = WB_WIDX + (size_t)64 * 1024;
constexpr size_t OFF_PPOOL = OFF_WB + AL(WB_END * 2);
constexpr size_t OFF_PK = OFF_PPOOL + SZ_ACT;
constexpr size_t OFF_PR = OFF_PK + SZ_ACT;
constexpr size_t OFF_PV = OFF_PR + SZ_ACT;
constexpr size_t OFF_PMISC = OFF_PV + SZ_ACT;
constexpr size_t OFF_VFIRST = OFF_PMISC + AL((size_t)NTP * PM_LD * 2);
constexpr size_t OFF_HALO = OFF_VFIRST + SZ_ACT;
constexpr size_t OFF_LIST = OFF_HALO + AL((size_t)130 * 16 * 1024 * 2);
constexpr size_t OFF_PW = OFF_LIST + AL((size_t)24 * NT * 4);
constexpr size_t WS_END = OFF_PW + AL((size_t)NT * 2 * 4);
constexpr size_t OFF_MERGED = OFF_PK;
constexpr size_t OFF_HM32 = OFF_PR;
constexpr size_t OFF_HN = OFF_PPOOL;
constexpr size_t OFF_WEXP = OFF_PMISC;
constexpr size_t WE_W1 = 0, WE_W3 = (size_t)16 * 256 * 1024, WE_W2 = (size_t)2 * 16 * 256 * 1024;
static_assert((size_t)3 * 16 * 256 * 1024 * 2 <= (size_t)NTP * PM_LD * 2, "expert weights must fit in Pmisc");
constexpr size_t DO_YC = 0;
constexpr size_t DO_CQN = DO_YC + SZ_ACT;
constexpr size_t DO_KV = DO_CQN + AL((size_t)NT * 256 * 2);
constexpr size_t DO_KIDX = DO_KV + AL((size_t)NT * 160 * 2);
constexpr size_t DO_WHEAD = DO_KIDX + AL((size_t)NT * 64 * 2);
constexpr size_t DO_ALR = DO_WHEAD + AL((size_t)NT * 8 * 4);
constexpr size_t DO_END = DO_ALR + AL((size_t)NT * 288 * 2);
constexpr size_t QS_BYTES = (size_t)16 * 16 * 160 * 2;
constexpr int QS_WS = (int)((277240096ull - WS_END) / QS_BYTES), QS_DO = (int)(((size_t)NB * SEQ * DM * 4 - DO_END) / QS_BYTES);
static_assert(QS_WS + QS_DO >= 256, "Q scratch");
constexpr size_t DO_HID = DO_YC;
static_assert(DO_END <= (size_t)NB * SEQ * DM * 4, "d_out scratch overflow");
static_assert((size_t)(129 + 24) * 128 * 512 * 2 <= SZ_ACT, "hid fits");
static_assert(WS_END <= 277240096ull, "workspace overflow");

struct Params {
    const float* in[42];
    float* out;
    unsigned char* ws;
};

__device__ __forceinline__ int otid() { int t = threadIdx.x; asm volatile("" : "+v"(t)); return t; }
__device__ __forceinline__ int obid() { int b = blockIdx.x; asm volatile("" : "+s"(b)); return b; }
typedef __attribute__((address_space(1))) unsigned char gas_uchar;
__device__ __forceinline__ unsigned char* WS(const Params& p) { gas_uchar* w = (gas_uchar*)p.ws; asm volatile("" : "+s"(w)); return (unsigned char*)w; }
__device__ __forceinline__ unsigned char* OUTB(const Params& p) { gas_uchar* w = (gas_uchar*)p.out; asm volatile("" : "+s"(w)); return (unsigned char*)w; }
__device__ __forceinline__ float bf2f(bf16_t v) { return __uint_as_float(((unsigned)v) << 16); }
typedef float f32x2v __attribute__((ext_vector_type(2)));
typedef __bf16 bf16x2v __attribute__((ext_vector_type(2)));
__device__ __forceinline__ unsigned pk2(float a, float b) { const f32x2v v = {a, b}; const bf16x2v r = __builtin_convertvector(v, bf16x2v); unsigned u; __builtin_memcpy(&u, &r, 4); return u; }
__device__ __forceinline__ bf16_t f2bf(float f) { const __bf16 h = (__bf16)f; bf16_t u; __builtin_memcpy(&u, &h, 2); return u; }
__device__ __forceinline__ float wave_sum(float v) {
#pragma unroll
    for (int o = 32; o > 0; o >>= 1) v += __shfl_xor(v, o);
    return v;
}
template <int CTRL> __device__ __forceinline__ float dpp_f(float x) {
    return __int_as_float(__builtin_amdgcn_update_dpp(0, __float_as_int(x), CTRL, 0xF, 0xF, true));
}
__device__ __forceinline__ float row16_sum(float v) {
    v += dpp_f<0xB1>(v);
    v += dpp_f<0x4E>(v);
    v += dpp_f<0x141>(v);
    v += dpp_f<0x140>(v);
    return v;
}
__device__ __forceinline__ void lds_barrier() { asm volatile("s_waitcnt lgkmcnt(0)" ::: "memory"); __builtin_amdgcn_s_barrier(); asm volatile("" ::: "memory"); }
__device__ __forceinline__ float fast_rcp(float x) { return __builtin_amdgcn_rcpf(x); }
__device__ __forceinline__ float fast_sigmoid(float x) { return fast_rcp(1.0f + __expf(-x)); }
__device__ __forceinline__ float fast_tanh(float x) { return 1.0f - 2.0f * fast_rcp(1.0f + __expf(2.0f * x)); }
__device__ __forceinline__ void row16_sum4(float& a, float& b, float& c, float& d) {
    asm volatile(
        "s_nop 1\n\t"
        "v_add_f32_dpp %0, %0, %0 quad_perm:[1,0,3,2] row_mask:0xf bank_mask:0xf\n\t"
        "v_add_f32_dpp %1, %1, %1 quad_perm:[1,0,3,2] row_mask:0xf bank_mask:0xf\n\t"
        "v_add_f32_dpp %2, %2, %2 quad_perm:[1,0,3,2] row_mask:0xf bank_mask:0xf\n\t"
        "v_add_f32_dpp %3, %3, %3 quad_perm:[1,0,3,2] row_mask:0xf bank_mask:0xf\n\t"
        "v_add_f32_dpp %0, %0, %0 quad_perm:[2,3,0,1] row_mask:0xf bank_mask:0xf\n\t"
        "v_add_f32_dpp %1, %1, %1 quad_perm:[2,3,0,1] row_mask:0xf bank_mask:0xf\n\t"
        "v_add_f32_dpp %2, %2, %2 quad_perm:[2,3,0,1] row_mask:0xf bank_mask:0xf\n\t"
        "v_add_f32_dpp %3, %3, %3 quad_perm:[2,3,0,1] row_mask:0xf bank_mask:0xf\n\t"
        "v_add_f32_dpp %0, %0, %0 row_half_mirror row_mask:0xf bank_mask:0xf\n\t"
        "v_add_f32_dpp %1, %1, %1 row_half_mirror row_mask:0xf bank_mask:0xf\n\t"
        "v_add_f32_dpp %2, %2, %2 row_half_mirror row_mask:0xf bank_mask:0xf\n\t"
        "v_add_f32_dpp %3, %3, %3 row_half_mirror row_mask:0xf bank_mask:0xf\n\t"
        "v_add_f32_dpp %0, %0, %0 row_mirror row_mask:0xf bank_mask:0xf\n\t"
        "v_add_f32_dpp %1, %1, %1 row_mirror row_mask:0xf bank_mask:0xf\n\t"
        "v_add_f32_dpp %2, %2, %2 row_mirror row_mask:0xf bank_mask:0xf\n\t"
        "v_add_f32_dpp %3, %3, %3 row_mirror row_mask:0xf bank_mask:0xf\n\t"
        "s_nop 1"
        : "+v"(a), "+v"(b), "+v"(c), "+v"(d));
}
__device__ __forceinline__ void row8_sum2(float& a, float& b) {
    asm volatile(
        "s_nop 1\n\t"
        "v_add_f32_dpp %0, %0, %0 quad_perm:[1,0,3,2] row_mask:0xf bank_mask:0xf\n\t"
        "v_add_f32_dpp %1, %1, %1 quad_perm:[1,0,3,2] row_mask:0xf bank_mask:0xf\n\t"
        "s_nop 0\n\t"
        "v_add_f32_dpp %0, %0, %0 quad_perm:[2,3,0,1] row_mask:0xf bank_mask:0xf\n\t"
        "v_add_f32_dpp %1, %1, %1 quad_perm:[2,3,0,1] row_mask:0xf bank_mask:0xf\n\t"
        "s_nop 0\n\t"
        "v_add_f32_dpp %0, %0, %0 row_half_mirror row_mask:0xf bank_mask:0xf\n\t"
        "v_add_f32_dpp %1, %1, %1 row_half_mirror row_mask:0xf bank_mask:0xf\n\t"
        "s_nop 1"
        : "+v"(a), "+v"(b));
}
__device__ __forceinline__ float xrow_sum(float v) {
    const auto a = __builtin_amdgcn_permlane16_swap(__float_as_uint(v), __float_as_uint(v), false, false);
    v = __uint_as_float(a[0]) + __uint_as_float(a[1]);
    const auto b = __builtin_amdgcn_permlane32_swap(__float_as_uint(v), __float_as_uint(v), false, false);
    return __uint_as_float(b[0]) + __uint_as_float(b[1]);
}
__device__ __forceinline__ float wave_sum_fast(float v) { return xrow_sum(row16_sum(v)); }
__device__ __forceinline__ float sigmoidf_(float x) { return 1.0f / (1.0f + __expf(-x)); }
__device__ __forceinline__ float softplusf_(float z) { return fmaxf(z, 0.f) + log1pf(__expf(-fabsf(z))); }
__device__ __forceinline__ void glds16(const void* g, void* l) {
    __builtin_amdgcn_global_load_lds((const unsigned*)g, (unsigned*)l, 16, 0, 0);
}

__device__ void phase_embed(const Params& p) {
    const int lane = otid() & 63;
    const int wave = (obid() * NTHR + otid()) >> 6, nw = gridDim.x * NTHR / 64;
    bf16_t* h = (bf16_t*)(WS(p) + OFF_H);
    float* rstd = (float*)(WS(p) + OFF_RSTD);
    auto srcrow = [&](int n) { const int b = n / TS, t = n % TS; return t < NMETA ? p.in[1] + (size_t)t * DM : p.in[0] + ((size_t)b * SEQ + (t - NMETA)) * DM; };
    float4 cur[4];
    if (wave < NT) {
        const float* src = srcrow(wave);
#pragma unroll
        for (int i = 0; i < 4; ++i) cur[i] = *(const float4*)(src + i * 256 + lane * 4);
    }
    for (int n = wave; n < NTP; n += nw) {
        if (n < NT) {
            float4 v[4];
#pragma unroll
            for (int i = 0; i < 4; ++i) v[i] = cur[i];
            if (n + nw < NT) {
                const float* src = srcrow(n + nw);
#pragma unroll
                for (int i = 0; i < 4; ++i) cur[i] = *(const float4*)(src + i * 256 + lane * 4);
            }
            float ss = 0.f;
#pragma unroll
            for (int i = 0; i < 4; ++i) {
                ss += v[i].x * v[i].x + v[i].y * v[i].y + v[i].z * v[i].z + v[i].w * v[i].w;
                *(uint2*)(h + (size_t)n * DM + i * 256 + lane * 4) = make_uint2(pk2(v[i].x, v[i].y), pk2(v[i].z, v[i].w));
            }
            ss = wave_sum_fast(ss);
            if (lane == 0) rstd[n] = rsqrtf(ss * (1.0f / 1024.0f) + 1e-6f);
        } else {
#pragma unroll
            for (int i = 0; i < 4; ++i) *(ushort4*)(h + (size_t)n * DM + i * 256 + lane * 4) = make_ushort4(0, 0, 0, 0);
            if (lane == 0) rstd[n] = 0.f;
        }
    }
    float* ctab = (float*)(WS(p) + OFF_ROPE);
    float* stab = ctab + TS * 16;
    for (int idx = obid() * NTHR + otid(); idx < TS * 16; idx += gridDim.x * NTHR) {
        const int t = idx >> 4, i = idx & 15;
        const float inv = powf(10000.0f, -(float)(2 * i) / 32.0f);
        const float ang = (float)t * inv;
        ctab[idx] = cosf(ang);
        stab[idx] = sinf(ang);
    }
}

__device__ void phase_rowstat(const Params& p) {
    const int lane = otid() & 63;
    const int wave = (obid() * NTHR + otid()) >> 6, nw = gridDim.x * NTHR / 64;
    const bf16_t* hb = (const bf16_t*)(WS(p) + OFF_H);
    float* rstd = (float*)(WS(p) + OFF_RSTD);
    uint4 cur[2];
    if (wave < NT) { cur[0] = *(const uint4*)(hb + (size_t)wave * DM + lane * 8); cur[1] = *(const uint4*)(hb + (size_t)wave * DM + 512 + lane * 8); }
    for (int n = wave; n < NT; n += nw) {
        float ss = 0.f;
#pragma unroll
        for (int i = 0; i < 2; ++i) {
            const unsigned w_[4] = {cur[i].x, cur[i].y, cur[i].z, cur[i].w};
#pragma unroll
            for (int j = 0; j < 4; ++j) { const float a_ = __uint_as_float(w_[j] << 16), b_ = __uint_as_float(w_[j] & 0xFFFF0000u); ss += a_ * a_ + b_ * b_; }
        }
        if (n + nw < NT) { cur[0] = *(const uint4*)(hb + (size_t)(n + nw) * DM + lane * 8); cur[1] = *(const uint4*)(hb + (size_t)(n + nw) * DM + 512 + lane * 8); }
        ss = wave_sum_fast(ss);
        if (lane == 0) rstd[n] = rsqrtf(ss * (1.0f / 1024.0f) + 1e-6f);
    }
}

struct ConvJob { const float* src; bf16_t* dst; const float* scale; int ldsrc, K, nvalid, nrows, nb, notr; size_t sbs, dbs; const float* srcB; int ldB, split; };
__device__ __forceinline__ int conv_job_tiles(const ConvJob& j) { return j.nb * (j.nrows >> 6) * (j.K >> 6); }
__device__ void conv_tile(const ConvJob& j, int tile, float* lds) {
    const int per = (j.nrows >> 6) * (j.K >> 6);
    const int bi = tile / per, rem = tile % per;
    const int ktiles = j.K >> 6;
    const int n0 = (rem / ktiles) << 6, k0 = (rem % ktiles) << 6;
    const int tid = otid(), tn = tid & 63, tk = tid >> 6;
    const float* src = j.src + (size_t)bi * j.sbs;
    bf16_t* dst = j.dst + (size_t)bi * j.dbs;
#pragma unroll
    for (int kk = 0; kk < 8; ++kk) {
        const int k = k0 + tk * 8 + kk;
        float v = 0.f;
        if (n0 + tn < j.nvalid) {
            if (j.split) { const int nn = n0 + tn; v = (nn < j.split) ? (j.src ? j.src[(size_t)k * j.ldsrc + nn] : 0.f) : j.srcB[(size_t)k * j.ldB + (nn - j.split)]; }
            else v = j.notr ? src[(size_t)(n0 + tn) * j.ldsrc + k] : src[(size_t)k * j.ldsrc + n0 + tn];
            if (j.scale) v *= j.scale[k];
        }
        lds[tn * 65 + tk * 8 + kk] = v;
    }
    __syncthreads();
    const int wn = tid >> 3, kq = tid & 7;
    uint4 o;
    unsigned w[4];
#pragma unroll
    for (int q = 0; q < 4; ++q) {
        const float lo = lds[wn * 65 + kq * 8 + 2 * q], hi = lds[wn * 65 + kq * 8 + 2 * q + 1];
        w[q] = pk2(lo, hi);
    }
    o.x = w[0]; o.y = w[1]; o.z = w[2]; o.w = w[3];
    *(uint4*)(dst + (size_t)(n0 + wn) * j.K + k0 + kq * 8) = o;
    __syncthreads();
}
__device__ ConvJob get_job_early(const Params& p, int l, int ji) {
    bf16_t* wb = (bf16_t*)(WS(p) + OFF_WB);
    const float* win = p.in[3] + (size_t)l * DM * CIN;
    const float* nm = p.in[2] + (size_t)l * DM;
    ConvJob j{}; j.nb = 1; j.sbs = 0; j.dbs = 0; j.K = 1024; j.ldsrc = CIN; j.scale = nm;
    switch (ji) {
    case 0: j.src = win + 3072; j.dst = wb + WB_WIN; j.nvalid = 4352; j.nrows = 4352; break;
    case 1: j.src = (l == 0 ? nullptr : p.in[17]); j.ldsrc = 32; j.split = 32; j.srcB = win + 7424; j.ldB = CIN; j.dst = wb + WB_WIN + (size_t)(4096 + PM_VD) * 1024; j.nvalid = 512; j.nrows = 512; break;
    case 2: j.src = win + 7904; j.dst = wb + WB_WIDX; j.nvalid = 8; j.nrows = 64; break;
    case 3: j.src = win; j.dst = wb + WB_WG; j.nvalid = 3072; j.nrows = 3072; break;
    case 4: j.src = p.in[29] + (size_t)l * DM * DM; j.ldsrc = 1024; j.scale = nullptr; j.dst = wb + WB_PA; j.nvalid = 1024; j.nrows = 1024; break;
    case 5: j.src = p.in[30] + (size_t)l * DM * DM; j.ldsrc = 1024; j.scale = nullptr; j.dst = wb + WB_PA + (size_t)1024 * 1024; j.nvalid = 1024; j.nrows = 1024; break;
    case 6: j.src = p.in[31] + (size_t)l * DM * DM; j.ldsrc = 1024; j.scale = nullptr; j.dst = wb + WB_PA + (size_t)2 * 1024 * 1024; j.nvalid = 1024; j.nrows = 1024; break;
    case 7: j.src = p.in[32] + (size_t)l * DM * DM; j.ldsrc = 1024; j.scale = nullptr; j.dst = wb + WB_WO; j.nvalid = 1024; j.nrows = 1024; break;
    case 8: j.src = p.in[5] + (size_t)l * 4 * 256 * 256; j.ldsrc = 256; j.K = 256; j.scale = nullptr; j.dst = wb + WB_POOL; j.nvalid = 256; j.nrows = 256; j.nb = 4; j.sbs = 65536; j.dbs = 65536; break;
    case 9: j.src = p.in[26] + (size_t)l * 256 * 512; j.ldsrc = 512; j.K = 256; j.scale = nullptr; j.dst = wb + WB_QI; j.nvalid = 512; j.nrows = 512; break;
    case 10: j.src = p.in[23] + (size_t)l * 256 * 1536; j.ldsrc = 1536; j.K = 256; j.scale = nullptr; j.dst = wb + WB_UQ; j.nvalid = 1536; j.nrows = 1536; break;
    case 11: j.src = p.in[24] + (size_t)l * 16 * 128 * 64; j.ldsrc = 64; j.K = 64; j.scale = nullptr; j.dst = wb + WB_UK; j.nvalid = 2048; j.nrows = 2048; j.notr = 1; break;
    default: j.src = p.in[25] + (size_t)l * 16 * 128 * 64; j.ldsrc = 64; j.K = 128; j.scale = nullptr; j.dst = wb + WB_UV; j.nvalid = 64; j.nrows = 64; j.nb = 16; j.sbs = 8192; j.dbs = 8192; break;
    }
    return j;
}
__device__ ConvJob get_job_late(const Params& p, int l, int ji) {
    bf16_t* we = (bf16_t*)(WS(p) + OFF_WEXP);
    ConvJob j{}; j.nb = 16; j.scale = nullptr; j.sbs = 262144; j.dbs = 262144;
    switch (ji) {
    case 0: j.src = p.in[38] + (size_t)l * 16 * 262144; j.dst = we + WE_W1; j.ldsrc = 256; j.K = 1024; j.nvalid = 256; j.nrows = 256; break;
    case 1: j.src = p.in[39] + (size_t)l * 16 * 262144; j.dst = we + WE_W3; j.ldsrc = 256; j.K = 1024; j.nvalid = 256; j.nrows = 256; break;
    default: j.src = p.in[40] + (size_t)l * 16 * 262144; j.dst = we + WE_W2; j.ldsrc = 1024; j.K = 256; j.nvalid = 1024; j.nrows = 1024; break;
    }
    return j;
}
template <bool LATE>
__device__ void phase_convert(const Params& p, int l, unsigned char* lds) {
    const int njobs = LATE ? 3 : 13;
    int base = 0;
    for (int ji = 0; ji < njobs; ++ji) {
        const ConvJob j = LATE ? get_job_late(p, l, ji) : get_job_early(p, l, ji);
        const int nt = conv_job_tiles(j);
        int first = ((int)obid() - base) % (int)gridDim.x; if (first < 0) first += gridDim.x;
        for (int t = first; t < nt; t += gridDim.x) conv_tile(j, t, (float*)lds);
        base += nt;
    }
}

template <int BM> struct G3 {
    static constexpr int MI = BM / 64;
    static constexpr int NA = BM / 64;
    static constexpr int STAGE = BM * 128 + 128 * 128;
    const bf16_t* ap[NA];
    const bf16_t* bp[2];
};
template <int BM>
__device__ __forceinline__ void g3_issue(const G3<BM>& g, int kt, unsigned char* stage, int tid) {
#pragma unroll
    for (int i = 0; i < G3<BM>::NA; ++i) glds16(g.ap[i] + kt * 64, stage + (tid + i * NTHR) * 16);
#pragma unroll
    for (int i = 0; i < 2; ++i) glds16(g.bp[i] + kt * 64, stage + BM * 128 + (tid + i * NTHR) * 16);
}
template <int BM, class FA, class FB>
__device__ __forceinline__ void g3_setup(G3<BM>& g, FA rowptr, FB bcol, int tid) {
#pragma unroll
    for (int i = 0; i < G3<BM>::NA; ++i) { const int idx = tid + i * NTHR, row = idx >> 3, sl = (idx & 7) ^ (row & 7); g.ap[i] = rowptr(row) + sl * 8; }
#pragma unroll
    for (int i = 0; i < 2; ++i) { const int idx = tid + i * NTHR, row = idx >> 3, sl = (idx & 7) ^ (row & 7); g.bp[i] = bcol(row) + sl * 8; }
}
template <int BM>
__device__ __forceinline__ void g3_kloop(f32x4 (&acc)[BM / 64][4], const G3<BM>& g, int K, unsigned char* lds) {
    constexpr int MI = G3<BM>::MI, STAGE = G3<BM>::STAGE, NL = G3<BM>::NA + 2;
    const int tid = otid(), lane = tid & 63, wid = tid >> 6, wr = wid >> 1, wc = wid & 1, fr = lane & 15, fq = lane >> 4;
    const int nk = K >> 6;
    g3_issue<BM>(g, 0, lds, tid);
    if (nk > 1) g3_issue<BM>(g, 1, lds + STAGE, tid);
    int cur = 0;
#pragma unroll 1
    for (int t = 0; t < nk; ++t) {
        if (t + 1 < nk) { if (NL == 6) asm volatile("s_waitcnt vmcnt(6)" ::: "memory"); else if (NL == 5) asm volatile("s_waitcnt vmcnt(5)" ::: "memory"); else asm volatile("s_waitcnt vmcnt(4)" ::: "memory"); }
        else asm volatile("s_waitcnt vmcnt(0)" ::: "memory");
        __builtin_amdgcn_s_barrier();
        if (t + 2 < nk) { int nx = cur + 2; if (nx >= 3) nx -= 3; g3_issue<BM>(g, t + 2, lds + nx * STAGE, tid); }
        const unsigned char* cA = lds + cur * STAGE;
        const unsigned char* cB = cA + BM * 128;
#pragma unroll
        for (int ks = 0; ks < 2; ++ks) {
            bf16x8 a[MI], b[4];
#pragma unroll
            for (int m = 0; m < MI; ++m) { const int row = wr * (BM / 4) + m * 16 + fr; a[m] = *(const bf16x8*)(cA + row * 128 + (((ks * 4 + fq) ^ (row & 7)) << 4)); }
#pragma unroll
            for (int n = 0; n < 4; ++n) { const int row = wc * 64 + n * 16 + fr; b[n] = *(const bf16x8*)(cB + row * 128 + (((ks * 4 + fq) ^ (row & 7)) << 4)); }
#pragma unroll
            for (int m = 0; m < MI; ++m)
#pragma unroll
                for (int n = 0; n < 4; ++n) acc[m][n] = __builtin_amdgcn_mfma_f32_16x16x32_bf16(b[n], a[m], acc[m][n], 0, 0, 0);
        }
        cur = (cur == 2) ? 0 : cur + 1;
    }
    __builtin_amdgcn_s_barrier();
}
struct G3D { const bf16_t* ap[2]; const bf16_t* b1[2]; const bf16_t* b3[2]; };
__device__ __forceinline__ void g3d_issue(const G3D& g, int kt, unsigned char* stage, int tid) {
#pragma unroll
    for (int i = 0; i < 2; ++i) glds16(g.ap[i] + kt * 64, stage + (tid + i * NTHR) * 16);
#pragma unroll
    for (int i = 0; i < 2; ++i) glds16(g.b1[i] + kt * 64, stage + 16384 + (tid + i * NTHR) * 16);
#pragma unroll
    for (int i = 0; i < 2; ++i) glds16(g.b3[i] + kt * 64, stage + 32768 + (tid + i * NTHR) * 16);
}
__device__ __forceinline__ void g3d_kloop(f32x4 (&acc1)[2][4], f32x4 (&acc3)[2][4], const G3D& g, int K, unsigned char* lds) {
    constexpr int STAGE = 49152;
    const int tid = otid(), lane = tid & 63, wid = tid >> 6, wr = wid >> 1, wc = wid & 1, fr = lane & 15, fq = lane >> 4;
    const int nk = K >> 6;
    g3d_issue(g, 0, lds, tid);
    if (nk > 1) g3d_issue(g, 1, lds + STAGE, tid);
    int cur = 0;
#pragma unroll 1
    for (int t = 0; t < nk; ++t) {
        if (t + 1 < nk) asm volatile("s_waitcnt vmcnt(6)" ::: "memory"); else asm volatile("s_waitcnt vmcnt(0)" ::: "memory");
        __builtin_amdgcn_s_barrier();
        if (t + 2 < nk) { int nx = cur + 2; if (nx >= 3) nx -= 3; g3d_issue(g, t + 2, lds + nx * STAGE, tid); }
        const unsigned char* cA = lds + cur * STAGE;
#pragma unroll
        for (int ks = 0; ks < 2; ++ks) {
            bf16x8 a[2], b1[4], b3[4];
#pragma unroll
            for (int m = 0; m < 2; ++m) { const int row = wr * 32 + m * 16 + fr; a[m] = *(const bf16x8*)(cA + row * 128 + (((ks * 4 + fq) ^ (row & 7)) << 4)); }
#pragma unroll
            for (int n = 0; n < 4; ++n) { const int row = wc * 64 + n * 16 + fr; const int off = row * 128 + (((ks * 4 + fq) ^ (row & 7)) << 4);
                b1[n] = *(const bf16x8*)(cA + 16384 + off); b3[n] = *(const bf16x8*)(cA + 32768 + off); }
#pragma unroll
            for (int m = 0; m < 2; ++m)
#pragma unroll
                for (int n = 0; n < 4; ++n) {
                    acc1[m][n] = __builtin_amdgcn_mfma_f32_16x16x32_bf16(b1[n], a[m], acc1[m][n], 0, 0, 0);
                    acc3[m][n] = __builtin_amdgcn_mfma_f32_16x16x32_bf16(b3[n], a[m], acc3[m][n], 0, 0, 0);
                }
        }
        cur = (cur == 2) ? 0 : cur + 1;
    }
    __builtin_amdgcn_s_barrier();
}
template <int MI>
__device__ __forceinline__ void g3_zero(f32x4 (&acc)[MI][4]) {
#pragma unroll
    for (int m = 0; m < MI; ++m)
#pragma unroll
        for (int n = 0; n < 4; ++n) acc[m][n] = (f32x4){0.f, 0.f, 0.f, 0.f};
}
__device__ __forceinline__ uint2 pack4(float a, float b, float c, float d) {
    uint2 r; r.x = pk2(a, b); r.y = pk2(c, d); return r;
}

namespace pg8 {
#define PG8_LAS __attribute__((address_space(3)))
typedef unsigned short bf16_t;
typedef short bf16x8 __attribute__((ext_vector_type(8)));
typedef float f32x4 __attribute__((ext_vector_type(4)));
typedef unsigned u32x4 __attribute__((ext_vector_type(4)));
constexpr int BM = 256, BK = 64, HALF = 128, HTB = HALF * BK * 2  , STAGE_BYTES = 8 * HTB, NXCD = 8, WGM = 8;

__host__ __device__ __forceinline__ int lds_byte(int r, int c) { const int st = (r >> 4) * 2 + (c >> 5), rr = r & 15, cc = c & 31, ob = rr * 64 + cc * 2; return st * 1024 + (ob ^ (((ob >> 9) & 1) << 5)); }
__host__ __device__ __forceinline__ void stage_rc(int b, int& R, int& C) { const int st = b / 1024, sb = b % 1024, swz = sb ^ (((sb >> 9) & 1) << 5); R = (st >> 1) * 16 + swz / 64; C = (st & 1) * 32 + (swz % 64) / 2; }
__host__ __device__ __forceinline__ int perm32(int rho) { const int n = rho >> 4, i = rho & 15; return 8 * (i >> 2) + 4 * n + (i & 3); }

struct Unit { int pm, pn; };
struct Gemm { const bf16_t* A; const bf16_t* Bt; int M, N, K; };

struct StaticOrder {
    int nM, nN, nwg, G, c;
    __host__ __device__ void init(int M, int N, int G_, int c_) { nM = M / BM; nN = N / BM; nwg = nM * nN; G = G_; c = c_; }
    __host__ __device__ bool next(int i, Unit& u) const {
        const long L = (long)i * G + c; if (L >= nwg) return false;
        int wgid = (int)L; { const int q = nwg / NXCD, r = nwg % NXCD, xcd = wgid % NXCD, off = wgid / NXCD; wgid = (xcd < r ? xcd * (q + 1) : r * (q + 1) + (xcd - r) * q) + off; }
        const int nig = WGM * nN, gid = wgid / nig, fm = gid * WGM, gsz = (nM - fm) < WGM ? (nM - fm) : WGM;
        u.pm = fm + ((wgid % nig) % gsz); u.pn = (wgid % nig) / gsz; return true;
    }
    __device__ __forceinline__ void a_ready(const Unit&) const {}
    __device__ __forceinline__ void done(const Unit&) const {}
};
template <class Epi, class Sched, bool STAMP = false>
__device__ __forceinline__ void gemm_phase(PG8_LAS unsigned char* lds, const Gemm g, const Sched& S, const Epi& E, unsigned long long* stamps) {
    const int tid = otid(), wid = __builtin_amdgcn_readfirstlane(tid >> 6), lane = tid & 63, wr = wid >> 2, wc = wid & 3, fr = lane & 15, fq = lane >> 4;
    const int K = g.K, nt = K / BK;
    int ts_lo = 0, ts_hi = 0, nts = 0; const unsigned long long rt_entry = STAMP ? 0ull : 0ull;
#define PG8_STAMP() do { if (STAMP && wid == 0 && nts < 64) { const unsigned long long _c = 0ull; \
        ts_lo = (lane == nts) ? (int)(unsigned)_c : ts_lo; ts_hi = (lane == nts) ? (int)(unsigned)(_c >> 32) : ts_hi; ++nts; } } while (0)
    PG8_STAMP();
    unsigned voffA[2], voffB[2];
#pragma unroll
    for (int i = 0; i < 2; ++i) { int R, C; stage_rc(tid * 16 + i * 8192, R, C); const int Rb = Epi::PERM ? ((R & ~31) + perm32(R & 31)) : R;
        voffA[i] = (unsigned)(R * K + C) * 2u; voffB[i] = (unsigned)(Rb * K + C) * 2u; }
    const size_t kstep = (size_t)(BK * 2);
    const size_t hstep = (size_t)HALF * K * 2;
    const size_t tstep = 2 * hstep;
    const unsigned ldsw = (unsigned)wid * 1024u;
    const int aoff = lds_byte(wr * 64 + fr, fq * 8), boff = lds_byte(wc * 32 + fr, fq * 8);
#define PG8_SA(b, h) (((b) * 2 + (h)) * HTB)
#define PG8_SB(b, h) ((4 + (b) * 2 + (h)) * HTB)
#define PG8_STAGE(bufoff, gbase, voff) do { _Pragma("unroll") for (int _i = 0; _i < 2; ++_i) \
        __builtin_amdgcn_global_load_lds((const unsigned*)((const char*)(gbase) + (voff)[_i]), (PG8_LAS unsigned*)(lds + (bufoff) + ldsw + _i * 8192), 16, 0, 0); } while (0)
#define PG8_LDA(dst, b, h) do { _Pragma("unroll") for (int m = 0; m < 4; ++m) _Pragma("unroll") for (int k = 0; k < 2; ++k) dst[m][k] = *(const PG8_LAS bf16x8*)(lds + PG8_SA(b, h) + aoff + m * 2048 + k * 1024); } while (0)
#define PG8_LDB(dst, b, h) do { _Pragma("unroll") for (int n = 0; n < 2; ++n) _Pragma("unroll") for (int k = 0; k < 2; ++k) dst[n][k] = *(const PG8_LAS bf16x8*)(lds + PG8_SB(b, h) + boff + n * 2048 + k * 1024); } while (0)
#define PG8_MMA(ai, bj, At, Bt) do { __builtin_amdgcn_s_setprio(1); _Pragma("unroll") for (int m = 0; m < 4; ++m) _Pragma("unroll") for (int n = 0; n < 2; ++n) _Pragma("unroll") for (int k = 0; k < 2; ++k) \
        acc[ai][bj][m][n] = __builtin_amdgcn_mfma_f32_16x16x32_bf16(Bt[n][k], At[m][k], acc[ai][bj][m][n], 0, 0, 0); __builtin_amdgcn_s_setprio(0); } while (0)
#define PG8_WAIT_V(n) asm volatile("s_waitcnt vmcnt(" #n ")" ::: "memory")
#define PG8_WAIT_L(n) asm volatile("s_waitcnt lgkmcnt(" #n ")" ::: "memory")
#define PG8_BAR __builtin_amdgcn_s_barrier()
#define PG8_SCHED __builtin_amdgcn_sched_barrier(0)
    Unit cur, nxt; int ui = 0;
    if (!S.next(0, cur)) return;
    f32x4 acc[2][2][4][2];
#pragma unroll
    for (int a = 0; a < 2; ++a)
#pragma unroll
        for (int b = 0; b < 2; ++b)
#pragma unroll
            for (int m = 0; m < 4; ++m)
#pragma unroll
                for (int n = 0; n < 2; ++n) acc[a][b][m][n] = (f32x4){0.f, 0.f, 0.f, 0.f};
    bf16x8 At[4][2], B0[2][2], B1[2][2];
    const char* cA = (const char*)g.A + (size_t)cur.pm * tstep; const char* cB = (const char*)g.Bt + (size_t)cur.pn * tstep;
    S.a_ready(cur);
    PG8_STAGE(PG8_SB(0, 0), cB, voffB); PG8_STAGE(PG8_SA(0, 0), cA, voffA); PG8_STAGE(PG8_SB(0, 1), cB + hstep, voffB); PG8_STAGE(PG8_SA(0, 1), cA + hstep, voffA);
    if (wr == 1) PG8_BAR;
    PG8_WAIT_V(4); PG8_BAR;
    PG8_STAGE(PG8_SB(1, 0), cB + kstep, voffB); PG8_STAGE(PG8_SA(1, 0), cA + kstep, voffA); PG8_STAGE(PG8_SB(1, 1), cB + hstep + kstep, voffB);
    PG8_WAIT_V(6); PG8_BAR;
    PG8_STAMP();
    for (;;) {
        const bool has_next = S.next(ui + 1, nxt);
        const char* nA = has_next ? (const char*)g.A + (size_t)nxt.pm * tstep : cA; const char* nB = has_next ? (const char*)g.Bt + (size_t)nxt.pn * tstep : cB;
        for (int t = 0; t < nt; t += 2) {
            const bool last = (t == nt - 2);
            const char* a1 = cA + (size_t)(t + 1) * kstep;
            const char* a2 = last ? nA : cA + (size_t)(t + 2) * kstep; const char* b2 = last ? nB : cB + (size_t)(t + 2) * kstep;
            const char* a3 = a2 + kstep; const char* b3 = b2 + kstep;
            if (last && has_next) S.a_ready(nxt);
            PG8_LDB(B0, 0, 0); PG8_SCHED; PG8_LDA(At, 0, 0); PG8_STAGE(PG8_SA(1, 1), a1 + hstep, voffA);
            PG8_WAIT_L(8); PG8_BAR; PG8_WAIT_L(0); PG8_MMA(0, 0, At, B0); PG8_BAR; PG8_SCHED;
            PG8_LDB(B1, 0, 1); PG8_STAGE(PG8_SB(0, 0), b2, voffB);
            PG8_BAR; PG8_WAIT_L(0); PG8_MMA(0, 1, At, B1); PG8_BAR;
            PG8_LDA(At, 0, 1); PG8_STAGE(PG8_SA(0, 0), a2, voffA);
            PG8_BAR; PG8_WAIT_L(0); PG8_MMA(1, 0, At, B0); PG8_BAR; PG8_SCHED;
            PG8_STAGE(PG8_SB(0, 1), b2 + hstep, voffB);
            PG8_WAIT_V(6); PG8_BAR; PG8_MMA(1, 1, At, B1); PG8_BAR;
            PG8_LDB(B0, 1, 0); PG8_SCHED; PG8_LDA(At, 1, 0); PG8_STAGE(PG8_SA(0, 1), a2 + hstep, voffA);
            PG8_WAIT_L(8); PG8_BAR; PG8_WAIT_L(0); PG8_MMA(0, 0, At, B0); PG8_BAR; PG8_SCHED;
            PG8_LDB(B1, 1, 1); PG8_STAGE(PG8_SB(1, 0), b3, voffB);
            PG8_BAR; PG8_WAIT_L(0); PG8_MMA(0, 1, At, B1); PG8_BAR;
            PG8_LDA(At, 1, 1); PG8_STAGE(PG8_SA(1, 0), a3, voffA);
            PG8_BAR; PG8_WAIT_L(0); PG8_MMA(1, 0, At, B0); PG8_BAR; PG8_SCHED;
            PG8_STAGE(PG8_SB(1, 1), b3 + hstep, voffB);
            PG8_WAIT_V(6); PG8_BAR; PG8_MMA(1, 1, At, B1); PG8_BAR;
        }
        PG8_STAMP();
        if constexpr (!Epi::AFTER_DRAIN) { E(acc, cur, wr, wc, fr, fq); S.done(cur); }
        PG8_STAMP();
        if (!has_next) break;
#pragma unroll
        for (int a = 0; a < 2; ++a)
#pragma unroll
            for (int b = 0; b < 2; ++b)
#pragma unroll
                for (int m = 0; m < 4; ++m)
#pragma unroll
                    for (int n = 0; n < 2; ++n) acc[a][b][m][n] = (f32x4){0.f, 0.f, 0.f, 0.f};
        cur = nxt; cA = nA; cB = nB; ++ui;
    }
    PG8_WAIT_V(0);
    if (wr == 0) PG8_BAR;
    PG8_BAR;
    if constexpr (Epi::AFTER_DRAIN) { E.fused(acc, cur, wr, wc, fr, fq, lds, wid, lane); S.done(cur); }
    PG8_STAMP();
    if (STAMP && wid == 0) { stamps[lane] = lane < nts ? (((unsigned long long)(unsigned)ts_hi << 32) | (unsigned)ts_lo) : 0ull;
        if (lane == 62) stamps[62] = rt_entry; if (lane == 63) stamps[63] = 0ull; }
#undef PG8_STAMP
#undef PG8_SA
#undef PG8_SB
#undef PG8_STAGE
#undef PG8_LDA
#undef PG8_LDB
#undef PG8_MMA
#undef PG8_WAIT_V
#undef PG8_WAIT_L
#undef PG8_BAR
#undef PG8_SCHED
}
}

struct EpiInproj {
    static constexpr bool PERM = true, AFTER_DRAIN = false;
    unsigned char* ws; const float* rstd;
    __device__ __forceinline__ void operator()(const pg8::f32x4 (&acc)[2][2][4][2], const pg8::Unit& u, int wr, int wc, int fr, int fq) const {
        const int pn = u.pn;
        bf16_t* dst; int ld, cb;
        if (pn < 4) { dst = (bf16_t*)(ws + OFF_PPOOL); ld = 1024; cb = pn * 256; }
        else if (pn < 8) { dst = (bf16_t*)(ws + OFF_PR); ld = 1024; cb = (pn - 4) * 256; }
        else if (pn < 12) { dst = (bf16_t*)(ws + OFF_PK); ld = 1024; cb = (pn - 8) * 256; }
        else if (pn < 16) { dst = (bf16_t*)(ws + OFF_PV); ld = 1024; cb = (pn - 12) * 256; }
        else { dst = (bf16_t*)(ws + OFF_PMISC); ld = PM_LD; cb = (pn - 16) * 256; }
        bf16_t* halo = (bf16_t*)(ws + OFF_HALO);
        float rsv[2][4];
#pragma unroll
        for (int ai = 0; ai < 2; ++ai)
#pragma unroll
            for (int m = 0; m < 4; ++m) { const int row = u.pm * 256 + ai * 128 + wr * 64 + m * 16 + fr; rsv[ai][m] = (row < NT) ? rstd[row] : 0.f; }
#pragma unroll
        for (int ai = 0; ai < 2; ++ai)
#pragma unroll
            for (int m = 0; m < 4; ++m) {
                const int row = u.pm * 256 + ai * 128 + wr * 64 + m * 16 + fr;
                if (row < NT) {
                    const float rs = rsv[ai][m];
                    const int lr = row & 127;
#pragma unroll
                    for (int bj = 0; bj < 2; ++bj) {
                        const int col = cb + bj * 128 + wc * 32 + fq * 8;
                        const uint2 lo = pack4(acc[ai][bj][m][0][0] * rs, acc[ai][bj][m][0][1] * rs, acc[ai][bj][m][0][2] * rs, acc[ai][bj][m][0][3] * rs);
                        const uint2 hi = pack4(acc[ai][bj][m][1][0] * rs, acc[ai][bj][m][1][1] * rs, acc[ai][bj][m][1][2] * rs, acc[ai][bj][m][1][3] * rs);
                        const uint4 v = make_uint4(lo.x, lo.y, hi.x, hi.y);
                        *(uint4*)(dst + (size_t)row * ld + col) = v;
                        if (pn < 4 && lr >= 112) *(uint4*)(halo + ((size_t)(row >> 7) * 16 + (lr - 112)) * 1024 + col) = v;
                    }
                }
            }
    }
};
__device__ void phase_inproj(const Params& p, unsigned char* lds) {
    pg8::StaticOrder S; S.init(NTP, NP1, (int)gridDim.x, obid());
    pg8::Gemm g; g.A = (const pg8::bf16_t*)(WS(p) + OFF_H); g.Bt = (const pg8::bf16_t*)(WS(p) + OFF_WB) + WB_WIN; g.M = NTP; g.N = NP1; g.K = DM;
    EpiInproj E; E.ws = WS(p); E.rstd = (const float*)(WS(p) + OFF_RSTD);
    pg8::gemm_phase<EpiInproj, pg8::StaticOrder, false>((PG8_LAS unsigned char*)lds, g, S, E, nullptr);
}

__device__ void phase_pool(const Params& p, int l, unsigned char* lds, int tb, int te, int tstep) {
    const int tid = otid(), lane = tid & 63, wid = tid >> 6, fr = lane & 15, fq = lane >> 4;
    bf16_t* pp = (bf16_t*)(WS(p) + OFF_PPOOL);
    const bf16_t* halo = (const bf16_t*)(WS(p) + OFF_HALO);
    const bf16_t* pw = (const bf16_t*)(WS(p) + OFF_WB) + WB_POOL;
    const float* scale = p.in[6] + (size_t)l * 1024;
    bf16_t* sp = (bf16_t*)lds;
    constexpr int SLD = 264;
    bf16_t* sraw = sp + 128 * SLD;
    for (int tile = tb; tile < te; tile += tstep) {
        const int mt = tile >> 2, g = tile & 3;
        const int row0 = mt * 128, w = 2 << g;
        const bf16_t* wg = pw + (size_t)g * 65536;
        bf16x8 bfr[8][2];
#pragma unroll
        for (int kk = 0; kk < 8; ++kk)
#pragma unroll
            for (int n = 0; n < 2; ++n) bfr[kk][n] = *(const bf16x8*)(wg + (size_t)(wid * 32 + n * 16 + fr) * 256 + kk * 32 + fq * 8);
        {
            for (int e = tid; e < 144 * 32; e += NTHR) {
                const int rr = e >> 5, c16 = e & 31;
                uint4 v = make_uint4(0u, 0u, 0u, 0u);
                if (rr >= 16) v = *(const uint4*)(pp + (size_t)(row0 + rr - 16) * 1024 + g * 256 + c16 * 8);
                else if (mt > 0) v = *(const uint4*)(halo + ((size_t)(mt - 1) * 16 + rr) * 1024 + g * 256 + c16 * 8);
                *(uint4*)(sraw + rr * 256 + c16 * 8) = v;
            }
        }
        __syncthreads();
        {
            const int c = tid & 255, r0 = (tid >> 8) * 64;
            auto rawv = [&](int nrel) -> float { return bf2f(sraw[(nrel + 16) * 256 + c]); };
            int t = (row0 + r0) % TS;
            float sum = 0.f;
            const int have = (t < w) ? t : w;
            for (int i = 1; i <= have; ++i) sum += rawv(r0 - i);
#pragma unroll 8
            for (int r = 0; r < 64; ++r) {
                if (t == 0) sum = 0.f;
                const float v = rawv(r0 + r);
                sum += v;
                if (t >= w) sum -= rawv(r0 + r - w);
                const int cnt = (t + 1 < w) ? (t + 1) : w;
                sp[(r0 + r) * SLD + c] = f2bf(sum * (1.0f / (float)cnt) - v);
                t = (t + 1 == TS) ? 0 : t + 1;
            }
        }
        __syncthreads();
        f32x4 acc[8][2];
#pragma unroll
        for (int m = 0; m < 8; ++m) { acc[m][0] = (f32x4){0.f, 0.f, 0.f, 0.f}; acc[m][1] = (f32x4){0.f, 0.f, 0.f, 0.f}; }
#pragma unroll
        for (int kk = 0; kk < 8; ++kk) {
#pragma unroll
            for (int m = 0; m < 8; ++m) {
                const bf16x8 a = *(const bf16x8*)(sp + (m * 16 + fr) * SLD + kk * 32 + fq * 8);
                acc[m][0] = __builtin_amdgcn_mfma_f32_16x16x32_bf16(bfr[kk][0], a, acc[m][0], 0, 0, 0);
                acc[m][1] = __builtin_amdgcn_mfma_f32_16x16x32_bf16(bfr[kk][1], a, acc[m][1], 0, 0, 0);
            }
        }
#pragma unroll
        for (int n = 0; n < 2; ++n) {
            const int col = g * 256 + wid * 32 + n * 16 + fq * 4;
            const float4 sc = *(const float4*)(scale + col);
#pragma unroll
            for (int m = 0; m < 8; ++m) {
                const int row = row0 + m * 16 + fr;
                *(uint2*)(pp + (size_t)row * 1024 + col) = pack4(acc[m][n][0] * sc.x, acc[m][n][1] * sc.y, acc[m][n][2] * sc.z, acc[m][n][3] * sc.w);
            }
        }
        __syncthreads();
    }
}

__device__ void phase_dsa_prep(const Params& p, int l) {
    const int lane = otid() & 63;
    const int wave = (obid() * NTHR + otid()) >> 6, nw = gridDim.x * NTHR / 64;
    const bf16_t* pm = (const bf16_t*)(WS(p) + OFF_PMISC);
    unsigned char* dob = OUTB(p);
    bf16_t* cqn = (bf16_t*)(dob + DO_CQN);
    bf16_t* kv = (bf16_t*)(dob + DO_KV);
    bf16_t* kidx = (bf16_t*)(dob + DO_KIDX);
    float* whead = (float*)(dob + DO_WHEAD);
    const float* ctab = (const float*)(WS(p) + OFF_ROPE);
    const float* stab = ctab + TS * 16;
    const bf16_t* hrow = (const bf16_t*)(WS(p) + OFF_H);
    const bf16_t* wwidx = (const bf16_t*)(WS(p) + OFF_WB) + WB_WIDX;
    const float* rstd_ = (const float*)(WS(p) + OFF_RSTD);
    const float4 qn4 = *(const float4*)(p.in[21] + l * 256 + lane * 4);
    const float2 kvn2 = *(const float2*)(p.in[22] + l * 128 + lane * 2);
    const float inw = p.in[27][l * 64 + lane], inb = p.in[28][l * 64 + lane];
    uint4 ww[8][2];
#pragma unroll
    for (int j = 0; j < 8; ++j) { ww[j][0] = *(const uint4*)(wwidx + (size_t)j * DM + lane * 16); ww[j][1] = *(const uint4*)(wwidx + (size_t)j * DM + lane * 16 + 8); }
    struct In { uint2 cq; unsigned ckv; bf16_t kr0, kr1, kix; uint4 h0, h1; float rs, c, s; };
    auto load = [&](int n) {
        In r;
        const bf16_t* row = pm + (size_t)n * PM_LD;
        const int t = n % TS;
        r.cq = *(const uint2*)(row + PM_CQ + lane * 4);
        r.ckv = *(const unsigned*)(row + PM_CKV + lane * 2);
        r.kr0 = row[PM_KROPE + (lane & 15)]; r.kr1 = row[PM_KROPE + 16 + (lane & 15)];
        r.kix = row[PM_KIDX + lane];
        r.h0 = *(const uint4*)(hrow + (size_t)n * DM + lane * 16); r.h1 = *(const uint4*)(hrow + (size_t)n * DM + lane * 16 + 8);
        r.rs = rstd_[n];
        r.c = ctab[t * 16 + (lane & 15)]; r.s = stab[t * 16 + (lane & 15)];
        return r;
    };
    In cur = load(wave < NT ? wave : 0);
    for (int n = wave; n < NT; n += nw) {
        const In x = cur;
        if (n + nw < NT) cur = load(n + nw);
        {
            const float v0 = __uint_as_float(x.cq.x << 16), v1 = __uint_as_float(x.cq.x & 0xFFFF0000u), v2 = __uint_as_float(x.cq.y << 16), v3 = __uint_as_float(x.cq.y & 0xFFFF0000u);
            const float ss = wave_sum_fast(v0 * v0 + v1 * v1 + v2 * v2 + v3 * v3);
            const float rs = rsqrtf(ss * (1.0f / 256.0f) + 1e-6f);
            *(uint2*)(cqn + (size_t)n * 256 + lane * 4) = pack4(v0 * rs * qn4.x, v1 * rs * qn4.y, v2 * rs * qn4.z, v3 * rs * qn4.w);
        }
        {
            const float v0 = __uint_as_float(x.ckv << 16), v1 = __uint_as_float(x.ckv & 0xFFFF0000u);
            const float ss = wave_sum_fast(v0 * v0 + v1 * v1);
            const float rs = rsqrtf(ss * (1.0f / 128.0f) + 1e-6f);
            *(unsigned*)(kv + (size_t)n * 160 + lane * 2) = pk2(v0 * rs * kvn2.x, v1 * rs * kvn2.y);
        }
        if (lane < 16) {
            const float x1 = bf2f(x.kr0), x2 = bf2f(x.kr1);
            kv[(size_t)n * 160 + 128 + lane] = f2bf(x1 * x.c - x2 * x.s);
            kv[(size_t)n * 160 + 144 + lane] = f2bf(x2 * x.c + x1 * x.s);
        }
        {
            const float xv = bf2f(x.kix);
            const float mu = wave_sum_fast(xv) * (1.0f / 64.0f);
            const float d = xv - mu;
            const float var = wave_sum_fast(d * d) * (1.0f / 64.0f);
            const float y = d * rsqrtf(var + 1e-6f) * inw + inb;
            const float yo = __shfl_xor(y, 16);
            float o = y;
            if (lane < 32) o = (lane < 16) ? (y * x.c - yo * x.s) : (y * x.c + yo * x.s);
            kidx[(size_t)n * 64 + lane] = f2bf(o);
        }
        {
            const uint4 hv0 = x.h0, hv1 = x.h1;
            float hx[16];
            hx[0] = __uint_as_float(hv0.x << 16); hx[1] = __uint_as_float(hv0.x & 0xFFFF0000u); hx[2] = __uint_as_float(hv0.y << 16); hx[3] = __uint_as_float(hv0.y & 0xFFFF0000u);
            hx[4] = __uint_as_float(hv0.z << 16); hx[5] = __uint_as_float(hv0.z & 0xFFFF0000u); hx[6] = __uint_as_float(hv0.w << 16); hx[7] = __uint_as_float(hv0.w & 0xFFFF0000u);
            hx[8] = __uint_as_float(hv1.x << 16); hx[9] = __uint_as_float(hv1.x & 0xFFFF0000u); hx[10] = __uint_as_float(hv1.y << 16); hx[11] = __uint_as_float(hv1.y & 0xFFFF0000u);
            hx[12] = __uint_as_float(hv1.z << 16); hx[13] = __uint_as_float(hv1.z & 0xFFFF0000u); hx[14] = __uint_as_float(hv1.w << 16); hx[15] = __uint_as_float(hv1.w & 0xFFFF0000u);
            float myw = 0.f;
#pragma unroll
            for (int j = 0; j < 8; ++j) {
                const uint4 w0 = ww[j][0], w1 = ww[j][1];
                float d = hx[0] * __uint_as_float(w0.x << 16) + hx[1] * __uint_as_float(w0.x & 0xFFFF0000u) + hx[2] * __uint_as_float(w0.y << 16) + hx[3] * __uint_as_float(w0.y & 0xFFFF0000u)
                        + hx[4] * __uint_as_float(w0.z << 16) + hx[5] * __uint_as_float(w0.z & 0xFFFF0000u) + hx[6] * __uint_as_float(w0.w << 16) + hx[7] * __uint_as_float(w0.w & 0xFFFF0000u)
                        + hx[8] * __uint_as_float(w1.x << 16) + hx[9] * __uint_as_float(w1.x & 0xFFFF0000u) + hx[10] * __uint_as_float(w1.y << 16) + hx[11] * __uint_as_float(w1.y & 0xFFFF0000u)
                        + hx[12] * __uint_as_float(w1.z << 16) + hx[13] * __uint_as_float(w1.z & 0xFFFF0000u) + hx[14] * __uint_as_float(w1.w << 16) + hx[15] * __uint_as_float(w1.w & 0xFFFF0000u);
                d = wave_sum_fast(d);
                myw = (lane == j) ? d : myw;
            }
            if (lane < 8) whead[(size_t)n * 8 + lane] = myw * x.rs * 0.04419417382415922f;
        }
    }
}

typedef short s16x4 __attribute__((ext_vector_type(4)));
__device__ __forceinline__ unsigned f2h_bits(float f) { const _Float16 h = (_Float16)f; unsigned short u; __builtin_memcpy(&u, &h, 2); return u; }
template <bool IMPORT_SEL>
__device__ void phase_dsa(const Params& p, int l, unsigned char* lds, bf16_t* yc, const unsigned short* gsel, const int* gnsel, int tb, int te, int tstep) {
    unsigned short* s_sc = (unsigned short*)lds;
    bf16_t* s_qi = (bf16_t*)(lds + 66048);
    bf16_t* s_Q = (bf16_t*)lds;
    unsigned short* s_sel = (unsigned short*)(lds + 82432 + 65536);
    int* s_nsel = (int*)(lds + 82432 + 65536 + 8192);
    unsigned char* dob = OUTB(p);
    const bf16_t* cqn = (const bf16_t*)(dob + DO_CQN);
    const bf16_t* kv = (const bf16_t*)(dob + DO_KV);
    const bf16_t* kidx = (const bf16_t*)(dob + DO_KIDX);
    const float* whead = (const float*)(dob + DO_WHEAD);
    const float* ctab = (const float*)(WS(p) + OFF_ROPE);
    const float* stab = ctab + TS * 16;
    const bf16_t* wb = (const bf16_t*)(WS(p) + OFF_WB);
    const bf16_t* wqiT = wb + WB_QI;
    const bf16_t* wuqT = wb + WB_UQ;
    const bf16_t* wuk = wb + WB_UK;
    const bf16_t* wuvT = wb + WB_UV;
    const float scale = 0.10206207261596575f;
    const f32x4 z4 = {0.f, 0.f, 0.f, 0.f};
    bf16_t* gq = (obid() < QS_WS) ? (bf16_t*)(WS(p) + WS_END + (size_t)obid() * QS_BYTES) : (bf16_t*)(OUTB(p) + DO_END + (size_t)(obid() - QS_WS) * QS_BYTES);
    for (int pair = tb; pair < te; pair += tstep) {
        const int qt = 128 - (pair >> 2);
        const int t0 = qt * 16;
#pragma unroll 1
        for (int half = 0; half < 2; ++half) {
        const int tid = otid(), lane = tid & 63, wid = tid >> 6, fr = lane & 15, fq = lane >> 4;
        unsigned char* s_Vw = lds + 82432 + wid * 8192;
        bf16_t* s_qn = (bf16_t*)s_Vw;
        const int b = (pair & 3) * 2 + half;
        const size_t n0 = (size_t)b * TS + t0;
        {
            bf16x8 acq[8];
#pragma unroll
            for (int kk = 0; kk < 8; ++kk) acq[kk] = *(const bf16x8*)(cqn + (n0 + fr) * 256 + kk * 32 + fq * 8);
            f32x4 c[4] = {z4, z4, z4, z4};
#pragma unroll
            for (int kb = 0; kb < 8; kb += 4) {
                bf16x8 bf[4][4];
#pragma unroll
                for (int k4 = 0; k4 < 4; ++k4)
#pragma unroll
                    for (int nt = 0; nt < 4; ++nt) bf[k4][nt] = *(const bf16x8*)(wqiT + (size_t)(wid * 64 + nt * 16 + fr) * 256 + (kb + k4) * 32 + fq * 8);
#pragma unroll
                for (int k4 = 0; k4 < 4; ++k4)
#pragma unroll
                    for (int nt = 0; nt < 4; ++nt) c[nt] = __builtin_amdgcn_mfma_f32_16x16x32_bf16(acq[kb + k4], bf[k4][nt], c[nt], 0, 0, 0);
            }
#pragma unroll
            for (int j = 0; j < 4; ++j) {
                const int t = t0 + fq * 4 + j;
                const float cs = ctab[t * 16 + fr], sn = stab[t * 16 + fr];
                const float x1 = c[0][j], x2 = c[1][j];
                c[0][j] = x1 * cs - x2 * sn; c[1][j] = x2 * cs + x1 * sn;
            }
#pragma unroll
            for (int nt = 0; nt < 4; ++nt)
#pragma unroll
                for (int j = 0; j < 4; ++j) s_qi[(fq * 4 + j) * 512 + wid * 64 + nt * 16 + fr] = f2bf(c[nt][j]);
        }
        __syncthreads();
        if (!IMPORT_SEL) {
            bf16x8 aq[8][2];
#pragma unroll
            for (int h = 0; h < 8; ++h)
#pragma unroll
                for (int ks = 0; ks < 2; ++ks) aq[h][ks] = *(const bf16x8*)(s_qi + fr * 512 + h * 64 + ks * 32 + fq * 8);
            float wh[4][8];
#pragma unroll
            for (int j = 0; j < 4; ++j) {
                const float4 w0 = *(const float4*)(whead + (n0 + fq * 4 + j) * 8), w1 = *(const float4*)(whead + (n0 + fq * 4 + j) * 8 + 4);
                wh[j][0] = w0.x; wh[j][1] = w0.y; wh[j][2] = w0.z; wh[j][3] = w0.w; wh[j][4] = w1.x; wh[j][5] = w1.y; wh[j][6] = w1.z; wh[j][7] = w1.w;
            }
            const int nkt = qt + 1;
            bf16x8 nb0 = {0, 0, 0, 0, 0, 0, 0, 0}, nb1 = nb0;
            if (wid < nkt) { const bf16_t* kr0 = kidx + ((size_t)b * TS + wid * 16 + fr) * 64 + fq * 8; nb0 = *(const bf16x8*)kr0; nb1 = *(const bf16x8*)(kr0 + 32); }
#pragma unroll 1
            for (int kt = wid; kt < nkt; kt += 8) {
                const bf16x8 bk0 = nb0, bk1 = nb1;
                if (kt + 8 < nkt) { const bf16_t* krn = kidx + ((size_t)b * TS + (kt + 8) * 16 + fr) * 64 + fq * 8; nb0 = *(const bf16x8*)krn; nb1 = *(const bf16x8*)(krn + 32); }
                float I[4] = {0.f, 0.f, 0.f, 0.f};
#pragma unroll
                for (int h = 0; h < 8; ++h) {
                    f32x4 a = __builtin_amdgcn_mfma_f32_16x16x32_bf16(aq[h][0], bk0, z4, 0, 0, 0);
                    a = __builtin_amdgcn_mfma_f32_16x16x32_bf16(aq[h][1], bk1, a, 0, 0, 0);
#pragma unroll
                    for (int j = 0; j < 4; ++j) I[j] += wh[j][h] * fmaxf(a[j], 0.f);
                }
#pragma unroll
                for (int j = 0; j < 4; ++j) s_sc[(fq * 4 + j) * 2064 + kt * 16 + fr] = (unsigned short)f2h_bits(I[j]);
            }
        }
        __syncthreads();
#pragma unroll 1
        for (int qi2 = 0; qi2 < 2; ++qi2) {
            const int q = wid + qi2 * 8;
            const int nadm = t0 + q + 1;
            unsigned short* sel = s_sel + q * 256;
            if (IMPORT_SEL) {
                const int ns = gnsel[n0 + q];
                for (int i = lane; i < ns; i += 64) sel[i] = gsel[(n0 + q) * 256 + i];
                if (lane == 0) s_nsel[q] = ns;
            } else if (nadm <= 256) {
                for (int i = lane; i < nadm; i += 64) sel[i] = (unsigned short)i;
                if (lane == 0) s_nsel[q] = nadm;
            } else {
                unsigned* hist = (unsigned*)(lds + 82432 + wid * 8192);
                const unsigned short* scq = s_sc + q * 2064;
                const int nch = (nadm + 63) >> 6;
                unsigned B1 = 0u; int na1 = 0, na2 = 0; unsigned T = 0u;
#pragma unroll 1
                for (int pass = 0; pass < 2; ++pass) {
                    *(uint4*)(hist + lane * 4) = make_uint4(0u, 0u, 0u, 0u);
#pragma unroll 1
                    for (int c0 = 0; c0 < nch; c0 += 8) {
                        unsigned kb[8];
#pragma unroll
                        for (int j = 0; j < 8; ++j) { const int s_ = (c0 + j) * 64 + lane; kb[j] = (s_ < nadm) ? (unsigned)scq[s_] : 0x10000u; }
#pragma unroll
                        for (int j = 0; j < 8; ++j) {
                            const unsigned u = kb[j];
                            const unsigned k = (u & 0x8000u) ? (~u & 0xFFFFu) : (u | 0x8000u);
                            const bool ok = (u < 0x10000u) && (pass == 0 || (k >> 8) == B1);
                            if (ok) atomicAdd(hist + (pass == 0 ? (k >> 8) : (k & 255u)), 1u);
                        }
                    }
                    const int need = 256 - na1;
                    const uint4 h4 = *(const uint4*)(hist + lane * 4);
                    const int sl = (int)(h4.x + h4.y + h4.z + h4.w);
                    int suf = sl;
#pragma unroll
                    for (int o = 1; o < 64; o <<= 1) { const int t_ = __shfl_down(suf, o); suf += (lane + o < 64) ? t_ : 0; }
                    const int above = suf - sl;
                    const bool mine = (suf >= need) && (above < need);
                    int a = above, bsel, asel;
                    if (a + (int)h4.w >= need) { bsel = 3; asel = a; }
                    else { a += (int)h4.w;
                        if (a + (int)h4.z >= need) { bsel = 2; asel = a; }
                        else { a += (int)h4.z;
                            if (a + (int)h4.y >= need) { bsel = 1; asel = a; }
                            else { a += (int)h4.y; bsel = 0; asel = a; } } }
                    const int src = __ffsll((long long)__ballot(mine)) - 1;
                    const unsigned bin = (unsigned)__shfl(lane * 4 + bsel, src); const int nab = __shfl(asel, src);
                    if (pass == 0) { B1 = bin; na1 = nab; } else { T = (B1 << 8) | bin; na2 = nab; }
                }
                {
                    const int rties = 256 - (na1 + na2);
                    int base = 0, ties = 0;
                    const unsigned long long ltmask = (1ull << lane) - 1ull;
#pragma unroll 1
                    for (int c0 = 0; c0 < nch; c0 += 4) {
                        unsigned kb[4];
#pragma unroll
                        for (int j = 0; j < 4; ++j) { const int s_ = (c0 + j) * 64 + lane; kb[j] = (s_ < nadm) ? (unsigned)scq[s_] : 0x10000u; }
#pragma unroll
                        for (int j = 0; j < 4; ++j) {
                            const int s_ = (c0 + j) * 64 + lane;
                            const unsigned u = kb[j];
                            const bool valid = u < 0x10000u;
                            const unsigned k = (u & 0x8000u) ? (~u & 0xFFFFu) : (u | 0x8000u);
                            const bool gt = valid && k > T, eq = valid && k == T;
                            const unsigned long long em = __ballot(eq);
                            const int myrank = ties + __popcll(em & ltmask);
                            const bool take = gt || (eq && myrank < rties);
                            const unsigned long long tm = __ballot(take);
                            const int pos = base + __popcll(tm & ltmask);
                            if (take && pos < 256) sel[pos] = (unsigned short)s_;
                            base += __popcll(tm); ties += __popcll(em);
                        }
                    }
                }
                if (lane == 0) s_nsel[q] = 256;
            }
        }
        __syncthreads();
        if (half == 0) {
            const size_t n0B = n0 + TS;
            bf16_t* s_qnB = s_qn + 1024;
#pragma unroll 1
            for (int hi = 0; hi < 2; ++hi) {
                const int hh = wid * 2 + hi;
                const bf16_t* caA = cqn + (n0 + fr) * 256 + fq * 8;
                const bf16_t* caB = cqn + (n0B + fr) * 256 + fq * 8;
                f32x4 cA[6] = {z4, z4, z4, z4, z4, z4}, cB[6] = {z4, z4, z4, z4, z4, z4};
#pragma unroll
                for (int kb = 0; kb < 8; kb += 2) {
                    bf16x8 bf[2][6], aA[2], aB[2];
#pragma unroll
                    for (int k2 = 0; k2 < 2; ++k2) {
                        aA[k2] = *(const bf16x8*)(caA + (kb + k2) * 32); aB[k2] = *(const bf16x8*)(caB + (kb + k2) * 32);
#pragma unroll
                        for (int nt = 0; nt < 6; ++nt) bf[k2][nt] = *(const bf16x8*)(wuqT + (size_t)(hh * 96 + nt * 16 + fr) * 256 + (kb + k2) * 32 + fq * 8);
                    }
#pragma unroll
                    for (int k2 = 0; k2 < 2; ++k2)
#pragma unroll
                        for (int nt = 0; nt < 6; ++nt) {
                            cA[nt] = __builtin_amdgcn_mfma_f32_16x16x32_bf16(aA[k2], bf[k2][nt], cA[nt], 0, 0, 0);
                            cB[nt] = __builtin_amdgcn_mfma_f32_16x16x32_bf16(aB[k2], bf[k2][nt], cB[nt], 0, 0, 0);
                        }
                }
#pragma unroll
                for (int j = 0; j < 4; ++j) {
                    const int q = fq * 4 + j, t = t0 + q;
                    const float cs = ctab[t * 16 + fr], sn = stab[t * 16 + fr];
                    s_Q[(q * 16 + hh) * 160 + 128 + fr] = f2bf(cA[4][j] * cs - cA[5][j] * sn);
                    s_Q[(q * 16 + hh) * 160 + 144 + fr] = f2bf(cA[5][j] * cs + cA[4][j] * sn);
                    gq[(q * 16 + hh) * 160 + 128 + fr] = f2bf(cB[4][j] * cs - cB[5][j] * sn);
                    gq[(q * 16 + hh) * 160 + 144 + fr] = f2bf(cB[5][j] * cs + cB[4][j] * sn);
#pragma unroll
                    for (int nt = 0; nt < 4; ++nt) { s_qn[q * 64 + nt * 16 + fr] = f2bf(cA[nt][j]); s_qnB[q * 64 + nt * 16 + fr] = f2bf(cB[nt][j]); }
                }
                __syncthreads();
                bf16x8 anA[2], anB[2];
#pragma unroll
                for (int ks = 0; ks < 2; ++ks) { anA[ks] = *(const bf16x8*)(s_qn + fr * 64 + ks * 32 + fq * 8); anB[ks] = *(const bf16x8*)(s_qnB + fr * 64 + ks * 32 + fq * 8); }
                bf16x8 bwk[8][2];
#pragma unroll
                for (int nt = 0; nt < 8; ++nt)
#pragma unroll
                    for (int ks = 0; ks < 2; ++ks) bwk[nt][ks] = *(const bf16x8*)(wuk + (size_t)(hh * 128 + nt * 16 + fr) * 64 + ks * 32 + fq * 8);
#pragma unroll
                for (int nt = 0; nt < 8; ++nt) {
                    f32x4 aA = z4, aB = z4;
#pragma unroll
                    for (int ks = 0; ks < 2; ++ks) {
                        aA = __builtin_amdgcn_mfma_f32_16x16x32_bf16(anA[ks], bwk[nt][ks], aA, 0, 0, 0);
                        aB = __builtin_amdgcn_mfma_f32_16x16x32_bf16(anB[ks], bwk[nt][ks], aB, 0, 0, 0);
                    }
#pragma unroll
                    for (int j = 0; j < 4; ++j) {
                        s_Q[((fq * 4 + j) * 16 + hh) * 160 + nt * 16 + fr] = f2bf(aA[j]);
                        gq[((fq * 4 + j) * 16 + hh) * 160 + nt * 16 + fr] = f2bf(aB[j]);
                    }
                }
                __syncthreads();
            }
        } else {
            for (int e = tid; e < QS_BYTES / 16; e += NTHR) ((uint4*)s_Q)[e] = ((const uint4*)gq)[e];
            __syncthreads();
        }
#pragma unroll 1
        for (int qi2 = 0; qi2 < 2; ++qi2) {
            const int q = wid + qi2 * 8;
            bf16x8 bq[5];
#pragma unroll
            for (int ks = 0; ks < 5; ++ks) bq[ks] = *(const bf16x8*)(s_Q + (q * 16 + fr) * 160 + ks * 32 + fq * 8);
            const int nsel = s_nsel[q];
            const unsigned short* sel = s_sel + q * 256;
            float m = -INFINITY, lsum = 0.f;
            f32x4 O[8] = {z4, z4, z4, z4, z4, z4, z4, z4};
            const int nchunk = (nsel + 31) >> 5;
            bf16x8 akn[2][5];
#pragma unroll
            for (int mt = 0; mt < 2; ++mt) {
                const int ki = mt * 16 + fr;
                const int sidx = sel[ki < nsel ? ki : 0];
                const bf16_t* krow = kv + ((size_t)b * TS + sidx) * 160 + fq * 8;
#pragma unroll
                for (int ks = 0; ks < 5; ++ks) akn[mt][ks] = *(const bf16x8*)(krow + ks * 32);
            }
#pragma unroll 1
            for (int ch = 0; ch < nchunk; ++ch) {
                bf16x8 ak[2][5];
#pragma unroll
                for (int mt = 0; mt < 2; ++mt)
#pragma unroll
                    for (int ks = 0; ks < 5; ++ks) ak[mt][ks] = akn[mt][ks];
                if (ch + 1 < nchunk) {
#pragma unroll
                    for (int mt = 0; mt < 2; ++mt) {
                        const int ki = (ch + 1) * 32 + mt * 16 + fr;
                        const int sidx = sel[ki < nsel ? ki : 0];
                        const bf16_t* krow = kv + ((size_t)b * TS + sidx) * 160 + fq * 8;
#pragma unroll
                        for (int ks = 0; ks < 5; ++ks) akn[mt][ks] = *(const bf16x8*)(krow + ks * 32);
                    }
                }
#pragma unroll
                for (int mt = 0; mt < 2; ++mt)
#pragma unroll
                    for (int ks = 0; ks < 4; ++ks) {
                        const int r = mt * 16 + fr;
                        *(bf16x8*)(s_Vw + r * 256 + (((ks * 2 + (fq >> 1)) ^ (r & 7)) * 32) + (fq & 1) * 16) = ak[mt][ks];
                    }
                f32x4 st[2] = {z4, z4};
#pragma unroll
                for (int mt = 0; mt < 2; ++mt)
#pragma unroll
                    for (int ks = 0; ks < 5; ++ks) st[mt] = __builtin_amdgcn_mfma_f32_16x16x32_bf16(ak[mt][ks], bq[ks], st[mt], 0, 0, 0);
                float sv[2][4]; float cmax = -INFINITY;
#pragma unroll
                for (int mt = 0; mt < 2; ++mt)
#pragma unroll
                    for (int j = 0; j < 4; ++j) {
                        const int ke = ch * 32 + mt * 16 + fq * 4 + j;
                        const float s_ = (ke < nsel) ? st[mt][j] * scale : -INFINITY;
                        sv[mt][j] = s_; cmax = fmaxf(cmax, s_);
                    }
                cmax = fmaxf(cmax, __shfl_xor(cmax, 16)); cmax = fmaxf(cmax, __shfl_xor(cmax, 32));
                const float mnew = fmaxf(m, cmax);
                const float alpha = __expf(m - mnew);
                float psum = 0.f;
#pragma unroll
                for (int mt = 0; mt < 2; ++mt)
#pragma unroll
                    for (int j = 0; j < 4; ++j) { const float pe = __expf(sv[mt][j] - mnew); sv[mt][j] = pe; psum += pe; }
                psum += __shfl_xor(psum, 16); psum += __shfl_xor(psum, 32);
                lsum = lsum * alpha + psum; m = mnew;
#pragma unroll
                for (int ct = 0; ct < 8; ++ct) O[ct] = O[ct] * alpha;
                bf16x8 pf;
#pragma unroll
                for (int mt = 0; mt < 2; ++mt)
#pragma unroll
                    for (int j = 0; j < 4; ++j) pf[mt * 4 + j] = (short)f2bf(sv[mt][j]);
                const int q_ = fr >> 2, p_ = fr & 3;
                const int r0 = fq * 4 + q_, r1 = 16 + r0;
#pragma unroll
                for (int ct = 0; ct < 8; ++ct) {
                    const s16x4 v0 = __builtin_amdgcn_ds_read_tr16_b64_v4i16((__attribute__((address_space(3))) s16x4*)(s_Vw + r0 * 256 + ((ct ^ (r0 & 7)) * 32) + p_ * 8));
                    const s16x4 v1 = __builtin_amdgcn_ds_read_tr16_b64_v4i16((__attribute__((address_space(3))) s16x4*)(s_Vw + r1 * 256 + ((ct ^ (r1 & 7)) * 32) + p_ * 8));
                    bf16x8 av; av[0] = v0[0]; av[1] = v0[1]; av[2] = v0[2]; av[3] = v0[3]; av[4] = v1[0]; av[5] = v1[1]; av[6] = v1[2]; av[7] = v1[3];
                    O[ct] = __builtin_amdgcn_mfma_f32_16x16x32_bf16(av, pf, O[ct], 0, 0, 0);
                }
            }
            const float inv = 1.0f / lsum;
#pragma unroll
            for (int ct = 0; ct < 8; ++ct)
#pragma unroll
                for (int j = 0; j < 4; ++j) s_Q[(q * 16 + fr) * 160 + ct * 16 + fq * 4 + j] = f2bf(O[ct][j] * inv);
        }
        __syncthreads();
#pragma unroll 1
        for (int hi = 0; hi < 2; ++hi) {
            const int hh = wid * 2 + hi;
            bf16x8 ao[4];
#pragma unroll
            for (int ks = 0; ks < 4; ++ks) ao[ks] = *(const bf16x8*)(s_Q + (fr * 16 + hh) * 160 + ks * 32 + fq * 8);
#pragma unroll
            for (int nt = 0; nt < 4; ++nt) {
                f32x4 a = z4;
#pragma unroll
                for (int ks = 0; ks < 4; ++ks)
                    a = __builtin_amdgcn_mfma_f32_16x16x32_bf16(ao[ks], *(const bf16x8*)(wuvT + (size_t)(hh * 64 + nt * 16 + fr) * 128 + ks * 32 + fq * 8), a, 0, 0, 0);
#pragma unroll
                for (int j = 0; j < 4; ++j) yc[(n0 + fq * 4 + j) * 1024 + hh * 64 + nt * 16 + fr] = f2bf(a[j]);
            }
        }
        __syncthreads();
        }
    }
}


__device__ void phase_lr_prep(const Params& p, int l) {
    const int lane = otid() & 63;
    const int wave = (obid() * NTHR + otid()) >> 6, nw = gridDim.x * NTHR / 64;
    const bf16_t* pm = (const bf16_t*)(WS(p) + OFF_PMISC);
    bf16_t* alr = (bf16_t*)(OUTB(p) + DO_ALR);
    const float4 mu4 = *(const float4*)(p.in[4] + (size_t)l * 3328 + 3072 + lane * 4);
    const float4 vm4 = *(const float4*)(p.in[18] + (lane & 7) * 4);
    struct In { uint2 c0, p0, c1, p1; };
    auto load = [&](int n) {
        In r;
        const bf16_t* row = pm + (size_t)n * PM_LD;
        const bool hp = (n % TS) > 0;
        r.c0 = *(const uint2*)(row + lane * 4);
        r.p0 = hp ? *(const uint2*)(row - PM_LD + lane * 4) : make_uint2(0u, 0u);
        r.c1 = make_uint2(0u, 0u); r.p1 = r.c1;
        if (lane < 8) { r.c1 = *(const uint2*)(row + 256 + lane * 4); if (hp) r.p1 = *(const uint2*)(row - PM_LD + 256 + lane * 4); }
        return r;
    };
    auto mix4 = [&](const uint2 c, const uint2 q, const float4 m, float (&o)[4]) {
        const float c0 = __uint_as_float(c.x << 16), c1 = __uint_as_float(c.x & 0xFFFF0000u), c2 = __uint_as_float(c.y << 16), c3 = __uint_as_float(c.y & 0xFFFF0000u);
        const float q0 = __uint_as_float(q.x << 16), q1 = __uint_as_float(q.x & 0xFFFF0000u), q2 = __uint_as_float(q.y << 16), q3 = __uint_as_float(q.y & 0xFFFF0000u);
        o[0] = c0 + (q0 - c0) * m.x; o[1] = c1 + (q1 - c1) * m.y; o[2] = c2 + (q2 - c2) * m.z; o[3] = c3 + (q3 - c3) * m.w;
    };
    In cur = load(wave < NT ? wave : 0);
    for (int n = wave; n < NT; n += nw) {
        const In x = cur;
        if (n + nw < NT) cur = load(n + nw);
        float o[4];
        mix4(x.c0, x.p0, mu4, o);
        if (lane < 16) { o[0] = tanhf(o[0]); o[1] = tanhf(o[1]); o[2] = tanhf(o[2]); o[3] = tanhf(o[3]); }
        else if (lane >= 32) { o[0] = sigmoidf_(o[0]); o[1] = sigmoidf_(o[1]); o[2] = sigmoidf_(o[2]); o[3] = sigmoidf_(o[3]); }
        *(uint2*)(alr + (size_t)n * 288 + lane * 4) = pack4(o[0], o[1], o[2], o[3]);
        if (lane < 8) {
            mix4(x.c1, x.p1, vm4, o);
            *(uint2*)(alr + (size_t)n * 288 + 256 + lane * 4) = pack4(o[0], o[1], o[2], o[3]);
        }
    }
}

typedef short sh4 __attribute__((ext_vector_type(4)));
__device__ __forceinline__ sh4 pk4v(const f32x4& v) { const uint2 u = pack4(v[0], v[1], v[2], v[3]); sh4 r; __builtin_memcpy(&r, &u, 8); return r; }
__device__ __forceinline__ bf16x8 cat8(const sh4& a, const sh4& b) { bf16x8 r; r[0] = a[0]; r[1] = a[1]; r[2] = a[2]; r[3] = a[3]; r[4] = b[0]; r[5] = b[1]; r[6] = b[2]; r[7] = b[3]; return r; }
#define MF32(a, b, c) __builtin_amdgcn_mfma_f32_16x16x32_bf16(a, b, c, 0, 0, 0)
#define MF16(a, b, c) MF32(cat8(a, sh4{0, 0, 0, 0}), cat8(b, sh4{0, 0, 0, 0}), c)
constexpr int SC_LT = 72;
constexpr int SC_LS = 36;
constexpr int SC_TC = 32;
constexpr int SC_ROWB = 1088;
__device__ __forceinline__ const unsigned char* scan_piece_src(const Params& p, int l, int b, int hc, int t0, int pi, bool& ok) {
    const int tau = pi / 68, seg = pi - tau * 68;
    const int t = t0 + tau;
    ok = (t < TS) && (tau < SC_TC);
    const size_t n = (size_t)b * TS + t;
    const unsigned char* ws = WS(p);
    if (seg < 8) return ws + OFF_PR + (n * 1024 + hc) * 2 + seg * 16;
    if (seg < 16) return ws + OFF_PK + (n * 1024 + hc) * 2 + (seg - 8) * 16;
    if (seg < 24) return ws + OFF_PV + (n * 1024 + hc) * 2 + (seg - 16) * 16;
    if (seg < 60) return OUTB(p) + DO_ALR + (n * 288) * 2 + (seg - 24) * 16;
    ok = ok && (l > 0);
    return ws + OFF_VFIRST + (n * 1024 + hc) * 2 + (seg - 60) * 16;
}
__device__ void phase_scan5(const Params& p, int l, unsigned char* lds, int blk) {
    const int tid = otid(), lane = tid & 63, wid = tid >> 6, fr = lane & 15, fq = lane >> 4;
    const int b = blk >> 4, hh = blk & 15, hc = hh * 64;
    float* s_r = (float*)lds;
    float* s_w = s_r + 2048;
    float* s_k = s_w + 2048;
    float* s_v = s_k + 2048;
    float* s_a = s_v + 2048;
    float* s_b = s_a + 2048;
    float* s_g = s_b + 2048;
    float* s_o = s_g + 2048;
    bf16_t* o_at = (bf16_t*)(s_o + 2048);
    bf16_t* o_rt = o_at + 32 * SC_LT;
    bf16_t* o_bt = o_rt + 32 * SC_LT;
    bf16_t* o_kt = o_bt + 32 * SC_LT;
    bf16_t* o_bT = o_kt + 32 * SC_LT;
    bf16_t* o_kT = o_bT + 64 * SC_LS;
    bf16_t* o_vT = o_kT + 64 * SC_LS;
    float* s_gc = (float*)(o_vT + 64 * SC_LS);
    unsigned char* raw = (unsigned char*)(s_gc + 128);
    float* prevb = (float*)(raw + 32 * SC_ROWB);
    unsigned* prevr = (unsigned*)prevb;
    float* cst = prevb + 960;
    float* s_gB = s_r;
    float* s_oB = s_k;
    float* s_vB = cst + 992;
    float* s_bs2 = s_vB + 2048;
    const float* mu = p.in[4] + (size_t)l * 3328;
    for (int e = tid; e < 480; e += NTHR) {
        float v;
        if (e < 192) v = mu[(e >> 6) * 1024 + hc + (e & 63)];
        else if (e < 448) v = mu[3072 + (e - 192)];
        else v = p.in[18][e - 448];
        cst[e] = v;
    }
    if (tid < 64) {
        cst[480 + tid] = p.in[7][l * 1024 + hc + tid];
        cst[544 + tid] = p.in[9][l * 1024 + hc + tid];
        cst[608 + tid] = p.in[12][l * 1024 + hc + tid];
        cst[672 + tid] = p.in[13][l * 1024 + hc + tid];
        cst[736 + tid] = p.in[14][l * 1024 + hc + tid];
        cst[800 + tid] = p.in[15][l * 1024 + hc + tid];
        cst[864 + tid] = p.in[16][l * 1024 + hc + tid];
        cst[928 + tid] = p.in[19][hc + tid];
    }
    const int mm = wid >> 1, ntb = (wid & 1) * 2;
    const int nks = (mm == 2) ? 4 : (mm == 3 ? 1 : 2);
    bf16x8 Bw[2][4];
    {
        const float* wsrc = (mm == 0) ? p.in[8] + (size_t)l * 64 * 1024 : (mm == 1) ? p.in[10] + (size_t)l * 64 * 1024 : (mm == 2) ? p.in[11] + (size_t)l * 128 * 1024 : p.in[20];
#pragma unroll
        for (int n2 = 0; n2 < 2; ++n2)
#pragma unroll
            for (int ks = 0; ks < 4; ++ks) {
                bf16x8 f;
#pragma unroll
                for (int j = 0; j < 8; ++j) {
                    const bool okw = ks < nks && (mm < 3 || l > 0);
                    const float v = wsrc[(size_t)(okw ? (ks * 32 + fq * 8 + j) : 0) * 1024 + hc + (ntb + n2) * 16 + fr];
                    f[j] = (short)f2bf(okw ? v : 0.f);
                }
                Bw[n2][ks] = f;
            }
    }
    const f32x4 z4 = {0.f, 0.f, 0.f, 0.f};
    f32x4 S[4] = {z4, z4, z4, z4};
    sh4 Lf;
#pragma unroll
    for (int j = 0; j < 4; ++j) Lf[j] = (fq * 4 + j <= fr) ? (short)0x3F80 : (short)0;
    bf16_t* Pr = (bf16_t*)(WS(p) + OFF_PR);
    bf16_t* vfirst = (bf16_t*)(WS(p) + OFF_VFIRST);
    const unsigned char* psrc[5]; int pstep[5], ptau[5]; bool pval[5];
#pragma unroll
    for (int k = 0; k < 5; ++k) {
        const int pi = tid + k * NTHR;
        bool ok = false;
        psrc[k] = scan_piece_src(p, l, b, hc, 0, pi < SC_TC * 68 ? pi : 0, ok);
        const int tau = (pi < SC_TC * 68 ? pi : 0) / 68, seg = (pi < SC_TC * 68 ? pi : 0) - tau * 68;
        ptau[k] = tau;
        pstep[k] = SC_TC * ((seg >= 24 && seg < 60) ? 576 : 2048);
        pval[k] = (pi < SC_TC * 68) && !(seg >= 60 && l == 0);
    }
    uint4 pre[5];
#pragma unroll
    for (int k = 0; k < 5; ++k) { pre[k] = make_uint4(0, 0, 0, 0); if (pval[k] && ptau[k] < TS) pre[k] = *(const uint4*)psrc[k]; }
    __syncthreads();
    auto stepE = [&](int tau, int c4, const float* so, const float* sv, const float* sgp, const float* sb, int t0e, int nve) {
        const int e = tau * 64 + c4;
        const size_t n = (size_t)b * TS + t0e + tau;
        const float4 o4 = *(const float4*)(so + e), v4_ = *(const float4*)(sv + e), g4_ = *(const float4*)(sgp + e);
        const float4 clw = *(const float4*)(cst + 800 + c4), clb = *(const float4*)(cst + 864 + c4);
        const float bsum = sb[tau];
        const float m_ = row16_sum((o4.x + o4.y) + (o4.z + o4.w)) * (1.0f / 64.0f);
        const float d0 = o4.x - m_, d1 = o4.y - m_, d2 = o4.z - m_, d3 = o4.w - m_;
        const float var = row16_sum(d0 * d0 + d1 * d1 + d2 * d2 + d3 * d3) * (1.0f / 64.0f);
        const float rs = rsqrtf(var + 64e-5f);
        const float y0 = (d0 * rs * clw.x + clb.x + bsum * v4_.x) * g4_.x, y1 = (d1 * rs * clw.y + clb.y + bsum * v4_.y) * g4_.y;
        const float y2 = (d2 * rs * clw.z + clb.z + bsum * v4_.z) * g4_.z, y3 = (d3 * rs * clw.w + clb.w + bsum * v4_.w) * g4_.w;
        if (tau < nve) *(uint2*)(Pr + n * 1024 + hc + c4) = pack4(y0, y1, y2, y3);
    };
#pragma unroll 1
    for (int t0 = 0, ch = 0; t0 < TS; t0 += SC_TC, ++ch) {
        const int nval = (TS - t0 < SC_TC) ? (TS - t0) : SC_TC;
        const bool par = (ch & 1) != 0;
        float* g_c = par ? s_gB : s_g; float* o_c = par ? s_oB : s_o; float* v_c = par ? s_vB : s_v; float* bs_c = s_bs2 + (par ? 32 : 0);
        float* g_p = par ? s_g : s_gB; float* o_p = par ? s_o : s_oB; float* v_p = par ? s_v : s_vB; float* bs_p = s_bs2 + (par ? 0 : 32);
#pragma unroll
        for (int k = 0; k < 5; ++k) { const int pi = tid + k * NTHR; if (pi < SC_TC * 68) *(uint4*)(raw + pi * 16) = pre[k]; }
        lds_barrier();
#pragma unroll
        for (int k = 0; k < 5; ++k) {
            pre[k] = make_uint4(0, 0, 0, 0);
            if (pval[k] && t0 + SC_TC + ptau[k] < TS) pre[k] = *(const uint4*)(psrc[k] + (size_t)(ch + 1) * pstep[k]);
        }
        if (mm < 3 || l > 0) {
            const unsigned char* Ab = raw + ((mm == 0) ? 384 : (mm == 1) ? 512 : (mm == 2) ? 640 : 896);
            float* dst = (mm == 0) ? s_w : (mm == 1) ? s_a : (mm == 2) ? g_c : o_c;
#pragma unroll
            for (int m = 0; m < 2; ++m) {
                f32x4 acc0 = {0.f, 0.f, 0.f, 0.f}, acc1 = {0.f, 0.f, 0.f, 0.f};
#pragma unroll
                for (int ks = 0; ks < 4; ++ks) {
                    if (ks < nks) {
                        const bf16x8 a = *(const bf16x8*)(Ab + (m * 16 + fr) * SC_ROWB + ks * 64 + fq * 16);
                        acc0 = __builtin_amdgcn_mfma_f32_16x16x32_bf16(a, Bw[0][ks], acc0, 0, 0, 0);
                        acc1 = __builtin_amdgcn_mfma_f32_16x16x32_bf16(a, Bw[1][ks], acc1, 0, 0, 0);
                    }
                }
                if (mm == 0) {
                    const float cw0 = cst[480 + ntb * 16 + fr], cw1 = cst[480 + (ntb + 1) * 16 + fr];
                    f32x4 l0, l1, r0, r1;
#pragma unroll
                    for (int j = 0; j < 4; ++j) { l0[j] = -0.6065306597126334f * fast_sigmoid(acc0[j] + cw0); l1[j] = -0.6065306597126334f * fast_sigmoid(acc1[j] + cw1); }
                    const uint2 h0 = pack4(l0[0], l0[1], l0[2], l0[3]), h1 = pack4(l1[0], l1[1], l1[2], l1[3]);
                    r0[0] = l0[0] - __uint_as_float(h0.x << 16); r0[1] = l0[1] - __uint_as_float(h0.x & 0xFFFF0000u); r0[2] = l0[2] - __uint_as_float(h0.y << 16); r0[3] = l0[3] - __uint_as_float(h0.y & 0xFFFF0000u);
                    r1[0] = l1[0] - __uint_as_float(h1.x << 16); r1[1] = l1[1] - __uint_as_float(h1.x & 0xFFFF0000u); r1[2] = l1[2] - __uint_as_float(h1.y << 16); r1[3] = l1[3] - __uint_as_float(h1.y & 0xFFFF0000u);
                    sh4 hh0, hh1; __builtin_memcpy(&hh0, &h0, 8); __builtin_memcpy(&hh1, &h1, 8);
                    f32x4 c0 = MF16(Lf, pk4v(r0), z4), c1 = MF16(Lf, pk4v(r1), z4);
                    c0 = MF16(Lf, hh0, c0); c1 = MF16(Lf, hh1, c1);
#pragma unroll
                    for (int j = 0; j < 4; ++j) {
                        const int eo = (m * 16 + fq * 4 + j) * 64 + ntb * 16 + fr;
                        s_w[eo] = c0[j]; s_w[eo + 16] = c1[j];
                        s_b[eo] = l0[j]; s_b[eo + 16] = l1[j];
                    }
                } else {
#pragma unroll
                    for (int j = 0; j < 4; ++j) {
                        dst[(m * 16 + fq * 4 + j) * 64 + ntb * 16 + fr] = acc0[j];
                        dst[(m * 16 + fq * 4 + j) * 64 + (ntb + 1) * 16 + fr] = acc1[j];
                    }
                }
            }
        }
        lds_barrier();
        {
            const int tau = tid >> 4, c4 = (tid & 15) * 4, e = tau * 64 + c4, t = t0 + tau;
            const size_t n = (size_t)b * TS + t;
            const float4 cum4 = *(const float4*)(s_w + e), lw4 = *(const float4*)(s_b + e), xa4 = *(const float4*)(s_a + e);
            const float4 ca = *(const float4*)(cst + 544 + c4), ckk = *(const float4*)(cst + 608 + c4), cka = *(const float4*)(cst + 672 + c4), crk = *(const float4*)(cst + 736 + c4);
            const float cum[4] = {cum4.x, cum4.y, cum4.z, cum4.w}, lw[4] = {lw4.x, lw4.y, lw4.z, lw4.w};
            const float xa[4] = {xa4.x + ca.x, xa4.y + ca.y, xa4.z + ca.z, xa4.w + ca.w};
            const float kkc[4] = {ckk.x, ckk.y, ckk.z, ckk.w}, kac[4] = {cka.x, cka.y, cka.z, cka.w};
            float rr[4], kr[4], vv[4];
            {
                const unsigned char* rc = raw + tau * SC_ROWB + c4 * 2;
                const uint2 cr = *(const uint2*)rc, ck = *(const uint2*)(rc + 128), cv = *(const uint2*)(rc + 256);
                uint2 qr = make_uint2(0u, 0u), qk = qr, qv = qr;
                if (tau > 0) { qr = *(const uint2*)(rc - SC_ROWB); qk = *(const uint2*)(rc - SC_ROWB + 128); qv = *(const uint2*)(rc - SC_ROWB + 256); }
                else if (t0 > 0) { const unsigned* pvr = prevr + ((ch + 1) & 1) * 96 + (c4 >> 1); qr = *(const uint2*)pvr; qk = *(const uint2*)(pvr + 32); qv = *(const uint2*)(pvr + 64); }
                if (tau == SC_TC - 1) { unsigned* pwr = prevr + (ch & 1) * 96 + (c4 >> 1); *(uint2*)pwr = cr; *(uint2*)(pwr + 32) = ck; *(uint2*)(pwr + 64) = cv; }
                const float4 mr = *(const float4*)(cst + c4), mk = *(const float4*)(cst + 64 + c4), mv = *(const float4*)(cst + 128 + c4);
                const float c_[12] = {__uint_as_float(cr.x << 16), __uint_as_float(cr.x & 0xFFFF0000u), __uint_as_float(cr.y << 16), __uint_as_float(cr.y & 0xFFFF0000u),
                                      __uint_as_float(ck.x << 16), __uint_as_float(ck.x & 0xFFFF0000u), __uint_as_float(ck.y << 16), __uint_as_float(ck.y & 0xFFFF0000u),
                                      __uint_as_float(cv.x << 16), __uint_as_float(cv.x & 0xFFFF0000u), __uint_as_float(cv.y << 16), __uint_as_float(cv.y & 0xFFFF0000u)};
                const float q_[12] = {__uint_as_float(qr.x << 16), __uint_as_float(qr.x & 0xFFFF0000u), __uint_as_float(qr.y << 16), __uint_as_float(qr.y & 0xFFFF0000u),
                                      __uint_as_float(qk.x << 16), __uint_as_float(qk.x & 0xFFFF0000u), __uint_as_float(qk.y << 16), __uint_as_float(qk.y & 0xFFFF0000u),
                                      __uint_as_float(qv.x << 16), __uint_as_float(qv.x & 0xFFFF0000u), __uint_as_float(qv.y << 16), __uint_as_float(qv.y & 0xFFFF0000u)};
                const float m_[12] = {mr.x, mr.y, mr.z, mr.w, mk.x, mk.y, mk.z, mk.w, mv.x, mv.y, mv.z, mv.w};
#pragma unroll
                for (int j = 0; j < 4; ++j) { rr[j] = c_[j] + (q_[j] - c_[j]) * m_[j]; kr[j] = c_[4 + j] + (q_[4 + j] - c_[4 + j]) * m_[4 + j]; vv[j] = c_[8 + j] + (q_[8 + j] - c_[8 + j]) * m_[8 + j]; }
            }
            if (l > 0) {
                const float4 xv4 = *(const float4*)(o_c + e), cv = *(const float4*)(cst + 928 + c4);
                const uint2 vfu = *(const uint2*)(raw + tau * SC_ROWB + 960 + c4 * 2);
                const float vf[4] = {__uint_as_float(vfu.x << 16), __uint_as_float(vfu.x & 0xFFFF0000u), __uint_as_float(vfu.y << 16), __uint_as_float(vfu.y & 0xFFFF0000u)};
                const float xv[4] = {xv4.x + cv.x, xv4.y + cv.y, xv4.z + cv.z, xv4.w + cv.w};
#pragma unroll
                for (int j = 0; j < 4; ++j) vv[j] = vv[j] + (vf[j] - vv[j]) * fast_sigmoid(xv[j]);
            } else if (t < TS) {
                *(uint2*)(vfirst + n * 1024 + hc + c4) = pack4(vv[0], vv[1], vv[2], vv[3]);
            }
            float av[4], kkv[4], ginc[4], gexc[4], ginv[4]; float ss = 0.f;
#pragma unroll
            for (int j = 0; j < 4; ++j) {
                ginc[j] = __expf(cum[j]); gexc[j] = __expf(cum[j] - lw[j]); ginv[j] = __expf(-cum[j]);
                av[j] = fast_sigmoid(xa[j]);
                kkv[j] = kr[j] * kkc[j];
                ss += kkv[j] * kkv[j];
            }
            float kk[4], kt[4];
#pragma unroll
            for (int j = 0; j < 4; ++j) kt[j] = kr[j] * (1.0f + (av[j] - 1.0f) * kac[j]);
            float bsum = rr[0] * kt[0] * crk.x + rr[1] * kt[1] * crk.y + rr[2] * kt[2] * crk.z + rr[3] * kt[3] * crk.w;
            float du0 = 0.f, du1 = 0.f;
            row16_sum4(ss, bsum, du0, du1);
            if ((tid & 15) == 0) bs_c[tau] = bsum;
            const float rn = rsqrtf(fmaxf(ss, 1e-24f));
#pragma unroll
            for (int j = 0; j < 4; ++j) kk[j] = kkv[j] * rn;
            const uint2 pa = pack4(-kk[0] * gexc[0], -kk[1] * gexc[1], -kk[2] * gexc[2], -kk[3] * gexc[3]);
            const uint2 pr = pack4(rr[0] * ginc[0], rr[1] * ginc[1], rr[2] * ginc[2], rr[3] * ginc[3]);
            const uint2 pb = pack4(kk[0] * av[0] * ginv[0], kk[1] * av[1] * ginv[1], kk[2] * av[2] * ginv[2], kk[3] * av[3] * ginv[3]);
            const uint2 pk = pack4(kt[0] * ginv[0], kt[1] * ginv[1], kt[2] * ginv[2], kt[3] * ginv[3]);
            const uint2 pv = pack4(vv[0], vv[1], vv[2], vv[3]);
            *(uint2*)(o_at + tau * SC_LT + c4) = pa;
            *(uint2*)(o_rt + tau * SC_LT + c4) = pr;
            *(uint2*)(o_bt + tau * SC_LT + c4) = pb;
            *(uint2*)(o_kt + tau * SC_LT + c4) = pk;
            o_bT[(c4 + 0) * SC_LS + tau] = (bf16_t)(pb.x & 0xFFFFu); o_bT[(c4 + 1) * SC_LS + tau] = (bf16_t)(pb.x >> 16); o_bT[(c4 + 2) * SC_LS + tau] = (bf16_t)(pb.y & 0xFFFFu); o_bT[(c4 + 3) * SC_LS + tau] = (bf16_t)(pb.y >> 16);
            o_kT[(c4 + 0) * SC_LS + tau] = (bf16_t)(pk.x & 0xFFFFu); o_kT[(c4 + 1) * SC_LS + tau] = (bf16_t)(pk.x >> 16); o_kT[(c4 + 2) * SC_LS + tau] = (bf16_t)(pk.y & 0xFFFFu); o_kT[(c4 + 3) * SC_LS + tau] = (bf16_t)(pk.y >> 16);
            o_vT[(c4 + 0) * SC_LS + tau] = (bf16_t)(pv.x & 0xFFFFu); o_vT[(c4 + 1) * SC_LS + tau] = (bf16_t)(pv.x >> 16); o_vT[(c4 + 2) * SC_LS + tau] = (bf16_t)(pv.y & 0xFFFFu); o_vT[(c4 + 3) * SC_LS + tau] = (bf16_t)(pv.y >> 16);
            if ((tau & 15) == 15) *(float4*)(s_gc + (tau >> 4) * 64 + c4) = make_float4(ginc[0], ginc[1], ginc[2], ginc[3]);
            *(float4*)(v_c + e) = make_float4(vv[0], vv[1], vv[2], vv[3]);
        }
        lds_barrier();
        if (wid < 4) {
#pragma unroll 1
            for (int sc = 0; sc < 2; ++sc) {
                if (sc * 16 < nval) {
                    const bf16_t* ar = o_at + (sc * 16 + fr) * SC_LT;
                    const bf16_t* rr_ = o_rt + (sc * 16 + fr) * SC_LT;
                    const bf16_t* br = o_bt + (sc * 16 + fr) * SC_LT;
                    const bf16_t* kr_ = o_kt + (sc * 16 + fr) * SC_LT;
                    const bf16x8 fa0 = *(const bf16x8*)(ar + fq * 8), fa1 = *(const bf16x8*)(ar + 32 + fq * 8);
                    const bf16x8 fb0 = *(const bf16x8*)(br + fq * 8), fb1 = *(const bf16x8*)(br + 32 + fq * 8);
                    const bf16x8 fk0 = *(const bf16x8*)(kr_ + fq * 8), fk1 = *(const bf16x8*)(kr_ + 32 + fq * 8);
                    const bf16x8 fr0 = *(const bf16x8*)(rr_ + fq * 8), fr1 = *(const bf16x8*)(rr_ + 32 + fq * 8);
                    f32x4 nA = MF32(fb0, fa0, z4); nA = MF32(fb1, fa1, nA);
                    f32x4 nB = MF32(fa0, fb0, z4); nB = MF32(fa1, fb1, nB);
                    f32x4 mak = MF32(fk0, fa0, z4); mak = MF32(fk1, fa1, mak);
                    f32x4 mbr = MF32(fb0, fr0, z4); mbr = MF32(fb1, fr1, mbr);
                    f32x4 mkr = MF32(fk0, fr0, z4); mkr = MF32(fk1, fr1, mkr);
#pragma unroll
                    for (int j = 0; j < 4; ++j) {
                        const int s_ = fq * 4 + j;
                        nA[j] = (s_ < fr) ? nA[j] : 0.f; nB[j] = (fr < s_) ? nB[j] : 0.f; mak[j] = (s_ < fr) ? mak[j] : 0.f;
                        mbr[j] = (s_ <= fr) ? mbr[j] : 0.f; mkr[j] = (s_ <= fr) ? mkr[j] : 0.f;
                    }
                    const sh4 pNA = pk4v(nA), pNB = pk4v(nB), pMak = pk4v(mak), pMbr = pk4v(mbr), pMkr = pk4v(mkr);
                    const f32x4 n2B = MF16(pNA, pNB, z4), n2A = MF16(pNB, pNA, z4);
                    const sh4 pN2A = pk4v(n2A), pN2B = pk4v(n2B);
                    const f32x4 n4B = MF16(pN2A, pN2B, z4), n4A = MF16(pN2B, pN2A, z4);
                    const sh4 pN4A = pk4v(n4A), pN4B = pk4v(n4B);
                    const sh4 pN8A = pk4v(MF16(pN4B, pN4A, z4));
                    const bf16x8 sB0 = cat8(pk4v(S[0]), pk4v(S[1])), sB1 = cat8(pk4v(S[2]), pk4v(S[3]));
                    const sh4 vf = *(const sh4*)(o_vT + (wid * 16 + fr) * SC_LS + sc * 16 + fq * 4);
                    f32x4 X = MF32(cat8(*(const sh4*)(ar + fq * 4), *(const sh4*)(ar + 16 + fq * 4)), sB0, z4);
                    X = MF32(cat8(*(const sh4*)(ar + 32 + fq * 4), *(const sh4*)(ar + 48 + fq * 4)), sB1, X);
                    X = MF16(pMak, vf, X);
                    X = MF16(pN8A, pk4v(X), X); X = MF16(pN4A, pk4v(X), X); X = MF16(pN2A, pk4v(X), X); X = MF16(pNA, pk4v(X), X);
                    const sh4 pSA = pk4v(X);
                    f32x4 O = MF32(cat8(*(const sh4*)(rr_ + fq * 4), *(const sh4*)(rr_ + 16 + fq * 4)), sB0, z4);
                    O = MF32(cat8(*(const sh4*)(rr_ + 32 + fq * 4), *(const sh4*)(rr_ + 48 + fq * 4)), sB1, O);
                    const bf16x8 sav = cat8(pSA, vf);
                    O = MF32(cat8(pMbr, pMkr), sav, O);
#pragma unroll
                    for (int j = 0; j < 4; ++j) o_c[(sc * 16 + fq * 4 + j) * 64 + wid * 16 + fr] = O[j];
#pragma unroll
                    for (int jt = 0; jt < 4; ++jt) {
                        const sh4 ka = *(const sh4*)(o_kT + (jt * 16 + fr) * SC_LS + sc * 16 + fq * 4), ba = *(const sh4*)(o_bT + (jt * 16 + fr) * SC_LS + sc * 16 + fq * 4);
                        f32x4 acc = MF32(cat8(ba, ka), sav, S[jt]);
                        const float4 g4 = *(const float4*)(s_gc + sc * 64 + jt * 16 + fq * 4);
                        acc[0] *= g4.x; acc[1] *= g4.y; acc[2] *= g4.z; acc[3] *= g4.w;
                        S[jt] = acc;
                    }
                }
            }
        } else if (ch > 0) {
            const int t2 = otid() - 256;
            stepE(t2 >> 4, (t2 & 15) * 4, o_p, v_p, g_p, bs_p, t0 - SC_TC, SC_TC);
            stepE(16 + (t2 >> 4), (t2 & 15) * 4, o_p, v_p, g_p, bs_p, t0 - SC_TC, SC_TC);
        }
        lds_barrier();
    }
    {
        const int chl = (TS + SC_TC - 1) / SC_TC - 1; const bool parl = (chl & 1) != 0;
        stepE(tid >> 4, (tid & 15) * 4, parl ? s_oB : s_o, parl ? s_vB : s_v, parl ? s_gB : s_g, s_bs2 + (parl ? 32 : 0), chl * SC_TC, TS - chl * SC_TC);
    }
}
__device__ __forceinline__ void xcd_panel_map(int& mt0, int& mstep, int& nt) {
    const int b = obid(), G = (int)gridDim.x;
    if (G == 256) { nt = (b >> 3) & 7; mt0 = (b & 7) * 4 + (b >> 6); mstep = 32; }
    else { nt = b & 7; mt0 = b >> 3; mstep = G >> 3; }
}
__device__ void phase_merge(const Params& p, unsigned char* lds) {
    const int tid = otid(), lane = tid & 63, wid = tid >> 6, wr = wid >> 1, wc = wid & 1, fr = lane & 15, fq = lane >> 4;
    const bf16_t* h = (const bf16_t*)(WS(p) + OFF_H);
    const bf16_t* wb = (const bf16_t*)(WS(p) + OFF_WB);
    const float* rstd = (const float*)(WS(p) + OFF_RSTD);
    bf16_t* merged = (bf16_t*)(WS(p) + OFF_MERGED);
    const bf16_t* ysrc0 = (const bf16_t*)(WS(p) + OFF_PPOOL);
    const bf16_t* ysrc1 = (const bf16_t*)(WS(p) + OFF_PR);
    const bf16_t* ysrc2 = (const bf16_t*)(OUTB(p) + DO_YC);
    int mt0, mstep, nt;
    xcd_panel_map(mt0, mstep, nt);
    for (int mt = mt0; mt < 86; mt += mstep) {
        const int row0 = mt * 192, col0 = nt * 128;
        uint2 maccp[3][4];
#pragma unroll
        for (int m = 0; m < 3; ++m)
#pragma unroll
            for (int n = 0; n < 4; ++n) maccp[m][n] = make_uint2(0u, 0u);
#pragma unroll 1
        for (int i = 0; i < 3; ++i) {
            const int tid = otid();
            const bf16_t* ys = (i == 0) ? ysrc0 : (i == 1 ? ysrc1 : ysrc2);
            uint2 sg[3][4];
            {
                f32x4 ag[3][4]; g3_zero<3>(ag);
                G3<192> g;
                g3_setup<192>(g, [&](int r) { return h + (size_t)(row0 + r) * DM; }, [&](int r) { return wb + WB_WG + (size_t)(i * 1024 + col0 + r) * DM; }, tid);
                g3_kloop<192>(ag, g, DM, lds);
#pragma unroll
                for (int m = 0; m < 3; ++m) {
                    const float rs = rstd[row0 + wr * 48 + m * 16 + fr];
#pragma unroll
                    for (int n = 0; n < 4; ++n) sg[m][n] = pack4(fast_sigmoid(ag[m][n][0] * rs), fast_sigmoid(ag[m][n][1] * rs), fast_sigmoid(ag[m][n][2] * rs), fast_sigmoid(ag[m][n][3] * rs));
                }
            }
            {
                f32x4 ay[3][4]; g3_zero<3>(ay);
                G3<192> g;
                g3_setup<192>(g, [&](int r) { return ys + (size_t)(row0 + r) * DM; }, [&](int r) { return wb + WB_PA + (size_t)(i * 1024 + col0 + r) * DM; }, tid);
                g3_kloop<192>(ay, g, DM, lds);
#pragma unroll
                for (int m = 0; m < 3; ++m)
#pragma unroll
                    for (int n = 0; n < 4; ++n) {
                        const float m0 = __uint_as_float(maccp[m][n].x << 16) + __uint_as_float(sg[m][n].x << 16) * ay[m][n][0];
                        const float m1 = __uint_as_float(maccp[m][n].x & 0xFFFF0000u) + __uint_as_float(sg[m][n].x & 0xFFFF0000u) * ay[m][n][1];
                        const float m2 = __uint_as_float(maccp[m][n].y << 16) + __uint_as_float(sg[m][n].y << 16) * ay[m][n][2];
                        const float m3 = __uint_as_float(maccp[m][n].y & 0xFFFF0000u) + __uint_as_float(sg[m][n].y & 0xFFFF0000u) * ay[m][n][3];
                        maccp[m][n] = pack4(m0, m1, m2, m3);
                    }
            }
        }
#pragma unroll
        for (int m = 0; m < 3; ++m) {
            const int row = row0 + wr * 48 + m * 16 + fr;
#pragma unroll
            for (int n = 0; n < 4; ++n)
                *(uint2*)(merged + (size_t)row * 1024 + col0 + wc * 64 + n * 16 + fq * 4) = maccp[m][n];
        }
    }
}

__device__ void phase_outproj(const Params& p, unsigned char* lds) {
    const int tid = otid(), lane = tid & 63, wid = tid >> 6, wr = wid >> 1, wc = wid & 1, fr = lane & 15, fq = lane >> 4;
    const bf16_t* h = (const bf16_t*)(WS(p) + OFF_H);
    const bf16_t* wb = (const bf16_t*)(WS(p) + OFF_WB);
    const bf16_t* merged = (const bf16_t*)(WS(p) + OFF_MERGED);
    float* hm = (float*)(WS(p) + OFF_HM32);
    int mt0, mstep, nt;
    xcd_panel_map(mt0, mstep, nt);
    for (int mt = mt0; mt < 86; mt += mstep) {
        const int row0 = mt * 192, col0 = nt * 128;
        G3<192> g;
        g3_setup<192>(g, [&](int r) { return merged + (size_t)(row0 + r) * DM; }, [&](int r) { return wb + WB_WO + (size_t)(col0 + r) * DM; }, tid);
        f32x4 acc[3][4]; g3_zero<3>(acc);
        g3_kloop<192>(acc, g, DM, lds);
        uint2 hres[3][4];
#pragma unroll
        for (int m = 0; m < 3; ++m)
#pragma unroll
            for (int n = 0; n < 4; ++n) hres[m][n] = *(const uint2*)(h + (size_t)(row0 + wr * 48 + m * 16 + fr) * 1024 + col0 + wc * 64 + n * 16 + fq * 4);
#pragma unroll
        for (int m = 0; m < 3; ++m) {
            const int row = row0 + wr * 48 + m * 16 + fr;
#pragma unroll
            for (int n = 0; n < 4; ++n) {
                const int col = col0 + wc * 64 + n * 16 + fq * 4;
                const uint2 hv = hres[m][n];
                float4 o;
                o.x = __uint_as_float(hv.x << 16) + acc[m][n][0]; o.y = __uint_as_float(hv.x & 0xFFFF0000u) + acc[m][n][1];
                o.z = __uint_as_float(hv.y << 16) + acc[m][n][2]; o.w = __uint_as_float(hv.y & 0xFFFF0000u) + acc[m][n][3];
                *(float4*)(hm + (size_t)row * 1024 + col) = o;
            }
        }
    }
}

__device__ __constant__ int c_pair_lo[6] = {0, 0, 0, 1, 1, 2};
__device__ __constant__ int c_pair_hi[6] = {1, 2, 3, 2, 3, 3};
__device__ void phase_route(const Params& p, int l, unsigned char* lds) {
    const int tid = otid(), lane = tid & 63, wid = tid >> 6;
    const int per = (NT + (int)gridDim.x - 1) / (int)gridDim.x;
    const int nbeg = obid() * per, nend = (nbeg + per < NT) ? nbeg + per : NT;
    int* s_cls = (int*)lds;
    int* s_base = s_cls + 512;
    float* s_wr = (float*)(lds + 4096);
    const float* hm = (const float*)(WS(p) + OFF_HM32);
    bf16_t* hn = (bf16_t*)(WS(p) + OFF_HN);
    const float* nf = p.in[33] + (size_t)l * 1024;
    const float* wg = p.in[34] + (size_t)l * 1024 * 4;
    const float* bg = p.in[35] + l * 4;
    const float* we = p.in[36] + (size_t)l * 1024 * 16;
    const float* be = p.in[37] + l * 16;
    int* cnt = (int*)(WS(p) + OFF_CTL);
    int* list = (int*)(WS(p) + OFF_LIST);
    float* pw = (float*)(WS(p) + OFF_PW);
    for (int e = tid; e < 1024 * 20; e += NTHR) {
        const int k = e / 20, c = e - k * 20;
        s_wr[c * 1024 + k] = (c < 4) ? wg[(size_t)k * 4 + c] : we[(size_t)k * 16 + (c - 4)];
    }
    __syncthreads();
    float4 nv[4], cur[4];
#pragma unroll
    for (int i = 0; i < 4; ++i) nv[i] = *(const float4*)(nf + i * 256 + lane * 4);
    if (nbeg + wid < nend) {
#pragma unroll
        for (int i = 0; i < 4; ++i) cur[i] = *(const float4*)(hm + (size_t)(nbeg + wid) * DM + i * 256 + lane * 4);
    }
    for (int n = nbeg + wid; n < nend; n += 8) {
        float4 xv[4]; float ss = 0.f;
#pragma unroll
        for (int i = 0; i < 4; ++i) { xv[i] = cur[i]; ss += xv[i].x * xv[i].x + xv[i].y * xv[i].y + xv[i].z * xv[i].z + xv[i].w * xv[i].w; }
        if (n + 8 < nend) {
#pragma unroll
            for (int i = 0; i < 4; ++i) cur[i] = *(const float4*)(hm + (size_t)(n + 8) * DM + i * 256 + lane * 4);
        }
        ss = wave_sum_fast(ss);
        const float rs = rsqrtf(ss * (1.0f / 1024.0f) + 1e-6f);
        float lg[4] = {0.f, 0.f, 0.f, 0.f};
        float le[16];
#pragma unroll
        for (int e = 0; e < 16; ++e) le[e] = 0.f;
#pragma unroll
        for (int i = 0; i < 4; ++i) {
            float y[4] = {xv[i].x * rs * nv[i].x, xv[i].y * rs * nv[i].y, xv[i].z * rs * nv[i].z, xv[i].w * rs * nv[i].w};
            {
                const int d0 = i * 256 + lane * 4;
#pragma unroll
                for (int g = 0; g < 4; ++g) { const float4 w4 = *(const float4*)(s_wr + g * 1024 + d0); lg[g] += y[0] * w4.x + y[1] * w4.y + y[2] * w4.z + y[3] * w4.w; }
#pragma unroll
                for (int e = 0; e < 16; ++e) { const float4 w4 = *(const float4*)(s_wr + (4 + e) * 1024 + d0); le[e] += y[0] * w4.x + y[1] * w4.y + y[2] * w4.z + y[3] * w4.w; }
            }
            *(uint2*)(hn + (size_t)n * DM + i * 256 + lane * 4) = pack4(y[0], y[1], y[2], y[3]);
        }
#pragma unroll
        for (int g = 0; g < 4; ++g) lg[g] = wave_sum_fast(lg[g]) + bg[g];
#pragma unroll
        for (int e = 0; e < 16; ++e) le[e] = wave_sum_fast(le[e]) + be[e];
        if (lane == 0) {
            int gs = 0; float gm = lg[0];
#pragma unroll
            for (int g = 1; g < 4; ++g) if (lg[g] > gm) { gm = lg[g]; gs = g; }
            float den = 0.f;
#pragma unroll
            for (int g = 0; g < 4; ++g) den += __expf(lg[g] - gm);
            const float pgrp = 1.0f / den;
            float v4[4];
#pragma unroll
            for (int e = 0; e < 4; ++e) {
                const float m0 = (gs == 0) ? 1.f : 0.f, m1s = (gs == 1) ? 1.f : 0.f, m2s = (gs == 2) ? 1.f : 0.f, m3s = (gs == 3) ? 1.f : 0.f;
                v4[e] = le[e] * m0 + le[4 + e] * m1s + le[8 + e] * m2s + le[12 + e] * m3s;
            }
            int i1 = 0; float m1 = v4[0];
#pragma unroll
            for (int e = 1; e < 4; ++e) if (v4[e] > m1) { m1 = v4[e]; i1 = e; }
            int i2 = -1; float m2 = -INFINITY;
#pragma unroll
            for (int e = 0; e < 4; ++e) if (e != i1 && v4[e] > m2) { m2 = v4[e]; i2 = e; }
            const float e2 = __expf(m2 - m1);
            const float p1 = pgrp / (1.0f + e2), p2 = pgrp * e2 / (1.0f + e2);
            const int lo = i1 < i2 ? i1 : i2, hi = i1 < i2 ? i2 : i1;
            const float plo = i1 < i2 ? p1 : p2, phi = i1 < i2 ? p2 : p1;
            const int pi = (lo == 0) ? (hi - 1) : (lo == 1 ? hi + 1 : 5);
            const int cls = gs * 6 + pi;
            s_cls[n - nbeg] = cls;
            pw[(size_t)n * 2 + 0] = plo; pw[(size_t)n * 2 + 1] = phi;
        }
    }
    __syncthreads();
    const int nloc = nend - nbeg;
    if (tid < 24) {
        int c_ = 0;
        for (int i = 0; i < nloc; ++i) c_ += (s_cls[i] == tid) ? 1 : 0;
        s_base[tid] = c_ ? atomicAdd(&cnt[tid * 32], c_) : 0;
    }
    __syncthreads();
    for (int it = tid; it < nloc; it += NTHR) {
        const int cls = s_cls[it];
        int rank = 0;
        for (int i = 0; i < it; ++i) rank += (s_cls[i] == cls) ? 1 : 0;
        list[(size_t)cls * NT + s_base[cls] + rank] = nbeg + it;
    }
    __syncthreads();
}


struct MoeTile { int cls, ti, cnt, tg; };
__device__ __forceinline__ int moe_table(const int* cnt, unsigned char* lds) {
    int* tab = (int*)(lds + LDS_BYTES - 512);
    __syncthreads();
    if (otid() < 24) tab[otid()] = cnt[otid() * 32];
    __syncthreads();
    if (otid() == 0) { int s_ = 0; for (int c = 0; c < 24; ++c) { tab[24 + c] = s_; s_ += (tab[c] + 127) >> 7; } tab[48] = s_; }
    __syncthreads();
    return tab[48];
}
__device__ __forceinline__ MoeTile moe_find(const unsigned char* lds, int tile) {
    const int* tab = (const int*)(lds + LDS_BYTES - 512);
    MoeTile r; r.cls = 0; r.ti = 0; r.cnt = 0; r.tg = tile;
    for (int c = 0; c < 24; ++c) { const int s_ = tab[24 + c], e_ = tab[25 + c]; if (tile >= s_ && tile < e_) { r.cls = c; r.ti = tile - s_; r.cnt = tab[c]; } }
    return r;
}
__device__ void phase_moe1(const Params& p, unsigned char* lds) {
    const int tid = otid(), lane = tid & 63, wid = tid >> 6, wr = wid >> 1, wc = wid & 1, fr = lane & 15, fq = lane >> 4;
    const int* cnt = (const int*)(WS(p) + OFF_CTL);
    const int* list = (const int*)(WS(p) + OFF_LIST);
    const float* pw = (const float*)(WS(p) + OFF_PW);
    const bf16_t* hn = (const bf16_t*)(WS(p) + OFF_HN);
    const bf16_t* we = (const bf16_t*)(WS(p) + OFF_WEXP);
    bf16_t* hid = (bf16_t*)(OUTB(p) + DO_HID);
    const int total = moe_table(cnt, lds);
    for (int item = obid(); item < total * 4; item += gridDim.x) {
        const MoeTile mt = moe_find(lds, item >> 2);
        const int nt = item & 3, slot = nt >> 1, f0 = (nt & 1) * 128;
        const int g_ = mt.cls / 6, pi = mt.cls % 6;
        const int e = g_ * 4 + (slot == 0 ? c_pair_lo[pi] : c_pair_hi[pi]);
        const int* lst = list + (size_t)mt.cls * NT + mt.ti * 128;
        const int nvalid = min(128, mt.cnt - mt.ti * 128);
        f32x4 a1[2][4], a3[2][4]; g3_zero<2>(a1); g3_zero<2>(a3);
        G3D g;
#pragma unroll
        for (int i = 0; i < 2; ++i) {
            const int idx = tid + i * NTHR, row = idx >> 3, sl = (idx & 7) ^ (row & 7);
            g.ap[i] = hn + (size_t)lst[row < nvalid ? row : 0] * DM + sl * 8;
            g.b1[i] = we + WE_W1 + ((size_t)e * 256 + f0 + row) * 1024 + sl * 8;
            g.b3[i] = we + WE_W3 + ((size_t)e * 256 + f0 + row) * 1024 + sl * 8;
        }
        g3d_kloop(a1, a3, g, DM, lds);
        float pev[2];
#pragma unroll
        for (int m = 0; m < 2; ++m) { const int lr = wr * 32 + m * 16 + fr; pev[m] = pw[(size_t)lst[lr < nvalid ? lr : 0] * 2 + slot]; }
#pragma unroll
        for (int m = 0; m < 2; ++m) {
            const int lr = wr * 32 + m * 16 + fr;
            const float pe = pev[m];
#pragma unroll
            for (int n = 0; n < 4; ++n) {
                const int col = slot * 256 + f0 + wc * 64 + n * 16 + fq * 4;
                float o[4];
#pragma unroll
                for (int j = 0; j < 4; ++j) { const float x1 = a1[m][n][j]; o[j] = x1 * sigmoidf_(x1) * a3[m][n][j] * pe; }
                *(uint2*)(hid + ((size_t)mt.tg * 128 + lr) * 512 + col) = pack4(o[0], o[1], o[2], o[3]);
            }
        }
    }
}
__device__ void phase_moe2(const Params& p, int l, unsigned char* lds) {
    const int tid = otid(), lane = tid & 63, wid = tid >> 6, wr = wid >> 1, wc = wid & 1, fr = lane & 15, fq = lane >> 4;
    const int* cnt = (const int*)(WS(p) + OFF_CTL);
    const int* list = (const int*)(WS(p) + OFF_LIST);
    const bf16_t* we = (const bf16_t*)(WS(p) + OFF_WEXP);
    const bf16_t* hid = (const bf16_t*)(OUTB(p) + DO_HID);
    float* hm = (float*)(WS(p) + OFF_HM32);
    bf16_t* h = (bf16_t*)(WS(p) + OFF_H);
    const int total = moe_table(cnt, lds);
    for (int item = obid(); item < total * 8; item += gridDim.x) {
        const MoeTile mt = moe_find(lds, item >> 3);
        const int nt = item & 7, col0 = nt * 128;
        const int g_ = mt.cls / 6, pi = mt.cls % 6;
        const int elo = g_ * 4 + c_pair_lo[pi], ehi = g_ * 4 + c_pair_hi[pi];
        const int* lst = list + (size_t)mt.cls * NT + mt.ti * 128;
        const int nvalid = min(128, mt.cnt - mt.ti * 128);
        f32x4 acc[2][4]; g3_zero<2>(acc);
        G3<128> g;
        g3_setup<128>(g, [&](int r) { return hid + ((size_t)mt.tg * 128 + r) * 512; }, [&](int r) { return we + WE_W2 + ((size_t)elo * 1024 + col0 + r) * 256; }, tid);
        g3_kloop<128>(acc, g, 256, lds);
        g3_setup<128>(g, [&](int r) { return hid + ((size_t)mt.tg * 128 + r) * 512 + 256; }, [&](int r) { return we + WE_W2 + ((size_t)ehi * 1024 + col0 + r) * 256; }, tid);
        g3_kloop<128>(acc, g, 256, lds);
        int tkv[2]; float4 hv[2][4];
#pragma unroll
        for (int m = 0; m < 2; ++m) {
            const int lr = wr * 32 + m * 16 + fr;
            tkv[m] = lst[lr < nvalid ? lr : 0];
#pragma unroll
            for (int n = 0; n < 4; ++n) hv[m][n] = *(const float4*)(hm + (size_t)tkv[m] * 1024 + col0 + wc * 64 + n * 16 + fq * 4);
        }
#pragma unroll
        for (int m = 0; m < 2; ++m) {
            const int lr = wr * 32 + m * 16 + fr;
            if (lr < nvalid) {
                const int tk = tkv[m];
#pragma unroll
                for (int n = 0; n < 4; ++n) {
                    const int col = col0 + wc * 64 + n * 16 + fq * 4;
                    float4 v = hv[m][n];
                    v.x += acc[m][n][0]; v.y += acc[m][n][1]; v.z += acc[m][n][2]; v.w += acc[m][n][3];
                    if (l == 0) *(uint2*)(h + (size_t)tk * 1024 + col) = pack4(v.x, v.y, v.z, v.w);
                    else *(float4*)(hm + (size_t)tk * 1024 + col) = v;
                }
            }
        }
    }
}

__device__ void phase_final(const Params& p) {
    const int lane = otid() & 63;
    const int wave = (obid() * NTHR + otid()) >> 6, nw = gridDim.x * NTHR / 64;
    const float* hm = (const float*)(WS(p) + OFF_HM32);
    const float* nf = p.in[41];
    float4 g[4], cur[4];
#pragma unroll
    for (int i = 0; i < 4; ++i) g[i] = *(const float4*)(nf + i * 256 + lane * 4);
    auto rowp = [&](int r) { const int b = r / SEQ, s_ = r % SEQ; return hm + ((size_t)b * TS + NMETA + s_) * DM; };
    if (wave < NB * SEQ) {
        const float* src = rowp(wave);
#pragma unroll
        for (int i = 0; i < 4; ++i) cur[i] = *(const float4*)(src + i * 256 + lane * 4);
    }
    for (int r = wave; r < NB * SEQ; r += nw) {
        float4 v[4]; float ss = 0.f;
#pragma unroll
        for (int i = 0; i < 4; ++i) { v[i] = cur[i]; ss += v[i].x * v[i].x + v[i].y * v[i].y + v[i].z * v[i].z + v[i].w * v[i].w; }
        if (r + nw < NB * SEQ) {
            const float* src = rowp(r + nw);
#pragma unroll
            for (int i = 0; i < 4; ++i) cur[i] = *(const float4*)(src + i * 256 + lane * 4);
        }
        ss = wave_sum_fast(ss);
        const float rs = rsqrtf(ss * (1.0f / 1024.0f) + 1e-6f);
#pragma unroll
        for (int i = 0; i < 4; ++i) {
            float4 o; o.x = v[i].x * rs * g[i].x; o.y = v[i].y * rs * g[i].y; o.z = v[i].z * rs * g[i].z; o.w = v[i].w * rs * g[i].w;
            *(float4*)((float*)OUTB(p) + (size_t)r * DM + i * 256 + lane * 4) = o;
        }
    }
}


#define XB_TMO      128
#define XB_XCNT(j)  (256  + 64 * (j))
#define XB_XSUB(j)  (1280 + 64 * (j))
#define XB_XGEN(j)  (2304 + 64 * (j))
#define XB_TOP      3328
#define XB_TOPGEN   3392
#define XCD_BAR_WORDS 3456
#define XB_SPIN_CAP (1u << 22)
#define LAS __attribute__((address_space(3)))
__device__ __forceinline__ unsigned xb_ld(unsigned* p) { return __hip_atomic_load(p, __ATOMIC_RELAXED, __HIP_MEMORY_SCOPE_AGENT); }
__device__ __forceinline__ unsigned xb_add(unsigned* p, unsigned v) { return __hip_atomic_fetch_add(p, v, __ATOMIC_RELAXED, __HIP_MEMORY_SCOPE_AGENT); }
__device__ __forceinline__ unsigned xb_xcc_id() { return (unsigned)__builtin_amdgcn_s_getreg((3 << 11) | 20) & 0xFu; }
#define XB_SPIN(cond, bar) do { unsigned _sp = 0; while (cond) { __builtin_amdgcn_s_sleep(1); \
    if ((++_sp & 255u) == 0u) { if (xb_ld(&(bar)[XB_TMO])) break; if (_sp > XB_SPIN_CAP) { atomicAdd(&(bar)[XB_TMO], 1u); break; } } } } while (0)
struct XcdBarrier { unsigned* bar; unsigned x; volatile LAS unsigned* st; };
__device__ __forceinline__ XcdBarrier xcd_barrier_post(unsigned* bar, volatile LAS unsigned* st) {
    XcdBarrier b; b.bar = bar; b.x = xb_xcc_id(); b.st = st;
    if (threadIdx.x == 0) (void)xb_add(&bar[XB_XCNT(b.x)], 1u);
    return b;
}
__device__ __forceinline__ void xcd_barrier_complete(unsigned* bar, unsigned x, unsigned& nloc, unsigned& nx) {
    const unsigned G = gridDim.x * gridDim.y * gridDim.z;
    unsigned sum, cnt, mine, sp = 0u;
    for (;;) {
        sum = 0u; cnt = 0u; mine = 0u;
#pragma unroll
        for (unsigned j = 0; j < 16; ++j) { const unsigned c = xb_ld(&bar[XB_XCNT(j)]); sum += c; cnt += (c > 0u) ? 1u : 0u; mine = (j == x) ? c : mine; }
        if (sum == G) break;
        __builtin_amdgcn_s_sleep(1);
        if ((++sp & 255u) == 0u) { if (xb_ld(&bar[XB_TMO])) break; if (sp > XB_SPIN_CAP) { atomicAdd(&bar[XB_TMO], 1u); break; } }
    }
    nloc = mine > 0u ? mine : 1u; nx = cnt > 0u ? cnt : 1u;
}
__device__ __forceinline__ void xcd_barrier(const XcdBarrier& b) {
    asm volatile("s_waitcnt vmcnt(0)" ::: "memory");
    __syncthreads();
    if (threadIdx.x == 0) {
        unsigned* bar = b.bar;
        __builtin_amdgcn_s_waitcnt(0);
        unsigned nloc = b.st[0], nx = b.st[1];
        if (nloc == 0u) { xcd_barrier_complete(bar, b.x, nloc, nx); b.st[0] = nloc; b.st[1] = nx; }
        const unsigned old = xb_add(&bar[XB_XSUB(b.x)], 1u);
        const unsigned gen = old / nloc;
        if (old + 1u == (gen + 1u) * nloc) {
            __builtin_amdgcn_fence(__ATOMIC_RELEASE, "agent");
            asm volatile("s_waitcnt vmcnt(0)" ::: "memory");
            const unsigned og = xb_add(&bar[XB_TOP], 1u);
            const unsigned tg = og / nx;
            if (og + 1u == (tg + 1u) * nx) xb_add(&bar[XB_TOPGEN], 1u);
            else XB_SPIN(xb_ld(&bar[XB_TOPGEN]) == tg, bar);
            __builtin_amdgcn_fence(__ATOMIC_ACQUIRE, "agent");
            xb_add(&bar[XB_XGEN(b.x)], 1u);
            asm volatile("s_waitcnt vmcnt(0)" ::: "memory");
        } else {
            XB_SPIN(xb_ld(&bar[XB_XGEN(b.x)]) == gen, bar);
            __builtin_amdgcn_fence(__ATOMIC_ACQUIRE, "agent");
            asm volatile("s_waitcnt vmcnt(0)" ::: "memory");
        }
    }
    __syncthreads();
}

__global__ void __launch_bounds__(NTHR) fwd_megakernel(Params p) {
    extern __shared__ __attribute__((aligned(16))) unsigned char lds[];
    cg::grid_group grid = cg::this_grid();
    volatile LAS unsigned* xst = (volatile LAS unsigned*)(lds + LDS_BYTES - 32);
    if (threadIdx.x < 2) xst[threadIdx.x] = 0u;
    __syncthreads();
    const XcdBarrier xb = xcd_barrier_post((unsigned*)(p.ws + OFF_BAR), xst);
    if (p.out == nullptr) grid.sync();
#pragma unroll 1
    for (int step = 0; step < 18; ++step) {
        const int l = step >= 9 ? 1 : 0;
        const int ph = step - l * 9;
        switch (ph) {
        case 0:
            if (l == 0) phase_embed(p); else phase_rowstat(p);
            phase_convert<false>(p, l, lds);
            if (obid() == 0 && otid() < 24) ((int*)(WS(p) + OFF_CTL))[otid() * 32] = 0;
            if (obid() == 0 && otid() == 32) ((int*)(WS(p) + OFF_CTL))[800 + l * 32] = 0;
            break;
        case 1: phase_inproj(p, lds); break;
        case 2: phase_dsa_prep(p, l); phase_lr_prep(p, l); break;
        case 3: {
            if (obid() < NB * 16) phase_scan5(p, l, lds, obid());
            int* qctr = (int*)(WS(p) + OFF_CTL) + 800 + l * 32;
            int* qslot = (int*)(lds + LDS_BYTES - 16);
            for (;;) {
                __syncthreads();
                if (otid() == 0) *qslot = atomicAdd(qctr, 1);
                __syncthreads();
                const int item = *qslot;
                if (item >= 516 + NT / 32 + 3072) break;
                if (item < 516) phase_pool(p, l, lds, item, item + 1, 1);
                else if (item < 516 + NT / 32) phase_dsa<false>(p, l, lds, (bf16_t*)(OUTB(p) + DO_YC), nullptr, nullptr, item - 516, item - 515, 1);
                else {
                    const int ct = item - (516 + NT / 32);
                    const ConvJob cj = get_job_late(p, l, ct >> 10);
                    conv_tile(cj, ct & 1023, (float*)lds);
                }
            }
        } break;
        case 4: phase_merge(p, lds); break;
        case 5: phase_outproj(p, lds); break;
        case 6: phase_route(p, l, lds); break;
        case 7: phase_moe1(p, lds); break;
        default: phase_moe2(p, l, lds); break;
        }
        xcd_barrier(xb);
    }
    phase_final(p);
}

extern "C" void kernel_launch(void* const* d_in, const int* in_sizes, int n_in,
                              void* d_out, int out_size, void* d_ws, size_t ws_size,
                              hipStream_t stream) {
    static int grid_blocks = 0;
    if (grid_blocks == 0) {
        int dev = 0, cus = 0, per_cu = 0;
        (void)hipGetDevice(&dev);
        (void)hipDeviceGetAttribute(&cus, hipDeviceAttributeMultiprocessorCount, dev);
        (void)hipFuncSetAttribute((const void*)fwd_megakernel, hipFuncAttributeMaxDynamicSharedMemorySize, LDS_BYTES);
        (void)hipOccupancyMaxActiveBlocksPerMultiprocessor(&per_cu, fwd_megakernel, NTHR, LDS_BYTES);
        if (per_cu < 1 || cus < NB * 16 || (cus & 7) != 0 || n_in != 42 || ws_size < WS_END + (size_t)QS_WS * QS_BYTES || cus > QS_WS + QS_DO) { fprintf(stderr, "kernel_launch: bad config per_cu=%d n_in=%d ws=%zu need=%zu\n", per_cu, n_in, ws_size, (size_t)WS_END); grid_blocks = -1; }
        else grid_blocks = cus;
    }
    if (grid_blocks < 0) return;
    Params p{};
    for (int i = 0; i < 42; ++i) p.in[i] = (const float*)d_in[i];
    p.out = (float*)d_out;
    p.ws = (unsigned char*)d_ws;
    (void)hipMemsetAsync((unsigned char*)d_ws + OFF_BAR, 0, XCD_BAR_WORDS * 4, stream);
    void* args[] = {&p};
    hipError_t e = hipLaunchCooperativeKernel((void*)fwd_megakernel, dim3(grid_blocks), dim3(NTHR), args, LDS_BYTES, stream);
    if (e != hipSuccess) fprintf(stderr, "cooperative launch failed: %s (grid %d)\n", hipGetErrorString(e), grid_blocks);
}
```

```cpp
#include <hip/hip_runtime.h>
#include <hip/hip_cooperative_groups.h>
#include <cstdio>
#include <cstdint>
#include <type_traits>
namespace cg = cooperative_groups;

typedef unsigned short bf16_t;
typedef short bf16x8 __attribute__((ext_vector_type(8)));
typedef float f32x4 __attribute__((ext_vector_type(4)));

constexpr int NB = 8, SEQ = 2048, NMETA = 16, TS = 2064, DM = 1024;
constexpr int NT = NB * TS;
constexpr int NTP = 16640;
constexpr int NTHR = 512;
constexpr int CIN = 7912;
constexpr int NP1 = 4864;
constexpr int PM_LD = 768;
constexpr int PM_WD = 0, PM_AD = 64, PM_GD = 128, PM_VD = 256, PM_CQ = 288, PM_CKV = 544, PM_KROPE = 672, PM_KIDX = 704;
constexpr int LDS_BYTES = 157 * 1024;

constexpr size_t AL(size_t x) { return (x + 255) & ~(size_t)255; }
constexpr size_t SZ_ACT = (size_t)NTP * 1024 * 2;
constexpr size_t OFF_CTL = 0;
constexpr size_t OFF_BAR = 4096;
constexpr size_t OFF_RSTD = OFF_BAR + 16384;
constexpr size_t OFF_ROPE = OFF_RSTD + AL((size_t)NTP * 4);
constexpr size_t OFF_H = OFF_ROPE + AL((size_t)TS * 16 * 4 * 2);
constexpr size_t OFF_WB = OFF_H + SZ_ACT;
constexpr size_t WB_WIN = 0;
constexpr size_t WB_WG = WB_WIN + (size_t)NP1 * 1024;
constexpr size_t WB_PA = WB_WG + (size_t)3072 * 1024;
constexpr size_t WB_WO = WB_PA + (size_t)3 * 1024 * 1024;
constexpr size_t WB_POOL = WB_WO + (size_t)1024 * 1024;
constexpr size_t WB_QI = WB_POOL + (size_t)4 * 256 * 256;
constexpr size_t WB_UQ = WB_QI + (size_t)512 * 256;
constexpr size_t WB_UK = WB_UQ + (size_t)1536 * 256;
constexpr size_t WB_UV = WB_UK + (size_t)16 * 128 * 64;
constexpr size_t WB_WIDX = WB_UV + (size_t)16 * 64 * 128;
constexpr size_t WB_END = WB_WIDX + (size_t)64 * 1024;
constexpr size_t OFF_PPOOL = OFF_WB + AL(WB_END * 2);
constexpr size_t OFF_PK = OFF_PPOOL + SZ_ACT;
constexpr size_t OFF_PR = OFF_PK + SZ_ACT;
constexpr size_t OFF_PV = OFF_PR + SZ_ACT;
constexpr size_t OFF_PMISC = OFF_PV + SZ_ACT;
constexpr size_t OFF_VFIRST = OFF_PMISC + AL((size_t)NTP * PM_LD * 2);
constexpr size_t OFF_HALO = OFF_VFIRST + SZ_ACT;
constexpr size_t OFF_LIST = OFF_HALO + AL((size_t)130 * 16 * 1024 * 2);
constexpr size_t OFF_PW = OFF_LIST + AL((size_t)24 * NT * 4);
constexpr size_t WS_END = OFF_PW + AL((size_t)NT * 2 * 4);
constexpr size_t OFF_MERGED = OFF_PK;
constexpr size_t OFF_HM32 = OFF_PR;
constexpr size_t OFF_HN = OFF_PPOOL;
constexpr size_t OFF_WEXP = OFF_PMISC;
constexpr size_t WE_W1 = 0, WE_W3 = (size_t)16 * 256 * 1024, WE_W2 = (size_t)2 * 16 * 256 * 1024;
static_assert((size_t)3 * 16 * 256 * 1024 * 2 <= (size_t)NTP * PM_LD * 2, "expert weights must fit in Pmisc");
constexpr size_t DO_YC = 0;
constexpr size_t DO_CQN = DO_YC + SZ_ACT;
constexpr size_t DO_KV = DO_CQN + AL((size_t)NT * 256 * 2);
constexpr size_t DO_KIDX = DO_KV + AL((size_t)NT * 160 * 2);
constexpr size_t DO_WHEAD = DO_KIDX + AL((size_t)NT * 64 * 2);
constexpr size_t DO_ALR = DO_WHEAD + AL((size_t)NT * 8 * 4);
constexpr size_t DO_END = DO_ALR + AL((size_t)NT * 288 * 2);
constexpr size_t QS_BYTES = (size_t)16 * 16 * 160 * 2;
constexpr int QS_WS = (int)((277240096ull - WS_END) / QS_BYTES), QS_DO = (int)(((size_t)NB * SEQ * DM * 4 - DO_END) / QS_BYTES);
static_assert(QS_WS + QS_DO >= 256, "Q scratch");
constexpr size_t DO_HID = DO_YC;
static_assert(DO_END <= (size_t)NB * SEQ * DM * 4, "d_out scratch overflow");
static_assert((size_t)(129 + 24) * 128 * 512 * 2 <= SZ_ACT, "hid fits");
static_assert(WS_END <= 277240096ull, "workspace overflow");

struct Params {
    const float* in[42];
    float* out;
    unsigned char* ws;
};

__device__ __forceinline__ int otid() { int t = threadIdx.x; asm volatile("" : "+v"(t)); return t; }
__device__ __forceinline__ int obid() { int b = blockIdx.x; asm volatile("" : "+s"(b)); return b; }
typedef __attribute__((address_space(1))) unsigned char gas_uchar;
__device__ __forceinline__ unsigned char* WS(const Params& p) { gas_uchar* w = (gas_uchar*)p.ws; asm volatile("" : "+s"(w)); return (unsigned char*)w; }
__device__ __forceinline__ unsigned char* OUTB(const Params& p) { gas_uchar* w = (gas_uchar*)p.out; asm volatile("" : "+s"(w)); return (unsigned char*)w; }
__device__ __forceinline__ float bf2f(bf16_t v) { return __uint_as_float(((unsigned)v) << 16); }
typedef float f32x2v __attribute__((ext_vector_type(2)));
typedef __bf16 bf16x2v __attribute__((ext_vector_type(2)));
__device__ __forceinline__ unsigned pk2(float a, float b) { const f32x2v v = {a, b}; const bf16x2v r = __builtin_convertvector(v, bf16x2v); unsigned u; __builtin_memcpy(&u, &r, 4); return u; }
__device__ __forceinline__ bf16_t f2bf(float f) { const __bf16 h = (__bf16)f; bf16_t u; __builtin_memcpy(&u, &h, 2); return u; }
__device__ __forceinline__ float wave_sum(float v) {
#pragma unroll
    for (int o = 32; o > 0; o >>= 1) v += __shfl_xor(v, o);
    return v;
}
template <int CTRL> __device__ __forceinline__ float dpp_f(float x) {
    return __int_as_float(__builtin_amdgcn_update_dpp(0, __float_as_int(x), CTRL, 0xF, 0xF, true));
}
__device__ __forceinline__ float row16_sum(float v) {
    v += dpp_f<0xB1>(v);
    v += dpp_f<0x4E>(v);
    v += dpp_f<0x141>(v);
    v += dpp_f<0x140>(v);
    return v;
}
__device__ __forceinline__ void lds_barrier() { asm volatile("s_waitcnt lgkmcnt(0)" ::: "memory"); __builtin_amdgcn_s_barrier(); asm volatile("" ::: "memory"); }
__device__ __forceinline__ float fast_rcp(float x) { return __builtin_amdgcn_rcpf(x); }
__device__ __forceinline__ float fast_sigmoid(float x) { return fast_rcp(1.0f + __expf(-x)); }
__device__ __forceinline__ float fast_tanh(float x) { return 1.0f - 2.0f * fast_rcp(1.0f + __expf(2.0f * x)); }
__device__ __forceinline__ void row16_sum4(float& a, float& b, float& c, float& d) {
    asm volatile(
        "s_nop 1\n\t"
        "v_add_f32_dpp %0, %0, %0 quad_perm:[1,0,3,2] row_mask:0xf bank_mask:0xf\n\t"
        "v_add_f32_dpp %1, %1, %1 quad_perm:[1,0,3,2] row_mask:0xf bank_mask:0xf\n\t"
        "v_add_f32_dpp %2, %2, %2 quad_perm:[1,0,3,2] row_mask:0xf bank_mask:0xf\n\t"
        "v_add_f32_dpp %3, %3, %3 quad_perm:[1,0,3,2] row_mask:0xf bank_mask:0xf\n\t"
        "v_add_f32_dpp %0, %0, %0 quad_perm:[2,3,0,1] row_mask:0xf bank_mask:0xf\n\t"
        "v_add_f32_dpp %1, %1, %1 quad_perm:[2,3,0,1] row_mask:0xf bank_mask:0xf\n\t"
        "v_add_f32_dpp %2, %2, %2 quad_perm:[2,3,0,1] row_mask:0xf bank_mask:0xf\n\t"
        "v_add_f32_dpp %3, %3, %3 quad_perm:[2,3,0,1] row_mask:0xf bank_mask:0xf\n\t"
        "v_add_f32_dpp %0, %0, %0 row_half_mirror row_mask:0xf bank_mask:0xf\n\t"
        "v_add_f32_dpp %1, %1, %1 row_half_mirror row_mask:0xf bank_mask:0xf\n\t"
        "v_add_f32_dpp %2, %2, %2 row_half_mirror row_mask:0xf bank_mask:0xf\n\t"
        "v_add_f32_dpp %3, %3, %3 row_half_mirror row_mask:0xf bank_mask:0xf\n\t"
        "v_add_f32_dpp %0, %0, %0 row_mirror row_mask:0xf bank_mask:0xf\n\t"
        "v_add_f32_dpp %1, %1, %1 row_mirror row_mask:0xf bank_mask:0xf\n\t"
        "v_add_f32_dpp %2, %2, %2 row_mirror row_mask:0xf bank_mask:0xf\n\t"
        "v_add_f32_dpp %3, %3, %3 row_mirror row_mask:0xf bank_mask:0xf\n\t"
        "s_nop 1"
        : "+v"(a), "+v"(b), "+v"(c), "+v"(d));
}
__device__ __forceinline__ void row8_sum2(float& a, float& b) {
    asm volatile(
        "s_nop 1\n\t"
        "v_add_f32_dpp %0, %0, %0 quad_perm:[1,0,3,2] row_mask:0xf bank_mask:0xf\n\t"
        "v_add_f32_dpp %1, %1, %1 quad_perm:[1,0,3,2] row_mask:0xf bank_mask:0xf\n\t"
        "s_nop 0\n\t"
        "v_add_f32_dpp %0, %0, %0 quad_perm:[2,3,0,1] row_mask:0xf bank_mask:0xf\n\t"
        "v_add_f32_dpp %1, %1, %1 quad_perm:[2,3,0,1] row_mask:0xf bank_mask:0xf\n\t"
        "s_nop 0\n\t"
        "v_add_f32_dpp %0, %0, %0 row_half_mirror row_mask:0xf bank_mask:0xf\n\t"
        "v_add_f32_dpp %1, %1, %1 row_half_mirror row_mask:0xf bank_mask:0xf\n\t"
        "s_nop 1"
        : "+v"(a), "+v"(b));
}
__device__ __forceinline__ float xrow_sum(float v) {
    const auto a = __builtin_amdgcn_permlane16_swap(__float_as_uint(v), __float_as_uint(v), false, false);
    v = __uint_as_float(a[0]) + __uint_as_float(a[1]);
    const auto b = __builtin_amdgcn_permlane32_swap(__float_as_uint(v), __float_as_uint(v), false, false);
    return __uint_as_float(b[0]) + __uint_as_float(b[1]);
}
__device__ __forceinline__ float wave_sum_fast(float v) { return xrow_sum(row16_sum(v)); }
__device__ __forceinline__ float sigmoidf_(float x) { return 1.0f / (1.0f + __expf(-x)); }
__device__ __forceinline__ float softplusf_(float z) { return fmaxf(z, 0.f) + log1pf(__expf(-fabsf(z))); }
__device__ __forceinline__ void glds16(const void* g, void* l) {
    __builtin_amdgcn_global_load_lds((const unsigned*)g, (unsigned*)l, 16, 0, 0);
}

__device__ void phase_embed(const Params& p) {
    const int lane = otid() & 63;
    const int wave = (obid() * NTHR + otid()) >> 6, nw = gridDim.x * NTHR / 64;
    bf16_t* h = (bf16_t*)(WS(p) + OFF_H);
    float* rstd = (float*)(WS(p) + OFF_RSTD);
    auto srcrow = [&](int n) { const int b = n / TS, t = n % TS; return t < NMETA ? p.in[1] + (size_t)t * DM : p.in[0] + ((size_t)b * SEQ + (t - NMETA)) * DM; };
    float4 cur[4];
    if (wave < NT) {
        const float* src = srcrow(wave);
#pragma unroll
        for (int i = 0; i < 4; ++i) cur[i] = *(const float4*)(src + i * 256 + lane * 4);
    }
    for (int n = wave; n < NTP; n += nw) {
        if (n < NT) {
            float4 v[4];
#pragma unroll
            for (int i = 0; i < 4; ++i) v[i] = cur[i];
            if (n + nw < NT) {
                const float* src = srcrow(n + nw);
#pragma unroll
                for (int i = 0; i < 4; ++i) cur[i] = *(const float4*)(src + i * 256 + lane * 4);
            }
            float ss = 0.f;
#pragma unroll
            for (int i = 0; i < 4; ++i) {
                ss += v[i].x * v[i].x + v[i].y * v[i].y + v[i].z * v[i].z + v[i].w * v[i].w;
                *(uint2*)(h + (size_t)n * DM + i * 256 + lane * 4) = make_uint2(pk2(v[i].x, v[i].y), pk2(v[i].z, v[i].w));
            }
            ss = wave_sum_fast(ss);
            if (lane == 0) rstd[n] = rsqrtf(ss * (1.0f / 1024.0f) + 1e-6f);
        } else {
#pragma unroll
            for (int i = 0; i < 4; ++i) *(ushort4*)(h + (size_t)n * DM + i * 256 + lane * 4) = make_ushort4(0, 0, 0, 0);
            if (lane == 0) rstd[n] = 0.f;
        }
    }
    float* ctab = (float*)(WS(p) + OFF_ROPE);
    float* stab = ctab + TS * 16;
    for (int idx = obid() * NTHR + otid(); idx < TS * 16; idx += gridDim.x * NTHR) {
        const int t = idx >> 4, i = idx & 15;
        const float inv = powf(10000.0f, -(float)(2 * i) / 32.0f);
        const float ang = (float)t * inv;
        ctab[idx] = cosf(ang);
        stab[idx] = sinf(ang);
    }
}

__device__ void phase_rowstat(const Params& p) {
    const int lane = otid() & 63;
    const int wave = (obid() * NTHR + otid()) >> 6, nw = gridDim.x * NTHR / 64;
    const bf16_t* hb = (const bf16_t*)(WS(p) + OFF_H);
    float* rstd = (float*)(WS(p) + OFF_RSTD);
    uint4 cur[2];
    if (wave < NT) { cur[0] = *(const uint4*)(hb + (size_t)wave * DM + lane * 8); cur[1] = *(const uint4*)(hb + (size_t)wave * DM + 512 + lane * 8); }
    for (int n = wave; n < NT; n += nw) {
        float ss = 0.f;
#pragma unroll
        for (int i = 0; i < 2; ++i) {
            const unsigned w_[4] = {cur[i].x, cur[i].y, cur[i].z, cur[i].w};
#pragma unroll
            for (int j = 0; j < 4; ++j) { const float a_ = __uint_as_float(w_[j] << 16), b_ = __uint_as_float(w_[j] & 0xFFFF0000u); ss += a_ * a_ + b_ * b_; }
        }
        if (n + nw < NT) { cur[0] = *(const uint4*)(hb + (size_t)(n + nw) * DM + lane * 8); cur[1] = *(const uint4*)(hb + (size_t)(n + nw) * DM + 512 + lane * 8); }
        ss = wave_sum_fast(ss);
        if (lane == 0) rstd[n] = rsqrtf(ss * (1.0f / 1024.0f) + 1e-6f);
    }
}

struct ConvJob { const float* src; bf16_t* dst; const float* scale; int ldsrc, K, nvalid, nrows, nb, notr; size_t sbs, dbs; const float* srcB; int ldB, split; };
__device__ __forceinline__ int conv_job_tiles(const ConvJob& j) { return j.nb * (j.nrows >> 6) * (j.K >> 6); }
__device__ void conv_tile(const ConvJob& j, int tile, float* lds) {
    const int per = (j.nrows >> 6) * (j.K >> 6);
    const int bi = tile / per, rem = tile % per;
    const int ktiles = j.K >> 6;
    const int n0 = (rem / ktiles) << 6, k0 = (rem % ktiles) << 6;
    const int tid = otid(), tn = tid & 63, tk = tid >> 6;
    const float* src = j.src + (size_t)bi * j.sbs;
    bf16_t* dst = j.dst + (size_t)bi * j.dbs;
#pragma unroll
    for (int kk = 0; kk < 8; ++kk) {
        const int k = k0 + tk * 8 + kk;
        float v = 0.f;
        if (n0 + tn < j.nvalid) {
            if (j.split) { const int nn = n0 + tn; v = (nn < j.split) ? (j.src ? j.src[(size_t)k * j.ldsrc + nn] : 0.f) : j.srcB[(size_t)k * j.ldB + (nn - j.split)]; }
            else v = j.notr ? src[(size_t)(n0 + tn) * j.ldsrc + k] : src[(size_t)k * j.ldsrc + n0 + tn];
            if (j.scale) v *= j.scale[k];
        }
        lds[tn * 65 + tk * 8 + kk] = v;
    }
    __syncthreads();
    const int wn = tid >> 3, kq = tid & 7;
    uint4 o;
    unsigned w[4];
#pragma unroll
    for (int q = 0; q < 4; ++q) {
        const float lo = lds[wn * 65 + kq * 8 + 2 * q], hi = lds[wn * 65 + kq * 8 + 2 * q + 1];
        w[q] = pk2(lo, hi);
    }
    o.x = w[0]; o.y = w[1]; o.z = w[2]; o.w = w[3];
    *(uint4*)(dst + (size_t)(n0 + wn) * j.K + k0 + kq * 8) = o;
    __syncthreads();
}
__device__ ConvJob get_job_early(const Params& p, int l, int ji) {
    bf16_t* wb = (bf16_t*)(WS(p) + OFF_WB);
    const float* win = p.in[3] + (size_t)l * DM * CIN;
    const float* nm = p.in[2] + (size_t)l * DM;
    ConvJob j{}; j.nb = 1; j.sbs = 0; j.dbs = 0; j.K = 1024; j.ldsrc = CIN; j.scale = nm;
    switch (ji) {
    case 0: j.src = win + 3072; j.dst = wb + WB_WIN; j.nvalid = 4352; j.nrows = 4352; break;
    case 1: j.src = (l == 0 ? nullptr : p.in[17]); j.ldsrc = 32; j.split = 32; j.srcB = win + 7424; j.ldB = CIN; j.dst = wb + WB_WIN + (size_t)(4096 + PM_VD) * 1024; j.nvalid = 512; j.nrows = 512; break;
    case 2: j.src = win + 7904; j.dst = wb + WB_WIDX; j.nvalid = 8; j.nrows = 64; break;
    case 3: j.src = win; j.dst = wb + WB_WG; j.nvalid = 3072; j.nrows = 3072; break;
    case 4: j.src = p.in[29] + (size_t)l * DM * DM; j.ldsrc = 1024; j.scale = nullptr; j.dst = wb + WB_PA; j.nvalid = 1024; j.nrows = 1024; break;
    case 5: j.src = p.in[30] + (size_t)l * DM * DM; j.ldsrc = 1024; j.scale = nullptr; j.dst = wb + WB_PA + (size_t)1024 * 1024; j.nvalid = 1024; j.nrows = 1024; break;
    case 6: j.src = p.in[31] + (size_t)l * DM * DM; j.ldsrc = 1024; j.scale = nullptr; j.dst = wb + WB_PA + (size_t)2 * 1024 * 1024; j.nvalid = 1024; j.nrows = 1024; break;
    case 7: j.src = p.in[32] + (size_t)l * DM * DM; j.ldsrc = 1024; j.scale = nullptr; j.dst = wb + WB_WO; j.nvalid = 1024; j.nrows = 1024; break;
    case 8: j.src = p.in[5] + (size_t)l * 4 * 256 * 256; j.ldsrc = 256; j.K = 256; j.scale = nullptr; j.dst = wb + WB_POOL; j.nvalid = 256; j.nrows = 256; j.nb = 4; j.sbs = 65536; j.dbs = 65536; break;
    case 9: j.src = p.in[26] + (size_t)l * 256 * 512; j.ldsrc = 512; j.K = 256; j.scale = nullptr; j.dst = wb + WB_QI; j.nvalid = 512; j.nrows = 512; break;
    case 10: j.src = p.in[23] + (size_t)l * 256 * 1536; j.ldsrc = 1536; j.K = 256; j.scale = nullptr; j.dst = wb + WB_UQ; j.nvalid = 1536; j.nrows = 1536; break;
    case 11: j.src = p.in[24] + (size_t)l * 16 * 128 * 64; j.ldsrc = 64; j.K = 64; j.scale = nullptr; j.dst = wb + WB_UK; j.nvalid = 2048; j.nrows = 2048; j.notr = 1; break;
    default: j.src = p.in[25] + (size_t)l * 16 * 128 * 64; j.ldsrc = 64; j.K = 128; j.scale = nullptr; j.dst = wb + WB_UV; j.nvalid = 64; j.nrows = 64; j.nb = 16; j.sbs = 8192; j.dbs = 8192; break;
    }
    return j;
}
__device__ ConvJob get_job_late(const Params& p, int l, int ji) {
    bf16_t* we = (bf16_t*)(WS(p) + OFF_WEXP);
    ConvJob j{}; j.nb = 16; j.scale = nullptr; j.sbs = 262144; j.dbs = 262144;
    switch (ji) {
    case 0: j.src = p.in[38] + (size_t)l * 16 * 262144; j.dst = we + WE_W1; j.ldsrc = 256; j.K = 1024; j.nvalid = 256; j.nrows = 256; break;
    case 1: j.src = p.in[39] + (size_t)l * 16 * 262144; j.dst = we + WE_W3; j.ldsrc = 256; j.K = 1024; j.nvalid = 256; j.nrows = 256; break;
    default: j.src = p.in[40] + (size_t)l * 16 * 262144; j.dst = we + WE_W2; j.ldsrc = 1024; j.K = 256; j.nvalid = 1024; j.nrows = 1024; break;
    }
    return j;
}
template <bool LATE>
__device__ void phase_convert(const Params& p, int l, unsigned char* lds) {
    const int njobs = LATE ? 3 : 13;
    int base = 0;
    for (int ji = 0; ji < njobs; ++ji) {
        const ConvJob j = LATE ? get_job_late(p, l, ji) : get_job_early(p, l, ji);
        const int nt = conv_job_tiles(j);
        int first = ((int)obid() - base) % (int)gridDim.x; if (first < 0) first += gridDim.x;
        for (int t = first; t < nt; t += gridDim.x) conv_tile(j, t, (float*)lds);
        base += nt;
    }
}

template <int BM> struct G3 {
    static constexpr int MI = BM / 64;
    static constexpr int NA = BM / 64;
    static constexpr int STAGE = BM * 128 + 128 * 128;
    const bf16_t* ap[NA];
    const bf16_t* bp[2];
};
template <int BM>
__device__ __forceinline__ void g3_issue(const G3<BM>& g, int kt, unsigned char* stage, int tid) {
#pragma unroll
    for (int i = 0; i < G3<BM>::NA; ++i) glds16(g.ap[i] + kt * 64, stage + (tid + i * NTHR) * 16);
#pragma unroll
    for (int i = 0; i < 2; ++i) glds16(g.bp[i] + kt * 64, stage + BM * 128 + (tid + i * NTHR) * 16);
}
template <int BM, class FA, class FB>
__device__ __forceinline__ void g3_setup(G3<BM>& g, FA rowptr, FB bcol, int tid) {
#pragma unroll
    for (int i = 0; i < G3<BM>::NA; ++i) { const int idx = tid + i * NTHR, row = idx >> 3, sl = (idx & 7) ^ (row & 7); g.ap[i] = rowptr(row) + sl * 8; }
#pragma unroll
    for (int i = 0; i < 2; ++i) { const int idx = tid + i * NTHR, row = idx >> 3, sl = (idx & 7) ^ (row & 7); g.bp[i] = bcol(row) + sl * 8; }
}
template <int BM>
__device__ __forceinline__ void g3_kloop(f32x4 (&acc)[BM / 64][4], const G3<BM>& g, int K, unsigned char* lds) {
    constexpr int MI = G3<BM>::MI, STAGE = G3<BM>::STAGE, NL = G3<BM>::NA + 2;
    const int tid = otid(), lane = tid & 63, wid = tid >> 6, wr = wid >> 1, wc = wid & 1, fr = lane & 15, fq = lane >> 4;
    const int nk = K >> 6;
    g3_issue<BM>(g, 0, lds, tid);
    if (nk > 1) g3_issue<BM>(g, 1, lds + STAGE, tid);
    int cur = 0;
#pragma unroll 1
    for (int t = 0; t < nk; ++t) {
        if (t + 1 < nk) { if (NL == 6) asm volatile("s_waitcnt vmcnt(6)" ::: "memory"); else if (NL == 5) asm volatile("s_waitcnt vmcnt(5)" ::: "memory"); else asm volatile("s_waitcnt vmcnt(4)" ::: "memory"); }
        else asm volatile("s_waitcnt vmcnt(0)" ::: "memory");
        __builtin_amdgcn_s_barrier();
        if (t + 2 < nk) { int nx = cur + 2; if (nx >= 3) nx -= 3; g3_issue<BM>(g, t + 2, lds + nx * STAGE, tid); }
        const unsigned char* cA = lds + cur * STAGE;
        const unsigned char* cB = cA + BM * 128;
#pragma unroll
        for (int ks = 0; ks < 2; ++ks) {
            bf16x8 a[MI], b[4];
#pragma unroll
            for (int m = 0; m < MI; ++m) { const int row = wr * (BM / 4) + m * 16 + fr; a[m] = *(const bf16x8*)(cA + row * 128 + (((ks * 4 + fq) ^ (row & 7)) << 4)); }
#pragma unroll
            for (int n = 0; n < 4; ++n) { const int row = wc * 64 + n * 16 + fr; b[n] = *(const bf16x8*)(cB + row * 128 + (((ks * 4 + fq) ^ (row & 7)) << 4)); }
#pragma unroll
            for (int m = 0; m < MI; ++m)
#pragma unroll
                for (int n = 0; n < 4; ++n) acc[m][n] = __builtin_amdgcn_mfma_f32_16x16x32_bf16(b[n], a[m], acc[m][n], 0, 0, 0);
        }
        cur = (cur == 2) ? 0 : cur + 1;
    }
    __builtin_amdgcn_s_barrier();
}
struct G3D { const bf16_t* ap[2]; const bf16_t* b1[2]; const bf16_t* b3[2]; };
__device__ __forceinline__ void g3d_issue(const G3D& g, int kt, unsigned char* stage, int tid) {
#pragma unroll
    for (int i = 0; i < 2; ++i) glds16(g.ap[i] + kt * 64, stage + (tid + i * NTHR) * 16);
#pragma unroll
    for (int i = 0; i < 2; ++i) glds16(g.b1[i] + kt * 64, stage + 16384 + (tid + i * NTHR) * 16);
#pragma unroll
    for (int i = 0; i < 2; ++i) glds16(g.b3[i] + kt * 64, stage + 32768 + (tid + i * NTHR) * 16);
}
__device__ __forceinline__ void g3d_kloop(f32x4 (&acc1)[2][4], f32x4 (&acc3)[2][4], const G3D& g, int K, unsigned char* lds) {
    constexpr int STAGE = 49152;
    const int tid = otid(), lane = tid & 63, wid = tid >> 6, wr = wid >> 1, wc = wid & 1, fr = lane & 15, fq = lane >> 4;
    const int nk = K >> 6;
    g3d_issue(g, 0, lds, tid);
    if (nk > 1) g3d_issue(g, 1, lds + STAGE, tid);
    int cur = 0;
#pragma unroll 1
    for (int t = 0; t < nk; ++t) {
        if (t + 1 < nk) asm volatile("s_waitcnt vmcnt(6)" ::: "memory"); else asm volatile("s_waitcnt vmcnt(0)" ::: "memory");
        __builtin_amdgcn_s_barrier();
        if (t + 2 < nk) { int nx = cur + 2; if (nx >= 3) nx -= 3; g3d_issue(g, t + 2, lds + nx * STAGE, tid); }
        const unsigned char* cA = lds + cur * STAGE;
#pragma unroll
        for (int ks = 0; ks < 2; ++ks) {
            bf16x8 a[2], b1[4], b3[4];
#pragma unroll
            for (int m = 0; m < 2; ++m) { const int row = wr * 32 + m * 16 + fr; a[m] = *(const bf16x8*)(cA + row * 128 + (((ks * 4 + fq) ^ (row & 7)) << 4)); }
#pragma unroll
            for (int n = 0; n < 4; ++n) { const int row = wc * 64 + n * 16 + fr; const int off = row * 128 + (((ks * 4 + fq) ^ (row & 7)) << 4);
                b1[n] = *(const bf16x8*)(cA + 16384 + off); b3[n] = *(const bf16x8*)(cA + 32768 + off); }
#pragma unroll
            for (int m = 0; m < 2; ++m)
#pragma unroll
                for (int n = 0; n < 4; ++n) {
                    acc1[m][n] = __builtin_amdgcn_mfma_f32_16x16x32_bf16(b1[n], a[m], acc1[m][n], 0, 0, 0);
                    acc3[m][n] = __builtin_amdgcn_mfma_f32_16x16x32_bf16(b3[n], a[m], acc3[m][n], 0, 0, 0);
                }
        }
        cur = (cur == 2) ? 0 : cur + 1;
    }
    __builtin_amdgcn_s_barrier();
}
template <int MI>
__device__ __forceinline__ void g3_zero(f32x4 (&acc)[MI][4]) {
#pragma unroll
    for (int m = 0; m < MI; ++m)
#pragma unroll
        for (int n = 0; n < 4; ++n) acc[m][n] = (f32x4){0.f, 0.f, 0.f, 0.f};
}
__device__ __forceinline__ uint2 pack4(float a, float b, float c, float d) {
    uint2 r; r.x = pk2(a, b); r.y = pk2(c, d); return r;
}

namespace pg8 {
#define PG8_LAS __attribute__((address_space(3)))
typedef unsigned short bf16_t;
typedef short bf16x8 __attribute__((ext_vector_type(8)));
typedef float f32x4 __attribute__((ext_vector_type(4)));
typedef unsigned u32x4 __attribute__((ext_vector_type(4)));
constexpr int BM = 256, BK = 64, HALF = 128, HTB = HALF * BK * 2  , STAGE_BYTES = 8 * HTB, NXCD = 8, WGM = 8;

__host__ __device__ __forceinline__ int lds_byte(int r, int c) { const int st = (r >> 4) * 2 + (c >> 5), rr = r & 15, cc = c & 31, ob = rr * 64 + cc * 2; return st * 1024 + (ob ^ (((ob >> 9) & 1) << 5)); }
__host__ __device__ __forceinline__ void stage_rc(int b, int& R, int& C) { const int st = b / 1024, sb = b % 1024, swz = sb ^ (((sb >> 9) & 1) << 5); R = (st >> 1) * 16 + swz / 64; C = (st & 1) * 32 + (swz % 64) / 2; }
__host__ __device__ __forceinline__ int perm32(int rho) { const int n = rho >> 4, i = rho & 15; return 8 * (i >> 2) + 4 * n + (i & 3); }

struct Unit { int pm, pn; };
struct Gemm { const bf16_t* A; const bf16_t* Bt; int M, N, K; };

struct StaticOrder {
    int nM, nN, nwg, G, c;
    __host__ __device__ void init(int M, int N, int G_, int c_) { nM = M / BM; nN = N / BM; nwg = nM * nN; G = G_; c = c_; }
    __host__ __device__ bool next(int i, Unit& u) const {
        const long L = (long)i * G + c; if (L >= nwg) return false;
        int wgid = (int)L; { const int q = nwg / NXCD, r = nwg % NXCD, xcd = wgid % NXCD, off = wgid / NXCD; wgid = (xcd < r ? xcd * (q + 1) : r * (q + 1) + (xcd - r) * q) + off; }
        const int nig = WGM * nN, gid = wgid / nig, fm = gid * WGM, gsz = (nM - fm) < WGM ? (nM - fm) : WGM;
        u.pm = fm + ((wgid % nig) % gsz); u.pn = (wgid % nig) / gsz; return true;
    }
    __device__ __forceinline__ void a_ready(const Unit&) const {}
    __device__ __forceinline__ void done(const Unit&) const {}
};
template <class Epi, class Sched, bool STAMP = false>
__device__ __forceinline__ void gemm_phase(PG8_LAS unsigned char* lds, const Gemm g, const Sched& S, const Epi& E, unsigned long long* stamps) {
    const int tid = otid(), wid = __builtin_amdgcn_readfirstlane(tid >> 6), lane = tid & 63, wr = wid >> 2, wc = wid & 3, fr = lane & 15, fq = lane >> 4;
    const int K = g.K, nt = K / BK;
    int ts_lo = 0, ts_hi = 0, nts = 0; const unsigned long long rt_entry = STAMP ? 0ull : 0ull;
#define PG8_STAMP() do { if (STAMP && wid == 0 && nts < 64) { const unsigned long long _c = 0ull; \
        ts_lo = (lane == nts) ? (int)(unsigned)_c : ts_lo; ts_hi = (lane == nts) ? (int)(unsigned)(_c >> 32) : ts_hi; ++nts; } } while (0)
    PG8_STAMP();
    unsigned voffA[2], voffB[2];
#pragma unroll
    for (int i = 0; i < 2; ++i) { int R, C; stage_rc(tid * 16 + i * 8192, R, C); const int Rb = Epi::PERM ? ((R & ~31) + perm32(R & 31)) : R;
        voffA[i] = (unsigned)(R * K + C) * 2u; voffB[i] = (unsigned)(Rb * K + C) * 2u; }
    const size_t kstep = (size_t)(BK * 2);
    const size_t hstep = (size_t)HALF * K * 2;
    const size_t tstep = 2 * hstep;
    const unsigned ldsw = (unsigned)wid * 1024u;
    const int aoff = lds_byte(wr * 64 + fr, fq * 8), boff = lds_byte(wc * 32 + fr, fq * 8);
#define PG8_SA(b, h) (((b) * 2 + (h)) * HTB)
#define PG8_SB(b, h) ((4 + (b) * 2 + (h)) * HTB)
#define PG8_STAGE(bufoff, gbase, voff) do { _Pragma("unroll") for (int _i = 0; _i < 2; ++_i) \
        __builtin_amdgcn_global_load_lds((const unsigned*)((const char*)(gbase) + (voff)[_i]), (PG8_LAS unsigned*)(lds + (bufoff) + ldsw + _i * 8192), 16, 0, 0); } while (0)
#define PG8_LDA(dst, b, h) do { _Pragma("unroll") for (int m = 0; m < 4; ++m) _Pragma("unroll") for (int k = 0; k < 2; ++k) dst[m][k] = *(const PG8_LAS bf16x8*)(lds + PG8_SA(b, h) + aoff + m * 2048 + k * 1024); } while (0)
#define PG8_LDB(dst, b, h) do { _Pragma("unroll") for (int n = 0; n < 2; ++n) _Pragma("unroll") for (int k = 0; k < 2; ++k) dst[n][k] = *(const PG8_LAS bf16x8*)(lds + PG8_SB(b, h) + boff + n * 2048 + k * 1024); } while (0)
#define PG8_MMA(ai, bj, At, Bt) do { __builtin_amdgcn_s_setprio(1); _Pragma("unroll") for (int m = 0; m < 4; ++m) _Pragma("unroll") for (int n = 0; n < 2; ++n) _Pragma("unroll") for (int k = 0; k < 2; ++k) \
        acc[ai][bj][m][n] = __builtin_amdgcn_mfma_f32_16x16x32_bf16(Bt[n][k], At[m][k], acc[ai][bj][m][n], 0, 0, 0); __builtin_amdgcn_s_setprio(0); } while (0)
#define PG8_WAIT_V(n) asm volatile("s_waitcnt vmcnt(" #n ")" ::: "memory")
#define PG8_WAIT_L(n) asm volatile("s_waitcnt lgkmcnt(" #n ")" ::: "memory")
#define PG8_BAR __builtin_amdgcn_s_barrier()
#define PG8_SCHED __builtin_amdgcn_sched_barrier(0)
    Unit cur, nxt; int ui = 0;
    if (!S.next(0, cur)) return;
    f32x4 acc[2][2][4][2];
#pragma unroll
    for (int a = 0; a < 2; ++a)
#pragma unroll
        for (int b = 0; b < 2; ++b)
#pragma unroll
            for (int m = 0; m < 4; ++m)
#pragma unroll
                for (int n = 0; n < 2; ++n) acc[a][b][m][n] = (f32x4){0.f, 0.f, 0.f, 0.f};
    bf16x8 At[4][2], B0[2][2], B1[2][2];
    const char* cA = (const char*)g.A + (size_t)cur.pm * tstep; const char* cB = (const char*)g.Bt + (size_t)cur.pn * tstep;
    S.a_ready(cur);
    PG8_STAGE(PG8_SB(0, 0), cB, voffB); PG8_STAGE(PG8_SA(0, 0), cA, voffA); PG8_STAGE(PG8_SB(0, 1), cB + hstep, voffB); PG8_STAGE(PG8_SA(0, 1), cA + hstep, voffA);
    if (wr == 1) PG8_BAR;
    PG8_WAIT_V(4); PG8_BAR;
    PG8_STAGE(PG8_SB(1, 0), cB + kstep, voffB); PG8_STAGE(PG8_SA(1, 0), cA + kstep, voffA); PG8_STAGE(PG8_SB(1, 1), cB + hstep + kstep, voffB);
    PG8_WAIT_V(6); PG8_BAR;
    PG8_STAMP();
    for (;;) {
        const bool has_next = S.next(ui + 1, nxt);
        const char* nA = has_next ? (const char*)g.A + (size_t)nxt.pm * tstep : cA; const char* nB = has_next ? (const char*)g.Bt + (size_t)nxt.pn * tstep : cB;
        for (int t = 0; t < nt; t += 2) {
            const bool last = (t == nt - 2);
            const char* a1 = cA + (size_t)(t + 1) * kstep;
            const char* a2 = last ? nA : cA + (size_t)(t + 2) * kstep; const char* b2 = last ? nB : cB + (size_t)(t + 2) * kstep;
            const char* a3 = a2 + kstep; const char* b3 = b2 + kstep;
            if (last && has_next) S.a_ready(nxt);
            PG8_LDB(B0, 0, 0); PG8_SCHED; PG8_LDA(At, 0, 0); PG8_STAGE(PG8_SA(1, 1), a1 + hstep, voffA);
            PG8_WAIT_L(8); PG8_BAR; PG8_WAIT_L(0); PG8_MMA(0, 0, At, B0); PG8_BAR; PG8_SCHED;
            PG8_LDB(B1, 0, 1); PG8_STAGE(PG8_SB(0, 0), b2, voffB);
            PG8_BAR; PG8_WAIT_L(0); PG8_MMA(0, 1, At, B1); PG8_BAR;
            PG8_LDA(At, 0, 1); PG8_STAGE(PG8_SA(0, 0), a2, voffA);
            PG8_BAR; PG8_WAIT_L(0); PG8_MMA(1, 0, At, B0); PG8_BAR; PG8_SCHED;
            PG8_STAGE(PG8_SB(0, 1), b2 + hstep, voffB);
            PG8_WAIT_V(6); PG8_BAR; PG8_MMA(1, 1, At, B1); PG8_BAR;
            PG8_LDB(B0, 1, 0); PG8_SCHED; PG8_LDA(At, 1, 0); PG8_STAGE(PG8_SA(0, 1), a2 + hstep, voffA);
            PG8_WAIT_L(8); PG8_BAR; PG8_WAIT_L(0); PG8_MMA(0, 0, At, B0); PG8_BAR; PG8_SCHED;
            PG8_LDB(B1, 1, 1); PG8_STAGE(PG8_SB(1, 0), b3, voffB);
            PG8_BAR; PG8_WAIT_L(0); PG8_MMA(0, 1, At, B1); PG8_BAR;
            PG8_LDA(At, 1, 1); PG8_STAGE(PG8_SA(1, 0), a3, voffA);
            PG8_BAR; PG8_WAIT_L(0); PG8_MMA(1, 0, At, B0); PG8_BAR; PG8_SCHED;
            PG8_STAGE(PG8_SB(1, 1), b3 + hstep, voffB);
            PG8_WAIT_V(6); PG8_BAR; PG8_MMA(1, 1, At, B1); PG8_BAR;
        }
        PG8_STAMP();
        if constexpr (!Epi::AFTER_DRAIN) { E(acc, cur, wr, wc, fr, fq); S.done(cur); }
        PG8_STAMP();
        if (!has_next) break;
#pragma unroll
        for (int a = 0; a < 2; ++a)
#pragma unroll
            for (int b = 0; b < 2; ++b)
#pragma unroll
                for (int m = 0; m < 4; ++m)
#pragma unroll
                    for (int n = 0; n < 2; ++n) acc[a][b][m][n] = (f32x4){0.f, 0.f, 0.f, 0.f};
        cur = nxt; cA = nA; cB = nB; ++ui;
    }
    PG8_WAIT_V(0);
    if (wr == 0) PG8_BAR;
    PG8_BAR;
    if constexpr (Epi::AFTER_DRAIN) { E.fused(acc, cur, wr, wc, fr, fq, lds, wid, lane); S.done(cur); }
    PG8_STAMP();
    if (STAMP && wid == 0) { stamps[lane] = lane < nts ? (((unsigned long long)(unsigned)ts_hi << 32) | (unsigned)ts_lo) : 0ull;
        if (lane == 62) stamps[62] = rt_entry; if (lane == 63) stamps[63] = 0ull; }
#undef PG8_STAMP
#undef PG8_SA
#undef PG8_SB
#undef PG8_STAGE
#undef PG8_LDA
#undef PG8_LDB
#undef PG8_MMA
#undef PG8_WAIT_V
#undef PG8_WAIT_L
#undef PG8_BAR
#undef PG8_SCHED
}
}

struct EpiInproj {
    static constexpr bool PERM = true, AFTER_DRAIN = false;
    unsigned char* ws; const float* rstd;
    __device__ __forceinline__ void operator()(const pg8::f32x4 (&acc)[2][2][4][2], const pg8::Unit& u, int wr, int wc, int fr, int fq) const {
        const int pn = u.pn;
        bf16_t* dst; int ld, cb;
        if (pn < 4) { dst = (bf16_t*)(ws + OFF_PPOOL); ld = 1024; cb = pn * 256; }
        else if (pn < 8) { dst = (bf16_t*)(ws + OFF_PR); ld = 1024; cb = (pn - 4) * 256; }
        else if (pn < 12) { dst = (bf16_t*)(ws + OFF_PK); ld = 1024; cb = (pn - 8) * 256; }
        else if (pn < 16) { dst = (bf16_t*)(ws + OFF_PV); ld = 1024; cb = (pn - 12) * 256; }
        else { dst = (bf16_t*)(ws + OFF_PMISC); ld = PM_LD; cb = (pn - 16) * 256; }
        bf16_t* halo = (bf16_t*)(ws + OFF_HALO);
        float rsv[2][4];
#pragma unroll
        for (int ai = 0; ai < 2; ++ai)
#pragma unroll
            for (int m = 0; m < 4; ++m) { const int row = u.pm * 256 + ai * 128 + wr * 64 + m * 16 + fr; rsv[ai][m] = (row < NT) ? rstd[row] : 0.f; }
#pragma unroll
        for (int ai = 0; ai < 2; ++ai)
#pragma unroll
            for (int m = 0; m < 4; ++m) {
                const int row = u.pm * 256 + ai * 128 + wr * 64 + m * 16 + fr;
                if (row < NT) {
                    const float rs = rsv[ai][m];
                    const int lr = row & 127;
#pragma unroll
                    for (int bj = 0; bj < 2; ++bj) {
                        const int col = cb + bj * 128 + wc * 32 + fq * 8;
                        const uint2 lo = pack4(acc[ai][bj][m][0][0] * rs, acc[ai][bj][m][0][1] * rs, acc[ai][bj][m][0][2] * rs, acc[ai][bj][m][0][3] * rs);
                        const uint2 hi = pack4(acc[ai][bj][m][1][0] * rs, acc[ai][bj][m][1][1] * rs, acc[ai][bj][m][1][2] * rs, acc[ai][bj][m][1][3] * rs);
                        const uint4 v = make_uint4(lo.x, lo.y, hi.x, hi.y);
                        *(uint4*)(dst + (size_t)row * ld + col) = v;
                        if (pn < 4 && lr >= 112) *(uint4*)(halo + ((size_t)(row >> 7) * 16 + (lr - 112)) * 1024 + col) = v;
                    }
                }
            }
    }
};
__device__ void phase_inproj(const Params& p, unsigned char* lds) {
    pg8::StaticOrder S; S.init(NTP, NP1, (int)gridDim.x, obid());
    pg8::Gemm g; g.A = (const pg8::bf16_t*)(WS(p) + OFF_H); g.Bt = (const pg8::bf16_t*)(WS(p) + OFF_WB) + WB_WIN; g.M = NTP; g.N = NP1; g.K = DM;
    EpiInproj E; E.ws = WS(p); E.rstd = (const float*)(WS(p) + OFF_RSTD);
    pg8::gemm_phase<EpiInproj, pg8::StaticOrder, false>((PG8_LAS unsigned char*)lds, g, S, E, nullptr);
}

__device__ void phase_pool(const Params& p, int l, unsigned char* lds, int tb, int te, int tstep) {
    const int tid = otid(), lane = tid & 63, wid = tid >> 6, fr = lane & 15, fq = lane >> 4;
    bf16_t* pp = (bf16_t*)(WS(p) + OFF_PPOOL);
    const bf16_t* halo = (const bf16_t*)(WS(p) + OFF_HALO);
    const bf16_t* pw = (const bf16_t*)(WS(p) + OFF_WB) + WB_POOL;
    const float* scale = p.in[6] + (size_t)l * 1024;
    bf16_t* sp = (bf16_t*)lds;
    constexpr int SLD = 264;
    bf16_t* sraw = sp + 128 * SLD;
    for (int tile = tb; tile < te; tile += tstep) {
        const int mt = tile >> 2, g = tile & 3;
        const int row0 = mt * 128, w = 2 << g;
        const bf16_t* wg = pw + (size_t)g * 65536;
        bf16x8 bfr[8][2];
#pragma unroll
        for (int kk = 0; kk < 8; ++kk)
#pragma unroll
            for (int n = 0; n < 2; ++n) bfr[kk][n] = *(const bf16x8*)(wg + (size_t)(wid * 32 + n * 16 + fr) * 256 + kk * 32 + fq * 8);
        {
            for (int e = tid; e < 144 * 32; e += NTHR) {
                const int rr = e >> 5, c16 = e & 31;
                uint4 v = make_uint4(0u, 0u, 0u, 0u);
                if (rr >= 16) v = *(const uint4*)(pp + (size_t)(row0 + rr - 16) * 1024 + g * 256 + c16 * 8);
                else if (mt > 0) v = *(const uint4*)(halo + ((size_t)(mt - 1) * 16 + rr) * 1024 + g * 256 + c16 * 8);
                *(uint4*)(sraw + rr * 256 + c16 * 8) = v;
            }
        }
        __syncthreads();
        {
            const int c = tid & 255, r0 = (tid >> 8) * 64;
            auto rawv = [&](int nrel) -> float { return bf2f(sraw[(nrel + 16) * 256 + c]); };
            int t = (row0 + r0) % TS;
            float sum = 0.f;
            const int have = (t < w) ? t : w;
            for (int i = 1; i <= have; ++i) sum += rawv(r0 - i);
#pragma unroll 8
            for (int r = 0; r < 64; ++r) {
                if (t == 0) sum = 0.f;
                const float v = rawv(r0 + r);
                sum += v;
                if (t >= w) sum -= rawv(r0 + r - w);
                const int cnt = (t + 1 < w) ? (t + 1) : w;
                sp[(r0 + r) * SLD + c] = f2bf(sum * (1.0f / (float)cnt) - v);
                t = (t + 1 == TS) ? 0 : t + 1;
            }
        }
        __syncthreads();
        f32x4 acc[8][2];
#pragma unroll
        for (int m = 0; m < 8; ++m) { acc[m][0] = (f32x4){0.f, 0.f, 0.f, 0.f}; acc[m][1] = (f32x4){0.f, 0.f, 0.f, 0.f}; }
#pragma unroll
        for (int kk = 0; kk < 8; ++kk) {
#pragma unroll
            for (int m = 0; m < 8; ++m) {
                const bf16x8 a = *(const bf16x8*)(sp + (m * 16 + fr) * SLD + kk * 32 + fq * 8);
                acc[m][0] = __builtin_amdgcn_mfma_f32_16x16x32_bf16(bfr[kk][0], a, acc[m][0], 0, 0, 0);
                acc[m][1] = __builtin_amdgcn_mfma_f32_16x16x32_bf16(bfr[kk][1], a, acc[m][1], 0, 0, 0);
            }
        }
#pragma unroll
        for (int n = 0; n < 2; ++n) {
            const int col = g * 256 + wid * 32 + n * 16 + fq * 4;
            const float4 sc = *(const float4*)(scale + col);
#pragma unroll
            for (int m = 0; m < 8; ++m) {
                const int row = row0 + m * 16 + fr;
                *(uint2*)(pp + (size_t)row * 1024 + col) = pack4(acc[m][n][0] * sc.x, acc[m][n][1] * sc.y, acc[m][n][2] * sc.z, acc[m][n][3] * sc.w);
            }
        }
        __syncthreads();
    }
}

__device__ void phase_dsa_prep(const Params& p, int l) {
    const int lane = otid() & 63;
    const int wave = (obid() * NTHR + otid()) >> 6, nw = gridDim.x * NTHR / 64;
    const bf16_t* pm = (const bf16_t*)(WS(p) + OFF_PMISC);
    unsigned char* dob = OUTB(p);
    bf16_t* cqn = (bf16_t*)(dob + DO_CQN);
    bf16_t* kv = (bf16_t*)(dob + DO_KV);
    bf16_t* kidx = (bf16_t*)(dob + DO_KIDX);
    float* whead = (float*)(dob + DO_WHEAD);
    const float* ctab = (const float*)(WS(p) + OFF_ROPE);
    const float* stab = ctab + TS * 16;
    const bf16_t* hrow = (const bf16_t*)(WS(p) + OFF_H);
    const bf16_t* wwidx = (const bf16_t*)(WS(p) + OFF_WB) + WB_WIDX;
    const float* rstd_ = (const float*)(WS(p) + OFF_RSTD);
    const float4 qn4 = *(const float4*)(p.in[21] + l * 256 + lane * 4);
    const float2 kvn2 = *(const float2*)(p.in[22] + l * 128 + lane * 2);
    const float inw = p.in[27][l * 64 + lane], inb = p.in[28][l * 64 + lane];
    uint4 ww[8][2];
#pragma unroll
    for (int j = 0; j < 8; ++j) { ww[j][0] = *(const uint4*)(wwidx + (size_t)j * DM + lane * 16); ww[j][1] = *(const uint4*)(wwidx + (size_t)j * DM + lane * 16 + 8); }
    struct In { uint2 cq; unsigned ckv; bf16_t kr0, kr1, kix; uint4 h0, h1; float rs, c, s; };
    auto load = [&](int n) {
        In r;
        const bf16_t* row = pm + (size_t)n * PM_LD;
        const int t = n % TS;
        r.cq = *(const uint2*)(row + PM_CQ + lane * 4);
        r.ckv = *(const unsigned*)(row + PM_CKV + lane * 2);
        r.kr0 = row[PM_KROPE + (lane & 15)]; r.kr1 = row[PM_KROPE + 16 + (lane & 15)];
        r.kix = row[PM_KIDX + lane];
        r.h0 = *(const uint4*)(hrow + (size_t)n * DM + lane * 16); r.h1 = *(const uint4*)(hrow + (size_t)n * DM + lane * 16 + 8);
        r.rs = rstd_[n];
        r.c = ctab[t * 16 + (lane & 15)]; r.s = stab[t * 16 + (lane & 15)];
        return r;
    };
    In cur = load(wave < NT ? wave : 0);
    for (int n = wave; n < NT; n += nw) {
        const In x = cur;
        if (n + nw < NT) cur = load(n + nw);
        {
            const float v0 = __uint_as_float(x.cq.x << 16), v1 = __uint_as_float(x.cq.x & 0xFFFF0000u), v2 = __uint_as_float(x.cq.y << 16), v3 = __uint_as_float(x.cq.y & 0xFFFF0000u);
            const float ss = wave_sum_fast(v0 * v0 + v1 * v1 + v2 * v2 + v3 * v3);
            const float rs = rsqrtf(ss * (1.0f / 256.0f) + 1e-6f);
            *(uint2*)(cqn + (size_t)n * 256 + lane * 4) = pack4(v0 * rs * qn4.x, v1 * rs * qn4.y, v2 * rs * qn4.z, v3 * rs * qn4.w);
        }
        {
            const float v0 = __uint_as_float(x.ckv << 16), v1 = __uint_as_float(x.ckv & 0xFFFF0000u);
            const float ss = wave_sum_fast(v0 * v0 + v1 * v1);
            const float rs = rsqrtf(ss * (1.0f / 128.0f) + 1e-6f);
            *(unsigned*)(kv + (size_t)n * 160 + lane * 2) = pk2(v0 * rs * kvn2.x, v1 * rs * kvn2.y);
        }
        if (lane < 16) {
            const float x1 = bf2f(x.kr0), x2 = bf2f(x.kr1);
            kv[(size_t)n * 160 + 128 + lane] = f2bf(x1 * x.c - x2 * x.s);
            kv[(size_t)n * 160 + 144 + lane] = f2bf(x2 * x.c + x1 * x.s);
        }
        {
            const float xv = bf2f(x.kix);
            const float mu = wave_sum_fast(xv) * (1.0f / 64.0f);
            const float d = xv - mu;
            const float var = wave_sum_fast(d * d) * (1.0f / 64.0f);
            const float y = d * rsqrtf(var + 1e-6f) * inw + inb;
            const float yo = __shfl_xor(y, 16);
            float o = y;
            if (lane < 32) o = (lane < 16) ? (y * x.c - yo * x.s) : (y * x.c + yo * x.s);
            kidx[(size_t)n * 64 + lane] = f2bf(o);
        }
        {
            const uint4 hv0 = x.h0, hv1 = x.h1;
            float hx[16];
            hx[0] = __uint_as_float(hv0.x << 16); hx[1] = __uint_as_float(hv0.x & 0xFFFF0000u); hx[2] = __uint_as_float(hv0.y << 16); hx[3] = __uint_as_float(hv0.y & 0xFFFF0000u);
            hx[4] = __uint_as_float(hv0.z << 16); hx[5] = __uint_as_float(hv0.z & 0xFFFF0000u); hx[6] = __uint_as_float(hv0.w << 16); hx[7] = __uint_as_float(hv0.w & 0xFFFF0000u);
            hx[8] = __uint_as_float(hv1.x << 16); hx[9] = __uint_as_float(hv1.x & 0xFFFF0000u); hx[10] = __uint_as_float(hv1.y << 16); hx[11] = __uint_as_float(hv1.y & 0xFFFF0000u);
            hx[12] = __uint_as_float(hv1.z << 16); hx[13] = __uint_as_float(hv1.z & 0xFFFF0000u); hx[14] = __uint_as_float(hv1.w << 16); hx[15] = __uint_as_float(hv1.w & 0xFFFF0000u);
            float myw = 0.f;
#pragma unroll
            for (int j = 0; j < 8; ++j) {
                const uint4 w0 = ww[j][0], w1 = ww[j][1];
                float d = hx[0] * __uint_as_float(w0.x << 16) + hx[1] * __uint_as_float(w0.x & 0xFFFF0000u) + hx[2] * __uint_as_float(w0.y << 16) + hx[3] * __uint_as_float(w0.y & 0xFFFF0000u)
                        + hx[4] * __uint_as_float(w0.z << 16) + hx[5] * __uint_as_float(w0.z & 0xFFFF0000u) + hx[6] * __uint_as_float(w0.w << 16) + hx[7] * __uint_as_float(w0.w & 0xFFFF0000u)
                        + hx[8] * __uint_as_float(w1.x << 16) + hx[9] * __uint_as_float(w1.x & 0xFFFF0000u) + hx[10] * __uint_as_float(w1.y << 16) + hx[11] * __uint_as_float(w1.y & 0xFFFF0000u)
                        + hx[12] * __uint_as_float(w1.z << 16) + hx[13] * __uint_as_float(w1.z & 0xFFFF0000u) + hx[14] * __uint_as_float(w1.w << 16) + hx[15] * __uint_as_float(w1.w & 0xFFFF0000u);
                d = wave_sum_fast(d);
                myw = (lane == j) ? d : myw;
            }
            if (lane < 8) whead[(size_t)n * 8 + lane] = myw * x.rs * 0.04419417382415922f;
        }
    }
}

typedef short s16x4 __attribute__((ext_vector_type(4)));
__device__ __forceinline__ unsigned f2h_bits(float f) { const _Float16 h = (_Float16)f; unsigned short u; __builtin_memcpy(&u, &h, 2); return u; }
template <bool IMPORT_SEL>
__device__ void phase_dsa(const Params& p, int l, unsigned char* lds, bf16_t* yc, const unsigned short* gsel, const int* gnsel, int tb, int te, int tstep) {
    unsigned short* s_sc = (unsigned short*)lds;
    bf16_t* s_qi = (bf16_t*)(lds + 66048);
    bf16_t* s_Q = (bf16_t*)lds;
    unsigned short* s_sel = (unsigned short*)(lds + 82432 + 65536);
    int* s_nsel = (int*)(lds + 82432 + 65536 + 8192);
    unsigned char* dob = OUTB(p);
    const bf16_t* cqn = (const bf16_t*)(dob + DO_CQN);
    const bf16_t* kv = (const bf16_t*)(dob + DO_KV);
    const bf16_t* kidx = (const bf16_t*)(dob + DO_KIDX);
    const float* whead = (const float*)(dob + DO_WHEAD);
    const float* ctab = (const float*)(WS(p) + OFF_ROPE);
    const float* stab = ctab + TS * 16;
    const bf16_t* wb = (const bf16_t*)(WS(p) + OFF_WB);
    const bf16_t* wqiT = wb + WB_QI;
    const bf16_t* wuqT = wb + WB_UQ;
    const bf16_t* wuk = wb + WB_UK;
    const bf16_t* wuvT = wb + WB_UV;
    const float scale = 0.10206207261596575f;
    const f32x4 z4 = {0.f, 0.f, 0.f, 0.f};
    bf16_t* gq = (obid() < QS_WS) ? (bf16_t*)(WS(p) + WS_END + (size_t)obid() * QS_BYTES) : (bf16_t*)(OUTB(p) + DO_END + (size_t)(obid() - QS_WS) * QS_BYTES);
    for (int pair = tb; pair < te; pair += tstep) {
        const int qt = 128 - (pair >> 2);
        const int t0 = qt * 16;
#pragma unroll 1
        for (int half = 0; half < 2; ++half) {
        const int tid = otid(), lane = tid & 63, wid = tid >> 6, fr = lane & 15, fq = lane >> 4;
        unsigned char* s_Vw = lds + 82432 + wid * 8192;
        bf16_t* s_qn = (bf16_t*)s_Vw;
        const int b = (pair & 3) * 2 + half;
        const size_t n0 = (size_t)b * TS + t0;
        {
            bf16x8 acq[8];
#pragma unroll
            for (int kk = 0; kk < 8; ++kk) acq[kk] = *(const bf16x8*)(cqn + (n0 + fr) * 256 + kk * 32 + fq * 8);
            f32x4 c[4] = {z4, z4, z4, z4};
#pragma unroll
            for (int kb = 0; kb < 8; kb += 4) {
                bf16x8 bf[4][4];
#pragma unroll
                for (int k4 = 0; k4 < 4; ++k4)
#pragma unroll
                    for (int nt = 0; nt < 4; ++nt) bf[k4][nt] = *(const bf16x8*)(wqiT + (size_t)(wid * 64 + nt * 16 + fr) * 256 + (kb + k4) * 32 + fq * 8);
#pragma unroll
                for (int k4 = 0; k4 < 4; ++k4)
#pragma unroll
                    for (int nt = 0; nt < 4; ++nt) c[nt] = __builtin_amdgcn_mfma_f32_16x16x32_bf16(acq[kb + k4], bf[k4][nt], c[nt], 0, 0, 0);
            }
#pragma unroll
            for (int j = 0; j < 4; ++j) {
                const int t = t0 + fq * 4 + j;
                const float cs = ctab[t * 16 + fr], sn = stab[t * 16 + fr];
                const float x1 = c[0][j], x2 = c[1][j];
                c[0][j] = x1 * cs - x2 * sn; c[1][j] = x2 * cs + x1 * sn;
            }
#pragma unroll
            for (int nt = 0; nt < 4; ++nt)
#pragma unroll
                for (int j = 0; j < 4; ++j) s_qi[(fq * 4 + j) * 512 + wid * 64 + nt * 16 + fr] = f2bf(c[nt][j]);
        }
        __syncthreads();
        if (!IMPORT_SEL) {
            bf16x8 aq[8][2];
#pragma unroll
            for (int h = 0; h < 8; ++h)
#pragma unroll
                for (int ks = 0; ks < 2; ++ks) aq[h][ks] = *(const bf16x8*)(s_qi + fr * 512 + h * 64 + ks * 32 + fq * 8);
            float wh[4][8];
#pragma unroll
            for (int j = 0; j < 4; ++j) {
                const float4 w0 = *(const float4*)(whead + (n0 + fq * 4 + j) * 8), w1 = *(const float4*)(whead + (n0 + fq * 4 + j) * 8 + 4);
                wh[j][0] = w0.x; wh[j][1] = w0.y; wh[j][2] = w0.z; wh[j][3] = w0.w; wh[j][4] = w1.x; wh[j][5] = w1.y; wh[j][6] = w1.z; wh[j][7] = w1.w;
            }
            const int nkt = qt + 1;
            bf16x8 nb0 = {0, 0, 0, 0, 0, 0, 0, 0}, nb1 = nb0;
            if (wid < nkt) { const bf16_t* kr0 = kidx + ((size_t)b * TS + wid * 16 + fr) * 64 + fq * 8; nb0 = *(const bf16x8*)kr0; nb1 = *(const bf16x8*)(kr0 + 32); }
#pragma unroll 1
            for (int kt = wid; kt < nkt; kt += 8) {
                const bf16x8 bk0 = nb0, bk1 = nb1;
                if (kt + 8 < nkt) { const bf16_t* krn = kidx + ((size_t)b * TS + (kt + 8) * 16 + fr) * 64 + fq * 8; nb0 = *(const bf16x8*)krn; nb1 = *(const bf16x8*)(krn + 32); }
                float I[4] = {0.f, 0.f, 0.f, 0.f};
#pragma unroll
                for (int h = 0; h < 8; ++h) {
                    f32x4 a = __builtin_amdgcn_mfma_f32_16x16x32_bf16(aq[h][0], bk0, z4, 0, 0, 0);
                    a = __builtin_amdgcn_mfma_f32_16x16x32_bf16(aq[h][1], bk1, a, 0, 0, 0);
#pragma unroll
                    for (int j = 0; j < 4; ++j) I[j] += wh[j][h] * fmaxf(a[j], 0.f);
                }
#pragma unroll
                for (int j = 0; j < 4; ++j) s_sc[(fq * 4 + j) * 2064 + kt * 16 + fr] = (unsigned short)f2h_bits(I[j]);
            }
        }
        __syncthreads();
#pragma unroll 1
        for (int qi2 = 0; qi2 < 2; ++qi2) {
            const int q = wid + qi2 * 8;
            const int nadm = t0 + q + 1;
            unsigned short* sel = s_sel + q * 256;
            if (IMPORT_SEL) {
                const int ns = gnsel[n0 + q];
                for (int i = lane; i < ns; i += 64) sel[i] = gsel[(n0 + q) * 256 + i];
                if (lane == 0) s_nsel[q] = ns;
            } else if (nadm <= 256) {
                for (int i = lane; i < nadm; i += 64) sel[i] = (unsigned short)i;
                if (lane == 0) s_nsel[q] = nadm;
            } else {
                unsigned* hist = (unsigned*)(lds + 82432 + wid * 8192);
                const unsigned short* scq = s_sc + q * 2064;
                const int nch = (nadm + 63) >> 6;
                unsigned B1 = 0u; int na1 = 0, na2 = 0; unsigned T = 0u;
#pragma unroll 1
                for (int pass = 0; pass < 2; ++pass) {
                    *(uint4*)(hist + lane * 4) = make_uint4(0u, 0u, 0u, 0u);
#pragma unroll 1
                    for (int c0 = 0; c0 < nch; c0 += 8) {
                        unsigned kb[8];
#pragma unroll
                        for (int j = 0; j < 8; ++j) { const int s_ = (c0 + j) * 64 + lane; kb[j] = (s_ < nadm) ? (unsigned)scq[s_] : 0x10000u; }
#pragma unroll
                        for (int j = 0; j < 8; ++j) {
                            const unsigned u = kb[j];
                            const unsigned k = (u & 0x8000u) ? (~u & 0xFFFFu) : (u | 0x8000u);
                            const bool ok = (u < 0x10000u) && (pass == 0 || (k >> 8) == B1);
                            if (ok) atomicAdd(hist + (pass == 0 ? (k >> 8) : (k & 255u)), 1u);
                        }
                    }
                    const int need = 256 - na1;
                    const uint4 h4 = *(const uint4*)(hist + lane * 4);
                    const int sl = (int)(h4.x + h4.y + h4.z + h4.w);
                    int suf = sl;
#pragma unroll
                    for (int o = 1; o < 64; o <<= 1) { const int t_ = __shfl_down(suf, o); suf += (lane + o < 64) ? t_ : 0; }
                    const int above = suf - sl;
                    const bool mine = (suf >= need) && (above < need);
                    int a = above, bsel, asel;
                    if (a + (int)h4.w >= need) { bsel = 3; asel = a; }
                    else { a += (int)h4.w;
                        if (a + (int)h4.z >= need) { bsel = 2; asel = a; }
                        else { a += (int)h4.z;
                            if (a + (int)h4.y >= need) { bsel = 1; asel = a; }
                            else { a += (int)h4.y; bsel = 0; asel = a; } } }
                    const int src = __ffsll((long long)__ballot(mine)) - 1;
                    const unsigned bin = (unsigned)__shfl(lane * 4 + bsel, src); const int nab = __shfl(asel, src);
                    if (pass == 0) { B1 = bin; na1 = nab; } else { T = (B1 << 8) | bin; na2 = nab; }
                }
                {
                    const int rties = 256 - (na1 + na2);
                    int base = 0, ties = 0;
                    const unsigned long long ltmask = (1ull << lane) - 1ull;
#pragma unroll 1
                    for (int c0 = 0; c0 < nch; c0 += 4) {
                        unsigned kb[4];
#pragma unroll
                        for (int j = 0; j < 4; ++j) { const int s_ = (c0 + j) * 64 + lane; kb[j] = (s_ < nadm) ? (unsigned)scq[s_] : 0x10000u; }
#pragma unroll
                        for (int j = 0; j < 4; ++j) {
                            const int s_ = (c0 + j) * 64 + lane;
                            const unsigned u = kb[j];
                            const bool valid = u < 0x10000u;
                            const unsigned k = (u & 0x8000u) ? (~u & 0xFFFFu) : (u | 0x8000u);
                            const bool gt = valid && k > T, eq = valid && k == T;
                            const unsigned long long em = __ballot(eq);
                            const int myrank = ties + __popcll(em & ltmask);
                            const bool take = gt || (eq && myrank < rties);
                            const unsigned long long tm = __ballot(take);
                            const int pos = base + __popcll(tm & ltmask);
                            if (take && pos < 256) sel[pos] = (unsigned short)s_;
                            base += __popcll(tm); ties += __popcll(em);
                        }
                    }
                }
                if (lane == 0) s_nsel[q] = 256;
            }
        }
        __syncthreads();
        if (half == 0) {
            const size_t n0B = n0 + TS;
            bf16_t* s_qnB = s_qn + 1024;
#pragma unroll 1
            for (int hi = 0; hi < 2; ++hi) {
                const int hh = wid * 2 + hi;
                const bf16_t* caA = cqn + (n0 + fr) * 256 + fq * 8;
                const bf16_t* caB = cqn + (n0B + fr) * 256 + fq * 8;
                f32x4 cA[6] = {z4, z4, z4, z4, z4, z4}, cB[6] = {z4, z4, z4, z4, z4, z4};
#pragma unroll
                for (int kb = 0; kb < 8; kb += 2) {
                    bf16x8 bf[2][6], aA[2], aB[2];
#pragma unroll
                    for (int k2 = 0; k2 < 2; ++k2) {
                        aA[k2] = *(const bf16x8*)(caA + (kb + k2) * 32); aB[k2] = *(const bf16x8*)(caB + (kb + k2) * 32);
#pragma unroll
                        for (int nt = 0; nt < 6; ++nt) bf[k2][nt] = *(const bf16x8*)(wuqT + (size_t)(hh * 96 + nt * 16 + fr) * 256 + (kb + k2) * 32 + fq * 8);
                    }
#pragma unroll
                    for (int k2 = 0; k2 < 2; ++k2)
#pragma unroll
                        for (int nt = 0; nt < 6; ++nt) {
                            cA[nt] = __builtin_amdgcn_mfma_f32_16x16x32_bf16(aA[k2], bf[k2][nt], cA[nt], 0, 0, 0);
                            cB[nt] = __builtin_amdgcn_mfma_f32_16x16x32_bf16(aB[k2], bf[k2][nt], cB[nt], 0, 0, 0);
                        }
                }
#pragma unroll
                for (int j = 0; j < 4; ++j) {
                    const int q = fq * 4 + j, t = t0 + q;
                    const float cs = ctab[t * 16 + fr], sn = stab[t * 16 + fr];
                    s_Q[(q * 16 + hh) * 160 + 128 + fr] = f2bf(cA[4][j] * cs - cA[5][j] * sn);
                    s_Q[(q * 16 + hh) * 160 + 144 + fr] = f2bf(cA[5][j] * cs + cA[4][j] * sn);
                    gq[(q * 16 + hh) * 160 + 128 + fr] = f2bf(cB[4][j] * cs - cB[5][j] * sn);
                    gq[(q * 16 + hh) * 160 + 144 + fr] = f2bf(cB[5][j] * cs + cB[4][j] * sn);
#pragma unroll
                    for (int nt = 0; nt < 4; ++nt) { s_qn[q * 64 + nt * 16 + fr] = f2bf(cA[nt][j]); s_qnB[q * 64 + nt * 16 + fr] = f2bf(cB[nt][j]); }
                }
                __syncthreads();
                bf16x8 anA[2], anB[2];
#pragma unroll
                for (int ks = 0; ks < 2; ++ks) { anA[ks] = *(const bf16x8*)(s_qn + fr * 64 + ks * 32 + fq * 8); anB[ks] = *(const bf16x8*)(s_qnB + fr * 64 + ks * 32 + fq * 8); }
                bf16x8 bwk[8][2];
#pragma unroll
                for (int nt = 0; nt < 8; ++nt)
#pragma unroll
                    for (int ks = 0; ks < 2; ++ks) bwk[nt][ks] = *(const bf16x8*)(wuk + (size_t)(hh * 128 + nt * 16 + fr) * 64 + ks * 32 + fq * 8);
#pragma unroll
                for (int nt = 0; nt < 8; ++nt) {
                    f32x4 aA = z4, aB = z4;
#pragma unroll
                    for (int ks = 0; ks < 2; ++ks) {
                        aA = __builtin_amdgcn_mfma_f32_16x16x32_bf16(anA[ks], bwk[nt][ks], aA, 0, 0, 0);
                        aB = __builtin_amdgcn_mfma_f32_16x16x32_bf16(anB[ks], bwk[nt][ks], aB, 0, 0, 0);
                    }
#pragma unroll
                    for (int j = 0; j < 4; ++j) {
                        s_Q[((fq * 4 + j) * 16 + hh) * 160 + nt * 16 + fr] = f2bf(aA[j]);
                        gq[((fq * 4 + j) * 16 + hh) * 160 + nt * 16 + fr] = f2bf(aB[j]);
                    }
                }
                __syncthreads();
            }
        } else {
            for (int e = tid; e < QS_BYTES / 16; e += NTHR) ((uint4*)s_Q)[e] = ((const uint4*)gq)[e];
            __syncthreads();
        }
#pragma unroll 1
        for (int qi2 = 0; qi2 < 2; ++qi2) {
            const int q = wid + qi2 * 8;
            bf16x8 bq[5];
#pragma unroll
            for (int ks = 0; ks < 5; ++ks) bq[ks] = *(const bf16x8*)(s_Q + (q * 16 + fr) * 160 + ks * 32 + fq * 8);
            const int nsel = s_nsel[q];
            const unsigned short* sel = s_sel + q * 256;
            float m = -INFINITY, lsum = 0.f;
            f32x4 O[8] = {z4, z4, z4, z4, z4, z4, z4, z4};
            const int nchunk = (nsel + 31) >> 5;
            bf16x8 akn[2][5];
#pragma unroll
            for (int mt = 0; mt < 2; ++mt) {
                const int ki = mt * 16 + fr;
                const int sidx = sel[ki < nsel ? ki : 0];
                const bf16_t* krow = kv + ((size_t)b * TS + sidx) * 160 + fq * 8;
#pragma unroll
                for (int ks = 0; ks < 5; ++ks) akn[mt][ks] = *(const bf16x8*)(krow + ks * 32);
            }
#pragma unroll 1
            for (int ch = 0; ch < nchunk; ++ch) {
                bf16x8 ak[2][5];
#pragma unroll
                for (int mt = 0; mt < 2; ++mt)
#pragma unroll
                    for (int ks = 0; ks < 5; ++ks) ak[mt][ks] = akn[mt][ks];
                if (ch + 1 < nchunk) {
#pragma unroll
                    for (int mt = 0; mt < 2; ++mt) {
                        const int ki = (ch + 1) * 32 + mt * 16 + fr;
                        const int sidx = sel[ki < nsel ? ki : 0];
                        const bf16_t* krow = kv + ((size_t)b * TS + sidx) * 160 + fq * 8;
#pragma unroll
                        for (int ks = 0; ks < 5; ++ks) akn[mt][ks] = *(const bf16x8*)(krow + ks * 32);
                    }
                }
#pragma unroll
                for (int mt = 0; mt < 2; ++mt)
#pragma unroll
                    for (int ks = 0; ks < 4; ++ks) {
                        const int r = mt * 16 + fr;
                        *(bf16x8*)(s_Vw + r * 256 + (((ks * 2 + (fq >> 1)) ^ (r & 7)) * 32) + (fq & 1) * 16) = ak[mt][ks];
                    }
                f32x4 st[2] = {z4, z4};
#pragma unroll
                for (int mt = 0; mt < 2; ++mt)
#pragma unroll
                    for (int ks = 0; ks < 5; ++ks) st[mt] = __builtin_amdgcn_mfma_f32_16x16x32_bf16(ak[mt][ks], bq[ks], st[mt], 0, 0, 0);
                float sv[2][4]; float cmax = -INFINITY;
#pragma unroll
                for (int mt = 0; mt < 2; ++mt)
#pragma unroll
                    for (int j = 0; j < 4; ++j) {
                        const int ke = ch * 32 + mt * 16 + fq * 4 + j;
                        const float s_ = (ke < nsel) ? st[mt][j] * scale : -INFINITY;
                        sv[mt][j] = s_; cmax = fmaxf(cmax, s_);
                    }
                cmax = fmaxf(cmax, __shfl_xor(cmax, 16)); cmax = fmaxf(cmax, __shfl_xor(cmax, 32));
                const float mnew = fmaxf(m, cmax);
                const float alpha = __expf(m - mnew);
                float psum = 0.f;
#pragma unroll
                for (int mt = 0; mt < 2; ++mt)
#pragma unroll
                    for (int j = 0; j < 4; ++j) { const float pe = __expf(sv[mt][j] - mnew); sv[mt][j] = pe; psum += pe; }
                psum += __shfl_xor(psum, 16); psum += __shfl_xor(psum, 32);
                lsum = lsum * alpha + psum; m = mnew;
#pragma unroll
                for (int ct = 0; ct < 8; ++ct) O[ct] = O[ct] * alpha;
                bf16x8 pf;
#pragma unroll
                for (int mt = 0; mt < 2; ++mt)
#pragma unroll
                    for (int j = 0; j < 4; ++j) pf[mt * 4 + j] = (short)f2bf(sv[mt][j]);
                const int q_ = fr >> 2, p_ = fr & 3;
                const int r0 = fq * 4 + q_, r1 = 16 + r0;
#pragma unroll
                for (int ct = 0; ct < 8; ++ct) {
                    const s16x4 v0 = __builtin_amdgcn_ds_read_tr16_b64_v4i16((__attribute__((address_space(3))) s16x4*)(s_Vw + r0 * 256 + ((ct ^ (r0 & 7)) * 32) + p_ * 8));
                    const s16x4 v1 = __builtin_amdgcn_ds_read_tr16_b64_v4i16((__attribute__((address_space(3))) s16x4*)(s_Vw + r1 * 256 + ((ct ^ (r1 & 7)) * 32) + p_ * 8));
                    bf16x8 av; av[0] = v0[0]; av[1] = v0[1]; av[2] = v0[2]; av[3] = v0[3]; av[4] = v1[0]; av[5] = v1[1]; av[6] = v1[2]; av[7] = v1[3];
                    O[ct] = __builtin_amdgcn_mfma_f32_16x16x32_bf16(av, pf, O[ct], 0, 0, 0);
                }
            }
            const float inv = 1.0f / lsum;
#pragma unroll
            for (int ct = 0; ct < 8; ++ct)
#pragma unroll
                for (int j = 0; j < 4; ++j) s_Q[(q * 16 + fr) * 160 + ct * 16 + fq * 4 + j] = f2bf(O[ct][j] * inv);
        }
        __syncthreads();
#pragma unroll 1
        for (int hi = 0; hi < 2; ++hi) {
            const int hh = wid * 2 + hi;
            bf16x8 ao[4];
#pragma unroll
            for (int ks = 0; ks < 4; ++ks) ao[ks] = *(const bf16x8*)(s_Q + (fr * 16 + hh) * 160 + ks * 32 + fq * 8);
#pragma unroll
            for (int nt = 0; nt < 4; ++nt) {
                f32x4 a = z4;
#pragma unroll
                for (int ks = 0; ks < 4; ++ks)
                    a = __builtin_amdgcn_mfma_f32_16x16x32_bf16(ao[ks], *(const bf16x8*)(wuvT + (size_t)(hh * 64 + nt * 16 + fr) * 128 + ks * 32 + fq * 8), a, 0, 0, 0);
#pragma unroll
                for (int j = 0; j < 4; ++j) yc[(n0 + fq * 4 + j) * 1024 + hh * 64 + nt * 16 + fr] = f2bf(a[j]);
            }
        }
        __syncthreads();
        }
    }
}


__device__ void phase_lr_prep(const Params& p, int l) {
    const int lane = otid() & 63;
    const int wave = (obid() * NTHR + otid()) >> 6, nw = gridDim.x * NTHR / 64;
    const bf16_t* pm = (const bf16_t*)(WS(p) + OFF_PMISC);
    bf16_t* alr = (bf16_t*)(OUTB(p) + DO_ALR);
    const float4 mu4 = *(const float4*)(p.in[4] + (size_t)l * 3328 + 3072 + lane * 4);
    const float4 vm4 = *(const float4*)(p.in[18] + (lane & 7) * 4);
    struct In { uint2 c0, p0, c1, p1; };
    auto load = [&](int n) {
        In r;
        const bf16_t* row = pm + (size_t)n * PM_LD;
        const bool hp = (n % TS) > 0;
        r.c0 = *(const uint2*)(row + lane * 4);
        r.p0 = hp ? *(const uint2*)(row - PM_LD + lane * 4) : make_uint2(0u, 0u);
        r.c1 = make_uint2(0u, 0u); r.p1 = r.c1;
        if (lane < 8) { r.c1 = *(const uint2*)(row + 256 + lane * 4); if (hp) r.p1 = *(const uint2*)(row - PM_LD + 256 + lane * 4); }
        return r;
    };
    auto mix4 = [&](const uint2 c, const uint2 q, const float4 m, float (&o)[4]) {
        const float c0 = __uint_as_float(c.x << 16), c1 = __uint_as_float(c.x & 0xFFFF0000u), c2 = __uint_as_float(c.y << 16), c3 = __uint_as_float(c.y & 0xFFFF0000u);
        const float q0 = __uint_as_float(q.x << 16), q1 = __uint_as_float(q.x & 0xFFFF0000u), q2 = __uint_as_float(q.y << 16), q3 = __uint_as_float(q.y & 0xFFFF0000u);
        o[0] = c0 + (q0 - c0) * m.x; o[1] = c1 + (q1 - c1) * m.y; o[2] = c2 + (q2 - c2) * m.z; o[3] = c3 + (q3 - c3) * m.w;
    };
    In cur = load(wave < NT ? wave : 0);
    for (int n = wave; n < NT; n += nw) {
        const In x = cur;
        if (n + nw < NT) cur = load(n + nw);
        float o[4];
        mix4(x.c0, x.p0, mu4, o);
        if (lane < 16) { o[0] = tanhf(o[0]); o[1] = tanhf(o[1]); o[2] = tanhf(o[2]); o[3] = tanhf(o[3]); }
        else if (lane >= 32) { o[0] = sigmoidf_(o[0]); o[1] = sigmoidf_(o[1]); o[2] = sigmoidf_(o[2]); o[3] = sigmoidf_(o[3]); }
        *(uint2*)(alr + (size_t)n * 288 + lane * 4) = pack4(o[0], o[1], o[2], o[3]);
        if (lane < 8) {
            mix4(x.c1, x.p1, vm4, o);
            *(uint2*)(alr + (size_t)n * 288 + 256 + lane * 4) = pack4(o[0], o[1], o[2], o[3]);
        }
    }
}

typedef short sh4 __attribute__((ext_vector_type(4)));
__device__ __forceinline__ sh4 pk4v(const f32x4& v) { const uint2 u = pack4(v[0], v[1], v[2], v[3]); sh4 r; __builtin_memcpy(&r, &u, 8); return r; }
__device__ __forceinline__ bf16x8 cat8(const sh4& a, const sh4& b) { bf16x8 r; r[0] = a[0]; r[1] = a[1]; r[2] = a[2]; r[3] = a[3]; r[4] = b[0]; r[5] = b[1]; r[6] = b[2]; r[7] = b[3]; return r; }
#define MF32(a, b, c) __builtin_amdgcn_mfma_f32_16x16x32_bf16(a, b, c, 0, 0, 0)
#define MF16(a, b, c) MF32(cat8(a, sh4{0, 0, 0, 0}), cat8(b, sh4{0, 0, 0, 0}), c)
constexpr int SC_LT = 72;
constexpr int SC_LS = 36;
constexpr int SC_TC = 32;
constexpr int SC_ROWB = 1088;
__device__ __forceinline__ const unsigned char* scan_piece_src(const Params& p, int l, int b, int hc, int t0, int pi, bool& ok) {
    const int tau = pi / 68, seg = pi - tau * 68;
    const int t = t0 + tau;
    ok = (t < TS) && (tau < SC_TC);
    const size_t n = (size_t)b * TS + t;
    const unsigned char* ws = WS(p);
    if (seg < 8) return ws + OFF_PR + (n * 1024 + hc) * 2 + seg * 16;
    if (seg < 16) return ws + OFF_PK + (n * 1024 + hc) * 2 + (seg - 8) * 16;
    if (seg < 24) return ws + OFF_PV + (n * 1024 + hc) * 2 + (seg - 16) * 16;
    if (seg < 60) return OUTB(p) + DO_ALR + (n * 288) * 2 + (seg - 24) * 16;
    ok = ok && (l > 0);
    return ws + OFF_VFIRST + (n * 1024 + hc) * 2 + (seg - 60) * 16;
}
__device__ void phase_scan5(const Params& p, int l, unsigned char* lds, int blk) {
    const int tid = otid(), lane = tid & 63, wid = tid >> 6, fr = lane & 15, fq = lane >> 4;
    const int b = blk >> 4, hh = blk & 15, hc = hh * 64;
    float* s_r = (float*)lds;
    float* s_w = s_r + 2048;
    float* s_k = s_w + 2048;
    float* s_v = s_k + 2048;
    float* s_a = s_v + 2048;
    float* s_b = s_a + 2048;
    float* s_g = s_b + 2048;
    float* s_o = s_g + 2048;
    bf16_t* o_at = (bf16_t*)(s_o + 2048);
    bf16_t* o_rt = o_at + 32 * SC_LT;
    bf16_t* o_bt = o_rt + 32 * SC_LT;
    bf16_t* o_kt = o_bt + 32 * SC_LT;
    bf16_t* o_bT = o_kt + 32 * SC_LT;
    bf16_t* o_kT = o_bT + 64 * SC_LS;
    bf16_t* o_vT = o_kT + 64 * SC_LS;
    float* s_gc = (float*)(o_vT + 64 * SC_LS);
    unsigned char* raw = (unsigned char*)(s_gc + 128);
    float* prevb = (float*)(raw + 32 * SC_ROWB);
    unsigned* prevr = (unsigned*)prevb;
    float* cst = prevb + 960;
    float* s_gB = s_r;
    float* s_oB = s_k;
    float* s_vB = cst + 992;
    float* s_bs2 = s_vB + 2048;
    const float* mu = p.in[4] + (size_t)l * 3328;
    for (int e = tid; e < 480; e += NTHR) {
        float v;
        if (e < 192) v = mu[(e >> 6) * 1024 + hc + (e & 63)];
        else if (e < 448) v = mu[3072 + (e - 192)];
        else v = p.in[18][e - 448];
        cst[e] = v;
    }
    if (tid < 64) {
        cst[480 + tid] = p.in[7][l * 1024 + hc + tid];
        cst[544 + tid] = p.in[9][l * 1024 + hc + tid];
        cst[608 + tid] = p.in[12][l * 1024 + hc + tid];
        cst[672 + tid] = p.in[13][l * 1024 + hc + tid];
        cst[736 + tid] = p.in[14][l * 1024 + hc + tid];
        cst[800 + tid] = p.in[15][l * 1024 + hc + tid];
        cst[864 + tid] = p.in[16][l * 1024 + hc + tid];
        cst[928 + tid] = p.in[19][hc + tid];
    }
    const int mm = wid >> 1, ntb = (wid & 1) * 2;
    const int nks = (mm == 2) ? 4 : (mm == 3 ? 1 : 2);
    bf16x8 Bw[2][4];
    {
        const float* wsrc = (mm == 0) ? p.in[8] + (size_t)l * 64 * 1024 : (mm == 1) ? p.in[10] + (size_t)l * 64 * 1024 : (mm == 2) ? p.in[11] + (size_t)l * 128 * 1024 : p.in[20];
#pragma unroll
        for (int n2 = 0; n2 < 2; ++n2)
#pragma unroll
            for (int ks = 0; ks < 4; ++ks) {
                bf16x8 f;
#pragma unroll
                for (int j = 0; j < 8; ++j) {
                    const bool okw = ks < nks && (mm < 3 || l > 0);
                    const float v = wsrc[(size_t)(okw ? (ks * 32 + fq * 8 + j) : 0) * 1024 + hc + (ntb + n2) * 16 + fr];
                    f[j] = (short)f2bf(okw ? v : 0.f);
                }
                Bw[n2][ks] = f;
            }
    }
    const f32x4 z4 = {0.f, 0.f, 0.f, 0.f};
    f32x4 S[4] = {z4, z4, z4, z4};
    sh4 Lf;
#pragma unroll
    for (int j = 0; j < 4; ++j) Lf[j] = (fq * 4 + j <= fr) ? (short)0x3F80 : (short)0;
    bf16_t* Pr = (bf16_t*)(WS(p) + OFF_PR);
    bf16_t* vfirst = (bf16_t*)(WS(p) + OFF_VFIRST);
    const unsigned char* psrc[5]; int pstep[5], ptau[5]; bool pval[5];
#pragma unroll
    for (int k = 0; k < 5; ++k) {
        const int pi = tid + k * NTHR;
        bool ok = false;
        psrc[k] = scan_piece_src(p, l, b, hc, 0, pi < SC_TC * 68 ? pi : 0, ok);
        const int tau = (pi < SC_TC * 68 ? pi : 0) / 68, seg = (pi < SC_TC * 68 ? pi : 0) - tau * 68;
        ptau[k] = tau;
        pstep[k] = SC_TC * ((seg >= 24 && seg < 60) ? 576 : 2048);
        pval[k] = (pi < SC_TC * 68) && !(seg >= 60 && l == 0);
    }
    uint4 pre[5];
#pragma unroll
    for (int k = 0; k < 5; ++k) { pre[k] = make_uint4(0, 0, 0, 0); if (pval[k] && ptau[k] < TS) pre[k] = *(const uint4*)psrc[k]; }
    __syncthreads();
    auto stepE = [&](int tau, int c4, const float* so, const float* sv, const float* sgp, const float* sb, int t0e, int nve) {
        const int e = tau * 64 + c4;
        const size_t n = (size_t)b * TS + t0e + tau;
        const float4 o4 = *(const float4*)(so + e), v4_ = *(const float4*)(sv + e), g4_ = *(const float4*)(sgp + e);
        const float4 clw = *(const float4*)(cst + 800 + c4), clb = *(const float4*)(cst + 864 + c4);
        const float bsum = sb[tau];
        const float m_ = row16_sum((o4.x + o4.y) + (o4.z + o4.w)) * (1.0f / 64.0f);
        const float d0 = o4.x - m_, d1 = o4.y - m_, d2 = o4.z - m_, d3 = o4.w - m_;
        const float var = row16_sum(d0 * d0 + d1 * d1 + d2 * d2 + d3 * d3) * (1.0f / 64.0f);
        const float rs = rsqrtf(var + 64e-5f);
        const float y0 = (d0 * rs * clw.x + clb.x + bsum * v4_.x) * g4_.x, y1 = (d1 * rs * clw.y + clb.y + bsum * v4_.y) * g4_.y;
        const float y2 = (d2 * rs * clw.z + clb.z + bsum * v4_.z) * g4_.z, y3 = (d3 * rs * clw.w + clb.w + bsum * v4_.w) * g4_.w;
        if (tau < nve) *(uint2*)(Pr + n * 1024 + hc + c4) = pack4(y0, y1, y2, y3);
    };
#pragma unroll 1
    for (int t0 = 0, ch = 0; t0 < TS; t0 += SC_TC, ++ch) {
        const int nval = (TS - t0 < SC_TC) ? (TS - t0) : SC_TC;
        const bool par = (ch & 1) != 0;
        float* g_c = par ? s_gB : s_g; float* o_c = par ? s_oB : s_o; float* v_c = par ? s_vB : s_v; float* bs_c = s_bs2 + (par ? 32 : 0);
        float* g_p = par ? s_g : s_gB; float* o_p = par ? s_o : s_oB; float* v_p = par ? s_v : s_vB; float* bs_p = s_bs2 + (par ? 0 : 32);
#pragma unroll
        for (int k = 0; k < 5; ++k) { const int pi = tid + k * NTHR; if (pi < SC_TC * 68) *(uint4*)(raw + pi * 16) = pre[k]; }
        lds_barrier();
#pragma unroll
        for (int k = 0; k < 5; ++k) {
            pre[k] = make_uint4(0, 0, 0, 0);
            if (pval[k] && t0 + SC_TC + ptau[k] < TS) pre[k] = *(const uint4*)(psrc[k] + (size_t)(ch + 1) * pstep[k]);
        }
        if (mm < 3 || l > 0) {
            const unsigned char* Ab = raw + ((mm == 0) ? 384 : (mm == 1) ? 512 : (mm == 2) ? 640 : 896);
            float* dst = (mm == 0) ? s_w : (mm == 1) ? s_a : (mm == 2) ? g_c : o_c;
#pragma unroll
            for (int m = 0; m < 2; ++m) {
                f32x4 acc0 = {0.f, 0.f, 0.f, 0.f}, acc1 = {0.f, 0.f, 0.f, 0.f};
#pragma unroll
                for (int ks = 0; ks < 4; ++ks) {
                    if (ks < nks) {
                        const bf16x8 a = *(const bf16x8*)(Ab + (m * 16 + fr) * SC_ROWB + ks * 64 + fq * 16);
                        acc0 = __builtin_amdgcn_mfma_f32_16x16x32_bf16(a, Bw[0][ks], acc0, 0, 0, 0);
                        acc1 = __builtin_amdgcn_mfma_f32_16x16x32_bf16(a, Bw[1][ks], acc1, 0, 0, 0);
                    }
                }
                if (mm == 0) {
                    const float cw0 = cst[480 + ntb * 16 + fr], cw1 = cst[480 + (ntb + 1) * 16 + fr];
                    f32x4 l0, l1, r0, r1;
#pragma unroll
                    for (int j = 0; j < 4; ++j) { l0[j] = -0.6065306597126334f * fast_sigmoid(acc0[j] + cw0); l1[j] = -0.6065306597126334f * fast_sigmoid(acc1[j] + cw1); }
                    const uint2 h0 = pack4(l0[0], l0[1], l0[2], l0[3]), h1 = pack4(l1[0], l1[1], l1[2], l1[3]);
                    r0[0] = l0[0] - __uint_as_float(h0.x << 16); r0[1] = l0[1] - __uint_as_float(h0.x & 0xFFFF0000u); r0[2] = l0[2] - __uint_as_float(h0.y << 16); r0[3] = l0[3] - __uint_as_float(h0.y & 0xFFFF0000u);
                    r1[0] = l1[0] - __uint_as_float(h1.x << 16); r1[1] = l1[1] - __uint_as_float(h1.x & 0xFFFF0000u); r1[2] = l1[2] - __uint_as_float(h1.y << 16); r1[3] = l1[3] - __uint_as_float(h1.y & 0xFFFF0000u);
                    sh4 hh0, hh1; __builtin_memcpy(&hh0, &h0, 8); __builtin_memcpy(&hh1, &h1, 8);
                    f32x4 c0 = MF16(Lf, pk4v(r0), z4), c1 = MF16(Lf, pk4v(r1), z4);
                    c0 = MF16(Lf, hh0, c0); c1 = MF16(Lf, hh1, c1);
#pragma unroll
                    for (int j = 0; j < 4; ++j) {
                        const int eo = (m * 16 + fq * 4 + j) * 64 + ntb * 16 + fr;
                        s_w[eo] = c0[j]; s_w[eo + 16] = c1[j];
                        s_b[eo] = l0[j]; s_b[eo + 16] = l1[j];
                    }
                } else {
#pragma unroll
                    for (int j = 0; j < 4; ++j) {
                        dst[(m * 16 + fq * 4 + j) * 64 + ntb * 16 + fr] = acc0[j];
                        dst[(m * 16 + fq * 4 + j) * 64 + (ntb + 1) * 16 + fr] = acc1[j];
                    }
                }
            }
        }
        lds_barrier();
        {
            const int tau = tid >> 4, c4 = (tid & 15) * 4, e = tau * 64 + c4, t = t0 + tau;
            const size_t n = (size_t)b * TS + t;
            const float4 cum4 = *(const float4*)(s_w + e), lw4 = *(const float4*)(s_b + e), xa4 = *(const float4*)(s_a + e);
            const float4 ca = *(const float4*)(cst + 544 + c4), ckk = *(const float4*)(cst + 608 + c4), cka = *(const float4*)(cst + 672 + c4), crk = *(const float4*)(cst + 736 + c4);
            const float cum[4] = {cum4.x, cum4.y, cum4.z, cum4.w}, lw[4] = {lw4.x, lw4.y, lw4.z, lw4.w};
            const float xa[4] = {xa4.x + ca.x, xa4.y + ca.y, xa4.z + ca.z, xa4.w + ca.w};
            const float kkc[4] = {ckk.x, ckk.y, ckk.z, ckk.w}, kac[4] = {cka.x, cka.y, cka.z, cka.w};
            float rr[4], kr[4], vv[4];
            {
                const unsigned char* rc = raw + tau * SC_ROWB + c4 * 2;
                const uint2 cr = *(const uint2*)rc, ck = *(const uint2*)(rc + 128), cv = *(const uint2*)(rc + 256);
                uint2 qr = make_uint2(0u, 0u), qk = qr, qv = qr;
                if (tau > 0) { qr = *(const uint2*)(rc - SC_ROWB); qk = *(const uint2*)(rc - SC_ROWB + 128); qv = *(const uint2*)(rc - SC_ROWB + 256); }
                else if (t0 > 0) { const unsigned* pvr = prevr + ((ch + 1) & 1) * 96 + (c4 >> 1); qr = *(const uint2*)pvr; qk = *(const uint2*)(pvr + 32); qv = *(const uint2*)(pvr + 64); }
                if (tau == SC_TC - 1) { unsigned* pwr = prevr + (ch & 1) * 96 + (c4 >> 1); *(uint2*)pwr = cr; *(uint2*)(pwr + 32) = ck; *(uint2*)(pwr + 64) = cv; }
                const float4 mr = *(const float4*)(cst + c4), mk = *(const float4*)(cst + 64 + c4), mv = *(const float4*)(cst + 128 + c4);
                const float c_[12] = {__uint_as_float(cr.x << 16), __uint_as_float(cr.x & 0xFFFF0000u), __uint_as_float(cr.y << 16), __uint_as_float(cr.y & 0xFFFF0000u),
                                      __uint_as_float(ck.x << 16), __uint_as_float(ck.x & 0xFFFF0000u), __uint_as_float(ck.y << 16), __uint_as_float(ck.y & 0xFFFF0000u),
                                      __uint_as_float(cv.x << 16), __uint_as_float(cv.x & 0xFFFF0000u), __uint_as_float(cv.y << 16), __uint_as_float(cv.y & 0xFFFF0000u)};
                const float q_[12] = {__uint_as_float(qr.x << 16), __uint_as_float(qr.x & 0xFFFF0000u), __uint_as_float(qr.y << 16), __uint_as_float(qr.y & 0xFFFF0000u),
                                      __uint_as_float(qk.x << 16), __uint_as_float(qk.x & 0xFFFF0000u), __uint_as_float(qk.y << 16), __uint_as_float(qk.y & 0xFFFF0000u),
                                      __uint_as_float(qv.x << 16), __uint_as_float(qv.x & 0xFFFF0000u), __uint_as_float(qv.y << 16), __uint_as_float(qv.y & 0xFFFF0000u)};
                const float m_[12] = {mr.x, mr.y, mr.z, mr.w, mk.x, mk.y, mk.z, mk.w, mv.x, mv.y, mv.z, mv.w};
#pragma unroll
                for (int j = 0; j < 4; ++j) { rr[j] = c_[j] + (q_[j] - c_[j]) * m_[j]; kr[j] = c_[4 + j] + (q_[4 + j] - c_[4 + j]) * m_[4 + j]; vv[j] = c_[8 + j] + (q_[8 + j] - c_[8 + j]) * m_[8 + j]; }
            }
            if (l > 0) {
                const float4 xv4 = *(const float4*)(o_c + e), cv = *(const float4*)(cst + 928 + c4);
                const uint2 vfu = *(const uint2*)(raw + tau * SC_ROWB + 960 + c4 * 2);
                const float vf[4] = {__uint_as_float(vfu.x << 16), __uint_as_float(vfu.x & 0xFFFF0000u), __uint_as_float(vfu.y << 16), __uint_as_float(vfu.y & 0xFFFF0000u)};
                const float xv[4] = {xv4.x + cv.x, xv4.y + cv.y, xv4.z + cv.z, xv4.w + cv.w};
#pragma unroll
                for (int j = 0; j < 4; ++j) vv[j] = vv[j] + (vf[j] - vv[j]) * fast_sigmoid(xv[j]);
            } else if (t < TS) {
                *(uint2*)(vfirst + n * 1024 + hc + c4) = pack4(vv[0], vv[1], vv[2], vv[3]);
            }
            float av[4], kkv[4], ginc[4], gexc[4], ginv[4]; float ss = 0.f;
#pragma unroll
            for (int j = 0; j < 4; ++j) {
                ginc[j] = __expf(cum[j]); gexc[j] = __expf(cum[j] - lw[j]); ginv[j] = __expf(-cum[j]);
                av[j] = fast_sigmoid(xa[j]);
                kkv[j] = kr[j] * kkc[j];
                ss += kkv[j] * kkv[j];
            }
            float kk[4], kt[4];
#pragma unroll
            for (int j = 0; j < 4; ++j) kt[j] = kr[j] * (1.0f + (av[j] - 1.0f) * kac[j]);
            float bsum = rr[0] * kt[0] * crk.x + rr[1] * kt[1] * crk.y + rr[2] * kt[2] * crk.z + rr[3] * kt[3] * crk.w;
            float du0 = 0.f, du1 = 0.f;
            row16_sum4(ss, bsum, du0, du1);
            if ((tid & 15) == 0) bs_c[tau] = bsum;
            const float rn = rsqrtf(fmaxf(ss, 1e-24f));
#pragma unroll
            for (int j = 0; j < 4; ++j) kk[j] = kkv[j] * rn;
            const uint2 pa = pack4(-kk[0] * gexc[0], -kk[1] * gexc[1], -kk[2] * gexc[2], -kk[3] * gexc[3]);
            const uint2 pr = pack4(rr[0] * ginc[0], rr[1] * ginc[1], rr[2] * ginc[2], rr[3] * ginc[3]);
            const uint2 pb = pack4(kk[0] * av[0] * ginv[0], kk[1] * av[1] * ginv[1], kk[2] * av[2] * ginv[2], kk[3] * av[3] * ginv[3]);
            const uint2 pk = pack4(kt[0] * ginv[0], kt[1] * ginv[1], kt[2] * ginv[2], kt[3] * ginv[3]);
            const uint2 pv = pack4(vv[0], vv[1], vv[2], vv[3]);
            *(uint2*)(o_at + tau * SC_LT + c4) = pa;
            *(uint2*)(o_rt + tau * SC_LT + c4) = pr;
            *(uint2*)(o_bt + tau * SC_LT + c4) = pb;
            *(uint2*)(o_kt + tau * SC_LT + c4) = pk;
            o_bT[(c4 + 0) * SC_LS + tau] = (bf16_t)(pb.x & 0xFFFFu); o_bT[(c4 + 1) * SC_LS + tau] = (bf16_t)(pb.x >> 16); o_bT[(c4 + 2) * SC_LS + tau] = (bf16_t)(pb.y & 0xFFFFu); o_bT[(c4 + 3) * SC_LS + tau] = (bf16_t)(pb.y >> 16);
            o_kT[(c4 + 0) * SC_LS + tau] = (bf16_t)(pk.x & 0xFFFFu); o_kT[(c4 + 1) * SC_LS + tau] = (bf16_t)(pk.x >> 16); o_kT[(c4 + 2) * SC_LS + tau] = (bf16_t)(pk.y & 0xFFFFu); o_kT[(c4 + 3) * SC_LS + tau] = (bf16_t)(pk.y >> 16);
            o_vT[(c4 + 0) * SC_LS + tau] = (bf16_t)(pv.x & 0xFFFFu); o_vT[(c4 + 1) * SC_LS + tau] = (bf16_t)(pv.x >> 16); o_vT[(c4 + 2) * SC_LS + tau] = (bf16_t)(pv.y & 0xFFFFu); o_vT[(c4 + 3) * SC_LS + tau] = (bf16_t)(pv.y >> 16);
            if ((tau & 15) == 15) *(float4*)(s_gc + (tau >> 4) * 64 + c4) = make_float4(ginc[0], ginc[1], ginc[2], ginc[3]);
            *(float4*)(v_c + e) = make_float4(vv[0], vv[1], vv[2], vv[3]);
        }
        lds_barrier();
        if (wid < 4) {
#pragma unroll 1
            for (int sc = 0; sc < 2; ++sc) {
                if (sc * 16 < nval) {
                    const bf16_t* ar = o_at + (sc * 16 + fr) * SC_LT;
                    const bf16_t* rr_ = o_rt + (sc * 16 + fr) * SC_LT;
                    const bf16_t* br = o_bt + (sc * 16 + fr) * SC_LT;
                    const bf16_t* kr_ = o_kt + (sc * 16 + fr) * SC_LT;
                    const bf16x8 fa0 = *(const bf16x8*)(ar + fq * 8), fa1 = *(const bf16x8*)(ar + 32 + fq * 8);
                    const bf16x8 fb0 = *(const bf16x8*)(br + fq * 8), fb1 = *(const bf16x8*)(br + 32 + fq * 8);
                    const bf16x8 fk0 = *(const bf16x8*)(kr_ + fq * 8), fk1 = *(const bf16x8*)(kr_ + 32 + fq * 8);
                    const bf16x8 fr0 = *(const bf16x8*)(rr_ + fq * 8), fr1 = *(const bf16x8*)(rr_ + 32 + fq * 8);
                    f32x4 nA = MF32(fb0, fa0, z4); nA = MF32(fb1, fa1, nA);
                    f32x4 nB = MF32(fa0, fb0, z4); nB = MF32(fa1, fb1, nB);
                    f32x4 mak = MF32(fk0, fa0, z4); mak = MF32(fk1, fa1, mak);
                    f32x4 mbr = MF32(fb0, fr0, z4); mbr = MF32(fb1, fr1, mbr);
                    f32x4 mkr = MF32(fk0, fr0, z4); mkr = MF32(fk1, fr1, mkr);
#pragma unroll
                    for (int j = 0; j < 4; ++j) {
                        const int s_ = fq * 4 + j;
                        nA[j] = (s_ < fr) ? nA[j] : 0.f; nB[j] = (fr < s_) ? nB[j] : 0.f; mak[j] = (s_ < fr) ? mak[j] : 0.f;
                        mbr[j] = (s_ <= fr) ? mbr[j] : 0.f; mkr[j] = (s_ <= fr) ? mkr[j] : 0.f;
                    }
                    const sh4 pNA = pk4v(nA), pNB = pk4v(nB), pMak = pk4v(mak), pMbr = pk4v(mbr), pMkr = pk4v(mkr);
                    const f32x4 n2B = MF16(pNA, pNB, z4), n2A = MF16(pNB, pNA, z4);
                    const sh4 pN2A = pk4v(n2A), pN2B = pk4v(n2B);
                    const f32x4 n4B = MF16(pN2A, pN2B, z4), n4A = MF16(pN2B, pN2A, z4);
                    const sh4 pN4A = pk4v(n4A), pN4B = pk4v(n4B);
                    const sh4 pN8A = pk4v(MF16(pN4B, pN4A, z4));
                    const bf16x8 sB0 = cat8(pk4v(S[0]), pk4v(S[1])), sB1 = cat8(pk4v(S[2]), pk4v(S[3]));
                    const sh4 vf = *(const sh4*)(o_vT + (wid * 16 + fr) * SC_LS + sc * 16 + fq * 4);
                    f32x4 X = MF32(cat8(*(const sh4*)(ar + fq * 4), *(const sh4*)(ar + 16 + fq * 4)), sB0, z4);
                    X = MF32(cat8(*(const sh4*)(ar + 32 + fq * 4), *(const sh4*)(ar + 48 + fq * 4)), sB1, X);
                    X = MF16(pMak, vf, X);
                    X = MF16(pN8A, pk4v(X), X); X = MF16(pN4A, pk4v(X), X); X = MF16(pN2A, pk4v(X), X); X = MF16(pNA, pk4v(X), X);
                    const sh4 pSA = pk4v(X);
                    f32x4 O = MF32(cat8(*(const sh4*)(rr_ + fq * 4), *(const sh4*)(rr_ + 16 + fq * 4)), sB0, z4);
                    O = MF32(cat8(*(const sh4*)(rr_ + 32 + fq * 4), *(const sh4*)(rr_ + 48 + fq * 4)), sB1, O);
                    const bf16x8 sav = cat8(pSA, vf);
                    O = MF32(cat8(pMbr, pMkr), sav, O);
#pragma unroll
                    for (int j = 0; j < 4; ++j) o_c[(sc * 16 + fq * 4 + j) * 64 + wid * 16 + fr] = O[j];
#pragma unroll
                    for (int jt = 0; jt < 4; ++jt) {
                        const sh4 ka = *(const sh4*)(o_kT + (jt * 16 + fr) * SC_LS + sc * 16 + fq * 4), ba = *(const sh4*)(o_bT + (jt * 16 + fr) * SC_LS + sc * 16 + fq * 4);
                        f32x4 acc = MF32(cat8(ba, ka), sav, S[jt]);
                        const float4 g4 = *(const float4*)(s_gc + sc * 64 + jt * 16 + fq * 4);
                        acc[0] *= g4.x; acc[1] *= g4.y; acc[2] *= g4.z; acc[3] *= g4.w;
                        S[jt] = acc;
                    }
                }
            }
        } else if (ch > 0) {
            const int t2 = otid() - 256;
            stepE(t2 >> 4, (t2 & 15) * 4, o_p, v_p, g_p, bs_p, t0 - SC_TC, SC_TC);
            stepE(16 + (t2 >> 4), (t2 & 15) * 4, o_p, v_p, g_p, bs_p, t0 - SC_TC, SC_TC);
        }
        lds_barrier();
    }
    {
        const int chl = (TS + SC_TC - 1) / SC_TC - 1; const bool parl = (chl & 1) != 0;
        stepE(tid >> 4, (tid & 15) * 4, parl ? s_oB : s_o, parl ? s_vB : s_v, parl ? s_gB : s_g, s_bs2 + (parl ? 32 : 0), chl * SC_TC, TS - chl * SC_TC);
    }
}
__device__ __forceinline__ void xcd_panel_map(int& mt0, int& mstep, int& nt) {
    const int b = obid(), G = (int)gridDim.x;
    if (G == 256) { nt = (b >> 3) & 7; mt0 = (b & 7) * 4 + (b >> 6); mstep = 32; }
    else { nt = b & 7; mt0 = b >> 3; mstep = G >> 3; }
}
__device__ void phase_merge(const Params& p, unsigned char* lds) {
    const int tid = otid(), lane = tid & 63, wid = tid >> 6, wr = wid >> 1, wc = wid & 1, fr = lane & 15, fq = lane >> 4;
    const bf16_t* h = (const bf16_t*)(WS(p) + OFF_H);
    const bf16_t* wb = (const bf16_t*)(WS(p) + OFF_WB);
    const float* rstd = (const float*)(WS(p) + OFF_RSTD);
    bf16_t* merged = (bf16_t*)(WS(p) + OFF_MERGED);
    const bf16_t* ysrc0 = (const bf16_t*)(WS(p) + OFF_PPOOL);
    const bf16_t* ysrc1 = (const bf16_t*)(WS(p) + OFF_PR);
    const bf16_t* ysrc2 = (const bf16_t*)(OUTB(p) + DO_YC);
    int mt0, mstep, nt;
    xcd_panel_map(mt0, mstep, nt);
    for (int mt = mt0; mt < 86; mt += mstep) {
        const int row0 = mt * 192, col0 = nt * 128;
        uint2 maccp[3][4];
#pragma unroll
        for (int m = 0; m < 3; ++m)
#pragma unroll
            for (int n = 0; n < 4; ++n) maccp[m][n] = make_uint2(0u, 0u);
#pragma unroll 1
        for (int i = 0; i < 3; ++i) {
            const int tid = otid();
            const bf16_t* ys = (i == 0) ? ysrc0 : (i == 1 ? ysrc1 : ysrc2);
            uint2 sg[3][4];
            {
                f32x4 ag[3][4]; g3_zero<3>(ag);
                G3<192> g;
                g3_setup<192>(g, [&](int r) { return h + (size_t)(row0 + r) * DM; }, [&](int r) { return wb + WB_WG + (size_t)(i * 1024 + col0 + r) * DM; }, tid);
                g3_kloop<192>(ag, g, DM, lds);
#pragma unroll
                for (int m = 0; m < 3; ++m) {
                    const float rs = rstd[row0 + wr * 48 + m * 16 + fr];
#pragma unroll
                    for (int n = 0; n < 4; ++n) sg[m][n] = pack4(fast_sigmoid(ag[m][n][0] * rs), fast_sigmoid(ag[m][n][1] * rs), fast_sigmoid(ag[m][n][2] * rs), fast_sigmoid(ag[m][n][3] * rs));
                }
            }
            {
                f32x4 ay[3][4]; g3_zero<3>(ay);
                G3<192> g;
                g3_setup<192>(g, [&](int r) { return ys + (size_t)(row0 + r) * DM; }, [&](int r) { return wb + WB_PA + (size_t)(i * 1024 + col0 + r) * DM; }, tid);
                g3_kloop<192>(ay, g, DM, lds);
#pragma unroll
                for (int m = 0; m < 3; ++m)
#pragma unroll
                    for (int n = 0; n < 4; ++n) {
                        const float m0 = __uint_as_float(maccp[m][n].x << 16) + __uint_as_float(sg[m][n].x << 16) * ay[m][n][0];
                        const float m1 = __uint_as_float(maccp[m][n].x & 0xFFFF0000u) + __uint_as_float(sg[m][n].x & 0xFFFF0000u) * ay[m][n][1];
                        const float m2 = __uint_as_float(maccp[m][n].y << 16) + __uint_as_float(sg[m][n].y << 16) * ay[m][n][2];
                        const float m3 = __uint_as_float(maccp[m][n].y & 0xFFFF0000u) + __uint_as_float(sg[m][n].y & 0xFFFF0000u) * ay[m][n][3];
                        maccp[m][n] = pack4(m0, m1, m2, m3);
                    }
            }
        }
#pragma unroll
        for (int m = 0; m < 3; ++m) {
            const int row = row0 + wr * 48 + m * 16 + fr;
#pragma unroll
            for (int n = 0; n < 4; ++n)
                *(uint2*)(merged + (size_t)row * 1024 + col0 + wc * 64 + n * 16 + fq * 4) = maccp[m][n];
        }
    }
}

__device__ void phase_outproj(const Params& p, unsigned char* lds) {
    const int tid = otid(), lane = tid & 63, wid = tid >> 6, wr = wid >> 1, wc = wid & 1, fr = lane & 15, fq = lane >> 4;
    const bf16_t* h = (const bf16_t*)(WS(p) + OFF_H);
    const bf16_t* wb = (const bf16_t*)(WS(p) + OFF_WB);
    const bf16_t* merged = (const bf16_t*)(WS(p) + OFF_MERGED);
    float* hm = (float*)(WS(p) + OFF_HM32);
    int mt0, mstep, nt;
    xcd_panel_map(mt0, mstep, nt);
    for (int mt = mt0; mt < 86; mt += mstep) {
        const int row0 = mt * 192, col0 = nt * 128;
        G3<192> g;
        g3_setup<192>(g, [&](int r) { return merged + (size_t)(row0 + r) * DM; }, [&](int r) { return wb + WB_WO + (size_t)(col0 + r) * DM; }, tid);
        f32x4 acc[3][4]; g3_zero<3>(acc);
        g3_kloop<192>(acc, g, DM, lds);
        uint2 hres[3][4];
#pragma unroll
        for (int m = 0; m < 3; ++m)
#pragma unroll
            for (int n = 0; n < 4; ++n) hres[m][n] = *(const uint2*)(h + (size_t)(row0 + wr * 48 + m * 16 + fr) * 1024 + col0 + wc * 64 + n * 16 + fq * 4);
#pragma unroll
        for (int m = 0; m < 3; ++m) {
            const int row = row0 + wr * 48 + m * 16 + fr;
#pragma unroll
            for (int n = 0; n < 4; ++n) {
                const int col = col0 + wc * 64 + n * 16 + fq * 4;
                const uint2 hv = hres[m][n];
                float4 o;
                o.x = __uint_as_float(hv.x << 16) + acc[m][n][0]; o.y = __uint_as_float(hv.x & 0xFFFF0000u) + acc[m][n][1];
                o.z = __uint_as_float(hv.y << 16) + acc[m][n][2]; o.w = __uint_as_float(hv.y & 0xFFFF0000u) + acc[m][n][3];
                *(float4*)(hm + (size_t)row * 1024 + col) = o;
            }
        }
    }
}

__device__ __constant__ int c_pair_lo[6] = {0, 0, 0, 1, 1, 2};
__device__ __constant__ int c_pair_hi[6] = {1, 2, 3, 2, 3, 3};
__device__ void phase_route(const Params& p, int l, unsigned char* lds) {
    const int tid = otid(), lane = tid & 63, wid = tid >> 6;
    const int per = (NT + (int)gridDim.x - 1) / (int)gridDim.x;
    const int nbeg = obid() * per, nend = (nbeg + per < NT) ? nbeg + per : NT;
    int* s_cls = (int*)lds;
    int* s_base = s_cls + 512;
    float* s_wr = (float*)(lds + 4096);
    const float* hm = (const float*)(WS(p) + OFF_HM32);
    bf16_t* hn = (bf16_t*)(WS(p) + OFF_HN);
    const float* nf = p.in[33] + (size_t)l * 1024;
    const float* wg = p.in[34] + (size_t)l * 1024 * 4;
    const float* bg = p.in[35] + l * 4;
    const float* we = p.in[36] + (size_t)l * 1024 * 16;
    const float* be = p.in[37] + l * 16;
    int* cnt = (int*)(WS(p) + OFF_CTL);
    int* list = (int*)(WS(p) + OFF_LIST);
    float* pw = (float*)(WS(p) + OFF_PW);
    {
        float4 gv[2], ev[8];
#pragma unroll
        for (int i = 0; i < 2; ++i) gv[i] = *(const float4*)(wg + (size_t)(tid + i * NTHR) * 4);
#pragma unroll
        for (int i = 0; i < 8; ++i) ev[i] = *(const float4*)(we + (size_t)(tid + i * NTHR) * 4);
#pragma unroll
        for (int i = 0; i < 2; ++i) { const int k = tid + i * NTHR; s_wr[k] = gv[i].x; s_wr[1024 + k] = gv[i].y; s_wr[2048 + k] = gv[i].z; s_wr[3072 + k] = gv[i].w; }
#pragma unroll
        for (int i = 0; i < 8; ++i) {
            const int q = tid + i * NTHR, k = q >> 2, e0 = 4 + (q & 3) * 4;
            s_wr[e0 * 1024 + k] = ev[i].x; s_wr[(e0 + 1) * 1024 + k] = ev[i].y; s_wr[(e0 + 2) * 1024 + k] = ev[i].z; s_wr[(e0 + 3) * 1024 + k] = ev[i].w;
        }
    }
    __syncthreads();
    float4 nv[4], cur[4];
#pragma unroll
    for (int i = 0; i < 4; ++i) nv[i] = *(const float4*)(nf + i * 256 + lane * 4);
    if (nbeg + wid < nend) {
#pragma unroll
        for (int i = 0; i < 4; ++i) cur[i] = *(const float4*)(hm + (size_t)(nbeg + wid) * DM + i * 256 + lane * 4);
    }
    for (int n = nbeg + wid; n < nend; n += 8) {
        float4 xv[4]; float ss = 0.f;
#pragma unroll
        for (int i = 0; i < 4; ++i) { xv[i] = cur[i]; ss += xv[i].x * xv[i].x + xv[i].y * xv[i].y + xv[i].z * xv[i].z + xv[i].w * xv[i].w; }
        if (n + 8 < nend) {
#pragma unroll
            for (int i = 0; i < 4; ++i) cur[i] = *(const float4*)(hm + (size_t)(n + 8) * DM + i * 256 + lane * 4);
        }
        ss = wave_sum_fast(ss);
        const float rs = rsqrtf(ss * (1.0f / 1024.0f) + 1e-6f);
        float lg[4] = {0.f, 0.f, 0.f, 0.f};
        float le[16];
#pragma unroll
        for (int e = 0; e < 16; ++e) le[e] = 0.f;
#pragma unroll
        for (int i = 0; i < 4; ++i) {
            float y[4] = {xv[i].x * rs * nv[i].x, xv[i].y * rs * nv[i].y, xv[i].z * rs * nv[i].z, xv[i].w * rs * nv[i].w};
            {
                const int d0 = i * 256 + lane * 4;
#pragma unroll
                for (int g = 0; g < 4; ++g) { const float4 w4 = *(const float4*)(s_wr + g * 1024 + d0); lg[g] += y[0] * w4.x + y[1] * w4.y + y[2] * w4.z + y[3] * w4.w; }
#pragma unroll
                for (int e = 0; e < 16; ++e) { const float4 w4 = *(const float4*)(s_wr + (4 + e) * 1024 + d0); le[e] += y[0] * w4.x + y[1] * w4.y + y[2] * w4.z + y[3] * w4.w; }
            }
            *(uint2*)(hn + (size_t)n * DM + i * 256 + lane * 4) = pack4(y[0], y[1], y[2], y[3]);
        }
#pragma unroll
        for (int g = 0; g < 4; ++g) lg[g] = wave_sum_fast(lg[g]) + bg[g];
#pragma unroll
        for (int e = 0; e < 16; ++e) le[e] = wave_sum_fast(le[e]) + be[e];
        if (lane == 0) {
            int gs = 0; float gm = lg[0];
#pragma unroll
            for (int g = 1; g < 4; ++g) if (lg[g] > gm) { gm = lg[g]; gs = g; }
            float den = 0.f;
#pragma unroll
            for (int g = 0; g < 4; ++g) den += __expf(lg[g] - gm);
            const float pgrp = 1.0f / den;
            float v4[4];
#pragma unroll
            for (int e = 0; e < 4; ++e) {
                const float m0 = (gs == 0) ? 1.f : 0.f, m1s = (gs == 1) ? 1.f : 0.f, m2s = (gs == 2) ? 1.f : 0.f, m3s = (gs == 3) ? 1.f : 0.f;
                v4[e] = le[e] * m0 + le[4 + e] * m1s + le[8 + e] * m2s + le[12 + e] * m3s;
            }
            int i1 = 0; float m1 = v4[0];
#pragma unroll
            for (int e = 1; e < 4; ++e) if (v4[e] > m1) { m1 = v4[e]; i1 = e; }
            int i2 = -1; float m2 = -INFINITY;
#pragma unroll
            for (int e = 0; e < 4; ++e) if (e != i1 && v4[e] > m2) { m2 = v4[e]; i2 = e; }
            const float e2 = __expf(m2 - m1);
            const float p1 = pgrp / (1.0f + e2), p2 = pgrp * e2 / (1.0f + e2);
            const int lo = i1 < i2 ? i1 : i2, hi = i1 < i2 ? i2 : i1;
            const float plo = i1 < i2 ? p1 : p2, phi = i1 < i2 ? p2 : p1;
            const int pi = (lo == 0) ? (hi - 1) : (lo == 1 ? hi + 1 : 5);
            const int cls = gs * 6 + pi;
            s_cls[n - nbeg] = cls;
            pw[(size_t)n * 2 + 0] = plo; pw[(size_t)n * 2 + 1] = phi;
        }
    }
    __syncthreads();
    const int nloc = nend - nbeg;
    if (tid < 24) {
        int c_ = 0;
        for (int i = 0; i < nloc; ++i) c_ += (s_cls[i] == tid) ? 1 : 0;
        s_base[tid] = c_ ? atomicAdd(&cnt[tid * 32], c_) : 0;
    }
    __syncthreads();
    for (int it = tid; it < nloc; it += NTHR) {
        const int cls = s_cls[it];
        int rank = 0;
        for (int i = 0; i < it; ++i) rank += (s_cls[i] == cls) ? 1 : 0;
        list[(size_t)cls * NT + s_base[cls] + rank] = nbeg + it;
    }
    __syncthreads();
}


struct MoeTile { int cls, ti, cnt, tg; };
__device__ __forceinline__ int moe_table(const int* cnt, unsigned char* lds) {
    int* tab = (int*)(lds + LDS_BYTES - 512);
    __syncthreads();
    if (otid() < 24) tab[otid()] = cnt[otid() * 32];
    __syncthreads();
    if (otid() == 0) { int s_ = 0; for (int c = 0; c < 24; ++c) { tab[24 + c] = s_; s_ += (tab[c] + 127) >> 7; } tab[48] = s_; }
    __syncthreads();
    return tab[48];
}
__device__ __forceinline__ MoeTile moe_find(const unsigned char* lds, int tile) {
    const int* tab = (const int*)(lds + LDS_BYTES - 512);
    MoeTile r; r.cls = 0; r.ti = 0; r.cnt = 0; r.tg = tile;
    for (int c = 0; c < 24; ++c) { const int s_ = tab[24 + c], e_ = tab[25 + c]; if (tile >= s_ && tile < e_) { r.cls = c; r.ti = tile - s_; r.cnt = tab[c]; } }
    return r;
}
__device__ void phase_moe1(const Params& p, unsigned char* lds) {
    const int tid = otid(), lane = tid & 63, wid = tid >> 6, wr = wid >> 1, wc = wid & 1, fr = lane & 15, fq = lane >> 4;
    const int* cnt = (const int*)(WS(p) + OFF_CTL);
    const int* list = (const int*)(WS(p) + OFF_LIST);
    const float* pw = (const float*)(WS(p) + OFF_PW);
    const bf16_t* hn = (const bf16_t*)(WS(p) + OFF_HN);
    const bf16_t* we = (const bf16_t*)(WS(p) + OFF_WEXP);
    bf16_t* hid = (bf16_t*)(OUTB(p) + DO_HID);
    const int total = moe_table(cnt, lds);
    const int xq = obid() & 7, yq = obid() >> 3, ystep = gridDim.x >> 3;
    for (int idx = yq; ; idx += ystep) {
        const int tix = (idx >> 2) * 8 + xq;
        if (tix >= total) break;
        const MoeTile mt = moe_find(lds, tix);
        const int nt = idx & 3, slot = nt >> 1, f0 = (nt & 1) * 128;
        const int g_ = mt.cls / 6, pi = mt.cls % 6;
        const int e = g_ * 4 + (slot == 0 ? c_pair_lo[pi] : c_pair_hi[pi]);
        const int* lst = list + (size_t)mt.cls * NT + mt.ti * 128;
        const int nvalid = min(128, mt.cnt - mt.ti * 128);
        f32x4 a1[2][4], a3[2][4]; g3_zero<2>(a1); g3_zero<2>(a3);
        G3D g;
#pragma unroll
        for (int i = 0; i < 2; ++i) {
            const int idx = tid + i * NTHR, row = idx >> 3, sl = (idx & 7) ^ (row & 7);
            g.ap[i] = hn + (size_t)lst[row < nvalid ? row : 0] * DM + sl * 8;
            g.b1[i] = we + WE_W1 + ((size_t)e * 256 + f0 + row) * 1024 + sl * 8;
            g.b3[i] = we + WE_W3 + ((size_t)e * 256 + f0 + row) * 1024 + sl * 8;
        }
        g3d_kloop(a1, a3, g, DM, lds);
        float pev[2];
#pragma unroll
        for (int m = 0; m < 2; ++m) { const int lr = wr * 32 + m * 16 + fr; pev[m] = pw[(size_t)lst[lr < nvalid ? lr : 0] * 2 + slot]; }
#pragma unroll
        for (int m = 0; m < 2; ++m) {
            const int lr = wr * 32 + m * 16 + fr;
            const float pe = pev[m];
#pragma unroll
            for (int n = 0; n < 4; ++n) {
                const int col = slot * 256 + f0 + wc * 64 + n * 16 + fq * 4;
                float o[4];
#pragma unroll
                for (int j = 0; j < 4; ++j) { const float x1 = a1[m][n][j]; o[j] = x1 * sigmoidf_(x1) * a3[m][n][j] * pe; }
                *(uint2*)(hid + ((size_t)mt.tg * 128 + lr) * 512 + col) = pack4(o[0], o[1], o[2], o[3]);
            }
        }
    }
}
__device__ void phase_moe2(const Params& p, int l, unsigned char* lds) {
    const int tid = otid(), lane = tid & 63, wid = tid >> 6, wr = wid >> 1, wc = wid & 1, fr = lane & 15, fq = lane >> 4;
    const int* cnt = (const int*)(WS(p) + OFF_CTL);
    const int* list = (const int*)(WS(p) + OFF_LIST);
    const bf16_t* we = (const bf16_t*)(WS(p) + OFF_WEXP);
    const bf16_t* hid = (const bf16_t*)(OUTB(p) + DO_HID);
    float* hm = (float*)(WS(p) + OFF_HM32);
    bf16_t* h = (bf16_t*)(WS(p) + OFF_H);
    const int total = moe_table(cnt, lds);
    const int xq = obid() & 7, yq = obid() >> 3, ystep = gridDim.x >> 3;
    for (int idx = yq; ; idx += ystep) {
        const int tix = (idx >> 3) * 8 + xq;
        if (tix >= total) break;
        const MoeTile mt = moe_find(lds, tix);
        const int nt = idx & 7, col0 = nt * 128;
        const int g_ = mt.cls / 6, pi = mt.cls % 6;
        const int elo = g_ * 4 + c_pair_lo[pi], ehi = g_ * 4 + c_pair_hi[pi];
        const int* lst = list + (size_t)mt.cls * NT + mt.ti * 128;
        const int nvalid = min(128, mt.cnt - mt.ti * 128);
        f32x4 acc[2][4]; g3_zero<2>(acc);
        G3<128> g;
        g3_setup<128>(g, [&](int r) { return hid + ((size_t)mt.tg * 128 + r) * 512; }, [&](int r) { return we + WE_W2 + ((size_t)elo * 1024 + col0 + r) * 256; }, tid);
        g3_kloop<128>(acc, g, 256, lds);
        g3_setup<128>(g, [&](int r) { return hid + ((size_t)mt.tg * 128 + r) * 512 + 256; }, [&](int r) { return we + WE_W2 + ((size_t)ehi * 1024 + col0 + r) * 256; }, tid);
        g3_kloop<128>(acc, g, 256, lds);
        int tkv[2]; float4 hv[2][4];
#pragma unroll
        for (int m = 0; m < 2; ++m) {
            const int lr = wr * 32 + m * 16 + fr;
            tkv[m] = lst[lr < nvalid ? lr : 0];
#pragma unroll
            for (int n = 0; n < 4; ++n) hv[m][n] = *(const float4*)(hm + (size_t)tkv[m] * 1024 + col0 + wc * 64 + n * 16 + fq * 4);
        }
#pragma unroll
        for (int m = 0; m < 2; ++m) {
            const int lr = wr * 32 + m * 16 + fr;
            if (lr < nvalid) {
                const int tk = tkv[m];
#pragma unroll
                for (int n = 0; n < 4; ++n) {
                    const int col = col0 + wc * 64 + n * 16 + fq * 4;
                    float4 v = hv[m][n];
                    v.x += acc[m][n][0]; v.y += acc[m][n][1]; v.z += acc[m][n][2]; v.w += acc[m][n][3];
                    if (l == 0) *(uint2*)(h + (size_t)tk * 1024 + col) = pack4(v.x, v.y, v.z, v.w);
                    else *(float4*)(hm + (size_t)tk * 1024 + col) = v;
                }
            }
        }
    }
}

__device__ void phase_final(const Params& p) {
    const int lane = otid() & 63;
    const int wave = (obid() * NTHR + otid()) >> 6, nw = gridDim.x * NTHR / 64;
    const float* hm = (const float*)(WS(p) + OFF_HM32);
    const float* nf = p.in[41];
    float4 g[4], cur[4];
#pragma unroll
    for (int i = 0; i < 4; ++i) g[i] = *(const float4*)(nf + i * 256 + lane * 4);
    auto rowp = [&](int r) { const int b = r / SEQ, s_ = r % SEQ; return hm + ((size_t)b * TS + NMETA + s_) * DM; };
    if (wave < NB * SEQ) {
        const float* src = rowp(wave);
#pragma unroll
        for (int i = 0; i < 4; ++i) cur[i] = *(const float4*)(src + i * 256 + lane * 4);
    }
    for (int r = wave; r < NB * SEQ; r += nw) {
        float4 v[4]; float ss = 0.f;
#pragma unroll
        for (int i = 0; i < 4; ++i) { v[i] = cur[i]; ss += v[i].x * v[i].x + v[i].y * v[i].y + v[i].z * v[i].z + v[i].w * v[i].w; }
        if (r + nw < NB * SEQ) {
            const float* src = rowp(r + nw);
#pragma unroll
            for (int i = 0; i < 4; ++i) cur[i] = *(const float4*)(src + i * 256 + lane * 4);
        }
        ss = wave_sum_fast(ss);
        const float rs = rsqrtf(ss * (1.0f / 1024.0f) + 1e-6f);
#pragma unroll
        for (int i = 0; i < 4; ++i) {
            float4 o; o.x = v[i].x * rs * g[i].x; o.y = v[i].y * rs * g[i].y; o.z = v[i].z * rs * g[i].z; o.w = v[i].w * rs * g[i].w;
            *(float4*)((float*)OUTB(p) + (size_t)r * DM + i * 256 + lane * 4) = o;
        }
    }
}


#define XB_TMO      128
#define XB_XCNT(j)  (256  + 64 * (j))
#define XB_XSUB(j)  (1280 + 64 * (j))
#define XB_XGEN(j)  (2304 + 64 * (j))
#define XB_TOP      3328
#define XB_TOPGEN   3392
#define XCD_BAR_WORDS 3456
#define XB_SPIN_CAP (1u << 22)
#define LAS __attribute__((address_space(3)))
__device__ __forceinline__ unsigned xb_ld(unsigned* p) { return __hip_atomic_load(p, __ATOMIC_RELAXED, __HIP_MEMORY_SCOPE_AGENT); }
__device__ __forceinline__ unsigned xb_add(unsigned* p, unsigned v) { return __hip_atomic_fetch_add(p, v, __ATOMIC_RELAXED, __HIP_MEMORY_SCOPE_AGENT); }
__device__ __forceinline__ unsigned xb_xcc_id() { return (unsigned)__builtin_amdgcn_s_getreg((3 << 11) | 20) & 0xFu; }
#define XB_SPIN(cond, bar) do { unsigned _sp = 0; while (cond) { __builtin_amdgcn_s_sleep(1); \
    if ((++_sp & 255u) == 0u) { if (xb_ld(&(bar)[XB_TMO])) break; if (_sp > XB_SPIN_CAP) { atomicAdd(&(bar)[XB_TMO], 1u); break; } } } } while (0)
struct XcdBarrier { unsigned* bar; unsigned x; volatile LAS unsigned* st; };
__device__ __forceinline__ XcdBarrier xcd_barrier_post(unsigned* bar, volatile LAS unsigned* st) {
    XcdBarrier b; b.bar = bar; b.x = xb_xcc_id(); b.st = st;
    if (threadIdx.x == 0) (void)xb_add(&bar[XB_XCNT(b.x)], 1u);
    return b;
}
__device__ __forceinline__ void xcd_barrier_complete(unsigned* bar, unsigned x, unsigned& nloc, unsigned& nx) {
    const unsigned G = gridDim.x * gridDim.y * gridDim.z;
    unsigned sum, cnt, mine, sp = 0u;
    for (;;) {
        sum = 0u; cnt = 0u; mine = 0u;
#pragma unroll
        for (unsigned j = 0; j < 16; ++j) { const unsigned c = xb_ld(&bar[XB_XCNT(j)]); sum += c; cnt += (c > 0u) ? 1u : 0u; mine = (j == x) ? c : mine; }
        if (sum == G) break;
        __builtin_amdgcn_s_sleep(1);
        if ((++sp & 255u) == 0u) { if (xb_ld(&bar[XB_TMO])) break; if (sp > XB_SPIN_CAP) { atomicAdd(&bar[XB_TMO], 1u); break; } }
    }
    nloc = mine > 0u ? mine : 1u; nx = cnt > 0u ? cnt : 1u;
}
__device__ __forceinline__ void xcd_barrier(const XcdBarrier& b) {
    asm volatile("s_waitcnt vmcnt(0)" ::: "memory");
    __syncthreads();
    if (threadIdx.x == 0) {
        unsigned* bar = b.bar;
        __builtin_amdgcn_s_waitcnt(0);
        unsigned nloc = b.st[0], nx = b.st[1];
        if (nloc == 0u) { xcd_barrier_complete(bar, b.x, nloc, nx); b.st[0] = nloc; b.st[1] = nx; }
        const unsigned old = xb_add(&bar[XB_XSUB(b.x)], 1u);
        const unsigned gen = old / nloc;
        if (old + 1u == (gen + 1u) * nloc) {
            __builtin_amdgcn_fence(__ATOMIC_RELEASE, "agent");
            asm volatile("s_waitcnt vmcnt(0)" ::: "memory");
            const unsigned og = xb_add(&bar[XB_TOP], 1u);
            const unsigned tg = og / nx;
            if (og + 1u == (tg + 1u) * nx) xb_add(&bar[XB_TOPGEN], 1u);
            else XB_SPIN(xb_ld(&bar[XB_TOPGEN]) == tg, bar);
            __builtin_amdgcn_fence(__ATOMIC_ACQUIRE, "agent");
            xb_add(&bar[XB_XGEN(b.x)], 1u);
            asm volatile("s_waitcnt vmcnt(0)" ::: "memory");
        } else {
            XB_SPIN(xb_ld(&bar[XB_XGEN(b.x)]) == gen, bar);
            __builtin_amdgcn_fence(__ATOMIC_ACQUIRE, "agent");
            asm volatile("s_waitcnt vmcnt(0)" ::: "memory");
        }
    }
    __syncthreads();
}

__global__ void __launch_bounds__(NTHR) fwd_megakernel(Params p) {
    extern __shared__ __attribute__((aligned(16))) unsigned char lds[];
    cg::grid_group grid = cg::this_grid();
    volatile LAS unsigned* xst = (volatile LAS unsigned*)(lds + LDS_BYTES - 32);
    if (threadIdx.x < 2) xst[threadIdx.x] = 0u;
    __syncthreads();
    const XcdBarrier xb = xcd_barrier_post((unsigned*)(p.ws + OFF_BAR), xst);
    if (p.out == nullptr) grid.sync();
#pragma unroll 1
    for (int step = 0; step < 18; ++step) {
        const int l = step >= 9 ? 1 : 0;
        const int ph = step - l * 9;
        switch (ph) {
        case 0:
            if (l == 0) phase_embed(p); else phase_rowstat(p);
            phase_convert<false>(p, l, lds);
            if (obid() == 0 && otid() < 24) ((int*)(WS(p) + OFF_CTL))[otid() * 32] = 0;
            if (obid() == 0 && otid() == 32) ((int*)(WS(p) + OFF_CTL))[800 + l * 32] = 0;
            break;
        case 1: phase_inproj(p, lds); break;
        case 2: phase_dsa_prep(p, l); phase_lr_prep(p, l); break;
        case 3: {
            if (obid() < NB * 16) phase_scan5(p, l, lds, obid());
            int* qctr = (int*)(WS(p) + OFF_CTL) + 800 + l * 32;
            int* qslot = (int*)(lds + LDS_BYTES - 16);
            for (;;) {
                __syncthreads();
                if (otid() == 0) *qslot = atomicAdd(qctr, 1);
                __syncthreads();
                const int item = *qslot;
                if (item >= 516 + NT / 32 + 3072) break;
                if (item < 516) phase_pool(p, l, lds, item, item + 1, 1);
                else if (item < 516 + NT / 32) phase_dsa<false>(p, l, lds, (bf16_t*)(OUTB(p) + DO_YC), nullptr, nullptr, item - 516, item - 515, 1);
                else {
                    const int ct = item - (516 + NT / 32);
                    const ConvJob cj = get_job_late(p, l, ct >> 10);
                    conv_tile(cj, ct & 1023, (float*)lds);
                }
            }
        } break;
        case 4: phase_merge(p, lds); break;
        case 5: phase_outproj(p, lds); break;
        case 6: phase_route(p, l, lds); break;
        case 7: phase_moe1(p, lds); break;
        default: phase_moe2(p, l, lds); break;
        }
        xcd_barrier(xb);
    }
    phase_final(p);
}

extern "C" void kernel_launch(void* const* d_in, const int* in_sizes, int n_in,
                              void* d_out, int out_size, void* d_ws, size_t ws_size,
                              hipStream_t stream) {
    static int grid_blocks = 0;
    if (grid_blocks == 0) {
        int dev = 0, cus = 0, per_cu = 0;
        (void)hipGetDevice(&dev);
        (void)hipDeviceGetAttribute(&cus, hipDeviceAttributeMultiprocessorCount, dev);
        (void)hipFuncSetAttribute((const void*)fwd_megakernel, hipFuncAttributeMaxDynamicSharedMemorySize, LDS_BYTES);
        (void)hipOccupancyMaxActiveBlocksPerMultiprocessor(&per_cu, fwd_megakernel, NTHR, LDS_BYTES);
        if (per_cu < 1 || cus < NB * 16 || (cus & 7) != 0 || n_in != 42 || ws_size < WS_END + (size_t)QS_WS * QS_BYTES || cus > QS_WS + QS_DO) { fprintf(stderr, "kernel_launch: bad config per_cu=%d n_in=%d ws=%zu need=%zu\n", per_cu, n_in, ws_size, (size_t)WS_END); grid_blocks = -1; }
        else grid_blocks = cus;
    }
    if (grid_blocks < 0) return;
    Params p{};
    for (int i = 0; i < 42; ++i) p.in[i] = (const float*)d_in[i];
    p.out = (float*)d_out;
    p.ws = (unsigned char*)d_ws;
    (void)hipMemsetAsync((unsigned char*)d_ws + OFF_BAR, 0, XCD_BAR_WORDS * 4, stream);
    void* args[] = {&p};
    hipError_t e = hipLaunchCooperativeKernel((void*)fwd_megakernel, dim3(grid_blocks), dim3(NTHR), args, LDS_BYTES, stream);
    if (e != hipSuccess) fprintf(stderr, "cooperative launch failed: %s (grid %d)\n", hipGetErrorString(e), grid_blocks);
}
```

```cpp
#include <hip/hip_runtime.h>
#include <hip/hip_cooperative_groups.h>
#include <cstdio>
#include <cstdint>
#include <type_traits>
namespace cg = cooperative_groups;

typedef unsigned short bf16_t;
typedef short bf16x8 __attribute__((ext_vector_type(8)));
typedef float f32x4 __attribute__((ext_vector_type(4)));

constexpr int NB = 8, SEQ = 2048, NMETA = 16, TS = 2064, DM = 1024;
constexpr int NT = NB * TS;
constexpr int NTP = 16640;
constexpr int NTHR = 512;
constexpr int CIN = 7912;
constexpr int NP1 = 4864;
constexpr int PM_LD = 768;
constexpr int PM_WD = 0, PM_AD = 64, PM_GD = 128, PM_VD = 256, PM_CQ = 288, PM_CKV = 544, PM_KROPE = 672, PM_KIDX = 704;
constexpr int LDS_BYTES = 157 * 1024;

constexpr size_t AL(size_t x) { return (x + 255) & ~(size_t)255; }
constexpr size_t SZ_ACT = (size_t)NTP * 1024 * 2;
constexpr size_t OFF_CTL = 0;
constexpr size_t OFF_BAR = 4096;
constexpr size_t OFF_RSTD = OFF_BAR + 16384;
constexpr size_t OFF_ROPE = OFF_RSTD + AL((size_t)NTP * 4);
constexpr size_t OFF_H = OFF_ROPE + AL((size_t)TS * 16 * 4 * 2);
constexpr size_t OFF_WB = OFF_H + SZ_ACT;
constexpr size_t WB_WIN = 0;
constexpr size_t WB_WG = WB_WIN + (size_t)NP1 * 1024;
constexpr size_t WB_PA = WB_WG + (size_t)3072 * 1024;
constexpr size_t WB_WO = WB_PA + (size_t)3 * 1024 * 1024;
constexpr size_t WB_POOL = WB_WO + (size_t)1024 * 1024;
constexpr size_t WB_QI = WB_POOL + (size_t)4 * 256 * 256;
constexpr size_t WB_UQ = WB_QI + (size_t)512 * 256;
constexpr size_t WB_UK = WB_UQ + (size_t)1536 * 256;
constexpr size_t WB_UV = WB_UK + (size_t)16 * 128 * 64;
constexpr size_t WB_WIDX = WB_UV + (size_t)16 * 64 * 128;
constexpr size_t WB_END = WB_WIDX + (size_t)64 * 1024;
constexpr size_t OFF_PPOOL = OFF_WB + AL(WB_END * 2);
constexpr size_t OFF_PK = OFF_PPOOL + SZ_ACT;
constexpr size_t OFF_PR = OFF_PK + SZ_ACT;
constexpr size_t OFF_PV = OFF_PR + SZ_ACT;
constexpr size_t OFF_PMISC = OFF_PV + SZ_ACT;
constexpr size_t OFF_VFIRST = OFF_PMISC + AL((size_t)NTP * PM_LD * 2);
constexpr size_t OFF_HALO = OFF_VFIRST + SZ_ACT;
constexpr size_t OFF_LIST = OFF_HALO + AL((size_t)130 * 16 * 1024 * 2);
constexpr size_t OFF_PW = OFF_LIST + AL((size_t)24 * NT * 4);
constexpr size_t WS_END = OFF_PW + AL((size_t)NT * 2 * 4);
constexpr size_t OFF_MERGED = OFF_PK;
constexpr size_t OFF_HM32 = OFF_PR;
constexpr size_t OFF_HN = OFF_PPOOL;
constexpr size_t OFF_WEXP = OFF_PMISC;
constexpr size_t WE_W1 = 0, WE_W3 = (size_t)16 * 256 * 1024, WE_W2 = (size_t)2 * 16 * 256 * 1024;
static_assert((size_t)3 * 16 * 256 * 1024 * 2 <= (size_t)NTP * PM_LD * 2, "expert weights must fit in Pmisc");
constexpr size_t DO_YC = 0;
constexpr size_t DO_CQN = DO_YC + SZ_ACT;
constexpr size_t DO_KV = DO_CQN + AL((size_t)NT * 256 * 2);
constexpr size_t DO_KIDX = DO_KV + AL((size_t)NT * 160 * 2);
constexpr size_t DO_WHEAD = DO_KIDX + AL((size_t)NT * 64 * 2);
constexpr size_t DO_ALR = DO_WHEAD + AL((size_t)NT * 8 * 4);
constexpr size_t DO_END = DO_ALR + AL((size_t)NT * 288 * 2);
constexpr size_t QS_BYTES = (size_t)16 * 16 * 160 * 2;
constexpr int QS_WS = (int)((277240096ull - WS_END) / QS_BYTES), QS_DO = (int)(((size_t)NB * SEQ * DM * 4 - DO_END) / QS_BYTES);
static_assert(QS_WS + QS_DO >= 256, "Q scratch");
constexpr size_t DO_HID = DO_YC;
static_assert(DO_END <= (size_t)NB * SEQ * DM * 4, "d_out scratch overflow");
static_assert((size_t)(129 + 24) * 128 * 512 * 2 <= SZ_ACT, "hid fits");
static_assert(WS_END <= 277240096ull, "workspace overflow");

struct Params {
    const float* in[42];
    float* out;
    unsigned char* ws;
};

__device__ __forceinline__ int otid() { int t = threadIdx.x; asm volatile("" : "+v"(t)); return t; }
__device__ __forceinline__ int obid() { int b = blockIdx.x; asm volatile("" : "+s"(b)); return b; }
typedef __attribute__((address_space(1))) unsigned char gas_uchar;
__device__ __forceinline__ unsigned char* WS(const Params& p) { gas_uchar* w = (gas_uchar*)p.ws; asm volatile("" : "+s"(w)); return (unsigned char*)w; }
__device__ __forceinline__ unsigned char* OUTB(const Params& p) { gas_uchar* w = (gas_uchar*)p.out; asm volatile("" : "+s"(w)); return (unsigned char*)w; }
__device__ __forceinline__ float bf2f(bf16_t v) { return __uint_as_float(((unsigned)v) << 16); }
typedef float f32x2v __attribute__((ext_vector_type(2)));
typedef __bf16 bf16x2v __attribute__((ext_vector_type(2)));
__device__ __forceinline__ unsigned pk2(float a, float b) { const f32x2v v = {a, b}; const bf16x2v r = __builtin_convertvector(v, bf16x2v); unsigned u; __builtin_memcpy(&u, &r, 4); return u; }
__device__ __forceinline__ bf16_t f2bf(float f) { const __bf16 h = (__bf16)f; bf16_t u; __builtin_memcpy(&u, &h, 2); return u; }
__device__ __forceinline__ float wave_sum(float v) {
#pragma unroll
    for (int o = 32; o > 0; o >>= 1) v += __shfl_xor(v, o);
    return v;
}
template <int CTRL> __device__ __forceinline__ float dpp_f(float x) {
    return __int_as_float(__builtin_amdgcn_update_dpp(0, __float_as_int(x), CTRL, 0xF, 0xF, true));
}
__device__ __forceinline__ float row16_sum(float v) {
    v += dpp_f<0xB1>(v);
    v += dpp_f<0x4E>(v);
    v += dpp_f<0x141>(v);
    v += dpp_f<0x140>(v);
    return v;
}
__device__ __forceinline__ void lds_barrier() { asm volatile("s_waitcnt lgkmcnt(0)" ::: "memory"); __builtin_amdgcn_s_barrier(); asm volatile("" ::: "memory"); }
__device__ __forceinline__ float fast_rcp(float x) { return __builtin_amdgcn_rcpf(x); }
__device__ __forceinline__ float fast_sigmoid(float x) { return fast_rcp(1.0f + __expf(-x)); }
__device__ __forceinline__ float fast_tanh(float x) { return 1.0f - 2.0f * fast_rcp(1.0f + __expf(2.0f * x)); }
__device__ __forceinline__ void row16_sum4(float& a, float& b, float& c, float& d) {
    asm volatile(
        "s_nop 1\n\t"
        "v_add_f32_dpp %0, %0, %0 quad_perm:[1,0,3,2] row_mask:0xf bank_mask:0xf\n\t"
        "v_add_f32_dpp %1, %1, %1 quad_perm:[1,0,3,2] row_mask:0xf bank_mask:0xf\n\t"
        "v_add_f32_dpp %2, %2, %2 quad_perm:[1,0,3,2] row_mask:0xf bank_mask:0xf\n\t"
        "v_add_f32_dpp %3, %3, %3 quad_perm:[1,0,3,2] row_mask:0xf bank_mask:0xf\n\t"
        "v_add_f32_dpp %0, %0, %0 quad_perm:[2,3,0,1] row_mask:0xf bank_mask:0xf\n\t"
        "v_add_f32_dpp %1, %1, %1 quad_perm:[2,3,0,1] row_mask:0xf bank_mask:0xf\n\t"
        "v_add_f32_dpp %2, %2, %2 quad_perm:[2,3,0,1] row_mask:0xf bank_mask:0xf\n\t"
        "v_add_f32_dpp %3, %3, %3 quad_perm:[2,3,0,1] row_mask:0xf bank_mask:0xf\n\t"
        "v_add_f32_dpp %0, %0, %0 row_half_mirror row_mask:0xf bank_mask:0xf\n\t"
        "v_add_f32_dpp %1, %1, %1 row_half_mirror row_mask:0xf bank_mask:0xf\n\t"
        "v_add_f32_dpp %2, %2, %2 row_half_mirror row_mask:0xf bank_mask:0xf\n\t"
        "v_add_f32_dpp %3, %3, %3 row_half_mirror row_mask:0xf bank_mask:0xf\n\t"
        "v_add_f32_dpp %0, %0, %0 row_mirror row_mask:0xf bank_mask:0xf\n\t"
        "v_add_f32_dpp %1, %1, %1 row_mirror row_mask:0xf bank_mask:0xf\n\t"
        "v_add_f32_dpp %2, %2, %2 row_mirror row_mask:0xf bank_mask:0xf\n\t"
        "v_add_f32_dpp %3, %3, %3 row_mirror row_mask:0xf bank_mask:0xf\n\t"
        "s_nop 1"
        : "+v"(a), "+v"(b), "+v"(c), "+v"(d));
}
__device__ __forceinline__ void row8_sum2(float& a, float& b) {
    asm volatile(
        "s_nop 1\n\t"
        "v_add_f32_dpp %0, %0, %0 quad_perm:[1,0,3,2] row_mask:0xf bank_mask:0xf\n\t"
        "v_add_f32_dpp %1, %1, %1 quad_perm:[1,0,3,2] row_mask:0xf bank_mask:0xf\n\t"
        "s_nop 0\n\t"
        "v_add_f32_dpp %0, %0, %0 quad_perm:[2,3,0,1] row_mask:0xf bank_mask:0xf\n\t"
        "v_add_f32_dpp %1, %1, %1 quad_perm:[2,3,0,1] row_mask:0xf bank_mask:0xf\n\t"
        "s_nop 0\n\t"
        "v_add_f32_dpp %0, %0, %0 row_half_mirror row_mask:0xf bank_mask:0xf\n\t"
        "v_add_f32_dpp %1, %1, %1 row_half_mirror row_mask:0xf bank_mask:0xf\n\t"
        "s_nop 1"
        : "+v"(a), "+v"(b));
}
__device__ __forceinline__ float xrow_sum(float v) {
    const auto a = __builtin_amdgcn_permlane16_swap(__float_as_uint(v), __float_as_uint(v), false, false);
    v = __uint_as_float(a[0]) + __uint_as_float(a[1]);
    const auto b = __builtin_amdgcn_permlane32_swap(__float_as_uint(v), __float_as_uint(v), false, false);
    return __uint_as_float(b[0]) + __uint_as_float(b[1]);
}
__device__ __forceinline__ float wave_sum_fast(float v) { return xrow_sum(row16_sum(v)); }
__device__ __forceinline__ float sigmoidf_(float x) { return 1.0f / (1.0f + __expf(-x)); }
__device__ __forceinline__ float softplusf_(float z) { return fmaxf(z, 0.f) + log1pf(__expf(-fabsf(z))); }
__device__ __forceinline__ void glds16(const void* g, void* l) {
    __builtin_amdgcn_global_load_lds((const unsigned*)g, (unsigned*)l, 16, 0, 0);
}

__device__ void phase_embed(const Params& p) {
    const int lane = otid() & 63;
    const int wave = (obid() * NTHR + otid()) >> 6, nw = gridDim.x * NTHR / 64;
    bf16_t* h = (bf16_t*)(WS(p) + OFF_H);
    float* rstd = (float*)(WS(p) + OFF_RSTD);
    auto srcrow = [&](int n) { const int b = n / TS, t = n % TS; return t < NMETA ? p.in[1] + (size_t)t * DM : p.in[0] + ((size_t)b * SEQ + (t - NMETA)) * DM; };
    float4 cur[4];
    if (wave < NT) {
        const float* src = srcrow(wave);
#pragma unroll
        for (int i = 0; i < 4; ++i) cur[i] = *(const float4*)(src + i * 256 + lane * 4);
    }
    for (int n = wave; n < NTP; n += nw) {
        if (n < NT) {
            float4 v[4];
#pragma unroll
            for (int i = 0; i < 4; ++i) v[i] = cur[i];
            if (n + nw < NT) {
                const float* src = srcrow(n + nw);
#pragma unroll
                for (int i = 0; i < 4; ++i) cur[i] = *(const float4*)(src + i * 256 + lane * 4);
            }
            float ss = 0.f;
#pragma unroll
            for (int i = 0; i < 4; ++i) {
                ss += v[i].x * v[i].x + v[i].y * v[i].y + v[i].z * v[i].z + v[i].w * v[i].w;
                *(uint2*)(h + (size_t)n * DM + i * 256 + lane * 4) = make_uint2(pk2(v[i].x, v[i].y), pk2(v[i].z, v[i].w));
            }
            ss = wave_sum_fast(ss);
            if (lane == 0) rstd[n] = rsqrtf(ss * (1.0f / 1024.0f) + 1e-6f);
        } else {
#pragma unroll
            for (int i = 0; i < 4; ++i) *(ushort4*)(h + (size_t)n * DM + i * 256 + lane * 4) = make_ushort4(0, 0, 0, 0);
            if (lane == 0) rstd[n] = 0.f;
        }
    }
    float* ctab = (float*)(WS(p) + OFF_ROPE);
    float* stab = ctab + TS * 16;
    for (int idx = obid() * NTHR + otid(); idx < TS * 16; idx += gridDim.x * NTHR) {
        const int t = idx >> 4, i = idx & 15;
        const float inv = powf(10000.0f, -(float)(2 * i) / 32.0f);
        const float ang = (float)t * inv;
        ctab[idx] = cosf(ang);
        stab[idx] = sinf(ang);
    }
}

__device__ void phase_rowstat(const Params& p) {
    const int lane = otid() & 63;
    const int wave = (obid() * NTHR + otid()) >> 6, nw = gridDim.x * NTHR / 64;
    const bf16_t* hb = (const bf16_t*)(WS(p) + OFF_H);
    float* rstd = (float*)(WS(p) + OFF_RSTD);
    uint4 cur[2];
    if (wave < NT) { cur[0] = *(const uint4*)(hb + (size_t)wave * DM + lane * 8); cur[1] = *(const uint4*)(hb + (size_t)wave * DM + 512 + lane * 8); }
    for (int n = wave; n < NT; n += nw) {
        float ss = 0.f;
#pragma unroll
        for (int i = 0; i < 2; ++i) {
            const unsigned w_[4] = {cur[i].x, cur[i].y, cur[i].z, cur[i].w};
#pragma unroll
            for (int j = 0; j < 4; ++j) { const float a_ = __uint_as_float(w_[j] << 16), b_ = __uint_as_float(w_[j] & 0xFFFF0000u); ss += a_ * a_ + b_ * b_; }
        }
        if (n + nw < NT) { cur[0] = *(const uint4*)(hb + (size_t)(n + nw) * DM + lane * 8); cur[1] = *(const uint4*)(hb + (size_t)(n + nw) * DM + 512 + lane * 8); }
        ss = wave_sum_fast(ss);
        if (lane == 0) rstd[n] = rsqrtf(ss * (1.0f / 1024.0f) + 1e-6f);
    }
}

struct ConvJob { const float* src; bf16_t* dst; const float* scale; int ldsrc, K, nvalid, nrows, nb, notr; size_t sbs, dbs; const float* srcB; int ldB, split; };
__device__ __forceinline__ int conv_job_tiles(const ConvJob& j) { return j.nb * (j.nrows >> 6) * (j.K >> 6); }
__device__ void conv_tile(const ConvJob& j, int tile, float* lds) {
    const int per = (j.nrows >> 6) * (j.K >> 6);
    const int bi = tile / per, rem = tile % per;
    const int ktiles = j.K >> 6;
    const int n0 = (rem / ktiles) << 6, k0 = (rem % ktiles) << 6;
    const int tid = otid(), tn = tid & 63, tk = tid >> 6;
    const float* src = j.src + (size_t)bi * j.sbs;
    bf16_t* dst = j.dst + (size_t)bi * j.dbs;
#pragma unroll
    for (int kk = 0; kk < 8; ++kk) {
        const int k = k0 + tk * 8 + kk;
        float v = 0.f;
        if (n0 + tn < j.nvalid) {
            if (j.split) { const int nn = n0 + tn; v = (nn < j.split) ? (j.src ? j.src[(size_t)k * j.ldsrc + nn] : 0.f) : j.srcB[(size_t)k * j.ldB + (nn - j.split)]; }
            else v = j.notr ? src[(size_t)(n0 + tn) * j.ldsrc + k] : src[(size_t)k * j.ldsrc + n0 + tn];
            if (j.scale) v *= j.scale[k];
        }
        lds[tn * 65 + tk * 8 + kk] = v;
    }
    __syncthreads();
    const int wn = tid >> 3, kq = tid & 7;
    uint4 o;
    unsigned w[4];
#pragma unroll
    for (int q = 0; q < 4; ++q) {
        const float lo = lds[wn * 65 + kq * 8 + 2 * q], hi = lds[wn * 65 + kq * 8 + 2 * q + 1];
        w[q] = pk2(lo, hi);
    }
    o.x = w[0]; o.y = w[1]; o.z = w[2]; o.w = w[3];
    *(uint4*)(dst + (size_t)(n0 + wn) * j.K + k0 + kq * 8) = o;
    __syncthreads();
}
__device__ ConvJob get_job_early(const Params& p, int l, int ji) {
    bf16_t* wb = (bf16_t*)(WS(p) + OFF_WB);
    const float* win = p.in[3] + (size_t)l * DM * CIN;
    const float* nm = p.in[2] + (size_t)l * DM;
    ConvJob j{}; j.nb = 1; j.sbs = 0; j.dbs = 0; j.K = 1024; j.ldsrc = CIN; j.scale = nm;
    switch (ji) {
    case 0: j.src = win + 3072; j.dst = wb + WB_WIN; j.nvalid = 4352; j.nrows = 4352; break;
    case 1: j.src = (l == 0 ? nullptr : p.in[17]); j.ldsrc = 32; j.split = 32; j.srcB = win + 7424; j.ldB = CIN; j.dst = wb + WB_WIN + (size_t)(4096 + PM_VD) * 1024; j.nvalid = 512; j.nrows = 512; break;
    case 2: j.src = win + 7904; j.dst = wb + WB_WIDX; j.nvalid = 8; j.nrows = 64; break;
    case 3: j.src = win; j.dst = wb + WB_WG; j.nvalid = 3072; j.nrows = 3072; break;
    case 4: j.src = p.in[29] + (size_t)l * DM * DM; j.ldsrc = 1024; j.scale = nullptr; j.dst = wb + WB_PA; j.nvalid = 1024; j.nrows = 1024; break;
    case 5: j.src = p.in[30] + (size_t)l * DM * DM; j.ldsrc = 1024; j.scale = nullptr; j.dst = wb + WB_PA + (size_t)1024 * 1024; j.nvalid = 1024; j.nrows = 1024; break;
    case 6: j.src = p.in[31] + (size_t)l * DM * DM; j.ldsrc = 1024; j.scale = nullptr; j.dst = wb + WB_PA + (size_t)2 * 1024 * 1024; j.nvalid = 1024; j.nrows = 1024; break;
    case 7: j.src = p.in[32] + (size_t)l * DM * DM; j.ldsrc = 1024; j.scale = nullptr; j.dst = wb + WB_WO; j.nvalid = 1024; j.nrows = 1024; break;
    case 8: j.src = p.in[5] + (size_t)l * 4 * 256 * 256; j.ldsrc = 256; j.K = 256; j.scale = nullptr; j.dst = wb + WB_POOL; j.nvalid = 256; j.nrows = 256; j.nb = 4; j.sbs = 65536; j.dbs = 65536; break;
    case 9: j.src = p.in[26] + (size_t)l * 256 * 512; j.ldsrc = 512; j.K = 256; j.scale = nullptr; j.dst = wb + WB_QI; j.nvalid = 512; j.nrows = 512; break;
    case 10: j.src = p.in[23] + (size_t)l * 256 * 1536; j.ldsrc = 1536; j.K = 256; j.scale = nullptr; j.dst = wb + WB_UQ; j.nvalid = 1536; j.nrows = 1536; break;
    case 11: j.src = p.in[24] + (size_t)l * 16 * 128 * 64; j.ldsrc = 64; j.K = 64; j.scale = nullptr; j.dst = wb + WB_UK; j.nvalid = 2048; j.nrows = 2048; j.notr = 1; break;
    default: j.src = p.in[25] + (size_t)l * 16 * 128 * 64; j.ldsrc = 64; j.K = 128; j.scale = nullptr; j.dst = wb + WB_UV; j.nvalid = 64; j.nrows = 64; j.nb = 16; j.sbs = 8192; j.dbs = 8192; break;
    }
    return j;
}
__device__ ConvJob get_job_late(const Params& p, int l, int ji) {
    bf16_t* we = (bf16_t*)(WS(p) + OFF_WEXP);
    ConvJob j{}; j.nb = 16; j.scale = nullptr; j.sbs = 262144; j.dbs = 262144;
    switch (ji) {
    case 0: j.src = p.in[38] + (size_t)l * 16 * 262144; j.dst = we + WE_W1; j.ldsrc = 256; j.K = 1024; j.nvalid = 256; j.nrows = 256; break;
    case 1: j.src = p.in[39] + (size_t)l * 16 * 262144; j.dst = we + WE_W3; j.ldsrc = 256; j.K = 1024; j.nvalid = 256; j.nrows = 256; break;
    default: j.src = p.in[40] + (size_t)l * 16 * 262144; j.dst = we + WE_W2; j.ldsrc = 1024; j.K = 256; j.nvalid = 1024; j.nrows = 1024; break;
    }
    return j;
}
template <bool LATE>
__device__ void phase_convert(const Params& p, int l, unsigned char* lds) {
    const int njobs = LATE ? 3 : 13;
    int base = 0;
    for (int ji = 0; ji < njobs; ++ji) {
        const ConvJob j = LATE ? get_job_late(p, l, ji) : get_job_early(p, l, ji);
        const int nt = conv_job_tiles(j);
        int first = ((int)obid() - base) % (int)gridDim.x; if (first < 0) first += gridDim.x;
        for (int t = first; t < nt; t += gridDim.x) conv_tile(j, t, (float*)lds);
        base += nt;
    }
}

template <int BM> struct G3 {
    static constexpr int MI = BM / 64;
    static constexpr int NA = BM / 64;
    static constexpr int STAGE = BM * 128 + 128 * 128;
    const bf16_t* ap[NA];
    const bf16_t* bp[2];
};
template <int BM>
__device__ __forceinline__ void g3_issue(const G3<BM>& g, int kt, unsigned char* stage, int tid) {
#pragma unroll
    for (int i = 0; i < G3<BM>::NA; ++i) glds16(g.ap[i] + kt * 64, stage + (tid + i * NTHR) * 16);
#pragma unroll
    for (int i = 0; i < 2; ++i) glds16(g.bp[i] + kt * 64, stage + BM * 128 + (tid + i * NTHR) * 16);
}
template <int BM, class FA, class FB>
__device__ __forceinline__ void g3_setup(G3<BM>& g, FA rowptr, FB bcol, int tid) {
#pragma unroll
    for (int i = 0; i < G3<BM>::NA; ++i) { const int idx = tid + i * NTHR, row = idx >> 3, sl = (idx & 7) ^ (row & 7); g.ap[i] = rowptr(row) + sl * 8; }
#pragma unroll
    for (int i = 0; i < 2; ++i) { const int idx = tid + i * NTHR, row = idx >> 3, sl = (idx & 7) ^ (row & 7); g.bp[i] = bcol(row) + sl * 8; }
}
template <int BM>
__device__ __forceinline__ void g3_kloop(f32x4 (&acc)[BM / 64][4], const G3<BM>& g, int K, unsigned char* lds) {
    constexpr int MI = G3<BM>::MI, STAGE = G3<BM>::STAGE, NL = G3<BM>::NA + 2;
    const int tid = otid(), lane = tid & 63, wid = tid >> 6, wr = wid >> 1, wc = wid & 1, fr = lane & 15, fq = lane >> 4;
    const int nk = K >> 6;
    g3_issue<BM>(g, 0, lds, tid);
    if (nk > 1) g3_issue<BM>(g, 1, lds + STAGE, tid);
    int cur = 0;
#pragma unroll 1
    for (int t = 0; t < nk; ++t) {
        if (t + 1 < nk) { if (NL == 6) asm volatile("s_waitcnt vmcnt(6)" ::: "memory"); else if (NL == 5) asm volatile("s_waitcnt vmcnt(5)" ::: "memory"); else asm volatile("s_waitcnt vmcnt(4)" ::: "memory"); }
        else asm volatile("s_waitcnt vmcnt(0)" ::: "memory");
        __builtin_amdgcn_s_barrier();
        if (t + 2 < nk) { int nx = cur + 2; if (nx >= 3) nx -= 3; g3_issue<BM>(g, t + 2, lds + nx * STAGE, tid); }
        const unsigned char* cA = lds + cur * STAGE;
        const unsigned char* cB = cA + BM * 128;
#pragma unroll
        for (int ks = 0; ks < 2; ++ks) {
            bf16x8 a[MI], b[4];
#pragma unroll
            for (int m = 0; m < MI; ++m) { const int row = wr * (BM / 4) + m * 16 + fr; a[m] = *(const bf16x8*)(cA + row * 128 + (((ks * 4 + fq) ^ (row & 7)) << 4)); }
#pragma unroll
            for (int n = 0; n < 4; ++n) { const int row = wc * 64 + n * 16 + fr; b[n] = *(const bf16x8*)(cB + row * 128 + (((ks * 4 + fq) ^ (row & 7)) << 4)); }
#pragma unroll
            for (int m = 0; m < MI; ++m)
#pragma unroll
                for (int n = 0; n < 4; ++n) acc[m][n] = __builtin_amdgcn_mfma_f32_16x16x32_bf16(b[n], a[m], acc[m][n], 0, 0, 0);
        }
        cur = (cur == 2) ? 0 : cur + 1;
    }
    __builtin_amdgcn_s_barrier();
}
struct G3D { const bf16_t* ap[2]; const bf16_t* b1[2]; const bf16_t* b3[2]; };
__device__ __forceinline__ void g3d_issue(const G3D& g, int kt, unsigned char* stage, int tid) {
#pragma unroll
    for (int i = 0; i < 2; ++i) glds16(g.ap[i] + kt * 64, stage + (tid + i * NTHR) * 16);
#pragma unroll
    for (int i = 0; i < 2; ++i) glds16(g.b1[i] + kt * 64, stage + 16384 + (tid + i * NTHR) * 16);
#pragma unroll
    for (int i = 0; i < 2; ++i) glds16(g.b3[i] + kt * 64, stage + 32768 + (tid + i * NTHR) * 16);
}
__device__ __forceinline__ void g3d_kloop(f32x4 (&acc1)[2][4], f32x4 (&acc3)[2][4], const G3D& g, int K, unsigned char* lds) {
    constexpr int STAGE = 49152;
    const int tid = otid(), lane = tid & 63, wid = tid >> 6, wr = wid >> 1, wc = wid & 1, fr = lane & 15, fq = lane >> 4;
    const int nk = K >> 6;
    g3d_issue(g, 0, lds, tid);
    if (nk > 1) g3d_issue(g, 1, lds + STAGE, tid);
    int cur = 0;
#pragma unroll 1
    for (int t = 0; t < nk; ++t) {
        if (t + 1 < nk) asm volatile("s_waitcnt vmcnt(6)" ::: "memory"); else asm volatile("s_waitcnt vmcnt(0)" ::: "memory");
        __builtin_amdgcn_s_barrier();
        if (t + 2 < nk) { int nx = cur + 2; if (nx >= 3) nx -= 3; g3d_issue(g, t + 2, lds + nx * STAGE, tid); }
        const unsigned char* cA = lds + cur * STAGE;
#pragma unroll
        for (int ks = 0; ks < 2; ++ks) {
            bf16x8 a[2], b1[4], b3[4];
#pragma unroll
            for (int m = 0; m < 2; ++m) { const int row = wr * 32 + m * 16 + fr; a[m] = *(const bf16x8*)(cA + row * 128 + (((ks * 4 + fq) ^ (row & 7)) << 4)); }
#pragma unroll
            for (int n = 0; n < 4; ++n) { const int row = wc * 64 + n * 16 + fr; const int off = row * 128 + (((ks * 4 + fq) ^ (row & 7)) << 4);
                b1[n] = *(const bf16x8*)(cA + 16384 + off); b3[n] = *(const bf16x8*)(cA + 32768 + off); }
#pragma unroll
            for (int m = 0; m < 2; ++m)
#pragma unroll
                for (int n = 0; n < 4; ++n) {
                    acc1[m][n] = __builtin_amdgcn_mfma_f32_16x16x32_bf16(b1[n], a[m], acc1[m][n], 0, 0, 0);
                    acc3[m][n] = __builtin_amdgcn_mfma_f32_16x16x32_bf16(b3[n], a[m], acc3[m][n], 0, 0, 0);
                }
        }
        cur = (cur == 2) ? 0 : cur + 1;
    }
    __builtin_amdgcn_s_barrier();
}
template <int MI>
__device__ __forceinline__ void g3_zero(f32x4 (&acc)[MI][4]) {
#pragma unroll
    for (int m = 0; m < MI; ++m)
#pragma unroll
        for (int n = 0; n < 4; ++n) acc[m][n] = (f32x4){0.f, 0.f, 0.f, 0.f};
}
__device__ __forceinline__ uint2 pack4(float a, float b, float c, float d) {
    uint2 r; r.x = pk2(a, b); r.y = pk2(c, d); return r;
}

namespace pg8 {
#define PG8_LAS __attribute__((address_space(3)))
typedef unsigned short bf16_t;
typedef short bf16x8 __attribute__((ext_vector_type(8)));
typedef float f32x4 __attribute__((ext_vector_type(4)));
typedef unsigned u32x4 __attribute__((ext_vector_type(4)));
constexpr int BM = 256, BK = 64, HALF = 128, HTB = HALF * BK * 2  , STAGE_BYTES = 8 * HTB, NXCD = 8, WGM = 8;

__host__ __device__ __forceinline__ int lds_byte(int r, int c) { const int st = (r >> 4) * 2 + (c >> 5), rr = r & 15, cc = c & 31, ob = rr * 64 + cc * 2; return st * 1024 + (ob ^ (((ob >> 9) & 1) << 5)); }
__host__ __device__ __forceinline__ void stage_rc(int b, int& R, int& C) { const int st = b / 1024, sb = b % 1024, swz = sb ^ (((sb >> 9) & 1) << 5); R = (st >> 1) * 16 + swz / 64; C = (st & 1) * 32 + (swz % 64) / 2; }
__host__ __device__ __forceinline__ int perm32(int rho) { const int n = rho >> 4, i = rho & 15; return 8 * (i >> 2) + 4 * n + (i & 3); }

struct Unit { int pm, pn; };
struct Gemm { const bf16_t* A; const bf16_t* Bt; int M, N, K; };

struct StaticOrder {
    int nM, nN, nwg, G, c;
    __host__ __device__ void init(int M, int N, int G_, int c_) { nM = M / BM; nN = N / BM; nwg = nM * nN; G = G_; c = c_; }
    __host__ __device__ bool next(int i, Unit& u) const {
        const long L = (long)i * G + c; if (L >= nwg) return false;
        int wgid = (int)L; { const int q = nwg / NXCD, r = nwg % NXCD, xcd = wgid % NXCD, off = wgid / NXCD; wgid = (xcd < r ? xcd * (q + 1) : r * (q + 1) + (xcd - r) * q) + off; }
        const int nig = WGM * nN, gid = wgid / nig, fm = gid * WGM, gsz = (nM - fm) < WGM ? (nM - fm) : WGM;
        u.pm = fm + ((wgid % nig) % gsz); u.pn = (wgid % nig) / gsz; return true;
    }
    __device__ __forceinline__ void a_ready(const Unit&) const {}
    __device__ __forceinline__ void done(const Unit&) const {}
};
template <class Epi, class Sched, bool STAMP = false>
__device__ __forceinline__ void gemm_phase(PG8_LAS unsigned char* lds, const Gemm g, const Sched& S, const Epi& E, unsigned long long* stamps) {
    const int tid = otid(), wid = __builtin_amdgcn_readfirstlane(tid >> 6), lane = tid & 63, wr = wid >> 2, wc = wid & 3, fr = lane & 15, fq = lane >> 4;
    const int K = g.K, nt = K / BK;
    int ts_lo = 0, ts_hi = 0, nts = 0; const unsigned long long rt_entry = STAMP ? 0ull : 0ull;
#define PG8_STAMP() do { if (STAMP && wid == 0 && nts < 64) { const unsigned long long _c = 0ull; \
        ts_lo = (lane == nts) ? (int)(unsigned)_c : ts_lo; ts_hi = (lane == nts) ? (int)(unsigned)(_c >> 32) : ts_hi; ++nts; } } while (0)
    PG8_STAMP();
    unsigned voffA[2], voffB[2];
#pragma unroll
    for (int i = 0; i < 2; ++i) { int R, C; stage_rc(tid * 16 + i * 8192, R, C); const int Rb = Epi::PERM ? ((R & ~31) + perm32(R & 31)) : R;
        voffA[i] = (unsigned)(R * K + C) * 2u; voffB[i] = (unsigned)(Rb * K + C) * 2u; }
    const size_t kstep = (size_t)(BK * 2);
    const size_t hstep = (size_t)HALF * K * 2;
    const size_t tstep = 2 * hstep;
    const unsigned ldsw = (unsigned)wid * 1024u;
    const int aoff = lds_byte(wr * 64 + fr, fq * 8), boff = lds_byte(wc * 32 + fr, fq * 8);
#define PG8_SA(b, h) (((b) * 2 + (h)) * HTB)
#define PG8_SB(b, h) ((4 + (b) * 2 + (h)) * HTB)
#define PG8_STAGE(bufoff, gbase, voff) do { _Pragma("unroll") for (int _i = 0; _i < 2; ++_i) \
        __builtin_amdgcn_global_load_lds((const unsigned*)((const char*)(gbase) + (voff)[_i]), (PG8_LAS unsigned*)(lds + (bufoff) + ldsw + _i * 8192), 16, 0, 0); } while (0)
#define PG8_LDA(dst, b, h) do { _Pragma("unroll") for (int m = 0; m < 4; ++m) _Pragma("unroll") for (int k = 0; k < 2; ++k) dst[m][k] = *(const PG8_LAS bf16x8*)(lds + PG8_SA(b, h) + aoff + m * 2048 + k * 1024); } while (0)
#define PG8_LDB(dst, b, h) do { _Pragma("unroll") for (int n = 0; n < 2; ++n) _Pragma("unroll") for (int k = 0; k < 2; ++k) dst[n][k] = *(const PG8_LAS bf16x8*)(lds + PG8_SB(b, h) + boff + n * 2048 + k * 1024); } while (0)
#define PG8_MMA(ai, bj, At, Bt) do { __builtin_amdgcn_s_setprio(1); _Pragma("unroll") for (int m = 0; m < 4; ++m) _Pragma("unroll") for (int n = 0; n < 2; ++n) _Pragma("unroll") for (int k = 0; k < 2; ++k) \
        acc[ai][bj][m][n] = __builtin_amdgcn_mfma_f32_16x16x32_bf16(Bt[n][k], At[m][k], acc[ai][bj][m][n], 0, 0, 0); __builtin_amdgcn_s_setprio(0); } while (0)
#define PG8_WAIT_V(n) asm volatile("s_waitcnt vmcnt(" #n ")" ::: "memory")
#define PG8_WAIT_L(n) asm volatile("s_waitcnt lgkmcnt(" #n ")" ::: "memory")
#define PG8_BAR __builtin_amdgcn_s_barrier()
#define PG8_SCHED __builtin_amdgcn_sched_barrier(0)
    Unit cur, nxt; int ui = 0;
    if (!S.next(0, cur)) return;
    f32x4 acc[2][2][4][2];
#pragma unroll
    for (int a = 0; a < 2; ++a)
#pragma unroll
        for (int b = 0; b < 2; ++b)
#pragma unroll
            for (int m = 0; m < 4; ++m)
#pragma unroll
                for (int n = 0; n < 2; ++n) acc[a][b][m][n] = (f32x4){0.f, 0.f, 0.f, 0.f};
    bf16x8 At[4][2], B0[2][2], B1[2][2];
    const char* cA = (const char*)g.A + (size_t)cur.pm * tstep; const char* cB = (const char*)g.Bt + (size_t)cur.pn * tstep;
    S.a_ready(cur);
    PG8_STAGE(PG8_SB(0, 0), cB, voffB); PG8_STAGE(PG8_SA(0, 0), cA, voffA); PG8_STAGE(PG8_SB(0, 1), cB + hstep, voffB); PG8_STAGE(PG8_SA(0, 1), cA + hstep, voffA);
    if (wr == 1) PG8_BAR;
    PG8_WAIT_V(4); PG8_BAR;
    PG8_STAGE(PG8_SB(1, 0), cB + kstep, voffB); PG8_STAGE(PG8_SA(1, 0), cA + kstep, voffA); PG8_STAGE(PG8_SB(1, 1), cB + hstep + kstep, voffB);
    PG8_WAIT_V(6); PG8_BAR;
    PG8_STAMP();
    for (;;) {
        const bool has_next = S.next(ui + 1, nxt);
        const char* nA = has_next ? (const char*)g.A + (size_t)nxt.pm * tstep : cA; const char* nB = has_next ? (const char*)g.Bt + (size_t)nxt.pn * tstep : cB;
        for (int t = 0; t < nt; t += 2) {
            const bool last = (t == nt - 2);
            const char* a1 = cA + (size_t)(t + 1) * kstep;
            const char* a2 = last ? nA : cA + (size_t)(t + 2) * kstep; const char* b2 = last ? nB : cB + (size_t)(t + 2) * kstep;
            const char* a3 = a2 + kstep; const char* b3 = b2 + kstep;
            if (last && has_next) S.a_ready(nxt);
            PG8_LDB(B0, 0, 0); PG8_SCHED; PG8_LDA(At, 0, 0); PG8_STAGE(PG8_SA(1, 1), a1 + hstep, voffA);
            PG8_WAIT_L(8); PG8_BAR; PG8_WAIT_L(0); PG8_MMA(0, 0, At, B0); PG8_BAR; PG8_SCHED;
            PG8_LDB(B1, 0, 1); PG8_STAGE(PG8_SB(0, 0), b2, voffB);
            PG8_BAR; PG8_WAIT_L(0); PG8_MMA(0, 1, At, B1); PG8_BAR;
            PG8_LDA(At, 0, 1); PG8_STAGE(PG8_SA(0, 0), a2, voffA);
            PG8_BAR; PG8_WAIT_L(0); PG8_MMA(1, 0, At, B0); PG8_BAR; PG8_SCHED;
            PG8_STAGE(PG8_SB(0, 1), b2 + hstep, voffB);
            PG8_WAIT_V(6); PG8_BAR; PG8_MMA(1, 1, At, B1); PG8_BAR;
            PG8_LDB(B0, 1, 0); PG8_SCHED; PG8_LDA(At, 1, 0); PG8_STAGE(PG8_SA(0, 1), a2 + hstep, voffA);
            PG8_WAIT_L(8); PG8_BAR; PG8_WAIT_L(0); PG8_MMA(0, 0, At, B0); PG8_BAR; PG8_SCHED;
            PG8_LDB(B1, 1, 1); PG8_STAGE(PG8_SB(1, 0), b3, voffB);
            PG8_BAR; PG8_WAIT_L(0); PG8_MMA(0, 1, At, B1); PG8_BAR;
            PG8_LDA(At, 1, 1); PG8_STAGE(PG8_SA(1, 0), a3, voffA);
            PG8_BAR; PG8_WAIT_L(0); PG8_MMA(1, 0, At, B0); PG8_BAR; PG8_SCHED;
            PG8_STAGE(PG8_SB(1, 1), b3 + hstep, voffB);
            PG8_WAIT_V(6); PG8_BAR; PG8_MMA(1, 1, At, B1); PG8_BAR;
        }
        PG8_STAMP();
        if constexpr (!Epi::AFTER_DRAIN) { E(acc, cur, wr, wc, fr, fq); S.done(cur); }
        PG8_STAMP();
        if (!has_next) break;
#pragma unroll
        for (int a = 0; a < 2; ++a)
#pragma unroll
            for (int b = 0; b < 2; ++b)
#pragma unroll
                for (int m = 0; m < 4; ++m)
#pragma unroll
                    for (int n = 0; n < 2; ++n) acc[a][b][m][n] = (f32x4){0.f, 0.f, 0.f, 0.f};
        cur = nxt; cA = nA; cB = nB; ++ui;
    }
    PG8_WAIT_V(0);
    if (wr == 0) PG8_BAR;
    PG8_BAR;
    if constexpr (Epi::AFTER_DRAIN) { E.fused(acc, cur, wr, wc, fr, fq, lds, wid, lane); S.done(cur); }
    PG8_STAMP();
    if (STAMP && wid == 0) { stamps[lane] = lane < nts ? (((unsigned long long)(unsigned)ts_hi << 32) | (unsigned)ts_lo) : 0ull;
        if (lane == 62) stamps[62] = rt_entry; if (lane == 63) stamps[63] = 0ull; }
#undef PG8_STAMP
#undef PG8_SA
#undef PG8_SB
#undef PG8_STAGE
#undef PG8_LDA
#undef PG8_LDB
#undef PG8_MMA
#undef PG8_WAIT_V
#undef PG8_WAIT_L
#undef PG8_BAR
#undef PG8_SCHED
}
}

struct EpiInproj {
    static constexpr bool PERM = true, AFTER_DRAIN = false;
    unsigned char* ws; const float* rstd;
    __device__ __forceinline__ void operator()(const pg8::f32x4 (&acc)[2][2][4][2], const pg8::Unit& u, int wr, int wc, int fr, int fq) const {
        const int pn = u.pn;
        bf16_t* dst; int ld, cb;
        if (pn < 4) { dst = (bf16_t*)(ws + OFF_PPOOL); ld = 1024; cb = pn * 256; }
        else if (pn < 8) { dst = (bf16_t*)(ws + OFF_PR); ld = 1024; cb = (pn - 4) * 256; }
        else if (pn < 12) { dst = (bf16_t*)(ws + OFF_PK); ld = 1024; cb = (pn - 8) * 256; }
        else if (pn < 16) { dst = (bf16_t*)(ws + OFF_PV); ld = 1024; cb = (pn - 12) * 256; }
        else { dst = (bf16_t*)(ws + OFF_PMISC); ld = PM_LD; cb = (pn - 16) * 256; }
        bf16_t* halo = (bf16_t*)(ws + OFF_HALO);
        float rsv[2][4];
#pragma unroll
        for (int ai = 0; ai < 2; ++ai)
#pragma unroll
            for (int m = 0; m < 4; ++m) { const int row = u.pm * 256 + ai * 128 + wr * 64 + m * 16 + fr; rsv[ai][m] = (row < NT) ? rstd[row] : 0.f; }
#pragma unroll
        for (int ai = 0; ai < 2; ++ai)
#pragma unroll
            for (int m = 0; m < 4; ++m) {
                const int row = u.pm * 256 + ai * 128 + wr * 64 + m * 16 + fr;
                if (row < NT) {
                    const float rs = rsv[ai][m];
                    const int lr = row & 127;
#pragma unroll
                    for (int bj = 0; bj < 2; ++bj) {
                        const int col = cb + bj * 128 + wc * 32 + fq * 8;
                        const uint2 lo = pack4(acc[ai][bj][m][0][0] * rs, acc[ai][bj][m][0][1] * rs, acc[ai][bj][m][0][2] * rs, acc[ai][bj][m][0][3] * rs);
                        const uint2 hi = pack4(acc[ai][bj][m][1][0] * rs, acc[ai][bj][m][1][1] * rs, acc[ai][bj][m][1][2] * rs, acc[ai][bj][m][1][3] * rs);
                        const uint4 v = make_uint4(lo.x, lo.y, hi.x, hi.y);
                        *(uint4*)(dst + (size_t)row * ld + col) = v;
                        if (pn < 4 && lr >= 112) *(uint4*)(halo + ((size_t)(row >> 7) * 16 + (lr - 112)) * 1024 + col) = v;
                    }
                }
            }
    }
};
__device__ void phase_inproj(const Params& p, unsigned char* lds) {
    pg8::StaticOrder S; S.init(NTP, NP1, (int)gridDim.x, obid());
    pg8::Gemm g; g.A = (const pg8::bf16_t*)(WS(p) + OFF_H); g.Bt = (const pg8::bf16_t*)(WS(p) + OFF_WB) + WB_WIN; g.M = NTP; g.N = NP1; g.K = DM;
    EpiInproj E; E.ws = WS(p); E.rstd = (const float*)(WS(p) + OFF_RSTD);
    pg8::gemm_phase<EpiInproj, pg8::StaticOrder, false>((PG8_LAS unsigned char*)lds, g, S, E, nullptr);
}

__device__ void phase_pool(const Params& p, int l, unsigned char* lds, int tb, int te, int tstep) {
    const int tid = otid(), lane = tid & 63, wid = tid >> 6, fr = lane & 15, fq = lane >> 4;
    bf16_t* pp = (bf16_t*)(WS(p) + OFF_PPOOL);
    const bf16_t* halo = (const bf16_t*)(WS(p) + OFF_HALO);
    const bf16_t* pw = (const bf16_t*)(WS(p) + OFF_WB) + WB_POOL;
    const float* scale = p.in[6] + (size_t)l * 1024;
    bf16_t* sp = (bf16_t*)lds;
    constexpr int SLD = 264;
    bf16_t* sraw = sp + 128 * SLD;
    for (int tile = tb; tile < te; tile += tstep) {
        const int mt = tile >> 2, g = tile & 3;
        const int row0 = mt * 128, w = 2 << g;
        const bf16_t* wg = pw + (size_t)g * 65536;
        bf16x8 bfr[8][2];
#pragma unroll
        for (int kk = 0; kk < 8; ++kk)
#pragma unroll
            for (int n = 0; n < 2; ++n) bfr[kk][n] = *(const bf16x8*)(wg + (size_t)(wid * 32 + n * 16 + fr) * 256 + kk * 32 + fq * 8);
        {
            for (int e = tid; e < 144 * 32; e += NTHR) {
                const int rr = e >> 5, c16 = e & 31;
                uint4 v = make_uint4(0u, 0u, 0u, 0u);
                if (rr >= 16) v = *(const uint4*)(pp + (size_t)(row0 + rr - 16) * 1024 + g * 256 + c16 * 8);
                else if (mt > 0) v = *(const uint4*)(halo + ((size_t)(mt - 1) * 16 + rr) * 1024 + g * 256 + c16 * 8);
                *(uint4*)(sraw + rr * 256 + c16 * 8) = v;
            }
        }
        __syncthreads();
        {
            const int c = tid & 255, r0 = (tid >> 8) * 64;
            auto rawv = [&](int nrel) -> float { return bf2f(sraw[(nrel + 16) * 256 + c]); };
            int t = (row0 + r0) % TS;
            float sum = 0.f;
            const int have = (t < w) ? t : w;
            for (int i = 1; i <= have; ++i) sum += rawv(r0 - i);
#pragma unroll 8
            for (int r = 0; r < 64; ++r) {
                if (t == 0) sum = 0.f;
                const float v = rawv(r0 + r);
                sum += v;
                if (t >= w) sum -= rawv(r0 + r - w);
                const int cnt = (t + 1 < w) ? (t + 1) : w;
                sp[(r0 + r) * SLD + c] = f2bf(sum * (1.0f / (float)cnt) - v);
                t = (t + 1 == TS) ? 0 : t + 1;
            }
        }
        __syncthreads();
        f32x4 acc[8][2];
#pragma unroll
        for (int m = 0; m < 8; ++m) { acc[m][0] = (f32x4){0.f, 0.f, 0.f, 0.f}; acc[m][1] = (f32x4){0.f, 0.f, 0.f, 0.f}; }
#pragma unroll
        for (int kk = 0; kk < 8; ++kk) {
#pragma unroll
            for (int m = 0; m < 8; ++m) {
                const bf16x8 a = *(const bf16x8*)(sp + (m * 16 + fr) * SLD + kk * 32 + fq * 8);
                acc[m][0] = __builtin_amdgcn_mfma_f32_16x16x32_bf16(bfr[kk][0], a, acc[m][0], 0, 0, 0);
                acc[m][1] = __builtin_amdgcn_mfma_f32_16x16x32_bf16(bfr[kk][1], a, acc[m][1], 0, 0, 0);
            }
        }
#pragma unroll
        for (int n = 0; n < 2; ++n) {
            const int col = g * 256 + wid * 32 + n * 16 + fq * 4;
            const float4 sc = *(const float4*)(scale + col);
#pragma unroll
            for (int m = 0; m < 8; ++m) {
                const int row = row0 + m * 16 + fr;
                *(uint2*)(pp + (size_t)row * 1024 + col) = pack4(acc[m][n][0] * sc.x, acc[m][n][1] * sc.y, acc[m][n][2] * sc.z, acc[m][n][3] * sc.w);
            }
        }
        __syncthreads();
    }
}

__device__ void phase_dsa_prep(const Params& p, int l) {
    const int lane = otid() & 63;
    const int wave = (obid() * NTHR + otid()) >> 6, nw = gridDim.x * NTHR / 64;
    const bf16_t* pm = (const bf16_t*)(WS(p) + OFF_PMISC);
    unsigned char* dob = OUTB(p);
    bf16_t* cqn = (bf16_t*)(dob + DO_CQN);
    bf16_t* kv = (bf16_t*)(dob + DO_KV);
    bf16_t* kidx = (bf16_t*)(dob + DO_KIDX);
    float* whead = (float*)(dob + DO_WHEAD);
    const float* ctab = (const float*)(WS(p) + OFF_ROPE);
    const float* stab = ctab + TS * 16;
    const bf16_t* hrow = (const bf16_t*)(WS(p) + OFF_H);
    const bf16_t* wwidx = (const bf16_t*)(WS(p) + OFF_WB) + WB_WIDX;
    const float* rstd_ = (const float*)(WS(p) + OFF_RSTD);
    const float4 qn4 = *(const float4*)(p.in[21] + l * 256 + lane * 4);
    const float2 kvn2 = *(const float2*)(p.in[22] + l * 128 + lane * 2);
    const float inw = p.in[27][l * 64 + lane], inb = p.in[28][l * 64 + lane];
    uint4 ww[8][2];
#pragma unroll
    for (int j = 0; j < 8; ++j) { ww[j][0] = *(const uint4*)(wwidx + (size_t)j * DM + lane * 16); ww[j][1] = *(const uint4*)(wwidx + (size_t)j * DM + lane * 16 + 8); }
    struct In { uint2 cq; unsigned ckv; bf16_t kr0, kr1, kix; uint4 h0, h1; float rs, c, s; };
    auto load = [&](int n) {
        In r;
        const bf16_t* row = pm + (size_t)n * PM_LD;
        const int t = n % TS;
        r.cq = *(const uint2*)(row + PM_CQ + lane * 4);
        r.ckv = *(const unsigned*)(row + PM_CKV + lane * 2);
        r.kr0 = row[PM_KROPE + (lane & 15)]; r.kr1 = row[PM_KROPE + 16 + (lane & 15)];
        r.kix = row[PM_KIDX + lane];
        r.h0 = *(const uint4*)(hrow + (size_t)n * DM + lane * 16); r.h1 = *(const uint4*)(hrow + (size_t)n * DM + lane * 16 + 8);
        r.rs = rstd_[n];
        r.c = ctab[t * 16 + (lane & 15)]; r.s = stab[t * 16 + (lane & 15)];
        return r;
    };
    In cur = load(wave < NT ? wave : 0);
    for (int n = wave; n < NT; n += nw) {
        const In x = cur;
        if (n + nw < NT) cur = load(n + nw);
        {
            const float v0 = __uint_as_float(x.cq.x << 16), v1 = __uint_as_float(x.cq.x & 0xFFFF0000u), v2 = __uint_as_float(x.cq.y << 16), v3 = __uint_as_float(x.cq.y & 0xFFFF0000u);
            const float ss = wave_sum_fast(v0 * v0 + v1 * v1 + v2 * v2 + v3 * v3);
            const float rs = rsqrtf(ss * (1.0f / 256.0f) + 1e-6f);
            *(uint2*)(cqn + (size_t)n * 256 + lane * 4) = pack4(v0 * rs * qn4.x, v1 * rs * qn4.y, v2 * rs * qn4.z, v3 * rs * qn4.w);
        }
        {
            const float v0 = __uint_as_float(x.ckv << 16), v1 = __uint_as_float(x.ckv & 0xFFFF0000u);
            const float ss = wave_sum_fast(v0 * v0 + v1 * v1);
            const float rs = rsqrtf(ss * (1.0f / 128.0f) + 1e-6f);
            *(unsigned*)(kv + (size_t)n * 160 + lane * 2) = pk2(v0 * rs * kvn2.x, v1 * rs * kvn2.y);
        }
        if (lane < 16) {
            const float x1 = bf2f(x.kr0), x2 = bf2f(x.kr1);
            kv[(size_t)n * 160 + 128 + lane] = f2bf(x1 * x.c - x2 * x.s);
            kv[(size_t)n * 160 + 144 + lane] = f2bf(x2 * x.c + x1 * x.s);
        }
        {
            const float xv = bf2f(x.kix);
            const float mu = wave_sum_fast(xv) * (1.0f / 64.0f);
            const float d = xv - mu;
            const float var = wave_sum_fast(d * d) * (1.0f / 64.0f);
            const float y = d * rsqrtf(var + 1e-6f) * inw + inb;
            const float yo = __shfl_xor(y, 16);
            float o = y;
            if (lane < 32) o = (lane < 16) ? (y * x.c - yo * x.s) : (y * x.c + yo * x.s);
            kidx[(size_t)n * 64 + lane] = f2bf(o);
        }
        {
            const uint4 hv0 = x.h0, hv1 = x.h1;
            float hx[16];
            hx[0] = __uint_as_float(hv0.x << 16); hx[1] = __uint_as_float(hv0.x & 0xFFFF0000u); hx[2] = __uint_as_float(hv0.y << 16); hx[3] = __uint_as_float(hv0.y & 0xFFFF0000u);
            hx[4] = __uint_as_float(hv0.z << 16); hx[5] = __uint_as_float(hv0.z & 0xFFFF0000u); hx[6] = __uint_as_float(hv0.w << 16); hx[7] = __uint_as_float(hv0.w & 0xFFFF0000u);
            hx[8] = __uint_as_float(hv1.x << 16); hx[9] = __uint_as_float(hv1.x & 0xFFFF0000u); hx[10] = __uint_as_float(hv1.y << 16); hx[11] = __uint_as_float(hv1.y & 0xFFFF0000u);
            hx[12] = __uint_as_float(hv1.z << 16); hx[13] = __uint_as_float(hv1.z & 0xFFFF0000u); hx[14] = __uint_as_float(hv1.w << 16); hx[15] = __uint_as_float(hv1.w & 0xFFFF0000u);
            float myw = 0.f;
#pragma unroll
            for (int j = 0; j < 8; ++j) {
                const uint4 w0 = ww[j][0], w1 = ww[j][1];
                float d = hx[0] * __uint_as_float(w0.x << 16) + hx[1] * __uint_as_float(w0.x & 0xFFFF0000u) + hx[2] * __uint_as_float(w0.y << 16) + hx[3] * __uint_as_float(w0.y & 0xFFFF0000u)
                        + hx[4] * __uint_as_float(w0.z << 16) + hx[5] * __uint_as_float(w0.z & 0xFFFF0000u) + hx[6] * __uint_as_float(w0.w << 16) + hx[7] * __uint_as_float(w0.w & 0xFFFF0000u)
                        + hx[8] * __uint_as_float(w1.x << 16) + hx[9] * __uint_as_float(w1.x & 0xFFFF0000u) + hx[10] * __uint_as_float(w1.y << 16) + hx[11] * __uint_as_float(w1.y & 0xFFFF0000u)
                        + hx[12] * __uint_as_float(w1.z << 16) + hx[13] * __uint_as_float(w1.z & 0xFFFF0000u) + hx[14] * __uint_as_float(w1.w << 16) + hx[15] * __uint_as_float(w1.w & 0xFFFF0000u);
                d = wave_sum_fast(d);
                myw = (lane == j) ? d : myw;
            }
            if (lane < 8) whead[(size_t)n * 8 + lane] = myw * x.rs * 0.04419417382415922f;
        }
    }
}

typedef short s16x4 __attribute__((ext_vector_type(4)));
__device__ __forceinline__ unsigned f2h_bits(float f) { const _Float16 h = (_Float16)f; unsigned short u; __builtin_memcpy(&u, &h, 2); return u; }
template <bool IMPORT_SEL>
__device__ void phase_dsa(const Params& p, int l, unsigned char* lds, bf16_t* yc, const unsigned short* gsel, const int* gnsel, int tb, int te, int tstep) {
    unsigned short* s_sc = (unsigned short*)lds;
    bf16_t* s_qi = (bf16_t*)(lds + 66048);
    bf16_t* s_Q = (bf16_t*)lds;
    unsigned short* s_sel = (unsigned short*)(lds + 82432 + 65536);
    int* s_nsel = (int*)(lds + 82432 + 65536 + 8192);
    unsigned char* dob = OUTB(p);
    const bf16_t* cqn = (const bf16_t*)(dob + DO_CQN);
    const bf16_t* kv = (const bf16_t*)(dob + DO_KV);
    const bf16_t* kidx = (const bf16_t*)(dob + DO_KIDX);
    const float* whead = (const float*)(dob + DO_WHEAD);
    const float* ctab = (const float*)(WS(p) + OFF_ROPE);
    const float* stab = ctab + TS * 16;
    const bf16_t* wb = (const bf16_t*)(WS(p) + OFF_WB);
    const bf16_t* wqiT = wb + WB_QI;
    const bf16_t* wuqT = wb + WB_UQ;
    const bf16_t* wuk = wb + WB_UK;
    const bf16_t* wuvT = wb + WB_UV;
    const float scale = 0.10206207261596575f;
    const f32x4 z4 = {0.f, 0.f, 0.f, 0.f};
    bf16_t* gq = (obid() < QS_WS) ? (bf16_t*)(WS(p) + WS_END + (size_t)obid() * QS_BYTES) : (bf16_t*)(OUTB(p) + DO_END + (size_t)(obid() - QS_WS) * QS_BYTES);
    for (int pair = tb; pair < te; pair += tstep) {
        const int qt = 128 - (pair >> 2);
        const int t0 = qt * 16;
        uint2 qiB[4] = {make_uint2(0u, 0u), make_uint2(0u, 0u), make_uint2(0u, 0u), make_uint2(0u, 0u)};
#pragma unroll 1
        for (int half = 0; half < 2; ++half) {
        const int tid = otid(), lane = tid & 63, wid = tid >> 6, fr = lane & 15, fq = lane >> 4;
        unsigned char* s_Vw = lds + 82432 + wid * 8192;
        bf16_t* s_qn = (bf16_t*)s_Vw;
        const int b = (pair & 3) * 2 + half;
        const size_t n0 = (size_t)b * TS + t0;
        if (half == 0) {
            bf16x8 acq[8], acqB[8];
#pragma unroll
            for (int kk = 0; kk < 8; ++kk) { acq[kk] = *(const bf16x8*)(cqn + (n0 + fr) * 256 + kk * 32 + fq * 8); acqB[kk] = *(const bf16x8*)(cqn + (n0 + TS + fr) * 256 + kk * 32 + fq * 8); }
            f32x4 c[4] = {z4, z4, z4, z4}, cB[4] = {z4, z4, z4, z4};
#pragma unroll
            for (int kb = 0; kb < 8; kb += 4) {
                bf16x8 bf[4][4];
#pragma unroll
                for (int k4 = 0; k4 < 4; ++k4)
#pragma unroll
                    for (int nt = 0; nt < 4; ++nt) bf[k4][nt] = *(const bf16x8*)(wqiT + (size_t)(wid * 64 + nt * 16 + fr) * 256 + (kb + k4) * 32 + fq * 8);
#pragma unroll
                for (int k4 = 0; k4 < 4; ++k4)
#pragma unroll
                    for (int nt = 0; nt < 4; ++nt) {
                        c[nt] = __builtin_amdgcn_mfma_f32_16x16x32_bf16(acq[kb + k4], bf[k4][nt], c[nt], 0, 0, 0);
                        cB[nt] = __builtin_amdgcn_mfma_f32_16x16x32_bf16(acqB[kb + k4], bf[k4][nt], cB[nt], 0, 0, 0);
                    }
            }
#pragma unroll
            for (int j = 0; j < 4; ++j) {
                const int t = t0 + fq * 4 + j;
                const float cs = ctab[t * 16 + fr], sn = stab[t * 16 + fr];
                const float x1 = c[0][j], x2 = c[1][j];
                c[0][j] = x1 * cs - x2 * sn; c[1][j] = x2 * cs + x1 * sn;
                const float y1 = cB[0][j], y2 = cB[1][j];
                cB[0][j] = y1 * cs - y2 * sn; cB[1][j] = y2 * cs + y1 * sn;
            }
#pragma unroll
            for (int nt = 0; nt < 4; ++nt) {
#pragma unroll
                for (int j = 0; j < 4; ++j) s_qi[(fq * 4 + j) * 512 + wid * 64 + nt * 16 + fr] = f2bf(c[nt][j]);
                qiB[nt] = pack4(cB[nt][0], cB[nt][1], cB[nt][2], cB[nt][3]);
            }
        } else {
#pragma unroll
            for (int nt = 0; nt < 4; ++nt) {
                s_qi[(fq * 4 + 0) * 512 + wid * 64 + nt * 16 + fr] = (bf16_t)(qiB[nt].x & 0xFFFFu); s_qi[(fq * 4 + 1) * 512 + wid * 64 + nt * 16 + fr] = (bf16_t)(qiB[nt].x >> 16);
                s_qi[(fq * 4 + 2) * 512 + wid * 64 + nt * 16 + fr] = (bf16_t)(qiB[nt].y & 0xFFFFu); s_qi[(fq * 4 + 3) * 512 + wid * 64 + nt * 16 + fr] = (bf16_t)(qiB[nt].y >> 16);
            }
        }
        __syncthreads();
        if (!IMPORT_SEL) {
            bf16x8 aq[8][2];
#pragma unroll
            for (int h = 0; h < 8; ++h)
#pragma unroll
                for (int ks = 0; ks < 2; ++ks) aq[h][ks] = *(const bf16x8*)(s_qi + fr * 512 + h * 64 + ks * 32 + fq * 8);
            float wh[4][8];
#pragma unroll
            for (int j = 0; j < 4; ++j) {
                const float4 w0 = *(const float4*)(whead + (n0 + fq * 4 + j) * 8), w1 = *(const float4*)(whead + (n0 + fq * 4 + j) * 8 + 4);
                wh[j][0] = w0.x; wh[j][1] = w0.y; wh[j][2] = w0.z; wh[j][3] = w0.w; wh[j][4] = w1.x; wh[j][5] = w1.y; wh[j][6] = w1.z; wh[j][7] = w1.w;
            }
            const int nkt = qt + 1;
            bf16x8 nb0 = {0, 0, 0, 0, 0, 0, 0, 0}, nb1 = nb0;
            if (wid < nkt) { const bf16_t* kr0 = kidx + ((size_t)b * TS + wid * 16 + fr) * 64 + fq * 8; nb0 = *(const bf16x8*)kr0; nb1 = *(const bf16x8*)(kr0 + 32); }
#pragma unroll 1
            for (int kt = wid; kt < nkt; kt += 8) {
                const bf16x8 bk0 = nb0, bk1 = nb1;
                if (kt + 8 < nkt) { const bf16_t* krn = kidx + ((size_t)b * TS + (kt + 8) * 16 + fr) * 64 + fq * 8; nb0 = *(const bf16x8*)krn; nb1 = *(const bf16x8*)(krn + 32); }
                float I[4] = {0.f, 0.f, 0.f, 0.f};
#pragma unroll
                for (int h = 0; h < 8; ++h) {
                    f32x4 a = __builtin_amdgcn_mfma_f32_16x16x32_bf16(aq[h][0], bk0, z4, 0, 0, 0);
                    a = __builtin_amdgcn_mfma_f32_16x16x32_bf16(aq[h][1], bk1, a, 0, 0, 0);
#pragma unroll
                    for (int j = 0; j < 4; ++j) I[j] += wh[j][h] * fmaxf(a[j], 0.f);
                }
#pragma unroll
                for (int j = 0; j < 4; ++j) s_sc[(fq * 4 + j) * 2064 + kt * 16 + fr] = (unsigned short)f2h_bits(I[j]);
            }
        }
        __syncthreads();
#pragma unroll 1
        for (int qi2 = 0; qi2 < 2; ++qi2) {
            const int q = wid + qi2 * 8;
            const int nadm = t0 + q + 1;
            unsigned short* sel = s_sel + q * 256;
            if (IMPORT_SEL) {
                const int ns = gnsel[n0 + q];
                for (int i = lane; i < ns; i += 64) sel[i] = gsel[(n0 + q) * 256 + i];
                if (lane == 0) s_nsel[q] = ns;
            } else if (nadm <= 256) {
                for (int i = lane; i < nadm; i += 64) sel[i] = (unsigned short)i;
                if (lane == 0) s_nsel[q] = nadm;
            } else {
                unsigned* hist = (unsigned*)(lds + 82432 + wid * 8192);
                const unsigned short* scq = s_sc + q * 2064;
                const int nch = (nadm + 63) >> 6;
                unsigned B1 = 0u; int na1 = 0, na2 = 0; unsigned T = 0u;
#pragma unroll 1
                for (int pass = 0; pass < 2; ++pass) {
                    *(uint4*)(hist + lane * 4) = make_uint4(0u, 0u, 0u, 0u);
#pragma unroll 1
                    for (int c0 = 0; c0 < nch; c0 += 8) {
                        unsigned kb[8];
#pragma unroll
                        for (int j = 0; j < 8; ++j) { const int s_ = (c0 + j) * 64 + lane; kb[j] = (s_ < nadm) ? (unsigned)scq[s_] : 0x10000u; }
#pragma unroll
                        for (int j = 0; j < 8; ++j) {
                            const unsigned u = kb[j];
                            const unsigned k = (u & 0x8000u) ? (~u & 0xFFFFu) : (u | 0x8000u);
                            const bool ok = (u < 0x10000u) && (pass == 0 || (k >> 8) == B1);
                            if (ok) atomicAdd(hist + (pass == 0 ? (k >> 8) : (k & 255u)), 1u);
                        }
                    }
                    const int need = 256 - na1;
                    const uint4 h4 = *(const uint4*)(hist + lane * 4);
                    const int sl = (int)(h4.x + h4.y + h4.z + h4.w);
                    int suf = sl;
#pragma unroll
                    for (int o = 1; o < 64; o <<= 1) { const int t_ = __shfl_down(suf, o); suf += (lane + o < 64) ? t_ : 0; }
                    const int above = suf - sl;
                    const bool mine = (suf >= need) && (above < need);
                    int a = above, bsel, asel;
                    if (a + (int)h4.w >= need) { bsel = 3; asel = a; }
                    else { a += (int)h4.w;
                        if (a + (int)h4.z >= need) { bsel = 2; asel = a; }
                        else { a += (int)h4.z;
                            if (a + (int)h4.y >= need) { bsel = 1; asel = a; }
                            else { a += (int)h4.y; bsel = 0; asel = a; } } }
                    const int src = __ffsll((long long)__ballot(mine)) - 1;
                    const unsigned bin = (unsigned)__shfl(lane * 4 + bsel, src); const int nab = __shfl(asel, src);
                    if (pass == 0) { B1 = bin; na1 = nab; } else { T = (B1 << 8) | bin; na2 = nab; }
                }
                {
                    const int rties = 256 - (na1 + na2);
                    int base = 0, ties = 0;
                    const unsigned long long ltmask = (1ull << lane) - 1ull;
#pragma unroll 1
                    for (int c0 = 0; c0 < nch; c0 += 4) {
                        unsigned kb[4];
#pragma unroll
                        for (int j = 0; j < 4; ++j) { const int s_ = (c0 + j) * 64 + lane; kb[j] = (s_ < nadm) ? (unsigned)scq[s_] : 0x10000u; }
#pragma unroll
                        for (int j = 0; j < 4; ++j) {
                            const int s_ = (c0 + j) * 64 + lane;
                            const unsigned u = kb[j];
                            const bool valid = u < 0x10000u;
                            const unsigned k = (u & 0x8000u) ? (~u & 0xFFFFu) : (u | 0x8000u);
                            const bool gt = valid && k > T, eq = valid && k == T;
                            const unsigned long long em = __ballot(eq);
                            const int myrank = ties + __popcll(em & ltmask);
                            const bool take = gt || (eq && myrank < rties);
                            const unsigned long long tm = __ballot(take);
                            const int pos = base + __popcll(tm & ltmask);
                            if (take && pos < 256) sel[pos] = (unsigned short)s_;
                            base += __popcll(tm); ties += __popcll(em);
                        }
                    }
                }
                if (lane == 0) s_nsel[q] = 256;
            }
        }
        __syncthreads();
        if (half == 0) {
            const size_t n0B = n0 + TS;
            bf16_t* s_qnB = s_qn + 1024;
#pragma unroll 1
            for (int hi = 0; hi < 2; ++hi) {
                const int hh = wid * 2 + hi;
                const bf16_t* caA = cqn + (n0 + fr) * 256 + fq * 8;
                const bf16_t* caB = cqn + (n0B + fr) * 256 + fq * 8;
                f32x4 cA[6] = {z4, z4, z4, z4, z4, z4}, cB[6] = {z4, z4, z4, z4, z4, z4};
#pragma unroll
                for (int kb = 0; kb < 8; kb += 2) {
                    bf16x8 bf[2][6], aA[2], aB[2];
#pragma unroll
                    for (int k2 = 0; k2 < 2; ++k2) {
                        aA[k2] = *(const bf16x8*)(caA + (kb + k2) * 32); aB[k2] = *(const bf16x8*)(caB + (kb + k2) * 32);
#pragma unroll
                        for (int nt = 0; nt < 6; ++nt) bf[k2][nt] = *(const bf16x8*)(wuqT + (size_t)(hh * 96 + nt * 16 + fr) * 256 + (kb + k2) * 32 + fq * 8);
                    }
#pragma unroll
                    for (int k2 = 0; k2 < 2; ++k2)
#pragma unroll
                        for (int nt = 0; nt < 6; ++nt) {
                            cA[nt] = __builtin_amdgcn_mfma_f32_16x16x32_bf16(aA[k2], bf[k2][nt], cA[nt], 0, 0, 0);
                            cB[nt] = __builtin_amdgcn_mfma_f32_16x16x32_bf16(aB[k2], bf[k2][nt], cB[nt], 0, 0, 0);
                        }
                }
#pragma unroll
                for (int j = 0; j < 4; ++j) {
                    const int q = fq * 4 + j, t = t0 + q;
                    const float cs = ctab[t * 16 + fr], sn = stab[t * 16 + fr];
                    s_Q[(q * 16 + hh) * 160 + 128 + fr] = f2bf(cA[4][j] * cs - cA[5][j] * sn);
                    s_Q[(q * 16 + hh) * 160 + 144 + fr] = f2bf(cA[5][j] * cs + cA[4][j] * sn);
                    gq[(q * 16 + hh) * 160 + 128 + fr] = f2bf(cB[4][j] * cs - cB[5][j] * sn);
                    gq[(q * 16 + hh) * 160 + 144 + fr] = f2bf(cB[5][j] * cs + cB[4][j] * sn);
#pragma unroll
                    for (int nt = 0; nt < 4; ++nt) { s_qn[q * 64 + nt * 16 + fr] = f2bf(cA[nt][j]); s_qnB[q * 64 + nt * 16 + fr] = f2bf(cB[nt][j]); }
                }
                __syncthreads();
                bf16x8 anA[2], anB[2];
#pragma unroll
                for (int ks = 0; ks < 2; ++ks) { anA[ks] = *(const bf16x8*)(s_qn + fr * 64 + ks * 32 + fq * 8); anB[ks] = *(const bf16x8*)(s_qnB + fr * 64 + ks * 32 + fq * 8); }
                bf16x8 bwk[8][2];
#pragma unroll
                for (int nt = 0; nt < 8; ++nt)
#pragma unroll
                    for (int ks = 0; ks < 2; ++ks) bwk[nt][ks] = *(const bf16x8*)(wuk + (size_t)(hh * 128 + nt * 16 + fr) * 64 + ks * 32 + fq * 8);
#pragma unroll
                for (int nt = 0; nt < 8; ++nt) {
                    f32x4 aA = z4, aB = z4;
#pragma unroll
                    for (int ks = 0; ks < 2; ++ks) {
                        aA = __builtin_amdgcn_mfma_f32_16x16x32_bf16(anA[ks], bwk[nt][ks], aA, 0, 0, 0);
                        aB = __builtin_amdgcn_mfma_f32_16x16x32_bf16(anB[ks], bwk[nt][ks], aB, 0, 0, 0);
                    }
#pragma unroll
                    for (int j = 0; j < 4; ++j) {
                        s_Q[((fq * 4 + j) * 16 + hh) * 160 + nt * 16 + fr] = f2bf(aA[j]);
                        gq[((fq * 4 + j) * 16 + hh) * 160 + nt * 16 + fr] = f2bf(aB[j]);
                    }
                }
                __syncthreads();
            }
        } else {
            for (int e = tid; e < QS_BYTES / 16; e += NTHR) ((uint4*)s_Q)[e] = ((const uint4*)gq)[e];
            __syncthreads();
        }
#pragma unroll 1
        for (int qi2 = 0; qi2 < 2; ++qi2) {
            const int q = wid + qi2 * 8;
            bf16x8 bq[5];
#pragma unroll
            for (int ks = 0; ks < 5; ++ks) bq[ks] = *(const bf16x8*)(s_Q + (q * 16 + fr) * 160 + ks * 32 + fq * 8);
            const int nsel = s_nsel[q];
            const unsigned short* sel = s_sel + q * 256;
            float m = -INFINITY, lsum = 0.f;
            f32x4 O[8] = {z4, z4, z4, z4, z4, z4, z4, z4};
            const int nchunk = (nsel + 31) >> 5;
            bf16x8 akn[2][5];
#pragma unroll
            for (int mt = 0; mt < 2; ++mt) {
                const int ki = mt * 16 + fr;
                const int sidx = sel[ki < nsel ? ki : 0];
                const bf16_t* krow = kv + ((size_t)b * TS + sidx) * 160 + fq * 8;
#pragma unroll
                for (int ks = 0; ks < 5; ++ks) akn[mt][ks] = *(const bf16x8*)(krow + ks * 32);
            }
#pragma unroll 1
            for (int ch = 0; ch < nchunk; ++ch) {
                bf16x8 ak[2][5];
#pragma unroll
                for (int mt = 0; mt < 2; ++mt)
#pragma unroll
                    for (int ks = 0; ks < 5; ++ks) ak[mt][ks] = akn[mt][ks];
                if (ch + 1 < nchunk) {
#pragma unroll
                    for (int mt = 0; mt < 2; ++mt) {
                        const int ki = (ch + 1) * 32 + mt * 16 + fr;
                        const int sidx = sel[ki < nsel ? ki : 0];
                        const bf16_t* krow = kv + ((size_t)b * TS + sidx) * 160 + fq * 8;
#pragma unroll
                        for (int ks = 0; ks < 5; ++ks) akn[mt][ks] = *(const bf16x8*)(krow + ks * 32);
                    }
                }
#pragma unroll
                for (int mt = 0; mt < 2; ++mt)
#pragma unroll
                    for (int ks = 0; ks < 4; ++ks) {
                        const int r = mt * 16 + fr;
                        *(bf16x8*)(s_Vw + r * 256 + (((ks * 2 + (fq >> 1)) ^ (r & 7)) * 32) + (fq & 1) * 16) = ak[mt][ks];
                    }
                f32x4 st[2] = {z4, z4};
#pragma unroll
                for (int mt = 0; mt < 2; ++mt)
#pragma unroll
                    for (int ks = 0; ks < 5; ++ks) st[mt] = __builtin_amdgcn_mfma_f32_16x16x32_bf16(ak[mt][ks], bq[ks], st[mt], 0, 0, 0);
                float sv[2][4]; float cmax = -INFINITY;
#pragma unroll
                for (int mt = 0; mt < 2; ++mt)
#pragma unroll
                    for (int j = 0; j < 4; ++j) {
                        const int ke = ch * 32 + mt * 16 + fq * 4 + j;
                        const float s_ = (ke < nsel) ? st[mt][j] * scale : -INFINITY;
                        sv[mt][j] = s_; cmax = fmaxf(cmax, s_);
                    }
                cmax = fmaxf(cmax, __shfl_xor(cmax, 16)); cmax = fmaxf(cmax, __shfl_xor(cmax, 32));
                const float mnew = fmaxf(m, cmax);
                const float alpha = __expf(m - mnew);
                float psum = 0.f;
#pragma unroll
                for (int mt = 0; mt < 2; ++mt)
#pragma unroll
                    for (int j = 0; j < 4; ++j) { const float pe = __expf(sv[mt][j] - mnew); sv[mt][j] = pe; psum += pe; }
                psum += __shfl_xor(psum, 16); psum += __shfl_xor(psum, 32);
                lsum = lsum * alpha + psum; m = mnew;
#pragma unroll
                for (int ct = 0; ct < 8; ++ct) O[ct] = O[ct] * alpha;
                bf16x8 pf;
#pragma unroll
                for (int mt = 0; mt < 2; ++mt)
#pragma unroll
                    for (int j = 0; j < 4; ++j) pf[mt * 4 + j] = (short)f2bf(sv[mt][j]);
                const int q_ = fr >> 2, p_ = fr & 3;
                const int r0 = fq * 4 + q_, r1 = 16 + r0;
#pragma unroll
                for (int ct = 0; ct < 8; ++ct) {
                    const s16x4 v0 = __builtin_amdgcn_ds_read_tr16_b64_v4i16((__attribute__((address_space(3))) s16x4*)(s_Vw + r0 * 256 + ((ct ^ (r0 & 7)) * 32) + p_ * 8));
                    const s16x4 v1 = __builtin_amdgcn_ds_read_tr16_b64_v4i16((__attribute__((address_space(3))) s16x4*)(s_Vw + r1 * 256 + ((ct ^ (r1 & 7)) * 32) + p_ * 8));
                    bf16x8 av; av[0] = v0[0]; av[1] = v0[1]; av[2] = v0[2]; av[3] = v0[3]; av[4] = v1[0]; av[5] = v1[1]; av[6] = v1[2]; av[7] = v1[3];
                    O[ct] = __builtin_amdgcn_mfma_f32_16x16x32_bf16(av, pf, O[ct], 0, 0, 0);
                }
            }
            const float inv = 1.0f / lsum;
#pragma unroll
            for (int ct = 0; ct < 8; ++ct)
#pragma unroll
                for (int j = 0; j < 4; ++j) s_Q[(q * 16 + fr) * 160 + ct * 16 + fq * 4 + j] = f2bf(O[ct][j] * inv);
        }
        __syncthreads();
#pragma unroll 1
        for (int hi = 0; hi < 2; ++hi) {
            const int hh = wid * 2 + hi;
            bf16x8 ao[4];
#pragma unroll
            for (int ks = 0; ks < 4; ++ks) ao[ks] = *(const bf16x8*)(s_Q + (fr * 16 + hh) * 160 + ks * 32 + fq * 8);
#pragma unroll
            for (int nt = 0; nt < 4; ++nt) {
                f32x4 a = z4;
#pragma unroll
                for (int ks = 0; ks < 4; ++ks)
                    a = __builtin_amdgcn_mfma_f32_16x16x32_bf16(ao[ks], *(const bf16x8*)(wuvT + (size_t)(hh * 64 + nt * 16 + fr) * 128 + ks * 32 + fq * 8), a, 0, 0, 0);
#pragma unroll
                for (int j = 0; j < 4; ++j) yc[(n0 + fq * 4 + j) * 1024 + hh * 64 + nt * 16 + fr] = f2bf(a[j]);
            }
        }
        __syncthreads();
        }
    }
}


__device__ void phase_lr_prep(const Params& p, int l) {
    const int lane = otid() & 63;
    const int wave = (obid() * NTHR + otid()) >> 6, nw = gridDim.x * NTHR / 64;
    const bf16_t* pm = (const bf16_t*)(WS(p) + OFF_PMISC);
    bf16_t* alr = (bf16_t*)(OUTB(p) + DO_ALR);
    const float4 mu4 = *(const float4*)(p.in[4] + (size_t)l * 3328 + 3072 + lane * 4);
    const float4 vm4 = *(const float4*)(p.in[18] + (lane & 7) * 4);
    struct In { uint2 c0, p0, c1, p1; };
    auto load = [&](int n) {
        In r;
        const bf16_t* row = pm + (size_t)n * PM_LD;
        const bool hp = (n % TS) > 0;
        r.c0 = *(const uint2*)(row + lane * 4);
        r.p0 = hp ? *(const uint2*)(row - PM_LD + lane * 4) : make_uint2(0u, 0u);
        r.c1 = make_uint2(0u, 0u); r.p1 = r.c1;
        if (lane < 8) { r.c1 = *(const uint2*)(row + 256 + lane * 4); if (hp) r.p1 = *(const uint2*)(row - PM_LD + 256 + lane * 4); }
        return r;
    };
    auto mix4 = [&](const uint2 c, const uint2 q, const float4 m, float (&o)[4]) {
        const float c0 = __uint_as_float(c.x << 16), c1 = __uint_as_float(c.x & 0xFFFF0000u), c2 = __uint_as_float(c.y << 16), c3 = __uint_as_float(c.y & 0xFFFF0000u);
        const float q0 = __uint_as_float(q.x << 16), q1 = __uint_as_float(q.x & 0xFFFF0000u), q2 = __uint_as_float(q.y << 16), q3 = __uint_as_float(q.y & 0xFFFF0000u);
        o[0] = c0 + (q0 - c0) * m.x; o[1] = c1 + (q1 - c1) * m.y; o[2] = c2 + (q2 - c2) * m.z; o[3] = c3 + (q3 - c3) * m.w;
    };
    In cur = load(wave < NT ? wave : 0);
    for (int n = wave; n < NT; n += nw) {
        const In x = cur;
        if (n + nw < NT) cur = load(n + nw);
        float o[4];
        mix4(x.c0, x.p0, mu4, o);
        if (lane < 16) { o[0] = tanhf(o[0]); o[1] = tanhf(o[1]); o[2] = tanhf(o[2]); o[3] = tanhf(o[3]); }
        else if (lane >= 32) { o[0] = sigmoidf_(o[0]); o[1] = sigmoidf_(o[1]); o[2] = sigmoidf_(o[2]); o[3] = sigmoidf_(o[3]); }
        *(uint2*)(alr + (size_t)n * 288 + lane * 4) = pack4(o[0], o[1], o[2], o[3]);
        if (lane < 8) {
            mix4(x.c1, x.p1, vm4, o);
            *(uint2*)(alr + (size_t)n * 288 + 256 + lane * 4) = pack4(o[0], o[1], o[2], o[3]);
        }
    }
}

typedef short sh4 __attribute__((ext_vector_type(4)));
__device__ __forceinline__ sh4 pk4v(const f32x4& v) { const uint2 u = pack4(v[0], v[1], v[2], v[3]); sh4 r; __builtin_memcpy(&r, &u, 8); return r; }
__device__ __forceinline__ bf16x8 cat8(const sh4& a, const sh4& b) { bf16x8 r; r[0] = a[0]; r[1] = a[1]; r[2] = a[2]; r[3] = a[3]; r[4] = b[0]; r[5] = b[1]; r[6] = b[2]; r[7] = b[3]; return r; }
#define MF32(a, b, c) __builtin_amdgcn_mfma_f32_16x16x32_bf16(a, b, c, 0, 0, 0)
#define MF16(a, b, c) MF32(cat8(a, sh4{0, 0, 0, 0}), cat8(b, sh4{0, 0, 0, 0}), c)
constexpr int SC_LT = 72;
constexpr int SC_LS = 36;
constexpr int SC_TC = 32;
constexpr int SC_ROWB = 1088;
__device__ __forceinline__ const unsigned char* scan_piece_src(const Params& p, int l, int b, int hc, int t0, int pi, bool& ok) {
    const int tau = pi / 68, seg = pi - tau * 68;
    const int t = t0 + tau;
    ok = (t < TS) && (tau < SC_TC);
    const size_t n = (size_t)b * TS + t;
    const unsigned char* ws = WS(p);
    if (seg < 8) return ws + OFF_PR + (n * 1024 + hc) * 2 + seg * 16;
    if (seg < 16) return ws + OFF_PK + (n * 1024 + hc) * 2 + (seg - 8) * 16;
    if (seg < 24) return ws + OFF_PV + (n * 1024 + hc) * 2 + (seg - 16) * 16;
    if (seg < 60) return OUTB(p) + DO_ALR + (n * 288) * 2 + (seg - 24) * 16;
    ok = ok && (l > 0);
    return ws + OFF_VFIRST + (n * 1024 + hc) * 2 + (seg - 60) * 16;
}
__device__ void phase_scan5(const Params& p, int l, unsigned char* lds, int blk) {
    const int tid = otid(), lane = tid & 63, wid = tid >> 6, fr = lane & 15, fq = lane >> 4;
    const int b = blk >> 4, hh = blk & 15, hc = hh * 64;
    float* s_r = (float*)lds;
    float* s_w = s_r + 2048;
    float* s_k = s_w + 2048;
    float* s_v = s_k + 2048;
    float* s_a = s_v + 2048;
    float* s_b = s_a + 2048;
    float* s_g = s_b + 2048;
    float* s_o = s_g + 2048;
    bf16_t* o_at = (bf16_t*)(s_o + 2048);
    bf16_t* o_rt = o_at + 32 * SC_LT;
    bf16_t* o_bt = o_rt + 32 * SC_LT;
    bf16_t* o_kt = o_bt + 32 * SC_LT;
    bf16_t* o_bT = o_kt + 32 * SC_LT;
    bf16_t* o_kT = o_bT + 64 * SC_LS;
    bf16_t* o_vT = o_kT + 64 * SC_LS;
    float* s_gc = (float*)(o_vT + 64 * SC_LS);
    unsigned char* raw = (unsigned char*)(s_gc + 128);
    float* prevb = (float*)(raw + 32 * SC_ROWB);
    unsigned* prevr = (unsigned*)prevb;
    float* cst = prevb + 960;
    float* s_gB = s_r;
    float* s_oB = s_k;
    float* s_vB = cst + 992;
    float* s_bs2 = s_vB + 2048;
    const float* mu = p.in[4] + (size_t)l * 3328;
    for (int e = tid; e < 480; e += NTHR) {
        float v;
        if (e < 192) v = mu[(e >> 6) * 1024 + hc + (e & 63)];
        else if (e < 448) v = mu[3072 + (e - 192)];
        else v = p.in[18][e - 448];
        cst[e] = v;
    }
    if (tid < 64) {
        cst[480 + tid] = p.in[7][l * 1024 + hc + tid];
        cst[544 + tid] = p.in[9][l * 1024 + hc + tid];
        cst[608 + tid] = p.in[12][l * 1024 + hc + tid];
        cst[672 + tid] = p.in[13][l * 1024 + hc + tid];
        cst[736 + tid] = p.in[14][l * 1024 + hc + tid];
        cst[800 + tid] = p.in[15][l * 1024 + hc + tid];
        cst[864 + tid] = p.in[16][l * 1024 + hc + tid];
        cst[928 + tid] = p.in[19][hc + tid];
    }
    const int mm = wid >> 1, ntb = (wid & 1) * 2;
    const int nks = (mm == 2) ? 4 : (mm == 3 ? 1 : 2);
    bf16x8 Bw[2][4];
    {
        const float* wsrc = (mm == 0) ? p.in[8] + (size_t)l * 64 * 1024 : (mm == 1) ? p.in[10] + (size_t)l * 64 * 1024 : (mm == 2) ? p.in[11] + (size_t)l * 128 * 1024 : p.in[20];
#pragma unroll
        for (int n2 = 0; n2 < 2; ++n2)
#pragma unroll
            for (int ks = 0; ks < 4; ++ks) {
                bf16x8 f;
#pragma unroll
                for (int j = 0; j < 8; ++j) {
                    const bool okw = ks < nks && (mm < 3 || l > 0);
                    const float v = wsrc[(size_t)(okw ? (ks * 32 + fq * 8 + j) : 0) * 1024 + hc + (ntb + n2) * 16 + fr];
                    f[j] = (short)f2bf(okw ? v : 0.f);
                }
                Bw[n2][ks] = f;
            }
    }
    const f32x4 z4 = {0.f, 0.f, 0.f, 0.f};
    f32x4 S[4] = {z4, z4, z4, z4};
    sh4 Lf;
#pragma unroll
    for (int j = 0; j < 4; ++j) Lf[j] = (fq * 4 + j <= fr) ? (short)0x3F80 : (short)0;
    bf16_t* Pr = (bf16_t*)(WS(p) + OFF_PR);
    bf16_t* vfirst = (bf16_t*)(WS(p) + OFF_VFIRST);
    const unsigned char* psrc[5]; int pstep[5], ptau[5]; bool pval[5];
#pragma unroll
    for (int k = 0; k < 5; ++k) {
        const int pi = tid + k * NTHR;
        bool ok = false;
        psrc[k] = scan_piece_src(p, l, b, hc, 0, pi < SC_TC * 68 ? pi : 0, ok);
        const int tau = (pi < SC_TC * 68 ? pi : 0) / 68, seg = (pi < SC_TC * 68 ? pi : 0) - tau * 68;
        ptau[k] = tau;
        pstep[k] = SC_TC * ((seg >= 24 && seg < 60) ? 576 : 2048);
        pval[k] = (pi < SC_TC * 68) && !(seg >= 60 && l == 0);
    }
    uint4 pre[5];
#pragma unroll
    for (int k = 0; k < 5; ++k) { pre[k] = make_uint4(0, 0, 0, 0); if (pval[k] && ptau[k] < TS) pre[k] = *(const uint4*)psrc[k]; }
    __syncthreads();
    auto stepE = [&](int tau, int c4, const float* so, const float* sv, const float* sgp, const float* sb, int t0e, int nve) {
        const int e = tau * 64 + c4;
        const size_t n = (size_t)b * TS + t0e + tau;
        const float4 o4 = *(const float4*)(so + e), v4_ = *(const float4*)(sv + e), g4_ = *(const float4*)(sgp + e);
        const float4 clw = *(const float4*)(cst + 800 + c4), clb = *(const float4*)(cst + 864 + c4);
        const float bsum = sb[tau];
        const float m_ = row16_sum((o4.x + o4.y) + (o4.z + o4.w)) * (1.0f / 64.0f);
        const float d0 = o4.x - m_, d1 = o4.y - m_, d2 = o4.z - m_, d3 = o4.w - m_;
        const float var = row16_sum(d0 * d0 + d1 * d1 + d2 * d2 + d3 * d3) * (1.0f / 64.0f);
        const float rs = rsqrtf(var + 64e-5f);
        const float y0 = (d0 * rs * clw.x + clb.x + bsum * v4_.x) * g4_.x, y1 = (d1 * rs * clw.y + clb.y + bsum * v4_.y) * g4_.y;
        const float y2 = (d2 * rs * clw.z + clb.z + bsum * v4_.z) * g4_.z, y3 = (d3 * rs * clw.w + clb.w + bsum * v4_.w) * g4_.w;
        if (tau < nve) *(uint2*)(Pr + n * 1024 + hc + c4) = pack4(y0, y1, y2, y3);
    };
#pragma unroll 1
    for (int t0 = 0, ch = 0; t0 < TS; t0 += SC_TC, ++ch) {
        const int nval = (TS - t0 < SC_TC) ? (TS - t0) : SC_TC;
        const bool par = (ch & 1) != 0;
        float* g_c = par ? s_gB : s_g; float* o_c = par ? s_oB : s_o; float* v_c = par ? s_vB : s_v; float* bs_c = s_bs2 + (par ? 32 : 0);
        float* g_p = par ? s_g : s_gB; float* o_p = par ? s_o : s_oB; float* v_p = par ? s_v : s_vB; float* bs_p = s_bs2 + (par ? 0 : 32);
#pragma unroll
        for (int k = 0; k < 5; ++k) { const int pi = tid + k * NTHR; if (pi < SC_TC * 68) *(uint4*)(raw + pi * 16) = pre[k]; }
        lds_barrier();
#pragma unroll
        for (int k = 0; k < 5; ++k) {
            pre[k] = make_uint4(0, 0, 0, 0);
            if (pval[k] && t0 + SC_TC + ptau[k] < TS) pre[k] = *(const uint4*)(psrc[k] + (size_t)(ch + 1) * pstep[k]);
        }
        if (mm < 3 || l > 0) {
            const unsigned char* Ab = raw + ((mm == 0) ? 384 : (mm == 1) ? 512 : (mm == 2) ? 640 : 896);
            float* dst = (mm == 0) ? s_w : (mm == 1) ? s_a : (mm == 2) ? g_c : o_c;
#pragma unroll
            for (int m = 0; m < 2; ++m) {
                f32x4 acc0 = {0.f, 0.f, 0.f, 0.f}, acc1 = {0.f, 0.f, 0.f, 0.f};
#pragma unroll
                for (int ks = 0; ks < 4; ++ks) {
                    if (ks < nks) {
                        const bf16x8 a = *(const bf16x8*)(Ab + (m * 16 + fr) * SC_ROWB + ks * 64 + fq * 16);
                        acc0 = __builtin_amdgcn_mfma_f32_16x16x32_bf16(a, Bw[0][ks], acc0, 0, 0, 0);
                        acc1 = __builtin_amdgcn_mfma_f32_16x16x32_bf16(a, Bw[1][ks], acc1, 0, 0, 0);
                    }
                }
                if (mm == 0) {
                    const float cw0 = cst[480 + ntb * 16 + fr], cw1 = cst[480 + (ntb + 1) * 16 + fr];
                    f32x4 l0, l1, r0, r1;
#pragma unroll
                    for (int j = 0; j < 4; ++j) { l0[j] = -0.6065306597126334f * fast_sigmoid(acc0[j] + cw0); l1[j] = -0.6065306597126334f * fast_sigmoid(acc1[j] + cw1); }
                    const uint2 h0 = pack4(l0[0], l0[1], l0[2], l0[3]), h1 = pack4(l1[0], l1[1], l1[2], l1[3]);
                    r0[0] = l0[0] - __uint_as_float(h0.x << 16); r0[1] = l0[1] - __uint_as_float(h0.x & 0xFFFF0000u); r0[2] = l0[2] - __uint_as_float(h0.y << 16); r0[3] = l0[3] - __uint_as_float(h0.y & 0xFFFF0000u);
                    r1[0] = l1[0] - __uint_as_float(h1.x << 16); r1[1] = l1[1] - __uint_as_float(h1.x & 0xFFFF0000u); r1[2] = l1[2] - __uint_as_float(h1.y << 16); r1[3] = l1[3] - __uint_as_float(h1.y & 0xFFFF0000u);
                    sh4 hh0, hh1; __builtin_memcpy(&hh0, &h0, 8); __builtin_memcpy(&hh1, &h1, 8);
                    f32x4 c0 = MF16(Lf, pk4v(r0), z4), c1 = MF16(Lf, pk4v(r1), z4);
                    c0 = MF16(Lf, hh0, c0); c1 = MF16(Lf, hh1, c1);
#pragma unroll
                    for (int j = 0; j < 4; ++j) {
                        const int eo = (m * 16 + fq * 4 + j) * 64 + ntb * 16 + fr;
                        s_w[eo] = c0[j]; s_w[eo + 16] = c1[j];
                        s_b[eo] = l0[j]; s_b[eo + 16] = l1[j];
                    }
                } else {
#pragma unroll
                    for (int j = 0; j < 4; ++j) {
                        dst[(m * 16 + fq * 4 + j) * 64 + ntb * 16 + fr] = acc0[j];
                        dst[(m * 16 + fq * 4 + j) * 64 + (ntb + 1) * 16 + fr] = acc1[j];
                    }
                }
            }
        }
        lds_barrier();
        {
            const int tau = tid >> 4, c4 = (tid & 15) * 4, e = tau * 64 + c4, t = t0 + tau;
            const size_t n = (size_t)b * TS + t;
            const float4 cum4 = *(const float4*)(s_w + e), lw4 = *(const float4*)(s_b + e), xa4 = *(const float4*)(s_a + e);
            const float4 ca = *(const float4*)(cst + 544 + c4), ckk = *(const float4*)(cst + 608 + c4), cka = *(const float4*)(cst + 672 + c4), crk = *(const float4*)(cst + 736 + c4);
            const float cum[4] = {cum4.x, cum4.y, cum4.z, cum4.w}, lw[4] = {lw4.x, lw4.y, lw4.z, lw4.w};
            const float xa[4] = {xa4.x + ca.x, xa4.y + ca.y, xa4.z + ca.z, xa4.w + ca.w};
            const float kkc[4] = {ckk.x, ckk.y, ckk.z, ckk.w}, kac[4] = {cka.x, cka.y, cka.z, cka.w};
            float rr[4], kr[4], vv[4];
            {
                const unsigned char* rc = raw + tau * SC_ROWB + c4 * 2;
                const uint2 cr = *(const uint2*)rc, ck = *(const uint2*)(rc + 128), cv = *(const uint2*)(rc + 256);
                uint2 qr = make_uint2(0u, 0u), qk = qr, qv = qr;
                if (tau > 0) { qr = *(const uint2*)(rc - SC_ROWB); qk = *(const uint2*)(rc - SC_ROWB + 128); qv = *(const uint2*)(rc - SC_ROWB + 256); }
                else if (t0 > 0) { const unsigned* pvr = prevr + ((ch + 1) & 1) * 96 + (c4 >> 1); qr = *(const uint2*)pvr; qk = *(const uint2*)(pvr + 32); qv = *(const uint2*)(pvr + 64); }
                if (tau == SC_TC - 1) { unsigned* pwr = prevr + (ch & 1) * 96 + (c4 >> 1); *(uint2*)pwr = cr; *(uint2*)(pwr + 32) = ck; *(uint2*)(pwr + 64) = cv; }
                const float4 mr = *(const float4*)(cst + c4), mk = *(const float4*)(cst + 64 + c4), mv = *(const float4*)(cst + 128 + c4);
                const float c_[12] = {__uint_as_float(cr.x << 16), __uint_as_float(cr.x & 0xFFFF0000u), __uint_as_float(cr.y << 16), __uint_as_float(cr.y & 0xFFFF0000u),
                                      __uint_as_float(ck.x << 16), __uint_as_float(ck.x & 0xFFFF0000u), __uint_as_float(ck.y << 16), __uint_as_float(ck.y & 0xFFFF0000u),
                                      __uint_as_float(cv.x << 16), __uint_as_float(cv.x & 0xFFFF0000u), __uint_as_float(cv.y << 16), __uint_as_float(cv.y & 0xFFFF0000u)};
                const float q_[12] = {__uint_as_float(qr.x << 16), __uint_as_float(qr.x & 0xFFFF0000u), __uint_as_float(qr.y << 16), __uint_as_float(qr.y & 0xFFFF0000u),
                                      __uint_as_float(qk.x << 16), __uint_as_float(qk.x & 0xFFFF0000u), __uint_as_float(qk.y << 16), __uint_as_float(qk.y & 0xFFFF0000u),
                                      __uint_as_float(qv.x << 16), __uint_as_float(qv.x & 0xFFFF0000u), __uint_as_float(qv.y << 16), __uint_as_float(qv.y & 0xFFFF0000u)};
                const float m_[12] = {mr.x, mr.y, mr.z, mr.w, mk.x, mk.y, mk.z, mk.w, mv.x, mv.y, mv.z, mv.w};
#pragma unroll
                for (int j = 0; j < 4; ++j) { rr[j] = c_[j] + (q_[j] - c_[j]) * m_[j]; kr[j] = c_[4 + j] + (q_[4 + j] - c_[4 + j]) * m_[4 + j]; vv[j] = c_[8 + j] + (q_[8 + j] - c_[8 + j]) * m_[8 + j]; }
            }
            if (l > 0) {
                const float4 xv4 = *(const float4*)(o_c + e), cv = *(const float4*)(cst + 928 + c4);
                const uint2 vfu = *(const uint2*)(raw + tau * SC_ROWB + 960 + c4 * 2);
                const float vf[4] = {__uint_as_float(vfu.x << 16), __uint_as_float(vfu.x & 0xFFFF0000u), __uint_as_float(vfu.y << 16), __uint_as_float(vfu.y & 0xFFFF0000u)};
                const float xv[4] = {xv4.x + cv.x, xv4.y + cv.y, xv4.z + cv.z, xv4.w + cv.w};
#pragma unroll
                for (int j = 0; j < 4; ++j) vv[j] = vv[j] + (vf[j] - vv[j]) * fast_sigmoid(xv[j]);
            } else if (t < TS) {
                *(uint2*)(vfirst + n * 1024 + hc + c4) = pack4(vv[0], vv[1], vv[2], vv[3]);
            }
            float av[4], kkv[4], ginc[4], gexc[4], ginv[4]; float ss = 0.f;
#pragma unroll
            for (int j = 0; j < 4; ++j) {
                ginc[j] = __expf(cum[j]); gexc[j] = __expf(cum[j] - lw[j]); ginv[j] = __expf(-cum[j]);
                av[j] = fast_sigmoid(xa[j]);
                kkv[j] = kr[j] * kkc[j];
                ss += kkv[j] * kkv[j];
            }
            float kk[4], kt[4];
#pragma unroll
            for (int j = 0; j < 4; ++j) kt[j] = kr[j] * (1.0f + (av[j] - 1.0f) * kac[j]);
            float bsum = rr[0] * kt[0] * crk.x + rr[1] * kt[1] * crk.y + rr[2] * kt[2] * crk.z + rr[3] * kt[3] * crk.w;
            float du0 = 0.f, du1 = 0.f;
            row16_sum4(ss, bsum, du0, du1);
            if ((tid & 15) == 0) bs_c[tau] = bsum;
            const float rn = rsqrtf(fmaxf(ss, 1e-24f));
#pragma unroll
            for (int j = 0; j < 4; ++j) kk[j] = kkv[j] * rn;
            const uint2 pa = pack4(-kk[0] * gexc[0], -kk[1] * gexc[1], -kk[2] * gexc[2], -kk[3] * gexc[3]);
            const uint2 pr = pack4(rr[0] * ginc[0], rr[1] * ginc[1], rr[2] * ginc[2], rr[3] * ginc[3]);
            const uint2 pb = pack4(kk[0] * av[0] * ginv[0], kk[1] * av[1] * ginv[1], kk[2] * av[2] * ginv[2], kk[3] * av[3] * ginv[3]);
            const uint2 pk = pack4(kt[0] * ginv[0], kt[1] * ginv[1], kt[2] * ginv[2], kt[3] * ginv[3]);
            const uint2 pv = pack4(vv[0], vv[1], vv[2], vv[3]);
            *(uint2*)(o_at + tau * SC_LT + c4) = pa;
            *(uint2*)(o_rt + tau * SC_LT + c4) = pr;
            *(uint2*)(o_bt + tau * SC_LT + c4) = pb;
            *(uint2*)(o_kt + tau * SC_LT + c4) = pk;
            o_bT[(c4 + 0) * SC_LS + tau] = (bf16_t)(pb.x & 0xFFFFu); o_bT[(c4 + 1) * SC_LS + tau] = (bf16_t)(pb.x >> 16); o_bT[(c4 + 2) * SC_LS + tau] = (bf16_t)(pb.y & 0xFFFFu); o_bT[(c4 + 3) * SC_LS + tau] = (bf16_t)(pb.y >> 16);
            o_kT[(c4 + 0) * SC_LS + tau] = (bf16_t)(pk.x & 0xFFFFu); o_kT[(c4 + 1) * SC_LS + tau] = (bf16_t)(pk.x >> 16); o_kT[(c4 + 2) * SC_LS + tau] = (bf16_t)(pk.y & 0xFFFFu); o_kT[(c4 + 3) * SC_LS + tau] = (bf16_t)(pk.y >> 16);
            o_vT[(c4 + 0) * SC_LS + tau] = (bf16_t)(pv.x & 0xFFFFu); o_vT[(c4 + 1) * SC_LS + tau] = (bf16_t)(pv.x >> 16); o_vT[(c4 + 2) * SC_LS + tau] = (bf16_t)(pv.y & 0xFFFFu); o_vT[(c4 + 3) * SC_LS + tau] = (bf16_t)(pv.y >> 16);
            if ((tau & 15) == 15) *(float4*)(s_gc + (tau >> 4) * 64 + c4) = make_float4(ginc[0], ginc[1], ginc[2], ginc[3]);
            *(float4*)(v_c + e) = make_float4(vv[0], vv[1], vv[2], vv[3]);
        }
        lds_barrier();
        if (wid < 4) {
#pragma unroll 1
            for (int sc = 0; sc < 2; ++sc) {
                if (sc * 16 < nval) {
                    const bf16_t* ar = o_at + (sc * 16 + fr) * SC_LT;
                    const bf16_t* rr_ = o_rt + (sc * 16 + fr) * SC_LT;
                    const bf16_t* br = o_bt + (sc * 16 + fr) * SC_LT;
                    const bf16_t* kr_ = o_kt + (sc * 16 + fr) * SC_LT;
                    const bf16x8 fa0 = *(const bf16x8*)(ar + fq * 8), fa1 = *(const bf16x8*)(ar + 32 + fq * 8);
                    const bf16x8 fb0 = *(const bf16x8*)(br + fq * 8), fb1 = *(const bf16x8*)(br + 32 + fq * 8);
                    const bf16x8 fk0 = *(const bf16x8*)(kr_ + fq * 8), fk1 = *(const bf16x8*)(kr_ + 32 + fq * 8);
                    const bf16x8 fr0 = *(const bf16x8*)(rr_ + fq * 8), fr1 = *(const bf16x8*)(rr_ + 32 + fq * 8);
                    f32x4 nA = MF32(fb0, fa0, z4); nA = MF32(fb1, fa1, nA);
                    f32x4 nB = MF32(fa0, fb0, z4); nB = MF32(fa1, fb1, nB);
                    f32x4 mak = MF32(fk0, fa0, z4); mak = MF32(fk1, fa1, mak);
                    f32x4 mbr = MF32(fb0, fr0, z4); mbr = MF32(fb1, fr1, mbr);
                    f32x4 mkr = MF32(fk0, fr0, z4); mkr = MF32(fk1, fr1, mkr);
#pragma unroll
                    for (int j = 0; j < 4; ++j) {
                        const int s_ = fq * 4 + j;
                        nA[j] = (s_ < fr) ? nA[j] : 0.f; nB[j] = (fr < s_) ? nB[j] : 0.f; mak[j] = (s_ < fr) ? mak[j] : 0.f;
                        mbr[j] = (s_ <= fr) ? mbr[j] : 0.f; mkr[j] = (s_ <= fr) ? mkr[j] : 0.f;
                    }
                    const sh4 pNA = pk4v(nA), pNB = pk4v(nB), pMak = pk4v(mak), pMbr = pk4v(mbr), pMkr = pk4v(mkr);
                    const f32x4 n2B = MF16(pNA, pNB, z4), n2A = MF16(pNB, pNA, z4);
                    const sh4 pN2A = pk4v(n2A), pN2B = pk4v(n2B);
                    const f32x4 n4B = MF16(pN2A, pN2B, z4), n4A = MF16(pN2B, pN2A, z4);
                    const sh4 pN4A = pk4v(n4A), pN4B = pk4v(n4B);
                    const sh4 pN8A = pk4v(MF16(pN4B, pN4A, z4));
                    const bf16x8 sB0 = cat8(pk4v(S[0]), pk4v(S[1])), sB1 = cat8(pk4v(S[2]), pk4v(S[3]));
                    const sh4 vf = *(const sh4*)(o_vT + (wid * 16 + fr) * SC_LS + sc * 16 + fq * 4);
                    f32x4 X = MF32(cat8(*(const sh4*)(ar + fq * 4), *(const sh4*)(ar + 16 + fq * 4)), sB0, z4);
                    X = MF32(cat8(*(const sh4*)(ar + 32 + fq * 4), *(const sh4*)(ar + 48 + fq * 4)), sB1, X);
                    X = MF16(pMak, vf, X);
                    X = MF16(pN8A, pk4v(X), X); X = MF16(pN4A, pk4v(X), X); X = MF16(pN2A, pk4v(X), X); X = MF16(pNA, pk4v(X), X);
                    const sh4 pSA = pk4v(X);
                    f32x4 O = MF32(cat8(*(const sh4*)(rr_ + fq * 4), *(const sh4*)(rr_ + 16 + fq * 4)), sB0, z4);
                    O = MF32(cat8(*(const sh4*)(rr_ + 32 + fq * 4), *(const sh4*)(rr_ + 48 + fq * 4)), sB1, O);
                    const bf16x8 sav = cat8(pSA, vf);
                    O = MF32(cat8(pMbr, pMkr), sav, O);
#pragma unroll
                    for (int j = 0; j < 4; ++j) o_c[(sc * 16 + fq * 4 + j) * 64 + wid * 16 + fr] = O[j];
#pragma unroll
                    for (int jt = 0; jt < 4; ++jt) {
                        const sh4 ka = *(const sh4*)(o_kT + (jt * 16 + fr) * SC_LS + sc * 16 + fq * 4), ba = *(const sh4*)(o_bT + (jt * 16 + fr) * SC_LS + sc * 16 + fq * 4);
                        f32x4 acc = MF32(cat8(ba, ka), sav, S[jt]);
                        const float4 g4 = *(const float4*)(s_gc + sc * 64 + jt * 16 + fq * 4);
                        acc[0] *= g4.x; acc[1] *= g4.y; acc[2] *= g4.z; acc[3] *= g4.w;
                        S[jt] = acc;
                    }
                }
            }
        } else if (ch > 0) {
            const int t2 = otid() - 256;
            stepE(t2 >> 4, (t2 & 15) * 4, o_p, v_p, g_p, bs_p, t0 - SC_TC, SC_TC);
            stepE(16 + (t2 >> 4), (t2 & 15) * 4, o_p, v_p, g_p, bs_p, t0 - SC_TC, SC_TC);
        }
        lds_barrier();
    }
    {
        const int chl = (TS + SC_TC - 1) / SC_TC - 1; const bool parl = (chl & 1) != 0;
        stepE(tid >> 4, (tid & 15) * 4, parl ? s_oB : s_o, parl ? s_vB : s_v, parl ? s_gB : s_g, s_bs2 + (parl ? 32 : 0), chl * SC_TC, TS - chl * SC_TC);
    }
}
__device__ __forceinline__ void xcd_panel_map(int& mt0, int& mstep, int& nt) {
    const int b = obid(), G = (int)gridDim.x;
    if (G == 256) { nt = (b >> 3) & 7; mt0 = (b & 7) * 4 + (b >> 6); mstep = 32; }
    else { nt = b & 7; mt0 = b >> 3; mstep = G >> 3; }
}
__device__ void phase_merge(const Params& p, unsigned char* lds) {
    const int tid = otid(), lane = tid & 63, wid = tid >> 6, wr = wid >> 1, wc = wid & 1, fr = lane & 15, fq = lane >> 4;
    const bf16_t* h = (const bf16_t*)(WS(p) + OFF_H);
    const bf16_t* wb = (const bf16_t*)(WS(p) + OFF_WB);
    const float* rstd = (const float*)(WS(p) + OFF_RSTD);
    bf16_t* merged = (bf16_t*)(WS(p) + OFF_MERGED);
    const bf16_t* ysrc0 = (const bf16_t*)(WS(p) + OFF_PPOOL);
    const bf16_t* ysrc1 = (const bf16_t*)(WS(p) + OFF_PR);
    const bf16_t* ysrc2 = (const bf16_t*)(OUTB(p) + DO_YC);
    int mt0, mstep, nt;
    xcd_panel_map(mt0, mstep, nt);
    for (int mt = mt0; mt < 86; mt += mstep) {
        const int row0 = mt * 192, col0 = nt * 128;
        uint2 maccp[3][4];
#pragma unroll
        for (int m = 0; m < 3; ++m)
#pragma unroll
            for (int n = 0; n < 4; ++n) maccp[m][n] = make_uint2(0u, 0u);
#pragma unroll 1
        for (int i = 0; i < 3; ++i) {
            const int tid = otid();
            const bf16_t* ys = (i == 0) ? ysrc0 : (i == 1 ? ysrc1 : ysrc2);
            uint2 sg[3][4];
            {
                f32x4 ag[3][4]; g3_zero<3>(ag);
                G3<192> g;
                g3_setup<192>(g, [&](int r) { return h + (size_t)(row0 + r) * DM; }, [&](int r) { return wb + WB_WG + (size_t)(i * 1024 + col0 + r) * DM; }, tid);
                g3_kloop<192>(ag, g, DM, lds);
#pragma unroll
                for (int m = 0; m < 3; ++m) {
                    const float rs = rstd[row0 + wr * 48 + m * 16 + fr];
#pragma unroll
                    for (int n = 0; n < 4; ++n) sg[m][n] = pack4(fast_sigmoid(ag[m][n][0] * rs), fast_sigmoid(ag[m][n][1] * rs), fast_sigmoid(ag[m][n][2] * rs), fast_sigmoid(ag[m][n][3] * rs));
                }
            }
            {
                f32x4 ay[3][4]; g3_zero<3>(ay);
                G3<192> g;
                g3_setup<192>(g, [&](int r) { return ys + (size_t)(row0 + r) * DM; }, [&](int r) { return wb + WB_PA + (size_t)(i * 1024 + col0 + r) * DM; }, tid);
                g3_kloop<192>(ay, g, DM, lds);
#pragma unroll
                for (int m = 0; m < 3; ++m)
#pragma unroll
                    for (int n = 0; n < 4; ++n) {
                        const float m0 = __uint_as_float(maccp[m][n].x << 16) + __uint_as_float(sg[m][n].x << 16) * ay[m][n][0];
                        const float m1 = __uint_as_float(maccp[m][n].x & 0xFFFF0000u) + __uint_as_float(sg[m][n].x & 0xFFFF0000u) * ay[m][n][1];
                        const float m2 = __uint_as_float(maccp[m][n].y << 16) + __uint_as_float(sg[m][n].y << 16) * ay[m][n][2];
                        const float m3 = __uint_as_float(maccp[m][n].y & 0xFFFF0000u) + __uint_as_float(sg[m][n].y & 0xFFFF0000u) * ay[m][n][3];
                        maccp[m][n] = pack4(m0, m1, m2, m3);
                    }
            }
        }
#pragma unroll
        for (int m = 0; m < 3; ++m) {
            const int row = row0 + wr * 48 + m * 16 + fr;
#pragma unroll
            for (int n = 0; n < 4; ++n)
                *(uint2*)(merged + (size_t)row * 1024 + col0 + wc * 64 + n * 16 + fq * 4) = maccp[m][n];
        }
    }
}

__device__ void phase_outproj(const Params& p, unsigned char* lds) {
    const int tid = otid(), lane = tid & 63, wid = tid >> 6, wr = wid >> 1, wc = wid & 1, fr = lane & 15, fq = lane >> 4;
    const bf16_t* h = (const bf16_t*)(WS(p) + OFF_H);
    const bf16_t* wb = (const bf16_t*)(WS(p) + OFF_WB);
    const bf16_t* merged = (const bf16_t*)(WS(p) + OFF_MERGED);
    float* hm = (float*)(WS(p) + OFF_HM32);
    int mt0, mstep, nt;
    xcd_panel_map(mt0, mstep, nt);
    for (int mt = mt0; mt < 86; mt += mstep) {
        const int row0 = mt * 192, col0 = nt * 128;
        G3<192> g;
        g3_setup<192>(g, [&](int r) { return merged + (size_t)(row0 + r) * DM; }, [&](int r) { return wb + WB_WO + (size_t)(col0 + r) * DM; }, tid);
        f32x4 acc[3][4]; g3_zero<3>(acc);
        g3_kloop<192>(acc, g, DM, lds);
        uint2 hres[3][4];
#pragma unroll
        for (int m = 0; m < 3; ++m)
#pragma unroll
            for (int n = 0; n < 4; ++n) hres[m][n] = *(const uint2*)(h + (size_t)(row0 + wr * 48 + m * 16 + fr) * 1024 + col0 + wc * 64 + n * 16 + fq * 4);
#pragma unroll
        for (int m = 0; m < 3; ++m) {
            const int row = row0 + wr * 48 + m * 16 + fr;
#pragma unroll
            for (int n = 0; n < 4; ++n) {
                const int col = col0 + wc * 64 + n * 16 + fq * 4;
                const uint2 hv = hres[m][n];
                float4 o;
                o.x = __uint_as_float(hv.x << 16) + acc[m][n][0]; o.y = __uint_as_float(hv.x & 0xFFFF0000u) + acc[m][n][1];
                o.z = __uint_as_float(hv.y << 16) + acc[m][n][2]; o.w = __uint_as_float(hv.y & 0xFFFF0000u) + acc[m][n][3];
                *(float4*)(hm + (size_t)row * 1024 + col) = o;
            }
        }
    }
}

__device__ __constant__ int c_pair_lo[6] = {0, 0, 0, 1, 1, 2};
__device__ __constant__ int c_pair_hi[6] = {1, 2, 3, 2, 3, 3};
__device__ void phase_route(const Params& p, int l, unsigned char* lds) {
    const int tid = otid(), lane = tid & 63, wid = tid >> 6;
    const int per = (NT + (int)gridDim.x - 1) / (int)gridDim.x;
    const int nbeg = obid() * per, nend = (nbeg + per < NT) ? nbeg + per : NT;
    int* s_cls = (int*)lds;
    int* s_base = s_cls + 512;
    float* s_wr = (float*)(lds + 4096);
    const float* hm = (const float*)(WS(p) + OFF_HM32);
    bf16_t* hn = (bf16_t*)(WS(p) + OFF_HN);
    const float* nf = p.in[33] + (size_t)l * 1024;
    const float* wg = p.in[34] + (size_t)l * 1024 * 4;
    const float* bg = p.in[35] + l * 4;
    const float* we = p.in[36] + (size_t)l * 1024 * 16;
    const float* be = p.in[37] + l * 16;
    int* cnt = (int*)(WS(p) + OFF_CTL);
    int* list = (int*)(WS(p) + OFF_LIST);
    float* pw = (float*)(WS(p) + OFF_PW);
    {
        float4 gv[2], ev[8];
#pragma unroll
        for (int i = 0; i < 2; ++i) gv[i] = *(const float4*)(wg + (size_t)(tid + i * NTHR) * 4);
#pragma unroll
        for (int i = 0; i < 8; ++i) ev[i] = *(const float4*)(we + (size_t)(tid + i * NTHR) * 4);
#pragma unroll
        for (int i = 0; i < 2; ++i) { const int k = tid + i * NTHR; s_wr[k] = gv[i].x; s_wr[1024 + k] = gv[i].y; s_wr[2048 + k] = gv[i].z; s_wr[3072 + k] = gv[i].w; }
#pragma unroll
        for (int i = 0; i < 8; ++i) {
            const int q = tid + i * NTHR, k = q >> 2, e0 = 4 + (q & 3) * 4;
            s_wr[e0 * 1024 + k] = ev[i].x; s_wr[(e0 + 1) * 1024 + k] = ev[i].y; s_wr[(e0 + 2) * 1024 + k] = ev[i].z; s_wr[(e0 + 3) * 1024 + k] = ev[i].w;
        }
    }
    __syncthreads();
    float4 nv[4], cur[4];
#pragma unroll
    for (int i = 0; i < 4; ++i) nv[i] = *(const float4*)(nf + i * 256 + lane * 4);
    if (nbeg + wid < nend) {
#pragma unroll
        for (int i = 0; i < 4; ++i) cur[i] = *(const float4*)(hm + (size_t)(nbeg + wid) * DM + i * 256 + lane * 4);
    }
    for (int n = nbeg + wid; n < nend; n += 8) {
        float4 xv[4]; float ss = 0.f;
#pragma unroll
        for (int i = 0; i < 4; ++i) { xv[i] = cur[i]; ss += xv[i].x * xv[i].x + xv[i].y * xv[i].y + xv[i].z * xv[i].z + xv[i].w * xv[i].w; }
        if (n + 8 < nend) {
#pragma unroll
            for (int i = 0; i < 4; ++i) cur[i] = *(const float4*)(hm + (size_t)(n + 8) * DM + i * 256 + lane * 4);
        }
        ss = wave_sum_fast(ss);
        const float rs = rsqrtf(ss * (1.0f / 1024.0f) + 1e-6f);
        float lg[4] = {0.f, 0.f, 0.f, 0.f};
        float le[16];
#pragma unroll
        for (int e = 0; e < 16; ++e) le[e] = 0.f;
#pragma unroll
        for (int i = 0; i < 4; ++i) {
            float y[4] = {xv[i].x * rs * nv[i].x, xv[i].y * rs * nv[i].y, xv[i].z * rs * nv[i].z, xv[i].w * rs * nv[i].w};
            {
                const int d0 = i * 256 + lane * 4;
#pragma unroll
                for (int g = 0; g < 4; ++g) { const float4 w4 = *(const float4*)(s_wr + g * 1024 + d0); lg[g] += y[0] * w4.x + y[1] * w4.y + y[2] * w4.z + y[3] * w4.w; }
#pragma unroll
                for (int e = 0; e < 16; ++e) { const float4 w4 = *(const float4*)(s_wr + (4 + e) * 1024 + d0); le[e] += y[0] * w4.x + y[1] * w4.y + y[2] * w4.z + y[3] * w4.w; }
            }
            *(uint2*)(hn + (size_t)n * DM + i * 256 + lane * 4) = pack4(y[0], y[1], y[2], y[3]);
        }
#pragma unroll
        for (int g = 0; g < 4; ++g) lg[g] = wave_sum_fast(lg[g]) + bg[g];
#pragma unroll
        for (int e = 0; e < 16; ++e) le[e] = wave_sum_fast(le[e]) + be[e];
        if (lane == 0) {
            int gs = 0; float gm = lg[0];
#pragma unroll
            for (int g = 1; g < 4; ++g) if (lg[g] > gm) { gm = lg[g]; gs = g; }
            float den = 0.f;
#pragma unroll
            for (int g = 0; g < 4; ++g) den += __expf(lg[g] - gm);
            const float pgrp = 1.0f / den;
            float v4[4];
#pragma unroll
            for (int e = 0; e < 4; ++e) {
                const float m0 = (gs == 0) ? 1.f : 0.f, m1s = (gs == 1) ? 1.f : 0.f, m2s = (gs == 2) ? 1.f : 0.f, m3s = (gs == 3) ? 1.f : 0.f;
                v4[e] = le[e] * m0 + le[4 + e] * m1s + le[8 + e] * m2s + le[12 + e] * m3s;
            }
            int i1 = 0; float m1 = v4[0];
#pragma unroll
            for (int e = 1; e < 4; ++e) if (v4[e] > m1) { m1 = v4[e]; i1 = e; }
            int i2 = -1; float m2 = -INFINITY;
#pragma unroll
            for (int e = 0; e < 4; ++e) if (e != i1 && v4[e] > m2) { m2 = v4[e]; i2 = e; }
            const float e2 = __expf(m2 - m1);
            const float p1 = pgrp / (1.0f + e2), p2 = pgrp * e2 / (1.0f + e2);
            const int lo = i1 < i2 ? i1 : i2, hi = i1 < i2 ? i2 : i1;
            const float plo = i1 < i2 ? p1 : p2, phi = i1 < i2 ? p2 : p1;
            const int pi = (lo == 0) ? (hi - 1) : (lo == 1 ? hi + 1 : 5);
            const int cls = gs * 6 + pi;
            s_cls[n - nbeg] = cls;
            pw[(size_t)n * 2 + 0] = plo; pw[(size_t)n * 2 + 1] = phi;
        }
    }
    __syncthreads();
    const int nloc = nend - nbeg;
    if (tid < 24) {
        int c_ = 0;
        for (int i = 0; i < nloc; ++i) c_ += (s_cls[i] == tid) ? 1 : 0;
        s_base[tid] = c_ ? atomicAdd(&cnt[tid * 32], c_) : 0;
    }
    __syncthreads();
    for (int it = tid; it < nloc; it += NTHR) {
        const int cls = s_cls[it];
        int rank = 0;
        for (int i = 0; i < it; ++i) rank += (s_cls[i] == cls) ? 1 : 0;
        list[(size_t)cls * NT + s_base[cls] + rank] = nbeg + it;
    }
    __syncthreads();
}


struct MoeTile { int cls, ti, cnt, tg; };
__device__ __forceinline__ int moe_table(const int* cnt, unsigned char* lds) {
    int* tab = (int*)(lds + LDS_BYTES - 512);
    __syncthreads();
    if (otid() < 24) tab[otid()] = cnt[otid() * 32];
    __syncthreads();
    if (otid() == 0) { int s_ = 0; for (int c = 0; c < 24; ++c) { tab[24 + c] = s_; s_ += (tab[c] + 127) >> 7; } tab[48] = s_; }
    __syncthreads();
    return tab[48];
}
__device__ __forceinline__ MoeTile moe_find(const unsigned char* lds, int tile) {
    const int* tab = (const int*)(lds + LDS_BYTES - 512);
    MoeTile r; r.cls = 0; r.ti = 0; r.cnt = 0; r.tg = tile;
    for (int c = 0; c < 24; ++c) { const int s_ = tab[24 + c], e_ = tab[25 + c]; if (tile >= s_ && tile < e_) { r.cls = c; r.ti = tile - s_; r.cnt = tab[c]; } }
    return r;
}
__device__ void phase_moe1(const Params& p, unsigned char* lds) {
    const int tid = otid(), lane = tid & 63, wid = tid >> 6, wr = wid >> 1, wc = wid & 1, fr = lane & 15, fq = lane >> 4;
    const int* cnt = (const int*)(WS(p) + OFF_CTL);
    const int* list = (const int*)(WS(p) + OFF_LIST);
    const float* pw = (const float*)(WS(p) + OFF_PW);
    const bf16_t* hn = (const bf16_t*)(WS(p) + OFF_HN);
    const bf16_t* we = (const bf16_t*)(WS(p) + OFF_WEXP);
    bf16_t* hid = (bf16_t*)(OUTB(p) + DO_HID);
    const int total = moe_table(cnt, lds);
    const int xq = obid() & 7, yq = obid() >> 3, ystep = gridDim.x >> 3;
    for (int idx = yq; ; idx += ystep) {
        const int tix = (idx >> 2) * 8 + xq;
        if (tix >= total) break;
        const MoeTile mt = moe_find(lds, tix);
        const int nt = idx & 3, slot = nt >> 1, f0 = (nt & 1) * 128;
        const int g_ = mt.cls / 6, pi = mt.cls % 6;
        const int e = g_ * 4 + (slot == 0 ? c_pair_lo[pi] : c_pair_hi[pi]);
        const int* lst = list + (size_t)mt.cls * NT + mt.ti * 128;
        const int nvalid = min(128, mt.cnt - mt.ti * 128);
        f32x4 a1[2][4], a3[2][4]; g3_zero<2>(a1); g3_zero<2>(a3);
        G3D g;
#pragma unroll
        for (int i = 0; i < 2; ++i) {
            const int idx = tid + i * NTHR, row = idx >> 3, sl = (idx & 7) ^ (row & 7);
            g.ap[i] = hn + (size_t)lst[row < nvalid ? row : 0] * DM + sl * 8;
            g.b1[i] = we + WE_W1 + ((size_t)e * 256 + f0 + row) * 1024 + sl * 8;
            g.b3[i] = we + WE_W3 + ((size_t)e * 256 + f0 + row) * 1024 + sl * 8;
        }
        g3d_kloop(a1, a3, g, DM, lds);
        float pev[2];
#pragma unroll
        for (int m = 0; m < 2; ++m) { const int lr = wr * 32 + m * 16 + fr; pev[m] = pw[(size_t)lst[lr < nvalid ? lr : 0] * 2 + slot]; }
#pragma unroll
        for (int m = 0; m < 2; ++m) {
            const int lr = wr * 32 + m * 16 + fr;
            const float pe = pev[m];
#pragma unroll
            for (int n = 0; n < 4; ++n) {
                const int col = slot * 256 + f0 + wc * 64 + n * 16 + fq * 4;
                float o[4];
#pragma unroll
                for (int j = 0; j < 4; ++j) { const float x1 = a1[m][n][j]; o[j] = x1 * sigmoidf_(x1) * a3[m][n][j] * pe; }
                *(uint2*)(hid + ((size_t)mt.tg * 128 + lr) * 512 + col) = pack4(o[0], o[1], o[2], o[3]);
            }
        }
    }
}
__device__ void phase_moe2(const Params& p, int l, unsigned char* lds) {
    const int tid = otid(), lane = tid & 63, wid = tid >> 6, wr = wid >> 1, wc = wid & 1, fr = lane & 15, fq = lane >> 4;
    const int* cnt = (const int*)(WS(p) + OFF_CTL);
    const int* list = (const int*)(WS(p) + OFF_LIST);
    const bf16_t* we = (const bf16_t*)(WS(p) + OFF_WEXP);
    const bf16_t* hid = (const bf16_t*)(OUTB(p) + DO_HID);
    float* hm = (float*)(WS(p) + OFF_HM32);
    bf16_t* h = (bf16_t*)(WS(p) + OFF_H);
    const int total = moe_table(cnt, lds);
    const int xq = obid() & 7, yq = obid() >> 3, ystep = gridDim.x >> 3;
    for (int idx = yq; ; idx += ystep) {
        const int tix = (idx >> 3) * 8 + xq;
        if (tix >= total) break;
        const MoeTile mt = moe_find(lds, tix);
        const int nt = idx & 7, col0 = nt * 128;
        const int g_ = mt.cls / 6, pi = mt.cls % 6;
        const int elo = g_ * 4 + c_pair_lo[pi], ehi = g_ * 4 + c_pair_hi[pi];
        const int* lst = list + (size_t)mt.cls * NT + mt.ti * 128;
        const int nvalid = min(128, mt.cnt - mt.ti * 128);
        f32x4 acc[2][4]; g3_zero<2>(acc);
        G3<128> g;
        g3_setup<128>(g, [&](int r) { return hid + ((size_t)mt.tg * 128 + r) * 512; }, [&](int r) { return we + WE_W2 + ((size_t)elo * 1024 + col0 + r) * 256; }, tid);
        g3_kloop<128>(acc, g, 256, lds);
        g3_setup<128>(g, [&](int r) { return hid + ((size_t)mt.tg * 128 + r) * 512 + 256; }, [&](int r) { return we + WE_W2 + ((size_t)ehi * 1024 + col0 + r) * 256; }, tid);
        g3_kloop<128>(acc, g, 256, lds);
        int tkv[2]; float4 hv[2][4];
#pragma unroll
        for (int m = 0; m < 2; ++m) {
            const int lr = wr * 32 + m * 16 + fr;
            tkv[m] = lst[lr < nvalid ? lr : 0];
#pragma unroll
            for (int n = 0; n < 4; ++n) hv[m][n] = *(const float4*)(hm + (size_t)tkv[m] * 1024 + col0 + wc * 64 + n * 16 + fq * 4);
        }
#pragma unroll
        for (int m = 0; m < 2; ++m) {
            const int lr = wr * 32 + m * 16 + fr;
            if (lr < nvalid) {
                const int tk = tkv[m];
#pragma unroll
                for (int n = 0; n < 4; ++n) {
                    const int col = col0 + wc * 64 + n * 16 + fq * 4;
                    float4 v = hv[m][n];
                    v.x += acc[m][n][0]; v.y += acc[m][n][1]; v.z += acc[m][n][2]; v.w += acc[m][n][3];
                    if (l == 0) *(uint2*)(h + (size_t)tk * 1024 + col) = pack4(v.x, v.y, v.z, v.w);
                    else *(float4*)(hm + (size_t)tk * 1024 + col) = v;
                }
            }
        }
    }
}

__device__ void phase_final(const Params& p) {
    const int lane = otid() & 63;
    const int wave = (obid() * NTHR + otid()) >> 6, nw = gridDim.x * NTHR / 64;
    const float* hm = (const float*)(WS(p) + OFF_HM32);
    const float* nf = p.in[41];
    float4 g[4], cur[4];
#pragma unroll
    for (int i = 0; i < 4; ++i) g[i] = *(const float4*)(nf + i * 256 + lane * 4);
    auto rowp = [&](int r) { const int b = r / SEQ, s_ = r % SEQ; return hm + ((size_t)b * TS + NMETA + s_) * DM; };
    if (wave < NB * SEQ) {
        const float* src = rowp(wave);
#pragma unroll
        for (int i = 0; i < 4; ++i) cur[i] = *(const float4*)(src + i * 256 + lane * 4);
    }
    for (int r = wave; r < NB * SEQ; r += nw) {
        float4 v[4]; float ss = 0.f;
#pragma unroll
        for (int i = 0; i < 4; ++i) { v[i] = cur[i]; ss += v[i].x * v[i].x + v[i].y * v[i].y + v[i].z * v[i].z + v[i].w * v[i].w; }
        if (r + nw < NB * SEQ) {
            const float* src = rowp(r + nw);
#pragma unroll
            for (int i = 0; i < 4; ++i) cur[i] = *(const float4*)(src + i * 256 + lane * 4);
        }
        ss = wave_sum_fast(ss);
        const float rs = rsqrtf(ss * (1.0f / 1024.0f) + 1e-6f);
#pragma unroll
        for (int i = 0; i < 4; ++i) {
            float4 o; o.x = v[i].x * rs * g[i].x; o.y = v[i].y * rs * g[i].y; o.z = v[i].z * rs * g[i].z; o.w = v[i].w * rs * g[i].w;
            *(float4*)((float*)OUTB(p) + (size_t)r * DM + i * 256 + lane * 4) = o;
        }
    }
}


#define XB_TMO      128
#define XB_XCNT(j)  (256  + 64 * (j))
#define XB_XSUB(j)  (1280 + 64 * (j))
#define XB_XGEN(j)  (2304 + 64 * (j))
#define XB_TOP      3328
#define XB_TOPGEN   3392
#define XCD_BAR_WORDS 3456
#define XB_SPIN_CAP (1u << 22)
#define LAS __attribute__((address_space(3)))
__device__ __forceinline__ unsigned xb_ld(unsigned* p) { return __hip_atomic_load(p, __ATOMIC_RELAXED, __HIP_MEMORY_SCOPE_AGENT); }
__device__ __forceinline__ unsigned xb_add(unsigned* p, unsigned v) { return __hip_atomic_fetch_add(p, v, __ATOMIC_RELAXED, __HIP_MEMORY_SCOPE_AGENT); }
__device__ __forceinline__ unsigned xb_xcc_id() { return (unsigned)__builtin_amdgcn_s_getreg((3 << 11) | 20) & 0xFu; }
#define XB_SPIN(cond, bar) do { unsigned _sp = 0; while (cond) { __builtin_amdgcn_s_sleep(1); \
    if ((++_sp & 255u) == 0u) { if (xb_ld(&(bar)[XB_TMO])) break; if (_sp > XB_SPIN_CAP) { atomicAdd(&(bar)[XB_TMO], 1u); break; } } } } while (0)
struct XcdBarrier { unsigned* bar; unsigned x; volatile LAS unsigned* st; };
__device__ __forceinline__ XcdBarrier xcd_barrier_post(unsigned* bar, volatile LAS unsigned* st) {
    XcdBarrier b; b.bar = bar; b.x = xb_xcc_id(); b.st = st;
    if (threadIdx.x == 0) (void)xb_add(&bar[XB_XCNT(b.x)], 1u);
    return b;
}
__device__ __forceinline__ void xcd_barrier_complete(unsigned* bar, unsigned x, unsigned& nloc, unsigned& nx) {
    const unsigned G = gridDim.x * gridDim.y * gridDim.z;
    unsigned sum, cnt, mine, sp = 0u;
    for (;;) {
        sum = 0u; cnt = 0u; mine = 0u;
#pragma unroll
        for (unsigned j = 0; j < 16; ++j) { const unsigned c = xb_ld(&bar[XB_XCNT(j)]); sum += c; cnt += (c > 0u) ? 1u : 0u; mine = (j == x) ? c : mine; }
        if (sum == G) break;
        __builtin_amdgcn_s_sleep(1);
        if ((++sp & 255u) == 0u) { if (xb_ld(&bar[XB_TMO])) break; if (sp > XB_SPIN_CAP) { atomicAdd(&bar[XB_TMO], 1u); break; } }
    }
    nloc = mine > 0u ? mine : 1u; nx = cnt > 0u ? cnt : 1u;
}
__device__ __forceinline__ void xcd_barrier(const XcdBarrier& b) {
    asm volatile("s_waitcnt vmcnt(0)" ::: "memory");
    __syncthreads();
    if (threadIdx.x == 0) {
        unsigned* bar = b.bar;
        __builtin_amdgcn_s_waitcnt(0);
        unsigned nloc = b.st[0], nx = b.st[1];
        if (nloc == 0u) { xcd_barrier_complete(bar, b.x, nloc, nx); b.st[0] = nloc; b.st[1] = nx; }
        const unsigned old = xb_add(&bar[XB_XSUB(b.x)], 1u);
        const unsigned gen = old / nloc;
        if (old + 1u == (gen + 1u) * nloc) {
            __builtin_amdgcn_fence(__ATOMIC_RELEASE, "agent");
            asm volatile("s_waitcnt vmcnt(0)" ::: "memory");
            const unsigned og = xb_add(&bar[XB_TOP], 1u);
            const unsigned tg = og / nx;
            if (og + 1u == (tg + 1u) * nx) xb_add(&bar[XB_TOPGEN], 1u);
            else XB_SPIN(xb_ld(&bar[XB_TOPGEN]) == tg, bar);
            __builtin_amdgcn_fence(__ATOMIC_ACQUIRE, "agent");
            xb_add(&bar[XB_XGEN(b.x)], 1u);
            asm volatile("s_waitcnt vmcnt(0)" ::: "memory");
        } else {
            XB_SPIN(xb_ld(&bar[XB_XGEN(b.x)]) == gen, bar);
            __builtin_amdgcn_fence(__ATOMIC_ACQUIRE, "agent");
            asm volatile("s_waitcnt vmcnt(0)" ::: "memory");
        }
    }
    __syncthreads();
}

__global__ void __launch_bounds__(NTHR) fwd_megakernel(Params p) {
    extern __shared__ __attribute__((aligned(16))) unsigned char lds[];
    cg::grid_group grid = cg::this_grid();
    volatile LAS unsigned* xst = (volatile LAS unsigned*)(lds + LDS_BYTES - 32);
    if (threadIdx.x < 2) xst[threadIdx.x] = 0u;
    __syncthreads();
    const XcdBarrier xb = xcd_barrier_post((unsigned*)(p.ws + OFF_BAR), xst);
    if (p.out == nullptr) grid.sync();
#pragma unroll 1
    for (int step = 0; step < 18; ++step) {
        const int l = step >= 9 ? 1 : 0;
        const int ph = step - l * 9;
        switch (ph) {
        case 0:
            if (l == 0) phase_embed(p); else phase_rowstat(p);
            phase_convert<false>(p, l, lds);
            if (obid() == 0 && otid() < 24) ((int*)(WS(p) + OFF_CTL))[otid() * 32] = 0;
            if (obid() == 0 && otid() == 32) ((int*)(WS(p) + OFF_CTL))[800 + l * 32] = 0;
            break;
        case 1: phase_inproj(p, lds); break;
        case 2: phase_dsa_prep(p, l); phase_lr_prep(p, l); break;
        case 3: {
            if (obid() < NB * 16) phase_scan5(p, l, lds, obid());
            int* qctr = (int*)(WS(p) + OFF_CTL) + 800 + l * 32;
            int* qslot = (int*)(lds + LDS_BYTES - 16);
            for (;;) {
                __syncthreads();
                if (otid() == 0) *qslot = atomicAdd(qctr, 1);
                __syncthreads();
                const int item = *qslot;
                if (item >= 516 + NT / 32 + 3072) break;
                if (item < 516) phase_pool(p, l, lds, item, item + 1, 1);
                else if (item < 516 + NT / 32) phase_dsa<false>(p, l, lds, (bf16_t*)(OUTB(p) + DO_YC), nullptr, nullptr, item - 516, item - 515, 1);
                else {
                    const int ct = item - (516 + NT / 32);
                    const ConvJob cj = get_job_late(p, l, ct >> 10);
                    conv_tile(cj, ct & 1023, (float*)lds);
                }
            }
        } break;
        case 4: phase_merge(p, lds); break;
        case 5: phase_outproj(p, lds); break;
        case 6: phase_route(p, l, lds); break;
        case 7: phase_moe1(p, lds); break;
        default: phase_moe2(p, l, lds); break;
        }
        xcd_barrier(xb);
    }
    phase_final(p);
}

extern "C" void kernel_launch(void* const* d_in, const int* in_sizes, int n_in,
                              void* d_out, int out_size, void* d_ws, size_t ws_size,
                              hipStream_t stream) {
    static int grid_blocks = 0;
    if (grid_blocks == 0) {
        int dev = 0, cus = 0, per_cu = 0;
        (void)hipGetDevice(&dev);
        (void)hipDeviceGetAttribute(&cus, hipDeviceAttributeMultiprocessorCount, dev);
        (void)hipFuncSetAttribute((const void*)fwd_megakernel, hipFuncAttributeMaxDynamicSharedMemorySize, LDS_BYTES);
        (void)hipOccupancyMaxActiveBlocksPerMultiprocessor(&per_cu, fwd_megakernel, NTHR, LDS_BYTES);
        if (per_cu < 1 || cus < NB * 16 || (cus & 7) != 0 || n_in != 42 || ws_size < WS_END + (size_t)QS_WS * QS_BYTES || cus > QS_WS + QS_DO) { fprintf(stderr, "kernel_launch: bad config per_cu=%d n_in=%d ws=%zu need=%zu\n", per_cu, n_in, ws_size, (size_t)WS_END); grid_blocks = -1; }
        else grid_blocks = cus;
    }
    if (grid_blocks < 0) return;
    Params p{};
    for (int i = 0; i < 42; ++i) p.in[i] = (const float*)d_in[i];
    p.out = (float*)d_out;
    p.ws = (unsigned char*)d_ws;
    (void)hipMemsetAsync((unsigned char*)d_ws + OFF_BAR, 0, XCD_BAR_WORDS * 4, stream);
    void* args[] = {&p};
    hipError_t e = hipLaunchCooperativeKernel((void*)fwd_megakernel, dim3(grid_blocks), dim3(NTHR), args, LDS_BYTES, stream);
    if (e != hipSuccess) fprintf(stderr, "cooperative launch failed: %s (grid %d)\n", hipGetErrorString(e), grid_blocks);
}
```

```cpp
#include <hip/hip_runtime.h>
#include <hip/hip_cooperative_groups.h>
#include <cstdio>
#include <cstdint>
#include <type_traits>
namespace cg = cooperative_groups;

typedef unsigned short bf16_t;
typedef short bf16x8 __attribute__((ext_vector_type(8)));
typedef float f32x4 __attribute__((ext_vector_type(4)));

constexpr int NB = 8, SEQ = 2048, NMETA = 16, TS = 2064, DM = 1024;
constexpr int NT = NB * TS;
constexpr int NTP = 16640;
constexpr int NTHR = 512;
constexpr int CIN = 7912;
constexpr int NP1 = 4864;
constexpr int PM_LD = 768;
constexpr int PM_WD = 0, PM_AD = 64, PM_GD = 128, PM_VD = 256, PM_CQ = 288, PM_CKV = 544, PM_KROPE = 672, PM_KIDX = 704;
constexpr int LDS_BYTES = 157 * 1024;
constexpr int FILL3 = 0;

constexpr size_t AL(size_t x) { return (x + 255) & ~(size_t)255; }
constexpr size_t SZ_ACT = (size_t)NTP * 1024 * 2;
constexpr size_t OFF_CTL = 0;
constexpr size_t OFF_BAR = 4096;
constexpr size_t OFF_RSTD = OFF_BAR + 16384;
constexpr size_t OFF_ROPE = OFF_RSTD + AL((size_t)NTP * 4);
constexpr size_t OFF_H = OFF_ROPE + AL((size_t)TS * 16 * 4 * 2);
constexpr size_t OFF_WB = OFF_H + SZ_ACT;
constexpr size_t WB_WIN = 0;
constexpr size_t WB_WG = WB_WIN + (size_t)NP1 * 1024;
constexpr size_t WB_PA = WB_WG + (size_t)3072 * 1024;
constexpr size_t WB_WO = WB_PA + (size_t)3 * 1024 * 1024;
constexpr size_t WB_POOL = WB_WO + (size_t)1024 * 1024;
constexpr size_t WB_QI = WB_POOL + (size_t)4 * 256 * 256;
constexpr size_t WB_UQ = WB_QI + (size_t)512 * 256;
constexpr size_t WB_UK = WB_UQ + (size_t)1536 * 256;
constexpr size_t WB_UV = WB_UK + (size_t)16 * 128 * 64;
constexpr size_t WB_WIDX = WB_UV + (size_t)16 * 64 * 128;
constexpr size_t WB_END = WB_WIDX + (size_t)64 * 1024;
constexpr size_t OFF_PPOOL = OFF_WB + AL(WB_END * 2);
constexpr size_t OFF_PK = OFF_PPOOL + SZ_ACT;
constexpr size_t OFF_PR = OFF_PK + SZ_ACT;
constexpr size_t OFF_PV = OFF_PR + SZ_ACT;
constexpr size_t OFF_PMISC = OFF_PV + SZ_ACT;
constexpr size_t OFF_VFIRST = OFF_PMISC + AL((size_t)NTP * PM_LD * 2);
constexpr size_t OFF_HALO = OFF_VFIRST + SZ_ACT;
constexpr size_t OFF_LIST = OFF_HALO + AL((size_t)130 * 16 * 1024 * 2);
constexpr size_t OFF_PW = OFF_LIST + AL((size_t)24 * NT * 4);
constexpr size_t OFF_SSQ = OFF_PW + AL((size_t)NT * 2 * 4);
constexpr size_t WS_END = OFF_SSQ + AL((size_t)NTP * 8);
constexpr size_t OFF_MERGED = OFF_PK;
constexpr size_t OFF_HMB = OFF_PR;
constexpr size_t OFF_HN = OFF_PPOOL;
constexpr size_t OFF_WEXP = OFF_PMISC;
constexpr size_t WE_W1 = 0, WE_W3 = (size_t)16 * 256 * 1024, WE_W2 = (size_t)2 * 16 * 256 * 1024;
static_assert((size_t)3 * 16 * 256 * 1024 * 2 <= (size_t)NTP * PM_LD * 2, "expert weights must fit in Pmisc");
constexpr size_t DO_YC = 0;
constexpr size_t DO_CQN = DO_YC + SZ_ACT;
constexpr size_t DO_KV = DO_CQN + AL((size_t)NT * 256 * 2);
constexpr size_t DO_KIDX = DO_KV + AL((size_t)NT * 160 * 2);
constexpr size_t DO_WHEAD = DO_KIDX + AL((size_t)NT * 64 * 2);
constexpr size_t DO_ALR = DO_WHEAD + AL((size_t)NT * 8 * 4);
constexpr size_t DO_END = DO_ALR + AL((size_t)NT * 288 * 2);
constexpr size_t QS_BYTES = (size_t)16 * 16 * 160 * 2;
constexpr int QS_WS = (int)((277240096ull - WS_END) / QS_BYTES), QS_DO = (int)(((size_t)NB * SEQ * DM * 4 - DO_END) / QS_BYTES);
static_assert(QS_WS + QS_DO >= 256, "Q scratch");
constexpr size_t DO_HID = DO_YC;
static_assert(DO_END <= (size_t)NB * SEQ * DM * 4, "d_out scratch overflow");
static_assert((size_t)(129 + 24) * 128 * 512 * 2 <= SZ_ACT, "hid fits");
static_assert(WS_END <= 277240096ull, "workspace overflow");

struct Params {
    const float* in[42];
    float* out;
    unsigned char* ws;
};

__device__ __forceinline__ int otid() { int t = threadIdx.x; asm volatile("" : "+v"(t)); return t; }
__device__ __forceinline__ int obid() { int b = blockIdx.x; asm volatile("" : "+s"(b)); return b; }
typedef __attribute__((address_space(1))) unsigned char gas_uchar;
__device__ __forceinline__ unsigned char* WS(const Params& p) { gas_uchar* w = (gas_uchar*)p.ws; asm volatile("" : "+s"(w)); return (unsigned char*)w; }
__device__ __forceinline__ unsigned char* OUTB(const Params& p) { gas_uchar* w = (gas_uchar*)p.out; asm volatile("" : "+s"(w)); return (unsigned char*)w; }
__device__ __forceinline__ float bf2f(bf16_t v) { return __uint_as_float(((unsigned)v) << 16); }
typedef float f32x2v __attribute__((ext_vector_type(2)));
typedef __bf16 bf16x2v __attribute__((ext_vector_type(2)));
__device__ __forceinline__ unsigned pk2(float a, float b) { const f32x2v v = {a, b}; const bf16x2v r = __builtin_convertvector(v, bf16x2v); unsigned u; __builtin_memcpy(&u, &r, 4); return u; }
__device__ __forceinline__ bf16_t f2bf(float f) { const __bf16 h = (__bf16)f; bf16_t u; __builtin_memcpy(&u, &h, 2); return u; }
__device__ __forceinline__ float wave_sum(float v) {
#pragma unroll
    for (int o = 32; o > 0; o >>= 1) v += __shfl_xor(v, o);
    return v;
}
template <int CTRL> __device__ __forceinline__ float dpp_f(float x) {
    return __int_as_float(__builtin_amdgcn_update_dpp(0, __float_as_int(x), CTRL, 0xF, 0xF, true));
}
__device__ __forceinline__ float row16_sum(float v) {
    v += dpp_f<0xB1>(v);
    v += dpp_f<0x4E>(v);
    v += dpp_f<0x141>(v);
    v += dpp_f<0x140>(v);
    return v;
}
__device__ __forceinline__ void lds_barrier() { asm volatile("s_waitcnt lgkmcnt(0)" ::: "memory"); __builtin_amdgcn_s_barrier(); asm volatile("" ::: "memory"); }
__device__ __forceinline__ float fast_rcp(float x) { return __builtin_amdgcn_rcpf(x); }
__device__ __forceinline__ float fast_sigmoid(float x) { return fast_rcp(1.0f + __expf(-x)); }
__device__ __forceinline__ float fast_tanh(float x) { return 1.0f - 2.0f * fast_rcp(1.0f + __expf(2.0f * x)); }
__device__ __forceinline__ void row16_sum4(float& a, float& b, float& c, float& d) {
    asm volatile(
        "s_nop 1\n\t"
        "v_add_f32_dpp %0, %0, %0 quad_perm:[1,0,3,2] row_mask:0xf bank_mask:0xf\n\t"
        "v_add_f32_dpp %1, %1, %1 quad_perm:[1,0,3,2] row_mask:0xf bank_mask:0xf\n\t"
        "v_add_f32_dpp %2, %2, %2 quad_perm:[1,0,3,2] row_mask:0xf bank_mask:0xf\n\t"
        "v_add_f32_dpp %3, %3, %3 quad_perm:[1,0,3,2] row_mask:0xf bank_mask:0xf\n\t"
        "v_add_f32_dpp %0, %0, %0 quad_perm:[2,3,0,1] row_mask:0xf bank_mask:0xf\n\t"
        "v_add_f32_dpp %1, %1, %1 quad_perm:[2,3,0,1] row_mask:0xf bank_mask:0xf\n\t"
        "v_add_f32_dpp %2, %2, %2 quad_perm:[2,3,0,1] row_mask:0xf bank_mask:0xf\n\t"
        "v_add_f32_dpp %3, %3, %3 quad_perm:[2,3,0,1] row_mask:0xf bank_mask:0xf\n\t"
        "v_add_f32_dpp %0, %0, %0 row_half_mirror row_mask:0xf bank_mask:0xf\n\t"
        "v_add_f32_dpp %1, %1, %1 row_half_mirror row_mask:0xf bank_mask:0xf\n\t"
        "v_add_f32_dpp %2, %2, %2 row_half_mirror row_mask:0xf bank_mask:0xf\n\t"
        "v_add_f32_dpp %3, %3, %3 row_half_mirror row_mask:0xf bank_mask:0xf\n\t"
        "v_add_f32_dpp %0, %0, %0 row_mirror row_mask:0xf bank_mask:0xf\n\t"
        "v_add_f32_dpp %1, %1, %1 row_mirror row_mask:0xf bank_mask:0xf\n\t"
        "v_add_f32_dpp %2, %2, %2 row_mirror row_mask:0xf bank_mask:0xf\n\t"
        "v_add_f32_dpp %3, %3, %3 row_mirror row_mask:0xf bank_mask:0xf\n\t"
        "s_nop 1"
        : "+v"(a), "+v"(b), "+v"(c), "+v"(d));
}
__device__ __forceinline__ void row8_sum2(float& a, float& b) {
    asm volatile(
        "s_nop 1\n\t"
        "v_add_f32_dpp %0, %0, %0 quad_perm:[1,0,3,2] row_mask:0xf bank_mask:0xf\n\t"
        "v_add_f32_dpp %1, %1, %1 quad_perm:[1,0,3,2] row_mask:0xf bank_mask:0xf\n\t"
        "s_nop 0\n\t"
        "v_add_f32_dpp %0, %0, %0 quad_perm:[2,3,0,1] row_mask:0xf bank_mask:0xf\n\t"
        "v_add_f32_dpp %1, %1, %1 quad_perm:[2,3,0,1] row_mask:0xf bank_mask:0xf\n\t"
        "s_nop 0\n\t"
        "v_add_f32_dpp %0, %0, %0 row_half_mirror row_mask:0xf bank_mask:0xf\n\t"
        "v_add_f32_dpp %1, %1, %1 row_half_mirror row_mask:0xf bank_mask:0xf\n\t"
        "s_nop 1"
        : "+v"(a), "+v"(b));
}
__device__ __forceinline__ float xrow_sum(float v) {
    const auto a = __builtin_amdgcn_permlane16_swap(__float_as_uint(v), __float_as_uint(v), false, false);
    v = __uint_as_float(a[0]) + __uint_as_float(a[1]);
    const auto b = __builtin_amdgcn_permlane32_swap(__float_as_uint(v), __float_as_uint(v), false, false);
    return __uint_as_float(b[0]) + __uint_as_float(b[1]);
}
__device__ __forceinline__ float wave_sum_fast(float v) { return xrow_sum(row16_sum(v)); }
__device__ __forceinline__ float sigmoidf_(float x) { return 1.0f / (1.0f + __expf(-x)); }
__device__ __forceinline__ float softplusf_(float z) { return fmaxf(z, 0.f) + log1pf(__expf(-fabsf(z))); }
__device__ __forceinline__ void glds16(const void* g, void* l) {
    __builtin_amdgcn_global_load_lds((const unsigned*)g, (unsigned*)l, 16, 0, 0);
}

__device__ void phase_embed(const Params& p) {
    const int lane = otid() & 63;
    const int wave = (obid() * NTHR + otid()) >> 6, nw = gridDim.x * NTHR / 64;
    bf16_t* h = (bf16_t*)(WS(p) + OFF_H);
    float* rstd = (float*)(WS(p) + OFF_RSTD);
    auto srcrow = [&](int n) { const int b = n / TS, t = n % TS; return t < NMETA ? p.in[1] + (size_t)t * DM : p.in[0] + ((size_t)b * SEQ + (t - NMETA)) * DM; };
    float4 cur[4];
    if (wave < NT) {
        const float* src = srcrow(wave);
#pragma unroll
        for (int i = 0; i < 4; ++i) cur[i] = *(const float4*)(src + i * 256 + lane * 4);
    }
    for (int n = wave; n < NTP; n += nw) {
        if (n < NT) {
            float4 v[4];
#pragma unroll
            for (int i = 0; i < 4; ++i) v[i] = cur[i];
            if (n + nw < NT) {
                const float* src = srcrow(n + nw);
#pragma unroll
                for (int i = 0; i < 4; ++i) cur[i] = *(const float4*)(src + i * 256 + lane * 4);
            }
            float ss = 0.f;
#pragma unroll
            for (int i = 0; i < 4; ++i) {
                ss += v[i].x * v[i].x + v[i].y * v[i].y + v[i].z * v[i].z + v[i].w * v[i].w;
                *(uint2*)(h + (size_t)n * DM + i * 256 + lane * 4) = make_uint2(pk2(v[i].x, v[i].y), pk2(v[i].z, v[i].w));
            }
            ss = wave_sum_fast(ss);
            if (lane == 0) rstd[n] = rsqrtf(ss * (1.0f / 1024.0f) + 1e-6f);
        } else {
#pragma unroll
            for (int i = 0; i < 4; ++i) *(ushort4*)(h + (size_t)n * DM + i * 256 + lane * 4) = make_ushort4(0, 0, 0, 0);
            if (lane == 0) rstd[n] = 0.f;
        }
    }
    unsigned long long* ssq = (unsigned long long*)(WS(p) + OFF_SSQ);
    for (int idx = obid() * NTHR + otid(); idx < NTP; idx += gridDim.x * NTHR) ssq[idx] = 0ull;
    float* ctab = (float*)(WS(p) + OFF_ROPE);
    float* stab = ctab + TS * 16;
    for (int idx = obid() * NTHR + otid(); idx < TS * 16; idx += gridDim.x * NTHR) {
        const int t = idx >> 4, i = idx & 15;
        const float inv = powf(10000.0f, -(float)(2 * i) / 32.0f);
        const float ang = (float)t * inv;
        ctab[idx] = cosf(ang);
        stab[idx] = sinf(ang);
    }
}

__device__ void phase_rowstat(const Params& p) {
    const int lane = otid() & 63;
    const int wave = (obid() * NTHR + otid()) >> 6, nw = gridDim.x * NTHR / 64;
    const bf16_t* hb = (const bf16_t*)(WS(p) + OFF_H);
    float* rstd = (float*)(WS(p) + OFF_RSTD);
    uint4 cur[2];
    if (wave < NT) { cur[0] = *(const uint4*)(hb + (size_t)wave * DM + lane * 8); cur[1] = *(const uint4*)(hb + (size_t)wave * DM + 512 + lane * 8); }
    for (int n = wave; n < NT; n += nw) {
        float ss = 0.f;
#pragma unroll
        for (int i = 0; i < 2; ++i) {
            const unsigned w_[4] = {cur[i].x, cur[i].y, cur[i].z, cur[i].w};
#pragma unroll
            for (int j = 0; j < 4; ++j) { const float a_ = __uint_as_float(w_[j] << 16), b_ = __uint_as_float(w_[j] & 0xFFFF0000u); ss += a_ * a_ + b_ * b_; }
        }
        if (n + nw < NT) { cur[0] = *(const uint4*)(hb + (size_t)(n + nw) * DM + lane * 8); cur[1] = *(const uint4*)(hb + (size_t)(n + nw) * DM + 512 + lane * 8); }
        ss = wave_sum_fast(ss);
        if (lane == 0) rstd[n] = rsqrtf(ss * (1.0f / 1024.0f) + 1e-6f);
    }
}

struct ConvJob { const float* src; bf16_t* dst; const float* scale; int ldsrc, K, nvalid, nrows, nb, notr; size_t sbs, dbs; const float* srcB; int ldB, split; };
__device__ __forceinline__ int conv_job_tiles(const ConvJob& j) { return j.nb * (j.nrows >> 6) * (j.K >> 6); }
__device__ void conv_tile(const ConvJob& j, int tile, float* lds) {
    const int per = (j.nrows >> 6) * (j.K >> 6);
    const int bi = tile / per, rem = tile % per;
    const int ktiles = j.K >> 6;
    const int n0 = (rem / ktiles) << 6, k0 = (rem % ktiles) << 6;
    const int tid = otid(), tn = tid & 63, tk = tid >> 6;
    const float* src = j.src + (size_t)bi * j.sbs;
    bf16_t* dst = j.dst + (size_t)bi * j.dbs;
    float vv[8];
    if (j.split) {
#pragma unroll
        for (int kk = 0; kk < 8; ++kk) {
            const int k = k0 + tk * 8 + kk, nn = n0 + tn;
            float v = 0.f;
            if (nn < j.nvalid) v = (nn < j.split) ? (j.src ? j.src[(size_t)k * j.ldsrc + nn] : 0.f) : j.srcB[(size_t)k * j.ldB + (nn - j.split)];
            vv[kk] = v;
        }
    } else {
        const int nn = (n0 + tn < j.nvalid) ? n0 + tn : j.nvalid - 1;
#pragma unroll
        for (int kk = 0; kk < 8; ++kk) { const int k = k0 + tk * 8 + kk; vv[kk] = j.notr ? src[(size_t)nn * j.ldsrc + k] : src[(size_t)k * j.ldsrc + nn]; }
    }
    if (j.scale) {
        float sc[8];
#pragma unroll
        for (int kk = 0; kk < 8; ++kk) sc[kk] = j.scale[k0 + tk * 8 + kk];
#pragma unroll
        for (int kk = 0; kk < 8; ++kk) vv[kk] *= sc[kk];
    }
    {
        const bool okc = n0 + tn < j.nvalid;
#pragma unroll
        for (int kk = 0; kk < 8; ++kk) lds[tn * 65 + tk * 8 + kk] = okc ? vv[kk] : 0.f;
    }
    __syncthreads();
    const int wn = tid >> 3, kq = tid & 7;
    uint4 o;
    unsigned w[4];
#pragma unroll
    for (int q = 0; q < 4; ++q) {
        const float lo = lds[wn * 65 + kq * 8 + 2 * q], hi = lds[wn * 65 + kq * 8 + 2 * q + 1];
        w[q] = pk2(lo, hi);
    }
    o.x = w[0]; o.y = w[1]; o.z = w[2]; o.w = w[3];
    *(uint4*)(dst + (size_t)(n0 + wn) * j.K + k0 + kq * 8) = o;
    __syncthreads();
}
__device__ __forceinline__ void conv_group4(const ConvJob& j, int tile0, float* lds) {
    const int per = (j.nrows >> 6) * (j.K >> 6), ktiles = j.K >> 6;
    const int tid = otid(), tn = tid & 63, tk = tid >> 6;
    float v[4][8];
#pragma unroll
    for (int u = 0; u < 4; ++u) {
        const int bi = (tile0 + u) / per, rem = (tile0 + u) % per;
        const int n0 = (rem / ktiles) << 6, k0 = (rem % ktiles) << 6;
        const int nn = (n0 + tn < j.nvalid) ? n0 + tn : j.nvalid - 1;
        const float* src = j.src + (size_t)bi * j.sbs + nn;
#pragma unroll
        for (int kk = 0; kk < 8; ++kk) v[u][kk] = src[(size_t)(k0 + tk * 8 + kk) * j.ldsrc];
    }
#pragma unroll
    for (int u = 0; u < 4; ++u) {
        const int bi = (tile0 + u) / per, rem = (tile0 + u) % per;
        const int n0 = (rem / ktiles) << 6, k0 = (rem % ktiles) << 6;
        bf16_t* dst = j.dst + (size_t)bi * j.dbs;
        float* lb = lds + (u & 1) * (64 * 65);
        const bool okc = n0 + tn < j.nvalid;
#pragma unroll
        for (int kk = 0; kk < 8; ++kk) lb[tn * 65 + tk * 8 + kk] = okc ? v[u][kk] : 0.f;
        __syncthreads();
        const int wn = tid >> 3, kq = tid & 7;
        float x[8];
#pragma unroll
        for (int q = 0; q < 8; ++q) x[q] = lb[wn * 65 + kq * 8 + q];
        if (j.scale) {
            const float4 s0 = *(const float4*)(j.scale + k0 + kq * 8), s1 = *(const float4*)(j.scale + k0 + kq * 8 + 4);
            x[0] *= s0.x; x[1] *= s0.y; x[2] *= s0.z; x[3] *= s0.w; x[4] *= s1.x; x[5] *= s1.y; x[6] *= s1.z; x[7] *= s1.w;
        }
        uint4 o; o.x = pk2(x[0], x[1]); o.y = pk2(x[2], x[3]); o.z = pk2(x[4], x[5]); o.w = pk2(x[6], x[7]);
        *(uint4*)(dst + (size_t)(n0 + wn) * j.K + k0 + kq * 8) = o;
    }
    __syncthreads();
}
__device__ ConvJob get_job_early(const Params& p, int l, int ji) {
    bf16_t* wb = (bf16_t*)(WS(p) + OFF_WB);
    const float* win = p.in[3] + (size_t)l * DM * CIN;
    const float* nm = p.in[2] + (size_t)l * DM;
    ConvJob j{}; j.nb = 1; j.sbs = 0; j.dbs = 0; j.K = 1024; j.ldsrc = CIN; j.scale = nm;
    switch (ji) {
    case 0: j.src = win + 3072; j.dst = wb + WB_WIN; j.nvalid = 4352; j.nrows = 4352; break;
    case 1: j.src = (l == 0 ? nullptr : p.in[17]); j.ldsrc = 32; j.split = 32; j.srcB = win + 7424; j.ldB = CIN; j.dst = wb + WB_WIN + (size_t)(4096 + PM_VD) * 1024; j.nvalid = 512; j.nrows = 512; break;
    case 2: j.src = win + 7904; j.dst = wb + WB_WIDX; j.nvalid = 8; j.nrows = 64; break;
    case 3: j.src = win; j.dst = wb + WB_WG; j.nvalid = 3072; j.nrows = 3072; break;
    case 4: j.src = p.in[29] + (size_t)l * DM * DM; j.ldsrc = 1024; j.scale = nullptr; j.dst = wb + WB_PA; j.nvalid = 1024; j.nrows = 1024; break;
    case 5: j.src = p.in[30] + (size_t)l * DM * DM; j.ldsrc = 1024; j.scale = nullptr; j.dst = wb + WB_PA + (size_t)1024 * 1024; j.nvalid = 1024; j.nrows = 1024; break;
    case 6: j.src = p.in[31] + (size_t)l * DM * DM; j.ldsrc = 1024; j.scale = nullptr; j.dst = wb + WB_PA + (size_t)2 * 1024 * 1024; j.nvalid = 1024; j.nrows = 1024; break;
    case 7: j.src = p.in[32] + (size_t)l * DM * DM; j.ldsrc = 1024; j.scale = nullptr; j.dst = wb + WB_WO; j.nvalid = 1024; j.nrows = 1024; break;
    case 8: j.src = p.in[5] + (size_t)l * 4 * 256 * 256; j.ldsrc = 256; j.K = 256; j.scale = nullptr; j.dst = wb + WB_POOL; j.nvalid = 256; j.nrows = 256; j.nb = 4; j.sbs = 65536; j.dbs = 65536; break;
    case 9: j.src = p.in[26] + (size_t)l * 256 * 512; j.ldsrc = 512; j.K = 256; j.scale = nullptr; j.dst = wb + WB_QI; j.nvalid = 512; j.nrows = 512; break;
    case 10: j.src = p.in[23] + (size_t)l * 256 * 1536; j.ldsrc = 1536; j.K = 256; j.scale = nullptr; j.dst = wb + WB_UQ; j.nvalid = 1536; j.nrows = 1536; break;
    case 11: j.src = p.in[24] + (size_t)l * 16 * 128 * 64; j.ldsrc = 64; j.K = 64; j.scale = nullptr; j.dst = wb + WB_UK; j.nvalid = 2048; j.nrows = 2048; j.notr = 1; break;
    default: j.src = p.in[25] + (size_t)l * 16 * 128 * 64; j.ldsrc = 64; j.K = 128; j.scale = nullptr; j.dst = wb + WB_UV; j.nvalid = 64; j.nrows = 64; j.nb = 16; j.sbs = 8192; j.dbs = 8192; break;
    }
    return j;
}
__device__ ConvJob get_job_late(const Params& p, int l, int ji) {
    bf16_t* we = (bf16_t*)(WS(p) + OFF_WEXP);
    ConvJob j{}; j.nb = 16; j.scale = nullptr; j.sbs = 262144; j.dbs = 262144;
    switch (ji) {
    case 0: j.src = p.in[38] + (size_t)l * 16 * 262144; j.dst = we + WE_W1; j.ldsrc = 256; j.K = 1024; j.nvalid = 256; j.nrows = 256; j.scale = p.in[33] + (size_t)l * 1024; break;
    case 1: j.src = p.in[39] + (size_t)l * 16 * 262144; j.dst = we + WE_W3; j.ldsrc = 256; j.K = 1024; j.nvalid = 256; j.nrows = 256; j.scale = p.in[33] + (size_t)l * 1024; break;
    default: j.src = p.in[40] + (size_t)l * 16 * 262144; j.dst = we + WE_W2; j.ldsrc = 1024; j.K = 256; j.nvalid = 1024; j.nrows = 1024; break;
    }
    return j;
}
__device__ void conv_early_group(const Params& p, int l, int gidx, unsigned char* lds) {
    int base = 0;
    for (int ji = 0; ji < 13; ++ji) {
        const ConvJob j = get_job_early(p, l, ji);
        const int ng = conv_job_tiles(j) >> 2;
        if (gidx < base + ng) {
            const int g = gidx - base;
            if (j.split || j.notr) { for (int u = 0; u < 4; ++u) conv_tile(j, g * 4 + u, (float*)lds); }
            else conv_group4(j, g * 4, (float*)lds);
            return;
        }
        base += ng;
    }
}
constexpr int CONV_EARLY_GROUPS = 820;
constexpr int CONV_Q7 = 500;
template <bool LATE>
__device__ void phase_convert(const Params& p, int l, unsigned char* lds) {
    const int njobs = LATE ? 3 : 13;
    int base = 0;
    for (int ji = 0; ji < njobs; ++ji) {
        const ConvJob j = LATE ? get_job_late(p, l, ji) : get_job_early(p, l, ji);
        const int nt = conv_job_tiles(j);
        const int ng = nt >> 2;
        int first = ((int)obid() - base) % (int)gridDim.x; if (first < 0) first += gridDim.x;
        for (int gidx = first; gidx < ng; gidx += gridDim.x) {
            if (j.split || j.notr) { for (int u = 0; u < 4; ++u) conv_tile(j, gidx * 4 + u, (float*)lds); }
            else conv_group4(j, gidx * 4, (float*)lds);
        }
        base += ng;
    }
}

template <int BM> struct G3 {
    static constexpr int MI = BM / 64;
    static constexpr int NA = BM / 64;
    static constexpr int STAGE = BM * 128 + 128 * 128;
    const bf16_t* ap[NA];
    const bf16_t* bp[2];
};
template <int BM>
__device__ __forceinline__ void g3_issue(const G3<BM>& g, int kt, unsigned char* stage, int tid) {
#pragma unroll
    for (int i = 0; i < G3<BM>::NA; ++i) glds16(g.ap[i] + kt * 64, stage + (tid + i * NTHR) * 16);
#pragma unroll
    for (int i = 0; i < 2; ++i) glds16(g.bp[i] + kt * 64, stage + BM * 128 + (tid + i * NTHR) * 16);
}
template <int BM, class FA, class FB>
__device__ __forceinline__ void g3_setup(G3<BM>& g, FA rowptr, FB bcol, int tid) {
#pragma unroll
    for (int i = 0; i < G3<BM>::NA; ++i) { const int idx = tid + i * NTHR, row = idx >> 3, sl = (idx & 7) ^ (row & 7); g.ap[i] = rowptr(row) + sl * 8; }
#pragma unroll
    for (int i = 0; i < 2; ++i) { const int idx = tid + i * NTHR, row = idx >> 3, sl = (idx & 7) ^ (row & 7); g.bp[i] = bcol(row) + sl * 8; }
}
template <int BM>
__device__ __forceinline__ void g3_kloop(f32x4 (&acc)[BM / 64][4], const G3<BM>& g, int K, unsigned char* lds) {
    constexpr int MI = G3<BM>::MI, STAGE = G3<BM>::STAGE, NL = G3<BM>::NA + 2;
    const int tid = otid(), lane = tid & 63, wid = __builtin_amdgcn_readfirstlane(tid >> 6), wr = wid >> 1, wc = wid & 1, fr = lane & 15, fq = lane >> 4;
    const int nk = K >> 6;
    g3_issue<BM>(g, 0, lds, tid);
    if (nk > 1) g3_issue<BM>(g, 1, lds + STAGE, tid);
    int cur = 0;
#pragma unroll 1
    for (int t = 0; t < nk; ++t) {
        if (t + 1 < nk) { if (NL == 6) asm volatile("s_waitcnt vmcnt(6)" ::: "memory"); else if (NL == 5) asm volatile("s_waitcnt vmcnt(5)" ::: "memory"); else asm volatile("s_waitcnt vmcnt(4)" ::: "memory"); }
        else asm volatile("s_waitcnt vmcnt(0)" ::: "memory");
        __builtin_amdgcn_s_barrier();
        if (t + 2 < nk) { int nx = cur + 2; if (nx >= 3) nx -= 3; g3_issue<BM>(g, t + 2, lds + nx * STAGE, tid); }
        const unsigned char* cA = lds + cur * STAGE;
        const unsigned char* cB = cA + BM * 128;
#pragma unroll
        for (int ks = 0; ks < 2; ++ks) {
            bf16x8 a[MI], b[4];
#pragma unroll
            for (int m = 0; m < MI; ++m) { const int row = wr * (BM / 4) + m * 16 + fr; a[m] = *(const bf16x8*)(cA + row * 128 + (((ks * 4 + fq) ^ (row & 7)) << 4)); }
#pragma unroll
            for (int n = 0; n < 4; ++n) { const int row = wc * 64 + n * 16 + fr; b[n] = *(const bf16x8*)(cB + row * 128 + (((ks * 4 + fq) ^ (row & 7)) << 4)); }
#pragma unroll
            for (int m = 0; m < MI; ++m)
#pragma unroll
                for (int n = 0; n < 4; ++n) acc[m][n] = __builtin_amdgcn_mfma_f32_16x16x32_bf16(b[n], a[m], acc[m][n], 0, 0, 0);
        }
        cur = (cur == 2) ? 0 : cur + 1;
    }
    __builtin_amdgcn_s_barrier();
}
struct G3D { const bf16_t* ap[2]; const bf16_t* b1[2]; const bf16_t* b3[2]; };
__device__ __forceinline__ void g3d_issue(const G3D& g, int kt, unsigned char* stage, int tid) {
#pragma unroll
    for (int i = 0; i < 2; ++i) glds16(g.ap[i] + kt * 64, stage + (tid + i * NTHR) * 16);
#pragma unroll
    for (int i = 0; i < 2; ++i) glds16(g.b1[i] + kt * 64, stage + 16384 + (tid + i * NTHR) * 16);
#pragma unroll
    for (int i = 0; i < 2; ++i) glds16(g.b3[i] + kt * 64, stage + 32768 + (tid + i * NTHR) * 16);
}
__device__ __forceinline__ void g3d_kloop(f32x4 (&acc1)[2][4], f32x4 (&acc3)[2][4], const G3D& g, int K, unsigned char* lds) {
    constexpr int STAGE = 49152;
    const int tid = otid(), lane = tid & 63, wid = __builtin_amdgcn_readfirstlane(tid >> 6), wr = wid >> 1, wc = wid & 1, fr = lane & 15, fq = lane >> 4;
    const int nk = K >> 6;
    g3d_issue(g, 0, lds, tid);
    if (nk > 1) g3d_issue(g, 1, lds + STAGE, tid);
    int cur = 0;
#pragma unroll 1
    for (int t = 0; t < nk; ++t) {
        if (t + 1 < nk) asm volatile("s_waitcnt vmcnt(6)" ::: "memory"); else asm volatile("s_waitcnt vmcnt(0)" ::: "memory");
        __builtin_amdgcn_s_barrier();
        if (t + 2 < nk) { int nx = cur + 2; if (nx >= 3) nx -= 3; g3d_issue(g, t + 2, lds + nx * STAGE, tid); }
        const unsigned char* cA = lds + cur * STAGE;
#pragma unroll
        for (int ks = 0; ks < 2; ++ks) {
            bf16x8 a[2], b1[4], b3[4];
#pragma unroll
            for (int m = 0; m < 2; ++m) { const int row = wr * 32 + m * 16 + fr; a[m] = *(const bf16x8*)(cA + row * 128 + (((ks * 4 + fq) ^ (row & 7)) << 4)); }
#pragma unroll
            for (int n = 0; n < 4; ++n) { const int row = wc * 64 + n * 16 + fr; const int off = row * 128 + (((ks * 4 + fq) ^ (row & 7)) << 4);
                b1[n] = *(const bf16x8*)(cA + 16384 + off); b3[n] = *(const bf16x8*)(cA + 32768 + off); }
#pragma unroll
            for (int m = 0; m < 2; ++m)
#pragma unroll
                for (int n = 0; n < 4; ++n) {
                    acc1[m][n] = __builtin_amdgcn_mfma_f32_16x16x32_bf16(b1[n], a[m], acc1[m][n], 0, 0, 0);
                    acc3[m][n] = __builtin_amdgcn_mfma_f32_16x16x32_bf16(b3[n], a[m], acc3[m][n], 0, 0, 0);
                }
        }
        cur = (cur == 2) ? 0 : cur + 1;
    }
    __builtin_amdgcn_s_barrier();
}
template <int MI>
__device__ __forceinline__ void g3_zero(f32x4 (&acc)[MI][4]) {
#pragma unroll
    for (int m = 0; m < MI; ++m)
#pragma unroll
        for (int n = 0; n < 4; ++n) acc[m][n] = (f32x4){0.f, 0.f, 0.f, 0.f};
}
__device__ __forceinline__ uint2 pack4(float a, float b, float c, float d) {
    uint2 r; r.x = pk2(a, b); r.y = pk2(c, d); return r;
}

namespace pg8 {
#define PG8_LAS __attribute__((address_space(3)))
typedef unsigned short bf16_t;
typedef short bf16x8 __attribute__((ext_vector_type(8)));
typedef float f32x4 __attribute__((ext_vector_type(4)));
typedef unsigned u32x4 __attribute__((ext_vector_type(4)));
constexpr int BM = 256, BK = 64, HALF = 128, HTB = HALF * BK * 2  , STAGE_BYTES = 8 * HTB, NXCD = 8, WGM = 8;

__host__ __device__ __forceinline__ int lds_byte(int r, int c) { const int st = (r >> 4) * 2 + (c >> 5), rr = r & 15, cc = c & 31, ob = rr * 64 + cc * 2; return st * 1024 + (ob ^ (((ob >> 9) & 1) << 5)); }
__host__ __device__ __forceinline__ void stage_rc(int b, int& R, int& C) { const int st = b / 1024, sb = b % 1024, swz = sb ^ (((sb >> 9) & 1) << 5); R = (st >> 1) * 16 + swz / 64; C = (st & 1) * 32 + (swz % 64) / 2; }
__host__ __device__ __forceinline__ int perm32(int rho) { const int n = rho >> 4, i = rho & 15; return 8 * (i >> 2) + 4 * n + (i & 3); }

struct Unit { int pm, pn; };
struct Gemm { const bf16_t* A; const bf16_t* Bt; int M, N, K; };

struct StaticOrder {
    int nM, nN, nwg, G, c;
    __host__ __device__ void init(int M, int N, int G_, int c_) { nM = M / BM; nN = N / BM; nwg = nM * nN; G = G_; c = c_; }
    __host__ __device__ bool next(int i, Unit& u) const {
        const long L = (long)i * G + c; if (L >= nwg) return false;
        int wgid = (int)L; { const int q = nwg / NXCD, r = nwg % NXCD, xcd = wgid % NXCD, off = wgid / NXCD; wgid = (xcd < r ? xcd * (q + 1) : r * (q + 1) + (xcd - r) * q) + off; }
        const int nig = WGM * nN, gid = wgid / nig, fm = gid * WGM, gsz = (nM - fm) < WGM ? (nM - fm) : WGM;
        u.pm = fm + ((wgid % nig) % gsz); u.pn = (wgid % nig) / gsz; return true;
    }
    __device__ __forceinline__ void a_ready(const Unit&) const {}
    __device__ __forceinline__ void done(const Unit&) const {}
};
template <class Epi, class Sched, bool STAMP = false>
__device__ __forceinline__ void gemm_phase(PG8_LAS unsigned char* lds, const Gemm g, const Sched& S, const Epi& E, unsigned long long* stamps) {
    const int tid = otid(), wid = __builtin_amdgcn_readfirstlane(tid >> 6), lane = tid & 63, wr = wid >> 2, wc = wid & 3, fr = lane & 15, fq = lane >> 4;
    const int K = g.K, nt = K / BK;
    int ts_lo = 0, ts_hi = 0, nts = 0; const unsigned long long rt_entry = STAMP ? 0ull : 0ull;
#define PG8_STAMP() do { if (STAMP && wid == 0 && nts < 64) { const unsigned long long _c = 0ull; \
        ts_lo = (lane == nts) ? (int)(unsigned)_c : ts_lo; ts_hi = (lane == nts) ? (int)(unsigned)(_c >> 32) : ts_hi; ++nts; } } while (0)
    PG8_STAMP();
    unsigned voffA[2], voffB[2];
#pragma unroll
    for (int i = 0; i < 2; ++i) { int R, C; stage_rc(tid * 16 + i * 8192, R, C); const int Rb = Epi::PERM ? ((R & ~31) + perm32(R & 31)) : R;
        voffA[i] = (unsigned)(R * K + C) * 2u; voffB[i] = (unsigned)(Rb * K + C) * 2u; }
    const size_t kstep = (size_t)(BK * 2);
    const size_t hstep = (size_t)HALF * K * 2;
    const size_t tstep = 2 * hstep;
    const unsigned ldsw = (unsigned)wid * 1024u;
    const int aoff = lds_byte(wr * 64 + fr, fq * 8), boff = lds_byte(wc * 32 + fr, fq * 8);
#define PG8_SA(b, h) (((b) * 2 + (h)) * HTB)
#define PG8_SB(b, h) ((4 + (b) * 2 + (h)) * HTB)
#define PG8_STAGE(bufoff, gbase, voff) do { _Pragma("unroll") for (int _i = 0; _i < 2; ++_i) \
        __builtin_amdgcn_global_load_lds((const unsigned*)((const char*)(gbase) + (voff)[_i]), (PG8_LAS unsigned*)(lds + (bufoff) + ldsw + _i * 8192), 16, 0, 0); } while (0)
#define PG8_LDA(dst, b, h) do { _Pragma("unroll") for (int m = 0; m < 4; ++m) _Pragma("unroll") for (int k = 0; k < 2; ++k) dst[m][k] = *(const PG8_LAS bf16x8*)(lds + PG8_SA(b, h) + aoff + m * 2048 + k * 1024); } while (0)
#define PG8_LDB(dst, b, h) do { _Pragma("unroll") for (int n = 0; n < 2; ++n) _Pragma("unroll") for (int k = 0; k < 2; ++k) dst[n][k] = *(const PG8_LAS bf16x8*)(lds + PG8_SB(b, h) + boff + n * 2048 + k * 1024); } while (0)
#define PG8_MMA(ai, bj, At, Bt) do { __builtin_amdgcn_s_setprio(1); _Pragma("unroll") for (int m = 0; m < 4; ++m) _Pragma("unroll") for (int n = 0; n < 2; ++n) _Pragma("unroll") for (int k = 0; k < 2; ++k) \
        acc[ai][bj][m][n] = __builtin_amdgcn_mfma_f32_16x16x32_bf16(Bt[n][k], At[m][k], acc[ai][bj][m][n], 0, 0, 0); __builtin_amdgcn_s_setprio(0); } while (0)
#define PG8_WAIT_V(n) asm volatile("s_waitcnt vmcnt(" #n ")" ::: "memory")
#define PG8_WAIT_L(n) asm volatile("s_waitcnt lgkmcnt(" #n ")" ::: "memory")
#define PG8_BAR __builtin_amdgcn_s_barrier()
#define PG8_SCHED __builtin_amdgcn_sched_barrier(0)
    Unit cur, nxt; int ui = 0;
    if (!S.next(0, cur)) return;
    f32x4 acc[2][2][4][2];
#pragma unroll
    for (int a = 0; a < 2; ++a)
#pragma unroll
        for (int b = 0; b < 2; ++b)
#pragma unroll
            for (int m = 0; m < 4; ++m)
#pragma unroll
                for (int n = 0; n < 2; ++n) acc[a][b][m][n] = (f32x4){0.f, 0.f, 0.f, 0.f};
    bf16x8 At[4][2], B0[2][2], B1[2][2];
    const char* cA = (const char*)g.A + (size_t)cur.pm * tstep; const char* cB = (const char*)g.Bt + (size_t)cur.pn * tstep;
    S.a_ready(cur);
    PG8_STAGE(PG8_SB(0, 0), cB, voffB); PG8_STAGE(PG8_SA(0, 0), cA, voffA); PG8_STAGE(PG8_SB(0, 1), cB + hstep, voffB); PG8_STAGE(PG8_SA(0, 1), cA + hstep, voffA);
    if (wr == 1) PG8_BAR;
    PG8_WAIT_V(4); PG8_BAR;
    PG8_STAGE(PG8_SB(1, 0), cB + kstep, voffB); PG8_STAGE(PG8_SA(1, 0), cA + kstep, voffA); PG8_STAGE(PG8_SB(1, 1), cB + hstep + kstep, voffB);
    PG8_WAIT_V(6); PG8_BAR;
    PG8_STAMP();
    for (;;) {
        const bool has_next = S.next(ui + 1, nxt);
        const char* nA = has_next ? (const char*)g.A + (size_t)nxt.pm * tstep : cA; const char* nB = has_next ? (const char*)g.Bt + (size_t)nxt.pn * tstep : cB;
        for (int t = 0; t < nt; t += 2) {
            const bool last = (t == nt - 2);
            const char* a1 = cA + (size_t)(t + 1) * kstep;
            const char* a2 = last ? nA : cA + (size_t)(t + 2) * kstep; const char* b2 = last ? nB : cB + (size_t)(t + 2) * kstep;
            const char* a3 = a2 + kstep; const char* b3 = b2 + kstep;
            if (last && has_next) S.a_ready(nxt);
            PG8_LDB(B0, 0, 0); PG8_SCHED; PG8_LDA(At, 0, 0); PG8_STAGE(PG8_SA(1, 1), a1 + hstep, voffA);
            PG8_WAIT_L(8); PG8_BAR; PG8_WAIT_L(0); PG8_MMA(0, 0, At, B0); PG8_BAR; PG8_SCHED;
            PG8_LDB(B1, 0, 1); PG8_STAGE(PG8_SB(0, 0), b2, voffB);
            PG8_BAR; PG8_WAIT_L(0); PG8_MMA(0, 1, At, B1); PG8_BAR;
            PG8_LDA(At, 0, 1); PG8_STAGE(PG8_SA(0, 0), a2, voffA);
            PG8_BAR; PG8_WAIT_L(0); PG8_MMA(1, 0, At, B0); PG8_BAR; PG8_SCHED;
            PG8_STAGE(PG8_SB(0, 1), b2 + hstep, voffB);
            PG8_WAIT_V(6); PG8_BAR; PG8_MMA(1, 1, At, B1); PG8_BAR;
            PG8_LDB(B0, 1, 0); PG8_SCHED; PG8_LDA(At, 1, 0); PG8_STAGE(PG8_SA(0, 1), a2 + hstep, voffA);
            PG8_WAIT_L(8); PG8_BAR; PG8_WAIT_L(0); PG8_MMA(0, 0, At, B0); PG8_BAR; PG8_SCHED;
            PG8_LDB(B1, 1, 1); PG8_STAGE(PG8_SB(1, 0), b3, voffB);
            PG8_BAR; PG8_WAIT_L(0); PG8_MMA(0, 1, At, B1); PG8_BAR;
            PG8_LDA(At, 1, 1); PG8_STAGE(PG8_SA(1, 0), a3, voffA);
            PG8_BAR; PG8_WAIT_L(0); PG8_MMA(1, 0, At, B0); PG8_BAR; PG8_SCHED;
            PG8_STAGE(PG8_SB(1, 1), b3 + hstep, voffB);
            PG8_WAIT_V(6); PG8_BAR; PG8_MMA(1, 1, At, B1); PG8_BAR;
        }
        PG8_STAMP();
        if constexpr (!Epi::AFTER_DRAIN) { E(acc, cur, wr, wc, fr, fq); S.done(cur); }
        PG8_STAMP();
        if (!has_next) break;
#pragma unroll
        for (int a = 0; a < 2; ++a)
#pragma unroll
            for (int b = 0; b < 2; ++b)
#pragma unroll
                for (int m = 0; m < 4; ++m)
#pragma unroll
                    for (int n = 0; n < 2; ++n) acc[a][b][m][n] = (f32x4){0.f, 0.f, 0.f, 0.f};
        cur = nxt; cA = nA; cB = nB; ++ui;
    }
    PG8_WAIT_V(0);
    if (wr == 0) PG8_BAR;
    PG8_BAR;
    if constexpr (Epi::AFTER_DRAIN) { E.fused(acc, cur, wr, wc, fr, fq, lds, wid, lane); S.done(cur); }
    PG8_STAMP();
    if (STAMP && wid == 0) { stamps[lane] = lane < nts ? (((unsigned long long)(unsigned)ts_hi << 32) | (unsigned)ts_lo) : 0ull;
        if (lane == 62) stamps[62] = rt_entry; if (lane == 63) stamps[63] = 0ull; }
#undef PG8_STAMP
#undef PG8_SA
#undef PG8_SB
#undef PG8_STAGE
#undef PG8_LDA
#undef PG8_LDB
#undef PG8_MMA
#undef PG8_WAIT_V
#undef PG8_WAIT_L
#undef PG8_BAR
#undef PG8_SCHED
}
}

struct EpiInproj {
    static constexpr bool PERM = true, AFTER_DRAIN = false;
    unsigned char* ws; float* rstd; const unsigned long long* ssq; int l;
    __device__ __forceinline__ void operator()(const pg8::f32x4 (&acc)[2][2][4][2], const pg8::Unit& u, int wr, int wc, int fr, int fq) const {
        const int pn = u.pn;
        bf16_t* dst; int ld, cb;
        if (pn < 4) { dst = (bf16_t*)(ws + OFF_PPOOL); ld = 1024; cb = pn * 256; }
        else if (pn < 8) { dst = (bf16_t*)(ws + OFF_PR); ld = 1024; cb = (pn - 4) * 256; }
        else if (pn < 12) { dst = (bf16_t*)(ws + OFF_PK); ld = 1024; cb = (pn - 8) * 256; }
        else if (pn < 16) { dst = (bf16_t*)(ws + OFF_PV); ld = 1024; cb = (pn - 12) * 256; }
        else { dst = (bf16_t*)(ws + OFF_PMISC); ld = PM_LD; cb = (pn - 16) * 256; }
        bf16_t* halo = (bf16_t*)(ws + OFF_HALO);
        float rsv[2][4];
        if (l == 0) {
#pragma unroll
            for (int ai = 0; ai < 2; ++ai)
#pragma unroll
                for (int m = 0; m < 4; ++m) { const int row = u.pm * 256 + ai * 128 + wr * 64 + m * 16 + fr; rsv[ai][m] = (row < NT) ? rstd[row] : 0.f; }
        } else {
            unsigned long long sq[2][4];
#pragma unroll
            for (int ai = 0; ai < 2; ++ai)
#pragma unroll
                for (int m = 0; m < 4; ++m) { const int row = u.pm * 256 + ai * 128 + wr * 64 + m * 16 + fr; sq[ai][m] = ssq[row < NT ? row : 0]; }
#pragma unroll
            for (int ai = 0; ai < 2; ++ai)
#pragma unroll
                for (int m = 0; m < 4; ++m) { const int row = u.pm * 256 + ai * 128 + wr * 64 + m * 16 + fr; rsv[ai][m] = (row < NT) ? rsqrtf((float)sq[ai][m] * (1.0f / 1048576.0f / 1024.0f) + 1e-6f) : 0.f; }
        }
        if (l > 0 && pn == 0 && wc == 0 && fq == 0) {
#pragma unroll
            for (int ai = 0; ai < 2; ++ai)
#pragma unroll
                for (int m = 0; m < 4; ++m) { const int row = u.pm * 256 + ai * 128 + wr * 64 + m * 16 + fr; if (row < NT) rstd[row] = rsv[ai][m]; }
        }
#pragma unroll
        for (int ai = 0; ai < 2; ++ai)
#pragma unroll
            for (int m = 0; m < 4; ++m) {
                const int row = u.pm * 256 + ai * 128 + wr * 64 + m * 16 + fr;
                if (row < NT) {
                    const float rs = rsv[ai][m];
                    const int lr = row & 127;
#pragma unroll
                    for (int bj = 0; bj < 2; ++bj) {
                        const int col = cb + bj * 128 + wc * 32 + fq * 8;
                        const uint2 lo = pack4(acc[ai][bj][m][0][0] * rs, acc[ai][bj][m][0][1] * rs, acc[ai][bj][m][0][2] * rs, acc[ai][bj][m][0][3] * rs);
                        const uint2 hi = pack4(acc[ai][bj][m][1][0] * rs, acc[ai][bj][m][1][1] * rs, acc[ai][bj][m][1][2] * rs, acc[ai][bj][m][1][3] * rs);
                        const uint4 v = make_uint4(lo.x, lo.y, hi.x, hi.y);
                        *(uint4*)(dst + (size_t)row * ld + col) = v;
                        if (pn < 4 && lr >= 112) *(uint4*)(halo + ((size_t)(row >> 7) * 16 + (lr - 112)) * 1024 + col) = v;
                    }
                }
            }
    }
};
__device__ void phase_inproj(const Params& p, int l, unsigned char* lds) {
    pg8::StaticOrder S; S.init(NTP, NP1, (int)gridDim.x, obid());
    pg8::Gemm g; g.A = (const pg8::bf16_t*)(WS(p) + OFF_H); g.Bt = (const pg8::bf16_t*)(WS(p) + OFF_WB) + WB_WIN; g.M = NTP; g.N = NP1; g.K = DM;
    EpiInproj E; E.ws = WS(p); E.rstd = (float*)(WS(p) + OFF_RSTD); E.ssq = (const unsigned long long*)(WS(p) + OFF_SSQ); E.l = l;
    pg8::gemm_phase<EpiInproj, pg8::StaticOrder, false>((PG8_LAS unsigned char*)lds, g, S, E, nullptr);
}

typedef short s16x4 __attribute__((ext_vector_type(4)));
__device__ void phase_pool(const Params& p, int l, unsigned char* lds, int tb, int te, int tstep) {
    const int tid = otid(), lane = tid & 63, wid = __builtin_amdgcn_readfirstlane(tid >> 6), fr = lane & 15, fq = lane >> 4;
    bf16_t* pp = (bf16_t*)(WS(p) + OFF_PPOOL);
    const bf16_t* halo = (const bf16_t*)(WS(p) + OFF_HALO);
    const bf16_t* pw = (const bf16_t*)(WS(p) + OFF_WB) + WB_POOL;
    const float* scale = p.in[6] + (size_t)l * 1024;
    bf16_t* sp = (bf16_t*)lds;
    constexpr int SLD = 264;
    bf16_t* sraw = sp + 128 * SLD;
    for (int tile = tb; tile < te; tile += tstep) {
        const int mt = tile >> 2, g = tile & 3;
        const int row0 = mt * 128, w = 2 << g;
        const bf16_t* wg = pw + (size_t)g * 65536;
        bf16x8 bfr[8][2];
#pragma unroll
        for (int kk = 0; kk < 8; ++kk)
#pragma unroll
            for (int n = 0; n < 2; ++n) bfr[kk][n] = *(const bf16x8*)(wg + (size_t)(wid * 32 + n * 16 + fr) * 256 + kk * 32 + fq * 8);
        {
            uint4 sv[9];
#pragma unroll
            for (int i = 0; i < 9; ++i) {
                const int e = tid + i * NTHR, rr = e >> 5, c16 = e & 31;
                const bf16_t* srcp = (rr >= 16) ? pp + (size_t)(row0 + rr - 16) * 1024 : halo + ((size_t)(mt > 0 ? mt - 1 : 0) * 16 + rr) * 1024;
                sv[i] = *(const uint4*)(srcp + g * 256 + c16 * 8);
            }
#pragma unroll
            for (int i = 0; i < 9; ++i) {
                const int e = tid + i * NTHR, rr = e >> 5, c16 = e & 31;
                *(uint4*)(sraw + rr * 256 + c16 * 8) = (rr >= 16 || mt > 0) ? sv[i] : make_uint4(0u, 0u, 0u, 0u);
            }
        }
        __syncthreads();
        {
            const int q_ = fr >> 2, p_ = fr & 3;
            int tl = (row0 + fr) % TS;
            s16x4 vp[2];
#pragma unroll
            for (int n = 0; n < 2; ++n)
                vp[n] = __builtin_amdgcn_ds_read_tr16_b64_v4i16((__attribute__((address_space(3))) s16x4*)(sraw + (fq * 4 + q_) * 256 + wid * 32 + n * 16 + p_ * 4));
#pragma unroll
            for (int m = 0; m < 8; ++m) {
                const int win = (tl + 1 < w) ? tl + 1 : w;
                const float iw = 1.0f / (float)win;
                const int ks = 16 + fr;
                bf16x8 bm;
#pragma unroll
                for (int sl = 0; sl < 8; ++sl) {
                    const int k = (sl < 4) ? (4 * fq + sl) : (12 + 4 * fq + sl);
                    const float v = ((k <= ks && k > ks - win) ? iw : 0.f) - ((k == ks) ? 1.f : 0.f);
                    bm[sl] = (short)f2bf(v);
                }
#pragma unroll
                for (int n = 0; n < 2; ++n) {
                    const s16x4 v1 = __builtin_amdgcn_ds_read_tr16_b64_v4i16((__attribute__((address_space(3))) s16x4*)(sraw + ((m + 1) * 16 + fq * 4 + q_) * 256 + wid * 32 + n * 16 + p_ * 4));
                    bf16x8 av;
                    av[0] = vp[n][0]; av[1] = vp[n][1]; av[2] = vp[n][2]; av[3] = vp[n][3]; av[4] = v1[0]; av[5] = v1[1]; av[6] = v1[2]; av[7] = v1[3];
                    const f32x4 d = __builtin_amdgcn_mfma_f32_16x16x32_bf16(av, bm, (f32x4){0.f, 0.f, 0.f, 0.f}, 0, 0, 0);
                    *(uint2*)(sp + (m * 16 + fr) * SLD + wid * 32 + n * 16 + fq * 4) = pack4(d[0], d[1], d[2], d[3]);
                    vp[n] = v1;
                }
                tl += 16; tl = (tl >= TS) ? tl - TS : tl;
            }
        }
        __syncthreads();
        f32x4 acc[8][2];
#pragma unroll
        for (int m = 0; m < 8; ++m) { acc[m][0] = (f32x4){0.f, 0.f, 0.f, 0.f}; acc[m][1] = (f32x4){0.f, 0.f, 0.f, 0.f}; }
#pragma unroll
        for (int kk = 0; kk < 8; ++kk) {
#pragma unroll
            for (int m = 0; m < 8; ++m) {
                const bf16x8 a = *(const bf16x8*)(sp + (m * 16 + fr) * SLD + kk * 32 + fq * 8);
                acc[m][0] = __builtin_amdgcn_mfma_f32_16x16x32_bf16(bfr[kk][0], a, acc[m][0], 0, 0, 0);
                acc[m][1] = __builtin_amdgcn_mfma_f32_16x16x32_bf16(bfr[kk][1], a, acc[m][1], 0, 0, 0);
            }
        }
#pragma unroll
        for (int n = 0; n < 2; ++n) {
            const int col = g * 256 + wid * 32 + n * 16 + fq * 4;
            const float4 sc = *(const float4*)(scale + col);
#pragma unroll
            for (int m = 0; m < 8; ++m) {
                const int row = row0 + m * 16 + fr;
                *(uint2*)(pp + (size_t)row * 1024 + col) = pack4(acc[m][n][0] * sc.x, acc[m][n][1] * sc.y, acc[m][n][2] * sc.z, acc[m][n][3] * sc.w);
            }
        }
        __syncthreads();
    }
}

__device__ void phase_dsa_prep(const Params& p, int l) {
    const int lane = otid() & 63;
    const int wave = (obid() * NTHR + otid()) >> 6, nw = gridDim.x * NTHR / 64;
    const bf16_t* pm = (const bf16_t*)(WS(p) + OFF_PMISC);
    unsigned char* dob = OUTB(p);
    bf16_t* cqn = (bf16_t*)(dob + DO_CQN);
    bf16_t* kv = (bf16_t*)(dob + DO_KV);
    bf16_t* kidx = (bf16_t*)(dob + DO_KIDX);
    float* whead = (float*)(dob + DO_WHEAD);
    const float* ctab = (const float*)(WS(p) + OFF_ROPE);
    const float* stab = ctab + TS * 16;
    const bf16_t* hrow = (const bf16_t*)(WS(p) + OFF_H);
    const bf16_t* wwidx = (const bf16_t*)(WS(p) + OFF_WB) + WB_WIDX;
    const float* rstd_ = (const float*)(WS(p) + OFF_RSTD);
    const float4 qn4 = *(const float4*)(p.in[21] + l * 256 + lane * 4);
    const float2 kvn2 = *(const float2*)(p.in[22] + l * 128 + lane * 2);
    const float inw = p.in[27][l * 64 + lane], inb = p.in[28][l * 64 + lane];
    uint4 ww[8][2];
#pragma unroll
    for (int j = 0; j < 8; ++j) { ww[j][0] = *(const uint4*)(wwidx + (size_t)j * DM + lane * 16); ww[j][1] = *(const uint4*)(wwidx + (size_t)j * DM + lane * 16 + 8); }
    struct In { uint2 cq; unsigned ckv; bf16_t kr0, kr1, kix; uint4 h0, h1; float rs, c, s; };
    auto load = [&](int n) {
        In r;
        const bf16_t* row = pm + (size_t)n * PM_LD;
        const int t = n % TS;
        r.cq = *(const uint2*)(row + PM_CQ + lane * 4);
        r.ckv = *(const unsigned*)(row + PM_CKV + lane * 2);
        r.kr0 = row[PM_KROPE + (lane & 15)]; r.kr1 = row[PM_KROPE + 16 + (lane & 15)];
        r.kix = row[PM_KIDX + lane];
        r.h0 = *(const uint4*)(hrow + (size_t)n * DM + lane * 16); r.h1 = *(const uint4*)(hrow + (size_t)n * DM + lane * 16 + 8);
        r.rs = rstd_[n];
        r.c = ctab[t * 16 + (lane & 15)]; r.s = stab[t * 16 + (lane & 15)];
        return r;
    };
    In cur = load(wave < NT ? wave : 0);
    for (int n = wave; n < NT; n += nw) {
        const In x = cur;
        if (n + nw < NT) cur = load(n + nw);
        {
            const float v0 = __uint_as_float(x.cq.x << 16), v1 = __uint_as_float(x.cq.x & 0xFFFF0000u), v2 = __uint_as_float(x.cq.y << 16), v3 = __uint_as_float(x.cq.y & 0xFFFF0000u);
            const float ss = wave_sum_fast(v0 * v0 + v1 * v1 + v2 * v2 + v3 * v3);
            const float rs = rsqrtf(ss * (1.0f / 256.0f) + 1e-6f);
            *(uint2*)(cqn + (size_t)n * 256 + lane * 4) = pack4(v0 * rs * qn4.x, v1 * rs * qn4.y, v2 * rs * qn4.z, v3 * rs * qn4.w);
        }
        {
            const float v0 = __uint_as_float(x.ckv << 16), v1 = __uint_as_float(x.ckv & 0xFFFF0000u);
            const float ss = wave_sum_fast(v0 * v0 + v1 * v1);
            const float rs = rsqrtf(ss * (1.0f / 128.0f) + 1e-6f);
            *(unsigned*)(kv + (size_t)n * 160 + lane * 2) = pk2(v0 * rs * kvn2.x, v1 * rs * kvn2.y);
        }
        if (lane < 16) {
            const float x1 = bf2f(x.kr0), x2 = bf2f(x.kr1);
            kv[(size_t)n * 160 + 128 + lane] = f2bf(x1 * x.c - x2 * x.s);
            kv[(size_t)n * 160 + 144 + lane] = f2bf(x2 * x.c + x1 * x.s);
        }
        {
            const float xv = bf2f(x.kix);
            const float mu = wave_sum_fast(xv) * (1.0f / 64.0f);
            const float d = xv - mu;
            const float var = wave_sum_fast(d * d) * (1.0f / 64.0f);
            const float y = d * rsqrtf(var + 1e-6f) * inw + inb;
            const float yo = __shfl_xor(y, 16);
            float o = y;
            if (lane < 32) o = (lane < 16) ? (y * x.c - yo * x.s) : (y * x.c + yo * x.s);
            kidx[(size_t)n * 64 + lane] = f2bf(o);
        }
        {
            const uint4 hv0 = x.h0, hv1 = x.h1;
            float hx[16];
            hx[0] = __uint_as_float(hv0.x << 16); hx[1] = __uint_as_float(hv0.x & 0xFFFF0000u); hx[2] = __uint_as_float(hv0.y << 16); hx[3] = __uint_as_float(hv0.y & 0xFFFF0000u);
            hx[4] = __uint_as_float(hv0.z << 16); hx[5] = __uint_as_float(hv0.z & 0xFFFF0000u); hx[6] = __uint_as_float(hv0.w << 16); hx[7] = __uint_as_float(hv0.w & 0xFFFF0000u);
            hx[8] = __uint_as_float(hv1.x << 16); hx[9] = __uint_as_float(hv1.x & 0xFFFF0000u); hx[10] = __uint_as_float(hv1.y << 16); hx[11] = __uint_as_float(hv1.y & 0xFFFF0000u);
            hx[12] = __uint_as_float(hv1.z << 16); hx[13] = __uint_as_float(hv1.z & 0xFFFF0000u); hx[14] = __uint_as_float(hv1.w << 16); hx[15] = __uint_as_float(hv1.w & 0xFFFF0000u);
            float myw = 0.f;
#pragma unroll
            for (int j = 0; j < 8; ++j) {
                const uint4 w0 = ww[j][0], w1 = ww[j][1];
                float d = hx[0] * __uint_as_float(w0.x << 16) + hx[1] * __uint_as_float(w0.x & 0xFFFF0000u) + hx[2] * __uint_as_float(w0.y << 16) + hx[3] * __uint_as_float(w0.y & 0xFFFF0000u)
                        + hx[4] * __uint_as_float(w0.z << 16) + hx[5] * __uint_as_float(w0.z & 0xFFFF0000u) + hx[6] * __uint_as_float(w0.w << 16) + hx[7] * __uint_as_float(w0.w & 0xFFFF0000u)
                        + hx[8] * __uint_as_float(w1.x << 16) + hx[9] * __uint_as_float(w1.x & 0xFFFF0000u) + hx[10] * __uint_as_float(w1.y << 16) + hx[11] * __uint_as_float(w1.y & 0xFFFF0000u)
                        + hx[12] * __uint_as_float(w1.z << 16) + hx[13] * __uint_as_float(w1.z & 0xFFFF0000u) + hx[14] * __uint_as_float(w1.w << 16) + hx[15] * __uint_as_float(w1.w & 0xFFFF0000u);
                d = wave_sum_fast(d);
                myw = (lane == j) ? d : myw;
            }
            if (lane < 8) whead[(size_t)n * 8 + lane] = myw * x.rs * 0.04419417382415922f;
        }
    }
}

typedef short s16x4 __attribute__((ext_vector_type(4)));
__device__ __forceinline__ unsigned f2h_bits(float f) { const _Float16 h = (_Float16)f; unsigned short u; __builtin_memcpy(&u, &h, 2); return u; }
template <bool IMPORT_SEL>
__device__ void phase_dsa(const Params& p, int l, unsigned char* lds, bf16_t* yc, const unsigned short* gsel, const int* gnsel, int tb, int te, int tstep) {
    unsigned short* s_sc = (unsigned short*)lds;
    bf16_t* s_qi = (bf16_t*)(lds + 66048);
    bf16_t* s_Q = (bf16_t*)lds;
    unsigned short* s_sel = (unsigned short*)(lds + 82432 + 65536);
    int* s_nsel = (int*)(lds + 82432 + 65536 + 8192);
    unsigned char* dob = OUTB(p);
    const bf16_t* cqn = (const bf16_t*)(dob + DO_CQN);
    const bf16_t* kv = (const bf16_t*)(dob + DO_KV);
    const bf16_t* kidx = (const bf16_t*)(dob + DO_KIDX);
    const float* whead = (const float*)(dob + DO_WHEAD);
    const float* ctab = (const float*)(WS(p) + OFF_ROPE);
    const float* stab = ctab + TS * 16;
    const bf16_t* wb = (const bf16_t*)(WS(p) + OFF_WB);
    const bf16_t* wqiT = wb + WB_QI;
    const bf16_t* wuqT = wb + WB_UQ;
    const bf16_t* wuk = wb + WB_UK;
    const bf16_t* wuvT = wb + WB_UV;
    const float scale = 0.10206207261596575f;
    const f32x4 z4 = {0.f, 0.f, 0.f, 0.f};
    bf16_t* gq = (obid() < QS_WS) ? (bf16_t*)(WS(p) + WS_END + (size_t)obid() * QS_BYTES) : (bf16_t*)(OUTB(p) + DO_END + (size_t)(obid() - QS_WS) * QS_BYTES);
    for (int pair = tb; pair < te; pair += tstep) {
        const int qt = 128 - (pair >> 2);
        const int t0 = qt * 16;
        uint2 qiB[4] = {make_uint2(0u, 0u), make_uint2(0u, 0u), make_uint2(0u, 0u), make_uint2(0u, 0u)};
#pragma unroll 1
        for (int half = 0; half < 2; ++half) {
        const int tid = otid(), lane = tid & 63, wid = __builtin_amdgcn_readfirstlane(tid >> 6), fr = lane & 15, fq = lane >> 4;
        unsigned char* s_Vw = lds + 82432 + wid * 8192;
        bf16_t* s_qn = (bf16_t*)s_Vw;
        const int b = (pair & 3) * 2 + half;
        const size_t n0 = (size_t)b * TS + t0;
        const bool need_idx = IMPORT_SEL || (t0 + 16 > 256);
        if (!need_idx) {
        } else if (half == 0) {
            bf16x8 acq[8], acqB[8];
#pragma unroll
            for (int kk = 0; kk < 8; ++kk) { acq[kk] = *(const bf16x8*)(cqn + (n0 + fr) * 256 + kk * 32 + fq * 8); acqB[kk] = *(const bf16x8*)(cqn + (n0 + TS + fr) * 256 + kk * 32 + fq * 8); }
            f32x4 c[4] = {z4, z4, z4, z4}, cB[4] = {z4, z4, z4, z4};
#pragma unroll
            for (int kb = 0; kb < 8; kb += 4) {
                bf16x8 bf[4][4];
#pragma unroll
                for (int k4 = 0; k4 < 4; ++k4)
#pragma unroll
                    for (int nt = 0; nt < 4; ++nt) bf[k4][nt] = *(const bf16x8*)(wqiT + (size_t)(wid * 64 + nt * 16 + fr) * 256 + (kb + k4) * 32 + fq * 8);
#pragma unroll
                for (int k4 = 0; k4 < 4; ++k4)
#pragma unroll
                    for (int nt = 0; nt < 4; ++nt) {
                        c[nt] = __builtin_amdgcn_mfma_f32_16x16x32_bf16(acq[kb + k4], bf[k4][nt], c[nt], 0, 0, 0);
                        cB[nt] = __builtin_amdgcn_mfma_f32_16x16x32_bf16(acqB[kb + k4], bf[k4][nt], cB[nt], 0, 0, 0);
                    }
            }
#pragma unroll
            for (int j = 0; j < 4; ++j) {
                const int t = t0 + fq * 4 + j;
                const float cs = ctab[t * 16 + fr], sn = stab[t * 16 + fr];
                const float x1 = c[0][j], x2 = c[1][j];
                c[0][j] = x1 * cs - x2 * sn; c[1][j] = x2 * cs + x1 * sn;
                const float y1 = cB[0][j], y2 = cB[1][j];
                cB[0][j] = y1 * cs - y2 * sn; cB[1][j] = y2 * cs + y1 * sn;
            }
#pragma unroll
            for (int nt = 0; nt < 4; ++nt) {
#pragma unroll
                for (int j = 0; j < 4; ++j) s_qi[(fq * 4 + j) * 512 + wid * 64 + nt * 16 + fr] = f2bf(c[nt][j]);
                qiB[nt] = pack4(cB[nt][0], cB[nt][1], cB[nt][2], cB[nt][3]);
            }
        } else {
#pragma unroll
            for (int nt = 0; nt < 4; ++nt) {
                s_qi[(fq * 4 + 0) * 512 + wid * 64 + nt * 16 + fr] = (bf16_t)(qiB[nt].x & 0xFFFFu); s_qi[(fq * 4 + 1) * 512 + wid * 64 + nt * 16 + fr] = (bf16_t)(qiB[nt].x >> 16);
                s_qi[(fq * 4 + 2) * 512 + wid * 64 + nt * 16 + fr] = (bf16_t)(qiB[nt].y & 0xFFFFu); s_qi[(fq * 4 + 3) * 512 + wid * 64 + nt * 16 + fr] = (bf16_t)(qiB[nt].y >> 16);
            }
        }
        __syncthreads();
        if (!IMPORT_SEL && need_idx) {
            bf16x8 aq[8][2];
#pragma unroll
            for (int h = 0; h < 8; ++h)
#pragma unroll
                for (int ks = 0; ks < 2; ++ks) aq[h][ks] = *(const bf16x8*)(s_qi + fr * 512 + h * 64 + ks * 32 + fq * 8);
            float wh[4][8];
#pragma unroll
            for (int j = 0; j < 4; ++j) {
                const float4 w0 = *(const float4*)(whead + (n0 + fq * 4 + j) * 8), w1 = *(const float4*)(whead + (n0 + fq * 4 + j) * 8 + 4);
                wh[j][0] = w0.x; wh[j][1] = w0.y; wh[j][2] = w0.z; wh[j][3] = w0.w; wh[j][4] = w1.x; wh[j][5] = w1.y; wh[j][6] = w1.z; wh[j][7] = w1.w;
            }
            const int nkt = qt + 1;
            bf16x8 nb0 = {0, 0, 0, 0, 0, 0, 0, 0}, nb1 = nb0;
            if (wid < nkt) { const bf16_t* kr0 = kidx + ((size_t)b * TS + wid * 16 + fr) * 64 + fq * 8; nb0 = *(const bf16x8*)kr0; nb1 = *(const bf16x8*)(kr0 + 32); }
#pragma unroll 1
            for (int kt = wid; kt < nkt; kt += 8) {
                const bf16x8 bk0 = nb0, bk1 = nb1;
                if (kt + 8 < nkt) { const bf16_t* krn = kidx + ((size_t)b * TS + (kt + 8) * 16 + fr) * 64 + fq * 8; nb0 = *(const bf16x8*)krn; nb1 = *(const bf16x8*)(krn + 32); }
                float I[4] = {0.f, 0.f, 0.f, 0.f};
#pragma unroll
                for (int h = 0; h < 8; ++h) {
                    f32x4 a = __builtin_amdgcn_mfma_f32_16x16x32_bf16(aq[h][0], bk0, z4, 0, 0, 0);
                    a = __builtin_amdgcn_mfma_f32_16x16x32_bf16(aq[h][1], bk1, a, 0, 0, 0);
#pragma unroll
                    for (int j = 0; j < 4; ++j) I[j] += wh[j][h] * fmaxf(a[j], 0.f);
                }
#pragma unroll
                for (int j = 0; j < 4; ++j) { const unsigned u = (unsigned)f2h_bits(I[j]) & 0xFFFFu; s_sc[(fq * 4 + j) * 2064 + kt * 16 + fr] = (unsigned short)(u ^ ((u & 0x8000u) ? 0xFFFFu : 0x8000u)); }
            }
        }
        __syncthreads();
#pragma unroll 1
        for (int qi2 = 0; qi2 < 2; ++qi2) {
            const int q = wid + qi2 * 8;
            const int nadm = t0 + q + 1;
            unsigned short* sel = s_sel + q * 256;
            if (IMPORT_SEL) {
                const int ns = gnsel[n0 + q];
                for (int i = lane; i < ns; i += 64) sel[i] = gsel[(n0 + q) * 256 + i];
                if (lane == 0) s_nsel[q] = ns;
            } else if (nadm <= 256) {
                for (int i = lane; i < nadm; i += 64) sel[i] = (unsigned short)i;
                if (lane == 0) s_nsel[q] = nadm;
            } else {
                unsigned* hist = (unsigned*)(lds + 82432 + wid * 8192);
                const unsigned short* scq = s_sc + q * 2064;
                const int nch = (nadm + 63) >> 6;
                unsigned* hmy = hist + (lane & 7) * 256;
                const unsigned hrot = (unsigned)(lane & 7) * 8u;
                unsigned B1 = 0u; int na1 = 0, na2 = 0; unsigned T = 0u;
#pragma unroll 1
                for (int pass = 0; pass < 2; ++pass) {
#pragma unroll
                    for (int j = 0; j < 8; ++j) *(uint4*)(hist + j * 256 + lane * 4) = make_uint4(0u, 0u, 0u, 0u);
                    if (pass == 0) {
#pragma unroll 1
                        for (int c0 = 0; c0 < nch; c0 += 8) {
                            unsigned kb[8];
#pragma unroll
                            for (int j = 0; j < 8; ++j) { const int s_ = (c0 + j) * 64 + lane; const unsigned u = scq[s_]; kb[j] = (s_ < nadm) ? u : 0u; }
#pragma unroll
                            for (int j = 0; j < 8; ++j) atomicAdd(hmy + (((kb[j] >> 8) + hrot) & 255u), 1u);
                        }
                    } else {
#pragma unroll 1
                        for (int c0 = 0; c0 < nch; c0 += 8) {
                            unsigned kb[8];
#pragma unroll
                            for (int j = 0; j < 8; ++j) { const int s_ = (c0 + j) * 64 + lane; const unsigned u = scq[s_]; kb[j] = (s_ < nadm) ? u : 0u; }
#pragma unroll
                            for (int j = 0; j < 8; ++j) if ((kb[j] >> 8) == B1) atomicAdd(hmy + ((kb[j] + hrot) & 255u), 1u);
                        }
                    }
                    const int need = 256 - na1;
                    uint4 h4 = make_uint4(0u, 0u, 0u, 0u);
#pragma unroll
                    for (int c = 0; c < 8; ++c) { const uint4 t4 = *(const uint4*)(hist + c * 256 + ((lane * 4 + c * 8) & 255)); h4.x += t4.x; h4.y += t4.y; h4.z += t4.z; h4.w += t4.w; }
                    const int sl = (int)(h4.x + h4.y + h4.z + h4.w);
                    int suf = sl;
                    suf += __builtin_amdgcn_update_dpp(0, suf, 0x101, 0xF, 0xF, true);
                    suf += __builtin_amdgcn_update_dpp(0, suf, 0x102, 0xF, 0xF, true);
                    suf += __builtin_amdgcn_update_dpp(0, suf, 0x104, 0xF, 0xF, true);
                    suf += __builtin_amdgcn_update_dpp(0, suf, 0x108, 0xF, 0xF, true);
                    {
                        const int t1 = __builtin_amdgcn_readlane(suf, 16), t2 = __builtin_amdgcn_readlane(suf, 32), t3 = __builtin_amdgcn_readlane(suf, 48);
                        suf += (fq == 0) ? t1 + t2 + t3 : (fq == 1) ? t2 + t3 : (fq == 2) ? t3 : 0;
                    }
                    const int above = suf - sl;
                    const bool mine = (suf >= need) && (above < need);
                    int a = above, bsel, asel;
                    if (a + (int)h4.w >= need) { bsel = 3; asel = a; }
                    else { a += (int)h4.w;
                        if (a + (int)h4.z >= need) { bsel = 2; asel = a; }
                        else { a += (int)h4.z;
                            if (a + (int)h4.y >= need) { bsel = 1; asel = a; }
                            else { a += (int)h4.y; bsel = 0; asel = a; } } }
                    const int src = __ffsll((long long)__ballot(mine)) - 1;
                    const unsigned bin = (unsigned)__builtin_amdgcn_readlane(lane * 4 + bsel, src); const int nab = __builtin_amdgcn_readlane(asel, src);
                    if (pass == 0) { B1 = bin; na1 = nab; } else { T = (B1 << 8) | bin; na2 = nab; }
                }
                {
                    const int rties = 256 - (na1 + na2);
                    int base = 0, ties = 0;
                    const unsigned long long ltmask = (1ull << lane) - 1ull;
#pragma unroll 1
                    for (int c0 = 0; c0 < nch; c0 += 4) {
                        unsigned kb[4];
#pragma unroll
                        for (int j = 0; j < 4; ++j) { const int s_ = (c0 + j) * 64 + lane; const unsigned u = scq[s_]; kb[j] = (s_ < nadm) ? u : 0u; }
#pragma unroll
                        for (int j = 0; j < 4; ++j) {
                            const int s_ = (c0 + j) * 64 + lane;
                            const unsigned k = kb[j];
                            const bool gt = k > T, eq = k == T;
                            const unsigned long long em = __ballot(eq);
                            const int myrank = ties + __popcll(em & ltmask);
                            const bool take = gt || (eq && myrank < rties);
                            const unsigned long long tm = __ballot(take);
                            const int pos = base + __popcll(tm & ltmask);
                            if (take && pos < 256) sel[pos] = (unsigned short)s_;
                            base += __popcll(tm); ties += __popcll(em);
                        }
                    }
                }
                if (lane == 0) s_nsel[q] = 256;
            }
        }
        __syncthreads();
        if (half == 0) {
            const size_t n0B = n0 + TS;
            bf16_t* s_qnB = s_qn + 1024;
#pragma unroll 1
            for (int hi = 0; hi < 2; ++hi) {
                const int hh = wid * 2 + hi;
                const bf16_t* caA = cqn + (n0 + fr) * 256 + fq * 8;
                const bf16_t* caB = cqn + (n0B + fr) * 256 + fq * 8;
                f32x4 cA[6] = {z4, z4, z4, z4, z4, z4}, cB[6] = {z4, z4, z4, z4, z4, z4};
#pragma unroll
                for (int kb = 0; kb < 8; kb += 2) {
                    bf16x8 bf[2][6], aA[2], aB[2];
#pragma unroll
                    for (int k2 = 0; k2 < 2; ++k2) {
                        aA[k2] = *(const bf16x8*)(caA + (kb + k2) * 32); aB[k2] = *(const bf16x8*)(caB + (kb + k2) * 32);
#pragma unroll
                        for (int nt = 0; nt < 6; ++nt) bf[k2][nt] = *(const bf16x8*)(wuqT + (size_t)(hh * 96 + nt * 16 + fr) * 256 + (kb + k2) * 32 + fq * 8);
                    }
#pragma unroll
                    for (int k2 = 0; k2 < 2; ++k2)
#pragma unroll
                        for (int nt = 0; nt < 6; ++nt) {
                            cA[nt] = __builtin_amdgcn_mfma_f32_16x16x32_bf16(aA[k2], bf[k2][nt], cA[nt], 0, 0, 0);
                            cB[nt] = __builtin_amdgcn_mfma_f32_16x16x32_bf16(aB[k2], bf[k2][nt], cB[nt], 0, 0, 0);
                        }
                }
#pragma unroll
                for (int j = 0; j < 4; ++j) {
                    const int q = fq * 4 + j, t = t0 + q;
                    const float cs = ctab[t * 16 + fr], sn = stab[t * 16 + fr];
                    s_Q[(q * 16 + hh) * 160 + 128 + fr] = f2bf(cA[4][j] * cs - cA[5][j] * sn);
                    s_Q[(q * 16 + hh) * 160 + 144 + fr] = f2bf(cA[5][j] * cs + cA[4][j] * sn);
                    gq[(q * 16 + hh) * 160 + 128 + fr] = f2bf(cB[4][j] * cs - cB[5][j] * sn);
                    gq[(q * 16 + hh) * 160 + 144 + fr] = f2bf(cB[5][j] * cs + cB[4][j] * sn);
#pragma unroll
                    for (int nt = 0; nt < 4; ++nt) { s_qn[q * 64 + nt * 16 + fr] = f2bf(cA[nt][j]); s_qnB[q * 64 + nt * 16 + fr] = f2bf(cB[nt][j]); }
                }
                __syncthreads();
                bf16x8 anA[2], anB[2];
#pragma unroll
                for (int ks = 0; ks < 2; ++ks) { anA[ks] = *(const bf16x8*)(s_qn + fr * 64 + ks * 32 + fq * 8); anB[ks] = *(const bf16x8*)(s_qnB + fr * 64 + ks * 32 + fq * 8); }
                bf16x8 bwk[8][2];
#pragma unroll
                for (int nt = 0; nt < 8; ++nt)
#pragma unroll
                    for (int ks = 0; ks < 2; ++ks) bwk[nt][ks] = *(const bf16x8*)(wuk + (size_t)(hh * 128 + nt * 16 + fr) * 64 + ks * 32 + fq * 8);
#pragma unroll
                for (int nt = 0; nt < 8; ++nt) {
                    f32x4 aA = z4, aB = z4;
#pragma unroll
                    for (int ks = 0; ks < 2; ++ks) {
                        aA = __builtin_amdgcn_mfma_f32_16x16x32_bf16(anA[ks], bwk[nt][ks], aA, 0, 0, 0);
                        aB = __builtin_amdgcn_mfma_f32_16x16x32_bf16(anB[ks], bwk[nt][ks], aB, 0, 0, 0);
                    }
#pragma unroll
                    for (int j = 0; j < 4; ++j) {
                        s_Q[((fq * 4 + j) * 16 + hh) * 160 + nt * 16 + fr] = f2bf(aA[j]);
                        gq[((fq * 4 + j) * 16 + hh) * 160 + nt * 16 + fr] = f2bf(aB[j]);
                    }
                }
                __syncthreads();
            }
        } else {
#pragma unroll
            for (int i = 0; i < (int)(QS_BYTES / 16 / NTHR); ++i) glds16((const unsigned char*)gq + (size_t)(tid + i * NTHR) * 16, (unsigned char*)s_Q + (tid + i * NTHR) * 16);
            asm volatile("s_waitcnt vmcnt(0)" ::: "memory");
            __syncthreads();
        }
#pragma unroll 1
        for (int qi2 = 0; qi2 < 2; ++qi2) {
            const int q = wid + qi2 * 8;
            bf16x8 bq[5];
#pragma unroll
            for (int ks = 0; ks < 5; ++ks) bq[ks] = *(const bf16x8*)(s_Q + (q * 16 + fr) * 160 + ks * 32 + fq * 8);
            const int nsel = s_nsel[q];
            const unsigned short* sel = s_sel + q * 256;
            float m = -INFINITY, lsum = 0.f;
            f32x4 O[8] = {z4, z4, z4, z4, z4, z4, z4, z4};
            const int nchunk = (nsel + 31) >> 5;
            bf16x8 akn[2][5];
#pragma unroll
            for (int mt = 0; mt < 2; ++mt) {
                const int ki = mt * 16 + fr;
                const int sidx = sel[ki < nsel ? ki : 0];
                const bf16_t* krow = kv + ((size_t)b * TS + sidx) * 160 + fq * 8;
#pragma unroll
                for (int ks = 0; ks < 5; ++ks) akn[mt][ks] = *(const bf16x8*)(krow + ks * 32);
            }
#pragma unroll 1
            for (int ch = 0; ch < nchunk; ++ch) {
                bf16x8 ak[2][5];
#pragma unroll
                for (int mt = 0; mt < 2; ++mt)
#pragma unroll
                    for (int ks = 0; ks < 5; ++ks) ak[mt][ks] = akn[mt][ks];
                if (ch + 1 < nchunk) {
#pragma unroll
                    for (int mt = 0; mt < 2; ++mt) {
                        const int ki = (ch + 1) * 32 + mt * 16 + fr;
                        const int sidx = sel[ki < nsel ? ki : 0];
                        const bf16_t* krow = kv + ((size_t)b * TS + sidx) * 160 + fq * 8;
#pragma unroll
                        for (int ks = 0; ks < 5; ++ks) akn[mt][ks] = *(const bf16x8*)(krow + ks * 32);
                    }
                }
#pragma unroll
                for (int mt = 0; mt < 2; ++mt)
#pragma unroll
                    for (int ks = 0; ks < 4; ++ks) {
                        const int r = mt * 16 + fr;
                        *(bf16x8*)(s_Vw + r * 256 + (((ks * 2 + (fq >> 1)) ^ (r & 7)) * 32) + (fq & 1) * 16) = ak[mt][ks];
                    }
                f32x4 st[2] = {z4, z4};
#pragma unroll
                for (int mt = 0; mt < 2; ++mt)
#pragma unroll
                    for (int ks = 0; ks < 5; ++ks) st[mt] = __builtin_amdgcn_mfma_f32_16x16x32_bf16(ak[mt][ks], bq[ks], st[mt], 0, 0, 0);
                float sv[2][4]; float cmax = -INFINITY;
#pragma unroll
                for (int mt = 0; mt < 2; ++mt)
#pragma unroll
                    for (int j = 0; j < 4; ++j) {
                        const int ke = ch * 32 + mt * 16 + fq * 4 + j;
                        const float s_ = (ke < nsel) ? st[mt][j] * scale : -INFINITY;
                        sv[mt][j] = s_; cmax = fmaxf(cmax, s_);
                    }
                { const auto a_ = __builtin_amdgcn_permlane16_swap(__float_as_uint(cmax), __float_as_uint(cmax), false, false); cmax = fmaxf(__uint_as_float(a_[0]), __uint_as_float(a_[1]));
                  const auto b_ = __builtin_amdgcn_permlane32_swap(__float_as_uint(cmax), __float_as_uint(cmax), false, false); cmax = fmaxf(__uint_as_float(b_[0]), __uint_as_float(b_[1])); }
                const float mnew = fmaxf(m, cmax);
                const float alpha = __expf(m - mnew);
                float psum = 0.f;
#pragma unroll
                for (int mt = 0; mt < 2; ++mt)
#pragma unroll
                    for (int j = 0; j < 4; ++j) { const float pe = __expf(sv[mt][j] - mnew); sv[mt][j] = pe; psum += pe; }
                psum = xrow_sum(psum);
                lsum = lsum * alpha + psum; m = mnew;
#pragma unroll
                for (int ct = 0; ct < 8; ++ct) O[ct] = O[ct] * alpha;
                bf16x8 pf;
#pragma unroll
                for (int mt = 0; mt < 2; ++mt)
#pragma unroll
                    for (int j = 0; j < 4; ++j) pf[mt * 4 + j] = (short)f2bf(sv[mt][j]);
                const int q_ = fr >> 2, p_ = fr & 3;
                const int r0 = fq * 4 + q_, r1 = 16 + r0;
                bf16x8 avv[8];
#pragma unroll
                for (int ct = 0; ct < 8; ++ct) {
                    const s16x4 v0 = __builtin_amdgcn_ds_read_tr16_b64_v4i16((__attribute__((address_space(3))) s16x4*)(s_Vw + r0 * 256 + ((ct ^ (r0 & 7)) * 32) + p_ * 8));
                    const s16x4 v1 = __builtin_amdgcn_ds_read_tr16_b64_v4i16((__attribute__((address_space(3))) s16x4*)(s_Vw + r1 * 256 + ((ct ^ (r1 & 7)) * 32) + p_ * 8));
                    avv[ct][0] = v0[0]; avv[ct][1] = v0[1]; avv[ct][2] = v0[2]; avv[ct][3] = v0[3]; avv[ct][4] = v1[0]; avv[ct][5] = v1[1]; avv[ct][6] = v1[2]; avv[ct][7] = v1[3];
                }
                __builtin_amdgcn_sched_barrier(0);
#pragma unroll
                for (int ct = 0; ct < 8; ++ct) O[ct] = __builtin_amdgcn_mfma_f32_16x16x32_bf16(avv[ct], pf, O[ct], 0, 0, 0);
            }
            const float inv = 1.0f / lsum;
#pragma unroll
            for (int ct = 0; ct < 8; ++ct)
#pragma unroll
                for (int j = 0; j < 4; ++j) s_Q[(q * 16 + fr) * 160 + ct * 16 + fq * 4 + j] = f2bf(O[ct][j] * inv);
        }
        __syncthreads();
        bf16_t* oscr = (bf16_t*)(WS(p) + OFF_PMISC) + (size_t)obid() * (16 * 16 * 128);
        if (half == 0) {
            uint4 ov[8];
#pragma unroll
            for (int i = 0; i < 8; ++i) { const int e = tid + i * NTHR, row = e >> 4, pc = e & 15; ov[i] = *(const uint4*)(s_Q + row * 160 + pc * 8); }
#pragma unroll
            for (int i = 0; i < 8; ++i) { const int e = tid + i * NTHR; *(uint4*)(oscr + (size_t)e * 8) = ov[i]; }
        } else {
#pragma unroll 1
            for (int hi = 0; hi < 2; ++hi) {
                const int hh = wid * 2 + hi;
                bf16x8 aoA[4], aoB[4];
#pragma unroll
                for (int ks = 0; ks < 4; ++ks) { aoA[ks] = *(const bf16x8*)(oscr + (fr * 16 + hh) * 128 + ks * 32 + fq * 8); aoB[ks] = *(const bf16x8*)(s_Q + (fr * 16 + hh) * 160 + ks * 32 + fq * 8); }
#pragma unroll
                for (int nt = 0; nt < 4; ++nt) {
                    bf16x8 wv[4];
#pragma unroll
                    for (int ks = 0; ks < 4; ++ks) wv[ks] = *(const bf16x8*)(wuvT + (size_t)(hh * 64 + nt * 16 + fr) * 128 + ks * 32 + fq * 8);
                    f32x4 aA = z4, aB = z4;
#pragma unroll
                    for (int ks = 0; ks < 4; ++ks) { aA = __builtin_amdgcn_mfma_f32_16x16x32_bf16(wv[ks], aoA[ks], aA, 0, 0, 0); aB = __builtin_amdgcn_mfma_f32_16x16x32_bf16(wv[ks], aoB[ks], aB, 0, 0, 0); }
                    *(uint2*)(yc + (n0 - TS + fr) * 1024 + hh * 64 + nt * 16 + fq * 4) = pack4(aA[0], aA[1], aA[2], aA[3]);
                    *(uint2*)(yc + (n0 + fr) * 1024 + hh * 64 + nt * 16 + fq * 4) = pack4(aB[0], aB[1], aB[2], aB[3]);
                }
            }
        }
        __syncthreads();
        }
    }
}


__device__ void phase_lr_prep(const Params& p, int l) {
    const int lane = otid() & 63;
    const int wave = (obid() * NTHR + otid()) >> 6, nw = gridDim.x * NTHR / 64;
    const bf16_t* pm = (const bf16_t*)(WS(p) + OFF_PMISC);
    bf16_t* alr = (bf16_t*)(OUTB(p) + DO_ALR);
    const float4 mu4 = *(const float4*)(p.in[4] + (size_t)l * 3328 + 3072 + lane * 4);
    const float4 vm4 = *(const float4*)(p.in[18] + (lane & 7) * 4);
    struct In { uint2 c0, p0, c1, p1; };
    auto load = [&](int n) {
        In r;
        const bf16_t* row = pm + (size_t)n * PM_LD;
        const bool hp = (n % TS) > 0;
        r.c0 = *(const uint2*)(row + lane * 4);
        r.p0 = hp ? *(const uint2*)(row - PM_LD + lane * 4) : make_uint2(0u, 0u);
        r.c1 = make_uint2(0u, 0u); r.p1 = r.c1;
        if (lane < 8) { r.c1 = *(const uint2*)(row + 256 + lane * 4); if (hp) r.p1 = *(const uint2*)(row - PM_LD + 256 + lane * 4); }
        return r;
    };
    auto mix4 = [&](const uint2 c, const uint2 q, const float4 m, float (&o)[4]) {
        const float c0 = __uint_as_float(c.x << 16), c1 = __uint_as_float(c.x & 0xFFFF0000u), c2 = __uint_as_float(c.y << 16), c3 = __uint_as_float(c.y & 0xFFFF0000u);
        const float q0 = __uint_as_float(q.x << 16), q1 = __uint_as_float(q.x & 0xFFFF0000u), q2 = __uint_as_float(q.y << 16), q3 = __uint_as_float(q.y & 0xFFFF0000u);
        o[0] = c0 + (q0 - c0) * m.x; o[1] = c1 + (q1 - c1) * m.y; o[2] = c2 + (q2 - c2) * m.z; o[3] = c3 + (q3 - c3) * m.w;
    };
    In cur = load(wave < NT ? wave : 0);
    for (int n = wave; n < NT; n += nw) {
        const In x = cur;
        if (n + nw < NT) cur = load(n + nw);
        float o[4];
        mix4(x.c0, x.p0, mu4, o);
        if (lane < 16) { o[0] = tanhf(o[0]); o[1] = tanhf(o[1]); o[2] = tanhf(o[2]); o[3] = tanhf(o[3]); }
        else if (lane >= 32) { o[0] = sigmoidf_(o[0]); o[1] = sigmoidf_(o[1]); o[2] = sigmoidf_(o[2]); o[3] = sigmoidf_(o[3]); }
        *(uint2*)(alr + (size_t)n * 288 + lane * 4) = pack4(o[0], o[1], o[2], o[3]);
        if (lane < 8) {
            mix4(x.c1, x.p1, vm4, o);
            *(uint2*)(alr + (size_t)n * 288 + 256 + lane * 4) = pack4(o[0], o[1], o[2], o[3]);
        }
    }
}

typedef short sh4 __attribute__((ext_vector_type(4)));
__device__ __forceinline__ sh4 pk4v(const f32x4& v) { const uint2 u = pack4(v[0], v[1], v[2], v[3]); sh4 r; __builtin_memcpy(&r, &u, 8); return r; }
__device__ __forceinline__ bf16x8 cat8(const sh4& a, const sh4& b) { bf16x8 r; r[0] = a[0]; r[1] = a[1]; r[2] = a[2]; r[3] = a[3]; r[4] = b[0]; r[5] = b[1]; r[6] = b[2]; r[7] = b[3]; return r; }
#define MF32(a, b, c) __builtin_amdgcn_mfma_f32_16x16x32_bf16(a, b, c, 0, 0, 0)
#define MF16(a, b, c) MF32(cat8(a, sh4{0, 0, 0, 0}), cat8(b, sh4{0, 0, 0, 0}), c)
constexpr int SC_LT = 72;
constexpr int SC_LS = 36;
constexpr int SC_TC = 32;
constexpr int SC_ROWB = 1088;
__device__ __forceinline__ const unsigned char* scan_piece_src(const Params& p, int l, int b, int hc, int t0, int pi, bool& ok) {
    const int tau = pi / 68, seg = pi - tau * 68;
    const int t = t0 + tau;
    ok = (t < TS) && (tau < SC_TC);
    const size_t n = (size_t)b * TS + t;
    const unsigned char* ws = WS(p);
    if (seg < 8) return ws + OFF_PR + (n * 1024 + hc) * 2 + seg * 16;
    if (seg < 16) return ws + OFF_PK + (n * 1024 + hc) * 2 + (seg - 8) * 16;
    if (seg < 24) return ws + OFF_PV + (n * 1024 + hc) * 2 + (seg - 16) * 16;
    if (seg < 60) return OUTB(p) + DO_ALR + (n * 288) * 2 + (seg - 24) * 16;
    ok = ok && (l > 0);
    return ws + OFF_VFIRST + (n * 1024 + hc) * 2 + (seg - 60) * 16;
}
__device__ void phase_scan5(const Params& p, int l, unsigned char* lds, int blk) {
    const int tid = otid(), lane = tid & 63, wid = __builtin_amdgcn_readfirstlane(tid >> 6), fr = lane & 15, fq = lane >> 4;
    const int b = blk >> 4, hh = blk & 15, hc = hh * 64;
    float* s_r = (float*)lds;
    float* s_w = s_r + 2048;
    float* s_k = s_w + 2048;
    float* s_v = s_k + 2048;
    float* s_a = s_v + 2048;
    float* s_b = s_a + 2048;
    float* s_g = s_b + 2048;
    float* s_o = s_g + 2048;
    bf16_t* o_at = (bf16_t*)(s_o + 2048);
    bf16_t* o_rt = o_at + 32 * SC_LT;
    bf16_t* o_bt = o_rt + 32 * SC_LT;
    bf16_t* o_kt = o_bt + 32 * SC_LT;
    bf16_t* o_bT = o_kt + 32 * SC_LT;
    bf16_t* o_kT = o_bT + 64 * SC_LS;
    bf16_t* o_vT = o_kT + 64 * SC_LS;
    float* s_gc = (float*)(o_vT + 64 * SC_LS);
    unsigned char* raw = (unsigned char*)(s_gc + 128);
    float* prevb = (float*)(raw + 32 * SC_ROWB);
    unsigned* prevr = (unsigned*)prevb;
    float* cst = prevb + 960;
    float* s_gB = s_r;
    float* s_oB = s_k;
    float* s_vB = cst + 992;
    float* s_bs2 = s_vB + 2048;
    uint2* s_op = (uint2*)(s_bs2 + 64);
    const float* mu = p.in[4] + (size_t)l * 3328;
    for (int e = tid; e < 480; e += NTHR) {
        float v;
        if (e < 192) v = mu[(e >> 6) * 1024 + hc + (e & 63)];
        else if (e < 448) v = mu[3072 + (e - 192)];
        else v = p.in[18][e - 448];
        cst[e] = v;
    }
    if (tid < 64) {
        cst[480 + tid] = p.in[7][l * 1024 + hc + tid];
        cst[544 + tid] = p.in[9][l * 1024 + hc + tid];
        cst[608 + tid] = p.in[12][l * 1024 + hc + tid];
        cst[672 + tid] = p.in[13][l * 1024 + hc + tid];
        cst[736 + tid] = p.in[14][l * 1024 + hc + tid];
        cst[800 + tid] = p.in[15][l * 1024 + hc + tid];
        cst[864 + tid] = p.in[16][l * 1024 + hc + tid];
        cst[928 + tid] = p.in[19][hc + tid];
    }
    const int mm = wid >> 1, ntb = (wid & 1) * 2;
    const int nks = (mm == 2) ? 4 : (mm == 3 ? 1 : 2);
    bf16x8 Bw[2][4];
    {
        const float* wsrc = (mm == 0) ? p.in[8] + (size_t)l * 64 * 1024 : (mm == 1) ? p.in[10] + (size_t)l * 64 * 1024 : (mm == 2) ? p.in[11] + (size_t)l * 128 * 1024 : p.in[20];
#pragma unroll
        for (int n2 = 0; n2 < 2; ++n2)
#pragma unroll
            for (int ks = 0; ks < 4; ++ks) {
                bf16x8 f;
#pragma unroll
                for (int j = 0; j < 8; ++j) {
                    const bool okw = ks < nks && (mm < 3 || l > 0);
                    const float v = wsrc[(size_t)(okw ? (ks * 32 + fq * 8 + j) : 0) * 1024 + hc + (ntb + n2) * 16 + fr];
                    f[j] = (short)f2bf(okw ? v : 0.f);
                }
                Bw[n2][ks] = f;
            }
    }
    const f32x4 z4 = {0.f, 0.f, 0.f, 0.f};
    f32x4 S[4] = {z4, z4, z4, z4};
    sh4 Lf;
#pragma unroll
    for (int j = 0; j < 4; ++j) Lf[j] = (fq * 4 + j <= fr) ? (short)0x3F80 : (short)0;
    bf16_t* Pr = (bf16_t*)(WS(p) + OFF_PR);
    bf16_t* vfirst = (bf16_t*)(WS(p) + OFF_VFIRST);
    const unsigned char* psrc[5]; int pstep[5], ptau[5]; bool pval[5];
#pragma unroll
    for (int k = 0; k < 5; ++k) {
        const int pi = tid + k * NTHR;
        bool ok = false;
        psrc[k] = scan_piece_src(p, l, b, hc, 0, pi < SC_TC * 68 ? pi : 0, ok);
        const int tau = (pi < SC_TC * 68 ? pi : 0) / 68, seg = (pi < SC_TC * 68 ? pi : 0) - tau * 68;
        ptau[k] = tau;
        pstep[k] = SC_TC * ((seg >= 24 && seg < 60) ? 576 : 2048);
        pval[k] = (pi < SC_TC * 68) && !(seg >= 60 && l == 0);
    }
    uint4 pre[5];
#pragma unroll
    for (int k = 0; k < 5; ++k) { pre[k] = make_uint4(0, 0, 0, 0); if (pval[k] && ptau[k] < TS) pre[k] = *(const uint4*)psrc[k]; }
    __syncthreads();
    auto stepE = [&](int tau, int c4, const float* so, const float* sv, const float* sgp, const float* sb, int t0e, int nve) {
        const int e = tau * 64 + c4;
        const size_t n = (size_t)b * TS + t0e + tau;
        const float4 o4 = *(const float4*)(so + e), v4_ = *(const float4*)(sv + e), g4_ = *(const float4*)(sgp + e);
        const float4 clw = *(const float4*)(cst + 800 + c4), clb = *(const float4*)(cst + 864 + c4);
        const float bsum = sb[tau];
        const float m_ = row16_sum((o4.x + o4.y) + (o4.z + o4.w)) * (1.0f / 64.0f);
        const float d0 = o4.x - m_, d1 = o4.y - m_, d2 = o4.z - m_, d3 = o4.w - m_;
        const float var = row16_sum(d0 * d0 + d1 * d1 + d2 * d2 + d3 * d3) * (1.0f / 64.0f);
        const float rs = rsqrtf(var + 64e-5f);
        const float y0 = (d0 * rs * clw.x + clb.x + bsum * v4_.x) * g4_.x, y1 = (d1 * rs * clw.y + clb.y + bsum * v4_.y) * g4_.y;
        const float y2 = (d2 * rs * clw.z + clb.z + bsum * v4_.z) * g4_.z, y3 = (d3 * rs * clw.w + clb.w + bsum * v4_.w) * g4_.w;
        if (tau < nve) *(uint2*)(Pr + n * 1024 + hc + c4) = pack4(y0, y1, y2, y3);
    };
#pragma unroll 1
    for (int t0 = 0, ch = 0; t0 < TS; t0 += SC_TC, ++ch) {
        const int nval = (TS - t0 < SC_TC) ? (TS - t0) : SC_TC;
        const bool par = (ch & 1) != 0;
        float* g_c = par ? s_gB : s_g; float* o_c = par ? s_oB : s_o; float* v_c = par ? s_vB : s_v; float* bs_c = s_bs2 + (par ? 32 : 0);
        float* g_p = par ? s_g : s_gB; float* o_p = par ? s_o : s_oB; float* v_p = par ? s_v : s_vB; float* bs_p = s_bs2 + (par ? 0 : 32);
#pragma unroll
        for (int k = 0; k < 5; ++k) { const int pi = tid + k * NTHR; if (pi < SC_TC * 68) *(uint4*)(raw + pi * 16) = pre[k]; }
        lds_barrier();
#pragma unroll
        for (int k = 0; k < 5; ++k) {
            pre[k] = make_uint4(0, 0, 0, 0);
            if (pval[k] && t0 + SC_TC + ptau[k] < TS) pre[k] = *(const uint4*)(psrc[k] + (size_t)(ch + 1) * pstep[k]);
        }
        if (mm < 3 || l > 0) {
            const unsigned char* Ab = raw + ((mm == 0) ? 384 : (mm == 1) ? 512 : (mm == 2) ? 640 : 896);
            float* dst = (mm == 0) ? s_w : (mm == 1) ? s_a : (mm == 2) ? g_c : o_c;
#pragma unroll
            for (int m = 0; m < 2; ++m) {
                f32x4 acc0 = {0.f, 0.f, 0.f, 0.f}, acc1 = {0.f, 0.f, 0.f, 0.f};
#pragma unroll
                for (int ks = 0; ks < 4; ++ks) {
                    if (ks < nks) {
                        const bf16x8 a = *(const bf16x8*)(Ab + (m * 16 + fr) * SC_ROWB + ks * 64 + fq * 16);
                        acc0 = __builtin_amdgcn_mfma_f32_16x16x32_bf16(a, Bw[0][ks], acc0, 0, 0, 0);
                        acc1 = __builtin_amdgcn_mfma_f32_16x16x32_bf16(a, Bw[1][ks], acc1, 0, 0, 0);
                    }
                }
                if (mm == 0) {
                    const float cw0 = cst[480 + ntb * 16 + fr], cw1 = cst[480 + (ntb + 1) * 16 + fr];
                    f32x4 l0, l1, r0, r1;
#pragma unroll
                    for (int j = 0; j < 4; ++j) { l0[j] = -0.6065306597126334f * fast_sigmoid(acc0[j] + cw0); l1[j] = -0.6065306597126334f * fast_sigmoid(acc1[j] + cw1); }
                    const uint2 h0 = pack4(l0[0], l0[1], l0[2], l0[3]), h1 = pack4(l1[0], l1[1], l1[2], l1[3]);
                    r0[0] = l0[0] - __uint_as_float(h0.x << 16); r0[1] = l0[1] - __uint_as_float(h0.x & 0xFFFF0000u); r0[2] = l0[2] - __uint_as_float(h0.y << 16); r0[3] = l0[3] - __uint_as_float(h0.y & 0xFFFF0000u);
                    r1[0] = l1[0] - __uint_as_float(h1.x << 16); r1[1] = l1[1] - __uint_as_float(h1.x & 0xFFFF0000u); r1[2] = l1[2] - __uint_as_float(h1.y << 16); r1[3] = l1[3] - __uint_as_float(h1.y & 0xFFFF0000u);
                    sh4 hh0, hh1; __builtin_memcpy(&hh0, &h0, 8); __builtin_memcpy(&hh1, &h1, 8);
                    f32x4 c0 = MF16(Lf, pk4v(r0), z4), c1 = MF16(Lf, pk4v(r1), z4);
                    c0 = MF16(Lf, hh0, c0); c1 = MF16(Lf, hh1, c1);
#pragma unroll
                    for (int j = 0; j < 4; ++j) {
                        const int eo = (m * 16 + fq * 4 + j) * 64 + ntb * 16 + fr;
                        s_w[eo] = c0[j]; s_w[eo + 16] = c1[j];
                        s_b[eo] = l0[j]; s_b[eo + 16] = l1[j];
                    }
                } else {
#pragma unroll
                    for (int j = 0; j < 4; ++j) {
                        dst[(m * 16 + fq * 4 + j) * 64 + ntb * 16 + fr] = acc0[j];
                        dst[(m * 16 + fq * 4 + j) * 64 + (ntb + 1) * 16 + fr] = acc1[j];
                    }
                }
            }
        }
        lds_barrier();
        {
            const int tau = tid >> 4, c4 = (tid & 15) * 4, e = tau * 64 + c4, t = t0 + tau;
            const size_t n = (size_t)b * TS + t;
            const float4 cum4 = *(const float4*)(s_w + e), lw4 = *(const float4*)(s_b + e), xa4 = *(const float4*)(s_a + e);
            const float4 ca = *(const float4*)(cst + 544 + c4), ckk = *(const float4*)(cst + 608 + c4), cka = *(const float4*)(cst + 672 + c4), crk = *(const float4*)(cst + 736 + c4);
            const float cum[4] = {cum4.x, cum4.y, cum4.z, cum4.w}, lw[4] = {lw4.x, lw4.y, lw4.z, lw4.w};
            const float xa[4] = {xa4.x + ca.x, xa4.y + ca.y, xa4.z + ca.z, xa4.w + ca.w};
            const float kkc[4] = {ckk.x, ckk.y, ckk.z, ckk.w}, kac[4] = {cka.x, cka.y, cka.z, cka.w};
            float rr[4], kr[4], vv[4];
            {
                const unsigned char* rc = raw + tau * SC_ROWB + c4 * 2;
                const uint2 cr = *(const uint2*)rc, ck = *(const uint2*)(rc + 128), cv = *(const uint2*)(rc + 256);
                uint2 qr = make_uint2(0u, 0u), qk = qr, qv = qr;
                if (tau > 0) { qr = *(const uint2*)(rc - SC_ROWB); qk = *(const uint2*)(rc - SC_ROWB + 128); qv = *(const uint2*)(rc - SC_ROWB + 256); }
                else if (t0 > 0) { const unsigned* pvr = prevr + ((ch + 1) & 1) * 96 + (c4 >> 1); qr = *(const uint2*)pvr; qk = *(const uint2*)(pvr + 32); qv = *(const uint2*)(pvr + 64); }
                if (tau == SC_TC - 1) { unsigned* pwr = prevr + (ch & 1) * 96 + (c4 >> 1); *(uint2*)pwr = cr; *(uint2*)(pwr + 32) = ck; *(uint2*)(pwr + 64) = cv; }
                const float4 mr = *(const float4*)(cst + c4), mk = *(const float4*)(cst + 64 + c4), mv = *(const float4*)(cst + 128 + c4);
                const float c_[12] = {__uint_as_float(cr.x << 16), __uint_as_float(cr.x & 0xFFFF0000u), __uint_as_float(cr.y << 16), __uint_as_float(cr.y & 0xFFFF0000u),
                                      __uint_as_float(ck.x << 16), __uint_as_float(ck.x & 0xFFFF0000u), __uint_as_float(ck.y << 16), __uint_as_float(ck.y & 0xFFFF0000u),
                                      __uint_as_float(cv.x << 16), __uint_as_float(cv.x & 0xFFFF0000u), __uint_as_float(cv.y << 16), __uint_as_float(cv.y & 0xFFFF0000u)};
                const float q_[12] = {__uint_as_float(qr.x << 16), __uint_as_float(qr.x & 0xFFFF0000u), __uint_as_float(qr.y << 16), __uint_as_float(qr.y & 0xFFFF0000u),
                                      __uint_as_float(qk.x << 16), __uint_as_float(qk.x & 0xFFFF0000u), __uint_as_float(qk.y << 16), __uint_as_float(qk.y & 0xFFFF0000u),
                                      __uint_as_float(qv.x << 16), __uint_as_float(qv.x & 0xFFFF0000u), __uint_as_float(qv.y << 16), __uint_as_float(qv.y & 0xFFFF0000u)};
                const float m_[12] = {mr.x, mr.y, mr.z, mr.w, mk.x, mk.y, mk.z, mk.w, mv.x, mv.y, mv.z, mv.w};
#pragma unroll
                for (int j = 0; j < 4; ++j) { rr[j] = c_[j] + (q_[j] - c_[j]) * m_[j]; kr[j] = c_[4 + j] + (q_[4 + j] - c_[4 + j]) * m_[4 + j]; vv[j] = c_[8 + j] + (q_[8 + j] - c_[8 + j]) * m_[8 + j]; }
            }
            if (l > 0) {
                const float4 xv4 = *(const float4*)(o_c + e), cv = *(const float4*)(cst + 928 + c4);
                const uint2 vfu = *(const uint2*)(raw + tau * SC_ROWB + 960 + c4 * 2);
                const float vf[4] = {__uint_as_float(vfu.x << 16), __uint_as_float(vfu.x & 0xFFFF0000u), __uint_as_float(vfu.y << 16), __uint_as_float(vfu.y & 0xFFFF0000u)};
                const float xv[4] = {xv4.x + cv.x, xv4.y + cv.y, xv4.z + cv.z, xv4.w + cv.w};
#pragma unroll
                for (int j = 0; j < 4; ++j) vv[j] = vv[j] + (vf[j] - vv[j]) * fast_sigmoid(xv[j]);
            } else if (t < TS) {
                *(uint2*)(vfirst + n * 1024 + hc + c4) = pack4(vv[0], vv[1], vv[2], vv[3]);
            }
            float av[4], kkv[4], ginc[4], gexc[4], ginv[4]; float ss = 0.f;
#pragma unroll
            for (int j = 0; j < 4; ++j) {
                ginc[j] = __expf(cum[j]); gexc[j] = __expf(cum[j] - lw[j]); ginv[j] = __expf(-cum[j]);
                av[j] = fast_sigmoid(xa[j]);
                kkv[j] = kr[j] * kkc[j];
                ss += kkv[j] * kkv[j];
            }
            float kk[4], kt[4];
#pragma unroll
            for (int j = 0; j < 4; ++j) kt[j] = kr[j] * (1.0f + (av[j] - 1.0f) * kac[j]);
            float bsum = rr[0] * kt[0] * crk.x + rr[1] * kt[1] * crk.y + rr[2] * kt[2] * crk.z + rr[3] * kt[3] * crk.w;
            float du0 = 0.f, du1 = 0.f;
            row16_sum4(ss, bsum, du0, du1);
            if ((tid & 15) == 0) bs_c[tau] = bsum;
            const float rn = rsqrtf(fmaxf(ss, 1e-24f));
#pragma unroll
            for (int j = 0; j < 4; ++j) kk[j] = kkv[j] * rn;
            const uint2 pa = pack4(-kk[0] * gexc[0], -kk[1] * gexc[1], -kk[2] * gexc[2], -kk[3] * gexc[3]);
            const uint2 pr = pack4(rr[0] * ginc[0], rr[1] * ginc[1], rr[2] * ginc[2], rr[3] * ginc[3]);
            const uint2 pb = pack4(kk[0] * av[0] * ginv[0], kk[1] * av[1] * ginv[1], kk[2] * av[2] * ginv[2], kk[3] * av[3] * ginv[3]);
            const uint2 pk = pack4(kt[0] * ginv[0], kt[1] * ginv[1], kt[2] * ginv[2], kt[3] * ginv[3]);
            const uint2 pv = pack4(vv[0], vv[1], vv[2], vv[3]);
            *(uint2*)(o_at + tau * SC_LT + c4) = pa;
            *(uint2*)(o_rt + tau * SC_LT + c4) = pr;
            *(uint2*)(o_bt + tau * SC_LT + c4) = pb;
            *(uint2*)(o_kt + tau * SC_LT + c4) = pk;
            o_bT[(c4 + 0) * SC_LS + tau] = (bf16_t)(pb.x & 0xFFFFu); o_bT[(c4 + 1) * SC_LS + tau] = (bf16_t)(pb.x >> 16); o_bT[(c4 + 2) * SC_LS + tau] = (bf16_t)(pb.y & 0xFFFFu); o_bT[(c4 + 3) * SC_LS + tau] = (bf16_t)(pb.y >> 16);
            o_kT[(c4 + 0) * SC_LS + tau] = (bf16_t)(pk.x & 0xFFFFu); o_kT[(c4 + 1) * SC_LS + tau] = (bf16_t)(pk.x >> 16); o_kT[(c4 + 2) * SC_LS + tau] = (bf16_t)(pk.y & 0xFFFFu); o_kT[(c4 + 3) * SC_LS + tau] = (bf16_t)(pk.y >> 16);
            o_vT[(c4 + 0) * SC_LS + tau] = (bf16_t)(pv.x & 0xFFFFu); o_vT[(c4 + 1) * SC_LS + tau] = (bf16_t)(pv.x >> 16); o_vT[(c4 + 2) * SC_LS + tau] = (bf16_t)(pv.y & 0xFFFFu); o_vT[(c4 + 3) * SC_LS + tau] = (bf16_t)(pv.y >> 16);
            if ((tau & 15) == 15) *(float4*)(s_gc + (tau >> 4) * 64 + c4) = make_float4(ginc[0], ginc[1], ginc[2], ginc[3]);
            *(float4*)(v_c + e) = make_float4(vv[0], vv[1], vv[2], vv[3]);
        }
        lds_barrier();
        if (wid == 4 || wid == 5) {
            const int sc = wid - 4;
            const bf16_t* ar = o_at + (sc * 16 + fr) * SC_LT;
            const bf16_t* rr_ = o_rt + (sc * 16 + fr) * SC_LT;
            const bf16_t* br = o_bt + (sc * 16 + fr) * SC_LT;
            const bf16_t* kr_ = o_kt + (sc * 16 + fr) * SC_LT;
            const bf16x8 fa0 = *(const bf16x8*)(ar + fq * 8), fa1 = *(const bf16x8*)(ar + 32 + fq * 8);
            const bf16x8 fb0 = *(const bf16x8*)(br + fq * 8), fb1 = *(const bf16x8*)(br + 32 + fq * 8);
            const bf16x8 fk0 = *(const bf16x8*)(kr_ + fq * 8), fk1 = *(const bf16x8*)(kr_ + 32 + fq * 8);
            const bf16x8 fr0 = *(const bf16x8*)(rr_ + fq * 8), fr1 = *(const bf16x8*)(rr_ + 32 + fq * 8);
            f32x4 nA = MF32(fb0, fa0, z4); nA = MF32(fb1, fa1, nA);
            f32x4 nB = MF32(fa0, fb0, z4); nB = MF32(fa1, fb1, nB);
            f32x4 mak = MF32(fk0, fa0, z4); mak = MF32(fk1, fa1, mak);
            f32x4 mbr = MF32(fb0, fr0, z4); mbr = MF32(fb1, fr1, mbr);
            f32x4 mkr = MF32(fk0, fr0, z4); mkr = MF32(fk1, fr1, mkr);
            float idv[4];
#pragma unroll
            for (int j = 0; j < 4; ++j) {
                const int s_ = fq * 4 + j;
                nA[j] = (s_ < fr) ? nA[j] : 0.f; nB[j] = (fr < s_) ? nB[j] : 0.f; mak[j] = (s_ < fr) ? mak[j] : 0.f;
                mbr[j] = (s_ <= fr) ? mbr[j] : 0.f; mkr[j] = (s_ <= fr) ? mkr[j] : 0.f;
                idv[j] = (s_ == fr) ? 1.f : 0.f;
            }
            const sh4 pNA = pk4v(nA), pNB = pk4v(nB);
            f32x4 n2B = MF16(pNA, pNB, z4); const f32x4 n2A = MF16(pNB, pNA, z4);
            const sh4 pN2A = pk4v(n2A), pN2B = pk4v(n2B);
            f32x4 n4B = MF16(pN2A, pN2B, z4); const f32x4 n4A = MF16(pN2B, pN2A, z4);
            f32x4 n8A = MF16(pk4v(n4B), pk4v(n4A), z4);
            f32x4 a1A = nA;
#pragma unroll
            for (int j = 0; j < 4; ++j) { a1A[j] += idv[j]; n2B[j] += idv[j]; n4B[j] += idv[j]; n8A[j] += idv[j]; }
            const f32x4 p12B = MF16(pk4v(a1A), pk4v(n2B), z4);
            const f32x4 p48A = MF16(pk4v(n4B), pk4v(n8A), z4);
            const f32x4 tA = MF16(pk4v(p12B), pk4v(p48A), z4);
            uint2* op = s_op + sc * 256 + lane;
            op[0] = pack4(tA[0], tA[1], tA[2], tA[3]); op[64] = pack4(mak[0], mak[1], mak[2], mak[3]);
            op[128] = pack4(mbr[0], mbr[1], mbr[2], mbr[3]); op[192] = pack4(mkr[0], mkr[1], mkr[2], mkr[3]);
        }
        lds_barrier();
        if (wid < 4) {
#pragma unroll 1
            for (int sc = 0; sc < 2; ++sc) {
                if (sc * 16 < nval) {
                    const bf16_t* ar = o_at + (sc * 16 + fr) * SC_LT;
                    const bf16_t* rr_ = o_rt + (sc * 16 + fr) * SC_LT;
                    const uint2* op = s_op + sc * 256 + lane;
                    sh4 pT, pMak, pMbr, pMkr;
                    { const uint2 u0 = op[0], u1 = op[64], u2 = op[128], u3 = op[192]; __builtin_memcpy(&pT, &u0, 8); __builtin_memcpy(&pMak, &u1, 8); __builtin_memcpy(&pMbr, &u2, 8); __builtin_memcpy(&pMkr, &u3, 8); }
                    const bf16x8 sB0 = cat8(pk4v(S[0]), pk4v(S[1])), sB1 = cat8(pk4v(S[2]), pk4v(S[3]));
                    const sh4 vf = *(const sh4*)(o_vT + (wid * 16 + fr) * SC_LS + sc * 16 + fq * 4);
                    f32x4 X = MF32(cat8(*(const sh4*)(ar + fq * 4), *(const sh4*)(ar + 16 + fq * 4)), sB0, z4);
                    X = MF32(cat8(*(const sh4*)(ar + 32 + fq * 4), *(const sh4*)(ar + 48 + fq * 4)), sB1, X);
                    X = MF16(pMak, vf, X);
                    const f32x4 SA = MF16(pT, pk4v(X), z4);
                    const sh4 pSA = pk4v(SA);
                    f32x4 O = MF32(cat8(*(const sh4*)(rr_ + fq * 4), *(const sh4*)(rr_ + 16 + fq * 4)), sB0, z4);
                    O = MF32(cat8(*(const sh4*)(rr_ + 32 + fq * 4), *(const sh4*)(rr_ + 48 + fq * 4)), sB1, O);
                    const bf16x8 sav = cat8(pSA, vf);
                    O = MF32(cat8(pMbr, pMkr), sav, O);
#pragma unroll
                    for (int j = 0; j < 4; ++j) o_c[(sc * 16 + fq * 4 + j) * 64 + wid * 16 + fr] = O[j];
#pragma unroll
                    for (int jt = 0; jt < 4; ++jt) {
                        const sh4 ka = *(const sh4*)(o_kT + (jt * 16 + fr) * SC_LS + sc * 16 + fq * 4), ba = *(const sh4*)(o_bT + (jt * 16 + fr) * SC_LS + sc * 16 + fq * 4);
                        f32x4 acc = MF32(cat8(ba, ka), sav, S[jt]);
                        const float4 g4 = *(const float4*)(s_gc + sc * 64 + jt * 16 + fq * 4);
                        acc[0] *= g4.x; acc[1] *= g4.y; acc[2] *= g4.z; acc[3] *= g4.w;
                        S[jt] = acc;
                    }
                }
            }
        } else if (ch > 0) {
            const int t2 = otid() - 256;
            stepE(t2 >> 4, (t2 & 15) * 4, o_p, v_p, g_p, bs_p, t0 - SC_TC, SC_TC);
            stepE(16 + (t2 >> 4), (t2 & 15) * 4, o_p, v_p, g_p, bs_p, t0 - SC_TC, SC_TC);
        }
        lds_barrier();
    }
    {
        const int chl = (TS + SC_TC - 1) / SC_TC - 1; const bool parl = (chl & 1) != 0;
        stepE(tid >> 4, (tid & 15) * 4, parl ? s_oB : s_o, parl ? s_vB : s_v, parl ? s_gB : s_g, s_bs2 + (parl ? 32 : 0), chl * SC_TC, TS - chl * SC_TC);
    }
}
__device__ __forceinline__ void xcd_panel_map(int& mt0, int& mstep, int& nt) {
    const int b = obid(), G = (int)gridDim.x;
    if (G == 256) { nt = (b >> 3) & 7; mt0 = (b & 7) * 4 + (b >> 6); mstep = 32; }
    else { nt = b & 7; mt0 = b >> 3; mstep = G >> 3; }
}
__device__ __forceinline__ void g3t_kloop(f32x4 (&acc0)[3][4], f32x4 (&acc1)[3][4], f32x4 (&acc2)[3][4], const bf16_t* const (&ap)[3], const bf16_t* const (&bp)[6], unsigned char* lds) {
    constexpr int BM = 192, STAGE = BM * 128 + 384 * 128, NKT = DM / 64;
    const int tid = otid(), lane = tid & 63, wid = __builtin_amdgcn_readfirstlane(tid >> 6), wr = wid >> 1, wc = wid & 1, fr = lane & 15, fq = lane >> 4;
    auto issue = [&](int kt, unsigned char* stage) {
#pragma unroll
        for (int i = 0; i < 3; ++i) glds16(ap[i] + kt * 64, stage + (tid + i * NTHR) * 16);
#pragma unroll
        for (int i = 0; i < 6; ++i) glds16(bp[i] + kt * 64, stage + BM * 128 + (tid + i * NTHR) * 16);
    };
    issue(0, lds);
#pragma unroll 1
    for (int t = 0; t < NKT; ++t) {
        asm volatile("s_waitcnt vmcnt(0)" ::: "memory");
        __builtin_amdgcn_s_barrier();
        if (t + 1 < NKT) issue(t + 1, lds + ((t + 1) & 1) * STAGE);
        const unsigned char* cA = lds + (t & 1) * STAGE;
        const unsigned char* cB = cA + BM * 128;
#pragma unroll
        for (int ks = 0; ks < 2; ++ks) {
            bf16x8 a[3];
#pragma unroll
            for (int m = 0; m < 3; ++m) { const int row = wr * 48 + m * 16 + fr; a[m] = *(const bf16x8*)(cA + row * 128 + (((ks * 4 + fq) ^ (row & 7)) << 4)); }
            {
                bf16x8 b_[4];
#pragma unroll
                for (int n = 0; n < 4; ++n) { const int row = wc * 64 + n * 16 + fr; b_[n] = *(const bf16x8*)(cB + row * 128 + (((ks * 4 + fq) ^ (row & 7)) << 4)); }
#pragma unroll
                for (int m = 0; m < 3; ++m)
#pragma unroll
                    for (int n = 0; n < 4; ++n) acc0[m][n] = __builtin_amdgcn_mfma_f32_16x16x32_bf16(b_[n], a[m], acc0[m][n], 0, 0, 0);
            }
            {
                bf16x8 b_[4];
#pragma unroll
                for (int n = 0; n < 4; ++n) { const int row = wc * 64 + n * 16 + fr; b_[n] = *(const bf16x8*)(cB + (128 + row) * 128 + (((ks * 4 + fq) ^ (row & 7)) << 4)); }
#pragma unroll
                for (int m = 0; m < 3; ++m)
#pragma unroll
                    for (int n = 0; n < 4; ++n) acc1[m][n] = __builtin_amdgcn_mfma_f32_16x16x32_bf16(b_[n], a[m], acc1[m][n], 0, 0, 0);
            }
            {
                bf16x8 b_[4];
#pragma unroll
                for (int n = 0; n < 4; ++n) { const int row = wc * 64 + n * 16 + fr; b_[n] = *(const bf16x8*)(cB + (256 + row) * 128 + (((ks * 4 + fq) ^ (row & 7)) << 4)); }
#pragma unroll
                for (int m = 0; m < 3; ++m)
#pragma unroll
                    for (int n = 0; n < 4; ++n) acc2[m][n] = __builtin_amdgcn_mfma_f32_16x16x32_bf16(b_[n], a[m], acc2[m][n], 0, 0, 0);
            }
        }
    }
    __builtin_amdgcn_s_barrier();
}
__device__ void phase_merge(const Params& p, unsigned char* lds) {
    const int tid = otid(), lane = tid & 63, wid = __builtin_amdgcn_readfirstlane(tid >> 6), wr = wid >> 1, wc = wid & 1, fr = lane & 15, fq = lane >> 4;
    const bf16_t* h = (const bf16_t*)(WS(p) + OFF_H);
    const bf16_t* wb = (const bf16_t*)(WS(p) + OFF_WB);
    const float* rstd = (const float*)(WS(p) + OFF_RSTD);
    bf16_t* merged = (bf16_t*)(WS(p) + OFF_MERGED);
    int mt0, mstep, nt;
    xcd_panel_map(mt0, mstep, nt);
    for (int mt = mt0; mt < 86; mt += mstep) {
        const int row0 = mt * 192, col0 = nt * 128;
        uint2 sg0[3][4], sg1[3][4], sg2[3][4];
        {
            f32x4 g0[3][4], g1[3][4], g2[3][4]; g3_zero<3>(g0); g3_zero<3>(g1); g3_zero<3>(g2);
            const int t_ = otid();
            const bf16_t* ap[3]; const bf16_t* bp[6];
#pragma unroll
            for (int i = 0; i < 3; ++i) { const int idx = t_ + i * NTHR, row = idx >> 3, sl = (idx & 7) ^ (row & 7); ap[i] = h + (size_t)(row0 + row) * DM + sl * 8; }
#pragma unroll
            for (int i = 0; i < 6; ++i) { const int idx = t_ + i * NTHR, row = idx >> 3, sl = (idx & 7) ^ (row & 7); bp[i] = wb + WB_WG + (size_t)((row >> 7) * 1024 + col0 + (row & 127)) * DM + sl * 8; }
            g3t_kloop(g0, g1, g2, ap, bp, lds);
#pragma unroll
            for (int m = 0; m < 3; ++m) {
                const float rs = rstd[row0 + wr * 48 + m * 16 + fr];
#pragma unroll
                for (int n = 0; n < 4; ++n) {
                    sg0[m][n] = pack4(fast_sigmoid(g0[m][n][0] * rs), fast_sigmoid(g0[m][n][1] * rs), fast_sigmoid(g0[m][n][2] * rs), fast_sigmoid(g0[m][n][3] * rs));
                    sg1[m][n] = pack4(fast_sigmoid(g1[m][n][0] * rs), fast_sigmoid(g1[m][n][1] * rs), fast_sigmoid(g1[m][n][2] * rs), fast_sigmoid(g1[m][n][3] * rs));
                    sg2[m][n] = pack4(fast_sigmoid(g2[m][n][0] * rs), fast_sigmoid(g2[m][n][1] * rs), fast_sigmoid(g2[m][n][2] * rs), fast_sigmoid(g2[m][n][3] * rs));
                }
            }
        }
        uint2 maccp[3][4];
#pragma unroll
        for (int m = 0; m < 3; ++m)
#pragma unroll
            for (int n = 0; n < 4; ++n) maccp[m][n] = make_uint2(0u, 0u);
#pragma unroll 1
        for (int i = 0; i < 3; ++i) {
            const bf16_t* ys = (i == 0) ? (const bf16_t*)(WS(p) + OFF_PPOOL) : (i == 1 ? (const bf16_t*)(WS(p) + OFF_PR) : (const bf16_t*)(OUTB(p) + DO_YC));
            f32x4 ay[3][4]; g3_zero<3>(ay);
            G3<192> g;
            g3_setup<192>(g, [&](int r) { return ys + (size_t)(row0 + r) * DM; }, [&](int r) { return wb + WB_PA + (size_t)(i * 1024 + col0 + r) * DM; }, otid());
            g3_kloop<192>(ay, g, DM, lds);
#pragma unroll
            for (int m = 0; m < 3; ++m)
#pragma unroll
                for (int n = 0; n < 4; ++n) {
                    const unsigned k0 = (i == 0) ? ~0u : 0u, k1 = (i == 1) ? ~0u : 0u, k2 = (i == 2) ? ~0u : 0u;
                    const uint2 sgv = make_uint2((sg0[m][n].x & k0) | (sg1[m][n].x & k1) | (sg2[m][n].x & k2), (sg0[m][n].y & k0) | (sg1[m][n].y & k1) | (sg2[m][n].y & k2));
                    const float m0 = __uint_as_float(maccp[m][n].x << 16) + __uint_as_float(sgv.x << 16) * ay[m][n][0];
                    const float m1 = __uint_as_float(maccp[m][n].x & 0xFFFF0000u) + __uint_as_float(sgv.x & 0xFFFF0000u) * ay[m][n][1];
                    const float m2 = __uint_as_float(maccp[m][n].y << 16) + __uint_as_float(sgv.y << 16) * ay[m][n][2];
                    const float m3 = __uint_as_float(maccp[m][n].y & 0xFFFF0000u) + __uint_as_float(sgv.y & 0xFFFF0000u) * ay[m][n][3];
                    maccp[m][n] = pack4(m0, m1, m2, m3);
                }
        }
#pragma unroll
        for (int m = 0; m < 3; ++m) {
            const int row = row0 + wr * 48 + m * 16 + fr;
#pragma unroll
            for (int n = 0; n < 4; ++n)
                *(uint2*)(merged + (size_t)row * 1024 + col0 + wc * 64 + n * 16 + fq * 4) = maccp[m][n];
        }
    }
}

__device__ void phase_outproj(const Params& p, unsigned char* lds) {
    const int tid = otid(), lane = tid & 63, wid = __builtin_amdgcn_readfirstlane(tid >> 6), wr = wid >> 1, wc = wid & 1, fr = lane & 15, fq = lane >> 4;
    const bf16_t* h = (const bf16_t*)(WS(p) + OFF_H);
    const bf16_t* wb = (const bf16_t*)(WS(p) + OFF_WB);
    const bf16_t* merged = (const bf16_t*)(WS(p) + OFF_MERGED);
    bf16_t* hm = (bf16_t*)(WS(p) + OFF_HMB);
    int mt0, mstep, nt;
    xcd_panel_map(mt0, mstep, nt);
    for (int mt = mt0; mt < 86; mt += mstep) {
        const int row0 = mt * 192, col0 = nt * 128;
        G3<192> g;
        g3_setup<192>(g, [&](int r) { return merged + (size_t)(row0 + r) * DM; }, [&](int r) { return wb + WB_WO + (size_t)(col0 + r) * DM; }, tid);
        f32x4 acc[3][4]; g3_zero<3>(acc);
        g3_kloop<192>(acc, g, DM, lds);
        uint2 hres[3][4];
#pragma unroll
        for (int m = 0; m < 3; ++m)
#pragma unroll
            for (int n = 0; n < 4; ++n) hres[m][n] = *(const uint2*)(h + (size_t)(row0 + wr * 48 + m * 16 + fr) * 1024 + col0 + wc * 64 + n * 16 + fq * 4);
#pragma unroll
        for (int m = 0; m < 3; ++m) {
            const int row = row0 + wr * 48 + m * 16 + fr;
#pragma unroll
            for (int n = 0; n < 4; ++n) {
                const int col = col0 + wc * 64 + n * 16 + fq * 4;
                const uint2 hv = hres[m][n];
                float4 o;
                o.x = __uint_as_float(hv.x << 16) + acc[m][n][0]; o.y = __uint_as_float(hv.x & 0xFFFF0000u) + acc[m][n][1];
                o.z = __uint_as_float(hv.y << 16) + acc[m][n][2]; o.w = __uint_as_float(hv.y & 0xFFFF0000u) + acc[m][n][3];
                *(uint2*)(hm + (size_t)row * 1024 + col) = pack4(o.x, o.y, o.z, o.w);
            }
        }
    }
}

__device__ __constant__ int c_pair_lo[6] = {0, 0, 0, 1, 1, 2};
__device__ __constant__ int c_pair_hi[6] = {1, 2, 3, 2, 3, 3};
__device__ void phase_route(const Params& p, int l, unsigned char* lds) {
    const int tid = otid(), lane = tid & 63, wid = __builtin_amdgcn_readfirstlane(tid >> 6);
    const int per = (NT + (int)gridDim.x - 1) / (int)gridDim.x;
    const int nbeg = obid() * per, nend = (nbeg + per < NT) ? nbeg + per : NT;
    int* s_cls = (int*)lds;
    int* s_base = s_cls + 512;
    float* s_wr = (float*)(lds + 4096);
    const bf16_t* hm = (const bf16_t*)(WS(p) + OFF_HMB);
    float* rsm = (float*)(WS(p) + OFF_RSTD);
    const float* nf = p.in[33] + (size_t)l * 1024;
    const float* wg = p.in[34] + (size_t)l * 1024 * 4;
    const float* bg = p.in[35] + l * 4;
    const float* we = p.in[36] + (size_t)l * 1024 * 16;
    const float* be = p.in[37] + l * 16;
    int* cnt = (int*)(WS(p) + OFF_CTL);
    int* list = (int*)(WS(p) + OFF_LIST);
    float* pw = (float*)(WS(p) + OFF_PW);
    {
        float4 gv[2], ev[8];
#pragma unroll
        for (int i = 0; i < 2; ++i) gv[i] = *(const float4*)(wg + (size_t)(tid + i * NTHR) * 4);
#pragma unroll
        for (int i = 0; i < 8; ++i) ev[i] = *(const float4*)(we + (size_t)(tid + i * NTHR) * 4);
#pragma unroll
        for (int i = 0; i < 2; ++i) { const int k = tid + i * NTHR; s_wr[k] = gv[i].x; s_wr[1024 + k] = gv[i].y; s_wr[2048 + k] = gv[i].z; s_wr[3072 + k] = gv[i].w; }
#pragma unroll
        for (int i = 0; i < 8; ++i) {
            const int q = tid + i * NTHR, k = q >> 2, e0 = 4 + (q & 3) * 4;
            s_wr[e0 * 1024 + k] = ev[i].x; s_wr[(e0 + 1) * 1024 + k] = ev[i].y; s_wr[(e0 + 2) * 1024 + k] = ev[i].z; s_wr[(e0 + 3) * 1024 + k] = ev[i].w;
        }
    }
    if (tid < 16) s_wr[20 * 1024 + tid] = be[tid]; else if (tid < 20) s_wr[20 * 1024 + tid] = bg[tid - 16];
    __syncthreads();
    float4 nv[4]; uint2 cur[4];
#pragma unroll
    for (int i = 0; i < 4; ++i) nv[i] = *(const float4*)(nf + i * 256 + lane * 4);
    if (nbeg + wid < nend) {
#pragma unroll
        for (int i = 0; i < 4; ++i) cur[i] = *(const uint2*)(hm + (size_t)(nbeg + wid) * DM + i * 256 + lane * 4);
    }
    for (int n = nbeg + wid; n < nend; n += 8) {
        float4 xv[4]; float ss = 0.f;
#pragma unroll
        for (int i = 0; i < 4; ++i) {
            xv[i] = make_float4(__uint_as_float(cur[i].x << 16), __uint_as_float(cur[i].x & 0xFFFF0000u), __uint_as_float(cur[i].y << 16), __uint_as_float(cur[i].y & 0xFFFF0000u));
            ss += xv[i].x * xv[i].x + xv[i].y * xv[i].y + xv[i].z * xv[i].z + xv[i].w * xv[i].w;
        }
        if (n + 8 < nend) {
#pragma unroll
            for (int i = 0; i < 4; ++i) cur[i] = *(const uint2*)(hm + (size_t)(n + 8) * DM + i * 256 + lane * 4);
        }
        ss = wave_sum_fast(ss);
        const float rs = rsqrtf(ss * (1.0f / 1024.0f) + 1e-6f);
        if (lane == 0) rsm[n] = rs;
        float lg[4] = {0.f, 0.f, 0.f, 0.f};
        float y[4][4];
#pragma unroll
        for (int i = 0; i < 4; ++i) {
            y[i][0] = xv[i].x * rs * nv[i].x; y[i][1] = xv[i].y * rs * nv[i].y; y[i][2] = xv[i].z * rs * nv[i].z; y[i][3] = xv[i].w * rs * nv[i].w;
            const int d0 = i * 256 + lane * 4;
#pragma unroll
            for (int g = 0; g < 4; ++g) { const float4 w4 = *(const float4*)(s_wr + g * 1024 + d0); lg[g] += y[i][0] * w4.x + y[i][1] * w4.y + y[i][2] * w4.z + y[i][3] * w4.w; }
        }
#pragma unroll
        for (int g = 0; g < 4; ++g) lg[g] = wave_sum_fast(lg[g]) + s_wr[20 * 1024 + 16 + g];
        int gs_ = 0; float gm = lg[0];
#pragma unroll
        for (int g = 1; g < 4; ++g) if (lg[g] > gm) { gm = lg[g]; gs_ = g; }
        const int gs = __builtin_amdgcn_readfirstlane(gs_);
        float v4[4] = {0.f, 0.f, 0.f, 0.f};
        {
            const float* wsel = s_wr + (4 + gs * 4) * 1024;
#pragma unroll
            for (int i = 0; i < 4; ++i) {
                const int d0 = i * 256 + lane * 4;
#pragma unroll
                for (int e = 0; e < 4; ++e) { const float4 w4 = *(const float4*)(wsel + e * 1024 + d0); v4[e] += y[i][0] * w4.x + y[i][1] * w4.y + y[i][2] * w4.z + y[i][3] * w4.w; }
            }
#pragma unroll
            for (int e = 0; e < 4; ++e) v4[e] = wave_sum_fast(v4[e]) + s_wr[20 * 1024 + gs * 4 + e];
        }
        if (lane == 0) {
            float den = 0.f;
#pragma unroll
            for (int g = 0; g < 4; ++g) den += __expf(lg[g] - gm);
            const float pgrp = 1.0f / den;
            int i1 = 0; float m1 = v4[0];
#pragma unroll
            for (int e = 1; e < 4; ++e) if (v4[e] > m1) { m1 = v4[e]; i1 = e; }
            int i2 = -1; float m2 = -INFINITY;
#pragma unroll
            for (int e = 0; e < 4; ++e) if (e != i1 && v4[e] > m2) { m2 = v4[e]; i2 = e; }
            const float e2 = __expf(m2 - m1);
            const float p1 = pgrp / (1.0f + e2), p2 = pgrp * e2 / (1.0f + e2);
            const int lo = i1 < i2 ? i1 : i2, hi = i1 < i2 ? i2 : i1;
            const float plo = i1 < i2 ? p1 : p2, phi = i1 < i2 ? p2 : p1;
            const int pi = (lo == 0) ? (hi - 1) : (lo == 1 ? hi + 1 : 5);
            const int cls = gs * 6 + pi;
            s_cls[n - nbeg] = cls;
            pw[(size_t)n * 2 + 0] = plo; pw[(size_t)n * 2 + 1] = phi;
        }
    }
    __syncthreads();
    const int nloc = nend - nbeg;
    if (tid < 24) {
        int c_ = 0;
        for (int i = 0; i < nloc; ++i) c_ += (s_cls[i] == tid) ? 1 : 0;
        s_base[tid] = c_ ? atomicAdd(&cnt[tid * 32], c_) : 0;
    }
    __syncthreads();
    for (int it = tid; it < nloc; it += NTHR) {
        const int cls = s_cls[it];
        int rank = 0;
        for (int i = 0; i < it; ++i) rank += (s_cls[i] == cls) ? 1 : 0;
        list[(size_t)cls * NT + s_base[cls] + rank] = nbeg + it;
    }
    __syncthreads();
}


struct MoeTile { int cls, ti, cnt, tg; };
__device__ __forceinline__ int moe_table(const int* cnt, unsigned char* lds) {
    int* tab = (int*)(lds + LDS_BYTES - 512);
    __syncthreads();
    if (otid() < 24) tab[otid()] = cnt[otid() * 32];
    __syncthreads();
    if (otid() == 0) { int s_ = 0; for (int c = 0; c < 24; ++c) { tab[24 + c] = s_; s_ += (tab[c] + 127) >> 7; } tab[48] = s_; }
    __syncthreads();
    return tab[48];
}
__device__ __forceinline__ MoeTile moe_find(const unsigned char* lds, int tile) {
    const int* tab = (const int*)(lds + LDS_BYTES - 512);
    MoeTile r; r.cls = 0; r.ti = 0; r.cnt = 0; r.tg = tile;
    for (int c = 0; c < 24; ++c) { const int s_ = tab[24 + c], e_ = tab[25 + c]; if (tile >= s_ && tile < e_) { r.cls = c; r.ti = tile - s_; r.cnt = tab[c]; } }
    return r;
}
__device__ void phase_moe1(const Params& p, unsigned char* lds) {
    const int tid = otid(), lane = tid & 63, wid = __builtin_amdgcn_readfirstlane(tid >> 6), wr = wid >> 1, wc = wid & 1, fr = lane & 15, fq = lane >> 4;
    const int* cnt = (const int*)(WS(p) + OFF_CTL);
    const int* list = (const int*)(WS(p) + OFF_LIST);
    const float* pw = (const float*)(WS(p) + OFF_PW);
    const bf16_t* hn = (const bf16_t*)(WS(p) + OFF_HMB);
    const float* rsm = (const float*)(WS(p) + OFF_RSTD);
    const bf16_t* we = (const bf16_t*)(WS(p) + OFF_WEXP);
    bf16_t* hid = (bf16_t*)(OUTB(p) + DO_HID);
    const int total = moe_table(cnt, lds);
    const int xq = obid() & 7, yq = obid() >> 3, ystep = gridDim.x >> 3;
    for (int idx = yq; ; idx += ystep) {
        const int tix = (idx >> 2) * 8 + xq;
        if (tix >= total) break;
        const MoeTile mt = moe_find(lds, tix);
        const int nt = idx & 3, slot = nt >> 1, f0 = (nt & 1) * 128;
        const int g_ = mt.cls / 6, pi = mt.cls % 6;
        const int e = g_ * 4 + (slot == 0 ? c_pair_lo[pi] : c_pair_hi[pi]);
        const int* lst = list + (size_t)mt.cls * NT + mt.ti * 128;
        const int nvalid = min(128, mt.cnt - mt.ti * 128);
        f32x4 a1[2][4], a3[2][4]; g3_zero<2>(a1); g3_zero<2>(a3);
        G3D g;
#pragma unroll
        for (int i = 0; i < 2; ++i) {
            const int idx = tid + i * NTHR, row = idx >> 3, sl = (idx & 7) ^ (row & 7);
            g.ap[i] = hn + (size_t)lst[row < nvalid ? row : 0] * DM + sl * 8;
            g.b1[i] = we + WE_W1 + ((size_t)e * 256 + f0 + row) * 1024 + sl * 8;
            g.b3[i] = we + WE_W3 + ((size_t)e * 256 + f0 + row) * 1024 + sl * 8;
        }
        g3d_kloop(a1, a3, g, DM, lds);
        float pev[2], rsv[2];
#pragma unroll
        for (int m = 0; m < 2; ++m) { const int lr = wr * 32 + m * 16 + fr; const int tk = lst[lr < nvalid ? lr : 0]; pev[m] = pw[(size_t)tk * 2 + slot]; rsv[m] = rsm[tk]; }
#pragma unroll
        for (int m = 0; m < 2; ++m) {
            const int lr = wr * 32 + m * 16 + fr;
            const float pe = pev[m] * rsv[m], rs_ = rsv[m];
#pragma unroll
            for (int n = 0; n < 4; ++n) {
                const int col = slot * 256 + f0 + wc * 64 + n * 16 + fq * 4;
                float o[4];
#pragma unroll
                for (int j = 0; j < 4; ++j) { const float x1 = a1[m][n][j] * rs_; o[j] = x1 * sigmoidf_(x1) * a3[m][n][j] * pe; }
                *(uint2*)(hid + ((size_t)mt.tg * 128 + lr) * 512 + col) = pack4(o[0], o[1], o[2], o[3]);
            }
        }
    }
}
__device__ void phase_moe2(const Params& p, int l, unsigned char* lds) {
    const int tid = otid(), lane = tid & 63, wid = __builtin_amdgcn_readfirstlane(tid >> 6), wr = wid >> 1, wc = wid & 1, fr = lane & 15, fq = lane >> 4;
    const int* cnt = (const int*)(WS(p) + OFF_CTL);
    const int* list = (const int*)(WS(p) + OFF_LIST);
    const bf16_t* we = (const bf16_t*)(WS(p) + OFF_WEXP);
    const bf16_t* hid = (const bf16_t*)(OUTB(p) + DO_HID);
    const bf16_t* hm = (const bf16_t*)(WS(p) + OFF_HMB);
    bf16_t* h = (bf16_t*)(WS(p) + OFF_H);
    const int total = moe_table(cnt, lds);
    const int xq = obid() & 7, yq = obid() >> 3, ystep = gridDim.x >> 3;
    for (int idx = yq; ; idx += ystep) {
        const int tix = (idx >> 3) * 8 + xq;
        if (tix >= total) break;
        const MoeTile mt = moe_find(lds, tix);
        const int nt = idx & 7, col0 = nt * 128;
        const int g_ = mt.cls / 6, pi = mt.cls % 6;
        const int elo = g_ * 4 + c_pair_lo[pi], ehi = g_ * 4 + c_pair_hi[pi];
        const int* lst = list + (size_t)mt.cls * NT + mt.ti * 128;
        const int nvalid = min(128, mt.cnt - mt.ti * 128);
        f32x4 acc[2][4]; g3_zero<2>(acc);
        {
            constexpr int BM = 128, STAGE = G3<BM>::STAGE;
            G3<BM> g; const bf16_t* bph[2];
            g3_setup<BM>(g, [&](int r) { return hid + ((size_t)mt.tg * 128 + r) * 512; }, [&](int r) { return we + WE_W2 + ((size_t)elo * 1024 + col0 + r) * 256; }, tid);
#pragma unroll
            for (int i = 0; i < 2; ++i) { const int idx = tid + i * NTHR, row = idx >> 3, sl = (idx & 7) ^ (row & 7); bph[i] = we + WE_W2 + ((size_t)ehi * 1024 + col0 + row) * 256 + sl * 8 - 256; }
            auto issue = [&](int kt, unsigned char* stage) {
#pragma unroll
                for (int i = 0; i < 2; ++i) glds16(g.ap[i] + kt * 64, stage + (tid + i * NTHR) * 16);
#pragma unroll
                for (int i = 0; i < 2; ++i) glds16((kt < 4 ? g.bp[i] : bph[i]) + kt * 64, stage + BM * 128 + (tid + i * NTHR) * 16);
            };
            issue(0, lds); issue(1, lds + STAGE);
            int cur = 0;
#pragma unroll 1
            for (int t = 0; t < 8; ++t) {
                if (t + 1 < 8) asm volatile("s_waitcnt vmcnt(4)" ::: "memory"); else asm volatile("s_waitcnt vmcnt(0)" ::: "memory");
                __builtin_amdgcn_s_barrier();
                if (t + 2 < 8) { int nx = cur + 2; if (nx >= 3) nx -= 3; issue(t + 2, lds + nx * STAGE); }
                const unsigned char* cA = lds + cur * STAGE;
                const unsigned char* cB = cA + BM * 128;
#pragma unroll
                for (int ks = 0; ks < 2; ++ks) {
                    bf16x8 a_[2], b_[4];
#pragma unroll
                    for (int m = 0; m < 2; ++m) { const int row = wr * 32 + m * 16 + fr; a_[m] = *(const bf16x8*)(cA + row * 128 + (((ks * 4 + fq) ^ (row & 7)) << 4)); }
#pragma unroll
                    for (int n = 0; n < 4; ++n) { const int row = wc * 64 + n * 16 + fr; b_[n] = *(const bf16x8*)(cB + row * 128 + (((ks * 4 + fq) ^ (row & 7)) << 4)); }
#pragma unroll
                    for (int m = 0; m < 2; ++m)
#pragma unroll
                        for (int n = 0; n < 4; ++n) acc[m][n] = __builtin_amdgcn_mfma_f32_16x16x32_bf16(b_[n], a_[m], acc[m][n], 0, 0, 0);
                }
                cur = (cur == 2) ? 0 : cur + 1;
            }
            __builtin_amdgcn_s_barrier();
        }
        int tkv[2]; uint2 hv[2][4];
#pragma unroll
        for (int m = 0; m < 2; ++m) {
            const int lr = wr * 32 + m * 16 + fr;
            tkv[m] = lst[lr < nvalid ? lr : 0];
#pragma unroll
            for (int n = 0; n < 4; ++n) hv[m][n] = *(const uint2*)(hm + (size_t)tkv[m] * 1024 + col0 + wc * 64 + n * 16 + fq * 4);
        }
        float rsum[2] = {0.f, 0.f};
#pragma unroll
        for (int m = 0; m < 2; ++m) {
            const int lr = wr * 32 + m * 16 + fr;
            if (lr < nvalid) {
                const int tk = tkv[m];
#pragma unroll
                for (int n = 0; n < 4; ++n) {
                    const int col = col0 + wc * 64 + n * 16 + fq * 4;
                    float4 v = make_float4(__uint_as_float(hv[m][n].x << 16), __uint_as_float(hv[m][n].x & 0xFFFF0000u), __uint_as_float(hv[m][n].y << 16), __uint_as_float(hv[m][n].y & 0xFFFF0000u));
                    v.x += acc[m][n][0]; v.y += acc[m][n][1]; v.z += acc[m][n][2]; v.w += acc[m][n][3];
                    if (l == 0) {
                        const uint2 pk = pack4(v.x, v.y, v.z, v.w);
                        *(uint2*)(h + (size_t)tk * 1024 + col) = pk;
                        const float r0 = __uint_as_float(pk.x << 16), r1 = __uint_as_float(pk.x & 0xFFFF0000u), r2 = __uint_as_float(pk.y << 16), r3 = __uint_as_float(pk.y & 0xFFFF0000u);
                        rsum[m] += (r0 * r0 + r1 * r1) + (r2 * r2 + r3 * r3);
                    }
                    else *(uint2*)(h + (size_t)tk * 1024 + col) = pack4(v.x, v.y, v.z, v.w);
                }
            }
        }
        if (l == 0) {
            unsigned long long* ssq = (unsigned long long*)(WS(p) + OFF_SSQ);
#pragma unroll
            for (int m = 0; m < 2; ++m) {
                float s_ = rsum[m];
                s_ += __shfl_xor(s_, 16); s_ += __shfl_xor(s_, 32);
                if (fq == 0 && wr * 32 + m * 16 + fr < nvalid) atomicAdd(ssq + tkv[m], (unsigned long long)(s_ * 1048576.0f + 0.5f));
            }
        }
    }
}

__device__ void phase_final(const Params& p) {
    const int lane = otid() & 63;
    const int wave = (obid() * NTHR + otid()) >> 6, nw = gridDim.x * NTHR / 64;
    const bf16_t* hm = (const bf16_t*)(WS(p) + OFF_H);
    const float* nf = p.in[41];
    float4 g[4]; uint2 cur[4];
#pragma unroll
    for (int i = 0; i < 4; ++i) g[i] = *(const float4*)(nf + i * 256 + lane * 4);
    auto rowp = [&](int r) { const int b = r / SEQ, s_ = r % SEQ; return hm + ((size_t)b * TS + NMETA + s_) * DM; };
    if (wave < NB * SEQ) {
        const bf16_t* src = rowp(wave);
#pragma unroll
        for (int i = 0; i < 4; ++i) cur[i] = *(const uint2*)(src + i * 256 + lane * 4);
    }
    for (int r = wave; r < NB * SEQ; r += nw) {
        float4 v[4]; float ss = 0.f;
#pragma unroll
        for (int i = 0; i < 4; ++i) {
            v[i] = make_float4(__uint_as_float(cur[i].x << 16), __uint_as_float(cur[i].x & 0xFFFF0000u), __uint_as_float(cur[i].y << 16), __uint_as_float(cur[i].y & 0xFFFF0000u));
            ss += v[i].x * v[i].x + v[i].y * v[i].y + v[i].z * v[i].z + v[i].w * v[i].w;
        }
        if (r + nw < NB * SEQ) {
            const bf16_t* src = rowp(r + nw);
#pragma unroll
            for (int i = 0; i < 4; ++i) cur[i] = *(const uint2*)(src + i * 256 + lane * 4);
        }
        ss = wave_sum_fast(ss);
        const float rs = rsqrtf(ss * (1.0f / 1024.0f) + 1e-6f);
#pragma unroll
        for (int i = 0; i < 4; ++i) {
            float4 o; o.x = v[i].x * rs * g[i].x; o.y = v[i].y * rs * g[i].y; o.z = v[i].z * rs * g[i].z; o.w = v[i].w * rs * g[i].w;
            *(float4*)((float*)OUTB(p) + (size_t)r * DM + i * 256 + lane * 4) = o;
        }
    }
}


#define XB_TMO      128
#define XB_XCNT(j)  (256  + 64 * (j))
#define XB_XSUB(j)  (1280 + 64 * (j))
#define XB_XGEN(j)  (2304 + 64 * (j))
#define XB_TOP      3328
#define XB_TOPGEN   3392
#define XCD_BAR_WORDS 3456
#define XB_SPIN_CAP (1u << 22)
#define LAS __attribute__((address_space(3)))
__device__ __forceinline__ unsigned xb_ld(unsigned* p) { return __hip_atomic_load(p, __ATOMIC_RELAXED, __HIP_MEMORY_SCOPE_AGENT); }
__device__ __forceinline__ unsigned xb_add(unsigned* p, unsigned v) { return __hip_atomic_fetch_add(p, v, __ATOMIC_RELAXED, __HIP_MEMORY_SCOPE_AGENT); }
__device__ __forceinline__ unsigned xb_xcc_id() { return (unsigned)__builtin_amdgcn_s_getreg((3 << 11) | 20) & 0xFu; }
#define XB_SPIN(cond, bar) do { unsigned _sp = 0; while (cond) { __builtin_amdgcn_s_sleep(1); \
    if ((++_sp & 255u) == 0u) { if (xb_ld(&(bar)[XB_TMO])) break; if (_sp > XB_SPIN_CAP) { atomicAdd(&(bar)[XB_TMO], 1u); break; } } } } while (0)
struct XcdBarrier { unsigned* bar; unsigned x; volatile LAS unsigned* st; };
__device__ __forceinline__ XcdBarrier xcd_barrier_post(unsigned* bar, volatile LAS unsigned* st) {
    XcdBarrier b; b.bar = bar; b.x = xb_xcc_id(); b.st = st;
    if (threadIdx.x == 0) (void)xb_add(&bar[XB_XCNT(b.x)], 1u);
    return b;
}
__device__ __forceinline__ void xcd_barrier_complete(unsigned* bar, unsigned x, unsigned& nloc, unsigned& nx) {
    const unsigned G = gridDim.x * gridDim.y * gridDim.z;
    unsigned sum, cnt, mine, sp = 0u;
    for (;;) {
        sum = 0u; cnt = 0u; mine = 0u;
#pragma unroll
        for (unsigned j = 0; j < 16; ++j) { const unsigned c = xb_ld(&bar[XB_XCNT(j)]); sum += c; cnt += (c > 0u) ? 1u : 0u; mine = (j == x) ? c : mine; }
        if (sum == G) break;
        __builtin_amdgcn_s_sleep(1);
        if ((++sp & 255u) == 0u) { if (xb_ld(&bar[XB_TMO])) break; if (sp > XB_SPIN_CAP) { atomicAdd(&bar[XB_TMO], 1u); break; } }
    }
    nloc = mine > 0u ? mine : 1u; nx = cnt > 0u ? cnt : 1u;
}
__device__ __forceinline__ void xcd_barrier(const XcdBarrier& b) {
    asm volatile("s_waitcnt vmcnt(0)" ::: "memory");
    __syncthreads();
    if (threadIdx.x == 0) {
        unsigned* bar = b.bar;
        __builtin_amdgcn_s_waitcnt(0);
        unsigned nloc = b.st[0], nx = b.st[1];
        if (nloc == 0u) { xcd_barrier_complete(bar, b.x, nloc, nx); b.st[0] = nloc; b.st[1] = nx; }
        const unsigned old = xb_add(&bar[XB_XSUB(b.x)], 1u);
        const unsigned gen = old / nloc;
        if (old + 1u == (gen + 1u) * nloc) {
            __builtin_amdgcn_fence(__ATOMIC_RELEASE, "agent");
            asm volatile("s_waitcnt vmcnt(0)" ::: "memory");
            const unsigned og = xb_add(&bar[XB_TOP], 1u);
            const unsigned tg = og / nx;
            if (og + 1u != (tg + 1u) * nx) XB_SPIN(xb_ld(&bar[XB_TOP]) < (tg + 1u) * nx, bar);
            __builtin_amdgcn_fence(__ATOMIC_ACQUIRE, "agent");
            xb_add(&bar[XB_XGEN(b.x)], 1u);
            asm volatile("s_waitcnt vmcnt(0)" ::: "memory");
        } else {
            XB_SPIN(xb_ld(&bar[XB_XGEN(b.x)]) == gen, bar);
            __builtin_amdgcn_fence(__ATOMIC_ACQUIRE, "agent");
            asm volatile("s_waitcnt vmcnt(0)" ::: "memory");
        }
    }
    __syncthreads();
}

__global__ void __launch_bounds__(NTHR) fwd_megakernel(Params p) {
    extern __shared__ __attribute__((aligned(16))) unsigned char lds[];
    cg::grid_group grid = cg::this_grid();
    volatile LAS unsigned* xst = (volatile LAS unsigned*)(lds + LDS_BYTES - 32);
    if (threadIdx.x < 2) xst[threadIdx.x] = 0u;
    __syncthreads();
    const XcdBarrier xb = xcd_barrier_post((unsigned*)(p.ws + OFF_BAR), xst);
    if (p.out == nullptr) grid.sync();
#pragma unroll 1
    for (int step = 0; step < 18; ++step) {
        const int l = step >= 9 ? 1 : 0;
        const int ph = step - l * 9;
        if (l == 1 && ph == 0) continue;
        switch (ph) {
        case 0:
            phase_embed(p);
            phase_convert<false>(p, l, lds);
            if (obid() == 0 && otid() < 24) ((int*)(WS(p) + OFF_CTL))[otid() * 32] = 0;
            if (obid() == 0 && otid() >= 32 && otid() < 34) ((int*)(WS(p) + OFF_CTL))[800 + (otid() - 32) * 32] = 0;
            if (obid() == 0 && otid() >= 34 && otid() < 36) ((int*)(WS(p) + OFF_CTL))[896 + (otid() - 34) * 32] = 0;
            if (obid() == 0 && otid() == 36) ((int*)(WS(p) + OFF_CTL))[960] = 0;
            break;
        case 1: phase_inproj(p, l, lds); break;
        case 2:
            if (l == 1 && obid() == 0 && otid() < 24) ((int*)(WS(p) + OFF_CTL))[otid() * 32] = 0;
            phase_dsa_prep(p, l); phase_lr_prep(p, l); break;
        case 3: {
            if (obid() < NB * 16) phase_scan5(p, l, lds, obid());
            int* qctr = (int*)(WS(p) + OFF_CTL) + 800 + l * 32;
            int* qslot = (int*)(lds + LDS_BYTES - 16);
            int qnext = -1;
            for (;;) {
                __syncthreads();
                if (otid() == 0) *qslot = (qnext >= 0) ? qnext : atomicAdd(qctr, 1);
                __syncthreads();
                const int item = *qslot;
                if (item >= 516 + NT / 32 + FILL3) break;
                if (otid() == 0) qnext = (item >= NT / 32) ? atomicAdd(qctr, 1) : -1;
                if (item < NT / 32) phase_dsa<false>(p, l, lds, (bf16_t*)(OUTB(p) + DO_YC), nullptr, nullptr, item, item + 1, 1);
                else if (item < 516 + NT / 32) phase_pool(p, l, lds, item - NT / 32, item - NT / 32 + 1, 1);
                else {
                    const int ct = item - (516 + NT / 32);
                    const ConvJob cj = get_job_late(p, l, ct >> 10);
                    conv_tile(cj, ct & 1023, (float*)lds);
                }
            }
        } break;
        case 4: {
            phase_merge(p, lds);
            int* qf = (int*)(WS(p) + OFF_CTL) + 896 + l * 32;
            int* qslot = (int*)(lds + LDS_BYTES - 16);
            for (;;) {
                __syncthreads();
                if (otid() == 0) *qslot = atomicAdd(qf, 1);
                __syncthreads();
                const int k = *qslot;
                if (k >= 3072 - FILL3) break;
                const int ct = FILL3 + k;
                const ConvJob cj = get_job_late(p, l, ct >> 10);
                conv_tile(cj, ct & 1023, (float*)lds);
            }
        } break;
        case 5: phase_outproj(p, lds); break;
        case 6: phase_route(p, l, lds); break;
        case 7:
        default: {
            if (ph == 7) phase_moe1(p, lds); else phase_moe2(p, l, lds);
            if (l == 0) {
                int* qc = (int*)(WS(p) + OFF_CTL) + 960;
                int* qslot = (int*)(lds + LDS_BYTES - 16);
                const int gend = (ph == 7) ? CONV_Q7 : CONV_EARLY_GROUPS;
                for (;;) {
                    __syncthreads();
                    if (otid() == 0) { const int g = atomicAdd(qc, 1); if (g >= gend) atomicAdd(qc, -1); *qslot = g; }
                    __syncthreads();
                    const int g = *qslot;
                    if (g >= gend) break;
                    conv_early_group(p, 1, g, lds);
                }
            }
        } break;
        }
        xcd_barrier(xb);
    }
    phase_final(p);
}

extern "C" void kernel_launch(void* const* d_in, const int* in_sizes, int n_in,
                              void* d_out, int out_size, void* d_ws, size_t ws_size,
                              hipStream_t stream) {
    static int grid_blocks = 0;
    if (grid_blocks == 0) {
        int dev = 0, cus = 0, per_cu = 0;
        (void)hipGetDevice(&dev);
        (void)hipDeviceGetAttribute(&cus, hipDeviceAttributeMultiprocessorCount, dev);
        (void)hipFuncSetAttribute((const void*)fwd_megakernel, hipFuncAttributeMaxDynamicSharedMemorySize, LDS_BYTES);
        (void)hipOccupancyMaxActiveBlocksPerMultiprocessor(&per_cu, fwd_megakernel, NTHR, LDS_BYTES);
        if (per_cu < 1 || cus < NB * 16 || (cus & 7) != 0 || n_in != 42 || ws_size < WS_END + (size_t)QS_WS * QS_BYTES || cus > QS_WS + QS_DO) { fprintf(stderr, "kernel_launch: bad config per_cu=%d n_in=%d ws=%zu need=%zu\n", per_cu, n_in, ws_size, (size_t)WS_END); grid_blocks = -1; }
        else grid_blocks = cus;
    }
    if (grid_blocks < 0) return;
    Params p{};
    for (int i = 0; i < 42; ++i) p.in[i] = (const float*)d_in[i];
    p.out = (float*)d_out;
    p.ws = (unsigned char*)d_ws;
    (void)hipMemsetAsync((unsigned char*)d_ws + OFF_BAR, 0, XCD_BAR_WORDS * 4, stream);
    void* args[] = {&p};
    hipError_t e = hipLaunchCooperativeKernel((void*)fwd_megakernel, dim3(grid_blocks), dim3(NTHR), args, LDS_BYTES, stream);
    if (e != hipSuccess) fprintf(stderr, "cooperative launch failed: %s (grid %d)\n", hipGetErrorString(e), grid_blocks);
}
```
